# Optimizing an MI355X kernel written in HIP

```python
import math
import jax, jax.numpy as jnp
from jax import lax
import numpy as np

D_MODEL = 1024
BATCH = 2
SEQ = 8192
DEPTH = 1
DEC_BATCH = 128
DEC_SEQ = 4
PAST_LEN = 8192
PAGE_SIZE = 128

MIX_WIDTH = 2 * D_MODEL
HEAD_DIM = 64
ATT_WIDTH = MIX_WIDTH // 4
ATT_HEADS = ATT_WIDTH // HEAD_DIM
SSD_WIDTH = MIX_WIDTH - ATT_WIDTH
SSD_HEADS = SSD_WIDTH // HEAD_DIM
SSD_GROUPS = 4
SSD_STATE = 128
SSD_CONV = 4
SSD_CHUNK = 128
CONV_DIM = SSD_WIDTH + 2 * SSD_GROUPS * SSD_STATE
IN_WIDTH = SSD_WIDTH + CONV_DIM + SSD_HEADS + 3 * ATT_WIDTH
DIL_PATTERNS = ((128, 1), (512, 4), (2048, 16))
W_MAX = max(w for w, _ in DIL_PATTERNS)
ATT_BLOCK = 128
ROPE_THETA = 10000.0
PEER_NKEYS = 128
PEER_EXPERTS = PEER_NKEYS * PEER_NKEYS
PEER_HEADS = 8
PEER_TOPK = 16
PEER_DKEY = 256
PEER_BLOCK = 128
ALPHA = (2 * DEPTH) ** 0.25
BETA = (8 * DEPTH) ** -0.25
LN_EPS = 1e-5

kernel_name = 'hymba_ssd_dilated_window_peer_step'

F32 = jnp.float32


def layer_norm(x, g, b):
    xf = x.astype(F32)
    mu = jnp.mean(xf, axis=-1, keepdims=True)
    xc = xf - mu
    var = jnp.mean(xc * xc, axis=-1, keepdims=True)
    return (xc * lax.rsqrt(var + LN_EPS) * g.astype(F32) + b.astype(F32)).astype(x.dtype)


def rope(t, pos):
    half = HEAD_DIM // 2
    inv = ROPE_THETA ** (-jnp.arange(half, dtype=F32) / half)
    ang = pos.astype(F32)[:, None] * inv[None, :]
    cos = jnp.cos(ang)[None, :, None, :]
    sin = jnp.sin(ang)[None, :, None, :]
    tf = t.astype(F32)
    t1, t2 = tf[..., :half], tf[..., half:]
    return jnp.concatenate([t1 * cos - t2 * sin, t2 * cos + t1 * sin], axis=-1).astype(t.dtype)


def mixer_inputs(x, pos, w_in):
    b, L, _ = x.shape
    proj = jnp.einsum('bld,de->ble', x, w_in)
    o1 = SSD_WIDTH
    o2 = o1 + CONV_DIM
    o3 = o2 + SSD_HEADS
    z = proj[..., :o1]
    xbc = proj[..., o1:o2]
    dt_raw = proj[..., o2:o3]
    qkv = proj[..., o3:].reshape(b, L, 3, ATT_HEADS, HEAD_DIM)
    q = rope(qkv[:, :, 0], pos)
    k = rope(qkv[:, :, 1], pos)
    v = qkv[:, :, 2]
    return z, xbc, dt_raw, q, k, v


def ssd_scan(x, dt, A, Bm, Cm, h0):
    b, L, H, P = x.shape
    G, N = Bm.shape[2], Bm.shape[3]
    R = H // G
    q = min(SSD_CHUNK, L)
    pad = (-L) % q
    if pad:
        pw = lambda t: jnp.pad(t, [(0, 0), (0, pad)] + [(0, 0)] * (t.ndim - 2))
        x, dt, Bm, Cm = pw(x), pw(dt), pw(Bm), pw(Cm)
    c = (L + pad) // q
    x = x.reshape(b, c, q, G, R, P)
    dt = dt.reshape(b, c, q, G, R)
    Bm = Bm.reshape(b, c, q, G, N)
    Cm = Cm.reshape(b, c, q, G, N)
    acs = jnp.cumsum(dt * A.reshape(G, R), axis=2)
    xdt = x * dt[..., None]
    causal = jnp.tril(jnp.ones((q, q), dtype=bool))[:, :, None, None]
    seg = acs[:, :, :, None] - acs[:, :, None, :]
    decay = jnp.exp(jnp.where(causal, seg, -jnp.inf))
    cb = jnp.einsum('bclgn,bcsgn->bclsg', Cm, Bm)
    y_diag = jnp.einsum('bclsgr,bcsgrp->bclgrp', cb[..., None] * decay, xdt)
    decay_to_end = jnp.exp(acs[:, :, -1:] - acs)
    states = jnp.einsum('bclgn,bclgrp->bcgrpn', Bm, xdt * decay_to_end[..., None])
    chunk_decay = jnp.exp(acs[:, :, -1])

    def step(h, inp):
        dec, st = inp
        return dec[..., None, None] * h + st, h

    h_final, h_in = lax.scan(step, h0.reshape(b, G, R, P, N),
                             (jnp.moveaxis(chunk_decay, 1, 0), jnp.moveaxis(states, 1, 0)))
    h_in = jnp.moveaxis(h_in, 0, 1)
    y_off = jnp.einsum('bclgn,bcgrpn->bclgrp', Cm, h_in) * jnp.exp(acs)[..., None]
    y = (y_diag + y_off).reshape(b, c * q, H, P)[:, :L]
    return y, h_final.reshape(b, H, P, N)


def ssd_mixer(z, xbc, dt_raw, conv_prev, h0, conv_w, conv_b, dt_bias, a_log, d_skip, norm_g):
    b, L, _ = z.shape
    xbc_in = jnp.concatenate([conv_prev.astype(xbc.dtype), xbc], axis=1)
    conv = conv_b + xbc_in[:, 0:L] * conv_w[0]
    for tap in range(1, SSD_CONV):
        conv = conv + xbc_in[:, tap:tap + L] * conv_w[tap]
    xbc_act = jax.nn.silu(conv)
    new_conv = xbc_in[:, -(SSD_CONV - 1):]
    gn = SSD_GROUPS * SSD_STATE
    xs = xbc_act[..., :SSD_WIDTH].reshape(b, L, SSD_HEADS, HEAD_DIM).astype(F32)
    bm = xbc_act[..., SSD_WIDTH:SSD_WIDTH + gn].reshape(b, L, SSD_GROUPS, SSD_STATE).astype(F32)
    cm = xbc_act[..., SSD_WIDTH + gn:].reshape(b, L, SSD_GROUPS, SSD_STATE).astype(F32)
    dt = jax.nn.softplus(dt_raw.astype(F32) + dt_bias.astype(F32))
    A = -jnp.exp(a_log.astype(F32))
    y, h = ssd_scan(xs, dt, A, bm, cm, h0.astype(F32))
    y = y + xs * d_skip.astype(F32)[:, None]
    gated = y.reshape(b, L, SSD_WIDTH) * jax.nn.silu(z.astype(F32))
    gg = gated.reshape(b, L, SSD_GROUPS, SSD_WIDTH // SSD_GROUPS)
    gg = gg * lax.rsqrt(jnp.mean(gg * gg, axis=-1, keepdims=True) + LN_EPS)
    out = (gg.reshape(b, L, SSD_WIDTH) * norm_g.astype(F32)).astype(z.dtype)
    return out, new_conv, h.astype(h0.dtype)


def band_attention(q, k, v, n):
    b, L, H, hd = q.shape
    nb = -(-L // ATT_BLOCK)
    Lp = nb * ATT_BLOCK
    if Lp > L:
        pw = lambda t: jnp.pad(t, [(0, 0), (0, Lp - L), (0, 0), (0, 0)])
        q, k, v = pw(q), pw(k), pw(v)
    qb = q.reshape(b, nb, ATT_BLOCK, H, hd)
    kb = k.reshape(b, nb, ATT_BLOCK, H, hd)
    vb = v.reshape(b, nb, ATT_BLOCK, H, hd)
    kc = jnp.concatenate([jnp.concatenate([jnp.zeros_like(kb[:, :1]), kb[:, :-1]], axis=1), kb], axis=2)
    vc = jnp.concatenate([jnp.concatenate([jnp.zeros_like(vb[:, :1]), vb[:, :-1]], axis=1), vb], axis=2)
    s = jnp.einsum('bnqhd,bnkhd->bnhqk', qb, kc).astype(F32) * (hd ** -0.5)
    qi = jnp.arange(ATT_BLOCK)[:, None] + ATT_BLOCK
    ki = jnp.arange(2 * ATT_BLOCK)[None, :]
    dist = qi - ki
    key_pos = (jnp.arange(nb) * ATT_BLOCK)[:, None, None] + ki[None] - ATT_BLOCK
    valid = (dist >= 0)[None] & (dist <= n)[None] & (key_pos >= 0)
    s = jnp.where(valid[None, :, None], s, -jnp.inf)
    lse = jax.nn.logsumexp(s, axis=-1)
    p = jnp.exp(s - lse[..., None])
    o = jnp.einsum('bnhqk,bnkhd->bnqhd', p.astype(v.dtype), vc)
    o = o.reshape(b, Lp, H, hd)[:, :L]
    lse = jnp.transpose(lse, (0, 1, 3, 2)).reshape(b, Lp, H)[:, :L]
    return o, lse


def combine_dilations(outs, lses, dtype):
    wts = jax.nn.softmax(jnp.stack(lses), axis=0)
    o = jnp.einsum('pblh,pblhd->blhd', wts, jnp.stack(outs).astype(F32))
    return o.astype(dtype)


def dilated_attention_prompt(q, k, v):
    b, L, H, hd = q.shape
    outs, lses = [], []
    for w, d in DIL_PATTERNS:
        n = w // d
        to_res = lambda t: jnp.transpose(t.reshape(b, L // d, d, H, hd), (0, 2, 1, 3, 4)).reshape(b * d, L // d, H, hd)
        o, lse = band_attention(to_res(q), to_res(k), to_res(v), n)
        o = jnp.transpose(o.reshape(b, d, L // d, H, hd), (0, 2, 1, 3, 4)).reshape(b, L, H, hd)
        lse = jnp.transpose(lse.reshape(b, d, L // d, H), (0, 2, 1, 3)).reshape(b, L, H)
        outs.append(o)
        lses.append(lse)
    return combine_dilations(outs, lses, q.dtype)


def dilated_attention_sample(q, k_all, v_all):
    b, Lq = q.shape[0], q.shape[1]
    hd = q.shape[-1]
    off = k_all.shape[1] - Lq
    outs, lses = [], []
    for w, d in DIL_PATTERNS:
        n = w // d
        idx = off + jnp.arange(Lq)[:, None] - d * jnp.arange(n + 1)[None, :]
        valid = idx >= 0
        idx = jnp.maximum(idx, 0)
        kg = k_all[:, idx]
        vg = v_all[:, idx]
        s = jnp.einsum('bqhd,bqmhd->bhqm', q, kg).astype(F32) * (hd ** -0.5)
        s = jnp.where(valid[None, None], s, -jnp.inf)
        lse = jax.nn.logsumexp(s, axis=-1)
        p = jnp.exp(s - lse[..., None])
        o = jnp.einsum('bhqm,bqmhd->bqhd', p.astype(v_all.dtype), vg)
        outs.append(o)
        lses.append(jnp.transpose(lse, (0, 2, 1)))
    return combine_dilations(outs, lses, q.dtype)


def peer_ffn(x, w_q, keys_1, keys_2, u_tab, v_tab):
    shp = x.shape
    xt = x.reshape(-1, D_MODEL)
    T = xt.shape[0]
    nblk = -(-T // PEER_BLOCK)
    xp = jnp.pad(xt, [(0, nblk * PEER_BLOCK - T), (0, 0)])
    half = PEER_DKEY // 2

    def block(xb):
        qh = jnp.einsum('td,de->te', xb, w_q).reshape(-1, PEER_HEADS, PEER_DKEY)
        s1 = jnp.einsum('thc,kc->thk', qh[..., :half], keys_1)
        s2 = jnp.einsum('thc,kc->thk', qh[..., half:], keys_2)
        v1, i1 = lax.top_k(s1, PEER_TOPK)
        v2, i2 = lax.top_k(s2, PEER_TOPK)
        cand = (v1[..., :, None] + v2[..., None, :]).reshape(-1, PEER_HEADS, PEER_TOPK * PEER_TOPK)
        sc, ci = lax.top_k(cand, PEER_TOPK)
        e = (jnp.take_along_axis(i1, ci // PEER_TOPK, axis=-1) * PEER_NKEYS
             + jnp.take_along_axis(i2, ci % PEER_TOPK, axis=-1))
        g = jax.nn.softmax(sc.astype(F32), axis=-1)
        hid = jax.nn.gelu(jnp.einsum('thkd,td->thk', u_tab[e], xb).astype(F32), approximate=False)
        return jnp.einsum('thk,thkd->td', (g * hid).astype(xb.dtype), v_tab[e])

    out = lax.map(block, xp.reshape(nblk, PEER_BLOCK, D_MODEL))
    return out.reshape(-1, D_MODEL)[:T].reshape(shp)


def finish_layer(x, y_ssd, att, w_out, ln1_g, ln1_b, peer_w_q, peer_keys_1, peer_keys_2,
                 peer_u, peer_v, ln2_g, ln2_b):
    b, L, _ = x.shape
    mix = jnp.einsum('ble,ed->bld', jnp.concatenate([y_ssd, att.reshape(b, L, ATT_WIDTH)], axis=-1), w_out)
    h = layer_norm(ALPHA * x + mix, ln1_g, ln1_b)
    return layer_norm(ALPHA * h + peer_ffn(h, peer_w_q, peer_keys_1, peer_keys_2, peer_u, peer_v), ln2_g, ln2_b)


def setup_inputs(seed: int = 0) -> dict:
    key = jax.random.key(seed)
    ks = jax.random.split(key, 24)
    buf = min(W_MAX, PAST_LEN)
    nrm = lambda k, shape, s: jax.random.normal(k, shape, F32) * s
    dt0 = jnp.exp(jax.random.uniform(ks[9], (DEPTH, SSD_HEADS), F32) * (math.log(0.1) - math.log(0.001)) + math.log(0.001))
    return {
        'x_prompt': nrm(ks[0], (BATCH, SEQ, D_MODEL), 1.0),
        'x_sample': nrm(ks[1], (DEC_BATCH, DEC_SEQ, D_MODEL), 1.0),
        'cache_attn_k': nrm(ks[2], (DEPTH, DEC_BATCH, buf, ATT_HEADS, HEAD_DIM), 1.0),
        'cache_attn_v': nrm(ks[3], (DEPTH, DEC_BATCH, buf, ATT_HEADS, HEAD_DIM), 1.0),
        'state_conv': nrm(ks[4], (DEPTH, DEC_BATCH, SSD_CONV - 1, CONV_DIM), 1.0),
        'state_ssm': nrm(ks[5], (DEPTH, DEC_BATCH, SSD_HEADS, HEAD_DIM, SSD_STATE), 0.5),
        'w_in': nrm(ks[6], (DEPTH, D_MODEL, IN_WIDTH), D_MODEL ** -0.5),
        'conv_w': nrm(ks[7], (DEPTH, SSD_CONV, CONV_DIM), SSD_CONV ** -0.5),
        'conv_b': nrm(ks[8], (DEPTH, CONV_DIM), 0.02),
        'dt_bias': dt0 + jnp.log(-jnp.expm1(-dt0)),
        'a_log': jnp.log(jax.random.uniform(ks[10], (DEPTH, SSD_HEADS), F32, 1.0, 16.0)),
        'd_skip': 1.0 + nrm(ks[11], (DEPTH, SSD_HEADS), 0.1),
        'ssd_norm_g': 1.0 + nrm(ks[12], (DEPTH, SSD_WIDTH), 0.05),
        'w_out': nrm(ks[13], (DEPTH, MIX_WIDTH, D_MODEL), BETA * MIX_WIDTH ** -0.5),
        'ln1_g': 1.0 + nrm(ks[14], (DEPTH, D_MODEL), 0.05),
        'ln1_b': nrm(ks[15], (DEPTH, D_MODEL), 0.02),
        'peer_w_q': nrm(ks[16], (DEPTH, D_MODEL, PEER_HEADS * PEER_DKEY), D_MODEL ** -0.5),
        'peer_keys_1': nrm(ks[17], (DEPTH, PEER_NKEYS, PEER_DKEY // 2), (PEER_DKEY // 2) ** -0.5),
        'peer_keys_2': nrm(ks[18], (DEPTH, PEER_NKEYS, PEER_DKEY // 2), (PEER_DKEY // 2) ** -0.5),
        'peer_u': nrm(ks[19], (DEPTH, PEER_EXPERTS, D_MODEL), D_MODEL ** -0.5),
        'peer_v': nrm(ks[20], (DEPTH, PEER_EXPERTS, D_MODEL), BETA * PEER_HEADS ** -0.5),
        'ln2_g': 1.0 + nrm(ks[21], (DEPTH, D_MODEL), 0.05),
        'ln2_b': nrm(ks[22], (DEPTH, D_MODEL), 0.02),
    }


def reference(x_prompt, x_sample, cache_attn_k, cache_attn_v, state_conv, state_ssm,
              w_in, conv_w, conv_b, dt_bias, a_log, d_skip, ssd_norm_g, w_out, ln1_g, ln1_b,
              peer_w_q, peer_keys_1, peer_keys_2, peer_u, peer_v, ln2_g, ln2_b):
    bp, Lp_len = x_prompt.shape[0], x_prompt.shape[1]
    Ls = x_sample.shape[1]
    pos_p = jnp.arange(Lp_len)
    pos_s = PAST_LEN + jnp.arange(Ls)
    buf_p = min(W_MAX, Lp_len)
    h_p, h_s = x_prompt, x_sample
    pk, pv, pc, ps, sk, sv, sc, ss = [], [], [], [], [], [], [], []
    for l in range(DEPTH):
        ssd_w = (conv_w[l], conv_b[l], dt_bias[l], a_log[l], d_skip[l], ssd_norm_g[l])
        tail_w = (w_out[l], ln1_g[l], ln1_b[l], peer_w_q[l], peer_keys_1[l], peer_keys_2[l],
                  peer_u[l], peer_v[l], ln2_g[l], ln2_b[l])
        z, xbc, dtr, q, k, v = mixer_inputs(h_p, pos_p, w_in[l])
        conv0 = jnp.zeros((bp, SSD_CONV - 1, CONV_DIM), h_p.dtype)
        ssm0 = jnp.zeros((bp, SSD_HEADS, HEAD_DIM, SSD_STATE), h_p.dtype)
        y_ssd, conv_new, ssm_new = ssd_mixer(z, xbc, dtr, conv0, ssm0, *ssd_w)
        att = dilated_attention_prompt(q, k, v)
        pk.append(k[:, -buf_p:])
        pv.append(v[:, -buf_p:])
        pc.append(conv_new)
        ps.append(ssm_new)
        h_p = finish_layer(h_p, y_ssd, att, *tail_w)
        z, xbc, dtr, q, k, v = mixer_inputs(h_s, pos_s, w_in[l])
        y_ssd, conv_new, ssm_new = ssd_mixer(z, xbc, dtr, state_conv[l], state_ssm[l], *ssd_w)
        k_all = jnp.concatenate([cache_attn_k[l].astype(k.dtype), k], axis=1)
        v_all = jnp.concatenate([cache_attn_v[l].astype(v.dtype), v], axis=1)
        att = dilated_attention_sample(q, k_all, v_all)
        buf_s = cache_attn_k.shape[2]
        sk.append(k_all[:, -buf_s:])
        sv.append(v_all[:, -buf_s:])
        sc.append(conv_new)
        ss.append(ssm_new)
        h_s = finish_layer(h_s, y_ssd, att, *tail_w)
    prompt_attn_k, prompt_attn_v = jnp.stack(pk), jnp.stack(pv)
    prompt_conv, prompt_ssm = jnp.stack(pc), jnp.stack(ps)
    sample_attn_k, sample_attn_v = jnp.stack(sk), jnp.stack(sv)
    sample_conv, sample_ssm = jnp.stack(sc), jnp.stack(ss)
    return (h_p, h_s, prompt_attn_k, prompt_attn_v, prompt_conv, prompt_ssm,
            sample_attn_k, sample_attn_v, sample_conv, sample_ssm)
```

```cpp
#include <hip/hip_runtime.h>
#include <stdint.h>

#define D_MODEL 1024
#define BATCH 2
#define SEQ 8192
#define DEC_BATCH 128
#define DEC_SEQ 4
#define PAST_LEN 8192
#define HEAD_DIM 64
#define ATT_WIDTH 512
#define ATT_HEADS 8
#define SSD_WIDTH 1536
#define SSD_HEADS 24
#define SSD_GROUPS 4
#define SSD_STATE 128
#define CONV_DIM 2560
#define IN_WIDTH 5656
#define MIX_WIDTH 2048
#define WBUF 2048
#define PEER_NKEYS 128
#define PEER_HEADS 8
#define PEER_TOPK 16
#define PEER_DKEY 256
#define T_PROMPT (BATCH * SEQ)
#define T_SAMPLE (DEC_BATCH * DEC_SEQ)
#define T_ALL (T_PROMPT + T_SAMPLE)
#define O_Z 0
#define O_XBC 1536
#define O_DT 4096
#define O_Q 4120
#define O_K 4632
#define O_V 5144
#define ALPHA_F 1.189207115002721f
#define LN_EPS 1e-5f

#define OUT_YP 0ull
#define OUT_YS (OUT_YP + 16777216ull)
#define OUT_PK (OUT_YS + 524288ull)
#define OUT_PV (OUT_PK + 2097152ull)
#define OUT_PC (OUT_PV + 2097152ull)
#define OUT_PS (OUT_PC + 15360ull)
#define OUT_SK (OUT_PS + 393216ull)
#define OUT_SV (OUT_SK + 134217728ull)
#define OUT_SC (OUT_SV + 134217728ull)
#define OUT_SS (OUT_SC + 983040ull)

__constant__ double ROPE_INV_REV[32] = {
    1.59154943091895346e-01, 1.19349370211248862e-01, 8.94994016088910133e-02, 6.71150830052272551e-02,
    5.03292121044870353e-02, 3.77415847174197711e-02, 2.83021958306233987e-02, 2.12236527647776604e-02,
    1.59154943091895339e-02, 1.19349370211248862e-02, 8.94994016088910237e-03, 6.71150830052272534e-03,
    5.03292121044870370e-03, 3.77415847174197719e-03, 2.83021958306233987e-03, 2.12236527647776622e-03,
    1.59154943091895356e-03, 1.19349370211248849e-03, 8.94994016088910237e-04, 6.71150830052272599e-04,
    5.03292121044870326e-04, 3.77415847174197741e-04, 2.83021958306233954e-04, 2.12236527647776605e-04,
    1.59154943091895351e-04, 1.19349370211248862e-04, 8.94994016088910182e-05, 6.71150830052272545e-05,
    5.03292121044870354e-05, 3.77415847174197768e-05, 2.83021958306233961e-05, 2.12236527647776592e-05
};

__device__ __forceinline__ float silu_f(float x) { return x / (1.0f + __expf(-x)); }
__device__ __forceinline__ float softplus_f(float x) { return fmaxf(x, 0.f) + log1pf(__expf(-fabsf(x))); }
__device__ __forceinline__ float gelu_f(float x) { return 0.5f * x * (1.0f + erff(x * 0.70710678118654752f)); }
__device__ __forceinline__ float wave_sum(float v) {
#pragma unroll
    for (int o = 32; o > 0; o >>= 1) v += __shfl_xor(v, o);
    return v;
}
__device__ __forceinline__ float wave_max(float v) {
#pragma unroll
    for (int o = 32; o > 0; o >>= 1) v = fmaxf(v, __shfl_xor(v, o));
    return v;
}

__global__ __launch_bounds__(256) void k_gemm_f32(const float* __restrict__ A, const float* __restrict__ B, float* __restrict__ C,
                                                  int M, int N, int K, int lda, int ldb, int ldc) {
    __shared__ float As[16][68];
    __shared__ float Bs[16][68];
    const int tid = threadIdx.x, tx = tid & 15, ty = tid >> 4;
    const int m0 = blockIdx.y * 64, n0 = blockIdx.x * 64;
    float acc[4][4];
#pragma unroll
    for (int i = 0; i < 4; ++i)
#pragma unroll
        for (int j = 0; j < 4; ++j) acc[i][j] = 0.f;
    for (int k0 = 0; k0 < K; k0 += 16) {
#pragma unroll
        for (int i = 0; i < 4; ++i) {
            int idx = tid + i * 256;
            int r = idx >> 4, c = idx & 15;
            As[c][r] = (m0 + r < M) ? A[(size_t)(m0 + r) * lda + k0 + c] : 0.f;
            int rb = idx >> 6, cb = idx & 63;
            Bs[rb][cb] = (n0 + cb < N) ? B[(size_t)(k0 + rb) * ldb + n0 + cb] : 0.f;
        }
        __syncthreads();
#pragma unroll
        for (int k = 0; k < 16; ++k) {
            float a[4], b[4];
#pragma unroll
            for (int i = 0; i < 4; ++i) { a[i] = As[k][ty * 4 + i]; b[i] = Bs[k][tx * 4 + i]; }
#pragma unroll
            for (int i = 0; i < 4; ++i)
#pragma unroll
                for (int j = 0; j < 4; ++j) acc[i][j] += a[i] * b[j];
        }
        __syncthreads();
    }
#pragma unroll
    for (int i = 0; i < 4; ++i)
#pragma unroll
        for (int j = 0; j < 4; ++j) {
            int r = m0 + ty * 4 + i, c = n0 + tx * 4 + j;
            if (r < M && c < N) C[(size_t)r * ldc + c] = acc[i][j];
        }
}

__global__ void k_concat_x(const float* __restrict__ xp, const float* __restrict__ xs, float* __restrict__ xall) {
    size_t i = (size_t)blockIdx.x * blockDim.x + threadIdx.x;
    size_t n4 = (size_t)T_ALL * D_MODEL / 4;
    if (i >= n4) return;
    size_t np4 = (size_t)T_PROMPT * D_MODEL / 4;
    float4 v = (i < np4) ? ((const float4*)xp)[i] : ((const float4*)xs)[i - np4];
    ((float4*)xall)[i] = v;
}

__global__ __launch_bounds__(256) void k_post_proj(const float* __restrict__ proj, const float* __restrict__ state_conv,
                                                   const float* __restrict__ conv_w, const float* __restrict__ conv_b,
                                                   const float* __restrict__ dt_bias,
                                                   float* __restrict__ xbc_act, float* __restrict__ dtv,
                                                   float* __restrict__ qrot, float* __restrict__ krot, float* __restrict__ out) {
    const int t = blockIdx.x, tid = threadIdx.x;
    const bool is_p = t < T_PROMPT;
    int b, i, pos;
    if (is_p) { b = t / SEQ; i = t % SEQ; pos = i; } else { int ts = t - T_PROMPT; b = ts / DEC_SEQ; i = ts % DEC_SEQ; pos = PAST_LEN + i; }
    const float* row = proj + (size_t)t * IN_WIDTH;
    for (int c = tid; c < CONV_DIM; c += 256) {
        float acc = conv_b[c];
#pragma unroll
        for (int tap = 0; tap < 4; ++tap) {
            int r = i - 3 + tap;
            float val;
            if (r >= 0) val = proj[(size_t)(t - i + r) * IN_WIDTH + O_XBC + c];
            else val = is_p ? 0.f : state_conv[((size_t)b * 3 + (3 + r)) * CONV_DIM + c];
            acc += val * conv_w[tap * CONV_DIM + c];
        }
        xbc_act[(size_t)t * CONV_DIM + c] = silu_f(acc);
    }
    if (tid < SSD_HEADS) dtv[(size_t)t * SSD_HEADS + tid] = softplus_f(row[O_DT + tid] + dt_bias[tid]);
    for (int idx = tid; idx < 512; idx += 256) {
        int which = idx >> 8, h = (idx >> 5) & 7, j = idx & 31;
        double rev = (double)pos * ROPE_INV_REV[j];
        float fr = (float)(rev - floor(rev));
        float sn = __builtin_amdgcn_sinf(fr), cs = __builtin_amdgcn_cosf(fr);
        const float* src = row + (which ? O_K : O_Q) + h * 64;
        float t1 = src[j], t2 = src[j + 32];
        float o1 = t1 * cs - t2 * sn, o2 = t2 * cs + t1 * sn;
        float* dst = (which ? krot : qrot) + (size_t)t * ATT_WIDTH + h * 64;
        dst[j] = o1; dst[j + 32] = o2;
        if (which) {
            if (is_p) { if (i >= SEQ - WBUF) { float* o = out + OUT_PK + ((size_t)b * WBUF + (i - (SEQ - WBUF))) * ATT_WIDTH + h * 64; o[j] = o1; o[j + 32] = o2; } }
            else { float* o = out + OUT_SK + ((size_t)b * WBUF + (WBUF - DEC_SEQ + i)) * ATT_WIDTH + h * 64; o[j] = o1; o[j + 32] = o2; }
        }
    }
    for (int c = tid; c < ATT_WIDTH; c += 256) {
        float v = row[O_V + c];
        if (is_p) { if (i >= SEQ - WBUF) out[OUT_PV + ((size_t)b * WBUF + (i - (SEQ - WBUF))) * ATT_WIDTH + c] = v; }
        else out[OUT_SV + ((size_t)b * WBUF + (WBUF - DEC_SEQ + i)) * ATT_WIDTH + c] = v;
    }
    if (is_p) {
        if (i >= SEQ - 3) { int r = i - (SEQ - 3); for (int c = tid; c < CONV_DIM; c += 256) out[OUT_PC + ((size_t)b * 3 + r) * CONV_DIM + c] = row[O_XBC + c]; }
    } else {
        if (i >= 1) { int r = i - 1; for (int c = tid; c < CONV_DIM; c += 256) out[OUT_SC + ((size_t)b * 3 + r) * CONV_DIM + c] = row[O_XBC + c]; }
    }
}

__global__ __launch_bounds__(256) void k_cache_copy(const float* __restrict__ ck, const float* __restrict__ cv, float* __restrict__ out) {
    const size_t per_b4 = (size_t)(WBUF - DEC_SEQ) * ATT_WIDTH / 4;
    const size_t total = per_b4 * DEC_BATCH;
    for (size_t i = (size_t)blockIdx.x * blockDim.x + threadIdx.x; i < total; i += (size_t)gridDim.x * blockDim.x) {
        size_t b = i / per_b4, r = i % per_b4;
        size_t src = (b * WBUF * ATT_WIDTH + DEC_SEQ * ATT_WIDTH) / 4 + r;
        size_t dst = (b * WBUF * ATT_WIDTH) / 4 + r;
        ((float4*)(out + OUT_SK))[dst] = ((const float4*)ck)[src];
        ((float4*)(out + OUT_SV))[dst] = ((const float4*)cv)[src];
    }
}

#define SSD_CH 32
__global__ __launch_bounds__(512) void k_ssd_naive(const float* __restrict__ xbc_act, const float* __restrict__ dtv, const float* __restrict__ a_log,
                                                   const float* __restrict__ d_skip, const float* __restrict__ state_ssm,
                                                   float* __restrict__ ybuf  , float* __restrict__ out) {
    __shared__ float sx[SSD_CH][64];
    __shared__ float sB[SSD_CH][128];
    __shared__ float sC[SSD_CH][128];
    __shared__ float sdt[SSD_CH];
    const int seq = blockIdx.x / SSD_HEADS, h = blockIdx.x % SSD_HEADS, g = h / 6;
    const int tid = threadIdx.x, p = tid >> 3, ng = tid & 7;
    const bool is_p = seq < BATCH;
    const int L = is_p ? SEQ : DEC_SEQ;
    const int t0 = is_p ? seq * SEQ : T_PROMPT + (seq - BATCH) * DEC_SEQ;
    const float A = -__expf(a_log[h]);
    const float D = d_skip[h];
    float hs[16];
    if (is_p) {
#pragma unroll
        for (int j = 0; j < 16; ++j) hs[j] = 0.f;
    } else {
        const float* s0 = state_ssm + (((size_t)(seq - BATCH) * SSD_HEADS + h) * 64 + p) * 128 + ng * 16;
#pragma unroll
        for (int j = 0; j < 16; ++j) hs[j] = s0[j];
    }
    for (int c0 = 0; c0 < L; c0 += SSD_CH) {
        const int nst = (L - c0) < SSD_CH ? (L - c0) : SSD_CH;
        __syncthreads();
        for (int idx = tid; idx < nst * 64; idx += 512) { int s = idx >> 6, c = idx & 63; sx[s][c] = xbc_act[(size_t)(t0 + c0 + s) * CONV_DIM + h * 64 + c]; }
        for (int idx = tid; idx < nst * 128; idx += 512) { int s = idx >> 7, c = idx & 127;
            sB[s][c] = xbc_act[(size_t)(t0 + c0 + s) * CONV_DIM + 1536 + g * 128 + c];
            sC[s][c] = xbc_act[(size_t)(t0 + c0 + s) * CONV_DIM + 2048 + g * 128 + c]; }
        if (tid < nst) sdt[tid] = dtv[(size_t)(t0 + c0 + tid) * SSD_HEADS + h];
        __syncthreads();
        for (int s = 0; s < nst; ++s) {
            const float dt = sdt[s], x = sx[s][p];
            const float a = __expf(dt * A), xdt = x * dt;
            float y = 0.f;
#pragma unroll
            for (int j = 0; j < 16; ++j) { hs[j] = a * hs[j] + xdt * sB[s][ng * 16 + j]; y += sC[s][ng * 16 + j] * hs[j]; }
            y += __shfl_xor(y, 1); y += __shfl_xor(y, 2); y += __shfl_xor(y, 4);
            if (ng == 0) ybuf[(size_t)(t0 + c0 + s) * MIX_WIDTH + h * 64 + p] = y + D * x;
        }
    }
    float* so = is_p ? out + OUT_PS + (((size_t)seq * SSD_HEADS + h) * 64 + p) * 128 + ng * 16
                     : out + OUT_SS + (((size_t)(seq - BATCH) * SSD_HEADS + h) * 64 + p) * 128 + ng * 16;
#pragma unroll
    for (int j = 0; j < 16; ++j) so[j] = hs[j];
}

__global__ __launch_bounds__(256) void k_gate_norm(const float* __restrict__ proj, const float* __restrict__ norm_g, float* __restrict__ ybuf) {
    const int t = blockIdx.x, g = threadIdx.x >> 6, lane = threadIdx.x & 63;
    float v[6]; float ss = 0.f;
#pragma unroll
    for (int j = 0; j < 6; ++j) {
        int c = g * 384 + j * 64 + lane;
        float y = ybuf[(size_t)t * MIX_WIDTH + c], z = proj[(size_t)t * IN_WIDTH + O_Z + c];
        v[j] = y * silu_f(z); ss += v[j] * v[j];
    }
    ss = wave_sum(ss);
    const float r = rsqrtf(ss * (1.0f / 384.0f) + LN_EPS);
#pragma unroll
    for (int j = 0; j < 6; ++j) { int c = g * 384 + j * 64 + lane; ybuf[(size_t)t * MIX_WIDTH + c] = v[j] * r * norm_g[c]; }
}

__global__ __launch_bounds__(256) void k_attn_naive(const float* __restrict__ proj, const float* __restrict__ qrot, const float* __restrict__ krot,
                                                    const float* __restrict__ ck, const float* __restrict__ cv, float* __restrict__ ybuf) {
    __shared__ float sq[4][64];
    const int w = threadIdx.x >> 6, lane = threadIdx.x & 63;
    const int item = blockIdx.x * 4 + w;
    const int t = item >> 3, h = item & 7;
    const bool is_p = t < T_PROMPT;
    int b, i;
    if (is_p) { b = t / SEQ; i = t % SEQ; } else { int ts = t - T_PROMPT; b = ts / DEC_SEQ; i = ts % DEC_SEQ; }
    sq[w][lane] = qrot[(size_t)t * ATT_WIDTH + h * 64 + lane];
    __syncthreads();
    const int qi = is_p ? i : WBUF + i;
    float sc[3][3];
    float mx = -INFINITY;
#pragma unroll
    for (int pt = 0; pt < 3; ++pt) {
        const int d = pt == 0 ? 1 : (pt == 1 ? 4 : 16);
#pragma unroll
        for (int sl = 0; sl < 3; ++sl) {
            const int m = lane + sl * 64;
            float s = -INFINITY;
            const int kj = qi - d * m;
            if (m <= 128 && kj >= 0) {
                const float* kr;
                if (is_p) kr = krot + (size_t)(b * SEQ + kj) * ATT_WIDTH + h * 64;
                else kr = (kj >= WBUF) ? krot + (size_t)(T_PROMPT + b * DEC_SEQ + (kj - WBUF)) * ATT_WIDTH + h * 64
                                       : ck + ((size_t)b * WBUF + kj) * ATT_WIDTH + h * 64;
                float a = 0.f;
#pragma unroll
                for (int c = 0; c < 64; c += 4) { float4 kv = *(const float4*)(kr + c); a += kv.x * sq[w][c] + kv.y * sq[w][c + 1] + kv.z * sq[w][c + 2] + kv.w * sq[w][c + 3]; }
                s = a * 0.125f;
            }
            sc[pt][sl] = s; mx = fmaxf(mx, s);
        }
    }
    mx = wave_max(mx);
    float lsum = 0.f;
#pragma unroll
    for (int pt = 0; pt < 3; ++pt)
#pragma unroll
        for (int sl = 0; sl < 3; ++sl) { float pv = (sc[pt][sl] == -INFINITY) ? 0.f : __expf(sc[pt][sl] - mx); sc[pt][sl] = pv; lsum += pv; }
    lsum = wave_sum(lsum);
    float o = 0.f;
#pragma unroll
    for (int pt = 0; pt < 3; ++pt) {
        const int d = pt == 0 ? 1 : (pt == 1 ? 4 : 16);
#pragma unroll
        for (int sl = 0; sl < 3; ++sl) {
            const int mend = sl < 2 ? 64 : 1;
            for (int ml = 0; ml < mend; ++ml) {
                const int m = ml + sl * 64;
                const int kj = qi - d * m;
                const float pv = __shfl(sc[pt][sl], ml);
                if (kj < 0) continue;
                const float* vr;
                if (is_p) vr = proj + (size_t)(b * SEQ + kj) * IN_WIDTH + O_V + h * 64;
                else vr = (kj >= WBUF) ? proj + (size_t)(T_PROMPT + b * DEC_SEQ + (kj - WBUF)) * IN_WIDTH + O_V + h * 64
                                       : cv + ((size_t)b * WBUF + kj) * ATT_WIDTH + h * 64;
                o += pv * vr[lane];
            }
        }
    }
    ybuf[(size_t)t * MIX_WIDTH + SSD_WIDTH + h * 64 + lane] = o / lsum;
}

__global__ __launch_bounds__(256) void k_ln_res(const float* __restrict__ res, const float* __restrict__ add, const float* __restrict__ gam,
                                                const float* __restrict__ bet, float* __restrict__ dst) {
    const int t = blockIdx.x * 4 + (threadIdx.x >> 6), lane = threadIdx.x & 63;
    float v[16]; float s = 0.f;
#pragma unroll
    for (int j = 0; j < 16; ++j) { int c = j * 64 + lane; v[j] = ALPHA_F * res[(size_t)t * D_MODEL + c] + add[(size_t)t * D_MODEL + c]; s += v[j]; }
    s = wave_sum(s);
    const float mu = s * (1.0f / 1024.0f);
    float q = 0.f;
#pragma unroll
    for (int j = 0; j < 16; ++j) { v[j] -= mu; q += v[j] * v[j]; }
    q = wave_sum(q);
    const float r = rsqrtf(q * (1.0f / 1024.0f) + LN_EPS);
#pragma unroll
    for (int j = 0; j < 16; ++j) { int c = j * 64 + lane; dst[(size_t)t * D_MODEL + c] = v[j] * r * gam[c] + bet[c]; }
}

__global__ __launch_bounds__(256) void k_peer_route(const float* __restrict__ qh, const float* __restrict__ keys1, const float* __restrict__ keys2,
                                                    int* __restrict__ eidx, float* __restrict__ gate) {
    __shared__ float sq[4][256];
    __shared__ float sv[4][2][16];
    __shared__ int si[4][2][16];
    const int w = threadIdx.x >> 6, lane = threadIdx.x & 63;
    const int item = blockIdx.x * 4 + w;
    const int t = item >> 3, h = item & 7;
    for (int c = lane; c < 256; c += 64) sq[w][c] = qh[(size_t)t * 2048 + h * 256 + c];
    __syncthreads();
#pragma unroll
    for (int half = 0; half < 2; ++half) {
        const float* keys = half ? keys2 : keys1;
        float s[2];
#pragma unroll
        for (int sl = 0; sl < 2; ++sl) {
            const float* kr = keys + (size_t)(lane + sl * 64) * 128;
            float a = 0.f;
#pragma unroll 8
            for (int c = 0; c < 128; c += 4) { float4 kv = *(const float4*)(kr + c); const float* qq = &sq[w][half * 128 + c]; a += kv.x * qq[0] + kv.y * qq[1] + kv.z * qq[2] + kv.w * qq[3]; }
            s[sl] = a;
        }
        for (int r = 0; r < 16; ++r) {
            float bv; int bi;
            if (s[0] >= s[1]) { bv = s[0]; bi = lane; } else { bv = s[1]; bi = lane + 64; }
#pragma unroll
            for (int o = 32; o > 0; o >>= 1) {
                float ov = __shfl_xor(bv, o); int oi = __shfl_xor(bi, o);
                if (ov > bv || (ov == bv && oi < bi)) { bv = ov; bi = oi; }
            }
            if (lane == 0) { sv[w][half][r] = bv; si[w][half][r] = bi; }
            if (bi == lane) s[0] = -INFINITY;
            if (bi == lane + 64) s[1] = -INFINITY;
        }
    }
    __syncthreads();
    float c[4];
#pragma unroll
    for (int j = 0; j < 4; ++j) { int ci = lane * 4 + j; c[j] = sv[w][0][ci >> 4] + sv[w][1][ci & 15]; }
    float myv = 0.f; int myc = 0;
    for (int r = 0; r < 16; ++r) {
        float bv = c[0]; int bi = lane * 4;
#pragma unroll
        for (int j = 1; j < 4; ++j) if (c[j] > bv) { bv = c[j]; bi = lane * 4 + j; }
#pragma unroll
        for (int o = 32; o > 0; o >>= 1) {
            float ov = __shfl_xor(bv, o); int oi = __shfl_xor(bi, o);
            if (ov > bv || (ov == bv && oi < bi)) { bv = ov; bi = oi; }
        }
        if (lane == r) { myv = bv; myc = bi; }
#pragma unroll
        for (int j = 0; j < 4; ++j) if (bi == lane * 4 + j) c[j] = -INFINITY;
    }
    float v = lane < 16 ? myv : -INFINITY;
    float mx = wave_max(v);
    float e = lane < 16 ? __expf(v - mx) : 0.f;
    float sum = wave_sum(e);
    if (lane < 16) {
        int ex = si[w][0][myc >> 4] * PEER_NKEYS + si[w][1][myc & 15];
        eidx[(size_t)t * 128 + h * 16 + lane] = ex;
        gate[(size_t)t * 128 + h * 16 + lane] = e / sum;
    }
}

__global__ __launch_bounds__(256) void k_peer_ffn(const float* __restrict__ hbuf, const int* __restrict__ eidx, const float* __restrict__ gate,
                                                  const float* __restrict__ ut, const float* __restrict__ vt, const float* __restrict__ gam,
                                                  const float* __restrict__ bet, float* __restrict__ out) {
    const int t = blockIdx.x * 4 + (threadIdx.x >> 6), lane = threadIdx.x & 63;
    float4 x[4], acc[4];
#pragma unroll
    for (int j = 0; j < 4; ++j) { x[j] = *(const float4*)(hbuf + (size_t)t * D_MODEL + j * 256 + lane * 4); acc[j] = make_float4(0.f, 0.f, 0.f, 0.f); }
    for (int k = 0; k < 128; ++k) {
        const int e = eidx[(size_t)t * 128 + k];
        const float g = gate[(size_t)t * 128 + k];
        const float* ur = ut + (size_t)e * D_MODEL;
        float d = 0.f;
#pragma unroll
        for (int j = 0; j < 4; ++j) { float4 u4 = *(const float4*)(ur + j * 256 + lane * 4); d += u4.x * x[j].x + u4.y * x[j].y + u4.z * x[j].z + u4.w * x[j].w; }
        d = wave_sum(d);
        const float wgt = g * gelu_f(d);
        const float* vr = vt + (size_t)e * D_MODEL;
#pragma unroll
        for (int j = 0; j < 4; ++j) { float4 v4 = *(const float4*)(vr + j * 256 + lane * 4); acc[j].x += wgt * v4.x; acc[j].y += wgt * v4.y; acc[j].z += wgt * v4.z; acc[j].w += wgt * v4.w; }
    }
    float s = 0.f;
#pragma unroll
    for (int j = 0; j < 4; ++j) { acc[j].x += ALPHA_F * x[j].x; acc[j].y += ALPHA_F * x[j].y; acc[j].z += ALPHA_F * x[j].z; acc[j].w += ALPHA_F * x[j].w; s += acc[j].x + acc[j].y + acc[j].z + acc[j].w; }
    s = wave_sum(s);
    const float mu = s * (1.0f / 1024.0f);
    float q = 0.f;
#pragma unroll
    for (int j = 0; j < 4; ++j) { acc[j].x -= mu; acc[j].y -= mu; acc[j].z -= mu; acc[j].w -= mu; q += acc[j].x * acc[j].x + acc[j].y * acc[j].y + acc[j].z * acc[j].z + acc[j].w * acc[j].w; }
    q = wave_sum(q);
    const float r = rsqrtf(q * (1.0f / 1024.0f) + LN_EPS);
    float* dst = (t < T_PROMPT) ? out + OUT_YP + (size_t)t * D_MODEL : out + OUT_YS + (size_t)(t - T_PROMPT) * D_MODEL;
#pragma unroll
    for (int j = 0; j < 4; ++j) {
        float4 g4 = *(const float4*)(gam + j * 256 + lane * 4), b4 = *(const float4*)(bet + j * 256 + lane * 4);
        float4 o; o.x = acc[j].x * r * g4.x + b4.x; o.y = acc[j].y * r * g4.y + b4.y; o.z = acc[j].z * r * g4.z + b4.z; o.w = acc[j].w * r * g4.w + b4.w;
        *(float4*)(dst + j * 256 + lane * 4) = o;
    }
}

extern "C" void kernel_launch(void* const* d_in, const int* in_sizes, int n_in, void* d_out, int out_size, void* d_ws, size_t ws_size, hipStream_t stream) {
    const float* x_prompt = (const float*)d_in[0];
    const float* x_sample = (const float*)d_in[1];
    const float* cache_k = (const float*)d_in[2];
    const float* cache_v = (const float*)d_in[3];
    const float* state_conv = (const float*)d_in[4];
    const float* state_ssm = (const float*)d_in[5];
    const float* w_in = (const float*)d_in[6];
    const float* conv_w = (const float*)d_in[7];
    const float* conv_b = (const float*)d_in[8];
    const float* dt_bias = (const float*)d_in[9];
    const float* a_log = (const float*)d_in[10];
    const float* d_skip = (const float*)d_in[11];
    const float* norm_g = (const float*)d_in[12];
    const float* w_out = (const float*)d_in[13];
    const float* ln1_g = (const float*)d_in[14];
    const float* ln1_b = (const float*)d_in[15];
    const float* peer_wq = (const float*)d_in[16];
    const float* keys1 = (const float*)d_in[17];
    const float* keys2 = (const float*)d_in[18];
    const float* peer_u = (const float*)d_in[19];
    const float* peer_v = (const float*)d_in[20];
    const float* ln2_g = (const float*)d_in[21];
    const float* ln2_b = (const float*)d_in[22];
    float* out = (float*)d_out;

    char* ws = (char*)d_ws;
    size_t off = 0;
    auto take = [&](size_t bytes) { char* p = ws + off; off += (bytes + 255) & ~(size_t)255; return p; };
    float* xall = (float*)take((size_t)T_ALL * D_MODEL * 4);
    float* proj = (float*)take((size_t)T_ALL * IN_WIDTH * 4);
    float* xbc_act = (float*)take((size_t)T_ALL * CONV_DIM * 4);
    float* dtv = (float*)take((size_t)T_ALL * SSD_HEADS * 4);
    float* qrot = (float*)take((size_t)T_ALL * ATT_WIDTH * 4);
    float* krot = (float*)take((size_t)T_ALL * ATT_WIDTH * 4);
    float* ybuf = (float*)take((size_t)T_ALL * MIX_WIDTH * 4);
    float* mix = (float*)take((size_t)T_ALL * D_MODEL * 4);
    float* hbuf = (float*)take((size_t)T_ALL * D_MODEL * 4);
    float* qh = (float*)take((size_t)T_ALL * 2048 * 4);
    int* eidx = (int*)take((size_t)T_ALL * 128 * 4);
    float* gate = (float*)take((size_t)T_ALL * 128 * 4);

    k_concat_x<<<(T_ALL * D_MODEL / 4 + 255) / 256, 256, 0, stream>>>(x_prompt, x_sample, xall);
    k_cache_copy<<<2048, 256, 0, stream>>>(cache_k, cache_v, out);
    k_gemm_f32<<<dim3((IN_WIDTH + 63) / 64, T_ALL / 64), 256, 0, stream>>>(xall, w_in, proj, T_ALL, IN_WIDTH, D_MODEL, D_MODEL, IN_WIDTH, IN_WIDTH);
    k_post_proj<<<T_ALL, 256, 0, stream>>>(proj, state_conv, conv_w, conv_b, dt_bias, xbc_act, dtv, qrot, krot, out);
    k_ssd_naive<<<(BATCH + DEC_BATCH) * SSD_HEADS, 512, 0, stream>>>(xbc_act, dtv, a_log, d_skip, state_ssm, ybuf, out);
    k_gate_norm<<<T_ALL, 256, 0, stream>>>(proj, norm_g, ybuf);
    k_attn_naive<<<T_ALL * 8 / 4, 256, 0, stream>>>(proj, qrot, krot, cache_k, cache_v, ybuf);
    k_gemm_f32<<<dim3(D_MODEL / 64, T_ALL / 64), 256, 0, stream>>>(ybuf, w_out, mix, T_ALL, D_MODEL, MIX_WIDTH, MIX_WIDTH, D_MODEL, D_MODEL);
    k_ln_res<<<T_ALL / 4, 256, 0, stream>>>(xall, mix, ln1_g, ln1_b, hbuf);
    k_gemm_f32<<<dim3(2048 / 64, T_ALL / 64), 256, 0, stream>>>(hbuf, peer_wq, qh, T_ALL, 2048, D_MODEL, D_MODEL, 2048, 2048);
    k_peer_route<<<T_ALL * 8 / 4, 256, 0, stream>>>(qh, keys1, keys2, eidx, gate);
    k_peer_ffn<<<T_ALL / 4, 256, 0, stream>>>(hbuf, eidx, gate, peer_u, peer_v, ln2_g, ln2_b, out);
}
```

```cpp
#include <hip/hip_runtime.h>
#include <stdint.h>

#define D_MODEL 1024
#define BATCH 2
#define SEQ 8192
#define DEC_BATCH 128
#define DEC_SEQ 4
#define PAST_LEN 8192
#define HEAD_DIM 64
#define ATT_WIDTH 512
#define ATT_HEADS 8
#define SSD_WIDTH 1536
#define SSD_HEADS 24
#define SSD_GROUPS 4
#define SSD_STATE 128
#define CONV_DIM 2560
#define IN_WIDTH 5656
#define MIX_WIDTH 2048
#define WBUF 2048
#define PEER_NKEYS 128
#define PEER_HEADS 8
#define PEER_TOPK 16
#define PEER_DKEY 256
#define T_PROMPT (BATCH * SEQ)
#define T_SAMPLE (DEC_BATCH * DEC_SEQ)
#define T_ALL (T_PROMPT + T_SAMPLE)
#define O_Z 0
#define O_XBC 1536
#define O_DT 4096
#define O_Q 4120
#define O_K 4632
#define O_V 5144
#define ALPHA_F 1.189207115002721f
#define LN_EPS 1e-5f

#define OUT_YP 0ull
#define OUT_YS (OUT_YP + 16777216ull)
#define OUT_PK (OUT_YS + 524288ull)
#define OUT_PV (OUT_PK + 2097152ull)
#define OUT_PC (OUT_PV + 2097152ull)
#define OUT_PS (OUT_PC + 15360ull)
#define OUT_SK (OUT_PS + 393216ull)
#define OUT_SV (OUT_SK + 134217728ull)
#define OUT_SC (OUT_SV + 134217728ull)
#define OUT_SS (OUT_SC + 983040ull)

__constant__ double ROPE_INV_REV[32] = {
    1.59154943091895346e-01, 1.19349370211248862e-01, 8.94994016088910133e-02, 6.71150830052272551e-02,
    5.03292121044870353e-02, 3.77415847174197711e-02, 2.83021958306233987e-02, 2.12236527647776604e-02,
    1.59154943091895339e-02, 1.19349370211248862e-02, 8.94994016088910237e-03, 6.71150830052272534e-03,
    5.03292121044870370e-03, 3.77415847174197719e-03, 2.83021958306233987e-03, 2.12236527647776622e-03,
    1.59154943091895356e-03, 1.19349370211248849e-03, 8.94994016088910237e-04, 6.71150830052272599e-04,
    5.03292121044870326e-04, 3.77415847174197741e-04, 2.83021958306233954e-04, 2.12236527647776605e-04,
    1.59154943091895351e-04, 1.19349370211248862e-04, 8.94994016088910182e-05, 6.71150830052272545e-05,
    5.03292121044870354e-05, 3.77415847174197768e-05, 2.83021958306233961e-05, 2.12236527647776592e-05
};

__device__ __forceinline__ float silu_f(float x) { return x / (1.0f + __expf(-x)); }
__device__ __forceinline__ float softplus_f(float x) { return fmaxf(x, 0.f) + log1pf(__expf(-fabsf(x))); }
__device__ __forceinline__ float gelu_f(float x) { return 0.5f * x * (1.0f + erff(x * 0.70710678118654752f)); }
__device__ __forceinline__ float wave_sum(float v) {
#pragma unroll
    for (int o = 32; o > 0; o >>= 1) v += __shfl_xor(v, o);
    return v;
}
__device__ __forceinline__ float wave_max(float v) {
#pragma unroll
    for (int o = 32; o > 0; o >>= 1) v = fmaxf(v, __shfl_xor(v, o));
    return v;
}

#include <cstdio>
#define XB_TMO      128
#define XB_XCNT(j)  (256  + 64 * (j))
#define XB_XSUB(j)  (1280 + 64 * (j))
#define XB_XGEN(j)  (2304 + 64 * (j))
#define XB_TOP      3328
#define XB_TOPGEN   3392
#define XCD_BAR_WORDS 3456
#define XB_SPIN_CAP (1u << 18)
#define LAS __attribute__((address_space(3)))

__device__ __forceinline__ unsigned xb_ld(unsigned* p)              { return __hip_atomic_load(p, __ATOMIC_RELAXED, __HIP_MEMORY_SCOPE_AGENT); }
__device__ __forceinline__ unsigned xb_add(unsigned* p, unsigned v) { return __hip_atomic_fetch_add(p, v, __ATOMIC_RELAXED, __HIP_MEMORY_SCOPE_AGENT); }
__device__ __forceinline__ unsigned xb_xcc_id() { return (unsigned)__builtin_amdgcn_s_getreg((3 << 11) | 20) & 0xFu; }
#define XB_SPIN(cond, bar) do { unsigned _sp = 0; while (cond) { __builtin_amdgcn_s_sleep(1); \
    if ((++_sp & 255u) == 0u) { if (xb_ld(&(bar)[XB_TMO])) break; if (_sp > XB_SPIN_CAP) { atomicAdd(&(bar)[XB_TMO], 1u); break; } } } } while (0)

struct XcdBarrier {
    unsigned* bar; unsigned x;
    volatile LAS unsigned* st;
};

__device__ __forceinline__ XcdBarrier xcd_barrier_post(unsigned* bar, volatile LAS unsigned* st) {
    XcdBarrier b; b.bar = bar; b.x = xb_xcc_id(); b.st = st;
    if (threadIdx.x == 0) (void)xb_add(&bar[XB_XCNT(b.x)], 1u);
    return b;
}
__device__ __forceinline__ void xcd_barrier_complete(unsigned* bar, unsigned x, unsigned& nloc, unsigned& nx) {
    const unsigned G = gridDim.x * gridDim.y * gridDim.z;
    unsigned sum, cnt, mine, sp = 0u;
    for (;;) {
        sum = 0u; cnt = 0u; mine = 0u;
#pragma unroll
        for (unsigned j = 0; j < 16; ++j) { const unsigned c = xb_ld(&bar[XB_XCNT(j)]); sum += c; cnt += (c > 0u) ? 1u : 0u; mine = (j == x) ? c : mine; }
        if (sum == G) break;
        __builtin_amdgcn_s_sleep(1);
        if ((++sp & 255u) == 0u) { if (xb_ld(&bar[XB_TMO])) break; if (sp > XB_SPIN_CAP) { atomicAdd(&bar[XB_TMO], 1u); break; } }
    }
    nloc = mine > 0u ? mine : 1u; nx = cnt > 0u ? cnt : 1u;
}

__device__ __forceinline__ void xcd_barrier(const XcdBarrier& b) {
    asm volatile("s_waitcnt vmcnt(0)" ::: "memory");
    __syncthreads();
    if (threadIdx.x == 0) {
        unsigned* bar = b.bar;
        __builtin_amdgcn_s_waitcnt(0);
        unsigned nloc = b.st[0], nx = b.st[1];
        if (nloc == 0u) { xcd_barrier_complete(bar, b.x, nloc, nx); b.st[0] = nloc; b.st[1] = nx; }
        const unsigned old = xb_add(&bar[XB_XSUB(b.x)], 1u);
        const unsigned gen = old / nloc;
        if (old + 1u == (gen + 1u) * nloc) {
            __builtin_amdgcn_fence(__ATOMIC_RELEASE, "agent");
            asm volatile("s_waitcnt vmcnt(0)" ::: "memory");
            const unsigned og = xb_add(&bar[XB_TOP], 1u);
            const unsigned tg = og / nx;
            if (og + 1u == (tg + 1u) * nx) xb_add(&bar[XB_TOPGEN], 1u);
            else XB_SPIN(xb_ld(&bar[XB_TOPGEN]) == tg, bar);
            __builtin_amdgcn_fence(__ATOMIC_ACQUIRE, "agent");
            xb_add(&bar[XB_XGEN(b.x)], 1u);
            asm volatile("s_waitcnt vmcnt(0)" ::: "memory");
        } else {
            XB_SPIN(xb_ld(&bar[XB_XGEN(b.x)]) == gen, bar);
            __builtin_amdgcn_fence(__ATOMIC_ACQUIRE, "agent");
            asm volatile("s_waitcnt vmcnt(0)" ::: "memory");
        }
    }
    __syncthreads();
}


#define NTHR 512
#define NWAVE 8

__device__ __forceinline__ void ph_gemm_f32(float* lds, const float* __restrict__ A, const float* __restrict__ B, float* __restrict__ C,
                                            int M, int N, int K, int lda, int ldb, int ldc) {
    const int tid = threadIdx.x & 255, half = threadIdx.x >> 8, tx = tid & 15, ty = tid >> 4;
    float (*As)[68] = (float (*)[68])(lds + half * 2 * 16 * 68);
    float (*Bs)[68] = (float (*)[68])(lds + half * 2 * 16 * 68 + 16 * 68);
    const int ntx = (N + 63) / 64, nty = M / 64, ntiles = ntx * nty;
    for (int it = blockIdx.x; 2 * it < ntiles; it += gridDim.x) {
        const int tile = 2 * it + half;
        const int m0 = (tile / ntx) * 64, n0 = (tile % ntx) * 64;
        float acc[4][4];
#pragma unroll
        for (int i = 0; i < 4; ++i)
#pragma unroll
            for (int j = 0; j < 4; ++j) acc[i][j] = 0.f;
        for (int k0 = 0; k0 < K; k0 += 16) {
#pragma unroll
            for (int i = 0; i < 4; ++i) {
                int idx = tid + i * 256;
                int r = idx >> 4, c = idx & 15;
                As[c][r] = (m0 + r < M) ? A[(size_t)(m0 + r) * lda + k0 + c] : 0.f;
                int rb = idx >> 6, cb = idx & 63;
                Bs[rb][cb] = (n0 + cb < N) ? B[(size_t)(k0 + rb) * ldb + n0 + cb] : 0.f;
            }
            __syncthreads();
#pragma unroll
            for (int k = 0; k < 16; ++k) {
                float a[4], b[4];
#pragma unroll
                for (int i = 0; i < 4; ++i) { a[i] = As[k][ty * 4 + i]; b[i] = Bs[k][tx * 4 + i]; }
#pragma unroll
                for (int i = 0; i < 4; ++i)
#pragma unroll
                    for (int j = 0; j < 4; ++j) acc[i][j] += a[i] * b[j];
            }
            __syncthreads();
        }
#pragma unroll
        for (int i = 0; i < 4; ++i)
#pragma unroll
            for (int j = 0; j < 4; ++j) {
                int r = m0 + ty * 4 + i, c = n0 + tx * 4 + j;
                if (r < M && c < N) C[(size_t)r * ldc + c] = acc[i][j];
            }
    }
}

__device__ __forceinline__ void ph_concat_x(const float* __restrict__ xp, const float* __restrict__ xs, float* __restrict__ xall) {
    const size_t n4 = (size_t)T_ALL * D_MODEL / 4, np4 = (size_t)T_PROMPT * D_MODEL / 4;
    for (size_t i = (size_t)blockIdx.x * NTHR + threadIdx.x; i < n4; i += (size_t)gridDim.x * NTHR) {
        float4 v = (i < np4) ? ((const float4*)xp)[i] : ((const float4*)xs)[i - np4];
        ((float4*)xall)[i] = v;
    }
}

__device__ __forceinline__ void ph_cache_copy(const float* __restrict__ ck, const float* __restrict__ cv, float* __restrict__ out) {
    const size_t per_b4 = (size_t)(WBUF - DEC_SEQ) * ATT_WIDTH / 4;
    const size_t total = per_b4 * DEC_BATCH;
    for (size_t i = (size_t)blockIdx.x * NTHR + threadIdx.x; i < total; i += (size_t)gridDim.x * NTHR) {
        size_t b = i / per_b4, r = i % per_b4;
        size_t src = (b * WBUF * ATT_WIDTH + DEC_SEQ * ATT_WIDTH) / 4 + r;
        size_t dst = (b * WBUF * ATT_WIDTH) / 4 + r;
        ((float4*)(out + OUT_SK))[dst] = ((const float4*)ck)[src];
        ((float4*)(out + OUT_SV))[dst] = ((const float4*)cv)[src];
    }
}

__device__ __forceinline__ void ph_post_proj(const float* __restrict__ proj, const float* __restrict__ state_conv,
                                             const float* __restrict__ conv_w, const float* __restrict__ conv_b, const float* __restrict__ dt_bias,
                                             float* __restrict__ xbc_act, float* __restrict__ dtv, float* __restrict__ qrot, float* __restrict__ krot,
                                             float* __restrict__ out) {
    const int tid = threadIdx.x & 255, half = threadIdx.x >> 8;
    for (int t = 2 * blockIdx.x + half; t < T_ALL; t += 2 * gridDim.x) {
        const bool is_p = t < T_PROMPT;
        int b, i, pos;
        if (is_p) { b = t / SEQ; i = t % SEQ; pos = i; } else { int ts = t - T_PROMPT; b = ts / DEC_SEQ; i = ts % DEC_SEQ; pos = PAST_LEN + i; }
        const float* row = proj + (size_t)t * IN_WIDTH;
        for (int c = tid; c < CONV_DIM; c += 256) {
            float acc = conv_b[c];
#pragma unroll
            for (int tap = 0; tap < 4; ++tap) {
                int r = i - 3 + tap;
                float val;
                if (r >= 0) val = proj[(size_t)(t - i + r) * IN_WIDTH + O_XBC + c];
                else val = is_p ? 0.f : state_conv[((size_t)b * 3 + (3 + r)) * CONV_DIM + c];
                acc += val * conv_w[tap * CONV_DIM + c];
            }
            xbc_act[(size_t)t * CONV_DIM + c] = silu_f(acc);
        }
        if (tid < SSD_HEADS) dtv[(size_t)t * SSD_HEADS + tid] = softplus_f(row[O_DT + tid] + dt_bias[tid]);
        for (int idx = tid; idx < 512; idx += 256) {
            int which = idx >> 8, h = (idx >> 5) & 7, j = idx & 31;
            double rev = (double)pos * ROPE_INV_REV[j];
            float fr = (float)(rev - floor(rev));
            float sn = __builtin_amdgcn_sinf(fr), cs = __builtin_amdgcn_cosf(fr);
            const float* src = row + (which ? O_K : O_Q) + h * 64;
            float t1 = src[j], t2 = src[j + 32];
            float o1 = t1 * cs - t2 * sn, o2 = t2 * cs + t1 * sn;
            float* dst = (which ? krot : qrot) + (size_t)t * ATT_WIDTH + h * 64;
            dst[j] = o1; dst[j + 32] = o2;
            if (which) {
                if (is_p) { if (i >= SEQ - WBUF) { float* o = out + OUT_PK + ((size_t)b * WBUF + (i - (SEQ - WBUF))) * ATT_WIDTH + h * 64; o[j] = o1; o[j + 32] = o2; } }
                else { float* o = out + OUT_SK + ((size_t)b * WBUF + (WBUF - DEC_SEQ + i)) * ATT_WIDTH + h * 64; o[j] = o1; o[j + 32] = o2; }
            }
        }
        for (int c = tid; c < ATT_WIDTH; c += 256) {
            float v = row[O_V + c];
            if (is_p) { if (i >= SEQ - WBUF) out[OUT_PV + ((size_t)b * WBUF + (i - (SEQ - WBUF))) * ATT_WIDTH + c] = v; }
            else out[OUT_SV + ((size_t)b * WBUF + (WBUF - DEC_SEQ + i)) * ATT_WIDTH + c] = v;
        }
        if (is_p) {
            if (i >= SEQ - 3) { int r = i - (SEQ - 3); for (int c = tid; c < CONV_DIM; c += 256) out[OUT_PC + ((size_t)b * 3 + r) * CONV_DIM + c] = row[O_XBC + c]; }
        } else {
            if (i >= 1) { int r = i - 1; for (int c = tid; c < CONV_DIM; c += 256) out[OUT_SC + ((size_t)b * 3 + r) * CONV_DIM + c] = row[O_XBC + c]; }
        }
    }
}

#define SSD_CH 32
__device__ __forceinline__ void ph_ssd_naive(float* lds, const float* __restrict__ xbc_act, const float* __restrict__ dtv, const float* __restrict__ a_log,
                                             const float* __restrict__ d_skip, const float* __restrict__ state_ssm, float* __restrict__ ybuf, float* __restrict__ out) {
    float (*sx)[64] = (float (*)[64])lds;
    float (*sB)[128] = (float (*)[128])(lds + SSD_CH * 64);
    float (*sC)[128] = (float (*)[128])(lds + SSD_CH * 64 + SSD_CH * 128);
    float* sdt = lds + SSD_CH * 64 + 2 * SSD_CH * 128;
    const int tid = threadIdx.x, p = tid >> 3, ng = tid & 7;
    for (int vb = blockIdx.x; vb < (BATCH + DEC_BATCH) * SSD_HEADS; vb += gridDim.x) {
        const int seq = vb / SSD_HEADS, h = vb % SSD_HEADS, g = h / 6;
        const bool is_p = seq < BATCH;
        const int L = is_p ? SEQ : DEC_SEQ;
        const int t0 = is_p ? seq * SEQ : T_PROMPT + (seq - BATCH) * DEC_SEQ;
        const float A = -__expf(a_log[h]);
        const float D = d_skip[h];
        float hs[16];
        if (is_p) {
#pragma unroll
            for (int j = 0; j < 16; ++j) hs[j] = 0.f;
        } else {
            const float* s0 = state_ssm + (((size_t)(seq - BATCH) * SSD_HEADS + h) * 64 + p) * 128 + ng * 16;
#pragma unroll
            for (int j = 0; j < 16; ++j) hs[j] = s0[j];
        }
        for (int c0 = 0; c0 < L; c0 += SSD_CH) {
            const int nst = (L - c0) < SSD_CH ? (L - c0) : SSD_CH;
            __syncthreads();
            for (int idx = tid; idx < nst * 64; idx += NTHR) { int s = idx >> 6, c = idx & 63; sx[s][c] = xbc_act[(size_t)(t0 + c0 + s) * CONV_DIM + h * 64 + c]; }
            for (int idx = tid; idx < nst * 128; idx += NTHR) { int s = idx >> 7, c = idx & 127;
                sB[s][c] = xbc_act[(size_t)(t0 + c0 + s) * CONV_DIM + 1536 + g * 128 + c];
                sC[s][c] = xbc_act[(size_t)(t0 + c0 + s) * CONV_DIM + 2048 + g * 128 + c]; }
            if (tid < nst) sdt[tid] = dtv[(size_t)(t0 + c0 + tid) * SSD_HEADS + h];
            __syncthreads();
            for (int s = 0; s < nst; ++s) {
                const float dt = sdt[s], x = sx[s][p];
                const float a = __expf(dt * A), xdt = x * dt;
                float y = 0.f;
#pragma unroll
                for (int j = 0; j < 16; ++j) { hs[j] = a * hs[j] + xdt * sB[s][ng * 16 + j]; y += sC[s][ng * 16 + j] * hs[j]; }
                y += __shfl_xor(y, 1); y += __shfl_xor(y, 2); y += __shfl_xor(y, 4);
                if (ng == 0) ybuf[(size_t)(t0 + c0 + s) * MIX_WIDTH + h * 64 + p] = y + D * x;
            }
        }
        float* so = is_p ? out + OUT_PS + (((size_t)seq * SSD_HEADS + h) * 64 + p) * 128 + ng * 16
                         : out + OUT_SS + (((size_t)(seq - BATCH) * SSD_HEADS + h) * 64 + p) * 128 + ng * 16;
#pragma unroll
        for (int j = 0; j < 16; ++j) so[j] = hs[j];
    }
}

__device__ __forceinline__ void ph_gate_norm(const float* __restrict__ proj, const float* __restrict__ norm_g, float* __restrict__ ybuf) {
    const int w = threadIdx.x >> 6, lane = threadIdx.x & 63, g = w & 3;
    for (int t = 2 * blockIdx.x + (w >> 2); t < T_ALL; t += 2 * gridDim.x) {
        float v[6]; float ss = 0.f;
#pragma unroll
        for (int j = 0; j < 6; ++j) {
            int c = g * 384 + j * 64 + lane;
            float y = ybuf[(size_t)t * MIX_WIDTH + c], z = proj[(size_t)t * IN_WIDTH + O_Z + c];
            v[j] = y * silu_f(z); ss += v[j] * v[j];
        }
        ss = wave_sum(ss);
        const float r = rsqrtf(ss * (1.0f / 384.0f) + LN_EPS);
#pragma unroll
        for (int j = 0; j < 6; ++j) { int c = g * 384 + j * 64 + lane; ybuf[(size_t)t * MIX_WIDTH + c] = v[j] * r * norm_g[c]; }
    }
}

__device__ __forceinline__ void ph_attn_naive(float* lds, const float* __restrict__ proj, const float* __restrict__ qrot, const float* __restrict__ krot,
                                              const float* __restrict__ ck, const float* __restrict__ cv, float* __restrict__ ybuf) {
    float (*sq)[64] = (float (*)[64])lds;
    const int w = threadIdx.x >> 6, lane = threadIdx.x & 63;
    for (int vb = blockIdx.x; vb < T_ALL * 8 / NWAVE; vb += gridDim.x) {
        const int item = vb * NWAVE + w;
        const int t = item >> 3, h = item & 7;
        const bool is_p = t < T_PROMPT;
        int b, i;
        if (is_p) { b = t / SEQ; i = t % SEQ; } else { int ts = t - T_PROMPT; b = ts / DEC_SEQ; i = ts % DEC_SEQ; }
        __syncthreads();
        sq[w][lane] = qrot[(size_t)t * ATT_WIDTH + h * 64 + lane];
        __syncthreads();
        const int qi = is_p ? i : WBUF + i;
        float sc[3][3];
        float mx = -INFINITY;
#pragma unroll
        for (int pt = 0; pt < 3; ++pt) {
            const int d = pt == 0 ? 1 : (pt == 1 ? 4 : 16);
#pragma unroll
            for (int sl = 0; sl < 3; ++sl) {
                const int m = lane + sl * 64;
                float s = -INFINITY;
                const int kj = qi - d * m;
                if (m <= 128 && kj >= 0) {
                    const float* kr;
                    if (is_p) kr = krot + (size_t)(b * SEQ + kj) * ATT_WIDTH + h * 64;
                    else kr = (kj >= WBUF) ? krot + (size_t)(T_PROMPT + b * DEC_SEQ + (kj - WBUF)) * ATT_WIDTH + h * 64
                                           : ck + ((size_t)b * WBUF + kj) * ATT_WIDTH + h * 64;
                    float a = 0.f;
#pragma unroll
                    for (int c = 0; c < 64; c += 4) { float4 kv = *(const float4*)(kr + c); a += kv.x * sq[w][c] + kv.y * sq[w][c + 1] + kv.z * sq[w][c + 2] + kv.w * sq[w][c + 3]; }
                    s = a * 0.125f;
                }
                sc[pt][sl] = s; mx = fmaxf(mx, s);
            }
        }
        mx = wave_max(mx);
        float lsum = 0.f;
#pragma unroll
        for (int pt = 0; pt < 3; ++pt)
#pragma unroll
            for (int sl = 0; sl < 3; ++sl) { float pv = (sc[pt][sl] == -INFINITY) ? 0.f : __expf(sc[pt][sl] - mx); sc[pt][sl] = pv; lsum += pv; }
        lsum = wave_sum(lsum);
        float o = 0.f;
#pragma unroll
        for (int pt = 0; pt < 3; ++pt) {
            const int d = pt == 0 ? 1 : (pt == 1 ? 4 : 16);
#pragma unroll
            for (int sl = 0; sl < 3; ++sl) {
                const int mend = sl < 2 ? 64 : 1;
                for (int ml = 0; ml < mend; ++ml) {
                    const int m = ml + sl * 64;
                    const int kj = qi - d * m;
                    const float pv = __shfl(sc[pt][sl], ml);
                    if (kj < 0) continue;
                    const float* vr;
                    if (is_p) vr = proj + (size_t)(b * SEQ + kj) * IN_WIDTH + O_V + h * 64;
                    else vr = (kj >= WBUF) ? proj + (size_t)(T_PROMPT + b * DEC_SEQ + (kj - WBUF)) * IN_WIDTH + O_V + h * 64
                                           : cv + ((size_t)b * WBUF + kj) * ATT_WIDTH + h * 64;
                    o += pv * vr[lane];
                }
            }
        }
        ybuf[(size_t)t * MIX_WIDTH + SSD_WIDTH + h * 64 + lane] = o / lsum;
    }
}

__device__ __forceinline__ void ph_ln_res(const float* __restrict__ res, const float* __restrict__ add, const float* __restrict__ gam,
                                          const float* __restrict__ bet, float* __restrict__ dst) {
    const int lane = threadIdx.x & 63;
    for (int t = blockIdx.x * NWAVE + (threadIdx.x >> 6); t < T_ALL; t += gridDim.x * NWAVE) {
        float v[16]; float s = 0.f;
#pragma unroll
        for (int j = 0; j < 16; ++j) { int c = j * 64 + lane; v[j] = ALPHA_F * res[(size_t)t * D_MODEL + c] + add[(size_t)t * D_MODEL + c]; s += v[j]; }
        s = wave_sum(s);
        const float mu = s * (1.0f / 1024.0f);
        float q = 0.f;
#pragma unroll
        for (int j = 0; j < 16; ++j) { v[j] -= mu; q += v[j] * v[j]; }
        q = wave_sum(q);
        const float r = rsqrtf(q * (1.0f / 1024.0f) + LN_EPS);
#pragma unroll
        for (int j = 0; j < 16; ++j) { int c = j * 64 + lane; dst[(size_t)t * D_MODEL + c] = v[j] * r * gam[c] + bet[c]; }
    }
}

__device__ __forceinline__ void ph_peer_route(float* lds, const float* __restrict__ qh, const float* __restrict__ keys1, const float* __restrict__ keys2,
                                              int* __restrict__ eidx, float* __restrict__ gate) {
    float (*sq)[256] = (float (*)[256])lds;
    float (*sv)[2][16] = (float (*)[2][16])(lds + NWAVE * 256);
    int (*si)[2][16] = (int (*)[2][16])(lds + NWAVE * 256 + NWAVE * 32);
    const int w = threadIdx.x >> 6, lane = threadIdx.x & 63;
    for (int vb = blockIdx.x; vb < T_ALL * 8 / NWAVE; vb += gridDim.x) {
        const int item = vb * NWAVE + w;
        const int t = item >> 3, h = item & 7;
        __syncthreads();
        for (int c = lane; c < 256; c += 64) sq[w][c] = qh[(size_t)t * 2048 + h * 256 + c];
        __syncthreads();
#pragma unroll
        for (int half = 0; half < 2; ++half) {
            const float* keys = half ? keys2 : keys1;
            float s[2];
#pragma unroll
            for (int sl = 0; sl < 2; ++sl) {
                const float* kr = keys + (size_t)(lane + sl * 64) * 128;
                float a = 0.f;
#pragma unroll 8
                for (int c = 0; c < 128; c += 4) { float4 kv = *(const float4*)(kr + c); const float* qq = &sq[w][half * 128 + c]; a += kv.x * qq[0] + kv.y * qq[1] + kv.z * qq[2] + kv.w * qq[3]; }
                s[sl] = a;
            }
            for (int r = 0; r < 16; ++r) {
                float bv; int bi;
                if (s[0] >= s[1]) { bv = s[0]; bi = lane; } else { bv = s[1]; bi = lane + 64; }
#pragma unroll
                for (int o = 32; o > 0; o >>= 1) {
                    float ov = __shfl_xor(bv, o); int oi = __shfl_xor(bi, o);
                    if (ov > bv || (ov == bv && oi < bi)) { bv = ov; bi = oi; }
                }
                if (lane == 0) { sv[w][half][r] = bv; si[w][half][r] = bi; }
                if (bi == lane) s[0] = -INFINITY;
                if (bi == lane + 64) s[1] = -INFINITY;
            }
        }
        __syncthreads();
        float c[4];
#pragma unroll
        for (int j = 0; j < 4; ++j) { int ci = lane * 4 + j; c[j] = sv[w][0][ci >> 4] + sv[w][1][ci & 15]; }
        float myv = 0.f; int myc = 0;
        for (int r = 0; r < 16; ++r) {
            float bv = c[0]; int bi = lane * 4;
#pragma unroll
            for (int j = 1; j < 4; ++j) if (c[j] > bv) { bv = c[j]; bi = lane * 4 + j; }
#pragma unroll
            for (int o = 32; o > 0; o >>= 1) {
                float ov = __shfl_xor(bv, o); int oi = __shfl_xor(bi, o);
                if (ov > bv || (ov == bv && oi < bi)) { bv = ov; bi = oi; }
            }
            if (lane == r) { myv = bv; myc = bi; }
#pragma unroll
            for (int j = 0; j < 4; ++j) if (bi == lane * 4 + j) c[j] = -INFINITY;
        }
        float v = lane < 16 ? myv : -INFINITY;
        float mx = wave_max(v);
        float e = lane < 16 ? __expf(v - mx) : 0.f;
        float sum = wave_sum(e);
        if (lane < 16) {
            int ex = si[w][0][myc >> 4] * PEER_NKEYS + si[w][1][myc & 15];
            eidx[(size_t)t * 128 + h * 16 + lane] = ex;
            gate[(size_t)t * 128 + h * 16 + lane] = e / sum;
        }
    }
}

__device__ __forceinline__ void ph_peer_ffn(const float* __restrict__ hbuf, const int* __restrict__ eidx, const float* __restrict__ gate,
                                            const float* __restrict__ ut, const float* __restrict__ vt, const float* __restrict__ gam,
                                            const float* __restrict__ bet, float* __restrict__ out) {
    const int lane = threadIdx.x & 63;
    for (int t = blockIdx.x * NWAVE + (threadIdx.x >> 6); t < T_ALL; t += gridDim.x * NWAVE) {
        float4 x[4], acc[4];
#pragma unroll
        for (int j = 0; j < 4; ++j) { x[j] = *(const float4*)(hbuf + (size_t)t * D_MODEL + j * 256 + lane * 4); acc[j] = make_float4(0.f, 0.f, 0.f, 0.f); }
        for (int k = 0; k < 128; ++k) {
            const int e = eidx[(size_t)t * 128 + k];
            const float g = gate[(size_t)t * 128 + k];
            const float* ur = ut + (size_t)e * D_MODEL;
            float d = 0.f;
#pragma unroll
            for (int j = 0; j < 4; ++j) { float4 u4 = *(const float4*)(ur + j * 256 + lane * 4); d += u4.x * x[j].x + u4.y * x[j].y + u4.z * x[j].z + u4.w * x[j].w; }
            d = wave_sum(d);
            const float wgt = g * gelu_f(d);
            const float* vr = vt + (size_t)e * D_MODEL;
#pragma unroll
            for (int j = 0; j < 4; ++j) { float4 v4 = *(const float4*)(vr + j * 256 + lane * 4); acc[j].x += wgt * v4.x; acc[j].y += wgt * v4.y; acc[j].z += wgt * v4.z; acc[j].w += wgt * v4.w; }
        }
        float s = 0.f;
#pragma unroll
        for (int j = 0; j < 4; ++j) { acc[j].x += ALPHA_F * x[j].x; acc[j].y += ALPHA_F * x[j].y; acc[j].z += ALPHA_F * x[j].z; acc[j].w += ALPHA_F * x[j].w; s += acc[j].x + acc[j].y + acc[j].z + acc[j].w; }
        s = wave_sum(s);
        const float mu = s * (1.0f / 1024.0f);
        float q = 0.f;
#pragma unroll
        for (int j = 0; j < 4; ++j) { acc[j].x -= mu; acc[j].y -= mu; acc[j].z -= mu; acc[j].w -= mu; q += acc[j].x * acc[j].x + acc[j].y * acc[j].y + acc[j].z * acc[j].z + acc[j].w * acc[j].w; }
        q = wave_sum(q);
        const float r = rsqrtf(q * (1.0f / 1024.0f) + LN_EPS);
        float* dst = (t < T_PROMPT) ? out + OUT_YP + (size_t)t * D_MODEL : out + OUT_YS + (size_t)(t - T_PROMPT) * D_MODEL;
#pragma unroll
        for (int j = 0; j < 4; ++j) {
            float4 g4 = *(const float4*)(gam + j * 256 + lane * 4), b4 = *(const float4*)(bet + j * 256 + lane * 4);
            float4 o; o.x = acc[j].x * r * g4.x + b4.x; o.y = acc[j].y * r * g4.y + b4.y; o.z = acc[j].z * r * g4.z + b4.z; o.w = acc[j].w * r * g4.w + b4.w;
            *(float4*)(dst + j * 256 + lane * 4) = o;
        }
    }
}

struct Params {
    const float* in[23];
    float* out;
    unsigned char* ws;
    unsigned* bar;
};

#define WS_BAR      0ull
#define WS_XALL     (1ull << 20)
#define WS_PROJ     (WS_XALL + (size_t)T_ALL * D_MODEL * 4)
#define WS_XBC      (WS_PROJ + (size_t)T_ALL * IN_WIDTH * 4)
#define WS_DT       (WS_XBC + (size_t)T_ALL * CONV_DIM * 4)
#define WS_QROT     (WS_DT + (size_t)T_ALL * SSD_HEADS * 4)
#define WS_KROT     (WS_QROT + (size_t)T_ALL * ATT_WIDTH * 4)
#define WS_YBUF     (WS_KROT + (size_t)T_ALL * ATT_WIDTH * 4)
#define WS_MIX      (WS_YBUF + (size_t)T_ALL * MIX_WIDTH * 4)
#define WS_HBUF     (WS_MIX + (size_t)T_ALL * D_MODEL * 4)
#define WS_QH       (WS_HBUF + (size_t)T_ALL * D_MODEL * 4)
#define WS_EIDX     (WS_QH + (size_t)T_ALL * 2048 * 4)
#define WS_GATE     (WS_EIDX + (size_t)T_ALL * 128 * 4)
#define WS_END      (WS_GATE + (size_t)T_ALL * 128 * 4)

#define LDS_BYTES (144 * 1024)

__global__ void __launch_bounds__(512, 2) mega_fwd(Params p) {
    extern __shared__ __attribute__((aligned(16))) unsigned char smem[];
    if (threadIdx.x == 0) *(uint4*)smem = make_uint4(0u, 0u, 0u, 0u);
    __syncthreads();
    XcdBarrier bar = xcd_barrier_post(p.bar, (volatile LAS unsigned*)smem);
    float* lds = (float*)(smem + 256);

    const float* x_prompt = p.in[0]; const float* x_sample = p.in[1]; const float* cache_k = p.in[2]; const float* cache_v = p.in[3];
    const float* state_conv = p.in[4]; const float* state_ssm = p.in[5]; const float* w_in = p.in[6]; const float* conv_w = p.in[7];
    const float* conv_b = p.in[8]; const float* dt_bias = p.in[9]; const float* a_log = p.in[10]; const float* d_skip = p.in[11];
    const float* norm_g = p.in[12]; const float* w_out = p.in[13]; const float* ln1_g = p.in[14]; const float* ln1_b = p.in[15];
    const float* peer_wq = p.in[16]; const float* keys1 = p.in[17]; const float* keys2 = p.in[18]; const float* peer_u = p.in[19];
    const float* peer_v = p.in[20]; const float* ln2_g = p.in[21]; const float* ln2_b = p.in[22];
    float* out = p.out;
    float* xall = (float*)(p.ws + WS_XALL); float* proj = (float*)(p.ws + WS_PROJ); float* xbc_act = (float*)(p.ws + WS_XBC);
    float* dtv = (float*)(p.ws + WS_DT); float* qrot = (float*)(p.ws + WS_QROT); float* krot = (float*)(p.ws + WS_KROT);
    float* ybuf = (float*)(p.ws + WS_YBUF); float* mix = (float*)(p.ws + WS_MIX); float* hbuf = (float*)(p.ws + WS_HBUF);
    float* qh = (float*)(p.ws + WS_QH); int* eidx = (int*)(p.ws + WS_EIDX); float* gate = (float*)(p.ws + WS_GATE);

    ph_concat_x(x_prompt, x_sample, xall);
    ph_cache_copy(cache_k, cache_v, out);
    xcd_barrier(bar);
    ph_gemm_f32(lds, xall, w_in, proj, T_ALL, IN_WIDTH, D_MODEL, D_MODEL, IN_WIDTH, IN_WIDTH);
    xcd_barrier(bar);
    ph_post_proj(proj, state_conv, conv_w, conv_b, dt_bias, xbc_act, dtv, qrot, krot, out);
    xcd_barrier(bar);
    ph_ssd_naive(lds, xbc_act, dtv, a_log, d_skip, state_ssm, ybuf, out);
    ph_attn_naive(lds, proj, qrot, krot, cache_k, cache_v, ybuf);
    xcd_barrier(bar);
    ph_gate_norm(proj, norm_g, ybuf);
    xcd_barrier(bar);
    ph_gemm_f32(lds, ybuf, w_out, mix, T_ALL, D_MODEL, MIX_WIDTH, MIX_WIDTH, D_MODEL, D_MODEL);
    xcd_barrier(bar);
    ph_ln_res(xall, mix, ln1_g, ln1_b, hbuf);
    xcd_barrier(bar);
    ph_gemm_f32(lds, hbuf, peer_wq, qh, T_ALL, 2048, D_MODEL, D_MODEL, 2048, 2048);
    xcd_barrier(bar);
    ph_peer_route(lds, qh, keys1, keys2, eidx, gate);
    xcd_barrier(bar);
    ph_peer_ffn(hbuf, eidx, gate, peer_u, peer_v, ln2_g, ln2_b, out);
}

extern "C" void kernel_launch(void* const* d_in, const int* in_sizes, int n_in, void* d_out, int out_size, void* d_ws, size_t ws_size, hipStream_t stream) {
    static int grid = 0;
    if (grid == 0) {
        int dev = 0, cus = 0, per_cu = 0;
        if (hipGetDevice(&dev) != hipSuccess || hipDeviceGetAttribute(&cus, hipDeviceAttributeMultiprocessorCount, dev) != hipSuccess) { fprintf(stderr, "kernel_launch: device query failed\n"); grid = -1; return; }
        if (hipFuncSetAttribute((const void*)mega_fwd, hipFuncAttributeMaxDynamicSharedMemorySize, LDS_BYTES) != hipSuccess) { fprintf(stderr, "kernel_launch: hipFuncSetAttribute failed\n"); grid = -1; return; }
        if (hipOccupancyMaxActiveBlocksPerMultiprocessor(&per_cu, (const void*)mega_fwd, NTHR, LDS_BYTES) != hipSuccess || per_cu < 1) { fprintf(stderr, "kernel_launch: occupancy query says %d\n", per_cu); }
        (void)hipGetLastError();
        grid = cus;
        if (ws_size < WS_END) { fprintf(stderr, "kernel_launch: workspace too small\n"); grid = -1; return; }
    }
    if (grid < 0) return;
    (void)hipMemsetAsync((char*)d_ws + WS_BAR, 0, XCD_BAR_WORDS * sizeof(unsigned), stream);
    Params p{};
    for (int i = 0; i < 23; ++i) p.in[i] = (const float*)d_in[i];
    p.out = (float*)d_out; p.ws = (unsigned char*)d_ws; p.bar = (unsigned*)((char*)d_ws + WS_BAR);
    hipLaunchKernelGGL(mega_fwd, dim3(grid), dim3(NTHR), LDS_BYTES, stream, p);
}
```

```cpp
#include <hip/hip_runtime.h>
#include <stdint.h>

#define D_MODEL 1024
#define BATCH 2
#define SEQ 8192
#define DEC_BATCH 128
#define DEC_SEQ 4
#define PAST_LEN 8192
#define HEAD_DIM 64
#define ATT_WIDTH 512
#define ATT_HEADS 8
#define SSD_WIDTH 1536
#define SSD_HEADS 24
#define SSD_GROUPS 4
#define SSD_STATE 128
#define CONV_DIM 2560
#define IN_WIDTH 5656
#define PROJ_LD 5888
#define MIX_WIDTH 2048
#define WBUF 2048
#define PEER_NKEYS 128
#define PEER_HEADS 8
#define PEER_TOPK 16
#define PEER_DKEY 256
#define T_PROMPT (BATCH * SEQ)
#define T_SAMPLE (DEC_BATCH * DEC_SEQ)
#define T_ALL (T_PROMPT + T_SAMPLE)
#define O_Z 0
#define O_XBC 1536
#define O_DT 4096
#define O_Q 4120
#define O_K 4632
#define O_V 5144
#define ALPHA_F 1.189207115002721f
#define LN_EPS 1e-5f

#define OUT_YP 0ull
#define OUT_YS (OUT_YP + 16777216ull)
#define OUT_PK (OUT_YS + 524288ull)
#define OUT_PV (OUT_PK + 2097152ull)
#define OUT_PC (OUT_PV + 2097152ull)
#define OUT_PS (OUT_PC + 15360ull)
#define OUT_SK (OUT_PS + 393216ull)
#define OUT_SV (OUT_SK + 134217728ull)
#define OUT_SC (OUT_SV + 134217728ull)
#define OUT_SS (OUT_SC + 983040ull)

__constant__ double ROPE_INV_REV[32] = {
    1.59154943091895346e-01, 1.19349370211248862e-01, 8.94994016088910133e-02, 6.71150830052272551e-02,
    5.03292121044870353e-02, 3.77415847174197711e-02, 2.83021958306233987e-02, 2.12236527647776604e-02,
    1.59154943091895339e-02, 1.19349370211248862e-02, 8.94994016088910237e-03, 6.71150830052272534e-03,
    5.03292121044870370e-03, 3.77415847174197719e-03, 2.83021958306233987e-03, 2.12236527647776622e-03,
    1.59154943091895356e-03, 1.19349370211248849e-03, 8.94994016088910237e-04, 6.71150830052272599e-04,
    5.03292121044870326e-04, 3.77415847174197741e-04, 2.83021958306233954e-04, 2.12236527647776605e-04,
    1.59154943091895351e-04, 1.19349370211248862e-04, 8.94994016088910182e-05, 6.71150830052272545e-05,
    5.03292121044870354e-05, 3.77415847174197768e-05, 2.83021958306233961e-05, 2.12236527647776592e-05
};

__device__ __forceinline__ float silu_f(float x) { return x / (1.0f + __expf(-x)); }
__device__ __forceinline__ float softplus_f(float x) { return fmaxf(x, 0.f) + log1pf(__expf(-fabsf(x))); }
__device__ __forceinline__ float gelu_f(float x) { return 0.5f * x * (1.0f + erff(x * 0.70710678118654752f)); }
__device__ __forceinline__ float wave_sum(float v) {
#pragma unroll
    for (int o = 32; o > 0; o >>= 1) v += __shfl_xor(v, o);
    return v;
}
__device__ __forceinline__ float wave_max(float v) {
#pragma unroll
    for (int o = 32; o > 0; o >>= 1) v = fmaxf(v, __shfl_xor(v, o));
    return v;
}

#include <cstdio>
#define XB_TMO      128
#define XB_XCNT(j)  (256  + 64 * (j))
#define XB_XSUB(j)  (1280 + 64 * (j))
#define XB_XGEN(j)  (2304 + 64 * (j))
#define XB_TOP      3328
#define XB_TOPGEN   3392
#define XCD_BAR_WORDS 3456
#define XB_SPIN_CAP (1u << 18)
#define LAS __attribute__((address_space(3)))

__device__ __forceinline__ unsigned xb_ld(unsigned* p)              { return __hip_atomic_load(p, __ATOMIC_RELAXED, __HIP_MEMORY_SCOPE_AGENT); }
__device__ __forceinline__ unsigned xb_add(unsigned* p, unsigned v) { return __hip_atomic_fetch_add(p, v, __ATOMIC_RELAXED, __HIP_MEMORY_SCOPE_AGENT); }
__device__ __forceinline__ unsigned xb_xcc_id() { return (unsigned)__builtin_amdgcn_s_getreg((3 << 11) | 20) & 0xFu; }
#define XB_SPIN(cond, bar) do { unsigned _sp = 0; while (cond) { __builtin_amdgcn_s_sleep(1); \
    if ((++_sp & 255u) == 0u) { if (xb_ld(&(bar)[XB_TMO])) break; if (_sp > XB_SPIN_CAP) { atomicAdd(&(bar)[XB_TMO], 1u); break; } } } } while (0)

struct XcdBarrier {
    unsigned* bar; unsigned x;
    volatile LAS unsigned* st;
};

__device__ __forceinline__ XcdBarrier xcd_barrier_post(unsigned* bar, volatile LAS unsigned* st) {
    XcdBarrier b; b.bar = bar; b.x = xb_xcc_id(); b.st = st;
    if (threadIdx.x == 0) (void)xb_add(&bar[XB_XCNT(b.x)], 1u);
    return b;
}
__device__ __forceinline__ void xcd_barrier_complete(unsigned* bar, unsigned x, unsigned& nloc, unsigned& nx) {
    const unsigned G = gridDim.x * gridDim.y * gridDim.z;
    unsigned sum, cnt, mine, sp = 0u;
    for (;;) {
        sum = 0u; cnt = 0u; mine = 0u;
#pragma unroll
        for (unsigned j = 0; j < 16; ++j) { const unsigned c = xb_ld(&bar[XB_XCNT(j)]); sum += c; cnt += (c > 0u) ? 1u : 0u; mine = (j == x) ? c : mine; }
        if (sum == G) break;
        __builtin_amdgcn_s_sleep(1);
        if ((++sp & 255u) == 0u) { if (xb_ld(&bar[XB_TMO])) break; if (sp > XB_SPIN_CAP) { atomicAdd(&bar[XB_TMO], 1u); break; } }
    }
    nloc = mine > 0u ? mine : 1u; nx = cnt > 0u ? cnt : 1u;
}

__device__ __forceinline__ void xcd_barrier(const XcdBarrier& b) {
    asm volatile("s_waitcnt vmcnt(0)" ::: "memory");
    __syncthreads();
    if (threadIdx.x == 0) {
        unsigned* bar = b.bar;
        __builtin_amdgcn_s_waitcnt(0);
        unsigned nloc = b.st[0], nx = b.st[1];
        if (nloc == 0u) { xcd_barrier_complete(bar, b.x, nloc, nx); b.st[0] = nloc; b.st[1] = nx; }
        const unsigned old = xb_add(&bar[XB_XSUB(b.x)], 1u);
        const unsigned gen = old / nloc;
        if (old + 1u == (gen + 1u) * nloc) {
            __builtin_amdgcn_fence(__ATOMIC_RELEASE, "agent");
            asm volatile("s_waitcnt vmcnt(0)" ::: "memory");
            const unsigned og = xb_add(&bar[XB_TOP], 1u);
            const unsigned tg = og / nx;
            if (og + 1u == (tg + 1u) * nx) xb_add(&bar[XB_TOPGEN], 1u);
            else XB_SPIN(xb_ld(&bar[XB_TOPGEN]) == tg, bar);
            __builtin_amdgcn_fence(__ATOMIC_ACQUIRE, "agent");
            xb_add(&bar[XB_XGEN(b.x)], 1u);
            asm volatile("s_waitcnt vmcnt(0)" ::: "memory");
        } else {
            XB_SPIN(xb_ld(&bar[XB_XGEN(b.x)]) == gen, bar);
            __builtin_amdgcn_fence(__ATOMIC_ACQUIRE, "agent");
            asm volatile("s_waitcnt vmcnt(0)" ::: "memory");
        }
    }
    __syncthreads();
}


#define GAS __attribute__((address_space(1)))
typedef unsigned short bf16;
typedef unsigned v4u __attribute__((ext_vector_type(4)));
#define LDS_WAIT() asm volatile("s_waitcnt lgkmcnt(0)" ::: "memory")
__device__ __forceinline__ unsigned f2bf(float f) { unsigned u = __builtin_bit_cast(unsigned, f); return (u + 0x7fffu + ((u >> 16) & 1u)) >> 16; }
__device__ __forceinline__ unsigned pk2(float lo, float hi) { return f2bf(lo) | (f2bf(hi) << 16); }
__device__ __forceinline__ float bf2f(unsigned short b) { return __builtin_bit_cast(float, (unsigned)b << 16); }
#include <hip/hip_runtime.h>
namespace pg8 {
#define PG8_LAS __attribute__((address_space(3)))
typedef unsigned short bf16_t;
typedef short bf16x8 __attribute__((ext_vector_type(8)));
typedef float f32x4 __attribute__((ext_vector_type(4)));
typedef unsigned u32x4 __attribute__((ext_vector_type(4)));
constexpr int BM = 256, BK = 64, HALF = 128, HTB = HALF * BK * 2  , STAGE_BYTES = 8 * HTB, NXCD = 8, WGM = 8;

__host__ __device__ __forceinline__ int lds_byte(int r, int c) { const int st = (r >> 4) * 2 + (c >> 5), rr = r & 15, cc = c & 31, ob = rr * 64 + cc * 2; return st * 1024 + (ob ^ (((ob >> 9) & 1) << 5)); }
__host__ __device__ __forceinline__ void stage_rc(int b, int& R, int& C) { const int st = b / 1024, sb = b % 1024, swz = sb ^ (((sb >> 9) & 1) << 5); R = (st >> 1) * 16 + swz / 64; C = (st & 1) * 32 + (swz % 64) / 2; }
__host__ __device__ __forceinline__ int perm32(int rho) { const int n = rho >> 4, i = rho & 15; return 8 * (i >> 2) + 4 * n + (i & 3); }

struct Unit { int pm, pn; };
struct Gemm { const bf16_t* A; const bf16_t* Bt; int M, N, K; };

struct StaticOrder {
    int nM, nN, nwg, G, c;
    __host__ __device__ void init(int M, int N, int G_, int c_) { nM = M / BM; nN = N / BM; nwg = nM * nN; G = G_; c = c_; }
    __host__ __device__ bool next(int i, Unit& u) const {
        const long L = (long)i * G + c; if (L >= nwg) return false;
        int wgid = (int)L; { const int q = nwg / NXCD, r = nwg % NXCD, xcd = wgid % NXCD, off = wgid / NXCD; wgid = (xcd < r ? xcd * (q + 1) : r * (q + 1) + (xcd - r) * q) + off; }
        const int nig = WGM * nN, gid = wgid / nig, fm = gid * WGM, gsz = (nM - fm) < WGM ? (nM - fm) : WGM;
        u.pm = fm + ((wgid % nig) % gsz); u.pn = (wgid % nig) / gsz; return true;
    }
    __device__ __forceinline__ void a_ready(const Unit&) const {}
    __device__ __forceinline__ void done(const Unit&) const {}
};
__device__ __forceinline__ unsigned cvt_pk_bf16(float lo, float hi) { unsigned r; asm volatile("v_cvt_pk_bf16_f32 %0, %1, %2" : "=v"(r) : "v"(lo), "v"(hi)); return r; }
typedef float f32x2 __attribute__((ext_vector_type(2)));
__device__ __forceinline__ f32x2 gelu_pk(f32x2 v) {
    const f32x2 av = __builtin_elementwise_abs(v), d = av * 0.2316418882f + 1.0f;
    f32x2 t; t.x = __builtin_amdgcn_rcpf(d.x); t.y = __builtin_amdgcn_rcpf(d.y);
    f32x2 q = t * 0.5307027145f + (-0.7265760135f); q = q * t + 0.7107068705f; q = q * t + (-0.142248368f); q = q * t + 0.127414796f; q = q * t;
    const f32x2 s = (v * v) * (-0.72134752044f);
    f32x2 e; e.x = __builtin_amdgcn_exp2f(s.x); e.y = __builtin_amdgcn_exp2f(s.y);
    const f32x2 m = v * (q * e), r = v - m;
    f32x2 o; o.x = v.x < 0.f ? m.x : r.x; o.y = v.y < 0.f ? m.y : r.y; return o;
}

struct EpiF32 {
    static constexpr bool PERM = false, AFTER_DRAIN = false;
    float* C; int ldc; const float* bias;
    __device__ __forceinline__ void operator()(const f32x4 (&acc)[2][2][4][2], const Unit& u, int wr, int wc, int fr, int fq) const {
        const int row0 = u.pm * BM + wr * 64 + fr, col0 = u.pn * BM + wc * 32 + 4 * fq;
        f32x4 bv[2][2];
#pragma unroll
        for (int bj = 0; bj < 2; ++bj)
#pragma unroll
            for (int n = 0; n < 2; ++n) bv[bj][n] = bias ? *(const f32x4*)(bias + col0 + bj * HALF + n * 16) : (f32x4){0.f, 0.f, 0.f, 0.f};
#pragma unroll
        for (int ai = 0; ai < 2; ++ai)
#pragma unroll
            for (int m = 0; m < 4; ++m) { float* rowp = C + (size_t)(row0 + ai * HALF + m * 16) * ldc + col0;
#pragma unroll
                for (int bj = 0; bj < 2; ++bj)
#pragma unroll
                    for (int n = 0; n < 2; ++n) *(f32x4*)(rowp + bj * HALF + n * 16) = acc[ai][bj][m][n] + bv[bj][n]; }
    }
};

template <class Epi, class Sched, bool STAMP = false>
__device__ __forceinline__ void gemm_phase(PG8_LAS unsigned char* lds, const Gemm g, const Sched& S, const Epi& E, unsigned long long* stamps) {
    const int tid = threadIdx.x, wid = __builtin_amdgcn_readfirstlane(tid >> 6), lane = tid & 63, wr = wid >> 2, wc = wid & 3, fr = lane & 15, fq = lane >> 4;
    const int K = g.K, nt = K / BK;
    int ts_lo = 0, ts_hi = 0, nts = 0; const unsigned long long rt_entry = STAMP ? (unsigned long long)wall_clock64() : 0ull;
#define PG8_STAMP() do { if (STAMP && wid == 0 && nts < 64) { const unsigned long long _c = (unsigned long long)clock64(); \
        ts_lo = (lane == nts) ? (int)(unsigned)_c : ts_lo; ts_hi = (lane == nts) ? (int)(unsigned)(_c >> 32) : ts_hi; ++nts; } } while (0)
    PG8_STAMP();
    unsigned voffA[2], voffB[2];
#pragma unroll
    for (int i = 0; i < 2; ++i) { int R, C; stage_rc(tid * 16 + i * 8192, R, C); const int Rb = Epi::PERM ? ((R & ~31) + perm32(R & 31)) : R;
        voffA[i] = (unsigned)(R * K + C) * 2u; voffB[i] = (unsigned)(Rb * K + C) * 2u; }
    const size_t kstep = (size_t)(BK * 2);
    const size_t hstep = (size_t)HALF * K * 2;
    const size_t tstep = 2 * hstep;
    const unsigned ldsw = (unsigned)wid * 1024u;
    const int aoff = lds_byte(wr * 64 + fr, fq * 8), boff = lds_byte(wc * 32 + fr, fq * 8);
#define PG8_SA(b, h) (((b) * 2 + (h)) * HTB)
#define PG8_SB(b, h) ((4 + (b) * 2 + (h)) * HTB)
#define PG8_STAGE(bufoff, gbase, voff) do { _Pragma("unroll") for (int _i = 0; _i < 2; ++_i) \
        __builtin_amdgcn_global_load_lds((const unsigned*)((const char*)(gbase) + (voff)[_i]), (PG8_LAS unsigned*)(lds + (bufoff) + ldsw + _i * 8192), 16, 0, 0); } while (0)
#define PG8_LDA(dst, b, h) do { _Pragma("unroll") for (int m = 0; m < 4; ++m) _Pragma("unroll") for (int k = 0; k < 2; ++k) dst[m][k] = *(const PG8_LAS bf16x8*)(lds + PG8_SA(b, h) + aoff + m * 2048 + k * 1024); } while (0)
#define PG8_LDB(dst, b, h) do { _Pragma("unroll") for (int n = 0; n < 2; ++n) _Pragma("unroll") for (int k = 0; k < 2; ++k) dst[n][k] = *(const PG8_LAS bf16x8*)(lds + PG8_SB(b, h) + boff + n * 2048 + k * 1024); } while (0)
#define PG8_MMA(ai, bj, At, Bt) do { __builtin_amdgcn_s_setprio(1); _Pragma("unroll") for (int m = 0; m < 4; ++m) _Pragma("unroll") for (int n = 0; n < 2; ++n) _Pragma("unroll") for (int k = 0; k < 2; ++k) \
        acc[ai][bj][m][n] = __builtin_amdgcn_mfma_f32_16x16x32_bf16(Bt[n][k], At[m][k], acc[ai][bj][m][n], 0, 0, 0); __builtin_amdgcn_s_setprio(0); } while (0)
#define PG8_WAIT_V(n) asm volatile("s_waitcnt vmcnt(" #n ")" ::: "memory")
#define PG8_WAIT_L(n) asm volatile("s_waitcnt lgkmcnt(" #n ")" ::: "memory")
#define PG8_BAR __builtin_amdgcn_s_barrier()
#define PG8_SCHED __builtin_amdgcn_sched_barrier(0)
    Unit cur, nxt; int ui = 0;
    if (!S.next(0, cur)) return;
    f32x4 acc[2][2][4][2];
#pragma unroll
    for (int a = 0; a < 2; ++a)
#pragma unroll
        for (int b = 0; b < 2; ++b)
#pragma unroll
            for (int m = 0; m < 4; ++m)
#pragma unroll
                for (int n = 0; n < 2; ++n) acc[a][b][m][n] = (f32x4){0.f, 0.f, 0.f, 0.f};
    bf16x8 At[4][2], B0[2][2], B1[2][2];
    const char* cA = (const char*)g.A + (size_t)cur.pm * tstep; const char* cB = (const char*)g.Bt + (size_t)cur.pn * tstep;
    S.a_ready(cur);
    PG8_STAGE(PG8_SB(0, 0), cB, voffB); PG8_STAGE(PG8_SA(0, 0), cA, voffA); PG8_STAGE(PG8_SB(0, 1), cB + hstep, voffB); PG8_STAGE(PG8_SA(0, 1), cA + hstep, voffA);
    if (wr == 1) PG8_BAR;
    PG8_WAIT_V(4); PG8_BAR;
    PG8_STAGE(PG8_SB(1, 0), cB + kstep, voffB); PG8_STAGE(PG8_SA(1, 0), cA + kstep, voffA); PG8_STAGE(PG8_SB(1, 1), cB + hstep + kstep, voffB);
    PG8_WAIT_V(6); PG8_BAR;
    PG8_STAMP();
    for (;;) {
        const bool has_next = S.next(ui + 1, nxt);
        const char* nA = has_next ? (const char*)g.A + (size_t)nxt.pm * tstep : cA; const char* nB = has_next ? (const char*)g.Bt + (size_t)nxt.pn * tstep : cB;
        for (int t = 0; t < nt; t += 2) {
            const bool last = (t == nt - 2);
            const char* a1 = cA + (size_t)(t + 1) * kstep;
            const char* a2 = last ? nA : cA + (size_t)(t + 2) * kstep; const char* b2 = last ? nB : cB + (size_t)(t + 2) * kstep;
            const char* a3 = a2 + kstep; const char* b3 = b2 + kstep;
            if (last && has_next) S.a_ready(nxt);
            PG8_LDB(B0, 0, 0); PG8_SCHED; PG8_LDA(At, 0, 0); PG8_STAGE(PG8_SA(1, 1), a1 + hstep, voffA);
            PG8_WAIT_L(8); PG8_BAR; PG8_WAIT_L(0); PG8_MMA(0, 0, At, B0); PG8_BAR; PG8_SCHED;
            PG8_LDB(B1, 0, 1); PG8_STAGE(PG8_SB(0, 0), b2, voffB);
            PG8_BAR; PG8_WAIT_L(0); PG8_MMA(0, 1, At, B1); PG8_BAR;
            PG8_LDA(At, 0, 1); PG8_STAGE(PG8_SA(0, 0), a2, voffA);
            PG8_BAR; PG8_WAIT_L(0); PG8_MMA(1, 0, At, B0); PG8_BAR; PG8_SCHED;
            PG8_STAGE(PG8_SB(0, 1), b2 + hstep, voffB);
            PG8_WAIT_V(6); PG8_BAR; PG8_MMA(1, 1, At, B1); PG8_BAR;
            PG8_LDB(B0, 1, 0); PG8_SCHED; PG8_LDA(At, 1, 0); PG8_STAGE(PG8_SA(0, 1), a2 + hstep, voffA);
            PG8_WAIT_L(8); PG8_BAR; PG8_WAIT_L(0); PG8_MMA(0, 0, At, B0); PG8_BAR; PG8_SCHED;
            PG8_LDB(B1, 1, 1); PG8_STAGE(PG8_SB(1, 0), b3, voffB);
            PG8_BAR; PG8_WAIT_L(0); PG8_MMA(0, 1, At, B1); PG8_BAR;
            PG8_LDA(At, 1, 1); PG8_STAGE(PG8_SA(1, 0), a3, voffA);
            PG8_BAR; PG8_WAIT_L(0); PG8_MMA(1, 0, At, B0); PG8_BAR; PG8_SCHED;
            PG8_STAGE(PG8_SB(1, 1), b3 + hstep, voffB);
            PG8_WAIT_V(6); PG8_BAR; PG8_MMA(1, 1, At, B1); PG8_BAR;
        }
        PG8_STAMP();
        if constexpr (!Epi::AFTER_DRAIN) { E(acc, cur, wr, wc, fr, fq); S.done(cur); }
        PG8_STAMP();
        if (!has_next) break;
#pragma unroll
        for (int a = 0; a < 2; ++a)
#pragma unroll
            for (int b = 0; b < 2; ++b)
#pragma unroll
                for (int m = 0; m < 4; ++m)
#pragma unroll
                    for (int n = 0; n < 2; ++n) acc[a][b][m][n] = (f32x4){0.f, 0.f, 0.f, 0.f};
        cur = nxt; cA = nA; cB = nB; ++ui;
    }
    PG8_WAIT_V(0);
    if (wr == 0) PG8_BAR;
    PG8_BAR;
    if constexpr (Epi::AFTER_DRAIN) { E.fused(acc, cur, wr, wc, fr, fq, lds, wid, lane); S.done(cur); }
    PG8_STAMP();
    if (STAMP && wid == 0) { stamps[lane] = lane < nts ? (((unsigned long long)(unsigned)ts_hi << 32) | (unsigned)ts_lo) : 0ull;
        if (lane == 62) stamps[62] = rt_entry; if (lane == 63) stamps[63] = (unsigned long long)wall_clock64(); }
#undef PG8_STAMP
#undef PG8_SA
#undef PG8_SB
#undef PG8_STAGE
#undef PG8_LDA
#undef PG8_LDB
#undef PG8_MMA
#undef PG8_WAIT_V
#undef PG8_WAIT_L
#undef PG8_BAR
#undef PG8_SCHED
}
}

#define NTHR 512
#define NWAVE 8

__device__ __forceinline__ void ph_gemm_f32(float* lds, const float* __restrict__ A, const float* __restrict__ B, float* __restrict__ C,
                                            int M, int N, int K, int lda, int ldb, int ldc) {
    const int tid = threadIdx.x & 255, half = threadIdx.x >> 8, tx = tid & 15, ty = tid >> 4;
    float (*As)[68] = (float (*)[68])(lds + half * 2 * 16 * 68);
    float (*Bs)[68] = (float (*)[68])(lds + half * 2 * 16 * 68 + 16 * 68);
    const int ntx = (N + 63) / 64, nty = M / 64, ntiles = ntx * nty;
    for (int it = blockIdx.x; 2 * it < ntiles; it += gridDim.x) {
        const int tile = 2 * it + half;
        const int m0 = (tile / ntx) * 64, n0 = (tile % ntx) * 64;
        float acc[4][4];
#pragma unroll
        for (int i = 0; i < 4; ++i)
#pragma unroll
            for (int j = 0; j < 4; ++j) acc[i][j] = 0.f;
        for (int k0 = 0; k0 < K; k0 += 16) {
#pragma unroll
            for (int i = 0; i < 4; ++i) {
                int idx = tid + i * 256;
                int r = idx >> 4, c = idx & 15;
                As[c][r] = (m0 + r < M) ? A[(size_t)(m0 + r) * lda + k0 + c] : 0.f;
                int rb = idx >> 6, cb = idx & 63;
                Bs[rb][cb] = (n0 + cb < N) ? B[(size_t)(k0 + rb) * ldb + n0 + cb] : 0.f;
            }
            __syncthreads();
#pragma unroll
            for (int k = 0; k < 16; ++k) {
                float a[4], b[4];
#pragma unroll
                for (int i = 0; i < 4; ++i) { a[i] = As[k][ty * 4 + i]; b[i] = Bs[k][tx * 4 + i]; }
#pragma unroll
                for (int i = 0; i < 4; ++i)
#pragma unroll
                    for (int j = 0; j < 4; ++j) acc[i][j] += a[i] * b[j];
            }
            __syncthreads();
        }
#pragma unroll
        for (int i = 0; i < 4; ++i)
#pragma unroll
            for (int j = 0; j < 4; ++j) {
                int r = m0 + ty * 4 + i, c = n0 + tx * 4 + j;
                if (r < M && c < N) C[(size_t)r * ldc + c] = acc[i][j];
            }
    }
}


__device__ __forceinline__ void transpose_item(const float* __restrict__ W, int K, int N, int Npad, bf16* __restrict__ WT, LAS float* scr, int item, int lane) {
    const int nblk = Npad / 32, kb = item / nblk, nb = item % nblk, k0 = 64 * kb, n0 = 32 * nb;
    const int n = n0 + (lane & 31);
#pragma unroll 8
    for (int i = 0; i < 32; ++i) { const int kk = 2 * i + (lane >> 5); scr[kk * 33 + (lane & 31)] = (n < N) ? W[(size_t)(k0 + kk) * N + n] : 0.f; }
    LDS_WAIT(); asm volatile("" ::: "memory");
    const int c = lane & 7;
#pragma unroll
    for (int j = 0; j < 4; ++j) { const int nn = (lane >> 3) + 8 * j; const LAS float* s = scr + (8 * c) * 33 + nn;
        v4u o; o.x = pk2(s[0 * 33], s[1 * 33]); o.y = pk2(s[2 * 33], s[3 * 33]); o.z = pk2(s[4 * 33], s[5 * 33]); o.w = pk2(s[6 * 33], s[7 * 33]);
        *(v4u*)(WT + (size_t)(n0 + nn) * K + k0 + 8 * c) = o; }
    LDS_WAIT(); asm volatile("" ::: "memory");
}
__device__ __forceinline__ void ph_prologue(LAS unsigned char* ldsb, const float* __restrict__ xp, const float* __restrict__ xs, bf16* __restrict__ A0,
                                            const float* __restrict__ w_in, bf16* __restrict__ wt_in, const float* __restrict__ w_out, bf16* __restrict__ wt_out,
                                            const float* __restrict__ w_q, bf16* __restrict__ wt_q) {
    const int lane = threadIdx.x & 63, wave = threadIdx.x >> 6;
    LAS float* scr = (LAS float*)(ldsb + wave * 16384);
    const int gw = blockIdx.x * NWAVE + wave, NGW = gridDim.x * NWAVE;
    constexpr int I_IN = (D_MODEL / 64) * (PROJ_LD / 32), I_OUT = (MIX_WIDTH / 64) * (D_MODEL / 32), I_Q = (D_MODEL / 64) * (2048 / 32);
    for (int it = gw; it < I_IN + I_OUT + I_Q; it += NGW) {
        int r = it;
        if (r < I_IN) { transpose_item(w_in, D_MODEL, IN_WIDTH, PROJ_LD, wt_in, scr, r, lane); continue; } r -= I_IN;
        if (r < I_OUT) { transpose_item(w_out, MIX_WIDTH, D_MODEL, D_MODEL, wt_out, scr, r, lane); continue; } r -= I_OUT;
        transpose_item(w_q, D_MODEL, 2048, 2048, wt_q, scr, r, lane);
    }
    const size_t n8 = (size_t)T_ALL * D_MODEL / 8, np8 = (size_t)T_PROMPT * D_MODEL / 8;
    for (size_t i = (size_t)blockIdx.x * NTHR + threadIdx.x; i < n8; i += (size_t)gridDim.x * NTHR) {
        const float4* s = (i < np8) ? (const float4*)xp + 2 * i : (const float4*)xs + 2 * (i - np8);
        float4 a = s[0], b = s[1];
        v4u o; o.x = pk2(a.x, a.y); o.y = pk2(a.z, a.w); o.z = pk2(b.x, b.y); o.w = pk2(b.z, b.w);
        ((v4u*)A0)[i] = o;
    }
}

__device__ __forceinline__ void ph_concat_x(const float* __restrict__ xp, const float* __restrict__ xs, float* __restrict__ xall) {
    const size_t n4 = (size_t)T_ALL * D_MODEL / 4, np4 = (size_t)T_PROMPT * D_MODEL / 4;
    for (size_t i = (size_t)blockIdx.x * NTHR + threadIdx.x; i < n4; i += (size_t)gridDim.x * NTHR) {
        float4 v = (i < np4) ? ((const float4*)xp)[i] : ((const float4*)xs)[i - np4];
        ((float4*)xall)[i] = v;
    }
}

__device__ __forceinline__ void ph_cache_copy(const float* __restrict__ ck, const float* __restrict__ cv, float* __restrict__ out) {
    const size_t per_b4 = (size_t)(WBUF - DEC_SEQ) * ATT_WIDTH / 4;
    const size_t total = per_b4 * DEC_BATCH;
    for (size_t i = (size_t)blockIdx.x * NTHR + threadIdx.x; i < total; i += (size_t)gridDim.x * NTHR) {
        size_t b = i / per_b4, r = i % per_b4;
        size_t src = (b * WBUF * ATT_WIDTH + DEC_SEQ * ATT_WIDTH) / 4 + r;
        size_t dst = (b * WBUF * ATT_WIDTH) / 4 + r;
        ((float4*)(out + OUT_SK))[dst] = ((const float4*)ck)[src];
        ((float4*)(out + OUT_SV))[dst] = ((const float4*)cv)[src];
    }
}

__device__ __forceinline__ void ph_post_proj(const float* __restrict__ proj, const float* __restrict__ state_conv,
                                             const float* __restrict__ conv_w, const float* __restrict__ conv_b, const float* __restrict__ dt_bias,
                                             float* __restrict__ xbc_act, float* __restrict__ dtv, float* __restrict__ qrot, float* __restrict__ krot,
                                             float* __restrict__ out) {
    const int tid = threadIdx.x & 255, half = threadIdx.x >> 8;
    for (int t = 2 * blockIdx.x + half; t < T_ALL; t += 2 * gridDim.x) {
        const bool is_p = t < T_PROMPT;
        int b, i, pos;
        if (is_p) { b = t / SEQ; i = t % SEQ; pos = i; } else { int ts = t - T_PROMPT; b = ts / DEC_SEQ; i = ts % DEC_SEQ; pos = PAST_LEN + i; }
        const float* row = proj + (size_t)t * PROJ_LD;
        for (int c = tid; c < CONV_DIM; c += 256) {
            float acc = conv_b[c];
#pragma unroll
            for (int tap = 0; tap < 4; ++tap) {
                int r = i - 3 + tap;
                float val;
                if (r >= 0) val = proj[(size_t)(t - i + r) * PROJ_LD + O_XBC + c];
                else val = is_p ? 0.f : state_conv[((size_t)b * 3 + (3 + r)) * CONV_DIM + c];
                acc += val * conv_w[tap * CONV_DIM + c];
            }
            xbc_act[(size_t)t * CONV_DIM + c] = silu_f(acc);
        }
        if (tid < SSD_HEADS) dtv[(size_t)t * SSD_HEADS + tid] = softplus_f(row[O_DT + tid] + dt_bias[tid]);
        for (int idx = tid; idx < 512; idx += 256) {
            int which = idx >> 8, h = (idx >> 5) & 7, j = idx & 31;
            double rev = (double)pos * ROPE_INV_REV[j];
            float fr = (float)(rev - floor(rev));
            float sn = __builtin_amdgcn_sinf(fr), cs = __builtin_amdgcn_cosf(fr);
            const float* src = row + (which ? O_K : O_Q) + h * 64;
            float t1 = src[j], t2 = src[j + 32];
            float o1 = t1 * cs - t2 * sn, o2 = t2 * cs + t1 * sn;
            float* dst = (which ? krot : qrot) + (size_t)t * ATT_WIDTH + h * 64;
            dst[j] = o1; dst[j + 32] = o2;
            if (which) {
                if (is_p) { if (i >= SEQ - WBUF) { float* o = out + OUT_PK + ((size_t)b * WBUF + (i - (SEQ - WBUF))) * ATT_WIDTH + h * 64; o[j] = o1; o[j + 32] = o2; } }
                else { float* o = out + OUT_SK + ((size_t)b * WBUF + (WBUF - DEC_SEQ + i)) * ATT_WIDTH + h * 64; o[j] = o1; o[j + 32] = o2; }
            }
        }
        for (int c = tid; c < ATT_WIDTH; c += 256) {
            float v = row[O_V + c];
            if (is_p) { if (i >= SEQ - WBUF) out[OUT_PV + ((size_t)b * WBUF + (i - (SEQ - WBUF))) * ATT_WIDTH + c] = v; }
            else out[OUT_SV + ((size_t)b * WBUF + (WBUF - DEC_SEQ + i)) * ATT_WIDTH + c] = v;
        }
        if (is_p) {
            if (i >= SEQ - 3) { int r = i - (SEQ - 3); for (int c = tid; c < CONV_DIM; c += 256) out[OUT_PC + ((size_t)b * 3 + r) * CONV_DIM + c] = row[O_XBC + c]; }
        } else {
            if (i >= 1) { int r = i - 1; for (int c = tid; c < CONV_DIM; c += 256) out[OUT_SC + ((size_t)b * 3 + r) * CONV_DIM + c] = row[O_XBC + c]; }
        }
    }
}

#define SSD_CH 32
__device__ __forceinline__ void ph_ssd_naive(float* lds, const float* __restrict__ xbc_act, const float* __restrict__ dtv, const float* __restrict__ a_log,
                                             const float* __restrict__ d_skip, const float* __restrict__ state_ssm, float* __restrict__ ybuf, float* __restrict__ out) {
    float (*sx)[64] = (float (*)[64])lds;
    float (*sB)[128] = (float (*)[128])(lds + SSD_CH * 64);
    float (*sC)[128] = (float (*)[128])(lds + SSD_CH * 64 + SSD_CH * 128);
    float* sdt = lds + SSD_CH * 64 + 2 * SSD_CH * 128;
    const int tid = threadIdx.x, p = tid >> 3, ng = tid & 7;
    for (int vb = blockIdx.x; vb < (BATCH + DEC_BATCH) * SSD_HEADS; vb += gridDim.x) {
        const int seq = vb / SSD_HEADS, h = vb % SSD_HEADS, g = h / 6;
        const bool is_p = seq < BATCH;
        const int L = is_p ? SEQ : DEC_SEQ;
        const int t0 = is_p ? seq * SEQ : T_PROMPT + (seq - BATCH) * DEC_SEQ;
        const float A = -__expf(a_log[h]);
        const float D = d_skip[h];
        float hs[16];
        if (is_p) {
#pragma unroll
            for (int j = 0; j < 16; ++j) hs[j] = 0.f;
        } else {
            const float* s0 = state_ssm + (((size_t)(seq - BATCH) * SSD_HEADS + h) * 64 + p) * 128 + ng * 16;
#pragma unroll
            for (int j = 0; j < 16; ++j) hs[j] = s0[j];
        }
        for (int c0 = 0; c0 < L; c0 += SSD_CH) {
            const int nst = (L - c0) < SSD_CH ? (L - c0) : SSD_CH;
            __syncthreads();
            for (int idx = tid; idx < nst * 64; idx += NTHR) { int s = idx >> 6, c = idx & 63; sx[s][c] = xbc_act[(size_t)(t0 + c0 + s) * CONV_DIM + h * 64 + c]; }
            for (int idx = tid; idx < nst * 128; idx += NTHR) { int s = idx >> 7, c = idx & 127;
                sB[s][c] = xbc_act[(size_t)(t0 + c0 + s) * CONV_DIM + 1536 + g * 128 + c];
                sC[s][c] = xbc_act[(size_t)(t0 + c0 + s) * CONV_DIM + 2048 + g * 128 + c]; }
            if (tid < nst) sdt[tid] = dtv[(size_t)(t0 + c0 + tid) * SSD_HEADS + h];
            __syncthreads();
            for (int s = 0; s < nst; ++s) {
                const float dt = sdt[s], x = sx[s][p];
                const float a = __expf(dt * A), xdt = x * dt;
                float y = 0.f;
#pragma unroll
                for (int j = 0; j < 16; ++j) { hs[j] = a * hs[j] + xdt * sB[s][ng * 16 + j]; y += sC[s][ng * 16 + j] * hs[j]; }
                y += __shfl_xor(y, 1); y += __shfl_xor(y, 2); y += __shfl_xor(y, 4);
                if (ng == 0) ybuf[(size_t)(t0 + c0 + s) * MIX_WIDTH + h * 64 + p] = y + D * x;
            }
        }
        float* so = is_p ? out + OUT_PS + (((size_t)seq * SSD_HEADS + h) * 64 + p) * 128 + ng * 16
                         : out + OUT_SS + (((size_t)(seq - BATCH) * SSD_HEADS + h) * 64 + p) * 128 + ng * 16;
#pragma unroll
        for (int j = 0; j < 16; ++j) so[j] = hs[j];
    }
}

__device__ __forceinline__ void ph_gate_norm(const float* __restrict__ proj, const float* __restrict__ norm_g, const float* __restrict__ ybuf, bf16* __restrict__ A1) {
    const int w = threadIdx.x >> 6, lane = threadIdx.x & 63, g = w & 3;
    for (int t = 2 * blockIdx.x + (w >> 2); t < T_ALL; t += 2 * gridDim.x) {
        float v[6]; float ss = 0.f;
#pragma unroll
        for (int j = 0; j < 6; ++j) {
            int c = g * 384 + j * 64 + lane;
            float y = ybuf[(size_t)t * MIX_WIDTH + c], z = proj[(size_t)t * PROJ_LD + O_Z + c];
            v[j] = y * silu_f(z); ss += v[j] * v[j];
        }
        ss = wave_sum(ss);
        const float r = rsqrtf(ss * (1.0f / 384.0f) + LN_EPS);
#pragma unroll
        for (int j = 0; j < 6; ++j) { int c = g * 384 + j * 64 + lane; A1[(size_t)t * MIX_WIDTH + c] = (bf16)f2bf(v[j] * r * norm_g[c]); }
#pragma unroll
        for (int j = 0; j < 2; ++j) { int c = SSD_WIDTH + g * 128 + j * 64 + lane; A1[(size_t)t * MIX_WIDTH + c] = (bf16)f2bf(ybuf[(size_t)t * MIX_WIDTH + c]); }
    }
}

__device__ __forceinline__ void ph_attn_naive(float* lds, const float* __restrict__ proj, const float* __restrict__ qrot, const float* __restrict__ krot,
                                              const float* __restrict__ ck, const float* __restrict__ cv, float* __restrict__ ybuf) {
    float (*sq)[64] = (float (*)[64])lds;
    const int w = threadIdx.x >> 6, lane = threadIdx.x & 63;
    for (int vb = blockIdx.x; vb < T_ALL * 8 / NWAVE; vb += gridDim.x) {
        const int item = vb * NWAVE + w;
        const int t = item >> 3, h = item & 7;
        const bool is_p = t < T_PROMPT;
        int b, i;
        if (is_p) { b = t / SEQ; i = t % SEQ; } else { int ts = t - T_PROMPT; b = ts / DEC_SEQ; i = ts % DEC_SEQ; }
        __syncthreads();
        sq[w][lane] = qrot[(size_t)t * ATT_WIDTH + h * 64 + lane];
        __syncthreads();
        const int qi = is_p ? i : WBUF + i;
        float sc[3][3];
        float mx = -INFINITY;
#pragma unroll
        for (int pt = 0; pt < 3; ++pt) {
            const int d = pt == 0 ? 1 : (pt == 1 ? 4 : 16);
#pragma unroll
            for (int sl = 0; sl < 3; ++sl) {
                const int m = lane + sl * 64;
                float s = -INFINITY;
                const int kj = qi - d * m;
                if (m <= 128 && kj >= 0) {
                    const float* kr;
                    if (is_p) kr = krot + (size_t)(b * SEQ + kj) * ATT_WIDTH + h * 64;
                    else kr = (kj >= WBUF) ? krot + (size_t)(T_PROMPT + b * DEC_SEQ + (kj - WBUF)) * ATT_WIDTH + h * 64
                                           : ck + ((size_t)b * WBUF + kj) * ATT_WIDTH + h * 64;
                    float a = 0.f;
#pragma unroll
                    for (int c = 0; c < 64; c += 4) { float4 kv = *(const float4*)(kr + c); a += kv.x * sq[w][c] + kv.y * sq[w][c + 1] + kv.z * sq[w][c + 2] + kv.w * sq[w][c + 3]; }
                    s = a * 0.125f;
                }
                sc[pt][sl] = s; mx = fmaxf(mx, s);
            }
        }
        mx = wave_max(mx);
        float lsum = 0.f;
#pragma unroll
        for (int pt = 0; pt < 3; ++pt)
#pragma unroll
            for (int sl = 0; sl < 3; ++sl) { float pv = (sc[pt][sl] == -INFINITY) ? 0.f : __expf(sc[pt][sl] - mx); sc[pt][sl] = pv; lsum += pv; }
        lsum = wave_sum(lsum);
        float o = 0.f;
#pragma unroll
        for (int pt = 0; pt < 3; ++pt) {
            const int d = pt == 0 ? 1 : (pt == 1 ? 4 : 16);
#pragma unroll
            for (int sl = 0; sl < 3; ++sl) {
                const int mend = sl < 2 ? 64 : 1;
                for (int ml = 0; ml < mend; ++ml) {
                    const int m = ml + sl * 64;
                    const int kj = qi - d * m;
                    const float pv = __shfl(sc[pt][sl], ml);
                    if (kj < 0) continue;
                    const float* vr;
                    if (is_p) vr = proj + (size_t)(b * SEQ + kj) * PROJ_LD + O_V + h * 64;
                    else vr = (kj >= WBUF) ? proj + (size_t)(T_PROMPT + b * DEC_SEQ + (kj - WBUF)) * PROJ_LD + O_V + h * 64
                                           : cv + ((size_t)b * WBUF + kj) * ATT_WIDTH + h * 64;
                    o += pv * vr[lane];
                }
            }
        }
        ybuf[(size_t)t * MIX_WIDTH + SSD_WIDTH + h * 64 + lane] = o / lsum;
    }
}

__device__ __forceinline__ void ph_ln_res(const float* __restrict__ res, const float* __restrict__ add, const float* __restrict__ gam,
                                          const float* __restrict__ bet, float* __restrict__ dst, bf16* __restrict__ dstb) {
    const int lane = threadIdx.x & 63;
    for (int t = blockIdx.x * NWAVE + (threadIdx.x >> 6); t < T_ALL; t += gridDim.x * NWAVE) {
        float v[16]; float s = 0.f;
#pragma unroll
        for (int j = 0; j < 16; ++j) { int c = j * 64 + lane; v[j] = ALPHA_F * res[(size_t)t * D_MODEL + c] + add[(size_t)t * D_MODEL + c]; s += v[j]; }
        s = wave_sum(s);
        const float mu = s * (1.0f / 1024.0f);
        float q = 0.f;
#pragma unroll
        for (int j = 0; j < 16; ++j) { v[j] -= mu; q += v[j] * v[j]; }
        q = wave_sum(q);
        const float r = rsqrtf(q * (1.0f / 1024.0f) + LN_EPS);
#pragma unroll
        for (int j = 0; j < 16; ++j) { int c = j * 64 + lane; float o = v[j] * r * gam[c] + bet[c]; dst[(size_t)t * D_MODEL + c] = o; dstb[(size_t)t * D_MODEL + c] = (bf16)f2bf(o); }
    }
}

__device__ __forceinline__ void ph_peer_route(float* lds, const float* __restrict__ qh, const float* __restrict__ keys1, const float* __restrict__ keys2,
                                              int* __restrict__ eidx, float* __restrict__ gate) {
    float (*sq)[256] = (float (*)[256])lds;
    float (*sv)[2][16] = (float (*)[2][16])(lds + NWAVE * 256);
    int (*si)[2][16] = (int (*)[2][16])(lds + NWAVE * 256 + NWAVE * 32);
    const int w = threadIdx.x >> 6, lane = threadIdx.x & 63;
    for (int vb = blockIdx.x; vb < T_ALL * 8 / NWAVE; vb += gridDim.x) {
        const int item = vb * NWAVE + w;
        const int t = item >> 3, h = item & 7;
        __syncthreads();
        for (int c = lane; c < 256; c += 64) sq[w][c] = qh[(size_t)t * 2048 + h * 256 + c];
        __syncthreads();
#pragma unroll
        for (int half = 0; half < 2; ++half) {
            const float* keys = half ? keys2 : keys1;
            float s[2];
#pragma unroll
            for (int sl = 0; sl < 2; ++sl) {
                const float* kr = keys + (size_t)(lane + sl * 64) * 128;
                float a = 0.f;
#pragma unroll 8
                for (int c = 0; c < 128; c += 4) { float4 kv = *(const float4*)(kr + c); const float* qq = &sq[w][half * 128 + c]; a += kv.x * qq[0] + kv.y * qq[1] + kv.z * qq[2] + kv.w * qq[3]; }
                s[sl] = a;
            }
            for (int r = 0; r < 16; ++r) {
                float bv; int bi;
                if (s[0] >= s[1]) { bv = s[0]; bi = lane; } else { bv = s[1]; bi = lane + 64; }
#pragma unroll
                for (int o = 32; o > 0; o >>= 1) {
                    float ov = __shfl_xor(bv, o); int oi = __shfl_xor(bi, o);
                    if (ov > bv || (ov == bv && oi < bi)) { bv = ov; bi = oi; }
                }
                if (lane == 0) { sv[w][half][r] = bv; si[w][half][r] = bi; }
                if (bi == lane) s[0] = -INFINITY;
                if (bi == lane + 64) s[1] = -INFINITY;
            }
        }
        __syncthreads();
        float c[4];
#pragma unroll
        for (int j = 0; j < 4; ++j) { int ci = lane * 4 + j; c[j] = sv[w][0][ci >> 4] + sv[w][1][ci & 15]; }
        float myv = 0.f; int myc = 0;
        for (int r = 0; r < 16; ++r) {
            float bv = c[0]; int bi = lane * 4;
#pragma unroll
            for (int j = 1; j < 4; ++j) if (c[j] > bv) { bv = c[j]; bi = lane * 4 + j; }
#pragma unroll
            for (int o = 32; o > 0; o >>= 1) {
                float ov = __shfl_xor(bv, o); int oi = __shfl_xor(bi, o);
                if (ov > bv || (ov == bv && oi < bi)) { bv = ov; bi = oi; }
            }
            if (lane == r) { myv = bv; myc = bi; }
#pragma unroll
            for (int j = 0; j < 4; ++j) if (bi == lane * 4 + j) c[j] = -INFINITY;
        }
        float v = lane < 16 ? myv : -INFINITY;
        float mx = wave_max(v);
        float e = lane < 16 ? __expf(v - mx) : 0.f;
        float sum = wave_sum(e);
        if (lane < 16) {
            int ex = si[w][0][myc >> 4] * PEER_NKEYS + si[w][1][myc & 15];
            eidx[(size_t)t * 128 + h * 16 + lane] = ex;
            gate[(size_t)t * 128 + h * 16 + lane] = e / sum;
        }
    }
}

__device__ __forceinline__ void ph_peer_ffn(const float* __restrict__ hbuf, const int* __restrict__ eidx, const float* __restrict__ gate,
                                            const float* __restrict__ ut, const float* __restrict__ vt, const float* __restrict__ gam,
                                            const float* __restrict__ bet, float* __restrict__ out) {
    const int lane = threadIdx.x & 63;
    for (int t = blockIdx.x * NWAVE + (threadIdx.x >> 6); t < T_ALL; t += gridDim.x * NWAVE) {
        float4 x[4], acc[4];
#pragma unroll
        for (int j = 0; j < 4; ++j) { x[j] = *(const float4*)(hbuf + (size_t)t * D_MODEL + j * 256 + lane * 4); acc[j] = make_float4(0.f, 0.f, 0.f, 0.f); }
        for (int k = 0; k < 128; ++k) {
            const int e = eidx[(size_t)t * 128 + k];
            const float g = gate[(size_t)t * 128 + k];
            const float* ur = ut + (size_t)e * D_MODEL;
            float d = 0.f;
#pragma unroll
            for (int j = 0; j < 4; ++j) { float4 u4 = *(const float4*)(ur + j * 256 + lane * 4); d += u4.x * x[j].x + u4.y * x[j].y + u4.z * x[j].z + u4.w * x[j].w; }
            d = wave_sum(d);
            const float wgt = g * gelu_f(d);
            const float* vr = vt + (size_t)e * D_MODEL;
#pragma unroll
            for (int j = 0; j < 4; ++j) { float4 v4 = *(const float4*)(vr + j * 256 + lane * 4); acc[j].x += wgt * v4.x; acc[j].y += wgt * v4.y; acc[j].z += wgt * v4.z; acc[j].w += wgt * v4.w; }
        }
        float s = 0.f;
#pragma unroll
        for (int j = 0; j < 4; ++j) { acc[j].x += ALPHA_F * x[j].x; acc[j].y += ALPHA_F * x[j].y; acc[j].z += ALPHA_F * x[j].z; acc[j].w += ALPHA_F * x[j].w; s += acc[j].x + acc[j].y + acc[j].z + acc[j].w; }
        s = wave_sum(s);
        const float mu = s * (1.0f / 1024.0f);
        float q = 0.f;
#pragma unroll
        for (int j = 0; j < 4; ++j) { acc[j].x -= mu; acc[j].y -= mu; acc[j].z -= mu; acc[j].w -= mu; q += acc[j].x * acc[j].x + acc[j].y * acc[j].y + acc[j].z * acc[j].z + acc[j].w * acc[j].w; }
        q = wave_sum(q);
        const float r = rsqrtf(q * (1.0f / 1024.0f) + LN_EPS);
        float* dst = (t < T_PROMPT) ? out + OUT_YP + (size_t)t * D_MODEL : out + OUT_YS + (size_t)(t - T_PROMPT) * D_MODEL;
#pragma unroll
        for (int j = 0; j < 4; ++j) {
            float4 g4 = *(const float4*)(gam + j * 256 + lane * 4), b4 = *(const float4*)(bet + j * 256 + lane * 4);
            float4 o; o.x = acc[j].x * r * g4.x + b4.x; o.y = acc[j].y * r * g4.y + b4.y; o.z = acc[j].z * r * g4.z + b4.z; o.w = acc[j].w * r * g4.w + b4.w;
            *(float4*)(dst + j * 256 + lane * 4) = o;
        }
    }
}

struct Params {
    const float* in[23];
    float* out;
    unsigned char* ws;
    unsigned* bar;
};

#define WS_BAR      0ull
#define WS_XALL     (1ull << 20)
#define WS_PROJ     (WS_XALL + (size_t)T_ALL * D_MODEL * 4)
#define WS_XBC      (WS_PROJ + (size_t)T_ALL * PROJ_LD * 4)
#define WS_DT       (WS_XBC + (size_t)T_ALL * CONV_DIM * 4)
#define WS_QROT     (WS_DT + (size_t)T_ALL * SSD_HEADS * 4)
#define WS_KROT     (WS_QROT + (size_t)T_ALL * ATT_WIDTH * 4)
#define WS_YBUF     (WS_KROT + (size_t)T_ALL * ATT_WIDTH * 4)
#define WS_MIX      (WS_YBUF + (size_t)T_ALL * MIX_WIDTH * 4)
#define WS_HBUF     (WS_MIX + (size_t)T_ALL * D_MODEL * 4)
#define WS_QH       (WS_HBUF + (size_t)T_ALL * D_MODEL * 4)
#define WS_EIDX     (WS_QH + (size_t)T_ALL * 2048 * 4)
#define WS_GATE     (WS_EIDX + (size_t)T_ALL * 128 * 4)
#define WS_A0       (WS_GATE + (size_t)T_ALL * 128 * 4)
#define WS_A1       (WS_A0 + (size_t)T_ALL * D_MODEL * 2)
#define WS_A2       (WS_A1 + (size_t)T_ALL * MIX_WIDTH * 2)
#define WS_WTIN     (WS_A2 + (size_t)T_ALL * D_MODEL * 2)
#define WS_WTOUT    (WS_WTIN + (size_t)PROJ_LD * D_MODEL * 2)
#define WS_WTQ      (WS_WTOUT + (size_t)D_MODEL * MIX_WIDTH * 2)
#define WS_END      (WS_WTQ + (size_t)2048 * D_MODEL * 2)

#define LDS_BYTES (144 * 1024)

__global__ void __launch_bounds__(512, 2) mega_fwd(Params p) {
    extern __shared__ __attribute__((aligned(16))) unsigned char smem[];
    if (threadIdx.x == 0) *(uint4*)smem = make_uint4(0u, 0u, 0u, 0u);
    __syncthreads();
    XcdBarrier bar = xcd_barrier_post(p.bar, (volatile LAS unsigned*)smem);
    float* lds = (float*)(smem + 256);

    const float* x_prompt = p.in[0]; const float* x_sample = p.in[1]; const float* cache_k = p.in[2]; const float* cache_v = p.in[3];
    const float* state_conv = p.in[4]; const float* state_ssm = p.in[5]; const float* w_in = p.in[6]; const float* conv_w = p.in[7];
    const float* conv_b = p.in[8]; const float* dt_bias = p.in[9]; const float* a_log = p.in[10]; const float* d_skip = p.in[11];
    const float* norm_g = p.in[12]; const float* w_out = p.in[13]; const float* ln1_g = p.in[14]; const float* ln1_b = p.in[15];
    const float* peer_wq = p.in[16]; const float* keys1 = p.in[17]; const float* keys2 = p.in[18]; const float* peer_u = p.in[19];
    const float* peer_v = p.in[20]; const float* ln2_g = p.in[21]; const float* ln2_b = p.in[22];
    float* out = p.out;
    float* xall = (float*)(p.ws + WS_XALL); float* proj = (float*)(p.ws + WS_PROJ); float* xbc_act = (float*)(p.ws + WS_XBC);
    float* dtv = (float*)(p.ws + WS_DT); float* qrot = (float*)(p.ws + WS_QROT); float* krot = (float*)(p.ws + WS_KROT);
    float* ybuf = (float*)(p.ws + WS_YBUF); float* mix = (float*)(p.ws + WS_MIX); float* hbuf = (float*)(p.ws + WS_HBUF);
    float* qh = (float*)(p.ws + WS_QH); int* eidx = (int*)(p.ws + WS_EIDX); float* gate = (float*)(p.ws + WS_GATE);
    bf16* A0 = (bf16*)(p.ws + WS_A0); bf16* A1 = (bf16*)(p.ws + WS_A1); bf16* A2 = (bf16*)(p.ws + WS_A2);
    bf16* wt_in = (bf16*)(p.ws + WS_WTIN); bf16* wt_out = (bf16*)(p.ws + WS_WTOUT); bf16* wt_q = (bf16*)(p.ws + WS_WTQ);
    LAS unsigned char* ldsb = (LAS unsigned char*)smem + 256;

    ph_concat_x(x_prompt, x_sample, xall);
    ph_prologue(ldsb, x_prompt, x_sample, A0, w_in, wt_in, w_out, wt_out, peer_wq, wt_q);
    ph_cache_copy(cache_k, cache_v, out);
    xcd_barrier(bar);
    { pg8::Gemm g{A0, wt_in, T_ALL, PROJ_LD, D_MODEL}; pg8::StaticOrder S; S.init(g.M, g.N, (int)gridDim.x, (int)blockIdx.x);
      pg8::EpiF32 E{proj, PROJ_LD, nullptr}; pg8::gemm_phase<pg8::EpiF32, pg8::StaticOrder, false>(ldsb, g, S, E, nullptr); }
    xcd_barrier(bar);
    ph_post_proj(proj, state_conv, conv_w, conv_b, dt_bias, xbc_act, dtv, qrot, krot, out);
    xcd_barrier(bar);
    ph_ssd_naive(lds, xbc_act, dtv, a_log, d_skip, state_ssm, ybuf, out);
    ph_attn_naive(lds, proj, qrot, krot, cache_k, cache_v, ybuf);
    xcd_barrier(bar);
    ph_gate_norm(proj, norm_g, ybuf, A1);
    xcd_barrier(bar);
    { pg8::Gemm g{A1, wt_out, T_ALL, D_MODEL, MIX_WIDTH}; pg8::StaticOrder S; S.init(g.M, g.N, (int)gridDim.x, (int)blockIdx.x);
      pg8::EpiF32 E{mix, D_MODEL, nullptr}; pg8::gemm_phase<pg8::EpiF32, pg8::StaticOrder, false>(ldsb, g, S, E, nullptr); }
    xcd_barrier(bar);
    ph_ln_res(xall, mix, ln1_g, ln1_b, hbuf, A2);
    xcd_barrier(bar);
    { pg8::Gemm g{A2, wt_q, T_ALL, 2048, D_MODEL}; pg8::StaticOrder S; S.init(g.M, g.N, (int)gridDim.x, (int)blockIdx.x);
      pg8::EpiF32 E{qh, 2048, nullptr}; pg8::gemm_phase<pg8::EpiF32, pg8::StaticOrder, false>(ldsb, g, S, E, nullptr); }
    xcd_barrier(bar);
    ph_peer_route(lds, qh, keys1, keys2, eidx, gate);
    xcd_barrier(bar);
    ph_peer_ffn(hbuf, eidx, gate, peer_u, peer_v, ln2_g, ln2_b, out);
}

extern "C" void kernel_launch(void* const* d_in, const int* in_sizes, int n_in, void* d_out, int out_size, void* d_ws, size_t ws_size, hipStream_t stream) {
    static int grid = 0;
    if (grid == 0) {
        int dev = 0, cus = 0, per_cu = 0;
        if (hipGetDevice(&dev) != hipSuccess || hipDeviceGetAttribute(&cus, hipDeviceAttributeMultiprocessorCount, dev) != hipSuccess) { fprintf(stderr, "kernel_launch: device query failed\n"); grid = -1; return; }
        if (hipFuncSetAttribute((const void*)mega_fwd, hipFuncAttributeMaxDynamicSharedMemorySize, LDS_BYTES) != hipSuccess) { fprintf(stderr, "kernel_launch: hipFuncSetAttribute failed\n"); grid = -1; return; }
        if (hipOccupancyMaxActiveBlocksPerMultiprocessor(&per_cu, (const void*)mega_fwd, NTHR, LDS_BYTES) != hipSuccess || per_cu < 1) { fprintf(stderr, "kernel_launch: occupancy query says %d\n", per_cu); }
        (void)hipGetLastError();
        grid = cus;
        if (ws_size < WS_END) { fprintf(stderr, "kernel_launch: workspace too small\n"); grid = -1; return; }
    }
    if (grid < 0) return;
    (void)hipMemsetAsync((char*)d_ws + WS_BAR, 0, XCD_BAR_WORDS * sizeof(unsigned), stream);
    Params p{};
    for (int i = 0; i < 23; ++i) p.in[i] = (const float*)d_in[i];
    p.out = (float*)d_out; p.ws = (unsigned char*)d_ws; p.bar = (unsigned*)((char*)d_ws + WS_BAR);
    hipLaunchKernelGGL(mega_fwd, dim3(grid), dim3(NTHR), LDS_BYTES, stream, p);
}
```

```cpp
#include <hip/hip_runtime.h>
#include <stdint.h>

#define D_MODEL 1024
#define BATCH 2
#define SEQ 8192
#define DEC_BATCH 128
#define DEC_SEQ 4
#define PAST_LEN 8192
#define HEAD_DIM 64
#define ATT_WIDTH 512
#define ATT_HEADS 8
#define SSD_WIDTH 1536
#define SSD_HEADS 24
#define SSD_GROUPS 4
#define SSD_STATE 128
#define CONV_DIM 2560
#define IN_WIDTH 5656
#define PROJ_LD 5888
#define MIX_WIDTH 2048
#define WBUF 2048
#define PEER_NKEYS 128
#define PEER_HEADS 8
#define PEER_TOPK 16
#define PEER_DKEY 256
#define T_PROMPT (BATCH * SEQ)
#define T_SAMPLE (DEC_BATCH * DEC_SEQ)
#define T_ALL (T_PROMPT + T_SAMPLE)
#define O_Z 0
#define O_XBC 1536
#define O_DT 4096
#define O_Q 4120
#define O_K 4632
#define O_V 5144
#define ALPHA_F 1.189207115002721f
#define LN_EPS 1e-5f

#define OUT_YP 0ull
#define OUT_YS (OUT_YP + 16777216ull)
#define OUT_PK (OUT_YS + 524288ull)
#define OUT_PV (OUT_PK + 2097152ull)
#define OUT_PC (OUT_PV + 2097152ull)
#define OUT_PS (OUT_PC + 15360ull)
#define OUT_SK (OUT_PS + 393216ull)
#define OUT_SV (OUT_SK + 134217728ull)
#define OUT_SC (OUT_SV + 134217728ull)
#define OUT_SS (OUT_SC + 983040ull)

__constant__ double ROPE_INV_REV[32] = {
    1.59154943091895346e-01, 1.19349370211248862e-01, 8.94994016088910133e-02, 6.71150830052272551e-02,
    5.03292121044870353e-02, 3.77415847174197711e-02, 2.83021958306233987e-02, 2.12236527647776604e-02,
    1.59154943091895339e-02, 1.19349370211248862e-02, 8.94994016088910237e-03, 6.71150830052272534e-03,
    5.03292121044870370e-03, 3.77415847174197719e-03, 2.83021958306233987e-03, 2.12236527647776622e-03,
    1.59154943091895356e-03, 1.19349370211248849e-03, 8.94994016088910237e-04, 6.71150830052272599e-04,
    5.03292121044870326e-04, 3.77415847174197741e-04, 2.83021958306233954e-04, 2.12236527647776605e-04,
    1.59154943091895351e-04, 1.19349370211248862e-04, 8.94994016088910182e-05, 6.71150830052272545e-05,
    5.03292121044870354e-05, 3.77415847174197768e-05, 2.83021958306233961e-05, 2.12236527647776592e-05
};

__device__ __forceinline__ float silu_f(float x) { return x / (1.0f + __expf(-x)); }
__device__ __forceinline__ float softplus_f(float x) { return fmaxf(x, 0.f) + log1pf(__expf(-fabsf(x))); }
__device__ __forceinline__ float gelu_f(float x) { return 0.5f * x * (1.0f + erff(x * 0.70710678118654752f)); }
__device__ __forceinline__ float wave_sum(float v) {
#pragma unroll
    for (int o = 32; o > 0; o >>= 1) v += __shfl_xor(v, o);
    return v;
}
__device__ __forceinline__ float wave_max(float v) {
#pragma unroll
    for (int o = 32; o > 0; o >>= 1) v = fmaxf(v, __shfl_xor(v, o));
    return v;
}

#include <cstdio>
#define XB_TMO      128
#define XB_XCNT(j)  (256  + 64 * (j))
#define XB_XSUB(j)  (1280 + 64 * (j))
#define XB_XGEN(j)  (2304 + 64 * (j))
#define XB_TOP      3328
#define XB_TOPGEN   3392
#define XCD_BAR_WORDS 3456
#define XB_SPIN_CAP (1u << 18)
#define LAS __attribute__((address_space(3)))

__device__ __forceinline__ unsigned xb_ld(unsigned* p)              { return __hip_atomic_load(p, __ATOMIC_RELAXED, __HIP_MEMORY_SCOPE_AGENT); }
__device__ __forceinline__ unsigned xb_add(unsigned* p, unsigned v) { return __hip_atomic_fetch_add(p, v, __ATOMIC_RELAXED, __HIP_MEMORY_SCOPE_AGENT); }
__device__ __forceinline__ unsigned xb_xcc_id() { return (unsigned)__builtin_amdgcn_s_getreg((3 << 11) | 20) & 0xFu; }
#define XB_SPIN(cond, bar) do { unsigned _sp = 0; while (cond) { __builtin_amdgcn_s_sleep(1); \
    if ((++_sp & 255u) == 0u) { if (xb_ld(&(bar)[XB_TMO])) break; if (_sp > XB_SPIN_CAP) { atomicAdd(&(bar)[XB_TMO], 1u); break; } } } } while (0)

struct XcdBarrier {
    unsigned* bar; unsigned x;
    volatile LAS unsigned* st;
};

__device__ __forceinline__ XcdBarrier xcd_barrier_post(unsigned* bar, volatile LAS unsigned* st) {
    XcdBarrier b; b.bar = bar; b.x = xb_xcc_id(); b.st = st;
    if (threadIdx.x == 0) (void)xb_add(&bar[XB_XCNT(b.x)], 1u);
    return b;
}
__device__ __forceinline__ void xcd_barrier_complete(unsigned* bar, unsigned x, unsigned& nloc, unsigned& nx) {
    const unsigned G = gridDim.x * gridDim.y * gridDim.z;
    unsigned sum, cnt, mine, sp = 0u;
    for (;;) {
        sum = 0u; cnt = 0u; mine = 0u;
#pragma unroll
        for (unsigned j = 0; j < 16; ++j) { const unsigned c = xb_ld(&bar[XB_XCNT(j)]); sum += c; cnt += (c > 0u) ? 1u : 0u; mine = (j == x) ? c : mine; }
        if (sum == G) break;
        __builtin_amdgcn_s_sleep(1);
        if ((++sp & 255u) == 0u) { if (xb_ld(&bar[XB_TMO])) break; if (sp > XB_SPIN_CAP) { atomicAdd(&bar[XB_TMO], 1u); break; } }
    }
    nloc = mine > 0u ? mine : 1u; nx = cnt > 0u ? cnt : 1u;
}

__device__ __forceinline__ void xcd_barrier(const XcdBarrier& b) {
    asm volatile("s_waitcnt vmcnt(0)" ::: "memory");
    __syncthreads();
    if (threadIdx.x == 0) {
        unsigned* bar = b.bar;
        __builtin_amdgcn_s_waitcnt(0);
        unsigned nloc = b.st[0], nx = b.st[1];
        if (nloc == 0u) { xcd_barrier_complete(bar, b.x, nloc, nx); b.st[0] = nloc; b.st[1] = nx; }
        const unsigned old = xb_add(&bar[XB_XSUB(b.x)], 1u);
        const unsigned gen = old / nloc;
        if (old + 1u == (gen + 1u) * nloc) {
            __builtin_amdgcn_fence(__ATOMIC_RELEASE, "agent");
            asm volatile("s_waitcnt vmcnt(0)" ::: "memory");
            const unsigned og = xb_add(&bar[XB_TOP], 1u);
            const unsigned tg = og / nx;
            if (og + 1u == (tg + 1u) * nx) xb_add(&bar[XB_TOPGEN], 1u);
            else XB_SPIN(xb_ld(&bar[XB_TOPGEN]) == tg, bar);
            __builtin_amdgcn_fence(__ATOMIC_ACQUIRE, "agent");
            xb_add(&bar[XB_XGEN(b.x)], 1u);
            asm volatile("s_waitcnt vmcnt(0)" ::: "memory");
        } else {
            XB_SPIN(xb_ld(&bar[XB_XGEN(b.x)]) == gen, bar);
            __builtin_amdgcn_fence(__ATOMIC_ACQUIRE, "agent");
            asm volatile("s_waitcnt vmcnt(0)" ::: "memory");
        }
    }
    __syncthreads();
}


#define GAS __attribute__((address_space(1)))
typedef unsigned short bf16;
typedef unsigned v4u __attribute__((ext_vector_type(4)));
#define LDS_WAIT() asm volatile("s_waitcnt lgkmcnt(0)" ::: "memory")
__device__ __forceinline__ unsigned f2bf(float f) { unsigned u = __builtin_bit_cast(unsigned, f); return (u + 0x7fffu + ((u >> 16) & 1u)) >> 16; }
__device__ __forceinline__ unsigned pk2(float lo, float hi) { return f2bf(lo) | (f2bf(hi) << 16); }
__device__ __forceinline__ float bf2f(unsigned short b) { return __builtin_bit_cast(float, (unsigned)b << 16); }
#include <hip/hip_runtime.h>
namespace pg8 {
#define PG8_LAS __attribute__((address_space(3)))
typedef unsigned short bf16_t;
typedef short bf16x8 __attribute__((ext_vector_type(8)));
typedef float f32x4 __attribute__((ext_vector_type(4)));
typedef unsigned u32x4 __attribute__((ext_vector_type(4)));
constexpr int BM = 256, BK = 64, HALF = 128, HTB = HALF * BK * 2  , STAGE_BYTES = 8 * HTB, NXCD = 8, WGM = 8;

__host__ __device__ __forceinline__ int lds_byte(int r, int c) { const int st = (r >> 4) * 2 + (c >> 5), rr = r & 15, cc = c & 31, ob = rr * 64 + cc * 2; return st * 1024 + (ob ^ (((ob >> 9) & 1) << 5)); }
__host__ __device__ __forceinline__ void stage_rc(int b, int& R, int& C) { const int st = b / 1024, sb = b % 1024, swz = sb ^ (((sb >> 9) & 1) << 5); R = (st >> 1) * 16 + swz / 64; C = (st & 1) * 32 + (swz % 64) / 2; }
__host__ __device__ __forceinline__ int perm32(int rho) { const int n = rho >> 4, i = rho & 15; return 8 * (i >> 2) + 4 * n + (i & 3); }

struct Unit { int pm, pn; };
struct Gemm { const bf16_t* A; const bf16_t* Bt; int M, N, K; };

struct StaticOrder {
    int nM, nN, nwg, G, c;
    __host__ __device__ void init(int M, int N, int G_, int c_) { nM = M / BM; nN = N / BM; nwg = nM * nN; G = G_; c = c_; }
    __host__ __device__ bool next(int i, Unit& u) const {
        const long L = (long)i * G + c; if (L >= nwg) return false;
        int wgid = (int)L; { const int q = nwg / NXCD, r = nwg % NXCD, xcd = wgid % NXCD, off = wgid / NXCD; wgid = (xcd < r ? xcd * (q + 1) : r * (q + 1) + (xcd - r) * q) + off; }
        const int nig = WGM * nN, gid = wgid / nig, fm = gid * WGM, gsz = (nM - fm) < WGM ? (nM - fm) : WGM;
        u.pm = fm + ((wgid % nig) % gsz); u.pn = (wgid % nig) / gsz; return true;
    }
    __device__ __forceinline__ void a_ready(const Unit&) const {}
    __device__ __forceinline__ void done(const Unit&) const {}
};
__device__ __forceinline__ unsigned cvt_pk_bf16(float lo, float hi) { unsigned r; asm volatile("v_cvt_pk_bf16_f32 %0, %1, %2" : "=v"(r) : "v"(lo), "v"(hi)); return r; }
typedef float f32x2 __attribute__((ext_vector_type(2)));
__device__ __forceinline__ f32x2 gelu_pk(f32x2 v) {
    const f32x2 av = __builtin_elementwise_abs(v), d = av * 0.2316418882f + 1.0f;
    f32x2 t; t.x = __builtin_amdgcn_rcpf(d.x); t.y = __builtin_amdgcn_rcpf(d.y);
    f32x2 q = t * 0.5307027145f + (-0.7265760135f); q = q * t + 0.7107068705f; q = q * t + (-0.142248368f); q = q * t + 0.127414796f; q = q * t;
    const f32x2 s = (v * v) * (-0.72134752044f);
    f32x2 e; e.x = __builtin_amdgcn_exp2f(s.x); e.y = __builtin_amdgcn_exp2f(s.y);
    const f32x2 m = v * (q * e), r = v - m;
    f32x2 o; o.x = v.x < 0.f ? m.x : r.x; o.y = v.y < 0.f ? m.y : r.y; return o;
}

struct EpiF32 {
    static constexpr bool PERM = false, AFTER_DRAIN = false;
    float* C; int ldc; const float* bias;
    __device__ __forceinline__ void operator()(const f32x4 (&acc)[2][2][4][2], const Unit& u, int wr, int wc, int fr, int fq) const {
        const int row0 = u.pm * BM + wr * 64 + fr, col0 = u.pn * BM + wc * 32 + 4 * fq;
        f32x4 bv[2][2];
#pragma unroll
        for (int bj = 0; bj < 2; ++bj)
#pragma unroll
            for (int n = 0; n < 2; ++n) bv[bj][n] = bias ? *(const f32x4*)(bias + col0 + bj * HALF + n * 16) : (f32x4){0.f, 0.f, 0.f, 0.f};
#pragma unroll
        for (int ai = 0; ai < 2; ++ai)
#pragma unroll
            for (int m = 0; m < 4; ++m) { float* rowp = C + (size_t)(row0 + ai * HALF + m * 16) * ldc + col0;
#pragma unroll
                for (int bj = 0; bj < 2; ++bj)
#pragma unroll
                    for (int n = 0; n < 2; ++n) *(f32x4*)(rowp + bj * HALF + n * 16) = acc[ai][bj][m][n] + bv[bj][n]; }
    }
};

template <class Epi, class Sched, bool STAMP = false>
__device__ __forceinline__ void gemm_phase(PG8_LAS unsigned char* lds, const Gemm g, const Sched& S, const Epi& E, unsigned long long* stamps) {
    const int tid = threadIdx.x, wid = __builtin_amdgcn_readfirstlane(tid >> 6), lane = tid & 63, wr = wid >> 2, wc = wid & 3, fr = lane & 15, fq = lane >> 4;
    const int K = g.K, nt = K / BK;
    int ts_lo = 0, ts_hi = 0, nts = 0; const unsigned long long rt_entry = STAMP ? (unsigned long long)wall_clock64() : 0ull;
#define PG8_STAMP() do { if (STAMP && wid == 0 && nts < 64) { const unsigned long long _c = (unsigned long long)clock64(); \
        ts_lo = (lane == nts) ? (int)(unsigned)_c : ts_lo; ts_hi = (lane == nts) ? (int)(unsigned)(_c >> 32) : ts_hi; ++nts; } } while (0)
    PG8_STAMP();
    unsigned voffA[2], voffB[2];
#pragma unroll
    for (int i = 0; i < 2; ++i) { int R, C; stage_rc(tid * 16 + i * 8192, R, C); const int Rb = Epi::PERM ? ((R & ~31) + perm32(R & 31)) : R;
        voffA[i] = (unsigned)(R * K + C) * 2u; voffB[i] = (unsigned)(Rb * K + C) * 2u; }
    const size_t kstep = (size_t)(BK * 2);
    const size_t hstep = (size_t)HALF * K * 2;
    const size_t tstep = 2 * hstep;
    const unsigned ldsw = (unsigned)wid * 1024u;
    const int aoff = lds_byte(wr * 64 + fr, fq * 8), boff = lds_byte(wc * 32 + fr, fq * 8);
#define PG8_SA(b, h) (((b) * 2 + (h)) * HTB)
#define PG8_SB(b, h) ((4 + (b) * 2 + (h)) * HTB)
#define PG8_STAGE(bufoff, gbase, voff) do { _Pragma("unroll") for (int _i = 0; _i < 2; ++_i) \
        __builtin_amdgcn_global_load_lds((const unsigned*)((const char*)(gbase) + (voff)[_i]), (PG8_LAS unsigned*)(lds + (bufoff) + ldsw + _i * 8192), 16, 0, 0); } while (0)
#define PG8_LDA(dst, b, h) do { _Pragma("unroll") for (int m = 0; m < 4; ++m) _Pragma("unroll") for (int k = 0; k < 2; ++k) dst[m][k] = *(const PG8_LAS bf16x8*)(lds + PG8_SA(b, h) + aoff + m * 2048 + k * 1024); } while (0)
#define PG8_LDB(dst, b, h) do { _Pragma("unroll") for (int n = 0; n < 2; ++n) _Pragma("unroll") for (int k = 0; k < 2; ++k) dst[n][k] = *(const PG8_LAS bf16x8*)(lds + PG8_SB(b, h) + boff + n * 2048 + k * 1024); } while (0)
#define PG8_MMA(ai, bj, At, Bt) do { __builtin_amdgcn_s_setprio(1); _Pragma("unroll") for (int m = 0; m < 4; ++m) _Pragma("unroll") for (int n = 0; n < 2; ++n) _Pragma("unroll") for (int k = 0; k < 2; ++k) \
        acc[ai][bj][m][n] = __builtin_amdgcn_mfma_f32_16x16x32_bf16(Bt[n][k], At[m][k], acc[ai][bj][m][n], 0, 0, 0); __builtin_amdgcn_s_setprio(0); } while (0)
#define PG8_WAIT_V(n) asm volatile("s_waitcnt vmcnt(" #n ")" ::: "memory")
#define PG8_WAIT_L(n) asm volatile("s_waitcnt lgkmcnt(" #n ")" ::: "memory")
#define PG8_BAR __builtin_amdgcn_s_barrier()
#define PG8_SCHED __builtin_amdgcn_sched_barrier(0)
    Unit cur, nxt; int ui = 0;
    if (!S.next(0, cur)) return;
    f32x4 acc[2][2][4][2];
#pragma unroll
    for (int a = 0; a < 2; ++a)
#pragma unroll
        for (int b = 0; b < 2; ++b)
#pragma unroll
            for (int m = 0; m < 4; ++m)
#pragma unroll
                for (int n = 0; n < 2; ++n) acc[a][b][m][n] = (f32x4){0.f, 0.f, 0.f, 0.f};
    bf16x8 At[4][2], B0[2][2], B1[2][2];
    const char* cA = (const char*)g.A + (size_t)cur.pm * tstep; const char* cB = (const char*)g.Bt + (size_t)cur.pn * tstep;
    S.a_ready(cur);
    PG8_STAGE(PG8_SB(0, 0), cB, voffB); PG8_STAGE(PG8_SA(0, 0), cA, voffA); PG8_STAGE(PG8_SB(0, 1), cB + hstep, voffB); PG8_STAGE(PG8_SA(0, 1), cA + hstep, voffA);
    if (wr == 1) PG8_BAR;
    PG8_WAIT_V(4); PG8_BAR;
    PG8_STAGE(PG8_SB(1, 0), cB + kstep, voffB); PG8_STAGE(PG8_SA(1, 0), cA + kstep, voffA); PG8_STAGE(PG8_SB(1, 1), cB + hstep + kstep, voffB);
    PG8_WAIT_V(6); PG8_BAR;
    PG8_STAMP();
    for (;;) {
        const bool has_next = S.next(ui + 1, nxt);
        const char* nA = has_next ? (const char*)g.A + (size_t)nxt.pm * tstep : cA; const char* nB = has_next ? (const char*)g.Bt + (size_t)nxt.pn * tstep : cB;
        for (int t = 0; t < nt; t += 2) {
            const bool last = (t == nt - 2);
            const char* a1 = cA + (size_t)(t + 1) * kstep;
            const char* a2 = last ? nA : cA + (size_t)(t + 2) * kstep; const char* b2 = last ? nB : cB + (size_t)(t + 2) * kstep;
            const char* a3 = a2 + kstep; const char* b3 = b2 + kstep;
            if (last && has_next) S.a_ready(nxt);
            PG8_LDB(B0, 0, 0); PG8_SCHED; PG8_LDA(At, 0, 0); PG8_STAGE(PG8_SA(1, 1), a1 + hstep, voffA);
            PG8_WAIT_L(8); PG8_BAR; PG8_WAIT_L(0); PG8_MMA(0, 0, At, B0); PG8_BAR; PG8_SCHED;
            PG8_LDB(B1, 0, 1); PG8_STAGE(PG8_SB(0, 0), b2, voffB);
            PG8_BAR; PG8_WAIT_L(0); PG8_MMA(0, 1, At, B1); PG8_BAR;
            PG8_LDA(At, 0, 1); PG8_STAGE(PG8_SA(0, 0), a2, voffA);
            PG8_BAR; PG8_WAIT_L(0); PG8_MMA(1, 0, At, B0); PG8_BAR; PG8_SCHED;
            PG8_STAGE(PG8_SB(0, 1), b2 + hstep, voffB);
            PG8_WAIT_V(6); PG8_BAR; PG8_MMA(1, 1, At, B1); PG8_BAR;
            PG8_LDB(B0, 1, 0); PG8_SCHED; PG8_LDA(At, 1, 0); PG8_STAGE(PG8_SA(0, 1), a2 + hstep, voffA);
            PG8_WAIT_L(8); PG8_BAR; PG8_WAIT_L(0); PG8_MMA(0, 0, At, B0); PG8_BAR; PG8_SCHED;
            PG8_LDB(B1, 1, 1); PG8_STAGE(PG8_SB(1, 0), b3, voffB);
            PG8_BAR; PG8_WAIT_L(0); PG8_MMA(0, 1, At, B1); PG8_BAR;
            PG8_LDA(At, 1, 1); PG8_STAGE(PG8_SA(1, 0), a3, voffA);
            PG8_BAR; PG8_WAIT_L(0); PG8_MMA(1, 0, At, B0); PG8_BAR; PG8_SCHED;
            PG8_STAGE(PG8_SB(1, 1), b3 + hstep, voffB);
            PG8_WAIT_V(6); PG8_BAR; PG8_MMA(1, 1, At, B1); PG8_BAR;
        }
        PG8_STAMP();
        if constexpr (!Epi::AFTER_DRAIN) { E(acc, cur, wr, wc, fr, fq); S.done(cur); }
        PG8_STAMP();
        if (!has_next) break;
#pragma unroll
        for (int a = 0; a < 2; ++a)
#pragma unroll
            for (int b = 0; b < 2; ++b)
#pragma unroll
                for (int m = 0; m < 4; ++m)
#pragma unroll
                    for (int n = 0; n < 2; ++n) acc[a][b][m][n] = (f32x4){0.f, 0.f, 0.f, 0.f};
        cur = nxt; cA = nA; cB = nB; ++ui;
    }
    PG8_WAIT_V(0);
    if (wr == 0) PG8_BAR;
    PG8_BAR;
    if constexpr (Epi::AFTER_DRAIN) { E.fused(acc, cur, wr, wc, fr, fq, lds, wid, lane); S.done(cur); }
    PG8_STAMP();
    if (STAMP && wid == 0) { stamps[lane] = lane < nts ? (((unsigned long long)(unsigned)ts_hi << 32) | (unsigned)ts_lo) : 0ull;
        if (lane == 62) stamps[62] = rt_entry; if (lane == 63) stamps[63] = (unsigned long long)wall_clock64(); }
#undef PG8_STAMP
#undef PG8_SA
#undef PG8_SB
#undef PG8_STAGE
#undef PG8_LDA
#undef PG8_LDB
#undef PG8_MMA
#undef PG8_WAIT_V
#undef PG8_WAIT_L
#undef PG8_BAR
#undef PG8_SCHED
}
}


namespace pg8 {
struct EpiProj {
    static constexpr bool PERM = true, AFTER_DRAIN = false;
    bf16_t* O; float* dtraw;
    __device__ __forceinline__ void operator()(const f32x4 (&acc)[2][2][4][2], const Unit& u, int wr, int wc, int fr, int fq) const {
        const int row0 = u.pm * BM + wr * 64 + fr;
        if (u.pn < 22) {
            const int col0 = u.pn * BM + wc * 32 + 8 * fq;
#pragma unroll
            for (int ai = 0; ai < 2; ++ai)
#pragma unroll
                for (int m = 0; m < 4; ++m) { bf16_t* rowp = O + (size_t)(row0 + ai * HALF + m * 16) * 5632 + col0;
#pragma unroll
                    for (int bj = 0; bj < 2; ++bj) { const f32x4 v0 = acc[ai][bj][m][0], v1 = acc[ai][bj][m][1];
                        u32x4 w; w.x = cvt_pk_bf16(v0[0], v0[1]); w.y = cvt_pk_bf16(v0[2], v0[3]); w.z = cvt_pk_bf16(v1[0], v1[1]); w.w = cvt_pk_bf16(v1[2], v1[3]);
                        *(u32x4*)(rowp + bj * HALF) = w; } }
        } else if (wc == 0) {
#pragma unroll
            for (int ai = 0; ai < 2; ++ai)
#pragma unroll
                for (int m = 0; m < 4; ++m) { float* rp = dtraw + (size_t)(row0 + ai * HALF + m * 16) * 32 + 8 * fq;
                    *(f32x4*)rp = acc[ai][0][m][0]; *(f32x4*)(rp + 4) = acc[ai][0][m][1]; }
        }
    }
};
}

#define NTHR 512
#define NWAVE 8

__device__ __forceinline__ void ph_gemm_f32(float* lds, const float* __restrict__ A, const float* __restrict__ B, float* __restrict__ C,
                                            int M, int N, int K, int lda, int ldb, int ldc) {
    const int tid = threadIdx.x & 255, half = threadIdx.x >> 8, tx = tid & 15, ty = tid >> 4;
    float (*As)[68] = (float (*)[68])(lds + half * 2 * 16 * 68);
    float (*Bs)[68] = (float (*)[68])(lds + half * 2 * 16 * 68 + 16 * 68);
    const int ntx = (N + 63) / 64, nty = M / 64, ntiles = ntx * nty;
    for (int it = blockIdx.x; 2 * it < ntiles; it += gridDim.x) {
        const int tile = 2 * it + half;
        const int m0 = (tile / ntx) * 64, n0 = (tile % ntx) * 64;
        float acc[4][4];
#pragma unroll
        for (int i = 0; i < 4; ++i)
#pragma unroll
            for (int j = 0; j < 4; ++j) acc[i][j] = 0.f;
        for (int k0 = 0; k0 < K; k0 += 16) {
#pragma unroll
            for (int i = 0; i < 4; ++i) {
                int idx = tid + i * 256;
                int r = idx >> 4, c = idx & 15;
                As[c][r] = (m0 + r < M) ? A[(size_t)(m0 + r) * lda + k0 + c] : 0.f;
                int rb = idx >> 6, cb = idx & 63;
                Bs[rb][cb] = (n0 + cb < N) ? B[(size_t)(k0 + rb) * ldb + n0 + cb] : 0.f;
            }
            __syncthreads();
#pragma unroll
            for (int k = 0; k < 16; ++k) {
                float a[4], b[4];
#pragma unroll
                for (int i = 0; i < 4; ++i) { a[i] = As[k][ty * 4 + i]; b[i] = Bs[k][tx * 4 + i]; }
#pragma unroll
                for (int i = 0; i < 4; ++i)
#pragma unroll
                    for (int j = 0; j < 4; ++j) acc[i][j] += a[i] * b[j];
            }
            __syncthreads();
        }
#pragma unroll
        for (int i = 0; i < 4; ++i)
#pragma unroll
            for (int j = 0; j < 4; ++j) {
                int r = m0 + ty * 4 + i, c = n0 + tx * 4 + j;
                if (r < M && c < N) C[(size_t)r * ldc + c] = acc[i][j];
            }
    }
}


template <int MODE>
__device__ __forceinline__ void transpose_item(const float* __restrict__ W, int K, int N, int Npad, bf16* __restrict__ WT, LAS float* scr, int item, int lane) {
    const int nblk = Npad / 32, kb = item / nblk, nb = item % nblk, k0 = 64 * kb, n0 = 32 * nb;
    const int n = n0 + (lane & 31);
    int sc = n;
    if (MODE == 1) sc = (n < 4096) ? n : (n < 5632 ? n + 24 : (n < 5656 ? n - 5632 + 4096 : -1));
    else sc = (n < N) ? n : -1;
#pragma unroll 8
    for (int i = 0; i < 32; ++i) { const int kk = 2 * i + (lane >> 5); scr[kk * 33 + (lane & 31)] = (sc >= 0) ? W[(size_t)(k0 + kk) * N + sc] : 0.f; }
    LDS_WAIT(); asm volatile("" ::: "memory");
    const int c = lane & 7;
#pragma unroll
    for (int j = 0; j < 4; ++j) { const int nn = (lane >> 3) + 8 * j; const LAS float* s = scr + (8 * c) * 33 + nn;
        v4u o; o.x = pk2(s[0 * 33], s[1 * 33]); o.y = pk2(s[2 * 33], s[3 * 33]); o.z = pk2(s[4 * 33], s[5 * 33]); o.w = pk2(s[6 * 33], s[7 * 33]);
        *(v4u*)(WT + (size_t)(n0 + nn) * K + k0 + 8 * c) = o; }
    LDS_WAIT(); asm volatile("" ::: "memory");
}
__device__ __forceinline__ void ph_prologue(LAS unsigned char* ldsb, const float* __restrict__ xp, const float* __restrict__ xs, bf16* __restrict__ A0,
                                            const float* __restrict__ w_in, bf16* __restrict__ wt_in, const float* __restrict__ w_out, bf16* __restrict__ wt_out,
                                            const float* __restrict__ w_q, bf16* __restrict__ wt_q,
                                            const float* __restrict__ pu, const float* __restrict__ pv, bf16* __restrict__ ub, bf16* __restrict__ vb) {
    const int lane = threadIdx.x & 63, wave = threadIdx.x >> 6;
    LAS float* scr = (LAS float*)(ldsb + wave * 16384);
    const int gw = blockIdx.x * NWAVE + wave, NGW = gridDim.x * NWAVE;
    constexpr int I_IN = (D_MODEL / 64) * (PROJ_LD / 32), I_OUT = (MIX_WIDTH / 64) * (D_MODEL / 32), I_Q = (D_MODEL / 64) * (2048 / 32);
    for (int it = gw; it < I_IN + I_OUT + I_Q; it += NGW) {
        int r = it;
        if (r < I_IN) { transpose_item<1>(w_in, D_MODEL, IN_WIDTH, PROJ_LD, wt_in, scr, r, lane); continue; } r -= I_IN;
        if (r < I_OUT) { transpose_item<0>(w_out, MIX_WIDTH, D_MODEL, D_MODEL, wt_out, scr, r, lane); continue; } r -= I_OUT;
        transpose_item<0>(w_q, D_MODEL, 2048, 2048, wt_q, scr, r, lane);
    }
    const size_t n8 = (size_t)T_ALL * D_MODEL / 8, np8 = (size_t)T_PROMPT * D_MODEL / 8;
    for (size_t i = (size_t)blockIdx.x * NTHR + threadIdx.x; i < n8; i += (size_t)gridDim.x * NTHR) {
        const float4* s = (i < np8) ? (const float4*)xp + 2 * i : (const float4*)xs + 2 * (i - np8);
        float4 a = s[0], b = s[1];
        v4u o; o.x = pk2(a.x, a.y); o.y = pk2(a.z, a.w); o.z = pk2(b.x, b.y); o.w = pk2(b.z, b.w);
        ((v4u*)A0)[i] = o;
    }
    const size_t t8 = (size_t)16384 * D_MODEL / 8;
    for (size_t i = (size_t)blockIdx.x * NTHR + threadIdx.x; i < 2 * t8; i += (size_t)gridDim.x * NTHR) {
        const float4* s = (i < t8) ? (const float4*)pu + 2 * i : (const float4*)pv + 2 * (i - t8);
        float4 a = s[0], b = s[1];
        v4u o; o.x = pk2(a.x, a.y); o.y = pk2(a.z, a.w); o.z = pk2(b.x, b.y); o.w = pk2(b.z, b.w);
        if (i < t8) ((v4u*)ub)[i] = o; else ((v4u*)vb)[i - t8] = o;
    }
}

__device__ __forceinline__ void ph_concat_x(const float* __restrict__ xp, const float* __restrict__ xs, float* __restrict__ xall) {
    const size_t n4 = (size_t)T_ALL * D_MODEL / 4, np4 = (size_t)T_PROMPT * D_MODEL / 4;
    for (size_t i = (size_t)blockIdx.x * NTHR + threadIdx.x; i < n4; i += (size_t)gridDim.x * NTHR) {
        float4 v = (i < np4) ? ((const float4*)xp)[i] : ((const float4*)xs)[i - np4];
        ((float4*)xall)[i] = v;
    }
}

__device__ __forceinline__ void ph_cache_copy(const float* __restrict__ ck, const float* __restrict__ cv, float* __restrict__ out) {
    const size_t per_b4 = (size_t)(WBUF - DEC_SEQ) * ATT_WIDTH / 4;
    const size_t total = per_b4 * DEC_BATCH;
    for (size_t i = (size_t)blockIdx.x * NTHR + threadIdx.x; i < total; i += (size_t)gridDim.x * NTHR) {
        size_t b = i / per_b4, r = i % per_b4;
        size_t src = (b * WBUF * ATT_WIDTH + DEC_SEQ * ATT_WIDTH) / 4 + r;
        size_t dst = (b * WBUF * ATT_WIDTH) / 4 + r;
        ((float4*)(out + OUT_SK))[dst] = ((const float4*)ck)[src];
        ((float4*)(out + OUT_SV))[dst] = ((const float4*)cv)[src];
    }
}

__device__ __forceinline__ void ph_post_proj(const float* __restrict__ proj, const float* __restrict__ state_conv,
                                             const float* __restrict__ conv_w, const float* __restrict__ conv_b, const float* __restrict__ dt_bias,
                                             float* __restrict__ xbc_act, float* __restrict__ dtv, float* __restrict__ qrot, float* __restrict__ krot,
                                             float* __restrict__ out) {
    const int tid = threadIdx.x & 255, half = threadIdx.x >> 8;
    for (int t = 2 * blockIdx.x + half; t < T_ALL; t += 2 * gridDim.x) {
        const bool is_p = t < T_PROMPT;
        int b, i, pos;
        if (is_p) { b = t / SEQ; i = t % SEQ; pos = i; } else { int ts = t - T_PROMPT; b = ts / DEC_SEQ; i = ts % DEC_SEQ; pos = PAST_LEN + i; }
        const float* row = proj + (size_t)t * PROJ_LD;
        for (int c = tid; c < CONV_DIM; c += 256) {
            float acc = conv_b[c];
#pragma unroll
            for (int tap = 0; tap < 4; ++tap) {
                int r = i - 3 + tap;
                float val;
                if (r >= 0) val = proj[(size_t)(t - i + r) * PROJ_LD + O_XBC + c];
                else val = is_p ? 0.f : state_conv[((size_t)b * 3 + (3 + r)) * CONV_DIM + c];
                acc += val * conv_w[tap * CONV_DIM + c];
            }
            xbc_act[(size_t)t * CONV_DIM + c] = silu_f(acc);
        }
        if (tid < SSD_HEADS) dtv[(size_t)t * SSD_HEADS + tid] = softplus_f(row[O_DT + tid] + dt_bias[tid]);
        for (int idx = tid; idx < 512; idx += 256) {
            int which = idx >> 8, h = (idx >> 5) & 7, j = idx & 31;
            double rev = (double)pos * ROPE_INV_REV[j];
            float fr = (float)(rev - floor(rev));
            float sn = __builtin_amdgcn_sinf(fr), cs = __builtin_amdgcn_cosf(fr);
            const float* src = row + (which ? O_K : O_Q) + h * 64;
            float t1 = src[j], t2 = src[j + 32];
            float o1 = t1 * cs - t2 * sn, o2 = t2 * cs + t1 * sn;
            float* dst = (which ? krot : qrot) + (size_t)t * ATT_WIDTH + h * 64;
            dst[j] = o1; dst[j + 32] = o2;
            if (which) {
                if (is_p) { if (i >= SEQ - WBUF) { float* o = out + OUT_PK + ((size_t)b * WBUF + (i - (SEQ - WBUF))) * ATT_WIDTH + h * 64; o[j] = o1; o[j + 32] = o2; } }
                else { float* o = out + OUT_SK + ((size_t)b * WBUF + (WBUF - DEC_SEQ + i)) * ATT_WIDTH + h * 64; o[j] = o1; o[j + 32] = o2; }
            }
        }
        for (int c = tid; c < ATT_WIDTH; c += 256) {
            float v = row[O_V + c];
            if (is_p) { if (i >= SEQ - WBUF) out[OUT_PV + ((size_t)b * WBUF + (i - (SEQ - WBUF))) * ATT_WIDTH + c] = v; }
            else out[OUT_SV + ((size_t)b * WBUF + (WBUF - DEC_SEQ + i)) * ATT_WIDTH + c] = v;
        }
        if (is_p) {
            if (i >= SEQ - 3) { int r = i - (SEQ - 3); for (int c = tid; c < CONV_DIM; c += 256) out[OUT_PC + ((size_t)b * 3 + r) * CONV_DIM + c] = row[O_XBC + c]; }
        } else {
            if (i >= 1) { int r = i - 1; for (int c = tid; c < CONV_DIM; c += 256) out[OUT_SC + ((size_t)b * 3 + r) * CONV_DIM + c] = row[O_XBC + c]; }
        }
    }
}


#define NB_LD 5632
#define NB_XBC 1536
#define NB_Q 4096
#define NB_K 4608
#define NB_V 5120
__device__ __forceinline__ void unpack8(const v4u w, float (&f)[8]) {
    f[0] = __builtin_bit_cast(float, w.x << 16); f[1] = __builtin_bit_cast(float, w.x & 0xffff0000u);
    f[2] = __builtin_bit_cast(float, w.y << 16); f[3] = __builtin_bit_cast(float, w.y & 0xffff0000u);
    f[4] = __builtin_bit_cast(float, w.z << 16); f[5] = __builtin_bit_cast(float, w.z & 0xffff0000u);
    f[6] = __builtin_bit_cast(float, w.w << 16); f[7] = __builtin_bit_cast(float, w.w & 0xffff0000u);
}
__device__ __forceinline__ void store8f(float* d, const float (&f)[8]) { *(float4*)d = make_float4(f[0], f[1], f[2], f[3]); *(float4*)(d + 4) = make_float4(f[4], f[5], f[6], f[7]); }
__device__ __forceinline__ void ph_post_proj2(const bf16* __restrict__ projb, const float* __restrict__ dtraw, const float* __restrict__ state_conv,
                                              const float* __restrict__ conv_w, const float* __restrict__ conv_b, const float* __restrict__ dt_bias,
                                              float* __restrict__ proj, float* __restrict__ xbc_act, bf16* __restrict__ xbc_b, float* __restrict__ dtv,
                                              float* __restrict__ qrot, float* __restrict__ krot, bf16* __restrict__ qrot_b, bf16* __restrict__ krot_b,
                                              float* __restrict__ out) {
    const int tid = threadIdx.x & 255, half = threadIdx.x >> 8;
    for (int t = 2 * blockIdx.x + half; t < T_ALL; t += 2 * gridDim.x) {
        const bool is_p = t < T_PROMPT;
        int b, i, pos;
        if (is_p) { b = t / SEQ; i = t % SEQ; pos = i; } else { int ts = t - T_PROMPT; b = ts / DEC_SEQ; i = ts % DEC_SEQ; pos = PAST_LEN + i; }
        const bf16* row = projb + (size_t)t * NB_LD;
        if (tid < 192) { float f[8]; unpack8(*(const v4u*)(row + tid * 8), f); store8f(proj + (size_t)t * PROJ_LD + O_Z + tid * 8, f); }
        if (tid < 64) {
            float f[8]; unpack8(*(const v4u*)(row + NB_V + tid * 8), f);
            store8f(proj + (size_t)t * PROJ_LD + O_V + tid * 8, f);
            if (is_p) { if (i >= SEQ - WBUF) store8f(out + OUT_PV + ((size_t)b * WBUF + (i - (SEQ - WBUF))) * ATT_WIDTH + tid * 8, f); }
            else store8f(out + OUT_SV + ((size_t)b * WBUF + (WBUF - DEC_SEQ + i)) * ATT_WIDTH + tid * 8, f);
        }
        for (int c8 = tid; c8 < 320; c8 += 256) {
            const int c = c8 * 8;
            float acc[8], cur[8];
            { const float4 b0 = *(const float4*)(conv_b + c), b1 = *(const float4*)(conv_b + c + 4);
              acc[0] = b0.x; acc[1] = b0.y; acc[2] = b0.z; acc[3] = b0.w; acc[4] = b1.x; acc[5] = b1.y; acc[6] = b1.z; acc[7] = b1.w; }
#pragma unroll
            for (int tap = 0; tap < 4; ++tap) {
                const int r = i - 3 + tap;
                float val[8];
                if (r >= 0) unpack8(*(const v4u*)(projb + (size_t)(t - i + r) * NB_LD + NB_XBC + c), val);
                else if (!is_p) { const float* sp = state_conv + ((size_t)b * 3 + (3 + r)) * CONV_DIM + c; const float4 s0 = *(const float4*)sp, s1 = *(const float4*)(sp + 4);
                    val[0] = s0.x; val[1] = s0.y; val[2] = s0.z; val[3] = s0.w; val[4] = s1.x; val[5] = s1.y; val[6] = s1.z; val[7] = s1.w; }
                else {
#pragma unroll
                    for (int j = 0; j < 8; ++j) val[j] = 0.f; }
                const float4 w0 = *(const float4*)(conv_w + tap * CONV_DIM + c), w1 = *(const float4*)(conv_w + tap * CONV_DIM + c + 4);
                acc[0] += val[0] * w0.x; acc[1] += val[1] * w0.y; acc[2] += val[2] * w0.z; acc[3] += val[3] * w0.w;
                acc[4] += val[4] * w1.x; acc[5] += val[5] * w1.y; acc[6] += val[6] * w1.z; acc[7] += val[7] * w1.w;
                if (tap == 3) {
#pragma unroll
                    for (int j = 0; j < 8; ++j) cur[j] = val[j]; }
            }
#pragma unroll
            for (int j = 0; j < 8; ++j) acc[j] = silu_f(acc[j]);
            store8f(xbc_act + (size_t)t * CONV_DIM + c, acc);
            v4u o; o.x = pk2(acc[0], acc[1]); o.y = pk2(acc[2], acc[3]); o.z = pk2(acc[4], acc[5]); o.w = pk2(acc[6], acc[7]);
            *(v4u*)(xbc_b + (size_t)t * CONV_DIM + c) = o;
            if (is_p) { if (i >= SEQ - 3) store8f(out + OUT_PC + ((size_t)b * 3 + (i - (SEQ - 3))) * CONV_DIM + c, cur); }
            else { if (i >= 1) store8f(out + OUT_SC + ((size_t)b * 3 + (i - 1)) * CONV_DIM + c, cur); }
        }
        if (tid < SSD_HEADS) dtv[(size_t)t * SSD_HEADS + tid] = softplus_f(dtraw[(size_t)t * 32 + tid] + dt_bias[tid]);
        if (tid < 128) {
            const int which = tid >> 6, h = (tid >> 3) & 7, jc = tid & 7;
            const bf16* src = row + (which ? NB_K : NB_Q) + h * 64 + jc * 4;
            const uint2 lo = *(const uint2*)src, hi = *(const uint2*)(src + 32);
            float t1[4], t2[4], o1[4], o2[4];
            t1[0] = __builtin_bit_cast(float, lo.x << 16); t1[1] = __builtin_bit_cast(float, lo.x & 0xffff0000u); t1[2] = __builtin_bit_cast(float, lo.y << 16); t1[3] = __builtin_bit_cast(float, lo.y & 0xffff0000u);
            t2[0] = __builtin_bit_cast(float, hi.x << 16); t2[1] = __builtin_bit_cast(float, hi.x & 0xffff0000u); t2[2] = __builtin_bit_cast(float, hi.y << 16); t2[3] = __builtin_bit_cast(float, hi.y & 0xffff0000u);
#pragma unroll
            for (int e = 0; e < 4; ++e) {
                const double rev = (double)pos * ROPE_INV_REV[jc * 4 + e];
                const float fr = (float)(rev - floor(rev));
                const float sn = __builtin_amdgcn_sinf(fr), cs = __builtin_amdgcn_cosf(fr);
                o1[e] = t1[e] * cs - t2[e] * sn; o2[e] = t2[e] * cs + t1[e] * sn;
            }
            const size_t doff = (size_t)t * ATT_WIDTH + h * 64 + jc * 4;
            float* df = which ? krot : qrot; bf16* db = which ? krot_b : qrot_b;
            *(float4*)(df + doff) = make_float4(o1[0], o1[1], o1[2], o1[3]); *(float4*)(df + doff + 32) = make_float4(o2[0], o2[1], o2[2], o2[3]);
            *(uint2*)(db + doff) = make_uint2(pk2(o1[0], o1[1]), pk2(o1[2], o1[3])); *(uint2*)(db + doff + 32) = make_uint2(pk2(o2[0], o2[1]), pk2(o2[2], o2[3]));
            if (which) {
                float* o = nullptr;
                if (is_p) { if (i >= SEQ - WBUF) o = out + OUT_PK + ((size_t)b * WBUF + (i - (SEQ - WBUF))) * ATT_WIDTH + h * 64 + jc * 4; }
                else o = out + OUT_SK + ((size_t)b * WBUF + (WBUF - DEC_SEQ + i)) * ATT_WIDTH + h * 64 + jc * 4;
                if (o) { *(float4*)o = make_float4(o1[0], o1[1], o1[2], o1[3]); *(float4*)(o + 32) = make_float4(o2[0], o2[1], o2[2], o2[3]); }
            }
        }
    }
}

#define SSD_CH 32
__device__ __forceinline__ void ph_ssd_naive(float* lds, const float* __restrict__ xbc_act, const float* __restrict__ dtv, const float* __restrict__ a_log,
                                             const float* __restrict__ d_skip, const float* __restrict__ state_ssm, float* __restrict__ ybuf, float* __restrict__ out) {
    float (*sx)[64] = (float (*)[64])lds;
    float (*sB)[128] = (float (*)[128])(lds + SSD_CH * 64);
    float (*sC)[128] = (float (*)[128])(lds + SSD_CH * 64 + SSD_CH * 128);
    float* sdt = lds + SSD_CH * 64 + 2 * SSD_CH * 128;
    const int tid = threadIdx.x, p = tid >> 3, ng = tid & 7;
    for (int vb = blockIdx.x; vb < (BATCH + DEC_BATCH) * SSD_HEADS; vb += gridDim.x) {
        const int seq = vb / SSD_HEADS, h = vb % SSD_HEADS, g = h / 6;
        const bool is_p = seq < BATCH;
        const int L = is_p ? SEQ : DEC_SEQ;
        const int t0 = is_p ? seq * SEQ : T_PROMPT + (seq - BATCH) * DEC_SEQ;
        const float A = -__expf(a_log[h]);
        const float D = d_skip[h];
        float hs[16];
        if (is_p) {
#pragma unroll
            for (int j = 0; j < 16; ++j) hs[j] = 0.f;
        } else {
            const float* s0 = state_ssm + (((size_t)(seq - BATCH) * SSD_HEADS + h) * 64 + p) * 128 + ng * 16;
#pragma unroll
            for (int j = 0; j < 16; ++j) hs[j] = s0[j];
        }
        for (int c0 = 0; c0 < L; c0 += SSD_CH) {
            const int nst = (L - c0) < SSD_CH ? (L - c0) : SSD_CH;
            __syncthreads();
            for (int idx = tid; idx < nst * 64; idx += NTHR) { int s = idx >> 6, c = idx & 63; sx[s][c] = xbc_act[(size_t)(t0 + c0 + s) * CONV_DIM + h * 64 + c]; }
            for (int idx = tid; idx < nst * 128; idx += NTHR) { int s = idx >> 7, c = idx & 127;
                sB[s][c] = xbc_act[(size_t)(t0 + c0 + s) * CONV_DIM + 1536 + g * 128 + c];
                sC[s][c] = xbc_act[(size_t)(t0 + c0 + s) * CONV_DIM + 2048 + g * 128 + c]; }
            if (tid < nst) sdt[tid] = dtv[(size_t)(t0 + c0 + tid) * SSD_HEADS + h];
            __syncthreads();
            for (int s = 0; s < nst; ++s) {
                const float dt = sdt[s], x = sx[s][p];
                const float a = __expf(dt * A), xdt = x * dt;
                float y = 0.f;
#pragma unroll
                for (int j = 0; j < 16; ++j) { hs[j] = a * hs[j] + xdt * sB[s][ng * 16 + j]; y += sC[s][ng * 16 + j] * hs[j]; }
                y += __shfl_xor(y, 1); y += __shfl_xor(y, 2); y += __shfl_xor(y, 4);
                if (ng == 0) ybuf[(size_t)(t0 + c0 + s) * MIX_WIDTH + h * 64 + p] = y + D * x;
            }
        }
        float* so = is_p ? out + OUT_PS + (((size_t)seq * SSD_HEADS + h) * 64 + p) * 128 + ng * 16
                         : out + OUT_SS + (((size_t)(seq - BATCH) * SSD_HEADS + h) * 64 + p) * 128 + ng * 16;
#pragma unroll
        for (int j = 0; j < 16; ++j) so[j] = hs[j];
    }
}

__device__ __forceinline__ void ph_gate_norm(const float* __restrict__ proj, const float* __restrict__ norm_g, const float* __restrict__ ybuf, bf16* __restrict__ A1) {
    const int w = threadIdx.x >> 6, lane = threadIdx.x & 63, g = w & 3;
    for (int t = 2 * blockIdx.x + (w >> 2); t < T_ALL; t += 2 * gridDim.x) {
        float v[6]; float ss = 0.f;
#pragma unroll
        for (int j = 0; j < 6; ++j) {
            int c = g * 384 + j * 64 + lane;
            float y = ybuf[(size_t)t * MIX_WIDTH + c], z = proj[(size_t)t * PROJ_LD + O_Z + c];
            v[j] = y * silu_f(z); ss += v[j] * v[j];
        }
        ss = wave_sum(ss);
        const float r = rsqrtf(ss * (1.0f / 384.0f) + LN_EPS);
#pragma unroll
        for (int j = 0; j < 6; ++j) { int c = g * 384 + j * 64 + lane; A1[(size_t)t * MIX_WIDTH + c] = (bf16)f2bf(v[j] * r * norm_g[c]); }
#pragma unroll
        for (int j = 0; j < 2; ++j) { int c = SSD_WIDTH + g * 128 + j * 64 + lane; A1[(size_t)t * MIX_WIDTH + c] = (bf16)f2bf(ybuf[(size_t)t * MIX_WIDTH + c]); }
    }
}

__device__ __forceinline__ void ph_attn_naive(float* lds, const float* __restrict__ proj, const float* __restrict__ qrot, const float* __restrict__ krot,
                                              const float* __restrict__ ck, const float* __restrict__ cv, float* __restrict__ ybuf) {
    float (*sq)[64] = (float (*)[64])lds;
    const int w = threadIdx.x >> 6, lane = threadIdx.x & 63;
    for (int vb = blockIdx.x; vb < T_ALL * 8 / NWAVE; vb += gridDim.x) {
        const int item = vb * NWAVE + w;
        const int t = item >> 3, h = item & 7;
        const bool is_p = t < T_PROMPT;
        int b, i;
        if (is_p) { b = t / SEQ; i = t % SEQ; } else { int ts = t - T_PROMPT; b = ts / DEC_SEQ; i = ts % DEC_SEQ; }
        __syncthreads();
        sq[w][lane] = qrot[(size_t)t * ATT_WIDTH + h * 64 + lane];
        __syncthreads();
        const int qi = is_p ? i : WBUF + i;
        float sc[3][3];
        float mx = -INFINITY;
#pragma unroll
        for (int pt = 0; pt < 3; ++pt) {
            const int d = pt == 0 ? 1 : (pt == 1 ? 4 : 16);
#pragma unroll
            for (int sl = 0; sl < 3; ++sl) {
                const int m = lane + sl * 64;
                float s = -INFINITY;
                const int kj = qi - d * m;
                if (m <= 128 && kj >= 0) {
                    const float* kr;
                    if (is_p) kr = krot + (size_t)(b * SEQ + kj) * ATT_WIDTH + h * 64;
                    else kr = (kj >= WBUF) ? krot + (size_t)(T_PROMPT + b * DEC_SEQ + (kj - WBUF)) * ATT_WIDTH + h * 64
                                           : ck + ((size_t)b * WBUF + kj) * ATT_WIDTH + h * 64;
                    float a = 0.f;
#pragma unroll
                    for (int c = 0; c < 64; c += 4) { float4 kv = *(const float4*)(kr + c); a += kv.x * sq[w][c] + kv.y * sq[w][c + 1] + kv.z * sq[w][c + 2] + kv.w * sq[w][c + 3]; }
                    s = a * 0.125f;
                }
                sc[pt][sl] = s; mx = fmaxf(mx, s);
            }
        }
        mx = wave_max(mx);
        float lsum = 0.f;
#pragma unroll
        for (int pt = 0; pt < 3; ++pt)
#pragma unroll
            for (int sl = 0; sl < 3; ++sl) { float pv = (sc[pt][sl] == -INFINITY) ? 0.f : __expf(sc[pt][sl] - mx); sc[pt][sl] = pv; lsum += pv; }
        lsum = wave_sum(lsum);
        float o = 0.f;
#pragma unroll
        for (int pt = 0; pt < 3; ++pt) {
            const int d = pt == 0 ? 1 : (pt == 1 ? 4 : 16);
#pragma unroll
            for (int sl = 0; sl < 3; ++sl) {
                const int mend = sl < 2 ? 64 : 1;
                for (int ml = 0; ml < mend; ++ml) {
                    const int m = ml + sl * 64;
                    const int kj = qi - d * m;
                    const float pv = __shfl(sc[pt][sl], ml);
                    if (kj < 0) continue;
                    const float* vr;
                    if (is_p) vr = proj + (size_t)(b * SEQ + kj) * PROJ_LD + O_V + h * 64;
                    else vr = (kj >= WBUF) ? proj + (size_t)(T_PROMPT + b * DEC_SEQ + (kj - WBUF)) * PROJ_LD + O_V + h * 64
                                           : cv + ((size_t)b * WBUF + kj) * ATT_WIDTH + h * 64;
                    o += pv * vr[lane];
                }
            }
        }
        ybuf[(size_t)t * MIX_WIDTH + SSD_WIDTH + h * 64 + lane] = o / lsum;
    }
}

__device__ __forceinline__ void ph_ln_res(const float* __restrict__ res, const float* __restrict__ add, const float* __restrict__ gam,
                                          const float* __restrict__ bet, float* __restrict__ dst, bf16* __restrict__ dstb) {
    const int lane = threadIdx.x & 63;
    for (int t = blockIdx.x * NWAVE + (threadIdx.x >> 6); t < T_ALL; t += gridDim.x * NWAVE) {
        float v[16]; float s = 0.f;
#pragma unroll
        for (int j = 0; j < 16; ++j) { int c = j * 64 + lane; v[j] = ALPHA_F * res[(size_t)t * D_MODEL + c] + add[(size_t)t * D_MODEL + c]; s += v[j]; }
        s = wave_sum(s);
        const float mu = s * (1.0f / 1024.0f);
        float q = 0.f;
#pragma unroll
        for (int j = 0; j < 16; ++j) { v[j] -= mu; q += v[j] * v[j]; }
        q = wave_sum(q);
        const float r = rsqrtf(q * (1.0f / 1024.0f) + LN_EPS);
#pragma unroll
        for (int j = 0; j < 16; ++j) { int c = j * 64 + lane; float o = v[j] * r * gam[c] + bet[c]; dst[(size_t)t * D_MODEL + c] = o; dstb[(size_t)t * D_MODEL + c] = (bf16)f2bf(o); }
    }
}

__device__ __forceinline__ void ph_peer_route(float* lds, const float* __restrict__ qh, const float* __restrict__ keys1, const float* __restrict__ keys2,
                                              int* __restrict__ eidx, float* __restrict__ gate) {
    float (*sq)[256] = (float (*)[256])lds;
    float (*sv)[2][16] = (float (*)[2][16])(lds + NWAVE * 256);
    int (*si)[2][16] = (int (*)[2][16])(lds + NWAVE * 256 + NWAVE * 32);
    const int w = threadIdx.x >> 6, lane = threadIdx.x & 63;
    for (int vb = blockIdx.x; vb < T_ALL * 8 / NWAVE; vb += gridDim.x) {
        const int item = vb * NWAVE + w;
        const int t = item >> 3, h = item & 7;
        __syncthreads();
        for (int c = lane; c < 256; c += 64) sq[w][c] = qh[(size_t)t * 2048 + h * 256 + c];
        __syncthreads();
#pragma unroll
        for (int half = 0; half < 2; ++half) {
            const float* keys = half ? keys2 : keys1;
            float s[2];
#pragma unroll
            for (int sl = 0; sl < 2; ++sl) {
                const float* kr = keys + (size_t)(lane + sl * 64) * 128;
                float a = 0.f;
#pragma unroll 8
                for (int c = 0; c < 128; c += 4) { float4 kv = *(const float4*)(kr + c); const float* qq = &sq[w][half * 128 + c]; a += kv.x * qq[0] + kv.y * qq[1] + kv.z * qq[2] + kv.w * qq[3]; }
                s[sl] = a;
            }
            for (int r = 0; r < 16; ++r) {
                float bv; int bi;
                if (s[0] >= s[1]) { bv = s[0]; bi = lane; } else { bv = s[1]; bi = lane + 64; }
#pragma unroll
                for (int o = 32; o > 0; o >>= 1) {
                    float ov = __shfl_xor(bv, o); int oi = __shfl_xor(bi, o);
                    if (ov > bv || (ov == bv && oi < bi)) { bv = ov; bi = oi; }
                }
                if (lane == 0) { sv[w][half][r] = bv; si[w][half][r] = bi; }
                if (bi == lane) s[0] = -INFINITY;
                if (bi == lane + 64) s[1] = -INFINITY;
            }
        }
        __syncthreads();
        float c[4];
#pragma unroll
        for (int j = 0; j < 4; ++j) { int ci = lane * 4 + j; c[j] = sv[w][0][ci >> 4] + sv[w][1][ci & 15]; }
        float myv = 0.f; int myc = 0;
        for (int r = 0; r < 16; ++r) {
            float bv = c[0]; int bi = lane * 4;
#pragma unroll
            for (int j = 1; j < 4; ++j) if (c[j] > bv) { bv = c[j]; bi = lane * 4 + j; }
#pragma unroll
            for (int o = 32; o > 0; o >>= 1) {
                float ov = __shfl_xor(bv, o); int oi = __shfl_xor(bi, o);
                if (ov > bv || (ov == bv && oi < bi)) { bv = ov; bi = oi; }
            }
            if (lane == r) { myv = bv; myc = bi; }
#pragma unroll
            for (int j = 0; j < 4; ++j) if (bi == lane * 4 + j) c[j] = -INFINITY;
        }
        float v = lane < 16 ? myv : -INFINITY;
        float mx = wave_max(v);
        float e = lane < 16 ? __expf(v - mx) : 0.f;
        float sum = wave_sum(e);
        if (lane < 16) {
            int ex = si[w][0][myc >> 4] * PEER_NKEYS + si[w][1][myc & 15];
            eidx[(size_t)t * 128 + h * 16 + lane] = ex;
            gate[(size_t)t * 128 + h * 16 + lane] = e / sum;
        }
    }
}

__device__ __forceinline__ void ph_peer_ffn(const float* __restrict__ hbuf, const int* __restrict__ eidx, const float* __restrict__ gate,
                                            const bf16* __restrict__ ub, const bf16* __restrict__ vb, const float* __restrict__ gam,
                                            const float* __restrict__ bet, float* __restrict__ out) {
    const int lane = threadIdx.x & 63;
    for (int t = blockIdx.x * NWAVE + (threadIdx.x >> 6); t < T_ALL; t += gridDim.x * NWAVE) {
        float x[16], acc[16];
        { const float* xr = hbuf + (size_t)t * D_MODEL + lane * 8;
          const float4 a = *(const float4*)xr, b = *(const float4*)(xr + 4), c = *(const float4*)(xr + 512), d = *(const float4*)(xr + 516);
          x[0] = a.x; x[1] = a.y; x[2] = a.z; x[3] = a.w; x[4] = b.x; x[5] = b.y; x[6] = b.z; x[7] = b.w;
          x[8] = c.x; x[9] = c.y; x[10] = c.z; x[11] = c.w; x[12] = d.x; x[13] = d.y; x[14] = d.z; x[15] = d.w; }
#pragma unroll
        for (int j = 0; j < 16; ++j) acc[j] = 0.f;
        for (int k = 0; k < 128; ++k) {
            const int e = eidx[(size_t)t * 128 + k];
            const float g = gate[(size_t)t * 128 + k];
            const bf16* ur = ub + (size_t)e * D_MODEL + lane * 8;
            float u0[8], u1[8];
            unpack8(*(const v4u*)ur, u0); unpack8(*(const v4u*)(ur + 512), u1);
            float d = 0.f;
#pragma unroll
            for (int j = 0; j < 8; ++j) d += u0[j] * x[j] + u1[j] * x[8 + j];
            d = wave_sum(d);
            const float wgt = g * gelu_f(d);
            const bf16* vr = vb + (size_t)e * D_MODEL + lane * 8;
            unpack8(*(const v4u*)vr, u0); unpack8(*(const v4u*)(vr + 512), u1);
#pragma unroll
            for (int j = 0; j < 8; ++j) { acc[j] += wgt * u0[j]; acc[8 + j] += wgt * u1[j]; }
        }
        float s = 0.f;
#pragma unroll
        for (int j = 0; j < 16; ++j) { acc[j] += ALPHA_F * x[j]; s += acc[j]; }
        s = wave_sum(s);
        const float mu = s * (1.0f / 1024.0f);
        float q = 0.f;
#pragma unroll
        for (int j = 0; j < 16; ++j) { acc[j] -= mu; q += acc[j] * acc[j]; }
        q = wave_sum(q);
        const float r = rsqrtf(q * (1.0f / 1024.0f) + LN_EPS);
        float* dst = ((t < T_PROMPT) ? out + OUT_YP + (size_t)t * D_MODEL : out + OUT_YS + (size_t)(t - T_PROMPT) * D_MODEL) + lane * 8;
#pragma unroll
        for (int q4 = 0; q4 < 4; ++q4) {
            const int eo = (q4 >> 1) * 512 + (q4 & 1) * 4;
            const float4 g4 = *(const float4*)(gam + lane * 8 + eo), b4 = *(const float4*)(bet + lane * 8 + eo);
            float4 o; o.x = acc[q4 * 4 + 0] * r * g4.x + b4.x; o.y = acc[q4 * 4 + 1] * r * g4.y + b4.y; o.z = acc[q4 * 4 + 2] * r * g4.z + b4.z; o.w = acc[q4 * 4 + 3] * r * g4.w + b4.w;
            *(float4*)(dst + eo) = o;
        }
    }
}

struct Params {
    const float* in[23];
    float* out;
    unsigned char* ws;
    unsigned* bar;
};

#define WS_BAR      0ull
#define WS_XALL     (1ull << 20)
#define WS_PROJ     (WS_XALL + (size_t)T_ALL * D_MODEL * 4)
#define WS_XBC      (WS_PROJ + (size_t)T_ALL * PROJ_LD * 4)
#define WS_DT       (WS_XBC + (size_t)T_ALL * CONV_DIM * 4)
#define WS_QROT     (WS_DT + (size_t)T_ALL * SSD_HEADS * 4)
#define WS_KROT     (WS_QROT + (size_t)T_ALL * ATT_WIDTH * 4)
#define WS_YBUF     (WS_KROT + (size_t)T_ALL * ATT_WIDTH * 4)
#define WS_MIX      (WS_YBUF + (size_t)T_ALL * MIX_WIDTH * 4)
#define WS_HBUF     (WS_MIX + (size_t)T_ALL * D_MODEL * 4)
#define WS_QH       (WS_HBUF + (size_t)T_ALL * D_MODEL * 4)
#define WS_EIDX     (WS_QH + (size_t)T_ALL * 2048 * 4)
#define WS_GATE     (WS_EIDX + (size_t)T_ALL * 128 * 4)
#define WS_A0       (WS_GATE + (size_t)T_ALL * 128 * 4)
#define WS_A1       (WS_A0 + (size_t)T_ALL * D_MODEL * 2)
#define WS_A2       (WS_A1 + (size_t)T_ALL * MIX_WIDTH * 2)
#define WS_WTIN     (WS_A2 + (size_t)T_ALL * D_MODEL * 2)
#define WS_WTOUT    (WS_WTIN + (size_t)PROJ_LD * D_MODEL * 2)
#define WS_WTQ      (WS_WTOUT + (size_t)D_MODEL * MIX_WIDTH * 2)
#define WS_PROJB    (WS_WTQ + (size_t)2048 * D_MODEL * 2)
#define WS_DTRAW    (WS_PROJB + (size_t)T_ALL * NB_LD * 2)
#define WS_XBCB     (WS_DTRAW + (size_t)T_ALL * 32 * 4)
#define WS_QROTB    (WS_XBCB + (size_t)T_ALL * CONV_DIM * 2)
#define WS_KROTB    (WS_QROTB + (size_t)T_ALL * ATT_WIDTH * 2)
#define WS_UB       (WS_KROTB + (size_t)T_ALL * ATT_WIDTH * 2)
#define WS_VB       (WS_UB + (size_t)16384 * D_MODEL * 2)
#define WS_END      (WS_VB + (size_t)16384 * D_MODEL * 2)

#define LDS_BYTES (144 * 1024)

__global__ void __launch_bounds__(512, 2) mega_fwd(Params p) {
    extern __shared__ __attribute__((aligned(16))) unsigned char smem[];
    if (threadIdx.x == 0) *(uint4*)smem = make_uint4(0u, 0u, 0u, 0u);
    __syncthreads();
    XcdBarrier bar = xcd_barrier_post(p.bar, (volatile LAS unsigned*)smem);
    float* lds = (float*)(smem + 256);

    const float* x_prompt = p.in[0]; const float* x_sample = p.in[1]; const float* cache_k = p.in[2]; const float* cache_v = p.in[3];
    const float* state_conv = p.in[4]; const float* state_ssm = p.in[5]; const float* w_in = p.in[6]; const float* conv_w = p.in[7];
    const float* conv_b = p.in[8]; const float* dt_bias = p.in[9]; const float* a_log = p.in[10]; const float* d_skip = p.in[11];
    const float* norm_g = p.in[12]; const float* w_out = p.in[13]; const float* ln1_g = p.in[14]; const float* ln1_b = p.in[15];
    const float* peer_wq = p.in[16]; const float* keys1 = p.in[17]; const float* keys2 = p.in[18]; const float* peer_u = p.in[19];
    const float* peer_v = p.in[20]; const float* ln2_g = p.in[21]; const float* ln2_b = p.in[22];
    float* out = p.out;
    float* xall = (float*)(p.ws + WS_XALL); float* proj = (float*)(p.ws + WS_PROJ); float* xbc_act = (float*)(p.ws + WS_XBC);
    float* dtv = (float*)(p.ws + WS_DT); float* qrot = (float*)(p.ws + WS_QROT); float* krot = (float*)(p.ws + WS_KROT);
    float* ybuf = (float*)(p.ws + WS_YBUF); float* mix = (float*)(p.ws + WS_MIX); float* hbuf = (float*)(p.ws + WS_HBUF);
    float* qh = (float*)(p.ws + WS_QH); int* eidx = (int*)(p.ws + WS_EIDX); float* gate = (float*)(p.ws + WS_GATE);
    bf16* A0 = (bf16*)(p.ws + WS_A0); bf16* A1 = (bf16*)(p.ws + WS_A1); bf16* A2 = (bf16*)(p.ws + WS_A2);
    bf16* wt_in = (bf16*)(p.ws + WS_WTIN); bf16* wt_out = (bf16*)(p.ws + WS_WTOUT); bf16* wt_q = (bf16*)(p.ws + WS_WTQ);
    bf16* projb = (bf16*)(p.ws + WS_PROJB); float* dtraw = (float*)(p.ws + WS_DTRAW); bf16* xbc_b = (bf16*)(p.ws + WS_XBCB);
    bf16* qrot_b = (bf16*)(p.ws + WS_QROTB); bf16* krot_b = (bf16*)(p.ws + WS_KROTB); bf16* ub = (bf16*)(p.ws + WS_UB); bf16* vb = (bf16*)(p.ws + WS_VB);
    LAS unsigned char* ldsb = (LAS unsigned char*)smem + 256;

    ph_concat_x(x_prompt, x_sample, xall);
    ph_prologue(ldsb, x_prompt, x_sample, A0, w_in, wt_in, w_out, wt_out, peer_wq, wt_q, peer_u, peer_v, ub, vb);
    ph_cache_copy(cache_k, cache_v, out);
    xcd_barrier(bar);
    { pg8::Gemm g{A0, wt_in, T_ALL, PROJ_LD, D_MODEL}; pg8::StaticOrder S; S.init(g.M, g.N, (int)gridDim.x, (int)blockIdx.x);
      pg8::EpiProj E{projb, dtraw}; pg8::gemm_phase<pg8::EpiProj, pg8::StaticOrder, false>(ldsb, g, S, E, nullptr); }
    xcd_barrier(bar);
    ph_post_proj2(projb, dtraw, state_conv, conv_w, conv_b, dt_bias, proj, xbc_act, xbc_b, dtv, qrot, krot, qrot_b, krot_b, out);
    xcd_barrier(bar);
    ph_ssd_naive(lds, xbc_act, dtv, a_log, d_skip, state_ssm, ybuf, out);
    ph_attn_naive(lds, proj, qrot, krot, cache_k, cache_v, ybuf);
    xcd_barrier(bar);
    ph_gate_norm(proj, norm_g, ybuf, A1);
    xcd_barrier(bar);
    { pg8::Gemm g{A1, wt_out, T_ALL, D_MODEL, MIX_WIDTH}; pg8::StaticOrder S; S.init(g.M, g.N, (int)gridDim.x, (int)blockIdx.x);
      pg8::EpiF32 E{mix, D_MODEL, nullptr}; pg8::gemm_phase<pg8::EpiF32, pg8::StaticOrder, false>(ldsb, g, S, E, nullptr); }
    xcd_barrier(bar);
    ph_ln_res(xall, mix, ln1_g, ln1_b, hbuf, A2);
    xcd_barrier(bar);
    { pg8::Gemm g{A2, wt_q, T_ALL, 2048, D_MODEL}; pg8::StaticOrder S; S.init(g.M, g.N, (int)gridDim.x, (int)blockIdx.x);
      pg8::EpiF32 E{qh, 2048, nullptr}; pg8::gemm_phase<pg8::EpiF32, pg8::StaticOrder, false>(ldsb, g, S, E, nullptr); }
    xcd_barrier(bar);
    ph_peer_route(lds, qh, keys1, keys2, eidx, gate);
    xcd_barrier(bar);
    ph_peer_ffn(hbuf, eidx, gate, ub, vb, ln2_g, ln2_b, out);
}

extern "C" void kernel_launch(void* const* d_in, const int* in_sizes, int n_in, void* d_out, int out_size, void* d_ws, size_t ws_size, hipStream_t stream) {
    static int grid = 0;
    if (grid == 0) {
        int dev = 0, cus = 0, per_cu = 0;
        if (hipGetDevice(&dev) != hipSuccess || hipDeviceGetAttribute(&cus, hipDeviceAttributeMultiprocessorCount, dev) != hipSuccess) { fprintf(stderr, "kernel_launch: device query failed\n"); grid = -1; return; }
        if (hipFuncSetAttribute((const void*)mega_fwd, hipFuncAttributeMaxDynamicSharedMemorySize, LDS_BYTES) != hipSuccess) { fprintf(stderr, "kernel_launch: hipFuncSetAttribute failed\n"); grid = -1; return; }
        if (hipOccupancyMaxActiveBlocksPerMultiprocessor(&per_cu, (const void*)mega_fwd, NTHR, LDS_BYTES) != hipSuccess || per_cu < 1) { fprintf(stderr, "kernel_launch: occupancy query says %d\n", per_cu); }
        (void)hipGetLastError();
        grid = cus;
        if (ws_size < WS_END) { fprintf(stderr, "kernel_launch: workspace too small\n"); grid = -1; return; }
    }
    if (grid < 0) return;
    (void)hipMemsetAsync((char*)d_ws + WS_BAR, 0, XCD_BAR_WORDS * sizeof(unsigned), stream);
    Params p{};
    for (int i = 0; i < 23; ++i) p.in[i] = (const float*)d_in[i];
    p.out = (float*)d_out; p.ws = (unsigned char*)d_ws; p.bar = (unsigned*)((char*)d_ws + WS_BAR);
    hipLaunchKernelGGL(mega_fwd, dim3(grid), dim3(NTHR), LDS_BYTES, stream, p);
}
```

```cpp
#include <hip/hip_runtime.h>
#include <stdint.h>

#define D_MODEL 1024
#define BATCH 2
#define SEQ 8192
#define DEC_BATCH 128
#define DEC_SEQ 4
#define PAST_LEN 8192
#define HEAD_DIM 64
#define ATT_WIDTH 512
#define ATT_HEADS 8
#define SSD_WIDTH 1536
#define SSD_HEADS 24
#define SSD_GROUPS 4
#define SSD_STATE 128
#define CONV_DIM 2560
#define IN_WIDTH 5656
#define PROJ_LD 5888
#define MIX_WIDTH 2048
#define WBUF 2048
#define PEER_NKEYS 128
#define PEER_HEADS 8
#define PEER_TOPK 16
#define PEER_DKEY 256
#define T_PROMPT (BATCH * SEQ)
#define T_SAMPLE (DEC_BATCH * DEC_SEQ)
#define T_ALL (T_PROMPT + T_SAMPLE)
#define O_Z 0
#define O_XBC 1536
#define O_DT 4096
#define O_Q 4120
#define O_K 4632
#define O_V 5144
#define ALPHA_F 1.189207115002721f
#define LN_EPS 1e-5f

#define OUT_YP 0ull
#define OUT_YS (OUT_YP + 16777216ull)
#define OUT_PK (OUT_YS + 524288ull)
#define OUT_PV (OUT_PK + 2097152ull)
#define OUT_PC (OUT_PV + 2097152ull)
#define OUT_PS (OUT_PC + 15360ull)
#define OUT_SK (OUT_PS + 393216ull)
#define OUT_SV (OUT_SK + 134217728ull)
#define OUT_SC (OUT_SV + 134217728ull)
#define OUT_SS (OUT_SC + 983040ull)

__constant__ double ROPE_INV_REV[32] = {
    1.59154943091895346e-01, 1.19349370211248862e-01, 8.94994016088910133e-02, 6.71150830052272551e-02,
    5.03292121044870353e-02, 3.77415847174197711e-02, 2.83021958306233987e-02, 2.12236527647776604e-02,
    1.59154943091895339e-02, 1.19349370211248862e-02, 8.94994016088910237e-03, 6.71150830052272534e-03,
    5.03292121044870370e-03, 3.77415847174197719e-03, 2.83021958306233987e-03, 2.12236527647776622e-03,
    1.59154943091895356e-03, 1.19349370211248849e-03, 8.94994016088910237e-04, 6.71150830052272599e-04,
    5.03292121044870326e-04, 3.77415847174197741e-04, 2.83021958306233954e-04, 2.12236527647776605e-04,
    1.59154943091895351e-04, 1.19349370211248862e-04, 8.94994016088910182e-05, 6.71150830052272545e-05,
    5.03292121044870354e-05, 3.77415847174197768e-05, 2.83021958306233961e-05, 2.12236527647776592e-05
};

__device__ __forceinline__ float silu_f(float x) { return x / (1.0f + __expf(-x)); }
__device__ __forceinline__ float softplus_f(float x) { return fmaxf(x, 0.f) + log1pf(__expf(-fabsf(x))); }
__device__ __forceinline__ float gelu_f(float x) { return 0.5f * x * (1.0f + erff(x * 0.70710678118654752f)); }
__device__ __forceinline__ float wave_sum(float v) {
#pragma unroll
    for (int o = 32; o > 0; o >>= 1) v += __shfl_xor(v, o);
    return v;
}
__device__ __forceinline__ float wave_max(float v) {
#pragma unroll
    for (int o = 32; o > 0; o >>= 1) v = fmaxf(v, __shfl_xor(v, o));
    return v;
}

#include <cstdio>
#define XB_TMO      128
#define XB_XCNT(j)  (256  + 64 * (j))
#define XB_XSUB(j)  (1280 + 64 * (j))
#define XB_XGEN(j)  (2304 + 64 * (j))
#define XB_TOP      3328
#define XB_TOPGEN   3392
#define XCD_BAR_WORDS 3456
#define XB_SPIN_CAP (1u << 18)
#define LAS __attribute__((address_space(3)))

__device__ __forceinline__ unsigned xb_ld(unsigned* p)              { return __hip_atomic_load(p, __ATOMIC_RELAXED, __HIP_MEMORY_SCOPE_AGENT); }
__device__ __forceinline__ unsigned xb_add(unsigned* p, unsigned v) { return __hip_atomic_fetch_add(p, v, __ATOMIC_RELAXED, __HIP_MEMORY_SCOPE_AGENT); }
__device__ __forceinline__ unsigned xb_xcc_id() { return (unsigned)__builtin_amdgcn_s_getreg((3 << 11) | 20) & 0xFu; }
#define XB_SPIN(cond, bar) do { unsigned _sp = 0; while (cond) { __builtin_amdgcn_s_sleep(1); \
    if ((++_sp & 255u) == 0u) { if (xb_ld(&(bar)[XB_TMO])) break; if (_sp > XB_SPIN_CAP) { atomicAdd(&(bar)[XB_TMO], 1u); break; } } } } while (0)

struct XcdBarrier {
    unsigned* bar; unsigned x;
    volatile LAS unsigned* st;
};

__device__ __forceinline__ XcdBarrier xcd_barrier_post(unsigned* bar, volatile LAS unsigned* st) {
    XcdBarrier b; b.bar = bar; b.x = xb_xcc_id(); b.st = st;
    if (threadIdx.x == 0) (void)xb_add(&bar[XB_XCNT(b.x)], 1u);
    return b;
}
__device__ __forceinline__ void xcd_barrier_complete(unsigned* bar, unsigned x, unsigned& nloc, unsigned& nx) {
    const unsigned G = gridDim.x * gridDim.y * gridDim.z;
    unsigned sum, cnt, mine, sp = 0u;
    for (;;) {
        sum = 0u; cnt = 0u; mine = 0u;
#pragma unroll
        for (unsigned j = 0; j < 16; ++j) { const unsigned c = xb_ld(&bar[XB_XCNT(j)]); sum += c; cnt += (c > 0u) ? 1u : 0u; mine = (j == x) ? c : mine; }
        if (sum == G) break;
        __builtin_amdgcn_s_sleep(1);
        if ((++sp & 255u) == 0u) { if (xb_ld(&bar[XB_TMO])) break; if (sp > XB_SPIN_CAP) { atomicAdd(&bar[XB_TMO], 1u); break; } }
    }
    nloc = mine > 0u ? mine : 1u; nx = cnt > 0u ? cnt : 1u;
}

__device__ __forceinline__ void xcd_barrier(const XcdBarrier& b) {
    asm volatile("s_waitcnt vmcnt(0)" ::: "memory");
    __syncthreads();
    if (threadIdx.x == 0) {
        unsigned* bar = b.bar;
        __builtin_amdgcn_s_waitcnt(0);
        unsigned nloc = b.st[0], nx = b.st[1];
        if (nloc == 0u) { xcd_barrier_complete(bar, b.x, nloc, nx); b.st[0] = nloc; b.st[1] = nx; }
        const unsigned old = xb_add(&bar[XB_XSUB(b.x)], 1u);
        const unsigned gen = old / nloc;
        if (old + 1u == (gen + 1u) * nloc) {
            __builtin_amdgcn_fence(__ATOMIC_RELEASE, "agent");
            asm volatile("s_waitcnt vmcnt(0)" ::: "memory");
            const unsigned og = xb_add(&bar[XB_TOP], 1u);
            const unsigned tg = og / nx;
            if (og + 1u == (tg + 1u) * nx) xb_add(&bar[XB_TOPGEN], 1u);
            else XB_SPIN(xb_ld(&bar[XB_TOPGEN]) == tg, bar);
            __builtin_amdgcn_fence(__ATOMIC_ACQUIRE, "agent");
            xb_add(&bar[XB_XGEN(b.x)], 1u);
            asm volatile("s_waitcnt vmcnt(0)" ::: "memory");
        } else {
            XB_SPIN(xb_ld(&bar[XB_XGEN(b.x)]) == gen, bar);
            __builtin_amdgcn_fence(__ATOMIC_ACQUIRE, "agent");
            asm volatile("s_waitcnt vmcnt(0)" ::: "memory");
        }
    }
    __syncthreads();
}


#define GAS __attribute__((address_space(1)))
typedef unsigned short bf16;
typedef unsigned v4u __attribute__((ext_vector_type(4)));
#define LDS_WAIT() asm volatile("s_waitcnt lgkmcnt(0)" ::: "memory")
__device__ __forceinline__ unsigned f2bf(float f) { unsigned u = __builtin_bit_cast(unsigned, f); return (u + 0x7fffu + ((u >> 16) & 1u)) >> 16; }
__device__ __forceinline__ unsigned pk2(float lo, float hi) { return f2bf(lo) | (f2bf(hi) << 16); }
__device__ __forceinline__ float bf2f(unsigned short b) { return __builtin_bit_cast(float, (unsigned)b << 16); }
#include <hip/hip_runtime.h>
namespace pg8 {
#define PG8_LAS __attribute__((address_space(3)))
typedef unsigned short bf16_t;
typedef short bf16x8 __attribute__((ext_vector_type(8)));
typedef float f32x4 __attribute__((ext_vector_type(4)));
typedef unsigned u32x4 __attribute__((ext_vector_type(4)));
constexpr int BM = 256, BK = 64, HALF = 128, HTB = HALF * BK * 2  , STAGE_BYTES = 8 * HTB, NXCD = 8, WGM = 8;

__host__ __device__ __forceinline__ int lds_byte(int r, int c) { const int st = (r >> 4) * 2 + (c >> 5), rr = r & 15, cc = c & 31, ob = rr * 64 + cc * 2; return st * 1024 + (ob ^ (((ob >> 9) & 1) << 5)); }
__host__ __device__ __forceinline__ void stage_rc(int b, int& R, int& C) { const int st = b / 1024, sb = b % 1024, swz = sb ^ (((sb >> 9) & 1) << 5); R = (st >> 1) * 16 + swz / 64; C = (st & 1) * 32 + (swz % 64) / 2; }
__host__ __device__ __forceinline__ int perm32(int rho) { const int n = rho >> 4, i = rho & 15; return 8 * (i >> 2) + 4 * n + (i & 3); }

struct Unit { int pm, pn; };
struct Gemm { const bf16_t* A; const bf16_t* Bt; int M, N, K; };

struct StaticOrder {
    int nM, nN, nwg, G, c;
    __host__ __device__ void init(int M, int N, int G_, int c_) { nM = M / BM; nN = N / BM; nwg = nM * nN; G = G_; c = c_; }
    __host__ __device__ bool next(int i, Unit& u) const {
        const long L = (long)i * G + c; if (L >= nwg) return false;
        int wgid = (int)L; { const int q = nwg / NXCD, r = nwg % NXCD, xcd = wgid % NXCD, off = wgid / NXCD; wgid = (xcd < r ? xcd * (q + 1) : r * (q + 1) + (xcd - r) * q) + off; }
        const int nig = WGM * nN, gid = wgid / nig, fm = gid * WGM, gsz = (nM - fm) < WGM ? (nM - fm) : WGM;
        u.pm = fm + ((wgid % nig) % gsz); u.pn = (wgid % nig) / gsz; return true;
    }
    __device__ __forceinline__ void a_ready(const Unit&) const {}
    __device__ __forceinline__ void done(const Unit&) const {}
};
__device__ __forceinline__ unsigned cvt_pk_bf16(float lo, float hi) { unsigned r; asm volatile("v_cvt_pk_bf16_f32 %0, %1, %2" : "=v"(r) : "v"(lo), "v"(hi)); return r; }
typedef float f32x2 __attribute__((ext_vector_type(2)));
__device__ __forceinline__ f32x2 gelu_pk(f32x2 v) {
    const f32x2 av = __builtin_elementwise_abs(v), d = av * 0.2316418882f + 1.0f;
    f32x2 t; t.x = __builtin_amdgcn_rcpf(d.x); t.y = __builtin_amdgcn_rcpf(d.y);
    f32x2 q = t * 0.5307027145f + (-0.7265760135f); q = q * t + 0.7107068705f; q = q * t + (-0.142248368f); q = q * t + 0.127414796f; q = q * t;
    const f32x2 s = (v * v) * (-0.72134752044f);
    f32x2 e; e.x = __builtin_amdgcn_exp2f(s.x); e.y = __builtin_amdgcn_exp2f(s.y);
    const f32x2 m = v * (q * e), r = v - m;
    f32x2 o; o.x = v.x < 0.f ? m.x : r.x; o.y = v.y < 0.f ? m.y : r.y; return o;
}

struct EpiF32 {
    static constexpr bool PERM = false, AFTER_DRAIN = false;
    float* C; int ldc; const float* bias;
    __device__ __forceinline__ void operator()(const f32x4 (&acc)[2][2][4][2], const Unit& u, int wr, int wc, int fr, int fq) const {
        const int row0 = u.pm * BM + wr * 64 + fr, col0 = u.pn * BM + wc * 32 + 4 * fq;
        f32x4 bv[2][2];
#pragma unroll
        for (int bj = 0; bj < 2; ++bj)
#pragma unroll
            for (int n = 0; n < 2; ++n) bv[bj][n] = bias ? *(const f32x4*)(bias + col0 + bj * HALF + n * 16) : (f32x4){0.f, 0.f, 0.f, 0.f};
#pragma unroll
        for (int ai = 0; ai < 2; ++ai)
#pragma unroll
            for (int m = 0; m < 4; ++m) { float* rowp = C + (size_t)(row0 + ai * HALF + m * 16) * ldc + col0;
#pragma unroll
                for (int bj = 0; bj < 2; ++bj)
#pragma unroll
                    for (int n = 0; n < 2; ++n) *(f32x4*)(rowp + bj * HALF + n * 16) = acc[ai][bj][m][n] + bv[bj][n]; }
    }
};

template <class Epi, class Sched, bool STAMP = false>
__device__ __forceinline__ void gemm_phase(PG8_LAS unsigned char* lds, const Gemm g, const Sched& S, const Epi& E, unsigned long long* stamps) {
    const int tid = threadIdx.x, wid = __builtin_amdgcn_readfirstlane(tid >> 6), lane = tid & 63, wr = wid >> 2, wc = wid & 3, fr = lane & 15, fq = lane >> 4;
    const int K = g.K, nt = K / BK;
    int ts_lo = 0, ts_hi = 0, nts = 0; const unsigned long long rt_entry = STAMP ? (unsigned long long)wall_clock64() : 0ull;
#define PG8_STAMP() do { if (STAMP && wid == 0 && nts < 64) { const unsigned long long _c = (unsigned long long)clock64(); \
        ts_lo = (lane == nts) ? (int)(unsigned)_c : ts_lo; ts_hi = (lane == nts) ? (int)(unsigned)(_c >> 32) : ts_hi; ++nts; } } while (0)
    PG8_STAMP();
    unsigned voffA[2], voffB[2];
#pragma unroll
    for (int i = 0; i < 2; ++i) { int R, C; stage_rc(tid * 16 + i * 8192, R, C); const int Rb = Epi::PERM ? ((R & ~31) + perm32(R & 31)) : R;
        voffA[i] = (unsigned)(R * K + C) * 2u; voffB[i] = (unsigned)(Rb * K + C) * 2u; }
    const size_t kstep = (size_t)(BK * 2);
    const size_t hstep = (size_t)HALF * K * 2;
    const size_t tstep = 2 * hstep;
    const unsigned ldsw = (unsigned)wid * 1024u;
    const int aoff = lds_byte(wr * 64 + fr, fq * 8), boff = lds_byte(wc * 32 + fr, fq * 8);
#define PG8_SA(b, h) (((b) * 2 + (h)) * HTB)
#define PG8_SB(b, h) ((4 + (b) * 2 + (h)) * HTB)
#define PG8_STAGE(bufoff, gbase, voff) do { _Pragma("unroll") for (int _i = 0; _i < 2; ++_i) \
        __builtin_amdgcn_global_load_lds((const unsigned*)((const char*)(gbase) + (voff)[_i]), (PG8_LAS unsigned*)(lds + (bufoff) + ldsw + _i * 8192), 16, 0, 0); } while (0)
#define PG8_LDA(dst, b, h) do { _Pragma("unroll") for (int m = 0; m < 4; ++m) _Pragma("unroll") for (int k = 0; k < 2; ++k) dst[m][k] = *(const PG8_LAS bf16x8*)(lds + PG8_SA(b, h) + aoff + m * 2048 + k * 1024); } while (0)
#define PG8_LDB(dst, b, h) do { _Pragma("unroll") for (int n = 0; n < 2; ++n) _Pragma("unroll") for (int k = 0; k < 2; ++k) dst[n][k] = *(const PG8_LAS bf16x8*)(lds + PG8_SB(b, h) + boff + n * 2048 + k * 1024); } while (0)
#define PG8_MMA(ai, bj, At, Bt) do { __builtin_amdgcn_s_setprio(1); _Pragma("unroll") for (int m = 0; m < 4; ++m) _Pragma("unroll") for (int n = 0; n < 2; ++n) _Pragma("unroll") for (int k = 0; k < 2; ++k) \
        acc[ai][bj][m][n] = __builtin_amdgcn_mfma_f32_16x16x32_bf16(Bt[n][k], At[m][k], acc[ai][bj][m][n], 0, 0, 0); __builtin_amdgcn_s_setprio(0); } while (0)
#define PG8_WAIT_V(n) asm volatile("s_waitcnt vmcnt(" #n ")" ::: "memory")
#define PG8_WAIT_L(n) asm volatile("s_waitcnt lgkmcnt(" #n ")" ::: "memory")
#define PG8_BAR __builtin_amdgcn_s_barrier()
#define PG8_SCHED __builtin_amdgcn_sched_barrier(0)
    Unit cur, nxt; int ui = 0;
    if (!S.next(0, cur)) return;
    f32x4 acc[2][2][4][2];
#pragma unroll
    for (int a = 0; a < 2; ++a)
#pragma unroll
        for (int b = 0; b < 2; ++b)
#pragma unroll
            for (int m = 0; m < 4; ++m)
#pragma unroll
                for (int n = 0; n < 2; ++n) acc[a][b][m][n] = (f32x4){0.f, 0.f, 0.f, 0.f};
    bf16x8 At[4][2], B0[2][2], B1[2][2];
    const char* cA = (const char*)g.A + (size_t)cur.pm * tstep; const char* cB = (const char*)g.Bt + (size_t)cur.pn * tstep;
    S.a_ready(cur);
    PG8_STAGE(PG8_SB(0, 0), cB, voffB); PG8_STAGE(PG8_SA(0, 0), cA, voffA); PG8_STAGE(PG8_SB(0, 1), cB + hstep, voffB); PG8_STAGE(PG8_SA(0, 1), cA + hstep, voffA);
    if (wr == 1) PG8_BAR;
    PG8_WAIT_V(4); PG8_BAR;
    PG8_STAGE(PG8_SB(1, 0), cB + kstep, voffB); PG8_STAGE(PG8_SA(1, 0), cA + kstep, voffA); PG8_STAGE(PG8_SB(1, 1), cB + hstep + kstep, voffB);
    PG8_WAIT_V(6); PG8_BAR;
    PG8_STAMP();
    for (;;) {
        const bool has_next = S.next(ui + 1, nxt);
        const char* nA = has_next ? (const char*)g.A + (size_t)nxt.pm * tstep : cA; const char* nB = has_next ? (const char*)g.Bt + (size_t)nxt.pn * tstep : cB;
        for (int t = 0; t < nt; t += 2) {
            const bool last = (t == nt - 2);
            const char* a1 = cA + (size_t)(t + 1) * kstep;
            const char* a2 = last ? nA : cA + (size_t)(t + 2) * kstep; const char* b2 = last ? nB : cB + (size_t)(t + 2) * kstep;
            const char* a3 = a2 + kstep; const char* b3 = b2 + kstep;
            if (last && has_next) S.a_ready(nxt);
            PG8_LDB(B0, 0, 0); PG8_SCHED; PG8_LDA(At, 0, 0); PG8_STAGE(PG8_SA(1, 1), a1 + hstep, voffA);
            PG8_WAIT_L(8); PG8_BAR; PG8_WAIT_L(0); PG8_MMA(0, 0, At, B0); PG8_BAR; PG8_SCHED;
            PG8_LDB(B1, 0, 1); PG8_STAGE(PG8_SB(0, 0), b2, voffB);
            PG8_BAR; PG8_WAIT_L(0); PG8_MMA(0, 1, At, B1); PG8_BAR;
            PG8_LDA(At, 0, 1); PG8_STAGE(PG8_SA(0, 0), a2, voffA);
            PG8_BAR; PG8_WAIT_L(0); PG8_MMA(1, 0, At, B0); PG8_BAR; PG8_SCHED;
            PG8_STAGE(PG8_SB(0, 1), b2 + hstep, voffB);
            PG8_WAIT_V(6); PG8_BAR; PG8_MMA(1, 1, At, B1); PG8_BAR;
            PG8_LDB(B0, 1, 0); PG8_SCHED; PG8_LDA(At, 1, 0); PG8_STAGE(PG8_SA(0, 1), a2 + hstep, voffA);
            PG8_WAIT_L(8); PG8_BAR; PG8_WAIT_L(0); PG8_MMA(0, 0, At, B0); PG8_BAR; PG8_SCHED;
            PG8_LDB(B1, 1, 1); PG8_STAGE(PG8_SB(1, 0), b3, voffB);
            PG8_BAR; PG8_WAIT_L(0); PG8_MMA(0, 1, At, B1); PG8_BAR;
            PG8_LDA(At, 1, 1); PG8_STAGE(PG8_SA(1, 0), a3, voffA);
            PG8_BAR; PG8_WAIT_L(0); PG8_MMA(1, 0, At, B0); PG8_BAR; PG8_SCHED;
            PG8_STAGE(PG8_SB(1, 1), b3 + hstep, voffB);
            PG8_WAIT_V(6); PG8_BAR; PG8_MMA(1, 1, At, B1); PG8_BAR;
        }
        PG8_STAMP();
        if constexpr (!Epi::AFTER_DRAIN) { E(acc, cur, wr, wc, fr, fq); S.done(cur); }
        PG8_STAMP();
        if (!has_next) break;
#pragma unroll
        for (int a = 0; a < 2; ++a)
#pragma unroll
            for (int b = 0; b < 2; ++b)
#pragma unroll
                for (int m = 0; m < 4; ++m)
#pragma unroll
                    for (int n = 0; n < 2; ++n) acc[a][b][m][n] = (f32x4){0.f, 0.f, 0.f, 0.f};
        cur = nxt; cA = nA; cB = nB; ++ui;
    }
    PG8_WAIT_V(0);
    if (wr == 0) PG8_BAR;
    PG8_BAR;
    if constexpr (Epi::AFTER_DRAIN) { E.fused(acc, cur, wr, wc, fr, fq, lds, wid, lane); S.done(cur); }
    PG8_STAMP();
    if (STAMP && wid == 0) { stamps[lane] = lane < nts ? (((unsigned long long)(unsigned)ts_hi << 32) | (unsigned)ts_lo) : 0ull;
        if (lane == 62) stamps[62] = rt_entry; if (lane == 63) stamps[63] = (unsigned long long)wall_clock64(); }
#undef PG8_STAMP
#undef PG8_SA
#undef PG8_SB
#undef PG8_STAGE
#undef PG8_LDA
#undef PG8_LDB
#undef PG8_MMA
#undef PG8_WAIT_V
#undef PG8_WAIT_L
#undef PG8_BAR
#undef PG8_SCHED
}
}


namespace pg8 {
struct EpiProj {
    static constexpr bool PERM = true, AFTER_DRAIN = false;
    bf16_t* O; float* dtraw;
    __device__ __forceinline__ void operator()(const f32x4 (&acc)[2][2][4][2], const Unit& u, int wr, int wc, int fr, int fq) const {
        const int row0 = u.pm * BM + wr * 64 + fr;
        if (u.pn < 22) {
            const int col0 = u.pn * BM + wc * 32 + 8 * fq;
#pragma unroll
            for (int ai = 0; ai < 2; ++ai)
#pragma unroll
                for (int m = 0; m < 4; ++m) { bf16_t* rowp = O + (size_t)(row0 + ai * HALF + m * 16) * 5632 + col0;
#pragma unroll
                    for (int bj = 0; bj < 2; ++bj) { const f32x4 v0 = acc[ai][bj][m][0], v1 = acc[ai][bj][m][1];
                        u32x4 w; w.x = cvt_pk_bf16(v0[0], v0[1]); w.y = cvt_pk_bf16(v0[2], v0[3]); w.z = cvt_pk_bf16(v1[0], v1[1]); w.w = cvt_pk_bf16(v1[2], v1[3]);
                        *(u32x4*)(rowp + bj * HALF) = w; } }
        } else if (wc == 0) {
#pragma unroll
            for (int ai = 0; ai < 2; ++ai)
#pragma unroll
                for (int m = 0; m < 4; ++m) { float* rp = dtraw + (size_t)(row0 + ai * HALF + m * 16) * 32 + 8 * fq;
                    *(f32x4*)rp = acc[ai][0][m][0]; *(f32x4*)(rp + 4) = acc[ai][0][m][1]; }
        }
    }
};
}

#define NTHR 512
#define NWAVE 8

__device__ __forceinline__ void ph_gemm_f32(float* lds, const float* __restrict__ A, const float* __restrict__ B, float* __restrict__ C,
                                            int M, int N, int K, int lda, int ldb, int ldc) {
    const int tid = threadIdx.x & 255, half = threadIdx.x >> 8, tx = tid & 15, ty = tid >> 4;
    float (*As)[68] = (float (*)[68])(lds + half * 2 * 16 * 68);
    float (*Bs)[68] = (float (*)[68])(lds + half * 2 * 16 * 68 + 16 * 68);
    const int ntx = (N + 63) / 64, nty = M / 64, ntiles = ntx * nty;
    for (int it = blockIdx.x; 2 * it < ntiles; it += gridDim.x) {
        const int tile = 2 * it + half;
        const int m0 = (tile / ntx) * 64, n0 = (tile % ntx) * 64;
        float acc[4][4];
#pragma unroll
        for (int i = 0; i < 4; ++i)
#pragma unroll
            for (int j = 0; j < 4; ++j) acc[i][j] = 0.f;
        for (int k0 = 0; k0 < K; k0 += 16) {
#pragma unroll
            for (int i = 0; i < 4; ++i) {
                int idx = tid + i * 256;
                int r = idx >> 4, c = idx & 15;
                As[c][r] = (m0 + r < M) ? A[(size_t)(m0 + r) * lda + k0 + c] : 0.f;
                int rb = idx >> 6, cb = idx & 63;
                Bs[rb][cb] = (n0 + cb < N) ? B[(size_t)(k0 + rb) * ldb + n0 + cb] : 0.f;
            }
            __syncthreads();
#pragma unroll
            for (int k = 0; k < 16; ++k) {
                float a[4], b[4];
#pragma unroll
                for (int i = 0; i < 4; ++i) { a[i] = As[k][ty * 4 + i]; b[i] = Bs[k][tx * 4 + i]; }
#pragma unroll
                for (int i = 0; i < 4; ++i)
#pragma unroll
                    for (int j = 0; j < 4; ++j) acc[i][j] += a[i] * b[j];
            }
            __syncthreads();
        }
#pragma unroll
        for (int i = 0; i < 4; ++i)
#pragma unroll
            for (int j = 0; j < 4; ++j) {
                int r = m0 + ty * 4 + i, c = n0 + tx * 4 + j;
                if (r < M && c < N) C[(size_t)r * ldc + c] = acc[i][j];
            }
    }
}


template <int MODE>
__device__ __forceinline__ void transpose_item(const float* __restrict__ W, int K, int N, int Npad, bf16* __restrict__ WT, LAS float* scr, int item, int lane) {
    const int nblk = Npad / 32, kb = item / nblk, nb = item % nblk, k0 = 64 * kb, n0 = 32 * nb;
    const int n = n0 + (lane & 31);
    int sc = n;
    if (MODE == 1) sc = (n < 4096) ? n : (n < 5632 ? n + 24 : (n < 5656 ? n - 5632 + 4096 : -1));
    else sc = (n < N) ? n : -1;
#pragma unroll 8
    for (int i = 0; i < 32; ++i) { const int kk = 2 * i + (lane >> 5); scr[kk * 33 + (lane & 31)] = (sc >= 0) ? W[(size_t)(k0 + kk) * N + sc] : 0.f; }
    LDS_WAIT(); asm volatile("" ::: "memory");
    const int c = lane & 7;
#pragma unroll
    for (int j = 0; j < 4; ++j) { const int nn = (lane >> 3) + 8 * j; const LAS float* s = scr + (8 * c) * 33 + nn;
        v4u o; o.x = pk2(s[0 * 33], s[1 * 33]); o.y = pk2(s[2 * 33], s[3 * 33]); o.z = pk2(s[4 * 33], s[5 * 33]); o.w = pk2(s[6 * 33], s[7 * 33]);
        *(v4u*)(WT + (size_t)(n0 + nn) * K + k0 + 8 * c) = o; }
    LDS_WAIT(); asm volatile("" ::: "memory");
}
__device__ __forceinline__ void ph_prologue(LAS unsigned char* ldsb, const float* __restrict__ xp, const float* __restrict__ xs, bf16* __restrict__ A0,
                                            const float* __restrict__ w_in, bf16* __restrict__ wt_in, const float* __restrict__ w_out, bf16* __restrict__ wt_out,
                                            const float* __restrict__ w_q, bf16* __restrict__ wt_q,
                                            const float* __restrict__ pu, const float* __restrict__ pv, bf16* __restrict__ ub, bf16* __restrict__ vb) {
    const int lane = threadIdx.x & 63, wave = threadIdx.x >> 6;
    LAS float* scr = (LAS float*)(ldsb + wave * 16384);
    const int gw = blockIdx.x * NWAVE + wave, NGW = gridDim.x * NWAVE;
    constexpr int I_IN = (D_MODEL / 64) * (PROJ_LD / 32), I_OUT = (MIX_WIDTH / 64) * (D_MODEL / 32), I_Q = (D_MODEL / 64) * (2048 / 32);
    for (int it = gw; it < I_IN + I_OUT + I_Q; it += NGW) {
        int r = it;
        if (r < I_IN) { transpose_item<1>(w_in, D_MODEL, IN_WIDTH, PROJ_LD, wt_in, scr, r, lane); continue; } r -= I_IN;
        if (r < I_OUT) { transpose_item<0>(w_out, MIX_WIDTH, D_MODEL, D_MODEL, wt_out, scr, r, lane); continue; } r -= I_OUT;
        transpose_item<0>(w_q, D_MODEL, 2048, 2048, wt_q, scr, r, lane);
    }
    const size_t n8 = (size_t)T_ALL * D_MODEL / 8, np8 = (size_t)T_PROMPT * D_MODEL / 8;
    for (size_t i = (size_t)blockIdx.x * NTHR + threadIdx.x; i < n8; i += (size_t)gridDim.x * NTHR) {
        const float4* s = (i < np8) ? (const float4*)xp + 2 * i : (const float4*)xs + 2 * (i - np8);
        float4 a = s[0], b = s[1];
        v4u o; o.x = pk2(a.x, a.y); o.y = pk2(a.z, a.w); o.z = pk2(b.x, b.y); o.w = pk2(b.z, b.w);
        ((v4u*)A0)[i] = o;
    }
    const size_t t8 = (size_t)16384 * D_MODEL / 8;
    for (size_t i = (size_t)blockIdx.x * NTHR + threadIdx.x; i < 2 * t8; i += (size_t)gridDim.x * NTHR) {
        const float4* s = (i < t8) ? (const float4*)pu + 2 * i : (const float4*)pv + 2 * (i - t8);
        float4 a = s[0], b = s[1];
        v4u o; o.x = pk2(a.x, a.y); o.y = pk2(a.z, a.w); o.z = pk2(b.x, b.y); o.w = pk2(b.z, b.w);
        if (i < t8) ((v4u*)ub)[i] = o; else ((v4u*)vb)[i - t8] = o;
    }
}

__device__ __forceinline__ void ph_concat_x(const float* __restrict__ xp, const float* __restrict__ xs, float* __restrict__ xall) {
    const size_t n4 = (size_t)T_ALL * D_MODEL / 4, np4 = (size_t)T_PROMPT * D_MODEL / 4;
    for (size_t i = (size_t)blockIdx.x * NTHR + threadIdx.x; i < n4; i += (size_t)gridDim.x * NTHR) {
        float4 v = (i < np4) ? ((const float4*)xp)[i] : ((const float4*)xs)[i - np4];
        ((float4*)xall)[i] = v;
    }
}

__device__ __forceinline__ void ph_cache_copy(const float* __restrict__ ck, const float* __restrict__ cv, float* __restrict__ out) {
    const size_t per_b4 = (size_t)(WBUF - DEC_SEQ) * ATT_WIDTH / 4;
    const size_t total = per_b4 * DEC_BATCH;
    for (size_t i = (size_t)blockIdx.x * NTHR + threadIdx.x; i < total; i += (size_t)gridDim.x * NTHR) {
        size_t b = i / per_b4, r = i % per_b4;
        size_t src = (b * WBUF * ATT_WIDTH + DEC_SEQ * ATT_WIDTH) / 4 + r;
        size_t dst = (b * WBUF * ATT_WIDTH) / 4 + r;
        ((float4*)(out + OUT_SK))[dst] = ((const float4*)ck)[src];
        ((float4*)(out + OUT_SV))[dst] = ((const float4*)cv)[src];
    }
}

__device__ __forceinline__ void ph_post_proj(const float* __restrict__ proj, const float* __restrict__ state_conv,
                                             const float* __restrict__ conv_w, const float* __restrict__ conv_b, const float* __restrict__ dt_bias,
                                             float* __restrict__ xbc_act, float* __restrict__ dtv, float* __restrict__ qrot, float* __restrict__ krot,
                                             float* __restrict__ out) {
    const int tid = threadIdx.x & 255, half = threadIdx.x >> 8;
    for (int t = 2 * blockIdx.x + half; t < T_ALL; t += 2 * gridDim.x) {
        const bool is_p = t < T_PROMPT;
        int b, i, pos;
        if (is_p) { b = t / SEQ; i = t % SEQ; pos = i; } else { int ts = t - T_PROMPT; b = ts / DEC_SEQ; i = ts % DEC_SEQ; pos = PAST_LEN + i; }
        const float* row = proj + (size_t)t * PROJ_LD;
        for (int c = tid; c < CONV_DIM; c += 256) {
            float acc = conv_b[c];
#pragma unroll
            for (int tap = 0; tap < 4; ++tap) {
                int r = i - 3 + tap;
                float val;
                if (r >= 0) val = proj[(size_t)(t - i + r) * PROJ_LD + O_XBC + c];
                else val = is_p ? 0.f : state_conv[((size_t)b * 3 + (3 + r)) * CONV_DIM + c];
                acc += val * conv_w[tap * CONV_DIM + c];
            }
            xbc_act[(size_t)t * CONV_DIM + c] = silu_f(acc);
        }
        if (tid < SSD_HEADS) dtv[(size_t)t * SSD_HEADS + tid] = softplus_f(row[O_DT + tid] + dt_bias[tid]);
        for (int idx = tid; idx < 512; idx += 256) {
            int which = idx >> 8, h = (idx >> 5) & 7, j = idx & 31;
            double rev = (double)pos * ROPE_INV_REV[j];
            float fr = (float)(rev - floor(rev));
            float sn = __builtin_amdgcn_sinf(fr), cs = __builtin_amdgcn_cosf(fr);
            const float* src = row + (which ? O_K : O_Q) + h * 64;
            float t1 = src[j], t2 = src[j + 32];
            float o1 = t1 * cs - t2 * sn, o2 = t2 * cs + t1 * sn;
            float* dst = (which ? krot : qrot) + (size_t)t * ATT_WIDTH + h * 64;
            dst[j] = o1; dst[j + 32] = o2;
            if (which) {
                if (is_p) { if (i >= SEQ - WBUF) { float* o = out + OUT_PK + ((size_t)b * WBUF + (i - (SEQ - WBUF))) * ATT_WIDTH + h * 64; o[j] = o1; o[j + 32] = o2; } }
                else { float* o = out + OUT_SK + ((size_t)b * WBUF + (WBUF - DEC_SEQ + i)) * ATT_WIDTH + h * 64; o[j] = o1; o[j + 32] = o2; }
            }
        }
        for (int c = tid; c < ATT_WIDTH; c += 256) {
            float v = row[O_V + c];
            if (is_p) { if (i >= SEQ - WBUF) out[OUT_PV + ((size_t)b * WBUF + (i - (SEQ - WBUF))) * ATT_WIDTH + c] = v; }
            else out[OUT_SV + ((size_t)b * WBUF + (WBUF - DEC_SEQ + i)) * ATT_WIDTH + c] = v;
        }
        if (is_p) {
            if (i >= SEQ - 3) { int r = i - (SEQ - 3); for (int c = tid; c < CONV_DIM; c += 256) out[OUT_PC + ((size_t)b * 3 + r) * CONV_DIM + c] = row[O_XBC + c]; }
        } else {
            if (i >= 1) { int r = i - 1; for (int c = tid; c < CONV_DIM; c += 256) out[OUT_SC + ((size_t)b * 3 + r) * CONV_DIM + c] = row[O_XBC + c]; }
        }
    }
}


#define NB_LD 5632
#define NB_XBC 1536
#define NB_Q 4096
#define NB_K 4608
#define NB_V 5120
__device__ __forceinline__ void unpack8(const v4u w, float (&f)[8]) {
    f[0] = __builtin_bit_cast(float, w.x << 16); f[1] = __builtin_bit_cast(float, w.x & 0xffff0000u);
    f[2] = __builtin_bit_cast(float, w.y << 16); f[3] = __builtin_bit_cast(float, w.y & 0xffff0000u);
    f[4] = __builtin_bit_cast(float, w.z << 16); f[5] = __builtin_bit_cast(float, w.z & 0xffff0000u);
    f[6] = __builtin_bit_cast(float, w.w << 16); f[7] = __builtin_bit_cast(float, w.w & 0xffff0000u);
}
__device__ __forceinline__ void store8f(float* d, const float (&f)[8]) { *(float4*)d = make_float4(f[0], f[1], f[2], f[3]); *(float4*)(d + 4) = make_float4(f[4], f[5], f[6], f[7]); }
__device__ __forceinline__ void ph_post_proj2(const bf16* __restrict__ projb, const float* __restrict__ dtraw, const float* __restrict__ state_conv,
                                              const float* __restrict__ conv_w, const float* __restrict__ conv_b, const float* __restrict__ dt_bias,
                                              float* __restrict__ proj, float* __restrict__ xbc_act, bf16* __restrict__ xbc_b, float* __restrict__ dtv,
                                              float* __restrict__ qrot, float* __restrict__ krot, bf16* __restrict__ qrot_b, bf16* __restrict__ krot_b,
                                              float* __restrict__ out) {
    const int tid = threadIdx.x & 255, half = threadIdx.x >> 8;
    for (int t = 2 * blockIdx.x + half; t < T_ALL; t += 2 * gridDim.x) {
        const bool is_p = t < T_PROMPT;
        int b, i, pos;
        if (is_p) { b = t / SEQ; i = t % SEQ; pos = i; } else { int ts = t - T_PROMPT; b = ts / DEC_SEQ; i = ts % DEC_SEQ; pos = PAST_LEN + i; }
        const bf16* row = projb + (size_t)t * NB_LD;
        if (tid < 192) { float f[8]; unpack8(*(const v4u*)(row + tid * 8), f); store8f(proj + (size_t)t * PROJ_LD + O_Z + tid * 8, f); }
        if (tid < 64) {
            float f[8]; unpack8(*(const v4u*)(row + NB_V + tid * 8), f);
            store8f(proj + (size_t)t * PROJ_LD + O_V + tid * 8, f);
            if (is_p) { if (i >= SEQ - WBUF) store8f(out + OUT_PV + ((size_t)b * WBUF + (i - (SEQ - WBUF))) * ATT_WIDTH + tid * 8, f); }
            else store8f(out + OUT_SV + ((size_t)b * WBUF + (WBUF - DEC_SEQ + i)) * ATT_WIDTH + tid * 8, f);
        }
        for (int c8 = tid; c8 < 320; c8 += 256) {
            const int c = c8 * 8;
            float acc[8], cur[8];
            { const float4 b0 = *(const float4*)(conv_b + c), b1 = *(const float4*)(conv_b + c + 4);
              acc[0] = b0.x; acc[1] = b0.y; acc[2] = b0.z; acc[3] = b0.w; acc[4] = b1.x; acc[5] = b1.y; acc[6] = b1.z; acc[7] = b1.w; }
#pragma unroll
            for (int tap = 0; tap < 4; ++tap) {
                const int r = i - 3 + tap;
                float val[8];
                if (r >= 0) unpack8(*(const v4u*)(projb + (size_t)(t - i + r) * NB_LD + NB_XBC + c), val);
                else if (!is_p) { const float* sp = state_conv + ((size_t)b * 3 + (3 + r)) * CONV_DIM + c; const float4 s0 = *(const float4*)sp, s1 = *(const float4*)(sp + 4);
                    val[0] = s0.x; val[1] = s0.y; val[2] = s0.z; val[3] = s0.w; val[4] = s1.x; val[5] = s1.y; val[6] = s1.z; val[7] = s1.w; }
                else {
#pragma unroll
                    for (int j = 0; j < 8; ++j) val[j] = 0.f; }
                const float4 w0 = *(const float4*)(conv_w + tap * CONV_DIM + c), w1 = *(const float4*)(conv_w + tap * CONV_DIM + c + 4);
                acc[0] += val[0] * w0.x; acc[1] += val[1] * w0.y; acc[2] += val[2] * w0.z; acc[3] += val[3] * w0.w;
                acc[4] += val[4] * w1.x; acc[5] += val[5] * w1.y; acc[6] += val[6] * w1.z; acc[7] += val[7] * w1.w;
                if (tap == 3) {
#pragma unroll
                    for (int j = 0; j < 8; ++j) cur[j] = val[j]; }
            }
#pragma unroll
            for (int j = 0; j < 8; ++j) acc[j] = silu_f(acc[j]);
            store8f(xbc_act + (size_t)t * CONV_DIM + c, acc);
            v4u o; o.x = pk2(acc[0], acc[1]); o.y = pk2(acc[2], acc[3]); o.z = pk2(acc[4], acc[5]); o.w = pk2(acc[6], acc[7]);
            *(v4u*)(xbc_b + (size_t)t * CONV_DIM + c) = o;
            if (is_p) { if (i >= SEQ - 3) store8f(out + OUT_PC + ((size_t)b * 3 + (i - (SEQ - 3))) * CONV_DIM + c, cur); }
            else { if (i >= 1) store8f(out + OUT_SC + ((size_t)b * 3 + (i - 1)) * CONV_DIM + c, cur); }
        }
        if (tid < SSD_HEADS) dtv[(size_t)t * SSD_HEADS + tid] = softplus_f(dtraw[(size_t)t * 32 + tid] + dt_bias[tid]);
        if (tid < 128) {
            const int which = tid >> 6, h = (tid >> 3) & 7, jc = tid & 7;
            const bf16* src = row + (which ? NB_K : NB_Q) + h * 64 + jc * 4;
            const uint2 lo = *(const uint2*)src, hi = *(const uint2*)(src + 32);
            float t1[4], t2[4], o1[4], o2[4];
            t1[0] = __builtin_bit_cast(float, lo.x << 16); t1[1] = __builtin_bit_cast(float, lo.x & 0xffff0000u); t1[2] = __builtin_bit_cast(float, lo.y << 16); t1[3] = __builtin_bit_cast(float, lo.y & 0xffff0000u);
            t2[0] = __builtin_bit_cast(float, hi.x << 16); t2[1] = __builtin_bit_cast(float, hi.x & 0xffff0000u); t2[2] = __builtin_bit_cast(float, hi.y << 16); t2[3] = __builtin_bit_cast(float, hi.y & 0xffff0000u);
#pragma unroll
            for (int e = 0; e < 4; ++e) {
                const double rev = (double)pos * ROPE_INV_REV[jc * 4 + e];
                const float fr = (float)(rev - floor(rev));
                const float sn = __builtin_amdgcn_sinf(fr), cs = __builtin_amdgcn_cosf(fr);
                o1[e] = t1[e] * cs - t2[e] * sn; o2[e] = t2[e] * cs + t1[e] * sn;
            }
            const size_t doff = (size_t)t * ATT_WIDTH + h * 64 + jc * 4;
            float* df = which ? krot : qrot; bf16* db = which ? krot_b : qrot_b;
            *(float4*)(df + doff) = make_float4(o1[0], o1[1], o1[2], o1[3]); *(float4*)(df + doff + 32) = make_float4(o2[0], o2[1], o2[2], o2[3]);
            *(uint2*)(db + doff) = make_uint2(pk2(o1[0], o1[1]), pk2(o1[2], o1[3])); *(uint2*)(db + doff + 32) = make_uint2(pk2(o2[0], o2[1]), pk2(o2[2], o2[3]));
            if (which) {
                float* o = nullptr;
                if (is_p) { if (i >= SEQ - WBUF) o = out + OUT_PK + ((size_t)b * WBUF + (i - (SEQ - WBUF))) * ATT_WIDTH + h * 64 + jc * 4; }
                else o = out + OUT_SK + ((size_t)b * WBUF + (WBUF - DEC_SEQ + i)) * ATT_WIDTH + h * 64 + jc * 4;
                if (o) { *(float4*)o = make_float4(o1[0], o1[1], o1[2], o1[3]); *(float4*)(o + 32) = make_float4(o2[0], o2[1], o2[2], o2[3]); }
            }
        }
    }
}

#define SSD_CH 32
__device__ __forceinline__ void ph_ssd_naive(float* lds, const float* __restrict__ xbc_act, const float* __restrict__ dtv, const float* __restrict__ a_log,
                                             const float* __restrict__ d_skip, const float* __restrict__ state_ssm, float* __restrict__ ybuf, float* __restrict__ out) {
    float (*sx)[64] = (float (*)[64])lds;
    float (*sB)[128] = (float (*)[128])(lds + SSD_CH * 64);
    float (*sC)[128] = (float (*)[128])(lds + SSD_CH * 64 + SSD_CH * 128);
    float* sdt = lds + SSD_CH * 64 + 2 * SSD_CH * 128;
    const int tid = threadIdx.x, p = tid >> 3, ng = tid & 7;
    for (int vb = BATCH * SSD_HEADS + blockIdx.x; vb < (BATCH + DEC_BATCH) * SSD_HEADS; vb += gridDim.x) {
        const int seq = vb / SSD_HEADS, h = vb % SSD_HEADS, g = h / 6;
        const bool is_p = seq < BATCH;
        const int L = is_p ? SEQ : DEC_SEQ;
        const int t0 = is_p ? seq * SEQ : T_PROMPT + (seq - BATCH) * DEC_SEQ;
        const float A = -__expf(a_log[h]);
        const float D = d_skip[h];
        float hs[16];
        if (is_p) {
#pragma unroll
            for (int j = 0; j < 16; ++j) hs[j] = 0.f;
        } else {
            const float* s0 = state_ssm + (((size_t)(seq - BATCH) * SSD_HEADS + h) * 64 + p) * 128 + ng * 16;
#pragma unroll
            for (int j = 0; j < 16; ++j) hs[j] = s0[j];
        }
        for (int c0 = 0; c0 < L; c0 += SSD_CH) {
            const int nst = (L - c0) < SSD_CH ? (L - c0) : SSD_CH;
            __syncthreads();
            for (int idx = tid; idx < nst * 64; idx += NTHR) { int s = idx >> 6, c = idx & 63; sx[s][c] = xbc_act[(size_t)(t0 + c0 + s) * CONV_DIM + h * 64 + c]; }
            for (int idx = tid; idx < nst * 128; idx += NTHR) { int s = idx >> 7, c = idx & 127;
                sB[s][c] = xbc_act[(size_t)(t0 + c0 + s) * CONV_DIM + 1536 + g * 128 + c];
                sC[s][c] = xbc_act[(size_t)(t0 + c0 + s) * CONV_DIM + 2048 + g * 128 + c]; }
            if (tid < nst) sdt[tid] = dtv[(size_t)(t0 + c0 + tid) * SSD_HEADS + h];
            __syncthreads();
            for (int s = 0; s < nst; ++s) {
                const float dt = sdt[s], x = sx[s][p];
                const float a = __expf(dt * A), xdt = x * dt;
                float y = 0.f;
#pragma unroll
                for (int j = 0; j < 16; ++j) { hs[j] = a * hs[j] + xdt * sB[s][ng * 16 + j]; y += sC[s][ng * 16 + j] * hs[j]; }
                y += __shfl_xor(y, 1); y += __shfl_xor(y, 2); y += __shfl_xor(y, 4);
                if (ng == 0) ybuf[(size_t)(t0 + c0 + s) * MIX_WIDTH + h * 64 + p] = y + D * x;
            }
        }
        float* so = is_p ? out + OUT_PS + (((size_t)seq * SSD_HEADS + h) * 64 + p) * 128 + ng * 16
                         : out + OUT_SS + (((size_t)(seq - BATCH) * SSD_HEADS + h) * 64 + p) * 128 + ng * 16;
#pragma unroll
        for (int j = 0; j < 16; ++j) so[j] = hs[j];
    }
}

__device__ __forceinline__ void ph_gate_norm(const float* __restrict__ proj, const float* __restrict__ norm_g, const float* __restrict__ ybuf, bf16* __restrict__ A1) {
    const int w = threadIdx.x >> 6, lane = threadIdx.x & 63, g = w & 3;
    for (int t = 2 * blockIdx.x + (w >> 2); t < T_ALL; t += 2 * gridDim.x) {
        if (t >= T_PROMPT) {
        float v[6]; float ss = 0.f;
#pragma unroll
        for (int j = 0; j < 6; ++j) {
            int c = g * 384 + j * 64 + lane;
            float y = ybuf[(size_t)t * MIX_WIDTH + c], z = proj[(size_t)t * PROJ_LD + O_Z + c];
            v[j] = y * silu_f(z); ss += v[j] * v[j];
        }
        ss = wave_sum(ss);
        const float r = rsqrtf(ss * (1.0f / 384.0f) + LN_EPS);
#pragma unroll
        for (int j = 0; j < 6; ++j) { int c = g * 384 + j * 64 + lane; A1[(size_t)t * MIX_WIDTH + c] = (bf16)f2bf(v[j] * r * norm_g[c]); }
        }
#pragma unroll
        for (int j = 0; j < 2; ++j) { int c = SSD_WIDTH + g * 128 + j * 64 + lane; A1[(size_t)t * MIX_WIDTH + c] = (bf16)f2bf(ybuf[(size_t)t * MIX_WIDTH + c]); }
    }
}

__device__ __forceinline__ void ph_attn_naive(float* lds, const float* __restrict__ proj, const float* __restrict__ qrot, const float* __restrict__ krot,
                                              const float* __restrict__ ck, const float* __restrict__ cv, float* __restrict__ ybuf) {
    float (*sq)[64] = (float (*)[64])lds;
    const int w = threadIdx.x >> 6, lane = threadIdx.x & 63;
    for (int vb = blockIdx.x; vb < T_ALL * 8 / NWAVE; vb += gridDim.x) {
        const int item = vb * NWAVE + w;
        const int t = item >> 3, h = item & 7;
        const bool is_p = t < T_PROMPT;
        int b, i;
        if (is_p) { b = t / SEQ; i = t % SEQ; } else { int ts = t - T_PROMPT; b = ts / DEC_SEQ; i = ts % DEC_SEQ; }
        __syncthreads();
        sq[w][lane] = qrot[(size_t)t * ATT_WIDTH + h * 64 + lane];
        __syncthreads();
        const int qi = is_p ? i : WBUF + i;
        float sc[3][3];
        float mx = -INFINITY;
#pragma unroll
        for (int pt = 0; pt < 3; ++pt) {
            const int d = pt == 0 ? 1 : (pt == 1 ? 4 : 16);
#pragma unroll
            for (int sl = 0; sl < 3; ++sl) {
                const int m = lane + sl * 64;
                float s = -INFINITY;
                const int kj = qi - d * m;
                if (m <= 128 && kj >= 0) {
                    const float* kr;
                    if (is_p) kr = krot + (size_t)(b * SEQ + kj) * ATT_WIDTH + h * 64;
                    else kr = (kj >= WBUF) ? krot + (size_t)(T_PROMPT + b * DEC_SEQ + (kj - WBUF)) * ATT_WIDTH + h * 64
                                           : ck + ((size_t)b * WBUF + kj) * ATT_WIDTH + h * 64;
                    float a = 0.f;
#pragma unroll
                    for (int c = 0; c < 64; c += 4) { float4 kv = *(const float4*)(kr + c); a += kv.x * sq[w][c] + kv.y * sq[w][c + 1] + kv.z * sq[w][c + 2] + kv.w * sq[w][c + 3]; }
                    s = a * 0.125f;
                }
                sc[pt][sl] = s; mx = fmaxf(mx, s);
            }
        }
        mx = wave_max(mx);
        float lsum = 0.f;
#pragma unroll
        for (int pt = 0; pt < 3; ++pt)
#pragma unroll
            for (int sl = 0; sl < 3; ++sl) { float pv = (sc[pt][sl] == -INFINITY) ? 0.f : __expf(sc[pt][sl] - mx); sc[pt][sl] = pv; lsum += pv; }
        lsum = wave_sum(lsum);
        float o = 0.f;
#pragma unroll
        for (int pt = 0; pt < 3; ++pt) {
            const int d = pt == 0 ? 1 : (pt == 1 ? 4 : 16);
#pragma unroll
            for (int sl = 0; sl < 3; ++sl) {
                const int mend = sl < 2 ? 64 : 1;
                for (int ml = 0; ml < mend; ++ml) {
                    const int m = ml + sl * 64;
                    const int kj = qi - d * m;
                    const float pv = __shfl(sc[pt][sl], ml);
                    if (kj < 0) continue;
                    const float* vr;
                    if (is_p) vr = proj + (size_t)(b * SEQ + kj) * PROJ_LD + O_V + h * 64;
                    else vr = (kj >= WBUF) ? proj + (size_t)(T_PROMPT + b * DEC_SEQ + (kj - WBUF)) * PROJ_LD + O_V + h * 64
                                           : cv + ((size_t)b * WBUF + kj) * ATT_WIDTH + h * 64;
                    o += pv * vr[lane];
                }
            }
        }
        ybuf[(size_t)t * MIX_WIDTH + SSD_WIDTH + h * 64 + lane] = o / lsum;
    }
}

__device__ __forceinline__ void ph_ln_res(const float* __restrict__ res, const float* __restrict__ add, const float* __restrict__ gam,
                                          const float* __restrict__ bet, float* __restrict__ dst, bf16* __restrict__ dstb) {
    const int lane = threadIdx.x & 63;
    for (int t = blockIdx.x * NWAVE + (threadIdx.x >> 6); t < T_ALL; t += gridDim.x * NWAVE) {
        float v[16]; float s = 0.f;
#pragma unroll
        for (int j = 0; j < 16; ++j) { int c = j * 64 + lane; v[j] = ALPHA_F * res[(size_t)t * D_MODEL + c] + add[(size_t)t * D_MODEL + c]; s += v[j]; }
        s = wave_sum(s);
        const float mu = s * (1.0f / 1024.0f);
        float q = 0.f;
#pragma unroll
        for (int j = 0; j < 16; ++j) { v[j] -= mu; q += v[j] * v[j]; }
        q = wave_sum(q);
        const float r = rsqrtf(q * (1.0f / 1024.0f) + LN_EPS);
#pragma unroll
        for (int j = 0; j < 16; ++j) { int c = j * 64 + lane; float o = v[j] * r * gam[c] + bet[c]; dst[(size_t)t * D_MODEL + c] = o; dstb[(size_t)t * D_MODEL + c] = (bf16)f2bf(o); }
    }
}

__device__ __forceinline__ void ph_peer_route(float* lds, const float* __restrict__ qh, const float* __restrict__ keys1, const float* __restrict__ keys2,
                                              int* __restrict__ eidx, float* __restrict__ gate) {
    float (*sq)[256] = (float (*)[256])lds;
    float (*sv)[2][16] = (float (*)[2][16])(lds + NWAVE * 256);
    int (*si)[2][16] = (int (*)[2][16])(lds + NWAVE * 256 + NWAVE * 32);
    const int w = threadIdx.x >> 6, lane = threadIdx.x & 63;
    for (int vb = blockIdx.x; vb < T_ALL * 8 / NWAVE; vb += gridDim.x) {
        const int item = vb * NWAVE + w;
        const int t = item >> 3, h = item & 7;
        __syncthreads();
        for (int c = lane; c < 256; c += 64) sq[w][c] = qh[(size_t)t * 2048 + h * 256 + c];
        __syncthreads();
#pragma unroll
        for (int half = 0; half < 2; ++half) {
            const float* keys = half ? keys2 : keys1;
            float s[2];
#pragma unroll
            for (int sl = 0; sl < 2; ++sl) {
                const float* kr = keys + (size_t)(lane + sl * 64) * 128;
                float a = 0.f;
#pragma unroll 8
                for (int c = 0; c < 128; c += 4) { float4 kv = *(const float4*)(kr + c); const float* qq = &sq[w][half * 128 + c]; a += kv.x * qq[0] + kv.y * qq[1] + kv.z * qq[2] + kv.w * qq[3]; }
                s[sl] = a;
            }
            for (int r = 0; r < 16; ++r) {
                float bv; int bi;
                if (s[0] >= s[1]) { bv = s[0]; bi = lane; } else { bv = s[1]; bi = lane + 64; }
#pragma unroll
                for (int o = 32; o > 0; o >>= 1) {
                    float ov = __shfl_xor(bv, o); int oi = __shfl_xor(bi, o);
                    if (ov > bv || (ov == bv && oi < bi)) { bv = ov; bi = oi; }
                }
                if (lane == 0) { sv[w][half][r] = bv; si[w][half][r] = bi; }
                if (bi == lane) s[0] = -INFINITY;
                if (bi == lane + 64) s[1] = -INFINITY;
            }
        }
        __syncthreads();
        float c[4];
#pragma unroll
        for (int j = 0; j < 4; ++j) { int ci = lane * 4 + j; c[j] = sv[w][0][ci >> 4] + sv[w][1][ci & 15]; }
        float myv = 0.f; int myc = 0;
        for (int r = 0; r < 16; ++r) {
            float bv = c[0]; int bi = lane * 4;
#pragma unroll
            for (int j = 1; j < 4; ++j) if (c[j] > bv) { bv = c[j]; bi = lane * 4 + j; }
#pragma unroll
            for (int o = 32; o > 0; o >>= 1) {
                float ov = __shfl_xor(bv, o); int oi = __shfl_xor(bi, o);
                if (ov > bv || (ov == bv && oi < bi)) { bv = ov; bi = oi; }
            }
            if (lane == r) { myv = bv; myc = bi; }
#pragma unroll
            for (int j = 0; j < 4; ++j) if (bi == lane * 4 + j) c[j] = -INFINITY;
        }
        float v = lane < 16 ? myv : -INFINITY;
        float mx = wave_max(v);
        float e = lane < 16 ? __expf(v - mx) : 0.f;
        float sum = wave_sum(e);
        if (lane < 16) {
            int ex = si[w][0][myc >> 4] * PEER_NKEYS + si[w][1][myc & 15];
            eidx[(size_t)t * 128 + h * 16 + lane] = ex;
            gate[(size_t)t * 128 + h * 16 + lane] = e / sum;
        }
    }
}

__device__ __forceinline__ void ph_peer_ffn(const float* __restrict__ hbuf, const int* __restrict__ eidx, const float* __restrict__ gate,
                                            const bf16* __restrict__ ub, const bf16* __restrict__ vb, const float* __restrict__ gam,
                                            const float* __restrict__ bet, float* __restrict__ out) {
    const int lane = threadIdx.x & 63;
    for (int t = blockIdx.x * NWAVE + (threadIdx.x >> 6); t < T_ALL; t += gridDim.x * NWAVE) {
        float x[16], acc[16];
        { const float* xr = hbuf + (size_t)t * D_MODEL + lane * 8;
          const float4 a = *(const float4*)xr, b = *(const float4*)(xr + 4), c = *(const float4*)(xr + 512), d = *(const float4*)(xr + 516);
          x[0] = a.x; x[1] = a.y; x[2] = a.z; x[3] = a.w; x[4] = b.x; x[5] = b.y; x[6] = b.z; x[7] = b.w;
          x[8] = c.x; x[9] = c.y; x[10] = c.z; x[11] = c.w; x[12] = d.x; x[13] = d.y; x[14] = d.z; x[15] = d.w; }
#pragma unroll
        for (int j = 0; j < 16; ++j) acc[j] = 0.f;
        for (int k = 0; k < 128; ++k) {
            const int e = eidx[(size_t)t * 128 + k];
            const float g = gate[(size_t)t * 128 + k];
            const bf16* ur = ub + (size_t)e * D_MODEL + lane * 8;
            float u0[8], u1[8];
            unpack8(*(const v4u*)ur, u0); unpack8(*(const v4u*)(ur + 512), u1);
            float d = 0.f;
#pragma unroll
            for (int j = 0; j < 8; ++j) d += u0[j] * x[j] + u1[j] * x[8 + j];
            d = wave_sum(d);
            const float wgt = g * gelu_f(d);
            const bf16* vr = vb + (size_t)e * D_MODEL + lane * 8;
            unpack8(*(const v4u*)vr, u0); unpack8(*(const v4u*)(vr + 512), u1);
#pragma unroll
            for (int j = 0; j < 8; ++j) { acc[j] += wgt * u0[j]; acc[8 + j] += wgt * u1[j]; }
        }
        float s = 0.f;
#pragma unroll
        for (int j = 0; j < 16; ++j) { acc[j] += ALPHA_F * x[j]; s += acc[j]; }
        s = wave_sum(s);
        const float mu = s * (1.0f / 1024.0f);
        float q = 0.f;
#pragma unroll
        for (int j = 0; j < 16; ++j) { acc[j] -= mu; q += acc[j] * acc[j]; }
        q = wave_sum(q);
        const float r = rsqrtf(q * (1.0f / 1024.0f) + LN_EPS);
        float* dst = ((t < T_PROMPT) ? out + OUT_YP + (size_t)t * D_MODEL : out + OUT_YS + (size_t)(t - T_PROMPT) * D_MODEL) + lane * 8;
#pragma unroll
        for (int q4 = 0; q4 < 4; ++q4) {
            const int eo = (q4 >> 1) * 512 + (q4 & 1) * 4;
            const float4 g4 = *(const float4*)(gam + lane * 8 + eo), b4 = *(const float4*)(bet + lane * 8 + eo);
            float4 o; o.x = acc[q4 * 4 + 0] * r * g4.x + b4.x; o.y = acc[q4 * 4 + 1] * r * g4.y + b4.y; o.z = acc[q4 * 4 + 2] * r * g4.z + b4.z; o.w = acc[q4 * 4 + 3] * r * g4.w + b4.w;
            *(float4*)(dst + eo) = o;
        }
    }
}

typedef float f32x16 __attribute__((ext_vector_type(16)));
typedef short s16x8 __attribute__((ext_vector_type(8)));
typedef short s16x4 __attribute__((ext_vector_type(4)));
typedef float f32x4v __attribute__((ext_vector_type(4)));
#define SSD_L_ACS 0
#define SSD_L_DTS 3072
#define SSD_L_BM 6144
#define SSD_RS_B 272
#define SSD_L_X (6144 + 128 * 272)
#define SSD_RS_X 144
#define SSD_XIMG (128 * 144)
#define SSD_RS_Y 784
template <int OFF0, int OFF1>
__device__ __forceinline__ s16x8 tr_frag(unsigned base) {
    s16x4 a, b;
    asm volatile("ds_read_b64_tr_b16 %0, %2 offset:%3\n\tds_read_b64_tr_b16 %1, %2 offset:%4\n\ts_waitcnt lgkmcnt(0)"
                 : "=&v"(a), "=&v"(b) : "v"(base), "n"(OFF0), "n"(OFF1) : "memory");
    return __builtin_shufflevector(a, b, 0, 1, 2, 3, 4, 5, 6, 7);
}
__device__ __forceinline__ unsigned lds_addr(LAS unsigned char* p) { return (unsigned)(size_t)p; }

__device__ __forceinline__ void ssd_chunk_acs(LAS unsigned char* ldsb, const float* __restrict__ dtv, const float* __restrict__ a_log, int t0, int g, float* cdec_out) {
    const int w = __builtin_amdgcn_readfirstlane(threadIdx.x >> 6), lane = threadIdx.x & 63;
    if (w < 6) {
        const int head = 6 * g + w;
        const float A = -__expf(a_log[head]);
        const float v0 = dtv[(size_t)(t0 + 2 * lane) * SSD_HEADS + head], v1 = dtv[(size_t)(t0 + 2 * lane + 1) * SSD_HEADS + head];
        const float a1 = v1 * A;
        float s = v0 * A + a1;
#pragma unroll
        for (int o = 1; o < 64; o <<= 1) { const float tmp = __shfl_up(s, o); if (lane >= o) s += tmp; }
        LAS float* acs = (LAS float*)(ldsb + SSD_L_ACS) + w * 128;
        LAS float* dts = (LAS float*)(ldsb + SSD_L_DTS) + w * 128;
        acs[2 * lane] = s - a1; acs[2 * lane + 1] = s;
        dts[2 * lane] = v0; dts[2 * lane + 1] = v1;
        if (cdec_out && lane == 63) cdec_out[head] = __expf(s);
    }
}

__device__ __forceinline__ void ph_ssd_states(LAS unsigned char* ldsb, const bf16* __restrict__ xbc_b, const float* __restrict__ dtv, const float* __restrict__ a_log,
                                              bf16* __restrict__ Sbuf, float* __restrict__ cdec) {
    const int tid = threadIdx.x, w = __builtin_amdgcn_readfirstlane(tid >> 6), lane = tid & 63;
    const int r = lane & 31, h = lane >> 5, blk = (lane >> 4) & 1, q = (lane & 15) >> 2, pp = lane & 3;
    const int nt = w & 3, pt = w >> 2;
    for (int unit = blockIdx.x; unit < BATCH * 64 * SSD_GROUPS; unit += gridDim.x) {
        const int g = unit & 3, bc = unit >> 2;
        const int t0 = bc * 128;
        __syncthreads();
        ssd_chunk_acs(ldsb, dtv, a_log, t0, g, cdec + (size_t)bc * SSD_HEADS);
        for (int idx = tid; idx < 2048; idx += NTHR) { const int row = idx >> 4, ch = idx & 15;
            const v4u v = *(const v4u*)(xbc_b + (size_t)(t0 + row) * CONV_DIM + 1536 + 128 * g + ch * 8);
            *(LAS v4u*)(ldsb + SSD_L_BM + row * SSD_RS_B + ch * 16) = v; }
        __syncthreads();
        for (int idx = tid; idx < 6144; idx += NTHR) { const int hh = idx >> 10, rem = idx & 1023, row = rem >> 3, ch = rem & 7;
            const LAS float* acs = (const LAS float*)(ldsb + SSD_L_ACS) + hh * 128; const LAS float* dts = (const LAS float*)(ldsb + SSD_L_DTS) + hh * 128;
            const float wgt = dts[row] * __expf(acs[127] - acs[row]);
            float f[8]; unpack8(*(const v4u*)(xbc_b + (size_t)(t0 + row) * CONV_DIM + (6 * g + hh) * 64 + ch * 8), f);
            v4u o; o.x = pk2(f[0] * wgt, f[1] * wgt); o.y = pk2(f[2] * wgt, f[3] * wgt); o.z = pk2(f[4] * wgt, f[5] * wgt); o.w = pk2(f[6] * wgt, f[7] * wgt);
            *(LAS v4u*)(ldsb + SSD_L_X + hh * SSD_XIMG + row * SSD_RS_X + ch * 16) = o; }
        __syncthreads();
        const unsigned abase = lds_addr(ldsb + SSD_L_BM) + (8 * h + q) * SSD_RS_B + (32 * nt + 16 * blk + 4 * pp) * 2;
        s16x8 afr[8];
        afr[0] = tr_frag<0 * 16 * SSD_RS_B, (0 * 16 + 4) * SSD_RS_B>(abase); afr[1] = tr_frag<1 * 16 * SSD_RS_B, (1 * 16 + 4) * SSD_RS_B>(abase);
        afr[2] = tr_frag<2 * 16 * SSD_RS_B, (2 * 16 + 4) * SSD_RS_B>(abase); afr[3] = tr_frag<3 * 16 * SSD_RS_B, (3 * 16 + 4) * SSD_RS_B>(abase);
        afr[4] = tr_frag<4 * 16 * SSD_RS_B, (4 * 16 + 4) * SSD_RS_B>(abase); afr[5] = tr_frag<5 * 16 * SSD_RS_B, (5 * 16 + 4) * SSD_RS_B>(abase);
        afr[6] = tr_frag<6 * 16 * SSD_RS_B, (6 * 16 + 4) * SSD_RS_B>(abase); afr[7] = tr_frag<7 * 16 * SSD_RS_B, (7 * 16 + 4) * SSD_RS_B>(abase);
#pragma unroll
        for (int hh = 0; hh < 6; ++hh) {
            const unsigned xb = lds_addr(ldsb + SSD_L_X + hh * SSD_XIMG) + (8 * h + q) * SSD_RS_X + (32 * pt + 16 * blk + 4 * pp) * 2;
            f32x16 acc;
#pragma unroll
            for (int i = 0; i < 16; ++i) acc[i] = 0.f;
            acc = __builtin_amdgcn_mfma_f32_32x32x16_bf16(afr[0], tr_frag<0 * 16 * SSD_RS_X, (0 * 16 + 4) * SSD_RS_X>(xb), acc, 0, 0, 0);
            acc = __builtin_amdgcn_mfma_f32_32x32x16_bf16(afr[1], tr_frag<1 * 16 * SSD_RS_X, (1 * 16 + 4) * SSD_RS_X>(xb), acc, 0, 0, 0);
            acc = __builtin_amdgcn_mfma_f32_32x32x16_bf16(afr[2], tr_frag<2 * 16 * SSD_RS_X, (2 * 16 + 4) * SSD_RS_X>(xb), acc, 0, 0, 0);
            acc = __builtin_amdgcn_mfma_f32_32x32x16_bf16(afr[3], tr_frag<3 * 16 * SSD_RS_X, (3 * 16 + 4) * SSD_RS_X>(xb), acc, 0, 0, 0);
            acc = __builtin_amdgcn_mfma_f32_32x32x16_bf16(afr[4], tr_frag<4 * 16 * SSD_RS_X, (4 * 16 + 4) * SSD_RS_X>(xb), acc, 0, 0, 0);
            acc = __builtin_amdgcn_mfma_f32_32x32x16_bf16(afr[5], tr_frag<5 * 16 * SSD_RS_X, (5 * 16 + 4) * SSD_RS_X>(xb), acc, 0, 0, 0);
            acc = __builtin_amdgcn_mfma_f32_32x32x16_bf16(afr[6], tr_frag<6 * 16 * SSD_RS_X, (6 * 16 + 4) * SSD_RS_X>(xb), acc, 0, 0, 0);
            acc = __builtin_amdgcn_mfma_f32_32x32x16_bf16(afr[7], tr_frag<7 * 16 * SSD_RS_X, (7 * 16 + 4) * SSD_RS_X>(xb), acc, 0, 0, 0);
            bf16* dst = Sbuf + (((size_t)bc * SSD_HEADS + 6 * g + hh) * 64 + 32 * pt + r) * 128 + 32 * nt + 4 * h;
#pragma unroll
            for (int q4 = 0; q4 < 4; ++q4) *(uint2*)(dst + 8 * q4) = make_uint2(pk2(acc[4 * q4], acc[4 * q4 + 1]), pk2(acc[4 * q4 + 2], acc[4 * q4 + 3]));
        }
    }
}

__device__ __forceinline__ void ph_ssd_scan(const bf16* __restrict__ Sbuf, const float* __restrict__ cdec, bf16* __restrict__ Hin, float* __restrict__ out) {
    for (int idx = blockIdx.x * NTHR + threadIdx.x; idx < BATCH * SSD_HEADS * 64 * 16; idx += gridDim.x * NTHR) {
        const int n8 = idx & 15, p = (idx >> 4) & 63, hb = idx >> 10, hd = hb % SSD_HEADS, b = hb / SSD_HEADS;
        float st[8];
#pragma unroll
        for (int j = 0; j < 8; ++j) st[j] = 0.f;
#pragma unroll 8
        for (int c = 0; c < 64; ++c) {
            const size_t base = ((((size_t)(b * 64 + c)) * SSD_HEADS + hd) * 64 + p) * 128 + n8 * 8;
            v4u o; o.x = pk2(st[0], st[1]); o.y = pk2(st[2], st[3]); o.z = pk2(st[4], st[5]); o.w = pk2(st[6], st[7]);
            *(v4u*)(Hin + base) = o;
            float s[8]; unpack8(*(const v4u*)(Sbuf + base), s);
            const float a = cdec[(size_t)(b * 64 + c) * SSD_HEADS + hd];
#pragma unroll
            for (int j = 0; j < 8; ++j) st[j] = a * st[j] + s[j];
        }
        store8f(out + OUT_PS + (((size_t)b * SSD_HEADS + hd) * 64 + p) * 128 + n8 * 8, st);
    }
}

__device__ __forceinline__ void ph_ssd_out(LAS unsigned char* ldsb, const bf16* __restrict__ xbc_b, const bf16* __restrict__ projb, const float* __restrict__ dtv,
                                           const float* __restrict__ a_log, const float* __restrict__ d_skip, const float* __restrict__ norm_g,
                                           const bf16* __restrict__ Hin, bf16* __restrict__ A1) {
    const int tid = threadIdx.x, w = __builtin_amdgcn_readfirstlane(tid >> 6), lane = tid & 63;
    const int r = lane & 31, h = lane >> 5, blk = (lane >> 4) & 1, q = (lane & 15) >> 2, pp = lane & 3;
    const int lt = w & 3, hs = w >> 2;
    for (int unit = blockIdx.x; unit < BATCH * 64 * SSD_GROUPS; unit += gridDim.x) {
        const int g = unit & 3, bc = unit >> 2;
        const int t0 = bc * 128;
        __syncthreads();
        ssd_chunk_acs(ldsb, dtv, a_log, t0, g, nullptr);
        for (int idx = tid; idx < 2048; idx += NTHR) { const int row = idx >> 4, ch = idx & 15;
            const v4u v = *(const v4u*)(xbc_b + (size_t)(t0 + row) * CONV_DIM + 1536 + 128 * g + ch * 8);
            *(LAS v4u*)(ldsb + SSD_L_BM + row * SSD_RS_B + ch * 16) = v; }
        for (int idx = tid; idx < 6144; idx += NTHR) { const int hh = idx >> 10, rem = idx & 1023, row = rem >> 3, ch = rem & 7;
            const v4u v = *(const v4u*)(xbc_b + (size_t)(t0 + row) * CONV_DIM + (6 * g + hh) * 64 + ch * 8);
            *(LAS v4u*)(ldsb + SSD_L_X + hh * SSD_XIMG + row * SSD_RS_X + ch * 16) = v; }
        __syncthreads();
        const bf16* cp = xbc_b + (size_t)(t0 + 32 * lt + r) * CONV_DIM + 2048 + 128 * g + 8 * h;
        const int lcol = 32 * lt + r;
        const LAS float* acsb = (const LAS float*)(ldsb + SSD_L_ACS) + 3 * hs * 128; const LAS float* dtsb = (const LAS float*)(ldsb + SSD_L_DTS) + 3 * hs * 128;
        f32x16 y[3][2];
#pragma unroll
        for (int h3 = 0; h3 < 3; ++h3)
#pragma unroll
            for (int i = 0; i < 16; ++i) { y[h3][0][i] = 0.f; y[h3][1][i] = 0.f; }
#pragma unroll 1
        for (int ks = 0; ks < 8; ++ks) {
            const s16x8 cf = *(const s16x8*)(cp + 16 * ks);
#pragma unroll
            for (int h3 = 0; h3 < 3; ++h3) {
                const bf16* hp = Hin + (((size_t)bc * SSD_HEADS + 6 * g + 3 * hs + h3) * 64 + r) * 128 + 8 * h + 16 * ks;
                const s16x8 h0 = *(const s16x8*)hp, h1 = *(const s16x8*)(hp + 32 * 128);
                y[h3][0] = __builtin_amdgcn_mfma_f32_32x32x16_bf16(cf, h0, y[h3][0], 0, 0, 0);
                y[h3][1] = __builtin_amdgcn_mfma_f32_32x32x16_bf16(cf, h1, y[h3][1], 0, 0, 0);
            }
        }
#pragma unroll
        for (int h3 = 0; h3 < 3; ++h3)
#pragma unroll
            for (int q4 = 0; q4 < 4; ++q4) {
                const f32x4v a4 = *(const LAS f32x4v*)(acsb + h3 * 128 + 32 * lt + 8 * q4 + 4 * h);
                const float e0 = __expf(a4[0]), e1 = __expf(a4[1]), e2 = __expf(a4[2]), e3 = __expf(a4[3]);
                y[h3][0][4 * q4] *= e0; y[h3][0][4 * q4 + 1] *= e1; y[h3][0][4 * q4 + 2] *= e2; y[h3][0][4 * q4 + 3] *= e3;
                y[h3][1][4 * q4] *= e0; y[h3][1][4 * q4 + 1] *= e1; y[h3][1][4 * q4 + 2] *= e2; y[h3][1][4 * q4 + 3] *= e3;
            }
        const unsigned xb0 = lds_addr(ldsb + SSD_L_X + 3 * hs * SSD_XIMG) + (4 * h + q) * SSD_RS_X + (16 * blk + 4 * pp) * 2;
        for (int st = 0; st <= lt; ++st) {
            f32x16 cb;
#pragma unroll
            for (int i = 0; i < 16; ++i) cb[i] = 0.f;
#pragma unroll 2
            for (int ks = 0; ks < 8; ++ks) {
                const s16x8 cf = *(const s16x8*)(cp + 16 * ks);
                const s16x8 bfrag = *(const LAS s16x8*)(ldsb + SSD_L_BM + (32 * st + r) * SSD_RS_B + (16 * ks + 8 * h) * 2);
                cb = __builtin_amdgcn_mfma_f32_32x32x16_bf16(bfrag, cf, cb, 0, 0, 0);
            }
#pragma unroll
            for (int h3 = 0; h3 < 3; ++h3) {
                const LAS float* acs = acsb + h3 * 128; const LAS float* dts = dtsb + h3 * 128;
                const float myacs = acs[lcol];
                const float Dh = d_skip[6 * g + 3 * hs + h3];
                const unsigned xb = xb0 + h3 * SSD_XIMG + st * 32 * SSD_RS_X;
#pragma unroll
                for (int kk = 0; kk < 2; ++kk) {
                    const int s0 = 32 * st + 16 * kk + 4 * h;
                    const f32x4v as0 = *(const LAS f32x4v*)(acs + s0), as1 = *(const LAS f32x4v*)(acs + s0 + 8);
                    const f32x4v ds0 = *(const LAS f32x4v*)(dts + s0), ds1 = *(const LAS f32x4v*)(dts + s0 + 8);
                    float wv[8];
#pragma unroll
                    for (int j = 0; j < 8; ++j) {
                        const int s = s0 + 8 * (j >> 2) + (j & 3);
                        const float asj = (j < 4) ? as0[j & 3] : as1[j & 3], dsj = (j < 4) ? ds0[j & 3] : ds1[j & 3];
                        float v = cb[8 * kk + j] * __expf(myacs - asj) * dsj;
                        v = (s <= lcol) ? v : 0.f;
                        v = (s == lcol) ? v + Dh : v;
                        wv[j] = v;
                    }
                    s16x8 afr;
                    { v4u o; o.x = pk2(wv[0], wv[1]); o.y = pk2(wv[2], wv[3]); o.z = pk2(wv[4], wv[5]); o.w = pk2(wv[6], wv[7]); afr = __builtin_bit_cast(s16x8, o); }
                    s16x8 b0, b1;
                    if (kk == 0) { b0 = tr_frag<0, 8 * SSD_RS_X>(xb); b1 = tr_frag<64, 8 * SSD_RS_X + 64>(xb); }
                    else { b0 = tr_frag<16 * SSD_RS_X, 24 * SSD_RS_X>(xb); b1 = tr_frag<16 * SSD_RS_X + 64, 24 * SSD_RS_X + 64>(xb); }
                    y[h3][0] = __builtin_amdgcn_mfma_f32_32x32x16_bf16(afr, b0, y[h3][0], 0, 0, 0);
                    y[h3][1] = __builtin_amdgcn_mfma_f32_32x32x16_bf16(afr, b1, y[h3][1], 0, 0, 0);
                    __builtin_amdgcn_sched_barrier(0);
                }
            }
        }
        __syncthreads();
        {
            LAS unsigned short* yst = (LAS unsigned short*)(ldsb + SSD_L_X);
#pragma unroll
            for (int h3 = 0; h3 < 3; ++h3)
#pragma unroll
                for (int ptile = 0; ptile < 2; ++ptile)
#pragma unroll
                    for (int reg = 0; reg < 16; ++reg) {
                        const int l0 = 32 * lt + (reg & 3) + 8 * (reg >> 2) + 4 * h;
                        const int col = (3 * hs + h3) * 64 + 32 * ptile + r;
                        yst[l0 * (SSD_RS_Y / 2) + col] = (unsigned short)f2bf(y[h3][ptile][reg]);
                    }
        }
        __syncthreads();
#pragma unroll
        for (int pass = 0; pass < 4; ++pass) {
            const int l = 4 * (pass * 8 + w) + (lane >> 4), i16 = lane & 15;
            float gv[3][8]; float ss = 0.f;
#pragma unroll
            for (int k = 0; k < 3; ++k) {
                const int col0 = 24 * i16 + 8 * k;
                float yv[8], zv[8];
                unpack8(*(const LAS v4u*)(ldsb + SSD_L_X + l * SSD_RS_Y + col0 * 2), yv);
                unpack8(*(const v4u*)(projb + (size_t)(t0 + l) * NB_LD + g * 384 + col0), zv);
#pragma unroll
                for (int j = 0; j < 8; ++j) { const float gg = yv[j] * silu_f(zv[j]); gv[k][j] = gg; ss += gg * gg; }
            }
            ss += __shfl_xor(ss, 1); ss += __shfl_xor(ss, 2); ss += __shfl_xor(ss, 4); ss += __shfl_xor(ss, 8);
            const float rstd = rsqrtf(ss * (1.0f / 384.0f) + LN_EPS);
#pragma unroll
            for (int k = 0; k < 3; ++k) {
                const int col0 = g * 384 + 24 * i16 + 8 * k;
                const float4 g0 = *(const float4*)(norm_g + col0), g1 = *(const float4*)(norm_g + col0 + 4);
                v4u o; o.x = pk2(gv[k][0] * rstd * g0.x, gv[k][1] * rstd * g0.y); o.y = pk2(gv[k][2] * rstd * g0.z, gv[k][3] * rstd * g0.w);
                o.z = pk2(gv[k][4] * rstd * g1.x, gv[k][5] * rstd * g1.y); o.w = pk2(gv[k][6] * rstd * g1.z, gv[k][7] * rstd * g1.w);
                *(v4u*)(A1 + (size_t)(t0 + l) * MIX_WIDTH + col0) = o;
            }
        }
    }
}

struct Params {
    const float* in[23];
    float* out;
    unsigned char* ws;
    unsigned* bar;
};

#define WS_BAR      0ull
#define WS_XALL     (1ull << 20)
#define WS_PROJ     (WS_XALL + (size_t)T_ALL * D_MODEL * 4)
#define WS_XBC      (WS_PROJ + (size_t)T_ALL * PROJ_LD * 4)
#define WS_DT       (WS_XBC + (size_t)T_ALL * CONV_DIM * 4)
#define WS_QROT     (WS_DT + (size_t)T_ALL * SSD_HEADS * 4)
#define WS_KROT     (WS_QROT + (size_t)T_ALL * ATT_WIDTH * 4)
#define WS_YBUF     (WS_KROT + (size_t)T_ALL * ATT_WIDTH * 4)
#define WS_MIX      (WS_YBUF + (size_t)T_ALL * MIX_WIDTH * 4)
#define WS_HBUF     (WS_MIX + (size_t)T_ALL * D_MODEL * 4)
#define WS_QH       (WS_HBUF + (size_t)T_ALL * D_MODEL * 4)
#define WS_EIDX     (WS_QH + (size_t)T_ALL * 2048 * 4)
#define WS_GATE     (WS_EIDX + (size_t)T_ALL * 128 * 4)
#define WS_A0       (WS_GATE + (size_t)T_ALL * 128 * 4)
#define WS_A1       (WS_A0 + (size_t)T_ALL * D_MODEL * 2)
#define WS_A2       (WS_A1 + (size_t)T_ALL * MIX_WIDTH * 2)
#define WS_WTIN     (WS_A2 + (size_t)T_ALL * D_MODEL * 2)
#define WS_WTOUT    (WS_WTIN + (size_t)PROJ_LD * D_MODEL * 2)
#define WS_WTQ      (WS_WTOUT + (size_t)D_MODEL * MIX_WIDTH * 2)
#define WS_PROJB    (WS_WTQ + (size_t)2048 * D_MODEL * 2)
#define WS_DTRAW    (WS_PROJB + (size_t)T_ALL * NB_LD * 2)
#define WS_XBCB     (WS_DTRAW + (size_t)T_ALL * 32 * 4)
#define WS_QROTB    (WS_XBCB + (size_t)T_ALL * CONV_DIM * 2)
#define WS_KROTB    (WS_QROTB + (size_t)T_ALL * ATT_WIDTH * 2)
#define WS_UB       (WS_KROTB + (size_t)T_ALL * ATT_WIDTH * 2)
#define WS_VB       (WS_UB + (size_t)16384 * D_MODEL * 2)
#define WS_SBUF     (WS_VB + (size_t)16384 * D_MODEL * 2)
#define WS_HIN      (WS_SBUF + (size_t)BATCH * 64 * SSD_HEADS * 64 * 128 * 2)
#define WS_CDEC     (WS_HIN + (size_t)BATCH * 64 * SSD_HEADS * 64 * 128 * 2)
#define WS_END      (WS_CDEC + (size_t)BATCH * 64 * SSD_HEADS * 4)

#define LDS_BYTES (160 * 1024)

__global__ void __launch_bounds__(512, 2) mega_fwd(Params p) {
    extern __shared__ __attribute__((aligned(16))) unsigned char smem[];
    if (threadIdx.x == 0) *(uint4*)smem = make_uint4(0u, 0u, 0u, 0u);
    __syncthreads();
    XcdBarrier bar = xcd_barrier_post(p.bar, (volatile LAS unsigned*)smem);
    float* lds = (float*)(smem + 256);

    const float* x_prompt = p.in[0]; const float* x_sample = p.in[1]; const float* cache_k = p.in[2]; const float* cache_v = p.in[3];
    const float* state_conv = p.in[4]; const float* state_ssm = p.in[5]; const float* w_in = p.in[6]; const float* conv_w = p.in[7];
    const float* conv_b = p.in[8]; const float* dt_bias = p.in[9]; const float* a_log = p.in[10]; const float* d_skip = p.in[11];
    const float* norm_g = p.in[12]; const float* w_out = p.in[13]; const float* ln1_g = p.in[14]; const float* ln1_b = p.in[15];
    const float* peer_wq = p.in[16]; const float* keys1 = p.in[17]; const float* keys2 = p.in[18]; const float* peer_u = p.in[19];
    const float* peer_v = p.in[20]; const float* ln2_g = p.in[21]; const float* ln2_b = p.in[22];
    float* out = p.out;
    float* xall = (float*)(p.ws + WS_XALL); float* proj = (float*)(p.ws + WS_PROJ); float* xbc_act = (float*)(p.ws + WS_XBC);
    float* dtv = (float*)(p.ws + WS_DT); float* qrot = (float*)(p.ws + WS_QROT); float* krot = (float*)(p.ws + WS_KROT);
    float* ybuf = (float*)(p.ws + WS_YBUF); float* mix = (float*)(p.ws + WS_MIX); float* hbuf = (float*)(p.ws + WS_HBUF);
    float* qh = (float*)(p.ws + WS_QH); int* eidx = (int*)(p.ws + WS_EIDX); float* gate = (float*)(p.ws + WS_GATE);
    bf16* A0 = (bf16*)(p.ws + WS_A0); bf16* A1 = (bf16*)(p.ws + WS_A1); bf16* A2 = (bf16*)(p.ws + WS_A2);
    bf16* wt_in = (bf16*)(p.ws + WS_WTIN); bf16* wt_out = (bf16*)(p.ws + WS_WTOUT); bf16* wt_q = (bf16*)(p.ws + WS_WTQ);
    bf16* projb = (bf16*)(p.ws + WS_PROJB); float* dtraw = (float*)(p.ws + WS_DTRAW); bf16* xbc_b = (bf16*)(p.ws + WS_XBCB);
    bf16* qrot_b = (bf16*)(p.ws + WS_QROTB); bf16* krot_b = (bf16*)(p.ws + WS_KROTB); bf16* ub = (bf16*)(p.ws + WS_UB); bf16* vb = (bf16*)(p.ws + WS_VB);
    bf16* Sbuf = (bf16*)(p.ws + WS_SBUF); bf16* Hin = (bf16*)(p.ws + WS_HIN); float* cdec = (float*)(p.ws + WS_CDEC);
    LAS unsigned char* ldsb = (LAS unsigned char*)smem + 256;

    ph_concat_x(x_prompt, x_sample, xall);
    ph_prologue(ldsb, x_prompt, x_sample, A0, w_in, wt_in, w_out, wt_out, peer_wq, wt_q, peer_u, peer_v, ub, vb);
    ph_cache_copy(cache_k, cache_v, out);
    xcd_barrier(bar);
    { pg8::Gemm g{A0, wt_in, T_ALL, PROJ_LD, D_MODEL}; pg8::StaticOrder S; S.init(g.M, g.N, (int)gridDim.x, (int)blockIdx.x);
      pg8::EpiProj E{projb, dtraw}; pg8::gemm_phase<pg8::EpiProj, pg8::StaticOrder, false>(ldsb, g, S, E, nullptr); }
    xcd_barrier(bar);
    ph_post_proj2(projb, dtraw, state_conv, conv_w, conv_b, dt_bias, proj, xbc_act, xbc_b, dtv, qrot, krot, qrot_b, krot_b, out);
    xcd_barrier(bar);
    ph_ssd_states(ldsb, xbc_b, dtv, a_log, Sbuf, cdec);
    __syncthreads();
    ph_ssd_naive(lds, xbc_act, dtv, a_log, d_skip, state_ssm, ybuf, out);
    ph_attn_naive(lds, proj, qrot, krot, cache_k, cache_v, ybuf);
    xcd_barrier(bar);
    ph_ssd_scan(Sbuf, cdec, Hin, out);
    xcd_barrier(bar);
    ph_ssd_out(ldsb, xbc_b, projb, dtv, a_log, d_skip, norm_g, Hin, A1);
    ph_gate_norm(proj, norm_g, ybuf, A1);
    xcd_barrier(bar);
    { pg8::Gemm g{A1, wt_out, T_ALL, D_MODEL, MIX_WIDTH}; pg8::StaticOrder S; S.init(g.M, g.N, (int)gridDim.x, (int)blockIdx.x);
      pg8::EpiF32 E{mix, D_MODEL, nullptr}; pg8::gemm_phase<pg8::EpiF32, pg8::StaticOrder, false>(ldsb, g, S, E, nullptr); }
    xcd_barrier(bar);
    ph_ln_res(xall, mix, ln1_g, ln1_b, hbuf, A2);
    xcd_barrier(bar);
    { pg8::Gemm g{A2, wt_q, T_ALL, 2048, D_MODEL}; pg8::StaticOrder S; S.init(g.M, g.N, (int)gridDim.x, (int)blockIdx.x);
      pg8::EpiF32 E{qh, 2048, nullptr}; pg8::gemm_phase<pg8::EpiF32, pg8::StaticOrder, false>(ldsb, g, S, E, nullptr); }
    xcd_barrier(bar);
    ph_peer_route(lds, qh, keys1, keys2, eidx, gate);
    xcd_barrier(bar);
    ph_peer_ffn(hbuf, eidx, gate, ub, vb, ln2_g, ln2_b, out);
}

extern "C" void kernel_launch(void* const* d_in, const int* in_sizes, int n_in, void* d_out, int out_size, void* d_ws, size_t ws_size, hipStream_t stream) {
    static int grid = 0;
    if (grid == 0) {
        int dev = 0, cus = 0, per_cu = 0;
        if (hipGetDevice(&dev) != hipSuccess || hipDeviceGetAttribute(&cus, hipDeviceAttributeMultiprocessorCount, dev) != hipSuccess) { fprintf(stderr, "kernel_launch: device query failed\n"); grid = -1; return; }
        if (hipFuncSetAttribute((const void*)mega_fwd, hipFuncAttributeMaxDynamicSharedMemorySize, LDS_BYTES) != hipSuccess) { fprintf(stderr, "kernel_launch: hipFuncSetAttribute failed\n"); grid = -1; return; }
        if (hipOccupancyMaxActiveBlocksPerMultiprocessor(&per_cu, (const void*)mega_fwd, NTHR, LDS_BYTES) != hipSuccess || per_cu < 1) { fprintf(stderr, "kernel_launch: occupancy query says %d\n", per_cu); }
        (void)hipGetLastError();
        grid = cus;
        if (ws_size < WS_END) { fprintf(stderr, "kernel_launch: workspace too small\n"); grid = -1; return; }
    }
    if (grid < 0) return;
    (void)hipMemsetAsync((char*)d_ws + WS_BAR, 0, XCD_BAR_WORDS * sizeof(unsigned), stream);
    Params p{};
    for (int i = 0; i < 23; ++i) p.in[i] = (const float*)d_in[i];
    p.out = (float*)d_out; p.ws = (unsigned char*)d_ws; p.bar = (unsigned*)((char*)d_ws + WS_BAR);
    hipLaunchKernelGGL(mega_fwd, dim3(grid), dim3(NTHR), LDS_BYTES, stream, p);
}
```

```cpp
#include <hip/hip_runtime.h>
#include <stdint.h>

#define D_MODEL 1024
#define BATCH 2
#define SEQ 8192
#define DEC_BATCH 128
#define DEC_SEQ 4
#define PAST_LEN 8192
#define HEAD_DIM 64
#define ATT_WIDTH 512
#define ATT_HEADS 8
#define SSD_WIDTH 1536
#define SSD_HEADS 24
#define SSD_GROUPS 4
#define SSD_STATE 128
#define CONV_DIM 2560
#define IN_WIDTH 5656
#define PROJ_LD 5888
#define MIX_WIDTH 2048
#define WBUF 2048
#define PEER_NKEYS 128
#define PEER_HEADS 8
#define PEER_TOPK 16
#define PEER_DKEY 256
#define T_PROMPT (BATCH * SEQ)
#define T_SAMPLE (DEC_BATCH * DEC_SEQ)
#define T_ALL (T_PROMPT + T_SAMPLE)
#define O_Z 0
#define O_XBC 1536
#define O_DT 4096
#define O_Q 4120
#define O_K 4632
#define O_V 5144
#define ALPHA_F 1.189207115002721f
#define LN_EPS 1e-5f

#define OUT_YP 0ull
#define OUT_YS (OUT_YP + 16777216ull)
#define OUT_PK (OUT_YS + 524288ull)
#define OUT_PV (OUT_PK + 2097152ull)
#define OUT_PC (OUT_PV + 2097152ull)
#define OUT_PS (OUT_PC + 15360ull)
#define OUT_SK (OUT_PS + 393216ull)
#define OUT_SV (OUT_SK + 134217728ull)
#define OUT_SC (OUT_SV + 134217728ull)
#define OUT_SS (OUT_SC + 983040ull)

__constant__ double ROPE_INV_REV[32] = {
    1.59154943091895346e-01, 1.19349370211248862e-01, 8.94994016088910133e-02, 6.71150830052272551e-02,
    5.03292121044870353e-02, 3.77415847174197711e-02, 2.83021958306233987e-02, 2.12236527647776604e-02,
    1.59154943091895339e-02, 1.19349370211248862e-02, 8.94994016088910237e-03, 6.71150830052272534e-03,
    5.03292121044870370e-03, 3.77415847174197719e-03, 2.83021958306233987e-03, 2.12236527647776622e-03,
    1.59154943091895356e-03, 1.19349370211248849e-03, 8.94994016088910237e-04, 6.71150830052272599e-04,
    5.03292121044870326e-04, 3.77415847174197741e-04, 2.83021958306233954e-04, 2.12236527647776605e-04,
    1.59154943091895351e-04, 1.19349370211248862e-04, 8.94994016088910182e-05, 6.71150830052272545e-05,
    5.03292121044870354e-05, 3.77415847174197768e-05, 2.83021958306233961e-05, 2.12236527647776592e-05
};

__device__ __forceinline__ float silu_f(float x) { return x / (1.0f + __expf(-x)); }
__device__ __forceinline__ float softplus_f(float x) { return fmaxf(x, 0.f) + log1pf(__expf(-fabsf(x))); }
__device__ __forceinline__ float gelu_f(float x) { return 0.5f * x * (1.0f + erff(x * 0.70710678118654752f)); }
__device__ __forceinline__ float wave_sum(float v) {
#pragma unroll
    for (int o = 32; o > 0; o >>= 1) v += __shfl_xor(v, o);
    return v;
}
__device__ __forceinline__ float wave_max(float v) {
#pragma unroll
    for (int o = 32; o > 0; o >>= 1) v = fmaxf(v, __shfl_xor(v, o));
    return v;
}

#include <cstdio>
#define XB_TMO      128
#define XB_XCNT(j)  (256  + 64 * (j))
#define XB_XSUB(j)  (1280 + 64 * (j))
#define XB_XGEN(j)  (2304 + 64 * (j))
#define XB_TOP      3328
#define XB_TOPGEN   3392
#define XCD_BAR_WORDS 3456
#define XB_SPIN_CAP (1u << 18)
#define LAS __attribute__((address_space(3)))

__device__ __forceinline__ unsigned xb_ld(unsigned* p)              { return __hip_atomic_load(p, __ATOMIC_RELAXED, __HIP_MEMORY_SCOPE_AGENT); }
__device__ __forceinline__ unsigned xb_add(unsigned* p, unsigned v) { return __hip_atomic_fetch_add(p, v, __ATOMIC_RELAXED, __HIP_MEMORY_SCOPE_AGENT); }
__device__ __forceinline__ unsigned xb_xcc_id() { return (unsigned)__builtin_amdgcn_s_getreg((3 << 11) | 20) & 0xFu; }
#define XB_SPIN(cond, bar) do { unsigned _sp = 0; while (cond) { __builtin_amdgcn_s_sleep(1); \
    if ((++_sp & 255u) == 0u) { if (xb_ld(&(bar)[XB_TMO])) break; if (_sp > XB_SPIN_CAP) { atomicAdd(&(bar)[XB_TMO], 1u); break; } } } } while (0)

struct XcdBarrier {
    unsigned* bar; unsigned x;
    volatile LAS unsigned* st;
};

__device__ __forceinline__ XcdBarrier xcd_barrier_post(unsigned* bar, volatile LAS unsigned* st) {
    XcdBarrier b; b.bar = bar; b.x = xb_xcc_id(); b.st = st;
    if (threadIdx.x == 0) (void)xb_add(&bar[XB_XCNT(b.x)], 1u);
    return b;
}
__device__ __forceinline__ void xcd_barrier_complete(unsigned* bar, unsigned x, unsigned& nloc, unsigned& nx) {
    const unsigned G = gridDim.x * gridDim.y * gridDim.z;
    unsigned sum, cnt, mine, sp = 0u;
    for (;;) {
        sum = 0u; cnt = 0u; mine = 0u;
#pragma unroll
        for (unsigned j = 0; j < 16; ++j) { const unsigned c = xb_ld(&bar[XB_XCNT(j)]); sum += c; cnt += (c > 0u) ? 1u : 0u; mine = (j == x) ? c : mine; }
        if (sum == G) break;
        __builtin_amdgcn_s_sleep(1);
        if ((++sp & 255u) == 0u) { if (xb_ld(&bar[XB_TMO])) break; if (sp > XB_SPIN_CAP) { atomicAdd(&bar[XB_TMO], 1u); break; } }
    }
    nloc = mine > 0u ? mine : 1u; nx = cnt > 0u ? cnt : 1u;
}

__device__ __forceinline__ void xcd_barrier(const XcdBarrier& b) {
    asm volatile("s_waitcnt vmcnt(0)" ::: "memory");
    __syncthreads();
    if (threadIdx.x == 0) {
        unsigned* bar = b.bar;
        __builtin_amdgcn_s_waitcnt(0);
        unsigned nloc = b.st[0], nx = b.st[1];
        if (nloc == 0u) { xcd_barrier_complete(bar, b.x, nloc, nx); b.st[0] = nloc; b.st[1] = nx; }
        const unsigned old = xb_add(&bar[XB_XSUB(b.x)], 1u);
        const unsigned gen = old / nloc;
        if (old + 1u == (gen + 1u) * nloc) {
            __builtin_amdgcn_fence(__ATOMIC_RELEASE, "agent");
            asm volatile("s_waitcnt vmcnt(0)" ::: "memory");
            const unsigned og = xb_add(&bar[XB_TOP], 1u);
            const unsigned tg = og / nx;
            if (og + 1u == (tg + 1u) * nx) xb_add(&bar[XB_TOPGEN], 1u);
            else XB_SPIN(xb_ld(&bar[XB_TOPGEN]) == tg, bar);
            __builtin_amdgcn_fence(__ATOMIC_ACQUIRE, "agent");
            xb_add(&bar[XB_XGEN(b.x)], 1u);
            asm volatile("s_waitcnt vmcnt(0)" ::: "memory");
        } else {
            XB_SPIN(xb_ld(&bar[XB_XGEN(b.x)]) == gen, bar);
            __builtin_amdgcn_fence(__ATOMIC_ACQUIRE, "agent");
            asm volatile("s_waitcnt vmcnt(0)" ::: "memory");
        }
    }
    __syncthreads();
}


#define GAS __attribute__((address_space(1)))
typedef unsigned short bf16;
typedef unsigned v4u __attribute__((ext_vector_type(4)));
#define LDS_WAIT() asm volatile("s_waitcnt lgkmcnt(0)" ::: "memory")
__device__ __forceinline__ unsigned f2bf(float f) { unsigned u = __builtin_bit_cast(unsigned, f); return (u + 0x7fffu + ((u >> 16) & 1u)) >> 16; }
__device__ __forceinline__ unsigned pk2(float lo, float hi) { return f2bf(lo) | (f2bf(hi) << 16); }
__device__ __forceinline__ float bf2f(unsigned short b) { return __builtin_bit_cast(float, (unsigned)b << 16); }
#include <hip/hip_runtime.h>
namespace pg8 {
#define PG8_LAS __attribute__((address_space(3)))
typedef unsigned short bf16_t;
typedef short bf16x8 __attribute__((ext_vector_type(8)));
typedef float f32x4 __attribute__((ext_vector_type(4)));
typedef unsigned u32x4 __attribute__((ext_vector_type(4)));
constexpr int BM = 256, BK = 64, HALF = 128, HTB = HALF * BK * 2  , STAGE_BYTES = 8 * HTB, NXCD = 8, WGM = 8;

__host__ __device__ __forceinline__ int lds_byte(int r, int c) { const int st = (r >> 4) * 2 + (c >> 5), rr = r & 15, cc = c & 31, ob = rr * 64 + cc * 2; return st * 1024 + (ob ^ (((ob >> 9) & 1) << 5)); }
__host__ __device__ __forceinline__ void stage_rc(int b, int& R, int& C) { const int st = b / 1024, sb = b % 1024, swz = sb ^ (((sb >> 9) & 1) << 5); R = (st >> 1) * 16 + swz / 64; C = (st & 1) * 32 + (swz % 64) / 2; }
__host__ __device__ __forceinline__ int perm32(int rho) { const int n = rho >> 4, i = rho & 15; return 8 * (i >> 2) + 4 * n + (i & 3); }

struct Unit { int pm, pn; };
struct Gemm { const bf16_t* A; const bf16_t* Bt; int M, N, K; };

struct StaticOrder {
    int nM, nN, nwg, G, c;
    __host__ __device__ void init(int M, int N, int G_, int c_) { nM = M / BM; nN = N / BM; nwg = nM * nN; G = G_; c = c_; }
    __host__ __device__ bool next(int i, Unit& u) const {
        const long L = (long)i * G + c; if (L >= nwg) return false;
        int wgid = (int)L; { const int q = nwg / NXCD, r = nwg % NXCD, xcd = wgid % NXCD, off = wgid / NXCD; wgid = (xcd < r ? xcd * (q + 1) : r * (q + 1) + (xcd - r) * q) + off; }
        const int nig = WGM * nN, gid = wgid / nig, fm = gid * WGM, gsz = (nM - fm) < WGM ? (nM - fm) : WGM;
        u.pm = fm + ((wgid % nig) % gsz); u.pn = (wgid % nig) / gsz; return true;
    }
    __device__ __forceinline__ void a_ready(const Unit&) const {}
    __device__ __forceinline__ void done(const Unit&) const {}
};
__device__ __forceinline__ unsigned cvt_pk_bf16(float lo, float hi) { unsigned r; asm volatile("v_cvt_pk_bf16_f32 %0, %1, %2" : "=v"(r) : "v"(lo), "v"(hi)); return r; }
typedef float f32x2 __attribute__((ext_vector_type(2)));
__device__ __forceinline__ f32x2 gelu_pk(f32x2 v) {
    const f32x2 av = __builtin_elementwise_abs(v), d = av * 0.2316418882f + 1.0f;
    f32x2 t; t.x = __builtin_amdgcn_rcpf(d.x); t.y = __builtin_amdgcn_rcpf(d.y);
    f32x2 q = t * 0.5307027145f + (-0.7265760135f); q = q * t + 0.7107068705f; q = q * t + (-0.142248368f); q = q * t + 0.127414796f; q = q * t;
    const f32x2 s = (v * v) * (-0.72134752044f);
    f32x2 e; e.x = __builtin_amdgcn_exp2f(s.x); e.y = __builtin_amdgcn_exp2f(s.y);
    const f32x2 m = v * (q * e), r = v - m;
    f32x2 o; o.x = v.x < 0.f ? m.x : r.x; o.y = v.y < 0.f ? m.y : r.y; return o;
}

struct EpiF32 {
    static constexpr bool PERM = false, AFTER_DRAIN = false;
    float* C; int ldc; const float* bias;
    __device__ __forceinline__ void operator()(const f32x4 (&acc)[2][2][4][2], const Unit& u, int wr, int wc, int fr, int fq) const {
        const int row0 = u.pm * BM + wr * 64 + fr, col0 = u.pn * BM + wc * 32 + 4 * fq;
        f32x4 bv[2][2];
#pragma unroll
        for (int bj = 0; bj < 2; ++bj)
#pragma unroll
            for (int n = 0; n < 2; ++n) bv[bj][n] = bias ? *(const f32x4*)(bias + col0 + bj * HALF + n * 16) : (f32x4){0.f, 0.f, 0.f, 0.f};
#pragma unroll
        for (int ai = 0; ai < 2; ++ai)
#pragma unroll
            for (int m = 0; m < 4; ++m) { float* rowp = C + (size_t)(row0 + ai * HALF + m * 16) * ldc + col0;
#pragma unroll
                for (int bj = 0; bj < 2; ++bj)
#pragma unroll
                    for (int n = 0; n < 2; ++n) *(f32x4*)(rowp + bj * HALF + n * 16) = acc[ai][bj][m][n] + bv[bj][n]; }
    }
};

template <class Epi, class Sched, bool STAMP = false>
__device__ __forceinline__ void gemm_phase(PG8_LAS unsigned char* lds, const Gemm g, const Sched& S, const Epi& E, unsigned long long* stamps) {
    const int tid = threadIdx.x, wid = __builtin_amdgcn_readfirstlane(tid >> 6), lane = tid & 63, wr = wid >> 2, wc = wid & 3, fr = lane & 15, fq = lane >> 4;
    const int K = g.K, nt = K / BK;
    int ts_lo = 0, ts_hi = 0, nts = 0; const unsigned long long rt_entry = STAMP ? (unsigned long long)wall_clock64() : 0ull;
#define PG8_STAMP() do { if (STAMP && wid == 0 && nts < 64) { const unsigned long long _c = (unsigned long long)clock64(); \
        ts_lo = (lane == nts) ? (int)(unsigned)_c : ts_lo; ts_hi = (lane == nts) ? (int)(unsigned)(_c >> 32) : ts_hi; ++nts; } } while (0)
    PG8_STAMP();
    unsigned voffA[2], voffB[2];
#pragma unroll
    for (int i = 0; i < 2; ++i) { int R, C; stage_rc(tid * 16 + i * 8192, R, C); const int Rb = Epi::PERM ? ((R & ~31) + perm32(R & 31)) : R;
        voffA[i] = (unsigned)(R * K + C) * 2u; voffB[i] = (unsigned)(Rb * K + C) * 2u; }
    const size_t kstep = (size_t)(BK * 2);
    const size_t hstep = (size_t)HALF * K * 2;
    const size_t tstep = 2 * hstep;
    const unsigned ldsw = (unsigned)wid * 1024u;
    const int aoff = lds_byte(wr * 64 + fr, fq * 8), boff = lds_byte(wc * 32 + fr, fq * 8);
#define PG8_SA(b, h) (((b) * 2 + (h)) * HTB)
#define PG8_SB(b, h) ((4 + (b) * 2 + (h)) * HTB)
#define PG8_STAGE(bufoff, gbase, voff) do { _Pragma("unroll") for (int _i = 0; _i < 2; ++_i) \
        __builtin_amdgcn_global_load_lds((const unsigned*)((const char*)(gbase) + (voff)[_i]), (PG8_LAS unsigned*)(lds + (bufoff) + ldsw + _i * 8192), 16, 0, 0); } while (0)
#define PG8_LDA(dst, b, h) do { _Pragma("unroll") for (int m = 0; m < 4; ++m) _Pragma("unroll") for (int k = 0; k < 2; ++k) dst[m][k] = *(const PG8_LAS bf16x8*)(lds + PG8_SA(b, h) + aoff + m * 2048 + k * 1024); } while (0)
#define PG8_LDB(dst, b, h) do { _Pragma("unroll") for (int n = 0; n < 2; ++n) _Pragma("unroll") for (int k = 0; k < 2; ++k) dst[n][k] = *(const PG8_LAS bf16x8*)(lds + PG8_SB(b, h) + boff + n * 2048 + k * 1024); } while (0)
#define PG8_MMA(ai, bj, At, Bt) do { __builtin_amdgcn_s_setprio(1); _Pragma("unroll") for (int m = 0; m < 4; ++m) _Pragma("unroll") for (int n = 0; n < 2; ++n) _Pragma("unroll") for (int k = 0; k < 2; ++k) \
        acc[ai][bj][m][n] = __builtin_amdgcn_mfma_f32_16x16x32_bf16(Bt[n][k], At[m][k], acc[ai][bj][m][n], 0, 0, 0); __builtin_amdgcn_s_setprio(0); } while (0)
#define PG8_WAIT_V(n) asm volatile("s_waitcnt vmcnt(" #n ")" ::: "memory")
#define PG8_WAIT_L(n) asm volatile("s_waitcnt lgkmcnt(" #n ")" ::: "memory")
#define PG8_BAR __builtin_amdgcn_s_barrier()
#define PG8_SCHED __builtin_amdgcn_sched_barrier(0)
    Unit cur, nxt; int ui = 0;
    if (!S.next(0, cur)) return;
    f32x4 acc[2][2][4][2];
#pragma unroll
    for (int a = 0; a < 2; ++a)
#pragma unroll
        for (int b = 0; b < 2; ++b)
#pragma unroll
            for (int m = 0; m < 4; ++m)
#pragma unroll
                for (int n = 0; n < 2; ++n) acc[a][b][m][n] = (f32x4){0.f, 0.f, 0.f, 0.f};
    bf16x8 At[4][2], B0[2][2], B1[2][2];
    const char* cA = (const char*)g.A + (size_t)cur.pm * tstep; const char* cB = (const char*)g.Bt + (size_t)cur.pn * tstep;
    S.a_ready(cur);
    PG8_STAGE(PG8_SB(0, 0), cB, voffB); PG8_STAGE(PG8_SA(0, 0), cA, voffA); PG8_STAGE(PG8_SB(0, 1), cB + hstep, voffB); PG8_STAGE(PG8_SA(0, 1), cA + hstep, voffA);
    if (wr == 1) PG8_BAR;
    PG8_WAIT_V(4); PG8_BAR;
    PG8_STAGE(PG8_SB(1, 0), cB + kstep, voffB); PG8_STAGE(PG8_SA(1, 0), cA + kstep, voffA); PG8_STAGE(PG8_SB(1, 1), cB + hstep + kstep, voffB);
    PG8_WAIT_V(6); PG8_BAR;
    PG8_STAMP();
    for (;;) {
        const bool has_next = S.next(ui + 1, nxt);
        const char* nA = has_next ? (const char*)g.A + (size_t)nxt.pm * tstep : cA; const char* nB = has_next ? (const char*)g.Bt + (size_t)nxt.pn * tstep : cB;
        for (int t = 0; t < nt; t += 2) {
            const bool last = (t == nt - 2);
            const char* a1 = cA + (size_t)(t + 1) * kstep;
            const char* a2 = last ? nA : cA + (size_t)(t + 2) * kstep; const char* b2 = last ? nB : cB + (size_t)(t + 2) * kstep;
            const char* a3 = a2 + kstep; const char* b3 = b2 + kstep;
            if (last && has_next) S.a_ready(nxt);
            PG8_LDB(B0, 0, 0); PG8_SCHED; PG8_LDA(At, 0, 0); PG8_STAGE(PG8_SA(1, 1), a1 + hstep, voffA);
            PG8_WAIT_L(8); PG8_BAR; PG8_WAIT_L(0); PG8_MMA(0, 0, At, B0); PG8_BAR; PG8_SCHED;
            PG8_LDB(B1, 0, 1); PG8_STAGE(PG8_SB(0, 0), b2, voffB);
            PG8_BAR; PG8_WAIT_L(0); PG8_MMA(0, 1, At, B1); PG8_BAR;
            PG8_LDA(At, 0, 1); PG8_STAGE(PG8_SA(0, 0), a2, voffA);
            PG8_BAR; PG8_WAIT_L(0); PG8_MMA(1, 0, At, B0); PG8_BAR; PG8_SCHED;
            PG8_STAGE(PG8_SB(0, 1), b2 + hstep, voffB);
            PG8_WAIT_V(6); PG8_BAR; PG8_MMA(1, 1, At, B1); PG8_BAR;
            PG8_LDB(B0, 1, 0); PG8_SCHED; PG8_LDA(At, 1, 0); PG8_STAGE(PG8_SA(0, 1), a2 + hstep, voffA);
            PG8_WAIT_L(8); PG8_BAR; PG8_WAIT_L(0); PG8_MMA(0, 0, At, B0); PG8_BAR; PG8_SCHED;
            PG8_LDB(B1, 1, 1); PG8_STAGE(PG8_SB(1, 0), b3, voffB);
            PG8_BAR; PG8_WAIT_L(0); PG8_MMA(0, 1, At, B1); PG8_BAR;
            PG8_LDA(At, 1, 1); PG8_STAGE(PG8_SA(1, 0), a3, voffA);
            PG8_BAR; PG8_WAIT_L(0); PG8_MMA(1, 0, At, B0); PG8_BAR; PG8_SCHED;
            PG8_STAGE(PG8_SB(1, 1), b3 + hstep, voffB);
            PG8_WAIT_V(6); PG8_BAR; PG8_MMA(1, 1, At, B1); PG8_BAR;
        }
        PG8_STAMP();
        if constexpr (!Epi::AFTER_DRAIN) { E(acc, cur, wr, wc, fr, fq); S.done(cur); }
        PG8_STAMP();
        if (!has_next) break;
#pragma unroll
        for (int a = 0; a < 2; ++a)
#pragma unroll
            for (int b = 0; b < 2; ++b)
#pragma unroll
                for (int m = 0; m < 4; ++m)
#pragma unroll
                    for (int n = 0; n < 2; ++n) acc[a][b][m][n] = (f32x4){0.f, 0.f, 0.f, 0.f};
        cur = nxt; cA = nA; cB = nB; ++ui;
    }
    PG8_WAIT_V(0);
    if (wr == 0) PG8_BAR;
    PG8_BAR;
    if constexpr (Epi::AFTER_DRAIN) { E.fused(acc, cur, wr, wc, fr, fq, lds, wid, lane); S.done(cur); }
    PG8_STAMP();
    if (STAMP && wid == 0) { stamps[lane] = lane < nts ? (((unsigned long long)(unsigned)ts_hi << 32) | (unsigned)ts_lo) : 0ull;
        if (lane == 62) stamps[62] = rt_entry; if (lane == 63) stamps[63] = (unsigned long long)wall_clock64(); }
#undef PG8_STAMP
#undef PG8_SA
#undef PG8_SB
#undef PG8_STAGE
#undef PG8_LDA
#undef PG8_LDB
#undef PG8_MMA
#undef PG8_WAIT_V
#undef PG8_WAIT_L
#undef PG8_BAR
#undef PG8_SCHED
}
}


namespace pg8 {
struct EpiProj {
    static constexpr bool PERM = true, AFTER_DRAIN = false;
    bf16_t* O; float* dtraw;
    __device__ __forceinline__ void operator()(const f32x4 (&acc)[2][2][4][2], const Unit& u, int wr, int wc, int fr, int fq) const {
        const int row0 = u.pm * BM + wr * 64 + fr;
        if (u.pn < 22) {
            const int col0 = u.pn * BM + wc * 32 + 8 * fq;
#pragma unroll
            for (int ai = 0; ai < 2; ++ai)
#pragma unroll
                for (int m = 0; m < 4; ++m) { bf16_t* rowp = O + (size_t)(row0 + ai * HALF + m * 16) * 5632 + col0;
#pragma unroll
                    for (int bj = 0; bj < 2; ++bj) { const f32x4 v0 = acc[ai][bj][m][0], v1 = acc[ai][bj][m][1];
                        u32x4 w; w.x = cvt_pk_bf16(v0[0], v0[1]); w.y = cvt_pk_bf16(v0[2], v0[3]); w.z = cvt_pk_bf16(v1[0], v1[1]); w.w = cvt_pk_bf16(v1[2], v1[3]);
                        *(u32x4*)(rowp + bj * HALF) = w; } }
        } else if (wc == 0) {
#pragma unroll
            for (int ai = 0; ai < 2; ++ai)
#pragma unroll
                for (int m = 0; m < 4; ++m) { float* rp = dtraw + (size_t)(row0 + ai * HALF + m * 16) * 32 + 8 * fq;
                    *(f32x4*)rp = acc[ai][0][m][0]; *(f32x4*)(rp + 4) = acc[ai][0][m][1]; }
        }
    }
};
}

#define NTHR 512
#define NWAVE 8

__device__ __forceinline__ void ph_gemm_f32(float* lds, const float* __restrict__ A, const float* __restrict__ B, float* __restrict__ C,
                                            int M, int N, int K, int lda, int ldb, int ldc) {
    const int tid = threadIdx.x & 255, half = threadIdx.x >> 8, tx = tid & 15, ty = tid >> 4;
    float (*As)[68] = (float (*)[68])(lds + half * 2 * 16 * 68);
    float (*Bs)[68] = (float (*)[68])(lds + half * 2 * 16 * 68 + 16 * 68);
    const int ntx = (N + 63) / 64, nty = M / 64, ntiles = ntx * nty;
    for (int it = blockIdx.x; 2 * it < ntiles; it += gridDim.x) {
        const int tile = 2 * it + half;
        const int m0 = (tile / ntx) * 64, n0 = (tile % ntx) * 64;
        float acc[4][4];
#pragma unroll
        for (int i = 0; i < 4; ++i)
#pragma unroll
            for (int j = 0; j < 4; ++j) acc[i][j] = 0.f;
        for (int k0 = 0; k0 < K; k0 += 16) {
#pragma unroll
            for (int i = 0; i < 4; ++i) {
                int idx = tid + i * 256;
                int r = idx >> 4, c = idx & 15;
                As[c][r] = (m0 + r < M) ? A[(size_t)(m0 + r) * lda + k0 + c] : 0.f;
                int rb = idx >> 6, cb = idx & 63;
                Bs[rb][cb] = (n0 + cb < N) ? B[(size_t)(k0 + rb) * ldb + n0 + cb] : 0.f;
            }
            __syncthreads();
#pragma unroll
            for (int k = 0; k < 16; ++k) {
                float a[4], b[4];
#pragma unroll
                for (int i = 0; i < 4; ++i) { a[i] = As[k][ty * 4 + i]; b[i] = Bs[k][tx * 4 + i]; }
#pragma unroll
                for (int i = 0; i < 4; ++i)
#pragma unroll
                    for (int j = 0; j < 4; ++j) acc[i][j] += a[i] * b[j];
            }
            __syncthreads();
        }
#pragma unroll
        for (int i = 0; i < 4; ++i)
#pragma unroll
            for (int j = 0; j < 4; ++j) {
                int r = m0 + ty * 4 + i, c = n0 + tx * 4 + j;
                if (r < M && c < N) C[(size_t)r * ldc + c] = acc[i][j];
            }
    }
}


template <int MODE>
__device__ __forceinline__ void transpose_item(const float* __restrict__ W, int K, int N, int Npad, bf16* __restrict__ WT, LAS float* scr, int item, int lane) {
    const int nblk = Npad / 32, kb = item / nblk, nb = item % nblk, k0 = 64 * kb, n0 = 32 * nb;
    const int n = n0 + (lane & 31);
    int sc = n;
    if (MODE == 1) sc = (n < 4096) ? n : (n < 5632 ? n + 24 : (n < 5656 ? n - 5632 + 4096 : -1));
    else sc = (n < N) ? n : -1;
#pragma unroll 8
    for (int i = 0; i < 32; ++i) { const int kk = 2 * i + (lane >> 5); scr[kk * 33 + (lane & 31)] = (sc >= 0) ? W[(size_t)(k0 + kk) * N + sc] : 0.f; }
    LDS_WAIT(); asm volatile("" ::: "memory");
    const int c = lane & 7;
#pragma unroll
    for (int j = 0; j < 4; ++j) { const int nn = (lane >> 3) + 8 * j; const LAS float* s = scr + (8 * c) * 33 + nn;
        v4u o; o.x = pk2(s[0 * 33], s[1 * 33]); o.y = pk2(s[2 * 33], s[3 * 33]); o.z = pk2(s[4 * 33], s[5 * 33]); o.w = pk2(s[6 * 33], s[7 * 33]);
        *(v4u*)(WT + (size_t)(n0 + nn) * K + k0 + 8 * c) = o; }
    LDS_WAIT(); asm volatile("" ::: "memory");
}
__device__ __forceinline__ void ph_prologue(LAS unsigned char* ldsb, const float* __restrict__ xp, const float* __restrict__ xs, bf16* __restrict__ A0,
                                            const float* __restrict__ w_in, bf16* __restrict__ wt_in, const float* __restrict__ w_out, bf16* __restrict__ wt_out,
                                            const float* __restrict__ w_q, bf16* __restrict__ wt_q,
                                            const float* __restrict__ pu, const float* __restrict__ pv, bf16* __restrict__ ub, bf16* __restrict__ vb) {
    const int lane = threadIdx.x & 63, wave = threadIdx.x >> 6;
    LAS float* scr = (LAS float*)(ldsb + wave * 16384);
    const int gw = blockIdx.x * NWAVE + wave, NGW = gridDim.x * NWAVE;
    constexpr int I_IN = (D_MODEL / 64) * (PROJ_LD / 32), I_OUT = (MIX_WIDTH / 64) * (D_MODEL / 32), I_Q = (D_MODEL / 64) * (2048 / 32);
    for (int it = gw; it < I_IN + I_OUT + I_Q; it += NGW) {
        int r = it;
        if (r < I_IN) { transpose_item<1>(w_in, D_MODEL, IN_WIDTH, PROJ_LD, wt_in, scr, r, lane); continue; } r -= I_IN;
        if (r < I_OUT) { transpose_item<0>(w_out, MIX_WIDTH, D_MODEL, D_MODEL, wt_out, scr, r, lane); continue; } r -= I_OUT;
        transpose_item<0>(w_q, D_MODEL, 2048, 2048, wt_q, scr, r, lane);
    }
    const size_t n8 = (size_t)T_ALL * D_MODEL / 8, np8 = (size_t)T_PROMPT * D_MODEL / 8;
    for (size_t i = (size_t)blockIdx.x * NTHR + threadIdx.x; i < n8; i += (size_t)gridDim.x * NTHR) {
        const float4* s = (i < np8) ? (const float4*)xp + 2 * i : (const float4*)xs + 2 * (i - np8);
        float4 a = s[0], b = s[1];
        v4u o; o.x = pk2(a.x, a.y); o.y = pk2(a.z, a.w); o.z = pk2(b.x, b.y); o.w = pk2(b.z, b.w);
        ((v4u*)A0)[i] = o;
    }
    const size_t t8 = (size_t)16384 * D_MODEL / 8;
    for (size_t i = (size_t)blockIdx.x * NTHR + threadIdx.x; i < 2 * t8; i += (size_t)gridDim.x * NTHR) {
        const float4* s = (i < t8) ? (const float4*)pu + 2 * i : (const float4*)pv + 2 * (i - t8);
        float4 a = s[0], b = s[1];
        v4u o; o.x = pk2(a.x, a.y); o.y = pk2(a.z, a.w); o.z = pk2(b.x, b.y); o.w = pk2(b.z, b.w);
        if (i < t8) ((v4u*)ub)[i] = o; else ((v4u*)vb)[i - t8] = o;
    }
}

__device__ __forceinline__ void ph_concat_x(const float* __restrict__ xp, const float* __restrict__ xs, float* __restrict__ xall) {
    const size_t n4 = (size_t)T_ALL * D_MODEL / 4, np4 = (size_t)T_PROMPT * D_MODEL / 4;
    for (size_t i = (size_t)blockIdx.x * NTHR + threadIdx.x; i < n4; i += (size_t)gridDim.x * NTHR) {
        float4 v = (i < np4) ? ((const float4*)xp)[i] : ((const float4*)xs)[i - np4];
        ((float4*)xall)[i] = v;
    }
}

__device__ __forceinline__ void ph_cache_copy(const float* __restrict__ ck, const float* __restrict__ cv, float* __restrict__ out) {
    const size_t per_b4 = (size_t)(WBUF - DEC_SEQ) * ATT_WIDTH / 4;
    const size_t total = per_b4 * DEC_BATCH;
    for (size_t i = (size_t)blockIdx.x * NTHR + threadIdx.x; i < total; i += (size_t)gridDim.x * NTHR) {
        size_t b = i / per_b4, r = i % per_b4;
        size_t src = (b * WBUF * ATT_WIDTH + DEC_SEQ * ATT_WIDTH) / 4 + r;
        size_t dst = (b * WBUF * ATT_WIDTH) / 4 + r;
        ((float4*)(out + OUT_SK))[dst] = ((const float4*)ck)[src];
        ((float4*)(out + OUT_SV))[dst] = ((const float4*)cv)[src];
    }
}

__device__ __forceinline__ void ph_post_proj(const float* __restrict__ proj, const float* __restrict__ state_conv,
                                             const float* __restrict__ conv_w, const float* __restrict__ conv_b, const float* __restrict__ dt_bias,
                                             float* __restrict__ xbc_act, float* __restrict__ dtv, float* __restrict__ qrot, float* __restrict__ krot,
                                             float* __restrict__ out) {
    const int tid = threadIdx.x & 255, half = threadIdx.x >> 8;
    for (int t = 2 * blockIdx.x + half; t < T_ALL; t += 2 * gridDim.x) {
        const bool is_p = t < T_PROMPT;
        int b, i, pos;
        if (is_p) { b = t / SEQ; i = t % SEQ; pos = i; } else { int ts = t - T_PROMPT; b = ts / DEC_SEQ; i = ts % DEC_SEQ; pos = PAST_LEN + i; }
        const float* row = proj + (size_t)t * PROJ_LD;
        for (int c = tid; c < CONV_DIM; c += 256) {
            float acc = conv_b[c];
#pragma unroll
            for (int tap = 0; tap < 4; ++tap) {
                int r = i - 3 + tap;
                float val;
                if (r >= 0) val = proj[(size_t)(t - i + r) * PROJ_LD + O_XBC + c];
                else val = is_p ? 0.f : state_conv[((size_t)b * 3 + (3 + r)) * CONV_DIM + c];
                acc += val * conv_w[tap * CONV_DIM + c];
            }
            xbc_act[(size_t)t * CONV_DIM + c] = silu_f(acc);
        }
        if (tid < SSD_HEADS) dtv[(size_t)t * SSD_HEADS + tid] = softplus_f(row[O_DT + tid] + dt_bias[tid]);
        for (int idx = tid; idx < 512; idx += 256) {
            int which = idx >> 8, h = (idx >> 5) & 7, j = idx & 31;
            double rev = (double)pos * ROPE_INV_REV[j];
            float fr = (float)(rev - floor(rev));
            float sn = __builtin_amdgcn_sinf(fr), cs = __builtin_amdgcn_cosf(fr);
            const float* src = row + (which ? O_K : O_Q) + h * 64;
            float t1 = src[j], t2 = src[j + 32];
            float o1 = t1 * cs - t2 * sn, o2 = t2 * cs + t1 * sn;
            float* dst = (which ? krot : qrot) + (size_t)t * ATT_WIDTH + h * 64;
            dst[j] = o1; dst[j + 32] = o2;
            if (which) {
                if (is_p) { if (i >= SEQ - WBUF) { float* o = out + OUT_PK + ((size_t)b * WBUF + (i - (SEQ - WBUF))) * ATT_WIDTH + h * 64; o[j] = o1; o[j + 32] = o2; } }
                else { float* o = out + OUT_SK + ((size_t)b * WBUF + (WBUF - DEC_SEQ + i)) * ATT_WIDTH + h * 64; o[j] = o1; o[j + 32] = o2; }
            }
        }
        for (int c = tid; c < ATT_WIDTH; c += 256) {
            float v = row[O_V + c];
            if (is_p) { if (i >= SEQ - WBUF) out[OUT_PV + ((size_t)b * WBUF + (i - (SEQ - WBUF))) * ATT_WIDTH + c] = v; }
            else out[OUT_SV + ((size_t)b * WBUF + (WBUF - DEC_SEQ + i)) * ATT_WIDTH + c] = v;
        }
        if (is_p) {
            if (i >= SEQ - 3) { int r = i - (SEQ - 3); for (int c = tid; c < CONV_DIM; c += 256) out[OUT_PC + ((size_t)b * 3 + r) * CONV_DIM + c] = row[O_XBC + c]; }
        } else {
            if (i >= 1) { int r = i - 1; for (int c = tid; c < CONV_DIM; c += 256) out[OUT_SC + ((size_t)b * 3 + r) * CONV_DIM + c] = row[O_XBC + c]; }
        }
    }
}


#define NB_LD 5632
#define NB_XBC 1536
#define NB_Q 4096
#define NB_K 4608
#define NB_V 5120
__device__ __forceinline__ void unpack8(const v4u w, float (&f)[8]) {
    f[0] = __builtin_bit_cast(float, w.x << 16); f[1] = __builtin_bit_cast(float, w.x & 0xffff0000u);
    f[2] = __builtin_bit_cast(float, w.y << 16); f[3] = __builtin_bit_cast(float, w.y & 0xffff0000u);
    f[4] = __builtin_bit_cast(float, w.z << 16); f[5] = __builtin_bit_cast(float, w.z & 0xffff0000u);
    f[6] = __builtin_bit_cast(float, w.w << 16); f[7] = __builtin_bit_cast(float, w.w & 0xffff0000u);
}
__device__ __forceinline__ void store8f(float* d, const float (&f)[8]) { *(float4*)d = make_float4(f[0], f[1], f[2], f[3]); *(float4*)(d + 4) = make_float4(f[4], f[5], f[6], f[7]); }
__device__ __forceinline__ void ph_post_proj2(const bf16* __restrict__ projb, const float* __restrict__ dtraw, const float* __restrict__ state_conv,
                                              const float* __restrict__ conv_w, const float* __restrict__ conv_b, const float* __restrict__ dt_bias,
                                              float* __restrict__ proj, float* __restrict__ xbc_act, bf16* __restrict__ xbc_b, float* __restrict__ dtv,
                                              float* __restrict__ qrot, float* __restrict__ krot, bf16* __restrict__ qrot_b, bf16* __restrict__ krot_b,
                                              float* __restrict__ out) {
    const int tid = threadIdx.x & 255, half = threadIdx.x >> 8;
    for (int t = 2 * blockIdx.x + half; t < T_ALL; t += 2 * gridDim.x) {
        const bool is_p = t < T_PROMPT;
        int b, i, pos;
        if (is_p) { b = t / SEQ; i = t % SEQ; pos = i; } else { int ts = t - T_PROMPT; b = ts / DEC_SEQ; i = ts % DEC_SEQ; pos = PAST_LEN + i; }
        const bf16* row = projb + (size_t)t * NB_LD;
        if (tid < 192) { float f[8]; unpack8(*(const v4u*)(row + tid * 8), f); store8f(proj + (size_t)t * PROJ_LD + O_Z + tid * 8, f); }
        if (tid < 64) {
            float f[8]; unpack8(*(const v4u*)(row + NB_V + tid * 8), f);
            store8f(proj + (size_t)t * PROJ_LD + O_V + tid * 8, f);
            if (is_p) { if (i >= SEQ - WBUF) store8f(out + OUT_PV + ((size_t)b * WBUF + (i - (SEQ - WBUF))) * ATT_WIDTH + tid * 8, f); }
            else store8f(out + OUT_SV + ((size_t)b * WBUF + (WBUF - DEC_SEQ + i)) * ATT_WIDTH + tid * 8, f);
        }
        for (int c8 = tid; c8 < 320; c8 += 256) {
            const int c = c8 * 8;
            float acc[8], cur[8];
            { const float4 b0 = *(const float4*)(conv_b + c), b1 = *(const float4*)(conv_b + c + 4);
              acc[0] = b0.x; acc[1] = b0.y; acc[2] = b0.z; acc[3] = b0.w; acc[4] = b1.x; acc[5] = b1.y; acc[6] = b1.z; acc[7] = b1.w; }
#pragma unroll
            for (int tap = 0; tap < 4; ++tap) {
                const int r = i - 3 + tap;
                float val[8];
                if (r >= 0) unpack8(*(const v4u*)(projb + (size_t)(t - i + r) * NB_LD + NB_XBC + c), val);
                else if (!is_p) { const float* sp = state_conv + ((size_t)b * 3 + (3 + r)) * CONV_DIM + c; const float4 s0 = *(const float4*)sp, s1 = *(const float4*)(sp + 4);
                    val[0] = s0.x; val[1] = s0.y; val[2] = s0.z; val[3] = s0.w; val[4] = s1.x; val[5] = s1.y; val[6] = s1.z; val[7] = s1.w; }
                else {
#pragma unroll
                    for (int j = 0; j < 8; ++j) val[j] = 0.f; }
                const float4 w0 = *(const float4*)(conv_w + tap * CONV_DIM + c), w1 = *(const float4*)(conv_w + tap * CONV_DIM + c + 4);
                acc[0] += val[0] * w0.x; acc[1] += val[1] * w0.y; acc[2] += val[2] * w0.z; acc[3] += val[3] * w0.w;
                acc[4] += val[4] * w1.x; acc[5] += val[5] * w1.y; acc[6] += val[6] * w1.z; acc[7] += val[7] * w1.w;
                if (tap == 3) {
#pragma unroll
                    for (int j = 0; j < 8; ++j) cur[j] = val[j]; }
            }
#pragma unroll
            for (int j = 0; j < 8; ++j) acc[j] = silu_f(acc[j]);
            store8f(xbc_act + (size_t)t * CONV_DIM + c, acc);
            v4u o; o.x = pk2(acc[0], acc[1]); o.y = pk2(acc[2], acc[3]); o.z = pk2(acc[4], acc[5]); o.w = pk2(acc[6], acc[7]);
            *(v4u*)(xbc_b + (size_t)t * CONV_DIM + c) = o;
            if (is_p) { if (i >= SEQ - 3) store8f(out + OUT_PC + ((size_t)b * 3 + (i - (SEQ - 3))) * CONV_DIM + c, cur); }
            else { if (i >= 1) store8f(out + OUT_SC + ((size_t)b * 3 + (i - 1)) * CONV_DIM + c, cur); }
        }
        if (tid < SSD_HEADS) dtv[(size_t)t * SSD_HEADS + tid] = softplus_f(dtraw[(size_t)t * 32 + tid] + dt_bias[tid]);
        if (tid < 128) {
            const int which = tid >> 6, h = (tid >> 3) & 7, jc = tid & 7;
            const bf16* src = row + (which ? NB_K : NB_Q) + h * 64 + jc * 4;
            const uint2 lo = *(const uint2*)src, hi = *(const uint2*)(src + 32);
            float t1[4], t2[4], o1[4], o2[4];
            t1[0] = __builtin_bit_cast(float, lo.x << 16); t1[1] = __builtin_bit_cast(float, lo.x & 0xffff0000u); t1[2] = __builtin_bit_cast(float, lo.y << 16); t1[3] = __builtin_bit_cast(float, lo.y & 0xffff0000u);
            t2[0] = __builtin_bit_cast(float, hi.x << 16); t2[1] = __builtin_bit_cast(float, hi.x & 0xffff0000u); t2[2] = __builtin_bit_cast(float, hi.y << 16); t2[3] = __builtin_bit_cast(float, hi.y & 0xffff0000u);
#pragma unroll
            for (int e = 0; e < 4; ++e) {
                const double rev = (double)pos * ROPE_INV_REV[jc * 4 + e];
                const float fr = (float)(rev - floor(rev));
                const float sn = __builtin_amdgcn_sinf(fr), cs = __builtin_amdgcn_cosf(fr);
                o1[e] = t1[e] * cs - t2[e] * sn; o2[e] = t2[e] * cs + t1[e] * sn;
            }
            const size_t doff = (size_t)t * ATT_WIDTH + h * 64 + jc * 4;
            float* df = which ? krot : qrot; bf16* db = which ? krot_b : qrot_b;
            *(float4*)(df + doff) = make_float4(o1[0], o1[1], o1[2], o1[3]); *(float4*)(df + doff + 32) = make_float4(o2[0], o2[1], o2[2], o2[3]);
            *(uint2*)(db + doff) = make_uint2(pk2(o1[0], o1[1]), pk2(o1[2], o1[3])); *(uint2*)(db + doff + 32) = make_uint2(pk2(o2[0], o2[1]), pk2(o2[2], o2[3]));
            if (which) {
                float* o = nullptr;
                if (is_p) { if (i >= SEQ - WBUF) o = out + OUT_PK + ((size_t)b * WBUF + (i - (SEQ - WBUF))) * ATT_WIDTH + h * 64 + jc * 4; }
                else o = out + OUT_SK + ((size_t)b * WBUF + (WBUF - DEC_SEQ + i)) * ATT_WIDTH + h * 64 + jc * 4;
                if (o) { *(float4*)o = make_float4(o1[0], o1[1], o1[2], o1[3]); *(float4*)(o + 32) = make_float4(o2[0], o2[1], o2[2], o2[3]); }
            }
        }
    }
}

#define SSD_CH 32
__device__ __forceinline__ void ph_ssd_naive(float* lds, const float* __restrict__ xbc_act, const float* __restrict__ dtv, const float* __restrict__ a_log,
                                             const float* __restrict__ d_skip, const float* __restrict__ state_ssm, float* __restrict__ ybuf, float* __restrict__ out) {
    float (*sx)[64] = (float (*)[64])lds;
    float (*sB)[128] = (float (*)[128])(lds + SSD_CH * 64);
    float (*sC)[128] = (float (*)[128])(lds + SSD_CH * 64 + SSD_CH * 128);
    float* sdt = lds + SSD_CH * 64 + 2 * SSD_CH * 128;
    const int tid = threadIdx.x, p = tid >> 3, ng = tid & 7;
    for (int vb = BATCH * SSD_HEADS + blockIdx.x; vb < (BATCH + DEC_BATCH) * SSD_HEADS; vb += gridDim.x) {
        const int seq = vb / SSD_HEADS, h = vb % SSD_HEADS, g = h / 6;
        const bool is_p = seq < BATCH;
        const int L = is_p ? SEQ : DEC_SEQ;
        const int t0 = is_p ? seq * SEQ : T_PROMPT + (seq - BATCH) * DEC_SEQ;
        const float A = -__expf(a_log[h]);
        const float D = d_skip[h];
        float hs[16];
        if (is_p) {
#pragma unroll
            for (int j = 0; j < 16; ++j) hs[j] = 0.f;
        } else {
            const float* s0 = state_ssm + (((size_t)(seq - BATCH) * SSD_HEADS + h) * 64 + p) * 128 + ng * 16;
#pragma unroll
            for (int j = 0; j < 16; ++j) hs[j] = s0[j];
        }
        for (int c0 = 0; c0 < L; c0 += SSD_CH) {
            const int nst = (L - c0) < SSD_CH ? (L - c0) : SSD_CH;
            __syncthreads();
            for (int idx = tid; idx < nst * 64; idx += NTHR) { int s = idx >> 6, c = idx & 63; sx[s][c] = xbc_act[(size_t)(t0 + c0 + s) * CONV_DIM + h * 64 + c]; }
            for (int idx = tid; idx < nst * 128; idx += NTHR) { int s = idx >> 7, c = idx & 127;
                sB[s][c] = xbc_act[(size_t)(t0 + c0 + s) * CONV_DIM + 1536 + g * 128 + c];
                sC[s][c] = xbc_act[(size_t)(t0 + c0 + s) * CONV_DIM + 2048 + g * 128 + c]; }
            if (tid < nst) sdt[tid] = dtv[(size_t)(t0 + c0 + tid) * SSD_HEADS + h];
            __syncthreads();
            for (int s = 0; s < nst; ++s) {
                const float dt = sdt[s], x = sx[s][p];
                const float a = __expf(dt * A), xdt = x * dt;
                float y = 0.f;
#pragma unroll
                for (int j = 0; j < 16; ++j) { hs[j] = a * hs[j] + xdt * sB[s][ng * 16 + j]; y += sC[s][ng * 16 + j] * hs[j]; }
                y += __shfl_xor(y, 1); y += __shfl_xor(y, 2); y += __shfl_xor(y, 4);
                if (ng == 0) ybuf[(size_t)(t0 + c0 + s) * MIX_WIDTH + h * 64 + p] = y + D * x;
            }
        }
        float* so = is_p ? out + OUT_PS + (((size_t)seq * SSD_HEADS + h) * 64 + p) * 128 + ng * 16
                         : out + OUT_SS + (((size_t)(seq - BATCH) * SSD_HEADS + h) * 64 + p) * 128 + ng * 16;
#pragma unroll
        for (int j = 0; j < 16; ++j) so[j] = hs[j];
    }
}

__device__ __forceinline__ void ph_gate_norm(const float* __restrict__ proj, const float* __restrict__ norm_g, const float* __restrict__ ybuf, bf16* __restrict__ A1) {
    const int w = threadIdx.x >> 6, lane = threadIdx.x & 63, g = w & 3;
    for (int t = 2 * blockIdx.x + (w >> 2); t < T_ALL; t += 2 * gridDim.x) {
        if (t >= T_PROMPT) {
        float v[6]; float ss = 0.f;
#pragma unroll
        for (int j = 0; j < 6; ++j) {
            int c = g * 384 + j * 64 + lane;
            float y = ybuf[(size_t)t * MIX_WIDTH + c], z = proj[(size_t)t * PROJ_LD + O_Z + c];
            v[j] = y * silu_f(z); ss += v[j] * v[j];
        }
        ss = wave_sum(ss);
        const float r = rsqrtf(ss * (1.0f / 384.0f) + LN_EPS);
#pragma unroll
        for (int j = 0; j < 6; ++j) { int c = g * 384 + j * 64 + lane; A1[(size_t)t * MIX_WIDTH + c] = (bf16)f2bf(v[j] * r * norm_g[c]); }
        }
#pragma unroll
        for (int j = 0; j < 2; ++j) { int c = SSD_WIDTH + g * 128 + j * 64 + lane; A1[(size_t)t * MIX_WIDTH + c] = (bf16)f2bf(ybuf[(size_t)t * MIX_WIDTH + c]); }
    }
}

__device__ __forceinline__ void ph_attn_naive(float* lds, const float* __restrict__ proj, const float* __restrict__ qrot, const float* __restrict__ krot,
                                              const float* __restrict__ ck, const float* __restrict__ cv, float* __restrict__ ybuf) {
    float (*sq)[64] = (float (*)[64])lds;
    const int w = threadIdx.x >> 6, lane = threadIdx.x & 63;
    for (int vb = blockIdx.x; vb < T_ALL * 8 / NWAVE; vb += gridDim.x) {
        const int item = vb * NWAVE + w;
        const int t = item >> 3, h = item & 7;
        const bool is_p = t < T_PROMPT;
        int b, i;
        if (is_p) { b = t / SEQ; i = t % SEQ; } else { int ts = t - T_PROMPT; b = ts / DEC_SEQ; i = ts % DEC_SEQ; }
        __syncthreads();
        sq[w][lane] = qrot[(size_t)t * ATT_WIDTH + h * 64 + lane];
        __syncthreads();
        const int qi = is_p ? i : WBUF + i;
        float sc[3][3];
        float mx = -INFINITY;
#pragma unroll
        for (int pt = 0; pt < 3; ++pt) {
            const int d = pt == 0 ? 1 : (pt == 1 ? 4 : 16);
#pragma unroll
            for (int sl = 0; sl < 3; ++sl) {
                const int m = lane + sl * 64;
                float s = -INFINITY;
                const int kj = qi - d * m;
                if (m <= 128 && kj >= 0) {
                    const float* kr;
                    if (is_p) kr = krot + (size_t)(b * SEQ + kj) * ATT_WIDTH + h * 64;
                    else kr = (kj >= WBUF) ? krot + (size_t)(T_PROMPT + b * DEC_SEQ + (kj - WBUF)) * ATT_WIDTH + h * 64
                                           : ck + ((size_t)b * WBUF + kj) * ATT_WIDTH + h * 64;
                    float a = 0.f;
#pragma unroll
                    for (int c = 0; c < 64; c += 4) { float4 kv = *(const float4*)(kr + c); a += kv.x * sq[w][c] + kv.y * sq[w][c + 1] + kv.z * sq[w][c + 2] + kv.w * sq[w][c + 3]; }
                    s = a * 0.125f;
                }
                sc[pt][sl] = s; mx = fmaxf(mx, s);
            }
        }
        mx = wave_max(mx);
        float lsum = 0.f;
#pragma unroll
        for (int pt = 0; pt < 3; ++pt)
#pragma unroll
            for (int sl = 0; sl < 3; ++sl) { float pv = (sc[pt][sl] == -INFINITY) ? 0.f : __expf(sc[pt][sl] - mx); sc[pt][sl] = pv; lsum += pv; }
        lsum = wave_sum(lsum);
        float o = 0.f;
#pragma unroll
        for (int pt = 0; pt < 3; ++pt) {
            const int d = pt == 0 ? 1 : (pt == 1 ? 4 : 16);
#pragma unroll
            for (int sl = 0; sl < 3; ++sl) {
                const int mend = sl < 2 ? 64 : 1;
                for (int ml = 0; ml < mend; ++ml) {
                    const int m = ml + sl * 64;
                    const int kj = qi - d * m;
                    const float pv = __shfl(sc[pt][sl], ml);
                    if (kj < 0) continue;
                    const float* vr;
                    if (is_p) vr = proj + (size_t)(b * SEQ + kj) * PROJ_LD + O_V + h * 64;
                    else vr = (kj >= WBUF) ? proj + (size_t)(T_PROMPT + b * DEC_SEQ + (kj - WBUF)) * PROJ_LD + O_V + h * 64
                                           : cv + ((size_t)b * WBUF + kj) * ATT_WIDTH + h * 64;
                    o += pv * vr[lane];
                }
            }
        }
        ybuf[(size_t)t * MIX_WIDTH + SSD_WIDTH + h * 64 + lane] = o / lsum;
    }
}

__device__ __forceinline__ void ph_ln_res(const float* __restrict__ res, const float* __restrict__ add, const float* __restrict__ gam,
                                          const float* __restrict__ bet, float* __restrict__ dst, bf16* __restrict__ dstb) {
    const int lane = threadIdx.x & 63;
    for (int t = blockIdx.x * NWAVE + (threadIdx.x >> 6); t < T_ALL; t += gridDim.x * NWAVE) {
        float v[16]; float s = 0.f;
#pragma unroll
        for (int j = 0; j < 16; ++j) { int c = j * 64 + lane; v[j] = ALPHA_F * res[(size_t)t * D_MODEL + c] + add[(size_t)t * D_MODEL + c]; s += v[j]; }
        s = wave_sum(s);
        const float mu = s * (1.0f / 1024.0f);
        float q = 0.f;
#pragma unroll
        for (int j = 0; j < 16; ++j) { v[j] -= mu; q += v[j] * v[j]; }
        q = wave_sum(q);
        const float r = rsqrtf(q * (1.0f / 1024.0f) + LN_EPS);
#pragma unroll
        for (int j = 0; j < 16; ++j) { int c = j * 64 + lane; float o = v[j] * r * gam[c] + bet[c]; dst[(size_t)t * D_MODEL + c] = o; dstb[(size_t)t * D_MODEL + c] = (bf16)f2bf(o); }
    }
}

__device__ __forceinline__ void ph_peer_route(float* lds, const float* __restrict__ qh, const float* __restrict__ keys1, const float* __restrict__ keys2,
                                              int* __restrict__ eidx, float* __restrict__ gate) {
    float (*sq)[256] = (float (*)[256])lds;
    float (*sv)[2][16] = (float (*)[2][16])(lds + NWAVE * 256);
    int (*si)[2][16] = (int (*)[2][16])(lds + NWAVE * 256 + NWAVE * 32);
    const int w = threadIdx.x >> 6, lane = threadIdx.x & 63;
    for (int vb = blockIdx.x; vb < T_ALL * 8 / NWAVE; vb += gridDim.x) {
        const int item = vb * NWAVE + w;
        const int t = item >> 3, h = item & 7;
        __syncthreads();
        for (int c = lane; c < 256; c += 64) sq[w][c] = qh[(size_t)t * 2048 + h * 256 + c];
        __syncthreads();
#pragma unroll
        for (int half = 0; half < 2; ++half) {
            const float* keys = half ? keys2 : keys1;
            float s[2];
#pragma unroll
            for (int sl = 0; sl < 2; ++sl) {
                const float* kr = keys + (size_t)(lane + sl * 64) * 128;
                float a = 0.f;
#pragma unroll 8
                for (int c = 0; c < 128; c += 4) { float4 kv = *(const float4*)(kr + c); const float* qq = &sq[w][half * 128 + c]; a += kv.x * qq[0] + kv.y * qq[1] + kv.z * qq[2] + kv.w * qq[3]; }
                s[sl] = a;
            }
            for (int r = 0; r < 16; ++r) {
                float bv; int bi;
                if (s[0] >= s[1]) { bv = s[0]; bi = lane; } else { bv = s[1]; bi = lane + 64; }
#pragma unroll
                for (int o = 32; o > 0; o >>= 1) {
                    float ov = __shfl_xor(bv, o); int oi = __shfl_xor(bi, o);
                    if (ov > bv || (ov == bv && oi < bi)) { bv = ov; bi = oi; }
                }
                if (lane == 0) { sv[w][half][r] = bv; si[w][half][r] = bi; }
                if (bi == lane) s[0] = -INFINITY;
                if (bi == lane + 64) s[1] = -INFINITY;
            }
        }
        __syncthreads();
        float c[4];
#pragma unroll
        for (int j = 0; j < 4; ++j) { int ci = lane * 4 + j; c[j] = sv[w][0][ci >> 4] + sv[w][1][ci & 15]; }
        float myv = 0.f; int myc = 0;
        for (int r = 0; r < 16; ++r) {
            float bv = c[0]; int bi = lane * 4;
#pragma unroll
            for (int j = 1; j < 4; ++j) if (c[j] > bv) { bv = c[j]; bi = lane * 4 + j; }
#pragma unroll
            for (int o = 32; o > 0; o >>= 1) {
                float ov = __shfl_xor(bv, o); int oi = __shfl_xor(bi, o);
                if (ov > bv || (ov == bv && oi < bi)) { bv = ov; bi = oi; }
            }
            if (lane == r) { myv = bv; myc = bi; }
#pragma unroll
            for (int j = 0; j < 4; ++j) if (bi == lane * 4 + j) c[j] = -INFINITY;
        }
        float v = lane < 16 ? myv : -INFINITY;
        float mx = wave_max(v);
        float e = lane < 16 ? __expf(v - mx) : 0.f;
        float sum = wave_sum(e);
        if (lane < 16) {
            int ex = si[w][0][myc >> 4] * PEER_NKEYS + si[w][1][myc & 15];
            eidx[(size_t)t * 128 + h * 16 + lane] = ex;
            gate[(size_t)t * 128 + h * 16 + lane] = e / sum;
        }
    }
}

__device__ __forceinline__ void ph_peer_ffn(const float* __restrict__ hbuf, const int* __restrict__ eidx, const float* __restrict__ gate,
                                            const bf16* __restrict__ ub, const bf16* __restrict__ vb, const float* __restrict__ gam,
                                            const float* __restrict__ bet, float* __restrict__ out) {
    const int lane = threadIdx.x & 63;
    for (int t = blockIdx.x * NWAVE + (threadIdx.x >> 6); t < T_ALL; t += gridDim.x * NWAVE) {
        float x[16], acc[16];
        { const float* xr = hbuf + (size_t)t * D_MODEL + lane * 8;
          const float4 a = *(const float4*)xr, b = *(const float4*)(xr + 4), c = *(const float4*)(xr + 512), d = *(const float4*)(xr + 516);
          x[0] = a.x; x[1] = a.y; x[2] = a.z; x[3] = a.w; x[4] = b.x; x[5] = b.y; x[6] = b.z; x[7] = b.w;
          x[8] = c.x; x[9] = c.y; x[10] = c.z; x[11] = c.w; x[12] = d.x; x[13] = d.y; x[14] = d.z; x[15] = d.w; }
#pragma unroll
        for (int j = 0; j < 16; ++j) acc[j] = 0.f;
        for (int k = 0; k < 128; ++k) {
            const int e = eidx[(size_t)t * 128 + k];
            const float g = gate[(size_t)t * 128 + k];
            const bf16* ur = ub + (size_t)e * D_MODEL + lane * 8;
            float u0[8], u1[8];
            unpack8(*(const v4u*)ur, u0); unpack8(*(const v4u*)(ur + 512), u1);
            float d = 0.f;
#pragma unroll
            for (int j = 0; j < 8; ++j) d += u0[j] * x[j] + u1[j] * x[8 + j];
            d = wave_sum(d);
            const float wgt = g * gelu_f(d);
            const bf16* vr = vb + (size_t)e * D_MODEL + lane * 8;
            unpack8(*(const v4u*)vr, u0); unpack8(*(const v4u*)(vr + 512), u1);
#pragma unroll
            for (int j = 0; j < 8; ++j) { acc[j] += wgt * u0[j]; acc[8 + j] += wgt * u1[j]; }
        }
        float s = 0.f;
#pragma unroll
        for (int j = 0; j < 16; ++j) { acc[j] += ALPHA_F * x[j]; s += acc[j]; }
        s = wave_sum(s);
        const float mu = s * (1.0f / 1024.0f);
        float q = 0.f;
#pragma unroll
        for (int j = 0; j < 16; ++j) { acc[j] -= mu; q += acc[j] * acc[j]; }
        q = wave_sum(q);
        const float r = rsqrtf(q * (1.0f / 1024.0f) + LN_EPS);
        float* dst = ((t < T_PROMPT) ? out + OUT_YP + (size_t)t * D_MODEL : out + OUT_YS + (size_t)(t - T_PROMPT) * D_MODEL) + lane * 8;
#pragma unroll
        for (int q4 = 0; q4 < 4; ++q4) {
            const int eo = (q4 >> 1) * 512 + (q4 & 1) * 4;
            const float4 g4 = *(const float4*)(gam + lane * 8 + eo), b4 = *(const float4*)(bet + lane * 8 + eo);
            float4 o; o.x = acc[q4 * 4 + 0] * r * g4.x + b4.x; o.y = acc[q4 * 4 + 1] * r * g4.y + b4.y; o.z = acc[q4 * 4 + 2] * r * g4.z + b4.z; o.w = acc[q4 * 4 + 3] * r * g4.w + b4.w;
            *(float4*)(dst + eo) = o;
        }
    }
}

__device__ __forceinline__ float peer_dot16(const v4u a, const v4u b, const float (&x)[16]) {
    float u0[8], u1[8]; unpack8(a, u0); unpack8(b, u1);
    float d = 0.f;
#pragma unroll
    for (int j = 0; j < 8; ++j) d += u0[j] * x[j] + u1[j] * x[8 + j];
    return d;
}
#define PEER_TR_STEP(N, M) _Pragma("unroll") for (int i = 0; i < N; ++i) { const bool up = (lane & M) != 0; const float keep = up ? part[i + N] : part[i]; const float send = up ? part[i] : part[i + N]; part[i] = keep + __shfl_xor(send, M); }
__device__ __forceinline__ void ph_peer_ffn2(const float* __restrict__ hbuf, const int* __restrict__ eidx, const float* __restrict__ gate,
                                             const bf16* __restrict__ ub, const bf16* __restrict__ vb, const float* __restrict__ gam,
                                             const float* __restrict__ bet, float* __restrict__ out) {
    const int lane0 = threadIdx.x & 63;
    for (int t = blockIdx.x * NWAVE + (threadIdx.x >> 6); t < T_ALL; t += gridDim.x * NWAVE) {
        int lane = lane0; asm volatile("" : "+v"(lane));
        float x[16];
        { const float* xr = hbuf + (size_t)t * D_MODEL + lane * 8;
          const float4 a = *(const float4*)xr, b = *(const float4*)(xr + 4), c = *(const float4*)(xr + 512), d = *(const float4*)(xr + 516);
          x[0] = a.x; x[1] = a.y; x[2] = a.z; x[3] = a.w; x[4] = b.x; x[5] = b.y; x[6] = b.z; x[7] = b.w;
          x[8] = c.x; x[9] = c.y; x[10] = c.z; x[11] = c.w; x[12] = d.x; x[13] = d.y; x[14] = d.z; x[15] = d.w; }
        int ev[2]; float wv[4];
        ev[0] = eidx[(size_t)t * 128 + lane]; ev[1] = eidx[(size_t)t * 128 + 64 + lane];
#pragma unroll
        for (int rd = 0; rd < 4; ++rd) wv[rd] = gate[(size_t)t * 128 + rd * 32 + (lane >> 1)];
#pragma unroll
        for (int rd = 0; rd < 4; ++rd) {
            float part[32];
#pragma unroll
            for (int kb = 0; kb < 8; ++kb) {
                v4u ra[4], rb[4];
#pragma unroll
                for (int k8 = 0; k8 < 4; ++k8) {
                    const int e = __builtin_amdgcn_readlane(ev[rd >> 1], (rd & 1) * 32 + kb * 4 + k8);
                    const bf16* ur = ub + (size_t)e * D_MODEL + lane * 8;
                    ra[k8] = *(const v4u*)ur; rb[k8] = *(const v4u*)(ur + 512);
                }
#pragma unroll
                for (int k8 = 0; k8 < 4; ++k8) part[kb * 4 + k8] = peer_dot16(ra[k8], rb[k8], x);
            }
            PEER_TR_STEP(16, 32) PEER_TR_STEP(8, 16) PEER_TR_STEP(4, 8) PEER_TR_STEP(2, 4) PEER_TR_STEP(1, 2)
            const float hid = part[0] + __shfl_xor(part[0], 1);
            wv[rd] *= gelu_f(hid);
        }
        float acc[16];
#pragma unroll
        for (int j = 0; j < 16; ++j) acc[j] = 0.f;
#pragma unroll
        for (int rd = 0; rd < 4; ++rd) {
#pragma unroll
            for (int kb = 0; kb < 4; ++kb) {
                v4u ra[8], rb[8];
#pragma unroll
                for (int k8 = 0; k8 < 8; ++k8) {
                    const int e = __builtin_amdgcn_readlane(ev[rd >> 1], (rd & 1) * 32 + kb * 8 + k8);
                    const bf16* vr = vb + (size_t)e * D_MODEL + lane * 8;
                    ra[k8] = *(const v4u*)vr; rb[k8] = *(const v4u*)(vr + 512);
                }
#pragma unroll
                for (int k8 = 0; k8 < 8; ++k8) {
                    const float wk = __builtin_bit_cast(float, __builtin_amdgcn_readlane(__builtin_bit_cast(int, wv[rd]), 2 * (kb * 8 + k8)));
                    float u0[8], u1[8]; unpack8(ra[k8], u0); unpack8(rb[k8], u1);
#pragma unroll
                    for (int j = 0; j < 8; ++j) { acc[j] += wk * u0[j]; acc[8 + j] += wk * u1[j]; }
                }
            }
        }
        float s = 0.f;
#pragma unroll
        for (int j = 0; j < 16; ++j) { acc[j] += ALPHA_F * x[j]; s += acc[j]; }
        s = wave_sum(s);
        const float mu = s * (1.0f / 1024.0f);
        float q = 0.f;
#pragma unroll
        for (int j = 0; j < 16; ++j) { acc[j] -= mu; q += acc[j] * acc[j]; }
        q = wave_sum(q);
        const float r = rsqrtf(q * (1.0f / 1024.0f) + LN_EPS);
        float* dst = ((t < T_PROMPT) ? out + OUT_YP + (size_t)t * D_MODEL : out + OUT_YS + (size_t)(t - T_PROMPT) * D_MODEL) + lane * 8;
#pragma unroll
        for (int q4 = 0; q4 < 4; ++q4) {
            const int eo = (q4 >> 1) * 512 + (q4 & 1) * 4;
            const float4 g4 = *(const float4*)(gam + lane * 8 + eo), b4 = *(const float4*)(bet + lane * 8 + eo);
            float4 o; o.x = acc[q4 * 4 + 0] * r * g4.x + b4.x; o.y = acc[q4 * 4 + 1] * r * g4.y + b4.y; o.z = acc[q4 * 4 + 2] * r * g4.z + b4.z; o.w = acc[q4 * 4 + 3] * r * g4.w + b4.w;
            *(float4*)(dst + eo) = o;
        }
    }
}

typedef float f32x16 __attribute__((ext_vector_type(16)));
typedef short s16x8 __attribute__((ext_vector_type(8)));
typedef short s16x4 __attribute__((ext_vector_type(4)));
typedef float f32x4v __attribute__((ext_vector_type(4)));
#define SSD_L_ACS 0
#define SSD_L_DTS 3072
#define SSD_L_BM 6144
#define SSD_RS_B 272
#define SSD_L_X (6144 + 128 * 272)
#define SSD_RS_X 144
#define SSD_XIMG (128 * 144)
#define SSD_RS_Y 784
template <int OFF0, int OFF1>
__device__ __forceinline__ s16x8 tr_frag(unsigned base) {
    s16x4 a, b;
    asm volatile("ds_read_b64_tr_b16 %0, %2 offset:%3\n\tds_read_b64_tr_b16 %1, %2 offset:%4\n\ts_waitcnt lgkmcnt(0)"
                 : "=&v"(a), "=&v"(b) : "v"(base), "n"(OFF0), "n"(OFF1) : "memory");
    return __builtin_shufflevector(a, b, 0, 1, 2, 3, 4, 5, 6, 7);
}
__device__ __forceinline__ unsigned lds_addr(LAS unsigned char* p) { return (unsigned)(size_t)p; }

__device__ __forceinline__ void ssd_chunk_acs(LAS unsigned char* ldsb, const float* __restrict__ dtv, const float* __restrict__ a_log, int t0, int g, float* cdec_out) {
    const int w = __builtin_amdgcn_readfirstlane(threadIdx.x >> 6), lane = threadIdx.x & 63;
    if (w < 6) {
        const int head = 6 * g + w;
        const float A = -__expf(a_log[head]);
        const float v0 = dtv[(size_t)(t0 + 2 * lane) * SSD_HEADS + head], v1 = dtv[(size_t)(t0 + 2 * lane + 1) * SSD_HEADS + head];
        const float a1 = v1 * A;
        float s = v0 * A + a1;
#pragma unroll
        for (int o = 1; o < 64; o <<= 1) { const float tmp = __shfl_up(s, o); if (lane >= o) s += tmp; }
        LAS float* acs = (LAS float*)(ldsb + SSD_L_ACS) + w * 128;
        LAS float* dts = (LAS float*)(ldsb + SSD_L_DTS) + w * 128;
        acs[2 * lane] = s - a1; acs[2 * lane + 1] = s;
        dts[2 * lane] = v0; dts[2 * lane + 1] = v1;
        if (cdec_out && lane == 63) cdec_out[head] = __expf(s);
    }
}

__device__ __forceinline__ void ph_ssd_states(LAS unsigned char* ldsb, const bf16* __restrict__ xbc_b, const float* __restrict__ dtv, const float* __restrict__ a_log,
                                              bf16* __restrict__ Sbuf, float* __restrict__ cdec) {
    const int tid = threadIdx.x, w = __builtin_amdgcn_readfirstlane(tid >> 6), lane = tid & 63;
    const int r = lane & 31, h = lane >> 5, blk = (lane >> 4) & 1, q = (lane & 15) >> 2, pp = lane & 3;
    const int nt = w & 3, pt = w >> 2;
    for (int unit = blockIdx.x; unit < BATCH * 64 * SSD_GROUPS; unit += gridDim.x) {
        const int g = unit & 3, bc = unit >> 2;
        const int t0 = bc * 128;
        __syncthreads();
        ssd_chunk_acs(ldsb, dtv, a_log, t0, g, cdec + (size_t)bc * SSD_HEADS);
        for (int idx = tid; idx < 2048; idx += NTHR) { const int row = idx >> 4, ch = idx & 15;
            const v4u v = *(const v4u*)(xbc_b + (size_t)(t0 + row) * CONV_DIM + 1536 + 128 * g + ch * 8);
            *(LAS v4u*)(ldsb + SSD_L_BM + row * SSD_RS_B + ch * 16) = v; }
        __syncthreads();
        for (int idx = tid; idx < 6144; idx += NTHR) { const int hh = idx >> 10, rem = idx & 1023, row = rem >> 3, ch = rem & 7;
            const LAS float* acs = (const LAS float*)(ldsb + SSD_L_ACS) + hh * 128; const LAS float* dts = (const LAS float*)(ldsb + SSD_L_DTS) + hh * 128;
            const float wgt = dts[row] * __expf(acs[127] - acs[row]);
            float f[8]; unpack8(*(const v4u*)(xbc_b + (size_t)(t0 + row) * CONV_DIM + (6 * g + hh) * 64 + ch * 8), f);
            v4u o; o.x = pk2(f[0] * wgt, f[1] * wgt); o.y = pk2(f[2] * wgt, f[3] * wgt); o.z = pk2(f[4] * wgt, f[5] * wgt); o.w = pk2(f[6] * wgt, f[7] * wgt);
            *(LAS v4u*)(ldsb + SSD_L_X + hh * SSD_XIMG + row * SSD_RS_X + ch * 16) = o; }
        __syncthreads();
        const unsigned abase = lds_addr(ldsb + SSD_L_BM) + (8 * h + q) * SSD_RS_B + (32 * nt + 16 * blk + 4 * pp) * 2;
        s16x8 afr[8];
        afr[0] = tr_frag<0 * 16 * SSD_RS_B, (0 * 16 + 4) * SSD_RS_B>(abase); afr[1] = tr_frag<1 * 16 * SSD_RS_B, (1 * 16 + 4) * SSD_RS_B>(abase);
        afr[2] = tr_frag<2 * 16 * SSD_RS_B, (2 * 16 + 4) * SSD_RS_B>(abase); afr[3] = tr_frag<3 * 16 * SSD_RS_B, (3 * 16 + 4) * SSD_RS_B>(abase);
        afr[4] = tr_frag<4 * 16 * SSD_RS_B, (4 * 16 + 4) * SSD_RS_B>(abase); afr[5] = tr_frag<5 * 16 * SSD_RS_B, (5 * 16 + 4) * SSD_RS_B>(abase);
        afr[6] = tr_frag<6 * 16 * SSD_RS_B, (6 * 16 + 4) * SSD_RS_B>(abase); afr[7] = tr_frag<7 * 16 * SSD_RS_B, (7 * 16 + 4) * SSD_RS_B>(abase);
#pragma unroll
        for (int hh = 0; hh < 6; ++hh) {
            const unsigned xb = lds_addr(ldsb + SSD_L_X + hh * SSD_XIMG) + (8 * h + q) * SSD_RS_X + (32 * pt + 16 * blk + 4 * pp) * 2;
            f32x16 acc;
#pragma unroll
            for (int i = 0; i < 16; ++i) acc[i] = 0.f;
            acc = __builtin_amdgcn_mfma_f32_32x32x16_bf16(afr[0], tr_frag<0 * 16 * SSD_RS_X, (0 * 16 + 4) * SSD_RS_X>(xb), acc, 0, 0, 0);
            acc = __builtin_amdgcn_mfma_f32_32x32x16_bf16(afr[1], tr_frag<1 * 16 * SSD_RS_X, (1 * 16 + 4) * SSD_RS_X>(xb), acc, 0, 0, 0);
            acc = __builtin_amdgcn_mfma_f32_32x32x16_bf16(afr[2], tr_frag<2 * 16 * SSD_RS_X, (2 * 16 + 4) * SSD_RS_X>(xb), acc, 0, 0, 0);
            acc = __builtin_amdgcn_mfma_f32_32x32x16_bf16(afr[3], tr_frag<3 * 16 * SSD_RS_X, (3 * 16 + 4) * SSD_RS_X>(xb), acc, 0, 0, 0);
            acc = __builtin_amdgcn_mfma_f32_32x32x16_bf16(afr[4], tr_frag<4 * 16 * SSD_RS_X, (4 * 16 + 4) * SSD_RS_X>(xb), acc, 0, 0, 0);
            acc = __builtin_amdgcn_mfma_f32_32x32x16_bf16(afr[5], tr_frag<5 * 16 * SSD_RS_X, (5 * 16 + 4) * SSD_RS_X>(xb), acc, 0, 0, 0);
            acc = __builtin_amdgcn_mfma_f32_32x32x16_bf16(afr[6], tr_frag<6 * 16 * SSD_RS_X, (6 * 16 + 4) * SSD_RS_X>(xb), acc, 0, 0, 0);
            acc = __builtin_amdgcn_mfma_f32_32x32x16_bf16(afr[7], tr_frag<7 * 16 * SSD_RS_X, (7 * 16 + 4) * SSD_RS_X>(xb), acc, 0, 0, 0);
            bf16* dst = Sbuf + (((size_t)bc * SSD_HEADS + 6 * g + hh) * 64 + 32 * pt + r) * 128 + 32 * nt + 4 * h;
#pragma unroll
            for (int q4 = 0; q4 < 4; ++q4) *(uint2*)(dst + 8 * q4) = make_uint2(pk2(acc[4 * q4], acc[4 * q4 + 1]), pk2(acc[4 * q4 + 2], acc[4 * q4 + 3]));
        }
    }
}

__device__ __forceinline__ void ph_ssd_scan(const bf16* __restrict__ Sbuf, const float* __restrict__ cdec, bf16* __restrict__ Hin, float* __restrict__ out) {
    for (int idx = blockIdx.x * NTHR + threadIdx.x; idx < BATCH * SSD_HEADS * 64 * 16; idx += gridDim.x * NTHR) {
        const int n8 = idx & 15, p = (idx >> 4) & 63, hb = idx >> 10, hd = hb % SSD_HEADS, b = hb / SSD_HEADS;
        float st[8];
#pragma unroll
        for (int j = 0; j < 8; ++j) st[j] = 0.f;
#pragma unroll 8
        for (int c = 0; c < 64; ++c) {
            const size_t base = ((((size_t)(b * 64 + c)) * SSD_HEADS + hd) * 64 + p) * 128 + n8 * 8;
            v4u o; o.x = pk2(st[0], st[1]); o.y = pk2(st[2], st[3]); o.z = pk2(st[4], st[5]); o.w = pk2(st[6], st[7]);
            *(v4u*)(Hin + base) = o;
            float s[8]; unpack8(*(const v4u*)(Sbuf + base), s);
            const float a = cdec[(size_t)(b * 64 + c) * SSD_HEADS + hd];
#pragma unroll
            for (int j = 0; j < 8; ++j) st[j] = a * st[j] + s[j];
        }
        store8f(out + OUT_PS + (((size_t)b * SSD_HEADS + hd) * 64 + p) * 128 + n8 * 8, st);
    }
}

__device__ __forceinline__ void ph_ssd_out(LAS unsigned char* ldsb, const bf16* __restrict__ xbc_b, const bf16* __restrict__ projb, const float* __restrict__ dtv,
                                           const float* __restrict__ a_log, const float* __restrict__ d_skip, const float* __restrict__ norm_g,
                                           const bf16* __restrict__ Hin, bf16* __restrict__ A1) {
    const int tid = threadIdx.x, w = __builtin_amdgcn_readfirstlane(tid >> 6), lane = tid & 63;
    const int r = lane & 31, h = lane >> 5, blk = (lane >> 4) & 1, q = (lane & 15) >> 2, pp = lane & 3;
    const int lt = w & 3, hs = w >> 2;
    for (int unit = blockIdx.x; unit < BATCH * 64 * SSD_GROUPS; unit += gridDim.x) {
        const int g = unit & 3, bc = unit >> 2;
        const int t0 = bc * 128;
        __syncthreads();
        ssd_chunk_acs(ldsb, dtv, a_log, t0, g, nullptr);
        for (int idx = tid; idx < 2048; idx += NTHR) { const int row = idx >> 4, ch = idx & 15;
            const v4u v = *(const v4u*)(xbc_b + (size_t)(t0 + row) * CONV_DIM + 1536 + 128 * g + ch * 8);
            *(LAS v4u*)(ldsb + SSD_L_BM + row * SSD_RS_B + ch * 16) = v; }
        for (int idx = tid; idx < 6144; idx += NTHR) { const int hh = idx >> 10, rem = idx & 1023, row = rem >> 3, ch = rem & 7;
            const v4u v = *(const v4u*)(xbc_b + (size_t)(t0 + row) * CONV_DIM + (6 * g + hh) * 64 + ch * 8);
            *(LAS v4u*)(ldsb + SSD_L_X + hh * SSD_XIMG + row * SSD_RS_X + ch * 16) = v; }
        __syncthreads();
        const bf16* cp = xbc_b + (size_t)(t0 + 32 * lt + r) * CONV_DIM + 2048 + 128 * g + 8 * h;
        const int lcol = 32 * lt + r;
        const LAS float* acsb = (const LAS float*)(ldsb + SSD_L_ACS) + 3 * hs * 128; const LAS float* dtsb = (const LAS float*)(ldsb + SSD_L_DTS) + 3 * hs * 128;
        f32x16 y[3][2];
#pragma unroll
        for (int h3 = 0; h3 < 3; ++h3)
#pragma unroll
            for (int i = 0; i < 16; ++i) { y[h3][0][i] = 0.f; y[h3][1][i] = 0.f; }
#pragma unroll 1
        for (int ks = 0; ks < 8; ++ks) {
            const s16x8 cf = *(const s16x8*)(cp + 16 * ks);
#pragma unroll
            for (int h3 = 0; h3 < 3; ++h3) {
                const bf16* hp = Hin + (((size_t)bc * SSD_HEADS + 6 * g + 3 * hs + h3) * 64 + r) * 128 + 8 * h + 16 * ks;
                const s16x8 h0 = *(const s16x8*)hp, h1 = *(const s16x8*)(hp + 32 * 128);
                y[h3][0] = __builtin_amdgcn_mfma_f32_32x32x16_bf16(cf, h0, y[h3][0], 0, 0, 0);
                y[h3][1] = __builtin_amdgcn_mfma_f32_32x32x16_bf16(cf, h1, y[h3][1], 0, 0, 0);
            }
        }
#pragma unroll
        for (int h3 = 0; h3 < 3; ++h3)
#pragma unroll
            for (int q4 = 0; q4 < 4; ++q4) {
                const f32x4v a4 = *(const LAS f32x4v*)(acsb + h3 * 128 + 32 * lt + 8 * q4 + 4 * h);
                const float e0 = __expf(a4[0]), e1 = __expf(a4[1]), e2 = __expf(a4[2]), e3 = __expf(a4[3]);
                y[h3][0][4 * q4] *= e0; y[h3][0][4 * q4 + 1] *= e1; y[h3][0][4 * q4 + 2] *= e2; y[h3][0][4 * q4 + 3] *= e3;
                y[h3][1][4 * q4] *= e0; y[h3][1][4 * q4 + 1] *= e1; y[h3][1][4 * q4 + 2] *= e2; y[h3][1][4 * q4 + 3] *= e3;
            }
        const unsigned xb0 = lds_addr(ldsb + SSD_L_X + 3 * hs * SSD_XIMG) + (4 * h + q) * SSD_RS_X + (16 * blk + 4 * pp) * 2;
        for (int st = 0; st <= lt; ++st) {
            f32x16 cb;
#pragma unroll
            for (int i = 0; i < 16; ++i) cb[i] = 0.f;
#pragma unroll 2
            for (int ks = 0; ks < 8; ++ks) {
                const s16x8 cf = *(const s16x8*)(cp + 16 * ks);
                const s16x8 bfrag = *(const LAS s16x8*)(ldsb + SSD_L_BM + (32 * st + r) * SSD_RS_B + (16 * ks + 8 * h) * 2);
                cb = __builtin_amdgcn_mfma_f32_32x32x16_bf16(bfrag, cf, cb, 0, 0, 0);
            }
#pragma unroll
            for (int h3 = 0; h3 < 3; ++h3) {
                const LAS float* acs = acsb + h3 * 128; const LAS float* dts = dtsb + h3 * 128;
                const float myacs = acs[lcol];
                const float Dh = d_skip[6 * g + 3 * hs + h3];
                const unsigned xb = xb0 + h3 * SSD_XIMG + st * 32 * SSD_RS_X;
#pragma unroll
                for (int kk = 0; kk < 2; ++kk) {
                    const int s0 = 32 * st + 16 * kk + 4 * h;
                    const f32x4v as0 = *(const LAS f32x4v*)(acs + s0), as1 = *(const LAS f32x4v*)(acs + s0 + 8);
                    const f32x4v ds0 = *(const LAS f32x4v*)(dts + s0), ds1 = *(const LAS f32x4v*)(dts + s0 + 8);
                    float wv[8];
#pragma unroll
                    for (int j = 0; j < 8; ++j) {
                        const int s = s0 + 8 * (j >> 2) + (j & 3);
                        const float asj = (j < 4) ? as0[j & 3] : as1[j & 3], dsj = (j < 4) ? ds0[j & 3] : ds1[j & 3];
                        float v = cb[8 * kk + j] * __expf(myacs - asj) * dsj;
                        v = (s <= lcol) ? v : 0.f;
                        v = (s == lcol) ? v + Dh : v;
                        wv[j] = v;
                    }
                    s16x8 afr;
                    { v4u o; o.x = pk2(wv[0], wv[1]); o.y = pk2(wv[2], wv[3]); o.z = pk2(wv[4], wv[5]); o.w = pk2(wv[6], wv[7]); afr = __builtin_bit_cast(s16x8, o); }
                    s16x8 b0, b1;
                    if (kk == 0) { b0 = tr_frag<0, 8 * SSD_RS_X>(xb); b1 = tr_frag<64, 8 * SSD_RS_X + 64>(xb); }
                    else { b0 = tr_frag<16 * SSD_RS_X, 24 * SSD_RS_X>(xb); b1 = tr_frag<16 * SSD_RS_X + 64, 24 * SSD_RS_X + 64>(xb); }
                    y[h3][0] = __builtin_amdgcn_mfma_f32_32x32x16_bf16(afr, b0, y[h3][0], 0, 0, 0);
                    y[h3][1] = __builtin_amdgcn_mfma_f32_32x32x16_bf16(afr, b1, y[h3][1], 0, 0, 0);
                    __builtin_amdgcn_sched_barrier(0);
                }
            }
        }
        __syncthreads();
        {
            LAS unsigned short* yst = (LAS unsigned short*)(ldsb + SSD_L_X);
#pragma unroll
            for (int h3 = 0; h3 < 3; ++h3)
#pragma unroll
                for (int ptile = 0; ptile < 2; ++ptile)
#pragma unroll
                    for (int reg = 0; reg < 16; ++reg) {
                        const int l0 = 32 * lt + (reg & 3) + 8 * (reg >> 2) + 4 * h;
                        const int col = (3 * hs + h3) * 64 + 32 * ptile + r;
                        yst[l0 * (SSD_RS_Y / 2) + col] = (unsigned short)f2bf(y[h3][ptile][reg]);
                    }
        }
        __syncthreads();
#pragma unroll
        for (int pass = 0; pass < 4; ++pass) {
            const int l = 4 * (pass * 8 + w) + (lane >> 4), i16 = lane & 15;
            float gv[3][8]; float ss = 0.f;
#pragma unroll
            for (int k = 0; k < 3; ++k) {
                const int col0 = 24 * i16 + 8 * k;
                float yv[8], zv[8];
                unpack8(*(const LAS v4u*)(ldsb + SSD_L_X + l * SSD_RS_Y + col0 * 2), yv);
                unpack8(*(const v4u*)(projb + (size_t)(t0 + l) * NB_LD + g * 384 + col0), zv);
#pragma unroll
                for (int j = 0; j < 8; ++j) { const float gg = yv[j] * silu_f(zv[j]); gv[k][j] = gg; ss += gg * gg; }
            }
            ss += __shfl_xor(ss, 1); ss += __shfl_xor(ss, 2); ss += __shfl_xor(ss, 4); ss += __shfl_xor(ss, 8);
            const float rstd = rsqrtf(ss * (1.0f / 384.0f) + LN_EPS);
#pragma unroll
            for (int k = 0; k < 3; ++k) {
                const int col0 = g * 384 + 24 * i16 + 8 * k;
                const float4 g0 = *(const float4*)(norm_g + col0), g1 = *(const float4*)(norm_g + col0 + 4);
                v4u o; o.x = pk2(gv[k][0] * rstd * g0.x, gv[k][1] * rstd * g0.y); o.y = pk2(gv[k][2] * rstd * g0.z, gv[k][3] * rstd * g0.w);
                o.z = pk2(gv[k][4] * rstd * g1.x, gv[k][5] * rstd * g1.y); o.w = pk2(gv[k][6] * rstd * g1.z, gv[k][7] * rstd * g1.w);
                *(v4u*)(A1 + (size_t)(t0 + l) * MIX_WIDTH + col0) = o;
            }
        }
    }
}

struct Params {
    const float* in[23];
    float* out;
    unsigned char* ws;
    unsigned* bar;
};

#define WS_BAR      0ull
#define WS_XALL     (1ull << 20)
#define WS_PROJ     (WS_XALL + (size_t)T_ALL * D_MODEL * 4)
#define WS_XBC      (WS_PROJ + (size_t)T_ALL * PROJ_LD * 4)
#define WS_DT       (WS_XBC + (size_t)T_ALL * CONV_DIM * 4)
#define WS_QROT     (WS_DT + (size_t)T_ALL * SSD_HEADS * 4)
#define WS_KROT     (WS_QROT + (size_t)T_ALL * ATT_WIDTH * 4)
#define WS_YBUF     (WS_KROT + (size_t)T_ALL * ATT_WIDTH * 4)
#define WS_MIX      (WS_YBUF + (size_t)T_ALL * MIX_WIDTH * 4)
#define WS_HBUF     (WS_MIX + (size_t)T_ALL * D_MODEL * 4)
#define WS_QH       (WS_HBUF + (size_t)T_ALL * D_MODEL * 4)
#define WS_EIDX     (WS_QH + (size_t)T_ALL * 2048 * 4)
#define WS_GATE     (WS_EIDX + (size_t)T_ALL * 128 * 4)
#define WS_A0       (WS_GATE + (size_t)T_ALL * 128 * 4)
#define WS_A1       (WS_A0 + (size_t)T_ALL * D_MODEL * 2)
#define WS_A2       (WS_A1 + (size_t)T_ALL * MIX_WIDTH * 2)
#define WS_WTIN     (WS_A2 + (size_t)T_ALL * D_MODEL * 2)
#define WS_WTOUT    (WS_WTIN + (size_t)PROJ_LD * D_MODEL * 2)
#define WS_WTQ      (WS_WTOUT + (size_t)D_MODEL * MIX_WIDTH * 2)
#define WS_PROJB    (WS_WTQ + (size_t)2048 * D_MODEL * 2)
#define WS_DTRAW    (WS_PROJB + (size_t)T_ALL * NB_LD * 2)
#define WS_XBCB     (WS_DTRAW + (size_t)T_ALL * 32 * 4)
#define WS_QROTB    (WS_XBCB + (size_t)T_ALL * CONV_DIM * 2)
#define WS_KROTB    (WS_QROTB + (size_t)T_ALL * ATT_WIDTH * 2)
#define WS_UB       (WS_KROTB + (size_t)T_ALL * ATT_WIDTH * 2)
#define WS_VB       (WS_UB + (size_t)16384 * D_MODEL * 2)
#define WS_SBUF     (WS_VB + (size_t)16384 * D_MODEL * 2)
#define WS_HIN      (WS_SBUF + (size_t)BATCH * 64 * SSD_HEADS * 64 * 128 * 2)
#define WS_CDEC     (WS_HIN + (size_t)BATCH * 64 * SSD_HEADS * 64 * 128 * 2)
#define WS_END      (WS_CDEC + (size_t)BATCH * 64 * SSD_HEADS * 4)

#define LDS_BYTES (160 * 1024)

__global__ void __launch_bounds__(512, 2) mega_fwd(Params p) {
    extern __shared__ __attribute__((aligned(16))) unsigned char smem[];
    if (threadIdx.x == 0) *(uint4*)smem = make_uint4(0u, 0u, 0u, 0u);
    __syncthreads();
    XcdBarrier bar = xcd_barrier_post(p.bar, (volatile LAS unsigned*)smem);
    float* lds = (float*)(smem + 256);

    const float* x_prompt = p.in[0]; const float* x_sample = p.in[1]; const float* cache_k = p.in[2]; const float* cache_v = p.in[3];
    const float* state_conv = p.in[4]; const float* state_ssm = p.in[5]; const float* w_in = p.in[6]; const float* conv_w = p.in[7];
    const float* conv_b = p.in[8]; const float* dt_bias = p.in[9]; const float* a_log = p.in[10]; const float* d_skip = p.in[11];
    const float* norm_g = p.in[12]; const float* w_out = p.in[13]; const float* ln1_g = p.in[14]; const float* ln1_b = p.in[15];
    const float* peer_wq = p.in[16]; const float* keys1 = p.in[17]; const float* keys2 = p.in[18]; const float* peer_u = p.in[19];
    const float* peer_v = p.in[20]; const float* ln2_g = p.in[21]; const float* ln2_b = p.in[22];
    float* out = p.out;
    float* xall = (float*)(p.ws + WS_XALL); float* proj = (float*)(p.ws + WS_PROJ); float* xbc_act = (float*)(p.ws + WS_XBC);
    float* dtv = (float*)(p.ws + WS_DT); float* qrot = (float*)(p.ws + WS_QROT); float* krot = (float*)(p.ws + WS_KROT);
    float* ybuf = (float*)(p.ws + WS_YBUF); float* mix = (float*)(p.ws + WS_MIX); float* hbuf = (float*)(p.ws + WS_HBUF);
    float* qh = (float*)(p.ws + WS_QH); int* eidx = (int*)(p.ws + WS_EIDX); float* gate = (float*)(p.ws + WS_GATE);
    bf16* A0 = (bf16*)(p.ws + WS_A0); bf16* A1 = (bf16*)(p.ws + WS_A1); bf16* A2 = (bf16*)(p.ws + WS_A2);
    bf16* wt_in = (bf16*)(p.ws + WS_WTIN); bf16* wt_out = (bf16*)(p.ws + WS_WTOUT); bf16* wt_q = (bf16*)(p.ws + WS_WTQ);
    bf16* projb = (bf16*)(p.ws + WS_PROJB); float* dtraw = (float*)(p.ws + WS_DTRAW); bf16* xbc_b = (bf16*)(p.ws + WS_XBCB);
    bf16* qrot_b = (bf16*)(p.ws + WS_QROTB); bf16* krot_b = (bf16*)(p.ws + WS_KROTB); bf16* ub = (bf16*)(p.ws + WS_UB); bf16* vb = (bf16*)(p.ws + WS_VB);
    bf16* Sbuf = (bf16*)(p.ws + WS_SBUF); bf16* Hin = (bf16*)(p.ws + WS_HIN); float* cdec = (float*)(p.ws + WS_CDEC);
    LAS unsigned char* ldsb = (LAS unsigned char*)smem + 256;

    ph_concat_x(x_prompt, x_sample, xall);
    ph_prologue(ldsb, x_prompt, x_sample, A0, w_in, wt_in, w_out, wt_out, peer_wq, wt_q, peer_u, peer_v, ub, vb);
    ph_cache_copy(cache_k, cache_v, out);
    xcd_barrier(bar);
    { pg8::Gemm g{A0, wt_in, T_ALL, PROJ_LD, D_MODEL}; pg8::StaticOrder S; S.init(g.M, g.N, (int)gridDim.x, (int)blockIdx.x);
      pg8::EpiProj E{projb, dtraw}; pg8::gemm_phase<pg8::EpiProj, pg8::StaticOrder, false>(ldsb, g, S, E, nullptr); }
    xcd_barrier(bar);
    ph_post_proj2(projb, dtraw, state_conv, conv_w, conv_b, dt_bias, proj, xbc_act, xbc_b, dtv, qrot, krot, qrot_b, krot_b, out);
    xcd_barrier(bar);
    ph_ssd_states(ldsb, xbc_b, dtv, a_log, Sbuf, cdec);
    __syncthreads();
    ph_ssd_naive(lds, xbc_act, dtv, a_log, d_skip, state_ssm, ybuf, out);
    ph_attn_naive(lds, proj, qrot, krot, cache_k, cache_v, ybuf);
    xcd_barrier(bar);
    ph_ssd_scan(Sbuf, cdec, Hin, out);
    xcd_barrier(bar);
    ph_ssd_out(ldsb, xbc_b, projb, dtv, a_log, d_skip, norm_g, Hin, A1);
    ph_gate_norm(proj, norm_g, ybuf, A1);
    xcd_barrier(bar);
    { pg8::Gemm g{A1, wt_out, T_ALL, D_MODEL, MIX_WIDTH}; pg8::StaticOrder S; S.init(g.M, g.N, (int)gridDim.x, (int)blockIdx.x);
      pg8::EpiF32 E{mix, D_MODEL, nullptr}; pg8::gemm_phase<pg8::EpiF32, pg8::StaticOrder, false>(ldsb, g, S, E, nullptr); }
    xcd_barrier(bar);
    ph_ln_res(xall, mix, ln1_g, ln1_b, hbuf, A2);
    xcd_barrier(bar);
    { pg8::Gemm g{A2, wt_q, T_ALL, 2048, D_MODEL}; pg8::StaticOrder S; S.init(g.M, g.N, (int)gridDim.x, (int)blockIdx.x);
      pg8::EpiF32 E{qh, 2048, nullptr}; pg8::gemm_phase<pg8::EpiF32, pg8::StaticOrder, false>(ldsb, g, S, E, nullptr); }
    xcd_barrier(bar);
    ph_peer_route(lds, qh, keys1, keys2, eidx, gate);
    xcd_barrier(bar);
    ph_peer_ffn2(hbuf, eidx, gate, ub, vb, ln2_g, ln2_b, out);
}

extern "C" void kernel_launch(void* const* d_in, const int* in_sizes, int n_in, void* d_out, int out_size, void* d_ws, size_t ws_size, hipStream_t stream) {
    static int grid = 0;
    if (grid == 0) {
        int dev = 0, cus = 0, per_cu = 0;
        if (hipGetDevice(&dev) != hipSuccess || hipDeviceGetAttribute(&cus, hipDeviceAttributeMultiprocessorCount, dev) != hipSuccess) { fprintf(stderr, "kernel_launch: device query failed\n"); grid = -1; return; }
        if (hipFuncSetAttribute((const void*)mega_fwd, hipFuncAttributeMaxDynamicSharedMemorySize, LDS_BYTES) != hipSuccess) { fprintf(stderr, "kernel_launch: hipFuncSetAttribute failed\n"); grid = -1; return; }
        if (hipOccupancyMaxActiveBlocksPerMultiprocessor(&per_cu, (const void*)mega_fwd, NTHR, LDS_BYTES) != hipSuccess || per_cu < 1) { fprintf(stderr, "kernel_launch: occupancy query says %d\n", per_cu); }
        (void)hipGetLastError();
        grid = cus;
        if (ws_size < WS_END) { fprintf(stderr, "kernel_launch: workspace too small\n"); grid = -1; return; }
    }
    if (grid < 0) return;
    (void)hipMemsetAsync((char*)d_ws + WS_BAR, 0, XCD_BAR_WORDS * sizeof(unsigned), stream);
    Params p{};
    for (int i = 0; i < 23; ++i) p.in[i] = (const float*)d_in[i];
    p.out = (float*)d_out; p.ws = (unsigned char*)d_ws; p.bar = (unsigned*)((char*)d_ws + WS_BAR);
    hipLaunchKernelGGL(mega_fwd, dim3(grid), dim3(NTHR), LDS_BYTES, stream, p);
}
```

```cpp
#include <hip/hip_runtime.h>
#include <stdint.h>

#define D_MODEL 1024
#define BATCH 2
#define SEQ 8192
#define DEC_BATCH 128
#define DEC_SEQ 4
#define PAST_LEN 8192
#define HEAD_DIM 64
#define ATT_WIDTH 512
#define ATT_HEADS 8
#define SSD_WIDTH 1536
#define SSD_HEADS 24
#define SSD_GROUPS 4
#define SSD_STATE 128
#define CONV_DIM 2560
#define IN_WIDTH 5656
#define PROJ_LD 5888
#define MIX_WIDTH 2048
#define WBUF 2048
#define PEER_NKEYS 128
#define PEER_HEADS 8
#define PEER_TOPK 16
#define PEER_DKEY 256
#define T_PROMPT (BATCH * SEQ)
#define T_SAMPLE (DEC_BATCH * DEC_SEQ)
#define T_ALL (T_PROMPT + T_SAMPLE)
#define O_Z 0
#define O_XBC 1536
#define O_DT 4096
#define O_Q 4120
#define O_K 4632
#define O_V 5144
#define ALPHA_F 1.189207115002721f
#define LN_EPS 1e-5f

#define OUT_YP 0ull
#define OUT_YS (OUT_YP + 16777216ull)
#define OUT_PK (OUT_YS + 524288ull)
#define OUT_PV (OUT_PK + 2097152ull)
#define OUT_PC (OUT_PV + 2097152ull)
#define OUT_PS (OUT_PC + 15360ull)
#define OUT_SK (OUT_PS + 393216ull)
#define OUT_SV (OUT_SK + 134217728ull)
#define OUT_SC (OUT_SV + 134217728ull)
#define OUT_SS (OUT_SC + 983040ull)

__constant__ double ROPE_INV_REV[32] = {
    1.59154943091895346e-01, 1.19349370211248862e-01, 8.94994016088910133e-02, 6.71150830052272551e-02,
    5.03292121044870353e-02, 3.77415847174197711e-02, 2.83021958306233987e-02, 2.12236527647776604e-02,
    1.59154943091895339e-02, 1.19349370211248862e-02, 8.94994016088910237e-03, 6.71150830052272534e-03,
    5.03292121044870370e-03, 3.77415847174197719e-03, 2.83021958306233987e-03, 2.12236527647776622e-03,
    1.59154943091895356e-03, 1.19349370211248849e-03, 8.94994016088910237e-04, 6.71150830052272599e-04,
    5.03292121044870326e-04, 3.77415847174197741e-04, 2.83021958306233954e-04, 2.12236527647776605e-04,
    1.59154943091895351e-04, 1.19349370211248862e-04, 8.94994016088910182e-05, 6.71150830052272545e-05,
    5.03292121044870354e-05, 3.77415847174197768e-05, 2.83021958306233961e-05, 2.12236527647776592e-05
};

__device__ __forceinline__ float silu_f(float x) { return x / (1.0f + __expf(-x)); }
__device__ __forceinline__ float softplus_f(float x) { return fmaxf(x, 0.f) + log1pf(__expf(-fabsf(x))); }
__device__ __forceinline__ float gelu_f(float x) { return 0.5f * x * (1.0f + erff(x * 0.70710678118654752f)); }
__device__ __forceinline__ float wave_sum(float v) {
#pragma unroll
    for (int o = 32; o > 0; o >>= 1) v += __shfl_xor(v, o);
    return v;
}
__device__ __forceinline__ float wave_max(float v) {
#pragma unroll
    for (int o = 32; o > 0; o >>= 1) v = fmaxf(v, __shfl_xor(v, o));
    return v;
}

#include <cstdio>
#define XB_TMO      128
#define XB_XCNT(j)  (256  + 64 * (j))
#define XB_XSUB(j)  (1280 + 64 * (j))
#define XB_XGEN(j)  (2304 + 64 * (j))
#define XB_TOP      3328
#define XB_TOPGEN   3392
#define XCD_BAR_WORDS 3456
#define XB_SPIN_CAP (1u << 18)
#define LAS __attribute__((address_space(3)))

__device__ __forceinline__ unsigned xb_ld(unsigned* p)              { return __hip_atomic_load(p, __ATOMIC_RELAXED, __HIP_MEMORY_SCOPE_AGENT); }
__device__ __forceinline__ unsigned xb_add(unsigned* p, unsigned v) { return __hip_atomic_fetch_add(p, v, __ATOMIC_RELAXED, __HIP_MEMORY_SCOPE_AGENT); }
__device__ __forceinline__ unsigned xb_xcc_id() { return (unsigned)__builtin_amdgcn_s_getreg((3 << 11) | 20) & 0xFu; }
#define XB_SPIN(cond, bar) do { unsigned _sp = 0; while (cond) { __builtin_amdgcn_s_sleep(1); \
    if ((++_sp & 255u) == 0u) { if (xb_ld(&(bar)[XB_TMO])) break; if (_sp > XB_SPIN_CAP) { atomicAdd(&(bar)[XB_TMO], 1u); break; } } } } while (0)

struct XcdBarrier {
    unsigned* bar; unsigned x;
    volatile LAS unsigned* st;
};

__device__ __forceinline__ XcdBarrier xcd_barrier_post(unsigned* bar, volatile LAS unsigned* st) {
    XcdBarrier b; b.bar = bar; b.x = xb_xcc_id(); b.st = st;
    if (threadIdx.x == 0) (void)xb_add(&bar[XB_XCNT(b.x)], 1u);
    return b;
}
__device__ __forceinline__ void xcd_barrier_complete(unsigned* bar, unsigned x, unsigned& nloc, unsigned& nx) {
    const unsigned G = gridDim.x * gridDim.y * gridDim.z;
    unsigned sum, cnt, mine, sp = 0u;
    for (;;) {
        sum = 0u; cnt = 0u; mine = 0u;
#pragma unroll
        for (unsigned j = 0; j < 16; ++j) { const unsigned c = xb_ld(&bar[XB_XCNT(j)]); sum += c; cnt += (c > 0u) ? 1u : 0u; mine = (j == x) ? c : mine; }
        if (sum == G) break;
        __builtin_amdgcn_s_sleep(1);
        if ((++sp & 255u) == 0u) { if (xb_ld(&bar[XB_TMO])) break; if (sp > XB_SPIN_CAP) { atomicAdd(&bar[XB_TMO], 1u); break; } }
    }
    nloc = mine > 0u ? mine : 1u; nx = cnt > 0u ? cnt : 1u;
}

__device__ __forceinline__ void xcd_barrier(const XcdBarrier& b) {
    asm volatile("s_waitcnt vmcnt(0)" ::: "memory");
    __syncthreads();
    if (threadIdx.x == 0) {
        unsigned* bar = b.bar;
        __builtin_amdgcn_s_waitcnt(0);
        unsigned nloc = b.st[0], nx = b.st[1];
        if (nloc == 0u) { xcd_barrier_complete(bar, b.x, nloc, nx); b.st[0] = nloc; b.st[1] = nx; }
        const unsigned old = xb_add(&bar[XB_XSUB(b.x)], 1u);
        const unsigned gen = old / nloc;
        if (old + 1u == (gen + 1u) * nloc) {
            __builtin_amdgcn_fence(__ATOMIC_RELEASE, "agent");
            asm volatile("s_waitcnt vmcnt(0)" ::: "memory");
            const unsigned og = xb_add(&bar[XB_TOP], 1u);
            const unsigned tg = og / nx;
            if (og + 1u == (tg + 1u) * nx) xb_add(&bar[XB_TOPGEN], 1u);
            else XB_SPIN(xb_ld(&bar[XB_TOPGEN]) == tg, bar);
            __builtin_amdgcn_fence(__ATOMIC_ACQUIRE, "agent");
            xb_add(&bar[XB_XGEN(b.x)], 1u);
            asm volatile("s_waitcnt vmcnt(0)" ::: "memory");
        } else {
            XB_SPIN(xb_ld(&bar[XB_XGEN(b.x)]) == gen, bar);
            __builtin_amdgcn_fence(__ATOMIC_ACQUIRE, "agent");
            asm volatile("s_waitcnt vmcnt(0)" ::: "memory");
        }
    }
    __syncthreads();
}


#define GAS __attribute__((address_space(1)))
typedef unsigned short bf16;
typedef unsigned v4u __attribute__((ext_vector_type(4)));
#define LDS_WAIT() asm volatile("s_waitcnt lgkmcnt(0)" ::: "memory")
__device__ __forceinline__ unsigned f2bf(float f) { unsigned u = __builtin_bit_cast(unsigned, f); return (u + 0x7fffu + ((u >> 16) & 1u)) >> 16; }
__device__ __forceinline__ unsigned pk2(float lo, float hi) { return f2bf(lo) | (f2bf(hi) << 16); }
__device__ __forceinline__ float bf2f(unsigned short b) { return __builtin_bit_cast(float, (unsigned)b << 16); }
#include <hip/hip_runtime.h>
namespace pg8 {
#define PG8_LAS __attribute__((address_space(3)))
typedef unsigned short bf16_t;
typedef short bf16x8 __attribute__((ext_vector_type(8)));
typedef float f32x4 __attribute__((ext_vector_type(4)));
typedef unsigned u32x4 __attribute__((ext_vector_type(4)));
constexpr int BM = 256, BK = 64, HALF = 128, HTB = HALF * BK * 2  , STAGE_BYTES = 8 * HTB, NXCD = 8, WGM = 8;

__host__ __device__ __forceinline__ int lds_byte(int r, int c) { const int st = (r >> 4) * 2 + (c >> 5), rr = r & 15, cc = c & 31, ob = rr * 64 + cc * 2; return st * 1024 + (ob ^ (((ob >> 9) & 1) << 5)); }
__host__ __device__ __forceinline__ void stage_rc(int b, int& R, int& C) { const int st = b / 1024, sb = b % 1024, swz = sb ^ (((sb >> 9) & 1) << 5); R = (st >> 1) * 16 + swz / 64; C = (st & 1) * 32 + (swz % 64) / 2; }
__host__ __device__ __forceinline__ int perm32(int rho) { const int n = rho >> 4, i = rho & 15; return 8 * (i >> 2) + 4 * n + (i & 3); }

struct Unit { int pm, pn; };
struct Gemm { const bf16_t* A; const bf16_t* Bt; int M, N, K; };

struct StaticOrder {
    int nM, nN, nwg, G, c;
    __host__ __device__ void init(int M, int N, int G_, int c_) { nM = M / BM; nN = N / BM; nwg = nM * nN; G = G_; c = c_; }
    __host__ __device__ bool next(int i, Unit& u) const {
        const long L = (long)i * G + c; if (L >= nwg) return false;
        int wgid = (int)L; { const int q = nwg / NXCD, r = nwg % NXCD, xcd = wgid % NXCD, off = wgid / NXCD; wgid = (xcd < r ? xcd * (q + 1) : r * (q + 1) + (xcd - r) * q) + off; }
        const int nig = WGM * nN, gid = wgid / nig, fm = gid * WGM, gsz = (nM - fm) < WGM ? (nM - fm) : WGM;
        u.pm = fm + ((wgid % nig) % gsz); u.pn = (wgid % nig) / gsz; return true;
    }
    __device__ __forceinline__ void a_ready(const Unit&) const {}
    __device__ __forceinline__ void done(const Unit&) const {}
};
__device__ __forceinline__ unsigned cvt_pk_bf16(float lo, float hi) { unsigned r; asm volatile("v_cvt_pk_bf16_f32 %0, %1, %2" : "=v"(r) : "v"(lo), "v"(hi)); return r; }
typedef float f32x2 __attribute__((ext_vector_type(2)));
__device__ __forceinline__ f32x2 gelu_pk(f32x2 v) {
    const f32x2 av = __builtin_elementwise_abs(v), d = av * 0.2316418882f + 1.0f;
    f32x2 t; t.x = __builtin_amdgcn_rcpf(d.x); t.y = __builtin_amdgcn_rcpf(d.y);
    f32x2 q = t * 0.5307027145f + (-0.7265760135f); q = q * t + 0.7107068705f; q = q * t + (-0.142248368f); q = q * t + 0.127414796f; q = q * t;
    const f32x2 s = (v * v) * (-0.72134752044f);
    f32x2 e; e.x = __builtin_amdgcn_exp2f(s.x); e.y = __builtin_amdgcn_exp2f(s.y);
    const f32x2 m = v * (q * e), r = v - m;
    f32x2 o; o.x = v.x < 0.f ? m.x : r.x; o.y = v.y < 0.f ? m.y : r.y; return o;
}

struct EpiF32 {
    static constexpr bool PERM = false, AFTER_DRAIN = false;
    float* C; int ldc; const float* bias;
    __device__ __forceinline__ void operator()(const f32x4 (&acc)[2][2][4][2], const Unit& u, int wr, int wc, int fr, int fq) const {
        const int row0 = u.pm * BM + wr * 64 + fr, col0 = u.pn * BM + wc * 32 + 4 * fq;
        f32x4 bv[2][2];
#pragma unroll
        for (int bj = 0; bj < 2; ++bj)
#pragma unroll
            for (int n = 0; n < 2; ++n) bv[bj][n] = bias ? *(const f32x4*)(bias + col0 + bj * HALF + n * 16) : (f32x4){0.f, 0.f, 0.f, 0.f};
#pragma unroll
        for (int ai = 0; ai < 2; ++ai)
#pragma unroll
            for (int m = 0; m < 4; ++m) { float* rowp = C + (size_t)(row0 + ai * HALF + m * 16) * ldc + col0;
#pragma unroll
                for (int bj = 0; bj < 2; ++bj)
#pragma unroll
                    for (int n = 0; n < 2; ++n) *(f32x4*)(rowp + bj * HALF + n * 16) = acc[ai][bj][m][n] + bv[bj][n]; }
    }
};

template <class Epi, class Sched, bool STAMP = false>
__device__ __forceinline__ void gemm_phase(PG8_LAS unsigned char* lds, const Gemm g, const Sched& S, const Epi& E, unsigned long long* stamps) {
    const int tid = threadIdx.x, wid = __builtin_amdgcn_readfirstlane(tid >> 6), lane = tid & 63, wr = wid >> 2, wc = wid & 3, fr = lane & 15, fq = lane >> 4;
    const int K = g.K, nt = K / BK;
    int ts_lo = 0, ts_hi = 0, nts = 0; const unsigned long long rt_entry = STAMP ? (unsigned long long)wall_clock64() : 0ull;
#define PG8_STAMP() do { if (STAMP && wid == 0 && nts < 64) { const unsigned long long _c = (unsigned long long)clock64(); \
        ts_lo = (lane == nts) ? (int)(unsigned)_c : ts_lo; ts_hi = (lane == nts) ? (int)(unsigned)(_c >> 32) : ts_hi; ++nts; } } while (0)
    PG8_STAMP();
    unsigned voffA[2], voffB[2];
#pragma unroll
    for (int i = 0; i < 2; ++i) { int R, C; stage_rc(tid * 16 + i * 8192, R, C); const int Rb = Epi::PERM ? ((R & ~31) + perm32(R & 31)) : R;
        voffA[i] = (unsigned)(R * K + C) * 2u; voffB[i] = (unsigned)(Rb * K + C) * 2u; }
    const size_t kstep = (size_t)(BK * 2);
    const size_t hstep = (size_t)HALF * K * 2;
    const size_t tstep = 2 * hstep;
    const unsigned ldsw = (unsigned)wid * 1024u;
    const int aoff = lds_byte(wr * 64 + fr, fq * 8), boff = lds_byte(wc * 32 + fr, fq * 8);
#define PG8_SA(b, h) (((b) * 2 + (h)) * HTB)
#define PG8_SB(b, h) ((4 + (b) * 2 + (h)) * HTB)
#define PG8_STAGE(bufoff, gbase, voff) do { _Pragma("unroll") for (int _i = 0; _i < 2; ++_i) \
        __builtin_amdgcn_global_load_lds((const unsigned*)((const char*)(gbase) + (voff)[_i]), (PG8_LAS unsigned*)(lds + (bufoff) + ldsw + _i * 8192), 16, 0, 0); } while (0)
#define PG8_LDA(dst, b, h) do { _Pragma("unroll") for (int m = 0; m < 4; ++m) _Pragma("unroll") for (int k = 0; k < 2; ++k) dst[m][k] = *(const PG8_LAS bf16x8*)(lds + PG8_SA(b, h) + aoff + m * 2048 + k * 1024); } while (0)
#define PG8_LDB(dst, b, h) do { _Pragma("unroll") for (int n = 0; n < 2; ++n) _Pragma("unroll") for (int k = 0; k < 2; ++k) dst[n][k] = *(const PG8_LAS bf16x8*)(lds + PG8_SB(b, h) + boff + n * 2048 + k * 1024); } while (0)
#define PG8_MMA(ai, bj, At, Bt) do { __builtin_amdgcn_s_setprio(1); _Pragma("unroll") for (int m = 0; m < 4; ++m) _Pragma("unroll") for (int n = 0; n < 2; ++n) _Pragma("unroll") for (int k = 0; k < 2; ++k) \
        acc[ai][bj][m][n] = __builtin_amdgcn_mfma_f32_16x16x32_bf16(Bt[n][k], At[m][k], acc[ai][bj][m][n], 0, 0, 0); __builtin_amdgcn_s_setprio(0); } while (0)
#define PG8_WAIT_V(n) asm volatile("s_waitcnt vmcnt(" #n ")" ::: "memory")
#define PG8_WAIT_L(n) asm volatile("s_waitcnt lgkmcnt(" #n ")" ::: "memory")
#define PG8_BAR __builtin_amdgcn_s_barrier()
#define PG8_SCHED __builtin_amdgcn_sched_barrier(0)
    Unit cur, nxt; int ui = 0;
    if (!S.next(0, cur)) return;
    f32x4 acc[2][2][4][2];
#pragma unroll
    for (int a = 0; a < 2; ++a)
#pragma unroll
        for (int b = 0; b < 2; ++b)
#pragma unroll
            for (int m = 0; m < 4; ++m)
#pragma unroll
                for (int n = 0; n < 2; ++n) acc[a][b][m][n] = (f32x4){0.f, 0.f, 0.f, 0.f};
    bf16x8 At[4][2], B0[2][2], B1[2][2];
    const char* cA = (const char*)g.A + (size_t)cur.pm * tstep; const char* cB = (const char*)g.Bt + (size_t)cur.pn * tstep;
    S.a_ready(cur);
    PG8_STAGE(PG8_SB(0, 0), cB, voffB); PG8_STAGE(PG8_SA(0, 0), cA, voffA); PG8_STAGE(PG8_SB(0, 1), cB + hstep, voffB); PG8_STAGE(PG8_SA(0, 1), cA + hstep, voffA);
    if (wr == 1) PG8_BAR;
    PG8_WAIT_V(4); PG8_BAR;
    PG8_STAGE(PG8_SB(1, 0), cB + kstep, voffB); PG8_STAGE(PG8_SA(1, 0), cA + kstep, voffA); PG8_STAGE(PG8_SB(1, 1), cB + hstep + kstep, voffB);
    PG8_WAIT_V(6); PG8_BAR;
    PG8_STAMP();
    for (;;) {
        const bool has_next = S.next(ui + 1, nxt);
        const char* nA = has_next ? (const char*)g.A + (size_t)nxt.pm * tstep : cA; const char* nB = has_next ? (const char*)g.Bt + (size_t)nxt.pn * tstep : cB;
        for (int t = 0; t < nt; t += 2) {
            const bool last = (t == nt - 2);
            const char* a1 = cA + (size_t)(t + 1) * kstep;
            const char* a2 = last ? nA : cA + (size_t)(t + 2) * kstep; const char* b2 = last ? nB : cB + (size_t)(t + 2) * kstep;
            const char* a3 = a2 + kstep; const char* b3 = b2 + kstep;
            if (last && has_next) S.a_ready(nxt);
            PG8_LDB(B0, 0, 0); PG8_SCHED; PG8_LDA(At, 0, 0); PG8_STAGE(PG8_SA(1, 1), a1 + hstep, voffA);
            PG8_WAIT_L(8); PG8_BAR; PG8_WAIT_L(0); PG8_MMA(0, 0, At, B0); PG8_BAR; PG8_SCHED;
            PG8_LDB(B1, 0, 1); PG8_STAGE(PG8_SB(0, 0), b2, voffB);
            PG8_BAR; PG8_WAIT_L(0); PG8_MMA(0, 1, At, B1); PG8_BAR;
            PG8_LDA(At, 0, 1); PG8_STAGE(PG8_SA(0, 0), a2, voffA);
            PG8_BAR; PG8_WAIT_L(0); PG8_MMA(1, 0, At, B0); PG8_BAR; PG8_SCHED;
            PG8_STAGE(PG8_SB(0, 1), b2 + hstep, voffB);
            PG8_WAIT_V(6); PG8_BAR; PG8_MMA(1, 1, At, B1); PG8_BAR;
            PG8_LDB(B0, 1, 0); PG8_SCHED; PG8_LDA(At, 1, 0); PG8_STAGE(PG8_SA(0, 1), a2 + hstep, voffA);
            PG8_WAIT_L(8); PG8_BAR; PG8_WAIT_L(0); PG8_MMA(0, 0, At, B0); PG8_BAR; PG8_SCHED;
            PG8_LDB(B1, 1, 1); PG8_STAGE(PG8_SB(1, 0), b3, voffB);
            PG8_BAR; PG8_WAIT_L(0); PG8_MMA(0, 1, At, B1); PG8_BAR;
            PG8_LDA(At, 1, 1); PG8_STAGE(PG8_SA(1, 0), a3, voffA);
            PG8_BAR; PG8_WAIT_L(0); PG8_MMA(1, 0, At, B0); PG8_BAR; PG8_SCHED;
            PG8_STAGE(PG8_SB(1, 1), b3 + hstep, voffB);
            PG8_WAIT_V(6); PG8_BAR; PG8_MMA(1, 1, At, B1); PG8_BAR;
        }
        PG8_STAMP();
        if constexpr (!Epi::AFTER_DRAIN) { E(acc, cur, wr, wc, fr, fq); S.done(cur); }
        PG8_STAMP();
        if (!has_next) break;
#pragma unroll
        for (int a = 0; a < 2; ++a)
#pragma unroll
            for (int b = 0; b < 2; ++b)
#pragma unroll
                for (int m = 0; m < 4; ++m)
#pragma unroll
                    for (int n = 0; n < 2; ++n) acc[a][b][m][n] = (f32x4){0.f, 0.f, 0.f, 0.f};
        cur = nxt; cA = nA; cB = nB; ++ui;
    }
    PG8_WAIT_V(0);
    if (wr == 0) PG8_BAR;
    PG8_BAR;
    if constexpr (Epi::AFTER_DRAIN) { E.fused(acc, cur, wr, wc, fr, fq, lds, wid, lane); S.done(cur); }
    PG8_STAMP();
    if (STAMP && wid == 0) { stamps[lane] = lane < nts ? (((unsigned long long)(unsigned)ts_hi << 32) | (unsigned)ts_lo) : 0ull;
        if (lane == 62) stamps[62] = rt_entry; if (lane == 63) stamps[63] = (unsigned long long)wall_clock64(); }
#undef PG8_STAMP
#undef PG8_SA
#undef PG8_SB
#undef PG8_STAGE
#undef PG8_LDA
#undef PG8_LDB
#undef PG8_MMA
#undef PG8_WAIT_V
#undef PG8_WAIT_L
#undef PG8_BAR
#undef PG8_SCHED
}
}


namespace pg8 {
struct EpiProj {
    static constexpr bool PERM = true, AFTER_DRAIN = false;
    bf16_t* O; float* dtraw;
    __device__ __forceinline__ void operator()(const f32x4 (&acc)[2][2][4][2], const Unit& u, int wr, int wc, int fr, int fq) const {
        const int row0 = u.pm * BM + wr * 64 + fr;
        if (u.pn < 22) {
            const int col0 = u.pn * BM + wc * 32 + 8 * fq;
#pragma unroll
            for (int ai = 0; ai < 2; ++ai)
#pragma unroll
                for (int m = 0; m < 4; ++m) { bf16_t* rowp = O + (size_t)(row0 + ai * HALF + m * 16) * 5632 + col0;
#pragma unroll
                    for (int bj = 0; bj < 2; ++bj) { const f32x4 v0 = acc[ai][bj][m][0], v1 = acc[ai][bj][m][1];
                        u32x4 w; w.x = cvt_pk_bf16(v0[0], v0[1]); w.y = cvt_pk_bf16(v0[2], v0[3]); w.z = cvt_pk_bf16(v1[0], v1[1]); w.w = cvt_pk_bf16(v1[2], v1[3]);
                        *(u32x4*)(rowp + bj * HALF) = w; } }
        } else if (wc == 0) {
#pragma unroll
            for (int ai = 0; ai < 2; ++ai)
#pragma unroll
                for (int m = 0; m < 4; ++m) { float* rp = dtraw + (size_t)(row0 + ai * HALF + m * 16) * 32 + 8 * fq;
                    *(f32x4*)rp = acc[ai][0][m][0]; *(f32x4*)(rp + 4) = acc[ai][0][m][1]; }
        }
    }
};
}

#define NTHR 512
#define NWAVE 8

__device__ __forceinline__ void ph_gemm_f32(float* lds, const float* __restrict__ A, const float* __restrict__ B, float* __restrict__ C,
                                            int M, int N, int K, int lda, int ldb, int ldc) {
    const int tid = threadIdx.x & 255, half = threadIdx.x >> 8, tx = tid & 15, ty = tid >> 4;
    float (*As)[68] = (float (*)[68])(lds + half * 2 * 16 * 68);
    float (*Bs)[68] = (float (*)[68])(lds + half * 2 * 16 * 68 + 16 * 68);
    const int ntx = (N + 63) / 64, nty = M / 64, ntiles = ntx * nty;
    for (int it = blockIdx.x; 2 * it < ntiles; it += gridDim.x) {
        const int tile = 2 * it + half;
        const int m0 = (tile / ntx) * 64, n0 = (tile % ntx) * 64;
        float acc[4][4];
#pragma unroll
        for (int i = 0; i < 4; ++i)
#pragma unroll
            for (int j = 0; j < 4; ++j) acc[i][j] = 0.f;
        for (int k0 = 0; k0 < K; k0 += 16) {
#pragma unroll
            for (int i = 0; i < 4; ++i) {
                int idx = tid + i * 256;
                int r = idx >> 4, c = idx & 15;
                As[c][r] = (m0 + r < M) ? A[(size_t)(m0 + r) * lda + k0 + c] : 0.f;
                int rb = idx >> 6, cb = idx & 63;
                Bs[rb][cb] = (n0 + cb < N) ? B[(size_t)(k0 + rb) * ldb + n0 + cb] : 0.f;
            }
            __syncthreads();
#pragma unroll
            for (int k = 0; k < 16; ++k) {
                float a[4], b[4];
#pragma unroll
                for (int i = 0; i < 4; ++i) { a[i] = As[k][ty * 4 + i]; b[i] = Bs[k][tx * 4 + i]; }
#pragma unroll
                for (int i = 0; i < 4; ++i)
#pragma unroll
                    for (int j = 0; j < 4; ++j) acc[i][j] += a[i] * b[j];
            }
            __syncthreads();
        }
#pragma unroll
        for (int i = 0; i < 4; ++i)
#pragma unroll
            for (int j = 0; j < 4; ++j) {
                int r = m0 + ty * 4 + i, c = n0 + tx * 4 + j;
                if (r < M && c < N) C[(size_t)r * ldc + c] = acc[i][j];
            }
    }
}


template <int MODE>
__device__ __forceinline__ void transpose_item(const float* __restrict__ W, int K, int N, int Npad, bf16* __restrict__ WT, LAS float* scr, int item, int lane) {
    const int nblk = Npad / 32, kb = item / nblk, nb = item % nblk, k0 = 64 * kb, n0 = 32 * nb;
    const int n = n0 + (lane & 31);
    int sc = n;
    if (MODE == 1) sc = (n < 4096) ? n : (n < 5632 ? n + 24 : (n < 5656 ? n - 5632 + 4096 : -1));
    else sc = (n < N) ? n : -1;
#pragma unroll 8
    for (int i = 0; i < 32; ++i) { const int kk = 2 * i + (lane >> 5); scr[kk * 33 + (lane & 31)] = (sc >= 0) ? W[(size_t)(k0 + kk) * N + sc] : 0.f; }
    LDS_WAIT(); asm volatile("" ::: "memory");
    const int c = lane & 7;
#pragma unroll
    for (int j = 0; j < 4; ++j) { const int nn = (lane >> 3) + 8 * j; const LAS float* s = scr + (8 * c) * 33 + nn;
        v4u o; o.x = pk2(s[0 * 33], s[1 * 33]); o.y = pk2(s[2 * 33], s[3 * 33]); o.z = pk2(s[4 * 33], s[5 * 33]); o.w = pk2(s[6 * 33], s[7 * 33]);
        *(v4u*)(WT + (size_t)(n0 + nn) * K + k0 + 8 * c) = o; }
    LDS_WAIT(); asm volatile("" ::: "memory");
}
__device__ __forceinline__ void ph_prologue(LAS unsigned char* ldsb, const float* __restrict__ xp, const float* __restrict__ xs, bf16* __restrict__ A0,
                                            const float* __restrict__ w_in, bf16* __restrict__ wt_in, const float* __restrict__ w_out, bf16* __restrict__ wt_out,
                                            const float* __restrict__ w_q, bf16* __restrict__ wt_q,
                                            const float* __restrict__ pu, const float* __restrict__ pv, bf16* __restrict__ ub, bf16* __restrict__ vb) {
    const int lane = threadIdx.x & 63, wave = threadIdx.x >> 6;
    LAS float* scr = (LAS float*)(ldsb + wave * 16384);
    const int gw = blockIdx.x * NWAVE + wave, NGW = gridDim.x * NWAVE;
    constexpr int I_IN = (D_MODEL / 64) * (PROJ_LD / 32), I_OUT = (MIX_WIDTH / 64) * (D_MODEL / 32), I_Q = (D_MODEL / 64) * (2048 / 32);
    for (int it = gw; it < I_IN + I_OUT + I_Q; it += NGW) {
        int r = it;
        if (r < I_IN) { transpose_item<1>(w_in, D_MODEL, IN_WIDTH, PROJ_LD, wt_in, scr, r, lane); continue; } r -= I_IN;
        if (r < I_OUT) { transpose_item<0>(w_out, MIX_WIDTH, D_MODEL, D_MODEL, wt_out, scr, r, lane); continue; } r -= I_OUT;
        transpose_item<0>(w_q, D_MODEL, 2048, 2048, wt_q, scr, r, lane);
    }
    const size_t n8 = (size_t)T_ALL * D_MODEL / 8, np8 = (size_t)T_PROMPT * D_MODEL / 8;
    for (size_t i = (size_t)blockIdx.x * NTHR + threadIdx.x; i < n8; i += (size_t)gridDim.x * NTHR) {
        const float4* s = (i < np8) ? (const float4*)xp + 2 * i : (const float4*)xs + 2 * (i - np8);
        float4 a = s[0], b = s[1];
        v4u o; o.x = pk2(a.x, a.y); o.y = pk2(a.z, a.w); o.z = pk2(b.x, b.y); o.w = pk2(b.z, b.w);
        ((v4u*)A0)[i] = o;
    }
    const size_t t8 = (size_t)16384 * D_MODEL / 8;
    for (size_t i = (size_t)blockIdx.x * NTHR + threadIdx.x; i < 2 * t8; i += (size_t)gridDim.x * NTHR) {
        const float4* s = (i < t8) ? (const float4*)pu + 2 * i : (const float4*)pv + 2 * (i - t8);
        float4 a = s[0], b = s[1];
        v4u o; o.x = pk2(a.x, a.y); o.y = pk2(a.z, a.w); o.z = pk2(b.x, b.y); o.w = pk2(b.z, b.w);
        if (i < t8) ((v4u*)ub)[i] = o; else ((v4u*)vb)[i - t8] = o;
    }
}

__device__ __forceinline__ void ph_concat_x(const float* __restrict__ xp, const float* __restrict__ xs, float* __restrict__ xall) {
    const size_t n4 = (size_t)T_ALL * D_MODEL / 4, np4 = (size_t)T_PROMPT * D_MODEL / 4;
    for (size_t i = (size_t)blockIdx.x * NTHR + threadIdx.x; i < n4; i += (size_t)gridDim.x * NTHR) {
        float4 v = (i < np4) ? ((const float4*)xp)[i] : ((const float4*)xs)[i - np4];
        ((float4*)xall)[i] = v;
    }
}

__device__ __forceinline__ void ph_cache_copy(const float* __restrict__ ck, const float* __restrict__ cv, float* __restrict__ out) {
    const size_t per_b4 = (size_t)(WBUF - DEC_SEQ) * ATT_WIDTH / 4;
    const size_t total = per_b4 * DEC_BATCH;
    for (size_t i = (size_t)blockIdx.x * NTHR + threadIdx.x; i < total; i += (size_t)gridDim.x * NTHR) {
        size_t b = i / per_b4, r = i % per_b4;
        size_t src = (b * WBUF * ATT_WIDTH + DEC_SEQ * ATT_WIDTH) / 4 + r;
        size_t dst = (b * WBUF * ATT_WIDTH) / 4 + r;
        ((float4*)(out + OUT_SK))[dst] = ((const float4*)ck)[src];
        ((float4*)(out + OUT_SV))[dst] = ((const float4*)cv)[src];
    }
}

__device__ __forceinline__ void ph_post_proj(const float* __restrict__ proj, const float* __restrict__ state_conv,
                                             const float* __restrict__ conv_w, const float* __restrict__ conv_b, const float* __restrict__ dt_bias,
                                             float* __restrict__ xbc_act, float* __restrict__ dtv, float* __restrict__ qrot, float* __restrict__ krot,
                                             float* __restrict__ out) {
    const int tid = threadIdx.x & 255, half = threadIdx.x >> 8;
    for (int t = 2 * blockIdx.x + half; t < T_ALL; t += 2 * gridDim.x) {
        const bool is_p = t < T_PROMPT;
        int b, i, pos;
        if (is_p) { b = t / SEQ; i = t % SEQ; pos = i; } else { int ts = t - T_PROMPT; b = ts / DEC_SEQ; i = ts % DEC_SEQ; pos = PAST_LEN + i; }
        const float* row = proj + (size_t)t * PROJ_LD;
        for (int c = tid; c < CONV_DIM; c += 256) {
            float acc = conv_b[c];
#pragma unroll
            for (int tap = 0; tap < 4; ++tap) {
                int r = i - 3 + tap;
                float val;
                if (r >= 0) val = proj[(size_t)(t - i + r) * PROJ_LD + O_XBC + c];
                else val = is_p ? 0.f : state_conv[((size_t)b * 3 + (3 + r)) * CONV_DIM + c];
                acc += val * conv_w[tap * CONV_DIM + c];
            }
            xbc_act[(size_t)t * CONV_DIM + c] = silu_f(acc);
        }
        if (tid < SSD_HEADS) dtv[(size_t)t * SSD_HEADS + tid] = softplus_f(row[O_DT + tid] + dt_bias[tid]);
        for (int idx = tid; idx < 512; idx += 256) {
            int which = idx >> 8, h = (idx >> 5) & 7, j = idx & 31;
            double rev = (double)pos * ROPE_INV_REV[j];
            float fr = (float)(rev - floor(rev));
            float sn = __builtin_amdgcn_sinf(fr), cs = __builtin_amdgcn_cosf(fr);
            const float* src = row + (which ? O_K : O_Q) + h * 64;
            float t1 = src[j], t2 = src[j + 32];
            float o1 = t1 * cs - t2 * sn, o2 = t2 * cs + t1 * sn;
            float* dst = (which ? krot : qrot) + (size_t)t * ATT_WIDTH + h * 64;
            dst[j] = o1; dst[j + 32] = o2;
            if (which) {
                if (is_p) { if (i >= SEQ - WBUF) { float* o = out + OUT_PK + ((size_t)b * WBUF + (i - (SEQ - WBUF))) * ATT_WIDTH + h * 64; o[j] = o1; o[j + 32] = o2; } }
                else { float* o = out + OUT_SK + ((size_t)b * WBUF + (WBUF - DEC_SEQ + i)) * ATT_WIDTH + h * 64; o[j] = o1; o[j + 32] = o2; }
            }
        }
        for (int c = tid; c < ATT_WIDTH; c += 256) {
            float v = row[O_V + c];
            if (is_p) { if (i >= SEQ - WBUF) out[OUT_PV + ((size_t)b * WBUF + (i - (SEQ - WBUF))) * ATT_WIDTH + c] = v; }
            else out[OUT_SV + ((size_t)b * WBUF + (WBUF - DEC_SEQ + i)) * ATT_WIDTH + c] = v;
        }
        if (is_p) {
            if (i >= SEQ - 3) { int r = i - (SEQ - 3); for (int c = tid; c < CONV_DIM; c += 256) out[OUT_PC + ((size_t)b * 3 + r) * CONV_DIM + c] = row[O_XBC + c]; }
        } else {
            if (i >= 1) { int r = i - 1; for (int c = tid; c < CONV_DIM; c += 256) out[OUT_SC + ((size_t)b * 3 + r) * CONV_DIM + c] = row[O_XBC + c]; }
        }
    }
}


#define NB_LD 5632
#define NB_XBC 1536
#define NB_Q 4096
#define NB_K 4608
#define NB_V 5120
__device__ __forceinline__ void unpack8(const v4u w, float (&f)[8]) {
    f[0] = __builtin_bit_cast(float, w.x << 16); f[1] = __builtin_bit_cast(float, w.x & 0xffff0000u);
    f[2] = __builtin_bit_cast(float, w.y << 16); f[3] = __builtin_bit_cast(float, w.y & 0xffff0000u);
    f[4] = __builtin_bit_cast(float, w.z << 16); f[5] = __builtin_bit_cast(float, w.z & 0xffff0000u);
    f[6] = __builtin_bit_cast(float, w.w << 16); f[7] = __builtin_bit_cast(float, w.w & 0xffff0000u);
}
__device__ __forceinline__ void store8f(float* d, const float (&f)[8]) { *(float4*)d = make_float4(f[0], f[1], f[2], f[3]); *(float4*)(d + 4) = make_float4(f[4], f[5], f[6], f[7]); }
__device__ __forceinline__ void ph_post_proj2(const bf16* __restrict__ projb, const float* __restrict__ dtraw, const float* __restrict__ state_conv,
                                              const float* __restrict__ conv_w, const float* __restrict__ conv_b, const float* __restrict__ dt_bias,
                                              float* __restrict__ proj, float* __restrict__ xbc_act, bf16* __restrict__ xbc_b, float* __restrict__ dtv,
                                              float* __restrict__ qrot, float* __restrict__ krot, bf16* __restrict__ qrot_b, bf16* __restrict__ krot_b,
                                              float* __restrict__ out) {
    const int tid = threadIdx.x & 255, half = threadIdx.x >> 8;
    for (int t = 2 * blockIdx.x + half; t < T_ALL; t += 2 * gridDim.x) {
        const bool is_p = t < T_PROMPT;
        int b, i, pos;
        if (is_p) { b = t / SEQ; i = t % SEQ; pos = i; } else { int ts = t - T_PROMPT; b = ts / DEC_SEQ; i = ts % DEC_SEQ; pos = PAST_LEN + i; }
        const bf16* row = projb + (size_t)t * NB_LD;
        if (tid < 192) { float f[8]; unpack8(*(const v4u*)(row + tid * 8), f); store8f(proj + (size_t)t * PROJ_LD + O_Z + tid * 8, f); }
        if (tid < 64) {
            float f[8]; unpack8(*(const v4u*)(row + NB_V + tid * 8), f);
            store8f(proj + (size_t)t * PROJ_LD + O_V + tid * 8, f);
            if (is_p) { if (i >= SEQ - WBUF) store8f(out + OUT_PV + ((size_t)b * WBUF + (i - (SEQ - WBUF))) * ATT_WIDTH + tid * 8, f); }
            else store8f(out + OUT_SV + ((size_t)b * WBUF + (WBUF - DEC_SEQ + i)) * ATT_WIDTH + tid * 8, f);
        }
        for (int c8 = tid; c8 < 320; c8 += 256) {
            const int c = c8 * 8;
            float acc[8], cur[8];
            { const float4 b0 = *(const float4*)(conv_b + c), b1 = *(const float4*)(conv_b + c + 4);
              acc[0] = b0.x; acc[1] = b0.y; acc[2] = b0.z; acc[3] = b0.w; acc[4] = b1.x; acc[5] = b1.y; acc[6] = b1.z; acc[7] = b1.w; }
#pragma unroll
            for (int tap = 0; tap < 4; ++tap) {
                const int r = i - 3 + tap;
                float val[8];
                if (r >= 0) unpack8(*(const v4u*)(projb + (size_t)(t - i + r) * NB_LD + NB_XBC + c), val);
                else if (!is_p) { const float* sp = state_conv + ((size_t)b * 3 + (3 + r)) * CONV_DIM + c; const float4 s0 = *(const float4*)sp, s1 = *(const float4*)(sp + 4);
                    val[0] = s0.x; val[1] = s0.y; val[2] = s0.z; val[3] = s0.w; val[4] = s1.x; val[5] = s1.y; val[6] = s1.z; val[7] = s1.w; }
                else {
#pragma unroll
                    for (int j = 0; j < 8; ++j) val[j] = 0.f; }
                const float4 w0 = *(const float4*)(conv_w + tap * CONV_DIM + c), w1 = *(const float4*)(conv_w + tap * CONV_DIM + c + 4);
                acc[0] += val[0] * w0.x; acc[1] += val[1] * w0.y; acc[2] += val[2] * w0.z; acc[3] += val[3] * w0.w;
                acc[4] += val[4] * w1.x; acc[5] += val[5] * w1.y; acc[6] += val[6] * w1.z; acc[7] += val[7] * w1.w;
                if (tap == 3) {
#pragma unroll
                    for (int j = 0; j < 8; ++j) cur[j] = val[j]; }
            }
#pragma unroll
            for (int j = 0; j < 8; ++j) acc[j] = silu_f(acc[j]);
            store8f(xbc_act + (size_t)t * CONV_DIM + c, acc);
            v4u o; o.x = pk2(acc[0], acc[1]); o.y = pk2(acc[2], acc[3]); o.z = pk2(acc[4], acc[5]); o.w = pk2(acc[6], acc[7]);
            *(v4u*)(xbc_b + (size_t)t * CONV_DIM + c) = o;
            if (is_p) { if (i >= SEQ - 3) store8f(out + OUT_PC + ((size_t)b * 3 + (i - (SEQ - 3))) * CONV_DIM + c, cur); }
            else { if (i >= 1) store8f(out + OUT_SC + ((size_t)b * 3 + (i - 1)) * CONV_DIM + c, cur); }
        }
        if (tid < SSD_HEADS) dtv[(size_t)t * SSD_HEADS + tid] = softplus_f(dtraw[(size_t)t * 32 + tid] + dt_bias[tid]);
        if (tid < 128) {
            const int which = tid >> 6, h = (tid >> 3) & 7, jc = tid & 7;
            const bf16* src = row + (which ? NB_K : NB_Q) + h * 64 + jc * 4;
            const uint2 lo = *(const uint2*)src, hi = *(const uint2*)(src + 32);
            float t1[4], t2[4], o1[4], o2[4];
            t1[0] = __builtin_bit_cast(float, lo.x << 16); t1[1] = __builtin_bit_cast(float, lo.x & 0xffff0000u); t1[2] = __builtin_bit_cast(float, lo.y << 16); t1[3] = __builtin_bit_cast(float, lo.y & 0xffff0000u);
            t2[0] = __builtin_bit_cast(float, hi.x << 16); t2[1] = __builtin_bit_cast(float, hi.x & 0xffff0000u); t2[2] = __builtin_bit_cast(float, hi.y << 16); t2[3] = __builtin_bit_cast(float, hi.y & 0xffff0000u);
#pragma unroll
            for (int e = 0; e < 4; ++e) {
                const double rev = (double)pos * ROPE_INV_REV[jc * 4 + e];
                const float fr = (float)(rev - floor(rev));
                const float sn = __builtin_amdgcn_sinf(fr), cs = __builtin_amdgcn_cosf(fr);
                o1[e] = t1[e] * cs - t2[e] * sn; o2[e] = t2[e] * cs + t1[e] * sn;
            }
            const size_t doff = (size_t)t * ATT_WIDTH + h * 64 + jc * 4;
            float* df = which ? krot : qrot; bf16* db = which ? krot_b : qrot_b;
            *(float4*)(df + doff) = make_float4(o1[0], o1[1], o1[2], o1[3]); *(float4*)(df + doff + 32) = make_float4(o2[0], o2[1], o2[2], o2[3]);
            *(uint2*)(db + doff) = make_uint2(pk2(o1[0], o1[1]), pk2(o1[2], o1[3])); *(uint2*)(db + doff + 32) = make_uint2(pk2(o2[0], o2[1]), pk2(o2[2], o2[3]));
            if (which) {
                float* o = nullptr;
                if (is_p) { if (i >= SEQ - WBUF) o = out + OUT_PK + ((size_t)b * WBUF + (i - (SEQ - WBUF))) * ATT_WIDTH + h * 64 + jc * 4; }
                else o = out + OUT_SK + ((size_t)b * WBUF + (WBUF - DEC_SEQ + i)) * ATT_WIDTH + h * 64 + jc * 4;
                if (o) { *(float4*)o = make_float4(o1[0], o1[1], o1[2], o1[3]); *(float4*)(o + 32) = make_float4(o2[0], o2[1], o2[2], o2[3]); }
            }
        }
    }
}

#define SSD_CH 32
__device__ __forceinline__ void ph_ssd_naive(float* lds, const float* __restrict__ xbc_act, const float* __restrict__ dtv, const float* __restrict__ a_log,
                                             const float* __restrict__ d_skip, const float* __restrict__ state_ssm, float* __restrict__ ybuf, float* __restrict__ out) {
    float (*sx)[64] = (float (*)[64])lds;
    float (*sB)[128] = (float (*)[128])(lds + SSD_CH * 64);
    float (*sC)[128] = (float (*)[128])(lds + SSD_CH * 64 + SSD_CH * 128);
    float* sdt = lds + SSD_CH * 64 + 2 * SSD_CH * 128;
    const int tid = threadIdx.x, p = tid >> 3, ng = tid & 7;
    for (int vb = BATCH * SSD_HEADS + blockIdx.x; vb < (BATCH + DEC_BATCH) * SSD_HEADS; vb += gridDim.x) {
        const int seq = vb / SSD_HEADS, h = vb % SSD_HEADS, g = h / 6;
        const bool is_p = seq < BATCH;
        const int L = is_p ? SEQ : DEC_SEQ;
        const int t0 = is_p ? seq * SEQ : T_PROMPT + (seq - BATCH) * DEC_SEQ;
        const float A = -__expf(a_log[h]);
        const float D = d_skip[h];
        float hs[16];
        if (is_p) {
#pragma unroll
            for (int j = 0; j < 16; ++j) hs[j] = 0.f;
        } else {
            const float* s0 = state_ssm + (((size_t)(seq - BATCH) * SSD_HEADS + h) * 64 + p) * 128 + ng * 16;
#pragma unroll
            for (int j = 0; j < 16; ++j) hs[j] = s0[j];
        }
        for (int c0 = 0; c0 < L; c0 += SSD_CH) {
            const int nst = (L - c0) < SSD_CH ? (L - c0) : SSD_CH;
            __syncthreads();
            for (int idx = tid; idx < nst * 64; idx += NTHR) { int s = idx >> 6, c = idx & 63; sx[s][c] = xbc_act[(size_t)(t0 + c0 + s) * CONV_DIM + h * 64 + c]; }
            for (int idx = tid; idx < nst * 128; idx += NTHR) { int s = idx >> 7, c = idx & 127;
                sB[s][c] = xbc_act[(size_t)(t0 + c0 + s) * CONV_DIM + 1536 + g * 128 + c];
                sC[s][c] = xbc_act[(size_t)(t0 + c0 + s) * CONV_DIM + 2048 + g * 128 + c]; }
            if (tid < nst) sdt[tid] = dtv[(size_t)(t0 + c0 + tid) * SSD_HEADS + h];
            __syncthreads();
            for (int s = 0; s < nst; ++s) {
                const float dt = sdt[s], x = sx[s][p];
                const float a = __expf(dt * A), xdt = x * dt;
                float y = 0.f;
#pragma unroll
                for (int j = 0; j < 16; ++j) { hs[j] = a * hs[j] + xdt * sB[s][ng * 16 + j]; y += sC[s][ng * 16 + j] * hs[j]; }
                y += __shfl_xor(y, 1); y += __shfl_xor(y, 2); y += __shfl_xor(y, 4);
                if (ng == 0) ybuf[(size_t)(t0 + c0 + s) * MIX_WIDTH + h * 64 + p] = y + D * x;
            }
        }
        float* so = is_p ? out + OUT_PS + (((size_t)seq * SSD_HEADS + h) * 64 + p) * 128 + ng * 16
                         : out + OUT_SS + (((size_t)(seq - BATCH) * SSD_HEADS + h) * 64 + p) * 128 + ng * 16;
#pragma unroll
        for (int j = 0; j < 16; ++j) so[j] = hs[j];
    }
}

__device__ __forceinline__ void ph_gate_norm(const float* __restrict__ proj, const float* __restrict__ norm_g, const float* __restrict__ ybuf, bf16* __restrict__ A1) {
    const int w = threadIdx.x >> 6, lane = threadIdx.x & 63, g = w & 3;
    for (int t = T_PROMPT + 2 * blockIdx.x + (w >> 2); t < T_ALL; t += 2 * gridDim.x) {
        {
        float v[6]; float ss = 0.f;
#pragma unroll
        for (int j = 0; j < 6; ++j) {
            int c = g * 384 + j * 64 + lane;
            float y = ybuf[(size_t)t * MIX_WIDTH + c], z = proj[(size_t)t * PROJ_LD + O_Z + c];
            v[j] = y * silu_f(z); ss += v[j] * v[j];
        }
        ss = wave_sum(ss);
        const float r = rsqrtf(ss * (1.0f / 384.0f) + LN_EPS);
#pragma unroll
        for (int j = 0; j < 6; ++j) { int c = g * 384 + j * 64 + lane; A1[(size_t)t * MIX_WIDTH + c] = (bf16)f2bf(v[j] * r * norm_g[c]); }
        }
#pragma unroll
        for (int j = 0; j < 2; ++j) { int c = SSD_WIDTH + g * 128 + j * 64 + lane; A1[(size_t)t * MIX_WIDTH + c] = (bf16)f2bf(ybuf[(size_t)t * MIX_WIDTH + c]); }
    }
}

__device__ __forceinline__ void ph_attn_naive(float* lds, const float* __restrict__ proj, const float* __restrict__ qrot, const float* __restrict__ krot,
                                              const float* __restrict__ ck, const float* __restrict__ cv, float* __restrict__ ybuf) {
    float (*sq)[64] = (float (*)[64])lds;
    const int w = threadIdx.x >> 6, lane = threadIdx.x & 63;
    for (int vb = blockIdx.x; vb < T_SAMPLE * 8 / NWAVE; vb += gridDim.x) {
        const int item = T_PROMPT * 8 + vb * NWAVE + w;
        const int t = item >> 3, h = item & 7;
        const bool is_p = t < T_PROMPT;
        int b, i;
        if (is_p) { b = t / SEQ; i = t % SEQ; } else { int ts = t - T_PROMPT; b = ts / DEC_SEQ; i = ts % DEC_SEQ; }
        __syncthreads();
        sq[w][lane] = qrot[(size_t)t * ATT_WIDTH + h * 64 + lane];
        __syncthreads();
        const int qi = is_p ? i : WBUF + i;
        float sc[3][3];
        float mx = -INFINITY;
#pragma unroll
        for (int pt = 0; pt < 3; ++pt) {
            const int d = pt == 0 ? 1 : (pt == 1 ? 4 : 16);
#pragma unroll
            for (int sl = 0; sl < 3; ++sl) {
                const int m = lane + sl * 64;
                float s = -INFINITY;
                const int kj = qi - d * m;
                if (m <= 128 && kj >= 0) {
                    const float* kr;
                    if (is_p) kr = krot + (size_t)(b * SEQ + kj) * ATT_WIDTH + h * 64;
                    else kr = (kj >= WBUF) ? krot + (size_t)(T_PROMPT + b * DEC_SEQ + (kj - WBUF)) * ATT_WIDTH + h * 64
                                           : ck + ((size_t)b * WBUF + kj) * ATT_WIDTH + h * 64;
                    float a = 0.f;
#pragma unroll
                    for (int c = 0; c < 64; c += 4) { float4 kv = *(const float4*)(kr + c); a += kv.x * sq[w][c] + kv.y * sq[w][c + 1] + kv.z * sq[w][c + 2] + kv.w * sq[w][c + 3]; }
                    s = a * 0.125f;
                }
                sc[pt][sl] = s; mx = fmaxf(mx, s);
            }
        }
        mx = wave_max(mx);
        float lsum = 0.f;
#pragma unroll
        for (int pt = 0; pt < 3; ++pt)
#pragma unroll
            for (int sl = 0; sl < 3; ++sl) { float pv = (sc[pt][sl] == -INFINITY) ? 0.f : __expf(sc[pt][sl] - mx); sc[pt][sl] = pv; lsum += pv; }
        lsum = wave_sum(lsum);
        float o = 0.f;
#pragma unroll
        for (int pt = 0; pt < 3; ++pt) {
            const int d = pt == 0 ? 1 : (pt == 1 ? 4 : 16);
#pragma unroll
            for (int sl = 0; sl < 3; ++sl) {
                const int mend = sl < 2 ? 64 : 1;
                for (int ml = 0; ml < mend; ++ml) {
                    const int m = ml + sl * 64;
                    const int kj = qi - d * m;
                    const float pv = __shfl(sc[pt][sl], ml);
                    if (kj < 0) continue;
                    const float* vr;
                    if (is_p) vr = proj + (size_t)(b * SEQ + kj) * PROJ_LD + O_V + h * 64;
                    else vr = (kj >= WBUF) ? proj + (size_t)(T_PROMPT + b * DEC_SEQ + (kj - WBUF)) * PROJ_LD + O_V + h * 64
                                           : cv + ((size_t)b * WBUF + kj) * ATT_WIDTH + h * 64;
                    o += pv * vr[lane];
                }
            }
        }
        ybuf[(size_t)t * MIX_WIDTH + SSD_WIDTH + h * 64 + lane] = o / lsum;
    }
}

__device__ __forceinline__ void ph_ln_res(const float* __restrict__ res, const float* __restrict__ add, const float* __restrict__ gam,
                                          const float* __restrict__ bet, float* __restrict__ dst, bf16* __restrict__ dstb) {
    const int lane = threadIdx.x & 63;
    for (int t = blockIdx.x * NWAVE + (threadIdx.x >> 6); t < T_ALL; t += gridDim.x * NWAVE) {
        float v[16]; float s = 0.f;
#pragma unroll
        for (int j = 0; j < 16; ++j) { int c = j * 64 + lane; v[j] = ALPHA_F * res[(size_t)t * D_MODEL + c] + add[(size_t)t * D_MODEL + c]; s += v[j]; }
        s = wave_sum(s);
        const float mu = s * (1.0f / 1024.0f);
        float q = 0.f;
#pragma unroll
        for (int j = 0; j < 16; ++j) { v[j] -= mu; q += v[j] * v[j]; }
        q = wave_sum(q);
        const float r = rsqrtf(q * (1.0f / 1024.0f) + LN_EPS);
#pragma unroll
        for (int j = 0; j < 16; ++j) { int c = j * 64 + lane; float o = v[j] * r * gam[c] + bet[c]; dst[(size_t)t * D_MODEL + c] = o; dstb[(size_t)t * D_MODEL + c] = (bf16)f2bf(o); }
    }
}

__device__ __forceinline__ void ph_peer_route(float* lds, const float* __restrict__ qh, const float* __restrict__ keys1, const float* __restrict__ keys2,
                                              int* __restrict__ eidx, float* __restrict__ gate) {
    float (*sq)[256] = (float (*)[256])lds;
    float (*sv)[2][16] = (float (*)[2][16])(lds + NWAVE * 256);
    int (*si)[2][16] = (int (*)[2][16])(lds + NWAVE * 256 + NWAVE * 32);
    const int w = threadIdx.x >> 6, lane = threadIdx.x & 63;
    for (int vb = blockIdx.x; vb < T_ALL * 8 / NWAVE; vb += gridDim.x) {
        const int item = vb * NWAVE + w;
        const int t = item >> 3, h = item & 7;
        __syncthreads();
        for (int c = lane; c < 256; c += 64) sq[w][c] = qh[(size_t)t * 2048 + h * 256 + c];
        __syncthreads();
#pragma unroll
        for (int half = 0; half < 2; ++half) {
            const float* keys = half ? keys2 : keys1;
            float s[2];
#pragma unroll
            for (int sl = 0; sl < 2; ++sl) {
                const float* kr = keys + (size_t)(lane + sl * 64) * 128;
                float a = 0.f;
#pragma unroll 8
                for (int c = 0; c < 128; c += 4) { float4 kv = *(const float4*)(kr + c); const float* qq = &sq[w][half * 128 + c]; a += kv.x * qq[0] + kv.y * qq[1] + kv.z * qq[2] + kv.w * qq[3]; }
                s[sl] = a;
            }
            for (int r = 0; r < 16; ++r) {
                float bv; int bi;
                if (s[0] >= s[1]) { bv = s[0]; bi = lane; } else { bv = s[1]; bi = lane + 64; }
#pragma unroll
                for (int o = 32; o > 0; o >>= 1) {
                    float ov = __shfl_xor(bv, o); int oi = __shfl_xor(bi, o);
                    if (ov > bv || (ov == bv && oi < bi)) { bv = ov; bi = oi; }
                }
                if (lane == 0) { sv[w][half][r] = bv; si[w][half][r] = bi; }
                if (bi == lane) s[0] = -INFINITY;
                if (bi == lane + 64) s[1] = -INFINITY;
            }
        }
        __syncthreads();
        float c[4];
#pragma unroll
        for (int j = 0; j < 4; ++j) { int ci = lane * 4 + j; c[j] = sv[w][0][ci >> 4] + sv[w][1][ci & 15]; }
        float myv = 0.f; int myc = 0;
        for (int r = 0; r < 16; ++r) {
            float bv = c[0]; int bi = lane * 4;
#pragma unroll
            for (int j = 1; j < 4; ++j) if (c[j] > bv) { bv = c[j]; bi = lane * 4 + j; }
#pragma unroll
            for (int o = 32; o > 0; o >>= 1) {
                float ov = __shfl_xor(bv, o); int oi = __shfl_xor(bi, o);
                if (ov > bv || (ov == bv && oi < bi)) { bv = ov; bi = oi; }
            }
            if (lane == r) { myv = bv; myc = bi; }
#pragma unroll
            for (int j = 0; j < 4; ++j) if (bi == lane * 4 + j) c[j] = -INFINITY;
        }
        float v = lane < 16 ? myv : -INFINITY;
        float mx = wave_max(v);
        float e = lane < 16 ? __expf(v - mx) : 0.f;
        float sum = wave_sum(e);
        if (lane < 16) {
            int ex = si[w][0][myc >> 4] * PEER_NKEYS + si[w][1][myc & 15];
            eidx[(size_t)t * 128 + h * 16 + lane] = ex;
            gate[(size_t)t * 128 + h * 16 + lane] = e / sum;
        }
    }
}

__device__ __forceinline__ void ph_peer_ffn(const float* __restrict__ hbuf, const int* __restrict__ eidx, const float* __restrict__ gate,
                                            const bf16* __restrict__ ub, const bf16* __restrict__ vb, const float* __restrict__ gam,
                                            const float* __restrict__ bet, float* __restrict__ out) {
    const int lane = threadIdx.x & 63;
    for (int t = blockIdx.x * NWAVE + (threadIdx.x >> 6); t < T_ALL; t += gridDim.x * NWAVE) {
        float x[16], acc[16];
        { const float* xr = hbuf + (size_t)t * D_MODEL + lane * 8;
          const float4 a = *(const float4*)xr, b = *(const float4*)(xr + 4), c = *(const float4*)(xr + 512), d = *(const float4*)(xr + 516);
          x[0] = a.x; x[1] = a.y; x[2] = a.z; x[3] = a.w; x[4] = b.x; x[5] = b.y; x[6] = b.z; x[7] = b.w;
          x[8] = c.x; x[9] = c.y; x[10] = c.z; x[11] = c.w; x[12] = d.x; x[13] = d.y; x[14] = d.z; x[15] = d.w; }
#pragma unroll
        for (int j = 0; j < 16; ++j) acc[j] = 0.f;
        for (int k = 0; k < 128; ++k) {
            const int e = eidx[(size_t)t * 128 + k];
            const float g = gate[(size_t)t * 128 + k];
            const bf16* ur = ub + (size_t)e * D_MODEL + lane * 8;
            float u0[8], u1[8];
            unpack8(*(const v4u*)ur, u0); unpack8(*(const v4u*)(ur + 512), u1);
            float d = 0.f;
#pragma unroll
            for (int j = 0; j < 8; ++j) d += u0[j] * x[j] + u1[j] * x[8 + j];
            d = wave_sum(d);
            const float wgt = g * gelu_f(d);
            const bf16* vr = vb + (size_t)e * D_MODEL + lane * 8;
            unpack8(*(const v4u*)vr, u0); unpack8(*(const v4u*)(vr + 512), u1);
#pragma unroll
            for (int j = 0; j < 8; ++j) { acc[j] += wgt * u0[j]; acc[8 + j] += wgt * u1[j]; }
        }
        float s = 0.f;
#pragma unroll
        for (int j = 0; j < 16; ++j) { acc[j] += ALPHA_F * x[j]; s += acc[j]; }
        s = wave_sum(s);
        const float mu = s * (1.0f / 1024.0f);
        float q = 0.f;
#pragma unroll
        for (int j = 0; j < 16; ++j) { acc[j] -= mu; q += acc[j] * acc[j]; }
        q = wave_sum(q);
        const float r = rsqrtf(q * (1.0f / 1024.0f) + LN_EPS);
        float* dst = ((t < T_PROMPT) ? out + OUT_YP + (size_t)t * D_MODEL : out + OUT_YS + (size_t)(t - T_PROMPT) * D_MODEL) + lane * 8;
#pragma unroll
        for (int q4 = 0; q4 < 4; ++q4) {
            const int eo = (q4 >> 1) * 512 + (q4 & 1) * 4;
            const float4 g4 = *(const float4*)(gam + lane * 8 + eo), b4 = *(const float4*)(bet + lane * 8 + eo);
            float4 o; o.x = acc[q4 * 4 + 0] * r * g4.x + b4.x; o.y = acc[q4 * 4 + 1] * r * g4.y + b4.y; o.z = acc[q4 * 4 + 2] * r * g4.z + b4.z; o.w = acc[q4 * 4 + 3] * r * g4.w + b4.w;
            *(float4*)(dst + eo) = o;
        }
    }
}

__device__ __forceinline__ float peer_dot16(const v4u a, const v4u b, const float (&x)[16]) {
    float u0[8], u1[8]; unpack8(a, u0); unpack8(b, u1);
    float d = 0.f;
#pragma unroll
    for (int j = 0; j < 8; ++j) d += u0[j] * x[j] + u1[j] * x[8 + j];
    return d;
}
#define PEER_TR_STEP(N, M) _Pragma("unroll") for (int i = 0; i < N; ++i) { const bool up = (lane & M) != 0; const float keep = up ? part[i + N] : part[i]; const float send = up ? part[i] : part[i + N]; part[i] = keep + __shfl_xor(send, M); }
__device__ __forceinline__ void ph_peer_ffn2(const float* __restrict__ hbuf, const int* __restrict__ eidx, const float* __restrict__ gate,
                                             const bf16* __restrict__ ub, const bf16* __restrict__ vb, const float* __restrict__ gam,
                                             const float* __restrict__ bet, float* __restrict__ out) {
    const int lane0 = threadIdx.x & 63;
    for (int t = blockIdx.x * NWAVE + (threadIdx.x >> 6); t < T_ALL; t += gridDim.x * NWAVE) {
        int lane = lane0; asm volatile("" : "+v"(lane));
        float x[16];
        { const float* xr = hbuf + (size_t)t * D_MODEL + lane * 8;
          const float4 a = *(const float4*)xr, b = *(const float4*)(xr + 4), c = *(const float4*)(xr + 512), d = *(const float4*)(xr + 516);
          x[0] = a.x; x[1] = a.y; x[2] = a.z; x[3] = a.w; x[4] = b.x; x[5] = b.y; x[6] = b.z; x[7] = b.w;
          x[8] = c.x; x[9] = c.y; x[10] = c.z; x[11] = c.w; x[12] = d.x; x[13] = d.y; x[14] = d.z; x[15] = d.w; }
        int ev[2]; float wv[4];
        ev[0] = eidx[(size_t)t * 128 + lane]; ev[1] = eidx[(size_t)t * 128 + 64 + lane];
#pragma unroll
        for (int rd = 0; rd < 4; ++rd) wv[rd] = gate[(size_t)t * 128 + rd * 32 + (lane >> 1)];
#pragma unroll
        for (int rd = 0; rd < 4; ++rd) {
            float part[32];
#pragma unroll
            for (int kb = 0; kb < 8; ++kb) {
                v4u ra[4], rb[4];
#pragma unroll
                for (int k8 = 0; k8 < 4; ++k8) {
                    const int e = __builtin_amdgcn_readlane(ev[rd >> 1], (rd & 1) * 32 + kb * 4 + k8);
                    const bf16* ur = ub + (size_t)e * D_MODEL + lane * 8;
                    ra[k8] = *(const v4u*)ur; rb[k8] = *(const v4u*)(ur + 512);
                }
#pragma unroll
                for (int k8 = 0; k8 < 4; ++k8) part[kb * 4 + k8] = peer_dot16(ra[k8], rb[k8], x);
            }
            PEER_TR_STEP(16, 32) PEER_TR_STEP(8, 16) PEER_TR_STEP(4, 8) PEER_TR_STEP(2, 4) PEER_TR_STEP(1, 2)
            const float hid = part[0] + __shfl_xor(part[0], 1);
            wv[rd] *= gelu_f(hid);
        }
        float acc[16];
#pragma unroll
        for (int j = 0; j < 16; ++j) acc[j] = 0.f;
#pragma unroll
        for (int rd = 0; rd < 4; ++rd) {
#pragma unroll
            for (int kb = 0; kb < 4; ++kb) {
                v4u ra[8], rb[8];
#pragma unroll
                for (int k8 = 0; k8 < 8; ++k8) {
                    const int e = __builtin_amdgcn_readlane(ev[rd >> 1], (rd & 1) * 32 + kb * 8 + k8);
                    const bf16* vr = vb + (size_t)e * D_MODEL + lane * 8;
                    ra[k8] = *(const v4u*)vr; rb[k8] = *(const v4u*)(vr + 512);
                }
#pragma unroll
                for (int k8 = 0; k8 < 8; ++k8) {
                    const float wk = __builtin_bit_cast(float, __builtin_amdgcn_readlane(__builtin_bit_cast(int, wv[rd]), 2 * (kb * 8 + k8)));
                    float u0[8], u1[8]; unpack8(ra[k8], u0); unpack8(rb[k8], u1);
#pragma unroll
                    for (int j = 0; j < 8; ++j) { acc[j] += wk * u0[j]; acc[8 + j] += wk * u1[j]; }
                }
            }
        }
        float s = 0.f;
#pragma unroll
        for (int j = 0; j < 16; ++j) { acc[j] += ALPHA_F * x[j]; s += acc[j]; }
        s = wave_sum(s);
        const float mu = s * (1.0f / 1024.0f);
        float q = 0.f;
#pragma unroll
        for (int j = 0; j < 16; ++j) { acc[j] -= mu; q += acc[j] * acc[j]; }
        q = wave_sum(q);
        const float r = rsqrtf(q * (1.0f / 1024.0f) + LN_EPS);
        float* dst = ((t < T_PROMPT) ? out + OUT_YP + (size_t)t * D_MODEL : out + OUT_YS + (size_t)(t - T_PROMPT) * D_MODEL) + lane * 8;
#pragma unroll
        for (int q4 = 0; q4 < 4; ++q4) {
            const int eo = (q4 >> 1) * 512 + (q4 & 1) * 4;
            const float4 g4 = *(const float4*)(gam + lane * 8 + eo), b4 = *(const float4*)(bet + lane * 8 + eo);
            float4 o; o.x = acc[q4 * 4 + 0] * r * g4.x + b4.x; o.y = acc[q4 * 4 + 1] * r * g4.y + b4.y; o.z = acc[q4 * 4 + 2] * r * g4.z + b4.z; o.w = acc[q4 * 4 + 3] * r * g4.w + b4.w;
            *(float4*)(dst + eo) = o;
        }
    }
}

typedef float f32x16 __attribute__((ext_vector_type(16)));
typedef short s16x8 __attribute__((ext_vector_type(8)));
typedef short s16x4 __attribute__((ext_vector_type(4)));
typedef float f32x4v __attribute__((ext_vector_type(4)));
#define SSD_L_ACS 0
#define SSD_L_DTS 3072
#define SSD_L_BM 6144
#define SSD_RS_B 272
#define SSD_L_X (6144 + 128 * 272)
#define SSD_RS_X 144
#define SSD_XIMG (128 * 144)
#define SSD_RS_Y 784
template <int OFF0, int OFF1>
__device__ __forceinline__ s16x8 tr_frag(unsigned base) {
    s16x4 a, b;
    asm volatile("ds_read_b64_tr_b16 %0, %2 offset:%3\n\tds_read_b64_tr_b16 %1, %2 offset:%4\n\ts_waitcnt lgkmcnt(0)"
                 : "=&v"(a), "=&v"(b) : "v"(base), "n"(OFF0), "n"(OFF1) : "memory");
    return __builtin_shufflevector(a, b, 0, 1, 2, 3, 4, 5, 6, 7);
}
__device__ __forceinline__ unsigned lds_addr(LAS unsigned char* p) { return (unsigned)(size_t)p; }

__device__ __forceinline__ void ssd_chunk_acs(LAS unsigned char* ldsb, const float* __restrict__ dtv, const float* __restrict__ a_log, int t0, int g, float* cdec_out) {
    const int w = __builtin_amdgcn_readfirstlane(threadIdx.x >> 6), lane = threadIdx.x & 63;
    if (w < 6) {
        const int head = 6 * g + w;
        const float A = -__expf(a_log[head]);
        const float v0 = dtv[(size_t)(t0 + 2 * lane) * SSD_HEADS + head], v1 = dtv[(size_t)(t0 + 2 * lane + 1) * SSD_HEADS + head];
        const float a1 = v1 * A;
        float s = v0 * A + a1;
#pragma unroll
        for (int o = 1; o < 64; o <<= 1) { const float tmp = __shfl_up(s, o); if (lane >= o) s += tmp; }
        LAS float* acs = (LAS float*)(ldsb + SSD_L_ACS) + w * 128;
        LAS float* dts = (LAS float*)(ldsb + SSD_L_DTS) + w * 128;
        acs[2 * lane] = s - a1; acs[2 * lane + 1] = s;
        dts[2 * lane] = v0; dts[2 * lane + 1] = v1;
        if (cdec_out && lane == 63) cdec_out[head] = __expf(s);
    }
}

__device__ __forceinline__ void ph_ssd_states(LAS unsigned char* ldsb, const bf16* __restrict__ xbc_b, const float* __restrict__ dtv, const float* __restrict__ a_log,
                                              bf16* __restrict__ Sbuf, float* __restrict__ cdec) {
    const int tid = threadIdx.x, w = __builtin_amdgcn_readfirstlane(tid >> 6), lane = tid & 63;
    const int r = lane & 31, h = lane >> 5, blk = (lane >> 4) & 1, q = (lane & 15) >> 2, pp = lane & 3;
    const int nt = w & 3, pt = w >> 2;
    for (int unit = blockIdx.x; unit < BATCH * 64 * SSD_GROUPS; unit += gridDim.x) {
        const int g = unit & 3, bc = unit >> 2;
        const int t0 = bc * 128;
        __syncthreads();
        ssd_chunk_acs(ldsb, dtv, a_log, t0, g, cdec + (size_t)bc * SSD_HEADS);
        for (int idx = tid; idx < 2048; idx += NTHR) { const int row = idx >> 4, ch = idx & 15;
            const v4u v = *(const v4u*)(xbc_b + (size_t)(t0 + row) * CONV_DIM + 1536 + 128 * g + ch * 8);
            *(LAS v4u*)(ldsb + SSD_L_BM + row * SSD_RS_B + ch * 16) = v; }
        __syncthreads();
        for (int idx = tid; idx < 6144; idx += NTHR) { const int hh = idx >> 10, rem = idx & 1023, row = rem >> 3, ch = rem & 7;
            const LAS float* acs = (const LAS float*)(ldsb + SSD_L_ACS) + hh * 128; const LAS float* dts = (const LAS float*)(ldsb + SSD_L_DTS) + hh * 128;
            const float wgt = dts[row] * __expf(acs[127] - acs[row]);
            float f[8]; unpack8(*(const v4u*)(xbc_b + (size_t)(t0 + row) * CONV_DIM + (6 * g + hh) * 64 + ch * 8), f);
            v4u o; o.x = pk2(f[0] * wgt, f[1] * wgt); o.y = pk2(f[2] * wgt, f[3] * wgt); o.z = pk2(f[4] * wgt, f[5] * wgt); o.w = pk2(f[6] * wgt, f[7] * wgt);
            *(LAS v4u*)(ldsb + SSD_L_X + hh * SSD_XIMG + row * SSD_RS_X + ch * 16) = o; }
        __syncthreads();
        const unsigned abase = lds_addr(ldsb + SSD_L_BM) + (8 * h + q) * SSD_RS_B + (32 * nt + 16 * blk + 4 * pp) * 2;
        s16x8 afr[8];
        afr[0] = tr_frag<0 * 16 * SSD_RS_B, (0 * 16 + 4) * SSD_RS_B>(abase); afr[1] = tr_frag<1 * 16 * SSD_RS_B, (1 * 16 + 4) * SSD_RS_B>(abase);
        afr[2] = tr_frag<2 * 16 * SSD_RS_B, (2 * 16 + 4) * SSD_RS_B>(abase); afr[3] = tr_frag<3 * 16 * SSD_RS_B, (3 * 16 + 4) * SSD_RS_B>(abase);
        afr[4] = tr_frag<4 * 16 * SSD_RS_B, (4 * 16 + 4) * SSD_RS_B>(abase); afr[5] = tr_frag<5 * 16 * SSD_RS_B, (5 * 16 + 4) * SSD_RS_B>(abase);
        afr[6] = tr_frag<6 * 16 * SSD_RS_B, (6 * 16 + 4) * SSD_RS_B>(abase); afr[7] = tr_frag<7 * 16 * SSD_RS_B, (7 * 16 + 4) * SSD_RS_B>(abase);
#pragma unroll
        for (int hh = 0; hh < 6; ++hh) {
            const unsigned xb = lds_addr(ldsb + SSD_L_X + hh * SSD_XIMG) + (8 * h + q) * SSD_RS_X + (32 * pt + 16 * blk + 4 * pp) * 2;
            f32x16 acc;
#pragma unroll
            for (int i = 0; i < 16; ++i) acc[i] = 0.f;
            acc = __builtin_amdgcn_mfma_f32_32x32x16_bf16(afr[0], tr_frag<0 * 16 * SSD_RS_X, (0 * 16 + 4) * SSD_RS_X>(xb), acc, 0, 0, 0);
            acc = __builtin_amdgcn_mfma_f32_32x32x16_bf16(afr[1], tr_frag<1 * 16 * SSD_RS_X, (1 * 16 + 4) * SSD_RS_X>(xb), acc, 0, 0, 0);
            acc = __builtin_amdgcn_mfma_f32_32x32x16_bf16(afr[2], tr_frag<2 * 16 * SSD_RS_X, (2 * 16 + 4) * SSD_RS_X>(xb), acc, 0, 0, 0);
            acc = __builtin_amdgcn_mfma_f32_32x32x16_bf16(afr[3], tr_frag<3 * 16 * SSD_RS_X, (3 * 16 + 4) * SSD_RS_X>(xb), acc, 0, 0, 0);
            acc = __builtin_amdgcn_mfma_f32_32x32x16_bf16(afr[4], tr_frag<4 * 16 * SSD_RS_X, (4 * 16 + 4) * SSD_RS_X>(xb), acc, 0, 0, 0);
            acc = __builtin_amdgcn_mfma_f32_32x32x16_bf16(afr[5], tr_frag<5 * 16 * SSD_RS_X, (5 * 16 + 4) * SSD_RS_X>(xb), acc, 0, 0, 0);
            acc = __builtin_amdgcn_mfma_f32_32x32x16_bf16(afr[6], tr_frag<6 * 16 * SSD_RS_X, (6 * 16 + 4) * SSD_RS_X>(xb), acc, 0, 0, 0);
            acc = __builtin_amdgcn_mfma_f32_32x32x16_bf16(afr[7], tr_frag<7 * 16 * SSD_RS_X, (7 * 16 + 4) * SSD_RS_X>(xb), acc, 0, 0, 0);
            bf16* dst = Sbuf + (((size_t)bc * SSD_HEADS + 6 * g + hh) * 64 + 32 * pt + r) * 128 + 32 * nt + 4 * h;
#pragma unroll
            for (int q4 = 0; q4 < 4; ++q4) *(uint2*)(dst + 8 * q4) = make_uint2(pk2(acc[4 * q4], acc[4 * q4 + 1]), pk2(acc[4 * q4 + 2], acc[4 * q4 + 3]));
        }
    }
}

__device__ __forceinline__ void ph_ssd_scan(const bf16* __restrict__ Sbuf, const float* __restrict__ cdec, bf16* __restrict__ Hin, float* __restrict__ out) {
    for (int idx = blockIdx.x * NTHR + threadIdx.x; idx < BATCH * SSD_HEADS * 64 * 16; idx += gridDim.x * NTHR) {
        const int n8 = idx & 15, p = (idx >> 4) & 63, hb = idx >> 10, hd = hb % SSD_HEADS, b = hb / SSD_HEADS;
        float st[8];
#pragma unroll
        for (int j = 0; j < 8; ++j) st[j] = 0.f;
#pragma unroll 8
        for (int c = 0; c < 64; ++c) {
            const size_t base = ((((size_t)(b * 64 + c)) * SSD_HEADS + hd) * 64 + p) * 128 + n8 * 8;
            v4u o; o.x = pk2(st[0], st[1]); o.y = pk2(st[2], st[3]); o.z = pk2(st[4], st[5]); o.w = pk2(st[6], st[7]);
            *(v4u*)(Hin + base) = o;
            float s[8]; unpack8(*(const v4u*)(Sbuf + base), s);
            const float a = cdec[(size_t)(b * 64 + c) * SSD_HEADS + hd];
#pragma unroll
            for (int j = 0; j < 8; ++j) st[j] = a * st[j] + s[j];
        }
        store8f(out + OUT_PS + (((size_t)b * SSD_HEADS + hd) * 64 + p) * 128 + n8 * 8, st);
    }
}

__device__ __forceinline__ void ph_ssd_out(LAS unsigned char* ldsb, const bf16* __restrict__ xbc_b, const bf16* __restrict__ projb, const float* __restrict__ dtv,
                                           const float* __restrict__ a_log, const float* __restrict__ d_skip, const float* __restrict__ norm_g,
                                           const bf16* __restrict__ Hin, bf16* __restrict__ A1) {
    const int tid = threadIdx.x, w = __builtin_amdgcn_readfirstlane(tid >> 6), lane = tid & 63;
    const int r = lane & 31, h = lane >> 5, blk = (lane >> 4) & 1, q = (lane & 15) >> 2, pp = lane & 3;
    const int lt = w & 3, hs = w >> 2;
    for (int unit = blockIdx.x; unit < BATCH * 64 * SSD_GROUPS; unit += gridDim.x) {
        const int g = unit & 3, bc = unit >> 2;
        const int t0 = bc * 128;
        __syncthreads();
        ssd_chunk_acs(ldsb, dtv, a_log, t0, g, nullptr);
        for (int idx = tid; idx < 2048; idx += NTHR) { const int row = idx >> 4, ch = idx & 15;
            const v4u v = *(const v4u*)(xbc_b + (size_t)(t0 + row) * CONV_DIM + 1536 + 128 * g + ch * 8);
            *(LAS v4u*)(ldsb + SSD_L_BM + row * SSD_RS_B + ch * 16) = v; }
        for (int idx = tid; idx < 6144; idx += NTHR) { const int hh = idx >> 10, rem = idx & 1023, row = rem >> 3, ch = rem & 7;
            const v4u v = *(const v4u*)(xbc_b + (size_t)(t0 + row) * CONV_DIM + (6 * g + hh) * 64 + ch * 8);
            *(LAS v4u*)(ldsb + SSD_L_X + hh * SSD_XIMG + row * SSD_RS_X + ch * 16) = v; }
        __syncthreads();
        const bf16* cp = xbc_b + (size_t)(t0 + 32 * lt + r) * CONV_DIM + 2048 + 128 * g + 8 * h;
        const int lcol = 32 * lt + r;
        const LAS float* acsb = (const LAS float*)(ldsb + SSD_L_ACS) + 3 * hs * 128; const LAS float* dtsb = (const LAS float*)(ldsb + SSD_L_DTS) + 3 * hs * 128;
        f32x16 y[3][2];
#pragma unroll
        for (int h3 = 0; h3 < 3; ++h3)
#pragma unroll
            for (int i = 0; i < 16; ++i) { y[h3][0][i] = 0.f; y[h3][1][i] = 0.f; }
#pragma unroll 1
        for (int ks = 0; ks < 8; ++ks) {
            const s16x8 cf = *(const s16x8*)(cp + 16 * ks);
#pragma unroll
            for (int h3 = 0; h3 < 3; ++h3) {
                const bf16* hp = Hin + (((size_t)bc * SSD_HEADS + 6 * g + 3 * hs + h3) * 64 + r) * 128 + 8 * h + 16 * ks;
                const s16x8 h0 = *(const s16x8*)hp, h1 = *(const s16x8*)(hp + 32 * 128);
                y[h3][0] = __builtin_amdgcn_mfma_f32_32x32x16_bf16(cf, h0, y[h3][0], 0, 0, 0);
                y[h3][1] = __builtin_amdgcn_mfma_f32_32x32x16_bf16(cf, h1, y[h3][1], 0, 0, 0);
            }
        }
#pragma unroll
        for (int h3 = 0; h3 < 3; ++h3)
#pragma unroll
            for (int q4 = 0; q4 < 4; ++q4) {
                const f32x4v a4 = *(const LAS f32x4v*)(acsb + h3 * 128 + 32 * lt + 8 * q4 + 4 * h);
                const float e0 = __expf(a4[0]), e1 = __expf(a4[1]), e2 = __expf(a4[2]), e3 = __expf(a4[3]);
                y[h3][0][4 * q4] *= e0; y[h3][0][4 * q4 + 1] *= e1; y[h3][0][4 * q4 + 2] *= e2; y[h3][0][4 * q4 + 3] *= e3;
                y[h3][1][4 * q4] *= e0; y[h3][1][4 * q4 + 1] *= e1; y[h3][1][4 * q4 + 2] *= e2; y[h3][1][4 * q4 + 3] *= e3;
            }
        const unsigned xb0 = lds_addr(ldsb + SSD_L_X + 3 * hs * SSD_XIMG) + (4 * h + q) * SSD_RS_X + (16 * blk + 4 * pp) * 2;
        for (int st = 0; st <= lt; ++st) {
            f32x16 cb;
#pragma unroll
            for (int i = 0; i < 16; ++i) cb[i] = 0.f;
#pragma unroll 2
            for (int ks = 0; ks < 8; ++ks) {
                const s16x8 cf = *(const s16x8*)(cp + 16 * ks);
                const s16x8 bfrag = *(const LAS s16x8*)(ldsb + SSD_L_BM + (32 * st + r) * SSD_RS_B + (16 * ks + 8 * h) * 2);
                cb = __builtin_amdgcn_mfma_f32_32x32x16_bf16(bfrag, cf, cb, 0, 0, 0);
            }
#pragma unroll
            for (int h3 = 0; h3 < 3; ++h3) {
                const LAS float* acs = acsb + h3 * 128; const LAS float* dts = dtsb + h3 * 128;
                const float myacs = acs[lcol];
                const float Dh = d_skip[6 * g + 3 * hs + h3];
                const unsigned xb = xb0 + h3 * SSD_XIMG + st * 32 * SSD_RS_X;
#pragma unroll
                for (int kk = 0; kk < 2; ++kk) {
                    const int s0 = 32 * st + 16 * kk + 4 * h;
                    const f32x4v as0 = *(const LAS f32x4v*)(acs + s0), as1 = *(const LAS f32x4v*)(acs + s0 + 8);
                    const f32x4v ds0 = *(const LAS f32x4v*)(dts + s0), ds1 = *(const LAS f32x4v*)(dts + s0 + 8);
                    float wv[8];
#pragma unroll
                    for (int j = 0; j < 8; ++j) {
                        const int s = s0 + 8 * (j >> 2) + (j & 3);
                        const float asj = (j < 4) ? as0[j & 3] : as1[j & 3], dsj = (j < 4) ? ds0[j & 3] : ds1[j & 3];
                        float v = cb[8 * kk + j] * __expf(myacs - asj) * dsj;
                        v = (s <= lcol) ? v : 0.f;
                        v = (s == lcol) ? v + Dh : v;
                        wv[j] = v;
                    }
                    s16x8 afr;
                    { v4u o; o.x = pk2(wv[0], wv[1]); o.y = pk2(wv[2], wv[3]); o.z = pk2(wv[4], wv[5]); o.w = pk2(wv[6], wv[7]); afr = __builtin_bit_cast(s16x8, o); }
                    s16x8 b0, b1;
                    if (kk == 0) { b0 = tr_frag<0, 8 * SSD_RS_X>(xb); b1 = tr_frag<64, 8 * SSD_RS_X + 64>(xb); }
                    else { b0 = tr_frag<16 * SSD_RS_X, 24 * SSD_RS_X>(xb); b1 = tr_frag<16 * SSD_RS_X + 64, 24 * SSD_RS_X + 64>(xb); }
                    y[h3][0] = __builtin_amdgcn_mfma_f32_32x32x16_bf16(afr, b0, y[h3][0], 0, 0, 0);
                    y[h3][1] = __builtin_amdgcn_mfma_f32_32x32x16_bf16(afr, b1, y[h3][1], 0, 0, 0);
                    __builtin_amdgcn_sched_barrier(0);
                }
            }
        }
        __syncthreads();
        {
            LAS unsigned short* yst = (LAS unsigned short*)(ldsb + SSD_L_X);
#pragma unroll
            for (int h3 = 0; h3 < 3; ++h3)
#pragma unroll
                for (int ptile = 0; ptile < 2; ++ptile)
#pragma unroll
                    for (int reg = 0; reg < 16; ++reg) {
                        const int l0 = 32 * lt + (reg & 3) + 8 * (reg >> 2) + 4 * h;
                        const int col = (3 * hs + h3) * 64 + 32 * ptile + r;
                        yst[l0 * (SSD_RS_Y / 2) + col] = (unsigned short)f2bf(y[h3][ptile][reg]);
                    }
        }
        __syncthreads();
#pragma unroll
        for (int pass = 0; pass < 4; ++pass) {
            const int l = 4 * (pass * 8 + w) + (lane >> 4), i16 = lane & 15;
            float gv[3][8]; float ss = 0.f;
#pragma unroll
            for (int k = 0; k < 3; ++k) {
                const int col0 = 24 * i16 + 8 * k;
                float yv[8], zv[8];
                unpack8(*(const LAS v4u*)(ldsb + SSD_L_X + l * SSD_RS_Y + col0 * 2), yv);
                unpack8(*(const v4u*)(projb + (size_t)(t0 + l) * NB_LD + g * 384 + col0), zv);
#pragma unroll
                for (int j = 0; j < 8; ++j) { const float gg = yv[j] * silu_f(zv[j]); gv[k][j] = gg; ss += gg * gg; }
            }
            ss += __shfl_xor(ss, 1); ss += __shfl_xor(ss, 2); ss += __shfl_xor(ss, 4); ss += __shfl_xor(ss, 8);
            const float rstd = rsqrtf(ss * (1.0f / 384.0f) + LN_EPS);
#pragma unroll
            for (int k = 0; k < 3; ++k) {
                const int col0 = g * 384 + 24 * i16 + 8 * k;
                const float4 g0 = *(const float4*)(norm_g + col0), g1 = *(const float4*)(norm_g + col0 + 4);
                v4u o; o.x = pk2(gv[k][0] * rstd * g0.x, gv[k][1] * rstd * g0.y); o.y = pk2(gv[k][2] * rstd * g0.z, gv[k][3] * rstd * g0.w);
                o.z = pk2(gv[k][4] * rstd * g1.x, gv[k][5] * rstd * g1.y); o.w = pk2(gv[k][6] * rstd * g1.z, gv[k][7] * rstd * g1.w);
                *(v4u*)(A1 + (size_t)(t0 + l) * MIX_WIDTH + col0) = o;
            }
        }
    }
}

#define ATT_RS_V 144
#define ATT_VIMG (256 * ATT_RS_V)
#define ATT_PV(KT, S2) { \
        v4u o_; o_.x = pk2(s[KT][8 * S2 + 0], s[KT][8 * S2 + 1]); o_.y = pk2(s[KT][8 * S2 + 2], s[KT][8 * S2 + 3]); \
        o_.z = pk2(s[KT][8 * S2 + 4], s[KT][8 * S2 + 5]); o_.w = pk2(s[KT][8 * S2 + 6], s[KT][8 * S2 + 7]); \
        const s16x8 pf_ = __builtin_bit_cast(s16x8, o_); \
        const s16x8 a0_ = tr_frag<(32 * KT + 16 * S2) * ATT_RS_V, (32 * KT + 16 * S2 + 8) * ATT_RS_V>(vbase); \
        const s16x8 a1_ = tr_frag<(32 * KT + 16 * S2) * ATT_RS_V + 64, (32 * KT + 16 * S2 + 8) * ATT_RS_V + 64>(vbase); \
        o0 = __builtin_amdgcn_mfma_f32_32x32x16_bf16(a0_, pf_, o0, 0, 0, 0); \
        o1 = __builtin_amdgcn_mfma_f32_32x32x16_bf16(a1_, pf_, o1, 0, 0, 0); }
__device__ __forceinline__ void ph_attn_prompt(LAS unsigned char* ldsb, const bf16* __restrict__ qrot_b, const bf16* __restrict__ krot_b, const bf16* __restrict__ projb,
                                               bf16* __restrict__ obuf, float* __restrict__ lsebuf) {
    const int tid = threadIdx.x, w = __builtin_amdgcn_readfirstlane(tid >> 6), lane = tid & 63;
    const int r = lane & 31, h = lane >> 5, blk = (lane >> 4) & 1, q = (lane & 15) >> 2, pp = lane & 3;
    const int qt = w & 3, hsel = w >> 2;
    for (int unit = blockIdx.x; unit < 3 * 512; unit += gridDim.x) {
        const int pat = unit >> 9, rem = unit & 511, hp = rem & 3, rem2 = rem >> 2, b = rem2 >> 6, bk = rem2 & 63;
        const int dsh = 2 * pat, nper = 64 >> dsh, res = bk >> (6 - dsh), nb = bk & (nper - 1);
        const int head = 2 * hp + hsel;
        __syncthreads();
        for (int idx = tid & 255; idx < 2048; idx += 256) {
            const int row = idx >> 3, ch = idx & 7, js = 128 * nb - 128 + row;
            v4u v; v.x = 0u; v.y = 0u; v.z = 0u; v.w = 0u;
            if (js >= 0) v = *(const v4u*)(projb + (size_t)(b * SEQ + (js << dsh) + res) * NB_LD + NB_V + head * 64 + ch * 8);
            *(LAS v4u*)(ldsb + hsel * ATT_VIMG + row * ATT_RS_V + ch * 16) = v;
        }
        const int tq = b * SEQ + ((128 * nb + 32 * qt + r) << dsh) + res;
        s16x8 qf[4];
#pragma unroll
        for (int ks = 0; ks < 4; ++ks) qf[ks] = *(const s16x8*)(qrot_b + (size_t)tq * ATT_WIDTH + head * 64 + 16 * ks + 8 * h);
        f32x16 s[5];
#pragma unroll
        for (int kt = 0; kt < 5; ++kt) {
            int js = 128 * nb + 32 * qt - 128 + 32 * kt + r; js = js < 0 ? 0 : js;
            const bf16* kp = krot_b + (size_t)(b * SEQ + (js << dsh) + res) * ATT_WIDTH + head * 64 + 8 * h;
#pragma unroll
            for (int i = 0; i < 16; ++i) s[kt][i] = 0.f;
#pragma unroll
            for (int ks = 0; ks < 4; ++ks) s[kt] = __builtin_amdgcn_mfma_f32_32x32x16_bf16(*(const s16x8*)(kp + 16 * ks), qf[ks], s[kt], 0, 0, 0);
        }
        float m = -INFINITY;
#pragma unroll
        for (int kt = 0; kt < 5; ++kt) {
            const bool tile_ok = (nb > 0) || (qt + kt >= 4);
#pragma unroll
            for (int reg = 0; reg < 16; ++reg) {
                const int c = (reg & 3) + 8 * (reg >> 2) + 4 * h;
                const bool ok = tile_ok && (kt == 0 ? (c >= r) : (kt == 4 ? (c <= r) : true));
                const float v = ok ? s[kt][reg] * 0.125f : -INFINITY;
                s[kt][reg] = v; m = fmaxf(m, v);
            }
        }
        m = fmaxf(m, __shfl_xor(m, 32));
        float l = 0.f;
#pragma unroll
        for (int kt = 0; kt < 5; ++kt)
#pragma unroll
            for (int reg = 0; reg < 16; ++reg) { const float p = __expf(s[kt][reg] - m); s[kt][reg] = p; l += p; }
        l += __shfl_xor(l, 32);
        __syncthreads();
        f32x16 o0, o1;
#pragma unroll
        for (int i = 0; i < 16; ++i) { o0[i] = 0.f; o1[i] = 0.f; }
        const unsigned vbase = lds_addr(ldsb + hsel * ATT_VIMG) + (32 * qt + 4 * h + q) * ATT_RS_V + (16 * blk + 4 * pp) * 2;
        ATT_PV(0, 0) ATT_PV(0, 1) ATT_PV(1, 0) ATT_PV(1, 1) ATT_PV(2, 0) ATT_PV(2, 1) ATT_PV(3, 0) ATT_PV(3, 1) ATT_PV(4, 0) ATT_PV(4, 1)
        const float inv = 1.0f / l;
        bf16* op = obuf + ((size_t)pat * T_PROMPT + tq) * ATT_WIDTH + head * 64 + 4 * h;
#pragma unroll
        for (int q4 = 0; q4 < 4; ++q4) {
            *(uint2*)(op + 8 * q4) = make_uint2(pk2(o0[4 * q4] * inv, o0[4 * q4 + 1] * inv), pk2(o0[4 * q4 + 2] * inv, o0[4 * q4 + 3] * inv));
            *(uint2*)(op + 32 + 8 * q4) = make_uint2(pk2(o1[4 * q4] * inv, o1[4 * q4 + 1] * inv), pk2(o1[4 * q4 + 2] * inv, o1[4 * q4 + 3] * inv));
        }
        if (h == 0) lsebuf[((size_t)pat * T_PROMPT + tq) * 8 + head] = m + __logf(l);
    }
}
__device__ __forceinline__ void ph_attn_combine(const bf16* __restrict__ obuf, const float* __restrict__ lsebuf, bf16* __restrict__ A1) {
    const int lane = threadIdx.x & 63;
    for (int t = blockIdx.x * NWAVE + (threadIdx.x >> 6); t < T_PROMPT; t += gridDim.x * NWAVE) {
        const int hd = lane >> 3;
        const float l0 = lsebuf[((size_t)0 * T_PROMPT + t) * 8 + hd], l1 = lsebuf[((size_t)1 * T_PROMPT + t) * 8 + hd], l2 = lsebuf[((size_t)2 * T_PROMPT + t) * 8 + hd];
        const float mx = fmaxf(l0, fmaxf(l1, l2));
        const float e0 = __expf(l0 - mx), e1 = __expf(l1 - mx), e2 = __expf(l2 - mx);
        const float inv = 1.0f / (e0 + e1 + e2);
        float a[8], b[8], c[8];
        unpack8(*(const v4u*)(obuf + ((size_t)0 * T_PROMPT + t) * ATT_WIDTH + lane * 8), a);
        unpack8(*(const v4u*)(obuf + ((size_t)1 * T_PROMPT + t) * ATT_WIDTH + lane * 8), b);
        unpack8(*(const v4u*)(obuf + ((size_t)2 * T_PROMPT + t) * ATT_WIDTH + lane * 8), c);
        float o[8];
#pragma unroll
        for (int j = 0; j < 8; ++j) o[j] = (e0 * a[j] + e1 * b[j] + e2 * c[j]) * inv;
        v4u w; w.x = pk2(o[0], o[1]); w.y = pk2(o[2], o[3]); w.z = pk2(o[4], o[5]); w.w = pk2(o[6], o[7]);
        *(v4u*)(A1 + (size_t)t * MIX_WIDTH + SSD_WIDTH + lane * 8) = w;
    }
}

struct Params {
    const float* in[23];
    float* out;
    unsigned char* ws;
    unsigned* bar;
};

#define WS_BAR      0ull
#define WS_XALL     (1ull << 20)
#define WS_PROJ     (WS_XALL + (size_t)T_ALL * D_MODEL * 4)
#define WS_XBC      (WS_PROJ + (size_t)T_ALL * PROJ_LD * 4)
#define WS_DT       (WS_XBC + (size_t)T_ALL * CONV_DIM * 4)
#define WS_QROT     (WS_DT + (size_t)T_ALL * SSD_HEADS * 4)
#define WS_KROT     (WS_QROT + (size_t)T_ALL * ATT_WIDTH * 4)
#define WS_YBUF     (WS_KROT + (size_t)T_ALL * ATT_WIDTH * 4)
#define WS_MIX      (WS_YBUF + (size_t)T_ALL * MIX_WIDTH * 4)
#define WS_HBUF     (WS_MIX + (size_t)T_ALL * D_MODEL * 4)
#define WS_QH       (WS_HBUF + (size_t)T_ALL * D_MODEL * 4)
#define WS_EIDX     (WS_QH + (size_t)T_ALL * 2048 * 4)
#define WS_GATE     (WS_EIDX + (size_t)T_ALL * 128 * 4)
#define WS_A0       (WS_GATE + (size_t)T_ALL * 128 * 4)
#define WS_A1       (WS_A0 + (size_t)T_ALL * D_MODEL * 2)
#define WS_A2       (WS_A1 + (size_t)T_ALL * MIX_WIDTH * 2)
#define WS_WTIN     (WS_A2 + (size_t)T_ALL * D_MODEL * 2)
#define WS_WTOUT    (WS_WTIN + (size_t)PROJ_LD * D_MODEL * 2)
#define WS_WTQ      (WS_WTOUT + (size_t)D_MODEL * MIX_WIDTH * 2)
#define WS_PROJB    (WS_WTQ + (size_t)2048 * D_MODEL * 2)
#define WS_DTRAW    (WS_PROJB + (size_t)T_ALL * NB_LD * 2)
#define WS_XBCB     (WS_DTRAW + (size_t)T_ALL * 32 * 4)
#define WS_QROTB    (WS_XBCB + (size_t)T_ALL * CONV_DIM * 2)
#define WS_KROTB    (WS_QROTB + (size_t)T_ALL * ATT_WIDTH * 2)
#define WS_UB       (WS_KROTB + (size_t)T_ALL * ATT_WIDTH * 2)
#define WS_VB       (WS_UB + (size_t)16384 * D_MODEL * 2)
#define WS_SBUF     (WS_VB + (size_t)16384 * D_MODEL * 2)
#define WS_HIN      (WS_SBUF + (size_t)BATCH * 64 * SSD_HEADS * 64 * 128 * 2)
#define WS_CDEC     (WS_HIN + (size_t)BATCH * 64 * SSD_HEADS * 64 * 128 * 2)
#define WS_OBUF     (WS_CDEC + (size_t)BATCH * 64 * SSD_HEADS * 4)
#define WS_LSE      (WS_OBUF + (size_t)3 * T_PROMPT * ATT_WIDTH * 2)
#define WS_END      (WS_LSE + (size_t)3 * T_PROMPT * 8 * 4)

#define LDS_BYTES (160 * 1024)

__global__ void __launch_bounds__(512, 2) mega_fwd(Params p) {
    extern __shared__ __attribute__((aligned(16))) unsigned char smem[];
    if (threadIdx.x == 0) *(uint4*)smem = make_uint4(0u, 0u, 0u, 0u);
    __syncthreads();
    XcdBarrier bar = xcd_barrier_post(p.bar, (volatile LAS unsigned*)smem);
    float* lds = (float*)(smem + 256);

    const float* x_prompt = p.in[0]; const float* x_sample = p.in[1]; const float* cache_k = p.in[2]; const float* cache_v = p.in[3];
    const float* state_conv = p.in[4]; const float* state_ssm = p.in[5]; const float* w_in = p.in[6]; const float* conv_w = p.in[7];
    const float* conv_b = p.in[8]; const float* dt_bias = p.in[9]; const float* a_log = p.in[10]; const float* d_skip = p.in[11];
    const float* norm_g = p.in[12]; const float* w_out = p.in[13]; const float* ln1_g = p.in[14]; const float* ln1_b = p.in[15];
    const float* peer_wq = p.in[16]; const float* keys1 = p.in[17]; const float* keys2 = p.in[18]; const float* peer_u = p.in[19];
    const float* peer_v = p.in[20]; const float* ln2_g = p.in[21]; const float* ln2_b = p.in[22];
    float* out = p.out;
    float* xall = (float*)(p.ws + WS_XALL); float* proj = (float*)(p.ws + WS_PROJ); float* xbc_act = (float*)(p.ws + WS_XBC);
    float* dtv = (float*)(p.ws + WS_DT); float* qrot = (float*)(p.ws + WS_QROT); float* krot = (float*)(p.ws + WS_KROT);
    float* ybuf = (float*)(p.ws + WS_YBUF); float* mix = (float*)(p.ws + WS_MIX); float* hbuf = (float*)(p.ws + WS_HBUF);
    float* qh = (float*)(p.ws + WS_QH); int* eidx = (int*)(p.ws + WS_EIDX); float* gate = (float*)(p.ws + WS_GATE);
    bf16* A0 = (bf16*)(p.ws + WS_A0); bf16* A1 = (bf16*)(p.ws + WS_A1); bf16* A2 = (bf16*)(p.ws + WS_A2);
    bf16* wt_in = (bf16*)(p.ws + WS_WTIN); bf16* wt_out = (bf16*)(p.ws + WS_WTOUT); bf16* wt_q = (bf16*)(p.ws + WS_WTQ);
    bf16* projb = (bf16*)(p.ws + WS_PROJB); float* dtraw = (float*)(p.ws + WS_DTRAW); bf16* xbc_b = (bf16*)(p.ws + WS_XBCB);
    bf16* qrot_b = (bf16*)(p.ws + WS_QROTB); bf16* krot_b = (bf16*)(p.ws + WS_KROTB); bf16* ub = (bf16*)(p.ws + WS_UB); bf16* vb = (bf16*)(p.ws + WS_VB);
    bf16* Sbuf = (bf16*)(p.ws + WS_SBUF); bf16* Hin = (bf16*)(p.ws + WS_HIN); float* cdec = (float*)(p.ws + WS_CDEC);
    bf16* obuf = (bf16*)(p.ws + WS_OBUF); float* lsebuf = (float*)(p.ws + WS_LSE);
    LAS unsigned char* ldsb = (LAS unsigned char*)smem + 256;

    ph_concat_x(x_prompt, x_sample, xall);
    ph_prologue(ldsb, x_prompt, x_sample, A0, w_in, wt_in, w_out, wt_out, peer_wq, wt_q, peer_u, peer_v, ub, vb);
    ph_cache_copy(cache_k, cache_v, out);
    xcd_barrier(bar);
    { pg8::Gemm g{A0, wt_in, T_ALL, PROJ_LD, D_MODEL}; pg8::StaticOrder S; S.init(g.M, g.N, (int)gridDim.x, (int)blockIdx.x);
      pg8::EpiProj E{projb, dtraw}; pg8::gemm_phase<pg8::EpiProj, pg8::StaticOrder, false>(ldsb, g, S, E, nullptr); }
    xcd_barrier(bar);
    ph_post_proj2(projb, dtraw, state_conv, conv_w, conv_b, dt_bias, proj, xbc_act, xbc_b, dtv, qrot, krot, qrot_b, krot_b, out);
    xcd_barrier(bar);
    ph_ssd_states(ldsb, xbc_b, dtv, a_log, Sbuf, cdec);
    __syncthreads();
    ph_attn_prompt(ldsb, qrot_b, krot_b, projb, obuf, lsebuf);
    __syncthreads();
    ph_ssd_naive(lds, xbc_act, dtv, a_log, d_skip, state_ssm, ybuf, out);
    ph_attn_naive(lds, proj, qrot, krot, cache_k, cache_v, ybuf);
    xcd_barrier(bar);
    ph_ssd_scan(Sbuf, cdec, Hin, out);
    xcd_barrier(bar);
    ph_ssd_out(ldsb, xbc_b, projb, dtv, a_log, d_skip, norm_g, Hin, A1);
    ph_attn_combine(obuf, lsebuf, A1);
    ph_gate_norm(proj, norm_g, ybuf, A1);
    xcd_barrier(bar);
    { pg8::Gemm g{A1, wt_out, T_ALL, D_MODEL, MIX_WIDTH}; pg8::StaticOrder S; S.init(g.M, g.N, (int)gridDim.x, (int)blockIdx.x);
      pg8::EpiF32 E{mix, D_MODEL, nullptr}; pg8::gemm_phase<pg8::EpiF32, pg8::StaticOrder, false>(ldsb, g, S, E, nullptr); }
    xcd_barrier(bar);
    ph_ln_res(xall, mix, ln1_g, ln1_b, hbuf, A2);
    xcd_barrier(bar);
    { pg8::Gemm g{A2, wt_q, T_ALL, 2048, D_MODEL}; pg8::StaticOrder S; S.init(g.M, g.N, (int)gridDim.x, (int)blockIdx.x);
      pg8::EpiF32 E{qh, 2048, nullptr}; pg8::gemm_phase<pg8::EpiF32, pg8::StaticOrder, false>(ldsb, g, S, E, nullptr); }
    xcd_barrier(bar);
    ph_peer_route(lds, qh, keys1, keys2, eidx, gate);
    xcd_barrier(bar);
    ph_peer_ffn2(hbuf, eidx, gate, ub, vb, ln2_g, ln2_b, out);
}

extern "C" void kernel_launch(void* const* d_in, const int* in_sizes, int n_in, void* d_out, int out_size, void* d_ws, size_t ws_size, hipStream_t stream) {
    static int grid = 0;
    if (grid == 0) {
        int dev = 0, cus = 0, per_cu = 0;
        if (hipGetDevice(&dev) != hipSuccess || hipDeviceGetAttribute(&cus, hipDeviceAttributeMultiprocessorCount, dev) != hipSuccess) { fprintf(stderr, "kernel_launch: device query failed\n"); grid = -1; return; }
        if (hipFuncSetAttribute((const void*)mega_fwd, hipFuncAttributeMaxDynamicSharedMemorySize, LDS_BYTES) != hipSuccess) { fprintf(stderr, "kernel_launch: hipFuncSetAttribute failed\n"); grid = -1; return; }
        if (hipOccupancyMaxActiveBlocksPerMultiprocessor(&per_cu, (const void*)mega_fwd, NTHR, LDS_BYTES) != hipSuccess || per_cu < 1) { fprintf(stderr, "kernel_launch: occupancy query says %d\n", per_cu); }
        (void)hipGetLastError();
        grid = cus;
        if (ws_size < WS_END) { fprintf(stderr, "kernel_launch: workspace too small\n"); grid = -1; return; }
    }
    if (grid < 0) return;
    (void)hipMemsetAsync((char*)d_ws + WS_BAR, 0, XCD_BAR_WORDS * sizeof(unsigned), stream);
    Params p{};
    for (int i = 0; i < 23; ++i) p.in[i] = (const float*)d_in[i];
    p.out = (float*)d_out; p.ws = (unsigned char*)d_ws; p.bar = (unsigned*)((char*)d_ws + WS_BAR);
    hipLaunchKernelGGL(mega_fwd, dim3(grid), dim3(NTHR), LDS_BYTES, stream, p);
}
```

```cpp
#include <hip/hip_runtime.h>
#include <stdint.h>

#define D_MODEL 1024
#define BATCH 2
#define SEQ 8192
#define DEC_BATCH 128
#define DEC_SEQ 4
#define PAST_LEN 8192
#define HEAD_DIM 64
#define ATT_WIDTH 512
#define ATT_HEADS 8
#define SSD_WIDTH 1536
#define SSD_HEADS 24
#define SSD_GROUPS 4
#define SSD_STATE 128
#define CONV_DIM 2560
#define IN_WIDTH 5656
#define PROJ_LD 5888
#define MIX_WIDTH 2048
#define WBUF 2048
#define PEER_NKEYS 128
#define PEER_HEADS 8
#define PEER_TOPK 16
#define PEER_DKEY 256
#define T_PROMPT (BATCH * SEQ)
#define T_SAMPLE (DEC_BATCH * DEC_SEQ)
#define T_ALL (T_PROMPT + T_SAMPLE)
#define O_Z 0
#define O_XBC 1536
#define O_DT 4096
#define O_Q 4120
#define O_K 4632
#define O_V 5144
#define ALPHA_F 1.189207115002721f
#define LN_EPS 1e-5f

#define OUT_YP 0ull
#define OUT_YS (OUT_YP + 16777216ull)
#define OUT_PK (OUT_YS + 524288ull)
#define OUT_PV (OUT_PK + 2097152ull)
#define OUT_PC (OUT_PV + 2097152ull)
#define OUT_PS (OUT_PC + 15360ull)
#define OUT_SK (OUT_PS + 393216ull)
#define OUT_SV (OUT_SK + 134217728ull)
#define OUT_SC (OUT_SV + 134217728ull)
#define OUT_SS (OUT_SC + 983040ull)

__constant__ double ROPE_INV_REV[32] = {
    1.59154943091895346e-01, 1.19349370211248862e-01, 8.94994016088910133e-02, 6.71150830052272551e-02,
    5.03292121044870353e-02, 3.77415847174197711e-02, 2.83021958306233987e-02, 2.12236527647776604e-02,
    1.59154943091895339e-02, 1.19349370211248862e-02, 8.94994016088910237e-03, 6.71150830052272534e-03,
    5.03292121044870370e-03, 3.77415847174197719e-03, 2.83021958306233987e-03, 2.12236527647776622e-03,
    1.59154943091895356e-03, 1.19349370211248849e-03, 8.94994016088910237e-04, 6.71150830052272599e-04,
    5.03292121044870326e-04, 3.77415847174197741e-04, 2.83021958306233954e-04, 2.12236527647776605e-04,
    1.59154943091895351e-04, 1.19349370211248862e-04, 8.94994016088910182e-05, 6.71150830052272545e-05,
    5.03292121044870354e-05, 3.77415847174197768e-05, 2.83021958306233961e-05, 2.12236527647776592e-05
};

__device__ __forceinline__ float silu_f(float x) { return x / (1.0f + __expf(-x)); }
__device__ __forceinline__ float softplus_f(float x) { return fmaxf(x, 0.f) + log1pf(__expf(-fabsf(x))); }
__device__ __forceinline__ float gelu_f(float x) { return 0.5f * x * (1.0f + erff(x * 0.70710678118654752f)); }
__device__ __forceinline__ float wave_sum(float v) {
#pragma unroll
    for (int o = 32; o > 0; o >>= 1) v += __shfl_xor(v, o);
    return v;
}
__device__ __forceinline__ float wave_max(float v) {
#pragma unroll
    for (int o = 32; o > 0; o >>= 1) v = fmaxf(v, __shfl_xor(v, o));
    return v;
}

#include <cstdio>
#define XB_TMO      128
#define XB_XCNT(j)  (256  + 64 * (j))
#define XB_XSUB(j)  (1280 + 64 * (j))
#define XB_XGEN(j)  (2304 + 64 * (j))
#define XB_TOP      3328
#define XB_TOPGEN   3392
#define XCD_BAR_WORDS 3456
#define XB_SPIN_CAP (1u << 18)
#define LAS __attribute__((address_space(3)))

__device__ __forceinline__ unsigned xb_ld(unsigned* p)              { return __hip_atomic_load(p, __ATOMIC_RELAXED, __HIP_MEMORY_SCOPE_AGENT); }
__device__ __forceinline__ unsigned xb_add(unsigned* p, unsigned v) { return __hip_atomic_fetch_add(p, v, __ATOMIC_RELAXED, __HIP_MEMORY_SCOPE_AGENT); }
__device__ __forceinline__ unsigned xb_xcc_id() { return (unsigned)__builtin_amdgcn_s_getreg((3 << 11) | 20) & 0xFu; }
#define XB_SPIN(cond, bar) do { unsigned _sp = 0; while (cond) { __builtin_amdgcn_s_sleep(1); \
    if ((++_sp & 255u) == 0u) { if (xb_ld(&(bar)[XB_TMO])) break; if (_sp > XB_SPIN_CAP) { atomicAdd(&(bar)[XB_TMO], 1u); break; } } } } while (0)

struct XcdBarrier {
    unsigned* bar; unsigned x;
    volatile LAS unsigned* st;
};

__device__ __forceinline__ XcdBarrier xcd_barrier_post(unsigned* bar, volatile LAS unsigned* st) {
    XcdBarrier b; b.bar = bar; b.x = xb_xcc_id(); b.st = st;
    if (threadIdx.x == 0) (void)xb_add(&bar[XB_XCNT(b.x)], 1u);
    return b;
}
__device__ __forceinline__ void xcd_barrier_complete(unsigned* bar, unsigned x, unsigned& nloc, unsigned& nx) {
    const unsigned G = gridDim.x * gridDim.y * gridDim.z;
    unsigned sum, cnt, mine, sp = 0u;
    for (;;) {
        sum = 0u; cnt = 0u; mine = 0u;
#pragma unroll
        for (unsigned j = 0; j < 16; ++j) { const unsigned c = xb_ld(&bar[XB_XCNT(j)]); sum += c; cnt += (c > 0u) ? 1u : 0u; mine = (j == x) ? c : mine; }
        if (sum == G) break;
        __builtin_amdgcn_s_sleep(1);
        if ((++sp & 255u) == 0u) { if (xb_ld(&bar[XB_TMO])) break; if (sp > XB_SPIN_CAP) { atomicAdd(&bar[XB_TMO], 1u); break; } }
    }
    nloc = mine > 0u ? mine : 1u; nx = cnt > 0u ? cnt : 1u;
}

__device__ __forceinline__ void xcd_barrier(const XcdBarrier& b) {
    asm volatile("s_waitcnt vmcnt(0)" ::: "memory");
    __syncthreads();
    if (threadIdx.x == 0) {
        unsigned* bar = b.bar;
        __builtin_amdgcn_s_waitcnt(0);
        unsigned nloc = b.st[0], nx = b.st[1];
        if (nloc == 0u) { xcd_barrier_complete(bar, b.x, nloc, nx); b.st[0] = nloc; b.st[1] = nx; }
        const unsigned old = xb_add(&bar[XB_XSUB(b.x)], 1u);
        const unsigned gen = old / nloc;
        if (old + 1u == (gen + 1u) * nloc) {
            __builtin_amdgcn_fence(__ATOMIC_RELEASE, "agent");
            asm volatile("s_waitcnt vmcnt(0)" ::: "memory");
            const unsigned og = xb_add(&bar[XB_TOP], 1u);
            const unsigned tg = og / nx;
            if (og + 1u == (tg + 1u) * nx) xb_add(&bar[XB_TOPGEN], 1u);
            else XB_SPIN(xb_ld(&bar[XB_TOPGEN]) == tg, bar);
            __builtin_amdgcn_fence(__ATOMIC_ACQUIRE, "agent");
            xb_add(&bar[XB_XGEN(b.x)], 1u);
            asm volatile("s_waitcnt vmcnt(0)" ::: "memory");
        } else {
            XB_SPIN(xb_ld(&bar[XB_XGEN(b.x)]) == gen, bar);
            __builtin_amdgcn_fence(__ATOMIC_ACQUIRE, "agent");
            asm volatile("s_waitcnt vmcnt(0)" ::: "memory");
        }
    }
    __syncthreads();
}


#define GAS __attribute__((address_space(1)))
typedef unsigned short bf16;
typedef unsigned v4u __attribute__((ext_vector_type(4)));
#define LDS_WAIT() asm volatile("s_waitcnt lgkmcnt(0)" ::: "memory")
__device__ __forceinline__ unsigned f2bf(float f) { unsigned u = __builtin_bit_cast(unsigned, f); return (u + 0x7fffu + ((u >> 16) & 1u)) >> 16; }
__device__ __forceinline__ unsigned pk2(float lo, float hi) { return f2bf(lo) | (f2bf(hi) << 16); }
__device__ __forceinline__ float bf2f(unsigned short b) { return __builtin_bit_cast(float, (unsigned)b << 16); }
#include <hip/hip_runtime.h>
namespace pg8 {
#define PG8_LAS __attribute__((address_space(3)))
typedef unsigned short bf16_t;
typedef short bf16x8 __attribute__((ext_vector_type(8)));
typedef float f32x4 __attribute__((ext_vector_type(4)));
typedef unsigned u32x4 __attribute__((ext_vector_type(4)));
constexpr int BM = 256, BK = 64, HALF = 128, HTB = HALF * BK * 2  , STAGE_BYTES = 8 * HTB, NXCD = 8, WGM = 8;

__host__ __device__ __forceinline__ int lds_byte(int r, int c) { const int st = (r >> 4) * 2 + (c >> 5), rr = r & 15, cc = c & 31, ob = rr * 64 + cc * 2; return st * 1024 + (ob ^ (((ob >> 9) & 1) << 5)); }
__host__ __device__ __forceinline__ void stage_rc(int b, int& R, int& C) { const int st = b / 1024, sb = b % 1024, swz = sb ^ (((sb >> 9) & 1) << 5); R = (st >> 1) * 16 + swz / 64; C = (st & 1) * 32 + (swz % 64) / 2; }
__host__ __device__ __forceinline__ int perm32(int rho) { const int n = rho >> 4, i = rho & 15; return 8 * (i >> 2) + 4 * n + (i & 3); }

struct Unit { int pm, pn; };
struct Gemm { const bf16_t* A; const bf16_t* Bt; int M, N, K; };

struct StaticOrder {
    int nM, nN, nwg, G, c;
    __host__ __device__ void init(int M, int N, int G_, int c_) { nM = M / BM; nN = N / BM; nwg = nM * nN; G = G_; c = c_; }
    __host__ __device__ bool next(int i, Unit& u) const {
        const long L = (long)i * G + c; if (L >= nwg) return false;
        int wgid = (int)L; { const int q = nwg / NXCD, r = nwg % NXCD, xcd = wgid % NXCD, off = wgid / NXCD; wgid = (xcd < r ? xcd * (q + 1) : r * (q + 1) + (xcd - r) * q) + off; }
        const int nig = WGM * nN, gid = wgid / nig, fm = gid * WGM, gsz = (nM - fm) < WGM ? (nM - fm) : WGM;
        u.pm = fm + ((wgid % nig) % gsz); u.pn = (wgid % nig) / gsz; return true;
    }
    __device__ __forceinline__ void a_ready(const Unit&) const {}
    __device__ __forceinline__ void done(const Unit&) const {}
};
__device__ __forceinline__ unsigned cvt_pk_bf16(float lo, float hi) { unsigned r; asm volatile("v_cvt_pk_bf16_f32 %0, %1, %2" : "=v"(r) : "v"(lo), "v"(hi)); return r; }
typedef float f32x2 __attribute__((ext_vector_type(2)));
__device__ __forceinline__ f32x2 gelu_pk(f32x2 v) {
    const f32x2 av = __builtin_elementwise_abs(v), d = av * 0.2316418882f + 1.0f;
    f32x2 t; t.x = __builtin_amdgcn_rcpf(d.x); t.y = __builtin_amdgcn_rcpf(d.y);
    f32x2 q = t * 0.5307027145f + (-0.7265760135f); q = q * t + 0.7107068705f; q = q * t + (-0.142248368f); q = q * t + 0.127414796f; q = q * t;
    const f32x2 s = (v * v) * (-0.72134752044f);
    f32x2 e; e.x = __builtin_amdgcn_exp2f(s.x); e.y = __builtin_amdgcn_exp2f(s.y);
    const f32x2 m = v * (q * e), r = v - m;
    f32x2 o; o.x = v.x < 0.f ? m.x : r.x; o.y = v.y < 0.f ? m.y : r.y; return o;
}

struct EpiF32 {
    static constexpr bool PERM = false, AFTER_DRAIN = false;
    float* C; int ldc; const float* bias;
    __device__ __forceinline__ void operator()(const f32x4 (&acc)[2][2][4][2], const Unit& u, int wr, int wc, int fr, int fq) const {
        const int row0 = u.pm * BM + wr * 64 + fr, col0 = u.pn * BM + wc * 32 + 4 * fq;
        f32x4 bv[2][2];
#pragma unroll
        for (int bj = 0; bj < 2; ++bj)
#pragma unroll
            for (int n = 0; n < 2; ++n) bv[bj][n] = bias ? *(const f32x4*)(bias + col0 + bj * HALF + n * 16) : (f32x4){0.f, 0.f, 0.f, 0.f};
#pragma unroll
        for (int ai = 0; ai < 2; ++ai)
#pragma unroll
            for (int m = 0; m < 4; ++m) { float* rowp = C + (size_t)(row0 + ai * HALF + m * 16) * ldc + col0;
#pragma unroll
                for (int bj = 0; bj < 2; ++bj)
#pragma unroll
                    for (int n = 0; n < 2; ++n) *(f32x4*)(rowp + bj * HALF + n * 16) = acc[ai][bj][m][n] + bv[bj][n]; }
    }
};

template <class Epi, class Sched, bool STAMP = false>
__device__ __forceinline__ void gemm_phase(PG8_LAS unsigned char* lds, const Gemm g, const Sched& S, const Epi& E, unsigned long long* stamps) {
    const int tid = threadIdx.x, wid = __builtin_amdgcn_readfirstlane(tid >> 6), lane = tid & 63, wr = wid >> 2, wc = wid & 3, fr = lane & 15, fq = lane >> 4;
    const int K = g.K, nt = K / BK;
    int ts_lo = 0, ts_hi = 0, nts = 0; const unsigned long long rt_entry = STAMP ? (unsigned long long)wall_clock64() : 0ull;
#define PG8_STAMP() do { if (STAMP && wid == 0 && nts < 64) { const unsigned long long _c = (unsigned long long)clock64(); \
        ts_lo = (lane == nts) ? (int)(unsigned)_c : ts_lo; ts_hi = (lane == nts) ? (int)(unsigned)(_c >> 32) : ts_hi; ++nts; } } while (0)
    PG8_STAMP();
    unsigned voffA[2], voffB[2];
#pragma unroll
    for (int i = 0; i < 2; ++i) { int R, C; stage_rc(tid * 16 + i * 8192, R, C); const int Rb = Epi::PERM ? ((R & ~31) + perm32(R & 31)) : R;
        voffA[i] = (unsigned)(R * K + C) * 2u; voffB[i] = (unsigned)(Rb * K + C) * 2u; }
    const size_t kstep = (size_t)(BK * 2);
    const size_t hstep = (size_t)HALF * K * 2;
    const size_t tstep = 2 * hstep;
    const unsigned ldsw = (unsigned)wid * 1024u;
    const int aoff = lds_byte(wr * 64 + fr, fq * 8), boff = lds_byte(wc * 32 + fr, fq * 8);
#define PG8_SA(b, h) (((b) * 2 + (h)) * HTB)
#define PG8_SB(b, h) ((4 + (b) * 2 + (h)) * HTB)
#define PG8_STAGE(bufoff, gbase, voff) do { _Pragma("unroll") for (int _i = 0; _i < 2; ++_i) \
        __builtin_amdgcn_global_load_lds((const unsigned*)((const char*)(gbase) + (voff)[_i]), (PG8_LAS unsigned*)(lds + (bufoff) + ldsw + _i * 8192), 16, 0, 0); } while (0)
#define PG8_LDA(dst, b, h) do { _Pragma("unroll") for (int m = 0; m < 4; ++m) _Pragma("unroll") for (int k = 0; k < 2; ++k) dst[m][k] = *(const PG8_LAS bf16x8*)(lds + PG8_SA(b, h) + aoff + m * 2048 + k * 1024); } while (0)
#define PG8_LDB(dst, b, h) do { _Pragma("unroll") for (int n = 0; n < 2; ++n) _Pragma("unroll") for (int k = 0; k < 2; ++k) dst[n][k] = *(const PG8_LAS bf16x8*)(lds + PG8_SB(b, h) + boff + n * 2048 + k * 1024); } while (0)
#define PG8_MMA(ai, bj, At, Bt) do { __builtin_amdgcn_s_setprio(1); _Pragma("unroll") for (int m = 0; m < 4; ++m) _Pragma("unroll") for (int n = 0; n < 2; ++n) _Pragma("unroll") for (int k = 0; k < 2; ++k) \
        acc[ai][bj][m][n] = __builtin_amdgcn_mfma_f32_16x16x32_bf16(Bt[n][k], At[m][k], acc[ai][bj][m][n], 0, 0, 0); __builtin_amdgcn_s_setprio(0); } while (0)
#define PG8_WAIT_V(n) asm volatile("s_waitcnt vmcnt(" #n ")" ::: "memory")
#define PG8_WAIT_L(n) asm volatile("s_waitcnt lgkmcnt(" #n ")" ::: "memory")
#define PG8_BAR __builtin_amdgcn_s_barrier()
#define PG8_SCHED __builtin_amdgcn_sched_barrier(0)
    Unit cur, nxt; int ui = 0;
    if (!S.next(0, cur)) return;
    f32x4 acc[2][2][4][2];
#pragma unroll
    for (int a = 0; a < 2; ++a)
#pragma unroll
        for (int b = 0; b < 2; ++b)
#pragma unroll
            for (int m = 0; m < 4; ++m)
#pragma unroll
                for (int n = 0; n < 2; ++n) acc[a][b][m][n] = (f32x4){0.f, 0.f, 0.f, 0.f};
    bf16x8 At[4][2], B0[2][2], B1[2][2];
    const char* cA = (const char*)g.A + (size_t)cur.pm * tstep; const char* cB = (const char*)g.Bt + (size_t)cur.pn * tstep;
    S.a_ready(cur);
    PG8_STAGE(PG8_SB(0, 0), cB, voffB); PG8_STAGE(PG8_SA(0, 0), cA, voffA); PG8_STAGE(PG8_SB(0, 1), cB + hstep, voffB); PG8_STAGE(PG8_SA(0, 1), cA + hstep, voffA);
    if (wr == 1) PG8_BAR;
    PG8_WAIT_V(4); PG8_BAR;
    PG8_STAGE(PG8_SB(1, 0), cB + kstep, voffB); PG8_STAGE(PG8_SA(1, 0), cA + kstep, voffA); PG8_STAGE(PG8_SB(1, 1), cB + hstep + kstep, voffB);
    PG8_WAIT_V(6); PG8_BAR;
    PG8_STAMP();
    for (;;) {
        const bool has_next = S.next(ui + 1, nxt);
        const char* nA = has_next ? (const char*)g.A + (size_t)nxt.pm * tstep : cA; const char* nB = has_next ? (const char*)g.Bt + (size_t)nxt.pn * tstep : cB;
        for (int t = 0; t < nt; t += 2) {
            const bool last = (t == nt - 2);
            const char* a1 = cA + (size_t)(t + 1) * kstep;
            const char* a2 = last ? nA : cA + (size_t)(t + 2) * kstep; const char* b2 = last ? nB : cB + (size_t)(t + 2) * kstep;
            const char* a3 = a2 + kstep; const char* b3 = b2 + kstep;
            if (last && has_next) S.a_ready(nxt);
            PG8_LDB(B0, 0, 0); PG8_SCHED; PG8_LDA(At, 0, 0); PG8_STAGE(PG8_SA(1, 1), a1 + hstep, voffA);
            PG8_WAIT_L(8); PG8_BAR; PG8_WAIT_L(0); PG8_MMA(0, 0, At, B0); PG8_BAR; PG8_SCHED;
            PG8_LDB(B1, 0, 1); PG8_STAGE(PG8_SB(0, 0), b2, voffB);
            PG8_BAR; PG8_WAIT_L(0); PG8_MMA(0, 1, At, B1); PG8_BAR;
            PG8_LDA(At, 0, 1); PG8_STAGE(PG8_SA(0, 0), a2, voffA);
            PG8_BAR; PG8_WAIT_L(0); PG8_MMA(1, 0, At, B0); PG8_BAR; PG8_SCHED;
            PG8_STAGE(PG8_SB(0, 1), b2 + hstep, voffB);
            PG8_WAIT_V(6); PG8_BAR; PG8_MMA(1, 1, At, B1); PG8_BAR;
            PG8_LDB(B0, 1, 0); PG8_SCHED; PG8_LDA(At, 1, 0); PG8_STAGE(PG8_SA(0, 1), a2 + hstep, voffA);
            PG8_WAIT_L(8); PG8_BAR; PG8_WAIT_L(0); PG8_MMA(0, 0, At, B0); PG8_BAR; PG8_SCHED;
            PG8_LDB(B1, 1, 1); PG8_STAGE(PG8_SB(1, 0), b3, voffB);
            PG8_BAR; PG8_WAIT_L(0); PG8_MMA(0, 1, At, B1); PG8_BAR;
            PG8_LDA(At, 1, 1); PG8_STAGE(PG8_SA(1, 0), a3, voffA);
            PG8_BAR; PG8_WAIT_L(0); PG8_MMA(1, 0, At, B0); PG8_BAR; PG8_SCHED;
            PG8_STAGE(PG8_SB(1, 1), b3 + hstep, voffB);
            PG8_WAIT_V(6); PG8_BAR; PG8_MMA(1, 1, At, B1); PG8_BAR;
        }
        PG8_STAMP();
        if constexpr (!Epi::AFTER_DRAIN) { E(acc, cur, wr, wc, fr, fq); S.done(cur); }
        PG8_STAMP();
        if (!has_next) break;
#pragma unroll
        for (int a = 0; a < 2; ++a)
#pragma unroll
            for (int b = 0; b < 2; ++b)
#pragma unroll
                for (int m = 0; m < 4; ++m)
#pragma unroll
                    for (int n = 0; n < 2; ++n) acc[a][b][m][n] = (f32x4){0.f, 0.f, 0.f, 0.f};
        cur = nxt; cA = nA; cB = nB; ++ui;
    }
    PG8_WAIT_V(0);
    if (wr == 0) PG8_BAR;
    PG8_BAR;
    if constexpr (Epi::AFTER_DRAIN) { E.fused(acc, cur, wr, wc, fr, fq, lds, wid, lane); S.done(cur); }
    PG8_STAMP();
    if (STAMP && wid == 0) { stamps[lane] = lane < nts ? (((unsigned long long)(unsigned)ts_hi << 32) | (unsigned)ts_lo) : 0ull;
        if (lane == 62) stamps[62] = rt_entry; if (lane == 63) stamps[63] = (unsigned long long)wall_clock64(); }
#undef PG8_STAMP
#undef PG8_SA
#undef PG8_SB
#undef PG8_STAGE
#undef PG8_LDA
#undef PG8_LDB
#undef PG8_MMA
#undef PG8_WAIT_V
#undef PG8_WAIT_L
#undef PG8_BAR
#undef PG8_SCHED
}
}


namespace pg8 {
struct EpiProj {
    static constexpr bool PERM = true, AFTER_DRAIN = false;
    bf16_t* O; float* dtraw;
    __device__ __forceinline__ void operator()(const f32x4 (&acc)[2][2][4][2], const Unit& u, int wr, int wc, int fr, int fq) const {
        const int row0 = u.pm * BM + wr * 64 + fr;
        if (u.pn < 22) {
            const int col0 = u.pn * BM + wc * 32 + 8 * fq;
#pragma unroll
            for (int ai = 0; ai < 2; ++ai)
#pragma unroll
                for (int m = 0; m < 4; ++m) { bf16_t* rowp = O + (size_t)(row0 + ai * HALF + m * 16) * 5632 + col0;
#pragma unroll
                    for (int bj = 0; bj < 2; ++bj) { const f32x4 v0 = acc[ai][bj][m][0], v1 = acc[ai][bj][m][1];
                        u32x4 w; w.x = cvt_pk_bf16(v0[0], v0[1]); w.y = cvt_pk_bf16(v0[2], v0[3]); w.z = cvt_pk_bf16(v1[0], v1[1]); w.w = cvt_pk_bf16(v1[2], v1[3]);
                        *(u32x4*)(rowp + bj * HALF) = w; } }
        } else if (wc == 0) {
#pragma unroll
            for (int ai = 0; ai < 2; ++ai)
#pragma unroll
                for (int m = 0; m < 4; ++m) { float* rp = dtraw + (size_t)(row0 + ai * HALF + m * 16) * 32 + 8 * fq;
                    *(f32x4*)rp = acc[ai][0][m][0]; *(f32x4*)(rp + 4) = acc[ai][0][m][1]; }
        }
    }
};
}


namespace pg8 {
struct EpiBf16Plain {
    static constexpr bool PERM = true, AFTER_DRAIN = false;
    bf16_t* O; int ldc;
    __device__ __forceinline__ void operator()(const f32x4 (&acc)[2][2][4][2], const Unit& u, int wr, int wc, int fr, int fq) const {
        const int row0 = u.pm * BM + wr * 64 + fr, col0 = u.pn * BM + wc * 32 + 8 * fq;
#pragma unroll
        for (int ai = 0; ai < 2; ++ai)
#pragma unroll
            for (int m = 0; m < 4; ++m) { bf16_t* rowp = O + (size_t)(row0 + ai * HALF + m * 16) * ldc + col0;
#pragma unroll
                for (int bj = 0; bj < 2; ++bj) { const f32x4 v0 = acc[ai][bj][m][0], v1 = acc[ai][bj][m][1];
                    u32x4 w; w.x = cvt_pk_bf16(v0[0], v0[1]); w.y = cvt_pk_bf16(v0[2], v0[3]); w.z = cvt_pk_bf16(v1[0], v1[1]); w.w = cvt_pk_bf16(v1[2], v1[3]);
                    *(u32x4*)(rowp + bj * HALF) = w; } }
    }
};
}

#define NTHR 512
#define NWAVE 8

__device__ __forceinline__ void ph_gemm_f32(float* lds, const float* __restrict__ A, const float* __restrict__ B, float* __restrict__ C,
                                            int M, int N, int K, int lda, int ldb, int ldc) {
    const int tid = threadIdx.x & 255, half = threadIdx.x >> 8, tx = tid & 15, ty = tid >> 4;
    float (*As)[68] = (float (*)[68])(lds + half * 2 * 16 * 68);
    float (*Bs)[68] = (float (*)[68])(lds + half * 2 * 16 * 68 + 16 * 68);
    const int ntx = (N + 63) / 64, nty = M / 64, ntiles = ntx * nty;
    for (int it = blockIdx.x; 2 * it < ntiles; it += gridDim.x) {
        const int tile = 2 * it + half;
        const int m0 = (tile / ntx) * 64, n0 = (tile % ntx) * 64;
        float acc[4][4];
#pragma unroll
        for (int i = 0; i < 4; ++i)
#pragma unroll
            for (int j = 0; j < 4; ++j) acc[i][j] = 0.f;
        for (int k0 = 0; k0 < K; k0 += 16) {
#pragma unroll
            for (int i = 0; i < 4; ++i) {
                int idx = tid + i * 256;
                int r = idx >> 4, c = idx & 15;
                As[c][r] = (m0 + r < M) ? A[(size_t)(m0 + r) * lda + k0 + c] : 0.f;
                int rb = idx >> 6, cb = idx & 63;
                Bs[rb][cb] = (n0 + cb < N) ? B[(size_t)(k0 + rb) * ldb + n0 + cb] : 0.f;
            }
            __syncthreads();
#pragma unroll
            for (int k = 0; k < 16; ++k) {
                float a[4], b[4];
#pragma unroll
                for (int i = 0; i < 4; ++i) { a[i] = As[k][ty * 4 + i]; b[i] = Bs[k][tx * 4 + i]; }
#pragma unroll
                for (int i = 0; i < 4; ++i)
#pragma unroll
                    for (int j = 0; j < 4; ++j) acc[i][j] += a[i] * b[j];
            }
            __syncthreads();
        }
#pragma unroll
        for (int i = 0; i < 4; ++i)
#pragma unroll
            for (int j = 0; j < 4; ++j) {
                int r = m0 + ty * 4 + i, c = n0 + tx * 4 + j;
                if (r < M && c < N) C[(size_t)r * ldc + c] = acc[i][j];
            }
    }
}


template <int MODE>
__device__ __forceinline__ void transpose_item(const float* __restrict__ W, int K, int N, int Npad, bf16* __restrict__ WT, LAS float* scr, int item, int lane) {
    const int nblk = Npad / 32, kb = item / nblk, nb = item % nblk, k0 = 64 * kb, n0 = 32 * nb;
    const int n = n0 + (lane & 31);
    int sc = n;
    if (MODE == 1) sc = (n < 4096) ? n : (n < 5632 ? n + 24 : (n < 5656 ? n - 5632 + 4096 : -1));
    else sc = (n < N) ? n : -1;
#pragma unroll 8
    for (int i = 0; i < 32; ++i) { const int kk = 2 * i + (lane >> 5); scr[kk * 33 + (lane & 31)] = (sc >= 0) ? W[(size_t)(k0 + kk) * N + sc] : 0.f; }
    LDS_WAIT(); asm volatile("" ::: "memory");
    const int c = lane & 7;
#pragma unroll
    for (int j = 0; j < 4; ++j) { const int nn = (lane >> 3) + 8 * j; const LAS float* s = scr + (8 * c) * 33 + nn;
        v4u o; o.x = pk2(s[0 * 33], s[1 * 33]); o.y = pk2(s[2 * 33], s[3 * 33]); o.z = pk2(s[4 * 33], s[5 * 33]); o.w = pk2(s[6 * 33], s[7 * 33]);
        *(v4u*)(WT + (size_t)(n0 + nn) * K + k0 + 8 * c) = o; }
    LDS_WAIT(); asm volatile("" ::: "memory");
}
__device__ __forceinline__ void ph_prologue(LAS unsigned char* ldsb, const float* __restrict__ xp, const float* __restrict__ xs, bf16* __restrict__ A0,
                                            const float* __restrict__ w_in, bf16* __restrict__ wt_in, const float* __restrict__ w_out, bf16* __restrict__ wt_out,
                                            const float* __restrict__ w_q, bf16* __restrict__ wt_q,
                                            const float* __restrict__ pu, const float* __restrict__ pv, bf16* __restrict__ ub, bf16* __restrict__ vb) {
    const int lane = threadIdx.x & 63, wave = threadIdx.x >> 6;
    LAS float* scr = (LAS float*)(ldsb + wave * 16384);
    const int gw = blockIdx.x * NWAVE + wave, NGW = gridDim.x * NWAVE;
    constexpr int I_IN = (D_MODEL / 64) * (PROJ_LD / 32), I_OUT = (MIX_WIDTH / 64) * (D_MODEL / 32), I_Q = (D_MODEL / 64) * (2048 / 32);
    for (int it = gw; it < I_IN + I_OUT + I_Q; it += NGW) {
        int r = it;
        if (r < I_IN) { transpose_item<1>(w_in, D_MODEL, IN_WIDTH, PROJ_LD, wt_in, scr, r, lane); continue; } r -= I_IN;
        if (r < I_OUT) { transpose_item<0>(w_out, MIX_WIDTH, D_MODEL, D_MODEL, wt_out, scr, r, lane); continue; } r -= I_OUT;
        transpose_item<0>(w_q, D_MODEL, 2048, 2048, wt_q, scr, r, lane);
    }
    const size_t n8 = (size_t)T_ALL * D_MODEL / 8, np8 = (size_t)T_PROMPT * D_MODEL / 8;
    for (size_t i = (size_t)blockIdx.x * NTHR + threadIdx.x; i < n8; i += (size_t)gridDim.x * NTHR) {
        const float4* s = (i < np8) ? (const float4*)xp + 2 * i : (const float4*)xs + 2 * (i - np8);
        float4 a = s[0], b = s[1];
        v4u o; o.x = pk2(a.x, a.y); o.y = pk2(a.z, a.w); o.z = pk2(b.x, b.y); o.w = pk2(b.z, b.w);
        ((v4u*)A0)[i] = o;
    }
    const size_t t8 = (size_t)16384 * D_MODEL / 8;
    for (size_t i = (size_t)blockIdx.x * NTHR + threadIdx.x; i < 2 * t8; i += (size_t)gridDim.x * NTHR) {
        const float4* s = (i < t8) ? (const float4*)pu + 2 * i : (const float4*)pv + 2 * (i - t8);
        float4 a = s[0], b = s[1];
        v4u o; o.x = pk2(a.x, a.y); o.y = pk2(a.z, a.w); o.z = pk2(b.x, b.y); o.w = pk2(b.z, b.w);
        if (i < t8) ((v4u*)ub)[i] = o; else ((v4u*)vb)[i - t8] = o;
    }
}

__device__ __forceinline__ void ph_concat_x(const float* __restrict__ xp, const float* __restrict__ xs, float* __restrict__ xall) {
    const size_t n4 = (size_t)T_ALL * D_MODEL / 4, np4 = (size_t)T_PROMPT * D_MODEL / 4;
    for (size_t i = (size_t)blockIdx.x * NTHR + threadIdx.x; i < n4; i += (size_t)gridDim.x * NTHR) {
        float4 v = (i < np4) ? ((const float4*)xp)[i] : ((const float4*)xs)[i - np4];
        ((float4*)xall)[i] = v;
    }
}

__device__ __forceinline__ void ph_cache_copy(const float* __restrict__ ck, const float* __restrict__ cv, float* __restrict__ out) {
    const size_t per_b4 = (size_t)(WBUF - DEC_SEQ) * ATT_WIDTH / 4;
    const size_t total = per_b4 * DEC_BATCH;
    for (size_t i = (size_t)blockIdx.x * NTHR + threadIdx.x; i < total; i += (size_t)gridDim.x * NTHR) {
        size_t b = i / per_b4, r = i % per_b4;
        size_t src = (b * WBUF * ATT_WIDTH + DEC_SEQ * ATT_WIDTH) / 4 + r;
        size_t dst = (b * WBUF * ATT_WIDTH) / 4 + r;
        ((float4*)(out + OUT_SK))[dst] = ((const float4*)ck)[src];
        ((float4*)(out + OUT_SV))[dst] = ((const float4*)cv)[src];
    }
}

__device__ __forceinline__ void ph_post_proj(const float* __restrict__ proj, const float* __restrict__ state_conv,
                                             const float* __restrict__ conv_w, const float* __restrict__ conv_b, const float* __restrict__ dt_bias,
                                             float* __restrict__ xbc_act, float* __restrict__ dtv, float* __restrict__ qrot, float* __restrict__ krot,
                                             float* __restrict__ out) {
    const int tid = threadIdx.x & 255, half = threadIdx.x >> 8;
    for (int t = 2 * blockIdx.x + half; t < T_ALL; t += 2 * gridDim.x) {
        const bool is_p = t < T_PROMPT;
        int b, i, pos;
        if (is_p) { b = t / SEQ; i = t % SEQ; pos = i; } else { int ts = t - T_PROMPT; b = ts / DEC_SEQ; i = ts % DEC_SEQ; pos = PAST_LEN + i; }
        const float* row = proj + (size_t)t * PROJ_LD;
        for (int c = tid; c < CONV_DIM; c += 256) {
            float acc = conv_b[c];
#pragma unroll
            for (int tap = 0; tap < 4; ++tap) {
                int r = i - 3 + tap;
                float val;
                if (r >= 0) val = proj[(size_t)(t - i + r) * PROJ_LD + O_XBC + c];
                else val = is_p ? 0.f : state_conv[((size_t)b * 3 + (3 + r)) * CONV_DIM + c];
                acc += val * conv_w[tap * CONV_DIM + c];
            }
            xbc_act[(size_t)t * CONV_DIM + c] = silu_f(acc);
        }
        if (tid < SSD_HEADS) dtv[(size_t)t * SSD_HEADS + tid] = softplus_f(row[O_DT + tid] + dt_bias[tid]);
        for (int idx = tid; idx < 512; idx += 256) {
            int which = idx >> 8, h = (idx >> 5) & 7, j = idx & 31;
            double rev = (double)pos * ROPE_INV_REV[j];
            float fr = (float)(rev - floor(rev));
            float sn = __builtin_amdgcn_sinf(fr), cs = __builtin_amdgcn_cosf(fr);
            const float* src = row + (which ? O_K : O_Q) + h * 64;
            float t1 = src[j], t2 = src[j + 32];
            float o1 = t1 * cs - t2 * sn, o2 = t2 * cs + t1 * sn;
            float* dst = (which ? krot : qrot) + (size_t)t * ATT_WIDTH + h * 64;
            dst[j] = o1; dst[j + 32] = o2;
            if (which) {
                if (is_p) { if (i >= SEQ - WBUF) { float* o = out + OUT_PK + ((size_t)b * WBUF + (i - (SEQ - WBUF))) * ATT_WIDTH + h * 64; o[j] = o1; o[j + 32] = o2; } }
                else { float* o = out + OUT_SK + ((size_t)b * WBUF + (WBUF - DEC_SEQ + i)) * ATT_WIDTH + h * 64; o[j] = o1; o[j + 32] = o2; }
            }
        }
        for (int c = tid; c < ATT_WIDTH; c += 256) {
            float v = row[O_V + c];
            if (is_p) { if (i >= SEQ - WBUF) out[OUT_PV + ((size_t)b * WBUF + (i - (SEQ - WBUF))) * ATT_WIDTH + c] = v; }
            else out[OUT_SV + ((size_t)b * WBUF + (WBUF - DEC_SEQ + i)) * ATT_WIDTH + c] = v;
        }
        if (is_p) {
            if (i >= SEQ - 3) { int r = i - (SEQ - 3); for (int c = tid; c < CONV_DIM; c += 256) out[OUT_PC + ((size_t)b * 3 + r) * CONV_DIM + c] = row[O_XBC + c]; }
        } else {
            if (i >= 1) { int r = i - 1; for (int c = tid; c < CONV_DIM; c += 256) out[OUT_SC + ((size_t)b * 3 + r) * CONV_DIM + c] = row[O_XBC + c]; }
        }
    }
}


#define NB_LD 5632
#define NB_XBC 1536
#define NB_Q 4096
#define NB_K 4608
#define NB_V 5120
__device__ __forceinline__ void unpack8(const v4u w, float (&f)[8]) {
    f[0] = __builtin_bit_cast(float, w.x << 16); f[1] = __builtin_bit_cast(float, w.x & 0xffff0000u);
    f[2] = __builtin_bit_cast(float, w.y << 16); f[3] = __builtin_bit_cast(float, w.y & 0xffff0000u);
    f[4] = __builtin_bit_cast(float, w.z << 16); f[5] = __builtin_bit_cast(float, w.z & 0xffff0000u);
    f[6] = __builtin_bit_cast(float, w.w << 16); f[7] = __builtin_bit_cast(float, w.w & 0xffff0000u);
}
__device__ __forceinline__ void store8f(float* d, const float (&f)[8]) { *(float4*)d = make_float4(f[0], f[1], f[2], f[3]); *(float4*)(d + 4) = make_float4(f[4], f[5], f[6], f[7]); }
__device__ __forceinline__ void ph_post_proj2(const bf16* __restrict__ projb, const float* __restrict__ dtraw, const float* __restrict__ state_conv,
                                              const float* __restrict__ conv_w, const float* __restrict__ conv_b, const float* __restrict__ dt_bias,
                                              float* __restrict__ proj, float* __restrict__ xbc_act, bf16* __restrict__ xbc_b, float* __restrict__ dtv,
                                              float* __restrict__ qrot, float* __restrict__ krot, bf16* __restrict__ qrot_b, bf16* __restrict__ krot_b,
                                              float* __restrict__ out) {
    const int tid = threadIdx.x & 255, half = threadIdx.x >> 8;
    for (int t = 2 * blockIdx.x + half; t < T_ALL; t += 2 * gridDim.x) {
        const bool is_p = t < T_PROMPT;
        int b, i, pos;
        if (is_p) { b = t / SEQ; i = t % SEQ; pos = i; } else { int ts = t - T_PROMPT; b = ts / DEC_SEQ; i = ts % DEC_SEQ; pos = PAST_LEN + i; }
        const bf16* row = projb + (size_t)t * NB_LD;
        if (tid < 192) { float f[8]; unpack8(*(const v4u*)(row + tid * 8), f); store8f(proj + (size_t)t * PROJ_LD + O_Z + tid * 8, f); }
        if (tid < 64) {
            float f[8]; unpack8(*(const v4u*)(row + NB_V + tid * 8), f);
            store8f(proj + (size_t)t * PROJ_LD + O_V + tid * 8, f);
            if (is_p) { if (i >= SEQ - WBUF) store8f(out + OUT_PV + ((size_t)b * WBUF + (i - (SEQ - WBUF))) * ATT_WIDTH + tid * 8, f); }
            else store8f(out + OUT_SV + ((size_t)b * WBUF + (WBUF - DEC_SEQ + i)) * ATT_WIDTH + tid * 8, f);
        }
        for (int c8 = tid; c8 < 320; c8 += 256) {
            const int c = c8 * 8;
            float acc[8], cur[8];
            { const float4 b0 = *(const float4*)(conv_b + c), b1 = *(const float4*)(conv_b + c + 4);
              acc[0] = b0.x; acc[1] = b0.y; acc[2] = b0.z; acc[3] = b0.w; acc[4] = b1.x; acc[5] = b1.y; acc[6] = b1.z; acc[7] = b1.w; }
#pragma unroll
            for (int tap = 0; tap < 4; ++tap) {
                const int r = i - 3 + tap;
                float val[8];
                if (r >= 0) unpack8(*(const v4u*)(projb + (size_t)(t - i + r) * NB_LD + NB_XBC + c), val);
                else if (!is_p) { const float* sp = state_conv + ((size_t)b * 3 + (3 + r)) * CONV_DIM + c; const float4 s0 = *(const float4*)sp, s1 = *(const float4*)(sp + 4);
                    val[0] = s0.x; val[1] = s0.y; val[2] = s0.z; val[3] = s0.w; val[4] = s1.x; val[5] = s1.y; val[6] = s1.z; val[7] = s1.w; }
                else {
#pragma unroll
                    for (int j = 0; j < 8; ++j) val[j] = 0.f; }
                const float4 w0 = *(const float4*)(conv_w + tap * CONV_DIM + c), w1 = *(const float4*)(conv_w + tap * CONV_DIM + c + 4);
                acc[0] += val[0] * w0.x; acc[1] += val[1] * w0.y; acc[2] += val[2] * w0.z; acc[3] += val[3] * w0.w;
                acc[4] += val[4] * w1.x; acc[5] += val[5] * w1.y; acc[6] += val[6] * w1.z; acc[7] += val[7] * w1.w;
                if (tap == 3) {
#pragma unroll
                    for (int j = 0; j < 8; ++j) cur[j] = val[j]; }
            }
#pragma unroll
            for (int j = 0; j < 8; ++j) acc[j] = silu_f(acc[j]);
            store8f(xbc_act + (size_t)t * CONV_DIM + c, acc);
            v4u o; o.x = pk2(acc[0], acc[1]); o.y = pk2(acc[2], acc[3]); o.z = pk2(acc[4], acc[5]); o.w = pk2(acc[6], acc[7]);
            *(v4u*)(xbc_b + (size_t)t * CONV_DIM + c) = o;
            if (is_p) { if (i >= SEQ - 3) store8f(out + OUT_PC + ((size_t)b * 3 + (i - (SEQ - 3))) * CONV_DIM + c, cur); }
            else { if (i >= 1) store8f(out + OUT_SC + ((size_t)b * 3 + (i - 1)) * CONV_DIM + c, cur); }
        }
        if (tid < SSD_HEADS) dtv[(size_t)t * SSD_HEADS + tid] = softplus_f(dtraw[(size_t)t * 32 + tid] + dt_bias[tid]);
        if (tid < 128) {
            const int which = tid >> 6, h = (tid >> 3) & 7, jc = tid & 7;
            const bf16* src = row + (which ? NB_K : NB_Q) + h * 64 + jc * 4;
            const uint2 lo = *(const uint2*)src, hi = *(const uint2*)(src + 32);
            float t1[4], t2[4], o1[4], o2[4];
            t1[0] = __builtin_bit_cast(float, lo.x << 16); t1[1] = __builtin_bit_cast(float, lo.x & 0xffff0000u); t1[2] = __builtin_bit_cast(float, lo.y << 16); t1[3] = __builtin_bit_cast(float, lo.y & 0xffff0000u);
            t2[0] = __builtin_bit_cast(float, hi.x << 16); t2[1] = __builtin_bit_cast(float, hi.x & 0xffff0000u); t2[2] = __builtin_bit_cast(float, hi.y << 16); t2[3] = __builtin_bit_cast(float, hi.y & 0xffff0000u);
#pragma unroll
            for (int e = 0; e < 4; ++e) {
                const double rev = (double)pos * ROPE_INV_REV[jc * 4 + e];
                const float fr = (float)(rev - floor(rev));
                const float sn = __builtin_amdgcn_sinf(fr), cs = __builtin_amdgcn_cosf(fr);
                o1[e] = t1[e] * cs - t2[e] * sn; o2[e] = t2[e] * cs + t1[e] * sn;
            }
            const size_t doff = (size_t)t * ATT_WIDTH + h * 64 + jc * 4;
            float* df = which ? krot : qrot; bf16* db = which ? krot_b : qrot_b;
            *(float4*)(df + doff) = make_float4(o1[0], o1[1], o1[2], o1[3]); *(float4*)(df + doff + 32) = make_float4(o2[0], o2[1], o2[2], o2[3]);
            *(uint2*)(db + doff) = make_uint2(pk2(o1[0], o1[1]), pk2(o1[2], o1[3])); *(uint2*)(db + doff + 32) = make_uint2(pk2(o2[0], o2[1]), pk2(o2[2], o2[3]));
            if (which) {
                float* o = nullptr;
                if (is_p) { if (i >= SEQ - WBUF) o = out + OUT_PK + ((size_t)b * WBUF + (i - (SEQ - WBUF))) * ATT_WIDTH + h * 64 + jc * 4; }
                else o = out + OUT_SK + ((size_t)b * WBUF + (WBUF - DEC_SEQ + i)) * ATT_WIDTH + h * 64 + jc * 4;
                if (o) { *(float4*)o = make_float4(o1[0], o1[1], o1[2], o1[3]); *(float4*)(o + 32) = make_float4(o2[0], o2[1], o2[2], o2[3]); }
            }
        }
    }
}

#define SSD_CH 32
__device__ __forceinline__ void ph_ssd_naive(float* lds, const float* __restrict__ xbc_act, const float* __restrict__ dtv, const float* __restrict__ a_log,
                                             const float* __restrict__ d_skip, const float* __restrict__ state_ssm, float* __restrict__ ybuf, float* __restrict__ out) {
    float (*sx)[64] = (float (*)[64])lds;
    float (*sB)[128] = (float (*)[128])(lds + SSD_CH * 64);
    float (*sC)[128] = (float (*)[128])(lds + SSD_CH * 64 + SSD_CH * 128);
    float* sdt = lds + SSD_CH * 64 + 2 * SSD_CH * 128;
    const int tid = threadIdx.x, p = tid >> 3, ng = tid & 7;
    for (int vb = BATCH * SSD_HEADS + blockIdx.x; vb < (BATCH + DEC_BATCH) * SSD_HEADS; vb += gridDim.x) {
        const int seq = vb / SSD_HEADS, h = vb % SSD_HEADS, g = h / 6;
        const bool is_p = seq < BATCH;
        const int L = is_p ? SEQ : DEC_SEQ;
        const int t0 = is_p ? seq * SEQ : T_PROMPT + (seq - BATCH) * DEC_SEQ;
        const float A = -__expf(a_log[h]);
        const float D = d_skip[h];
        float hs[16];
        if (is_p) {
#pragma unroll
            for (int j = 0; j < 16; ++j) hs[j] = 0.f;
        } else {
            const float* s0 = state_ssm + (((size_t)(seq - BATCH) * SSD_HEADS + h) * 64 + p) * 128 + ng * 16;
#pragma unroll
            for (int j = 0; j < 16; ++j) hs[j] = s0[j];
        }
        for (int c0 = 0; c0 < L; c0 += SSD_CH) {
            const int nst = (L - c0) < SSD_CH ? (L - c0) : SSD_CH;
            __syncthreads();
            for (int idx = tid; idx < nst * 64; idx += NTHR) { int s = idx >> 6, c = idx & 63; sx[s][c] = xbc_act[(size_t)(t0 + c0 + s) * CONV_DIM + h * 64 + c]; }
            for (int idx = tid; idx < nst * 128; idx += NTHR) { int s = idx >> 7, c = idx & 127;
                sB[s][c] = xbc_act[(size_t)(t0 + c0 + s) * CONV_DIM + 1536 + g * 128 + c];
                sC[s][c] = xbc_act[(size_t)(t0 + c0 + s) * CONV_DIM + 2048 + g * 128 + c]; }
            if (tid < nst) sdt[tid] = dtv[(size_t)(t0 + c0 + tid) * SSD_HEADS + h];
            __syncthreads();
            for (int s = 0; s < nst; ++s) {
                const float dt = sdt[s], x = sx[s][p];
                const float a = __expf(dt * A), xdt = x * dt;
                float y = 0.f;
#pragma unroll
                for (int j = 0; j < 16; ++j) { hs[j] = a * hs[j] + xdt * sB[s][ng * 16 + j]; y += sC[s][ng * 16 + j] * hs[j]; }
                y += __shfl_xor(y, 1); y += __shfl_xor(y, 2); y += __shfl_xor(y, 4);
                if (ng == 0) ybuf[(size_t)(t0 + c0 + s) * MIX_WIDTH + h * 64 + p] = y + D * x;
            }
        }
        float* so = is_p ? out + OUT_PS + (((size_t)seq * SSD_HEADS + h) * 64 + p) * 128 + ng * 16
                         : out + OUT_SS + (((size_t)(seq - BATCH) * SSD_HEADS + h) * 64 + p) * 128 + ng * 16;
#pragma unroll
        for (int j = 0; j < 16; ++j) so[j] = hs[j];
    }
}

__device__ __forceinline__ void ph_gate_norm(const float* __restrict__ proj, const float* __restrict__ norm_g, const float* __restrict__ ybuf, bf16* __restrict__ A1) {
    const int w = threadIdx.x >> 6, lane = threadIdx.x & 63, g = w & 3;
    for (int t = T_PROMPT + 2 * blockIdx.x + (w >> 2); t < T_ALL; t += 2 * gridDim.x) {
        {
        float v[6]; float ss = 0.f;
#pragma unroll
        for (int j = 0; j < 6; ++j) {
            int c = g * 384 + j * 64 + lane;
            float y = ybuf[(size_t)t * MIX_WIDTH + c], z = proj[(size_t)t * PROJ_LD + O_Z + c];
            v[j] = y * silu_f(z); ss += v[j] * v[j];
        }
        ss = wave_sum(ss);
        const float r = rsqrtf(ss * (1.0f / 384.0f) + LN_EPS);
#pragma unroll
        for (int j = 0; j < 6; ++j) { int c = g * 384 + j * 64 + lane; A1[(size_t)t * MIX_WIDTH + c] = (bf16)f2bf(v[j] * r * norm_g[c]); }
        }
#pragma unroll
        for (int j = 0; j < 2; ++j) { int c = SSD_WIDTH + g * 128 + j * 64 + lane; A1[(size_t)t * MIX_WIDTH + c] = (bf16)f2bf(ybuf[(size_t)t * MIX_WIDTH + c]); }
    }
}

__device__ __forceinline__ void ph_attn_naive(float* lds, const float* __restrict__ proj, const float* __restrict__ qrot, const float* __restrict__ krot,
                                              const float* __restrict__ ck, const float* __restrict__ cv, float* __restrict__ ybuf) {
    float (*sq)[64] = (float (*)[64])lds;
    const int w = threadIdx.x >> 6, lane = threadIdx.x & 63;
    for (int vb = blockIdx.x; vb < T_SAMPLE * 8 / NWAVE; vb += gridDim.x) {
        const int item = T_PROMPT * 8 + vb * NWAVE + w;
        const int t = item >> 3, h = item & 7;
        const bool is_p = t < T_PROMPT;
        int b, i;
        if (is_p) { b = t / SEQ; i = t % SEQ; } else { int ts = t - T_PROMPT; b = ts / DEC_SEQ; i = ts % DEC_SEQ; }
        __syncthreads();
        sq[w][lane] = qrot[(size_t)t * ATT_WIDTH + h * 64 + lane];
        __syncthreads();
        const int qi = is_p ? i : WBUF + i;
        float sc[3][3];
        float mx = -INFINITY;
#pragma unroll
        for (int pt = 0; pt < 3; ++pt) {
            const int d = pt == 0 ? 1 : (pt == 1 ? 4 : 16);
#pragma unroll
            for (int sl = 0; sl < 3; ++sl) {
                const int m = lane + sl * 64;
                float s = -INFINITY;
                const int kj = qi - d * m;
                if (m <= 128 && kj >= 0) {
                    const float* kr;
                    if (is_p) kr = krot + (size_t)(b * SEQ + kj) * ATT_WIDTH + h * 64;
                    else kr = (kj >= WBUF) ? krot + (size_t)(T_PROMPT + b * DEC_SEQ + (kj - WBUF)) * ATT_WIDTH + h * 64
                                           : ck + ((size_t)b * WBUF + kj) * ATT_WIDTH + h * 64;
                    float a = 0.f;
#pragma unroll
                    for (int c = 0; c < 64; c += 4) { float4 kv = *(const float4*)(kr + c); a += kv.x * sq[w][c] + kv.y * sq[w][c + 1] + kv.z * sq[w][c + 2] + kv.w * sq[w][c + 3]; }
                    s = a * 0.125f;
                }
                sc[pt][sl] = s; mx = fmaxf(mx, s);
            }
        }
        mx = wave_max(mx);
        float lsum = 0.f;
#pragma unroll
        for (int pt = 0; pt < 3; ++pt)
#pragma unroll
            for (int sl = 0; sl < 3; ++sl) { float pv = (sc[pt][sl] == -INFINITY) ? 0.f : __expf(sc[pt][sl] - mx); sc[pt][sl] = pv; lsum += pv; }
        lsum = wave_sum(lsum);
        float o = 0.f;
#pragma unroll
        for (int pt = 0; pt < 3; ++pt) {
            const int d = pt == 0 ? 1 : (pt == 1 ? 4 : 16);
#pragma unroll
            for (int sl = 0; sl < 3; ++sl) {
                const int mend = sl < 2 ? 64 : 1;
                for (int ml = 0; ml < mend; ++ml) {
                    const int m = ml + sl * 64;
                    const int kj = qi - d * m;
                    const float pv = __shfl(sc[pt][sl], ml);
                    if (kj < 0) continue;
                    const float* vr;
                    if (is_p) vr = proj + (size_t)(b * SEQ + kj) * PROJ_LD + O_V + h * 64;
                    else vr = (kj >= WBUF) ? proj + (size_t)(T_PROMPT + b * DEC_SEQ + (kj - WBUF)) * PROJ_LD + O_V + h * 64
                                           : cv + ((size_t)b * WBUF + kj) * ATT_WIDTH + h * 64;
                    o += pv * vr[lane];
                }
            }
        }
        ybuf[(size_t)t * MIX_WIDTH + SSD_WIDTH + h * 64 + lane] = o / lsum;
    }
}

__device__ __forceinline__ void ph_ln_res(const float* __restrict__ res, const float* __restrict__ add, const float* __restrict__ gam,
                                          const float* __restrict__ bet, float* __restrict__ dst, bf16* __restrict__ dstb) {
    const int lane = threadIdx.x & 63;
    for (int t = blockIdx.x * NWAVE + (threadIdx.x >> 6); t < T_ALL; t += gridDim.x * NWAVE) {
        float v[16]; float s = 0.f;
#pragma unroll
        for (int j = 0; j < 16; ++j) { int c = j * 64 + lane; v[j] = ALPHA_F * res[(size_t)t * D_MODEL + c] + add[(size_t)t * D_MODEL + c]; s += v[j]; }
        s = wave_sum(s);
        const float mu = s * (1.0f / 1024.0f);
        float q = 0.f;
#pragma unroll
        for (int j = 0; j < 16; ++j) { v[j] -= mu; q += v[j] * v[j]; }
        q = wave_sum(q);
        const float r = rsqrtf(q * (1.0f / 1024.0f) + LN_EPS);
#pragma unroll
        for (int j = 0; j < 16; ++j) { int c = j * 64 + lane; float o = v[j] * r * gam[c] + bet[c]; dst[(size_t)t * D_MODEL + c] = o; dstb[(size_t)t * D_MODEL + c] = (bf16)f2bf(o); }
    }
}

__device__ __forceinline__ void ph_peer_route(float* lds, const float* __restrict__ qh, const float* __restrict__ keys1, const float* __restrict__ keys2,
                                              int* __restrict__ eidx, float* __restrict__ gate) {
    float (*sq)[256] = (float (*)[256])lds;
    float (*sv)[2][16] = (float (*)[2][16])(lds + NWAVE * 256);
    int (*si)[2][16] = (int (*)[2][16])(lds + NWAVE * 256 + NWAVE * 32);
    const int w = threadIdx.x >> 6, lane = threadIdx.x & 63;
    for (int vb = blockIdx.x; vb < T_ALL * 8 / NWAVE; vb += gridDim.x) {
        const int item = vb * NWAVE + w;
        const int t = item >> 3, h = item & 7;
        __syncthreads();
        for (int c = lane; c < 256; c += 64) sq[w][c] = qh[(size_t)t * 2048 + h * 256 + c];
        __syncthreads();
#pragma unroll
        for (int half = 0; half < 2; ++half) {
            const float* keys = half ? keys2 : keys1;
            float s[2];
#pragma unroll
            for (int sl = 0; sl < 2; ++sl) {
                const float* kr = keys + (size_t)(lane + sl * 64) * 128;
                float a = 0.f;
#pragma unroll 8
                for (int c = 0; c < 128; c += 4) { float4 kv = *(const float4*)(kr + c); const float* qq = &sq[w][half * 128 + c]; a += kv.x * qq[0] + kv.y * qq[1] + kv.z * qq[2] + kv.w * qq[3]; }
                s[sl] = a;
            }
            for (int r = 0; r < 16; ++r) {
                float bv; int bi;
                if (s[0] >= s[1]) { bv = s[0]; bi = lane; } else { bv = s[1]; bi = lane + 64; }
#pragma unroll
                for (int o = 32; o > 0; o >>= 1) {
                    float ov = __shfl_xor(bv, o); int oi = __shfl_xor(bi, o);
                    if (ov > bv || (ov == bv && oi < bi)) { bv = ov; bi = oi; }
                }
                if (lane == 0) { sv[w][half][r] = bv; si[w][half][r] = bi; }
                if (bi == lane) s[0] = -INFINITY;
                if (bi == lane + 64) s[1] = -INFINITY;
            }
        }
        __syncthreads();
        float c[4];
#pragma unroll
        for (int j = 0; j < 4; ++j) { int ci = lane * 4 + j; c[j] = sv[w][0][ci >> 4] + sv[w][1][ci & 15]; }
        float myv = 0.f; int myc = 0;
        for (int r = 0; r < 16; ++r) {
            float bv = c[0]; int bi = lane * 4;
#pragma unroll
            for (int j = 1; j < 4; ++j) if (c[j] > bv) { bv = c[j]; bi = lane * 4 + j; }
#pragma unroll
            for (int o = 32; o > 0; o >>= 1) {
                float ov = __shfl_xor(bv, o); int oi = __shfl_xor(bi, o);
                if (ov > bv || (ov == bv && oi < bi)) { bv = ov; bi = oi; }
            }
            if (lane == r) { myv = bv; myc = bi; }
#pragma unroll
            for (int j = 0; j < 4; ++j) if (bi == lane * 4 + j) c[j] = -INFINITY;
        }
        float v = lane < 16 ? myv : -INFINITY;
        float mx = wave_max(v);
        float e = lane < 16 ? __expf(v - mx) : 0.f;
        float sum = wave_sum(e);
        if (lane < 16) {
            int ex = si[w][0][myc >> 4] * PEER_NKEYS + si[w][1][myc & 15];
            eidx[(size_t)t * 128 + h * 16 + lane] = ex;
            gate[(size_t)t * 128 + h * 16 + lane] = e / sum;
        }
    }
}

__device__ __forceinline__ void ph_peer_ffn(const float* __restrict__ hbuf, const int* __restrict__ eidx, const float* __restrict__ gate,
                                            const bf16* __restrict__ ub, const bf16* __restrict__ vb, const float* __restrict__ gam,
                                            const float* __restrict__ bet, float* __restrict__ out) {
    const int lane = threadIdx.x & 63;
    for (int t = blockIdx.x * NWAVE + (threadIdx.x >> 6); t < T_ALL; t += gridDim.x * NWAVE) {
        float x[16], acc[16];
        { const float* xr = hbuf + (size_t)t * D_MODEL + lane * 8;
          const float4 a = *(const float4*)xr, b = *(const float4*)(xr + 4), c = *(const float4*)(xr + 512), d = *(const float4*)(xr + 516);
          x[0] = a.x; x[1] = a.y; x[2] = a.z; x[3] = a.w; x[4] = b.x; x[5] = b.y; x[6] = b.z; x[7] = b.w;
          x[8] = c.x; x[9] = c.y; x[10] = c.z; x[11] = c.w; x[12] = d.x; x[13] = d.y; x[14] = d.z; x[15] = d.w; }
#pragma unroll
        for (int j = 0; j < 16; ++j) acc[j] = 0.f;
        for (int k = 0; k < 128; ++k) {
            const int e = eidx[(size_t)t * 128 + k];
            const float g = gate[(size_t)t * 128 + k];
            const bf16* ur = ub + (size_t)e * D_MODEL + lane * 8;
            float u0[8], u1[8];
            unpack8(*(const v4u*)ur, u0); unpack8(*(const v4u*)(ur + 512), u1);
            float d = 0.f;
#pragma unroll
            for (int j = 0; j < 8; ++j) d += u0[j] * x[j] + u1[j] * x[8 + j];
            d = wave_sum(d);
            const float wgt = g * gelu_f(d);
            const bf16* vr = vb + (size_t)e * D_MODEL + lane * 8;
            unpack8(*(const v4u*)vr, u0); unpack8(*(const v4u*)(vr + 512), u1);
#pragma unroll
            for (int j = 0; j < 8; ++j) { acc[j] += wgt * u0[j]; acc[8 + j] += wgt * u1[j]; }
        }
        float s = 0.f;
#pragma unroll
        for (int j = 0; j < 16; ++j) { acc[j] += ALPHA_F * x[j]; s += acc[j]; }
        s = wave_sum(s);
        const float mu = s * (1.0f / 1024.0f);
        float q = 0.f;
#pragma unroll
        for (int j = 0; j < 16; ++j) { acc[j] -= mu; q += acc[j] * acc[j]; }
        q = wave_sum(q);
        const float r = rsqrtf(q * (1.0f / 1024.0f) + LN_EPS);
        float* dst = ((t < T_PROMPT) ? out + OUT_YP + (size_t)t * D_MODEL : out + OUT_YS + (size_t)(t - T_PROMPT) * D_MODEL) + lane * 8;
#pragma unroll
        for (int q4 = 0; q4 < 4; ++q4) {
            const int eo = (q4 >> 1) * 512 + (q4 & 1) * 4;
            const float4 g4 = *(const float4*)(gam + lane * 8 + eo), b4 = *(const float4*)(bet + lane * 8 + eo);
            float4 o; o.x = acc[q4 * 4 + 0] * r * g4.x + b4.x; o.y = acc[q4 * 4 + 1] * r * g4.y + b4.y; o.z = acc[q4 * 4 + 2] * r * g4.z + b4.z; o.w = acc[q4 * 4 + 3] * r * g4.w + b4.w;
            *(float4*)(dst + eo) = o;
        }
    }
}

__device__ __forceinline__ float peer_dot16(const v4u a, const v4u b, const float (&x)[16]) {
    float u0[8], u1[8]; unpack8(a, u0); unpack8(b, u1);
    float d = 0.f;
#pragma unroll
    for (int j = 0; j < 8; ++j) d += u0[j] * x[j] + u1[j] * x[8 + j];
    return d;
}
#define PEER_TR_STEP(N, M) _Pragma("unroll") for (int i = 0; i < N; ++i) { const bool up = (lane & M) != 0; const float keep = up ? part[i + N] : part[i]; const float send = up ? part[i] : part[i + N]; part[i] = keep + __shfl_xor(send, M); }
__device__ __forceinline__ void ph_peer_ffn2(const float* __restrict__ hbuf, const int* __restrict__ eidx, const float* __restrict__ gate,
                                             const bf16* __restrict__ ub, const bf16* __restrict__ vb, const float* __restrict__ gam,
                                             const float* __restrict__ bet, float* __restrict__ out) {
    const int lane0 = threadIdx.x & 63;
    for (int t = blockIdx.x * NWAVE + (threadIdx.x >> 6); t < T_ALL; t += gridDim.x * NWAVE) {
        int lane = lane0; asm volatile("" : "+v"(lane));
        float x[16];
        { const float* xr = hbuf + (size_t)t * D_MODEL + lane * 8;
          const float4 a = *(const float4*)xr, b = *(const float4*)(xr + 4), c = *(const float4*)(xr + 512), d = *(const float4*)(xr + 516);
          x[0] = a.x; x[1] = a.y; x[2] = a.z; x[3] = a.w; x[4] = b.x; x[5] = b.y; x[6] = b.z; x[7] = b.w;
          x[8] = c.x; x[9] = c.y; x[10] = c.z; x[11] = c.w; x[12] = d.x; x[13] = d.y; x[14] = d.z; x[15] = d.w; }
        int ev[2]; float wv[4];
        ev[0] = eidx[(size_t)t * 128 + lane]; ev[1] = eidx[(size_t)t * 128 + 64 + lane];
#pragma unroll
        for (int rd = 0; rd < 4; ++rd) wv[rd] = gate[(size_t)t * 128 + rd * 32 + (lane >> 1)];
#pragma unroll
        for (int rd = 0; rd < 4; ++rd) {
            float part[32];
#pragma unroll
            for (int kb = 0; kb < 8; ++kb) {
                v4u ra[4], rb[4];
#pragma unroll
                for (int k8 = 0; k8 < 4; ++k8) {
                    const int e = __builtin_amdgcn_readlane(ev[rd >> 1], (rd & 1) * 32 + kb * 4 + k8);
                    const bf16* ur = ub + (size_t)e * D_MODEL + lane * 8;
                    ra[k8] = *(const v4u*)ur; rb[k8] = *(const v4u*)(ur + 512);
                }
#pragma unroll
                for (int k8 = 0; k8 < 4; ++k8) part[kb * 4 + k8] = peer_dot16(ra[k8], rb[k8], x);
            }
            PEER_TR_STEP(16, 32) PEER_TR_STEP(8, 16) PEER_TR_STEP(4, 8) PEER_TR_STEP(2, 4) PEER_TR_STEP(1, 2)
            const float hid = part[0] + __shfl_xor(part[0], 1);
            wv[rd] *= gelu_f(hid);
        }
        float acc[16];
#pragma unroll
        for (int j = 0; j < 16; ++j) acc[j] = 0.f;
#pragma unroll
        for (int rd = 0; rd < 4; ++rd) {
#pragma unroll
            for (int kb = 0; kb < 4; ++kb) {
                v4u ra[8], rb[8];
#pragma unroll
                for (int k8 = 0; k8 < 8; ++k8) {
                    const int e = __builtin_amdgcn_readlane(ev[rd >> 1], (rd & 1) * 32 + kb * 8 + k8);
                    const bf16* vr = vb + (size_t)e * D_MODEL + lane * 8;
                    ra[k8] = *(const v4u*)vr; rb[k8] = *(const v4u*)(vr + 512);
                }
#pragma unroll
                for (int k8 = 0; k8 < 8; ++k8) {
                    const float wk = __builtin_bit_cast(float, __builtin_amdgcn_readlane(__builtin_bit_cast(int, wv[rd]), 2 * (kb * 8 + k8)));
                    float u0[8], u1[8]; unpack8(ra[k8], u0); unpack8(rb[k8], u1);
#pragma unroll
                    for (int j = 0; j < 8; ++j) { acc[j] += wk * u0[j]; acc[8 + j] += wk * u1[j]; }
                }
            }
        }
        float s = 0.f;
#pragma unroll
        for (int j = 0; j < 16; ++j) { acc[j] += ALPHA_F * x[j]; s += acc[j]; }
        s = wave_sum(s);
        const float mu = s * (1.0f / 1024.0f);
        float q = 0.f;
#pragma unroll
        for (int j = 0; j < 16; ++j) { acc[j] -= mu; q += acc[j] * acc[j]; }
        q = wave_sum(q);
        const float r = rsqrtf(q * (1.0f / 1024.0f) + LN_EPS);
        float* dst = ((t < T_PROMPT) ? out + OUT_YP + (size_t)t * D_MODEL : out + OUT_YS + (size_t)(t - T_PROMPT) * D_MODEL) + lane * 8;
#pragma unroll
        for (int q4 = 0; q4 < 4; ++q4) {
            const int eo = (q4 >> 1) * 512 + (q4 & 1) * 4;
            const float4 g4 = *(const float4*)(gam + lane * 8 + eo), b4 = *(const float4*)(bet + lane * 8 + eo);
            float4 o; o.x = acc[q4 * 4 + 0] * r * g4.x + b4.x; o.y = acc[q4 * 4 + 1] * r * g4.y + b4.y; o.z = acc[q4 * 4 + 2] * r * g4.z + b4.z; o.w = acc[q4 * 4 + 3] * r * g4.w + b4.w;
            *(float4*)(dst + eo) = o;
        }
    }
}

typedef float f32x16 __attribute__((ext_vector_type(16)));
typedef short s16x8 __attribute__((ext_vector_type(8)));
typedef short s16x4 __attribute__((ext_vector_type(4)));
typedef float f32x4v __attribute__((ext_vector_type(4)));
#define SSD_L_ACS 0
#define SSD_L_DTS 3072
#define SSD_L_BM 6144
#define SSD_RS_B 272
#define SSD_L_X (6144 + 128 * 272)
#define SSD_RS_X 144
#define SSD_XIMG (128 * 144)
#define SSD_RS_Y 784
template <int OFF0, int OFF1>
__device__ __forceinline__ s16x8 tr_frag(unsigned base) {
    s16x4 a, b;
    asm volatile("ds_read_b64_tr_b16 %0, %2 offset:%3\n\tds_read_b64_tr_b16 %1, %2 offset:%4\n\ts_waitcnt lgkmcnt(0)"
                 : "=&v"(a), "=&v"(b) : "v"(base), "n"(OFF0), "n"(OFF1) : "memory");
    return __builtin_shufflevector(a, b, 0, 1, 2, 3, 4, 5, 6, 7);
}
__device__ __forceinline__ unsigned lds_addr(LAS unsigned char* p) { return (unsigned)(size_t)p; }

__device__ __forceinline__ void ssd_chunk_acs(LAS unsigned char* ldsb, const float* __restrict__ dtv, const float* __restrict__ a_log, int t0, int g, float* cdec_out) {
    const int w = __builtin_amdgcn_readfirstlane(threadIdx.x >> 6), lane = threadIdx.x & 63;
    if (w < 6) {
        const int head = 6 * g + w;
        const float A = -__expf(a_log[head]);
        const float v0 = dtv[(size_t)(t0 + 2 * lane) * SSD_HEADS + head], v1 = dtv[(size_t)(t0 + 2 * lane + 1) * SSD_HEADS + head];
        const float a1 = v1 * A;
        float s = v0 * A + a1;
#pragma unroll
        for (int o = 1; o < 64; o <<= 1) { const float tmp = __shfl_up(s, o); if (lane >= o) s += tmp; }
        LAS float* acs = (LAS float*)(ldsb + SSD_L_ACS) + w * 128;
        LAS float* dts = (LAS float*)(ldsb + SSD_L_DTS) + w * 128;
        acs[2 * lane] = s - a1; acs[2 * lane + 1] = s;
        dts[2 * lane] = v0; dts[2 * lane + 1] = v1;
        if (cdec_out && lane == 63) cdec_out[head] = __expf(s);
    }
}

__device__ __forceinline__ void ph_ssd_states(LAS unsigned char* ldsb, const bf16* __restrict__ xbc_b, const float* __restrict__ dtv, const float* __restrict__ a_log,
                                              bf16* __restrict__ Sbuf, float* __restrict__ cdec) {
    const int tid = threadIdx.x, w = __builtin_amdgcn_readfirstlane(tid >> 6), lane = tid & 63;
    const int r = lane & 31, h = lane >> 5, blk = (lane >> 4) & 1, q = (lane & 15) >> 2, pp = lane & 3;
    const int nt = w & 3, pt = w >> 2;
    for (int unit = blockIdx.x; unit < BATCH * 64 * SSD_GROUPS; unit += gridDim.x) {
        const int g = unit & 3, bc = unit >> 2;
        const int t0 = bc * 128;
        __syncthreads();
        ssd_chunk_acs(ldsb, dtv, a_log, t0, g, cdec + (size_t)bc * SSD_HEADS);
        for (int idx = tid; idx < 2048; idx += NTHR) { const int row = idx >> 4, ch = idx & 15;
            const v4u v = *(const v4u*)(xbc_b + (size_t)(t0 + row) * CONV_DIM + 1536 + 128 * g + ch * 8);
            *(LAS v4u*)(ldsb + SSD_L_BM + row * SSD_RS_B + ch * 16) = v; }
        __syncthreads();
        for (int idx = tid; idx < 6144; idx += NTHR) { const int hh = idx >> 10, rem = idx & 1023, row = rem >> 3, ch = rem & 7;
            const LAS float* acs = (const LAS float*)(ldsb + SSD_L_ACS) + hh * 128; const LAS float* dts = (const LAS float*)(ldsb + SSD_L_DTS) + hh * 128;
            const float wgt = dts[row] * __expf(acs[127] - acs[row]);
            float f[8]; unpack8(*(const v4u*)(xbc_b + (size_t)(t0 + row) * CONV_DIM + (6 * g + hh) * 64 + ch * 8), f);
            v4u o; o.x = pk2(f[0] * wgt, f[1] * wgt); o.y = pk2(f[2] * wgt, f[3] * wgt); o.z = pk2(f[4] * wgt, f[5] * wgt); o.w = pk2(f[6] * wgt, f[7] * wgt);
            *(LAS v4u*)(ldsb + SSD_L_X + hh * SSD_XIMG + row * SSD_RS_X + ch * 16) = o; }
        __syncthreads();
        const unsigned abase = lds_addr(ldsb + SSD_L_BM) + (8 * h + q) * SSD_RS_B + (32 * nt + 16 * blk + 4 * pp) * 2;
        s16x8 afr[8];
        afr[0] = tr_frag<0 * 16 * SSD_RS_B, (0 * 16 + 4) * SSD_RS_B>(abase); afr[1] = tr_frag<1 * 16 * SSD_RS_B, (1 * 16 + 4) * SSD_RS_B>(abase);
        afr[2] = tr_frag<2 * 16 * SSD_RS_B, (2 * 16 + 4) * SSD_RS_B>(abase); afr[3] = tr_frag<3 * 16 * SSD_RS_B, (3 * 16 + 4) * SSD_RS_B>(abase);
        afr[4] = tr_frag<4 * 16 * SSD_RS_B, (4 * 16 + 4) * SSD_RS_B>(abase); afr[5] = tr_frag<5 * 16 * SSD_RS_B, (5 * 16 + 4) * SSD_RS_B>(abase);
        afr[6] = tr_frag<6 * 16 * SSD_RS_B, (6 * 16 + 4) * SSD_RS_B>(abase); afr[7] = tr_frag<7 * 16 * SSD_RS_B, (7 * 16 + 4) * SSD_RS_B>(abase);
#pragma unroll
        for (int hh = 0; hh < 6; ++hh) {
            const unsigned xb = lds_addr(ldsb + SSD_L_X + hh * SSD_XIMG) + (8 * h + q) * SSD_RS_X + (32 * pt + 16 * blk + 4 * pp) * 2;
            f32x16 acc;
#pragma unroll
            for (int i = 0; i < 16; ++i) acc[i] = 0.f;
            acc = __builtin_amdgcn_mfma_f32_32x32x16_bf16(afr[0], tr_frag<0 * 16 * SSD_RS_X, (0 * 16 + 4) * SSD_RS_X>(xb), acc, 0, 0, 0);
            acc = __builtin_amdgcn_mfma_f32_32x32x16_bf16(afr[1], tr_frag<1 * 16 * SSD_RS_X, (1 * 16 + 4) * SSD_RS_X>(xb), acc, 0, 0, 0);
            acc = __builtin_amdgcn_mfma_f32_32x32x16_bf16(afr[2], tr_frag<2 * 16 * SSD_RS_X, (2 * 16 + 4) * SSD_RS_X>(xb), acc, 0, 0, 0);
            acc = __builtin_amdgcn_mfma_f32_32x32x16_bf16(afr[3], tr_frag<3 * 16 * SSD_RS_X, (3 * 16 + 4) * SSD_RS_X>(xb), acc, 0, 0, 0);
            acc = __builtin_amdgcn_mfma_f32_32x32x16_bf16(afr[4], tr_frag<4 * 16 * SSD_RS_X, (4 * 16 + 4) * SSD_RS_X>(xb), acc, 0, 0, 0);
            acc = __builtin_amdgcn_mfma_f32_32x32x16_bf16(afr[5], tr_frag<5 * 16 * SSD_RS_X, (5 * 16 + 4) * SSD_RS_X>(xb), acc, 0, 0, 0);
            acc = __builtin_amdgcn_mfma_f32_32x32x16_bf16(afr[6], tr_frag<6 * 16 * SSD_RS_X, (6 * 16 + 4) * SSD_RS_X>(xb), acc, 0, 0, 0);
            acc = __builtin_amdgcn_mfma_f32_32x32x16_bf16(afr[7], tr_frag<7 * 16 * SSD_RS_X, (7 * 16 + 4) * SSD_RS_X>(xb), acc, 0, 0, 0);
            bf16* dst = Sbuf + (((size_t)bc * SSD_HEADS + 6 * g + hh) * 64 + 32 * pt + r) * 128 + 32 * nt + 4 * h;
#pragma unroll
            for (int q4 = 0; q4 < 4; ++q4) *(uint2*)(dst + 8 * q4) = make_uint2(pk2(acc[4 * q4], acc[4 * q4 + 1]), pk2(acc[4 * q4 + 2], acc[4 * q4 + 3]));
        }
    }
}

__device__ __forceinline__ void ph_ssd_scan(const bf16* __restrict__ Sbuf, const float* __restrict__ cdec, bf16* __restrict__ Hin, float* __restrict__ out) {
    for (int idx = blockIdx.x * NTHR + threadIdx.x; idx < BATCH * SSD_HEADS * 64 * 16; idx += gridDim.x * NTHR) {
        const int n8 = idx & 15, p = (idx >> 4) & 63, hb = idx >> 10, hd = hb % SSD_HEADS, b = hb / SSD_HEADS;
        float st[8];
#pragma unroll
        for (int j = 0; j < 8; ++j) st[j] = 0.f;
#pragma unroll 8
        for (int c = 0; c < 64; ++c) {
            const size_t base = ((((size_t)(b * 64 + c)) * SSD_HEADS + hd) * 64 + p) * 128 + n8 * 8;
            v4u o; o.x = pk2(st[0], st[1]); o.y = pk2(st[2], st[3]); o.z = pk2(st[4], st[5]); o.w = pk2(st[6], st[7]);
            *(v4u*)(Hin + base) = o;
            float s[8]; unpack8(*(const v4u*)(Sbuf + base), s);
            const float a = cdec[(size_t)(b * 64 + c) * SSD_HEADS + hd];
#pragma unroll
            for (int j = 0; j < 8; ++j) st[j] = a * st[j] + s[j];
        }
        store8f(out + OUT_PS + (((size_t)b * SSD_HEADS + hd) * 64 + p) * 128 + n8 * 8, st);
    }
}

__device__ __forceinline__ void ph_ssd_out(LAS unsigned char* ldsb, const bf16* __restrict__ xbc_b, const bf16* __restrict__ projb, const float* __restrict__ dtv,
                                           const float* __restrict__ a_log, const float* __restrict__ d_skip, const float* __restrict__ norm_g,
                                           const bf16* __restrict__ Hin, bf16* __restrict__ A1) {
    const int tid = threadIdx.x, w = __builtin_amdgcn_readfirstlane(tid >> 6), lane = tid & 63;
    const int r = lane & 31, h = lane >> 5, blk = (lane >> 4) & 1, q = (lane & 15) >> 2, pp = lane & 3;
    const int lt = w & 3, hs = w >> 2;
    for (int unit = blockIdx.x; unit < BATCH * 64 * SSD_GROUPS; unit += gridDim.x) {
        const int g = unit & 3, bc = unit >> 2;
        const int t0 = bc * 128;
        __syncthreads();
        ssd_chunk_acs(ldsb, dtv, a_log, t0, g, nullptr);
        for (int idx = tid; idx < 2048; idx += NTHR) { const int row = idx >> 4, ch = idx & 15;
            const v4u v = *(const v4u*)(xbc_b + (size_t)(t0 + row) * CONV_DIM + 1536 + 128 * g + ch * 8);
            *(LAS v4u*)(ldsb + SSD_L_BM + row * SSD_RS_B + ch * 16) = v; }
        for (int idx = tid; idx < 6144; idx += NTHR) { const int hh = idx >> 10, rem = idx & 1023, row = rem >> 3, ch = rem & 7;
            const v4u v = *(const v4u*)(xbc_b + (size_t)(t0 + row) * CONV_DIM + (6 * g + hh) * 64 + ch * 8);
            *(LAS v4u*)(ldsb + SSD_L_X + hh * SSD_XIMG + row * SSD_RS_X + ch * 16) = v; }
        __syncthreads();
        const bf16* cp = xbc_b + (size_t)(t0 + 32 * lt + r) * CONV_DIM + 2048 + 128 * g + 8 * h;
        const int lcol = 32 * lt + r;
        const LAS float* acsb = (const LAS float*)(ldsb + SSD_L_ACS) + 3 * hs * 128; const LAS float* dtsb = (const LAS float*)(ldsb + SSD_L_DTS) + 3 * hs * 128;
        f32x16 y[3][2];
#pragma unroll
        for (int h3 = 0; h3 < 3; ++h3)
#pragma unroll
            for (int i = 0; i < 16; ++i) { y[h3][0][i] = 0.f; y[h3][1][i] = 0.f; }
#pragma unroll 1
        for (int ks = 0; ks < 8; ++ks) {
            const s16x8 cf = *(const s16x8*)(cp + 16 * ks);
#pragma unroll
            for (int h3 = 0; h3 < 3; ++h3) {
                const bf16* hp = Hin + (((size_t)bc * SSD_HEADS + 6 * g + 3 * hs + h3) * 64 + r) * 128 + 8 * h + 16 * ks;
                const s16x8 h0 = *(const s16x8*)hp, h1 = *(const s16x8*)(hp + 32 * 128);
                y[h3][0] = __builtin_amdgcn_mfma_f32_32x32x16_bf16(cf, h0, y[h3][0], 0, 0, 0);
                y[h3][1] = __builtin_amdgcn_mfma_f32_32x32x16_bf16(cf, h1, y[h3][1], 0, 0, 0);
            }
        }
#pragma unroll
        for (int h3 = 0; h3 < 3; ++h3)
#pragma unroll
            for (int q4 = 0; q4 < 4; ++q4) {
                const f32x4v a4 = *(const LAS f32x4v*)(acsb + h3 * 128 + 32 * lt + 8 * q4 + 4 * h);
                const float e0 = __expf(a4[0]), e1 = __expf(a4[1]), e2 = __expf(a4[2]), e3 = __expf(a4[3]);
                y[h3][0][4 * q4] *= e0; y[h3][0][4 * q4 + 1] *= e1; y[h3][0][4 * q4 + 2] *= e2; y[h3][0][4 * q4 + 3] *= e3;
                y[h3][1][4 * q4] *= e0; y[h3][1][4 * q4 + 1] *= e1; y[h3][1][4 * q4 + 2] *= e2; y[h3][1][4 * q4 + 3] *= e3;
            }
        const unsigned xb0 = lds_addr(ldsb + SSD_L_X + 3 * hs * SSD_XIMG) + (4 * h + q) * SSD_RS_X + (16 * blk + 4 * pp) * 2;
        for (int st = 0; st <= lt; ++st) {
            f32x16 cb;
#pragma unroll
            for (int i = 0; i < 16; ++i) cb[i] = 0.f;
#pragma unroll 2
            for (int ks = 0; ks < 8; ++ks) {
                const s16x8 cf = *(const s16x8*)(cp + 16 * ks);
                const s16x8 bfrag = *(const LAS s16x8*)(ldsb + SSD_L_BM + (32 * st + r) * SSD_RS_B + (16 * ks + 8 * h) * 2);
                cb = __builtin_amdgcn_mfma_f32_32x32x16_bf16(bfrag, cf, cb, 0, 0, 0);
            }
#pragma unroll
            for (int h3 = 0; h3 < 3; ++h3) {
                const LAS float* acs = acsb + h3 * 128; const LAS float* dts = dtsb + h3 * 128;
                const float myacs = acs[lcol];
                const float Dh = d_skip[6 * g + 3 * hs + h3];
                const unsigned xb = xb0 + h3 * SSD_XIMG + st * 32 * SSD_RS_X;
#pragma unroll
                for (int kk = 0; kk < 2; ++kk) {
                    const int s0 = 32 * st + 16 * kk + 4 * h;
                    const f32x4v as0 = *(const LAS f32x4v*)(acs + s0), as1 = *(const LAS f32x4v*)(acs + s0 + 8);
                    const f32x4v ds0 = *(const LAS f32x4v*)(dts + s0), ds1 = *(const LAS f32x4v*)(dts + s0 + 8);
                    float wv[8];
#pragma unroll
                    for (int j = 0; j < 8; ++j) {
                        const int s = s0 + 8 * (j >> 2) + (j & 3);
                        const float asj = (j < 4) ? as0[j & 3] : as1[j & 3], dsj = (j < 4) ? ds0[j & 3] : ds1[j & 3];
                        float v = cb[8 * kk + j] * __expf(myacs - asj) * dsj;
                        v = (s <= lcol) ? v : 0.f;
                        v = (s == lcol) ? v + Dh : v;
                        wv[j] = v;
                    }
                    s16x8 afr;
                    { v4u o; o.x = pk2(wv[0], wv[1]); o.y = pk2(wv[2], wv[3]); o.z = pk2(wv[4], wv[5]); o.w = pk2(wv[6], wv[7]); afr = __builtin_bit_cast(s16x8, o); }
                    s16x8 b0, b1;
                    if (kk == 0) { b0 = tr_frag<0, 8 * SSD_RS_X>(xb); b1 = tr_frag<64, 8 * SSD_RS_X + 64>(xb); }
                    else { b0 = tr_frag<16 * SSD_RS_X, 24 * SSD_RS_X>(xb); b1 = tr_frag<16 * SSD_RS_X + 64, 24 * SSD_RS_X + 64>(xb); }
                    y[h3][0] = __builtin_amdgcn_mfma_f32_32x32x16_bf16(afr, b0, y[h3][0], 0, 0, 0);
                    y[h3][1] = __builtin_amdgcn_mfma_f32_32x32x16_bf16(afr, b1, y[h3][1], 0, 0, 0);
                    __builtin_amdgcn_sched_barrier(0);
                }
            }
        }
        __syncthreads();
        {
            LAS unsigned short* yst = (LAS unsigned short*)(ldsb + SSD_L_X);
#pragma unroll
            for (int h3 = 0; h3 < 3; ++h3)
#pragma unroll
                for (int ptile = 0; ptile < 2; ++ptile)
#pragma unroll
                    for (int reg = 0; reg < 16; ++reg) {
                        const int l0 = 32 * lt + (reg & 3) + 8 * (reg >> 2) + 4 * h;
                        const int col = (3 * hs + h3) * 64 + 32 * ptile + r;
                        yst[l0 * (SSD_RS_Y / 2) + col] = (unsigned short)f2bf(y[h3][ptile][reg]);
                    }
        }
        __syncthreads();
#pragma unroll
        for (int pass = 0; pass < 4; ++pass) {
            const int l = 4 * (pass * 8 + w) + (lane >> 4), i16 = lane & 15;
            float gv[3][8]; float ss = 0.f;
#pragma unroll
            for (int k = 0; k < 3; ++k) {
                const int col0 = 24 * i16 + 8 * k;
                float yv[8], zv[8];
                unpack8(*(const LAS v4u*)(ldsb + SSD_L_X + l * SSD_RS_Y + col0 * 2), yv);
                unpack8(*(const v4u*)(projb + (size_t)(t0 + l) * NB_LD + g * 384 + col0), zv);
#pragma unroll
                for (int j = 0; j < 8; ++j) { const float gg = yv[j] * silu_f(zv[j]); gv[k][j] = gg; ss += gg * gg; }
            }
            ss += __shfl_xor(ss, 1); ss += __shfl_xor(ss, 2); ss += __shfl_xor(ss, 4); ss += __shfl_xor(ss, 8);
            const float rstd = rsqrtf(ss * (1.0f / 384.0f) + LN_EPS);
#pragma unroll
            for (int k = 0; k < 3; ++k) {
                const int col0 = g * 384 + 24 * i16 + 8 * k;
                const float4 g0 = *(const float4*)(norm_g + col0), g1 = *(const float4*)(norm_g + col0 + 4);
                v4u o; o.x = pk2(gv[k][0] * rstd * g0.x, gv[k][1] * rstd * g0.y); o.y = pk2(gv[k][2] * rstd * g0.z, gv[k][3] * rstd * g0.w);
                o.z = pk2(gv[k][4] * rstd * g1.x, gv[k][5] * rstd * g1.y); o.w = pk2(gv[k][6] * rstd * g1.z, gv[k][7] * rstd * g1.w);
                *(v4u*)(A1 + (size_t)(t0 + l) * MIX_WIDTH + col0) = o;
            }
        }
    }
}

#define ATT_RS_V 144
#define ATT_VIMG (256 * ATT_RS_V)
#define ATT_PV(KT, S2) { \
        v4u o_; o_.x = pk2(s[KT][8 * S2 + 0], s[KT][8 * S2 + 1]); o_.y = pk2(s[KT][8 * S2 + 2], s[KT][8 * S2 + 3]); \
        o_.z = pk2(s[KT][8 * S2 + 4], s[KT][8 * S2 + 5]); o_.w = pk2(s[KT][8 * S2 + 6], s[KT][8 * S2 + 7]); \
        const s16x8 pf_ = __builtin_bit_cast(s16x8, o_); \
        const s16x8 a0_ = tr_frag<(32 * KT + 16 * S2) * ATT_RS_V, (32 * KT + 16 * S2 + 8) * ATT_RS_V>(vbase); \
        const s16x8 a1_ = tr_frag<(32 * KT + 16 * S2) * ATT_RS_V + 64, (32 * KT + 16 * S2 + 8) * ATT_RS_V + 64>(vbase); \
        o0 = __builtin_amdgcn_mfma_f32_32x32x16_bf16(a0_, pf_, o0, 0, 0, 0); \
        o1 = __builtin_amdgcn_mfma_f32_32x32x16_bf16(a1_, pf_, o1, 0, 0, 0); }
__device__ __forceinline__ void ph_attn_prompt(LAS unsigned char* ldsb, const bf16* __restrict__ qrot_b, const bf16* __restrict__ krot_b, const bf16* __restrict__ projb,
                                               bf16* __restrict__ obuf, float* __restrict__ lsebuf) {
    const int tid = threadIdx.x, w = __builtin_amdgcn_readfirstlane(tid >> 6), lane = tid & 63;
    const int r = lane & 31, h = lane >> 5, blk = (lane >> 4) & 1, q = (lane & 15) >> 2, pp = lane & 3;
    const int qt = w & 3, hsel = w >> 2;
    for (int unit = blockIdx.x; unit < 3 * 512; unit += gridDim.x) {
        const int pat = unit >> 9, rem = unit & 511, hp = rem & 3, rem2 = rem >> 2, b = rem2 >> 6, bk = rem2 & 63;
        const int dsh = 2 * pat, nper = 64 >> dsh, res = bk >> (6 - dsh), nb = bk & (nper - 1);
        const int head = 2 * hp + hsel;
        __syncthreads();
        for (int idx = tid & 255; idx < 2048; idx += 256) {
            const int row = idx >> 3, ch = idx & 7, js = 128 * nb - 128 + row;
            v4u v; v.x = 0u; v.y = 0u; v.z = 0u; v.w = 0u;
            if (js >= 0) v = *(const v4u*)(projb + (size_t)(b * SEQ + (js << dsh) + res) * NB_LD + NB_V + head * 64 + ch * 8);
            *(LAS v4u*)(ldsb + hsel * ATT_VIMG + row * ATT_RS_V + ch * 16) = v;
        }
        const int tq = b * SEQ + ((128 * nb + 32 * qt + r) << dsh) + res;
        s16x8 qf[4];
#pragma unroll
        for (int ks = 0; ks < 4; ++ks) qf[ks] = *(const s16x8*)(qrot_b + (size_t)tq * ATT_WIDTH + head * 64 + 16 * ks + 8 * h);
        f32x16 s[5];
#pragma unroll
        for (int kt = 0; kt < 5; ++kt) {
            int js = 128 * nb + 32 * qt - 128 + 32 * kt + r; js = js < 0 ? 0 : js;
            const bf16* kp = krot_b + (size_t)(b * SEQ + (js << dsh) + res) * ATT_WIDTH + head * 64 + 8 * h;
#pragma unroll
            for (int i = 0; i < 16; ++i) s[kt][i] = 0.f;
#pragma unroll
            for (int ks = 0; ks < 4; ++ks) s[kt] = __builtin_amdgcn_mfma_f32_32x32x16_bf16(*(const s16x8*)(kp + 16 * ks), qf[ks], s[kt], 0, 0, 0);
        }
        float m = -INFINITY;
#pragma unroll
        for (int kt = 0; kt < 5; ++kt) {
            const bool tile_ok = (nb > 0) || (qt + kt >= 4);
#pragma unroll
            for (int reg = 0; reg < 16; ++reg) {
                const int c = (reg & 3) + 8 * (reg >> 2) + 4 * h;
                const bool ok = tile_ok && (kt == 0 ? (c >= r) : (kt == 4 ? (c <= r) : true));
                const float v = ok ? s[kt][reg] * 0.125f : -INFINITY;
                s[kt][reg] = v; m = fmaxf(m, v);
            }
        }
        m = fmaxf(m, __shfl_xor(m, 32));
        float l = 0.f;
#pragma unroll
        for (int kt = 0; kt < 5; ++kt)
#pragma unroll
            for (int reg = 0; reg < 16; ++reg) { const float p = __expf(s[kt][reg] - m); s[kt][reg] = p; l += p; }
        l += __shfl_xor(l, 32);
        __syncthreads();
        f32x16 o0, o1;
#pragma unroll
        for (int i = 0; i < 16; ++i) { o0[i] = 0.f; o1[i] = 0.f; }
        const unsigned vbase = lds_addr(ldsb + hsel * ATT_VIMG) + (32 * qt + 4 * h + q) * ATT_RS_V + (16 * blk + 4 * pp) * 2;
        ATT_PV(0, 0) ATT_PV(0, 1) ATT_PV(1, 0) ATT_PV(1, 1) ATT_PV(2, 0) ATT_PV(2, 1) ATT_PV(3, 0) ATT_PV(3, 1) ATT_PV(4, 0) ATT_PV(4, 1)
        const float inv = 1.0f / l;
        bf16* op = obuf + ((size_t)pat * T_PROMPT + tq) * ATT_WIDTH + head * 64 + 4 * h;
#pragma unroll
        for (int q4 = 0; q4 < 4; ++q4) {
            *(uint2*)(op + 8 * q4) = make_uint2(pk2(o0[4 * q4] * inv, o0[4 * q4 + 1] * inv), pk2(o0[4 * q4 + 2] * inv, o0[4 * q4 + 3] * inv));
            *(uint2*)(op + 32 + 8 * q4) = make_uint2(pk2(o1[4 * q4] * inv, o1[4 * q4 + 1] * inv), pk2(o1[4 * q4 + 2] * inv, o1[4 * q4 + 3] * inv));
        }
        if (h == 0) lsebuf[((size_t)pat * T_PROMPT + tq) * 8 + head] = m + __logf(l);
    }
}
__device__ __forceinline__ void ph_attn_combine(const bf16* __restrict__ obuf, const float* __restrict__ lsebuf, bf16* __restrict__ A1) {
    const int lane = threadIdx.x & 63;
    for (int t = blockIdx.x * NWAVE + (threadIdx.x >> 6); t < T_PROMPT; t += gridDim.x * NWAVE) {
        const int hd = lane >> 3;
        const float l0 = lsebuf[((size_t)0 * T_PROMPT + t) * 8 + hd], l1 = lsebuf[((size_t)1 * T_PROMPT + t) * 8 + hd], l2 = lsebuf[((size_t)2 * T_PROMPT + t) * 8 + hd];
        const float mx = fmaxf(l0, fmaxf(l1, l2));
        const float e0 = __expf(l0 - mx), e1 = __expf(l1 - mx), e2 = __expf(l2 - mx);
        const float inv = 1.0f / (e0 + e1 + e2);
        float a[8], b[8], c[8];
        unpack8(*(const v4u*)(obuf + ((size_t)0 * T_PROMPT + t) * ATT_WIDTH + lane * 8), a);
        unpack8(*(const v4u*)(obuf + ((size_t)1 * T_PROMPT + t) * ATT_WIDTH + lane * 8), b);
        unpack8(*(const v4u*)(obuf + ((size_t)2 * T_PROMPT + t) * ATT_WIDTH + lane * 8), c);
        float o[8];
#pragma unroll
        for (int j = 0; j < 8; ++j) o[j] = (e0 * a[j] + e1 * b[j] + e2 * c[j]) * inv;
        v4u w; w.x = pk2(o[0], o[1]); w.y = pk2(o[2], o[3]); w.z = pk2(o[4], o[5]); w.w = pk2(o[6], o[7]);
        *(v4u*)(A1 + (size_t)t * MIX_WIDTH + SSD_WIDTH + lane * 8) = w;
    }
}

#define RT_RS 272
#define RT_KIMG (128 * RT_RS)
#define RT_LUT (2 * RT_KIMG)
constexpr unsigned char RT_CANDS[64] = {0, 1, 2, 3, 4, 5, 6, 7, 8, 9, 10, 11, 12, 13, 14, 15, 16, 17, 18, 19, 20, 21, 22, 23, 32, 33, 34, 35, 36, 48, 49, 50, 51, 64, 65, 66, 80, 81, 96, 97,
                                        112, 113, 128, 144, 160, 176, 192, 208, 224, 240, 0, 0, 0, 0, 0, 0, 0, 0, 0, 0, 0, 0, 0, 0};
__device__ __forceinline__ unsigned rt_mono(float f) { const unsigned u = __builtin_bit_cast(unsigned, f); return u ^ ((unsigned)((int)u >> 31) | 0x80000000u); }
__device__ __forceinline__ float rt_unmono(unsigned m) { const unsigned u = (m & 0x80000000u) ? (m ^ 0x80000000u) : ~m; return __builtin_bit_cast(float, u); }
#define RT_CE_DESC(a, b) { const unsigned x_ = (a), y_ = (b); (a) = x_ > y_ ? x_ : y_; (b) = x_ > y_ ? y_ : x_; }
#define RT_CE_ASC(a, b) { const unsigned x_ = (a), y_ = (b); (a) = x_ > y_ ? y_ : x_; (b) = x_ > y_ ? x_ : y_; }
__device__ __forceinline__ void rt_sort16(unsigned (&v)[16]) {
#pragma unroll
    for (int k = 2; k <= 16; k <<= 1)
#pragma unroll
        for (int j = k >> 1; j > 0; j >>= 1)
#pragma unroll
            for (int i = 0; i < 16; ++i) { const int l = i ^ j; if (l > i) { if ((i & k) == 0) RT_CE_DESC(v[i], v[l]) else RT_CE_ASC(v[i], v[l]) } }
}
__device__ __forceinline__ void rt_merge16(unsigned (&v)[16]) {
#pragma unroll
    for (int j = 8; j > 0; j >>= 1)
#pragma unroll
        for (int i = 0; i < 16; ++i) { const int l = i ^ j; if (l > i) RT_CE_DESC(v[i], v[l]) }
}
__device__ __forceinline__ void rt_top16(unsigned (&a)[16], const unsigned (&b)[16]) {
#pragma unroll
    for (int i = 0; i < 16; ++i) a[i] = a[i] > b[15 - i] ? a[i] : b[15 - i];
    rt_merge16(a);
}
__device__ __forceinline__ void rt_top16_partner(unsigned (&a)[16]) {
    unsigned b[16];
#pragma unroll
    for (int i = 0; i < 16; ++i) b[i] = (unsigned)__shfl_xor((int)a[i], 32);
    rt_top16(a, b);
}
__device__ __forceinline__ void rt_scores_top16(LAS unsigned char* kimg, const bf16* __restrict__ qp, int r, int h, unsigned (&k0)[16]) {
    f32x16 acc[4];
#pragma unroll
    for (int kt = 0; kt < 4; ++kt)
#pragma unroll
        for (int i = 0; i < 16; ++i) acc[kt][i] = 0.f;
#pragma unroll
    for (int ks = 0; ks < 8; ++ks) {
        const s16x8 qf = *(const s16x8*)(qp + 16 * ks);
#pragma unroll
        for (int kt = 0; kt < 4; ++kt) {
            const s16x8 kf = *(const LAS s16x8*)(kimg + (32 * kt + r) * RT_RS + (16 * ks + 8 * h) * 2);
            acc[kt] = __builtin_amdgcn_mfma_f32_32x32x16_bf16(kf, qf, acc[kt], 0, 0, 0);
        }
    }
    unsigned k1[16], k2[16], k3[16];
#pragma unroll
    for (int reg = 0; reg < 16; ++reg) {
        const unsigned ki = (unsigned)((reg & 3) + 8 * (reg >> 2) + 4 * h);
        k0[reg] = (rt_mono(acc[0][reg]) & 0xFFFFFF80u) | ki;
        k1[reg] = (rt_mono(acc[1][reg]) & 0xFFFFFF80u) | (ki + 32u);
        k2[reg] = (rt_mono(acc[2][reg]) & 0xFFFFFF80u) | (ki + 64u);
        k3[reg] = (rt_mono(acc[3][reg]) & 0xFFFFFF80u) | (ki + 96u);
    }
    rt_sort16(k0); rt_sort16(k1); rt_sort16(k2); rt_sort16(k3);
    rt_top16(k0, k1); rt_top16(k2, k3); rt_top16(k0, k2);
    rt_top16_partner(k0);
}
__device__ __forceinline__ void ph_peer_route2(LAS unsigned char* ldsb, const bf16* __restrict__ qhb, const float* __restrict__ keys1, const float* __restrict__ keys2,
                                               int* __restrict__ eidx, float* __restrict__ gate) {
    const int tid = threadIdx.x, w = __builtin_amdgcn_readfirstlane(tid >> 6), lane = tid & 63, r = lane & 31, h = lane >> 5;
    __syncthreads();
    for (int idx = tid; idx < 2 * 128 * 16; idx += NTHR) {
        const int tb = idx >> 11, rem = idx & 2047, row = rem >> 4, ch = rem & 15;
        const float* sp = (tb ? keys2 : keys1) + row * 128 + ch * 8;
        const float4 a = *(const float4*)sp, b = *(const float4*)(sp + 4);
        v4u o; o.x = pk2(a.x, a.y); o.y = pk2(a.z, a.w); o.z = pk2(b.x, b.y); o.w = pk2(b.z, b.w);
        *(LAS v4u*)(ldsb + tb * RT_KIMG + row * RT_RS + ch * 16) = o;
    }
    __syncthreads();
    LAS unsigned* lut = (LAS unsigned*)(ldsb + RT_LUT) + w * 512;
    for (int unit = blockIdx.x * NWAVE + w; unit < (T_ALL / 32) * 8; unit += gridDim.x * NWAVE) {
        const int tt = unit >> 3, hd = unit & 7;
        const int tok = 32 * tt + r;
        const bf16* qp = qhb + (size_t)tok * 2048 + hd * 256 + 8 * h;
        unsigned ka[16], kb[16];
        rt_scores_top16(ldsb, qp, r, h, ka);
        rt_scores_top16(ldsb + RT_KIMG, qp + 128, r, h, kb);
        float v1[16], v2[16];
#pragma unroll
        for (int i = 0; i < 16; ++i) { v1[i] = rt_unmono(ka[i] & 0xFFFFFF80u); v2[i] = rt_unmono(kb[i] & 0xFFFFFF80u); }
#pragma unroll
        for (int wd = 0; wd < 4; ++wd) {
            lut[wd * 64 + lane] = (ka[4 * wd] & 0x7Fu) | ((ka[4 * wd + 1] & 0x7Fu) << 8) | ((ka[4 * wd + 2] & 0x7Fu) << 16) | ((ka[4 * wd + 3] & 0x7Fu) << 24);
            lut[(4 + wd) * 64 + lane] = (kb[4 * wd] & 0x7Fu) | ((kb[4 * wd + 1] & 0x7Fu) << 8) | ((kb[4 * wd + 2] & 0x7Fu) << 16) | ((kb[4 * wd + 3] & 0x7Fu) << 24);
        }
        unsigned c0[16], c1[16];
        c0[0] = (rt_mono(h ? (v1[0] + v2[1]) : (v1[0] + v2[0])) & 0xFFFFFF00u) | (h ? 1u : 0u);
        c0[1] = (rt_mono(h ? (v1[0] + v2[3]) : (v1[0] + v2[2])) & 0xFFFFFF00u) | (h ? 3u : 2u);
        c0[2] = (rt_mono(h ? (v1[0] + v2[5]) : (v1[0] + v2[4])) & 0xFFFFFF00u) | (h ? 5u : 4u);
        c0[3] = (rt_mono(h ? (v1[0] + v2[7]) : (v1[0] + v2[6])) & 0xFFFFFF00u) | (h ? 7u : 6u);
        c0[4] = (rt_mono(h ? (v1[0] + v2[9]) : (v1[0] + v2[8])) & 0xFFFFFF00u) | (h ? 9u : 8u);
        c0[5] = (rt_mono(h ? (v1[0] + v2[11]) : (v1[0] + v2[10])) & 0xFFFFFF00u) | (h ? 11u : 10u);
        c0[6] = (rt_mono(h ? (v1[0] + v2[13]) : (v1[0] + v2[12])) & 0xFFFFFF00u) | (h ? 13u : 12u);
        c0[7] = (rt_mono(h ? (v1[0] + v2[15]) : (v1[0] + v2[14])) & 0xFFFFFF00u) | (h ? 15u : 14u);
        c0[8] = (rt_mono(h ? (v1[1] + v2[1]) : (v1[1] + v2[0])) & 0xFFFFFF00u) | (h ? 17u : 16u);
        c0[9] = (rt_mono(h ? (v1[1] + v2[3]) : (v1[1] + v2[2])) & 0xFFFFFF00u) | (h ? 19u : 18u);
        c0[10] = (rt_mono(h ? (v1[1] + v2[5]) : (v1[1] + v2[4])) & 0xFFFFFF00u) | (h ? 21u : 20u);
        c0[11] = (rt_mono(h ? (v1[1] + v2[7]) : (v1[1] + v2[6])) & 0xFFFFFF00u) | (h ? 23u : 22u);
        c0[12] = (rt_mono(h ? (v1[2] + v2[1]) : (v1[2] + v2[0])) & 0xFFFFFF00u) | (h ? 33u : 32u);
        c0[13] = (rt_mono(h ? (v1[2] + v2[3]) : (v1[2] + v2[2])) & 0xFFFFFF00u) | (h ? 35u : 34u);
        c0[14] = (rt_mono(h ? (v1[3] + v2[0]) : (v1[2] + v2[4])) & 0xFFFFFF00u) | (h ? 48u : 36u);
        c0[15] = (rt_mono(h ? (v1[3] + v2[2]) : (v1[3] + v2[1])) & 0xFFFFFF00u) | (h ? 50u : 49u);
        c1[0] = (rt_mono(h ? (v1[4] + v2[0]) : (v1[3] + v2[3])) & 0xFFFFFF00u) | (h ? 64u : 51u);
        c1[1] = (rt_mono(h ? (v1[4] + v2[2]) : (v1[4] + v2[1])) & 0xFFFFFF00u) | (h ? 66u : 65u);
        c1[2] = (rt_mono(h ? (v1[5] + v2[1]) : (v1[5] + v2[0])) & 0xFFFFFF00u) | (h ? 81u : 80u);
        c1[3] = (rt_mono(h ? (v1[6] + v2[1]) : (v1[6] + v2[0])) & 0xFFFFFF00u) | (h ? 97u : 96u);
        c1[4] = (rt_mono(h ? (v1[7] + v2[1]) : (v1[7] + v2[0])) & 0xFFFFFF00u) | (h ? 113u : 112u);
        c1[5] = (rt_mono(h ? (v1[9] + v2[0]) : (v1[8] + v2[0])) & 0xFFFFFF00u) | (h ? 144u : 128u);
        c1[6] = (rt_mono(h ? (v1[11] + v2[0]) : (v1[10] + v2[0])) & 0xFFFFFF00u) | (h ? 176u : 160u);
        c1[7] = (rt_mono(h ? (v1[13] + v2[0]) : (v1[12] + v2[0])) & 0xFFFFFF00u) | (h ? 208u : 192u);
        c1[8] = (rt_mono(h ? (v1[15] + v2[0]) : (v1[14] + v2[0])) & 0xFFFFFF00u) | (h ? 240u : 224u);
        c1[9] = 0u;
        c1[10] = 0u;
        c1[11] = 0u;
        c1[12] = 0u;
        c1[13] = 0u;
        c1[14] = 0u;
        c1[15] = 0u;
        rt_sort16(c0); rt_sort16(c1); rt_top16(c0, c1); rt_top16_partner(c0);
        float e[16]; float sum = 0.f;
        const float mx = rt_unmono(c0[0] & 0xFFFFFF00u);
#pragma unroll
        for (int k = 0; k < 16; ++k) { e[k] = __expf(rt_unmono(c0[k] & 0xFFFFFF00u) - mx); sum += e[k]; }
        const float inv = 1.0f / sum;
        asm volatile("s_waitcnt lgkmcnt(0)" ::: "memory");
        int ex[8]; float gv[8];
#pragma unroll
        for (int k = 0; k < 8; ++k) {
            const unsigned hm = (unsigned)(-h);
            const unsigned ck = (c0[k] & ~hm) | (c0[8 + k] & hm);
            const float ek = __builtin_bit_cast(float, (__builtin_bit_cast(unsigned, e[k]) & ~hm) | (__builtin_bit_cast(unsigned, e[8 + k]) & hm));
            const unsigned ci = (ck >> 4) & 15u, cj = ck & 15u;
            const unsigned w1 = lut[(ci >> 2) * 64 + lane], w2 = lut[(4 + (cj >> 2)) * 64 + lane];
            const unsigned i1 = (w1 >> (8 * (ci & 3))) & 0x7Fu, i2 = (w2 >> (8 * (cj & 3))) & 0x7Fu;
            ex[k] = (int)(i1 * PEER_NKEYS + i2); gv[k] = ek * inv;
        }
        int* ep = eidx + (size_t)tok * 128 + hd * 16 + 8 * h; float* gp = gate + (size_t)tok * 128 + hd * 16 + 8 * h;
        *(int4*)ep = make_int4(ex[0], ex[1], ex[2], ex[3]); *(int4*)(ep + 4) = make_int4(ex[4], ex[5], ex[6], ex[7]);
        *(float4*)gp = make_float4(gv[0], gv[1], gv[2], gv[3]); *(float4*)(gp + 4) = make_float4(gv[4], gv[5], gv[6], gv[7]);
    }
}

struct Params {
    const float* in[23];
    float* out;
    unsigned char* ws;
    unsigned* bar;
};

#define WS_BAR      0ull
#define WS_XALL     (1ull << 20)
#define WS_PROJ     (WS_XALL + (size_t)T_ALL * D_MODEL * 4)
#define WS_XBC      (WS_PROJ + (size_t)T_ALL * PROJ_LD * 4)
#define WS_DT       (WS_XBC + (size_t)T_ALL * CONV_DIM * 4)
#define WS_QROT     (WS_DT + (size_t)T_ALL * SSD_HEADS * 4)
#define WS_KROT     (WS_QROT + (size_t)T_ALL * ATT_WIDTH * 4)
#define WS_YBUF     (WS_KROT + (size_t)T_ALL * ATT_WIDTH * 4)
#define WS_MIX      (WS_YBUF + (size_t)T_ALL * MIX_WIDTH * 4)
#define WS_HBUF     (WS_MIX + (size_t)T_ALL * D_MODEL * 4)
#define WS_QH       (WS_HBUF + (size_t)T_ALL * D_MODEL * 4)
#define WS_EIDX     (WS_QH + (size_t)T_ALL * 2048 * 4)
#define WS_GATE     (WS_EIDX + (size_t)T_ALL * 128 * 4)
#define WS_A0       (WS_GATE + (size_t)T_ALL * 128 * 4)
#define WS_A1       (WS_A0 + (size_t)T_ALL * D_MODEL * 2)
#define WS_A2       (WS_A1 + (size_t)T_ALL * MIX_WIDTH * 2)
#define WS_WTIN     (WS_A2 + (size_t)T_ALL * D_MODEL * 2)
#define WS_WTOUT    (WS_WTIN + (size_t)PROJ_LD * D_MODEL * 2)
#define WS_WTQ      (WS_WTOUT + (size_t)D_MODEL * MIX_WIDTH * 2)
#define WS_PROJB    (WS_WTQ + (size_t)2048 * D_MODEL * 2)
#define WS_DTRAW    (WS_PROJB + (size_t)T_ALL * NB_LD * 2)
#define WS_XBCB     (WS_DTRAW + (size_t)T_ALL * 32 * 4)
#define WS_QROTB    (WS_XBCB + (size_t)T_ALL * CONV_DIM * 2)
#define WS_KROTB    (WS_QROTB + (size_t)T_ALL * ATT_WIDTH * 2)
#define WS_UB       (WS_KROTB + (size_t)T_ALL * ATT_WIDTH * 2)
#define WS_VB       (WS_UB + (size_t)16384 * D_MODEL * 2)
#define WS_SBUF     (WS_VB + (size_t)16384 * D_MODEL * 2)
#define WS_HIN      (WS_SBUF + (size_t)BATCH * 64 * SSD_HEADS * 64 * 128 * 2)
#define WS_CDEC     (WS_HIN + (size_t)BATCH * 64 * SSD_HEADS * 64 * 128 * 2)
#define WS_OBUF     (WS_CDEC + (size_t)BATCH * 64 * SSD_HEADS * 4)
#define WS_LSE      (WS_OBUF + (size_t)3 * T_PROMPT * ATT_WIDTH * 2)
#define WS_END      (WS_LSE + (size_t)3 * T_PROMPT * 8 * 4)

#define LDS_BYTES (160 * 1024)

__global__ void __launch_bounds__(512, 2) mega_fwd(Params p) {
    extern __shared__ __attribute__((aligned(16))) unsigned char smem[];
    if (threadIdx.x == 0) *(uint4*)smem = make_uint4(0u, 0u, 0u, 0u);
    __syncthreads();
    XcdBarrier bar = xcd_barrier_post(p.bar, (volatile LAS unsigned*)smem);
    float* lds = (float*)(smem + 256);

    const float* x_prompt = p.in[0]; const float* x_sample = p.in[1]; const float* cache_k = p.in[2]; const float* cache_v = p.in[3];
    const float* state_conv = p.in[4]; const float* state_ssm = p.in[5]; const float* w_in = p.in[6]; const float* conv_w = p.in[7];
    const float* conv_b = p.in[8]; const float* dt_bias = p.in[9]; const float* a_log = p.in[10]; const float* d_skip = p.in[11];
    const float* norm_g = p.in[12]; const float* w_out = p.in[13]; const float* ln1_g = p.in[14]; const float* ln1_b = p.in[15];
    const float* peer_wq = p.in[16]; const float* keys1 = p.in[17]; const float* keys2 = p.in[18]; const float* peer_u = p.in[19];
    const float* peer_v = p.in[20]; const float* ln2_g = p.in[21]; const float* ln2_b = p.in[22];
    float* out = p.out;
    float* xall = (float*)(p.ws + WS_XALL); float* proj = (float*)(p.ws + WS_PROJ); float* xbc_act = (float*)(p.ws + WS_XBC);
    float* dtv = (float*)(p.ws + WS_DT); float* qrot = (float*)(p.ws + WS_QROT); float* krot = (float*)(p.ws + WS_KROT);
    float* ybuf = (float*)(p.ws + WS_YBUF); float* mix = (float*)(p.ws + WS_MIX); float* hbuf = (float*)(p.ws + WS_HBUF);
    float* qh = (float*)(p.ws + WS_QH); int* eidx = (int*)(p.ws + WS_EIDX); float* gate = (float*)(p.ws + WS_GATE);
    bf16* A0 = (bf16*)(p.ws + WS_A0); bf16* A1 = (bf16*)(p.ws + WS_A1); bf16* A2 = (bf16*)(p.ws + WS_A2);
    bf16* wt_in = (bf16*)(p.ws + WS_WTIN); bf16* wt_out = (bf16*)(p.ws + WS_WTOUT); bf16* wt_q = (bf16*)(p.ws + WS_WTQ);
    bf16* projb = (bf16*)(p.ws + WS_PROJB); float* dtraw = (float*)(p.ws + WS_DTRAW); bf16* xbc_b = (bf16*)(p.ws + WS_XBCB);
    bf16* qrot_b = (bf16*)(p.ws + WS_QROTB); bf16* krot_b = (bf16*)(p.ws + WS_KROTB); bf16* ub = (bf16*)(p.ws + WS_UB); bf16* vb = (bf16*)(p.ws + WS_VB);
    bf16* Sbuf = (bf16*)(p.ws + WS_SBUF); bf16* Hin = (bf16*)(p.ws + WS_HIN); float* cdec = (float*)(p.ws + WS_CDEC);
    bf16* obuf = (bf16*)(p.ws + WS_OBUF); float* lsebuf = (float*)(p.ws + WS_LSE);
    LAS unsigned char* ldsb = (LAS unsigned char*)smem + 256;

    ph_concat_x(x_prompt, x_sample, xall);
    ph_prologue(ldsb, x_prompt, x_sample, A0, w_in, wt_in, w_out, wt_out, peer_wq, wt_q, peer_u, peer_v, ub, vb);
    ph_cache_copy(cache_k, cache_v, out);
    xcd_barrier(bar);
    { pg8::Gemm g{A0, wt_in, T_ALL, PROJ_LD, D_MODEL}; pg8::StaticOrder S; S.init(g.M, g.N, (int)gridDim.x, (int)blockIdx.x);
      pg8::EpiProj E{projb, dtraw}; pg8::gemm_phase<pg8::EpiProj, pg8::StaticOrder, false>(ldsb, g, S, E, nullptr); }
    xcd_barrier(bar);
    ph_post_proj2(projb, dtraw, state_conv, conv_w, conv_b, dt_bias, proj, xbc_act, xbc_b, dtv, qrot, krot, qrot_b, krot_b, out);
    xcd_barrier(bar);
    ph_ssd_states(ldsb, xbc_b, dtv, a_log, Sbuf, cdec);
    __syncthreads();
    ph_attn_prompt(ldsb, qrot_b, krot_b, projb, obuf, lsebuf);
    __syncthreads();
    ph_ssd_naive(lds, xbc_act, dtv, a_log, d_skip, state_ssm, ybuf, out);
    ph_attn_naive(lds, proj, qrot, krot, cache_k, cache_v, ybuf);
    xcd_barrier(bar);
    ph_ssd_scan(Sbuf, cdec, Hin, out);
    xcd_barrier(bar);
    ph_ssd_out(ldsb, xbc_b, projb, dtv, a_log, d_skip, norm_g, Hin, A1);
    ph_attn_combine(obuf, lsebuf, A1);
    ph_gate_norm(proj, norm_g, ybuf, A1);
    xcd_barrier(bar);
    { pg8::Gemm g{A1, wt_out, T_ALL, D_MODEL, MIX_WIDTH}; pg8::StaticOrder S; S.init(g.M, g.N, (int)gridDim.x, (int)blockIdx.x);
      pg8::EpiF32 E{mix, D_MODEL, nullptr}; pg8::gemm_phase<pg8::EpiF32, pg8::StaticOrder, false>(ldsb, g, S, E, nullptr); }
    xcd_barrier(bar);
    ph_ln_res(xall, mix, ln1_g, ln1_b, hbuf, A2);
    xcd_barrier(bar);
    { pg8::Gemm g{A2, wt_q, T_ALL, 2048, D_MODEL}; pg8::StaticOrder S; S.init(g.M, g.N, (int)gridDim.x, (int)blockIdx.x);
      pg8::EpiBf16Plain E{(bf16*)qh, 2048}; pg8::gemm_phase<pg8::EpiBf16Plain, pg8::StaticOrder, false>(ldsb, g, S, E, nullptr); }
    xcd_barrier(bar);
    ph_peer_route2(ldsb, (const bf16*)qh, keys1, keys2, eidx, gate);
    xcd_barrier(bar);
    ph_peer_ffn2(hbuf, eidx, gate, ub, vb, ln2_g, ln2_b, out);
}

extern "C" void kernel_launch(void* const* d_in, const int* in_sizes, int n_in, void* d_out, int out_size, void* d_ws, size_t ws_size, hipStream_t stream) {
    static int grid = 0;
    if (grid == 0) {
        int dev = 0, cus = 0, per_cu = 0;
        if (hipGetDevice(&dev) != hipSuccess || hipDeviceGetAttribute(&cus, hipDeviceAttributeMultiprocessorCount, dev) != hipSuccess) { fprintf(stderr, "kernel_launch: device query failed\n"); grid = -1; return; }
        if (hipFuncSetAttribute((const void*)mega_fwd, hipFuncAttributeMaxDynamicSharedMemorySize, LDS_BYTES) != hipSuccess) { fprintf(stderr, "kernel_launch: hipFuncSetAttribute failed\n"); grid = -1; return; }
        if (hipOccupancyMaxActiveBlocksPerMultiprocessor(&per_cu, (const void*)mega_fwd, NTHR, LDS_BYTES) != hipSuccess || per_cu < 1) { fprintf(stderr, "kernel_launch: occupancy query says %d\n", per_cu); }
        (void)hipGetLastError();
        grid = cus;
        if (ws_size < WS_END) { fprintf(stderr, "kernel_launch: workspace too small\n"); grid = -1; return; }
    }
    if (grid < 0) return;
    (void)hipMemsetAsync((char*)d_ws + WS_BAR, 0, XCD_BAR_WORDS * sizeof(unsigned), stream);
    Params p{};
    for (int i = 0; i < 23; ++i) p.in[i] = (const float*)d_in[i];
    p.out = (float*)d_out; p.ws = (unsigned char*)d_ws; p.bar = (unsigned*)((char*)d_ws + WS_BAR);
    hipLaunchKernelGGL(mega_fwd, dim3(grid), dim3(NTHR), LDS_BYTES, stream, p);
}
```

```cpp
#include <hip/hip_runtime.h>
#include <stdint.h>

#define D_MODEL 1024
#define BATCH 2
#define SEQ 8192
#define DEC_BATCH 128
#define DEC_SEQ 4
#define PAST_LEN 8192
#define HEAD_DIM 64
#define ATT_WIDTH 512
#define ATT_HEADS 8
#define SSD_WIDTH 1536
#define SSD_HEADS 24
#define SSD_GROUPS 4
#define SSD_STATE 128
#define CONV_DIM 2560
#define IN_WIDTH 5656
#define PROJ_LD 5888
#define MIX_WIDTH 2048
#define WBUF 2048
#define PEER_NKEYS 128
#define PEER_HEADS 8
#define PEER_TOPK 16
#define PEER_DKEY 256
#define T_PROMPT (BATCH * SEQ)
#define T_SAMPLE (DEC_BATCH * DEC_SEQ)
#define T_ALL (T_PROMPT + T_SAMPLE)
#define O_Z 0
#define O_XBC 1536
#define O_DT 4096
#define O_Q 4120
#define O_K 4632
#define O_V 5144
#define ALPHA_F 1.189207115002721f
#define LN_EPS 1e-5f

#define OUT_YP 0ull
#define OUT_YS (OUT_YP + 16777216ull)
#define OUT_PK (OUT_YS + 524288ull)
#define OUT_PV (OUT_PK + 2097152ull)
#define OUT_PC (OUT_PV + 2097152ull)
#define OUT_PS (OUT_PC + 15360ull)
#define OUT_SK (OUT_PS + 393216ull)
#define OUT_SV (OUT_SK + 134217728ull)
#define OUT_SC (OUT_SV + 134217728ull)
#define OUT_SS (OUT_SC + 983040ull)

__constant__ double ROPE_INV_REV[32] = {
    1.59154943091895346e-01, 1.19349370211248862e-01, 8.94994016088910133e-02, 6.71150830052272551e-02,
    5.03292121044870353e-02, 3.77415847174197711e-02, 2.83021958306233987e-02, 2.12236527647776604e-02,
    1.59154943091895339e-02, 1.19349370211248862e-02, 8.94994016088910237e-03, 6.71150830052272534e-03,
    5.03292121044870370e-03, 3.77415847174197719e-03, 2.83021958306233987e-03, 2.12236527647776622e-03,
    1.59154943091895356e-03, 1.19349370211248849e-03, 8.94994016088910237e-04, 6.71150830052272599e-04,
    5.03292121044870326e-04, 3.77415847174197741e-04, 2.83021958306233954e-04, 2.12236527647776605e-04,
    1.59154943091895351e-04, 1.19349370211248862e-04, 8.94994016088910182e-05, 6.71150830052272545e-05,
    5.03292121044870354e-05, 3.77415847174197768e-05, 2.83021958306233961e-05, 2.12236527647776592e-05
};

__device__ __forceinline__ float silu_f(float x) { return x / (1.0f + __expf(-x)); }
__device__ __forceinline__ float softplus_f(float x) { return fmaxf(x, 0.f) + log1pf(__expf(-fabsf(x))); }
__device__ __forceinline__ float gelu_f(float x) { return 0.5f * x * (1.0f + erff(x * 0.70710678118654752f)); }
__device__ __forceinline__ float wave_sum(float v) {
#pragma unroll
    for (int o = 32; o > 0; o >>= 1) v += __shfl_xor(v, o);
    return v;
}
__device__ __forceinline__ float wave_max(float v) {
#pragma unroll
    for (int o = 32; o > 0; o >>= 1) v = fmaxf(v, __shfl_xor(v, o));
    return v;
}

#include <cstdio>
#define XB_TMO      128
#define XB_XCNT(j)  (256  + 64 * (j))
#define XB_XSUB(j)  (1280 + 64 * (j))
#define XB_XGEN(j)  (2304 + 64 * (j))
#define XB_TOP      3328
#define XB_TOPGEN   3392
#define XCD_BAR_WORDS 3456
#define XB_SPIN_CAP (1u << 18)
#define LAS __attribute__((address_space(3)))

__device__ __forceinline__ unsigned xb_ld(unsigned* p)              { return __hip_atomic_load(p, __ATOMIC_RELAXED, __HIP_MEMORY_SCOPE_AGENT); }
__device__ __forceinline__ unsigned xb_add(unsigned* p, unsigned v) { return __hip_atomic_fetch_add(p, v, __ATOMIC_RELAXED, __HIP_MEMORY_SCOPE_AGENT); }
__device__ __forceinline__ unsigned xb_xcc_id() { return (unsigned)__builtin_amdgcn_s_getreg((3 << 11) | 20) & 0xFu; }
#define XB_SPIN(cond, bar) do { unsigned _sp = 0; while (cond) { __builtin_amdgcn_s_sleep(1); \
    if ((++_sp & 255u) == 0u) { if (xb_ld(&(bar)[XB_TMO])) break; if (_sp > XB_SPIN_CAP) { atomicAdd(&(bar)[XB_TMO], 1u); break; } } } } while (0)

struct XcdBarrier {
    unsigned* bar; unsigned x;
    volatile LAS unsigned* st;
};

__device__ __forceinline__ XcdBarrier xcd_barrier_post(unsigned* bar, volatile LAS unsigned* st) {
    XcdBarrier b; b.bar = bar; b.x = xb_xcc_id(); b.st = st;
    if (threadIdx.x == 0) (void)xb_add(&bar[XB_XCNT(b.x)], 1u);
    return b;
}
__device__ __forceinline__ void xcd_barrier_complete(unsigned* bar, unsigned x, unsigned& nloc, unsigned& nx) {
    const unsigned G = gridDim.x * gridDim.y * gridDim.z;
    unsigned sum, cnt, mine, sp = 0u;
    for (;;) {
        sum = 0u; cnt = 0u; mine = 0u;
#pragma unroll
        for (unsigned j = 0; j < 16; ++j) { const unsigned c = xb_ld(&bar[XB_XCNT(j)]); sum += c; cnt += (c > 0u) ? 1u : 0u; mine = (j == x) ? c : mine; }
        if (sum == G) break;
        __builtin_amdgcn_s_sleep(1);
        if ((++sp & 255u) == 0u) { if (xb_ld(&bar[XB_TMO])) break; if (sp > XB_SPIN_CAP) { atomicAdd(&bar[XB_TMO], 1u); break; } }
    }
    nloc = mine > 0u ? mine : 1u; nx = cnt > 0u ? cnt : 1u;
}

__device__ __forceinline__ void xcd_barrier(const XcdBarrier& b) {
    asm volatile("s_waitcnt vmcnt(0)" ::: "memory");
    __syncthreads();
    if (threadIdx.x == 0) {
        unsigned* bar = b.bar;
        __builtin_amdgcn_s_waitcnt(0);
        unsigned nloc = b.st[0], nx = b.st[1];
        if (nloc == 0u) { xcd_barrier_complete(bar, b.x, nloc, nx); b.st[0] = nloc; b.st[1] = nx; }
        const unsigned old = xb_add(&bar[XB_XSUB(b.x)], 1u);
        const unsigned gen = old / nloc;
        if (old + 1u == (gen + 1u) * nloc) {
            __builtin_amdgcn_fence(__ATOMIC_RELEASE, "agent");
            asm volatile("s_waitcnt vmcnt(0)" ::: "memory");
            const unsigned og = xb_add(&bar[XB_TOP], 1u);
            const unsigned tg = og / nx;
            if (og + 1u == (tg + 1u) * nx) xb_add(&bar[XB_TOPGEN], 1u);
            else XB_SPIN(xb_ld(&bar[XB_TOPGEN]) == tg, bar);
            __builtin_amdgcn_fence(__ATOMIC_ACQUIRE, "agent");
            xb_add(&bar[XB_XGEN(b.x)], 1u);
            asm volatile("s_waitcnt vmcnt(0)" ::: "memory");
        } else {
            XB_SPIN(xb_ld(&bar[XB_XGEN(b.x)]) == gen, bar);
            __builtin_amdgcn_fence(__ATOMIC_ACQUIRE, "agent");
            asm volatile("s_waitcnt vmcnt(0)" ::: "memory");
        }
    }
    __syncthreads();
}


#define GAS __attribute__((address_space(1)))
typedef unsigned short bf16;
typedef unsigned v4u __attribute__((ext_vector_type(4)));
#define LDS_WAIT() asm volatile("s_waitcnt lgkmcnt(0)" ::: "memory")
__device__ __forceinline__ unsigned f2bf(float f) { unsigned u = __builtin_bit_cast(unsigned, f); return (u + 0x7fffu + ((u >> 16) & 1u)) >> 16; }
__device__ __forceinline__ unsigned pk2(float lo, float hi) { return f2bf(lo) | (f2bf(hi) << 16); }
__device__ __forceinline__ float bf2f(unsigned short b) { return __builtin_bit_cast(float, (unsigned)b << 16); }
#include <hip/hip_runtime.h>
namespace pg8 {
#define PG8_LAS __attribute__((address_space(3)))
typedef unsigned short bf16_t;
typedef short bf16x8 __attribute__((ext_vector_type(8)));
typedef float f32x4 __attribute__((ext_vector_type(4)));
typedef unsigned u32x4 __attribute__((ext_vector_type(4)));
constexpr int BM = 256, BK = 64, HALF = 128, HTB = HALF * BK * 2  , STAGE_BYTES = 8 * HTB, NXCD = 8, WGM = 8;

__host__ __device__ __forceinline__ int lds_byte(int r, int c) { const int st = (r >> 4) * 2 + (c >> 5), rr = r & 15, cc = c & 31, ob = rr * 64 + cc * 2; return st * 1024 + (ob ^ (((ob >> 9) & 1) << 5)); }
__host__ __device__ __forceinline__ void stage_rc(int b, int& R, int& C) { const int st = b / 1024, sb = b % 1024, swz = sb ^ (((sb >> 9) & 1) << 5); R = (st >> 1) * 16 + swz / 64; C = (st & 1) * 32 + (swz % 64) / 2; }
__host__ __device__ __forceinline__ int perm32(int rho) { const int n = rho >> 4, i = rho & 15; return 8 * (i >> 2) + 4 * n + (i & 3); }

struct Unit { int pm, pn; };
struct Gemm { const bf16_t* A; const bf16_t* Bt; int M, N, K; };

struct StaticOrder {
    int nM, nN, nwg, G, c;
    __host__ __device__ void init(int M, int N, int G_, int c_) { nM = M / BM; nN = N / BM; nwg = nM * nN; G = G_; c = c_; }
    __host__ __device__ bool next(int i, Unit& u) const {
        const long L = (long)i * G + c; if (L >= nwg) return false;
        int wgid = (int)L; { const int q = nwg / NXCD, r = nwg % NXCD, xcd = wgid % NXCD, off = wgid / NXCD; wgid = (xcd < r ? xcd * (q + 1) : r * (q + 1) + (xcd - r) * q) + off; }
        const int nig = WGM * nN, gid = wgid / nig, fm = gid * WGM, gsz = (nM - fm) < WGM ? (nM - fm) : WGM;
        u.pm = fm + ((wgid % nig) % gsz); u.pn = (wgid % nig) / gsz; return true;
    }
    __device__ __forceinline__ void a_ready(const Unit&) const {}
    __device__ __forceinline__ void done(const Unit&) const {}
};
__device__ __forceinline__ unsigned cvt_pk_bf16(float lo, float hi) { unsigned r; asm volatile("v_cvt_pk_bf16_f32 %0, %1, %2" : "=v"(r) : "v"(lo), "v"(hi)); return r; }
typedef float f32x2 __attribute__((ext_vector_type(2)));
__device__ __forceinline__ f32x2 gelu_pk(f32x2 v) {
    const f32x2 av = __builtin_elementwise_abs(v), d = av * 0.2316418882f + 1.0f;
    f32x2 t; t.x = __builtin_amdgcn_rcpf(d.x); t.y = __builtin_amdgcn_rcpf(d.y);
    f32x2 q = t * 0.5307027145f + (-0.7265760135f); q = q * t + 0.7107068705f; q = q * t + (-0.142248368f); q = q * t + 0.127414796f; q = q * t;
    const f32x2 s = (v * v) * (-0.72134752044f);
    f32x2 e; e.x = __builtin_amdgcn_exp2f(s.x); e.y = __builtin_amdgcn_exp2f(s.y);
    const f32x2 m = v * (q * e), r = v - m;
    f32x2 o; o.x = v.x < 0.f ? m.x : r.x; o.y = v.y < 0.f ? m.y : r.y; return o;
}

struct EpiF32 {
    static constexpr bool PERM = false, AFTER_DRAIN = false;
    float* C; int ldc; const float* bias;
    __device__ __forceinline__ void operator()(const f32x4 (&acc)[2][2][4][2], const Unit& u, int wr, int wc, int fr, int fq) const {
        const int row0 = u.pm * BM + wr * 64 + fr, col0 = u.pn * BM + wc * 32 + 4 * fq;
        f32x4 bv[2][2];
#pragma unroll
        for (int bj = 0; bj < 2; ++bj)
#pragma unroll
            for (int n = 0; n < 2; ++n) bv[bj][n] = bias ? *(const f32x4*)(bias + col0 + bj * HALF + n * 16) : (f32x4){0.f, 0.f, 0.f, 0.f};
#pragma unroll
        for (int ai = 0; ai < 2; ++ai)
#pragma unroll
            for (int m = 0; m < 4; ++m) { float* rowp = C + (size_t)(row0 + ai * HALF + m * 16) * ldc + col0;
#pragma unroll
                for (int bj = 0; bj < 2; ++bj)
#pragma unroll
                    for (int n = 0; n < 2; ++n) *(f32x4*)(rowp + bj * HALF + n * 16) = acc[ai][bj][m][n] + bv[bj][n]; }
    }
};

template <class Epi, class Sched, bool STAMP = false>
__device__ __forceinline__ void gemm_phase(PG8_LAS unsigned char* lds, const Gemm g, const Sched& S, const Epi& E, unsigned long long* stamps) {
    const int tid = threadIdx.x, wid = __builtin_amdgcn_readfirstlane(tid >> 6), lane = tid & 63, wr = wid >> 2, wc = wid & 3, fr = lane & 15, fq = lane >> 4;
    const int K = g.K, nt = K / BK;
    int ts_lo = 0, ts_hi = 0, nts = 0; const unsigned long long rt_entry = STAMP ? (unsigned long long)wall_clock64() : 0ull;
#define PG8_STAMP() do { if (STAMP && wid == 0 && nts < 64) { const unsigned long long _c = (unsigned long long)clock64(); \
        ts_lo = (lane == nts) ? (int)(unsigned)_c : ts_lo; ts_hi = (lane == nts) ? (int)(unsigned)(_c >> 32) : ts_hi; ++nts; } } while (0)
    PG8_STAMP();
    unsigned voffA[2], voffB[2];
#pragma unroll
    for (int i = 0; i < 2; ++i) { int R, C; stage_rc(tid * 16 + i * 8192, R, C); const int Rb = Epi::PERM ? ((R & ~31) + perm32(R & 31)) : R;
        voffA[i] = (unsigned)(R * K + C) * 2u; voffB[i] = (unsigned)(Rb * K + C) * 2u; }
    const size_t kstep = (size_t)(BK * 2);
    const size_t hstep = (size_t)HALF * K * 2;
    const size_t tstep = 2 * hstep;
    const unsigned ldsw = (unsigned)wid * 1024u;
    const int aoff = lds_byte(wr * 64 + fr, fq * 8), boff = lds_byte(wc * 32 + fr, fq * 8);
#define PG8_SA(b, h) (((b) * 2 + (h)) * HTB)
#define PG8_SB(b, h) ((4 + (b) * 2 + (h)) * HTB)
#define PG8_STAGE(bufoff, gbase, voff) do { _Pragma("unroll") for (int _i = 0; _i < 2; ++_i) \
        __builtin_amdgcn_global_load_lds((const unsigned*)((const char*)(gbase) + (voff)[_i]), (PG8_LAS unsigned*)(lds + (bufoff) + ldsw + _i * 8192), 16, 0, 0); } while (0)
#define PG8_LDA(dst, b, h) do { _Pragma("unroll") for (int m = 0; m < 4; ++m) _Pragma("unroll") for (int k = 0; k < 2; ++k) dst[m][k] = *(const PG8_LAS bf16x8*)(lds + PG8_SA(b, h) + aoff + m * 2048 + k * 1024); } while (0)
#define PG8_LDB(dst, b, h) do { _Pragma("unroll") for (int n = 0; n < 2; ++n) _Pragma("unroll") for (int k = 0; k < 2; ++k) dst[n][k] = *(const PG8_LAS bf16x8*)(lds + PG8_SB(b, h) + boff + n * 2048 + k * 1024); } while (0)
#define PG8_MMA(ai, bj, At, Bt) do { __builtin_amdgcn_s_setprio(1); _Pragma("unroll") for (int m = 0; m < 4; ++m) _Pragma("unroll") for (int n = 0; n < 2; ++n) _Pragma("unroll") for (int k = 0; k < 2; ++k) \
        acc[ai][bj][m][n] = __builtin_amdgcn_mfma_f32_16x16x32_bf16(Bt[n][k], At[m][k], acc[ai][bj][m][n], 0, 0, 0); __builtin_amdgcn_s_setprio(0); } while (0)
#define PG8_WAIT_V(n) asm volatile("s_waitcnt vmcnt(" #n ")" ::: "memory")
#define PG8_WAIT_L(n) asm volatile("s_waitcnt lgkmcnt(" #n ")" ::: "memory")
#define PG8_BAR __builtin_amdgcn_s_barrier()
#define PG8_SCHED __builtin_amdgcn_sched_barrier(0)
    Unit cur, nxt; int ui = 0;
    if (!S.next(0, cur)) return;
    f32x4 acc[2][2][4][2];
#pragma unroll
    for (int a = 0; a < 2; ++a)
#pragma unroll
        for (int b = 0; b < 2; ++b)
#pragma unroll
            for (int m = 0; m < 4; ++m)
#pragma unroll
                for (int n = 0; n < 2; ++n) acc[a][b][m][n] = (f32x4){0.f, 0.f, 0.f, 0.f};
    bf16x8 At[4][2], B0[2][2], B1[2][2];
    const char* cA = (const char*)g.A + (size_t)cur.pm * tstep; const char* cB = (const char*)g.Bt + (size_t)cur.pn * tstep;
    S.a_ready(cur);
    PG8_STAGE(PG8_SB(0, 0), cB, voffB); PG8_STAGE(PG8_SA(0, 0), cA, voffA); PG8_STAGE(PG8_SB(0, 1), cB + hstep, voffB); PG8_STAGE(PG8_SA(0, 1), cA + hstep, voffA);
    if (wr == 1) PG8_BAR;
    PG8_WAIT_V(4); PG8_BAR;
    PG8_STAGE(PG8_SB(1, 0), cB + kstep, voffB); PG8_STAGE(PG8_SA(1, 0), cA + kstep, voffA); PG8_STAGE(PG8_SB(1, 1), cB + hstep + kstep, voffB);
    PG8_WAIT_V(6); PG8_BAR;
    PG8_STAMP();
    for (;;) {
        const bool has_next = S.next(ui + 1, nxt);
        const char* nA = has_next ? (const char*)g.A + (size_t)nxt.pm * tstep : cA; const char* nB = has_next ? (const char*)g.Bt + (size_t)nxt.pn * tstep : cB;
        for (int t = 0; t < nt; t += 2) {
            const bool last = (t == nt - 2);
            const char* a1 = cA + (size_t)(t + 1) * kstep;
            const char* a2 = last ? nA : cA + (size_t)(t + 2) * kstep; const char* b2 = last ? nB : cB + (size_t)(t + 2) * kstep;
            const char* a3 = a2 + kstep; const char* b3 = b2 + kstep;
            if (last && has_next) S.a_ready(nxt);
            PG8_LDB(B0, 0, 0); PG8_SCHED; PG8_LDA(At, 0, 0); PG8_STAGE(PG8_SA(1, 1), a1 + hstep, voffA);
            PG8_WAIT_L(8); PG8_BAR; PG8_WAIT_L(0); PG8_MMA(0, 0, At, B0); PG8_BAR; PG8_SCHED;
            PG8_LDB(B1, 0, 1); PG8_STAGE(PG8_SB(0, 0), b2, voffB);
            PG8_BAR; PG8_WAIT_L(0); PG8_MMA(0, 1, At, B1); PG8_BAR;
            PG8_LDA(At, 0, 1); PG8_STAGE(PG8_SA(0, 0), a2, voffA);
            PG8_BAR; PG8_WAIT_L(0); PG8_MMA(1, 0, At, B0); PG8_BAR; PG8_SCHED;
            PG8_STAGE(PG8_SB(0, 1), b2 + hstep, voffB);
            PG8_WAIT_V(6); PG8_BAR; PG8_MMA(1, 1, At, B1); PG8_BAR;
            PG8_LDB(B0, 1, 0); PG8_SCHED; PG8_LDA(At, 1, 0); PG8_STAGE(PG8_SA(0, 1), a2 + hstep, voffA);
            PG8_WAIT_L(8); PG8_BAR; PG8_WAIT_L(0); PG8_MMA(0, 0, At, B0); PG8_BAR; PG8_SCHED;
            PG8_LDB(B1, 1, 1); PG8_STAGE(PG8_SB(1, 0), b3, voffB);
            PG8_BAR; PG8_WAIT_L(0); PG8_MMA(0, 1, At, B1); PG8_BAR;
            PG8_LDA(At, 1, 1); PG8_STAGE(PG8_SA(1, 0), a3, voffA);
            PG8_BAR; PG8_WAIT_L(0); PG8_MMA(1, 0, At, B0); PG8_BAR; PG8_SCHED;
            PG8_STAGE(PG8_SB(1, 1), b3 + hstep, voffB);
            PG8_WAIT_V(6); PG8_BAR; PG8_MMA(1, 1, At, B1); PG8_BAR;
        }
        PG8_STAMP();
        if constexpr (!Epi::AFTER_DRAIN) { E(acc, cur, wr, wc, fr, fq); S.done(cur); }
        PG8_STAMP();
        if (!has_next) break;
#pragma unroll
        for (int a = 0; a < 2; ++a)
#pragma unroll
            for (int b = 0; b < 2; ++b)
#pragma unroll
                for (int m = 0; m < 4; ++m)
#pragma unroll
                    for (int n = 0; n < 2; ++n) acc[a][b][m][n] = (f32x4){0.f, 0.f, 0.f, 0.f};
        cur = nxt; cA = nA; cB = nB; ++ui;
    }
    PG8_WAIT_V(0);
    if (wr == 0) PG8_BAR;
    PG8_BAR;
    if constexpr (Epi::AFTER_DRAIN) { E.fused(acc, cur, wr, wc, fr, fq, lds, wid, lane); S.done(cur); }
    PG8_STAMP();
    if (STAMP && wid == 0) { stamps[lane] = lane < nts ? (((unsigned long long)(unsigned)ts_hi << 32) | (unsigned)ts_lo) : 0ull;
        if (lane == 62) stamps[62] = rt_entry; if (lane == 63) stamps[63] = (unsigned long long)wall_clock64(); }
#undef PG8_STAMP
#undef PG8_SA
#undef PG8_SB
#undef PG8_STAGE
#undef PG8_LDA
#undef PG8_LDB
#undef PG8_MMA
#undef PG8_WAIT_V
#undef PG8_WAIT_L
#undef PG8_BAR
#undef PG8_SCHED
}
}


namespace pg8 {
struct EpiProj {
    static constexpr bool PERM = true, AFTER_DRAIN = false;
    bf16_t* O; float* dtraw;
    __device__ __forceinline__ void operator()(const f32x4 (&acc)[2][2][4][2], const Unit& u, int wr, int wc, int fr, int fq) const {
        const int row0 = u.pm * BM + wr * 64 + fr;
        if (u.pn < 22) {
            const int col0 = u.pn * BM + wc * 32 + 8 * fq;
#pragma unroll
            for (int ai = 0; ai < 2; ++ai)
#pragma unroll
                for (int m = 0; m < 4; ++m) { bf16_t* rowp = O + (size_t)(row0 + ai * HALF + m * 16) * 5632 + col0;
#pragma unroll
                    for (int bj = 0; bj < 2; ++bj) { const f32x4 v0 = acc[ai][bj][m][0], v1 = acc[ai][bj][m][1];
                        u32x4 w; w.x = cvt_pk_bf16(v0[0], v0[1]); w.y = cvt_pk_bf16(v0[2], v0[3]); w.z = cvt_pk_bf16(v1[0], v1[1]); w.w = cvt_pk_bf16(v1[2], v1[3]);
                        *(u32x4*)(rowp + bj * HALF) = w; } }
        } else if (wc == 0) {
#pragma unroll
            for (int ai = 0; ai < 2; ++ai)
#pragma unroll
                for (int m = 0; m < 4; ++m) { float* rp = dtraw + (size_t)(row0 + ai * HALF + m * 16) * 32 + 8 * fq;
                    *(f32x4*)rp = acc[ai][0][m][0]; *(f32x4*)(rp + 4) = acc[ai][0][m][1]; }
        }
    }
};
}


namespace pg8 {
struct EpiBf16Plain {
    static constexpr bool PERM = true, AFTER_DRAIN = false;
    bf16_t* O; int ldc;
    __device__ __forceinline__ void operator()(const f32x4 (&acc)[2][2][4][2], const Unit& u, int wr, int wc, int fr, int fq) const {
        const int row0 = u.pm * BM + wr * 64 + fr, col0 = u.pn * BM + wc * 32 + 8 * fq;
#pragma unroll
        for (int ai = 0; ai < 2; ++ai)
#pragma unroll
            for (int m = 0; m < 4; ++m) { bf16_t* rowp = O + (size_t)(row0 + ai * HALF + m * 16) * ldc + col0;
#pragma unroll
                for (int bj = 0; bj < 2; ++bj) { const f32x4 v0 = acc[ai][bj][m][0], v1 = acc[ai][bj][m][1];
                    u32x4 w; w.x = cvt_pk_bf16(v0[0], v0[1]); w.y = cvt_pk_bf16(v0[2], v0[3]); w.z = cvt_pk_bf16(v1[0], v1[1]); w.w = cvt_pk_bf16(v1[2], v1[3]);
                    *(u32x4*)(rowp + bj * HALF) = w; } }
    }
};
}

#define NTHR 512
#define NWAVE 8

__device__ __forceinline__ void ph_gemm_f32(float* lds, const float* __restrict__ A, const float* __restrict__ B, float* __restrict__ C,
                                            int M, int N, int K, int lda, int ldb, int ldc) {
    const int tid = threadIdx.x & 255, half = threadIdx.x >> 8, tx = tid & 15, ty = tid >> 4;
    float (*As)[68] = (float (*)[68])(lds + half * 2 * 16 * 68);
    float (*Bs)[68] = (float (*)[68])(lds + half * 2 * 16 * 68 + 16 * 68);
    const int ntx = (N + 63) / 64, nty = M / 64, ntiles = ntx * nty;
    for (int it = blockIdx.x; 2 * it < ntiles; it += gridDim.x) {
        const int tile = 2 * it + half;
        const int m0 = (tile / ntx) * 64, n0 = (tile % ntx) * 64;
        float acc[4][4];
#pragma unroll
        for (int i = 0; i < 4; ++i)
#pragma unroll
            for (int j = 0; j < 4; ++j) acc[i][j] = 0.f;
        for (int k0 = 0; k0 < K; k0 += 16) {
#pragma unroll
            for (int i = 0; i < 4; ++i) {
                int idx = tid + i * 256;
                int r = idx >> 4, c = idx & 15;
                As[c][r] = (m0 + r < M) ? A[(size_t)(m0 + r) * lda + k0 + c] : 0.f;
                int rb = idx >> 6, cb = idx & 63;
                Bs[rb][cb] = (n0 + cb < N) ? B[(size_t)(k0 + rb) * ldb + n0 + cb] : 0.f;
            }
            __syncthreads();
#pragma unroll
            for (int k = 0; k < 16; ++k) {
                float a[4], b[4];
#pragma unroll
                for (int i = 0; i < 4; ++i) { a[i] = As[k][ty * 4 + i]; b[i] = Bs[k][tx * 4 + i]; }
#pragma unroll
                for (int i = 0; i < 4; ++i)
#pragma unroll
                    for (int j = 0; j < 4; ++j) acc[i][j] += a[i] * b[j];
            }
            __syncthreads();
        }
#pragma unroll
        for (int i = 0; i < 4; ++i)
#pragma unroll
            for (int j = 0; j < 4; ++j) {
                int r = m0 + ty * 4 + i, c = n0 + tx * 4 + j;
                if (r < M && c < N) C[(size_t)r * ldc + c] = acc[i][j];
            }
    }
}


template <int MODE>
__device__ __forceinline__ void transpose_item(const float* __restrict__ W, int K, int N, int Npad, bf16* __restrict__ WT, LAS float* scr, int item, int lane) {
    const int nblk = Npad / 32, kb = item / nblk, nb = item % nblk, k0 = 64 * kb, n0 = 32 * nb;
    const int n = n0 + (lane & 31);
    int sc = n;
    if (MODE == 1) sc = (n < 4096) ? n : (n < 5632 ? n + 24 : (n < 5656 ? n - 5632 + 4096 : -1));
    else sc = (n < N) ? n : -1;
#pragma unroll 8
    for (int i = 0; i < 32; ++i) { const int kk = 2 * i + (lane >> 5); scr[kk * 33 + (lane & 31)] = (sc >= 0) ? W[(size_t)(k0 + kk) * N + sc] : 0.f; }
    LDS_WAIT(); asm volatile("" ::: "memory");
    const int c = lane & 7;
#pragma unroll
    for (int j = 0; j < 4; ++j) { const int nn = (lane >> 3) + 8 * j; const LAS float* s = scr + (8 * c) * 33 + nn;
        v4u o; o.x = pk2(s[0 * 33], s[1 * 33]); o.y = pk2(s[2 * 33], s[3 * 33]); o.z = pk2(s[4 * 33], s[5 * 33]); o.w = pk2(s[6 * 33], s[7 * 33]);
        *(v4u*)(WT + (size_t)(n0 + nn) * K + k0 + 8 * c) = o; }
    LDS_WAIT(); asm volatile("" ::: "memory");
}
__device__ __forceinline__ void ph_prologue(LAS unsigned char* ldsb, const float* __restrict__ xp, const float* __restrict__ xs, bf16* __restrict__ A0,
                                            const float* __restrict__ w_in, bf16* __restrict__ wt_in, const float* __restrict__ w_out, bf16* __restrict__ wt_out,
                                            const float* __restrict__ w_q, bf16* __restrict__ wt_q,
                                            const float* __restrict__ pu, const float* __restrict__ pv, bf16* __restrict__ ub, bf16* __restrict__ vb) {
    const int lane = threadIdx.x & 63, wave = threadIdx.x >> 6;
    LAS float* scr = (LAS float*)(ldsb + wave * 16384);
    const int gw = blockIdx.x * NWAVE + wave, NGW = gridDim.x * NWAVE;
    constexpr int I_IN = (D_MODEL / 64) * (PROJ_LD / 32), I_OUT = (MIX_WIDTH / 64) * (D_MODEL / 32), I_Q = (D_MODEL / 64) * (2048 / 32);
    for (int it = gw; it < I_IN + I_OUT + I_Q; it += NGW) {
        int r = it;
        if (r < I_IN) { transpose_item<1>(w_in, D_MODEL, IN_WIDTH, PROJ_LD, wt_in, scr, r, lane); continue; } r -= I_IN;
        if (r < I_OUT) { transpose_item<0>(w_out, MIX_WIDTH, D_MODEL, D_MODEL, wt_out, scr, r, lane); continue; } r -= I_OUT;
        transpose_item<0>(w_q, D_MODEL, 2048, 2048, wt_q, scr, r, lane);
    }
    const size_t n8 = (size_t)T_ALL * D_MODEL / 8, np8 = (size_t)T_PROMPT * D_MODEL / 8;
    for (size_t i = (size_t)blockIdx.x * NTHR + threadIdx.x; i < n8; i += (size_t)gridDim.x * NTHR) {
        const float4* s = (i < np8) ? (const float4*)xp + 2 * i : (const float4*)xs + 2 * (i - np8);
        float4 a = s[0], b = s[1];
        v4u o; o.x = pk2(a.x, a.y); o.y = pk2(a.z, a.w); o.z = pk2(b.x, b.y); o.w = pk2(b.z, b.w);
        ((v4u*)A0)[i] = o;
    }
    const size_t t8 = (size_t)16384 * D_MODEL / 8;
    for (size_t i = (size_t)blockIdx.x * NTHR + threadIdx.x; i < 2 * t8; i += (size_t)gridDim.x * NTHR) {
        const float4* s = (i < t8) ? (const float4*)pu + 2 * i : (const float4*)pv + 2 * (i - t8);
        float4 a = s[0], b = s[1];
        v4u o; o.x = pk2(a.x, a.y); o.y = pk2(a.z, a.w); o.z = pk2(b.x, b.y); o.w = pk2(b.z, b.w);
        if (i < t8) ((v4u*)ub)[i] = o; else ((v4u*)vb)[i - t8] = o;
    }
}

__device__ __forceinline__ void ph_concat_x(const float* __restrict__ xp, const float* __restrict__ xs, float* __restrict__ xall) {
    const size_t n4 = (size_t)T_ALL * D_MODEL / 4, np4 = (size_t)T_PROMPT * D_MODEL / 4;
    for (size_t i = (size_t)blockIdx.x * NTHR + threadIdx.x; i < n4; i += (size_t)gridDim.x * NTHR) {
        float4 v = (i < np4) ? ((const float4*)xp)[i] : ((const float4*)xs)[i - np4];
        ((float4*)xall)[i] = v;
    }
}

__device__ __forceinline__ void ph_cache_copy(const float* __restrict__ ck, const float* __restrict__ cv, float* __restrict__ out) {
    const size_t per_b4 = (size_t)(WBUF - DEC_SEQ) * ATT_WIDTH / 4;
    const size_t total = per_b4 * DEC_BATCH;
    for (size_t i = (size_t)blockIdx.x * NTHR + threadIdx.x; i < total; i += (size_t)gridDim.x * NTHR) {
        size_t b = i / per_b4, r = i % per_b4;
        size_t src = (b * WBUF * ATT_WIDTH + DEC_SEQ * ATT_WIDTH) / 4 + r;
        size_t dst = (b * WBUF * ATT_WIDTH) / 4 + r;
        ((float4*)(out + OUT_SK))[dst] = ((const float4*)ck)[src];
        ((float4*)(out + OUT_SV))[dst] = ((const float4*)cv)[src];
    }
}

__device__ __forceinline__ void ph_post_proj(const float* __restrict__ proj, const float* __restrict__ state_conv,
                                             const float* __restrict__ conv_w, const float* __restrict__ conv_b, const float* __restrict__ dt_bias,
                                             float* __restrict__ xbc_act, float* __restrict__ dtv, float* __restrict__ qrot, float* __restrict__ krot,
                                             float* __restrict__ out) {
    const int tid = threadIdx.x & 255, half = threadIdx.x >> 8;
    for (int t = 2 * blockIdx.x + half; t < T_ALL; t += 2 * gridDim.x) {
        const bool is_p = t < T_PROMPT;
        int b, i, pos;
        if (is_p) { b = t / SEQ; i = t % SEQ; pos = i; } else { int ts = t - T_PROMPT; b = ts / DEC_SEQ; i = ts % DEC_SEQ; pos = PAST_LEN + i; }
        const float* row = proj + (size_t)t * PROJ_LD;
        for (int c = tid; c < CONV_DIM; c += 256) {
            float acc = conv_b[c];
#pragma unroll
            for (int tap = 0; tap < 4; ++tap) {
                int r = i - 3 + tap;
                float val;
                if (r >= 0) val = proj[(size_t)(t - i + r) * PROJ_LD + O_XBC + c];
                else val = is_p ? 0.f : state_conv[((size_t)b * 3 + (3 + r)) * CONV_DIM + c];
                acc += val * conv_w[tap * CONV_DIM + c];
            }
            xbc_act[(size_t)t * CONV_DIM + c] = silu_f(acc);
        }
        if (tid < SSD_HEADS) dtv[(size_t)t * SSD_HEADS + tid] = softplus_f(row[O_DT + tid] + dt_bias[tid]);
        for (int idx = tid; idx < 512; idx += 256) {
            int which = idx >> 8, h = (idx >> 5) & 7, j = idx & 31;
            double rev = (double)pos * ROPE_INV_REV[j];
            float fr = (float)(rev - floor(rev));
            float sn = __builtin_amdgcn_sinf(fr), cs = __builtin_amdgcn_cosf(fr);
            const float* src = row + (which ? O_K : O_Q) + h * 64;
            float t1 = src[j], t2 = src[j + 32];
            float o1 = t1 * cs - t2 * sn, o2 = t2 * cs + t1 * sn;
            float* dst = (which ? krot : qrot) + (size_t)t * ATT_WIDTH + h * 64;
            dst[j] = o1; dst[j + 32] = o2;
            if (which) {
                if (is_p) { if (i >= SEQ - WBUF) { float* o = out + OUT_PK + ((size_t)b * WBUF + (i - (SEQ - WBUF))) * ATT_WIDTH + h * 64; o[j] = o1; o[j + 32] = o2; } }
                else { float* o = out + OUT_SK + ((size_t)b * WBUF + (WBUF - DEC_SEQ + i)) * ATT_WIDTH + h * 64; o[j] = o1; o[j + 32] = o2; }
            }
        }
        for (int c = tid; c < ATT_WIDTH; c += 256) {
            float v = row[O_V + c];
            if (is_p) { if (i >= SEQ - WBUF) out[OUT_PV + ((size_t)b * WBUF + (i - (SEQ - WBUF))) * ATT_WIDTH + c] = v; }
            else out[OUT_SV + ((size_t)b * WBUF + (WBUF - DEC_SEQ + i)) * ATT_WIDTH + c] = v;
        }
        if (is_p) {
            if (i >= SEQ - 3) { int r = i - (SEQ - 3); for (int c = tid; c < CONV_DIM; c += 256) out[OUT_PC + ((size_t)b * 3 + r) * CONV_DIM + c] = row[O_XBC + c]; }
        } else {
            if (i >= 1) { int r = i - 1; for (int c = tid; c < CONV_DIM; c += 256) out[OUT_SC + ((size_t)b * 3 + r) * CONV_DIM + c] = row[O_XBC + c]; }
        }
    }
}


#define NB_LD 5632
#define NB_XBC 1536
#define NB_Q 4096
#define NB_K 4608
#define NB_V 5120
__device__ __forceinline__ void unpack8(const v4u w, float (&f)[8]) {
    f[0] = __builtin_bit_cast(float, w.x << 16); f[1] = __builtin_bit_cast(float, w.x & 0xffff0000u);
    f[2] = __builtin_bit_cast(float, w.y << 16); f[3] = __builtin_bit_cast(float, w.y & 0xffff0000u);
    f[4] = __builtin_bit_cast(float, w.z << 16); f[5] = __builtin_bit_cast(float, w.z & 0xffff0000u);
    f[6] = __builtin_bit_cast(float, w.w << 16); f[7] = __builtin_bit_cast(float, w.w & 0xffff0000u);
}
__device__ __forceinline__ void store8f(float* d, const float (&f)[8]) { *(float4*)d = make_float4(f[0], f[1], f[2], f[3]); *(float4*)(d + 4) = make_float4(f[4], f[5], f[6], f[7]); }
__device__ __forceinline__ void ph_post_proj2(const bf16* __restrict__ projb, const float* __restrict__ dtraw, const float* __restrict__ state_conv,
                                              const float* __restrict__ conv_w, const float* __restrict__ conv_b, const float* __restrict__ dt_bias,
                                              float* __restrict__ proj, float* __restrict__ xbc_act, bf16* __restrict__ xbc_b, float* __restrict__ dtv,
                                              float* __restrict__ qrot, float* __restrict__ krot, bf16* __restrict__ qrot_b, bf16* __restrict__ krot_b,
                                              float* __restrict__ out) {
    const int tid = threadIdx.x & 255, half = threadIdx.x >> 8;
    for (int t = 2 * blockIdx.x + half; t < T_ALL; t += 2 * gridDim.x) {
        const bool is_p = t < T_PROMPT;
        int b, i, pos;
        if (is_p) { b = t / SEQ; i = t % SEQ; pos = i; } else { int ts = t - T_PROMPT; b = ts / DEC_SEQ; i = ts % DEC_SEQ; pos = PAST_LEN + i; }
        const bf16* row = projb + (size_t)t * NB_LD;
        if (tid < 64) {
            float f[8]; unpack8(*(const v4u*)(row + NB_V + tid * 8), f);
            if (is_p) { if (i >= SEQ - WBUF) store8f(out + OUT_PV + ((size_t)b * WBUF + (i - (SEQ - WBUF))) * ATT_WIDTH + tid * 8, f); }
            else store8f(out + OUT_SV + ((size_t)b * WBUF + (WBUF - DEC_SEQ + i)) * ATT_WIDTH + tid * 8, f);
        }
        for (int c8 = tid; c8 < 320; c8 += 256) {
            const int c = c8 * 8;
            float acc[8], cur[8];
            { const float4 b0 = *(const float4*)(conv_b + c), b1 = *(const float4*)(conv_b + c + 4);
              acc[0] = b0.x; acc[1] = b0.y; acc[2] = b0.z; acc[3] = b0.w; acc[4] = b1.x; acc[5] = b1.y; acc[6] = b1.z; acc[7] = b1.w; }
#pragma unroll
            for (int tap = 0; tap < 4; ++tap) {
                const int r = i - 3 + tap;
                float val[8];
                if (r >= 0) unpack8(*(const v4u*)(projb + (size_t)(t - i + r) * NB_LD + NB_XBC + c), val);
                else if (!is_p) { const float* sp = state_conv + ((size_t)b * 3 + (3 + r)) * CONV_DIM + c; const float4 s0 = *(const float4*)sp, s1 = *(const float4*)(sp + 4);
                    val[0] = s0.x; val[1] = s0.y; val[2] = s0.z; val[3] = s0.w; val[4] = s1.x; val[5] = s1.y; val[6] = s1.z; val[7] = s1.w; }
                else {
#pragma unroll
                    for (int j = 0; j < 8; ++j) val[j] = 0.f; }
                const float4 w0 = *(const float4*)(conv_w + tap * CONV_DIM + c), w1 = *(const float4*)(conv_w + tap * CONV_DIM + c + 4);
                acc[0] += val[0] * w0.x; acc[1] += val[1] * w0.y; acc[2] += val[2] * w0.z; acc[3] += val[3] * w0.w;
                acc[4] += val[4] * w1.x; acc[5] += val[5] * w1.y; acc[6] += val[6] * w1.z; acc[7] += val[7] * w1.w;
                if (tap == 3) {
#pragma unroll
                    for (int j = 0; j < 8; ++j) cur[j] = val[j]; }
            }
#pragma unroll
            for (int j = 0; j < 8; ++j) acc[j] = silu_f(acc[j]);
            v4u o; o.x = pk2(acc[0], acc[1]); o.y = pk2(acc[2], acc[3]); o.z = pk2(acc[4], acc[5]); o.w = pk2(acc[6], acc[7]);
            *(v4u*)(xbc_b + (size_t)t * CONV_DIM + c) = o;
            if (is_p) { if (i >= SEQ - 3) store8f(out + OUT_PC + ((size_t)b * 3 + (i - (SEQ - 3))) * CONV_DIM + c, cur); }
            else { if (i >= 1) store8f(out + OUT_SC + ((size_t)b * 3 + (i - 1)) * CONV_DIM + c, cur); }
        }
        if (tid < SSD_HEADS) dtv[(size_t)t * SSD_HEADS + tid] = softplus_f(dtraw[(size_t)t * 32 + tid] + dt_bias[tid]);
        if (tid < 128) {
            const int which = tid >> 6, h = (tid >> 3) & 7, jc = tid & 7;
            const bf16* src = row + (which ? NB_K : NB_Q) + h * 64 + jc * 4;
            const uint2 lo = *(const uint2*)src, hi = *(const uint2*)(src + 32);
            float t1[4], t2[4], o1[4], o2[4];
            t1[0] = __builtin_bit_cast(float, lo.x << 16); t1[1] = __builtin_bit_cast(float, lo.x & 0xffff0000u); t1[2] = __builtin_bit_cast(float, lo.y << 16); t1[3] = __builtin_bit_cast(float, lo.y & 0xffff0000u);
            t2[0] = __builtin_bit_cast(float, hi.x << 16); t2[1] = __builtin_bit_cast(float, hi.x & 0xffff0000u); t2[2] = __builtin_bit_cast(float, hi.y << 16); t2[3] = __builtin_bit_cast(float, hi.y & 0xffff0000u);
#pragma unroll
            for (int e = 0; e < 4; ++e) {
                const double rev = (double)pos * ROPE_INV_REV[jc * 4 + e];
                const float fr = (float)(rev - floor(rev));
                const float sn = __builtin_amdgcn_sinf(fr), cs = __builtin_amdgcn_cosf(fr);
                o1[e] = t1[e] * cs - t2[e] * sn; o2[e] = t2[e] * cs + t1[e] * sn;
            }
            const size_t doff = (size_t)t * ATT_WIDTH + h * 64 + jc * 4;
            bf16* db = which ? krot_b : qrot_b;
            *(uint2*)(db + doff) = make_uint2(pk2(o1[0], o1[1]), pk2(o1[2], o1[3])); *(uint2*)(db + doff + 32) = make_uint2(pk2(o2[0], o2[1]), pk2(o2[2], o2[3]));
            if (which) {
                float* o = nullptr;
                if (is_p) { if (i >= SEQ - WBUF) o = out + OUT_PK + ((size_t)b * WBUF + (i - (SEQ - WBUF))) * ATT_WIDTH + h * 64 + jc * 4; }
                else o = out + OUT_SK + ((size_t)b * WBUF + (WBUF - DEC_SEQ + i)) * ATT_WIDTH + h * 64 + jc * 4;
                if (o) { *(float4*)o = make_float4(o1[0], o1[1], o1[2], o1[3]); *(float4*)(o + 32) = make_float4(o2[0], o2[1], o2[2], o2[3]); }
            }
        }
    }
}

#define SSD_CH 32
__device__ __forceinline__ void ph_ssd_naive(float* lds, const bf16* __restrict__ xbc_act, const float* __restrict__ dtv, const float* __restrict__ a_log,
                                             const float* __restrict__ d_skip, const float* __restrict__ state_ssm, float* __restrict__ ybuf, float* __restrict__ out) {
    float (*sx)[64] = (float (*)[64])lds;
    float (*sB)[128] = (float (*)[128])(lds + SSD_CH * 64);
    float (*sC)[128] = (float (*)[128])(lds + SSD_CH * 64 + SSD_CH * 128);
    float* sdt = lds + SSD_CH * 64 + 2 * SSD_CH * 128;
    const int tid = threadIdx.x, p = tid >> 3, ng = tid & 7;
    for (int vb = BATCH * SSD_HEADS + blockIdx.x; vb < (BATCH + DEC_BATCH) * SSD_HEADS; vb += gridDim.x) {
        const int seq = vb / SSD_HEADS, h = vb % SSD_HEADS, g = h / 6;
        const bool is_p = seq < BATCH;
        const int L = is_p ? SEQ : DEC_SEQ;
        const int t0 = is_p ? seq * SEQ : T_PROMPT + (seq - BATCH) * DEC_SEQ;
        const float A = -__expf(a_log[h]);
        const float D = d_skip[h];
        float hs[16];
        if (is_p) {
#pragma unroll
            for (int j = 0; j < 16; ++j) hs[j] = 0.f;
        } else {
            const float* s0 = state_ssm + (((size_t)(seq - BATCH) * SSD_HEADS + h) * 64 + p) * 128 + ng * 16;
#pragma unroll
            for (int j = 0; j < 16; ++j) hs[j] = s0[j];
        }
        for (int c0 = 0; c0 < L; c0 += SSD_CH) {
            const int nst = (L - c0) < SSD_CH ? (L - c0) : SSD_CH;
            __syncthreads();
            for (int idx = tid; idx < nst * 64; idx += NTHR) { int s = idx >> 6, c = idx & 63; sx[s][c] = bf2f(xbc_act[(size_t)(t0 + c0 + s) * CONV_DIM + h * 64 + c]); }
            for (int idx = tid; idx < nst * 128; idx += NTHR) { int s = idx >> 7, c = idx & 127;
                sB[s][c] = bf2f(xbc_act[(size_t)(t0 + c0 + s) * CONV_DIM + 1536 + g * 128 + c]);
                sC[s][c] = bf2f(xbc_act[(size_t)(t0 + c0 + s) * CONV_DIM + 2048 + g * 128 + c]); }
            if (tid < nst) sdt[tid] = dtv[(size_t)(t0 + c0 + tid) * SSD_HEADS + h];
            __syncthreads();
            for (int s = 0; s < nst; ++s) {
                const float dt = sdt[s], x = sx[s][p];
                const float a = __expf(dt * A), xdt = x * dt;
                float y = 0.f;
#pragma unroll
                for (int j = 0; j < 16; ++j) { hs[j] = a * hs[j] + xdt * sB[s][ng * 16 + j]; y += sC[s][ng * 16 + j] * hs[j]; }
                y += __shfl_xor(y, 1); y += __shfl_xor(y, 2); y += __shfl_xor(y, 4);
                if (ng == 0) ybuf[(size_t)(t0 + c0 + s) * MIX_WIDTH + h * 64 + p] = y + D * x;
            }
        }
        float* so = is_p ? out + OUT_PS + (((size_t)seq * SSD_HEADS + h) * 64 + p) * 128 + ng * 16
                         : out + OUT_SS + (((size_t)(seq - BATCH) * SSD_HEADS + h) * 64 + p) * 128 + ng * 16;
#pragma unroll
        for (int j = 0; j < 16; ++j) so[j] = hs[j];
    }
}

__device__ __forceinline__ void ph_gate_norm(const bf16* __restrict__ projb, const float* __restrict__ norm_g, const float* __restrict__ ybuf, bf16* __restrict__ A1) {
    const int w = threadIdx.x >> 6, lane = threadIdx.x & 63, g = w & 3;
    for (int t = T_PROMPT + 2 * blockIdx.x + (w >> 2); t < T_ALL; t += 2 * gridDim.x) {
        float v[6]; float ss = 0.f;
#pragma unroll
        for (int j = 0; j < 6; ++j) {
            int c = g * 384 + j * 64 + lane;
            float y = ybuf[(size_t)t * MIX_WIDTH + c], z = bf2f(projb[(size_t)t * NB_LD + c]);
            v[j] = y * silu_f(z); ss += v[j] * v[j];
        }
        ss = wave_sum(ss);
        const float r = rsqrtf(ss * (1.0f / 384.0f) + LN_EPS);
#pragma unroll
        for (int j = 0; j < 6; ++j) { int c = g * 384 + j * 64 + lane; A1[(size_t)t * MIX_WIDTH + c] = (bf16)f2bf(v[j] * r * norm_g[c]); }
    }
}

__device__ __forceinline__ void ph_attn_naive(float* lds, const float* __restrict__ proj, const float* __restrict__ qrot, const float* __restrict__ krot,
                                              const float* __restrict__ ck, const float* __restrict__ cv, float* __restrict__ ybuf) {
    float (*sq)[64] = (float (*)[64])lds;
    const int w = threadIdx.x >> 6, lane = threadIdx.x & 63;
    for (int vb = blockIdx.x; vb < T_SAMPLE * 8 / NWAVE; vb += gridDim.x) {
        const int item = T_PROMPT * 8 + vb * NWAVE + w;
        const int t = item >> 3, h = item & 7;
        const bool is_p = t < T_PROMPT;
        int b, i;
        if (is_p) { b = t / SEQ; i = t % SEQ; } else { int ts = t - T_PROMPT; b = ts / DEC_SEQ; i = ts % DEC_SEQ; }
        __syncthreads();
        sq[w][lane] = qrot[(size_t)t * ATT_WIDTH + h * 64 + lane];
        __syncthreads();
        const int qi = is_p ? i : WBUF + i;
        float sc[3][3];
        float mx = -INFINITY;
#pragma unroll
        for (int pt = 0; pt < 3; ++pt) {
            const int d = pt == 0 ? 1 : (pt == 1 ? 4 : 16);
#pragma unroll
            for (int sl = 0; sl < 3; ++sl) {
                const int m = lane + sl * 64;
                float s = -INFINITY;
                const int kj = qi - d * m;
                if (m <= 128 && kj >= 0) {
                    const float* kr;
                    if (is_p) kr = krot + (size_t)(b * SEQ + kj) * ATT_WIDTH + h * 64;
                    else kr = (kj >= WBUF) ? krot + (size_t)(T_PROMPT + b * DEC_SEQ + (kj - WBUF)) * ATT_WIDTH + h * 64
                                           : ck + ((size_t)b * WBUF + kj) * ATT_WIDTH + h * 64;
                    float a = 0.f;
#pragma unroll
                    for (int c = 0; c < 64; c += 4) { float4 kv = *(const float4*)(kr + c); a += kv.x * sq[w][c] + kv.y * sq[w][c + 1] + kv.z * sq[w][c + 2] + kv.w * sq[w][c + 3]; }
                    s = a * 0.125f;
                }
                sc[pt][sl] = s; mx = fmaxf(mx, s);
            }
        }
        mx = wave_max(mx);
        float lsum = 0.f;
#pragma unroll
        for (int pt = 0; pt < 3; ++pt)
#pragma unroll
            for (int sl = 0; sl < 3; ++sl) { float pv = (sc[pt][sl] == -INFINITY) ? 0.f : __expf(sc[pt][sl] - mx); sc[pt][sl] = pv; lsum += pv; }
        lsum = wave_sum(lsum);
        float o = 0.f;
#pragma unroll
        for (int pt = 0; pt < 3; ++pt) {
            const int d = pt == 0 ? 1 : (pt == 1 ? 4 : 16);
#pragma unroll
            for (int sl = 0; sl < 3; ++sl) {
                const int mend = sl < 2 ? 64 : 1;
                for (int ml = 0; ml < mend; ++ml) {
                    const int m = ml + sl * 64;
                    const int kj = qi - d * m;
                    const float pv = __shfl(sc[pt][sl], ml);
                    if (kj < 0) continue;
                    const float* vr;
                    if (is_p) vr = proj + (size_t)(b * SEQ + kj) * PROJ_LD + O_V + h * 64;
                    else vr = (kj >= WBUF) ? proj + (size_t)(T_PROMPT + b * DEC_SEQ + (kj - WBUF)) * PROJ_LD + O_V + h * 64
                                           : cv + ((size_t)b * WBUF + kj) * ATT_WIDTH + h * 64;
                    o += pv * vr[lane];
                }
            }
        }
        ybuf[(size_t)t * MIX_WIDTH + SSD_WIDTH + h * 64 + lane] = o / lsum;
    }
}

__device__ __forceinline__ void ph_ln_res(const float* __restrict__ res, const float* __restrict__ add, const float* __restrict__ gam,
                                          const float* __restrict__ bet, float* __restrict__ dst, bf16* __restrict__ dstb) {
    const int lane = threadIdx.x & 63;
    for (int t = blockIdx.x * NWAVE + (threadIdx.x >> 6); t < T_ALL; t += gridDim.x * NWAVE) {
        float v[16]; float s = 0.f;
#pragma unroll
        for (int j = 0; j < 16; ++j) { int c = j * 64 + lane; v[j] = ALPHA_F * res[(size_t)t * D_MODEL + c] + add[(size_t)t * D_MODEL + c]; s += v[j]; }
        s = wave_sum(s);
        const float mu = s * (1.0f / 1024.0f);
        float q = 0.f;
#pragma unroll
        for (int j = 0; j < 16; ++j) { v[j] -= mu; q += v[j] * v[j]; }
        q = wave_sum(q);
        const float r = rsqrtf(q * (1.0f / 1024.0f) + LN_EPS);
#pragma unroll
        for (int j = 0; j < 16; ++j) { int c = j * 64 + lane; float o = v[j] * r * gam[c] + bet[c]; dst[(size_t)t * D_MODEL + c] = o; dstb[(size_t)t * D_MODEL + c] = (bf16)f2bf(o); }
    }
}

__device__ __forceinline__ void ph_peer_route(float* lds, const float* __restrict__ qh, const float* __restrict__ keys1, const float* __restrict__ keys2,
                                              int* __restrict__ eidx, float* __restrict__ gate) {
    float (*sq)[256] = (float (*)[256])lds;
    float (*sv)[2][16] = (float (*)[2][16])(lds + NWAVE * 256);
    int (*si)[2][16] = (int (*)[2][16])(lds + NWAVE * 256 + NWAVE * 32);
    const int w = threadIdx.x >> 6, lane = threadIdx.x & 63;
    for (int vb = blockIdx.x; vb < T_ALL * 8 / NWAVE; vb += gridDim.x) {
        const int item = vb * NWAVE + w;
        const int t = item >> 3, h = item & 7;
        __syncthreads();
        for (int c = lane; c < 256; c += 64) sq[w][c] = qh[(size_t)t * 2048 + h * 256 + c];
        __syncthreads();
#pragma unroll
        for (int half = 0; half < 2; ++half) {
            const float* keys = half ? keys2 : keys1;
            float s[2];
#pragma unroll
            for (int sl = 0; sl < 2; ++sl) {
                const float* kr = keys + (size_t)(lane + sl * 64) * 128;
                float a = 0.f;
#pragma unroll 8
                for (int c = 0; c < 128; c += 4) { float4 kv = *(const float4*)(kr + c); const float* qq = &sq[w][half * 128 + c]; a += kv.x * qq[0] + kv.y * qq[1] + kv.z * qq[2] + kv.w * qq[3]; }
                s[sl] = a;
            }
            for (int r = 0; r < 16; ++r) {
                float bv; int bi;
                if (s[0] >= s[1]) { bv = s[0]; bi = lane; } else { bv = s[1]; bi = lane + 64; }
#pragma unroll
                for (int o = 32; o > 0; o >>= 1) {
                    float ov = __shfl_xor(bv, o); int oi = __shfl_xor(bi, o);
                    if (ov > bv || (ov == bv && oi < bi)) { bv = ov; bi = oi; }
                }
                if (lane == 0) { sv[w][half][r] = bv; si[w][half][r] = bi; }
                if (bi == lane) s[0] = -INFINITY;
                if (bi == lane + 64) s[1] = -INFINITY;
            }
        }
        __syncthreads();
        float c[4];
#pragma unroll
        for (int j = 0; j < 4; ++j) { int ci = lane * 4 + j; c[j] = sv[w][0][ci >> 4] + sv[w][1][ci & 15]; }
        float myv = 0.f; int myc = 0;
        for (int r = 0; r < 16; ++r) {
            float bv = c[0]; int bi = lane * 4;
#pragma unroll
            for (int j = 1; j < 4; ++j) if (c[j] > bv) { bv = c[j]; bi = lane * 4 + j; }
#pragma unroll
            for (int o = 32; o > 0; o >>= 1) {
                float ov = __shfl_xor(bv, o); int oi = __shfl_xor(bi, o);
                if (ov > bv || (ov == bv && oi < bi)) { bv = ov; bi = oi; }
            }
            if (lane == r) { myv = bv; myc = bi; }
#pragma unroll
            for (int j = 0; j < 4; ++j) if (bi == lane * 4 + j) c[j] = -INFINITY;
        }
        float v = lane < 16 ? myv : -INFINITY;
        float mx = wave_max(v);
        float e = lane < 16 ? __expf(v - mx) : 0.f;
        float sum = wave_sum(e);
        if (lane < 16) {
            int ex = si[w][0][myc >> 4] * PEER_NKEYS + si[w][1][myc & 15];
            eidx[(size_t)t * 128 + h * 16 + lane] = ex;
            gate[(size_t)t * 128 + h * 16 + lane] = e / sum;
        }
    }
}

__device__ __forceinline__ void ph_peer_ffn(const float* __restrict__ hbuf, const int* __restrict__ eidx, const float* __restrict__ gate,
                                            const bf16* __restrict__ ub, const bf16* __restrict__ vb, const float* __restrict__ gam,
                                            const float* __restrict__ bet, float* __restrict__ out) {
    const int lane = threadIdx.x & 63;
    for (int t = blockIdx.x * NWAVE + (threadIdx.x >> 6); t < T_ALL; t += gridDim.x * NWAVE) {
        float x[16], acc[16];
        { const float* xr = hbuf + (size_t)t * D_MODEL + lane * 8;
          const float4 a = *(const float4*)xr, b = *(const float4*)(xr + 4), c = *(const float4*)(xr + 512), d = *(const float4*)(xr + 516);
          x[0] = a.x; x[1] = a.y; x[2] = a.z; x[3] = a.w; x[4] = b.x; x[5] = b.y; x[6] = b.z; x[7] = b.w;
          x[8] = c.x; x[9] = c.y; x[10] = c.z; x[11] = c.w; x[12] = d.x; x[13] = d.y; x[14] = d.z; x[15] = d.w; }
#pragma unroll
        for (int j = 0; j < 16; ++j) acc[j] = 0.f;
        for (int k = 0; k < 128; ++k) {
            const int e = eidx[(size_t)t * 128 + k];
            const float g = gate[(size_t)t * 128 + k];
            const bf16* ur = ub + (size_t)e * D_MODEL + lane * 8;
            float u0[8], u1[8];
            unpack8(*(const v4u*)ur, u0); unpack8(*(const v4u*)(ur + 512), u1);
            float d = 0.f;
#pragma unroll
            for (int j = 0; j < 8; ++j) d += u0[j] * x[j] + u1[j] * x[8 + j];
            d = wave_sum(d);
            const float wgt = g * gelu_f(d);
            const bf16* vr = vb + (size_t)e * D_MODEL + lane * 8;
            unpack8(*(const v4u*)vr, u0); unpack8(*(const v4u*)(vr + 512), u1);
#pragma unroll
            for (int j = 0; j < 8; ++j) { acc[j] += wgt * u0[j]; acc[8 + j] += wgt * u1[j]; }
        }
        float s = 0.f;
#pragma unroll
        for (int j = 0; j < 16; ++j) { acc[j] += ALPHA_F * x[j]; s += acc[j]; }
        s = wave_sum(s);
        const float mu = s * (1.0f / 1024.0f);
        float q = 0.f;
#pragma unroll
        for (int j = 0; j < 16; ++j) { acc[j] -= mu; q += acc[j] * acc[j]; }
        q = wave_sum(q);
        const float r = rsqrtf(q * (1.0f / 1024.0f) + LN_EPS);
        float* dst = ((t < T_PROMPT) ? out + OUT_YP + (size_t)t * D_MODEL : out + OUT_YS + (size_t)(t - T_PROMPT) * D_MODEL) + lane * 8;
#pragma unroll
        for (int q4 = 0; q4 < 4; ++q4) {
            const int eo = (q4 >> 1) * 512 + (q4 & 1) * 4;
            const float4 g4 = *(const float4*)(gam + lane * 8 + eo), b4 = *(const float4*)(bet + lane * 8 + eo);
            float4 o; o.x = acc[q4 * 4 + 0] * r * g4.x + b4.x; o.y = acc[q4 * 4 + 1] * r * g4.y + b4.y; o.z = acc[q4 * 4 + 2] * r * g4.z + b4.z; o.w = acc[q4 * 4 + 3] * r * g4.w + b4.w;
            *(float4*)(dst + eo) = o;
        }
    }
}

__device__ __forceinline__ float peer_dot16(const v4u a, const v4u b, const float (&x)[16]) {
    float u0[8], u1[8]; unpack8(a, u0); unpack8(b, u1);
    float d = 0.f;
#pragma unroll
    for (int j = 0; j < 8; ++j) d += u0[j] * x[j] + u1[j] * x[8 + j];
    return d;
}
#define PEER_TR_STEP(N, M) _Pragma("unroll") for (int i = 0; i < N; ++i) { const bool up = (lane & M) != 0; const float keep = up ? part[i + N] : part[i]; const float send = up ? part[i] : part[i + N]; part[i] = keep + __shfl_xor(send, M); }
__device__ __forceinline__ void ph_peer_ffn2(const float* __restrict__ hbuf, const int* __restrict__ eidx, const float* __restrict__ gate,
                                             const bf16* __restrict__ ub, const bf16* __restrict__ vb, const float* __restrict__ gam,
                                             const float* __restrict__ bet, float* __restrict__ out) {
    const int lane0 = threadIdx.x & 63;
    for (int t = blockIdx.x * NWAVE + (threadIdx.x >> 6); t < T_ALL; t += gridDim.x * NWAVE) {
        int lane = lane0; asm volatile("" : "+v"(lane));
        float x[16];
        { const float* xr = hbuf + (size_t)t * D_MODEL + lane * 8;
          const float4 a = *(const float4*)xr, b = *(const float4*)(xr + 4), c = *(const float4*)(xr + 512), d = *(const float4*)(xr + 516);
          x[0] = a.x; x[1] = a.y; x[2] = a.z; x[3] = a.w; x[4] = b.x; x[5] = b.y; x[6] = b.z; x[7] = b.w;
          x[8] = c.x; x[9] = c.y; x[10] = c.z; x[11] = c.w; x[12] = d.x; x[13] = d.y; x[14] = d.z; x[15] = d.w; }
        int ev[2]; float wv[4];
        ev[0] = eidx[(size_t)t * 128 + lane]; ev[1] = eidx[(size_t)t * 128 + 64 + lane];
#pragma unroll
        for (int rd = 0; rd < 4; ++rd) wv[rd] = gate[(size_t)t * 128 + rd * 32 + (lane >> 1)];
#pragma unroll
        for (int rd = 0; rd < 4; ++rd) {
            float part[32];
#pragma unroll
            for (int kb = 0; kb < 8; ++kb) {
                v4u ra[4], rb[4];
#pragma unroll
                for (int k8 = 0; k8 < 4; ++k8) {
                    const int e = __builtin_amdgcn_readlane(ev[rd >> 1], (rd & 1) * 32 + kb * 4 + k8);
                    const bf16* ur = ub + (size_t)e * D_MODEL + lane * 8;
                    ra[k8] = *(const v4u*)ur; rb[k8] = *(const v4u*)(ur + 512);
                }
#pragma unroll
                for (int k8 = 0; k8 < 4; ++k8) part[kb * 4 + k8] = peer_dot16(ra[k8], rb[k8], x);
            }
            PEER_TR_STEP(16, 32) PEER_TR_STEP(8, 16) PEER_TR_STEP(4, 8) PEER_TR_STEP(2, 4) PEER_TR_STEP(1, 2)
            const float hid = part[0] + __shfl_xor(part[0], 1);
            wv[rd] *= gelu_f(hid);
        }
        float acc[16];
#pragma unroll
        for (int j = 0; j < 16; ++j) acc[j] = 0.f;
#pragma unroll
        for (int rd = 0; rd < 4; ++rd) {
#pragma unroll
            for (int kb = 0; kb < 4; ++kb) {
                v4u ra[8], rb[8];
#pragma unroll
                for (int k8 = 0; k8 < 8; ++k8) {
                    const int e = __builtin_amdgcn_readlane(ev[rd >> 1], (rd & 1) * 32 + kb * 8 + k8);
                    const bf16* vr = vb + (size_t)e * D_MODEL + lane * 8;
                    ra[k8] = *(const v4u*)vr; rb[k8] = *(const v4u*)(vr + 512);
                }
#pragma unroll
                for (int k8 = 0; k8 < 8; ++k8) {
                    const float wk = __builtin_bit_cast(float, __builtin_amdgcn_readlane(__builtin_bit_cast(int, wv[rd]), 2 * (kb * 8 + k8)));
                    float u0[8], u1[8]; unpack8(ra[k8], u0); unpack8(rb[k8], u1);
#pragma unroll
                    for (int j = 0; j < 8; ++j) { acc[j] += wk * u0[j]; acc[8 + j] += wk * u1[j]; }
                }
            }
        }
        float s = 0.f;
#pragma unroll
        for (int j = 0; j < 16; ++j) { acc[j] += ALPHA_F * x[j]; s += acc[j]; }
        s = wave_sum(s);
        const float mu = s * (1.0f / 1024.0f);
        float q = 0.f;
#pragma unroll
        for (int j = 0; j < 16; ++j) { acc[j] -= mu; q += acc[j] * acc[j]; }
        q = wave_sum(q);
        const float r = rsqrtf(q * (1.0f / 1024.0f) + LN_EPS);
        float* dst = ((t < T_PROMPT) ? out + OUT_YP + (size_t)t * D_MODEL : out + OUT_YS + (size_t)(t - T_PROMPT) * D_MODEL) + lane * 8;
#pragma unroll
        for (int q4 = 0; q4 < 4; ++q4) {
            const int eo = (q4 >> 1) * 512 + (q4 & 1) * 4;
            const float4 g4 = *(const float4*)(gam + lane * 8 + eo), b4 = *(const float4*)(bet + lane * 8 + eo);
            float4 o; o.x = acc[q4 * 4 + 0] * r * g4.x + b4.x; o.y = acc[q4 * 4 + 1] * r * g4.y + b4.y; o.z = acc[q4 * 4 + 2] * r * g4.z + b4.z; o.w = acc[q4 * 4 + 3] * r * g4.w + b4.w;
            *(float4*)(dst + eo) = o;
        }
    }
}

__device__ __forceinline__ void ph_attn_sample(float* lds, const bf16* __restrict__ qrot_b, const bf16* __restrict__ krot_b, const bf16* __restrict__ projb,
                                               const float* __restrict__ ck, const float* __restrict__ cv, bf16* __restrict__ A1) {
    float (*sq)[64] = (float (*)[64])lds;
    const int w = threadIdx.x >> 6, lane0 = threadIdx.x & 63;
    for (int vb = blockIdx.x; vb < T_SAMPLE * 8 / NWAVE; vb += gridDim.x) {
        int lane = lane0; asm volatile("" : "+v"(lane));
        const int item = vb * NWAVE + w, ts = item >> 3, hd = item & 7, b = ts >> 2, i = ts & 3, t = T_PROMPT + ts;
        __syncthreads();
        sq[w][lane] = bf2f(qrot_b[(size_t)t * ATT_WIDTH + hd * 64 + lane]);
        __syncthreads();
        const int qi = WBUF + i;
        float sc[8];
        float mx = -INFINITY;
#pragma unroll
        for (int slot = 0; slot < 7; ++slot) {
            const int pt = slot < 6 ? (slot >> 1) : (lane < 3 ? lane : 0);
            const int m = slot < 6 ? lane + 64 * (slot & 1) : 128;
            const int kj = qi - (m << (2 * pt));
            const bool valid = (slot < 6 || lane < 3) && kj < WBUF;
            const int kc = kj < WBUF ? kj : WBUF - 1;
            const float* kr = ck + ((size_t)b * WBUF + kc) * ATT_WIDTH + hd * 64;
            float a = 0.f;
#pragma unroll
            for (int c = 0; c < 64; c += 4) { const float4 kv = *(const float4*)(kr + c); a += kv.x * sq[w][c] + kv.y * sq[w][c + 1] + kv.z * sq[w][c + 2] + kv.w * sq[w][c + 3]; }
            const float s = valid ? a * 0.125f : -INFINITY;
            sc[slot] = s; mx = fmaxf(mx, s);
        }
        const int nt7 = lane <= i ? i - lane : i;
        const bool valid7 = lane < i + 3;
        {
            const bf16* kr = krot_b + (size_t)(T_PROMPT + b * DEC_SEQ + nt7) * ATT_WIDTH + hd * 64;
            float a = 0.f;
#pragma unroll
            for (int c = 0; c < 64; c += 8) { float f[8]; unpack8(*(const v4u*)(kr + c), f);
#pragma unroll
                for (int j = 0; j < 8; ++j) a += f[j] * sq[w][c + j]; }
            const float s = valid7 ? a * 0.125f : -INFINITY;
            sc[7] = s; mx = fmaxf(mx, s);
        }
        mx = wave_max(mx);
        float lsum = 0.f;
#pragma unroll
        for (int slot = 0; slot < 8; ++slot) { const float pv = __expf(sc[slot] - mx); sc[slot] = pv; lsum += pv; }
        lsum = wave_sum(lsum);
        float part[64];
#pragma unroll
        for (int c = 0; c < 64; ++c) part[c] = 0.f;
#pragma unroll
        for (int slot = 0; slot < 7; ++slot) {
            const int pt = slot < 6 ? (slot >> 1) : (lane < 3 ? lane : 0);
            const int m = slot < 6 ? lane + 64 * (slot & 1) : 128;
            const int kj = qi - (m << (2 * pt));
            const int kc = kj < WBUF ? kj : WBUF - 1;
            const float pv = sc[slot];
            const float* vr = cv + ((size_t)b * WBUF + kc) * ATT_WIDTH + hd * 64;
#pragma unroll
            for (int c = 0; c < 64; c += 4) { const float4 vv = *(const float4*)(vr + c); part[c] += pv * vv.x; part[c + 1] += pv * vv.y; part[c + 2] += pv * vv.z; part[c + 3] += pv * vv.w; }
        }
        {
            const float pv = sc[7];
            const bf16* vr = projb + (size_t)(T_PROMPT + b * DEC_SEQ + nt7) * NB_LD + NB_V + hd * 64;
#pragma unroll
            for (int c = 0; c < 64; c += 8) { float f[8]; unpack8(*(const v4u*)(vr + c), f);
#pragma unroll
                for (int j = 0; j < 8; ++j) part[c + j] += pv * f[j]; }
        }
        PEER_TR_STEP(32, 32) PEER_TR_STEP(16, 16) PEER_TR_STEP(8, 8) PEER_TR_STEP(4, 4) PEER_TR_STEP(2, 2) PEER_TR_STEP(1, 1)
        A1[(size_t)t * MIX_WIDTH + SSD_WIDTH + hd * 64 + lane] = (bf16)f2bf(part[0] / lsum);
    }
}

typedef float f32x16 __attribute__((ext_vector_type(16)));
typedef short s16x8 __attribute__((ext_vector_type(8)));
typedef short s16x4 __attribute__((ext_vector_type(4)));
typedef float f32x4v __attribute__((ext_vector_type(4)));
#define SSD_L_ACS 0
#define SSD_L_DTS 3072
#define SSD_L_BM 6144
#define SSD_RS_B 272
#define SSD_L_X (6144 + 128 * 272)
#define SSD_RS_X 144
#define SSD_XIMG (128 * 144)
#define SSD_RS_Y 784
template <int OFF0, int OFF1>
__device__ __forceinline__ s16x8 tr_frag(unsigned base) {
    s16x4 a, b;
    asm volatile("ds_read_b64_tr_b16 %0, %2 offset:%3\n\tds_read_b64_tr_b16 %1, %2 offset:%4\n\ts_waitcnt lgkmcnt(0)"
                 : "=&v"(a), "=&v"(b) : "v"(base), "n"(OFF0), "n"(OFF1) : "memory");
    return __builtin_shufflevector(a, b, 0, 1, 2, 3, 4, 5, 6, 7);
}
__device__ __forceinline__ unsigned lds_addr(LAS unsigned char* p) { return (unsigned)(size_t)p; }

__device__ __forceinline__ void ssd_chunk_acs(LAS unsigned char* ldsb, const float* __restrict__ dtv, const float* __restrict__ a_log, int t0, int g, float* cdec_out) {
    const int w = __builtin_amdgcn_readfirstlane(threadIdx.x >> 6), lane = threadIdx.x & 63;
    if (w < 6) {
        const int head = 6 * g + w;
        const float A = -__expf(a_log[head]);
        const float v0 = dtv[(size_t)(t0 + 2 * lane) * SSD_HEADS + head], v1 = dtv[(size_t)(t0 + 2 * lane + 1) * SSD_HEADS + head];
        const float a1 = v1 * A;
        float s = v0 * A + a1;
#pragma unroll
        for (int o = 1; o < 64; o <<= 1) { const float tmp = __shfl_up(s, o); if (lane >= o) s += tmp; }
        LAS float* acs = (LAS float*)(ldsb + SSD_L_ACS) + w * 128;
        LAS float* dts = (LAS float*)(ldsb + SSD_L_DTS) + w * 128;
        acs[2 * lane] = s - a1; acs[2 * lane + 1] = s;
        dts[2 * lane] = v0; dts[2 * lane + 1] = v1;
        if (cdec_out && lane == 63) cdec_out[head] = __expf(s);
    }
}

__device__ __forceinline__ void ph_ssd_states(LAS unsigned char* ldsb, const bf16* __restrict__ xbc_b, const float* __restrict__ dtv, const float* __restrict__ a_log,
                                              bf16* __restrict__ Sbuf, float* __restrict__ cdec) {
    const int tid = threadIdx.x, w = __builtin_amdgcn_readfirstlane(tid >> 6), lane = tid & 63;
    const int r = lane & 31, h = lane >> 5, blk = (lane >> 4) & 1, q = (lane & 15) >> 2, pp = lane & 3;
    const int nt = w & 3, pt = w >> 2;
    for (int unit = blockIdx.x; unit < BATCH * 64 * SSD_GROUPS; unit += gridDim.x) {
        const int g = unit & 3, bc = unit >> 2;
        const int t0 = bc * 128;
        __syncthreads();
        ssd_chunk_acs(ldsb, dtv, a_log, t0, g, cdec + (size_t)bc * SSD_HEADS);
        for (int idx = tid; idx < 2048; idx += NTHR) { const int row = idx >> 4, ch = idx & 15;
            const v4u v = *(const v4u*)(xbc_b + (size_t)(t0 + row) * CONV_DIM + 1536 + 128 * g + ch * 8);
            *(LAS v4u*)(ldsb + SSD_L_BM + row * SSD_RS_B + ch * 16) = v; }
        __syncthreads();
        for (int idx = tid; idx < 6144; idx += NTHR) { const int hh = idx >> 10, rem = idx & 1023, row = rem >> 3, ch = rem & 7;
            const LAS float* acs = (const LAS float*)(ldsb + SSD_L_ACS) + hh * 128; const LAS float* dts = (const LAS float*)(ldsb + SSD_L_DTS) + hh * 128;
            const float wgt = dts[row] * __expf(acs[127] - acs[row]);
            float f[8]; unpack8(*(const v4u*)(xbc_b + (size_t)(t0 + row) * CONV_DIM + (6 * g + hh) * 64 + ch * 8), f);
            v4u o; o.x = pk2(f[0] * wgt, f[1] * wgt); o.y = pk2(f[2] * wgt, f[3] * wgt); o.z = pk2(f[4] * wgt, f[5] * wgt); o.w = pk2(f[6] * wgt, f[7] * wgt);
            *(LAS v4u*)(ldsb + SSD_L_X + hh * SSD_XIMG + row * SSD_RS_X + ch * 16) = o; }
        __syncthreads();
        const unsigned abase = lds_addr(ldsb + SSD_L_BM) + (8 * h + q) * SSD_RS_B + (32 * nt + 16 * blk + 4 * pp) * 2;
        s16x8 afr[8];
        afr[0] = tr_frag<0 * 16 * SSD_RS_B, (0 * 16 + 4) * SSD_RS_B>(abase); afr[1] = tr_frag<1 * 16 * SSD_RS_B, (1 * 16 + 4) * SSD_RS_B>(abase);
        afr[2] = tr_frag<2 * 16 * SSD_RS_B, (2 * 16 + 4) * SSD_RS_B>(abase); afr[3] = tr_frag<3 * 16 * SSD_RS_B, (3 * 16 + 4) * SSD_RS_B>(abase);
        afr[4] = tr_frag<4 * 16 * SSD_RS_B, (4 * 16 + 4) * SSD_RS_B>(abase); afr[5] = tr_frag<5 * 16 * SSD_RS_B, (5 * 16 + 4) * SSD_RS_B>(abase);
        afr[6] = tr_frag<6 * 16 * SSD_RS_B, (6 * 16 + 4) * SSD_RS_B>(abase); afr[7] = tr_frag<7 * 16 * SSD_RS_B, (7 * 16 + 4) * SSD_RS_B>(abase);
#pragma unroll
        for (int hh = 0; hh < 6; ++hh) {
            const unsigned xb = lds_addr(ldsb + SSD_L_X + hh * SSD_XIMG) + (8 * h + q) * SSD_RS_X + (32 * pt + 16 * blk + 4 * pp) * 2;
            f32x16 acc;
#pragma unroll
            for (int i = 0; i < 16; ++i) acc[i] = 0.f;
            acc = __builtin_amdgcn_mfma_f32_32x32x16_bf16(afr[0], tr_frag<0 * 16 * SSD_RS_X, (0 * 16 + 4) * SSD_RS_X>(xb), acc, 0, 0, 0);
            acc = __builtin_amdgcn_mfma_f32_32x32x16_bf16(afr[1], tr_frag<1 * 16 * SSD_RS_X, (1 * 16 + 4) * SSD_RS_X>(xb), acc, 0, 0, 0);
            acc = __builtin_amdgcn_mfma_f32_32x32x16_bf16(afr[2], tr_frag<2 * 16 * SSD_RS_X, (2 * 16 + 4) * SSD_RS_X>(xb), acc, 0, 0, 0);
            acc = __builtin_amdgcn_mfma_f32_32x32x16_bf16(afr[3], tr_frag<3 * 16 * SSD_RS_X, (3 * 16 + 4) * SSD_RS_X>(xb), acc, 0, 0, 0);
            acc = __builtin_amdgcn_mfma_f32_32x32x16_bf16(afr[4], tr_frag<4 * 16 * SSD_RS_X, (4 * 16 + 4) * SSD_RS_X>(xb), acc, 0, 0, 0);
            acc = __builtin_amdgcn_mfma_f32_32x32x16_bf16(afr[5], tr_frag<5 * 16 * SSD_RS_X, (5 * 16 + 4) * SSD_RS_X>(xb), acc, 0, 0, 0);
            acc = __builtin_amdgcn_mfma_f32_32x32x16_bf16(afr[6], tr_frag<6 * 16 * SSD_RS_X, (6 * 16 + 4) * SSD_RS_X>(xb), acc, 0, 0, 0);
            acc = __builtin_amdgcn_mfma_f32_32x32x16_bf16(afr[7], tr_frag<7 * 16 * SSD_RS_X, (7 * 16 + 4) * SSD_RS_X>(xb), acc, 0, 0, 0);
            bf16* dst = Sbuf + (((size_t)bc * SSD_HEADS + 6 * g + hh) * 64 + 32 * pt + r) * 128 + 32 * nt + 4 * h;
#pragma unroll
            for (int q4 = 0; q4 < 4; ++q4) *(uint2*)(dst + 8 * q4) = make_uint2(pk2(acc[4 * q4], acc[4 * q4 + 1]), pk2(acc[4 * q4 + 2], acc[4 * q4 + 3]));
        }
    }
}

__device__ __forceinline__ void ph_ssd_scan(const bf16* __restrict__ Sbuf, const float* __restrict__ cdec, bf16* __restrict__ Hin, float* __restrict__ out) {
    for (int idx = blockIdx.x * NTHR + threadIdx.x; idx < BATCH * SSD_HEADS * 64 * 16; idx += gridDim.x * NTHR) {
        const int n8 = idx & 15, p = (idx >> 4) & 63, hb = idx >> 10, hd = hb % SSD_HEADS, b = hb / SSD_HEADS;
        float st[8];
#pragma unroll
        for (int j = 0; j < 8; ++j) st[j] = 0.f;
#pragma unroll 8
        for (int c = 0; c < 64; ++c) {
            const size_t base = ((((size_t)(b * 64 + c)) * SSD_HEADS + hd) * 64 + p) * 128 + n8 * 8;
            v4u o; o.x = pk2(st[0], st[1]); o.y = pk2(st[2], st[3]); o.z = pk2(st[4], st[5]); o.w = pk2(st[6], st[7]);
            *(v4u*)(Hin + base) = o;
            float s[8]; unpack8(*(const v4u*)(Sbuf + base), s);
            const float a = cdec[(size_t)(b * 64 + c) * SSD_HEADS + hd];
#pragma unroll
            for (int j = 0; j < 8; ++j) st[j] = a * st[j] + s[j];
        }
        store8f(out + OUT_PS + (((size_t)b * SSD_HEADS + hd) * 64 + p) * 128 + n8 * 8, st);
    }
}

__device__ __forceinline__ void ph_ssd_out(LAS unsigned char* ldsb, const bf16* __restrict__ xbc_b, const bf16* __restrict__ projb, const float* __restrict__ dtv,
                                           const float* __restrict__ a_log, const float* __restrict__ d_skip, const float* __restrict__ norm_g,
                                           const bf16* __restrict__ Hin, bf16* __restrict__ A1) {
    const int tid = threadIdx.x, w = __builtin_amdgcn_readfirstlane(tid >> 6), lane = tid & 63;
    const int r = lane & 31, h = lane >> 5, blk = (lane >> 4) & 1, q = (lane & 15) >> 2, pp = lane & 3;
    const int lt = w & 3, hs = w >> 2;
    for (int unit = blockIdx.x; unit < BATCH * 64 * SSD_GROUPS; unit += gridDim.x) {
        const int g = unit & 3, bc = unit >> 2;
        const int t0 = bc * 128;
        __syncthreads();
        ssd_chunk_acs(ldsb, dtv, a_log, t0, g, nullptr);
        for (int idx = tid; idx < 2048; idx += NTHR) { const int row = idx >> 4, ch = idx & 15;
            const v4u v = *(const v4u*)(xbc_b + (size_t)(t0 + row) * CONV_DIM + 1536 + 128 * g + ch * 8);
            *(LAS v4u*)(ldsb + SSD_L_BM + row * SSD_RS_B + ch * 16) = v; }
        for (int idx = tid; idx < 6144; idx += NTHR) { const int hh = idx >> 10, rem = idx & 1023, row = rem >> 3, ch = rem & 7;
            const v4u v = *(const v4u*)(xbc_b + (size_t)(t0 + row) * CONV_DIM + (6 * g + hh) * 64 + ch * 8);
            *(LAS v4u*)(ldsb + SSD_L_X + hh * SSD_XIMG + row * SSD_RS_X + ch * 16) = v; }
        __syncthreads();
        const bf16* cp = xbc_b + (size_t)(t0 + 32 * lt + r) * CONV_DIM + 2048 + 128 * g + 8 * h;
        const int lcol = 32 * lt + r;
        const LAS float* acsb = (const LAS float*)(ldsb + SSD_L_ACS) + 3 * hs * 128; const LAS float* dtsb = (const LAS float*)(ldsb + SSD_L_DTS) + 3 * hs * 128;
        f32x16 y[3][2];
#pragma unroll
        for (int h3 = 0; h3 < 3; ++h3)
#pragma unroll
            for (int i = 0; i < 16; ++i) { y[h3][0][i] = 0.f; y[h3][1][i] = 0.f; }
#pragma unroll 1
        for (int ks = 0; ks < 8; ++ks) {
            const s16x8 cf = *(const s16x8*)(cp + 16 * ks);
#pragma unroll
            for (int h3 = 0; h3 < 3; ++h3) {
                const bf16* hp = Hin + (((size_t)bc * SSD_HEADS + 6 * g + 3 * hs + h3) * 64 + r) * 128 + 8 * h + 16 * ks;
                const s16x8 h0 = *(const s16x8*)hp, h1 = *(const s16x8*)(hp + 32 * 128);
                y[h3][0] = __builtin_amdgcn_mfma_f32_32x32x16_bf16(cf, h0, y[h3][0], 0, 0, 0);
                y[h3][1] = __builtin_amdgcn_mfma_f32_32x32x16_bf16(cf, h1, y[h3][1], 0, 0, 0);
            }
        }
#pragma unroll
        for (int h3 = 0; h3 < 3; ++h3)
#pragma unroll
            for (int q4 = 0; q4 < 4; ++q4) {
                const f32x4v a4 = *(const LAS f32x4v*)(acsb + h3 * 128 + 32 * lt + 8 * q4 + 4 * h);
                const float e0 = __expf(a4[0]), e1 = __expf(a4[1]), e2 = __expf(a4[2]), e3 = __expf(a4[3]);
                y[h3][0][4 * q4] *= e0; y[h3][0][4 * q4 + 1] *= e1; y[h3][0][4 * q4 + 2] *= e2; y[h3][0][4 * q4 + 3] *= e3;
                y[h3][1][4 * q4] *= e0; y[h3][1][4 * q4 + 1] *= e1; y[h3][1][4 * q4 + 2] *= e2; y[h3][1][4 * q4 + 3] *= e3;
            }
        const unsigned xb0 = lds_addr(ldsb + SSD_L_X + 3 * hs * SSD_XIMG) + (4 * h + q) * SSD_RS_X + (16 * blk + 4 * pp) * 2;
        for (int st = 0; st <= lt; ++st) {
            f32x16 cb;
#pragma unroll
            for (int i = 0; i < 16; ++i) cb[i] = 0.f;
#pragma unroll 2
            for (int ks = 0; ks < 8; ++ks) {
                const s16x8 cf = *(const s16x8*)(cp + 16 * ks);
                const s16x8 bfrag = *(const LAS s16x8*)(ldsb + SSD_L_BM + (32 * st + r) * SSD_RS_B + (16 * ks + 8 * h) * 2);
                cb = __builtin_amdgcn_mfma_f32_32x32x16_bf16(bfrag, cf, cb, 0, 0, 0);
            }
#pragma unroll
            for (int h3 = 0; h3 < 3; ++h3) {
                const LAS float* acs = acsb + h3 * 128; const LAS float* dts = dtsb + h3 * 128;
                const float myacs = acs[lcol];
                const float Dh = d_skip[6 * g + 3 * hs + h3];
                const unsigned xb = xb0 + h3 * SSD_XIMG + st * 32 * SSD_RS_X;
#pragma unroll
                for (int kk = 0; kk < 2; ++kk) {
                    const int s0 = 32 * st + 16 * kk + 4 * h;
                    const f32x4v as0 = *(const LAS f32x4v*)(acs + s0), as1 = *(const LAS f32x4v*)(acs + s0 + 8);
                    const f32x4v ds0 = *(const LAS f32x4v*)(dts + s0), ds1 = *(const LAS f32x4v*)(dts + s0 + 8);
                    float wv[8];
#pragma unroll
                    for (int j = 0; j < 8; ++j) {
                        const int s = s0 + 8 * (j >> 2) + (j & 3);
                        const float asj = (j < 4) ? as0[j & 3] : as1[j & 3], dsj = (j < 4) ? ds0[j & 3] : ds1[j & 3];
                        float v = cb[8 * kk + j] * __expf(myacs - asj) * dsj;
                        v = (s <= lcol) ? v : 0.f;
                        v = (s == lcol) ? v + Dh : v;
                        wv[j] = v;
                    }
                    s16x8 afr;
                    { v4u o; o.x = pk2(wv[0], wv[1]); o.y = pk2(wv[2], wv[3]); o.z = pk2(wv[4], wv[5]); o.w = pk2(wv[6], wv[7]); afr = __builtin_bit_cast(s16x8, o); }
                    s16x8 b0, b1;
                    if (kk == 0) { b0 = tr_frag<0, 8 * SSD_RS_X>(xb); b1 = tr_frag<64, 8 * SSD_RS_X + 64>(xb); }
                    else { b0 = tr_frag<16 * SSD_RS_X, 24 * SSD_RS_X>(xb); b1 = tr_frag<16 * SSD_RS_X + 64, 24 * SSD_RS_X + 64>(xb); }
                    y[h3][0] = __builtin_amdgcn_mfma_f32_32x32x16_bf16(afr, b0, y[h3][0], 0, 0, 0);
                    y[h3][1] = __builtin_amdgcn_mfma_f32_32x32x16_bf16(afr, b1, y[h3][1], 0, 0, 0);
                    __builtin_amdgcn_sched_barrier(0);
                }
            }
        }
        __syncthreads();
        {
            LAS unsigned short* yst = (LAS unsigned short*)(ldsb + SSD_L_X);
#pragma unroll
            for (int h3 = 0; h3 < 3; ++h3)
#pragma unroll
                for (int ptile = 0; ptile < 2; ++ptile)
#pragma unroll
                    for (int reg = 0; reg < 16; ++reg) {
                        const int l0 = 32 * lt + (reg & 3) + 8 * (reg >> 2) + 4 * h;
                        const int col = (3 * hs + h3) * 64 + 32 * ptile + r;
                        yst[l0 * (SSD_RS_Y / 2) + col] = (unsigned short)f2bf(y[h3][ptile][reg]);
                    }
        }
        __syncthreads();
#pragma unroll
        for (int pass = 0; pass < 4; ++pass) {
            const int l = 4 * (pass * 8 + w) + (lane >> 4), i16 = lane & 15;
            float gv[3][8]; float ss = 0.f;
#pragma unroll
            for (int k = 0; k < 3; ++k) {
                const int col0 = 24 * i16 + 8 * k;
                float yv[8], zv[8];
                unpack8(*(const LAS v4u*)(ldsb + SSD_L_X + l * SSD_RS_Y + col0 * 2), yv);
                unpack8(*(const v4u*)(projb + (size_t)(t0 + l) * NB_LD + g * 384 + col0), zv);
#pragma unroll
                for (int j = 0; j < 8; ++j) { const float gg = yv[j] * silu_f(zv[j]); gv[k][j] = gg; ss += gg * gg; }
            }
            ss += __shfl_xor(ss, 1); ss += __shfl_xor(ss, 2); ss += __shfl_xor(ss, 4); ss += __shfl_xor(ss, 8);
            const float rstd = rsqrtf(ss * (1.0f / 384.0f) + LN_EPS);
#pragma unroll
            for (int k = 0; k < 3; ++k) {
                const int col0 = g * 384 + 24 * i16 + 8 * k;
                const float4 g0 = *(const float4*)(norm_g + col0), g1 = *(const float4*)(norm_g + col0 + 4);
                v4u o; o.x = pk2(gv[k][0] * rstd * g0.x, gv[k][1] * rstd * g0.y); o.y = pk2(gv[k][2] * rstd * g0.z, gv[k][3] * rstd * g0.w);
                o.z = pk2(gv[k][4] * rstd * g1.x, gv[k][5] * rstd * g1.y); o.w = pk2(gv[k][6] * rstd * g1.z, gv[k][7] * rstd * g1.w);
                *(v4u*)(A1 + (size_t)(t0 + l) * MIX_WIDTH + col0) = o;
            }
        }
    }
}

#define ATT_RS_V 144
#define ATT_VIMG (256 * ATT_RS_V)
#define ATT_PV(KT, S2) { \
        v4u o_; o_.x = pk2(s[KT][8 * S2 + 0], s[KT][8 * S2 + 1]); o_.y = pk2(s[KT][8 * S2 + 2], s[KT][8 * S2 + 3]); \
        o_.z = pk2(s[KT][8 * S2 + 4], s[KT][8 * S2 + 5]); o_.w = pk2(s[KT][8 * S2 + 6], s[KT][8 * S2 + 7]); \
        const s16x8 pf_ = __builtin_bit_cast(s16x8, o_); \
        const s16x8 a0_ = tr_frag<(32 * KT + 16 * S2) * ATT_RS_V, (32 * KT + 16 * S2 + 8) * ATT_RS_V>(vbase); \
        const s16x8 a1_ = tr_frag<(32 * KT + 16 * S2) * ATT_RS_V + 64, (32 * KT + 16 * S2 + 8) * ATT_RS_V + 64>(vbase); \
        o0 = __builtin_amdgcn_mfma_f32_32x32x16_bf16(a0_, pf_, o0, 0, 0, 0); \
        o1 = __builtin_amdgcn_mfma_f32_32x32x16_bf16(a1_, pf_, o1, 0, 0, 0); }
__device__ __forceinline__ void ph_attn_prompt(LAS unsigned char* ldsb, const bf16* __restrict__ qrot_b, const bf16* __restrict__ krot_b, const bf16* __restrict__ projb,
                                               bf16* __restrict__ obuf, float* __restrict__ lsebuf) {
    const int tid = threadIdx.x, w = __builtin_amdgcn_readfirstlane(tid >> 6), lane = tid & 63;
    const int r = lane & 31, h = lane >> 5, blk = (lane >> 4) & 1, q = (lane & 15) >> 2, pp = lane & 3;
    const int qt = w & 3, hsel = w >> 2;
    for (int unit = blockIdx.x; unit < 3 * 512; unit += gridDim.x) {
        const int pat = unit >> 9, rem = unit & 511, hp = rem & 3, rem2 = rem >> 2, b = rem2 >> 6, bk = rem2 & 63;
        const int dsh = 2 * pat, nper = 64 >> dsh, res = bk >> (6 - dsh), nb = bk & (nper - 1);
        const int head = 2 * hp + hsel;
        __syncthreads();
        for (int idx = tid & 255; idx < 2048; idx += 256) {
            const int row = idx >> 3, ch = idx & 7, js = 128 * nb - 128 + row;
            v4u v; v.x = 0u; v.y = 0u; v.z = 0u; v.w = 0u;
            if (js >= 0) v = *(const v4u*)(projb + (size_t)(b * SEQ + (js << dsh) + res) * NB_LD + NB_V + head * 64 + ch * 8);
            *(LAS v4u*)(ldsb + hsel * ATT_VIMG + row * ATT_RS_V + ch * 16) = v;
        }
        const int tq = b * SEQ + ((128 * nb + 32 * qt + r) << dsh) + res;
        s16x8 qf[4];
#pragma unroll
        for (int ks = 0; ks < 4; ++ks) qf[ks] = *(const s16x8*)(qrot_b + (size_t)tq * ATT_WIDTH + head * 64 + 16 * ks + 8 * h);
        f32x16 s[5];
#pragma unroll
        for (int kt = 0; kt < 5; ++kt) {
            int js = 128 * nb + 32 * qt - 128 + 32 * kt + r; js = js < 0 ? 0 : js;
            const bf16* kp = krot_b + (size_t)(b * SEQ + (js << dsh) + res) * ATT_WIDTH + head * 64 + 8 * h;
#pragma unroll
            for (int i = 0; i < 16; ++i) s[kt][i] = 0.f;
#pragma unroll
            for (int ks = 0; ks < 4; ++ks) s[kt] = __builtin_amdgcn_mfma_f32_32x32x16_bf16(*(const s16x8*)(kp + 16 * ks), qf[ks], s[kt], 0, 0, 0);
        }
        float m = -INFINITY;
#pragma unroll
        for (int kt = 0; kt < 5; ++kt) {
            const bool tile_ok = (nb > 0) || (qt + kt >= 4);
#pragma unroll
            for (int reg = 0; reg < 16; ++reg) {
                const int c = (reg & 3) + 8 * (reg >> 2) + 4 * h;
                const bool ok = tile_ok && (kt == 0 ? (c >= r) : (kt == 4 ? (c <= r) : true));
                const float v = ok ? s[kt][reg] * 0.125f : -INFINITY;
                s[kt][reg] = v; m = fmaxf(m, v);
            }
        }
        m = fmaxf(m, __shfl_xor(m, 32));
        float l = 0.f;
#pragma unroll
        for (int kt = 0; kt < 5; ++kt)
#pragma unroll
            for (int reg = 0; reg < 16; ++reg) { const float p = __expf(s[kt][reg] - m); s[kt][reg] = p; l += p; }
        l += __shfl_xor(l, 32);
        __syncthreads();
        f32x16 o0, o1;
#pragma unroll
        for (int i = 0; i < 16; ++i) { o0[i] = 0.f; o1[i] = 0.f; }
        const unsigned vbase = lds_addr(ldsb + hsel * ATT_VIMG) + (32 * qt + 4 * h + q) * ATT_RS_V + (16 * blk + 4 * pp) * 2;
        ATT_PV(0, 0) ATT_PV(0, 1) ATT_PV(1, 0) ATT_PV(1, 1) ATT_PV(2, 0) ATT_PV(2, 1) ATT_PV(3, 0) ATT_PV(3, 1) ATT_PV(4, 0) ATT_PV(4, 1)
        const float inv = 1.0f / l;
        bf16* op = obuf + ((size_t)pat * T_PROMPT + tq) * ATT_WIDTH + head * 64 + 4 * h;
#pragma unroll
        for (int q4 = 0; q4 < 4; ++q4) {
            *(uint2*)(op + 8 * q4) = make_uint2(pk2(o0[4 * q4] * inv, o0[4 * q4 + 1] * inv), pk2(o0[4 * q4 + 2] * inv, o0[4 * q4 + 3] * inv));
            *(uint2*)(op + 32 + 8 * q4) = make_uint2(pk2(o1[4 * q4] * inv, o1[4 * q4 + 1] * inv), pk2(o1[4 * q4 + 2] * inv, o1[4 * q4 + 3] * inv));
        }
        if (h == 0) lsebuf[((size_t)pat * T_PROMPT + tq) * 8 + head] = m + __logf(l);
    }
}
__device__ __forceinline__ void ph_attn_combine(const bf16* __restrict__ obuf, const float* __restrict__ lsebuf, bf16* __restrict__ A1) {
    const int lane = threadIdx.x & 63;
    for (int t = blockIdx.x * NWAVE + (threadIdx.x >> 6); t < T_PROMPT; t += gridDim.x * NWAVE) {
        const int hd = lane >> 3;
        const float l0 = lsebuf[((size_t)0 * T_PROMPT + t) * 8 + hd], l1 = lsebuf[((size_t)1 * T_PROMPT + t) * 8 + hd], l2 = lsebuf[((size_t)2 * T_PROMPT + t) * 8 + hd];
        const float mx = fmaxf(l0, fmaxf(l1, l2));
        const float e0 = __expf(l0 - mx), e1 = __expf(l1 - mx), e2 = __expf(l2 - mx);
        const float inv = 1.0f / (e0 + e1 + e2);
        float a[8], b[8], c[8];
        unpack8(*(const v4u*)(obuf + ((size_t)0 * T_PROMPT + t) * ATT_WIDTH + lane * 8), a);
        unpack8(*(const v4u*)(obuf + ((size_t)1 * T_PROMPT + t) * ATT_WIDTH + lane * 8), b);
        unpack8(*(const v4u*)(obuf + ((size_t)2 * T_PROMPT + t) * ATT_WIDTH + lane * 8), c);
        float o[8];
#pragma unroll
        for (int j = 0; j < 8; ++j) o[j] = (e0 * a[j] + e1 * b[j] + e2 * c[j]) * inv;
        v4u w; w.x = pk2(o[0], o[1]); w.y = pk2(o[2], o[3]); w.z = pk2(o[4], o[5]); w.w = pk2(o[6], o[7]);
        *(v4u*)(A1 + (size_t)t * MIX_WIDTH + SSD_WIDTH + lane * 8) = w;
    }
}

#define RT_RS 272
#define RT_KIMG (128 * RT_RS)
#define RT_LUT (2 * RT_KIMG)
constexpr unsigned char RT_CANDS[64] = {0, 1, 2, 3, 4, 5, 6, 7, 8, 9, 10, 11, 12, 13, 14, 15, 16, 17, 18, 19, 20, 21, 22, 23, 32, 33, 34, 35, 36, 48, 49, 50, 51, 64, 65, 66, 80, 81, 96, 97,
                                        112, 113, 128, 144, 160, 176, 192, 208, 224, 240, 0, 0, 0, 0, 0, 0, 0, 0, 0, 0, 0, 0, 0, 0};
__device__ __forceinline__ unsigned rt_mono(float f) { const unsigned u = __builtin_bit_cast(unsigned, f); return u ^ ((unsigned)((int)u >> 31) | 0x80000000u); }
__device__ __forceinline__ float rt_unmono(unsigned m) { const unsigned u = (m & 0x80000000u) ? (m ^ 0x80000000u) : ~m; return __builtin_bit_cast(float, u); }
#define RT_CE_DESC(a, b) { const unsigned x_ = (a), y_ = (b); (a) = x_ > y_ ? x_ : y_; (b) = x_ > y_ ? y_ : x_; }
#define RT_CE_ASC(a, b) { const unsigned x_ = (a), y_ = (b); (a) = x_ > y_ ? y_ : x_; (b) = x_ > y_ ? x_ : y_; }
__device__ __forceinline__ void rt_sort16(unsigned (&v)[16]) {
#pragma unroll
    for (int k = 2; k <= 16; k <<= 1)
#pragma unroll
        for (int j = k >> 1; j > 0; j >>= 1)
#pragma unroll
            for (int i = 0; i < 16; ++i) { const int l = i ^ j; if (l > i) { if ((i & k) == 0) RT_CE_DESC(v[i], v[l]) else RT_CE_ASC(v[i], v[l]) } }
}
__device__ __forceinline__ void rt_merge16(unsigned (&v)[16]) {
#pragma unroll
    for (int j = 8; j > 0; j >>= 1)
#pragma unroll
        for (int i = 0; i < 16; ++i) { const int l = i ^ j; if (l > i) RT_CE_DESC(v[i], v[l]) }
}
__device__ __forceinline__ void rt_top16(unsigned (&a)[16], const unsigned (&b)[16]) {
#pragma unroll
    for (int i = 0; i < 16; ++i) a[i] = a[i] > b[15 - i] ? a[i] : b[15 - i];
    rt_merge16(a);
}
__device__ __forceinline__ void rt_top16_partner(unsigned (&a)[16]) {
    unsigned b[16];
#pragma unroll
    for (int i = 0; i < 16; ++i) b[i] = (unsigned)__shfl_xor((int)a[i], 32);
    rt_top16(a, b);
}
__device__ __forceinline__ void rt_scores_top16(LAS unsigned char* kimg, const bf16* __restrict__ qp, int r, int h, unsigned (&k0)[16]) {
    f32x16 acc[4];
#pragma unroll
    for (int kt = 0; kt < 4; ++kt)
#pragma unroll
        for (int i = 0; i < 16; ++i) acc[kt][i] = 0.f;
#pragma unroll
    for (int ks = 0; ks < 8; ++ks) {
        const s16x8 qf = *(const s16x8*)(qp + 16 * ks);
#pragma unroll
        for (int kt = 0; kt < 4; ++kt) {
            const s16x8 kf = *(const LAS s16x8*)(kimg + (32 * kt + r) * RT_RS + (16 * ks + 8 * h) * 2);
            acc[kt] = __builtin_amdgcn_mfma_f32_32x32x16_bf16(kf, qf, acc[kt], 0, 0, 0);
        }
    }
    unsigned k1[16], k2[16], k3[16];
#pragma unroll
    for (int reg = 0; reg < 16; ++reg) {
        const unsigned ki = (unsigned)((reg & 3) + 8 * (reg >> 2) + 4 * h);
        k0[reg] = (rt_mono(acc[0][reg]) & 0xFFFFFF80u) | ki;
        k1[reg] = (rt_mono(acc[1][reg]) & 0xFFFFFF80u) | (ki + 32u);
        k2[reg] = (rt_mono(acc[2][reg]) & 0xFFFFFF80u) | (ki + 64u);
        k3[reg] = (rt_mono(acc[3][reg]) & 0xFFFFFF80u) | (ki + 96u);
    }
    rt_sort16(k0); rt_sort16(k1); rt_sort16(k2); rt_sort16(k3);
    rt_top16(k0, k1); rt_top16(k2, k3); rt_top16(k0, k2);
    rt_top16_partner(k0);
}
__device__ __forceinline__ void ph_peer_route2(LAS unsigned char* ldsb, const bf16* __restrict__ qhb, const float* __restrict__ keys1, const float* __restrict__ keys2,
                                               int* __restrict__ eidx, float* __restrict__ gate) {
    const int tid = threadIdx.x, w = __builtin_amdgcn_readfirstlane(tid >> 6), lane = tid & 63, r = lane & 31, h = lane >> 5;
    __syncthreads();
    for (int idx = tid; idx < 2 * 128 * 16; idx += NTHR) {
        const int tb = idx >> 11, rem = idx & 2047, row = rem >> 4, ch = rem & 15;
        const float* sp = (tb ? keys2 : keys1) + row * 128 + ch * 8;
        const float4 a = *(const float4*)sp, b = *(const float4*)(sp + 4);
        v4u o; o.x = pk2(a.x, a.y); o.y = pk2(a.z, a.w); o.z = pk2(b.x, b.y); o.w = pk2(b.z, b.w);
        *(LAS v4u*)(ldsb + tb * RT_KIMG + row * RT_RS + ch * 16) = o;
    }
    __syncthreads();
    LAS unsigned* lut = (LAS unsigned*)(ldsb + RT_LUT) + w * 512;
    for (int unit = blockIdx.x * NWAVE + w; unit < (T_ALL / 32) * 8; unit += gridDim.x * NWAVE) {
        const int tt = unit >> 3, hd = unit & 7;
        const int tok = 32 * tt + r;
        const bf16* qp = qhb + (size_t)tok * 2048 + hd * 256 + 8 * h;
        unsigned ka[16], kb[16];
        rt_scores_top16(ldsb, qp, r, h, ka);
        rt_scores_top16(ldsb + RT_KIMG, qp + 128, r, h, kb);
        float v1[16], v2[16];
#pragma unroll
        for (int i = 0; i < 16; ++i) { v1[i] = rt_unmono(ka[i] & 0xFFFFFF80u); v2[i] = rt_unmono(kb[i] & 0xFFFFFF80u); }
#pragma unroll
        for (int wd = 0; wd < 4; ++wd) {
            lut[wd * 64 + lane] = (ka[4 * wd] & 0x7Fu) | ((ka[4 * wd + 1] & 0x7Fu) << 8) | ((ka[4 * wd + 2] & 0x7Fu) << 16) | ((ka[4 * wd + 3] & 0x7Fu) << 24);
            lut[(4 + wd) * 64 + lane] = (kb[4 * wd] & 0x7Fu) | ((kb[4 * wd + 1] & 0x7Fu) << 8) | ((kb[4 * wd + 2] & 0x7Fu) << 16) | ((kb[4 * wd + 3] & 0x7Fu) << 24);
        }
        unsigned c0[16], c1[16];
        c0[0] = (rt_mono(h ? (v1[0] + v2[1]) : (v1[0] + v2[0])) & 0xFFFFFF00u) | (h ? 1u : 0u);
        c0[1] = (rt_mono(h ? (v1[0] + v2[3]) : (v1[0] + v2[2])) & 0xFFFFFF00u) | (h ? 3u : 2u);
        c0[2] = (rt_mono(h ? (v1[0] + v2[5]) : (v1[0] + v2[4])) & 0xFFFFFF00u) | (h ? 5u : 4u);
        c0[3] = (rt_mono(h ? (v1[0] + v2[7]) : (v1[0] + v2[6])) & 0xFFFFFF00u) | (h ? 7u : 6u);
        c0[4] = (rt_mono(h ? (v1[0] + v2[9]) : (v1[0] + v2[8])) & 0xFFFFFF00u) | (h ? 9u : 8u);
        c0[5] = (rt_mono(h ? (v1[0] + v2[11]) : (v1[0] + v2[10])) & 0xFFFFFF00u) | (h ? 11u : 10u);
        c0[6] = (rt_mono(h ? (v1[0] + v2[13]) : (v1[0] + v2[12])) & 0xFFFFFF00u) | (h ? 13u : 12u);
        c0[7] = (rt_mono(h ? (v1[0] + v2[15]) : (v1[0] + v2[14])) & 0xFFFFFF00u) | (h ? 15u : 14u);
        c0[8] = (rt_mono(h ? (v1[1] + v2[1]) : (v1[1] + v2[0])) & 0xFFFFFF00u) | (h ? 17u : 16u);
        c0[9] = (rt_mono(h ? (v1[1] + v2[3]) : (v1[1] + v2[2])) & 0xFFFFFF00u) | (h ? 19u : 18u);
        c0[10] = (rt_mono(h ? (v1[1] + v2[5]) : (v1[1] + v2[4])) & 0xFFFFFF00u) | (h ? 21u : 20u);
        c0[11] = (rt_mono(h ? (v1[1] + v2[7]) : (v1[1] + v2[6])) & 0xFFFFFF00u) | (h ? 23u : 22u);
        c0[12] = (rt_mono(h ? (v1[2] + v2[1]) : (v1[2] + v2[0])) & 0xFFFFFF00u) | (h ? 33u : 32u);
        c0[13] = (rt_mono(h ? (v1[2] + v2[3]) : (v1[2] + v2[2])) & 0xFFFFFF00u) | (h ? 35u : 34u);
        c0[14] = (rt_mono(h ? (v1[3] + v2[0]) : (v1[2] + v2[4])) & 0xFFFFFF00u) | (h ? 48u : 36u);
        c0[15] = (rt_mono(h ? (v1[3] + v2[2]) : (v1[3] + v2[1])) & 0xFFFFFF00u) | (h ? 50u : 49u);
        c1[0] = (rt_mono(h ? (v1[4] + v2[0]) : (v1[3] + v2[3])) & 0xFFFFFF00u) | (h ? 64u : 51u);
        c1[1] = (rt_mono(h ? (v1[4] + v2[2]) : (v1[4] + v2[1])) & 0xFFFFFF00u) | (h ? 66u : 65u);
        c1[2] = (rt_mono(h ? (v1[5] + v2[1]) : (v1[5] + v2[0])) & 0xFFFFFF00u) | (h ? 81u : 80u);
        c1[3] = (rt_mono(h ? (v1[6] + v2[1]) : (v1[6] + v2[0])) & 0xFFFFFF00u) | (h ? 97u : 96u);
        c1[4] = (rt_mono(h ? (v1[7] + v2[1]) : (v1[7] + v2[0])) & 0xFFFFFF00u) | (h ? 113u : 112u);
        c1[5] = (rt_mono(h ? (v1[9] + v2[0]) : (v1[8] + v2[0])) & 0xFFFFFF00u) | (h ? 144u : 128u);
        c1[6] = (rt_mono(h ? (v1[11] + v2[0]) : (v1[10] + v2[0])) & 0xFFFFFF00u) | (h ? 176u : 160u);
        c1[7] = (rt_mono(h ? (v1[13] + v2[0]) : (v1[12] + v2[0])) & 0xFFFFFF00u) | (h ? 208u : 192u);
        c1[8] = (rt_mono(h ? (v1[15] + v2[0]) : (v1[14] + v2[0])) & 0xFFFFFF00u) | (h ? 240u : 224u);
        c1[9] = 0u;
        c1[10] = 0u;
        c1[11] = 0u;
        c1[12] = 0u;
        c1[13] = 0u;
        c1[14] = 0u;
        c1[15] = 0u;
        rt_sort16(c0); rt_sort16(c1); rt_top16(c0, c1); rt_top16_partner(c0);
        float e[16]; float sum = 0.f;
        const float mx = rt_unmono(c0[0] & 0xFFFFFF00u);
#pragma unroll
        for (int k = 0; k < 16; ++k) { e[k] = __expf(rt_unmono(c0[k] & 0xFFFFFF00u) - mx); sum += e[k]; }
        const float inv = 1.0f / sum;
        asm volatile("s_waitcnt lgkmcnt(0)" ::: "memory");
        int ex[8]; float gv[8];
#pragma unroll
        for (int k = 0; k < 8; ++k) {
            const unsigned hm = (unsigned)(-h);
            const unsigned ck = (c0[k] & ~hm) | (c0[8 + k] & hm);
            const float ek = __builtin_bit_cast(float, (__builtin_bit_cast(unsigned, e[k]) & ~hm) | (__builtin_bit_cast(unsigned, e[8 + k]) & hm));
            const unsigned ci = (ck >> 4) & 15u, cj = ck & 15u;
            const unsigned w1 = lut[(ci >> 2) * 64 + lane], w2 = lut[(4 + (cj >> 2)) * 64 + lane];
            const unsigned i1 = (w1 >> (8 * (ci & 3))) & 0x7Fu, i2 = (w2 >> (8 * (cj & 3))) & 0x7Fu;
            ex[k] = (int)(i1 * PEER_NKEYS + i2); gv[k] = ek * inv;
        }
        int* ep = eidx + (size_t)tok * 128 + hd * 16 + 8 * h; float* gp = gate + (size_t)tok * 128 + hd * 16 + 8 * h;
        *(int4*)ep = make_int4(ex[0], ex[1], ex[2], ex[3]); *(int4*)(ep + 4) = make_int4(ex[4], ex[5], ex[6], ex[7]);
        *(float4*)gp = make_float4(gv[0], gv[1], gv[2], gv[3]); *(float4*)(gp + 4) = make_float4(gv[4], gv[5], gv[6], gv[7]);
    }
}

struct Params {
    const float* in[23];
    float* out;
    unsigned char* ws;
    unsigned* bar;
};

#define WS_BAR      0ull
#define WS_XALL     (1ull << 20)
#define WS_PROJ     (WS_XALL + (size_t)T_ALL * D_MODEL * 4)
#define WS_XBC      (WS_PROJ + (size_t)T_ALL * PROJ_LD * 4)
#define WS_DT       (WS_XBC + (size_t)T_ALL * CONV_DIM * 4)
#define WS_QROT     (WS_DT + (size_t)T_ALL * SSD_HEADS * 4)
#define WS_KROT     (WS_QROT + (size_t)T_ALL * ATT_WIDTH * 4)
#define WS_YBUF     (WS_KROT + (size_t)T_ALL * ATT_WIDTH * 4)
#define WS_MIX      (WS_YBUF + (size_t)T_ALL * MIX_WIDTH * 4)
#define WS_HBUF     (WS_MIX + (size_t)T_ALL * D_MODEL * 4)
#define WS_QH       (WS_HBUF + (size_t)T_ALL * D_MODEL * 4)
#define WS_EIDX     (WS_QH + (size_t)T_ALL * 2048 * 4)
#define WS_GATE     (WS_EIDX + (size_t)T_ALL * 128 * 4)
#define WS_A0       (WS_GATE + (size_t)T_ALL * 128 * 4)
#define WS_A1       (WS_A0 + (size_t)T_ALL * D_MODEL * 2)
#define WS_A2       (WS_A1 + (size_t)T_ALL * MIX_WIDTH * 2)
#define WS_WTIN     (WS_A2 + (size_t)T_ALL * D_MODEL * 2)
#define WS_WTOUT    (WS_WTIN + (size_t)PROJ_LD * D_MODEL * 2)
#define WS_WTQ      (WS_WTOUT + (size_t)D_MODEL * MIX_WIDTH * 2)
#define WS_PROJB    (WS_WTQ + (size_t)2048 * D_MODEL * 2)
#define WS_DTRAW    (WS_PROJB + (size_t)T_ALL * NB_LD * 2)
#define WS_XBCB     (WS_DTRAW + (size_t)T_ALL * 32 * 4)
#define WS_QROTB    (WS_XBCB + (size_t)T_ALL * CONV_DIM * 2)
#define WS_KROTB    (WS_QROTB + (size_t)T_ALL * ATT_WIDTH * 2)
#define WS_UB       (WS_KROTB + (size_t)T_ALL * ATT_WIDTH * 2)
#define WS_VB       (WS_UB + (size_t)16384 * D_MODEL * 2)
#define WS_SBUF     (WS_VB + (size_t)16384 * D_MODEL * 2)
#define WS_HIN      (WS_SBUF + (size_t)BATCH * 64 * SSD_HEADS * 64 * 128 * 2)
#define WS_CDEC     (WS_HIN + (size_t)BATCH * 64 * SSD_HEADS * 64 * 128 * 2)
#define WS_OBUF     (WS_CDEC + (size_t)BATCH * 64 * SSD_HEADS * 4)
#define WS_LSE      (WS_OBUF + (size_t)3 * T_PROMPT * ATT_WIDTH * 2)
#define WS_END      (WS_LSE + (size_t)3 * T_PROMPT * 8 * 4)

#define LDS_BYTES (160 * 1024)

__global__ void __launch_bounds__(512, 2) mega_fwd(Params p) {
    extern __shared__ __attribute__((aligned(16))) unsigned char smem[];
    if (threadIdx.x == 0) *(uint4*)smem = make_uint4(0u, 0u, 0u, 0u);
    __syncthreads();
    XcdBarrier bar = xcd_barrier_post(p.bar, (volatile LAS unsigned*)smem);
    float* lds = (float*)(smem + 256);

    const float* x_prompt = p.in[0]; const float* x_sample = p.in[1]; const float* cache_k = p.in[2]; const float* cache_v = p.in[3];
    const float* state_conv = p.in[4]; const float* state_ssm = p.in[5]; const float* w_in = p.in[6]; const float* conv_w = p.in[7];
    const float* conv_b = p.in[8]; const float* dt_bias = p.in[9]; const float* a_log = p.in[10]; const float* d_skip = p.in[11];
    const float* norm_g = p.in[12]; const float* w_out = p.in[13]; const float* ln1_g = p.in[14]; const float* ln1_b = p.in[15];
    const float* peer_wq = p.in[16]; const float* keys1 = p.in[17]; const float* keys2 = p.in[18]; const float* peer_u = p.in[19];
    const float* peer_v = p.in[20]; const float* ln2_g = p.in[21]; const float* ln2_b = p.in[22];
    float* out = p.out;
    float* xall = (float*)(p.ws + WS_XALL); float* proj = (float*)(p.ws + WS_PROJ); float* xbc_act = (float*)(p.ws + WS_XBC);
    float* dtv = (float*)(p.ws + WS_DT); float* qrot = (float*)(p.ws + WS_QROT); float* krot = (float*)(p.ws + WS_KROT);
    float* ybuf = (float*)(p.ws + WS_YBUF); float* mix = (float*)(p.ws + WS_MIX); float* hbuf = (float*)(p.ws + WS_HBUF);
    float* qh = (float*)(p.ws + WS_QH); int* eidx = (int*)(p.ws + WS_EIDX); float* gate = (float*)(p.ws + WS_GATE);
    bf16* A0 = (bf16*)(p.ws + WS_A0); bf16* A1 = (bf16*)(p.ws + WS_A1); bf16* A2 = (bf16*)(p.ws + WS_A2);
    bf16* wt_in = (bf16*)(p.ws + WS_WTIN); bf16* wt_out = (bf16*)(p.ws + WS_WTOUT); bf16* wt_q = (bf16*)(p.ws + WS_WTQ);
    bf16* projb = (bf16*)(p.ws + WS_PROJB); float* dtraw = (float*)(p.ws + WS_DTRAW); bf16* xbc_b = (bf16*)(p.ws + WS_XBCB);
    bf16* qrot_b = (bf16*)(p.ws + WS_QROTB); bf16* krot_b = (bf16*)(p.ws + WS_KROTB); bf16* ub = (bf16*)(p.ws + WS_UB); bf16* vb = (bf16*)(p.ws + WS_VB);
    bf16* Sbuf = (bf16*)(p.ws + WS_SBUF); bf16* Hin = (bf16*)(p.ws + WS_HIN); float* cdec = (float*)(p.ws + WS_CDEC);
    bf16* obuf = (bf16*)(p.ws + WS_OBUF); float* lsebuf = (float*)(p.ws + WS_LSE);
    LAS unsigned char* ldsb = (LAS unsigned char*)smem + 256;

    ph_concat_x(x_prompt, x_sample, xall);
    ph_prologue(ldsb, x_prompt, x_sample, A0, w_in, wt_in, w_out, wt_out, peer_wq, wt_q, peer_u, peer_v, ub, vb);
    ph_cache_copy(cache_k, cache_v, out);
    xcd_barrier(bar);
    { pg8::Gemm g{A0, wt_in, T_ALL, PROJ_LD, D_MODEL}; pg8::StaticOrder S; S.init(g.M, g.N, (int)gridDim.x, (int)blockIdx.x);
      pg8::EpiProj E{projb, dtraw}; pg8::gemm_phase<pg8::EpiProj, pg8::StaticOrder, false>(ldsb, g, S, E, nullptr); }
    xcd_barrier(bar);
    ph_post_proj2(projb, dtraw, state_conv, conv_w, conv_b, dt_bias, proj, xbc_act, xbc_b, dtv, qrot, krot, qrot_b, krot_b, out);
    xcd_barrier(bar);
    ph_ssd_states(ldsb, xbc_b, dtv, a_log, Sbuf, cdec);
    __syncthreads();
    ph_attn_prompt(ldsb, qrot_b, krot_b, projb, obuf, lsebuf);
    __syncthreads();
    ph_ssd_naive(lds, xbc_b, dtv, a_log, d_skip, state_ssm, ybuf, out);
    ph_attn_sample(lds, qrot_b, krot_b, projb, cache_k, cache_v, A1);
    xcd_barrier(bar);
    ph_ssd_scan(Sbuf, cdec, Hin, out);
    xcd_barrier(bar);
    ph_ssd_out(ldsb, xbc_b, projb, dtv, a_log, d_skip, norm_g, Hin, A1);
    ph_attn_combine(obuf, lsebuf, A1);
    ph_gate_norm(projb, norm_g, ybuf, A1);
    xcd_barrier(bar);
    { pg8::Gemm g{A1, wt_out, T_ALL, D_MODEL, MIX_WIDTH}; pg8::StaticOrder S; S.init(g.M, g.N, (int)gridDim.x, (int)blockIdx.x);
      pg8::EpiF32 E{mix, D_MODEL, nullptr}; pg8::gemm_phase<pg8::EpiF32, pg8::StaticOrder, false>(ldsb, g, S, E, nullptr); }
    xcd_barrier(bar);
    ph_ln_res(xall, mix, ln1_g, ln1_b, hbuf, A2);
    xcd_barrier(bar);
    { pg8::Gemm g{A2, wt_q, T_ALL, 2048, D_MODEL}; pg8::StaticOrder S; S.init(g.M, g.N, (int)gridDim.x, (int)blockIdx.x);
      pg8::EpiBf16Plain E{(bf16*)qh, 2048}; pg8::gemm_phase<pg8::EpiBf16Plain, pg8::StaticOrder, false>(ldsb, g, S, E, nullptr); }
    xcd_barrier(bar);
    ph_peer_route2(ldsb, (const bf16*)qh, keys1, keys2, eidx, gate);
    xcd_barrier(bar);
    ph_peer_ffn2(hbuf, eidx, gate, ub, vb, ln2_g, ln2_b, out);
}

extern "C" void kernel_launch(void* const* d_in, const int* in_sizes, int n_in, void* d_out, int out_size, void* d_ws, size_t ws_size, hipStream_t stream) {
    static int grid = 0;
    if (grid == 0) {
        int dev = 0, cus = 0, per_cu = 0;
        if (hipGetDevice(&dev) != hipSuccess || hipDeviceGetAttribute(&cus, hipDeviceAttributeMultiprocessorCount, dev) != hipSuccess) { fprintf(stderr, "kernel_launch: device query failed\n"); grid = -1; return; }
        if (hipFuncSetAttribute((const void*)mega_fwd, hipFuncAttributeMaxDynamicSharedMemorySize, LDS_BYTES) != hipSuccess) { fprintf(stderr, "kernel_launch: hipFuncSetAttribute failed\n"); grid = -1; return; }
        if (hipOccupancyMaxActiveBlocksPerMultiprocessor(&per_cu, (const void*)mega_fwd, NTHR, LDS_BYTES) != hipSuccess || per_cu < 1) { fprintf(stderr, "kernel_launch: occupancy query says %d\n", per_cu); }
        (void)hipGetLastError();
        grid = cus;
        if (ws_size < WS_END) { fprintf(stderr, "kernel_launch: workspace too small\n"); grid = -1; return; }
    }
    if (grid < 0) return;
    (void)hipMemsetAsync((char*)d_ws + WS_BAR, 0, XCD_BAR_WORDS * sizeof(unsigned), stream);
    Params p{};
    for (int i = 0; i < 23; ++i) p.in[i] = (const float*)d_in[i];
    p.out = (float*)d_out; p.ws = (unsigned char*)d_ws; p.bar = (unsigned*)((char*)d_ws + WS_BAR);
    hipLaunchKernelGGL(mega_fwd, dim3(grid), dim3(NTHR), LDS_BYTES, stream, p);
}
```

```cpp
#include <hip/hip_runtime.h>
#include <stdint.h>

#define D_MODEL 1024
#define BATCH 2
#define SEQ 8192
#define DEC_BATCH 128
#define DEC_SEQ 4
#define PAST_LEN 8192
#define HEAD_DIM 64
#define ATT_WIDTH 512
#define ATT_HEADS 8
#define SSD_WIDTH 1536
#define SSD_HEADS 24
#define SSD_GROUPS 4
#define SSD_STATE 128
#define CONV_DIM 2560
#define IN_WIDTH 5656
#define PROJ_LD 5888
#define MIX_WIDTH 2048
#define WBUF 2048
#define PEER_NKEYS 128
#define PEER_HEADS 8
#define PEER_TOPK 16
#define PEER_DKEY 256
#define T_PROMPT (BATCH * SEQ)
#define T_SAMPLE (DEC_BATCH * DEC_SEQ)
#define T_ALL (T_PROMPT + T_SAMPLE)
#define O_Z 0
#define O_XBC 1536
#define O_DT 4096
#define O_Q 4120
#define O_K 4632
#define O_V 5144
#define ALPHA_F 1.189207115002721f
#define LN_EPS 1e-5f

#define OUT_YP 0ull
#define OUT_YS (OUT_YP + 16777216ull)
#define OUT_PK (OUT_YS + 524288ull)
#define OUT_PV (OUT_PK + 2097152ull)
#define OUT_PC (OUT_PV + 2097152ull)
#define OUT_PS (OUT_PC + 15360ull)
#define OUT_SK (OUT_PS + 393216ull)
#define OUT_SV (OUT_SK + 134217728ull)
#define OUT_SC (OUT_SV + 134217728ull)
#define OUT_SS (OUT_SC + 983040ull)

__constant__ double ROPE_INV_REV[32] = {
    1.59154943091895346e-01, 1.19349370211248862e-01, 8.94994016088910133e-02, 6.71150830052272551e-02,
    5.03292121044870353e-02, 3.77415847174197711e-02, 2.83021958306233987e-02, 2.12236527647776604e-02,
    1.59154943091895339e-02, 1.19349370211248862e-02, 8.94994016088910237e-03, 6.71150830052272534e-03,
    5.03292121044870370e-03, 3.77415847174197719e-03, 2.83021958306233987e-03, 2.12236527647776622e-03,
    1.59154943091895356e-03, 1.19349370211248849e-03, 8.94994016088910237e-04, 6.71150830052272599e-04,
    5.03292121044870326e-04, 3.77415847174197741e-04, 2.83021958306233954e-04, 2.12236527647776605e-04,
    1.59154943091895351e-04, 1.19349370211248862e-04, 8.94994016088910182e-05, 6.71150830052272545e-05,
    5.03292121044870354e-05, 3.77415847174197768e-05, 2.83021958306233961e-05, 2.12236527647776592e-05
};

__device__ __forceinline__ float silu_f(float x) { return x / (1.0f + __expf(-x)); }
__device__ __forceinline__ float softplus_f(float x) { return fmaxf(x, 0.f) + log1pf(__expf(-fabsf(x))); }
__device__ __forceinline__ float gelu_f(float x) { return 0.5f * x * (1.0f + erff(x * 0.70710678118654752f)); }
__device__ __forceinline__ float wave_sum(float v) {
#pragma unroll
    for (int o = 32; o > 0; o >>= 1) v += __shfl_xor(v, o);
    return v;
}
__device__ __forceinline__ float wave_max(float v) {
#pragma unroll
    for (int o = 32; o > 0; o >>= 1) v = fmaxf(v, __shfl_xor(v, o));
    return v;
}

#include <cstdio>
#define XB_TMO      128
#define XB_XCNT(j)  (256  + 64 * (j))
#define XB_XSUB(j)  (1280 + 64 * (j))
#define XB_XGEN(j)  (2304 + 64 * (j))
#define XB_TOP      3328
#define XB_TOPGEN   3392
#define XCD_BAR_WORDS 3456
#define XB_SPIN_CAP (1u << 18)
#define LAS __attribute__((address_space(3)))

__device__ __forceinline__ unsigned xb_ld(unsigned* p)              { return __hip_atomic_load(p, __ATOMIC_RELAXED, __HIP_MEMORY_SCOPE_AGENT); }
__device__ __forceinline__ unsigned xb_add(unsigned* p, unsigned v) { return __hip_atomic_fetch_add(p, v, __ATOMIC_RELAXED, __HIP_MEMORY_SCOPE_AGENT); }
__device__ __forceinline__ unsigned xb_xcc_id() { return (unsigned)__builtin_amdgcn_s_getreg((3 << 11) | 20) & 0xFu; }
#define XB_SPIN(cond, bar) do { unsigned _sp = 0; while (cond) { __builtin_amdgcn_s_sleep(1); \
    if ((++_sp & 255u) == 0u) { if (xb_ld(&(bar)[XB_TMO])) break; if (_sp > XB_SPIN_CAP) { atomicAdd(&(bar)[XB_TMO], 1u); break; } } } } while (0)

struct XcdBarrier {
    unsigned* bar; unsigned x;
    volatile LAS unsigned* st;
};

__device__ __forceinline__ XcdBarrier xcd_barrier_post(unsigned* bar, volatile LAS unsigned* st) {
    XcdBarrier b; b.bar = bar; b.x = xb_xcc_id(); b.st = st;
    if (threadIdx.x == 0) (void)xb_add(&bar[XB_XCNT(b.x)], 1u);
    return b;
}
__device__ __forceinline__ void xcd_barrier_complete(unsigned* bar, unsigned x, unsigned& nloc, unsigned& nx) {
    const unsigned G = gridDim.x * gridDim.y * gridDim.z;
    unsigned sum, cnt, mine, sp = 0u;
    for (;;) {
        sum = 0u; cnt = 0u; mine = 0u;
#pragma unroll
        for (unsigned j = 0; j < 16; ++j) { const unsigned c = xb_ld(&bar[XB_XCNT(j)]); sum += c; cnt += (c > 0u) ? 1u : 0u; mine = (j == x) ? c : mine; }
        if (sum == G) break;
        __builtin_amdgcn_s_sleep(1);
        if ((++sp & 255u) == 0u) { if (xb_ld(&bar[XB_TMO])) break; if (sp > XB_SPIN_CAP) { atomicAdd(&bar[XB_TMO], 1u); break; } }
    }
    nloc = mine > 0u ? mine : 1u; nx = cnt > 0u ? cnt : 1u;
}

__device__ __forceinline__ void xcd_barrier(const XcdBarrier& b) {
    asm volatile("s_waitcnt vmcnt(0)" ::: "memory");
    __syncthreads();
    if (threadIdx.x == 0) {
        unsigned* bar = b.bar;
        __builtin_amdgcn_s_waitcnt(0);
        unsigned nloc = b.st[0], nx = b.st[1];
        if (nloc == 0u) { xcd_barrier_complete(bar, b.x, nloc, nx); b.st[0] = nloc; b.st[1] = nx; }
        const unsigned old = xb_add(&bar[XB_XSUB(b.x)], 1u);
        const unsigned gen = old / nloc;
        if (old + 1u == (gen + 1u) * nloc) {
            __builtin_amdgcn_fence(__ATOMIC_RELEASE, "agent");
            asm volatile("s_waitcnt vmcnt(0)" ::: "memory");
            const unsigned og = xb_add(&bar[XB_TOP], 1u);
            const unsigned tg = og / nx;
            if (og + 1u == (tg + 1u) * nx) xb_add(&bar[XB_TOPGEN], 1u);
            else XB_SPIN(xb_ld(&bar[XB_TOPGEN]) == tg, bar);
            __builtin_amdgcn_fence(__ATOMIC_ACQUIRE, "agent");
            xb_add(&bar[XB_XGEN(b.x)], 1u);
            asm volatile("s_waitcnt vmcnt(0)" ::: "memory");
        } else {
            XB_SPIN(xb_ld(&bar[XB_XGEN(b.x)]) == gen, bar);
            __builtin_amdgcn_fence(__ATOMIC_ACQUIRE, "agent");
            asm volatile("s_waitcnt vmcnt(0)" ::: "memory");
        }
    }
    __syncthreads();
}


#define GAS __attribute__((address_space(1)))
typedef unsigned short bf16;
typedef unsigned v4u __attribute__((ext_vector_type(4)));
#define LDS_WAIT() asm volatile("s_waitcnt lgkmcnt(0)" ::: "memory")
__device__ __forceinline__ unsigned f2bf(float f) { unsigned u = __builtin_bit_cast(unsigned, f); return (u + 0x7fffu + ((u >> 16) & 1u)) >> 16; }
__device__ __forceinline__ unsigned pk2(float lo, float hi) { return f2bf(lo) | (f2bf(hi) << 16); }
__device__ __forceinline__ float bf2f(unsigned short b) { return __builtin_bit_cast(float, (unsigned)b << 16); }
#include <hip/hip_runtime.h>
namespace pg8 {
#define PG8_LAS __attribute__((address_space(3)))
typedef unsigned short bf16_t;
typedef short bf16x8 __attribute__((ext_vector_type(8)));
typedef float f32x4 __attribute__((ext_vector_type(4)));
typedef unsigned u32x4 __attribute__((ext_vector_type(4)));
constexpr int BM = 256, BK = 64, HALF = 128, HTB = HALF * BK * 2  , STAGE_BYTES = 8 * HTB, NXCD = 8, WGM = 8;

__host__ __device__ __forceinline__ int lds_byte(int r, int c) { const int st = (r >> 4) * 2 + (c >> 5), rr = r & 15, cc = c & 31, ob = rr * 64 + cc * 2; return st * 1024 + (ob ^ (((ob >> 9) & 1) << 5)); }
__host__ __device__ __forceinline__ void stage_rc(int b, int& R, int& C) { const int st = b / 1024, sb = b % 1024, swz = sb ^ (((sb >> 9) & 1) << 5); R = (st >> 1) * 16 + swz / 64; C = (st & 1) * 32 + (swz % 64) / 2; }
__host__ __device__ __forceinline__ int perm32(int rho) { const int n = rho >> 4, i = rho & 15; return 8 * (i >> 2) + 4 * n + (i & 3); }

struct Unit { int pm, pn; };
struct Gemm { const bf16_t* A; const bf16_t* Bt; int M, N, K; };

struct StaticOrder {
    int nM, nN, nwg, G, c;
    __host__ __device__ void init(int M, int N, int G_, int c_) { nM = M / BM; nN = N / BM; nwg = nM * nN; G = G_; c = c_; }
    __host__ __device__ bool next(int i, Unit& u) const {
        const long L = (long)i * G + c; if (L >= nwg) return false;
        int wgid = (int)L; { const int q = nwg / NXCD, r = nwg % NXCD, xcd = wgid % NXCD, off = wgid / NXCD; wgid = (xcd < r ? xcd * (q + 1) : r * (q + 1) + (xcd - r) * q) + off; }
        const int nig = WGM * nN, gid = wgid / nig, fm = gid * WGM, gsz = (nM - fm) < WGM ? (nM - fm) : WGM;
        u.pm = fm + ((wgid % nig) % gsz); u.pn = (wgid % nig) / gsz; return true;
    }
    __device__ __forceinline__ void a_ready(const Unit&) const {}
    __device__ __forceinline__ void done(const Unit&) const {}
};
__device__ __forceinline__ unsigned cvt_pk_bf16(float lo, float hi) { unsigned r; asm volatile("v_cvt_pk_bf16_f32 %0, %1, %2" : "=v"(r) : "v"(lo), "v"(hi)); return r; }
typedef float f32x2 __attribute__((ext_vector_type(2)));
__device__ __forceinline__ f32x2 gelu_pk(f32x2 v) {
    const f32x2 av = __builtin_elementwise_abs(v), d = av * 0.2316418882f + 1.0f;
    f32x2 t; t.x = __builtin_amdgcn_rcpf(d.x); t.y = __builtin_amdgcn_rcpf(d.y);
    f32x2 q = t * 0.5307027145f + (-0.7265760135f); q = q * t + 0.7107068705f; q = q * t + (-0.142248368f); q = q * t + 0.127414796f; q = q * t;
    const f32x2 s = (v * v) * (-0.72134752044f);
    f32x2 e; e.x = __builtin_amdgcn_exp2f(s.x); e.y = __builtin_amdgcn_exp2f(s.y);
    const f32x2 m = v * (q * e), r = v - m;
    f32x2 o; o.x = v.x < 0.f ? m.x : r.x; o.y = v.y < 0.f ? m.y : r.y; return o;
}

struct EpiF32 {
    static constexpr bool PERM = false, AFTER_DRAIN = false;
    float* C; int ldc; const float* bias;
    __device__ __forceinline__ void operator()(const f32x4 (&acc)[2][2][4][2], const Unit& u, int wr, int wc, int fr, int fq) const {
        const int row0 = u.pm * BM + wr * 64 + fr, col0 = u.pn * BM + wc * 32 + 4 * fq;
        f32x4 bv[2][2];
#pragma unroll
        for (int bj = 0; bj < 2; ++bj)
#pragma unroll
            for (int n = 0; n < 2; ++n) bv[bj][n] = bias ? *(const f32x4*)(bias + col0 + bj * HALF + n * 16) : (f32x4){0.f, 0.f, 0.f, 0.f};
#pragma unroll
        for (int ai = 0; ai < 2; ++ai)
#pragma unroll
            for (int m = 0; m < 4; ++m) { float* rowp = C + (size_t)(row0 + ai * HALF + m * 16) * ldc + col0;
#pragma unroll
                for (int bj = 0; bj < 2; ++bj)
#pragma unroll
                    for (int n = 0; n < 2; ++n) *(f32x4*)(rowp + bj * HALF + n * 16) = acc[ai][bj][m][n] + bv[bj][n]; }
    }
};

template <class Epi, class Sched, bool STAMP = false>
__device__ __forceinline__ void gemm_phase(PG8_LAS unsigned char* lds, const Gemm g, const Sched& S, const Epi& E, unsigned long long* stamps) {
    const int tid = threadIdx.x, wid = __builtin_amdgcn_readfirstlane(tid >> 6), lane = tid & 63, wr = wid >> 2, wc = wid & 3, fr = lane & 15, fq = lane >> 4;
    const int K = g.K, nt = K / BK;
    int ts_lo = 0, ts_hi = 0, nts = 0; const unsigned long long rt_entry = STAMP ? (unsigned long long)wall_clock64() : 0ull;
#define PG8_STAMP() do { if (STAMP && wid == 0 && nts < 64) { const unsigned long long _c = (unsigned long long)clock64(); \
        ts_lo = (lane == nts) ? (int)(unsigned)_c : ts_lo; ts_hi = (lane == nts) ? (int)(unsigned)(_c >> 32) : ts_hi; ++nts; } } while (0)
    PG8_STAMP();
    unsigned voffA[2], voffB[2];
#pragma unroll
    for (int i = 0; i < 2; ++i) { int R, C; stage_rc(tid * 16 + i * 8192, R, C); const int Rb = Epi::PERM ? ((R & ~31) + perm32(R & 31)) : R;
        voffA[i] = (unsigned)(R * K + C) * 2u; voffB[i] = (unsigned)(Rb * K + C) * 2u; }
    const size_t kstep = (size_t)(BK * 2);
    const size_t hstep = (size_t)HALF * K * 2;
    const size_t tstep = 2 * hstep;
    const unsigned ldsw = (unsigned)wid * 1024u;
    const int aoff = lds_byte(wr * 64 + fr, fq * 8), boff = lds_byte(wc * 32 + fr, fq * 8);
#define PG8_SA(b, h) (((b) * 2 + (h)) * HTB)
#define PG8_SB(b, h) ((4 + (b) * 2 + (h)) * HTB)
#define PG8_STAGE(bufoff, gbase, voff) do { _Pragma("unroll") for (int _i = 0; _i < 2; ++_i) \
        __builtin_amdgcn_global_load_lds((const unsigned*)((const char*)(gbase) + (voff)[_i]), (PG8_LAS unsigned*)(lds + (bufoff) + ldsw + _i * 8192), 16, 0, 0); } while (0)
#define PG8_LDA(dst, b, h) do { _Pragma("unroll") for (int m = 0; m < 4; ++m) _Pragma("unroll") for (int k = 0; k < 2; ++k) dst[m][k] = *(const PG8_LAS bf16x8*)(lds + PG8_SA(b, h) + aoff + m * 2048 + k * 1024); } while (0)
#define PG8_LDB(dst, b, h) do { _Pragma("unroll") for (int n = 0; n < 2; ++n) _Pragma("unroll") for (int k = 0; k < 2; ++k) dst[n][k] = *(const PG8_LAS bf16x8*)(lds + PG8_SB(b, h) + boff + n * 2048 + k * 1024); } while (0)
#define PG8_MMA(ai, bj, At, Bt) do { __builtin_amdgcn_s_setprio(1); _Pragma("unroll") for (int m = 0; m < 4; ++m) _Pragma("unroll") for (int n = 0; n < 2; ++n) _Pragma("unroll") for (int k = 0; k < 2; ++k) \
        acc[ai][bj][m][n] = __builtin_amdgcn_mfma_f32_16x16x32_bf16(Bt[n][k], At[m][k], acc[ai][bj][m][n], 0, 0, 0); __builtin_amdgcn_s_setprio(0); } while (0)
#define PG8_WAIT_V(n) asm volatile("s_waitcnt vmcnt(" #n ")" ::: "memory")
#define PG8_WAIT_L(n) asm volatile("s_waitcnt lgkmcnt(" #n ")" ::: "memory")
#define PG8_BAR __builtin_amdgcn_s_barrier()
#define PG8_SCHED __builtin_amdgcn_sched_barrier(0)
    Unit cur, nxt; int ui = 0;
    if (!S.next(0, cur)) return;
    f32x4 acc[2][2][4][2];
#pragma unroll
    for (int a = 0; a < 2; ++a)
#pragma unroll
        for (int b = 0; b < 2; ++b)
#pragma unroll
            for (int m = 0; m < 4; ++m)
#pragma unroll
                for (int n = 0; n < 2; ++n) acc[a][b][m][n] = (f32x4){0.f, 0.f, 0.f, 0.f};
    bf16x8 At[4][2], B0[2][2], B1[2][2];
    const char* cA = (const char*)g.A + (size_t)cur.pm * tstep; const char* cB = (const char*)g.Bt + (size_t)cur.pn * tstep;
    S.a_ready(cur);
    PG8_STAGE(PG8_SB(0, 0), cB, voffB); PG8_STAGE(PG8_SA(0, 0), cA, voffA); PG8_STAGE(PG8_SB(0, 1), cB + hstep, voffB); PG8_STAGE(PG8_SA(0, 1), cA + hstep, voffA);
    if (wr == 1) PG8_BAR;
    PG8_WAIT_V(4); PG8_BAR;
    PG8_STAGE(PG8_SB(1, 0), cB + kstep, voffB); PG8_STAGE(PG8_SA(1, 0), cA + kstep, voffA); PG8_STAGE(PG8_SB(1, 1), cB + hstep + kstep, voffB);
    PG8_WAIT_V(6); PG8_BAR;
    PG8_STAMP();
    for (;;) {
        const bool has_next = S.next(ui + 1, nxt);
        const char* nA = has_next ? (const char*)g.A + (size_t)nxt.pm * tstep : cA; const char* nB = has_next ? (const char*)g.Bt + (size_t)nxt.pn * tstep : cB;
        for (int t = 0; t < nt; t += 2) {
            const bool last = (t == nt - 2);
            const char* a1 = cA + (size_t)(t + 1) * kstep;
            const char* a2 = last ? nA : cA + (size_t)(t + 2) * kstep; const char* b2 = last ? nB : cB + (size_t)(t + 2) * kstep;
            const char* a3 = a2 + kstep; const char* b3 = b2 + kstep;
            if (last && has_next) S.a_ready(nxt);
            PG8_LDB(B0, 0, 0); PG8_SCHED; PG8_LDA(At, 0, 0); PG8_STAGE(PG8_SA(1, 1), a1 + hstep, voffA);
            PG8_WAIT_L(8); PG8_BAR; PG8_WAIT_L(0); PG8_MMA(0, 0, At, B0); PG8_BAR; PG8_SCHED;
            PG8_LDB(B1, 0, 1); PG8_STAGE(PG8_SB(0, 0), b2, voffB);
            PG8_BAR; PG8_WAIT_L(0); PG8_MMA(0, 1, At, B1); PG8_BAR;
            PG8_LDA(At, 0, 1); PG8_STAGE(PG8_SA(0, 0), a2, voffA);
            PG8_BAR; PG8_WAIT_L(0); PG8_MMA(1, 0, At, B0); PG8_BAR; PG8_SCHED;
            PG8_STAGE(PG8_SB(0, 1), b2 + hstep, voffB);
            PG8_WAIT_V(6); PG8_BAR; PG8_MMA(1, 1, At, B1); PG8_BAR;
            PG8_LDB(B0, 1, 0); PG8_SCHED; PG8_LDA(At, 1, 0); PG8_STAGE(PG8_SA(0, 1), a2 + hstep, voffA);
            PG8_WAIT_L(8); PG8_BAR; PG8_WAIT_L(0); PG8_MMA(0, 0, At, B0); PG8_BAR; PG8_SCHED;
            PG8_LDB(B1, 1, 1); PG8_STAGE(PG8_SB(1, 0), b3, voffB);
            PG8_BAR; PG8_WAIT_L(0); PG8_MMA(0, 1, At, B1); PG8_BAR;
            PG8_LDA(At, 1, 1); PG8_STAGE(PG8_SA(1, 0), a3, voffA);
            PG8_BAR; PG8_WAIT_L(0); PG8_MMA(1, 0, At, B0); PG8_BAR; PG8_SCHED;
            PG8_STAGE(PG8_SB(1, 1), b3 + hstep, voffB);
            PG8_WAIT_V(6); PG8_BAR; PG8_MMA(1, 1, At, B1); PG8_BAR;
        }
        PG8_STAMP();
        if constexpr (!Epi::AFTER_DRAIN) { E(acc, cur, wr, wc, fr, fq); S.done(cur); }
        PG8_STAMP();
        if (!has_next) break;
#pragma unroll
        for (int a = 0; a < 2; ++a)
#pragma unroll
            for (int b = 0; b < 2; ++b)
#pragma unroll
                for (int m = 0; m < 4; ++m)
#pragma unroll
                    for (int n = 0; n < 2; ++n) acc[a][b][m][n] = (f32x4){0.f, 0.f, 0.f, 0.f};
        cur = nxt; cA = nA; cB = nB; ++ui;
    }
    PG8_WAIT_V(0);
    if (wr == 0) PG8_BAR;
    PG8_BAR;
    if constexpr (Epi::AFTER_DRAIN) { E.fused(acc, cur, wr, wc, fr, fq, lds, wid, lane); S.done(cur); }
    PG8_STAMP();
    if (STAMP && wid == 0) { stamps[lane] = lane < nts ? (((unsigned long long)(unsigned)ts_hi << 32) | (unsigned)ts_lo) : 0ull;
        if (lane == 62) stamps[62] = rt_entry; if (lane == 63) stamps[63] = (unsigned long long)wall_clock64(); }
#undef PG8_STAMP
#undef PG8_SA
#undef PG8_SB
#undef PG8_STAGE
#undef PG8_LDA
#undef PG8_LDB
#undef PG8_MMA
#undef PG8_WAIT_V
#undef PG8_WAIT_L
#undef PG8_BAR
#undef PG8_SCHED
}
}


namespace pg8 {
struct EpiProj {
    static constexpr bool PERM = true, AFTER_DRAIN = false;
    bf16_t* O; float* dtraw;
    __device__ __forceinline__ void operator()(const f32x4 (&acc)[2][2][4][2], const Unit& u, int wr, int wc, int fr, int fq) const {
        const int row0 = u.pm * BM + wr * 64 + fr;
        if (u.pn < 22) {
            const int col0 = u.pn * BM + wc * 32 + 8 * fq;
#pragma unroll
            for (int ai = 0; ai < 2; ++ai)
#pragma unroll
                for (int m = 0; m < 4; ++m) { bf16_t* rowp = O + (size_t)(row0 + ai * HALF + m * 16) * 5632 + col0;
#pragma unroll
                    for (int bj = 0; bj < 2; ++bj) { const f32x4 v0 = acc[ai][bj][m][0], v1 = acc[ai][bj][m][1];
                        u32x4 w; w.x = cvt_pk_bf16(v0[0], v0[1]); w.y = cvt_pk_bf16(v0[2], v0[3]); w.z = cvt_pk_bf16(v1[0], v1[1]); w.w = cvt_pk_bf16(v1[2], v1[3]);
                        *(u32x4*)(rowp + bj * HALF) = w; } }
        } else if (wc == 0) {
#pragma unroll
            for (int ai = 0; ai < 2; ++ai)
#pragma unroll
                for (int m = 0; m < 4; ++m) { float* rp = dtraw + (size_t)(row0 + ai * HALF + m * 16) * 32 + 8 * fq;
                    *(f32x4*)rp = acc[ai][0][m][0]; *(f32x4*)(rp + 4) = acc[ai][0][m][1]; }
        }
    }
};
}


namespace pg8 {
struct EpiBf16Plain {
    static constexpr bool PERM = true, AFTER_DRAIN = false;
    bf16_t* O; int ldc;
    __device__ __forceinline__ void operator()(const f32x4 (&acc)[2][2][4][2], const Unit& u, int wr, int wc, int fr, int fq) const {
        const int row0 = u.pm * BM + wr * 64 + fr, col0 = u.pn * BM + wc * 32 + 8 * fq;
#pragma unroll
        for (int ai = 0; ai < 2; ++ai)
#pragma unroll
            for (int m = 0; m < 4; ++m) { bf16_t* rowp = O + (size_t)(row0 + ai * HALF + m * 16) * ldc + col0;
#pragma unroll
                for (int bj = 0; bj < 2; ++bj) { const f32x4 v0 = acc[ai][bj][m][0], v1 = acc[ai][bj][m][1];
                    u32x4 w; w.x = cvt_pk_bf16(v0[0], v0[1]); w.y = cvt_pk_bf16(v0[2], v0[3]); w.z = cvt_pk_bf16(v1[0], v1[1]); w.w = cvt_pk_bf16(v1[2], v1[3]);
                    *(u32x4*)(rowp + bj * HALF) = w; } }
    }
};
}

#define NTHR 512
#define NWAVE 8

__device__ __forceinline__ void ph_gemm_f32(float* lds, const float* __restrict__ A, const float* __restrict__ B, float* __restrict__ C,
                                            int M, int N, int K, int lda, int ldb, int ldc) {
    const int tid = threadIdx.x & 255, half = threadIdx.x >> 8, tx = tid & 15, ty = tid >> 4;
    float (*As)[68] = (float (*)[68])(lds + half * 2 * 16 * 68);
    float (*Bs)[68] = (float (*)[68])(lds + half * 2 * 16 * 68 + 16 * 68);
    const int ntx = (N + 63) / 64, nty = M / 64, ntiles = ntx * nty;
    for (int it = blockIdx.x; 2 * it < ntiles; it += gridDim.x) {
        const int tile = 2 * it + half;
        const int m0 = (tile / ntx) * 64, n0 = (tile % ntx) * 64;
        float acc[4][4];
#pragma unroll
        for (int i = 0; i < 4; ++i)
#pragma unroll
            for (int j = 0; j < 4; ++j) acc[i][j] = 0.f;
        for (int k0 = 0; k0 < K; k0 += 16) {
#pragma unroll
            for (int i = 0; i < 4; ++i) {
                int idx = tid + i * 256;
                int r = idx >> 4, c = idx & 15;
                As[c][r] = (m0 + r < M) ? A[(size_t)(m0 + r) * lda + k0 + c] : 0.f;
                int rb = idx >> 6, cb = idx & 63;
                Bs[rb][cb] = (n0 + cb < N) ? B[(size_t)(k0 + rb) * ldb + n0 + cb] : 0.f;
            }
            __syncthreads();
#pragma unroll
            for (int k = 0; k < 16; ++k) {
                float a[4], b[4];
#pragma unroll
                for (int i = 0; i < 4; ++i) { a[i] = As[k][ty * 4 + i]; b[i] = Bs[k][tx * 4 + i]; }
#pragma unroll
                for (int i = 0; i < 4; ++i)
#pragma unroll
                    for (int j = 0; j < 4; ++j) acc[i][j] += a[i] * b[j];
            }
            __syncthreads();
        }
#pragma unroll
        for (int i = 0; i < 4; ++i)
#pragma unroll
            for (int j = 0; j < 4; ++j) {
                int r = m0 + ty * 4 + i, c = n0 + tx * 4 + j;
                if (r < M && c < N) C[(size_t)r * ldc + c] = acc[i][j];
            }
    }
}


template <int MODE>
__device__ __forceinline__ void transpose_item(const float* __restrict__ W, int K, int N, int Npad, bf16* __restrict__ WT, LAS float* scr, int item, int lane) {
    const int nblk = Npad / 32, kb = item / nblk, nb = item % nblk, k0 = 64 * kb, n0 = 32 * nb;
    const int n = n0 + (lane & 31);
    int sc = n;
    if (MODE == 1) sc = (n < 4096) ? n : (n < 5632 ? n + 24 : (n < 5656 ? n - 5632 + 4096 : -1));
    else sc = (n < N) ? n : -1;
#pragma unroll 8
    for (int i = 0; i < 32; ++i) { const int kk = 2 * i + (lane >> 5); scr[kk * 33 + (lane & 31)] = (sc >= 0) ? W[(size_t)(k0 + kk) * N + sc] : 0.f; }
    LDS_WAIT(); asm volatile("" ::: "memory");
    const int c = lane & 7;
#pragma unroll
    for (int j = 0; j < 4; ++j) { const int nn = (lane >> 3) + 8 * j; const LAS float* s = scr + (8 * c) * 33 + nn;
        v4u o; o.x = pk2(s[0 * 33], s[1 * 33]); o.y = pk2(s[2 * 33], s[3 * 33]); o.z = pk2(s[4 * 33], s[5 * 33]); o.w = pk2(s[6 * 33], s[7 * 33]);
        *(v4u*)(WT + (size_t)(n0 + nn) * K + k0 + 8 * c) = o; }
    LDS_WAIT(); asm volatile("" ::: "memory");
}
__device__ __forceinline__ void ph_prologue(LAS unsigned char* ldsb, const float* __restrict__ xp, const float* __restrict__ xs, bf16* __restrict__ A0,
                                            const float* __restrict__ w_in, bf16* __restrict__ wt_in, const float* __restrict__ w_out, bf16* __restrict__ wt_out,
                                            const float* __restrict__ w_q, bf16* __restrict__ wt_q) {
    const int lane = threadIdx.x & 63, wave = threadIdx.x >> 6;
    LAS float* scr = (LAS float*)(ldsb + wave * 16384);
    const int gw = blockIdx.x * NWAVE + wave, NGW = gridDim.x * NWAVE;
    constexpr int I_IN = (D_MODEL / 64) * (PROJ_LD / 32), I_OUT = (MIX_WIDTH / 64) * (D_MODEL / 32), I_Q = (D_MODEL / 64) * (2048 / 32);
    for (int it = gw; it < I_IN + I_OUT + I_Q; it += NGW) {
        int r = it;
        if (r < I_IN) { transpose_item<1>(w_in, D_MODEL, IN_WIDTH, PROJ_LD, wt_in, scr, r, lane); continue; } r -= I_IN;
        if (r < I_OUT) { transpose_item<0>(w_out, MIX_WIDTH, D_MODEL, D_MODEL, wt_out, scr, r, lane); continue; } r -= I_OUT;
        transpose_item<0>(w_q, D_MODEL, 2048, 2048, wt_q, scr, r, lane);
    }
    const size_t n8 = (size_t)T_ALL * D_MODEL / 8, np8 = (size_t)T_PROMPT * D_MODEL / 8;
    for (size_t i = (size_t)blockIdx.x * NTHR + threadIdx.x; i < n8; i += (size_t)gridDim.x * NTHR) {
        const float4* s = (i < np8) ? (const float4*)xp + 2 * i : (const float4*)xs + 2 * (i - np8);
        float4 a = s[0], b = s[1];
        v4u o; o.x = pk2(a.x, a.y); o.y = pk2(a.z, a.w); o.z = pk2(b.x, b.y); o.w = pk2(b.z, b.w);
        ((v4u*)A0)[i] = o;
    }
}

__device__ __forceinline__ void ph_concat_x(const float* __restrict__ xp, const float* __restrict__ xs, float* __restrict__ xall) {
    const size_t n4 = (size_t)T_ALL * D_MODEL / 4, np4 = (size_t)T_PROMPT * D_MODEL / 4;
    for (size_t i = (size_t)blockIdx.x * NTHR + threadIdx.x; i < n4; i += (size_t)gridDim.x * NTHR) {
        float4 v = (i < np4) ? ((const float4*)xp)[i] : ((const float4*)xs)[i - np4];
        ((float4*)xall)[i] = v;
    }
}

__device__ __forceinline__ void ph_cache_copy(const float* __restrict__ ck, const float* __restrict__ cv, float* __restrict__ out) {
    const size_t per_b4 = (size_t)(WBUF - DEC_SEQ) * ATT_WIDTH / 4;
    const size_t total = per_b4 * DEC_BATCH;
    for (size_t i = (size_t)blockIdx.x * NTHR + threadIdx.x; i < total; i += (size_t)gridDim.x * NTHR) {
        size_t b = i / per_b4, r = i % per_b4;
        size_t src = (b * WBUF * ATT_WIDTH + DEC_SEQ * ATT_WIDTH) / 4 + r;
        size_t dst = (b * WBUF * ATT_WIDTH) / 4 + r;
        ((float4*)(out + OUT_SK))[dst] = ((const float4*)ck)[src];
        ((float4*)(out + OUT_SV))[dst] = ((const float4*)cv)[src];
    }
}

__device__ __forceinline__ void ph_post_proj(const float* __restrict__ proj, const float* __restrict__ state_conv,
                                             const float* __restrict__ conv_w, const float* __restrict__ conv_b, const float* __restrict__ dt_bias,
                                             float* __restrict__ xbc_act, float* __restrict__ dtv, float* __restrict__ qrot, float* __restrict__ krot,
                                             float* __restrict__ out) {
    const int tid = threadIdx.x & 255, half = threadIdx.x >> 8;
    for (int t = 2 * blockIdx.x + half; t < T_ALL; t += 2 * gridDim.x) {
        const bool is_p = t < T_PROMPT;
        int b, i, pos;
        if (is_p) { b = t / SEQ; i = t % SEQ; pos = i; } else { int ts = t - T_PROMPT; b = ts / DEC_SEQ; i = ts % DEC_SEQ; pos = PAST_LEN + i; }
        const float* row = proj + (size_t)t * PROJ_LD;
        for (int c = tid; c < CONV_DIM; c += 256) {
            float acc = conv_b[c];
#pragma unroll
            for (int tap = 0; tap < 4; ++tap) {
                int r = i - 3 + tap;
                float val;
                if (r >= 0) val = proj[(size_t)(t - i + r) * PROJ_LD + O_XBC + c];
                else val = is_p ? 0.f : state_conv[((size_t)b * 3 + (3 + r)) * CONV_DIM + c];
                acc += val * conv_w[tap * CONV_DIM + c];
            }
            xbc_act[(size_t)t * CONV_DIM + c] = silu_f(acc);
        }
        if (tid < SSD_HEADS) dtv[(size_t)t * SSD_HEADS + tid] = softplus_f(row[O_DT + tid] + dt_bias[tid]);
        for (int idx = tid; idx < 512; idx += 256) {
            int which = idx >> 8, h = (idx >> 5) & 7, j = idx & 31;
            double rev = (double)pos * ROPE_INV_REV[j];
            float fr = (float)(rev - floor(rev));
            float sn = __builtin_amdgcn_sinf(fr), cs = __builtin_amdgcn_cosf(fr);
            const float* src = row + (which ? O_K : O_Q) + h * 64;
            float t1 = src[j], t2 = src[j + 32];
            float o1 = t1 * cs - t2 * sn, o2 = t2 * cs + t1 * sn;
            float* dst = (which ? krot : qrot) + (size_t)t * ATT_WIDTH + h * 64;
            dst[j] = o1; dst[j + 32] = o2;
            if (which) {
                if (is_p) { if (i >= SEQ - WBUF) { float* o = out + OUT_PK + ((size_t)b * WBUF + (i - (SEQ - WBUF))) * ATT_WIDTH + h * 64; o[j] = o1; o[j + 32] = o2; } }
                else { float* o = out + OUT_SK + ((size_t)b * WBUF + (WBUF - DEC_SEQ + i)) * ATT_WIDTH + h * 64; o[j] = o1; o[j + 32] = o2; }
            }
        }
        for (int c = tid; c < ATT_WIDTH; c += 256) {
            float v = row[O_V + c];
            if (is_p) { if (i >= SEQ - WBUF) out[OUT_PV + ((size_t)b * WBUF + (i - (SEQ - WBUF))) * ATT_WIDTH + c] = v; }
            else out[OUT_SV + ((size_t)b * WBUF + (WBUF - DEC_SEQ + i)) * ATT_WIDTH + c] = v;
        }
        if (is_p) {
            if (i >= SEQ - 3) { int r = i - (SEQ - 3); for (int c = tid; c < CONV_DIM; c += 256) out[OUT_PC + ((size_t)b * 3 + r) * CONV_DIM + c] = row[O_XBC + c]; }
        } else {
            if (i >= 1) { int r = i - 1; for (int c = tid; c < CONV_DIM; c += 256) out[OUT_SC + ((size_t)b * 3 + r) * CONV_DIM + c] = row[O_XBC + c]; }
        }
    }
}


#define NB_LD 5632
#define NB_XBC 1536
#define NB_Q 4096
#define NB_K 4608
#define NB_V 5120
__device__ __forceinline__ void unpack8(const v4u w, float (&f)[8]) {
    f[0] = __builtin_bit_cast(float, w.x << 16); f[1] = __builtin_bit_cast(float, w.x & 0xffff0000u);
    f[2] = __builtin_bit_cast(float, w.y << 16); f[3] = __builtin_bit_cast(float, w.y & 0xffff0000u);
    f[4] = __builtin_bit_cast(float, w.z << 16); f[5] = __builtin_bit_cast(float, w.z & 0xffff0000u);
    f[6] = __builtin_bit_cast(float, w.w << 16); f[7] = __builtin_bit_cast(float, w.w & 0xffff0000u);
}
__device__ __forceinline__ void store8f(float* d, const float (&f)[8]) { *(float4*)d = make_float4(f[0], f[1], f[2], f[3]); *(float4*)(d + 4) = make_float4(f[4], f[5], f[6], f[7]); }
__device__ __forceinline__ void ph_post_proj2(const bf16* __restrict__ projb, const float* __restrict__ dtraw, const float* __restrict__ state_conv,
                                              const float* __restrict__ conv_w, const float* __restrict__ conv_b, const float* __restrict__ dt_bias,
                                              bf16* __restrict__ xbc_b, float* __restrict__ dtv, bf16* __restrict__ qrot_b, bf16* __restrict__ krot_b,
                                              float* __restrict__ out) {
    const int tid = threadIdx.x & 255, half = threadIdx.x >> 8;
    for (int t = 2 * blockIdx.x + half; t < T_ALL; t += 2 * gridDim.x) {
        const bool is_p = t < T_PROMPT;
        int b, i, pos;
        if (is_p) { b = t / SEQ; i = t % SEQ; pos = i; } else { int ts = t - T_PROMPT; b = ts / DEC_SEQ; i = ts % DEC_SEQ; pos = PAST_LEN + i; }
        const bf16* row = projb + (size_t)t * NB_LD;
        if (tid < 64) {
            float f[8]; unpack8(*(const v4u*)(row + NB_V + tid * 8), f);
            if (is_p) { if (i >= SEQ - WBUF) store8f(out + OUT_PV + ((size_t)b * WBUF + (i - (SEQ - WBUF))) * ATT_WIDTH + tid * 8, f); }
            else store8f(out + OUT_SV + ((size_t)b * WBUF + (WBUF - DEC_SEQ + i)) * ATT_WIDTH + tid * 8, f);
        }
        for (int c8 = tid; c8 < 320; c8 += 256) {
            const int c = c8 * 8;
            float acc[8], cur[8];
            { const float4 b0 = *(const float4*)(conv_b + c), b1 = *(const float4*)(conv_b + c + 4);
              acc[0] = b0.x; acc[1] = b0.y; acc[2] = b0.z; acc[3] = b0.w; acc[4] = b1.x; acc[5] = b1.y; acc[6] = b1.z; acc[7] = b1.w; }
#pragma unroll
            for (int tap = 0; tap < 4; ++tap) {
                const int r = i - 3 + tap;
                float val[8];
                if (r >= 0) unpack8(*(const v4u*)(projb + (size_t)(t - i + r) * NB_LD + NB_XBC + c), val);
                else if (!is_p) { const float* sp = state_conv + ((size_t)b * 3 + (3 + r)) * CONV_DIM + c; const float4 s0 = *(const float4*)sp, s1 = *(const float4*)(sp + 4);
                    val[0] = s0.x; val[1] = s0.y; val[2] = s0.z; val[3] = s0.w; val[4] = s1.x; val[5] = s1.y; val[6] = s1.z; val[7] = s1.w; }
                else {
#pragma unroll
                    for (int j = 0; j < 8; ++j) val[j] = 0.f; }
                const float4 w0 = *(const float4*)(conv_w + tap * CONV_DIM + c), w1 = *(const float4*)(conv_w + tap * CONV_DIM + c + 4);
                acc[0] += val[0] * w0.x; acc[1] += val[1] * w0.y; acc[2] += val[2] * w0.z; acc[3] += val[3] * w0.w;
                acc[4] += val[4] * w1.x; acc[5] += val[5] * w1.y; acc[6] += val[6] * w1.z; acc[7] += val[7] * w1.w;
                if (tap == 3) {
#pragma unroll
                    for (int j = 0; j < 8; ++j) cur[j] = val[j]; }
            }
#pragma unroll
            for (int j = 0; j < 8; ++j) acc[j] = silu_f(acc[j]);
            v4u o; o.x = pk2(acc[0], acc[1]); o.y = pk2(acc[2], acc[3]); o.z = pk2(acc[4], acc[5]); o.w = pk2(acc[6], acc[7]);
            *(v4u*)(xbc_b + (size_t)t * CONV_DIM + c) = o;
            if (is_p) { if (i >= SEQ - 3) store8f(out + OUT_PC + ((size_t)b * 3 + (i - (SEQ - 3))) * CONV_DIM + c, cur); }
            else { if (i >= 1) store8f(out + OUT_SC + ((size_t)b * 3 + (i - 1)) * CONV_DIM + c, cur); }
        }
        if (tid < SSD_HEADS) dtv[(size_t)t * SSD_HEADS + tid] = softplus_f(dtraw[(size_t)t * 32 + tid] + dt_bias[tid]);
        if (tid < 128) {
            const int which = tid >> 6, h = (tid >> 3) & 7, jc = tid & 7;
            const bf16* src = row + (which ? NB_K : NB_Q) + h * 64 + jc * 4;
            const uint2 lo = *(const uint2*)src, hi = *(const uint2*)(src + 32);
            float t1[4], t2[4], o1[4], o2[4];
            t1[0] = __builtin_bit_cast(float, lo.x << 16); t1[1] = __builtin_bit_cast(float, lo.x & 0xffff0000u); t1[2] = __builtin_bit_cast(float, lo.y << 16); t1[3] = __builtin_bit_cast(float, lo.y & 0xffff0000u);
            t2[0] = __builtin_bit_cast(float, hi.x << 16); t2[1] = __builtin_bit_cast(float, hi.x & 0xffff0000u); t2[2] = __builtin_bit_cast(float, hi.y << 16); t2[3] = __builtin_bit_cast(float, hi.y & 0xffff0000u);
#pragma unroll
            for (int e = 0; e < 4; ++e) {
                const double rev = (double)pos * ROPE_INV_REV[jc * 4 + e];
                const float fr = (float)(rev - floor(rev));
                const float sn = __builtin_amdgcn_sinf(fr), cs = __builtin_amdgcn_cosf(fr);
                o1[e] = t1[e] * cs - t2[e] * sn; o2[e] = t2[e] * cs + t1[e] * sn;
            }
            const size_t doff = (size_t)t * ATT_WIDTH + h * 64 + jc * 4;
            bf16* db = which ? krot_b : qrot_b;
            *(uint2*)(db + doff) = make_uint2(pk2(o1[0], o1[1]), pk2(o1[2], o1[3])); *(uint2*)(db + doff + 32) = make_uint2(pk2(o2[0], o2[1]), pk2(o2[2], o2[3]));
            if (which) {
                float* o = nullptr;
                if (is_p) { if (i >= SEQ - WBUF) o = out + OUT_PK + ((size_t)b * WBUF + (i - (SEQ - WBUF))) * ATT_WIDTH + h * 64 + jc * 4; }
                else o = out + OUT_SK + ((size_t)b * WBUF + (WBUF - DEC_SEQ + i)) * ATT_WIDTH + h * 64 + jc * 4;
                if (o) { *(float4*)o = make_float4(o1[0], o1[1], o1[2], o1[3]); *(float4*)(o + 32) = make_float4(o2[0], o2[1], o2[2], o2[3]); }
            }
        }
    }
}

#define SSD_CH 32
__device__ __forceinline__ void ph_ssd_naive(float* lds, const bf16* __restrict__ xbc_act, const float* __restrict__ dtv, const float* __restrict__ a_log,
                                             const float* __restrict__ d_skip, const float* __restrict__ state_ssm, float* __restrict__ ybuf, float* __restrict__ out) {
    float (*sx)[64] = (float (*)[64])lds;
    float (*sB)[128] = (float (*)[128])(lds + SSD_CH * 64);
    float (*sC)[128] = (float (*)[128])(lds + SSD_CH * 64 + SSD_CH * 128);
    float* sdt = lds + SSD_CH * 64 + 2 * SSD_CH * 128;
    const int tid = threadIdx.x, p = tid >> 3, ng = tid & 7;
    for (int vb = BATCH * SSD_HEADS + blockIdx.x; vb < (BATCH + DEC_BATCH) * SSD_HEADS; vb += gridDim.x) {
        const int seq = vb / SSD_HEADS, h = vb % SSD_HEADS, g = h / 6;
        const bool is_p = seq < BATCH;
        const int L = is_p ? SEQ : DEC_SEQ;
        const int t0 = is_p ? seq * SEQ : T_PROMPT + (seq - BATCH) * DEC_SEQ;
        const float A = -__expf(a_log[h]);
        const float D = d_skip[h];
        float hs[16];
        if (is_p) {
#pragma unroll
            for (int j = 0; j < 16; ++j) hs[j] = 0.f;
        } else {
            const float* s0 = state_ssm + (((size_t)(seq - BATCH) * SSD_HEADS + h) * 64 + p) * 128 + ng * 16;
#pragma unroll
            for (int j = 0; j < 16; ++j) hs[j] = s0[j];
        }
        for (int c0 = 0; c0 < L; c0 += SSD_CH) {
            const int nst = (L - c0) < SSD_CH ? (L - c0) : SSD_CH;
            __syncthreads();
            for (int idx = tid; idx < nst * 64; idx += NTHR) { int s = idx >> 6, c = idx & 63; sx[s][c] = bf2f(xbc_act[(size_t)(t0 + c0 + s) * CONV_DIM + h * 64 + c]); }
            for (int idx = tid; idx < nst * 128; idx += NTHR) { int s = idx >> 7, c = idx & 127;
                sB[s][c] = bf2f(xbc_act[(size_t)(t0 + c0 + s) * CONV_DIM + 1536 + g * 128 + c]);
                sC[s][c] = bf2f(xbc_act[(size_t)(t0 + c0 + s) * CONV_DIM + 2048 + g * 128 + c]); }
            if (tid < nst) sdt[tid] = dtv[(size_t)(t0 + c0 + tid) * SSD_HEADS + h];
            __syncthreads();
            for (int s = 0; s < nst; ++s) {
                const float dt = sdt[s], x = sx[s][p];
                const float a = __expf(dt * A), xdt = x * dt;
                float y = 0.f;
#pragma unroll
                for (int j = 0; j < 16; ++j) { hs[j] = a * hs[j] + xdt * sB[s][ng * 16 + j]; y += sC[s][ng * 16 + j] * hs[j]; }
                y += __shfl_xor(y, 1); y += __shfl_xor(y, 2); y += __shfl_xor(y, 4);
                if (ng == 0) ybuf[(size_t)(t0 + c0 + s) * MIX_WIDTH + h * 64 + p] = y + D * x;
            }
        }
        float* so = is_p ? out + OUT_PS + (((size_t)seq * SSD_HEADS + h) * 64 + p) * 128 + ng * 16
                         : out + OUT_SS + (((size_t)(seq - BATCH) * SSD_HEADS + h) * 64 + p) * 128 + ng * 16;
#pragma unroll
        for (int j = 0; j < 16; ++j) so[j] = hs[j];
    }
}

__device__ __forceinline__ void ph_gate_norm(const bf16* __restrict__ projb, const float* __restrict__ norm_g, const float* __restrict__ ybuf, bf16* __restrict__ A1) {
    const int w = threadIdx.x >> 6, lane = threadIdx.x & 63, g = w & 3;
    for (int t = T_PROMPT + 2 * blockIdx.x + (w >> 2); t < T_ALL; t += 2 * gridDim.x) {
        float v[6]; float ss = 0.f;
#pragma unroll
        for (int j = 0; j < 6; ++j) {
            int c = g * 384 + j * 64 + lane;
            float y = ybuf[(size_t)t * MIX_WIDTH + c], z = bf2f(projb[(size_t)t * NB_LD + c]);
            v[j] = y * silu_f(z); ss += v[j] * v[j];
        }
        ss = wave_sum(ss);
        const float r = rsqrtf(ss * (1.0f / 384.0f) + LN_EPS);
#pragma unroll
        for (int j = 0; j < 6; ++j) { int c = g * 384 + j * 64 + lane; A1[(size_t)t * MIX_WIDTH + c] = (bf16)f2bf(v[j] * r * norm_g[c]); }
    }
}

__device__ __forceinline__ void ph_attn_naive(float* lds, const float* __restrict__ proj, const float* __restrict__ qrot, const float* __restrict__ krot,
                                              const float* __restrict__ ck, const float* __restrict__ cv, float* __restrict__ ybuf) {
    float (*sq)[64] = (float (*)[64])lds;
    const int w = threadIdx.x >> 6, lane = threadIdx.x & 63;
    for (int vb = blockIdx.x; vb < T_SAMPLE * 8 / NWAVE; vb += gridDim.x) {
        const int item = T_PROMPT * 8 + vb * NWAVE + w;
        const int t = item >> 3, h = item & 7;
        const bool is_p = t < T_PROMPT;
        int b, i;
        if (is_p) { b = t / SEQ; i = t % SEQ; } else { int ts = t - T_PROMPT; b = ts / DEC_SEQ; i = ts % DEC_SEQ; }
        __syncthreads();
        sq[w][lane] = qrot[(size_t)t * ATT_WIDTH + h * 64 + lane];
        __syncthreads();
        const int qi = is_p ? i : WBUF + i;
        float sc[3][3];
        float mx = -INFINITY;
#pragma unroll
        for (int pt = 0; pt < 3; ++pt) {
            const int d = pt == 0 ? 1 : (pt == 1 ? 4 : 16);
#pragma unroll
            for (int sl = 0; sl < 3; ++sl) {
                const int m = lane + sl * 64;
                float s = -INFINITY;
                const int kj = qi - d * m;
                if (m <= 128 && kj >= 0) {
                    const float* kr;
                    if (is_p) kr = krot + (size_t)(b * SEQ + kj) * ATT_WIDTH + h * 64;
                    else kr = (kj >= WBUF) ? krot + (size_t)(T_PROMPT + b * DEC_SEQ + (kj - WBUF)) * ATT_WIDTH + h * 64
                                           : ck + ((size_t)b * WBUF + kj) * ATT_WIDTH + h * 64;
                    float a = 0.f;
#pragma unroll
                    for (int c = 0; c < 64; c += 4) { float4 kv = *(const float4*)(kr + c); a += kv.x * sq[w][c] + kv.y * sq[w][c + 1] + kv.z * sq[w][c + 2] + kv.w * sq[w][c + 3]; }
                    s = a * 0.125f;
                }
                sc[pt][sl] = s; mx = fmaxf(mx, s);
            }
        }
        mx = wave_max(mx);
        float lsum = 0.f;
#pragma unroll
        for (int pt = 0; pt < 3; ++pt)
#pragma unroll
            for (int sl = 0; sl < 3; ++sl) { float pv = (sc[pt][sl] == -INFINITY) ? 0.f : __expf(sc[pt][sl] - mx); sc[pt][sl] = pv; lsum += pv; }
        lsum = wave_sum(lsum);
        float o = 0.f;
#pragma unroll
        for (int pt = 0; pt < 3; ++pt) {
            const int d = pt == 0 ? 1 : (pt == 1 ? 4 : 16);
#pragma unroll
            for (int sl = 0; sl < 3; ++sl) {
                const int mend = sl < 2 ? 64 : 1;
                for (int ml = 0; ml < mend; ++ml) {
                    const int m = ml + sl * 64;
                    const int kj = qi - d * m;
                    const float pv = __shfl(sc[pt][sl], ml);
                    if (kj < 0) continue;
                    const float* vr;
                    if (is_p) vr = proj + (size_t)(b * SEQ + kj) * PROJ_LD + O_V + h * 64;
                    else vr = (kj >= WBUF) ? proj + (size_t)(T_PROMPT + b * DEC_SEQ + (kj - WBUF)) * PROJ_LD + O_V + h * 64
                                           : cv + ((size_t)b * WBUF + kj) * ATT_WIDTH + h * 64;
                    o += pv * vr[lane];
                }
            }
        }
        ybuf[(size_t)t * MIX_WIDTH + SSD_WIDTH + h * 64 + lane] = o / lsum;
    }
}

__device__ __forceinline__ void ph_ln_res(const float* __restrict__ xp, const float* __restrict__ xs, const float* __restrict__ add, const float* __restrict__ gam,
                                          const float* __restrict__ bet, float* __restrict__ dst, bf16* __restrict__ dstb) {
    const int lane = threadIdx.x & 63;
    for (int t = blockIdx.x * NWAVE + (threadIdx.x >> 6); t < T_ALL; t += gridDim.x * NWAVE) {
        const float* res = (t < T_PROMPT) ? xp + (size_t)t * D_MODEL : xs + (size_t)(t - T_PROMPT) * D_MODEL;
        float v[16]; float s = 0.f;
#pragma unroll
        for (int j = 0; j < 4; ++j) { const int c = j * 256 + lane * 4; const float4 r4 = *(const float4*)(res + c), a4 = *(const float4*)(add + (size_t)t * D_MODEL + c);
            v[4 * j] = ALPHA_F * r4.x + a4.x; v[4 * j + 1] = ALPHA_F * r4.y + a4.y; v[4 * j + 2] = ALPHA_F * r4.z + a4.z; v[4 * j + 3] = ALPHA_F * r4.w + a4.w;
            s += (v[4 * j] + v[4 * j + 1]) + (v[4 * j + 2] + v[4 * j + 3]); }
        s = wave_sum(s);
        const float mu = s * (1.0f / 1024.0f);
        float q = 0.f;
#pragma unroll
        for (int j = 0; j < 16; ++j) { v[j] -= mu; q += v[j] * v[j]; }
        q = wave_sum(q);
        const float r = rsqrtf(q * (1.0f / 1024.0f) + LN_EPS);
#pragma unroll
        for (int j = 0; j < 4; ++j) { const int c = j * 256 + lane * 4; const float4 g4 = *(const float4*)(gam + c), b4 = *(const float4*)(bet + c);
            const float o0 = v[4 * j] * r * g4.x + b4.x, o1 = v[4 * j + 1] * r * g4.y + b4.y, o2 = v[4 * j + 2] * r * g4.z + b4.z, o3 = v[4 * j + 3] * r * g4.w + b4.w;
            *(float4*)(dst + (size_t)t * D_MODEL + c) = make_float4(o0, o1, o2, o3);
            *(uint2*)(dstb + (size_t)t * D_MODEL + c) = make_uint2(pk2(o0, o1), pk2(o2, o3)); }
    }
}

__device__ __forceinline__ void ph_peer_route(float* lds, const float* __restrict__ qh, const float* __restrict__ keys1, const float* __restrict__ keys2,
                                              int* __restrict__ eidx, float* __restrict__ gate) {
    float (*sq)[256] = (float (*)[256])lds;
    float (*sv)[2][16] = (float (*)[2][16])(lds + NWAVE * 256);
    int (*si)[2][16] = (int (*)[2][16])(lds + NWAVE * 256 + NWAVE * 32);
    const int w = threadIdx.x >> 6, lane = threadIdx.x & 63;
    for (int vb = blockIdx.x; vb < T_ALL * 8 / NWAVE; vb += gridDim.x) {
        const int item = vb * NWAVE + w;
        const int t = item >> 3, h = item & 7;
        __syncthreads();
        for (int c = lane; c < 256; c += 64) sq[w][c] = qh[(size_t)t * 2048 + h * 256 + c];
        __syncthreads();
#pragma unroll
        for (int half = 0; half < 2; ++half) {
            const float* keys = half ? keys2 : keys1;
            float s[2];
#pragma unroll
            for (int sl = 0; sl < 2; ++sl) {
                const float* kr = keys + (size_t)(lane + sl * 64) * 128;
                float a = 0.f;
#pragma unroll 8
                for (int c = 0; c < 128; c += 4) { float4 kv = *(const float4*)(kr + c); const float* qq = &sq[w][half * 128 + c]; a += kv.x * qq[0] + kv.y * qq[1] + kv.z * qq[2] + kv.w * qq[3]; }
                s[sl] = a;
            }
            for (int r = 0; r < 16; ++r) {
                float bv; int bi;
                if (s[0] >= s[1]) { bv = s[0]; bi = lane; } else { bv = s[1]; bi = lane + 64; }
#pragma unroll
                for (int o = 32; o > 0; o >>= 1) {
                    float ov = __shfl_xor(bv, o); int oi = __shfl_xor(bi, o);
                    if (ov > bv || (ov == bv && oi < bi)) { bv = ov; bi = oi; }
                }
                if (lane == 0) { sv[w][half][r] = bv; si[w][half][r] = bi; }
                if (bi == lane) s[0] = -INFINITY;
                if (bi == lane + 64) s[1] = -INFINITY;
            }
        }
        __syncthreads();
        float c[4];
#pragma unroll
        for (int j = 0; j < 4; ++j) { int ci = lane * 4 + j; c[j] = sv[w][0][ci >> 4] + sv[w][1][ci & 15]; }
        float myv = 0.f; int myc = 0;
        for (int r = 0; r < 16; ++r) {
            float bv = c[0]; int bi = lane * 4;
#pragma unroll
            for (int j = 1; j < 4; ++j) if (c[j] > bv) { bv = c[j]; bi = lane * 4 + j; }
#pragma unroll
            for (int o = 32; o > 0; o >>= 1) {
                float ov = __shfl_xor(bv, o); int oi = __shfl_xor(bi, o);
                if (ov > bv || (ov == bv && oi < bi)) { bv = ov; bi = oi; }
            }
            if (lane == r) { myv = bv; myc = bi; }
#pragma unroll
            for (int j = 0; j < 4; ++j) if (bi == lane * 4 + j) c[j] = -INFINITY;
        }
        float v = lane < 16 ? myv : -INFINITY;
        float mx = wave_max(v);
        float e = lane < 16 ? __expf(v - mx) : 0.f;
        float sum = wave_sum(e);
        if (lane < 16) {
            int ex = si[w][0][myc >> 4] * PEER_NKEYS + si[w][1][myc & 15];
            eidx[(size_t)t * 128 + h * 16 + lane] = ex;
            gate[(size_t)t * 128 + h * 16 + lane] = e / sum;
        }
    }
}

__device__ __forceinline__ void ph_peer_ffn(const float* __restrict__ hbuf, const int* __restrict__ eidx, const float* __restrict__ gate,
                                            const bf16* __restrict__ ub, const bf16* __restrict__ vb, const float* __restrict__ gam,
                                            const float* __restrict__ bet, float* __restrict__ out) {
    const int lane = threadIdx.x & 63;
    for (int t = blockIdx.x * NWAVE + (threadIdx.x >> 6); t < T_ALL; t += gridDim.x * NWAVE) {
        float x[16], acc[16];
        { const float* xr = hbuf + (size_t)t * D_MODEL + lane * 8;
          const float4 a = *(const float4*)xr, b = *(const float4*)(xr + 4), c = *(const float4*)(xr + 512), d = *(const float4*)(xr + 516);
          x[0] = a.x; x[1] = a.y; x[2] = a.z; x[3] = a.w; x[4] = b.x; x[5] = b.y; x[6] = b.z; x[7] = b.w;
          x[8] = c.x; x[9] = c.y; x[10] = c.z; x[11] = c.w; x[12] = d.x; x[13] = d.y; x[14] = d.z; x[15] = d.w; }
#pragma unroll
        for (int j = 0; j < 16; ++j) acc[j] = 0.f;
        for (int k = 0; k < 128; ++k) {
            const int e = eidx[(size_t)t * 128 + k];
            const float g = gate[(size_t)t * 128 + k];
            const bf16* ur = ub + (size_t)e * D_MODEL + lane * 8;
            float u0[8], u1[8];
            unpack8(*(const v4u*)ur, u0); unpack8(*(const v4u*)(ur + 512), u1);
            float d = 0.f;
#pragma unroll
            for (int j = 0; j < 8; ++j) d += u0[j] * x[j] + u1[j] * x[8 + j];
            d = wave_sum(d);
            const float wgt = g * gelu_f(d);
            const bf16* vr = vb + (size_t)e * D_MODEL + lane * 8;
            unpack8(*(const v4u*)vr, u0); unpack8(*(const v4u*)(vr + 512), u1);
#pragma unroll
            for (int j = 0; j < 8; ++j) { acc[j] += wgt * u0[j]; acc[8 + j] += wgt * u1[j]; }
        }
        float s = 0.f;
#pragma unroll
        for (int j = 0; j < 16; ++j) { acc[j] += ALPHA_F * x[j]; s += acc[j]; }
        s = wave_sum(s);
        const float mu = s * (1.0f / 1024.0f);
        float q = 0.f;
#pragma unroll
        for (int j = 0; j < 16; ++j) { acc[j] -= mu; q += acc[j] * acc[j]; }
        q = wave_sum(q);
        const float r = rsqrtf(q * (1.0f / 1024.0f) + LN_EPS);
        float* dst = ((t < T_PROMPT) ? out + OUT_YP + (size_t)t * D_MODEL : out + OUT_YS + (size_t)(t - T_PROMPT) * D_MODEL) + lane * 8;
#pragma unroll
        for (int q4 = 0; q4 < 4; ++q4) {
            const int eo = (q4 >> 1) * 512 + (q4 & 1) * 4;
            const float4 g4 = *(const float4*)(gam + lane * 8 + eo), b4 = *(const float4*)(bet + lane * 8 + eo);
            float4 o; o.x = acc[q4 * 4 + 0] * r * g4.x + b4.x; o.y = acc[q4 * 4 + 1] * r * g4.y + b4.y; o.z = acc[q4 * 4 + 2] * r * g4.z + b4.z; o.w = acc[q4 * 4 + 3] * r * g4.w + b4.w;
            *(float4*)(dst + eo) = o;
        }
    }
}

__device__ __forceinline__ float peer_dot16(const v4u a, const v4u b, const float (&x)[16]) {
    float u0[8], u1[8]; unpack8(a, u0); unpack8(b, u1);
    float d = 0.f;
#pragma unroll
    for (int j = 0; j < 8; ++j) d += u0[j] * x[j] + u1[j] * x[8 + j];
    return d;
}
#define PEER_TR_STEP(N, M) _Pragma("unroll") for (int i = 0; i < N; ++i) { const bool up = (lane & M) != 0; const float keep = up ? part[i + N] : part[i]; const float send = up ? part[i] : part[i + N]; part[i] = keep + __shfl_xor(send, M); }
__device__ __forceinline__ void ph_peer_ffn2(const float* __restrict__ hbuf, const int* __restrict__ eidx, const float* __restrict__ gate,
                                             const bf16* __restrict__ ub, const bf16* __restrict__ vb, const float* __restrict__ gam,
                                             const float* __restrict__ bet, float* __restrict__ out) {
    const int lane0 = threadIdx.x & 63;
    for (int t = blockIdx.x * NWAVE + (threadIdx.x >> 6); t < T_ALL; t += gridDim.x * NWAVE) {
        int lane = lane0; asm volatile("" : "+v"(lane));
        float x[16];
        { const float* xr = hbuf + (size_t)t * D_MODEL + lane * 8;
          const float4 a = *(const float4*)xr, b = *(const float4*)(xr + 4), c = *(const float4*)(xr + 512), d = *(const float4*)(xr + 516);
          x[0] = a.x; x[1] = a.y; x[2] = a.z; x[3] = a.w; x[4] = b.x; x[5] = b.y; x[6] = b.z; x[7] = b.w;
          x[8] = c.x; x[9] = c.y; x[10] = c.z; x[11] = c.w; x[12] = d.x; x[13] = d.y; x[14] = d.z; x[15] = d.w; }
        int ev[2]; float wv[4];
        ev[0] = eidx[(size_t)t * 128 + lane]; ev[1] = eidx[(size_t)t * 128 + 64 + lane];
#pragma unroll
        for (int rd = 0; rd < 4; ++rd) wv[rd] = gate[(size_t)t * 128 + rd * 32 + (lane >> 1)];
#pragma unroll
        for (int rd = 0; rd < 4; ++rd) {
            float part[32];
#pragma unroll
            for (int kb = 0; kb < 8; ++kb) {
                v4u ra[4], rb[4];
#pragma unroll
                for (int k8 = 0; k8 < 4; ++k8) {
                    const int e = __builtin_amdgcn_readlane(ev[rd >> 1], (rd & 1) * 32 + kb * 4 + k8);
                    const bf16* ur = ub + (size_t)e * D_MODEL + lane * 8;
                    ra[k8] = *(const v4u*)ur; rb[k8] = *(const v4u*)(ur + 512);
                }
#pragma unroll
                for (int k8 = 0; k8 < 4; ++k8) part[kb * 4 + k8] = peer_dot16(ra[k8], rb[k8], x);
            }
            PEER_TR_STEP(16, 32) PEER_TR_STEP(8, 16) PEER_TR_STEP(4, 8) PEER_TR_STEP(2, 4) PEER_TR_STEP(1, 2)
            const float hid = part[0] + __shfl_xor(part[0], 1);
            wv[rd] *= gelu_f(hid);
        }
        float acc[16];
#pragma unroll
        for (int j = 0; j < 16; ++j) acc[j] = 0.f;
#pragma unroll
        for (int rd = 0; rd < 4; ++rd) {
#pragma unroll
            for (int kb = 0; kb < 4; ++kb) {
                v4u ra[8], rb[8];
#pragma unroll
                for (int k8 = 0; k8 < 8; ++k8) {
                    const int e = __builtin_amdgcn_readlane(ev[rd >> 1], (rd & 1) * 32 + kb * 8 + k8);
                    const bf16* vr = vb + (size_t)e * D_MODEL + lane * 8;
                    ra[k8] = *(const v4u*)vr; rb[k8] = *(const v4u*)(vr + 512);
                }
#pragma unroll
                for (int k8 = 0; k8 < 8; ++k8) {
                    const float wk = __builtin_bit_cast(float, __builtin_amdgcn_readlane(__builtin_bit_cast(int, wv[rd]), 2 * (kb * 8 + k8)));
                    float u0[8], u1[8]; unpack8(ra[k8], u0); unpack8(rb[k8], u1);
#pragma unroll
                    for (int j = 0; j < 8; ++j) { acc[j] += wk * u0[j]; acc[8 + j] += wk * u1[j]; }
                }
            }
        }
        float s = 0.f;
#pragma unroll
        for (int j = 0; j < 16; ++j) { acc[j] += ALPHA_F * x[j]; s += acc[j]; }
        s = wave_sum(s);
        const float mu = s * (1.0f / 1024.0f);
        float q = 0.f;
#pragma unroll
        for (int j = 0; j < 16; ++j) { acc[j] -= mu; q += acc[j] * acc[j]; }
        q = wave_sum(q);
        const float r = rsqrtf(q * (1.0f / 1024.0f) + LN_EPS);
        float* dst = ((t < T_PROMPT) ? out + OUT_YP + (size_t)t * D_MODEL : out + OUT_YS + (size_t)(t - T_PROMPT) * D_MODEL) + lane * 8;
#pragma unroll
        for (int q4 = 0; q4 < 4; ++q4) {
            const int eo = (q4 >> 1) * 512 + (q4 & 1) * 4;
            const float4 g4 = *(const float4*)(gam + lane * 8 + eo), b4 = *(const float4*)(bet + lane * 8 + eo);
            float4 o; o.x = acc[q4 * 4 + 0] * r * g4.x + b4.x; o.y = acc[q4 * 4 + 1] * r * g4.y + b4.y; o.z = acc[q4 * 4 + 2] * r * g4.z + b4.z; o.w = acc[q4 * 4 + 3] * r * g4.w + b4.w;
            *(float4*)(dst + eo) = o;
        }
    }
}

__device__ __forceinline__ void ph_attn_sample(float* lds, const bf16* __restrict__ qrot_b, const bf16* __restrict__ krot_b, const bf16* __restrict__ projb,
                                               const float* __restrict__ ck, const float* __restrict__ cv, bf16* __restrict__ A1) {
    float (*sq)[64] = (float (*)[64])lds;
    const int w = threadIdx.x >> 6, lane0 = threadIdx.x & 63;
    for (int vb = blockIdx.x; vb < T_SAMPLE * 8 / NWAVE; vb += gridDim.x) {
        int lane = lane0; asm volatile("" : "+v"(lane));
        const int item = vb * NWAVE + w, ts = item >> 3, hd = item & 7, b = ts >> 2, i = ts & 3, t = T_PROMPT + ts;
        __syncthreads();
        sq[w][lane] = bf2f(qrot_b[(size_t)t * ATT_WIDTH + hd * 64 + lane]);
        __syncthreads();
        const int qi = WBUF + i;
        float sc[8];
        float mx = -INFINITY;
#pragma unroll
        for (int slot = 0; slot < 7; ++slot) {
            const int pt = slot < 6 ? (slot >> 1) : (lane < 3 ? lane : 0);
            const int m = slot < 6 ? lane + 64 * (slot & 1) : 128;
            const int kj = qi - (m << (2 * pt));
            const bool valid = (slot < 6 || lane < 3) && kj < WBUF;
            const int kc = kj < WBUF ? kj : WBUF - 1;
            const float* kr = ck + ((size_t)b * WBUF + kc) * ATT_WIDTH + hd * 64;
            float a = 0.f;
#pragma unroll
            for (int c = 0; c < 64; c += 4) { const float4 kv = *(const float4*)(kr + c); a += kv.x * sq[w][c] + kv.y * sq[w][c + 1] + kv.z * sq[w][c + 2] + kv.w * sq[w][c + 3]; }
            const float s = valid ? a * 0.125f : -INFINITY;
            sc[slot] = s; mx = fmaxf(mx, s);
        }
        const int nt7 = lane <= i ? i - lane : i;
        const bool valid7 = lane < i + 3;
        {
            const bf16* kr = krot_b + (size_t)(T_PROMPT + b * DEC_SEQ + nt7) * ATT_WIDTH + hd * 64;
            float a = 0.f;
#pragma unroll
            for (int c = 0; c < 64; c += 8) { float f[8]; unpack8(*(const v4u*)(kr + c), f);
#pragma unroll
                for (int j = 0; j < 8; ++j) a += f[j] * sq[w][c + j]; }
            const float s = valid7 ? a * 0.125f : -INFINITY;
            sc[7] = s; mx = fmaxf(mx, s);
        }
        mx = wave_max(mx);
        float lsum = 0.f;
#pragma unroll
        for (int slot = 0; slot < 8; ++slot) { const float pv = __expf(sc[slot] - mx); sc[slot] = pv; lsum += pv; }
        lsum = wave_sum(lsum);
        float part[64];
#pragma unroll
        for (int c = 0; c < 64; ++c) part[c] = 0.f;
#pragma unroll
        for (int slot = 0; slot < 7; ++slot) {
            const int pt = slot < 6 ? (slot >> 1) : (lane < 3 ? lane : 0);
            const int m = slot < 6 ? lane + 64 * (slot & 1) : 128;
            const int kj = qi - (m << (2 * pt));
            const int kc = kj < WBUF ? kj : WBUF - 1;
            const float pv = sc[slot];
            const float* vr = cv + ((size_t)b * WBUF + kc) * ATT_WIDTH + hd * 64;
#pragma unroll
            for (int c = 0; c < 64; c += 4) { const float4 vv = *(const float4*)(vr + c); part[c] += pv * vv.x; part[c + 1] += pv * vv.y; part[c + 2] += pv * vv.z; part[c + 3] += pv * vv.w; }
        }
        {
            const float pv = sc[7];
            const bf16* vr = projb + (size_t)(T_PROMPT + b * DEC_SEQ + nt7) * NB_LD + NB_V + hd * 64;
#pragma unroll
            for (int c = 0; c < 64; c += 8) { float f[8]; unpack8(*(const v4u*)(vr + c), f);
#pragma unroll
                for (int j = 0; j < 8; ++j) part[c + j] += pv * f[j]; }
        }
        PEER_TR_STEP(32, 32) PEER_TR_STEP(16, 16) PEER_TR_STEP(8, 8) PEER_TR_STEP(4, 4) PEER_TR_STEP(2, 2) PEER_TR_STEP(1, 1)
        A1[(size_t)t * MIX_WIDTH + SSD_WIDTH + hd * 64 + lane] = (bf16)f2bf(part[0] / lsum);
    }
}

typedef float f32x2v __attribute__((ext_vector_type(2)));
__device__ __forceinline__ void ph_quant_tables(const float* __restrict__ pu, const float* __restrict__ pv, unsigned char* __restrict__ ub8, unsigned char* __restrict__ vb8,
                                                float* __restrict__ usc, float* __restrict__ vsc) {
    const int lane = threadIdx.x & 63;
    for (int row = blockIdx.x * NWAVE + (threadIdx.x >> 6); row < 2 * 16384; row += gridDim.x * NWAVE) {
        const int rr = row & 16383; const bool isv = row >= 16384;
        const float* src = (isv ? pv : pu) + (size_t)rr * D_MODEL + lane * 8;
        const float4 a = *(const float4*)src, b = *(const float4*)(src + 4), c = *(const float4*)(src + 512), d = *(const float4*)(src + 516);
        float am = fmaxf(fmaxf(fmaxf(fabsf(a.x), fabsf(a.y)), fmaxf(fabsf(a.z), fabsf(a.w))), fmaxf(fmaxf(fabsf(b.x), fabsf(b.y)), fmaxf(fabsf(b.z), fabsf(b.w))));
        am = fmaxf(am, fmaxf(fmaxf(fmaxf(fabsf(c.x), fabsf(c.y)), fmaxf(fabsf(c.z), fabsf(c.w))), fmaxf(fmaxf(fabsf(d.x), fabsf(d.y)), fmaxf(fabsf(d.z), fabsf(d.w)))));
        am = wave_max(am);
        const float sc = am > 0.f ? 224.0f / am : 1.0f;
        v4u o;
        o.x = (unsigned)__builtin_amdgcn_cvt_pk_fp8_f32(a.z * sc, a.w * sc, __builtin_amdgcn_cvt_pk_fp8_f32(a.x * sc, a.y * sc, 0, false), true);
        o.y = (unsigned)__builtin_amdgcn_cvt_pk_fp8_f32(b.z * sc, b.w * sc, __builtin_amdgcn_cvt_pk_fp8_f32(b.x * sc, b.y * sc, 0, false), true);
        o.z = (unsigned)__builtin_amdgcn_cvt_pk_fp8_f32(c.z * sc, c.w * sc, __builtin_amdgcn_cvt_pk_fp8_f32(c.x * sc, c.y * sc, 0, false), true);
        o.w = (unsigned)__builtin_amdgcn_cvt_pk_fp8_f32(d.z * sc, d.w * sc, __builtin_amdgcn_cvt_pk_fp8_f32(d.x * sc, d.y * sc, 0, false), true);
        *(v4u*)((isv ? vb8 : ub8) + (size_t)rr * 1024 + lane * 16) = o;
        if (lane == 0) (isv ? vsc : usc)[rr] = am > 0.f ? am * (1.0f / 224.0f) : 1.0f;
    }
}
__device__ __forceinline__ void unpack16_fp8(const v4u w, float (&f)[16]) {
#pragma unroll
    for (int i = 0; i < 4; ++i) {
        const f32x2v lo = __builtin_amdgcn_cvt_pk_f32_fp8((int)w[i], false), hi = __builtin_amdgcn_cvt_pk_f32_fp8((int)w[i], true);
        f[4 * i] = lo[0]; f[4 * i + 1] = lo[1]; f[4 * i + 2] = hi[0]; f[4 * i + 3] = hi[1];
    }
}
__device__ __forceinline__ void ph_peer_ffn3(const float* __restrict__ hbuf, const int* __restrict__ eidx, const float* __restrict__ gate,
                                             const unsigned char* __restrict__ ub8, const unsigned char* __restrict__ vb8, const float* __restrict__ usc, const float* __restrict__ vsc,
                                             const float* __restrict__ gam, const float* __restrict__ bet, float* __restrict__ out) {
    const int lane0 = threadIdx.x & 63;
    for (int t = blockIdx.x * NWAVE + (threadIdx.x >> 6); t < T_ALL; t += gridDim.x * NWAVE) {
        int lane = lane0; asm volatile("" : "+v"(lane));
        const unsigned lo16 = (unsigned)lane * 16u, lo8 = (unsigned)lane * 8u;
        float x[16];
        { const float* xr = hbuf + (size_t)t * D_MODEL + lo8;
          const float4 a = *(const float4*)xr, b = *(const float4*)(xr + 4), c = *(const float4*)(xr + 512), d = *(const float4*)(xr + 516);
          x[0] = a.x; x[1] = a.y; x[2] = a.z; x[3] = a.w; x[4] = b.x; x[5] = b.y; x[6] = b.z; x[7] = b.w;
          x[8] = c.x; x[9] = c.y; x[10] = c.z; x[11] = c.w; x[12] = d.x; x[13] = d.y; x[14] = d.z; x[15] = d.w; }
        int ev[2]; float wv[4], su[4];
        ev[0] = eidx[(size_t)t * 128 + lane]; ev[1] = eidx[(size_t)t * 128 + 64 + lane];
#pragma unroll
        for (int rd = 0; rd < 4; ++rd) {
            const int er = eidx[(size_t)t * 128 + rd * 32 + (lane >> 1)];
            wv[rd] = gate[(size_t)t * 128 + rd * 32 + (lane >> 1)] * vsc[er];
            su[rd] = usc[er];
        }
#pragma unroll
        for (int rd = 0; rd < 4; ++rd) {
            float part[32];
#pragma unroll
            for (int kb = 0; kb < 8; ++kb) {
                v4u ra[4];
#pragma unroll
                for (int k8 = 0; k8 < 4; ++k8) {
                    const int e = __builtin_amdgcn_readlane(ev[rd >> 1], (rd & 1) * 32 + kb * 4 + k8);
                    ra[k8] = *(const v4u*)(ub8 + (size_t)e * 1024 + lo16);
                }
#pragma unroll
                for (int k8 = 0; k8 < 4; ++k8) {
                    float f[16]; unpack16_fp8(ra[k8], f);
                    float d = 0.f;
#pragma unroll
                    for (int j = 0; j < 16; ++j) d += f[j] * x[j];
                    part[kb * 4 + k8] = d;
                }
            }
            PEER_TR_STEP(16, 32) PEER_TR_STEP(8, 16) PEER_TR_STEP(4, 8) PEER_TR_STEP(2, 4) PEER_TR_STEP(1, 2)
            const float hid = (part[0] + __shfl_xor(part[0], 1)) * su[rd];
            wv[rd] *= gelu_f(hid);
        }
        float acc[16];
#pragma unroll
        for (int j = 0; j < 16; ++j) acc[j] = 0.f;
#pragma unroll
        for (int rd = 0; rd < 4; ++rd) {
#pragma unroll
            for (int kb = 0; kb < 4; ++kb) {
                v4u ra[8];
#pragma unroll
                for (int k8 = 0; k8 < 8; ++k8) {
                    const int e = __builtin_amdgcn_readlane(ev[rd >> 1], (rd & 1) * 32 + kb * 8 + k8);
                    ra[k8] = *(const v4u*)(vb8 + (size_t)e * 1024 + lo16);
                }
#pragma unroll
                for (int k8 = 0; k8 < 8; ++k8) {
                    const float wk = __builtin_bit_cast(float, __builtin_amdgcn_readlane(__builtin_bit_cast(int, wv[rd]), 2 * (kb * 8 + k8)));
                    float f[16]; unpack16_fp8(ra[k8], f);
#pragma unroll
                    for (int j = 0; j < 16; ++j) acc[j] += wk * f[j];
                }
            }
        }
        float s = 0.f;
#pragma unroll
        for (int j = 0; j < 16; ++j) { acc[j] += ALPHA_F * x[j]; s += acc[j]; }
        s = wave_sum(s);
        const float mu = s * (1.0f / 1024.0f);
        float q = 0.f;
#pragma unroll
        for (int j = 0; j < 16; ++j) { acc[j] -= mu; q += acc[j] * acc[j]; }
        q = wave_sum(q);
        const float r = rsqrtf(q * (1.0f / 1024.0f) + LN_EPS);
        float* dst = ((t < T_PROMPT) ? out + OUT_YP + (size_t)t * D_MODEL : out + OUT_YS + (size_t)(t - T_PROMPT) * D_MODEL) + lo8;
#pragma unroll
        for (int q4 = 0; q4 < 4; ++q4) {
            const int eo = (q4 >> 1) * 512 + (q4 & 1) * 4;
            const float4 g4 = *(const float4*)(gam + lo8 + eo), b4 = *(const float4*)(bet + lo8 + eo);
            float4 o; o.x = acc[q4 * 4 + 0] * r * g4.x + b4.x; o.y = acc[q4 * 4 + 1] * r * g4.y + b4.y; o.z = acc[q4 * 4 + 2] * r * g4.z + b4.z; o.w = acc[q4 * 4 + 3] * r * g4.w + b4.w;
            *(float4*)(dst + eo) = o;
        }
    }
}

typedef float f32x16 __attribute__((ext_vector_type(16)));
typedef short s16x8 __attribute__((ext_vector_type(8)));
typedef short s16x4 __attribute__((ext_vector_type(4)));
typedef float f32x4v __attribute__((ext_vector_type(4)));
#define SSD_L_ACS 0
#define SSD_L_DTS 3072
#define SSD_L_BM 6144
#define SSD_RS_B 272
#define SSD_L_X (6144 + 128 * 272)
#define SSD_RS_X 144
#define SSD_XIMG (128 * 144)
#define SSD_RS_Y 784
template <int OFF0, int OFF1>
__device__ __forceinline__ s16x8 tr_frag(unsigned base) {
    s16x4 a, b;
    asm volatile("ds_read_b64_tr_b16 %0, %2 offset:%3\n\tds_read_b64_tr_b16 %1, %2 offset:%4\n\ts_waitcnt lgkmcnt(0)"
                 : "=&v"(a), "=&v"(b) : "v"(base), "n"(OFF0), "n"(OFF1) : "memory");
    return __builtin_shufflevector(a, b, 0, 1, 2, 3, 4, 5, 6, 7);
}
__device__ __forceinline__ unsigned lds_addr(LAS unsigned char* p) { return (unsigned)(size_t)p; }

__device__ __forceinline__ void ssd_chunk_acs(LAS unsigned char* ldsb, const float* __restrict__ dtv, const float* __restrict__ a_log, int t0, int g, float* cdec_out) {
    const int w = __builtin_amdgcn_readfirstlane(threadIdx.x >> 6), lane = threadIdx.x & 63;
    if (w < 6) {
        const int head = 6 * g + w;
        const float A = -__expf(a_log[head]);
        const float v0 = dtv[(size_t)(t0 + 2 * lane) * SSD_HEADS + head], v1 = dtv[(size_t)(t0 + 2 * lane + 1) * SSD_HEADS + head];
        const float a1 = v1 * A;
        float s = v0 * A + a1;
#pragma unroll
        for (int o = 1; o < 64; o <<= 1) { const float tmp = __shfl_up(s, o); if (lane >= o) s += tmp; }
        LAS float* acs = (LAS float*)(ldsb + SSD_L_ACS) + w * 128;
        LAS float* dts = (LAS float*)(ldsb + SSD_L_DTS) + w * 128;
        acs[2 * lane] = s - a1; acs[2 * lane + 1] = s;
        dts[2 * lane] = v0; dts[2 * lane + 1] = v1;
        if (cdec_out && lane == 63) cdec_out[head] = __expf(s);
    }
}

__device__ __forceinline__ void ph_ssd_states(LAS unsigned char* ldsb, const bf16* __restrict__ xbc_b, const float* __restrict__ dtv, const float* __restrict__ a_log,
                                              bf16* __restrict__ Sbuf, float* __restrict__ cdec) {
    const int tid = threadIdx.x, w = __builtin_amdgcn_readfirstlane(tid >> 6), lane = tid & 63;
    const int r = lane & 31, h = lane >> 5, blk = (lane >> 4) & 1, q = (lane & 15) >> 2, pp = lane & 3;
    const int nt = w & 3, pt = w >> 2;
    for (int unit = blockIdx.x; unit < BATCH * 64 * SSD_GROUPS; unit += gridDim.x) {
        const int g = unit & 3, bc = unit >> 2;
        const int t0 = bc * 128;
        __syncthreads();
        ssd_chunk_acs(ldsb, dtv, a_log, t0, g, cdec + (size_t)bc * SSD_HEADS);
        for (int idx = tid; idx < 2048; idx += NTHR) { const int row = idx >> 4, ch = idx & 15;
            const v4u v = *(const v4u*)(xbc_b + (size_t)(t0 + row) * CONV_DIM + 1536 + 128 * g + ch * 8);
            *(LAS v4u*)(ldsb + SSD_L_BM + row * SSD_RS_B + ch * 16) = v; }
        __syncthreads();
        for (int idx = tid; idx < 6144; idx += NTHR) { const int hh = idx >> 10, rem = idx & 1023, row = rem >> 3, ch = rem & 7;
            const LAS float* acs = (const LAS float*)(ldsb + SSD_L_ACS) + hh * 128; const LAS float* dts = (const LAS float*)(ldsb + SSD_L_DTS) + hh * 128;
            const float wgt = dts[row] * __expf(acs[127] - acs[row]);
            float f[8]; unpack8(*(const v4u*)(xbc_b + (size_t)(t0 + row) * CONV_DIM + (6 * g + hh) * 64 + ch * 8), f);
            v4u o; o.x = pk2(f[0] * wgt, f[1] * wgt); o.y = pk2(f[2] * wgt, f[3] * wgt); o.z = pk2(f[4] * wgt, f[5] * wgt); o.w = pk2(f[6] * wgt, f[7] * wgt);
            *(LAS v4u*)(ldsb + SSD_L_X + hh * SSD_XIMG + row * SSD_RS_X + ch * 16) = o; }
        __syncthreads();
        const unsigned abase = lds_addr(ldsb + SSD_L_BM) + (8 * h + q) * SSD_RS_B + (32 * nt + 16 * blk + 4 * pp) * 2;
        s16x8 afr[8];
        afr[0] = tr_frag<0 * 16 * SSD_RS_B, (0 * 16 + 4) * SSD_RS_B>(abase); afr[1] = tr_frag<1 * 16 * SSD_RS_B, (1 * 16 + 4) * SSD_RS_B>(abase);
        afr[2] = tr_frag<2 * 16 * SSD_RS_B, (2 * 16 + 4) * SSD_RS_B>(abase); afr[3] = tr_frag<3 * 16 * SSD_RS_B, (3 * 16 + 4) * SSD_RS_B>(abase);
        afr[4] = tr_frag<4 * 16 * SSD_RS_B, (4 * 16 + 4) * SSD_RS_B>(abase); afr[5] = tr_frag<5 * 16 * SSD_RS_B, (5 * 16 + 4) * SSD_RS_B>(abase);
        afr[6] = tr_frag<6 * 16 * SSD_RS_B, (6 * 16 + 4) * SSD_RS_B>(abase); afr[7] = tr_frag<7 * 16 * SSD_RS_B, (7 * 16 + 4) * SSD_RS_B>(abase);
#pragma unroll
        for (int hh = 0; hh < 6; ++hh) {
            const unsigned xb = lds_addr(ldsb + SSD_L_X + hh * SSD_XIMG) + (8 * h + q) * SSD_RS_X + (32 * pt + 16 * blk + 4 * pp) * 2;
            f32x16 acc;
#pragma unroll
            for (int i = 0; i < 16; ++i) acc[i] = 0.f;
            acc = __builtin_amdgcn_mfma_f32_32x32x16_bf16(afr[0], tr_frag<0 * 16 * SSD_RS_X, (0 * 16 + 4) * SSD_RS_X>(xb), acc, 0, 0, 0);
            acc = __builtin_amdgcn_mfma_f32_32x32x16_bf16(afr[1], tr_frag<1 * 16 * SSD_RS_X, (1 * 16 + 4) * SSD_RS_X>(xb), acc, 0, 0, 0);
            acc = __builtin_amdgcn_mfma_f32_32x32x16_bf16(afr[2], tr_frag<2 * 16 * SSD_RS_X, (2 * 16 + 4) * SSD_RS_X>(xb), acc, 0, 0, 0);
            acc = __builtin_amdgcn_mfma_f32_32x32x16_bf16(afr[3], tr_frag<3 * 16 * SSD_RS_X, (3 * 16 + 4) * SSD_RS_X>(xb), acc, 0, 0, 0);
            acc = __builtin_amdgcn_mfma_f32_32x32x16_bf16(afr[4], tr_frag<4 * 16 * SSD_RS_X, (4 * 16 + 4) * SSD_RS_X>(xb), acc, 0, 0, 0);
            acc = __builtin_amdgcn_mfma_f32_32x32x16_bf16(afr[5], tr_frag<5 * 16 * SSD_RS_X, (5 * 16 + 4) * SSD_RS_X>(xb), acc, 0, 0, 0);
            acc = __builtin_amdgcn_mfma_f32_32x32x16_bf16(afr[6], tr_frag<6 * 16 * SSD_RS_X, (6 * 16 + 4) * SSD_RS_X>(xb), acc, 0, 0, 0);
            acc = __builtin_amdgcn_mfma_f32_32x32x16_bf16(afr[7], tr_frag<7 * 16 * SSD_RS_X, (7 * 16 + 4) * SSD_RS_X>(xb), acc, 0, 0, 0);
            bf16* dst = Sbuf + (((size_t)bc * SSD_HEADS + 6 * g + hh) * 64 + 32 * pt + r) * 128 + 32 * nt + 4 * h;
#pragma unroll
            for (int q4 = 0; q4 < 4; ++q4) *(uint2*)(dst + 8 * q4) = make_uint2(pk2(acc[4 * q4], acc[4 * q4 + 1]), pk2(acc[4 * q4 + 2], acc[4 * q4 + 3]));
        }
    }
}

__device__ __forceinline__ void ph_ssd_scan(const bf16* __restrict__ Sbuf, const float* __restrict__ cdec, bf16* __restrict__ Hin, float* __restrict__ out) {
    for (int idx = blockIdx.x * NTHR + threadIdx.x; idx < BATCH * SSD_HEADS * 64 * 16; idx += gridDim.x * NTHR) {
        const int n8 = idx & 15, p = (idx >> 4) & 63, hb = idx >> 10, hd = hb % SSD_HEADS, b = hb / SSD_HEADS;
        float st[8];
#pragma unroll
        for (int j = 0; j < 8; ++j) st[j] = 0.f;
#pragma unroll 8
        for (int c = 0; c < 64; ++c) {
            const size_t base = ((((size_t)(b * 64 + c)) * SSD_HEADS + hd) * 64 + p) * 128 + n8 * 8;
            v4u o; o.x = pk2(st[0], st[1]); o.y = pk2(st[2], st[3]); o.z = pk2(st[4], st[5]); o.w = pk2(st[6], st[7]);
            *(v4u*)(Hin + base) = o;
            float s[8]; unpack8(*(const v4u*)(Sbuf + base), s);
            const float a = cdec[(size_t)(b * 64 + c) * SSD_HEADS + hd];
#pragma unroll
            for (int j = 0; j < 8; ++j) st[j] = a * st[j] + s[j];
        }
        store8f(out + OUT_PS + (((size_t)b * SSD_HEADS + hd) * 64 + p) * 128 + n8 * 8, st);
    }
}

__device__ __forceinline__ void ph_ssd_out(LAS unsigned char* ldsb, const bf16* __restrict__ xbc_b, const bf16* __restrict__ projb, const float* __restrict__ dtv,
                                           const float* __restrict__ a_log, const float* __restrict__ d_skip, const float* __restrict__ norm_g,
                                           const bf16* __restrict__ Hin, bf16* __restrict__ A1) {
    const int tid = threadIdx.x, w = __builtin_amdgcn_readfirstlane(tid >> 6), lane = tid & 63;
    const int r = lane & 31, h = lane >> 5, blk = (lane >> 4) & 1, q = (lane & 15) >> 2, pp = lane & 3;
    const int lt = w & 3, hs = w >> 2;
    for (int unit = blockIdx.x; unit < BATCH * 64 * SSD_GROUPS; unit += gridDim.x) {
        const int g = unit & 3, bc = unit >> 2;
        const int t0 = bc * 128;
        __syncthreads();
        ssd_chunk_acs(ldsb, dtv, a_log, t0, g, nullptr);
        for (int idx = tid; idx < 2048; idx += NTHR) { const int row = idx >> 4, ch = idx & 15;
            const v4u v = *(const v4u*)(xbc_b + (size_t)(t0 + row) * CONV_DIM + 1536 + 128 * g + ch * 8);
            *(LAS v4u*)(ldsb + SSD_L_BM + row * SSD_RS_B + ch * 16) = v; }
        for (int idx = tid; idx < 6144; idx += NTHR) { const int hh = idx >> 10, rem = idx & 1023, row = rem >> 3, ch = rem & 7;
            const v4u v = *(const v4u*)(xbc_b + (size_t)(t0 + row) * CONV_DIM + (6 * g + hh) * 64 + ch * 8);
            *(LAS v4u*)(ldsb + SSD_L_X + hh * SSD_XIMG + row * SSD_RS_X + ch * 16) = v; }
        __syncthreads();
        const bf16* cp = xbc_b + (size_t)(t0 + 32 * lt + r) * CONV_DIM + 2048 + 128 * g + 8 * h;
        const int lcol = 32 * lt + r;
        const LAS float* acsb = (const LAS float*)(ldsb + SSD_L_ACS) + 3 * hs * 128; const LAS float* dtsb = (const LAS float*)(ldsb + SSD_L_DTS) + 3 * hs * 128;
        f32x16 y[3][2];
#pragma unroll
        for (int h3 = 0; h3 < 3; ++h3)
#pragma unroll
            for (int i = 0; i < 16; ++i) { y[h3][0][i] = 0.f; y[h3][1][i] = 0.f; }
#pragma unroll 1
        for (int ks = 0; ks < 8; ++ks) {
            const s16x8 cf = *(const s16x8*)(cp + 16 * ks);
#pragma unroll
            for (int h3 = 0; h3 < 3; ++h3) {
                const bf16* hp = Hin + (((size_t)bc * SSD_HEADS + 6 * g + 3 * hs + h3) * 64 + r) * 128 + 8 * h + 16 * ks;
                const s16x8 h0 = *(const s16x8*)hp, h1 = *(const s16x8*)(hp + 32 * 128);
                y[h3][0] = __builtin_amdgcn_mfma_f32_32x32x16_bf16(cf, h0, y[h3][0], 0, 0, 0);
                y[h3][1] = __builtin_amdgcn_mfma_f32_32x32x16_bf16(cf, h1, y[h3][1], 0, 0, 0);
            }
        }
#pragma unroll
        for (int h3 = 0; h3 < 3; ++h3)
#pragma unroll
            for (int q4 = 0; q4 < 4; ++q4) {
                const f32x4v a4 = *(const LAS f32x4v*)(acsb + h3 * 128 + 32 * lt + 8 * q4 + 4 * h);
                const float e0 = __expf(a4[0]), e1 = __expf(a4[1]), e2 = __expf(a4[2]), e3 = __expf(a4[3]);
                y[h3][0][4 * q4] *= e0; y[h3][0][4 * q4 + 1] *= e1; y[h3][0][4 * q4 + 2] *= e2; y[h3][0][4 * q4 + 3] *= e3;
                y[h3][1][4 * q4] *= e0; y[h3][1][4 * q4 + 1] *= e1; y[h3][1][4 * q4 + 2] *= e2; y[h3][1][4 * q4 + 3] *= e3;
            }
        const unsigned xb0 = lds_addr(ldsb + SSD_L_X + 3 * hs * SSD_XIMG) + (4 * h + q) * SSD_RS_X + (16 * blk + 4 * pp) * 2;
        for (int st = 0; st <= lt; ++st) {
            f32x16 cb;
#pragma unroll
            for (int i = 0; i < 16; ++i) cb[i] = 0.f;
#pragma unroll 2
            for (int ks = 0; ks < 8; ++ks) {
                const s16x8 cf = *(const s16x8*)(cp + 16 * ks);
                const s16x8 bfrag = *(const LAS s16x8*)(ldsb + SSD_L_BM + (32 * st + r) * SSD_RS_B + (16 * ks + 8 * h) * 2);
                cb = __builtin_amdgcn_mfma_f32_32x32x16_bf16(bfrag, cf, cb, 0, 0, 0);
            }
#pragma unroll
            for (int h3 = 0; h3 < 3; ++h3) {
                const LAS float* acs = acsb + h3 * 128; const LAS float* dts = dtsb + h3 * 128;
                const float myacs = acs[lcol];
                const float Dh = d_skip[6 * g + 3 * hs + h3];
                const unsigned xb = xb0 + h3 * SSD_XIMG + st * 32 * SSD_RS_X;
#pragma unroll
                for (int kk = 0; kk < 2; ++kk) {
                    const int s0 = 32 * st + 16 * kk + 4 * h;
                    const f32x4v as0 = *(const LAS f32x4v*)(acs + s0), as1 = *(const LAS f32x4v*)(acs + s0 + 8);
                    const f32x4v ds0 = *(const LAS f32x4v*)(dts + s0), ds1 = *(const LAS f32x4v*)(dts + s0 + 8);
                    float wv[8];
#pragma unroll
                    for (int j = 0; j < 8; ++j) {
                        const int s = s0 + 8 * (j >> 2) + (j & 3);
                        const float asj = (j < 4) ? as0[j & 3] : as1[j & 3], dsj = (j < 4) ? ds0[j & 3] : ds1[j & 3];
                        float v = cb[8 * kk + j] * __expf(myacs - asj) * dsj;
                        v = (s <= lcol) ? v : 0.f;
                        v = (s == lcol) ? v + Dh : v;
                        wv[j] = v;
                    }
                    s16x8 afr;
                    { v4u o; o.x = pk2(wv[0], wv[1]); o.y = pk2(wv[2], wv[3]); o.z = pk2(wv[4], wv[5]); o.w = pk2(wv[6], wv[7]); afr = __builtin_bit_cast(s16x8, o); }
                    s16x8 b0, b1;
                    if (kk == 0) { b0 = tr_frag<0, 8 * SSD_RS_X>(xb); b1 = tr_frag<64, 8 * SSD_RS_X + 64>(xb); }
                    else { b0 = tr_frag<16 * SSD_RS_X, 24 * SSD_RS_X>(xb); b1 = tr_frag<16 * SSD_RS_X + 64, 24 * SSD_RS_X + 64>(xb); }
                    y[h3][0] = __builtin_amdgcn_mfma_f32_32x32x16_bf16(afr, b0, y[h3][0], 0, 0, 0);
                    y[h3][1] = __builtin_amdgcn_mfma_f32_32x32x16_bf16(afr, b1, y[h3][1], 0, 0, 0);
                    __builtin_amdgcn_sched_barrier(0);
                }
            }
        }
        __syncthreads();
        {
            LAS unsigned short* yst = (LAS unsigned short*)(ldsb + SSD_L_X);
#pragma unroll
            for (int h3 = 0; h3 < 3; ++h3)
#pragma unroll
                for (int ptile = 0; ptile < 2; ++ptile)
#pragma unroll
                    for (int reg = 0; reg < 16; ++reg) {
                        const int l0 = 32 * lt + (reg & 3) + 8 * (reg >> 2) + 4 * h;
                        const int col = (3 * hs + h3) * 64 + 32 * ptile + r;
                        yst[l0 * (SSD_RS_Y / 2) + col] = (unsigned short)f2bf(y[h3][ptile][reg]);
                    }
        }
        __syncthreads();
#pragma unroll
        for (int pass = 0; pass < 4; ++pass) {
            const int l = 4 * (pass * 8 + w) + (lane >> 4), i16 = lane & 15;
            float gv[3][8]; float ss = 0.f;
#pragma unroll
            for (int k = 0; k < 3; ++k) {
                const int col0 = 24 * i16 + 8 * k;
                float yv[8], zv[8];
                unpack8(*(const LAS v4u*)(ldsb + SSD_L_X + l * SSD_RS_Y + col0 * 2), yv);
                unpack8(*(const v4u*)(projb + (size_t)(t0 + l) * NB_LD + g * 384 + col0), zv);
#pragma unroll
                for (int j = 0; j < 8; ++j) { const float gg = yv[j] * silu_f(zv[j]); gv[k][j] = gg; ss += gg * gg; }
            }
            ss += __shfl_xor(ss, 1); ss += __shfl_xor(ss, 2); ss += __shfl_xor(ss, 4); ss += __shfl_xor(ss, 8);
            const float rstd = rsqrtf(ss * (1.0f / 384.0f) + LN_EPS);
#pragma unroll
            for (int k = 0; k < 3; ++k) {
                const int col0 = g * 384 + 24 * i16 + 8 * k;
                const float4 g0 = *(const float4*)(norm_g + col0), g1 = *(const float4*)(norm_g + col0 + 4);
                v4u o; o.x = pk2(gv[k][0] * rstd * g0.x, gv[k][1] * rstd * g0.y); o.y = pk2(gv[k][2] * rstd * g0.z, gv[k][3] * rstd * g0.w);
                o.z = pk2(gv[k][4] * rstd * g1.x, gv[k][5] * rstd * g1.y); o.w = pk2(gv[k][6] * rstd * g1.z, gv[k][7] * rstd * g1.w);
                *(v4u*)(A1 + (size_t)(t0 + l) * MIX_WIDTH + col0) = o;
            }
        }
    }
}

#define ATT_RS_V 144
#define ATT_VIMG (256 * ATT_RS_V)
#define ATT_PV(KT, S2) { \
        v4u o_; o_.x = pk2(s[KT][8 * S2 + 0], s[KT][8 * S2 + 1]); o_.y = pk2(s[KT][8 * S2 + 2], s[KT][8 * S2 + 3]); \
        o_.z = pk2(s[KT][8 * S2 + 4], s[KT][8 * S2 + 5]); o_.w = pk2(s[KT][8 * S2 + 6], s[KT][8 * S2 + 7]); \
        const s16x8 pf_ = __builtin_bit_cast(s16x8, o_); \
        const s16x8 a0_ = tr_frag<(32 * KT + 16 * S2) * ATT_RS_V, (32 * KT + 16 * S2 + 8) * ATT_RS_V>(vbase); \
        const s16x8 a1_ = tr_frag<(32 * KT + 16 * S2) * ATT_RS_V + 64, (32 * KT + 16 * S2 + 8) * ATT_RS_V + 64>(vbase); \
        o0 = __builtin_amdgcn_mfma_f32_32x32x16_bf16(a0_, pf_, o0, 0, 0, 0); \
        o1 = __builtin_amdgcn_mfma_f32_32x32x16_bf16(a1_, pf_, o1, 0, 0, 0); }
__device__ __forceinline__ void ph_attn_prompt(LAS unsigned char* ldsb, const bf16* __restrict__ qrot_b, const bf16* __restrict__ krot_b, const bf16* __restrict__ projb,
                                               bf16* __restrict__ obuf, float* __restrict__ lsebuf) {
    const int tid = threadIdx.x, w = __builtin_amdgcn_readfirstlane(tid >> 6), lane = tid & 63;
    const int r = lane & 31, h = lane >> 5, blk = (lane >> 4) & 1, q = (lane & 15) >> 2, pp = lane & 3;
    const int qt = w & 3, hsel = w >> 2;
    for (int unit = blockIdx.x; unit < 3 * 512; unit += gridDim.x) {
        const int pat = unit >> 9, rem = unit & 511, hp = rem & 3, rem2 = rem >> 2, b = rem2 >> 6, bk = rem2 & 63;
        const int dsh = 2 * pat, nper = 64 >> dsh, res = bk >> (6 - dsh), nb = bk & (nper - 1);
        const int head = 2 * hp + hsel;
        __syncthreads();
        for (int idx = tid & 255; idx < 2048; idx += 256) {
            const int row = idx >> 3, ch = idx & 7, js = 128 * nb - 128 + row;
            v4u v; v.x = 0u; v.y = 0u; v.z = 0u; v.w = 0u;
            if (js >= 0) v = *(const v4u*)(projb + (size_t)(b * SEQ + (js << dsh) + res) * NB_LD + NB_V + head * 64 + ch * 8);
            *(LAS v4u*)(ldsb + hsel * ATT_VIMG + row * ATT_RS_V + ch * 16) = v;
        }
        const int tq = b * SEQ + ((128 * nb + 32 * qt + r) << dsh) + res;
        s16x8 qf[4];
#pragma unroll
        for (int ks = 0; ks < 4; ++ks) qf[ks] = *(const s16x8*)(qrot_b + (size_t)tq * ATT_WIDTH + head * 64 + 16 * ks + 8 * h);
        f32x16 s[5];
#pragma unroll
        for (int kt = 0; kt < 5; ++kt) {
            int js = 128 * nb + 32 * qt - 128 + 32 * kt + r; js = js < 0 ? 0 : js;
            const bf16* kp = krot_b + (size_t)(b * SEQ + (js << dsh) + res) * ATT_WIDTH + head * 64 + 8 * h;
#pragma unroll
            for (int i = 0; i < 16; ++i) s[kt][i] = 0.f;
#pragma unroll
            for (int ks = 0; ks < 4; ++ks) s[kt] = __builtin_amdgcn_mfma_f32_32x32x16_bf16(*(const s16x8*)(kp + 16 * ks), qf[ks], s[kt], 0, 0, 0);
        }
        float m = -INFINITY;
#pragma unroll
        for (int kt = 0; kt < 5; ++kt) {
            const bool tile_ok = (nb > 0) || (qt + kt >= 4);
#pragma unroll
            for (int reg = 0; reg < 16; ++reg) {
                const int c = (reg & 3) + 8 * (reg >> 2) + 4 * h;
                const bool ok = tile_ok && (kt == 0 ? (c >= r) : (kt == 4 ? (c <= r) : true));
                const float v = ok ? s[kt][reg] * 0.125f : -INFINITY;
                s[kt][reg] = v; m = fmaxf(m, v);
            }
        }
        m = fmaxf(m, __shfl_xor(m, 32));
        float l = 0.f;
#pragma unroll
        for (int kt = 0; kt < 5; ++kt)
#pragma unroll
            for (int reg = 0; reg < 16; ++reg) { const float p = __expf(s[kt][reg] - m); s[kt][reg] = p; l += p; }
        l += __shfl_xor(l, 32);
        __syncthreads();
        f32x16 o0, o1;
#pragma unroll
        for (int i = 0; i < 16; ++i) { o0[i] = 0.f; o1[i] = 0.f; }
        const unsigned vbase = lds_addr(ldsb + hsel * ATT_VIMG) + (32 * qt + 4 * h + q) * ATT_RS_V + (16 * blk + 4 * pp) * 2;
        ATT_PV(0, 0) ATT_PV(0, 1) ATT_PV(1, 0) ATT_PV(1, 1) ATT_PV(2, 0) ATT_PV(2, 1) ATT_PV(3, 0) ATT_PV(3, 1) ATT_PV(4, 0) ATT_PV(4, 1)
        const float inv = 1.0f / l;
        bf16* op = obuf + ((size_t)pat * T_PROMPT + tq) * ATT_WIDTH + head * 64 + 4 * h;
#pragma unroll
        for (int q4 = 0; q4 < 4; ++q4) {
            *(uint2*)(op + 8 * q4) = make_uint2(pk2(o0[4 * q4] * inv, o0[4 * q4 + 1] * inv), pk2(o0[4 * q4 + 2] * inv, o0[4 * q4 + 3] * inv));
            *(uint2*)(op + 32 + 8 * q4) = make_uint2(pk2(o1[4 * q4] * inv, o1[4 * q4 + 1] * inv), pk2(o1[4 * q4 + 2] * inv, o1[4 * q4 + 3] * inv));
        }
        if (h == 0) lsebuf[((size_t)pat * T_PROMPT + tq) * 8 + head] = m + __logf(l);
    }
}
__device__ __forceinline__ void ph_attn_combine(const bf16* __restrict__ obuf, const float* __restrict__ lsebuf, bf16* __restrict__ A1) {
    const int lane = threadIdx.x & 63;
    for (int t = blockIdx.x * NWAVE + (threadIdx.x >> 6); t < T_PROMPT; t += gridDim.x * NWAVE) {
        const int hd = lane >> 3;
        const float l0 = lsebuf[((size_t)0 * T_PROMPT + t) * 8 + hd], l1 = lsebuf[((size_t)1 * T_PROMPT + t) * 8 + hd], l2 = lsebuf[((size_t)2 * T_PROMPT + t) * 8 + hd];
        const float mx = fmaxf(l0, fmaxf(l1, l2));
        const float e0 = __expf(l0 - mx), e1 = __expf(l1 - mx), e2 = __expf(l2 - mx);
        const float inv = 1.0f / (e0 + e1 + e2);
        float a[8], b[8], c[8];
        unpack8(*(const v4u*)(obuf + ((size_t)0 * T_PROMPT + t) * ATT_WIDTH + lane * 8), a);
        unpack8(*(const v4u*)(obuf + ((size_t)1 * T_PROMPT + t) * ATT_WIDTH + lane * 8), b);
        unpack8(*(const v4u*)(obuf + ((size_t)2 * T_PROMPT + t) * ATT_WIDTH + lane * 8), c);
        float o[8];
#pragma unroll
        for (int j = 0; j < 8; ++j) o[j] = (e0 * a[j] + e1 * b[j] + e2 * c[j]) * inv;
        v4u w; w.x = pk2(o[0], o[1]); w.y = pk2(o[2], o[3]); w.z = pk2(o[4], o[5]); w.w = pk2(o[6], o[7]);
        *(v4u*)(A1 + (size_t)t * MIX_WIDTH + SSD_WIDTH + lane * 8) = w;
    }
}

#define RT_RS 272
#define RT_KIMG (128 * RT_RS)
#define RT_LUT (2 * RT_KIMG)
constexpr unsigned char RT_CANDS[64] = {0, 1, 2, 3, 4, 5, 6, 7, 8, 9, 10, 11, 12, 13, 14, 15, 16, 17, 18, 19, 20, 21, 22, 23, 32, 33, 34, 35, 36, 48, 49, 50, 51, 64, 65, 66, 80, 81, 96, 97,
                                        112, 113, 128, 144, 160, 176, 192, 208, 224, 240, 0, 0, 0, 0, 0, 0, 0, 0, 0, 0, 0, 0, 0, 0};
__device__ __forceinline__ unsigned rt_mono(float f) { const unsigned u = __builtin_bit_cast(unsigned, f); return u ^ ((unsigned)((int)u >> 31) | 0x80000000u); }
__device__ __forceinline__ float rt_unmono(unsigned m) { const unsigned u = (m & 0x80000000u) ? (m ^ 0x80000000u) : ~m; return __builtin_bit_cast(float, u); }
#define RT_CE_DESC(a, b) { const unsigned x_ = (a), y_ = (b); (a) = x_ > y_ ? x_ : y_; (b) = x_ > y_ ? y_ : x_; }
#define RT_CE_ASC(a, b) { const unsigned x_ = (a), y_ = (b); (a) = x_ > y_ ? y_ : x_; (b) = x_ > y_ ? x_ : y_; }
__device__ __forceinline__ void rt_sort16(unsigned (&v)[16]) {
#pragma unroll
    for (int k = 2; k <= 16; k <<= 1)
#pragma unroll
        for (int j = k >> 1; j > 0; j >>= 1)
#pragma unroll
            for (int i = 0; i < 16; ++i) { const int l = i ^ j; if (l > i) { if ((i & k) == 0) RT_CE_DESC(v[i], v[l]) else RT_CE_ASC(v[i], v[l]) } }
}
__device__ __forceinline__ void rt_merge16(unsigned (&v)[16]) {
#pragma unroll
    for (int j = 8; j > 0; j >>= 1)
#pragma unroll
        for (int i = 0; i < 16; ++i) { const int l = i ^ j; if (l > i) RT_CE_DESC(v[i], v[l]) }
}
__device__ __forceinline__ void rt_top16(unsigned (&a)[16], const unsigned (&b)[16]) {
#pragma unroll
    for (int i = 0; i < 16; ++i) a[i] = a[i] > b[15 - i] ? a[i] : b[15 - i];
    rt_merge16(a);
}
__device__ __forceinline__ void rt_top16_partner(unsigned (&a)[16]) {
    unsigned b[16];
#pragma unroll
    for (int i = 0; i < 16; ++i) b[i] = (unsigned)__shfl_xor((int)a[i], 32);
    rt_top16(a, b);
}
__device__ __forceinline__ void rt_scores_top16(LAS unsigned char* kimg, const bf16* __restrict__ qp, int r, int h, unsigned (&k0)[16]) {
    f32x16 acc[4];
#pragma unroll
    for (int kt = 0; kt < 4; ++kt)
#pragma unroll
        for (int i = 0; i < 16; ++i) acc[kt][i] = 0.f;
#pragma unroll
    for (int ks = 0; ks < 8; ++ks) {
        const s16x8 qf = *(const s16x8*)(qp + 16 * ks);
#pragma unroll
        for (int kt = 0; kt < 4; ++kt) {
            const s16x8 kf = *(const LAS s16x8*)(kimg + (32 * kt + r) * RT_RS + (16 * ks + 8 * h) * 2);
            acc[kt] = __builtin_amdgcn_mfma_f32_32x32x16_bf16(kf, qf, acc[kt], 0, 0, 0);
        }
    }
    unsigned k1[16], k2[16], k3[16];
#pragma unroll
    for (int reg = 0; reg < 16; ++reg) {
        const unsigned ki = (unsigned)((reg & 3) + 8 * (reg >> 2) + 4 * h);
        k0[reg] = (rt_mono(acc[0][reg]) & 0xFFFFFF80u) | ki;
        k1[reg] = (rt_mono(acc[1][reg]) & 0xFFFFFF80u) | (ki + 32u);
        k2[reg] = (rt_mono(acc[2][reg]) & 0xFFFFFF80u) | (ki + 64u);
        k3[reg] = (rt_mono(acc[3][reg]) & 0xFFFFFF80u) | (ki + 96u);
    }
    rt_sort16(k0); rt_sort16(k1); rt_sort16(k2); rt_sort16(k3);
    rt_top16(k0, k1); rt_top16(k2, k3); rt_top16(k0, k2);
    rt_top16_partner(k0);
}
__device__ __forceinline__ void ph_peer_route2(LAS unsigned char* ldsb, const bf16* __restrict__ qhb, const float* __restrict__ keys1, const float* __restrict__ keys2,
                                               int* __restrict__ eidx, float* __restrict__ gate) {
    const int tid = threadIdx.x, w = __builtin_amdgcn_readfirstlane(tid >> 6), lane = tid & 63, r = lane & 31, h = lane >> 5;
    __syncthreads();
    for (int idx = tid; idx < 2 * 128 * 16; idx += NTHR) {
        const int tb = idx >> 11, rem = idx & 2047, row = rem >> 4, ch = rem & 15;
        const float* sp = (tb ? keys2 : keys1) + row * 128 + ch * 8;
        const float4 a = *(const float4*)sp, b = *(const float4*)(sp + 4);
        v4u o; o.x = pk2(a.x, a.y); o.y = pk2(a.z, a.w); o.z = pk2(b.x, b.y); o.w = pk2(b.z, b.w);
        *(LAS v4u*)(ldsb + tb * RT_KIMG + row * RT_RS + ch * 16) = o;
    }
    __syncthreads();
    LAS unsigned* lut = (LAS unsigned*)(ldsb + RT_LUT) + w * 512;
    for (int unit = blockIdx.x * NWAVE + w; unit < (T_ALL / 32) * 8; unit += gridDim.x * NWAVE) {
        const int tt = unit >> 3, hd = unit & 7;
        const int tok = 32 * tt + r;
        const bf16* qp = qhb + (size_t)tok * 2048 + hd * 256 + 8 * h;
        unsigned ka[16], kb[16];
        rt_scores_top16(ldsb, qp, r, h, ka);
        rt_scores_top16(ldsb + RT_KIMG, qp + 128, r, h, kb);
        float v1[16], v2[16];
#pragma unroll
        for (int i = 0; i < 16; ++i) { v1[i] = rt_unmono(ka[i] & 0xFFFFFF80u); v2[i] = rt_unmono(kb[i] & 0xFFFFFF80u); }
#pragma unroll
        for (int wd = 0; wd < 4; ++wd) {
            lut[wd * 64 + lane] = (ka[4 * wd] & 0x7Fu) | ((ka[4 * wd + 1] & 0x7Fu) << 8) | ((ka[4 * wd + 2] & 0x7Fu) << 16) | ((ka[4 * wd + 3] & 0x7Fu) << 24);
            lut[(4 + wd) * 64 + lane] = (kb[4 * wd] & 0x7Fu) | ((kb[4 * wd + 1] & 0x7Fu) << 8) | ((kb[4 * wd + 2] & 0x7Fu) << 16) | ((kb[4 * wd + 3] & 0x7Fu) << 24);
        }
        unsigned c0[16], c1[16];
        c0[0] = (rt_mono(h ? (v1[0] + v2[1]) : (v1[0] + v2[0])) & 0xFFFFFF00u) | (h ? 1u : 0u);
        c0[1] = (rt_mono(h ? (v1[0] + v2[3]) : (v1[0] + v2[2])) & 0xFFFFFF00u) | (h ? 3u : 2u);
        c0[2] = (rt_mono(h ? (v1[0] + v2[5]) : (v1[0] + v2[4])) & 0xFFFFFF00u) | (h ? 5u : 4u);
        c0[3] = (rt_mono(h ? (v1[0] + v2[7]) : (v1[0] + v2[6])) & 0xFFFFFF00u) | (h ? 7u : 6u);
        c0[4] = (rt_mono(h ? (v1[0] + v2[9]) : (v1[0] + v2[8])) & 0xFFFFFF00u) | (h ? 9u : 8u);
        c0[5] = (rt_mono(h ? (v1[0] + v2[11]) : (v1[0] + v2[10])) & 0xFFFFFF00u) | (h ? 11u : 10u);
        c0[6] = (rt_mono(h ? (v1[0] + v2[13]) : (v1[0] + v2[12])) & 0xFFFFFF00u) | (h ? 13u : 12u);
        c0[7] = (rt_mono(h ? (v1[0] + v2[15]) : (v1[0] + v2[14])) & 0xFFFFFF00u) | (h ? 15u : 14u);
        c0[8] = (rt_mono(h ? (v1[1] + v2[1]) : (v1[1] + v2[0])) & 0xFFFFFF00u) | (h ? 17u : 16u);
        c0[9] = (rt_mono(h ? (v1[1] + v2[3]) : (v1[1] + v2[2])) & 0xFFFFFF00u) | (h ? 19u : 18u);
        c0[10] = (rt_mono(h ? (v1[1] + v2[5]) : (v1[1] + v2[4])) & 0xFFFFFF00u) | (h ? 21u : 20u);
        c0[11] = (rt_mono(h ? (v1[1] + v2[7]) : (v1[1] + v2[6])) & 0xFFFFFF00u) | (h ? 23u : 22u);
        c0[12] = (rt_mono(h ? (v1[2] + v2[1]) : (v1[2] + v2[0])) & 0xFFFFFF00u) | (h ? 33u : 32u);
        c0[13] = (rt_mono(h ? (v1[2] + v2[3]) : (v1[2] + v2[2])) & 0xFFFFFF00u) | (h ? 35u : 34u);
        c0[14] = (rt_mono(h ? (v1[3] + v2[0]) : (v1[2] + v2[4])) & 0xFFFFFF00u) | (h ? 48u : 36u);
        c0[15] = (rt_mono(h ? (v1[3] + v2[2]) : (v1[3] + v2[1])) & 0xFFFFFF00u) | (h ? 50u : 49u);
        c1[0] = (rt_mono(h ? (v1[4] + v2[0]) : (v1[3] + v2[3])) & 0xFFFFFF00u) | (h ? 64u : 51u);
        c1[1] = (rt_mono(h ? (v1[4] + v2[2]) : (v1[4] + v2[1])) & 0xFFFFFF00u) | (h ? 66u : 65u);
        c1[2] = (rt_mono(h ? (v1[5] + v2[1]) : (v1[5] + v2[0])) & 0xFFFFFF00u) | (h ? 81u : 80u);
        c1[3] = (rt_mono(h ? (v1[6] + v2[1]) : (v1[6] + v2[0])) & 0xFFFFFF00u) | (h ? 97u : 96u);
        c1[4] = (rt_mono(h ? (v1[7] + v2[1]) : (v1[7] + v2[0])) & 0xFFFFFF00u) | (h ? 113u : 112u);
        c1[5] = (rt_mono(h ? (v1[9] + v2[0]) : (v1[8] + v2[0])) & 0xFFFFFF00u) | (h ? 144u : 128u);
        c1[6] = (rt_mono(h ? (v1[11] + v2[0]) : (v1[10] + v2[0])) & 0xFFFFFF00u) | (h ? 176u : 160u);
        c1[7] = (rt_mono(h ? (v1[13] + v2[0]) : (v1[12] + v2[0])) & 0xFFFFFF00u) | (h ? 208u : 192u);
        c1[8] = (rt_mono(h ? (v1[15] + v2[0]) : (v1[14] + v2[0])) & 0xFFFFFF00u) | (h ? 240u : 224u);
        c1[9] = 0u;
        c1[10] = 0u;
        c1[11] = 0u;
        c1[12] = 0u;
        c1[13] = 0u;
        c1[14] = 0u;
        c1[15] = 0u;
        rt_sort16(c0); rt_sort16(c1); rt_top16(c0, c1); rt_top16_partner(c0);
        float e[16]; float sum = 0.f;
        const float mx = rt_unmono(c0[0] & 0xFFFFFF00u);
#pragma unroll
        for (int k = 0; k < 16; ++k) { e[k] = __expf(rt_unmono(c0[k] & 0xFFFFFF00u) - mx); sum += e[k]; }
        const float inv = 1.0f / sum;
        asm volatile("s_waitcnt lgkmcnt(0)" ::: "memory");
        int ex[8]; float gv[8];
#pragma unroll
        for (int k = 0; k < 8; ++k) {
            const unsigned hm = (unsigned)(-h);
            const unsigned ck = (c0[k] & ~hm) | (c0[8 + k] & hm);
            const float ek = __builtin_bit_cast(float, (__builtin_bit_cast(unsigned, e[k]) & ~hm) | (__builtin_bit_cast(unsigned, e[8 + k]) & hm));
            const unsigned ci = (ck >> 4) & 15u, cj = ck & 15u;
            const unsigned w1 = lut[(ci >> 2) * 64 + lane], w2 = lut[(4 + (cj >> 2)) * 64 + lane];
            const unsigned i1 = (w1 >> (8 * (ci & 3))) & 0x7Fu, i2 = (w2 >> (8 * (cj & 3))) & 0x7Fu;
            ex[k] = (int)(i1 * PEER_NKEYS + i2); gv[k] = ek * inv;
        }
        int* ep = eidx + (size_t)tok * 128 + hd * 16 + 8 * h; float* gp = gate + (size_t)tok * 128 + hd * 16 + 8 * h;
        *(int4*)ep = make_int4(ex[0], ex[1], ex[2], ex[3]); *(int4*)(ep + 4) = make_int4(ex[4], ex[5], ex[6], ex[7]);
        *(float4*)gp = make_float4(gv[0], gv[1], gv[2], gv[3]); *(float4*)(gp + 4) = make_float4(gv[4], gv[5], gv[6], gv[7]);
    }
}

struct Params {
    const float* in[23];
    float* out;
    unsigned char* ws;
    unsigned* bar;
};

#define WS_BAR      0ull
#define WS_XALL     (1ull << 20)
#define WS_PROJ     (WS_XALL + (size_t)T_ALL * D_MODEL * 4)
#define WS_XBC      (WS_PROJ + (size_t)T_ALL * PROJ_LD * 4)
#define WS_DT       (WS_XBC + (size_t)T_ALL * CONV_DIM * 4)
#define WS_QROT     (WS_DT + (size_t)T_ALL * SSD_HEADS * 4)
#define WS_KROT     (WS_QROT + (size_t)T_ALL * ATT_WIDTH * 4)
#define WS_YBUF     (WS_KROT + (size_t)T_ALL * ATT_WIDTH * 4)
#define WS_MIX      (WS_YBUF + (size_t)T_ALL * MIX_WIDTH * 4)
#define WS_HBUF     (WS_MIX + (size_t)T_ALL * D_MODEL * 4)
#define WS_QH       (WS_HBUF + (size_t)T_ALL * D_MODEL * 4)
#define WS_EIDX     (WS_QH + (size_t)T_ALL * 2048 * 4)
#define WS_GATE     (WS_EIDX + (size_t)T_ALL * 128 * 4)
#define WS_A0       (WS_GATE + (size_t)T_ALL * 128 * 4)
#define WS_A1       (WS_A0 + (size_t)T_ALL * D_MODEL * 2)
#define WS_A2       (WS_A1 + (size_t)T_ALL * MIX_WIDTH * 2)
#define WS_WTIN     (WS_A2 + (size_t)T_ALL * D_MODEL * 2)
#define WS_WTOUT    (WS_WTIN + (size_t)PROJ_LD * D_MODEL * 2)
#define WS_WTQ      (WS_WTOUT + (size_t)D_MODEL * MIX_WIDTH * 2)
#define WS_PROJB    (WS_WTQ + (size_t)2048 * D_MODEL * 2)
#define WS_DTRAW    (WS_PROJB + (size_t)T_ALL * NB_LD * 2)
#define WS_XBCB     (WS_DTRAW + (size_t)T_ALL * 32 * 4)
#define WS_QROTB    (WS_XBCB + (size_t)T_ALL * CONV_DIM * 2)
#define WS_KROTB    (WS_QROTB + (size_t)T_ALL * ATT_WIDTH * 2)
#define WS_UB       (WS_KROTB + (size_t)T_ALL * ATT_WIDTH * 2)
#define WS_VB       (WS_UB + (size_t)16384 * D_MODEL * 2)
#define WS_USC      (WS_VB + (size_t)16384 * D_MODEL * 2)
#define WS_VSC      (WS_USC + 16384 * 4)
#define WS_SBUF     (WS_VSC + 16384 * 4)
#define WS_HIN      (WS_SBUF + (size_t)BATCH * 64 * SSD_HEADS * 64 * 128 * 2)
#define WS_CDEC     (WS_HIN + (size_t)BATCH * 64 * SSD_HEADS * 64 * 128 * 2)
#define WS_OBUF     (WS_CDEC + (size_t)BATCH * 64 * SSD_HEADS * 4)
#define WS_LSE      (WS_OBUF + (size_t)3 * T_PROMPT * ATT_WIDTH * 2)
#define WS_END      (WS_LSE + (size_t)3 * T_PROMPT * 8 * 4)

#define LDS_BYTES (160 * 1024)

#define KP const __attribute__((address_space(4))) Params* kp = (const __attribute__((address_space(4))) Params*)__builtin_amdgcn_kernarg_segment_ptr(); asm volatile("" : "+s"(kp)); unsigned char* ws = kp->ws; (void)ws;
#define IN(i) (kp->in[i])
#define WSP(T, off) ((T*)(ws + (off)))
__global__ void __launch_bounds__(512, 2) mega_fwd(Params p) {
    extern __shared__ __attribute__((aligned(16))) unsigned char smem[];
    if (threadIdx.x == 0) *(uint4*)smem = make_uint4(0u, 0u, 0u, 0u);
    __syncthreads();
    XcdBarrier bar = xcd_barrier_post(p.bar, (volatile LAS unsigned*)smem);
    float* lds = (float*)(smem + 256);
    LAS unsigned char* ldsb = (LAS unsigned char*)smem + 256;

    { KP ph_prologue(ldsb, IN(0), IN(1), WSP(bf16, WS_A0), IN(6), WSP(bf16, WS_WTIN), IN(13), WSP(bf16, WS_WTOUT), IN(16), WSP(bf16, WS_WTQ)); }
    { KP ph_quant_tables(IN(19), IN(20), WSP(unsigned char, WS_UB), WSP(unsigned char, WS_VB), WSP(float, WS_USC), WSP(float, WS_VSC)); }
    { KP ph_cache_copy(IN(2), IN(3), kp->out); }
    xcd_barrier(bar);
    { KP pg8::Gemm g{WSP(bf16, WS_A0), WSP(bf16, WS_WTIN), T_ALL, PROJ_LD, D_MODEL}; pg8::StaticOrder S; S.init(g.M, g.N, (int)gridDim.x, (int)blockIdx.x);
      pg8::EpiProj E{WSP(bf16, WS_PROJB), WSP(float, WS_DTRAW)}; pg8::gemm_phase<pg8::EpiProj, pg8::StaticOrder, false>(ldsb, g, S, E, nullptr); }
    xcd_barrier(bar);
    { KP ph_post_proj2(WSP(bf16, WS_PROJB), WSP(float, WS_DTRAW), IN(4), IN(7), IN(8), IN(9), WSP(bf16, WS_XBCB), WSP(float, WS_DT), WSP(bf16, WS_QROTB), WSP(bf16, WS_KROTB), kp->out); }
    xcd_barrier(bar);
    { KP ph_ssd_states(ldsb, WSP(bf16, WS_XBCB), WSP(float, WS_DT), IN(10), WSP(bf16, WS_SBUF), WSP(float, WS_CDEC)); }
    __syncthreads();
    { KP ph_attn_prompt(ldsb, WSP(bf16, WS_QROTB), WSP(bf16, WS_KROTB), WSP(bf16, WS_PROJB), WSP(bf16, WS_OBUF), WSP(float, WS_LSE)); }
    __syncthreads();
    { KP ph_ssd_naive(lds, WSP(bf16, WS_XBCB), WSP(float, WS_DT), IN(10), IN(11), IN(5), WSP(float, WS_YBUF), kp->out); }
    { KP ph_attn_sample(lds, WSP(bf16, WS_QROTB), WSP(bf16, WS_KROTB), WSP(bf16, WS_PROJB), IN(2), IN(3), WSP(bf16, WS_A1)); }
    xcd_barrier(bar);
    { KP ph_ssd_scan(WSP(bf16, WS_SBUF), WSP(float, WS_CDEC), WSP(bf16, WS_HIN), kp->out); }
    xcd_barrier(bar);
    { KP ph_ssd_out(ldsb, WSP(bf16, WS_XBCB), WSP(bf16, WS_PROJB), WSP(float, WS_DT), IN(10), IN(11), IN(12), WSP(bf16, WS_HIN), WSP(bf16, WS_A1)); }
    { KP ph_attn_combine(WSP(bf16, WS_OBUF), WSP(float, WS_LSE), WSP(bf16, WS_A1)); }
    { KP ph_gate_norm(WSP(bf16, WS_PROJB), IN(12), WSP(float, WS_YBUF), WSP(bf16, WS_A1)); }
    xcd_barrier(bar);
    { KP pg8::Gemm g{WSP(bf16, WS_A1), WSP(bf16, WS_WTOUT), T_ALL, D_MODEL, MIX_WIDTH}; pg8::StaticOrder S; S.init(g.M, g.N, (int)gridDim.x, (int)blockIdx.x);
      pg8::EpiF32 E{WSP(float, WS_MIX), D_MODEL, nullptr}; pg8::gemm_phase<pg8::EpiF32, pg8::StaticOrder, false>(ldsb, g, S, E, nullptr); }
    xcd_barrier(bar);
    { KP ph_ln_res(IN(0), IN(1), WSP(float, WS_MIX), IN(14), IN(15), WSP(float, WS_HBUF), WSP(bf16, WS_A2)); }
    xcd_barrier(bar);
    { KP pg8::Gemm g{WSP(bf16, WS_A2), WSP(bf16, WS_WTQ), T_ALL, 2048, D_MODEL}; pg8::StaticOrder S; S.init(g.M, g.N, (int)gridDim.x, (int)blockIdx.x);
      pg8::EpiBf16Plain E{WSP(bf16, WS_QH), 2048}; pg8::gemm_phase<pg8::EpiBf16Plain, pg8::StaticOrder, false>(ldsb, g, S, E, nullptr); }
    xcd_barrier(bar);
    { KP ph_peer_route2(ldsb, WSP(bf16, WS_QH), IN(17), IN(18), WSP(int, WS_EIDX), WSP(float, WS_GATE)); }
    xcd_barrier(bar);
    { KP ph_peer_ffn3(WSP(float, WS_HBUF), WSP(int, WS_EIDX), WSP(float, WS_GATE), WSP(unsigned char, WS_UB), WSP(unsigned char, WS_VB), WSP(float, WS_USC), WSP(float, WS_VSC), IN(21), IN(22), kp->out); }
}

extern "C" void kernel_launch(void* const* d_in, const int* in_sizes, int n_in, void* d_out, int out_size, void* d_ws, size_t ws_size, hipStream_t stream) {
    static int grid = 0;
    if (grid == 0) {
        int dev = 0, cus = 0, per_cu = 0;
        if (hipGetDevice(&dev) != hipSuccess || hipDeviceGetAttribute(&cus, hipDeviceAttributeMultiprocessorCount, dev) != hipSuccess) { fprintf(stderr, "kernel_launch: device query failed\n"); grid = -1; return; }
        if (hipFuncSetAttribute((const void*)mega_fwd, hipFuncAttributeMaxDynamicSharedMemorySize, LDS_BYTES) != hipSuccess) { fprintf(stderr, "kernel_launch: hipFuncSetAttribute failed\n"); grid = -1; return; }
        if (hipOccupancyMaxActiveBlocksPerMultiprocessor(&per_cu, (const void*)mega_fwd, NTHR, LDS_BYTES) != hipSuccess || per_cu < 1) { fprintf(stderr, "kernel_launch: occupancy query says %d\n", per_cu); }
        (void)hipGetLastError();
        grid = cus;
        if (ws_size < WS_END) { fprintf(stderr, "kernel_launch: workspace too small\n"); grid = -1; return; }
    }
    if (grid < 0) return;
    (void)hipMemsetAsync((char*)d_ws + WS_BAR, 0, XCD_BAR_WORDS * sizeof(unsigned), stream);
    Params p{};
    for (int i = 0; i < 23; ++i) p.in[i] = (const float*)d_in[i];
    p.out = (float*)d_out; p.ws = (unsigned char*)d_ws; p.bar = (unsigned*)((char*)d_ws + WS_BAR);
    hipLaunchKernelGGL(mega_fwd, dim3(grid), dim3(NTHR), LDS_BYTES, stream, p);
}
```

```cpp
#include <hip/hip_runtime.h>
#include <stdint.h>

#define D_MODEL 1024
#define BATCH 2
#define SEQ 8192
#define DEC_BATCH 128
#define DEC_SEQ 4
#define PAST_LEN 8192
#define HEAD_DIM 64
#define ATT_WIDTH 512
#define ATT_HEADS 8
#define SSD_WIDTH 1536
#define SSD_HEADS 24
#define SSD_GROUPS 4
#define SSD_STATE 128
#define CONV_DIM 2560
#define IN_WIDTH 5656
#define PROJ_LD 5888
#define MIX_WIDTH 2048
#define WBUF 2048
#define PEER_NKEYS 128
#define PEER_HEADS 8
#define PEER_TOPK 16
#define PEER_DKEY 256
#define T_PROMPT (BATCH * SEQ)
#define T_SAMPLE (DEC_BATCH * DEC_SEQ)
#define T_ALL (T_PROMPT + T_SAMPLE)
#define O_Z 0
#define O_XBC 1536
#define O_DT 4096
#define O_Q 4120
#define O_K 4632
#define O_V 5144
#define ALPHA_F 1.189207115002721f
#define LN_EPS 1e-5f

#define OUT_YP 0ull
#define OUT_YS (OUT_YP + 16777216ull)
#define OUT_PK (OUT_YS + 524288ull)
#define OUT_PV (OUT_PK + 2097152ull)
#define OUT_PC (OUT_PV + 2097152ull)
#define OUT_PS (OUT_PC + 15360ull)
#define OUT_SK (OUT_PS + 393216ull)
#define OUT_SV (OUT_SK + 134217728ull)
#define OUT_SC (OUT_SV + 134217728ull)
#define OUT_SS (OUT_SC + 983040ull)

__constant__ double ROPE_INV_REV[32] = {
    1.59154943091895346e-01, 1.19349370211248862e-01, 8.94994016088910133e-02, 6.71150830052272551e-02,
    5.03292121044870353e-02, 3.77415847174197711e-02, 2.83021958306233987e-02, 2.12236527647776604e-02,
    1.59154943091895339e-02, 1.19349370211248862e-02, 8.94994016088910237e-03, 6.71150830052272534e-03,
    5.03292121044870370e-03, 3.77415847174197719e-03, 2.83021958306233987e-03, 2.12236527647776622e-03,
    1.59154943091895356e-03, 1.19349370211248849e-03, 8.94994016088910237e-04, 6.71150830052272599e-04,
    5.03292121044870326e-04, 3.77415847174197741e-04, 2.83021958306233954e-04, 2.12236527647776605e-04,
    1.59154943091895351e-04, 1.19349370211248862e-04, 8.94994016088910182e-05, 6.71150830052272545e-05,
    5.03292121044870354e-05, 3.77415847174197768e-05, 2.83021958306233961e-05, 2.12236527647776592e-05
};

__device__ __forceinline__ float silu_f(float x) { return x / (1.0f + __expf(-x)); }
__device__ __forceinline__ float softplus_f(float x) { return fmaxf(x, 0.f) + log1pf(__expf(-fabsf(x))); }
__device__ __forceinline__ float gelu_f(float x) { return 0.5f * x * (1.0f + erff(x * 0.70710678118654752f)); }
__device__ __forceinline__ float wave_sum(float v) {
#pragma unroll
    for (int o = 32; o > 0; o >>= 1) v += __shfl_xor(v, o);
    return v;
}
__device__ __forceinline__ float wave_max(float v) {
#pragma unroll
    for (int o = 32; o > 0; o >>= 1) v = fmaxf(v, __shfl_xor(v, o));
    return v;
}

#include <cstdio>
#define XB_TMO      128
#define XB_XCNT(j)  (256  + 64 * (j))
#define XB_XSUB(j)  (1280 + 64 * (j))
#define XB_XGEN(j)  (2304 + 64 * (j))
#define XB_TOP      3328
#define XB_TOPGEN   3392
#define XCD_BAR_WORDS 3456
#define XB_SPIN_CAP (1u << 18)
#define LAS __attribute__((address_space(3)))

__device__ __forceinline__ unsigned xb_ld(unsigned* p)              { return __hip_atomic_load(p, __ATOMIC_RELAXED, __HIP_MEMORY_SCOPE_AGENT); }
__device__ __forceinline__ unsigned xb_add(unsigned* p, unsigned v) { return __hip_atomic_fetch_add(p, v, __ATOMIC_RELAXED, __HIP_MEMORY_SCOPE_AGENT); }
__device__ __forceinline__ unsigned xb_xcc_id() { return (unsigned)__builtin_amdgcn_s_getreg((3 << 11) | 20) & 0xFu; }
#define XB_SPIN(cond, bar) do { unsigned _sp = 0; while (cond) { __builtin_amdgcn_s_sleep(1); \
    if ((++_sp & 255u) == 0u) { if (xb_ld(&(bar)[XB_TMO])) break; if (_sp > XB_SPIN_CAP) { atomicAdd(&(bar)[XB_TMO], 1u); break; } } } } while (0)

struct XcdBarrier {
    unsigned* bar; unsigned x;
    volatile LAS unsigned* st;
};

__device__ __forceinline__ XcdBarrier xcd_barrier_post(unsigned* bar, volatile LAS unsigned* st) {
    XcdBarrier b; b.bar = bar; b.x = xb_xcc_id(); b.st = st;
    if (threadIdx.x == 0) (void)xb_add(&bar[XB_XCNT(b.x)], 1u);
    return b;
}
__device__ __forceinline__ void xcd_barrier_complete(unsigned* bar, unsigned x, unsigned& nloc, unsigned& nx) {
    const unsigned G = gridDim.x * gridDim.y * gridDim.z;
    unsigned sum, cnt, mine, sp = 0u;
    for (;;) {
        sum = 0u; cnt = 0u; mine = 0u;
#pragma unroll
        for (unsigned j = 0; j < 16; ++j) { const unsigned c = xb_ld(&bar[XB_XCNT(j)]); sum += c; cnt += (c > 0u) ? 1u : 0u; mine = (j == x) ? c : mine; }
        if (sum == G) break;
        __builtin_amdgcn_s_sleep(1);
        if ((++sp & 255u) == 0u) { if (xb_ld(&bar[XB_TMO])) break; if (sp > XB_SPIN_CAP) { atomicAdd(&bar[XB_TMO], 1u); break; } }
    }
    nloc = mine > 0u ? mine : 1u; nx = cnt > 0u ? cnt : 1u;
}

__device__ __forceinline__ void xcd_barrier(const XcdBarrier& b) {
    asm volatile("s_waitcnt vmcnt(0)" ::: "memory");
    __syncthreads();
    if (threadIdx.x == 0) {
        unsigned* bar = b.bar;
        __builtin_amdgcn_s_waitcnt(0);
        unsigned nloc = b.st[0], nx = b.st[1];
        if (nloc == 0u) { xcd_barrier_complete(bar, b.x, nloc, nx); b.st[0] = nloc; b.st[1] = nx; }
        const unsigned old = xb_add(&bar[XB_XSUB(b.x)], 1u);
        const unsigned gen = old / nloc;
        if (old + 1u == (gen + 1u) * nloc) {
            __builtin_amdgcn_fence(__ATOMIC_RELEASE, "agent");
            asm volatile("s_waitcnt vmcnt(0)" ::: "memory");
            const unsigned og = xb_add(&bar[XB_TOP], 1u);
            const unsigned tg = og / nx;
            if (og + 1u == (tg + 1u) * nx) xb_add(&bar[XB_TOPGEN], 1u);
            else XB_SPIN(xb_ld(&bar[XB_TOPGEN]) == tg, bar);
            __builtin_amdgcn_fence(__ATOMIC_ACQUIRE, "agent");
            xb_add(&bar[XB_XGEN(b.x)], 1u);
            asm volatile("s_waitcnt vmcnt(0)" ::: "memory");
        } else {
            XB_SPIN(xb_ld(&bar[XB_XGEN(b.x)]) == gen, bar);
            __builtin_amdgcn_fence(__ATOMIC_ACQUIRE, "agent");
            asm volatile("s_waitcnt vmcnt(0)" ::: "memory");
        }
    }
    __syncthreads();
}


#define GAS __attribute__((address_space(1)))
typedef unsigned short bf16;
typedef unsigned v4u __attribute__((ext_vector_type(4)));
#define LDS_WAIT() asm volatile("s_waitcnt lgkmcnt(0)" ::: "memory")
__device__ __forceinline__ unsigned f2bf(float f) { unsigned u = __builtin_bit_cast(unsigned, f); return (u + 0x7fffu + ((u >> 16) & 1u)) >> 16; }
__device__ __forceinline__ unsigned pk2(float lo, float hi) { return f2bf(lo) | (f2bf(hi) << 16); }
__device__ __forceinline__ float bf2f(unsigned short b) { return __builtin_bit_cast(float, (unsigned)b << 16); }
#include <hip/hip_runtime.h>
namespace pg8 {
#define PG8_LAS __attribute__((address_space(3)))
typedef unsigned short bf16_t;
typedef short bf16x8 __attribute__((ext_vector_type(8)));
typedef float f32x4 __attribute__((ext_vector_type(4)));
typedef unsigned u32x4 __attribute__((ext_vector_type(4)));
constexpr int BM = 256, BK = 64, HALF = 128, HTB = HALF * BK * 2  , STAGE_BYTES = 8 * HTB, NXCD = 8, WGM = 8;

__host__ __device__ __forceinline__ int lds_byte(int r, int c) { const int st = (r >> 4) * 2 + (c >> 5), rr = r & 15, cc = c & 31, ob = rr * 64 + cc * 2; return st * 1024 + (ob ^ (((ob >> 9) & 1) << 5)); }
__host__ __device__ __forceinline__ void stage_rc(int b, int& R, int& C) { const int st = b / 1024, sb = b % 1024, swz = sb ^ (((sb >> 9) & 1) << 5); R = (st >> 1) * 16 + swz / 64; C = (st & 1) * 32 + (swz % 64) / 2; }
__host__ __device__ __forceinline__ int perm32(int rho) { const int n = rho >> 4, i = rho & 15; return 8 * (i >> 2) + 4 * n + (i & 3); }

struct Unit { int pm, pn; };
struct Gemm { const bf16_t* A; const bf16_t* Bt; int M, N, K; };

struct StaticOrder {
    int nM, nN, nwg, G, c;
    __host__ __device__ void init(int M, int N, int G_, int c_) { nM = M / BM; nN = N / BM; nwg = nM * nN; G = G_; c = c_; }
    __host__ __device__ bool next(int i, Unit& u) const {
        const long L = (long)i * G + c; if (L >= nwg) return false;
        int wgid = (int)L; { const int q = nwg / NXCD, r = nwg % NXCD, xcd = wgid % NXCD, off = wgid / NXCD; wgid = (xcd < r ? xcd * (q + 1) : r * (q + 1) + (xcd - r) * q) + off; }
        const int nig = WGM * nN, gid = wgid / nig, fm = gid * WGM, gsz = (nM - fm) < WGM ? (nM - fm) : WGM;
        u.pm = fm + ((wgid % nig) % gsz); u.pn = (wgid % nig) / gsz; return true;
    }
    __device__ __forceinline__ void a_ready(const Unit&) const {}
    __device__ __forceinline__ void done(const Unit&) const {}
};
__device__ __forceinline__ unsigned cvt_pk_bf16(float lo, float hi) { unsigned r; asm volatile("v_cvt_pk_bf16_f32 %0, %1, %2" : "=v"(r) : "v"(lo), "v"(hi)); return r; }
typedef float f32x2 __attribute__((ext_vector_type(2)));
__device__ __forceinline__ f32x2 gelu_pk(f32x2 v) {
    const f32x2 av = __builtin_elementwise_abs(v), d = av * 0.2316418882f + 1.0f;
    f32x2 t; t.x = __builtin_amdgcn_rcpf(d.x); t.y = __builtin_amdgcn_rcpf(d.y);
    f32x2 q = t * 0.5307027145f + (-0.7265760135f); q = q * t + 0.7107068705f; q = q * t + (-0.142248368f); q = q * t + 0.127414796f; q = q * t;
    const f32x2 s = (v * v) * (-0.72134752044f);
    f32x2 e; e.x = __builtin_amdgcn_exp2f(s.x); e.y = __builtin_amdgcn_exp2f(s.y);
    const f32x2 m = v * (q * e), r = v - m;
    f32x2 o; o.x = v.x < 0.f ? m.x : r.x; o.y = v.y < 0.f ? m.y : r.y; return o;
}

struct EpiF32 {
    static constexpr bool PERM = false, AFTER_DRAIN = false;
    float* C; int ldc; const float* bias;
    __device__ __forceinline__ void operator()(const f32x4 (&acc)[2][2][4][2], const Unit& u, int wr, int wc, int fr, int fq) const {
        const int row0 = u.pm * BM + wr * 64 + fr, col0 = u.pn * BM + wc * 32 + 4 * fq;
        f32x4 bv[2][2];
#pragma unroll
        for (int bj = 0; bj < 2; ++bj)
#pragma unroll
            for (int n = 0; n < 2; ++n) bv[bj][n] = bias ? *(const f32x4*)(bias + col0 + bj * HALF + n * 16) : (f32x4){0.f, 0.f, 0.f, 0.f};
#pragma unroll
        for (int ai = 0; ai < 2; ++ai)
#pragma unroll
            for (int m = 0; m < 4; ++m) { float* rowp = C + (size_t)(row0 + ai * HALF + m * 16) * ldc + col0;
#pragma unroll
                for (int bj = 0; bj < 2; ++bj)
#pragma unroll
                    for (int n = 0; n < 2; ++n) *(f32x4*)(rowp + bj * HALF + n * 16) = acc[ai][bj][m][n] + bv[bj][n]; }
    }
};

template <class Epi, class Sched, bool STAMP = false>
__device__ __forceinline__ void gemm_phase(PG8_LAS unsigned char* lds, const Gemm g, const Sched& S, const Epi& E, unsigned long long* stamps) {
    const int tid = threadIdx.x, wid = __builtin_amdgcn_readfirstlane(tid >> 6), lane = tid & 63, wr = wid >> 2, wc = wid & 3, fr = lane & 15, fq = lane >> 4;
    const int K = g.K, nt = K / BK;
    int ts_lo = 0, ts_hi = 0, nts = 0; const unsigned long long rt_entry = STAMP ? (unsigned long long)wall_clock64() : 0ull;
#define PG8_STAMP() do { if (STAMP && wid == 0 && nts < 64) { const unsigned long long _c = (unsigned long long)clock64(); \
        ts_lo = (lane == nts) ? (int)(unsigned)_c : ts_lo; ts_hi = (lane == nts) ? (int)(unsigned)(_c >> 32) : ts_hi; ++nts; } } while (0)
    PG8_STAMP();
    unsigned voffA[2], voffB[2];
#pragma unroll
    for (int i = 0; i < 2; ++i) { int R, C; stage_rc(tid * 16 + i * 8192, R, C); const int Rb = Epi::PERM ? ((R & ~31) + perm32(R & 31)) : R;
        voffA[i] = (unsigned)(R * K + C) * 2u; voffB[i] = (unsigned)(Rb * K + C) * 2u; }
    const size_t kstep = (size_t)(BK * 2);
    const size_t hstep = (size_t)HALF * K * 2;
    const size_t tstep = 2 * hstep;
    const unsigned ldsw = (unsigned)wid * 1024u;
    const int aoff = lds_byte(wr * 64 + fr, fq * 8), boff = lds_byte(wc * 32 + fr, fq * 8);
#define PG8_SA(b, h) (((b) * 2 + (h)) * HTB)
#define PG8_SB(b, h) ((4 + (b) * 2 + (h)) * HTB)
#define PG8_STAGE(bufoff, gbase, voff) do { _Pragma("unroll") for (int _i = 0; _i < 2; ++_i) \
        __builtin_amdgcn_global_load_lds((const unsigned*)((const char*)(gbase) + (voff)[_i]), (PG8_LAS unsigned*)(lds + (bufoff) + ldsw + _i * 8192), 16, 0, 0); } while (0)
#define PG8_LDA(dst, b, h) do { _Pragma("unroll") for (int m = 0; m < 4; ++m) _Pragma("unroll") for (int k = 0; k < 2; ++k) dst[m][k] = *(const PG8_LAS bf16x8*)(lds + PG8_SA(b, h) + aoff + m * 2048 + k * 1024); } while (0)
#define PG8_LDB(dst, b, h) do { _Pragma("unroll") for (int n = 0; n < 2; ++n) _Pragma("unroll") for (int k = 0; k < 2; ++k) dst[n][k] = *(const PG8_LAS bf16x8*)(lds + PG8_SB(b, h) + boff + n * 2048 + k * 1024); } while (0)
#define PG8_MMA(ai, bj, At, Bt) do { __builtin_amdgcn_s_setprio(1); _Pragma("unroll") for (int m = 0; m < 4; ++m) _Pragma("unroll") for (int n = 0; n < 2; ++n) _Pragma("unroll") for (int k = 0; k < 2; ++k) \
        acc[ai][bj][m][n] = __builtin_amdgcn_mfma_f32_16x16x32_bf16(Bt[n][k], At[m][k], acc[ai][bj][m][n], 0, 0, 0); __builtin_amdgcn_s_setprio(0); } while (0)
#define PG8_WAIT_V(n) asm volatile("s_waitcnt vmcnt(" #n ")" ::: "memory")
#define PG8_WAIT_L(n) asm volatile("s_waitcnt lgkmcnt(" #n ")" ::: "memory")
#define PG8_BAR __builtin_amdgcn_s_barrier()
#define PG8_SCHED __builtin_amdgcn_sched_barrier(0)
    Unit cur, nxt; int ui = 0;
    if (!S.next(0, cur)) return;
    f32x4 acc[2][2][4][2];
#pragma unroll
    for (int a = 0; a < 2; ++a)
#pragma unroll
        for (int b = 0; b < 2; ++b)
#pragma unroll
            for (int m = 0; m < 4; ++m)
#pragma unroll
                for (int n = 0; n < 2; ++n) acc[a][b][m][n] = (f32x4){0.f, 0.f, 0.f, 0.f};
    bf16x8 At[4][2], B0[2][2], B1[2][2];
    const char* cA = (const char*)g.A + (size_t)cur.pm * tstep; const char* cB = (const char*)g.Bt + (size_t)cur.pn * tstep;
    S.a_ready(cur);
    PG8_STAGE(PG8_SB(0, 0), cB, voffB); PG8_STAGE(PG8_SA(0, 0), cA, voffA); PG8_STAGE(PG8_SB(0, 1), cB + hstep, voffB); PG8_STAGE(PG8_SA(0, 1), cA + hstep, voffA);
    if (wr == 1) PG8_BAR;
    PG8_WAIT_V(4); PG8_BAR;
    PG8_STAGE(PG8_SB(1, 0), cB + kstep, voffB); PG8_STAGE(PG8_SA(1, 0), cA + kstep, voffA); PG8_STAGE(PG8_SB(1, 1), cB + hstep + kstep, voffB);
    PG8_WAIT_V(6); PG8_BAR;
    PG8_STAMP();
    for (;;) {
        const bool has_next = S.next(ui + 1, nxt);
        const char* nA = has_next ? (const char*)g.A + (size_t)nxt.pm * tstep : cA; const char* nB = has_next ? (const char*)g.Bt + (size_t)nxt.pn * tstep : cB;
        for (int t = 0; t < nt; t += 2) {
            const bool last = (t == nt - 2);
            const char* a1 = cA + (size_t)(t + 1) * kstep;
            const char* a2 = last ? nA : cA + (size_t)(t + 2) * kstep; const char* b2 = last ? nB : cB + (size_t)(t + 2) * kstep;
            const char* a3 = a2 + kstep; const char* b3 = b2 + kstep;
            if (last && has_next) S.a_ready(nxt);
            PG8_LDB(B0, 0, 0); PG8_SCHED; PG8_LDA(At, 0, 0); PG8_STAGE(PG8_SA(1, 1), a1 + hstep, voffA);
            PG8_WAIT_L(8); PG8_BAR; PG8_WAIT_L(0); PG8_MMA(0, 0, At, B0); PG8_BAR; PG8_SCHED;
            PG8_LDB(B1, 0, 1); PG8_STAGE(PG8_SB(0, 0), b2, voffB);
            PG8_BAR; PG8_WAIT_L(0); PG8_MMA(0, 1, At, B1); PG8_BAR;
            PG8_LDA(At, 0, 1); PG8_STAGE(PG8_SA(0, 0), a2, voffA);
            PG8_BAR; PG8_WAIT_L(0); PG8_MMA(1, 0, At, B0); PG8_BAR; PG8_SCHED;
            PG8_STAGE(PG8_SB(0, 1), b2 + hstep, voffB);
            PG8_WAIT_V(6); PG8_BAR; PG8_MMA(1, 1, At, B1); PG8_BAR;
            PG8_LDB(B0, 1, 0); PG8_SCHED; PG8_LDA(At, 1, 0); PG8_STAGE(PG8_SA(0, 1), a2 + hstep, voffA);
            PG8_WAIT_L(8); PG8_BAR; PG8_WAIT_L(0); PG8_MMA(0, 0, At, B0); PG8_BAR; PG8_SCHED;
            PG8_LDB(B1, 1, 1); PG8_STAGE(PG8_SB(1, 0), b3, voffB);
            PG8_BAR; PG8_WAIT_L(0); PG8_MMA(0, 1, At, B1); PG8_BAR;
            PG8_LDA(At, 1, 1); PG8_STAGE(PG8_SA(1, 0), a3, voffA);
            PG8_BAR; PG8_WAIT_L(0); PG8_MMA(1, 0, At, B0); PG8_BAR; PG8_SCHED;
            PG8_STAGE(PG8_SB(1, 1), b3 + hstep, voffB);
            PG8_WAIT_V(6); PG8_BAR; PG8_MMA(1, 1, At, B1); PG8_BAR;
        }
        PG8_STAMP();
        if constexpr (!Epi::AFTER_DRAIN) { E(acc, cur, wr, wc, fr, fq); S.done(cur); }
        PG8_STAMP();
        if (!has_next) break;
#pragma unroll
        for (int a = 0; a < 2; ++a)
#pragma unroll
            for (int b = 0; b < 2; ++b)
#pragma unroll
                for (int m = 0; m < 4; ++m)
#pragma unroll
                    for (int n = 0; n < 2; ++n) acc[a][b][m][n] = (f32x4){0.f, 0.f, 0.f, 0.f};
        cur = nxt; cA = nA; cB = nB; ++ui;
    }
    PG8_WAIT_V(0);
    if (wr == 0) PG8_BAR;
    PG8_BAR;
    if constexpr (Epi::AFTER_DRAIN) { E.fused(acc, cur, wr, wc, fr, fq, lds, wid, lane); S.done(cur); }
    PG8_STAMP();
    if (STAMP && wid == 0) { stamps[lane] = lane < nts ? (((unsigned long long)(unsigned)ts_hi << 32) | (unsigned)ts_lo) : 0ull;
        if (lane == 62) stamps[62] = rt_entry; if (lane == 63) stamps[63] = (unsigned long long)wall_clock64(); }
#undef PG8_STAMP
#undef PG8_SA
#undef PG8_SB
#undef PG8_STAGE
#undef PG8_LDA
#undef PG8_LDB
#undef PG8_MMA
#undef PG8_WAIT_V
#undef PG8_WAIT_L
#undef PG8_BAR
#undef PG8_SCHED
}
}


namespace pg8 {
struct EpiProj {
    static constexpr bool PERM = true, AFTER_DRAIN = false;
    bf16_t* O; float* dtraw;
    __device__ __forceinline__ void operator()(const f32x4 (&acc)[2][2][4][2], const Unit& u, int wr, int wc, int fr, int fq) const {
        const int row0 = u.pm * BM + wr * 64 + fr;
        if (u.pn < 22) {
            const int col0 = u.pn * BM + wc * 32 + 8 * fq;
#pragma unroll
            for (int ai = 0; ai < 2; ++ai)
#pragma unroll
                for (int m = 0; m < 4; ++m) { bf16_t* rowp = O + (size_t)(row0 + ai * HALF + m * 16) * 5632 + col0;
#pragma unroll
                    for (int bj = 0; bj < 2; ++bj) { const f32x4 v0 = acc[ai][bj][m][0], v1 = acc[ai][bj][m][1];
                        u32x4 w; w.x = cvt_pk_bf16(v0[0], v0[1]); w.y = cvt_pk_bf16(v0[2], v0[3]); w.z = cvt_pk_bf16(v1[0], v1[1]); w.w = cvt_pk_bf16(v1[2], v1[3]);
                        *(u32x4*)(rowp + bj * HALF) = w; } }
        } else if (wc == 0) {
#pragma unroll
            for (int ai = 0; ai < 2; ++ai)
#pragma unroll
                for (int m = 0; m < 4; ++m) { float* rp = dtraw + (size_t)(row0 + ai * HALF + m * 16) * 32 + 8 * fq;
                    *(f32x4*)rp = acc[ai][0][m][0]; *(f32x4*)(rp + 4) = acc[ai][0][m][1]; }
        }
    }
};
}


namespace pg8 {
struct EpiBf16Plain {
    static constexpr bool PERM = true, AFTER_DRAIN = false;
    bf16_t* O; int ldc;
    __device__ __forceinline__ void operator()(const f32x4 (&acc)[2][2][4][2], const Unit& u, int wr, int wc, int fr, int fq) const {
        const int row0 = u.pm * BM + wr * 64 + fr, col0 = u.pn * BM + wc * 32 + 8 * fq;
#pragma unroll
        for (int ai = 0; ai < 2; ++ai)
#pragma unroll
            for (int m = 0; m < 4; ++m) { bf16_t* rowp = O + (size_t)(row0 + ai * HALF + m * 16) * ldc + col0;
#pragma unroll
                for (int bj = 0; bj < 2; ++bj) { const f32x4 v0 = acc[ai][bj][m][0], v1 = acc[ai][bj][m][1];
                    u32x4 w; w.x = cvt_pk_bf16(v0[0], v0[1]); w.y = cvt_pk_bf16(v0[2], v0[3]); w.z = cvt_pk_bf16(v1[0], v1[1]); w.w = cvt_pk_bf16(v1[2], v1[3]);
                    *(u32x4*)(rowp + bj * HALF) = w; } }
    }
};
}

#define NTHR 512
#define NWAVE 8

__device__ __forceinline__ void ph_gemm_f32(float* lds, const float* __restrict__ A, const float* __restrict__ B, float* __restrict__ C,
                                            int M, int N, int K, int lda, int ldb, int ldc) {
    const int tid = threadIdx.x & 255, half = threadIdx.x >> 8, tx = tid & 15, ty = tid >> 4;
    float (*As)[68] = (float (*)[68])(lds + half * 2 * 16 * 68);
    float (*Bs)[68] = (float (*)[68])(lds + half * 2 * 16 * 68 + 16 * 68);
    const int ntx = (N + 63) / 64, nty = M / 64, ntiles = ntx * nty;
    for (int it = blockIdx.x; 2 * it < ntiles; it += gridDim.x) {
        const int tile = 2 * it + half;
        const int m0 = (tile / ntx) * 64, n0 = (tile % ntx) * 64;
        float acc[4][4];
#pragma unroll
        for (int i = 0; i < 4; ++i)
#pragma unroll
            for (int j = 0; j < 4; ++j) acc[i][j] = 0.f;
        for (int k0 = 0; k0 < K; k0 += 16) {
#pragma unroll
            for (int i = 0; i < 4; ++i) {
                int idx = tid + i * 256;
                int r = idx >> 4, c = idx & 15;
                As[c][r] = (m0 + r < M) ? A[(size_t)(m0 + r) * lda + k0 + c] : 0.f;
                int rb = idx >> 6, cb = idx & 63;
                Bs[rb][cb] = (n0 + cb < N) ? B[(size_t)(k0 + rb) * ldb + n0 + cb] : 0.f;
            }
            __syncthreads();
#pragma unroll
            for (int k = 0; k < 16; ++k) {
                float a[4], b[4];
#pragma unroll
                for (int i = 0; i < 4; ++i) { a[i] = As[k][ty * 4 + i]; b[i] = Bs[k][tx * 4 + i]; }
#pragma unroll
                for (int i = 0; i < 4; ++i)
#pragma unroll
                    for (int j = 0; j < 4; ++j) acc[i][j] += a[i] * b[j];
            }
            __syncthreads();
        }
#pragma unroll
        for (int i = 0; i < 4; ++i)
#pragma unroll
            for (int j = 0; j < 4; ++j) {
                int r = m0 + ty * 4 + i, c = n0 + tx * 4 + j;
                if (r < M && c < N) C[(size_t)r * ldc + c] = acc[i][j];
            }
    }
}


template <int MODE>
__device__ __forceinline__ void transpose_item(const float* __restrict__ W, int K, int N, int Npad, bf16* __restrict__ WT, LAS float* scr, int item, int lane) {
    const int nblk = Npad / 32, kb = item / nblk, nb = item % nblk, k0 = 64 * kb, n0 = 32 * nb;
    const int n = n0 + (lane & 31);
    int sc = n;
    if (MODE == 1) sc = (n < 4096) ? n : (n < 5632 ? n + 24 : (n < 5656 ? n - 5632 + 4096 : -1));
    else sc = (n < N) ? n : -1;
#pragma unroll 8
    for (int i = 0; i < 32; ++i) { const int kk = 2 * i + (lane >> 5); scr[kk * 33 + (lane & 31)] = (sc >= 0) ? W[(size_t)(k0 + kk) * N + sc] : 0.f; }
    LDS_WAIT(); asm volatile("" ::: "memory");
    const int c = lane & 7;
#pragma unroll
    for (int j = 0; j < 4; ++j) { const int nn = (lane >> 3) + 8 * j; const LAS float* s = scr + (8 * c) * 33 + nn;
        v4u o; o.x = pk2(s[0 * 33], s[1 * 33]); o.y = pk2(s[2 * 33], s[3 * 33]); o.z = pk2(s[4 * 33], s[5 * 33]); o.w = pk2(s[6 * 33], s[7 * 33]);
        *(v4u*)(WT + (size_t)(n0 + nn) * K + k0 + 8 * c) = o; }
    LDS_WAIT(); asm volatile("" ::: "memory");
}
__device__ __forceinline__ void ph_prologue(LAS unsigned char* ldsb, const float* __restrict__ xp, const float* __restrict__ xs, bf16* __restrict__ A0,
                                            const float* __restrict__ w_in, bf16* __restrict__ wt_in, const float* __restrict__ w_out, bf16* __restrict__ wt_out,
                                            const float* __restrict__ w_q, bf16* __restrict__ wt_q) {
    const int lane = threadIdx.x & 63, wave = threadIdx.x >> 6;
    LAS float* scr = (LAS float*)(ldsb + wave * 16384);
    const int gw = blockIdx.x * NWAVE + wave, NGW = gridDim.x * NWAVE;
    constexpr int I_IN = (D_MODEL / 64) * (PROJ_LD / 32), I_OUT = (MIX_WIDTH / 64) * (D_MODEL / 32), I_Q = (D_MODEL / 64) * (2048 / 32);
    for (int it = gw; it < I_IN + I_OUT + I_Q; it += NGW) {
        int r = it;
        if (r < I_IN) { transpose_item<1>(w_in, D_MODEL, IN_WIDTH, PROJ_LD, wt_in, scr, r, lane); continue; } r -= I_IN;
        if (r < I_OUT) { transpose_item<0>(w_out, MIX_WIDTH, D_MODEL, D_MODEL, wt_out, scr, r, lane); continue; } r -= I_OUT;
        transpose_item<0>(w_q, D_MODEL, 2048, 2048, wt_q, scr, r, lane);
    }
    const size_t n8 = (size_t)T_ALL * D_MODEL / 8, np8 = (size_t)T_PROMPT * D_MODEL / 8;
#pragma unroll 4
    for (size_t i = (size_t)blockIdx.x * NTHR + threadIdx.x; i < n8; i += (size_t)gridDim.x * NTHR) {
        const float4* s = (i < np8) ? (const float4*)xp + 2 * i : (const float4*)xs + 2 * (i - np8);
        float4 a = s[0], b = s[1];
        v4u o; o.x = pk2(a.x, a.y); o.y = pk2(a.z, a.w); o.z = pk2(b.x, b.y); o.w = pk2(b.z, b.w);
        ((v4u*)A0)[i] = o;
    }
}

__device__ __forceinline__ void ph_concat_x(const float* __restrict__ xp, const float* __restrict__ xs, float* __restrict__ xall) {
    const size_t n4 = (size_t)T_ALL * D_MODEL / 4, np4 = (size_t)T_PROMPT * D_MODEL / 4;
    for (size_t i = (size_t)blockIdx.x * NTHR + threadIdx.x; i < n4; i += (size_t)gridDim.x * NTHR) {
        float4 v = (i < np4) ? ((const float4*)xp)[i] : ((const float4*)xs)[i - np4];
        ((float4*)xall)[i] = v;
    }
}

typedef float f32x4n __attribute__((ext_vector_type(4)));
__device__ __forceinline__ void ph_cache_copy(const float* __restrict__ ck, const float* __restrict__ cv, float* __restrict__ out) {
    constexpr unsigned PER_B = (WBUF - DEC_SEQ) * ATT_WIDTH / 4;
    constexpr unsigned TOTAL = 2u * DEC_BATCH * PER_B;
    for (unsigned c = blockIdx.x; c < TOTAL / 4096u; c += gridDim.x) {
        f32x4n v[8]; size_t dsti[8]; bool isv[8];
#pragma unroll
        for (int j = 0; j < 8; ++j) {
            const unsigned idx = c * 4096u + j * 512u + threadIdx.x;
            const unsigned tb = idx / PER_B, r = idx - tb * PER_B, bb = tb & (DEC_BATCH - 1);
            isv[j] = tb >= DEC_BATCH;
            const size_t srci = (size_t)bb * (WBUF * ATT_WIDTH / 4) + (DEC_SEQ * ATT_WIDTH / 4) + r;
            dsti[j] = (size_t)bb * (WBUF * ATT_WIDTH / 4) + r;
            v[j] = __builtin_nontemporal_load((isv[j] ? (const f32x4n*)cv : (const f32x4n*)ck) + srci);
        }
#pragma unroll
        for (int j = 0; j < 8; ++j) __builtin_nontemporal_store(v[j], (f32x4n*)(out + (isv[j] ? OUT_SV : OUT_SK)) + dsti[j]);
    }
}

__device__ __forceinline__ void ph_post_proj(const float* __restrict__ proj, const float* __restrict__ state_conv,
                                             const float* __restrict__ conv_w, const float* __restrict__ conv_b, const float* __restrict__ dt_bias,
                                             float* __restrict__ xbc_act, float* __restrict__ dtv, float* __restrict__ qrot, float* __restrict__ krot,
                                             float* __restrict__ out) {
    const int tid = threadIdx.x & 255, half = threadIdx.x >> 8;
    for (int t = 2 * blockIdx.x + half; t < T_ALL; t += 2 * gridDim.x) {
        const bool is_p = t < T_PROMPT;
        int b, i, pos;
        if (is_p) { b = t / SEQ; i = t % SEQ; pos = i; } else { int ts = t - T_PROMPT; b = ts / DEC_SEQ; i = ts % DEC_SEQ; pos = PAST_LEN + i; }
        const float* row = proj + (size_t)t * PROJ_LD;
        for (int c = tid; c < CONV_DIM; c += 256) {
            float acc = conv_b[c];
#pragma unroll
            for (int tap = 0; tap < 4; ++tap) {
                int r = i - 3 + tap;
                float val;
                if (r >= 0) val = proj[(size_t)(t - i + r) * PROJ_LD + O_XBC + c];
                else val = is_p ? 0.f : state_conv[((size_t)b * 3 + (3 + r)) * CONV_DIM + c];
                acc += val * conv_w[tap * CONV_DIM + c];
            }
            xbc_act[(size_t)t * CONV_DIM + c] = silu_f(acc);
        }
        if (tid < SSD_HEADS) dtv[(size_t)t * SSD_HEADS + tid] = softplus_f(row[O_DT + tid] + dt_bias[tid]);
        for (int idx = tid; idx < 512; idx += 256) {
            int which = idx >> 8, h = (idx >> 5) & 7, j = idx & 31;
            double rev = (double)pos * ROPE_INV_REV[j];
            float fr = (float)(rev - floor(rev));
            float sn = __builtin_amdgcn_sinf(fr), cs = __builtin_amdgcn_cosf(fr);
            const float* src = row + (which ? O_K : O_Q) + h * 64;
            float t1 = src[j], t2 = src[j + 32];
            float o1 = t1 * cs - t2 * sn, o2 = t2 * cs + t1 * sn;
            float* dst = (which ? krot : qrot) + (size_t)t * ATT_WIDTH + h * 64;
            dst[j] = o1; dst[j + 32] = o2;
            if (which) {
                if (is_p) { if (i >= SEQ - WBUF) { float* o = out + OUT_PK + ((size_t)b * WBUF + (i - (SEQ - WBUF))) * ATT_WIDTH + h * 64; o[j] = o1; o[j + 32] = o2; } }
                else { float* o = out + OUT_SK + ((size_t)b * WBUF + (WBUF - DEC_SEQ + i)) * ATT_WIDTH + h * 64; o[j] = o1; o[j + 32] = o2; }
            }
        }
        for (int c = tid; c < ATT_WIDTH; c += 256) {
            float v = row[O_V + c];
            if (is_p) { if (i >= SEQ - WBUF) out[OUT_PV + ((size_t)b * WBUF + (i - (SEQ - WBUF))) * ATT_WIDTH + c] = v; }
            else out[OUT_SV + ((size_t)b * WBUF + (WBUF - DEC_SEQ + i)) * ATT_WIDTH + c] = v;
        }
        if (is_p) {
            if (i >= SEQ - 3) { int r = i - (SEQ - 3); for (int c = tid; c < CONV_DIM; c += 256) out[OUT_PC + ((size_t)b * 3 + r) * CONV_DIM + c] = row[O_XBC + c]; }
        } else {
            if (i >= 1) { int r = i - 1; for (int c = tid; c < CONV_DIM; c += 256) out[OUT_SC + ((size_t)b * 3 + r) * CONV_DIM + c] = row[O_XBC + c]; }
        }
    }
}


#define NB_LD 5632
#define NB_XBC 1536
#define NB_Q 4096
#define NB_K 4608
#define NB_V 5120
__device__ __forceinline__ void unpack8(const v4u w, float (&f)[8]) {
    f[0] = __builtin_bit_cast(float, w.x << 16); f[1] = __builtin_bit_cast(float, w.x & 0xffff0000u);
    f[2] = __builtin_bit_cast(float, w.y << 16); f[3] = __builtin_bit_cast(float, w.y & 0xffff0000u);
    f[4] = __builtin_bit_cast(float, w.z << 16); f[5] = __builtin_bit_cast(float, w.z & 0xffff0000u);
    f[6] = __builtin_bit_cast(float, w.w << 16); f[7] = __builtin_bit_cast(float, w.w & 0xffff0000u);
}
__device__ __forceinline__ void store8f(float* d, const float (&f)[8]) { *(float4*)d = make_float4(f[0], f[1], f[2], f[3]); *(float4*)(d + 4) = make_float4(f[4], f[5], f[6], f[7]); }
__device__ __forceinline__ void ph_post_proj2(const bf16* __restrict__ projb, const float* __restrict__ dtraw, const float* __restrict__ state_conv,
                                              const float* __restrict__ conv_w, const float* __restrict__ conv_b, const float* __restrict__ dt_bias,
                                              bf16* __restrict__ xbc_b, float* __restrict__ dtv, bf16* __restrict__ qrot_b, bf16* __restrict__ krot_b,
                                              float* __restrict__ out) {
    const int tid = threadIdx.x & 255, half = threadIdx.x >> 8;
    for (int t = 2 * blockIdx.x + half; t < T_ALL; t += 2 * gridDim.x) {
        const bool is_p = t < T_PROMPT;
        int b, i, pos;
        if (is_p) { b = t / SEQ; i = t % SEQ; pos = i; } else { int ts = t - T_PROMPT; b = ts / DEC_SEQ; i = ts % DEC_SEQ; pos = PAST_LEN + i; }
        const bf16* row = projb + (size_t)t * NB_LD;
        if (tid < 64) {
            float f[8]; unpack8(*(const v4u*)(row + NB_V + tid * 8), f);
            if (is_p) { if (i >= SEQ - WBUF) store8f(out + OUT_PV + ((size_t)b * WBUF + (i - (SEQ - WBUF))) * ATT_WIDTH + tid * 8, f); }
            else store8f(out + OUT_SV + ((size_t)b * WBUF + (WBUF - DEC_SEQ + i)) * ATT_WIDTH + tid * 8, f);
        }
        for (int c8 = tid; c8 < 320; c8 += 256) {
            const int c = c8 * 8;
            float acc[8], cur[8];
            { const float4 b0 = *(const float4*)(conv_b + c), b1 = *(const float4*)(conv_b + c + 4);
              acc[0] = b0.x; acc[1] = b0.y; acc[2] = b0.z; acc[3] = b0.w; acc[4] = b1.x; acc[5] = b1.y; acc[6] = b1.z; acc[7] = b1.w; }
#pragma unroll
            for (int tap = 0; tap < 4; ++tap) {
                const int r = i - 3 + tap;
                float val[8];
                if (r >= 0) unpack8(*(const v4u*)(projb + (size_t)(t - i + r) * NB_LD + NB_XBC + c), val);
                else if (!is_p) { const float* sp = state_conv + ((size_t)b * 3 + (3 + r)) * CONV_DIM + c; const float4 s0 = *(const float4*)sp, s1 = *(const float4*)(sp + 4);
                    val[0] = s0.x; val[1] = s0.y; val[2] = s0.z; val[3] = s0.w; val[4] = s1.x; val[5] = s1.y; val[6] = s1.z; val[7] = s1.w; }
                else {
#pragma unroll
                    for (int j = 0; j < 8; ++j) val[j] = 0.f; }
                const float4 w0 = *(const float4*)(conv_w + tap * CONV_DIM + c), w1 = *(const float4*)(conv_w + tap * CONV_DIM + c + 4);
                acc[0] += val[0] * w0.x; acc[1] += val[1] * w0.y; acc[2] += val[2] * w0.z; acc[3] += val[3] * w0.w;
                acc[4] += val[4] * w1.x; acc[5] += val[5] * w1.y; acc[6] += val[6] * w1.z; acc[7] += val[7] * w1.w;
                if (tap == 3) {
#pragma unroll
                    for (int j = 0; j < 8; ++j) cur[j] = val[j]; }
            }
#pragma unroll
            for (int j = 0; j < 8; ++j) acc[j] = silu_f(acc[j]);
            v4u o; o.x = pk2(acc[0], acc[1]); o.y = pk2(acc[2], acc[3]); o.z = pk2(acc[4], acc[5]); o.w = pk2(acc[6], acc[7]);
            *(v4u*)(xbc_b + (size_t)t * CONV_DIM + c) = o;
            if (is_p) { if (i >= SEQ - 3) store8f(out + OUT_PC + ((size_t)b * 3 + (i - (SEQ - 3))) * CONV_DIM + c, cur); }
            else { if (i >= 1) store8f(out + OUT_SC + ((size_t)b * 3 + (i - 1)) * CONV_DIM + c, cur); }
        }
        if (tid < SSD_HEADS) dtv[(size_t)t * SSD_HEADS + tid] = softplus_f(dtraw[(size_t)t * 32 + tid] + dt_bias[tid]);
        if (tid < 128) {
            const int which = tid >> 6, h = (tid >> 3) & 7, jc = tid & 7;
            const bf16* src = row + (which ? NB_K : NB_Q) + h * 64 + jc * 4;
            const uint2 lo = *(const uint2*)src, hi = *(const uint2*)(src + 32);
            float t1[4], t2[4], o1[4], o2[4];
            t1[0] = __builtin_bit_cast(float, lo.x << 16); t1[1] = __builtin_bit_cast(float, lo.x & 0xffff0000u); t1[2] = __builtin_bit_cast(float, lo.y << 16); t1[3] = __builtin_bit_cast(float, lo.y & 0xffff0000u);
            t2[0] = __builtin_bit_cast(float, hi.x << 16); t2[1] = __builtin_bit_cast(float, hi.x & 0xffff0000u); t2[2] = __builtin_bit_cast(float, hi.y << 16); t2[3] = __builtin_bit_cast(float, hi.y & 0xffff0000u);
#pragma unroll
            for (int e = 0; e < 4; ++e) {
                const double rev = (double)pos * ROPE_INV_REV[jc * 4 + e];
                const float fr = (float)(rev - floor(rev));
                const float sn = __builtin_amdgcn_sinf(fr), cs = __builtin_amdgcn_cosf(fr);
                o1[e] = t1[e] * cs - t2[e] * sn; o2[e] = t2[e] * cs + t1[e] * sn;
            }
            const size_t doff = (size_t)t * ATT_WIDTH + h * 64 + jc * 4;
            bf16* db = which ? krot_b : qrot_b;
            *(uint2*)(db + doff) = make_uint2(pk2(o1[0], o1[1]), pk2(o1[2], o1[3])); *(uint2*)(db + doff + 32) = make_uint2(pk2(o2[0], o2[1]), pk2(o2[2], o2[3]));
            if (which) {
                float* o = nullptr;
                if (is_p) { if (i >= SEQ - WBUF) o = out + OUT_PK + ((size_t)b * WBUF + (i - (SEQ - WBUF))) * ATT_WIDTH + h * 64 + jc * 4; }
                else o = out + OUT_SK + ((size_t)b * WBUF + (WBUF - DEC_SEQ + i)) * ATT_WIDTH + h * 64 + jc * 4;
                if (o) { *(float4*)o = make_float4(o1[0], o1[1], o1[2], o1[3]); *(float4*)(o + 32) = make_float4(o2[0], o2[1], o2[2], o2[3]); }
            }
        }
    }
}

#define SSD_CH 32
__device__ __forceinline__ void ph_ssd_naive(float* lds, const bf16* __restrict__ xbc_act, const float* __restrict__ dtv, const float* __restrict__ a_log,
                                             const float* __restrict__ d_skip, const float* __restrict__ state_ssm, float* __restrict__ ybuf, float* __restrict__ out) {
    float (*sx)[64] = (float (*)[64])lds;
    float (*sB)[128] = (float (*)[128])(lds + SSD_CH * 64);
    float (*sC)[128] = (float (*)[128])(lds + SSD_CH * 64 + SSD_CH * 128);
    float* sdt = lds + SSD_CH * 64 + 2 * SSD_CH * 128;
    const int tid = threadIdx.x, p = tid >> 3, ng = tid & 7;
    for (int vb = BATCH * SSD_HEADS + blockIdx.x; vb < (BATCH + DEC_BATCH) * SSD_HEADS; vb += gridDim.x) {
        const int seq = vb / SSD_HEADS, h = vb % SSD_HEADS, g = h / 6;
        const bool is_p = seq < BATCH;
        const int L = is_p ? SEQ : DEC_SEQ;
        const int t0 = is_p ? seq * SEQ : T_PROMPT + (seq - BATCH) * DEC_SEQ;
        const float A = -__expf(a_log[h]);
        const float D = d_skip[h];
        float hs[16];
        if (is_p) {
#pragma unroll
            for (int j = 0; j < 16; ++j) hs[j] = 0.f;
        } else {
            const float* s0 = state_ssm + (((size_t)(seq - BATCH) * SSD_HEADS + h) * 64 + p) * 128 + ng * 16;
#pragma unroll
            for (int j = 0; j < 16; ++j) hs[j] = s0[j];
        }
        for (int c0 = 0; c0 < L; c0 += SSD_CH) {
            const int nst = (L - c0) < SSD_CH ? (L - c0) : SSD_CH;
            __syncthreads();
            for (int idx = tid; idx < nst * 64; idx += NTHR) { int s = idx >> 6, c = idx & 63; sx[s][c] = bf2f(xbc_act[(size_t)(t0 + c0 + s) * CONV_DIM + h * 64 + c]); }
            for (int idx = tid; idx < nst * 128; idx += NTHR) { int s = idx >> 7, c = idx & 127;
                sB[s][c] = bf2f(xbc_act[(size_t)(t0 + c0 + s) * CONV_DIM + 1536 + g * 128 + c]);
                sC[s][c] = bf2f(xbc_act[(size_t)(t0 + c0 + s) * CONV_DIM + 2048 + g * 128 + c]); }
            if (tid < nst) sdt[tid] = dtv[(size_t)(t0 + c0 + tid) * SSD_HEADS + h];
            __syncthreads();
            for (int s = 0; s < nst; ++s) {
                const float dt = sdt[s], x = sx[s][p];
                const float a = __expf(dt * A), xdt = x * dt;
                float y = 0.f;
#pragma unroll
                for (int j = 0; j < 16; ++j) { hs[j] = a * hs[j] + xdt * sB[s][ng * 16 + j]; y += sC[s][ng * 16 + j] * hs[j]; }
                y += __shfl_xor(y, 1); y += __shfl_xor(y, 2); y += __shfl_xor(y, 4);
                if (ng == 0) ybuf[(size_t)(t0 + c0 + s) * MIX_WIDTH + h * 64 + p] = y + D * x;
            }
        }
        float* so = is_p ? out + OUT_PS + (((size_t)seq * SSD_HEADS + h) * 64 + p) * 128 + ng * 16
                         : out + OUT_SS + (((size_t)(seq - BATCH) * SSD_HEADS + h) * 64 + p) * 128 + ng * 16;
#pragma unroll
        for (int j = 0; j < 16; ++j) so[j] = hs[j];
    }
}

__device__ __forceinline__ void ph_gate_norm(const bf16* __restrict__ projb, const float* __restrict__ norm_g, const float* __restrict__ ybuf, bf16* __restrict__ A1) {
    const int w = threadIdx.x >> 6, lane = threadIdx.x & 63, g = w & 3;
    for (int t = T_PROMPT + 2 * blockIdx.x + (w >> 2); t < T_ALL; t += 2 * gridDim.x) {
        float v[6]; float ss = 0.f;
#pragma unroll
        for (int j = 0; j < 6; ++j) {
            int c = g * 384 + j * 64 + lane;
            float y = ybuf[(size_t)t * MIX_WIDTH + c], z = bf2f(projb[(size_t)t * NB_LD + c]);
            v[j] = y * silu_f(z); ss += v[j] * v[j];
        }
        ss = wave_sum(ss);
        const float r = rsqrtf(ss * (1.0f / 384.0f) + LN_EPS);
#pragma unroll
        for (int j = 0; j < 6; ++j) { int c = g * 384 + j * 64 + lane; A1[(size_t)t * MIX_WIDTH + c] = (bf16)f2bf(v[j] * r * norm_g[c]); }
    }
}

__device__ __forceinline__ void ph_attn_naive(float* lds, const float* __restrict__ proj, const float* __restrict__ qrot, const float* __restrict__ krot,
                                              const float* __restrict__ ck, const float* __restrict__ cv, float* __restrict__ ybuf) {
    float (*sq)[64] = (float (*)[64])lds;
    const int w = threadIdx.x >> 6, lane = threadIdx.x & 63;
    for (int vb = blockIdx.x; vb < T_SAMPLE * 8 / NWAVE; vb += gridDim.x) {
        const int item = T_PROMPT * 8 + vb * NWAVE + w;
        const int t = item >> 3, h = item & 7;
        const bool is_p = t < T_PROMPT;
        int b, i;
        if (is_p) { b = t / SEQ; i = t % SEQ; } else { int ts = t - T_PROMPT; b = ts / DEC_SEQ; i = ts % DEC_SEQ; }
        __syncthreads();
        sq[w][lane] = qrot[(size_t)t * ATT_WIDTH + h * 64 + lane];
        __syncthreads();
        const int qi = is_p ? i : WBUF + i;
        float sc[3][3];
        float mx = -INFINITY;
#pragma unroll
        for (int pt = 0; pt < 3; ++pt) {
            const int d = pt == 0 ? 1 : (pt == 1 ? 4 : 16);
#pragma unroll
            for (int sl = 0; sl < 3; ++sl) {
                const int m = lane + sl * 64;
                float s = -INFINITY;
                const int kj = qi - d * m;
                if (m <= 128 && kj >= 0) {
                    const float* kr;
                    if (is_p) kr = krot + (size_t)(b * SEQ + kj) * ATT_WIDTH + h * 64;
                    else kr = (kj >= WBUF) ? krot + (size_t)(T_PROMPT + b * DEC_SEQ + (kj - WBUF)) * ATT_WIDTH + h * 64
                                           : ck + ((size_t)b * WBUF + kj) * ATT_WIDTH + h * 64;
                    float a = 0.f;
#pragma unroll
                    for (int c = 0; c < 64; c += 4) { float4 kv = *(const float4*)(kr + c); a += kv.x * sq[w][c] + kv.y * sq[w][c + 1] + kv.z * sq[w][c + 2] + kv.w * sq[w][c + 3]; }
                    s = a * 0.125f;
                }
                sc[pt][sl] = s; mx = fmaxf(mx, s);
            }
        }
        mx = wave_max(mx);
        float lsum = 0.f;
#pragma unroll
        for (int pt = 0; pt < 3; ++pt)
#pragma unroll
            for (int sl = 0; sl < 3; ++sl) { float pv = (sc[pt][sl] == -INFINITY) ? 0.f : __expf(sc[pt][sl] - mx); sc[pt][sl] = pv; lsum += pv; }
        lsum = wave_sum(lsum);
        float o = 0.f;
#pragma unroll
        for (int pt = 0; pt < 3; ++pt) {
            const int d = pt == 0 ? 1 : (pt == 1 ? 4 : 16);
#pragma unroll
            for (int sl = 0; sl < 3; ++sl) {
                const int mend = sl < 2 ? 64 : 1;
                for (int ml = 0; ml < mend; ++ml) {
                    const int m = ml + sl * 64;
                    const int kj = qi - d * m;
                    const float pv = __shfl(sc[pt][sl], ml);
                    if (kj < 0) continue;
                    const float* vr;
                    if (is_p) vr = proj + (size_t)(b * SEQ + kj) * PROJ_LD + O_V + h * 64;
                    else vr = (kj >= WBUF) ? proj + (size_t)(T_PROMPT + b * DEC_SEQ + (kj - WBUF)) * PROJ_LD + O_V + h * 64
                                           : cv + ((size_t)b * WBUF + kj) * ATT_WIDTH + h * 64;
                    o += pv * vr[lane];
                }
            }
        }
        ybuf[(size_t)t * MIX_WIDTH + SSD_WIDTH + h * 64 + lane] = o / lsum;
    }
}

__device__ __forceinline__ void ph_ln_res(const float* __restrict__ xp, const float* __restrict__ xs, const float* __restrict__ add, const float* __restrict__ gam,
                                          const float* __restrict__ bet, float* __restrict__ dst, bf16* __restrict__ dstb) {
    const int lane = threadIdx.x & 63;
    for (int t = blockIdx.x * NWAVE + (threadIdx.x >> 6); t < T_ALL; t += gridDim.x * NWAVE) {
        const float* res = (t < T_PROMPT) ? xp + (size_t)t * D_MODEL : xs + (size_t)(t - T_PROMPT) * D_MODEL;
        float v[16]; float s = 0.f;
#pragma unroll
        for (int j = 0; j < 4; ++j) { const int c = j * 256 + lane * 4; const float4 r4 = *(const float4*)(res + c), a4 = *(const float4*)(add + (size_t)t * D_MODEL + c);
            v[4 * j] = ALPHA_F * r4.x + a4.x; v[4 * j + 1] = ALPHA_F * r4.y + a4.y; v[4 * j + 2] = ALPHA_F * r4.z + a4.z; v[4 * j + 3] = ALPHA_F * r4.w + a4.w;
            s += (v[4 * j] + v[4 * j + 1]) + (v[4 * j + 2] + v[4 * j + 3]); }
        s = wave_sum(s);
        const float mu = s * (1.0f / 1024.0f);
        float q = 0.f;
#pragma unroll
        for (int j = 0; j < 16; ++j) { v[j] -= mu; q += v[j] * v[j]; }
        q = wave_sum(q);
        const float r = rsqrtf(q * (1.0f / 1024.0f) + LN_EPS);
#pragma unroll
        for (int j = 0; j < 4; ++j) { const int c = j * 256 + lane * 4; const float4 g4 = *(const float4*)(gam + c), b4 = *(const float4*)(bet + c);
            const float o0 = v[4 * j] * r * g4.x + b4.x, o1 = v[4 * j + 1] * r * g4.y + b4.y, o2 = v[4 * j + 2] * r * g4.z + b4.z, o3 = v[4 * j + 3] * r * g4.w + b4.w;
            *(float4*)(dst + (size_t)t * D_MODEL + c) = make_float4(o0, o1, o2, o3);
            *(uint2*)(dstb + (size_t)t * D_MODEL + c) = make_uint2(pk2(o0, o1), pk2(o2, o3)); }
    }
}

__device__ __forceinline__ void ph_peer_route(float* lds, const float* __restrict__ qh, const float* __restrict__ keys1, const float* __restrict__ keys2,
                                              int* __restrict__ eidx, float* __restrict__ gate) {
    float (*sq)[256] = (float (*)[256])lds;
    float (*sv)[2][16] = (float (*)[2][16])(lds + NWAVE * 256);
    int (*si)[2][16] = (int (*)[2][16])(lds + NWAVE * 256 + NWAVE * 32);
    const int w = threadIdx.x >> 6, lane = threadIdx.x & 63;
    for (int vb = blockIdx.x; vb < T_ALL * 8 / NWAVE; vb += gridDim.x) {
        const int item = vb * NWAVE + w;
        const int t = item >> 3, h = item & 7;
        __syncthreads();
        for (int c = lane; c < 256; c += 64) sq[w][c] = qh[(size_t)t * 2048 + h * 256 + c];
        __syncthreads();
#pragma unroll
        for (int half = 0; half < 2; ++half) {
            const float* keys = half ? keys2 : keys1;
            float s[2];
#pragma unroll
            for (int sl = 0; sl < 2; ++sl) {
                const float* kr = keys + (size_t)(lane + sl * 64) * 128;
                float a = 0.f;
#pragma unroll 8
                for (int c = 0; c < 128; c += 4) { float4 kv = *(const float4*)(kr + c); const float* qq = &sq[w][half * 128 + c]; a += kv.x * qq[0] + kv.y * qq[1] + kv.z * qq[2] + kv.w * qq[3]; }
                s[sl] = a;
            }
            for (int r = 0; r < 16; ++r) {
                float bv; int bi;
                if (s[0] >= s[1]) { bv = s[0]; bi = lane; } else { bv = s[1]; bi = lane + 64; }
#pragma unroll
                for (int o = 32; o > 0; o >>= 1) {
                    float ov = __shfl_xor(bv, o); int oi = __shfl_xor(bi, o);
                    if (ov > bv || (ov == bv && oi < bi)) { bv = ov; bi = oi; }
                }
                if (lane == 0) { sv[w][half][r] = bv; si[w][half][r] = bi; }
                if (bi == lane) s[0] = -INFINITY;
                if (bi == lane + 64) s[1] = -INFINITY;
            }
        }
        __syncthreads();
        float c[4];
#pragma unroll
        for (int j = 0; j < 4; ++j) { int ci = lane * 4 + j; c[j] = sv[w][0][ci >> 4] + sv[w][1][ci & 15]; }
        float myv = 0.f; int myc = 0;
        for (int r = 0; r < 16; ++r) {
            float bv = c[0]; int bi = lane * 4;
#pragma unroll
            for (int j = 1; j < 4; ++j) if (c[j] > bv) { bv = c[j]; bi = lane * 4 + j; }
#pragma unroll
            for (int o = 32; o > 0; o >>= 1) {
                float ov = __shfl_xor(bv, o); int oi = __shfl_xor(bi, o);
                if (ov > bv || (ov == bv && oi < bi)) { bv = ov; bi = oi; }
            }
            if (lane == r) { myv = bv; myc = bi; }
#pragma unroll
            for (int j = 0; j < 4; ++j) if (bi == lane * 4 + j) c[j] = -INFINITY;
        }
        float v = lane < 16 ? myv : -INFINITY;
        float mx = wave_max(v);
        float e = lane < 16 ? __expf(v - mx) : 0.f;
        float sum = wave_sum(e);
        if (lane < 16) {
            int ex = si[w][0][myc >> 4] * PEER_NKEYS + si[w][1][myc & 15];
            eidx[(size_t)t * 128 + h * 16 + lane] = ex;
            gate[(size_t)t * 128 + h * 16 + lane] = e / sum;
        }
    }
}

__device__ __forceinline__ void ph_peer_ffn(const float* __restrict__ hbuf, const int* __restrict__ eidx, const float* __restrict__ gate,
                                            const bf16* __restrict__ ub, const bf16* __restrict__ vb, const float* __restrict__ gam,
                                            const float* __restrict__ bet, float* __restrict__ out) {
    const int lane = threadIdx.x & 63;
    for (int t = blockIdx.x * NWAVE + (threadIdx.x >> 6); t < T_ALL; t += gridDim.x * NWAVE) {
        float x[16], acc[16];
        { const float* xr = hbuf + (size_t)t * D_MODEL + lane * 8;
          const float4 a = *(const float4*)xr, b = *(const float4*)(xr + 4), c = *(const float4*)(xr + 512), d = *(const float4*)(xr + 516);
          x[0] = a.x; x[1] = a.y; x[2] = a.z; x[3] = a.w; x[4] = b.x; x[5] = b.y; x[6] = b.z; x[7] = b.w;
          x[8] = c.x; x[9] = c.y; x[10] = c.z; x[11] = c.w; x[12] = d.x; x[13] = d.y; x[14] = d.z; x[15] = d.w; }
#pragma unroll
        for (int j = 0; j < 16; ++j) acc[j] = 0.f;
        for (int k = 0; k < 128; ++k) {
            const int e = eidx[(size_t)t * 128 + k];
            const float g = gate[(size_t)t * 128 + k];
            const bf16* ur = ub + (size_t)e * D_MODEL + lane * 8;
            float u0[8], u1[8];
            unpack8(*(const v4u*)ur, u0); unpack8(*(const v4u*)(ur + 512), u1);
            float d = 0.f;
#pragma unroll
            for (int j = 0; j < 8; ++j) d += u0[j] * x[j] + u1[j] * x[8 + j];
            d = wave_sum(d);
            const float wgt = g * gelu_f(d);
            const bf16* vr = vb + (size_t)e * D_MODEL + lane * 8;
            unpack8(*(const v4u*)vr, u0); unpack8(*(const v4u*)(vr + 512), u1);
#pragma unroll
            for (int j = 0; j < 8; ++j) { acc[j] += wgt * u0[j]; acc[8 + j] += wgt * u1[j]; }
        }
        float s = 0.f;
#pragma unroll
        for (int j = 0; j < 16; ++j) { acc[j] += ALPHA_F * x[j]; s += acc[j]; }
        s = wave_sum(s);
        const float mu = s * (1.0f / 1024.0f);
        float q = 0.f;
#pragma unroll
        for (int j = 0; j < 16; ++j) { acc[j] -= mu; q += acc[j] * acc[j]; }
        q = wave_sum(q);
        const float r = rsqrtf(q * (1.0f / 1024.0f) + LN_EPS);
        float* dst = ((t < T_PROMPT) ? out + OUT_YP + (size_t)t * D_MODEL : out + OUT_YS + (size_t)(t - T_PROMPT) * D_MODEL) + lane * 8;
#pragma unroll
        for (int q4 = 0; q4 < 4; ++q4) {
            const int eo = (q4 >> 1) * 512 + (q4 & 1) * 4;
            const float4 g4 = *(const float4*)(gam + lane * 8 + eo), b4 = *(const float4*)(bet + lane * 8 + eo);
            float4 o; o.x = acc[q4 * 4 + 0] * r * g4.x + b4.x; o.y = acc[q4 * 4 + 1] * r * g4.y + b4.y; o.z = acc[q4 * 4 + 2] * r * g4.z + b4.z; o.w = acc[q4 * 4 + 3] * r * g4.w + b4.w;
            *(float4*)(dst + eo) = o;
        }
    }
}

__device__ __forceinline__ float peer_dot16(const v4u a, const v4u b, const float (&x)[16]) {
    float u0[8], u1[8]; unpack8(a, u0); unpack8(b, u1);
    float d = 0.f;
#pragma unroll
    for (int j = 0; j < 8; ++j) d += u0[j] * x[j] + u1[j] * x[8 + j];
    return d;
}
#define PEER_TR_STEP(N, M) _Pragma("unroll") for (int i = 0; i < N; ++i) { const bool up = (lane & M) != 0; const float keep = up ? part[i + N] : part[i]; const float send = up ? part[i] : part[i + N]; part[i] = keep + __shfl_xor(send, M); }
__device__ __forceinline__ void ph_peer_ffn2(const float* __restrict__ hbuf, const int* __restrict__ eidx, const float* __restrict__ gate,
                                             const bf16* __restrict__ ub, const bf16* __restrict__ vb, const float* __restrict__ gam,
                                             const float* __restrict__ bet, float* __restrict__ out) {
    const int lane0 = threadIdx.x & 63;
    for (int t = blockIdx.x * NWAVE + (threadIdx.x >> 6); t < T_ALL; t += gridDim.x * NWAVE) {
        int lane = lane0; asm volatile("" : "+v"(lane));
        float x[16];
        { const float* xr = hbuf + (size_t)t * D_MODEL + lane * 8;
          const float4 a = *(const float4*)xr, b = *(const float4*)(xr + 4), c = *(const float4*)(xr + 512), d = *(const float4*)(xr + 516);
          x[0] = a.x; x[1] = a.y; x[2] = a.z; x[3] = a.w; x[4] = b.x; x[5] = b.y; x[6] = b.z; x[7] = b.w;
          x[8] = c.x; x[9] = c.y; x[10] = c.z; x[11] = c.w; x[12] = d.x; x[13] = d.y; x[14] = d.z; x[15] = d.w; }
        int ev[2]; float wv[4];
        ev[0] = eidx[(size_t)t * 128 + lane]; ev[1] = eidx[(size_t)t * 128 + 64 + lane];
#pragma unroll
        for (int rd = 0; rd < 4; ++rd) wv[rd] = gate[(size_t)t * 128 + rd * 32 + (lane >> 1)];
#pragma unroll
        for (int rd = 0; rd < 4; ++rd) {
            float part[32];
#pragma unroll
            for (int kb = 0; kb < 8; ++kb) {
                v4u ra[4], rb[4];
#pragma unroll
                for (int k8 = 0; k8 < 4; ++k8) {
                    const int e = __builtin_amdgcn_readlane(ev[rd >> 1], (rd & 1) * 32 + kb * 4 + k8);
                    const bf16* ur = ub + (size_t)e * D_MODEL + lane * 8;
                    ra[k8] = *(const v4u*)ur; rb[k8] = *(const v4u*)(ur + 512);
                }
#pragma unroll
                for (int k8 = 0; k8 < 4; ++k8) part[kb * 4 + k8] = peer_dot16(ra[k8], rb[k8], x);
            }
            PEER_TR_STEP(16, 32) PEER_TR_STEP(8, 16) PEER_TR_STEP(4, 8) PEER_TR_STEP(2, 4) PEER_TR_STEP(1, 2)
            const float hid = part[0] + __shfl_xor(part[0], 1);
            wv[rd] *= gelu_f(hid);
        }
        float acc[16];
#pragma unroll
        for (int j = 0; j < 16; ++j) acc[j] = 0.f;
#pragma unroll
        for (int rd = 0; rd < 4; ++rd) {
#pragma unroll
            for (int kb = 0; kb < 4; ++kb) {
                v4u ra[8], rb[8];
#pragma unroll
                for (int k8 = 0; k8 < 8; ++k8) {
                    const int e = __builtin_amdgcn_readlane(ev[rd >> 1], (rd & 1) * 32 + kb * 8 + k8);
                    const bf16* vr = vb + (size_t)e * D_MODEL + lane * 8;
                    ra[k8] = *(const v4u*)vr; rb[k8] = *(const v4u*)(vr + 512);
                }
#pragma unroll
                for (int k8 = 0; k8 < 8; ++k8) {
                    const float wk = __builtin_bit_cast(float, __builtin_amdgcn_readlane(__builtin_bit_cast(int, wv[rd]), 2 * (kb * 8 + k8)));
                    float u0[8], u1[8]; unpack8(ra[k8], u0); unpack8(rb[k8], u1);
#pragma unroll
                    for (int j = 0; j < 8; ++j) { acc[j] += wk * u0[j]; acc[8 + j] += wk * u1[j]; }
                }
            }
        }
        float s = 0.f;
#pragma unroll
        for (int j = 0; j < 16; ++j) { acc[j] += ALPHA_F * x[j]; s += acc[j]; }
        s = wave_sum(s);
        const float mu = s * (1.0f / 1024.0f);
        float q = 0.f;
#pragma unroll
        for (int j = 0; j < 16; ++j) { acc[j] -= mu; q += acc[j] * acc[j]; }
        q = wave_sum(q);
        const float r = rsqrtf(q * (1.0f / 1024.0f) + LN_EPS);
        float* dst = ((t < T_PROMPT) ? out + OUT_YP + (size_t)t * D_MODEL : out + OUT_YS + (size_t)(t - T_PROMPT) * D_MODEL) + lane * 8;
#pragma unroll
        for (int q4 = 0; q4 < 4; ++q4) {
            const int eo = (q4 >> 1) * 512 + (q4 & 1) * 4;
            const float4 g4 = *(const float4*)(gam + lane * 8 + eo), b4 = *(const float4*)(bet + lane * 8 + eo);
            float4 o; o.x = acc[q4 * 4 + 0] * r * g4.x + b4.x; o.y = acc[q4 * 4 + 1] * r * g4.y + b4.y; o.z = acc[q4 * 4 + 2] * r * g4.z + b4.z; o.w = acc[q4 * 4 + 3] * r * g4.w + b4.w;
            *(float4*)(dst + eo) = o;
        }
    }
}

__device__ __forceinline__ void ph_attn_sample(float* lds, const bf16* __restrict__ qrot_b, const bf16* __restrict__ krot_b, const bf16* __restrict__ projb,
                                               const float* __restrict__ ck, const float* __restrict__ cv, bf16* __restrict__ A1) {
    float (*sq)[64] = (float (*)[64])lds;
    const int w = threadIdx.x >> 6, lane0 = threadIdx.x & 63;
    for (int vb = blockIdx.x; vb < T_SAMPLE * 8 / NWAVE; vb += gridDim.x) {
        int lane = lane0; asm volatile("" : "+v"(lane));
        const int item = vb * NWAVE + w, ts = item >> 3, hd = item & 7, b = ts >> 2, i = ts & 3, t = T_PROMPT + ts;
        __syncthreads();
        sq[w][lane] = bf2f(qrot_b[(size_t)t * ATT_WIDTH + hd * 64 + lane]);
        __syncthreads();
        const int qi = WBUF + i;
        float sc[8];
        float mx = -INFINITY;
#pragma unroll
        for (int slot = 0; slot < 7; ++slot) {
            const int pt = slot < 6 ? (slot >> 1) : (lane < 3 ? lane : 0);
            const int m = slot < 6 ? lane + 64 * (slot & 1) : 128;
            const int kj = qi - (m << (2 * pt));
            const bool valid = (slot < 6 || lane < 3) && kj < WBUF;
            const int kc = kj < WBUF ? kj : WBUF - 1;
            const float* kr = ck + ((size_t)b * WBUF + kc) * ATT_WIDTH + hd * 64;
            float a = 0.f;
#pragma unroll
            for (int c = 0; c < 64; c += 4) { const float4 kv = *(const float4*)(kr + c); a += kv.x * sq[w][c] + kv.y * sq[w][c + 1] + kv.z * sq[w][c + 2] + kv.w * sq[w][c + 3]; }
            const float s = valid ? a * 0.125f : -INFINITY;
            sc[slot] = s; mx = fmaxf(mx, s);
        }
        const int nt7 = lane <= i ? i - lane : i;
        const bool valid7 = lane < i + 3;
        {
            const bf16* kr = krot_b + (size_t)(T_PROMPT + b * DEC_SEQ + nt7) * ATT_WIDTH + hd * 64;
            float a = 0.f;
#pragma unroll
            for (int c = 0; c < 64; c += 8) { float f[8]; unpack8(*(const v4u*)(kr + c), f);
#pragma unroll
                for (int j = 0; j < 8; ++j) a += f[j] * sq[w][c + j]; }
            const float s = valid7 ? a * 0.125f : -INFINITY;
            sc[7] = s; mx = fmaxf(mx, s);
        }
        mx = wave_max(mx);
        float lsum = 0.f;
#pragma unroll
        for (int slot = 0; slot < 8; ++slot) { const float pv = __expf(sc[slot] - mx); sc[slot] = pv; lsum += pv; }
        lsum = wave_sum(lsum);
        float part[64];
#pragma unroll
        for (int c = 0; c < 64; ++c) part[c] = 0.f;
#pragma unroll
        for (int slot = 0; slot < 7; ++slot) {
            const int pt = slot < 6 ? (slot >> 1) : (lane < 3 ? lane : 0);
            const int m = slot < 6 ? lane + 64 * (slot & 1) : 128;
            const int kj = qi - (m << (2 * pt));
            const int kc = kj < WBUF ? kj : WBUF - 1;
            const float pv = sc[slot];
            const float* vr = cv + ((size_t)b * WBUF + kc) * ATT_WIDTH + hd * 64;
#pragma unroll
            for (int c = 0; c < 64; c += 4) { const float4 vv = *(const float4*)(vr + c); part[c] += pv * vv.x; part[c + 1] += pv * vv.y; part[c + 2] += pv * vv.z; part[c + 3] += pv * vv.w; }
        }
        {
            const float pv = sc[7];
            const bf16* vr = projb + (size_t)(T_PROMPT + b * DEC_SEQ + nt7) * NB_LD + NB_V + hd * 64;
#pragma unroll
            for (int c = 0; c < 64; c += 8) { float f[8]; unpack8(*(const v4u*)(vr + c), f);
#pragma unroll
                for (int j = 0; j < 8; ++j) part[c + j] += pv * f[j]; }
        }
        PEER_TR_STEP(32, 32) PEER_TR_STEP(16, 16) PEER_TR_STEP(8, 8) PEER_TR_STEP(4, 4) PEER_TR_STEP(2, 2) PEER_TR_STEP(1, 1)
        A1[(size_t)t * MIX_WIDTH + SSD_WIDTH + hd * 64 + lane] = (bf16)f2bf(part[0] / lsum);
    }
}


__device__ __forceinline__ void cache_copy_slice(const float* __restrict__ ck, const float* __restrict__ cv, float* __restrict__ out, unsigned slice, unsigned lane) {
    constexpr unsigned PER_B = (WBUF - DEC_SEQ) * ATT_WIDTH / 4;
    constexpr unsigned TOTAL = 2u * DEC_BATCH * PER_B;
#pragma unroll 1
    for (unsigned bt = 0; bt < 8; ++bt) {
        f32x4n v[8]; size_t dsti[8]; bool isv[8]; bool ok[8];
#pragma unroll
        for (int j = 0; j < 8; ++j) {
            const unsigned idx = slice * 4096u + bt * 512u + j * 64u + lane;
            ok[j] = idx < TOTAL;
            const unsigned idc = ok[j] ? idx : 0u;
            const unsigned tb = idc / PER_B, r = idc - tb * PER_B, bb = tb & (DEC_BATCH - 1);
            isv[j] = tb >= DEC_BATCH;
            const size_t srci = (size_t)bb * (WBUF * ATT_WIDTH / 4) + (DEC_SEQ * ATT_WIDTH / 4) + r;
            dsti[j] = (size_t)bb * (WBUF * ATT_WIDTH / 4) + r;
            v[j] = __builtin_nontemporal_load((isv[j] ? (const f32x4n*)cv : (const f32x4n*)ck) + srci);
        }
#pragma unroll
        for (int j = 0; j < 8; ++j) if (ok[j]) __builtin_nontemporal_store(v[j], (f32x4n*)(out + (isv[j] ? OUT_SV : OUT_SK)) + dsti[j]);
    }
}
typedef float f32x2v __attribute__((ext_vector_type(2)));
__device__ __forceinline__ void ph_quant_tables(const float* __restrict__ pu, const float* __restrict__ pv, unsigned char* __restrict__ ub8, unsigned char* __restrict__ vb8,
                                                float* __restrict__ usc, float* __restrict__ vsc) {
    const int lane = threadIdx.x & 63;
#pragma unroll 2
    for (int row = blockIdx.x * NWAVE + (threadIdx.x >> 6); row < 2 * 16384; row += gridDim.x * NWAVE) {
        const int rr = row & 16383; const bool isv = row >= 16384;
        const float* src = (isv ? pv : pu) + (size_t)rr * D_MODEL + lane * 8;
        const float4 a = *(const float4*)src, b = *(const float4*)(src + 4), c = *(const float4*)(src + 512), d = *(const float4*)(src + 516);
        float am = fmaxf(fmaxf(fmaxf(fabsf(a.x), fabsf(a.y)), fmaxf(fabsf(a.z), fabsf(a.w))), fmaxf(fmaxf(fabsf(b.x), fabsf(b.y)), fmaxf(fabsf(b.z), fabsf(b.w))));
        am = fmaxf(am, fmaxf(fmaxf(fmaxf(fabsf(c.x), fabsf(c.y)), fmaxf(fabsf(c.z), fabsf(c.w))), fmaxf(fmaxf(fabsf(d.x), fabsf(d.y)), fmaxf(fabsf(d.z), fabsf(d.w)))));
        am = wave_max(am);
        const float sc = am > 0.f ? 224.0f / am : 1.0f;
        v4u o;
        o.x = (unsigned)__builtin_amdgcn_cvt_pk_fp8_f32(a.z * sc, a.w * sc, __builtin_amdgcn_cvt_pk_fp8_f32(a.x * sc, a.y * sc, 0, false), true);
        o.y = (unsigned)__builtin_amdgcn_cvt_pk_fp8_f32(b.z * sc, b.w * sc, __builtin_amdgcn_cvt_pk_fp8_f32(b.x * sc, b.y * sc, 0, false), true);
        o.z = (unsigned)__builtin_amdgcn_cvt_pk_fp8_f32(c.z * sc, c.w * sc, __builtin_amdgcn_cvt_pk_fp8_f32(c.x * sc, c.y * sc, 0, false), true);
        o.w = (unsigned)__builtin_amdgcn_cvt_pk_fp8_f32(d.z * sc, d.w * sc, __builtin_amdgcn_cvt_pk_fp8_f32(d.x * sc, d.y * sc, 0, false), true);
        *(v4u*)((isv ? vb8 : ub8) + (size_t)rr * 1024 + lane * 16) = o;
        if (lane == 0) (isv ? vsc : usc)[rr] = am > 0.f ? am * (1.0f / 224.0f) : 1.0f;
    }
}
__device__ __forceinline__ void unpack16_fp8(const v4u w, float (&f)[16]) {
#pragma unroll
    for (int i = 0; i < 4; ++i) {
        const f32x2v lo = __builtin_amdgcn_cvt_pk_f32_fp8((int)w[i], false), hi = __builtin_amdgcn_cvt_pk_f32_fp8((int)w[i], true);
        f[4 * i] = lo[0]; f[4 * i + 1] = lo[1]; f[4 * i + 2] = hi[0]; f[4 * i + 3] = hi[1];
    }
}
__device__ __forceinline__ void ph_peer_ffn3(const float* __restrict__ hbuf, const int* __restrict__ eidx, const float* __restrict__ gate,
                                             const unsigned char* __restrict__ ub8, const unsigned char* __restrict__ vb8, const float* __restrict__ usc, const float* __restrict__ vsc,
                                             const float* __restrict__ gam, const float* __restrict__ bet, float* __restrict__ out,
                                             const float* __restrict__ ck, const float* __restrict__ cv) {
    const int lane0 = threadIdx.x & 63;
    unsigned it = 0;
    for (int t = blockIdx.x * NWAVE + (threadIdx.x >> 6); t < T_ALL; t += gridDim.x * NWAVE, ++it) {
        int lane = lane0; asm volatile("" : "+v"(lane));
        if (it < 8) cache_copy_slice(ck, cv, out, (blockIdx.x * NWAVE + (threadIdx.x >> 6)) * 8u + it, (unsigned)lane);
        const unsigned lo16 = (unsigned)lane * 16u, lo8 = (unsigned)lane * 8u;
        float x[16];
        { const float* xr = hbuf + (size_t)t * D_MODEL + lo8;
          const float4 a = *(const float4*)xr, b = *(const float4*)(xr + 4), c = *(const float4*)(xr + 512), d = *(const float4*)(xr + 516);
          x[0] = a.x; x[1] = a.y; x[2] = a.z; x[3] = a.w; x[4] = b.x; x[5] = b.y; x[6] = b.z; x[7] = b.w;
          x[8] = c.x; x[9] = c.y; x[10] = c.z; x[11] = c.w; x[12] = d.x; x[13] = d.y; x[14] = d.z; x[15] = d.w; }
        int ev[2]; float wv[4], su[4];
        ev[0] = eidx[(size_t)t * 128 + lane]; ev[1] = eidx[(size_t)t * 128 + 64 + lane];
#pragma unroll
        for (int rd = 0; rd < 4; ++rd) {
            const int er = eidx[(size_t)t * 128 + rd * 32 + (lane >> 1)];
            wv[rd] = gate[(size_t)t * 128 + rd * 32 + (lane >> 1)] * vsc[er];
            su[rd] = usc[er];
        }
#pragma unroll
        for (int rd = 0; rd < 4; ++rd) {
            float part[32];
#pragma unroll
            for (int kb = 0; kb < 8; ++kb) {
                v4u ra[4];
#pragma unroll
                for (int k8 = 0; k8 < 4; ++k8) {
                    const int e = __builtin_amdgcn_readlane(ev[rd >> 1], (rd & 1) * 32 + kb * 4 + k8);
                    ra[k8] = *(const v4u*)(ub8 + (size_t)e * 1024 + lo16);
                }
#pragma unroll
                for (int k8 = 0; k8 < 4; ++k8) {
                    float f[16]; unpack16_fp8(ra[k8], f);
                    float d = 0.f;
#pragma unroll
                    for (int j = 0; j < 16; ++j) d += f[j] * x[j];
                    part[kb * 4 + k8] = d;
                }
            }
            PEER_TR_STEP(16, 32) PEER_TR_STEP(8, 16) PEER_TR_STEP(4, 8) PEER_TR_STEP(2, 4) PEER_TR_STEP(1, 2)
            const float hid = (part[0] + __shfl_xor(part[0], 1)) * su[rd];
            wv[rd] *= gelu_f(hid);
        }
        float acc[16];
#pragma unroll
        for (int j = 0; j < 16; ++j) acc[j] = 0.f;
#pragma unroll
        for (int rd = 0; rd < 4; ++rd) {
#pragma unroll
            for (int kb = 0; kb < 4; ++kb) {
                v4u ra[8];
#pragma unroll
                for (int k8 = 0; k8 < 8; ++k8) {
                    const int e = __builtin_amdgcn_readlane(ev[rd >> 1], (rd & 1) * 32 + kb * 8 + k8);
                    ra[k8] = *(const v4u*)(vb8 + (size_t)e * 1024 + lo16);
                }
#pragma unroll
                for (int k8 = 0; k8 < 8; ++k8) {
                    const float wk = __builtin_bit_cast(float, __builtin_amdgcn_readlane(__builtin_bit_cast(int, wv[rd]), 2 * (kb * 8 + k8)));
                    float f[16]; unpack16_fp8(ra[k8], f);
#pragma unroll
                    for (int j = 0; j < 16; ++j) acc[j] += wk * f[j];
                }
            }
        }
        float s = 0.f;
#pragma unroll
        for (int j = 0; j < 16; ++j) { acc[j] += ALPHA_F * x[j]; s += acc[j]; }
        s = wave_sum(s);
        const float mu = s * (1.0f / 1024.0f);
        float q = 0.f;
#pragma unroll
        for (int j = 0; j < 16; ++j) { acc[j] -= mu; q += acc[j] * acc[j]; }
        q = wave_sum(q);
        const float r = rsqrtf(q * (1.0f / 1024.0f) + LN_EPS);
        float* dst = ((t < T_PROMPT) ? out + OUT_YP + (size_t)t * D_MODEL : out + OUT_YS + (size_t)(t - T_PROMPT) * D_MODEL) + lo8;
#pragma unroll
        for (int q4 = 0; q4 < 4; ++q4) {
            const int eo = (q4 >> 1) * 512 + (q4 & 1) * 4;
            const float4 g4 = *(const float4*)(gam + lo8 + eo), b4 = *(const float4*)(bet + lo8 + eo);
            float4 o; o.x = acc[q4 * 4 + 0] * r * g4.x + b4.x; o.y = acc[q4 * 4 + 1] * r * g4.y + b4.y; o.z = acc[q4 * 4 + 2] * r * g4.z + b4.z; o.w = acc[q4 * 4 + 3] * r * g4.w + b4.w;
            *(float4*)(dst + eo) = o;
        }
    }
}

typedef float f32x16 __attribute__((ext_vector_type(16)));
typedef short s16x8 __attribute__((ext_vector_type(8)));
typedef short s16x4 __attribute__((ext_vector_type(4)));
typedef float f32x4v __attribute__((ext_vector_type(4)));
#define SSD_L_ACS 0
#define SSD_L_DTS 3072
#define SSD_L_BM 6144
#define SSD_RS_B 272
#define SSD_L_X (6144 + 128 * 272)
#define SSD_RS_X 144
#define SSD_XIMG (128 * 144)
#define SSD_RS_Y 784
template <int OFF0, int OFF1>
__device__ __forceinline__ s16x8 tr_frag(unsigned base) {
    s16x4 a, b;
    asm volatile("ds_read_b64_tr_b16 %0, %2 offset:%3\n\tds_read_b64_tr_b16 %1, %2 offset:%4\n\ts_waitcnt lgkmcnt(0)"
                 : "=&v"(a), "=&v"(b) : "v"(base), "n"(OFF0), "n"(OFF1) : "memory");
    return __builtin_shufflevector(a, b, 0, 1, 2, 3, 4, 5, 6, 7);
}
__device__ __forceinline__ unsigned lds_addr(LAS unsigned char* p) { return (unsigned)(size_t)p; }

__device__ __forceinline__ void ssd_chunk_acs(LAS unsigned char* ldsb, const float* __restrict__ dtv, const float* __restrict__ a_log, int t0, int g, float* cdec_out) {
    const int w = __builtin_amdgcn_readfirstlane(threadIdx.x >> 6), lane = threadIdx.x & 63;
    if (w < 6) {
        const int head = 6 * g + w;
        const float A = -__expf(a_log[head]);
        const float v0 = dtv[(size_t)(t0 + 2 * lane) * SSD_HEADS + head], v1 = dtv[(size_t)(t0 + 2 * lane + 1) * SSD_HEADS + head];
        const float a1 = v1 * A;
        float s = v0 * A + a1;
#pragma unroll
        for (int o = 1; o < 64; o <<= 1) { const float tmp = __shfl_up(s, o); if (lane >= o) s += tmp; }
        LAS float* acs = (LAS float*)(ldsb + SSD_L_ACS) + w * 128;
        LAS float* dts = (LAS float*)(ldsb + SSD_L_DTS) + w * 128;
        acs[2 * lane] = s - a1; acs[2 * lane + 1] = s;
        dts[2 * lane] = v0; dts[2 * lane + 1] = v1;
        if (cdec_out && lane == 63) cdec_out[head] = __expf(s);
    }
}

__device__ __forceinline__ void ph_ssd_states(LAS unsigned char* ldsb, const bf16* __restrict__ xbc_b, const float* __restrict__ dtv, const float* __restrict__ a_log,
                                              bf16* __restrict__ Sbuf, float* __restrict__ cdec) {
    const int tid = threadIdx.x, w = __builtin_amdgcn_readfirstlane(tid >> 6), lane = tid & 63;
    const int r = lane & 31, h = lane >> 5, blk = (lane >> 4) & 1, q = (lane & 15) >> 2, pp = lane & 3;
    const int nt = w & 3, pt = w >> 2;
    for (int unit = blockIdx.x; unit < BATCH * 64 * SSD_GROUPS; unit += gridDim.x) {
        const int g = unit & 3, bc = unit >> 2;
        const int t0 = bc * 128;
        __syncthreads();
        ssd_chunk_acs(ldsb, dtv, a_log, t0, g, cdec + (size_t)bc * SSD_HEADS);
        for (int idx = tid; idx < 2048; idx += NTHR) { const int row = idx >> 4, ch = idx & 15;
            const v4u v = *(const v4u*)(xbc_b + (size_t)(t0 + row) * CONV_DIM + 1536 + 128 * g + ch * 8);
            *(LAS v4u*)(ldsb + SSD_L_BM + row * SSD_RS_B + ch * 16) = v; }
        __syncthreads();
        for (int idx = tid; idx < 6144; idx += NTHR) { const int hh = idx >> 10, rem = idx & 1023, row = rem >> 3, ch = rem & 7;
            const LAS float* acs = (const LAS float*)(ldsb + SSD_L_ACS) + hh * 128; const LAS float* dts = (const LAS float*)(ldsb + SSD_L_DTS) + hh * 128;
            const float wgt = dts[row] * __expf(acs[127] - acs[row]);
            float f[8]; unpack8(*(const v4u*)(xbc_b + (size_t)(t0 + row) * CONV_DIM + (6 * g + hh) * 64 + ch * 8), f);
            v4u o; o.x = pk2(f[0] * wgt, f[1] * wgt); o.y = pk2(f[2] * wgt, f[3] * wgt); o.z = pk2(f[4] * wgt, f[5] * wgt); o.w = pk2(f[6] * wgt, f[7] * wgt);
            *(LAS v4u*)(ldsb + SSD_L_X + hh * SSD_XIMG + row * SSD_RS_X + ch * 16) = o; }
        __syncthreads();
        const unsigned abase = lds_addr(ldsb + SSD_L_BM) + (8 * h + q) * SSD_RS_B + (32 * nt + 16 * blk + 4 * pp) * 2;
        s16x8 afr[8];
        afr[0] = tr_frag<0 * 16 * SSD_RS_B, (0 * 16 + 4) * SSD_RS_B>(abase); afr[1] = tr_frag<1 * 16 * SSD_RS_B, (1 * 16 + 4) * SSD_RS_B>(abase);
        afr[2] = tr_frag<2 * 16 * SSD_RS_B, (2 * 16 + 4) * SSD_RS_B>(abase); afr[3] = tr_frag<3 * 16 * SSD_RS_B, (3 * 16 + 4) * SSD_RS_B>(abase);
        afr[4] = tr_frag<4 * 16 * SSD_RS_B, (4 * 16 + 4) * SSD_RS_B>(abase); afr[5] = tr_frag<5 * 16 * SSD_RS_B, (5 * 16 + 4) * SSD_RS_B>(abase);
        afr[6] = tr_frag<6 * 16 * SSD_RS_B, (6 * 16 + 4) * SSD_RS_B>(abase); afr[7] = tr_frag<7 * 16 * SSD_RS_B, (7 * 16 + 4) * SSD_RS_B>(abase);
#pragma unroll
        for (int hh = 0; hh < 6; ++hh) {
            const unsigned xb = lds_addr(ldsb + SSD_L_X + hh * SSD_XIMG) + (8 * h + q) * SSD_RS_X + (32 * pt + 16 * blk + 4 * pp) * 2;
            f32x16 acc;
#pragma unroll
            for (int i = 0; i < 16; ++i) acc[i] = 0.f;
            acc = __builtin_amdgcn_mfma_f32_32x32x16_bf16(afr[0], tr_frag<0 * 16 * SSD_RS_X, (0 * 16 + 4) * SSD_RS_X>(xb), acc, 0, 0, 0);
            acc = __builtin_amdgcn_mfma_f32_32x32x16_bf16(afr[1], tr_frag<1 * 16 * SSD_RS_X, (1 * 16 + 4) * SSD_RS_X>(xb), acc, 0, 0, 0);
            acc = __builtin_amdgcn_mfma_f32_32x32x16_bf16(afr[2], tr_frag<2 * 16 * SSD_RS_X, (2 * 16 + 4) * SSD_RS_X>(xb), acc, 0, 0, 0);
            acc = __builtin_amdgcn_mfma_f32_32x32x16_bf16(afr[3], tr_frag<3 * 16 * SSD_RS_X, (3 * 16 + 4) * SSD_RS_X>(xb), acc, 0, 0, 0);
            acc = __builtin_amdgcn_mfma_f32_32x32x16_bf16(afr[4], tr_frag<4 * 16 * SSD_RS_X, (4 * 16 + 4) * SSD_RS_X>(xb), acc, 0, 0, 0);
            acc = __builtin_amdgcn_mfma_f32_32x32x16_bf16(afr[5], tr_frag<5 * 16 * SSD_RS_X, (5 * 16 + 4) * SSD_RS_X>(xb), acc, 0, 0, 0);
            acc = __builtin_amdgcn_mfma_f32_32x32x16_bf16(afr[6], tr_frag<6 * 16 * SSD_RS_X, (6 * 16 + 4) * SSD_RS_X>(xb), acc, 0, 0, 0);
            acc = __builtin_amdgcn_mfma_f32_32x32x16_bf16(afr[7], tr_frag<7 * 16 * SSD_RS_X, (7 * 16 + 4) * SSD_RS_X>(xb), acc, 0, 0, 0);
            bf16* dst = Sbuf + (((size_t)bc * SSD_HEADS + 6 * g + hh) * 64 + 32 * pt + r) * 128 + 32 * nt + 4 * h;
#pragma unroll
            for (int q4 = 0; q4 < 4; ++q4) *(uint2*)(dst + 8 * q4) = make_uint2(pk2(acc[4 * q4], acc[4 * q4 + 1]), pk2(acc[4 * q4 + 2], acc[4 * q4 + 3]));
        }
    }
}

__device__ __forceinline__ void ph_ssd_scan(const bf16* __restrict__ Sbuf, const float* __restrict__ cdec, bf16* __restrict__ Hin, float* __restrict__ out) {
    for (int idx = blockIdx.x * NTHR + threadIdx.x; idx < BATCH * SSD_HEADS * 64 * 16; idx += gridDim.x * NTHR) {
        const int n8 = idx & 15, p = (idx >> 4) & 63, hb = idx >> 10, hd = hb % SSD_HEADS, b = hb / SSD_HEADS;
        float st[8];
#pragma unroll
        for (int j = 0; j < 8; ++j) st[j] = 0.f;
#pragma unroll 8
        for (int c = 0; c < 64; ++c) {
            const size_t base = ((((size_t)(b * 64 + c)) * SSD_HEADS + hd) * 64 + p) * 128 + n8 * 8;
            v4u o; o.x = pk2(st[0], st[1]); o.y = pk2(st[2], st[3]); o.z = pk2(st[4], st[5]); o.w = pk2(st[6], st[7]);
            *(v4u*)(Hin + base) = o;
            float s[8]; unpack8(*(const v4u*)(Sbuf + base), s);
            const float a = cdec[(size_t)(b * 64 + c) * SSD_HEADS + hd];
#pragma unroll
            for (int j = 0; j < 8; ++j) st[j] = a * st[j] + s[j];
        }
        store8f(out + OUT_PS + (((size_t)b * SSD_HEADS + hd) * 64 + p) * 128 + n8 * 8, st);
    }
}

__device__ __forceinline__ void ph_ssd_out(LAS unsigned char* ldsb, const bf16* __restrict__ xbc_b, const bf16* __restrict__ projb, const float* __restrict__ dtv,
                                           const float* __restrict__ a_log, const float* __restrict__ d_skip, const float* __restrict__ norm_g,
                                           const bf16* __restrict__ Hin, bf16* __restrict__ A1) {
    const int tid = threadIdx.x, w = __builtin_amdgcn_readfirstlane(tid >> 6), lane = tid & 63;
    const int r = lane & 31, h = lane >> 5, blk = (lane >> 4) & 1, q = (lane & 15) >> 2, pp = lane & 3;
    const int lt = w & 3, hs = w >> 2;
    for (int unit = blockIdx.x; unit < BATCH * 64 * SSD_GROUPS; unit += gridDim.x) {
        const int g = unit & 3, bc = unit >> 2;
        const int t0 = bc * 128;
        __syncthreads();
        ssd_chunk_acs(ldsb, dtv, a_log, t0, g, nullptr);
        for (int idx = tid; idx < 2048; idx += NTHR) { const int row = idx >> 4, ch = idx & 15;
            const v4u v = *(const v4u*)(xbc_b + (size_t)(t0 + row) * CONV_DIM + 1536 + 128 * g + ch * 8);
            *(LAS v4u*)(ldsb + SSD_L_BM + row * SSD_RS_B + ch * 16) = v; }
        for (int idx = tid; idx < 6144; idx += NTHR) { const int hh = idx >> 10, rem = idx & 1023, row = rem >> 3, ch = rem & 7;
            const v4u v = *(const v4u*)(xbc_b + (size_t)(t0 + row) * CONV_DIM + (6 * g + hh) * 64 + ch * 8);
            *(LAS v4u*)(ldsb + SSD_L_X + hh * SSD_XIMG + row * SSD_RS_X + ch * 16) = v; }
        __syncthreads();
        const bf16* cp = xbc_b + (size_t)(t0 + 32 * lt + r) * CONV_DIM + 2048 + 128 * g + 8 * h;
        const int lcol = 32 * lt + r;
        const LAS float* acsb = (const LAS float*)(ldsb + SSD_L_ACS) + 3 * hs * 128; const LAS float* dtsb = (const LAS float*)(ldsb + SSD_L_DTS) + 3 * hs * 128;
        f32x16 y[3][2];
#pragma unroll
        for (int h3 = 0; h3 < 3; ++h3)
#pragma unroll
            for (int i = 0; i < 16; ++i) { y[h3][0][i] = 0.f; y[h3][1][i] = 0.f; }
#pragma unroll 1
        for (int ks = 0; ks < 8; ++ks) {
            const s16x8 cf = *(const s16x8*)(cp + 16 * ks);
#pragma unroll
            for (int h3 = 0; h3 < 3; ++h3) {
                const bf16* hp = Hin + (((size_t)bc * SSD_HEADS + 6 * g + 3 * hs + h3) * 64 + r) * 128 + 8 * h + 16 * ks;
                const s16x8 h0 = *(const s16x8*)hp, h1 = *(const s16x8*)(hp + 32 * 128);
                y[h3][0] = __builtin_amdgcn_mfma_f32_32x32x16_bf16(cf, h0, y[h3][0], 0, 0, 0);
                y[h3][1] = __builtin_amdgcn_mfma_f32_32x32x16_bf16(cf, h1, y[h3][1], 0, 0, 0);
            }
        }
#pragma unroll
        for (int h3 = 0; h3 < 3; ++h3)
#pragma unroll
            for (int q4 = 0; q4 < 4; ++q4) {
                const f32x4v a4 = *(const LAS f32x4v*)(acsb + h3 * 128 + 32 * lt + 8 * q4 + 4 * h);
                const float e0 = __expf(a4[0]), e1 = __expf(a4[1]), e2 = __expf(a4[2]), e3 = __expf(a4[3]);
                y[h3][0][4 * q4] *= e0; y[h3][0][4 * q4 + 1] *= e1; y[h3][0][4 * q4 + 2] *= e2; y[h3][0][4 * q4 + 3] *= e3;
                y[h3][1][4 * q4] *= e0; y[h3][1][4 * q4 + 1] *= e1; y[h3][1][4 * q4 + 2] *= e2; y[h3][1][4 * q4 + 3] *= e3;
            }
        const unsigned xb0 = lds_addr(ldsb + SSD_L_X + 3 * hs * SSD_XIMG) + (4 * h + q) * SSD_RS_X + (16 * blk + 4 * pp) * 2;
        for (int st = 0; st <= lt; ++st) {
            f32x16 cb;
#pragma unroll
            for (int i = 0; i < 16; ++i) cb[i] = 0.f;
#pragma unroll 2
            for (int ks = 0; ks < 8; ++ks) {
                const s16x8 cf = *(const s16x8*)(cp + 16 * ks);
                const s16x8 bfrag = *(const LAS s16x8*)(ldsb + SSD_L_BM + (32 * st + r) * SSD_RS_B + (16 * ks + 8 * h) * 2);
                cb = __builtin_amdgcn_mfma_f32_32x32x16_bf16(bfrag, cf, cb, 0, 0, 0);
            }
#pragma unroll
            for (int h3 = 0; h3 < 3; ++h3) {
                const LAS float* acs = acsb + h3 * 128; const LAS float* dts = dtsb + h3 * 128;
                const float myacs = acs[lcol];
                const float Dh = d_skip[6 * g + 3 * hs + h3];
                const unsigned xb = xb0 + h3 * SSD_XIMG + st * 32 * SSD_RS_X;
#pragma unroll
                for (int kk = 0; kk < 2; ++kk) {
                    const int s0 = 32 * st + 16 * kk + 4 * h;
                    const f32x4v as0 = *(const LAS f32x4v*)(acs + s0), as1 = *(const LAS f32x4v*)(acs + s0 + 8);
                    const f32x4v ds0 = *(const LAS f32x4v*)(dts + s0), ds1 = *(const LAS f32x4v*)(dts + s0 + 8);
                    float wv[8];
#pragma unroll
                    for (int j = 0; j < 8; ++j) {
                        const int s = s0 + 8 * (j >> 2) + (j & 3);
                        const float asj = (j < 4) ? as0[j & 3] : as1[j & 3], dsj = (j < 4) ? ds0[j & 3] : ds1[j & 3];
                        float v = cb[8 * kk + j] * __expf(myacs - asj) * dsj;
                        v = (s <= lcol) ? v : 0.f;
                        v = (s == lcol) ? v + Dh : v;
                        wv[j] = v;
                    }
                    s16x8 afr;
                    { v4u o; o.x = pk2(wv[0], wv[1]); o.y = pk2(wv[2], wv[3]); o.z = pk2(wv[4], wv[5]); o.w = pk2(wv[6], wv[7]); afr = __builtin_bit_cast(s16x8, o); }
                    s16x8 b0, b1;
                    if (kk == 0) { b0 = tr_frag<0, 8 * SSD_RS_X>(xb); b1 = tr_frag<64, 8 * SSD_RS_X + 64>(xb); }
                    else { b0 = tr_frag<16 * SSD_RS_X, 24 * SSD_RS_X>(xb); b1 = tr_frag<16 * SSD_RS_X + 64, 24 * SSD_RS_X + 64>(xb); }
                    y[h3][0] = __builtin_amdgcn_mfma_f32_32x32x16_bf16(afr, b0, y[h3][0], 0, 0, 0);
                    y[h3][1] = __builtin_amdgcn_mfma_f32_32x32x16_bf16(afr, b1, y[h3][1], 0, 0, 0);
                    __builtin_amdgcn_sched_barrier(0);
                }
            }
        }
        __syncthreads();
        {
            LAS unsigned short* yst = (LAS unsigned short*)(ldsb + SSD_L_X);
#pragma unroll
            for (int h3 = 0; h3 < 3; ++h3)
#pragma unroll
                for (int ptile = 0; ptile < 2; ++ptile)
#pragma unroll
                    for (int reg = 0; reg < 16; ++reg) {
                        const int l0 = 32 * lt + (reg & 3) + 8 * (reg >> 2) + 4 * h;
                        const int col = (3 * hs + h3) * 64 + 32 * ptile + r;
                        yst[l0 * (SSD_RS_Y / 2) + col] = (unsigned short)f2bf(y[h3][ptile][reg]);
                    }
        }
        __syncthreads();
#pragma unroll
        for (int pass = 0; pass < 4; ++pass) {
            const int l = 4 * (pass * 8 + w) + (lane >> 4), i16 = lane & 15;
            float gv[3][8]; float ss = 0.f;
#pragma unroll
            for (int k = 0; k < 3; ++k) {
                const int col0 = 24 * i16 + 8 * k;
                float yv[8], zv[8];
                unpack8(*(const LAS v4u*)(ldsb + SSD_L_X + l * SSD_RS_Y + col0 * 2), yv);
                unpack8(*(const v4u*)(projb + (size_t)(t0 + l) * NB_LD + g * 384 + col0), zv);
#pragma unroll
                for (int j = 0; j < 8; ++j) { const float gg = yv[j] * silu_f(zv[j]); gv[k][j] = gg; ss += gg * gg; }
            }
            ss += __shfl_xor(ss, 1); ss += __shfl_xor(ss, 2); ss += __shfl_xor(ss, 4); ss += __shfl_xor(ss, 8);
            const float rstd = rsqrtf(ss * (1.0f / 384.0f) + LN_EPS);
#pragma unroll
            for (int k = 0; k < 3; ++k) {
                const int col0 = g * 384 + 24 * i16 + 8 * k;
                const float4 g0 = *(const float4*)(norm_g + col0), g1 = *(const float4*)(norm_g + col0 + 4);
                v4u o; o.x = pk2(gv[k][0] * rstd * g0.x, gv[k][1] * rstd * g0.y); o.y = pk2(gv[k][2] * rstd * g0.z, gv[k][3] * rstd * g0.w);
                o.z = pk2(gv[k][4] * rstd * g1.x, gv[k][5] * rstd * g1.y); o.w = pk2(gv[k][6] * rstd * g1.z, gv[k][7] * rstd * g1.w);
                *(v4u*)(A1 + (size_t)(t0 + l) * MIX_WIDTH + col0) = o;
            }
        }
    }
}

#define ATT_RS_V 144
#define ATT_VIMG (256 * ATT_RS_V)
#define ATT_PV(KT, S2) { \
        v4u o_; o_.x = pk2(s[KT][8 * S2 + 0], s[KT][8 * S2 + 1]); o_.y = pk2(s[KT][8 * S2 + 2], s[KT][8 * S2 + 3]); \
        o_.z = pk2(s[KT][8 * S2 + 4], s[KT][8 * S2 + 5]); o_.w = pk2(s[KT][8 * S2 + 6], s[KT][8 * S2 + 7]); \
        const s16x8 pf_ = __builtin_bit_cast(s16x8, o_); \
        const s16x8 a0_ = tr_frag<(32 * KT + 16 * S2) * ATT_RS_V, (32 * KT + 16 * S2 + 8) * ATT_RS_V>(vbase); \
        const s16x8 a1_ = tr_frag<(32 * KT + 16 * S2) * ATT_RS_V + 64, (32 * KT + 16 * S2 + 8) * ATT_RS_V + 64>(vbase); \
        o0 = __builtin_amdgcn_mfma_f32_32x32x16_bf16(a0_, pf_, o0, 0, 0, 0); \
        o1 = __builtin_amdgcn_mfma_f32_32x32x16_bf16(a1_, pf_, o1, 0, 0, 0); }
__device__ __forceinline__ void ph_attn_prompt(LAS unsigned char* ldsb, const bf16* __restrict__ qrot_b, const bf16* __restrict__ krot_b, const bf16* __restrict__ projb,
                                               bf16* __restrict__ obuf, float* __restrict__ lsebuf) {
    const int tid = threadIdx.x, w = __builtin_amdgcn_readfirstlane(tid >> 6), lane = tid & 63;
    const int r = lane & 31, h = lane >> 5, blk = (lane >> 4) & 1, q = (lane & 15) >> 2, pp = lane & 3;
    const int qt = w & 3, hsel = w >> 2;
    for (int unit = blockIdx.x; unit < 3 * 512; unit += gridDim.x) {
        const int pat = unit >> 9, rem = unit & 511, hp = rem & 3, rem2 = rem >> 2, b = rem2 >> 6, bk = rem2 & 63;
        const int dsh = 2 * pat, nper = 64 >> dsh, res = bk >> (6 - dsh), nb = bk & (nper - 1);
        const int head = 2 * hp + hsel;
        __syncthreads();
        for (int idx = tid & 255; idx < 2048; idx += 256) {
            const int row = idx >> 3, ch = idx & 7, js = 128 * nb - 128 + row;
            v4u v; v.x = 0u; v.y = 0u; v.z = 0u; v.w = 0u;
            if (js >= 0) v = *(const v4u*)(projb + (size_t)(b * SEQ + (js << dsh) + res) * NB_LD + NB_V + head * 64 + ch * 8);
            *(LAS v4u*)(ldsb + hsel * ATT_VIMG + row * ATT_RS_V + ch * 16) = v;
        }
        const int tq = b * SEQ + ((128 * nb + 32 * qt + r) << dsh) + res;
        s16x8 qf[4];
#pragma unroll
        for (int ks = 0; ks < 4; ++ks) qf[ks] = *(const s16x8*)(qrot_b + (size_t)tq * ATT_WIDTH + head * 64 + 16 * ks + 8 * h);
        f32x16 s[5];
#pragma unroll
        for (int kt = 0; kt < 5; ++kt) {
            int js = 128 * nb + 32 * qt - 128 + 32 * kt + r; js = js < 0 ? 0 : js;
            const bf16* kp = krot_b + (size_t)(b * SEQ + (js << dsh) + res) * ATT_WIDTH + head * 64 + 8 * h;
#pragma unroll
            for (int i = 0; i < 16; ++i) s[kt][i] = 0.f;
#pragma unroll
            for (int ks = 0; ks < 4; ++ks) s[kt] = __builtin_amdgcn_mfma_f32_32x32x16_bf16(*(const s16x8*)(kp + 16 * ks), qf[ks], s[kt], 0, 0, 0);
        }
        float m = -INFINITY;
#pragma unroll
        for (int kt = 0; kt < 5; ++kt) {
            const bool tile_ok = (nb > 0) || (qt + kt >= 4);
#pragma unroll
            for (int reg = 0; reg < 16; ++reg) {
                const int c = (reg & 3) + 8 * (reg >> 2) + 4 * h;
                const bool ok = tile_ok && (kt == 0 ? (c >= r) : (kt == 4 ? (c <= r) : true));
                const float v = ok ? s[kt][reg] * 0.125f : -INFINITY;
                s[kt][reg] = v; m = fmaxf(m, v);
            }
        }
        m = fmaxf(m, __shfl_xor(m, 32));
        float l = 0.f;
#pragma unroll
        for (int kt = 0; kt < 5; ++kt)
#pragma unroll
            for (int reg = 0; reg < 16; ++reg) { const float p = __expf(s[kt][reg] - m); s[kt][reg] = p; l += p; }
        l += __shfl_xor(l, 32);
        __syncthreads();
        f32x16 o0, o1;
#pragma unroll
        for (int i = 0; i < 16; ++i) { o0[i] = 0.f; o1[i] = 0.f; }
        const unsigned vbase = lds_addr(ldsb + hsel * ATT_VIMG) + (32 * qt + 4 * h + q) * ATT_RS_V + (16 * blk + 4 * pp) * 2;
        ATT_PV(0, 0) ATT_PV(0, 1) ATT_PV(1, 0) ATT_PV(1, 1) ATT_PV(2, 0) ATT_PV(2, 1) ATT_PV(3, 0) ATT_PV(3, 1) ATT_PV(4, 0) ATT_PV(4, 1)
        const float inv = 1.0f / l;
        bf16* op = obuf + ((size_t)pat * T_PROMPT + tq) * ATT_WIDTH + head * 64 + 4 * h;
#pragma unroll
        for (int q4 = 0; q4 < 4; ++q4) {
            *(uint2*)(op + 8 * q4) = make_uint2(pk2(o0[4 * q4] * inv, o0[4 * q4 + 1] * inv), pk2(o0[4 * q4 + 2] * inv, o0[4 * q4 + 3] * inv));
            *(uint2*)(op + 32 + 8 * q4) = make_uint2(pk2(o1[4 * q4] * inv, o1[4 * q4 + 1] * inv), pk2(o1[4 * q4 + 2] * inv, o1[4 * q4 + 3] * inv));
        }
        if (h == 0) lsebuf[((size_t)pat * T_PROMPT + tq) * 8 + head] = m + __logf(l);
    }
}
__device__ __forceinline__ void ph_attn_combine(const bf16* __restrict__ obuf, const float* __restrict__ lsebuf, bf16* __restrict__ A1) {
    const int lane = threadIdx.x & 63;
    for (int t = blockIdx.x * NWAVE + (threadIdx.x >> 6); t < T_PROMPT; t += gridDim.x * NWAVE) {
        const int hd = lane >> 3;
        const float l0 = lsebuf[((size_t)0 * T_PROMPT + t) * 8 + hd], l1 = lsebuf[((size_t)1 * T_PROMPT + t) * 8 + hd], l2 = lsebuf[((size_t)2 * T_PROMPT + t) * 8 + hd];
        const float mx = fmaxf(l0, fmaxf(l1, l2));
        const float e0 = __expf(l0 - mx), e1 = __expf(l1 - mx), e2 = __expf(l2 - mx);
        const float inv = 1.0f / (e0 + e1 + e2);
        float a[8], b[8], c[8];
        unpack8(*(const v4u*)(obuf + ((size_t)0 * T_PROMPT + t) * ATT_WIDTH + lane * 8), a);
        unpack8(*(const v4u*)(obuf + ((size_t)1 * T_PROMPT + t) * ATT_WIDTH + lane * 8), b);
        unpack8(*(const v4u*)(obuf + ((size_t)2 * T_PROMPT + t) * ATT_WIDTH + lane * 8), c);
        float o[8];
#pragma unroll
        for (int j = 0; j < 8; ++j) o[j] = (e0 * a[j] + e1 * b[j] + e2 * c[j]) * inv;
        v4u w; w.x = pk2(o[0], o[1]); w.y = pk2(o[2], o[3]); w.z = pk2(o[4], o[5]); w.w = pk2(o[6], o[7]);
        *(v4u*)(A1 + (size_t)t * MIX_WIDTH + SSD_WIDTH + lane * 8) = w;
    }
}

#define RT_RS 272
#define RT_KIMG (128 * RT_RS)
#define RT_LUT (2 * RT_KIMG)
constexpr unsigned char RT_CANDS[64] = {0, 1, 2, 3, 4, 5, 6, 7, 8, 9, 10, 11, 12, 13, 14, 15, 16, 17, 18, 19, 20, 21, 22, 23, 32, 33, 34, 35, 36, 48, 49, 50, 51, 64, 65, 66, 80, 81, 96, 97,
                                        112, 113, 128, 144, 160, 176, 192, 208, 224, 240, 0, 0, 0, 0, 0, 0, 0, 0, 0, 0, 0, 0, 0, 0};
__device__ __forceinline__ unsigned rt_mono(float f) { const unsigned u = __builtin_bit_cast(unsigned, f); return u ^ ((unsigned)((int)u >> 31) | 0x80000000u); }
__device__ __forceinline__ float rt_unmono(unsigned m) { const unsigned u = (m & 0x80000000u) ? (m ^ 0x80000000u) : ~m; return __builtin_bit_cast(float, u); }
#define RT_CE_DESC(a, b) { const unsigned x_ = (a), y_ = (b); (a) = x_ > y_ ? x_ : y_; (b) = x_ > y_ ? y_ : x_; }
#define RT_CE_ASC(a, b) { const unsigned x_ = (a), y_ = (b); (a) = x_ > y_ ? y_ : x_; (b) = x_ > y_ ? x_ : y_; }
__device__ __forceinline__ void rt_sort16(unsigned (&v)[16]) {
#pragma unroll
    for (int k = 2; k <= 16; k <<= 1)
#pragma unroll
        for (int j = k >> 1; j > 0; j >>= 1)
#pragma unroll
            for (int i = 0; i < 16; ++i) { const int l = i ^ j; if (l > i) { if ((i & k) == 0) RT_CE_DESC(v[i], v[l]) else RT_CE_ASC(v[i], v[l]) } }
}
__device__ __forceinline__ void rt_merge16(unsigned (&v)[16]) {
#pragma unroll
    for (int j = 8; j > 0; j >>= 1)
#pragma unroll
        for (int i = 0; i < 16; ++i) { const int l = i ^ j; if (l > i) RT_CE_DESC(v[i], v[l]) }
}
__device__ __forceinline__ void rt_top16(unsigned (&a)[16], const unsigned (&b)[16]) {
#pragma unroll
    for (int i = 0; i < 16; ++i) a[i] = a[i] > b[15 - i] ? a[i] : b[15 - i];
    rt_merge16(a);
}
__device__ __forceinline__ void rt_top16_partner(unsigned (&a)[16]) {
    unsigned b[16];
#pragma unroll
    for (int i = 0; i < 16; ++i) b[i] = (unsigned)__shfl_xor((int)a[i], 32);
    rt_top16(a, b);
}
__device__ __forceinline__ void rt_scores_top16(LAS unsigned char* kimg, const bf16* __restrict__ qp, int r, int h, unsigned (&k0)[16]) {
    f32x16 acc[4];
#pragma unroll
    for (int kt = 0; kt < 4; ++kt)
#pragma unroll
        for (int i = 0; i < 16; ++i) acc[kt][i] = 0.f;
#pragma unroll
    for (int ks = 0; ks < 8; ++ks) {
        const s16x8 qf = *(const s16x8*)(qp + 16 * ks);
#pragma unroll
        for (int kt = 0; kt < 4; ++kt) {
            const s16x8 kf = *(const LAS s16x8*)(kimg + (32 * kt + r) * RT_RS + (16 * ks + 8 * h) * 2);
            acc[kt] = __builtin_amdgcn_mfma_f32_32x32x16_bf16(kf, qf, acc[kt], 0, 0, 0);
        }
    }
    unsigned k1[16], k2[16], k3[16];
#pragma unroll
    for (int reg = 0; reg < 16; ++reg) {
        const unsigned ki = (unsigned)((reg & 3) + 8 * (reg >> 2) + 4 * h);
        k0[reg] = (rt_mono(acc[0][reg]) & 0xFFFFFF80u) | ki;
        k1[reg] = (rt_mono(acc[1][reg]) & 0xFFFFFF80u) | (ki + 32u);
        k2[reg] = (rt_mono(acc[2][reg]) & 0xFFFFFF80u) | (ki + 64u);
        k3[reg] = (rt_mono(acc[3][reg]) & 0xFFFFFF80u) | (ki + 96u);
    }
    rt_sort16(k0); rt_sort16(k1); rt_sort16(k2); rt_sort16(k3);
    rt_top16(k0, k1); rt_top16(k2, k3); rt_top16(k0, k2);
    rt_top16_partner(k0);
}
__device__ __forceinline__ void ph_peer_route2(LAS unsigned char* ldsb, const bf16* __restrict__ qhb, const float* __restrict__ keys1, const float* __restrict__ keys2,
                                               int* __restrict__ eidx, float* __restrict__ gate) {
    const int tid = threadIdx.x, w = __builtin_amdgcn_readfirstlane(tid >> 6), lane = tid & 63, r = lane & 31, h = lane >> 5;
    __syncthreads();
    for (int idx = tid; idx < 2 * 128 * 16; idx += NTHR) {
        const int tb = idx >> 11, rem = idx & 2047, row = rem >> 4, ch = rem & 15;
        const float* sp = (tb ? keys2 : keys1) + row * 128 + ch * 8;
        const float4 a = *(const float4*)sp, b = *(const float4*)(sp + 4);
        v4u o; o.x = pk2(a.x, a.y); o.y = pk2(a.z, a.w); o.z = pk2(b.x, b.y); o.w = pk2(b.z, b.w);
        *(LAS v4u*)(ldsb + tb * RT_KIMG + row * RT_RS + ch * 16) = o;
    }
    __syncthreads();
    LAS unsigned* lut = (LAS unsigned*)(ldsb + RT_LUT) + w * 512;
    for (int unit = blockIdx.x * NWAVE + w; unit < (T_ALL / 32) * 8; unit += gridDim.x * NWAVE) {
        const int tt = unit >> 3, hd = unit & 7;
        const int tok = 32 * tt + r;
        const bf16* qp = qhb + (size_t)tok * 2048 + hd * 256 + 8 * h;
        unsigned ka[16], kb[16];
        rt_scores_top16(ldsb, qp, r, h, ka);
        rt_scores_top16(ldsb + RT_KIMG, qp + 128, r, h, kb);
        float v1[16], v2[16];
#pragma unroll
        for (int i = 0; i < 16; ++i) { v1[i] = rt_unmono(ka[i] & 0xFFFFFF80u); v2[i] = rt_unmono(kb[i] & 0xFFFFFF80u); }
#pragma unroll
        for (int wd = 0; wd < 4; ++wd) {
            lut[wd * 64 + lane] = (ka[4 * wd] & 0x7Fu) | ((ka[4 * wd + 1] & 0x7Fu) << 8) | ((ka[4 * wd + 2] & 0x7Fu) << 16) | ((ka[4 * wd + 3] & 0x7Fu) << 24);
            lut[(4 + wd) * 64 + lane] = (kb[4 * wd] & 0x7Fu) | ((kb[4 * wd + 1] & 0x7Fu) << 8) | ((kb[4 * wd + 2] & 0x7Fu) << 16) | ((kb[4 * wd + 3] & 0x7Fu) << 24);
        }
        unsigned c0[16], c1[16];
        c0[0] = (rt_mono(h ? (v1[0] + v2[1]) : (v1[0] + v2[0])) & 0xFFFFFF00u) | (h ? 1u : 0u);
        c0[1] = (rt_mono(h ? (v1[0] + v2[3]) : (v1[0] + v2[2])) & 0xFFFFFF00u) | (h ? 3u : 2u);
        c0[2] = (rt_mono(h ? (v1[0] + v2[5]) : (v1[0] + v2[4])) & 0xFFFFFF00u) | (h ? 5u : 4u);
        c0[3] = (rt_mono(h ? (v1[0] + v2[7]) : (v1[0] + v2[6])) & 0xFFFFFF00u) | (h ? 7u : 6u);
        c0[4] = (rt_mono(h ? (v1[0] + v2[9]) : (v1[0] + v2[8])) & 0xFFFFFF00u) | (h ? 9u : 8u);
        c0[5] = (rt_mono(h ? (v1[0] + v2[11]) : (v1[0] + v2[10])) & 0xFFFFFF00u) | (h ? 11u : 10u);
        c0[6] = (rt_mono(h ? (v1[0] + v2[13]) : (v1[0] + v2[12])) & 0xFFFFFF00u) | (h ? 13u : 12u);
        c0[7] = (rt_mono(h ? (v1[0] + v2[15]) : (v1[0] + v2[14])) & 0xFFFFFF00u) | (h ? 15u : 14u);
        c0[8] = (rt_mono(h ? (v1[1] + v2[1]) : (v1[1] + v2[0])) & 0xFFFFFF00u) | (h ? 17u : 16u);
        c0[9] = (rt_mono(h ? (v1[1] + v2[3]) : (v1[1] + v2[2])) & 0xFFFFFF00u) | (h ? 19u : 18u);
        c0[10] = (rt_mono(h ? (v1[1] + v2[5]) : (v1[1] + v2[4])) & 0xFFFFFF00u) | (h ? 21u : 20u);
        c0[11] = (rt_mono(h ? (v1[1] + v2[7]) : (v1[1] + v2[6])) & 0xFFFFFF00u) | (h ? 23u : 22u);
        c0[12] = (rt_mono(h ? (v1[2] + v2[1]) : (v1[2] + v2[0])) & 0xFFFFFF00u) | (h ? 33u : 32u);
        c0[13] = (rt_mono(h ? (v1[2] + v2[3]) : (v1[2] + v2[2])) & 0xFFFFFF00u) | (h ? 35u : 34u);
        c0[14] = (rt_mono(h ? (v1[3] + v2[0]) : (v1[2] + v2[4])) & 0xFFFFFF00u) | (h ? 48u : 36u);
        c0[15] = (rt_mono(h ? (v1[3] + v2[2]) : (v1[3] + v2[1])) & 0xFFFFFF00u) | (h ? 50u : 49u);
        c1[0] = (rt_mono(h ? (v1[4] + v2[0]) : (v1[3] + v2[3])) & 0xFFFFFF00u) | (h ? 64u : 51u);
        c1[1] = (rt_mono(h ? (v1[4] + v2[2]) : (v1[4] + v2[1])) & 0xFFFFFF00u) | (h ? 66u : 65u);
        c1[2] = (rt_mono(h ? (v1[5] + v2[1]) : (v1[5] + v2[0])) & 0xFFFFFF00u) | (h ? 81u : 80u);
        c1[3] = (rt_mono(h ? (v1[6] + v2[1]) : (v1[6] + v2[0])) & 0xFFFFFF00u) | (h ? 97u : 96u);
        c1[4] = (rt_mono(h ? (v1[7] + v2[1]) : (v1[7] + v2[0])) & 0xFFFFFF00u) | (h ? 113u : 112u);
        c1[5] = (rt_mono(h ? (v1[9] + v2[0]) : (v1[8] + v2[0])) & 0xFFFFFF00u) | (h ? 144u : 128u);
        c1[6] = (rt_mono(h ? (v1[11] + v2[0]) : (v1[10] + v2[0])) & 0xFFFFFF00u) | (h ? 176u : 160u);
        c1[7] = (rt_mono(h ? (v1[13] + v2[0]) : (v1[12] + v2[0])) & 0xFFFFFF00u) | (h ? 208u : 192u);
        c1[8] = (rt_mono(h ? (v1[15] + v2[0]) : (v1[14] + v2[0])) & 0xFFFFFF00u) | (h ? 240u : 224u);
        c1[9] = 0u;
        c1[10] = 0u;
        c1[11] = 0u;
        c1[12] = 0u;
        c1[13] = 0u;
        c1[14] = 0u;
        c1[15] = 0u;
        rt_sort16(c0); rt_sort16(c1); rt_top16(c0, c1); rt_top16_partner(c0);
        float e[16]; float sum = 0.f;
        const float mx = rt_unmono(c0[0] & 0xFFFFFF00u);
#pragma unroll
        for (int k = 0; k < 16; ++k) { e[k] = __expf(rt_unmono(c0[k] & 0xFFFFFF00u) - mx); sum += e[k]; }
        const float inv = 1.0f / sum;
        asm volatile("s_waitcnt lgkmcnt(0)" ::: "memory");
        int ex[8]; float gv[8];
#pragma unroll
        for (int k = 0; k < 8; ++k) {
            const unsigned hm = (unsigned)(-h);
            const unsigned ck = (c0[k] & ~hm) | (c0[8 + k] & hm);
            const float ek = __builtin_bit_cast(float, (__builtin_bit_cast(unsigned, e[k]) & ~hm) | (__builtin_bit_cast(unsigned, e[8 + k]) & hm));
            const unsigned ci = (ck >> 4) & 15u, cj = ck & 15u;
            const unsigned w1 = lut[(ci >> 2) * 64 + lane], w2 = lut[(4 + (cj >> 2)) * 64 + lane];
            const unsigned i1 = (w1 >> (8 * (ci & 3))) & 0x7Fu, i2 = (w2 >> (8 * (cj & 3))) & 0x7Fu;
            ex[k] = (int)(i1 * PEER_NKEYS + i2); gv[k] = ek * inv;
        }
        int* ep = eidx + (size_t)tok * 128 + hd * 16 + 8 * h; float* gp = gate + (size_t)tok * 128 + hd * 16 + 8 * h;
        *(int4*)ep = make_int4(ex[0], ex[1], ex[2], ex[3]); *(int4*)(ep + 4) = make_int4(ex[4], ex[5], ex[6], ex[7]);
        *(float4*)gp = make_float4(gv[0], gv[1], gv[2], gv[3]); *(float4*)(gp + 4) = make_float4(gv[4], gv[5], gv[6], gv[7]);
    }
}

struct Params {
    const float* in[23];
    float* out;
    unsigned char* ws;
    unsigned* bar;
};

#define WS_BAR      0ull
#define WS_XALL     (1ull << 20)
#define WS_PROJ     (WS_XALL + (size_t)T_ALL * D_MODEL * 4)
#define WS_XBC      (WS_PROJ + (size_t)T_ALL * PROJ_LD * 4)
#define WS_DT       (WS_XBC + (size_t)T_ALL * CONV_DIM * 4)
#define WS_QROT     (WS_DT + (size_t)T_ALL * SSD_HEADS * 4)
#define WS_KROT     (WS_QROT + (size_t)T_ALL * ATT_WIDTH * 4)
#define WS_YBUF     (WS_KROT + (size_t)T_ALL * ATT_WIDTH * 4)
#define WS_MIX      (WS_YBUF + (size_t)T_ALL * MIX_WIDTH * 4)
#define WS_HBUF     (WS_MIX + (size_t)T_ALL * D_MODEL * 4)
#define WS_QH       (WS_HBUF + (size_t)T_ALL * D_MODEL * 4)
#define WS_EIDX     (WS_QH + (size_t)T_ALL * 2048 * 4)
#define WS_GATE     (WS_EIDX + (size_t)T_ALL * 128 * 4)
#define WS_A0       (WS_GATE + (size_t)T_ALL * 128 * 4)
#define WS_A1       (WS_A0 + (size_t)T_ALL * D_MODEL * 2)
#define WS_A2       (WS_A1 + (size_t)T_ALL * MIX_WIDTH * 2)
#define WS_WTIN     (WS_A2 + (size_t)T_ALL * D_MODEL * 2)
#define WS_WTOUT    (WS_WTIN + (size_t)PROJ_LD * D_MODEL * 2)
#define WS_WTQ      (WS_WTOUT + (size_t)D_MODEL * MIX_WIDTH * 2)
#define WS_PROJB    (WS_WTQ + (size_t)2048 * D_MODEL * 2)
#define WS_DTRAW    (WS_PROJB + (size_t)T_ALL * NB_LD * 2)
#define WS_XBCB     (WS_DTRAW + (size_t)T_ALL * 32 * 4)
#define WS_QROTB    (WS_XBCB + (size_t)T_ALL * CONV_DIM * 2)
#define WS_KROTB    (WS_QROTB + (size_t)T_ALL * ATT_WIDTH * 2)
#define WS_UB       (WS_KROTB + (size_t)T_ALL * ATT_WIDTH * 2)
#define WS_VB       (WS_UB + (size_t)16384 * D_MODEL * 2)
#define WS_USC      (WS_VB + (size_t)16384 * D_MODEL * 2)
#define WS_VSC      (WS_USC + 16384 * 4)
#define WS_SBUF     (WS_VSC + 16384 * 4)
#define WS_HIN      (WS_SBUF + (size_t)BATCH * 64 * SSD_HEADS * 64 * 128 * 2)
#define WS_CDEC     (WS_HIN + (size_t)BATCH * 64 * SSD_HEADS * 64 * 128 * 2)
#define WS_OBUF     (WS_CDEC + (size_t)BATCH * 64 * SSD_HEADS * 4)
#define WS_LSE      (WS_OBUF + (size_t)3 * T_PROMPT * ATT_WIDTH * 2)
#define WS_END      (WS_LSE + (size_t)3 * T_PROMPT * 8 * 4)

#define LDS_BYTES (160 * 1024)

#define KP const __attribute__((address_space(4))) Params* kp = (const __attribute__((address_space(4))) Params*)__builtin_amdgcn_kernarg_segment_ptr(); asm volatile("" : "+s"(kp)); unsigned char* ws = kp->ws; (void)ws;
#define IN(i) (kp->in[i])
#define WSP(T, off) ((T*)(ws + (off)))
__global__ void __launch_bounds__(512, 2) mega_fwd(Params p) {
    extern __shared__ __attribute__((aligned(16))) unsigned char smem[];
    if (threadIdx.x == 0) *(uint4*)smem = make_uint4(0u, 0u, 0u, 0u);
    __syncthreads();
    XcdBarrier bar = xcd_barrier_post(p.bar, (volatile LAS unsigned*)smem);
    float* lds = (float*)(smem + 256);
    LAS unsigned char* ldsb = (LAS unsigned char*)smem + 256;

    { KP ph_prologue(ldsb, IN(0), IN(1), WSP(bf16, WS_A0), IN(6), WSP(bf16, WS_WTIN), IN(13), WSP(bf16, WS_WTOUT), IN(16), WSP(bf16, WS_WTQ)); }
    { KP ph_quant_tables(IN(19), IN(20), WSP(unsigned char, WS_UB), WSP(unsigned char, WS_VB), WSP(float, WS_USC), WSP(float, WS_VSC)); }
    xcd_barrier(bar);
    { KP pg8::Gemm g{WSP(bf16, WS_A0), WSP(bf16, WS_WTIN), T_ALL, PROJ_LD, D_MODEL}; pg8::StaticOrder S; S.init(g.M, g.N, (int)gridDim.x, (int)blockIdx.x);
      pg8::EpiProj E{WSP(bf16, WS_PROJB), WSP(float, WS_DTRAW)}; pg8::gemm_phase<pg8::EpiProj, pg8::StaticOrder, false>(ldsb, g, S, E, nullptr); }
    xcd_barrier(bar);
    { KP ph_post_proj2(WSP(bf16, WS_PROJB), WSP(float, WS_DTRAW), IN(4), IN(7), IN(8), IN(9), WSP(bf16, WS_XBCB), WSP(float, WS_DT), WSP(bf16, WS_QROTB), WSP(bf16, WS_KROTB), kp->out); }
    xcd_barrier(bar);
    { KP ph_ssd_states(ldsb, WSP(bf16, WS_XBCB), WSP(float, WS_DT), IN(10), WSP(bf16, WS_SBUF), WSP(float, WS_CDEC)); }
    __syncthreads();
    { KP ph_attn_prompt(ldsb, WSP(bf16, WS_QROTB), WSP(bf16, WS_KROTB), WSP(bf16, WS_PROJB), WSP(bf16, WS_OBUF), WSP(float, WS_LSE)); }
    __syncthreads();
    { KP ph_ssd_naive(lds, WSP(bf16, WS_XBCB), WSP(float, WS_DT), IN(10), IN(11), IN(5), WSP(float, WS_YBUF), kp->out); }
    { KP ph_attn_sample(lds, WSP(bf16, WS_QROTB), WSP(bf16, WS_KROTB), WSP(bf16, WS_PROJB), IN(2), IN(3), WSP(bf16, WS_A1)); }
    xcd_barrier(bar);
    { KP ph_ssd_scan(WSP(bf16, WS_SBUF), WSP(float, WS_CDEC), WSP(bf16, WS_HIN), kp->out); }
    xcd_barrier(bar);
    { KP ph_ssd_out(ldsb, WSP(bf16, WS_XBCB), WSP(bf16, WS_PROJB), WSP(float, WS_DT), IN(10), IN(11), IN(12), WSP(bf16, WS_HIN), WSP(bf16, WS_A1)); }
    { KP ph_attn_combine(WSP(bf16, WS_OBUF), WSP(float, WS_LSE), WSP(bf16, WS_A1)); }
    { KP ph_gate_norm(WSP(bf16, WS_PROJB), IN(12), WSP(float, WS_YBUF), WSP(bf16, WS_A1)); }
    xcd_barrier(bar);
    { KP pg8::Gemm g{WSP(bf16, WS_A1), WSP(bf16, WS_WTOUT), T_ALL, D_MODEL, MIX_WIDTH}; pg8::StaticOrder S; S.init(g.M, g.N, (int)gridDim.x, (int)blockIdx.x);
      pg8::EpiF32 E{WSP(float, WS_MIX), D_MODEL, nullptr}; pg8::gemm_phase<pg8::EpiF32, pg8::StaticOrder, false>(ldsb, g, S, E, nullptr); }
    xcd_barrier(bar);
    { KP ph_ln_res(IN(0), IN(1), WSP(float, WS_MIX), IN(14), IN(15), WSP(float, WS_HBUF), WSP(bf16, WS_A2)); }
    xcd_barrier(bar);
    { KP pg8::Gemm g{WSP(bf16, WS_A2), WSP(bf16, WS_WTQ), T_ALL, 2048, D_MODEL}; pg8::StaticOrder S; S.init(g.M, g.N, (int)gridDim.x, (int)blockIdx.x);
      pg8::EpiBf16Plain E{WSP(bf16, WS_QH), 2048}; pg8::gemm_phase<pg8::EpiBf16Plain, pg8::StaticOrder, false>(ldsb, g, S, E, nullptr); }
    xcd_barrier(bar);
    { KP ph_peer_route2(ldsb, WSP(bf16, WS_QH), IN(17), IN(18), WSP(int, WS_EIDX), WSP(float, WS_GATE)); }
    xcd_barrier(bar);
    { KP ph_peer_ffn3(WSP(float, WS_HBUF), WSP(int, WS_EIDX), WSP(float, WS_GATE), WSP(unsigned char, WS_UB), WSP(unsigned char, WS_VB), WSP(float, WS_USC), WSP(float, WS_VSC), IN(21), IN(22), kp->out, IN(2), IN(3)); }
}

extern "C" void kernel_launch(void* const* d_in, const int* in_sizes, int n_in, void* d_out, int out_size, void* d_ws, size_t ws_size, hipStream_t stream) {
    static int grid = 0;
    if (grid == 0) {
        int dev = 0, cus = 0, per_cu = 0;
        if (hipGetDevice(&dev) != hipSuccess || hipDeviceGetAttribute(&cus, hipDeviceAttributeMultiprocessorCount, dev) != hipSuccess) { fprintf(stderr, "kernel_launch: device query failed\n"); grid = -1; return; }
        if (hipFuncSetAttribute((const void*)mega_fwd, hipFuncAttributeMaxDynamicSharedMemorySize, LDS_BYTES) != hipSuccess) { fprintf(stderr, "kernel_launch: hipFuncSetAttribute failed\n"); grid = -1; return; }
        if (hipOccupancyMaxActiveBlocksPerMultiprocessor(&per_cu, (const void*)mega_fwd, NTHR, LDS_BYTES) != hipSuccess || per_cu < 1) { fprintf(stderr, "kernel_launch: occupancy query says %d\n", per_cu); }
        (void)hipGetLastError();
        grid = cus;
        if (ws_size < WS_END) { fprintf(stderr, "kernel_launch: workspace too small\n"); grid = -1; return; }
    }
    if (grid < 0) return;
    (void)hipMemsetAsync((char*)d_ws + WS_BAR, 0, XCD_BAR_WORDS * sizeof(unsigned), stream);
    Params p{};
    for (int i = 0; i < 23; ++i) p.in[i] = (const float*)d_in[i];
    p.out = (float*)d_out; p.ws = (unsigned char*)d_ws; p.bar = (unsigned*)((char*)d_ws + WS_BAR);
    hipLaunchKernelGGL(mega_fwd, dim3(grid), dim3(NTHR), LDS_BYTES, stream, p);
}
```

```cpp
#include <hip/hip_runtime.h>
#include <stdint.h>

#define D_MODEL 1024
#define BATCH 2
#define SEQ 8192
#define DEC_BATCH 128
#define DEC_SEQ 4
#define PAST_LEN 8192
#define HEAD_DIM 64
#define ATT_WIDTH 512
#define ATT_HEADS 8
#define SSD_WIDTH 1536
#define SSD_HEADS 24
#define SSD_GROUPS 4
#define SSD_STATE 128
#define CONV_DIM 2560
#define IN_WIDTH 5656
#define PROJ_LD 5888
#define MIX_WIDTH 2048
#define WBUF 2048
#define PEER_NKEYS 128
#define PEER_HEADS 8
#define PEER_TOPK 16
#define PEER_DKEY 256
#define T_PROMPT (BATCH * SEQ)
#define T_SAMPLE (DEC_BATCH * DEC_SEQ)
#define T_ALL (T_PROMPT + T_SAMPLE)
#define O_Z 0
#define O_XBC 1536
#define O_DT 4096
#define O_Q 4120
#define O_K 4632
#define O_V 5144
#define ALPHA_F 1.189207115002721f
#define LN_EPS 1e-5f

#define OUT_YP 0ull
#define OUT_YS (OUT_YP + 16777216ull)
#define OUT_PK (OUT_YS + 524288ull)
#define OUT_PV (OUT_PK + 2097152ull)
#define OUT_PC (OUT_PV + 2097152ull)
#define OUT_PS (OUT_PC + 15360ull)
#define OUT_SK (OUT_PS + 393216ull)
#define OUT_SV (OUT_SK + 134217728ull)
#define OUT_SC (OUT_SV + 134217728ull)
#define OUT_SS (OUT_SC + 983040ull)

__constant__ double ROPE_INV_REV[32] = {
    1.59154943091895346e-01, 1.19349370211248862e-01, 8.94994016088910133e-02, 6.71150830052272551e-02,
    5.03292121044870353e-02, 3.77415847174197711e-02, 2.83021958306233987e-02, 2.12236527647776604e-02,
    1.59154943091895339e-02, 1.19349370211248862e-02, 8.94994016088910237e-03, 6.71150830052272534e-03,
    5.03292121044870370e-03, 3.77415847174197719e-03, 2.83021958306233987e-03, 2.12236527647776622e-03,
    1.59154943091895356e-03, 1.19349370211248849e-03, 8.94994016088910237e-04, 6.71150830052272599e-04,
    5.03292121044870326e-04, 3.77415847174197741e-04, 2.83021958306233954e-04, 2.12236527647776605e-04,
    1.59154943091895351e-04, 1.19349370211248862e-04, 8.94994016088910182e-05, 6.71150830052272545e-05,
    5.03292121044870354e-05, 3.77415847174197768e-05, 2.83021958306233961e-05, 2.12236527647776592e-05
};

__device__ __forceinline__ float silu_f(float x) { return x / (1.0f + __expf(-x)); }
__device__ __forceinline__ float softplus_f(float x) { return fmaxf(x, 0.f) + log1pf(__expf(-fabsf(x))); }
__device__ __forceinline__ float gelu_f(float x) { return 0.5f * x * (1.0f + erff(x * 0.70710678118654752f)); }
__device__ __forceinline__ float wave_sum(float v) {
#pragma unroll
    for (int o = 32; o > 0; o >>= 1) v += __shfl_xor(v, o);
    return v;
}
__device__ __forceinline__ float wave_max(float v) {
#pragma unroll
    for (int o = 32; o > 0; o >>= 1) v = fmaxf(v, __shfl_xor(v, o));
    return v;
}

#include <cstdio>
#define XB_TMO      128
#define XB_XCNT(j)  (256  + 64 * (j))
#define XB_XSUB(j)  (1280 + 64 * (j))
#define XB_XGEN(j)  (2304 + 64 * (j))
#define XB_TOP      3328
#define XB_TOPGEN   3392
#define XCD_BAR_WORDS 3456
#define XB_SPIN_CAP (1u << 18)
#define LAS __attribute__((address_space(3)))

__device__ __forceinline__ unsigned xb_ld(unsigned* p)              { return __hip_atomic_load(p, __ATOMIC_RELAXED, __HIP_MEMORY_SCOPE_AGENT); }
__device__ __forceinline__ unsigned xb_add(unsigned* p, unsigned v) { return __hip_atomic_fetch_add(p, v, __ATOMIC_RELAXED, __HIP_MEMORY_SCOPE_AGENT); }
__device__ __forceinline__ unsigned xb_xcc_id() { return (unsigned)__builtin_amdgcn_s_getreg((3 << 11) | 20) & 0xFu; }
#define XB_SPIN(cond, bar) do { unsigned _sp = 0; while (cond) { __builtin_amdgcn_s_sleep(1); \
    if ((++_sp & 255u) == 0u) { if (xb_ld(&(bar)[XB_TMO])) break; if (_sp > XB_SPIN_CAP) { atomicAdd(&(bar)[XB_TMO], 1u); break; } } } } while (0)

struct XcdBarrier {
    unsigned* bar; unsigned x;
    volatile LAS unsigned* st;
};

__device__ __forceinline__ XcdBarrier xcd_barrier_post(unsigned* bar, volatile LAS unsigned* st) {
    XcdBarrier b; b.bar = bar; b.x = xb_xcc_id(); b.st = st;
    if (threadIdx.x == 0) (void)xb_add(&bar[XB_XCNT(b.x)], 1u);
    return b;
}
__device__ __forceinline__ void xcd_barrier_complete(unsigned* bar, unsigned x, unsigned& nloc, unsigned& nx) {
    const unsigned G = gridDim.x * gridDim.y * gridDim.z;
    unsigned sum, cnt, mine, sp = 0u;
    for (;;) {
        sum = 0u; cnt = 0u; mine = 0u;
#pragma unroll
        for (unsigned j = 0; j < 16; ++j) { const unsigned c = xb_ld(&bar[XB_XCNT(j)]); sum += c; cnt += (c > 0u) ? 1u : 0u; mine = (j == x) ? c : mine; }
        if (sum == G) break;
        __builtin_amdgcn_s_sleep(1);
        if ((++sp & 255u) == 0u) { if (xb_ld(&bar[XB_TMO])) break; if (sp > XB_SPIN_CAP) { atomicAdd(&bar[XB_TMO], 1u); break; } }
    }
    nloc = mine > 0u ? mine : 1u; nx = cnt > 0u ? cnt : 1u;
}

__device__ __forceinline__ void xcd_barrier(const XcdBarrier& b) {
    asm volatile("s_waitcnt vmcnt(0)" ::: "memory");
    __syncthreads();
    if (threadIdx.x == 0) {
        unsigned* bar = b.bar;
        __builtin_amdgcn_s_waitcnt(0);
        unsigned nloc = b.st[0], nx = b.st[1];
        if (nloc == 0u) { xcd_barrier_complete(bar, b.x, nloc, nx); b.st[0] = nloc; b.st[1] = nx; }
        const unsigned old = xb_add(&bar[XB_XSUB(b.x)], 1u);
        const unsigned gen = old / nloc;
        if (old + 1u == (gen + 1u) * nloc) {
            __builtin_amdgcn_fence(__ATOMIC_RELEASE, "agent");
            asm volatile("s_waitcnt vmcnt(0)" ::: "memory");
            const unsigned og = xb_add(&bar[XB_TOP], 1u);
            const unsigned tg = og / nx;
            if (og + 1u == (tg + 1u) * nx) xb_add(&bar[XB_TOPGEN], 1u);
            else XB_SPIN(xb_ld(&bar[XB_TOPGEN]) == tg, bar);
            __builtin_amdgcn_fence(__ATOMIC_ACQUIRE, "agent");
            xb_add(&bar[XB_XGEN(b.x)], 1u);
            asm volatile("s_waitcnt vmcnt(0)" ::: "memory");
        } else {
            XB_SPIN(xb_ld(&bar[XB_XGEN(b.x)]) == gen, bar);
            __builtin_amdgcn_fence(__ATOMIC_ACQUIRE, "agent");
            asm volatile("s_waitcnt vmcnt(0)" ::: "memory");
        }
    }
    __syncthreads();
}


#define GAS __attribute__((address_space(1)))
typedef unsigned short bf16;
typedef unsigned v4u __attribute__((ext_vector_type(4)));
#define LDS_WAIT() asm volatile("s_waitcnt lgkmcnt(0)" ::: "memory")
__device__ __forceinline__ unsigned f2bf(float f) { unsigned u = __builtin_bit_cast(unsigned, f); return (u + 0x7fffu + ((u >> 16) & 1u)) >> 16; }
__device__ __forceinline__ unsigned pk2(float lo, float hi) { return f2bf(lo) | (f2bf(hi) << 16); }
__device__ __forceinline__ float bf2f(unsigned short b) { return __builtin_bit_cast(float, (unsigned)b << 16); }
#include <hip/hip_runtime.h>
namespace pg8 {
#define PG8_LAS __attribute__((address_space(3)))
typedef unsigned short bf16_t;
typedef short bf16x8 __attribute__((ext_vector_type(8)));
typedef float f32x4 __attribute__((ext_vector_type(4)));
typedef unsigned u32x4 __attribute__((ext_vector_type(4)));
constexpr int BM = 256, BK = 64, HALF = 128, HTB = HALF * BK * 2  , STAGE_BYTES = 8 * HTB, NXCD = 8, WGM = 8;

__host__ __device__ __forceinline__ int lds_byte(int r, int c) { const int st = (r >> 4) * 2 + (c >> 5), rr = r & 15, cc = c & 31, ob = rr * 64 + cc * 2; return st * 1024 + (ob ^ (((ob >> 9) & 1) << 5)); }
__host__ __device__ __forceinline__ void stage_rc(int b, int& R, int& C) { const int st = b / 1024, sb = b % 1024, swz = sb ^ (((sb >> 9) & 1) << 5); R = (st >> 1) * 16 + swz / 64; C = (st & 1) * 32 + (swz % 64) / 2; }
__host__ __device__ __forceinline__ int perm32(int rho) { const int n = rho >> 4, i = rho & 15; return 8 * (i >> 2) + 4 * n + (i & 3); }

struct Unit { int pm, pn; };
struct Gemm { const bf16_t* A; const bf16_t* Bt; int M, N, K; };

struct StaticOrder {
    int nM, nN, nwg, G, c;
    __host__ __device__ void init(int M, int N, int G_, int c_) { nM = M / BM; nN = N / BM; nwg = nM * nN; G = G_; c = c_; }
    __host__ __device__ bool next(int i, Unit& u) const {
        const long L = (long)i * G + c; if (L >= nwg) return false;
        int wgid = (int)L; { const int q = nwg / NXCD, r = nwg % NXCD, xcd = wgid % NXCD, off = wgid / NXCD; wgid = (xcd < r ? xcd * (q + 1) : r * (q + 1) + (xcd - r) * q) + off; }
        const int nig = WGM * nN, gid = wgid / nig, fm = gid * WGM, gsz = (nM - fm) < WGM ? (nM - fm) : WGM;
        u.pm = fm + ((wgid % nig) % gsz); u.pn = (wgid % nig) / gsz; return true;
    }
    __device__ __forceinline__ void a_ready(const Unit&) const {}
    __device__ __forceinline__ void done(const Unit&) const {}
};
__device__ __forceinline__ unsigned cvt_pk_bf16(float lo, float hi) { unsigned r; asm volatile("v_cvt_pk_bf16_f32 %0, %1, %2" : "=v"(r) : "v"(lo), "v"(hi)); return r; }
typedef float f32x2 __attribute__((ext_vector_type(2)));
__device__ __forceinline__ f32x2 gelu_pk(f32x2 v) {
    const f32x2 av = __builtin_elementwise_abs(v), d = av * 0.2316418882f + 1.0f;
    f32x2 t; t.x = __builtin_amdgcn_rcpf(d.x); t.y = __builtin_amdgcn_rcpf(d.y);
    f32x2 q = t * 0.5307027145f + (-0.7265760135f); q = q * t + 0.7107068705f; q = q * t + (-0.142248368f); q = q * t + 0.127414796f; q = q * t;
    const f32x2 s = (v * v) * (-0.72134752044f);
    f32x2 e; e.x = __builtin_amdgcn_exp2f(s.x); e.y = __builtin_amdgcn_exp2f(s.y);
    const f32x2 m = v * (q * e), r = v - m;
    f32x2 o; o.x = v.x < 0.f ? m.x : r.x; o.y = v.y < 0.f ? m.y : r.y; return o;
}

struct EpiF32 {
    static constexpr bool PERM = false, AFTER_DRAIN = false;
    float* C; int ldc; const float* bias;
    __device__ __forceinline__ void operator()(const f32x4 (&acc)[2][2][4][2], const Unit& u, int wr, int wc, int fr, int fq) const {
        const int row0 = u.pm * BM + wr * 64 + fr, col0 = u.pn * BM + wc * 32 + 4 * fq;
        f32x4 bv[2][2];
#pragma unroll
        for (int bj = 0; bj < 2; ++bj)
#pragma unroll
            for (int n = 0; n < 2; ++n) bv[bj][n] = bias ? *(const f32x4*)(bias + col0 + bj * HALF + n * 16) : (f32x4){0.f, 0.f, 0.f, 0.f};
#pragma unroll
        for (int ai = 0; ai < 2; ++ai)
#pragma unroll
            for (int m = 0; m < 4; ++m) { float* rowp = C + (size_t)(row0 + ai * HALF + m * 16) * ldc + col0;
#pragma unroll
                for (int bj = 0; bj < 2; ++bj)
#pragma unroll
                    for (int n = 0; n < 2; ++n) *(f32x4*)(rowp + bj * HALF + n * 16) = acc[ai][bj][m][n] + bv[bj][n]; }
    }
};

template <class Epi, class Sched, bool STAMP = false>
__device__ __forceinline__ void gemm_phase(PG8_LAS unsigned char* lds, const Gemm g, const Sched& S, const Epi& E, unsigned long long* stamps) {
    const int tid = threadIdx.x, wid = __builtin_amdgcn_readfirstlane(tid >> 6), lane = tid & 63, wr = wid >> 2, wc = wid & 3, fr = lane & 15, fq = lane >> 4;
    const int K = g.K, nt = K / BK;
    int ts_lo = 0, ts_hi = 0, nts = 0; const unsigned long long rt_entry = STAMP ? (unsigned long long)wall_clock64() : 0ull;
#define PG8_STAMP() do { if (STAMP && wid == 0 && nts < 64) { const unsigned long long _c = (unsigned long long)clock64(); \
        ts_lo = (lane == nts) ? (int)(unsigned)_c : ts_lo; ts_hi = (lane == nts) ? (int)(unsigned)(_c >> 32) : ts_hi; ++nts; } } while (0)
    PG8_STAMP();
    unsigned voffA[2], voffB[2];
#pragma unroll
    for (int i = 0; i < 2; ++i) { int R, C; stage_rc(tid * 16 + i * 8192, R, C); const int Rb = Epi::PERM ? ((R & ~31) + perm32(R & 31)) : R;
        voffA[i] = (unsigned)(R * K + C) * 2u; voffB[i] = (unsigned)(Rb * K + C) * 2u; }
    const size_t kstep = (size_t)(BK * 2);
    const size_t hstep = (size_t)HALF * K * 2;
    const size_t tstep = 2 * hstep;
    const unsigned ldsw = (unsigned)wid * 1024u;
    const int aoff = lds_byte(wr * 64 + fr, fq * 8), boff = lds_byte(wc * 32 + fr, fq * 8);
#define PG8_SA(b, h) (((b) * 2 + (h)) * HTB)
#define PG8_SB(b, h) ((4 + (b) * 2 + (h)) * HTB)
#define PG8_STAGE(bufoff, gbase, voff) do { _Pragma("unroll") for (int _i = 0; _i < 2; ++_i) \
        __builtin_amdgcn_global_load_lds((const unsigned*)((const char*)(gbase) + (voff)[_i]), (PG8_LAS unsigned*)(lds + (bufoff) + ldsw + _i * 8192), 16, 0, 0); } while (0)
#define PG8_LDA(dst, b, h) do { _Pragma("unroll") for (int m = 0; m < 4; ++m) _Pragma("unroll") for (int k = 0; k < 2; ++k) dst[m][k] = *(const PG8_LAS bf16x8*)(lds + PG8_SA(b, h) + aoff + m * 2048 + k * 1024); } while (0)
#define PG8_LDB(dst, b, h) do { _Pragma("unroll") for (int n = 0; n < 2; ++n) _Pragma("unroll") for (int k = 0; k < 2; ++k) dst[n][k] = *(const PG8_LAS bf16x8*)(lds + PG8_SB(b, h) + boff + n * 2048 + k * 1024); } while (0)
#define PG8_MMA(ai, bj, At, Bt) do { __builtin_amdgcn_s_setprio(1); _Pragma("unroll") for (int m = 0; m < 4; ++m) _Pragma("unroll") for (int n = 0; n < 2; ++n) _Pragma("unroll") for (int k = 0; k < 2; ++k) \
        acc[ai][bj][m][n] = __builtin_amdgcn_mfma_f32_16x16x32_bf16(Bt[n][k], At[m][k], acc[ai][bj][m][n], 0, 0, 0); __builtin_amdgcn_s_setprio(0); } while (0)
#define PG8_WAIT_V(n) asm volatile("s_waitcnt vmcnt(" #n ")" ::: "memory")
#define PG8_WAIT_L(n) asm volatile("s_waitcnt lgkmcnt(" #n ")" ::: "memory")
#define PG8_BAR __builtin_amdgcn_s_barrier()
#define PG8_SCHED __builtin_amdgcn_sched_barrier(0)
    Unit cur, nxt; int ui = 0;
    if (!S.next(0, cur)) return;
    f32x4 acc[2][2][4][2];
#pragma unroll
    for (int a = 0; a < 2; ++a)
#pragma unroll
        for (int b = 0; b < 2; ++b)
#pragma unroll
            for (int m = 0; m < 4; ++m)
#pragma unroll
                for (int n = 0; n < 2; ++n) acc[a][b][m][n] = (f32x4){0.f, 0.f, 0.f, 0.f};
    bf16x8 At[4][2], B0[2][2], B1[2][2];
    const char* cA = (const char*)g.A + (size_t)cur.pm * tstep; const char* cB = (const char*)g.Bt + (size_t)cur.pn * tstep;
    S.a_ready(cur);
    PG8_STAGE(PG8_SB(0, 0), cB, voffB); PG8_STAGE(PG8_SA(0, 0), cA, voffA); PG8_STAGE(PG8_SB(0, 1), cB + hstep, voffB); PG8_STAGE(PG8_SA(0, 1), cA + hstep, voffA);
    if (wr == 1) PG8_BAR;
    PG8_WAIT_V(4); PG8_BAR;
    PG8_STAGE(PG8_SB(1, 0), cB + kstep, voffB); PG8_STAGE(PG8_SA(1, 0), cA + kstep, voffA); PG8_STAGE(PG8_SB(1, 1), cB + hstep + kstep, voffB);
    PG8_WAIT_V(6); PG8_BAR;
    PG8_STAMP();
    for (;;) {
        const bool has_next = S.next(ui + 1, nxt);
        const char* nA = has_next ? (const char*)g.A + (size_t)nxt.pm * tstep : cA; const char* nB = has_next ? (const char*)g.Bt + (size_t)nxt.pn * tstep : cB;
        for (int t = 0; t < nt; t += 2) {
            const bool last = (t == nt - 2);
            const char* a1 = cA + (size_t)(t + 1) * kstep;
            const char* a2 = last ? nA : cA + (size_t)(t + 2) * kstep; const char* b2 = last ? nB : cB + (size_t)(t + 2) * kstep;
            const char* a3 = a2 + kstep; const char* b3 = b2 + kstep;
            if (last && has_next) S.a_ready(nxt);
            PG8_LDB(B0, 0, 0); PG8_SCHED; PG8_LDA(At, 0, 0); PG8_STAGE(PG8_SA(1, 1), a1 + hstep, voffA);
            PG8_WAIT_L(8); PG8_BAR; PG8_WAIT_L(0); PG8_MMA(0, 0, At, B0); PG8_BAR; PG8_SCHED;
            PG8_LDB(B1, 0, 1); PG8_STAGE(PG8_SB(0, 0), b2, voffB);
            PG8_BAR; PG8_WAIT_L(0); PG8_MMA(0, 1, At, B1); PG8_BAR;
            PG8_LDA(At, 0, 1); PG8_STAGE(PG8_SA(0, 0), a2, voffA);
            PG8_BAR; PG8_WAIT_L(0); PG8_MMA(1, 0, At, B0); PG8_BAR; PG8_SCHED;
            PG8_STAGE(PG8_SB(0, 1), b2 + hstep, voffB);
            PG8_WAIT_V(6); PG8_BAR; PG8_MMA(1, 1, At, B1); PG8_BAR;
            PG8_LDB(B0, 1, 0); PG8_SCHED; PG8_LDA(At, 1, 0); PG8_STAGE(PG8_SA(0, 1), a2 + hstep, voffA);
            PG8_WAIT_L(8); PG8_BAR; PG8_WAIT_L(0); PG8_MMA(0, 0, At, B0); PG8_BAR; PG8_SCHED;
            PG8_LDB(B1, 1, 1); PG8_STAGE(PG8_SB(1, 0), b3, voffB);
            PG8_BAR; PG8_WAIT_L(0); PG8_MMA(0, 1, At, B1); PG8_BAR;
            PG8_LDA(At, 1, 1); PG8_STAGE(PG8_SA(1, 0), a3, voffA);
            PG8_BAR; PG8_WAIT_L(0); PG8_MMA(1, 0, At, B0); PG8_BAR; PG8_SCHED;
            PG8_STAGE(PG8_SB(1, 1), b3 + hstep, voffB);
            PG8_WAIT_V(6); PG8_BAR; PG8_MMA(1, 1, At, B1); PG8_BAR;
        }
        PG8_STAMP();
        if constexpr (!Epi::AFTER_DRAIN) { E(acc, cur, wr, wc, fr, fq); S.done(cur); }
        PG8_STAMP();
        if (!has_next) break;
#pragma unroll
        for (int a = 0; a < 2; ++a)
#pragma unroll
            for (int b = 0; b < 2; ++b)
#pragma unroll
                for (int m = 0; m < 4; ++m)
#pragma unroll
                    for (int n = 0; n < 2; ++n) acc[a][b][m][n] = (f32x4){0.f, 0.f, 0.f, 0.f};
        cur = nxt; cA = nA; cB = nB; ++ui;
    }
    PG8_WAIT_V(0);
    if (wr == 0) PG8_BAR;
    PG8_BAR;
    if constexpr (Epi::AFTER_DRAIN) { E.fused(acc, cur, wr, wc, fr, fq, lds, wid, lane); S.done(cur); }
    PG8_STAMP();
    if (STAMP && wid == 0) { stamps[lane] = lane < nts ? (((unsigned long long)(unsigned)ts_hi << 32) | (unsigned)ts_lo) : 0ull;
        if (lane == 62) stamps[62] = rt_entry; if (lane == 63) stamps[63] = (unsigned long long)wall_clock64(); }
#undef PG8_STAMP
#undef PG8_SA
#undef PG8_SB
#undef PG8_STAGE
#undef PG8_LDA
#undef PG8_LDB
#undef PG8_MMA
#undef PG8_WAIT_V
#undef PG8_WAIT_L
#undef PG8_BAR
#undef PG8_SCHED
}
}


namespace pg8 {
struct EpiProj {
    static constexpr bool PERM = true, AFTER_DRAIN = false;
    bf16_t* O; float* dtraw;
    __device__ __forceinline__ void operator()(const f32x4 (&acc)[2][2][4][2], const Unit& u, int wr, int wc, int fr, int fq) const {
        const int row0 = u.pm * BM + wr * 64 + fr;
        if (u.pn < 22) {
            const int col0 = u.pn * BM + wc * 32 + 8 * fq;
#pragma unroll
            for (int ai = 0; ai < 2; ++ai)
#pragma unroll
                for (int m = 0; m < 4; ++m) { bf16_t* rowp = O + (size_t)(row0 + ai * HALF + m * 16) * 5632 + col0;
#pragma unroll
                    for (int bj = 0; bj < 2; ++bj) { const f32x4 v0 = acc[ai][bj][m][0], v1 = acc[ai][bj][m][1];
                        u32x4 w; w.x = cvt_pk_bf16(v0[0], v0[1]); w.y = cvt_pk_bf16(v0[2], v0[3]); w.z = cvt_pk_bf16(v1[0], v1[1]); w.w = cvt_pk_bf16(v1[2], v1[3]);
                        *(u32x4*)(rowp + bj * HALF) = w; } }
        } else if (wc == 0) {
#pragma unroll
            for (int ai = 0; ai < 2; ++ai)
#pragma unroll
                for (int m = 0; m < 4; ++m) { float* rp = dtraw + (size_t)(row0 + ai * HALF + m * 16) * 32 + 8 * fq;
                    *(f32x4*)rp = acc[ai][0][m][0]; *(f32x4*)(rp + 4) = acc[ai][0][m][1]; }
        }
    }
};
}


namespace pg8 {
struct EpiBf16Plain {
    static constexpr bool PERM = true, AFTER_DRAIN = false;
    bf16_t* O; int ldc;
    __device__ __forceinline__ void operator()(const f32x4 (&acc)[2][2][4][2], const Unit& u, int wr, int wc, int fr, int fq) const {
        const int row0 = u.pm * BM + wr * 64 + fr, col0 = u.pn * BM + wc * 32 + 8 * fq;
#pragma unroll
        for (int ai = 0; ai < 2; ++ai)
#pragma unroll
            for (int m = 0; m < 4; ++m) { bf16_t* rowp = O + (size_t)(row0 + ai * HALF + m * 16) * ldc + col0;
#pragma unroll
                for (int bj = 0; bj < 2; ++bj) { const f32x4 v0 = acc[ai][bj][m][0], v1 = acc[ai][bj][m][1];
                    u32x4 w; w.x = cvt_pk_bf16(v0[0], v0[1]); w.y = cvt_pk_bf16(v0[2], v0[3]); w.z = cvt_pk_bf16(v1[0], v1[1]); w.w = cvt_pk_bf16(v1[2], v1[3]);
                    *(u32x4*)(rowp + bj * HALF) = w; } }
    }
};
}

#define NTHR 512
#define NWAVE 8

__device__ __forceinline__ void ph_gemm_f32(float* lds, const float* __restrict__ A, const float* __restrict__ B, float* __restrict__ C,
                                            int M, int N, int K, int lda, int ldb, int ldc) {
    const int tid = threadIdx.x & 255, half = threadIdx.x >> 8, tx = tid & 15, ty = tid >> 4;
    float (*As)[68] = (float (*)[68])(lds + half * 2 * 16 * 68);
    float (*Bs)[68] = (float (*)[68])(lds + half * 2 * 16 * 68 + 16 * 68);
    const int ntx = (N + 63) / 64, nty = M / 64, ntiles = ntx * nty;
    for (int it = blockIdx.x; 2 * it < ntiles; it += gridDim.x) {
        const int tile = 2 * it + half;
        const int m0 = (tile / ntx) * 64, n0 = (tile % ntx) * 64;
        float acc[4][4];
#pragma unroll
        for (int i = 0; i < 4; ++i)
#pragma unroll
            for (int j = 0; j < 4; ++j) acc[i][j] = 0.f;
        for (int k0 = 0; k0 < K; k0 += 16) {
#pragma unroll
            for (int i = 0; i < 4; ++i) {
                int idx = tid + i * 256;
                int r = idx >> 4, c = idx & 15;
                As[c][r] = (m0 + r < M) ? A[(size_t)(m0 + r) * lda + k0 + c] : 0.f;
                int rb = idx >> 6, cb = idx & 63;
                Bs[rb][cb] = (n0 + cb < N) ? B[(size_t)(k0 + rb) * ldb + n0 + cb] : 0.f;
            }
            __syncthreads();
#pragma unroll
            for (int k = 0; k < 16; ++k) {
                float a[4], b[4];
#pragma unroll
                for (int i = 0; i < 4; ++i) { a[i] = As[k][ty * 4 + i]; b[i] = Bs[k][tx * 4 + i]; }
#pragma unroll
                for (int i = 0; i < 4; ++i)
#pragma unroll
                    for (int j = 0; j < 4; ++j) acc[i][j] += a[i] * b[j];
            }
            __syncthreads();
        }
#pragma unroll
        for (int i = 0; i < 4; ++i)
#pragma unroll
            for (int j = 0; j < 4; ++j) {
                int r = m0 + ty * 4 + i, c = n0 + tx * 4 + j;
                if (r < M && c < N) C[(size_t)r * ldc + c] = acc[i][j];
            }
    }
}


template <int MODE>
__device__ __forceinline__ void transpose_item(const float* __restrict__ W, int K, int N, int Npad, bf16* __restrict__ WT, LAS float* scr, int item, int lane) {
    const int nblk = Npad / 32, kb = item / nblk, nb = item % nblk, k0 = 64 * kb, n0 = 32 * nb;
    const int n = n0 + (lane & 31);
    int sc = n;
    if (MODE == 1) sc = (n < 4096) ? n : (n < 5632 ? n + 24 : (n < 5656 ? n - 5632 + 4096 : -1));
    else sc = (n < N) ? n : -1;
#pragma unroll 8
    for (int i = 0; i < 32; ++i) { const int kk = 2 * i + (lane >> 5); scr[kk * 33 + (lane & 31)] = (sc >= 0) ? W[(size_t)(k0 + kk) * N + sc] : 0.f; }
    LDS_WAIT(); asm volatile("" ::: "memory");
    const int c = lane & 7;
#pragma unroll
    for (int j = 0; j < 4; ++j) { const int nn = (lane >> 3) + 8 * j; const LAS float* s = scr + (8 * c) * 33 + nn;
        v4u o; o.x = pk2(s[0 * 33], s[1 * 33]); o.y = pk2(s[2 * 33], s[3 * 33]); o.z = pk2(s[4 * 33], s[5 * 33]); o.w = pk2(s[6 * 33], s[7 * 33]);
        *(v4u*)(WT + (size_t)(n0 + nn) * K + k0 + 8 * c) = o; }
    LDS_WAIT(); asm volatile("" ::: "memory");
}
__device__ __forceinline__ void ph_prologue(LAS unsigned char* ldsb, const float* __restrict__ xp, const float* __restrict__ xs, bf16* __restrict__ A0,
                                            const float* __restrict__ w_in, bf16* __restrict__ wt_in, float* __restrict__ rope_tab) {
    const int lane = threadIdx.x & 63, wave = threadIdx.x >> 6;
    LAS float* scr = (LAS float*)(ldsb + wave * 16384);
    const int gw = blockIdx.x * NWAVE + wave, NGW = gridDim.x * NWAVE;
    constexpr int I_IN = (D_MODEL / 64) * (PROJ_LD / 32);
    for (int it = gw; it < I_IN; it += NGW) transpose_item<1>(w_in, D_MODEL, IN_WIDTH, PROJ_LD, wt_in, scr, it, lane);
    for (int idx = blockIdx.x * NTHR + threadIdx.x; idx < SEQ * 32; idx += gridDim.x * NTHR) {
        const int pos = idx >> 5, j = idx & 31;
        const double rev = (double)pos * ROPE_INV_REV[j];
        const float fr = (float)(rev - floor(rev));
        rope_tab[(size_t)pos * 64 + j] = __builtin_amdgcn_cosf(fr); rope_tab[(size_t)pos * 64 + 32 + j] = __builtin_amdgcn_sinf(fr);
    }
    const size_t n8 = (size_t)T_ALL * D_MODEL / 8, np8 = (size_t)T_PROMPT * D_MODEL / 8;
#pragma unroll 4
    for (size_t i = (size_t)blockIdx.x * NTHR + threadIdx.x; i < n8; i += (size_t)gridDim.x * NTHR) {
        const float4* s = (i < np8) ? (const float4*)xp + 2 * i : (const float4*)xs + 2 * (i - np8);
        float4 a = s[0], b = s[1];
        v4u o; o.x = pk2(a.x, a.y); o.y = pk2(a.z, a.w); o.z = pk2(b.x, b.y); o.w = pk2(b.z, b.w);
        ((v4u*)A0)[i] = o;
    }
}
__device__ __forceinline__ void ph_prologue2(LAS unsigned char* ldsb, const float* __restrict__ w_out, bf16* __restrict__ wt_out, const float* __restrict__ w_q, bf16* __restrict__ wt_q,
                                             int rank, int nranks) {
    const int lane = threadIdx.x & 63, wave = threadIdx.x >> 6;
    LAS float* scr = (LAS float*)(ldsb + wave * 16384);
    constexpr int I_OUT = (MIX_WIDTH / 64) * (D_MODEL / 32), I_Q = (D_MODEL / 64) * (2048 / 32);
    for (int it = rank * NWAVE + wave; it < I_OUT + I_Q; it += nranks * NWAVE) {
        if (it < I_OUT) transpose_item<0>(w_out, MIX_WIDTH, D_MODEL, D_MODEL, wt_out, scr, it, lane);
        else transpose_item<0>(w_q, D_MODEL, 2048, 2048, wt_q, scr, it - I_OUT, lane);
    }
}

__device__ __forceinline__ void ph_concat_x(const float* __restrict__ xp, const float* __restrict__ xs, float* __restrict__ xall) {
    const size_t n4 = (size_t)T_ALL * D_MODEL / 4, np4 = (size_t)T_PROMPT * D_MODEL / 4;
    for (size_t i = (size_t)blockIdx.x * NTHR + threadIdx.x; i < n4; i += (size_t)gridDim.x * NTHR) {
        float4 v = (i < np4) ? ((const float4*)xp)[i] : ((const float4*)xs)[i - np4];
        ((float4*)xall)[i] = v;
    }
}

typedef float f32x4n __attribute__((ext_vector_type(4)));
__device__ __forceinline__ void ph_cache_copy(const float* __restrict__ ck, const float* __restrict__ cv, float* __restrict__ out) {
    constexpr unsigned PER_B = (WBUF - DEC_SEQ) * ATT_WIDTH / 4;
    constexpr unsigned TOTAL = 2u * DEC_BATCH * PER_B;
    for (unsigned c = blockIdx.x; c < TOTAL / 4096u; c += gridDim.x) {
        f32x4n v[8]; size_t dsti[8]; bool isv[8];
#pragma unroll
        for (int j = 0; j < 8; ++j) {
            const unsigned idx = c * 4096u + j * 512u + threadIdx.x;
            const unsigned tb = idx / PER_B, r = idx - tb * PER_B, bb = tb & (DEC_BATCH - 1);
            isv[j] = tb >= DEC_BATCH;
            const size_t srci = (size_t)bb * (WBUF * ATT_WIDTH / 4) + (DEC_SEQ * ATT_WIDTH / 4) + r;
            dsti[j] = (size_t)bb * (WBUF * ATT_WIDTH / 4) + r;
            v[j] = __builtin_nontemporal_load((isv[j] ? (const f32x4n*)cv : (const f32x4n*)ck) + srci);
        }
#pragma unroll
        for (int j = 0; j < 8; ++j) __builtin_nontemporal_store(v[j], (f32x4n*)(out + (isv[j] ? OUT_SV : OUT_SK)) + dsti[j]);
    }
}

__device__ __forceinline__ void ph_post_proj(const float* __restrict__ proj, const float* __restrict__ state_conv,
                                             const float* __restrict__ conv_w, const float* __restrict__ conv_b, const float* __restrict__ dt_bias,
                                             float* __restrict__ xbc_act, float* __restrict__ dtv, float* __restrict__ qrot, float* __restrict__ krot,
                                             float* __restrict__ out) {
    const int tid = threadIdx.x & 255, half = threadIdx.x >> 8;
    for (int t = 2 * blockIdx.x + half; t < T_ALL; t += 2 * gridDim.x) {
        const bool is_p = t < T_PROMPT;
        int b, i, pos;
        if (is_p) { b = t / SEQ; i = t % SEQ; pos = i; } else { int ts = t - T_PROMPT; b = ts / DEC_SEQ; i = ts % DEC_SEQ; pos = PAST_LEN + i; }
        const float* row = proj + (size_t)t * PROJ_LD;
        for (int c = tid; c < CONV_DIM; c += 256) {
            float acc = conv_b[c];
#pragma unroll
            for (int tap = 0; tap < 4; ++tap) {
                int r = i - 3 + tap;
                float val;
                if (r >= 0) val = proj[(size_t)(t - i + r) * PROJ_LD + O_XBC + c];
                else val = is_p ? 0.f : state_conv[((size_t)b * 3 + (3 + r)) * CONV_DIM + c];
                acc += val * conv_w[tap * CONV_DIM + c];
            }
            xbc_act[(size_t)t * CONV_DIM + c] = silu_f(acc);
        }
        if (tid < SSD_HEADS) dtv[(size_t)t * SSD_HEADS + tid] = softplus_f(row[O_DT + tid] + dt_bias[tid]);
        for (int idx = tid; idx < 512; idx += 256) {
            int which = idx >> 8, h = (idx >> 5) & 7, j = idx & 31;
            double rev = (double)pos * ROPE_INV_REV[j];
            float fr = (float)(rev - floor(rev));
            float sn = __builtin_amdgcn_sinf(fr), cs = __builtin_amdgcn_cosf(fr);
            const float* src = row + (which ? O_K : O_Q) + h * 64;
            float t1 = src[j], t2 = src[j + 32];
            float o1 = t1 * cs - t2 * sn, o2 = t2 * cs + t1 * sn;
            float* dst = (which ? krot : qrot) + (size_t)t * ATT_WIDTH + h * 64;
            dst[j] = o1; dst[j + 32] = o2;
            if (which) {
                if (is_p) { if (i >= SEQ - WBUF) { float* o = out + OUT_PK + ((size_t)b * WBUF + (i - (SEQ - WBUF))) * ATT_WIDTH + h * 64; o[j] = o1; o[j + 32] = o2; } }
                else { float* o = out + OUT_SK + ((size_t)b * WBUF + (WBUF - DEC_SEQ + i)) * ATT_WIDTH + h * 64; o[j] = o1; o[j + 32] = o2; }
            }
        }
        for (int c = tid; c < ATT_WIDTH; c += 256) {
            float v = row[O_V + c];
            if (is_p) { if (i >= SEQ - WBUF) out[OUT_PV + ((size_t)b * WBUF + (i - (SEQ - WBUF))) * ATT_WIDTH + c] = v; }
            else out[OUT_SV + ((size_t)b * WBUF + (WBUF - DEC_SEQ + i)) * ATT_WIDTH + c] = v;
        }
        if (is_p) {
            if (i >= SEQ - 3) { int r = i - (SEQ - 3); for (int c = tid; c < CONV_DIM; c += 256) out[OUT_PC + ((size_t)b * 3 + r) * CONV_DIM + c] = row[O_XBC + c]; }
        } else {
            if (i >= 1) { int r = i - 1; for (int c = tid; c < CONV_DIM; c += 256) out[OUT_SC + ((size_t)b * 3 + r) * CONV_DIM + c] = row[O_XBC + c]; }
        }
    }
}


#define NB_LD 5632
#define NB_XBC 1536
#define NB_Q 4096
#define NB_K 4608
#define NB_V 5120
__device__ __forceinline__ void unpack8(const v4u w, float (&f)[8]) {
    f[0] = __builtin_bit_cast(float, w.x << 16); f[1] = __builtin_bit_cast(float, w.x & 0xffff0000u);
    f[2] = __builtin_bit_cast(float, w.y << 16); f[3] = __builtin_bit_cast(float, w.y & 0xffff0000u);
    f[4] = __builtin_bit_cast(float, w.z << 16); f[5] = __builtin_bit_cast(float, w.z & 0xffff0000u);
    f[6] = __builtin_bit_cast(float, w.w << 16); f[7] = __builtin_bit_cast(float, w.w & 0xffff0000u);
}
__device__ __forceinline__ void store8f(float* d, const float (&f)[8]) { *(float4*)d = make_float4(f[0], f[1], f[2], f[3]); *(float4*)(d + 4) = make_float4(f[4], f[5], f[6], f[7]); }
__device__ __forceinline__ void ph_post_proj2(const bf16* __restrict__ projb, const float* __restrict__ dtraw, const float* __restrict__ state_conv,
                                              const float* __restrict__ conv_w, const float* __restrict__ conv_b, const float* __restrict__ dt_bias,
                                              bf16* __restrict__ xbc_b, float* __restrict__ dtv, bf16* __restrict__ qrot_b, bf16* __restrict__ krot_b,
                                              float* __restrict__ out) {
    const int tid = threadIdx.x & 255, half = threadIdx.x >> 8;
    for (int t = T_PROMPT + 2 * blockIdx.x + half; t < T_ALL; t += 2 * gridDim.x) {
        const bool is_p = t < T_PROMPT;
        int b, i, pos;
        if (is_p) { b = t / SEQ; i = t % SEQ; pos = i; } else { int ts = t - T_PROMPT; b = ts / DEC_SEQ; i = ts % DEC_SEQ; pos = PAST_LEN + i; }
        const bf16* row = projb + (size_t)t * NB_LD;
        if (tid < 64) {
            float f[8]; unpack8(*(const v4u*)(row + NB_V + tid * 8), f);
            if (is_p) { if (i >= SEQ - WBUF) store8f(out + OUT_PV + ((size_t)b * WBUF + (i - (SEQ - WBUF))) * ATT_WIDTH + tid * 8, f); }
            else store8f(out + OUT_SV + ((size_t)b * WBUF + (WBUF - DEC_SEQ + i)) * ATT_WIDTH + tid * 8, f);
        }
        for (int c8 = tid; c8 < 320; c8 += 256) {
            const int c = c8 * 8;
            float acc[8], cur[8];
            { const float4 b0 = *(const float4*)(conv_b + c), b1 = *(const float4*)(conv_b + c + 4);
              acc[0] = b0.x; acc[1] = b0.y; acc[2] = b0.z; acc[3] = b0.w; acc[4] = b1.x; acc[5] = b1.y; acc[6] = b1.z; acc[7] = b1.w; }
#pragma unroll
            for (int tap = 0; tap < 4; ++tap) {
                const int r = i - 3 + tap;
                float val[8];
                if (r >= 0) unpack8(*(const v4u*)(projb + (size_t)(t - i + r) * NB_LD + NB_XBC + c), val);
                else if (!is_p) { const float* sp = state_conv + ((size_t)b * 3 + (3 + r)) * CONV_DIM + c; const float4 s0 = *(const float4*)sp, s1 = *(const float4*)(sp + 4);
                    val[0] = s0.x; val[1] = s0.y; val[2] = s0.z; val[3] = s0.w; val[4] = s1.x; val[5] = s1.y; val[6] = s1.z; val[7] = s1.w; }
                else {
#pragma unroll
                    for (int j = 0; j < 8; ++j) val[j] = 0.f; }
                const float4 w0 = *(const float4*)(conv_w + tap * CONV_DIM + c), w1 = *(const float4*)(conv_w + tap * CONV_DIM + c + 4);
                acc[0] += val[0] * w0.x; acc[1] += val[1] * w0.y; acc[2] += val[2] * w0.z; acc[3] += val[3] * w0.w;
                acc[4] += val[4] * w1.x; acc[5] += val[5] * w1.y; acc[6] += val[6] * w1.z; acc[7] += val[7] * w1.w;
                if (tap == 3) {
#pragma unroll
                    for (int j = 0; j < 8; ++j) cur[j] = val[j]; }
            }
#pragma unroll
            for (int j = 0; j < 8; ++j) acc[j] = silu_f(acc[j]);
            v4u o; o.x = pk2(acc[0], acc[1]); o.y = pk2(acc[2], acc[3]); o.z = pk2(acc[4], acc[5]); o.w = pk2(acc[6], acc[7]);
            *(v4u*)(xbc_b + (size_t)t * CONV_DIM + c) = o;
            if (is_p) { if (i >= SEQ - 3) store8f(out + OUT_PC + ((size_t)b * 3 + (i - (SEQ - 3))) * CONV_DIM + c, cur); }
            else { if (i >= 1) store8f(out + OUT_SC + ((size_t)b * 3 + (i - 1)) * CONV_DIM + c, cur); }
        }
        if (tid < SSD_HEADS) dtv[(size_t)t * SSD_HEADS + tid] = softplus_f(dtraw[(size_t)t * 32 + tid] + dt_bias[tid]);
        if (tid < 128) {
            const int which = tid >> 6, h = (tid >> 3) & 7, jc = tid & 7;
            const bf16* src = row + (which ? NB_K : NB_Q) + h * 64 + jc * 4;
            const uint2 lo = *(const uint2*)src, hi = *(const uint2*)(src + 32);
            float t1[4], t2[4], o1[4], o2[4];
            t1[0] = __builtin_bit_cast(float, lo.x << 16); t1[1] = __builtin_bit_cast(float, lo.x & 0xffff0000u); t1[2] = __builtin_bit_cast(float, lo.y << 16); t1[3] = __builtin_bit_cast(float, lo.y & 0xffff0000u);
            t2[0] = __builtin_bit_cast(float, hi.x << 16); t2[1] = __builtin_bit_cast(float, hi.x & 0xffff0000u); t2[2] = __builtin_bit_cast(float, hi.y << 16); t2[3] = __builtin_bit_cast(float, hi.y & 0xffff0000u);
#pragma unroll
            for (int e = 0; e < 4; ++e) {
                const double rev = (double)pos * ROPE_INV_REV[jc * 4 + e];
                const float fr = (float)(rev - floor(rev));
                const float sn = __builtin_amdgcn_sinf(fr), cs = __builtin_amdgcn_cosf(fr);
                o1[e] = t1[e] * cs - t2[e] * sn; o2[e] = t2[e] * cs + t1[e] * sn;
            }
            const size_t doff = (size_t)t * ATT_WIDTH + h * 64 + jc * 4;
            bf16* db = which ? krot_b : qrot_b;
            *(uint2*)(db + doff) = make_uint2(pk2(o1[0], o1[1]), pk2(o1[2], o1[3])); *(uint2*)(db + doff + 32) = make_uint2(pk2(o2[0], o2[1]), pk2(o2[2], o2[3]));
            if (which) {
                float* o = nullptr;
                if (is_p) { if (i >= SEQ - WBUF) o = out + OUT_PK + ((size_t)b * WBUF + (i - (SEQ - WBUF))) * ATT_WIDTH + h * 64 + jc * 4; }
                else o = out + OUT_SK + ((size_t)b * WBUF + (WBUF - DEC_SEQ + i)) * ATT_WIDTH + h * 64 + jc * 4;
                if (o) { *(float4*)o = make_float4(o1[0], o1[1], o1[2], o1[3]); *(float4*)(o + 32) = make_float4(o2[0], o2[1], o2[2], o2[3]); }
            }
        }
    }
}


__device__ __forceinline__ void ph_post_proj_prompt(const bf16* __restrict__ projb, const float* __restrict__ dtraw, const float* __restrict__ conv_w, const float* __restrict__ conv_b,
                                                    const float* __restrict__ dt_bias, const float* __restrict__ rope_tab, bf16* __restrict__ xbc_b, float* __restrict__ dtv,
                                                    bf16* __restrict__ qrot_b, bf16* __restrict__ krot_b, float* __restrict__ out) {
    const int gtid = blockIdx.x * NTHR + threadIdx.x, gsz = gridDim.x * NTHR;
    for (int item = gtid; item < (T_PROMPT / 16) * 320; item += gsz) {
        const int run = item / 320, c = (item - run * 320) * 8, t0 = run * 16, i0 = t0 & (SEQ - 1), b = t0 >> 13;
        float w[4][8], bias[8];
#pragma unroll
        for (int tap = 0; tap < 4; ++tap) { const float4 w0 = *(const float4*)(conv_w + tap * CONV_DIM + c), w1 = *(const float4*)(conv_w + tap * CONV_DIM + c + 4);
            w[tap][0] = w0.x; w[tap][1] = w0.y; w[tap][2] = w0.z; w[tap][3] = w0.w; w[tap][4] = w1.x; w[tap][5] = w1.y; w[tap][6] = w1.z; w[tap][7] = w1.w; }
        { const float4 b0 = *(const float4*)(conv_b + c), b1 = *(const float4*)(conv_b + c + 4);
          bias[0] = b0.x; bias[1] = b0.y; bias[2] = b0.z; bias[3] = b0.w; bias[4] = b1.x; bias[5] = b1.y; bias[6] = b1.z; bias[7] = b1.w; }
        const bf16* src = projb + (size_t)t0 * NB_LD + NB_XBC + c;
        v4u raw[19];
#pragma unroll
        for (int s = 0; s < 19; ++s) { v4u z; z.x = 0u; z.y = 0u; z.z = 0u; z.w = 0u; raw[s] = (s >= 3 || i0 != 0) ? *(const v4u*)(src + (ptrdiff_t)(s - 3) * NB_LD) : z; }
        float p0[8], p1[8], p2[8];
        unpack8(raw[0], p0); unpack8(raw[1], p1); unpack8(raw[2], p2);
#pragma unroll
        for (int s = 0; s < 16; ++s) {
            float cur[8], acc[8]; unpack8(raw[s + 3], cur);
#pragma unroll
            for (int j = 0; j < 8; ++j) acc[j] = silu_f(bias[j] + p0[j] * w[0][j] + p1[j] * w[1][j] + p2[j] * w[2][j] + cur[j] * w[3][j]);
            v4u o; o.x = pk2(acc[0], acc[1]); o.y = pk2(acc[2], acc[3]); o.z = pk2(acc[4], acc[5]); o.w = pk2(acc[6], acc[7]);
            *(v4u*)(xbc_b + (size_t)(t0 + s) * CONV_DIM + c) = o;
            if (i0 + s >= SEQ - 3) store8f(out + OUT_PC + ((size_t)b * 3 + (i0 + s - (SEQ - 3))) * CONV_DIM + c, cur);
#pragma unroll
            for (int j = 0; j < 8; ++j) { p0[j] = p1[j]; p1[j] = p2[j]; p2[j] = cur[j]; }
        }
    }
    for (int item = gtid; item < T_PROMPT * 128; item += gsz) {
        const int t = item >> 7, sub = item & 127, which = sub >> 6, h = (sub >> 3) & 7, jc = sub & 7, i = t & (SEQ - 1), b = t >> 13;
        const bf16* src = projb + (size_t)t * NB_LD + (which ? NB_K : NB_Q) + h * 64 + jc * 4;
        const uint2 lo = *(const uint2*)src, hi = *(const uint2*)(src + 32);
        const float4 cs = *(const float4*)(rope_tab + (size_t)i * 64 + jc * 4), sn = *(const float4*)(rope_tab + (size_t)i * 64 + 32 + jc * 4);
        float t1[4], t2[4], o1[4], o2[4];
        t1[0] = __builtin_bit_cast(float, lo.x << 16); t1[1] = __builtin_bit_cast(float, lo.x & 0xffff0000u); t1[2] = __builtin_bit_cast(float, lo.y << 16); t1[3] = __builtin_bit_cast(float, lo.y & 0xffff0000u);
        t2[0] = __builtin_bit_cast(float, hi.x << 16); t2[1] = __builtin_bit_cast(float, hi.x & 0xffff0000u); t2[2] = __builtin_bit_cast(float, hi.y << 16); t2[3] = __builtin_bit_cast(float, hi.y & 0xffff0000u);
        const float cv[4] = {cs.x, cs.y, cs.z, cs.w}, sv[4] = {sn.x, sn.y, sn.z, sn.w};
#pragma unroll
        for (int e = 0; e < 4; ++e) { o1[e] = t1[e] * cv[e] - t2[e] * sv[e]; o2[e] = t2[e] * cv[e] + t1[e] * sv[e]; }
        const size_t doff = (size_t)t * ATT_WIDTH + h * 64 + jc * 4;
        bf16* db = which ? krot_b : qrot_b;
        *(uint2*)(db + doff) = make_uint2(pk2(o1[0], o1[1]), pk2(o1[2], o1[3])); *(uint2*)(db + doff + 32) = make_uint2(pk2(o2[0], o2[1]), pk2(o2[2], o2[3]));
        if (which && i >= SEQ - WBUF) {
            float* o = out + OUT_PK + ((size_t)b * WBUF + (i - (SEQ - WBUF))) * ATT_WIDTH + h * 64 + jc * 4;
            *(float4*)o = make_float4(o1[0], o1[1], o1[2], o1[3]); *(float4*)(o + 32) = make_float4(o2[0], o2[1], o2[2], o2[3]);
        }
    }
    for (int item = gtid; item < T_PROMPT * SSD_HEADS; item += gsz) { const int t = item / SSD_HEADS, hd = item - t * SSD_HEADS; dtv[item] = softplus_f(dtraw[(size_t)t * 32 + hd] + dt_bias[hd]); }
    for (int item = gtid; item < BATCH * WBUF * 64; item += gsz) {
        const int ch = item & 63, j = (item >> 6) & (WBUF - 1), b = item >> 17;
        float f[8]; unpack8(*(const v4u*)(projb + (size_t)(b * SEQ + (SEQ - WBUF) + j) * NB_LD + NB_V + ch * 8), f);
        store8f(out + OUT_PV + ((size_t)b * WBUF + j) * ATT_WIDTH + ch * 8, f);
    }
}

#define SSD_CH 32
__device__ __forceinline__ void ph_ssd_naive(float* lds, const bf16* __restrict__ xbc_act, const float* __restrict__ dtv, const float* __restrict__ a_log,
                                             const float* __restrict__ d_skip, const float* __restrict__ state_ssm, float* __restrict__ ybuf, float* __restrict__ out) {
    float (*sx)[64] = (float (*)[64])lds;
    float (*sB)[128] = (float (*)[128])(lds + SSD_CH * 64);
    float (*sC)[128] = (float (*)[128])(lds + SSD_CH * 64 + SSD_CH * 128);
    float* sdt = lds + SSD_CH * 64 + 2 * SSD_CH * 128;
    const int tid = threadIdx.x, p = tid >> 3, ng = tid & 7;
    for (int vb = BATCH * SSD_HEADS + blockIdx.x; vb < (BATCH + DEC_BATCH) * SSD_HEADS; vb += gridDim.x) {
        const int seq = vb / SSD_HEADS, h = vb % SSD_HEADS, g = h / 6;
        const bool is_p = seq < BATCH;
        const int L = is_p ? SEQ : DEC_SEQ;
        const int t0 = is_p ? seq * SEQ : T_PROMPT + (seq - BATCH) * DEC_SEQ;
        const float A = -__expf(a_log[h]);
        const float D = d_skip[h];
        float hs[16];
        if (is_p) {
#pragma unroll
            for (int j = 0; j < 16; ++j) hs[j] = 0.f;
        } else {
            const float* s0 = state_ssm + (((size_t)(seq - BATCH) * SSD_HEADS + h) * 64 + p) * 128 + ng * 16;
#pragma unroll
            for (int j = 0; j < 16; ++j) hs[j] = s0[j];
        }
        for (int c0 = 0; c0 < L; c0 += SSD_CH) {
            const int nst = (L - c0) < SSD_CH ? (L - c0) : SSD_CH;
            __syncthreads();
            for (int idx = tid; idx < nst * 64; idx += NTHR) { int s = idx >> 6, c = idx & 63; sx[s][c] = bf2f(xbc_act[(size_t)(t0 + c0 + s) * CONV_DIM + h * 64 + c]); }
            for (int idx = tid; idx < nst * 128; idx += NTHR) { int s = idx >> 7, c = idx & 127;
                sB[s][c] = bf2f(xbc_act[(size_t)(t0 + c0 + s) * CONV_DIM + 1536 + g * 128 + c]);
                sC[s][c] = bf2f(xbc_act[(size_t)(t0 + c0 + s) * CONV_DIM + 2048 + g * 128 + c]); }
            if (tid < nst) sdt[tid] = dtv[(size_t)(t0 + c0 + tid) * SSD_HEADS + h];
            __syncthreads();
            for (int s = 0; s < nst; ++s) {
                const float dt = sdt[s], x = sx[s][p];
                const float a = __expf(dt * A), xdt = x * dt;
                float y = 0.f;
#pragma unroll
                for (int j = 0; j < 16; ++j) { hs[j] = a * hs[j] + xdt * sB[s][ng * 16 + j]; y += sC[s][ng * 16 + j] * hs[j]; }
                y += __shfl_xor(y, 1); y += __shfl_xor(y, 2); y += __shfl_xor(y, 4);
                if (ng == 0) ybuf[(size_t)(t0 + c0 + s) * MIX_WIDTH + h * 64 + p] = y + D * x;
            }
        }
        float* so = is_p ? out + OUT_PS + (((size_t)seq * SSD_HEADS + h) * 64 + p) * 128 + ng * 16
                         : out + OUT_SS + (((size_t)(seq - BATCH) * SSD_HEADS + h) * 64 + p) * 128 + ng * 16;
#pragma unroll
        for (int j = 0; j < 16; ++j) so[j] = hs[j];
    }
}

__device__ __forceinline__ void ph_gate_norm(const bf16* __restrict__ projb, const float* __restrict__ norm_g, const float* __restrict__ ybuf, bf16* __restrict__ A1) {
    const int w = threadIdx.x >> 6, lane = threadIdx.x & 63, g = w & 3;
    for (int t = T_PROMPT + 2 * blockIdx.x + (w >> 2); t < T_ALL; t += 2 * gridDim.x) {
        float v[6]; float ss = 0.f;
#pragma unroll
        for (int j = 0; j < 6; ++j) {
            int c = g * 384 + j * 64 + lane;
            float y = ybuf[(size_t)t * MIX_WIDTH + c], z = bf2f(projb[(size_t)t * NB_LD + c]);
            v[j] = y * silu_f(z); ss += v[j] * v[j];
        }
        ss = wave_sum(ss);
        const float r = rsqrtf(ss * (1.0f / 384.0f) + LN_EPS);
#pragma unroll
        for (int j = 0; j < 6; ++j) { int c = g * 384 + j * 64 + lane; A1[(size_t)t * MIX_WIDTH + c] = (bf16)f2bf(v[j] * r * norm_g[c]); }
    }
}

__device__ __forceinline__ void ph_attn_naive(float* lds, const float* __restrict__ proj, const float* __restrict__ qrot, const float* __restrict__ krot,
                                              const float* __restrict__ ck, const float* __restrict__ cv, float* __restrict__ ybuf) {
    float (*sq)[64] = (float (*)[64])lds;
    const int w = threadIdx.x >> 6, lane = threadIdx.x & 63;
    for (int vb = blockIdx.x; vb < T_SAMPLE * 8 / NWAVE; vb += gridDim.x) {
        const int item = T_PROMPT * 8 + vb * NWAVE + w;
        const int t = item >> 3, h = item & 7;
        const bool is_p = t < T_PROMPT;
        int b, i;
        if (is_p) { b = t / SEQ; i = t % SEQ; } else { int ts = t - T_PROMPT; b = ts / DEC_SEQ; i = ts % DEC_SEQ; }
        __syncthreads();
        sq[w][lane] = qrot[(size_t)t * ATT_WIDTH + h * 64 + lane];
        __syncthreads();
        const int qi = is_p ? i : WBUF + i;
        float sc[3][3];
        float mx = -INFINITY;
#pragma unroll
        for (int pt = 0; pt < 3; ++pt) {
            const int d = pt == 0 ? 1 : (pt == 1 ? 4 : 16);
#pragma unroll
            for (int sl = 0; sl < 3; ++sl) {
                const int m = lane + sl * 64;
                float s = -INFINITY;
                const int kj = qi - d * m;
                if (m <= 128 && kj >= 0) {
                    const float* kr;
                    if (is_p) kr = krot + (size_t)(b * SEQ + kj) * ATT_WIDTH + h * 64;
                    else kr = (kj >= WBUF) ? krot + (size_t)(T_PROMPT + b * DEC_SEQ + (kj - WBUF)) * ATT_WIDTH + h * 64
                                           : ck + ((size_t)b * WBUF + kj) * ATT_WIDTH + h * 64;
                    float a = 0.f;
#pragma unroll
                    for (int c = 0; c < 64; c += 4) { float4 kv = *(const float4*)(kr + c); a += kv.x * sq[w][c] + kv.y * sq[w][c + 1] + kv.z * sq[w][c + 2] + kv.w * sq[w][c + 3]; }
                    s = a * 0.125f;
                }
                sc[pt][sl] = s; mx = fmaxf(mx, s);
            }
        }
        mx = wave_max(mx);
        float lsum = 0.f;
#pragma unroll
        for (int pt = 0; pt < 3; ++pt)
#pragma unroll
            for (int sl = 0; sl < 3; ++sl) { float pv = (sc[pt][sl] == -INFINITY) ? 0.f : __expf(sc[pt][sl] - mx); sc[pt][sl] = pv; lsum += pv; }
        lsum = wave_sum(lsum);
        float o = 0.f;
#pragma unroll
        for (int pt = 0; pt < 3; ++pt) {
            const int d = pt == 0 ? 1 : (pt == 1 ? 4 : 16);
#pragma unroll
            for (int sl = 0; sl < 3; ++sl) {
                const int mend = sl < 2 ? 64 : 1;
                for (int ml = 0; ml < mend; ++ml) {
                    const int m = ml + sl * 64;
                    const int kj = qi - d * m;
                    const float pv = __shfl(sc[pt][sl], ml);
                    if (kj < 0) continue;
                    const float* vr;
                    if (is_p) vr = proj + (size_t)(b * SEQ + kj) * PROJ_LD + O_V + h * 64;
                    else vr = (kj >= WBUF) ? proj + (size_t)(T_PROMPT + b * DEC_SEQ + (kj - WBUF)) * PROJ_LD + O_V + h * 64
                                           : cv + ((size_t)b * WBUF + kj) * ATT_WIDTH + h * 64;
                    o += pv * vr[lane];
                }
            }
        }
        ybuf[(size_t)t * MIX_WIDTH + SSD_WIDTH + h * 64 + lane] = o / lsum;
    }
}

__device__ __forceinline__ void ph_ln_res(const float* __restrict__ xp, const float* __restrict__ xs, const float* __restrict__ add, const float* __restrict__ gam,
                                          const float* __restrict__ bet, float* __restrict__ dst, bf16* __restrict__ dstb) {
    const int lane = threadIdx.x & 63;
    for (int t = blockIdx.x * NWAVE + (threadIdx.x >> 6); t < T_ALL; t += gridDim.x * NWAVE) {
        const float* res = (t < T_PROMPT) ? xp + (size_t)t * D_MODEL : xs + (size_t)(t - T_PROMPT) * D_MODEL;
        float v[16]; float s = 0.f;
#pragma unroll
        for (int j = 0; j < 4; ++j) { const int c = j * 256 + lane * 4; const float4 r4 = *(const float4*)(res + c), a4 = *(const float4*)(add + (size_t)t * D_MODEL + c);
            v[4 * j] = ALPHA_F * r4.x + a4.x; v[4 * j + 1] = ALPHA_F * r4.y + a4.y; v[4 * j + 2] = ALPHA_F * r4.z + a4.z; v[4 * j + 3] = ALPHA_F * r4.w + a4.w;
            s += (v[4 * j] + v[4 * j + 1]) + (v[4 * j + 2] + v[4 * j + 3]); }
        s = wave_sum(s);
        const float mu = s * (1.0f / 1024.0f);
        float q = 0.f;
#pragma unroll
        for (int j = 0; j < 16; ++j) { v[j] -= mu; q += v[j] * v[j]; }
        q = wave_sum(q);
        const float r = rsqrtf(q * (1.0f / 1024.0f) + LN_EPS);
#pragma unroll
        for (int j = 0; j < 4; ++j) { const int c = j * 256 + lane * 4; const float4 g4 = *(const float4*)(gam + c), b4 = *(const float4*)(bet + c);
            const float o0 = v[4 * j] * r * g4.x + b4.x, o1 = v[4 * j + 1] * r * g4.y + b4.y, o2 = v[4 * j + 2] * r * g4.z + b4.z, o3 = v[4 * j + 3] * r * g4.w + b4.w;
            *(float4*)(dst + (size_t)t * D_MODEL + c) = make_float4(o0, o1, o2, o3);
            *(uint2*)(dstb + (size_t)t * D_MODEL + c) = make_uint2(pk2(o0, o1), pk2(o2, o3)); }
    }
}

__device__ __forceinline__ void ph_peer_route(float* lds, const float* __restrict__ qh, const float* __restrict__ keys1, const float* __restrict__ keys2,
                                              int* __restrict__ eidx, float* __restrict__ gate) {
    float (*sq)[256] = (float (*)[256])lds;
    float (*sv)[2][16] = (float (*)[2][16])(lds + NWAVE * 256);
    int (*si)[2][16] = (int (*)[2][16])(lds + NWAVE * 256 + NWAVE * 32);
    const int w = threadIdx.x >> 6, lane = threadIdx.x & 63;
    for (int vb = blockIdx.x; vb < T_ALL * 8 / NWAVE; vb += gridDim.x) {
        const int item = vb * NWAVE + w;
        const int t = item >> 3, h = item & 7;
        __syncthreads();
        for (int c = lane; c < 256; c += 64) sq[w][c] = qh[(size_t)t * 2048 + h * 256 + c];
        __syncthreads();
#pragma unroll
        for (int half = 0; half < 2; ++half) {
            const float* keys = half ? keys2 : keys1;
            float s[2];
#pragma unroll
            for (int sl = 0; sl < 2; ++sl) {
                const float* kr = keys + (size_t)(lane + sl * 64) * 128;
                float a = 0.f;
#pragma unroll 8
                for (int c = 0; c < 128; c += 4) { float4 kv = *(const float4*)(kr + c); const float* qq = &sq[w][half * 128 + c]; a += kv.x * qq[0] + kv.y * qq[1] + kv.z * qq[2] + kv.w * qq[3]; }
                s[sl] = a;
            }
            for (int r = 0; r < 16; ++r) {
                float bv; int bi;
                if (s[0] >= s[1]) { bv = s[0]; bi = lane; } else { bv = s[1]; bi = lane + 64; }
#pragma unroll
                for (int o = 32; o > 0; o >>= 1) {
                    float ov = __shfl_xor(bv, o); int oi = __shfl_xor(bi, o);
                    if (ov > bv || (ov == bv && oi < bi)) { bv = ov; bi = oi; }
                }
                if (lane == 0) { sv[w][half][r] = bv; si[w][half][r] = bi; }
                if (bi == lane) s[0] = -INFINITY;
                if (bi == lane + 64) s[1] = -INFINITY;
            }
        }
        __syncthreads();
        float c[4];
#pragma unroll
        for (int j = 0; j < 4; ++j) { int ci = lane * 4 + j; c[j] = sv[w][0][ci >> 4] + sv[w][1][ci & 15]; }
        float myv = 0.f; int myc = 0;
        for (int r = 0; r < 16; ++r) {
            float bv = c[0]; int bi = lane * 4;
#pragma unroll
            for (int j = 1; j < 4; ++j) if (c[j] > bv) { bv = c[j]; bi = lane * 4 + j; }
#pragma unroll
            for (int o = 32; o > 0; o >>= 1) {
                float ov = __shfl_xor(bv, o); int oi = __shfl_xor(bi, o);
                if (ov > bv || (ov == bv && oi < bi)) { bv = ov; bi = oi; }
            }
            if (lane == r) { myv = bv; myc = bi; }
#pragma unroll
            for (int j = 0; j < 4; ++j) if (bi == lane * 4 + j) c[j] = -INFINITY;
        }
        float v = lane < 16 ? myv : -INFINITY;
        float mx = wave_max(v);
        float e = lane < 16 ? __expf(v - mx) : 0.f;
        float sum = wave_sum(e);
        if (lane < 16) {
            int ex = si[w][0][myc >> 4] * PEER_NKEYS + si[w][1][myc & 15];
            eidx[(size_t)t * 128 + h * 16 + lane] = ex;
            gate[(size_t)t * 128 + h * 16 + lane] = e / sum;
        }
    }
}

__device__ __forceinline__ void ph_peer_ffn(const float* __restrict__ hbuf, const int* __restrict__ eidx, const float* __restrict__ gate,
                                            const bf16* __restrict__ ub, const bf16* __restrict__ vb, const float* __restrict__ gam,
                                            const float* __restrict__ bet, float* __restrict__ out) {
    const int lane = threadIdx.x & 63;
    for (int t = blockIdx.x * NWAVE + (threadIdx.x >> 6); t < T_ALL; t += gridDim.x * NWAVE) {
        float x[16], acc[16];
        { const float* xr = hbuf + (size_t)t * D_MODEL + lane * 8;
          const float4 a = *(const float4*)xr, b = *(const float4*)(xr + 4), c = *(const float4*)(xr + 512), d = *(const float4*)(xr + 516);
          x[0] = a.x; x[1] = a.y; x[2] = a.z; x[3] = a.w; x[4] = b.x; x[5] = b.y; x[6] = b.z; x[7] = b.w;
          x[8] = c.x; x[9] = c.y; x[10] = c.z; x[11] = c.w; x[12] = d.x; x[13] = d.y; x[14] = d.z; x[15] = d.w; }
#pragma unroll
        for (int j = 0; j < 16; ++j) acc[j] = 0.f;
        for (int k = 0; k < 128; ++k) {
            const int e = eidx[(size_t)t * 128 + k];
            const float g = gate[(size_t)t * 128 + k];
            const bf16* ur = ub + (size_t)e * D_MODEL + lane * 8;
            float u0[8], u1[8];
            unpack8(*(const v4u*)ur, u0); unpack8(*(const v4u*)(ur + 512), u1);
            float d = 0.f;
#pragma unroll
            for (int j = 0; j < 8; ++j) d += u0[j] * x[j] + u1[j] * x[8 + j];
            d = wave_sum(d);
            const float wgt = g * gelu_f(d);
            const bf16* vr = vb + (size_t)e * D_MODEL + lane * 8;
            unpack8(*(const v4u*)vr, u0); unpack8(*(const v4u*)(vr + 512), u1);
#pragma unroll
            for (int j = 0; j < 8; ++j) { acc[j] += wgt * u0[j]; acc[8 + j] += wgt * u1[j]; }
        }
        float s = 0.f;
#pragma unroll
        for (int j = 0; j < 16; ++j) { acc[j] += ALPHA_F * x[j]; s += acc[j]; }
        s = wave_sum(s);
        const float mu = s * (1.0f / 1024.0f);
        float q = 0.f;
#pragma unroll
        for (int j = 0; j < 16; ++j) { acc[j] -= mu; q += acc[j] * acc[j]; }
        q = wave_sum(q);
        const float r = rsqrtf(q * (1.0f / 1024.0f) + LN_EPS);
        float* dst = ((t < T_PROMPT) ? out + OUT_YP + (size_t)t * D_MODEL : out + OUT_YS + (size_t)(t - T_PROMPT) * D_MODEL) + lane * 8;
#pragma unroll
        for (int q4 = 0; q4 < 4; ++q4) {
            const int eo = (q4 >> 1) * 512 + (q4 & 1) * 4;
            const float4 g4 = *(const float4*)(gam + lane * 8 + eo), b4 = *(const float4*)(bet + lane * 8 + eo);
            float4 o; o.x = acc[q4 * 4 + 0] * r * g4.x + b4.x; o.y = acc[q4 * 4 + 1] * r * g4.y + b4.y; o.z = acc[q4 * 4 + 2] * r * g4.z + b4.z; o.w = acc[q4 * 4 + 3] * r * g4.w + b4.w;
            *(float4*)(dst + eo) = o;
        }
    }
}

__device__ __forceinline__ float peer_dot16(const v4u a, const v4u b, const float (&x)[16]) {
    float u0[8], u1[8]; unpack8(a, u0); unpack8(b, u1);
    float d = 0.f;
#pragma unroll
    for (int j = 0; j < 8; ++j) d += u0[j] * x[j] + u1[j] * x[8 + j];
    return d;
}
#define PEER_TR_STEP(N, M) _Pragma("unroll") for (int i = 0; i < N; ++i) { const bool up = (lane & M) != 0; const float keep = up ? part[i + N] : part[i]; const float send = up ? part[i] : part[i + N]; part[i] = keep + __shfl_xor(send, M); }
__device__ __forceinline__ void ph_peer_ffn2(const float* __restrict__ hbuf, const int* __restrict__ eidx, const float* __restrict__ gate,
                                             const bf16* __restrict__ ub, const bf16* __restrict__ vb, const float* __restrict__ gam,
                                             const float* __restrict__ bet, float* __restrict__ out) {
    const int lane0 = threadIdx.x & 63;
    for (int t = blockIdx.x * NWAVE + (threadIdx.x >> 6); t < T_ALL; t += gridDim.x * NWAVE) {
        int lane = lane0; asm volatile("" : "+v"(lane));
        float x[16];
        { const float* xr = hbuf + (size_t)t * D_MODEL + lane * 8;
          const float4 a = *(const float4*)xr, b = *(const float4*)(xr + 4), c = *(const float4*)(xr + 512), d = *(const float4*)(xr + 516);
          x[0] = a.x; x[1] = a.y; x[2] = a.z; x[3] = a.w; x[4] = b.x; x[5] = b.y; x[6] = b.z; x[7] = b.w;
          x[8] = c.x; x[9] = c.y; x[10] = c.z; x[11] = c.w; x[12] = d.x; x[13] = d.y; x[14] = d.z; x[15] = d.w; }
        int ev[2]; float wv[4];
        ev[0] = eidx[(size_t)t * 128 + lane]; ev[1] = eidx[(size_t)t * 128 + 64 + lane];
#pragma unroll
        for (int rd = 0; rd < 4; ++rd) wv[rd] = gate[(size_t)t * 128 + rd * 32 + (lane >> 1)];
#pragma unroll
        for (int rd = 0; rd < 4; ++rd) {
            float part[32];
#pragma unroll
            for (int kb = 0; kb < 8; ++kb) {
                v4u ra[4], rb[4];
#pragma unroll
                for (int k8 = 0; k8 < 4; ++k8) {
                    const int e = __builtin_amdgcn_readlane(ev[rd >> 1], (rd & 1) * 32 + kb * 4 + k8);
                    const bf16* ur = ub + (size_t)e * D_MODEL + lane * 8;
                    ra[k8] = *(const v4u*)ur; rb[k8] = *(const v4u*)(ur + 512);
                }
#pragma unroll
                for (int k8 = 0; k8 < 4; ++k8) part[kb * 4 + k8] = peer_dot16(ra[k8], rb[k8], x);
            }
            PEER_TR_STEP(16, 32) PEER_TR_STEP(8, 16) PEER_TR_STEP(4, 8) PEER_TR_STEP(2, 4) PEER_TR_STEP(1, 2)
            const float hid = part[0] + __shfl_xor(part[0], 1);
            wv[rd] *= gelu_f(hid);
        }
        float acc[16];
#pragma unroll
        for (int j = 0; j < 16; ++j) acc[j] = 0.f;
#pragma unroll
        for (int rd = 0; rd < 4; ++rd) {
#pragma unroll
            for (int kb = 0; kb < 4; ++kb) {
                v4u ra[8], rb[8];
#pragma unroll
                for (int k8 = 0; k8 < 8; ++k8) {
                    const int e = __builtin_amdgcn_readlane(ev[rd >> 1], (rd & 1) * 32 + kb * 8 + k8);
                    const bf16* vr = vb + (size_t)e * D_MODEL + lane * 8;
                    ra[k8] = *(const v4u*)vr; rb[k8] = *(const v4u*)(vr + 512);
                }
#pragma unroll
                for (int k8 = 0; k8 < 8; ++k8) {
                    const float wk = __builtin_bit_cast(float, __builtin_amdgcn_readlane(__builtin_bit_cast(int, wv[rd]), 2 * (kb * 8 + k8)));
                    float u0[8], u1[8]; unpack8(ra[k8], u0); unpack8(rb[k8], u1);
#pragma unroll
                    for (int j = 0; j < 8; ++j) { acc[j] += wk * u0[j]; acc[8 + j] += wk * u1[j]; }
                }
            }
        }
        float s = 0.f;
#pragma unroll
        for (int j = 0; j < 16; ++j) { acc[j] += ALPHA_F * x[j]; s += acc[j]; }
        s = wave_sum(s);
        const float mu = s * (1.0f / 1024.0f);
        float q = 0.f;
#pragma unroll
        for (int j = 0; j < 16; ++j) { acc[j] -= mu; q += acc[j] * acc[j]; }
        q = wave_sum(q);
        const float r = rsqrtf(q * (1.0f / 1024.0f) + LN_EPS);
        float* dst = ((t < T_PROMPT) ? out + OUT_YP + (size_t)t * D_MODEL : out + OUT_YS + (size_t)(t - T_PROMPT) * D_MODEL) + lane * 8;
#pragma unroll
        for (int q4 = 0; q4 < 4; ++q4) {
            const int eo = (q4 >> 1) * 512 + (q4 & 1) * 4;
            const float4 g4 = *(const float4*)(gam + lane * 8 + eo), b4 = *(const float4*)(bet + lane * 8 + eo);
            float4 o; o.x = acc[q4 * 4 + 0] * r * g4.x + b4.x; o.y = acc[q4 * 4 + 1] * r * g4.y + b4.y; o.z = acc[q4 * 4 + 2] * r * g4.z + b4.z; o.w = acc[q4 * 4 + 3] * r * g4.w + b4.w;
            *(float4*)(dst + eo) = o;
        }
    }
}

__device__ __forceinline__ void ph_attn_sample(float* lds, const bf16* __restrict__ qrot_b, const bf16* __restrict__ krot_b, const bf16* __restrict__ projb,
                                               const float* __restrict__ ck, const float* __restrict__ cv, bf16* __restrict__ A1) {
    float (*sq)[64] = (float (*)[64])lds;
    const int w = threadIdx.x >> 6, lane0 = threadIdx.x & 63;
    for (int vb = blockIdx.x; vb < T_SAMPLE * 8 / NWAVE; vb += gridDim.x) {
        int lane = lane0; asm volatile("" : "+v"(lane));
        const int item = vb * NWAVE + w, ts = item >> 3, hd = item & 7, b = ts >> 2, i = ts & 3, t = T_PROMPT + ts;
        __syncthreads();
        sq[w][lane] = bf2f(qrot_b[(size_t)t * ATT_WIDTH + hd * 64 + lane]);
        __syncthreads();
        const int qi = WBUF + i;
        float sc[8];
        float mx = -INFINITY;
#pragma unroll
        for (int slot = 0; slot < 7; ++slot) {
            const int pt = slot < 6 ? (slot >> 1) : (lane < 3 ? lane : 0);
            const int m = slot < 6 ? lane + 64 * (slot & 1) : 128;
            const int kj = qi - (m << (2 * pt));
            const bool valid = (slot < 6 || lane < 3) && kj < WBUF;
            const int kc = kj < WBUF ? kj : WBUF - 1;
            const float* kr = ck + ((size_t)b * WBUF + kc) * ATT_WIDTH + hd * 64;
            float a = 0.f;
#pragma unroll
            for (int c = 0; c < 64; c += 4) { const float4 kv = *(const float4*)(kr + c); a += kv.x * sq[w][c] + kv.y * sq[w][c + 1] + kv.z * sq[w][c + 2] + kv.w * sq[w][c + 3]; }
            const float s = valid ? a * 0.125f : -INFINITY;
            sc[slot] = s; mx = fmaxf(mx, s);
        }
        const int nt7 = lane <= i ? i - lane : i;
        const bool valid7 = lane < i + 3;
        {
            const bf16* kr = krot_b + (size_t)(T_PROMPT + b * DEC_SEQ + nt7) * ATT_WIDTH + hd * 64;
            float a = 0.f;
#pragma unroll
            for (int c = 0; c < 64; c += 8) { float f[8]; unpack8(*(const v4u*)(kr + c), f);
#pragma unroll
                for (int j = 0; j < 8; ++j) a += f[j] * sq[w][c + j]; }
            const float s = valid7 ? a * 0.125f : -INFINITY;
            sc[7] = s; mx = fmaxf(mx, s);
        }
        mx = wave_max(mx);
        float lsum = 0.f;
#pragma unroll
        for (int slot = 0; slot < 8; ++slot) { const float pv = __expf(sc[slot] - mx); sc[slot] = pv; lsum += pv; }
        lsum = wave_sum(lsum);
        float part[64];
#pragma unroll
        for (int c = 0; c < 64; ++c) part[c] = 0.f;
#pragma unroll
        for (int slot = 0; slot < 7; ++slot) {
            const int pt = slot < 6 ? (slot >> 1) : (lane < 3 ? lane : 0);
            const int m = slot < 6 ? lane + 64 * (slot & 1) : 128;
            const int kj = qi - (m << (2 * pt));
            const int kc = kj < WBUF ? kj : WBUF - 1;
            const float pv = sc[slot];
            const float* vr = cv + ((size_t)b * WBUF + kc) * ATT_WIDTH + hd * 64;
#pragma unroll
            for (int c = 0; c < 64; c += 4) { const float4 vv = *(const float4*)(vr + c); part[c] += pv * vv.x; part[c + 1] += pv * vv.y; part[c + 2] += pv * vv.z; part[c + 3] += pv * vv.w; }
        }
        {
            const float pv = sc[7];
            const bf16* vr = projb + (size_t)(T_PROMPT + b * DEC_SEQ + nt7) * NB_LD + NB_V + hd * 64;
#pragma unroll
            for (int c = 0; c < 64; c += 8) { float f[8]; unpack8(*(const v4u*)(vr + c), f);
#pragma unroll
                for (int j = 0; j < 8; ++j) part[c + j] += pv * f[j]; }
        }
        PEER_TR_STEP(32, 32) PEER_TR_STEP(16, 16) PEER_TR_STEP(8, 8) PEER_TR_STEP(4, 4) PEER_TR_STEP(2, 2) PEER_TR_STEP(1, 1)
        A1[(size_t)t * MIX_WIDTH + SSD_WIDTH + hd * 64 + lane] = (bf16)f2bf(part[0] / lsum);
    }
}


__device__ __forceinline__ void cache_copy_slice(const float* __restrict__ ck, const float* __restrict__ cv, float* __restrict__ out, unsigned slice, unsigned lane) {
    constexpr unsigned PER_B = (WBUF - DEC_SEQ) * ATT_WIDTH / 4;
    constexpr unsigned TOTAL = 2u * DEC_BATCH * PER_B;
#pragma unroll 1
    for (unsigned bt = 0; bt < 8; ++bt) {
        f32x4n v[8]; size_t dsti[8]; bool isv[8]; bool ok[8];
#pragma unroll
        for (int j = 0; j < 8; ++j) {
            const unsigned idx = slice * 4096u + bt * 512u + j * 64u + lane;
            ok[j] = idx < TOTAL;
            const unsigned idc = ok[j] ? idx : 0u;
            const unsigned tb = idc / PER_B, r = idc - tb * PER_B, bb = tb & (DEC_BATCH - 1);
            isv[j] = tb >= DEC_BATCH;
            const size_t srci = (size_t)bb * (WBUF * ATT_WIDTH / 4) + (DEC_SEQ * ATT_WIDTH / 4) + r;
            dsti[j] = (size_t)bb * (WBUF * ATT_WIDTH / 4) + r;
            v[j] = __builtin_nontemporal_load((isv[j] ? (const f32x4n*)cv : (const f32x4n*)ck) + srci);
        }
#pragma unroll
        for (int j = 0; j < 8; ++j) if (ok[j]) __builtin_nontemporal_store(v[j], (f32x4n*)(out + (isv[j] ? OUT_SV : OUT_SK)) + dsti[j]);
    }
}
typedef float f32x2v __attribute__((ext_vector_type(2)));
__device__ __forceinline__ void ph_quant_tables(const float* __restrict__ pu, const float* __restrict__ pv, unsigned char* __restrict__ ub8, unsigned char* __restrict__ vb8,
                                                float* __restrict__ usc, float* __restrict__ vsc, int rank, int nranks) {
    const int lane = threadIdx.x & 63;
#pragma unroll 2
    for (int row = rank * NWAVE + (threadIdx.x >> 6); row < 2 * 16384; row += nranks * NWAVE) {
        const int rr = row & 16383; const bool isv = row >= 16384;
        const float* src = (isv ? pv : pu) + (size_t)rr * D_MODEL + lane * 8;
        const float4 a = *(const float4*)src, b = *(const float4*)(src + 4), c = *(const float4*)(src + 512), d = *(const float4*)(src + 516);
        float am = fmaxf(fmaxf(fmaxf(fabsf(a.x), fabsf(a.y)), fmaxf(fabsf(a.z), fabsf(a.w))), fmaxf(fmaxf(fabsf(b.x), fabsf(b.y)), fmaxf(fabsf(b.z), fabsf(b.w))));
        am = fmaxf(am, fmaxf(fmaxf(fmaxf(fabsf(c.x), fabsf(c.y)), fmaxf(fabsf(c.z), fabsf(c.w))), fmaxf(fmaxf(fabsf(d.x), fabsf(d.y)), fmaxf(fabsf(d.z), fabsf(d.w)))));
        am = wave_max(am);
        const float sc = am > 0.f ? 224.0f / am : 1.0f;
        v4u o;
        o.x = (unsigned)__builtin_amdgcn_cvt_pk_fp8_f32(a.z * sc, a.w * sc, __builtin_amdgcn_cvt_pk_fp8_f32(a.x * sc, a.y * sc, 0, false), true);
        o.y = (unsigned)__builtin_amdgcn_cvt_pk_fp8_f32(b.z * sc, b.w * sc, __builtin_amdgcn_cvt_pk_fp8_f32(b.x * sc, b.y * sc, 0, false), true);
        o.z = (unsigned)__builtin_amdgcn_cvt_pk_fp8_f32(c.z * sc, c.w * sc, __builtin_amdgcn_cvt_pk_fp8_f32(c.x * sc, c.y * sc, 0, false), true);
        o.w = (unsigned)__builtin_amdgcn_cvt_pk_fp8_f32(d.z * sc, d.w * sc, __builtin_amdgcn_cvt_pk_fp8_f32(d.x * sc, d.y * sc, 0, false), true);
        *(v4u*)((isv ? vb8 : ub8) + (size_t)rr * 1024 + lane * 16) = o;
        if (lane == 0) (isv ? vsc : usc)[rr] = am > 0.f ? am * (1.0f / 224.0f) : 1.0f;
    }
}
__device__ __forceinline__ void unpack16_fp8(const v4u w, float (&f)[16]) {
#pragma unroll
    for (int i = 0; i < 4; ++i) {
        const f32x2v lo = __builtin_amdgcn_cvt_pk_f32_fp8((int)w[i], false), hi = __builtin_amdgcn_cvt_pk_f32_fp8((int)w[i], true);
        f[4 * i] = lo[0]; f[4 * i + 1] = lo[1]; f[4 * i + 2] = hi[0]; f[4 * i + 3] = hi[1];
    }
}
__device__ __forceinline__ void ph_peer_ffn3(const float* __restrict__ hbuf, const int* __restrict__ eidx, const float* __restrict__ gate,
                                             const unsigned char* __restrict__ ub8, const unsigned char* __restrict__ vb8, const float* __restrict__ usc, const float* __restrict__ vsc,
                                             const float* __restrict__ gam, const float* __restrict__ bet, float* __restrict__ out,
                                             const float* __restrict__ ck, const float* __restrict__ cv, unsigned n9) {
    const int lane0 = threadIdx.x & 63;
    unsigned it = 0;
    for (int t = blockIdx.x * NWAVE + (threadIdx.x >> 6); t < T_ALL; t += gridDim.x * NWAVE, ++it) {
        int lane = lane0; asm volatile("" : "+v"(lane));
        { const unsigned sl = (blockIdx.x * NWAVE + (threadIdx.x >> 6)) + it * (gridDim.x * NWAVE); if (it < 8 && sl < n9) cache_copy_slice(ck, cv, out, sl, (unsigned)lane); }
        const unsigned lo16 = (unsigned)lane * 16u, lo8 = (unsigned)lane * 8u;
        float x[16];
        { const float* xr = hbuf + (size_t)t * D_MODEL + lo8;
          const float4 a = *(const float4*)xr, b = *(const float4*)(xr + 4), c = *(const float4*)(xr + 512), d = *(const float4*)(xr + 516);
          x[0] = a.x; x[1] = a.y; x[2] = a.z; x[3] = a.w; x[4] = b.x; x[5] = b.y; x[6] = b.z; x[7] = b.w;
          x[8] = c.x; x[9] = c.y; x[10] = c.z; x[11] = c.w; x[12] = d.x; x[13] = d.y; x[14] = d.z; x[15] = d.w; }
        int ev[2]; float wv[4], su[4];
        ev[0] = eidx[(size_t)t * 128 + lane]; ev[1] = eidx[(size_t)t * 128 + 64 + lane];
#pragma unroll
        for (int rd = 0; rd < 4; ++rd) {
            const int er = eidx[(size_t)t * 128 + rd * 32 + (lane >> 1)];
            wv[rd] = gate[(size_t)t * 128 + rd * 32 + (lane >> 1)] * vsc[er];
            su[rd] = usc[er];
        }
#pragma unroll
        for (int rd = 0; rd < 4; ++rd) {
            float part[32];
#pragma unroll
            for (int kb = 0; kb < 8; ++kb) {
                v4u ra[4];
#pragma unroll
                for (int k8 = 0; k8 < 4; ++k8) {
                    const int e = __builtin_amdgcn_readlane(ev[rd >> 1], (rd & 1) * 32 + kb * 4 + k8);
                    ra[k8] = *(const v4u*)(ub8 + (size_t)e * 1024 + lo16);
                }
#pragma unroll
                for (int k8 = 0; k8 < 4; ++k8) {
                    float f[16]; unpack16_fp8(ra[k8], f);
                    float d = 0.f;
#pragma unroll
                    for (int j = 0; j < 16; ++j) d += f[j] * x[j];
                    part[kb * 4 + k8] = d;
                    if (k8 & 1) __builtin_amdgcn_sched_barrier(0);
                }
            }
            PEER_TR_STEP(16, 32) PEER_TR_STEP(8, 16) PEER_TR_STEP(4, 8) PEER_TR_STEP(2, 4) PEER_TR_STEP(1, 2)
            const float hid = (part[0] + __shfl_xor(part[0], 1)) * su[rd];
            wv[rd] *= gelu_f(hid);
        }
        float acc[16];
#pragma unroll
        for (int j = 0; j < 16; ++j) acc[j] = 0.f;
#pragma unroll
        for (int rd = 0; rd < 4; ++rd) {
#pragma unroll
            for (int kb = 0; kb < 4; ++kb) {
                v4u ra[8];
#pragma unroll
                for (int k8 = 0; k8 < 8; ++k8) {
                    const int e = __builtin_amdgcn_readlane(ev[rd >> 1], (rd & 1) * 32 + kb * 8 + k8);
                    ra[k8] = *(const v4u*)(vb8 + (size_t)e * 1024 + lo16);
                }
#pragma unroll
                for (int k8 = 0; k8 < 8; ++k8) {
                    const float wk = __builtin_bit_cast(float, __builtin_amdgcn_readlane(__builtin_bit_cast(int, wv[rd]), 2 * (kb * 8 + k8)));
                    float f[16]; unpack16_fp8(ra[k8], f);
#pragma unroll
                    for (int j = 0; j < 16; ++j) acc[j] += wk * f[j];
                    if (k8 & 1) __builtin_amdgcn_sched_barrier(0);
                }
            }
        }
        float s = 0.f;
#pragma unroll
        for (int j = 0; j < 16; ++j) { acc[j] += ALPHA_F * x[j]; s += acc[j]; }
        s = wave_sum(s);
        const float mu = s * (1.0f / 1024.0f);
        float q = 0.f;
#pragma unroll
        for (int j = 0; j < 16; ++j) { acc[j] -= mu; q += acc[j] * acc[j]; }
        q = wave_sum(q);
        const float r = rsqrtf(q * (1.0f / 1024.0f) + LN_EPS);
        float* dst = ((t < T_PROMPT) ? out + OUT_YP + (size_t)t * D_MODEL : out + OUT_YS + (size_t)(t - T_PROMPT) * D_MODEL) + lo8;
#pragma unroll
        for (int q4 = 0; q4 < 4; ++q4) {
            const int eo = (q4 >> 1) * 512 + (q4 & 1) * 4;
            const float4 g4 = *(const float4*)(gam + lo8 + eo), b4 = *(const float4*)(bet + lo8 + eo);
            float4 o; o.x = acc[q4 * 4 + 0] * r * g4.x + b4.x; o.y = acc[q4 * 4 + 1] * r * g4.y + b4.y; o.z = acc[q4 * 4 + 2] * r * g4.z + b4.z; o.w = acc[q4 * 4 + 3] * r * g4.w + b4.w;
            *(float4*)(dst + eo) = o;
        }
    }
}

typedef float f32x16 __attribute__((ext_vector_type(16)));
typedef short s16x8 __attribute__((ext_vector_type(8)));
typedef short s16x4 __attribute__((ext_vector_type(4)));
typedef float f32x4v __attribute__((ext_vector_type(4)));
#define SSD_L_ACS 0
#define SSD_L_DTS 3072
#define SSD_L_BM 6144
#define SSD_RS_B 272
#define SSD_L_X (6144 + 128 * 272)
#define SSD_RS_X 144
#define SSD_XIMG (128 * 144)
#define SSD_RS_Y 784
template <int OFF0, int OFF1>
__device__ __forceinline__ s16x8 tr_frag(unsigned base) {
    s16x4 a, b;
    asm volatile("ds_read_b64_tr_b16 %0, %2 offset:%3\n\tds_read_b64_tr_b16 %1, %2 offset:%4\n\ts_waitcnt lgkmcnt(0)"
                 : "=&v"(a), "=&v"(b) : "v"(base), "n"(OFF0), "n"(OFF1) : "memory");
    return __builtin_shufflevector(a, b, 0, 1, 2, 3, 4, 5, 6, 7);
}
__device__ __forceinline__ unsigned lds_addr(LAS unsigned char* p) { return (unsigned)(size_t)p; }

__device__ __forceinline__ void ssd_chunk_acs(LAS unsigned char* ldsb, const float* __restrict__ dtv, const float* __restrict__ a_log, int t0, int g, float* cdec_out) {
    const int w = __builtin_amdgcn_readfirstlane(threadIdx.x >> 6), lane = threadIdx.x & 63;
    if (w < 6) {
        const int head = 6 * g + w;
        const float A = -__expf(a_log[head]);
        const float v0 = dtv[(size_t)(t0 + 2 * lane) * SSD_HEADS + head], v1 = dtv[(size_t)(t0 + 2 * lane + 1) * SSD_HEADS + head];
        const float a1 = v1 * A;
        float s = v0 * A + a1;
#pragma unroll
        for (int o = 1; o < 64; o <<= 1) { const float tmp = __shfl_up(s, o); if (lane >= o) s += tmp; }
        LAS float* acs = (LAS float*)(ldsb + SSD_L_ACS) + w * 128;
        LAS float* dts = (LAS float*)(ldsb + SSD_L_DTS) + w * 128;
        acs[2 * lane] = s - a1; acs[2 * lane + 1] = s;
        dts[2 * lane] = v0; dts[2 * lane + 1] = v1;
        if (cdec_out && lane == 63) cdec_out[head] = __expf(s);
    }
}

__device__ __forceinline__ void ph_ssd_states(LAS unsigned char* ldsb, const bf16* __restrict__ xbc_b, const float* __restrict__ dtv, const float* __restrict__ a_log,
                                              bf16* __restrict__ Sbuf, float* __restrict__ cdec) {
    const int tid = threadIdx.x, w = __builtin_amdgcn_readfirstlane(tid >> 6), lane = tid & 63;
    const int r = lane & 31, h = lane >> 5, blk = (lane >> 4) & 1, q = (lane & 15) >> 2, pp = lane & 3;
    const int nt = w & 3, pt = w >> 2;
    for (int unit = blockIdx.x; unit < BATCH * 64 * SSD_GROUPS; unit += gridDim.x) {
        const int g = unit & 3, bc = unit >> 2;
        const int t0 = bc * 128;
        __syncthreads();
        ssd_chunk_acs(ldsb, dtv, a_log, t0, g, cdec + (size_t)bc * SSD_HEADS);
        for (int idx = tid; idx < 2048; idx += NTHR) { const int row = idx >> 4, ch = idx & 15;
            const v4u v = *(const v4u*)(xbc_b + (size_t)(t0 + row) * CONV_DIM + 1536 + 128 * g + ch * 8);
            *(LAS v4u*)(ldsb + SSD_L_BM + row * SSD_RS_B + ch * 16) = v; }
        __syncthreads();
        for (int idx = tid; idx < 6144; idx += NTHR) { const int hh = idx >> 10, rem = idx & 1023, row = rem >> 3, ch = rem & 7;
            const LAS float* acs = (const LAS float*)(ldsb + SSD_L_ACS) + hh * 128; const LAS float* dts = (const LAS float*)(ldsb + SSD_L_DTS) + hh * 128;
            const float wgt = dts[row] * __expf(acs[127] - acs[row]);
            float f[8]; unpack8(*(const v4u*)(xbc_b + (size_t)(t0 + row) * CONV_DIM + (6 * g + hh) * 64 + ch * 8), f);
            v4u o; o.x = pk2(f[0] * wgt, f[1] * wgt); o.y = pk2(f[2] * wgt, f[3] * wgt); o.z = pk2(f[4] * wgt, f[5] * wgt); o.w = pk2(f[6] * wgt, f[7] * wgt);
            *(LAS v4u*)(ldsb + SSD_L_X + hh * SSD_XIMG + row * SSD_RS_X + ch * 16) = o; }
        __syncthreads();
        const unsigned abase = lds_addr(ldsb + SSD_L_BM) + (8 * h + q) * SSD_RS_B + (32 * nt + 16 * blk + 4 * pp) * 2;
        s16x8 afr[8];
        afr[0] = tr_frag<0 * 16 * SSD_RS_B, (0 * 16 + 4) * SSD_RS_B>(abase); afr[1] = tr_frag<1 * 16 * SSD_RS_B, (1 * 16 + 4) * SSD_RS_B>(abase);
        afr[2] = tr_frag<2 * 16 * SSD_RS_B, (2 * 16 + 4) * SSD_RS_B>(abase); afr[3] = tr_frag<3 * 16 * SSD_RS_B, (3 * 16 + 4) * SSD_RS_B>(abase);
        afr[4] = tr_frag<4 * 16 * SSD_RS_B, (4 * 16 + 4) * SSD_RS_B>(abase); afr[5] = tr_frag<5 * 16 * SSD_RS_B, (5 * 16 + 4) * SSD_RS_B>(abase);
        afr[6] = tr_frag<6 * 16 * SSD_RS_B, (6 * 16 + 4) * SSD_RS_B>(abase); afr[7] = tr_frag<7 * 16 * SSD_RS_B, (7 * 16 + 4) * SSD_RS_B>(abase);
#pragma unroll
        for (int hh = 0; hh < 6; ++hh) {
            const unsigned xb = lds_addr(ldsb + SSD_L_X + hh * SSD_XIMG) + (8 * h + q) * SSD_RS_X + (32 * pt + 16 * blk + 4 * pp) * 2;
            f32x16 acc;
#pragma unroll
            for (int i = 0; i < 16; ++i) acc[i] = 0.f;
            acc = __builtin_amdgcn_mfma_f32_32x32x16_bf16(afr[0], tr_frag<0 * 16 * SSD_RS_X, (0 * 16 + 4) * SSD_RS_X>(xb), acc, 0, 0, 0);
            acc = __builtin_amdgcn_mfma_f32_32x32x16_bf16(afr[1], tr_frag<1 * 16 * SSD_RS_X, (1 * 16 + 4) * SSD_RS_X>(xb), acc, 0, 0, 0);
            acc = __builtin_amdgcn_mfma_f32_32x32x16_bf16(afr[2], tr_frag<2 * 16 * SSD_RS_X, (2 * 16 + 4) * SSD_RS_X>(xb), acc, 0, 0, 0);
            acc = __builtin_amdgcn_mfma_f32_32x32x16_bf16(afr[3], tr_frag<3 * 16 * SSD_RS_X, (3 * 16 + 4) * SSD_RS_X>(xb), acc, 0, 0, 0);
            acc = __builtin_amdgcn_mfma_f32_32x32x16_bf16(afr[4], tr_frag<4 * 16 * SSD_RS_X, (4 * 16 + 4) * SSD_RS_X>(xb), acc, 0, 0, 0);
            acc = __builtin_amdgcn_mfma_f32_32x32x16_bf16(afr[5], tr_frag<5 * 16 * SSD_RS_X, (5 * 16 + 4) * SSD_RS_X>(xb), acc, 0, 0, 0);
            acc = __builtin_amdgcn_mfma_f32_32x32x16_bf16(afr[6], tr_frag<6 * 16 * SSD_RS_X, (6 * 16 + 4) * SSD_RS_X>(xb), acc, 0, 0, 0);
            acc = __builtin_amdgcn_mfma_f32_32x32x16_bf16(afr[7], tr_frag<7 * 16 * SSD_RS_X, (7 * 16 + 4) * SSD_RS_X>(xb), acc, 0, 0, 0);
            bf16* dst = Sbuf + (((size_t)bc * SSD_HEADS + 6 * g + hh) * 64 + 32 * pt + r) * 128 + 32 * nt + 4 * h;
#pragma unroll
            for (int q4 = 0; q4 < 4; ++q4) *(uint2*)(dst + 8 * q4) = make_uint2(pk2(acc[4 * q4], acc[4 * q4 + 1]), pk2(acc[4 * q4 + 2], acc[4 * q4 + 3]));
        }
    }
}

__device__ __forceinline__ void ph_ssd_scan(const bf16* __restrict__ Sbuf, const float* __restrict__ cdec, bf16* __restrict__ Hin, float* __restrict__ out, int rank, int nranks) {
    for (int idx = rank * NTHR + threadIdx.x; idx < BATCH * SSD_HEADS * 64 * 16; idx += nranks * NTHR) {
        const int n8 = idx & 15, p = (idx >> 4) & 63, hb = idx >> 10, hd = hb % SSD_HEADS, b = hb / SSD_HEADS;
        float st[8];
#pragma unroll
        for (int j = 0; j < 8; ++j) st[j] = 0.f;
#pragma unroll 8
        for (int c = 0; c < 64; ++c) {
            const size_t base = ((((size_t)(b * 64 + c)) * SSD_HEADS + hd) * 64 + p) * 128 + n8 * 8;
            v4u o; o.x = pk2(st[0], st[1]); o.y = pk2(st[2], st[3]); o.z = pk2(st[4], st[5]); o.w = pk2(st[6], st[7]);
            *(v4u*)(Hin + base) = o;
            float s[8]; unpack8(*(const v4u*)(Sbuf + base), s);
            const float a = cdec[(size_t)(b * 64 + c) * SSD_HEADS + hd];
#pragma unroll
            for (int j = 0; j < 8; ++j) st[j] = a * st[j] + s[j];
        }
        store8f(out + OUT_PS + (((size_t)b * SSD_HEADS + hd) * 64 + p) * 128 + n8 * 8, st);
    }
}

__device__ __forceinline__ void ph_ssd_out(LAS unsigned char* ldsb, const bf16* __restrict__ xbc_b, const bf16* __restrict__ projb, const float* __restrict__ dtv,
                                           const float* __restrict__ a_log, const float* __restrict__ d_skip, const float* __restrict__ norm_g,
                                           const bf16* __restrict__ Hin, bf16* __restrict__ A1) {
    const int tid = threadIdx.x, w = __builtin_amdgcn_readfirstlane(tid >> 6), lane = tid & 63;
    const int r = lane & 31, h = lane >> 5, blk = (lane >> 4) & 1, q = (lane & 15) >> 2, pp = lane & 3;
    const int lt = w & 3, hs = w >> 2;
    for (int unit = blockIdx.x; unit < BATCH * 64 * SSD_GROUPS; unit += gridDim.x) {
        const int g = unit & 3, bc = unit >> 2;
        const int t0 = bc * 128;
        __syncthreads();
        ssd_chunk_acs(ldsb, dtv, a_log, t0, g, nullptr);
        for (int idx = tid; idx < 2048; idx += NTHR) { const int row = idx >> 4, ch = idx & 15;
            const v4u v = *(const v4u*)(xbc_b + (size_t)(t0 + row) * CONV_DIM + 1536 + 128 * g + ch * 8);
            *(LAS v4u*)(ldsb + SSD_L_BM + row * SSD_RS_B + ch * 16) = v; }
        for (int idx = tid; idx < 6144; idx += NTHR) { const int hh = idx >> 10, rem = idx & 1023, row = rem >> 3, ch = rem & 7;
            const v4u v = *(const v4u*)(xbc_b + (size_t)(t0 + row) * CONV_DIM + (6 * g + hh) * 64 + ch * 8);
            *(LAS v4u*)(ldsb + SSD_L_X + hh * SSD_XIMG + row * SSD_RS_X + ch * 16) = v; }
        __syncthreads();
        const bf16* cp = xbc_b + (size_t)(t0 + 32 * lt + r) * CONV_DIM + 2048 + 128 * g + 8 * h;
        const int lcol = 32 * lt + r;
        const LAS float* acsb = (const LAS float*)(ldsb + SSD_L_ACS) + 3 * hs * 128; const LAS float* dtsb = (const LAS float*)(ldsb + SSD_L_DTS) + 3 * hs * 128;
        f32x16 y[3][2];
#pragma unroll
        for (int h3 = 0; h3 < 3; ++h3)
#pragma unroll
            for (int i = 0; i < 16; ++i) { y[h3][0][i] = 0.f; y[h3][1][i] = 0.f; }
#pragma unroll 1
        for (int ks = 0; ks < 8; ++ks) {
            const s16x8 cf = *(const s16x8*)(cp + 16 * ks);
#pragma unroll
            for (int h3 = 0; h3 < 3; ++h3) {
                const bf16* hp = Hin + (((size_t)bc * SSD_HEADS + 6 * g + 3 * hs + h3) * 64 + r) * 128 + 8 * h + 16 * ks;
                const s16x8 h0 = *(const s16x8*)hp, h1 = *(const s16x8*)(hp + 32 * 128);
                y[h3][0] = __builtin_amdgcn_mfma_f32_32x32x16_bf16(cf, h0, y[h3][0], 0, 0, 0);
                y[h3][1] = __builtin_amdgcn_mfma_f32_32x32x16_bf16(cf, h1, y[h3][1], 0, 0, 0);
            }
        }
#pragma unroll
        for (int h3 = 0; h3 < 3; ++h3)
#pragma unroll
            for (int q4 = 0; q4 < 4; ++q4) {
                const f32x4v a4 = *(const LAS f32x4v*)(acsb + h3 * 128 + 32 * lt + 8 * q4 + 4 * h);
                const float e0 = __expf(a4[0]), e1 = __expf(a4[1]), e2 = __expf(a4[2]), e3 = __expf(a4[3]);
                y[h3][0][4 * q4] *= e0; y[h3][0][4 * q4 + 1] *= e1; y[h3][0][4 * q4 + 2] *= e2; y[h3][0][4 * q4 + 3] *= e3;
                y[h3][1][4 * q4] *= e0; y[h3][1][4 * q4 + 1] *= e1; y[h3][1][4 * q4 + 2] *= e2; y[h3][1][4 * q4 + 3] *= e3;
            }
        const unsigned xb0 = lds_addr(ldsb + SSD_L_X + 3 * hs * SSD_XIMG) + (4 * h + q) * SSD_RS_X + (16 * blk + 4 * pp) * 2;
        for (int st = 0; st <= lt; ++st) {
            f32x16 cb;
#pragma unroll
            for (int i = 0; i < 16; ++i) cb[i] = 0.f;
#pragma unroll 2
            for (int ks = 0; ks < 8; ++ks) {
                const s16x8 cf = *(const s16x8*)(cp + 16 * ks);
                const s16x8 bfrag = *(const LAS s16x8*)(ldsb + SSD_L_BM + (32 * st + r) * SSD_RS_B + (16 * ks + 8 * h) * 2);
                cb = __builtin_amdgcn_mfma_f32_32x32x16_bf16(bfrag, cf, cb, 0, 0, 0);
            }
#pragma unroll
            for (int h3 = 0; h3 < 3; ++h3) {
                const LAS float* acs = acsb + h3 * 128; const LAS float* dts = dtsb + h3 * 128;
                const float myacs = acs[lcol];
                const float Dh = d_skip[6 * g + 3 * hs + h3];
                const unsigned xb = xb0 + h3 * SSD_XIMG + st * 32 * SSD_RS_X;
#pragma unroll
                for (int kk = 0; kk < 2; ++kk) {
                    const int s0 = 32 * st + 16 * kk + 4 * h;
                    const f32x4v as0 = *(const LAS f32x4v*)(acs + s0), as1 = *(const LAS f32x4v*)(acs + s0 + 8);
                    const f32x4v ds0 = *(const LAS f32x4v*)(dts + s0), ds1 = *(const LAS f32x4v*)(dts + s0 + 8);
                    float wv[8];
#pragma unroll
                    for (int j = 0; j < 8; ++j) {
                        const int s = s0 + 8 * (j >> 2) + (j & 3);
                        const float asj = (j < 4) ? as0[j & 3] : as1[j & 3], dsj = (j < 4) ? ds0[j & 3] : ds1[j & 3];
                        float v = cb[8 * kk + j] * __expf(myacs - asj) * dsj;
                        v = (s <= lcol) ? v : 0.f;
                        v = (s == lcol) ? v + Dh : v;
                        wv[j] = v;
                    }
                    s16x8 afr;
                    { v4u o; o.x = pk2(wv[0], wv[1]); o.y = pk2(wv[2], wv[3]); o.z = pk2(wv[4], wv[5]); o.w = pk2(wv[6], wv[7]); afr = __builtin_bit_cast(s16x8, o); }
                    s16x8 b0, b1;
                    if (kk == 0) { b0 = tr_frag<0, 8 * SSD_RS_X>(xb); b1 = tr_frag<64, 8 * SSD_RS_X + 64>(xb); }
                    else { b0 = tr_frag<16 * SSD_RS_X, 24 * SSD_RS_X>(xb); b1 = tr_frag<16 * SSD_RS_X + 64, 24 * SSD_RS_X + 64>(xb); }
                    y[h3][0] = __builtin_amdgcn_mfma_f32_32x32x16_bf16(afr, b0, y[h3][0], 0, 0, 0);
                    y[h3][1] = __builtin_amdgcn_mfma_f32_32x32x16_bf16(afr, b1, y[h3][1], 0, 0, 0);
                    __builtin_amdgcn_sched_barrier(0);
                }
            }
        }
        __syncthreads();
        {
            LAS unsigned short* yst = (LAS unsigned short*)(ldsb + SSD_L_X);
#pragma unroll
            for (int h3 = 0; h3 < 3; ++h3)
#pragma unroll
                for (int ptile = 0; ptile < 2; ++ptile)
#pragma unroll
                    for (int reg = 0; reg < 16; ++reg) {
                        const int l0 = 32 * lt + (reg & 3) + 8 * (reg >> 2) + 4 * h;
                        const int col = (3 * hs + h3) * 64 + 32 * ptile + r;
                        yst[l0 * (SSD_RS_Y / 2) + col] = (unsigned short)f2bf(y[h3][ptile][reg]);
                    }
        }
        __syncthreads();
#pragma unroll
        for (int pass = 0; pass < 4; ++pass) {
            const int l = 4 * (pass * 8 + w) + (lane >> 4), i16 = lane & 15;
            float gv[3][8]; float ss = 0.f;
#pragma unroll
            for (int k = 0; k < 3; ++k) {
                const int col0 = 24 * i16 + 8 * k;
                float yv[8], zv[8];
                unpack8(*(const LAS v4u*)(ldsb + SSD_L_X + l * SSD_RS_Y + col0 * 2), yv);
                unpack8(*(const v4u*)(projb + (size_t)(t0 + l) * NB_LD + g * 384 + col0), zv);
#pragma unroll
                for (int j = 0; j < 8; ++j) { const float gg = yv[j] * silu_f(zv[j]); gv[k][j] = gg; ss += gg * gg; }
            }
            ss += __shfl_xor(ss, 1); ss += __shfl_xor(ss, 2); ss += __shfl_xor(ss, 4); ss += __shfl_xor(ss, 8);
            const float rstd = rsqrtf(ss * (1.0f / 384.0f) + LN_EPS);
#pragma unroll
            for (int k = 0; k < 3; ++k) {
                const int col0 = g * 384 + 24 * i16 + 8 * k;
                const float4 g0 = *(const float4*)(norm_g + col0), g1 = *(const float4*)(norm_g + col0 + 4);
                v4u o; o.x = pk2(gv[k][0] * rstd * g0.x, gv[k][1] * rstd * g0.y); o.y = pk2(gv[k][2] * rstd * g0.z, gv[k][3] * rstd * g0.w);
                o.z = pk2(gv[k][4] * rstd * g1.x, gv[k][5] * rstd * g1.y); o.w = pk2(gv[k][6] * rstd * g1.z, gv[k][7] * rstd * g1.w);
                *(v4u*)(A1 + (size_t)(t0 + l) * MIX_WIDTH + col0) = o;
            }
        }
    }
}

#define ATT_RS_V 144
#define ATT_VIMG (256 * ATT_RS_V)
#define ATT_PV(KT, S2) { \
        v4u o_; o_.x = pk2(s[KT][8 * S2 + 0], s[KT][8 * S2 + 1]); o_.y = pk2(s[KT][8 * S2 + 2], s[KT][8 * S2 + 3]); \
        o_.z = pk2(s[KT][8 * S2 + 4], s[KT][8 * S2 + 5]); o_.w = pk2(s[KT][8 * S2 + 6], s[KT][8 * S2 + 7]); \
        const s16x8 pf_ = __builtin_bit_cast(s16x8, o_); \
        const s16x8 a0_ = tr_frag<(32 * KT + 16 * S2) * ATT_RS_V, (32 * KT + 16 * S2 + 8) * ATT_RS_V>(vbase); \
        const s16x8 a1_ = tr_frag<(32 * KT + 16 * S2) * ATT_RS_V + 64, (32 * KT + 16 * S2 + 8) * ATT_RS_V + 64>(vbase); \
        o0 = __builtin_amdgcn_mfma_f32_32x32x16_bf16(a0_, pf_, o0, 0, 0, 0); \
        o1 = __builtin_amdgcn_mfma_f32_32x32x16_bf16(a1_, pf_, o1, 0, 0, 0); }
__device__ __forceinline__ void ph_attn_prompt(LAS unsigned char* ldsb, const bf16* __restrict__ qrot_b, const bf16* __restrict__ krot_b, const bf16* __restrict__ projb,
                                               bf16* __restrict__ obuf, float* __restrict__ lsebuf) {
    const int tid = threadIdx.x, w = __builtin_amdgcn_readfirstlane(tid >> 6), lane = tid & 63;
    const int r = lane & 31, h = lane >> 5, blk = (lane >> 4) & 1, q = (lane & 15) >> 2, pp = lane & 3;
    const int qt = w & 3, hsel = w >> 2;
    for (int unit = blockIdx.x; unit < 3 * 512; unit += gridDim.x) {
        const int pat = unit >> 9, rem = unit & 511, hp = rem & 3, rem2 = rem >> 2, b = rem2 >> 6, bk = rem2 & 63;
        const int dsh = 2 * pat, nper = 64 >> dsh, res = bk >> (6 - dsh), nb = bk & (nper - 1);
        const int head = 2 * hp + hsel;
        __syncthreads();
        for (int idx = tid & 255; idx < 2048; idx += 256) {
            const int row = idx >> 3, ch = idx & 7, js = 128 * nb - 128 + row;
            v4u v; v.x = 0u; v.y = 0u; v.z = 0u; v.w = 0u;
            if (js >= 0) v = *(const v4u*)(projb + (size_t)(b * SEQ + (js << dsh) + res) * NB_LD + NB_V + head * 64 + ch * 8);
            *(LAS v4u*)(ldsb + hsel * ATT_VIMG + row * ATT_RS_V + ch * 16) = v;
        }
        const int tq = b * SEQ + ((128 * nb + 32 * qt + r) << dsh) + res;
        s16x8 qf[4];
#pragma unroll
        for (int ks = 0; ks < 4; ++ks) qf[ks] = *(const s16x8*)(qrot_b + (size_t)tq * ATT_WIDTH + head * 64 + 16 * ks + 8 * h);
        f32x16 s[5];
#pragma unroll
        for (int kt = 0; kt < 5; ++kt) {
            int js = 128 * nb + 32 * qt - 128 + 32 * kt + r; js = js < 0 ? 0 : js;
            const bf16* kp = krot_b + (size_t)(b * SEQ + (js << dsh) + res) * ATT_WIDTH + head * 64 + 8 * h;
#pragma unroll
            for (int i = 0; i < 16; ++i) s[kt][i] = 0.f;
#pragma unroll
            for (int ks = 0; ks < 4; ++ks) s[kt] = __builtin_amdgcn_mfma_f32_32x32x16_bf16(*(const s16x8*)(kp + 16 * ks), qf[ks], s[kt], 0, 0, 0);
        }
        float m = -INFINITY;
#pragma unroll
        for (int kt = 0; kt < 5; ++kt) {
            const bool tile_ok = (nb > 0) || (qt + kt >= 4);
#pragma unroll
            for (int reg = 0; reg < 16; ++reg) {
                const int c = (reg & 3) + 8 * (reg >> 2) + 4 * h;
                const bool ok = tile_ok && (kt == 0 ? (c >= r) : (kt == 4 ? (c <= r) : true));
                const float v = ok ? s[kt][reg] * 0.125f : -INFINITY;
                s[kt][reg] = v; m = fmaxf(m, v);
            }
        }
        m = fmaxf(m, __shfl_xor(m, 32));
        float l = 0.f;
#pragma unroll
        for (int kt = 0; kt < 5; ++kt)
#pragma unroll
            for (int reg = 0; reg < 16; ++reg) { const float p = __expf(s[kt][reg] - m); s[kt][reg] = p; l += p; }
        l += __shfl_xor(l, 32);
        __syncthreads();
        f32x16 o0, o1;
#pragma unroll
        for (int i = 0; i < 16; ++i) { o0[i] = 0.f; o1[i] = 0.f; }
        const unsigned vbase = lds_addr(ldsb + hsel * ATT_VIMG) + (32 * qt + 4 * h + q) * ATT_RS_V + (16 * blk + 4 * pp) * 2;
        ATT_PV(0, 0) ATT_PV(0, 1) ATT_PV(1, 0) ATT_PV(1, 1) ATT_PV(2, 0) ATT_PV(2, 1) ATT_PV(3, 0) ATT_PV(3, 1) ATT_PV(4, 0) ATT_PV(4, 1)
        const float inv = 1.0f / l;
        bf16* op = obuf + ((size_t)pat * T_PROMPT + tq) * ATT_WIDTH + head * 64 + 4 * h;
#pragma unroll
        for (int q4 = 0; q4 < 4; ++q4) {
            *(uint2*)(op + 8 * q4) = make_uint2(pk2(o0[4 * q4] * inv, o0[4 * q4 + 1] * inv), pk2(o0[4 * q4 + 2] * inv, o0[4 * q4 + 3] * inv));
            *(uint2*)(op + 32 + 8 * q4) = make_uint2(pk2(o1[4 * q4] * inv, o1[4 * q4 + 1] * inv), pk2(o1[4 * q4 + 2] * inv, o1[4 * q4 + 3] * inv));
        }
        if (h == 0) lsebuf[((size_t)pat * T_PROMPT + tq) * 8 + head] = m + __logf(l);
    }
}
__device__ __forceinline__ void ph_attn_combine(const bf16* __restrict__ obuf, const float* __restrict__ lsebuf, bf16* __restrict__ A1) {
    const int lane = threadIdx.x & 63;
    for (int t = blockIdx.x * NWAVE + (threadIdx.x >> 6); t < T_PROMPT; t += gridDim.x * NWAVE) {
        const int hd = lane >> 3;
        const float l0 = lsebuf[((size_t)0 * T_PROMPT + t) * 8 + hd], l1 = lsebuf[((size_t)1 * T_PROMPT + t) * 8 + hd], l2 = lsebuf[((size_t)2 * T_PROMPT + t) * 8 + hd];
        const float mx = fmaxf(l0, fmaxf(l1, l2));
        const float e0 = __expf(l0 - mx), e1 = __expf(l1 - mx), e2 = __expf(l2 - mx);
        const float inv = 1.0f / (e0 + e1 + e2);
        float a[8], b[8], c[8];
        unpack8(*(const v4u*)(obuf + ((size_t)0 * T_PROMPT + t) * ATT_WIDTH + lane * 8), a);
        unpack8(*(const v4u*)(obuf + ((size_t)1 * T_PROMPT + t) * ATT_WIDTH + lane * 8), b);
        unpack8(*(const v4u*)(obuf + ((size_t)2 * T_PROMPT + t) * ATT_WIDTH + lane * 8), c);
        float o[8];
#pragma unroll
        for (int j = 0; j < 8; ++j) o[j] = (e0 * a[j] + e1 * b[j] + e2 * c[j]) * inv;
        v4u w; w.x = pk2(o[0], o[1]); w.y = pk2(o[2], o[3]); w.z = pk2(o[4], o[5]); w.w = pk2(o[6], o[7]);
        *(v4u*)(A1 + (size_t)t * MIX_WIDTH + SSD_WIDTH + lane * 8) = w;
    }
}

#define RT_RS 272
#define RT_KIMG (128 * RT_RS)
#define RT_LUT (2 * RT_KIMG)
constexpr unsigned char RT_CANDS[64] = {0, 1, 2, 3, 4, 5, 6, 7, 8, 9, 10, 11, 12, 13, 14, 15, 16, 17, 18, 19, 20, 21, 22, 23, 32, 33, 34, 35, 36, 48, 49, 50, 51, 64, 65, 66, 80, 81, 96, 97,
                                        112, 113, 128, 144, 160, 176, 192, 208, 224, 240, 0, 0, 0, 0, 0, 0, 0, 0, 0, 0, 0, 0, 0, 0};
__device__ __forceinline__ unsigned rt_mono(float f) { const unsigned u = __builtin_bit_cast(unsigned, f); return u ^ ((unsigned)((int)u >> 31) | 0x80000000u); }
__device__ __forceinline__ float rt_unmono(unsigned m) { const unsigned u = (m & 0x80000000u) ? (m ^ 0x80000000u) : ~m; return __builtin_bit_cast(float, u); }
#define RT_CE_DESC(a, b) { const unsigned x_ = (a), y_ = (b); (a) = x_ > y_ ? x_ : y_; (b) = x_ > y_ ? y_ : x_; }
#define RT_CE_ASC(a, b) { const unsigned x_ = (a), y_ = (b); (a) = x_ > y_ ? y_ : x_; (b) = x_ > y_ ? x_ : y_; }
__device__ __forceinline__ void rt_sort16(unsigned (&v)[16]) {
#pragma unroll
    for (int k = 2; k <= 16; k <<= 1)
#pragma unroll
        for (int j = k >> 1; j > 0; j >>= 1)
#pragma unroll
            for (int i = 0; i < 16; ++i) { const int l = i ^ j; if (l > i) { if ((i & k) == 0) RT_CE_DESC(v[i], v[l]) else RT_CE_ASC(v[i], v[l]) } }
}
__device__ __forceinline__ void rt_merge16(unsigned (&v)[16]) {
#pragma unroll
    for (int j = 8; j > 0; j >>= 1)
#pragma unroll
        for (int i = 0; i < 16; ++i) { const int l = i ^ j; if (l > i) RT_CE_DESC(v[i], v[l]) }
}
__device__ __forceinline__ void rt_top16(unsigned (&a)[16], const unsigned (&b)[16]) {
#pragma unroll
    for (int i = 0; i < 16; ++i) a[i] = a[i] > b[15 - i] ? a[i] : b[15 - i];
    rt_merge16(a);
}
__device__ __forceinline__ void rt_top16_partner(unsigned (&a)[16]) {
    unsigned b[16];
#pragma unroll
    for (int i = 0; i < 16; ++i) b[i] = (unsigned)__shfl_xor((int)a[i], 32);
    rt_top16(a, b);
}
__device__ __forceinline__ void rt_scores_top16(LAS unsigned char* kimg, const bf16* __restrict__ qp, int r, int h, unsigned (&k0)[16]) {
    f32x16 acc[4];
#pragma unroll
    for (int kt = 0; kt < 4; ++kt)
#pragma unroll
        for (int i = 0; i < 16; ++i) acc[kt][i] = 0.f;
#pragma unroll
    for (int ks = 0; ks < 8; ++ks) {
        const s16x8 qf = *(const s16x8*)(qp + 16 * ks);
#pragma unroll
        for (int kt = 0; kt < 4; ++kt) {
            const s16x8 kf = *(const LAS s16x8*)(kimg + (32 * kt + r) * RT_RS + (16 * ks + 8 * h) * 2);
            acc[kt] = __builtin_amdgcn_mfma_f32_32x32x16_bf16(kf, qf, acc[kt], 0, 0, 0);
        }
    }
    unsigned k1[16], k2[16], k3[16];
#pragma unroll
    for (int reg = 0; reg < 16; ++reg) {
        const unsigned ki = (unsigned)((reg & 3) + 8 * (reg >> 2) + 4 * h);
        k0[reg] = (rt_mono(acc[0][reg]) & 0xFFFFFF80u) | ki;
        k1[reg] = (rt_mono(acc[1][reg]) & 0xFFFFFF80u) | (ki + 32u);
        k2[reg] = (rt_mono(acc[2][reg]) & 0xFFFFFF80u) | (ki + 64u);
        k3[reg] = (rt_mono(acc[3][reg]) & 0xFFFFFF80u) | (ki + 96u);
    }
    rt_sort16(k0); rt_sort16(k1); rt_sort16(k2); rt_sort16(k3);
    rt_top16(k0, k1); rt_top16(k2, k3); rt_top16(k0, k2);
    rt_top16_partner(k0);
}
__device__ __forceinline__ void ph_peer_route2(LAS unsigned char* ldsb, const bf16* __restrict__ qhb, const float* __restrict__ keys1, const float* __restrict__ keys2,
                                               int* __restrict__ eidx, float* __restrict__ gate) {
    const int tid = threadIdx.x, w = __builtin_amdgcn_readfirstlane(tid >> 6), lane = tid & 63, r = lane & 31, h = lane >> 5;
    __syncthreads();
    for (int idx = tid; idx < 2 * 128 * 16; idx += NTHR) {
        const int tb = idx >> 11, rem = idx & 2047, row = rem >> 4, ch = rem & 15;
        const float* sp = (tb ? keys2 : keys1) + row * 128 + ch * 8;
        const float4 a = *(const float4*)sp, b = *(const float4*)(sp + 4);
        v4u o; o.x = pk2(a.x, a.y); o.y = pk2(a.z, a.w); o.z = pk2(b.x, b.y); o.w = pk2(b.z, b.w);
        *(LAS v4u*)(ldsb + tb * RT_KIMG + row * RT_RS + ch * 16) = o;
    }
    __syncthreads();
    LAS unsigned* lut = (LAS unsigned*)(ldsb + RT_LUT) + w * 512;
    for (int unit = blockIdx.x * NWAVE + w; unit < (T_ALL / 32) * 8; unit += gridDim.x * NWAVE) {
        const int tt = unit >> 3, hd = unit & 7;
        const int tok = 32 * tt + r;
        const bf16* qp = qhb + (size_t)tok * 2048 + hd * 256 + 8 * h;
        unsigned ka[16], kb[16];
        rt_scores_top16(ldsb, qp, r, h, ka);
        rt_scores_top16(ldsb + RT_KIMG, qp + 128, r, h, kb);
        float v1[16], v2[16];
#pragma unroll
        for (int i = 0; i < 16; ++i) { v1[i] = rt_unmono(ka[i] & 0xFFFFFF80u); v2[i] = rt_unmono(kb[i] & 0xFFFFFF80u); }
#pragma unroll
        for (int wd = 0; wd < 4; ++wd) {
            lut[wd * 64 + lane] = (ka[4 * wd] & 0x7Fu) | ((ka[4 * wd + 1] & 0x7Fu) << 8) | ((ka[4 * wd + 2] & 0x7Fu) << 16) | ((ka[4 * wd + 3] & 0x7Fu) << 24);
            lut[(4 + wd) * 64 + lane] = (kb[4 * wd] & 0x7Fu) | ((kb[4 * wd + 1] & 0x7Fu) << 8) | ((kb[4 * wd + 2] & 0x7Fu) << 16) | ((kb[4 * wd + 3] & 0x7Fu) << 24);
        }
        unsigned c0[16], c1[16];
        c0[0] = (rt_mono(h ? (v1[0] + v2[1]) : (v1[0] + v2[0])) & 0xFFFFFF00u) | (h ? 1u : 0u);
        c0[1] = (rt_mono(h ? (v1[0] + v2[3]) : (v1[0] + v2[2])) & 0xFFFFFF00u) | (h ? 3u : 2u);
        c0[2] = (rt_mono(h ? (v1[0] + v2[5]) : (v1[0] + v2[4])) & 0xFFFFFF00u) | (h ? 5u : 4u);
        c0[3] = (rt_mono(h ? (v1[0] + v2[7]) : (v1[0] + v2[6])) & 0xFFFFFF00u) | (h ? 7u : 6u);
        c0[4] = (rt_mono(h ? (v1[0] + v2[9]) : (v1[0] + v2[8])) & 0xFFFFFF00u) | (h ? 9u : 8u);
        c0[5] = (rt_mono(h ? (v1[0] + v2[11]) : (v1[0] + v2[10])) & 0xFFFFFF00u) | (h ? 11u : 10u);
        c0[6] = (rt_mono(h ? (v1[0] + v2[13]) : (v1[0] + v2[12])) & 0xFFFFFF00u) | (h ? 13u : 12u);
        c0[7] = (rt_mono(h ? (v1[0] + v2[15]) : (v1[0] + v2[14])) & 0xFFFFFF00u) | (h ? 15u : 14u);
        c0[8] = (rt_mono(h ? (v1[1] + v2[1]) : (v1[1] + v2[0])) & 0xFFFFFF00u) | (h ? 17u : 16u);
        c0[9] = (rt_mono(h ? (v1[1] + v2[3]) : (v1[1] + v2[2])) & 0xFFFFFF00u) | (h ? 19u : 18u);
        c0[10] = (rt_mono(h ? (v1[1] + v2[5]) : (v1[1] + v2[4])) & 0xFFFFFF00u) | (h ? 21u : 20u);
        c0[11] = (rt_mono(h ? (v1[1] + v2[7]) : (v1[1] + v2[6])) & 0xFFFFFF00u) | (h ? 23u : 22u);
        c0[12] = (rt_mono(h ? (v1[2] + v2[1]) : (v1[2] + v2[0])) & 0xFFFFFF00u) | (h ? 33u : 32u);
        c0[13] = (rt_mono(h ? (v1[2] + v2[3]) : (v1[2] + v2[2])) & 0xFFFFFF00u) | (h ? 35u : 34u);
        c0[14] = (rt_mono(h ? (v1[3] + v2[0]) : (v1[2] + v2[4])) & 0xFFFFFF00u) | (h ? 48u : 36u);
        c0[15] = (rt_mono(h ? (v1[3] + v2[2]) : (v1[3] + v2[1])) & 0xFFFFFF00u) | (h ? 50u : 49u);
        c1[0] = (rt_mono(h ? (v1[4] + v2[0]) : (v1[3] + v2[3])) & 0xFFFFFF00u) | (h ? 64u : 51u);
        c1[1] = (rt_mono(h ? (v1[4] + v2[2]) : (v1[4] + v2[1])) & 0xFFFFFF00u) | (h ? 66u : 65u);
        c1[2] = (rt_mono(h ? (v1[5] + v2[1]) : (v1[5] + v2[0])) & 0xFFFFFF00u) | (h ? 81u : 80u);
        c1[3] = (rt_mono(h ? (v1[6] + v2[1]) : (v1[6] + v2[0])) & 0xFFFFFF00u) | (h ? 97u : 96u);
        c1[4] = (rt_mono(h ? (v1[7] + v2[1]) : (v1[7] + v2[0])) & 0xFFFFFF00u) | (h ? 113u : 112u);
        c1[5] = (rt_mono(h ? (v1[9] + v2[0]) : (v1[8] + v2[0])) & 0xFFFFFF00u) | (h ? 144u : 128u);
        c1[6] = (rt_mono(h ? (v1[11] + v2[0]) : (v1[10] + v2[0])) & 0xFFFFFF00u) | (h ? 176u : 160u);
        c1[7] = (rt_mono(h ? (v1[13] + v2[0]) : (v1[12] + v2[0])) & 0xFFFFFF00u) | (h ? 208u : 192u);
        c1[8] = (rt_mono(h ? (v1[15] + v2[0]) : (v1[14] + v2[0])) & 0xFFFFFF00u) | (h ? 240u : 224u);
        c1[9] = 0u;
        c1[10] = 0u;
        c1[11] = 0u;
        c1[12] = 0u;
        c1[13] = 0u;
        c1[14] = 0u;
        c1[15] = 0u;
        rt_sort16(c0); rt_sort16(c1); rt_top16(c0, c1); rt_top16_partner(c0);
        float e[16]; float sum = 0.f;
        const float mx = rt_unmono(c0[0] & 0xFFFFFF00u);
#pragma unroll
        for (int k = 0; k < 16; ++k) { e[k] = __expf(rt_unmono(c0[k] & 0xFFFFFF00u) - mx); sum += e[k]; }
        const float inv = 1.0f / sum;
        asm volatile("s_waitcnt lgkmcnt(0)" ::: "memory");
        int ex[8]; float gv[8];
#pragma unroll
        for (int k = 0; k < 8; ++k) {
            const unsigned hm = (unsigned)(-h);
            const unsigned ck = (c0[k] & ~hm) | (c0[8 + k] & hm);
            const float ek = __builtin_bit_cast(float, (__builtin_bit_cast(unsigned, e[k]) & ~hm) | (__builtin_bit_cast(unsigned, e[8 + k]) & hm));
            const unsigned ci = (ck >> 4) & 15u, cj = ck & 15u;
            const unsigned w1 = lut[(ci >> 2) * 64 + lane], w2 = lut[(4 + (cj >> 2)) * 64 + lane];
            const unsigned i1 = (w1 >> (8 * (ci & 3))) & 0x7Fu, i2 = (w2 >> (8 * (cj & 3))) & 0x7Fu;
            ex[k] = (int)(i1 * PEER_NKEYS + i2); gv[k] = ek * inv;
        }
        int* ep = eidx + (size_t)tok * 128 + hd * 16 + 8 * h; float* gp = gate + (size_t)tok * 128 + hd * 16 + 8 * h;
        *(int4*)ep = make_int4(ex[0], ex[1], ex[2], ex[3]); *(int4*)(ep + 4) = make_int4(ex[4], ex[5], ex[6], ex[7]);
        *(float4*)gp = make_float4(gv[0], gv[1], gv[2], gv[3]); *(float4*)(gp + 4) = make_float4(gv[4], gv[5], gv[6], gv[7]);
    }
}

struct Params {
    const float* in[23];
    float* out;
    unsigned char* ws;
    unsigned* bar;
};

#define WS_BAR      0ull
#define WS_XALL     (1ull << 20)
#define WS_PROJ     (WS_XALL + (size_t)T_ALL * D_MODEL * 4)
#define WS_XBC      (WS_PROJ + (size_t)T_ALL * PROJ_LD * 4)
#define WS_DT       (WS_XBC + (size_t)T_ALL * CONV_DIM * 4)
#define WS_QROT     (WS_DT + (size_t)T_ALL * SSD_HEADS * 4)
#define WS_KROT     (WS_QROT + (size_t)T_ALL * ATT_WIDTH * 4)
#define WS_YBUF     (WS_KROT + (size_t)T_ALL * ATT_WIDTH * 4)
#define WS_MIX      (WS_YBUF + (size_t)T_ALL * MIX_WIDTH * 4)
#define WS_HBUF     (WS_MIX + (size_t)T_ALL * D_MODEL * 4)
#define WS_QH       (WS_HBUF + (size_t)T_ALL * D_MODEL * 4)
#define WS_EIDX     (WS_QH + (size_t)T_ALL * 2048 * 4)
#define WS_GATE     (WS_EIDX + (size_t)T_ALL * 128 * 4)
#define WS_A0       (WS_GATE + (size_t)T_ALL * 128 * 4)
#define WS_A1       (WS_A0 + (size_t)T_ALL * D_MODEL * 2)
#define WS_A2       (WS_A1 + (size_t)T_ALL * MIX_WIDTH * 2)
#define WS_WTIN     (WS_A2 + (size_t)T_ALL * D_MODEL * 2)
#define WS_WTOUT    (WS_WTIN + (size_t)PROJ_LD * D_MODEL * 2)
#define WS_WTQ      (WS_WTOUT + (size_t)D_MODEL * MIX_WIDTH * 2)
#define WS_PROJB    (WS_WTQ + (size_t)2048 * D_MODEL * 2)
#define WS_DTRAW    (WS_PROJB + (size_t)T_ALL * NB_LD * 2)
#define WS_XBCB     (WS_DTRAW + (size_t)T_ALL * 32 * 4)
#define WS_QROTB    (WS_XBCB + (size_t)T_ALL * CONV_DIM * 2)
#define WS_KROTB    (WS_QROTB + (size_t)T_ALL * ATT_WIDTH * 2)
#define WS_UB       (WS_KROTB + (size_t)T_ALL * ATT_WIDTH * 2)
#define WS_VB       (WS_UB + (size_t)16384 * D_MODEL * 2)
#define WS_USC      (WS_VB + (size_t)16384 * D_MODEL * 2)
#define WS_VSC      (WS_USC + 16384 * 4)
#define WS_SBUF     (WS_VSC + 16384 * 4)
#define WS_HIN      (WS_SBUF + (size_t)BATCH * 64 * SSD_HEADS * 64 * 128 * 2)
#define WS_CDEC     (WS_HIN + (size_t)BATCH * 64 * SSD_HEADS * 64 * 128 * 2)
#define WS_OBUF     (WS_CDEC + (size_t)BATCH * 64 * SSD_HEADS * 4)
#define WS_LSE      (WS_OBUF + (size_t)3 * T_PROMPT * ATT_WIDTH * 2)
#define WS_ROPE     (WS_LSE + (size_t)3 * T_PROMPT * 8 * 4)
#define WS_END      (WS_ROPE + (size_t)SEQ * 64 * 4)

#define LDS_BYTES (160 * 1024)
#define N9_SLICES 13440u

#define KP const __attribute__((address_space(4))) Params* kp = (const __attribute__((address_space(4))) Params*)__builtin_amdgcn_kernarg_segment_ptr(); asm volatile("" : "+s"(kp)); unsigned char* ws = kp->ws; (void)ws;
#define IN(i) (kp->in[i])
#define WSP(T, off) ((T*)(ws + (off)))
__global__ void __launch_bounds__(512, 2) mega_fwd(Params p) {
    extern __shared__ __attribute__((aligned(16))) unsigned char smem[];
    if (threadIdx.x == 0) *(uint4*)smem = make_uint4(0u, 0u, 0u, 0u);
    __syncthreads();
    XcdBarrier bar = xcd_barrier_post(p.bar, (volatile LAS unsigned*)smem);
    float* lds = (float*)(smem + 256);
    LAS unsigned char* ldsb = (LAS unsigned char*)smem + 256;

    { KP ph_prologue(ldsb, IN(0), IN(1), WSP(bf16, WS_A0), IN(6), WSP(bf16, WS_WTIN), WSP(float, WS_ROPE)); }
    xcd_barrier(bar);
    { KP pg8::Gemm g{WSP(bf16, WS_A0), WSP(bf16, WS_WTIN), T_ALL, PROJ_LD, D_MODEL}; pg8::StaticOrder S; S.init(g.M, g.N, (int)gridDim.x, (int)blockIdx.x);
      pg8::EpiProj E{WSP(bf16, WS_PROJB), WSP(float, WS_DTRAW)}; pg8::gemm_phase<pg8::EpiProj, pg8::StaticOrder, false>(ldsb, g, S, E, nullptr); }
    xcd_barrier(bar);
    { KP ph_post_proj_prompt(WSP(bf16, WS_PROJB), WSP(float, WS_DTRAW), IN(7), IN(8), IN(9), WSP(float, WS_ROPE), WSP(bf16, WS_XBCB), WSP(float, WS_DT), WSP(bf16, WS_QROTB), WSP(bf16, WS_KROTB), kp->out); }
    { KP ph_post_proj2(WSP(bf16, WS_PROJB), WSP(float, WS_DTRAW), IN(4), IN(7), IN(8), IN(9), WSP(bf16, WS_XBCB), WSP(float, WS_DT), WSP(bf16, WS_QROTB), WSP(bf16, WS_KROTB), kp->out); }
    xcd_barrier(bar);
    { KP ph_ssd_states(ldsb, WSP(bf16, WS_XBCB), WSP(float, WS_DT), IN(10), WSP(bf16, WS_SBUF), WSP(float, WS_CDEC)); }
    __syncthreads();
    { KP ph_attn_prompt(ldsb, WSP(bf16, WS_QROTB), WSP(bf16, WS_KROTB), WSP(bf16, WS_PROJB), WSP(bf16, WS_OBUF), WSP(float, WS_LSE)); }
    __syncthreads();
    { KP ph_ssd_naive(lds, WSP(bf16, WS_XBCB), WSP(float, WS_DT), IN(10), IN(11), IN(5), WSP(float, WS_YBUF), kp->out); }
    { KP ph_attn_sample(lds, WSP(bf16, WS_QROTB), WSP(bf16, WS_KROTB), WSP(bf16, WS_PROJB), IN(2), IN(3), WSP(bf16, WS_A1)); }
    xcd_barrier(bar);
    if ((int)gridDim.x > 128) {
        if ((int)blockIdx.x < 96) { KP ph_ssd_scan(WSP(bf16, WS_SBUF), WSP(float, WS_CDEC), WSP(bf16, WS_HIN), kp->out, (int)blockIdx.x, 96); }
        else {
            { KP ph_prologue2(ldsb, IN(13), WSP(bf16, WS_WTOUT), IN(16), WSP(bf16, WS_WTQ), (int)blockIdx.x - 96, (int)gridDim.x - 96); }
            { KP ph_quant_tables(IN(19), IN(20), WSP(unsigned char, WS_UB), WSP(unsigned char, WS_VB), WSP(float, WS_USC), WSP(float, WS_VSC), (int)blockIdx.x - 96, (int)gridDim.x - 96); }
        }
    } else {
        { KP ph_ssd_scan(WSP(bf16, WS_SBUF), WSP(float, WS_CDEC), WSP(bf16, WS_HIN), kp->out, (int)blockIdx.x, (int)gridDim.x); }
        { KP ph_prologue2(ldsb, IN(13), WSP(bf16, WS_WTOUT), IN(16), WSP(bf16, WS_WTQ), (int)blockIdx.x, (int)gridDim.x); }
        { KP ph_quant_tables(IN(19), IN(20), WSP(unsigned char, WS_UB), WSP(unsigned char, WS_VB), WSP(float, WS_USC), WSP(float, WS_VSC), (int)blockIdx.x, (int)gridDim.x); }
    }
    xcd_barrier(bar);
    { KP ph_ssd_out(ldsb, WSP(bf16, WS_XBCB), WSP(bf16, WS_PROJB), WSP(float, WS_DT), IN(10), IN(11), IN(12), WSP(bf16, WS_HIN), WSP(bf16, WS_A1)); }
    { KP ph_attn_combine(WSP(bf16, WS_OBUF), WSP(float, WS_LSE), WSP(bf16, WS_A1)); }
    { KP ph_gate_norm(WSP(bf16, WS_PROJB), IN(12), WSP(float, WS_YBUF), WSP(bf16, WS_A1)); }
    xcd_barrier(bar);
    { KP pg8::Gemm g{WSP(bf16, WS_A1), WSP(bf16, WS_WTOUT), T_ALL, D_MODEL, MIX_WIDTH}; pg8::StaticOrder S; S.init(g.M, g.N, (int)gridDim.x, (int)blockIdx.x);
      pg8::EpiF32 E{WSP(float, WS_MIX), D_MODEL, nullptr}; pg8::gemm_phase<pg8::EpiF32, pg8::StaticOrder, false>(ldsb, g, S, E, nullptr); }
    if (blockIdx.x >= 8 && gridDim.x == 256) { KP cache_copy_slice(IN(2), IN(3), kp->out, N9_SLICES + (blockIdx.x - 8) * 8u + (threadIdx.x >> 6), threadIdx.x & 63u); }
    xcd_barrier(bar);
    { KP ph_ln_res(IN(0), IN(1), WSP(float, WS_MIX), IN(14), IN(15), WSP(float, WS_HBUF), WSP(bf16, WS_A2)); }
    xcd_barrier(bar);
    { KP pg8::Gemm g{WSP(bf16, WS_A2), WSP(bf16, WS_WTQ), T_ALL, 2048, D_MODEL}; pg8::StaticOrder S; S.init(g.M, g.N, (int)gridDim.x, (int)blockIdx.x);
      pg8::EpiBf16Plain E{WSP(bf16, WS_QH), 2048}; pg8::gemm_phase<pg8::EpiBf16Plain, pg8::StaticOrder, false>(ldsb, g, S, E, nullptr); }
    if (blockIdx.x >= 16 && gridDim.x == 256 && threadIdx.x < 256) { KP cache_copy_slice(IN(2), IN(3), kp->out, N9_SLICES + 1984u + (blockIdx.x - 16) * 4u + (threadIdx.x >> 6), threadIdx.x & 63u); }
    xcd_barrier(bar);
    { KP ph_peer_route2(ldsb, WSP(bf16, WS_QH), IN(17), IN(18), WSP(int, WS_EIDX), WSP(float, WS_GATE)); }
    xcd_barrier(bar);
    { KP ph_peer_ffn3(WSP(float, WS_HBUF), WSP(int, WS_EIDX), WSP(float, WS_GATE), WSP(unsigned char, WS_UB), WSP(unsigned char, WS_VB), WSP(float, WS_USC), WSP(float, WS_VSC), IN(21), IN(22), kp->out, IN(2), IN(3), gridDim.x == 256 ? N9_SLICES : 16384u); }
}

extern "C" void kernel_launch(void* const* d_in, const int* in_sizes, int n_in, void* d_out, int out_size, void* d_ws, size_t ws_size, hipStream_t stream) {
    static int grid = 0;
    if (grid == 0) {
        int dev = 0, cus = 0, per_cu = 0;
        if (hipGetDevice(&dev) != hipSuccess || hipDeviceGetAttribute(&cus, hipDeviceAttributeMultiprocessorCount, dev) != hipSuccess) { fprintf(stderr, "kernel_launch: device query failed\n"); grid = -1; return; }
        if (hipFuncSetAttribute((const void*)mega_fwd, hipFuncAttributeMaxDynamicSharedMemorySize, LDS_BYTES) != hipSuccess) { fprintf(stderr, "kernel_launch: hipFuncSetAttribute failed\n"); grid = -1; return; }
        if (hipOccupancyMaxActiveBlocksPerMultiprocessor(&per_cu, (const void*)mega_fwd, NTHR, LDS_BYTES) != hipSuccess || per_cu < 1) { fprintf(stderr, "kernel_launch: occupancy query says %d\n", per_cu); }
        (void)hipGetLastError();
        grid = cus;
        if (ws_size < WS_END) { fprintf(stderr, "kernel_launch: workspace too small\n"); grid = -1; return; }
    }
    if (grid < 0) return;
    (void)hipMemsetAsync((char*)d_ws + WS_BAR, 0, XCD_BAR_WORDS * sizeof(unsigned), stream);
    Params p{};
    for (int i = 0; i < 23; ++i) p.in[i] = (const float*)d_in[i];
    p.out = (float*)d_out; p.ws = (unsigned char*)d_ws; p.bar = (unsigned*)((char*)d_ws + WS_BAR);
    hipLaunchKernelGGL(mega_fwd, dim3(grid), dim3(NTHR), LDS_BYTES, stream, p);
}
```

```cpp
#include <hip/hip_runtime.h>
#include <stdint.h>

#define D_MODEL 1024
#define BATCH 2
#define SEQ 8192
#define DEC_BATCH 128
#define DEC_SEQ 4
#define PAST_LEN 8192
#define HEAD_DIM 64
#define ATT_WIDTH 512
#define ATT_HEADS 8
#define SSD_WIDTH 1536
#define SSD_HEADS 24
#define SSD_GROUPS 4
#define SSD_STATE 128
#define CONV_DIM 2560
#define IN_WIDTH 5656
#define PROJ_LD 5888
#define MIX_WIDTH 2048
#define WBUF 2048
#define PEER_NKEYS 128
#define PEER_HEADS 8
#define PEER_TOPK 16
#define PEER_DKEY 256
#define T_PROMPT (BATCH * SEQ)
#define T_SAMPLE (DEC_BATCH * DEC_SEQ)
#define T_ALL (T_PROMPT + T_SAMPLE)
#define O_Z 0
#define O_XBC 1536
#define O_DT 4096
#define O_Q 4120
#define O_K 4632
#define O_V 5144
#define ALPHA_F 1.189207115002721f
#define LN_EPS 1e-5f

#define OUT_YP 0ull
#define OUT_YS (OUT_YP + 16777216ull)
#define OUT_PK (OUT_YS + 524288ull)
#define OUT_PV (OUT_PK + 2097152ull)
#define OUT_PC (OUT_PV + 2097152ull)
#define OUT_PS (OUT_PC + 15360ull)
#define OUT_SK (OUT_PS + 393216ull)
#define OUT_SV (OUT_SK + 134217728ull)
#define OUT_SC (OUT_SV + 134217728ull)
#define OUT_SS (OUT_SC + 983040ull)

__constant__ double ROPE_INV_REV[32] = {
    1.59154943091895346e-01, 1.19349370211248862e-01, 8.94994016088910133e-02, 6.71150830052272551e-02,
    5.03292121044870353e-02, 3.77415847174197711e-02, 2.83021958306233987e-02, 2.12236527647776604e-02,
    1.59154943091895339e-02, 1.19349370211248862e-02, 8.94994016088910237e-03, 6.71150830052272534e-03,
    5.03292121044870370e-03, 3.77415847174197719e-03, 2.83021958306233987e-03, 2.12236527647776622e-03,
    1.59154943091895356e-03, 1.19349370211248849e-03, 8.94994016088910237e-04, 6.71150830052272599e-04,
    5.03292121044870326e-04, 3.77415847174197741e-04, 2.83021958306233954e-04, 2.12236527647776605e-04,
    1.59154943091895351e-04, 1.19349370211248862e-04, 8.94994016088910182e-05, 6.71150830052272545e-05,
    5.03292121044870354e-05, 3.77415847174197768e-05, 2.83021958306233961e-05, 2.12236527647776592e-05
};

__device__ __forceinline__ float silu_f(float x) { return x / (1.0f + __expf(-x)); }
__device__ __forceinline__ float softplus_f(float x) { return fmaxf(x, 0.f) + log1pf(__expf(-fabsf(x))); }
__device__ __forceinline__ float gelu_f(float x) { return 0.5f * x * (1.0f + erff(x * 0.70710678118654752f)); }
__device__ __forceinline__ float wave_sum(float v) {
#pragma unroll
    for (int o = 32; o > 0; o >>= 1) v += __shfl_xor(v, o);
    return v;
}
__device__ __forceinline__ float wave_max(float v) {
#pragma unroll
    for (int o = 32; o > 0; o >>= 1) v = fmaxf(v, __shfl_xor(v, o));
    return v;
}

#include <cstdio>
#define XB_TMO      128
#define XB_XCNT(j)  (256  + 64 * (j))
#define XB_XSUB(j)  (1280 + 64 * (j))
#define XB_XGEN(j)  (2304 + 64 * (j))
#define XB_TOP      3328
#define XB_TOPGEN   3392
#define XCD_BAR_WORDS 3456
#define XB_SPIN_CAP (1u << 18)
#define LAS __attribute__((address_space(3)))

__device__ __forceinline__ unsigned xb_ld(unsigned* p)              { return __hip_atomic_load(p, __ATOMIC_RELAXED, __HIP_MEMORY_SCOPE_AGENT); }
__device__ __forceinline__ unsigned xb_add(unsigned* p, unsigned v) { return __hip_atomic_fetch_add(p, v, __ATOMIC_RELAXED, __HIP_MEMORY_SCOPE_AGENT); }
__device__ __forceinline__ unsigned xb_xcc_id() { return (unsigned)__builtin_amdgcn_s_getreg((3 << 11) | 20) & 0xFu; }
#define XB_SPIN(cond, bar) do { unsigned _sp = 0; while (cond) { __builtin_amdgcn_s_sleep(1); \
    if ((++_sp & 255u) == 0u) { if (xb_ld(&(bar)[XB_TMO])) break; if (_sp > XB_SPIN_CAP) { atomicAdd(&(bar)[XB_TMO], 1u); break; } } } } while (0)

struct XcdBarrier {
    unsigned* bar; unsigned x;
    volatile LAS unsigned* st;
};

__device__ __forceinline__ XcdBarrier xcd_barrier_post(unsigned* bar, volatile LAS unsigned* st) {
    XcdBarrier b; b.bar = bar; b.x = xb_xcc_id(); b.st = st;
    if (threadIdx.x == 0) (void)xb_add(&bar[XB_XCNT(b.x)], 1u);
    return b;
}
__device__ __forceinline__ void xcd_barrier_complete(unsigned* bar, unsigned x, unsigned& nloc, unsigned& nx) {
    const unsigned G = gridDim.x * gridDim.y * gridDim.z;
    unsigned sum, cnt, mine, sp = 0u;
    for (;;) {
        sum = 0u; cnt = 0u; mine = 0u;
#pragma unroll
        for (unsigned j = 0; j < 16; ++j) { const unsigned c = xb_ld(&bar[XB_XCNT(j)]); sum += c; cnt += (c > 0u) ? 1u : 0u; mine = (j == x) ? c : mine; }
        if (sum == G) break;
        __builtin_amdgcn_s_sleep(1);
        if ((++sp & 255u) == 0u) { if (xb_ld(&bar[XB_TMO])) break; if (sp > XB_SPIN_CAP) { atomicAdd(&bar[XB_TMO], 1u); break; } }
    }
    nloc = mine > 0u ? mine : 1u; nx = cnt > 0u ? cnt : 1u;
}

__device__ __forceinline__ void xcd_barrier(const XcdBarrier& b) {
    asm volatile("s_waitcnt vmcnt(0)" ::: "memory");
    __syncthreads();
    if (threadIdx.x == 0) {
        unsigned* bar = b.bar;
        __builtin_amdgcn_s_waitcnt(0);
        unsigned nloc = b.st[0], nx = b.st[1];
        if (nloc == 0u) { xcd_barrier_complete(bar, b.x, nloc, nx); b.st[0] = nloc; b.st[1] = nx; }
        const unsigned old = xb_add(&bar[XB_XSUB(b.x)], 1u);
        const unsigned gen = old / nloc;
        if (old + 1u == (gen + 1u) * nloc) {
            __builtin_amdgcn_fence(__ATOMIC_RELEASE, "agent");
            asm volatile("s_waitcnt vmcnt(0)" ::: "memory");
            const unsigned og = xb_add(&bar[XB_TOP], 1u);
            const unsigned tg = og / nx;
            if (og + 1u == (tg + 1u) * nx) xb_add(&bar[XB_TOPGEN], 1u);
            else XB_SPIN(xb_ld(&bar[XB_TOPGEN]) == tg, bar);
            __builtin_amdgcn_fence(__ATOMIC_ACQUIRE, "agent");
            xb_add(&bar[XB_XGEN(b.x)], 1u);
            asm volatile("s_waitcnt vmcnt(0)" ::: "memory");
        } else {
            XB_SPIN(xb_ld(&bar[XB_XGEN(b.x)]) == gen, bar);
            __builtin_amdgcn_fence(__ATOMIC_ACQUIRE, "agent");
            asm volatile("s_waitcnt vmcnt(0)" ::: "memory");
        }
    }
    __syncthreads();
}


#define GAS __attribute__((address_space(1)))
typedef unsigned short bf16;
typedef unsigned v4u __attribute__((ext_vector_type(4)));
#define LDS_WAIT() asm volatile("s_waitcnt lgkmcnt(0)" ::: "memory")
__device__ __forceinline__ unsigned f2bf(float f) { unsigned u = __builtin_bit_cast(unsigned, f); return (u + 0x7fffu + ((u >> 16) & 1u)) >> 16; }
__device__ __forceinline__ unsigned pk2(float lo, float hi) { return f2bf(lo) | (f2bf(hi) << 16); }
__device__ __forceinline__ float bf2f(unsigned short b) { return __builtin_bit_cast(float, (unsigned)b << 16); }
#include <hip/hip_runtime.h>
namespace pg8 {
#define PG8_LAS __attribute__((address_space(3)))
typedef unsigned short bf16_t;
typedef short bf16x8 __attribute__((ext_vector_type(8)));
typedef float f32x4 __attribute__((ext_vector_type(4)));
typedef unsigned u32x4 __attribute__((ext_vector_type(4)));
constexpr int BM = 256, BK = 64, HALF = 128, HTB = HALF * BK * 2  , STAGE_BYTES = 8 * HTB, NXCD = 8, WGM = 8;

__host__ __device__ __forceinline__ int lds_byte(int r, int c) { const int st = (r >> 4) * 2 + (c >> 5), rr = r & 15, cc = c & 31, ob = rr * 64 + cc * 2; return st * 1024 + (ob ^ (((ob >> 9) & 1) << 5)); }
__host__ __device__ __forceinline__ void stage_rc(int b, int& R, int& C) { const int st = b / 1024, sb = b % 1024, swz = sb ^ (((sb >> 9) & 1) << 5); R = (st >> 1) * 16 + swz / 64; C = (st & 1) * 32 + (swz % 64) / 2; }
__host__ __device__ __forceinline__ int perm32(int rho) { const int n = rho >> 4, i = rho & 15; return 8 * (i >> 2) + 4 * n + (i & 3); }

struct Unit { int pm, pn; };
struct Gemm { const bf16_t* A; const bf16_t* Bt; int M, N, K; };

struct StaticOrder {
    int nM, nN, nwg, G, c;
    __host__ __device__ void init(int M, int N, int G_, int c_) { nM = M / BM; nN = N / BM; nwg = nM * nN; G = G_; c = c_; }
    __host__ __device__ bool next(int i, Unit& u) const {
        const long L = (long)i * G + c; if (L >= nwg) return false;
        int wgid = (int)L; { const int q = nwg / NXCD, r = nwg % NXCD, xcd = wgid % NXCD, off = wgid / NXCD; wgid = (xcd < r ? xcd * (q + 1) : r * (q + 1) + (xcd - r) * q) + off; }
        const int nig = WGM * nN, gid = wgid / nig, fm = gid * WGM, gsz = (nM - fm) < WGM ? (nM - fm) : WGM;
        u.pm = fm + ((wgid % nig) % gsz); u.pn = (wgid % nig) / gsz; return true;
    }
    __device__ __forceinline__ void a_ready(const Unit&) const {}
    __device__ __forceinline__ void done(const Unit&) const {}
};
__device__ __forceinline__ unsigned cvt_pk_bf16(float lo, float hi) { unsigned r; asm volatile("v_cvt_pk_bf16_f32 %0, %1, %2" : "=v"(r) : "v"(lo), "v"(hi)); return r; }
typedef float f32x2 __attribute__((ext_vector_type(2)));
__device__ __forceinline__ f32x2 gelu_pk(f32x2 v) {
    const f32x2 av = __builtin_elementwise_abs(v), d = av * 0.2316418882f + 1.0f;
    f32x2 t; t.x = __builtin_amdgcn_rcpf(d.x); t.y = __builtin_amdgcn_rcpf(d.y);
    f32x2 q = t * 0.5307027145f + (-0.7265760135f); q = q * t + 0.7107068705f; q = q * t + (-0.142248368f); q = q * t + 0.127414796f; q = q * t;
    const f32x2 s = (v * v) * (-0.72134752044f);
    f32x2 e; e.x = __builtin_amdgcn_exp2f(s.x); e.y = __builtin_amdgcn_exp2f(s.y);
    const f32x2 m = v * (q * e), r = v - m;
    f32x2 o; o.x = v.x < 0.f ? m.x : r.x; o.y = v.y < 0.f ? m.y : r.y; return o;
}

struct EpiF32 {
    static constexpr bool PERM = false, AFTER_DRAIN = false;
    float* C; int ldc; const float* bias;
    __device__ __forceinline__ void operator()(const f32x4 (&acc)[2][2][4][2], const Unit& u, int wr, int wc, int fr, int fq) const {
        const int row0 = u.pm * BM + wr * 64 + fr, col0 = u.pn * BM + wc * 32 + 4 * fq;
        f32x4 bv[2][2];
#pragma unroll
        for (int bj = 0; bj < 2; ++bj)
#pragma unroll
            for (int n = 0; n < 2; ++n) bv[bj][n] = bias ? *(const f32x4*)(bias + col0 + bj * HALF + n * 16) : (f32x4){0.f, 0.f, 0.f, 0.f};
#pragma unroll
        for (int ai = 0; ai < 2; ++ai)
#pragma unroll
            for (int m = 0; m < 4; ++m) { float* rowp = C + (size_t)(row0 + ai * HALF + m * 16) * ldc + col0;
#pragma unroll
                for (int bj = 0; bj < 2; ++bj)
#pragma unroll
                    for (int n = 0; n < 2; ++n) *(f32x4*)(rowp + bj * HALF + n * 16) = acc[ai][bj][m][n] + bv[bj][n]; }
    }
};

template <class Epi, class Sched, bool STAMP = false>
__device__ __forceinline__ void gemm_phase(PG8_LAS unsigned char* lds, const Gemm g, const Sched& S, const Epi& E, unsigned long long* stamps) {
    const int tid = threadIdx.x, wid = __builtin_amdgcn_readfirstlane(tid >> 6), lane = tid & 63, wr = wid >> 2, wc = wid & 3, fr = lane & 15, fq = lane >> 4;
    const int K = g.K, nt = K / BK;
    int ts_lo = 0, ts_hi = 0, nts = 0; const unsigned long long rt_entry = STAMP ? (unsigned long long)wall_clock64() : 0ull;
#define PG8_STAMP() do { if (STAMP && wid == 0 && nts < 64) { const unsigned long long _c = (unsigned long long)clock64(); \
        ts_lo = (lane == nts) ? (int)(unsigned)_c : ts_lo; ts_hi = (lane == nts) ? (int)(unsigned)(_c >> 32) : ts_hi; ++nts; } } while (0)
    PG8_STAMP();
    unsigned voffA[2], voffB[2];
#pragma unroll
    for (int i = 0; i < 2; ++i) { int R, C; stage_rc(tid * 16 + i * 8192, R, C); const int Rb = Epi::PERM ? ((R & ~31) + perm32(R & 31)) : R;
        voffA[i] = (unsigned)(R * K + C) * 2u; voffB[i] = (unsigned)(Rb * K + C) * 2u; }
    const size_t kstep = (size_t)(BK * 2);
    const size_t hstep = (size_t)HALF * K * 2;
    const size_t tstep = 2 * hstep;
    const unsigned ldsw = (unsigned)wid * 1024u;
    const int aoff = lds_byte(wr * 64 + fr, fq * 8), boff = lds_byte(wc * 32 + fr, fq * 8);
#define PG8_SA(b, h) (((b) * 2 + (h)) * HTB)
#define PG8_SB(b, h) ((4 + (b) * 2 + (h)) * HTB)
#define PG8_STAGE(bufoff, gbase, voff) do { _Pragma("unroll") for (int _i = 0; _i < 2; ++_i) \
        __builtin_amdgcn_global_load_lds((const unsigned*)((const char*)(gbase) + (voff)[_i]), (PG8_LAS unsigned*)(lds + (bufoff) + ldsw + _i * 8192), 16, 0, 0); } while (0)
#define PG8_LDA(dst, b, h) do { _Pragma("unroll") for (int m = 0; m < 4; ++m) _Pragma("unroll") for (int k = 0; k < 2; ++k) dst[m][k] = *(const PG8_LAS bf16x8*)(lds + PG8_SA(b, h) + aoff + m * 2048 + k * 1024); } while (0)
#define PG8_LDB(dst, b, h) do { _Pragma("unroll") for (int n = 0; n < 2; ++n) _Pragma("unroll") for (int k = 0; k < 2; ++k) dst[n][k] = *(const PG8_LAS bf16x8*)(lds + PG8_SB(b, h) + boff + n * 2048 + k * 1024); } while (0)
#define PG8_MMA(ai, bj, At, Bt) do { __builtin_amdgcn_s_setprio(1); _Pragma("unroll") for (int m = 0; m < 4; ++m) _Pragma("unroll") for (int n = 0; n < 2; ++n) _Pragma("unroll") for (int k = 0; k < 2; ++k) \
        acc[ai][bj][m][n] = __builtin_amdgcn_mfma_f32_16x16x32_bf16(Bt[n][k], At[m][k], acc[ai][bj][m][n], 0, 0, 0); __builtin_amdgcn_s_setprio(0); } while (0)
#define PG8_WAIT_V(n) asm volatile("s_waitcnt vmcnt(" #n ")" ::: "memory")
#define PG8_WAIT_L(n) asm volatile("s_waitcnt lgkmcnt(" #n ")" ::: "memory")
#define PG8_BAR __builtin_amdgcn_s_barrier()
#define PG8_SCHED __builtin_amdgcn_sched_barrier(0)
    Unit cur, nxt; int ui = 0;
    if (!S.next(0, cur)) return;
    f32x4 acc[2][2][4][2];
#pragma unroll
    for (int a = 0; a < 2; ++a)
#pragma unroll
        for (int b = 0; b < 2; ++b)
#pragma unroll
            for (int m = 0; m < 4; ++m)
#pragma unroll
                for (int n = 0; n < 2; ++n) acc[a][b][m][n] = (f32x4){0.f, 0.f, 0.f, 0.f};
    bf16x8 At[4][2], B0[2][2], B1[2][2];
    const char* cA = (const char*)g.A + (size_t)cur.pm * tstep; const char* cB = (const char*)g.Bt + (size_t)cur.pn * tstep;
    S.a_ready(cur);
    PG8_STAGE(PG8_SB(0, 0), cB, voffB); PG8_STAGE(PG8_SA(0, 0), cA, voffA); PG8_STAGE(PG8_SB(0, 1), cB + hstep, voffB); PG8_STAGE(PG8_SA(0, 1), cA + hstep, voffA);
    if (wr == 1) PG8_BAR;
    PG8_WAIT_V(4); PG8_BAR;
    PG8_STAGE(PG8_SB(1, 0), cB + kstep, voffB); PG8_STAGE(PG8_SA(1, 0), cA + kstep, voffA); PG8_STAGE(PG8_SB(1, 1), cB + hstep + kstep, voffB);
    PG8_WAIT_V(6); PG8_BAR;
    PG8_STAMP();
    for (;;) {
        const bool has_next = S.next(ui + 1, nxt);
        const char* nA = has_next ? (const char*)g.A + (size_t)nxt.pm * tstep : cA; const char* nB = has_next ? (const char*)g.Bt + (size_t)nxt.pn * tstep : cB;
        for (int t = 0; t < nt; t += 2) {
            const bool last = (t == nt - 2);
            const char* a1 = cA + (size_t)(t + 1) * kstep;
            const char* a2 = last ? nA : cA + (size_t)(t + 2) * kstep; const char* b2 = last ? nB : cB + (size_t)(t + 2) * kstep;
            const char* a3 = a2 + kstep; const char* b3 = b2 + kstep;
            if (last && has_next) S.a_ready(nxt);
            PG8_LDB(B0, 0, 0); PG8_SCHED; PG8_LDA(At, 0, 0); PG8_STAGE(PG8_SA(1, 1), a1 + hstep, voffA);
            PG8_WAIT_L(8); PG8_BAR; PG8_WAIT_L(0); PG8_MMA(0, 0, At, B0); PG8_BAR; PG8_SCHED;
            PG8_LDB(B1, 0, 1); PG8_STAGE(PG8_SB(0, 0), b2, voffB);
            PG8_BAR; PG8_WAIT_L(0); PG8_MMA(0, 1, At, B1); PG8_BAR;
            PG8_LDA(At, 0, 1); PG8_STAGE(PG8_SA(0, 0), a2, voffA);
            PG8_BAR; PG8_WAIT_L(0); PG8_MMA(1, 0, At, B0); PG8_BAR; PG8_SCHED;
            PG8_STAGE(PG8_SB(0, 1), b2 + hstep, voffB);
            PG8_WAIT_V(6); PG8_BAR; PG8_MMA(1, 1, At, B1); PG8_BAR;
            PG8_LDB(B0, 1, 0); PG8_SCHED; PG8_LDA(At, 1, 0); PG8_STAGE(PG8_SA(0, 1), a2 + hstep, voffA);
            PG8_WAIT_L(8); PG8_BAR; PG8_WAIT_L(0); PG8_MMA(0, 0, At, B0); PG8_BAR; PG8_SCHED;
            PG8_LDB(B1, 1, 1); PG8_STAGE(PG8_SB(1, 0), b3, voffB);
            PG8_BAR; PG8_WAIT_L(0); PG8_MMA(0, 1, At, B1); PG8_BAR;
            PG8_LDA(At, 1, 1); PG8_STAGE(PG8_SA(1, 0), a3, voffA);
            PG8_BAR; PG8_WAIT_L(0); PG8_MMA(1, 0, At, B0); PG8_BAR; PG8_SCHED;
            PG8_STAGE(PG8_SB(1, 1), b3 + hstep, voffB);
            PG8_WAIT_V(6); PG8_BAR; PG8_MMA(1, 1, At, B1); PG8_BAR;
        }
        PG8_STAMP();
        if constexpr (!Epi::AFTER_DRAIN) { E(acc, cur, wr, wc, fr, fq); S.done(cur); }
        PG8_STAMP();
        if (!has_next) break;
#pragma unroll
        for (int a = 0; a < 2; ++a)
#pragma unroll
            for (int b = 0; b < 2; ++b)
#pragma unroll
                for (int m = 0; m < 4; ++m)
#pragma unroll
                    for (int n = 0; n < 2; ++n) acc[a][b][m][n] = (f32x4){0.f, 0.f, 0.f, 0.f};
        cur = nxt; cA = nA; cB = nB; ++ui;
    }
    PG8_WAIT_V(0);
    if (wr == 0) PG8_BAR;
    PG8_BAR;
    if constexpr (Epi::AFTER_DRAIN) { E.fused(acc, cur, wr, wc, fr, fq, lds, wid, lane); S.done(cur); }
    PG8_STAMP();
    if (STAMP && wid == 0) { stamps[lane] = lane < nts ? (((unsigned long long)(unsigned)ts_hi << 32) | (unsigned)ts_lo) : 0ull;
        if (lane == 62) stamps[62] = rt_entry; if (lane == 63) stamps[63] = (unsigned long long)wall_clock64(); }
#undef PG8_STAMP
#undef PG8_SA
#undef PG8_SB
#undef PG8_STAGE
#undef PG8_LDA
#undef PG8_LDB
#undef PG8_MMA
#undef PG8_WAIT_V
#undef PG8_WAIT_L
#undef PG8_BAR
#undef PG8_SCHED
}
}


namespace pg8 {
struct EpiProj {
    static constexpr bool PERM = true, AFTER_DRAIN = false;
    bf16_t* O; float* dtraw;
    __device__ __forceinline__ void operator()(const f32x4 (&acc)[2][2][4][2], const Unit& u, int wr, int wc, int fr, int fq) const {
        const int row0 = u.pm * BM + wr * 64 + fr;
        if (u.pn < 22) {
            const int col0 = u.pn * BM + wc * 32 + 8 * fq;
#pragma unroll
            for (int ai = 0; ai < 2; ++ai)
#pragma unroll
                for (int m = 0; m < 4; ++m) { bf16_t* rowp = O + (size_t)(row0 + ai * HALF + m * 16) * 5632 + col0;
#pragma unroll
                    for (int bj = 0; bj < 2; ++bj) { const f32x4 v0 = acc[ai][bj][m][0], v1 = acc[ai][bj][m][1];
                        u32x4 w; w.x = cvt_pk_bf16(v0[0], v0[1]); w.y = cvt_pk_bf16(v0[2], v0[3]); w.z = cvt_pk_bf16(v1[0], v1[1]); w.w = cvt_pk_bf16(v1[2], v1[3]);
                        *(u32x4*)(rowp + bj * HALF) = w; } }
        } else if (wc == 0) {
#pragma unroll
            for (int ai = 0; ai < 2; ++ai)
#pragma unroll
                for (int m = 0; m < 4; ++m) { float* rp = dtraw + (size_t)(row0 + ai * HALF + m * 16) * 32 + 8 * fq;
                    *(f32x4*)rp = acc[ai][0][m][0]; *(f32x4*)(rp + 4) = acc[ai][0][m][1]; }
        }
    }
};
}


namespace pg8 {
struct EpiBf16Plain {
    static constexpr bool PERM = true, AFTER_DRAIN = false;
    bf16_t* O; int ldc;
    __device__ __forceinline__ void operator()(const f32x4 (&acc)[2][2][4][2], const Unit& u, int wr, int wc, int fr, int fq) const {
        const int row0 = u.pm * BM + wr * 64 + fr, col0 = u.pn * BM + wc * 32 + 8 * fq;
#pragma unroll
        for (int ai = 0; ai < 2; ++ai)
#pragma unroll
            for (int m = 0; m < 4; ++m) { bf16_t* rowp = O + (size_t)(row0 + ai * HALF + m * 16) * ldc + col0;
#pragma unroll
                for (int bj = 0; bj < 2; ++bj) { const f32x4 v0 = acc[ai][bj][m][0], v1 = acc[ai][bj][m][1];
                    u32x4 w; w.x = cvt_pk_bf16(v0[0], v0[1]); w.y = cvt_pk_bf16(v0[2], v0[3]); w.z = cvt_pk_bf16(v1[0], v1[1]); w.w = cvt_pk_bf16(v1[2], v1[3]);
                    *(u32x4*)(rowp + bj * HALF) = w; } }
    }
};
}

#define NTHR 512
#define NWAVE 8

__device__ __forceinline__ void ph_gemm_f32(float* lds, const float* __restrict__ A, const float* __restrict__ B, float* __restrict__ C,
                                            int M, int N, int K, int lda, int ldb, int ldc) {
    const int tid = threadIdx.x & 255, half = threadIdx.x >> 8, tx = tid & 15, ty = tid >> 4;
    float (*As)[68] = (float (*)[68])(lds + half * 2 * 16 * 68);
    float (*Bs)[68] = (float (*)[68])(lds + half * 2 * 16 * 68 + 16 * 68);
    const int ntx = (N + 63) / 64, nty = M / 64, ntiles = ntx * nty;
    for (int it = blockIdx.x; 2 * it < ntiles; it += gridDim.x) {
        const int tile = 2 * it + half;
        const int m0 = (tile / ntx) * 64, n0 = (tile % ntx) * 64;
        float acc[4][4];
#pragma unroll
        for (int i = 0; i < 4; ++i)
#pragma unroll
            for (int j = 0; j < 4; ++j) acc[i][j] = 0.f;
        for (int k0 = 0; k0 < K; k0 += 16) {
#pragma unroll
            for (int i = 0; i < 4; ++i) {
                int idx = tid + i * 256;
                int r = idx >> 4, c = idx & 15;
                As[c][r] = (m0 + r < M) ? A[(size_t)(m0 + r) * lda + k0 + c] : 0.f;
                int rb = idx >> 6, cb = idx & 63;
                Bs[rb][cb] = (n0 + cb < N) ? B[(size_t)(k0 + rb) * ldb + n0 + cb] : 0.f;
            }
            __syncthreads();
#pragma unroll
            for (int k = 0; k < 16; ++k) {
                float a[4], b[4];
#pragma unroll
                for (int i = 0; i < 4; ++i) { a[i] = As[k][ty * 4 + i]; b[i] = Bs[k][tx * 4 + i]; }
#pragma unroll
                for (int i = 0; i < 4; ++i)
#pragma unroll
                    for (int j = 0; j < 4; ++j) acc[i][j] += a[i] * b[j];
            }
            __syncthreads();
        }
#pragma unroll
        for (int i = 0; i < 4; ++i)
#pragma unroll
            for (int j = 0; j < 4; ++j) {
                int r = m0 + ty * 4 + i, c = n0 + tx * 4 + j;
                if (r < M && c < N) C[(size_t)r * ldc + c] = acc[i][j];
            }
    }
}


template <int MODE>
__device__ __forceinline__ void transpose_item(const float* __restrict__ W, int K, int N, int Npad, bf16* __restrict__ WT, LAS float* scr, int item, int lane) {
    const int nblk = Npad / 32, kb = item / nblk, nb = item % nblk, k0 = 64 * kb, n0 = 32 * nb;
    const int n = n0 + (lane & 31);
    int sc = n;
    if (MODE == 1) sc = (n < 4096) ? n : (n < 5632 ? n + 24 : (n < 5656 ? n - 5632 + 4096 : -1));
    else sc = (n < N) ? n : -1;
#pragma unroll 8
    for (int i = 0; i < 32; ++i) { const int kk = 2 * i + (lane >> 5); scr[kk * 33 + (lane & 31)] = (sc >= 0) ? W[(size_t)(k0 + kk) * N + sc] : 0.f; }
    LDS_WAIT(); asm volatile("" ::: "memory");
    const int c = lane & 7;
#pragma unroll
    for (int j = 0; j < 4; ++j) { const int nn = (lane >> 3) + 8 * j; const LAS float* s = scr + (8 * c) * 33 + nn;
        v4u o; o.x = pk2(s[0 * 33], s[1 * 33]); o.y = pk2(s[2 * 33], s[3 * 33]); o.z = pk2(s[4 * 33], s[5 * 33]); o.w = pk2(s[6 * 33], s[7 * 33]);
        *(v4u*)(WT + (size_t)(n0 + nn) * K + k0 + 8 * c) = o; }
    LDS_WAIT(); asm volatile("" ::: "memory");
}
__device__ __forceinline__ void ph_prologue(LAS unsigned char* ldsb, const float* __restrict__ xp, const float* __restrict__ xs, bf16* __restrict__ A0,
                                            const float* __restrict__ w_in, bf16* __restrict__ wt_in, float* __restrict__ rope_tab) {
    const int lane = threadIdx.x & 63, wave = threadIdx.x >> 6;
    LAS float* scr = (LAS float*)(ldsb + wave * 16384);
    const int gw = blockIdx.x * NWAVE + wave, NGW = gridDim.x * NWAVE;
    constexpr int I_IN = (D_MODEL / 64) * (PROJ_LD / 32);
    for (int it = gw; it < I_IN; it += NGW) transpose_item<1>(w_in, D_MODEL, IN_WIDTH, PROJ_LD, wt_in, scr, it, lane);
    for (int idx = blockIdx.x * NTHR + threadIdx.x; idx < SEQ * 32; idx += gridDim.x * NTHR) {
        const int pos = idx >> 5, j = idx & 31;
        const double rev = (double)pos * ROPE_INV_REV[j];
        const float fr = (float)(rev - floor(rev));
        rope_tab[(size_t)pos * 64 + j] = __builtin_amdgcn_cosf(fr); rope_tab[(size_t)pos * 64 + 32 + j] = __builtin_amdgcn_sinf(fr);
    }
    const size_t n8 = (size_t)T_ALL * D_MODEL / 8, np8 = (size_t)T_PROMPT * D_MODEL / 8;
#pragma unroll 4
    for (size_t i = (size_t)blockIdx.x * NTHR + threadIdx.x; i < n8; i += (size_t)gridDim.x * NTHR) {
        const float4* s = (i < np8) ? (const float4*)xp + 2 * i : (const float4*)xs + 2 * (i - np8);
        float4 a = s[0], b = s[1];
        v4u o; o.x = pk2(a.x, a.y); o.y = pk2(a.z, a.w); o.z = pk2(b.x, b.y); o.w = pk2(b.z, b.w);
        ((v4u*)A0)[i] = o;
    }
}
__device__ __forceinline__ void ph_prologue2(LAS unsigned char* ldsb, const float* __restrict__ w_out, bf16* __restrict__ wt_out, const float* __restrict__ w_q, bf16* __restrict__ wt_q,
                                             int rank, int nranks) {
    const int lane = threadIdx.x & 63, wave = threadIdx.x >> 6;
    LAS float* scr = (LAS float*)(ldsb + wave * 16384);
    constexpr int I_OUT = (MIX_WIDTH / 64) * (D_MODEL / 32), I_Q = (D_MODEL / 64) * (2048 / 32);
    for (int it = rank * NWAVE + wave; it < I_OUT + I_Q; it += nranks * NWAVE) {
        if (it < I_OUT) transpose_item<0>(w_out, MIX_WIDTH, D_MODEL, D_MODEL, wt_out, scr, it, lane);
        else transpose_item<0>(w_q, D_MODEL, 2048, 2048, wt_q, scr, it - I_OUT, lane);
    }
}

__device__ __forceinline__ void ph_concat_x(const float* __restrict__ xp, const float* __restrict__ xs, float* __restrict__ xall) {
    const size_t n4 = (size_t)T_ALL * D_MODEL / 4, np4 = (size_t)T_PROMPT * D_MODEL / 4;
    for (size_t i = (size_t)blockIdx.x * NTHR + threadIdx.x; i < n4; i += (size_t)gridDim.x * NTHR) {
        float4 v = (i < np4) ? ((const float4*)xp)[i] : ((const float4*)xs)[i - np4];
        ((float4*)xall)[i] = v;
    }
}

typedef float f32x4n __attribute__((ext_vector_type(4)));
__device__ __forceinline__ void ph_cache_copy(const float* __restrict__ ck, const float* __restrict__ cv, float* __restrict__ out) {
    constexpr unsigned PER_B = (WBUF - DEC_SEQ) * ATT_WIDTH / 4;
    constexpr unsigned TOTAL = 2u * DEC_BATCH * PER_B;
    for (unsigned c = blockIdx.x; c < TOTAL / 4096u; c += gridDim.x) {
        f32x4n v[8]; size_t dsti[8]; bool isv[8];
#pragma unroll
        for (int j = 0; j < 8; ++j) {
            const unsigned idx = c * 4096u + j * 512u + threadIdx.x;
            const unsigned tb = idx / PER_B, r = idx - tb * PER_B, bb = tb & (DEC_BATCH - 1);
            isv[j] = tb >= DEC_BATCH;
            const size_t srci = (size_t)bb * (WBUF * ATT_WIDTH / 4) + (DEC_SEQ * ATT_WIDTH / 4) + r;
            dsti[j] = (size_t)bb * (WBUF * ATT_WIDTH / 4) + r;
            v[j] = __builtin_nontemporal_load((isv[j] ? (const f32x4n*)cv : (const f32x4n*)ck) + srci);
        }
#pragma unroll
        for (int j = 0; j < 8; ++j) __builtin_nontemporal_store(v[j], (f32x4n*)(out + (isv[j] ? OUT_SV : OUT_SK)) + dsti[j]);
    }
}

__device__ __forceinline__ void ph_post_proj(const float* __restrict__ proj, const float* __restrict__ state_conv,
                                             const float* __restrict__ conv_w, const float* __restrict__ conv_b, const float* __restrict__ dt_bias,
                                             float* __restrict__ xbc_act, float* __restrict__ dtv, float* __restrict__ qrot, float* __restrict__ krot,
                                             float* __restrict__ out) {
    const int tid = threadIdx.x & 255, half = threadIdx.x >> 8;
    for (int t = 2 * blockIdx.x + half; t < T_ALL; t += 2 * gridDim.x) {
        const bool is_p = t < T_PROMPT;
        int b, i, pos;
        if (is_p) { b = t / SEQ; i = t % SEQ; pos = i; } else { int ts = t - T_PROMPT; b = ts / DEC_SEQ; i = ts % DEC_SEQ; pos = PAST_LEN + i; }
        const float* row = proj + (size_t)t * PROJ_LD;
        for (int c = tid; c < CONV_DIM; c += 256) {
            float acc = conv_b[c];
#pragma unroll
            for (int tap = 0; tap < 4; ++tap) {
                int r = i - 3 + tap;
                float val;
                if (r >= 0) val = proj[(size_t)(t - i + r) * PROJ_LD + O_XBC + c];
                else val = is_p ? 0.f : state_conv[((size_t)b * 3 + (3 + r)) * CONV_DIM + c];
                acc += val * conv_w[tap * CONV_DIM + c];
            }
            xbc_act[(size_t)t * CONV_DIM + c] = silu_f(acc);
        }
        if (tid < SSD_HEADS) dtv[(size_t)t * SSD_HEADS + tid] = softplus_f(row[O_DT + tid] + dt_bias[tid]);
        for (int idx = tid; idx < 512; idx += 256) {
            int which = idx >> 8, h = (idx >> 5) & 7, j = idx & 31;
            double rev = (double)pos * ROPE_INV_REV[j];
            float fr = (float)(rev - floor(rev));
            float sn = __builtin_amdgcn_sinf(fr), cs = __builtin_amdgcn_cosf(fr);
            const float* src = row + (which ? O_K : O_Q) + h * 64;
            float t1 = src[j], t2 = src[j + 32];
            float o1 = t1 * cs - t2 * sn, o2 = t2 * cs + t1 * sn;
            float* dst = (which ? krot : qrot) + (size_t)t * ATT_WIDTH + h * 64;
            dst[j] = o1; dst[j + 32] = o2;
            if (which) {
                if (is_p) { if (i >= SEQ - WBUF) { float* o = out + OUT_PK + ((size_t)b * WBUF + (i - (SEQ - WBUF))) * ATT_WIDTH + h * 64; o[j] = o1; o[j + 32] = o2; } }
                else { float* o = out + OUT_SK + ((size_t)b * WBUF + (WBUF - DEC_SEQ + i)) * ATT_WIDTH + h * 64; o[j] = o1; o[j + 32] = o2; }
            }
        }
        for (int c = tid; c < ATT_WIDTH; c += 256) {
            float v = row[O_V + c];
            if (is_p) { if (i >= SEQ - WBUF) out[OUT_PV + ((size_t)b * WBUF + (i - (SEQ - WBUF))) * ATT_WIDTH + c] = v; }
            else out[OUT_SV + ((size_t)b * WBUF + (WBUF - DEC_SEQ + i)) * ATT_WIDTH + c] = v;
        }
        if (is_p) {
            if (i >= SEQ - 3) { int r = i - (SEQ - 3); for (int c = tid; c < CONV_DIM; c += 256) out[OUT_PC + ((size_t)b * 3 + r) * CONV_DIM + c] = row[O_XBC + c]; }
        } else {
            if (i >= 1) { int r = i - 1; for (int c = tid; c < CONV_DIM; c += 256) out[OUT_SC + ((size_t)b * 3 + r) * CONV_DIM + c] = row[O_XBC + c]; }
        }
    }
}


#define NB_LD 5632
#define NB_XBC 1536
#define NB_Q 4096
#define NB_K 4608
#define NB_V 5120
__device__ __forceinline__ void unpack8(const v4u w, float (&f)[8]) {
    f[0] = __builtin_bit_cast(float, w.x << 16); f[1] = __builtin_bit_cast(float, w.x & 0xffff0000u);
    f[2] = __builtin_bit_cast(float, w.y << 16); f[3] = __builtin_bit_cast(float, w.y & 0xffff0000u);
    f[4] = __builtin_bit_cast(float, w.z << 16); f[5] = __builtin_bit_cast(float, w.z & 0xffff0000u);
    f[6] = __builtin_bit_cast(float, w.w << 16); f[7] = __builtin_bit_cast(float, w.w & 0xffff0000u);
}
__device__ __forceinline__ void store8f(float* d, const float (&f)[8]) { *(float4*)d = make_float4(f[0], f[1], f[2], f[3]); *(float4*)(d + 4) = make_float4(f[4], f[5], f[6], f[7]); }
__device__ __forceinline__ void ph_post_proj2(const bf16* __restrict__ projb, const float* __restrict__ dtraw, const float* __restrict__ state_conv,
                                              const float* __restrict__ conv_w, const float* __restrict__ conv_b, const float* __restrict__ dt_bias,
                                              bf16* __restrict__ xbc_b, float* __restrict__ dtv, bf16* __restrict__ qrot_b, bf16* __restrict__ krot_b,
                                              float* __restrict__ out) {
    const int tid = threadIdx.x & 255, half = threadIdx.x >> 8;
    for (int t = T_PROMPT + 2 * blockIdx.x + half; t < T_ALL; t += 2 * gridDim.x) {
        const bool is_p = t < T_PROMPT;
        int b, i, pos;
        if (is_p) { b = t / SEQ; i = t % SEQ; pos = i; } else { int ts = t - T_PROMPT; b = ts / DEC_SEQ; i = ts % DEC_SEQ; pos = PAST_LEN + i; }
        const bf16* row = projb + (size_t)t * NB_LD;
        if (tid < 64) {
            float f[8]; unpack8(*(const v4u*)(row + NB_V + tid * 8), f);
            if (is_p) { if (i >= SEQ - WBUF) store8f(out + OUT_PV + ((size_t)b * WBUF + (i - (SEQ - WBUF))) * ATT_WIDTH + tid * 8, f); }
            else store8f(out + OUT_SV + ((size_t)b * WBUF + (WBUF - DEC_SEQ + i)) * ATT_WIDTH + tid * 8, f);
        }
        for (int c8 = tid; c8 < 320; c8 += 256) {
            const int c = c8 * 8;
            float acc[8], cur[8];
            { const float4 b0 = *(const float4*)(conv_b + c), b1 = *(const float4*)(conv_b + c + 4);
              acc[0] = b0.x; acc[1] = b0.y; acc[2] = b0.z; acc[3] = b0.w; acc[4] = b1.x; acc[5] = b1.y; acc[6] = b1.z; acc[7] = b1.w; }
#pragma unroll
            for (int tap = 0; tap < 4; ++tap) {
                const int r = i - 3 + tap;
                float val[8];
                if (r >= 0) unpack8(*(const v4u*)(projb + (size_t)(t - i + r) * NB_LD + NB_XBC + c), val);
                else if (!is_p) { const float* sp = state_conv + ((size_t)b * 3 + (3 + r)) * CONV_DIM + c; const float4 s0 = *(const float4*)sp, s1 = *(const float4*)(sp + 4);
                    val[0] = s0.x; val[1] = s0.y; val[2] = s0.z; val[3] = s0.w; val[4] = s1.x; val[5] = s1.y; val[6] = s1.z; val[7] = s1.w; }
                else {
#pragma unroll
                    for (int j = 0; j < 8; ++j) val[j] = 0.f; }
                const float4 w0 = *(const float4*)(conv_w + tap * CONV_DIM + c), w1 = *(const float4*)(conv_w + tap * CONV_DIM + c + 4);
                acc[0] += val[0] * w0.x; acc[1] += val[1] * w0.y; acc[2] += val[2] * w0.z; acc[3] += val[3] * w0.w;
                acc[4] += val[4] * w1.x; acc[5] += val[5] * w1.y; acc[6] += val[6] * w1.z; acc[7] += val[7] * w1.w;
                if (tap == 3) {
#pragma unroll
                    for (int j = 0; j < 8; ++j) cur[j] = val[j]; }
            }
#pragma unroll
            for (int j = 0; j < 8; ++j) acc[j] = silu_f(acc[j]);
            v4u o; o.x = pk2(acc[0], acc[1]); o.y = pk2(acc[2], acc[3]); o.z = pk2(acc[4], acc[5]); o.w = pk2(acc[6], acc[7]);
            *(v4u*)(xbc_b + (size_t)t * CONV_DIM + c) = o;
            if (is_p) { if (i >= SEQ - 3) store8f(out + OUT_PC + ((size_t)b * 3 + (i - (SEQ - 3))) * CONV_DIM + c, cur); }
            else { if (i >= 1) store8f(out + OUT_SC + ((size_t)b * 3 + (i - 1)) * CONV_DIM + c, cur); }
        }
        if (tid < SSD_HEADS) dtv[(size_t)t * SSD_HEADS + tid] = softplus_f(dtraw[(size_t)t * 32 + tid] + dt_bias[tid]);
        if (tid < 128) {
            const int which = tid >> 6, h = (tid >> 3) & 7, jc = tid & 7;
            const bf16* src = row + (which ? NB_K : NB_Q) + h * 64 + jc * 4;
            const uint2 lo = *(const uint2*)src, hi = *(const uint2*)(src + 32);
            float t1[4], t2[4], o1[4], o2[4];
            t1[0] = __builtin_bit_cast(float, lo.x << 16); t1[1] = __builtin_bit_cast(float, lo.x & 0xffff0000u); t1[2] = __builtin_bit_cast(float, lo.y << 16); t1[3] = __builtin_bit_cast(float, lo.y & 0xffff0000u);
            t2[0] = __builtin_bit_cast(float, hi.x << 16); t2[1] = __builtin_bit_cast(float, hi.x & 0xffff0000u); t2[2] = __builtin_bit_cast(float, hi.y << 16); t2[3] = __builtin_bit_cast(float, hi.y & 0xffff0000u);
#pragma unroll
            for (int e = 0; e < 4; ++e) {
                const double rev = (double)pos * ROPE_INV_REV[jc * 4 + e];
                const float fr = (float)(rev - floor(rev));
                const float sn = __builtin_amdgcn_sinf(fr), cs = __builtin_amdgcn_cosf(fr);
                o1[e] = t1[e] * cs - t2[e] * sn; o2[e] = t2[e] * cs + t1[e] * sn;
            }
            const size_t doff = (size_t)t * ATT_WIDTH + h * 64 + jc * 4;
            bf16* db = which ? krot_b : qrot_b;
            *(uint2*)(db + doff) = make_uint2(pk2(o1[0], o1[1]), pk2(o1[2], o1[3])); *(uint2*)(db + doff + 32) = make_uint2(pk2(o2[0], o2[1]), pk2(o2[2], o2[3]));
            if (which) {
                float* o = nullptr;
                if (is_p) { if (i >= SEQ - WBUF) o = out + OUT_PK + ((size_t)b * WBUF + (i - (SEQ - WBUF))) * ATT_WIDTH + h * 64 + jc * 4; }
                else o = out + OUT_SK + ((size_t)b * WBUF + (WBUF - DEC_SEQ + i)) * ATT_WIDTH + h * 64 + jc * 4;
                if (o) { *(float4*)o = make_float4(o1[0], o1[1], o1[2], o1[3]); *(float4*)(o + 32) = make_float4(o2[0], o2[1], o2[2], o2[3]); }
            }
        }
    }
}


__device__ __forceinline__ void ph_post_proj_prompt(const bf16* __restrict__ projb, const float* __restrict__ dtraw, const float* __restrict__ conv_w, const float* __restrict__ conv_b,
                                                    const float* __restrict__ dt_bias, const float* __restrict__ rope_tab, bf16* __restrict__ xbc_b, float* __restrict__ dtv,
                                                    bf16* __restrict__ qrot_b, bf16* __restrict__ krot_b, float* __restrict__ out) {
    const int gtid = blockIdx.x * NTHR + threadIdx.x, gsz = gridDim.x * NTHR;
    for (int item = gtid; item < (T_PROMPT / 16) * 320; item += gsz) {
        const int run = item / 320, c = (item - run * 320) * 8, t0 = run * 16, i0 = t0 & (SEQ - 1), b = t0 >> 13;
        float w[4][8], bias[8];
#pragma unroll
        for (int tap = 0; tap < 4; ++tap) { const float4 w0 = *(const float4*)(conv_w + tap * CONV_DIM + c), w1 = *(const float4*)(conv_w + tap * CONV_DIM + c + 4);
            w[tap][0] = w0.x; w[tap][1] = w0.y; w[tap][2] = w0.z; w[tap][3] = w0.w; w[tap][4] = w1.x; w[tap][5] = w1.y; w[tap][6] = w1.z; w[tap][7] = w1.w; }
        { const float4 b0 = *(const float4*)(conv_b + c), b1 = *(const float4*)(conv_b + c + 4);
          bias[0] = b0.x; bias[1] = b0.y; bias[2] = b0.z; bias[3] = b0.w; bias[4] = b1.x; bias[5] = b1.y; bias[6] = b1.z; bias[7] = b1.w; }
        const bf16* src = projb + (size_t)t0 * NB_LD + NB_XBC + c;
        v4u raw[19];
#pragma unroll
        for (int s = 0; s < 19; ++s) { v4u z; z.x = 0u; z.y = 0u; z.z = 0u; z.w = 0u; raw[s] = (s >= 3 || i0 != 0) ? *(const v4u*)(src + (ptrdiff_t)(s - 3) * NB_LD) : z; }
        float p0[8], p1[8], p2[8];
        unpack8(raw[0], p0); unpack8(raw[1], p1); unpack8(raw[2], p2);
#pragma unroll
        for (int s = 0; s < 16; ++s) {
            float cur[8], acc[8]; unpack8(raw[s + 3], cur);
#pragma unroll
            for (int j = 0; j < 8; ++j) acc[j] = silu_f(bias[j] + p0[j] * w[0][j] + p1[j] * w[1][j] + p2[j] * w[2][j] + cur[j] * w[3][j]);
            v4u o; o.x = pk2(acc[0], acc[1]); o.y = pk2(acc[2], acc[3]); o.z = pk2(acc[4], acc[5]); o.w = pk2(acc[6], acc[7]);
            *(v4u*)(xbc_b + (size_t)(t0 + s) * CONV_DIM + c) = o;
            if (i0 + s >= SEQ - 3) store8f(out + OUT_PC + ((size_t)b * 3 + (i0 + s - (SEQ - 3))) * CONV_DIM + c, cur);
#pragma unroll
            for (int j = 0; j < 8; ++j) { p0[j] = p1[j]; p1[j] = p2[j]; p2[j] = cur[j]; }
        }
    }
    for (int item = gtid; item < T_PROMPT * 128; item += gsz) {
        const int t = item >> 7, sub = item & 127, which = sub >> 6, h = (sub >> 3) & 7, jc = sub & 7, i = t & (SEQ - 1), b = t >> 13;
        const bf16* src = projb + (size_t)t * NB_LD + (which ? NB_K : NB_Q) + h * 64 + jc * 4;
        const uint2 lo = *(const uint2*)src, hi = *(const uint2*)(src + 32);
        const float4 cs = *(const float4*)(rope_tab + (size_t)i * 64 + jc * 4), sn = *(const float4*)(rope_tab + (size_t)i * 64 + 32 + jc * 4);
        float t1[4], t2[4], o1[4], o2[4];
        t1[0] = __builtin_bit_cast(float, lo.x << 16); t1[1] = __builtin_bit_cast(float, lo.x & 0xffff0000u); t1[2] = __builtin_bit_cast(float, lo.y << 16); t1[3] = __builtin_bit_cast(float, lo.y & 0xffff0000u);
        t2[0] = __builtin_bit_cast(float, hi.x << 16); t2[1] = __builtin_bit_cast(float, hi.x & 0xffff0000u); t2[2] = __builtin_bit_cast(float, hi.y << 16); t2[3] = __builtin_bit_cast(float, hi.y & 0xffff0000u);
        const float cv[4] = {cs.x, cs.y, cs.z, cs.w}, sv[4] = {sn.x, sn.y, sn.z, sn.w};
#pragma unroll
        for (int e = 0; e < 4; ++e) { o1[e] = t1[e] * cv[e] - t2[e] * sv[e]; o2[e] = t2[e] * cv[e] + t1[e] * sv[e]; }
        const size_t doff = (size_t)t * ATT_WIDTH + h * 64 + jc * 4;
        bf16* db = which ? krot_b : qrot_b;
        *(uint2*)(db + doff) = make_uint2(pk2(o1[0], o1[1]), pk2(o1[2], o1[3])); *(uint2*)(db + doff + 32) = make_uint2(pk2(o2[0], o2[1]), pk2(o2[2], o2[3]));
        if (which && i >= SEQ - WBUF) {
            float* o = out + OUT_PK + ((size_t)b * WBUF + (i - (SEQ - WBUF))) * ATT_WIDTH + h * 64 + jc * 4;
            *(float4*)o = make_float4(o1[0], o1[1], o1[2], o1[3]); *(float4*)(o + 32) = make_float4(o2[0], o2[1], o2[2], o2[3]);
        }
    }
    for (int item = gtid; item < T_PROMPT * SSD_HEADS; item += gsz) { const int t = item / SSD_HEADS, hd = item - t * SSD_HEADS; dtv[item] = softplus_f(dtraw[(size_t)t * 32 + hd] + dt_bias[hd]); }
    for (int item = gtid; item < BATCH * WBUF * 64; item += gsz) {
        const int ch = item & 63, j = (item >> 6) & (WBUF - 1), b = item >> 17;
        float f[8]; unpack8(*(const v4u*)(projb + (size_t)(b * SEQ + (SEQ - WBUF) + j) * NB_LD + NB_V + ch * 8), f);
        store8f(out + OUT_PV + ((size_t)b * WBUF + j) * ATT_WIDTH + ch * 8, f);
    }
}

#define SSD_CH 32
__device__ __forceinline__ void ph_ssd_naive(float* lds, const bf16* __restrict__ xbc_act, const float* __restrict__ dtv, const float* __restrict__ a_log,
                                             const float* __restrict__ d_skip, const float* __restrict__ state_ssm, float* __restrict__ ybuf, float* __restrict__ out) {
    float (*sx)[64] = (float (*)[64])lds;
    float (*sB)[128] = (float (*)[128])(lds + SSD_CH * 64);
    float (*sC)[128] = (float (*)[128])(lds + SSD_CH * 64 + SSD_CH * 128);
    float* sdt = lds + SSD_CH * 64 + 2 * SSD_CH * 128;
    const int tid = threadIdx.x, p = tid >> 3, ng = tid & 7;
    for (int vb = BATCH * SSD_HEADS + blockIdx.x; vb < (BATCH + DEC_BATCH) * SSD_HEADS; vb += gridDim.x) {
        const int seq = vb / SSD_HEADS, h = vb % SSD_HEADS, g = h / 6;
        const bool is_p = seq < BATCH;
        const int L = is_p ? SEQ : DEC_SEQ;
        const int t0 = is_p ? seq * SEQ : T_PROMPT + (seq - BATCH) * DEC_SEQ;
        const float A = -__expf(a_log[h]);
        const float D = d_skip[h];
        float hs[16];
        if (is_p) {
#pragma unroll
            for (int j = 0; j < 16; ++j) hs[j] = 0.f;
        } else {
            const float* s0 = state_ssm + (((size_t)(seq - BATCH) * SSD_HEADS + h) * 64 + p) * 128 + ng * 16;
#pragma unroll
            for (int j = 0; j < 16; ++j) hs[j] = s0[j];
        }
        for (int c0 = 0; c0 < L; c0 += SSD_CH) {
            const int nst = (L - c0) < SSD_CH ? (L - c0) : SSD_CH;
            __syncthreads();
            for (int idx = tid; idx < nst * 64; idx += NTHR) { int s = idx >> 6, c = idx & 63; sx[s][c] = bf2f(xbc_act[(size_t)(t0 + c0 + s) * CONV_DIM + h * 64 + c]); }
            for (int idx = tid; idx < nst * 128; idx += NTHR) { int s = idx >> 7, c = idx & 127;
                sB[s][c] = bf2f(xbc_act[(size_t)(t0 + c0 + s) * CONV_DIM + 1536 + g * 128 + c]);
                sC[s][c] = bf2f(xbc_act[(size_t)(t0 + c0 + s) * CONV_DIM + 2048 + g * 128 + c]); }
            if (tid < nst) sdt[tid] = dtv[(size_t)(t0 + c0 + tid) * SSD_HEADS + h];
            __syncthreads();
            for (int s = 0; s < nst; ++s) {
                const float dt = sdt[s], x = sx[s][p];
                const float a = __expf(dt * A), xdt = x * dt;
                float y = 0.f;
#pragma unroll
                for (int j = 0; j < 16; ++j) { hs[j] = a * hs[j] + xdt * sB[s][ng * 16 + j]; y += sC[s][ng * 16 + j] * hs[j]; }
                y += __shfl_xor(y, 1); y += __shfl_xor(y, 2); y += __shfl_xor(y, 4);
                if (ng == 0) ybuf[(size_t)(t0 + c0 + s) * MIX_WIDTH + h * 64 + p] = y + D * x;
            }
        }
        float* so = is_p ? out + OUT_PS + (((size_t)seq * SSD_HEADS + h) * 64 + p) * 128 + ng * 16
                         : out + OUT_SS + (((size_t)(seq - BATCH) * SSD_HEADS + h) * 64 + p) * 128 + ng * 16;
#pragma unroll
        for (int j = 0; j < 16; ++j) so[j] = hs[j];
    }
}

__device__ __forceinline__ void ph_gate_norm(const bf16* __restrict__ projb, const float* __restrict__ norm_g, const float* __restrict__ ybuf, bf16* __restrict__ A1) {
    const int w = threadIdx.x >> 6, lane = threadIdx.x & 63, g = w & 3;
    for (int t = T_PROMPT + 2 * blockIdx.x + (w >> 2); t < T_ALL; t += 2 * gridDim.x) {
        float v[6]; float ss = 0.f;
#pragma unroll
        for (int j = 0; j < 6; ++j) {
            int c = g * 384 + j * 64 + lane;
            float y = ybuf[(size_t)t * MIX_WIDTH + c], z = bf2f(projb[(size_t)t * NB_LD + c]);
            v[j] = y * silu_f(z); ss += v[j] * v[j];
        }
        ss = wave_sum(ss);
        const float r = rsqrtf(ss * (1.0f / 384.0f) + LN_EPS);
#pragma unroll
        for (int j = 0; j < 6; ++j) { int c = g * 384 + j * 64 + lane; A1[(size_t)t * MIX_WIDTH + c] = (bf16)f2bf(v[j] * r * norm_g[c]); }
    }
}

__device__ __forceinline__ void ph_attn_naive(float* lds, const float* __restrict__ proj, const float* __restrict__ qrot, const float* __restrict__ krot,
                                              const float* __restrict__ ck, const float* __restrict__ cv, float* __restrict__ ybuf) {
    float (*sq)[64] = (float (*)[64])lds;
    const int w = threadIdx.x >> 6, lane = threadIdx.x & 63;
    for (int vb = blockIdx.x; vb < T_SAMPLE * 8 / NWAVE; vb += gridDim.x) {
        const int item = T_PROMPT * 8 + vb * NWAVE + w;
        const int t = item >> 3, h = item & 7;
        const bool is_p = t < T_PROMPT;
        int b, i;
        if (is_p) { b = t / SEQ; i = t % SEQ; } else { int ts = t - T_PROMPT; b = ts / DEC_SEQ; i = ts % DEC_SEQ; }
        __syncthreads();
        sq[w][lane] = qrot[(size_t)t * ATT_WIDTH + h * 64 + lane];
        __syncthreads();
        const int qi = is_p ? i : WBUF + i;
        float sc[3][3];
        float mx = -INFINITY;
#pragma unroll
        for (int pt = 0; pt < 3; ++pt) {
            const int d = pt == 0 ? 1 : (pt == 1 ? 4 : 16);
#pragma unroll
            for (int sl = 0; sl < 3; ++sl) {
                const int m = lane + sl * 64;
                float s = -INFINITY;
                const int kj = qi - d * m;
                if (m <= 128 && kj >= 0) {
                    const float* kr;
                    if (is_p) kr = krot + (size_t)(b * SEQ + kj) * ATT_WIDTH + h * 64;
                    else kr = (kj >= WBUF) ? krot + (size_t)(T_PROMPT + b * DEC_SEQ + (kj - WBUF)) * ATT_WIDTH + h * 64
                                           : ck + ((size_t)b * WBUF + kj) * ATT_WIDTH + h * 64;
                    float a = 0.f;
#pragma unroll
                    for (int c = 0; c < 64; c += 4) { float4 kv = *(const float4*)(kr + c); a += kv.x * sq[w][c] + kv.y * sq[w][c + 1] + kv.z * sq[w][c + 2] + kv.w * sq[w][c + 3]; }
                    s = a * 0.125f;
                }
                sc[pt][sl] = s; mx = fmaxf(mx, s);
            }
        }
        mx = wave_max(mx);
        float lsum = 0.f;
#pragma unroll
        for (int pt = 0; pt < 3; ++pt)
#pragma unroll
            for (int sl = 0; sl < 3; ++sl) { float pv = (sc[pt][sl] == -INFINITY) ? 0.f : __expf(sc[pt][sl] - mx); sc[pt][sl] = pv; lsum += pv; }
        lsum = wave_sum(lsum);
        float o = 0.f;
#pragma unroll
        for (int pt = 0; pt < 3; ++pt) {
            const int d = pt == 0 ? 1 : (pt == 1 ? 4 : 16);
#pragma unroll
            for (int sl = 0; sl < 3; ++sl) {
                const int mend = sl < 2 ? 64 : 1;
                for (int ml = 0; ml < mend; ++ml) {
                    const int m = ml + sl * 64;
                    const int kj = qi - d * m;
                    const float pv = __shfl(sc[pt][sl], ml);
                    if (kj < 0) continue;
                    const float* vr;
                    if (is_p) vr = proj + (size_t)(b * SEQ + kj) * PROJ_LD + O_V + h * 64;
                    else vr = (kj >= WBUF) ? proj + (size_t)(T_PROMPT + b * DEC_SEQ + (kj - WBUF)) * PROJ_LD + O_V + h * 64
                                           : cv + ((size_t)b * WBUF + kj) * ATT_WIDTH + h * 64;
                    o += pv * vr[lane];
                }
            }
        }
        ybuf[(size_t)t * MIX_WIDTH + SSD_WIDTH + h * 64 + lane] = o / lsum;
    }
}

__device__ __forceinline__ void ph_ln_res(const float* __restrict__ xp, const float* __restrict__ xs, const float* __restrict__ add, const float* __restrict__ gam,
                                          const float* __restrict__ bet, float* __restrict__ dst, bf16* __restrict__ dstb) {
    const int lane = threadIdx.x & 63;
    for (int t = blockIdx.x * NWAVE + (threadIdx.x >> 6); t < T_ALL; t += gridDim.x * NWAVE) {
        const float* res = (t < T_PROMPT) ? xp + (size_t)t * D_MODEL : xs + (size_t)(t - T_PROMPT) * D_MODEL;
        float v[16]; float s = 0.f;
#pragma unroll
        for (int j = 0; j < 4; ++j) { const int c = j * 256 + lane * 4; const float4 r4 = *(const float4*)(res + c), a4 = *(const float4*)(add + (size_t)t * D_MODEL + c);
            v[4 * j] = ALPHA_F * r4.x + a4.x; v[4 * j + 1] = ALPHA_F * r4.y + a4.y; v[4 * j + 2] = ALPHA_F * r4.z + a4.z; v[4 * j + 3] = ALPHA_F * r4.w + a4.w;
            s += (v[4 * j] + v[4 * j + 1]) + (v[4 * j + 2] + v[4 * j + 3]); }
        s = wave_sum(s);
        const float mu = s * (1.0f / 1024.0f);
        float q = 0.f;
#pragma unroll
        for (int j = 0; j < 16; ++j) { v[j] -= mu; q += v[j] * v[j]; }
        q = wave_sum(q);
        const float r = rsqrtf(q * (1.0f / 1024.0f) + LN_EPS);
#pragma unroll
        for (int j = 0; j < 4; ++j) { const int c = j * 256 + lane * 4; const float4 g4 = *(const float4*)(gam + c), b4 = *(const float4*)(bet + c);
            const float o0 = v[4 * j] * r * g4.x + b4.x, o1 = v[4 * j + 1] * r * g4.y + b4.y, o2 = v[4 * j + 2] * r * g4.z + b4.z, o3 = v[4 * j + 3] * r * g4.w + b4.w;
            *(float4*)(dst + (size_t)t * D_MODEL + c) = make_float4(o0, o1, o2, o3);
            *(uint2*)(dstb + (size_t)t * D_MODEL + c) = make_uint2(pk2(o0, o1), pk2(o2, o3)); }
    }
}

__device__ __forceinline__ void ph_peer_route(float* lds, const float* __restrict__ qh, const float* __restrict__ keys1, const float* __restrict__ keys2,
                                              int* __restrict__ eidx, float* __restrict__ gate) {
    float (*sq)[256] = (float (*)[256])lds;
    float (*sv)[2][16] = (float (*)[2][16])(lds + NWAVE * 256);
    int (*si)[2][16] = (int (*)[2][16])(lds + NWAVE * 256 + NWAVE * 32);
    const int w = threadIdx.x >> 6, lane = threadIdx.x & 63;
    for (int vb = blockIdx.x; vb < T_ALL * 8 / NWAVE; vb += gridDim.x) {
        const int item = vb * NWAVE + w;
        const int t = item >> 3, h = item & 7;
        __syncthreads();
        for (int c = lane; c < 256; c += 64) sq[w][c] = qh[(size_t)t * 2048 + h * 256 + c];
        __syncthreads();
#pragma unroll
        for (int half = 0; half < 2; ++half) {
            const float* keys = half ? keys2 : keys1;
            float s[2];
#pragma unroll
            for (int sl = 0; sl < 2; ++sl) {
                const float* kr = keys + (size_t)(lane + sl * 64) * 128;
                float a = 0.f;
#pragma unroll 8
                for (int c = 0; c < 128; c += 4) { float4 kv = *(const float4*)(kr + c); const float* qq = &sq[w][half * 128 + c]; a += kv.x * qq[0] + kv.y * qq[1] + kv.z * qq[2] + kv.w * qq[3]; }
                s[sl] = a;
            }
            for (int r = 0; r < 16; ++r) {
                float bv; int bi;
                if (s[0] >= s[1]) { bv = s[0]; bi = lane; } else { bv = s[1]; bi = lane + 64; }
#pragma unroll
                for (int o = 32; o > 0; o >>= 1) {
                    float ov = __shfl_xor(bv, o); int oi = __shfl_xor(bi, o);
                    if (ov > bv || (ov == bv && oi < bi)) { bv = ov; bi = oi; }
                }
                if (lane == 0) { sv[w][half][r] = bv; si[w][half][r] = bi; }
                if (bi == lane) s[0] = -INFINITY;
                if (bi == lane + 64) s[1] = -INFINITY;
            }
        }
        __syncthreads();
        float c[4];
#pragma unroll
        for (int j = 0; j < 4; ++j) { int ci = lane * 4 + j; c[j] = sv[w][0][ci >> 4] + sv[w][1][ci & 15]; }
        float myv = 0.f; int myc = 0;
        for (int r = 0; r < 16; ++r) {
            float bv = c[0]; int bi = lane * 4;
#pragma unroll
            for (int j = 1; j < 4; ++j) if (c[j] > bv) { bv = c[j]; bi = lane * 4 + j; }
#pragma unroll
            for (int o = 32; o > 0; o >>= 1) {
                float ov = __shfl_xor(bv, o); int oi = __shfl_xor(bi, o);
                if (ov > bv || (ov == bv && oi < bi)) { bv = ov; bi = oi; }
            }
            if (lane == r) { myv = bv; myc = bi; }
#pragma unroll
            for (int j = 0; j < 4; ++j) if (bi == lane * 4 + j) c[j] = -INFINITY;
        }
        float v = lane < 16 ? myv : -INFINITY;
        float mx = wave_max(v);
        float e = lane < 16 ? __expf(v - mx) : 0.f;
        float sum = wave_sum(e);
        if (lane < 16) {
            int ex = si[w][0][myc >> 4] * PEER_NKEYS + si[w][1][myc & 15];
            eidx[(size_t)t * 128 + h * 16 + lane] = ex;
            gate[(size_t)t * 128 + h * 16 + lane] = e / sum;
        }
    }
}

__device__ __forceinline__ void ph_peer_ffn(const float* __restrict__ hbuf, const int* __restrict__ eidx, const float* __restrict__ gate,
                                            const bf16* __restrict__ ub, const bf16* __restrict__ vb, const float* __restrict__ gam,
                                            const float* __restrict__ bet, float* __restrict__ out) {
    const int lane = threadIdx.x & 63;
    for (int t = blockIdx.x * NWAVE + (threadIdx.x >> 6); t < T_ALL; t += gridDim.x * NWAVE) {
        float x[16], acc[16];
        { const float* xr = hbuf + (size_t)t * D_MODEL + lane * 8;
          const float4 a = *(const float4*)xr, b = *(const float4*)(xr + 4), c = *(const float4*)(xr + 512), d = *(const float4*)(xr + 516);
          x[0] = a.x; x[1] = a.y; x[2] = a.z; x[3] = a.w; x[4] = b.x; x[5] = b.y; x[6] = b.z; x[7] = b.w;
          x[8] = c.x; x[9] = c.y; x[10] = c.z; x[11] = c.w; x[12] = d.x; x[13] = d.y; x[14] = d.z; x[15] = d.w; }
#pragma unroll
        for (int j = 0; j < 16; ++j) acc[j] = 0.f;
        for (int k = 0; k < 128; ++k) {
            const int e = eidx[(size_t)t * 128 + k];
            const float g = gate[(size_t)t * 128 + k];
            const bf16* ur = ub + (size_t)e * D_MODEL + lane * 8;
            float u0[8], u1[8];
            unpack8(*(const v4u*)ur, u0); unpack8(*(const v4u*)(ur + 512), u1);
            float d = 0.f;
#pragma unroll
            for (int j = 0; j < 8; ++j) d += u0[j] * x[j] + u1[j] * x[8 + j];
            d = wave_sum(d);
            const float wgt = g * gelu_f(d);
            const bf16* vr = vb + (size_t)e * D_MODEL + lane * 8;
            unpack8(*(const v4u*)vr, u0); unpack8(*(const v4u*)(vr + 512), u1);
#pragma unroll
            for (int j = 0; j < 8; ++j) { acc[j] += wgt * u0[j]; acc[8 + j] += wgt * u1[j]; }
        }
        float s = 0.f;
#pragma unroll
        for (int j = 0; j < 16; ++j) { acc[j] += ALPHA_F * x[j]; s += acc[j]; }
        s = wave_sum(s);
        const float mu = s * (1.0f / 1024.0f);
        float q = 0.f;
#pragma unroll
        for (int j = 0; j < 16; ++j) { acc[j] -= mu; q += acc[j] * acc[j]; }
        q = wave_sum(q);
        const float r = rsqrtf(q * (1.0f / 1024.0f) + LN_EPS);
        float* dst = ((t < T_PROMPT) ? out + OUT_YP + (size_t)t * D_MODEL : out + OUT_YS + (size_t)(t - T_PROMPT) * D_MODEL) + lane * 8;
#pragma unroll
        for (int q4 = 0; q4 < 4; ++q4) {
            const int eo = (q4 >> 1) * 512 + (q4 & 1) * 4;
            const float4 g4 = *(const float4*)(gam + lane * 8 + eo), b4 = *(const float4*)(bet + lane * 8 + eo);
            float4 o; o.x = acc[q4 * 4 + 0] * r * g4.x + b4.x; o.y = acc[q4 * 4 + 1] * r * g4.y + b4.y; o.z = acc[q4 * 4 + 2] * r * g4.z + b4.z; o.w = acc[q4 * 4 + 3] * r * g4.w + b4.w;
            *(float4*)(dst + eo) = o;
        }
    }
}

__device__ __forceinline__ float peer_dot16(const v4u a, const v4u b, const float (&x)[16]) {
    float u0[8], u1[8]; unpack8(a, u0); unpack8(b, u1);
    float d = 0.f;
#pragma unroll
    for (int j = 0; j < 8; ++j) d += u0[j] * x[j] + u1[j] * x[8 + j];
    return d;
}
#define PEER_TR_STEP(N, M) _Pragma("unroll") for (int i = 0; i < N; ++i) { const bool up = (lane & M) != 0; const float keep = up ? part[i + N] : part[i]; const float send = up ? part[i] : part[i + N]; part[i] = keep + __shfl_xor(send, M); }
__device__ __forceinline__ void ph_peer_ffn2(const float* __restrict__ hbuf, const int* __restrict__ eidx, const float* __restrict__ gate,
                                             const bf16* __restrict__ ub, const bf16* __restrict__ vb, const float* __restrict__ gam,
                                             const float* __restrict__ bet, float* __restrict__ out) {
    const int lane0 = threadIdx.x & 63;
    for (int t = blockIdx.x * NWAVE + (threadIdx.x >> 6); t < T_ALL; t += gridDim.x * NWAVE) {
        int lane = lane0; asm volatile("" : "+v"(lane));
        float x[16];
        { const float* xr = hbuf + (size_t)t * D_MODEL + lane * 8;
          const float4 a = *(const float4*)xr, b = *(const float4*)(xr + 4), c = *(const float4*)(xr + 512), d = *(const float4*)(xr + 516);
          x[0] = a.x; x[1] = a.y; x[2] = a.z; x[3] = a.w; x[4] = b.x; x[5] = b.y; x[6] = b.z; x[7] = b.w;
          x[8] = c.x; x[9] = c.y; x[10] = c.z; x[11] = c.w; x[12] = d.x; x[13] = d.y; x[14] = d.z; x[15] = d.w; }
        int ev[2]; float wv[4];
        ev[0] = eidx[(size_t)t * 128 + lane]; ev[1] = eidx[(size_t)t * 128 + 64 + lane];
#pragma unroll
        for (int rd = 0; rd < 4; ++rd) wv[rd] = gate[(size_t)t * 128 + rd * 32 + (lane >> 1)];
#pragma unroll
        for (int rd = 0; rd < 4; ++rd) {
            float part[32];
#pragma unroll
            for (int kb = 0; kb < 8; ++kb) {
                v4u ra[4], rb[4];
#pragma unroll
                for (int k8 = 0; k8 < 4; ++k8) {
                    const int e = __builtin_amdgcn_readlane(ev[rd >> 1], (rd & 1) * 32 + kb * 4 + k8);
                    const bf16* ur = ub + (size_t)e * D_MODEL + lane * 8;
                    ra[k8] = *(const v4u*)ur; rb[k8] = *(const v4u*)(ur + 512);
                }
#pragma unroll
                for (int k8 = 0; k8 < 4; ++k8) part[kb * 4 + k8] = peer_dot16(ra[k8], rb[k8], x);
            }
            PEER_TR_STEP(16, 32) PEER_TR_STEP(8, 16) PEER_TR_STEP(4, 8) PEER_TR_STEP(2, 4) PEER_TR_STEP(1, 2)
            const float hid = part[0] + __shfl_xor(part[0], 1);
            wv[rd] *= gelu_f(hid);
        }
        float acc[16];
#pragma unroll
        for (int j = 0; j < 16; ++j) acc[j] = 0.f;
#pragma unroll
        for (int rd = 0; rd < 4; ++rd) {
#pragma unroll
            for (int kb = 0; kb < 4; ++kb) {
                v4u ra[8], rb[8];
#pragma unroll
                for (int k8 = 0; k8 < 8; ++k8) {
                    const int e = __builtin_amdgcn_readlane(ev[rd >> 1], (rd & 1) * 32 + kb * 8 + k8);
                    const bf16* vr = vb + (size_t)e * D_MODEL + lane * 8;
                    ra[k8] = *(const v4u*)vr; rb[k8] = *(const v4u*)(vr + 512);
                }
#pragma unroll
                for (int k8 = 0; k8 < 8; ++k8) {
                    const float wk = __builtin_bit_cast(float, __builtin_amdgcn_readlane(__builtin_bit_cast(int, wv[rd]), 2 * (kb * 8 + k8)));
                    float u0[8], u1[8]; unpack8(ra[k8], u0); unpack8(rb[k8], u1);
#pragma unroll
                    for (int j = 0; j < 8; ++j) { acc[j] += wk * u0[j]; acc[8 + j] += wk * u1[j]; }
                }
            }
        }
        float s = 0.f;
#pragma unroll
        for (int j = 0; j < 16; ++j) { acc[j] += ALPHA_F * x[j]; s += acc[j]; }
        s = wave_sum(s);
        const float mu = s * (1.0f / 1024.0f);
        float q = 0.f;
#pragma unroll
        for (int j = 0; j < 16; ++j) { acc[j] -= mu; q += acc[j] * acc[j]; }
        q = wave_sum(q);
        const float r = rsqrtf(q * (1.0f / 1024.0f) + LN_EPS);
        float* dst = ((t < T_PROMPT) ? out + OUT_YP + (size_t)t * D_MODEL : out + OUT_YS + (size_t)(t - T_PROMPT) * D_MODEL) + lane * 8;
#pragma unroll
        for (int q4 = 0; q4 < 4; ++q4) {
            const int eo = (q4 >> 1) * 512 + (q4 & 1) * 4;
            const float4 g4 = *(const float4*)(gam + lane * 8 + eo), b4 = *(const float4*)(bet + lane * 8 + eo);
            float4 o; o.x = acc[q4 * 4 + 0] * r * g4.x + b4.x; o.y = acc[q4 * 4 + 1] * r * g4.y + b4.y; o.z = acc[q4 * 4 + 2] * r * g4.z + b4.z; o.w = acc[q4 * 4 + 3] * r * g4.w + b4.w;
            *(float4*)(dst + eo) = o;
        }
    }
}

__device__ __forceinline__ void ph_attn_sample(float* lds, const bf16* __restrict__ qrot_b, const bf16* __restrict__ krot_b, const bf16* __restrict__ projb,
                                               const float* __restrict__ ck, const float* __restrict__ cv, bf16* __restrict__ A1) {
    float (*sq)[64] = (float (*)[64])lds;
    const int w = threadIdx.x >> 6, lane0 = threadIdx.x & 63;
    for (int vb = blockIdx.x; vb < T_SAMPLE * 8 / NWAVE; vb += gridDim.x) {
        int lane = lane0; asm volatile("" : "+v"(lane));
        const int item = vb * NWAVE + w, ts = item >> 3, hd = item & 7, b = ts >> 2, i = ts & 3, t = T_PROMPT + ts;
        __syncthreads();
        sq[w][lane] = bf2f(qrot_b[(size_t)t * ATT_WIDTH + hd * 64 + lane]);
        __syncthreads();
        const int qi = WBUF + i;
        float sc[8];
        float mx = -INFINITY;
#pragma unroll
        for (int slot = 0; slot < 7; ++slot) {
            const int pt = slot < 6 ? (slot >> 1) : (lane < 3 ? lane : 0);
            const int m = slot < 6 ? lane + 64 * (slot & 1) : 128;
            const int kj = qi - (m << (2 * pt));
            const bool valid = (slot < 6 || lane < 3) && kj < WBUF;
            const int kc = kj < WBUF ? kj : WBUF - 1;
            const float* kr = ck + ((size_t)b * WBUF + kc) * ATT_WIDTH + hd * 64;
            float a = 0.f;
#pragma unroll
            for (int c = 0; c < 64; c += 4) { const float4 kv = *(const float4*)(kr + c); a += kv.x * sq[w][c] + kv.y * sq[w][c + 1] + kv.z * sq[w][c + 2] + kv.w * sq[w][c + 3]; }
            const float s = valid ? a * 0.125f : -INFINITY;
            sc[slot] = s; mx = fmaxf(mx, s);
        }
        const int nt7 = lane <= i ? i - lane : i;
        const bool valid7 = lane < i + 3;
        {
            const bf16* kr = krot_b + (size_t)(T_PROMPT + b * DEC_SEQ + nt7) * ATT_WIDTH + hd * 64;
            float a = 0.f;
#pragma unroll
            for (int c = 0; c < 64; c += 8) { float f[8]; unpack8(*(const v4u*)(kr + c), f);
#pragma unroll
                for (int j = 0; j < 8; ++j) a += f[j] * sq[w][c + j]; }
            const float s = valid7 ? a * 0.125f : -INFINITY;
            sc[7] = s; mx = fmaxf(mx, s);
        }
        mx = wave_max(mx);
        float lsum = 0.f;
#pragma unroll
        for (int slot = 0; slot < 8; ++slot) { const float pv = __expf(sc[slot] - mx); sc[slot] = pv; lsum += pv; }
        lsum = wave_sum(lsum);
        float part[64];
#pragma unroll
        for (int c = 0; c < 64; ++c) part[c] = 0.f;
#pragma unroll
        for (int slot = 0; slot < 7; ++slot) {
            const int pt = slot < 6 ? (slot >> 1) : (lane < 3 ? lane : 0);
            const int m = slot < 6 ? lane + 64 * (slot & 1) : 128;
            const int kj = qi - (m << (2 * pt));
            const int kc = kj < WBUF ? kj : WBUF - 1;
            const float pv = sc[slot];
            const float* vr = cv + ((size_t)b * WBUF + kc) * ATT_WIDTH + hd * 64;
#pragma unroll
            for (int c = 0; c < 64; c += 4) { const float4 vv = *(const float4*)(vr + c); part[c] += pv * vv.x; part[c + 1] += pv * vv.y; part[c + 2] += pv * vv.z; part[c + 3] += pv * vv.w; }
        }
        {
            const float pv = sc[7];
            const bf16* vr = projb + (size_t)(T_PROMPT + b * DEC_SEQ + nt7) * NB_LD + NB_V + hd * 64;
#pragma unroll
            for (int c = 0; c < 64; c += 8) { float f[8]; unpack8(*(const v4u*)(vr + c), f);
#pragma unroll
                for (int j = 0; j < 8; ++j) part[c + j] += pv * f[j]; }
        }
        PEER_TR_STEP(32, 32) PEER_TR_STEP(16, 16) PEER_TR_STEP(8, 8) PEER_TR_STEP(4, 4) PEER_TR_STEP(2, 2) PEER_TR_STEP(1, 1)
        A1[(size_t)t * MIX_WIDTH + SSD_WIDTH + hd * 64 + lane] = (bf16)f2bf(part[0] / lsum);
    }
}


__device__ __forceinline__ void cache_copy_slice(const float* __restrict__ ck, const float* __restrict__ cv, float* __restrict__ out, unsigned slice, unsigned lane) {
    constexpr unsigned PER_B = (WBUF - DEC_SEQ) * ATT_WIDTH / 4;
    constexpr unsigned TOTAL = 2u * DEC_BATCH * PER_B;
#pragma unroll 1
    for (unsigned bt = 0; bt < 8; ++bt) {
        f32x4n v[8]; size_t dsti[8]; bool isv[8]; bool ok[8];
#pragma unroll
        for (int j = 0; j < 8; ++j) {
            const unsigned idx = slice * 4096u + bt * 512u + j * 64u + lane;
            ok[j] = idx < TOTAL;
            const unsigned idc = ok[j] ? idx : 0u;
            const unsigned tb = idc / PER_B, r = idc - tb * PER_B, bb = tb & (DEC_BATCH - 1);
            isv[j] = tb >= DEC_BATCH;
            const size_t srci = (size_t)bb * (WBUF * ATT_WIDTH / 4) + (DEC_SEQ * ATT_WIDTH / 4) + r;
            dsti[j] = (size_t)bb * (WBUF * ATT_WIDTH / 4) + r;
            v[j] = __builtin_nontemporal_load((isv[j] ? (const f32x4n*)cv : (const f32x4n*)ck) + srci);
        }
#pragma unroll
        for (int j = 0; j < 8; ++j) if (ok[j]) __builtin_nontemporal_store(v[j], (f32x4n*)(out + (isv[j] ? OUT_SV : OUT_SK)) + dsti[j]);
    }
}
typedef float f32x2v __attribute__((ext_vector_type(2)));
__device__ __forceinline__ void ph_quant_tables(const float* __restrict__ pu, const float* __restrict__ pv, unsigned char* __restrict__ ub8, unsigned char* __restrict__ vb8,
                                                float* __restrict__ usc, float* __restrict__ vsc, int rank, int nranks) {
    const int lane = threadIdx.x & 63;
#pragma unroll 2
    for (int row = rank * NWAVE + (threadIdx.x >> 6); row < 2 * 16384; row += nranks * NWAVE) {
        const int rr = row & 16383; const bool isv = row >= 16384;
        const float* src = (isv ? pv : pu) + (size_t)rr * D_MODEL + lane * 8;
        const float4 a = *(const float4*)src, b = *(const float4*)(src + 4), c = *(const float4*)(src + 512), d = *(const float4*)(src + 516);
        float am = fmaxf(fmaxf(fmaxf(fabsf(a.x), fabsf(a.y)), fmaxf(fabsf(a.z), fabsf(a.w))), fmaxf(fmaxf(fabsf(b.x), fabsf(b.y)), fmaxf(fabsf(b.z), fabsf(b.w))));
        am = fmaxf(am, fmaxf(fmaxf(fmaxf(fabsf(c.x), fabsf(c.y)), fmaxf(fabsf(c.z), fabsf(c.w))), fmaxf(fmaxf(fabsf(d.x), fabsf(d.y)), fmaxf(fabsf(d.z), fabsf(d.w)))));
        am = wave_max(am);
        const float sc = am > 0.f ? 224.0f / am : 1.0f;
        v4u o;
        o.x = (unsigned)__builtin_amdgcn_cvt_pk_fp8_f32(a.z * sc, a.w * sc, __builtin_amdgcn_cvt_pk_fp8_f32(a.x * sc, a.y * sc, 0, false), true);
        o.y = (unsigned)__builtin_amdgcn_cvt_pk_fp8_f32(b.z * sc, b.w * sc, __builtin_amdgcn_cvt_pk_fp8_f32(b.x * sc, b.y * sc, 0, false), true);
        o.z = (unsigned)__builtin_amdgcn_cvt_pk_fp8_f32(c.z * sc, c.w * sc, __builtin_amdgcn_cvt_pk_fp8_f32(c.x * sc, c.y * sc, 0, false), true);
        o.w = (unsigned)__builtin_amdgcn_cvt_pk_fp8_f32(d.z * sc, d.w * sc, __builtin_amdgcn_cvt_pk_fp8_f32(d.x * sc, d.y * sc, 0, false), true);
        *(v4u*)((isv ? vb8 : ub8) + (size_t)rr * 1024 + lane * 16) = o;
        if (lane == 0) (isv ? vsc : usc)[rr] = am > 0.f ? am * (1.0f / 224.0f) : 1.0f;
    }
}
__device__ __forceinline__ void unpack16_fp8(const v4u w, float (&f)[16]) {
#pragma unroll
    for (int i = 0; i < 4; ++i) {
        const f32x2v lo = __builtin_amdgcn_cvt_pk_f32_fp8((int)w[i], false), hi = __builtin_amdgcn_cvt_pk_f32_fp8((int)w[i], true);
        f[4 * i] = lo[0]; f[4 * i + 1] = lo[1]; f[4 * i + 2] = hi[0]; f[4 * i + 3] = hi[1];
    }
}
__device__ __forceinline__ void ph_peer_ffn3(const float* __restrict__ hbuf, const int* __restrict__ eidx, const float* __restrict__ gate,
                                             const unsigned char* __restrict__ ub8, const unsigned char* __restrict__ vb8, const float* __restrict__ usc, const float* __restrict__ vsc,
                                             const float* __restrict__ gam, const float* __restrict__ bet, float* __restrict__ out,
                                             const float* __restrict__ ck, const float* __restrict__ cv, unsigned n9) {
    const int lane0 = threadIdx.x & 63;
    unsigned it = 0;
    for (int t = blockIdx.x * NWAVE + (threadIdx.x >> 6); t < T_ALL; t += gridDim.x * NWAVE, ++it) {
        int lane = lane0; asm volatile("" : "+v"(lane));
        { const unsigned sl = (blockIdx.x * NWAVE + (threadIdx.x >> 6)) + it * (gridDim.x * NWAVE); if (it < 8 && sl < n9) cache_copy_slice(ck, cv, out, sl, (unsigned)lane); }
        const unsigned lo16 = (unsigned)lane * 16u, lo8 = (unsigned)lane * 8u;
        float x[16];
        { const float* xr = hbuf + (size_t)t * D_MODEL + lo8;
          const float4 a = *(const float4*)xr, b = *(const float4*)(xr + 4), c = *(const float4*)(xr + 512), d = *(const float4*)(xr + 516);
          x[0] = a.x; x[1] = a.y; x[2] = a.z; x[3] = a.w; x[4] = b.x; x[5] = b.y; x[6] = b.z; x[7] = b.w;
          x[8] = c.x; x[9] = c.y; x[10] = c.z; x[11] = c.w; x[12] = d.x; x[13] = d.y; x[14] = d.z; x[15] = d.w; }
        int ev[2]; float wv[4], su[4];
        ev[0] = eidx[(size_t)t * 128 + lane]; ev[1] = eidx[(size_t)t * 128 + 64 + lane];
#pragma unroll
        for (int rd = 0; rd < 4; ++rd) {
            const int er = eidx[(size_t)t * 128 + rd * 32 + (lane >> 1)];
            wv[rd] = gate[(size_t)t * 128 + rd * 32 + (lane >> 1)] * vsc[er];
            su[rd] = usc[er];
        }
#pragma unroll
        for (int rd = 0; rd < 4; ++rd) {
            float part[32];
#pragma unroll
            for (int kb = 0; kb < 8; ++kb) {
                v4u ra[4];
#pragma unroll
                for (int k8 = 0; k8 < 4; ++k8) {
                    const int e = __builtin_amdgcn_readlane(ev[rd >> 1], (rd & 1) * 32 + kb * 4 + k8);
                    ra[k8] = *(const v4u*)(ub8 + (size_t)e * 1024 + lo16);
                }
#pragma unroll
                for (int k8 = 0; k8 < 4; ++k8) {
                    float f[16]; unpack16_fp8(ra[k8], f);
                    float d = 0.f;
#pragma unroll
                    for (int j = 0; j < 16; ++j) d += f[j] * x[j];
                    part[kb * 4 + k8] = d;
                    if (k8 & 1) __builtin_amdgcn_sched_barrier(0);
                }
            }
            PEER_TR_STEP(16, 32) PEER_TR_STEP(8, 16) PEER_TR_STEP(4, 8) PEER_TR_STEP(2, 4) PEER_TR_STEP(1, 2)
            const float hid = (part[0] + __shfl_xor(part[0], 1)) * su[rd];
            wv[rd] *= gelu_f(hid);
        }
        float acc[16];
#pragma unroll
        for (int j = 0; j < 16; ++j) acc[j] = 0.f;
#pragma unroll
        for (int rd = 0; rd < 4; ++rd) {
#pragma unroll
            for (int kb = 0; kb < 4; ++kb) {
                v4u ra[8];
#pragma unroll
                for (int k8 = 0; k8 < 8; ++k8) {
                    const int e = __builtin_amdgcn_readlane(ev[rd >> 1], (rd & 1) * 32 + kb * 8 + k8);
                    ra[k8] = *(const v4u*)(vb8 + (size_t)e * 1024 + lo16);
                }
#pragma unroll
                for (int k8 = 0; k8 < 8; ++k8) {
                    const float wk = __builtin_bit_cast(float, __builtin_amdgcn_readlane(__builtin_bit_cast(int, wv[rd]), 2 * (kb * 8 + k8)));
                    float f[16]; unpack16_fp8(ra[k8], f);
#pragma unroll
                    for (int j = 0; j < 16; ++j) acc[j] += wk * f[j];
                    if (k8 & 1) __builtin_amdgcn_sched_barrier(0);
                }
            }
        }
        float s = 0.f;
#pragma unroll
        for (int j = 0; j < 16; ++j) { acc[j] += ALPHA_F * x[j]; s += acc[j]; }
        s = wave_sum(s);
        const float mu = s * (1.0f / 1024.0f);
        float q = 0.f;
#pragma unroll
        for (int j = 0; j < 16; ++j) { acc[j] -= mu; q += acc[j] * acc[j]; }
        q = wave_sum(q);
        const float r = rsqrtf(q * (1.0f / 1024.0f) + LN_EPS);
        float* dst = ((t < T_PROMPT) ? out + OUT_YP + (size_t)t * D_MODEL : out + OUT_YS + (size_t)(t - T_PROMPT) * D_MODEL) + lo8;
#pragma unroll
        for (int q4 = 0; q4 < 4; ++q4) {
            const int eo = (q4 >> 1) * 512 + (q4 & 1) * 4;
            const float4 g4 = *(const float4*)(gam + lo8 + eo), b4 = *(const float4*)(bet + lo8 + eo);
            float4 o; o.x = acc[q4 * 4 + 0] * r * g4.x + b4.x; o.y = acc[q4 * 4 + 1] * r * g4.y + b4.y; o.z = acc[q4 * 4 + 2] * r * g4.z + b4.z; o.w = acc[q4 * 4 + 3] * r * g4.w + b4.w;
            *(float4*)(dst + eo) = o;
        }
    }
}


__device__ __forceinline__ void ssd_decode_load(const bf16* __restrict__ xbc_b, const float* __restrict__ dtv, const float* __restrict__ state_ssm, int item, int p, int ng,
                                                float (&hs)[16], v4u (&bq)[4][2], v4u (&cq)[4][2], float (&xv)[4], float (&dv)[4]) {
    const int sb = item / SSD_HEADS, h = item - sb * SSD_HEADS, g = h / 6, t0 = T_PROMPT + sb * DEC_SEQ;
    const float* s0 = state_ssm + (((size_t)sb * SSD_HEADS + h) * 64 + p) * 128 + ng * 16;
#pragma unroll
    for (int j = 0; j < 4; ++j) { const float4 v = *(const float4*)(s0 + 4 * j); hs[4 * j] = v.x; hs[4 * j + 1] = v.y; hs[4 * j + 2] = v.z; hs[4 * j + 3] = v.w; }
#pragma unroll
    for (int s = 0; s < 4; ++s) {
        const bf16* row = xbc_b + (size_t)(t0 + s) * CONV_DIM;
        bq[s][0] = *(const v4u*)(row + 1536 + g * 128 + ng * 16); bq[s][1] = *(const v4u*)(row + 1536 + g * 128 + ng * 16 + 8);
        cq[s][0] = *(const v4u*)(row + 2048 + g * 128 + ng * 16); cq[s][1] = *(const v4u*)(row + 2048 + g * 128 + ng * 16 + 8);
        xv[s] = bf2f(row[h * 64 + p]); dv[s] = dtv[(size_t)(t0 + s) * SSD_HEADS + h];
    }
}
__device__ __forceinline__ void ssd_decode_compute(const float* __restrict__ a_log, const float* __restrict__ d_skip, int item, int p, int ng,
                                                   float (&hs)[16], const v4u (&bq)[4][2], const v4u (&cq)[4][2], const float (&xv)[4], const float (&dv)[4],
                                                   float* __restrict__ ybuf, float* __restrict__ out) {
    const int sb = item / SSD_HEADS, h = item - sb * SSD_HEADS, t0 = T_PROMPT + sb * DEC_SEQ;
    const float A = -__expf(a_log[h]), D = d_skip[h];
#pragma unroll
    for (int s = 0; s < 4; ++s) {
        float Bf[16], Cf[16];
        { float t8[8]; unpack8(bq[s][0], t8);
#pragma unroll
          for (int j = 0; j < 8; ++j) Bf[j] = t8[j];
          unpack8(bq[s][1], t8);
#pragma unroll
          for (int j = 0; j < 8; ++j) Bf[8 + j] = t8[j];
          unpack8(cq[s][0], t8);
#pragma unroll
          for (int j = 0; j < 8; ++j) Cf[j] = t8[j];
          unpack8(cq[s][1], t8);
#pragma unroll
          for (int j = 0; j < 8; ++j) Cf[8 + j] = t8[j]; }
        const float a = __expf(dv[s] * A), xdt = xv[s] * dv[s];
        float y = 0.f;
#pragma unroll
        for (int j = 0; j < 16; ++j) { hs[j] = a * hs[j] + xdt * Bf[j]; y += Cf[j] * hs[j]; }
        y += __shfl_xor(y, 1); y += __shfl_xor(y, 2); y += __shfl_xor(y, 4);
        if (ng == 0) ybuf[(size_t)(t0 + s) * MIX_WIDTH + h * 64 + p] = y + D * xv[s];
    }
    float* so = out + OUT_SS + (((size_t)sb * SSD_HEADS + h) * 64 + p) * 128 + ng * 16;
#pragma unroll
    for (int j = 0; j < 4; ++j) *(float4*)(so + 4 * j) = make_float4(hs[4 * j], hs[4 * j + 1], hs[4 * j + 2], hs[4 * j + 3]);
}
__device__ __forceinline__ void ph_ssd_decode(const bf16* __restrict__ xbc_b, const float* __restrict__ dtv, const float* __restrict__ a_log, const float* __restrict__ d_skip,
                                              const float* __restrict__ state_ssm, float* __restrict__ ybuf, float* __restrict__ out) {
    const int tid = threadIdx.x, p = tid >> 3, ng = tid & 7;
    constexpr int NITEM = DEC_BATCH * SSD_HEADS;
    for (int it = blockIdx.x; it < NITEM; it += 2 * gridDim.x) {
        const int it2 = it + gridDim.x; const bool has2 = it2 < NITEM; const int it2c = has2 ? it2 : it;
        float hsA[16], hsB[16], xA[4], xB[4], dA[4], dB[4]; v4u bA[4][2], cA[4][2], bB[4][2], cB[4][2];
        ssd_decode_load(xbc_b, dtv, state_ssm, it, p, ng, hsA, bA, cA, xA, dA);
        ssd_decode_load(xbc_b, dtv, state_ssm, it2c, p, ng, hsB, bB, cB, xB, dB);
        ssd_decode_compute(a_log, d_skip, it, p, ng, hsA, bA, cA, xA, dA, ybuf, out);
        if (has2) ssd_decode_compute(a_log, d_skip, it2, p, ng, hsB, bB, cB, xB, dB, ybuf, out);
    }
}

typedef float f32x16 __attribute__((ext_vector_type(16)));
typedef short s16x8 __attribute__((ext_vector_type(8)));
typedef short s16x4 __attribute__((ext_vector_type(4)));
typedef float f32x4v __attribute__((ext_vector_type(4)));
#define SSD_L_ACS 0
#define SSD_L_DTS 3072
#define SSD_L_BM 6144
#define SSD_RS_B 272
#define SSD_L_X (6144 + 128 * 272)
#define SSD_RS_X 144
#define SSD_XIMG (128 * 144)
#define SSD_RS_Y 784
template <int OFF0, int OFF1>
__device__ __forceinline__ s16x8 tr_frag(unsigned base) {
    s16x4 a, b;
    asm volatile("ds_read_b64_tr_b16 %0, %2 offset:%3\n\tds_read_b64_tr_b16 %1, %2 offset:%4\n\ts_waitcnt lgkmcnt(0)"
                 : "=&v"(a), "=&v"(b) : "v"(base), "n"(OFF0), "n"(OFF1) : "memory");
    return __builtin_shufflevector(a, b, 0, 1, 2, 3, 4, 5, 6, 7);
}
__device__ __forceinline__ unsigned lds_addr(LAS unsigned char* p) { return (unsigned)(size_t)p; }

__device__ __forceinline__ void ssd_chunk_acs(LAS unsigned char* ldsb, const float* __restrict__ dtv, const float* __restrict__ a_log, int t0, int g, float* cdec_out) {
    const int w = __builtin_amdgcn_readfirstlane(threadIdx.x >> 6), lane = threadIdx.x & 63;
    if (w < 6) {
        const int head = 6 * g + w;
        const float A = -__expf(a_log[head]);
        const float v0 = dtv[(size_t)(t0 + 2 * lane) * SSD_HEADS + head], v1 = dtv[(size_t)(t0 + 2 * lane + 1) * SSD_HEADS + head];
        const float a1 = v1 * A;
        float s = v0 * A + a1;
#pragma unroll
        for (int o = 1; o < 64; o <<= 1) { const float tmp = __shfl_up(s, o); if (lane >= o) s += tmp; }
        LAS float* acs = (LAS float*)(ldsb + SSD_L_ACS) + w * 128;
        LAS float* dts = (LAS float*)(ldsb + SSD_L_DTS) + w * 128;
        acs[2 * lane] = s - a1; acs[2 * lane + 1] = s;
        dts[2 * lane] = v0; dts[2 * lane + 1] = v1;
        if (cdec_out && lane == 63) cdec_out[head] = __expf(s);
    }
}

__device__ __forceinline__ void ph_ssd_states(LAS unsigned char* ldsb, const bf16* __restrict__ xbc_b, const float* __restrict__ dtv, const float* __restrict__ a_log,
                                              bf16* __restrict__ Sbuf, float* __restrict__ cdec) {
    const int tid = threadIdx.x, w = __builtin_amdgcn_readfirstlane(tid >> 6), lane = tid & 63;
    const int r = lane & 31, h = lane >> 5, blk = (lane >> 4) & 1, q = (lane & 15) >> 2, pp = lane & 3;
    const int nt = w & 3, pt = w >> 2;
    for (int unit = blockIdx.x; unit < BATCH * 64 * SSD_GROUPS; unit += gridDim.x) {
        const int g = unit & 3, bc = unit >> 2;
        const int t0 = bc * 128;
        __syncthreads();
        ssd_chunk_acs(ldsb, dtv, a_log, t0, g, cdec + (size_t)bc * SSD_HEADS);
#pragma unroll
        for (int it_ = 0; it_ < 4; ++it_) { const int idx = tid + it_ * NTHR; const int row = idx >> 4, ch = idx & 15;
            const v4u v = *(const v4u*)(xbc_b + (size_t)(t0 + row) * CONV_DIM + 1536 + 128 * g + ch * 8);
            *(LAS v4u*)(ldsb + SSD_L_BM + row * SSD_RS_B + ch * 16) = v; }
        __syncthreads();
#pragma unroll
        for (int it_ = 0; it_ < 12; ++it_) { const int idx = tid + it_ * NTHR; const int hh = idx >> 10, rem = idx & 1023, row = rem >> 3, ch = rem & 7;
            const LAS float* acs = (const LAS float*)(ldsb + SSD_L_ACS) + hh * 128; const LAS float* dts = (const LAS float*)(ldsb + SSD_L_DTS) + hh * 128;
            const float wgt = dts[row] * __expf(acs[127] - acs[row]);
            float f[8]; unpack8(*(const v4u*)(xbc_b + (size_t)(t0 + row) * CONV_DIM + (6 * g + hh) * 64 + ch * 8), f);
            v4u o; o.x = pk2(f[0] * wgt, f[1] * wgt); o.y = pk2(f[2] * wgt, f[3] * wgt); o.z = pk2(f[4] * wgt, f[5] * wgt); o.w = pk2(f[6] * wgt, f[7] * wgt);
            *(LAS v4u*)(ldsb + SSD_L_X + hh * SSD_XIMG + row * SSD_RS_X + ch * 16) = o; }
        __syncthreads();
        const unsigned abase = lds_addr(ldsb + SSD_L_BM) + (8 * h + q) * SSD_RS_B + (32 * nt + 16 * blk + 4 * pp) * 2;
        s16x8 afr[8];
        afr[0] = tr_frag<0 * 16 * SSD_RS_B, (0 * 16 + 4) * SSD_RS_B>(abase); afr[1] = tr_frag<1 * 16 * SSD_RS_B, (1 * 16 + 4) * SSD_RS_B>(abase);
        afr[2] = tr_frag<2 * 16 * SSD_RS_B, (2 * 16 + 4) * SSD_RS_B>(abase); afr[3] = tr_frag<3 * 16 * SSD_RS_B, (3 * 16 + 4) * SSD_RS_B>(abase);
        afr[4] = tr_frag<4 * 16 * SSD_RS_B, (4 * 16 + 4) * SSD_RS_B>(abase); afr[5] = tr_frag<5 * 16 * SSD_RS_B, (5 * 16 + 4) * SSD_RS_B>(abase);
        afr[6] = tr_frag<6 * 16 * SSD_RS_B, (6 * 16 + 4) * SSD_RS_B>(abase); afr[7] = tr_frag<7 * 16 * SSD_RS_B, (7 * 16 + 4) * SSD_RS_B>(abase);
#pragma unroll
        for (int hh = 0; hh < 6; ++hh) {
            const unsigned xb = lds_addr(ldsb + SSD_L_X + hh * SSD_XIMG) + (8 * h + q) * SSD_RS_X + (32 * pt + 16 * blk + 4 * pp) * 2;
            f32x16 acc;
#pragma unroll
            for (int i = 0; i < 16; ++i) acc[i] = 0.f;
            acc = __builtin_amdgcn_mfma_f32_32x32x16_bf16(afr[0], tr_frag<0 * 16 * SSD_RS_X, (0 * 16 + 4) * SSD_RS_X>(xb), acc, 0, 0, 0);
            acc = __builtin_amdgcn_mfma_f32_32x32x16_bf16(afr[1], tr_frag<1 * 16 * SSD_RS_X, (1 * 16 + 4) * SSD_RS_X>(xb), acc, 0, 0, 0);
            acc = __builtin_amdgcn_mfma_f32_32x32x16_bf16(afr[2], tr_frag<2 * 16 * SSD_RS_X, (2 * 16 + 4) * SSD_RS_X>(xb), acc, 0, 0, 0);
            acc = __builtin_amdgcn_mfma_f32_32x32x16_bf16(afr[3], tr_frag<3 * 16 * SSD_RS_X, (3 * 16 + 4) * SSD_RS_X>(xb), acc, 0, 0, 0);
            acc = __builtin_amdgcn_mfma_f32_32x32x16_bf16(afr[4], tr_frag<4 * 16 * SSD_RS_X, (4 * 16 + 4) * SSD_RS_X>(xb), acc, 0, 0, 0);
            acc = __builtin_amdgcn_mfma_f32_32x32x16_bf16(afr[5], tr_frag<5 * 16 * SSD_RS_X, (5 * 16 + 4) * SSD_RS_X>(xb), acc, 0, 0, 0);
            acc = __builtin_amdgcn_mfma_f32_32x32x16_bf16(afr[6], tr_frag<6 * 16 * SSD_RS_X, (6 * 16 + 4) * SSD_RS_X>(xb), acc, 0, 0, 0);
            acc = __builtin_amdgcn_mfma_f32_32x32x16_bf16(afr[7], tr_frag<7 * 16 * SSD_RS_X, (7 * 16 + 4) * SSD_RS_X>(xb), acc, 0, 0, 0);
            bf16* dst = Sbuf + (((size_t)bc * SSD_HEADS + 6 * g + hh) * 64 + 32 * pt + r) * 128 + 32 * nt + 4 * h;
#pragma unroll
            for (int q4 = 0; q4 < 4; ++q4) *(uint2*)(dst + 8 * q4) = make_uint2(pk2(acc[4 * q4], acc[4 * q4 + 1]), pk2(acc[4 * q4 + 2], acc[4 * q4 + 3]));
        }
    }
}

__device__ __forceinline__ void ph_ssd_scan(const bf16* __restrict__ Sbuf, const float* __restrict__ cdec, bf16* __restrict__ Hin, float* __restrict__ out, int rank, int nranks) {
    for (int idx = rank * NTHR + threadIdx.x; idx < BATCH * SSD_HEADS * 64 * 16; idx += nranks * NTHR) {
        const int n8 = idx & 15, p = (idx >> 4) & 63, hb = idx >> 10, hd = hb % SSD_HEADS, b = hb / SSD_HEADS;
        float st[8];
#pragma unroll
        for (int j = 0; j < 8; ++j) st[j] = 0.f;
#pragma unroll 8
        for (int c = 0; c < 64; ++c) {
            const size_t base = ((((size_t)(b * 64 + c)) * SSD_HEADS + hd) * 64 + p) * 128 + n8 * 8;
            v4u o; o.x = pk2(st[0], st[1]); o.y = pk2(st[2], st[3]); o.z = pk2(st[4], st[5]); o.w = pk2(st[6], st[7]);
            *(v4u*)(Hin + base) = o;
            float s[8]; unpack8(*(const v4u*)(Sbuf + base), s);
            const float a = cdec[(size_t)(b * 64 + c) * SSD_HEADS + hd];
#pragma unroll
            for (int j = 0; j < 8; ++j) st[j] = a * st[j] + s[j];
        }
        store8f(out + OUT_PS + (((size_t)b * SSD_HEADS + hd) * 64 + p) * 128 + n8 * 8, st);
    }
}

__device__ __forceinline__ void ph_ssd_out(LAS unsigned char* ldsb, const bf16* __restrict__ xbc_b, const bf16* __restrict__ projb, const float* __restrict__ dtv,
                                           const float* __restrict__ a_log, const float* __restrict__ d_skip, const float* __restrict__ norm_g,
                                           const bf16* __restrict__ Hin, bf16* __restrict__ A1) {
    const int tid = threadIdx.x, w = __builtin_amdgcn_readfirstlane(tid >> 6), lane = tid & 63;
    const int r = lane & 31, h = lane >> 5, blk = (lane >> 4) & 1, q = (lane & 15) >> 2, pp = lane & 3;
    const int lt = w & 3, hs = w >> 2;
    for (int unit = blockIdx.x; unit < BATCH * 64 * SSD_GROUPS; unit += gridDim.x) {
        const int g = unit & 3, bc = unit >> 2;
        const int t0 = bc * 128;
        __syncthreads();
        ssd_chunk_acs(ldsb, dtv, a_log, t0, g, nullptr);
#pragma unroll
        for (int it_ = 0; it_ < 4; ++it_) { const int idx = tid + it_ * NTHR; const int row = idx >> 4, ch = idx & 15;
            const v4u v = *(const v4u*)(xbc_b + (size_t)(t0 + row) * CONV_DIM + 1536 + 128 * g + ch * 8);
            *(LAS v4u*)(ldsb + SSD_L_BM + row * SSD_RS_B + ch * 16) = v; }
#pragma unroll
        for (int it_ = 0; it_ < 12; ++it_) { const int idx = tid + it_ * NTHR; const int hh = idx >> 10, rem = idx & 1023, row = rem >> 3, ch = rem & 7;
            const v4u v = *(const v4u*)(xbc_b + (size_t)(t0 + row) * CONV_DIM + (6 * g + hh) * 64 + ch * 8);
            *(LAS v4u*)(ldsb + SSD_L_X + hh * SSD_XIMG + row * SSD_RS_X + ch * 16) = v; }
        __syncthreads();
        const bf16* cp = xbc_b + (size_t)(t0 + 32 * lt + r) * CONV_DIM + 2048 + 128 * g + 8 * h;
        const int lcol = 32 * lt + r;
        const LAS float* acsb = (const LAS float*)(ldsb + SSD_L_ACS) + 3 * hs * 128; const LAS float* dtsb = (const LAS float*)(ldsb + SSD_L_DTS) + 3 * hs * 128;
        f32x16 y[3][2];
#pragma unroll
        for (int h3 = 0; h3 < 3; ++h3)
#pragma unroll
            for (int i = 0; i < 16; ++i) { y[h3][0][i] = 0.f; y[h3][1][i] = 0.f; }
#pragma unroll 1
        for (int ks = 0; ks < 8; ++ks) {
            const s16x8 cf = *(const s16x8*)(cp + 16 * ks);
#pragma unroll
            for (int h3 = 0; h3 < 3; ++h3) {
                const bf16* hp = Hin + (((size_t)bc * SSD_HEADS + 6 * g + 3 * hs + h3) * 64 + r) * 128 + 8 * h + 16 * ks;
                const s16x8 h0 = *(const s16x8*)hp, h1 = *(const s16x8*)(hp + 32 * 128);
                y[h3][0] = __builtin_amdgcn_mfma_f32_32x32x16_bf16(cf, h0, y[h3][0], 0, 0, 0);
                y[h3][1] = __builtin_amdgcn_mfma_f32_32x32x16_bf16(cf, h1, y[h3][1], 0, 0, 0);
            }
        }
#pragma unroll
        for (int h3 = 0; h3 < 3; ++h3)
#pragma unroll
            for (int q4 = 0; q4 < 4; ++q4) {
                const f32x4v a4 = *(const LAS f32x4v*)(acsb + h3 * 128 + 32 * lt + 8 * q4 + 4 * h);
                const float e0 = __expf(a4[0]), e1 = __expf(a4[1]), e2 = __expf(a4[2]), e3 = __expf(a4[3]);
                y[h3][0][4 * q4] *= e0; y[h3][0][4 * q4 + 1] *= e1; y[h3][0][4 * q4 + 2] *= e2; y[h3][0][4 * q4 + 3] *= e3;
                y[h3][1][4 * q4] *= e0; y[h3][1][4 * q4 + 1] *= e1; y[h3][1][4 * q4 + 2] *= e2; y[h3][1][4 * q4 + 3] *= e3;
            }
        const unsigned xb0 = lds_addr(ldsb + SSD_L_X + 3 * hs * SSD_XIMG) + (4 * h + q) * SSD_RS_X + (16 * blk + 4 * pp) * 2;
        for (int st = 0; st <= lt; ++st) {
            f32x16 cb;
#pragma unroll
            for (int i = 0; i < 16; ++i) cb[i] = 0.f;
#pragma unroll 2
            for (int ks = 0; ks < 8; ++ks) {
                const s16x8 cf = *(const s16x8*)(cp + 16 * ks);
                const s16x8 bfrag = *(const LAS s16x8*)(ldsb + SSD_L_BM + (32 * st + r) * SSD_RS_B + (16 * ks + 8 * h) * 2);
                cb = __builtin_amdgcn_mfma_f32_32x32x16_bf16(bfrag, cf, cb, 0, 0, 0);
            }
#pragma unroll
            for (int h3 = 0; h3 < 3; ++h3) {
                const LAS float* acs = acsb + h3 * 128; const LAS float* dts = dtsb + h3 * 128;
                const float myacs = acs[lcol];
                const float Dh = d_skip[6 * g + 3 * hs + h3];
                const unsigned xb = xb0 + h3 * SSD_XIMG + st * 32 * SSD_RS_X;
#pragma unroll
                for (int kk = 0; kk < 2; ++kk) {
                    const int s0 = 32 * st + 16 * kk + 4 * h;
                    const f32x4v as0 = *(const LAS f32x4v*)(acs + s0), as1 = *(const LAS f32x4v*)(acs + s0 + 8);
                    const f32x4v ds0 = *(const LAS f32x4v*)(dts + s0), ds1 = *(const LAS f32x4v*)(dts + s0 + 8);
                    float wv[8];
#pragma unroll
                    for (int j = 0; j < 8; ++j) {
                        const int s = s0 + 8 * (j >> 2) + (j & 3);
                        const float asj = (j < 4) ? as0[j & 3] : as1[j & 3], dsj = (j < 4) ? ds0[j & 3] : ds1[j & 3];
                        float v = cb[8 * kk + j] * __expf(myacs - asj) * dsj;
                        v = (s <= lcol) ? v : 0.f;
                        v = (s == lcol) ? v + Dh : v;
                        wv[j] = v;
                    }
                    s16x8 afr;
                    { v4u o; o.x = pk2(wv[0], wv[1]); o.y = pk2(wv[2], wv[3]); o.z = pk2(wv[4], wv[5]); o.w = pk2(wv[6], wv[7]); afr = __builtin_bit_cast(s16x8, o); }
                    s16x8 b0, b1;
                    if (kk == 0) { b0 = tr_frag<0, 8 * SSD_RS_X>(xb); b1 = tr_frag<64, 8 * SSD_RS_X + 64>(xb); }
                    else { b0 = tr_frag<16 * SSD_RS_X, 24 * SSD_RS_X>(xb); b1 = tr_frag<16 * SSD_RS_X + 64, 24 * SSD_RS_X + 64>(xb); }
                    y[h3][0] = __builtin_amdgcn_mfma_f32_32x32x16_bf16(afr, b0, y[h3][0], 0, 0, 0);
                    y[h3][1] = __builtin_amdgcn_mfma_f32_32x32x16_bf16(afr, b1, y[h3][1], 0, 0, 0);
                    __builtin_amdgcn_sched_barrier(0);
                }
            }
        }
        __syncthreads();
        {
            LAS unsigned short* yst = (LAS unsigned short*)(ldsb + SSD_L_X);
#pragma unroll
            for (int h3 = 0; h3 < 3; ++h3)
#pragma unroll
                for (int ptile = 0; ptile < 2; ++ptile)
#pragma unroll
                    for (int reg = 0; reg < 16; ++reg) {
                        const int l0 = 32 * lt + (reg & 3) + 8 * (reg >> 2) + 4 * h;
                        const int col = (3 * hs + h3) * 64 + 32 * ptile + r;
                        yst[l0 * (SSD_RS_Y / 2) + col] = (unsigned short)f2bf(y[h3][ptile][reg]);
                    }
        }
        __syncthreads();
#pragma unroll
        for (int pass = 0; pass < 4; ++pass) {
            const int l = 4 * (pass * 8 + w) + (lane >> 4), i16 = lane & 15;
            float gv[3][8]; float ss = 0.f;
#pragma unroll
            for (int k = 0; k < 3; ++k) {
                const int col0 = 24 * i16 + 8 * k;
                float yv[8], zv[8];
                unpack8(*(const LAS v4u*)(ldsb + SSD_L_X + l * SSD_RS_Y + col0 * 2), yv);
                unpack8(*(const v4u*)(projb + (size_t)(t0 + l) * NB_LD + g * 384 + col0), zv);
#pragma unroll
                for (int j = 0; j < 8; ++j) { const float gg = yv[j] * silu_f(zv[j]); gv[k][j] = gg; ss += gg * gg; }
            }
            ss += __shfl_xor(ss, 1); ss += __shfl_xor(ss, 2); ss += __shfl_xor(ss, 4); ss += __shfl_xor(ss, 8);
            const float rstd = rsqrtf(ss * (1.0f / 384.0f) + LN_EPS);
#pragma unroll
            for (int k = 0; k < 3; ++k) {
                const int col0 = g * 384 + 24 * i16 + 8 * k;
                const float4 g0 = *(const float4*)(norm_g + col0), g1 = *(const float4*)(norm_g + col0 + 4);
                v4u o; o.x = pk2(gv[k][0] * rstd * g0.x, gv[k][1] * rstd * g0.y); o.y = pk2(gv[k][2] * rstd * g0.z, gv[k][3] * rstd * g0.w);
                o.z = pk2(gv[k][4] * rstd * g1.x, gv[k][5] * rstd * g1.y); o.w = pk2(gv[k][6] * rstd * g1.z, gv[k][7] * rstd * g1.w);
                *(v4u*)(A1 + (size_t)(t0 + l) * MIX_WIDTH + col0) = o;
            }
        }
    }
}

#define ATT_RS_V 144
#define ATT_VIMG (256 * ATT_RS_V)
#define ATT_PV(KT, S2) { \
        v4u o_; o_.x = pk2(s[KT][8 * S2 + 0], s[KT][8 * S2 + 1]); o_.y = pk2(s[KT][8 * S2 + 2], s[KT][8 * S2 + 3]); \
        o_.z = pk2(s[KT][8 * S2 + 4], s[KT][8 * S2 + 5]); o_.w = pk2(s[KT][8 * S2 + 6], s[KT][8 * S2 + 7]); \
        const s16x8 pf_ = __builtin_bit_cast(s16x8, o_); \
        const s16x8 a0_ = tr_frag<(32 * KT + 16 * S2) * ATT_RS_V, (32 * KT + 16 * S2 + 8) * ATT_RS_V>(vbase); \
        const s16x8 a1_ = tr_frag<(32 * KT + 16 * S2) * ATT_RS_V + 64, (32 * KT + 16 * S2 + 8) * ATT_RS_V + 64>(vbase); \
        o0 = __builtin_amdgcn_mfma_f32_32x32x16_bf16(a0_, pf_, o0, 0, 0, 0); \
        o1 = __builtin_amdgcn_mfma_f32_32x32x16_bf16(a1_, pf_, o1, 0, 0, 0); }
__device__ __forceinline__ void ph_attn_prompt(LAS unsigned char* ldsb, const bf16* __restrict__ qrot_b, const bf16* __restrict__ krot_b, const bf16* __restrict__ projb,
                                               bf16* __restrict__ obuf, float* __restrict__ lsebuf) {
    const int tid = threadIdx.x, w = __builtin_amdgcn_readfirstlane(tid >> 6), lane = tid & 63;
    const int r = lane & 31, h = lane >> 5, blk = (lane >> 4) & 1, q = (lane & 15) >> 2, pp = lane & 3;
    const int qt = w & 3, hsel = w >> 2;
    for (int unit = blockIdx.x; unit < 3 * 512; unit += gridDim.x) {
        const int pat = unit >> 9, rem = unit & 511, hp = rem & 3, rem2 = rem >> 2, b = rem2 >> 6, bk = rem2 & 63;
        const int dsh = 2 * pat, nper = 64 >> dsh, res = bk >> (6 - dsh), nb = bk & (nper - 1);
        const int head = 2 * hp + hsel;
        __syncthreads();
#pragma unroll
        for (int it_ = 0; it_ < 8; ++it_) { const int idx = (tid & 255) + it_ * 256;
            const int row = idx >> 3, ch = idx & 7, js = 128 * nb - 128 + row;
            v4u v; v.x = 0u; v.y = 0u; v.z = 0u; v.w = 0u;
            if (js >= 0) v = *(const v4u*)(projb + (size_t)(b * SEQ + (js << dsh) + res) * NB_LD + NB_V + head * 64 + ch * 8);
            *(LAS v4u*)(ldsb + hsel * ATT_VIMG + row * ATT_RS_V + ch * 16) = v;
        }
        const int tq = b * SEQ + ((128 * nb + 32 * qt + r) << dsh) + res;
        s16x8 qf[4];
#pragma unroll
        for (int ks = 0; ks < 4; ++ks) qf[ks] = *(const s16x8*)(qrot_b + (size_t)tq * ATT_WIDTH + head * 64 + 16 * ks + 8 * h);
        f32x16 s[5];
#pragma unroll
        for (int kt = 0; kt < 5; ++kt) {
            int js = 128 * nb + 32 * qt - 128 + 32 * kt + r; js = js < 0 ? 0 : js;
            const bf16* kp = krot_b + (size_t)(b * SEQ + (js << dsh) + res) * ATT_WIDTH + head * 64 + 8 * h;
#pragma unroll
            for (int i = 0; i < 16; ++i) s[kt][i] = 0.f;
#pragma unroll
            for (int ks = 0; ks < 4; ++ks) s[kt] = __builtin_amdgcn_mfma_f32_32x32x16_bf16(*(const s16x8*)(kp + 16 * ks), qf[ks], s[kt], 0, 0, 0);
        }
        float m = -INFINITY;
#pragma unroll
        for (int kt = 0; kt < 5; ++kt) {
            const bool tile_ok = (nb > 0) || (qt + kt >= 4);
#pragma unroll
            for (int reg = 0; reg < 16; ++reg) {
                const int c = (reg & 3) + 8 * (reg >> 2) + 4 * h;
                const bool ok = tile_ok && (kt == 0 ? (c >= r) : (kt == 4 ? (c <= r) : true));
                const float v = ok ? s[kt][reg] * 0.125f : -INFINITY;
                s[kt][reg] = v; m = fmaxf(m, v);
            }
        }
        m = fmaxf(m, __shfl_xor(m, 32));
        float l = 0.f;
#pragma unroll
        for (int kt = 0; kt < 5; ++kt)
#pragma unroll
            for (int reg = 0; reg < 16; ++reg) { const float p = __expf(s[kt][reg] - m); s[kt][reg] = p; l += p; }
        l += __shfl_xor(l, 32);
        __syncthreads();
        f32x16 o0, o1;
#pragma unroll
        for (int i = 0; i < 16; ++i) { o0[i] = 0.f; o1[i] = 0.f; }
        const unsigned vbase = lds_addr(ldsb + hsel * ATT_VIMG) + (32 * qt + 4 * h + q) * ATT_RS_V + (16 * blk + 4 * pp) * 2;
        ATT_PV(0, 0) ATT_PV(0, 1) ATT_PV(1, 0) ATT_PV(1, 1) ATT_PV(2, 0) ATT_PV(2, 1) ATT_PV(3, 0) ATT_PV(3, 1) ATT_PV(4, 0) ATT_PV(4, 1)
        const float inv = 1.0f / l;
        bf16* op = obuf + ((size_t)pat * T_PROMPT + tq) * ATT_WIDTH + head * 64 + 4 * h;
#pragma unroll
        for (int q4 = 0; q4 < 4; ++q4) {
            *(uint2*)(op + 8 * q4) = make_uint2(pk2(o0[4 * q4] * inv, o0[4 * q4 + 1] * inv), pk2(o0[4 * q4 + 2] * inv, o0[4 * q4 + 3] * inv));
            *(uint2*)(op + 32 + 8 * q4) = make_uint2(pk2(o1[4 * q4] * inv, o1[4 * q4 + 1] * inv), pk2(o1[4 * q4 + 2] * inv, o1[4 * q4 + 3] * inv));
        }
        if (h == 0) lsebuf[((size_t)pat * T_PROMPT + tq) * 8 + head] = m + __logf(l);
    }
}
__device__ __forceinline__ void ph_attn_combine(const bf16* __restrict__ obuf, const float* __restrict__ lsebuf, bf16* __restrict__ A1) {
    const int lane = threadIdx.x & 63;
    for (int t = blockIdx.x * NWAVE + (threadIdx.x >> 6); t < T_PROMPT; t += gridDim.x * NWAVE) {
        const int hd = lane >> 3;
        const float l0 = lsebuf[((size_t)0 * T_PROMPT + t) * 8 + hd], l1 = lsebuf[((size_t)1 * T_PROMPT + t) * 8 + hd], l2 = lsebuf[((size_t)2 * T_PROMPT + t) * 8 + hd];
        const float mx = fmaxf(l0, fmaxf(l1, l2));
        const float e0 = __expf(l0 - mx), e1 = __expf(l1 - mx), e2 = __expf(l2 - mx);
        const float inv = 1.0f / (e0 + e1 + e2);
        float a[8], b[8], c[8];
        unpack8(*(const v4u*)(obuf + ((size_t)0 * T_PROMPT + t) * ATT_WIDTH + lane * 8), a);
        unpack8(*(const v4u*)(obuf + ((size_t)1 * T_PROMPT + t) * ATT_WIDTH + lane * 8), b);
        unpack8(*(const v4u*)(obuf + ((size_t)2 * T_PROMPT + t) * ATT_WIDTH + lane * 8), c);
        float o[8];
#pragma unroll
        for (int j = 0; j < 8; ++j) o[j] = (e0 * a[j] + e1 * b[j] + e2 * c[j]) * inv;
        v4u w; w.x = pk2(o[0], o[1]); w.y = pk2(o[2], o[3]); w.z = pk2(o[4], o[5]); w.w = pk2(o[6], o[7]);
        *(v4u*)(A1 + (size_t)t * MIX_WIDTH + SSD_WIDTH + lane * 8) = w;
    }
}

#define RT_RS 272
#define RT_KIMG (128 * RT_RS)
#define RT_LUT (2 * RT_KIMG)
constexpr unsigned char RT_CANDS[64] = {0, 1, 2, 3, 4, 5, 6, 7, 8, 9, 10, 11, 12, 13, 14, 15, 16, 17, 18, 19, 20, 21, 22, 23, 32, 33, 34, 35, 36, 48, 49, 50, 51, 64, 65, 66, 80, 81, 96, 97,
                                        112, 113, 128, 144, 160, 176, 192, 208, 224, 240, 0, 0, 0, 0, 0, 0, 0, 0, 0, 0, 0, 0, 0, 0};
__device__ __forceinline__ unsigned rt_mono(float f) { const unsigned u = __builtin_bit_cast(unsigned, f); return u ^ ((unsigned)((int)u >> 31) | 0x80000000u); }
__device__ __forceinline__ float rt_unmono(unsigned m) { const unsigned u = (m & 0x80000000u) ? (m ^ 0x80000000u) : ~m; return __builtin_bit_cast(float, u); }
#define RT_CE_DESC(a, b) { const unsigned x_ = (a), y_ = (b); (a) = x_ > y_ ? x_ : y_; (b) = x_ > y_ ? y_ : x_; }
#define RT_CE_ASC(a, b) { const unsigned x_ = (a), y_ = (b); (a) = x_ > y_ ? y_ : x_; (b) = x_ > y_ ? x_ : y_; }
__device__ __forceinline__ void rt_sort16(unsigned (&v)[16]) {
#pragma unroll
    for (int k = 2; k <= 16; k <<= 1)
#pragma unroll
        for (int j = k >> 1; j > 0; j >>= 1)
#pragma unroll
            for (int i = 0; i < 16; ++i) { const int l = i ^ j; if (l > i) { if ((i & k) == 0) RT_CE_DESC(v[i], v[l]) else RT_CE_ASC(v[i], v[l]) } }
}
__device__ __forceinline__ void rt_merge16(unsigned (&v)[16]) {
#pragma unroll
    for (int j = 8; j > 0; j >>= 1)
#pragma unroll
        for (int i = 0; i < 16; ++i) { const int l = i ^ j; if (l > i) RT_CE_DESC(v[i], v[l]) }
}
__device__ __forceinline__ void rt_top16(unsigned (&a)[16], const unsigned (&b)[16]) {
#pragma unroll
    for (int i = 0; i < 16; ++i) a[i] = a[i] > b[15 - i] ? a[i] : b[15 - i];
    rt_merge16(a);
}
__device__ __forceinline__ void rt_top16_partner(unsigned (&a)[16]) {
    unsigned b[16];
#pragma unroll
    for (int i = 0; i < 16; ++i) b[i] = (unsigned)__shfl_xor((int)a[i], 32);
    rt_top16(a, b);
}
__device__ __forceinline__ void rt_scores_top16(LAS unsigned char* kimg, const bf16* __restrict__ qp, int r, int h, unsigned (&k0)[16]) {
    f32x16 acc[4];
#pragma unroll
    for (int kt = 0; kt < 4; ++kt)
#pragma unroll
        for (int i = 0; i < 16; ++i) acc[kt][i] = 0.f;
#pragma unroll
    for (int ks = 0; ks < 8; ++ks) {
        const s16x8 qf = *(const s16x8*)(qp + 16 * ks);
#pragma unroll
        for (int kt = 0; kt < 4; ++kt) {
            const s16x8 kf = *(const LAS s16x8*)(kimg + (32 * kt + r) * RT_RS + (16 * ks + 8 * h) * 2);
            acc[kt] = __builtin_amdgcn_mfma_f32_32x32x16_bf16(kf, qf, acc[kt], 0, 0, 0);
        }
    }
    unsigned k1[16], k2[16], k3[16];
#pragma unroll
    for (int reg = 0; reg < 16; ++reg) {
        const unsigned ki = (unsigned)((reg & 3) + 8 * (reg >> 2) + 4 * h);
        k0[reg] = (rt_mono(acc[0][reg]) & 0xFFFFFF80u) | ki;
        k1[reg] = (rt_mono(acc[1][reg]) & 0xFFFFFF80u) | (ki + 32u);
        k2[reg] = (rt_mono(acc[2][reg]) & 0xFFFFFF80u) | (ki + 64u);
        k3[reg] = (rt_mono(acc[3][reg]) & 0xFFFFFF80u) | (ki + 96u);
    }
    rt_sort16(k0); rt_sort16(k1); rt_sort16(k2); rt_sort16(k3);
    rt_top16(k0, k1); rt_top16(k2, k3); rt_top16(k0, k2);
    rt_top16_partner(k0);
}
__device__ __forceinline__ void ph_peer_route2(LAS unsigned char* ldsb, const bf16* __restrict__ qhb, const float* __restrict__ keys1, const float* __restrict__ keys2,
                                               int* __restrict__ eidx, float* __restrict__ gate) {
    const int tid = threadIdx.x, w = __builtin_amdgcn_readfirstlane(tid >> 6), lane = tid & 63, r = lane & 31, h = lane >> 5;
    __syncthreads();
    for (int idx = tid; idx < 2 * 128 * 16; idx += NTHR) {
        const int tb = idx >> 11, rem = idx & 2047, row = rem >> 4, ch = rem & 15;
        const float* sp = (tb ? keys2 : keys1) + row * 128 + ch * 8;
        const float4 a = *(const float4*)sp, b = *(const float4*)(sp + 4);
        v4u o; o.x = pk2(a.x, a.y); o.y = pk2(a.z, a.w); o.z = pk2(b.x, b.y); o.w = pk2(b.z, b.w);
        *(LAS v4u*)(ldsb + tb * RT_KIMG + row * RT_RS + ch * 16) = o;
    }
    __syncthreads();
    LAS unsigned* lut = (LAS unsigned*)(ldsb + RT_LUT) + w * 512;
    for (int unit = blockIdx.x * NWAVE + w; unit < (T_ALL / 32) * 8; unit += gridDim.x * NWAVE) {
        const int tt = unit >> 3, hd = unit & 7;
        const int tok = 32 * tt + r;
        const bf16* qp = qhb + (size_t)tok * 2048 + hd * 256 + 8 * h;
        unsigned ka[16], kb[16];
        rt_scores_top16(ldsb, qp, r, h, ka);
        rt_scores_top16(ldsb + RT_KIMG, qp + 128, r, h, kb);
        float v1[16], v2[16];
#pragma unroll
        for (int i = 0; i < 16; ++i) { v1[i] = rt_unmono(ka[i] & 0xFFFFFF80u); v2[i] = rt_unmono(kb[i] & 0xFFFFFF80u); }
#pragma unroll
        for (int wd = 0; wd < 4; ++wd) {
            lut[wd * 64 + lane] = (ka[4 * wd] & 0x7Fu) | ((ka[4 * wd + 1] & 0x7Fu) << 8) | ((ka[4 * wd + 2] & 0x7Fu) << 16) | ((ka[4 * wd + 3] & 0x7Fu) << 24);
            lut[(4 + wd) * 64 + lane] = (kb[4 * wd] & 0x7Fu) | ((kb[4 * wd + 1] & 0x7Fu) << 8) | ((kb[4 * wd + 2] & 0x7Fu) << 16) | ((kb[4 * wd + 3] & 0x7Fu) << 24);
        }
        unsigned c0[16], c1[16];
        c0[0] = (rt_mono(h ? (v1[0] + v2[1]) : (v1[0] + v2[0])) & 0xFFFFFF00u) | (h ? 1u : 0u);
        c0[1] = (rt_mono(h ? (v1[0] + v2[3]) : (v1[0] + v2[2])) & 0xFFFFFF00u) | (h ? 3u : 2u);
        c0[2] = (rt_mono(h ? (v1[0] + v2[5]) : (v1[0] + v2[4])) & 0xFFFFFF00u) | (h ? 5u : 4u);
        c0[3] = (rt_mono(h ? (v1[0] + v2[7]) : (v1[0] + v2[6])) & 0xFFFFFF00u) | (h ? 7u : 6u);
        c0[4] = (rt_mono(h ? (v1[0] + v2[9]) : (v1[0] + v2[8])) & 0xFFFFFF00u) | (h ? 9u : 8u);
        c0[5] = (rt_mono(h ? (v1[0] + v2[11]) : (v1[0] + v2[10])) & 0xFFFFFF00u) | (h ? 11u : 10u);
        c0[6] = (rt_mono(h ? (v1[0] + v2[13]) : (v1[0] + v2[12])) & 0xFFFFFF00u) | (h ? 13u : 12u);
        c0[7] = (rt_mono(h ? (v1[0] + v2[15]) : (v1[0] + v2[14])) & 0xFFFFFF00u) | (h ? 15u : 14u);
        c0[8] = (rt_mono(h ? (v1[1] + v2[1]) : (v1[1] + v2[0])) & 0xFFFFFF00u) | (h ? 17u : 16u);
        c0[9] = (rt_mono(h ? (v1[1] + v2[3]) : (v1[1] + v2[2])) & 0xFFFFFF00u) | (h ? 19u : 18u);
        c0[10] = (rt_mono(h ? (v1[1] + v2[5]) : (v1[1] + v2[4])) & 0xFFFFFF00u) | (h ? 21u : 20u);
        c0[11] = (rt_mono(h ? (v1[1] + v2[7]) : (v1[1] + v2[6])) & 0xFFFFFF00u) | (h ? 23u : 22u);
        c0[12] = (rt_mono(h ? (v1[2] + v2[1]) : (v1[2] + v2[0])) & 0xFFFFFF00u) | (h ? 33u : 32u);
        c0[13] = (rt_mono(h ? (v1[2] + v2[3]) : (v1[2] + v2[2])) & 0xFFFFFF00u) | (h ? 35u : 34u);
        c0[14] = (rt_mono(h ? (v1[3] + v2[0]) : (v1[2] + v2[4])) & 0xFFFFFF00u) | (h ? 48u : 36u);
        c0[15] = (rt_mono(h ? (v1[3] + v2[2]) : (v1[3] + v2[1])) & 0xFFFFFF00u) | (h ? 50u : 49u);
        c1[0] = (rt_mono(h ? (v1[4] + v2[0]) : (v1[3] + v2[3])) & 0xFFFFFF00u) | (h ? 64u : 51u);
        c1[1] = (rt_mono(h ? (v1[4] + v2[2]) : (v1[4] + v2[1])) & 0xFFFFFF00u) | (h ? 66u : 65u);
        c1[2] = (rt_mono(h ? (v1[5] + v2[1]) : (v1[5] + v2[0])) & 0xFFFFFF00u) | (h ? 81u : 80u);
        c1[3] = (rt_mono(h ? (v1[6] + v2[1]) : (v1[6] + v2[0])) & 0xFFFFFF00u) | (h ? 97u : 96u);
        c1[4] = (rt_mono(h ? (v1[7] + v2[1]) : (v1[7] + v2[0])) & 0xFFFFFF00u) | (h ? 113u : 112u);
        c1[5] = (rt_mono(h ? (v1[9] + v2[0]) : (v1[8] + v2[0])) & 0xFFFFFF00u) | (h ? 144u : 128u);
        c1[6] = (rt_mono(h ? (v1[11] + v2[0]) : (v1[10] + v2[0])) & 0xFFFFFF00u) | (h ? 176u : 160u);
        c1[7] = (rt_mono(h ? (v1[13] + v2[0]) : (v1[12] + v2[0])) & 0xFFFFFF00u) | (h ? 208u : 192u);
        c1[8] = (rt_mono(h ? (v1[15] + v2[0]) : (v1[14] + v2[0])) & 0xFFFFFF00u) | (h ? 240u : 224u);
        c1[9] = 0u;
        c1[10] = 0u;
        c1[11] = 0u;
        c1[12] = 0u;
        c1[13] = 0u;
        c1[14] = 0u;
        c1[15] = 0u;
        rt_sort16(c0); rt_sort16(c1); rt_top16(c0, c1); rt_top16_partner(c0);
        float e[16]; float sum = 0.f;
        const float mx = rt_unmono(c0[0] & 0xFFFFFF00u);
#pragma unroll
        for (int k = 0; k < 16; ++k) { e[k] = __expf(rt_unmono(c0[k] & 0xFFFFFF00u) - mx); sum += e[k]; }
        const float inv = 1.0f / sum;
        asm volatile("s_waitcnt lgkmcnt(0)" ::: "memory");
        int ex[8]; float gv[8];
#pragma unroll
        for (int k = 0; k < 8; ++k) {
            const unsigned hm = (unsigned)(-h);
            const unsigned ck = (c0[k] & ~hm) | (c0[8 + k] & hm);
            const float ek = __builtin_bit_cast(float, (__builtin_bit_cast(unsigned, e[k]) & ~hm) | (__builtin_bit_cast(unsigned, e[8 + k]) & hm));
            const unsigned ci = (ck >> 4) & 15u, cj = ck & 15u;
            const unsigned w1 = lut[(ci >> 2) * 64 + lane], w2 = lut[(4 + (cj >> 2)) * 64 + lane];
            const unsigned i1 = (w1 >> (8 * (ci & 3))) & 0x7Fu, i2 = (w2 >> (8 * (cj & 3))) & 0x7Fu;
            ex[k] = (int)(i1 * PEER_NKEYS + i2); gv[k] = ek * inv;
        }
        int* ep = eidx + (size_t)tok * 128 + hd * 16 + 8 * h; float* gp = gate + (size_t)tok * 128 + hd * 16 + 8 * h;
        *(int4*)ep = make_int4(ex[0], ex[1], ex[2], ex[3]); *(int4*)(ep + 4) = make_int4(ex[4], ex[5], ex[6], ex[7]);
        *(float4*)gp = make_float4(gv[0], gv[1], gv[2], gv[3]); *(float4*)(gp + 4) = make_float4(gv[4], gv[5], gv[6], gv[7]);
    }
}

struct Params {
    const float* in[23];
    float* out;
    unsigned char* ws;
    unsigned* bar;
};

#define WS_BAR      0ull
#define WS_XALL     (1ull << 20)
#define WS_PROJ     (WS_XALL + (size_t)T_ALL * D_MODEL * 4)
#define WS_XBC      (WS_PROJ + (size_t)T_ALL * PROJ_LD * 4)
#define WS_DT       (WS_XBC + (size_t)T_ALL * CONV_DIM * 4)
#define WS_QROT     (WS_DT + (size_t)T_ALL * SSD_HEADS * 4)
#define WS_KROT     (WS_QROT + (size_t)T_ALL * ATT_WIDTH * 4)
#define WS_YBUF     (WS_KROT + (size_t)T_ALL * ATT_WIDTH * 4)
#define WS_MIX      (WS_YBUF + (size_t)T_ALL * MIX_WIDTH * 4)
#define WS_HBUF     (WS_MIX + (size_t)T_ALL * D_MODEL * 4)
#define WS_QH       (WS_HBUF + (size_t)T_ALL * D_MODEL * 4)
#define WS_EIDX     (WS_QH + (size_t)T_ALL * 2048 * 4)
#define WS_GATE     (WS_EIDX + (size_t)T_ALL * 128 * 4)
#define WS_A0       (WS_GATE + (size_t)T_ALL * 128 * 4)
#define WS_A1       (WS_A0 + (size_t)T_ALL * D_MODEL * 2)
#define WS_A2       (WS_A1 + (size_t)T_ALL * MIX_WIDTH * 2)
#define WS_WTIN     (WS_A2 + (size_t)T_ALL * D_MODEL * 2)
#define WS_WTOUT    (WS_WTIN + (size_t)PROJ_LD * D_MODEL * 2)
#define WS_WTQ      (WS_WTOUT + (size_t)D_MODEL * MIX_WIDTH * 2)
#define WS_PROJB    (WS_WTQ + (size_t)2048 * D_MODEL * 2)
#define WS_DTRAW    (WS_PROJB + (size_t)T_ALL * NB_LD * 2)
#define WS_XBCB     (WS_DTRAW + (size_t)T_ALL * 32 * 4)
#define WS_QROTB    (WS_XBCB + (size_t)T_ALL * CONV_DIM * 2)
#define WS_KROTB    (WS_QROTB + (size_t)T_ALL * ATT_WIDTH * 2)
#define WS_UB       (WS_KROTB + (size_t)T_ALL * ATT_WIDTH * 2)
#define WS_VB       (WS_UB + (size_t)16384 * D_MODEL * 2)
#define WS_USC      (WS_VB + (size_t)16384 * D_MODEL * 2)
#define WS_VSC      (WS_USC + 16384 * 4)
#define WS_SBUF     (WS_VSC + 16384 * 4)
#define WS_HIN      (WS_SBUF + (size_t)BATCH * 64 * SSD_HEADS * 64 * 128 * 2)
#define WS_CDEC     (WS_HIN + (size_t)BATCH * 64 * SSD_HEADS * 64 * 128 * 2)
#define WS_OBUF     (WS_CDEC + (size_t)BATCH * 64 * SSD_HEADS * 4)
#define WS_LSE      (WS_OBUF + (size_t)3 * T_PROMPT * ATT_WIDTH * 2)
#define WS_ROPE     (WS_LSE + (size_t)3 * T_PROMPT * 8 * 4)
#define WS_END      (WS_ROPE + (size_t)SEQ * 64 * 4)

#define LDS_BYTES (160 * 1024)
#define N9_SLICES 13440u

#define KP const __attribute__((address_space(4))) Params* kp = (const __attribute__((address_space(4))) Params*)__builtin_amdgcn_kernarg_segment_ptr(); asm volatile("" : "+s"(kp)); unsigned char* ws = kp->ws; (void)ws;
#define IN(i) (kp->in[i])
#define WSP(T, off) ((T*)(ws + (off)))
__global__ void __launch_bounds__(512, 2) mega_fwd(Params p) {
    extern __shared__ __attribute__((aligned(16))) unsigned char smem[];
    if (threadIdx.x == 0) *(uint4*)smem = make_uint4(0u, 0u, 0u, 0u);
    __syncthreads();
    XcdBarrier bar = xcd_barrier_post(p.bar, (volatile LAS unsigned*)smem);
    float* lds = (float*)(smem + 256);
    LAS unsigned char* ldsb = (LAS unsigned char*)smem + 256;

    { KP ph_prologue(ldsb, IN(0), IN(1), WSP(bf16, WS_A0), IN(6), WSP(bf16, WS_WTIN), WSP(float, WS_ROPE)); }
    xcd_barrier(bar);
    { KP pg8::Gemm g{WSP(bf16, WS_A0), WSP(bf16, WS_WTIN), T_ALL, PROJ_LD, D_MODEL}; pg8::StaticOrder S; S.init(g.M, g.N, (int)gridDim.x, (int)blockIdx.x);
      pg8::EpiProj E{WSP(bf16, WS_PROJB), WSP(float, WS_DTRAW)}; pg8::gemm_phase<pg8::EpiProj, pg8::StaticOrder, false>(ldsb, g, S, E, nullptr); }
    xcd_barrier(bar);
    { KP ph_post_proj_prompt(WSP(bf16, WS_PROJB), WSP(float, WS_DTRAW), IN(7), IN(8), IN(9), WSP(float, WS_ROPE), WSP(bf16, WS_XBCB), WSP(float, WS_DT), WSP(bf16, WS_QROTB), WSP(bf16, WS_KROTB), kp->out); }
    { KP ph_post_proj2(WSP(bf16, WS_PROJB), WSP(float, WS_DTRAW), IN(4), IN(7), IN(8), IN(9), WSP(bf16, WS_XBCB), WSP(float, WS_DT), WSP(bf16, WS_QROTB), WSP(bf16, WS_KROTB), kp->out); }
    xcd_barrier(bar);
    { KP ph_ssd_states(ldsb, WSP(bf16, WS_XBCB), WSP(float, WS_DT), IN(10), WSP(bf16, WS_SBUF), WSP(float, WS_CDEC)); }
    __syncthreads();
    { KP ph_attn_prompt(ldsb, WSP(bf16, WS_QROTB), WSP(bf16, WS_KROTB), WSP(bf16, WS_PROJB), WSP(bf16, WS_OBUF), WSP(float, WS_LSE)); }
    __syncthreads();
    { KP ph_ssd_decode(WSP(bf16, WS_XBCB), WSP(float, WS_DT), IN(10), IN(11), IN(5), WSP(float, WS_YBUF), kp->out); }
    { KP ph_attn_sample(lds, WSP(bf16, WS_QROTB), WSP(bf16, WS_KROTB), WSP(bf16, WS_PROJB), IN(2), IN(3), WSP(bf16, WS_A1)); }
    xcd_barrier(bar);
    if ((int)gridDim.x > 128) {
        if ((int)blockIdx.x < 96) { KP ph_ssd_scan(WSP(bf16, WS_SBUF), WSP(float, WS_CDEC), WSP(bf16, WS_HIN), kp->out, (int)blockIdx.x, 96); }
        else {
            { KP ph_prologue2(ldsb, IN(13), WSP(bf16, WS_WTOUT), IN(16), WSP(bf16, WS_WTQ), (int)blockIdx.x - 96, (int)gridDim.x - 96); }
            { KP ph_quant_tables(IN(19), IN(20), WSP(unsigned char, WS_UB), WSP(unsigned char, WS_VB), WSP(float, WS_USC), WSP(float, WS_VSC), (int)blockIdx.x - 96, (int)gridDim.x - 96); }
        }
    } else {
        { KP ph_ssd_scan(WSP(bf16, WS_SBUF), WSP(float, WS_CDEC), WSP(bf16, WS_HIN), kp->out, (int)blockIdx.x, (int)gridDim.x); }
        { KP ph_prologue2(ldsb, IN(13), WSP(bf16, WS_WTOUT), IN(16), WSP(bf16, WS_WTQ), (int)blockIdx.x, (int)gridDim.x); }
        { KP ph_quant_tables(IN(19), IN(20), WSP(unsigned char, WS_UB), WSP(unsigned char, WS_VB), WSP(float, WS_USC), WSP(float, WS_VSC), (int)blockIdx.x, (int)gridDim.x); }
    }
    xcd_barrier(bar);
    { KP ph_ssd_out(ldsb, WSP(bf16, WS_XBCB), WSP(bf16, WS_PROJB), WSP(float, WS_DT), IN(10), IN(11), IN(12), WSP(bf16, WS_HIN), WSP(bf16, WS_A1)); }
    { KP ph_attn_combine(WSP(bf16, WS_OBUF), WSP(float, WS_LSE), WSP(bf16, WS_A1)); }
    { KP ph_gate_norm(WSP(bf16, WS_PROJB), IN(12), WSP(float, WS_YBUF), WSP(bf16, WS_A1)); }
    xcd_barrier(bar);
    { KP pg8::Gemm g{WSP(bf16, WS_A1), WSP(bf16, WS_WTOUT), T_ALL, D_MODEL, MIX_WIDTH}; pg8::StaticOrder S; S.init(g.M, g.N, (int)gridDim.x, (int)blockIdx.x);
      pg8::EpiF32 E{WSP(float, WS_MIX), D_MODEL, nullptr}; pg8::gemm_phase<pg8::EpiF32, pg8::StaticOrder, false>(ldsb, g, S, E, nullptr); }
    if (blockIdx.x >= 8 && gridDim.x == 256) { KP cache_copy_slice(IN(2), IN(3), kp->out, N9_SLICES + (blockIdx.x - 8) * 8u + (threadIdx.x >> 6), threadIdx.x & 63u); }
    xcd_barrier(bar);
    { KP ph_ln_res(IN(0), IN(1), WSP(float, WS_MIX), IN(14), IN(15), WSP(float, WS_HBUF), WSP(bf16, WS_A2)); }
    xcd_barrier(bar);
    { KP pg8::Gemm g{WSP(bf16, WS_A2), WSP(bf16, WS_WTQ), T_ALL, 2048, D_MODEL}; pg8::StaticOrder S; S.init(g.M, g.N, (int)gridDim.x, (int)blockIdx.x);
      pg8::EpiBf16Plain E{WSP(bf16, WS_QH), 2048}; pg8::gemm_phase<pg8::EpiBf16Plain, pg8::StaticOrder, false>(ldsb, g, S, E, nullptr); }
    if (blockIdx.x >= 16 && gridDim.x == 256 && threadIdx.x < 256) { KP cache_copy_slice(IN(2), IN(3), kp->out, N9_SLICES + 1984u + (blockIdx.x - 16) * 4u + (threadIdx.x >> 6), threadIdx.x & 63u); }
    xcd_barrier(bar);
    { KP ph_peer_route2(ldsb, WSP(bf16, WS_QH), IN(17), IN(18), WSP(int, WS_EIDX), WSP(float, WS_GATE)); }
    xcd_barrier(bar);
    { KP ph_peer_ffn3(WSP(float, WS_HBUF), WSP(int, WS_EIDX), WSP(float, WS_GATE), WSP(unsigned char, WS_UB), WSP(unsigned char, WS_VB), WSP(float, WS_USC), WSP(float, WS_VSC), IN(21), IN(22), kp->out, IN(2), IN(3), gridDim.x == 256 ? N9_SLICES : 16384u); }
}

extern "C" void kernel_launch(void* const* d_in, const int* in_sizes, int n_in, void* d_out, int out_size, void* d_ws, size_t ws_size, hipStream_t stream) {
    static int grid = 0;
    if (grid == 0) {
        int dev = 0, cus = 0, per_cu = 0;
        if (hipGetDevice(&dev) != hipSuccess || hipDeviceGetAttribute(&cus, hipDeviceAttributeMultiprocessorCount, dev) != hipSuccess) { fprintf(stderr, "kernel_launch: device query failed\n"); grid = -1; return; }
        if (hipFuncSetAttribute((const void*)mega_fwd, hipFuncAttributeMaxDynamicSharedMemorySize, LDS_BYTES) != hipSuccess) { fprintf(stderr, "kernel_launch: hipFuncSetAttribute failed\n"); grid = -1; return; }
        if (hipOccupancyMaxActiveBlocksPerMultiprocessor(&per_cu, (const void*)mega_fwd, NTHR, LDS_BYTES) != hipSuccess || per_cu < 1) { fprintf(stderr, "kernel_launch: occupancy query says %d\n", per_cu); }
        (void)hipGetLastError();
        grid = cus;
        if (ws_size < WS_END) { fprintf(stderr, "kernel_launch: workspace too small\n"); grid = -1; return; }
    }
    if (grid < 0) return;
    (void)hipMemsetAsync((char*)d_ws + WS_BAR, 0, XCD_BAR_WORDS * sizeof(unsigned), stream);
    Params p{};
    for (int i = 0; i < 23; ++i) p.in[i] = (const float*)d_in[i];
    p.out = (float*)d_out; p.ws = (unsigned char*)d_ws; p.bar = (unsigned*)((char*)d_ws + WS_BAR);
    hipLaunchKernelGGL(mega_fwd, dim3(grid), dim3(NTHR), LDS_BYTES, stream, p);
}
```

```cpp
#include <hip/hip_runtime.h>
#include <stdint.h>

#define D_MODEL 1024
#define BATCH 2
#define SEQ 8192
#define DEC_BATCH 128
#define DEC_SEQ 4
#define PAST_LEN 8192
#define HEAD_DIM 64
#define ATT_WIDTH 512
#define ATT_HEADS 8
#define SSD_WIDTH 1536
#define SSD_HEADS 24
#define SSD_GROUPS 4
#define SSD_STATE 128
#define CONV_DIM 2560
#define IN_WIDTH 5656
#define PROJ_LD 5888
#define MIX_WIDTH 2048
#define WBUF 2048
#define PEER_NKEYS 128
#define PEER_HEADS 8
#define PEER_TOPK 16
#define PEER_DKEY 256
#define T_PROMPT (BATCH * SEQ)
#define T_SAMPLE (DEC_BATCH * DEC_SEQ)
#define T_ALL (T_PROMPT + T_SAMPLE)
#define O_Z 0
#define O_XBC 1536
#define O_DT 4096
#define O_Q 4120
#define O_K 4632
#define O_V 5144
#define ALPHA_F 1.189207115002721f
#define LN_EPS 1e-5f

#define OUT_YP 0ull
#define OUT_YS (OUT_YP + 16777216ull)
#define OUT_PK (OUT_YS + 524288ull)
#define OUT_PV (OUT_PK + 2097152ull)
#define OUT_PC (OUT_PV + 2097152ull)
#define OUT_PS (OUT_PC + 15360ull)
#define OUT_SK (OUT_PS + 393216ull)
#define OUT_SV (OUT_SK + 134217728ull)
#define OUT_SC (OUT_SV + 134217728ull)
#define OUT_SS (OUT_SC + 983040ull)

__constant__ double ROPE_INV_REV[32] = {
    1.59154943091895346e-01, 1.19349370211248862e-01, 8.94994016088910133e-02, 6.71150830052272551e-02,
    5.03292121044870353e-02, 3.77415847174197711e-02, 2.83021958306233987e-02, 2.12236527647776604e-02,
    1.59154943091895339e-02, 1.19349370211248862e-02, 8.94994016088910237e-03, 6.71150830052272534e-03,
    5.03292121044870370e-03, 3.77415847174197719e-03, 2.83021958306233987e-03, 2.12236527647776622e-03,
    1.59154943091895356e-03, 1.19349370211248849e-03, 8.94994016088910237e-04, 6.71150830052272599e-04,
    5.03292121044870326e-04, 3.77415847174197741e-04, 2.83021958306233954e-04, 2.12236527647776605e-04,
    1.59154943091895351e-04, 1.19349370211248862e-04, 8.94994016088910182e-05, 6.71150830052272545e-05,
    5.03292121044870354e-05, 3.77415847174197768e-05, 2.83021958306233961e-05, 2.12236527647776592e-05
};

__device__ __forceinline__ float silu_f(float x) { return x * __builtin_amdgcn_rcpf(1.0f + __expf(-x)); }
__device__ __forceinline__ float softplus_f(float x) { return fmaxf(x, 0.f) + log1pf(__expf(-fabsf(x))); }
__device__ __forceinline__ float gelu_f(float x) { return 0.5f * x * (1.0f + erff(x * 0.70710678118654752f)); }
__device__ __forceinline__ float wave_sum(float v) {
#pragma unroll
    for (int o = 32; o > 0; o >>= 1) v += __shfl_xor(v, o);
    return v;
}
__device__ __forceinline__ float wave_max(float v) {
#pragma unroll
    for (int o = 32; o > 0; o >>= 1) v = fmaxf(v, __shfl_xor(v, o));
    return v;
}

#include <cstdio>
#define XB_TMO      128
#define XB_XCNT(j)  (256  + 64 * (j))
#define XB_XSUB(j)  (1280 + 64 * (j))
#define XB_XGEN(j)  (2304 + 64 * (j))
#define XB_TOP      3328
#define XB_TOPGEN   3392
#define XCD_BAR_WORDS 3456
#define XB_SPIN_CAP (1u << 18)
#define LAS __attribute__((address_space(3)))

__device__ __forceinline__ unsigned xb_ld(unsigned* p)              { return __hip_atomic_load(p, __ATOMIC_RELAXED, __HIP_MEMORY_SCOPE_AGENT); }
__device__ __forceinline__ unsigned xb_add(unsigned* p, unsigned v) { return __hip_atomic_fetch_add(p, v, __ATOMIC_RELAXED, __HIP_MEMORY_SCOPE_AGENT); }
__device__ __forceinline__ unsigned xb_xcc_id() { return (unsigned)__builtin_amdgcn_s_getreg((3 << 11) | 20) & 0xFu; }
#define XB_SPIN(cond, bar) do { unsigned _sp = 0; while (cond) { __builtin_amdgcn_s_sleep(1); \
    if ((++_sp & 255u) == 0u) { if (xb_ld(&(bar)[XB_TMO])) break; if (_sp > XB_SPIN_CAP) { atomicAdd(&(bar)[XB_TMO], 1u); break; } } } } while (0)

struct XcdBarrier {
    unsigned* bar; unsigned x;
    volatile LAS unsigned* st;
};

__device__ __forceinline__ XcdBarrier xcd_barrier_post(unsigned* bar, volatile LAS unsigned* st) {
    XcdBarrier b; b.bar = bar; b.x = xb_xcc_id(); b.st = st;
    if (threadIdx.x == 0) (void)xb_add(&bar[XB_XCNT(b.x)], 1u);
    return b;
}
__device__ __forceinline__ void xcd_barrier_complete(unsigned* bar, unsigned x, unsigned& nloc, unsigned& nx) {
    const unsigned G = gridDim.x * gridDim.y * gridDim.z;
    unsigned sum, cnt, mine, sp = 0u;
    for (;;) {
        sum = 0u; cnt = 0u; mine = 0u;
#pragma unroll
        for (unsigned j = 0; j < 16; ++j) { const unsigned c = xb_ld(&bar[XB_XCNT(j)]); sum += c; cnt += (c > 0u) ? 1u : 0u; mine = (j == x) ? c : mine; }
        if (sum == G) break;
        __builtin_amdgcn_s_sleep(1);
        if ((++sp & 255u) == 0u) { if (xb_ld(&bar[XB_TMO])) break; if (sp > XB_SPIN_CAP) { atomicAdd(&bar[XB_TMO], 1u); break; } }
    }
    nloc = mine > 0u ? mine : 1u; nx = cnt > 0u ? cnt : 1u;
}

__device__ __forceinline__ void xcd_barrier(const XcdBarrier& b) {
    asm volatile("s_waitcnt vmcnt(0)" ::: "memory");
    __syncthreads();
    if (threadIdx.x == 0) {
        unsigned* bar = b.bar;
        __builtin_amdgcn_s_waitcnt(0);
        unsigned nloc = b.st[0], nx = b.st[1];
        if (nloc == 0u) { xcd_barrier_complete(bar, b.x, nloc, nx); b.st[0] = nloc; b.st[1] = nx; }
        const unsigned old = xb_add(&bar[XB_XSUB(b.x)], 1u);
        const unsigned gen = old / nloc;
        if (old + 1u == (gen + 1u) * nloc) {
            __builtin_amdgcn_fence(__ATOMIC_RELEASE, "agent");
            asm volatile("s_waitcnt vmcnt(0)" ::: "memory");
            const unsigned og = xb_add(&bar[XB_TOP], 1u);
            const unsigned tg = og / nx;
            if (og + 1u == (tg + 1u) * nx) xb_add(&bar[XB_TOPGEN], 1u);
            else XB_SPIN(xb_ld(&bar[XB_TOPGEN]) == tg, bar);
            __builtin_amdgcn_fence(__ATOMIC_ACQUIRE, "agent");
            xb_add(&bar[XB_XGEN(b.x)], 1u);
            asm volatile("s_waitcnt vmcnt(0)" ::: "memory");
        } else {
            XB_SPIN(xb_ld(&bar[XB_XGEN(b.x)]) == gen, bar);
            __builtin_amdgcn_fence(__ATOMIC_ACQUIRE, "agent");
            asm volatile("s_waitcnt vmcnt(0)" ::: "memory");
        }
    }
    __syncthreads();
}


#define GAS __attribute__((address_space(1)))
typedef unsigned short bf16;
typedef unsigned v4u __attribute__((ext_vector_type(4)));
#define LDS_WAIT() asm volatile("s_waitcnt lgkmcnt(0)" ::: "memory")
__device__ __forceinline__ unsigned f2bf(float f) { unsigned u = __builtin_bit_cast(unsigned, f); return (u + 0x7fffu + ((u >> 16) & 1u)) >> 16; }
__device__ __forceinline__ unsigned pk2(float lo, float hi) { return f2bf(lo) | (f2bf(hi) << 16); }
__device__ __forceinline__ float bf2f(unsigned short b) { return __builtin_bit_cast(float, (unsigned)b << 16); }
#include <hip/hip_runtime.h>
namespace pg8 {
#define PG8_LAS __attribute__((address_space(3)))
typedef unsigned short bf16_t;
typedef short bf16x8 __attribute__((ext_vector_type(8)));
typedef float f32x4 __attribute__((ext_vector_type(4)));
typedef unsigned u32x4 __attribute__((ext_vector_type(4)));
constexpr int BM = 256, BK = 64, HALF = 128, HTB = HALF * BK * 2  , STAGE_BYTES = 8 * HTB, NXCD = 8, WGM = 8;

__host__ __device__ __forceinline__ int lds_byte(int r, int c) { const int st = (r >> 4) * 2 + (c >> 5), rr = r & 15, cc = c & 31, ob = rr * 64 + cc * 2; return st * 1024 + (ob ^ (((ob >> 9) & 1) << 5)); }
__host__ __device__ __forceinline__ void stage_rc(int b, int& R, int& C) { const int st = b / 1024, sb = b % 1024, swz = sb ^ (((sb >> 9) & 1) << 5); R = (st >> 1) * 16 + swz / 64; C = (st & 1) * 32 + (swz % 64) / 2; }
__host__ __device__ __forceinline__ int perm32(int rho) { const int n = rho >> 4, i = rho & 15; return 8 * (i >> 2) + 4 * n + (i & 3); }

struct Unit { int pm, pn; };
struct Gemm { const bf16_t* A; const bf16_t* Bt; int M, N, K; };

struct StaticOrder {
    int nM, nN, nwg, G, c;
    __host__ __device__ void init(int M, int N, int G_, int c_) { nM = M / BM; nN = N / BM; nwg = nM * nN; G = G_; c = c_; }
    __host__ __device__ bool next(int i, Unit& u) const {
        const long L = (long)i * G + c; if (L >= nwg) return false;
        int wgid = (int)L; { const int q = nwg / NXCD, r = nwg % NXCD, xcd = wgid % NXCD, off = wgid / NXCD; wgid = (xcd < r ? xcd * (q + 1) : r * (q + 1) + (xcd - r) * q) + off; }
        const int nig = WGM * nN, gid = wgid / nig, fm = gid * WGM, gsz = (nM - fm) < WGM ? (nM - fm) : WGM;
        u.pm = fm + ((wgid % nig) % gsz); u.pn = (wgid % nig) / gsz; return true;
    }
    __device__ __forceinline__ void a_ready(const Unit&) const {}
    __device__ __forceinline__ void done(const Unit&) const {}
};
__device__ __forceinline__ unsigned cvt_pk_bf16(float lo, float hi) { unsigned r; asm volatile("v_cvt_pk_bf16_f32 %0, %1, %2" : "=v"(r) : "v"(lo), "v"(hi)); return r; }
typedef float f32x2 __attribute__((ext_vector_type(2)));
__device__ __forceinline__ f32x2 gelu_pk(f32x2 v) {
    const f32x2 av = __builtin_elementwise_abs(v), d = av * 0.2316418882f + 1.0f;
    f32x2 t; t.x = __builtin_amdgcn_rcpf(d.x); t.y = __builtin_amdgcn_rcpf(d.y);
    f32x2 q = t * 0.5307027145f + (-0.7265760135f); q = q * t + 0.7107068705f; q = q * t + (-0.142248368f); q = q * t + 0.127414796f; q = q * t;
    const f32x2 s = (v * v) * (-0.72134752044f);
    f32x2 e; e.x = __builtin_amdgcn_exp2f(s.x); e.y = __builtin_amdgcn_exp2f(s.y);
    const f32x2 m = v * (q * e), r = v - m;
    f32x2 o; o.x = v.x < 0.f ? m.x : r.x; o.y = v.y < 0.f ? m.y : r.y; return o;
}

struct EpiF32 {
    static constexpr bool PERM = false, AFTER_DRAIN = false;
    float* C; int ldc; const float* bias;
    __device__ __forceinline__ void operator()(const f32x4 (&acc)[2][2][4][2], const Unit& u, int wr, int wc, int fr, int fq) const {
        const int row0 = u.pm * BM + wr * 64 + fr, col0 = u.pn * BM + wc * 32 + 4 * fq;
        f32x4 bv[2][2];
#pragma unroll
        for (int bj = 0; bj < 2; ++bj)
#pragma unroll
            for (int n = 0; n < 2; ++n) bv[bj][n] = bias ? *(const f32x4*)(bias + col0 + bj * HALF + n * 16) : (f32x4){0.f, 0.f, 0.f, 0.f};
#pragma unroll
        for (int ai = 0; ai < 2; ++ai)
#pragma unroll
            for (int m = 0; m < 4; ++m) { float* rowp = C + (size_t)(row0 + ai * HALF + m * 16) * ldc + col0;
#pragma unroll
                for (int bj = 0; bj < 2; ++bj)
#pragma unroll
                    for (int n = 0; n < 2; ++n) *(f32x4*)(rowp + bj * HALF + n * 16) = acc[ai][bj][m][n] + bv[bj][n]; }
    }
};

template <class Epi, class Sched, bool STAMP = false>
__device__ __forceinline__ void gemm_phase(PG8_LAS unsigned char* lds, const Gemm g, const Sched& S, const Epi& E, unsigned long long* stamps) {
    const int tid = threadIdx.x, wid = __builtin_amdgcn_readfirstlane(tid >> 6), lane = tid & 63, wr = wid >> 2, wc = wid & 3, fr = lane & 15, fq = lane >> 4;
    const int K = g.K, nt = K / BK;
    int ts_lo = 0, ts_hi = 0, nts = 0; const unsigned long long rt_entry = STAMP ? (unsigned long long)wall_clock64() : 0ull;
#define PG8_STAMP() do { if (STAMP && wid == 0 && nts < 64) { const unsigned long long _c = (unsigned long long)clock64(); \
        ts_lo = (lane == nts) ? (int)(unsigned)_c : ts_lo; ts_hi = (lane == nts) ? (int)(unsigned)(_c >> 32) : ts_hi; ++nts; } } while (0)
    PG8_STAMP();
    unsigned voffA[2], voffB[2];
#pragma unroll
    for (int i = 0; i < 2; ++i) { int R, C; stage_rc(tid * 16 + i * 8192, R, C); const int Rb = Epi::PERM ? ((R & ~31) + perm32(R & 31)) : R;
        voffA[i] = (unsigned)(R * K + C) * 2u; voffB[i] = (unsigned)(Rb * K + C) * 2u; }
    const size_t kstep = (size_t)(BK * 2);
    const size_t hstep = (size_t)HALF * K * 2;
    const size_t tstep = 2 * hstep;
    const unsigned ldsw = (unsigned)wid * 1024u;
    const int aoff = lds_byte(wr * 64 + fr, fq * 8), boff = lds_byte(wc * 32 + fr, fq * 8);
#define PG8_SA(b, h) (((b) * 2 + (h)) * HTB)
#define PG8_SB(b, h) ((4 + (b) * 2 + (h)) * HTB)
#define PG8_STAGE(bufoff, gbase, voff) do { _Pragma("unroll") for (int _i = 0; _i < 2; ++_i) \
        __builtin_amdgcn_global_load_lds((const unsigned*)((const char*)(gbase) + (voff)[_i]), (PG8_LAS unsigned*)(lds + (bufoff) + ldsw + _i * 8192), 16, 0, 0); } while (0)
#define PG8_LDA(dst, b, h) do { _Pragma("unroll") for (int m = 0; m < 4; ++m) _Pragma("unroll") for (int k = 0; k < 2; ++k) dst[m][k] = *(const PG8_LAS bf16x8*)(lds + PG8_SA(b, h) + aoff + m * 2048 + k * 1024); } while (0)
#define PG8_LDB(dst, b, h) do { _Pragma("unroll") for (int n = 0; n < 2; ++n) _Pragma("unroll") for (int k = 0; k < 2; ++k) dst[n][k] = *(const PG8_LAS bf16x8*)(lds + PG8_SB(b, h) + boff + n * 2048 + k * 1024); } while (0)
#define PG8_MMA(ai, bj, At, Bt) do { __builtin_amdgcn_s_setprio(1); _Pragma("unroll") for (int m = 0; m < 4; ++m) _Pragma("unroll") for (int n = 0; n < 2; ++n) _Pragma("unroll") for (int k = 0; k < 2; ++k) \
        acc[ai][bj][m][n] = __builtin_amdgcn_mfma_f32_16x16x32_bf16(Bt[n][k], At[m][k], acc[ai][bj][m][n], 0, 0, 0); __builtin_amdgcn_s_setprio(0); } while (0)
#define PG8_WAIT_V(n) asm volatile("s_waitcnt vmcnt(" #n ")" ::: "memory")
#define PG8_WAIT_L(n) asm volatile("s_waitcnt lgkmcnt(" #n ")" ::: "memory")
#define PG8_BAR __builtin_amdgcn_s_barrier()
#define PG8_SCHED __builtin_amdgcn_sched_barrier(0)
    Unit cur, nxt; int ui = 0;
    if (!S.next(0, cur)) return;
    f32x4 acc[2][2][4][2];
#pragma unroll
    for (int a = 0; a < 2; ++a)
#pragma unroll
        for (int b = 0; b < 2; ++b)
#pragma unroll
            for (int m = 0; m < 4; ++m)
#pragma unroll
                for (int n = 0; n < 2; ++n) acc[a][b][m][n] = (f32x4){0.f, 0.f, 0.f, 0.f};
    bf16x8 At[4][2], B0[2][2], B1[2][2];
    const char* cA = (const char*)g.A + (size_t)cur.pm * tstep; const char* cB = (const char*)g.Bt + (size_t)cur.pn * tstep;
    S.a_ready(cur);
    PG8_STAGE(PG8_SB(0, 0), cB, voffB); PG8_STAGE(PG8_SA(0, 0), cA, voffA); PG8_STAGE(PG8_SB(0, 1), cB + hstep, voffB); PG8_STAGE(PG8_SA(0, 1), cA + hstep, voffA);
    if (wr == 1) PG8_BAR;
    PG8_WAIT_V(4); PG8_BAR;
    PG8_STAGE(PG8_SB(1, 0), cB + kstep, voffB); PG8_STAGE(PG8_SA(1, 0), cA + kstep, voffA); PG8_STAGE(PG8_SB(1, 1), cB + hstep + kstep, voffB);
    PG8_WAIT_V(6); PG8_BAR;
    PG8_STAMP();
    for (;;) {
        const bool has_next = S.next(ui + 1, nxt);
        const char* nA = has_next ? (const char*)g.A + (size_t)nxt.pm * tstep : cA; const char* nB = has_next ? (const char*)g.Bt + (size_t)nxt.pn * tstep : cB;
        for (int t = 0; t < nt; t += 2) {
            const bool last = (t == nt - 2);
            const char* a1 = cA + (size_t)(t + 1) * kstep;
            const char* a2 = last ? nA : cA + (size_t)(t + 2) * kstep; const char* b2 = last ? nB : cB + (size_t)(t + 2) * kstep;
            const char* a3 = a2 + kstep; const char* b3 = b2 + kstep;
            if (last && has_next) S.a_ready(nxt);
            PG8_LDB(B0, 0, 0); PG8_SCHED; PG8_LDA(At, 0, 0); PG8_STAGE(PG8_SA(1, 1), a1 + hstep, voffA);
            PG8_WAIT_L(8); PG8_BAR; PG8_WAIT_L(0); PG8_MMA(0, 0, At, B0); PG8_BAR; PG8_SCHED;
            PG8_LDB(B1, 0, 1); PG8_STAGE(PG8_SB(0, 0), b2, voffB);
            PG8_BAR; PG8_WAIT_L(0); PG8_MMA(0, 1, At, B1); PG8_BAR;
            PG8_LDA(At, 0, 1); PG8_STAGE(PG8_SA(0, 0), a2, voffA);
            PG8_BAR; PG8_WAIT_L(0); PG8_MMA(1, 0, At, B0); PG8_BAR; PG8_SCHED;
            PG8_STAGE(PG8_SB(0, 1), b2 + hstep, voffB);
            PG8_WAIT_V(6); PG8_BAR; PG8_MMA(1, 1, At, B1); PG8_BAR;
            PG8_LDB(B0, 1, 0); PG8_SCHED; PG8_LDA(At, 1, 0); PG8_STAGE(PG8_SA(0, 1), a2 + hstep, voffA);
            PG8_WAIT_L(8); PG8_BAR; PG8_WAIT_L(0); PG8_MMA(0, 0, At, B0); PG8_BAR; PG8_SCHED;
            PG8_LDB(B1, 1, 1); PG8_STAGE(PG8_SB(1, 0), b3, voffB);
            PG8_BAR; PG8_WAIT_L(0); PG8_MMA(0, 1, At, B1); PG8_BAR;
            PG8_LDA(At, 1, 1); PG8_STAGE(PG8_SA(1, 0), a3, voffA);
            PG8_BAR; PG8_WAIT_L(0); PG8_MMA(1, 0, At, B0); PG8_BAR; PG8_SCHED;
            PG8_STAGE(PG8_SB(1, 1), b3 + hstep, voffB);
            PG8_WAIT_V(6); PG8_BAR; PG8_MMA(1, 1, At, B1); PG8_BAR;
        }
        PG8_STAMP();
        if constexpr (!Epi::AFTER_DRAIN) { E(acc, cur, wr, wc, fr, fq); S.done(cur); }
        PG8_STAMP();
        if (!has_next) break;
#pragma unroll
        for (int a = 0; a < 2; ++a)
#pragma unroll
            for (int b = 0; b < 2; ++b)
#pragma unroll
                for (int m = 0; m < 4; ++m)
#pragma unroll
                    for (int n = 0; n < 2; ++n) acc[a][b][m][n] = (f32x4){0.f, 0.f, 0.f, 0.f};
        cur = nxt; cA = nA; cB = nB; ++ui;
    }
    PG8_WAIT_V(0);
    if (wr == 0) PG8_BAR;
    PG8_BAR;
    if constexpr (Epi::AFTER_DRAIN) { E.fused(acc, cur, wr, wc, fr, fq, lds, wid, lane); S.done(cur); }
    PG8_STAMP();
    if (STAMP && wid == 0) { stamps[lane] = lane < nts ? (((unsigned long long)(unsigned)ts_hi << 32) | (unsigned)ts_lo) : 0ull;
        if (lane == 62) stamps[62] = rt_entry; if (lane == 63) stamps[63] = (unsigned long long)wall_clock64(); }
#undef PG8_STAMP
#undef PG8_SA
#undef PG8_SB
#undef PG8_STAGE
#undef PG8_LDA
#undef PG8_LDB
#undef PG8_MMA
#undef PG8_WAIT_V
#undef PG8_WAIT_L
#undef PG8_BAR
#undef PG8_SCHED
}
}


namespace pg8 {
struct EpiProj {
    static constexpr bool PERM = true, AFTER_DRAIN = false;
    bf16_t* O; float* dtraw;
    __device__ __forceinline__ void operator()(const f32x4 (&acc)[2][2][4][2], const Unit& u, int wr, int wc, int fr, int fq) const {
        const int row0 = u.pm * BM + wr * 64 + fr;
        if (u.pn < 22) {
            const int col0 = u.pn * BM + wc * 32 + 8 * fq;
#pragma unroll
            for (int ai = 0; ai < 2; ++ai)
#pragma unroll
                for (int m = 0; m < 4; ++m) { bf16_t* rowp = O + (size_t)(row0 + ai * HALF + m * 16) * 5632 + col0;
#pragma unroll
                    for (int bj = 0; bj < 2; ++bj) { const f32x4 v0 = acc[ai][bj][m][0], v1 = acc[ai][bj][m][1];
                        u32x4 w; w.x = cvt_pk_bf16(v0[0], v0[1]); w.y = cvt_pk_bf16(v0[2], v0[3]); w.z = cvt_pk_bf16(v1[0], v1[1]); w.w = cvt_pk_bf16(v1[2], v1[3]);
                        *(u32x4*)(rowp + bj * HALF) = w; } }
        } else if (wc == 0) {
#pragma unroll
            for (int ai = 0; ai < 2; ++ai)
#pragma unroll
                for (int m = 0; m < 4; ++m) { float* rp = dtraw + (size_t)(row0 + ai * HALF + m * 16) * 32 + 8 * fq;
                    *(f32x4*)rp = acc[ai][0][m][0]; *(f32x4*)(rp + 4) = acc[ai][0][m][1]; }
        }
    }
};
}


namespace pg8 {
struct EpiBf16Plain {
    static constexpr bool PERM = true, AFTER_DRAIN = false;
    bf16_t* O; int ldc;
    __device__ __forceinline__ void operator()(const f32x4 (&acc)[2][2][4][2], const Unit& u, int wr, int wc, int fr, int fq) const {
        const int row0 = u.pm * BM + wr * 64 + fr, col0 = u.pn * BM + wc * 32 + 8 * fq;
#pragma unroll
        for (int ai = 0; ai < 2; ++ai)
#pragma unroll
            for (int m = 0; m < 4; ++m) { bf16_t* rowp = O + (size_t)(row0 + ai * HALF + m * 16) * ldc + col0;
#pragma unroll
                for (int bj = 0; bj < 2; ++bj) { const f32x4 v0 = acc[ai][bj][m][0], v1 = acc[ai][bj][m][1];
                    u32x4 w; w.x = cvt_pk_bf16(v0[0], v0[1]); w.y = cvt_pk_bf16(v0[2], v0[3]); w.z = cvt_pk_bf16(v1[0], v1[1]); w.w = cvt_pk_bf16(v1[2], v1[3]);
                    *(u32x4*)(rowp + bj * HALF) = w; } }
    }
};
}

#define NTHR 512
#define NWAVE 8

__device__ __forceinline__ void ph_gemm_f32(float* lds, const float* __restrict__ A, const float* __restrict__ B, float* __restrict__ C,
                                            int M, int N, int K, int lda, int ldb, int ldc) {
    const int tid = threadIdx.x & 255, half = threadIdx.x >> 8, tx = tid & 15, ty = tid >> 4;
    float (*As)[68] = (float (*)[68])(lds + half * 2 * 16 * 68);
    float (*Bs)[68] = (float (*)[68])(lds + half * 2 * 16 * 68 + 16 * 68);
    const int ntx = (N + 63) / 64, nty = M / 64, ntiles = ntx * nty;
    for (int it = blockIdx.x; 2 * it < ntiles; it += gridDim.x) {
        const int tile = 2 * it + half;
        const int m0 = (tile / ntx) * 64, n0 = (tile % ntx) * 64;
        float acc[4][4];
#pragma unroll
        for (int i = 0; i < 4; ++i)
#pragma unroll
            for (int j = 0; j < 4; ++j) acc[i][j] = 0.f;
        for (int k0 = 0; k0 < K; k0 += 16) {
#pragma unroll
            for (int i = 0; i < 4; ++i) {
                int idx = tid + i * 256;
                int r = idx >> 4, c = idx & 15;
                As[c][r] = (m0 + r < M) ? A[(size_t)(m0 + r) * lda + k0 + c] : 0.f;
                int rb = idx >> 6, cb = idx & 63;
                Bs[rb][cb] = (n0 + cb < N) ? B[(size_t)(k0 + rb) * ldb + n0 + cb] : 0.f;
            }
            __syncthreads();
#pragma unroll
            for (int k = 0; k < 16; ++k) {
                float a[4], b[4];
#pragma unroll
                for (int i = 0; i < 4; ++i) { a[i] = As[k][ty * 4 + i]; b[i] = Bs[k][tx * 4 + i]; }
#pragma unroll
                for (int i = 0; i < 4; ++i)
#pragma unroll
                    for (int j = 0; j < 4; ++j) acc[i][j] += a[i] * b[j];
            }
            __syncthreads();
        }
#pragma unroll
        for (int i = 0; i < 4; ++i)
#pragma unroll
            for (int j = 0; j < 4; ++j) {
                int r = m0 + ty * 4 + i, c = n0 + tx * 4 + j;
                if (r < M && c < N) C[(size_t)r * ldc + c] = acc[i][j];
            }
    }
}


template <int MODE>
__device__ __forceinline__ void transpose_item(const float* __restrict__ W, int K, int N, int Npad, bf16* __restrict__ WT, LAS float* scr, int item, int lane) {
    const int nblk = Npad / 32, kb = item / nblk, nb = item % nblk, k0 = 64 * kb, n0 = 32 * nb;
    const int n = n0 + (lane & 31);
    int sc = n;
    if (MODE == 1) sc = (n < 4096) ? n : (n < 5632 ? n + 24 : (n < 5656 ? n - 5632 + 4096 : -1));
    else sc = (n < N) ? n : -1;
#pragma unroll 8
    for (int i = 0; i < 32; ++i) { const int kk = 2 * i + (lane >> 5); scr[kk * 33 + (lane & 31)] = (sc >= 0) ? W[(size_t)(k0 + kk) * N + sc] : 0.f; }
    LDS_WAIT(); asm volatile("" ::: "memory");
    const int c = lane & 7;
#pragma unroll
    for (int j = 0; j < 4; ++j) { const int nn = (lane >> 3) + 8 * j; const LAS float* s = scr + (8 * c) * 33 + nn;
        v4u o; o.x = pk2(s[0 * 33], s[1 * 33]); o.y = pk2(s[2 * 33], s[3 * 33]); o.z = pk2(s[4 * 33], s[5 * 33]); o.w = pk2(s[6 * 33], s[7 * 33]);
        *(v4u*)(WT + (size_t)(n0 + nn) * K + k0 + 8 * c) = o; }
    LDS_WAIT(); asm volatile("" ::: "memory");
}
__device__ __forceinline__ void ph_prologue(LAS unsigned char* ldsb, const float* __restrict__ xp, const float* __restrict__ xs, bf16* __restrict__ A0,
                                            const float* __restrict__ w_in, bf16* __restrict__ wt_in, float* __restrict__ rope_tab) {
    const int lane = threadIdx.x & 63, wave = threadIdx.x >> 6;
    LAS float* scr = (LAS float*)(ldsb + wave * 16384);
    const int gw = blockIdx.x * NWAVE + wave, NGW = gridDim.x * NWAVE;
    constexpr int I_IN = (D_MODEL / 64) * (PROJ_LD / 32);
    for (int it = gw; it < I_IN; it += NGW) transpose_item<1>(w_in, D_MODEL, IN_WIDTH, PROJ_LD, wt_in, scr, it, lane);
    for (int idx = blockIdx.x * NTHR + threadIdx.x; idx < SEQ * 32; idx += gridDim.x * NTHR) {
        const int pos = idx >> 5, j = idx & 31;
        const double rev = (double)pos * ROPE_INV_REV[j];
        const float fr = (float)(rev - floor(rev));
        rope_tab[(size_t)pos * 64 + j] = __builtin_amdgcn_cosf(fr); rope_tab[(size_t)pos * 64 + 32 + j] = __builtin_amdgcn_sinf(fr);
    }
    const size_t n8 = (size_t)T_ALL * D_MODEL / 8, np8 = (size_t)T_PROMPT * D_MODEL / 8;
#pragma unroll 4
    for (size_t i = (size_t)blockIdx.x * NTHR + threadIdx.x; i < n8; i += (size_t)gridDim.x * NTHR) {
        const float4* s = (i < np8) ? (const float4*)xp + 2 * i : (const float4*)xs + 2 * (i - np8);
        float4 a = s[0], b = s[1];
        v4u o; o.x = pk2(a.x, a.y); o.y = pk2(a.z, a.w); o.z = pk2(b.x, b.y); o.w = pk2(b.z, b.w);
        ((v4u*)A0)[i] = o;
    }
}
__device__ __forceinline__ void ph_prologue2(LAS unsigned char* ldsb, const float* __restrict__ w_out, bf16* __restrict__ wt_out, const float* __restrict__ w_q, bf16* __restrict__ wt_q,
                                             int rank, int nranks) {
    const int lane = threadIdx.x & 63, wave = threadIdx.x >> 6;
    LAS float* scr = (LAS float*)(ldsb + wave * 16384);
    constexpr int I_OUT = (MIX_WIDTH / 64) * (D_MODEL / 32), I_Q = (D_MODEL / 64) * (2048 / 32);
    for (int it = rank * NWAVE + wave; it < I_OUT + I_Q; it += nranks * NWAVE) {
        if (it < I_OUT) transpose_item<0>(w_out, MIX_WIDTH, D_MODEL, D_MODEL, wt_out, scr, it, lane);
        else transpose_item<0>(w_q, D_MODEL, 2048, 2048, wt_q, scr, it - I_OUT, lane);
    }
}

__device__ __forceinline__ void ph_concat_x(const float* __restrict__ xp, const float* __restrict__ xs, float* __restrict__ xall) {
    const size_t n4 = (size_t)T_ALL * D_MODEL / 4, np4 = (size_t)T_PROMPT * D_MODEL / 4;
    for (size_t i = (size_t)blockIdx.x * NTHR + threadIdx.x; i < n4; i += (size_t)gridDim.x * NTHR) {
        float4 v = (i < np4) ? ((const float4*)xp)[i] : ((const float4*)xs)[i - np4];
        ((float4*)xall)[i] = v;
    }
}

typedef float f32x4n __attribute__((ext_vector_type(4)));
__device__ __forceinline__ void ph_cache_copy(const float* __restrict__ ck, const float* __restrict__ cv, float* __restrict__ out) {
    constexpr unsigned PER_B = (WBUF - DEC_SEQ) * ATT_WIDTH / 4;
    constexpr unsigned TOTAL = 2u * DEC_BATCH * PER_B;
    for (unsigned c = blockIdx.x; c < TOTAL / 4096u; c += gridDim.x) {
        f32x4n v[8]; size_t dsti[8]; bool isv[8];
#pragma unroll
        for (int j = 0; j < 8; ++j) {
            const unsigned idx = c * 4096u + j * 512u + threadIdx.x;
            const unsigned tb = idx / PER_B, r = idx - tb * PER_B, bb = tb & (DEC_BATCH - 1);
            isv[j] = tb >= DEC_BATCH;
            const size_t srci = (size_t)bb * (WBUF * ATT_WIDTH / 4) + (DEC_SEQ * ATT_WIDTH / 4) + r;
            dsti[j] = (size_t)bb * (WBUF * ATT_WIDTH / 4) + r;
            v[j] = __builtin_nontemporal_load((isv[j] ? (const f32x4n*)cv : (const f32x4n*)ck) + srci);
        }
#pragma unroll
        for (int j = 0; j < 8; ++j) __builtin_nontemporal_store(v[j], (f32x4n*)(out + (isv[j] ? OUT_SV : OUT_SK)) + dsti[j]);
    }
}

__device__ __forceinline__ void ph_post_proj(const float* __restrict__ proj, const float* __restrict__ state_conv,
                                             const float* __restrict__ conv_w, const float* __restrict__ conv_b, const float* __restrict__ dt_bias,
                                             float* __restrict__ xbc_act, float* __restrict__ dtv, float* __restrict__ qrot, float* __restrict__ krot,
                                             float* __restrict__ out) {
    const int tid = threadIdx.x & 255, half = threadIdx.x >> 8;
    for (int t = 2 * blockIdx.x + half; t < T_ALL; t += 2 * gridDim.x) {
        const bool is_p = t < T_PROMPT;
        int b, i, pos;
        if (is_p) { b = t / SEQ; i = t % SEQ; pos = i; } else { int ts = t - T_PROMPT; b = ts / DEC_SEQ; i = ts % DEC_SEQ; pos = PAST_LEN + i; }
        const float* row = proj + (size_t)t * PROJ_LD;
        for (int c = tid; c < CONV_DIM; c += 256) {
            float acc = conv_b[c];
#pragma unroll
            for (int tap = 0; tap < 4; ++tap) {
                int r = i - 3 + tap;
                float val;
                if (r >= 0) val = proj[(size_t)(t - i + r) * PROJ_LD + O_XBC + c];
                else val = is_p ? 0.f : state_conv[((size_t)b * 3 + (3 + r)) * CONV_DIM + c];
                acc += val * conv_w[tap * CONV_DIM + c];
            }
            xbc_act[(size_t)t * CONV_DIM + c] = silu_f(acc);
        }
        if (tid < SSD_HEADS) dtv[(size_t)t * SSD_HEADS + tid] = softplus_f(row[O_DT + tid] + dt_bias[tid]);
        for (int idx = tid; idx < 512; idx += 256) {
            int which = idx >> 8, h = (idx >> 5) & 7, j = idx & 31;
            double rev = (double)pos * ROPE_INV_REV[j];
            float fr = (float)(rev - floor(rev));
            float sn = __builtin_amdgcn_sinf(fr), cs = __builtin_amdgcn_cosf(fr);
            const float* src = row + (which ? O_K : O_Q) + h * 64;
            float t1 = src[j], t2 = src[j + 32];
            float o1 = t1 * cs - t2 * sn, o2 = t2 * cs + t1 * sn;
            float* dst = (which ? krot : qrot) + (size_t)t * ATT_WIDTH + h * 64;
            dst[j] = o1; dst[j + 32] = o2;
            if (which) {
                if (is_p) { if (i >= SEQ - WBUF) { float* o = out + OUT_PK + ((size_t)b * WBUF + (i - (SEQ - WBUF))) * ATT_WIDTH + h * 64; o[j] = o1; o[j + 32] = o2; } }
                else { float* o = out + OUT_SK + ((size_t)b * WBUF + (WBUF - DEC_SEQ + i)) * ATT_WIDTH + h * 64; o[j] = o1; o[j + 32] = o2; }
            }
        }
        for (int c = tid; c < ATT_WIDTH; c += 256) {
            float v = row[O_V + c];
            if (is_p) { if (i >= SEQ - WBUF) out[OUT_PV + ((size_t)b * WBUF + (i - (SEQ - WBUF))) * ATT_WIDTH + c] = v; }
            else out[OUT_SV + ((size_t)b * WBUF + (WBUF - DEC_SEQ + i)) * ATT_WIDTH + c] = v;
        }
        if (is_p) {
            if (i >= SEQ - 3) { int r = i - (SEQ - 3); for (int c = tid; c < CONV_DIM; c += 256) out[OUT_PC + ((size_t)b * 3 + r) * CONV_DIM + c] = row[O_XBC + c]; }
        } else {
            if (i >= 1) { int r = i - 1; for (int c = tid; c < CONV_DIM; c += 256) out[OUT_SC + ((size_t)b * 3 + r) * CONV_DIM + c] = row[O_XBC + c]; }
        }
    }
}


#define NB_LD 5632
#define NB_XBC 1536
#define NB_Q 4096
#define NB_K 4608
#define NB_V 5120
__device__ __forceinline__ void unpack8(const v4u w, float (&f)[8]) {
    f[0] = __builtin_bit_cast(float, w.x << 16); f[1] = __builtin_bit_cast(float, w.x & 0xffff0000u);
    f[2] = __builtin_bit_cast(float, w.y << 16); f[3] = __builtin_bit_cast(float, w.y & 0xffff0000u);
    f[4] = __builtin_bit_cast(float, w.z << 16); f[5] = __builtin_bit_cast(float, w.z & 0xffff0000u);
    f[6] = __builtin_bit_cast(float, w.w << 16); f[7] = __builtin_bit_cast(float, w.w & 0xffff0000u);
}
__device__ __forceinline__ void store8f(float* d, const float (&f)[8]) { *(float4*)d = make_float4(f[0], f[1], f[2], f[3]); *(float4*)(d + 4) = make_float4(f[4], f[5], f[6], f[7]); }
__device__ __forceinline__ void ph_post_proj2(const bf16* __restrict__ projb, const float* __restrict__ dtraw, const float* __restrict__ state_conv,
                                              const float* __restrict__ conv_w, const float* __restrict__ conv_b, const float* __restrict__ dt_bias,
                                              bf16* __restrict__ xbc_b, float* __restrict__ dtv, bf16* __restrict__ qrot_b, bf16* __restrict__ krot_b,
                                              float* __restrict__ out) {
    const int tid = threadIdx.x & 255, half = threadIdx.x >> 8;
    for (int t = T_PROMPT + 2 * blockIdx.x + half; t < T_ALL; t += 2 * gridDim.x) {
        const bool is_p = t < T_PROMPT;
        int b, i, pos;
        if (is_p) { b = t / SEQ; i = t % SEQ; pos = i; } else { int ts = t - T_PROMPT; b = ts / DEC_SEQ; i = ts % DEC_SEQ; pos = PAST_LEN + i; }
        const bf16* row = projb + (size_t)t * NB_LD;
        if (tid < 64) {
            float f[8]; unpack8(*(const v4u*)(row + NB_V + tid * 8), f);
            if (is_p) { if (i >= SEQ - WBUF) store8f(out + OUT_PV + ((size_t)b * WBUF + (i - (SEQ - WBUF))) * ATT_WIDTH + tid * 8, f); }
            else store8f(out + OUT_SV + ((size_t)b * WBUF + (WBUF - DEC_SEQ + i)) * ATT_WIDTH + tid * 8, f);
        }
        for (int c8 = tid; c8 < 320; c8 += 256) {
            const int c = c8 * 8;
            float acc[8], cur[8];
            { const float4 b0 = *(const float4*)(conv_b + c), b1 = *(const float4*)(conv_b + c + 4);
              acc[0] = b0.x; acc[1] = b0.y; acc[2] = b0.z; acc[3] = b0.w; acc[4] = b1.x; acc[5] = b1.y; acc[6] = b1.z; acc[7] = b1.w; }
#pragma unroll
            for (int tap = 0; tap < 4; ++tap) {
                const int r = i - 3 + tap;
                float val[8];
                if (r >= 0) unpack8(*(const v4u*)(projb + (size_t)(t - i + r) * NB_LD + NB_XBC + c), val);
                else if (!is_p) { const float* sp = state_conv + ((size_t)b * 3 + (3 + r)) * CONV_DIM + c; const float4 s0 = *(const float4*)sp, s1 = *(const float4*)(sp + 4);
                    val[0] = s0.x; val[1] = s0.y; val[2] = s0.z; val[3] = s0.w; val[4] = s1.x; val[5] = s1.y; val[6] = s1.z; val[7] = s1.w; }
                else {
#pragma unroll
                    for (int j = 0; j < 8; ++j) val[j] = 0.f; }
                const float4 w0 = *(const float4*)(conv_w + tap * CONV_DIM + c), w1 = *(const float4*)(conv_w + tap * CONV_DIM + c + 4);
                acc[0] += val[0] * w0.x; acc[1] += val[1] * w0.y; acc[2] += val[2] * w0.z; acc[3] += val[3] * w0.w;
                acc[4] += val[4] * w1.x; acc[5] += val[5] * w1.y; acc[6] += val[6] * w1.z; acc[7] += val[7] * w1.w;
                if (tap == 3) {
#pragma unroll
                    for (int j = 0; j < 8; ++j) cur[j] = val[j]; }
            }
#pragma unroll
            for (int j = 0; j < 8; ++j) acc[j] = silu_f(acc[j]);
            v4u o; o.x = pk2(acc[0], acc[1]); o.y = pk2(acc[2], acc[3]); o.z = pk2(acc[4], acc[5]); o.w = pk2(acc[6], acc[7]);
            *(v4u*)(xbc_b + (size_t)t * CONV_DIM + c) = o;
            if (is_p) { if (i >= SEQ - 3) store8f(out + OUT_PC + ((size_t)b * 3 + (i - (SEQ - 3))) * CONV_DIM + c, cur); }
            else { if (i >= 1) store8f(out + OUT_SC + ((size_t)b * 3 + (i - 1)) * CONV_DIM + c, cur); }
        }
        if (tid < SSD_HEADS) dtv[(size_t)t * SSD_HEADS + tid] = softplus_f(dtraw[(size_t)t * 32 + tid] + dt_bias[tid]);
        if (tid < 128) {
            const int which = tid >> 6, h = (tid >> 3) & 7, jc = tid & 7;
            const bf16* src = row + (which ? NB_K : NB_Q) + h * 64 + jc * 4;
            const uint2 lo = *(const uint2*)src, hi = *(const uint2*)(src + 32);
            float t1[4], t2[4], o1[4], o2[4];
            t1[0] = __builtin_bit_cast(float, lo.x << 16); t1[1] = __builtin_bit_cast(float, lo.x & 0xffff0000u); t1[2] = __builtin_bit_cast(float, lo.y << 16); t1[3] = __builtin_bit_cast(float, lo.y & 0xffff0000u);
            t2[0] = __builtin_bit_cast(float, hi.x << 16); t2[1] = __builtin_bit_cast(float, hi.x & 0xffff0000u); t2[2] = __builtin_bit_cast(float, hi.y << 16); t2[3] = __builtin_bit_cast(float, hi.y & 0xffff0000u);
#pragma unroll
            for (int e = 0; e < 4; ++e) {
                const double rev = (double)pos * ROPE_INV_REV[jc * 4 + e];
                const float fr = (float)(rev - floor(rev));
                const float sn = __builtin_amdgcn_sinf(fr), cs = __builtin_amdgcn_cosf(fr);
                o1[e] = t1[e] * cs - t2[e] * sn; o2[e] = t2[e] * cs + t1[e] * sn;
            }
            const size_t doff = (size_t)t * ATT_WIDTH + h * 64 + jc * 4;
            bf16* db = which ? krot_b : qrot_b;
            *(uint2*)(db + doff) = make_uint2(pk2(o1[0], o1[1]), pk2(o1[2], o1[3])); *(uint2*)(db + doff + 32) = make_uint2(pk2(o2[0], o2[1]), pk2(o2[2], o2[3]));
            if (which) {
                float* o = nullptr;
                if (is_p) { if (i >= SEQ - WBUF) o = out + OUT_PK + ((size_t)b * WBUF + (i - (SEQ - WBUF))) * ATT_WIDTH + h * 64 + jc * 4; }
                else o = out + OUT_SK + ((size_t)b * WBUF + (WBUF - DEC_SEQ + i)) * ATT_WIDTH + h * 64 + jc * 4;
                if (o) { *(float4*)o = make_float4(o1[0], o1[1], o1[2], o1[3]); *(float4*)(o + 32) = make_float4(o2[0], o2[1], o2[2], o2[3]); }
            }
        }
    }
}


__device__ __forceinline__ void ph_post_proj_prompt(const bf16* __restrict__ projb, const float* __restrict__ dtraw, const float* __restrict__ conv_w, const float* __restrict__ conv_b,
                                                    const float* __restrict__ dt_bias, const float* __restrict__ rope_tab, bf16* __restrict__ xbc_b, float* __restrict__ dtv,
                                                    bf16* __restrict__ qrot_b, bf16* __restrict__ krot_b, float* __restrict__ out) {
    const int gtid = blockIdx.x * NTHR + threadIdx.x, gsz = gridDim.x * NTHR;
    for (int item = gtid; item < (T_PROMPT / 16) * 320; item += gsz) {
        const int run = item / 320, c = (item - run * 320) * 8, t0 = run * 16, i0 = t0 & (SEQ - 1), b = t0 >> 13;
        float w[4][8], bias[8];
#pragma unroll
        for (int tap = 0; tap < 4; ++tap) { const float4 w0 = *(const float4*)(conv_w + tap * CONV_DIM + c), w1 = *(const float4*)(conv_w + tap * CONV_DIM + c + 4);
            w[tap][0] = w0.x; w[tap][1] = w0.y; w[tap][2] = w0.z; w[tap][3] = w0.w; w[tap][4] = w1.x; w[tap][5] = w1.y; w[tap][6] = w1.z; w[tap][7] = w1.w; }
        { const float4 b0 = *(const float4*)(conv_b + c), b1 = *(const float4*)(conv_b + c + 4);
          bias[0] = b0.x; bias[1] = b0.y; bias[2] = b0.z; bias[3] = b0.w; bias[4] = b1.x; bias[5] = b1.y; bias[6] = b1.z; bias[7] = b1.w; }
        const bf16* src = projb + (size_t)t0 * NB_LD + NB_XBC + c;
        v4u raw[19];
#pragma unroll
        for (int s = 0; s < 19; ++s) { v4u z; z.x = 0u; z.y = 0u; z.z = 0u; z.w = 0u; raw[s] = (s >= 3 || i0 != 0) ? *(const v4u*)(src + (ptrdiff_t)(s - 3) * NB_LD) : z; }
        float p0[8], p1[8], p2[8];
        unpack8(raw[0], p0); unpack8(raw[1], p1); unpack8(raw[2], p2);
#pragma unroll
        for (int s = 0; s < 16; ++s) {
            float cur[8], acc[8]; unpack8(raw[s + 3], cur);
#pragma unroll
            for (int j = 0; j < 8; ++j) acc[j] = silu_f(bias[j] + p0[j] * w[0][j] + p1[j] * w[1][j] + p2[j] * w[2][j] + cur[j] * w[3][j]);
            v4u o; o.x = pk2(acc[0], acc[1]); o.y = pk2(acc[2], acc[3]); o.z = pk2(acc[4], acc[5]); o.w = pk2(acc[6], acc[7]);
            *(v4u*)(xbc_b + (size_t)(t0 + s) * CONV_DIM + c) = o;
            if (i0 + s >= SEQ - 3) store8f(out + OUT_PC + ((size_t)b * 3 + (i0 + s - (SEQ - 3))) * CONV_DIM + c, cur);
#pragma unroll
            for (int j = 0; j < 8; ++j) { p0[j] = p1[j]; p1[j] = p2[j]; p2[j] = cur[j]; }
        }
    }
#pragma unroll 4
    for (int item = gtid; item < T_PROMPT * 128; item += gsz) {
        const int t = item >> 7, sub = item & 127, which = sub >> 6, h = (sub >> 3) & 7, jc = sub & 7, i = t & (SEQ - 1), b = t >> 13;
        const bf16* src = projb + (size_t)t * NB_LD + (which ? NB_K : NB_Q) + h * 64 + jc * 4;
        const uint2 lo = *(const uint2*)src, hi = *(const uint2*)(src + 32);
        const float4 cs = *(const float4*)(rope_tab + (size_t)i * 64 + jc * 4), sn = *(const float4*)(rope_tab + (size_t)i * 64 + 32 + jc * 4);
        float t1[4], t2[4], o1[4], o2[4];
        t1[0] = __builtin_bit_cast(float, lo.x << 16); t1[1] = __builtin_bit_cast(float, lo.x & 0xffff0000u); t1[2] = __builtin_bit_cast(float, lo.y << 16); t1[3] = __builtin_bit_cast(float, lo.y & 0xffff0000u);
        t2[0] = __builtin_bit_cast(float, hi.x << 16); t2[1] = __builtin_bit_cast(float, hi.x & 0xffff0000u); t2[2] = __builtin_bit_cast(float, hi.y << 16); t2[3] = __builtin_bit_cast(float, hi.y & 0xffff0000u);
        const float cv[4] = {cs.x, cs.y, cs.z, cs.w}, sv[4] = {sn.x, sn.y, sn.z, sn.w};
#pragma unroll
        for (int e = 0; e < 4; ++e) { o1[e] = t1[e] * cv[e] - t2[e] * sv[e]; o2[e] = t2[e] * cv[e] + t1[e] * sv[e]; }
        const size_t doff = (size_t)t * ATT_WIDTH + h * 64 + jc * 4;
        bf16* db = which ? krot_b : qrot_b;
        *(uint2*)(db + doff) = make_uint2(pk2(o1[0], o1[1]), pk2(o1[2], o1[3])); *(uint2*)(db + doff + 32) = make_uint2(pk2(o2[0], o2[1]), pk2(o2[2], o2[3]));
        if (which && i >= SEQ - WBUF) {
            float* o = out + OUT_PK + ((size_t)b * WBUF + (i - (SEQ - WBUF))) * ATT_WIDTH + h * 64 + jc * 4;
            *(float4*)o = make_float4(o1[0], o1[1], o1[2], o1[3]); *(float4*)(o + 32) = make_float4(o2[0], o2[1], o2[2], o2[3]);
        }
    }
#pragma unroll 4
    for (int item = gtid; item < T_PROMPT * SSD_HEADS; item += gsz) { const int t = item / SSD_HEADS, hd = item - t * SSD_HEADS; dtv[item] = softplus_f(dtraw[(size_t)t * 32 + hd] + dt_bias[hd]); }
#pragma unroll 2
    for (int item = gtid; item < BATCH * WBUF * 64; item += gsz) {
        const int ch = item & 63, j = (item >> 6) & (WBUF - 1), b = item >> 17;
        float f[8]; unpack8(*(const v4u*)(projb + (size_t)(b * SEQ + (SEQ - WBUF) + j) * NB_LD + NB_V + ch * 8), f);
        store8f(out + OUT_PV + ((size_t)b * WBUF + j) * ATT_WIDTH + ch * 8, f);
    }
}

#define SSD_CH 32
__device__ __forceinline__ void ph_ssd_naive(float* lds, const bf16* __restrict__ xbc_act, const float* __restrict__ dtv, const float* __restrict__ a_log,
                                             const float* __restrict__ d_skip, const float* __restrict__ state_ssm, float* __restrict__ ybuf, float* __restrict__ out) {
    float (*sx)[64] = (float (*)[64])lds;
    float (*sB)[128] = (float (*)[128])(lds + SSD_CH * 64);
    float (*sC)[128] = (float (*)[128])(lds + SSD_CH * 64 + SSD_CH * 128);
    float* sdt = lds + SSD_CH * 64 + 2 * SSD_CH * 128;
    const int tid = threadIdx.x, p = tid >> 3, ng = tid & 7;
    for (int vb = BATCH * SSD_HEADS + blockIdx.x; vb < (BATCH + DEC_BATCH) * SSD_HEADS; vb += gridDim.x) {
        const int seq = vb / SSD_HEADS, h = vb % SSD_HEADS, g = h / 6;
        const bool is_p = seq < BATCH;
        const int L = is_p ? SEQ : DEC_SEQ;
        const int t0 = is_p ? seq * SEQ : T_PROMPT + (seq - BATCH) * DEC_SEQ;
        const float A = -__expf(a_log[h]);
        const float D = d_skip[h];
        float hs[16];
        if (is_p) {
#pragma unroll
            for (int j = 0; j < 16; ++j) hs[j] = 0.f;
        } else {
            const float* s0 = state_ssm + (((size_t)(seq - BATCH) * SSD_HEADS + h) * 64 + p) * 128 + ng * 16;
#pragma unroll
            for (int j = 0; j < 16; ++j) hs[j] = s0[j];
        }
        for (int c0 = 0; c0 < L; c0 += SSD_CH) {
            const int nst = (L - c0) < SSD_CH ? (L - c0) : SSD_CH;
            __syncthreads();
            for (int idx = tid; idx < nst * 64; idx += NTHR) { int s = idx >> 6, c = idx & 63; sx[s][c] = bf2f(xbc_act[(size_t)(t0 + c0 + s) * CONV_DIM + h * 64 + c]); }
            for (int idx = tid; idx < nst * 128; idx += NTHR) { int s = idx >> 7, c = idx & 127;
                sB[s][c] = bf2f(xbc_act[(size_t)(t0 + c0 + s) * CONV_DIM + 1536 + g * 128 + c]);
                sC[s][c] = bf2f(xbc_act[(size_t)(t0 + c0 + s) * CONV_DIM + 2048 + g * 128 + c]); }
            if (tid < nst) sdt[tid] = dtv[(size_t)(t0 + c0 + tid) * SSD_HEADS + h];
            __syncthreads();
            for (int s = 0; s < nst; ++s) {
                const float dt = sdt[s], x = sx[s][p];
                const float a = __expf(dt * A), xdt = x * dt;
                float y = 0.f;
#pragma unroll
                for (int j = 0; j < 16; ++j) { hs[j] = a * hs[j] + xdt * sB[s][ng * 16 + j]; y += sC[s][ng * 16 + j] * hs[j]; }
                y += __shfl_xor(y, 1); y += __shfl_xor(y, 2); y += __shfl_xor(y, 4);
                if (ng == 0) ybuf[(size_t)(t0 + c0 + s) * MIX_WIDTH + h * 64 + p] = y + D * x;
            }
        }
        float* so = is_p ? out + OUT_PS + (((size_t)seq * SSD_HEADS + h) * 64 + p) * 128 + ng * 16
                         : out + OUT_SS + (((size_t)(seq - BATCH) * SSD_HEADS + h) * 64 + p) * 128 + ng * 16;
#pragma unroll
        for (int j = 0; j < 16; ++j) so[j] = hs[j];
    }
}

__device__ __forceinline__ void ph_gate_norm(const bf16* __restrict__ projb, const float* __restrict__ norm_g, const float* __restrict__ ybuf, bf16* __restrict__ A1) {
    const int w = threadIdx.x >> 6, lane = threadIdx.x & 63, g = w & 3;
    for (int t = T_PROMPT + 2 * blockIdx.x + (w >> 2); t < T_ALL; t += 2 * gridDim.x) {
        float v[6]; float ss = 0.f;
#pragma unroll
        for (int j = 0; j < 6; ++j) {
            int c = g * 384 + j * 64 + lane;
            float y = ybuf[(size_t)t * MIX_WIDTH + c], z = bf2f(projb[(size_t)t * NB_LD + c]);
            v[j] = y * silu_f(z); ss += v[j] * v[j];
        }
        ss = wave_sum(ss);
        const float r = rsqrtf(ss * (1.0f / 384.0f) + LN_EPS);
#pragma unroll
        for (int j = 0; j < 6; ++j) { int c = g * 384 + j * 64 + lane; A1[(size_t)t * MIX_WIDTH + c] = (bf16)f2bf(v[j] * r * norm_g[c]); }
    }
}

__device__ __forceinline__ void ph_attn_naive(float* lds, const float* __restrict__ proj, const float* __restrict__ qrot, const float* __restrict__ krot,
                                              const float* __restrict__ ck, const float* __restrict__ cv, float* __restrict__ ybuf) {
    float (*sq)[64] = (float (*)[64])lds;
    const int w = threadIdx.x >> 6, lane = threadIdx.x & 63;
    for (int vb = blockIdx.x; vb < T_SAMPLE * 8 / NWAVE; vb += gridDim.x) {
        const int item = T_PROMPT * 8 + vb * NWAVE + w;
        const int t = item >> 3, h = item & 7;
        const bool is_p = t < T_PROMPT;
        int b, i;
        if (is_p) { b = t / SEQ; i = t % SEQ; } else { int ts = t - T_PROMPT; b = ts / DEC_SEQ; i = ts % DEC_SEQ; }
        __syncthreads();
        sq[w][lane] = qrot[(size_t)t * ATT_WIDTH + h * 64 + lane];
        __syncthreads();
        const int qi = is_p ? i : WBUF + i;
        float sc[3][3];
        float mx = -INFINITY;
#pragma unroll
        for (int pt = 0; pt < 3; ++pt) {
            const int d = pt == 0 ? 1 : (pt == 1 ? 4 : 16);
#pragma unroll
            for (int sl = 0; sl < 3; ++sl) {
                const int m = lane + sl * 64;
                float s = -INFINITY;
                const int kj = qi - d * m;
                if (m <= 128 && kj >= 0) {
                    const float* kr;
                    if (is_p) kr = krot + (size_t)(b * SEQ + kj) * ATT_WIDTH + h * 64;
                    else kr = (kj >= WBUF) ? krot + (size_t)(T_PROMPT + b * DEC_SEQ + (kj - WBUF)) * ATT_WIDTH + h * 64
                                           : ck + ((size_t)b * WBUF + kj) * ATT_WIDTH + h * 64;
                    float a = 0.f;
#pragma unroll
                    for (int c = 0; c < 64; c += 4) { float4 kv = *(const float4*)(kr + c); a += kv.x * sq[w][c] + kv.y * sq[w][c + 1] + kv.z * sq[w][c + 2] + kv.w * sq[w][c + 3]; }
                    s = a * 0.125f;
                }
                sc[pt][sl] = s; mx = fmaxf(mx, s);
            }
        }
        mx = wave_max(mx);
        float lsum = 0.f;
#pragma unroll
        for (int pt = 0; pt < 3; ++pt)
#pragma unroll
            for (int sl = 0; sl < 3; ++sl) { float pv = (sc[pt][sl] == -INFINITY) ? 0.f : __expf(sc[pt][sl] - mx); sc[pt][sl] = pv; lsum += pv; }
        lsum = wave_sum(lsum);
        float o = 0.f;
#pragma unroll
        for (int pt = 0; pt < 3; ++pt) {
            const int d = pt == 0 ? 1 : (pt == 1 ? 4 : 16);
#pragma unroll
            for (int sl = 0; sl < 3; ++sl) {
                const int mend = sl < 2 ? 64 : 1;
                for (int ml = 0; ml < mend; ++ml) {
                    const int m = ml + sl * 64;
                    const int kj = qi - d * m;
                    const float pv = __shfl(sc[pt][sl], ml);
                    if (kj < 0) continue;
                    const float* vr;
                    if (is_p) vr = proj + (size_t)(b * SEQ + kj) * PROJ_LD + O_V + h * 64;
                    else vr = (kj >= WBUF) ? proj + (size_t)(T_PROMPT + b * DEC_SEQ + (kj - WBUF)) * PROJ_LD + O_V + h * 64
                                           : cv + ((size_t)b * WBUF + kj) * ATT_WIDTH + h * 64;
                    o += pv * vr[lane];
                }
            }
        }
        ybuf[(size_t)t * MIX_WIDTH + SSD_WIDTH + h * 64 + lane] = o / lsum;
    }
}

__device__ __forceinline__ void ph_ln_res(const float* __restrict__ xp, const float* __restrict__ xs, const float* __restrict__ add, const float* __restrict__ gam,
                                          const float* __restrict__ bet, float* __restrict__ dst, bf16* __restrict__ dstb) {
    const int lane = threadIdx.x & 63;
    for (int t = blockIdx.x * NWAVE + (threadIdx.x >> 6); t < T_ALL; t += gridDim.x * NWAVE) {
        const float* res = (t < T_PROMPT) ? xp + (size_t)t * D_MODEL : xs + (size_t)(t - T_PROMPT) * D_MODEL;
        float v[16]; float s = 0.f;
#pragma unroll
        for (int j = 0; j < 4; ++j) { const int c = j * 256 + lane * 4; const float4 r4 = *(const float4*)(res + c), a4 = *(const float4*)(add + (size_t)t * D_MODEL + c);
            v[4 * j] = ALPHA_F * r4.x + a4.x; v[4 * j + 1] = ALPHA_F * r4.y + a4.y; v[4 * j + 2] = ALPHA_F * r4.z + a4.z; v[4 * j + 3] = ALPHA_F * r4.w + a4.w;
            s += (v[4 * j] + v[4 * j + 1]) + (v[4 * j + 2] + v[4 * j + 3]); }
        s = wave_sum(s);
        const float mu = s * (1.0f / 1024.0f);
        float q = 0.f;
#pragma unroll
        for (int j = 0; j < 16; ++j) { v[j] -= mu; q += v[j] * v[j]; }
        q = wave_sum(q);
        const float r = rsqrtf(q * (1.0f / 1024.0f) + LN_EPS);
#pragma unroll
        for (int j = 0; j < 4; ++j) { const int c = j * 256 + lane * 4; const float4 g4 = *(const float4*)(gam + c), b4 = *(const float4*)(bet + c);
            const float o0 = v[4 * j] * r * g4.x + b4.x, o1 = v[4 * j + 1] * r * g4.y + b4.y, o2 = v[4 * j + 2] * r * g4.z + b4.z, o3 = v[4 * j + 3] * r * g4.w + b4.w;
            *(float4*)(dst + (size_t)t * D_MODEL + c) = make_float4(o0, o1, o2, o3);
            *(uint2*)(dstb + (size_t)t * D_MODEL + c) = make_uint2(pk2(o0, o1), pk2(o2, o3)); }
    }
}

__device__ __forceinline__ void ph_peer_route(float* lds, const float* __restrict__ qh, const float* __restrict__ keys1, const float* __restrict__ keys2,
                                              int* __restrict__ eidx, float* __restrict__ gate) {
    float (*sq)[256] = (float (*)[256])lds;
    float (*sv)[2][16] = (float (*)[2][16])(lds + NWAVE * 256);
    int (*si)[2][16] = (int (*)[2][16])(lds + NWAVE * 256 + NWAVE * 32);
    const int w = threadIdx.x >> 6, lane = threadIdx.x & 63;
    for (int vb = blockIdx.x; vb < T_ALL * 8 / NWAVE; vb += gridDim.x) {
        const int item = vb * NWAVE + w;
        const int t = item >> 3, h = item & 7;
        __syncthreads();
        for (int c = lane; c < 256; c += 64) sq[w][c] = qh[(size_t)t * 2048 + h * 256 + c];
        __syncthreads();
#pragma unroll
        for (int half = 0; half < 2; ++half) {
            const float* keys = half ? keys2 : keys1;
            float s[2];
#pragma unroll
            for (int sl = 0; sl < 2; ++sl) {
                const float* kr = keys + (size_t)(lane + sl * 64) * 128;
                float a = 0.f;
#pragma unroll 8
                for (int c = 0; c < 128; c += 4) { float4 kv = *(const float4*)(kr + c); const float* qq = &sq[w][half * 128 + c]; a += kv.x * qq[0] + kv.y * qq[1] + kv.z * qq[2] + kv.w * qq[3]; }
                s[sl] = a;
            }
            for (int r = 0; r < 16; ++r) {
                float bv; int bi;
                if (s[0] >= s[1]) { bv = s[0]; bi = lane; } else { bv = s[1]; bi = lane + 64; }
#pragma unroll
                for (int o = 32; o > 0; o >>= 1) {
                    float ov = __shfl_xor(bv, o); int oi = __shfl_xor(bi, o);
                    if (ov > bv || (ov == bv && oi < bi)) { bv = ov; bi = oi; }
                }
                if (lane == 0) { sv[w][half][r] = bv; si[w][half][r] = bi; }
                if (bi == lane) s[0] = -INFINITY;
                if (bi == lane + 64) s[1] = -INFINITY;
            }
        }
        __syncthreads();
        float c[4];
#pragma unroll
        for (int j = 0; j < 4; ++j) { int ci = lane * 4 + j; c[j] = sv[w][0][ci >> 4] + sv[w][1][ci & 15]; }
        float myv = 0.f; int myc = 0;
        for (int r = 0; r < 16; ++r) {
            float bv = c[0]; int bi = lane * 4;
#pragma unroll
            for (int j = 1; j < 4; ++j) if (c[j] > bv) { bv = c[j]; bi = lane * 4 + j; }
#pragma unroll
            for (int o = 32; o > 0; o >>= 1) {
                float ov = __shfl_xor(bv, o); int oi = __shfl_xor(bi, o);
                if (ov > bv || (ov == bv && oi < bi)) { bv = ov; bi = oi; }
            }
            if (lane == r) { myv = bv; myc = bi; }
#pragma unroll
            for (int j = 0; j < 4; ++j) if (bi == lane * 4 + j) c[j] = -INFINITY;
        }
        float v = lane < 16 ? myv : -INFINITY;
        float mx = wave_max(v);
        float e = lane < 16 ? __expf(v - mx) : 0.f;
        float sum = wave_sum(e);
        if (lane < 16) {
            int ex = si[w][0][myc >> 4] * PEER_NKEYS + si[w][1][myc & 15];
            eidx[(size_t)t * 128 + h * 16 + lane] = ex;
            gate[(size_t)t * 128 + h * 16 + lane] = e / sum;
        }
    }
}

__device__ __forceinline__ void ph_peer_ffn(const float* __restrict__ hbuf, const int* __restrict__ eidx, const float* __restrict__ gate,
                                            const bf16* __restrict__ ub, const bf16* __restrict__ vb, const float* __restrict__ gam,
                                            const float* __restrict__ bet, float* __restrict__ out) {
    const int lane = threadIdx.x & 63;
    for (int t = blockIdx.x * NWAVE + (threadIdx.x >> 6); t < T_ALL; t += gridDim.x * NWAVE) {
        float x[16], acc[16];
        { const float* xr = hbuf + (size_t)t * D_MODEL + lane * 8;
          const float4 a = *(const float4*)xr, b = *(const float4*)(xr + 4), c = *(const float4*)(xr + 512), d = *(const float4*)(xr + 516);
          x[0] = a.x; x[1] = a.y; x[2] = a.z; x[3] = a.w; x[4] = b.x; x[5] = b.y; x[6] = b.z; x[7] = b.w;
          x[8] = c.x; x[9] = c.y; x[10] = c.z; x[11] = c.w; x[12] = d.x; x[13] = d.y; x[14] = d.z; x[15] = d.w; }
#pragma unroll
        for (int j = 0; j < 16; ++j) acc[j] = 0.f;
        for (int k = 0; k < 128; ++k) {
            const int e = eidx[(size_t)t * 128 + k];
            const float g = gate[(size_t)t * 128 + k];
            const bf16* ur = ub + (size_t)e * D_MODEL + lane * 8;
            float u0[8], u1[8];
            unpack8(*(const v4u*)ur, u0); unpack8(*(const v4u*)(ur + 512), u1);
            float d = 0.f;
#pragma unroll
            for (int j = 0; j < 8; ++j) d += u0[j] * x[j] + u1[j] * x[8 + j];
            d = wave_sum(d);
            const float wgt = g * gelu_f(d);
            const bf16* vr = vb + (size_t)e * D_MODEL + lane * 8;
            unpack8(*(const v4u*)vr, u0); unpack8(*(const v4u*)(vr + 512), u1);
#pragma unroll
            for (int j = 0; j < 8; ++j) { acc[j] += wgt * u0[j]; acc[8 + j] += wgt * u1[j]; }
        }
        float s = 0.f;
#pragma unroll
        for (int j = 0; j < 16; ++j) { acc[j] += ALPHA_F * x[j]; s += acc[j]; }
        s = wave_sum(s);
        const float mu = s * (1.0f / 1024.0f);
        float q = 0.f;
#pragma unroll
        for (int j = 0; j < 16; ++j) { acc[j] -= mu; q += acc[j] * acc[j]; }
        q = wave_sum(q);
        const float r = rsqrtf(q * (1.0f / 1024.0f) + LN_EPS);
        float* dst = ((t < T_PROMPT) ? out + OUT_YP + (size_t)t * D_MODEL : out + OUT_YS + (size_t)(t - T_PROMPT) * D_MODEL) + lane * 8;
#pragma unroll
        for (int q4 = 0; q4 < 4; ++q4) {
            const int eo = (q4 >> 1) * 512 + (q4 & 1) * 4;
            const float4 g4 = *(const float4*)(gam + lane * 8 + eo), b4 = *(const float4*)(bet + lane * 8 + eo);
            float4 o; o.x = acc[q4 * 4 + 0] * r * g4.x + b4.x; o.y = acc[q4 * 4 + 1] * r * g4.y + b4.y; o.z = acc[q4 * 4 + 2] * r * g4.z + b4.z; o.w = acc[q4 * 4 + 3] * r * g4.w + b4.w;
            *(float4*)(dst + eo) = o;
        }
    }
}

__device__ __forceinline__ float peer_dot16(const v4u a, const v4u b, const float (&x)[16]) {
    float u0[8], u1[8]; unpack8(a, u0); unpack8(b, u1);
    float d = 0.f;
#pragma unroll
    for (int j = 0; j < 8; ++j) d += u0[j] * x[j] + u1[j] * x[8 + j];
    return d;
}
#define PEER_TR_STEP(N, M) _Pragma("unroll") for (int i = 0; i < N; ++i) { const bool up = (lane & M) != 0; const float keep = up ? part[i + N] : part[i]; const float send = up ? part[i] : part[i + N]; part[i] = keep + __shfl_xor(send, M); }
__device__ __forceinline__ void ph_peer_ffn2(const float* __restrict__ hbuf, const int* __restrict__ eidx, const float* __restrict__ gate,
                                             const bf16* __restrict__ ub, const bf16* __restrict__ vb, const float* __restrict__ gam,
                                             const float* __restrict__ bet, float* __restrict__ out) {
    const int lane0 = threadIdx.x & 63;
    for (int t = blockIdx.x * NWAVE + (threadIdx.x >> 6); t < T_ALL; t += gridDim.x * NWAVE) {
        int lane = lane0; asm volatile("" : "+v"(lane));
        float x[16];
        { const float* xr = hbuf + (size_t)t * D_MODEL + lane * 8;
          const float4 a = *(const float4*)xr, b = *(const float4*)(xr + 4), c = *(const float4*)(xr + 512), d = *(const float4*)(xr + 516);
          x[0] = a.x; x[1] = a.y; x[2] = a.z; x[3] = a.w; x[4] = b.x; x[5] = b.y; x[6] = b.z; x[7] = b.w;
          x[8] = c.x; x[9] = c.y; x[10] = c.z; x[11] = c.w; x[12] = d.x; x[13] = d.y; x[14] = d.z; x[15] = d.w; }
        int ev[2]; float wv[4];
        ev[0] = eidx[(size_t)t * 128 + lane]; ev[1] = eidx[(size_t)t * 128 + 64 + lane];
#pragma unroll
        for (int rd = 0; rd < 4; ++rd) wv[rd] = gate[(size_t)t * 128 + rd * 32 + (lane >> 1)];
#pragma unroll
        for (int rd = 0; rd < 4; ++rd) {
            float part[32];
#pragma unroll
            for (int kb = 0; kb < 8; ++kb) {
                v4u ra[4], rb[4];
#pragma unroll
                for (int k8 = 0; k8 < 4; ++k8) {
                    const int e = __builtin_amdgcn_readlane(ev[rd >> 1], (rd & 1) * 32 + kb * 4 + k8);
                    const bf16* ur = ub + (size_t)e * D_MODEL + lane * 8;
                    ra[k8] = *(const v4u*)ur; rb[k8] = *(const v4u*)(ur + 512);
                }
#pragma unroll
                for (int k8 = 0; k8 < 4; ++k8) part[kb * 4 + k8] = peer_dot16(ra[k8], rb[k8], x);
            }
            PEER_TR_STEP(16, 32) PEER_TR_STEP(8, 16) PEER_TR_STEP(4, 8) PEER_TR_STEP(2, 4) PEER_TR_STEP(1, 2)
            const float hid = part[0] + __shfl_xor(part[0], 1);
            wv[rd] *= gelu_f(hid);
        }
        float acc[16];
#pragma unroll
        for (int j = 0; j < 16; ++j) acc[j] = 0.f;
#pragma unroll
        for (int rd = 0; rd < 4; ++rd) {
#pragma unroll
            for (int kb = 0; kb < 4; ++kb) {
                v4u ra[8], rb[8];
#pragma unroll
                for (int k8 = 0; k8 < 8; ++k8) {
                    const int e = __builtin_amdgcn_readlane(ev[rd >> 1], (rd & 1) * 32 + kb * 8 + k8);
                    const bf16* vr = vb + (size_t)e * D_MODEL + lane * 8;
                    ra[k8] = *(const v4u*)vr; rb[k8] = *(const v4u*)(vr + 512);
                }
#pragma unroll
                for (int k8 = 0; k8 < 8; ++k8) {
                    const float wk = __builtin_bit_cast(float, __builtin_amdgcn_readlane(__builtin_bit_cast(int, wv[rd]), 2 * (kb * 8 + k8)));
                    float u0[8], u1[8]; unpack8(ra[k8], u0); unpack8(rb[k8], u1);
#pragma unroll
                    for (int j = 0; j < 8; ++j) { acc[j] += wk * u0[j]; acc[8 + j] += wk * u1[j]; }
                }
            }
        }
        float s = 0.f;
#pragma unroll
        for (int j = 0; j < 16; ++j) { acc[j] += ALPHA_F * x[j]; s += acc[j]; }
        s = wave_sum(s);
        const float mu = s * (1.0f / 1024.0f);
        float q = 0.f;
#pragma unroll
        for (int j = 0; j < 16; ++j) { acc[j] -= mu; q += acc[j] * acc[j]; }
        q = wave_sum(q);
        const float r = rsqrtf(q * (1.0f / 1024.0f) + LN_EPS);
        float* dst = ((t < T_PROMPT) ? out + OUT_YP + (size_t)t * D_MODEL : out + OUT_YS + (size_t)(t - T_PROMPT) * D_MODEL) + lane * 8;
#pragma unroll
        for (int q4 = 0; q4 < 4; ++q4) {
            const int eo = (q4 >> 1) * 512 + (q4 & 1) * 4;
            const float4 g4 = *(const float4*)(gam + lane * 8 + eo), b4 = *(const float4*)(bet + lane * 8 + eo);
            float4 o; o.x = acc[q4 * 4 + 0] * r * g4.x + b4.x; o.y = acc[q4 * 4 + 1] * r * g4.y + b4.y; o.z = acc[q4 * 4 + 2] * r * g4.z + b4.z; o.w = acc[q4 * 4 + 3] * r * g4.w + b4.w;
            *(float4*)(dst + eo) = o;
        }
    }
}

__device__ __forceinline__ void ph_attn_sample(float* lds, const bf16* __restrict__ qrot_b, const bf16* __restrict__ krot_b, const bf16* __restrict__ projb,
                                               const float* __restrict__ ck, const float* __restrict__ cv, bf16* __restrict__ A1) {
    float (*sq)[64] = (float (*)[64])lds;
    const int w = threadIdx.x >> 6, lane0 = threadIdx.x & 63;
    for (int vb = blockIdx.x; vb < T_SAMPLE * 8 / NWAVE; vb += gridDim.x) {
        int lane = lane0; asm volatile("" : "+v"(lane));
        const int item = vb * NWAVE + w, ts = item >> 3, hd = item & 7, b = ts >> 2, i = ts & 3, t = T_PROMPT + ts;
        __syncthreads();
        sq[w][lane] = bf2f(qrot_b[(size_t)t * ATT_WIDTH + hd * 64 + lane]);
        __syncthreads();
        const int qi = WBUF + i;
        float sc[8];
        float mx = -INFINITY;
#pragma unroll
        for (int slot = 0; slot < 7; ++slot) {
            const int pt = slot < 6 ? (slot >> 1) : (lane < 3 ? lane : 0);
            const int m = slot < 6 ? lane + 64 * (slot & 1) : 128;
            const int kj = qi - (m << (2 * pt));
            const bool valid = (slot < 6 || lane < 3) && kj < WBUF;
            const int kc = kj < WBUF ? kj : WBUF - 1;
            const float* kr = ck + ((size_t)b * WBUF + kc) * ATT_WIDTH + hd * 64;
            float a = 0.f;
#pragma unroll
            for (int c = 0; c < 64; c += 4) { const float4 kv = *(const float4*)(kr + c); a += kv.x * sq[w][c] + kv.y * sq[w][c + 1] + kv.z * sq[w][c + 2] + kv.w * sq[w][c + 3]; }
            const float s = valid ? a * 0.125f : -INFINITY;
            sc[slot] = s; mx = fmaxf(mx, s);
        }
        const int nt7 = lane <= i ? i - lane : i;
        const bool valid7 = lane < i + 3;
        {
            const bf16* kr = krot_b + (size_t)(T_PROMPT + b * DEC_SEQ + nt7) * ATT_WIDTH + hd * 64;
            float a = 0.f;
#pragma unroll
            for (int c = 0; c < 64; c += 8) { float f[8]; unpack8(*(const v4u*)(kr + c), f);
#pragma unroll
                for (int j = 0; j < 8; ++j) a += f[j] * sq[w][c + j]; }
            const float s = valid7 ? a * 0.125f : -INFINITY;
            sc[7] = s; mx = fmaxf(mx, s);
        }
        mx = wave_max(mx);
        float lsum = 0.f;
#pragma unroll
        for (int slot = 0; slot < 8; ++slot) { const float pv = __expf(sc[slot] - mx); sc[slot] = pv; lsum += pv; }
        lsum = wave_sum(lsum);
        float part[64];
#pragma unroll
        for (int c = 0; c < 64; ++c) part[c] = 0.f;
#pragma unroll
        for (int slot = 0; slot < 7; ++slot) {
            const int pt = slot < 6 ? (slot >> 1) : (lane < 3 ? lane : 0);
            const int m = slot < 6 ? lane + 64 * (slot & 1) : 128;
            const int kj = qi - (m << (2 * pt));
            const int kc = kj < WBUF ? kj : WBUF - 1;
            const float pv = sc[slot];
            const float* vr = cv + ((size_t)b * WBUF + kc) * ATT_WIDTH + hd * 64;
#pragma unroll
            for (int c = 0; c < 64; c += 4) { const float4 vv = *(const float4*)(vr + c); part[c] += pv * vv.x; part[c + 1] += pv * vv.y; part[c + 2] += pv * vv.z; part[c + 3] += pv * vv.w; }
        }
        {
            const float pv = sc[7];
            const bf16* vr = projb + (size_t)(T_PROMPT + b * DEC_SEQ + nt7) * NB_LD + NB_V + hd * 64;
#pragma unroll
            for (int c = 0; c < 64; c += 8) { float f[8]; unpack8(*(const v4u*)(vr + c), f);
#pragma unroll
                for (int j = 0; j < 8; ++j) part[c + j] += pv * f[j]; }
        }
        PEER_TR_STEP(32, 32) PEER_TR_STEP(16, 16) PEER_TR_STEP(8, 8) PEER_TR_STEP(4, 4) PEER_TR_STEP(2, 2) PEER_TR_STEP(1, 1)
        A1[(size_t)t * MIX_WIDTH + SSD_WIDTH + hd * 64 + lane] = (bf16)f2bf(part[0] / lsum);
    }
}


__device__ __forceinline__ void cache_copy_slice(const float* __restrict__ ck, const float* __restrict__ cv, float* __restrict__ out, unsigned slice, unsigned lane) {
    constexpr unsigned PER_B = (WBUF - DEC_SEQ) * ATT_WIDTH / 4;
    constexpr unsigned TOTAL = 2u * DEC_BATCH * PER_B;
#pragma unroll 1
    for (unsigned bt = 0; bt < 8; ++bt) {
        f32x4n v[8]; size_t dsti[8]; bool isv[8]; bool ok[8];
#pragma unroll
        for (int j = 0; j < 8; ++j) {
            const unsigned idx = slice * 4096u + bt * 512u + j * 64u + lane;
            ok[j] = idx < TOTAL;
            const unsigned idc = ok[j] ? idx : 0u;
            const unsigned tb = idc / PER_B, r = idc - tb * PER_B, bb = tb & (DEC_BATCH - 1);
            isv[j] = tb >= DEC_BATCH;
            const size_t srci = (size_t)bb * (WBUF * ATT_WIDTH / 4) + (DEC_SEQ * ATT_WIDTH / 4) + r;
            dsti[j] = (size_t)bb * (WBUF * ATT_WIDTH / 4) + r;
            v[j] = __builtin_nontemporal_load((isv[j] ? (const f32x4n*)cv : (const f32x4n*)ck) + srci);
        }
#pragma unroll
        for (int j = 0; j < 8; ++j) if (ok[j]) __builtin_nontemporal_store(v[j], (f32x4n*)(out + (isv[j] ? OUT_SV : OUT_SK)) + dsti[j]);
    }
}
typedef float f32x2v __attribute__((ext_vector_type(2)));
__device__ __forceinline__ void ph_quant_tables(const float* __restrict__ pu, const float* __restrict__ pv, unsigned char* __restrict__ ub8, unsigned char* __restrict__ vb8,
                                                float* __restrict__ usc, float* __restrict__ vsc, int rank, int nranks) {
    const int lane = threadIdx.x & 63;
#pragma unroll 2
    for (int row = rank * NWAVE + (threadIdx.x >> 6); row < 2 * 16384; row += nranks * NWAVE) {
        const int rr = row & 16383; const bool isv = row >= 16384;
        const float* src = (isv ? pv : pu) + (size_t)rr * D_MODEL + lane * 8;
        const float4 a = *(const float4*)src, b = *(const float4*)(src + 4), c = *(const float4*)(src + 512), d = *(const float4*)(src + 516);
        float am = fmaxf(fmaxf(fmaxf(fabsf(a.x), fabsf(a.y)), fmaxf(fabsf(a.z), fabsf(a.w))), fmaxf(fmaxf(fabsf(b.x), fabsf(b.y)), fmaxf(fabsf(b.z), fabsf(b.w))));
        am = fmaxf(am, fmaxf(fmaxf(fmaxf(fabsf(c.x), fabsf(c.y)), fmaxf(fabsf(c.z), fabsf(c.w))), fmaxf(fmaxf(fabsf(d.x), fabsf(d.y)), fmaxf(fabsf(d.z), fabsf(d.w)))));
        am = wave_max(am);
        const float sc = am > 0.f ? 224.0f / am : 1.0f;
        v4u o;
        o.x = (unsigned)__builtin_amdgcn_cvt_pk_fp8_f32(a.z * sc, a.w * sc, __builtin_amdgcn_cvt_pk_fp8_f32(a.x * sc, a.y * sc, 0, false), true);
        o.y = (unsigned)__builtin_amdgcn_cvt_pk_fp8_f32(b.z * sc, b.w * sc, __builtin_amdgcn_cvt_pk_fp8_f32(b.x * sc, b.y * sc, 0, false), true);
        o.z = (unsigned)__builtin_amdgcn_cvt_pk_fp8_f32(c.z * sc, c.w * sc, __builtin_amdgcn_cvt_pk_fp8_f32(c.x * sc, c.y * sc, 0, false), true);
        o.w = (unsigned)__builtin_amdgcn_cvt_pk_fp8_f32(d.z * sc, d.w * sc, __builtin_amdgcn_cvt_pk_fp8_f32(d.x * sc, d.y * sc, 0, false), true);
        *(v4u*)((isv ? vb8 : ub8) + (size_t)rr * 1024 + lane * 16) = o;
        if (lane == 0) (isv ? vsc : usc)[rr] = am > 0.f ? am * (1.0f / 224.0f) : 1.0f;
    }
}
__device__ __forceinline__ void unpack16_fp8(const v4u w, float (&f)[16]) {
#pragma unroll
    for (int i = 0; i < 4; ++i) {
        const f32x2v lo = __builtin_amdgcn_cvt_pk_f32_fp8((int)w[i], false), hi = __builtin_amdgcn_cvt_pk_f32_fp8((int)w[i], true);
        f[4 * i] = lo[0]; f[4 * i + 1] = lo[1]; f[4 * i + 2] = hi[0]; f[4 * i + 3] = hi[1];
    }
}
__device__ __forceinline__ void ph_peer_ffn3(const float* __restrict__ hbuf, const int* __restrict__ eidx, const float* __restrict__ gate,
                                             const unsigned char* __restrict__ ub8, const unsigned char* __restrict__ vb8, const float* __restrict__ usc, const float* __restrict__ vsc,
                                             const float* __restrict__ gam, const float* __restrict__ bet, float* __restrict__ out,
                                             const float* __restrict__ ck, const float* __restrict__ cv, unsigned n9) {
    const int lane0 = threadIdx.x & 63;
    unsigned it = 0;
    for (int t = blockIdx.x * NWAVE + (threadIdx.x >> 6); t < T_ALL; t += gridDim.x * NWAVE, ++it) {
        int lane = lane0; asm volatile("" : "+v"(lane));
        { const unsigned sl = (blockIdx.x * NWAVE + (threadIdx.x >> 6)) + it * (gridDim.x * NWAVE); if (it < 8 && sl < n9) cache_copy_slice(ck, cv, out, sl, (unsigned)lane); }
        const unsigned lo16 = (unsigned)lane * 16u, lo8 = (unsigned)lane * 8u;
        float x[16];
        { const float* xr = hbuf + (size_t)t * D_MODEL + lo8;
          const float4 a = *(const float4*)xr, b = *(const float4*)(xr + 4), c = *(const float4*)(xr + 512), d = *(const float4*)(xr + 516);
          x[0] = a.x; x[1] = a.y; x[2] = a.z; x[3] = a.w; x[4] = b.x; x[5] = b.y; x[6] = b.z; x[7] = b.w;
          x[8] = c.x; x[9] = c.y; x[10] = c.z; x[11] = c.w; x[12] = d.x; x[13] = d.y; x[14] = d.z; x[15] = d.w; }
        int ev[2]; float wv[4], su[4];
        ev[0] = eidx[(size_t)t * 128 + lane]; ev[1] = eidx[(size_t)t * 128 + 64 + lane];
#pragma unroll
        for (int rd = 0; rd < 4; ++rd) {
            const int er = eidx[(size_t)t * 128 + rd * 32 + (lane >> 1)];
            wv[rd] = gate[(size_t)t * 128 + rd * 32 + (lane >> 1)] * vsc[er];
            su[rd] = usc[er];
        }
#pragma unroll
        for (int rd = 0; rd < 4; ++rd) {
            float part[32];
#pragma unroll
            for (int kb = 0; kb < 8; ++kb) {
                v4u ra[4];
#pragma unroll
                for (int k8 = 0; k8 < 4; ++k8) {
                    const int e = __builtin_amdgcn_readlane(ev[rd >> 1], (rd & 1) * 32 + kb * 4 + k8);
                    ra[k8] = *(const v4u*)(ub8 + (size_t)e * 1024 + lo16);
                }
#pragma unroll
                for (int k8 = 0; k8 < 4; ++k8) {
                    float f[16]; unpack16_fp8(ra[k8], f);
                    float d = 0.f;
#pragma unroll
                    for (int j = 0; j < 16; ++j) d += f[j] * x[j];
                    part[kb * 4 + k8] = d;
                    if (k8 & 1) __builtin_amdgcn_sched_barrier(0);
                }
            }
            PEER_TR_STEP(16, 32) PEER_TR_STEP(8, 16) PEER_TR_STEP(4, 8) PEER_TR_STEP(2, 4) PEER_TR_STEP(1, 2)
            const float hid = (part[0] + __shfl_xor(part[0], 1)) * su[rd];
            wv[rd] *= gelu_f(hid);
        }
        float acc[16];
#pragma unroll
        for (int j = 0; j < 16; ++j) acc[j] = 0.f;
#pragma unroll
        for (int rd = 0; rd < 4; ++rd) {
#pragma unroll
            for (int kb = 0; kb < 4; ++kb) {
                v4u ra[8];
#pragma unroll
                for (int k8 = 0; k8 < 8; ++k8) {
                    const int e = __builtin_amdgcn_readlane(ev[rd >> 1], (rd & 1) * 32 + kb * 8 + k8);
                    ra[k8] = *(const v4u*)(vb8 + (size_t)e * 1024 + lo16);
                }
#pragma unroll
                for (int k8 = 0; k8 < 8; ++k8) {
                    const float wk = __builtin_bit_cast(float, __builtin_amdgcn_readlane(__builtin_bit_cast(int, wv[rd]), 2 * (kb * 8 + k8)));
                    float f[16]; unpack16_fp8(ra[k8], f);
#pragma unroll
                    for (int j = 0; j < 16; ++j) acc[j] += wk * f[j];
                    if (k8 & 1) __builtin_amdgcn_sched_barrier(0);
                }
            }
        }
        float s = 0.f;
#pragma unroll
        for (int j = 0; j < 16; ++j) { acc[j] += ALPHA_F * x[j]; s += acc[j]; }
        s = wave_sum(s);
        const float mu = s * (1.0f / 1024.0f);
        float q = 0.f;
#pragma unroll
        for (int j = 0; j < 16; ++j) { acc[j] -= mu; q += acc[j] * acc[j]; }
        q = wave_sum(q);
        const float r = rsqrtf(q * (1.0f / 1024.0f) + LN_EPS);
        float* dst = ((t < T_PROMPT) ? out + OUT_YP + (size_t)t * D_MODEL : out + OUT_YS + (size_t)(t - T_PROMPT) * D_MODEL) + lo8;
#pragma unroll
        for (int q4 = 0; q4 < 4; ++q4) {
            const int eo = (q4 >> 1) * 512 + (q4 & 1) * 4;
            const float4 g4 = *(const float4*)(gam + lo8 + eo), b4 = *(const float4*)(bet + lo8 + eo);
            float4 o; o.x = acc[q4 * 4 + 0] * r * g4.x + b4.x; o.y = acc[q4 * 4 + 1] * r * g4.y + b4.y; o.z = acc[q4 * 4 + 2] * r * g4.z + b4.z; o.w = acc[q4 * 4 + 3] * r * g4.w + b4.w;
            *(float4*)(dst + eo) = o;
        }
    }
}


__device__ __forceinline__ void ssd_decode_load(const bf16* __restrict__ xbc_b, const float* __restrict__ dtv, const float* __restrict__ state_ssm, int item, int p, int ng,
                                                float (&hs)[16], v4u (&bq)[4][2], v4u (&cq)[4][2], float (&xv)[4], float (&dv)[4]) {
    const int sb = item / SSD_HEADS, h = item - sb * SSD_HEADS, g = h / 6, t0 = T_PROMPT + sb * DEC_SEQ;
    const float* s0 = state_ssm + (((size_t)sb * SSD_HEADS + h) * 64 + p) * 128 + ng * 16;
#pragma unroll
    for (int j = 0; j < 4; ++j) { const float4 v = *(const float4*)(s0 + 4 * j); hs[4 * j] = v.x; hs[4 * j + 1] = v.y; hs[4 * j + 2] = v.z; hs[4 * j + 3] = v.w; }
#pragma unroll
    for (int s = 0; s < 4; ++s) {
        const bf16* row = xbc_b + (size_t)(t0 + s) * CONV_DIM;
        bq[s][0] = *(const v4u*)(row + 1536 + g * 128 + ng * 16); bq[s][1] = *(const v4u*)(row + 1536 + g * 128 + ng * 16 + 8);
        cq[s][0] = *(const v4u*)(row + 2048 + g * 128 + ng * 16); cq[s][1] = *(const v4u*)(row + 2048 + g * 128 + ng * 16 + 8);
        xv[s] = bf2f(row[h * 64 + p]); dv[s] = dtv[(size_t)(t0 + s) * SSD_HEADS + h];
    }
}
__device__ __forceinline__ void ssd_decode_compute(const float* __restrict__ a_log, const float* __restrict__ d_skip, int item, int p, int ng,
                                                   float (&hs)[16], const v4u (&bq)[4][2], const v4u (&cq)[4][2], const float (&xv)[4], const float (&dv)[4],
                                                   float* __restrict__ ybuf, float* __restrict__ out) {
    const int sb = item / SSD_HEADS, h = item - sb * SSD_HEADS, t0 = T_PROMPT + sb * DEC_SEQ;
    const float A = -__expf(a_log[h]), D = d_skip[h];
#pragma unroll
    for (int s = 0; s < 4; ++s) {
        float Bf[16], Cf[16];
        { float t8[8]; unpack8(bq[s][0], t8);
#pragma unroll
          for (int j = 0; j < 8; ++j) Bf[j] = t8[j];
          unpack8(bq[s][1], t8);
#pragma unroll
          for (int j = 0; j < 8; ++j) Bf[8 + j] = t8[j];
          unpack8(cq[s][0], t8);
#pragma unroll
          for (int j = 0; j < 8; ++j) Cf[j] = t8[j];
          unpack8(cq[s][1], t8);
#pragma unroll
          for (int j = 0; j < 8; ++j) Cf[8 + j] = t8[j]; }
        const float a = __expf(dv[s] * A), xdt = xv[s] * dv[s];
        float y = 0.f;
#pragma unroll
        for (int j = 0; j < 16; ++j) { hs[j] = a * hs[j] + xdt * Bf[j]; y += Cf[j] * hs[j]; }
        y += __shfl_xor(y, 1); y += __shfl_xor(y, 2); y += __shfl_xor(y, 4);
        if (ng == 0) ybuf[(size_t)(t0 + s) * MIX_WIDTH + h * 64 + p] = y + D * xv[s];
    }
    float* so = out + OUT_SS + (((size_t)sb * SSD_HEADS + h) * 64 + p) * 128 + ng * 16;
#pragma unroll
    for (int j = 0; j < 4; ++j) *(float4*)(so + 4 * j) = make_float4(hs[4 * j], hs[4 * j + 1], hs[4 * j + 2], hs[4 * j + 3]);
}
__device__ __forceinline__ void ph_ssd_decode(const bf16* __restrict__ xbc_b, const float* __restrict__ dtv, const float* __restrict__ a_log, const float* __restrict__ d_skip,
                                              const float* __restrict__ state_ssm, float* __restrict__ ybuf, float* __restrict__ out) {
    const int tid = threadIdx.x, p = tid >> 3, ng = tid & 7;
    constexpr int NITEM = DEC_BATCH * SSD_HEADS;
    for (int it = blockIdx.x; it < NITEM; it += 2 * gridDim.x) {
        const int it2 = it + gridDim.x; const bool has2 = it2 < NITEM; const int it2c = has2 ? it2 : it;
        float hsA[16], hsB[16], xA[4], xB[4], dA[4], dB[4]; v4u bA[4][2], cA[4][2], bB[4][2], cB[4][2];
        ssd_decode_load(xbc_b, dtv, state_ssm, it, p, ng, hsA, bA, cA, xA, dA);
        ssd_decode_load(xbc_b, dtv, state_ssm, it2c, p, ng, hsB, bB, cB, xB, dB);
        ssd_decode_compute(a_log, d_skip, it, p, ng, hsA, bA, cA, xA, dA, ybuf, out);
        if (has2) ssd_decode_compute(a_log, d_skip, it2, p, ng, hsB, bB, cB, xB, dB, ybuf, out);
    }
}

typedef float f32x16 __attribute__((ext_vector_type(16)));
typedef short s16x8 __attribute__((ext_vector_type(8)));
typedef short s16x4 __attribute__((ext_vector_type(4)));
typedef float f32x4v __attribute__((ext_vector_type(4)));
#define SSD_L_ACS 0
#define SSD_L_DTS 3072
#define SSD_L_BM 6144
#define SSD_RS_B 272
#define SSD_L_X (6144 + 128 * 272)
#define SSD_RS_X 144
#define SSD_XIMG (128 * 144)
#define SSD_RS_Y 784
template <int OFF0, int OFF1>
__device__ __forceinline__ s16x8 tr_frag(unsigned base) {
    s16x4 a, b;
    asm volatile("ds_read_b64_tr_b16 %0, %2 offset:%3\n\tds_read_b64_tr_b16 %1, %2 offset:%4\n\ts_waitcnt lgkmcnt(0)"
                 : "=&v"(a), "=&v"(b) : "v"(base), "n"(OFF0), "n"(OFF1) : "memory");
    return __builtin_shufflevector(a, b, 0, 1, 2, 3, 4, 5, 6, 7);
}
__device__ __forceinline__ unsigned lds_addr(LAS unsigned char* p) { return (unsigned)(size_t)p; }
template <int O0, int O1, int O2, int O3, int O4, int O5, int O6, int O7>
__device__ __forceinline__ void tr_read8(unsigned base, s16x4 (&v)[8]) {
    asm volatile("ds_read_b64_tr_b16 %0, %8 offset:%9\n\tds_read_b64_tr_b16 %1, %8 offset:%10\n\tds_read_b64_tr_b16 %2, %8 offset:%11\n\tds_read_b64_tr_b16 %3, %8 offset:%12\n\t"
                 "ds_read_b64_tr_b16 %4, %8 offset:%13\n\tds_read_b64_tr_b16 %5, %8 offset:%14\n\tds_read_b64_tr_b16 %6, %8 offset:%15\n\tds_read_b64_tr_b16 %7, %8 offset:%16\n\ts_waitcnt lgkmcnt(0)"
                 : "=&v"(v[0]), "=&v"(v[1]), "=&v"(v[2]), "=&v"(v[3]), "=&v"(v[4]), "=&v"(v[5]), "=&v"(v[6]), "=&v"(v[7])
                 : "v"(base), "n"(O0), "n"(O1), "n"(O2), "n"(O3), "n"(O4), "n"(O5), "n"(O6), "n"(O7) : "memory");
}
#define TRCAT(a, b) __builtin_shufflevector(a, b, 0, 1, 2, 3, 4, 5, 6, 7)


__device__ __forceinline__ void ssd_chunk_acs(LAS unsigned char* ldsb, const float* __restrict__ dtv, const float* __restrict__ a_log, int t0, int g, float* cdec_out) {
    const int w = __builtin_amdgcn_readfirstlane(threadIdx.x >> 6), lane = threadIdx.x & 63;
    if (w < 6) {
        const int head = 6 * g + w;
        const float A = -__expf(a_log[head]);
        const float v0 = dtv[(size_t)(t0 + 2 * lane) * SSD_HEADS + head], v1 = dtv[(size_t)(t0 + 2 * lane + 1) * SSD_HEADS + head];
        const float a1 = v1 * A;
        float s = v0 * A + a1;
#pragma unroll
        for (int o = 1; o < 64; o <<= 1) { const float tmp = __shfl_up(s, o); if (lane >= o) s += tmp; }
        LAS float* acs = (LAS float*)(ldsb + SSD_L_ACS) + w * 128;
        LAS float* dts = (LAS float*)(ldsb + SSD_L_DTS) + w * 128;
        acs[2 * lane] = s - a1; acs[2 * lane + 1] = s;
        dts[2 * lane] = v0; dts[2 * lane + 1] = v1;
        if (cdec_out && lane == 63) cdec_out[head] = __expf(s);
    }
}

__device__ __forceinline__ void ph_ssd_states(LAS unsigned char* ldsb, const bf16* __restrict__ xbc_b, const float* __restrict__ dtv, const float* __restrict__ a_log,
                                              bf16* __restrict__ Sbuf, float* __restrict__ cdec) {
    const int tid = threadIdx.x, w = __builtin_amdgcn_readfirstlane(tid >> 6), lane = tid & 63;
    const int r = lane & 31, h = lane >> 5, blk = (lane >> 4) & 1, q = (lane & 15) >> 2, pp = lane & 3;
    const int nt = w & 3, pt = w >> 2;
    for (int unit = blockIdx.x; unit < BATCH * 64 * SSD_GROUPS; unit += gridDim.x) {
        const int g = unit & 3, bc = unit >> 2;
        const int t0 = bc * 128;
        __syncthreads();
        ssd_chunk_acs(ldsb, dtv, a_log, t0, g, cdec + (size_t)bc * SSD_HEADS);
#pragma unroll
        for (int it_ = 0; it_ < 4; ++it_) { const int idx = tid + it_ * NTHR; const int row = idx >> 4, ch = idx & 15;
            const v4u v = *(const v4u*)(xbc_b + (size_t)(t0 + row) * CONV_DIM + 1536 + 128 * g + ch * 8);
            *(LAS v4u*)(ldsb + SSD_L_BM + row * SSD_RS_B + ch * 16) = v; }
        __syncthreads();
#pragma unroll
        for (int it_ = 0; it_ < 12; ++it_) { const int idx = tid + it_ * NTHR; const int hh = idx >> 10, rem = idx & 1023, row = rem >> 3, ch = rem & 7;
            const LAS float* acs = (const LAS float*)(ldsb + SSD_L_ACS) + hh * 128; const LAS float* dts = (const LAS float*)(ldsb + SSD_L_DTS) + hh * 128;
            const float wgt = dts[row] * __expf(acs[127] - acs[row]);
            float f[8]; unpack8(*(const v4u*)(xbc_b + (size_t)(t0 + row) * CONV_DIM + (6 * g + hh) * 64 + ch * 8), f);
            v4u o; o.x = pk2(f[0] * wgt, f[1] * wgt); o.y = pk2(f[2] * wgt, f[3] * wgt); o.z = pk2(f[4] * wgt, f[5] * wgt); o.w = pk2(f[6] * wgt, f[7] * wgt);
            *(LAS v4u*)(ldsb + SSD_L_X + hh * SSD_XIMG + row * SSD_RS_X + ch * 16) = o; }
        __syncthreads();
        const unsigned abase = lds_addr(ldsb + SSD_L_BM) + (8 * h + q) * SSD_RS_B + (32 * nt + 16 * blk + 4 * pp) * 2;
        s16x8 afr[8];
        { s16x4 av[8];
          tr_read8<0 * SSD_RS_B, 4 * SSD_RS_B, 16 * SSD_RS_B, 20 * SSD_RS_B, 32 * SSD_RS_B, 36 * SSD_RS_B, 48 * SSD_RS_B, 52 * SSD_RS_B>(abase, av);
          afr[0] = TRCAT(av[0], av[1]); afr[1] = TRCAT(av[2], av[3]); afr[2] = TRCAT(av[4], av[5]); afr[3] = TRCAT(av[6], av[7]);
          tr_read8<64 * SSD_RS_B, 68 * SSD_RS_B, 80 * SSD_RS_B, 84 * SSD_RS_B, 96 * SSD_RS_B, 100 * SSD_RS_B, 112 * SSD_RS_B, 116 * SSD_RS_B>(abase, av);
          afr[4] = TRCAT(av[0], av[1]); afr[5] = TRCAT(av[2], av[3]); afr[6] = TRCAT(av[4], av[5]); afr[7] = TRCAT(av[6], av[7]); }
#pragma unroll
        for (int hh = 0; hh < 6; ++hh) {
            const unsigned xb = lds_addr(ldsb + SSD_L_X + hh * SSD_XIMG) + (8 * h + q) * SSD_RS_X + (32 * pt + 16 * blk + 4 * pp) * 2;
            f32x16 acc;
#pragma unroll
            for (int i = 0; i < 16; ++i) acc[i] = 0.f;
            { s16x4 xv[8];
              tr_read8<0 * SSD_RS_X, 4 * SSD_RS_X, 16 * SSD_RS_X, 20 * SSD_RS_X, 32 * SSD_RS_X, 36 * SSD_RS_X, 48 * SSD_RS_X, 52 * SSD_RS_X>(xb, xv);
              acc = __builtin_amdgcn_mfma_f32_32x32x16_bf16(afr[0], TRCAT(xv[0], xv[1]), acc, 0, 0, 0);
              acc = __builtin_amdgcn_mfma_f32_32x32x16_bf16(afr[1], TRCAT(xv[2], xv[3]), acc, 0, 0, 0);
              acc = __builtin_amdgcn_mfma_f32_32x32x16_bf16(afr[2], TRCAT(xv[4], xv[5]), acc, 0, 0, 0);
              acc = __builtin_amdgcn_mfma_f32_32x32x16_bf16(afr[3], TRCAT(xv[6], xv[7]), acc, 0, 0, 0);
              tr_read8<64 * SSD_RS_X, 68 * SSD_RS_X, 80 * SSD_RS_X, 84 * SSD_RS_X, 96 * SSD_RS_X, 100 * SSD_RS_X, 112 * SSD_RS_X, 116 * SSD_RS_X>(xb, xv);
              acc = __builtin_amdgcn_mfma_f32_32x32x16_bf16(afr[4], TRCAT(xv[0], xv[1]), acc, 0, 0, 0);
              acc = __builtin_amdgcn_mfma_f32_32x32x16_bf16(afr[5], TRCAT(xv[2], xv[3]), acc, 0, 0, 0);
              acc = __builtin_amdgcn_mfma_f32_32x32x16_bf16(afr[6], TRCAT(xv[4], xv[5]), acc, 0, 0, 0);
              acc = __builtin_amdgcn_mfma_f32_32x32x16_bf16(afr[7], TRCAT(xv[6], xv[7]), acc, 0, 0, 0); }
            bf16* dst = Sbuf + (((size_t)bc * SSD_HEADS + 6 * g + hh) * 64 + 32 * pt + r) * 128 + 32 * nt + 4 * h;
#pragma unroll
            for (int q4 = 0; q4 < 4; ++q4) *(uint2*)(dst + 8 * q4) = make_uint2(pk2(acc[4 * q4], acc[4 * q4 + 1]), pk2(acc[4 * q4 + 2], acc[4 * q4 + 3]));
        }
    }
}

__device__ __forceinline__ void ph_ssd_scan(const bf16* __restrict__ Sbuf, const float* __restrict__ cdec, bf16* __restrict__ Hin, float* __restrict__ out, int rank, int nranks) {
    for (int idx = rank * NTHR + threadIdx.x; idx < BATCH * SSD_HEADS * 64 * 16; idx += nranks * NTHR) {
        const int n8 = idx & 15, p = (idx >> 4) & 63, hb = idx >> 10, hd = hb % SSD_HEADS, b = hb / SSD_HEADS;
        float st[8];
#pragma unroll
        for (int j = 0; j < 8; ++j) st[j] = 0.f;
#pragma unroll 8
        for (int c = 0; c < 64; ++c) {
            const size_t base = ((((size_t)(b * 64 + c)) * SSD_HEADS + hd) * 64 + p) * 128 + n8 * 8;
            v4u o; o.x = pk2(st[0], st[1]); o.y = pk2(st[2], st[3]); o.z = pk2(st[4], st[5]); o.w = pk2(st[6], st[7]);
            *(v4u*)(Hin + base) = o;
            float s[8]; unpack8(*(const v4u*)(Sbuf + base), s);
            const float a = cdec[(size_t)(b * 64 + c) * SSD_HEADS + hd];
#pragma unroll
            for (int j = 0; j < 8; ++j) st[j] = a * st[j] + s[j];
        }
        store8f(out + OUT_PS + (((size_t)b * SSD_HEADS + hd) * 64 + p) * 128 + n8 * 8, st);
    }
}

__device__ __forceinline__ void ph_ssd_out(LAS unsigned char* ldsb, const bf16* __restrict__ xbc_b, const bf16* __restrict__ projb, const float* __restrict__ dtv,
                                           const float* __restrict__ a_log, const float* __restrict__ d_skip, const float* __restrict__ norm_g,
                                           const bf16* __restrict__ Hin, bf16* __restrict__ A1) {
    const int tid = threadIdx.x, w = __builtin_amdgcn_readfirstlane(tid >> 6), lane = tid & 63;
    const int r = lane & 31, h = lane >> 5, blk = (lane >> 4) & 1, q = (lane & 15) >> 2, pp = lane & 3;
    const int lt = w & 3, hs = w >> 2;
    for (int unit = blockIdx.x; unit < BATCH * 64 * SSD_GROUPS; unit += gridDim.x) {
        const int g = unit & 3, bc = unit >> 2;
        const int t0 = bc * 128;
        __syncthreads();
        ssd_chunk_acs(ldsb, dtv, a_log, t0, g, nullptr);
#pragma unroll
        for (int it_ = 0; it_ < 4; ++it_) { const int idx = tid + it_ * NTHR; const int row = idx >> 4, ch = idx & 15;
            const v4u v = *(const v4u*)(xbc_b + (size_t)(t0 + row) * CONV_DIM + 1536 + 128 * g + ch * 8);
            *(LAS v4u*)(ldsb + SSD_L_BM + row * SSD_RS_B + ch * 16) = v; }
#pragma unroll
        for (int it_ = 0; it_ < 12; ++it_) { const int idx = tid + it_ * NTHR; const int hh = idx >> 10, rem = idx & 1023, row = rem >> 3, ch = rem & 7;
            const v4u v = *(const v4u*)(xbc_b + (size_t)(t0 + row) * CONV_DIM + (6 * g + hh) * 64 + ch * 8);
            *(LAS v4u*)(ldsb + SSD_L_X + hh * SSD_XIMG + row * SSD_RS_X + ch * 16) = v; }
        __syncthreads();
        const bf16* cp = xbc_b + (size_t)(t0 + 32 * lt + r) * CONV_DIM + 2048 + 128 * g + 8 * h;
        const int lcol = 32 * lt + r;
        const LAS float* acsb = (const LAS float*)(ldsb + SSD_L_ACS) + 3 * hs * 128; const LAS float* dtsb = (const LAS float*)(ldsb + SSD_L_DTS) + 3 * hs * 128;
        f32x16 y[3][2];
#pragma unroll
        for (int h3 = 0; h3 < 3; ++h3)
#pragma unroll
            for (int i = 0; i < 16; ++i) { y[h3][0][i] = 0.f; y[h3][1][i] = 0.f; }
#pragma unroll 1
        for (int ks = 0; ks < 8; ++ks) {
            const s16x8 cf = *(const s16x8*)(cp + 16 * ks);
#pragma unroll
            for (int h3 = 0; h3 < 3; ++h3) {
                const bf16* hp = Hin + (((size_t)bc * SSD_HEADS + 6 * g + 3 * hs + h3) * 64 + r) * 128 + 8 * h + 16 * ks;
                const s16x8 h0 = *(const s16x8*)hp, h1 = *(const s16x8*)(hp + 32 * 128);
                y[h3][0] = __builtin_amdgcn_mfma_f32_32x32x16_bf16(cf, h0, y[h3][0], 0, 0, 0);
                y[h3][1] = __builtin_amdgcn_mfma_f32_32x32x16_bf16(cf, h1, y[h3][1], 0, 0, 0);
            }
        }
#pragma unroll
        for (int h3 = 0; h3 < 3; ++h3)
#pragma unroll
            for (int q4 = 0; q4 < 4; ++q4) {
                const f32x4v a4 = *(const LAS f32x4v*)(acsb + h3 * 128 + 32 * lt + 8 * q4 + 4 * h);
                const float e0 = __expf(a4[0]), e1 = __expf(a4[1]), e2 = __expf(a4[2]), e3 = __expf(a4[3]);
                y[h3][0][4 * q4] *= e0; y[h3][0][4 * q4 + 1] *= e1; y[h3][0][4 * q4 + 2] *= e2; y[h3][0][4 * q4 + 3] *= e3;
                y[h3][1][4 * q4] *= e0; y[h3][1][4 * q4 + 1] *= e1; y[h3][1][4 * q4 + 2] *= e2; y[h3][1][4 * q4 + 3] *= e3;
            }
        const unsigned xb0 = lds_addr(ldsb + SSD_L_X + 3 * hs * SSD_XIMG) + (4 * h + q) * SSD_RS_X + (16 * blk + 4 * pp) * 2;
        for (int st = 0; st <= lt; ++st) {
            f32x16 cb;
#pragma unroll
            for (int i = 0; i < 16; ++i) cb[i] = 0.f;
#pragma unroll 2
            for (int ks = 0; ks < 8; ++ks) {
                const s16x8 cf = *(const s16x8*)(cp + 16 * ks);
                const s16x8 bfrag = *(const LAS s16x8*)(ldsb + SSD_L_BM + (32 * st + r) * SSD_RS_B + (16 * ks + 8 * h) * 2);
                cb = __builtin_amdgcn_mfma_f32_32x32x16_bf16(bfrag, cf, cb, 0, 0, 0);
            }
#pragma unroll
            for (int h3 = 0; h3 < 3; ++h3) {
                const LAS float* acs = acsb + h3 * 128; const LAS float* dts = dtsb + h3 * 128;
                const float myacs = acs[lcol];
                const float Dh = d_skip[6 * g + 3 * hs + h3];
                const unsigned xb = xb0 + h3 * SSD_XIMG + st * 32 * SSD_RS_X;
                s16x4 xv[8];
                tr_read8<0, 8 * SSD_RS_X, 64, 8 * SSD_RS_X + 64, 16 * SSD_RS_X, 24 * SSD_RS_X, 16 * SSD_RS_X + 64, 24 * SSD_RS_X + 64>(xb, xv);
#pragma unroll
                for (int kk = 0; kk < 2; ++kk) {
                    const int s0 = 32 * st + 16 * kk + 4 * h;
                    const f32x4v as0 = *(const LAS f32x4v*)(acs + s0), as1 = *(const LAS f32x4v*)(acs + s0 + 8);
                    const f32x4v ds0 = *(const LAS f32x4v*)(dts + s0), ds1 = *(const LAS f32x4v*)(dts + s0 + 8);
                    float wv[8];
#pragma unroll
                    for (int j = 0; j < 8; ++j) {
                        const int s = s0 + 8 * (j >> 2) + (j & 3);
                        const float asj = (j < 4) ? as0[j & 3] : as1[j & 3], dsj = (j < 4) ? ds0[j & 3] : ds1[j & 3];
                        float v = cb[8 * kk + j] * __expf(myacs - asj) * dsj;
                        v = (s <= lcol) ? v : 0.f;
                        v = (s == lcol) ? v + Dh : v;
                        wv[j] = v;
                    }
                    s16x8 afr;
                    { v4u o; o.x = pk2(wv[0], wv[1]); o.y = pk2(wv[2], wv[3]); o.z = pk2(wv[4], wv[5]); o.w = pk2(wv[6], wv[7]); afr = __builtin_bit_cast(s16x8, o); }
                    const s16x8 b0 = kk == 0 ? TRCAT(xv[0], xv[1]) : TRCAT(xv[4], xv[5]);
                    const s16x8 b1 = kk == 0 ? TRCAT(xv[2], xv[3]) : TRCAT(xv[6], xv[7]);
                    y[h3][0] = __builtin_amdgcn_mfma_f32_32x32x16_bf16(afr, b0, y[h3][0], 0, 0, 0);
                    y[h3][1] = __builtin_amdgcn_mfma_f32_32x32x16_bf16(afr, b1, y[h3][1], 0, 0, 0);
                    __builtin_amdgcn_sched_barrier(0);
                }
            }
        }
        __syncthreads();
        {
            LAS unsigned short* yst = (LAS unsigned short*)(ldsb + SSD_L_X);
#pragma unroll
            for (int h3 = 0; h3 < 3; ++h3)
#pragma unroll
                for (int ptile = 0; ptile < 2; ++ptile)
#pragma unroll
                    for (int reg = 0; reg < 16; ++reg) {
                        const int l0 = 32 * lt + (reg & 3) + 8 * (reg >> 2) + 4 * h;
                        const int col = (3 * hs + h3) * 64 + 32 * ptile + r;
                        yst[l0 * (SSD_RS_Y / 2) + col] = (unsigned short)f2bf(y[h3][ptile][reg]);
                    }
        }
        __syncthreads();
#pragma unroll
        for (int pass = 0; pass < 4; ++pass) {
            const int l = 4 * (pass * 8 + w) + (lane >> 4), i16 = lane & 15;
            float gv[3][8]; float ss = 0.f;
#pragma unroll
            for (int k = 0; k < 3; ++k) {
                const int col0 = 24 * i16 + 8 * k;
                float yv[8], zv[8];
                unpack8(*(const LAS v4u*)(ldsb + SSD_L_X + l * SSD_RS_Y + col0 * 2), yv);
                unpack8(*(const v4u*)(projb + (size_t)(t0 + l) * NB_LD + g * 384 + col0), zv);
#pragma unroll
                for (int j = 0; j < 8; ++j) { const float gg = yv[j] * silu_f(zv[j]); gv[k][j] = gg; ss += gg * gg; }
            }
            ss += __shfl_xor(ss, 1); ss += __shfl_xor(ss, 2); ss += __shfl_xor(ss, 4); ss += __shfl_xor(ss, 8);
            const float rstd = rsqrtf(ss * (1.0f / 384.0f) + LN_EPS);
#pragma unroll
            for (int k = 0; k < 3; ++k) {
                const int col0 = g * 384 + 24 * i16 + 8 * k;
                const float4 g0 = *(const float4*)(norm_g + col0), g1 = *(const float4*)(norm_g + col0 + 4);
                v4u o; o.x = pk2(gv[k][0] * rstd * g0.x, gv[k][1] * rstd * g0.y); o.y = pk2(gv[k][2] * rstd * g0.z, gv[k][3] * rstd * g0.w);
                o.z = pk2(gv[k][4] * rstd * g1.x, gv[k][5] * rstd * g1.y); o.w = pk2(gv[k][6] * rstd * g1.z, gv[k][7] * rstd * g1.w);
                *(v4u*)(A1 + (size_t)(t0 + l) * MIX_WIDTH + col0) = o;
            }
        }
    }
}

#define ATT_RS_V 144
#define ATT_VIMG (256 * ATT_RS_V)
#define ATT_PVT(KT) { \
        s16x4 vv_[8]; \
        tr_read8<(32 * KT) * ATT_RS_V, (32 * KT + 8) * ATT_RS_V, (32 * KT) * ATT_RS_V + 64, (32 * KT + 8) * ATT_RS_V + 64, \
                 (32 * KT + 16) * ATT_RS_V, (32 * KT + 24) * ATT_RS_V, (32 * KT + 16) * ATT_RS_V + 64, (32 * KT + 24) * ATT_RS_V + 64>(vbase, vv_); \
        _Pragma("unroll") for (int s2_ = 0; s2_ < 2; ++s2_) { \
            v4u o_; o_.x = pk2(s[KT][8 * s2_ + 0], s[KT][8 * s2_ + 1]); o_.y = pk2(s[KT][8 * s2_ + 2], s[KT][8 * s2_ + 3]); \
            o_.z = pk2(s[KT][8 * s2_ + 4], s[KT][8 * s2_ + 5]); o_.w = pk2(s[KT][8 * s2_ + 6], s[KT][8 * s2_ + 7]); \
            const s16x8 pf_ = __builtin_bit_cast(s16x8, o_); \
            const s16x8 a0_ = s2_ == 0 ? TRCAT(vv_[0], vv_[1]) : TRCAT(vv_[4], vv_[5]); \
            const s16x8 a1_ = s2_ == 0 ? TRCAT(vv_[2], vv_[3]) : TRCAT(vv_[6], vv_[7]); \
            o0 = __builtin_amdgcn_mfma_f32_32x32x16_bf16(a0_, pf_, o0, 0, 0, 0); \
            o1 = __builtin_amdgcn_mfma_f32_32x32x16_bf16(a1_, pf_, o1, 0, 0, 0); } }
__device__ __forceinline__ void ph_attn_prompt(LAS unsigned char* ldsb, const bf16* __restrict__ qrot_b, const bf16* __restrict__ krot_b, const bf16* __restrict__ projb,
                                               bf16* __restrict__ obuf, float* __restrict__ lsebuf) {
    const int tid = threadIdx.x, w = __builtin_amdgcn_readfirstlane(tid >> 6), lane = tid & 63;
    const int r = lane & 31, h = lane >> 5, blk = (lane >> 4) & 1, q = (lane & 15) >> 2, pp = lane & 3;
    const int qt = w & 3, hsel = w >> 2;
    for (int unit = blockIdx.x; unit < 3 * 512; unit += gridDim.x) {
        const int pat = unit >> 9, rem = unit & 511, hp = rem & 3, rem2 = rem >> 2, b = rem2 >> 6, bk = rem2 & 63;
        const int dsh = 2 * pat, nper = 64 >> dsh, res = bk >> (6 - dsh), nb = bk & (nper - 1);
        const int head = 2 * hp + hsel;
        __syncthreads();
#pragma unroll
        for (int it_ = 0; it_ < 8; ++it_) { const int idx = (tid & 255) + it_ * 256;
            const int row = idx >> 3, ch = idx & 7, js = 128 * nb - 128 + row;
            v4u v; v.x = 0u; v.y = 0u; v.z = 0u; v.w = 0u;
            if (js >= 0) v = *(const v4u*)(projb + (size_t)(b * SEQ + (js << dsh) + res) * NB_LD + NB_V + head * 64 + ch * 8);
            *(LAS v4u*)(ldsb + hsel * ATT_VIMG + row * ATT_RS_V + ch * 16) = v;
        }
        const int tq = b * SEQ + ((128 * nb + 32 * qt + r) << dsh) + res;
        s16x8 qf[4];
#pragma unroll
        for (int ks = 0; ks < 4; ++ks) qf[ks] = *(const s16x8*)(qrot_b + (size_t)tq * ATT_WIDTH + head * 64 + 16 * ks + 8 * h);
        f32x16 s[5];
#pragma unroll
        for (int kt = 0; kt < 5; ++kt) {
            int js = 128 * nb + 32 * qt - 128 + 32 * kt + r; js = js < 0 ? 0 : js;
            const bf16* kp = krot_b + (size_t)(b * SEQ + (js << dsh) + res) * ATT_WIDTH + head * 64 + 8 * h;
#pragma unroll
            for (int i = 0; i < 16; ++i) s[kt][i] = 0.f;
#pragma unroll
            for (int ks = 0; ks < 4; ++ks) s[kt] = __builtin_amdgcn_mfma_f32_32x32x16_bf16(*(const s16x8*)(kp + 16 * ks), qf[ks], s[kt], 0, 0, 0);
        }
        float m = -INFINITY;
#pragma unroll
        for (int kt = 0; kt < 5; ++kt) {
            const bool tile_ok = (nb > 0) || (qt + kt >= 4);
#pragma unroll
            for (int reg = 0; reg < 16; ++reg) {
                const int c = (reg & 3) + 8 * (reg >> 2) + 4 * h;
                const bool ok = tile_ok && (kt == 0 ? (c >= r) : (kt == 4 ? (c <= r) : true));
                const float v = ok ? s[kt][reg] * 0.125f : -INFINITY;
                s[kt][reg] = v; m = fmaxf(m, v);
            }
        }
        m = fmaxf(m, __shfl_xor(m, 32));
        float l = 0.f;
#pragma unroll
        for (int kt = 0; kt < 5; ++kt)
#pragma unroll
            for (int reg = 0; reg < 16; ++reg) { const float p = __expf(s[kt][reg] - m); s[kt][reg] = p; l += p; }
        l += __shfl_xor(l, 32);
        __syncthreads();
        f32x16 o0, o1;
#pragma unroll
        for (int i = 0; i < 16; ++i) { o0[i] = 0.f; o1[i] = 0.f; }
        const unsigned vbase = lds_addr(ldsb + hsel * ATT_VIMG) + (32 * qt + 4 * h + q) * ATT_RS_V + (16 * blk + 4 * pp) * 2;
        ATT_PVT(0) ATT_PVT(1) ATT_PVT(2) ATT_PVT(3) ATT_PVT(4)
        const float inv = 1.0f / l;
        bf16* op = obuf + ((size_t)pat * T_PROMPT + tq) * ATT_WIDTH + head * 64 + 4 * h;
#pragma unroll
        for (int q4 = 0; q4 < 4; ++q4) {
            *(uint2*)(op + 8 * q4) = make_uint2(pk2(o0[4 * q4] * inv, o0[4 * q4 + 1] * inv), pk2(o0[4 * q4 + 2] * inv, o0[4 * q4 + 3] * inv));
            *(uint2*)(op + 32 + 8 * q4) = make_uint2(pk2(o1[4 * q4] * inv, o1[4 * q4 + 1] * inv), pk2(o1[4 * q4 + 2] * inv, o1[4 * q4 + 3] * inv));
        }
        if (h == 0) lsebuf[((size_t)pat * T_PROMPT + tq) * 8 + head] = m + __logf(l);
    }
}
__device__ __forceinline__ void ph_attn_combine(const bf16* __restrict__ obuf, const float* __restrict__ lsebuf, bf16* __restrict__ A1) {
    const int lane = threadIdx.x & 63;
    for (int t = blockIdx.x * NWAVE + (threadIdx.x >> 6); t < T_PROMPT; t += gridDim.x * NWAVE) {
        const int hd = lane >> 3;
        const float l0 = lsebuf[((size_t)0 * T_PROMPT + t) * 8 + hd], l1 = lsebuf[((size_t)1 * T_PROMPT + t) * 8 + hd], l2 = lsebuf[((size_t)2 * T_PROMPT + t) * 8 + hd];
        const float mx = fmaxf(l0, fmaxf(l1, l2));
        const float e0 = __expf(l0 - mx), e1 = __expf(l1 - mx), e2 = __expf(l2 - mx);
        const float inv = 1.0f / (e0 + e1 + e2);
        float a[8], b[8], c[8];
        unpack8(*(const v4u*)(obuf + ((size_t)0 * T_PROMPT + t) * ATT_WIDTH + lane * 8), a);
        unpack8(*(const v4u*)(obuf + ((size_t)1 * T_PROMPT + t) * ATT_WIDTH + lane * 8), b);
        unpack8(*(const v4u*)(obuf + ((size_t)2 * T_PROMPT + t) * ATT_WIDTH + lane * 8), c);
        float o[8];
#pragma unroll
        for (int j = 0; j < 8; ++j) o[j] = (e0 * a[j] + e1 * b[j] + e2 * c[j]) * inv;
        v4u w; w.x = pk2(o[0], o[1]); w.y = pk2(o[2], o[3]); w.z = pk2(o[4], o[5]); w.w = pk2(o[6], o[7]);
        *(v4u*)(A1 + (size_t)t * MIX_WIDTH + SSD_WIDTH + lane * 8) = w;
    }
}

#define RT_RS 272
#define RT_KIMG (128 * RT_RS)
#define RT_LUT (2 * RT_KIMG)
constexpr unsigned char RT_CANDS[64] = {0, 1, 2, 3, 4, 5, 6, 7, 8, 9, 10, 11, 12, 13, 14, 15, 16, 17, 18, 19, 20, 21, 22, 23, 32, 33, 34, 35, 36, 48, 49, 50, 51, 64, 65, 66, 80, 81, 96, 97,
                                        112, 113, 128, 144, 160, 176, 192, 208, 224, 240, 0, 0, 0, 0, 0, 0, 0, 0, 0, 0, 0, 0, 0, 0};
__device__ __forceinline__ unsigned rt_mono(float f) { const unsigned u = __builtin_bit_cast(unsigned, f); return u ^ ((unsigned)((int)u >> 31) | 0x80000000u); }
__device__ __forceinline__ float rt_unmono(unsigned m) { const unsigned u = (m & 0x80000000u) ? (m ^ 0x80000000u) : ~m; return __builtin_bit_cast(float, u); }
#define RT_CE_DESC(a, b) { const unsigned x_ = (a), y_ = (b); (a) = x_ > y_ ? x_ : y_; (b) = x_ > y_ ? y_ : x_; }
#define RT_CE_ASC(a, b) { const unsigned x_ = (a), y_ = (b); (a) = x_ > y_ ? y_ : x_; (b) = x_ > y_ ? x_ : y_; }
__device__ __forceinline__ void rt_sort16(unsigned (&v)[16]) {
#pragma unroll
    for (int k = 2; k <= 16; k <<= 1)
#pragma unroll
        for (int j = k >> 1; j > 0; j >>= 1)
#pragma unroll
            for (int i = 0; i < 16; ++i) { const int l = i ^ j; if (l > i) { if ((i & k) == 0) RT_CE_DESC(v[i], v[l]) else RT_CE_ASC(v[i], v[l]) } }
}
__device__ __forceinline__ void rt_merge16(unsigned (&v)[16]) {
#pragma unroll
    for (int j = 8; j > 0; j >>= 1)
#pragma unroll
        for (int i = 0; i < 16; ++i) { const int l = i ^ j; if (l > i) RT_CE_DESC(v[i], v[l]) }
}
__device__ __forceinline__ void rt_top16(unsigned (&a)[16], const unsigned (&b)[16]) {
#pragma unroll
    for (int i = 0; i < 16; ++i) a[i] = a[i] > b[15 - i] ? a[i] : b[15 - i];
    rt_merge16(a);
}
__device__ __forceinline__ void rt_top16_partner(unsigned (&a)[16]) {
    unsigned b[16];
#pragma unroll
    for (int i = 0; i < 16; ++i) b[i] = (unsigned)__shfl_xor((int)a[i], 32);
    rt_top16(a, b);
}
__device__ __forceinline__ void rt_scores_top16(LAS unsigned char* kimg, const bf16* __restrict__ qp, int r, int h, unsigned (&k0)[16]) {
    f32x16 acc[4];
#pragma unroll
    for (int kt = 0; kt < 4; ++kt)
#pragma unroll
        for (int i = 0; i < 16; ++i) acc[kt][i] = 0.f;
#pragma unroll
    for (int ks = 0; ks < 8; ++ks) {
        const s16x8 qf = *(const s16x8*)(qp + 16 * ks);
#pragma unroll
        for (int kt = 0; kt < 4; ++kt) {
            const s16x8 kf = *(const LAS s16x8*)(kimg + (32 * kt + r) * RT_RS + (16 * ks + 8 * h) * 2);
            acc[kt] = __builtin_amdgcn_mfma_f32_32x32x16_bf16(kf, qf, acc[kt], 0, 0, 0);
        }
    }
    unsigned k1[16], k2[16], k3[16];
#pragma unroll
    for (int reg = 0; reg < 16; ++reg) {
        const unsigned ki = (unsigned)((reg & 3) + 8 * (reg >> 2) + 4 * h);
        k0[reg] = (rt_mono(acc[0][reg]) & 0xFFFFFF80u) | ki;
        k1[reg] = (rt_mono(acc[1][reg]) & 0xFFFFFF80u) | (ki + 32u);
        k2[reg] = (rt_mono(acc[2][reg]) & 0xFFFFFF80u) | (ki + 64u);
        k3[reg] = (rt_mono(acc[3][reg]) & 0xFFFFFF80u) | (ki + 96u);
    }
    rt_sort16(k0); rt_sort16(k1); rt_sort16(k2); rt_sort16(k3);
    rt_top16(k0, k1); rt_top16(k2, k3); rt_top16(k0, k2);
    rt_top16_partner(k0);
}
__device__ __forceinline__ void ph_peer_route2(LAS unsigned char* ldsb, const bf16* __restrict__ qhb, const float* __restrict__ keys1, const float* __restrict__ keys2,
                                               int* __restrict__ eidx, float* __restrict__ gate) {
    const int tid = threadIdx.x, w = __builtin_amdgcn_readfirstlane(tid >> 6), lane = tid & 63, r = lane & 31, h = lane >> 5;
    __syncthreads();
    for (int idx = tid; idx < 2 * 128 * 16; idx += NTHR) {
        const int tb = idx >> 11, rem = idx & 2047, row = rem >> 4, ch = rem & 15;
        const float* sp = (tb ? keys2 : keys1) + row * 128 + ch * 8;
        const float4 a = *(const float4*)sp, b = *(const float4*)(sp + 4);
        v4u o; o.x = pk2(a.x, a.y); o.y = pk2(a.z, a.w); o.z = pk2(b.x, b.y); o.w = pk2(b.z, b.w);
        *(LAS v4u*)(ldsb + tb * RT_KIMG + row * RT_RS + ch * 16) = o;
    }
    __syncthreads();
    LAS unsigned* lut = (LAS unsigned*)(ldsb + RT_LUT) + w * 512;
    for (int unit = blockIdx.x * NWAVE + w; unit < (T_ALL / 32) * 8; unit += gridDim.x * NWAVE) {
        const int tt = unit >> 3, hd = unit & 7;
        const int tok = 32 * tt + r;
        const bf16* qp = qhb + (size_t)tok * 2048 + hd * 256 + 8 * h;
        unsigned ka[16], kb[16];
        rt_scores_top16(ldsb, qp, r, h, ka);
        rt_scores_top16(ldsb + RT_KIMG, qp + 128, r, h, kb);
        float v1[16], v2[16];
#pragma unroll
        for (int i = 0; i < 16; ++i) { v1[i] = rt_unmono(ka[i] & 0xFFFFFF80u); v2[i] = rt_unmono(kb[i] & 0xFFFFFF80u); }
#pragma unroll
        for (int wd = 0; wd < 4; ++wd) {
            lut[wd * 64 + lane] = (ka[4 * wd] & 0x7Fu) | ((ka[4 * wd + 1] & 0x7Fu) << 8) | ((ka[4 * wd + 2] & 0x7Fu) << 16) | ((ka[4 * wd + 3] & 0x7Fu) << 24);
            lut[(4 + wd) * 64 + lane] = (kb[4 * wd] & 0x7Fu) | ((kb[4 * wd + 1] & 0x7Fu) << 8) | ((kb[4 * wd + 2] & 0x7Fu) << 16) | ((kb[4 * wd + 3] & 0x7Fu) << 24);
        }
        unsigned c0[16], c1[16];
        c0[0] = (rt_mono(h ? (v1[0] + v2[1]) : (v1[0] + v2[0])) & 0xFFFFFF00u) | (h ? 1u : 0u);
        c0[1] = (rt_mono(h ? (v1[0] + v2[3]) : (v1[0] + v2[2])) & 0xFFFFFF00u) | (h ? 3u : 2u);
        c0[2] = (rt_mono(h ? (v1[0] + v2[5]) : (v1[0] + v2[4])) & 0xFFFFFF00u) | (h ? 5u : 4u);
        c0[3] = (rt_mono(h ? (v1[0] + v2[7]) : (v1[0] + v2[6])) & 0xFFFFFF00u) | (h ? 7u : 6u);
        c0[4] = (rt_mono(h ? (v1[0] + v2[9]) : (v1[0] + v2[8])) & 0xFFFFFF00u) | (h ? 9u : 8u);
        c0[5] = (rt_mono(h ? (v1[0] + v2[11]) : (v1[0] + v2[10])) & 0xFFFFFF00u) | (h ? 11u : 10u);
        c0[6] = (rt_mono(h ? (v1[0] + v2[13]) : (v1[0] + v2[12])) & 0xFFFFFF00u) | (h ? 13u : 12u);
        c0[7] = (rt_mono(h ? (v1[0] + v2[15]) : (v1[0] + v2[14])) & 0xFFFFFF00u) | (h ? 15u : 14u);
        c0[8] = (rt_mono(h ? (v1[1] + v2[1]) : (v1[1] + v2[0])) & 0xFFFFFF00u) | (h ? 17u : 16u);
        c0[9] = (rt_mono(h ? (v1[1] + v2[3]) : (v1[1] + v2[2])) & 0xFFFFFF00u) | (h ? 19u : 18u);
        c0[10] = (rt_mono(h ? (v1[1] + v2[5]) : (v1[1] + v2[4])) & 0xFFFFFF00u) | (h ? 21u : 20u);
        c0[11] = (rt_mono(h ? (v1[1] + v2[7]) : (v1[1] + v2[6])) & 0xFFFFFF00u) | (h ? 23u : 22u);
        c0[12] = (rt_mono(h ? (v1[2] + v2[1]) : (v1[2] + v2[0])) & 0xFFFFFF00u) | (h ? 33u : 32u);
        c0[13] = (rt_mono(h ? (v1[2] + v2[3]) : (v1[2] + v2[2])) & 0xFFFFFF00u) | (h ? 35u : 34u);
        c0[14] = (rt_mono(h ? (v1[3] + v2[0]) : (v1[2] + v2[4])) & 0xFFFFFF00u) | (h ? 48u : 36u);
        c0[15] = (rt_mono(h ? (v1[3] + v2[2]) : (v1[3] + v2[1])) & 0xFFFFFF00u) | (h ? 50u : 49u);
        c1[0] = (rt_mono(h ? (v1[4] + v2[0]) : (v1[3] + v2[3])) & 0xFFFFFF00u) | (h ? 64u : 51u);
        c1[1] = (rt_mono(h ? (v1[4] + v2[2]) : (v1[4] + v2[1])) & 0xFFFFFF00u) | (h ? 66u : 65u);
        c1[2] = (rt_mono(h ? (v1[5] + v2[1]) : (v1[5] + v2[0])) & 0xFFFFFF00u) | (h ? 81u : 80u);
        c1[3] = (rt_mono(h ? (v1[6] + v2[1]) : (v1[6] + v2[0])) & 0xFFFFFF00u) | (h ? 97u : 96u);
        c1[4] = (rt_mono(h ? (v1[7] + v2[1]) : (v1[7] + v2[0])) & 0xFFFFFF00u) | (h ? 113u : 112u);
        c1[5] = (rt_mono(h ? (v1[9] + v2[0]) : (v1[8] + v2[0])) & 0xFFFFFF00u) | (h ? 144u : 128u);
        c1[6] = (rt_mono(h ? (v1[11] + v2[0]) : (v1[10] + v2[0])) & 0xFFFFFF00u) | (h ? 176u : 160u);
        c1[7] = (rt_mono(h ? (v1[13] + v2[0]) : (v1[12] + v2[0])) & 0xFFFFFF00u) | (h ? 208u : 192u);
        c1[8] = (rt_mono(h ? (v1[15] + v2[0]) : (v1[14] + v2[0])) & 0xFFFFFF00u) | (h ? 240u : 224u);
        c1[9] = 0u;
        c1[10] = 0u;
        c1[11] = 0u;
        c1[12] = 0u;
        c1[13] = 0u;
        c1[14] = 0u;
        c1[15] = 0u;
        rt_sort16(c0); rt_sort16(c1); rt_top16(c0, c1); rt_top16_partner(c0);
        float e[16]; float sum = 0.f;
        const float mx = rt_unmono(c0[0] & 0xFFFFFF00u);
#pragma unroll
        for (int k = 0; k < 16; ++k) { e[k] = __expf(rt_unmono(c0[k] & 0xFFFFFF00u) - mx); sum += e[k]; }
        const float inv = 1.0f / sum;
        asm volatile("s_waitcnt lgkmcnt(0)" ::: "memory");
        int ex[8]; float gv[8];
#pragma unroll
        for (int k = 0; k < 8; ++k) {
            const unsigned hm = (unsigned)(-h);
            const unsigned ck = (c0[k] & ~hm) | (c0[8 + k] & hm);
            const float ek = __builtin_bit_cast(float, (__builtin_bit_cast(unsigned, e[k]) & ~hm) | (__builtin_bit_cast(unsigned, e[8 + k]) & hm));
            const unsigned ci = (ck >> 4) & 15u, cj = ck & 15u;
            const unsigned w1 = lut[(ci >> 2) * 64 + lane], w2 = lut[(4 + (cj >> 2)) * 64 + lane];
            const unsigned i1 = (w1 >> (8 * (ci & 3))) & 0x7Fu, i2 = (w2 >> (8 * (cj & 3))) & 0x7Fu;
            ex[k] = (int)(i1 * PEER_NKEYS + i2); gv[k] = ek * inv;
        }
        int* ep = eidx + (size_t)tok * 128 + hd * 16 + 8 * h; float* gp = gate + (size_t)tok * 128 + hd * 16 + 8 * h;
        *(int4*)ep = make_int4(ex[0], ex[1], ex[2], ex[3]); *(int4*)(ep + 4) = make_int4(ex[4], ex[5], ex[6], ex[7]);
        *(float4*)gp = make_float4(gv[0], gv[1], gv[2], gv[3]); *(float4*)(gp + 4) = make_float4(gv[4], gv[5], gv[6], gv[7]);
    }
}

struct Params {
    const float* in[23];
    float* out;
    unsigned char* ws;
    unsigned* bar;
};

#define WS_BAR      0ull
#define WS_XALL     (1ull << 20)
#define WS_PROJ     (WS_XALL + (size_t)T_ALL * D_MODEL * 4)
#define WS_XBC      (WS_PROJ + (size_t)T_ALL * PROJ_LD * 4)
#define WS_DT       (WS_XBC + (size_t)T_ALL * CONV_DIM * 4)
#define WS_QROT     (WS_DT + (size_t)T_ALL * SSD_HEADS * 4)
#define WS_KROT     (WS_QROT + (size_t)T_ALL * ATT_WIDTH * 4)
#define WS_YBUF     (WS_KROT + (size_t)T_ALL * ATT_WIDTH * 4)
#define WS_MIX      (WS_YBUF + (size_t)T_ALL * MIX_WIDTH * 4)
#define WS_HBUF     (WS_MIX + (size_t)T_ALL * D_MODEL * 4)
#define WS_QH       (WS_HBUF + (size_t)T_ALL * D_MODEL * 4)
#define WS_EIDX     (WS_QH + (size_t)T_ALL * 2048 * 4)
#define WS_GATE     (WS_EIDX + (size_t)T_ALL * 128 * 4)
#define WS_A0       (WS_GATE + (size_t)T_ALL * 128 * 4)
#define WS_A1       (WS_A0 + (size_t)T_ALL * D_MODEL * 2)
#define WS_A2       (WS_A1 + (size_t)T_ALL * MIX_WIDTH * 2)
#define WS_WTIN     (WS_A2 + (size_t)T_ALL * D_MODEL * 2)
#define WS_WTOUT    (WS_WTIN + (size_t)PROJ_LD * D_MODEL * 2)
#define WS_WTQ      (WS_WTOUT + (size_t)D_MODEL * MIX_WIDTH * 2)
#define WS_PROJB    (WS_WTQ + (size_t)2048 * D_MODEL * 2)
#define WS_DTRAW    (WS_PROJB + (size_t)T_ALL * NB_LD * 2)
#define WS_XBCB     (WS_DTRAW + (size_t)T_ALL * 32 * 4)
#define WS_QROTB    (WS_XBCB + (size_t)T_ALL * CONV_DIM * 2)
#define WS_KROTB    (WS_QROTB + (size_t)T_ALL * ATT_WIDTH * 2)
#define WS_UB       (WS_KROTB + (size_t)T_ALL * ATT_WIDTH * 2)
#define WS_VB       (WS_UB + (size_t)16384 * D_MODEL * 2)
#define WS_USC      (WS_VB + (size_t)16384 * D_MODEL * 2)
#define WS_VSC      (WS_USC + 16384 * 4)
#define WS_SBUF     (WS_VSC + 16384 * 4)
#define WS_HIN      (WS_SBUF + (size_t)BATCH * 64 * SSD_HEADS * 64 * 128 * 2)
#define WS_CDEC     (WS_HIN + (size_t)BATCH * 64 * SSD_HEADS * 64 * 128 * 2)
#define WS_OBUF     (WS_CDEC + (size_t)BATCH * 64 * SSD_HEADS * 4)
#define WS_LSE      (WS_OBUF + (size_t)3 * T_PROMPT * ATT_WIDTH * 2)
#define WS_ROPE     (WS_LSE + (size_t)3 * T_PROMPT * 8 * 4)
#define WS_END      (WS_ROPE + (size_t)SEQ * 64 * 4)

#define LDS_BYTES (160 * 1024)
#define N9_SLICES 13440u

#define KP const __attribute__((address_space(4))) Params* kp = (const __attribute__((address_space(4))) Params*)__builtin_amdgcn_kernarg_segment_ptr(); asm volatile("" : "+s"(kp)); unsigned char* ws = kp->ws; (void)ws;
#define IN(i) (kp->in[i])
#define WSP(T, off) ((T*)(ws + (off)))
__global__ void __launch_bounds__(512, 2) mega_fwd(Params p) {
    extern __shared__ __attribute__((aligned(16))) unsigned char smem[];
    if (threadIdx.x == 0) *(uint4*)smem = make_uint4(0u, 0u, 0u, 0u);
    __syncthreads();
    XcdBarrier bar = xcd_barrier_post(p.bar, (volatile LAS unsigned*)smem);
    float* lds = (float*)(smem + 256);
    LAS unsigned char* ldsb = (LAS unsigned char*)smem + 256;

    { KP ph_prologue(ldsb, IN(0), IN(1), WSP(bf16, WS_A0), IN(6), WSP(bf16, WS_WTIN), WSP(float, WS_ROPE)); }
    xcd_barrier(bar);
    { KP pg8::Gemm g{WSP(bf16, WS_A0), WSP(bf16, WS_WTIN), T_ALL, PROJ_LD, D_MODEL}; pg8::StaticOrder S; S.init(g.M, g.N, (int)gridDim.x, (int)blockIdx.x);
      pg8::EpiProj E{WSP(bf16, WS_PROJB), WSP(float, WS_DTRAW)}; pg8::gemm_phase<pg8::EpiProj, pg8::StaticOrder, false>(ldsb, g, S, E, nullptr); }
    xcd_barrier(bar);
    { KP ph_post_proj_prompt(WSP(bf16, WS_PROJB), WSP(float, WS_DTRAW), IN(7), IN(8), IN(9), WSP(float, WS_ROPE), WSP(bf16, WS_XBCB), WSP(float, WS_DT), WSP(bf16, WS_QROTB), WSP(bf16, WS_KROTB), kp->out); }
    { KP ph_post_proj2(WSP(bf16, WS_PROJB), WSP(float, WS_DTRAW), IN(4), IN(7), IN(8), IN(9), WSP(bf16, WS_XBCB), WSP(float, WS_DT), WSP(bf16, WS_QROTB), WSP(bf16, WS_KROTB), kp->out); }
    xcd_barrier(bar);
    { KP ph_ssd_states(ldsb, WSP(bf16, WS_XBCB), WSP(float, WS_DT), IN(10), WSP(bf16, WS_SBUF), WSP(float, WS_CDEC)); }
    __syncthreads();
    { KP ph_attn_prompt(ldsb, WSP(bf16, WS_QROTB), WSP(bf16, WS_KROTB), WSP(bf16, WS_PROJB), WSP(bf16, WS_OBUF), WSP(float, WS_LSE)); }
    __syncthreads();
    { KP ph_ssd_decode(WSP(bf16, WS_XBCB), WSP(float, WS_DT), IN(10), IN(11), IN(5), WSP(float, WS_YBUF), kp->out); }
    { KP ph_attn_sample(lds, WSP(bf16, WS_QROTB), WSP(bf16, WS_KROTB), WSP(bf16, WS_PROJB), IN(2), IN(3), WSP(bf16, WS_A1)); }
    xcd_barrier(bar);
    if ((int)gridDim.x > 128) {
        if ((int)blockIdx.x < 96) { KP ph_ssd_scan(WSP(bf16, WS_SBUF), WSP(float, WS_CDEC), WSP(bf16, WS_HIN), kp->out, (int)blockIdx.x, 96); }
        else {
            { KP ph_prologue2(ldsb, IN(13), WSP(bf16, WS_WTOUT), IN(16), WSP(bf16, WS_WTQ), (int)blockIdx.x - 96, (int)gridDim.x - 96); }
            { KP ph_quant_tables(IN(19), IN(20), WSP(unsigned char, WS_UB), WSP(unsigned char, WS_VB), WSP(float, WS_USC), WSP(float, WS_VSC), (int)blockIdx.x - 96, (int)gridDim.x - 96); }
        }
    } else {
        { KP ph_ssd_scan(WSP(bf16, WS_SBUF), WSP(float, WS_CDEC), WSP(bf16, WS_HIN), kp->out, (int)blockIdx.x, (int)gridDim.x); }
        { KP ph_prologue2(ldsb, IN(13), WSP(bf16, WS_WTOUT), IN(16), WSP(bf16, WS_WTQ), (int)blockIdx.x, (int)gridDim.x); }
        { KP ph_quant_tables(IN(19), IN(20), WSP(unsigned char, WS_UB), WSP(unsigned char, WS_VB), WSP(float, WS_USC), WSP(float, WS_VSC), (int)blockIdx.x, (int)gridDim.x); }
    }
    xcd_barrier(bar);
    { KP ph_ssd_out(ldsb, WSP(bf16, WS_XBCB), WSP(bf16, WS_PROJB), WSP(float, WS_DT), IN(10), IN(11), IN(12), WSP(bf16, WS_HIN), WSP(bf16, WS_A1)); }
    { KP ph_attn_combine(WSP(bf16, WS_OBUF), WSP(float, WS_LSE), WSP(bf16, WS_A1)); }
    { KP ph_gate_norm(WSP(bf16, WS_PROJB), IN(12), WSP(float, WS_YBUF), WSP(bf16, WS_A1)); }
    xcd_barrier(bar);
    { KP pg8::Gemm g{WSP(bf16, WS_A1), WSP(bf16, WS_WTOUT), T_ALL, D_MODEL, MIX_WIDTH}; pg8::StaticOrder S; S.init(g.M, g.N, (int)gridDim.x, (int)blockIdx.x);
      pg8::EpiF32 E{WSP(float, WS_MIX), D_MODEL, nullptr}; pg8::gemm_phase<pg8::EpiF32, pg8::StaticOrder, false>(ldsb, g, S, E, nullptr); }
    if (blockIdx.x >= 8 && gridDim.x == 256) { KP cache_copy_slice(IN(2), IN(3), kp->out, N9_SLICES + (blockIdx.x - 8) * 8u + (threadIdx.x >> 6), threadIdx.x & 63u); }
    xcd_barrier(bar);
    { KP ph_ln_res(IN(0), IN(1), WSP(float, WS_MIX), IN(14), IN(15), WSP(float, WS_HBUF), WSP(bf16, WS_A2)); }
    xcd_barrier(bar);
    { KP pg8::Gemm g{WSP(bf16, WS_A2), WSP(bf16, WS_WTQ), T_ALL, 2048, D_MODEL}; pg8::StaticOrder S; S.init(g.M, g.N, (int)gridDim.x, (int)blockIdx.x);
      pg8::EpiBf16Plain E{WSP(bf16, WS_QH), 2048}; pg8::gemm_phase<pg8::EpiBf16Plain, pg8::StaticOrder, false>(ldsb, g, S, E, nullptr); }
    if (blockIdx.x >= 16 && gridDim.x == 256 && threadIdx.x < 256) { KP cache_copy_slice(IN(2), IN(3), kp->out, N9_SLICES + 1984u + (blockIdx.x - 16) * 4u + (threadIdx.x >> 6), threadIdx.x & 63u); }
    xcd_barrier(bar);
    { KP ph_peer_route2(ldsb, WSP(bf16, WS_QH), IN(17), IN(18), WSP(int, WS_EIDX), WSP(float, WS_GATE)); }
    xcd_barrier(bar);
    { KP ph_peer_ffn3(WSP(float, WS_HBUF), WSP(int, WS_EIDX), WSP(float, WS_GATE), WSP(unsigned char, WS_UB), WSP(unsigned char, WS_VB), WSP(float, WS_USC), WSP(float, WS_VSC), IN(21), IN(22), kp->out, IN(2), IN(3), gridDim.x == 256 ? N9_SLICES : 16384u); }
}

extern "C" void kernel_launch(void* const* d_in, const int* in_sizes, int n_in, void* d_out, int out_size, void* d_ws, size_t ws_size, hipStream_t stream) {
    static int grid = 0;
    if (grid == 0) {
        int dev = 0, cus = 0, per_cu = 0;
        if (hipGetDevice(&dev) != hipSuccess || hipDeviceGetAttribute(&cus, hipDeviceAttributeMultiprocessorCount, dev) != hipSuccess) { fprintf(stderr, "kernel_launch: device query failed\n"); grid = -1; return; }
        if (hipFuncSetAttribute((const void*)mega_fwd, hipFuncAttributeMaxDynamicSharedMemorySize, LDS_BYTES) != hipSuccess) { fprintf(stderr, "kernel_launch: hipFuncSetAttribute failed\n"); grid = -1; return; }
        if (hipOccupancyMaxActiveBlocksPerMultiprocessor(&per_cu, (const void*)mega_fwd, NTHR, LDS_BYTES) != hipSuccess || per_cu < 1) { fprintf(stderr, "kernel_launch: occupancy query says %d\n", per_cu); }
        (void)hipGetLastError();
        grid = cus;
        if (ws_size < WS_END) { fprintf(stderr, "kernel_launch: workspace too small\n"); grid = -1; return; }
    }
    if (grid < 0) return;
    (void)hipMemsetAsync((char*)d_ws + WS_BAR, 0, XCD_BAR_WORDS * sizeof(unsigned), stream);
    Params p{};
    for (int i = 0; i < 23; ++i) p.in[i] = (const float*)d_in[i];
    p.out = (float*)d_out; p.ws = (unsigned char*)d_ws; p.bar = (unsigned*)((char*)d_ws + WS_BAR);
    hipLaunchKernelGGL(mega_fwd, dim3(grid), dim3(NTHR), LDS_BYTES, stream, p);
}
```

```cpp
#include <hip/hip_runtime.h>
#include <stdint.h>

#define D_MODEL 1024
#define BATCH 2
#define SEQ 8192
#define DEC_BATCH 128
#define DEC_SEQ 4
#define PAST_LEN 8192
#define HEAD_DIM 64
#define ATT_WIDTH 512
#define ATT_HEADS 8
#define SSD_WIDTH 1536
#define SSD_HEADS 24
#define SSD_GROUPS 4
#define SSD_STATE 128
#define CONV_DIM 2560
#define IN_WIDTH 5656
#define PROJ_LD 5888
#define MIX_WIDTH 2048
#define WBUF 2048
#define PEER_NKEYS 128
#define PEER_HEADS 8
#define PEER_TOPK 16
#define PEER_DKEY 256
#define T_PROMPT (BATCH * SEQ)
#define T_SAMPLE (DEC_BATCH * DEC_SEQ)
#define T_ALL (T_PROMPT + T_SAMPLE)
#define O_Z 0
#define O_XBC 1536
#define O_DT 4096
#define O_Q 4120
#define O_K 4632
#define O_V 5144
#define ALPHA_F 1.189207115002721f
#define LN_EPS 1e-5f

#define OUT_YP 0ull
#define OUT_YS (OUT_YP + 16777216ull)
#define OUT_PK (OUT_YS + 524288ull)
#define OUT_PV (OUT_PK + 2097152ull)
#define OUT_PC (OUT_PV + 2097152ull)
#define OUT_PS (OUT_PC + 15360ull)
#define OUT_SK (OUT_PS + 393216ull)
#define OUT_SV (OUT_SK + 134217728ull)
#define OUT_SC (OUT_SV + 134217728ull)
#define OUT_SS (OUT_SC + 983040ull)

__constant__ double ROPE_INV_REV[32] = {
    1.59154943091895346e-01, 1.19349370211248862e-01, 8.94994016088910133e-02, 6.71150830052272551e-02,
    5.03292121044870353e-02, 3.77415847174197711e-02, 2.83021958306233987e-02, 2.12236527647776604e-02,
    1.59154943091895339e-02, 1.19349370211248862e-02, 8.94994016088910237e-03, 6.71150830052272534e-03,
    5.03292121044870370e-03, 3.77415847174197719e-03, 2.83021958306233987e-03, 2.12236527647776622e-03,
    1.59154943091895356e-03, 1.19349370211248849e-03, 8.94994016088910237e-04, 6.71150830052272599e-04,
    5.03292121044870326e-04, 3.77415847174197741e-04, 2.83021958306233954e-04, 2.12236527647776605e-04,
    1.59154943091895351e-04, 1.19349370211248862e-04, 8.94994016088910182e-05, 6.71150830052272545e-05,
    5.03292121044870354e-05, 3.77415847174197768e-05, 2.83021958306233961e-05, 2.12236527647776592e-05
};

__device__ __forceinline__ float silu_f(float x) { return x * __builtin_amdgcn_rcpf(1.0f + __expf(-x)); }
__device__ __forceinline__ float softplus_f(float x) { return fmaxf(x, 0.f) + log1pf(__expf(-fabsf(x))); }
__device__ __forceinline__ float gelu_f(float x) { return 0.5f * x * (1.0f + erff(x * 0.70710678118654752f)); }
__device__ __forceinline__ float wave_sum(float v) {
#pragma unroll
    for (int o = 32; o > 0; o >>= 1) v += __shfl_xor(v, o);
    return v;
}
__device__ __forceinline__ float wave_max(float v) {
#pragma unroll
    for (int o = 32; o > 0; o >>= 1) v = fmaxf(v, __shfl_xor(v, o));
    return v;
}

#include <cstdio>
#define XB_TMO      128
#define XB_XCNT(j)  (256  + 64 * (j))
#define XB_XSUB(j)  (1280 + 64 * (j))
#define XB_XGEN(j)  (2304 + 64 * (j))
#define XB_TOP      3328
#define XB_TOPGEN   3392
#define XCD_BAR_WORDS 3456
#define XB_SPIN_CAP (1u << 18)
#define LAS __attribute__((address_space(3)))

__device__ __forceinline__ unsigned xb_ld(unsigned* p)              { return __hip_atomic_load(p, __ATOMIC_RELAXED, __HIP_MEMORY_SCOPE_AGENT); }
__device__ __forceinline__ unsigned xb_add(unsigned* p, unsigned v) { return __hip_atomic_fetch_add(p, v, __ATOMIC_RELAXED, __HIP_MEMORY_SCOPE_AGENT); }
__device__ __forceinline__ unsigned xb_xcc_id() { return (unsigned)__builtin_amdgcn_s_getreg((3 << 11) | 20) & 0xFu; }
#define XB_SPIN(cond, bar) do { unsigned _sp = 0; while (cond) { __builtin_amdgcn_s_sleep(1); \
    if ((++_sp & 255u) == 0u) { if (xb_ld(&(bar)[XB_TMO])) break; if (_sp > XB_SPIN_CAP) { atomicAdd(&(bar)[XB_TMO], 1u); break; } } } } while (0)

struct XcdBarrier {
    unsigned* bar; unsigned x;
    volatile LAS unsigned* st;
};

__device__ __forceinline__ XcdBarrier xcd_barrier_post(unsigned* bar, volatile LAS unsigned* st) {
    XcdBarrier b; b.bar = bar; b.x = xb_xcc_id(); b.st = st;
    if (threadIdx.x == 0) (void)xb_add(&bar[XB_XCNT(b.x)], 1u);
    return b;
}
__device__ __forceinline__ void xcd_barrier_complete(unsigned* bar, unsigned x, unsigned& nloc, unsigned& nx) {
    const unsigned G = gridDim.x * gridDim.y * gridDim.z;
    unsigned sum, cnt, mine, sp = 0u;
    for (;;) {
        sum = 0u; cnt = 0u; mine = 0u;
#pragma unroll
        for (unsigned j = 0; j < 16; ++j) { const unsigned c = xb_ld(&bar[XB_XCNT(j)]); sum += c; cnt += (c > 0u) ? 1u : 0u; mine = (j == x) ? c : mine; }
        if (sum == G) break;
        __builtin_amdgcn_s_sleep(1);
        if ((++sp & 255u) == 0u) { if (xb_ld(&bar[XB_TMO])) break; if (sp > XB_SPIN_CAP) { atomicAdd(&bar[XB_TMO], 1u); break; } }
    }
    nloc = mine > 0u ? mine : 1u; nx = cnt > 0u ? cnt : 1u;
}

__device__ __forceinline__ void xcd_barrier(const XcdBarrier& b) {
    asm volatile("s_waitcnt vmcnt(0)" ::: "memory");
    __syncthreads();
    if (threadIdx.x == 0) {
        unsigned* bar = b.bar;
        __builtin_amdgcn_s_waitcnt(0);
        unsigned nloc = b.st[0], nx = b.st[1];
        if (nloc == 0u) { xcd_barrier_complete(bar, b.x, nloc, nx); b.st[0] = nloc; b.st[1] = nx; }
        const unsigned old = xb_add(&bar[XB_XSUB(b.x)], 1u);
        const unsigned gen = old / nloc;
        if (old + 1u == (gen + 1u) * nloc) {
            __builtin_amdgcn_fence(__ATOMIC_RELEASE, "agent");
            asm volatile("s_waitcnt vmcnt(0)" ::: "memory");
            const unsigned og = xb_add(&bar[XB_TOP], 1u);
            const unsigned tg = og / nx;
            if (og + 1u == (tg + 1u) * nx) xb_add(&bar[XB_TOPGEN], 1u);
            else XB_SPIN(xb_ld(&bar[XB_TOPGEN]) == tg, bar);
            __builtin_amdgcn_fence(__ATOMIC_ACQUIRE, "agent");
            xb_add(&bar[XB_XGEN(b.x)], 1u);
            asm volatile("s_waitcnt vmcnt(0)" ::: "memory");
        } else {
            XB_SPIN(xb_ld(&bar[XB_XGEN(b.x)]) == gen, bar);
            __builtin_amdgcn_fence(__ATOMIC_ACQUIRE, "agent");
            asm volatile("s_waitcnt vmcnt(0)" ::: "memory");
        }
    }
    __syncthreads();
}


#define GAS __attribute__((address_space(1)))
typedef unsigned short bf16;
typedef unsigned v4u __attribute__((ext_vector_type(4)));
#define LDS_WAIT() asm volatile("s_waitcnt lgkmcnt(0)" ::: "memory")
__device__ __forceinline__ unsigned f2bf(float f) { unsigned u = __builtin_bit_cast(unsigned, f); return (u + 0x7fffu + ((u >> 16) & 1u)) >> 16; }
__device__ __forceinline__ unsigned pk2(float lo, float hi) { return f2bf(lo) | (f2bf(hi) << 16); }
__device__ __forceinline__ float bf2f(unsigned short b) { return __builtin_bit_cast(float, (unsigned)b << 16); }
#include <hip/hip_runtime.h>
namespace pg8 {
#define PG8_LAS __attribute__((address_space(3)))
typedef unsigned short bf16_t;
typedef short bf16x8 __attribute__((ext_vector_type(8)));
typedef float f32x4 __attribute__((ext_vector_type(4)));
typedef unsigned u32x4 __attribute__((ext_vector_type(4)));
constexpr int BM = 256, BK = 64, HALF = 128, HTB = HALF * BK * 2  , STAGE_BYTES = 8 * HTB, NXCD = 8, WGM = 8;

__host__ __device__ __forceinline__ int lds_byte(int r, int c) { const int st = (r >> 4) * 2 + (c >> 5), rr = r & 15, cc = c & 31, ob = rr * 64 + cc * 2; return st * 1024 + (ob ^ (((ob >> 9) & 1) << 5)); }
__host__ __device__ __forceinline__ void stage_rc(int b, int& R, int& C) { const int st = b / 1024, sb = b % 1024, swz = sb ^ (((sb >> 9) & 1) << 5); R = (st >> 1) * 16 + swz / 64; C = (st & 1) * 32 + (swz % 64) / 2; }
__host__ __device__ __forceinline__ int perm32(int rho) { const int n = rho >> 4, i = rho & 15; return 8 * (i >> 2) + 4 * n + (i & 3); }

struct Unit { int pm, pn; };
struct Gemm { const bf16_t* A; const bf16_t* Bt; int M, N, K; };

struct StaticOrder {
    int nM, nN, nwg, G, c;
    __host__ __device__ void init(int M, int N, int G_, int c_) { nM = M / BM; nN = N / BM; nwg = nM * nN; G = G_; c = c_; }
    __host__ __device__ bool next(int i, Unit& u) const {
        const long L = (long)i * G + c; if (L >= nwg) return false;
        int wgid = (int)L; { const int q = nwg / NXCD, r = nwg % NXCD, xcd = wgid % NXCD, off = wgid / NXCD; wgid = (xcd < r ? xcd * (q + 1) : r * (q + 1) + (xcd - r) * q) + off; }
        const int nig = WGM * nN, gid = wgid / nig, fm = gid * WGM, gsz = (nM - fm) < WGM ? (nM - fm) : WGM;
        u.pm = fm + ((wgid % nig) % gsz); u.pn = (wgid % nig) / gsz; return true;
    }
    __device__ __forceinline__ void a_ready(const Unit&) const {}
    __device__ __forceinline__ void done(const Unit&) const {}
};
__device__ __forceinline__ unsigned cvt_pk_bf16(float lo, float hi) { unsigned r; asm volatile("v_cvt_pk_bf16_f32 %0, %1, %2" : "=v"(r) : "v"(lo), "v"(hi)); return r; }
typedef float f32x2 __attribute__((ext_vector_type(2)));
__device__ __forceinline__ f32x2 gelu_pk(f32x2 v) {
    const f32x2 av = __builtin_elementwise_abs(v), d = av * 0.2316418882f + 1.0f;
    f32x2 t; t.x = __builtin_amdgcn_rcpf(d.x); t.y = __builtin_amdgcn_rcpf(d.y);
    f32x2 q = t * 0.5307027145f + (-0.7265760135f); q = q * t + 0.7107068705f; q = q * t + (-0.142248368f); q = q * t + 0.127414796f; q = q * t;
    const f32x2 s = (v * v) * (-0.72134752044f);
    f32x2 e; e.x = __builtin_amdgcn_exp2f(s.x); e.y = __builtin_amdgcn_exp2f(s.y);
    const f32x2 m = v * (q * e), r = v - m;
    f32x2 o; o.x = v.x < 0.f ? m.x : r.x; o.y = v.y < 0.f ? m.y : r.y; return o;
}

struct EpiF32 {
    static constexpr bool PERM = false, AFTER_DRAIN = false;
    float* C; int ldc; const float* bias;
    __device__ __forceinline__ void operator()(const f32x4 (&acc)[2][2][4][2], const Unit& u, int wr, int wc, int fr, int fq) const {
        const int row0 = u.pm * BM + wr * 64 + fr, col0 = u.pn * BM + wc * 32 + 4 * fq;
        f32x4 bv[2][2];
#pragma unroll
        for (int bj = 0; bj < 2; ++bj)
#pragma unroll
            for (int n = 0; n < 2; ++n) bv[bj][n] = bias ? *(const f32x4*)(bias + col0 + bj * HALF + n * 16) : (f32x4){0.f, 0.f, 0.f, 0.f};
#pragma unroll
        for (int ai = 0; ai < 2; ++ai)
#pragma unroll
            for (int m = 0; m < 4; ++m) { float* rowp = C + (size_t)(row0 + ai * HALF + m * 16) * ldc + col0;
#pragma unroll
                for (int bj = 0; bj < 2; ++bj)
#pragma unroll
                    for (int n = 0; n < 2; ++n) *(f32x4*)(rowp + bj * HALF + n * 16) = acc[ai][bj][m][n] + bv[bj][n]; }
    }
};

template <class Epi, class Sched, bool STAMP = false>
__device__ __forceinline__ void gemm_phase(PG8_LAS unsigned char* lds, const Gemm g, const Sched& S, const Epi& E, unsigned long long* stamps) {
    int tid = threadIdx.x; asm volatile("" : "+v"(tid));
    const int wid = __builtin_amdgcn_readfirstlane(tid >> 6), lane = tid & 63, wr = wid >> 2, wc = wid & 3, fr = lane & 15, fq = lane >> 4;
    const int K = g.K, nt = K / BK;
    int ts_lo = 0, ts_hi = 0, nts = 0; const unsigned long long rt_entry = STAMP ? (unsigned long long)wall_clock64() : 0ull;
#define PG8_STAMP() do { if (STAMP && wid == 0 && nts < 64) { const unsigned long long _c = (unsigned long long)clock64(); \
        ts_lo = (lane == nts) ? (int)(unsigned)_c : ts_lo; ts_hi = (lane == nts) ? (int)(unsigned)(_c >> 32) : ts_hi; ++nts; } } while (0)
    PG8_STAMP();
    unsigned voffA[2], voffB[2];
#pragma unroll
    for (int i = 0; i < 2; ++i) { int R, C; stage_rc(tid * 16 + i * 8192, R, C); const int Rb = Epi::PERM ? ((R & ~31) + perm32(R & 31)) : R;
        voffA[i] = (unsigned)(R * K + C) * 2u; voffB[i] = (unsigned)(Rb * K + C) * 2u; }
    const size_t kstep = (size_t)(BK * 2);
    const size_t hstep = (size_t)HALF * K * 2;
    const size_t tstep = 2 * hstep;
    const unsigned ldsw = (unsigned)wid * 1024u;
    const int aoff = lds_byte(wr * 64 + fr, fq * 8), boff = lds_byte(wc * 32 + fr, fq * 8);
#define PG8_SA(b, h) (((b) * 2 + (h)) * HTB)
#define PG8_SB(b, h) ((4 + (b) * 2 + (h)) * HTB)
#define PG8_STAGE(bufoff, gbase, voff) do { _Pragma("unroll") for (int _i = 0; _i < 2; ++_i) \
        __builtin_amdgcn_global_load_lds((const unsigned*)((const char*)(gbase) + (voff)[_i]), (PG8_LAS unsigned*)(lds + (bufoff) + ldsw + _i * 8192), 16, 0, 0); } while (0)
#define PG8_LDA(dst, b, h) do { _Pragma("unroll") for (int m = 0; m < 4; ++m) _Pragma("unroll") for (int k = 0; k < 2; ++k) dst[m][k] = *(const PG8_LAS bf16x8*)(lds + PG8_SA(b, h) + aoff + m * 2048 + k * 1024); } while (0)
#define PG8_LDB(dst, b, h) do { _Pragma("unroll") for (int n = 0; n < 2; ++n) _Pragma("unroll") for (int k = 0; k < 2; ++k) dst[n][k] = *(const PG8_LAS bf16x8*)(lds + PG8_SB(b, h) + boff + n * 2048 + k * 1024); } while (0)
#define PG8_MMA(ai, bj, At, Bt) do { __builtin_amdgcn_s_setprio(1); _Pragma("unroll") for (int m = 0; m < 4; ++m) _Pragma("unroll") for (int n = 0; n < 2; ++n) _Pragma("unroll") for (int k = 0; k < 2; ++k) \
        acc[ai][bj][m][n] = __builtin_amdgcn_mfma_f32_16x16x32_bf16(Bt[n][k], At[m][k], acc[ai][bj][m][n], 0, 0, 0); __builtin_amdgcn_s_setprio(0); } while (0)
#define PG8_WAIT_V(n) asm volatile("s_waitcnt vmcnt(" #n ")" ::: "memory")
#define PG8_WAIT_L(n) asm volatile("s_waitcnt lgkmcnt(" #n ")" ::: "memory")
#define PG8_BAR __builtin_amdgcn_s_barrier()
#define PG8_SCHED __builtin_amdgcn_sched_barrier(0)
    Unit cur, nxt; int ui = 0;
    if (!S.next(0, cur)) return;
    f32x4 acc[2][2][4][2];
#pragma unroll
    for (int a = 0; a < 2; ++a)
#pragma unroll
        for (int b = 0; b < 2; ++b)
#pragma unroll
            for (int m = 0; m < 4; ++m)
#pragma unroll
                for (int n = 0; n < 2; ++n) acc[a][b][m][n] = (f32x4){0.f, 0.f, 0.f, 0.f};
    bf16x8 At[4][2], B0[2][2], B1[2][2];
    const char* cA = (const char*)g.A + (size_t)cur.pm * tstep; const char* cB = (const char*)g.Bt + (size_t)cur.pn * tstep;
    S.a_ready(cur);
    PG8_STAGE(PG8_SB(0, 0), cB, voffB); PG8_STAGE(PG8_SA(0, 0), cA, voffA); PG8_STAGE(PG8_SB(0, 1), cB + hstep, voffB); PG8_STAGE(PG8_SA(0, 1), cA + hstep, voffA);
    if (wr == 1) PG8_BAR;
    PG8_WAIT_V(4); PG8_BAR;
    PG8_STAGE(PG8_SB(1, 0), cB + kstep, voffB); PG8_STAGE(PG8_SA(1, 0), cA + kstep, voffA); PG8_STAGE(PG8_SB(1, 1), cB + hstep + kstep, voffB);
    PG8_WAIT_V(6); PG8_BAR;
    PG8_STAMP();
    for (;;) {
        const bool has_next = S.next(ui + 1, nxt);
        const char* nA = has_next ? (const char*)g.A + (size_t)nxt.pm * tstep : cA; const char* nB = has_next ? (const char*)g.Bt + (size_t)nxt.pn * tstep : cB;
        for (int t = 0; t < nt; t += 2) {
            const bool last = (t == nt - 2);
            const char* a1 = cA + (size_t)(t + 1) * kstep;
            const char* a2 = last ? nA : cA + (size_t)(t + 2) * kstep; const char* b2 = last ? nB : cB + (size_t)(t + 2) * kstep;
            const char* a3 = a2 + kstep; const char* b3 = b2 + kstep;
            if (last && has_next) S.a_ready(nxt);
            PG8_LDB(B0, 0, 0); PG8_SCHED; PG8_LDA(At, 0, 0); PG8_STAGE(PG8_SA(1, 1), a1 + hstep, voffA);
            PG8_WAIT_L(8); PG8_BAR; PG8_WAIT_L(0); PG8_MMA(0, 0, At, B0); PG8_BAR; PG8_SCHED;
            PG8_LDB(B1, 0, 1); PG8_STAGE(PG8_SB(0, 0), b2, voffB);
            PG8_BAR; PG8_WAIT_L(0); PG8_MMA(0, 1, At, B1); PG8_BAR;
            PG8_LDA(At, 0, 1); PG8_STAGE(PG8_SA(0, 0), a2, voffA);
            PG8_BAR; PG8_WAIT_L(0); PG8_MMA(1, 0, At, B0); PG8_BAR; PG8_SCHED;
            PG8_STAGE(PG8_SB(0, 1), b2 + hstep, voffB);
            PG8_WAIT_V(6); PG8_BAR; PG8_MMA(1, 1, At, B1); PG8_BAR;
            PG8_LDB(B0, 1, 0); PG8_SCHED; PG8_LDA(At, 1, 0); PG8_STAGE(PG8_SA(0, 1), a2 + hstep, voffA);
            PG8_WAIT_L(8); PG8_BAR; PG8_WAIT_L(0); PG8_MMA(0, 0, At, B0); PG8_BAR; PG8_SCHED;
            PG8_LDB(B1, 1, 1); PG8_STAGE(PG8_SB(1, 0), b3, voffB);
            PG8_BAR; PG8_WAIT_L(0); PG8_MMA(0, 1, At, B1); PG8_BAR;
            PG8_LDA(At, 1, 1); PG8_STAGE(PG8_SA(1, 0), a3, voffA);
            PG8_BAR; PG8_WAIT_L(0); PG8_MMA(1, 0, At, B0); PG8_BAR; PG8_SCHED;
            PG8_STAGE(PG8_SB(1, 1), b3 + hstep, voffB);
            PG8_WAIT_V(6); PG8_BAR; PG8_MMA(1, 1, At, B1); PG8_BAR;
        }
        PG8_STAMP();
        if constexpr (!Epi::AFTER_DRAIN) { E(acc, cur, wr, wc, fr, fq); S.done(cur); }
        PG8_STAMP();
        if (!has_next) break;
#pragma unroll
        for (int a = 0; a < 2; ++a)
#pragma unroll
            for (int b = 0; b < 2; ++b)
#pragma unroll
                for (int m = 0; m < 4; ++m)
#pragma unroll
                    for (int n = 0; n < 2; ++n) acc[a][b][m][n] = (f32x4){0.f, 0.f, 0.f, 0.f};
        cur = nxt; cA = nA; cB = nB; ++ui;
    }
    PG8_WAIT_V(0);
    if (wr == 0) PG8_BAR;
    PG8_BAR;
    if constexpr (Epi::AFTER_DRAIN) { E.fused(acc, cur, wr, wc, fr, fq, lds, wid, lane); S.done(cur); }
    PG8_STAMP();
    if (STAMP && wid == 0) { stamps[lane] = lane < nts ? (((unsigned long long)(unsigned)ts_hi << 32) | (unsigned)ts_lo) : 0ull;
        if (lane == 62) stamps[62] = rt_entry; if (lane == 63) stamps[63] = (unsigned long long)wall_clock64(); }
#undef PG8_STAMP
#undef PG8_SA
#undef PG8_SB
#undef PG8_STAGE
#undef PG8_LDA
#undef PG8_LDB
#undef PG8_MMA
#undef PG8_WAIT_V
#undef PG8_WAIT_L
#undef PG8_BAR
#undef PG8_SCHED
}
}


namespace pg8 {
struct EpiProj {
    static constexpr bool PERM = true, AFTER_DRAIN = false;
    bf16_t* O; float* dtraw;
    __device__ __forceinline__ void operator()(const f32x4 (&acc)[2][2][4][2], const Unit& u, int wr, int wc, int fr, int fq) const {
        const int row0 = u.pm * BM + wr * 64 + fr;
        if (u.pn < 22) {
            const int col0 = u.pn * BM + wc * 32 + 8 * fq;
#pragma unroll
            for (int ai = 0; ai < 2; ++ai)
#pragma unroll
                for (int m = 0; m < 4; ++m) { bf16_t* rowp = O + (size_t)(row0 + ai * HALF + m * 16) * 5632 + col0;
#pragma unroll
                    for (int bj = 0; bj < 2; ++bj) { const f32x4 v0 = acc[ai][bj][m][0], v1 = acc[ai][bj][m][1];
                        u32x4 w; w.x = cvt_pk_bf16(v0[0], v0[1]); w.y = cvt_pk_bf16(v0[2], v0[3]); w.z = cvt_pk_bf16(v1[0], v1[1]); w.w = cvt_pk_bf16(v1[2], v1[3]);
                        *(u32x4*)(rowp + bj * HALF) = w; } }
        } else if (wc == 0) {
#pragma unroll
            for (int ai = 0; ai < 2; ++ai)
#pragma unroll
                for (int m = 0; m < 4; ++m) { float* rp = dtraw + (size_t)(row0 + ai * HALF + m * 16) * 32 + 8 * fq;
                    *(f32x4*)rp = acc[ai][0][m][0]; *(f32x4*)(rp + 4) = acc[ai][0][m][1]; }
        }
    }
};
}


namespace pg8 {
struct EpiBf16Plain {
    static constexpr bool PERM = true, AFTER_DRAIN = false;
    bf16_t* O; int ldc;
    __device__ __forceinline__ void operator()(const f32x4 (&acc)[2][2][4][2], const Unit& u, int wr, int wc, int fr, int fq) const {
        const int row0 = u.pm * BM + wr * 64 + fr, col0 = u.pn * BM + wc * 32 + 8 * fq;
#pragma unroll
        for (int ai = 0; ai < 2; ++ai)
#pragma unroll
            for (int m = 0; m < 4; ++m) { bf16_t* rowp = O + (size_t)(row0 + ai * HALF + m * 16) * ldc + col0;
#pragma unroll
                for (int bj = 0; bj < 2; ++bj) { const f32x4 v0 = acc[ai][bj][m][0], v1 = acc[ai][bj][m][1];
                    u32x4 w; w.x = cvt_pk_bf16(v0[0], v0[1]); w.y = cvt_pk_bf16(v0[2], v0[3]); w.z = cvt_pk_bf16(v1[0], v1[1]); w.w = cvt_pk_bf16(v1[2], v1[3]);
                    *(u32x4*)(rowp + bj * HALF) = w; } }
    }
};
}

#define NTHR 512
#define NWAVE 8

__device__ __forceinline__ void ph_gemm_f32(float* lds, const float* __restrict__ A, const float* __restrict__ B, float* __restrict__ C,
                                            int M, int N, int K, int lda, int ldb, int ldc) {
    const int tid = threadIdx.x & 255, half = threadIdx.x >> 8, tx = tid & 15, ty = tid >> 4;
    float (*As)[68] = (float (*)[68])(lds + half * 2 * 16 * 68);
    float (*Bs)[68] = (float (*)[68])(lds + half * 2 * 16 * 68 + 16 * 68);
    const int ntx = (N + 63) / 64, nty = M / 64, ntiles = ntx * nty;
    for (int it = blockIdx.x; 2 * it < ntiles; it += gridDim.x) {
        const int tile = 2 * it + half;
        const int m0 = (tile / ntx) * 64, n0 = (tile % ntx) * 64;
        float acc[4][4];
#pragma unroll
        for (int i = 0; i < 4; ++i)
#pragma unroll
            for (int j = 0; j < 4; ++j) acc[i][j] = 0.f;
        for (int k0 = 0; k0 < K; k0 += 16) {
#pragma unroll
            for (int i = 0; i < 4; ++i) {
                int idx = tid + i * 256;
                int r = idx >> 4, c = idx & 15;
                As[c][r] = (m0 + r < M) ? A[(size_t)(m0 + r) * lda + k0 + c] : 0.f;
                int rb = idx >> 6, cb = idx & 63;
                Bs[rb][cb] = (n0 + cb < N) ? B[(size_t)(k0 + rb) * ldb + n0 + cb] : 0.f;
            }
            __syncthreads();
#pragma unroll
            for (int k = 0; k < 16; ++k) {
                float a[4], b[4];
#pragma unroll
                for (int i = 0; i < 4; ++i) { a[i] = As[k][ty * 4 + i]; b[i] = Bs[k][tx * 4 + i]; }
#pragma unroll
                for (int i = 0; i < 4; ++i)
#pragma unroll
                    for (int j = 0; j < 4; ++j) acc[i][j] += a[i] * b[j];
            }
            __syncthreads();
        }
#pragma unroll
        for (int i = 0; i < 4; ++i)
#pragma unroll
            for (int j = 0; j < 4; ++j) {
                int r = m0 + ty * 4 + i, c = n0 + tx * 4 + j;
                if (r < M && c < N) C[(size_t)r * ldc + c] = acc[i][j];
            }
    }
}


template <int MODE>
__device__ __forceinline__ void transpose_item(const float* __restrict__ W, int K, int N, int Npad, bf16* __restrict__ WT, LAS float* scr, int item, int lane) {
    const int nblk = Npad / 32, kb = item / nblk, nb = item % nblk, k0 = 64 * kb, n0 = 32 * nb;
    const int n = n0 + (lane & 31);
    int sc = n;
    if (MODE == 1) sc = (n < 4096) ? n : (n < 5632 ? n + 24 : (n < 5656 ? n - 5632 + 4096 : -1));
    else sc = (n < N) ? n : -1;
#pragma unroll 8
    for (int i = 0; i < 32; ++i) { const int kk = 2 * i + (lane >> 5); scr[kk * 33 + (lane & 31)] = (sc >= 0) ? W[(size_t)(k0 + kk) * N + sc] : 0.f; }
    LDS_WAIT(); asm volatile("" ::: "memory");
    const int c = lane & 7;
#pragma unroll
    for (int j = 0; j < 4; ++j) { const int nn = (lane >> 3) + 8 * j; const LAS float* s = scr + (8 * c) * 33 + nn;
        v4u o; o.x = pk2(s[0 * 33], s[1 * 33]); o.y = pk2(s[2 * 33], s[3 * 33]); o.z = pk2(s[4 * 33], s[5 * 33]); o.w = pk2(s[6 * 33], s[7 * 33]);
        *(v4u*)(WT + (size_t)(n0 + nn) * K + k0 + 8 * c) = o; }
    LDS_WAIT(); asm volatile("" ::: "memory");
}
__device__ __forceinline__ void ph_prologue(LAS unsigned char* ldsb, const float* __restrict__ xp, const float* __restrict__ xs, bf16* __restrict__ A0,
                                            const float* __restrict__ w_in, bf16* __restrict__ wt_in, float* __restrict__ rope_tab) {
    const int lane = threadIdx.x & 63, wave = threadIdx.x >> 6;
    LAS float* scr = (LAS float*)(ldsb + wave * 16384);
    const int gw = blockIdx.x * NWAVE + wave, NGW = gridDim.x * NWAVE;
    constexpr int I_IN = (D_MODEL / 64) * (PROJ_LD / 32);
    for (int it = gw; it < I_IN; it += NGW) transpose_item<1>(w_in, D_MODEL, IN_WIDTH, PROJ_LD, wt_in, scr, it, lane);
    for (int idx = blockIdx.x * NTHR + threadIdx.x; idx < SEQ * 32; idx += gridDim.x * NTHR) {
        const int pos = idx >> 5, j = idx & 31;
        const double rev = (double)pos * ROPE_INV_REV[j];
        const float fr = (float)(rev - floor(rev));
        rope_tab[(size_t)pos * 64 + j] = __builtin_amdgcn_cosf(fr); rope_tab[(size_t)pos * 64 + 32 + j] = __builtin_amdgcn_sinf(fr);
    }
    const size_t n8 = (size_t)T_ALL * D_MODEL / 8, np8 = (size_t)T_PROMPT * D_MODEL / 8;
#pragma unroll 4
    for (size_t i = (size_t)blockIdx.x * NTHR + threadIdx.x; i < n8; i += (size_t)gridDim.x * NTHR) {
        const float4* s = (i < np8) ? (const float4*)xp + 2 * i : (const float4*)xs + 2 * (i - np8);
        float4 a = s[0], b = s[1];
        v4u o; o.x = pk2(a.x, a.y); o.y = pk2(a.z, a.w); o.z = pk2(b.x, b.y); o.w = pk2(b.z, b.w);
        ((v4u*)A0)[i] = o;
    }
}
__device__ __forceinline__ void ph_prologue2(LAS unsigned char* ldsb, const float* __restrict__ w_out, bf16* __restrict__ wt_out, const float* __restrict__ w_q, bf16* __restrict__ wt_q,
                                             int rank, int nranks) {
    const int lane = threadIdx.x & 63, wave = threadIdx.x >> 6;
    LAS float* scr = (LAS float*)(ldsb + wave * 16384);
    constexpr int I_OUT = (MIX_WIDTH / 64) * (D_MODEL / 32), I_Q = (D_MODEL / 64) * (2048 / 32);
    for (int it = rank * NWAVE + wave; it < I_OUT + I_Q; it += nranks * NWAVE) {
        if (it < I_OUT) transpose_item<0>(w_out, MIX_WIDTH, D_MODEL, D_MODEL, wt_out, scr, it, lane);
        else transpose_item<0>(w_q, D_MODEL, 2048, 2048, wt_q, scr, it - I_OUT, lane);
    }
}

__device__ __forceinline__ void ph_concat_x(const float* __restrict__ xp, const float* __restrict__ xs, float* __restrict__ xall) {
    const size_t n4 = (size_t)T_ALL * D_MODEL / 4, np4 = (size_t)T_PROMPT * D_MODEL / 4;
    for (size_t i = (size_t)blockIdx.x * NTHR + threadIdx.x; i < n4; i += (size_t)gridDim.x * NTHR) {
        float4 v = (i < np4) ? ((const float4*)xp)[i] : ((const float4*)xs)[i - np4];
        ((float4*)xall)[i] = v;
    }
}

typedef float f32x4n __attribute__((ext_vector_type(4)));
__device__ __forceinline__ void ph_cache_copy(const float* __restrict__ ck, const float* __restrict__ cv, float* __restrict__ out) {
    constexpr unsigned PER_B = (WBUF - DEC_SEQ) * ATT_WIDTH / 4;
    constexpr unsigned TOTAL = 2u * DEC_BATCH * PER_B;
    for (unsigned c = blockIdx.x; c < TOTAL / 4096u; c += gridDim.x) {
        f32x4n v[8]; size_t dsti[8]; bool isv[8];
#pragma unroll
        for (int j = 0; j < 8; ++j) {
            const unsigned idx = c * 4096u + j * 512u + threadIdx.x;
            const unsigned tb = idx / PER_B, r = idx - tb * PER_B, bb = tb & (DEC_BATCH - 1);
            isv[j] = tb >= DEC_BATCH;
            const size_t srci = (size_t)bb * (WBUF * ATT_WIDTH / 4) + (DEC_SEQ * ATT_WIDTH / 4) + r;
            dsti[j] = (size_t)bb * (WBUF * ATT_WIDTH / 4) + r;
            v[j] = __builtin_nontemporal_load((isv[j] ? (const f32x4n*)cv : (const f32x4n*)ck) + srci);
        }
#pragma unroll
        for (int j = 0; j < 8; ++j) __builtin_nontemporal_store(v[j], (f32x4n*)(out + (isv[j] ? OUT_SV : OUT_SK)) + dsti[j]);
    }
}

__device__ __forceinline__ void ph_post_proj(const float* __restrict__ proj, const float* __restrict__ state_conv,
                                             const float* __restrict__ conv_w, const float* __restrict__ conv_b, const float* __restrict__ dt_bias,
                                             float* __restrict__ xbc_act, float* __restrict__ dtv, float* __restrict__ qrot, float* __restrict__ krot,
                                             float* __restrict__ out) {
    const int tid = threadIdx.x & 255, half = threadIdx.x >> 8;
    for (int t = 2 * blockIdx.x + half; t < T_ALL; t += 2 * gridDim.x) {
        const bool is_p = t < T_PROMPT;
        int b, i, pos;
        if (is_p) { b = t / SEQ; i = t % SEQ; pos = i; } else { int ts = t - T_PROMPT; b = ts / DEC_SEQ; i = ts % DEC_SEQ; pos = PAST_LEN + i; }
        const float* row = proj + (size_t)t * PROJ_LD;
        for (int c = tid; c < CONV_DIM; c += 256) {
            float acc = conv_b[c];
#pragma unroll
            for (int tap = 0; tap < 4; ++tap) {
                int r = i - 3 + tap;
                float val;
                if (r >= 0) val = proj[(size_t)(t - i + r) * PROJ_LD + O_XBC + c];
                else val = is_p ? 0.f : state_conv[((size_t)b * 3 + (3 + r)) * CONV_DIM + c];
                acc += val * conv_w[tap * CONV_DIM + c];
            }
            xbc_act[(size_t)t * CONV_DIM + c] = silu_f(acc);
        }
        if (tid < SSD_HEADS) dtv[(size_t)t * SSD_HEADS + tid] = softplus_f(row[O_DT + tid] + dt_bias[tid]);
        for (int idx = tid; idx < 512; idx += 256) {
            int which = idx >> 8, h = (idx >> 5) & 7, j = idx & 31;
            double rev = (double)pos * ROPE_INV_REV[j];
            float fr = (float)(rev - floor(rev));
            float sn = __builtin_amdgcn_sinf(fr), cs = __builtin_amdgcn_cosf(fr);
            const float* src = row + (which ? O_K : O_Q) + h * 64;
            float t1 = src[j], t2 = src[j + 32];
            float o1 = t1 * cs - t2 * sn, o2 = t2 * cs + t1 * sn;
            float* dst = (which ? krot : qrot) + (size_t)t * ATT_WIDTH + h * 64;
            dst[j] = o1; dst[j + 32] = o2;
            if (which) {
                if (is_p) { if (i >= SEQ - WBUF) { float* o = out + OUT_PK + ((size_t)b * WBUF + (i - (SEQ - WBUF))) * ATT_WIDTH + h * 64; o[j] = o1; o[j + 32] = o2; } }
                else { float* o = out + OUT_SK + ((size_t)b * WBUF + (WBUF - DEC_SEQ + i)) * ATT_WIDTH + h * 64; o[j] = o1; o[j + 32] = o2; }
            }
        }
        for (int c = tid; c < ATT_WIDTH; c += 256) {
            float v = row[O_V + c];
            if (is_p) { if (i >= SEQ - WBUF) out[OUT_PV + ((size_t)b * WBUF + (i - (SEQ - WBUF))) * ATT_WIDTH + c] = v; }
            else out[OUT_SV + ((size_t)b * WBUF + (WBUF - DEC_SEQ + i)) * ATT_WIDTH + c] = v;
        }
        if (is_p) {
            if (i >= SEQ - 3) { int r = i - (SEQ - 3); for (int c = tid; c < CONV_DIM; c += 256) out[OUT_PC + ((size_t)b * 3 + r) * CONV_DIM + c] = row[O_XBC + c]; }
        } else {
            if (i >= 1) { int r = i - 1; for (int c = tid; c < CONV_DIM; c += 256) out[OUT_SC + ((size_t)b * 3 + r) * CONV_DIM + c] = row[O_XBC + c]; }
        }
    }
}


#define NB_LD 5632
#define NB_XBC 1536
#define NB_Q 4096
#define NB_K 4608
#define NB_V 5120
__device__ __forceinline__ void unpack8(const v4u w, float (&f)[8]) {
    f[0] = __builtin_bit_cast(float, w.x << 16); f[1] = __builtin_bit_cast(float, w.x & 0xffff0000u);
    f[2] = __builtin_bit_cast(float, w.y << 16); f[3] = __builtin_bit_cast(float, w.y & 0xffff0000u);
    f[4] = __builtin_bit_cast(float, w.z << 16); f[5] = __builtin_bit_cast(float, w.z & 0xffff0000u);
    f[6] = __builtin_bit_cast(float, w.w << 16); f[7] = __builtin_bit_cast(float, w.w & 0xffff0000u);
}
__device__ __forceinline__ void store8f(float* d, const float (&f)[8]) { *(float4*)d = make_float4(f[0], f[1], f[2], f[3]); *(float4*)(d + 4) = make_float4(f[4], f[5], f[6], f[7]); }
__device__ __forceinline__ void ph_post_proj2(const bf16* __restrict__ projb, const float* __restrict__ dtraw, const float* __restrict__ state_conv,
                                              const float* __restrict__ conv_w, const float* __restrict__ conv_b, const float* __restrict__ dt_bias,
                                              bf16* __restrict__ xbc_b, float* __restrict__ dtv, bf16* __restrict__ qrot_b, bf16* __restrict__ krot_b,
                                              float* __restrict__ out) {
    const int tid = threadIdx.x & 255, half = threadIdx.x >> 8;
    for (int t = T_PROMPT + 2 * blockIdx.x + half; t < T_ALL; t += 2 * gridDim.x) {
        const bool is_p = t < T_PROMPT;
        int b, i, pos;
        if (is_p) { b = t / SEQ; i = t % SEQ; pos = i; } else { int ts = t - T_PROMPT; b = ts / DEC_SEQ; i = ts % DEC_SEQ; pos = PAST_LEN + i; }
        const bf16* row = projb + (size_t)t * NB_LD;
        if (tid < 64) {
            float f[8]; unpack8(*(const v4u*)(row + NB_V + tid * 8), f);
            if (is_p) { if (i >= SEQ - WBUF) store8f(out + OUT_PV + ((size_t)b * WBUF + (i - (SEQ - WBUF))) * ATT_WIDTH + tid * 8, f); }
            else store8f(out + OUT_SV + ((size_t)b * WBUF + (WBUF - DEC_SEQ + i)) * ATT_WIDTH + tid * 8, f);
        }
        for (int c8 = tid; c8 < 320; c8 += 256) {
            const int c = c8 * 8;
            float acc[8], cur[8];
            { const float4 b0 = *(const float4*)(conv_b + c), b1 = *(const float4*)(conv_b + c + 4);
              acc[0] = b0.x; acc[1] = b0.y; acc[2] = b0.z; acc[3] = b0.w; acc[4] = b1.x; acc[5] = b1.y; acc[6] = b1.z; acc[7] = b1.w; }
#pragma unroll
            for (int tap = 0; tap < 4; ++tap) {
                const int r = i - 3 + tap;
                float val[8];
                if (r >= 0) unpack8(*(const v4u*)(projb + (size_t)(t - i + r) * NB_LD + NB_XBC + c), val);
                else if (!is_p) { const float* sp = state_conv + ((size_t)b * 3 + (3 + r)) * CONV_DIM + c; const float4 s0 = *(const float4*)sp, s1 = *(const float4*)(sp + 4);
                    val[0] = s0.x; val[1] = s0.y; val[2] = s0.z; val[3] = s0.w; val[4] = s1.x; val[5] = s1.y; val[6] = s1.z; val[7] = s1.w; }
                else {
#pragma unroll
                    for (int j = 0; j < 8; ++j) val[j] = 0.f; }
                const float4 w0 = *(const float4*)(conv_w + tap * CONV_DIM + c), w1 = *(const float4*)(conv_w + tap * CONV_DIM + c + 4);
                acc[0] += val[0] * w0.x; acc[1] += val[1] * w0.y; acc[2] += val[2] * w0.z; acc[3] += val[3] * w0.w;
                acc[4] += val[4] * w1.x; acc[5] += val[5] * w1.y; acc[6] += val[6] * w1.z; acc[7] += val[7] * w1.w;
                if (tap == 3) {
#pragma unroll
                    for (int j = 0; j < 8; ++j) cur[j] = val[j]; }
            }
#pragma unroll
            for (int j = 0; j < 8; ++j) acc[j] = silu_f(acc[j]);
            v4u o; o.x = pk2(acc[0], acc[1]); o.y = pk2(acc[2], acc[3]); o.z = pk2(acc[4], acc[5]); o.w = pk2(acc[6], acc[7]);
            *(v4u*)(xbc_b + (size_t)t * CONV_DIM + c) = o;
            if (is_p) { if (i >= SEQ - 3) store8f(out + OUT_PC + ((size_t)b * 3 + (i - (SEQ - 3))) * CONV_DIM + c, cur); }
            else { if (i >= 1) store8f(out + OUT_SC + ((size_t)b * 3 + (i - 1)) * CONV_DIM + c, cur); }
        }
        if (tid < SSD_HEADS) dtv[(size_t)t * SSD_HEADS + tid] = softplus_f(dtraw[(size_t)t * 32 + tid] + dt_bias[tid]);
        if (tid < 128) {
            const int which = tid >> 6, h = (tid >> 3) & 7, jc = tid & 7;
            const bf16* src = row + (which ? NB_K : NB_Q) + h * 64 + jc * 4;
            const uint2 lo = *(const uint2*)src, hi = *(const uint2*)(src + 32);
            float t1[4], t2[4], o1[4], o2[4];
            t1[0] = __builtin_bit_cast(float, lo.x << 16); t1[1] = __builtin_bit_cast(float, lo.x & 0xffff0000u); t1[2] = __builtin_bit_cast(float, lo.y << 16); t1[3] = __builtin_bit_cast(float, lo.y & 0xffff0000u);
            t2[0] = __builtin_bit_cast(float, hi.x << 16); t2[1] = __builtin_bit_cast(float, hi.x & 0xffff0000u); t2[2] = __builtin_bit_cast(float, hi.y << 16); t2[3] = __builtin_bit_cast(float, hi.y & 0xffff0000u);
#pragma unroll
            for (int e = 0; e < 4; ++e) {
                const double rev = (double)pos * ROPE_INV_REV[jc * 4 + e];
                const float fr = (float)(rev - floor(rev));
                const float sn = __builtin_amdgcn_sinf(fr), cs = __builtin_amdgcn_cosf(fr);
                o1[e] = t1[e] * cs - t2[e] * sn; o2[e] = t2[e] * cs + t1[e] * sn;
            }
            const size_t doff = (size_t)t * ATT_WIDTH + h * 64 + jc * 4;
            bf16* db = which ? krot_b : qrot_b;
            *(uint2*)(db + doff) = make_uint2(pk2(o1[0], o1[1]), pk2(o1[2], o1[3])); *(uint2*)(db + doff + 32) = make_uint2(pk2(o2[0], o2[1]), pk2(o2[2], o2[3]));
            if (which) {
                float* o = nullptr;
                if (is_p) { if (i >= SEQ - WBUF) o = out + OUT_PK + ((size_t)b * WBUF + (i - (SEQ - WBUF))) * ATT_WIDTH + h * 64 + jc * 4; }
                else o = out + OUT_SK + ((size_t)b * WBUF + (WBUF - DEC_SEQ + i)) * ATT_WIDTH + h * 64 + jc * 4;
                if (o) { *(float4*)o = make_float4(o1[0], o1[1], o1[2], o1[3]); *(float4*)(o + 32) = make_float4(o2[0], o2[1], o2[2], o2[3]); }
            }
        }
    }
}


__device__ __forceinline__ void ph_post_proj_prompt(const bf16* __restrict__ projb, const float* __restrict__ dtraw, const float* __restrict__ conv_w, const float* __restrict__ conv_b,
                                                    const float* __restrict__ dt_bias, const float* __restrict__ rope_tab, bf16* __restrict__ xbc_b, float* __restrict__ dtv,
                                                    bf16* __restrict__ qrot_b, bf16* __restrict__ krot_b, float* __restrict__ out) {
    const int gtid = blockIdx.x * NTHR + threadIdx.x, gsz = gridDim.x * NTHR;
    for (int item = gtid; item < (T_PROMPT / 16) * 320; item += gsz) {
        const int run = item / 320, c = (item - run * 320) * 8, t0 = run * 16, i0 = t0 & (SEQ - 1), b = t0 >> 13;
        float w[4][8], bias[8];
#pragma unroll
        for (int tap = 0; tap < 4; ++tap) { const float4 w0 = *(const float4*)(conv_w + tap * CONV_DIM + c), w1 = *(const float4*)(conv_w + tap * CONV_DIM + c + 4);
            w[tap][0] = w0.x; w[tap][1] = w0.y; w[tap][2] = w0.z; w[tap][3] = w0.w; w[tap][4] = w1.x; w[tap][5] = w1.y; w[tap][6] = w1.z; w[tap][7] = w1.w; }
        { const float4 b0 = *(const float4*)(conv_b + c), b1 = *(const float4*)(conv_b + c + 4);
          bias[0] = b0.x; bias[1] = b0.y; bias[2] = b0.z; bias[3] = b0.w; bias[4] = b1.x; bias[5] = b1.y; bias[6] = b1.z; bias[7] = b1.w; }
        const bf16* src = projb + (size_t)t0 * NB_LD + NB_XBC + c;
        v4u raw[19];
#pragma unroll
        for (int s = 0; s < 19; ++s) { v4u z; z.x = 0u; z.y = 0u; z.z = 0u; z.w = 0u; raw[s] = (s >= 3 || i0 != 0) ? *(const v4u*)(src + (ptrdiff_t)(s - 3) * NB_LD) : z; }
        float p0[8], p1[8], p2[8];
        unpack8(raw[0], p0); unpack8(raw[1], p1); unpack8(raw[2], p2);
#pragma unroll
        for (int s = 0; s < 16; ++s) {
            float cur[8], acc[8]; unpack8(raw[s + 3], cur);
#pragma unroll
            for (int j = 0; j < 8; ++j) acc[j] = silu_f(bias[j] + p0[j] * w[0][j] + p1[j] * w[1][j] + p2[j] * w[2][j] + cur[j] * w[3][j]);
            v4u o; o.x = pk2(acc[0], acc[1]); o.y = pk2(acc[2], acc[3]); o.z = pk2(acc[4], acc[5]); o.w = pk2(acc[6], acc[7]);
            *(v4u*)(xbc_b + (size_t)(t0 + s) * CONV_DIM + c) = o;
            if (i0 + s >= SEQ - 3) store8f(out + OUT_PC + ((size_t)b * 3 + (i0 + s - (SEQ - 3))) * CONV_DIM + c, cur);
#pragma unroll
            for (int j = 0; j < 8; ++j) { p0[j] = p1[j]; p1[j] = p2[j]; p2[j] = cur[j]; }
        }
    }
#pragma unroll 4
    for (int item = gtid; item < T_PROMPT * 128; item += gsz) {
        const int t = item >> 7, sub = item & 127, which = sub >> 6, h = (sub >> 3) & 7, jc = sub & 7, i = t & (SEQ - 1), b = t >> 13;
        const bf16* src = projb + (size_t)t * NB_LD + (which ? NB_K : NB_Q) + h * 64 + jc * 4;
        const uint2 lo = *(const uint2*)src, hi = *(const uint2*)(src + 32);
        const float4 cs = *(const float4*)(rope_tab + (size_t)i * 64 + jc * 4), sn = *(const float4*)(rope_tab + (size_t)i * 64 + 32 + jc * 4);
        float t1[4], t2[4], o1[4], o2[4];
        t1[0] = __builtin_bit_cast(float, lo.x << 16); t1[1] = __builtin_bit_cast(float, lo.x & 0xffff0000u); t1[2] = __builtin_bit_cast(float, lo.y << 16); t1[3] = __builtin_bit_cast(float, lo.y & 0xffff0000u);
        t2[0] = __builtin_bit_cast(float, hi.x << 16); t2[1] = __builtin_bit_cast(float, hi.x & 0xffff0000u); t2[2] = __builtin_bit_cast(float, hi.y << 16); t2[3] = __builtin_bit_cast(float, hi.y & 0xffff0000u);
        const float cv[4] = {cs.x, cs.y, cs.z, cs.w}, sv[4] = {sn.x, sn.y, sn.z, sn.w};
#pragma unroll
        for (int e = 0; e < 4; ++e) { o1[e] = t1[e] * cv[e] - t2[e] * sv[e]; o2[e] = t2[e] * cv[e] + t1[e] * sv[e]; }
        const size_t doff = (size_t)t * ATT_WIDTH + h * 64 + jc * 4;
        bf16* db = which ? krot_b : qrot_b;
        *(uint2*)(db + doff) = make_uint2(pk2(o1[0], o1[1]), pk2(o1[2], o1[3])); *(uint2*)(db + doff + 32) = make_uint2(pk2(o2[0], o2[1]), pk2(o2[2], o2[3]));
        if (which && i >= SEQ - WBUF) {
            float* o = out + OUT_PK + ((size_t)b * WBUF + (i - (SEQ - WBUF))) * ATT_WIDTH + h * 64 + jc * 4;
            *(float4*)o = make_float4(o1[0], o1[1], o1[2], o1[3]); *(float4*)(o + 32) = make_float4(o2[0], o2[1], o2[2], o2[3]);
        }
    }
#pragma unroll 4
    for (int item = gtid; item < T_PROMPT * SSD_HEADS; item += gsz) { const int t = item / SSD_HEADS, hd = item - t * SSD_HEADS; dtv[item] = softplus_f(dtraw[(size_t)t * 32 + hd] + dt_bias[hd]); }
#pragma unroll 2
    for (int item = gtid; item < BATCH * WBUF * 64; item += gsz) {
        const int ch = item & 63, j = (item >> 6) & (WBUF - 1), b = item >> 17;
        float f[8]; unpack8(*(const v4u*)(projb + (size_t)(b * SEQ + (SEQ - WBUF) + j) * NB_LD + NB_V + ch * 8), f);
        store8f(out + OUT_PV + ((size_t)b * WBUF + j) * ATT_WIDTH + ch * 8, f);
    }
}

#define SSD_CH 32
__device__ __forceinline__ void ph_ssd_naive(float* lds, const bf16* __restrict__ xbc_act, const float* __restrict__ dtv, const float* __restrict__ a_log,
                                             const float* __restrict__ d_skip, const float* __restrict__ state_ssm, float* __restrict__ ybuf, float* __restrict__ out) {
    float (*sx)[64] = (float (*)[64])lds;
    float (*sB)[128] = (float (*)[128])(lds + SSD_CH * 64);
    float (*sC)[128] = (float (*)[128])(lds + SSD_CH * 64 + SSD_CH * 128);
    float* sdt = lds + SSD_CH * 64 + 2 * SSD_CH * 128;
    const int tid = threadIdx.x, p = tid >> 3, ng = tid & 7;
    for (int vb = BATCH * SSD_HEADS + blockIdx.x; vb < (BATCH + DEC_BATCH) * SSD_HEADS; vb += gridDim.x) {
        const int seq = vb / SSD_HEADS, h = vb % SSD_HEADS, g = h / 6;
        const bool is_p = seq < BATCH;
        const int L = is_p ? SEQ : DEC_SEQ;
        const int t0 = is_p ? seq * SEQ : T_PROMPT + (seq - BATCH) * DEC_SEQ;
        const float A = -__expf(a_log[h]);
        const float D = d_skip[h];
        float hs[16];
        if (is_p) {
#pragma unroll
            for (int j = 0; j < 16; ++j) hs[j] = 0.f;
        } else {
            const float* s0 = state_ssm + (((size_t)(seq - BATCH) * SSD_HEADS + h) * 64 + p) * 128 + ng * 16;
#pragma unroll
            for (int j = 0; j < 16; ++j) hs[j] = s0[j];
        }
        for (int c0 = 0; c0 < L; c0 += SSD_CH) {
            const int nst = (L - c0) < SSD_CH ? (L - c0) : SSD_CH;
            __syncthreads();
            for (int idx = tid; idx < nst * 64; idx += NTHR) { int s = idx >> 6, c = idx & 63; sx[s][c] = bf2f(xbc_act[(size_t)(t0 + c0 + s) * CONV_DIM + h * 64 + c]); }
            for (int idx = tid; idx < nst * 128; idx += NTHR) { int s = idx >> 7, c = idx & 127;
                sB[s][c] = bf2f(xbc_act[(size_t)(t0 + c0 + s) * CONV_DIM + 1536 + g * 128 + c]);
                sC[s][c] = bf2f(xbc_act[(size_t)(t0 + c0 + s) * CONV_DIM + 2048 + g * 128 + c]); }
            if (tid < nst) sdt[tid] = dtv[(size_t)(t0 + c0 + tid) * SSD_HEADS + h];
            __syncthreads();
            for (int s = 0; s < nst; ++s) {
                const float dt = sdt[s], x = sx[s][p];
                const float a = __expf(dt * A), xdt = x * dt;
                float y = 0.f;
#pragma unroll
                for (int j = 0; j < 16; ++j) { hs[j] = a * hs[j] + xdt * sB[s][ng * 16 + j]; y += sC[s][ng * 16 + j] * hs[j]; }
                y += __shfl_xor(y, 1); y += __shfl_xor(y, 2); y += __shfl_xor(y, 4);
                if (ng == 0) ybuf[(size_t)(t0 + c0 + s) * MIX_WIDTH + h * 64 + p] = y + D * x;
            }
        }
        float* so = is_p ? out + OUT_PS + (((size_t)seq * SSD_HEADS + h) * 64 + p) * 128 + ng * 16
                         : out + OUT_SS + (((size_t)(seq - BATCH) * SSD_HEADS + h) * 64 + p) * 128 + ng * 16;
#pragma unroll
        for (int j = 0; j < 16; ++j) so[j] = hs[j];
    }
}

__device__ __forceinline__ void ph_gate_norm(const bf16* __restrict__ projb, const float* __restrict__ norm_g, const float* __restrict__ ybuf, bf16* __restrict__ A1) {
    const int w = threadIdx.x >> 6, lane = threadIdx.x & 63, g = w & 3;
    for (int t = T_PROMPT + 2 * blockIdx.x + (w >> 2); t < T_ALL; t += 2 * gridDim.x) {
        float v[6]; float ss = 0.f;
#pragma unroll
        for (int j = 0; j < 6; ++j) {
            int c = g * 384 + j * 64 + lane;
            float y = ybuf[(size_t)t * MIX_WIDTH + c], z = bf2f(projb[(size_t)t * NB_LD + c]);
            v[j] = y * silu_f(z); ss += v[j] * v[j];
        }
        ss = wave_sum(ss);
        const float r = rsqrtf(ss * (1.0f / 384.0f) + LN_EPS);
#pragma unroll
        for (int j = 0; j < 6; ++j) { int c = g * 384 + j * 64 + lane; A1[(size_t)t * MIX_WIDTH + c] = (bf16)f2bf(v[j] * r * norm_g[c]); }
    }
}

__device__ __forceinline__ void ph_attn_naive(float* lds, const float* __restrict__ proj, const float* __restrict__ qrot, const float* __restrict__ krot,
                                              const float* __restrict__ ck, const float* __restrict__ cv, float* __restrict__ ybuf) {
    float (*sq)[64] = (float (*)[64])lds;
    const int w = threadIdx.x >> 6, lane = threadIdx.x & 63;
    for (int vb = blockIdx.x; vb < T_SAMPLE * 8 / NWAVE; vb += gridDim.x) {
        const int item = T_PROMPT * 8 + vb * NWAVE + w;
        const int t = item >> 3, h = item & 7;
        const bool is_p = t < T_PROMPT;
        int b, i;
        if (is_p) { b = t / SEQ; i = t % SEQ; } else { int ts = t - T_PROMPT; b = ts / DEC_SEQ; i = ts % DEC_SEQ; }
        __syncthreads();
        sq[w][lane] = qrot[(size_t)t * ATT_WIDTH + h * 64 + lane];
        __syncthreads();
        const int qi = is_p ? i : WBUF + i;
        float sc[3][3];
        float mx = -INFINITY;
#pragma unroll
        for (int pt = 0; pt < 3; ++pt) {
            const int d = pt == 0 ? 1 : (pt == 1 ? 4 : 16);
#pragma unroll
            for (int sl = 0; sl < 3; ++sl) {
                const int m = lane + sl * 64;
                float s = -INFINITY;
                const int kj = qi - d * m;
                if (m <= 128 && kj >= 0) {
                    const float* kr;
                    if (is_p) kr = krot + (size_t)(b * SEQ + kj) * ATT_WIDTH + h * 64;
                    else kr = (kj >= WBUF) ? krot + (size_t)(T_PROMPT + b * DEC_SEQ + (kj - WBUF)) * ATT_WIDTH + h * 64
                                           : ck + ((size_t)b * WBUF + kj) * ATT_WIDTH + h * 64;
                    float a = 0.f;
#pragma unroll
                    for (int c = 0; c < 64; c += 4) { float4 kv = *(const float4*)(kr + c); a += kv.x * sq[w][c] + kv.y * sq[w][c + 1] + kv.z * sq[w][c + 2] + kv.w * sq[w][c + 3]; }
                    s = a * 0.125f;
                }
                sc[pt][sl] = s; mx = fmaxf(mx, s);
            }
        }
        mx = wave_max(mx);
        float lsum = 0.f;
#pragma unroll
        for (int pt = 0; pt < 3; ++pt)
#pragma unroll
            for (int sl = 0; sl < 3; ++sl) { float pv = (sc[pt][sl] == -INFINITY) ? 0.f : __expf(sc[pt][sl] - mx); sc[pt][sl] = pv; lsum += pv; }
        lsum = wave_sum(lsum);
        float o = 0.f;
#pragma unroll
        for (int pt = 0; pt < 3; ++pt) {
            const int d = pt == 0 ? 1 : (pt == 1 ? 4 : 16);
#pragma unroll
            for (int sl = 0; sl < 3; ++sl) {
                const int mend = sl < 2 ? 64 : 1;
                for (int ml = 0; ml < mend; ++ml) {
                    const int m = ml + sl * 64;
                    const int kj = qi - d * m;
                    const float pv = __shfl(sc[pt][sl], ml);
                    if (kj < 0) continue;
                    const float* vr;
                    if (is_p) vr = proj + (size_t)(b * SEQ + kj) * PROJ_LD + O_V + h * 64;
                    else vr = (kj >= WBUF) ? proj + (size_t)(T_PROMPT + b * DEC_SEQ + (kj - WBUF)) * PROJ_LD + O_V + h * 64
                                           : cv + ((size_t)b * WBUF + kj) * ATT_WIDTH + h * 64;
                    o += pv * vr[lane];
                }
            }
        }
        ybuf[(size_t)t * MIX_WIDTH + SSD_WIDTH + h * 64 + lane] = o / lsum;
    }
}

__device__ __forceinline__ void ph_ln_res(const float* __restrict__ xp, const float* __restrict__ xs, const float* __restrict__ add, const float* __restrict__ gam,
                                          const float* __restrict__ bet, float* __restrict__ dst, bf16* __restrict__ dstb) {
    const int lane = threadIdx.x & 63;
    for (int t = blockIdx.x * NWAVE + (threadIdx.x >> 6); t < T_ALL; t += gridDim.x * NWAVE) {
        const float* res = (t < T_PROMPT) ? xp + (size_t)t * D_MODEL : xs + (size_t)(t - T_PROMPT) * D_MODEL;
        float v[16]; float s = 0.f;
#pragma unroll
        for (int j = 0; j < 4; ++j) { const int c = j * 256 + lane * 4; const float4 r4 = *(const float4*)(res + c), a4 = *(const float4*)(add + (size_t)t * D_MODEL + c);
            v[4 * j] = ALPHA_F * r4.x + a4.x; v[4 * j + 1] = ALPHA_F * r4.y + a4.y; v[4 * j + 2] = ALPHA_F * r4.z + a4.z; v[4 * j + 3] = ALPHA_F * r4.w + a4.w;
            s += (v[4 * j] + v[4 * j + 1]) + (v[4 * j + 2] + v[4 * j + 3]); }
        s = wave_sum(s);
        const float mu = s * (1.0f / 1024.0f);
        float q = 0.f;
#pragma unroll
        for (int j = 0; j < 16; ++j) { v[j] -= mu; q += v[j] * v[j]; }
        q = wave_sum(q);
        const float r = rsqrtf(q * (1.0f / 1024.0f) + LN_EPS);
#pragma unroll
        for (int j = 0; j < 4; ++j) { const int c = j * 256 + lane * 4; const float4 g4 = *(const float4*)(gam + c), b4 = *(const float4*)(bet + c);
            const float o0 = v[4 * j] * r * g4.x + b4.x, o1 = v[4 * j + 1] * r * g4.y + b4.y, o2 = v[4 * j + 2] * r * g4.z + b4.z, o3 = v[4 * j + 3] * r * g4.w + b4.w;
            *(float4*)(dst + (size_t)t * D_MODEL + c) = make_float4(o0, o1, o2, o3);
            *(uint2*)(dstb + (size_t)t * D_MODEL + c) = make_uint2(pk2(o0, o1), pk2(o2, o3)); }
    }
}

__device__ __forceinline__ void ph_peer_route(float* lds, const float* __restrict__ qh, const float* __restrict__ keys1, const float* __restrict__ keys2,
                                              int* __restrict__ eidx, float* __restrict__ gate) {
    float (*sq)[256] = (float (*)[256])lds;
    float (*sv)[2][16] = (float (*)[2][16])(lds + NWAVE * 256);
    int (*si)[2][16] = (int (*)[2][16])(lds + NWAVE * 256 + NWAVE * 32);
    const int w = threadIdx.x >> 6, lane = threadIdx.x & 63;
    for (int vb = blockIdx.x; vb < T_ALL * 8 / NWAVE; vb += gridDim.x) {
        const int item = vb * NWAVE + w;
        const int t = item >> 3, h = item & 7;
        __syncthreads();
        for (int c = lane; c < 256; c += 64) sq[w][c] = qh[(size_t)t * 2048 + h * 256 + c];
        __syncthreads();
#pragma unroll
        for (int half = 0; half < 2; ++half) {
            const float* keys = half ? keys2 : keys1;
            float s[2];
#pragma unroll
            for (int sl = 0; sl < 2; ++sl) {
                const float* kr = keys + (size_t)(lane + sl * 64) * 128;
                float a = 0.f;
#pragma unroll 8
                for (int c = 0; c < 128; c += 4) { float4 kv = *(const float4*)(kr + c); const float* qq = &sq[w][half * 128 + c]; a += kv.x * qq[0] + kv.y * qq[1] + kv.z * qq[2] + kv.w * qq[3]; }
                s[sl] = a;
            }
            for (int r = 0; r < 16; ++r) {
                float bv; int bi;
                if (s[0] >= s[1]) { bv = s[0]; bi = lane; } else { bv = s[1]; bi = lane + 64; }
#pragma unroll
                for (int o = 32; o > 0; o >>= 1) {
                    float ov = __shfl_xor(bv, o); int oi = __shfl_xor(bi, o);
                    if (ov > bv || (ov == bv && oi < bi)) { bv = ov; bi = oi; }
                }
                if (lane == 0) { sv[w][half][r] = bv; si[w][half][r] = bi; }
                if (bi == lane) s[0] = -INFINITY;
                if (bi == lane + 64) s[1] = -INFINITY;
            }
        }
        __syncthreads();
        float c[4];
#pragma unroll
        for (int j = 0; j < 4; ++j) { int ci = lane * 4 + j; c[j] = sv[w][0][ci >> 4] + sv[w][1][ci & 15]; }
        float myv = 0.f; int myc = 0;
        for (int r = 0; r < 16; ++r) {
            float bv = c[0]; int bi = lane * 4;
#pragma unroll
            for (int j = 1; j < 4; ++j) if (c[j] > bv) { bv = c[j]; bi = lane * 4 + j; }
#pragma unroll
            for (int o = 32; o > 0; o >>= 1) {
                float ov = __shfl_xor(bv, o); int oi = __shfl_xor(bi, o);
                if (ov > bv || (ov == bv && oi < bi)) { bv = ov; bi = oi; }
            }
            if (lane == r) { myv = bv; myc = bi; }
#pragma unroll
            for (int j = 0; j < 4; ++j) if (bi == lane * 4 + j) c[j] = -INFINITY;
        }
        float v = lane < 16 ? myv : -INFINITY;
        float mx = wave_max(v);
        float e = lane < 16 ? __expf(v - mx) : 0.f;
        float sum = wave_sum(e);
        if (lane < 16) {
            int ex = si[w][0][myc >> 4] * PEER_NKEYS + si[w][1][myc & 15];
            eidx[(size_t)t * 128 + h * 16 + lane] = ex;
            gate[(size_t)t * 128 + h * 16 + lane] = e / sum;
        }
    }
}

__device__ __forceinline__ void ph_peer_ffn(const float* __restrict__ hbuf, const int* __restrict__ eidx, const float* __restrict__ gate,
                                            const bf16* __restrict__ ub, const bf16* __restrict__ vb, const float* __restrict__ gam,
                                            const float* __restrict__ bet, float* __restrict__ out) {
    const int lane = threadIdx.x & 63;
    for (int t = blockIdx.x * NWAVE + (threadIdx.x >> 6); t < T_ALL; t += gridDim.x * NWAVE) {
        float x[16], acc[16];
        { const float* xr = hbuf + (size_t)t * D_MODEL + lane * 8;
          const float4 a = *(const float4*)xr, b = *(const float4*)(xr + 4), c = *(const float4*)(xr + 512), d = *(const float4*)(xr + 516);
          x[0] = a.x; x[1] = a.y; x[2] = a.z; x[3] = a.w; x[4] = b.x; x[5] = b.y; x[6] = b.z; x[7] = b.w;
          x[8] = c.x; x[9] = c.y; x[10] = c.z; x[11] = c.w; x[12] = d.x; x[13] = d.y; x[14] = d.z; x[15] = d.w; }
#pragma unroll
        for (int j = 0; j < 16; ++j) acc[j] = 0.f;
        for (int k = 0; k < 128; ++k) {
            const int e = eidx[(size_t)t * 128 + k];
            const float g = gate[(size_t)t * 128 + k];
            const bf16* ur = ub + (size_t)e * D_MODEL + lane * 8;
            float u0[8], u1[8];
            unpack8(*(const v4u*)ur, u0); unpack8(*(const v4u*)(ur + 512), u1);
            float d = 0.f;
#pragma unroll
            for (int j = 0; j < 8; ++j) d += u0[j] * x[j] + u1[j] * x[8 + j];
            d = wave_sum(d);
            const float wgt = g * gelu_f(d);
            const bf16* vr = vb + (size_t)e * D_MODEL + lane * 8;
            unpack8(*(const v4u*)vr, u0); unpack8(*(const v4u*)(vr + 512), u1);
#pragma unroll
            for (int j = 0; j < 8; ++j) { acc[j] += wgt * u0[j]; acc[8 + j] += wgt * u1[j]; }
        }
        float s = 0.f;
#pragma unroll
        for (int j = 0; j < 16; ++j) { acc[j] += ALPHA_F * x[j]; s += acc[j]; }
        s = wave_sum(s);
        const float mu = s * (1.0f / 1024.0f);
        float q = 0.f;
#pragma unroll
        for (int j = 0; j < 16; ++j) { acc[j] -= mu; q += acc[j] * acc[j]; }
        q = wave_sum(q);
        const float r = rsqrtf(q * (1.0f / 1024.0f) + LN_EPS);
        float* dst = ((t < T_PROMPT) ? out + OUT_YP + (size_t)t * D_MODEL : out + OUT_YS + (size_t)(t - T_PROMPT) * D_MODEL) + lane * 8;
#pragma unroll
        for (int q4 = 0; q4 < 4; ++q4) {
            const int eo = (q4 >> 1) * 512 + (q4 & 1) * 4;
            const float4 g4 = *(const float4*)(gam + lane * 8 + eo), b4 = *(const float4*)(bet + lane * 8 + eo);
            float4 o; o.x = acc[q4 * 4 + 0] * r * g4.x + b4.x; o.y = acc[q4 * 4 + 1] * r * g4.y + b4.y; o.z = acc[q4 * 4 + 2] * r * g4.z + b4.z; o.w = acc[q4 * 4 + 3] * r * g4.w + b4.w;
            *(float4*)(dst + eo) = o;
        }
    }
}

__device__ __forceinline__ float peer_dot16(const v4u a, const v4u b, const float (&x)[16]) {
    float u0[8], u1[8]; unpack8(a, u0); unpack8(b, u1);
    float d = 0.f;
#pragma unroll
    for (int j = 0; j < 8; ++j) d += u0[j] * x[j] + u1[j] * x[8 + j];
    return d;
}
#define PEER_TR_STEP(N, M) _Pragma("unroll") for (int i = 0; i < N; ++i) { const bool up = (lane & M) != 0; const float keep = up ? part[i + N] : part[i]; const float send = up ? part[i] : part[i + N]; part[i] = keep + __shfl_xor(send, M); }
__device__ __forceinline__ void ph_peer_ffn2(const float* __restrict__ hbuf, const int* __restrict__ eidx, const float* __restrict__ gate,
                                             const bf16* __restrict__ ub, const bf16* __restrict__ vb, const float* __restrict__ gam,
                                             const float* __restrict__ bet, float* __restrict__ out) {
    const int lane0 = threadIdx.x & 63;
    for (int t = blockIdx.x * NWAVE + (threadIdx.x >> 6); t < T_ALL; t += gridDim.x * NWAVE) {
        int lane = lane0; asm volatile("" : "+v"(lane));
        float x[16];
        { const float* xr = hbuf + (size_t)t * D_MODEL + lane * 8;
          const float4 a = *(const float4*)xr, b = *(const float4*)(xr + 4), c = *(const float4*)(xr + 512), d = *(const float4*)(xr + 516);
          x[0] = a.x; x[1] = a.y; x[2] = a.z; x[3] = a.w; x[4] = b.x; x[5] = b.y; x[6] = b.z; x[7] = b.w;
          x[8] = c.x; x[9] = c.y; x[10] = c.z; x[11] = c.w; x[12] = d.x; x[13] = d.y; x[14] = d.z; x[15] = d.w; }
        int ev[2]; float wv[4];
        ev[0] = eidx[(size_t)t * 128 + lane]; ev[1] = eidx[(size_t)t * 128 + 64 + lane];
#pragma unroll
        for (int rd = 0; rd < 4; ++rd) wv[rd] = gate[(size_t)t * 128 + rd * 32 + (lane >> 1)];
#pragma unroll
        for (int rd = 0; rd < 4; ++rd) {
            float part[32];
#pragma unroll
            for (int kb = 0; kb < 8; ++kb) {
                v4u ra[4], rb[4];
#pragma unroll
                for (int k8 = 0; k8 < 4; ++k8) {
                    const int e = __builtin_amdgcn_readlane(ev[rd >> 1], (rd & 1) * 32 + kb * 4 + k8);
                    const bf16* ur = ub + (size_t)e * D_MODEL + lane * 8;
                    ra[k8] = *(const v4u*)ur; rb[k8] = *(const v4u*)(ur + 512);
                }
#pragma unroll
                for (int k8 = 0; k8 < 4; ++k8) part[kb * 4 + k8] = peer_dot16(ra[k8], rb[k8], x);
            }
            PEER_TR_STEP(16, 32) PEER_TR_STEP(8, 16) PEER_TR_STEP(4, 8) PEER_TR_STEP(2, 4) PEER_TR_STEP(1, 2)
            const float hid = part[0] + __shfl_xor(part[0], 1);
            wv[rd] *= gelu_f(hid);
        }
        float acc[16];
#pragma unroll
        for (int j = 0; j < 16; ++j) acc[j] = 0.f;
#pragma unroll
        for (int rd = 0; rd < 4; ++rd) {
#pragma unroll
            for (int kb = 0; kb < 4; ++kb) {
                v4u ra[8], rb[8];
#pragma unroll
                for (int k8 = 0; k8 < 8; ++k8) {
                    const int e = __builtin_amdgcn_readlane(ev[rd >> 1], (rd & 1) * 32 + kb * 8 + k8);
                    const bf16* vr = vb + (size_t)e * D_MODEL + lane * 8;
                    ra[k8] = *(const v4u*)vr; rb[k8] = *(const v4u*)(vr + 512);
                }
#pragma unroll
                for (int k8 = 0; k8 < 8; ++k8) {
                    const float wk = __builtin_bit_cast(float, __builtin_amdgcn_readlane(__builtin_bit_cast(int, wv[rd]), 2 * (kb * 8 + k8)));
                    float u0[8], u1[8]; unpack8(ra[k8], u0); unpack8(rb[k8], u1);
#pragma unroll
                    for (int j = 0; j < 8; ++j) { acc[j] += wk * u0[j]; acc[8 + j] += wk * u1[j]; }
                }
            }
        }
        float s = 0.f;
#pragma unroll
        for (int j = 0; j < 16; ++j) { acc[j] += ALPHA_F * x[j]; s += acc[j]; }
        s = wave_sum(s);
        const float mu = s * (1.0f / 1024.0f);
        float q = 0.f;
#pragma unroll
        for (int j = 0; j < 16; ++j) { acc[j] -= mu; q += acc[j] * acc[j]; }
        q = wave_sum(q);
        const float r = rsqrtf(q * (1.0f / 1024.0f) + LN_EPS);
        float* dst = ((t < T_PROMPT) ? out + OUT_YP + (size_t)t * D_MODEL : out + OUT_YS + (size_t)(t - T_PROMPT) * D_MODEL) + lane * 8;
#pragma unroll
        for (int q4 = 0; q4 < 4; ++q4) {
            const int eo = (q4 >> 1) * 512 + (q4 & 1) * 4;
            const float4 g4 = *(const float4*)(gam + lane * 8 + eo), b4 = *(const float4*)(bet + lane * 8 + eo);
            float4 o; o.x = acc[q4 * 4 + 0] * r * g4.x + b4.x; o.y = acc[q4 * 4 + 1] * r * g4.y + b4.y; o.z = acc[q4 * 4 + 2] * r * g4.z + b4.z; o.w = acc[q4 * 4 + 3] * r * g4.w + b4.w;
            *(float4*)(dst + eo) = o;
        }
    }
}

__device__ __forceinline__ void ph_attn_sample(float* lds, const bf16* __restrict__ qrot_b, const bf16* __restrict__ krot_b, const bf16* __restrict__ projb,
                                               const float* __restrict__ ck, const float* __restrict__ cv, bf16* __restrict__ A1) {
    float (*sq)[64] = (float (*)[64])lds;
    const int w = threadIdx.x >> 6, lane0 = threadIdx.x & 63;
    for (int vb = blockIdx.x; vb < T_SAMPLE * 8 / NWAVE; vb += gridDim.x) {
        int lane = lane0; asm volatile("" : "+v"(lane));
        const int item = vb * NWAVE + w, ts = item >> 3, hd = item & 7, b = ts >> 2, i = ts & 3, t = T_PROMPT + ts;
        __syncthreads();
        sq[w][lane] = bf2f(qrot_b[(size_t)t * ATT_WIDTH + hd * 64 + lane]);
        __syncthreads();
        const int qi = WBUF + i;
        float sc[8];
        float mx = -INFINITY;
#pragma unroll
        for (int slot = 0; slot < 7; ++slot) {
            const int pt = slot < 6 ? (slot >> 1) : (lane < 3 ? lane : 0);
            const int m = slot < 6 ? lane + 64 * (slot & 1) : 128;
            const int kj = qi - (m << (2 * pt));
            const bool valid = (slot < 6 || lane < 3) && kj < WBUF;
            const int kc = kj < WBUF ? kj : WBUF - 1;
            const float* kr = ck + ((size_t)b * WBUF + kc) * ATT_WIDTH + hd * 64;
            float a = 0.f;
#pragma unroll
            for (int c = 0; c < 64; c += 4) { const float4 kv = *(const float4*)(kr + c); a += kv.x * sq[w][c] + kv.y * sq[w][c + 1] + kv.z * sq[w][c + 2] + kv.w * sq[w][c + 3]; }
            const float s = valid ? a * 0.125f : -INFINITY;
            sc[slot] = s; mx = fmaxf(mx, s);
        }
        const int nt7 = lane <= i ? i - lane : i;
        const bool valid7 = lane < i + 3;
        {
            const bf16* kr = krot_b + (size_t)(T_PROMPT + b * DEC_SEQ + nt7) * ATT_WIDTH + hd * 64;
            float a = 0.f;
#pragma unroll
            for (int c = 0; c < 64; c += 8) { float f[8]; unpack8(*(const v4u*)(kr + c), f);
#pragma unroll
                for (int j = 0; j < 8; ++j) a += f[j] * sq[w][c + j]; }
            const float s = valid7 ? a * 0.125f : -INFINITY;
            sc[7] = s; mx = fmaxf(mx, s);
        }
        mx = wave_max(mx);
        float lsum = 0.f;
#pragma unroll
        for (int slot = 0; slot < 8; ++slot) { const float pv = __expf(sc[slot] - mx); sc[slot] = pv; lsum += pv; }
        lsum = wave_sum(lsum);
        float part[64];
#pragma unroll
        for (int c = 0; c < 64; ++c) part[c] = 0.f;
#pragma unroll
        for (int slot = 0; slot < 7; ++slot) {
            const int pt = slot < 6 ? (slot >> 1) : (lane < 3 ? lane : 0);
            const int m = slot < 6 ? lane + 64 * (slot & 1) : 128;
            const int kj = qi - (m << (2 * pt));
            const int kc = kj < WBUF ? kj : WBUF - 1;
            const float pv = sc[slot];
            const float* vr = cv + ((size_t)b * WBUF + kc) * ATT_WIDTH + hd * 64;
#pragma unroll
            for (int c = 0; c < 64; c += 4) { const float4 vv = *(const float4*)(vr + c); part[c] += pv * vv.x; part[c + 1] += pv * vv.y; part[c + 2] += pv * vv.z; part[c + 3] += pv * vv.w; }
        }
        {
            const float pv = sc[7];
            const bf16* vr = projb + (size_t)(T_PROMPT + b * DEC_SEQ + nt7) * NB_LD + NB_V + hd * 64;
#pragma unroll
            for (int c = 0; c < 64; c += 8) { float f[8]; unpack8(*(const v4u*)(vr + c), f);
#pragma unroll
                for (int j = 0; j < 8; ++j) part[c + j] += pv * f[j]; }
        }
        PEER_TR_STEP(32, 32) PEER_TR_STEP(16, 16) PEER_TR_STEP(8, 8) PEER_TR_STEP(4, 4) PEER_TR_STEP(2, 2) PEER_TR_STEP(1, 1)
        A1[(size_t)t * MIX_WIDTH + SSD_WIDTH + hd * 64 + lane] = (bf16)f2bf(part[0] / lsum);
    }
}


__device__ __forceinline__ void cache_copy_slice(const float* __restrict__ ck, const float* __restrict__ cv, float* __restrict__ out, unsigned slice, unsigned lane) {
    constexpr unsigned PER_B = (WBUF - DEC_SEQ) * ATT_WIDTH / 4;
    constexpr unsigned TOTAL = 2u * DEC_BATCH * PER_B;
#pragma unroll 1
    for (unsigned bt = 0; bt < 8; ++bt) {
        f32x4n v[8]; size_t dsti[8]; bool isv[8]; bool ok[8];
#pragma unroll
        for (int j = 0; j < 8; ++j) {
            const unsigned idx = slice * 4096u + bt * 512u + j * 64u + lane;
            ok[j] = idx < TOTAL;
            const unsigned idc = ok[j] ? idx : 0u;
            const unsigned tb = idc / PER_B, r = idc - tb * PER_B, bb = tb & (DEC_BATCH - 1);
            isv[j] = tb >= DEC_BATCH;
            const size_t srci = (size_t)bb * (WBUF * ATT_WIDTH / 4) + (DEC_SEQ * ATT_WIDTH / 4) + r;
            dsti[j] = (size_t)bb * (WBUF * ATT_WIDTH / 4) + r;
            v[j] = __builtin_nontemporal_load((isv[j] ? (const f32x4n*)cv : (const f32x4n*)ck) + srci);
        }
#pragma unroll
        for (int j = 0; j < 8; ++j) if (ok[j]) __builtin_nontemporal_store(v[j], (f32x4n*)(out + (isv[j] ? OUT_SV : OUT_SK)) + dsti[j]);
    }
}
typedef float f32x2v __attribute__((ext_vector_type(2)));
__device__ __forceinline__ void ph_quant_tables(const float* __restrict__ pu, const float* __restrict__ pv, unsigned char* __restrict__ ub8, unsigned char* __restrict__ vb8,
                                                float* __restrict__ usc, float* __restrict__ vsc, int rank, int nranks) {
    const int lane = threadIdx.x & 63;
#pragma unroll 2
    for (int row = rank * NWAVE + (threadIdx.x >> 6); row < 2 * 16384; row += nranks * NWAVE) {
        const int rr = row & 16383; const bool isv = row >= 16384;
        const float* src = (isv ? pv : pu) + (size_t)rr * D_MODEL + lane * 8;
        const float4 a = *(const float4*)src, b = *(const float4*)(src + 4), c = *(const float4*)(src + 512), d = *(const float4*)(src + 516);
        float am = fmaxf(fmaxf(fmaxf(fabsf(a.x), fabsf(a.y)), fmaxf(fabsf(a.z), fabsf(a.w))), fmaxf(fmaxf(fabsf(b.x), fabsf(b.y)), fmaxf(fabsf(b.z), fabsf(b.w))));
        am = fmaxf(am, fmaxf(fmaxf(fmaxf(fabsf(c.x), fabsf(c.y)), fmaxf(fabsf(c.z), fabsf(c.w))), fmaxf(fmaxf(fabsf(d.x), fabsf(d.y)), fmaxf(fabsf(d.z), fabsf(d.w)))));
        am = wave_max(am);
        const float sc = am > 0.f ? 224.0f / am : 1.0f;
        v4u o;
        o.x = (unsigned)__builtin_amdgcn_cvt_pk_fp8_f32(a.z * sc, a.w * sc, __builtin_amdgcn_cvt_pk_fp8_f32(a.x * sc, a.y * sc, 0, false), true);
        o.y = (unsigned)__builtin_amdgcn_cvt_pk_fp8_f32(b.z * sc, b.w * sc, __builtin_amdgcn_cvt_pk_fp8_f32(b.x * sc, b.y * sc, 0, false), true);
        o.z = (unsigned)__builtin_amdgcn_cvt_pk_fp8_f32(c.z * sc, c.w * sc, __builtin_amdgcn_cvt_pk_fp8_f32(c.x * sc, c.y * sc, 0, false), true);
        o.w = (unsigned)__builtin_amdgcn_cvt_pk_fp8_f32(d.z * sc, d.w * sc, __builtin_amdgcn_cvt_pk_fp8_f32(d.x * sc, d.y * sc, 0, false), true);
        *(v4u*)((isv ? vb8 : ub8) + (size_t)rr * 1024 + lane * 16) = o;
        if (lane == 0) (isv ? vsc : usc)[rr] = am > 0.f ? am * (1.0f / 224.0f) : 1.0f;
    }
}
__device__ __forceinline__ void unpack16_fp8(const v4u w, float (&f)[16]) {
#pragma unroll
    for (int i = 0; i < 4; ++i) {
        const f32x2v lo = __builtin_amdgcn_cvt_pk_f32_fp8((int)w[i], false), hi = __builtin_amdgcn_cvt_pk_f32_fp8((int)w[i], true);
        f[4 * i] = lo[0]; f[4 * i + 1] = lo[1]; f[4 * i + 2] = hi[0]; f[4 * i + 3] = hi[1];
    }
}
__device__ __forceinline__ void ph_peer_ffn3(const float* __restrict__ hbuf, const int* __restrict__ eidx, const float* __restrict__ gate,
                                             const unsigned char* __restrict__ ub8, const unsigned char* __restrict__ vb8, const float* __restrict__ usc, const float* __restrict__ vsc,
                                             const float* __restrict__ gam, const float* __restrict__ bet, float* __restrict__ out,
                                             const float* __restrict__ ck, const float* __restrict__ cv, unsigned n9) {
    const int lane0 = threadIdx.x & 63;
    unsigned it = 0;
    for (int t = blockIdx.x * NWAVE + (threadIdx.x >> 6); t < T_ALL; t += gridDim.x * NWAVE, ++it) {
        int lane = lane0; asm volatile("" : "+v"(lane));
        { const unsigned sl = (blockIdx.x * NWAVE + (threadIdx.x >> 6)) + it * (gridDim.x * NWAVE); if (it < 8 && sl < n9) cache_copy_slice(ck, cv, out, sl, (unsigned)lane); }
        const unsigned lo16 = (unsigned)lane * 16u, lo8 = (unsigned)lane * 8u;
        float x[16];
        { const float* xr = hbuf + (size_t)t * D_MODEL + lo8;
          const float4 a = *(const float4*)xr, b = *(const float4*)(xr + 4), c = *(const float4*)(xr + 512), d = *(const float4*)(xr + 516);
          x[0] = a.x; x[1] = a.y; x[2] = a.z; x[3] = a.w; x[4] = b.x; x[5] = b.y; x[6] = b.z; x[7] = b.w;
          x[8] = c.x; x[9] = c.y; x[10] = c.z; x[11] = c.w; x[12] = d.x; x[13] = d.y; x[14] = d.z; x[15] = d.w; }
        int ev[2]; float wv[4], su[4];
        ev[0] = eidx[(size_t)t * 128 + lane]; ev[1] = eidx[(size_t)t * 128 + 64 + lane];
#pragma unroll
        for (int rd = 0; rd < 4; ++rd) {
            const int er = eidx[(size_t)t * 128 + rd * 32 + (lane >> 1)];
            wv[rd] = gate[(size_t)t * 128 + rd * 32 + (lane >> 1)] * vsc[er];
            su[rd] = usc[er];
        }
#pragma unroll
        for (int rd = 0; rd < 4; ++rd) {
            float part[32];
#pragma unroll
            for (int kb = 0; kb < 8; ++kb) {
                v4u ra[4];
#pragma unroll
                for (int k8 = 0; k8 < 4; ++k8) {
                    const int e = __builtin_amdgcn_readlane(ev[rd >> 1], (rd & 1) * 32 + kb * 4 + k8);
                    ra[k8] = *(const v4u*)(ub8 + (size_t)e * 1024 + lo16);
                }
#pragma unroll
                for (int k8 = 0; k8 < 4; ++k8) {
                    float f[16]; unpack16_fp8(ra[k8], f);
                    float d = 0.f;
#pragma unroll
                    for (int j = 0; j < 16; ++j) d += f[j] * x[j];
                    part[kb * 4 + k8] = d;
                    if (k8 & 1) __builtin_amdgcn_sched_barrier(0);
                }
            }
            PEER_TR_STEP(16, 32) PEER_TR_STEP(8, 16) PEER_TR_STEP(4, 8) PEER_TR_STEP(2, 4) PEER_TR_STEP(1, 2)
            const float hid = (part[0] + __shfl_xor(part[0], 1)) * su[rd];
            wv[rd] *= gelu_f(hid);
        }
        float acc[16];
#pragma unroll
        for (int j = 0; j < 16; ++j) acc[j] = 0.f;
#pragma unroll
        for (int rd = 0; rd < 4; ++rd) {
#pragma unroll
            for (int kb = 0; kb < 4; ++kb) {
                v4u ra[8];
#pragma unroll
                for (int k8 = 0; k8 < 8; ++k8) {
                    const int e = __builtin_amdgcn_readlane(ev[rd >> 1], (rd & 1) * 32 + kb * 8 + k8);
                    ra[k8] = *(const v4u*)(vb8 + (size_t)e * 1024 + lo16);
                }
#pragma unroll
                for (int k8 = 0; k8 < 8; ++k8) {
                    const float wk = __builtin_bit_cast(float, __builtin_amdgcn_readlane(__builtin_bit_cast(int, wv[rd]), 2 * (kb * 8 + k8)));
                    float f[16]; unpack16_fp8(ra[k8], f);
#pragma unroll
                    for (int j = 0; j < 16; ++j) acc[j] += wk * f[j];
                    if (k8 & 1) __builtin_amdgcn_sched_barrier(0);
                }
            }
        }
        float s = 0.f;
#pragma unroll
        for (int j = 0; j < 16; ++j) { acc[j] += ALPHA_F * x[j]; s += acc[j]; }
        s = wave_sum(s);
        const float mu = s * (1.0f / 1024.0f);
        float q = 0.f;
#pragma unroll
        for (int j = 0; j < 16; ++j) { acc[j] -= mu; q += acc[j] * acc[j]; }
        q = wave_sum(q);
        const float r = rsqrtf(q * (1.0f / 1024.0f) + LN_EPS);
        float* dst = ((t < T_PROMPT) ? out + OUT_YP + (size_t)t * D_MODEL : out + OUT_YS + (size_t)(t - T_PROMPT) * D_MODEL) + lo8;
#pragma unroll
        for (int q4 = 0; q4 < 4; ++q4) {
            const int eo = (q4 >> 1) * 512 + (q4 & 1) * 4;
            const float4 g4 = *(const float4*)(gam + lo8 + eo), b4 = *(const float4*)(bet + lo8 + eo);
            float4 o; o.x = acc[q4 * 4 + 0] * r * g4.x + b4.x; o.y = acc[q4 * 4 + 1] * r * g4.y + b4.y; o.z = acc[q4 * 4 + 2] * r * g4.z + b4.z; o.w = acc[q4 * 4 + 3] * r * g4.w + b4.w;
            *(float4*)(dst + eo) = o;
        }
    }
}


__device__ __forceinline__ void ssd_decode_load(const bf16* __restrict__ xbc_b, const float* __restrict__ dtv, const float* __restrict__ state_ssm, int item, int p, int ng,
                                                float (&hs)[16], v4u (&bq)[4][2], v4u (&cq)[4][2], float (&xv)[4], float (&dv)[4]) {
    const int sb = item / SSD_HEADS, h = item - sb * SSD_HEADS, g = h / 6, t0 = T_PROMPT + sb * DEC_SEQ;
    const float* s0 = state_ssm + (((size_t)sb * SSD_HEADS + h) * 64 + p) * 128 + ng * 16;
#pragma unroll
    for (int j = 0; j < 4; ++j) { const float4 v = *(const float4*)(s0 + 4 * j); hs[4 * j] = v.x; hs[4 * j + 1] = v.y; hs[4 * j + 2] = v.z; hs[4 * j + 3] = v.w; }
#pragma unroll
    for (int s = 0; s < 4; ++s) {
        const bf16* row = xbc_b + (size_t)(t0 + s) * CONV_DIM;
        bq[s][0] = *(const v4u*)(row + 1536 + g * 128 + ng * 16); bq[s][1] = *(const v4u*)(row + 1536 + g * 128 + ng * 16 + 8);
        cq[s][0] = *(const v4u*)(row + 2048 + g * 128 + ng * 16); cq[s][1] = *(const v4u*)(row + 2048 + g * 128 + ng * 16 + 8);
        xv[s] = bf2f(row[h * 64 + p]); dv[s] = dtv[(size_t)(t0 + s) * SSD_HEADS + h];
    }
}
__device__ __forceinline__ void ssd_decode_compute(const float* __restrict__ a_log, const float* __restrict__ d_skip, int item, int p, int ng,
                                                   float (&hs)[16], const v4u (&bq)[4][2], const v4u (&cq)[4][2], const float (&xv)[4], const float (&dv)[4],
                                                   float* __restrict__ ybuf, float* __restrict__ out) {
    const int sb = item / SSD_HEADS, h = item - sb * SSD_HEADS, t0 = T_PROMPT + sb * DEC_SEQ;
    const float A = -__expf(a_log[h]), D = d_skip[h];
#pragma unroll
    for (int s = 0; s < 4; ++s) {
        float Bf[16], Cf[16];
        { float t8[8]; unpack8(bq[s][0], t8);
#pragma unroll
          for (int j = 0; j < 8; ++j) Bf[j] = t8[j];
          unpack8(bq[s][1], t8);
#pragma unroll
          for (int j = 0; j < 8; ++j) Bf[8 + j] = t8[j];
          unpack8(cq[s][0], t8);
#pragma unroll
          for (int j = 0; j < 8; ++j) Cf[j] = t8[j];
          unpack8(cq[s][1], t8);
#pragma unroll
          for (int j = 0; j < 8; ++j) Cf[8 + j] = t8[j]; }
        const float a = __expf(dv[s] * A), xdt = xv[s] * dv[s];
        float y = 0.f;
#pragma unroll
        for (int j = 0; j < 16; ++j) { hs[j] = a * hs[j] + xdt * Bf[j]; y += Cf[j] * hs[j]; }
        y += __shfl_xor(y, 1); y += __shfl_xor(y, 2); y += __shfl_xor(y, 4);
        if (ng == 0) ybuf[(size_t)(t0 + s) * MIX_WIDTH + h * 64 + p] = y + D * xv[s];
    }
    float* so = out + OUT_SS + (((size_t)sb * SSD_HEADS + h) * 64 + p) * 128 + ng * 16;
#pragma unroll
    for (int j = 0; j < 4; ++j) *(float4*)(so + 4 * j) = make_float4(hs[4 * j], hs[4 * j + 1], hs[4 * j + 2], hs[4 * j + 3]);
}
__device__ __forceinline__ void ph_ssd_decode(const bf16* __restrict__ xbc_b, const float* __restrict__ dtv, const float* __restrict__ a_log, const float* __restrict__ d_skip,
                                              const float* __restrict__ state_ssm, float* __restrict__ ybuf, float* __restrict__ out) {
    const int tid = threadIdx.x, p = tid >> 3, ng = tid & 7;
    constexpr int NITEM = DEC_BATCH * SSD_HEADS;
    for (int it = blockIdx.x; it < NITEM; it += 2 * gridDim.x) {
        const int it2 = it + gridDim.x; const bool has2 = it2 < NITEM; const int it2c = has2 ? it2 : it;
        float hsA[16], hsB[16], xA[4], xB[4], dA[4], dB[4]; v4u bA[4][2], cA[4][2], bB[4][2], cB[4][2];
        ssd_decode_load(xbc_b, dtv, state_ssm, it, p, ng, hsA, bA, cA, xA, dA);
        ssd_decode_load(xbc_b, dtv, state_ssm, it2c, p, ng, hsB, bB, cB, xB, dB);
        ssd_decode_compute(a_log, d_skip, it, p, ng, hsA, bA, cA, xA, dA, ybuf, out);
        if (has2) ssd_decode_compute(a_log, d_skip, it2, p, ng, hsB, bB, cB, xB, dB, ybuf, out);
    }
}

__device__ __forceinline__ float samp_cw(int d) { return (float)((int)(d >= 0 && d <= 128) + (int)(d >= 0 && (d & 3) == 0 && d <= 512) + (int)(d >= 0 && (d & 15) == 0 && d <= 2048)); }
__device__ __forceinline__ void samp_update(float sv, float cw, const float (&vrow)[64], float& m, float& l, float (&part)[64]) {
    const float mn = fmaxf(m, sv), alpha = __expf(m - mn), p = cw * __expf(sv - mn);
    m = mn; l = l * alpha + p;
#pragma unroll
    for (int c = 0; c < 64; ++c) part[c] = part[c] * alpha + p * vrow[c];
}
__device__ __forceinline__ void ph_attn_sample3(float* lds, const bf16* __restrict__ qrot_b, const bf16* __restrict__ krot_b, const bf16* __restrict__ projb,
                                                const float* __restrict__ ck, const float* __restrict__ cv, bf16* __restrict__ A1) {
    const int lane0 = threadIdx.x & 63, w = __builtin_amdgcn_readfirstlane(threadIdx.x >> 6);
    float* sq = lds + w * 256;
    for (int item = blockIdx.x + gridDim.x * w; item < DEC_BATCH * ATT_HEADS; item += gridDim.x * NWAVE) {
        int lane = lane0; asm volatile("" : "+v"(lane));
        const int b = item >> 3, hd = item & 7, qi = lane & 3, g = lane >> 2;
        const int tq0 = T_PROMPT + b * DEC_SEQ;
#pragma unroll
        for (int i = 0; i < 4; ++i) sq[i * 64 + lane] = bf2f(qrot_b[(size_t)(tq0 + i) * ATT_WIDTH + hd * 64 + lane]);
        asm volatile("s_waitcnt lgkmcnt(0)" ::: "memory");
        const float* qv = sq + qi * 64;
        const float* ckb = ck + (size_t)b * WBUF * ATT_WIDTH + hd * 64; const float* cvb = cv + (size_t)b * WBUF * ATT_WIDTH + hd * 64;
        float m = -1e30f, l = 0.f, part[64];
#pragma unroll
        for (int c = 0; c < 64; ++c) part[c] = 0.f;
        {
            const int P = 2051 - g;
            const float cw = samp_cw(WBUF + qi - P);
            const bool isn = P >= WBUF;
            const int nt = isn ? P - WBUF : 0, Pc = isn ? WBUF - 1 : P;
            const bf16* kn = krot_b + (size_t)(tq0 + nt) * ATT_WIDTH + hd * 64; const float* kr = ckb + (size_t)Pc * ATT_WIDTH;
            float a = 0.f;
#pragma unroll
            for (int c = 0; c < 64; c += 8) { float f[8]; unpack8(*(const v4u*)(kn + c), f); const float4 k0 = *(const float4*)(kr + c), k1 = *(const float4*)(kr + c + 4);
                a += (isn ? f[0] : k0.x) * qv[c] + (isn ? f[1] : k0.y) * qv[c + 1] + (isn ? f[2] : k0.z) * qv[c + 2] + (isn ? f[3] : k0.w) * qv[c + 3]
                   + (isn ? f[4] : k1.x) * qv[c + 4] + (isn ? f[5] : k1.y) * qv[c + 5] + (isn ? f[6] : k1.z) * qv[c + 6] + (isn ? f[7] : k1.w) * qv[c + 7]; }
            const float sv = cw > 0.f ? a * 0.125f : -1e30f;
            const bf16* vn = projb + (size_t)(tq0 + nt) * NB_LD + NB_V + hd * 64; const float* vr = cvb + (size_t)Pc * ATT_WIDTH;
            float vrow[64];
#pragma unroll
            for (int c = 0; c < 64; c += 8) { float f[8]; unpack8(*(const v4u*)(vn + c), f); const float4 v0 = *(const float4*)(vr + c), v1 = *(const float4*)(vr + c + 4);
                vrow[c] = isn ? f[0] : v0.x; vrow[c + 1] = isn ? f[1] : v0.y; vrow[c + 2] = isn ? f[2] : v0.z; vrow[c + 3] = isn ? f[3] : v0.w;
                vrow[c + 4] = isn ? f[4] : v1.x; vrow[c + 5] = isn ? f[5] : v1.y; vrow[c + 6] = isn ? f[6] : v1.z; vrow[c + 7] = isn ? f[7] : v1.w; }
            samp_update(sv, cw, vrow, m, l, part);
        }
#pragma unroll 1
        for (int s = 1; s < 21; ++s) {
            const int P = s < 9 ? 2051 - (16 * s + g) : (s < 15 ? 1536 + 64 * (s - 9) + lane : qi + 16 * (16 * (s - 15) + g));
            const float cw = (s < 9 && P < 1920) ? 0.f : samp_cw(WBUF + qi - P);
            const float* kr = ckb + (size_t)P * ATT_WIDTH;
            float a = 0.f;
#pragma unroll
            for (int c = 0; c < 64; c += 4) { const float4 kv = *(const float4*)(kr + c); a += kv.x * qv[c] + kv.y * qv[c + 1] + kv.z * qv[c + 2] + kv.w * qv[c + 3]; }
            const float sv = cw > 0.f ? a * 0.125f : -1e30f;
            __builtin_amdgcn_sched_barrier(0);
            const float* vr = cvb + (size_t)P * ATT_WIDTH;
            float vrow[64];
#pragma unroll
            for (int c = 0; c < 64; c += 4) { const float4 vv = *(const float4*)(vr + c); vrow[c] = vv.x; vrow[c + 1] = vv.y; vrow[c + 2] = vv.z; vrow[c + 3] = vv.w; }
            samp_update(sv, cw, vrow, m, l, part);
        }
        float M = m;
        M = fmaxf(M, __shfl_xor(M, 4)); M = fmaxf(M, __shfl_xor(M, 8)); M = fmaxf(M, __shfl_xor(M, 16)); M = fmaxf(M, __shfl_xor(M, 32));
        const float sc = __expf(m - M);
        float lsum = l * sc;
        lsum += __shfl_xor(lsum, 4); lsum += __shfl_xor(lsum, 8); lsum += __shfl_xor(lsum, 16); lsum += __shfl_xor(lsum, 32);
#pragma unroll
        for (int c = 0; c < 64; ++c) part[c] *= sc;
        PEER_TR_STEP(32, 32) PEER_TR_STEP(16, 16) PEER_TR_STEP(8, 8) PEER_TR_STEP(4, 4)
        const float inv = 1.0f / lsum;
        *(uint2*)(A1 + (size_t)(tq0 + qi) * MIX_WIDTH + SSD_WIDTH + hd * 64 + 4 * g) = make_uint2(pk2(part[0] * inv, part[1] * inv), pk2(part[2] * inv, part[3] * inv));
    }
}

typedef float f32x16 __attribute__((ext_vector_type(16)));
typedef short s16x8 __attribute__((ext_vector_type(8)));
typedef short s16x4 __attribute__((ext_vector_type(4)));
typedef float f32x4v __attribute__((ext_vector_type(4)));
#define SSD_L_ACS 0
#define SSD_L_DTS 3072
#define SSD_L_BM 6144
#define SSD_RS_B 272
#define SSD_L_X (6144 + 128 * 272)
#define SSD_RS_X 144
#define SSD_XIMG (128 * 144)
#define SSD_RS_Y 784
template <int OFF0, int OFF1>
__device__ __forceinline__ s16x8 tr_frag(unsigned base) {
    s16x4 a, b;
    asm volatile("ds_read_b64_tr_b16 %0, %2 offset:%3\n\tds_read_b64_tr_b16 %1, %2 offset:%4\n\ts_waitcnt lgkmcnt(0)"
                 : "=&v"(a), "=&v"(b) : "v"(base), "n"(OFF0), "n"(OFF1) : "memory");
    return __builtin_shufflevector(a, b, 0, 1, 2, 3, 4, 5, 6, 7);
}
__device__ __forceinline__ unsigned lds_addr(LAS unsigned char* p) { return (unsigned)(size_t)p; }
template <int O0, int O1, int O2, int O3, int O4, int O5, int O6, int O7>
__device__ __forceinline__ void tr_read8(unsigned base, s16x4 (&v)[8]) {
    asm volatile("ds_read_b64_tr_b16 %0, %8 offset:%9\n\tds_read_b64_tr_b16 %1, %8 offset:%10\n\tds_read_b64_tr_b16 %2, %8 offset:%11\n\tds_read_b64_tr_b16 %3, %8 offset:%12\n\t"
                 "ds_read_b64_tr_b16 %4, %8 offset:%13\n\tds_read_b64_tr_b16 %5, %8 offset:%14\n\tds_read_b64_tr_b16 %6, %8 offset:%15\n\tds_read_b64_tr_b16 %7, %8 offset:%16\n\ts_waitcnt lgkmcnt(0)"
                 : "=&v"(v[0]), "=&v"(v[1]), "=&v"(v[2]), "=&v"(v[3]), "=&v"(v[4]), "=&v"(v[5]), "=&v"(v[6]), "=&v"(v[7])
                 : "v"(base), "n"(O0), "n"(O1), "n"(O2), "n"(O3), "n"(O4), "n"(O5), "n"(O6), "n"(O7) : "memory");
}
#define TRCAT(a, b) __builtin_shufflevector(a, b, 0, 1, 2, 3, 4, 5, 6, 7)


__device__ __forceinline__ void ssd_chunk_acs(LAS unsigned char* ldsb, const float* __restrict__ dtv, const float* __restrict__ a_log, int t0, int g, float* cdec_out) {
    const int w = __builtin_amdgcn_readfirstlane(threadIdx.x >> 6), lane = threadIdx.x & 63;
    if (w < 6) {
        const int head = 6 * g + w;
        const float A = -__expf(a_log[head]);
        const float v0 = dtv[(size_t)(t0 + 2 * lane) * SSD_HEADS + head], v1 = dtv[(size_t)(t0 + 2 * lane + 1) * SSD_HEADS + head];
        const float a1 = v1 * A;
        float s = v0 * A + a1;
#pragma unroll
        for (int o = 1; o < 64; o <<= 1) { const float tmp = __shfl_up(s, o); if (lane >= o) s += tmp; }
        LAS float* acs = (LAS float*)(ldsb + SSD_L_ACS) + w * 128;
        LAS float* dts = (LAS float*)(ldsb + SSD_L_DTS) + w * 128;
        acs[2 * lane] = s - a1; acs[2 * lane + 1] = s;
        dts[2 * lane] = v0; dts[2 * lane + 1] = v1;
        if (cdec_out && lane == 63) cdec_out[head] = __expf(s);
    }
}

__device__ __forceinline__ void ph_ssd_states(LAS unsigned char* ldsb, const bf16* __restrict__ xbc_b, const float* __restrict__ dtv, const float* __restrict__ a_log,
                                              bf16* __restrict__ Sbuf, float* __restrict__ cdec) {
    const int tid = threadIdx.x, w = __builtin_amdgcn_readfirstlane(tid >> 6), lane = tid & 63;
    const int r = lane & 31, h = lane >> 5, blk = (lane >> 4) & 1, q = (lane & 15) >> 2, pp = lane & 3;
    const int nt = w & 3, pt = w >> 2;
    for (int unit = blockIdx.x; unit < BATCH * 64 * SSD_GROUPS; unit += gridDim.x) {
        const int g = unit & 3, bc = unit >> 2;
        const int t0 = bc * 128;
        __syncthreads();
        ssd_chunk_acs(ldsb, dtv, a_log, t0, g, cdec + (size_t)bc * SSD_HEADS);
#pragma unroll
        for (int it_ = 0; it_ < 4; ++it_) { const int idx = tid + it_ * NTHR; const int row = idx >> 4, ch = idx & 15;
            const v4u v = *(const v4u*)(xbc_b + (size_t)(t0 + row) * CONV_DIM + 1536 + 128 * g + ch * 8);
            *(LAS v4u*)(ldsb + SSD_L_BM + row * SSD_RS_B + ch * 16) = v; }
        __syncthreads();
#pragma unroll
        for (int it_ = 0; it_ < 12; ++it_) { const int idx = tid + it_ * NTHR; const int hh = idx >> 10, rem = idx & 1023, row = rem >> 3, ch = rem & 7;
            const LAS float* acs = (const LAS float*)(ldsb + SSD_L_ACS) + hh * 128; const LAS float* dts = (const LAS float*)(ldsb + SSD_L_DTS) + hh * 128;
            const float wgt = dts[row] * __expf(acs[127] - acs[row]);
            float f[8]; unpack8(*(const v4u*)(xbc_b + (size_t)(t0 + row) * CONV_DIM + (6 * g + hh) * 64 + ch * 8), f);
            v4u o; o.x = pk2(f[0] * wgt, f[1] * wgt); o.y = pk2(f[2] * wgt, f[3] * wgt); o.z = pk2(f[4] * wgt, f[5] * wgt); o.w = pk2(f[6] * wgt, f[7] * wgt);
            *(LAS v4u*)(ldsb + SSD_L_X + hh * SSD_XIMG + row * SSD_RS_X + ch * 16) = o; }
        __syncthreads();
        const unsigned abase = lds_addr(ldsb + SSD_L_BM) + (8 * h + q) * SSD_RS_B + (32 * nt + 16 * blk + 4 * pp) * 2;
        s16x8 afr[8];
        { s16x4 av[8];
          tr_read8<0 * SSD_RS_B, 4 * SSD_RS_B, 16 * SSD_RS_B, 20 * SSD_RS_B, 32 * SSD_RS_B, 36 * SSD_RS_B, 48 * SSD_RS_B, 52 * SSD_RS_B>(abase, av);
          afr[0] = TRCAT(av[0], av[1]); afr[1] = TRCAT(av[2], av[3]); afr[2] = TRCAT(av[4], av[5]); afr[3] = TRCAT(av[6], av[7]);
          tr_read8<64 * SSD_RS_B, 68 * SSD_RS_B, 80 * SSD_RS_B, 84 * SSD_RS_B, 96 * SSD_RS_B, 100 * SSD_RS_B, 112 * SSD_RS_B, 116 * SSD_RS_B>(abase, av);
          afr[4] = TRCAT(av[0], av[1]); afr[5] = TRCAT(av[2], av[3]); afr[6] = TRCAT(av[4], av[5]); afr[7] = TRCAT(av[6], av[7]); }
#pragma unroll
        for (int hh = 0; hh < 6; ++hh) {
            const unsigned xb = lds_addr(ldsb + SSD_L_X + hh * SSD_XIMG) + (8 * h + q) * SSD_RS_X + (32 * pt + 16 * blk + 4 * pp) * 2;
            f32x16 acc;
#pragma unroll
            for (int i = 0; i < 16; ++i) acc[i] = 0.f;
            { s16x4 xv[8];
              tr_read8<0 * SSD_RS_X, 4 * SSD_RS_X, 16 * SSD_RS_X, 20 * SSD_RS_X, 32 * SSD_RS_X, 36 * SSD_RS_X, 48 * SSD_RS_X, 52 * SSD_RS_X>(xb, xv);
              acc = __builtin_amdgcn_mfma_f32_32x32x16_bf16(afr[0], TRCAT(xv[0], xv[1]), acc, 0, 0, 0);
              acc = __builtin_amdgcn_mfma_f32_32x32x16_bf16(afr[1], TRCAT(xv[2], xv[3]), acc, 0, 0, 0);
              acc = __builtin_amdgcn_mfma_f32_32x32x16_bf16(afr[2], TRCAT(xv[4], xv[5]), acc, 0, 0, 0);
              acc = __builtin_amdgcn_mfma_f32_32x32x16_bf16(afr[3], TRCAT(xv[6], xv[7]), acc, 0, 0, 0);
              tr_read8<64 * SSD_RS_X, 68 * SSD_RS_X, 80 * SSD_RS_X, 84 * SSD_RS_X, 96 * SSD_RS_X, 100 * SSD_RS_X, 112 * SSD_RS_X, 116 * SSD_RS_X>(xb, xv);
              acc = __builtin_amdgcn_mfma_f32_32x32x16_bf16(afr[4], TRCAT(xv[0], xv[1]), acc, 0, 0, 0);
              acc = __builtin_amdgcn_mfma_f32_32x32x16_bf16(afr[5], TRCAT(xv[2], xv[3]), acc, 0, 0, 0);
              acc = __builtin_amdgcn_mfma_f32_32x32x16_bf16(afr[6], TRCAT(xv[4], xv[5]), acc, 0, 0, 0);
              acc = __builtin_amdgcn_mfma_f32_32x32x16_bf16(afr[7], TRCAT(xv[6], xv[7]), acc, 0, 0, 0); }
            bf16* dst = Sbuf + (((size_t)bc * SSD_HEADS + 6 * g + hh) * 64 + 32 * pt + r) * 128 + 32 * nt + 4 * h;
#pragma unroll
            for (int q4 = 0; q4 < 4; ++q4) *(uint2*)(dst + 8 * q4) = make_uint2(pk2(acc[4 * q4], acc[4 * q4 + 1]), pk2(acc[4 * q4 + 2], acc[4 * q4 + 3]));
        }
    }
}

__device__ __forceinline__ void ph_ssd_scan(const bf16* __restrict__ Sbuf, const float* __restrict__ cdec, bf16* __restrict__ Hin, float* __restrict__ out, int rank, int nranks) {
    for (int idx = rank * NTHR + threadIdx.x; idx < BATCH * SSD_HEADS * 64 * 16; idx += nranks * NTHR) {
        const int n8 = idx & 15, p = (idx >> 4) & 63, hb = idx >> 10, hd = hb % SSD_HEADS, b = hb / SSD_HEADS;
        float st[8];
#pragma unroll
        for (int j = 0; j < 8; ++j) st[j] = 0.f;
#pragma unroll 8
        for (int c = 0; c < 64; ++c) {
            const size_t base = ((((size_t)(b * 64 + c)) * SSD_HEADS + hd) * 64 + p) * 128 + n8 * 8;
            v4u o; o.x = pk2(st[0], st[1]); o.y = pk2(st[2], st[3]); o.z = pk2(st[4], st[5]); o.w = pk2(st[6], st[7]);
            *(v4u*)(Hin + base) = o;
            float s[8]; unpack8(*(const v4u*)(Sbuf + base), s);
            const float a = cdec[(size_t)(b * 64 + c) * SSD_HEADS + hd];
#pragma unroll
            for (int j = 0; j < 8; ++j) st[j] = a * st[j] + s[j];
        }
        store8f(out + OUT_PS + (((size_t)b * SSD_HEADS + hd) * 64 + p) * 128 + n8 * 8, st);
    }
}

__device__ __forceinline__ void ph_ssd_out(LAS unsigned char* ldsb, const bf16* __restrict__ xbc_b, const bf16* __restrict__ projb, const float* __restrict__ dtv,
                                           const float* __restrict__ a_log, const float* __restrict__ d_skip, const float* __restrict__ norm_g,
                                           const bf16* __restrict__ Hin, bf16* __restrict__ A1) {
    const int tid = threadIdx.x, w = __builtin_amdgcn_readfirstlane(tid >> 6), lane = tid & 63;
    const int r = lane & 31, h = lane >> 5, blk = (lane >> 4) & 1, q = (lane & 15) >> 2, pp = lane & 3;
    const int lt = w & 3, hs = w >> 2;
    for (int unit = blockIdx.x; unit < BATCH * 64 * SSD_GROUPS; unit += gridDim.x) {
        const int g = unit & 3, bc = unit >> 2;
        const int t0 = bc * 128;
        __syncthreads();
        ssd_chunk_acs(ldsb, dtv, a_log, t0, g, nullptr);
#pragma unroll
        for (int it_ = 0; it_ < 4; ++it_) { const int idx = tid + it_ * NTHR; const int row = idx >> 4, ch = idx & 15;
            const v4u v = *(const v4u*)(xbc_b + (size_t)(t0 + row) * CONV_DIM + 1536 + 128 * g + ch * 8);
            *(LAS v4u*)(ldsb + SSD_L_BM + row * SSD_RS_B + ch * 16) = v; }
#pragma unroll
        for (int it_ = 0; it_ < 12; ++it_) { const int idx = tid + it_ * NTHR; const int hh = idx >> 10, rem = idx & 1023, row = rem >> 3, ch = rem & 7;
            const v4u v = *(const v4u*)(xbc_b + (size_t)(t0 + row) * CONV_DIM + (6 * g + hh) * 64 + ch * 8);
            *(LAS v4u*)(ldsb + SSD_L_X + hh * SSD_XIMG + row * SSD_RS_X + ch * 16) = v; }
        __syncthreads();
        const bf16* cp = xbc_b + (size_t)(t0 + 32 * lt + r) * CONV_DIM + 2048 + 128 * g + 8 * h;
        s16x8 cfr[8];
#pragma unroll
        for (int ks = 0; ks < 8; ++ks) cfr[ks] = *(const s16x8*)(cp + 16 * ks);
        const int lcol = 32 * lt + r;
        const LAS float* acsb = (const LAS float*)(ldsb + SSD_L_ACS) + 3 * hs * 128; const LAS float* dtsb = (const LAS float*)(ldsb + SSD_L_DTS) + 3 * hs * 128;
        const unsigned xb0 = lds_addr(ldsb + SSD_L_X + 3 * hs * SSD_XIMG) + (4 * h + q) * SSD_RS_X + (16 * blk + 4 * pp) * 2;
        unsigned ypk[3][16];
#pragma unroll
        for (int h3 = 0; h3 < 3; ++h3) {
            const LAS float* acs = acsb + h3 * 128; const LAS float* dts = dtsb + h3 * 128;
            const float myacs = acs[lcol];
            const float Dh = d_skip[6 * g + 3 * hs + h3];
            f32x16 y0, y1;
#pragma unroll
            for (int i = 0; i < 16; ++i) { y0[i] = 0.f; y1[i] = 0.f; }
            { const bf16* hp = Hin + (((size_t)bc * SSD_HEADS + 6 * g + 3 * hs + h3) * 64 + r) * 128 + 8 * h;
#pragma unroll
              for (int kh = 0; kh < 2; ++kh) {
                  s16x8 hf0[4], hf1[4];
#pragma unroll
                  for (int ks = 0; ks < 4; ++ks) { hf0[ks] = *(const s16x8*)(hp + 16 * (4 * kh + ks)); hf1[ks] = *(const s16x8*)(hp + 32 * 128 + 16 * (4 * kh + ks)); }
#pragma unroll
                  for (int ks = 0; ks < 4; ++ks) { y0 = __builtin_amdgcn_mfma_f32_32x32x16_bf16(cfr[4 * kh + ks], hf0[ks], y0, 0, 0, 0); y1 = __builtin_amdgcn_mfma_f32_32x32x16_bf16(cfr[4 * kh + ks], hf1[ks], y1, 0, 0, 0); }
                  __builtin_amdgcn_sched_barrier(0);
              } }
#pragma unroll
            for (int q4 = 0; q4 < 4; ++q4) {
                const f32x4v a4 = *(const LAS f32x4v*)(acs + 32 * lt + 8 * q4 + 4 * h);
                const float e0 = __expf(a4[0]), e1 = __expf(a4[1]), e2 = __expf(a4[2]), e3 = __expf(a4[3]);
                y0[4 * q4] *= e0; y0[4 * q4 + 1] *= e1; y0[4 * q4 + 2] *= e2; y0[4 * q4 + 3] *= e3;
                y1[4 * q4] *= e0; y1[4 * q4 + 1] *= e1; y1[4 * q4 + 2] *= e2; y1[4 * q4 + 3] *= e3;
            }
            __builtin_amdgcn_sched_barrier(0);
            for (int st = 0; st <= lt; ++st) {
                f32x16 cb;
#pragma unroll
                for (int i = 0; i < 16; ++i) cb[i] = 0.f;
#pragma unroll
                for (int ks = 0; ks < 8; ++ks) {
                    const s16x8 bfrag = *(const LAS s16x8*)(ldsb + SSD_L_BM + (32 * st + r) * SSD_RS_B + (16 * ks + 8 * h) * 2);
                    cb = __builtin_amdgcn_mfma_f32_32x32x16_bf16(bfrag, cfr[ks], cb, 0, 0, 0);
                }
                __builtin_amdgcn_sched_barrier(0);
                const unsigned xb = xb0 + h3 * SSD_XIMG + st * 32 * SSD_RS_X;
                s16x4 xv[8];
                tr_read8<0, 8 * SSD_RS_X, 64, 8 * SSD_RS_X + 64, 16 * SSD_RS_X, 24 * SSD_RS_X, 16 * SSD_RS_X + 64, 24 * SSD_RS_X + 64>(xb, xv);
#pragma unroll
                for (int kk = 0; kk < 2; ++kk) {
                    const int s0 = 32 * st + 16 * kk + 4 * h;
                    const f32x4v as0 = *(const LAS f32x4v*)(acs + s0), as1 = *(const LAS f32x4v*)(acs + s0 + 8);
                    const f32x4v ds0 = *(const LAS f32x4v*)(dts + s0), ds1 = *(const LAS f32x4v*)(dts + s0 + 8);
                    float wv[8];
#pragma unroll
                    for (int j = 0; j < 8; ++j) {
                        const int s = s0 + 8 * (j >> 2) + (j & 3);
                        const float asj = (j < 4) ? as0[j & 3] : as1[j & 3], dsj = (j < 4) ? ds0[j & 3] : ds1[j & 3];
                        float v = cb[8 * kk + j] * __expf(myacs - asj) * dsj;
                        v = (s <= lcol) ? v : 0.f;
                        v = (s == lcol) ? v + Dh : v;
                        wv[j] = v;
                    }
                    s16x8 afr;
                    { v4u o; o.x = pk2(wv[0], wv[1]); o.y = pk2(wv[2], wv[3]); o.z = pk2(wv[4], wv[5]); o.w = pk2(wv[6], wv[7]); afr = __builtin_bit_cast(s16x8, o); }
                    const s16x8 b0 = kk == 0 ? TRCAT(xv[0], xv[1]) : TRCAT(xv[4], xv[5]);
                    const s16x8 b1 = kk == 0 ? TRCAT(xv[2], xv[3]) : TRCAT(xv[6], xv[7]);
                    y0 = __builtin_amdgcn_mfma_f32_32x32x16_bf16(afr, b0, y0, 0, 0, 0);
                    y1 = __builtin_amdgcn_mfma_f32_32x32x16_bf16(afr, b1, y1, 0, 0, 0);
                    __builtin_amdgcn_sched_barrier(0);
                }
            }
#pragma unroll
            for (int i = 0; i < 8; ++i) { ypk[h3][i] = pk2(y0[2 * i], y0[2 * i + 1]); ypk[h3][8 + i] = pk2(y1[2 * i], y1[2 * i + 1]); }
            __builtin_amdgcn_sched_barrier(0);
        }
        __syncthreads();
        {
            LAS unsigned short* yst = (LAS unsigned short*)(ldsb + SSD_L_X);
#pragma unroll
            for (int h3 = 0; h3 < 3; ++h3)
#pragma unroll
                for (int ptile = 0; ptile < 2; ++ptile)
#pragma unroll
                    for (int i = 0; i < 8; ++i) {
                        const int reg = 2 * i;
                        const int l0 = 32 * lt + (reg & 3) + 8 * (reg >> 2) + 4 * h;
                        const int col = (3 * hs + h3) * 64 + 32 * ptile + r;
                        const unsigned v = ypk[h3][8 * ptile + i];
                        yst[l0 * (SSD_RS_Y / 2) + col] = (unsigned short)(v & 0xffffu);
                        yst[(l0 + 1) * (SSD_RS_Y / 2) + col] = (unsigned short)(v >> 16);
                    }
        }
        __syncthreads();
#pragma unroll
        for (int pass = 0; pass < 4; ++pass) {
            const int l = 4 * (pass * 8 + w) + (lane >> 4), i16 = lane & 15;
            float gv[3][8]; float ss = 0.f;
#pragma unroll
            for (int k = 0; k < 3; ++k) {
                const int col0 = 24 * i16 + 8 * k;
                float yv[8], zv[8];
                unpack8(*(const LAS v4u*)(ldsb + SSD_L_X + l * SSD_RS_Y + col0 * 2), yv);
                unpack8(*(const v4u*)(projb + (size_t)(t0 + l) * NB_LD + g * 384 + col0), zv);
#pragma unroll
                for (int j = 0; j < 8; ++j) { const float gg = yv[j] * silu_f(zv[j]); gv[k][j] = gg; ss += gg * gg; }
            }
            ss += __shfl_xor(ss, 1); ss += __shfl_xor(ss, 2); ss += __shfl_xor(ss, 4); ss += __shfl_xor(ss, 8);
            const float rstd = rsqrtf(ss * (1.0f / 384.0f) + LN_EPS);
#pragma unroll
            for (int k = 0; k < 3; ++k) {
                const int col0 = g * 384 + 24 * i16 + 8 * k;
                const float4 g0 = *(const float4*)(norm_g + col0), g1 = *(const float4*)(norm_g + col0 + 4);
                v4u o; o.x = pk2(gv[k][0] * rstd * g0.x, gv[k][1] * rstd * g0.y); o.y = pk2(gv[k][2] * rstd * g0.z, gv[k][3] * rstd * g0.w);
                o.z = pk2(gv[k][4] * rstd * g1.x, gv[k][5] * rstd * g1.y); o.w = pk2(gv[k][6] * rstd * g1.z, gv[k][7] * rstd * g1.w);
                *(v4u*)(A1 + (size_t)(t0 + l) * MIX_WIDTH + col0) = o;
            }
        }
    }
}

#define ATT_RS_V 144
#define ATT_VIMG (256 * ATT_RS_V)
#define ATT_PVT(KT) { \
        s16x4 vv_[8]; \
        tr_read8<(32 * KT) * ATT_RS_V, (32 * KT + 8) * ATT_RS_V, (32 * KT) * ATT_RS_V + 64, (32 * KT + 8) * ATT_RS_V + 64, \
                 (32 * KT + 16) * ATT_RS_V, (32 * KT + 24) * ATT_RS_V, (32 * KT + 16) * ATT_RS_V + 64, (32 * KT + 24) * ATT_RS_V + 64>(vbase, vv_); \
        _Pragma("unroll") for (int s2_ = 0; s2_ < 2; ++s2_) { \
            v4u o_; o_.x = pk2(s[KT][8 * s2_ + 0], s[KT][8 * s2_ + 1]); o_.y = pk2(s[KT][8 * s2_ + 2], s[KT][8 * s2_ + 3]); \
            o_.z = pk2(s[KT][8 * s2_ + 4], s[KT][8 * s2_ + 5]); o_.w = pk2(s[KT][8 * s2_ + 6], s[KT][8 * s2_ + 7]); \
            const s16x8 pf_ = __builtin_bit_cast(s16x8, o_); \
            const s16x8 a0_ = s2_ == 0 ? TRCAT(vv_[0], vv_[1]) : TRCAT(vv_[4], vv_[5]); \
            const s16x8 a1_ = s2_ == 0 ? TRCAT(vv_[2], vv_[3]) : TRCAT(vv_[6], vv_[7]); \
            o0 = __builtin_amdgcn_mfma_f32_32x32x16_bf16(a0_, pf_, o0, 0, 0, 0); \
            o1 = __builtin_amdgcn_mfma_f32_32x32x16_bf16(a1_, pf_, o1, 0, 0, 0); } }
__device__ __forceinline__ void ph_attn_prompt(LAS unsigned char* ldsb, const bf16* __restrict__ qrot_b, const bf16* __restrict__ krot_b, const bf16* __restrict__ projb,
                                               bf16* __restrict__ obuf, float* __restrict__ lsebuf) {
    const int tid = threadIdx.x, w = __builtin_amdgcn_readfirstlane(tid >> 6), lane = tid & 63;
    const int r = lane & 31, h = lane >> 5, blk = (lane >> 4) & 1, q = (lane & 15) >> 2, pp = lane & 3;
    const int qt = w & 3, hsel = w >> 2;
    for (int unit = blockIdx.x; unit < 3 * 512; unit += gridDim.x) {
        const int pat = unit >> 9, rem = unit & 511, hp = rem & 3, rem2 = rem >> 2, b = rem2 >> 6, bk = rem2 & 63;
        const int dsh = 2 * pat, nper = 64 >> dsh, res = bk >> (6 - dsh), nb = bk & (nper - 1);
        const int head = 2 * hp + hsel;
        __syncthreads();
#pragma unroll
        for (int it_ = 0; it_ < 8; ++it_) { const int idx = (tid & 255) + it_ * 256;
            const int row = idx >> 3, ch = idx & 7, js = 128 * nb - 128 + row;
            v4u v; v.x = 0u; v.y = 0u; v.z = 0u; v.w = 0u;
            if (js >= 0) v = *(const v4u*)(projb + (size_t)(b * SEQ + (js << dsh) + res) * NB_LD + NB_V + head * 64 + ch * 8);
            *(LAS v4u*)(ldsb + hsel * ATT_VIMG + row * ATT_RS_V + ch * 16) = v;
        }
        const int tq = b * SEQ + ((128 * nb + 32 * qt + r) << dsh) + res;
        s16x8 qf[4];
#pragma unroll
        for (int ks = 0; ks < 4; ++ks) qf[ks] = *(const s16x8*)(qrot_b + (size_t)tq * ATT_WIDTH + head * 64 + 16 * ks + 8 * h);
        f32x16 s[5];
#pragma unroll
        for (int kt = 0; kt < 5; ++kt) {
            int js = 128 * nb + 32 * qt - 128 + 32 * kt + r; js = js < 0 ? 0 : js;
            const bf16* kp = krot_b + (size_t)(b * SEQ + (js << dsh) + res) * ATT_WIDTH + head * 64 + 8 * h;
#pragma unroll
            for (int i = 0; i < 16; ++i) s[kt][i] = 0.f;
#pragma unroll
            for (int ks = 0; ks < 4; ++ks) s[kt] = __builtin_amdgcn_mfma_f32_32x32x16_bf16(*(const s16x8*)(kp + 16 * ks), qf[ks], s[kt], 0, 0, 0);
        }
        float m = -INFINITY;
#pragma unroll
        for (int kt = 0; kt < 5; ++kt) {
            const bool tile_ok = (nb > 0) || (qt + kt >= 4);
#pragma unroll
            for (int reg = 0; reg < 16; ++reg) {
                const int c = (reg & 3) + 8 * (reg >> 2) + 4 * h;
                const bool ok = tile_ok && (kt == 0 ? (c >= r) : (kt == 4 ? (c <= r) : true));
                const float v = ok ? s[kt][reg] * 0.125f : -INFINITY;
                s[kt][reg] = v; m = fmaxf(m, v);
            }
        }
        m = fmaxf(m, __shfl_xor(m, 32));
        float l = 0.f;
#pragma unroll
        for (int kt = 0; kt < 5; ++kt)
#pragma unroll
            for (int reg = 0; reg < 16; ++reg) { const float p = __expf(s[kt][reg] - m); s[kt][reg] = p; l += p; }
        l += __shfl_xor(l, 32);
        __syncthreads();
        f32x16 o0, o1;
#pragma unroll
        for (int i = 0; i < 16; ++i) { o0[i] = 0.f; o1[i] = 0.f; }
        const unsigned vbase = lds_addr(ldsb + hsel * ATT_VIMG) + (32 * qt + 4 * h + q) * ATT_RS_V + (16 * blk + 4 * pp) * 2;
        ATT_PVT(0) ATT_PVT(1) ATT_PVT(2) ATT_PVT(3) ATT_PVT(4)
        const float inv = 1.0f / l;
        bf16* op = obuf + ((size_t)pat * T_PROMPT + tq) * ATT_WIDTH + head * 64 + 4 * h;
#pragma unroll
        for (int q4 = 0; q4 < 4; ++q4) {
            *(uint2*)(op + 8 * q4) = make_uint2(pk2(o0[4 * q4] * inv, o0[4 * q4 + 1] * inv), pk2(o0[4 * q4 + 2] * inv, o0[4 * q4 + 3] * inv));
            *(uint2*)(op + 32 + 8 * q4) = make_uint2(pk2(o1[4 * q4] * inv, o1[4 * q4 + 1] * inv), pk2(o1[4 * q4 + 2] * inv, o1[4 * q4 + 3] * inv));
        }
        if (h == 0) lsebuf[((size_t)pat * T_PROMPT + tq) * 8 + head] = m + __logf(l);
    }
}
__device__ __forceinline__ void ph_attn_combine(const bf16* __restrict__ obuf, const float* __restrict__ lsebuf, bf16* __restrict__ A1) {
    const int lane = threadIdx.x & 63;
    for (int t = blockIdx.x * NWAVE + (threadIdx.x >> 6); t < T_PROMPT; t += gridDim.x * NWAVE) {
        const int hd = lane >> 3;
        const float l0 = lsebuf[((size_t)0 * T_PROMPT + t) * 8 + hd], l1 = lsebuf[((size_t)1 * T_PROMPT + t) * 8 + hd], l2 = lsebuf[((size_t)2 * T_PROMPT + t) * 8 + hd];
        const float mx = fmaxf(l0, fmaxf(l1, l2));
        const float e0 = __expf(l0 - mx), e1 = __expf(l1 - mx), e2 = __expf(l2 - mx);
        const float inv = 1.0f / (e0 + e1 + e2);
        float a[8], b[8], c[8];
        unpack8(*(const v4u*)(obuf + ((size_t)0 * T_PROMPT + t) * ATT_WIDTH + lane * 8), a);
        unpack8(*(const v4u*)(obuf + ((size_t)1 * T_PROMPT + t) * ATT_WIDTH + lane * 8), b);
        unpack8(*(const v4u*)(obuf + ((size_t)2 * T_PROMPT + t) * ATT_WIDTH + lane * 8), c);
        float o[8];
#pragma unroll
        for (int j = 0; j < 8; ++j) o[j] = (e0 * a[j] + e1 * b[j] + e2 * c[j]) * inv;
        v4u w; w.x = pk2(o[0], o[1]); w.y = pk2(o[2], o[3]); w.z = pk2(o[4], o[5]); w.w = pk2(o[6], o[7]);
        *(v4u*)(A1 + (size_t)t * MIX_WIDTH + SSD_WIDTH + lane * 8) = w;
    }
}

#define RT_RS 272
#define RT_KIMG (128 * RT_RS)
#define RT_LUT (2 * RT_KIMG)
constexpr unsigned char RT_CANDS[64] = {0, 1, 2, 3, 4, 5, 6, 7, 8, 9, 10, 11, 12, 13, 14, 15, 16, 17, 18, 19, 20, 21, 22, 23, 32, 33, 34, 35, 36, 48, 49, 50, 51, 64, 65, 66, 80, 81, 96, 97,
                                        112, 113, 128, 144, 160, 176, 192, 208, 224, 240, 0, 0, 0, 0, 0, 0, 0, 0, 0, 0, 0, 0, 0, 0};
__device__ __forceinline__ unsigned rt_mono(float f) { const unsigned u = __builtin_bit_cast(unsigned, f); return u ^ ((unsigned)((int)u >> 31) | 0x80000000u); }
__device__ __forceinline__ float rt_unmono(unsigned m) { const unsigned u = (m & 0x80000000u) ? (m ^ 0x80000000u) : ~m; return __builtin_bit_cast(float, u); }
#define RT_CE_DESC(a, b) { const unsigned x_ = (a), y_ = (b); (a) = x_ > y_ ? x_ : y_; (b) = x_ > y_ ? y_ : x_; }
#define RT_CE_ASC(a, b) { const unsigned x_ = (a), y_ = (b); (a) = x_ > y_ ? y_ : x_; (b) = x_ > y_ ? x_ : y_; }
__device__ __forceinline__ void rt_sort16(unsigned (&v)[16]) {
#pragma unroll
    for (int k = 2; k <= 16; k <<= 1)
#pragma unroll
        for (int j = k >> 1; j > 0; j >>= 1)
#pragma unroll
            for (int i = 0; i < 16; ++i) { const int l = i ^ j; if (l > i) { if ((i & k) == 0) RT_CE_DESC(v[i], v[l]) else RT_CE_ASC(v[i], v[l]) } }
}
__device__ __forceinline__ void rt_merge16(unsigned (&v)[16]) {
#pragma unroll
    for (int j = 8; j > 0; j >>= 1)
#pragma unroll
        for (int i = 0; i < 16; ++i) { const int l = i ^ j; if (l > i) RT_CE_DESC(v[i], v[l]) }
}
__device__ __forceinline__ void rt_top16(unsigned (&a)[16], const unsigned (&b)[16]) {
#pragma unroll
    for (int i = 0; i < 16; ++i) a[i] = a[i] > b[15 - i] ? a[i] : b[15 - i];
    rt_merge16(a);
}
__device__ __forceinline__ void rt_top16_partner(unsigned (&a)[16]) {
    unsigned b[16];
#pragma unroll
    for (int i = 0; i < 16; ++i) b[i] = (unsigned)__shfl_xor((int)a[i], 32);
    rt_top16(a, b);
}
__device__ __forceinline__ void rt_scores_top16(LAS unsigned char* kimg, const bf16* __restrict__ qp, int r, int h, unsigned (&k0)[16]) {
    f32x16 acc[4];
#pragma unroll
    for (int kt = 0; kt < 4; ++kt)
#pragma unroll
        for (int i = 0; i < 16; ++i) acc[kt][i] = 0.f;
#pragma unroll
    for (int ks = 0; ks < 8; ++ks) {
        const s16x8 qf = *(const s16x8*)(qp + 16 * ks);
#pragma unroll
        for (int kt = 0; kt < 4; ++kt) {
            const s16x8 kf = *(const LAS s16x8*)(kimg + (32 * kt + r) * RT_RS + (16 * ks + 8 * h) * 2);
            acc[kt] = __builtin_amdgcn_mfma_f32_32x32x16_bf16(kf, qf, acc[kt], 0, 0, 0);
        }
    }
    unsigned k1[16], k2[16], k3[16];
#pragma unroll
    for (int reg = 0; reg < 16; ++reg) {
        const unsigned ki = (unsigned)((reg & 3) + 8 * (reg >> 2) + 4 * h);
        k0[reg] = (rt_mono(acc[0][reg]) & 0xFFFFFF80u) | ki;
        k1[reg] = (rt_mono(acc[1][reg]) & 0xFFFFFF80u) | (ki + 32u);
        k2[reg] = (rt_mono(acc[2][reg]) & 0xFFFFFF80u) | (ki + 64u);
        k3[reg] = (rt_mono(acc[3][reg]) & 0xFFFFFF80u) | (ki + 96u);
    }
    rt_sort16(k0); rt_sort16(k1); rt_sort16(k2); rt_sort16(k3);
    rt_top16(k0, k1); rt_top16(k2, k3); rt_top16(k0, k2);
    rt_top16_partner(k0);
}
__device__ __forceinline__ void ph_peer_route2(LAS unsigned char* ldsb, const bf16* __restrict__ qhb, const float* __restrict__ keys1, const float* __restrict__ keys2,
                                               int* __restrict__ eidx, float* __restrict__ gate) {
    const int tid = threadIdx.x, w = __builtin_amdgcn_readfirstlane(tid >> 6), lane = tid & 63, r = lane & 31, h = lane >> 5;
    __syncthreads();
    for (int idx = tid; idx < 2 * 128 * 16; idx += NTHR) {
        const int tb = idx >> 11, rem = idx & 2047, row = rem >> 4, ch = rem & 15;
        const float* sp = (tb ? keys2 : keys1) + row * 128 + ch * 8;
        const float4 a = *(const float4*)sp, b = *(const float4*)(sp + 4);
        v4u o; o.x = pk2(a.x, a.y); o.y = pk2(a.z, a.w); o.z = pk2(b.x, b.y); o.w = pk2(b.z, b.w);
        *(LAS v4u*)(ldsb + tb * RT_KIMG + row * RT_RS + ch * 16) = o;
    }
    __syncthreads();
    LAS unsigned* lut = (LAS unsigned*)(ldsb + RT_LUT) + w * 512;
    for (int unit = blockIdx.x * NWAVE + w; unit < (T_ALL / 32) * 8; unit += gridDim.x * NWAVE) {
        const int tt = unit >> 3, hd = unit & 7;
        const int tok = 32 * tt + r;
        const bf16* qp = qhb + (size_t)tok * 2048 + hd * 256 + 8 * h;
        unsigned ka[16], kb[16];
        rt_scores_top16(ldsb, qp, r, h, ka);
        rt_scores_top16(ldsb + RT_KIMG, qp + 128, r, h, kb);
        float v1[16], v2[16];
#pragma unroll
        for (int i = 0; i < 16; ++i) { v1[i] = rt_unmono(ka[i] & 0xFFFFFF80u); v2[i] = rt_unmono(kb[i] & 0xFFFFFF80u); }
#pragma unroll
        for (int wd = 0; wd < 4; ++wd) {
            lut[wd * 64 + lane] = (ka[4 * wd] & 0x7Fu) | ((ka[4 * wd + 1] & 0x7Fu) << 8) | ((ka[4 * wd + 2] & 0x7Fu) << 16) | ((ka[4 * wd + 3] & 0x7Fu) << 24);
            lut[(4 + wd) * 64 + lane] = (kb[4 * wd] & 0x7Fu) | ((kb[4 * wd + 1] & 0x7Fu) << 8) | ((kb[4 * wd + 2] & 0x7Fu) << 16) | ((kb[4 * wd + 3] & 0x7Fu) << 24);
        }
        unsigned c0[16], c1[16];
        c0[0] = (rt_mono(h ? (v1[0] + v2[1]) : (v1[0] + v2[0])) & 0xFFFFFF00u) | (h ? 1u : 0u);
        c0[1] = (rt_mono(h ? (v1[0] + v2[3]) : (v1[0] + v2[2])) & 0xFFFFFF00u) | (h ? 3u : 2u);
        c0[2] = (rt_mono(h ? (v1[0] + v2[5]) : (v1[0] + v2[4])) & 0xFFFFFF00u) | (h ? 5u : 4u);
        c0[3] = (rt_mono(h ? (v1[0] + v2[7]) : (v1[0] + v2[6])) & 0xFFFFFF00u) | (h ? 7u : 6u);
        c0[4] = (rt_mono(h ? (v1[0] + v2[9]) : (v1[0] + v2[8])) & 0xFFFFFF00u) | (h ? 9u : 8u);
        c0[5] = (rt_mono(h ? (v1[0] + v2[11]) : (v1[0] + v2[10])) & 0xFFFFFF00u) | (h ? 11u : 10u);
        c0[6] = (rt_mono(h ? (v1[0] + v2[13]) : (v1[0] + v2[12])) & 0xFFFFFF00u) | (h ? 13u : 12u);
        c0[7] = (rt_mono(h ? (v1[0] + v2[15]) : (v1[0] + v2[14])) & 0xFFFFFF00u) | (h ? 15u : 14u);
        c0[8] = (rt_mono(h ? (v1[1] + v2[1]) : (v1[1] + v2[0])) & 0xFFFFFF00u) | (h ? 17u : 16u);
        c0[9] = (rt_mono(h ? (v1[1] + v2[3]) : (v1[1] + v2[2])) & 0xFFFFFF00u) | (h ? 19u : 18u);
        c0[10] = (rt_mono(h ? (v1[1] + v2[5]) : (v1[1] + v2[4])) & 0xFFFFFF00u) | (h ? 21u : 20u);
        c0[11] = (rt_mono(h ? (v1[1] + v2[7]) : (v1[1] + v2[6])) & 0xFFFFFF00u) | (h ? 23u : 22u);
        c0[12] = (rt_mono(h ? (v1[2] + v2[1]) : (v1[2] + v2[0])) & 0xFFFFFF00u) | (h ? 33u : 32u);
        c0[13] = (rt_mono(h ? (v1[2] + v2[3]) : (v1[2] + v2[2])) & 0xFFFFFF00u) | (h ? 35u : 34u);
        c0[14] = (rt_mono(h ? (v1[3] + v2[0]) : (v1[2] + v2[4])) & 0xFFFFFF00u) | (h ? 48u : 36u);
        c0[15] = (rt_mono(h ? (v1[3] + v2[2]) : (v1[3] + v2[1])) & 0xFFFFFF00u) | (h ? 50u : 49u);
        c1[0] = (rt_mono(h ? (v1[4] + v2[0]) : (v1[3] + v2[3])) & 0xFFFFFF00u) | (h ? 64u : 51u);
        c1[1] = (rt_mono(h ? (v1[4] + v2[2]) : (v1[4] + v2[1])) & 0xFFFFFF00u) | (h ? 66u : 65u);
        c1[2] = (rt_mono(h ? (v1[5] + v2[1]) : (v1[5] + v2[0])) & 0xFFFFFF00u) | (h ? 81u : 80u);
        c1[3] = (rt_mono(h ? (v1[6] + v2[1]) : (v1[6] + v2[0])) & 0xFFFFFF00u) | (h ? 97u : 96u);
        c1[4] = (rt_mono(h ? (v1[7] + v2[1]) : (v1[7] + v2[0])) & 0xFFFFFF00u) | (h ? 113u : 112u);
        c1[5] = (rt_mono(h ? (v1[9] + v2[0]) : (v1[8] + v2[0])) & 0xFFFFFF00u) | (h ? 144u : 128u);
        c1[6] = (rt_mono(h ? (v1[11] + v2[0]) : (v1[10] + v2[0])) & 0xFFFFFF00u) | (h ? 176u : 160u);
        c1[7] = (rt_mono(h ? (v1[13] + v2[0]) : (v1[12] + v2[0])) & 0xFFFFFF00u) | (h ? 208u : 192u);
        c1[8] = (rt_mono(h ? (v1[15] + v2[0]) : (v1[14] + v2[0])) & 0xFFFFFF00u) | (h ? 240u : 224u);
        c1[9] = 0u;
        c1[10] = 0u;
        c1[11] = 0u;
        c1[12] = 0u;
        c1[13] = 0u;
        c1[14] = 0u;
        c1[15] = 0u;
        rt_sort16(c0); rt_sort16(c1); rt_top16(c0, c1); rt_top16_partner(c0);
        float e[16]; float sum = 0.f;
        const float mx = rt_unmono(c0[0] & 0xFFFFFF00u);
#pragma unroll
        for (int k = 0; k < 16; ++k) { e[k] = __expf(rt_unmono(c0[k] & 0xFFFFFF00u) - mx); sum += e[k]; }
        const float inv = 1.0f / sum;
        asm volatile("s_waitcnt lgkmcnt(0)" ::: "memory");
        int ex[8]; float gv[8];
#pragma unroll
        for (int k = 0; k < 8; ++k) {
            const unsigned hm = (unsigned)(-h);
            const unsigned ck = (c0[k] & ~hm) | (c0[8 + k] & hm);
            const float ek = __builtin_bit_cast(float, (__builtin_bit_cast(unsigned, e[k]) & ~hm) | (__builtin_bit_cast(unsigned, e[8 + k]) & hm));
            const unsigned ci = (ck >> 4) & 15u, cj = ck & 15u;
            const unsigned w1 = lut[(ci >> 2) * 64 + lane], w2 = lut[(4 + (cj >> 2)) * 64 + lane];
            const unsigned i1 = (w1 >> (8 * (ci & 3))) & 0x7Fu, i2 = (w2 >> (8 * (cj & 3))) & 0x7Fu;
            ex[k] = (int)(i1 * PEER_NKEYS + i2); gv[k] = ek * inv;
        }
        int* ep = eidx + (size_t)tok * 128 + hd * 16 + 8 * h; float* gp = gate + (size_t)tok * 128 + hd * 16 + 8 * h;
        *(int4*)ep = make_int4(ex[0], ex[1], ex[2], ex[3]); *(int4*)(ep + 4) = make_int4(ex[4], ex[5], ex[6], ex[7]);
        *(float4*)gp = make_float4(gv[0], gv[1], gv[2], gv[3]); *(float4*)(gp + 4) = make_float4(gv[4], gv[5], gv[6], gv[7]);
    }
}

struct Params {
    const float* in[23];
    float* out;
    unsigned char* ws;
    unsigned* bar;
};

#define WS_BAR      0ull
#define WS_XALL     (1ull << 20)
#define WS_PROJ     (WS_XALL + (size_t)T_ALL * D_MODEL * 4)
#define WS_XBC      (WS_PROJ + (size_t)T_ALL * PROJ_LD * 4)
#define WS_DT       (WS_XBC + (size_t)T_ALL * CONV_DIM * 4)
#define WS_QROT     (WS_DT + (size_t)T_ALL * SSD_HEADS * 4)
#define WS_KROT     (WS_QROT + (size_t)T_ALL * ATT_WIDTH * 4)
#define WS_YBUF     (WS_KROT + (size_t)T_ALL * ATT_WIDTH * 4)
#define WS_MIX      (WS_YBUF + (size_t)T_ALL * MIX_WIDTH * 4)
#define WS_HBUF     (WS_MIX + (size_t)T_ALL * D_MODEL * 4)
#define WS_QH       (WS_HBUF + (size_t)T_ALL * D_MODEL * 4)
#define WS_EIDX     (WS_QH + (size_t)T_ALL * 2048 * 4)
#define WS_GATE     (WS_EIDX + (size_t)T_ALL * 128 * 4)
#define WS_A0       (WS_GATE + (size_t)T_ALL * 128 * 4)
#define WS_A1       (WS_A0 + (size_t)T_ALL * D_MODEL * 2)
#define WS_A2       (WS_A1 + (size_t)T_ALL * MIX_WIDTH * 2)
#define WS_WTIN     (WS_A2 + (size_t)T_ALL * D_MODEL * 2)
#define WS_WTOUT    (WS_WTIN + (size_t)PROJ_LD * D_MODEL * 2)
#define WS_WTQ      (WS_WTOUT + (size_t)D_MODEL * MIX_WIDTH * 2)
#define WS_PROJB    (WS_WTQ + (size_t)2048 * D_MODEL * 2)
#define WS_DTRAW    (WS_PROJB + (size_t)T_ALL * NB_LD * 2)
#define WS_XBCB     (WS_DTRAW + (size_t)T_ALL * 32 * 4)
#define WS_QROTB    (WS_XBCB + (size_t)T_ALL * CONV_DIM * 2)
#define WS_KROTB    (WS_QROTB + (size_t)T_ALL * ATT_WIDTH * 2)
#define WS_UB       (WS_KROTB + (size_t)T_ALL * ATT_WIDTH * 2)
#define WS_VB       (WS_UB + (size_t)16384 * D_MODEL * 2)
#define WS_USC      (WS_VB + (size_t)16384 * D_MODEL * 2)
#define WS_VSC      (WS_USC + 16384 * 4)
#define WS_SBUF     (WS_VSC + 16384 * 4)
#define WS_HIN      (WS_SBUF + (size_t)BATCH * 64 * SSD_HEADS * 64 * 128 * 2)
#define WS_CDEC     (WS_HIN + (size_t)BATCH * 64 * SSD_HEADS * 64 * 128 * 2)
#define WS_OBUF     (WS_CDEC + (size_t)BATCH * 64 * SSD_HEADS * 4)
#define WS_LSE      (WS_OBUF + (size_t)3 * T_PROMPT * ATT_WIDTH * 2)
#define WS_ROPE     (WS_LSE + (size_t)3 * T_PROMPT * 8 * 4)
#define WS_END      (WS_ROPE + (size_t)SEQ * 64 * 4)

#define LDS_BYTES (160 * 1024)
#define N9_SLICES 13440u

#define KP const __attribute__((address_space(4))) Params* kp = (const __attribute__((address_space(4))) Params*)__builtin_amdgcn_kernarg_segment_ptr(); asm volatile("" : "+s"(kp)); unsigned char* ws = kp->ws; (void)ws;
#define IN(i) (kp->in[i])
#define WSP(T, off) ((T*)(ws + (off)))
__global__ void __launch_bounds__(512, 2) mega_fwd(Params p) {
    extern __shared__ __attribute__((aligned(16))) unsigned char smem[];
    if (threadIdx.x == 0) *(uint4*)smem = make_uint4(0u, 0u, 0u, 0u);
    __syncthreads();
    XcdBarrier bar = xcd_barrier_post(p.bar, (volatile LAS unsigned*)smem);
    float* lds = (float*)(smem + 256);
    LAS unsigned char* ldsb = (LAS unsigned char*)smem + 256;

    { KP ph_prologue(ldsb, IN(0), IN(1), WSP(bf16, WS_A0), IN(6), WSP(bf16, WS_WTIN), WSP(float, WS_ROPE)); }
    xcd_barrier(bar);
    { KP pg8::Gemm g{WSP(bf16, WS_A0), WSP(bf16, WS_WTIN), T_ALL, PROJ_LD, D_MODEL}; pg8::StaticOrder S; S.init(g.M, g.N, (int)gridDim.x, (int)blockIdx.x);
      pg8::EpiProj E{WSP(bf16, WS_PROJB), WSP(float, WS_DTRAW)}; pg8::gemm_phase<pg8::EpiProj, pg8::StaticOrder, false>(ldsb, g, S, E, nullptr); }
    xcd_barrier(bar);
    { KP ph_post_proj_prompt(WSP(bf16, WS_PROJB), WSP(float, WS_DTRAW), IN(7), IN(8), IN(9), WSP(float, WS_ROPE), WSP(bf16, WS_XBCB), WSP(float, WS_DT), WSP(bf16, WS_QROTB), WSP(bf16, WS_KROTB), kp->out); }
    { KP ph_post_proj2(WSP(bf16, WS_PROJB), WSP(float, WS_DTRAW), IN(4), IN(7), IN(8), IN(9), WSP(bf16, WS_XBCB), WSP(float, WS_DT), WSP(bf16, WS_QROTB), WSP(bf16, WS_KROTB), kp->out); }
    xcd_barrier(bar);
    { KP ph_ssd_states(ldsb, WSP(bf16, WS_XBCB), WSP(float, WS_DT), IN(10), WSP(bf16, WS_SBUF), WSP(float, WS_CDEC)); }
    __syncthreads();
    { KP ph_attn_prompt(ldsb, WSP(bf16, WS_QROTB), WSP(bf16, WS_KROTB), WSP(bf16, WS_PROJB), WSP(bf16, WS_OBUF), WSP(float, WS_LSE)); }
    __syncthreads();
    { KP ph_ssd_decode(WSP(bf16, WS_XBCB), WSP(float, WS_DT), IN(10), IN(11), IN(5), WSP(float, WS_YBUF), kp->out); }
    { KP ph_attn_sample3(lds, WSP(bf16, WS_QROTB), WSP(bf16, WS_KROTB), WSP(bf16, WS_PROJB), IN(2), IN(3), WSP(bf16, WS_A1)); }
    xcd_barrier(bar);
    if ((int)gridDim.x > 128) {
        if ((int)blockIdx.x < 96) { KP ph_ssd_scan(WSP(bf16, WS_SBUF), WSP(float, WS_CDEC), WSP(bf16, WS_HIN), kp->out, (int)blockIdx.x, 96); }
        else {
            { KP ph_prologue2(ldsb, IN(13), WSP(bf16, WS_WTOUT), IN(16), WSP(bf16, WS_WTQ), (int)blockIdx.x - 96, (int)gridDim.x - 96); }
            { KP ph_quant_tables(IN(19), IN(20), WSP(unsigned char, WS_UB), WSP(unsigned char, WS_VB), WSP(float, WS_USC), WSP(float, WS_VSC), (int)blockIdx.x - 96, (int)gridDim.x - 96); }
        }
    } else {
        { KP ph_ssd_scan(WSP(bf16, WS_SBUF), WSP(float, WS_CDEC), WSP(bf16, WS_HIN), kp->out, (int)blockIdx.x, (int)gridDim.x); }
        { KP ph_prologue2(ldsb, IN(13), WSP(bf16, WS_WTOUT), IN(16), WSP(bf16, WS_WTQ), (int)blockIdx.x, (int)gridDim.x); }
        { KP ph_quant_tables(IN(19), IN(20), WSP(unsigned char, WS_UB), WSP(unsigned char, WS_VB), WSP(float, WS_USC), WSP(float, WS_VSC), (int)blockIdx.x, (int)gridDim.x); }
    }
    xcd_barrier(bar);
    { KP ph_ssd_out(ldsb, WSP(bf16, WS_XBCB), WSP(bf16, WS_PROJB), WSP(float, WS_DT), IN(10), IN(11), IN(12), WSP(bf16, WS_HIN), WSP(bf16, WS_A1)); }
    { KP ph_attn_combine(WSP(bf16, WS_OBUF), WSP(float, WS_LSE), WSP(bf16, WS_A1)); }
    { KP ph_gate_norm(WSP(bf16, WS_PROJB), IN(12), WSP(float, WS_YBUF), WSP(bf16, WS_A1)); }
    xcd_barrier(bar);
    { KP pg8::Gemm g{WSP(bf16, WS_A1), WSP(bf16, WS_WTOUT), T_ALL, D_MODEL, MIX_WIDTH}; pg8::StaticOrder S; S.init(g.M, g.N, (int)gridDim.x, (int)blockIdx.x);
      pg8::EpiF32 E{WSP(float, WS_MIX), D_MODEL, nullptr}; pg8::gemm_phase<pg8::EpiF32, pg8::StaticOrder, false>(ldsb, g, S, E, nullptr); }
    if (blockIdx.x >= 8 && gridDim.x == 256) { KP cache_copy_slice(IN(2), IN(3), kp->out, N9_SLICES + (blockIdx.x - 8) * 8u + (threadIdx.x >> 6), threadIdx.x & 63u); }
    xcd_barrier(bar);
    { KP ph_ln_res(IN(0), IN(1), WSP(float, WS_MIX), IN(14), IN(15), WSP(float, WS_HBUF), WSP(bf16, WS_A2)); }
    xcd_barrier(bar);
    { KP pg8::Gemm g{WSP(bf16, WS_A2), WSP(bf16, WS_WTQ), T_ALL, 2048, D_MODEL}; pg8::StaticOrder S; S.init(g.M, g.N, (int)gridDim.x, (int)blockIdx.x);
      pg8::EpiBf16Plain E{WSP(bf16, WS_QH), 2048}; pg8::gemm_phase<pg8::EpiBf16Plain, pg8::StaticOrder, false>(ldsb, g, S, E, nullptr); }
    if (blockIdx.x >= 16 && gridDim.x == 256 && threadIdx.x < 256) { KP cache_copy_slice(IN(2), IN(3), kp->out, N9_SLICES + 1984u + (blockIdx.x - 16) * 4u + (threadIdx.x >> 6), threadIdx.x & 63u); }
    xcd_barrier(bar);
    { KP ph_peer_route2(ldsb, WSP(bf16, WS_QH), IN(17), IN(18), WSP(int, WS_EIDX), WSP(float, WS_GATE)); }
    xcd_barrier(bar);
    { KP ph_peer_ffn3(WSP(float, WS_HBUF), WSP(int, WS_EIDX), WSP(float, WS_GATE), WSP(unsigned char, WS_UB), WSP(unsigned char, WS_VB), WSP(float, WS_USC), WSP(float, WS_VSC), IN(21), IN(22), kp->out, IN(2), IN(3), gridDim.x == 256 ? N9_SLICES : 16384u); }
}

extern "C" void kernel_launch(void* const* d_in, const int* in_sizes, int n_in, void* d_out, int out_size, void* d_ws, size_t ws_size, hipStream_t stream) {
    static int grid = 0;
    if (grid == 0) {
        int dev = 0, cus = 0, per_cu = 0;
        if (hipGetDevice(&dev) != hipSuccess || hipDeviceGetAttribute(&cus, hipDeviceAttributeMultiprocessorCount, dev) != hipSuccess) { fprintf(stderr, "kernel_launch: device query failed\n"); grid = -1; return; }
        if (hipFuncSetAttribute((const void*)mega_fwd, hipFuncAttributeMaxDynamicSharedMemorySize, LDS_BYTES) != hipSuccess) { fprintf(stderr, "kernel_launch: hipFuncSetAttribute failed\n"); grid = -1; return; }
        if (hipOccupancyMaxActiveBlocksPerMultiprocessor(&per_cu, (const void*)mega_fwd, NTHR, LDS_BYTES) != hipSuccess || per_cu < 1) { fprintf(stderr, "kernel_launch: occupancy query says %d\n", per_cu); }
        (void)hipGetLastError();
        grid = cus;
        if (ws_size < WS_END) { fprintf(stderr, "kernel_launch: workspace too small\n"); grid = -1; return; }
    }
    if (grid < 0) return;
    (void)hipMemsetAsync((char*)d_ws + WS_BAR, 0, XCD_BAR_WORDS * sizeof(unsigned), stream);
    Params p{};
    for (int i = 0; i < 23; ++i) p.in[i] = (const float*)d_in[i];
    p.out = (float*)d_out; p.ws = (unsigned char*)d_ws; p.bar = (unsigned*)((char*)d_ws + WS_BAR);
    hipLaunchKernelGGL(mega_fwd, dim3(grid), dim3(NTHR), LDS_BYTES, stream, p);
}
```

```cpp
#include <hip/hip_runtime.h>
#include <stdint.h>

#define D_MODEL 1024
#define BATCH 2
#define SEQ 8192
#define DEC_BATCH 128
#define DEC_SEQ 4
#define PAST_LEN 8192
#define HEAD_DIM 64
#define ATT_WIDTH 512
#define ATT_HEADS 8
#define SSD_WIDTH 1536
#define SSD_HEADS 24
#define SSD_GROUPS 4
#define SSD_STATE 128
#define CONV_DIM 2560
#define IN_WIDTH 5656
#define PROJ_LD 5888
#define MIX_WIDTH 2048
#define WBUF 2048
#define PEER_NKEYS 128
#define PEER_HEADS 8
#define PEER_TOPK 16
#define PEER_DKEY 256
#define T_PROMPT (BATCH * SEQ)
#define T_SAMPLE (DEC_BATCH * DEC_SEQ)
#define T_ALL (T_PROMPT + T_SAMPLE)
#define O_Z 0
#define O_XBC 1536
#define O_DT 4096
#define O_Q 4120
#define O_K 4632
#define O_V 5144
#define ALPHA_F 1.189207115002721f
#define LN_EPS 1e-5f

#define OUT_YP 0ull
#define OUT_YS (OUT_YP + 16777216ull)
#define OUT_PK (OUT_YS + 524288ull)
#define OUT_PV (OUT_PK + 2097152ull)
#define OUT_PC (OUT_PV + 2097152ull)
#define OUT_PS (OUT_PC + 15360ull)
#define OUT_SK (OUT_PS + 393216ull)
#define OUT_SV (OUT_SK + 134217728ull)
#define OUT_SC (OUT_SV + 134217728ull)
#define OUT_SS (OUT_SC + 983040ull)

__constant__ double ROPE_INV_REV[32] = {
    1.59154943091895346e-01, 1.19349370211248862e-01, 8.94994016088910133e-02, 6.71150830052272551e-02,
    5.03292121044870353e-02, 3.77415847174197711e-02, 2.83021958306233987e-02, 2.12236527647776604e-02,
    1.59154943091895339e-02, 1.19349370211248862e-02, 8.94994016088910237e-03, 6.71150830052272534e-03,
    5.03292121044870370e-03, 3.77415847174197719e-03, 2.83021958306233987e-03, 2.12236527647776622e-03,
    1.59154943091895356e-03, 1.19349370211248849e-03, 8.94994016088910237e-04, 6.71150830052272599e-04,
    5.03292121044870326e-04, 3.77415847174197741e-04, 2.83021958306233954e-04, 2.12236527647776605e-04,
    1.59154943091895351e-04, 1.19349370211248862e-04, 8.94994016088910182e-05, 6.71150830052272545e-05,
    5.03292121044870354e-05, 3.77415847174197768e-05, 2.83021958306233961e-05, 2.12236527647776592e-05
};

__device__ __forceinline__ float silu_f(float x) { return x * __builtin_amdgcn_rcpf(1.0f + __expf(-x)); }
__device__ __forceinline__ float softplus_f(float x) { return fmaxf(x, 0.f) + log1pf(__expf(-fabsf(x))); }
__device__ __forceinline__ float gelu_f(float x) { return 0.5f * x * (1.0f + erff(x * 0.70710678118654752f)); }
__device__ __forceinline__ float wave_sum(float v) {
#pragma unroll
    for (int o = 32; o > 0; o >>= 1) v += __shfl_xor(v, o);
    return v;
}
__device__ __forceinline__ float wave_max(float v) {
#pragma unroll
    for (int o = 32; o > 0; o >>= 1) v = fmaxf(v, __shfl_xor(v, o));
    return v;
}

#include <cstdio>
#define XB_TMO      128
#define XB_XCNT(j)  (256  + 64 * (j))
#define XB_XSUB(j)  (1280 + 64 * (j))
#define XB_XGEN(j)  (2304 + 64 * (j))
#define XB_TOP      3328
#define XB_TOPGEN   3392
#define XCD_BAR_WORDS 3456
#define XB_SPIN_CAP (1u << 18)
#define LAS __attribute__((address_space(3)))

__device__ __forceinline__ unsigned xb_ld(unsigned* p)              { return __hip_atomic_load(p, __ATOMIC_RELAXED, __HIP_MEMORY_SCOPE_AGENT); }
__device__ __forceinline__ unsigned xb_add(unsigned* p, unsigned v) { return __hip_atomic_fetch_add(p, v, __ATOMIC_RELAXED, __HIP_MEMORY_SCOPE_AGENT); }
__device__ __forceinline__ unsigned xb_xcc_id() { return (unsigned)__builtin_amdgcn_s_getreg((3 << 11) | 20) & 0xFu; }
#define XB_SPIN(cond, bar) do { unsigned _sp = 0; while (cond) { __builtin_amdgcn_s_sleep(1); \
    if ((++_sp & 255u) == 0u) { if (xb_ld(&(bar)[XB_TMO])) break; if (_sp > XB_SPIN_CAP) { atomicAdd(&(bar)[XB_TMO], 1u); break; } } } } while (0)

struct XcdBarrier {
    unsigned* bar; unsigned x;
    volatile LAS unsigned* st;
};

__device__ __forceinline__ XcdBarrier xcd_barrier_post(unsigned* bar, volatile LAS unsigned* st) {
    XcdBarrier b; b.bar = bar; b.x = xb_xcc_id(); b.st = st;
    if (threadIdx.x == 0) (void)xb_add(&bar[XB_XCNT(b.x)], 1u);
    return b;
}
__device__ __forceinline__ void xcd_barrier_complete(unsigned* bar, unsigned x, unsigned& nloc, unsigned& nx) {
    const unsigned G = gridDim.x * gridDim.y * gridDim.z;
    unsigned sum, cnt, mine, sp = 0u;
    for (;;) {
        sum = 0u; cnt = 0u; mine = 0u;
#pragma unroll
        for (unsigned j = 0; j < 16; ++j) { const unsigned c = xb_ld(&bar[XB_XCNT(j)]); sum += c; cnt += (c > 0u) ? 1u : 0u; mine = (j == x) ? c : mine; }
        if (sum == G) break;
        __builtin_amdgcn_s_sleep(1);
        if ((++sp & 255u) == 0u) { if (xb_ld(&bar[XB_TMO])) break; if (sp > XB_SPIN_CAP) { atomicAdd(&bar[XB_TMO], 1u); break; } }
    }
    nloc = mine > 0u ? mine : 1u; nx = cnt > 0u ? cnt : 1u;
}

__device__ __forceinline__ void xcd_barrier(const XcdBarrier& b) {
    asm volatile("s_waitcnt vmcnt(0)" ::: "memory");
    __syncthreads();
    if (threadIdx.x == 0) {
        unsigned* bar = b.bar;
        __builtin_amdgcn_s_waitcnt(0);
        unsigned nloc = b.st[0], nx = b.st[1];
        if (nloc == 0u) { xcd_barrier_complete(bar, b.x, nloc, nx); b.st[0] = nloc; b.st[1] = nx; }
        const unsigned old = xb_add(&bar[XB_XSUB(b.x)], 1u);
        const unsigned gen = old / nloc;
        if (old + 1u == (gen + 1u) * nloc) {
            __builtin_amdgcn_fence(__ATOMIC_RELEASE, "agent");
            asm volatile("s_waitcnt vmcnt(0)" ::: "memory");
            const unsigned og = xb_add(&bar[XB_TOP], 1u);
            const unsigned tg = og / nx;
            if (og + 1u == (tg + 1u) * nx) xb_add(&bar[XB_TOPGEN], 1u);
            else XB_SPIN(xb_ld(&bar[XB_TOPGEN]) == tg, bar);
            __builtin_amdgcn_fence(__ATOMIC_ACQUIRE, "agent");
            xb_add(&bar[XB_XGEN(b.x)], 1u);
            asm volatile("s_waitcnt vmcnt(0)" ::: "memory");
        } else {
            XB_SPIN(xb_ld(&bar[XB_XGEN(b.x)]) == gen, bar);
            __builtin_amdgcn_fence(__ATOMIC_ACQUIRE, "agent");
            asm volatile("s_waitcnt vmcnt(0)" ::: "memory");
        }
    }
    __syncthreads();
}


#define GAS __attribute__((address_space(1)))
typedef unsigned short bf16;
typedef unsigned v4u __attribute__((ext_vector_type(4)));
#define LDS_WAIT() asm volatile("s_waitcnt lgkmcnt(0)" ::: "memory")
__device__ __forceinline__ unsigned f2bf(float f) { unsigned u = __builtin_bit_cast(unsigned, f); return (u + 0x7fffu + ((u >> 16) & 1u)) >> 16; }
__device__ __forceinline__ unsigned pk2(float lo, float hi) { return f2bf(lo) | (f2bf(hi) << 16); }
__device__ __forceinline__ float bf2f(unsigned short b) { return __builtin_bit_cast(float, (unsigned)b << 16); }
#include <hip/hip_runtime.h>
namespace pg8 {
#define PG8_LAS __attribute__((address_space(3)))
typedef unsigned short bf16_t;
typedef short bf16x8 __attribute__((ext_vector_type(8)));
typedef float f32x4 __attribute__((ext_vector_type(4)));
typedef unsigned u32x4 __attribute__((ext_vector_type(4)));
constexpr int BM = 256, BK = 64, HALF = 128, HTB = HALF * BK * 2  , STAGE_BYTES = 8 * HTB, NXCD = 8, WGM = 8;

__host__ __device__ __forceinline__ int lds_byte(int r, int c) { const int st = (r >> 4) * 2 + (c >> 5), rr = r & 15, cc = c & 31, ob = rr * 64 + cc * 2; return st * 1024 + (ob ^ (((ob >> 9) & 1) << 5)); }
__host__ __device__ __forceinline__ void stage_rc(int b, int& R, int& C) { const int st = b / 1024, sb = b % 1024, swz = sb ^ (((sb >> 9) & 1) << 5); R = (st >> 1) * 16 + swz / 64; C = (st & 1) * 32 + (swz % 64) / 2; }
__host__ __device__ __forceinline__ int perm32(int rho) { const int n = rho >> 4, i = rho & 15; return 8 * (i >> 2) + 4 * n + (i & 3); }

struct Unit { int pm, pn; };
struct Gemm { const bf16_t* A; const bf16_t* Bt; int M, N, K; };

struct StaticOrder {
    int nM, nN, nwg, G, c;
    __host__ __device__ void init(int M, int N, int G_, int c_) { nM = M / BM; nN = N / BM; nwg = nM * nN; G = G_; c = c_; }
    __host__ __device__ bool next(int i, Unit& u) const {
        const long L = (long)i * G + c; if (L >= nwg) return false;
        int wgid = (int)L; { const int q = nwg / NXCD, r = nwg % NXCD, xcd = wgid % NXCD, off = wgid / NXCD; wgid = (xcd < r ? xcd * (q + 1) : r * (q + 1) + (xcd - r) * q) + off; }
        const int nig = WGM * nN, gid = wgid / nig, fm = gid * WGM, gsz = (nM - fm) < WGM ? (nM - fm) : WGM;
        u.pm = fm + ((wgid % nig) % gsz); u.pn = (wgid % nig) / gsz; return true;
    }
    __device__ __forceinline__ void a_ready(const Unit&) const {}
    __device__ __forceinline__ void done(const Unit&) const {}
};
__device__ __forceinline__ unsigned cvt_pk_bf16(float lo, float hi) { unsigned r; asm volatile("v_cvt_pk_bf16_f32 %0, %1, %2" : "=v"(r) : "v"(lo), "v"(hi)); return r; }
typedef float f32x2 __attribute__((ext_vector_type(2)));
__device__ __forceinline__ f32x2 gelu_pk(f32x2 v) {
    const f32x2 av = __builtin_elementwise_abs(v), d = av * 0.2316418882f + 1.0f;
    f32x2 t; t.x = __builtin_amdgcn_rcpf(d.x); t.y = __builtin_amdgcn_rcpf(d.y);
    f32x2 q = t * 0.5307027145f + (-0.7265760135f); q = q * t + 0.7107068705f; q = q * t + (-0.142248368f); q = q * t + 0.127414796f; q = q * t;
    const f32x2 s = (v * v) * (-0.72134752044f);
    f32x2 e; e.x = __builtin_amdgcn_exp2f(s.x); e.y = __builtin_amdgcn_exp2f(s.y);
    const f32x2 m = v * (q * e), r = v - m;
    f32x2 o; o.x = v.x < 0.f ? m.x : r.x; o.y = v.y < 0.f ? m.y : r.y; return o;
}

struct EpiF32 {
    static constexpr bool PERM = false, AFTER_DRAIN = false;
    float* C; int ldc; const float* bias;
    __device__ __forceinline__ void operator()(const f32x4 (&acc)[2][2][4][2], const Unit& u, int wr, int wc, int fr, int fq) const {
        const int row0 = u.pm * BM + wr * 64 + fr, col0 = u.pn * BM + wc * 32 + 4 * fq;
        f32x4 bv[2][2];
#pragma unroll
        for (int bj = 0; bj < 2; ++bj)
#pragma unroll
            for (int n = 0; n < 2; ++n) bv[bj][n] = bias ? *(const f32x4*)(bias + col0 + bj * HALF + n * 16) : (f32x4){0.f, 0.f, 0.f, 0.f};
#pragma unroll
        for (int ai = 0; ai < 2; ++ai)
#pragma unroll
            for (int m = 0; m < 4; ++m) { float* rowp = C + (size_t)(row0 + ai * HALF + m * 16) * ldc + col0;
#pragma unroll
                for (int bj = 0; bj < 2; ++bj)
#pragma unroll
                    for (int n = 0; n < 2; ++n) *(f32x4*)(rowp + bj * HALF + n * 16) = acc[ai][bj][m][n] + bv[bj][n]; }
    }
};

template <class Epi, class Sched, bool STAMP = false>
__device__ __forceinline__ void gemm_phase(PG8_LAS unsigned char* lds, const Gemm g, const Sched& S, const Epi& E, unsigned long long* stamps) {
    int tid = threadIdx.x; asm volatile("" : "+v"(tid));
    const int wid = __builtin_amdgcn_readfirstlane(tid >> 6), lane = tid & 63, wr = wid >> 2, wc = wid & 3, fr = lane & 15, fq = lane >> 4;
    const int K = g.K, nt = K / BK;
    int ts_lo = 0, ts_hi = 0, nts = 0; const unsigned long long rt_entry = STAMP ? (unsigned long long)wall_clock64() : 0ull;
#define PG8_STAMP() do { if (STAMP && wid == 0 && nts < 64) { const unsigned long long _c = (unsigned long long)clock64(); \
        ts_lo = (lane == nts) ? (int)(unsigned)_c : ts_lo; ts_hi = (lane == nts) ? (int)(unsigned)(_c >> 32) : ts_hi; ++nts; } } while (0)
    PG8_STAMP();
    unsigned voffA[2], voffB[2];
#pragma unroll
    for (int i = 0; i < 2; ++i) { int R, C; stage_rc(tid * 16 + i * 8192, R, C); const int Rb = Epi::PERM ? ((R & ~31) + perm32(R & 31)) : R;
        voffA[i] = (unsigned)(R * K + C) * 2u; voffB[i] = (unsigned)(Rb * K + C) * 2u; }
    const size_t kstep = (size_t)(BK * 2);
    const size_t hstep = (size_t)HALF * K * 2;
    const size_t tstep = 2 * hstep;
    const unsigned ldsw = (unsigned)wid * 1024u;
    const int aoff = lds_byte(wr * 64 + fr, fq * 8), boff = lds_byte(wc * 32 + fr, fq * 8);
#define PG8_SA(b, h) (((b) * 2 + (h)) * HTB)
#define PG8_SB(b, h) ((4 + (b) * 2 + (h)) * HTB)
#define PG8_STAGE(bufoff, gbase, voff) do { _Pragma("unroll") for (int _i = 0; _i < 2; ++_i) \
        __builtin_amdgcn_global_load_lds((const unsigned*)((const char*)(gbase) + (voff)[_i]), (PG8_LAS unsigned*)(lds + (bufoff) + ldsw + _i * 8192), 16, 0, 0); } while (0)
#define PG8_LDA(dst, b, h) do { _Pragma("unroll") for (int m = 0; m < 4; ++m) _Pragma("unroll") for (int k = 0; k < 2; ++k) dst[m][k] = *(const PG8_LAS bf16x8*)(lds + PG8_SA(b, h) + aoff + m * 2048 + k * 1024); } while (0)
#define PG8_LDB(dst, b, h) do { _Pragma("unroll") for (int n = 0; n < 2; ++n) _Pragma("unroll") for (int k = 0; k < 2; ++k) dst[n][k] = *(const PG8_LAS bf16x8*)(lds + PG8_SB(b, h) + boff + n * 2048 + k * 1024); } while (0)
#define PG8_MMA(ai, bj, At, Bt) do { __builtin_amdgcn_s_setprio(1); _Pragma("unroll") for (int m = 0; m < 4; ++m) _Pragma("unroll") for (int n = 0; n < 2; ++n) _Pragma("unroll") for (int k = 0; k < 2; ++k) \
        acc[ai][bj][m][n] = __builtin_amdgcn_mfma_f32_16x16x32_bf16(Bt[n][k], At[m][k], acc[ai][bj][m][n], 0, 0, 0); __builtin_amdgcn_s_setprio(0); } while (0)
#define PG8_WAIT_V(n) asm volatile("s_waitcnt vmcnt(" #n ")" ::: "memory")
#define PG8_WAIT_L(n) asm volatile("s_waitcnt lgkmcnt(" #n ")" ::: "memory")
#define PG8_BAR __builtin_amdgcn_s_barrier()
#define PG8_SCHED __builtin_amdgcn_sched_barrier(0)
    Unit cur, nxt; int ui = 0;
    if (!S.next(0, cur)) return;
    f32x4 acc[2][2][4][2];
#pragma unroll
    for (int a = 0; a < 2; ++a)
#pragma unroll
        for (int b = 0; b < 2; ++b)
#pragma unroll
            for (int m = 0; m < 4; ++m)
#pragma unroll
                for (int n = 0; n < 2; ++n) acc[a][b][m][n] = (f32x4){0.f, 0.f, 0.f, 0.f};
    bf16x8 At[4][2], B0[2][2], B1[2][2];
    const char* cA = (const char*)g.A + (size_t)cur.pm * tstep; const char* cB = (const char*)g.Bt + (size_t)cur.pn * tstep;
    S.a_ready(cur);
    PG8_STAGE(PG8_SB(0, 0), cB, voffB); PG8_STAGE(PG8_SA(0, 0), cA, voffA); PG8_STAGE(PG8_SB(0, 1), cB + hstep, voffB); PG8_STAGE(PG8_SA(0, 1), cA + hstep, voffA);
    if (wr == 1) PG8_BAR;
    PG8_WAIT_V(4); PG8_BAR;
    PG8_STAGE(PG8_SB(1, 0), cB + kstep, voffB); PG8_STAGE(PG8_SA(1, 0), cA + kstep, voffA); PG8_STAGE(PG8_SB(1, 1), cB + hstep + kstep, voffB);
    PG8_WAIT_V(6); PG8_BAR;
    PG8_STAMP();
    for (;;) {
        const bool has_next = S.next(ui + 1, nxt);
        const char* nA = has_next ? (const char*)g.A + (size_t)nxt.pm * tstep : cA; const char* nB = has_next ? (const char*)g.Bt + (size_t)nxt.pn * tstep : cB;
        for (int t = 0; t < nt; t += 2) {
            const bool last = (t == nt - 2);
            const char* a1 = cA + (size_t)(t + 1) * kstep;
            const char* a2 = last ? nA : cA + (size_t)(t + 2) * kstep; const char* b2 = last ? nB : cB + (size_t)(t + 2) * kstep;
            const char* a3 = a2 + kstep; const char* b3 = b2 + kstep;
            if (last && has_next) S.a_ready(nxt);
            PG8_LDB(B0, 0, 0); PG8_SCHED; PG8_LDA(At, 0, 0); PG8_STAGE(PG8_SA(1, 1), a1 + hstep, voffA);
            PG8_WAIT_L(8); PG8_BAR; PG8_WAIT_L(0); PG8_MMA(0, 0, At, B0); PG8_BAR; PG8_SCHED;
            PG8_LDB(B1, 0, 1); PG8_STAGE(PG8_SB(0, 0), b2, voffB);
            PG8_BAR; PG8_WAIT_L(0); PG8_MMA(0, 1, At, B1); PG8_BAR;
            PG8_LDA(At, 0, 1); PG8_STAGE(PG8_SA(0, 0), a2, voffA);
            PG8_BAR; PG8_WAIT_L(0); PG8_MMA(1, 0, At, B0); PG8_BAR; PG8_SCHED;
            PG8_STAGE(PG8_SB(0, 1), b2 + hstep, voffB);
            PG8_WAIT_V(6); PG8_BAR; PG8_MMA(1, 1, At, B1); PG8_BAR;
            PG8_LDB(B0, 1, 0); PG8_SCHED; PG8_LDA(At, 1, 0); PG8_STAGE(PG8_SA(0, 1), a2 + hstep, voffA);
            PG8_WAIT_L(8); PG8_BAR; PG8_WAIT_L(0); PG8_MMA(0, 0, At, B0); PG8_BAR; PG8_SCHED;
            PG8_LDB(B1, 1, 1); PG8_STAGE(PG8_SB(1, 0), b3, voffB);
            PG8_BAR; PG8_WAIT_L(0); PG8_MMA(0, 1, At, B1); PG8_BAR;
            PG8_LDA(At, 1, 1); PG8_STAGE(PG8_SA(1, 0), a3, voffA);
            PG8_BAR; PG8_WAIT_L(0); PG8_MMA(1, 0, At, B0); PG8_BAR; PG8_SCHED;
            PG8_STAGE(PG8_SB(1, 1), b3 + hstep, voffB);
            PG8_WAIT_V(6); PG8_BAR; PG8_MMA(1, 1, At, B1); PG8_BAR;
        }
        PG8_STAMP();
        if constexpr (!Epi::AFTER_DRAIN) { E(acc, cur, wr, wc, fr, fq); S.done(cur); }
        PG8_STAMP();
        if (!has_next) break;
#pragma unroll
        for (int a = 0; a < 2; ++a)
#pragma unroll
            for (int b = 0; b < 2; ++b)
#pragma unroll
                for (int m = 0; m < 4; ++m)
#pragma unroll
                    for (int n = 0; n < 2; ++n) acc[a][b][m][n] = (f32x4){0.f, 0.f, 0.f, 0.f};
        cur = nxt; cA = nA; cB = nB; ++ui;
    }
    PG8_WAIT_V(0);
    if (wr == 0) PG8_BAR;
    PG8_BAR;
    if constexpr (Epi::AFTER_DRAIN) { E.fused(acc, cur, wr, wc, fr, fq, lds, wid, lane); S.done(cur); }
    PG8_STAMP();
    if (STAMP && wid == 0) { stamps[lane] = lane < nts ? (((unsigned long long)(unsigned)ts_hi << 32) | (unsigned)ts_lo) : 0ull;
        if (lane == 62) stamps[62] = rt_entry; if (lane == 63) stamps[63] = (unsigned long long)wall_clock64(); }
#undef PG8_STAMP
#undef PG8_SA
#undef PG8_SB
#undef PG8_STAGE
#undef PG8_LDA
#undef PG8_LDB
#undef PG8_MMA
#undef PG8_WAIT_V
#undef PG8_WAIT_L
#undef PG8_BAR
#undef PG8_SCHED
}
}


namespace pg8 {
struct EpiProj {
    static constexpr bool PERM = true, AFTER_DRAIN = false;
    bf16_t* O; float* dtraw;
    __device__ __forceinline__ void operator()(const f32x4 (&acc)[2][2][4][2], const Unit& u, int wr, int wc, int fr, int fq) const {
        const int row0 = u.pm * BM + wr * 64 + fr;
        if (u.pn < 22) {
            const int col0 = u.pn * BM + wc * 32 + 8 * fq;
#pragma unroll
            for (int ai = 0; ai < 2; ++ai)
#pragma unroll
                for (int m = 0; m < 4; ++m) { bf16_t* rowp = O + (size_t)(row0 + ai * HALF + m * 16) * 5632 + col0;
#pragma unroll
                    for (int bj = 0; bj < 2; ++bj) { const f32x4 v0 = acc[ai][bj][m][0], v1 = acc[ai][bj][m][1];
                        u32x4 w; w.x = cvt_pk_bf16(v0[0], v0[1]); w.y = cvt_pk_bf16(v0[2], v0[3]); w.z = cvt_pk_bf16(v1[0], v1[1]); w.w = cvt_pk_bf16(v1[2], v1[3]);
                        *(u32x4*)(rowp + bj * HALF) = w; } }
        } else if (wc == 0) {
#pragma unroll
            for (int ai = 0; ai < 2; ++ai)
#pragma unroll
                for (int m = 0; m < 4; ++m) { float* rp = dtraw + (size_t)(row0 + ai * HALF + m * 16) * 32 + 8 * fq;
                    *(f32x4*)rp = acc[ai][0][m][0]; *(f32x4*)(rp + 4) = acc[ai][0][m][1]; }
        }
    }
};
}


namespace pg8 {
struct EpiBf16Plain {
    static constexpr bool PERM = true, AFTER_DRAIN = false;
    bf16_t* O; int ldc;
    __device__ __forceinline__ void operator()(const f32x4 (&acc)[2][2][4][2], const Unit& u, int wr, int wc, int fr, int fq) const {
        const int row0 = u.pm * BM + wr * 64 + fr, col0 = u.pn * BM + wc * 32 + 8 * fq;
#pragma unroll
        for (int ai = 0; ai < 2; ++ai)
#pragma unroll
            for (int m = 0; m < 4; ++m) { bf16_t* rowp = O + (size_t)(row0 + ai * HALF + m * 16) * ldc + col0;
#pragma unroll
                for (int bj = 0; bj < 2; ++bj) { const f32x4 v0 = acc[ai][bj][m][0], v1 = acc[ai][bj][m][1];
                    u32x4 w; w.x = cvt_pk_bf16(v0[0], v0[1]); w.y = cvt_pk_bf16(v0[2], v0[3]); w.z = cvt_pk_bf16(v1[0], v1[1]); w.w = cvt_pk_bf16(v1[2], v1[3]);
                    *(u32x4*)(rowp + bj * HALF) = w; } }
    }
};
}

#define NTHR 512
#define NWAVE 8

__device__ __forceinline__ void ph_gemm_f32(float* lds, const float* __restrict__ A, const float* __restrict__ B, float* __restrict__ C,
                                            int M, int N, int K, int lda, int ldb, int ldc) {
    const int tid = threadIdx.x & 255, half = threadIdx.x >> 8, tx = tid & 15, ty = tid >> 4;
    float (*As)[68] = (float (*)[68])(lds + half * 2 * 16 * 68);
    float (*Bs)[68] = (float (*)[68])(lds + half * 2 * 16 * 68 + 16 * 68);
    const int ntx = (N + 63) / 64, nty = M / 64, ntiles = ntx * nty;
    for (int it = blockIdx.x; 2 * it < ntiles; it += gridDim.x) {
        const int tile = 2 * it + half;
        const int m0 = (tile / ntx) * 64, n0 = (tile % ntx) * 64;
        float acc[4][4];
#pragma unroll
        for (int i = 0; i < 4; ++i)
#pragma unroll
            for (int j = 0; j < 4; ++j) acc[i][j] = 0.f;
        for (int k0 = 0; k0 < K; k0 += 16) {
#pragma unroll
            for (int i = 0; i < 4; ++i) {
                int idx = tid + i * 256;
                int r = idx >> 4, c = idx & 15;
                As[c][r] = (m0 + r < M) ? A[(size_t)(m0 + r) * lda + k0 + c] : 0.f;
                int rb = idx >> 6, cb = idx & 63;
                Bs[rb][cb] = (n0 + cb < N) ? B[(size_t)(k0 + rb) * ldb + n0 + cb] : 0.f;
            }
            __syncthreads();
#pragma unroll
            for (int k = 0; k < 16; ++k) {
                float a[4], b[4];
#pragma unroll
                for (int i = 0; i < 4; ++i) { a[i] = As[k][ty * 4 + i]; b[i] = Bs[k][tx * 4 + i]; }
#pragma unroll
                for (int i = 0; i < 4; ++i)
#pragma unroll
                    for (int j = 0; j < 4; ++j) acc[i][j] += a[i] * b[j];
            }
            __syncthreads();
        }
#pragma unroll
        for (int i = 0; i < 4; ++i)
#pragma unroll
            for (int j = 0; j < 4; ++j) {
                int r = m0 + ty * 4 + i, c = n0 + tx * 4 + j;
                if (r < M && c < N) C[(size_t)r * ldc + c] = acc[i][j];
            }
    }
}


template <int MODE>
__device__ __forceinline__ void transpose_item(const float* __restrict__ W, int K, int N, int Npad, bf16* __restrict__ WT, LAS float* scr, int item, int lane) {
    const int nblk = Npad / 32, kb = item / nblk, nb = item % nblk, k0 = 64 * kb, n0 = 32 * nb;
    const int n = n0 + (lane & 31);
    int sc = n;
    if (MODE == 1) sc = (n < 4096) ? n : (n < 5632 ? n + 24 : (n < 5656 ? n - 5632 + 4096 : -1));
    else sc = (n < N) ? n : -1;
#pragma unroll 8
    for (int i = 0; i < 32; ++i) { const int kk = 2 * i + (lane >> 5); scr[kk * 33 + (lane & 31)] = (sc >= 0) ? W[(size_t)(k0 + kk) * N + sc] : 0.f; }
    LDS_WAIT(); asm volatile("" ::: "memory");
    const int c = lane & 7;
#pragma unroll
    for (int j = 0; j < 4; ++j) { const int nn = (lane >> 3) + 8 * j; const LAS float* s = scr + (8 * c) * 33 + nn;
        v4u o; o.x = pk2(s[0 * 33], s[1 * 33]); o.y = pk2(s[2 * 33], s[3 * 33]); o.z = pk2(s[4 * 33], s[5 * 33]); o.w = pk2(s[6 * 33], s[7 * 33]);
        *(v4u*)(WT + (size_t)(n0 + nn) * K + k0 + 8 * c) = o; }
    LDS_WAIT(); asm volatile("" ::: "memory");
}
__device__ __forceinline__ void ph_prologue(LAS unsigned char* ldsb, const float* __restrict__ xp, const float* __restrict__ xs, bf16* __restrict__ A0,
                                            const float* __restrict__ w_in, bf16* __restrict__ wt_in, float* __restrict__ rope_tab) {
    const int lane = threadIdx.x & 63, wave = threadIdx.x >> 6;
    LAS float* scr = (LAS float*)(ldsb + wave * 16384);
    const int gw = blockIdx.x * NWAVE + wave, NGW = gridDim.x * NWAVE;
    constexpr int I_IN = (D_MODEL / 64) * (PROJ_LD / 32);
    for (int it = gw; it < I_IN; it += NGW) transpose_item<1>(w_in, D_MODEL, IN_WIDTH, PROJ_LD, wt_in, scr, it, lane);
    for (int idx = blockIdx.x * NTHR + threadIdx.x; idx < SEQ * 32; idx += gridDim.x * NTHR) {
        const int pos = idx >> 5, j = idx & 31;
        const double rev = (double)pos * ROPE_INV_REV[j];
        const float fr = (float)(rev - floor(rev));
        rope_tab[(size_t)pos * 64 + j] = __builtin_amdgcn_cosf(fr); rope_tab[(size_t)pos * 64 + 32 + j] = __builtin_amdgcn_sinf(fr);
    }
    const size_t n8 = (size_t)T_ALL * D_MODEL / 8, np8 = (size_t)T_PROMPT * D_MODEL / 8;
#pragma unroll 4
    for (size_t i = (size_t)blockIdx.x * NTHR + threadIdx.x; i < n8; i += (size_t)gridDim.x * NTHR) {
        const float4* s = (i < np8) ? (const float4*)xp + 2 * i : (const float4*)xs + 2 * (i - np8);
        float4 a = s[0], b = s[1];
        v4u o; o.x = pk2(a.x, a.y); o.y = pk2(a.z, a.w); o.z = pk2(b.x, b.y); o.w = pk2(b.z, b.w);
        ((v4u*)A0)[i] = o;
    }
}
__device__ __forceinline__ void ph_prologue2(LAS unsigned char* ldsb, const float* __restrict__ w_out, bf16* __restrict__ wt_out, const float* __restrict__ w_q, bf16* __restrict__ wt_q,
                                             int rank, int nranks) {
    const int lane = threadIdx.x & 63, wave = threadIdx.x >> 6;
    LAS float* scr = (LAS float*)(ldsb + wave * 16384);
    constexpr int I_OUT = (MIX_WIDTH / 64) * (D_MODEL / 32), I_Q = (D_MODEL / 64) * (2048 / 32);
    for (int it = rank * NWAVE + wave; it < I_OUT + I_Q; it += nranks * NWAVE) {
        if (it < I_OUT) transpose_item<0>(w_out, MIX_WIDTH, D_MODEL, D_MODEL, wt_out, scr, it, lane);
        else transpose_item<0>(w_q, D_MODEL, 2048, 2048, wt_q, scr, it - I_OUT, lane);
    }
}

__device__ __forceinline__ void ph_concat_x(const float* __restrict__ xp, const float* __restrict__ xs, float* __restrict__ xall) {
    const size_t n4 = (size_t)T_ALL * D_MODEL / 4, np4 = (size_t)T_PROMPT * D_MODEL / 4;
    for (size_t i = (size_t)blockIdx.x * NTHR + threadIdx.x; i < n4; i += (size_t)gridDim.x * NTHR) {
        float4 v = (i < np4) ? ((const float4*)xp)[i] : ((const float4*)xs)[i - np4];
        ((float4*)xall)[i] = v;
    }
}

typedef float f32x4n __attribute__((ext_vector_type(4)));
__device__ __forceinline__ void ph_cache_copy(const float* __restrict__ ck, const float* __restrict__ cv, float* __restrict__ out) {
    constexpr unsigned PER_B = (WBUF - DEC_SEQ) * ATT_WIDTH / 4;
    constexpr unsigned TOTAL = 2u * DEC_BATCH * PER_B;
    for (unsigned c = blockIdx.x; c < TOTAL / 4096u; c += gridDim.x) {
        f32x4n v[8]; size_t dsti[8]; bool isv[8];
#pragma unroll
        for (int j = 0; j < 8; ++j) {
            const unsigned idx = c * 4096u + j * 512u + threadIdx.x;
            const unsigned tb = idx / PER_B, r = idx - tb * PER_B, bb = tb & (DEC_BATCH - 1);
            isv[j] = tb >= DEC_BATCH;
            const size_t srci = (size_t)bb * (WBUF * ATT_WIDTH / 4) + (DEC_SEQ * ATT_WIDTH / 4) + r;
            dsti[j] = (size_t)bb * (WBUF * ATT_WIDTH / 4) + r;
            v[j] = __builtin_nontemporal_load((isv[j] ? (const f32x4n*)cv : (const f32x4n*)ck) + srci);
        }
#pragma unroll
        for (int j = 0; j < 8; ++j) __builtin_nontemporal_store(v[j], (f32x4n*)(out + (isv[j] ? OUT_SV : OUT_SK)) + dsti[j]);
    }
}

__device__ __forceinline__ void ph_post_proj(const float* __restrict__ proj, const float* __restrict__ state_conv,
                                             const float* __restrict__ conv_w, const float* __restrict__ conv_b, const float* __restrict__ dt_bias,
                                             float* __restrict__ xbc_act, float* __restrict__ dtv, float* __restrict__ qrot, float* __restrict__ krot,
                                             float* __restrict__ out) {
    const int tid = threadIdx.x & 255, half = threadIdx.x >> 8;
    for (int t = 2 * blockIdx.x + half; t < T_ALL; t += 2 * gridDim.x) {
        const bool is_p = t < T_PROMPT;
        int b, i, pos;
        if (is_p) { b = t / SEQ; i = t % SEQ; pos = i; } else { int ts = t - T_PROMPT; b = ts / DEC_SEQ; i = ts % DEC_SEQ; pos = PAST_LEN + i; }
        const float* row = proj + (size_t)t * PROJ_LD;
        for (int c = tid; c < CONV_DIM; c += 256) {
            float acc = conv_b[c];
#pragma unroll
            for (int tap = 0; tap < 4; ++tap) {
                int r = i - 3 + tap;
                float val;
                if (r >= 0) val = proj[(size_t)(t - i + r) * PROJ_LD + O_XBC + c];
                else val = is_p ? 0.f : state_conv[((size_t)b * 3 + (3 + r)) * CONV_DIM + c];
                acc += val * conv_w[tap * CONV_DIM + c];
            }
            xbc_act[(size_t)t * CONV_DIM + c] = silu_f(acc);
        }
        if (tid < SSD_HEADS) dtv[(size_t)t * SSD_HEADS + tid] = softplus_f(row[O_DT + tid] + dt_bias[tid]);
        for (int idx = tid; idx < 512; idx += 256) {
            int which = idx >> 8, h = (idx >> 5) & 7, j = idx & 31;
            double rev = (double)pos * ROPE_INV_REV[j];
            float fr = (float)(rev - floor(rev));
            float sn = __builtin_amdgcn_sinf(fr), cs = __builtin_amdgcn_cosf(fr);
            const float* src = row + (which ? O_K : O_Q) + h * 64;
            float t1 = src[j], t2 = src[j + 32];
            float o1 = t1 * cs - t2 * sn, o2 = t2 * cs + t1 * sn;
            float* dst = (which ? krot : qrot) + (size_t)t * ATT_WIDTH + h * 64;
            dst[j] = o1; dst[j + 32] = o2;
            if (which) {
                if (is_p) { if (i >= SEQ - WBUF) { float* o = out + OUT_PK + ((size_t)b * WBUF + (i - (SEQ - WBUF))) * ATT_WIDTH + h * 64; o[j] = o1; o[j + 32] = o2; } }
                else { float* o = out + OUT_SK + ((size_t)b * WBUF + (WBUF - DEC_SEQ + i)) * ATT_WIDTH + h * 64; o[j] = o1; o[j + 32] = o2; }
            }
        }
        for (int c = tid; c < ATT_WIDTH; c += 256) {
            float v = row[O_V + c];
            if (is_p) { if (i >= SEQ - WBUF) out[OUT_PV + ((size_t)b * WBUF + (i - (SEQ - WBUF))) * ATT_WIDTH + c] = v; }
            else out[OUT_SV + ((size_t)b * WBUF + (WBUF - DEC_SEQ + i)) * ATT_WIDTH + c] = v;
        }
        if (is_p) {
            if (i >= SEQ - 3) { int r = i - (SEQ - 3); for (int c = tid; c < CONV_DIM; c += 256) out[OUT_PC + ((size_t)b * 3 + r) * CONV_DIM + c] = row[O_XBC + c]; }
        } else {
            if (i >= 1) { int r = i - 1; for (int c = tid; c < CONV_DIM; c += 256) out[OUT_SC + ((size_t)b * 3 + r) * CONV_DIM + c] = row[O_XBC + c]; }
        }
    }
}


#define NB_LD 5632
#define NB_XBC 1536
#define NB_Q 4096
#define NB_K 4608
#define NB_V 5120
__device__ __forceinline__ void unpack8(const v4u w, float (&f)[8]) {
    f[0] = __builtin_bit_cast(float, w.x << 16); f[1] = __builtin_bit_cast(float, w.x & 0xffff0000u);
    f[2] = __builtin_bit_cast(float, w.y << 16); f[3] = __builtin_bit_cast(float, w.y & 0xffff0000u);
    f[4] = __builtin_bit_cast(float, w.z << 16); f[5] = __builtin_bit_cast(float, w.z & 0xffff0000u);
    f[6] = __builtin_bit_cast(float, w.w << 16); f[7] = __builtin_bit_cast(float, w.w & 0xffff0000u);
}
__device__ __forceinline__ void store8f(float* d, const float (&f)[8]) { *(float4*)d = make_float4(f[0], f[1], f[2], f[3]); *(float4*)(d + 4) = make_float4(f[4], f[5], f[6], f[7]); }
__device__ __forceinline__ void ph_post_proj2(const bf16* __restrict__ projb, const float* __restrict__ dtraw, const float* __restrict__ state_conv,
                                              const float* __restrict__ conv_w, const float* __restrict__ conv_b, const float* __restrict__ dt_bias,
                                              bf16* __restrict__ xbc_b, float* __restrict__ dtv, bf16* __restrict__ qrot_b, bf16* __restrict__ krot_b,
                                              float* __restrict__ out) {
    const int tid = threadIdx.x & 255, half = threadIdx.x >> 8;
    for (int t = T_PROMPT + 2 * blockIdx.x + half; t < T_ALL; t += 2 * gridDim.x) {
        const bool is_p = t < T_PROMPT;
        int b, i, pos;
        if (is_p) { b = t / SEQ; i = t % SEQ; pos = i; } else { int ts = t - T_PROMPT; b = ts / DEC_SEQ; i = ts % DEC_SEQ; pos = PAST_LEN + i; }
        const bf16* row = projb + (size_t)t * NB_LD;
        if (tid < 64) {
            float f[8]; unpack8(*(const v4u*)(row + NB_V + tid * 8), f);
            if (is_p) { if (i >= SEQ - WBUF) store8f(out + OUT_PV + ((size_t)b * WBUF + (i - (SEQ - WBUF))) * ATT_WIDTH + tid * 8, f); }
            else store8f(out + OUT_SV + ((size_t)b * WBUF + (WBUF - DEC_SEQ + i)) * ATT_WIDTH + tid * 8, f);
        }
        for (int c8 = tid; c8 < 320; c8 += 256) {
            const int c = c8 * 8;
            float acc[8], cur[8];
            { const float4 b0 = *(const float4*)(conv_b + c), b1 = *(const float4*)(conv_b + c + 4);
              acc[0] = b0.x; acc[1] = b0.y; acc[2] = b0.z; acc[3] = b0.w; acc[4] = b1.x; acc[5] = b1.y; acc[6] = b1.z; acc[7] = b1.w; }
#pragma unroll
            for (int tap = 0; tap < 4; ++tap) {
                const int r = i - 3 + tap;
                float val[8];
                if (r >= 0) unpack8(*(const v4u*)(projb + (size_t)(t - i + r) * NB_LD + NB_XBC + c), val);
                else if (!is_p) { const float* sp = state_conv + ((size_t)b * 3 + (3 + r)) * CONV_DIM + c; const float4 s0 = *(const float4*)sp, s1 = *(const float4*)(sp + 4);
                    val[0] = s0.x; val[1] = s0.y; val[2] = s0.z; val[3] = s0.w; val[4] = s1.x; val[5] = s1.y; val[6] = s1.z; val[7] = s1.w; }
                else {
#pragma unroll
                    for (int j = 0; j < 8; ++j) val[j] = 0.f; }
                const float4 w0 = *(const float4*)(conv_w + tap * CONV_DIM + c), w1 = *(const float4*)(conv_w + tap * CONV_DIM + c + 4);
                acc[0] += val[0] * w0.x; acc[1] += val[1] * w0.y; acc[2] += val[2] * w0.z; acc[3] += val[3] * w0.w;
                acc[4] += val[4] * w1.x; acc[5] += val[5] * w1.y; acc[6] += val[6] * w1.z; acc[7] += val[7] * w1.w;
                if (tap == 3) {
#pragma unroll
                    for (int j = 0; j < 8; ++j) cur[j] = val[j]; }
            }
#pragma unroll
            for (int j = 0; j < 8; ++j) acc[j] = silu_f(acc[j]);
            v4u o; o.x = pk2(acc[0], acc[1]); o.y = pk2(acc[2], acc[3]); o.z = pk2(acc[4], acc[5]); o.w = pk2(acc[6], acc[7]);
            *(v4u*)(xbc_b + (size_t)t * CONV_DIM + c) = o;
            if (is_p) { if (i >= SEQ - 3) store8f(out + OUT_PC + ((size_t)b * 3 + (i - (SEQ - 3))) * CONV_DIM + c, cur); }
            else { if (i >= 1) store8f(out + OUT_SC + ((size_t)b * 3 + (i - 1)) * CONV_DIM + c, cur); }
        }
        if (tid < SSD_HEADS) dtv[(size_t)t * SSD_HEADS + tid] = softplus_f(dtraw[(size_t)t * 32 + tid] + dt_bias[tid]);
        if (tid < 128) {
            const int which = tid >> 6, h = (tid >> 3) & 7, jc = tid & 7;
            const bf16* src = row + (which ? NB_K : NB_Q) + h * 64 + jc * 4;
            const uint2 lo = *(const uint2*)src, hi = *(const uint2*)(src + 32);
            float t1[4], t2[4], o1[4], o2[4];
            t1[0] = __builtin_bit_cast(float, lo.x << 16); t1[1] = __builtin_bit_cast(float, lo.x & 0xffff0000u); t1[2] = __builtin_bit_cast(float, lo.y << 16); t1[3] = __builtin_bit_cast(float, lo.y & 0xffff0000u);
            t2[0] = __builtin_bit_cast(float, hi.x << 16); t2[1] = __builtin_bit_cast(float, hi.x & 0xffff0000u); t2[2] = __builtin_bit_cast(float, hi.y << 16); t2[3] = __builtin_bit_cast(float, hi.y & 0xffff0000u);
#pragma unroll
            for (int e = 0; e < 4; ++e) {
                const double rev = (double)pos * ROPE_INV_REV[jc * 4 + e];
                const float fr = (float)(rev - floor(rev));
                const float sn = __builtin_amdgcn_sinf(fr), cs = __builtin_amdgcn_cosf(fr);
                o1[e] = t1[e] * cs - t2[e] * sn; o2[e] = t2[e] * cs + t1[e] * sn;
            }
            const size_t doff = (size_t)t * ATT_WIDTH + h * 64 + jc * 4;
            bf16* db = which ? krot_b : qrot_b;
            *(uint2*)(db + doff) = make_uint2(pk2(o1[0], o1[1]), pk2(o1[2], o1[3])); *(uint2*)(db + doff + 32) = make_uint2(pk2(o2[0], o2[1]), pk2(o2[2], o2[3]));
            if (which) {
                float* o = nullptr;
                if (is_p) { if (i >= SEQ - WBUF) o = out + OUT_PK + ((size_t)b * WBUF + (i - (SEQ - WBUF))) * ATT_WIDTH + h * 64 + jc * 4; }
                else o = out + OUT_SK + ((size_t)b * WBUF + (WBUF - DEC_SEQ + i)) * ATT_WIDTH + h * 64 + jc * 4;
                if (o) { *(float4*)o = make_float4(o1[0], o1[1], o1[2], o1[3]); *(float4*)(o + 32) = make_float4(o2[0], o2[1], o2[2], o2[3]); }
            }
        }
    }
}


__device__ __forceinline__ void ph_post_proj_prompt(const bf16* __restrict__ projb, const float* __restrict__ dtraw, const float* __restrict__ conv_w, const float* __restrict__ conv_b,
                                                    const float* __restrict__ dt_bias, const float* __restrict__ rope_tab, bf16* __restrict__ xbc_b, float* __restrict__ dtv,
                                                    bf16* __restrict__ qrot_b, bf16* __restrict__ krot_b, float* __restrict__ out) {
    const int gtid = blockIdx.x * NTHR + threadIdx.x, gsz = gridDim.x * NTHR;
    for (int item = gtid; item < (T_PROMPT / 16) * 320; item += gsz) {
        const int run = item / 320, c = (item - run * 320) * 8, t0 = run * 16, i0 = t0 & (SEQ - 1), b = t0 >> 13;
        float w[4][8], bias[8];
#pragma unroll
        for (int tap = 0; tap < 4; ++tap) { const float4 w0 = *(const float4*)(conv_w + tap * CONV_DIM + c), w1 = *(const float4*)(conv_w + tap * CONV_DIM + c + 4);
            w[tap][0] = w0.x; w[tap][1] = w0.y; w[tap][2] = w0.z; w[tap][3] = w0.w; w[tap][4] = w1.x; w[tap][5] = w1.y; w[tap][6] = w1.z; w[tap][7] = w1.w; }
        { const float4 b0 = *(const float4*)(conv_b + c), b1 = *(const float4*)(conv_b + c + 4);
          bias[0] = b0.x; bias[1] = b0.y; bias[2] = b0.z; bias[3] = b0.w; bias[4] = b1.x; bias[5] = b1.y; bias[6] = b1.z; bias[7] = b1.w; }
        const bf16* src = projb + (size_t)t0 * NB_LD + NB_XBC + c;
        v4u raw[19];
#pragma unroll
        for (int s = 0; s < 19; ++s) { v4u z; z.x = 0u; z.y = 0u; z.z = 0u; z.w = 0u; raw[s] = (s >= 3 || i0 != 0) ? *(const v4u*)(src + (ptrdiff_t)(s - 3) * NB_LD) : z; }
        float p0[8], p1[8], p2[8];
        unpack8(raw[0], p0); unpack8(raw[1], p1); unpack8(raw[2], p2);
#pragma unroll
        for (int s = 0; s < 16; ++s) {
            float cur[8], acc[8]; unpack8(raw[s + 3], cur);
#pragma unroll
            for (int j = 0; j < 8; ++j) acc[j] = silu_f(bias[j] + p0[j] * w[0][j] + p1[j] * w[1][j] + p2[j] * w[2][j] + cur[j] * w[3][j]);
            v4u o; o.x = pk2(acc[0], acc[1]); o.y = pk2(acc[2], acc[3]); o.z = pk2(acc[4], acc[5]); o.w = pk2(acc[6], acc[7]);
            *(v4u*)(xbc_b + (size_t)(t0 + s) * CONV_DIM + c) = o;
            if (i0 + s >= SEQ - 3) store8f(out + OUT_PC + ((size_t)b * 3 + (i0 + s - (SEQ - 3))) * CONV_DIM + c, cur);
#pragma unroll
            for (int j = 0; j < 8; ++j) { p0[j] = p1[j]; p1[j] = p2[j]; p2[j] = cur[j]; }
        }
    }
#pragma unroll 4
    for (int item = gtid; item < T_PROMPT * 128; item += gsz) {
        const int t = item >> 7, sub = item & 127, which = sub >> 6, h = (sub >> 3) & 7, jc = sub & 7, i = t & (SEQ - 1), b = t >> 13;
        const bf16* src = projb + (size_t)t * NB_LD + (which ? NB_K : NB_Q) + h * 64 + jc * 4;
        const uint2 lo = *(const uint2*)src, hi = *(const uint2*)(src + 32);
        const float4 cs = *(const float4*)(rope_tab + (size_t)i * 64 + jc * 4), sn = *(const float4*)(rope_tab + (size_t)i * 64 + 32 + jc * 4);
        float t1[4], t2[4], o1[4], o2[4];
        t1[0] = __builtin_bit_cast(float, lo.x << 16); t1[1] = __builtin_bit_cast(float, lo.x & 0xffff0000u); t1[2] = __builtin_bit_cast(float, lo.y << 16); t1[3] = __builtin_bit_cast(float, lo.y & 0xffff0000u);
        t2[0] = __builtin_bit_cast(float, hi.x << 16); t2[1] = __builtin_bit_cast(float, hi.x & 0xffff0000u); t2[2] = __builtin_bit_cast(float, hi.y << 16); t2[3] = __builtin_bit_cast(float, hi.y & 0xffff0000u);
        const float cv[4] = {cs.x, cs.y, cs.z, cs.w}, sv[4] = {sn.x, sn.y, sn.z, sn.w};
#pragma unroll
        for (int e = 0; e < 4; ++e) { o1[e] = t1[e] * cv[e] - t2[e] * sv[e]; o2[e] = t2[e] * cv[e] + t1[e] * sv[e]; }
        const size_t doff = (size_t)t * ATT_WIDTH + h * 64 + jc * 4;
        bf16* db = which ? krot_b : qrot_b;
        *(uint2*)(db + doff) = make_uint2(pk2(o1[0], o1[1]), pk2(o1[2], o1[3])); *(uint2*)(db + doff + 32) = make_uint2(pk2(o2[0], o2[1]), pk2(o2[2], o2[3]));
        if (which && i >= SEQ - WBUF) {
            float* o = out + OUT_PK + ((size_t)b * WBUF + (i - (SEQ - WBUF))) * ATT_WIDTH + h * 64 + jc * 4;
            *(float4*)o = make_float4(o1[0], o1[1], o1[2], o1[3]); *(float4*)(o + 32) = make_float4(o2[0], o2[1], o2[2], o2[3]);
        }
    }
#pragma unroll 4
    for (int item = gtid; item < T_PROMPT * SSD_HEADS; item += gsz) { const int t = item / SSD_HEADS, hd = item - t * SSD_HEADS; dtv[item] = softplus_f(dtraw[(size_t)t * 32 + hd] + dt_bias[hd]); }
#pragma unroll 2
    for (int item = gtid; item < BATCH * WBUF * 64; item += gsz) {
        const int ch = item & 63, j = (item >> 6) & (WBUF - 1), b = item >> 17;
        float f[8]; unpack8(*(const v4u*)(projb + (size_t)(b * SEQ + (SEQ - WBUF) + j) * NB_LD + NB_V + ch * 8), f);
        store8f(out + OUT_PV + ((size_t)b * WBUF + j) * ATT_WIDTH + ch * 8, f);
    }
}

#define SSD_CH 32
__device__ __forceinline__ void ph_ssd_naive(float* lds, const bf16* __restrict__ xbc_act, const float* __restrict__ dtv, const float* __restrict__ a_log,
                                             const float* __restrict__ d_skip, const float* __restrict__ state_ssm, float* __restrict__ ybuf, float* __restrict__ out) {
    float (*sx)[64] = (float (*)[64])lds;
    float (*sB)[128] = (float (*)[128])(lds + SSD_CH * 64);
    float (*sC)[128] = (float (*)[128])(lds + SSD_CH * 64 + SSD_CH * 128);
    float* sdt = lds + SSD_CH * 64 + 2 * SSD_CH * 128;
    const int tid = threadIdx.x, p = tid >> 3, ng = tid & 7;
    for (int vb = BATCH * SSD_HEADS + blockIdx.x; vb < (BATCH + DEC_BATCH) * SSD_HEADS; vb += gridDim.x) {
        const int seq = vb / SSD_HEADS, h = vb % SSD_HEADS, g = h / 6;
        const bool is_p = seq < BATCH;
        const int L = is_p ? SEQ : DEC_SEQ;
        const int t0 = is_p ? seq * SEQ : T_PROMPT + (seq - BATCH) * DEC_SEQ;
        const float A = -__expf(a_log[h]);
        const float D = d_skip[h];
        float hs[16];
        if (is_p) {
#pragma unroll
            for (int j = 0; j < 16; ++j) hs[j] = 0.f;
        } else {
            const float* s0 = state_ssm + (((size_t)(seq - BATCH) * SSD_HEADS + h) * 64 + p) * 128 + ng * 16;
#pragma unroll
            for (int j = 0; j < 16; ++j) hs[j] = s0[j];
        }
        for (int c0 = 0; c0 < L; c0 += SSD_CH) {
            const int nst = (L - c0) < SSD_CH ? (L - c0) : SSD_CH;
            __syncthreads();
            for (int idx = tid; idx < nst * 64; idx += NTHR) { int s = idx >> 6, c = idx & 63; sx[s][c] = bf2f(xbc_act[(size_t)(t0 + c0 + s) * CONV_DIM + h * 64 + c]); }
            for (int idx = tid; idx < nst * 128; idx += NTHR) { int s = idx >> 7, c = idx & 127;
                sB[s][c] = bf2f(xbc_act[(size_t)(t0 + c0 + s) * CONV_DIM + 1536 + g * 128 + c]);
                sC[s][c] = bf2f(xbc_act[(size_t)(t0 + c0 + s) * CONV_DIM + 2048 + g * 128 + c]); }
            if (tid < nst) sdt[tid] = dtv[(size_t)(t0 + c0 + tid) * SSD_HEADS + h];
            __syncthreads();
            for (int s = 0; s < nst; ++s) {
                const float dt = sdt[s], x = sx[s][p];
                const float a = __expf(dt * A), xdt = x * dt;
                float y = 0.f;
#pragma unroll
                for (int j = 0; j < 16; ++j) { hs[j] = a * hs[j] + xdt * sB[s][ng * 16 + j]; y += sC[s][ng * 16 + j] * hs[j]; }
                y += __shfl_xor(y, 1); y += __shfl_xor(y, 2); y += __shfl_xor(y, 4);
                if (ng == 0) ybuf[(size_t)(t0 + c0 + s) * MIX_WIDTH + h * 64 + p] = y + D * x;
            }
        }
        float* so = is_p ? out + OUT_PS + (((size_t)seq * SSD_HEADS + h) * 64 + p) * 128 + ng * 16
                         : out + OUT_SS + (((size_t)(seq - BATCH) * SSD_HEADS + h) * 64 + p) * 128 + ng * 16;
#pragma unroll
        for (int j = 0; j < 16; ++j) so[j] = hs[j];
    }
}

__device__ __forceinline__ void ph_gate_norm(const bf16* __restrict__ projb, const float* __restrict__ norm_g, const float* __restrict__ ybuf, bf16* __restrict__ A1) {
    const int w = threadIdx.x >> 6, lane = threadIdx.x & 63, g = w & 3;
    for (int t = T_PROMPT + 2 * blockIdx.x + (w >> 2); t < T_ALL; t += 2 * gridDim.x) {
        float v[6]; float ss = 0.f;
#pragma unroll
        for (int j = 0; j < 6; ++j) {
            int c = g * 384 + j * 64 + lane;
            float y = ybuf[(size_t)t * MIX_WIDTH + c], z = bf2f(projb[(size_t)t * NB_LD + c]);
            v[j] = y * silu_f(z); ss += v[j] * v[j];
        }
        ss = wave_sum(ss);
        const float r = rsqrtf(ss * (1.0f / 384.0f) + LN_EPS);
#pragma unroll
        for (int j = 0; j < 6; ++j) { int c = g * 384 + j * 64 + lane; A1[(size_t)t * MIX_WIDTH + c] = (bf16)f2bf(v[j] * r * norm_g[c]); }
    }
}

__device__ __forceinline__ void ph_attn_naive(float* lds, const float* __restrict__ proj, const float* __restrict__ qrot, const float* __restrict__ krot,
                                              const float* __restrict__ ck, const float* __restrict__ cv, float* __restrict__ ybuf) {
    float (*sq)[64] = (float (*)[64])lds;
    const int w = threadIdx.x >> 6, lane = threadIdx.x & 63;
    for (int vb = blockIdx.x; vb < T_SAMPLE * 8 / NWAVE; vb += gridDim.x) {
        const int item = T_PROMPT * 8 + vb * NWAVE + w;
        const int t = item >> 3, h = item & 7;
        const bool is_p = t < T_PROMPT;
        int b, i;
        if (is_p) { b = t / SEQ; i = t % SEQ; } else { int ts = t - T_PROMPT; b = ts / DEC_SEQ; i = ts % DEC_SEQ; }
        __syncthreads();
        sq[w][lane] = qrot[(size_t)t * ATT_WIDTH + h * 64 + lane];
        __syncthreads();
        const int qi = is_p ? i : WBUF + i;
        float sc[3][3];
        float mx = -INFINITY;
#pragma unroll
        for (int pt = 0; pt < 3; ++pt) {
            const int d = pt == 0 ? 1 : (pt == 1 ? 4 : 16);
#pragma unroll
            for (int sl = 0; sl < 3; ++sl) {
                const int m = lane + sl * 64;
                float s = -INFINITY;
                const int kj = qi - d * m;
                if (m <= 128 && kj >= 0) {
                    const float* kr;
                    if (is_p) kr = krot + (size_t)(b * SEQ + kj) * ATT_WIDTH + h * 64;
                    else kr = (kj >= WBUF) ? krot + (size_t)(T_PROMPT + b * DEC_SEQ + (kj - WBUF)) * ATT_WIDTH + h * 64
                                           : ck + ((size_t)b * WBUF + kj) * ATT_WIDTH + h * 64;
                    float a = 0.f;
#pragma unroll
                    for (int c = 0; c < 64; c += 4) { float4 kv = *(const float4*)(kr + c); a += kv.x * sq[w][c] + kv.y * sq[w][c + 1] + kv.z * sq[w][c + 2] + kv.w * sq[w][c + 3]; }
                    s = a * 0.125f;
                }
                sc[pt][sl] = s; mx = fmaxf(mx, s);
            }
        }
        mx = wave_max(mx);
        float lsum = 0.f;
#pragma unroll
        for (int pt = 0; pt < 3; ++pt)
#pragma unroll
            for (int sl = 0; sl < 3; ++sl) { float pv = (sc[pt][sl] == -INFINITY) ? 0.f : __expf(sc[pt][sl] - mx); sc[pt][sl] = pv; lsum += pv; }
        lsum = wave_sum(lsum);
        float o = 0.f;
#pragma unroll
        for (int pt = 0; pt < 3; ++pt) {
            const int d = pt == 0 ? 1 : (pt == 1 ? 4 : 16);
#pragma unroll
            for (int sl = 0; sl < 3; ++sl) {
                const int mend = sl < 2 ? 64 : 1;
                for (int ml = 0; ml < mend; ++ml) {
                    const int m = ml + sl * 64;
                    const int kj = qi - d * m;
                    const float pv = __shfl(sc[pt][sl], ml);
                    if (kj < 0) continue;
                    const float* vr;
                    if (is_p) vr = proj + (size_t)(b * SEQ + kj) * PROJ_LD + O_V + h * 64;
                    else vr = (kj >= WBUF) ? proj + (size_t)(T_PROMPT + b * DEC_SEQ + (kj - WBUF)) * PROJ_LD + O_V + h * 64
                                           : cv + ((size_t)b * WBUF + kj) * ATT_WIDTH + h * 64;
                    o += pv * vr[lane];
                }
            }
        }
        ybuf[(size_t)t * MIX_WIDTH + SSD_WIDTH + h * 64 + lane] = o / lsum;
    }
}

__device__ __forceinline__ void ph_ln_res(const float* __restrict__ xp, const float* __restrict__ xs, const bf16* __restrict__ add, const float* __restrict__ gam,
                                          const float* __restrict__ bet, bf16* __restrict__ dstb) {
    const int lane = threadIdx.x & 63;
#pragma unroll 2
    for (int t = blockIdx.x * NWAVE + (threadIdx.x >> 6); t < T_ALL; t += gridDim.x * NWAVE) {
        const float* res = (t < T_PROMPT) ? xp + (size_t)t * D_MODEL : xs + (size_t)(t - T_PROMPT) * D_MODEL;
        float v[16]; float s = 0.f;
#pragma unroll
        for (int j = 0; j < 2; ++j) { const int c = j * 512 + lane * 8; const float4 r0 = *(const float4*)(res + c), r1 = *(const float4*)(res + c + 4);
            float a8[8]; unpack8(*(const v4u*)(add + (size_t)t * D_MODEL + c), a8);
            v[8 * j] = ALPHA_F * r0.x + a8[0]; v[8 * j + 1] = ALPHA_F * r0.y + a8[1]; v[8 * j + 2] = ALPHA_F * r0.z + a8[2]; v[8 * j + 3] = ALPHA_F * r0.w + a8[3];
            v[8 * j + 4] = ALPHA_F * r1.x + a8[4]; v[8 * j + 5] = ALPHA_F * r1.y + a8[5]; v[8 * j + 6] = ALPHA_F * r1.z + a8[6]; v[8 * j + 7] = ALPHA_F * r1.w + a8[7]; }
#pragma unroll
        for (int j = 0; j < 16; ++j) s += v[j];
        s = wave_sum(s);
        const float mu = s * (1.0f / 1024.0f);
        float q = 0.f;
#pragma unroll
        for (int j = 0; j < 16; ++j) { v[j] -= mu; q += v[j] * v[j]; }
        q = wave_sum(q);
        const float r = rsqrtf(q * (1.0f / 1024.0f) + LN_EPS);
#pragma unroll
        for (int j = 0; j < 2; ++j) { const int c = j * 512 + lane * 8; const float4 g0 = *(const float4*)(gam + c), g1 = *(const float4*)(gam + c + 4), b0 = *(const float4*)(bet + c), b1 = *(const float4*)(bet + c + 4);
            v4u o; o.x = pk2(v[8 * j] * r * g0.x + b0.x, v[8 * j + 1] * r * g0.y + b0.y); o.y = pk2(v[8 * j + 2] * r * g0.z + b0.z, v[8 * j + 3] * r * g0.w + b0.w);
            o.z = pk2(v[8 * j + 4] * r * g1.x + b1.x, v[8 * j + 5] * r * g1.y + b1.y); o.w = pk2(v[8 * j + 6] * r * g1.z + b1.z, v[8 * j + 7] * r * g1.w + b1.w);
            *(v4u*)(dstb + (size_t)t * D_MODEL + c) = o; }
    }
}

__device__ __forceinline__ void ph_peer_route(float* lds, const float* __restrict__ qh, const float* __restrict__ keys1, const float* __restrict__ keys2,
                                              int* __restrict__ eidx, float* __restrict__ gate) {
    float (*sq)[256] = (float (*)[256])lds;
    float (*sv)[2][16] = (float (*)[2][16])(lds + NWAVE * 256);
    int (*si)[2][16] = (int (*)[2][16])(lds + NWAVE * 256 + NWAVE * 32);
    const int w = threadIdx.x >> 6, lane = threadIdx.x & 63;
    for (int vb = blockIdx.x; vb < T_ALL * 8 / NWAVE; vb += gridDim.x) {
        const int item = vb * NWAVE + w;
        const int t = item >> 3, h = item & 7;
        __syncthreads();
        for (int c = lane; c < 256; c += 64) sq[w][c] = qh[(size_t)t * 2048 + h * 256 + c];
        __syncthreads();
#pragma unroll
        for (int half = 0; half < 2; ++half) {
            const float* keys = half ? keys2 : keys1;
            float s[2];
#pragma unroll
            for (int sl = 0; sl < 2; ++sl) {
                const float* kr = keys + (size_t)(lane + sl * 64) * 128;
                float a = 0.f;
#pragma unroll 8
                for (int c = 0; c < 128; c += 4) { float4 kv = *(const float4*)(kr + c); const float* qq = &sq[w][half * 128 + c]; a += kv.x * qq[0] + kv.y * qq[1] + kv.z * qq[2] + kv.w * qq[3]; }
                s[sl] = a;
            }
            for (int r = 0; r < 16; ++r) {
                float bv; int bi;
                if (s[0] >= s[1]) { bv = s[0]; bi = lane; } else { bv = s[1]; bi = lane + 64; }
#pragma unroll
                for (int o = 32; o > 0; o >>= 1) {
                    float ov = __shfl_xor(bv, o); int oi = __shfl_xor(bi, o);
                    if (ov > bv || (ov == bv && oi < bi)) { bv = ov; bi = oi; }
                }
                if (lane == 0) { sv[w][half][r] = bv; si[w][half][r] = bi; }
                if (bi == lane) s[0] = -INFINITY;
                if (bi == lane + 64) s[1] = -INFINITY;
            }
        }
        __syncthreads();
        float c[4];
#pragma unroll
        for (int j = 0; j < 4; ++j) { int ci = lane * 4 + j; c[j] = sv[w][0][ci >> 4] + sv[w][1][ci & 15]; }
        float myv = 0.f; int myc = 0;
        for (int r = 0; r < 16; ++r) {
            float bv = c[0]; int bi = lane * 4;
#pragma unroll
            for (int j = 1; j < 4; ++j) if (c[j] > bv) { bv = c[j]; bi = lane * 4 + j; }
#pragma unroll
            for (int o = 32; o > 0; o >>= 1) {
                float ov = __shfl_xor(bv, o); int oi = __shfl_xor(bi, o);
                if (ov > bv || (ov == bv && oi < bi)) { bv = ov; bi = oi; }
            }
            if (lane == r) { myv = bv; myc = bi; }
#pragma unroll
            for (int j = 0; j < 4; ++j) if (bi == lane * 4 + j) c[j] = -INFINITY;
        }
        float v = lane < 16 ? myv : -INFINITY;
        float mx = wave_max(v);
        float e = lane < 16 ? __expf(v - mx) : 0.f;
        float sum = wave_sum(e);
        if (lane < 16) {
            int ex = si[w][0][myc >> 4] * PEER_NKEYS + si[w][1][myc & 15];
            eidx[(size_t)t * 128 + h * 16 + lane] = ex;
            gate[(size_t)t * 128 + h * 16 + lane] = e / sum;
        }
    }
}

__device__ __forceinline__ void ph_peer_ffn(const float* __restrict__ hbuf, const int* __restrict__ eidx, const float* __restrict__ gate,
                                            const bf16* __restrict__ ub, const bf16* __restrict__ vb, const float* __restrict__ gam,
                                            const float* __restrict__ bet, float* __restrict__ out) {
    const int lane = threadIdx.x & 63;
    for (int t = blockIdx.x * NWAVE + (threadIdx.x >> 6); t < T_ALL; t += gridDim.x * NWAVE) {
        float x[16], acc[16];
        { const float* xr = hbuf + (size_t)t * D_MODEL + lane * 8;
          const float4 a = *(const float4*)xr, b = *(const float4*)(xr + 4), c = *(const float4*)(xr + 512), d = *(const float4*)(xr + 516);
          x[0] = a.x; x[1] = a.y; x[2] = a.z; x[3] = a.w; x[4] = b.x; x[5] = b.y; x[6] = b.z; x[7] = b.w;
          x[8] = c.x; x[9] = c.y; x[10] = c.z; x[11] = c.w; x[12] = d.x; x[13] = d.y; x[14] = d.z; x[15] = d.w; }
#pragma unroll
        for (int j = 0; j < 16; ++j) acc[j] = 0.f;
        for (int k = 0; k < 128; ++k) {
            const int e = eidx[(size_t)t * 128 + k];
            const float g = gate[(size_t)t * 128 + k];
            const bf16* ur = ub + (size_t)e * D_MODEL + lane * 8;
            float u0[8], u1[8];
            unpack8(*(const v4u*)ur, u0); unpack8(*(const v4u*)(ur + 512), u1);
            float d = 0.f;
#pragma unroll
            for (int j = 0; j < 8; ++j) d += u0[j] * x[j] + u1[j] * x[8 + j];
            d = wave_sum(d);
            const float wgt = g * gelu_f(d);
            const bf16* vr = vb + (size_t)e * D_MODEL + lane * 8;
            unpack8(*(const v4u*)vr, u0); unpack8(*(const v4u*)(vr + 512), u1);
#pragma unroll
            for (int j = 0; j < 8; ++j) { acc[j] += wgt * u0[j]; acc[8 + j] += wgt * u1[j]; }
        }
        float s = 0.f;
#pragma unroll
        for (int j = 0; j < 16; ++j) { acc[j] += ALPHA_F * x[j]; s += acc[j]; }
        s = wave_sum(s);
        const float mu = s * (1.0f / 1024.0f);
        float q = 0.f;
#pragma unroll
        for (int j = 0; j < 16; ++j) { acc[j] -= mu; q += acc[j] * acc[j]; }
        q = wave_sum(q);
        const float r = rsqrtf(q * (1.0f / 1024.0f) + LN_EPS);
        float* dst = ((t < T_PROMPT) ? out + OUT_YP + (size_t)t * D_MODEL : out + OUT_YS + (size_t)(t - T_PROMPT) * D_MODEL) + lane * 8;
#pragma unroll
        for (int q4 = 0; q4 < 4; ++q4) {
            const int eo = (q4 >> 1) * 512 + (q4 & 1) * 4;
            const float4 g4 = *(const float4*)(gam + lane * 8 + eo), b4 = *(const float4*)(bet + lane * 8 + eo);
            float4 o; o.x = acc[q4 * 4 + 0] * r * g4.x + b4.x; o.y = acc[q4 * 4 + 1] * r * g4.y + b4.y; o.z = acc[q4 * 4 + 2] * r * g4.z + b4.z; o.w = acc[q4 * 4 + 3] * r * g4.w + b4.w;
            *(float4*)(dst + eo) = o;
        }
    }
}

__device__ __forceinline__ float peer_dot16(const v4u a, const v4u b, const float (&x)[16]) {
    float u0[8], u1[8]; unpack8(a, u0); unpack8(b, u1);
    float d = 0.f;
#pragma unroll
    for (int j = 0; j < 8; ++j) d += u0[j] * x[j] + u1[j] * x[8 + j];
    return d;
}
#define PEER_TR_STEP(N, M) _Pragma("unroll") for (int i = 0; i < N; ++i) { const bool up = (lane & M) != 0; const float keep = up ? part[i + N] : part[i]; const float send = up ? part[i] : part[i + N]; part[i] = keep + __shfl_xor(send, M); }
__device__ __forceinline__ void ph_peer_ffn2(const float* __restrict__ hbuf, const int* __restrict__ eidx, const float* __restrict__ gate,
                                             const bf16* __restrict__ ub, const bf16* __restrict__ vb, const float* __restrict__ gam,
                                             const float* __restrict__ bet, float* __restrict__ out) {
    const int lane0 = threadIdx.x & 63;
    for (int t = blockIdx.x * NWAVE + (threadIdx.x >> 6); t < T_ALL; t += gridDim.x * NWAVE) {
        int lane = lane0; asm volatile("" : "+v"(lane));
        float x[16];
        { const float* xr = hbuf + (size_t)t * D_MODEL + lane * 8;
          const float4 a = *(const float4*)xr, b = *(const float4*)(xr + 4), c = *(const float4*)(xr + 512), d = *(const float4*)(xr + 516);
          x[0] = a.x; x[1] = a.y; x[2] = a.z; x[3] = a.w; x[4] = b.x; x[5] = b.y; x[6] = b.z; x[7] = b.w;
          x[8] = c.x; x[9] = c.y; x[10] = c.z; x[11] = c.w; x[12] = d.x; x[13] = d.y; x[14] = d.z; x[15] = d.w; }
        int ev[2]; float wv[4];
        ev[0] = eidx[(size_t)t * 128 + lane]; ev[1] = eidx[(size_t)t * 128 + 64 + lane];
#pragma unroll
        for (int rd = 0; rd < 4; ++rd) wv[rd] = gate[(size_t)t * 128 + rd * 32 + (lane >> 1)];
#pragma unroll
        for (int rd = 0; rd < 4; ++rd) {
            float part[32];
#pragma unroll
            for (int kb = 0; kb < 8; ++kb) {
                v4u ra[4], rb[4];
#pragma unroll
                for (int k8 = 0; k8 < 4; ++k8) {
                    const int e = __builtin_amdgcn_readlane(ev[rd >> 1], (rd & 1) * 32 + kb * 4 + k8);
                    const bf16* ur = ub + (size_t)e * D_MODEL + lane * 8;
                    ra[k8] = *(const v4u*)ur; rb[k8] = *(const v4u*)(ur + 512);
                }
#pragma unroll
                for (int k8 = 0; k8 < 4; ++k8) part[kb * 4 + k8] = peer_dot16(ra[k8], rb[k8], x);
            }
            PEER_TR_STEP(16, 32) PEER_TR_STEP(8, 16) PEER_TR_STEP(4, 8) PEER_TR_STEP(2, 4) PEER_TR_STEP(1, 2)
            const float hid = part[0] + __shfl_xor(part[0], 1);
            wv[rd] *= gelu_f(hid);
        }
        float acc[16];
#pragma unroll
        for (int j = 0; j < 16; ++j) acc[j] = 0.f;
#pragma unroll
        for (int rd = 0; rd < 4; ++rd) {
#pragma unroll
            for (int kb = 0; kb < 4; ++kb) {
                v4u ra[8], rb[8];
#pragma unroll
                for (int k8 = 0; k8 < 8; ++k8) {
                    const int e = __builtin_amdgcn_readlane(ev[rd >> 1], (rd & 1) * 32 + kb * 8 + k8);
                    const bf16* vr = vb + (size_t)e * D_MODEL + lane * 8;
                    ra[k8] = *(const v4u*)vr; rb[k8] = *(const v4u*)(vr + 512);
                }
#pragma unroll
                for (int k8 = 0; k8 < 8; ++k8) {
                    const float wk = __builtin_bit_cast(float, __builtin_amdgcn_readlane(__builtin_bit_cast(int, wv[rd]), 2 * (kb * 8 + k8)));
                    float u0[8], u1[8]; unpack8(ra[k8], u0); unpack8(rb[k8], u1);
#pragma unroll
                    for (int j = 0; j < 8; ++j) { acc[j] += wk * u0[j]; acc[8 + j] += wk * u1[j]; }
                }
            }
        }
        float s = 0.f;
#pragma unroll
        for (int j = 0; j < 16; ++j) { acc[j] += ALPHA_F * x[j]; s += acc[j]; }
        s = wave_sum(s);
        const float mu = s * (1.0f / 1024.0f);
        float q = 0.f;
#pragma unroll
        for (int j = 0; j < 16; ++j) { acc[j] -= mu; q += acc[j] * acc[j]; }
        q = wave_sum(q);
        const float r = rsqrtf(q * (1.0f / 1024.0f) + LN_EPS);
        float* dst = ((t < T_PROMPT) ? out + OUT_YP + (size_t)t * D_MODEL : out + OUT_YS + (size_t)(t - T_PROMPT) * D_MODEL) + lane * 8;
#pragma unroll
        for (int q4 = 0; q4 < 4; ++q4) {
            const int eo = (q4 >> 1) * 512 + (q4 & 1) * 4;
            const float4 g4 = *(const float4*)(gam + lane * 8 + eo), b4 = *(const float4*)(bet + lane * 8 + eo);
            float4 o; o.x = acc[q4 * 4 + 0] * r * g4.x + b4.x; o.y = acc[q4 * 4 + 1] * r * g4.y + b4.y; o.z = acc[q4 * 4 + 2] * r * g4.z + b4.z; o.w = acc[q4 * 4 + 3] * r * g4.w + b4.w;
            *(float4*)(dst + eo) = o;
        }
    }
}

__device__ __forceinline__ void ph_attn_sample(float* lds, const bf16* __restrict__ qrot_b, const bf16* __restrict__ krot_b, const bf16* __restrict__ projb,
                                               const float* __restrict__ ck, const float* __restrict__ cv, bf16* __restrict__ A1) {
    float (*sq)[64] = (float (*)[64])lds;
    const int w = threadIdx.x >> 6, lane0 = threadIdx.x & 63;
    for (int vb = blockIdx.x; vb < T_SAMPLE * 8 / NWAVE; vb += gridDim.x) {
        int lane = lane0; asm volatile("" : "+v"(lane));
        const int item = vb * NWAVE + w, ts = item >> 3, hd = item & 7, b = ts >> 2, i = ts & 3, t = T_PROMPT + ts;
        __syncthreads();
        sq[w][lane] = bf2f(qrot_b[(size_t)t * ATT_WIDTH + hd * 64 + lane]);
        __syncthreads();
        const int qi = WBUF + i;
        float sc[8];
        float mx = -INFINITY;
#pragma unroll
        for (int slot = 0; slot < 7; ++slot) {
            const int pt = slot < 6 ? (slot >> 1) : (lane < 3 ? lane : 0);
            const int m = slot < 6 ? lane + 64 * (slot & 1) : 128;
            const int kj = qi - (m << (2 * pt));
            const bool valid = (slot < 6 || lane < 3) && kj < WBUF;
            const int kc = kj < WBUF ? kj : WBUF - 1;
            const float* kr = ck + ((size_t)b * WBUF + kc) * ATT_WIDTH + hd * 64;
            float a = 0.f;
#pragma unroll
            for (int c = 0; c < 64; c += 4) { const float4 kv = *(const float4*)(kr + c); a += kv.x * sq[w][c] + kv.y * sq[w][c + 1] + kv.z * sq[w][c + 2] + kv.w * sq[w][c + 3]; }
            const float s = valid ? a * 0.125f : -INFINITY;
            sc[slot] = s; mx = fmaxf(mx, s);
        }
        const int nt7 = lane <= i ? i - lane : i;
        const bool valid7 = lane < i + 3;
        {
            const bf16* kr = krot_b + (size_t)(T_PROMPT + b * DEC_SEQ + nt7) * ATT_WIDTH + hd * 64;
            float a = 0.f;
#pragma unroll
            for (int c = 0; c < 64; c += 8) { float f[8]; unpack8(*(const v4u*)(kr + c), f);
#pragma unroll
                for (int j = 0; j < 8; ++j) a += f[j] * sq[w][c + j]; }
            const float s = valid7 ? a * 0.125f : -INFINITY;
            sc[7] = s; mx = fmaxf(mx, s);
        }
        mx = wave_max(mx);
        float lsum = 0.f;
#pragma unroll
        for (int slot = 0; slot < 8; ++slot) { const float pv = __expf(sc[slot] - mx); sc[slot] = pv; lsum += pv; }
        lsum = wave_sum(lsum);
        float part[64];
#pragma unroll
        for (int c = 0; c < 64; ++c) part[c] = 0.f;
#pragma unroll
        for (int slot = 0; slot < 7; ++slot) {
            const int pt = slot < 6 ? (slot >> 1) : (lane < 3 ? lane : 0);
            const int m = slot < 6 ? lane + 64 * (slot & 1) : 128;
            const int kj = qi - (m << (2 * pt));
            const int kc = kj < WBUF ? kj : WBUF - 1;
            const float pv = sc[slot];
            const float* vr = cv + ((size_t)b * WBUF + kc) * ATT_WIDTH + hd * 64;
#pragma unroll
            for (int c = 0; c < 64; c += 4) { const float4 vv = *(const float4*)(vr + c); part[c] += pv * vv.x; part[c + 1] += pv * vv.y; part[c + 2] += pv * vv.z; part[c + 3] += pv * vv.w; }
        }
        {
            const float pv = sc[7];
            const bf16* vr = projb + (size_t)(T_PROMPT + b * DEC_SEQ + nt7) * NB_LD + NB_V + hd * 64;
#pragma unroll
            for (int c = 0; c < 64; c += 8) { float f[8]; unpack8(*(const v4u*)(vr + c), f);
#pragma unroll
                for (int j = 0; j < 8; ++j) part[c + j] += pv * f[j]; }
        }
        PEER_TR_STEP(32, 32) PEER_TR_STEP(16, 16) PEER_TR_STEP(8, 8) PEER_TR_STEP(4, 4) PEER_TR_STEP(2, 2) PEER_TR_STEP(1, 1)
        A1[(size_t)t * MIX_WIDTH + SSD_WIDTH + hd * 64 + lane] = (bf16)f2bf(part[0] / lsum);
    }
}


__device__ __forceinline__ void cache_copy_slice(const float* __restrict__ ck, const float* __restrict__ cv, float* __restrict__ out, unsigned slice, unsigned lane) {
    constexpr unsigned PER_B = (WBUF - DEC_SEQ) * ATT_WIDTH / 4;
    constexpr unsigned TOTAL = 2u * DEC_BATCH * PER_B;
#pragma unroll 1
    for (unsigned bt = 0; bt < 8; ++bt) {
        f32x4n v[8]; size_t dsti[8]; bool isv[8]; bool ok[8];
#pragma unroll
        for (int j = 0; j < 8; ++j) {
            const unsigned idx = slice * 4096u + bt * 512u + j * 64u + lane;
            ok[j] = idx < TOTAL;
            const unsigned idc = ok[j] ? idx : 0u;
            const unsigned tb = idc / PER_B, r = idc - tb * PER_B, bb = tb & (DEC_BATCH - 1);
            isv[j] = tb >= DEC_BATCH;
            const size_t srci = (size_t)bb * (WBUF * ATT_WIDTH / 4) + (DEC_SEQ * ATT_WIDTH / 4) + r;
            dsti[j] = (size_t)bb * (WBUF * ATT_WIDTH / 4) + r;
            v[j] = __builtin_nontemporal_load((isv[j] ? (const f32x4n*)cv : (const f32x4n*)ck) + srci);
        }
#pragma unroll
        for (int j = 0; j < 8; ++j) if (ok[j]) __builtin_nontemporal_store(v[j], (f32x4n*)(out + (isv[j] ? OUT_SV : OUT_SK)) + dsti[j]);
    }
}
typedef float f32x2v __attribute__((ext_vector_type(2)));
__device__ __forceinline__ void ph_quant_tables(const float* __restrict__ pu, const float* __restrict__ pv, unsigned char* __restrict__ ub8, unsigned char* __restrict__ vb8,
                                                float* __restrict__ usc, float* __restrict__ vsc, int rank, int nranks) {
    const int lane = threadIdx.x & 63;
#pragma unroll 2
    for (int row = rank * NWAVE + (threadIdx.x >> 6); row < 2 * 16384; row += nranks * NWAVE) {
        const int rr = row & 16383; const bool isv = row >= 16384;
        const float* src = (isv ? pv : pu) + (size_t)rr * D_MODEL + lane * 8;
        const float4 a = *(const float4*)src, b = *(const float4*)(src + 4), c = *(const float4*)(src + 512), d = *(const float4*)(src + 516);
        float am = fmaxf(fmaxf(fmaxf(fabsf(a.x), fabsf(a.y)), fmaxf(fabsf(a.z), fabsf(a.w))), fmaxf(fmaxf(fabsf(b.x), fabsf(b.y)), fmaxf(fabsf(b.z), fabsf(b.w))));
        am = fmaxf(am, fmaxf(fmaxf(fmaxf(fabsf(c.x), fabsf(c.y)), fmaxf(fabsf(c.z), fabsf(c.w))), fmaxf(fmaxf(fabsf(d.x), fabsf(d.y)), fmaxf(fabsf(d.z), fabsf(d.w)))));
        am = wave_max(am);
        const float sc = am > 0.f ? 224.0f / am : 1.0f;
        v4u o;
        o.x = (unsigned)__builtin_amdgcn_cvt_pk_fp8_f32(a.z * sc, a.w * sc, __builtin_amdgcn_cvt_pk_fp8_f32(a.x * sc, a.y * sc, 0, false), true);
        o.y = (unsigned)__builtin_amdgcn_cvt_pk_fp8_f32(b.z * sc, b.w * sc, __builtin_amdgcn_cvt_pk_fp8_f32(b.x * sc, b.y * sc, 0, false), true);
        o.z = (unsigned)__builtin_amdgcn_cvt_pk_fp8_f32(c.z * sc, c.w * sc, __builtin_amdgcn_cvt_pk_fp8_f32(c.x * sc, c.y * sc, 0, false), true);
        o.w = (unsigned)__builtin_amdgcn_cvt_pk_fp8_f32(d.z * sc, d.w * sc, __builtin_amdgcn_cvt_pk_fp8_f32(d.x * sc, d.y * sc, 0, false), true);
        *(v4u*)((isv ? vb8 : ub8) + (size_t)rr * 1024 + lane * 16) = o;
        if (lane == 0) (isv ? vsc : usc)[rr] = am > 0.f ? am * (1.0f / 224.0f) : 1.0f;
    }
}
__device__ __forceinline__ void unpack16_fp8(const v4u w, float (&f)[16]) {
#pragma unroll
    for (int i = 0; i < 4; ++i) {
        const f32x2v lo = __builtin_amdgcn_cvt_pk_f32_fp8((int)w[i], false), hi = __builtin_amdgcn_cvt_pk_f32_fp8((int)w[i], true);
        f[4 * i] = lo[0]; f[4 * i + 1] = lo[1]; f[4 * i + 2] = hi[0]; f[4 * i + 3] = hi[1];
    }
}
__device__ __forceinline__ void ph_peer_ffn3(const bf16* __restrict__ hb, const int* __restrict__ eidx, const float* __restrict__ gate,
                                             const unsigned char* __restrict__ ub8, const unsigned char* __restrict__ vb8, const float* __restrict__ usc, const float* __restrict__ vsc,
                                             const float* __restrict__ gam, const float* __restrict__ bet, float* __restrict__ out,
                                             const float* __restrict__ ck, const float* __restrict__ cv, unsigned n9) {
    const int lane0 = threadIdx.x & 63;
    unsigned it = 0;
    for (int t = blockIdx.x * NWAVE + (threadIdx.x >> 6); t < T_ALL; t += gridDim.x * NWAVE, ++it) {
        int lane = lane0; asm volatile("" : "+v"(lane));
        { const unsigned sl = (blockIdx.x * NWAVE + (threadIdx.x >> 6)) + it * (gridDim.x * NWAVE); if (it < 8 && sl < n9) cache_copy_slice(ck, cv, out, sl, (unsigned)lane); }
        const unsigned lo16 = (unsigned)lane * 16u, lo8 = (unsigned)lane * 8u;
        float x[16];
        { float f0[8], f1[8]; const bf16* xr = hb + (size_t)t * D_MODEL + lo8; unpack8(*(const v4u*)xr, f0); unpack8(*(const v4u*)(xr + 512), f1);
#pragma unroll
          for (int j = 0; j < 8; ++j) { x[j] = f0[j]; x[8 + j] = f1[j]; } }
        int ev[2]; float wv[4], su[4];
        ev[0] = eidx[(size_t)t * 128 + lane]; ev[1] = eidx[(size_t)t * 128 + 64 + lane];
#pragma unroll
        for (int rd = 0; rd < 4; ++rd) {
            const int er = eidx[(size_t)t * 128 + rd * 32 + (lane >> 1)];
            wv[rd] = gate[(size_t)t * 128 + rd * 32 + (lane >> 1)] * vsc[er];
            su[rd] = usc[er];
        }
#pragma unroll
        for (int rd = 0; rd < 4; ++rd) {
            float part[32];
#pragma unroll
            for (int kb = 0; kb < 8; ++kb) {
                v4u ra[4];
#pragma unroll
                for (int k8 = 0; k8 < 4; ++k8) {
                    const int e = __builtin_amdgcn_readlane(ev[rd >> 1], (rd & 1) * 32 + kb * 4 + k8);
                    ra[k8] = *(const v4u*)(ub8 + (size_t)e * 1024 + lo16);
                }
#pragma unroll
                for (int k8 = 0; k8 < 4; ++k8) {
                    float f[16]; unpack16_fp8(ra[k8], f);
                    float d = 0.f;
#pragma unroll
                    for (int j = 0; j < 16; ++j) d += f[j] * x[j];
                    part[kb * 4 + k8] = d;
                    if (k8 & 1) __builtin_amdgcn_sched_barrier(0);
                }
            }
            PEER_TR_STEP(16, 32) PEER_TR_STEP(8, 16) PEER_TR_STEP(4, 8) PEER_TR_STEP(2, 4) PEER_TR_STEP(1, 2)
            const float hid = (part[0] + __shfl_xor(part[0], 1)) * su[rd];
            wv[rd] *= gelu_f(hid);
        }
        float acc[16];
#pragma unroll
        for (int j = 0; j < 16; ++j) acc[j] = 0.f;
#pragma unroll
        for (int rd = 0; rd < 4; ++rd) {
#pragma unroll
            for (int kb = 0; kb < 4; ++kb) {
                v4u ra[8];
#pragma unroll
                for (int k8 = 0; k8 < 8; ++k8) {
                    const int e = __builtin_amdgcn_readlane(ev[rd >> 1], (rd & 1) * 32 + kb * 8 + k8);
                    ra[k8] = *(const v4u*)(vb8 + (size_t)e * 1024 + lo16);
                }
#pragma unroll
                for (int k8 = 0; k8 < 8; ++k8) {
                    const float wk = __builtin_bit_cast(float, __builtin_amdgcn_readlane(__builtin_bit_cast(int, wv[rd]), 2 * (kb * 8 + k8)));
                    float f[16]; unpack16_fp8(ra[k8], f);
#pragma unroll
                    for (int j = 0; j < 16; ++j) acc[j] += wk * f[j];
                    if (k8 & 1) __builtin_amdgcn_sched_barrier(0);
                }
            }
        }
        float s = 0.f;
#pragma unroll
        for (int j = 0; j < 16; ++j) { acc[j] += ALPHA_F * x[j]; s += acc[j]; }
        s = wave_sum(s);
        const float mu = s * (1.0f / 1024.0f);
        float q = 0.f;
#pragma unroll
        for (int j = 0; j < 16; ++j) { acc[j] -= mu; q += acc[j] * acc[j]; }
        q = wave_sum(q);
        const float r = rsqrtf(q * (1.0f / 1024.0f) + LN_EPS);
        float* dst = ((t < T_PROMPT) ? out + OUT_YP + (size_t)t * D_MODEL : out + OUT_YS + (size_t)(t - T_PROMPT) * D_MODEL) + lo8;
#pragma unroll
        for (int q4 = 0; q4 < 4; ++q4) {
            const int eo = (q4 >> 1) * 512 + (q4 & 1) * 4;
            const float4 g4 = *(const float4*)(gam + lo8 + eo), b4 = *(const float4*)(bet + lo8 + eo);
            float4 o; o.x = acc[q4 * 4 + 0] * r * g4.x + b4.x; o.y = acc[q4 * 4 + 1] * r * g4.y + b4.y; o.z = acc[q4 * 4 + 2] * r * g4.z + b4.z; o.w = acc[q4 * 4 + 3] * r * g4.w + b4.w;
            *(float4*)(dst + eo) = o;
        }
    }
}


__device__ __forceinline__ void ssd_decode_load(const bf16* __restrict__ xbc_b, const float* __restrict__ dtv, const float* __restrict__ state_ssm, int item, int p, int ng,
                                                float (&hs)[16], v4u (&bq)[4][2], v4u (&cq)[4][2], float (&xv)[4], float (&dv)[4]) {
    const int sb = item / SSD_HEADS, h = item - sb * SSD_HEADS, g = h / 6, t0 = T_PROMPT + sb * DEC_SEQ;
    const float* s0 = state_ssm + (((size_t)sb * SSD_HEADS + h) * 64 + p) * 128 + ng * 16;
#pragma unroll
    for (int j = 0; j < 4; ++j) { const float4 v = *(const float4*)(s0 + 4 * j); hs[4 * j] = v.x; hs[4 * j + 1] = v.y; hs[4 * j + 2] = v.z; hs[4 * j + 3] = v.w; }
#pragma unroll
    for (int s = 0; s < 4; ++s) {
        const bf16* row = xbc_b + (size_t)(t0 + s) * CONV_DIM;
        bq[s][0] = *(const v4u*)(row + 1536 + g * 128 + ng * 16); bq[s][1] = *(const v4u*)(row + 1536 + g * 128 + ng * 16 + 8);
        cq[s][0] = *(const v4u*)(row + 2048 + g * 128 + ng * 16); cq[s][1] = *(const v4u*)(row + 2048 + g * 128 + ng * 16 + 8);
        xv[s] = bf2f(row[h * 64 + p]); dv[s] = dtv[(size_t)(t0 + s) * SSD_HEADS + h];
    }
}
__device__ __forceinline__ void ssd_decode_compute(const float* __restrict__ a_log, const float* __restrict__ d_skip, int item, int p, int ng,
                                                   float (&hs)[16], const v4u (&bq)[4][2], const v4u (&cq)[4][2], const float (&xv)[4], const float (&dv)[4],
                                                   float* __restrict__ ybuf, float* __restrict__ out) {
    const int sb = item / SSD_HEADS, h = item - sb * SSD_HEADS, t0 = T_PROMPT + sb * DEC_SEQ;
    const float A = -__expf(a_log[h]), D = d_skip[h];
#pragma unroll
    for (int s = 0; s < 4; ++s) {
        float Bf[16], Cf[16];
        { float t8[8]; unpack8(bq[s][0], t8);
#pragma unroll
          for (int j = 0; j < 8; ++j) Bf[j] = t8[j];
          unpack8(bq[s][1], t8);
#pragma unroll
          for (int j = 0; j < 8; ++j) Bf[8 + j] = t8[j];
          unpack8(cq[s][0], t8);
#pragma unroll
          for (int j = 0; j < 8; ++j) Cf[j] = t8[j];
          unpack8(cq[s][1], t8);
#pragma unroll
          for (int j = 0; j < 8; ++j) Cf[8 + j] = t8[j]; }
        const float a = __expf(dv[s] * A), xdt = xv[s] * dv[s];
        float y = 0.f;
#pragma unroll
        for (int j = 0; j < 16; ++j) { hs[j] = a * hs[j] + xdt * Bf[j]; y += Cf[j] * hs[j]; }
        y += __shfl_xor(y, 1); y += __shfl_xor(y, 2); y += __shfl_xor(y, 4);
        if (ng == 0) ybuf[(size_t)(t0 + s) * MIX_WIDTH + h * 64 + p] = y + D * xv[s];
    }
    float* so = out + OUT_SS + (((size_t)sb * SSD_HEADS + h) * 64 + p) * 128 + ng * 16;
#pragma unroll
    for (int j = 0; j < 4; ++j) *(float4*)(so + 4 * j) = make_float4(hs[4 * j], hs[4 * j + 1], hs[4 * j + 2], hs[4 * j + 3]);
}
__device__ __forceinline__ void ph_ssd_decode(const bf16* __restrict__ xbc_b, const float* __restrict__ dtv, const float* __restrict__ a_log, const float* __restrict__ d_skip,
                                              const float* __restrict__ state_ssm, float* __restrict__ ybuf, float* __restrict__ out) {
    const int tid = threadIdx.x, p = tid >> 3, ng = tid & 7;
    constexpr int NITEM = DEC_BATCH * SSD_HEADS;
    for (int it = blockIdx.x; it < NITEM; it += 2 * gridDim.x) {
        const int it2 = it + gridDim.x; const bool has2 = it2 < NITEM; const int it2c = has2 ? it2 : it;
        float hsA[16], hsB[16], xA[4], xB[4], dA[4], dB[4]; v4u bA[4][2], cA[4][2], bB[4][2], cB[4][2];
        ssd_decode_load(xbc_b, dtv, state_ssm, it, p, ng, hsA, bA, cA, xA, dA);
        ssd_decode_load(xbc_b, dtv, state_ssm, it2c, p, ng, hsB, bB, cB, xB, dB);
        ssd_decode_compute(a_log, d_skip, it, p, ng, hsA, bA, cA, xA, dA, ybuf, out);
        if (has2) ssd_decode_compute(a_log, d_skip, it2, p, ng, hsB, bB, cB, xB, dB, ybuf, out);
    }
}

__device__ __forceinline__ float samp_cw(int d) { return (float)((int)(d >= 0 && d <= 128) + (int)(d >= 0 && (d & 3) == 0 && d <= 512) + (int)(d >= 0 && (d & 15) == 0 && d <= 2048)); }
__device__ __forceinline__ void samp_update(float sv, float cw, const float (&vrow)[64], float& m, float& l, float (&part)[64]) {
    const float mn = fmaxf(m, sv), alpha = __expf(m - mn), p = cw * __expf(sv - mn);
    m = mn; l = l * alpha + p;
#pragma unroll
    for (int c = 0; c < 64; ++c) part[c] = part[c] * alpha + p * vrow[c];
}
__device__ __forceinline__ void ph_attn_sample3(float* lds, const bf16* __restrict__ qrot_b, const bf16* __restrict__ krot_b, const bf16* __restrict__ projb,
                                                const float* __restrict__ ck, const float* __restrict__ cv, bf16* __restrict__ A1) {
    const int lane0 = threadIdx.x & 63, w = __builtin_amdgcn_readfirstlane(threadIdx.x >> 6);
    float* sq = lds + w * 256;
    for (int item = blockIdx.x + gridDim.x * w; item < DEC_BATCH * ATT_HEADS; item += gridDim.x * NWAVE) {
        int lane = lane0; asm volatile("" : "+v"(lane));
        const int b = item >> 3, hd = item & 7, qi = lane & 3, g = lane >> 2;
        const int tq0 = T_PROMPT + b * DEC_SEQ;
#pragma unroll
        for (int i = 0; i < 4; ++i) sq[i * 64 + lane] = bf2f(qrot_b[(size_t)(tq0 + i) * ATT_WIDTH + hd * 64 + lane]);
        asm volatile("s_waitcnt lgkmcnt(0)" ::: "memory");
        const float* qv = sq + qi * 64;
        const float* ckb = ck + (size_t)b * WBUF * ATT_WIDTH + hd * 64; const float* cvb = cv + (size_t)b * WBUF * ATT_WIDTH + hd * 64;
        float m = -1e30f, l = 0.f, part[64];
#pragma unroll
        for (int c = 0; c < 64; ++c) part[c] = 0.f;
        {
            const int P = 2051 - g;
            const float cw = samp_cw(WBUF + qi - P);
            const bool isn = P >= WBUF;
            const int nt = isn ? P - WBUF : 0, Pc = isn ? WBUF - 1 : P;
            const bf16* kn = krot_b + (size_t)(tq0 + nt) * ATT_WIDTH + hd * 64; const float* kr = ckb + (size_t)Pc * ATT_WIDTH;
            float a = 0.f;
#pragma unroll
            for (int c = 0; c < 64; c += 8) { float f[8]; unpack8(*(const v4u*)(kn + c), f); const float4 k0 = *(const float4*)(kr + c), k1 = *(const float4*)(kr + c + 4);
                a += (isn ? f[0] : k0.x) * qv[c] + (isn ? f[1] : k0.y) * qv[c + 1] + (isn ? f[2] : k0.z) * qv[c + 2] + (isn ? f[3] : k0.w) * qv[c + 3]
                   + (isn ? f[4] : k1.x) * qv[c + 4] + (isn ? f[5] : k1.y) * qv[c + 5] + (isn ? f[6] : k1.z) * qv[c + 6] + (isn ? f[7] : k1.w) * qv[c + 7]; }
            const float sv = cw > 0.f ? a * 0.125f : -1e30f;
            const bf16* vn = projb + (size_t)(tq0 + nt) * NB_LD + NB_V + hd * 64; const float* vr = cvb + (size_t)Pc * ATT_WIDTH;
            float vrow[64];
#pragma unroll
            for (int c = 0; c < 64; c += 8) { float f[8]; unpack8(*(const v4u*)(vn + c), f); const float4 v0 = *(const float4*)(vr + c), v1 = *(const float4*)(vr + c + 4);
                vrow[c] = isn ? f[0] : v0.x; vrow[c + 1] = isn ? f[1] : v0.y; vrow[c + 2] = isn ? f[2] : v0.z; vrow[c + 3] = isn ? f[3] : v0.w;
                vrow[c + 4] = isn ? f[4] : v1.x; vrow[c + 5] = isn ? f[5] : v1.y; vrow[c + 6] = isn ? f[6] : v1.z; vrow[c + 7] = isn ? f[7] : v1.w; }
            samp_update(sv, cw, vrow, m, l, part);
        }
#pragma unroll 1
        for (int s = 1; s < 21; ++s) {
            const int P = s < 9 ? 2051 - (16 * s + g) : (s < 15 ? 1536 + 64 * (s - 9) + lane : qi + 16 * (16 * (s - 15) + g));
            const float cw = (s < 9 && P < 1920) ? 0.f : samp_cw(WBUF + qi - P);
            const float* kr = ckb + (size_t)P * ATT_WIDTH;
            float a = 0.f;
#pragma unroll
            for (int c = 0; c < 64; c += 4) { const float4 kv = *(const float4*)(kr + c); a += kv.x * qv[c] + kv.y * qv[c + 1] + kv.z * qv[c + 2] + kv.w * qv[c + 3]; }
            const float sv = cw > 0.f ? a * 0.125f : -1e30f;
            __builtin_amdgcn_sched_barrier(0);
            const float* vr = cvb + (size_t)P * ATT_WIDTH;
            float vrow[64];
#pragma unroll
            for (int c = 0; c < 64; c += 4) { const float4 vv = *(const float4*)(vr + c); vrow[c] = vv.x; vrow[c + 1] = vv.y; vrow[c + 2] = vv.z; vrow[c + 3] = vv.w; }
            samp_update(sv, cw, vrow, m, l, part);
        }
        float M = m;
        M = fmaxf(M, __shfl_xor(M, 4)); M = fmaxf(M, __shfl_xor(M, 8)); M = fmaxf(M, __shfl_xor(M, 16)); M = fmaxf(M, __shfl_xor(M, 32));
        const float sc = __expf(m - M);
        float lsum = l * sc;
        lsum += __shfl_xor(lsum, 4); lsum += __shfl_xor(lsum, 8); lsum += __shfl_xor(lsum, 16); lsum += __shfl_xor(lsum, 32);
#pragma unroll
        for (int c = 0; c < 64; ++c) part[c] *= sc;
        PEER_TR_STEP(32, 32) PEER_TR_STEP(16, 16) PEER_TR_STEP(8, 8) PEER_TR_STEP(4, 4)
        const float inv = 1.0f / lsum;
        *(uint2*)(A1 + (size_t)(tq0 + qi) * MIX_WIDTH + SSD_WIDTH + hd * 64 + 4 * g) = make_uint2(pk2(part[0] * inv, part[1] * inv), pk2(part[2] * inv, part[3] * inv));
    }
}

typedef float f32x16 __attribute__((ext_vector_type(16)));
typedef short s16x8 __attribute__((ext_vector_type(8)));
typedef short s16x4 __attribute__((ext_vector_type(4)));
typedef float f32x4v __attribute__((ext_vector_type(4)));
#define SSD_L_ACS 0
#define SSD_L_DTS 3072
#define SSD_L_BM 6144
#define SSD_RS_B 272
#define SSD_L_X (6144 + 128 * 272)
#define SSD_RS_X 144
#define SSD_XIMG (128 * 144)
#define SSD_RS_Y 784
template <int OFF0, int OFF1>
__device__ __forceinline__ s16x8 tr_frag(unsigned base) {
    s16x4 a, b;
    asm volatile("ds_read_b64_tr_b16 %0, %2 offset:%3\n\tds_read_b64_tr_b16 %1, %2 offset:%4\n\ts_waitcnt lgkmcnt(0)"
                 : "=&v"(a), "=&v"(b) : "v"(base), "n"(OFF0), "n"(OFF1) : "memory");
    return __builtin_shufflevector(a, b, 0, 1, 2, 3, 4, 5, 6, 7);
}
__device__ __forceinline__ unsigned lds_addr(LAS unsigned char* p) { return (unsigned)(size_t)p; }
template <int O0, int O1, int O2, int O3, int O4, int O5, int O6, int O7>
__device__ __forceinline__ void tr_read8(unsigned base, s16x4 (&v)[8]) {
    asm volatile("ds_read_b64_tr_b16 %0, %8 offset:%9\n\tds_read_b64_tr_b16 %1, %8 offset:%10\n\tds_read_b64_tr_b16 %2, %8 offset:%11\n\tds_read_b64_tr_b16 %3, %8 offset:%12\n\t"
                 "ds_read_b64_tr_b16 %4, %8 offset:%13\n\tds_read_b64_tr_b16 %5, %8 offset:%14\n\tds_read_b64_tr_b16 %6, %8 offset:%15\n\tds_read_b64_tr_b16 %7, %8 offset:%16\n\ts_waitcnt lgkmcnt(0)"
                 : "=&v"(v[0]), "=&v"(v[1]), "=&v"(v[2]), "=&v"(v[3]), "=&v"(v[4]), "=&v"(v[5]), "=&v"(v[6]), "=&v"(v[7])
                 : "v"(base), "n"(O0), "n"(O1), "n"(O2), "n"(O3), "n"(O4), "n"(O5), "n"(O6), "n"(O7) : "memory");
}
#define TRCAT(a, b) __builtin_shufflevector(a, b, 0, 1, 2, 3, 4, 5, 6, 7)


__device__ __forceinline__ void ssd_chunk_acs(LAS unsigned char* ldsb, const float* __restrict__ dtv, const float* __restrict__ a_log, int t0, int g, float* cdec_out) {
    const int w = __builtin_amdgcn_readfirstlane(threadIdx.x >> 6), lane = threadIdx.x & 63;
    if (w < 6) {
        const int head = 6 * g + w;
        const float A = -__expf(a_log[head]);
        const float v0 = dtv[(size_t)(t0 + 2 * lane) * SSD_HEADS + head], v1 = dtv[(size_t)(t0 + 2 * lane + 1) * SSD_HEADS + head];
        const float a1 = v1 * A;
        float s = v0 * A + a1;
#pragma unroll
        for (int o = 1; o < 64; o <<= 1) { const float tmp = __shfl_up(s, o); if (lane >= o) s += tmp; }
        LAS float* acs = (LAS float*)(ldsb + SSD_L_ACS) + w * 128;
        LAS float* dts = (LAS float*)(ldsb + SSD_L_DTS) + w * 128;
        acs[2 * lane] = s - a1; acs[2 * lane + 1] = s;
        dts[2 * lane] = v0; dts[2 * lane + 1] = v1;
        if (cdec_out && lane == 63) cdec_out[head] = __expf(s);
    }
}

__device__ __forceinline__ void ph_ssd_states(LAS unsigned char* ldsb, const bf16* __restrict__ xbc_b, const float* __restrict__ dtv, const float* __restrict__ a_log,
                                              bf16* __restrict__ Sbuf, float* __restrict__ cdec) {
    const int tid = threadIdx.x, w = __builtin_amdgcn_readfirstlane(tid >> 6), lane = tid & 63;
    const int r = lane & 31, h = lane >> 5, blk = (lane >> 4) & 1, q = (lane & 15) >> 2, pp = lane & 3;
    const int nt = w & 3, pt = w >> 2;
    for (int unit = blockIdx.x; unit < BATCH * 64 * SSD_GROUPS; unit += gridDim.x) {
        const int g = unit & 3, bc = unit >> 2;
        const int t0 = bc * 128;
        __syncthreads();
        ssd_chunk_acs(ldsb, dtv, a_log, t0, g, cdec + (size_t)bc * SSD_HEADS);
#pragma unroll
        for (int it_ = 0; it_ < 4; ++it_) { const int idx = tid + it_ * NTHR; const int row = idx >> 4, ch = idx & 15;
            const v4u v = *(const v4u*)(xbc_b + (size_t)(t0 + row) * CONV_DIM + 1536 + 128 * g + ch * 8);
            *(LAS v4u*)(ldsb + SSD_L_BM + row * SSD_RS_B + ch * 16) = v; }
        __syncthreads();
#pragma unroll
        for (int it_ = 0; it_ < 12; ++it_) { const int idx = tid + it_ * NTHR; const int hh = idx >> 10, rem = idx & 1023, row = rem >> 3, ch = rem & 7;
            const LAS float* acs = (const LAS float*)(ldsb + SSD_L_ACS) + hh * 128; const LAS float* dts = (const LAS float*)(ldsb + SSD_L_DTS) + hh * 128;
            const float wgt = dts[row] * __expf(acs[127] - acs[row]);
            float f[8]; unpack8(*(const v4u*)(xbc_b + (size_t)(t0 + row) * CONV_DIM + (6 * g + hh) * 64 + ch * 8), f);
            v4u o; o.x = pk2(f[0] * wgt, f[1] * wgt); o.y = pk2(f[2] * wgt, f[3] * wgt); o.z = pk2(f[4] * wgt, f[5] * wgt); o.w = pk2(f[6] * wgt, f[7] * wgt);
            *(LAS v4u*)(ldsb + SSD_L_X + hh * SSD_XIMG + row * SSD_RS_X + ch * 16) = o; }
        __syncthreads();
        const unsigned abase = lds_addr(ldsb + SSD_L_BM) + (8 * h + q) * SSD_RS_B + (32 * nt + 16 * blk + 4 * pp) * 2;
        s16x8 afr[8];
        { s16x4 av[8];
          tr_read8<0 * SSD_RS_B, 4 * SSD_RS_B, 16 * SSD_RS_B, 20 * SSD_RS_B, 32 * SSD_RS_B, 36 * SSD_RS_B, 48 * SSD_RS_B, 52 * SSD_RS_B>(abase, av);
          afr[0] = TRCAT(av[0], av[1]); afr[1] = TRCAT(av[2], av[3]); afr[2] = TRCAT(av[4], av[5]); afr[3] = TRCAT(av[6], av[7]);
          tr_read8<64 * SSD_RS_B, 68 * SSD_RS_B, 80 * SSD_RS_B, 84 * SSD_RS_B, 96 * SSD_RS_B, 100 * SSD_RS_B, 112 * SSD_RS_B, 116 * SSD_RS_B>(abase, av);
          afr[4] = TRCAT(av[0], av[1]); afr[5] = TRCAT(av[2], av[3]); afr[6] = TRCAT(av[4], av[5]); afr[7] = TRCAT(av[6], av[7]); }
#pragma unroll
        for (int hh = 0; hh < 6; ++hh) {
            const unsigned xb = lds_addr(ldsb + SSD_L_X + hh * SSD_XIMG) + (8 * h + q) * SSD_RS_X + (32 * pt + 16 * blk + 4 * pp) * 2;
            f32x16 acc;
#pragma unroll
            for (int i = 0; i < 16; ++i) acc[i] = 0.f;
            { s16x4 xv[8];
              tr_read8<0 * SSD_RS_X, 4 * SSD_RS_X, 16 * SSD_RS_X, 20 * SSD_RS_X, 32 * SSD_RS_X, 36 * SSD_RS_X, 48 * SSD_RS_X, 52 * SSD_RS_X>(xb, xv);
              acc = __builtin_amdgcn_mfma_f32_32x32x16_bf16(afr[0], TRCAT(xv[0], xv[1]), acc, 0, 0, 0);
              acc = __builtin_amdgcn_mfma_f32_32x32x16_bf16(afr[1], TRCAT(xv[2], xv[3]), acc, 0, 0, 0);
              acc = __builtin_amdgcn_mfma_f32_32x32x16_bf16(afr[2], TRCAT(xv[4], xv[5]), acc, 0, 0, 0);
              acc = __builtin_amdgcn_mfma_f32_32x32x16_bf16(afr[3], TRCAT(xv[6], xv[7]), acc, 0, 0, 0);
              tr_read8<64 * SSD_RS_X, 68 * SSD_RS_X, 80 * SSD_RS_X, 84 * SSD_RS_X, 96 * SSD_RS_X, 100 * SSD_RS_X, 112 * SSD_RS_X, 116 * SSD_RS_X>(xb, xv);
              acc = __builtin_amdgcn_mfma_f32_32x32x16_bf16(afr[4], TRCAT(xv[0], xv[1]), acc, 0, 0, 0);
              acc = __builtin_amdgcn_mfma_f32_32x32x16_bf16(afr[5], TRCAT(xv[2], xv[3]), acc, 0, 0, 0);
              acc = __builtin_amdgcn_mfma_f32_32x32x16_bf16(afr[6], TRCAT(xv[4], xv[5]), acc, 0, 0, 0);
              acc = __builtin_amdgcn_mfma_f32_32x32x16_bf16(afr[7], TRCAT(xv[6], xv[7]), acc, 0, 0, 0); }
            bf16* dst = Sbuf + (((size_t)bc * SSD_HEADS + 6 * g + hh) * 64 + 32 * pt + r) * 128 + 32 * nt + 4 * h;
#pragma unroll
            for (int q4 = 0; q4 < 4; ++q4) *(uint2*)(dst + 8 * q4) = make_uint2(pk2(acc[4 * q4], acc[4 * q4 + 1]), pk2(acc[4 * q4 + 2], acc[4 * q4 + 3]));
        }
    }
}

__device__ __forceinline__ void ph_ssd_scan(const bf16* __restrict__ Sbuf, const float* __restrict__ cdec, bf16* __restrict__ Hin, float* __restrict__ out, int rank, int nranks) {
    for (int idx = rank * NTHR + threadIdx.x; idx < BATCH * SSD_HEADS * 64 * 16; idx += nranks * NTHR) {
        const int n8 = idx & 15, p = (idx >> 4) & 63, hb = idx >> 10, hd = hb % SSD_HEADS, b = hb / SSD_HEADS;
        float st[8];
#pragma unroll
        for (int j = 0; j < 8; ++j) st[j] = 0.f;
#pragma unroll 8
        for (int c = 0; c < 64; ++c) {
            const size_t base = ((((size_t)(b * 64 + c)) * SSD_HEADS + hd) * 64 + p) * 128 + n8 * 8;
            v4u o; o.x = pk2(st[0], st[1]); o.y = pk2(st[2], st[3]); o.z = pk2(st[4], st[5]); o.w = pk2(st[6], st[7]);
            *(v4u*)(Hin + base) = o;
            float s[8]; unpack8(*(const v4u*)(Sbuf + base), s);
            const float a = cdec[(size_t)(b * 64 + c) * SSD_HEADS + hd];
#pragma unroll
            for (int j = 0; j < 8; ++j) st[j] = a * st[j] + s[j];
        }
        store8f(out + OUT_PS + (((size_t)b * SSD_HEADS + hd) * 64 + p) * 128 + n8 * 8, st);
    }
}

__device__ __forceinline__ void ph_ssd_out(LAS unsigned char* ldsb, const bf16* __restrict__ xbc_b, const bf16* __restrict__ projb, const float* __restrict__ dtv,
                                           const float* __restrict__ a_log, const float* __restrict__ d_skip, const float* __restrict__ norm_g,
                                           const bf16* __restrict__ Hin, bf16* __restrict__ A1) {
    const int tid = threadIdx.x, w = __builtin_amdgcn_readfirstlane(tid >> 6), lane = tid & 63;
    const int r = lane & 31, h = lane >> 5, blk = (lane >> 4) & 1, q = (lane & 15) >> 2, pp = lane & 3;
    const int lt = w & 3, hs = w >> 2;
    for (int unit = blockIdx.x; unit < BATCH * 64 * SSD_GROUPS; unit += gridDim.x) {
        const int g = unit & 3, bc = unit >> 2;
        const int t0 = bc * 128;
        __syncthreads();
        ssd_chunk_acs(ldsb, dtv, a_log, t0, g, nullptr);
#pragma unroll
        for (int it_ = 0; it_ < 4; ++it_) { const int idx = tid + it_ * NTHR; const int row = idx >> 4, ch = idx & 15;
            const v4u v = *(const v4u*)(xbc_b + (size_t)(t0 + row) * CONV_DIM + 1536 + 128 * g + ch * 8);
            *(LAS v4u*)(ldsb + SSD_L_BM + row * SSD_RS_B + ch * 16) = v; }
#pragma unroll
        for (int it_ = 0; it_ < 12; ++it_) { const int idx = tid + it_ * NTHR; const int hh = idx >> 10, rem = idx & 1023, row = rem >> 3, ch = rem & 7;
            const v4u v = *(const v4u*)(xbc_b + (size_t)(t0 + row) * CONV_DIM + (6 * g + hh) * 64 + ch * 8);
            *(LAS v4u*)(ldsb + SSD_L_X + hh * SSD_XIMG + row * SSD_RS_X + ch * 16) = v; }
        __syncthreads();
        const bf16* cp = xbc_b + (size_t)(t0 + 32 * lt + r) * CONV_DIM + 2048 + 128 * g + 8 * h;
        s16x8 cfr[8];
#pragma unroll
        for (int ks = 0; ks < 8; ++ks) cfr[ks] = *(const s16x8*)(cp + 16 * ks);
        const int lcol = 32 * lt + r;
        const LAS float* acsb = (const LAS float*)(ldsb + SSD_L_ACS) + 3 * hs * 128; const LAS float* dtsb = (const LAS float*)(ldsb + SSD_L_DTS) + 3 * hs * 128;
        const unsigned xb0 = lds_addr(ldsb + SSD_L_X + 3 * hs * SSD_XIMG) + (4 * h + q) * SSD_RS_X + (16 * blk + 4 * pp) * 2;
        unsigned ypk[3][16];
#pragma unroll
        for (int h3 = 0; h3 < 3; ++h3) {
            const LAS float* acs = acsb + h3 * 128; const LAS float* dts = dtsb + h3 * 128;
            const float myacs = acs[lcol];
            const float Dh = d_skip[6 * g + 3 * hs + h3];
            f32x16 y0, y1;
#pragma unroll
            for (int i = 0; i < 16; ++i) { y0[i] = 0.f; y1[i] = 0.f; }
            { const bf16* hp = Hin + (((size_t)bc * SSD_HEADS + 6 * g + 3 * hs + h3) * 64 + r) * 128 + 8 * h;
#pragma unroll
              for (int kh = 0; kh < 2; ++kh) {
                  s16x8 hf0[4], hf1[4];
#pragma unroll
                  for (int ks = 0; ks < 4; ++ks) { hf0[ks] = *(const s16x8*)(hp + 16 * (4 * kh + ks)); hf1[ks] = *(const s16x8*)(hp + 32 * 128 + 16 * (4 * kh + ks)); }
#pragma unroll
                  for (int ks = 0; ks < 4; ++ks) { y0 = __builtin_amdgcn_mfma_f32_32x32x16_bf16(cfr[4 * kh + ks], hf0[ks], y0, 0, 0, 0); y1 = __builtin_amdgcn_mfma_f32_32x32x16_bf16(cfr[4 * kh + ks], hf1[ks], y1, 0, 0, 0); }
                  __builtin_amdgcn_sched_barrier(0);
              } }
#pragma unroll
            for (int q4 = 0; q4 < 4; ++q4) {
                const f32x4v a4 = *(const LAS f32x4v*)(acs + 32 * lt + 8 * q4 + 4 * h);
                const float e0 = __expf(a4[0]), e1 = __expf(a4[1]), e2 = __expf(a4[2]), e3 = __expf(a4[3]);
                y0[4 * q4] *= e0; y0[4 * q4 + 1] *= e1; y0[4 * q4 + 2] *= e2; y0[4 * q4 + 3] *= e3;
                y1[4 * q4] *= e0; y1[4 * q4 + 1] *= e1; y1[4 * q4 + 2] *= e2; y1[4 * q4 + 3] *= e3;
            }
            __builtin_amdgcn_sched_barrier(0);
            for (int st = 0; st <= lt; ++st) {
                f32x16 cb;
#pragma unroll
                for (int i = 0; i < 16; ++i) cb[i] = 0.f;
#pragma unroll
                for (int ks = 0; ks < 8; ++ks) {
                    const s16x8 bfrag = *(const LAS s16x8*)(ldsb + SSD_L_BM + (32 * st + r) * SSD_RS_B + (16 * ks + 8 * h) * 2);
                    cb = __builtin_amdgcn_mfma_f32_32x32x16_bf16(bfrag, cfr[ks], cb, 0, 0, 0);
                }
                __builtin_amdgcn_sched_barrier(0);
                const unsigned xb = xb0 + h3 * SSD_XIMG + st * 32 * SSD_RS_X;
                s16x4 xv[8];
                tr_read8<0, 8 * SSD_RS_X, 64, 8 * SSD_RS_X + 64, 16 * SSD_RS_X, 24 * SSD_RS_X, 16 * SSD_RS_X + 64, 24 * SSD_RS_X + 64>(xb, xv);
#pragma unroll
                for (int kk = 0; kk < 2; ++kk) {
                    const int s0 = 32 * st + 16 * kk + 4 * h;
                    const f32x4v as0 = *(const LAS f32x4v*)(acs + s0), as1 = *(const LAS f32x4v*)(acs + s0 + 8);
                    const f32x4v ds0 = *(const LAS f32x4v*)(dts + s0), ds1 = *(const LAS f32x4v*)(dts + s0 + 8);
                    float wv[8];
#pragma unroll
                    for (int j = 0; j < 8; ++j) {
                        const int s = s0 + 8 * (j >> 2) + (j & 3);
                        const float asj = (j < 4) ? as0[j & 3] : as1[j & 3], dsj = (j < 4) ? ds0[j & 3] : ds1[j & 3];
                        float v = cb[8 * kk + j] * __expf(myacs - asj) * dsj;
                        v = (s <= lcol) ? v : 0.f;
                        v = (s == lcol) ? v + Dh : v;
                        wv[j] = v;
                    }
                    s16x8 afr;
                    { v4u o; o.x = pk2(wv[0], wv[1]); o.y = pk2(wv[2], wv[3]); o.z = pk2(wv[4], wv[5]); o.w = pk2(wv[6], wv[7]); afr = __builtin_bit_cast(s16x8, o); }
                    const s16x8 b0 = kk == 0 ? TRCAT(xv[0], xv[1]) : TRCAT(xv[4], xv[5]);
                    const s16x8 b1 = kk == 0 ? TRCAT(xv[2], xv[3]) : TRCAT(xv[6], xv[7]);
                    y0 = __builtin_amdgcn_mfma_f32_32x32x16_bf16(afr, b0, y0, 0, 0, 0);
                    y1 = __builtin_amdgcn_mfma_f32_32x32x16_bf16(afr, b1, y1, 0, 0, 0);
                    __builtin_amdgcn_sched_barrier(0);
                }
            }
#pragma unroll
            for (int i = 0; i < 8; ++i) { ypk[h3][i] = pk2(y0[2 * i], y0[2 * i + 1]); ypk[h3][8 + i] = pk2(y1[2 * i], y1[2 * i + 1]); }
            __builtin_amdgcn_sched_barrier(0);
        }
        __syncthreads();
        {
            LAS unsigned short* yst = (LAS unsigned short*)(ldsb + SSD_L_X);
#pragma unroll
            for (int h3 = 0; h3 < 3; ++h3)
#pragma unroll
                for (int ptile = 0; ptile < 2; ++ptile)
#pragma unroll
                    for (int i = 0; i < 8; ++i) {
                        const int reg = 2 * i;
                        const int l0 = 32 * lt + (reg & 3) + 8 * (reg >> 2) + 4 * h;
                        const int col = (3 * hs + h3) * 64 + 32 * ptile + r;
                        const unsigned v = ypk[h3][8 * ptile + i];
                        yst[l0 * (SSD_RS_Y / 2) + col] = (unsigned short)(v & 0xffffu);
                        yst[(l0 + 1) * (SSD_RS_Y / 2) + col] = (unsigned short)(v >> 16);
                    }
        }
        __syncthreads();
#pragma unroll
        for (int pass = 0; pass < 4; ++pass) {
            const int l = 4 * (pass * 8 + w) + (lane >> 4), i16 = lane & 15;
            float gv[3][8]; float ss = 0.f;
#pragma unroll
            for (int k = 0; k < 3; ++k) {
                const int col0 = 24 * i16 + 8 * k;
                float yv[8], zv[8];
                unpack8(*(const LAS v4u*)(ldsb + SSD_L_X + l * SSD_RS_Y + col0 * 2), yv);
                unpack8(*(const v4u*)(projb + (size_t)(t0 + l) * NB_LD + g * 384 + col0), zv);
#pragma unroll
                for (int j = 0; j < 8; ++j) { const float gg = yv[j] * silu_f(zv[j]); gv[k][j] = gg; ss += gg * gg; }
            }
            ss += __shfl_xor(ss, 1); ss += __shfl_xor(ss, 2); ss += __shfl_xor(ss, 4); ss += __shfl_xor(ss, 8);
            const float rstd = rsqrtf(ss * (1.0f / 384.0f) + LN_EPS);
#pragma unroll
            for (int k = 0; k < 3; ++k) {
                const int col0 = g * 384 + 24 * i16 + 8 * k;
                const float4 g0 = *(const float4*)(norm_g + col0), g1 = *(const float4*)(norm_g + col0 + 4);
                v4u o; o.x = pk2(gv[k][0] * rstd * g0.x, gv[k][1] * rstd * g0.y); o.y = pk2(gv[k][2] * rstd * g0.z, gv[k][3] * rstd * g0.w);
                o.z = pk2(gv[k][4] * rstd * g1.x, gv[k][5] * rstd * g1.y); o.w = pk2(gv[k][6] * rstd * g1.z, gv[k][7] * rstd * g1.w);
                *(v4u*)(A1 + (size_t)(t0 + l) * MIX_WIDTH + col0) = o;
            }
        }
    }
}

#define ATT_RS_V 144
#define ATT_VIMG (256 * ATT_RS_V)
#define ATT_PVT(KT) { \
        s16x4 vv_[8]; \
        tr_read8<(32 * KT) * ATT_RS_V, (32 * KT + 8) * ATT_RS_V, (32 * KT) * ATT_RS_V + 64, (32 * KT + 8) * ATT_RS_V + 64, \
                 (32 * KT + 16) * ATT_RS_V, (32 * KT + 24) * ATT_RS_V, (32 * KT + 16) * ATT_RS_V + 64, (32 * KT + 24) * ATT_RS_V + 64>(vbase, vv_); \
        _Pragma("unroll") for (int s2_ = 0; s2_ < 2; ++s2_) { \
            v4u o_; o_.x = pk2(s[KT][8 * s2_ + 0], s[KT][8 * s2_ + 1]); o_.y = pk2(s[KT][8 * s2_ + 2], s[KT][8 * s2_ + 3]); \
            o_.z = pk2(s[KT][8 * s2_ + 4], s[KT][8 * s2_ + 5]); o_.w = pk2(s[KT][8 * s2_ + 6], s[KT][8 * s2_ + 7]); \
            const s16x8 pf_ = __builtin_bit_cast(s16x8, o_); \
            const s16x8 a0_ = s2_ == 0 ? TRCAT(vv_[0], vv_[1]) : TRCAT(vv_[4], vv_[5]); \
            const s16x8 a1_ = s2_ == 0 ? TRCAT(vv_[2], vv_[3]) : TRCAT(vv_[6], vv_[7]); \
            o0 = __builtin_amdgcn_mfma_f32_32x32x16_bf16(a0_, pf_, o0, 0, 0, 0); \
            o1 = __builtin_amdgcn_mfma_f32_32x32x16_bf16(a1_, pf_, o1, 0, 0, 0); } }
__device__ __forceinline__ void ph_attn_prompt(LAS unsigned char* ldsb, const bf16* __restrict__ qrot_b, const bf16* __restrict__ krot_b, const bf16* __restrict__ projb,
                                               bf16* __restrict__ obuf, float* __restrict__ lsebuf) {
    const int tid = threadIdx.x, w = __builtin_amdgcn_readfirstlane(tid >> 6), lane = tid & 63;
    const int r = lane & 31, h = lane >> 5, blk = (lane >> 4) & 1, q = (lane & 15) >> 2, pp = lane & 3;
    const int qt = w & 3, hsel = w >> 2;
    for (int unit = blockIdx.x; unit < 3 * 512; unit += gridDim.x) {
        const int pat = unit >> 9, rem = unit & 511, hp = rem & 3, rem2 = rem >> 2, b = rem2 >> 6, bk = rem2 & 63;
        const int dsh = 2 * pat, nper = 64 >> dsh, res = bk >> (6 - dsh), nb = bk & (nper - 1);
        const int head = 2 * hp + hsel;
        __syncthreads();
#pragma unroll
        for (int it_ = 0; it_ < 8; ++it_) { const int idx = (tid & 255) + it_ * 256;
            const int row = idx >> 3, ch = idx & 7, js = 128 * nb - 128 + row;
            v4u v; v.x = 0u; v.y = 0u; v.z = 0u; v.w = 0u;
            if (js >= 0) v = *(const v4u*)(projb + (size_t)(b * SEQ + (js << dsh) + res) * NB_LD + NB_V + head * 64 + ch * 8);
            *(LAS v4u*)(ldsb + hsel * ATT_VIMG + row * ATT_RS_V + ch * 16) = v;
        }
        const int tq = b * SEQ + ((128 * nb + 32 * qt + r) << dsh) + res;
        s16x8 qf[4];
#pragma unroll
        for (int ks = 0; ks < 4; ++ks) qf[ks] = *(const s16x8*)(qrot_b + (size_t)tq * ATT_WIDTH + head * 64 + 16 * ks + 8 * h);
        f32x16 s[5];
#pragma unroll
        for (int kt = 0; kt < 5; ++kt) {
            int js = 128 * nb + 32 * qt - 128 + 32 * kt + r; js = js < 0 ? 0 : js;
            const bf16* kp = krot_b + (size_t)(b * SEQ + (js << dsh) + res) * ATT_WIDTH + head * 64 + 8 * h;
#pragma unroll
            for (int i = 0; i < 16; ++i) s[kt][i] = 0.f;
#pragma unroll
            for (int ks = 0; ks < 4; ++ks) s[kt] = __builtin_amdgcn_mfma_f32_32x32x16_bf16(*(const s16x8*)(kp + 16 * ks), qf[ks], s[kt], 0, 0, 0);
        }
        float m = -INFINITY;
#pragma unroll
        for (int kt = 0; kt < 5; ++kt) {
            const bool tile_ok = (nb > 0) || (qt + kt >= 4);
#pragma unroll
            for (int reg = 0; reg < 16; ++reg) {
                const int c = (reg & 3) + 8 * (reg >> 2) + 4 * h;
                const bool ok = tile_ok && (kt == 0 ? (c >= r) : (kt == 4 ? (c <= r) : true));
                const float v = ok ? s[kt][reg] * 0.125f : -INFINITY;
                s[kt][reg] = v; m = fmaxf(m, v);
            }
        }
        m = fmaxf(m, __shfl_xor(m, 32));
        float l = 0.f;
#pragma unroll
        for (int kt = 0; kt < 5; ++kt)
#pragma unroll
            for (int reg = 0; reg < 16; ++reg) { const float p = __expf(s[kt][reg] - m); s[kt][reg] = p; l += p; }
        l += __shfl_xor(l, 32);
        __syncthreads();
        f32x16 o0, o1;
#pragma unroll
        for (int i = 0; i < 16; ++i) { o0[i] = 0.f; o1[i] = 0.f; }
        const unsigned vbase = lds_addr(ldsb + hsel * ATT_VIMG) + (32 * qt + 4 * h + q) * ATT_RS_V + (16 * blk + 4 * pp) * 2;
        ATT_PVT(0) ATT_PVT(1) ATT_PVT(2) ATT_PVT(3) ATT_PVT(4)
        const float inv = 1.0f / l;
        bf16* op = obuf + ((size_t)pat * T_PROMPT + tq) * ATT_WIDTH + head * 64 + 4 * h;
#pragma unroll
        for (int q4 = 0; q4 < 4; ++q4) {
            *(uint2*)(op + 8 * q4) = make_uint2(pk2(o0[4 * q4] * inv, o0[4 * q4 + 1] * inv), pk2(o0[4 * q4 + 2] * inv, o0[4 * q4 + 3] * inv));
            *(uint2*)(op + 32 + 8 * q4) = make_uint2(pk2(o1[4 * q4] * inv, o1[4 * q4 + 1] * inv), pk2(o1[4 * q4 + 2] * inv, o1[4 * q4 + 3] * inv));
        }
        if (h == 0) lsebuf[((size_t)pat * T_PROMPT + tq) * 8 + head] = m + __logf(l);
    }
}
__device__ __forceinline__ void ph_attn_combine(const bf16* __restrict__ obuf, const float* __restrict__ lsebuf, bf16* __restrict__ A1) {
    const int lane = threadIdx.x & 63;
#pragma unroll 4
    for (int t = blockIdx.x * NWAVE + (threadIdx.x >> 6); t < T_PROMPT; t += gridDim.x * NWAVE) {
        const int hd = lane >> 3;
        const float l0 = lsebuf[((size_t)0 * T_PROMPT + t) * 8 + hd], l1 = lsebuf[((size_t)1 * T_PROMPT + t) * 8 + hd], l2 = lsebuf[((size_t)2 * T_PROMPT + t) * 8 + hd];
        const float mx = fmaxf(l0, fmaxf(l1, l2));
        const float e0 = __expf(l0 - mx), e1 = __expf(l1 - mx), e2 = __expf(l2 - mx);
        const float inv = 1.0f / (e0 + e1 + e2);
        float a[8], b[8], c[8];
        unpack8(*(const v4u*)(obuf + ((size_t)0 * T_PROMPT + t) * ATT_WIDTH + lane * 8), a);
        unpack8(*(const v4u*)(obuf + ((size_t)1 * T_PROMPT + t) * ATT_WIDTH + lane * 8), b);
        unpack8(*(const v4u*)(obuf + ((size_t)2 * T_PROMPT + t) * ATT_WIDTH + lane * 8), c);
        float o[8];
#pragma unroll
        for (int j = 0; j < 8; ++j) o[j] = (e0 * a[j] + e1 * b[j] + e2 * c[j]) * inv;
        v4u w; w.x = pk2(o[0], o[1]); w.y = pk2(o[2], o[3]); w.z = pk2(o[4], o[5]); w.w = pk2(o[6], o[7]);
        *(v4u*)(A1 + (size_t)t * MIX_WIDTH + SSD_WIDTH + lane * 8) = w;
    }
}

#define RT_RS 272
#define RT_KIMG (128 * RT_RS)
#define RT_LUT (2 * RT_KIMG)
constexpr unsigned char RT_CANDS[64] = {0, 1, 2, 3, 4, 5, 6, 7, 8, 9, 10, 11, 12, 13, 14, 15, 16, 17, 18, 19, 20, 21, 22, 23, 32, 33, 34, 35, 36, 48, 49, 50, 51, 64, 65, 66, 80, 81, 96, 97,
                                        112, 113, 128, 144, 160, 176, 192, 208, 224, 240, 0, 0, 0, 0, 0, 0, 0, 0, 0, 0, 0, 0, 0, 0};
__device__ __forceinline__ unsigned rt_mono(float f) { const unsigned u = __builtin_bit_cast(unsigned, f); return u ^ ((unsigned)((int)u >> 31) | 0x80000000u); }
__device__ __forceinline__ float rt_unmono(unsigned m) { const unsigned u = (m & 0x80000000u) ? (m ^ 0x80000000u) : ~m; return __builtin_bit_cast(float, u); }
#define RT_CE_DESC(a, b) { const unsigned x_ = (a), y_ = (b); (a) = x_ > y_ ? x_ : y_; (b) = x_ > y_ ? y_ : x_; }
#define RT_CE_ASC(a, b) { const unsigned x_ = (a), y_ = (b); (a) = x_ > y_ ? y_ : x_; (b) = x_ > y_ ? x_ : y_; }
__device__ __forceinline__ void rt_sort16(unsigned (&v)[16]) {
#pragma unroll
    for (int k = 2; k <= 16; k <<= 1)
#pragma unroll
        for (int j = k >> 1; j > 0; j >>= 1)
#pragma unroll
            for (int i = 0; i < 16; ++i) { const int l = i ^ j; if (l > i) { if ((i & k) == 0) RT_CE_DESC(v[i], v[l]) else RT_CE_ASC(v[i], v[l]) } }
}
__device__ __forceinline__ void rt_merge16(unsigned (&v)[16]) {
#pragma unroll
    for (int j = 8; j > 0; j >>= 1)
#pragma unroll
        for (int i = 0; i < 16; ++i) { const int l = i ^ j; if (l > i) RT_CE_DESC(v[i], v[l]) }
}
__device__ __forceinline__ void rt_top16(unsigned (&a)[16], const unsigned (&b)[16]) {
#pragma unroll
    for (int i = 0; i < 16; ++i) a[i] = a[i] > b[15 - i] ? a[i] : b[15 - i];
    rt_merge16(a);
}
__device__ __forceinline__ void rt_top16_partner(unsigned (&a)[16]) {
    unsigned b[16];
#pragma unroll
    for (int i = 0; i < 16; ++i) b[i] = (unsigned)__shfl_xor((int)a[i], 32);
    rt_top16(a, b);
}
__device__ __forceinline__ void rt_scores_top16(LAS unsigned char* kimg, const bf16* __restrict__ qp, int r, int h, unsigned (&k0)[16]) {
    f32x16 acc[4];
#pragma unroll
    for (int kt = 0; kt < 4; ++kt)
#pragma unroll
        for (int i = 0; i < 16; ++i) acc[kt][i] = 0.f;
#pragma unroll
    for (int ks = 0; ks < 8; ++ks) {
        const s16x8 qf = *(const s16x8*)(qp + 16 * ks);
#pragma unroll
        for (int kt = 0; kt < 4; ++kt) {
            const s16x8 kf = *(const LAS s16x8*)(kimg + (32 * kt + r) * RT_RS + (16 * ks + 8 * h) * 2);
            acc[kt] = __builtin_amdgcn_mfma_f32_32x32x16_bf16(kf, qf, acc[kt], 0, 0, 0);
        }
    }
    unsigned k1[16], k2[16], k3[16];
#pragma unroll
    for (int reg = 0; reg < 16; ++reg) {
        const unsigned ki = (unsigned)((reg & 3) + 8 * (reg >> 2) + 4 * h);
        k0[reg] = (rt_mono(acc[0][reg]) & 0xFFFFFF80u) | ki;
        k1[reg] = (rt_mono(acc[1][reg]) & 0xFFFFFF80u) | (ki + 32u);
        k2[reg] = (rt_mono(acc[2][reg]) & 0xFFFFFF80u) | (ki + 64u);
        k3[reg] = (rt_mono(acc[3][reg]) & 0xFFFFFF80u) | (ki + 96u);
    }
    rt_sort16(k0); rt_sort16(k1); rt_sort16(k2); rt_sort16(k3);
    rt_top16(k0, k1); rt_top16(k2, k3); rt_top16(k0, k2);
    rt_top16_partner(k0);
}
__device__ __forceinline__ void ph_peer_route2(LAS unsigned char* ldsb, const bf16* __restrict__ qhb, const float* __restrict__ keys1, const float* __restrict__ keys2,
                                               int* __restrict__ eidx, float* __restrict__ gate) {
    const int tid = threadIdx.x, w = __builtin_amdgcn_readfirstlane(tid >> 6), lane = tid & 63, r = lane & 31, h = lane >> 5;
    __syncthreads();
    for (int idx = tid; idx < 2 * 128 * 16; idx += NTHR) {
        const int tb = idx >> 11, rem = idx & 2047, row = rem >> 4, ch = rem & 15;
        const float* sp = (tb ? keys2 : keys1) + row * 128 + ch * 8;
        const float4 a = *(const float4*)sp, b = *(const float4*)(sp + 4);
        v4u o; o.x = pk2(a.x, a.y); o.y = pk2(a.z, a.w); o.z = pk2(b.x, b.y); o.w = pk2(b.z, b.w);
        *(LAS v4u*)(ldsb + tb * RT_KIMG + row * RT_RS + ch * 16) = o;
    }
    __syncthreads();
    LAS unsigned* lut = (LAS unsigned*)(ldsb + RT_LUT) + w * 512;
    for (int unit = blockIdx.x * NWAVE + w; unit < (T_ALL / 32) * 8; unit += gridDim.x * NWAVE) {
        const int tt = unit >> 3, hd = unit & 7;
        const int tok = 32 * tt + r;
        const bf16* qp = qhb + (size_t)tok * 2048 + hd * 256 + 8 * h;
        unsigned ka[16], kb[16];
        rt_scores_top16(ldsb, qp, r, h, ka);
        rt_scores_top16(ldsb + RT_KIMG, qp + 128, r, h, kb);
        float v1[16], v2[16];
#pragma unroll
        for (int i = 0; i < 16; ++i) { v1[i] = rt_unmono(ka[i] & 0xFFFFFF80u); v2[i] = rt_unmono(kb[i] & 0xFFFFFF80u); }
#pragma unroll
        for (int wd = 0; wd < 4; ++wd) {
            lut[wd * 64 + lane] = (ka[4 * wd] & 0x7Fu) | ((ka[4 * wd + 1] & 0x7Fu) << 8) | ((ka[4 * wd + 2] & 0x7Fu) << 16) | ((ka[4 * wd + 3] & 0x7Fu) << 24);
            lut[(4 + wd) * 64 + lane] = (kb[4 * wd] & 0x7Fu) | ((kb[4 * wd + 1] & 0x7Fu) << 8) | ((kb[4 * wd + 2] & 0x7Fu) << 16) | ((kb[4 * wd + 3] & 0x7Fu) << 24);
        }
        unsigned c0[16], c1[16];
        c0[0] = (rt_mono(h ? (v1[0] + v2[1]) : (v1[0] + v2[0])) & 0xFFFFFF00u) | (h ? 1u : 0u);
        c0[1] = (rt_mono(h ? (v1[0] + v2[3]) : (v1[0] + v2[2])) & 0xFFFFFF00u) | (h ? 3u : 2u);
        c0[2] = (rt_mono(h ? (v1[0] + v2[5]) : (v1[0] + v2[4])) & 0xFFFFFF00u) | (h ? 5u : 4u);
        c0[3] = (rt_mono(h ? (v1[0] + v2[7]) : (v1[0] + v2[6])) & 0xFFFFFF00u) | (h ? 7u : 6u);
        c0[4] = (rt_mono(h ? (v1[0] + v2[9]) : (v1[0] + v2[8])) & 0xFFFFFF00u) | (h ? 9u : 8u);
        c0[5] = (rt_mono(h ? (v1[0] + v2[11]) : (v1[0] + v2[10])) & 0xFFFFFF00u) | (h ? 11u : 10u);
        c0[6] = (rt_mono(h ? (v1[0] + v2[13]) : (v1[0] + v2[12])) & 0xFFFFFF00u) | (h ? 13u : 12u);
        c0[7] = (rt_mono(h ? (v1[0] + v2[15]) : (v1[0] + v2[14])) & 0xFFFFFF00u) | (h ? 15u : 14u);
        c0[8] = (rt_mono(h ? (v1[1] + v2[1]) : (v1[1] + v2[0])) & 0xFFFFFF00u) | (h ? 17u : 16u);
        c0[9] = (rt_mono(h ? (v1[1] + v2[3]) : (v1[1] + v2[2])) & 0xFFFFFF00u) | (h ? 19u : 18u);
        c0[10] = (rt_mono(h ? (v1[1] + v2[5]) : (v1[1] + v2[4])) & 0xFFFFFF00u) | (h ? 21u : 20u);
        c0[11] = (rt_mono(h ? (v1[1] + v2[7]) : (v1[1] + v2[6])) & 0xFFFFFF00u) | (h ? 23u : 22u);
        c0[12] = (rt_mono(h ? (v1[2] + v2[1]) : (v1[2] + v2[0])) & 0xFFFFFF00u) | (h ? 33u : 32u);
        c0[13] = (rt_mono(h ? (v1[2] + v2[3]) : (v1[2] + v2[2])) & 0xFFFFFF00u) | (h ? 35u : 34u);
        c0[14] = (rt_mono(h ? (v1[3] + v2[0]) : (v1[2] + v2[4])) & 0xFFFFFF00u) | (h ? 48u : 36u);
        c0[15] = (rt_mono(h ? (v1[3] + v2[2]) : (v1[3] + v2[1])) & 0xFFFFFF00u) | (h ? 50u : 49u);
        c1[0] = (rt_mono(h ? (v1[4] + v2[0]) : (v1[3] + v2[3])) & 0xFFFFFF00u) | (h ? 64u : 51u);
        c1[1] = (rt_mono(h ? (v1[4] + v2[2]) : (v1[4] + v2[1])) & 0xFFFFFF00u) | (h ? 66u : 65u);
        c1[2] = (rt_mono(h ? (v1[5] + v2[1]) : (v1[5] + v2[0])) & 0xFFFFFF00u) | (h ? 81u : 80u);
        c1[3] = (rt_mono(h ? (v1[6] + v2[1]) : (v1[6] + v2[0])) & 0xFFFFFF00u) | (h ? 97u : 96u);
        c1[4] = (rt_mono(h ? (v1[7] + v2[1]) : (v1[7] + v2[0])) & 0xFFFFFF00u) | (h ? 113u : 112u);
        c1[5] = (rt_mono(h ? (v1[9] + v2[0]) : (v1[8] + v2[0])) & 0xFFFFFF00u) | (h ? 144u : 128u);
        c1[6] = (rt_mono(h ? (v1[11] + v2[0]) : (v1[10] + v2[0])) & 0xFFFFFF00u) | (h ? 176u : 160u);
        c1[7] = (rt_mono(h ? (v1[13] + v2[0]) : (v1[12] + v2[0])) & 0xFFFFFF00u) | (h ? 208u : 192u);
        c1[8] = (rt_mono(h ? (v1[15] + v2[0]) : (v1[14] + v2[0])) & 0xFFFFFF00u) | (h ? 240u : 224u);
        c1[9] = 0u;
        c1[10] = 0u;
        c1[11] = 0u;
        c1[12] = 0u;
        c1[13] = 0u;
        c1[14] = 0u;
        c1[15] = 0u;
        rt_sort16(c0); rt_sort16(c1); rt_top16(c0, c1); rt_top16_partner(c0);
        float e[16]; float sum = 0.f;
        const float mx = rt_unmono(c0[0] & 0xFFFFFF00u);
#pragma unroll
        for (int k = 0; k < 16; ++k) { e[k] = __expf(rt_unmono(c0[k] & 0xFFFFFF00u) - mx); sum += e[k]; }
        const float inv = 1.0f / sum;
        asm volatile("s_waitcnt lgkmcnt(0)" ::: "memory");
        int ex[8]; float gv[8];
#pragma unroll
        for (int k = 0; k < 8; ++k) {
            const unsigned hm = (unsigned)(-h);
            const unsigned ck = (c0[k] & ~hm) | (c0[8 + k] & hm);
            const float ek = __builtin_bit_cast(float, (__builtin_bit_cast(unsigned, e[k]) & ~hm) | (__builtin_bit_cast(unsigned, e[8 + k]) & hm));
            const unsigned ci = (ck >> 4) & 15u, cj = ck & 15u;
            const unsigned w1 = lut[(ci >> 2) * 64 + lane], w2 = lut[(4 + (cj >> 2)) * 64 + lane];
            const unsigned i1 = (w1 >> (8 * (ci & 3))) & 0x7Fu, i2 = (w2 >> (8 * (cj & 3))) & 0x7Fu;
            ex[k] = (int)(i1 * PEER_NKEYS + i2); gv[k] = ek * inv;
        }
        int* ep = eidx + (size_t)tok * 128 + hd * 16 + 8 * h; float* gp = gate + (size_t)tok * 128 + hd * 16 + 8 * h;
        *(int4*)ep = make_int4(ex[0], ex[1], ex[2], ex[3]); *(int4*)(ep + 4) = make_int4(ex[4], ex[5], ex[6], ex[7]);
        *(float4*)gp = make_float4(gv[0], gv[1], gv[2], gv[3]); *(float4*)(gp + 4) = make_float4(gv[4], gv[5], gv[6], gv[7]);
    }
}

struct Params {
    const float* in[23];
    float* out;
    unsigned char* ws;
    unsigned* bar;
};

#define WS_BAR      0ull
#define WS_XALL     (1ull << 20)
#define WS_PROJ     (WS_XALL + (size_t)T_ALL * D_MODEL * 4)
#define WS_XBC      (WS_PROJ + (size_t)T_ALL * PROJ_LD * 4)
#define WS_DT       (WS_XBC + (size_t)T_ALL * CONV_DIM * 4)
#define WS_QROT     (WS_DT + (size_t)T_ALL * SSD_HEADS * 4)
#define WS_KROT     (WS_QROT + (size_t)T_ALL * ATT_WIDTH * 4)
#define WS_YBUF     (WS_KROT + (size_t)T_ALL * ATT_WIDTH * 4)
#define WS_MIX      (WS_YBUF + (size_t)T_ALL * MIX_WIDTH * 4)
#define WS_HBUF     (WS_MIX + (size_t)T_ALL * D_MODEL * 4)
#define WS_QH       (WS_HBUF + (size_t)T_ALL * D_MODEL * 4)
#define WS_EIDX     (WS_QH + (size_t)T_ALL * 2048 * 4)
#define WS_GATE     (WS_EIDX + (size_t)T_ALL * 128 * 4)
#define WS_A0       (WS_GATE + (size_t)T_ALL * 128 * 4)
#define WS_A1       (WS_A0 + (size_t)T_ALL * D_MODEL * 2)
#define WS_A2       (WS_A1 + (size_t)T_ALL * MIX_WIDTH * 2)
#define WS_WTIN     (WS_A2 + (size_t)T_ALL * D_MODEL * 2)
#define WS_WTOUT    (WS_WTIN + (size_t)PROJ_LD * D_MODEL * 2)
#define WS_WTQ      (WS_WTOUT + (size_t)D_MODEL * MIX_WIDTH * 2)
#define WS_PROJB    (WS_WTQ + (size_t)2048 * D_MODEL * 2)
#define WS_DTRAW    (WS_PROJB + (size_t)T_ALL * NB_LD * 2)
#define WS_XBCB     (WS_DTRAW + (size_t)T_ALL * 32 * 4)
#define WS_QROTB    (WS_XBCB + (size_t)T_ALL * CONV_DIM * 2)
#define WS_KROTB    (WS_QROTB + (size_t)T_ALL * ATT_WIDTH * 2)
#define WS_UB       (WS_KROTB + (size_t)T_ALL * ATT_WIDTH * 2)
#define WS_VB       (WS_UB + (size_t)16384 * D_MODEL * 2)
#define WS_USC      (WS_VB + (size_t)16384 * D_MODEL * 2)
#define WS_VSC      (WS_USC + 16384 * 4)
#define WS_SBUF     (WS_VSC + 16384 * 4)
#define WS_HIN      (WS_SBUF + (size_t)BATCH * 64 * SSD_HEADS * 64 * 128 * 2)
#define WS_CDEC     (WS_HIN + (size_t)BATCH * 64 * SSD_HEADS * 64 * 128 * 2)
#define WS_OBUF     (WS_CDEC + (size_t)BATCH * 64 * SSD_HEADS * 4)
#define WS_LSE      (WS_OBUF + (size_t)3 * T_PROMPT * ATT_WIDTH * 2)
#define WS_ROPE     (WS_LSE + (size_t)3 * T_PROMPT * 8 * 4)
#define WS_END      (WS_ROPE + (size_t)SEQ * 64 * 4)

#define LDS_BYTES (160 * 1024)
#define N9_SLICES 13440u

#define KP const __attribute__((address_space(4))) Params* kp = (const __attribute__((address_space(4))) Params*)__builtin_amdgcn_kernarg_segment_ptr(); asm volatile("" : "+s"(kp)); unsigned char* ws = kp->ws; (void)ws;
#define IN(i) (kp->in[i])
#define WSP(T, off) ((T*)(ws + (off)))
__global__ void __launch_bounds__(512, 2) mega_fwd(Params p) {
    extern __shared__ __attribute__((aligned(16))) unsigned char smem[];
    if (threadIdx.x == 0) *(uint4*)smem = make_uint4(0u, 0u, 0u, 0u);
    __syncthreads();
    XcdBarrier bar = xcd_barrier_post(p.bar, (volatile LAS unsigned*)smem);
    float* lds = (float*)(smem + 256);
    LAS unsigned char* ldsb = (LAS unsigned char*)smem + 256;

    { KP ph_prologue(ldsb, IN(0), IN(1), WSP(bf16, WS_A0), IN(6), WSP(bf16, WS_WTIN), WSP(float, WS_ROPE)); }
    xcd_barrier(bar);
    { KP pg8::Gemm g{WSP(bf16, WS_A0), WSP(bf16, WS_WTIN), T_ALL, PROJ_LD, D_MODEL}; pg8::StaticOrder S; S.init(g.M, g.N, (int)gridDim.x, (int)blockIdx.x);
      pg8::EpiProj E{WSP(bf16, WS_PROJB), WSP(float, WS_DTRAW)}; pg8::gemm_phase<pg8::EpiProj, pg8::StaticOrder, false>(ldsb, g, S, E, nullptr); }
    xcd_barrier(bar);
    { KP ph_post_proj_prompt(WSP(bf16, WS_PROJB), WSP(float, WS_DTRAW), IN(7), IN(8), IN(9), WSP(float, WS_ROPE), WSP(bf16, WS_XBCB), WSP(float, WS_DT), WSP(bf16, WS_QROTB), WSP(bf16, WS_KROTB), kp->out); }
    { KP ph_post_proj2(WSP(bf16, WS_PROJB), WSP(float, WS_DTRAW), IN(4), IN(7), IN(8), IN(9), WSP(bf16, WS_XBCB), WSP(float, WS_DT), WSP(bf16, WS_QROTB), WSP(bf16, WS_KROTB), kp->out); }
    xcd_barrier(bar);
    { KP ph_ssd_states(ldsb, WSP(bf16, WS_XBCB), WSP(float, WS_DT), IN(10), WSP(bf16, WS_SBUF), WSP(float, WS_CDEC)); }
    __syncthreads();
    { KP ph_attn_prompt(ldsb, WSP(bf16, WS_QROTB), WSP(bf16, WS_KROTB), WSP(bf16, WS_PROJB), WSP(bf16, WS_OBUF), WSP(float, WS_LSE)); }
    __syncthreads();
    { KP ph_ssd_decode(WSP(bf16, WS_XBCB), WSP(float, WS_DT), IN(10), IN(11), IN(5), WSP(float, WS_YBUF), kp->out); }
    { KP ph_attn_sample3(lds, WSP(bf16, WS_QROTB), WSP(bf16, WS_KROTB), WSP(bf16, WS_PROJB), IN(2), IN(3), WSP(bf16, WS_A1)); }
    xcd_barrier(bar);
    if ((int)gridDim.x > 128) {
        if ((int)blockIdx.x < 96) { KP ph_ssd_scan(WSP(bf16, WS_SBUF), WSP(float, WS_CDEC), WSP(bf16, WS_HIN), kp->out, (int)blockIdx.x, 96); }
        else {
            { KP ph_prologue2(ldsb, IN(13), WSP(bf16, WS_WTOUT), IN(16), WSP(bf16, WS_WTQ), (int)blockIdx.x - 96, (int)gridDim.x - 96); }
            { KP ph_quant_tables(IN(19), IN(20), WSP(unsigned char, WS_UB), WSP(unsigned char, WS_VB), WSP(float, WS_USC), WSP(float, WS_VSC), (int)blockIdx.x - 96, (int)gridDim.x - 96); }
        }
    } else {
        { KP ph_ssd_scan(WSP(bf16, WS_SBUF), WSP(float, WS_CDEC), WSP(bf16, WS_HIN), kp->out, (int)blockIdx.x, (int)gridDim.x); }
        { KP ph_prologue2(ldsb, IN(13), WSP(bf16, WS_WTOUT), IN(16), WSP(bf16, WS_WTQ), (int)blockIdx.x, (int)gridDim.x); }
        { KP ph_quant_tables(IN(19), IN(20), WSP(unsigned char, WS_UB), WSP(unsigned char, WS_VB), WSP(float, WS_USC), WSP(float, WS_VSC), (int)blockIdx.x, (int)gridDim.x); }
    }
    xcd_barrier(bar);
    { KP ph_ssd_out(ldsb, WSP(bf16, WS_XBCB), WSP(bf16, WS_PROJB), WSP(float, WS_DT), IN(10), IN(11), IN(12), WSP(bf16, WS_HIN), WSP(bf16, WS_A1)); }
    { KP ph_attn_combine(WSP(bf16, WS_OBUF), WSP(float, WS_LSE), WSP(bf16, WS_A1)); }
    { KP ph_gate_norm(WSP(bf16, WS_PROJB), IN(12), WSP(float, WS_YBUF), WSP(bf16, WS_A1)); }
    xcd_barrier(bar);
    { KP pg8::Gemm g{WSP(bf16, WS_A1), WSP(bf16, WS_WTOUT), T_ALL, D_MODEL, MIX_WIDTH}; pg8::StaticOrder S; S.init(g.M, g.N, (int)gridDim.x, (int)blockIdx.x);
      pg8::EpiBf16Plain E{WSP(bf16, WS_MIX), D_MODEL}; pg8::gemm_phase<pg8::EpiBf16Plain, pg8::StaticOrder, false>(ldsb, g, S, E, nullptr); }
    if (blockIdx.x >= 8 && gridDim.x == 256) { KP cache_copy_slice(IN(2), IN(3), kp->out, N9_SLICES + (blockIdx.x - 8) * 8u + (threadIdx.x >> 6), threadIdx.x & 63u); }
    xcd_barrier(bar);
    { KP ph_ln_res(IN(0), IN(1), WSP(bf16, WS_MIX), IN(14), IN(15), WSP(bf16, WS_A2)); }
    xcd_barrier(bar);
    { KP pg8::Gemm g{WSP(bf16, WS_A2), WSP(bf16, WS_WTQ), T_ALL, 2048, D_MODEL}; pg8::StaticOrder S; S.init(g.M, g.N, (int)gridDim.x, (int)blockIdx.x);
      pg8::EpiBf16Plain E{WSP(bf16, WS_QH), 2048}; pg8::gemm_phase<pg8::EpiBf16Plain, pg8::StaticOrder, false>(ldsb, g, S, E, nullptr); }
    if (blockIdx.x >= 16 && gridDim.x == 256 && threadIdx.x < 256) { KP cache_copy_slice(IN(2), IN(3), kp->out, N9_SLICES + 1984u + (blockIdx.x - 16) * 4u + (threadIdx.x >> 6), threadIdx.x & 63u); }
    xcd_barrier(bar);
    { KP ph_peer_route2(ldsb, WSP(bf16, WS_QH), IN(17), IN(18), WSP(int, WS_EIDX), WSP(float, WS_GATE)); }
    xcd_barrier(bar);
    { KP ph_peer_ffn3(WSP(bf16, WS_A2), WSP(int, WS_EIDX), WSP(float, WS_GATE), WSP(unsigned char, WS_UB), WSP(unsigned char, WS_VB), WSP(float, WS_USC), WSP(float, WS_VSC), IN(21), IN(22), kp->out, IN(2), IN(3), gridDim.x == 256 ? N9_SLICES : 16384u); }
}

extern "C" void kernel_launch(void* const* d_in, const int* in_sizes, int n_in, void* d_out, int out_size, void* d_ws, size_t ws_size, hipStream_t stream) {
    static int grid = 0;
    if (grid == 0) {
        int dev = 0, cus = 0, per_cu = 0;
        if (hipGetDevice(&dev) != hipSuccess || hipDeviceGetAttribute(&cus, hipDeviceAttributeMultiprocessorCount, dev) != hipSuccess) { fprintf(stderr, "kernel_launch: device query failed\n"); grid = -1; return; }
        if (hipFuncSetAttribute((const void*)mega_fwd, hipFuncAttributeMaxDynamicSharedMemorySize, LDS_BYTES) != hipSuccess) { fprintf(stderr, "kernel_launch: hipFuncSetAttribute failed\n"); grid = -1; return; }
        if (hipOccupancyMaxActiveBlocksPerMultiprocessor(&per_cu, (const void*)mega_fwd, NTHR, LDS_BYTES) != hipSuccess || per_cu < 1) { fprintf(stderr, "kernel_launch: occupancy query says %d\n", per_cu); }
        (void)hipGetLastError();
        grid = cus;
        if (ws_size < WS_END) { fprintf(stderr, "kernel_launch: workspace too small\n"); grid = -1; return; }
    }
    if (grid < 0) return;
    (void)hipMemsetAsync((char*)d_ws + WS_BAR, 0, XCD_BAR_WORDS * sizeof(unsigned), stream);
    Params p{};
    for (int i = 0; i < 23; ++i) p.in[i] = (const float*)d_in[i];
    p.out = (float*)d_out; p.ws = (unsigned char*)d_ws; p.bar = (unsigned*)((char*)d_ws + WS_BAR);
    hipLaunchKernelGGL(mega_fwd, dim3(grid), dim3(NTHR), LDS_BYTES, stream, p);
}
```

```cpp
#include <hip/hip_runtime.h>
#include <stdint.h>

#define D_MODEL 1024
#define BATCH 2
#define SEQ 8192
#define DEC_BATCH 128
#define DEC_SEQ 4
#define PAST_LEN 8192
#define HEAD_DIM 64
#define ATT_WIDTH 512
#define ATT_HEADS 8
#define SSD_WIDTH 1536
#define SSD_HEADS 24
#define SSD_GROUPS 4
#define SSD_STATE 128
#define CONV_DIM 2560
#define IN_WIDTH 5656
#define PROJ_LD 5888
#define MIX_WIDTH 2048
#define WBUF 2048
#define PEER_NKEYS 128
#define PEER_HEADS 8
#define PEER_TOPK 16
#define PEER_DKEY 256
#define T_PROMPT (BATCH * SEQ)
#define T_SAMPLE (DEC_BATCH * DEC_SEQ)
#define T_ALL (T_PROMPT + T_SAMPLE)
#define O_Z 0
#define O_XBC 1536
#define O_DT 4096
#define O_Q 4120
#define O_K 4632
#define O_V 5144
#define ALPHA_F 1.189207115002721f
#define LN_EPS 1e-5f

#define OUT_YP 0ull
#define OUT_YS (OUT_YP + 16777216ull)
#define OUT_PK (OUT_YS + 524288ull)
#define OUT_PV (OUT_PK + 2097152ull)
#define OUT_PC (OUT_PV + 2097152ull)
#define OUT_PS (OUT_PC + 15360ull)
#define OUT_SK (OUT_PS + 393216ull)
#define OUT_SV (OUT_SK + 134217728ull)
#define OUT_SC (OUT_SV + 134217728ull)
#define OUT_SS (OUT_SC + 983040ull)

__constant__ double ROPE_INV_REV[32] = {
    1.59154943091895346e-01, 1.19349370211248862e-01, 8.94994016088910133e-02, 6.71150830052272551e-02,
    5.03292121044870353e-02, 3.77415847174197711e-02, 2.83021958306233987e-02, 2.12236527647776604e-02,
    1.59154943091895339e-02, 1.19349370211248862e-02, 8.94994016088910237e-03, 6.71150830052272534e-03,
    5.03292121044870370e-03, 3.77415847174197719e-03, 2.83021958306233987e-03, 2.12236527647776622e-03,
    1.59154943091895356e-03, 1.19349370211248849e-03, 8.94994016088910237e-04, 6.71150830052272599e-04,
    5.03292121044870326e-04, 3.77415847174197741e-04, 2.83021958306233954e-04, 2.12236527647776605e-04,
    1.59154943091895351e-04, 1.19349370211248862e-04, 8.94994016088910182e-05, 6.71150830052272545e-05,
    5.03292121044870354e-05, 3.77415847174197768e-05, 2.83021958306233961e-05, 2.12236527647776592e-05
};

__device__ __forceinline__ float silu_f(float x) { return x * __builtin_amdgcn_rcpf(1.0f + __expf(-x)); }
__device__ __forceinline__ float softplus_f(float x) { return fmaxf(x, 0.f) + log1pf(__expf(-fabsf(x))); }
__device__ __forceinline__ float gelu_f(float x) { return 0.5f * x * (1.0f + erff(x * 0.70710678118654752f)); }
__device__ __forceinline__ float wave_sum(float v) {
#pragma unroll
    for (int o = 32; o > 0; o >>= 1) v += __shfl_xor(v, o);
    return v;
}
__device__ __forceinline__ float wave_max(float v) {
#pragma unroll
    for (int o = 32; o > 0; o >>= 1) v = fmaxf(v, __shfl_xor(v, o));
    return v;
}

#include <cstdio>
#define XB_TMO      128
#define XB_XCNT(j)  (256  + 64 * (j))
#define XB_XSUB(j)  (1280 + 64 * (j))
#define XB_XGEN(j)  (2304 + 64 * (j))
#define XB_TOP      3328
#define XB_TOPGEN   3392
#define XCD_BAR_WORDS 3456
#define XB_SPIN_CAP (1u << 18)
#define LAS __attribute__((address_space(3)))

__device__ __forceinline__ unsigned xb_ld(unsigned* p)              { return __hip_atomic_load(p, __ATOMIC_RELAXED, __HIP_MEMORY_SCOPE_AGENT); }
__device__ __forceinline__ unsigned xb_add(unsigned* p, unsigned v) { return __hip_atomic_fetch_add(p, v, __ATOMIC_RELAXED, __HIP_MEMORY_SCOPE_AGENT); }
__device__ __forceinline__ unsigned xb_xcc_id() { return (unsigned)__builtin_amdgcn_s_getreg((3 << 11) | 20) & 0xFu; }
#define XB_SPIN(cond, bar) do { unsigned _sp = 0; while (cond) { __builtin_amdgcn_s_sleep(1); \
    if ((++_sp & 255u) == 0u) { if (xb_ld(&(bar)[XB_TMO])) break; if (_sp > XB_SPIN_CAP) { atomicAdd(&(bar)[XB_TMO], 1u); break; } } } } while (0)

struct XcdBarrier {
    unsigned* bar; unsigned x;
    volatile LAS unsigned* st;
};

__device__ __forceinline__ XcdBarrier xcd_barrier_post(unsigned* bar, volatile LAS unsigned* st) {
    XcdBarrier b; b.bar = bar; b.x = xb_xcc_id(); b.st = st;
    if (threadIdx.x == 0) (void)xb_add(&bar[XB_XCNT(b.x)], 1u);
    return b;
}
__device__ __forceinline__ void xcd_barrier_complete(unsigned* bar, unsigned x, unsigned& nloc, unsigned& nx) {
    const unsigned G = gridDim.x * gridDim.y * gridDim.z;
    unsigned sum, cnt, mine, sp = 0u;
    for (;;) {
        sum = 0u; cnt = 0u; mine = 0u;
#pragma unroll
        for (unsigned j = 0; j < 16; ++j) { const unsigned c = xb_ld(&bar[XB_XCNT(j)]); sum += c; cnt += (c > 0u) ? 1u : 0u; mine = (j == x) ? c : mine; }
        if (sum == G) break;
        __builtin_amdgcn_s_sleep(1);
        if ((++sp & 255u) == 0u) { if (xb_ld(&bar[XB_TMO])) break; if (sp > XB_SPIN_CAP) { atomicAdd(&bar[XB_TMO], 1u); break; } }
    }
    nloc = mine > 0u ? mine : 1u; nx = cnt > 0u ? cnt : 1u;
}

__device__ __forceinline__ void xcd_barrier(const XcdBarrier& b) {
    asm volatile("s_waitcnt vmcnt(0)" ::: "memory");
    __syncthreads();
    if (threadIdx.x == 0) {
        unsigned* bar = b.bar;
        __builtin_amdgcn_s_waitcnt(0);
        unsigned nloc = b.st[0], nx = b.st[1];
        if (nloc == 0u) { xcd_barrier_complete(bar, b.x, nloc, nx); b.st[0] = nloc; b.st[1] = nx; }
        const unsigned old = xb_add(&bar[XB_XSUB(b.x)], 1u);
        const unsigned gen = old / nloc;
        if (old + 1u == (gen + 1u) * nloc) {
            __builtin_amdgcn_fence(__ATOMIC_RELEASE, "agent");
            asm volatile("s_waitcnt vmcnt(0)" ::: "memory");
            const unsigned og = xb_add(&bar[XB_TOP], 1u);
            const unsigned tg = og / nx;
            if (og + 1u == (tg + 1u) * nx) xb_add(&bar[XB_TOPGEN], 1u);
            else XB_SPIN(xb_ld(&bar[XB_TOPGEN]) == tg, bar);
            __builtin_amdgcn_fence(__ATOMIC_ACQUIRE, "agent");
            xb_add(&bar[XB_XGEN(b.x)], 1u);
            asm volatile("s_waitcnt vmcnt(0)" ::: "memory");
        } else {
            XB_SPIN(xb_ld(&bar[XB_XGEN(b.x)]) == gen, bar);
            __builtin_amdgcn_fence(__ATOMIC_ACQUIRE, "agent");
            asm volatile("s_waitcnt vmcnt(0)" ::: "memory");
        }
    }
    __syncthreads();
}


#define GAS __attribute__((address_space(1)))
typedef unsigned short bf16;
typedef unsigned v4u __attribute__((ext_vector_type(4)));
#define LDS_WAIT() asm volatile("s_waitcnt lgkmcnt(0)" ::: "memory")
__device__ __forceinline__ unsigned f2bf(float f) { unsigned u = __builtin_bit_cast(unsigned, f); return (u + 0x7fffu + ((u >> 16) & 1u)) >> 16; }
__device__ __forceinline__ unsigned pk2(float lo, float hi) { return f2bf(lo) | (f2bf(hi) << 16); }
__device__ __forceinline__ float bf2f(unsigned short b) { return __builtin_bit_cast(float, (unsigned)b << 16); }
#include <hip/hip_runtime.h>
namespace pg8 {
#define PG8_LAS __attribute__((address_space(3)))
typedef unsigned short bf16_t;
typedef short bf16x8 __attribute__((ext_vector_type(8)));
typedef float f32x4 __attribute__((ext_vector_type(4)));
typedef unsigned u32x4 __attribute__((ext_vector_type(4)));
constexpr int BM = 256, BK = 64, HALF = 128, HTB = HALF * BK * 2  , STAGE_BYTES = 8 * HTB, NXCD = 8, WGM = 8;

__host__ __device__ __forceinline__ int lds_byte(int r, int c) { const int st = (r >> 4) * 2 + (c >> 5), rr = r & 15, cc = c & 31, ob = rr * 64 + cc * 2; return st * 1024 + (ob ^ (((ob >> 9) & 1) << 5)); }
__host__ __device__ __forceinline__ void stage_rc(int b, int& R, int& C) { const int st = b / 1024, sb = b % 1024, swz = sb ^ (((sb >> 9) & 1) << 5); R = (st >> 1) * 16 + swz / 64; C = (st & 1) * 32 + (swz % 64) / 2; }
__host__ __device__ __forceinline__ int perm32(int rho) { const int n = rho >> 4, i = rho & 15; return 8 * (i >> 2) + 4 * n + (i & 3); }

struct Unit { int pm, pn; };
struct Gemm { const bf16_t* A; const bf16_t* Bt; int M, N, K; };

struct StaticOrder {
    int nM, nN, nwg, G, c;
    __host__ __device__ void init(int M, int N, int G_, int c_) { nM = M / BM; nN = N / BM; nwg = nM * nN; G = G_; c = c_; }
    __host__ __device__ bool next(int i, Unit& u) const {
        const long L = (long)i * G + c; if (L >= nwg) return false;
        int wgid = (int)L; { const int q = nwg / NXCD, r = nwg % NXCD, xcd = wgid % NXCD, off = wgid / NXCD; wgid = (xcd < r ? xcd * (q + 1) : r * (q + 1) + (xcd - r) * q) + off; }
        const int nig = WGM * nN, gid = wgid / nig, fm = gid * WGM, gsz = (nM - fm) < WGM ? (nM - fm) : WGM;
        u.pm = fm + ((wgid % nig) % gsz); u.pn = (wgid % nig) / gsz; return true;
    }
    __device__ __forceinline__ void a_ready(const Unit&) const {}
    __device__ __forceinline__ void done(const Unit&) const {}
};
__device__ __forceinline__ unsigned cvt_pk_bf16(float lo, float hi) { unsigned r; asm volatile("v_cvt_pk_bf16_f32 %0, %1, %2" : "=v"(r) : "v"(lo), "v"(hi)); return r; }
typedef float f32x2 __attribute__((ext_vector_type(2)));
__device__ __forceinline__ f32x2 gelu_pk(f32x2 v) {
    const f32x2 av = __builtin_elementwise_abs(v), d = av * 0.2316418882f + 1.0f;
    f32x2 t; t.x = __builtin_amdgcn_rcpf(d.x); t.y = __builtin_amdgcn_rcpf(d.y);
    f32x2 q = t * 0.5307027145f + (-0.7265760135f); q = q * t + 0.7107068705f; q = q * t + (-0.142248368f); q = q * t + 0.127414796f; q = q * t;
    const f32x2 s = (v * v) * (-0.72134752044f);
    f32x2 e; e.x = __builtin_amdgcn_exp2f(s.x); e.y = __builtin_amdgcn_exp2f(s.y);
    const f32x2 m = v * (q * e), r = v - m;
    f32x2 o; o.x = v.x < 0.f ? m.x : r.x; o.y = v.y < 0.f ? m.y : r.y; return o;
}

struct EpiF32 {
    static constexpr bool PERM = false, AFTER_DRAIN = false;
    float* C; int ldc; const float* bias;
    __device__ __forceinline__ void operator()(const f32x4 (&acc)[2][2][4][2], const Unit& u, int wr, int wc, int fr, int fq) const {
        const int row0 = u.pm * BM + wr * 64 + fr, col0 = u.pn * BM + wc * 32 + 4 * fq;
        f32x4 bv[2][2];
#pragma unroll
        for (int bj = 0; bj < 2; ++bj)
#pragma unroll
            for (int n = 0; n < 2; ++n) bv[bj][n] = bias ? *(const f32x4*)(bias + col0 + bj * HALF + n * 16) : (f32x4){0.f, 0.f, 0.f, 0.f};
#pragma unroll
        for (int ai = 0; ai < 2; ++ai)
#pragma unroll
            for (int m = 0; m < 4; ++m) { float* rowp = C + (size_t)(row0 + ai * HALF + m * 16) * ldc + col0;
#pragma unroll
                for (int bj = 0; bj < 2; ++bj)
#pragma unroll
                    for (int n = 0; n < 2; ++n) *(f32x4*)(rowp + bj * HALF + n * 16) = acc[ai][bj][m][n] + bv[bj][n]; }
    }
};

template <class Epi, class Sched, bool STAMP = false>
__device__ __forceinline__ void gemm_phase(PG8_LAS unsigned char* lds, const Gemm g, const Sched& S, const Epi& E, unsigned long long* stamps) {
    int tid = threadIdx.x; asm volatile("" : "+v"(tid));
    const int wid = __builtin_amdgcn_readfirstlane(tid >> 6), lane = tid & 63, wr = wid >> 2, wc = wid & 3, fr = lane & 15, fq = lane >> 4;
    const int K = g.K, nt = K / BK;
    int ts_lo = 0, ts_hi = 0, nts = 0; const unsigned long long rt_entry = STAMP ? (unsigned long long)wall_clock64() : 0ull;
#define PG8_STAMP() do { if (STAMP && wid == 0 && nts < 64) { const unsigned long long _c = (unsigned long long)clock64(); \
        ts_lo = (lane == nts) ? (int)(unsigned)_c : ts_lo; ts_hi = (lane == nts) ? (int)(unsigned)(_c >> 32) : ts_hi; ++nts; } } while (0)
    PG8_STAMP();
    unsigned voffA[2], voffB[2];
#pragma unroll
    for (int i = 0; i < 2; ++i) { int R, C; stage_rc(tid * 16 + i * 8192, R, C); const int Rb = Epi::PERM ? ((R & ~31) + perm32(R & 31)) : R;
        voffA[i] = (unsigned)(R * K + C) * 2u; voffB[i] = (unsigned)(Rb * K + C) * 2u; }
    const size_t kstep = (size_t)(BK * 2);
    const size_t hstep = (size_t)HALF * K * 2;
    const size_t tstep = 2 * hstep;
    const unsigned ldsw = (unsigned)wid * 1024u;
    const int aoff = lds_byte(wr * 64 + fr, fq * 8), boff = lds_byte(wc * 32 + fr, fq * 8);
#define PG8_SA(b, h) (((b) * 2 + (h)) * HTB)
#define PG8_SB(b, h) ((4 + (b) * 2 + (h)) * HTB)
#define PG8_STAGE(bufoff, gbase, voff) do { _Pragma("unroll") for (int _i = 0; _i < 2; ++_i) \
        __builtin_amdgcn_global_load_lds((const unsigned*)((const char*)(gbase) + (voff)[_i]), (PG8_LAS unsigned*)(lds + (bufoff) + ldsw + _i * 8192), 16, 0, 0); } while (0)
#define PG8_LDA(dst, b, h) do { _Pragma("unroll") for (int m = 0; m < 4; ++m) _Pragma("unroll") for (int k = 0; k < 2; ++k) dst[m][k] = *(const PG8_LAS bf16x8*)(lds + PG8_SA(b, h) + aoff + m * 2048 + k * 1024); } while (0)
#define PG8_LDB(dst, b, h) do { _Pragma("unroll") for (int n = 0; n < 2; ++n) _Pragma("unroll") for (int k = 0; k < 2; ++k) dst[n][k] = *(const PG8_LAS bf16x8*)(lds + PG8_SB(b, h) + boff + n * 2048 + k * 1024); } while (0)
#define PG8_MMA(ai, bj, At, Bt) do { __builtin_amdgcn_s_setprio(1); _Pragma("unroll") for (int m = 0; m < 4; ++m) _Pragma("unroll") for (int n = 0; n < 2; ++n) _Pragma("unroll") for (int k = 0; k < 2; ++k) \
        acc[ai][bj][m][n] = __builtin_amdgcn_mfma_f32_16x16x32_bf16(Bt[n][k], At[m][k], acc[ai][bj][m][n], 0, 0, 0); __builtin_amdgcn_s_setprio(0); } while (0)
#define PG8_WAIT_V(n) asm volatile("s_waitcnt vmcnt(" #n ")" ::: "memory")
#define PG8_WAIT_L(n) asm volatile("s_waitcnt lgkmcnt(" #n ")" ::: "memory")
#define PG8_BAR __builtin_amdgcn_s_barrier()
#define PG8_SCHED __builtin_amdgcn_sched_barrier(0)
    Unit cur, nxt; int ui = 0;
    if (!S.next(0, cur)) return;
    f32x4 acc[2][2][4][2];
#pragma unroll
    for (int a = 0; a < 2; ++a)
#pragma unroll
        for (int b = 0; b < 2; ++b)
#pragma unroll
            for (int m = 0; m < 4; ++m)
#pragma unroll
                for (int n = 0; n < 2; ++n) acc[a][b][m][n] = (f32x4){0.f, 0.f, 0.f, 0.f};
    bf16x8 At[4][2], B0[2][2], B1[2][2];
    const char* cA = (const char*)g.A + (size_t)cur.pm * tstep; const char* cB = (const char*)g.Bt + (size_t)cur.pn * tstep;
    S.a_ready(cur);
    PG8_STAGE(PG8_SB(0, 0), cB, voffB); PG8_STAGE(PG8_SA(0, 0), cA, voffA); PG8_STAGE(PG8_SB(0, 1), cB + hstep, voffB); PG8_STAGE(PG8_SA(0, 1), cA + hstep, voffA);
    if (wr == 1) PG8_BAR;
    PG8_WAIT_V(4); PG8_BAR;
    PG8_STAGE(PG8_SB(1, 0), cB + kstep, voffB); PG8_STAGE(PG8_SA(1, 0), cA + kstep, voffA); PG8_STAGE(PG8_SB(1, 1), cB + hstep + kstep, voffB);
    PG8_WAIT_V(6); PG8_BAR;
    PG8_STAMP();
    for (;;) {
        const bool has_next = S.next(ui + 1, nxt);
        const char* nA = has_next ? (const char*)g.A + (size_t)nxt.pm * tstep : cA; const char* nB = has_next ? (const char*)g.Bt + (size_t)nxt.pn * tstep : cB;
        for (int t = 0; t < nt; t += 2) {
            const bool last = (t == nt - 2);
            const char* a1 = cA + (size_t)(t + 1) * kstep;
            const char* a2 = last ? nA : cA + (size_t)(t + 2) * kstep; const char* b2 = last ? nB : cB + (size_t)(t + 2) * kstep;
            const char* a3 = a2 + kstep; const char* b3 = b2 + kstep;
            if (last && has_next) S.a_ready(nxt);
            PG8_LDB(B0, 0, 0); PG8_SCHED; PG8_LDA(At, 0, 0); PG8_STAGE(PG8_SA(1, 1), a1 + hstep, voffA);
            PG8_WAIT_L(8); PG8_BAR; PG8_WAIT_L(0); PG8_MMA(0, 0, At, B0); PG8_BAR; PG8_SCHED;
            PG8_LDB(B1, 0, 1); PG8_STAGE(PG8_SB(0, 0), b2, voffB);
            PG8_BAR; PG8_WAIT_L(0); PG8_MMA(0, 1, At, B1); PG8_BAR;
            PG8_LDA(At, 0, 1); PG8_STAGE(PG8_SA(0, 0), a2, voffA);
            PG8_BAR; PG8_WAIT_L(0); PG8_MMA(1, 0, At, B0); PG8_BAR; PG8_SCHED;
            PG8_STAGE(PG8_SB(0, 1), b2 + hstep, voffB);
            PG8_WAIT_V(6); PG8_BAR; PG8_MMA(1, 1, At, B1); PG8_BAR;
            PG8_LDB(B0, 1, 0); PG8_SCHED; PG8_LDA(At, 1, 0); PG8_STAGE(PG8_SA(0, 1), a2 + hstep, voffA);
            PG8_WAIT_L(8); PG8_BAR; PG8_WAIT_L(0); PG8_MMA(0, 0, At, B0); PG8_BAR; PG8_SCHED;
            PG8_LDB(B1, 1, 1); PG8_STAGE(PG8_SB(1, 0), b3, voffB);
            PG8_BAR; PG8_WAIT_L(0); PG8_MMA(0, 1, At, B1); PG8_BAR;
            PG8_LDA(At, 1, 1); PG8_STAGE(PG8_SA(1, 0), a3, voffA);
            PG8_BAR; PG8_WAIT_L(0); PG8_MMA(1, 0, At, B0); PG8_BAR; PG8_SCHED;
            PG8_STAGE(PG8_SB(1, 1), b3 + hstep, voffB);
            PG8_WAIT_V(6); PG8_BAR; PG8_MMA(1, 1, At, B1); PG8_BAR;
        }
        PG8_STAMP();
        if constexpr (!Epi::AFTER_DRAIN) { E(acc, cur, wr, wc, fr, fq); S.done(cur); }
        PG8_STAMP();
        if (!has_next) break;
#pragma unroll
        for (int a = 0; a < 2; ++a)
#pragma unroll
            for (int b = 0; b < 2; ++b)
#pragma unroll
                for (int m = 0; m < 4; ++m)
#pragma unroll
                    for (int n = 0; n < 2; ++n) acc[a][b][m][n] = (f32x4){0.f, 0.f, 0.f, 0.f};
        cur = nxt; cA = nA; cB = nB; ++ui;
    }
    PG8_WAIT_V(0);
    if (wr == 0) PG8_BAR;
    PG8_BAR;
    if constexpr (Epi::AFTER_DRAIN) { E.fused(acc, cur, wr, wc, fr, fq, lds, wid, lane); S.done(cur); }
    PG8_STAMP();
    if (STAMP && wid == 0) { stamps[lane] = lane < nts ? (((unsigned long long)(unsigned)ts_hi << 32) | (unsigned)ts_lo) : 0ull;
        if (lane == 62) stamps[62] = rt_entry; if (lane == 63) stamps[63] = (unsigned long long)wall_clock64(); }
#undef PG8_STAMP
#undef PG8_SA
#undef PG8_SB
#undef PG8_STAGE
#undef PG8_LDA
#undef PG8_LDB
#undef PG8_MMA
#undef PG8_WAIT_V
#undef PG8_WAIT_L
#undef PG8_BAR
#undef PG8_SCHED
}
}


namespace pg8 {
struct EpiProj {
    static constexpr bool PERM = true, AFTER_DRAIN = false;
    bf16_t* O; float* dtraw;
    __device__ __forceinline__ void operator()(const f32x4 (&acc)[2][2][4][2], const Unit& u, int wr, int wc, int fr, int fq) const {
        const int row0 = u.pm * BM + wr * 64 + fr;
        if (u.pn < 22) {
            const int col0 = u.pn * BM + wc * 32 + 8 * fq;
#pragma unroll
            for (int ai = 0; ai < 2; ++ai)
#pragma unroll
                for (int m = 0; m < 4; ++m) { bf16_t* rowp = O + (size_t)(row0 + ai * HALF + m * 16) * 5632 + col0;
#pragma unroll
                    for (int bj = 0; bj < 2; ++bj) { const f32x4 v0 = acc[ai][bj][m][0], v1 = acc[ai][bj][m][1];
                        u32x4 w; w.x = cvt_pk_bf16(v0[0], v0[1]); w.y = cvt_pk_bf16(v0[2], v0[3]); w.z = cvt_pk_bf16(v1[0], v1[1]); w.w = cvt_pk_bf16(v1[2], v1[3]);
                        *(u32x4*)(rowp + bj * HALF) = w; } }
        } else if (wc == 0) {
#pragma unroll
            for (int ai = 0; ai < 2; ++ai)
#pragma unroll
                for (int m = 0; m < 4; ++m) { float* rp = dtraw + (size_t)(row0 + ai * HALF + m * 16) * 32 + 8 * fq;
                    *(f32x4*)rp = acc[ai][0][m][0]; *(f32x4*)(rp + 4) = acc[ai][0][m][1]; }
        }
    }
};
}


namespace pg8 {
struct EpiBf16Plain {
    static constexpr bool PERM = true, AFTER_DRAIN = false;
    bf16_t* O; int ldc;
    __device__ __forceinline__ void operator()(const f32x4 (&acc)[2][2][4][2], const Unit& u, int wr, int wc, int fr, int fq) const {
        const int row0 = u.pm * BM + wr * 64 + fr, col0 = u.pn * BM + wc * 32 + 8 * fq;
#pragma unroll
        for (int ai = 0; ai < 2; ++ai)
#pragma unroll
            for (int m = 0; m < 4; ++m) { bf16_t* rowp = O + (size_t)(row0 + ai * HALF + m * 16) * ldc + col0;
#pragma unroll
                for (int bj = 0; bj < 2; ++bj) { const f32x4 v0 = acc[ai][bj][m][0], v1 = acc[ai][bj][m][1];
                    u32x4 w; w.x = cvt_pk_bf16(v0[0], v0[1]); w.y = cvt_pk_bf16(v0[2], v0[3]); w.z = cvt_pk_bf16(v1[0], v1[1]); w.w = cvt_pk_bf16(v1[2], v1[3]);
                    *(u32x4*)(rowp + bj * HALF) = w; } }
    }
};
}

#define NTHR 512
#define NWAVE 8

__device__ __forceinline__ void ph_gemm_f32(float* lds, const float* __restrict__ A, const float* __restrict__ B, float* __restrict__ C,
                                            int M, int N, int K, int lda, int ldb, int ldc) {
    const int tid = threadIdx.x & 255, half = threadIdx.x >> 8, tx = tid & 15, ty = tid >> 4;
    float (*As)[68] = (float (*)[68])(lds + half * 2 * 16 * 68);
    float (*Bs)[68] = (float (*)[68])(lds + half * 2 * 16 * 68 + 16 * 68);
    const int ntx = (N + 63) / 64, nty = M / 64, ntiles = ntx * nty;
    for (int it = blockIdx.x; 2 * it < ntiles; it += gridDim.x) {
        const int tile = 2 * it + half;
        const int m0 = (tile / ntx) * 64, n0 = (tile % ntx) * 64;
        float acc[4][4];
#pragma unroll
        for (int i = 0; i < 4; ++i)
#pragma unroll
            for (int j = 0; j < 4; ++j) acc[i][j] = 0.f;
        for (int k0 = 0; k0 < K; k0 += 16) {
#pragma unroll
            for (int i = 0; i < 4; ++i) {
                int idx = tid + i * 256;
                int r = idx >> 4, c = idx & 15;
                As[c][r] = (m0 + r < M) ? A[(size_t)(m0 + r) * lda + k0 + c] : 0.f;
                int rb = idx >> 6, cb = idx & 63;
                Bs[rb][cb] = (n0 + cb < N) ? B[(size_t)(k0 + rb) * ldb + n0 + cb] : 0.f;
            }
            __syncthreads();
#pragma unroll
            for (int k = 0; k < 16; ++k) {
                float a[4], b[4];
#pragma unroll
                for (int i = 0; i < 4; ++i) { a[i] = As[k][ty * 4 + i]; b[i] = Bs[k][tx * 4 + i]; }
#pragma unroll
                for (int i = 0; i < 4; ++i)
#pragma unroll
                    for (int j = 0; j < 4; ++j) acc[i][j] += a[i] * b[j];
            }
            __syncthreads();
        }
#pragma unroll
        for (int i = 0; i < 4; ++i)
#pragma unroll
            for (int j = 0; j < 4; ++j) {
                int r = m0 + ty * 4 + i, c = n0 + tx * 4 + j;
                if (r < M && c < N) C[(size_t)r * ldc + c] = acc[i][j];
            }
    }
}


template <int MODE>
__device__ __forceinline__ void transpose_item(const float* __restrict__ W, int K, int N, int Npad, bf16* __restrict__ WT, LAS float* scr, int item, int lane) {
    const int nblk = Npad / 32, kb = item / nblk, nb = item % nblk, k0 = 64 * kb, n0 = 32 * nb;
    const int n = n0 + (lane & 31);
    int sc = n;
    if (MODE == 1) sc = (n < 4096) ? n : (n < 5632 ? n + 24 : (n < 5656 ? n - 5632 + 4096 : -1));
    else sc = (n < N) ? n : -1;
#pragma unroll 8
    for (int i = 0; i < 32; ++i) { const int kk = 2 * i + (lane >> 5); scr[kk * 33 + (lane & 31)] = (sc >= 0) ? W[(size_t)(k0 + kk) * N + sc] : 0.f; }
    LDS_WAIT(); asm volatile("" ::: "memory");
    const int c = lane & 7;
#pragma unroll
    for (int j = 0; j < 4; ++j) { const int nn = (lane >> 3) + 8 * j; const LAS float* s = scr + (8 * c) * 33 + nn;
        v4u o; o.x = pk2(s[0 * 33], s[1 * 33]); o.y = pk2(s[2 * 33], s[3 * 33]); o.z = pk2(s[4 * 33], s[5 * 33]); o.w = pk2(s[6 * 33], s[7 * 33]);
        *(v4u*)(WT + (size_t)(n0 + nn) * K + k0 + 8 * c) = o; }
    LDS_WAIT(); asm volatile("" ::: "memory");
}
__device__ __forceinline__ void ph_prologue(LAS unsigned char* ldsb, const float* __restrict__ xp, const float* __restrict__ xs, bf16* __restrict__ A0,
                                            const float* __restrict__ w_in, bf16* __restrict__ wt_in, float* __restrict__ rope_tab) {
    const int lane = threadIdx.x & 63, wave = threadIdx.x >> 6;
    LAS float* scr = (LAS float*)(ldsb + wave * 16384);
    const int gw = blockIdx.x * NWAVE + wave, NGW = gridDim.x * NWAVE;
    constexpr int I_IN = (D_MODEL / 64) * (PROJ_LD / 32);
    for (int it = gw; it < I_IN; it += NGW) transpose_item<1>(w_in, D_MODEL, IN_WIDTH, PROJ_LD, wt_in, scr, it, lane);
    for (int idx = blockIdx.x * NTHR + threadIdx.x; idx < SEQ * 32; idx += gridDim.x * NTHR) {
        const int pos = idx >> 5, j = idx & 31;
        const double rev = (double)pos * ROPE_INV_REV[j];
        const float fr = (float)(rev - floor(rev));
        rope_tab[(size_t)pos * 64 + j] = __builtin_amdgcn_cosf(fr); rope_tab[(size_t)pos * 64 + 32 + j] = __builtin_amdgcn_sinf(fr);
    }
    const size_t n8 = (size_t)T_ALL * D_MODEL / 8, np8 = (size_t)T_PROMPT * D_MODEL / 8;
#pragma unroll 4
    for (size_t i = (size_t)blockIdx.x * NTHR + threadIdx.x; i < n8; i += (size_t)gridDim.x * NTHR) {
        const float4* s = (i < np8) ? (const float4*)xp + 2 * i : (const float4*)xs + 2 * (i - np8);
        float4 a = s[0], b = s[1];
        v4u o; o.x = pk2(a.x, a.y); o.y = pk2(a.z, a.w); o.z = pk2(b.x, b.y); o.w = pk2(b.z, b.w);
        ((v4u*)A0)[i] = o;
    }
}
__device__ __forceinline__ void ph_prologue2(LAS unsigned char* ldsb, const float* __restrict__ w_out, bf16* __restrict__ wt_out, const float* __restrict__ w_q, bf16* __restrict__ wt_q,
                                             int rank, int nranks) {
    const int lane = threadIdx.x & 63, wave = threadIdx.x >> 6;
    LAS float* scr = (LAS float*)(ldsb + wave * 16384);
    constexpr int I_OUT = (MIX_WIDTH / 64) * (D_MODEL / 32), I_Q = (D_MODEL / 64) * (2048 / 32);
    for (int it = rank * NWAVE + wave; it < I_OUT + I_Q; it += nranks * NWAVE) {
        if (it < I_OUT) transpose_item<0>(w_out, MIX_WIDTH, D_MODEL, D_MODEL, wt_out, scr, it, lane);
        else transpose_item<0>(w_q, D_MODEL, 2048, 2048, wt_q, scr, it - I_OUT, lane);
    }
}

__device__ __forceinline__ void ph_concat_x(const float* __restrict__ xp, const float* __restrict__ xs, float* __restrict__ xall) {
    const size_t n4 = (size_t)T_ALL * D_MODEL / 4, np4 = (size_t)T_PROMPT * D_MODEL / 4;
    for (size_t i = (size_t)blockIdx.x * NTHR + threadIdx.x; i < n4; i += (size_t)gridDim.x * NTHR) {
        float4 v = (i < np4) ? ((const float4*)xp)[i] : ((const float4*)xs)[i - np4];
        ((float4*)xall)[i] = v;
    }
}

typedef float f32x4n __attribute__((ext_vector_type(4)));
__device__ __forceinline__ void ph_cache_copy(const float* __restrict__ ck, const float* __restrict__ cv, float* __restrict__ out) {
    constexpr unsigned PER_B = (WBUF - DEC_SEQ) * ATT_WIDTH / 4;
    constexpr unsigned TOTAL = 2u * DEC_BATCH * PER_B;
    for (unsigned c = blockIdx.x; c < TOTAL / 4096u; c += gridDim.x) {
        f32x4n v[8]; size_t dsti[8]; bool isv[8];
#pragma unroll
        for (int j = 0; j < 8; ++j) {
            const unsigned idx = c * 4096u + j * 512u + threadIdx.x;
            const unsigned tb = idx / PER_B, r = idx - tb * PER_B, bb = tb & (DEC_BATCH - 1);
            isv[j] = tb >= DEC_BATCH;
            const size_t srci = (size_t)bb * (WBUF * ATT_WIDTH / 4) + (DEC_SEQ * ATT_WIDTH / 4) + r;
            dsti[j] = (size_t)bb * (WBUF * ATT_WIDTH / 4) + r;
            v[j] = __builtin_nontemporal_load((isv[j] ? (const f32x4n*)cv : (const f32x4n*)ck) + srci);
        }
#pragma unroll
        for (int j = 0; j < 8; ++j) __builtin_nontemporal_store(v[j], (f32x4n*)(out + (isv[j] ? OUT_SV : OUT_SK)) + dsti[j]);
    }
}

__device__ __forceinline__ void ph_post_proj(const float* __restrict__ proj, const float* __restrict__ state_conv,
                                             const float* __restrict__ conv_w, const float* __restrict__ conv_b, const float* __restrict__ dt_bias,
                                             float* __restrict__ xbc_act, float* __restrict__ dtv, float* __restrict__ qrot, float* __restrict__ krot,
                                             float* __restrict__ out) {
    const int tid = threadIdx.x & 255, half = threadIdx.x >> 8;
    for (int t = 2 * blockIdx.x + half; t < T_ALL; t += 2 * gridDim.x) {
        const bool is_p = t < T_PROMPT;
        int b, i, pos;
        if (is_p) { b = t / SEQ; i = t % SEQ; pos = i; } else { int ts = t - T_PROMPT; b = ts / DEC_SEQ; i = ts % DEC_SEQ; pos = PAST_LEN + i; }
        const float* row = proj + (size_t)t * PROJ_LD;
        for (int c = tid; c < CONV_DIM; c += 256) {
            float acc = conv_b[c];
#pragma unroll
            for (int tap = 0; tap < 4; ++tap) {
                int r = i - 3 + tap;
                float val;
                if (r >= 0) val = proj[(size_t)(t - i + r) * PROJ_LD + O_XBC + c];
                else val = is_p ? 0.f : state_conv[((size_t)b * 3 + (3 + r)) * CONV_DIM + c];
                acc += val * conv_w[tap * CONV_DIM + c];
            }
            xbc_act[(size_t)t * CONV_DIM + c] = silu_f(acc);
        }
        if (tid < SSD_HEADS) dtv[(size_t)t * SSD_HEADS + tid] = softplus_f(row[O_DT + tid] + dt_bias[tid]);
        for (int idx = tid; idx < 512; idx += 256) {
            int which = idx >> 8, h = (idx >> 5) & 7, j = idx & 31;
            double rev = (double)pos * ROPE_INV_REV[j];
            float fr = (float)(rev - floor(rev));
            float sn = __builtin_amdgcn_sinf(fr), cs = __builtin_amdgcn_cosf(fr);
            const float* src = row + (which ? O_K : O_Q) + h * 64;
            float t1 = src[j], t2 = src[j + 32];
            float o1 = t1 * cs - t2 * sn, o2 = t2 * cs + t1 * sn;
            float* dst = (which ? krot : qrot) + (size_t)t * ATT_WIDTH + h * 64;
            dst[j] = o1; dst[j + 32] = o2;
            if (which) {
                if (is_p) { if (i >= SEQ - WBUF) { float* o = out + OUT_PK + ((size_t)b * WBUF + (i - (SEQ - WBUF))) * ATT_WIDTH + h * 64; o[j] = o1; o[j + 32] = o2; } }
                else { float* o = out + OUT_SK + ((size_t)b * WBUF + (WBUF - DEC_SEQ + i)) * ATT_WIDTH + h * 64; o[j] = o1; o[j + 32] = o2; }
            }
        }
        for (int c = tid; c < ATT_WIDTH; c += 256) {
            float v = row[O_V + c];
            if (is_p) { if (i >= SEQ - WBUF) out[OUT_PV + ((size_t)b * WBUF + (i - (SEQ - WBUF))) * ATT_WIDTH + c] = v; }
            else out[OUT_SV + ((size_t)b * WBUF + (WBUF - DEC_SEQ + i)) * ATT_WIDTH + c] = v;
        }
        if (is_p) {
            if (i >= SEQ - 3) { int r = i - (SEQ - 3); for (int c = tid; c < CONV_DIM; c += 256) out[OUT_PC + ((size_t)b * 3 + r) * CONV_DIM + c] = row[O_XBC + c]; }
        } else {
            if (i >= 1) { int r = i - 1; for (int c = tid; c < CONV_DIM; c += 256) out[OUT_SC + ((size_t)b * 3 + r) * CONV_DIM + c] = row[O_XBC + c]; }
        }
    }
}


#define NB_LD 5632
#define NB_XBC 1536
#define NB_Q 4096
#define NB_K 4608
#define NB_V 5120
__device__ __forceinline__ void unpack8(const v4u w, float (&f)[8]) {
    f[0] = __builtin_bit_cast(float, w.x << 16); f[1] = __builtin_bit_cast(float, w.x & 0xffff0000u);
    f[2] = __builtin_bit_cast(float, w.y << 16); f[3] = __builtin_bit_cast(float, w.y & 0xffff0000u);
    f[4] = __builtin_bit_cast(float, w.z << 16); f[5] = __builtin_bit_cast(float, w.z & 0xffff0000u);
    f[6] = __builtin_bit_cast(float, w.w << 16); f[7] = __builtin_bit_cast(float, w.w & 0xffff0000u);
}
__device__ __forceinline__ void store8f(float* d, const float (&f)[8]) { *(float4*)d = make_float4(f[0], f[1], f[2], f[3]); *(float4*)(d + 4) = make_float4(f[4], f[5], f[6], f[7]); }
__device__ __forceinline__ void ph_post_proj2(const bf16* __restrict__ projb, const float* __restrict__ dtraw, const float* __restrict__ state_conv,
                                              const float* __restrict__ conv_w, const float* __restrict__ conv_b, const float* __restrict__ dt_bias,
                                              bf16* __restrict__ xbc_b, float* __restrict__ dtv, bf16* __restrict__ qrot_b, bf16* __restrict__ krot_b,
                                              float* __restrict__ out) {
    const int tid = threadIdx.x & 255, half = threadIdx.x >> 8;
    for (int t = T_PROMPT + 2 * blockIdx.x + half; t < T_ALL; t += 2 * gridDim.x) {
        const bool is_p = t < T_PROMPT;
        int b, i, pos;
        if (is_p) { b = t / SEQ; i = t % SEQ; pos = i; } else { int ts = t - T_PROMPT; b = ts / DEC_SEQ; i = ts % DEC_SEQ; pos = PAST_LEN + i; }
        const bf16* row = projb + (size_t)t * NB_LD;
        if (tid < 64) {
            float f[8]; unpack8(*(const v4u*)(row + NB_V + tid * 8), f);
            if (is_p) { if (i >= SEQ - WBUF) store8f(out + OUT_PV + ((size_t)b * WBUF + (i - (SEQ - WBUF))) * ATT_WIDTH + tid * 8, f); }
            else store8f(out + OUT_SV + ((size_t)b * WBUF + (WBUF - DEC_SEQ + i)) * ATT_WIDTH + tid * 8, f);
        }
        for (int c8 = tid; c8 < 320; c8 += 256) {
            const int c = c8 * 8;
            float acc[8], cur[8];
            { const float4 b0 = *(const float4*)(conv_b + c), b1 = *(const float4*)(conv_b + c + 4);
              acc[0] = b0.x; acc[1] = b0.y; acc[2] = b0.z; acc[3] = b0.w; acc[4] = b1.x; acc[5] = b1.y; acc[6] = b1.z; acc[7] = b1.w; }
#pragma unroll
            for (int tap = 0; tap < 4; ++tap) {
                const int r = i - 3 + tap;
                float val[8];
                if (r >= 0) unpack8(*(const v4u*)(projb + (size_t)(t - i + r) * NB_LD + NB_XBC + c), val);
                else if (!is_p) { const float* sp = state_conv + ((size_t)b * 3 + (3 + r)) * CONV_DIM + c; const float4 s0 = *(const float4*)sp, s1 = *(const float4*)(sp + 4);
                    val[0] = s0.x; val[1] = s0.y; val[2] = s0.z; val[3] = s0.w; val[4] = s1.x; val[5] = s1.y; val[6] = s1.z; val[7] = s1.w; }
                else {
#pragma unroll
                    for (int j = 0; j < 8; ++j) val[j] = 0.f; }
                const float4 w0 = *(const float4*)(conv_w + tap * CONV_DIM + c), w1 = *(const float4*)(conv_w + tap * CONV_DIM + c + 4);
                acc[0] += val[0] * w0.x; acc[1] += val[1] * w0.y; acc[2] += val[2] * w0.z; acc[3] += val[3] * w0.w;
                acc[4] += val[4] * w1.x; acc[5] += val[5] * w1.y; acc[6] += val[6] * w1.z; acc[7] += val[7] * w1.w;
                if (tap == 3) {
#pragma unroll
                    for (int j = 0; j < 8; ++j) cur[j] = val[j]; }
            }
#pragma unroll
            for (int j = 0; j < 8; ++j) acc[j] = silu_f(acc[j]);
            v4u o; o.x = pk2(acc[0], acc[1]); o.y = pk2(acc[2], acc[3]); o.z = pk2(acc[4], acc[5]); o.w = pk2(acc[6], acc[7]);
            *(v4u*)(xbc_b + (size_t)t * CONV_DIM + c) = o;
            if (is_p) { if (i >= SEQ - 3) store8f(out + OUT_PC + ((size_t)b * 3 + (i - (SEQ - 3))) * CONV_DIM + c, cur); }
            else { if (i >= 1) store8f(out + OUT_SC + ((size_t)b * 3 + (i - 1)) * CONV_DIM + c, cur); }
        }
        if (tid < SSD_HEADS) dtv[(size_t)t * SSD_HEADS + tid] = softplus_f(dtraw[(size_t)t * 32 + tid] + dt_bias[tid]);
        if (tid < 128) {
            const int which = tid >> 6, h = (tid >> 3) & 7, jc = tid & 7;
            const bf16* src = row + (which ? NB_K : NB_Q) + h * 64 + jc * 4;
            const uint2 lo = *(const uint2*)src, hi = *(const uint2*)(src + 32);
            float t1[4], t2[4], o1[4], o2[4];
            t1[0] = __builtin_bit_cast(float, lo.x << 16); t1[1] = __builtin_bit_cast(float, lo.x & 0xffff0000u); t1[2] = __builtin_bit_cast(float, lo.y << 16); t1[3] = __builtin_bit_cast(float, lo.y & 0xffff0000u);
            t2[0] = __builtin_bit_cast(float, hi.x << 16); t2[1] = __builtin_bit_cast(float, hi.x & 0xffff0000u); t2[2] = __builtin_bit_cast(float, hi.y << 16); t2[3] = __builtin_bit_cast(float, hi.y & 0xffff0000u);
#pragma unroll
            for (int e = 0; e < 4; ++e) {
                const double rev = (double)pos * ROPE_INV_REV[jc * 4 + e];
                const float fr = (float)(rev - floor(rev));
                const float sn = __builtin_amdgcn_sinf(fr), cs = __builtin_amdgcn_cosf(fr);
                o1[e] = t1[e] * cs - t2[e] * sn; o2[e] = t2[e] * cs + t1[e] * sn;
            }
            const size_t doff = (size_t)t * ATT_WIDTH + h * 64 + jc * 4;
            bf16* db = which ? krot_b : qrot_b;
            *(uint2*)(db + doff) = make_uint2(pk2(o1[0], o1[1]), pk2(o1[2], o1[3])); *(uint2*)(db + doff + 32) = make_uint2(pk2(o2[0], o2[1]), pk2(o2[2], o2[3]));
            if (which) {
                float* o = nullptr;
                if (is_p) { if (i >= SEQ - WBUF) o = out + OUT_PK + ((size_t)b * WBUF + (i - (SEQ - WBUF))) * ATT_WIDTH + h * 64 + jc * 4; }
                else o = out + OUT_SK + ((size_t)b * WBUF + (WBUF - DEC_SEQ + i)) * ATT_WIDTH + h * 64 + jc * 4;
                if (o) { *(float4*)o = make_float4(o1[0], o1[1], o1[2], o1[3]); *(float4*)(o + 32) = make_float4(o2[0], o2[1], o2[2], o2[3]); }
            }
        }
    }
}


__device__ __forceinline__ void ph_post_proj_prompt(const bf16* __restrict__ projb, const float* __restrict__ dtraw, const float* __restrict__ conv_w, const float* __restrict__ conv_b,
                                                    const float* __restrict__ dt_bias, const float* __restrict__ rope_tab, bf16* __restrict__ xbc_b, float* __restrict__ dtv,
                                                    bf16* __restrict__ qrot_b, bf16* __restrict__ krot_b, float* __restrict__ out) {
    const int gtid = blockIdx.x * NTHR + threadIdx.x, gsz = gridDim.x * NTHR;
    for (int item = gtid; item < (T_PROMPT / 16) * 320; item += gsz) {
        const int run = item / 320, c = (item - run * 320) * 8, t0 = run * 16, i0 = t0 & (SEQ - 1), b = t0 >> 13;
        float w[4][8], bias[8];
#pragma unroll
        for (int tap = 0; tap < 4; ++tap) { const float4 w0 = *(const float4*)(conv_w + tap * CONV_DIM + c), w1 = *(const float4*)(conv_w + tap * CONV_DIM + c + 4);
            w[tap][0] = w0.x; w[tap][1] = w0.y; w[tap][2] = w0.z; w[tap][3] = w0.w; w[tap][4] = w1.x; w[tap][5] = w1.y; w[tap][6] = w1.z; w[tap][7] = w1.w; }
        { const float4 b0 = *(const float4*)(conv_b + c), b1 = *(const float4*)(conv_b + c + 4);
          bias[0] = b0.x; bias[1] = b0.y; bias[2] = b0.z; bias[3] = b0.w; bias[4] = b1.x; bias[5] = b1.y; bias[6] = b1.z; bias[7] = b1.w; }
        const bf16* src = projb + (size_t)t0 * NB_LD + NB_XBC + c;
        v4u raw[19];
#pragma unroll
        for (int s = 0; s < 19; ++s) { v4u z; z.x = 0u; z.y = 0u; z.z = 0u; z.w = 0u; raw[s] = (s >= 3 || i0 != 0) ? *(const v4u*)(src + (ptrdiff_t)(s - 3) * NB_LD) : z; }
        float p0[8], p1[8], p2[8];
        unpack8(raw[0], p0); unpack8(raw[1], p1); unpack8(raw[2], p2);
#pragma unroll
        for (int s = 0; s < 16; ++s) {
            float cur[8], acc[8]; unpack8(raw[s + 3], cur);
#pragma unroll
            for (int j = 0; j < 8; ++j) acc[j] = silu_f(bias[j] + p0[j] * w[0][j] + p1[j] * w[1][j] + p2[j] * w[2][j] + cur[j] * w[3][j]);
            v4u o; o.x = pk2(acc[0], acc[1]); o.y = pk2(acc[2], acc[3]); o.z = pk2(acc[4], acc[5]); o.w = pk2(acc[6], acc[7]);
            *(v4u*)(xbc_b + (size_t)(t0 + s) * CONV_DIM + c) = o;
            if (i0 + s >= SEQ - 3) store8f(out + OUT_PC + ((size_t)b * 3 + (i0 + s - (SEQ - 3))) * CONV_DIM + c, cur);
#pragma unroll
            for (int j = 0; j < 8; ++j) { p0[j] = p1[j]; p1[j] = p2[j]; p2[j] = cur[j]; }
        }
    }
#pragma unroll 4
    for (int item = gtid; item < T_PROMPT * 128; item += gsz) {
        const int t = item >> 7, sub = item & 127, which = sub >> 6, h = (sub >> 3) & 7, jc = sub & 7, i = t & (SEQ - 1), b = t >> 13;
        const bf16* src = projb + (size_t)t * NB_LD + (which ? NB_K : NB_Q) + h * 64 + jc * 4;
        const uint2 lo = *(const uint2*)src, hi = *(const uint2*)(src + 32);
        const float4 cs = *(const float4*)(rope_tab + (size_t)i * 64 + jc * 4), sn = *(const float4*)(rope_tab + (size_t)i * 64 + 32 + jc * 4);
        float t1[4], t2[4], o1[4], o2[4];
        t1[0] = __builtin_bit_cast(float, lo.x << 16); t1[1] = __builtin_bit_cast(float, lo.x & 0xffff0000u); t1[2] = __builtin_bit_cast(float, lo.y << 16); t1[3] = __builtin_bit_cast(float, lo.y & 0xffff0000u);
        t2[0] = __builtin_bit_cast(float, hi.x << 16); t2[1] = __builtin_bit_cast(float, hi.x & 0xffff0000u); t2[2] = __builtin_bit_cast(float, hi.y << 16); t2[3] = __builtin_bit_cast(float, hi.y & 0xffff0000u);
        const float cv[4] = {cs.x, cs.y, cs.z, cs.w}, sv[4] = {sn.x, sn.y, sn.z, sn.w};
#pragma unroll
        for (int e = 0; e < 4; ++e) { o1[e] = t1[e] * cv[e] - t2[e] * sv[e]; o2[e] = t2[e] * cv[e] + t1[e] * sv[e]; }
        const size_t doff = (size_t)t * ATT_WIDTH + h * 64 + jc * 4;
        bf16* db = which ? krot_b : qrot_b;
        *(uint2*)(db + doff) = make_uint2(pk2(o1[0], o1[1]), pk2(o1[2], o1[3])); *(uint2*)(db + doff + 32) = make_uint2(pk2(o2[0], o2[1]), pk2(o2[2], o2[3]));
        if (which && i >= SEQ - WBUF) {
            float* o = out + OUT_PK + ((size_t)b * WBUF + (i - (SEQ - WBUF))) * ATT_WIDTH + h * 64 + jc * 4;
            *(float4*)o = make_float4(o1[0], o1[1], o1[2], o1[3]); *(float4*)(o + 32) = make_float4(o2[0], o2[1], o2[2], o2[3]);
        }
    }
#pragma unroll 4
    for (int item = gtid; item < T_PROMPT * SSD_HEADS; item += gsz) { const int t = item / SSD_HEADS, hd = item - t * SSD_HEADS; dtv[item] = softplus_f(dtraw[(size_t)t * 32 + hd] + dt_bias[hd]); }
#pragma unroll 2
    for (int item = gtid; item < BATCH * WBUF * 64; item += gsz) {
        const int ch = item & 63, j = (item >> 6) & (WBUF - 1), b = item >> 17;
        float f[8]; unpack8(*(const v4u*)(projb + (size_t)(b * SEQ + (SEQ - WBUF) + j) * NB_LD + NB_V + ch * 8), f);
        store8f(out + OUT_PV + ((size_t)b * WBUF + j) * ATT_WIDTH + ch * 8, f);
    }
}

#define SSD_CH 32
__device__ __forceinline__ void ph_ssd_naive(float* lds, const bf16* __restrict__ xbc_act, const float* __restrict__ dtv, const float* __restrict__ a_log,
                                             const float* __restrict__ d_skip, const float* __restrict__ state_ssm, float* __restrict__ ybuf, float* __restrict__ out) {
    float (*sx)[64] = (float (*)[64])lds;
    float (*sB)[128] = (float (*)[128])(lds + SSD_CH * 64);
    float (*sC)[128] = (float (*)[128])(lds + SSD_CH * 64 + SSD_CH * 128);
    float* sdt = lds + SSD_CH * 64 + 2 * SSD_CH * 128;
    const int tid = threadIdx.x, p = tid >> 3, ng = tid & 7;
    for (int vb = BATCH * SSD_HEADS + blockIdx.x; vb < (BATCH + DEC_BATCH) * SSD_HEADS; vb += gridDim.x) {
        const int seq = vb / SSD_HEADS, h = vb % SSD_HEADS, g = h / 6;
        const bool is_p = seq < BATCH;
        const int L = is_p ? SEQ : DEC_SEQ;
        const int t0 = is_p ? seq * SEQ : T_PROMPT + (seq - BATCH) * DEC_SEQ;
        const float A = -__expf(a_log[h]);
        const float D = d_skip[h];
        float hs[16];
        if (is_p) {
#pragma unroll
            for (int j = 0; j < 16; ++j) hs[j] = 0.f;
        } else {
            const float* s0 = state_ssm + (((size_t)(seq - BATCH) * SSD_HEADS + h) * 64 + p) * 128 + ng * 16;
#pragma unroll
            for (int j = 0; j < 16; ++j) hs[j] = s0[j];
        }
        for (int c0 = 0; c0 < L; c0 += SSD_CH) {
            const int nst = (L - c0) < SSD_CH ? (L - c0) : SSD_CH;
            __syncthreads();
            for (int idx = tid; idx < nst * 64; idx += NTHR) { int s = idx >> 6, c = idx & 63; sx[s][c] = bf2f(xbc_act[(size_t)(t0 + c0 + s) * CONV_DIM + h * 64 + c]); }
            for (int idx = tid; idx < nst * 128; idx += NTHR) { int s = idx >> 7, c = idx & 127;
                sB[s][c] = bf2f(xbc_act[(size_t)(t0 + c0 + s) * CONV_DIM + 1536 + g * 128 + c]);
                sC[s][c] = bf2f(xbc_act[(size_t)(t0 + c0 + s) * CONV_DIM + 2048 + g * 128 + c]); }
            if (tid < nst) sdt[tid] = dtv[(size_t)(t0 + c0 + tid) * SSD_HEADS + h];
            __syncthreads();
            for (int s = 0; s < nst; ++s) {
                const float dt = sdt[s], x = sx[s][p];
                const float a = __expf(dt * A), xdt = x * dt;
                float y = 0.f;
#pragma unroll
                for (int j = 0; j < 16; ++j) { hs[j] = a * hs[j] + xdt * sB[s][ng * 16 + j]; y += sC[s][ng * 16 + j] * hs[j]; }
                y += __shfl_xor(y, 1); y += __shfl_xor(y, 2); y += __shfl_xor(y, 4);
                if (ng == 0) ybuf[(size_t)(t0 + c0 + s) * MIX_WIDTH + h * 64 + p] = y + D * x;
            }
        }
        float* so = is_p ? out + OUT_PS + (((size_t)seq * SSD_HEADS + h) * 64 + p) * 128 + ng * 16
                         : out + OUT_SS + (((size_t)(seq - BATCH) * SSD_HEADS + h) * 64 + p) * 128 + ng * 16;
#pragma unroll
        for (int j = 0; j < 16; ++j) so[j] = hs[j];
    }
}

__device__ __forceinline__ void ph_gate_norm(const bf16* __restrict__ projb, const float* __restrict__ norm_g, const float* __restrict__ ybuf, bf16* __restrict__ A1) {
    const int w = threadIdx.x >> 6, lane = threadIdx.x & 63, g = w & 3;
    for (int t = T_PROMPT + 2 * blockIdx.x + (w >> 2); t < T_ALL; t += 2 * gridDim.x) {
        float v[6]; float ss = 0.f;
#pragma unroll
        for (int j = 0; j < 6; ++j) {
            int c = g * 384 + j * 64 + lane;
            float y = ybuf[(size_t)t * MIX_WIDTH + c], z = bf2f(projb[(size_t)t * NB_LD + c]);
            v[j] = y * silu_f(z); ss += v[j] * v[j];
        }
        ss = wave_sum(ss);
        const float r = rsqrtf(ss * (1.0f / 384.0f) + LN_EPS);
#pragma unroll
        for (int j = 0; j < 6; ++j) { int c = g * 384 + j * 64 + lane; A1[(size_t)t * MIX_WIDTH + c] = (bf16)f2bf(v[j] * r * norm_g[c]); }
    }
}

__device__ __forceinline__ void ph_attn_naive(float* lds, const float* __restrict__ proj, const float* __restrict__ qrot, const float* __restrict__ krot,
                                              const float* __restrict__ ck, const float* __restrict__ cv, float* __restrict__ ybuf) {
    float (*sq)[64] = (float (*)[64])lds;
    const int w = threadIdx.x >> 6, lane = threadIdx.x & 63;
    for (int vb = blockIdx.x; vb < T_SAMPLE * 8 / NWAVE; vb += gridDim.x) {
        const int item = T_PROMPT * 8 + vb * NWAVE + w;
        const int t = item >> 3, h = item & 7;
        const bool is_p = t < T_PROMPT;
        int b, i;
        if (is_p) { b = t / SEQ; i = t % SEQ; } else { int ts = t - T_PROMPT; b = ts / DEC_SEQ; i = ts % DEC_SEQ; }
        __syncthreads();
        sq[w][lane] = qrot[(size_t)t * ATT_WIDTH + h * 64 + lane];
        __syncthreads();
        const int qi = is_p ? i : WBUF + i;
        float sc[3][3];
        float mx = -INFINITY;
#pragma unroll
        for (int pt = 0; pt < 3; ++pt) {
            const int d = pt == 0 ? 1 : (pt == 1 ? 4 : 16);
#pragma unroll
            for (int sl = 0; sl < 3; ++sl) {
                const int m = lane + sl * 64;
                float s = -INFINITY;
                const int kj = qi - d * m;
                if (m <= 128 && kj >= 0) {
                    const float* kr;
                    if (is_p) kr = krot + (size_t)(b * SEQ + kj) * ATT_WIDTH + h * 64;
                    else kr = (kj >= WBUF) ? krot + (size_t)(T_PROMPT + b * DEC_SEQ + (kj - WBUF)) * ATT_WIDTH + h * 64
                                           : ck + ((size_t)b * WBUF + kj) * ATT_WIDTH + h * 64;
                    float a = 0.f;
#pragma unroll
                    for (int c = 0; c < 64; c += 4) { float4 kv = *(const float4*)(kr + c); a += kv.x * sq[w][c] + kv.y * sq[w][c + 1] + kv.z * sq[w][c + 2] + kv.w * sq[w][c + 3]; }
                    s = a * 0.125f;
                }
                sc[pt][sl] = s; mx = fmaxf(mx, s);
            }
        }
        mx = wave_max(mx);
        float lsum = 0.f;
#pragma unroll
        for (int pt = 0; pt < 3; ++pt)
#pragma unroll
            for (int sl = 0; sl < 3; ++sl) { float pv = (sc[pt][sl] == -INFINITY) ? 0.f : __expf(sc[pt][sl] - mx); sc[pt][sl] = pv; lsum += pv; }
        lsum = wave_sum(lsum);
        float o = 0.f;
#pragma unroll
        for (int pt = 0; pt < 3; ++pt) {
            const int d = pt == 0 ? 1 : (pt == 1 ? 4 : 16);
#pragma unroll
            for (int sl = 0; sl < 3; ++sl) {
                const int mend = sl < 2 ? 64 : 1;
                for (int ml = 0; ml < mend; ++ml) {
                    const int m = ml + sl * 64;
                    const int kj = qi - d * m;
                    const float pv = __shfl(sc[pt][sl], ml);
                    if (kj < 0) continue;
                    const float* vr;
                    if (is_p) vr = proj + (size_t)(b * SEQ + kj) * PROJ_LD + O_V + h * 64;
                    else vr = (kj >= WBUF) ? proj + (size_t)(T_PROMPT + b * DEC_SEQ + (kj - WBUF)) * PROJ_LD + O_V + h * 64
                                           : cv + ((size_t)b * WBUF + kj) * ATT_WIDTH + h * 64;
                    o += pv * vr[lane];
                }
            }
        }
        ybuf[(size_t)t * MIX_WIDTH + SSD_WIDTH + h * 64 + lane] = o / lsum;
    }
}

__device__ __forceinline__ void ph_ln_res(const float* __restrict__ xp, const float* __restrict__ xs, const bf16* __restrict__ add, const float* __restrict__ gam,
                                          const float* __restrict__ bet, bf16* __restrict__ dstb) {
    const int lane = threadIdx.x & 63;
#pragma unroll 2
    for (int t = blockIdx.x * NWAVE + (threadIdx.x >> 6); t < T_ALL; t += gridDim.x * NWAVE) {
        const float* res = (t < T_PROMPT) ? xp + (size_t)t * D_MODEL : xs + (size_t)(t - T_PROMPT) * D_MODEL;
        float v[16]; float s = 0.f;
#pragma unroll
        for (int j = 0; j < 2; ++j) { const int c = j * 512 + lane * 8; const float4 r0 = *(const float4*)(res + c), r1 = *(const float4*)(res + c + 4);
            float a8[8]; unpack8(*(const v4u*)(add + (size_t)t * D_MODEL + c), a8);
            v[8 * j] = ALPHA_F * r0.x + a8[0]; v[8 * j + 1] = ALPHA_F * r0.y + a8[1]; v[8 * j + 2] = ALPHA_F * r0.z + a8[2]; v[8 * j + 3] = ALPHA_F * r0.w + a8[3];
            v[8 * j + 4] = ALPHA_F * r1.x + a8[4]; v[8 * j + 5] = ALPHA_F * r1.y + a8[5]; v[8 * j + 6] = ALPHA_F * r1.z + a8[6]; v[8 * j + 7] = ALPHA_F * r1.w + a8[7]; }
#pragma unroll
        for (int j = 0; j < 16; ++j) s += v[j];
        s = wave_sum(s);
        const float mu = s * (1.0f / 1024.0f);
        float q = 0.f;
#pragma unroll
        for (int j = 0; j < 16; ++j) { v[j] -= mu; q += v[j] * v[j]; }
        q = wave_sum(q);
        const float r = rsqrtf(q * (1.0f / 1024.0f) + LN_EPS);
#pragma unroll
        for (int j = 0; j < 2; ++j) { const int c = j * 512 + lane * 8; const float4 g0 = *(const float4*)(gam + c), g1 = *(const float4*)(gam + c + 4), b0 = *(const float4*)(bet + c), b1 = *(const float4*)(bet + c + 4);
            v4u o; o.x = pk2(v[8 * j] * r * g0.x + b0.x, v[8 * j + 1] * r * g0.y + b0.y); o.y = pk2(v[8 * j + 2] * r * g0.z + b0.z, v[8 * j + 3] * r * g0.w + b0.w);
            o.z = pk2(v[8 * j + 4] * r * g1.x + b1.x, v[8 * j + 5] * r * g1.y + b1.y); o.w = pk2(v[8 * j + 6] * r * g1.z + b1.z, v[8 * j + 7] * r * g1.w + b1.w);
            *(v4u*)(dstb + (size_t)t * D_MODEL + c) = o; }
    }
}

__device__ __forceinline__ void ph_peer_route(float* lds, const float* __restrict__ qh, const float* __restrict__ keys1, const float* __restrict__ keys2,
                                              int* __restrict__ eidx, float* __restrict__ gate) {
    float (*sq)[256] = (float (*)[256])lds;
    float (*sv)[2][16] = (float (*)[2][16])(lds + NWAVE * 256);
    int (*si)[2][16] = (int (*)[2][16])(lds + NWAVE * 256 + NWAVE * 32);
    const int w = threadIdx.x >> 6, lane = threadIdx.x & 63;
    for (int vb = blockIdx.x; vb < T_ALL * 8 / NWAVE; vb += gridDim.x) {
        const int item = vb * NWAVE + w;
        const int t = item >> 3, h = item & 7;
        __syncthreads();
        for (int c = lane; c < 256; c += 64) sq[w][c] = qh[(size_t)t * 2048 + h * 256 + c];
        __syncthreads();
#pragma unroll
        for (int half = 0; half < 2; ++half) {
            const float* keys = half ? keys2 : keys1;
            float s[2];
#pragma unroll
            for (int sl = 0; sl < 2; ++sl) {
                const float* kr = keys + (size_t)(lane + sl * 64) * 128;
                float a = 0.f;
#pragma unroll 8
                for (int c = 0; c < 128; c += 4) { float4 kv = *(const float4*)(kr + c); const float* qq = &sq[w][half * 128 + c]; a += kv.x * qq[0] + kv.y * qq[1] + kv.z * qq[2] + kv.w * qq[3]; }
                s[sl] = a;
            }
            for (int r = 0; r < 16; ++r) {
                float bv; int bi;
                if (s[0] >= s[1]) { bv = s[0]; bi = lane; } else { bv = s[1]; bi = lane + 64; }
#pragma unroll
                for (int o = 32; o > 0; o >>= 1) {
                    float ov = __shfl_xor(bv, o); int oi = __shfl_xor(bi, o);
                    if (ov > bv || (ov == bv && oi < bi)) { bv = ov; bi = oi; }
                }
                if (lane == 0) { sv[w][half][r] = bv; si[w][half][r] = bi; }
                if (bi == lane) s[0] = -INFINITY;
                if (bi == lane + 64) s[1] = -INFINITY;
            }
        }
        __syncthreads();
        float c[4];
#pragma unroll
        for (int j = 0; j < 4; ++j) { int ci = lane * 4 + j; c[j] = sv[w][0][ci >> 4] + sv[w][1][ci & 15]; }
        float myv = 0.f; int myc = 0;
        for (int r = 0; r < 16; ++r) {
            float bv = c[0]; int bi = lane * 4;
#pragma unroll
            for (int j = 1; j < 4; ++j) if (c[j] > bv) { bv = c[j]; bi = lane * 4 + j; }
#pragma unroll
            for (int o = 32; o > 0; o >>= 1) {
                float ov = __shfl_xor(bv, o); int oi = __shfl_xor(bi, o);
                if (ov > bv || (ov == bv && oi < bi)) { bv = ov; bi = oi; }
            }
            if (lane == r) { myv = bv; myc = bi; }
#pragma unroll
            for (int j = 0; j < 4; ++j) if (bi == lane * 4 + j) c[j] = -INFINITY;
        }
        float v = lane < 16 ? myv : -INFINITY;
        float mx = wave_max(v);
        float e = lane < 16 ? __expf(v - mx) : 0.f;
        float sum = wave_sum(e);
        if (lane < 16) {
            int ex = si[w][0][myc >> 4] * PEER_NKEYS + si[w][1][myc & 15];
            eidx[(size_t)t * 128 + h * 16 + lane] = ex;
            gate[(size_t)t * 128 + h * 16 + lane] = e / sum;
        }
    }
}

__device__ __forceinline__ void ph_peer_ffn(const float* __restrict__ hbuf, const int* __restrict__ eidx, const float* __restrict__ gate,
                                            const bf16* __restrict__ ub, const bf16* __restrict__ vb, const float* __restrict__ gam,
                                            const float* __restrict__ bet, float* __restrict__ out) {
    const int lane = threadIdx.x & 63;
    for (int t = blockIdx.x * NWAVE + (threadIdx.x >> 6); t < T_ALL; t += gridDim.x * NWAVE) {
        float x[16], acc[16];
        { const float* xr = hbuf + (size_t)t * D_MODEL + lane * 8;
          const float4 a = *(const float4*)xr, b = *(const float4*)(xr + 4), c = *(const float4*)(xr + 512), d = *(const float4*)(xr + 516);
          x[0] = a.x; x[1] = a.y; x[2] = a.z; x[3] = a.w; x[4] = b.x; x[5] = b.y; x[6] = b.z; x[7] = b.w;
          x[8] = c.x; x[9] = c.y; x[10] = c.z; x[11] = c.w; x[12] = d.x; x[13] = d.y; x[14] = d.z; x[15] = d.w; }
#pragma unroll
        for (int j = 0; j < 16; ++j) acc[j] = 0.f;
        for (int k = 0; k < 128; ++k) {
            const int e = eidx[(size_t)t * 128 + k];
            const float g = gate[(size_t)t * 128 + k];
            const bf16* ur = ub + (size_t)e * D_MODEL + lane * 8;
            float u0[8], u1[8];
            unpack8(*(const v4u*)ur, u0); unpack8(*(const v4u*)(ur + 512), u1);
            float d = 0.f;
#pragma unroll
            for (int j = 0; j < 8; ++j) d += u0[j] * x[j] + u1[j] * x[8 + j];
            d = wave_sum(d);
            const float wgt = g * gelu_f(d);
            const bf16* vr = vb + (size_t)e * D_MODEL + lane * 8;
            unpack8(*(const v4u*)vr, u0); unpack8(*(const v4u*)(vr + 512), u1);
#pragma unroll
            for (int j = 0; j < 8; ++j) { acc[j] += wgt * u0[j]; acc[8 + j] += wgt * u1[j]; }
        }
        float s = 0.f;
#pragma unroll
        for (int j = 0; j < 16; ++j) { acc[j] += ALPHA_F * x[j]; s += acc[j]; }
        s = wave_sum(s);
        const float mu = s * (1.0f / 1024.0f);
        float q = 0.f;
#pragma unroll
        for (int j = 0; j < 16; ++j) { acc[j] -= mu; q += acc[j] * acc[j]; }
        q = wave_sum(q);
        const float r = rsqrtf(q * (1.0f / 1024.0f) + LN_EPS);
        float* dst = ((t < T_PROMPT) ? out + OUT_YP + (size_t)t * D_MODEL : out + OUT_YS + (size_t)(t - T_PROMPT) * D_MODEL) + lane * 8;
#pragma unroll
        for (int q4 = 0; q4 < 4; ++q4) {
            const int eo = (q4 >> 1) * 512 + (q4 & 1) * 4;
            const float4 g4 = *(const float4*)(gam + lane * 8 + eo), b4 = *(const float4*)(bet + lane * 8 + eo);
            float4 o; o.x = acc[q4 * 4 + 0] * r * g4.x + b4.x; o.y = acc[q4 * 4 + 1] * r * g4.y + b4.y; o.z = acc[q4 * 4 + 2] * r * g4.z + b4.z; o.w = acc[q4 * 4 + 3] * r * g4.w + b4.w;
            *(float4*)(dst + eo) = o;
        }
    }
}

__device__ __forceinline__ float peer_dot16(const v4u a, const v4u b, const float (&x)[16]) {
    float u0[8], u1[8]; unpack8(a, u0); unpack8(b, u1);
    float d = 0.f;
#pragma unroll
    for (int j = 0; j < 8; ++j) d += u0[j] * x[j] + u1[j] * x[8 + j];
    return d;
}
#define PEER_TR_STEP(N, M) _Pragma("unroll") for (int i = 0; i < N; ++i) { const bool up = (lane & M) != 0; const float keep = up ? part[i + N] : part[i]; const float send = up ? part[i] : part[i + N]; part[i] = keep + __shfl_xor(send, M); }
__device__ __forceinline__ void ph_peer_ffn2(const float* __restrict__ hbuf, const int* __restrict__ eidx, const float* __restrict__ gate,
                                             const bf16* __restrict__ ub, const bf16* __restrict__ vb, const float* __restrict__ gam,
                                             const float* __restrict__ bet, float* __restrict__ out) {
    const int lane0 = threadIdx.x & 63;
    for (int t = blockIdx.x * NWAVE + (threadIdx.x >> 6); t < T_ALL; t += gridDim.x * NWAVE) {
        int lane = lane0; asm volatile("" : "+v"(lane));
        float x[16];
        { const float* xr = hbuf + (size_t)t * D_MODEL + lane * 8;
          const float4 a = *(const float4*)xr, b = *(const float4*)(xr + 4), c = *(const float4*)(xr + 512), d = *(const float4*)(xr + 516);
          x[0] = a.x; x[1] = a.y; x[2] = a.z; x[3] = a.w; x[4] = b.x; x[5] = b.y; x[6] = b.z; x[7] = b.w;
          x[8] = c.x; x[9] = c.y; x[10] = c.z; x[11] = c.w; x[12] = d.x; x[13] = d.y; x[14] = d.z; x[15] = d.w; }
        int ev[2]; float wv[4];
        ev[0] = eidx[(size_t)t * 128 + lane]; ev[1] = eidx[(size_t)t * 128 + 64 + lane];
#pragma unroll
        for (int rd = 0; rd < 4; ++rd) wv[rd] = gate[(size_t)t * 128 + rd * 32 + (lane >> 1)];
#pragma unroll
        for (int rd = 0; rd < 4; ++rd) {
            float part[32];
#pragma unroll
            for (int kb = 0; kb < 8; ++kb) {
                v4u ra[4], rb[4];
#pragma unroll
                for (int k8 = 0; k8 < 4; ++k8) {
                    const int e = __builtin_amdgcn_readlane(ev[rd >> 1], (rd & 1) * 32 + kb * 4 + k8);
                    const bf16* ur = ub + (size_t)e * D_MODEL + lane * 8;
                    ra[k8] = *(const v4u*)ur; rb[k8] = *(const v4u*)(ur + 512);
                }
#pragma unroll
                for (int k8 = 0; k8 < 4; ++k8) part[kb * 4 + k8] = peer_dot16(ra[k8], rb[k8], x);
            }
            PEER_TR_STEP(16, 32) PEER_TR_STEP(8, 16) PEER_TR_STEP(4, 8) PEER_TR_STEP(2, 4) PEER_TR_STEP(1, 2)
            const float hid = part[0] + __shfl_xor(part[0], 1);
            wv[rd] *= gelu_f(hid);
        }
        float acc[16];
#pragma unroll
        for (int j = 0; j < 16; ++j) acc[j] = 0.f;
#pragma unroll
        for (int rd = 0; rd < 4; ++rd) {
#pragma unroll
            for (int kb = 0; kb < 4; ++kb) {
                v4u ra[8], rb[8];
#pragma unroll
                for (int k8 = 0; k8 < 8; ++k8) {
                    const int e = __builtin_amdgcn_readlane(ev[rd >> 1], (rd & 1) * 32 + kb * 8 + k8);
                    const bf16* vr = vb + (size_t)e * D_MODEL + lane * 8;
                    ra[k8] = *(const v4u*)vr; rb[k8] = *(const v4u*)(vr + 512);
                }
#pragma unroll
                for (int k8 = 0; k8 < 8; ++k8) {
                    const float wk = __builtin_bit_cast(float, __builtin_amdgcn_readlane(__builtin_bit_cast(int, wv[rd]), 2 * (kb * 8 + k8)));
                    float u0[8], u1[8]; unpack8(ra[k8], u0); unpack8(rb[k8], u1);
#pragma unroll
                    for (int j = 0; j < 8; ++j) { acc[j] += wk * u0[j]; acc[8 + j] += wk * u1[j]; }
                }
            }
        }
        float s = 0.f;
#pragma unroll
        for (int j = 0; j < 16; ++j) { acc[j] += ALPHA_F * x[j]; s += acc[j]; }
        s = wave_sum(s);
        const float mu = s * (1.0f / 1024.0f);
        float q = 0.f;
#pragma unroll
        for (int j = 0; j < 16; ++j) { acc[j] -= mu; q += acc[j] * acc[j]; }
        q = wave_sum(q);
        const float r = rsqrtf(q * (1.0f / 1024.0f) + LN_EPS);
        float* dst = ((t < T_PROMPT) ? out + OUT_YP + (size_t)t * D_MODEL : out + OUT_YS + (size_t)(t - T_PROMPT) * D_MODEL) + lane * 8;
#pragma unroll
        for (int q4 = 0; q4 < 4; ++q4) {
            const int eo = (q4 >> 1) * 512 + (q4 & 1) * 4;
            const float4 g4 = *(const float4*)(gam + lane * 8 + eo), b4 = *(const float4*)(bet + lane * 8 + eo);
            float4 o; o.x = acc[q4 * 4 + 0] * r * g4.x + b4.x; o.y = acc[q4 * 4 + 1] * r * g4.y + b4.y; o.z = acc[q4 * 4 + 2] * r * g4.z + b4.z; o.w = acc[q4 * 4 + 3] * r * g4.w + b4.w;
            *(float4*)(dst + eo) = o;
        }
    }
}

__device__ __forceinline__ void ph_attn_sample(float* lds, const bf16* __restrict__ qrot_b, const bf16* __restrict__ krot_b, const bf16* __restrict__ projb,
                                               const float* __restrict__ ck, const float* __restrict__ cv, bf16* __restrict__ A1) {
    float (*sq)[64] = (float (*)[64])lds;
    const int w = threadIdx.x >> 6, lane0 = threadIdx.x & 63;
    for (int vb = blockIdx.x; vb < T_SAMPLE * 8 / NWAVE; vb += gridDim.x) {
        int lane = lane0; asm volatile("" : "+v"(lane));
        const int item = vb * NWAVE + w, ts = item >> 3, hd = item & 7, b = ts >> 2, i = ts & 3, t = T_PROMPT + ts;
        __syncthreads();
        sq[w][lane] = bf2f(qrot_b[(size_t)t * ATT_WIDTH + hd * 64 + lane]);
        __syncthreads();
        const int qi = WBUF + i;
        float sc[8];
        float mx = -INFINITY;
#pragma unroll
        for (int slot = 0; slot < 7; ++slot) {
            const int pt = slot < 6 ? (slot >> 1) : (lane < 3 ? lane : 0);
            const int m = slot < 6 ? lane + 64 * (slot & 1) : 128;
            const int kj = qi - (m << (2 * pt));
            const bool valid = (slot < 6 || lane < 3) && kj < WBUF;
            const int kc = kj < WBUF ? kj : WBUF - 1;
            const float* kr = ck + ((size_t)b * WBUF + kc) * ATT_WIDTH + hd * 64;
            float a = 0.f;
#pragma unroll
            for (int c = 0; c < 64; c += 4) { const float4 kv = *(const float4*)(kr + c); a += kv.x * sq[w][c] + kv.y * sq[w][c + 1] + kv.z * sq[w][c + 2] + kv.w * sq[w][c + 3]; }
            const float s = valid ? a * 0.125f : -INFINITY;
            sc[slot] = s; mx = fmaxf(mx, s);
        }
        const int nt7 = lane <= i ? i - lane : i;
        const bool valid7 = lane < i + 3;
        {
            const bf16* kr = krot_b + (size_t)(T_PROMPT + b * DEC_SEQ + nt7) * ATT_WIDTH + hd * 64;
            float a = 0.f;
#pragma unroll
            for (int c = 0; c < 64; c += 8) { float f[8]; unpack8(*(const v4u*)(kr + c), f);
#pragma unroll
                for (int j = 0; j < 8; ++j) a += f[j] * sq[w][c + j]; }
            const float s = valid7 ? a * 0.125f : -INFINITY;
            sc[7] = s; mx = fmaxf(mx, s);
        }
        mx = wave_max(mx);
        float lsum = 0.f;
#pragma unroll
        for (int slot = 0; slot < 8; ++slot) { const float pv = __expf(sc[slot] - mx); sc[slot] = pv; lsum += pv; }
        lsum = wave_sum(lsum);
        float part[64];
#pragma unroll
        for (int c = 0; c < 64; ++c) part[c] = 0.f;
#pragma unroll
        for (int slot = 0; slot < 7; ++slot) {
            const int pt = slot < 6 ? (slot >> 1) : (lane < 3 ? lane : 0);
            const int m = slot < 6 ? lane + 64 * (slot & 1) : 128;
            const int kj = qi - (m << (2 * pt));
            const int kc = kj < WBUF ? kj : WBUF - 1;
            const float pv = sc[slot];
            const float* vr = cv + ((size_t)b * WBUF + kc) * ATT_WIDTH + hd * 64;
#pragma unroll
            for (int c = 0; c < 64; c += 4) { const float4 vv = *(const float4*)(vr + c); part[c] += pv * vv.x; part[c + 1] += pv * vv.y; part[c + 2] += pv * vv.z; part[c + 3] += pv * vv.w; }
        }
        {
            const float pv = sc[7];
            const bf16* vr = projb + (size_t)(T_PROMPT + b * DEC_SEQ + nt7) * NB_LD + NB_V + hd * 64;
#pragma unroll
            for (int c = 0; c < 64; c += 8) { float f[8]; unpack8(*(const v4u*)(vr + c), f);
#pragma unroll
                for (int j = 0; j < 8; ++j) part[c + j] += pv * f[j]; }
        }
        PEER_TR_STEP(32, 32) PEER_TR_STEP(16, 16) PEER_TR_STEP(8, 8) PEER_TR_STEP(4, 4) PEER_TR_STEP(2, 2) PEER_TR_STEP(1, 1)
        A1[(size_t)t * MIX_WIDTH + SSD_WIDTH + hd * 64 + lane] = (bf16)f2bf(part[0] / lsum);
    }
}


__device__ __forceinline__ void cache_copy_slice(const float* __restrict__ ck, const float* __restrict__ cv, float* __restrict__ out, unsigned slice, unsigned lane) {
    constexpr unsigned PER_B = (WBUF - DEC_SEQ) * ATT_WIDTH / 4;
    constexpr unsigned TOTAL = 2u * DEC_BATCH * PER_B;
#pragma unroll 1
    for (unsigned bt = 0; bt < 8; ++bt) {
        f32x4n v[8]; size_t dsti[8]; bool isv[8]; bool ok[8];
#pragma unroll
        for (int j = 0; j < 8; ++j) {
            const unsigned idx = slice * 4096u + bt * 512u + j * 64u + lane;
            ok[j] = idx < TOTAL;
            const unsigned idc = ok[j] ? idx : 0u;
            const unsigned tb = idc / PER_B, r = idc - tb * PER_B, bb = tb & (DEC_BATCH - 1);
            isv[j] = tb >= DEC_BATCH;
            const size_t srci = (size_t)bb * (WBUF * ATT_WIDTH / 4) + (DEC_SEQ * ATT_WIDTH / 4) + r;
            dsti[j] = (size_t)bb * (WBUF * ATT_WIDTH / 4) + r;
            v[j] = __builtin_nontemporal_load((isv[j] ? (const f32x4n*)cv : (const f32x4n*)ck) + srci);
        }
#pragma unroll
        for (int j = 0; j < 8; ++j) if (ok[j]) __builtin_nontemporal_store(v[j], (f32x4n*)(out + (isv[j] ? OUT_SV : OUT_SK)) + dsti[j]);
    }
}

__device__ __forceinline__ void copy_q_load(const float* __restrict__ ck, const float* __restrict__ cv, unsigned q, unsigned lane, f32x4n (&v)[16]) {
    constexpr unsigned PER_B = (WBUF - DEC_SEQ) * ATT_WIDTH / 4, TOTAL = 2u * DEC_BATCH * PER_B;
#pragma unroll
    for (int j = 0; j < 16; ++j) {
        const unsigned idx = q * 1024u + j * 64u + lane, idc = idx < TOTAL ? idx : 0u;
        const unsigned tb = idc / PER_B, r = idc - tb * PER_B, bb = tb & (DEC_BATCH - 1);
        const size_t srci = (size_t)bb * (WBUF * ATT_WIDTH / 4) + (DEC_SEQ * ATT_WIDTH / 4) + r;
        v[j] = __builtin_nontemporal_load((tb >= DEC_BATCH ? (const f32x4n*)cv : (const f32x4n*)ck) + srci);
    }
}
__device__ __forceinline__ void copy_q_store(float* __restrict__ out, unsigned q, unsigned lane, const f32x4n (&v)[16]) {
    constexpr unsigned PER_B = (WBUF - DEC_SEQ) * ATT_WIDTH / 4, TOTAL = 2u * DEC_BATCH * PER_B;
#pragma unroll
    for (int j = 0; j < 16; ++j) {
        const unsigned idx = q * 1024u + j * 64u + lane;
        if (idx < TOTAL) {
            const unsigned tb = idx / PER_B, r = idx - tb * PER_B, bb = tb & (DEC_BATCH - 1);
            const size_t dsti = (size_t)bb * (WBUF * ATT_WIDTH / 4) + r;
            __builtin_nontemporal_store(v[j], (f32x4n*)(out + (tb >= DEC_BATCH ? OUT_SV : OUT_SK)) + dsti);
        }
    }
}
typedef float f32x2v __attribute__((ext_vector_type(2)));
__device__ __forceinline__ void ph_quant_tables(const float* __restrict__ pu, const float* __restrict__ pv, unsigned char* __restrict__ ub8, unsigned char* __restrict__ vb8,
                                                float* __restrict__ usc, float* __restrict__ vsc, int rank, int nranks) {
    const int lane = threadIdx.x & 63;
#pragma unroll 2
    for (int row = rank * NWAVE + (threadIdx.x >> 6); row < 2 * 16384; row += nranks * NWAVE) {
        const int rr = row & 16383; const bool isv = row >= 16384;
        const float* src = (isv ? pv : pu) + (size_t)rr * D_MODEL + lane * 8;
        const float4 a = *(const float4*)src, b = *(const float4*)(src + 4), c = *(const float4*)(src + 512), d = *(const float4*)(src + 516);
        float am = fmaxf(fmaxf(fmaxf(fabsf(a.x), fabsf(a.y)), fmaxf(fabsf(a.z), fabsf(a.w))), fmaxf(fmaxf(fabsf(b.x), fabsf(b.y)), fmaxf(fabsf(b.z), fabsf(b.w))));
        am = fmaxf(am, fmaxf(fmaxf(fmaxf(fabsf(c.x), fabsf(c.y)), fmaxf(fabsf(c.z), fabsf(c.w))), fmaxf(fmaxf(fabsf(d.x), fabsf(d.y)), fmaxf(fabsf(d.z), fabsf(d.w)))));
        am = wave_max(am);
        const float sc = am > 0.f ? 224.0f / am : 1.0f;
        v4u o;
        o.x = (unsigned)__builtin_amdgcn_cvt_pk_fp8_f32(a.z * sc, a.w * sc, __builtin_amdgcn_cvt_pk_fp8_f32(a.x * sc, a.y * sc, 0, false), true);
        o.y = (unsigned)__builtin_amdgcn_cvt_pk_fp8_f32(b.z * sc, b.w * sc, __builtin_amdgcn_cvt_pk_fp8_f32(b.x * sc, b.y * sc, 0, false), true);
        o.z = (unsigned)__builtin_amdgcn_cvt_pk_fp8_f32(c.z * sc, c.w * sc, __builtin_amdgcn_cvt_pk_fp8_f32(c.x * sc, c.y * sc, 0, false), true);
        o.w = (unsigned)__builtin_amdgcn_cvt_pk_fp8_f32(d.z * sc, d.w * sc, __builtin_amdgcn_cvt_pk_fp8_f32(d.x * sc, d.y * sc, 0, false), true);
        *(v4u*)((isv ? vb8 : ub8) + (size_t)rr * 1024 + lane * 16) = o;
        if (lane == 0) (isv ? vsc : usc)[rr] = am > 0.f ? am * (1.0f / 224.0f) : 1.0f;
    }
}
__device__ __forceinline__ void unpack16_fp8(const v4u w, float (&f)[16]) {
#pragma unroll
    for (int i = 0; i < 4; ++i) {
        const f32x2v lo = __builtin_amdgcn_cvt_pk_f32_fp8((int)w[i], false), hi = __builtin_amdgcn_cvt_pk_f32_fp8((int)w[i], true);
        f[4 * i] = lo[0]; f[4 * i + 1] = lo[1]; f[4 * i + 2] = hi[0]; f[4 * i + 3] = hi[1];
    }
}
__device__ __forceinline__ void ph_peer_ffn3(const bf16* __restrict__ hb, const int* __restrict__ eidx, const float* __restrict__ gate,
                                             const unsigned char* __restrict__ ub8, const unsigned char* __restrict__ vb8, const float* __restrict__ usc, const float* __restrict__ vsc,
                                             const float* __restrict__ gam, const float* __restrict__ bet, float* __restrict__ out,
                                             const float* __restrict__ ck, const float* __restrict__ cv, unsigned n9) {
    const int lane0 = threadIdx.x & 63;
    unsigned it = 0;
    for (int t = blockIdx.x * NWAVE + (threadIdx.x >> 6); t < T_ALL; t += gridDim.x * NWAVE, ++it) {
        int lane = lane0; asm volatile("" : "+v"(lane));
        { const unsigned sl = n9 + (blockIdx.x * NWAVE + (threadIdx.x >> 6)) + it * (gridDim.x * NWAVE); if (sl < 16384u) cache_copy_slice(ck, cv, out, sl, (unsigned)lane); }
        const unsigned lo16 = (unsigned)lane * 16u, lo8 = (unsigned)lane * 8u;
        float x[16];
        { float f0[8], f1[8]; const bf16* xr = hb + (size_t)t * D_MODEL + lo8; unpack8(*(const v4u*)xr, f0); unpack8(*(const v4u*)(xr + 512), f1);
#pragma unroll
          for (int j = 0; j < 8; ++j) { x[j] = f0[j]; x[8 + j] = f1[j]; } }
        int ev[2]; float wv[4], su[4];
        ev[0] = eidx[(size_t)t * 128 + lane]; ev[1] = eidx[(size_t)t * 128 + 64 + lane];
#pragma unroll
        for (int rd = 0; rd < 4; ++rd) {
            const int er = eidx[(size_t)t * 128 + rd * 32 + (lane >> 1)];
            wv[rd] = gate[(size_t)t * 128 + rd * 32 + (lane >> 1)] * vsc[er];
            su[rd] = usc[er];
        }
#pragma unroll
        for (int rd = 0; rd < 4; ++rd) {
            float part[32];
#pragma unroll
            for (int kb = 0; kb < 8; ++kb) {
                v4u ra[4];
#pragma unroll
                for (int k8 = 0; k8 < 4; ++k8) {
                    const int e = __builtin_amdgcn_readlane(ev[rd >> 1], (rd & 1) * 32 + kb * 4 + k8);
                    ra[k8] = *(const v4u*)(ub8 + (size_t)e * 1024 + lo16);
                }
#pragma unroll
                for (int k8 = 0; k8 < 4; ++k8) {
                    f32x2v dv = {0.f, 0.f};
#pragma unroll
                    for (int i = 0; i < 4; ++i) {
                        const f32x2v lo = __builtin_amdgcn_cvt_pk_f32_fp8((int)ra[k8][i], false), hi = __builtin_amdgcn_cvt_pk_f32_fp8((int)ra[k8][i], true);
                        dv += lo * (f32x2v){x[4 * i], x[4 * i + 1]}; dv += hi * (f32x2v){x[4 * i + 2], x[4 * i + 3]};
                    }
                    part[kb * 4 + k8] = dv[0] + dv[1];
                    if (k8 & 1) __builtin_amdgcn_sched_barrier(0);
                }
            }
            PEER_TR_STEP(16, 32) PEER_TR_STEP(8, 16) PEER_TR_STEP(4, 8) PEER_TR_STEP(2, 4) PEER_TR_STEP(1, 2)
            const float hid = (part[0] + __shfl_xor(part[0], 1)) * su[rd];
            wv[rd] *= gelu_f(hid);
        }
        float acc[16];
#pragma unroll
        for (int j = 0; j < 16; ++j) acc[j] = 0.f;
#pragma unroll
        for (int rd = 0; rd < 4; ++rd) {
#pragma unroll
            for (int kb = 0; kb < 4; ++kb) {
                v4u ra[8];
#pragma unroll
                for (int k8 = 0; k8 < 8; ++k8) {
                    const int e = __builtin_amdgcn_readlane(ev[rd >> 1], (rd & 1) * 32 + kb * 8 + k8);
                    ra[k8] = *(const v4u*)(vb8 + (size_t)e * 1024 + lo16);
                }
#pragma unroll
                for (int k8 = 0; k8 < 8; ++k8) {
                    const float wk = __builtin_bit_cast(float, __builtin_amdgcn_readlane(__builtin_bit_cast(int, wv[rd]), 2 * (kb * 8 + k8)));
                    float f[16]; unpack16_fp8(ra[k8], f);
#pragma unroll
                    for (int j = 0; j < 16; ++j) acc[j] += wk * f[j];
                    if (k8 & 1) __builtin_amdgcn_sched_barrier(0);
                }
            }
        }
        float s = 0.f;
#pragma unroll
        for (int j = 0; j < 16; ++j) { acc[j] += ALPHA_F * x[j]; s += acc[j]; }
        s = wave_sum(s);
        const float mu = s * (1.0f / 1024.0f);
        float q = 0.f;
#pragma unroll
        for (int j = 0; j < 16; ++j) { acc[j] -= mu; q += acc[j] * acc[j]; }
        q = wave_sum(q);
        const float r = rsqrtf(q * (1.0f / 1024.0f) + LN_EPS);
        float* dst = ((t < T_PROMPT) ? out + OUT_YP + (size_t)t * D_MODEL : out + OUT_YS + (size_t)(t - T_PROMPT) * D_MODEL) + lo8;
#pragma unroll
        for (int q4 = 0; q4 < 4; ++q4) {
            const int eo = (q4 >> 1) * 512 + (q4 & 1) * 4;
            const float4 g4 = *(const float4*)(gam + lo8 + eo), b4 = *(const float4*)(bet + lo8 + eo);
            float4 o; o.x = acc[q4 * 4 + 0] * r * g4.x + b4.x; o.y = acc[q4 * 4 + 1] * r * g4.y + b4.y; o.z = acc[q4 * 4 + 2] * r * g4.z + b4.z; o.w = acc[q4 * 4 + 3] * r * g4.w + b4.w;
            *(float4*)(dst + eo) = o;
        }
    }
    for (;; ++it) {
        const unsigned sl = n9 + (blockIdx.x * NWAVE + (threadIdx.x >> 6)) + it * (gridDim.x * NWAVE);
        if (sl >= 16384u) break;
        cache_copy_slice(ck, cv, out, sl, (unsigned)lane0);
    }
}


__device__ __forceinline__ void ssd_decode_load(const bf16* __restrict__ xbc_b, const float* __restrict__ dtv, const float* __restrict__ state_ssm, int item, int p, int ng,
                                                float (&hs)[16], v4u (&bq)[4][2], v4u (&cq)[4][2], float (&xv)[4], float (&dv)[4]) {
    const int sb = item / SSD_HEADS, h = item - sb * SSD_HEADS, g = h / 6, t0 = T_PROMPT + sb * DEC_SEQ;
    const float* s0 = state_ssm + (((size_t)sb * SSD_HEADS + h) * 64 + p) * 128 + ng * 16;
#pragma unroll
    for (int j = 0; j < 4; ++j) { const float4 v = *(const float4*)(s0 + 4 * j); hs[4 * j] = v.x; hs[4 * j + 1] = v.y; hs[4 * j + 2] = v.z; hs[4 * j + 3] = v.w; }
#pragma unroll
    for (int s = 0; s < 4; ++s) {
        const bf16* row = xbc_b + (size_t)(t0 + s) * CONV_DIM;
        bq[s][0] = *(const v4u*)(row + 1536 + g * 128 + ng * 16); bq[s][1] = *(const v4u*)(row + 1536 + g * 128 + ng * 16 + 8);
        cq[s][0] = *(const v4u*)(row + 2048 + g * 128 + ng * 16); cq[s][1] = *(const v4u*)(row + 2048 + g * 128 + ng * 16 + 8);
        xv[s] = bf2f(row[h * 64 + p]); dv[s] = dtv[(size_t)(t0 + s) * SSD_HEADS + h];
    }
}
__device__ __forceinline__ void ssd_decode_compute(const float* __restrict__ a_log, const float* __restrict__ d_skip, int item, int p, int ng,
                                                   float (&hs)[16], const v4u (&bq)[4][2], const v4u (&cq)[4][2], const float (&xv)[4], const float (&dv)[4],
                                                   float* __restrict__ ybuf, float* __restrict__ out) {
    const int sb = item / SSD_HEADS, h = item - sb * SSD_HEADS, t0 = T_PROMPT + sb * DEC_SEQ;
    const float A = -__expf(a_log[h]), D = d_skip[h];
#pragma unroll
    for (int s = 0; s < 4; ++s) {
        float Bf[16], Cf[16];
        { float t8[8]; unpack8(bq[s][0], t8);
#pragma unroll
          for (int j = 0; j < 8; ++j) Bf[j] = t8[j];
          unpack8(bq[s][1], t8);
#pragma unroll
          for (int j = 0; j < 8; ++j) Bf[8 + j] = t8[j];
          unpack8(cq[s][0], t8);
#pragma unroll
          for (int j = 0; j < 8; ++j) Cf[j] = t8[j];
          unpack8(cq[s][1], t8);
#pragma unroll
          for (int j = 0; j < 8; ++j) Cf[8 + j] = t8[j]; }
        const float a = __expf(dv[s] * A), xdt = xv[s] * dv[s];
        float y = 0.f;
#pragma unroll
        for (int j = 0; j < 16; ++j) { hs[j] = a * hs[j] + xdt * Bf[j]; y += Cf[j] * hs[j]; }
        y += __shfl_xor(y, 1); y += __shfl_xor(y, 2); y += __shfl_xor(y, 4);
        if (ng == 0) ybuf[(size_t)(t0 + s) * MIX_WIDTH + h * 64 + p] = y + D * xv[s];
    }
    float* so = out + OUT_SS + (((size_t)sb * SSD_HEADS + h) * 64 + p) * 128 + ng * 16;
#pragma unroll
    for (int j = 0; j < 4; ++j) *(float4*)(so + 4 * j) = make_float4(hs[4 * j], hs[4 * j + 1], hs[4 * j + 2], hs[4 * j + 3]);
}
__device__ __forceinline__ void ph_ssd_decode(const bf16* __restrict__ xbc_b, const float* __restrict__ dtv, const float* __restrict__ a_log, const float* __restrict__ d_skip,
                                              const float* __restrict__ state_ssm, float* __restrict__ ybuf, float* __restrict__ out) {
    const int tid = threadIdx.x, p = tid >> 3, ng = tid & 7;
    constexpr int NITEM = DEC_BATCH * SSD_HEADS;
    for (int it = blockIdx.x; it < NITEM; it += 2 * gridDim.x) {
        const int it2 = it + gridDim.x; const bool has2 = it2 < NITEM; const int it2c = has2 ? it2 : it;
        float hsA[16], hsB[16], xA[4], xB[4], dA[4], dB[4]; v4u bA[4][2], cA[4][2], bB[4][2], cB[4][2];
        ssd_decode_load(xbc_b, dtv, state_ssm, it, p, ng, hsA, bA, cA, xA, dA);
        ssd_decode_load(xbc_b, dtv, state_ssm, it2c, p, ng, hsB, bB, cB, xB, dB);
        ssd_decode_compute(a_log, d_skip, it, p, ng, hsA, bA, cA, xA, dA, ybuf, out);
        if (has2) ssd_decode_compute(a_log, d_skip, it2, p, ng, hsB, bB, cB, xB, dB, ybuf, out);
    }
}

__device__ __forceinline__ float samp_cw(int d) { return (float)((int)(d >= 0 && d <= 128) + (int)(d >= 0 && (d & 3) == 0 && d <= 512) + (int)(d >= 0 && (d & 15) == 0 && d <= 2048)); }
__device__ __forceinline__ void samp_update(float sv, float cw, const float (&vrow)[64], float& m, float& l, float (&part)[64]) {
    const float mn = fmaxf(m, sv), alpha = __expf(m - mn), p = cw * __expf(sv - mn);
    m = mn; l = l * alpha + p;
#pragma unroll
    for (int c = 0; c < 64; ++c) part[c] = part[c] * alpha + p * vrow[c];
}
__device__ __forceinline__ void ph_attn_sample3(float* lds, const bf16* __restrict__ qrot_b, const bf16* __restrict__ krot_b, const bf16* __restrict__ projb,
                                                const float* __restrict__ ck, const float* __restrict__ cv, bf16* __restrict__ A1) {
    const int lane0 = threadIdx.x & 63, w = __builtin_amdgcn_readfirstlane(threadIdx.x >> 6);
    float* sq = lds + w * 256;
    for (int item = blockIdx.x + gridDim.x * w; item < DEC_BATCH * ATT_HEADS; item += gridDim.x * NWAVE) {
        int lane = lane0; asm volatile("" : "+v"(lane));
        const int b = item >> 3, hd = item & 7, qi = lane & 3, g = lane >> 2;
        const int tq0 = T_PROMPT + b * DEC_SEQ;
#pragma unroll
        for (int i = 0; i < 4; ++i) sq[i * 64 + lane] = bf2f(qrot_b[(size_t)(tq0 + i) * ATT_WIDTH + hd * 64 + lane]);
        asm volatile("s_waitcnt lgkmcnt(0)" ::: "memory");
        const float* qv = sq + qi * 64;
        const float* ckb = ck + (size_t)b * WBUF * ATT_WIDTH + hd * 64; const float* cvb = cv + (size_t)b * WBUF * ATT_WIDTH + hd * 64;
        float m = -1e30f, l = 0.f, part[64];
#pragma unroll
        for (int c = 0; c < 64; ++c) part[c] = 0.f;
        {
            const int P = 2051 - g;
            const float cw = samp_cw(WBUF + qi - P);
            const bool isn = P >= WBUF;
            const int nt = isn ? P - WBUF : 0, Pc = isn ? WBUF - 1 : P;
            const bf16* kn = krot_b + (size_t)(tq0 + nt) * ATT_WIDTH + hd * 64; const float* kr = ckb + (size_t)Pc * ATT_WIDTH;
            float a = 0.f;
#pragma unroll
            for (int c = 0; c < 64; c += 8) { float f[8]; unpack8(*(const v4u*)(kn + c), f); const float4 k0 = *(const float4*)(kr + c), k1 = *(const float4*)(kr + c + 4);
                a += (isn ? f[0] : k0.x) * qv[c] + (isn ? f[1] : k0.y) * qv[c + 1] + (isn ? f[2] : k0.z) * qv[c + 2] + (isn ? f[3] : k0.w) * qv[c + 3]
                   + (isn ? f[4] : k1.x) * qv[c + 4] + (isn ? f[5] : k1.y) * qv[c + 5] + (isn ? f[6] : k1.z) * qv[c + 6] + (isn ? f[7] : k1.w) * qv[c + 7]; }
            const float sv = cw > 0.f ? a * 0.125f : -1e30f;
            const bf16* vn = projb + (size_t)(tq0 + nt) * NB_LD + NB_V + hd * 64; const float* vr = cvb + (size_t)Pc * ATT_WIDTH;
            float vrow[64];
#pragma unroll
            for (int c = 0; c < 64; c += 8) { float f[8]; unpack8(*(const v4u*)(vn + c), f); const float4 v0 = *(const float4*)(vr + c), v1 = *(const float4*)(vr + c + 4);
                vrow[c] = isn ? f[0] : v0.x; vrow[c + 1] = isn ? f[1] : v0.y; vrow[c + 2] = isn ? f[2] : v0.z; vrow[c + 3] = isn ? f[3] : v0.w;
                vrow[c + 4] = isn ? f[4] : v1.x; vrow[c + 5] = isn ? f[5] : v1.y; vrow[c + 6] = isn ? f[6] : v1.z; vrow[c + 7] = isn ? f[7] : v1.w; }
            samp_update(sv, cw, vrow, m, l, part);
        }
#pragma unroll 1
        for (int s = 1; s < 21; ++s) {
            const int P = s < 9 ? 2051 - (16 * s + g) : (s < 15 ? 1536 + 64 * (s - 9) + lane : qi + 16 * (16 * (s - 15) + g));
            const float cw = (s < 9 && P < 1920) ? 0.f : samp_cw(WBUF + qi - P);
            const float* kr = ckb + (size_t)P * ATT_WIDTH;
            float a = 0.f;
#pragma unroll
            for (int c = 0; c < 64; c += 4) { const float4 kv = *(const float4*)(kr + c); a += kv.x * qv[c] + kv.y * qv[c + 1] + kv.z * qv[c + 2] + kv.w * qv[c + 3]; }
            const float sv = cw > 0.f ? a * 0.125f : -1e30f;
            __builtin_amdgcn_sched_barrier(0);
            const float* vr = cvb + (size_t)P * ATT_WIDTH;
            float vrow[64];
#pragma unroll
            for (int c = 0; c < 64; c += 4) { const float4 vv = *(const float4*)(vr + c); vrow[c] = vv.x; vrow[c + 1] = vv.y; vrow[c + 2] = vv.z; vrow[c + 3] = vv.w; }
            samp_update(sv, cw, vrow, m, l, part);
        }
        float M = m;
        M = fmaxf(M, __shfl_xor(M, 4)); M = fmaxf(M, __shfl_xor(M, 8)); M = fmaxf(M, __shfl_xor(M, 16)); M = fmaxf(M, __shfl_xor(M, 32));
        const float sc = __expf(m - M);
        float lsum = l * sc;
        lsum += __shfl_xor(lsum, 4); lsum += __shfl_xor(lsum, 8); lsum += __shfl_xor(lsum, 16); lsum += __shfl_xor(lsum, 32);
#pragma unroll
        for (int c = 0; c < 64; ++c) part[c] *= sc;
        PEER_TR_STEP(32, 32) PEER_TR_STEP(16, 16) PEER_TR_STEP(8, 8) PEER_TR_STEP(4, 4)
        const float inv = 1.0f / lsum;
        *(uint2*)(A1 + (size_t)(tq0 + qi) * MIX_WIDTH + SSD_WIDTH + hd * 64 + 4 * g) = make_uint2(pk2(part[0] * inv, part[1] * inv), pk2(part[2] * inv, part[3] * inv));
    }
}

typedef float f32x16 __attribute__((ext_vector_type(16)));
typedef short s16x8 __attribute__((ext_vector_type(8)));
typedef short s16x4 __attribute__((ext_vector_type(4)));
typedef float f32x4v __attribute__((ext_vector_type(4)));
#define SSD_L_ACS 0
#define SSD_L_DTS 3072
#define SSD_L_BM 6144
#define SSD_RS_B 272
#define SSD_L_X (6144 + 128 * 272)
#define SSD_RS_X 144
#define SSD_XIMG (128 * 144)
#define SSD_RS_Y 784
template <int OFF0, int OFF1>
__device__ __forceinline__ s16x8 tr_frag(unsigned base) {
    s16x4 a, b;
    asm volatile("ds_read_b64_tr_b16 %0, %2 offset:%3\n\tds_read_b64_tr_b16 %1, %2 offset:%4\n\ts_waitcnt lgkmcnt(0)"
                 : "=&v"(a), "=&v"(b) : "v"(base), "n"(OFF0), "n"(OFF1) : "memory");
    return __builtin_shufflevector(a, b, 0, 1, 2, 3, 4, 5, 6, 7);
}
__device__ __forceinline__ unsigned lds_addr(LAS unsigned char* p) { return (unsigned)(size_t)p; }
template <int O0, int O1, int O2, int O3, int O4, int O5, int O6, int O7>
__device__ __forceinline__ void tr_read8(unsigned base, s16x4 (&v)[8]) {
    asm volatile("ds_read_b64_tr_b16 %0, %8 offset:%9\n\tds_read_b64_tr_b16 %1, %8 offset:%10\n\tds_read_b64_tr_b16 %2, %8 offset:%11\n\tds_read_b64_tr_b16 %3, %8 offset:%12\n\t"
                 "ds_read_b64_tr_b16 %4, %8 offset:%13\n\tds_read_b64_tr_b16 %5, %8 offset:%14\n\tds_read_b64_tr_b16 %6, %8 offset:%15\n\tds_read_b64_tr_b16 %7, %8 offset:%16\n\ts_waitcnt lgkmcnt(0)"
                 : "=&v"(v[0]), "=&v"(v[1]), "=&v"(v[2]), "=&v"(v[3]), "=&v"(v[4]), "=&v"(v[5]), "=&v"(v[6]), "=&v"(v[7])
                 : "v"(base), "n"(O0), "n"(O1), "n"(O2), "n"(O3), "n"(O4), "n"(O5), "n"(O6), "n"(O7) : "memory");
}
#define TRCAT(a, b) __builtin_shufflevector(a, b, 0, 1, 2, 3, 4, 5, 6, 7)


__device__ __forceinline__ void ssd_chunk_acs(LAS unsigned char* ldsb, const float* __restrict__ dtv, const float* __restrict__ a_log, int t0, int g, float* cdec_out) {
    const int w = __builtin_amdgcn_readfirstlane(threadIdx.x >> 6), lane = threadIdx.x & 63;
    if (w < 6) {
        const int head = 6 * g + w;
        const float A = -__expf(a_log[head]);
        const float v0 = dtv[(size_t)(t0 + 2 * lane) * SSD_HEADS + head], v1 = dtv[(size_t)(t0 + 2 * lane + 1) * SSD_HEADS + head];
        const float a1 = v1 * A;
        float s = v0 * A + a1;
#pragma unroll
        for (int o = 1; o < 64; o <<= 1) { const float tmp = __shfl_up(s, o); if (lane >= o) s += tmp; }
        LAS float* acs = (LAS float*)(ldsb + SSD_L_ACS) + w * 128;
        LAS float* dts = (LAS float*)(ldsb + SSD_L_DTS) + w * 128;
        acs[2 * lane] = s - a1; acs[2 * lane + 1] = s;
        dts[2 * lane] = v0; dts[2 * lane + 1] = v1;
        if (cdec_out && lane == 63) cdec_out[head] = __expf(s);
    }
}

__device__ __forceinline__ void ph_ssd_states(LAS unsigned char* ldsb, const bf16* __restrict__ xbc_b, const float* __restrict__ dtv, const float* __restrict__ a_log,
                                              bf16* __restrict__ Sbuf, float* __restrict__ cdec, const float* __restrict__ ck, const float* __restrict__ cv, float* __restrict__ out) {
    const int tid = threadIdx.x, w = __builtin_amdgcn_readfirstlane(tid >> 6), lane = tid & 63;
    const int r = lane & 31, h = lane >> 5, blk = (lane >> 4) & 1, q = (lane & 15) >> 2, pp = lane & 3;
    const int nt = w & 3, pt = w >> 2;
    for (int unit = blockIdx.x; unit < BATCH * 64 * SSD_GROUPS; unit += gridDim.x) {
        const int g = unit & 3, bc = unit >> 2;
        const int t0 = bc * 128;
        __syncthreads();
        ssd_chunk_acs(ldsb, dtv, a_log, t0, g, cdec + (size_t)bc * SSD_HEADS);
#pragma unroll
        for (int it_ = 0; it_ < 4; ++it_) { const int idx = tid + it_ * NTHR; const int row = idx >> 4, ch = idx & 15;
            const v4u v = *(const v4u*)(xbc_b + (size_t)(t0 + row) * CONV_DIM + 1536 + 128 * g + ch * 8);
            *(LAS v4u*)(ldsb + SSD_L_BM + row * SSD_RS_B + ch * 16) = v; }
        __syncthreads();
#pragma unroll
        for (int it_ = 0; it_ < 12; ++it_) { const int idx = tid + it_ * NTHR; const int hh = idx >> 10, rem = idx & 1023, row = rem >> 3, ch = rem & 7;
            const LAS float* acs = (const LAS float*)(ldsb + SSD_L_ACS) + hh * 128; const LAS float* dts = (const LAS float*)(ldsb + SSD_L_DTS) + hh * 128;
            const float wgt = dts[row] * __expf(acs[127] - acs[row]);
            float f[8]; unpack8(*(const v4u*)(xbc_b + (size_t)(t0 + row) * CONV_DIM + (6 * g + hh) * 64 + ch * 8), f);
            v4u o; o.x = pk2(f[0] * wgt, f[1] * wgt); o.y = pk2(f[2] * wgt, f[3] * wgt); o.z = pk2(f[4] * wgt, f[5] * wgt); o.w = pk2(f[6] * wgt, f[7] * wgt);
            *(LAS v4u*)(ldsb + SSD_L_X + hh * SSD_XIMG + row * SSD_RS_X + ch * 16) = o; }
        __syncthreads();
        f32x4n rider[16];
        copy_q_load(ck, cv, 12288u + (unsigned)(unit * NWAVE + w), (unsigned)lane, rider);
        const unsigned abase = lds_addr(ldsb + SSD_L_BM) + (8 * h + q) * SSD_RS_B + (32 * nt + 16 * blk + 4 * pp) * 2;
        s16x8 afr[8];
        { s16x4 av[8];
          tr_read8<0 * SSD_RS_B, 4 * SSD_RS_B, 16 * SSD_RS_B, 20 * SSD_RS_B, 32 * SSD_RS_B, 36 * SSD_RS_B, 48 * SSD_RS_B, 52 * SSD_RS_B>(abase, av);
          afr[0] = TRCAT(av[0], av[1]); afr[1] = TRCAT(av[2], av[3]); afr[2] = TRCAT(av[4], av[5]); afr[3] = TRCAT(av[6], av[7]);
          tr_read8<64 * SSD_RS_B, 68 * SSD_RS_B, 80 * SSD_RS_B, 84 * SSD_RS_B, 96 * SSD_RS_B, 100 * SSD_RS_B, 112 * SSD_RS_B, 116 * SSD_RS_B>(abase, av);
          afr[4] = TRCAT(av[0], av[1]); afr[5] = TRCAT(av[2], av[3]); afr[6] = TRCAT(av[4], av[5]); afr[7] = TRCAT(av[6], av[7]); }
#pragma unroll
        for (int hh = 0; hh < 6; ++hh) {
            const unsigned xb = lds_addr(ldsb + SSD_L_X + hh * SSD_XIMG) + (8 * h + q) * SSD_RS_X + (32 * pt + 16 * blk + 4 * pp) * 2;
            f32x16 acc;
#pragma unroll
            for (int i = 0; i < 16; ++i) acc[i] = 0.f;
            { s16x4 xv[8];
              tr_read8<0 * SSD_RS_X, 4 * SSD_RS_X, 16 * SSD_RS_X, 20 * SSD_RS_X, 32 * SSD_RS_X, 36 * SSD_RS_X, 48 * SSD_RS_X, 52 * SSD_RS_X>(xb, xv);
              acc = __builtin_amdgcn_mfma_f32_32x32x16_bf16(afr[0], TRCAT(xv[0], xv[1]), acc, 0, 0, 0);
              acc = __builtin_amdgcn_mfma_f32_32x32x16_bf16(afr[1], TRCAT(xv[2], xv[3]), acc, 0, 0, 0);
              acc = __builtin_amdgcn_mfma_f32_32x32x16_bf16(afr[2], TRCAT(xv[4], xv[5]), acc, 0, 0, 0);
              acc = __builtin_amdgcn_mfma_f32_32x32x16_bf16(afr[3], TRCAT(xv[6], xv[7]), acc, 0, 0, 0);
              tr_read8<64 * SSD_RS_X, 68 * SSD_RS_X, 80 * SSD_RS_X, 84 * SSD_RS_X, 96 * SSD_RS_X, 100 * SSD_RS_X, 112 * SSD_RS_X, 116 * SSD_RS_X>(xb, xv);
              acc = __builtin_amdgcn_mfma_f32_32x32x16_bf16(afr[4], TRCAT(xv[0], xv[1]), acc, 0, 0, 0);
              acc = __builtin_amdgcn_mfma_f32_32x32x16_bf16(afr[5], TRCAT(xv[2], xv[3]), acc, 0, 0, 0);
              acc = __builtin_amdgcn_mfma_f32_32x32x16_bf16(afr[6], TRCAT(xv[4], xv[5]), acc, 0, 0, 0);
              acc = __builtin_amdgcn_mfma_f32_32x32x16_bf16(afr[7], TRCAT(xv[6], xv[7]), acc, 0, 0, 0); }
            bf16* dst = Sbuf + (((size_t)bc * SSD_HEADS + 6 * g + hh) * 64 + 32 * pt + r) * 128 + 32 * nt + 4 * h;
#pragma unroll
            for (int q4 = 0; q4 < 4; ++q4) *(uint2*)(dst + 8 * q4) = make_uint2(pk2(acc[4 * q4], acc[4 * q4 + 1]), pk2(acc[4 * q4 + 2], acc[4 * q4 + 3]));
        }
        copy_q_store(out, 12288u + (unsigned)(unit * NWAVE + w), (unsigned)lane, rider);
    }
}

__device__ __forceinline__ void ph_ssd_scan(const bf16* __restrict__ Sbuf, const float* __restrict__ cdec, bf16* __restrict__ Hin, float* __restrict__ out, int rank, int nranks) {
    for (int idx = rank * NTHR + threadIdx.x; idx < BATCH * SSD_HEADS * 64 * 16; idx += nranks * NTHR) {
        const int n8 = idx & 15, p = (idx >> 4) & 63, hb = idx >> 10, hd = hb % SSD_HEADS, b = hb / SSD_HEADS;
        float st[8];
#pragma unroll
        for (int j = 0; j < 8; ++j) st[j] = 0.f;
#pragma unroll 8
        for (int c = 0; c < 64; ++c) {
            const size_t base = ((((size_t)(b * 64 + c)) * SSD_HEADS + hd) * 64 + p) * 128 + n8 * 8;
            v4u o; o.x = pk2(st[0], st[1]); o.y = pk2(st[2], st[3]); o.z = pk2(st[4], st[5]); o.w = pk2(st[6], st[7]);
            *(v4u*)(Hin + base) = o;
            float s[8]; unpack8(*(const v4u*)(Sbuf + base), s);
            const float a = cdec[(size_t)(b * 64 + c) * SSD_HEADS + hd];
#pragma unroll
            for (int j = 0; j < 8; ++j) st[j] = a * st[j] + s[j];
        }
        store8f(out + OUT_PS + (((size_t)b * SSD_HEADS + hd) * 64 + p) * 128 + n8 * 8, st);
    }
}

__device__ __forceinline__ void ph_ssd_out(LAS unsigned char* ldsb, const bf16* __restrict__ xbc_b, const bf16* __restrict__ projb, const float* __restrict__ dtv,
                                           const float* __restrict__ a_log, const float* __restrict__ d_skip, const float* __restrict__ norm_g,
                                           const bf16* __restrict__ Hin, bf16* __restrict__ A1) {
    const int tid = threadIdx.x, w = __builtin_amdgcn_readfirstlane(tid >> 6), lane = tid & 63;
    const int r = lane & 31, h = lane >> 5, blk = (lane >> 4) & 1, q = (lane & 15) >> 2, pp = lane & 3;
    const int lt = w & 3, hs = w >> 2;
    for (int unit = blockIdx.x; unit < BATCH * 64 * SSD_GROUPS; unit += gridDim.x) {
        const int g = unit & 3, bc = unit >> 2;
        const int t0 = bc * 128;
        __syncthreads();
        ssd_chunk_acs(ldsb, dtv, a_log, t0, g, nullptr);
#pragma unroll
        for (int it_ = 0; it_ < 4; ++it_) { const int idx = tid + it_ * NTHR; const int row = idx >> 4, ch = idx & 15;
            const v4u v = *(const v4u*)(xbc_b + (size_t)(t0 + row) * CONV_DIM + 1536 + 128 * g + ch * 8);
            *(LAS v4u*)(ldsb + SSD_L_BM + row * SSD_RS_B + ch * 16) = v; }
#pragma unroll
        for (int it_ = 0; it_ < 12; ++it_) { const int idx = tid + it_ * NTHR; const int hh = idx >> 10, rem = idx & 1023, row = rem >> 3, ch = rem & 7;
            const v4u v = *(const v4u*)(xbc_b + (size_t)(t0 + row) * CONV_DIM + (6 * g + hh) * 64 + ch * 8);
            *(LAS v4u*)(ldsb + SSD_L_X + hh * SSD_XIMG + row * SSD_RS_X + ch * 16) = v; }
        __syncthreads();
        const bf16* cp = xbc_b + (size_t)(t0 + 32 * lt + r) * CONV_DIM + 2048 + 128 * g + 8 * h;
        s16x8 cfr[8];
#pragma unroll
        for (int ks = 0; ks < 8; ++ks) cfr[ks] = *(const s16x8*)(cp + 16 * ks);
        const int lcol = 32 * lt + r;
        const LAS float* acsb = (const LAS float*)(ldsb + SSD_L_ACS) + 3 * hs * 128; const LAS float* dtsb = (const LAS float*)(ldsb + SSD_L_DTS) + 3 * hs * 128;
        const unsigned xb0 = lds_addr(ldsb + SSD_L_X + 3 * hs * SSD_XIMG) + (4 * h + q) * SSD_RS_X + (16 * blk + 4 * pp) * 2;
        unsigned ypk[3][16];
#pragma unroll
        for (int h3 = 0; h3 < 3; ++h3) {
            const LAS float* acs = acsb + h3 * 128; const LAS float* dts = dtsb + h3 * 128;
            const float myacs = acs[lcol];
            const float Dh = d_skip[6 * g + 3 * hs + h3];
            f32x16 y0, y1;
#pragma unroll
            for (int i = 0; i < 16; ++i) { y0[i] = 0.f; y1[i] = 0.f; }
            { const bf16* hp = Hin + (((size_t)bc * SSD_HEADS + 6 * g + 3 * hs + h3) * 64 + r) * 128 + 8 * h;
#pragma unroll
              for (int kh = 0; kh < 2; ++kh) {
                  s16x8 hf0[4], hf1[4];
#pragma unroll
                  for (int ks = 0; ks < 4; ++ks) { hf0[ks] = *(const s16x8*)(hp + 16 * (4 * kh + ks)); hf1[ks] = *(const s16x8*)(hp + 32 * 128 + 16 * (4 * kh + ks)); }
#pragma unroll
                  for (int ks = 0; ks < 4; ++ks) { y0 = __builtin_amdgcn_mfma_f32_32x32x16_bf16(cfr[4 * kh + ks], hf0[ks], y0, 0, 0, 0); y1 = __builtin_amdgcn_mfma_f32_32x32x16_bf16(cfr[4 * kh + ks], hf1[ks], y1, 0, 0, 0); }
                  __builtin_amdgcn_sched_barrier(0);
              } }
#pragma unroll
            for (int q4 = 0; q4 < 4; ++q4) {
                const f32x4v a4 = *(const LAS f32x4v*)(acs + 32 * lt + 8 * q4 + 4 * h);
                const float e0 = __expf(a4[0]), e1 = __expf(a4[1]), e2 = __expf(a4[2]), e3 = __expf(a4[3]);
                y0[4 * q4] *= e0; y0[4 * q4 + 1] *= e1; y0[4 * q4 + 2] *= e2; y0[4 * q4 + 3] *= e3;
                y1[4 * q4] *= e0; y1[4 * q4 + 1] *= e1; y1[4 * q4 + 2] *= e2; y1[4 * q4 + 3] *= e3;
            }
            __builtin_amdgcn_sched_barrier(0);
            for (int st = 0; st <= lt; ++st) {
                f32x16 cb;
#pragma unroll
                for (int i = 0; i < 16; ++i) cb[i] = 0.f;
#pragma unroll
                for (int ks = 0; ks < 8; ++ks) {
                    const s16x8 bfrag = *(const LAS s16x8*)(ldsb + SSD_L_BM + (32 * st + r) * SSD_RS_B + (16 * ks + 8 * h) * 2);
                    cb = __builtin_amdgcn_mfma_f32_32x32x16_bf16(bfrag, cfr[ks], cb, 0, 0, 0);
                }
                __builtin_amdgcn_sched_barrier(0);
                const unsigned xb = xb0 + h3 * SSD_XIMG + st * 32 * SSD_RS_X;
                s16x4 xv[8];
                tr_read8<0, 8 * SSD_RS_X, 64, 8 * SSD_RS_X + 64, 16 * SSD_RS_X, 24 * SSD_RS_X, 16 * SSD_RS_X + 64, 24 * SSD_RS_X + 64>(xb, xv);
#pragma unroll
                for (int kk = 0; kk < 2; ++kk) {
                    const int s0 = 32 * st + 16 * kk + 4 * h;
                    const f32x4v as0 = *(const LAS f32x4v*)(acs + s0), as1 = *(const LAS f32x4v*)(acs + s0 + 8);
                    const f32x4v ds0 = *(const LAS f32x4v*)(dts + s0), ds1 = *(const LAS f32x4v*)(dts + s0 + 8);
                    float wv[8];
#pragma unroll
                    for (int j = 0; j < 8; ++j) {
                        const int s = s0 + 8 * (j >> 2) + (j & 3);
                        const float asj = (j < 4) ? as0[j & 3] : as1[j & 3], dsj = (j < 4) ? ds0[j & 3] : ds1[j & 3];
                        float v = cb[8 * kk + j] * __expf(myacs - asj) * dsj;
                        v = (s <= lcol) ? v : 0.f;
                        v = (s == lcol) ? v + Dh : v;
                        wv[j] = v;
                    }
                    s16x8 afr;
                    { v4u o; o.x = pk2(wv[0], wv[1]); o.y = pk2(wv[2], wv[3]); o.z = pk2(wv[4], wv[5]); o.w = pk2(wv[6], wv[7]); afr = __builtin_bit_cast(s16x8, o); }
                    const s16x8 b0 = kk == 0 ? TRCAT(xv[0], xv[1]) : TRCAT(xv[4], xv[5]);
                    const s16x8 b1 = kk == 0 ? TRCAT(xv[2], xv[3]) : TRCAT(xv[6], xv[7]);
                    y0 = __builtin_amdgcn_mfma_f32_32x32x16_bf16(afr, b0, y0, 0, 0, 0);
                    y1 = __builtin_amdgcn_mfma_f32_32x32x16_bf16(afr, b1, y1, 0, 0, 0);
                    __builtin_amdgcn_sched_barrier(0);
                }
            }
#pragma unroll
            for (int i = 0; i < 8; ++i) { ypk[h3][i] = pk2(y0[2 * i], y0[2 * i + 1]); ypk[h3][8 + i] = pk2(y1[2 * i], y1[2 * i + 1]); }
            __builtin_amdgcn_sched_barrier(0);
        }
        __syncthreads();
        {
            LAS unsigned short* yst = (LAS unsigned short*)(ldsb + SSD_L_X);
#pragma unroll
            for (int h3 = 0; h3 < 3; ++h3)
#pragma unroll
                for (int ptile = 0; ptile < 2; ++ptile)
#pragma unroll
                    for (int i = 0; i < 8; ++i) {
                        const int reg = 2 * i;
                        const int l0 = 32 * lt + (reg & 3) + 8 * (reg >> 2) + 4 * h;
                        const int col = (3 * hs + h3) * 64 + 32 * ptile + r;
                        const unsigned v = ypk[h3][8 * ptile + i];
                        yst[l0 * (SSD_RS_Y / 2) + col] = (unsigned short)(v & 0xffffu);
                        yst[(l0 + 1) * (SSD_RS_Y / 2) + col] = (unsigned short)(v >> 16);
                    }
        }
        __syncthreads();
#pragma unroll
        for (int pass = 0; pass < 4; ++pass) {
            const int l = 4 * (pass * 8 + w) + (lane >> 4), i16 = lane & 15;
            float gv[3][8]; float ss = 0.f;
#pragma unroll
            for (int k = 0; k < 3; ++k) {
                const int col0 = 24 * i16 + 8 * k;
                float yv[8], zv[8];
                unpack8(*(const LAS v4u*)(ldsb + SSD_L_X + l * SSD_RS_Y + col0 * 2), yv);
                unpack8(*(const v4u*)(projb + (size_t)(t0 + l) * NB_LD + g * 384 + col0), zv);
#pragma unroll
                for (int j = 0; j < 8; ++j) { const float gg = yv[j] * silu_f(zv[j]); gv[k][j] = gg; ss += gg * gg; }
            }
            ss += __shfl_xor(ss, 1); ss += __shfl_xor(ss, 2); ss += __shfl_xor(ss, 4); ss += __shfl_xor(ss, 8);
            const float rstd = rsqrtf(ss * (1.0f / 384.0f) + LN_EPS);
#pragma unroll
            for (int k = 0; k < 3; ++k) {
                const int col0 = g * 384 + 24 * i16 + 8 * k;
                const float4 g0 = *(const float4*)(norm_g + col0), g1 = *(const float4*)(norm_g + col0 + 4);
                v4u o; o.x = pk2(gv[k][0] * rstd * g0.x, gv[k][1] * rstd * g0.y); o.y = pk2(gv[k][2] * rstd * g0.z, gv[k][3] * rstd * g0.w);
                o.z = pk2(gv[k][4] * rstd * g1.x, gv[k][5] * rstd * g1.y); o.w = pk2(gv[k][6] * rstd * g1.z, gv[k][7] * rstd * g1.w);
                *(v4u*)(A1 + (size_t)(t0 + l) * MIX_WIDTH + col0) = o;
            }
        }
    }
}

#define ATT_RS_V 144
#define ATT_VIMG (256 * ATT_RS_V)
#define ATT_PVT(KT) { \
        s16x4 vv_[8]; \
        tr_read8<(32 * KT) * ATT_RS_V, (32 * KT + 8) * ATT_RS_V, (32 * KT) * ATT_RS_V + 64, (32 * KT + 8) * ATT_RS_V + 64, \
                 (32 * KT + 16) * ATT_RS_V, (32 * KT + 24) * ATT_RS_V, (32 * KT + 16) * ATT_RS_V + 64, (32 * KT + 24) * ATT_RS_V + 64>(vbase, vv_); \
        _Pragma("unroll") for (int s2_ = 0; s2_ < 2; ++s2_) { \
            v4u o_; o_.x = pk2(s[KT][8 * s2_ + 0], s[KT][8 * s2_ + 1]); o_.y = pk2(s[KT][8 * s2_ + 2], s[KT][8 * s2_ + 3]); \
            o_.z = pk2(s[KT][8 * s2_ + 4], s[KT][8 * s2_ + 5]); o_.w = pk2(s[KT][8 * s2_ + 6], s[KT][8 * s2_ + 7]); \
            const s16x8 pf_ = __builtin_bit_cast(s16x8, o_); \
            const s16x8 a0_ = s2_ == 0 ? TRCAT(vv_[0], vv_[1]) : TRCAT(vv_[4], vv_[5]); \
            const s16x8 a1_ = s2_ == 0 ? TRCAT(vv_[2], vv_[3]) : TRCAT(vv_[6], vv_[7]); \
            o0 = __builtin_amdgcn_mfma_f32_32x32x16_bf16(a0_, pf_, o0, 0, 0, 0); \
            o1 = __builtin_amdgcn_mfma_f32_32x32x16_bf16(a1_, pf_, o1, 0, 0, 0); } }
__device__ __forceinline__ void ph_attn_prompt(LAS unsigned char* ldsb, const bf16* __restrict__ qrot_b, const bf16* __restrict__ krot_b, const bf16* __restrict__ projb,
                                               bf16* __restrict__ obuf, float* __restrict__ lsebuf, const float* __restrict__ ck, const float* __restrict__ cv, float* __restrict__ out) {
    const int tid = threadIdx.x, w = __builtin_amdgcn_readfirstlane(tid >> 6), lane = tid & 63;
    const int r = lane & 31, h = lane >> 5, blk = (lane >> 4) & 1, q = (lane & 15) >> 2, pp = lane & 3;
    const int qt = w & 3, hsel = w >> 2;
    for (int unit = blockIdx.x; unit < 3 * 512; unit += gridDim.x) {
        const int pat = unit >> 9, rem = unit & 511, hp = rem & 3, rem2 = rem >> 2, b = rem2 >> 6, bk = rem2 & 63;
        const int dsh = 2 * pat, nper = 64 >> dsh, res = bk >> (6 - dsh), nb = bk & (nper - 1);
        const int head = 2 * hp + hsel;
        __syncthreads();
#pragma unroll
        for (int it_ = 0; it_ < 8; ++it_) { const int idx = (tid & 255) + it_ * 256;
            const int row = idx >> 3, ch = idx & 7, js = 128 * nb - 128 + row;
            v4u v; v.x = 0u; v.y = 0u; v.z = 0u; v.w = 0u;
            if (js >= 0) v = *(const v4u*)(projb + (size_t)(b * SEQ + (js << dsh) + res) * NB_LD + NB_V + head * 64 + ch * 8);
            *(LAS v4u*)(ldsb + hsel * ATT_VIMG + row * ATT_RS_V + ch * 16) = v;
        }
        const int tq = b * SEQ + ((128 * nb + 32 * qt + r) << dsh) + res;
        s16x8 qf[4];
#pragma unroll
        for (int ks = 0; ks < 4; ++ks) qf[ks] = *(const s16x8*)(qrot_b + (size_t)tq * ATT_WIDTH + head * 64 + 16 * ks + 8 * h);
        f32x16 s[5];
#pragma unroll
        for (int kt = 0; kt < 5; ++kt) {
            int js = 128 * nb + 32 * qt - 128 + 32 * kt + r; js = js < 0 ? 0 : js;
            const bf16* kp = krot_b + (size_t)(b * SEQ + (js << dsh) + res) * ATT_WIDTH + head * 64 + 8 * h;
#pragma unroll
            for (int i = 0; i < 16; ++i) s[kt][i] = 0.f;
#pragma unroll
            for (int ks = 0; ks < 4; ++ks) s[kt] = __builtin_amdgcn_mfma_f32_32x32x16_bf16(*(const s16x8*)(kp + 16 * ks), qf[ks], s[kt], 0, 0, 0);
        }
        f32x4n rider[16];
        copy_q_load(ck, cv, (unsigned)(unit * NWAVE + w), (unsigned)lane, rider);
        float m = -INFINITY;
#pragma unroll
        for (int kt = 0; kt < 5; ++kt) {
            const bool tile_ok = (nb > 0) || (qt + kt >= 4);
#pragma unroll
            for (int reg = 0; reg < 16; ++reg) {
                const int c = (reg & 3) + 8 * (reg >> 2) + 4 * h;
                const bool ok = tile_ok && (kt == 0 ? (c >= r) : (kt == 4 ? (c <= r) : true));
                const float v = ok ? s[kt][reg] * 0.125f : -INFINITY;
                s[kt][reg] = v; m = fmaxf(m, v);
            }
        }
        m = fmaxf(m, __shfl_xor(m, 32));
        float l = 0.f;
#pragma unroll
        for (int kt = 0; kt < 5; ++kt)
#pragma unroll
            for (int reg = 0; reg < 16; ++reg) { const float p = __expf(s[kt][reg] - m); s[kt][reg] = p; l += p; }
        l += __shfl_xor(l, 32);
        __syncthreads();
        f32x16 o0, o1;
#pragma unroll
        for (int i = 0; i < 16; ++i) { o0[i] = 0.f; o1[i] = 0.f; }
        const unsigned vbase = lds_addr(ldsb + hsel * ATT_VIMG) + (32 * qt + 4 * h + q) * ATT_RS_V + (16 * blk + 4 * pp) * 2;
        ATT_PVT(0) ATT_PVT(1) ATT_PVT(2) ATT_PVT(3) ATT_PVT(4)
        const float inv = 1.0f / l;
        bf16* op = obuf + ((size_t)pat * T_PROMPT + tq) * ATT_WIDTH + head * 64 + 4 * h;
#pragma unroll
        for (int q4 = 0; q4 < 4; ++q4) {
            *(uint2*)(op + 8 * q4) = make_uint2(pk2(o0[4 * q4] * inv, o0[4 * q4 + 1] * inv), pk2(o0[4 * q4 + 2] * inv, o0[4 * q4 + 3] * inv));
            *(uint2*)(op + 32 + 8 * q4) = make_uint2(pk2(o1[4 * q4] * inv, o1[4 * q4 + 1] * inv), pk2(o1[4 * q4 + 2] * inv, o1[4 * q4 + 3] * inv));
        }
        if (h == 0) lsebuf[((size_t)pat * T_PROMPT + tq) * 8 + head] = m + __logf(l);
        copy_q_store(out, (unsigned)(unit * NWAVE + w), (unsigned)lane, rider);
    }
}
__device__ __forceinline__ void ph_attn_combine(const bf16* __restrict__ obuf, const float* __restrict__ lsebuf, bf16* __restrict__ A1) {
    const int lane = threadIdx.x & 63;
#pragma unroll 4
    for (int t = blockIdx.x * NWAVE + (threadIdx.x >> 6); t < T_PROMPT; t += gridDim.x * NWAVE) {
        const int hd = lane >> 3;
        const float l0 = lsebuf[((size_t)0 * T_PROMPT + t) * 8 + hd], l1 = lsebuf[((size_t)1 * T_PROMPT + t) * 8 + hd], l2 = lsebuf[((size_t)2 * T_PROMPT + t) * 8 + hd];
        const float mx = fmaxf(l0, fmaxf(l1, l2));
        const float e0 = __expf(l0 - mx), e1 = __expf(l1 - mx), e2 = __expf(l2 - mx);
        const float inv = 1.0f / (e0 + e1 + e2);
        float a[8], b[8], c[8];
        unpack8(*(const v4u*)(obuf + ((size_t)0 * T_PROMPT + t) * ATT_WIDTH + lane * 8), a);
        unpack8(*(const v4u*)(obuf + ((size_t)1 * T_PROMPT + t) * ATT_WIDTH + lane * 8), b);
        unpack8(*(const v4u*)(obuf + ((size_t)2 * T_PROMPT + t) * ATT_WIDTH + lane * 8), c);
        float o[8];
#pragma unroll
        for (int j = 0; j < 8; ++j) o[j] = (e0 * a[j] + e1 * b[j] + e2 * c[j]) * inv;
        v4u w; w.x = pk2(o[0], o[1]); w.y = pk2(o[2], o[3]); w.z = pk2(o[4], o[5]); w.w = pk2(o[6], o[7]);
        *(v4u*)(A1 + (size_t)t * MIX_WIDTH + SSD_WIDTH + lane * 8) = w;
    }
}

#define RT_RS 272
#define RT_KIMG (128 * RT_RS)
#define RT_LUT (2 * RT_KIMG)
constexpr unsigned char RT_CANDS[64] = {0, 1, 2, 3, 4, 5, 6, 7, 8, 9, 10, 11, 12, 13, 14, 15, 16, 17, 18, 19, 20, 21, 22, 23, 32, 33, 34, 35, 36, 48, 49, 50, 51, 64, 65, 66, 80, 81, 96, 97,
                                        112, 113, 128, 144, 160, 176, 192, 208, 224, 240, 0, 0, 0, 0, 0, 0, 0, 0, 0, 0, 0, 0, 0, 0};
__device__ __forceinline__ unsigned rt_mono(float f) { const unsigned u = __builtin_bit_cast(unsigned, f); return u ^ ((unsigned)((int)u >> 31) | 0x80000000u); }
__device__ __forceinline__ float rt_unmono(unsigned m) { const unsigned u = (m & 0x80000000u) ? (m ^ 0x80000000u) : ~m; return __builtin_bit_cast(float, u); }
#define RT_CE_DESC(a, b) { const unsigned x_ = (a), y_ = (b); (a) = x_ > y_ ? x_ : y_; (b) = x_ > y_ ? y_ : x_; }
#define RT_CE_ASC(a, b) { const unsigned x_ = (a), y_ = (b); (a) = x_ > y_ ? y_ : x_; (b) = x_ > y_ ? x_ : y_; }
__device__ __forceinline__ void rt_sort16(unsigned (&v)[16]) {
#pragma unroll
    for (int k = 2; k <= 16; k <<= 1)
#pragma unroll
        for (int j = k >> 1; j > 0; j >>= 1)
#pragma unroll
            for (int i = 0; i < 16; ++i) { const int l = i ^ j; if (l > i) { if ((i & k) == 0) RT_CE_DESC(v[i], v[l]) else RT_CE_ASC(v[i], v[l]) } }
}
__device__ __forceinline__ void rt_merge16(unsigned (&v)[16]) {
#pragma unroll
    for (int j = 8; j > 0; j >>= 1)
#pragma unroll
        for (int i = 0; i < 16; ++i) { const int l = i ^ j; if (l > i) RT_CE_DESC(v[i], v[l]) }
}
__device__ __forceinline__ void rt_top16(unsigned (&a)[16], const unsigned (&b)[16]) {
#pragma unroll
    for (int i = 0; i < 16; ++i) a[i] = a[i] > b[15 - i] ? a[i] : b[15 - i];
    rt_merge16(a);
}
__device__ __forceinline__ void rt_top16_partner(unsigned (&a)[16]) {
    unsigned b[16];
#pragma unroll
    for (int i = 0; i < 16; ++i) b[i] = (unsigned)__shfl_xor((int)a[i], 32);
    rt_top16(a, b);
}
__device__ __forceinline__ void rt_scores_top16(LAS unsigned char* kimg, const bf16* __restrict__ qp, int r, int h, unsigned (&k0)[16]) {
    f32x16 acc[4];
#pragma unroll
    for (int kt = 0; kt < 4; ++kt)
#pragma unroll
        for (int i = 0; i < 16; ++i) acc[kt][i] = 0.f;
#pragma unroll
    for (int ks = 0; ks < 8; ++ks) {
        const s16x8 qf = *(const s16x8*)(qp + 16 * ks);
#pragma unroll
        for (int kt = 0; kt < 4; ++kt) {
            const s16x8 kf = *(const LAS s16x8*)(kimg + (32 * kt + r) * RT_RS + (16 * ks + 8 * h) * 2);
            acc[kt] = __builtin_amdgcn_mfma_f32_32x32x16_bf16(kf, qf, acc[kt], 0, 0, 0);
        }
    }
    unsigned k1[16], k2[16], k3[16];
#pragma unroll
    for (int reg = 0; reg < 16; ++reg) {
        const unsigned ki = (unsigned)((reg & 3) + 8 * (reg >> 2) + 4 * h);
        k0[reg] = (rt_mono(acc[0][reg]) & 0xFFFFFF80u) | ki;
        k1[reg] = (rt_mono(acc[1][reg]) & 0xFFFFFF80u) | (ki + 32u);
        k2[reg] = (rt_mono(acc[2][reg]) & 0xFFFFFF80u) | (ki + 64u);
        k3[reg] = (rt_mono(acc[3][reg]) & 0xFFFFFF80u) | (ki + 96u);
    }
    rt_sort16(k0); rt_sort16(k1); rt_sort16(k2); rt_sort16(k3);
    rt_top16(k0, k1); rt_top16(k2, k3); rt_top16(k0, k2);
    rt_top16_partner(k0);
}
__device__ __forceinline__ void ph_peer_route2(LAS unsigned char* ldsb, const bf16* __restrict__ qhb, const float* __restrict__ keys1, const float* __restrict__ keys2,
                                               int* __restrict__ eidx, float* __restrict__ gate) {
    const int tid = threadIdx.x, w = __builtin_amdgcn_readfirstlane(tid >> 6), lane = tid & 63, r = lane & 31, h = lane >> 5;
    __syncthreads();
    for (int idx = tid; idx < 2 * 128 * 16; idx += NTHR) {
        const int tb = idx >> 11, rem = idx & 2047, row = rem >> 4, ch = rem & 15;
        const float* sp = (tb ? keys2 : keys1) + row * 128 + ch * 8;
        const float4 a = *(const float4*)sp, b = *(const float4*)(sp + 4);
        v4u o; o.x = pk2(a.x, a.y); o.y = pk2(a.z, a.w); o.z = pk2(b.x, b.y); o.w = pk2(b.z, b.w);
        *(LAS v4u*)(ldsb + tb * RT_KIMG + row * RT_RS + ch * 16) = o;
    }
    __syncthreads();
    LAS unsigned* lut = (LAS unsigned*)(ldsb + RT_LUT) + w * 512;
    for (int unit = blockIdx.x * NWAVE + w; unit < (T_ALL / 32) * 8; unit += gridDim.x * NWAVE) {
        const int tt = unit >> 3, hd = unit & 7;
        const int tok = 32 * tt + r;
        const bf16* qp = qhb + (size_t)tok * 2048 + hd * 256 + 8 * h;
        unsigned ka[16], kb[16];
        rt_scores_top16(ldsb, qp, r, h, ka);
        rt_scores_top16(ldsb + RT_KIMG, qp + 128, r, h, kb);
        float v1[16], v2[16];
#pragma unroll
        for (int i = 0; i < 16; ++i) { v1[i] = rt_unmono(ka[i] & 0xFFFFFF80u); v2[i] = rt_unmono(kb[i] & 0xFFFFFF80u); }
#pragma unroll
        for (int wd = 0; wd < 4; ++wd) {
            lut[wd * 64 + lane] = (ka[4 * wd] & 0x7Fu) | ((ka[4 * wd + 1] & 0x7Fu) << 8) | ((ka[4 * wd + 2] & 0x7Fu) << 16) | ((ka[4 * wd + 3] & 0x7Fu) << 24);
            lut[(4 + wd) * 64 + lane] = (kb[4 * wd] & 0x7Fu) | ((kb[4 * wd + 1] & 0x7Fu) << 8) | ((kb[4 * wd + 2] & 0x7Fu) << 16) | ((kb[4 * wd + 3] & 0x7Fu) << 24);
        }
        unsigned c0[16], c1[16];
        c0[0] = (rt_mono(h ? (v1[0] + v2[1]) : (v1[0] + v2[0])) & 0xFFFFFF00u) | (h ? 1u : 0u);
        c0[1] = (rt_mono(h ? (v1[0] + v2[3]) : (v1[0] + v2[2])) & 0xFFFFFF00u) | (h ? 3u : 2u);
        c0[2] = (rt_mono(h ? (v1[0] + v2[5]) : (v1[0] + v2[4])) & 0xFFFFFF00u) | (h ? 5u : 4u);
        c0[3] = (rt_mono(h ? (v1[0] + v2[7]) : (v1[0] + v2[6])) & 0xFFFFFF00u) | (h ? 7u : 6u);
        c0[4] = (rt_mono(h ? (v1[0] + v2[9]) : (v1[0] + v2[8])) & 0xFFFFFF00u) | (h ? 9u : 8u);
        c0[5] = (rt_mono(h ? (v1[0] + v2[11]) : (v1[0] + v2[10])) & 0xFFFFFF00u) | (h ? 11u : 10u);
        c0[6] = (rt_mono(h ? (v1[0] + v2[13]) : (v1[0] + v2[12])) & 0xFFFFFF00u) | (h ? 13u : 12u);
        c0[7] = (rt_mono(h ? (v1[0] + v2[15]) : (v1[0] + v2[14])) & 0xFFFFFF00u) | (h ? 15u : 14u);
        c0[8] = (rt_mono(h ? (v1[1] + v2[1]) : (v1[1] + v2[0])) & 0xFFFFFF00u) | (h ? 17u : 16u);
        c0[9] = (rt_mono(h ? (v1[1] + v2[3]) : (v1[1] + v2[2])) & 0xFFFFFF00u) | (h ? 19u : 18u);
        c0[10] = (rt_mono(h ? (v1[1] + v2[5]) : (v1[1] + v2[4])) & 0xFFFFFF00u) | (h ? 21u : 20u);
        c0[11] = (rt_mono(h ? (v1[1] + v2[7]) : (v1[1] + v2[6])) & 0xFFFFFF00u) | (h ? 23u : 22u);
        c0[12] = (rt_mono(h ? (v1[2] + v2[1]) : (v1[2] + v2[0])) & 0xFFFFFF00u) | (h ? 33u : 32u);
        c0[13] = (rt_mono(h ? (v1[2] + v2[3]) : (v1[2] + v2[2])) & 0xFFFFFF00u) | (h ? 35u : 34u);
        c0[14] = (rt_mono(h ? (v1[3] + v2[0]) : (v1[2] + v2[4])) & 0xFFFFFF00u) | (h ? 48u : 36u);
        c0[15] = (rt_mono(h ? (v1[3] + v2[2]) : (v1[3] + v2[1])) & 0xFFFFFF00u) | (h ? 50u : 49u);
        c1[0] = (rt_mono(h ? (v1[4] + v2[0]) : (v1[3] + v2[3])) & 0xFFFFFF00u) | (h ? 64u : 51u);
        c1[1] = (rt_mono(h ? (v1[4] + v2[2]) : (v1[4] + v2[1])) & 0xFFFFFF00u) | (h ? 66u : 65u);
        c1[2] = (rt_mono(h ? (v1[5] + v2[1]) : (v1[5] + v2[0])) & 0xFFFFFF00u) | (h ? 81u : 80u);
        c1[3] = (rt_mono(h ? (v1[6] + v2[1]) : (v1[6] + v2[0])) & 0xFFFFFF00u) | (h ? 97u : 96u);
        c1[4] = (rt_mono(h ? (v1[7] + v2[1]) : (v1[7] + v2[0])) & 0xFFFFFF00u) | (h ? 113u : 112u);
        c1[5] = (rt_mono(h ? (v1[9] + v2[0]) : (v1[8] + v2[0])) & 0xFFFFFF00u) | (h ? 144u : 128u);
        c1[6] = (rt_mono(h ? (v1[11] + v2[0]) : (v1[10] + v2[0])) & 0xFFFFFF00u) | (h ? 176u : 160u);
        c1[7] = (rt_mono(h ? (v1[13] + v2[0]) : (v1[12] + v2[0])) & 0xFFFFFF00u) | (h ? 208u : 192u);
        c1[8] = (rt_mono(h ? (v1[15] + v2[0]) : (v1[14] + v2[0])) & 0xFFFFFF00u) | (h ? 240u : 224u);
        c1[9] = 0u;
        c1[10] = 0u;
        c1[11] = 0u;
        c1[12] = 0u;
        c1[13] = 0u;
        c1[14] = 0u;
        c1[15] = 0u;
        rt_sort16(c0); rt_sort16(c1); rt_top16(c0, c1); rt_top16_partner(c0);
        float e[16]; float sum = 0.f;
        const float mx = rt_unmono(c0[0] & 0xFFFFFF00u);
#pragma unroll
        for (int k = 0; k < 16; ++k) { e[k] = __expf(rt_unmono(c0[k] & 0xFFFFFF00u) - mx); sum += e[k]; }
        const float inv = 1.0f / sum;
        asm volatile("s_waitcnt lgkmcnt(0)" ::: "memory");
        int ex[8]; float gv[8];
#pragma unroll
        for (int k = 0; k < 8; ++k) {
            const unsigned hm = (unsigned)(-h);
            const unsigned ck = (c0[k] & ~hm) | (c0[8 + k] & hm);
            const float ek = __builtin_bit_cast(float, (__builtin_bit_cast(unsigned, e[k]) & ~hm) | (__builtin_bit_cast(unsigned, e[8 + k]) & hm));
            const unsigned ci = (ck >> 4) & 15u, cj = ck & 15u;
            const unsigned w1 = lut[(ci >> 2) * 64 + lane], w2 = lut[(4 + (cj >> 2)) * 64 + lane];
            const unsigned i1 = (w1 >> (8 * (ci & 3))) & 0x7Fu, i2 = (w2 >> (8 * (cj & 3))) & 0x7Fu;
            ex[k] = (int)(i1 * PEER_NKEYS + i2); gv[k] = ek * inv;
        }
        int* ep = eidx + (size_t)tok * 128 + hd * 16 + 8 * h; float* gp = gate + (size_t)tok * 128 + hd * 16 + 8 * h;
        *(int4*)ep = make_int4(ex[0], ex[1], ex[2], ex[3]); *(int4*)(ep + 4) = make_int4(ex[4], ex[5], ex[6], ex[7]);
        *(float4*)gp = make_float4(gv[0], gv[1], gv[2], gv[3]); *(float4*)(gp + 4) = make_float4(gv[4], gv[5], gv[6], gv[7]);
    }
}

struct Params {
    const float* in[23];
    float* out;
    unsigned char* ws;
    unsigned* bar;
};

#define WS_BAR      0ull
#define WS_XALL     (1ull << 20)
#define WS_PROJ     (WS_XALL + (size_t)T_ALL * D_MODEL * 4)
#define WS_XBC      (WS_PROJ + (size_t)T_ALL * PROJ_LD * 4)
#define WS_DT       (WS_XBC + (size_t)T_ALL * CONV_DIM * 4)
#define WS_QROT     (WS_DT + (size_t)T_ALL * SSD_HEADS * 4)
#define WS_KROT     (WS_QROT + (size_t)T_ALL * ATT_WIDTH * 4)
#define WS_YBUF     (WS_KROT + (size_t)T_ALL * ATT_WIDTH * 4)
#define WS_MIX      (WS_YBUF + (size_t)T_ALL * MIX_WIDTH * 4)
#define WS_HBUF     (WS_MIX + (size_t)T_ALL * D_MODEL * 4)
#define WS_QH       (WS_HBUF + (size_t)T_ALL * D_MODEL * 4)
#define WS_EIDX     (WS_QH + (size_t)T_ALL * 2048 * 4)
#define WS_GATE     (WS_EIDX + (size_t)T_ALL * 128 * 4)
#define WS_A0       (WS_GATE + (size_t)T_ALL * 128 * 4)
#define WS_A1       (WS_A0 + (size_t)T_ALL * D_MODEL * 2)
#define WS_A2       (WS_A1 + (size_t)T_ALL * MIX_WIDTH * 2)
#define WS_WTIN     (WS_A2 + (size_t)T_ALL * D_MODEL * 2)
#define WS_WTOUT    (WS_WTIN + (size_t)PROJ_LD * D_MODEL * 2)
#define WS_WTQ      (WS_WTOUT + (size_t)D_MODEL * MIX_WIDTH * 2)
#define WS_PROJB    (WS_WTQ + (size_t)2048 * D_MODEL * 2)
#define WS_DTRAW    (WS_PROJB + (size_t)T_ALL * NB_LD * 2)
#define WS_XBCB     (WS_DTRAW + (size_t)T_ALL * 32 * 4)
#define WS_QROTB    (WS_XBCB + (size_t)T_ALL * CONV_DIM * 2)
#define WS_KROTB    (WS_QROTB + (size_t)T_ALL * ATT_WIDTH * 2)
#define WS_UB       (WS_KROTB + (size_t)T_ALL * ATT_WIDTH * 2)
#define WS_VB       (WS_UB + (size_t)16384 * D_MODEL * 2)
#define WS_USC      (WS_VB + (size_t)16384 * D_MODEL * 2)
#define WS_VSC      (WS_USC + 16384 * 4)
#define WS_SBUF     (WS_VSC + 16384 * 4)
#define WS_HIN      (WS_SBUF + (size_t)BATCH * 64 * SSD_HEADS * 64 * 128 * 2)
#define WS_CDEC     (WS_HIN + (size_t)BATCH * 64 * SSD_HEADS * 64 * 128 * 2)
#define WS_OBUF     (WS_CDEC + (size_t)BATCH * 64 * SSD_HEADS * 4)
#define WS_LSE      (WS_OBUF + (size_t)3 * T_PROMPT * ATT_WIDTH * 2)
#define WS_ROPE     (WS_LSE + (size_t)3 * T_PROMPT * 8 * 4)
#define WS_END      (WS_ROPE + (size_t)SEQ * 64 * 4)

#define LDS_BYTES (160 * 1024)

#define KP const __attribute__((address_space(4))) Params* kp = (const __attribute__((address_space(4))) Params*)__builtin_amdgcn_kernarg_segment_ptr(); asm volatile("" : "+s"(kp)); unsigned char* ws = kp->ws; (void)ws;
#define IN(i) (kp->in[i])
#define WSP(T, off) ((T*)(ws + (off)))
__global__ void __launch_bounds__(512, 2) mega_fwd(Params p) {
    extern __shared__ __attribute__((aligned(16))) unsigned char smem[];
    if (threadIdx.x == 0) *(uint4*)smem = make_uint4(0u, 0u, 0u, 0u);
    __syncthreads();
    XcdBarrier bar = xcd_barrier_post(p.bar, (volatile LAS unsigned*)smem);
    float* lds = (float*)(smem + 256);
    LAS unsigned char* ldsb = (LAS unsigned char*)smem + 256;

    { KP ph_prologue(ldsb, IN(0), IN(1), WSP(bf16, WS_A0), IN(6), WSP(bf16, WS_WTIN), WSP(float, WS_ROPE)); }
    xcd_barrier(bar);
    { KP pg8::Gemm g{WSP(bf16, WS_A0), WSP(bf16, WS_WTIN), T_ALL, PROJ_LD, D_MODEL}; pg8::StaticOrder S; S.init(g.M, g.N, (int)gridDim.x, (int)blockIdx.x);
      pg8::EpiProj E{WSP(bf16, WS_PROJB), WSP(float, WS_DTRAW)}; pg8::gemm_phase<pg8::EpiProj, pg8::StaticOrder, false>(ldsb, g, S, E, nullptr); }
    xcd_barrier(bar);
    { KP ph_post_proj_prompt(WSP(bf16, WS_PROJB), WSP(float, WS_DTRAW), IN(7), IN(8), IN(9), WSP(float, WS_ROPE), WSP(bf16, WS_XBCB), WSP(float, WS_DT), WSP(bf16, WS_QROTB), WSP(bf16, WS_KROTB), kp->out); }
    { KP ph_post_proj2(WSP(bf16, WS_PROJB), WSP(float, WS_DTRAW), IN(4), IN(7), IN(8), IN(9), WSP(bf16, WS_XBCB), WSP(float, WS_DT), WSP(bf16, WS_QROTB), WSP(bf16, WS_KROTB), kp->out); }
    xcd_barrier(bar);
    { KP ph_ssd_states(ldsb, WSP(bf16, WS_XBCB), WSP(float, WS_DT), IN(10), WSP(bf16, WS_SBUF), WSP(float, WS_CDEC), IN(2), IN(3), kp->out); }
    __syncthreads();
    { KP ph_attn_prompt(ldsb, WSP(bf16, WS_QROTB), WSP(bf16, WS_KROTB), WSP(bf16, WS_PROJB), WSP(bf16, WS_OBUF), WSP(float, WS_LSE), IN(2), IN(3), kp->out); }
    __syncthreads();
    { KP ph_ssd_decode(WSP(bf16, WS_XBCB), WSP(float, WS_DT), IN(10), IN(11), IN(5), WSP(float, WS_YBUF), kp->out); }
    { KP ph_attn_sample3(lds, WSP(bf16, WS_QROTB), WSP(bf16, WS_KROTB), WSP(bf16, WS_PROJB), IN(2), IN(3), WSP(bf16, WS_A1)); }
    xcd_barrier(bar);
    if ((int)gridDim.x > 128) {
        if ((int)blockIdx.x < 96) { KP ph_ssd_scan(WSP(bf16, WS_SBUF), WSP(float, WS_CDEC), WSP(bf16, WS_HIN), kp->out, (int)blockIdx.x, 96); }
        else {
            { KP ph_prologue2(ldsb, IN(13), WSP(bf16, WS_WTOUT), IN(16), WSP(bf16, WS_WTQ), (int)blockIdx.x - 96, (int)gridDim.x - 96); }
            { KP ph_quant_tables(IN(19), IN(20), WSP(unsigned char, WS_UB), WSP(unsigned char, WS_VB), WSP(float, WS_USC), WSP(float, WS_VSC), (int)blockIdx.x - 96, (int)gridDim.x - 96); }
        }
    } else {
        { KP ph_ssd_scan(WSP(bf16, WS_SBUF), WSP(float, WS_CDEC), WSP(bf16, WS_HIN), kp->out, (int)blockIdx.x, (int)gridDim.x); }
        { KP ph_prologue2(ldsb, IN(13), WSP(bf16, WS_WTOUT), IN(16), WSP(bf16, WS_WTQ), (int)blockIdx.x, (int)gridDim.x); }
        { KP ph_quant_tables(IN(19), IN(20), WSP(unsigned char, WS_UB), WSP(unsigned char, WS_VB), WSP(float, WS_USC), WSP(float, WS_VSC), (int)blockIdx.x, (int)gridDim.x); }
    }
    xcd_barrier(bar);
    { KP ph_ssd_out(ldsb, WSP(bf16, WS_XBCB), WSP(bf16, WS_PROJB), WSP(float, WS_DT), IN(10), IN(11), IN(12), WSP(bf16, WS_HIN), WSP(bf16, WS_A1)); }
    { KP ph_attn_combine(WSP(bf16, WS_OBUF), WSP(float, WS_LSE), WSP(bf16, WS_A1)); }
    { KP ph_gate_norm(WSP(bf16, WS_PROJB), IN(12), WSP(float, WS_YBUF), WSP(bf16, WS_A1)); }
    xcd_barrier(bar);
    { KP pg8::Gemm g{WSP(bf16, WS_A1), WSP(bf16, WS_WTOUT), T_ALL, D_MODEL, MIX_WIDTH}; pg8::StaticOrder S; S.init(g.M, g.N, (int)gridDim.x, (int)blockIdx.x);
      pg8::EpiBf16Plain E{WSP(bf16, WS_MIX), D_MODEL}; pg8::gemm_phase<pg8::EpiBf16Plain, pg8::StaticOrder, false>(ldsb, g, S, E, nullptr); }
    if (blockIdx.x >= 8 && gridDim.x == 256) { KP cache_copy_slice(IN(2), IN(3), kp->out, 4096u + (blockIdx.x - 8) * 8u + (threadIdx.x >> 6), threadIdx.x & 63u); }
    xcd_barrier(bar);
    { KP ph_ln_res(IN(0), IN(1), WSP(bf16, WS_MIX), IN(14), IN(15), WSP(bf16, WS_A2)); }
    xcd_barrier(bar);
    { KP pg8::Gemm g{WSP(bf16, WS_A2), WSP(bf16, WS_WTQ), T_ALL, 2048, D_MODEL}; pg8::StaticOrder S; S.init(g.M, g.N, (int)gridDim.x, (int)blockIdx.x);
      pg8::EpiBf16Plain E{WSP(bf16, WS_QH), 2048}; pg8::gemm_phase<pg8::EpiBf16Plain, pg8::StaticOrder, false>(ldsb, g, S, E, nullptr); }
    if (blockIdx.x >= 16 && gridDim.x == 256 && threadIdx.x < 256) { KP cache_copy_slice(IN(2), IN(3), kp->out, 4096u + 1984u + (blockIdx.x - 16) * 4u + (threadIdx.x >> 6), threadIdx.x & 63u); }
    xcd_barrier(bar);
    { KP ph_peer_route2(ldsb, WSP(bf16, WS_QH), IN(17), IN(18), WSP(int, WS_EIDX), WSP(float, WS_GATE)); }
    xcd_barrier(bar);
    { KP ph_peer_ffn3(WSP(bf16, WS_A2), WSP(int, WS_EIDX), WSP(float, WS_GATE), WSP(unsigned char, WS_UB), WSP(unsigned char, WS_VB), WSP(float, WS_USC), WSP(float, WS_VSC), IN(21), IN(22), kp->out, IN(2), IN(3), gridDim.x == 256 ? 7040u : 4096u); }
}

extern "C" void kernel_launch(void* const* d_in, const int* in_sizes, int n_in, void* d_out, int out_size, void* d_ws, size_t ws_size, hipStream_t stream) {
    static int grid = 0;
    if (grid == 0) {
        int dev = 0, cus = 0, per_cu = 0;
        if (hipGetDevice(&dev) != hipSuccess || hipDeviceGetAttribute(&cus, hipDeviceAttributeMultiprocessorCount, dev) != hipSuccess) { fprintf(stderr, "kernel_launch: device query failed\n"); grid = -1; return; }
        if (hipFuncSetAttribute((const void*)mega_fwd, hipFuncAttributeMaxDynamicSharedMemorySize, LDS_BYTES) != hipSuccess) { fprintf(stderr, "kernel_launch: hipFuncSetAttribute failed\n"); grid = -1; return; }
        if (hipOccupancyMaxActiveBlocksPerMultiprocessor(&per_cu, (const void*)mega_fwd, NTHR, LDS_BYTES) != hipSuccess || per_cu < 1) { fprintf(stderr, "kernel_launch: occupancy query says %d\n", per_cu); }
        (void)hipGetLastError();
        grid = cus;
        if (ws_size < WS_END) { fprintf(stderr, "kernel_launch: workspace too small\n"); grid = -1; return; }
    }
    if (grid < 0) return;
    (void)hipMemsetAsync((char*)d_ws + WS_BAR, 0, XCD_BAR_WORDS * sizeof(unsigned), stream);
    Params p{};
    for (int i = 0; i < 23; ++i) p.in[i] = (const float*)d_in[i];
    p.out = (float*)d_out; p.ws = (unsigned char*)d_ws; p.bar = (unsigned*)((char*)d_ws + WS_BAR);
    hipLaunchKernelGGL(mega_fwd, dim3(grid), dim3(NTHR), LDS_BYTES, stream, p);
}
```

```cpp
#include <hip/hip_runtime.h>
#include <stdint.h>

#define D_MODEL 1024
#define BATCH 2
#define SEQ 8192
#define DEC_BATCH 128
#define DEC_SEQ 4
#define PAST_LEN 8192
#define HEAD_DIM 64
#define ATT_WIDTH 512
#define ATT_HEADS 8
#define SSD_WIDTH 1536
#define SSD_HEADS 24
#define SSD_GROUPS 4
#define SSD_STATE 128
#define CONV_DIM 2560
#define IN_WIDTH 5656
#define PROJ_LD 5888
#define MIX_WIDTH 2048
#define WBUF 2048
#define PEER_NKEYS 128
#define PEER_HEADS 8
#define PEER_TOPK 16
#define PEER_DKEY 256
#define T_PROMPT (BATCH * SEQ)
#define T_SAMPLE (DEC_BATCH * DEC_SEQ)
#define T_ALL (T_PROMPT + T_SAMPLE)
#define O_Z 0
#define O_XBC 1536
#define O_DT 4096
#define O_Q 4120
#define O_K 4632
#define O_V 5144
#define ALPHA_F 1.189207115002721f
#define LN_EPS 1e-5f

#define OUT_YP 0ull
#define OUT_YS (OUT_YP + 16777216ull)
#define OUT_PK (OUT_YS + 524288ull)
#define OUT_PV (OUT_PK + 2097152ull)
#define OUT_PC (OUT_PV + 2097152ull)
#define OUT_PS (OUT_PC + 15360ull)
#define OUT_SK (OUT_PS + 393216ull)
#define OUT_SV (OUT_SK + 134217728ull)
#define OUT_SC (OUT_SV + 134217728ull)
#define OUT_SS (OUT_SC + 983040ull)

__constant__ double ROPE_INV_REV[32] = {
    1.59154943091895346e-01, 1.19349370211248862e-01, 8.94994016088910133e-02, 6.71150830052272551e-02,
    5.03292121044870353e-02, 3.77415847174197711e-02, 2.83021958306233987e-02, 2.12236527647776604e-02,
    1.59154943091895339e-02, 1.19349370211248862e-02, 8.94994016088910237e-03, 6.71150830052272534e-03,
    5.03292121044870370e-03, 3.77415847174197719e-03, 2.83021958306233987e-03, 2.12236527647776622e-03,
    1.59154943091895356e-03, 1.19349370211248849e-03, 8.94994016088910237e-04, 6.71150830052272599e-04,
    5.03292121044870326e-04, 3.77415847174197741e-04, 2.83021958306233954e-04, 2.12236527647776605e-04,
    1.59154943091895351e-04, 1.19349370211248862e-04, 8.94994016088910182e-05, 6.71150830052272545e-05,
    5.03292121044870354e-05, 3.77415847174197768e-05, 2.83021958306233961e-05, 2.12236527647776592e-05
};

__device__ __forceinline__ float silu_f(float x) { return x * __builtin_amdgcn_rcpf(1.0f + __expf(-x)); }
__device__ __forceinline__ float softplus_f(float x) { return fmaxf(x, 0.f) + log1pf(__expf(-fabsf(x))); }
__device__ __forceinline__ float gelu_f(float x) { return 0.5f * x * (1.0f + erff(x * 0.70710678118654752f)); }
__device__ __forceinline__ float wave_sum(float v) {
#pragma unroll
    for (int o = 32; o > 0; o >>= 1) v += __shfl_xor(v, o);
    return v;
}
__device__ __forceinline__ float wave_max(float v) {
#pragma unroll
    for (int o = 32; o > 0; o >>= 1) v = fmaxf(v, __shfl_xor(v, o));
    return v;
}

#include <cstdio>
#define XB_TMO      128
#define XB_XCNT(j)  (256  + 64 * (j))
#define XB_XSUB(j)  (1280 + 64 * (j))
#define XB_XGEN(j)  (2304 + 64 * (j))
#define XB_TOP      3328
#define XB_TOPGEN   3392
#define XCD_BAR_WORDS 3456
#define XB_SPIN_CAP (1u << 18)
#define LAS __attribute__((address_space(3)))

__device__ __forceinline__ unsigned xb_ld(unsigned* p)              { return __hip_atomic_load(p, __ATOMIC_RELAXED, __HIP_MEMORY_SCOPE_AGENT); }
__device__ __forceinline__ unsigned xb_add(unsigned* p, unsigned v) { return __hip_atomic_fetch_add(p, v, __ATOMIC_RELAXED, __HIP_MEMORY_SCOPE_AGENT); }
__device__ __forceinline__ unsigned xb_xcc_id() { return (unsigned)__builtin_amdgcn_s_getreg((3 << 11) | 20) & 0xFu; }
#define XB_SPIN(cond, bar) do { unsigned _sp = 0; while (cond) { __builtin_amdgcn_s_sleep(1); \
    if ((++_sp & 255u) == 0u) { if (xb_ld(&(bar)[XB_TMO])) break; if (_sp > XB_SPIN_CAP) { atomicAdd(&(bar)[XB_TMO], 1u); break; } } } } while (0)

struct XcdBarrier {
    unsigned* bar; unsigned x;
    volatile LAS unsigned* st;
};

__device__ __forceinline__ XcdBarrier xcd_barrier_post(unsigned* bar, volatile LAS unsigned* st) {
    XcdBarrier b; b.bar = bar; b.x = xb_xcc_id(); b.st = st;
    if (threadIdx.x == 0) (void)xb_add(&bar[XB_XCNT(b.x)], 1u);
    return b;
}
__device__ __forceinline__ void xcd_barrier_complete(unsigned* bar, unsigned x, unsigned& nloc, unsigned& nx) {
    const unsigned G = gridDim.x * gridDim.y * gridDim.z;
    unsigned sum, cnt, mine, sp = 0u;
    for (;;) {
        sum = 0u; cnt = 0u; mine = 0u;
#pragma unroll
        for (unsigned j = 0; j < 16; ++j) { const unsigned c = xb_ld(&bar[XB_XCNT(j)]); sum += c; cnt += (c > 0u) ? 1u : 0u; mine = (j == x) ? c : mine; }
        if (sum == G) break;
        __builtin_amdgcn_s_sleep(1);
        if ((++sp & 255u) == 0u) { if (xb_ld(&bar[XB_TMO])) break; if (sp > XB_SPIN_CAP) { atomicAdd(&bar[XB_TMO], 1u); break; } }
    }
    nloc = mine > 0u ? mine : 1u; nx = cnt > 0u ? cnt : 1u;
}

__device__ __forceinline__ void xcd_barrier(const XcdBarrier& b) {
    asm volatile("s_waitcnt vmcnt(0)" ::: "memory");
    __syncthreads();
    if (threadIdx.x == 0) {
        unsigned* bar = b.bar;
        __builtin_amdgcn_s_waitcnt(0);
        unsigned nloc = b.st[0], nx = b.st[1];
        if (nloc == 0u) { xcd_barrier_complete(bar, b.x, nloc, nx); b.st[0] = nloc; b.st[1] = nx; }
        const unsigned old = xb_add(&bar[XB_XSUB(b.x)], 1u);
        const unsigned gen = old / nloc;
        if (old + 1u == (gen + 1u) * nloc) {
            __builtin_amdgcn_fence(__ATOMIC_RELEASE, "agent");
            asm volatile("s_waitcnt vmcnt(0)" ::: "memory");
            const unsigned og = xb_add(&bar[XB_TOP], 1u);
            const unsigned tg = og / nx;
            if (og + 1u == (tg + 1u) * nx) xb_add(&bar[XB_TOPGEN], 1u);
            else XB_SPIN(xb_ld(&bar[XB_TOPGEN]) == tg, bar);
            __builtin_amdgcn_fence(__ATOMIC_ACQUIRE, "agent");
            xb_add(&bar[XB_XGEN(b.x)], 1u);
            asm volatile("s_waitcnt vmcnt(0)" ::: "memory");
        } else {
            XB_SPIN(xb_ld(&bar[XB_XGEN(b.x)]) == gen, bar);
            __builtin_amdgcn_fence(__ATOMIC_ACQUIRE, "agent");
            asm volatile("s_waitcnt vmcnt(0)" ::: "memory");
        }
    }
    __syncthreads();
}


#define GAS __attribute__((address_space(1)))
typedef unsigned short bf16;
typedef unsigned v4u __attribute__((ext_vector_type(4)));
#define LDS_WAIT() asm volatile("s_waitcnt lgkmcnt(0)" ::: "memory")
__device__ __forceinline__ unsigned f2bf(float f) { unsigned u = __builtin_bit_cast(unsigned, f); return (u + 0x7fffu + ((u >> 16) & 1u)) >> 16; }
__device__ __forceinline__ unsigned pk2(float lo, float hi) { return f2bf(lo) | (f2bf(hi) << 16); }
__device__ __forceinline__ float bf2f(unsigned short b) { return __builtin_bit_cast(float, (unsigned)b << 16); }
#include <hip/hip_runtime.h>
namespace pg8 {
#define PG8_LAS __attribute__((address_space(3)))
typedef unsigned short bf16_t;
typedef short bf16x8 __attribute__((ext_vector_type(8)));
typedef float f32x4 __attribute__((ext_vector_type(4)));
typedef unsigned u32x4 __attribute__((ext_vector_type(4)));
constexpr int BM = 256, BK = 64, HALF = 128, HTB = HALF * BK * 2  , STAGE_BYTES = 8 * HTB, NXCD = 8, WGM = 8;

__host__ __device__ __forceinline__ int lds_byte(int r, int c) { const int st = (r >> 4) * 2 + (c >> 5), rr = r & 15, cc = c & 31, ob = rr * 64 + cc * 2; return st * 1024 + (ob ^ (((ob >> 9) & 1) << 5)); }
__host__ __device__ __forceinline__ void stage_rc(int b, int& R, int& C) { const int st = b / 1024, sb = b % 1024, swz = sb ^ (((sb >> 9) & 1) << 5); R = (st >> 1) * 16 + swz / 64; C = (st & 1) * 32 + (swz % 64) / 2; }
__host__ __device__ __forceinline__ int perm32(int rho) { const int n = rho >> 4, i = rho & 15; return 8 * (i >> 2) + 4 * n + (i & 3); }

struct Unit { int pm, pn; };
struct Gemm { const bf16_t* A; const bf16_t* Bt; int M, N, K; };

struct StaticOrder {
    int nM, nN, nwg, G, c;
    __host__ __device__ void init(int M, int N, int G_, int c_) { nM = M / BM; nN = N / BM; nwg = nM * nN; G = G_; c = c_; }
    __host__ __device__ bool next(int i, Unit& u) const {
        const long L = (long)i * G + c; if (L >= nwg) return false;
        int wgid = (int)L; { const int q = nwg / NXCD, r = nwg % NXCD, xcd = wgid % NXCD, off = wgid / NXCD; wgid = (xcd < r ? xcd * (q + 1) : r * (q + 1) + (xcd - r) * q) + off; }
        const int nig = WGM * nN, gid = wgid / nig, fm = gid * WGM, gsz = (nM - fm) < WGM ? (nM - fm) : WGM;
        u.pm = fm + ((wgid % nig) % gsz); u.pn = (wgid % nig) / gsz; return true;
    }
    __device__ __forceinline__ void a_ready(const Unit&) const {}
    __device__ __forceinline__ void done(const Unit&) const {}
};
__device__ __forceinline__ unsigned cvt_pk_bf16(float lo, float hi) { unsigned r; asm volatile("v_cvt_pk_bf16_f32 %0, %1, %2" : "=v"(r) : "v"(lo), "v"(hi)); return r; }
typedef float f32x2 __attribute__((ext_vector_type(2)));
__device__ __forceinline__ f32x2 gelu_pk(f32x2 v) {
    const f32x2 av = __builtin_elementwise_abs(v), d = av * 0.2316418882f + 1.0f;
    f32x2 t; t.x = __builtin_amdgcn_rcpf(d.x); t.y = __builtin_amdgcn_rcpf(d.y);
    f32x2 q = t * 0.5307027145f + (-0.7265760135f); q = q * t + 0.7107068705f; q = q * t + (-0.142248368f); q = q * t + 0.127414796f; q = q * t;
    const f32x2 s = (v * v) * (-0.72134752044f);
    f32x2 e; e.x = __builtin_amdgcn_exp2f(s.x); e.y = __builtin_amdgcn_exp2f(s.y);
    const f32x2 m = v * (q * e), r = v - m;
    f32x2 o; o.x = v.x < 0.f ? m.x : r.x; o.y = v.y < 0.f ? m.y : r.y; return o;
}

struct EpiF32 {
    static constexpr bool PERM = false, AFTER_DRAIN = false;
    float* C; int ldc; const float* bias;
    __device__ __forceinline__ void operator()(const f32x4 (&acc)[2][2][4][2], const Unit& u, int wr, int wc, int fr, int fq) const {
        const int row0 = u.pm * BM + wr * 64 + fr, col0 = u.pn * BM + wc * 32 + 4 * fq;
        f32x4 bv[2][2];
#pragma unroll
        for (int bj = 0; bj < 2; ++bj)
#pragma unroll
            for (int n = 0; n < 2; ++n) bv[bj][n] = bias ? *(const f32x4*)(bias + col0 + bj * HALF + n * 16) : (f32x4){0.f, 0.f, 0.f, 0.f};
#pragma unroll
        for (int ai = 0; ai < 2; ++ai)
#pragma unroll
            for (int m = 0; m < 4; ++m) { float* rowp = C + (size_t)(row0 + ai * HALF + m * 16) * ldc + col0;
#pragma unroll
                for (int bj = 0; bj < 2; ++bj)
#pragma unroll
                    for (int n = 0; n < 2; ++n) *(f32x4*)(rowp + bj * HALF + n * 16) = acc[ai][bj][m][n] + bv[bj][n]; }
    }
};

template <class Epi, class Sched, bool STAMP = false>
__device__ __forceinline__ void gemm_phase(PG8_LAS unsigned char* lds, const Gemm g, const Sched& S, const Epi& E, unsigned long long* stamps) {
    int tid = threadIdx.x; asm volatile("" : "+v"(tid));
    const int wid = __builtin_amdgcn_readfirstlane(tid >> 6), lane = tid & 63, wr = wid >> 2, wc = wid & 3, fr = lane & 15, fq = lane >> 4;
    const int K = g.K, nt = K / BK;
    int ts_lo = 0, ts_hi = 0, nts = 0; const unsigned long long rt_entry = STAMP ? (unsigned long long)wall_clock64() : 0ull;
#define PG8_STAMP() do { if (STAMP && wid == 0 && nts < 64) { const unsigned long long _c = (unsigned long long)clock64(); \
        ts_lo = (lane == nts) ? (int)(unsigned)_c : ts_lo; ts_hi = (lane == nts) ? (int)(unsigned)(_c >> 32) : ts_hi; ++nts; } } while (0)
    PG8_STAMP();
    unsigned voffA[2], voffB[2];
#pragma unroll
    for (int i = 0; i < 2; ++i) { int R, C; stage_rc(tid * 16 + i * 8192, R, C); const int Rb = Epi::PERM ? ((R & ~31) + perm32(R & 31)) : R;
        voffA[i] = (unsigned)(R * K + C) * 2u; voffB[i] = (unsigned)(Rb * K + C) * 2u; }
    const size_t kstep = (size_t)(BK * 2);
    const size_t hstep = (size_t)HALF * K * 2;
    const size_t tstep = 2 * hstep;
    const unsigned ldsw = (unsigned)wid * 1024u;
    const int aoff = lds_byte(wr * 64 + fr, fq * 8), boff = lds_byte(wc * 32 + fr, fq * 8);
#define PG8_SA(b, h) (((b) * 2 + (h)) * HTB)
#define PG8_SB(b, h) ((4 + (b) * 2 + (h)) * HTB)
#define PG8_STAGE(bufoff, gbase, voff) do { _Pragma("unroll") for (int _i = 0; _i < 2; ++_i) \
        __builtin_amdgcn_global_load_lds((const unsigned*)((const char*)(gbase) + (voff)[_i]), (PG8_LAS unsigned*)(lds + (bufoff) + ldsw + _i * 8192), 16, 0, 0); } while (0)
#define PG8_LDA(dst, b, h) do { _Pragma("unroll") for (int m = 0; m < 4; ++m) _Pragma("unroll") for (int k = 0; k < 2; ++k) dst[m][k] = *(const PG8_LAS bf16x8*)(lds + PG8_SA(b, h) + aoff + m * 2048 + k * 1024); } while (0)
#define PG8_LDB(dst, b, h) do { _Pragma("unroll") for (int n = 0; n < 2; ++n) _Pragma("unroll") for (int k = 0; k < 2; ++k) dst[n][k] = *(const PG8_LAS bf16x8*)(lds + PG8_SB(b, h) + boff + n * 2048 + k * 1024); } while (0)
#define PG8_MMA(ai, bj, At, Bt) do { __builtin_amdgcn_s_setprio(1); _Pragma("unroll") for (int m = 0; m < 4; ++m) _Pragma("unroll") for (int n = 0; n < 2; ++n) _Pragma("unroll") for (int k = 0; k < 2; ++k) \
        acc[ai][bj][m][n] = __builtin_amdgcn_mfma_f32_16x16x32_bf16(Bt[n][k], At[m][k], acc[ai][bj][m][n], 0, 0, 0); __builtin_amdgcn_s_setprio(0); } while (0)
#define PG8_WAIT_V(n) asm volatile("s_waitcnt vmcnt(" #n ")" ::: "memory")
#define PG8_WAIT_L(n) asm volatile("s_waitcnt lgkmcnt(" #n ")" ::: "memory")
#define PG8_BAR __builtin_amdgcn_s_barrier()
#define PG8_SCHED __builtin_amdgcn_sched_barrier(0)
    Unit cur, nxt; int ui = 0;
    if (!S.next(0, cur)) return;
    f32x4 acc[2][2][4][2];
#pragma unroll
    for (int a = 0; a < 2; ++a)
#pragma unroll
        for (int b = 0; b < 2; ++b)
#pragma unroll
            for (int m = 0; m < 4; ++m)
#pragma unroll
                for (int n = 0; n < 2; ++n) acc[a][b][m][n] = (f32x4){0.f, 0.f, 0.f, 0.f};
    bf16x8 At[4][2], B0[2][2], B1[2][2];
    const char* cA = (const char*)g.A + (size_t)cur.pm * tstep; const char* cB = (const char*)g.Bt + (size_t)cur.pn * tstep;
    S.a_ready(cur);
    PG8_STAGE(PG8_SB(0, 0), cB, voffB); PG8_STAGE(PG8_SA(0, 0), cA, voffA); PG8_STAGE(PG8_SB(0, 1), cB + hstep, voffB); PG8_STAGE(PG8_SA(0, 1), cA + hstep, voffA);
    if (wr == 1) PG8_BAR;
    PG8_WAIT_V(4); PG8_BAR;
    PG8_STAGE(PG8_SB(1, 0), cB + kstep, voffB); PG8_STAGE(PG8_SA(1, 0), cA + kstep, voffA); PG8_STAGE(PG8_SB(1, 1), cB + hstep + kstep, voffB);
    PG8_WAIT_V(6); PG8_BAR;
    PG8_STAMP();
    for (;;) {
        const bool has_next = S.next(ui + 1, nxt);
        const char* nA = has_next ? (const char*)g.A + (size_t)nxt.pm * tstep : cA; const char* nB = has_next ? (const char*)g.Bt + (size_t)nxt.pn * tstep : cB;
        for (int t = 0; t < nt; t += 2) {
            const bool last = (t == nt - 2);
            const char* a1 = cA + (size_t)(t + 1) * kstep;
            const char* a2 = last ? nA : cA + (size_t)(t + 2) * kstep; const char* b2 = last ? nB : cB + (size_t)(t + 2) * kstep;
            const char* a3 = a2 + kstep; const char* b3 = b2 + kstep;
            if (last && has_next) S.a_ready(nxt);
            PG8_LDB(B0, 0, 0); PG8_SCHED; PG8_LDA(At, 0, 0); PG8_STAGE(PG8_SA(1, 1), a1 + hstep, voffA);
            PG8_WAIT_L(8); PG8_BAR; PG8_WAIT_L(0); PG8_MMA(0, 0, At, B0); PG8_BAR; PG8_SCHED;
            PG8_LDB(B1, 0, 1); PG8_STAGE(PG8_SB(0, 0), b2, voffB);
            PG8_BAR; PG8_WAIT_L(0); PG8_MMA(0, 1, At, B1); PG8_BAR;
            PG8_LDA(At, 0, 1); PG8_STAGE(PG8_SA(0, 0), a2, voffA);
            PG8_BAR; PG8_WAIT_L(0); PG8_MMA(1, 0, At, B0); PG8_BAR; PG8_SCHED;
            PG8_STAGE(PG8_SB(0, 1), b2 + hstep, voffB);
            PG8_WAIT_V(6); PG8_BAR; PG8_MMA(1, 1, At, B1); PG8_BAR;
            PG8_LDB(B0, 1, 0); PG8_SCHED; PG8_LDA(At, 1, 0); PG8_STAGE(PG8_SA(0, 1), a2 + hstep, voffA);
            PG8_WAIT_L(8); PG8_BAR; PG8_WAIT_L(0); PG8_MMA(0, 0, At, B0); PG8_BAR; PG8_SCHED;
            PG8_LDB(B1, 1, 1); PG8_STAGE(PG8_SB(1, 0), b3, voffB);
            PG8_BAR; PG8_WAIT_L(0); PG8_MMA(0, 1, At, B1); PG8_BAR;
            PG8_LDA(At, 1, 1); PG8_STAGE(PG8_SA(1, 0), a3, voffA);
            PG8_BAR; PG8_WAIT_L(0); PG8_MMA(1, 0, At, B0); PG8_BAR; PG8_SCHED;
            PG8_STAGE(PG8_SB(1, 1), b3 + hstep, voffB);
            PG8_WAIT_V(6); PG8_BAR; PG8_MMA(1, 1, At, B1); PG8_BAR;
        }
        PG8_STAMP();
        if constexpr (!Epi::AFTER_DRAIN) { E(acc, cur, wr, wc, fr, fq); S.done(cur); }
        PG8_STAMP();
        if (!has_next) break;
#pragma unroll
        for (int a = 0; a < 2; ++a)
#pragma unroll
            for (int b = 0; b < 2; ++b)
#pragma unroll
                for (int m = 0; m < 4; ++m)
#pragma unroll
                    for (int n = 0; n < 2; ++n) acc[a][b][m][n] = (f32x4){0.f, 0.f, 0.f, 0.f};
        cur = nxt; cA = nA; cB = nB; ++ui;
    }
    PG8_WAIT_V(0);
    if (wr == 0) PG8_BAR;
    PG8_BAR;
    if constexpr (Epi::AFTER_DRAIN) { E.fused(acc, cur, wr, wc, fr, fq, lds, wid, lane); S.done(cur); }
    PG8_STAMP();
    if (STAMP && wid == 0) { stamps[lane] = lane < nts ? (((unsigned long long)(unsigned)ts_hi << 32) | (unsigned)ts_lo) : 0ull;
        if (lane == 62) stamps[62] = rt_entry; if (lane == 63) stamps[63] = (unsigned long long)wall_clock64(); }
#undef PG8_STAMP
#undef PG8_SA
#undef PG8_SB
#undef PG8_STAGE
#undef PG8_LDA
#undef PG8_LDB
#undef PG8_MMA
#undef PG8_WAIT_V
#undef PG8_WAIT_L
#undef PG8_BAR
#undef PG8_SCHED
}
}


namespace pg8 {
struct EpiProj {
    static constexpr bool PERM = true, AFTER_DRAIN = false;
    bf16_t* O; float* dtraw;
    __device__ __forceinline__ void operator()(const f32x4 (&acc)[2][2][4][2], const Unit& u, int wr, int wc, int fr, int fq) const {
        const int row0 = u.pm * BM + wr * 64 + fr;
        if (u.pn < 22) {
            const int col0 = u.pn * BM + wc * 32 + 8 * fq;
#pragma unroll
            for (int ai = 0; ai < 2; ++ai)
#pragma unroll
                for (int m = 0; m < 4; ++m) { bf16_t* rowp = O + (size_t)(row0 + ai * HALF + m * 16) * 5632 + col0;
#pragma unroll
                    for (int bj = 0; bj < 2; ++bj) { const f32x4 v0 = acc[ai][bj][m][0], v1 = acc[ai][bj][m][1];
                        u32x4 w; w.x = cvt_pk_bf16(v0[0], v0[1]); w.y = cvt_pk_bf16(v0[2], v0[3]); w.z = cvt_pk_bf16(v1[0], v1[1]); w.w = cvt_pk_bf16(v1[2], v1[3]);
                        *(u32x4*)(rowp + bj * HALF) = w; } }
        } else if (wc == 0) {
#pragma unroll
            for (int ai = 0; ai < 2; ++ai)
#pragma unroll
                for (int m = 0; m < 4; ++m) { float* rp = dtraw + (size_t)(row0 + ai * HALF + m * 16) * 32 + 8 * fq;
                    *(f32x4*)rp = acc[ai][0][m][0]; *(f32x4*)(rp + 4) = acc[ai][0][m][1]; }
        }
    }
};
}


namespace pg8 {
struct EpiBf16Plain {
    static constexpr bool PERM = true, AFTER_DRAIN = false;
    bf16_t* O; int ldc;
    __device__ __forceinline__ void operator()(const f32x4 (&acc)[2][2][4][2], const Unit& u, int wr, int wc, int fr, int fq) const {
        const int row0 = u.pm * BM + wr * 64 + fr, col0 = u.pn * BM + wc * 32 + 8 * fq;
#pragma unroll
        for (int ai = 0; ai < 2; ++ai)
#pragma unroll
            for (int m = 0; m < 4; ++m) { bf16_t* rowp = O + (size_t)(row0 + ai * HALF + m * 16) * ldc + col0;
#pragma unroll
                for (int bj = 0; bj < 2; ++bj) { const f32x4 v0 = acc[ai][bj][m][0], v1 = acc[ai][bj][m][1];
                    u32x4 w; w.x = cvt_pk_bf16(v0[0], v0[1]); w.y = cvt_pk_bf16(v0[2], v0[3]); w.z = cvt_pk_bf16(v1[0], v1[1]); w.w = cvt_pk_bf16(v1[2], v1[3]);
                    *(u32x4*)(rowp + bj * HALF) = w; } }
    }
};
}

#define NTHR 512
#define NWAVE 8

__device__ __forceinline__ void ph_gemm_f32(float* lds, const float* __restrict__ A, const float* __restrict__ B, float* __restrict__ C,
                                            int M, int N, int K, int lda, int ldb, int ldc) {
    const int tid = threadIdx.x & 255, half = threadIdx.x >> 8, tx = tid & 15, ty = tid >> 4;
    float (*As)[68] = (float (*)[68])(lds + half * 2 * 16 * 68);
    float (*Bs)[68] = (float (*)[68])(lds + half * 2 * 16 * 68 + 16 * 68);
    const int ntx = (N + 63) / 64, nty = M / 64, ntiles = ntx * nty;
    for (int it = blockIdx.x; 2 * it < ntiles; it += gridDim.x) {
        const int tile = 2 * it + half;
        const int m0 = (tile / ntx) * 64, n0 = (tile % ntx) * 64;
        float acc[4][4];
#pragma unroll
        for (int i = 0; i < 4; ++i)
#pragma unroll
            for (int j = 0; j < 4; ++j) acc[i][j] = 0.f;
        for (int k0 = 0; k0 < K; k0 += 16) {
#pragma unroll
            for (int i = 0; i < 4; ++i) {
                int idx = tid + i * 256;
                int r = idx >> 4, c = idx & 15;
                As[c][r] = (m0 + r < M) ? A[(size_t)(m0 + r) * lda + k0 + c] : 0.f;
                int rb = idx >> 6, cb = idx & 63;
                Bs[rb][cb] = (n0 + cb < N) ? B[(size_t)(k0 + rb) * ldb + n0 + cb] : 0.f;
            }
            __syncthreads();
#pragma unroll
            for (int k = 0; k < 16; ++k) {
                float a[4], b[4];
#pragma unroll
                for (int i = 0; i < 4; ++i) { a[i] = As[k][ty * 4 + i]; b[i] = Bs[k][tx * 4 + i]; }
#pragma unroll
                for (int i = 0; i < 4; ++i)
#pragma unroll
                    for (int j = 0; j < 4; ++j) acc[i][j] += a[i] * b[j];
            }
            __syncthreads();
        }
#pragma unroll
        for (int i = 0; i < 4; ++i)
#pragma unroll
            for (int j = 0; j < 4; ++j) {
                int r = m0 + ty * 4 + i, c = n0 + tx * 4 + j;
                if (r < M && c < N) C[(size_t)r * ldc + c] = acc[i][j];
            }
    }
}


template <int MODE>
__device__ __forceinline__ void transpose_item(const float* __restrict__ W, int K, int N, int Npad, bf16* __restrict__ WT, LAS float* scr, int item, int lane) {
    const int nblk = Npad / 32, kb = item / nblk, nb = item % nblk, k0 = 64 * kb, n0 = 32 * nb;
    const int n = n0 + (lane & 31);
    int sc = n;
    if (MODE == 1) sc = (n < 4096) ? n : (n < 5632 ? n + 24 : (n < 5656 ? n - 5632 + 4096 : -1));
    else sc = (n < N) ? n : -1;
#pragma unroll 8
    for (int i = 0; i < 32; ++i) { const int kk = 2 * i + (lane >> 5); scr[kk * 33 + (lane & 31)] = (sc >= 0) ? W[(size_t)(k0 + kk) * N + sc] : 0.f; }
    LDS_WAIT(); asm volatile("" ::: "memory");
    const int c = lane & 7;
#pragma unroll
    for (int j = 0; j < 4; ++j) { const int nn = (lane >> 3) + 8 * j; const LAS float* s = scr + (8 * c) * 33 + nn;
        v4u o; o.x = pk2(s[0 * 33], s[1 * 33]); o.y = pk2(s[2 * 33], s[3 * 33]); o.z = pk2(s[4 * 33], s[5 * 33]); o.w = pk2(s[6 * 33], s[7 * 33]);
        *(v4u*)(WT + (size_t)(n0 + nn) * K + k0 + 8 * c) = o; }
    LDS_WAIT(); asm volatile("" ::: "memory");
}
__device__ __forceinline__ void ph_prologue(LAS unsigned char* ldsb, const float* __restrict__ xp, const float* __restrict__ xs, bf16* __restrict__ A0,
                                            const float* __restrict__ w_in, bf16* __restrict__ wt_in, float* __restrict__ rope_tab) {
    const int lane = threadIdx.x & 63, wave = threadIdx.x >> 6;
    LAS float* scr = (LAS float*)(ldsb + wave * 16384);
    const int gw = blockIdx.x * NWAVE + wave, NGW = gridDim.x * NWAVE;
    constexpr int I_IN = (D_MODEL / 64) * (PROJ_LD / 32);
    for (int it = gw; it < I_IN; it += NGW) transpose_item<1>(w_in, D_MODEL, IN_WIDTH, PROJ_LD, wt_in, scr, it, lane);
    for (int idx = blockIdx.x * NTHR + threadIdx.x; idx < SEQ * 32; idx += gridDim.x * NTHR) {
        const int pos = idx >> 5, j = idx & 31;
        const double rev = (double)pos * ROPE_INV_REV[j];
        const float fr = (float)(rev - floor(rev));
        rope_tab[(size_t)pos * 64 + j] = __builtin_amdgcn_cosf(fr); rope_tab[(size_t)pos * 64 + 32 + j] = __builtin_amdgcn_sinf(fr);
    }
    const size_t n8 = (size_t)T_ALL * D_MODEL / 8, np8 = (size_t)T_PROMPT * D_MODEL / 8;
#pragma unroll 4
    for (size_t i = (size_t)blockIdx.x * NTHR + threadIdx.x; i < n8; i += (size_t)gridDim.x * NTHR) {
        const float4* s = (i < np8) ? (const float4*)xp + 2 * i : (const float4*)xs + 2 * (i - np8);
        float4 a = s[0], b = s[1];
        v4u o; o.x = pk2(a.x, a.y); o.y = pk2(a.z, a.w); o.z = pk2(b.x, b.y); o.w = pk2(b.z, b.w);
        ((v4u*)A0)[i] = o;
    }
}
__device__ __forceinline__ void ph_prologue2(LAS unsigned char* ldsb, const float* __restrict__ w_out, bf16* __restrict__ wt_out, const float* __restrict__ w_q, bf16* __restrict__ wt_q,
                                             int rank, int nranks) {
    const int lane = threadIdx.x & 63, wave = threadIdx.x >> 6;
    LAS float* scr = (LAS float*)(ldsb + wave * 16384);
    constexpr int I_OUT = (MIX_WIDTH / 64) * (D_MODEL / 32), I_Q = (D_MODEL / 64) * (2048 / 32);
    for (int it = rank * NWAVE + wave; it < I_OUT + I_Q; it += nranks * NWAVE) {
        if (it < I_OUT) transpose_item<0>(w_out, MIX_WIDTH, D_MODEL, D_MODEL, wt_out, scr, it, lane);
        else transpose_item<0>(w_q, D_MODEL, 2048, 2048, wt_q, scr, it - I_OUT, lane);
    }
}

__device__ __forceinline__ void ph_concat_x(const float* __restrict__ xp, const float* __restrict__ xs, float* __restrict__ xall) {
    const size_t n4 = (size_t)T_ALL * D_MODEL / 4, np4 = (size_t)T_PROMPT * D_MODEL / 4;
    for (size_t i = (size_t)blockIdx.x * NTHR + threadIdx.x; i < n4; i += (size_t)gridDim.x * NTHR) {
        float4 v = (i < np4) ? ((const float4*)xp)[i] : ((const float4*)xs)[i - np4];
        ((float4*)xall)[i] = v;
    }
}

typedef float f32x4n __attribute__((ext_vector_type(4)));
__device__ __forceinline__ void ph_cache_copy(const float* __restrict__ ck, const float* __restrict__ cv, float* __restrict__ out) {
    constexpr unsigned PER_B = (WBUF - DEC_SEQ) * ATT_WIDTH / 4;
    constexpr unsigned TOTAL = 2u * DEC_BATCH * PER_B;
    for (unsigned c = blockIdx.x; c < TOTAL / 4096u; c += gridDim.x) {
        f32x4n v[8]; size_t dsti[8]; bool isv[8];
#pragma unroll
        for (int j = 0; j < 8; ++j) {
            const unsigned idx = c * 4096u + j * 512u + threadIdx.x;
            const unsigned tb = idx / PER_B, r = idx - tb * PER_B, bb = tb & (DEC_BATCH - 1);
            isv[j] = tb >= DEC_BATCH;
            const size_t srci = (size_t)bb * (WBUF * ATT_WIDTH / 4) + (DEC_SEQ * ATT_WIDTH / 4) + r;
            dsti[j] = (size_t)bb * (WBUF * ATT_WIDTH / 4) + r;
            v[j] = __builtin_nontemporal_load((isv[j] ? (const f32x4n*)cv : (const f32x4n*)ck) + srci);
        }
#pragma unroll
        for (int j = 0; j < 8; ++j) __builtin_nontemporal_store(v[j], (f32x4n*)(out + (isv[j] ? OUT_SV : OUT_SK)) + dsti[j]);
    }
}

__device__ __forceinline__ void ph_post_proj(const float* __restrict__ proj, const float* __restrict__ state_conv,
                                             const float* __restrict__ conv_w, const float* __restrict__ conv_b, const float* __restrict__ dt_bias,
                                             float* __restrict__ xbc_act, float* __restrict__ dtv, float* __restrict__ qrot, float* __restrict__ krot,
                                             float* __restrict__ out) {
    const int tid = threadIdx.x & 255, half = threadIdx.x >> 8;
    for (int t = 2 * blockIdx.x + half; t < T_ALL; t += 2 * gridDim.x) {
        const bool is_p = t < T_PROMPT;
        int b, i, pos;
        if (is_p) { b = t / SEQ; i = t % SEQ; pos = i; } else { int ts = t - T_PROMPT; b = ts / DEC_SEQ; i = ts % DEC_SEQ; pos = PAST_LEN + i; }
        const float* row = proj + (size_t)t * PROJ_LD;
        for (int c = tid; c < CONV_DIM; c += 256) {
            float acc = conv_b[c];
#pragma unroll
            for (int tap = 0; tap < 4; ++tap) {
                int r = i - 3 + tap;
                float val;
                if (r >= 0) val = proj[(size_t)(t - i + r) * PROJ_LD + O_XBC + c];
                else val = is_p ? 0.f : state_conv[((size_t)b * 3 + (3 + r)) * CONV_DIM + c];
                acc += val * conv_w[tap * CONV_DIM + c];
            }
            xbc_act[(size_t)t * CONV_DIM + c] = silu_f(acc);
        }
        if (tid < SSD_HEADS) dtv[(size_t)t * SSD_HEADS + tid] = softplus_f(row[O_DT + tid] + dt_bias[tid]);
        for (int idx = tid; idx < 512; idx += 256) {
            int which = idx >> 8, h = (idx >> 5) & 7, j = idx & 31;
            double rev = (double)pos * ROPE_INV_REV[j];
            float fr = (float)(rev - floor(rev));
            float sn = __builtin_amdgcn_sinf(fr), cs = __builtin_amdgcn_cosf(fr);
            const float* src = row + (which ? O_K : O_Q) + h * 64;
            float t1 = src[j], t2 = src[j + 32];
            float o1 = t1 * cs - t2 * sn, o2 = t2 * cs + t1 * sn;
            float* dst = (which ? krot : qrot) + (size_t)t * ATT_WIDTH + h * 64;
            dst[j] = o1; dst[j + 32] = o2;
            if (which) {
                if (is_p) { if (i >= SEQ - WBUF) { float* o = out + OUT_PK + ((size_t)b * WBUF + (i - (SEQ - WBUF))) * ATT_WIDTH + h * 64; o[j] = o1; o[j + 32] = o2; } }
                else { float* o = out + OUT_SK + ((size_t)b * WBUF + (WBUF - DEC_SEQ + i)) * ATT_WIDTH + h * 64; o[j] = o1; o[j + 32] = o2; }
            }
        }
        for (int c = tid; c < ATT_WIDTH; c += 256) {
            float v = row[O_V + c];
            if (is_p) { if (i >= SEQ - WBUF) out[OUT_PV + ((size_t)b * WBUF + (i - (SEQ - WBUF))) * ATT_WIDTH + c] = v; }
            else out[OUT_SV + ((size_t)b * WBUF + (WBUF - DEC_SEQ + i)) * ATT_WIDTH + c] = v;
        }
        if (is_p) {
            if (i >= SEQ - 3) { int r = i - (SEQ - 3); for (int c = tid; c < CONV_DIM; c += 256) out[OUT_PC + ((size_t)b * 3 + r) * CONV_DIM + c] = row[O_XBC + c]; }
        } else {
            if (i >= 1) { int r = i - 1; for (int c = tid; c < CONV_DIM; c += 256) out[OUT_SC + ((size_t)b * 3 + r) * CONV_DIM + c] = row[O_XBC + c]; }
        }
    }
}


#define NB_LD 5632
#define NB_XBC 1536
#define NB_Q 4096
#define NB_K 4608
#define NB_V 5120
__device__ __forceinline__ void unpack8(const v4u w, float (&f)[8]) {
    f[0] = __builtin_bit_cast(float, w.x << 16); f[1] = __builtin_bit_cast(float, w.x & 0xffff0000u);
    f[2] = __builtin_bit_cast(float, w.y << 16); f[3] = __builtin_bit_cast(float, w.y & 0xffff0000u);
    f[4] = __builtin_bit_cast(float, w.z << 16); f[5] = __builtin_bit_cast(float, w.z & 0xffff0000u);
    f[6] = __builtin_bit_cast(float, w.w << 16); f[7] = __builtin_bit_cast(float, w.w & 0xffff0000u);
}
__device__ __forceinline__ void store8f(float* d, const float (&f)[8]) { *(float4*)d = make_float4(f[0], f[1], f[2], f[3]); *(float4*)(d + 4) = make_float4(f[4], f[5], f[6], f[7]); }
__device__ __forceinline__ void ph_post_proj2(const bf16* __restrict__ projb, const float* __restrict__ dtraw, const float* __restrict__ state_conv,
                                              const float* __restrict__ conv_w, const float* __restrict__ conv_b, const float* __restrict__ dt_bias,
                                              bf16* __restrict__ xbc_b, float* __restrict__ dtv, bf16* __restrict__ qrot_b, bf16* __restrict__ krot_b,
                                              float* __restrict__ out) {
    const int tid = threadIdx.x & 255, half = threadIdx.x >> 8;
    for (int t = T_PROMPT + 2 * blockIdx.x + half; t < T_ALL; t += 2 * gridDim.x) {
        const bool is_p = t < T_PROMPT;
        int b, i, pos;
        if (is_p) { b = t / SEQ; i = t % SEQ; pos = i; } else { int ts = t - T_PROMPT; b = ts / DEC_SEQ; i = ts % DEC_SEQ; pos = PAST_LEN + i; }
        const bf16* row = projb + (size_t)t * NB_LD;
        if (tid < 64) {
            float f[8]; unpack8(*(const v4u*)(row + NB_V + tid * 8), f);
            if (is_p) { if (i >= SEQ - WBUF) store8f(out + OUT_PV + ((size_t)b * WBUF + (i - (SEQ - WBUF))) * ATT_WIDTH + tid * 8, f); }
            else store8f(out + OUT_SV + ((size_t)b * WBUF + (WBUF - DEC_SEQ + i)) * ATT_WIDTH + tid * 8, f);
        }
        for (int c8 = tid; c8 < 320; c8 += 256) {
            const int c = c8 * 8;
            float acc[8], cur[8];
            { const float4 b0 = *(const float4*)(conv_b + c), b1 = *(const float4*)(conv_b + c + 4);
              acc[0] = b0.x; acc[1] = b0.y; acc[2] = b0.z; acc[3] = b0.w; acc[4] = b1.x; acc[5] = b1.y; acc[6] = b1.z; acc[7] = b1.w; }
#pragma unroll
            for (int tap = 0; tap < 4; ++tap) {
                const int r = i - 3 + tap;
                float val[8];
                if (r >= 0) unpack8(*(const v4u*)(projb + (size_t)(t - i + r) * NB_LD + NB_XBC + c), val);
                else if (!is_p) { const float* sp = state_conv + ((size_t)b * 3 + (3 + r)) * CONV_DIM + c; const float4 s0 = *(const float4*)sp, s1 = *(const float4*)(sp + 4);
                    val[0] = s0.x; val[1] = s0.y; val[2] = s0.z; val[3] = s0.w; val[4] = s1.x; val[5] = s1.y; val[6] = s1.z; val[7] = s1.w; }
                else {
#pragma unroll
                    for (int j = 0; j < 8; ++j) val[j] = 0.f; }
                const float4 w0 = *(const float4*)(conv_w + tap * CONV_DIM + c), w1 = *(const float4*)(conv_w + tap * CONV_DIM + c + 4);
                acc[0] += val[0] * w0.x; acc[1] += val[1] * w0.y; acc[2] += val[2] * w0.z; acc[3] += val[3] * w0.w;
                acc[4] += val[4] * w1.x; acc[5] += val[5] * w1.y; acc[6] += val[6] * w1.z; acc[7] += val[7] * w1.w;
                if (tap == 3) {
#pragma unroll
                    for (int j = 0; j < 8; ++j) cur[j] = val[j]; }
            }
#pragma unroll
            for (int j = 0; j < 8; ++j) acc[j] = silu_f(acc[j]);
            v4u o; o.x = pk2(acc[0], acc[1]); o.y = pk2(acc[2], acc[3]); o.z = pk2(acc[4], acc[5]); o.w = pk2(acc[6], acc[7]);
            *(v4u*)(xbc_b + (size_t)t * CONV_DIM + c) = o;
            if (is_p) { if (i >= SEQ - 3) store8f(out + OUT_PC + ((size_t)b * 3 + (i - (SEQ - 3))) * CONV_DIM + c, cur); }
            else { if (i >= 1) store8f(out + OUT_SC + ((size_t)b * 3 + (i - 1)) * CONV_DIM + c, cur); }
        }
        if (tid < SSD_HEADS) dtv[(size_t)t * SSD_HEADS + tid] = softplus_f(dtraw[(size_t)t * 32 + tid] + dt_bias[tid]);
        if (tid < 128) {
            const int which = tid >> 6, h = (tid >> 3) & 7, jc = tid & 7;
            const bf16* src = row + (which ? NB_K : NB_Q) + h * 64 + jc * 4;
            const uint2 lo = *(const uint2*)src, hi = *(const uint2*)(src + 32);
            float t1[4], t2[4], o1[4], o2[4];
            t1[0] = __builtin_bit_cast(float, lo.x << 16); t1[1] = __builtin_bit_cast(float, lo.x & 0xffff0000u); t1[2] = __builtin_bit_cast(float, lo.y << 16); t1[3] = __builtin_bit_cast(float, lo.y & 0xffff0000u);
            t2[0] = __builtin_bit_cast(float, hi.x << 16); t2[1] = __builtin_bit_cast(float, hi.x & 0xffff0000u); t2[2] = __builtin_bit_cast(float, hi.y << 16); t2[3] = __builtin_bit_cast(float, hi.y & 0xffff0000u);
#pragma unroll
            for (int e = 0; e < 4; ++e) {
                const double rev = (double)pos * ROPE_INV_REV[jc * 4 + e];
                const float fr = (float)(rev - floor(rev));
                const float sn = __builtin_amdgcn_sinf(fr), cs = __builtin_amdgcn_cosf(fr);
                o1[e] = t1[e] * cs - t2[e] * sn; o2[e] = t2[e] * cs + t1[e] * sn;
            }
            const size_t doff = (size_t)t * ATT_WIDTH + h * 64 + jc * 4;
            bf16* db = which ? krot_b : qrot_b;
            *(uint2*)(db + doff) = make_uint2(pk2(o1[0], o1[1]), pk2(o1[2], o1[3])); *(uint2*)(db + doff + 32) = make_uint2(pk2(o2[0], o2[1]), pk2(o2[2], o2[3]));
            if (which) {
                float* o = nullptr;
                if (is_p) { if (i >= SEQ - WBUF) o = out + OUT_PK + ((size_t)b * WBUF + (i - (SEQ - WBUF))) * ATT_WIDTH + h * 64 + jc * 4; }
                else o = out + OUT_SK + ((size_t)b * WBUF + (WBUF - DEC_SEQ + i)) * ATT_WIDTH + h * 64 + jc * 4;
                if (o) { *(float4*)o = make_float4(o1[0], o1[1], o1[2], o1[3]); *(float4*)(o + 32) = make_float4(o2[0], o2[1], o2[2], o2[3]); }
            }
        }
    }
}


__device__ __forceinline__ void ph_post_proj_prompt(const bf16* __restrict__ projb, const float* __restrict__ dtraw, const float* __restrict__ conv_w, const float* __restrict__ conv_b,
                                                    const float* __restrict__ dt_bias, const float* __restrict__ rope_tab, bf16* __restrict__ xbc_b, float* __restrict__ dtv,
                                                    bf16* __restrict__ qrot_b, bf16* __restrict__ krot_b, float* __restrict__ out) {
    const int gtid = blockIdx.x * NTHR + threadIdx.x, gsz = gridDim.x * NTHR;
    for (int item = gtid; item < (T_PROMPT / 16) * 320; item += gsz) {
        const int run = item / 320, c = (item - run * 320) * 8, t0 = run * 16, i0 = t0 & (SEQ - 1), b = t0 >> 13;
        float w[4][8], bias[8];
#pragma unroll
        for (int tap = 0; tap < 4; ++tap) { const float4 w0 = *(const float4*)(conv_w + tap * CONV_DIM + c), w1 = *(const float4*)(conv_w + tap * CONV_DIM + c + 4);
            w[tap][0] = w0.x; w[tap][1] = w0.y; w[tap][2] = w0.z; w[tap][3] = w0.w; w[tap][4] = w1.x; w[tap][5] = w1.y; w[tap][6] = w1.z; w[tap][7] = w1.w; }
        { const float4 b0 = *(const float4*)(conv_b + c), b1 = *(const float4*)(conv_b + c + 4);
          bias[0] = b0.x; bias[1] = b0.y; bias[2] = b0.z; bias[3] = b0.w; bias[4] = b1.x; bias[5] = b1.y; bias[6] = b1.z; bias[7] = b1.w; }
        const bf16* src = projb + (size_t)t0 * NB_LD + NB_XBC + c;
        v4u raw[19];
#pragma unroll
        for (int s = 0; s < 19; ++s) { v4u z; z.x = 0u; z.y = 0u; z.z = 0u; z.w = 0u; raw[s] = (s >= 3 || i0 != 0) ? *(const v4u*)(src + (ptrdiff_t)(s - 3) * NB_LD) : z; }
        float p0[8], p1[8], p2[8];
        unpack8(raw[0], p0); unpack8(raw[1], p1); unpack8(raw[2], p2);
#pragma unroll
        for (int s = 0; s < 16; ++s) {
            float cur[8], acc[8]; unpack8(raw[s + 3], cur);
#pragma unroll
            for (int j = 0; j < 8; ++j) acc[j] = silu_f(bias[j] + p0[j] * w[0][j] + p1[j] * w[1][j] + p2[j] * w[2][j] + cur[j] * w[3][j]);
            v4u o; o.x = pk2(acc[0], acc[1]); o.y = pk2(acc[2], acc[3]); o.z = pk2(acc[4], acc[5]); o.w = pk2(acc[6], acc[7]);
            *(v4u*)(xbc_b + (size_t)(t0 + s) * CONV_DIM + c) = o;
            if (i0 + s >= SEQ - 3) store8f(out + OUT_PC + ((size_t)b * 3 + (i0 + s - (SEQ - 3))) * CONV_DIM + c, cur);
#pragma unroll
            for (int j = 0; j < 8; ++j) { p0[j] = p1[j]; p1[j] = p2[j]; p2[j] = cur[j]; }
        }
    }
#pragma unroll 4
    for (int item = gtid; item < T_PROMPT * 128; item += gsz) {
        const int t = item >> 7, sub = item & 127, which = sub >> 6, h = (sub >> 3) & 7, jc = sub & 7, i = t & (SEQ - 1), b = t >> 13;
        const bf16* src = projb + (size_t)t * NB_LD + (which ? NB_K : NB_Q) + h * 64 + jc * 4;
        const uint2 lo = *(const uint2*)src, hi = *(const uint2*)(src + 32);
        const float4 cs = *(const float4*)(rope_tab + (size_t)i * 64 + jc * 4), sn = *(const float4*)(rope_tab + (size_t)i * 64 + 32 + jc * 4);
        float t1[4], t2[4], o1[4], o2[4];
        t1[0] = __builtin_bit_cast(float, lo.x << 16); t1[1] = __builtin_bit_cast(float, lo.x & 0xffff0000u); t1[2] = __builtin_bit_cast(float, lo.y << 16); t1[3] = __builtin_bit_cast(float, lo.y & 0xffff0000u);
        t2[0] = __builtin_bit_cast(float, hi.x << 16); t2[1] = __builtin_bit_cast(float, hi.x & 0xffff0000u); t2[2] = __builtin_bit_cast(float, hi.y << 16); t2[3] = __builtin_bit_cast(float, hi.y & 0xffff0000u);
        const float cv[4] = {cs.x, cs.y, cs.z, cs.w}, sv[4] = {sn.x, sn.y, sn.z, sn.w};
#pragma unroll
        for (int e = 0; e < 4; ++e) { o1[e] = t1[e] * cv[e] - t2[e] * sv[e]; o2[e] = t2[e] * cv[e] + t1[e] * sv[e]; }
        const size_t doff = (size_t)t * ATT_WIDTH + h * 64 + jc * 4;
        bf16* db = which ? krot_b : qrot_b;
        *(uint2*)(db + doff) = make_uint2(pk2(o1[0], o1[1]), pk2(o1[2], o1[3])); *(uint2*)(db + doff + 32) = make_uint2(pk2(o2[0], o2[1]), pk2(o2[2], o2[3]));
        if (which && i >= SEQ - WBUF) {
            float* o = out + OUT_PK + ((size_t)b * WBUF + (i - (SEQ - WBUF))) * ATT_WIDTH + h * 64 + jc * 4;
            *(float4*)o = make_float4(o1[0], o1[1], o1[2], o1[3]); *(float4*)(o + 32) = make_float4(o2[0], o2[1], o2[2], o2[3]);
        }
    }
#pragma unroll 4
    for (int item = gtid; item < T_PROMPT * SSD_HEADS; item += gsz) { const int t = item / SSD_HEADS, hd = item - t * SSD_HEADS; dtv[item] = softplus_f(dtraw[(size_t)t * 32 + hd] + dt_bias[hd]); }
#pragma unroll 2
    for (int item = gtid; item < BATCH * WBUF * 64; item += gsz) {
        const int ch = item & 63, j = (item >> 6) & (WBUF - 1), b = item >> 17;
        float f[8]; unpack8(*(const v4u*)(projb + (size_t)(b * SEQ + (SEQ - WBUF) + j) * NB_LD + NB_V + ch * 8), f);
        store8f(out + OUT_PV + ((size_t)b * WBUF + j) * ATT_WIDTH + ch * 8, f);
    }
}

#define SSD_CH 32
__device__ __forceinline__ void ph_ssd_naive(float* lds, const bf16* __restrict__ xbc_act, const float* __restrict__ dtv, const float* __restrict__ a_log,
                                             const float* __restrict__ d_skip, const float* __restrict__ state_ssm, float* __restrict__ ybuf, float* __restrict__ out) {
    float (*sx)[64] = (float (*)[64])lds;
    float (*sB)[128] = (float (*)[128])(lds + SSD_CH * 64);
    float (*sC)[128] = (float (*)[128])(lds + SSD_CH * 64 + SSD_CH * 128);
    float* sdt = lds + SSD_CH * 64 + 2 * SSD_CH * 128;
    const int tid = threadIdx.x, p = tid >> 3, ng = tid & 7;
    for (int vb = BATCH * SSD_HEADS + blockIdx.x; vb < (BATCH + DEC_BATCH) * SSD_HEADS; vb += gridDim.x) {
        const int seq = vb / SSD_HEADS, h = vb % SSD_HEADS, g = h / 6;
        const bool is_p = seq < BATCH;
        const int L = is_p ? SEQ : DEC_SEQ;
        const int t0 = is_p ? seq * SEQ : T_PROMPT + (seq - BATCH) * DEC_SEQ;
        const float A = -__expf(a_log[h]);
        const float D = d_skip[h];
        float hs[16];
        if (is_p) {
#pragma unroll
            for (int j = 0; j < 16; ++j) hs[j] = 0.f;
        } else {
            const float* s0 = state_ssm + (((size_t)(seq - BATCH) * SSD_HEADS + h) * 64 + p) * 128 + ng * 16;
#pragma unroll
            for (int j = 0; j < 16; ++j) hs[j] = s0[j];
        }
        for (int c0 = 0; c0 < L; c0 += SSD_CH) {
            const int nst = (L - c0) < SSD_CH ? (L - c0) : SSD_CH;
            __syncthreads();
            for (int idx = tid; idx < nst * 64; idx += NTHR) { int s = idx >> 6, c = idx & 63; sx[s][c] = bf2f(xbc_act[(size_t)(t0 + c0 + s) * CONV_DIM + h * 64 + c]); }
            for (int idx = tid; idx < nst * 128; idx += NTHR) { int s = idx >> 7, c = idx & 127;
                sB[s][c] = bf2f(xbc_act[(size_t)(t0 + c0 + s) * CONV_DIM + 1536 + g * 128 + c]);
                sC[s][c] = bf2f(xbc_act[(size_t)(t0 + c0 + s) * CONV_DIM + 2048 + g * 128 + c]); }
            if (tid < nst) sdt[tid] = dtv[(size_t)(t0 + c0 + tid) * SSD_HEADS + h];
            __syncthreads();
            for (int s = 0; s < nst; ++s) {
                const float dt = sdt[s], x = sx[s][p];
                const float a = __expf(dt * A), xdt = x * dt;
                float y = 0.f;
#pragma unroll
                for (int j = 0; j < 16; ++j) { hs[j] = a * hs[j] + xdt * sB[s][ng * 16 + j]; y += sC[s][ng * 16 + j] * hs[j]; }
                y += __shfl_xor(y, 1); y += __shfl_xor(y, 2); y += __shfl_xor(y, 4);
                if (ng == 0) ybuf[(size_t)(t0 + c0 + s) * MIX_WIDTH + h * 64 + p] = y + D * x;
            }
        }
        float* so = is_p ? out + OUT_PS + (((size_t)seq * SSD_HEADS + h) * 64 + p) * 128 + ng * 16
                         : out + OUT_SS + (((size_t)(seq - BATCH) * SSD_HEADS + h) * 64 + p) * 128 + ng * 16;
#pragma unroll
        for (int j = 0; j < 16; ++j) so[j] = hs[j];
    }
}

__device__ __forceinline__ void ph_gate_norm(const bf16* __restrict__ projb, const float* __restrict__ norm_g, const float* __restrict__ ybuf, bf16* __restrict__ A1) {
    const int w = threadIdx.x >> 6, lane = threadIdx.x & 63, g = w & 3;
    for (int t = T_PROMPT + 2 * blockIdx.x + (w >> 2); t < T_ALL; t += 2 * gridDim.x) {
        float v[6]; float ss = 0.f;
#pragma unroll
        for (int j = 0; j < 6; ++j) {
            int c = g * 384 + j * 64 + lane;
            float y = ybuf[(size_t)t * MIX_WIDTH + c], z = bf2f(projb[(size_t)t * NB_LD + c]);
            v[j] = y * silu_f(z); ss += v[j] * v[j];
        }
        ss = wave_sum(ss);
        const float r = rsqrtf(ss * (1.0f / 384.0f) + LN_EPS);
#pragma unroll
        for (int j = 0; j < 6; ++j) { int c = g * 384 + j * 64 + lane; A1[(size_t)t * MIX_WIDTH + c] = (bf16)f2bf(v[j] * r * norm_g[c]); }
    }
}

__device__ __forceinline__ void ph_attn_naive(float* lds, const float* __restrict__ proj, const float* __restrict__ qrot, const float* __restrict__ krot,
                                              const float* __restrict__ ck, const float* __restrict__ cv, float* __restrict__ ybuf) {
    float (*sq)[64] = (float (*)[64])lds;
    const int w = threadIdx.x >> 6, lane = threadIdx.x & 63;
    for (int vb = blockIdx.x; vb < T_SAMPLE * 8 / NWAVE; vb += gridDim.x) {
        const int item = T_PROMPT * 8 + vb * NWAVE + w;
        const int t = item >> 3, h = item & 7;
        const bool is_p = t < T_PROMPT;
        int b, i;
        if (is_p) { b = t / SEQ; i = t % SEQ; } else { int ts = t - T_PROMPT; b = ts / DEC_SEQ; i = ts % DEC_SEQ; }
        __syncthreads();
        sq[w][lane] = qrot[(size_t)t * ATT_WIDTH + h * 64 + lane];
        __syncthreads();
        const int qi = is_p ? i : WBUF + i;
        float sc[3][3];
        float mx = -INFINITY;
#pragma unroll
        for (int pt = 0; pt < 3; ++pt) {
            const int d = pt == 0 ? 1 : (pt == 1 ? 4 : 16);
#pragma unroll
            for (int sl = 0; sl < 3; ++sl) {
                const int m = lane + sl * 64;
                float s = -INFINITY;
                const int kj = qi - d * m;
                if (m <= 128 && kj >= 0) {
                    const float* kr;
                    if (is_p) kr = krot + (size_t)(b * SEQ + kj) * ATT_WIDTH + h * 64;
                    else kr = (kj >= WBUF) ? krot + (size_t)(T_PROMPT + b * DEC_SEQ + (kj - WBUF)) * ATT_WIDTH + h * 64
                                           : ck + ((size_t)b * WBUF + kj) * ATT_WIDTH + h * 64;
                    float a = 0.f;
#pragma unroll
                    for (int c = 0; c < 64; c += 4) { float4 kv = *(const float4*)(kr + c); a += kv.x * sq[w][c] + kv.y * sq[w][c + 1] + kv.z * sq[w][c + 2] + kv.w * sq[w][c + 3]; }
                    s = a * 0.125f;
                }
                sc[pt][sl] = s; mx = fmaxf(mx, s);
            }
        }
        mx = wave_max(mx);
        float lsum = 0.f;
#pragma unroll
        for (int pt = 0; pt < 3; ++pt)
#pragma unroll
            for (int sl = 0; sl < 3; ++sl) { float pv = (sc[pt][sl] == -INFINITY) ? 0.f : __expf(sc[pt][sl] - mx); sc[pt][sl] = pv; lsum += pv; }
        lsum = wave_sum(lsum);
        float o = 0.f;
#pragma unroll
        for (int pt = 0; pt < 3; ++pt) {
            const int d = pt == 0 ? 1 : (pt == 1 ? 4 : 16);
#pragma unroll
            for (int sl = 0; sl < 3; ++sl) {
                const int mend = sl < 2 ? 64 : 1;
                for (int ml = 0; ml < mend; ++ml) {
                    const int m = ml + sl * 64;
                    const int kj = qi - d * m;
                    const float pv = __shfl(sc[pt][sl], ml);
                    if (kj < 0) continue;
                    const float* vr;
                    if (is_p) vr = proj + (size_t)(b * SEQ + kj) * PROJ_LD + O_V + h * 64;
                    else vr = (kj >= WBUF) ? proj + (size_t)(T_PROMPT + b * DEC_SEQ + (kj - WBUF)) * PROJ_LD + O_V + h * 64
                                           : cv + ((size_t)b * WBUF + kj) * ATT_WIDTH + h * 64;
                    o += pv * vr[lane];
                }
            }
        }
        ybuf[(size_t)t * MIX_WIDTH + SSD_WIDTH + h * 64 + lane] = o / lsum;
    }
}

__device__ __forceinline__ void ph_ln_res(const float* __restrict__ xp, const float* __restrict__ xs, const bf16* __restrict__ add, const float* __restrict__ gam,
                                          const float* __restrict__ bet, bf16* __restrict__ dstb) {
    const int lane = threadIdx.x & 63;
#pragma unroll 2
    for (int t = blockIdx.x * NWAVE + (threadIdx.x >> 6); t < T_ALL; t += gridDim.x * NWAVE) {
        const float* res = (t < T_PROMPT) ? xp + (size_t)t * D_MODEL : xs + (size_t)(t - T_PROMPT) * D_MODEL;
        float v[16]; float s = 0.f;
#pragma unroll
        for (int j = 0; j < 2; ++j) { const int c = j * 512 + lane * 8; const float4 r0 = *(const float4*)(res + c), r1 = *(const float4*)(res + c + 4);
            float a8[8]; unpack8(*(const v4u*)(add + (size_t)t * D_MODEL + c), a8);
            v[8 * j] = ALPHA_F * r0.x + a8[0]; v[8 * j + 1] = ALPHA_F * r0.y + a8[1]; v[8 * j + 2] = ALPHA_F * r0.z + a8[2]; v[8 * j + 3] = ALPHA_F * r0.w + a8[3];
            v[8 * j + 4] = ALPHA_F * r1.x + a8[4]; v[8 * j + 5] = ALPHA_F * r1.y + a8[5]; v[8 * j + 6] = ALPHA_F * r1.z + a8[6]; v[8 * j + 7] = ALPHA_F * r1.w + a8[7]; }
#pragma unroll
        for (int j = 0; j < 16; ++j) s += v[j];
        s = wave_sum(s);
        const float mu = s * (1.0f / 1024.0f);
        float q = 0.f;
#pragma unroll
        for (int j = 0; j < 16; ++j) { v[j] -= mu; q += v[j] * v[j]; }
        q = wave_sum(q);
        const float r = rsqrtf(q * (1.0f / 1024.0f) + LN_EPS);
#pragma unroll
        for (int j = 0; j < 2; ++j) { const int c = j * 512 + lane * 8; const float4 g0 = *(const float4*)(gam + c), g1 = *(const float4*)(gam + c + 4), b0 = *(const float4*)(bet + c), b1 = *(const float4*)(bet + c + 4);
            v4u o; o.x = pk2(v[8 * j] * r * g0.x + b0.x, v[8 * j + 1] * r * g0.y + b0.y); o.y = pk2(v[8 * j + 2] * r * g0.z + b0.z, v[8 * j + 3] * r * g0.w + b0.w);
            o.z = pk2(v[8 * j + 4] * r * g1.x + b1.x, v[8 * j + 5] * r * g1.y + b1.y); o.w = pk2(v[8 * j + 6] * r * g1.z + b1.z, v[8 * j + 7] * r * g1.w + b1.w);
            *(v4u*)(dstb + (size_t)t * D_MODEL + c) = o; }
    }
}

__device__ __forceinline__ void ph_peer_route(float* lds, const float* __restrict__ qh, const float* __restrict__ keys1, const float* __restrict__ keys2,
                                              int* __restrict__ eidx, float* __restrict__ gate) {
    float (*sq)[256] = (float (*)[256])lds;
    float (*sv)[2][16] = (float (*)[2][16])(lds + NWAVE * 256);
    int (*si)[2][16] = (int (*)[2][16])(lds + NWAVE * 256 + NWAVE * 32);
    const int w = threadIdx.x >> 6, lane = threadIdx.x & 63;
    for (int vb = blockIdx.x; vb < T_ALL * 8 / NWAVE; vb += gridDim.x) {
        const int item = vb * NWAVE + w;
        const int t = item >> 3, h = item & 7;
        __syncthreads();
        for (int c = lane; c < 256; c += 64) sq[w][c] = qh[(size_t)t * 2048 + h * 256 + c];
        __syncthreads();
#pragma unroll
        for (int half = 0; half < 2; ++half) {
            const float* keys = half ? keys2 : keys1;
            float s[2];
#pragma unroll
            for (int sl = 0; sl < 2; ++sl) {
                const float* kr = keys + (size_t)(lane + sl * 64) * 128;
                float a = 0.f;
#pragma unroll 8
                for (int c = 0; c < 128; c += 4) { float4 kv = *(const float4*)(kr + c); const float* qq = &sq[w][half * 128 + c]; a += kv.x * qq[0] + kv.y * qq[1] + kv.z * qq[2] + kv.w * qq[3]; }
                s[sl] = a;
            }
            for (int r = 0; r < 16; ++r) {
                float bv; int bi;
                if (s[0] >= s[1]) { bv = s[0]; bi = lane; } else { bv = s[1]; bi = lane + 64; }
#pragma unroll
                for (int o = 32; o > 0; o >>= 1) {
                    float ov = __shfl_xor(bv, o); int oi = __shfl_xor(bi, o);
                    if (ov > bv || (ov == bv && oi < bi)) { bv = ov; bi = oi; }
                }
                if (lane == 0) { sv[w][half][r] = bv; si[w][half][r] = bi; }
                if (bi == lane) s[0] = -INFINITY;
                if (bi == lane + 64) s[1] = -INFINITY;
            }
        }
        __syncthreads();
        float c[4];
#pragma unroll
        for (int j = 0; j < 4; ++j) { int ci = lane * 4 + j; c[j] = sv[w][0][ci >> 4] + sv[w][1][ci & 15]; }
        float myv = 0.f; int myc = 0;
        for (int r = 0; r < 16; ++r) {
            float bv = c[0]; int bi = lane * 4;
#pragma unroll
            for (int j = 1; j < 4; ++j) if (c[j] > bv) { bv = c[j]; bi = lane * 4 + j; }
#pragma unroll
            for (int o = 32; o > 0; o >>= 1) {
                float ov = __shfl_xor(bv, o); int oi = __shfl_xor(bi, o);
                if (ov > bv || (ov == bv && oi < bi)) { bv = ov; bi = oi; }
            }
            if (lane == r) { myv = bv; myc = bi; }
#pragma unroll
            for (int j = 0; j < 4; ++j) if (bi == lane * 4 + j) c[j] = -INFINITY;
        }
        float v = lane < 16 ? myv : -INFINITY;
        float mx = wave_max(v);
        float e = lane < 16 ? __expf(v - mx) : 0.f;
        float sum = wave_sum(e);
        if (lane < 16) {
            int ex = si[w][0][myc >> 4] * PEER_NKEYS + si[w][1][myc & 15];
            eidx[(size_t)t * 128 + h * 16 + lane] = ex;
            gate[(size_t)t * 128 + h * 16 + lane] = e / sum;
        }
    }
}

__device__ __forceinline__ void ph_peer_ffn(const float* __restrict__ hbuf, const int* __restrict__ eidx, const float* __restrict__ gate,
                                            const bf16* __restrict__ ub, const bf16* __restrict__ vb, const float* __restrict__ gam,
                                            const float* __restrict__ bet, float* __restrict__ out) {
    const int lane = threadIdx.x & 63;
    for (int t = blockIdx.x * NWAVE + (threadIdx.x >> 6); t < T_ALL; t += gridDim.x * NWAVE) {
        float x[16], acc[16];
        { const float* xr = hbuf + (size_t)t * D_MODEL + lane * 8;
          const float4 a = *(const float4*)xr, b = *(const float4*)(xr + 4), c = *(const float4*)(xr + 512), d = *(const float4*)(xr + 516);
          x[0] = a.x; x[1] = a.y; x[2] = a.z; x[3] = a.w; x[4] = b.x; x[5] = b.y; x[6] = b.z; x[7] = b.w;
          x[8] = c.x; x[9] = c.y; x[10] = c.z; x[11] = c.w; x[12] = d.x; x[13] = d.y; x[14] = d.z; x[15] = d.w; }
#pragma unroll
        for (int j = 0; j < 16; ++j) acc[j] = 0.f;
        for (int k = 0; k < 128; ++k) {
            const int e = eidx[(size_t)t * 128 + k];
            const float g = gate[(size_t)t * 128 + k];
            const bf16* ur = ub + (size_t)e * D_MODEL + lane * 8;
            float u0[8], u1[8];
            unpack8(*(const v4u*)ur, u0); unpack8(*(const v4u*)(ur + 512), u1);
            float d = 0.f;
#pragma unroll
            for (int j = 0; j < 8; ++j) d += u0[j] * x[j] + u1[j] * x[8 + j];
            d = wave_sum(d);
            const float wgt = g * gelu_f(d);
            const bf16* vr = vb + (size_t)e * D_MODEL + lane * 8;
            unpack8(*(const v4u*)vr, u0); unpack8(*(const v4u*)(vr + 512), u1);
#pragma unroll
            for (int j = 0; j < 8; ++j) { acc[j] += wgt * u0[j]; acc[8 + j] += wgt * u1[j]; }
        }
        float s = 0.f;
#pragma unroll
        for (int j = 0; j < 16; ++j) { acc[j] += ALPHA_F * x[j]; s += acc[j]; }
        s = wave_sum(s);
        const float mu = s * (1.0f / 1024.0f);
        float q = 0.f;
#pragma unroll
        for (int j = 0; j < 16; ++j) { acc[j] -= mu; q += acc[j] * acc[j]; }
        q = wave_sum(q);
        const float r = rsqrtf(q * (1.0f / 1024.0f) + LN_EPS);
        float* dst = ((t < T_PROMPT) ? out + OUT_YP + (size_t)t * D_MODEL : out + OUT_YS + (size_t)(t - T_PROMPT) * D_MODEL) + lane * 8;
#pragma unroll
        for (int q4 = 0; q4 < 4; ++q4) {
            const int eo = (q4 >> 1) * 512 + (q4 & 1) * 4;
            const float4 g4 = *(const float4*)(gam + lane * 8 + eo), b4 = *(const float4*)(bet + lane * 8 + eo);
            float4 o; o.x = acc[q4 * 4 + 0] * r * g4.x + b4.x; o.y = acc[q4 * 4 + 1] * r * g4.y + b4.y; o.z = acc[q4 * 4 + 2] * r * g4.z + b4.z; o.w = acc[q4 * 4 + 3] * r * g4.w + b4.w;
            *(float4*)(dst + eo) = o;
        }
    }
}

__device__ __forceinline__ float peer_dot16(const v4u a, const v4u b, const float (&x)[16]) {
    float u0[8], u1[8]; unpack8(a, u0); unpack8(b, u1);
    float d = 0.f;
#pragma unroll
    for (int j = 0; j < 8; ++j) d += u0[j] * x[j] + u1[j] * x[8 + j];
    return d;
}
#define PEER_TR_STEP(N, M) _Pragma("unroll") for (int i = 0; i < N; ++i) { const bool up = (lane & M) != 0; const float keep = up ? part[i + N] : part[i]; const float send = up ? part[i] : part[i + N]; part[i] = keep + __shfl_xor(send, M); }
__device__ __forceinline__ void ph_peer_ffn2(const float* __restrict__ hbuf, const int* __restrict__ eidx, const float* __restrict__ gate,
                                             const bf16* __restrict__ ub, const bf16* __restrict__ vb, const float* __restrict__ gam,
                                             const float* __restrict__ bet, float* __restrict__ out) {
    const int lane0 = threadIdx.x & 63;
    for (int t = blockIdx.x * NWAVE + (threadIdx.x >> 6); t < T_ALL; t += gridDim.x * NWAVE) {
        int lane = lane0; asm volatile("" : "+v"(lane));
        float x[16];
        { const float* xr = hbuf + (size_t)t * D_MODEL + lane * 8;
          const float4 a = *(const float4*)xr, b = *(const float4*)(xr + 4), c = *(const float4*)(xr + 512), d = *(const float4*)(xr + 516);
          x[0] = a.x; x[1] = a.y; x[2] = a.z; x[3] = a.w; x[4] = b.x; x[5] = b.y; x[6] = b.z; x[7] = b.w;
          x[8] = c.x; x[9] = c.y; x[10] = c.z; x[11] = c.w; x[12] = d.x; x[13] = d.y; x[14] = d.z; x[15] = d.w; }
        int ev[2]; float wv[4];
        ev[0] = eidx[(size_t)t * 128 + lane]; ev[1] = eidx[(size_t)t * 128 + 64 + lane];
#pragma unroll
        for (int rd = 0; rd < 4; ++rd) wv[rd] = gate[(size_t)t * 128 + rd * 32 + (lane >> 1)];
#pragma unroll
        for (int rd = 0; rd < 4; ++rd) {
            float part[32];
#pragma unroll
            for (int kb = 0; kb < 8; ++kb) {
                v4u ra[4], rb[4];
#pragma unroll
                for (int k8 = 0; k8 < 4; ++k8) {
                    const int e = __builtin_amdgcn_readlane(ev[rd >> 1], (rd & 1) * 32 + kb * 4 + k8);
                    const bf16* ur = ub + (size_t)e * D_MODEL + lane * 8;
                    ra[k8] = *(const v4u*)ur; rb[k8] = *(const v4u*)(ur + 512);
                }
#pragma unroll
                for (int k8 = 0; k8 < 4; ++k8) part[kb * 4 + k8] = peer_dot16(ra[k8], rb[k8], x);
            }
            PEER_TR_STEP(16, 32) PEER_TR_STEP(8, 16) PEER_TR_STEP(4, 8) PEER_TR_STEP(2, 4) PEER_TR_STEP(1, 2)
            const float hid = part[0] + __shfl_xor(part[0], 1);
            wv[rd] *= gelu_f(hid);
        }
        float acc[16];
#pragma unroll
        for (int j = 0; j < 16; ++j) acc[j] = 0.f;
#pragma unroll
        for (int rd = 0; rd < 4; ++rd) {
#pragma unroll
            for (int kb = 0; kb < 4; ++kb) {
                v4u ra[8], rb[8];
#pragma unroll
                for (int k8 = 0; k8 < 8; ++k8) {
                    const int e = __builtin_amdgcn_readlane(ev[rd >> 1], (rd & 1) * 32 + kb * 8 + k8);
                    const bf16* vr = vb + (size_t)e * D_MODEL + lane * 8;
                    ra[k8] = *(const v4u*)vr; rb[k8] = *(const v4u*)(vr + 512);
                }
#pragma unroll
                for (int k8 = 0; k8 < 8; ++k8) {
                    const float wk = __builtin_bit_cast(float, __builtin_amdgcn_readlane(__builtin_bit_cast(int, wv[rd]), 2 * (kb * 8 + k8)));
                    float u0[8], u1[8]; unpack8(ra[k8], u0); unpack8(rb[k8], u1);
#pragma unroll
                    for (int j = 0; j < 8; ++j) { acc[j] += wk * u0[j]; acc[8 + j] += wk * u1[j]; }
                }
            }
        }
        float s = 0.f;
#pragma unroll
        for (int j = 0; j < 16; ++j) { acc[j] += ALPHA_F * x[j]; s += acc[j]; }
        s = wave_sum(s);
        const float mu = s * (1.0f / 1024.0f);
        float q = 0.f;
#pragma unroll
        for (int j = 0; j < 16; ++j) { acc[j] -= mu; q += acc[j] * acc[j]; }
        q = wave_sum(q);
        const float r = rsqrtf(q * (1.0f / 1024.0f) + LN_EPS);
        float* dst = ((t < T_PROMPT) ? out + OUT_YP + (size_t)t * D_MODEL : out + OUT_YS + (size_t)(t - T_PROMPT) * D_MODEL) + lane * 8;
#pragma unroll
        for (int q4 = 0; q4 < 4; ++q4) {
            const int eo = (q4 >> 1) * 512 + (q4 & 1) * 4;
            const float4 g4 = *(const float4*)(gam + lane * 8 + eo), b4 = *(const float4*)(bet + lane * 8 + eo);
            float4 o; o.x = acc[q4 * 4 + 0] * r * g4.x + b4.x; o.y = acc[q4 * 4 + 1] * r * g4.y + b4.y; o.z = acc[q4 * 4 + 2] * r * g4.z + b4.z; o.w = acc[q4 * 4 + 3] * r * g4.w + b4.w;
            *(float4*)(dst + eo) = o;
        }
    }
}

__device__ __forceinline__ void ph_attn_sample(float* lds, const bf16* __restrict__ qrot_b, const bf16* __restrict__ krot_b, const bf16* __restrict__ projb,
                                               const float* __restrict__ ck, const float* __restrict__ cv, bf16* __restrict__ A1) {
    float (*sq)[64] = (float (*)[64])lds;
    const int w = threadIdx.x >> 6, lane0 = threadIdx.x & 63;
    for (int vb = blockIdx.x; vb < T_SAMPLE * 8 / NWAVE; vb += gridDim.x) {
        int lane = lane0; asm volatile("" : "+v"(lane));
        const int item = vb * NWAVE + w, ts = item >> 3, hd = item & 7, b = ts >> 2, i = ts & 3, t = T_PROMPT + ts;
        __syncthreads();
        sq[w][lane] = bf2f(qrot_b[(size_t)t * ATT_WIDTH + hd * 64 + lane]);
        __syncthreads();
        const int qi = WBUF + i;
        float sc[8];
        float mx = -INFINITY;
#pragma unroll
        for (int slot = 0; slot < 7; ++slot) {
            const int pt = slot < 6 ? (slot >> 1) : (lane < 3 ? lane : 0);
            const int m = slot < 6 ? lane + 64 * (slot & 1) : 128;
            const int kj = qi - (m << (2 * pt));
            const bool valid = (slot < 6 || lane < 3) && kj < WBUF;
            const int kc = kj < WBUF ? kj : WBUF - 1;
            const float* kr = ck + ((size_t)b * WBUF + kc) * ATT_WIDTH + hd * 64;
            float a = 0.f;
#pragma unroll
            for (int c = 0; c < 64; c += 4) { const float4 kv = *(const float4*)(kr + c); a += kv.x * sq[w][c] + kv.y * sq[w][c + 1] + kv.z * sq[w][c + 2] + kv.w * sq[w][c + 3]; }
            const float s = valid ? a * 0.125f : -INFINITY;
            sc[slot] = s; mx = fmaxf(mx, s);
        }
        const int nt7 = lane <= i ? i - lane : i;
        const bool valid7 = lane < i + 3;
        {
            const bf16* kr = krot_b + (size_t)(T_PROMPT + b * DEC_SEQ + nt7) * ATT_WIDTH + hd * 64;
            float a = 0.f;
#pragma unroll
            for (int c = 0; c < 64; c += 8) { float f[8]; unpack8(*(const v4u*)(kr + c), f);
#pragma unroll
                for (int j = 0; j < 8; ++j) a += f[j] * sq[w][c + j]; }
            const float s = valid7 ? a * 0.125f : -INFINITY;
            sc[7] = s; mx = fmaxf(mx, s);
        }
        mx = wave_max(mx);
        float lsum = 0.f;
#pragma unroll
        for (int slot = 0; slot < 8; ++slot) { const float pv = __expf(sc[slot] - mx); sc[slot] = pv; lsum += pv; }
        lsum = wave_sum(lsum);
        float part[64];
#pragma unroll
        for (int c = 0; c < 64; ++c) part[c] = 0.f;
#pragma unroll
        for (int slot = 0; slot < 7; ++slot) {
            const int pt = slot < 6 ? (slot >> 1) : (lane < 3 ? lane : 0);
            const int m = slot < 6 ? lane + 64 * (slot & 1) : 128;
            const int kj = qi - (m << (2 * pt));
            const int kc = kj < WBUF ? kj : WBUF - 1;
            const float pv = sc[slot];
            const float* vr = cv + ((size_t)b * WBUF + kc) * ATT_WIDTH + hd * 64;
#pragma unroll
            for (int c = 0; c < 64; c += 4) { const float4 vv = *(const float4*)(vr + c); part[c] += pv * vv.x; part[c + 1] += pv * vv.y; part[c + 2] += pv * vv.z; part[c + 3] += pv * vv.w; }
        }
        {
            const float pv = sc[7];
            const bf16* vr = projb + (size_t)(T_PROMPT + b * DEC_SEQ + nt7) * NB_LD + NB_V + hd * 64;
#pragma unroll
            for (int c = 0; c < 64; c += 8) { float f[8]; unpack8(*(const v4u*)(vr + c), f);
#pragma unroll
                for (int j = 0; j < 8; ++j) part[c + j] += pv * f[j]; }
        }
        PEER_TR_STEP(32, 32) PEER_TR_STEP(16, 16) PEER_TR_STEP(8, 8) PEER_TR_STEP(4, 4) PEER_TR_STEP(2, 2) PEER_TR_STEP(1, 1)
        A1[(size_t)t * MIX_WIDTH + SSD_WIDTH + hd * 64 + lane] = (bf16)f2bf(part[0] / lsum);
    }
}


__device__ __forceinline__ void cache_copy_slice(const float* __restrict__ ck, const float* __restrict__ cv, float* __restrict__ out, unsigned slice, unsigned lane) {
    constexpr unsigned PER_B = (WBUF - DEC_SEQ) * ATT_WIDTH / 4;
    constexpr unsigned TOTAL = 2u * DEC_BATCH * PER_B;
#pragma unroll 1
    for (unsigned bt = 0; bt < 8; ++bt) {
        f32x4n v[8]; size_t dsti[8]; bool isv[8]; bool ok[8];
#pragma unroll
        for (int j = 0; j < 8; ++j) {
            const unsigned idx = slice * 4096u + bt * 512u + j * 64u + lane;
            ok[j] = idx < TOTAL;
            const unsigned idc = ok[j] ? idx : 0u;
            const unsigned tb = idc / PER_B, r = idc - tb * PER_B, bb = tb & (DEC_BATCH - 1);
            isv[j] = tb >= DEC_BATCH;
            const size_t srci = (size_t)bb * (WBUF * ATT_WIDTH / 4) + (DEC_SEQ * ATT_WIDTH / 4) + r;
            dsti[j] = (size_t)bb * (WBUF * ATT_WIDTH / 4) + r;
            v[j] = __builtin_nontemporal_load((isv[j] ? (const f32x4n*)cv : (const f32x4n*)ck) + srci);
        }
#pragma unroll
        for (int j = 0; j < 8; ++j) if (ok[j]) __builtin_nontemporal_store(v[j], (f32x4n*)(out + (isv[j] ? OUT_SV : OUT_SK)) + dsti[j]);
    }
}

__device__ __forceinline__ void copy_q_load(const float* __restrict__ ck, const float* __restrict__ cv, unsigned q, unsigned lane, f32x4n (&v)[16]) {
    constexpr unsigned PER_B = (WBUF - DEC_SEQ) * ATT_WIDTH / 4, TOTAL = 2u * DEC_BATCH * PER_B;
#pragma unroll
    for (int j = 0; j < 16; ++j) {
        const unsigned idx = q * 1024u + j * 64u + lane, idc = idx < TOTAL ? idx : 0u;
        const unsigned tb = idc / PER_B, r = idc - tb * PER_B, bb = tb & (DEC_BATCH - 1);
        const size_t srci = (size_t)bb * (WBUF * ATT_WIDTH / 4) + (DEC_SEQ * ATT_WIDTH / 4) + r;
        v[j] = __builtin_nontemporal_load((tb >= DEC_BATCH ? (const f32x4n*)cv : (const f32x4n*)ck) + srci);
    }
}
__device__ __forceinline__ void copy_q_store(float* __restrict__ out, unsigned q, unsigned lane, const f32x4n (&v)[16]) {
    constexpr unsigned PER_B = (WBUF - DEC_SEQ) * ATT_WIDTH / 4, TOTAL = 2u * DEC_BATCH * PER_B;
#pragma unroll
    for (int j = 0; j < 16; ++j) {
        const unsigned idx = q * 1024u + j * 64u + lane;
        if (idx < TOTAL) {
            const unsigned tb = idx / PER_B, r = idx - tb * PER_B, bb = tb & (DEC_BATCH - 1);
            const size_t dsti = (size_t)bb * (WBUF * ATT_WIDTH / 4) + r;
            __builtin_nontemporal_store(v[j], (f32x4n*)(out + (tb >= DEC_BATCH ? OUT_SV : OUT_SK)) + dsti);
        }
    }
}
typedef float f32x2v __attribute__((ext_vector_type(2)));
__device__ __forceinline__ void ph_quant_tables(const float* __restrict__ pu, const float* __restrict__ pv, unsigned char* __restrict__ ub8, unsigned char* __restrict__ vb8,
                                                float* __restrict__ usc, float* __restrict__ vsc, int rank, int nranks) {
    const int lane = threadIdx.x & 63;
#pragma unroll 2
    for (int row = rank * NWAVE + (threadIdx.x >> 6); row < 2 * 16384; row += nranks * NWAVE) {
        const int rr = row & 16383; const bool isv = row >= 16384;
        const float* src = (isv ? pv : pu) + (size_t)rr * D_MODEL + lane * 8;
        const float4 a = *(const float4*)src, b = *(const float4*)(src + 4), c = *(const float4*)(src + 512), d = *(const float4*)(src + 516);
        float am = fmaxf(fmaxf(fmaxf(fabsf(a.x), fabsf(a.y)), fmaxf(fabsf(a.z), fabsf(a.w))), fmaxf(fmaxf(fabsf(b.x), fabsf(b.y)), fmaxf(fabsf(b.z), fabsf(b.w))));
        am = fmaxf(am, fmaxf(fmaxf(fmaxf(fabsf(c.x), fabsf(c.y)), fmaxf(fabsf(c.z), fabsf(c.w))), fmaxf(fmaxf(fabsf(d.x), fabsf(d.y)), fmaxf(fabsf(d.z), fabsf(d.w)))));
        am = wave_max(am);
        const float sc = am > 0.f ? 224.0f / am : 1.0f;
        v4u o;
        o.x = (unsigned)__builtin_amdgcn_cvt_pk_fp8_f32(a.z * sc, a.w * sc, __builtin_amdgcn_cvt_pk_fp8_f32(a.x * sc, a.y * sc, 0, false), true);
        o.y = (unsigned)__builtin_amdgcn_cvt_pk_fp8_f32(b.z * sc, b.w * sc, __builtin_amdgcn_cvt_pk_fp8_f32(b.x * sc, b.y * sc, 0, false), true);
        o.z = (unsigned)__builtin_amdgcn_cvt_pk_fp8_f32(c.z * sc, c.w * sc, __builtin_amdgcn_cvt_pk_fp8_f32(c.x * sc, c.y * sc, 0, false), true);
        o.w = (unsigned)__builtin_amdgcn_cvt_pk_fp8_f32(d.z * sc, d.w * sc, __builtin_amdgcn_cvt_pk_fp8_f32(d.x * sc, d.y * sc, 0, false), true);
        *(v4u*)((isv ? vb8 : ub8) + (size_t)rr * 1024 + lane * 16) = o;
        if (lane == 0) (isv ? vsc : usc)[rr] = am > 0.f ? am * (1.0f / 224.0f) : 1.0f;
    }
}
__device__ __forceinline__ void unpack16_fp8(const v4u w, float (&f)[16]) {
#pragma unroll
    for (int i = 0; i < 4; ++i) {
        const f32x2v lo = __builtin_amdgcn_cvt_pk_f32_fp8((int)w[i], false), hi = __builtin_amdgcn_cvt_pk_f32_fp8((int)w[i], true);
        f[4 * i] = lo[0]; f[4 * i + 1] = lo[1]; f[4 * i + 2] = hi[0]; f[4 * i + 3] = hi[1];
    }
}
__device__ __forceinline__ void ph_peer_ffn3(const bf16* __restrict__ hb, const int* __restrict__ eidx, const float* __restrict__ gate,
                                             const unsigned char* __restrict__ ub8, const unsigned char* __restrict__ vb8, const float* __restrict__ usc, const float* __restrict__ vsc,
                                             const float* __restrict__ gam, const float* __restrict__ bet, float* __restrict__ out,
                                             const float* __restrict__ ck, const float* __restrict__ cv, unsigned n9) {
    const int lane0 = threadIdx.x & 63;
    unsigned it = 0;
    for (int t = blockIdx.x * NWAVE + (threadIdx.x >> 6); t < T_ALL; t += gridDim.x * NWAVE, ++it) {
        int lane = lane0; asm volatile("" : "+v"(lane));
        { const unsigned sl = n9 + (blockIdx.x * NWAVE + (threadIdx.x >> 6)) + it * (gridDim.x * NWAVE); if (sl < 16384u) cache_copy_slice(ck, cv, out, sl, (unsigned)lane); }
        const unsigned lo16 = (unsigned)lane * 16u, lo8 = (unsigned)lane * 8u;
        float x[16];
        { float f0[8], f1[8]; const bf16* xr = hb + (size_t)t * D_MODEL + lo8; unpack8(*(const v4u*)xr, f0); unpack8(*(const v4u*)(xr + 512), f1);
#pragma unroll
          for (int j = 0; j < 8; ++j) { x[j] = f0[j]; x[8 + j] = f1[j]; } }
        int ev[2]; float wv[4], su[4];
        ev[0] = eidx[(size_t)t * 128 + lane]; ev[1] = eidx[(size_t)t * 128 + 64 + lane];
#pragma unroll
        for (int rd = 0; rd < 4; ++rd) {
            const int er = eidx[(size_t)t * 128 + rd * 32 + (lane >> 1)];
            wv[rd] = gate[(size_t)t * 128 + rd * 32 + (lane >> 1)] * vsc[er];
            su[rd] = usc[er];
        }
#pragma unroll
        for (int rd = 0; rd < 4; ++rd) {
            float part[32];
#pragma unroll
            for (int kb = 0; kb < 8; ++kb) {
                v4u ra[4];
#pragma unroll
                for (int k8 = 0; k8 < 4; ++k8) {
                    const int e = __builtin_amdgcn_readlane(ev[rd >> 1], (rd & 1) * 32 + kb * 4 + k8);
                    ra[k8] = *(const v4u*)(ub8 + (size_t)e * 1024 + lo16);
                }
#pragma unroll
                for (int k8 = 0; k8 < 4; ++k8) {
                    f32x2v dv = {0.f, 0.f};
#pragma unroll
                    for (int i = 0; i < 4; ++i) {
                        const f32x2v lo = __builtin_amdgcn_cvt_pk_f32_fp8((int)ra[k8][i], false), hi = __builtin_amdgcn_cvt_pk_f32_fp8((int)ra[k8][i], true);
                        dv += lo * (f32x2v){x[4 * i], x[4 * i + 1]}; dv += hi * (f32x2v){x[4 * i + 2], x[4 * i + 3]};
                    }
                    part[kb * 4 + k8] = dv[0] + dv[1];
                    if (k8 & 1) __builtin_amdgcn_sched_barrier(0);
                }
            }
            PEER_TR_STEP(16, 32) PEER_TR_STEP(8, 16) PEER_TR_STEP(4, 8) PEER_TR_STEP(2, 4) PEER_TR_STEP(1, 2)
            const float hid = (part[0] + __shfl_xor(part[0], 1)) * su[rd];
            wv[rd] *= gelu_f(hid);
        }
        float acc[16];
#pragma unroll
        for (int j = 0; j < 16; ++j) acc[j] = 0.f;
#pragma unroll
        for (int rd = 0; rd < 4; ++rd) {
#pragma unroll
            for (int kb = 0; kb < 4; ++kb) {
                v4u ra[8];
#pragma unroll
                for (int k8 = 0; k8 < 8; ++k8) {
                    const int e = __builtin_amdgcn_readlane(ev[rd >> 1], (rd & 1) * 32 + kb * 8 + k8);
                    ra[k8] = *(const v4u*)(vb8 + (size_t)e * 1024 + lo16);
                }
#pragma unroll
                for (int k8 = 0; k8 < 8; ++k8) {
                    const float wk = __builtin_bit_cast(float, __builtin_amdgcn_readlane(__builtin_bit_cast(int, wv[rd]), 2 * (kb * 8 + k8)));
                    float f[16]; unpack16_fp8(ra[k8], f);
#pragma unroll
                    for (int j = 0; j < 16; ++j) acc[j] += wk * f[j];
                    if (k8 & 1) __builtin_amdgcn_sched_barrier(0);
                }
            }
        }
        float s = 0.f;
#pragma unroll
        for (int j = 0; j < 16; ++j) { acc[j] += ALPHA_F * x[j]; s += acc[j]; }
        s = wave_sum(s);
        const float mu = s * (1.0f / 1024.0f);
        float q = 0.f;
#pragma unroll
        for (int j = 0; j < 16; ++j) { acc[j] -= mu; q += acc[j] * acc[j]; }
        q = wave_sum(q);
        const float r = rsqrtf(q * (1.0f / 1024.0f) + LN_EPS);
        float* dst = ((t < T_PROMPT) ? out + OUT_YP + (size_t)t * D_MODEL : out + OUT_YS + (size_t)(t - T_PROMPT) * D_MODEL) + lo8;
#pragma unroll
        for (int q4 = 0; q4 < 4; ++q4) {
            const int eo = (q4 >> 1) * 512 + (q4 & 1) * 4;
            const float4 g4 = *(const float4*)(gam + lo8 + eo), b4 = *(const float4*)(bet + lo8 + eo);
            float4 o; o.x = acc[q4 * 4 + 0] * r * g4.x + b4.x; o.y = acc[q4 * 4 + 1] * r * g4.y + b4.y; o.z = acc[q4 * 4 + 2] * r * g4.z + b4.z; o.w = acc[q4 * 4 + 3] * r * g4.w + b4.w;
            *(float4*)(dst + eo) = o;
        }
    }
    for (;; ++it) {
        const unsigned sl = n9 + (blockIdx.x * NWAVE + (threadIdx.x >> 6)) + it * (gridDim.x * NWAVE);
        if (sl >= 16384u) break;
        cache_copy_slice(ck, cv, out, sl, (unsigned)lane0);
    }
}


__device__ __forceinline__ void ssd_decode_load(const bf16* __restrict__ xbc_b, const float* __restrict__ dtv, const float* __restrict__ state_ssm, int item, int p, int ng,
                                                float (&hs)[16], v4u (&bq)[4][2], v4u (&cq)[4][2], float (&xv)[4], float (&dv)[4]) {
    const int sb = item / SSD_HEADS, h = item - sb * SSD_HEADS, g = h / 6, t0 = T_PROMPT + sb * DEC_SEQ;
    const float* s0 = state_ssm + (((size_t)sb * SSD_HEADS + h) * 64 + p) * 128 + ng * 16;
#pragma unroll
    for (int j = 0; j < 4; ++j) { const float4 v = *(const float4*)(s0 + 4 * j); hs[4 * j] = v.x; hs[4 * j + 1] = v.y; hs[4 * j + 2] = v.z; hs[4 * j + 3] = v.w; }
#pragma unroll
    for (int s = 0; s < 4; ++s) {
        const bf16* row = xbc_b + (size_t)(t0 + s) * CONV_DIM;
        bq[s][0] = *(const v4u*)(row + 1536 + g * 128 + ng * 16); bq[s][1] = *(const v4u*)(row + 1536 + g * 128 + ng * 16 + 8);
        cq[s][0] = *(const v4u*)(row + 2048 + g * 128 + ng * 16); cq[s][1] = *(const v4u*)(row + 2048 + g * 128 + ng * 16 + 8);
        xv[s] = bf2f(row[h * 64 + p]); dv[s] = dtv[(size_t)(t0 + s) * SSD_HEADS + h];
    }
}
__device__ __forceinline__ void ssd_decode_compute(const float* __restrict__ a_log, const float* __restrict__ d_skip, int item, int p, int ng,
                                                   float (&hs)[16], const v4u (&bq)[4][2], const v4u (&cq)[4][2], const float (&xv)[4], const float (&dv)[4],
                                                   float* __restrict__ ybuf, float* __restrict__ out) {
    const int sb = item / SSD_HEADS, h = item - sb * SSD_HEADS, t0 = T_PROMPT + sb * DEC_SEQ;
    const float A = -__expf(a_log[h]), D = d_skip[h];
#pragma unroll
    for (int s = 0; s < 4; ++s) {
        float Bf[16], Cf[16];
        { float t8[8]; unpack8(bq[s][0], t8);
#pragma unroll
          for (int j = 0; j < 8; ++j) Bf[j] = t8[j];
          unpack8(bq[s][1], t8);
#pragma unroll
          for (int j = 0; j < 8; ++j) Bf[8 + j] = t8[j];
          unpack8(cq[s][0], t8);
#pragma unroll
          for (int j = 0; j < 8; ++j) Cf[j] = t8[j];
          unpack8(cq[s][1], t8);
#pragma unroll
          for (int j = 0; j < 8; ++j) Cf[8 + j] = t8[j]; }
        const float a = __expf(dv[s] * A), xdt = xv[s] * dv[s];
        float y = 0.f;
#pragma unroll
        for (int j = 0; j < 16; ++j) { hs[j] = a * hs[j] + xdt * Bf[j]; y += Cf[j] * hs[j]; }
        y += __shfl_xor(y, 1); y += __shfl_xor(y, 2); y += __shfl_xor(y, 4);
        if (ng == 0) ybuf[(size_t)(t0 + s) * MIX_WIDTH + h * 64 + p] = y + D * xv[s];
    }
    float* so = out + OUT_SS + (((size_t)sb * SSD_HEADS + h) * 64 + p) * 128 + ng * 16;
#pragma unroll
    for (int j = 0; j < 4; ++j) *(float4*)(so + 4 * j) = make_float4(hs[4 * j], hs[4 * j + 1], hs[4 * j + 2], hs[4 * j + 3]);
}
__device__ __forceinline__ void ph_ssd_decode(const bf16* __restrict__ xbc_b, const float* __restrict__ dtv, const float* __restrict__ a_log, const float* __restrict__ d_skip,
                                              const float* __restrict__ state_ssm, float* __restrict__ ybuf, float* __restrict__ out) {
    const int tid = threadIdx.x, p = tid >> 3, ng = tid & 7;
    constexpr int NITEM = DEC_BATCH * SSD_HEADS;
    for (int it = blockIdx.x; it < NITEM; it += 2 * gridDim.x) {
        const int it2 = it + gridDim.x; const bool has2 = it2 < NITEM; const int it2c = has2 ? it2 : it;
        float hsA[16], hsB[16], xA[4], xB[4], dA[4], dB[4]; v4u bA[4][2], cA[4][2], bB[4][2], cB[4][2];
        ssd_decode_load(xbc_b, dtv, state_ssm, it, p, ng, hsA, bA, cA, xA, dA);
        ssd_decode_load(xbc_b, dtv, state_ssm, it2c, p, ng, hsB, bB, cB, xB, dB);
        ssd_decode_compute(a_log, d_skip, it, p, ng, hsA, bA, cA, xA, dA, ybuf, out);
        if (has2) ssd_decode_compute(a_log, d_skip, it2, p, ng, hsB, bB, cB, xB, dB, ybuf, out);
    }
}

__device__ __forceinline__ float samp_cw(int d) { return (float)((int)(d >= 0 && d <= 128) + (int)(d >= 0 && (d & 3) == 0 && d <= 512) + (int)(d >= 0 && (d & 15) == 0 && d <= 2048)); }
__device__ __forceinline__ void samp_update(float sv, float cw, const float (&vrow)[64], float& m, float& l, float (&part)[64]) {
    const float mn = fmaxf(m, sv), alpha = __expf(m - mn), p = cw * __expf(sv - mn);
    m = mn; l = l * alpha + p;
#pragma unroll
    for (int c = 0; c < 64; ++c) part[c] = part[c] * alpha + p * vrow[c];
}
__device__ __forceinline__ void ph_attn_sample3(float* lds, const bf16* __restrict__ qrot_b, const bf16* __restrict__ krot_b, const bf16* __restrict__ projb,
                                                const float* __restrict__ ck, const float* __restrict__ cv, bf16* __restrict__ A1) {
    const int lane0 = threadIdx.x & 63, w = __builtin_amdgcn_readfirstlane(threadIdx.x >> 6);
    float* sq = lds + w * 256;
    for (int item = blockIdx.x + gridDim.x * w; item < DEC_BATCH * ATT_HEADS; item += gridDim.x * NWAVE) {
        int lane = lane0; asm volatile("" : "+v"(lane));
        const int b = item >> 3, hd = item & 7, qi = lane & 3, g = lane >> 2;
        const int tq0 = T_PROMPT + b * DEC_SEQ;
#pragma unroll
        for (int i = 0; i < 4; ++i) sq[i * 64 + lane] = bf2f(qrot_b[(size_t)(tq0 + i) * ATT_WIDTH + hd * 64 + lane]);
        asm volatile("s_waitcnt lgkmcnt(0)" ::: "memory");
        const float* qv = sq + qi * 64;
        const float* ckb = ck + (size_t)b * WBUF * ATT_WIDTH + hd * 64; const float* cvb = cv + (size_t)b * WBUF * ATT_WIDTH + hd * 64;
        float m = -1e30f, l = 0.f, part[64];
#pragma unroll
        for (int c = 0; c < 64; ++c) part[c] = 0.f;
        {
            const int P = 2051 - g;
            const float cw = samp_cw(WBUF + qi - P);
            const bool isn = P >= WBUF;
            const int nt = isn ? P - WBUF : 0, Pc = isn ? WBUF - 1 : P;
            const bf16* kn = krot_b + (size_t)(tq0 + nt) * ATT_WIDTH + hd * 64; const float* kr = ckb + (size_t)Pc * ATT_WIDTH;
            float a = 0.f;
#pragma unroll
            for (int c = 0; c < 64; c += 8) { float f[8]; unpack8(*(const v4u*)(kn + c), f); const float4 k0 = *(const float4*)(kr + c), k1 = *(const float4*)(kr + c + 4);
                a += (isn ? f[0] : k0.x) * qv[c] + (isn ? f[1] : k0.y) * qv[c + 1] + (isn ? f[2] : k0.z) * qv[c + 2] + (isn ? f[3] : k0.w) * qv[c + 3]
                   + (isn ? f[4] : k1.x) * qv[c + 4] + (isn ? f[5] : k1.y) * qv[c + 5] + (isn ? f[6] : k1.z) * qv[c + 6] + (isn ? f[7] : k1.w) * qv[c + 7]; }
            const float sv = cw > 0.f ? a * 0.125f : -1e30f;
            const bf16* vn = projb + (size_t)(tq0 + nt) * NB_LD + NB_V + hd * 64; const float* vr = cvb + (size_t)Pc * ATT_WIDTH;
            float vrow[64];
#pragma unroll
            for (int c = 0; c < 64; c += 8) { float f[8]; unpack8(*(const v4u*)(vn + c), f); const float4 v0 = *(const float4*)(vr + c), v1 = *(const float4*)(vr + c + 4);
                vrow[c] = isn ? f[0] : v0.x; vrow[c + 1] = isn ? f[1] : v0.y; vrow[c + 2] = isn ? f[2] : v0.z; vrow[c + 3] = isn ? f[3] : v0.w;
                vrow[c + 4] = isn ? f[4] : v1.x; vrow[c + 5] = isn ? f[5] : v1.y; vrow[c + 6] = isn ? f[6] : v1.z; vrow[c + 7] = isn ? f[7] : v1.w; }
            samp_update(sv, cw, vrow, m, l, part);
        }
#pragma unroll 1
        for (int s = 1; s < 21; ++s) {
            const int P = s < 9 ? 2051 - (16 * s + g) : (s < 15 ? 1536 + 64 * (s - 9) + lane : qi + 16 * (16 * (s - 15) + g));
            const float cw = (s < 9 && P < 1920) ? 0.f : samp_cw(WBUF + qi - P);
            const float* kr = ckb + (size_t)P * ATT_WIDTH;
            float a = 0.f;
#pragma unroll
            for (int c = 0; c < 64; c += 4) { const float4 kv = *(const float4*)(kr + c); a += kv.x * qv[c] + kv.y * qv[c + 1] + kv.z * qv[c + 2] + kv.w * qv[c + 3]; }
            const float sv = cw > 0.f ? a * 0.125f : -1e30f;
            __builtin_amdgcn_sched_barrier(0);
            const float* vr = cvb + (size_t)P * ATT_WIDTH;
            float vrow[64];
#pragma unroll
            for (int c = 0; c < 64; c += 4) { const float4 vv = *(const float4*)(vr + c); vrow[c] = vv.x; vrow[c + 1] = vv.y; vrow[c + 2] = vv.z; vrow[c + 3] = vv.w; }
            samp_update(sv, cw, vrow, m, l, part);
        }
        float M = m;
        M = fmaxf(M, __shfl_xor(M, 4)); M = fmaxf(M, __shfl_xor(M, 8)); M = fmaxf(M, __shfl_xor(M, 16)); M = fmaxf(M, __shfl_xor(M, 32));
        const float sc = __expf(m - M);
        float lsum = l * sc;
        lsum += __shfl_xor(lsum, 4); lsum += __shfl_xor(lsum, 8); lsum += __shfl_xor(lsum, 16); lsum += __shfl_xor(lsum, 32);
#pragma unroll
        for (int c = 0; c < 64; ++c) part[c] *= sc;
        PEER_TR_STEP(32, 32) PEER_TR_STEP(16, 16) PEER_TR_STEP(8, 8) PEER_TR_STEP(4, 4)
        const float inv = 1.0f / lsum;
        *(uint2*)(A1 + (size_t)(tq0 + qi) * MIX_WIDTH + SSD_WIDTH + hd * 64 + 4 * g) = make_uint2(pk2(part[0] * inv, part[1] * inv), pk2(part[2] * inv, part[3] * inv));
    }
}

typedef float f32x16 __attribute__((ext_vector_type(16)));
typedef short s16x8 __attribute__((ext_vector_type(8)));
typedef short s16x4 __attribute__((ext_vector_type(4)));
typedef float f32x4v __attribute__((ext_vector_type(4)));
#define SSD_L_ACS 0
#define SSD_L_DTS 3072
#define SSD_L_BM 6144
#define SSD_RS_B 272
#define SSD_L_X (6144 + 128 * 272)
#define SSD_RS_X 144
#define SSD_XIMG (128 * 144)
#define SSD_RS_Y 784
template <int OFF0, int OFF1>
__device__ __forceinline__ s16x8 tr_frag(unsigned base) {
    s16x4 a, b;
    asm volatile("ds_read_b64_tr_b16 %0, %2 offset:%3\n\tds_read_b64_tr_b16 %1, %2 offset:%4\n\ts_waitcnt lgkmcnt(0)"
                 : "=&v"(a), "=&v"(b) : "v"(base), "n"(OFF0), "n"(OFF1) : "memory");
    return __builtin_shufflevector(a, b, 0, 1, 2, 3, 4, 5, 6, 7);
}
__device__ __forceinline__ unsigned lds_addr(LAS unsigned char* p) { return (unsigned)(size_t)p; }
template <int O0, int O1, int O2, int O3, int O4, int O5, int O6, int O7>
__device__ __forceinline__ void tr_read8(unsigned base, s16x4 (&v)[8]) {
    asm volatile("ds_read_b64_tr_b16 %0, %8 offset:%9\n\tds_read_b64_tr_b16 %1, %8 offset:%10\n\tds_read_b64_tr_b16 %2, %8 offset:%11\n\tds_read_b64_tr_b16 %3, %8 offset:%12\n\t"
                 "ds_read_b64_tr_b16 %4, %8 offset:%13\n\tds_read_b64_tr_b16 %5, %8 offset:%14\n\tds_read_b64_tr_b16 %6, %8 offset:%15\n\tds_read_b64_tr_b16 %7, %8 offset:%16\n\ts_waitcnt lgkmcnt(0)"
                 : "=&v"(v[0]), "=&v"(v[1]), "=&v"(v[2]), "=&v"(v[3]), "=&v"(v[4]), "=&v"(v[5]), "=&v"(v[6]), "=&v"(v[7])
                 : "v"(base), "n"(O0), "n"(O1), "n"(O2), "n"(O3), "n"(O4), "n"(O5), "n"(O6), "n"(O7) : "memory");
}
#define TRCAT(a, b) __builtin_shufflevector(a, b, 0, 1, 2, 3, 4, 5, 6, 7)


__device__ __forceinline__ void ssd_chunk_acs(LAS unsigned char* ldsb, const float* __restrict__ dtv, const float* __restrict__ a_log, int t0, int g, float* cdec_out) {
    const int w = __builtin_amdgcn_readfirstlane(threadIdx.x >> 6), lane = threadIdx.x & 63;
    if (w < 6) {
        const int head = 6 * g + w;
        const float A = -__expf(a_log[head]);
        const float v0 = dtv[(size_t)(t0 + 2 * lane) * SSD_HEADS + head], v1 = dtv[(size_t)(t0 + 2 * lane + 1) * SSD_HEADS + head];
        const float a1 = v1 * A;
        float s = v0 * A + a1;
#pragma unroll
        for (int o = 1; o < 64; o <<= 1) { const float tmp = __shfl_up(s, o); if (lane >= o) s += tmp; }
        LAS float* acs = (LAS float*)(ldsb + SSD_L_ACS) + w * 128;
        LAS float* dts = (LAS float*)(ldsb + SSD_L_DTS) + w * 128;
        acs[2 * lane] = s - a1; acs[2 * lane + 1] = s;
        dts[2 * lane] = v0; dts[2 * lane + 1] = v1;
        if (cdec_out && lane == 63) cdec_out[head] = __expf(s);
    }
}

__device__ __forceinline__ void ph_ssd_states(LAS unsigned char* ldsb, const bf16* __restrict__ xbc_b, const float* __restrict__ dtv, const float* __restrict__ a_log,
                                              bf16* __restrict__ Sbuf, float* __restrict__ cdec, const float* __restrict__ ck, const float* __restrict__ cv, float* __restrict__ out) {
    const int tid = threadIdx.x, w = __builtin_amdgcn_readfirstlane(tid >> 6), lane = tid & 63;
    const int r = lane & 31, h = lane >> 5, blk = (lane >> 4) & 1, q = (lane & 15) >> 2, pp = lane & 3;
    const int nt = w & 3, pt = w >> 2;
    for (int unit = blockIdx.x; unit < BATCH * 64 * SSD_GROUPS; unit += gridDim.x) {
        const int g = unit & 3, bc = unit >> 2;
        const int t0 = bc * 128;
        __syncthreads();
        ssd_chunk_acs(ldsb, dtv, a_log, t0, g, cdec + (size_t)bc * SSD_HEADS);
#pragma unroll
        for (int it_ = 0; it_ < 4; ++it_) { const int idx = tid + it_ * NTHR; const int row = idx >> 4, ch = idx & 15;
            const v4u v = *(const v4u*)(xbc_b + (size_t)(t0 + row) * CONV_DIM + 1536 + 128 * g + ch * 8);
            *(LAS v4u*)(ldsb + SSD_L_BM + row * SSD_RS_B + ch * 16) = v; }
        __syncthreads();
#pragma unroll
        for (int it_ = 0; it_ < 12; ++it_) { const int idx = tid + it_ * NTHR; const int hh = idx >> 10, rem = idx & 1023, row = rem >> 3, ch = rem & 7;
            const LAS float* acs = (const LAS float*)(ldsb + SSD_L_ACS) + hh * 128; const LAS float* dts = (const LAS float*)(ldsb + SSD_L_DTS) + hh * 128;
            const float wgt = dts[row] * __expf(acs[127] - acs[row]);
            float f[8]; unpack8(*(const v4u*)(xbc_b + (size_t)(t0 + row) * CONV_DIM + (6 * g + hh) * 64 + ch * 8), f);
            v4u o; o.x = pk2(f[0] * wgt, f[1] * wgt); o.y = pk2(f[2] * wgt, f[3] * wgt); o.z = pk2(f[4] * wgt, f[5] * wgt); o.w = pk2(f[6] * wgt, f[7] * wgt);
            *(LAS v4u*)(ldsb + SSD_L_X + hh * SSD_XIMG + row * SSD_RS_X + ch * 16) = o; }
        __syncthreads();
        f32x4n rider[16];
        copy_q_load(ck, cv, 12288u + (unsigned)(unit * NWAVE + w), (unsigned)lane, rider);
        const unsigned abase = lds_addr(ldsb + SSD_L_BM) + (8 * h + q) * SSD_RS_B + (32 * nt + 16 * blk + 4 * pp) * 2;
        s16x8 afr[8];
        { s16x4 av[8];
          tr_read8<0 * SSD_RS_B, 4 * SSD_RS_B, 16 * SSD_RS_B, 20 * SSD_RS_B, 32 * SSD_RS_B, 36 * SSD_RS_B, 48 * SSD_RS_B, 52 * SSD_RS_B>(abase, av);
          afr[0] = TRCAT(av[0], av[1]); afr[1] = TRCAT(av[2], av[3]); afr[2] = TRCAT(av[4], av[5]); afr[3] = TRCAT(av[6], av[7]);
          tr_read8<64 * SSD_RS_B, 68 * SSD_RS_B, 80 * SSD_RS_B, 84 * SSD_RS_B, 96 * SSD_RS_B, 100 * SSD_RS_B, 112 * SSD_RS_B, 116 * SSD_RS_B>(abase, av);
          afr[4] = TRCAT(av[0], av[1]); afr[5] = TRCAT(av[2], av[3]); afr[6] = TRCAT(av[4], av[5]); afr[7] = TRCAT(av[6], av[7]); }
#pragma unroll
        for (int hh = 0; hh < 6; ++hh) {
            const unsigned xb = lds_addr(ldsb + SSD_L_X + hh * SSD_XIMG) + (8 * h + q) * SSD_RS_X + (32 * pt + 16 * blk + 4 * pp) * 2;
            f32x16 acc;
#pragma unroll
            for (int i = 0; i < 16; ++i) acc[i] = 0.f;
            { s16x4 xv[8];
              tr_read8<0 * SSD_RS_X, 4 * SSD_RS_X, 16 * SSD_RS_X, 20 * SSD_RS_X, 32 * SSD_RS_X, 36 * SSD_RS_X, 48 * SSD_RS_X, 52 * SSD_RS_X>(xb, xv);
              acc = __builtin_amdgcn_mfma_f32_32x32x16_bf16(afr[0], TRCAT(xv[0], xv[1]), acc, 0, 0, 0);
              acc = __builtin_amdgcn_mfma_f32_32x32x16_bf16(afr[1], TRCAT(xv[2], xv[3]), acc, 0, 0, 0);
              acc = __builtin_amdgcn_mfma_f32_32x32x16_bf16(afr[2], TRCAT(xv[4], xv[5]), acc, 0, 0, 0);
              acc = __builtin_amdgcn_mfma_f32_32x32x16_bf16(afr[3], TRCAT(xv[6], xv[7]), acc, 0, 0, 0);
              tr_read8<64 * SSD_RS_X, 68 * SSD_RS_X, 80 * SSD_RS_X, 84 * SSD_RS_X, 96 * SSD_RS_X, 100 * SSD_RS_X, 112 * SSD_RS_X, 116 * SSD_RS_X>(xb, xv);
              acc = __builtin_amdgcn_mfma_f32_32x32x16_bf16(afr[4], TRCAT(xv[0], xv[1]), acc, 0, 0, 0);
              acc = __builtin_amdgcn_mfma_f32_32x32x16_bf16(afr[5], TRCAT(xv[2], xv[3]), acc, 0, 0, 0);
              acc = __builtin_amdgcn_mfma_f32_32x32x16_bf16(afr[6], TRCAT(xv[4], xv[5]), acc, 0, 0, 0);
              acc = __builtin_amdgcn_mfma_f32_32x32x16_bf16(afr[7], TRCAT(xv[6], xv[7]), acc, 0, 0, 0); }
            bf16* dst = Sbuf + (((size_t)bc * SSD_HEADS + 6 * g + hh) * 64 + 32 * pt + r) * 128 + 32 * nt + 4 * h;
#pragma unroll
            for (int q4 = 0; q4 < 4; ++q4) *(uint2*)(dst + 8 * q4) = make_uint2(pk2(acc[4 * q4], acc[4 * q4 + 1]), pk2(acc[4 * q4 + 2], acc[4 * q4 + 3]));
        }
        copy_q_store(out, 12288u + (unsigned)(unit * NWAVE + w), (unsigned)lane, rider);
    }
}

__device__ __forceinline__ void ph_ssd_scan(const bf16* __restrict__ Sbuf, const float* __restrict__ cdec, bf16* __restrict__ Hin, float* __restrict__ out, int rank, int nranks) {
    for (int idx = rank * NTHR + threadIdx.x; idx < BATCH * SSD_HEADS * 64 * 16; idx += nranks * NTHR) {
        const int n8 = idx & 15, p = (idx >> 4) & 63, hb = idx >> 10, hd = hb % SSD_HEADS, b = hb / SSD_HEADS;
        float st[8];
#pragma unroll
        for (int j = 0; j < 8; ++j) st[j] = 0.f;
#pragma unroll 8
        for (int c = 0; c < 64; ++c) {
            const size_t base = ((((size_t)(b * 64 + c)) * SSD_HEADS + hd) * 64 + p) * 128 + n8 * 8;
            v4u o; o.x = pk2(st[0], st[1]); o.y = pk2(st[2], st[3]); o.z = pk2(st[4], st[5]); o.w = pk2(st[6], st[7]);
            *(v4u*)(Hin + base) = o;
            float s[8]; unpack8(*(const v4u*)(Sbuf + base), s);
            const float a = cdec[(size_t)(b * 64 + c) * SSD_HEADS + hd];
#pragma unroll
            for (int j = 0; j < 8; ++j) st[j] = a * st[j] + s[j];
        }
        store8f(out + OUT_PS + (((size_t)b * SSD_HEADS + hd) * 64 + p) * 128 + n8 * 8, st);
    }
}

__device__ __forceinline__ void ph_ssd_out(LAS unsigned char* ldsb, const bf16* __restrict__ xbc_b, const bf16* __restrict__ projb, const float* __restrict__ dtv,
                                           const float* __restrict__ a_log, const float* __restrict__ d_skip, const float* __restrict__ norm_g,
                                           const bf16* __restrict__ Hin, bf16* __restrict__ A1) {
    const int tid = threadIdx.x, w = __builtin_amdgcn_readfirstlane(tid >> 6), lane = tid & 63;
    const int r = lane & 31, h = lane >> 5, blk = (lane >> 4) & 1, q = (lane & 15) >> 2, pp = lane & 3;
    const int lt = w & 3, hs = w >> 2;
    for (int unit = blockIdx.x; unit < BATCH * 64 * SSD_GROUPS; unit += gridDim.x) {
        const int g = unit & 3, bc = unit >> 2;
        const int t0 = bc * 128;
        __syncthreads();
        ssd_chunk_acs(ldsb, dtv, a_log, t0, g, nullptr);
#pragma unroll
        for (int it_ = 0; it_ < 4; ++it_) { const int idx = tid + it_ * NTHR; const int row = idx >> 4, ch = idx & 15;
            const v4u v = *(const v4u*)(xbc_b + (size_t)(t0 + row) * CONV_DIM + 1536 + 128 * g + ch * 8);
            *(LAS v4u*)(ldsb + SSD_L_BM + row * SSD_RS_B + ch * 16) = v; }
#pragma unroll
        for (int it_ = 0; it_ < 12; ++it_) { const int idx = tid + it_ * NTHR; const int hh = idx >> 10, rem = idx & 1023, row = rem >> 3, ch = rem & 7;
            const v4u v = *(const v4u*)(xbc_b + (size_t)(t0 + row) * CONV_DIM + (6 * g + hh) * 64 + ch * 8);
            *(LAS v4u*)(ldsb + SSD_L_X + hh * SSD_XIMG + row * SSD_RS_X + ch * 16) = v; }
        __syncthreads();
        const bf16* cp = xbc_b + (size_t)(t0 + 32 * lt + r) * CONV_DIM + 2048 + 128 * g + 8 * h;
        s16x8 cfr[8];
#pragma unroll
        for (int ks = 0; ks < 8; ++ks) cfr[ks] = *(const s16x8*)(cp + 16 * ks);
        const int lcol = 32 * lt + r;
        const LAS float* acsb = (const LAS float*)(ldsb + SSD_L_ACS) + 3 * hs * 128; const LAS float* dtsb = (const LAS float*)(ldsb + SSD_L_DTS) + 3 * hs * 128;
        const unsigned xb0 = lds_addr(ldsb + SSD_L_X + 3 * hs * SSD_XIMG) + (4 * h + q) * SSD_RS_X + (16 * blk + 4 * pp) * 2;
        unsigned ypk[3][16];
#pragma unroll
        for (int h3 = 0; h3 < 3; ++h3) {
            const LAS float* acs = acsb + h3 * 128; const LAS float* dts = dtsb + h3 * 128;
            const float myacs = acs[lcol];
            const float Dh = d_skip[6 * g + 3 * hs + h3];
            f32x16 y0, y1;
#pragma unroll
            for (int i = 0; i < 16; ++i) { y0[i] = 0.f; y1[i] = 0.f; }
            { const bf16* hp = Hin + (((size_t)bc * SSD_HEADS + 6 * g + 3 * hs + h3) * 64 + r) * 128 + 8 * h;
#pragma unroll
              for (int kh = 0; kh < 2; ++kh) {
                  s16x8 hf0[4], hf1[4];
#pragma unroll
                  for (int ks = 0; ks < 4; ++ks) { hf0[ks] = *(const s16x8*)(hp + 16 * (4 * kh + ks)); hf1[ks] = *(const s16x8*)(hp + 32 * 128 + 16 * (4 * kh + ks)); }
#pragma unroll
                  for (int ks = 0; ks < 4; ++ks) { y0 = __builtin_amdgcn_mfma_f32_32x32x16_bf16(cfr[4 * kh + ks], hf0[ks], y0, 0, 0, 0); y1 = __builtin_amdgcn_mfma_f32_32x32x16_bf16(cfr[4 * kh + ks], hf1[ks], y1, 0, 0, 0); }
                  __builtin_amdgcn_sched_barrier(0);
              } }
#pragma unroll
            for (int q4 = 0; q4 < 4; ++q4) {
                const f32x4v a4 = *(const LAS f32x4v*)(acs + 32 * lt + 8 * q4 + 4 * h);
                const float e0 = __expf(a4[0]), e1 = __expf(a4[1]), e2 = __expf(a4[2]), e3 = __expf(a4[3]);
                y0[4 * q4] *= e0; y0[4 * q4 + 1] *= e1; y0[4 * q4 + 2] *= e2; y0[4 * q4 + 3] *= e3;
                y1[4 * q4] *= e0; y1[4 * q4 + 1] *= e1; y1[4 * q4 + 2] *= e2; y1[4 * q4 + 3] *= e3;
            }
            __builtin_amdgcn_sched_barrier(0);
            for (int st = 0; st <= lt; ++st) {
                f32x16 cb;
#pragma unroll
                for (int i = 0; i < 16; ++i) cb[i] = 0.f;
#pragma unroll
                for (int ks = 0; ks < 8; ++ks) {
                    const s16x8 bfrag = *(const LAS s16x8*)(ldsb + SSD_L_BM + (32 * st + r) * SSD_RS_B + (16 * ks + 8 * h) * 2);
                    cb = __builtin_amdgcn_mfma_f32_32x32x16_bf16(bfrag, cfr[ks], cb, 0, 0, 0);
                }
                __builtin_amdgcn_sched_barrier(0);
                const unsigned xb = xb0 + h3 * SSD_XIMG + st * 32 * SSD_RS_X;
                s16x4 xv[8];
                tr_read8<0, 8 * SSD_RS_X, 64, 8 * SSD_RS_X + 64, 16 * SSD_RS_X, 24 * SSD_RS_X, 16 * SSD_RS_X + 64, 24 * SSD_RS_X + 64>(xb, xv);
#pragma unroll
                for (int kk = 0; kk < 2; ++kk) {
                    const int s0 = 32 * st + 16 * kk + 4 * h;
                    const f32x4v as0 = *(const LAS f32x4v*)(acs + s0), as1 = *(const LAS f32x4v*)(acs + s0 + 8);
                    const f32x4v ds0 = *(const LAS f32x4v*)(dts + s0), ds1 = *(const LAS f32x4v*)(dts + s0 + 8);
                    float wv[8];
#pragma unroll
                    for (int j = 0; j < 8; ++j) {
                        const int s = s0 + 8 * (j >> 2) + (j & 3);
                        const float asj = (j < 4) ? as0[j & 3] : as1[j & 3], dsj = (j < 4) ? ds0[j & 3] : ds1[j & 3];
                        float v = cb[8 * kk + j] * __expf(myacs - asj) * dsj;
                        v = (s <= lcol) ? v : 0.f;
                        v = (s == lcol) ? v + Dh : v;
                        wv[j] = v;
                    }
                    s16x8 afr;
                    { v4u o; o.x = pk2(wv[0], wv[1]); o.y = pk2(wv[2], wv[3]); o.z = pk2(wv[4], wv[5]); o.w = pk2(wv[6], wv[7]); afr = __builtin_bit_cast(s16x8, o); }
                    const s16x8 b0 = kk == 0 ? TRCAT(xv[0], xv[1]) : TRCAT(xv[4], xv[5]);
                    const s16x8 b1 = kk == 0 ? TRCAT(xv[2], xv[3]) : TRCAT(xv[6], xv[7]);
                    y0 = __builtin_amdgcn_mfma_f32_32x32x16_bf16(afr, b0, y0, 0, 0, 0);
                    y1 = __builtin_amdgcn_mfma_f32_32x32x16_bf16(afr, b1, y1, 0, 0, 0);
                    __builtin_amdgcn_sched_barrier(0);
                }
            }
#pragma unroll
            for (int i = 0; i < 8; ++i) { ypk[h3][i] = pk2(y0[2 * i], y0[2 * i + 1]); ypk[h3][8 + i] = pk2(y1[2 * i], y1[2 * i + 1]); }
            __builtin_amdgcn_sched_barrier(0);
        }
        __syncthreads();
        {
            LAS unsigned short* yst = (LAS unsigned short*)(ldsb + SSD_L_X);
#pragma unroll
            for (int h3 = 0; h3 < 3; ++h3)
#pragma unroll
                for (int ptile = 0; ptile < 2; ++ptile)
#pragma unroll
                    for (int i = 0; i < 8; ++i) {
                        const int reg = 2 * i;
                        const int l0 = 32 * lt + (reg & 3) + 8 * (reg >> 2) + 4 * h;
                        const int col = (3 * hs + h3) * 64 + 32 * ptile + r;
                        const unsigned v = ypk[h3][8 * ptile + i];
                        yst[l0 * (SSD_RS_Y / 2) + col] = (unsigned short)(v & 0xffffu);
                        yst[(l0 + 1) * (SSD_RS_Y / 2) + col] = (unsigned short)(v >> 16);
                    }
        }
        __syncthreads();
#pragma unroll
        for (int pass = 0; pass < 4; ++pass) {
            const int l = 4 * (pass * 8 + w) + (lane >> 4), i16 = lane & 15;
            float gv[3][8]; float ss = 0.f;
#pragma unroll
            for (int k = 0; k < 3; ++k) {
                const int col0 = 24 * i16 + 8 * k;
                float yv[8], zv[8];
                unpack8(*(const LAS v4u*)(ldsb + SSD_L_X + l * SSD_RS_Y + col0 * 2), yv);
                unpack8(*(const v4u*)(projb + (size_t)(t0 + l) * NB_LD + g * 384 + col0), zv);
#pragma unroll
                for (int j = 0; j < 8; ++j) { const float gg = yv[j] * silu_f(zv[j]); gv[k][j] = gg; ss += gg * gg; }
            }
            ss += __shfl_xor(ss, 1); ss += __shfl_xor(ss, 2); ss += __shfl_xor(ss, 4); ss += __shfl_xor(ss, 8);
            const float rstd = rsqrtf(ss * (1.0f / 384.0f) + LN_EPS);
#pragma unroll
            for (int k = 0; k < 3; ++k) {
                const int col0 = g * 384 + 24 * i16 + 8 * k;
                const float4 g0 = *(const float4*)(norm_g + col0), g1 = *(const float4*)(norm_g + col0 + 4);
                v4u o; o.x = pk2(gv[k][0] * rstd * g0.x, gv[k][1] * rstd * g0.y); o.y = pk2(gv[k][2] * rstd * g0.z, gv[k][3] * rstd * g0.w);
                o.z = pk2(gv[k][4] * rstd * g1.x, gv[k][5] * rstd * g1.y); o.w = pk2(gv[k][6] * rstd * g1.z, gv[k][7] * rstd * g1.w);
                *(v4u*)(A1 + (size_t)(t0 + l) * MIX_WIDTH + col0) = o;
            }
        }
    }
}

#define ATT_RS_V 144
#define ATT_VIMG (256 * ATT_RS_V)
#define ATT_PVT(KT) { \
        s16x4 vv_[8]; \
        tr_read8<(32 * KT) * ATT_RS_V, (32 * KT + 8) * ATT_RS_V, (32 * KT) * ATT_RS_V + 64, (32 * KT + 8) * ATT_RS_V + 64, \
                 (32 * KT + 16) * ATT_RS_V, (32 * KT + 24) * ATT_RS_V, (32 * KT + 16) * ATT_RS_V + 64, (32 * KT + 24) * ATT_RS_V + 64>(vbase, vv_); \
        _Pragma("unroll") for (int s2_ = 0; s2_ < 2; ++s2_) { \
            v4u o_; o_.x = pk2(s[KT][8 * s2_ + 0], s[KT][8 * s2_ + 1]); o_.y = pk2(s[KT][8 * s2_ + 2], s[KT][8 * s2_ + 3]); \
            o_.z = pk2(s[KT][8 * s2_ + 4], s[KT][8 * s2_ + 5]); o_.w = pk2(s[KT][8 * s2_ + 6], s[KT][8 * s2_ + 7]); \
            const s16x8 pf_ = __builtin_bit_cast(s16x8, o_); \
            const s16x8 a0_ = s2_ == 0 ? TRCAT(vv_[0], vv_[1]) : TRCAT(vv_[4], vv_[5]); \
            const s16x8 a1_ = s2_ == 0 ? TRCAT(vv_[2], vv_[3]) : TRCAT(vv_[6], vv_[7]); \
            o0 = __builtin_amdgcn_mfma_f32_32x32x16_bf16(a0_, pf_, o0, 0, 0, 0); \
            o1 = __builtin_amdgcn_mfma_f32_32x32x16_bf16(a1_, pf_, o1, 0, 0, 0); } }
__device__ __forceinline__ void ph_attn_prompt(LAS unsigned char* ldsb, const bf16* __restrict__ qrot_b, const bf16* __restrict__ krot_b, const bf16* __restrict__ projb,
                                               bf16* __restrict__ obuf, float* __restrict__ lsebuf, const float* __restrict__ ck, const float* __restrict__ cv, float* __restrict__ out) {
    const int tid = threadIdx.x, w = __builtin_amdgcn_readfirstlane(tid >> 6), lane = tid & 63;
    const int r = lane & 31, h = lane >> 5, blk = (lane >> 4) & 1, q = (lane & 15) >> 2, pp = lane & 3;
    const int qt = w & 3, hsel = w >> 2;
    f32x4n rider[16]; bool pend = false; unsigned pq = 0u;
    for (int unit = blockIdx.x; unit < 3 * 512; unit += gridDim.x) {
        const int pat = unit >> 9, rem = unit & 511, hp = rem & 3, rem2 = rem >> 2, b = rem2 >> 6, bk = rem2 & 63;
        const int dsh = 2 * pat, nper = 64 >> dsh, res = bk >> (6 - dsh), nb = bk & (nper - 1);
        const int head = 2 * hp + hsel;
        __syncthreads();
#pragma unroll
        for (int it_ = 0; it_ < 8; ++it_) { const int idx = (tid & 255) + it_ * 256;
            const int row = idx >> 3, ch = idx & 7, js = 128 * nb - 128 + row;
            v4u v; v.x = 0u; v.y = 0u; v.z = 0u; v.w = 0u;
            if (js >= 0) v = *(const v4u*)(projb + (size_t)(b * SEQ + (js << dsh) + res) * NB_LD + NB_V + head * 64 + ch * 8);
            *(LAS v4u*)(ldsb + hsel * ATT_VIMG + row * ATT_RS_V + ch * 16) = v;
        }
        const int tq = b * SEQ + ((128 * nb + 32 * qt + r) << dsh) + res;
        s16x8 qf[4];
#pragma unroll
        for (int ks = 0; ks < 4; ++ks) qf[ks] = *(const s16x8*)(qrot_b + (size_t)tq * ATT_WIDTH + head * 64 + 16 * ks + 8 * h);
        f32x16 s[5];
#pragma unroll
        for (int kt = 0; kt < 5; ++kt) {
            int js = 128 * nb + 32 * qt - 128 + 32 * kt + r; js = js < 0 ? 0 : js;
            const bf16* kp = krot_b + (size_t)(b * SEQ + (js << dsh) + res) * ATT_WIDTH + head * 64 + 8 * h;
#pragma unroll
            for (int i = 0; i < 16; ++i) s[kt][i] = 0.f;
#pragma unroll
            for (int ks = 0; ks < 4; ++ks) s[kt] = __builtin_amdgcn_mfma_f32_32x32x16_bf16(*(const s16x8*)(kp + 16 * ks), qf[ks], s[kt], 0, 0, 0);
        }
        if (pend) copy_q_store(out, pq, (unsigned)lane, rider);
        float m = -INFINITY;
#pragma unroll
        for (int kt = 0; kt < 5; ++kt) {
            const bool tile_ok = (nb > 0) || (qt + kt >= 4);
#pragma unroll
            for (int reg = 0; reg < 16; ++reg) {
                const int c = (reg & 3) + 8 * (reg >> 2) + 4 * h;
                const bool ok = tile_ok && (kt == 0 ? (c >= r) : (kt == 4 ? (c <= r) : true));
                const float v = ok ? s[kt][reg] * 0.125f : -INFINITY;
                s[kt][reg] = v; m = fmaxf(m, v);
            }
        }
        m = fmaxf(m, __shfl_xor(m, 32));
        float l = 0.f;
#pragma unroll
        for (int kt = 0; kt < 5; ++kt)
#pragma unroll
            for (int reg = 0; reg < 16; ++reg) { const float p = __expf(s[kt][reg] - m); s[kt][reg] = p; l += p; }
        l += __shfl_xor(l, 32);
        __syncthreads();
        pq = (unsigned)(unit * NWAVE + w); copy_q_load(ck, cv, pq, (unsigned)lane, rider); pend = true;
        f32x16 o0, o1;
#pragma unroll
        for (int i = 0; i < 16; ++i) { o0[i] = 0.f; o1[i] = 0.f; }
        const unsigned vbase = lds_addr(ldsb + hsel * ATT_VIMG) + (32 * qt + 4 * h + q) * ATT_RS_V + (16 * blk + 4 * pp) * 2;
        ATT_PVT(0) ATT_PVT(1) ATT_PVT(2) ATT_PVT(3) ATT_PVT(4)
        const float inv = 1.0f / l;
        bf16* op = obuf + ((size_t)pat * T_PROMPT + tq) * ATT_WIDTH + head * 64 + 4 * h;
#pragma unroll
        for (int q4 = 0; q4 < 4; ++q4) {
            *(uint2*)(op + 8 * q4) = make_uint2(pk2(o0[4 * q4] * inv, o0[4 * q4 + 1] * inv), pk2(o0[4 * q4 + 2] * inv, o0[4 * q4 + 3] * inv));
            *(uint2*)(op + 32 + 8 * q4) = make_uint2(pk2(o1[4 * q4] * inv, o1[4 * q4 + 1] * inv), pk2(o1[4 * q4 + 2] * inv, o1[4 * q4 + 3] * inv));
        }
        if (h == 0) lsebuf[((size_t)pat * T_PROMPT + tq) * 8 + head] = m + __logf(l);
    }
    if (pend) copy_q_store(out, pq, (unsigned)lane, rider);
}
__device__ __forceinline__ void ph_attn_combine(const bf16* __restrict__ obuf, const float* __restrict__ lsebuf, bf16* __restrict__ A1) {
    const int lane = threadIdx.x & 63;
#pragma unroll 4
    for (int t = blockIdx.x * NWAVE + (threadIdx.x >> 6); t < T_PROMPT; t += gridDim.x * NWAVE) {
        const int hd = lane >> 3;
        const float l0 = lsebuf[((size_t)0 * T_PROMPT + t) * 8 + hd], l1 = lsebuf[((size_t)1 * T_PROMPT + t) * 8 + hd], l2 = lsebuf[((size_t)2 * T_PROMPT + t) * 8 + hd];
        const float mx = fmaxf(l0, fmaxf(l1, l2));
        const float e0 = __expf(l0 - mx), e1 = __expf(l1 - mx), e2 = __expf(l2 - mx);
        const float inv = 1.0f / (e0 + e1 + e2);
        float a[8], b[8], c[8];
        unpack8(*(const v4u*)(obuf + ((size_t)0 * T_PROMPT + t) * ATT_WIDTH + lane * 8), a);
        unpack8(*(const v4u*)(obuf + ((size_t)1 * T_PROMPT + t) * ATT_WIDTH + lane * 8), b);
        unpack8(*(const v4u*)(obuf + ((size_t)2 * T_PROMPT + t) * ATT_WIDTH + lane * 8), c);
        float o[8];
#pragma unroll
        for (int j = 0; j < 8; ++j) o[j] = (e0 * a[j] + e1 * b[j] + e2 * c[j]) * inv;
        v4u w; w.x = pk2(o[0], o[1]); w.y = pk2(o[2], o[3]); w.z = pk2(o[4], o[5]); w.w = pk2(o[6], o[7]);
        *(v4u*)(A1 + (size_t)t * MIX_WIDTH + SSD_WIDTH + lane * 8) = w;
    }
}

#define RT_RS 272
#define RT_KIMG (128 * RT_RS)
#define RT_LUT (2 * RT_KIMG)
constexpr unsigned char RT_CANDS[64] = {0, 1, 2, 3, 4, 5, 6, 7, 8, 9, 10, 11, 12, 13, 14, 15, 16, 17, 18, 19, 20, 21, 22, 23, 32, 33, 34, 35, 36, 48, 49, 50, 51, 64, 65, 66, 80, 81, 96, 97,
                                        112, 113, 128, 144, 160, 176, 192, 208, 224, 240, 0, 0, 0, 0, 0, 0, 0, 0, 0, 0, 0, 0, 0, 0};
__device__ __forceinline__ unsigned rt_mono(float f) { const unsigned u = __builtin_bit_cast(unsigned, f); return u ^ ((unsigned)((int)u >> 31) | 0x80000000u); }
__device__ __forceinline__ float rt_unmono(unsigned m) { const unsigned u = (m & 0x80000000u) ? (m ^ 0x80000000u) : ~m; return __builtin_bit_cast(float, u); }
#define RT_CE_DESC(a, b) { const unsigned x_ = (a), y_ = (b); (a) = x_ > y_ ? x_ : y_; (b) = x_ > y_ ? y_ : x_; }
#define RT_CE_ASC(a, b) { const unsigned x_ = (a), y_ = (b); (a) = x_ > y_ ? y_ : x_; (b) = x_ > y_ ? x_ : y_; }
__device__ __forceinline__ void rt_sort16(unsigned (&v)[16]) {
#pragma unroll
    for (int k = 2; k <= 16; k <<= 1)
#pragma unroll
        for (int j = k >> 1; j > 0; j >>= 1)
#pragma unroll
            for (int i = 0; i < 16; ++i) { const int l = i ^ j; if (l > i) { if ((i & k) == 0) RT_CE_DESC(v[i], v[l]) else RT_CE_ASC(v[i], v[l]) } }
}
__device__ __forceinline__ void rt_merge16(unsigned (&v)[16]) {
#pragma unroll
    for (int j = 8; j > 0; j >>= 1)
#pragma unroll
        for (int i = 0; i < 16; ++i) { const int l = i ^ j; if (l > i) RT_CE_DESC(v[i], v[l]) }
}
__device__ __forceinline__ void rt_top16(unsigned (&a)[16], const unsigned (&b)[16]) {
#pragma unroll
    for (int i = 0; i < 16; ++i) a[i] = a[i] > b[15 - i] ? a[i] : b[15 - i];
    rt_merge16(a);
}
__device__ __forceinline__ void rt_top16_partner(unsigned (&a)[16]) {
    unsigned b[16];
#pragma unroll
    for (int i = 0; i < 16; ++i) b[i] = (unsigned)__shfl_xor((int)a[i], 32);
    rt_top16(a, b);
}
__device__ __forceinline__ void rt_scores_top16(LAS unsigned char* kimg, const bf16* __restrict__ qp, int r, int h, unsigned (&k0)[16]) {
    f32x16 acc[4];
#pragma unroll
    for (int kt = 0; kt < 4; ++kt)
#pragma unroll
        for (int i = 0; i < 16; ++i) acc[kt][i] = 0.f;
#pragma unroll
    for (int ks = 0; ks < 8; ++ks) {
        const s16x8 qf = *(const s16x8*)(qp + 16 * ks);
#pragma unroll
        for (int kt = 0; kt < 4; ++kt) {
            const s16x8 kf = *(const LAS s16x8*)(kimg + (32 * kt + r) * RT_RS + (16 * ks + 8 * h) * 2);
            acc[kt] = __builtin_amdgcn_mfma_f32_32x32x16_bf16(kf, qf, acc[kt], 0, 0, 0);
        }
    }
    unsigned k1[16], k2[16], k3[16];
#pragma unroll
    for (int reg = 0; reg < 16; ++reg) {
        const unsigned ki = (unsigned)((reg & 3) + 8 * (reg >> 2) + 4 * h);
        k0[reg] = (rt_mono(acc[0][reg]) & 0xFFFFFF80u) | ki;
        k1[reg] = (rt_mono(acc[1][reg]) & 0xFFFFFF80u) | (ki + 32u);
        k2[reg] = (rt_mono(acc[2][reg]) & 0xFFFFFF80u) | (ki + 64u);
        k3[reg] = (rt_mono(acc[3][reg]) & 0xFFFFFF80u) | (ki + 96u);
    }
    rt_sort16(k0); rt_sort16(k1); rt_sort16(k2); rt_sort16(k3);
    rt_top16(k0, k1); rt_top16(k2, k3); rt_top16(k0, k2);
    rt_top16_partner(k0);
}
__device__ __forceinline__ void ph_peer_route2(LAS unsigned char* ldsb, const bf16* __restrict__ qhb, const float* __restrict__ keys1, const float* __restrict__ keys2,
                                               int* __restrict__ eidx, float* __restrict__ gate, const float* __restrict__ ck, const float* __restrict__ cv, float* __restrict__ out) {
    const int tid = threadIdx.x, w = __builtin_amdgcn_readfirstlane(tid >> 6), lane = tid & 63, r = lane & 31, h = lane >> 5;
    __syncthreads();
    for (int idx = tid; idx < 2 * 128 * 16; idx += NTHR) {
        const int tb = idx >> 11, rem = idx & 2047, row = rem >> 4, ch = rem & 15;
        const float* sp = (tb ? keys2 : keys1) + row * 128 + ch * 8;
        const float4 a = *(const float4*)sp, b = *(const float4*)(sp + 4);
        v4u o; o.x = pk2(a.x, a.y); o.y = pk2(a.z, a.w); o.z = pk2(b.x, b.y); o.w = pk2(b.z, b.w);
        *(LAS v4u*)(ldsb + tb * RT_KIMG + row * RT_RS + ch * 16) = o;
    }
    __syncthreads();
    LAS unsigned* lut = (LAS unsigned*)(ldsb + RT_LUT) + w * 512;
    for (int unit = blockIdx.x * NWAVE + w; unit < (T_ALL / 32) * 8; unit += gridDim.x * NWAVE) {
        const int tt = unit >> 3, hd = unit & 7;
        const int tok = 32 * tt + r;
        const bf16* qp = qhb + (size_t)tok * 2048 + hd * 256 + 8 * h;
        unsigned ka[16], kb[16];
        rt_scores_top16(ldsb, qp, r, h, ka);
        rt_scores_top16(ldsb + RT_KIMG, qp + 128, r, h, kb);
        float v1[16], v2[16];
#pragma unroll
        for (int i = 0; i < 16; ++i) { v1[i] = rt_unmono(ka[i] & 0xFFFFFF80u); v2[i] = rt_unmono(kb[i] & 0xFFFFFF80u); }
#pragma unroll
        for (int wd = 0; wd < 4; ++wd) {
            lut[wd * 64 + lane] = (ka[4 * wd] & 0x7Fu) | ((ka[4 * wd + 1] & 0x7Fu) << 8) | ((ka[4 * wd + 2] & 0x7Fu) << 16) | ((ka[4 * wd + 3] & 0x7Fu) << 24);
            lut[(4 + wd) * 64 + lane] = (kb[4 * wd] & 0x7Fu) | ((kb[4 * wd + 1] & 0x7Fu) << 8) | ((kb[4 * wd + 2] & 0x7Fu) << 16) | ((kb[4 * wd + 3] & 0x7Fu) << 24);
        }
        unsigned c0[16], c1[16];
        c0[0] = (rt_mono(h ? (v1[0] + v2[1]) : (v1[0] + v2[0])) & 0xFFFFFF00u) | (h ? 1u : 0u);
        c0[1] = (rt_mono(h ? (v1[0] + v2[3]) : (v1[0] + v2[2])) & 0xFFFFFF00u) | (h ? 3u : 2u);
        c0[2] = (rt_mono(h ? (v1[0] + v2[5]) : (v1[0] + v2[4])) & 0xFFFFFF00u) | (h ? 5u : 4u);
        c0[3] = (rt_mono(h ? (v1[0] + v2[7]) : (v1[0] + v2[6])) & 0xFFFFFF00u) | (h ? 7u : 6u);
        c0[4] = (rt_mono(h ? (v1[0] + v2[9]) : (v1[0] + v2[8])) & 0xFFFFFF00u) | (h ? 9u : 8u);
        c0[5] = (rt_mono(h ? (v1[0] + v2[11]) : (v1[0] + v2[10])) & 0xFFFFFF00u) | (h ? 11u : 10u);
        c0[6] = (rt_mono(h ? (v1[0] + v2[13]) : (v1[0] + v2[12])) & 0xFFFFFF00u) | (h ? 13u : 12u);
        c0[7] = (rt_mono(h ? (v1[0] + v2[15]) : (v1[0] + v2[14])) & 0xFFFFFF00u) | (h ? 15u : 14u);
        c0[8] = (rt_mono(h ? (v1[1] + v2[1]) : (v1[1] + v2[0])) & 0xFFFFFF00u) | (h ? 17u : 16u);
        c0[9] = (rt_mono(h ? (v1[1] + v2[3]) : (v1[1] + v2[2])) & 0xFFFFFF00u) | (h ? 19u : 18u);
        c0[10] = (rt_mono(h ? (v1[1] + v2[5]) : (v1[1] + v2[4])) & 0xFFFFFF00u) | (h ? 21u : 20u);
        c0[11] = (rt_mono(h ? (v1[1] + v2[7]) : (v1[1] + v2[6])) & 0xFFFFFF00u) | (h ? 23u : 22u);
        c0[12] = (rt_mono(h ? (v1[2] + v2[1]) : (v1[2] + v2[0])) & 0xFFFFFF00u) | (h ? 33u : 32u);
        c0[13] = (rt_mono(h ? (v1[2] + v2[3]) : (v1[2] + v2[2])) & 0xFFFFFF00u) | (h ? 35u : 34u);
        c0[14] = (rt_mono(h ? (v1[3] + v2[0]) : (v1[2] + v2[4])) & 0xFFFFFF00u) | (h ? 48u : 36u);
        c0[15] = (rt_mono(h ? (v1[3] + v2[2]) : (v1[3] + v2[1])) & 0xFFFFFF00u) | (h ? 50u : 49u);
        c1[0] = (rt_mono(h ? (v1[4] + v2[0]) : (v1[3] + v2[3])) & 0xFFFFFF00u) | (h ? 64u : 51u);
        c1[1] = (rt_mono(h ? (v1[4] + v2[2]) : (v1[4] + v2[1])) & 0xFFFFFF00u) | (h ? 66u : 65u);
        c1[2] = (rt_mono(h ? (v1[5] + v2[1]) : (v1[5] + v2[0])) & 0xFFFFFF00u) | (h ? 81u : 80u);
        c1[3] = (rt_mono(h ? (v1[6] + v2[1]) : (v1[6] + v2[0])) & 0xFFFFFF00u) | (h ? 97u : 96u);
        c1[4] = (rt_mono(h ? (v1[7] + v2[1]) : (v1[7] + v2[0])) & 0xFFFFFF00u) | (h ? 113u : 112u);
        c1[5] = (rt_mono(h ? (v1[9] + v2[0]) : (v1[8] + v2[0])) & 0xFFFFFF00u) | (h ? 144u : 128u);
        c1[6] = (rt_mono(h ? (v1[11] + v2[0]) : (v1[10] + v2[0])) & 0xFFFFFF00u) | (h ? 176u : 160u);
        c1[7] = (rt_mono(h ? (v1[13] + v2[0]) : (v1[12] + v2[0])) & 0xFFFFFF00u) | (h ? 208u : 192u);
        c1[8] = (rt_mono(h ? (v1[15] + v2[0]) : (v1[14] + v2[0])) & 0xFFFFFF00u) | (h ? 240u : 224u);
        c1[9] = 0u;
        c1[10] = 0u;
        c1[11] = 0u;
        c1[12] = 0u;
        c1[13] = 0u;
        c1[14] = 0u;
        c1[15] = 0u;
        rt_sort16(c0); rt_sort16(c1); rt_top16(c0, c1); rt_top16_partner(c0);
        float e[16]; float sum = 0.f;
        const float mx = rt_unmono(c0[0] & 0xFFFFFF00u);
#pragma unroll
        for (int k = 0; k < 16; ++k) { e[k] = __expf(rt_unmono(c0[k] & 0xFFFFFF00u) - mx); sum += e[k]; }
        const float inv = 1.0f / sum;
        asm volatile("s_waitcnt lgkmcnt(0)" ::: "memory");
        int ex[8]; float gv[8];
#pragma unroll
        for (int k = 0; k < 8; ++k) {
            const unsigned hm = (unsigned)(-h);
            const unsigned ck = (c0[k] & ~hm) | (c0[8 + k] & hm);
            const float ek = __builtin_bit_cast(float, (__builtin_bit_cast(unsigned, e[k]) & ~hm) | (__builtin_bit_cast(unsigned, e[8 + k]) & hm));
            const unsigned ci = (ck >> 4) & 15u, cj = ck & 15u;
            const unsigned w1 = lut[(ci >> 2) * 64 + lane], w2 = lut[(4 + (cj >> 2)) * 64 + lane];
            const unsigned i1 = (w1 >> (8 * (ci & 3))) & 0x7Fu, i2 = (w2 >> (8 * (cj & 3))) & 0x7Fu;
            ex[k] = (int)(i1 * PEER_NKEYS + i2); gv[k] = ek * inv;
        }
        int* ep = eidx + (size_t)tok * 128 + hd * 16 + 8 * h; float* gp = gate + (size_t)tok * 128 + hd * 16 + 8 * h;
        *(int4*)ep = make_int4(ex[0], ex[1], ex[2], ex[3]); *(int4*)(ep + 4) = make_int4(ex[4], ex[5], ex[6], ex[7]);
        *(float4*)gp = make_float4(gv[0], gv[1], gv[2], gv[3]); *(float4*)(gp + 4) = make_float4(gv[4], gv[5], gv[6], gv[7]);
    }
    { const unsigned gwv = blockIdx.x * NWAVE + w; if (gridDim.x == 256 && gwv >= 128u) cache_copy_slice(ck, cv, out, 7040u + (gwv - 128u), (unsigned)lane); }
}

struct Params {
    const float* in[23];
    float* out;
    unsigned char* ws;
    unsigned* bar;
};

#define WS_BAR      0ull
#define WS_XALL     (1ull << 20)
#define WS_PROJ     (WS_XALL + (size_t)T_ALL * D_MODEL * 4)
#define WS_XBC      (WS_PROJ + (size_t)T_ALL * PROJ_LD * 4)
#define WS_DT       (WS_XBC + (size_t)T_ALL * CONV_DIM * 4)
#define WS_QROT     (WS_DT + (size_t)T_ALL * SSD_HEADS * 4)
#define WS_KROT     (WS_QROT + (size_t)T_ALL * ATT_WIDTH * 4)
#define WS_YBUF     (WS_KROT + (size_t)T_ALL * ATT_WIDTH * 4)
#define WS_MIX      (WS_YBUF + (size_t)T_ALL * MIX_WIDTH * 4)
#define WS_HBUF     (WS_MIX + (size_t)T_ALL * D_MODEL * 4)
#define WS_QH       (WS_HBUF + (size_t)T_ALL * D_MODEL * 4)
#define WS_EIDX     (WS_QH + (size_t)T_ALL * 2048 * 4)
#define WS_GATE     (WS_EIDX + (size_t)T_ALL * 128 * 4)
#define WS_A0       (WS_GATE + (size_t)T_ALL * 128 * 4)
#define WS_A1       (WS_A0 + (size_t)T_ALL * D_MODEL * 2)
#define WS_A2       (WS_A1 + (size_t)T_ALL * MIX_WIDTH * 2)
#define WS_WTIN     (WS_A2 + (size_t)T_ALL * D_MODEL * 2)
#define WS_WTOUT    (WS_WTIN + (size_t)PROJ_LD * D_MODEL * 2)
#define WS_WTQ      (WS_WTOUT + (size_t)D_MODEL * MIX_WIDTH * 2)
#define WS_PROJB    (WS_WTQ + (size_t)2048 * D_MODEL * 2)
#define WS_DTRAW    (WS_PROJB + (size_t)T_ALL * NB_LD * 2)
#define WS_XBCB     (WS_DTRAW + (size_t)T_ALL * 32 * 4)
#define WS_QROTB    (WS_XBCB + (size_t)T_ALL * CONV_DIM * 2)
#define WS_KROTB    (WS_QROTB + (size_t)T_ALL * ATT_WIDTH * 2)
#define WS_UB       (WS_KROTB + (size_t)T_ALL * ATT_WIDTH * 2)
#define WS_VB       (WS_UB + (size_t)16384 * D_MODEL * 2)
#define WS_USC      (WS_VB + (size_t)16384 * D_MODEL * 2)
#define WS_VSC      (WS_USC + 16384 * 4)
#define WS_SBUF     (WS_VSC + 16384 * 4)
#define WS_HIN      (WS_SBUF + (size_t)BATCH * 64 * SSD_HEADS * 64 * 128 * 2)
#define WS_CDEC     (WS_HIN + (size_t)BATCH * 64 * SSD_HEADS * 64 * 128 * 2)
#define WS_OBUF     (WS_CDEC + (size_t)BATCH * 64 * SSD_HEADS * 4)
#define WS_LSE      (WS_OBUF + (size_t)3 * T_PROMPT * ATT_WIDTH * 2)
#define WS_ROPE     (WS_LSE + (size_t)3 * T_PROMPT * 8 * 4)
#define WS_END      (WS_ROPE + (size_t)SEQ * 64 * 4)

#define LDS_BYTES (160 * 1024)

#define KP const __attribute__((address_space(4))) Params* kp = (const __attribute__((address_space(4))) Params*)__builtin_amdgcn_kernarg_segment_ptr(); asm volatile("" : "+s"(kp)); unsigned char* ws = kp->ws; (void)ws;
#define IN(i) (kp->in[i])
#define WSP(T, off) ((T*)(ws + (off)))
__global__ void __launch_bounds__(512, 2) mega_fwd(Params p) {
    extern __shared__ __attribute__((aligned(16))) unsigned char smem[];
    if (threadIdx.x == 0) *(uint4*)smem = make_uint4(0u, 0u, 0u, 0u);
    __syncthreads();
    XcdBarrier bar = xcd_barrier_post(p.bar, (volatile LAS unsigned*)smem);
    float* lds = (float*)(smem + 256);
    LAS unsigned char* ldsb = (LAS unsigned char*)smem + 256;

    { KP ph_prologue(ldsb, IN(0), IN(1), WSP(bf16, WS_A0), IN(6), WSP(bf16, WS_WTIN), WSP(float, WS_ROPE)); }
    xcd_barrier(bar);
    { KP pg8::Gemm g{WSP(bf16, WS_A0), WSP(bf16, WS_WTIN), T_ALL, PROJ_LD, D_MODEL}; pg8::StaticOrder S; S.init(g.M, g.N, (int)gridDim.x, (int)blockIdx.x);
      pg8::EpiProj E{WSP(bf16, WS_PROJB), WSP(float, WS_DTRAW)}; pg8::gemm_phase<pg8::EpiProj, pg8::StaticOrder, false>(ldsb, g, S, E, nullptr); }
    xcd_barrier(bar);
    { KP ph_post_proj_prompt(WSP(bf16, WS_PROJB), WSP(float, WS_DTRAW), IN(7), IN(8), IN(9), WSP(float, WS_ROPE), WSP(bf16, WS_XBCB), WSP(float, WS_DT), WSP(bf16, WS_QROTB), WSP(bf16, WS_KROTB), kp->out); }
    { KP ph_post_proj2(WSP(bf16, WS_PROJB), WSP(float, WS_DTRAW), IN(4), IN(7), IN(8), IN(9), WSP(bf16, WS_XBCB), WSP(float, WS_DT), WSP(bf16, WS_QROTB), WSP(bf16, WS_KROTB), kp->out); }
    xcd_barrier(bar);
    { KP ph_ssd_states(ldsb, WSP(bf16, WS_XBCB), WSP(float, WS_DT), IN(10), WSP(bf16, WS_SBUF), WSP(float, WS_CDEC), IN(2), IN(3), kp->out); }
    __syncthreads();
    { KP ph_attn_prompt(ldsb, WSP(bf16, WS_QROTB), WSP(bf16, WS_KROTB), WSP(bf16, WS_PROJB), WSP(bf16, WS_OBUF), WSP(float, WS_LSE), IN(2), IN(3), kp->out); }
    __syncthreads();
    { KP ph_ssd_decode(WSP(bf16, WS_XBCB), WSP(float, WS_DT), IN(10), IN(11), IN(5), WSP(float, WS_YBUF), kp->out); }
    { KP ph_attn_sample3(lds, WSP(bf16, WS_QROTB), WSP(bf16, WS_KROTB), WSP(bf16, WS_PROJB), IN(2), IN(3), WSP(bf16, WS_A1)); }
    xcd_barrier(bar);
    if ((int)gridDim.x > 128) {
        if ((int)blockIdx.x < 96) { KP ph_ssd_scan(WSP(bf16, WS_SBUF), WSP(float, WS_CDEC), WSP(bf16, WS_HIN), kp->out, (int)blockIdx.x, 96); }
        else {
            { KP ph_prologue2(ldsb, IN(13), WSP(bf16, WS_WTOUT), IN(16), WSP(bf16, WS_WTQ), (int)blockIdx.x - 96, (int)gridDim.x - 96); }
            { KP ph_quant_tables(IN(19), IN(20), WSP(unsigned char, WS_UB), WSP(unsigned char, WS_VB), WSP(float, WS_USC), WSP(float, WS_VSC), (int)blockIdx.x - 96, (int)gridDim.x - 96); }
        }
    } else {
        { KP ph_ssd_scan(WSP(bf16, WS_SBUF), WSP(float, WS_CDEC), WSP(bf16, WS_HIN), kp->out, (int)blockIdx.x, (int)gridDim.x); }
        { KP ph_prologue2(ldsb, IN(13), WSP(bf16, WS_WTOUT), IN(16), WSP(bf16, WS_WTQ), (int)blockIdx.x, (int)gridDim.x); }
        { KP ph_quant_tables(IN(19), IN(20), WSP(unsigned char, WS_UB), WSP(unsigned char, WS_VB), WSP(float, WS_USC), WSP(float, WS_VSC), (int)blockIdx.x, (int)gridDim.x); }
    }
    xcd_barrier(bar);
    { KP ph_ssd_out(ldsb, WSP(bf16, WS_XBCB), WSP(bf16, WS_PROJB), WSP(float, WS_DT), IN(10), IN(11), IN(12), WSP(bf16, WS_HIN), WSP(bf16, WS_A1)); }
    { KP ph_attn_combine(WSP(bf16, WS_OBUF), WSP(float, WS_LSE), WSP(bf16, WS_A1)); }
    { KP ph_gate_norm(WSP(bf16, WS_PROJB), IN(12), WSP(float, WS_YBUF), WSP(bf16, WS_A1)); }
    xcd_barrier(bar);
    { KP pg8::Gemm g{WSP(bf16, WS_A1), WSP(bf16, WS_WTOUT), T_ALL, D_MODEL, MIX_WIDTH}; pg8::StaticOrder S; S.init(g.M, g.N, (int)gridDim.x, (int)blockIdx.x);
      pg8::EpiBf16Plain E{WSP(bf16, WS_MIX), D_MODEL}; pg8::gemm_phase<pg8::EpiBf16Plain, pg8::StaticOrder, false>(ldsb, g, S, E, nullptr); }
    if (blockIdx.x >= 8 && gridDim.x == 256) { KP cache_copy_slice(IN(2), IN(3), kp->out, 4096u + (blockIdx.x - 8) * 8u + (threadIdx.x >> 6), threadIdx.x & 63u); }
    xcd_barrier(bar);
    { KP ph_ln_res(IN(0), IN(1), WSP(bf16, WS_MIX), IN(14), IN(15), WSP(bf16, WS_A2)); }
    xcd_barrier(bar);
    { KP pg8::Gemm g{WSP(bf16, WS_A2), WSP(bf16, WS_WTQ), T_ALL, 2048, D_MODEL}; pg8::StaticOrder S; S.init(g.M, g.N, (int)gridDim.x, (int)blockIdx.x);
      pg8::EpiBf16Plain E{WSP(bf16, WS_QH), 2048}; pg8::gemm_phase<pg8::EpiBf16Plain, pg8::StaticOrder, false>(ldsb, g, S, E, nullptr); }
    if (blockIdx.x >= 16 && gridDim.x == 256 && threadIdx.x < 256) { KP cache_copy_slice(IN(2), IN(3), kp->out, 4096u + 1984u + (blockIdx.x - 16) * 4u + (threadIdx.x >> 6), threadIdx.x & 63u); }
    xcd_barrier(bar);
    { KP ph_peer_route2(ldsb, WSP(bf16, WS_QH), IN(17), IN(18), WSP(int, WS_EIDX), WSP(float, WS_GATE), IN(2), IN(3), kp->out); }
    xcd_barrier(bar);
    { KP ph_peer_ffn3(WSP(bf16, WS_A2), WSP(int, WS_EIDX), WSP(float, WS_GATE), WSP(unsigned char, WS_UB), WSP(unsigned char, WS_VB), WSP(float, WS_USC), WSP(float, WS_VSC), IN(21), IN(22), kp->out, IN(2), IN(3), gridDim.x == 256 ? 8960u : 4096u); }
}

extern "C" void kernel_launch(void* const* d_in, const int* in_sizes, int n_in, void* d_out, int out_size, void* d_ws, size_t ws_size, hipStream_t stream) {
    static int grid = 0;
    if (grid == 0) {
        int dev = 0, cus = 0, per_cu = 0;
        if (hipGetDevice(&dev) != hipSuccess || hipDeviceGetAttribute(&cus, hipDeviceAttributeMultiprocessorCount, dev) != hipSuccess) { fprintf(stderr, "kernel_launch: device query failed\n"); grid = -1; return; }
        if (hipFuncSetAttribute((const void*)mega_fwd, hipFuncAttributeMaxDynamicSharedMemorySize, LDS_BYTES) != hipSuccess) { fprintf(stderr, "kernel_launch: hipFuncSetAttribute failed\n"); grid = -1; return; }
        if (hipOccupancyMaxActiveBlocksPerMultiprocessor(&per_cu, (const void*)mega_fwd, NTHR, LDS_BYTES) != hipSuccess || per_cu < 1) { fprintf(stderr, "kernel_launch: occupancy query says %d\n", per_cu); }
        (void)hipGetLastError();
        grid = cus;
        if (ws_size < WS_END) { fprintf(stderr, "kernel_launch: workspace too small\n"); grid = -1; return; }
    }
    if (grid < 0) return;
    (void)hipMemsetAsync((char*)d_ws + WS_BAR, 0, XCD_BAR_WORDS * sizeof(unsigned), stream);
    Params p{};
    for (int i = 0; i < 23; ++i) p.in[i] = (const float*)d_in[i];
    p.out = (float*)d_out; p.ws = (unsigned char*)d_ws; p.bar = (unsigned*)((char*)d_ws + WS_BAR);
    hipLaunchKernelGGL(mega_fwd, dim3(grid), dim3(NTHR), LDS_BYTES, stream, p);
}
```

```cpp
#include <hip/hip_runtime.h>
#include <stdint.h>

#define D_MODEL 1024
#define BATCH 2
#define SEQ 8192
#define DEC_BATCH 128
#define DEC_SEQ 4
#define PAST_LEN 8192
#define HEAD_DIM 64
#define ATT_WIDTH 512
#define ATT_HEADS 8
#define SSD_WIDTH 1536
#define SSD_HEADS 24
#define SSD_GROUPS 4
#define SSD_STATE 128
#define CONV_DIM 2560
#define IN_WIDTH 5656
#define PROJ_LD 5888
#define MIX_WIDTH 2048
#define WBUF 2048
#define PEER_NKEYS 128
#define PEER_HEADS 8
#define PEER_TOPK 16
#define PEER_DKEY 256
#define T_PROMPT (BATCH * SEQ)
#define T_SAMPLE (DEC_BATCH * DEC_SEQ)
#define T_ALL (T_PROMPT + T_SAMPLE)
#define O_Z 0
#define O_XBC 1536
#define O_DT 4096
#define O_Q 4120
#define O_K 4632
#define O_V 5144
#define ALPHA_F 1.189207115002721f
#define LN_EPS 1e-5f

#define OUT_YP 0ull
#define OUT_YS (OUT_YP + 16777216ull)
#define OUT_PK (OUT_YS + 524288ull)
#define OUT_PV (OUT_PK + 2097152ull)
#define OUT_PC (OUT_PV + 2097152ull)
#define OUT_PS (OUT_PC + 15360ull)
#define OUT_SK (OUT_PS + 393216ull)
#define OUT_SV (OUT_SK + 134217728ull)
#define OUT_SC (OUT_SV + 134217728ull)
#define OUT_SS (OUT_SC + 983040ull)

__constant__ double ROPE_INV_REV[32] = {
    1.59154943091895346e-01, 1.19349370211248862e-01, 8.94994016088910133e-02, 6.71150830052272551e-02,
    5.03292121044870353e-02, 3.77415847174197711e-02, 2.83021958306233987e-02, 2.12236527647776604e-02,
    1.59154943091895339e-02, 1.19349370211248862e-02, 8.94994016088910237e-03, 6.71150830052272534e-03,
    5.03292121044870370e-03, 3.77415847174197719e-03, 2.83021958306233987e-03, 2.12236527647776622e-03,
    1.59154943091895356e-03, 1.19349370211248849e-03, 8.94994016088910237e-04, 6.71150830052272599e-04,
    5.03292121044870326e-04, 3.77415847174197741e-04, 2.83021958306233954e-04, 2.12236527647776605e-04,
    1.59154943091895351e-04, 1.19349370211248862e-04, 8.94994016088910182e-05, 6.71150830052272545e-05,
    5.03292121044870354e-05, 3.77415847174197768e-05, 2.83021958306233961e-05, 2.12236527647776592e-05
};

__device__ __forceinline__ float silu_f(float x) { return x * __builtin_amdgcn_rcpf(1.0f + __expf(-x)); }
__device__ __forceinline__ float softplus_f(float x) { return fmaxf(x, 0.f) + log1pf(__expf(-fabsf(x))); }
__device__ __forceinline__ float gelu_f(float x) { return 0.5f * x * (1.0f + erff(x * 0.70710678118654752f)); }
__device__ __forceinline__ float wave_sum(float v) {
#pragma unroll
    for (int o = 32; o > 0; o >>= 1) v += __shfl_xor(v, o);
    return v;
}
__device__ __forceinline__ float wave_max(float v) {
#pragma unroll
    for (int o = 32; o > 0; o >>= 1) v = fmaxf(v, __shfl_xor(v, o));
    return v;
}

#include <cstdio>
#define XB_TMO      128
#define XB_XCNT(j)  (256  + 64 * (j))
#define XB_XSUB(j)  (1280 + 64 * (j))
#define XB_XGEN(j)  (2304 + 64 * (j))
#define XB_TOP      3328
#define XB_TOPGEN   3392
#define XCD_BAR_WORDS 3456
#define XB_SPIN_CAP (1u << 18)
#define LAS __attribute__((address_space(3)))

__device__ __forceinline__ unsigned xb_ld(unsigned* p)              { return __hip_atomic_load(p, __ATOMIC_RELAXED, __HIP_MEMORY_SCOPE_AGENT); }
__device__ __forceinline__ unsigned xb_add(unsigned* p, unsigned v) { return __hip_atomic_fetch_add(p, v, __ATOMIC_RELAXED, __HIP_MEMORY_SCOPE_AGENT); }
__device__ __forceinline__ unsigned xb_xcc_id() { return (unsigned)__builtin_amdgcn_s_getreg((3 << 11) | 20) & 0xFu; }
#define XB_SPIN(cond, bar) do { unsigned _sp = 0; while (cond) { __builtin_amdgcn_s_sleep(1); \
    if ((++_sp & 255u) == 0u) { if (xb_ld(&(bar)[XB_TMO])) break; if (_sp > XB_SPIN_CAP) { atomicAdd(&(bar)[XB_TMO], 1u); break; } } } } while (0)

struct XcdBarrier {
    unsigned* bar; unsigned x;
    volatile LAS unsigned* st;
};

__device__ __forceinline__ XcdBarrier xcd_barrier_post(unsigned* bar, volatile LAS unsigned* st) {
    XcdBarrier b; b.bar = bar; b.x = xb_xcc_id(); b.st = st;
    if (threadIdx.x == 0) (void)xb_add(&bar[XB_XCNT(b.x)], 1u);
    return b;
}
__device__ __forceinline__ void xcd_barrier_complete(unsigned* bar, unsigned x, unsigned& nloc, unsigned& nx) {
    const unsigned G = gridDim.x * gridDim.y * gridDim.z;
    unsigned sum, cnt, mine, sp = 0u;
    for (;;) {
        sum = 0u; cnt = 0u; mine = 0u;
#pragma unroll
        for (unsigned j = 0; j < 16; ++j) { const unsigned c = xb_ld(&bar[XB_XCNT(j)]); sum += c; cnt += (c > 0u) ? 1u : 0u; mine = (j == x) ? c : mine; }
        if (sum == G) break;
        __builtin_amdgcn_s_sleep(1);
        if ((++sp & 255u) == 0u) { if (xb_ld(&bar[XB_TMO])) break; if (sp > XB_SPIN_CAP) { atomicAdd(&bar[XB_TMO], 1u); break; } }
    }
    nloc = mine > 0u ? mine : 1u; nx = cnt > 0u ? cnt : 1u;
}

__device__ __forceinline__ void xcd_barrier(const XcdBarrier& b) {
    asm volatile("s_waitcnt vmcnt(0)" ::: "memory");
    __syncthreads();
    if (threadIdx.x == 0) {
        unsigned* bar = b.bar;
        __builtin_amdgcn_s_waitcnt(0);
        unsigned nloc = b.st[0], nx = b.st[1];
        if (nloc == 0u) { xcd_barrier_complete(bar, b.x, nloc, nx); b.st[0] = nloc; b.st[1] = nx; }
        const unsigned old = xb_add(&bar[XB_XSUB(b.x)], 1u);
        const unsigned gen = old / nloc;
        if (old + 1u == (gen + 1u) * nloc) {
            __builtin_amdgcn_fence(__ATOMIC_RELEASE, "agent");
            asm volatile("s_waitcnt vmcnt(0)" ::: "memory");
            const unsigned og = xb_add(&bar[XB_TOP], 1u);
            const unsigned tg = og / nx;
            if (og + 1u == (tg + 1u) * nx) xb_add(&bar[XB_TOPGEN], 1u);
            else XB_SPIN(xb_ld(&bar[XB_TOPGEN]) == tg, bar);
            __builtin_amdgcn_fence(__ATOMIC_ACQUIRE, "agent");
            xb_add(&bar[XB_XGEN(b.x)], 1u);
            asm volatile("s_waitcnt vmcnt(0)" ::: "memory");
        } else {
            XB_SPIN(xb_ld(&bar[XB_XGEN(b.x)]) == gen, bar);
            __builtin_amdgcn_fence(__ATOMIC_ACQUIRE, "agent");
            asm volatile("s_waitcnt vmcnt(0)" ::: "memory");
        }
    }
    __syncthreads();
}


#define GAS __attribute__((address_space(1)))
typedef unsigned short bf16;
typedef unsigned v4u __attribute__((ext_vector_type(4)));
#define LDS_WAIT() asm volatile("s_waitcnt lgkmcnt(0)" ::: "memory")
__device__ __forceinline__ unsigned f2bf(float f) { unsigned u = __builtin_bit_cast(unsigned, f); return (u + 0x7fffu + ((u >> 16) & 1u)) >> 16; }
__device__ __forceinline__ unsigned pk2(float lo, float hi) { return f2bf(lo) | (f2bf(hi) << 16); }
__device__ __forceinline__ float bf2f(unsigned short b) { return __builtin_bit_cast(float, (unsigned)b << 16); }
#include <hip/hip_runtime.h>
namespace pg8 {
#define PG8_LAS __attribute__((address_space(3)))
typedef unsigned short bf16_t;
typedef short bf16x8 __attribute__((ext_vector_type(8)));
typedef float f32x4 __attribute__((ext_vector_type(4)));
typedef unsigned u32x4 __attribute__((ext_vector_type(4)));
constexpr int BM = 256, BK = 64, HALF = 128, HTB = HALF * BK * 2  , STAGE_BYTES = 8 * HTB, NXCD = 8, WGM = 8;

__host__ __device__ __forceinline__ int lds_byte(int r, int c) { const int st = (r >> 4) * 2 + (c >> 5), rr = r & 15, cc = c & 31, ob = rr * 64 + cc * 2; return st * 1024 + (ob ^ (((ob >> 9) & 1) << 5)); }
__host__ __device__ __forceinline__ void stage_rc(int b, int& R, int& C) { const int st = b / 1024, sb = b % 1024, swz = sb ^ (((sb >> 9) & 1) << 5); R = (st >> 1) * 16 + swz / 64; C = (st & 1) * 32 + (swz % 64) / 2; }
__host__ __device__ __forceinline__ int perm32(int rho) { const int n = rho >> 4, i = rho & 15; return 8 * (i >> 2) + 4 * n + (i & 3); }

struct Unit { int pm, pn; };
struct Gemm { const bf16_t* A; const bf16_t* Bt; int M, N, K; };

struct StaticOrder {
    int nM, nN, nwg, G, c;
    __host__ __device__ void init(int M, int N, int G_, int c_) { nM = M / BM; nN = N / BM; nwg = nM * nN; G = G_; c = c_; }
    __host__ __device__ bool next(int i, Unit& u) const {
        const long L = (long)i * G + c; if (L >= nwg) return false;
        int wgid = (int)L; { const int q = nwg / NXCD, r = nwg % NXCD, xcd = wgid % NXCD, off = wgid / NXCD; wgid = (xcd < r ? xcd * (q + 1) : r * (q + 1) + (xcd - r) * q) + off; }
        const int nig = WGM * nN, gid = wgid / nig, fm = gid * WGM, gsz = (nM - fm) < WGM ? (nM - fm) : WGM;
        u.pm = fm + ((wgid % nig) % gsz); u.pn = (wgid % nig) / gsz; return true;
    }
    __device__ __forceinline__ void a_ready(const Unit&) const {}
    __device__ __forceinline__ void done(const Unit&) const {}
};
__device__ __forceinline__ unsigned cvt_pk_bf16(float lo, float hi) { unsigned r; asm volatile("v_cvt_pk_bf16_f32 %0, %1, %2" : "=v"(r) : "v"(lo), "v"(hi)); return r; }
typedef float f32x2 __attribute__((ext_vector_type(2)));
__device__ __forceinline__ f32x2 gelu_pk(f32x2 v) {
    const f32x2 av = __builtin_elementwise_abs(v), d = av * 0.2316418882f + 1.0f;
    f32x2 t; t.x = __builtin_amdgcn_rcpf(d.x); t.y = __builtin_amdgcn_rcpf(d.y);
    f32x2 q = t * 0.5307027145f + (-0.7265760135f); q = q * t + 0.7107068705f; q = q * t + (-0.142248368f); q = q * t + 0.127414796f; q = q * t;
    const f32x2 s = (v * v) * (-0.72134752044f);
    f32x2 e; e.x = __builtin_amdgcn_exp2f(s.x); e.y = __builtin_amdgcn_exp2f(s.y);
    const f32x2 m = v * (q * e), r = v - m;
    f32x2 o; o.x = v.x < 0.f ? m.x : r.x; o.y = v.y < 0.f ? m.y : r.y; return o;
}

struct EpiF32 {
    static constexpr bool PERM = false, AFTER_DRAIN = false;
    float* C; int ldc; const float* bias;
    __device__ __forceinline__ void operator()(const f32x4 (&acc)[2][2][4][2], const Unit& u, int wr, int wc, int fr, int fq) const {
        const int row0 = u.pm * BM + wr * 64 + fr, col0 = u.pn * BM + wc * 32 + 4 * fq;
        f32x4 bv[2][2];
#pragma unroll
        for (int bj = 0; bj < 2; ++bj)
#pragma unroll
            for (int n = 0; n < 2; ++n) bv[bj][n] = bias ? *(const f32x4*)(bias + col0 + bj * HALF + n * 16) : (f32x4){0.f, 0.f, 0.f, 0.f};
#pragma unroll
        for (int ai = 0; ai < 2; ++ai)
#pragma unroll
            for (int m = 0; m < 4; ++m) { float* rowp = C + (size_t)(row0 + ai * HALF + m * 16) * ldc + col0;
#pragma unroll
                for (int bj = 0; bj < 2; ++bj)
#pragma unroll
                    for (int n = 0; n < 2; ++n) *(f32x4*)(rowp + bj * HALF + n * 16) = acc[ai][bj][m][n] + bv[bj][n]; }
    }
};

template <class Epi, class Sched, bool STAMP = false>
__device__ __forceinline__ void gemm_phase(PG8_LAS unsigned char* lds, const Gemm g, const Sched& S, const Epi& E, unsigned long long* stamps) {
    int tid = threadIdx.x; asm volatile("" : "+v"(tid));
    const int wid = __builtin_amdgcn_readfirstlane(tid >> 6), lane = tid & 63, wr = wid >> 2, wc = wid & 3, fr = lane & 15, fq = lane >> 4;
    const int K = g.K, nt = K / BK;
    int ts_lo = 0, ts_hi = 0, nts = 0; const unsigned long long rt_entry = STAMP ? (unsigned long long)wall_clock64() : 0ull;
#define PG8_STAMP() do { if (STAMP && wid == 0 && nts < 64) { const unsigned long long _c = (unsigned long long)clock64(); \
        ts_lo = (lane == nts) ? (int)(unsigned)_c : ts_lo; ts_hi = (lane == nts) ? (int)(unsigned)(_c >> 32) : ts_hi; ++nts; } } while (0)
    PG8_STAMP();
    unsigned voffA[2], voffB[2];
#pragma unroll
    for (int i = 0; i < 2; ++i) { int R, C; stage_rc(tid * 16 + i * 8192, R, C); const int Rb = Epi::PERM ? ((R & ~31) + perm32(R & 31)) : R;
        voffA[i] = (unsigned)(R * K + C) * 2u; voffB[i] = (unsigned)(Rb * K + C) * 2u; }
    const size_t kstep = (size_t)(BK * 2);
    const size_t hstep = (size_t)HALF * K * 2;
    const size_t tstep = 2 * hstep;
    const unsigned ldsw = (unsigned)wid * 1024u;
    const int aoff = lds_byte(wr * 64 + fr, fq * 8), boff = lds_byte(wc * 32 + fr, fq * 8);
#define PG8_SA(b, h) (((b) * 2 + (h)) * HTB)
#define PG8_SB(b, h) ((4 + (b) * 2 + (h)) * HTB)
#define PG8_STAGE(bufoff, gbase, voff) do { _Pragma("unroll") for (int _i = 0; _i < 2; ++_i) \
        __builtin_amdgcn_global_load_lds((const unsigned*)((const char*)(gbase) + (voff)[_i]), (PG8_LAS unsigned*)(lds + (bufoff) + ldsw + _i * 8192), 16, 0, 0); } while (0)
#define PG8_LDA(dst, b, h) do { _Pragma("unroll") for (int m = 0; m < 4; ++m) _Pragma("unroll") for (int k = 0; k < 2; ++k) dst[m][k] = *(const PG8_LAS bf16x8*)(lds + PG8_SA(b, h) + aoff + m * 2048 + k * 1024); } while (0)
#define PG8_LDB(dst, b, h) do { _Pragma("unroll") for (int n = 0; n < 2; ++n) _Pragma("unroll") for (int k = 0; k < 2; ++k) dst[n][k] = *(const PG8_LAS bf16x8*)(lds + PG8_SB(b, h) + boff + n * 2048 + k * 1024); } while (0)
#define PG8_MMA(ai, bj, At, Bt) do { __builtin_amdgcn_s_setprio(1); _Pragma("unroll") for (int m = 0; m < 4; ++m) _Pragma("unroll") for (int n = 0; n < 2; ++n) _Pragma("unroll") for (int k = 0; k < 2; ++k) \
        acc[ai][bj][m][n] = __builtin_amdgcn_mfma_f32_16x16x32_bf16(Bt[n][k], At[m][k], acc[ai][bj][m][n], 0, 0, 0); __builtin_amdgcn_s_setprio(0); } while (0)
#define PG8_WAIT_V(n) asm volatile("s_waitcnt vmcnt(" #n ")" ::: "memory")
#define PG8_WAIT_L(n) asm volatile("s_waitcnt lgkmcnt(" #n ")" ::: "memory")
#define PG8_BAR __builtin_amdgcn_s_barrier()
#define PG8_SCHED __builtin_amdgcn_sched_barrier(0)
    Unit cur, nxt; int ui = 0;
    if (!S.next(0, cur)) return;
    f32x4 acc[2][2][4][2];
#pragma unroll
    for (int a = 0; a < 2; ++a)
#pragma unroll
        for (int b = 0; b < 2; ++b)
#pragma unroll
            for (int m = 0; m < 4; ++m)
#pragma unroll
                for (int n = 0; n < 2; ++n) acc[a][b][m][n] = (f32x4){0.f, 0.f, 0.f, 0.f};
    bf16x8 At[4][2], B0[2][2], B1[2][2];
    const char* cA = (const char*)g.A + (size_t)cur.pm * tstep; const char* cB = (const char*)g.Bt + (size_t)cur.pn * tstep;
    S.a_ready(cur);
    PG8_STAGE(PG8_SB(0, 0), cB, voffB); PG8_STAGE(PG8_SA(0, 0), cA, voffA); PG8_STAGE(PG8_SB(0, 1), cB + hstep, voffB); PG8_STAGE(PG8_SA(0, 1), cA + hstep, voffA);
    if (wr == 1) PG8_BAR;
    PG8_WAIT_V(4); PG8_BAR;
    PG8_STAGE(PG8_SB(1, 0), cB + kstep, voffB); PG8_STAGE(PG8_SA(1, 0), cA + kstep, voffA); PG8_STAGE(PG8_SB(1, 1), cB + hstep + kstep, voffB);
    PG8_WAIT_V(6); PG8_BAR;
    PG8_STAMP();
    for (;;) {
        const bool has_next = S.next(ui + 1, nxt);
        const char* nA = has_next ? (const char*)g.A + (size_t)nxt.pm * tstep : cA; const char* nB = has_next ? (const char*)g.Bt + (size_t)nxt.pn * tstep : cB;
        for (int t = 0; t < nt; t += 2) {
            const bool last = (t == nt - 2);
            const char* a1 = cA + (size_t)(t + 1) * kstep;
            const char* a2 = last ? nA : cA + (size_t)(t + 2) * kstep; const char* b2 = last ? nB : cB + (size_t)(t + 2) * kstep;
            const char* a3 = a2 + kstep; const char* b3 = b2 + kstep;
            if (last && has_next) S.a_ready(nxt);
            PG8_LDB(B0, 0, 0); PG8_SCHED; PG8_LDA(At, 0, 0); PG8_STAGE(PG8_SA(1, 1), a1 + hstep, voffA);
            PG8_WAIT_L(8); PG8_BAR; PG8_WAIT_L(0); PG8_MMA(0, 0, At, B0); PG8_BAR; PG8_SCHED;
            PG8_LDB(B1, 0, 1); PG8_STAGE(PG8_SB(0, 0), b2, voffB);
            PG8_BAR; PG8_WAIT_L(0); PG8_MMA(0, 1, At, B1); PG8_BAR;
            PG8_LDA(At, 0, 1); PG8_STAGE(PG8_SA(0, 0), a2, voffA);
            PG8_BAR; PG8_WAIT_L(0); PG8_MMA(1, 0, At, B0); PG8_BAR; PG8_SCHED;
            PG8_STAGE(PG8_SB(0, 1), b2 + hstep, voffB);
            PG8_WAIT_V(6); PG8_BAR; PG8_MMA(1, 1, At, B1); PG8_BAR;
            PG8_LDB(B0, 1, 0); PG8_SCHED; PG8_LDA(At, 1, 0); PG8_STAGE(PG8_SA(0, 1), a2 + hstep, voffA);
            PG8_WAIT_L(8); PG8_BAR; PG8_WAIT_L(0); PG8_MMA(0, 0, At, B0); PG8_BAR; PG8_SCHED;
            PG8_LDB(B1, 1, 1); PG8_STAGE(PG8_SB(1, 0), b3, voffB);
            PG8_BAR; PG8_WAIT_L(0); PG8_MMA(0, 1, At, B1); PG8_BAR;
            PG8_LDA(At, 1, 1); PG8_STAGE(PG8_SA(1, 0), a3, voffA);
            PG8_BAR; PG8_WAIT_L(0); PG8_MMA(1, 0, At, B0); PG8_BAR; PG8_SCHED;
            PG8_STAGE(PG8_SB(1, 1), b3 + hstep, voffB);
            PG8_WAIT_V(6); PG8_BAR; PG8_MMA(1, 1, At, B1); PG8_BAR;
        }
        PG8_STAMP();
        if constexpr (!Epi::AFTER_DRAIN) { E(acc, cur, wr, wc, fr, fq); S.done(cur); }
        PG8_STAMP();
        if (!has_next) break;
#pragma unroll
        for (int a = 0; a < 2; ++a)
#pragma unroll
            for (int b = 0; b < 2; ++b)
#pragma unroll
                for (int m = 0; m < 4; ++m)
#pragma unroll
                    for (int n = 0; n < 2; ++n) acc[a][b][m][n] = (f32x4){0.f, 0.f, 0.f, 0.f};
        cur = nxt; cA = nA; cB = nB; ++ui;
    }
    PG8_WAIT_V(0);
    if (wr == 0) PG8_BAR;
    PG8_BAR;
    if constexpr (Epi::AFTER_DRAIN) { E.fused(acc, cur, wr, wc, fr, fq, lds, wid, lane); S.done(cur); }
    PG8_STAMP();
    if (STAMP && wid == 0) { stamps[lane] = lane < nts ? (((unsigned long long)(unsigned)ts_hi << 32) | (unsigned)ts_lo) : 0ull;
        if (lane == 62) stamps[62] = rt_entry; if (lane == 63) stamps[63] = (unsigned long long)wall_clock64(); }
#undef PG8_STAMP
#undef PG8_SA
#undef PG8_SB
#undef PG8_STAGE
#undef PG8_LDA
#undef PG8_LDB
#undef PG8_MMA
#undef PG8_WAIT_V
#undef PG8_WAIT_L
#undef PG8_BAR
#undef PG8_SCHED
}
}


namespace pg8 {
struct EpiProj {
    static constexpr bool PERM = true, AFTER_DRAIN = false;
    bf16_t* O; float* dtraw;
    __device__ __forceinline__ void operator()(const f32x4 (&acc)[2][2][4][2], const Unit& u, int wr, int wc, int fr, int fq) const {
        const int row0 = u.pm * BM + wr * 64 + fr;
        if (u.pn < 22) {
            const int col0 = u.pn * BM + wc * 32 + 8 * fq;
#pragma unroll
            for (int ai = 0; ai < 2; ++ai)
#pragma unroll
                for (int m = 0; m < 4; ++m) { bf16_t* rowp = O + (size_t)(row0 + ai * HALF + m * 16) * 5632 + col0;
#pragma unroll
                    for (int bj = 0; bj < 2; ++bj) { const f32x4 v0 = acc[ai][bj][m][0], v1 = acc[ai][bj][m][1];
                        u32x4 w; w.x = cvt_pk_bf16(v0[0], v0[1]); w.y = cvt_pk_bf16(v0[2], v0[3]); w.z = cvt_pk_bf16(v1[0], v1[1]); w.w = cvt_pk_bf16(v1[2], v1[3]);
                        *(u32x4*)(rowp + bj * HALF) = w; } }
        } else if (wc == 0) {
#pragma unroll
            for (int ai = 0; ai < 2; ++ai)
#pragma unroll
                for (int m = 0; m < 4; ++m) { float* rp = dtraw + (size_t)(row0 + ai * HALF + m * 16) * 32 + 8 * fq;
                    *(f32x4*)rp = acc[ai][0][m][0]; *(f32x4*)(rp + 4) = acc[ai][0][m][1]; }
        }
    }
};
}


namespace pg8 {
struct EpiBf16Plain {
    static constexpr bool PERM = true, AFTER_DRAIN = false;
    bf16_t* O; int ldc;
    __device__ __forceinline__ void operator()(const f32x4 (&acc)[2][2][4][2], const Unit& u, int wr, int wc, int fr, int fq) const {
        const int row0 = u.pm * BM + wr * 64 + fr, col0 = u.pn * BM + wc * 32 + 8 * fq;
#pragma unroll
        for (int ai = 0; ai < 2; ++ai)
#pragma unroll
            for (int m = 0; m < 4; ++m) { bf16_t* rowp = O + (size_t)(row0 + ai * HALF + m * 16) * ldc + col0;
#pragma unroll
                for (int bj = 0; bj < 2; ++bj) { const f32x4 v0 = acc[ai][bj][m][0], v1 = acc[ai][bj][m][1];
                    u32x4 w; w.x = cvt_pk_bf16(v0[0], v0[1]); w.y = cvt_pk_bf16(v0[2], v0[3]); w.z = cvt_pk_bf16(v1[0], v1[1]); w.w = cvt_pk_bf16(v1[2], v1[3]);
                    *(u32x4*)(rowp + bj * HALF) = w; } }
    }
};
}

#define NTHR 512
#define NWAVE 8

__device__ __forceinline__ void ph_gemm_f32(float* lds, const float* __restrict__ A, const float* __restrict__ B, float* __restrict__ C,
                                            int M, int N, int K, int lda, int ldb, int ldc) {
    const int tid = threadIdx.x & 255, half = threadIdx.x >> 8, tx = tid & 15, ty = tid >> 4;
    float (*As)[68] = (float (*)[68])(lds + half * 2 * 16 * 68);
    float (*Bs)[68] = (float (*)[68])(lds + half * 2 * 16 * 68 + 16 * 68);
    const int ntx = (N + 63) / 64, nty = M / 64, ntiles = ntx * nty;
    for (int it = blockIdx.x; 2 * it < ntiles; it += gridDim.x) {
        const int tile = 2 * it + half;
        const int m0 = (tile / ntx) * 64, n0 = (tile % ntx) * 64;
        float acc[4][4];
#pragma unroll
        for (int i = 0; i < 4; ++i)
#pragma unroll
            for (int j = 0; j < 4; ++j) acc[i][j] = 0.f;
        for (int k0 = 0; k0 < K; k0 += 16) {
#pragma unroll
            for (int i = 0; i < 4; ++i) {
                int idx = tid + i * 256;
                int r = idx >> 4, c = idx & 15;
                As[c][r] = (m0 + r < M) ? A[(size_t)(m0 + r) * lda + k0 + c] : 0.f;
                int rb = idx >> 6, cb = idx & 63;
                Bs[rb][cb] = (n0 + cb < N) ? B[(size_t)(k0 + rb) * ldb + n0 + cb] : 0.f;
            }
            __syncthreads();
#pragma unroll
            for (int k = 0; k < 16; ++k) {
                float a[4], b[4];
#pragma unroll
                for (int i = 0; i < 4; ++i) { a[i] = As[k][ty * 4 + i]; b[i] = Bs[k][tx * 4 + i]; }
#pragma unroll
                for (int i = 0; i < 4; ++i)
#pragma unroll
                    for (int j = 0; j < 4; ++j) acc[i][j] += a[i] * b[j];
            }
            __syncthreads();
        }
#pragma unroll
        for (int i = 0; i < 4; ++i)
#pragma unroll
            for (int j = 0; j < 4; ++j) {
                int r = m0 + ty * 4 + i, c = n0 + tx * 4 + j;
                if (r < M && c < N) C[(size_t)r * ldc + c] = acc[i][j];
            }
    }
}


template <int MODE>
__device__ __forceinline__ void transpose_item(const float* __restrict__ W, int K, int N, int Npad, bf16* __restrict__ WT, LAS float* scr, int item, int lane) {
    const int nblk = Npad / 32, kb = item / nblk, nb = item % nblk, k0 = 64 * kb, n0 = 32 * nb;
    const int n = n0 + (lane & 31);
    int sc = n;
    if (MODE == 1) sc = (n < 4096) ? n : (n < 5632 ? n + 24 : (n < 5656 ? n - 5632 + 4096 : -1));
    else sc = (n < N) ? n : -1;
#pragma unroll 8
    for (int i = 0; i < 32; ++i) { const int kk = 2 * i + (lane >> 5); scr[kk * 33 + (lane & 31)] = (sc >= 0) ? W[(size_t)(k0 + kk) * N + sc] : 0.f; }
    LDS_WAIT(); asm volatile("" ::: "memory");
    const int c = lane & 7;
#pragma unroll
    for (int j = 0; j < 4; ++j) { const int nn = (lane >> 3) + 8 * j; const LAS float* s = scr + (8 * c) * 33 + nn;
        v4u o; o.x = pk2(s[0 * 33], s[1 * 33]); o.y = pk2(s[2 * 33], s[3 * 33]); o.z = pk2(s[4 * 33], s[5 * 33]); o.w = pk2(s[6 * 33], s[7 * 33]);
        *(v4u*)(WT + (size_t)(n0 + nn) * K + k0 + 8 * c) = o; }
    LDS_WAIT(); asm volatile("" ::: "memory");
}
__device__ __forceinline__ void ph_prologue(LAS unsigned char* ldsb, const float* __restrict__ xp, const float* __restrict__ xs, bf16* __restrict__ A0,
                                            const float* __restrict__ w_in, bf16* __restrict__ wt_in, float* __restrict__ rope_tab) {
    const int lane = threadIdx.x & 63, wave = threadIdx.x >> 6;
    LAS float* scr = (LAS float*)(ldsb + wave * 16384);
    const int gw = blockIdx.x * NWAVE + wave, NGW = gridDim.x * NWAVE;
    constexpr int I_IN = (D_MODEL / 64) * (PROJ_LD / 32);
    for (int it = gw; it < I_IN; it += NGW) transpose_item<1>(w_in, D_MODEL, IN_WIDTH, PROJ_LD, wt_in, scr, it, lane);
    for (int idx = blockIdx.x * NTHR + threadIdx.x; idx < SEQ * 32; idx += gridDim.x * NTHR) {
        const int pos = idx >> 5, j = idx & 31;
        const double rev = (double)pos * ROPE_INV_REV[j];
        const float fr = (float)(rev - floor(rev));
        rope_tab[(size_t)pos * 64 + j] = __builtin_amdgcn_cosf(fr); rope_tab[(size_t)pos * 64 + 32 + j] = __builtin_amdgcn_sinf(fr);
    }
    const size_t n8 = (size_t)T_ALL * D_MODEL / 8, np8 = (size_t)T_PROMPT * D_MODEL / 8;
#pragma unroll 4
    for (size_t i = (size_t)blockIdx.x * NTHR + threadIdx.x; i < n8; i += (size_t)gridDim.x * NTHR) {
        const float4* s = (i < np8) ? (const float4*)xp + 2 * i : (const float4*)xs + 2 * (i - np8);
        float4 a = s[0], b = s[1];
        v4u o; o.x = pk2(a.x, a.y); o.y = pk2(a.z, a.w); o.z = pk2(b.x, b.y); o.w = pk2(b.z, b.w);
        ((v4u*)A0)[i] = o;
    }
}
__device__ __forceinline__ void ph_prologue2(LAS unsigned char* ldsb, const float* __restrict__ w_out, bf16* __restrict__ wt_out, const float* __restrict__ w_q, bf16* __restrict__ wt_q,
                                             int rank, int nranks) {
    const int lane = threadIdx.x & 63, wave = threadIdx.x >> 6;
    LAS float* scr = (LAS float*)(ldsb + wave * 16384);
    constexpr int I_OUT = (MIX_WIDTH / 64) * (D_MODEL / 32), I_Q = (D_MODEL / 64) * (2048 / 32);
    for (int it = rank * NWAVE + wave; it < I_OUT + I_Q; it += nranks * NWAVE) {
        if (it < I_OUT) transpose_item<0>(w_out, MIX_WIDTH, D_MODEL, D_MODEL, wt_out, scr, it, lane);
        else transpose_item<0>(w_q, D_MODEL, 2048, 2048, wt_q, scr, it - I_OUT, lane);
    }
}

__device__ __forceinline__ void ph_concat_x(const float* __restrict__ xp, const float* __restrict__ xs, float* __restrict__ xall) {
    const size_t n4 = (size_t)T_ALL * D_MODEL / 4, np4 = (size_t)T_PROMPT * D_MODEL / 4;
    for (size_t i = (size_t)blockIdx.x * NTHR + threadIdx.x; i < n4; i += (size_t)gridDim.x * NTHR) {
        float4 v = (i < np4) ? ((const float4*)xp)[i] : ((const float4*)xs)[i - np4];
        ((float4*)xall)[i] = v;
    }
}

typedef float f32x4n __attribute__((ext_vector_type(4)));
__device__ __forceinline__ void ph_cache_copy(const float* __restrict__ ck, const float* __restrict__ cv, float* __restrict__ out) {
    constexpr unsigned PER_B = (WBUF - DEC_SEQ) * ATT_WIDTH / 4;
    constexpr unsigned TOTAL = 2u * DEC_BATCH * PER_B;
    for (unsigned c = blockIdx.x; c < TOTAL / 4096u; c += gridDim.x) {
        f32x4n v[8]; size_t dsti[8]; bool isv[8];
#pragma unroll
        for (int j = 0; j < 8; ++j) {
            const unsigned idx = c * 4096u + j * 512u + threadIdx.x;
            const unsigned tb = idx / PER_B, r = idx - tb * PER_B, bb = tb & (DEC_BATCH - 1);
            isv[j] = tb >= DEC_BATCH;
            const size_t srci = (size_t)bb * (WBUF * ATT_WIDTH / 4) + (DEC_SEQ * ATT_WIDTH / 4) + r;
            dsti[j] = (size_t)bb * (WBUF * ATT_WIDTH / 4) + r;
            v[j] = __builtin_nontemporal_load((isv[j] ? (const f32x4n*)cv : (const f32x4n*)ck) + srci);
        }
#pragma unroll
        for (int j = 0; j < 8; ++j) __builtin_nontemporal_store(v[j], (f32x4n*)(out + (isv[j] ? OUT_SV : OUT_SK)) + dsti[j]);
    }
}

__device__ __forceinline__ void ph_post_proj(const float* __restrict__ proj, const float* __restrict__ state_conv,
                                             const float* __restrict__ conv_w, const float* __restrict__ conv_b, const float* __restrict__ dt_bias,
                                             float* __restrict__ xbc_act, float* __restrict__ dtv, float* __restrict__ qrot, float* __restrict__ krot,
                                             float* __restrict__ out) {
    const int tid = threadIdx.x & 255, half = threadIdx.x >> 8;
    for (int t = 2 * blockIdx.x + half; t < T_ALL; t += 2 * gridDim.x) {
        const bool is_p = t < T_PROMPT;
        int b, i, pos;
        if (is_p) { b = t / SEQ; i = t % SEQ; pos = i; } else { int ts = t - T_PROMPT; b = ts / DEC_SEQ; i = ts % DEC_SEQ; pos = PAST_LEN + i; }
        const float* row = proj + (size_t)t * PROJ_LD;
        for (int c = tid; c < CONV_DIM; c += 256) {
            float acc = conv_b[c];
#pragma unroll
            for (int tap = 0; tap < 4; ++tap) {
                int r = i - 3 + tap;
                float val;
                if (r >= 0) val = proj[(size_t)(t - i + r) * PROJ_LD + O_XBC + c];
                else val = is_p ? 0.f : state_conv[((size_t)b * 3 + (3 + r)) * CONV_DIM + c];
                acc += val * conv_w[tap * CONV_DIM + c];
            }
            xbc_act[(size_t)t * CONV_DIM + c] = silu_f(acc);
        }
        if (tid < SSD_HEADS) dtv[(size_t)t * SSD_HEADS + tid] = softplus_f(row[O_DT + tid] + dt_bias[tid]);
        for (int idx = tid; idx < 512; idx += 256) {
            int which = idx >> 8, h = (idx >> 5) & 7, j = idx & 31;
            double rev = (double)pos * ROPE_INV_REV[j];
            float fr = (float)(rev - floor(rev));
            float sn = __builtin_amdgcn_sinf(fr), cs = __builtin_amdgcn_cosf(fr);
            const float* src = row + (which ? O_K : O_Q) + h * 64;
            float t1 = src[j], t2 = src[j + 32];
            float o1 = t1 * cs - t2 * sn, o2 = t2 * cs + t1 * sn;
            float* dst = (which ? krot : qrot) + (size_t)t * ATT_WIDTH + h * 64;
            dst[j] = o1; dst[j + 32] = o2;
            if (which) {
                if (is_p) { if (i >= SEQ - WBUF) { float* o = out + OUT_PK + ((size_t)b * WBUF + (i - (SEQ - WBUF))) * ATT_WIDTH + h * 64; o[j] = o1; o[j + 32] = o2; } }
                else { float* o = out + OUT_SK + ((size_t)b * WBUF + (WBUF - DEC_SEQ + i)) * ATT_WIDTH + h * 64; o[j] = o1; o[j + 32] = o2; }
            }
        }
        for (int c = tid; c < ATT_WIDTH; c += 256) {
            float v = row[O_V + c];
            if (is_p) { if (i >= SEQ - WBUF) out[OUT_PV + ((size_t)b * WBUF + (i - (SEQ - WBUF))) * ATT_WIDTH + c] = v; }
            else out[OUT_SV + ((size_t)b * WBUF + (WBUF - DEC_SEQ + i)) * ATT_WIDTH + c] = v;
        }
        if (is_p) {
            if (i >= SEQ - 3) { int r = i - (SEQ - 3); for (int c = tid; c < CONV_DIM; c += 256) out[OUT_PC + ((size_t)b * 3 + r) * CONV_DIM + c] = row[O_XBC + c]; }
        } else {
            if (i >= 1) { int r = i - 1; for (int c = tid; c < CONV_DIM; c += 256) out[OUT_SC + ((size_t)b * 3 + r) * CONV_DIM + c] = row[O_XBC + c]; }
        }
    }
}


#define NB_LD 5632
#define NB_XBC 1536
#define NB_Q 4096
#define NB_K 4608
#define NB_V 5120
__device__ __forceinline__ void unpack8(const v4u w, float (&f)[8]) {
    f[0] = __builtin_bit_cast(float, w.x << 16); f[1] = __builtin_bit_cast(float, w.x & 0xffff0000u);
    f[2] = __builtin_bit_cast(float, w.y << 16); f[3] = __builtin_bit_cast(float, w.y & 0xffff0000u);
    f[4] = __builtin_bit_cast(float, w.z << 16); f[5] = __builtin_bit_cast(float, w.z & 0xffff0000u);
    f[6] = __builtin_bit_cast(float, w.w << 16); f[7] = __builtin_bit_cast(float, w.w & 0xffff0000u);
}
__device__ __forceinline__ void store8f(float* d, const float (&f)[8]) { *(float4*)d = make_float4(f[0], f[1], f[2], f[3]); *(float4*)(d + 4) = make_float4(f[4], f[5], f[6], f[7]); }
__device__ __forceinline__ void ph_post_proj2(const bf16* __restrict__ projb, const float* __restrict__ dtraw, const float* __restrict__ state_conv,
                                              const float* __restrict__ conv_w, const float* __restrict__ conv_b, const float* __restrict__ dt_bias,
                                              bf16* __restrict__ xbc_b, float* __restrict__ dtv, bf16* __restrict__ qrot_b, bf16* __restrict__ krot_b,
                                              float* __restrict__ out) {
    const int tid = threadIdx.x & 255, half = threadIdx.x >> 8;
    for (int t = T_PROMPT + 2 * blockIdx.x + half; t < T_ALL; t += 2 * gridDim.x) {
        const bool is_p = t < T_PROMPT;
        int b, i, pos;
        if (is_p) { b = t / SEQ; i = t % SEQ; pos = i; } else { int ts = t - T_PROMPT; b = ts / DEC_SEQ; i = ts % DEC_SEQ; pos = PAST_LEN + i; }
        const bf16* row = projb + (size_t)t * NB_LD;
        if (tid < 64) {
            float f[8]; unpack8(*(const v4u*)(row + NB_V + tid * 8), f);
            if (is_p) { if (i >= SEQ - WBUF) store8f(out + OUT_PV + ((size_t)b * WBUF + (i - (SEQ - WBUF))) * ATT_WIDTH + tid * 8, f); }
            else store8f(out + OUT_SV + ((size_t)b * WBUF + (WBUF - DEC_SEQ + i)) * ATT_WIDTH + tid * 8, f);
        }
        for (int c8 = tid; c8 < 320; c8 += 256) {
            const int c = c8 * 8;
            float acc[8], cur[8];
            { const float4 b0 = *(const float4*)(conv_b + c), b1 = *(const float4*)(conv_b + c + 4);
              acc[0] = b0.x; acc[1] = b0.y; acc[2] = b0.z; acc[3] = b0.w; acc[4] = b1.x; acc[5] = b1.y; acc[6] = b1.z; acc[7] = b1.w; }
#pragma unroll
            for (int tap = 0; tap < 4; ++tap) {
                const int r = i - 3 + tap;
                float val[8];
                if (r >= 0) unpack8(*(const v4u*)(projb + (size_t)(t - i + r) * NB_LD + NB_XBC + c), val);
                else if (!is_p) { const float* sp = state_conv + ((size_t)b * 3 + (3 + r)) * CONV_DIM + c; const float4 s0 = *(const float4*)sp, s1 = *(const float4*)(sp + 4);
                    val[0] = s0.x; val[1] = s0.y; val[2] = s0.z; val[3] = s0.w; val[4] = s1.x; val[5] = s1.y; val[6] = s1.z; val[7] = s1.w; }
                else {
#pragma unroll
                    for (int j = 0; j < 8; ++j) val[j] = 0.f; }
                const float4 w0 = *(const float4*)(conv_w + tap * CONV_DIM + c), w1 = *(const float4*)(conv_w + tap * CONV_DIM + c + 4);
                acc[0] += val[0] * w0.x; acc[1] += val[1] * w0.y; acc[2] += val[2] * w0.z; acc[3] += val[3] * w0.w;
                acc[4] += val[4] * w1.x; acc[5] += val[5] * w1.y; acc[6] += val[6] * w1.z; acc[7] += val[7] * w1.w;
                if (tap == 3) {
#pragma unroll
                    for (int j = 0; j < 8; ++j) cur[j] = val[j]; }
            }
#pragma unroll
            for (int j = 0; j < 8; ++j) acc[j] = silu_f(acc[j]);
            v4u o; o.x = pk2(acc[0], acc[1]); o.y = pk2(acc[2], acc[3]); o.z = pk2(acc[4], acc[5]); o.w = pk2(acc[6], acc[7]);
            *(v4u*)(xbc_b + (size_t)t * CONV_DIM + c) = o;
            if (is_p) { if (i >= SEQ - 3) store8f(out + OUT_PC + ((size_t)b * 3 + (i - (SEQ - 3))) * CONV_DIM + c, cur); }
            else { if (i >= 1) store8f(out + OUT_SC + ((size_t)b * 3 + (i - 1)) * CONV_DIM + c, cur); }
        }
        if (tid < SSD_HEADS) dtv[(size_t)t * SSD_HEADS + tid] = softplus_f(dtraw[(size_t)t * 32 + tid] + dt_bias[tid]);
        if (tid < 128) {
            const int which = tid >> 6, h = (tid >> 3) & 7, jc = tid & 7;
            const bf16* src = row + (which ? NB_K : NB_Q) + h * 64 + jc * 4;
            const uint2 lo = *(const uint2*)src, hi = *(const uint2*)(src + 32);
            float t1[4], t2[4], o1[4], o2[4];
            t1[0] = __builtin_bit_cast(float, lo.x << 16); t1[1] = __builtin_bit_cast(float, lo.x & 0xffff0000u); t1[2] = __builtin_bit_cast(float, lo.y << 16); t1[3] = __builtin_bit_cast(float, lo.y & 0xffff0000u);
            t2[0] = __builtin_bit_cast(float, hi.x << 16); t2[1] = __builtin_bit_cast(float, hi.x & 0xffff0000u); t2[2] = __builtin_bit_cast(float, hi.y << 16); t2[3] = __builtin_bit_cast(float, hi.y & 0xffff0000u);
#pragma unroll
            for (int e = 0; e < 4; ++e) {
                const double rev = (double)pos * ROPE_INV_REV[jc * 4 + e];
                const float fr = (float)(rev - floor(rev));
                const float sn = __builtin_amdgcn_sinf(fr), cs = __builtin_amdgcn_cosf(fr);
                o1[e] = t1[e] * cs - t2[e] * sn; o2[e] = t2[e] * cs + t1[e] * sn;
            }
            const size_t doff = (size_t)t * ATT_WIDTH + h * 64 + jc * 4;
            bf16* db = which ? krot_b : qrot_b;
            *(uint2*)(db + doff) = make_uint2(pk2(o1[0], o1[1]), pk2(o1[2], o1[3])); *(uint2*)(db + doff + 32) = make_uint2(pk2(o2[0], o2[1]), pk2(o2[2], o2[3]));
            if (which) {
                float* o = nullptr;
                if (is_p) { if (i >= SEQ - WBUF) o = out + OUT_PK + ((size_t)b * WBUF + (i - (SEQ - WBUF))) * ATT_WIDTH + h * 64 + jc * 4; }
                else o = out + OUT_SK + ((size_t)b * WBUF + (WBUF - DEC_SEQ + i)) * ATT_WIDTH + h * 64 + jc * 4;
                if (o) { *(float4*)o = make_float4(o1[0], o1[1], o1[2], o1[3]); *(float4*)(o + 32) = make_float4(o2[0], o2[1], o2[2], o2[3]); }
            }
        }
    }
}


__device__ __forceinline__ void ph_post_proj_prompt(const bf16* __restrict__ projb, const float* __restrict__ dtraw, const float* __restrict__ conv_w, const float* __restrict__ conv_b,
                                                    const float* __restrict__ dt_bias, const float* __restrict__ rope_tab, bf16* __restrict__ xbc_b, float* __restrict__ dtv,
                                                    bf16* __restrict__ qrot_b, bf16* __restrict__ krot_b, float* __restrict__ out) {
    const int gtid = blockIdx.x * NTHR + threadIdx.x, gsz = gridDim.x * NTHR;
    for (int item = gtid; item < (T_PROMPT / 16) * 320; item += gsz) {
        const int run = item / 320, c = (item - run * 320) * 8, t0 = run * 16, i0 = t0 & (SEQ - 1), b = t0 >> 13;
        float w[4][8], bias[8];
#pragma unroll
        for (int tap = 0; tap < 4; ++tap) { const float4 w0 = *(const float4*)(conv_w + tap * CONV_DIM + c), w1 = *(const float4*)(conv_w + tap * CONV_DIM + c + 4);
            w[tap][0] = w0.x; w[tap][1] = w0.y; w[tap][2] = w0.z; w[tap][3] = w0.w; w[tap][4] = w1.x; w[tap][5] = w1.y; w[tap][6] = w1.z; w[tap][7] = w1.w; }
        { const float4 b0 = *(const float4*)(conv_b + c), b1 = *(const float4*)(conv_b + c + 4);
          bias[0] = b0.x; bias[1] = b0.y; bias[2] = b0.z; bias[3] = b0.w; bias[4] = b1.x; bias[5] = b1.y; bias[6] = b1.z; bias[7] = b1.w; }
        const bf16* src = projb + (size_t)t0 * NB_LD + NB_XBC + c;
        v4u raw[19];
#pragma unroll
        for (int s = 0; s < 19; ++s) { v4u z; z.x = 0u; z.y = 0u; z.z = 0u; z.w = 0u; raw[s] = (s >= 3 || i0 != 0) ? *(const v4u*)(src + (ptrdiff_t)(s - 3) * NB_LD) : z; }
        float p0[8], p1[8], p2[8];
        unpack8(raw[0], p0); unpack8(raw[1], p1); unpack8(raw[2], p2);
#pragma unroll
        for (int s = 0; s < 16; ++s) {
            float cur[8], acc[8]; unpack8(raw[s + 3], cur);
#pragma unroll
            for (int j = 0; j < 8; ++j) acc[j] = silu_f(bias[j] + p0[j] * w[0][j] + p1[j] * w[1][j] + p2[j] * w[2][j] + cur[j] * w[3][j]);
            v4u o; o.x = pk2(acc[0], acc[1]); o.y = pk2(acc[2], acc[3]); o.z = pk2(acc[4], acc[5]); o.w = pk2(acc[6], acc[7]);
            *(v4u*)(xbc_b + (size_t)(t0 + s) * CONV_DIM + c) = o;
            if (i0 + s >= SEQ - 3) store8f(out + OUT_PC + ((size_t)b * 3 + (i0 + s - (SEQ - 3))) * CONV_DIM + c, cur);
#pragma unroll
            for (int j = 0; j < 8; ++j) { p0[j] = p1[j]; p1[j] = p2[j]; p2[j] = cur[j]; }
        }
    }
#pragma unroll 4
    for (int item = gtid; item < T_PROMPT * 128; item += gsz) {
        const int t = item >> 7, sub = item & 127, which = sub >> 6, h = (sub >> 3) & 7, jc = sub & 7, i = t & (SEQ - 1), b = t >> 13;
        const bf16* src = projb + (size_t)t * NB_LD + (which ? NB_K : NB_Q) + h * 64 + jc * 4;
        const uint2 lo = *(const uint2*)src, hi = *(const uint2*)(src + 32);
        const float4 cs = *(const float4*)(rope_tab + (size_t)i * 64 + jc * 4), sn = *(const float4*)(rope_tab + (size_t)i * 64 + 32 + jc * 4);
        float t1[4], t2[4], o1[4], o2[4];
        t1[0] = __builtin_bit_cast(float, lo.x << 16); t1[1] = __builtin_bit_cast(float, lo.x & 0xffff0000u); t1[2] = __builtin_bit_cast(float, lo.y << 16); t1[3] = __builtin_bit_cast(float, lo.y & 0xffff0000u);
        t2[0] = __builtin_bit_cast(float, hi.x << 16); t2[1] = __builtin_bit_cast(float, hi.x & 0xffff0000u); t2[2] = __builtin_bit_cast(float, hi.y << 16); t2[3] = __builtin_bit_cast(float, hi.y & 0xffff0000u);
        const float cv[4] = {cs.x, cs.y, cs.z, cs.w}, sv[4] = {sn.x, sn.y, sn.z, sn.w};
#pragma unroll
        for (int e = 0; e < 4; ++e) { o1[e] = t1[e] * cv[e] - t2[e] * sv[e]; o2[e] = t2[e] * cv[e] + t1[e] * sv[e]; }
        const size_t doff = (size_t)t * ATT_WIDTH + h * 64 + jc * 4;
        bf16* db = which ? krot_b : qrot_b;
        *(uint2*)(db + doff) = make_uint2(pk2(o1[0], o1[1]), pk2(o1[2], o1[3])); *(uint2*)(db + doff + 32) = make_uint2(pk2(o2[0], o2[1]), pk2(o2[2], o2[3]));
        if (which && i >= SEQ - WBUF) {
            float* o = out + OUT_PK + ((size_t)b * WBUF + (i - (SEQ - WBUF))) * ATT_WIDTH + h * 64 + jc * 4;
            *(float4*)o = make_float4(o1[0], o1[1], o1[2], o1[3]); *(float4*)(o + 32) = make_float4(o2[0], o2[1], o2[2], o2[3]);
        }
    }
#pragma unroll 4
    for (int item = gtid; item < T_PROMPT * SSD_HEADS; item += gsz) { const int t = item / SSD_HEADS, hd = item - t * SSD_HEADS; dtv[item] = softplus_f(dtraw[(size_t)t * 32 + hd] + dt_bias[hd]); }
#pragma unroll 2
    for (int item = gtid; item < BATCH * WBUF * 64; item += gsz) {
        const int ch = item & 63, j = (item >> 6) & (WBUF - 1), b = item >> 17;
        float f[8]; unpack8(*(const v4u*)(projb + (size_t)(b * SEQ + (SEQ - WBUF) + j) * NB_LD + NB_V + ch * 8), f);
        store8f(out + OUT_PV + ((size_t)b * WBUF + j) * ATT_WIDTH + ch * 8, f);
    }
}

#define SSD_CH 32
__device__ __forceinline__ void ph_ssd_naive(float* lds, const bf16* __restrict__ xbc_act, const float* __restrict__ dtv, const float* __restrict__ a_log,
                                             const float* __restrict__ d_skip, const float* __restrict__ state_ssm, float* __restrict__ ybuf, float* __restrict__ out) {
    float (*sx)[64] = (float (*)[64])lds;
    float (*sB)[128] = (float (*)[128])(lds + SSD_CH * 64);
    float (*sC)[128] = (float (*)[128])(lds + SSD_CH * 64 + SSD_CH * 128);
    float* sdt = lds + SSD_CH * 64 + 2 * SSD_CH * 128;
    const int tid = threadIdx.x, p = tid >> 3, ng = tid & 7;
    for (int vb = BATCH * SSD_HEADS + blockIdx.x; vb < (BATCH + DEC_BATCH) * SSD_HEADS; vb += gridDim.x) {
        const int seq = vb / SSD_HEADS, h = vb % SSD_HEADS, g = h / 6;
        const bool is_p = seq < BATCH;
        const int L = is_p ? SEQ : DEC_SEQ;
        const int t0 = is_p ? seq * SEQ : T_PROMPT + (seq - BATCH) * DEC_SEQ;
        const float A = -__expf(a_log[h]);
        const float D = d_skip[h];
        float hs[16];
        if (is_p) {
#pragma unroll
            for (int j = 0; j < 16; ++j) hs[j] = 0.f;
        } else {
            const float* s0 = state_ssm + (((size_t)(seq - BATCH) * SSD_HEADS + h) * 64 + p) * 128 + ng * 16;
#pragma unroll
            for (int j = 0; j < 16; ++j) hs[j] = s0[j];
        }
        for (int c0 = 0; c0 < L; c0 += SSD_CH) {
            const int nst = (L - c0) < SSD_CH ? (L - c0) : SSD_CH;
            __syncthreads();
            for (int idx = tid; idx < nst * 64; idx += NTHR) { int s = idx >> 6, c = idx & 63; sx[s][c] = bf2f(xbc_act[(size_t)(t0 + c0 + s) * CONV_DIM + h * 64 + c]); }
            for (int idx = tid; idx < nst * 128; idx += NTHR) { int s = idx >> 7, c = idx & 127;
                sB[s][c] = bf2f(xbc_act[(size_t)(t0 + c0 + s) * CONV_DIM + 1536 + g * 128 + c]);
                sC[s][c] = bf2f(xbc_act[(size_t)(t0 + c0 + s) * CONV_DIM + 2048 + g * 128 + c]); }
            if (tid < nst) sdt[tid] = dtv[(size_t)(t0 + c0 + tid) * SSD_HEADS + h];
            __syncthreads();
            for (int s = 0; s < nst; ++s) {
                const float dt = sdt[s], x = sx[s][p];
                const float a = __expf(dt * A), xdt = x * dt;
                float y = 0.f;
#pragma unroll
                for (int j = 0; j < 16; ++j) { hs[j] = a * hs[j] + xdt * sB[s][ng * 16 + j]; y += sC[s][ng * 16 + j] * hs[j]; }
                y += __shfl_xor(y, 1); y += __shfl_xor(y, 2); y += __shfl_xor(y, 4);
                if (ng == 0) ybuf[(size_t)(t0 + c0 + s) * MIX_WIDTH + h * 64 + p] = y + D * x;
            }
        }
        float* so = is_p ? out + OUT_PS + (((size_t)seq * SSD_HEADS + h) * 64 + p) * 128 + ng * 16
                         : out + OUT_SS + (((size_t)(seq - BATCH) * SSD_HEADS + h) * 64 + p) * 128 + ng * 16;
#pragma unroll
        for (int j = 0; j < 16; ++j) so[j] = hs[j];
    }
}

__device__ __forceinline__ void ph_gate_norm(const bf16* __restrict__ projb, const float* __restrict__ norm_g, const float* __restrict__ ybuf, bf16* __restrict__ A1) {
    const int w = threadIdx.x >> 6, lane = threadIdx.x & 63, g = w & 3;
    for (int t = T_PROMPT + 2 * blockIdx.x + (w >> 2); t < T_ALL; t += 2 * gridDim.x) {
        float v[6]; float ss = 0.f;
#pragma unroll
        for (int j = 0; j < 6; ++j) {
            int c = g * 384 + j * 64 + lane;
            float y = ybuf[(size_t)t * MIX_WIDTH + c], z = bf2f(projb[(size_t)t * NB_LD + c]);
            v[j] = y * silu_f(z); ss += v[j] * v[j];
        }
        ss = wave_sum(ss);
        const float r = rsqrtf(ss * (1.0f / 384.0f) + LN_EPS);
#pragma unroll
        for (int j = 0; j < 6; ++j) { int c = g * 384 + j * 64 + lane; A1[(size_t)t * MIX_WIDTH + c] = (bf16)f2bf(v[j] * r * norm_g[c]); }
    }
}

__device__ __forceinline__ void ph_attn_naive(float* lds, const float* __restrict__ proj, const float* __restrict__ qrot, const float* __restrict__ krot,
                                              const float* __restrict__ ck, const float* __restrict__ cv, float* __restrict__ ybuf) {
    float (*sq)[64] = (float (*)[64])lds;
    const int w = threadIdx.x >> 6, lane = threadIdx.x & 63;
    for (int vb = blockIdx.x; vb < T_SAMPLE * 8 / NWAVE; vb += gridDim.x) {
        const int item = T_PROMPT * 8 + vb * NWAVE + w;
        const int t = item >> 3, h = item & 7;
        const bool is_p = t < T_PROMPT;
        int b, i;
        if (is_p) { b = t / SEQ; i = t % SEQ; } else { int ts = t - T_PROMPT; b = ts / DEC_SEQ; i = ts % DEC_SEQ; }
        __syncthreads();
        sq[w][lane] = qrot[(size_t)t * ATT_WIDTH + h * 64 + lane];
        __syncthreads();
        const int qi = is_p ? i : WBUF + i;
        float sc[3][3];
        float mx = -INFINITY;
#pragma unroll
        for (int pt = 0; pt < 3; ++pt) {
            const int d = pt == 0 ? 1 : (pt == 1 ? 4 : 16);
#pragma unroll
            for (int sl = 0; sl < 3; ++sl) {
                const int m = lane + sl * 64;
                float s = -INFINITY;
                const int kj = qi - d * m;
                if (m <= 128 && kj >= 0) {
                    const float* kr;
                    if (is_p) kr = krot + (size_t)(b * SEQ + kj) * ATT_WIDTH + h * 64;
                    else kr = (kj >= WBUF) ? krot + (size_t)(T_PROMPT + b * DEC_SEQ + (kj - WBUF)) * ATT_WIDTH + h * 64
                                           : ck + ((size_t)b * WBUF + kj) * ATT_WIDTH + h * 64;
                    float a = 0.f;
#pragma unroll
                    for (int c = 0; c < 64; c += 4) { float4 kv = *(const float4*)(kr + c); a += kv.x * sq[w][c] + kv.y * sq[w][c + 1] + kv.z * sq[w][c + 2] + kv.w * sq[w][c + 3]; }
                    s = a * 0.125f;
                }
                sc[pt][sl] = s; mx = fmaxf(mx, s);
            }
        }
        mx = wave_max(mx);
        float lsum = 0.f;
#pragma unroll
        for (int pt = 0; pt < 3; ++pt)
#pragma unroll
            for (int sl = 0; sl < 3; ++sl) { float pv = (sc[pt][sl] == -INFINITY) ? 0.f : __expf(sc[pt][sl] - mx); sc[pt][sl] = pv; lsum += pv; }
        lsum = wave_sum(lsum);
        float o = 0.f;
#pragma unroll
        for (int pt = 0; pt < 3; ++pt) {
            const int d = pt == 0 ? 1 : (pt == 1 ? 4 : 16);
#pragma unroll
            for (int sl = 0; sl < 3; ++sl) {
                const int mend = sl < 2 ? 64 : 1;
                for (int ml = 0; ml < mend; ++ml) {
                    const int m = ml + sl * 64;
                    const int kj = qi - d * m;
                    const float pv = __shfl(sc[pt][sl], ml);
                    if (kj < 0) continue;
                    const float* vr;
                    if (is_p) vr = proj + (size_t)(b * SEQ + kj) * PROJ_LD + O_V + h * 64;
                    else vr = (kj >= WBUF) ? proj + (size_t)(T_PROMPT + b * DEC_SEQ + (kj - WBUF)) * PROJ_LD + O_V + h * 64
                                           : cv + ((size_t)b * WBUF + kj) * ATT_WIDTH + h * 64;
                    o += pv * vr[lane];
                }
            }
        }
        ybuf[(size_t)t * MIX_WIDTH + SSD_WIDTH + h * 64 + lane] = o / lsum;
    }
}

__device__ __forceinline__ void ph_ln_res(const float* __restrict__ xp, const float* __restrict__ xs, const bf16* __restrict__ add, const float* __restrict__ gam,
                                          const float* __restrict__ bet, bf16* __restrict__ dstb) {
    const int lane = threadIdx.x & 63;
#pragma unroll 2
    for (int t = blockIdx.x * NWAVE + (threadIdx.x >> 6); t < T_ALL; t += gridDim.x * NWAVE) {
        const float* res = (t < T_PROMPT) ? xp + (size_t)t * D_MODEL : xs + (size_t)(t - T_PROMPT) * D_MODEL;
        float v[16]; float s = 0.f;
#pragma unroll
        for (int j = 0; j < 2; ++j) { const int c = j * 512 + lane * 8; const float4 r0 = *(const float4*)(res + c), r1 = *(const float4*)(res + c + 4);
            float a8[8]; unpack8(*(const v4u*)(add + (size_t)t * D_MODEL + c), a8);
            v[8 * j] = ALPHA_F * r0.x + a8[0]; v[8 * j + 1] = ALPHA_F * r0.y + a8[1]; v[8 * j + 2] = ALPHA_F * r0.z + a8[2]; v[8 * j + 3] = ALPHA_F * r0.w + a8[3];
            v[8 * j + 4] = ALPHA_F * r1.x + a8[4]; v[8 * j + 5] = ALPHA_F * r1.y + a8[5]; v[8 * j + 6] = ALPHA_F * r1.z + a8[6]; v[8 * j + 7] = ALPHA_F * r1.w + a8[7]; }
#pragma unroll
        for (int j = 0; j < 16; ++j) s += v[j];
        s = wave_sum(s);
        const float mu = s * (1.0f / 1024.0f);
        float q = 0.f;
#pragma unroll
        for (int j = 0; j < 16; ++j) { v[j] -= mu; q += v[j] * v[j]; }
        q = wave_sum(q);
        const float r = rsqrtf(q * (1.0f / 1024.0f) + LN_EPS);
#pragma unroll
        for (int j = 0; j < 2; ++j) { const int c = j * 512 + lane * 8; const float4 g0 = *(const float4*)(gam + c), g1 = *(const float4*)(gam + c + 4), b0 = *(const float4*)(bet + c), b1 = *(const float4*)(bet + c + 4);
            v4u o; o.x = pk2(v[8 * j] * r * g0.x + b0.x, v[8 * j + 1] * r * g0.y + b0.y); o.y = pk2(v[8 * j + 2] * r * g0.z + b0.z, v[8 * j + 3] * r * g0.w + b0.w);
            o.z = pk2(v[8 * j + 4] * r * g1.x + b1.x, v[8 * j + 5] * r * g1.y + b1.y); o.w = pk2(v[8 * j + 6] * r * g1.z + b1.z, v[8 * j + 7] * r * g1.w + b1.w);
            *(v4u*)(dstb + (size_t)t * D_MODEL + c) = o; }
    }
}

__device__ __forceinline__ void ph_peer_route(float* lds, const float* __restrict__ qh, const float* __restrict__ keys1, const float* __restrict__ keys2,
                                              int* __restrict__ eidx, float* __restrict__ gate) {
    float (*sq)[256] = (float (*)[256])lds;
    float (*sv)[2][16] = (float (*)[2][16])(lds + NWAVE * 256);
    int (*si)[2][16] = (int (*)[2][16])(lds + NWAVE * 256 + NWAVE * 32);
    const int w = threadIdx.x >> 6, lane = threadIdx.x & 63;
    for (int vb = blockIdx.x; vb < T_ALL * 8 / NWAVE; vb += gridDim.x) {
        const int item = vb * NWAVE + w;
        const int t = item >> 3, h = item & 7;
        __syncthreads();
        for (int c = lane; c < 256; c += 64) sq[w][c] = qh[(size_t)t * 2048 + h * 256 + c];
        __syncthreads();
#pragma unroll
        for (int half = 0; half < 2; ++half) {
            const float* keys = half ? keys2 : keys1;
            float s[2];
#pragma unroll
            for (int sl = 0; sl < 2; ++sl) {
                const float* kr = keys + (size_t)(lane + sl * 64) * 128;
                float a = 0.f;
#pragma unroll 8
                for (int c = 0; c < 128; c += 4) { float4 kv = *(const float4*)(kr + c); const float* qq = &sq[w][half * 128 + c]; a += kv.x * qq[0] + kv.y * qq[1] + kv.z * qq[2] + kv.w * qq[3]; }
                s[sl] = a;
            }
            for (int r = 0; r < 16; ++r) {
                float bv; int bi;
                if (s[0] >= s[1]) { bv = s[0]; bi = lane; } else { bv = s[1]; bi = lane + 64; }
#pragma unroll
                for (int o = 32; o > 0; o >>= 1) {
                    float ov = __shfl_xor(bv, o); int oi = __shfl_xor(bi, o);
                    if (ov > bv || (ov == bv && oi < bi)) { bv = ov; bi = oi; }
                }
                if (lane == 0) { sv[w][half][r] = bv; si[w][half][r] = bi; }
                if (bi == lane) s[0] = -INFINITY;
                if (bi == lane + 64) s[1] = -INFINITY;
            }
        }
        __syncthreads();
        float c[4];
#pragma unroll
        for (int j = 0; j < 4; ++j) { int ci = lane * 4 + j; c[j] = sv[w][0][ci >> 4] + sv[w][1][ci & 15]; }
        float myv = 0.f; int myc = 0;
        for (int r = 0; r < 16; ++r) {
            float bv = c[0]; int bi = lane * 4;
#pragma unroll
            for (int j = 1; j < 4; ++j) if (c[j] > bv) { bv = c[j]; bi = lane * 4 + j; }
#pragma unroll
            for (int o = 32; o > 0; o >>= 1) {
                float ov = __shfl_xor(bv, o); int oi = __shfl_xor(bi, o);
                if (ov > bv || (ov == bv && oi < bi)) { bv = ov; bi = oi; }
            }
            if (lane == r) { myv = bv; myc = bi; }
#pragma unroll
            for (int j = 0; j < 4; ++j) if (bi == lane * 4 + j) c[j] = -INFINITY;
        }
        float v = lane < 16 ? myv : -INFINITY;
        float mx = wave_max(v);
        float e = lane < 16 ? __expf(v - mx) : 0.f;
        float sum = wave_sum(e);
        if (lane < 16) {
            int ex = si[w][0][myc >> 4] * PEER_NKEYS + si[w][1][myc & 15];
            eidx[(size_t)t * 128 + h * 16 + lane] = ex;
            gate[(size_t)t * 128 + h * 16 + lane] = e / sum;
        }
    }
}

__device__ __forceinline__ void ph_peer_ffn(const float* __restrict__ hbuf, const int* __restrict__ eidx, const float* __restrict__ gate,
                                            const bf16* __restrict__ ub, const bf16* __restrict__ vb, const float* __restrict__ gam,
                                            const float* __restrict__ bet, float* __restrict__ out) {
    const int lane = threadIdx.x & 63;
    for (int t = blockIdx.x * NWAVE + (threadIdx.x >> 6); t < T_ALL; t += gridDim.x * NWAVE) {
        float x[16], acc[16];
        { const float* xr = hbuf + (size_t)t * D_MODEL + lane * 8;
          const float4 a = *(const float4*)xr, b = *(const float4*)(xr + 4), c = *(const float4*)(xr + 512), d = *(const float4*)(xr + 516);
          x[0] = a.x; x[1] = a.y; x[2] = a.z; x[3] = a.w; x[4] = b.x; x[5] = b.y; x[6] = b.z; x[7] = b.w;
          x[8] = c.x; x[9] = c.y; x[10] = c.z; x[11] = c.w; x[12] = d.x; x[13] = d.y; x[14] = d.z; x[15] = d.w; }
#pragma unroll
        for (int j = 0; j < 16; ++j) acc[j] = 0.f;
        for (int k = 0; k < 128; ++k) {
            const int e = eidx[(size_t)t * 128 + k];
            const float g = gate[(size_t)t * 128 + k];
            const bf16* ur = ub + (size_t)e * D_MODEL + lane * 8;
            float u0[8], u1[8];
            unpack8(*(const v4u*)ur, u0); unpack8(*(const v4u*)(ur + 512), u1);
            float d = 0.f;
#pragma unroll
            for (int j = 0; j < 8; ++j) d += u0[j] * x[j] + u1[j] * x[8 + j];
            d = wave_sum(d);
            const float wgt = g * gelu_f(d);
            const bf16* vr = vb + (size_t)e * D_MODEL + lane * 8;
            unpack8(*(const v4u*)vr, u0); unpack8(*(const v4u*)(vr + 512), u1);
#pragma unroll
            for (int j = 0; j < 8; ++j) { acc[j] += wgt * u0[j]; acc[8 + j] += wgt * u1[j]; }
        }
        float s = 0.f;
#pragma unroll
        for (int j = 0; j < 16; ++j) { acc[j] += ALPHA_F * x[j]; s += acc[j]; }
        s = wave_sum(s);
        const float mu = s * (1.0f / 1024.0f);
        float q = 0.f;
#pragma unroll
        for (int j = 0; j < 16; ++j) { acc[j] -= mu; q += acc[j] * acc[j]; }
        q = wave_sum(q);
        const float r = rsqrtf(q * (1.0f / 1024.0f) + LN_EPS);
        float* dst = ((t < T_PROMPT) ? out + OUT_YP + (size_t)t * D_MODEL : out + OUT_YS + (size_t)(t - T_PROMPT) * D_MODEL) + lane * 8;
#pragma unroll
        for (int q4 = 0; q4 < 4; ++q4) {
            const int eo = (q4 >> 1) * 512 + (q4 & 1) * 4;
            const float4 g4 = *(const float4*)(gam + lane * 8 + eo), b4 = *(const float4*)(bet + lane * 8 + eo);
            float4 o; o.x = acc[q4 * 4 + 0] * r * g4.x + b4.x; o.y = acc[q4 * 4 + 1] * r * g4.y + b4.y; o.z = acc[q4 * 4 + 2] * r * g4.z + b4.z; o.w = acc[q4 * 4 + 3] * r * g4.w + b4.w;
            *(float4*)(dst + eo) = o;
        }
    }
}

__device__ __forceinline__ float peer_dot16(const v4u a, const v4u b, const float (&x)[16]) {
    float u0[8], u1[8]; unpack8(a, u0); unpack8(b, u1);
    float d = 0.f;
#pragma unroll
    for (int j = 0; j < 8; ++j) d += u0[j] * x[j] + u1[j] * x[8 + j];
    return d;
}
#define PEER_TR_STEP(N, M) _Pragma("unroll") for (int i = 0; i < N; ++i) { const bool up = (lane & M) != 0; const float keep = up ? part[i + N] : part[i]; const float send = up ? part[i] : part[i + N]; part[i] = keep + __shfl_xor(send, M); }
__device__ __forceinline__ void ph_peer_ffn2(const float* __restrict__ hbuf, const int* __restrict__ eidx, const float* __restrict__ gate,
                                             const bf16* __restrict__ ub, const bf16* __restrict__ vb, const float* __restrict__ gam,
                                             const float* __restrict__ bet, float* __restrict__ out) {
    const int lane0 = threadIdx.x & 63;
    for (int t = blockIdx.x * NWAVE + (threadIdx.x >> 6); t < T_ALL; t += gridDim.x * NWAVE) {
        int lane = lane0; asm volatile("" : "+v"(lane));
        float x[16];
        { const float* xr = hbuf + (size_t)t * D_MODEL + lane * 8;
          const float4 a = *(const float4*)xr, b = *(const float4*)(xr + 4), c = *(const float4*)(xr + 512), d = *(const float4*)(xr + 516);
          x[0] = a.x; x[1] = a.y; x[2] = a.z; x[3] = a.w; x[4] = b.x; x[5] = b.y; x[6] = b.z; x[7] = b.w;
          x[8] = c.x; x[9] = c.y; x[10] = c.z; x[11] = c.w; x[12] = d.x; x[13] = d.y; x[14] = d.z; x[15] = d.w; }
        int ev[2]; float wv[4];
        ev[0] = eidx[(size_t)t * 128 + lane]; ev[1] = eidx[(size_t)t * 128 + 64 + lane];
#pragma unroll
        for (int rd = 0; rd < 4; ++rd) wv[rd] = gate[(size_t)t * 128 + rd * 32 + (lane >> 1)];
#pragma unroll
        for (int rd = 0; rd < 4; ++rd) {
            float part[32];
#pragma unroll
            for (int kb = 0; kb < 8; ++kb) {
                v4u ra[4], rb[4];
#pragma unroll
                for (int k8 = 0; k8 < 4; ++k8) {
                    const int e = __builtin_amdgcn_readlane(ev[rd >> 1], (rd & 1) * 32 + kb * 4 + k8);
                    const bf16* ur = ub + (size_t)e * D_MODEL + lane * 8;
                    ra[k8] = *(const v4u*)ur; rb[k8] = *(const v4u*)(ur + 512);
                }
#pragma unroll
                for (int k8 = 0; k8 < 4; ++k8) part[kb * 4 + k8] = peer_dot16(ra[k8], rb[k8], x);
            }
            PEER_TR_STEP(16, 32) PEER_TR_STEP(8, 16) PEER_TR_STEP(4, 8) PEER_TR_STEP(2, 4) PEER_TR_STEP(1, 2)
            const float hid = part[0] + __shfl_xor(part[0], 1);
            wv[rd] *= gelu_f(hid);
        }
        float acc[16];
#pragma unroll
        for (int j = 0; j < 16; ++j) acc[j] = 0.f;
#pragma unroll
        for (int rd = 0; rd < 4; ++rd) {
#pragma unroll
            for (int kb = 0; kb < 4; ++kb) {
                v4u ra[8], rb[8];
#pragma unroll
                for (int k8 = 0; k8 < 8; ++k8) {
                    const int e = __builtin_amdgcn_readlane(ev[rd >> 1], (rd & 1) * 32 + kb * 8 + k8);
                    const bf16* vr = vb + (size_t)e * D_MODEL + lane * 8;
                    ra[k8] = *(const v4u*)vr; rb[k8] = *(const v4u*)(vr + 512);
                }
#pragma unroll
                for (int k8 = 0; k8 < 8; ++k8) {
                    const float wk = __builtin_bit_cast(float, __builtin_amdgcn_readlane(__builtin_bit_cast(int, wv[rd]), 2 * (kb * 8 + k8)));
                    float u0[8], u1[8]; unpack8(ra[k8], u0); unpack8(rb[k8], u1);
#pragma unroll
                    for (int j = 0; j < 8; ++j) { acc[j] += wk * u0[j]; acc[8 + j] += wk * u1[j]; }
                }
            }
        }
        float s = 0.f;
#pragma unroll
        for (int j = 0; j < 16; ++j) { acc[j] += ALPHA_F * x[j]; s += acc[j]; }
        s = wave_sum(s);
        const float mu = s * (1.0f / 1024.0f);
        float q = 0.f;
#pragma unroll
        for (int j = 0; j < 16; ++j) { acc[j] -= mu; q += acc[j] * acc[j]; }
        q = wave_sum(q);
        const float r = rsqrtf(q * (1.0f / 1024.0f) + LN_EPS);
        float* dst = ((t < T_PROMPT) ? out + OUT_YP + (size_t)t * D_MODEL : out + OUT_YS + (size_t)(t - T_PROMPT) * D_MODEL) + lane * 8;
#pragma unroll
        for (int q4 = 0; q4 < 4; ++q4) {
            const int eo = (q4 >> 1) * 512 + (q4 & 1) * 4;
            const float4 g4 = *(const float4*)(gam + lane * 8 + eo), b4 = *(const float4*)(bet + lane * 8 + eo);
            float4 o; o.x = acc[q4 * 4 + 0] * r * g4.x + b4.x; o.y = acc[q4 * 4 + 1] * r * g4.y + b4.y; o.z = acc[q4 * 4 + 2] * r * g4.z + b4.z; o.w = acc[q4 * 4 + 3] * r * g4.w + b4.w;
            *(float4*)(dst + eo) = o;
        }
    }
}

__device__ __forceinline__ void ph_attn_sample(float* lds, const bf16* __restrict__ qrot_b, const bf16* __restrict__ krot_b, const bf16* __restrict__ projb,
                                               const float* __restrict__ ck, const float* __restrict__ cv, bf16* __restrict__ A1) {
    float (*sq)[64] = (float (*)[64])lds;
    const int w = threadIdx.x >> 6, lane0 = threadIdx.x & 63;
    for (int vb = blockIdx.x; vb < T_SAMPLE * 8 / NWAVE; vb += gridDim.x) {
        int lane = lane0; asm volatile("" : "+v"(lane));
        const int item = vb * NWAVE + w, ts = item >> 3, hd = item & 7, b = ts >> 2, i = ts & 3, t = T_PROMPT + ts;
        __syncthreads();
        sq[w][lane] = bf2f(qrot_b[(size_t)t * ATT_WIDTH + hd * 64 + lane]);
        __syncthreads();
        const int qi = WBUF + i;
        float sc[8];
        float mx = -INFINITY;
#pragma unroll
        for (int slot = 0; slot < 7; ++slot) {
            const int pt = slot < 6 ? (slot >> 1) : (lane < 3 ? lane : 0);
            const int m = slot < 6 ? lane + 64 * (slot & 1) : 128;
            const int kj = qi - (m << (2 * pt));
            const bool valid = (slot < 6 || lane < 3) && kj < WBUF;
            const int kc = kj < WBUF ? kj : WBUF - 1;
            const float* kr = ck + ((size_t)b * WBUF + kc) * ATT_WIDTH + hd * 64;
            float a = 0.f;
#pragma unroll
            for (int c = 0; c < 64; c += 4) { const float4 kv = *(const float4*)(kr + c); a += kv.x * sq[w][c] + kv.y * sq[w][c + 1] + kv.z * sq[w][c + 2] + kv.w * sq[w][c + 3]; }
            const float s = valid ? a * 0.125f : -INFINITY;
            sc[slot] = s; mx = fmaxf(mx, s);
        }
        const int nt7 = lane <= i ? i - lane : i;
        const bool valid7 = lane < i + 3;
        {
            const bf16* kr = krot_b + (size_t)(T_PROMPT + b * DEC_SEQ + nt7) * ATT_WIDTH + hd * 64;
            float a = 0.f;
#pragma unroll
            for (int c = 0; c < 64; c += 8) { float f[8]; unpack8(*(const v4u*)(kr + c), f);
#pragma unroll
                for (int j = 0; j < 8; ++j) a += f[j] * sq[w][c + j]; }
            const float s = valid7 ? a * 0.125f : -INFINITY;
            sc[7] = s; mx = fmaxf(mx, s);
        }
        mx = wave_max(mx);
        float lsum = 0.f;
#pragma unroll
        for (int slot = 0; slot < 8; ++slot) { const float pv = __expf(sc[slot] - mx); sc[slot] = pv; lsum += pv; }
        lsum = wave_sum(lsum);
        float part[64];
#pragma unroll
        for (int c = 0; c < 64; ++c) part[c] = 0.f;
#pragma unroll
        for (int slot = 0; slot < 7; ++slot) {
            const int pt = slot < 6 ? (slot >> 1) : (lane < 3 ? lane : 0);
            const int m = slot < 6 ? lane + 64 * (slot & 1) : 128;
            const int kj = qi - (m << (2 * pt));
            const int kc = kj < WBUF ? kj : WBUF - 1;
            const float pv = sc[slot];
            const float* vr = cv + ((size_t)b * WBUF + kc) * ATT_WIDTH + hd * 64;
#pragma unroll
            for (int c = 0; c < 64; c += 4) { const float4 vv = *(const float4*)(vr + c); part[c] += pv * vv.x; part[c + 1] += pv * vv.y; part[c + 2] += pv * vv.z; part[c + 3] += pv * vv.w; }
        }
        {
            const float pv = sc[7];
            const bf16* vr = projb + (size_t)(T_PROMPT + b * DEC_SEQ + nt7) * NB_LD + NB_V + hd * 64;
#pragma unroll
            for (int c = 0; c < 64; c += 8) { float f[8]; unpack8(*(const v4u*)(vr + c), f);
#pragma unroll
                for (int j = 0; j < 8; ++j) part[c + j] += pv * f[j]; }
        }
        PEER_TR_STEP(32, 32) PEER_TR_STEP(16, 16) PEER_TR_STEP(8, 8) PEER_TR_STEP(4, 4) PEER_TR_STEP(2, 2) PEER_TR_STEP(1, 1)
        A1[(size_t)t * MIX_WIDTH + SSD_WIDTH + hd * 64 + lane] = (bf16)f2bf(part[0] / lsum);
    }
}


__device__ __forceinline__ void cache_copy_slice(const float* __restrict__ ck, const float* __restrict__ cv, float* __restrict__ out, unsigned slice, unsigned lane) {
    constexpr unsigned PER_B = (WBUF - DEC_SEQ) * ATT_WIDTH / 4;
    constexpr unsigned TOTAL = 2u * DEC_BATCH * PER_B;
#pragma unroll 1
    for (unsigned bt = 0; bt < 8; ++bt) {
        f32x4n v[8]; size_t dsti[8]; bool isv[8]; bool ok[8];
#pragma unroll
        for (int j = 0; j < 8; ++j) {
            const unsigned idx = slice * 4096u + bt * 512u + j * 64u + lane;
            ok[j] = idx < TOTAL;
            const unsigned idc = ok[j] ? idx : 0u;
            const unsigned tb = idc / PER_B, r = idc - tb * PER_B, bb = tb & (DEC_BATCH - 1);
            isv[j] = tb >= DEC_BATCH;
            const size_t srci = (size_t)bb * (WBUF * ATT_WIDTH / 4) + (DEC_SEQ * ATT_WIDTH / 4) + r;
            dsti[j] = (size_t)bb * (WBUF * ATT_WIDTH / 4) + r;
            v[j] = __builtin_nontemporal_load((isv[j] ? (const f32x4n*)cv : (const f32x4n*)ck) + srci);
        }
#pragma unroll
        for (int j = 0; j < 8; ++j) if (ok[j]) __builtin_nontemporal_store(v[j], (f32x4n*)(out + (isv[j] ? OUT_SV : OUT_SK)) + dsti[j]);
    }
}

__device__ __forceinline__ void copy_q_load(const float* __restrict__ ck, const float* __restrict__ cv, unsigned q, unsigned lane, f32x4n (&v)[16]) {
    constexpr unsigned PER_B = (WBUF - DEC_SEQ) * ATT_WIDTH / 4, TOTAL = 2u * DEC_BATCH * PER_B;
#pragma unroll
    for (int j = 0; j < 16; ++j) {
        const unsigned idx = q * 1024u + j * 64u + lane, idc = idx < TOTAL ? idx : 0u;
        const unsigned tb = idc / PER_B, r = idc - tb * PER_B, bb = tb & (DEC_BATCH - 1);
        const size_t srci = (size_t)bb * (WBUF * ATT_WIDTH / 4) + (DEC_SEQ * ATT_WIDTH / 4) + r;
        v[j] = __builtin_nontemporal_load((tb >= DEC_BATCH ? (const f32x4n*)cv : (const f32x4n*)ck) + srci);
    }
}
__device__ __forceinline__ void copy_q_store(float* __restrict__ out, unsigned q, unsigned lane, const f32x4n (&v)[16]) {
    constexpr unsigned PER_B = (WBUF - DEC_SEQ) * ATT_WIDTH / 4, TOTAL = 2u * DEC_BATCH * PER_B;
#pragma unroll
    for (int j = 0; j < 16; ++j) {
        const unsigned idx = q * 1024u + j * 64u + lane;
        if (idx < TOTAL) {
            const unsigned tb = idx / PER_B, r = idx - tb * PER_B, bb = tb & (DEC_BATCH - 1);
            const size_t dsti = (size_t)bb * (WBUF * ATT_WIDTH / 4) + r;
            __builtin_nontemporal_store(v[j], (f32x4n*)(out + (tb >= DEC_BATCH ? OUT_SV : OUT_SK)) + dsti);
        }
    }
}
typedef float f32x2v __attribute__((ext_vector_type(2)));
__device__ __forceinline__ void ph_quant_tables(const float* __restrict__ pu, const float* __restrict__ pv, unsigned char* __restrict__ ub8, unsigned char* __restrict__ vb8,
                                                float* __restrict__ usc, float* __restrict__ vsc, int rank, int nranks) {
    const int lane = threadIdx.x & 63;
#pragma unroll 2
    for (int row = rank * NWAVE + (threadIdx.x >> 6); row < 2 * 16384; row += nranks * NWAVE) {
        const int rr = row & 16383; const bool isv = row >= 16384;
        const float* src = (isv ? pv : pu) + (size_t)rr * D_MODEL + lane * 8;
        const float4 a = *(const float4*)src, b = *(const float4*)(src + 4), c = *(const float4*)(src + 512), d = *(const float4*)(src + 516);
        float am = fmaxf(fmaxf(fmaxf(fabsf(a.x), fabsf(a.y)), fmaxf(fabsf(a.z), fabsf(a.w))), fmaxf(fmaxf(fabsf(b.x), fabsf(b.y)), fmaxf(fabsf(b.z), fabsf(b.w))));
        am = fmaxf(am, fmaxf(fmaxf(fmaxf(fabsf(c.x), fabsf(c.y)), fmaxf(fabsf(c.z), fabsf(c.w))), fmaxf(fmaxf(fabsf(d.x), fabsf(d.y)), fmaxf(fabsf(d.z), fabsf(d.w)))));
        am = wave_max(am);
        const float sc = am > 0.f ? 224.0f / am : 1.0f;
        v4u o;
        o.x = (unsigned)__builtin_amdgcn_cvt_pk_fp8_f32(a.z * sc, a.w * sc, __builtin_amdgcn_cvt_pk_fp8_f32(a.x * sc, a.y * sc, 0, false), true);
        o.y = (unsigned)__builtin_amdgcn_cvt_pk_fp8_f32(b.z * sc, b.w * sc, __builtin_amdgcn_cvt_pk_fp8_f32(b.x * sc, b.y * sc, 0, false), true);
        o.z = (unsigned)__builtin_amdgcn_cvt_pk_fp8_f32(c.z * sc, c.w * sc, __builtin_amdgcn_cvt_pk_fp8_f32(c.x * sc, c.y * sc, 0, false), true);
        o.w = (unsigned)__builtin_amdgcn_cvt_pk_fp8_f32(d.z * sc, d.w * sc, __builtin_amdgcn_cvt_pk_fp8_f32(d.x * sc, d.y * sc, 0, false), true);
        *(v4u*)((isv ? vb8 : ub8) + (size_t)rr * 1024 + lane * 16) = o;
        if (lane == 0) (isv ? vsc : usc)[rr] = am > 0.f ? am * (1.0f / 224.0f) : 1.0f;
    }
}
__device__ __forceinline__ void unpack16_fp8(const v4u w, float (&f)[16]) {
#pragma unroll
    for (int i = 0; i < 4; ++i) {
        const f32x2v lo = __builtin_amdgcn_cvt_pk_f32_fp8((int)w[i], false), hi = __builtin_amdgcn_cvt_pk_f32_fp8((int)w[i], true);
        f[4 * i] = lo[0]; f[4 * i + 1] = lo[1]; f[4 * i + 2] = hi[0]; f[4 * i + 3] = hi[1];
    }
}
__device__ __forceinline__ void ph_peer_ffn3(const bf16* __restrict__ hb, const int* __restrict__ eidx, const float* __restrict__ gate,
                                             const unsigned char* __restrict__ ub8, const unsigned char* __restrict__ vb8, const float* __restrict__ usc, const float* __restrict__ vsc,
                                             const float* __restrict__ gam, const float* __restrict__ bet, float* __restrict__ out,
                                             const float* __restrict__ ck, const float* __restrict__ cv, unsigned n9) {
    const int lane0 = threadIdx.x & 63;
    unsigned it = 0;
    for (int t = blockIdx.x * NWAVE + (threadIdx.x >> 6); t < T_ALL; t += gridDim.x * NWAVE, ++it) {
        int lane = lane0; asm volatile("" : "+v"(lane));
        { const unsigned sl = n9 + (blockIdx.x * NWAVE + (threadIdx.x >> 6)) + it * (gridDim.x * NWAVE); if (sl < 16384u) cache_copy_slice(ck, cv, out, sl, (unsigned)lane); }
        const unsigned lo16 = (unsigned)lane * 16u, lo8 = (unsigned)lane * 8u;
        float x[16];
        { float f0[8], f1[8]; const bf16* xr = hb + (size_t)t * D_MODEL + lo8; unpack8(*(const v4u*)xr, f0); unpack8(*(const v4u*)(xr + 512), f1);
#pragma unroll
          for (int j = 0; j < 8; ++j) { x[j] = f0[j]; x[8 + j] = f1[j]; } }
        int ev[2]; float wv[4], su[4];
        ev[0] = eidx[(size_t)t * 128 + lane]; ev[1] = eidx[(size_t)t * 128 + 64 + lane];
#pragma unroll
        for (int rd = 0; rd < 4; ++rd) {
            const int er = eidx[(size_t)t * 128 + rd * 32 + (lane >> 1)];
            wv[rd] = gate[(size_t)t * 128 + rd * 32 + (lane >> 1)] * vsc[er];
            su[rd] = usc[er];
        }
#pragma unroll
        for (int rd = 0; rd < 4; ++rd) {
            float part[32];
#pragma unroll
            for (int kb = 0; kb < 8; ++kb) {
                v4u ra[4];
#pragma unroll
                for (int k8 = 0; k8 < 4; ++k8) {
                    const int e = __builtin_amdgcn_readlane(ev[rd >> 1], (rd & 1) * 32 + kb * 4 + k8);
                    ra[k8] = *(const v4u*)(ub8 + (size_t)e * 1024 + lo16);
                }
#pragma unroll
                for (int k8 = 0; k8 < 4; ++k8) {
                    f32x2v dv = {0.f, 0.f};
#pragma unroll
                    for (int i = 0; i < 4; ++i) {
                        const f32x2v lo = __builtin_amdgcn_cvt_pk_f32_fp8((int)ra[k8][i], false), hi = __builtin_amdgcn_cvt_pk_f32_fp8((int)ra[k8][i], true);
                        dv += lo * (f32x2v){x[4 * i], x[4 * i + 1]}; dv += hi * (f32x2v){x[4 * i + 2], x[4 * i + 3]};
                    }
                    part[kb * 4 + k8] = dv[0] + dv[1];
                    if (k8 & 1) __builtin_amdgcn_sched_barrier(0);
                }
            }
            PEER_TR_STEP(16, 32) PEER_TR_STEP(8, 16) PEER_TR_STEP(4, 8) PEER_TR_STEP(2, 4) PEER_TR_STEP(1, 2)
            const float hid = (part[0] + __shfl_xor(part[0], 1)) * su[rd];
            wv[rd] *= gelu_f(hid);
        }
        float acc[16];
#pragma unroll
        for (int j = 0; j < 16; ++j) acc[j] = 0.f;
#pragma unroll
        for (int rd = 0; rd < 4; ++rd) {
#pragma unroll
            for (int kb = 0; kb < 4; ++kb) {
                v4u ra[8];
#pragma unroll
                for (int k8 = 0; k8 < 8; ++k8) {
                    const int e = __builtin_amdgcn_readlane(ev[rd >> 1], (rd & 1) * 32 + kb * 8 + k8);
                    ra[k8] = *(const v4u*)(vb8 + (size_t)e * 1024 + lo16);
                }
#pragma unroll
                for (int k8 = 0; k8 < 8; ++k8) {
                    const float wk = __builtin_bit_cast(float, __builtin_amdgcn_readlane(__builtin_bit_cast(int, wv[rd]), 2 * (kb * 8 + k8)));
                    float f[16]; unpack16_fp8(ra[k8], f);
#pragma unroll
                    for (int j = 0; j < 16; ++j) acc[j] += wk * f[j];
                    if (k8 & 1) __builtin_amdgcn_sched_barrier(0);
                }
            }
        }
        float s = 0.f;
#pragma unroll
        for (int j = 0; j < 16; ++j) { acc[j] += ALPHA_F * x[j]; s += acc[j]; }
        s = wave_sum(s);
        const float mu = s * (1.0f / 1024.0f);
        float q = 0.f;
#pragma unroll
        for (int j = 0; j < 16; ++j) { acc[j] -= mu; q += acc[j] * acc[j]; }
        q = wave_sum(q);
        const float r = rsqrtf(q * (1.0f / 1024.0f) + LN_EPS);
        float* dst = ((t < T_PROMPT) ? out + OUT_YP + (size_t)t * D_MODEL : out + OUT_YS + (size_t)(t - T_PROMPT) * D_MODEL) + lo8;
#pragma unroll
        for (int q4 = 0; q4 < 4; ++q4) {
            const int eo = (q4 >> 1) * 512 + (q4 & 1) * 4;
            const float4 g4 = *(const float4*)(gam + lo8 + eo), b4 = *(const float4*)(bet + lo8 + eo);
            float4 o; o.x = acc[q4 * 4 + 0] * r * g4.x + b4.x; o.y = acc[q4 * 4 + 1] * r * g4.y + b4.y; o.z = acc[q4 * 4 + 2] * r * g4.z + b4.z; o.w = acc[q4 * 4 + 3] * r * g4.w + b4.w;
            *(float4*)(dst + eo) = o;
        }
    }
    for (;; ++it) {
        const unsigned sl = n9 + (blockIdx.x * NWAVE + (threadIdx.x >> 6)) + it * (gridDim.x * NWAVE);
        if (sl >= 16384u) break;
        cache_copy_slice(ck, cv, out, sl, (unsigned)lane0);
    }
}


__device__ __forceinline__ void ssd_decode_load(const bf16* __restrict__ xbc_b, const float* __restrict__ dtv, const float* __restrict__ state_ssm, int item, int p, int ng,
                                                float (&hs)[16], v4u (&bq)[4][2], v4u (&cq)[4][2], float (&xv)[4], float (&dv)[4]) {
    const int sb = item / SSD_HEADS, h = item - sb * SSD_HEADS, g = h / 6, t0 = T_PROMPT + sb * DEC_SEQ;
    const float* s0 = state_ssm + (((size_t)sb * SSD_HEADS + h) * 64 + p) * 128 + ng * 16;
#pragma unroll
    for (int j = 0; j < 4; ++j) { const float4 v = *(const float4*)(s0 + 4 * j); hs[4 * j] = v.x; hs[4 * j + 1] = v.y; hs[4 * j + 2] = v.z; hs[4 * j + 3] = v.w; }
#pragma unroll
    for (int s = 0; s < 4; ++s) {
        const bf16* row = xbc_b + (size_t)(t0 + s) * CONV_DIM;
        bq[s][0] = *(const v4u*)(row + 1536 + g * 128 + ng * 16); bq[s][1] = *(const v4u*)(row + 1536 + g * 128 + ng * 16 + 8);
        cq[s][0] = *(const v4u*)(row + 2048 + g * 128 + ng * 16); cq[s][1] = *(const v4u*)(row + 2048 + g * 128 + ng * 16 + 8);
        xv[s] = bf2f(row[h * 64 + p]); dv[s] = dtv[(size_t)(t0 + s) * SSD_HEADS + h];
    }
}
__device__ __forceinline__ void ssd_decode_compute(const float* __restrict__ a_log, const float* __restrict__ d_skip, int item, int p, int ng,
                                                   float (&hs)[16], const v4u (&bq)[4][2], const v4u (&cq)[4][2], const float (&xv)[4], const float (&dv)[4],
                                                   float* __restrict__ ybuf, float* __restrict__ out) {
    const int sb = item / SSD_HEADS, h = item - sb * SSD_HEADS, t0 = T_PROMPT + sb * DEC_SEQ;
    const float A = -__expf(a_log[h]), D = d_skip[h];
#pragma unroll
    for (int s = 0; s < 4; ++s) {
        float Bf[16], Cf[16];
        { float t8[8]; unpack8(bq[s][0], t8);
#pragma unroll
          for (int j = 0; j < 8; ++j) Bf[j] = t8[j];
          unpack8(bq[s][1], t8);
#pragma unroll
          for (int j = 0; j < 8; ++j) Bf[8 + j] = t8[j];
          unpack8(cq[s][0], t8);
#pragma unroll
          for (int j = 0; j < 8; ++j) Cf[j] = t8[j];
          unpack8(cq[s][1], t8);
#pragma unroll
          for (int j = 0; j < 8; ++j) Cf[8 + j] = t8[j]; }
        const float a = __expf(dv[s] * A), xdt = xv[s] * dv[s];
        float y = 0.f;
#pragma unroll
        for (int j = 0; j < 16; ++j) { hs[j] = a * hs[j] + xdt * Bf[j]; y += Cf[j] * hs[j]; }
        y += __shfl_xor(y, 1); y += __shfl_xor(y, 2); y += __shfl_xor(y, 4);
        if (ng == 0) ybuf[(size_t)(t0 + s) * MIX_WIDTH + h * 64 + p] = y + D * xv[s];
    }
    float* so = out + OUT_SS + (((size_t)sb * SSD_HEADS + h) * 64 + p) * 128 + ng * 16;
#pragma unroll
    for (int j = 0; j < 4; ++j) *(float4*)(so + 4 * j) = make_float4(hs[4 * j], hs[4 * j + 1], hs[4 * j + 2], hs[4 * j + 3]);
}
__device__ __forceinline__ void ph_ssd_decode(const bf16* __restrict__ xbc_b, const float* __restrict__ dtv, const float* __restrict__ a_log, const float* __restrict__ d_skip,
                                              const float* __restrict__ state_ssm, float* __restrict__ ybuf, float* __restrict__ out) {
    const int tid = threadIdx.x, p = tid >> 3, ng = tid & 7;
    constexpr int NITEM = DEC_BATCH * SSD_HEADS;
    for (int it = blockIdx.x; it < NITEM; it += 2 * gridDim.x) {
        const int it2 = it + gridDim.x; const bool has2 = it2 < NITEM; const int it2c = has2 ? it2 : it;
        float hsA[16], hsB[16], xA[4], xB[4], dA[4], dB[4]; v4u bA[4][2], cA[4][2], bB[4][2], cB[4][2];
        ssd_decode_load(xbc_b, dtv, state_ssm, it, p, ng, hsA, bA, cA, xA, dA);
        ssd_decode_load(xbc_b, dtv, state_ssm, it2c, p, ng, hsB, bB, cB, xB, dB);
        ssd_decode_compute(a_log, d_skip, it, p, ng, hsA, bA, cA, xA, dA, ybuf, out);
        if (has2) ssd_decode_compute(a_log, d_skip, it2, p, ng, hsB, bB, cB, xB, dB, ybuf, out);
    }
}

__device__ __forceinline__ float samp_cw(int d) { return (float)((int)(d >= 0 && d <= 128) + (int)(d >= 0 && (d & 3) == 0 && d <= 512) + (int)(d >= 0 && (d & 15) == 0 && d <= 2048)); }
__device__ __forceinline__ void samp_update(float sv, float cw, const float (&vrow)[64], float& m, float& l, float (&part)[64]) {
    const float mn = fmaxf(m, sv), alpha = __expf(m - mn), p = cw * __expf(sv - mn);
    m = mn; l = l * alpha + p;
#pragma unroll
    for (int c = 0; c < 64; ++c) part[c] = part[c] * alpha + p * vrow[c];
}
__device__ __forceinline__ void ph_attn_sample3(float* lds, const bf16* __restrict__ qrot_b, const bf16* __restrict__ krot_b, const bf16* __restrict__ projb,
                                                const float* __restrict__ ck, const float* __restrict__ cv, bf16* __restrict__ A1) {
    const int lane0 = threadIdx.x & 63, w = __builtin_amdgcn_readfirstlane(threadIdx.x >> 6);
    float* sq = lds + w * 256;
    for (int item = blockIdx.x + gridDim.x * w; item < DEC_BATCH * ATT_HEADS; item += gridDim.x * NWAVE) {
        int lane = lane0; asm volatile("" : "+v"(lane));
        const int b = item >> 3, hd = item & 7, qi = lane & 3, g = lane >> 2;
        const int tq0 = T_PROMPT + b * DEC_SEQ;
#pragma unroll
        for (int i = 0; i < 4; ++i) sq[i * 64 + lane] = bf2f(qrot_b[(size_t)(tq0 + i) * ATT_WIDTH + hd * 64 + lane]);
        asm volatile("s_waitcnt lgkmcnt(0)" ::: "memory");
        const float* qv = sq + qi * 64;
        const float* ckb = ck + (size_t)b * WBUF * ATT_WIDTH + hd * 64; const float* cvb = cv + (size_t)b * WBUF * ATT_WIDTH + hd * 64;
        float m = -1e30f, l = 0.f, part[64];
#pragma unroll
        for (int c = 0; c < 64; ++c) part[c] = 0.f;
        {
            const int P = 2051 - g;
            const float cw = samp_cw(WBUF + qi - P);
            const bool isn = P >= WBUF;
            const int nt = isn ? P - WBUF : 0, Pc = isn ? WBUF - 1 : P;
            const bf16* kn = krot_b + (size_t)(tq0 + nt) * ATT_WIDTH + hd * 64; const float* kr = ckb + (size_t)Pc * ATT_WIDTH;
            float a = 0.f;
#pragma unroll
            for (int c = 0; c < 64; c += 8) { float f[8]; unpack8(*(const v4u*)(kn + c), f); const float4 k0 = *(const float4*)(kr + c), k1 = *(const float4*)(kr + c + 4);
                a += (isn ? f[0] : k0.x) * qv[c] + (isn ? f[1] : k0.y) * qv[c + 1] + (isn ? f[2] : k0.z) * qv[c + 2] + (isn ? f[3] : k0.w) * qv[c + 3]
                   + (isn ? f[4] : k1.x) * qv[c + 4] + (isn ? f[5] : k1.y) * qv[c + 5] + (isn ? f[6] : k1.z) * qv[c + 6] + (isn ? f[7] : k1.w) * qv[c + 7]; }
            const float sv = cw > 0.f ? a * 0.125f : -1e30f;
            const bf16* vn = projb + (size_t)(tq0 + nt) * NB_LD + NB_V + hd * 64; const float* vr = cvb + (size_t)Pc * ATT_WIDTH;
            float vrow[64];
#pragma unroll
            for (int c = 0; c < 64; c += 8) { float f[8]; unpack8(*(const v4u*)(vn + c), f); const float4 v0 = *(const float4*)(vr + c), v1 = *(const float4*)(vr + c + 4);
                vrow[c] = isn ? f[0] : v0.x; vrow[c + 1] = isn ? f[1] : v0.y; vrow[c + 2] = isn ? f[2] : v0.z; vrow[c + 3] = isn ? f[3] : v0.w;
                vrow[c + 4] = isn ? f[4] : v1.x; vrow[c + 5] = isn ? f[5] : v1.y; vrow[c + 6] = isn ? f[6] : v1.z; vrow[c + 7] = isn ? f[7] : v1.w; }
            samp_update(sv, cw, vrow, m, l, part);
        }
#pragma unroll 1
        for (int s = 1; s < 21; ++s) {
            const int P = s < 9 ? 2051 - (16 * s + g) : (s < 15 ? 1536 + 64 * (s - 9) + lane : qi + 16 * (16 * (s - 15) + g));
            const float cw = (s < 9 && P < 1920) ? 0.f : samp_cw(WBUF + qi - P);
            const float* kr = ckb + (size_t)P * ATT_WIDTH;
            float a = 0.f;
#pragma unroll
            for (int c = 0; c < 64; c += 4) { const float4 kv = *(const float4*)(kr + c); a += kv.x * qv[c] + kv.y * qv[c + 1] + kv.z * qv[c + 2] + kv.w * qv[c + 3]; }
            const float sv = cw > 0.f ? a * 0.125f : -1e30f;
            __builtin_amdgcn_sched_barrier(0);
            const float* vr = cvb + (size_t)P * ATT_WIDTH;
            float vrow[64];
#pragma unroll
            for (int c = 0; c < 64; c += 4) { const float4 vv = *(const float4*)(vr + c); vrow[c] = vv.x; vrow[c + 1] = vv.y; vrow[c + 2] = vv.z; vrow[c + 3] = vv.w; }
            samp_update(sv, cw, vrow, m, l, part);
        }
        float M = m;
        M = fmaxf(M, __shfl_xor(M, 4)); M = fmaxf(M, __shfl_xor(M, 8)); M = fmaxf(M, __shfl_xor(M, 16)); M = fmaxf(M, __shfl_xor(M, 32));
        const float sc = __expf(m - M);
        float lsum = l * sc;
        lsum += __shfl_xor(lsum, 4); lsum += __shfl_xor(lsum, 8); lsum += __shfl_xor(lsum, 16); lsum += __shfl_xor(lsum, 32);
#pragma unroll
        for (int c = 0; c < 64; ++c) part[c] *= sc;
        PEER_TR_STEP(32, 32) PEER_TR_STEP(16, 16) PEER_TR_STEP(8, 8) PEER_TR_STEP(4, 4)
        const float inv = 1.0f / lsum;
        *(uint2*)(A1 + (size_t)(tq0 + qi) * MIX_WIDTH + SSD_WIDTH + hd * 64 + 4 * g) = make_uint2(pk2(part[0] * inv, part[1] * inv), pk2(part[2] * inv, part[3] * inv));
    }
}

typedef float f32x16 __attribute__((ext_vector_type(16)));
typedef short s16x8 __attribute__((ext_vector_type(8)));
typedef short s16x4 __attribute__((ext_vector_type(4)));
typedef float f32x4v __attribute__((ext_vector_type(4)));
#define SSD_L_ACS 0
#define SSD_L_DTS 3072
#define SSD_L_BM 6144
#define SSD_RS_B 272
#define SSD_L_X (6144 + 128 * 272)
#define SSD_RS_X 144
#define SSD_XIMG (128 * 144)
#define SSD_RS_Y 784
template <int OFF0, int OFF1>
__device__ __forceinline__ s16x8 tr_frag(unsigned base) {
    s16x4 a, b;
    asm volatile("ds_read_b64_tr_b16 %0, %2 offset:%3\n\tds_read_b64_tr_b16 %1, %2 offset:%4\n\ts_waitcnt lgkmcnt(0)"
                 : "=&v"(a), "=&v"(b) : "v"(base), "n"(OFF0), "n"(OFF1) : "memory");
    return __builtin_shufflevector(a, b, 0, 1, 2, 3, 4, 5, 6, 7);
}
__device__ __forceinline__ unsigned lds_addr(LAS unsigned char* p) { return (unsigned)(size_t)p; }
template <int O0, int O1, int O2, int O3, int O4, int O5, int O6, int O7>
__device__ __forceinline__ void tr_read8(unsigned base, s16x4 (&v)[8]) {
    asm volatile("ds_read_b64_tr_b16 %0, %8 offset:%9\n\tds_read_b64_tr_b16 %1, %8 offset:%10\n\tds_read_b64_tr_b16 %2, %8 offset:%11\n\tds_read_b64_tr_b16 %3, %8 offset:%12\n\t"
                 "ds_read_b64_tr_b16 %4, %8 offset:%13\n\tds_read_b64_tr_b16 %5, %8 offset:%14\n\tds_read_b64_tr_b16 %6, %8 offset:%15\n\tds_read_b64_tr_b16 %7, %8 offset:%16\n\ts_waitcnt lgkmcnt(0)"
                 : "=&v"(v[0]), "=&v"(v[1]), "=&v"(v[2]), "=&v"(v[3]), "=&v"(v[4]), "=&v"(v[5]), "=&v"(v[6]), "=&v"(v[7])
                 : "v"(base), "n"(O0), "n"(O1), "n"(O2), "n"(O3), "n"(O4), "n"(O5), "n"(O6), "n"(O7) : "memory");
}
#define TRCAT(a, b) __builtin_shufflevector(a, b, 0, 1, 2, 3, 4, 5, 6, 7)


__device__ __forceinline__ void ssd_chunk_acs(LAS unsigned char* ldsb, const float* __restrict__ dtv, const float* __restrict__ a_log, int t0, int g, float* cdec_out) {
    const int w = __builtin_amdgcn_readfirstlane(threadIdx.x >> 6), lane = threadIdx.x & 63;
    if (w < 6) {
        const int head = 6 * g + w;
        const float A = -__expf(a_log[head]);
        const float v0 = dtv[(size_t)(t0 + 2 * lane) * SSD_HEADS + head], v1 = dtv[(size_t)(t0 + 2 * lane + 1) * SSD_HEADS + head];
        const float a1 = v1 * A;
        float s = v0 * A + a1;
#pragma unroll
        for (int o = 1; o < 64; o <<= 1) { const float tmp = __shfl_up(s, o); if (lane >= o) s += tmp; }
        LAS float* acs = (LAS float*)(ldsb + SSD_L_ACS) + w * 128;
        LAS float* dts = (LAS float*)(ldsb + SSD_L_DTS) + w * 128;
        acs[2 * lane] = s - a1; acs[2 * lane + 1] = s;
        dts[2 * lane] = v0; dts[2 * lane + 1] = v1;
        if (cdec_out && lane == 63) cdec_out[head] = __expf(s);
    }
}

__device__ __forceinline__ void ph_ssd_states(LAS unsigned char* ldsb, const bf16* __restrict__ xbc_b, const float* __restrict__ dtv, const float* __restrict__ a_log,
                                              bf16* __restrict__ Sbuf, float* __restrict__ cdec, const float* __restrict__ ck, const float* __restrict__ cv, float* __restrict__ out) {
    const int tid = threadIdx.x, w = __builtin_amdgcn_readfirstlane(tid >> 6), lane = tid & 63;
    const int r = lane & 31, h = lane >> 5, blk = (lane >> 4) & 1, q = (lane & 15) >> 2, pp = lane & 3;
    const int nt = w & 3, pt = w >> 2;
    for (int unit = blockIdx.x; unit < BATCH * 64 * SSD_GROUPS; unit += gridDim.x) {
        const int g = unit & 3, bc = unit >> 2;
        const int t0 = bc * 128;
        __syncthreads();
        ssd_chunk_acs(ldsb, dtv, a_log, t0, g, cdec + (size_t)bc * SSD_HEADS);
#pragma unroll
        for (int it_ = 0; it_ < 4; ++it_) { const int idx = tid + it_ * NTHR; const int row = idx >> 4, ch = idx & 15;
            const v4u v = *(const v4u*)(xbc_b + (size_t)(t0 + row) * CONV_DIM + 1536 + 128 * g + ch * 8);
            *(LAS v4u*)(ldsb + SSD_L_BM + row * SSD_RS_B + ch * 16) = v; }
        __syncthreads();
#pragma unroll
        for (int it_ = 0; it_ < 12; ++it_) { const int idx = tid + it_ * NTHR; const int hh = idx >> 10, rem = idx & 1023, row = rem >> 3, ch = rem & 7;
            const LAS float* acs = (const LAS float*)(ldsb + SSD_L_ACS) + hh * 128; const LAS float* dts = (const LAS float*)(ldsb + SSD_L_DTS) + hh * 128;
            const float wgt = dts[row] * __expf(acs[127] - acs[row]);
            float f[8]; unpack8(*(const v4u*)(xbc_b + (size_t)(t0 + row) * CONV_DIM + (6 * g + hh) * 64 + ch * 8), f);
            v4u o; o.x = pk2(f[0] * wgt, f[1] * wgt); o.y = pk2(f[2] * wgt, f[3] * wgt); o.z = pk2(f[4] * wgt, f[5] * wgt); o.w = pk2(f[6] * wgt, f[7] * wgt);
            *(LAS v4u*)(ldsb + SSD_L_X + hh * SSD_XIMG + row * SSD_RS_X + ch * 16) = o; }
        __syncthreads();
        f32x4n rider[16];
        copy_q_load(ck, cv, 12288u + (unsigned)(unit * NWAVE + w), (unsigned)lane, rider);
        const unsigned abase = lds_addr(ldsb + SSD_L_BM) + (8 * h + q) * SSD_RS_B + (32 * nt + 16 * blk + 4 * pp) * 2;
        s16x8 afr[8];
        { s16x4 av[8];
          tr_read8<0 * SSD_RS_B, 4 * SSD_RS_B, 16 * SSD_RS_B, 20 * SSD_RS_B, 32 * SSD_RS_B, 36 * SSD_RS_B, 48 * SSD_RS_B, 52 * SSD_RS_B>(abase, av);
          afr[0] = TRCAT(av[0], av[1]); afr[1] = TRCAT(av[2], av[3]); afr[2] = TRCAT(av[4], av[5]); afr[3] = TRCAT(av[6], av[7]);
          tr_read8<64 * SSD_RS_B, 68 * SSD_RS_B, 80 * SSD_RS_B, 84 * SSD_RS_B, 96 * SSD_RS_B, 100 * SSD_RS_B, 112 * SSD_RS_B, 116 * SSD_RS_B>(abase, av);
          afr[4] = TRCAT(av[0], av[1]); afr[5] = TRCAT(av[2], av[3]); afr[6] = TRCAT(av[4], av[5]); afr[7] = TRCAT(av[6], av[7]); }
#pragma unroll
        for (int hh = 0; hh < 6; ++hh) {
            const unsigned xb = lds_addr(ldsb + SSD_L_X + hh * SSD_XIMG) + (8 * h + q) * SSD_RS_X + (32 * pt + 16 * blk + 4 * pp) * 2;
            f32x16 acc;
#pragma unroll
            for (int i = 0; i < 16; ++i) acc[i] = 0.f;
            { s16x4 xv[8];
              tr_read8<0 * SSD_RS_X, 4 * SSD_RS_X, 16 * SSD_RS_X, 20 * SSD_RS_X, 32 * SSD_RS_X, 36 * SSD_RS_X, 48 * SSD_RS_X, 52 * SSD_RS_X>(xb, xv);
              acc = __builtin_amdgcn_mfma_f32_32x32x16_bf16(afr[0], TRCAT(xv[0], xv[1]), acc, 0, 0, 0);
              acc = __builtin_amdgcn_mfma_f32_32x32x16_bf16(afr[1], TRCAT(xv[2], xv[3]), acc, 0, 0, 0);
              acc = __builtin_amdgcn_mfma_f32_32x32x16_bf16(afr[2], TRCAT(xv[4], xv[5]), acc, 0, 0, 0);
              acc = __builtin_amdgcn_mfma_f32_32x32x16_bf16(afr[3], TRCAT(xv[6], xv[7]), acc, 0, 0, 0);
              tr_read8<64 * SSD_RS_X, 68 * SSD_RS_X, 80 * SSD_RS_X, 84 * SSD_RS_X, 96 * SSD_RS_X, 100 * SSD_RS_X, 112 * SSD_RS_X, 116 * SSD_RS_X>(xb, xv);
              acc = __builtin_amdgcn_mfma_f32_32x32x16_bf16(afr[4], TRCAT(xv[0], xv[1]), acc, 0, 0, 0);
              acc = __builtin_amdgcn_mfma_f32_32x32x16_bf16(afr[5], TRCAT(xv[2], xv[3]), acc, 0, 0, 0);
              acc = __builtin_amdgcn_mfma_f32_32x32x16_bf16(afr[6], TRCAT(xv[4], xv[5]), acc, 0, 0, 0);
              acc = __builtin_amdgcn_mfma_f32_32x32x16_bf16(afr[7], TRCAT(xv[6], xv[7]), acc, 0, 0, 0); }
            bf16* dst = Sbuf + (((size_t)bc * SSD_HEADS + 6 * g + hh) * 64 + 32 * pt + r) * 128 + 32 * nt + 4 * h;
#pragma unroll
            for (int q4 = 0; q4 < 4; ++q4) *(uint2*)(dst + 8 * q4) = make_uint2(pk2(acc[4 * q4], acc[4 * q4 + 1]), pk2(acc[4 * q4 + 2], acc[4 * q4 + 3]));
        }
        copy_q_store(out, 12288u + (unsigned)(unit * NWAVE + w), (unsigned)lane, rider);
    }
}

__device__ __forceinline__ void ph_ssd_scan(const bf16* __restrict__ Sbuf, const float* __restrict__ cdec, bf16* __restrict__ Hin, float* __restrict__ out, int rank, int nranks) {
    for (int idx = rank * NTHR + threadIdx.x; idx < BATCH * SSD_HEADS * 64 * 16; idx += nranks * NTHR) {
        const int n8 = idx & 15, p = (idx >> 4) & 63, hb = idx >> 10, hd = hb % SSD_HEADS, b = hb / SSD_HEADS;
        float st[8];
#pragma unroll
        for (int j = 0; j < 8; ++j) st[j] = 0.f;
#pragma unroll 8
        for (int c = 0; c < 64; ++c) {
            const size_t base = ((((size_t)(b * 64 + c)) * SSD_HEADS + hd) * 64 + p) * 128 + n8 * 8;
            v4u o; o.x = pk2(st[0], st[1]); o.y = pk2(st[2], st[3]); o.z = pk2(st[4], st[5]); o.w = pk2(st[6], st[7]);
            *(v4u*)(Hin + base) = o;
            float s[8]; unpack8(*(const v4u*)(Sbuf + base), s);
            const float a = cdec[(size_t)(b * 64 + c) * SSD_HEADS + hd];
#pragma unroll
            for (int j = 0; j < 8; ++j) st[j] = a * st[j] + s[j];
        }
        store8f(out + OUT_PS + (((size_t)b * SSD_HEADS + hd) * 64 + p) * 128 + n8 * 8, st);
    }
}

__device__ __forceinline__ void ph_ssd_out(LAS unsigned char* ldsb, const bf16* __restrict__ xbc_b, const bf16* __restrict__ projb, const float* __restrict__ dtv,
                                           const float* __restrict__ a_log, const float* __restrict__ d_skip, const float* __restrict__ norm_g,
                                           const bf16* __restrict__ Hin, bf16* __restrict__ A1) {
    const int tid = threadIdx.x, w = __builtin_amdgcn_readfirstlane(tid >> 6), lane = tid & 63;
    const int r = lane & 31, h = lane >> 5, blk = (lane >> 4) & 1, q = (lane & 15) >> 2, pp = lane & 3;
    const int lt = w & 3, hs = w >> 2;
    for (int unit = blockIdx.x; unit < BATCH * 64 * SSD_GROUPS; unit += gridDim.x) {
        const int g = unit & 3, bc = unit >> 2;
        const int t0 = bc * 128;
        __syncthreads();
        ssd_chunk_acs(ldsb, dtv, a_log, t0, g, nullptr);
#pragma unroll
        for (int it_ = 0; it_ < 4; ++it_) { const int idx = tid + it_ * NTHR; const int row = idx >> 4, ch = idx & 15;
            const v4u v = *(const v4u*)(xbc_b + (size_t)(t0 + row) * CONV_DIM + 1536 + 128 * g + ch * 8);
            *(LAS v4u*)(ldsb + SSD_L_BM + row * SSD_RS_B + ch * 16) = v; }
#pragma unroll
        for (int it_ = 0; it_ < 12; ++it_) { const int idx = tid + it_ * NTHR; const int hh = idx >> 10, rem = idx & 1023, row = rem >> 3, ch = rem & 7;
            const v4u v = *(const v4u*)(xbc_b + (size_t)(t0 + row) * CONV_DIM + (6 * g + hh) * 64 + ch * 8);
            *(LAS v4u*)(ldsb + SSD_L_X + hh * SSD_XIMG + row * SSD_RS_X + ch * 16) = v; }
        __syncthreads();
        const bf16* cp = xbc_b + (size_t)(t0 + 32 * lt + r) * CONV_DIM + 2048 + 128 * g + 8 * h;
        s16x8 cfr[8];
#pragma unroll
        for (int ks = 0; ks < 8; ++ks) cfr[ks] = *(const s16x8*)(cp + 16 * ks);
        const int lcol = 32 * lt + r;
        const LAS float* acsb = (const LAS float*)(ldsb + SSD_L_ACS) + 3 * hs * 128; const LAS float* dtsb = (const LAS float*)(ldsb + SSD_L_DTS) + 3 * hs * 128;
        const unsigned xb0 = lds_addr(ldsb + SSD_L_X + 3 * hs * SSD_XIMG) + (4 * h + q) * SSD_RS_X + (16 * blk + 4 * pp) * 2;
        unsigned ypk[3][16];
#pragma unroll
        for (int h3 = 0; h3 < 3; ++h3) {
            const LAS float* acs = acsb + h3 * 128; const LAS float* dts = dtsb + h3 * 128;
            const float myacs = acs[lcol];
            const float Dh = d_skip[6 * g + 3 * hs + h3];
            f32x16 y0, y1;
#pragma unroll
            for (int i = 0; i < 16; ++i) { y0[i] = 0.f; y1[i] = 0.f; }
            { const bf16* hp = Hin + (((size_t)bc * SSD_HEADS + 6 * g + 3 * hs + h3) * 64 + r) * 128 + 8 * h;
#pragma unroll
              for (int kh = 0; kh < 2; ++kh) {
                  s16x8 hf0[4], hf1[4];
#pragma unroll
                  for (int ks = 0; ks < 4; ++ks) { hf0[ks] = *(const s16x8*)(hp + 16 * (4 * kh + ks)); hf1[ks] = *(const s16x8*)(hp + 32 * 128 + 16 * (4 * kh + ks)); }
#pragma unroll
                  for (int ks = 0; ks < 4; ++ks) { y0 = __builtin_amdgcn_mfma_f32_32x32x16_bf16(cfr[4 * kh + ks], hf0[ks], y0, 0, 0, 0); y1 = __builtin_amdgcn_mfma_f32_32x32x16_bf16(cfr[4 * kh + ks], hf1[ks], y1, 0, 0, 0); }
                  __builtin_amdgcn_sched_barrier(0);
              } }
#pragma unroll
            for (int q4 = 0; q4 < 4; ++q4) {
                const f32x4v a4 = *(const LAS f32x4v*)(acs + 32 * lt + 8 * q4 + 4 * h);
                const float e0 = __expf(a4[0]), e1 = __expf(a4[1]), e2 = __expf(a4[2]), e3 = __expf(a4[3]);
                y0[4 * q4] *= e0; y0[4 * q4 + 1] *= e1; y0[4 * q4 + 2] *= e2; y0[4 * q4 + 3] *= e3;
                y1[4 * q4] *= e0; y1[4 * q4 + 1] *= e1; y1[4 * q4 + 2] *= e2; y1[4 * q4 + 3] *= e3;
            }
            __builtin_amdgcn_sched_barrier(0);
            for (int st = 0; st <= lt; ++st) {
                f32x16 cb;
#pragma unroll
                for (int i = 0; i < 16; ++i) cb[i] = 0.f;
#pragma unroll
                for (int ks = 0; ks < 8; ++ks) {
                    const s16x8 bfrag = *(const LAS s16x8*)(ldsb + SSD_L_BM + (32 * st + r) * SSD_RS_B + (16 * ks + 8 * h) * 2);
                    cb = __builtin_amdgcn_mfma_f32_32x32x16_bf16(bfrag, cfr[ks], cb, 0, 0, 0);
                }
                __builtin_amdgcn_sched_barrier(0);
                const unsigned xb = xb0 + h3 * SSD_XIMG + st * 32 * SSD_RS_X;
                s16x4 xv[8];
                tr_read8<0, 8 * SSD_RS_X, 64, 8 * SSD_RS_X + 64, 16 * SSD_RS_X, 24 * SSD_RS_X, 16 * SSD_RS_X + 64, 24 * SSD_RS_X + 64>(xb, xv);
#pragma unroll
                for (int kk = 0; kk < 2; ++kk) {
                    const int s0 = 32 * st + 16 * kk + 4 * h;
                    const f32x4v as0 = *(const LAS f32x4v*)(acs + s0), as1 = *(const LAS f32x4v*)(acs + s0 + 8);
                    const f32x4v ds0 = *(const LAS f32x4v*)(dts + s0), ds1 = *(const LAS f32x4v*)(dts + s0 + 8);
                    float wv[8];
#pragma unroll
                    for (int j = 0; j < 8; ++j) {
                        const int s = s0 + 8 * (j >> 2) + (j & 3);
                        const float asj = (j < 4) ? as0[j & 3] : as1[j & 3], dsj = (j < 4) ? ds0[j & 3] : ds1[j & 3];
                        float v = cb[8 * kk + j] * __expf(myacs - asj) * dsj;
                        v = (s <= lcol) ? v : 0.f;
                        v = (s == lcol) ? v + Dh : v;
                        wv[j] = v;
                    }
                    s16x8 afr;
                    { v4u o; o.x = pk2(wv[0], wv[1]); o.y = pk2(wv[2], wv[3]); o.z = pk2(wv[4], wv[5]); o.w = pk2(wv[6], wv[7]); afr = __builtin_bit_cast(s16x8, o); }
                    const s16x8 b0 = kk == 0 ? TRCAT(xv[0], xv[1]) : TRCAT(xv[4], xv[5]);
                    const s16x8 b1 = kk == 0 ? TRCAT(xv[2], xv[3]) : TRCAT(xv[6], xv[7]);
                    y0 = __builtin_amdgcn_mfma_f32_32x32x16_bf16(afr, b0, y0, 0, 0, 0);
                    y1 = __builtin_amdgcn_mfma_f32_32x32x16_bf16(afr, b1, y1, 0, 0, 0);
                    __builtin_amdgcn_sched_barrier(0);
                }
            }
#pragma unroll
            for (int i = 0; i < 8; ++i) { ypk[h3][i] = pk2(y0[2 * i], y0[2 * i + 1]); ypk[h3][8 + i] = pk2(y1[2 * i], y1[2 * i + 1]); }
            __builtin_amdgcn_sched_barrier(0);
        }
        __syncthreads();
        {
            LAS unsigned short* yst = (LAS unsigned short*)(ldsb + SSD_L_X);
#pragma unroll
            for (int h3 = 0; h3 < 3; ++h3)
#pragma unroll
                for (int ptile = 0; ptile < 2; ++ptile)
#pragma unroll
                    for (int i = 0; i < 8; ++i) {
                        const int reg = 2 * i;
                        const int l0 = 32 * lt + (reg & 3) + 8 * (reg >> 2) + 4 * h;
                        const int col = (3 * hs + h3) * 64 + 32 * ptile + r;
                        const unsigned v = ypk[h3][8 * ptile + i];
                        yst[l0 * (SSD_RS_Y / 2) + col] = (unsigned short)(v & 0xffffu);
                        yst[(l0 + 1) * (SSD_RS_Y / 2) + col] = (unsigned short)(v >> 16);
                    }
        }
        __syncthreads();
#pragma unroll
        for (int pass = 0; pass < 4; ++pass) {
            const int l = 4 * (pass * 8 + w) + (lane >> 4), i16 = lane & 15;
            float gv[3][8]; float ss = 0.f;
#pragma unroll
            for (int k = 0; k < 3; ++k) {
                const int col0 = 24 * i16 + 8 * k;
                float yv[8], zv[8];
                unpack8(*(const LAS v4u*)(ldsb + SSD_L_X + l * SSD_RS_Y + col0 * 2), yv);
                unpack8(*(const v4u*)(projb + (size_t)(t0 + l) * NB_LD + g * 384 + col0), zv);
#pragma unroll
                for (int j = 0; j < 8; ++j) { const float gg = yv[j] * silu_f(zv[j]); gv[k][j] = gg; ss += gg * gg; }
            }
            ss += __shfl_xor(ss, 1); ss += __shfl_xor(ss, 2); ss += __shfl_xor(ss, 4); ss += __shfl_xor(ss, 8);
            const float rstd = rsqrtf(ss * (1.0f / 384.0f) + LN_EPS);
#pragma unroll
            for (int k = 0; k < 3; ++k) {
                const int col0 = g * 384 + 24 * i16 + 8 * k;
                const float4 g0 = *(const float4*)(norm_g + col0), g1 = *(const float4*)(norm_g + col0 + 4);
                v4u o; o.x = pk2(gv[k][0] * rstd * g0.x, gv[k][1] * rstd * g0.y); o.y = pk2(gv[k][2] * rstd * g0.z, gv[k][3] * rstd * g0.w);
                o.z = pk2(gv[k][4] * rstd * g1.x, gv[k][5] * rstd * g1.y); o.w = pk2(gv[k][6] * rstd * g1.z, gv[k][7] * rstd * g1.w);
                *(v4u*)(A1 + (size_t)(t0 + l) * MIX_WIDTH + col0) = o;
            }
        }
    }
}

#define ATT_RS_V 144
#define ATT_VIMG (256 * ATT_RS_V)
#define ATT_HIMG (2 * ATT_VIMG)
#define ATT_PVT(KT) { \
        s16x4 vv_[8]; \
        tr_read8<(32 * KT) * ATT_RS_V, (32 * KT + 8) * ATT_RS_V, (32 * KT) * ATT_RS_V + 64, (32 * KT + 8) * ATT_RS_V + 64, \
                 (32 * KT + 16) * ATT_RS_V, (32 * KT + 24) * ATT_RS_V, (32 * KT + 16) * ATT_RS_V + 64, (32 * KT + 24) * ATT_RS_V + 64>(vbase, vv_); \
        _Pragma("unroll") for (int s2_ = 0; s2_ < 2; ++s2_) { \
            v4u o_; o_.x = pk2(s[KT][8 * s2_ + 0], s[KT][8 * s2_ + 1]); o_.y = pk2(s[KT][8 * s2_ + 2], s[KT][8 * s2_ + 3]); \
            o_.z = pk2(s[KT][8 * s2_ + 4], s[KT][8 * s2_ + 5]); o_.w = pk2(s[KT][8 * s2_ + 6], s[KT][8 * s2_ + 7]); \
            const s16x8 pf_ = __builtin_bit_cast(s16x8, o_); \
            const s16x8 a0_ = s2_ == 0 ? TRCAT(vv_[0], vv_[1]) : TRCAT(vv_[4], vv_[5]); \
            const s16x8 a1_ = s2_ == 0 ? TRCAT(vv_[2], vv_[3]) : TRCAT(vv_[6], vv_[7]); \
            o0 = __builtin_amdgcn_mfma_f32_32x32x16_bf16(a0_, pf_, o0, 0, 0, 0); \
            o1 = __builtin_amdgcn_mfma_f32_32x32x16_bf16(a1_, pf_, o1, 0, 0, 0); } }
__device__ __forceinline__ void ph_attn_prompt(LAS unsigned char* ldsb, const bf16* __restrict__ qrot_b, const bf16* __restrict__ krot_b, const bf16* __restrict__ projb,
                                               bf16* __restrict__ obuf, float* __restrict__ lsebuf, const float* __restrict__ ck, const float* __restrict__ cv, float* __restrict__ out) {
    const int tid = threadIdx.x, w = __builtin_amdgcn_readfirstlane(tid >> 6), lane = tid & 63;
    const int r = lane & 31, h = lane >> 5, blk = (lane >> 4) & 1, q = (lane & 15) >> 2, pp = lane & 3;
    const int qt = w & 3, hsel = w >> 2;
    f32x4n rider[16]; bool pend = false; unsigned pq = 0u;
    for (int unit = blockIdx.x; unit < 3 * 512; unit += gridDim.x) {
        const int pat = unit >> 9, rem = unit & 511, hp = rem & 3, rem2 = rem >> 2, b = rem2 >> 6, bk = rem2 & 63;
        const int dsh = 2 * pat, nper = 64 >> dsh, res = bk >> (6 - dsh), nb = bk & (nper - 1);
        const int head = 2 * hp + hsel;
        __syncthreads();
        { v4u vst[8], kst[8];
#pragma unroll
          for (int it_ = 0; it_ < 8; ++it_) { const int idx = (tid & 255) + it_ * 256;
              const int row = idx >> 3, ch = idx & 7, js = 128 * nb - 128 + row, jc = js < 0 ? 0 : js;
              const size_t tk = (size_t)(b * SEQ + (jc << dsh) + res);
              vst[it_] = *(const v4u*)(projb + tk * NB_LD + NB_V + head * 64 + ch * 8);
              kst[it_] = *(const v4u*)(krot_b + tk * ATT_WIDTH + head * 64 + ch * 8); }
#pragma unroll
          for (int it_ = 0; it_ < 8; ++it_) { const int idx = (tid & 255) + it_ * 256;
              const int row = idx >> 3, ch = idx & 7, js = 128 * nb - 128 + row;
              v4u v = vst[it_], k = kst[it_]; if (js < 0) { v.x = 0u; v.y = 0u; v.z = 0u; v.w = 0u; k = v; }
              *(LAS v4u*)(ldsb + hsel * ATT_HIMG + row * ATT_RS_V + ch * 16) = v;
              *(LAS v4u*)(ldsb + hsel * ATT_HIMG + ATT_VIMG + row * ATT_RS_V + ch * 16) = k; } }
        const int tq = b * SEQ + ((128 * nb + 32 * qt + r) << dsh) + res;
        s16x8 qf[4];
#pragma unroll
        for (int ks = 0; ks < 4; ++ks) qf[ks] = *(const s16x8*)(qrot_b + (size_t)tq * ATT_WIDTH + head * 64 + 16 * ks + 8 * h);
        __syncthreads();
        f32x16 s[5];
#pragma unroll
        for (int kt = 0; kt < 5; ++kt) {
            const LAS unsigned char* kp = ldsb + hsel * ATT_HIMG + ATT_VIMG + (32 * qt + 32 * kt + r) * ATT_RS_V + 16 * h;
#pragma unroll
            for (int i = 0; i < 16; ++i) s[kt][i] = 0.f;
#pragma unroll
            for (int ks = 0; ks < 4; ++ks) s[kt] = __builtin_amdgcn_mfma_f32_32x32x16_bf16(*(const LAS s16x8*)(kp + 32 * ks), qf[ks], s[kt], 0, 0, 0);
        }
        if (pend) copy_q_store(out, pq, (unsigned)lane, rider);
        float m = -INFINITY;
#pragma unroll
        for (int kt = 0; kt < 5; ++kt) {
            const bool tile_ok = (nb > 0) || (qt + kt >= 4);
#pragma unroll
            for (int reg = 0; reg < 16; ++reg) {
                const int c = (reg & 3) + 8 * (reg >> 2) + 4 * h;
                const bool ok = tile_ok && (kt == 0 ? (c >= r) : (kt == 4 ? (c <= r) : true));
                const float v = ok ? s[kt][reg] * 0.125f : -INFINITY;
                s[kt][reg] = v; m = fmaxf(m, v);
            }
        }
        m = fmaxf(m, __shfl_xor(m, 32));
        float l = 0.f;
#pragma unroll
        for (int kt = 0; kt < 5; ++kt)
#pragma unroll
            for (int reg = 0; reg < 16; ++reg) { const float p = __expf(s[kt][reg] - m); s[kt][reg] = p; l += p; }
        l += __shfl_xor(l, 32);
        pq = (unsigned)(unit * NWAVE + w); copy_q_load(ck, cv, pq, (unsigned)lane, rider); pend = true;
        f32x16 o0, o1;
#pragma unroll
        for (int i = 0; i < 16; ++i) { o0[i] = 0.f; o1[i] = 0.f; }
        const unsigned vbase = lds_addr(ldsb + hsel * ATT_HIMG) + (32 * qt + 4 * h + q) * ATT_RS_V + (16 * blk + 4 * pp) * 2;
        ATT_PVT(0) ATT_PVT(1) ATT_PVT(2) ATT_PVT(3) ATT_PVT(4)
        const float inv = 1.0f / l;
        bf16* op = obuf + ((size_t)pat * T_PROMPT + tq) * ATT_WIDTH + head * 64 + 4 * h;
#pragma unroll
        for (int q4 = 0; q4 < 4; ++q4) {
            *(uint2*)(op + 8 * q4) = make_uint2(pk2(o0[4 * q4] * inv, o0[4 * q4 + 1] * inv), pk2(o0[4 * q4 + 2] * inv, o0[4 * q4 + 3] * inv));
            *(uint2*)(op + 32 + 8 * q4) = make_uint2(pk2(o1[4 * q4] * inv, o1[4 * q4 + 1] * inv), pk2(o1[4 * q4 + 2] * inv, o1[4 * q4 + 3] * inv));
        }
        if (h == 0) lsebuf[((size_t)pat * T_PROMPT + tq) * 8 + head] = m + __logf(l);
    }
    if (pend) copy_q_store(out, pq, (unsigned)lane, rider);
}
__device__ __forceinline__ void ph_attn_combine(const bf16* __restrict__ obuf, const float* __restrict__ lsebuf, bf16* __restrict__ A1) {
    const int lane = threadIdx.x & 63;
#pragma unroll 4
    for (int t = blockIdx.x * NWAVE + (threadIdx.x >> 6); t < T_PROMPT; t += gridDim.x * NWAVE) {
        const int hd = lane >> 3;
        const float l0 = lsebuf[((size_t)0 * T_PROMPT + t) * 8 + hd], l1 = lsebuf[((size_t)1 * T_PROMPT + t) * 8 + hd], l2 = lsebuf[((size_t)2 * T_PROMPT + t) * 8 + hd];
        const float mx = fmaxf(l0, fmaxf(l1, l2));
        const float e0 = __expf(l0 - mx), e1 = __expf(l1 - mx), e2 = __expf(l2 - mx);
        const float inv = 1.0f / (e0 + e1 + e2);
        float a[8], b[8], c[8];
        unpack8(*(const v4u*)(obuf + ((size_t)0 * T_PROMPT + t) * ATT_WIDTH + lane * 8), a);
        unpack8(*(const v4u*)(obuf + ((size_t)1 * T_PROMPT + t) * ATT_WIDTH + lane * 8), b);
        unpack8(*(const v4u*)(obuf + ((size_t)2 * T_PROMPT + t) * ATT_WIDTH + lane * 8), c);
        float o[8];
#pragma unroll
        for (int j = 0; j < 8; ++j) o[j] = (e0 * a[j] + e1 * b[j] + e2 * c[j]) * inv;
        v4u w; w.x = pk2(o[0], o[1]); w.y = pk2(o[2], o[3]); w.z = pk2(o[4], o[5]); w.w = pk2(o[6], o[7]);
        *(v4u*)(A1 + (size_t)t * MIX_WIDTH + SSD_WIDTH + lane * 8) = w;
    }
}

#define RT_RS 272
#define RT_KIMG (128 * RT_RS)
#define RT_LUT (2 * RT_KIMG)
constexpr unsigned char RT_CANDS[64] = {0, 1, 2, 3, 4, 5, 6, 7, 8, 9, 10, 11, 12, 13, 14, 15, 16, 17, 18, 19, 20, 21, 22, 23, 32, 33, 34, 35, 36, 48, 49, 50, 51, 64, 65, 66, 80, 81, 96, 97,
                                        112, 113, 128, 144, 160, 176, 192, 208, 224, 240, 0, 0, 0, 0, 0, 0, 0, 0, 0, 0, 0, 0, 0, 0};
__device__ __forceinline__ unsigned rt_mono(float f) { const unsigned u = __builtin_bit_cast(unsigned, f); return u ^ ((unsigned)((int)u >> 31) | 0x80000000u); }
__device__ __forceinline__ float rt_unmono(unsigned m) { const unsigned u = (m & 0x80000000u) ? (m ^ 0x80000000u) : ~m; return __builtin_bit_cast(float, u); }
#define RT_CE_DESC(a, b) { const unsigned x_ = (a), y_ = (b); (a) = x_ > y_ ? x_ : y_; (b) = x_ > y_ ? y_ : x_; }
#define RT_CE_ASC(a, b) { const unsigned x_ = (a), y_ = (b); (a) = x_ > y_ ? y_ : x_; (b) = x_ > y_ ? x_ : y_; }
__device__ __forceinline__ void rt_sort16(unsigned (&v)[16]) {
#pragma unroll
    for (int k = 2; k <= 16; k <<= 1)
#pragma unroll
        for (int j = k >> 1; j > 0; j >>= 1)
#pragma unroll
            for (int i = 0; i < 16; ++i) { const int l = i ^ j; if (l > i) { if ((i & k) == 0) RT_CE_DESC(v[i], v[l]) else RT_CE_ASC(v[i], v[l]) } }
}
__device__ __forceinline__ void rt_merge16(unsigned (&v)[16]) {
#pragma unroll
    for (int j = 8; j > 0; j >>= 1)
#pragma unroll
        for (int i = 0; i < 16; ++i) { const int l = i ^ j; if (l > i) RT_CE_DESC(v[i], v[l]) }
}
__device__ __forceinline__ void rt_top16(unsigned (&a)[16], const unsigned (&b)[16]) {
#pragma unroll
    for (int i = 0; i < 16; ++i) a[i] = a[i] > b[15 - i] ? a[i] : b[15 - i];
    rt_merge16(a);
}
__device__ __forceinline__ void rt_top16_partner(unsigned (&a)[16]) {
    unsigned b[16];
#pragma unroll
    for (int i = 0; i < 16; ++i) b[i] = (unsigned)__shfl_xor((int)a[i], 32);
    rt_top16(a, b);
}
__device__ __forceinline__ void rt_scores_top16(LAS unsigned char* kimg, const bf16* __restrict__ qp, int r, int h, unsigned (&k0)[16]) {
    f32x16 acc[4];
#pragma unroll
    for (int kt = 0; kt < 4; ++kt)
#pragma unroll
        for (int i = 0; i < 16; ++i) acc[kt][i] = 0.f;
#pragma unroll
    for (int ks = 0; ks < 8; ++ks) {
        const s16x8 qf = *(const s16x8*)(qp + 16 * ks);
#pragma unroll
        for (int kt = 0; kt < 4; ++kt) {
            const s16x8 kf = *(const LAS s16x8*)(kimg + (32 * kt + r) * RT_RS + (16 * ks + 8 * h) * 2);
            acc[kt] = __builtin_amdgcn_mfma_f32_32x32x16_bf16(kf, qf, acc[kt], 0, 0, 0);
        }
    }
    unsigned k1[16], k2[16], k3[16];
#pragma unroll
    for (int reg = 0; reg < 16; ++reg) {
        const unsigned ki = (unsigned)((reg & 3) + 8 * (reg >> 2) + 4 * h);
        k0[reg] = (rt_mono(acc[0][reg]) & 0xFFFFFF80u) | ki;
        k1[reg] = (rt_mono(acc[1][reg]) & 0xFFFFFF80u) | (ki + 32u);
        k2[reg] = (rt_mono(acc[2][reg]) & 0xFFFFFF80u) | (ki + 64u);
        k3[reg] = (rt_mono(acc[3][reg]) & 0xFFFFFF80u) | (ki + 96u);
    }
    rt_sort16(k0); rt_sort16(k1); rt_sort16(k2); rt_sort16(k3);
    rt_top16(k0, k1); rt_top16(k2, k3); rt_top16(k0, k2);
    rt_top16_partner(k0);
}
__device__ __forceinline__ void ph_peer_route2(LAS unsigned char* ldsb, const bf16* __restrict__ qhb, const float* __restrict__ keys1, const float* __restrict__ keys2,
                                               int* __restrict__ eidx, float* __restrict__ gate, const float* __restrict__ ck, const float* __restrict__ cv, float* __restrict__ out) {
    const int tid = threadIdx.x, w = __builtin_amdgcn_readfirstlane(tid >> 6), lane = tid & 63, r = lane & 31, h = lane >> 5;
    __syncthreads();
    for (int idx = tid; idx < 2 * 128 * 16; idx += NTHR) {
        const int tb = idx >> 11, rem = idx & 2047, row = rem >> 4, ch = rem & 15;
        const float* sp = (tb ? keys2 : keys1) + row * 128 + ch * 8;
        const float4 a = *(const float4*)sp, b = *(const float4*)(sp + 4);
        v4u o; o.x = pk2(a.x, a.y); o.y = pk2(a.z, a.w); o.z = pk2(b.x, b.y); o.w = pk2(b.z, b.w);
        *(LAS v4u*)(ldsb + tb * RT_KIMG + row * RT_RS + ch * 16) = o;
    }
    __syncthreads();
    LAS unsigned* lut = (LAS unsigned*)(ldsb + RT_LUT) + w * 512;
    for (int unit = blockIdx.x * NWAVE + w; unit < (T_ALL / 32) * 8; unit += gridDim.x * NWAVE) {
        const int tt = unit >> 3, hd = unit & 7;
        const int tok = 32 * tt + r;
        const bf16* qp = qhb + (size_t)tok * 2048 + hd * 256 + 8 * h;
        unsigned ka[16], kb[16];
        rt_scores_top16(ldsb, qp, r, h, ka);
        rt_scores_top16(ldsb + RT_KIMG, qp + 128, r, h, kb);
        float v1[16], v2[16];
#pragma unroll
        for (int i = 0; i < 16; ++i) { v1[i] = rt_unmono(ka[i] & 0xFFFFFF80u); v2[i] = rt_unmono(kb[i] & 0xFFFFFF80u); }
#pragma unroll
        for (int wd = 0; wd < 4; ++wd) {
            lut[wd * 64 + lane] = (ka[4 * wd] & 0x7Fu) | ((ka[4 * wd + 1] & 0x7Fu) << 8) | ((ka[4 * wd + 2] & 0x7Fu) << 16) | ((ka[4 * wd + 3] & 0x7Fu) << 24);
            lut[(4 + wd) * 64 + lane] = (kb[4 * wd] & 0x7Fu) | ((kb[4 * wd + 1] & 0x7Fu) << 8) | ((kb[4 * wd + 2] & 0x7Fu) << 16) | ((kb[4 * wd + 3] & 0x7Fu) << 24);
        }
        unsigned c0[16], c1[16];
        c0[0] = (rt_mono(h ? (v1[0] + v2[1]) : (v1[0] + v2[0])) & 0xFFFFFF00u) | (h ? 1u : 0u);
        c0[1] = (rt_mono(h ? (v1[0] + v2[3]) : (v1[0] + v2[2])) & 0xFFFFFF00u) | (h ? 3u : 2u);
        c0[2] = (rt_mono(h ? (v1[0] + v2[5]) : (v1[0] + v2[4])) & 0xFFFFFF00u) | (h ? 5u : 4u);
        c0[3] = (rt_mono(h ? (v1[0] + v2[7]) : (v1[0] + v2[6])) & 0xFFFFFF00u) | (h ? 7u : 6u);
        c0[4] = (rt_mono(h ? (v1[0] + v2[9]) : (v1[0] + v2[8])) & 0xFFFFFF00u) | (h ? 9u : 8u);
        c0[5] = (rt_mono(h ? (v1[0] + v2[11]) : (v1[0] + v2[10])) & 0xFFFFFF00u) | (h ? 11u : 10u);
        c0[6] = (rt_mono(h ? (v1[0] + v2[13]) : (v1[0] + v2[12])) & 0xFFFFFF00u) | (h ? 13u : 12u);
        c0[7] = (rt_mono(h ? (v1[0] + v2[15]) : (v1[0] + v2[14])) & 0xFFFFFF00u) | (h ? 15u : 14u);
        c0[8] = (rt_mono(h ? (v1[1] + v2[1]) : (v1[1] + v2[0])) & 0xFFFFFF00u) | (h ? 17u : 16u);
        c0[9] = (rt_mono(h ? (v1[1] + v2[3]) : (v1[1] + v2[2])) & 0xFFFFFF00u) | (h ? 19u : 18u);
        c0[10] = (rt_mono(h ? (v1[1] + v2[5]) : (v1[1] + v2[4])) & 0xFFFFFF00u) | (h ? 21u : 20u);
        c0[11] = (rt_mono(h ? (v1[1] + v2[7]) : (v1[1] + v2[6])) & 0xFFFFFF00u) | (h ? 23u : 22u);
        c0[12] = (rt_mono(h ? (v1[2] + v2[1]) : (v1[2] + v2[0])) & 0xFFFFFF00u) | (h ? 33u : 32u);
        c0[13] = (rt_mono(h ? (v1[2] + v2[3]) : (v1[2] + v2[2])) & 0xFFFFFF00u) | (h ? 35u : 34u);
        c0[14] = (rt_mono(h ? (v1[3] + v2[0]) : (v1[2] + v2[4])) & 0xFFFFFF00u) | (h ? 48u : 36u);
        c0[15] = (rt_mono(h ? (v1[3] + v2[2]) : (v1[3] + v2[1])) & 0xFFFFFF00u) | (h ? 50u : 49u);
        c1[0] = (rt_mono(h ? (v1[4] + v2[0]) : (v1[3] + v2[3])) & 0xFFFFFF00u) | (h ? 64u : 51u);
        c1[1] = (rt_mono(h ? (v1[4] + v2[2]) : (v1[4] + v2[1])) & 0xFFFFFF00u) | (h ? 66u : 65u);
        c1[2] = (rt_mono(h ? (v1[5] + v2[1]) : (v1[5] + v2[0])) & 0xFFFFFF00u) | (h ? 81u : 80u);
        c1[3] = (rt_mono(h ? (v1[6] + v2[1]) : (v1[6] + v2[0])) & 0xFFFFFF00u) | (h ? 97u : 96u);
        c1[4] = (rt_mono(h ? (v1[7] + v2[1]) : (v1[7] + v2[0])) & 0xFFFFFF00u) | (h ? 113u : 112u);
        c1[5] = (rt_mono(h ? (v1[9] + v2[0]) : (v1[8] + v2[0])) & 0xFFFFFF00u) | (h ? 144u : 128u);
        c1[6] = (rt_mono(h ? (v1[11] + v2[0]) : (v1[10] + v2[0])) & 0xFFFFFF00u) | (h ? 176u : 160u);
        c1[7] = (rt_mono(h ? (v1[13] + v2[0]) : (v1[12] + v2[0])) & 0xFFFFFF00u) | (h ? 208u : 192u);
        c1[8] = (rt_mono(h ? (v1[15] + v2[0]) : (v1[14] + v2[0])) & 0xFFFFFF00u) | (h ? 240u : 224u);
        c1[9] = 0u;
        c1[10] = 0u;
        c1[11] = 0u;
        c1[12] = 0u;
        c1[13] = 0u;
        c1[14] = 0u;
        c1[15] = 0u;
        rt_sort16(c0); rt_sort16(c1); rt_top16(c0, c1); rt_top16_partner(c0);
        float e[16]; float sum = 0.f;
        const float mx = rt_unmono(c0[0] & 0xFFFFFF00u);
#pragma unroll
        for (int k = 0; k < 16; ++k) { e[k] = __expf(rt_unmono(c0[k] & 0xFFFFFF00u) - mx); sum += e[k]; }
        const float inv = 1.0f / sum;
        asm volatile("s_waitcnt lgkmcnt(0)" ::: "memory");
        int ex[8]; float gv[8];
#pragma unroll
        for (int k = 0; k < 8; ++k) {
            const unsigned hm = (unsigned)(-h);
            const unsigned ck = (c0[k] & ~hm) | (c0[8 + k] & hm);
            const float ek = __builtin_bit_cast(float, (__builtin_bit_cast(unsigned, e[k]) & ~hm) | (__builtin_bit_cast(unsigned, e[8 + k]) & hm));
            const unsigned ci = (ck >> 4) & 15u, cj = ck & 15u;
            const unsigned w1 = lut[(ci >> 2) * 64 + lane], w2 = lut[(4 + (cj >> 2)) * 64 + lane];
            const unsigned i1 = (w1 >> (8 * (ci & 3))) & 0x7Fu, i2 = (w2 >> (8 * (cj & 3))) & 0x7Fu;
            ex[k] = (int)(i1 * PEER_NKEYS + i2); gv[k] = ek * inv;
        }
        int* ep = eidx + (size_t)tok * 128 + hd * 16 + 8 * h; float* gp = gate + (size_t)tok * 128 + hd * 16 + 8 * h;
        *(int4*)ep = make_int4(ex[0], ex[1], ex[2], ex[3]); *(int4*)(ep + 4) = make_int4(ex[4], ex[5], ex[6], ex[7]);
        *(float4*)gp = make_float4(gv[0], gv[1], gv[2], gv[3]); *(float4*)(gp + 4) = make_float4(gv[4], gv[5], gv[6], gv[7]);
    }
    { const unsigned gwv = blockIdx.x * NWAVE + w; if (gridDim.x == 256 && gwv >= 128u) cache_copy_slice(ck, cv, out, 7040u + (gwv - 128u), (unsigned)lane); }
}

struct Params {
    const float* in[23];
    float* out;
    unsigned char* ws;
    unsigned* bar;
};

#define WS_BAR      0ull
#define WS_XALL     (1ull << 20)
#define WS_PROJ     (WS_XALL + (size_t)T_ALL * D_MODEL * 4)
#define WS_XBC      (WS_PROJ + (size_t)T_ALL * PROJ_LD * 4)
#define WS_DT       (WS_XBC + (size_t)T_ALL * CONV_DIM * 4)
#define WS_QROT     (WS_DT + (size_t)T_ALL * SSD_HEADS * 4)
#define WS_KROT     (WS_QROT + (size_t)T_ALL * ATT_WIDTH * 4)
#define WS_YBUF     (WS_KROT + (size_t)T_ALL * ATT_WIDTH * 4)
#define WS_MIX      (WS_YBUF + (size_t)T_ALL * MIX_WIDTH * 4)
#define WS_HBUF     (WS_MIX + (size_t)T_ALL * D_MODEL * 4)
#define WS_QH       (WS_HBUF + (size_t)T_ALL * D_MODEL * 4)
#define WS_EIDX     (WS_QH + (size_t)T_ALL * 2048 * 4)
#define WS_GATE     (WS_EIDX + (size_t)T_ALL * 128 * 4)
#define WS_A0       (WS_GATE + (size_t)T_ALL * 128 * 4)
#define WS_A1       (WS_A0 + (size_t)T_ALL * D_MODEL * 2)
#define WS_A2       (WS_A1 + (size_t)T_ALL * MIX_WIDTH * 2)
#define WS_WTIN     (WS_A2 + (size_t)T_ALL * D_MODEL * 2)
#define WS_WTOUT    (WS_WTIN + (size_t)PROJ_LD * D_MODEL * 2)
#define WS_WTQ      (WS_WTOUT + (size_t)D_MODEL * MIX_WIDTH * 2)
#define WS_PROJB    (WS_WTQ + (size_t)2048 * D_MODEL * 2)
#define WS_DTRAW    (WS_PROJB + (size_t)T_ALL * NB_LD * 2)
#define WS_XBCB     (WS_DTRAW + (size_t)T_ALL * 32 * 4)
#define WS_QROTB    (WS_XBCB + (size_t)T_ALL * CONV_DIM * 2)
#define WS_KROTB    (WS_QROTB + (size_t)T_ALL * ATT_WIDTH * 2)
#define WS_UB       (WS_KROTB + (size_t)T_ALL * ATT_WIDTH * 2)
#define WS_VB       (WS_UB + (size_t)16384 * D_MODEL * 2)
#define WS_USC      (WS_VB + (size_t)16384 * D_MODEL * 2)
#define WS_VSC      (WS_USC + 16384 * 4)
#define WS_SBUF     (WS_VSC + 16384 * 4)
#define WS_HIN      (WS_SBUF + (size_t)BATCH * 64 * SSD_HEADS * 64 * 128 * 2)
#define WS_CDEC     (WS_HIN + (size_t)BATCH * 64 * SSD_HEADS * 64 * 128 * 2)
#define WS_OBUF     (WS_CDEC + (size_t)BATCH * 64 * SSD_HEADS * 4)
#define WS_LSE      (WS_OBUF + (size_t)3 * T_PROMPT * ATT_WIDTH * 2)
#define WS_ROPE     (WS_LSE + (size_t)3 * T_PROMPT * 8 * 4)
#define WS_END      (WS_ROPE + (size_t)SEQ * 64 * 4)

#define LDS_BYTES (160 * 1024)

#define KP const __attribute__((address_space(4))) Params* kp = (const __attribute__((address_space(4))) Params*)__builtin_amdgcn_kernarg_segment_ptr(); asm volatile("" : "+s"(kp)); unsigned char* ws = kp->ws; (void)ws;
#define IN(i) (kp->in[i])
#define WSP(T, off) ((T*)(ws + (off)))
__global__ void __launch_bounds__(512, 2) mega_fwd(Params p) {
    extern __shared__ __attribute__((aligned(16))) unsigned char smem[];
    if (threadIdx.x == 0) *(uint4*)smem = make_uint4(0u, 0u, 0u, 0u);
    __syncthreads();
    XcdBarrier bar = xcd_barrier_post(p.bar, (volatile LAS unsigned*)smem);
    float* lds = (float*)(smem + 256);
    LAS unsigned char* ldsb = (LAS unsigned char*)smem + 256;

    { KP ph_prologue(ldsb, IN(0), IN(1), WSP(bf16, WS_A0), IN(6), WSP(bf16, WS_WTIN), WSP(float, WS_ROPE)); }
    xcd_barrier(bar);
    { KP pg8::Gemm g{WSP(bf16, WS_A0), WSP(bf16, WS_WTIN), T_ALL, PROJ_LD, D_MODEL}; pg8::StaticOrder S; S.init(g.M, g.N, (int)gridDim.x, (int)blockIdx.x);
      pg8::EpiProj E{WSP(bf16, WS_PROJB), WSP(float, WS_DTRAW)}; pg8::gemm_phase<pg8::EpiProj, pg8::StaticOrder, false>(ldsb, g, S, E, nullptr); }
    xcd_barrier(bar);
    { KP ph_post_proj_prompt(WSP(bf16, WS_PROJB), WSP(float, WS_DTRAW), IN(7), IN(8), IN(9), WSP(float, WS_ROPE), WSP(bf16, WS_XBCB), WSP(float, WS_DT), WSP(bf16, WS_QROTB), WSP(bf16, WS_KROTB), kp->out); }
    { KP ph_post_proj2(WSP(bf16, WS_PROJB), WSP(float, WS_DTRAW), IN(4), IN(7), IN(8), IN(9), WSP(bf16, WS_XBCB), WSP(float, WS_DT), WSP(bf16, WS_QROTB), WSP(bf16, WS_KROTB), kp->out); }
    xcd_barrier(bar);
    { KP ph_ssd_states(ldsb, WSP(bf16, WS_XBCB), WSP(float, WS_DT), IN(10), WSP(bf16, WS_SBUF), WSP(float, WS_CDEC), IN(2), IN(3), kp->out); }
    __syncthreads();
    { KP ph_attn_prompt(ldsb, WSP(bf16, WS_QROTB), WSP(bf16, WS_KROTB), WSP(bf16, WS_PROJB), WSP(bf16, WS_OBUF), WSP(float, WS_LSE), IN(2), IN(3), kp->out); }
    __syncthreads();
    { KP ph_ssd_decode(WSP(bf16, WS_XBCB), WSP(float, WS_DT), IN(10), IN(11), IN(5), WSP(float, WS_YBUF), kp->out); }
    { KP ph_attn_sample3(lds, WSP(bf16, WS_QROTB), WSP(bf16, WS_KROTB), WSP(bf16, WS_PROJB), IN(2), IN(3), WSP(bf16, WS_A1)); }
    xcd_barrier(bar);
    if ((int)gridDim.x > 128) {
        if ((int)blockIdx.x < 96) { KP ph_ssd_scan(WSP(bf16, WS_SBUF), WSP(float, WS_CDEC), WSP(bf16, WS_HIN), kp->out, (int)blockIdx.x, 96); }
        else {
            { KP ph_prologue2(ldsb, IN(13), WSP(bf16, WS_WTOUT), IN(16), WSP(bf16, WS_WTQ), (int)blockIdx.x - 96, (int)gridDim.x - 96); }
            { KP ph_quant_tables(IN(19), IN(20), WSP(unsigned char, WS_UB), WSP(unsigned char, WS_VB), WSP(float, WS_USC), WSP(float, WS_VSC), (int)blockIdx.x - 96, (int)gridDim.x - 96); }
        }
    } else {
        { KP ph_ssd_scan(WSP(bf16, WS_SBUF), WSP(float, WS_CDEC), WSP(bf16, WS_HIN), kp->out, (int)blockIdx.x, (int)gridDim.x); }
        { KP ph_prologue2(ldsb, IN(13), WSP(bf16, WS_WTOUT), IN(16), WSP(bf16, WS_WTQ), (int)blockIdx.x, (int)gridDim.x); }
        { KP ph_quant_tables(IN(19), IN(20), WSP(unsigned char, WS_UB), WSP(unsigned char, WS_VB), WSP(float, WS_USC), WSP(float, WS_VSC), (int)blockIdx.x, (int)gridDim.x); }
    }
    xcd_barrier(bar);
    { KP ph_ssd_out(ldsb, WSP(bf16, WS_XBCB), WSP(bf16, WS_PROJB), WSP(float, WS_DT), IN(10), IN(11), IN(12), WSP(bf16, WS_HIN), WSP(bf16, WS_A1)); }
    { KP ph_attn_combine(WSP(bf16, WS_OBUF), WSP(float, WS_LSE), WSP(bf16, WS_A1)); }
    { KP ph_gate_norm(WSP(bf16, WS_PROJB), IN(12), WSP(float, WS_YBUF), WSP(bf16, WS_A1)); }
    xcd_barrier(bar);
    { KP pg8::Gemm g{WSP(bf16, WS_A1), WSP(bf16, WS_WTOUT), T_ALL, D_MODEL, MIX_WIDTH}; pg8::StaticOrder S; S.init(g.M, g.N, (int)gridDim.x, (int)blockIdx.x);
      pg8::EpiBf16Plain E{WSP(bf16, WS_MIX), D_MODEL}; pg8::gemm_phase<pg8::EpiBf16Plain, pg8::StaticOrder, false>(ldsb, g, S, E, nullptr); }
    if (blockIdx.x >= 8 && gridDim.x == 256) { KP cache_copy_slice(IN(2), IN(3), kp->out, 4096u + (blockIdx.x - 8) * 8u + (threadIdx.x >> 6), threadIdx.x & 63u); }
    xcd_barrier(bar);
    { KP ph_ln_res(IN(0), IN(1), WSP(bf16, WS_MIX), IN(14), IN(15), WSP(bf16, WS_A2)); }
    xcd_barrier(bar);
    { KP pg8::Gemm g{WSP(bf16, WS_A2), WSP(bf16, WS_WTQ), T_ALL, 2048, D_MODEL}; pg8::StaticOrder S; S.init(g.M, g.N, (int)gridDim.x, (int)blockIdx.x);
      pg8::EpiBf16Plain E{WSP(bf16, WS_QH), 2048}; pg8::gemm_phase<pg8::EpiBf16Plain, pg8::StaticOrder, false>(ldsb, g, S, E, nullptr); }
    if (blockIdx.x >= 16 && gridDim.x == 256 && threadIdx.x < 256) { KP cache_copy_slice(IN(2), IN(3), kp->out, 4096u + 1984u + (blockIdx.x - 16) * 4u + (threadIdx.x >> 6), threadIdx.x & 63u); }
    xcd_barrier(bar);
    { KP ph_peer_route2(ldsb, WSP(bf16, WS_QH), IN(17), IN(18), WSP(int, WS_EIDX), WSP(float, WS_GATE), IN(2), IN(3), kp->out); }
    xcd_barrier(bar);
    { KP ph_peer_ffn3(WSP(bf16, WS_A2), WSP(int, WS_EIDX), WSP(float, WS_GATE), WSP(unsigned char, WS_UB), WSP(unsigned char, WS_VB), WSP(float, WS_USC), WSP(float, WS_VSC), IN(21), IN(22), kp->out, IN(2), IN(3), gridDim.x == 256 ? 8960u : 4096u); }
}

extern "C" void kernel_launch(void* const* d_in, const int* in_sizes, int n_in, void* d_out, int out_size, void* d_ws, size_t ws_size, hipStream_t stream) {
    static int grid = 0;
    if (grid == 0) {
        int dev = 0, cus = 0, per_cu = 0;
        if (hipGetDevice(&dev) != hipSuccess || hipDeviceGetAttribute(&cus, hipDeviceAttributeMultiprocessorCount, dev) != hipSuccess) { fprintf(stderr, "kernel_launch: device query failed\n"); grid = -1; return; }
        if (hipFuncSetAttribute((const void*)mega_fwd, hipFuncAttributeMaxDynamicSharedMemorySize, LDS_BYTES) != hipSuccess) { fprintf(stderr, "kernel_launch: hipFuncSetAttribute failed\n"); grid = -1; return; }
        if (hipOccupancyMaxActiveBlocksPerMultiprocessor(&per_cu, (const void*)mega_fwd, NTHR, LDS_BYTES) != hipSuccess || per_cu < 1) { fprintf(stderr, "kernel_launch: occupancy query says %d\n", per_cu); }
        (void)hipGetLastError();
        grid = cus;
        if (ws_size < WS_END) { fprintf(stderr, "kernel_launch: workspace too small\n"); grid = -1; return; }
    }
    if (grid < 0) return;
    (void)hipMemsetAsync((char*)d_ws + WS_BAR, 0, XCD_BAR_WORDS * sizeof(unsigned), stream);
    Params p{};
    for (int i = 0; i < 23; ++i) p.in[i] = (const float*)d_in[i];
    p.out = (float*)d_out; p.ws = (unsigned char*)d_ws; p.bar = (unsigned*)((char*)d_ws + WS_BAR);
    hipLaunchKernelGGL(mega_fwd, dim3(grid), dim3(NTHR), LDS_BYTES, stream, p);
}
```

```cpp
#include <hip/hip_runtime.h>
#include <stdint.h>

#define D_MODEL 1024
#define BATCH 2
#define SEQ 8192
#define DEC_BATCH 128
#define DEC_SEQ 4
#define PAST_LEN 8192
#define HEAD_DIM 64
#define ATT_WIDTH 512
#define ATT_HEADS 8
#define SSD_WIDTH 1536
#define SSD_HEADS 24
#define SSD_GROUPS 4
#define SSD_STATE 128
#define CONV_DIM 2560
#define IN_WIDTH 5656
#define PROJ_LD 5888
#define MIX_WIDTH 2048
#define WBUF 2048
#define PEER_NKEYS 128
#define PEER_HEADS 8
#define PEER_TOPK 16
#define PEER_DKEY 256
#define T_PROMPT (BATCH * SEQ)
#define T_SAMPLE (DEC_BATCH * DEC_SEQ)
#define T_ALL (T_PROMPT + T_SAMPLE)
#define O_Z 0
#define O_XBC 1536
#define O_DT 4096
#define O_Q 4120
#define O_K 4632
#define O_V 5144
#define ALPHA_F 1.189207115002721f
#define LN_EPS 1e-5f

#define OUT_YP 0ull
#define OUT_YS (OUT_YP + 16777216ull)
#define OUT_PK (OUT_YS + 524288ull)
#define OUT_PV (OUT_PK + 2097152ull)
#define OUT_PC (OUT_PV + 2097152ull)
#define OUT_PS (OUT_PC + 15360ull)
#define OUT_SK (OUT_PS + 393216ull)
#define OUT_SV (OUT_SK + 134217728ull)
#define OUT_SC (OUT_SV + 134217728ull)
#define OUT_SS (OUT_SC + 983040ull)

__constant__ double ROPE_INV_REV[32] = {
    1.59154943091895346e-01, 1.19349370211248862e-01, 8.94994016088910133e-02, 6.71150830052272551e-02,
    5.03292121044870353e-02, 3.77415847174197711e-02, 2.83021958306233987e-02, 2.12236527647776604e-02,
    1.59154943091895339e-02, 1.19349370211248862e-02, 8.94994016088910237e-03, 6.71150830052272534e-03,
    5.03292121044870370e-03, 3.77415847174197719e-03, 2.83021958306233987e-03, 2.12236527647776622e-03,
    1.59154943091895356e-03, 1.19349370211248849e-03, 8.94994016088910237e-04, 6.71150830052272599e-04,
    5.03292121044870326e-04, 3.77415847174197741e-04, 2.83021958306233954e-04, 2.12236527647776605e-04,
    1.59154943091895351e-04, 1.19349370211248862e-04, 8.94994016088910182e-05, 6.71150830052272545e-05,
    5.03292121044870354e-05, 3.77415847174197768e-05, 2.83021958306233961e-05, 2.12236527647776592e-05
};

__device__ __forceinline__ float silu_f(float x) { return x * __builtin_amdgcn_rcpf(1.0f + __expf(-x)); }
__device__ __forceinline__ float softplus_f(float x) { return fmaxf(x, 0.f) + log1pf(__expf(-fabsf(x))); }
__device__ __forceinline__ float gelu_f(float x) { return 0.5f * x * (1.0f + erff(x * 0.70710678118654752f)); }
__device__ __forceinline__ float wave_sum(float v) {
#pragma unroll
    for (int o = 32; o > 0; o >>= 1) v += __shfl_xor(v, o);
    return v;
}
__device__ __forceinline__ float wave_max(float v) {
#pragma unroll
    for (int o = 32; o > 0; o >>= 1) v = fmaxf(v, __shfl_xor(v, o));
    return v;
}

#include <cstdio>
#define XB_TMO      128
#define XB_XCNT(j)  (256  + 64 * (j))
#define XB_XSUB(j)  (1280 + 64 * (j))
#define XB_XGEN(j)  (2304 + 64 * (j))
#define XB_TOP      3328
#define XB_TOPGEN   3392
#define XCD_BAR_WORDS 3456
#define XB_SPIN_CAP (1u << 18)
#define LAS __attribute__((address_space(3)))

__device__ __forceinline__ unsigned xb_ld(unsigned* p)              { return __hip_atomic_load(p, __ATOMIC_RELAXED, __HIP_MEMORY_SCOPE_AGENT); }
__device__ __forceinline__ unsigned xb_add(unsigned* p, unsigned v) { return __hip_atomic_fetch_add(p, v, __ATOMIC_RELAXED, __HIP_MEMORY_SCOPE_AGENT); }
__device__ __forceinline__ unsigned xb_xcc_id() { return (unsigned)__builtin_amdgcn_s_getreg((3 << 11) | 20) & 0xFu; }
#define XB_SPIN(cond, bar) do { unsigned _sp = 0; while (cond) { __builtin_amdgcn_s_sleep(1); \
    if ((++_sp & 255u) == 0u) { if (xb_ld(&(bar)[XB_TMO])) break; if (_sp > XB_SPIN_CAP) { atomicAdd(&(bar)[XB_TMO], 1u); break; } } } } while (0)

struct XcdBarrier {
    unsigned* bar; unsigned x;
    volatile LAS unsigned* st;
};

__device__ __forceinline__ XcdBarrier xcd_barrier_post(unsigned* bar, volatile LAS unsigned* st) {
    XcdBarrier b; b.bar = bar; b.x = xb_xcc_id(); b.st = st;
    if (threadIdx.x == 0) (void)xb_add(&bar[XB_XCNT(b.x)], 1u);
    return b;
}
__device__ __forceinline__ void xcd_barrier_complete(unsigned* bar, unsigned x, unsigned& nloc, unsigned& nx) {
    const unsigned G = gridDim.x * gridDim.y * gridDim.z;
    unsigned sum, cnt, mine, sp = 0u;
    for (;;) {
        sum = 0u; cnt = 0u; mine = 0u;
#pragma unroll
        for (unsigned j = 0; j < 16; ++j) { const unsigned c = xb_ld(&bar[XB_XCNT(j)]); sum += c; cnt += (c > 0u) ? 1u : 0u; mine = (j == x) ? c : mine; }
        if (sum == G) break;
        __builtin_amdgcn_s_sleep(1);
        if ((++sp & 255u) == 0u) { if (xb_ld(&bar[XB_TMO])) break; if (sp > XB_SPIN_CAP) { atomicAdd(&bar[XB_TMO], 1u); break; } }
    }
    nloc = mine > 0u ? mine : 1u; nx = cnt > 0u ? cnt : 1u;
}

__device__ __forceinline__ void xcd_barrier(const XcdBarrier& b) {
    asm volatile("s_waitcnt vmcnt(0)" ::: "memory");
    __syncthreads();
    if (threadIdx.x == 0) {
        unsigned* bar = b.bar;
        __builtin_amdgcn_s_waitcnt(0);
        unsigned nloc = b.st[0], nx = b.st[1];
        if (nloc == 0u) { xcd_barrier_complete(bar, b.x, nloc, nx); b.st[0] = nloc; b.st[1] = nx; }
        const unsigned old = xb_add(&bar[XB_XSUB(b.x)], 1u);
        const unsigned gen = old / nloc;
        if (old + 1u == (gen + 1u) * nloc) {
            __builtin_amdgcn_fence(__ATOMIC_RELEASE, "agent");
            asm volatile("s_waitcnt vmcnt(0)" ::: "memory");
            const unsigned og = xb_add(&bar[XB_TOP], 1u);
            const unsigned tg = og / nx;
            if (og + 1u == (tg + 1u) * nx) xb_add(&bar[XB_TOPGEN], 1u);
            else XB_SPIN(xb_ld(&bar[XB_TOPGEN]) == tg, bar);
            __builtin_amdgcn_fence(__ATOMIC_ACQUIRE, "agent");
            xb_add(&bar[XB_XGEN(b.x)], 1u);
            asm volatile("s_waitcnt vmcnt(0)" ::: "memory");
        } else {
            XB_SPIN(xb_ld(&bar[XB_XGEN(b.x)]) == gen, bar);
            __builtin_amdgcn_fence(__ATOMIC_ACQUIRE, "agent");
            asm volatile("s_waitcnt vmcnt(0)" ::: "memory");
        }
    }
    __syncthreads();
}


#define GAS __attribute__((address_space(1)))
typedef unsigned short bf16;
typedef unsigned v4u __attribute__((ext_vector_type(4)));
#define LDS_WAIT() asm volatile("s_waitcnt lgkmcnt(0)" ::: "memory")
__device__ __forceinline__ unsigned f2bf(float f) { unsigned u = __builtin_bit_cast(unsigned, f); return (u + 0x7fffu + ((u >> 16) & 1u)) >> 16; }
__device__ __forceinline__ unsigned pk2(float lo, float hi) { return f2bf(lo) | (f2bf(hi) << 16); }
__device__ __forceinline__ float bf2f(unsigned short b) { return __builtin_bit_cast(float, (unsigned)b << 16); }
#include <hip/hip_runtime.h>
namespace pg8 {
#define PG8_LAS __attribute__((address_space(3)))
typedef unsigned short bf16_t;
typedef short bf16x8 __attribute__((ext_vector_type(8)));
typedef float f32x4 __attribute__((ext_vector_type(4)));
typedef unsigned u32x4 __attribute__((ext_vector_type(4)));
constexpr int BM = 256, BK = 64, HALF = 128, HTB = HALF * BK * 2  , STAGE_BYTES = 8 * HTB, NXCD = 8, WGM = 8;

__host__ __device__ __forceinline__ int lds_byte(int r, int c) { const int st = (r >> 4) * 2 + (c >> 5), rr = r & 15, cc = c & 31, ob = rr * 64 + cc * 2; return st * 1024 + (ob ^ (((ob >> 9) & 1) << 5)); }
__host__ __device__ __forceinline__ void stage_rc(int b, int& R, int& C) { const int st = b / 1024, sb = b % 1024, swz = sb ^ (((sb >> 9) & 1) << 5); R = (st >> 1) * 16 + swz / 64; C = (st & 1) * 32 + (swz % 64) / 2; }
__host__ __device__ __forceinline__ int perm32(int rho) { const int n = rho >> 4, i = rho & 15; return 8 * (i >> 2) + 4 * n + (i & 3); }

struct Unit { int pm, pn; };
struct Gemm { const bf16_t* A; const bf16_t* Bt; int M, N, K; };

struct StaticOrder {
    int nM, nN, nwg, G, c;
    __host__ __device__ void init(int M, int N, int G_, int c_) { nM = M / BM; nN = N / BM; nwg = nM * nN; G = G_; c = c_; }
    __host__ __device__ bool next(int i, Unit& u) const {
        const long L = (long)i * G + c; if (L >= nwg) return false;
        int wgid = (int)L; { const int q = nwg / NXCD, r = nwg % NXCD, xcd = wgid % NXCD, off = wgid / NXCD; wgid = (xcd < r ? xcd * (q + 1) : r * (q + 1) + (xcd - r) * q) + off; }
        const int nig = WGM * nN, gid = wgid / nig, fm = gid * WGM, gsz = (nM - fm) < WGM ? (nM - fm) : WGM;
        u.pm = fm + ((wgid % nig) % gsz); u.pn = (wgid % nig) / gsz; return true;
    }
    __device__ __forceinline__ void a_ready(const Unit&) const {}
    __device__ __forceinline__ void done(const Unit&) const {}
};
__device__ __forceinline__ unsigned cvt_pk_bf16(float lo, float hi) { unsigned r; asm volatile("v_cvt_pk_bf16_f32 %0, %1, %2" : "=v"(r) : "v"(lo), "v"(hi)); return r; }
typedef float f32x2 __attribute__((ext_vector_type(2)));
__device__ __forceinline__ f32x2 gelu_pk(f32x2 v) {
    const f32x2 av = __builtin_elementwise_abs(v), d = av * 0.2316418882f + 1.0f;
    f32x2 t; t.x = __builtin_amdgcn_rcpf(d.x); t.y = __builtin_amdgcn_rcpf(d.y);
    f32x2 q = t * 0.5307027145f + (-0.7265760135f); q = q * t + 0.7107068705f; q = q * t + (-0.142248368f); q = q * t + 0.127414796f; q = q * t;
    const f32x2 s = (v * v) * (-0.72134752044f);
    f32x2 e; e.x = __builtin_amdgcn_exp2f(s.x); e.y = __builtin_amdgcn_exp2f(s.y);
    const f32x2 m = v * (q * e), r = v - m;
    f32x2 o; o.x = v.x < 0.f ? m.x : r.x; o.y = v.y < 0.f ? m.y : r.y; return o;
}

struct EpiF32 {
    static constexpr bool PERM = false, AFTER_DRAIN = false;
    float* C; int ldc; const float* bias;
    __device__ __forceinline__ void operator()(const f32x4 (&acc)[2][2][4][2], const Unit& u, int wr, int wc, int fr, int fq) const {
        const int row0 = u.pm * BM + wr * 64 + fr, col0 = u.pn * BM + wc * 32 + 4 * fq;
        f32x4 bv[2][2];
#pragma unroll
        for (int bj = 0; bj < 2; ++bj)
#pragma unroll
            for (int n = 0; n < 2; ++n) bv[bj][n] = bias ? *(const f32x4*)(bias + col0 + bj * HALF + n * 16) : (f32x4){0.f, 0.f, 0.f, 0.f};
#pragma unroll
        for (int ai = 0; ai < 2; ++ai)
#pragma unroll
            for (int m = 0; m < 4; ++m) { float* rowp = C + (size_t)(row0 + ai * HALF + m * 16) * ldc + col0;
#pragma unroll
                for (int bj = 0; bj < 2; ++bj)
#pragma unroll
                    for (int n = 0; n < 2; ++n) *(f32x4*)(rowp + bj * HALF + n * 16) = acc[ai][bj][m][n] + bv[bj][n]; }
    }
};

template <class Epi, class Sched, bool STAMP = false>
__device__ __forceinline__ void gemm_phase(PG8_LAS unsigned char* lds, const Gemm g, const Sched& S, const Epi& E, unsigned long long* stamps) {
    int tid = threadIdx.x; asm volatile("" : "+v"(tid));
    const int wid = __builtin_amdgcn_readfirstlane(tid >> 6), lane = tid & 63, wr = wid >> 2, wc = wid & 3, fr = lane & 15, fq = lane >> 4;
    const int K = g.K, nt = K / BK;
    int ts_lo = 0, ts_hi = 0, nts = 0; const unsigned long long rt_entry = STAMP ? (unsigned long long)wall_clock64() : 0ull;
#define PG8_STAMP() do { if (STAMP && wid == 0 && nts < 64) { const unsigned long long _c = (unsigned long long)clock64(); \
        ts_lo = (lane == nts) ? (int)(unsigned)_c : ts_lo; ts_hi = (lane == nts) ? (int)(unsigned)(_c >> 32) : ts_hi; ++nts; } } while (0)
    PG8_STAMP();
    unsigned voffA[2], voffB[2];
#pragma unroll
    for (int i = 0; i < 2; ++i) { int R, C; stage_rc(tid * 16 + i * 8192, R, C); const int Rb = Epi::PERM ? ((R & ~31) + perm32(R & 31)) : R;
        voffA[i] = (unsigned)(R * K + C) * 2u; voffB[i] = (unsigned)(Rb * K + C) * 2u; }
    const size_t kstep = (size_t)(BK * 2);
    const size_t hstep = (size_t)HALF * K * 2;
    const size_t tstep = 2 * hstep;
    const unsigned ldsw = (unsigned)wid * 1024u;
    const int aoff = lds_byte(wr * 64 + fr, fq * 8), boff = lds_byte(wc * 32 + fr, fq * 8);
#define PG8_SA(b, h) (((b) * 2 + (h)) * HTB)
#define PG8_SB(b, h) ((4 + (b) * 2 + (h)) * HTB)
#define PG8_STAGE(bufoff, gbase, voff) do { _Pragma("unroll") for (int _i = 0; _i < 2; ++_i) \
        __builtin_amdgcn_global_load_lds((const unsigned*)((const char*)(gbase) + (voff)[_i]), (PG8_LAS unsigned*)(lds + (bufoff) + ldsw + _i * 8192), 16, 0, 0); } while (0)
#define PG8_LDA(dst, b, h) do { _Pragma("unroll") for (int m = 0; m < 4; ++m) _Pragma("unroll") for (int k = 0; k < 2; ++k) dst[m][k] = *(const PG8_LAS bf16x8*)(lds + PG8_SA(b, h) + aoff + m * 2048 + k * 1024); } while (0)
#define PG8_LDB(dst, b, h) do { _Pragma("unroll") for (int n = 0; n < 2; ++n) _Pragma("unroll") for (int k = 0; k < 2; ++k) dst[n][k] = *(const PG8_LAS bf16x8*)(lds + PG8_SB(b, h) + boff + n * 2048 + k * 1024); } while (0)
#define PG8_MMA(ai, bj, At, Bt) do { __builtin_amdgcn_s_setprio(1); _Pragma("unroll") for (int m = 0; m < 4; ++m) _Pragma("unroll") for (int n = 0; n < 2; ++n) _Pragma("unroll") for (int k = 0; k < 2; ++k) \
        acc[ai][bj][m][n] = __builtin_amdgcn_mfma_f32_16x16x32_bf16(Bt[n][k], At[m][k], acc[ai][bj][m][n], 0, 0, 0); __builtin_amdgcn_s_setprio(0); } while (0)
#define PG8_WAIT_V(n) asm volatile("s_waitcnt vmcnt(" #n ")" ::: "memory")
#define PG8_WAIT_L(n) asm volatile("s_waitcnt lgkmcnt(" #n ")" ::: "memory")
#define PG8_BAR __builtin_amdgcn_s_barrier()
#define PG8_SCHED __builtin_amdgcn_sched_barrier(0)
    Unit cur, nxt; int ui = 0;
    if (!S.next(0, cur)) return;
    f32x4 acc[2][2][4][2];
#pragma unroll
    for (int a = 0; a < 2; ++a)
#pragma unroll
        for (int b = 0; b < 2; ++b)
#pragma unroll
            for (int m = 0; m < 4; ++m)
#pragma unroll
                for (int n = 0; n < 2; ++n) acc[a][b][m][n] = (f32x4){0.f, 0.f, 0.f, 0.f};
    bf16x8 At[4][2], B0[2][2], B1[2][2];
    const char* cA = (const char*)g.A + (size_t)cur.pm * tstep; const char* cB = (const char*)g.Bt + (size_t)cur.pn * tstep;
    S.a_ready(cur);
    PG8_STAGE(PG8_SB(0, 0), cB, voffB); PG8_STAGE(PG8_SA(0, 0), cA, voffA); PG8_STAGE(PG8_SB(0, 1), cB + hstep, voffB); PG8_STAGE(PG8_SA(0, 1), cA + hstep, voffA);
    if (wr == 1) PG8_BAR;
    PG8_WAIT_V(4); PG8_BAR;
    PG8_STAGE(PG8_SB(1, 0), cB + kstep, voffB); PG8_STAGE(PG8_SA(1, 0), cA + kstep, voffA); PG8_STAGE(PG8_SB(1, 1), cB + hstep + kstep, voffB);
    PG8_WAIT_V(6); PG8_BAR;
    PG8_STAMP();
    for (;;) {
        const bool has_next = S.next(ui + 1, nxt);
        const char* nA = has_next ? (const char*)g.A + (size_t)nxt.pm * tstep : cA; const char* nB = has_next ? (const char*)g.Bt + (size_t)nxt.pn * tstep : cB;
        for (int t = 0; t < nt; t += 2) {
            const bool last = (t == nt - 2);
            const char* a1 = cA + (size_t)(t + 1) * kstep;
            const char* a2 = last ? nA : cA + (size_t)(t + 2) * kstep; const char* b2 = last ? nB : cB + (size_t)(t + 2) * kstep;
            const char* a3 = a2 + kstep; const char* b3 = b2 + kstep;
            if (last && has_next) S.a_ready(nxt);
            PG8_LDB(B0, 0, 0); PG8_SCHED; PG8_LDA(At, 0, 0); PG8_STAGE(PG8_SA(1, 1), a1 + hstep, voffA);
            PG8_WAIT_L(8); PG8_BAR; PG8_WAIT_L(0); PG8_MMA(0, 0, At, B0); PG8_BAR; PG8_SCHED;
            PG8_LDB(B1, 0, 1); PG8_STAGE(PG8_SB(0, 0), b2, voffB);
            PG8_BAR; PG8_WAIT_L(0); PG8_MMA(0, 1, At, B1); PG8_BAR;
            PG8_LDA(At, 0, 1); PG8_STAGE(PG8_SA(0, 0), a2, voffA);
            PG8_BAR; PG8_WAIT_L(0); PG8_MMA(1, 0, At, B0); PG8_BAR; PG8_SCHED;
            PG8_STAGE(PG8_SB(0, 1), b2 + hstep, voffB);
            PG8_WAIT_V(6); PG8_BAR; PG8_MMA(1, 1, At, B1); PG8_BAR;
            PG8_LDB(B0, 1, 0); PG8_SCHED; PG8_LDA(At, 1, 0); PG8_STAGE(PG8_SA(0, 1), a2 + hstep, voffA);
            PG8_WAIT_L(8); PG8_BAR; PG8_WAIT_L(0); PG8_MMA(0, 0, At, B0); PG8_BAR; PG8_SCHED;
            PG8_LDB(B1, 1, 1); PG8_STAGE(PG8_SB(1, 0), b3, voffB);
            PG8_BAR; PG8_WAIT_L(0); PG8_MMA(0, 1, At, B1); PG8_BAR;
            PG8_LDA(At, 1, 1); PG8_STAGE(PG8_SA(1, 0), a3, voffA);
            PG8_BAR; PG8_WAIT_L(0); PG8_MMA(1, 0, At, B0); PG8_BAR; PG8_SCHED;
            PG8_STAGE(PG8_SB(1, 1), b3 + hstep, voffB);
            PG8_WAIT_V(6); PG8_BAR; PG8_MMA(1, 1, At, B1); PG8_BAR;
        }
        PG8_STAMP();
        if constexpr (!Epi::AFTER_DRAIN) { E(acc, cur, wr, wc, fr, fq); S.done(cur); }
        PG8_STAMP();
        if (!has_next) break;
#pragma unroll
        for (int a = 0; a < 2; ++a)
#pragma unroll
            for (int b = 0; b < 2; ++b)
#pragma unroll
                for (int m = 0; m < 4; ++m)
#pragma unroll
                    for (int n = 0; n < 2; ++n) acc[a][b][m][n] = (f32x4){0.f, 0.f, 0.f, 0.f};
        cur = nxt; cA = nA; cB = nB; ++ui;
    }
    PG8_WAIT_V(0);
    if (wr == 0) PG8_BAR;
    PG8_BAR;
    if constexpr (Epi::AFTER_DRAIN) { E.fused(acc, cur, wr, wc, fr, fq, lds, wid, lane); S.done(cur); }
    PG8_STAMP();
    if (STAMP && wid == 0) { stamps[lane] = lane < nts ? (((unsigned long long)(unsigned)ts_hi << 32) | (unsigned)ts_lo) : 0ull;
        if (lane == 62) stamps[62] = rt_entry; if (lane == 63) stamps[63] = (unsigned long long)wall_clock64(); }
#undef PG8_STAMP
#undef PG8_SA
#undef PG8_SB
#undef PG8_STAGE
#undef PG8_LDA
#undef PG8_LDB
#undef PG8_MMA
#undef PG8_WAIT_V
#undef PG8_WAIT_L
#undef PG8_BAR
#undef PG8_SCHED
}
}


namespace pg8 {
struct EpiProj {
    static constexpr bool PERM = true, AFTER_DRAIN = false;
    bf16_t* O; float* dtraw;
    __device__ __forceinline__ void operator()(const f32x4 (&acc)[2][2][4][2], const Unit& u, int wr, int wc, int fr, int fq) const {
        const int row0 = u.pm * BM + wr * 64 + fr;
        if (u.pn < 22) {
            const int col0 = u.pn * BM + wc * 32 + 8 * fq;
#pragma unroll
            for (int ai = 0; ai < 2; ++ai)
#pragma unroll
                for (int m = 0; m < 4; ++m) { bf16_t* rowp = O + (size_t)(row0 + ai * HALF + m * 16) * 5632 + col0;
#pragma unroll
                    for (int bj = 0; bj < 2; ++bj) { const f32x4 v0 = acc[ai][bj][m][0], v1 = acc[ai][bj][m][1];
                        u32x4 w; w.x = cvt_pk_bf16(v0[0], v0[1]); w.y = cvt_pk_bf16(v0[2], v0[3]); w.z = cvt_pk_bf16(v1[0], v1[1]); w.w = cvt_pk_bf16(v1[2], v1[3]);
                        *(u32x4*)(rowp + bj * HALF) = w; } }
        } else if (wc == 0) {
#pragma unroll
            for (int ai = 0; ai < 2; ++ai)
#pragma unroll
                for (int m = 0; m < 4; ++m) { float* rp = dtraw + (size_t)(row0 + ai * HALF + m * 16) * 32 + 8 * fq;
                    *(f32x4*)rp = acc[ai][0][m][0]; *(f32x4*)(rp + 4) = acc[ai][0][m][1]; }
        }
    }
};
}


namespace pg8 {
struct EpiBf16Plain {
    static constexpr bool PERM = true, AFTER_DRAIN = false;
    bf16_t* O; int ldc;
    __device__ __forceinline__ void operator()(const f32x4 (&acc)[2][2][4][2], const Unit& u, int wr, int wc, int fr, int fq) const {
        const int row0 = u.pm * BM + wr * 64 + fr, col0 = u.pn * BM + wc * 32 + 8 * fq;
#pragma unroll
        for (int ai = 0; ai < 2; ++ai)
#pragma unroll
            for (int m = 0; m < 4; ++m) { bf16_t* rowp = O + (size_t)(row0 + ai * HALF + m * 16) * ldc + col0;
#pragma unroll
                for (int bj = 0; bj < 2; ++bj) { const f32x4 v0 = acc[ai][bj][m][0], v1 = acc[ai][bj][m][1];
                    u32x4 w; w.x = cvt_pk_bf16(v0[0], v0[1]); w.y = cvt_pk_bf16(v0[2], v0[3]); w.z = cvt_pk_bf16(v1[0], v1[1]); w.w = cvt_pk_bf16(v1[2], v1[3]);
                    *(u32x4*)(rowp + bj * HALF) = w; } }
    }
};
}

#define NTHR 512
#define NWAVE 8

__device__ __forceinline__ void ph_gemm_f32(float* lds, const float* __restrict__ A, const float* __restrict__ B, float* __restrict__ C,
                                            int M, int N, int K, int lda, int ldb, int ldc) {
    const int tid = threadIdx.x & 255, half = threadIdx.x >> 8, tx = tid & 15, ty = tid >> 4;
    float (*As)[68] = (float (*)[68])(lds + half * 2 * 16 * 68);
    float (*Bs)[68] = (float (*)[68])(lds + half * 2 * 16 * 68 + 16 * 68);
    const int ntx = (N + 63) / 64, nty = M / 64, ntiles = ntx * nty;
    for (int it = blockIdx.x; 2 * it < ntiles; it += gridDim.x) {
        const int tile = 2 * it + half;
        const int m0 = (tile / ntx) * 64, n0 = (tile % ntx) * 64;
        float acc[4][4];
#pragma unroll
        for (int i = 0; i < 4; ++i)
#pragma unroll
            for (int j = 0; j < 4; ++j) acc[i][j] = 0.f;
        for (int k0 = 0; k0 < K; k0 += 16) {
#pragma unroll
            for (int i = 0; i < 4; ++i) {
                int idx = tid + i * 256;
                int r = idx >> 4, c = idx & 15;
                As[c][r] = (m0 + r < M) ? A[(size_t)(m0 + r) * lda + k0 + c] : 0.f;
                int rb = idx >> 6, cb = idx & 63;
                Bs[rb][cb] = (n0 + cb < N) ? B[(size_t)(k0 + rb) * ldb + n0 + cb] : 0.f;
            }
            __syncthreads();
#pragma unroll
            for (int k = 0; k < 16; ++k) {
                float a[4], b[4];
#pragma unroll
                for (int i = 0; i < 4; ++i) { a[i] = As[k][ty * 4 + i]; b[i] = Bs[k][tx * 4 + i]; }
#pragma unroll
                for (int i = 0; i < 4; ++i)
#pragma unroll
                    for (int j = 0; j < 4; ++j) acc[i][j] += a[i] * b[j];
            }
            __syncthreads();
        }
#pragma unroll
        for (int i = 0; i < 4; ++i)
#pragma unroll
            for (int j = 0; j < 4; ++j) {
                int r = m0 + ty * 4 + i, c = n0 + tx * 4 + j;
                if (r < M && c < N) C[(size_t)r * ldc + c] = acc[i][j];
            }
    }
}


template <int MODE>
__device__ __forceinline__ void transpose_item(const float* __restrict__ W, int K, int N, int Npad, bf16* __restrict__ WT, LAS float* scr, int item, int lane) {
    const int nblk = Npad / 32, kb = item / nblk, nb = item % nblk, k0 = 64 * kb, n0 = 32 * nb;
    const int n = n0 + (lane & 31);
    int sc = n;
    if (MODE == 1) sc = (n < 4096) ? n : (n < 5632 ? n + 24 : (n < 5656 ? n - 5632 + 4096 : -1));
    else sc = (n < N) ? n : -1;
#pragma unroll 8
    for (int i = 0; i < 32; ++i) { const int kk = 2 * i + (lane >> 5); scr[kk * 33 + (lane & 31)] = (sc >= 0) ? W[(size_t)(k0 + kk) * N + sc] : 0.f; }
    LDS_WAIT(); asm volatile("" ::: "memory");
    const int c = lane & 7;
#pragma unroll
    for (int j = 0; j < 4; ++j) { const int nn = (lane >> 3) + 8 * j; const LAS float* s = scr + (8 * c) * 33 + nn;
        v4u o; o.x = pk2(s[0 * 33], s[1 * 33]); o.y = pk2(s[2 * 33], s[3 * 33]); o.z = pk2(s[4 * 33], s[5 * 33]); o.w = pk2(s[6 * 33], s[7 * 33]);
        *(v4u*)(WT + (size_t)(n0 + nn) * K + k0 + 8 * c) = o; }
    LDS_WAIT(); asm volatile("" ::: "memory");
}
__device__ __forceinline__ void ph_prologue(LAS unsigned char* ldsb, const float* __restrict__ xp, const float* __restrict__ xs, bf16* __restrict__ A0,
                                            const float* __restrict__ w_in, bf16* __restrict__ wt_in, float* __restrict__ rope_tab) {
    const int lane = threadIdx.x & 63, wave = threadIdx.x >> 6;
    LAS float* scr = (LAS float*)(ldsb + wave * 16384);
    const int gw = blockIdx.x * NWAVE + wave, NGW = gridDim.x * NWAVE;
    constexpr int I_IN = (D_MODEL / 64) * (PROJ_LD / 32);
    for (int it = gw; it < I_IN; it += NGW) transpose_item<1>(w_in, D_MODEL, IN_WIDTH, PROJ_LD, wt_in, scr, it, lane);
    for (int idx = blockIdx.x * NTHR + threadIdx.x; idx < SEQ * 32; idx += gridDim.x * NTHR) {
        const int pos = idx >> 5, j = idx & 31;
        const double rev = (double)pos * ROPE_INV_REV[j];
        const float fr = (float)(rev - floor(rev));
        rope_tab[(size_t)pos * 64 + j] = __builtin_amdgcn_cosf(fr); rope_tab[(size_t)pos * 64 + 32 + j] = __builtin_amdgcn_sinf(fr);
    }
    const size_t n8 = (size_t)T_ALL * D_MODEL / 8, np8 = (size_t)T_PROMPT * D_MODEL / 8;
#pragma unroll 4
    for (size_t i = (size_t)blockIdx.x * NTHR + threadIdx.x; i < n8; i += (size_t)gridDim.x * NTHR) {
        const float4* s = (i < np8) ? (const float4*)xp + 2 * i : (const float4*)xs + 2 * (i - np8);
        float4 a = s[0], b = s[1];
        v4u o; o.x = pk2(a.x, a.y); o.y = pk2(a.z, a.w); o.z = pk2(b.x, b.y); o.w = pk2(b.z, b.w);
        ((v4u*)A0)[i] = o;
    }
}
__device__ __forceinline__ void ph_prologue2(LAS unsigned char* ldsb, const float* __restrict__ w_out, bf16* __restrict__ wt_out, const float* __restrict__ w_q, bf16* __restrict__ wt_q,
                                             int rank, int nranks) {
    const int lane = threadIdx.x & 63, wave = threadIdx.x >> 6;
    LAS float* scr = (LAS float*)(ldsb + wave * 16384);
    constexpr int I_OUT = (MIX_WIDTH / 64) * (D_MODEL / 32), I_Q = (D_MODEL / 64) * (2048 / 32);
    for (int it = rank * NWAVE + wave; it < I_OUT + I_Q; it += nranks * NWAVE) {
        if (it < I_OUT) transpose_item<0>(w_out, MIX_WIDTH, D_MODEL, D_MODEL, wt_out, scr, it, lane);
        else transpose_item<0>(w_q, D_MODEL, 2048, 2048, wt_q, scr, it - I_OUT, lane);
    }
}

__device__ __forceinline__ void ph_concat_x(const float* __restrict__ xp, const float* __restrict__ xs, float* __restrict__ xall) {
    const size_t n4 = (size_t)T_ALL * D_MODEL / 4, np4 = (size_t)T_PROMPT * D_MODEL / 4;
    for (size_t i = (size_t)blockIdx.x * NTHR + threadIdx.x; i < n4; i += (size_t)gridDim.x * NTHR) {
        float4 v = (i < np4) ? ((const float4*)xp)[i] : ((const float4*)xs)[i - np4];
        ((float4*)xall)[i] = v;
    }
}

typedef float f32x4n __attribute__((ext_vector_type(4)));
__device__ __forceinline__ void ph_cache_copy(const float* __restrict__ ck, const float* __restrict__ cv, float* __restrict__ out) {
    constexpr unsigned PER_B = (WBUF - DEC_SEQ) * ATT_WIDTH / 4;
    constexpr unsigned TOTAL = 2u * DEC_BATCH * PER_B;
    for (unsigned c = blockIdx.x; c < TOTAL / 4096u; c += gridDim.x) {
        f32x4n v[8]; size_t dsti[8]; bool isv[8];
#pragma unroll
        for (int j = 0; j < 8; ++j) {
            const unsigned idx = c * 4096u + j * 512u + threadIdx.x;
            const unsigned tb = idx / PER_B, r = idx - tb * PER_B, bb = tb & (DEC_BATCH - 1);
            isv[j] = tb >= DEC_BATCH;
            const size_t srci = (size_t)bb * (WBUF * ATT_WIDTH / 4) + (DEC_SEQ * ATT_WIDTH / 4) + r;
            dsti[j] = (size_t)bb * (WBUF * ATT_WIDTH / 4) + r;
            v[j] = __builtin_nontemporal_load((isv[j] ? (const f32x4n*)cv : (const f32x4n*)ck) + srci);
        }
#pragma unroll
        for (int j = 0; j < 8; ++j) __builtin_nontemporal_store(v[j], (f32x4n*)(out + (isv[j] ? OUT_SV : OUT_SK)) + dsti[j]);
    }
}

__device__ __forceinline__ void ph_post_proj(const float* __restrict__ proj, const float* __restrict__ state_conv,
                                             const float* __restrict__ conv_w, const float* __restrict__ conv_b, const float* __restrict__ dt_bias,
                                             float* __restrict__ xbc_act, float* __restrict__ dtv, float* __restrict__ qrot, float* __restrict__ krot,
                                             float* __restrict__ out) {
    const int tid = threadIdx.x & 255, half = threadIdx.x >> 8;
    for (int t = 2 * blockIdx.x + half; t < T_ALL; t += 2 * gridDim.x) {
        const bool is_p = t < T_PROMPT;
        int b, i, pos;
        if (is_p) { b = t / SEQ; i = t % SEQ; pos = i; } else { int ts = t - T_PROMPT; b = ts / DEC_SEQ; i = ts % DEC_SEQ; pos = PAST_LEN + i; }
        const float* row = proj + (size_t)t * PROJ_LD;
        for (int c = tid; c < CONV_DIM; c += 256) {
            float acc = conv_b[c];
#pragma unroll
            for (int tap = 0; tap < 4; ++tap) {
                int r = i - 3 + tap;
                float val;
                if (r >= 0) val = proj[(size_t)(t - i + r) * PROJ_LD + O_XBC + c];
                else val = is_p ? 0.f : state_conv[((size_t)b * 3 + (3 + r)) * CONV_DIM + c];
                acc += val * conv_w[tap * CONV_DIM + c];
            }
            xbc_act[(size_t)t * CONV_DIM + c] = silu_f(acc);
        }
        if (tid < SSD_HEADS) dtv[(size_t)t * SSD_HEADS + tid] = softplus_f(row[O_DT + tid] + dt_bias[tid]);
        for (int idx = tid; idx < 512; idx += 256) {
            int which = idx >> 8, h = (idx >> 5) & 7, j = idx & 31;
            double rev = (double)pos * ROPE_INV_REV[j];
            float fr = (float)(rev - floor(rev));
            float sn = __builtin_amdgcn_sinf(fr), cs = __builtin_amdgcn_cosf(fr);
            const float* src = row + (which ? O_K : O_Q) + h * 64;
            float t1 = src[j], t2 = src[j + 32];
            float o1 = t1 * cs - t2 * sn, o2 = t2 * cs + t1 * sn;
            float* dst = (which ? krot : qrot) + (size_t)t * ATT_WIDTH + h * 64;
            dst[j] = o1; dst[j + 32] = o2;
            if (which) {
                if (is_p) { if (i >= SEQ - WBUF) { float* o = out + OUT_PK + ((size_t)b * WBUF + (i - (SEQ - WBUF))) * ATT_WIDTH + h * 64; o[j] = o1; o[j + 32] = o2; } }
                else { float* o = out + OUT_SK + ((size_t)b * WBUF + (WBUF - DEC_SEQ + i)) * ATT_WIDTH + h * 64; o[j] = o1; o[j + 32] = o2; }
            }
        }
        for (int c = tid; c < ATT_WIDTH; c += 256) {
            float v = row[O_V + c];
            if (is_p) { if (i >= SEQ - WBUF) out[OUT_PV + ((size_t)b * WBUF + (i - (SEQ - WBUF))) * ATT_WIDTH + c] = v; }
            else out[OUT_SV + ((size_t)b * WBUF + (WBUF - DEC_SEQ + i)) * ATT_WIDTH + c] = v;
        }
        if (is_p) {
            if (i >= SEQ - 3) { int r = i - (SEQ - 3); for (int c = tid; c < CONV_DIM; c += 256) out[OUT_PC + ((size_t)b * 3 + r) * CONV_DIM + c] = row[O_XBC + c]; }
        } else {
            if (i >= 1) { int r = i - 1; for (int c = tid; c < CONV_DIM; c += 256) out[OUT_SC + ((size_t)b * 3 + r) * CONV_DIM + c] = row[O_XBC + c]; }
        }
    }
}


#define NB_LD 5632
#define NB_XBC 1536
#define NB_Q 4096
#define NB_K 4608
#define NB_V 5120
__device__ __forceinline__ void unpack8(const v4u w, float (&f)[8]) {
    f[0] = __builtin_bit_cast(float, w.x << 16); f[1] = __builtin_bit_cast(float, w.x & 0xffff0000u);
    f[2] = __builtin_bit_cast(float, w.y << 16); f[3] = __builtin_bit_cast(float, w.y & 0xffff0000u);
    f[4] = __builtin_bit_cast(float, w.z << 16); f[5] = __builtin_bit_cast(float, w.z & 0xffff0000u);
    f[6] = __builtin_bit_cast(float, w.w << 16); f[7] = __builtin_bit_cast(float, w.w & 0xffff0000u);
}
__device__ __forceinline__ void store8f(float* d, const float (&f)[8]) { *(float4*)d = make_float4(f[0], f[1], f[2], f[3]); *(float4*)(d + 4) = make_float4(f[4], f[5], f[6], f[7]); }
__device__ __forceinline__ void ph_post_proj2(const bf16* __restrict__ projb, const float* __restrict__ dtraw, const float* __restrict__ state_conv,
                                              const float* __restrict__ conv_w, const float* __restrict__ conv_b, const float* __restrict__ dt_bias,
                                              bf16* __restrict__ xbc_b, float* __restrict__ dtv, bf16* __restrict__ qrot_b, bf16* __restrict__ krot_b,
                                              float* __restrict__ out) {
    const int tid = threadIdx.x & 255, half = threadIdx.x >> 8;
    for (int t = T_PROMPT + 2 * blockIdx.x + half; t < T_ALL; t += 2 * gridDim.x) {
        const bool is_p = t < T_PROMPT;
        int b, i, pos;
        if (is_p) { b = t / SEQ; i = t % SEQ; pos = i; } else { int ts = t - T_PROMPT; b = ts / DEC_SEQ; i = ts % DEC_SEQ; pos = PAST_LEN + i; }
        const bf16* row = projb + (size_t)t * NB_LD;
        if (tid < 64) {
            float f[8]; unpack8(*(const v4u*)(row + NB_V + tid * 8), f);
            if (is_p) { if (i >= SEQ - WBUF) store8f(out + OUT_PV + ((size_t)b * WBUF + (i - (SEQ - WBUF))) * ATT_WIDTH + tid * 8, f); }
            else store8f(out + OUT_SV + ((size_t)b * WBUF + (WBUF - DEC_SEQ + i)) * ATT_WIDTH + tid * 8, f);
        }
        for (int c8 = tid; c8 < 320; c8 += 256) {
            const int c = c8 * 8;
            float acc[8], cur[8];
            { const float4 b0 = *(const float4*)(conv_b + c), b1 = *(const float4*)(conv_b + c + 4);
              acc[0] = b0.x; acc[1] = b0.y; acc[2] = b0.z; acc[3] = b0.w; acc[4] = b1.x; acc[5] = b1.y; acc[6] = b1.z; acc[7] = b1.w; }
#pragma unroll
            for (int tap = 0; tap < 4; ++tap) {
                const int r = i - 3 + tap;
                float val[8];
                if (r >= 0) unpack8(*(const v4u*)(projb + (size_t)(t - i + r) * NB_LD + NB_XBC + c), val);
                else if (!is_p) { const float* sp = state_conv + ((size_t)b * 3 + (3 + r)) * CONV_DIM + c; const float4 s0 = *(const float4*)sp, s1 = *(const float4*)(sp + 4);
                    val[0] = s0.x; val[1] = s0.y; val[2] = s0.z; val[3] = s0.w; val[4] = s1.x; val[5] = s1.y; val[6] = s1.z; val[7] = s1.w; }
                else {
#pragma unroll
                    for (int j = 0; j < 8; ++j) val[j] = 0.f; }
                const float4 w0 = *(const float4*)(conv_w + tap * CONV_DIM + c), w1 = *(const float4*)(conv_w + tap * CONV_DIM + c + 4);
                acc[0] += val[0] * w0.x; acc[1] += val[1] * w0.y; acc[2] += val[2] * w0.z; acc[3] += val[3] * w0.w;
                acc[4] += val[4] * w1.x; acc[5] += val[5] * w1.y; acc[6] += val[6] * w1.z; acc[7] += val[7] * w1.w;
                if (tap == 3) {
#pragma unroll
                    for (int j = 0; j < 8; ++j) cur[j] = val[j]; }
            }
#pragma unroll
            for (int j = 0; j < 8; ++j) acc[j] = silu_f(acc[j]);
            v4u o; o.x = pk2(acc[0], acc[1]); o.y = pk2(acc[2], acc[3]); o.z = pk2(acc[4], acc[5]); o.w = pk2(acc[6], acc[7]);
            *(v4u*)(xbc_b + (size_t)t * CONV_DIM + c) = o;
            if (is_p) { if (i >= SEQ - 3) store8f(out + OUT_PC + ((size_t)b * 3 + (i - (SEQ - 3))) * CONV_DIM + c, cur); }
            else { if (i >= 1) store8f(out + OUT_SC + ((size_t)b * 3 + (i - 1)) * CONV_DIM + c, cur); }
        }
        if (tid < SSD_HEADS) dtv[(size_t)t * SSD_HEADS + tid] = softplus_f(dtraw[(size_t)t * 32 + tid] + dt_bias[tid]);
        if (tid < 128) {
            const int which = tid >> 6, h = (tid >> 3) & 7, jc = tid & 7;
            const bf16* src = row + (which ? NB_K : NB_Q) + h * 64 + jc * 4;
            const uint2 lo = *(const uint2*)src, hi = *(const uint2*)(src + 32);
            float t1[4], t2[4], o1[4], o2[4];
            t1[0] = __builtin_bit_cast(float, lo.x << 16); t1[1] = __builtin_bit_cast(float, lo.x & 0xffff0000u); t1[2] = __builtin_bit_cast(float, lo.y << 16); t1[3] = __builtin_bit_cast(float, lo.y & 0xffff0000u);
            t2[0] = __builtin_bit_cast(float, hi.x << 16); t2[1] = __builtin_bit_cast(float, hi.x & 0xffff0000u); t2[2] = __builtin_bit_cast(float, hi.y << 16); t2[3] = __builtin_bit_cast(float, hi.y & 0xffff0000u);
#pragma unroll
            for (int e = 0; e < 4; ++e) {
                const double rev = (double)pos * ROPE_INV_REV[jc * 4 + e];
                const float fr = (float)(rev - floor(rev));
                const float sn = __builtin_amdgcn_sinf(fr), cs = __builtin_amdgcn_cosf(fr);
                o1[e] = t1[e] * cs - t2[e] * sn; o2[e] = t2[e] * cs + t1[e] * sn;
            }
            const size_t doff = (size_t)t * ATT_WIDTH + h * 64 + jc * 4;
            bf16* db = which ? krot_b : qrot_b;
            *(uint2*)(db + doff) = make_uint2(pk2(o1[0], o1[1]), pk2(o1[2], o1[3])); *(uint2*)(db + doff + 32) = make_uint2(pk2(o2[0], o2[1]), pk2(o2[2], o2[3]));
            if (which) {
                float* o = nullptr;
                if (is_p) { if (i >= SEQ - WBUF) o = out + OUT_PK + ((size_t)b * WBUF + (i - (SEQ - WBUF))) * ATT_WIDTH + h * 64 + jc * 4; }
                else o = out + OUT_SK + ((size_t)b * WBUF + (WBUF - DEC_SEQ + i)) * ATT_WIDTH + h * 64 + jc * 4;
                if (o) { *(float4*)o = make_float4(o1[0], o1[1], o1[2], o1[3]); *(float4*)(o + 32) = make_float4(o2[0], o2[1], o2[2], o2[3]); }
            }
        }
    }
}


__device__ __forceinline__ void ph_post_proj_prompt(const bf16* __restrict__ projb, const float* __restrict__ dtraw, const float* __restrict__ conv_w, const float* __restrict__ conv_b,
                                                    const float* __restrict__ dt_bias, const float* __restrict__ rope_tab, bf16* __restrict__ xbc_b, float* __restrict__ dtv,
                                                    bf16* __restrict__ qrot_b, bf16* __restrict__ krot_b, float* __restrict__ out) {
    const int gtid = blockIdx.x * NTHR + threadIdx.x, gsz = gridDim.x * NTHR;
    for (int item = gtid; item < (T_PROMPT / 16) * 320; item += gsz) {
        const int run = item / 320, c = (item - run * 320) * 8, t0 = run * 16, i0 = t0 & (SEQ - 1), b = t0 >> 13;
        float w[4][8], bias[8];
#pragma unroll
        for (int tap = 0; tap < 4; ++tap) { const float4 w0 = *(const float4*)(conv_w + tap * CONV_DIM + c), w1 = *(const float4*)(conv_w + tap * CONV_DIM + c + 4);
            w[tap][0] = w0.x; w[tap][1] = w0.y; w[tap][2] = w0.z; w[tap][3] = w0.w; w[tap][4] = w1.x; w[tap][5] = w1.y; w[tap][6] = w1.z; w[tap][7] = w1.w; }
        { const float4 b0 = *(const float4*)(conv_b + c), b1 = *(const float4*)(conv_b + c + 4);
          bias[0] = b0.x; bias[1] = b0.y; bias[2] = b0.z; bias[3] = b0.w; bias[4] = b1.x; bias[5] = b1.y; bias[6] = b1.z; bias[7] = b1.w; }
        const bf16* src = projb + (size_t)t0 * NB_LD + NB_XBC + c;
        v4u raw[19];
#pragma unroll
        for (int s = 0; s < 19; ++s) { v4u z; z.x = 0u; z.y = 0u; z.z = 0u; z.w = 0u; raw[s] = (s >= 3 || i0 != 0) ? *(const v4u*)(src + (ptrdiff_t)(s - 3) * NB_LD) : z; }
        float p0[8], p1[8], p2[8];
        unpack8(raw[0], p0); unpack8(raw[1], p1); unpack8(raw[2], p2);
#pragma unroll
        for (int s = 0; s < 16; ++s) {
            float cur[8], acc[8]; unpack8(raw[s + 3], cur);
#pragma unroll
            for (int j = 0; j < 8; ++j) acc[j] = silu_f(bias[j] + p0[j] * w[0][j] + p1[j] * w[1][j] + p2[j] * w[2][j] + cur[j] * w[3][j]);
            v4u o; o.x = pk2(acc[0], acc[1]); o.y = pk2(acc[2], acc[3]); o.z = pk2(acc[4], acc[5]); o.w = pk2(acc[6], acc[7]);
            *(v4u*)(xbc_b + (size_t)(t0 + s) * CONV_DIM + c) = o;
            if (i0 + s >= SEQ - 3) store8f(out + OUT_PC + ((size_t)b * 3 + (i0 + s - (SEQ - 3))) * CONV_DIM + c, cur);
#pragma unroll
            for (int j = 0; j < 8; ++j) { p0[j] = p1[j]; p1[j] = p2[j]; p2[j] = cur[j]; }
        }
    }
#pragma unroll 4
    for (int item = gtid; item < T_PROMPT * 128; item += gsz) {
        const int t = item >> 7, sub = item & 127, which = sub >> 6, h = (sub >> 3) & 7, jc = sub & 7, i = t & (SEQ - 1), b = t >> 13;
        const bf16* src = projb + (size_t)t * NB_LD + (which ? NB_K : NB_Q) + h * 64 + jc * 4;
        const uint2 lo = *(const uint2*)src, hi = *(const uint2*)(src + 32);
        const float4 cs = *(const float4*)(rope_tab + (size_t)i * 64 + jc * 4), sn = *(const float4*)(rope_tab + (size_t)i * 64 + 32 + jc * 4);
        float t1[4], t2[4], o1[4], o2[4];
        t1[0] = __builtin_bit_cast(float, lo.x << 16); t1[1] = __builtin_bit_cast(float, lo.x & 0xffff0000u); t1[2] = __builtin_bit_cast(float, lo.y << 16); t1[3] = __builtin_bit_cast(float, lo.y & 0xffff0000u);
        t2[0] = __builtin_bit_cast(float, hi.x << 16); t2[1] = __builtin_bit_cast(float, hi.x & 0xffff0000u); t2[2] = __builtin_bit_cast(float, hi.y << 16); t2[3] = __builtin_bit_cast(float, hi.y & 0xffff0000u);
        const float cv[4] = {cs.x, cs.y, cs.z, cs.w}, sv[4] = {sn.x, sn.y, sn.z, sn.w};
#pragma unroll
        for (int e = 0; e < 4; ++e) { o1[e] = t1[e] * cv[e] - t2[e] * sv[e]; o2[e] = t2[e] * cv[e] + t1[e] * sv[e]; }
        const size_t doff = (size_t)t * ATT_WIDTH + h * 64 + jc * 4;
        bf16* db = which ? krot_b : qrot_b;
        *(uint2*)(db + doff) = make_uint2(pk2(o1[0], o1[1]), pk2(o1[2], o1[3])); *(uint2*)(db + doff + 32) = make_uint2(pk2(o2[0], o2[1]), pk2(o2[2], o2[3]));
        if (which && i >= SEQ - WBUF) {
            float* o = out + OUT_PK + ((size_t)b * WBUF + (i - (SEQ - WBUF))) * ATT_WIDTH + h * 64 + jc * 4;
            *(float4*)o = make_float4(o1[0], o1[1], o1[2], o1[3]); *(float4*)(o + 32) = make_float4(o2[0], o2[1], o2[2], o2[3]);
        }
    }
#pragma unroll 4
    for (int item = gtid; item < T_PROMPT * SSD_HEADS; item += gsz) { const int t = item / SSD_HEADS, hd = item - t * SSD_HEADS; dtv[item] = softplus_f(dtraw[(size_t)t * 32 + hd] + dt_bias[hd]); }
#pragma unroll 2
    for (int item = gtid; item < BATCH * WBUF * 64; item += gsz) {
        const int ch = item & 63, j = (item >> 6) & (WBUF - 1), b = item >> 17;
        float f[8]; unpack8(*(const v4u*)(projb + (size_t)(b * SEQ + (SEQ - WBUF) + j) * NB_LD + NB_V + ch * 8), f);
        store8f(out + OUT_PV + ((size_t)b * WBUF + j) * ATT_WIDTH + ch * 8, f);
    }
}

#define SSD_CH 32
__device__ __forceinline__ void ph_ssd_naive(float* lds, const bf16* __restrict__ xbc_act, const float* __restrict__ dtv, const float* __restrict__ a_log,
                                             const float* __restrict__ d_skip, const float* __restrict__ state_ssm, float* __restrict__ ybuf, float* __restrict__ out) {
    float (*sx)[64] = (float (*)[64])lds;
    float (*sB)[128] = (float (*)[128])(lds + SSD_CH * 64);
    float (*sC)[128] = (float (*)[128])(lds + SSD_CH * 64 + SSD_CH * 128);
    float* sdt = lds + SSD_CH * 64 + 2 * SSD_CH * 128;
    const int tid = threadIdx.x, p = tid >> 3, ng = tid & 7;
    for (int vb = BATCH * SSD_HEADS + blockIdx.x; vb < (BATCH + DEC_BATCH) * SSD_HEADS; vb += gridDim.x) {
        const int seq = vb / SSD_HEADS, h = vb % SSD_HEADS, g = h / 6;
        const bool is_p = seq < BATCH;
        const int L = is_p ? SEQ : DEC_SEQ;
        const int t0 = is_p ? seq * SEQ : T_PROMPT + (seq - BATCH) * DEC_SEQ;
        const float A = -__expf(a_log[h]);
        const float D = d_skip[h];
        float hs[16];
        if (is_p) {
#pragma unroll
            for (int j = 0; j < 16; ++j) hs[j] = 0.f;
        } else {
            const float* s0 = state_ssm + (((size_t)(seq - BATCH) * SSD_HEADS + h) * 64 + p) * 128 + ng * 16;
#pragma unroll
            for (int j = 0; j < 16; ++j) hs[j] = s0[j];
        }
        for (int c0 = 0; c0 < L; c0 += SSD_CH) {
            const int nst = (L - c0) < SSD_CH ? (L - c0) : SSD_CH;
            __syncthreads();
            for (int idx = tid; idx < nst * 64; idx += NTHR) { int s = idx >> 6, c = idx & 63; sx[s][c] = bf2f(xbc_act[(size_t)(t0 + c0 + s) * CONV_DIM + h * 64 + c]); }
            for (int idx = tid; idx < nst * 128; idx += NTHR) { int s = idx >> 7, c = idx & 127;
                sB[s][c] = bf2f(xbc_act[(size_t)(t0 + c0 + s) * CONV_DIM + 1536 + g * 128 + c]);
                sC[s][c] = bf2f(xbc_act[(size_t)(t0 + c0 + s) * CONV_DIM + 2048 + g * 128 + c]); }
            if (tid < nst) sdt[tid] = dtv[(size_t)(t0 + c0 + tid) * SSD_HEADS + h];
            __syncthreads();
            for (int s = 0; s < nst; ++s) {
                const float dt = sdt[s], x = sx[s][p];
                const float a = __expf(dt * A), xdt = x * dt;
                float y = 0.f;
#pragma unroll
                for (int j = 0; j < 16; ++j) { hs[j] = a * hs[j] + xdt * sB[s][ng * 16 + j]; y += sC[s][ng * 16 + j] * hs[j]; }
                y += __shfl_xor(y, 1); y += __shfl_xor(y, 2); y += __shfl_xor(y, 4);
                if (ng == 0) ybuf[(size_t)(t0 + c0 + s) * MIX_WIDTH + h * 64 + p] = y + D * x;
            }
        }
        float* so = is_p ? out + OUT_PS + (((size_t)seq * SSD_HEADS + h) * 64 + p) * 128 + ng * 16
                         : out + OUT_SS + (((size_t)(seq - BATCH) * SSD_HEADS + h) * 64 + p) * 128 + ng * 16;
#pragma unroll
        for (int j = 0; j < 16; ++j) so[j] = hs[j];
    }
}

__device__ __forceinline__ void ph_gate_norm(const bf16* __restrict__ projb, const float* __restrict__ norm_g, const float* __restrict__ ybuf, bf16* __restrict__ A1) {
    const int w = threadIdx.x >> 6, lane = threadIdx.x & 63, g = w & 3;
    for (int t = T_PROMPT + 2 * blockIdx.x + (w >> 2); t < T_ALL; t += 2 * gridDim.x) {
        float v[6]; float ss = 0.f;
#pragma unroll
        for (int j = 0; j < 6; ++j) {
            int c = g * 384 + j * 64 + lane;
            float y = ybuf[(size_t)t * MIX_WIDTH + c], z = bf2f(projb[(size_t)t * NB_LD + c]);
            v[j] = y * silu_f(z); ss += v[j] * v[j];
        }
        ss = wave_sum(ss);
        const float r = rsqrtf(ss * (1.0f / 384.0f) + LN_EPS);
#pragma unroll
        for (int j = 0; j < 6; ++j) { int c = g * 384 + j * 64 + lane; A1[(size_t)t * MIX_WIDTH + c] = (bf16)f2bf(v[j] * r * norm_g[c]); }
    }
}

__device__ __forceinline__ void ph_attn_naive(float* lds, const float* __restrict__ proj, const float* __restrict__ qrot, const float* __restrict__ krot,
                                              const float* __restrict__ ck, const float* __restrict__ cv, float* __restrict__ ybuf) {
    float (*sq)[64] = (float (*)[64])lds;
    const int w = threadIdx.x >> 6, lane = threadIdx.x & 63;
    for (int vb = blockIdx.x; vb < T_SAMPLE * 8 / NWAVE; vb += gridDim.x) {
        const int item = T_PROMPT * 8 + vb * NWAVE + w;
        const int t = item >> 3, h = item & 7;
        const bool is_p = t < T_PROMPT;
        int b, i;
        if (is_p) { b = t / SEQ; i = t % SEQ; } else { int ts = t - T_PROMPT; b = ts / DEC_SEQ; i = ts % DEC_SEQ; }
        __syncthreads();
        sq[w][lane] = qrot[(size_t)t * ATT_WIDTH + h * 64 + lane];
        __syncthreads();
        const int qi = is_p ? i : WBUF + i;
        float sc[3][3];
        float mx = -INFINITY;
#pragma unroll
        for (int pt = 0; pt < 3; ++pt) {
            const int d = pt == 0 ? 1 : (pt == 1 ? 4 : 16);
#pragma unroll
            for (int sl = 0; sl < 3; ++sl) {
                const int m = lane + sl * 64;
                float s = -INFINITY;
                const int kj = qi - d * m;
                if (m <= 128 && kj >= 0) {
                    const float* kr;
                    if (is_p) kr = krot + (size_t)(b * SEQ + kj) * ATT_WIDTH + h * 64;
                    else kr = (kj >= WBUF) ? krot + (size_t)(T_PROMPT + b * DEC_SEQ + (kj - WBUF)) * ATT_WIDTH + h * 64
                                           : ck + ((size_t)b * WBUF + kj) * ATT_WIDTH + h * 64;
                    float a = 0.f;
#pragma unroll
                    for (int c = 0; c < 64; c += 4) { float4 kv = *(const float4*)(kr + c); a += kv.x * sq[w][c] + kv.y * sq[w][c + 1] + kv.z * sq[w][c + 2] + kv.w * sq[w][c + 3]; }
                    s = a * 0.125f;
                }
                sc[pt][sl] = s; mx = fmaxf(mx, s);
            }
        }
        mx = wave_max(mx);
        float lsum = 0.f;
#pragma unroll
        for (int pt = 0; pt < 3; ++pt)
#pragma unroll
            for (int sl = 0; sl < 3; ++sl) { float pv = (sc[pt][sl] == -INFINITY) ? 0.f : __expf(sc[pt][sl] - mx); sc[pt][sl] = pv; lsum += pv; }
        lsum = wave_sum(lsum);
        float o = 0.f;
#pragma unroll
        for (int pt = 0; pt < 3; ++pt) {
            const int d = pt == 0 ? 1 : (pt == 1 ? 4 : 16);
#pragma unroll
            for (int sl = 0; sl < 3; ++sl) {
                const int mend = sl < 2 ? 64 : 1;
                for (int ml = 0; ml < mend; ++ml) {
                    const int m = ml + sl * 64;
                    const int kj = qi - d * m;
                    const float pv = __shfl(sc[pt][sl], ml);
                    if (kj < 0) continue;
                    const float* vr;
                    if (is_p) vr = proj + (size_t)(b * SEQ + kj) * PROJ_LD + O_V + h * 64;
                    else vr = (kj >= WBUF) ? proj + (size_t)(T_PROMPT + b * DEC_SEQ + (kj - WBUF)) * PROJ_LD + O_V + h * 64
                                           : cv + ((size_t)b * WBUF + kj) * ATT_WIDTH + h * 64;
                    o += pv * vr[lane];
                }
            }
        }
        ybuf[(size_t)t * MIX_WIDTH + SSD_WIDTH + h * 64 + lane] = o / lsum;
    }
}

__device__ __forceinline__ void ph_ln_res(const float* __restrict__ xp, const float* __restrict__ xs, const bf16* __restrict__ add, const float* __restrict__ gam,
                                          const float* __restrict__ bet, bf16* __restrict__ dstb) {
    const int lane = threadIdx.x & 63;
#pragma unroll 2
    for (int t = blockIdx.x * NWAVE + (threadIdx.x >> 6); t < T_ALL; t += gridDim.x * NWAVE) {
        const float* res = (t < T_PROMPT) ? xp + (size_t)t * D_MODEL : xs + (size_t)(t - T_PROMPT) * D_MODEL;
        float v[16]; float s = 0.f;
#pragma unroll
        for (int j = 0; j < 2; ++j) { const int c = j * 512 + lane * 8; const float4 r0 = *(const float4*)(res + c), r1 = *(const float4*)(res + c + 4);
            float a8[8]; unpack8(*(const v4u*)(add + (size_t)t * D_MODEL + c), a8);
            v[8 * j] = ALPHA_F * r0.x + a8[0]; v[8 * j + 1] = ALPHA_F * r0.y + a8[1]; v[8 * j + 2] = ALPHA_F * r0.z + a8[2]; v[8 * j + 3] = ALPHA_F * r0.w + a8[3];
            v[8 * j + 4] = ALPHA_F * r1.x + a8[4]; v[8 * j + 5] = ALPHA_F * r1.y + a8[5]; v[8 * j + 6] = ALPHA_F * r1.z + a8[6]; v[8 * j + 7] = ALPHA_F * r1.w + a8[7]; }
#pragma unroll
        for (int j = 0; j < 16; ++j) s += v[j];
        s = wave_sum(s);
        const float mu = s * (1.0f / 1024.0f);
        float q = 0.f;
#pragma unroll
        for (int j = 0; j < 16; ++j) { v[j] -= mu; q += v[j] * v[j]; }
        q = wave_sum(q);
        const float r = rsqrtf(q * (1.0f / 1024.0f) + LN_EPS);
#pragma unroll
        for (int j = 0; j < 2; ++j) { const int c = j * 512 + lane * 8; const float4 g0 = *(const float4*)(gam + c), g1 = *(const float4*)(gam + c + 4), b0 = *(const float4*)(bet + c), b1 = *(const float4*)(bet + c + 4);
            v4u o; o.x = pk2(v[8 * j] * r * g0.x + b0.x, v[8 * j + 1] * r * g0.y + b0.y); o.y = pk2(v[8 * j + 2] * r * g0.z + b0.z, v[8 * j + 3] * r * g0.w + b0.w);
            o.z = pk2(v[8 * j + 4] * r * g1.x + b1.x, v[8 * j + 5] * r * g1.y + b1.y); o.w = pk2(v[8 * j + 6] * r * g1.z + b1.z, v[8 * j + 7] * r * g1.w + b1.w);
            *(v4u*)(dstb + (size_t)t * D_MODEL + c) = o; }
    }
}

__device__ __forceinline__ void ph_peer_route(float* lds, const float* __restrict__ qh, const float* __restrict__ keys1, const float* __restrict__ keys2,
                                              int* __restrict__ eidx, float* __restrict__ gate) {
    float (*sq)[256] = (float (*)[256])lds;
    float (*sv)[2][16] = (float (*)[2][16])(lds + NWAVE * 256);
    int (*si)[2][16] = (int (*)[2][16])(lds + NWAVE * 256 + NWAVE * 32);
    const int w = threadIdx.x >> 6, lane = threadIdx.x & 63;
    for (int vb = blockIdx.x; vb < T_ALL * 8 / NWAVE; vb += gridDim.x) {
        const int item = vb * NWAVE + w;
        const int t = item >> 3, h = item & 7;
        __syncthreads();
        for (int c = lane; c < 256; c += 64) sq[w][c] = qh[(size_t)t * 2048 + h * 256 + c];
        __syncthreads();
#pragma unroll
        for (int half = 0; half < 2; ++half) {
            const float* keys = half ? keys2 : keys1;
            float s[2];
#pragma unroll
            for (int sl = 0; sl < 2; ++sl) {
                const float* kr = keys + (size_t)(lane + sl * 64) * 128;
                float a = 0.f;
#pragma unroll 8
                for (int c = 0; c < 128; c += 4) { float4 kv = *(const float4*)(kr + c); const float* qq = &sq[w][half * 128 + c]; a += kv.x * qq[0] + kv.y * qq[1] + kv.z * qq[2] + kv.w * qq[3]; }
                s[sl] = a;
            }
            for (int r = 0; r < 16; ++r) {
                float bv; int bi;
                if (s[0] >= s[1]) { bv = s[0]; bi = lane; } else { bv = s[1]; bi = lane + 64; }
#pragma unroll
                for (int o = 32; o > 0; o >>= 1) {
                    float ov = __shfl_xor(bv, o); int oi = __shfl_xor(bi, o);
                    if (ov > bv || (ov == bv && oi < bi)) { bv = ov; bi = oi; }
                }
                if (lane == 0) { sv[w][half][r] = bv; si[w][half][r] = bi; }
                if (bi == lane) s[0] = -INFINITY;
                if (bi == lane + 64) s[1] = -INFINITY;
            }
        }
        __syncthreads();
        float c[4];
#pragma unroll
        for (int j = 0; j < 4; ++j) { int ci = lane * 4 + j; c[j] = sv[w][0][ci >> 4] + sv[w][1][ci & 15]; }
        float myv = 0.f; int myc = 0;
        for (int r = 0; r < 16; ++r) {
            float bv = c[0]; int bi = lane * 4;
#pragma unroll
            for (int j = 1; j < 4; ++j) if (c[j] > bv) { bv = c[j]; bi = lane * 4 + j; }
#pragma unroll
            for (int o = 32; o > 0; o >>= 1) {
                float ov = __shfl_xor(bv, o); int oi = __shfl_xor(bi, o);
                if (ov > bv || (ov == bv && oi < bi)) { bv = ov; bi = oi; }
            }
            if (lane == r) { myv = bv; myc = bi; }
#pragma unroll
            for (int j = 0; j < 4; ++j) if (bi == lane * 4 + j) c[j] = -INFINITY;
        }
        float v = lane < 16 ? myv : -INFINITY;
        float mx = wave_max(v);
        float e = lane < 16 ? __expf(v - mx) : 0.f;
        float sum = wave_sum(e);
        if (lane < 16) {
            int ex = si[w][0][myc >> 4] * PEER_NKEYS + si[w][1][myc & 15];
            eidx[(size_t)t * 128 + h * 16 + lane] = ex;
            gate[(size_t)t * 128 + h * 16 + lane] = e / sum;
        }
    }
}

__device__ __forceinline__ void ph_peer_ffn(const float* __restrict__ hbuf, const int* __restrict__ eidx, const float* __restrict__ gate,
                                            const bf16* __restrict__ ub, const bf16* __restrict__ vb, const float* __restrict__ gam,
                                            const float* __restrict__ bet, float* __restrict__ out) {
    const int lane = threadIdx.x & 63;
    for (int t = blockIdx.x * NWAVE + (threadIdx.x >> 6); t < T_ALL; t += gridDim.x * NWAVE) {
        float x[16], acc[16];
        { const float* xr = hbuf + (size_t)t * D_MODEL + lane * 8;
          const float4 a = *(const float4*)xr, b = *(const float4*)(xr + 4), c = *(const float4*)(xr + 512), d = *(const float4*)(xr + 516);
          x[0] = a.x; x[1] = a.y; x[2] = a.z; x[3] = a.w; x[4] = b.x; x[5] = b.y; x[6] = b.z; x[7] = b.w;
          x[8] = c.x; x[9] = c.y; x[10] = c.z; x[11] = c.w; x[12] = d.x; x[13] = d.y; x[14] = d.z; x[15] = d.w; }
#pragma unroll
        for (int j = 0; j < 16; ++j) acc[j] = 0.f;
        for (int k = 0; k < 128; ++k) {
            const int e = eidx[(size_t)t * 128 + k];
            const float g = gate[(size_t)t * 128 + k];
            const bf16* ur = ub + (size_t)e * D_MODEL + lane * 8;
            float u0[8], u1[8];
            unpack8(*(const v4u*)ur, u0); unpack8(*(const v4u*)(ur + 512), u1);
            float d = 0.f;
#pragma unroll
            for (int j = 0; j < 8; ++j) d += u0[j] * x[j] + u1[j] * x[8 + j];
            d = wave_sum(d);
            const float wgt = g * gelu_f(d);
            const bf16* vr = vb + (size_t)e * D_MODEL + lane * 8;
            unpack8(*(const v4u*)vr, u0); unpack8(*(const v4u*)(vr + 512), u1);
#pragma unroll
            for (int j = 0; j < 8; ++j) { acc[j] += wgt * u0[j]; acc[8 + j] += wgt * u1[j]; }
        }
        float s = 0.f;
#pragma unroll
        for (int j = 0; j < 16; ++j) { acc[j] += ALPHA_F * x[j]; s += acc[j]; }
        s = wave_sum(s);
        const float mu = s * (1.0f / 1024.0f);
        float q = 0.f;
#pragma unroll
        for (int j = 0; j < 16; ++j) { acc[j] -= mu; q += acc[j] * acc[j]; }
        q = wave_sum(q);
        const float r = rsqrtf(q * (1.0f / 1024.0f) + LN_EPS);
        float* dst = ((t < T_PROMPT) ? out + OUT_YP + (size_t)t * D_MODEL : out + OUT_YS + (size_t)(t - T_PROMPT) * D_MODEL) + lane * 8;
#pragma unroll
        for (int q4 = 0; q4 < 4; ++q4) {
            const int eo = (q4 >> 1) * 512 + (q4 & 1) * 4;
            const float4 g4 = *(const float4*)(gam + lane * 8 + eo), b4 = *(const float4*)(bet + lane * 8 + eo);
            float4 o; o.x = acc[q4 * 4 + 0] * r * g4.x + b4.x; o.y = acc[q4 * 4 + 1] * r * g4.y + b4.y; o.z = acc[q4 * 4 + 2] * r * g4.z + b4.z; o.w = acc[q4 * 4 + 3] * r * g4.w + b4.w;
            *(float4*)(dst + eo) = o;
        }
    }
}

__device__ __forceinline__ float peer_dot16(const v4u a, const v4u b, const float (&x)[16]) {
    float u0[8], u1[8]; unpack8(a, u0); unpack8(b, u1);
    float d = 0.f;
#pragma unroll
    for (int j = 0; j < 8; ++j) d += u0[j] * x[j] + u1[j] * x[8 + j];
    return d;
}
#define PEER_TR_STEP(N, M) _Pragma("unroll") for (int i = 0; i < N; ++i) { const bool up = (lane & M) != 0; const float keep = up ? part[i + N] : part[i]; const float send = up ? part[i] : part[i + N]; part[i] = keep + __shfl_xor(send, M); }
__device__ __forceinline__ void ph_peer_ffn2(const float* __restrict__ hbuf, const int* __restrict__ eidx, const float* __restrict__ gate,
                                             const bf16* __restrict__ ub, const bf16* __restrict__ vb, const float* __restrict__ gam,
                                             const float* __restrict__ bet, float* __restrict__ out) {
    const int lane0 = threadIdx.x & 63;
    for (int t = blockIdx.x * NWAVE + (threadIdx.x >> 6); t < T_ALL; t += gridDim.x * NWAVE) {
        int lane = lane0; asm volatile("" : "+v"(lane));
        float x[16];
        { const float* xr = hbuf + (size_t)t * D_MODEL + lane * 8;
          const float4 a = *(const float4*)xr, b = *(const float4*)(xr + 4), c = *(const float4*)(xr + 512), d = *(const float4*)(xr + 516);
          x[0] = a.x; x[1] = a.y; x[2] = a.z; x[3] = a.w; x[4] = b.x; x[5] = b.y; x[6] = b.z; x[7] = b.w;
          x[8] = c.x; x[9] = c.y; x[10] = c.z; x[11] = c.w; x[12] = d.x; x[13] = d.y; x[14] = d.z; x[15] = d.w; }
        int ev[2]; float wv[4];
        ev[0] = eidx[(size_t)t * 128 + lane]; ev[1] = eidx[(size_t)t * 128 + 64 + lane];
#pragma unroll
        for (int rd = 0; rd < 4; ++rd) wv[rd] = gate[(size_t)t * 128 + rd * 32 + (lane >> 1)];
#pragma unroll
        for (int rd = 0; rd < 4; ++rd) {
            float part[32];
#pragma unroll
            for (int kb = 0; kb < 8; ++kb) {
                v4u ra[4], rb[4];
#pragma unroll
                for (int k8 = 0; k8 < 4; ++k8) {
                    const int e = __builtin_amdgcn_readlane(ev[rd >> 1], (rd & 1) * 32 + kb * 4 + k8);
                    const bf16* ur = ub + (size_t)e * D_MODEL + lane * 8;
                    ra[k8] = *(const v4u*)ur; rb[k8] = *(const v4u*)(ur + 512);
                }
#pragma unroll
                for (int k8 = 0; k8 < 4; ++k8) part[kb * 4 + k8] = peer_dot16(ra[k8], rb[k8], x);
            }
            PEER_TR_STEP(16, 32) PEER_TR_STEP(8, 16) PEER_TR_STEP(4, 8) PEER_TR_STEP(2, 4) PEER_TR_STEP(1, 2)
            const float hid = part[0] + __shfl_xor(part[0], 1);
            wv[rd] *= gelu_f(hid);
        }
        float acc[16];
#pragma unroll
        for (int j = 0; j < 16; ++j) acc[j] = 0.f;
#pragma unroll
        for (int rd = 0; rd < 4; ++rd) {
#pragma unroll
            for (int kb = 0; kb < 4; ++kb) {
                v4u ra[8], rb[8];
#pragma unroll
                for (int k8 = 0; k8 < 8; ++k8) {
                    const int e = __builtin_amdgcn_readlane(ev[rd >> 1], (rd & 1) * 32 + kb * 8 + k8);
                    const bf16* vr = vb + (size_t)e * D_MODEL + lane * 8;
                    ra[k8] = *(const v4u*)vr; rb[k8] = *(const v4u*)(vr + 512);
                }
#pragma unroll
                for (int k8 = 0; k8 < 8; ++k8) {
                    const float wk = __builtin_bit_cast(float, __builtin_amdgcn_readlane(__builtin_bit_cast(int, wv[rd]), 2 * (kb * 8 + k8)));
                    float u0[8], u1[8]; unpack8(ra[k8], u0); unpack8(rb[k8], u1);
#pragma unroll
                    for (int j = 0; j < 8; ++j) { acc[j] += wk * u0[j]; acc[8 + j] += wk * u1[j]; }
                }
            }
        }
        float s = 0.f;
#pragma unroll
        for (int j = 0; j < 16; ++j) { acc[j] += ALPHA_F * x[j]; s += acc[j]; }
        s = wave_sum(s);
        const float mu = s * (1.0f / 1024.0f);
        float q = 0.f;
#pragma unroll
        for (int j = 0; j < 16; ++j) { acc[j] -= mu; q += acc[j] * acc[j]; }
        q = wave_sum(q);
        const float r = rsqrtf(q * (1.0f / 1024.0f) + LN_EPS);
        float* dst = ((t < T_PROMPT) ? out + OUT_YP + (size_t)t * D_MODEL : out + OUT_YS + (size_t)(t - T_PROMPT) * D_MODEL) + lane * 8;
#pragma unroll
        for (int q4 = 0; q4 < 4; ++q4) {
            const int eo = (q4 >> 1) * 512 + (q4 & 1) * 4;
            const float4 g4 = *(const float4*)(gam + lane * 8 + eo), b4 = *(const float4*)(bet + lane * 8 + eo);
            float4 o; o.x = acc[q4 * 4 + 0] * r * g4.x + b4.x; o.y = acc[q4 * 4 + 1] * r * g4.y + b4.y; o.z = acc[q4 * 4 + 2] * r * g4.z + b4.z; o.w = acc[q4 * 4 + 3] * r * g4.w + b4.w;
            *(float4*)(dst + eo) = o;
        }
    }
}

__device__ __forceinline__ void ph_attn_sample(float* lds, const bf16* __restrict__ qrot_b, const bf16* __restrict__ krot_b, const bf16* __restrict__ projb,
                                               const float* __restrict__ ck, const float* __restrict__ cv, bf16* __restrict__ A1) {
    float (*sq)[64] = (float (*)[64])lds;
    const int w = threadIdx.x >> 6, lane0 = threadIdx.x & 63;
    for (int vb = blockIdx.x; vb < T_SAMPLE * 8 / NWAVE; vb += gridDim.x) {
        int lane = lane0; asm volatile("" : "+v"(lane));
        const int item = vb * NWAVE + w, ts = item >> 3, hd = item & 7, b = ts >> 2, i = ts & 3, t = T_PROMPT + ts;
        __syncthreads();
        sq[w][lane] = bf2f(qrot_b[(size_t)t * ATT_WIDTH + hd * 64 + lane]);
        __syncthreads();
        const int qi = WBUF + i;
        float sc[8];
        float mx = -INFINITY;
#pragma unroll
        for (int slot = 0; slot < 7; ++slot) {
            const int pt = slot < 6 ? (slot >> 1) : (lane < 3 ? lane : 0);
            const int m = slot < 6 ? lane + 64 * (slot & 1) : 128;
            const int kj = qi - (m << (2 * pt));
            const bool valid = (slot < 6 || lane < 3) && kj < WBUF;
            const int kc = kj < WBUF ? kj : WBUF - 1;
            const float* kr = ck + ((size_t)b * WBUF + kc) * ATT_WIDTH + hd * 64;
            float a = 0.f;
#pragma unroll
            for (int c = 0; c < 64; c += 4) { const float4 kv = *(const float4*)(kr + c); a += kv.x * sq[w][c] + kv.y * sq[w][c + 1] + kv.z * sq[w][c + 2] + kv.w * sq[w][c + 3]; }
            const float s = valid ? a * 0.125f : -INFINITY;
            sc[slot] = s; mx = fmaxf(mx, s);
        }
        const int nt7 = lane <= i ? i - lane : i;
        const bool valid7 = lane < i + 3;
        {
            const bf16* kr = krot_b + (size_t)(T_PROMPT + b * DEC_SEQ + nt7) * ATT_WIDTH + hd * 64;
            float a = 0.f;
#pragma unroll
            for (int c = 0; c < 64; c += 8) { float f[8]; unpack8(*(const v4u*)(kr + c), f);
#pragma unroll
                for (int j = 0; j < 8; ++j) a += f[j] * sq[w][c + j]; }
            const float s = valid7 ? a * 0.125f : -INFINITY;
            sc[7] = s; mx = fmaxf(mx, s);
        }
        mx = wave_max(mx);
        float lsum = 0.f;
#pragma unroll
        for (int slot = 0; slot < 8; ++slot) { const float pv = __expf(sc[slot] - mx); sc[slot] = pv; lsum += pv; }
        lsum = wave_sum(lsum);
        float part[64];
#pragma unroll
        for (int c = 0; c < 64; ++c) part[c] = 0.f;
#pragma unroll
        for (int slot = 0; slot < 7; ++slot) {
            const int pt = slot < 6 ? (slot >> 1) : (lane < 3 ? lane : 0);
            const int m = slot < 6 ? lane + 64 * (slot & 1) : 128;
            const int kj = qi - (m << (2 * pt));
            const int kc = kj < WBUF ? kj : WBUF - 1;
            const float pv = sc[slot];
            const float* vr = cv + ((size_t)b * WBUF + kc) * ATT_WIDTH + hd * 64;
#pragma unroll
            for (int c = 0; c < 64; c += 4) { const float4 vv = *(const float4*)(vr + c); part[c] += pv * vv.x; part[c + 1] += pv * vv.y; part[c + 2] += pv * vv.z; part[c + 3] += pv * vv.w; }
        }
        {
            const float pv = sc[7];
            const bf16* vr = projb + (size_t)(T_PROMPT + b * DEC_SEQ + nt7) * NB_LD + NB_V + hd * 64;
#pragma unroll
            for (int c = 0; c < 64; c += 8) { float f[8]; unpack8(*(const v4u*)(vr + c), f);
#pragma unroll
                for (int j = 0; j < 8; ++j) part[c + j] += pv * f[j]; }
        }
        PEER_TR_STEP(32, 32) PEER_TR_STEP(16, 16) PEER_TR_STEP(8, 8) PEER_TR_STEP(4, 4) PEER_TR_STEP(2, 2) PEER_TR_STEP(1, 1)
        A1[(size_t)t * MIX_WIDTH + SSD_WIDTH + hd * 64 + lane] = (bf16)f2bf(part[0] / lsum);
    }
}


__device__ __forceinline__ void cache_copy_slice(const float* __restrict__ ck, const float* __restrict__ cv, float* __restrict__ out, unsigned slice, unsigned lane) {
    constexpr unsigned PER_B = (WBUF - DEC_SEQ) * ATT_WIDTH / 4;
    constexpr unsigned TOTAL = 2u * DEC_BATCH * PER_B;
#pragma unroll 1
    for (unsigned bt = 0; bt < 8; ++bt) {
        f32x4n v[8]; size_t dsti[8]; bool isv[8]; bool ok[8];
#pragma unroll
        for (int j = 0; j < 8; ++j) {
            const unsigned idx = slice * 4096u + bt * 512u + j * 64u + lane;
            ok[j] = idx < TOTAL;
            const unsigned idc = ok[j] ? idx : 0u;
            const unsigned tb = idc / PER_B, r = idc - tb * PER_B, bb = tb & (DEC_BATCH - 1);
            isv[j] = tb >= DEC_BATCH;
            const size_t srci = (size_t)bb * (WBUF * ATT_WIDTH / 4) + (DEC_SEQ * ATT_WIDTH / 4) + r;
            dsti[j] = (size_t)bb * (WBUF * ATT_WIDTH / 4) + r;
            v[j] = __builtin_nontemporal_load((isv[j] ? (const f32x4n*)cv : (const f32x4n*)ck) + srci);
        }
#pragma unroll
        for (int j = 0; j < 8; ++j) if (ok[j]) __builtin_nontemporal_store(v[j], (f32x4n*)(out + (isv[j] ? OUT_SV : OUT_SK)) + dsti[j]);
    }
}

__device__ __forceinline__ void copy_q_load(const float* __restrict__ ck, const float* __restrict__ cv, unsigned q, unsigned lane, f32x4n (&v)[16]) {
    constexpr unsigned PER_B = (WBUF - DEC_SEQ) * ATT_WIDTH / 4, TOTAL = 2u * DEC_BATCH * PER_B;
#pragma unroll
    for (int j = 0; j < 16; ++j) {
        const unsigned idx = q * 1024u + j * 64u + lane, idc = idx < TOTAL ? idx : 0u;
        const unsigned tb = idc / PER_B, r = idc - tb * PER_B, bb = tb & (DEC_BATCH - 1);
        const size_t srci = (size_t)bb * (WBUF * ATT_WIDTH / 4) + (DEC_SEQ * ATT_WIDTH / 4) + r;
        v[j] = __builtin_nontemporal_load((tb >= DEC_BATCH ? (const f32x4n*)cv : (const f32x4n*)ck) + srci);
    }
}
__device__ __forceinline__ void copy_q_store(float* __restrict__ out, unsigned q, unsigned lane, const f32x4n (&v)[16]) {
    constexpr unsigned PER_B = (WBUF - DEC_SEQ) * ATT_WIDTH / 4, TOTAL = 2u * DEC_BATCH * PER_B;
#pragma unroll
    for (int j = 0; j < 16; ++j) {
        const unsigned idx = q * 1024u + j * 64u + lane;
        if (idx < TOTAL) {
            const unsigned tb = idx / PER_B, r = idx - tb * PER_B, bb = tb & (DEC_BATCH - 1);
            const size_t dsti = (size_t)bb * (WBUF * ATT_WIDTH / 4) + r;
            __builtin_nontemporal_store(v[j], (f32x4n*)(out + (tb >= DEC_BATCH ? OUT_SV : OUT_SK)) + dsti);
        }
    }
}
typedef float f32x2v __attribute__((ext_vector_type(2)));
__device__ __forceinline__ void ph_quant_tables(const float* __restrict__ pu, const float* __restrict__ pv, unsigned char* __restrict__ ub8, unsigned char* __restrict__ vb8,
                                                float* __restrict__ usc, float* __restrict__ vsc, int rank, int nranks) {
    const int lane = threadIdx.x & 63;
#pragma unroll 2
    for (int row = rank * NWAVE + (threadIdx.x >> 6); row < 2 * 16384; row += nranks * NWAVE) {
        const int rr = row & 16383; const bool isv = row >= 16384;
        const float* src = (isv ? pv : pu) + (size_t)rr * D_MODEL + lane * 8;
        const float4 a = *(const float4*)src, b = *(const float4*)(src + 4), c = *(const float4*)(src + 512), d = *(const float4*)(src + 516);
        float am = fmaxf(fmaxf(fmaxf(fabsf(a.x), fabsf(a.y)), fmaxf(fabsf(a.z), fabsf(a.w))), fmaxf(fmaxf(fabsf(b.x), fabsf(b.y)), fmaxf(fabsf(b.z), fabsf(b.w))));
        am = fmaxf(am, fmaxf(fmaxf(fmaxf(fabsf(c.x), fabsf(c.y)), fmaxf(fabsf(c.z), fabsf(c.w))), fmaxf(fmaxf(fabsf(d.x), fabsf(d.y)), fmaxf(fabsf(d.z), fabsf(d.w)))));
        am = wave_max(am);
        const float sc = am > 0.f ? 224.0f / am : 1.0f;
        v4u o;
        o.x = (unsigned)__builtin_amdgcn_cvt_pk_fp8_f32(a.z * sc, a.w * sc, __builtin_amdgcn_cvt_pk_fp8_f32(a.x * sc, a.y * sc, 0, false), true);
        o.y = (unsigned)__builtin_amdgcn_cvt_pk_fp8_f32(b.z * sc, b.w * sc, __builtin_amdgcn_cvt_pk_fp8_f32(b.x * sc, b.y * sc, 0, false), true);
        o.z = (unsigned)__builtin_amdgcn_cvt_pk_fp8_f32(c.z * sc, c.w * sc, __builtin_amdgcn_cvt_pk_fp8_f32(c.x * sc, c.y * sc, 0, false), true);
        o.w = (unsigned)__builtin_amdgcn_cvt_pk_fp8_f32(d.z * sc, d.w * sc, __builtin_amdgcn_cvt_pk_fp8_f32(d.x * sc, d.y * sc, 0, false), true);
        *(v4u*)((isv ? vb8 : ub8) + (size_t)rr * 1024 + lane * 16) = o;
        if (lane == 0) (isv ? vsc : usc)[rr] = am > 0.f ? am * (1.0f / 224.0f) : 1.0f;
    }
}
__device__ __forceinline__ void unpack16_fp8(const v4u w, float (&f)[16]) {
#pragma unroll
    for (int i = 0; i < 4; ++i) {
        const f32x2v lo = __builtin_amdgcn_cvt_pk_f32_fp8((int)w[i], false), hi = __builtin_amdgcn_cvt_pk_f32_fp8((int)w[i], true);
        f[4 * i] = lo[0]; f[4 * i + 1] = lo[1]; f[4 * i + 2] = hi[0]; f[4 * i + 3] = hi[1];
    }
}
__device__ __forceinline__ void ph_peer_ffn3(const bf16* __restrict__ hb, const int* __restrict__ eidx, const float* __restrict__ gate,
                                             const unsigned char* __restrict__ ub8, const unsigned char* __restrict__ vb8, const float* __restrict__ usc, const float* __restrict__ vsc,
                                             const float* __restrict__ gam, const float* __restrict__ bet, float* __restrict__ out,
                                             const float* __restrict__ ck, const float* __restrict__ cv, unsigned n9) {
    const int lane0 = threadIdx.x & 63;
    unsigned it = 0;
    for (int t = blockIdx.x * NWAVE + (threadIdx.x >> 6); t < T_ALL; t += gridDim.x * NWAVE, ++it) {
        int lane = lane0; asm volatile("" : "+v"(lane));
        { const unsigned sl = n9 + (blockIdx.x * NWAVE + (threadIdx.x >> 6)) + it * (gridDim.x * NWAVE); if (sl < 16384u) cache_copy_slice(ck, cv, out, sl, (unsigned)lane); }
        const unsigned lo16 = (unsigned)lane * 16u, lo8 = (unsigned)lane * 8u;
        float x[16];
        { float f0[8], f1[8]; const bf16* xr = hb + (size_t)t * D_MODEL + lo8; unpack8(*(const v4u*)xr, f0); unpack8(*(const v4u*)(xr + 512), f1);
#pragma unroll
          for (int j = 0; j < 8; ++j) { x[j] = f0[j]; x[8 + j] = f1[j]; } }
        int ev[2]; float wv[4], su[4];
        ev[0] = eidx[(size_t)t * 128 + lane]; ev[1] = eidx[(size_t)t * 128 + 64 + lane];
#pragma unroll
        for (int rd = 0; rd < 4; ++rd) {
            const int er = eidx[(size_t)t * 128 + rd * 32 + (lane >> 1)];
            wv[rd] = gate[(size_t)t * 128 + rd * 32 + (lane >> 1)] * vsc[er];
            su[rd] = usc[er];
        }
#pragma unroll
        for (int rd = 0; rd < 4; ++rd) {
            float part[32];
#pragma unroll
            for (int kb = 0; kb < 8; ++kb) {
                v4u ra[4];
#pragma unroll
                for (int k8 = 0; k8 < 4; ++k8) {
                    const int e = __builtin_amdgcn_readlane(ev[rd >> 1], (rd & 1) * 32 + kb * 4 + k8);
                    ra[k8] = *(const v4u*)(ub8 + (size_t)e * 1024 + lo16);
                }
#pragma unroll
                for (int k8 = 0; k8 < 4; ++k8) {
                    f32x2v dv = {0.f, 0.f};
#pragma unroll
                    for (int i = 0; i < 4; ++i) {
                        const f32x2v lo = __builtin_amdgcn_cvt_pk_f32_fp8((int)ra[k8][i], false), hi = __builtin_amdgcn_cvt_pk_f32_fp8((int)ra[k8][i], true);
                        dv += lo * (f32x2v){x[4 * i], x[4 * i + 1]}; dv += hi * (f32x2v){x[4 * i + 2], x[4 * i + 3]};
                    }
                    part[kb * 4 + k8] = dv[0] + dv[1];
                    if (k8 & 1) __builtin_amdgcn_sched_barrier(0);
                }
            }
            PEER_TR_STEP(16, 32) PEER_TR_STEP(8, 16) PEER_TR_STEP(4, 8) PEER_TR_STEP(2, 4) PEER_TR_STEP(1, 2)
            const float hid = (part[0] + __shfl_xor(part[0], 1)) * su[rd];
            wv[rd] *= gelu_f(hid);
        }
        float acc[16];
#pragma unroll
        for (int j = 0; j < 16; ++j) acc[j] = 0.f;
#pragma unroll
        for (int rd = 0; rd < 4; ++rd) {
#pragma unroll
            for (int kb = 0; kb < 4; ++kb) {
                v4u ra[8];
#pragma unroll
                for (int k8 = 0; k8 < 8; ++k8) {
                    const int e = __builtin_amdgcn_readlane(ev[rd >> 1], (rd & 1) * 32 + kb * 8 + k8);
                    ra[k8] = *(const v4u*)(vb8 + (size_t)e * 1024 + lo16);
                }
#pragma unroll
                for (int k8 = 0; k8 < 8; ++k8) {
                    const float wk = __builtin_bit_cast(float, __builtin_amdgcn_readlane(__builtin_bit_cast(int, wv[rd]), 2 * (kb * 8 + k8)));
                    float f[16]; unpack16_fp8(ra[k8], f);
#pragma unroll
                    for (int j = 0; j < 16; ++j) acc[j] += wk * f[j];
                    if (k8 & 1) __builtin_amdgcn_sched_barrier(0);
                }
            }
        }
        float s = 0.f;
#pragma unroll
        for (int j = 0; j < 16; ++j) { acc[j] += ALPHA_F * x[j]; s += acc[j]; }
        s = wave_sum(s);
        const float mu = s * (1.0f / 1024.0f);
        float q = 0.f;
#pragma unroll
        for (int j = 0; j < 16; ++j) { acc[j] -= mu; q += acc[j] * acc[j]; }
        q = wave_sum(q);
        const float r = rsqrtf(q * (1.0f / 1024.0f) + LN_EPS);
        float* dst = ((t < T_PROMPT) ? out + OUT_YP + (size_t)t * D_MODEL : out + OUT_YS + (size_t)(t - T_PROMPT) * D_MODEL) + lo8;
#pragma unroll
        for (int q4 = 0; q4 < 4; ++q4) {
            const int eo = (q4 >> 1) * 512 + (q4 & 1) * 4;
            const float4 g4 = *(const float4*)(gam + lo8 + eo), b4 = *(const float4*)(bet + lo8 + eo);
            float4 o; o.x = acc[q4 * 4 + 0] * r * g4.x + b4.x; o.y = acc[q4 * 4 + 1] * r * g4.y + b4.y; o.z = acc[q4 * 4 + 2] * r * g4.z + b4.z; o.w = acc[q4 * 4 + 3] * r * g4.w + b4.w;
            *(float4*)(dst + eo) = o;
        }
    }
    for (;; ++it) {
        const unsigned sl = n9 + (blockIdx.x * NWAVE + (threadIdx.x >> 6)) + it * (gridDim.x * NWAVE);
        if (sl >= 16384u) break;
        cache_copy_slice(ck, cv, out, sl, (unsigned)lane0);
    }
}


__device__ __forceinline__ void ssd_decode_load(const bf16* __restrict__ xbc_b, const float* __restrict__ dtv, const float* __restrict__ state_ssm, int item, int p, int ng,
                                                float (&hs)[16], v4u (&bq)[4][2], v4u (&cq)[4][2], float (&xv)[4], float (&dv)[4]) {
    const int sb = item / SSD_HEADS, h = item - sb * SSD_HEADS, g = h / 6, t0 = T_PROMPT + sb * DEC_SEQ;
    const float* s0 = state_ssm + (((size_t)sb * SSD_HEADS + h) * 64 + p) * 128 + ng * 16;
#pragma unroll
    for (int j = 0; j < 4; ++j) { const float4 v = *(const float4*)(s0 + 4 * j); hs[4 * j] = v.x; hs[4 * j + 1] = v.y; hs[4 * j + 2] = v.z; hs[4 * j + 3] = v.w; }
#pragma unroll
    for (int s = 0; s < 4; ++s) {
        const bf16* row = xbc_b + (size_t)(t0 + s) * CONV_DIM;
        bq[s][0] = *(const v4u*)(row + 1536 + g * 128 + ng * 16); bq[s][1] = *(const v4u*)(row + 1536 + g * 128 + ng * 16 + 8);
        cq[s][0] = *(const v4u*)(row + 2048 + g * 128 + ng * 16); cq[s][1] = *(const v4u*)(row + 2048 + g * 128 + ng * 16 + 8);
        xv[s] = bf2f(row[h * 64 + p]); dv[s] = dtv[(size_t)(t0 + s) * SSD_HEADS + h];
    }
}
__device__ __forceinline__ void ssd_decode_compute(const float* __restrict__ a_log, const float* __restrict__ d_skip, int item, int p, int ng,
                                                   float (&hs)[16], const v4u (&bq)[4][2], const v4u (&cq)[4][2], const float (&xv)[4], const float (&dv)[4],
                                                   float* __restrict__ ybuf, float* __restrict__ out) {
    const int sb = item / SSD_HEADS, h = item - sb * SSD_HEADS, t0 = T_PROMPT + sb * DEC_SEQ;
    const float A = -__expf(a_log[h]), D = d_skip[h];
#pragma unroll
    for (int s = 0; s < 4; ++s) {
        float Bf[16], Cf[16];
        { float t8[8]; unpack8(bq[s][0], t8);
#pragma unroll
          for (int j = 0; j < 8; ++j) Bf[j] = t8[j];
          unpack8(bq[s][1], t8);
#pragma unroll
          for (int j = 0; j < 8; ++j) Bf[8 + j] = t8[j];
          unpack8(cq[s][0], t8);
#pragma unroll
          for (int j = 0; j < 8; ++j) Cf[j] = t8[j];
          unpack8(cq[s][1], t8);
#pragma unroll
          for (int j = 0; j < 8; ++j) Cf[8 + j] = t8[j]; }
        const float a = __expf(dv[s] * A), xdt = xv[s] * dv[s];
        float y = 0.f;
#pragma unroll
        for (int j = 0; j < 16; ++j) { hs[j] = a * hs[j] + xdt * Bf[j]; y += Cf[j] * hs[j]; }
        y += __shfl_xor(y, 1); y += __shfl_xor(y, 2); y += __shfl_xor(y, 4);
        if (ng == 0) ybuf[(size_t)(t0 + s) * MIX_WIDTH + h * 64 + p] = y + D * xv[s];
    }
    float* so = out + OUT_SS + (((size_t)sb * SSD_HEADS + h) * 64 + p) * 128 + ng * 16;
#pragma unroll
    for (int j = 0; j < 4; ++j) *(float4*)(so + 4 * j) = make_float4(hs[4 * j], hs[4 * j + 1], hs[4 * j + 2], hs[4 * j + 3]);
}
__device__ __forceinline__ void ph_ssd_decode(const bf16* __restrict__ xbc_b, const float* __restrict__ dtv, const float* __restrict__ a_log, const float* __restrict__ d_skip,
                                              const float* __restrict__ state_ssm, float* __restrict__ ybuf, float* __restrict__ out) {
    const int tid = threadIdx.x, p = tid >> 3, ng = tid & 7;
    constexpr int NITEM = DEC_BATCH * SSD_HEADS;
    for (int it = blockIdx.x; it < NITEM; it += 2 * gridDim.x) {
        const int it2 = it + gridDim.x; const bool has2 = it2 < NITEM; const int it2c = has2 ? it2 : it;
        float hsA[16], hsB[16], xA[4], xB[4], dA[4], dB[4]; v4u bA[4][2], cA[4][2], bB[4][2], cB[4][2];
        ssd_decode_load(xbc_b, dtv, state_ssm, it, p, ng, hsA, bA, cA, xA, dA);
        ssd_decode_load(xbc_b, dtv, state_ssm, it2c, p, ng, hsB, bB, cB, xB, dB);
        ssd_decode_compute(a_log, d_skip, it, p, ng, hsA, bA, cA, xA, dA, ybuf, out);
        if (has2) ssd_decode_compute(a_log, d_skip, it2, p, ng, hsB, bB, cB, xB, dB, ybuf, out);
    }
}

__device__ __forceinline__ float samp_cw(int d) { return (float)((int)(d >= 0 && d <= 128) + (int)(d >= 0 && (d & 3) == 0 && d <= 512) + (int)(d >= 0 && (d & 15) == 0 && d <= 2048)); }
__device__ __forceinline__ void samp_update(float sv, float cw, const float (&vrow)[64], float& m, float& l, float (&part)[64]) {
    const float mn = fmaxf(m, sv), alpha = __expf(m - mn), p = cw * __expf(sv - mn);
    m = mn; l = l * alpha + p;
#pragma unroll
    for (int c = 0; c < 64; ++c) part[c] = part[c] * alpha + p * vrow[c];
}
__device__ __forceinline__ void ph_attn_sample3(float* lds, const bf16* __restrict__ qrot_b, const bf16* __restrict__ krot_b, const bf16* __restrict__ projb,
                                                const float* __restrict__ ck, const float* __restrict__ cv, bf16* __restrict__ A1) {
    const int lane0 = threadIdx.x & 63, w = __builtin_amdgcn_readfirstlane(threadIdx.x >> 6);
    float* sq = lds + w * 256;
    for (int item = blockIdx.x + gridDim.x * w; item < DEC_BATCH * ATT_HEADS; item += gridDim.x * NWAVE) {
        int lane = lane0; asm volatile("" : "+v"(lane));
        const int b = item >> 3, hd = item & 7, qi = lane & 3, g = lane >> 2;
        const int tq0 = T_PROMPT + b * DEC_SEQ;
#pragma unroll
        for (int i = 0; i < 4; ++i) sq[i * 64 + lane] = bf2f(qrot_b[(size_t)(tq0 + i) * ATT_WIDTH + hd * 64 + lane]);
        asm volatile("s_waitcnt lgkmcnt(0)" ::: "memory");
        const float* qv = sq + qi * 64;
        const float* ckb = ck + (size_t)b * WBUF * ATT_WIDTH + hd * 64; const float* cvb = cv + (size_t)b * WBUF * ATT_WIDTH + hd * 64;
        float m = -1e30f, l = 0.f, part[64];
#pragma unroll
        for (int c = 0; c < 64; ++c) part[c] = 0.f;
        {
            const int P = 2051 - g;
            const float cw = samp_cw(WBUF + qi - P);
            const bool isn = P >= WBUF;
            const int nt = isn ? P - WBUF : 0, Pc = isn ? WBUF - 1 : P;
            const bf16* kn = krot_b + (size_t)(tq0 + nt) * ATT_WIDTH + hd * 64; const float* kr = ckb + (size_t)Pc * ATT_WIDTH;
            float a = 0.f;
#pragma unroll
            for (int c = 0; c < 64; c += 8) { float f[8]; unpack8(*(const v4u*)(kn + c), f); const float4 k0 = *(const float4*)(kr + c), k1 = *(const float4*)(kr + c + 4);
                a += (isn ? f[0] : k0.x) * qv[c] + (isn ? f[1] : k0.y) * qv[c + 1] + (isn ? f[2] : k0.z) * qv[c + 2] + (isn ? f[3] : k0.w) * qv[c + 3]
                   + (isn ? f[4] : k1.x) * qv[c + 4] + (isn ? f[5] : k1.y) * qv[c + 5] + (isn ? f[6] : k1.z) * qv[c + 6] + (isn ? f[7] : k1.w) * qv[c + 7]; }
            const float sv = cw > 0.f ? a * 0.125f : -1e30f;
            const bf16* vn = projb + (size_t)(tq0 + nt) * NB_LD + NB_V + hd * 64; const float* vr = cvb + (size_t)Pc * ATT_WIDTH;
            float vrow[64];
#pragma unroll
            for (int c = 0; c < 64; c += 8) { float f[8]; unpack8(*(const v4u*)(vn + c), f); const float4 v0 = *(const float4*)(vr + c), v1 = *(const float4*)(vr + c + 4);
                vrow[c] = isn ? f[0] : v0.x; vrow[c + 1] = isn ? f[1] : v0.y; vrow[c + 2] = isn ? f[2] : v0.z; vrow[c + 3] = isn ? f[3] : v0.w;
                vrow[c + 4] = isn ? f[4] : v1.x; vrow[c + 5] = isn ? f[5] : v1.y; vrow[c + 6] = isn ? f[6] : v1.z; vrow[c + 7] = isn ? f[7] : v1.w; }
            samp_update(sv, cw, vrow, m, l, part);
        }
#pragma unroll 1
        for (int s = 1; s < 21; ++s) {
            const int P = s < 9 ? 2051 - (16 * s + g) : (s < 15 ? 1536 + 64 * (s - 9) + lane : qi + 16 * (16 * (s - 15) + g));
            const float cw = (s < 9 && P < 1920) ? 0.f : samp_cw(WBUF + qi - P);
            const float* kr = ckb + (size_t)P * ATT_WIDTH;
            float a = 0.f;
#pragma unroll
            for (int c = 0; c < 64; c += 4) { const float4 kv = *(const float4*)(kr + c); a += kv.x * qv[c] + kv.y * qv[c + 1] + kv.z * qv[c + 2] + kv.w * qv[c + 3]; }
            const float sv = cw > 0.f ? a * 0.125f : -1e30f;
            __builtin_amdgcn_sched_barrier(0);
            const float* vr = cvb + (size_t)P * ATT_WIDTH;
            float vrow[64];
#pragma unroll
            for (int c = 0; c < 64; c += 4) { const float4 vv = *(const float4*)(vr + c); vrow[c] = vv.x; vrow[c + 1] = vv.y; vrow[c + 2] = vv.z; vrow[c + 3] = vv.w; }
            samp_update(sv, cw, vrow, m, l, part);
        }
        float M = m;
        M = fmaxf(M, __shfl_xor(M, 4)); M = fmaxf(M, __shfl_xor(M, 8)); M = fmaxf(M, __shfl_xor(M, 16)); M = fmaxf(M, __shfl_xor(M, 32));
        const float sc = __expf(m - M);
        float lsum = l * sc;
        lsum += __shfl_xor(lsum, 4); lsum += __shfl_xor(lsum, 8); lsum += __shfl_xor(lsum, 16); lsum += __shfl_xor(lsum, 32);
#pragma unroll
        for (int c = 0; c < 64; ++c) part[c] *= sc;
        PEER_TR_STEP(32, 32) PEER_TR_STEP(16, 16) PEER_TR_STEP(8, 8) PEER_TR_STEP(4, 4)
        const float inv = 1.0f / lsum;
        *(uint2*)(A1 + (size_t)(tq0 + qi) * MIX_WIDTH + SSD_WIDTH + hd * 64 + 4 * g) = make_uint2(pk2(part[0] * inv, part[1] * inv), pk2(part[2] * inv, part[3] * inv));
    }
}

typedef float f32x16 __attribute__((ext_vector_type(16)));
typedef short s16x8 __attribute__((ext_vector_type(8)));
typedef short s16x4 __attribute__((ext_vector_type(4)));
typedef float f32x4v __attribute__((ext_vector_type(4)));
#define SSD_L_ACS 0
#define SSD_L_DTS 3072
#define SSD_L_BM 6144
#define SSD_RS_B 272
#define SSD_L_X (6144 + 128 * 272)
#define SSD_RS_X 144
#define SSD_XIMG (128 * 144)
#define SSD_RS_Y 784
template <int OFF0, int OFF1>
__device__ __forceinline__ s16x8 tr_frag(unsigned base) {
    s16x4 a, b;
    asm volatile("ds_read_b64_tr_b16 %0, %2 offset:%3\n\tds_read_b64_tr_b16 %1, %2 offset:%4\n\ts_waitcnt lgkmcnt(0)"
                 : "=&v"(a), "=&v"(b) : "v"(base), "n"(OFF0), "n"(OFF1) : "memory");
    return __builtin_shufflevector(a, b, 0, 1, 2, 3, 4, 5, 6, 7);
}
__device__ __forceinline__ unsigned lds_addr(LAS unsigned char* p) { return (unsigned)(size_t)p; }
template <int O0, int O1, int O2, int O3, int O4, int O5, int O6, int O7>
__device__ __forceinline__ void tr_read8(unsigned base, s16x4 (&v)[8]) {
    asm volatile("ds_read_b64_tr_b16 %0, %8 offset:%9\n\tds_read_b64_tr_b16 %1, %8 offset:%10\n\tds_read_b64_tr_b16 %2, %8 offset:%11\n\tds_read_b64_tr_b16 %3, %8 offset:%12\n\t"
                 "ds_read_b64_tr_b16 %4, %8 offset:%13\n\tds_read_b64_tr_b16 %5, %8 offset:%14\n\tds_read_b64_tr_b16 %6, %8 offset:%15\n\tds_read_b64_tr_b16 %7, %8 offset:%16\n\ts_waitcnt lgkmcnt(0)"
                 : "=&v"(v[0]), "=&v"(v[1]), "=&v"(v[2]), "=&v"(v[3]), "=&v"(v[4]), "=&v"(v[5]), "=&v"(v[6]), "=&v"(v[7])
                 : "v"(base), "n"(O0), "n"(O1), "n"(O2), "n"(O3), "n"(O4), "n"(O5), "n"(O6), "n"(O7) : "memory");
}
#define TRCAT(a, b) __builtin_shufflevector(a, b, 0, 1, 2, 3, 4, 5, 6, 7)


__device__ __forceinline__ void ssd_chunk_acs(LAS unsigned char* ldsb, const float* __restrict__ dtv, const float* __restrict__ a_log, int t0, int g, float* cdec_out) {
    const int w = __builtin_amdgcn_readfirstlane(threadIdx.x >> 6), lane = threadIdx.x & 63;
    if (w < 6) {
        const int head = 6 * g + w;
        const float A = -__expf(a_log[head]);
        const float v0 = dtv[(size_t)(t0 + 2 * lane) * SSD_HEADS + head], v1 = dtv[(size_t)(t0 + 2 * lane + 1) * SSD_HEADS + head];
        const float a1 = v1 * A;
        float s = v0 * A + a1;
#pragma unroll
        for (int o = 1; o < 64; o <<= 1) { const float tmp = __shfl_up(s, o); if (lane >= o) s += tmp; }
        LAS float* acs = (LAS float*)(ldsb + SSD_L_ACS) + w * 128;
        LAS float* dts = (LAS float*)(ldsb + SSD_L_DTS) + w * 128;
        acs[2 * lane] = s - a1; acs[2 * lane + 1] = s;
        dts[2 * lane] = v0; dts[2 * lane + 1] = v1;
        if (cdec_out && lane == 63) cdec_out[head] = __expf(s);
    }
}

__device__ __forceinline__ void ph_ssd_states(LAS unsigned char* ldsb, const bf16* __restrict__ xbc_b, const float* __restrict__ dtv, const float* __restrict__ a_log,
                                              bf16* __restrict__ Sbuf, float* __restrict__ cdec, const float* __restrict__ ck, const float* __restrict__ cv, float* __restrict__ out) {
    const int tid = threadIdx.x, w = __builtin_amdgcn_readfirstlane(tid >> 6), lane = tid & 63;
    const int r = lane & 31, h = lane >> 5, blk = (lane >> 4) & 1, q = (lane & 15) >> 2, pp = lane & 3;
    const int nt = w & 3, pt = w >> 2;
    for (int unit = blockIdx.x; unit < BATCH * 64 * SSD_GROUPS; unit += gridDim.x) {
        const int g = unit & 3, bc = unit >> 2;
        const int t0 = bc * 128;
        __syncthreads();
        ssd_chunk_acs(ldsb, dtv, a_log, t0, g, cdec + (size_t)bc * SSD_HEADS);
#pragma unroll
        for (int it_ = 0; it_ < 4; ++it_) { const int idx = tid + it_ * NTHR; const int row = idx >> 4, ch = idx & 15;
            const v4u v = *(const v4u*)(xbc_b + (size_t)(t0 + row) * CONV_DIM + 1536 + 128 * g + ch * 8);
            *(LAS v4u*)(ldsb + SSD_L_BM + row * SSD_RS_B + ch * 16) = v; }
        __syncthreads();
#pragma unroll
        for (int it_ = 0; it_ < 12; ++it_) { const int idx = tid + it_ * NTHR; const int hh = idx >> 10, rem = idx & 1023, row = rem >> 3, ch = rem & 7;
            const LAS float* acs = (const LAS float*)(ldsb + SSD_L_ACS) + hh * 128; const LAS float* dts = (const LAS float*)(ldsb + SSD_L_DTS) + hh * 128;
            const float wgt = dts[row] * __expf(acs[127] - acs[row]);
            float f[8]; unpack8(*(const v4u*)(xbc_b + (size_t)(t0 + row) * CONV_DIM + (6 * g + hh) * 64 + ch * 8), f);
            v4u o; o.x = pk2(f[0] * wgt, f[1] * wgt); o.y = pk2(f[2] * wgt, f[3] * wgt); o.z = pk2(f[4] * wgt, f[5] * wgt); o.w = pk2(f[6] * wgt, f[7] * wgt);
            *(LAS v4u*)(ldsb + SSD_L_X + hh * SSD_XIMG + row * SSD_RS_X + ch * 16) = o; }
        __syncthreads();
        f32x4n rider[16];
        copy_q_load(ck, cv, 12288u + (unsigned)(unit * NWAVE + w), (unsigned)lane, rider);
        const unsigned abase = lds_addr(ldsb + SSD_L_BM) + (8 * h + q) * SSD_RS_B + (32 * nt + 16 * blk + 4 * pp) * 2;
        s16x8 afr[8];
        { s16x4 av[8];
          tr_read8<0 * SSD_RS_B, 4 * SSD_RS_B, 16 * SSD_RS_B, 20 * SSD_RS_B, 32 * SSD_RS_B, 36 * SSD_RS_B, 48 * SSD_RS_B, 52 * SSD_RS_B>(abase, av);
          afr[0] = TRCAT(av[0], av[1]); afr[1] = TRCAT(av[2], av[3]); afr[2] = TRCAT(av[4], av[5]); afr[3] = TRCAT(av[6], av[7]);
          tr_read8<64 * SSD_RS_B, 68 * SSD_RS_B, 80 * SSD_RS_B, 84 * SSD_RS_B, 96 * SSD_RS_B, 100 * SSD_RS_B, 112 * SSD_RS_B, 116 * SSD_RS_B>(abase, av);
          afr[4] = TRCAT(av[0], av[1]); afr[5] = TRCAT(av[2], av[3]); afr[6] = TRCAT(av[4], av[5]); afr[7] = TRCAT(av[6], av[7]); }
#pragma unroll
        for (int hh = 0; hh < 6; ++hh) {
            const unsigned xb = lds_addr(ldsb + SSD_L_X + hh * SSD_XIMG) + (8 * h + q) * SSD_RS_X + (32 * pt + 16 * blk + 4 * pp) * 2;
            f32x16 acc;
#pragma unroll
            for (int i = 0; i < 16; ++i) acc[i] = 0.f;
            { s16x4 xv[8];
              tr_read8<0 * SSD_RS_X, 4 * SSD_RS_X, 16 * SSD_RS_X, 20 * SSD_RS_X, 32 * SSD_RS_X, 36 * SSD_RS_X, 48 * SSD_RS_X, 52 * SSD_RS_X>(xb, xv);
              acc = __builtin_amdgcn_mfma_f32_32x32x16_bf16(afr[0], TRCAT(xv[0], xv[1]), acc, 0, 0, 0);
              acc = __builtin_amdgcn_mfma_f32_32x32x16_bf16(afr[1], TRCAT(xv[2], xv[3]), acc, 0, 0, 0);
              acc = __builtin_amdgcn_mfma_f32_32x32x16_bf16(afr[2], TRCAT(xv[4], xv[5]), acc, 0, 0, 0);
              acc = __builtin_amdgcn_mfma_f32_32x32x16_bf16(afr[3], TRCAT(xv[6], xv[7]), acc, 0, 0, 0);
              tr_read8<64 * SSD_RS_X, 68 * SSD_RS_X, 80 * SSD_RS_X, 84 * SSD_RS_X, 96 * SSD_RS_X, 100 * SSD_RS_X, 112 * SSD_RS_X, 116 * SSD_RS_X>(xb, xv);
              acc = __builtin_amdgcn_mfma_f32_32x32x16_bf16(afr[4], TRCAT(xv[0], xv[1]), acc, 0, 0, 0);
              acc = __builtin_amdgcn_mfma_f32_32x32x16_bf16(afr[5], TRCAT(xv[2], xv[3]), acc, 0, 0, 0);
              acc = __builtin_amdgcn_mfma_f32_32x32x16_bf16(afr[6], TRCAT(xv[4], xv[5]), acc, 0, 0, 0);
              acc = __builtin_amdgcn_mfma_f32_32x32x16_bf16(afr[7], TRCAT(xv[6], xv[7]), acc, 0, 0, 0); }
            bf16* dst = Sbuf + ((size_t)bc * SSD_HEADS + 6 * g + hh) * 8192 + (size_t)(pt * 8 + 2 * nt) * 512 + r * 8 + 4 * h;
#pragma unroll
            for (int q4 = 0; q4 < 4; ++q4) *(uint2*)(dst + (q4 >> 1) * 512 + (q4 & 1) * 256) = make_uint2(pk2(acc[4 * q4], acc[4 * q4 + 1]), pk2(acc[4 * q4 + 2], acc[4 * q4 + 3]));
        }
        copy_q_store(out, 12288u + (unsigned)(unit * NWAVE + w), (unsigned)lane, rider);
    }
}

__device__ __forceinline__ void ph_ssd_scan(const bf16* __restrict__ Sbuf, const float* __restrict__ cdec, bf16* __restrict__ Hin, float* __restrict__ out, int rank, int nranks) {
    for (int idx = rank * NTHR + threadIdx.x; idx < BATCH * SSD_HEADS * 1024; idx += nranks * NTHR) {
        const int i = idx & 1023, hb = idx >> 10, hd = hb % SSD_HEADS, b = hb / SSD_HEADS;
        float st[8];
#pragma unroll
        for (int j = 0; j < 8; ++j) st[j] = 0.f;
#pragma unroll 8
        for (int c = 0; c < 64; ++c) {
            const size_t base = (((size_t)(b * 64 + c)) * SSD_HEADS + hd) * 8192 + (size_t)i * 8;
            v4u o; o.x = pk2(st[0], st[1]); o.y = pk2(st[2], st[3]); o.z = pk2(st[4], st[5]); o.w = pk2(st[6], st[7]);
            *(v4u*)(Hin + base) = o;
            float s[8]; unpack8(*(const v4u*)(Sbuf + base), s);
            const float a = cdec[(size_t)(b * 64 + c) * SSD_HEADS + hd];
#pragma unroll
            for (int j = 0; j < 8; ++j) st[j] = a * st[j] + s[j];
        }
        const int ln = i & 63, ks = (i >> 6) & 7, pt = i >> 9, p = 32 * pt + (ln & 31), n0 = 16 * ks + 8 * (ln >> 5);
        store8f(out + OUT_PS + (((size_t)b * SSD_HEADS + hd) * 64 + p) * 128 + n0, st);
    }
}

__device__ __forceinline__ void ph_ssd_out(LAS unsigned char* ldsb, const bf16* __restrict__ xbc_b, const bf16* __restrict__ projb, const float* __restrict__ dtv,
                                           const float* __restrict__ a_log, const float* __restrict__ d_skip, const float* __restrict__ norm_g,
                                           const bf16* __restrict__ Hin, bf16* __restrict__ A1) {
    const int tid = threadIdx.x, w = __builtin_amdgcn_readfirstlane(tid >> 6), lane = tid & 63;
    const int r = lane & 31, h = lane >> 5, blk = (lane >> 4) & 1, q = (lane & 15) >> 2, pp = lane & 3;
    const int lt = w & 3, hs = w >> 2;
    for (int unit = blockIdx.x; unit < BATCH * 64 * SSD_GROUPS; unit += gridDim.x) {
        const int g = unit & 3, bc = unit >> 2;
        const int t0 = bc * 128;
        __syncthreads();
        ssd_chunk_acs(ldsb, dtv, a_log, t0, g, nullptr);
#pragma unroll
        for (int it_ = 0; it_ < 4; ++it_) { const int idx = tid + it_ * NTHR; const int row = idx >> 4, ch = idx & 15;
            const v4u v = *(const v4u*)(xbc_b + (size_t)(t0 + row) * CONV_DIM + 1536 + 128 * g + ch * 8);
            *(LAS v4u*)(ldsb + SSD_L_BM + row * SSD_RS_B + ch * 16) = v; }
#pragma unroll
        for (int it_ = 0; it_ < 12; ++it_) { const int idx = tid + it_ * NTHR; const int hh = idx >> 10, rem = idx & 1023, row = rem >> 3, ch = rem & 7;
            const v4u v = *(const v4u*)(xbc_b + (size_t)(t0 + row) * CONV_DIM + (6 * g + hh) * 64 + ch * 8);
            *(LAS v4u*)(ldsb + SSD_L_X + hh * SSD_XIMG + row * SSD_RS_X + ch * 16) = v; }
        __syncthreads();
        const bf16* cp = xbc_b + (size_t)(t0 + 32 * lt + r) * CONV_DIM + 2048 + 128 * g + 8 * h;
        s16x8 cfr[8];
#pragma unroll
        for (int ks = 0; ks < 8; ++ks) cfr[ks] = *(const s16x8*)(cp + 16 * ks);
        const int lcol = 32 * lt + r;
        const LAS float* acsb = (const LAS float*)(ldsb + SSD_L_ACS) + 3 * hs * 128; const LAS float* dtsb = (const LAS float*)(ldsb + SSD_L_DTS) + 3 * hs * 128;
        const unsigned xb0 = lds_addr(ldsb + SSD_L_X + 3 * hs * SSD_XIMG) + (4 * h + q) * SSD_RS_X + (16 * blk + 4 * pp) * 2;
        unsigned ypk[3][16];
#pragma unroll
        for (int h3 = 0; h3 < 3; ++h3) {
            const LAS float* acs = acsb + h3 * 128; const LAS float* dts = dtsb + h3 * 128;
            const float myacs = acs[lcol];
            const float Dh = d_skip[6 * g + 3 * hs + h3];
            f32x16 y0, y1;
#pragma unroll
            for (int i = 0; i < 16; ++i) { y0[i] = 0.f; y1[i] = 0.f; }
            { const bf16* hp = Hin + ((size_t)bc * SSD_HEADS + 6 * g + 3 * hs + h3) * 8192 + lane * 8;
#pragma unroll
              for (int kh = 0; kh < 2; ++kh) {
                  s16x8 hf0[4], hf1[4];
#pragma unroll
                  for (int ks = 0; ks < 4; ++ks) { hf0[ks] = *(const s16x8*)(hp + (4 * kh + ks) * 512); hf1[ks] = *(const s16x8*)(hp + (8 + 4 * kh + ks) * 512); }
#pragma unroll
                  for (int ks = 0; ks < 4; ++ks) { y0 = __builtin_amdgcn_mfma_f32_32x32x16_bf16(cfr[4 * kh + ks], hf0[ks], y0, 0, 0, 0); y1 = __builtin_amdgcn_mfma_f32_32x32x16_bf16(cfr[4 * kh + ks], hf1[ks], y1, 0, 0, 0); }
                  __builtin_amdgcn_sched_barrier(0);
              } }
#pragma unroll
            for (int q4 = 0; q4 < 4; ++q4) {
                const f32x4v a4 = *(const LAS f32x4v*)(acs + 32 * lt + 8 * q4 + 4 * h);
                const float e0 = __expf(a4[0]), e1 = __expf(a4[1]), e2 = __expf(a4[2]), e3 = __expf(a4[3]);
                y0[4 * q4] *= e0; y0[4 * q4 + 1] *= e1; y0[4 * q4 + 2] *= e2; y0[4 * q4 + 3] *= e3;
                y1[4 * q4] *= e0; y1[4 * q4 + 1] *= e1; y1[4 * q4 + 2] *= e2; y1[4 * q4 + 3] *= e3;
            }
            __builtin_amdgcn_sched_barrier(0);
            for (int st = 0; st <= lt; ++st) {
                f32x16 cb;
#pragma unroll
                for (int i = 0; i < 16; ++i) cb[i] = 0.f;
#pragma unroll
                for (int ks = 0; ks < 8; ++ks) {
                    const s16x8 bfrag = *(const LAS s16x8*)(ldsb + SSD_L_BM + (32 * st + r) * SSD_RS_B + (16 * ks + 8 * h) * 2);
                    cb = __builtin_amdgcn_mfma_f32_32x32x16_bf16(bfrag, cfr[ks], cb, 0, 0, 0);
                }
                __builtin_amdgcn_sched_barrier(0);
                const unsigned xb = xb0 + h3 * SSD_XIMG + st * 32 * SSD_RS_X;
                s16x4 xv[8];
                tr_read8<0, 8 * SSD_RS_X, 64, 8 * SSD_RS_X + 64, 16 * SSD_RS_X, 24 * SSD_RS_X, 16 * SSD_RS_X + 64, 24 * SSD_RS_X + 64>(xb, xv);
#pragma unroll
                for (int kk = 0; kk < 2; ++kk) {
                    const int s0 = 32 * st + 16 * kk + 4 * h;
                    const f32x4v as0 = *(const LAS f32x4v*)(acs + s0), as1 = *(const LAS f32x4v*)(acs + s0 + 8);
                    const f32x4v ds0 = *(const LAS f32x4v*)(dts + s0), ds1 = *(const LAS f32x4v*)(dts + s0 + 8);
                    float wv[8];
#pragma unroll
                    for (int j = 0; j < 8; ++j) {
                        const int s = s0 + 8 * (j >> 2) + (j & 3);
                        const float asj = (j < 4) ? as0[j & 3] : as1[j & 3], dsj = (j < 4) ? ds0[j & 3] : ds1[j & 3];
                        float v = cb[8 * kk + j] * __expf(myacs - asj) * dsj;
                        v = (s <= lcol) ? v : 0.f;
                        v = (s == lcol) ? v + Dh : v;
                        wv[j] = v;
                    }
                    s16x8 afr;
                    { v4u o; o.x = pk2(wv[0], wv[1]); o.y = pk2(wv[2], wv[3]); o.z = pk2(wv[4], wv[5]); o.w = pk2(wv[6], wv[7]); afr = __builtin_bit_cast(s16x8, o); }
                    const s16x8 b0 = kk == 0 ? TRCAT(xv[0], xv[1]) : TRCAT(xv[4], xv[5]);
                    const s16x8 b1 = kk == 0 ? TRCAT(xv[2], xv[3]) : TRCAT(xv[6], xv[7]);
                    y0 = __builtin_amdgcn_mfma_f32_32x32x16_bf16(afr, b0, y0, 0, 0, 0);
                    y1 = __builtin_amdgcn_mfma_f32_32x32x16_bf16(afr, b1, y1, 0, 0, 0);
                    __builtin_amdgcn_sched_barrier(0);
                }
            }
#pragma unroll
            for (int i = 0; i < 8; ++i) { ypk[h3][i] = pk2(y0[2 * i], y0[2 * i + 1]); ypk[h3][8 + i] = pk2(y1[2 * i], y1[2 * i + 1]); }
            __builtin_amdgcn_sched_barrier(0);
        }
        __syncthreads();
        {
            LAS unsigned short* yst = (LAS unsigned short*)(ldsb + SSD_L_X);
#pragma unroll
            for (int h3 = 0; h3 < 3; ++h3)
#pragma unroll
                for (int ptile = 0; ptile < 2; ++ptile)
#pragma unroll
                    for (int i = 0; i < 8; ++i) {
                        const int reg = 2 * i;
                        const int l0 = 32 * lt + (reg & 3) + 8 * (reg >> 2) + 4 * h;
                        const int col = (3 * hs + h3) * 64 + 32 * ptile + r;
                        const unsigned v = ypk[h3][8 * ptile + i];
                        yst[l0 * (SSD_RS_Y / 2) + col] = (unsigned short)(v & 0xffffu);
                        yst[(l0 + 1) * (SSD_RS_Y / 2) + col] = (unsigned short)(v >> 16);
                    }
        }
        __syncthreads();
#pragma unroll
        for (int pass = 0; pass < 4; ++pass) {
            const int l = 4 * (pass * 8 + w) + (lane >> 4), i16 = lane & 15;
            float gv[3][8]; float ss = 0.f;
#pragma unroll
            for (int k = 0; k < 3; ++k) {
                const int col0 = 24 * i16 + 8 * k;
                float yv[8], zv[8];
                unpack8(*(const LAS v4u*)(ldsb + SSD_L_X + l * SSD_RS_Y + col0 * 2), yv);
                unpack8(*(const v4u*)(projb + (size_t)(t0 + l) * NB_LD + g * 384 + col0), zv);
#pragma unroll
                for (int j = 0; j < 8; ++j) { const float gg = yv[j] * silu_f(zv[j]); gv[k][j] = gg; ss += gg * gg; }
            }
            ss += __shfl_xor(ss, 1); ss += __shfl_xor(ss, 2); ss += __shfl_xor(ss, 4); ss += __shfl_xor(ss, 8);
            const float rstd = rsqrtf(ss * (1.0f / 384.0f) + LN_EPS);
#pragma unroll
            for (int k = 0; k < 3; ++k) {
                const int col0 = g * 384 + 24 * i16 + 8 * k;
                const float4 g0 = *(const float4*)(norm_g + col0), g1 = *(const float4*)(norm_g + col0 + 4);
                v4u o; o.x = pk2(gv[k][0] * rstd * g0.x, gv[k][1] * rstd * g0.y); o.y = pk2(gv[k][2] * rstd * g0.z, gv[k][3] * rstd * g0.w);
                o.z = pk2(gv[k][4] * rstd * g1.x, gv[k][5] * rstd * g1.y); o.w = pk2(gv[k][6] * rstd * g1.z, gv[k][7] * rstd * g1.w);
                *(v4u*)(A1 + (size_t)(t0 + l) * MIX_WIDTH + col0) = o;
            }
        }
    }
}

#define ATT_RS_V 144
#define ATT_VIMG (256 * ATT_RS_V)
#define ATT_HIMG (2 * ATT_VIMG)
#define ATT_PVT(KT) { \
        s16x4 vv_[8]; \
        tr_read8<(32 * KT) * ATT_RS_V, (32 * KT + 8) * ATT_RS_V, (32 * KT) * ATT_RS_V + 64, (32 * KT + 8) * ATT_RS_V + 64, \
                 (32 * KT + 16) * ATT_RS_V, (32 * KT + 24) * ATT_RS_V, (32 * KT + 16) * ATT_RS_V + 64, (32 * KT + 24) * ATT_RS_V + 64>(vbase, vv_); \
        _Pragma("unroll") for (int s2_ = 0; s2_ < 2; ++s2_) { \
            v4u o_; o_.x = pk2(s[KT][8 * s2_ + 0], s[KT][8 * s2_ + 1]); o_.y = pk2(s[KT][8 * s2_ + 2], s[KT][8 * s2_ + 3]); \
            o_.z = pk2(s[KT][8 * s2_ + 4], s[KT][8 * s2_ + 5]); o_.w = pk2(s[KT][8 * s2_ + 6], s[KT][8 * s2_ + 7]); \
            const s16x8 pf_ = __builtin_bit_cast(s16x8, o_); \
            const s16x8 a0_ = s2_ == 0 ? TRCAT(vv_[0], vv_[1]) : TRCAT(vv_[4], vv_[5]); \
            const s16x8 a1_ = s2_ == 0 ? TRCAT(vv_[2], vv_[3]) : TRCAT(vv_[6], vv_[7]); \
            o0 = __builtin_amdgcn_mfma_f32_32x32x16_bf16(a0_, pf_, o0, 0, 0, 0); \
            o1 = __builtin_amdgcn_mfma_f32_32x32x16_bf16(a1_, pf_, o1, 0, 0, 0); } }
__device__ __forceinline__ void ph_attn_prompt(LAS unsigned char* ldsb, const bf16* __restrict__ qrot_b, const bf16* __restrict__ krot_b, const bf16* __restrict__ projb,
                                               bf16* __restrict__ obuf, float* __restrict__ lsebuf, const float* __restrict__ ck, const float* __restrict__ cv, float* __restrict__ out) {
    const int tid = threadIdx.x, w = __builtin_amdgcn_readfirstlane(tid >> 6), lane = tid & 63;
    const int r = lane & 31, h = lane >> 5, blk = (lane >> 4) & 1, q = (lane & 15) >> 2, pp = lane & 3;
    const int qt = w & 3, hsel = w >> 2;
    f32x4n rider[16]; bool pend = false; unsigned pq = 0u;
    for (int unit = blockIdx.x; unit < 3 * 512; unit += gridDim.x) {
        const int pat = unit >> 9, rem = unit & 511, hp = rem & 3, rem2 = rem >> 2, b = rem2 >> 6, bk = rem2 & 63;
        const int dsh = 2 * pat, nper = 64 >> dsh, res = bk >> (6 - dsh), nb = bk & (nper - 1);
        const int head = 2 * hp + hsel;
        __syncthreads();
        { v4u vst[8], kst[8];
#pragma unroll
          for (int it_ = 0; it_ < 8; ++it_) { const int idx = (tid & 255) + it_ * 256;
              const int row = idx >> 3, ch = idx & 7, js = 128 * nb - 128 + row, jc = js < 0 ? 0 : js;
              const size_t tk = (size_t)(b * SEQ + (jc << dsh) + res);
              vst[it_] = *(const v4u*)(projb + tk * NB_LD + NB_V + head * 64 + ch * 8);
              kst[it_] = *(const v4u*)(krot_b + tk * ATT_WIDTH + head * 64 + ch * 8); }
#pragma unroll
          for (int it_ = 0; it_ < 8; ++it_) { const int idx = (tid & 255) + it_ * 256;
              const int row = idx >> 3, ch = idx & 7, js = 128 * nb - 128 + row;
              v4u v = vst[it_], k = kst[it_]; if (js < 0) { v.x = 0u; v.y = 0u; v.z = 0u; v.w = 0u; k = v; }
              *(LAS v4u*)(ldsb + hsel * ATT_HIMG + row * ATT_RS_V + ch * 16) = v;
              *(LAS v4u*)(ldsb + hsel * ATT_HIMG + ATT_VIMG + row * ATT_RS_V + ch * 16) = k; } }
        const int tq = b * SEQ + ((128 * nb + 32 * qt + r) << dsh) + res;
        s16x8 qf[4];
#pragma unroll
        for (int ks = 0; ks < 4; ++ks) qf[ks] = *(const s16x8*)(qrot_b + (size_t)tq * ATT_WIDTH + head * 64 + 16 * ks + 8 * h);
        __syncthreads();
        f32x16 s[5];
#pragma unroll
        for (int kt = 0; kt < 5; ++kt) {
            const LAS unsigned char* kp = ldsb + hsel * ATT_HIMG + ATT_VIMG + (32 * qt + 32 * kt + r) * ATT_RS_V + 16 * h;
#pragma unroll
            for (int i = 0; i < 16; ++i) s[kt][i] = 0.f;
#pragma unroll
            for (int ks = 0; ks < 4; ++ks) s[kt] = __builtin_amdgcn_mfma_f32_32x32x16_bf16(*(const LAS s16x8*)(kp + 32 * ks), qf[ks], s[kt], 0, 0, 0);
        }
        if (pend) copy_q_store(out, pq, (unsigned)lane, rider);
        float m = -INFINITY;
#pragma unroll
        for (int kt = 0; kt < 5; ++kt) {
            const bool tile_ok = (nb > 0) || (qt + kt >= 4);
#pragma unroll
            for (int reg = 0; reg < 16; ++reg) {
                const int c = (reg & 3) + 8 * (reg >> 2) + 4 * h;
                const bool ok = tile_ok && (kt == 0 ? (c >= r) : (kt == 4 ? (c <= r) : true));
                const float v = ok ? s[kt][reg] * 0.125f : -INFINITY;
                s[kt][reg] = v; m = fmaxf(m, v);
            }
        }
        m = fmaxf(m, __shfl_xor(m, 32));
        float l = 0.f;
#pragma unroll
        for (int kt = 0; kt < 5; ++kt)
#pragma unroll
            for (int reg = 0; reg < 16; ++reg) { const float p = __expf(s[kt][reg] - m); s[kt][reg] = p; l += p; }
        l += __shfl_xor(l, 32);
        pq = (unsigned)(unit * NWAVE + w); copy_q_load(ck, cv, pq, (unsigned)lane, rider); pend = true;
        f32x16 o0, o1;
#pragma unroll
        for (int i = 0; i < 16; ++i) { o0[i] = 0.f; o1[i] = 0.f; }
        const unsigned vbase = lds_addr(ldsb + hsel * ATT_HIMG) + (32 * qt + 4 * h + q) * ATT_RS_V + (16 * blk + 4 * pp) * 2;
        ATT_PVT(0) ATT_PVT(1) ATT_PVT(2) ATT_PVT(3) ATT_PVT(4)
        const float inv = 1.0f / l;
        bf16* op = obuf + ((size_t)pat * T_PROMPT + tq) * ATT_WIDTH + head * 64 + 4 * h;
#pragma unroll
        for (int q4 = 0; q4 < 4; ++q4) {
            *(uint2*)(op + 8 * q4) = make_uint2(pk2(o0[4 * q4] * inv, o0[4 * q4 + 1] * inv), pk2(o0[4 * q4 + 2] * inv, o0[4 * q4 + 3] * inv));
            *(uint2*)(op + 32 + 8 * q4) = make_uint2(pk2(o1[4 * q4] * inv, o1[4 * q4 + 1] * inv), pk2(o1[4 * q4 + 2] * inv, o1[4 * q4 + 3] * inv));
        }
        if (h == 0) lsebuf[((size_t)pat * T_PROMPT + tq) * 8 + head] = m + __logf(l);
    }
    if (pend) copy_q_store(out, pq, (unsigned)lane, rider);
}
__device__ __forceinline__ void ph_attn_combine(const bf16* __restrict__ obuf, const float* __restrict__ lsebuf, bf16* __restrict__ A1) {
    const int lane = threadIdx.x & 63;
#pragma unroll 4
    for (int t = blockIdx.x * NWAVE + (threadIdx.x >> 6); t < T_PROMPT; t += gridDim.x * NWAVE) {
        const int hd = lane >> 3;
        const float l0 = lsebuf[((size_t)0 * T_PROMPT + t) * 8 + hd], l1 = lsebuf[((size_t)1 * T_PROMPT + t) * 8 + hd], l2 = lsebuf[((size_t)2 * T_PROMPT + t) * 8 + hd];
        const float mx = fmaxf(l0, fmaxf(l1, l2));
        const float e0 = __expf(l0 - mx), e1 = __expf(l1 - mx), e2 = __expf(l2 - mx);
        const float inv = 1.0f / (e0 + e1 + e2);
        float a[8], b[8], c[8];
        unpack8(*(const v4u*)(obuf + ((size_t)0 * T_PROMPT + t) * ATT_WIDTH + lane * 8), a);
        unpack8(*(const v4u*)(obuf + ((size_t)1 * T_PROMPT + t) * ATT_WIDTH + lane * 8), b);
        unpack8(*(const v4u*)(obuf + ((size_t)2 * T_PROMPT + t) * ATT_WIDTH + lane * 8), c);
        float o[8];
#pragma unroll
        for (int j = 0; j < 8; ++j) o[j] = (e0 * a[j] + e1 * b[j] + e2 * c[j]) * inv;
        v4u w; w.x = pk2(o[0], o[1]); w.y = pk2(o[2], o[3]); w.z = pk2(o[4], o[5]); w.w = pk2(o[6], o[7]);
        *(v4u*)(A1 + (size_t)t * MIX_WIDTH + SSD_WIDTH + lane * 8) = w;
    }
}

#define RT_RS 272
#define RT_KIMG (128 * RT_RS)
#define RT_LUT (2 * RT_KIMG)
constexpr unsigned char RT_CANDS[64] = {0, 1, 2, 3, 4, 5, 6, 7, 8, 9, 10, 11, 12, 13, 14, 15, 16, 17, 18, 19, 20, 21, 22, 23, 32, 33, 34, 35, 36, 48, 49, 50, 51, 64, 65, 66, 80, 81, 96, 97,
                                        112, 113, 128, 144, 160, 176, 192, 208, 224, 240, 0, 0, 0, 0, 0, 0, 0, 0, 0, 0, 0, 0, 0, 0};
__device__ __forceinline__ unsigned rt_mono(float f) { const unsigned u = __builtin_bit_cast(unsigned, f); return u ^ ((unsigned)((int)u >> 31) | 0x80000000u); }
__device__ __forceinline__ float rt_unmono(unsigned m) { const unsigned u = (m & 0x80000000u) ? (m ^ 0x80000000u) : ~m; return __builtin_bit_cast(float, u); }
#define RT_CE_DESC(a, b) { const unsigned x_ = (a), y_ = (b); (a) = x_ > y_ ? x_ : y_; (b) = x_ > y_ ? y_ : x_; }
#define RT_CE_ASC(a, b) { const unsigned x_ = (a), y_ = (b); (a) = x_ > y_ ? y_ : x_; (b) = x_ > y_ ? x_ : y_; }
__device__ __forceinline__ void rt_sort16(unsigned (&v)[16]) {
#pragma unroll
    for (int k = 2; k <= 16; k <<= 1)
#pragma unroll
        for (int j = k >> 1; j > 0; j >>= 1)
#pragma unroll
            for (int i = 0; i < 16; ++i) { const int l = i ^ j; if (l > i) { if ((i & k) == 0) RT_CE_DESC(v[i], v[l]) else RT_CE_ASC(v[i], v[l]) } }
}
__device__ __forceinline__ void rt_merge16(unsigned (&v)[16]) {
#pragma unroll
    for (int j = 8; j > 0; j >>= 1)
#pragma unroll
        for (int i = 0; i < 16; ++i) { const int l = i ^ j; if (l > i) RT_CE_DESC(v[i], v[l]) }
}
__device__ __forceinline__ void rt_top16(unsigned (&a)[16], const unsigned (&b)[16]) {
#pragma unroll
    for (int i = 0; i < 16; ++i) a[i] = a[i] > b[15 - i] ? a[i] : b[15 - i];
    rt_merge16(a);
}
__device__ __forceinline__ void rt_top16_partner(unsigned (&a)[16]) {
    unsigned b[16];
#pragma unroll
    for (int i = 0; i < 16; ++i) b[i] = (unsigned)__shfl_xor((int)a[i], 32);
    rt_top16(a, b);
}
__device__ __forceinline__ void rt_scores_top16(LAS unsigned char* kimg, const bf16* __restrict__ qp, int r, int h, unsigned (&k0)[16]) {
    f32x16 acc[4];
#pragma unroll
    for (int kt = 0; kt < 4; ++kt)
#pragma unroll
        for (int i = 0; i < 16; ++i) acc[kt][i] = 0.f;
#pragma unroll
    for (int ks = 0; ks < 8; ++ks) {
        const s16x8 qf = *(const s16x8*)(qp + 16 * ks);
#pragma unroll
        for (int kt = 0; kt < 4; ++kt) {
            const s16x8 kf = *(const LAS s16x8*)(kimg + (32 * kt + r) * RT_RS + (16 * ks + 8 * h) * 2);
            acc[kt] = __builtin_amdgcn_mfma_f32_32x32x16_bf16(kf, qf, acc[kt], 0, 0, 0);
        }
    }
    unsigned k1[16], k2[16], k3[16];
#pragma unroll
    for (int reg = 0; reg < 16; ++reg) {
        const unsigned ki = (unsigned)((reg & 3) + 8 * (reg >> 2) + 4 * h);
        k0[reg] = (rt_mono(acc[0][reg]) & 0xFFFFFF80u) | ki;
        k1[reg] = (rt_mono(acc[1][reg]) & 0xFFFFFF80u) | (ki + 32u);
        k2[reg] = (rt_mono(acc[2][reg]) & 0xFFFFFF80u) | (ki + 64u);
        k3[reg] = (rt_mono(acc[3][reg]) & 0xFFFFFF80u) | (ki + 96u);
    }
    rt_sort16(k0); rt_sort16(k1); rt_sort16(k2); rt_sort16(k3);
    rt_top16(k0, k1); rt_top16(k2, k3); rt_top16(k0, k2);
    rt_top16_partner(k0);
}
__device__ __forceinline__ void ph_peer_route2(LAS unsigned char* ldsb, const bf16* __restrict__ qhb, const float* __restrict__ keys1, const float* __restrict__ keys2,
                                               int* __restrict__ eidx, float* __restrict__ gate, const float* __restrict__ ck, const float* __restrict__ cv, float* __restrict__ out) {
    const int tid = threadIdx.x, w = __builtin_amdgcn_readfirstlane(tid >> 6), lane = tid & 63, r = lane & 31, h = lane >> 5;
    __syncthreads();
    for (int idx = tid; idx < 2 * 128 * 16; idx += NTHR) {
        const int tb = idx >> 11, rem = idx & 2047, row = rem >> 4, ch = rem & 15;
        const float* sp = (tb ? keys2 : keys1) + row * 128 + ch * 8;
        const float4 a = *(const float4*)sp, b = *(const float4*)(sp + 4);
        v4u o; o.x = pk2(a.x, a.y); o.y = pk2(a.z, a.w); o.z = pk2(b.x, b.y); o.w = pk2(b.z, b.w);
        *(LAS v4u*)(ldsb + tb * RT_KIMG + row * RT_RS + ch * 16) = o;
    }
    __syncthreads();
    LAS unsigned* lut = (LAS unsigned*)(ldsb + RT_LUT) + w * 512;
    for (int unit = blockIdx.x * NWAVE + w; unit < (T_ALL / 32) * 8; unit += gridDim.x * NWAVE) {
        const int tt = unit >> 3, hd = unit & 7;
        const int tok = 32 * tt + r;
        const bf16* qp = qhb + (size_t)tok * 2048 + hd * 256 + 8 * h;
        unsigned ka[16], kb[16];
        rt_scores_top16(ldsb, qp, r, h, ka);
        rt_scores_top16(ldsb + RT_KIMG, qp + 128, r, h, kb);
        float v1[16], v2[16];
#pragma unroll
        for (int i = 0; i < 16; ++i) { v1[i] = rt_unmono(ka[i] & 0xFFFFFF80u); v2[i] = rt_unmono(kb[i] & 0xFFFFFF80u); }
#pragma unroll
        for (int wd = 0; wd < 4; ++wd) {
            lut[wd * 64 + lane] = (ka[4 * wd] & 0x7Fu) | ((ka[4 * wd + 1] & 0x7Fu) << 8) | ((ka[4 * wd + 2] & 0x7Fu) << 16) | ((ka[4 * wd + 3] & 0x7Fu) << 24);
            lut[(4 + wd) * 64 + lane] = (kb[4 * wd] & 0x7Fu) | ((kb[4 * wd + 1] & 0x7Fu) << 8) | ((kb[4 * wd + 2] & 0x7Fu) << 16) | ((kb[4 * wd + 3] & 0x7Fu) << 24);
        }
        unsigned c0[16], c1[16];
        c0[0] = (rt_mono(h ? (v1[0] + v2[1]) : (v1[0] + v2[0])) & 0xFFFFFF00u) | (h ? 1u : 0u);
        c0[1] = (rt_mono(h ? (v1[0] + v2[3]) : (v1[0] + v2[2])) & 0xFFFFFF00u) | (h ? 3u : 2u);
        c0[2] = (rt_mono(h ? (v1[0] + v2[5]) : (v1[0] + v2[4])) & 0xFFFFFF00u) | (h ? 5u : 4u);
        c0[3] = (rt_mono(h ? (v1[0] + v2[7]) : (v1[0] + v2[6])) & 0xFFFFFF00u) | (h ? 7u : 6u);
        c0[4] = (rt_mono(h ? (v1[0] + v2[9]) : (v1[0] + v2[8])) & 0xFFFFFF00u) | (h ? 9u : 8u);
        c0[5] = (rt_mono(h ? (v1[0] + v2[11]) : (v1[0] + v2[10])) & 0xFFFFFF00u) | (h ? 11u : 10u);
        c0[6] = (rt_mono(h ? (v1[0] + v2[13]) : (v1[0] + v2[12])) & 0xFFFFFF00u) | (h ? 13u : 12u);
        c0[7] = (rt_mono(h ? (v1[0] + v2[15]) : (v1[0] + v2[14])) & 0xFFFFFF00u) | (h ? 15u : 14u);
        c0[8] = (rt_mono(h ? (v1[1] + v2[1]) : (v1[1] + v2[0])) & 0xFFFFFF00u) | (h ? 17u : 16u);
        c0[9] = (rt_mono(h ? (v1[1] + v2[3]) : (v1[1] + v2[2])) & 0xFFFFFF00u) | (h ? 19u : 18u);
        c0[10] = (rt_mono(h ? (v1[1] + v2[5]) : (v1[1] + v2[4])) & 0xFFFFFF00u) | (h ? 21u : 20u);
        c0[11] = (rt_mono(h ? (v1[1] + v2[7]) : (v1[1] + v2[6])) & 0xFFFFFF00u) | (h ? 23u : 22u);
        c0[12] = (rt_mono(h ? (v1[2] + v2[1]) : (v1[2] + v2[0])) & 0xFFFFFF00u) | (h ? 33u : 32u);
        c0[13] = (rt_mono(h ? (v1[2] + v2[3]) : (v1[2] + v2[2])) & 0xFFFFFF00u) | (h ? 35u : 34u);
        c0[14] = (rt_mono(h ? (v1[3] + v2[0]) : (v1[2] + v2[4])) & 0xFFFFFF00u) | (h ? 48u : 36u);
        c0[15] = (rt_mono(h ? (v1[3] + v2[2]) : (v1[3] + v2[1])) & 0xFFFFFF00u) | (h ? 50u : 49u);
        c1[0] = (rt_mono(h ? (v1[4] + v2[0]) : (v1[3] + v2[3])) & 0xFFFFFF00u) | (h ? 64u : 51u);
        c1[1] = (rt_mono(h ? (v1[4] + v2[2]) : (v1[4] + v2[1])) & 0xFFFFFF00u) | (h ? 66u : 65u);
        c1[2] = (rt_mono(h ? (v1[5] + v2[1]) : (v1[5] + v2[0])) & 0xFFFFFF00u) | (h ? 81u : 80u);
        c1[3] = (rt_mono(h ? (v1[6] + v2[1]) : (v1[6] + v2[0])) & 0xFFFFFF00u) | (h ? 97u : 96u);
        c1[4] = (rt_mono(h ? (v1[7] + v2[1]) : (v1[7] + v2[0])) & 0xFFFFFF00u) | (h ? 113u : 112u);
        c1[5] = (rt_mono(h ? (v1[9] + v2[0]) : (v1[8] + v2[0])) & 0xFFFFFF00u) | (h ? 144u : 128u);
        c1[6] = (rt_mono(h ? (v1[11] + v2[0]) : (v1[10] + v2[0])) & 0xFFFFFF00u) | (h ? 176u : 160u);
        c1[7] = (rt_mono(h ? (v1[13] + v2[0]) : (v1[12] + v2[0])) & 0xFFFFFF00u) | (h ? 208u : 192u);
        c1[8] = (rt_mono(h ? (v1[15] + v2[0]) : (v1[14] + v2[0])) & 0xFFFFFF00u) | (h ? 240u : 224u);
        c1[9] = 0u;
        c1[10] = 0u;
        c1[11] = 0u;
        c1[12] = 0u;
        c1[13] = 0u;
        c1[14] = 0u;
        c1[15] = 0u;
        rt_sort16(c0); rt_sort16(c1); rt_top16(c0, c1); rt_top16_partner(c0);
        float e[16]; float sum = 0.f;
        const float mx = rt_unmono(c0[0] & 0xFFFFFF00u);
#pragma unroll
        for (int k = 0; k < 16; ++k) { e[k] = __expf(rt_unmono(c0[k] & 0xFFFFFF00u) - mx); sum += e[k]; }
        const float inv = 1.0f / sum;
        asm volatile("s_waitcnt lgkmcnt(0)" ::: "memory");
        int ex[8]; float gv[8];
#pragma unroll
        for (int k = 0; k < 8; ++k) {
            const unsigned hm = (unsigned)(-h);
            const unsigned ck = (c0[k] & ~hm) | (c0[8 + k] & hm);
            const float ek = __builtin_bit_cast(float, (__builtin_bit_cast(unsigned, e[k]) & ~hm) | (__builtin_bit_cast(unsigned, e[8 + k]) & hm));
            const unsigned ci = (ck >> 4) & 15u, cj = ck & 15u;
            const unsigned w1 = lut[(ci >> 2) * 64 + lane], w2 = lut[(4 + (cj >> 2)) * 64 + lane];
            const unsigned i1 = (w1 >> (8 * (ci & 3))) & 0x7Fu, i2 = (w2 >> (8 * (cj & 3))) & 0x7Fu;
            ex[k] = (int)(i1 * PEER_NKEYS + i2); gv[k] = ek * inv;
        }
        int* ep = eidx + (size_t)tok * 128 + hd * 16 + 8 * h; float* gp = gate + (size_t)tok * 128 + hd * 16 + 8 * h;
        *(int4*)ep = make_int4(ex[0], ex[1], ex[2], ex[3]); *(int4*)(ep + 4) = make_int4(ex[4], ex[5], ex[6], ex[7]);
        *(float4*)gp = make_float4(gv[0], gv[1], gv[2], gv[3]); *(float4*)(gp + 4) = make_float4(gv[4], gv[5], gv[6], gv[7]);
    }
    { const unsigned gwv = blockIdx.x * NWAVE + w; if (gridDim.x == 256 && gwv >= 128u) cache_copy_slice(ck, cv, out, 7040u + (gwv - 128u), (unsigned)lane); }
}

struct Params {
    const float* in[23];
    float* out;
    unsigned char* ws;
    unsigned* bar;
};

#define WS_BAR      0ull
#define WS_XALL     (1ull << 20)
#define WS_PROJ     (WS_XALL + (size_t)T_ALL * D_MODEL * 4)
#define WS_XBC      (WS_PROJ + (size_t)T_ALL * PROJ_LD * 4)
#define WS_DT       (WS_XBC + (size_t)T_ALL * CONV_DIM * 4)
#define WS_QROT     (WS_DT + (size_t)T_ALL * SSD_HEADS * 4)
#define WS_KROT     (WS_QROT + (size_t)T_ALL * ATT_WIDTH * 4)
#define WS_YBUF     (WS_KROT + (size_t)T_ALL * ATT_WIDTH * 4)
#define WS_MIX      (WS_YBUF + (size_t)T_ALL * MIX_WIDTH * 4)
#define WS_HBUF     (WS_MIX + (size_t)T_ALL * D_MODEL * 4)
#define WS_QH       (WS_HBUF + (size_t)T_ALL * D_MODEL * 4)
#define WS_EIDX     (WS_QH + (size_t)T_ALL * 2048 * 4)
#define WS_GATE     (WS_EIDX + (size_t)T_ALL * 128 * 4)
#define WS_A0       (WS_GATE + (size_t)T_ALL * 128 * 4)
#define WS_A1       (WS_A0 + (size_t)T_ALL * D_MODEL * 2)
#define WS_A2       (WS_A1 + (size_t)T_ALL * MIX_WIDTH * 2)
#define WS_WTIN     (WS_A2 + (size_t)T_ALL * D_MODEL * 2)
#define WS_WTOUT    (WS_WTIN + (size_t)PROJ_LD * D_MODEL * 2)
#define WS_WTQ      (WS_WTOUT + (size_t)D_MODEL * MIX_WIDTH * 2)
#define WS_PROJB    (WS_WTQ + (size_t)2048 * D_MODEL * 2)
#define WS_DTRAW    (WS_PROJB + (size_t)T_ALL * NB_LD * 2)
#define WS_XBCB     (WS_DTRAW + (size_t)T_ALL * 32 * 4)
#define WS_QROTB    (WS_XBCB + (size_t)T_ALL * CONV_DIM * 2)
#define WS_KROTB    (WS_QROTB + (size_t)T_ALL * ATT_WIDTH * 2)
#define WS_UB       (WS_KROTB + (size_t)T_ALL * ATT_WIDTH * 2)
#define WS_VB       (WS_UB + (size_t)16384 * D_MODEL * 2)
#define WS_USC      (WS_VB + (size_t)16384 * D_MODEL * 2)
#define WS_VSC      (WS_USC + 16384 * 4)
#define WS_SBUF     (WS_VSC + 16384 * 4)
#define WS_HIN      (WS_SBUF + (size_t)BATCH * 64 * SSD_HEADS * 64 * 128 * 2)
#define WS_CDEC     (WS_HIN + (size_t)BATCH * 64 * SSD_HEADS * 64 * 128 * 2)
#define WS_OBUF     (WS_CDEC + (size_t)BATCH * 64 * SSD_HEADS * 4)
#define WS_LSE      (WS_OBUF + (size_t)3 * T_PROMPT * ATT_WIDTH * 2)
#define WS_ROPE     (WS_LSE + (size_t)3 * T_PROMPT * 8 * 4)
#define WS_END      (WS_ROPE + (size_t)SEQ * 64 * 4)

#define LDS_BYTES (160 * 1024)

#define KP const __attribute__((address_space(4))) Params* kp = (const __attribute__((address_space(4))) Params*)__builtin_amdgcn_kernarg_segment_ptr(); asm volatile("" : "+s"(kp)); unsigned char* ws = kp->ws; (void)ws;
#define IN(i) (kp->in[i])
#define WSP(T, off) ((T*)(ws + (off)))
__global__ void __launch_bounds__(512, 2) mega_fwd(Params p) {
    extern __shared__ __attribute__((aligned(16))) unsigned char smem[];
    if (threadIdx.x == 0) *(uint4*)smem = make_uint4(0u, 0u, 0u, 0u);
    __syncthreads();
    XcdBarrier bar = xcd_barrier_post(p.bar, (volatile LAS unsigned*)smem);
    float* lds = (float*)(smem + 256);
    LAS unsigned char* ldsb = (LAS unsigned char*)smem + 256;

    { KP ph_prologue(ldsb, IN(0), IN(1), WSP(bf16, WS_A0), IN(6), WSP(bf16, WS_WTIN), WSP(float, WS_ROPE)); }
    xcd_barrier(bar);
    { KP pg8::Gemm g{WSP(bf16, WS_A0), WSP(bf16, WS_WTIN), T_ALL, PROJ_LD, D_MODEL}; pg8::StaticOrder S; S.init(g.M, g.N, (int)gridDim.x, (int)blockIdx.x);
      pg8::EpiProj E{WSP(bf16, WS_PROJB), WSP(float, WS_DTRAW)}; pg8::gemm_phase<pg8::EpiProj, pg8::StaticOrder, false>(ldsb, g, S, E, nullptr); }
    xcd_barrier(bar);
    { KP ph_post_proj_prompt(WSP(bf16, WS_PROJB), WSP(float, WS_DTRAW), IN(7), IN(8), IN(9), WSP(float, WS_ROPE), WSP(bf16, WS_XBCB), WSP(float, WS_DT), WSP(bf16, WS_QROTB), WSP(bf16, WS_KROTB), kp->out); }
    { KP ph_post_proj2(WSP(bf16, WS_PROJB), WSP(float, WS_DTRAW), IN(4), IN(7), IN(8), IN(9), WSP(bf16, WS_XBCB), WSP(float, WS_DT), WSP(bf16, WS_QROTB), WSP(bf16, WS_KROTB), kp->out); }
    xcd_barrier(bar);
    { KP ph_ssd_states(ldsb, WSP(bf16, WS_XBCB), WSP(float, WS_DT), IN(10), WSP(bf16, WS_SBUF), WSP(float, WS_CDEC), IN(2), IN(3), kp->out); }
    __syncthreads();
    { KP ph_attn_prompt(ldsb, WSP(bf16, WS_QROTB), WSP(bf16, WS_KROTB), WSP(bf16, WS_PROJB), WSP(bf16, WS_OBUF), WSP(float, WS_LSE), IN(2), IN(3), kp->out); }
    __syncthreads();
    { KP ph_ssd_decode(WSP(bf16, WS_XBCB), WSP(float, WS_DT), IN(10), IN(11), IN(5), WSP(float, WS_YBUF), kp->out); }
    { KP ph_attn_sample3(lds, WSP(bf16, WS_QROTB), WSP(bf16, WS_KROTB), WSP(bf16, WS_PROJB), IN(2), IN(3), WSP(bf16, WS_A1)); }
    xcd_barrier(bar);
    if ((int)gridDim.x > 128) {
        if ((int)blockIdx.x < 96) { KP ph_ssd_scan(WSP(bf16, WS_SBUF), WSP(float, WS_CDEC), WSP(bf16, WS_HIN), kp->out, (int)blockIdx.x, 96); }
        else {
            { KP ph_prologue2(ldsb, IN(13), WSP(bf16, WS_WTOUT), IN(16), WSP(bf16, WS_WTQ), (int)blockIdx.x - 96, (int)gridDim.x - 96); }
            { KP ph_quant_tables(IN(19), IN(20), WSP(unsigned char, WS_UB), WSP(unsigned char, WS_VB), WSP(float, WS_USC), WSP(float, WS_VSC), (int)blockIdx.x - 96, (int)gridDim.x - 96); }
        }
    } else {
        { KP ph_ssd_scan(WSP(bf16, WS_SBUF), WSP(float, WS_CDEC), WSP(bf16, WS_HIN), kp->out, (int)blockIdx.x, (int)gridDim.x); }
        { KP ph_prologue2(ldsb, IN(13), WSP(bf16, WS_WTOUT), IN(16), WSP(bf16, WS_WTQ), (int)blockIdx.x, (int)gridDim.x); }
        { KP ph_quant_tables(IN(19), IN(20), WSP(unsigned char, WS_UB), WSP(unsigned char, WS_VB), WSP(float, WS_USC), WSP(float, WS_VSC), (int)blockIdx.x, (int)gridDim.x); }
    }
    xcd_barrier(bar);
    { KP ph_ssd_out(ldsb, WSP(bf16, WS_XBCB), WSP(bf16, WS_PROJB), WSP(float, WS_DT), IN(10), IN(11), IN(12), WSP(bf16, WS_HIN), WSP(bf16, WS_A1)); }
    { KP ph_attn_combine(WSP(bf16, WS_OBUF), WSP(float, WS_LSE), WSP(bf16, WS_A1)); }
    { KP ph_gate_norm(WSP(bf16, WS_PROJB), IN(12), WSP(float, WS_YBUF), WSP(bf16, WS_A1)); }
    xcd_barrier(bar);
    { KP pg8::Gemm g{WSP(bf16, WS_A1), WSP(bf16, WS_WTOUT), T_ALL, D_MODEL, MIX_WIDTH}; pg8::StaticOrder S; S.init(g.M, g.N, (int)gridDim.x, (int)blockIdx.x);
      pg8::EpiBf16Plain E{WSP(bf16, WS_MIX), D_MODEL}; pg8::gemm_phase<pg8::EpiBf16Plain, pg8::StaticOrder, false>(ldsb, g, S, E, nullptr); }
    if (blockIdx.x >= 8 && gridDim.x == 256) { KP cache_copy_slice(IN(2), IN(3), kp->out, 4096u + (blockIdx.x - 8) * 8u + (threadIdx.x >> 6), threadIdx.x & 63u); }
    xcd_barrier(bar);
    { KP ph_ln_res(IN(0), IN(1), WSP(bf16, WS_MIX), IN(14), IN(15), WSP(bf16, WS_A2)); }
    xcd_barrier(bar);
    { KP pg8::Gemm g{WSP(bf16, WS_A2), WSP(bf16, WS_WTQ), T_ALL, 2048, D_MODEL}; pg8::StaticOrder S; S.init(g.M, g.N, (int)gridDim.x, (int)blockIdx.x);
      pg8::EpiBf16Plain E{WSP(bf16, WS_QH), 2048}; pg8::gemm_phase<pg8::EpiBf16Plain, pg8::StaticOrder, false>(ldsb, g, S, E, nullptr); }
    if (blockIdx.x >= 16 && gridDim.x == 256 && threadIdx.x < 256) { KP cache_copy_slice(IN(2), IN(3), kp->out, 4096u + 1984u + (blockIdx.x - 16) * 4u + (threadIdx.x >> 6), threadIdx.x & 63u); }
    xcd_barrier(bar);
    { KP ph_peer_route2(ldsb, WSP(bf16, WS_QH), IN(17), IN(18), WSP(int, WS_EIDX), WSP(float, WS_GATE), IN(2), IN(3), kp->out); }
    xcd_barrier(bar);
    { KP ph_peer_ffn3(WSP(bf16, WS_A2), WSP(int, WS_EIDX), WSP(float, WS_GATE), WSP(unsigned char, WS_UB), WSP(unsigned char, WS_VB), WSP(float, WS_USC), WSP(float, WS_VSC), IN(21), IN(22), kp->out, IN(2), IN(3), gridDim.x == 256 ? 8960u : 4096u); }
}

extern "C" void kernel_launch(void* const* d_in, const int* in_sizes, int n_in, void* d_out, int out_size, void* d_ws, size_t ws_size, hipStream_t stream) {
    static int grid = 0;
    if (grid == 0) {
        int dev = 0, cus = 0, per_cu = 0;
        if (hipGetDevice(&dev) != hipSuccess || hipDeviceGetAttribute(&cus, hipDeviceAttributeMultiprocessorCount, dev) != hipSuccess) { fprintf(stderr, "kernel_launch: device query failed\n"); grid = -1; return; }
        if (hipFuncSetAttribute((const void*)mega_fwd, hipFuncAttributeMaxDynamicSharedMemorySize, LDS_BYTES) != hipSuccess) { fprintf(stderr, "kernel_launch: hipFuncSetAttribute failed\n"); grid = -1; return; }
        if (hipOccupancyMaxActiveBlocksPerMultiprocessor(&per_cu, (const void*)mega_fwd, NTHR, LDS_BYTES) != hipSuccess || per_cu < 1) { fprintf(stderr, "kernel_launch: occupancy query says %d\n", per_cu); }
        (void)hipGetLastError();
        grid = cus;
        if (ws_size < WS_END) { fprintf(stderr, "kernel_launch: workspace too small\n"); grid = -1; return; }
    }
    if (grid < 0) return;
    (void)hipMemsetAsync((char*)d_ws + WS_BAR, 0, XCD_BAR_WORDS * sizeof(unsigned), stream);
    Params p{};
    for (int i = 0; i < 23; ++i) p.in[i] = (const float*)d_in[i];
    p.out = (float*)d_out; p.ws = (unsigned char*)d_ws; p.bar = (unsigned*)((char*)d_ws + WS_BAR);
    hipLaunchKernelGGL(mega_fwd, dim3(grid), dim3(NTHR), LDS_BYTES, stream, p);
}
```

```cpp
#include <hip/hip_runtime.h>
#include <stdint.h>

#define D_MODEL 1024
#define BATCH 2
#define SEQ 8192
#define DEC_BATCH 128
#define DEC_SEQ 4
#define PAST_LEN 8192
#define HEAD_DIM 64
#define ATT_WIDTH 512
#define ATT_HEADS 8
#define SSD_WIDTH 1536
#define SSD_HEADS 24
#define SSD_GROUPS 4
#define SSD_STATE 128
#define CONV_DIM 2560
#define IN_WIDTH 5656
#define PROJ_LD 5888
#define MIX_WIDTH 2048
#define WBUF 2048
#define PEER_NKEYS 128
#define PEER_HEADS 8
#define PEER_TOPK 16
#define PEER_DKEY 256
#define T_PROMPT (BATCH * SEQ)
#define T_SAMPLE (DEC_BATCH * DEC_SEQ)
#define T_ALL (T_PROMPT + T_SAMPLE)
#define O_Z 0
#define O_XBC 1536
#define O_DT 4096
#define O_Q 4120
#define O_K 4632
#define O_V 5144
#define ALPHA_F 1.189207115002721f
#define LN_EPS 1e-5f

#define OUT_YP 0ull
#define OUT_YS (OUT_YP + 16777216ull)
#define OUT_PK (OUT_YS + 524288ull)
#define OUT_PV (OUT_PK + 2097152ull)
#define OUT_PC (OUT_PV + 2097152ull)
#define OUT_PS (OUT_PC + 15360ull)
#define OUT_SK (OUT_PS + 393216ull)
#define OUT_SV (OUT_SK + 134217728ull)
#define OUT_SC (OUT_SV + 134217728ull)
#define OUT_SS (OUT_SC + 983040ull)

__constant__ double ROPE_INV_REV[32] = {
    1.59154943091895346e-01, 1.19349370211248862e-01, 8.94994016088910133e-02, 6.71150830052272551e-02,
    5.03292121044870353e-02, 3.77415847174197711e-02, 2.83021958306233987e-02, 2.12236527647776604e-02,
    1.59154943091895339e-02, 1.19349370211248862e-02, 8.94994016088910237e-03, 6.71150830052272534e-03,
    5.03292121044870370e-03, 3.77415847174197719e-03, 2.83021958306233987e-03, 2.12236527647776622e-03,
    1.59154943091895356e-03, 1.19349370211248849e-03, 8.94994016088910237e-04, 6.71150830052272599e-04,
    5.03292121044870326e-04, 3.77415847174197741e-04, 2.83021958306233954e-04, 2.12236527647776605e-04,
    1.59154943091895351e-04, 1.19349370211248862e-04, 8.94994016088910182e-05, 6.71150830052272545e-05,
    5.03292121044870354e-05, 3.77415847174197768e-05, 2.83021958306233961e-05, 2.12236527647776592e-05
};

__device__ __forceinline__ float silu_f(float x) { return x * __builtin_amdgcn_rcpf(1.0f + __expf(-x)); }
__device__ __forceinline__ float softplus_f(float x) { return fmaxf(x, 0.f) + log1pf(__expf(-fabsf(x))); }
__device__ __forceinline__ float gelu_f(float x) { return 0.5f * x * (1.0f + erff(x * 0.70710678118654752f)); }
__device__ __forceinline__ float wave_sum(float v) {
#pragma unroll
    for (int o = 32; o > 0; o >>= 1) v += __shfl_xor(v, o);
    return v;
}
__device__ __forceinline__ float wave_max(float v) {
#pragma unroll
    for (int o = 32; o > 0; o >>= 1) v = fmaxf(v, __shfl_xor(v, o));
    return v;
}

#include <cstdio>
#define XB_TMO      128
#define XB_XCNT(j)  (256  + 64 * (j))
#define XB_XSUB(j)  (1280 + 64 * (j))
#define XB_XGEN(j)  (2304 + 64 * (j))
#define XB_TOP      3328
#define XB_TOPGEN   3392
#define XCD_BAR_WORDS 3456
#define XB_SPIN_CAP (1u << 18)
#define LAS __attribute__((address_space(3)))

__device__ __forceinline__ unsigned xb_ld(unsigned* p)              { return __hip_atomic_load(p, __ATOMIC_RELAXED, __HIP_MEMORY_SCOPE_AGENT); }
__device__ __forceinline__ unsigned xb_add(unsigned* p, unsigned v) { return __hip_atomic_fetch_add(p, v, __ATOMIC_RELAXED, __HIP_MEMORY_SCOPE_AGENT); }
__device__ __forceinline__ unsigned xb_xcc_id() { return (unsigned)__builtin_amdgcn_s_getreg((3 << 11) | 20) & 0xFu; }
#define XB_SPIN(cond, bar) do { unsigned _sp = 0; while (cond) { __builtin_amdgcn_s_sleep(1); \
    if ((++_sp & 255u) == 0u) { if (xb_ld(&(bar)[XB_TMO])) break; if (_sp > XB_SPIN_CAP) { atomicAdd(&(bar)[XB_TMO], 1u); break; } } } } while (0)

struct XcdBarrier {
    unsigned* bar; unsigned x;
    volatile LAS unsigned* st;
};

__device__ __forceinline__ XcdBarrier xcd_barrier_post(unsigned* bar, volatile LAS unsigned* st) {
    XcdBarrier b; b.bar = bar; b.x = xb_xcc_id(); b.st = st;
    if (threadIdx.x == 0) (void)xb_add(&bar[XB_XCNT(b.x)], 1u);
    return b;
}
__device__ __forceinline__ void xcd_barrier_complete(unsigned* bar, unsigned x, unsigned& nloc, unsigned& nx) {
    const unsigned G = gridDim.x * gridDim.y * gridDim.z;
    unsigned sum, cnt, mine, sp = 0u;
    for (;;) {
        sum = 0u; cnt = 0u; mine = 0u;
#pragma unroll
        for (unsigned j = 0; j < 16; ++j) { const unsigned c = xb_ld(&bar[XB_XCNT(j)]); sum += c; cnt += (c > 0u) ? 1u : 0u; mine = (j == x) ? c : mine; }
        if (sum == G) break;
        __builtin_amdgcn_s_sleep(1);
        if ((++sp & 255u) == 0u) { if (xb_ld(&bar[XB_TMO])) break; if (sp > XB_SPIN_CAP) { atomicAdd(&bar[XB_TMO], 1u); break; } }
    }
    nloc = mine > 0u ? mine : 1u; nx = cnt > 0u ? cnt : 1u;
}

__device__ __forceinline__ void xcd_barrier(const XcdBarrier& b) {
    asm volatile("s_waitcnt vmcnt(0)" ::: "memory");
    __syncthreads();
    if (threadIdx.x == 0) {
        unsigned* bar = b.bar;
        __builtin_amdgcn_s_waitcnt(0);
        unsigned nloc = b.st[0], nx = b.st[1];
        if (nloc == 0u) { xcd_barrier_complete(bar, b.x, nloc, nx); b.st[0] = nloc; b.st[1] = nx; }
        const unsigned old = xb_add(&bar[XB_XSUB(b.x)], 1u);
        const unsigned gen = old / nloc;
        if (old + 1u == (gen + 1u) * nloc) {
            __builtin_amdgcn_fence(__ATOMIC_RELEASE, "agent");
            asm volatile("s_waitcnt vmcnt(0)" ::: "memory");
            const unsigned og = xb_add(&bar[XB_TOP], 1u);
            const unsigned tg = og / nx;
            if (og + 1u == (tg + 1u) * nx) xb_add(&bar[XB_TOPGEN], 1u);
            else XB_SPIN(xb_ld(&bar[XB_TOPGEN]) == tg, bar);
            __builtin_amdgcn_fence(__ATOMIC_ACQUIRE, "agent");
            xb_add(&bar[XB_XGEN(b.x)], 1u);
            asm volatile("s_waitcnt vmcnt(0)" ::: "memory");
        } else {
            XB_SPIN(xb_ld(&bar[XB_XGEN(b.x)]) == gen, bar);
            __builtin_amdgcn_fence(__ATOMIC_ACQUIRE, "agent");
            asm volatile("s_waitcnt vmcnt(0)" ::: "memory");
        }
    }
    __syncthreads();
}


#define GAS __attribute__((address_space(1)))
typedef unsigned short bf16;
typedef unsigned v4u __attribute__((ext_vector_type(4)));
#define LDS_WAIT() asm volatile("s_waitcnt lgkmcnt(0)" ::: "memory")
__device__ __forceinline__ unsigned f2bf(float f) { unsigned u = __builtin_bit_cast(unsigned, f); return (u + 0x7fffu + ((u >> 16) & 1u)) >> 16; }
__device__ __forceinline__ unsigned pk2(float lo, float hi) { return f2bf(lo) | (f2bf(hi) << 16); }
__device__ __forceinline__ float bf2f(unsigned short b) { return __builtin_bit_cast(float, (unsigned)b << 16); }
#include <hip/hip_runtime.h>
namespace pg8 {
#define PG8_LAS __attribute__((address_space(3)))
typedef unsigned short bf16_t;
typedef short bf16x8 __attribute__((ext_vector_type(8)));
typedef float f32x4 __attribute__((ext_vector_type(4)));
typedef unsigned u32x4 __attribute__((ext_vector_type(4)));
constexpr int BM = 256, BK = 64, HALF = 128, HTB = HALF * BK * 2  , STAGE_BYTES = 8 * HTB, NXCD = 8, WGM = 8;

__host__ __device__ __forceinline__ int lds_byte(int r, int c) { const int st = (r >> 4) * 2 + (c >> 5), rr = r & 15, cc = c & 31, ob = rr * 64 + cc * 2; return st * 1024 + (ob ^ (((ob >> 9) & 1) << 5)); }
__host__ __device__ __forceinline__ void stage_rc(int b, int& R, int& C) { const int st = b / 1024, sb = b % 1024, swz = sb ^ (((sb >> 9) & 1) << 5); R = (st >> 1) * 16 + swz / 64; C = (st & 1) * 32 + (swz % 64) / 2; }
__host__ __device__ __forceinline__ int perm32(int rho) { const int n = rho >> 4, i = rho & 15; return 8 * (i >> 2) + 4 * n + (i & 3); }

struct Unit { int pm, pn; };
struct Gemm { const bf16_t* A; const bf16_t* Bt; int M, N, K; };

struct StaticOrder {
    int nM, nN, nwg, G, c;
    __host__ __device__ void init(int M, int N, int G_, int c_) { nM = M / BM; nN = N / BM; nwg = nM * nN; G = G_; c = c_; }
    __host__ __device__ bool next(int i, Unit& u) const {
        const long L = (long)i * G + c; if (L >= nwg) return false;
        int wgid = (int)L; { const int q = nwg / NXCD, r = nwg % NXCD, xcd = wgid % NXCD, off = wgid / NXCD; wgid = (xcd < r ? xcd * (q + 1) : r * (q + 1) + (xcd - r) * q) + off; }
        const int nig = WGM * nN, gid = wgid / nig, fm = gid * WGM, gsz = (nM - fm) < WGM ? (nM - fm) : WGM;
        u.pm = fm + ((wgid % nig) % gsz); u.pn = (wgid % nig) / gsz; return true;
    }
    __device__ __forceinline__ void a_ready(const Unit&) const {}
    __device__ __forceinline__ void done(const Unit&) const {}
};
__device__ __forceinline__ unsigned cvt_pk_bf16(float lo, float hi) { unsigned r; asm volatile("v_cvt_pk_bf16_f32 %0, %1, %2" : "=v"(r) : "v"(lo), "v"(hi)); return r; }
typedef float f32x2 __attribute__((ext_vector_type(2)));
__device__ __forceinline__ f32x2 gelu_pk(f32x2 v) {
    const f32x2 av = __builtin_elementwise_abs(v), d = av * 0.2316418882f + 1.0f;
    f32x2 t; t.x = __builtin_amdgcn_rcpf(d.x); t.y = __builtin_amdgcn_rcpf(d.y);
    f32x2 q = t * 0.5307027145f + (-0.7265760135f); q = q * t + 0.7107068705f; q = q * t + (-0.142248368f); q = q * t + 0.127414796f; q = q * t;
    const f32x2 s = (v * v) * (-0.72134752044f);
    f32x2 e; e.x = __builtin_amdgcn_exp2f(s.x); e.y = __builtin_amdgcn_exp2f(s.y);
    const f32x2 m = v * (q * e), r = v - m;
    f32x2 o; o.x = v.x < 0.f ? m.x : r.x; o.y = v.y < 0.f ? m.y : r.y; return o;
}

struct EpiF32 {
    static constexpr bool PERM = false, AFTER_DRAIN = false;
    float* C; int ldc; const float* bias;
    __device__ __forceinline__ void operator()(const f32x4 (&acc)[2][2][4][2], const Unit& u, int wr, int wc, int fr, int fq) const {
        const int row0 = u.pm * BM + wr * 64 + fr, col0 = u.pn * BM + wc * 32 + 4 * fq;
        f32x4 bv[2][2];
#pragma unroll
        for (int bj = 0; bj < 2; ++bj)
#pragma unroll
            for (int n = 0; n < 2; ++n) bv[bj][n] = bias ? *(const f32x4*)(bias + col0 + bj * HALF + n * 16) : (f32x4){0.f, 0.f, 0.f, 0.f};
#pragma unroll
        for (int ai = 0; ai < 2; ++ai)
#pragma unroll
            for (int m = 0; m < 4; ++m) { float* rowp = C + (size_t)(row0 + ai * HALF + m * 16) * ldc + col0;
#pragma unroll
                for (int bj = 0; bj < 2; ++bj)
#pragma unroll
                    for (int n = 0; n < 2; ++n) *(f32x4*)(rowp + bj * HALF + n * 16) = acc[ai][bj][m][n] + bv[bj][n]; }
    }
};

template <class Epi, class Sched, bool STAMP = false>
__device__ __forceinline__ void gemm_phase(PG8_LAS unsigned char* lds, const Gemm g, const Sched& S, const Epi& E, unsigned long long* stamps) {
    int tid = threadIdx.x; asm volatile("" : "+v"(tid));
    const int wid = __builtin_amdgcn_readfirstlane(tid >> 6), lane = tid & 63, wr = wid >> 2, wc = wid & 3, fr = lane & 15, fq = lane >> 4;
    const int K = g.K, nt = K / BK;
    int ts_lo = 0, ts_hi = 0, nts = 0; const unsigned long long rt_entry = STAMP ? (unsigned long long)wall_clock64() : 0ull;
#define PG8_STAMP() do { if (STAMP && wid == 0 && nts < 64) { const unsigned long long _c = (unsigned long long)clock64(); \
        ts_lo = (lane == nts) ? (int)(unsigned)_c : ts_lo; ts_hi = (lane == nts) ? (int)(unsigned)(_c >> 32) : ts_hi; ++nts; } } while (0)
    PG8_STAMP();
    unsigned voffA[2], voffB[2];
#pragma unroll
    for (int i = 0; i < 2; ++i) { int R, C; stage_rc(tid * 16 + i * 8192, R, C); const int Rb = Epi::PERM ? ((R & ~31) + perm32(R & 31)) : R;
        voffA[i] = (unsigned)(R * K + C) * 2u; voffB[i] = (unsigned)(Rb * K + C) * 2u; }
    const size_t kstep = (size_t)(BK * 2);
    const size_t hstep = (size_t)HALF * K * 2;
    const size_t tstep = 2 * hstep;
    const unsigned ldsw = (unsigned)wid * 1024u;
    const int aoff = lds_byte(wr * 64 + fr, fq * 8), boff = lds_byte(wc * 32 + fr, fq * 8);
#define PG8_SA(b, h) (((b) * 2 + (h)) * HTB)
#define PG8_SB(b, h) ((4 + (b) * 2 + (h)) * HTB)
#define PG8_STAGE(bufoff, gbase, voff) do { _Pragma("unroll") for (int _i = 0; _i < 2; ++_i) \
        __builtin_amdgcn_global_load_lds((const unsigned*)((const char*)(gbase) + (voff)[_i]), (PG8_LAS unsigned*)(lds + (bufoff) + ldsw + _i * 8192), 16, 0, 0); } while (0)
#define PG8_LDA(dst, b, h) do { _Pragma("unroll") for (int m = 0; m < 4; ++m) _Pragma("unroll") for (int k = 0; k < 2; ++k) dst[m][k] = *(const PG8_LAS bf16x8*)(lds + PG8_SA(b, h) + aoff + m * 2048 + k * 1024); } while (0)
#define PG8_LDB(dst, b, h) do { _Pragma("unroll") for (int n = 0; n < 2; ++n) _Pragma("unroll") for (int k = 0; k < 2; ++k) dst[n][k] = *(const PG8_LAS bf16x8*)(lds + PG8_SB(b, h) + boff + n * 2048 + k * 1024); } while (0)
#define PG8_MMA(ai, bj, At, Bt) do { __builtin_amdgcn_s_setprio(1); _Pragma("unroll") for (int m = 0; m < 4; ++m) _Pragma("unroll") for (int n = 0; n < 2; ++n) _Pragma("unroll") for (int k = 0; k < 2; ++k) \
        acc[ai][bj][m][n] = __builtin_amdgcn_mfma_f32_16x16x32_bf16(Bt[n][k], At[m][k], acc[ai][bj][m][n], 0, 0, 0); __builtin_amdgcn_s_setprio(0); } while (0)
#define PG8_WAIT_V(n) asm volatile("s_waitcnt vmcnt(" #n ")" ::: "memory")
#define PG8_WAIT_L(n) asm volatile("s_waitcnt lgkmcnt(" #n ")" ::: "memory")
#define PG8_BAR __builtin_amdgcn_s_barrier()
#define PG8_SCHED __builtin_amdgcn_sched_barrier(0)
    Unit cur, nxt; int ui = 0;
    if (!S.next(0, cur)) return;
    f32x4 acc[2][2][4][2];
#pragma unroll
    for (int a = 0; a < 2; ++a)
#pragma unroll
        for (int b = 0; b < 2; ++b)
#pragma unroll
            for (int m = 0; m < 4; ++m)
#pragma unroll
                for (int n = 0; n < 2; ++n) acc[a][b][m][n] = (f32x4){0.f, 0.f, 0.f, 0.f};
    bf16x8 At[4][2], B0[2][2], B1[2][2];
    const char* cA = (const char*)g.A + (size_t)cur.pm * tstep; const char* cB = (const char*)g.Bt + (size_t)cur.pn * tstep;
    S.a_ready(cur);
    PG8_STAGE(PG8_SB(0, 0), cB, voffB); PG8_STAGE(PG8_SA(0, 0), cA, voffA); PG8_STAGE(PG8_SB(0, 1), cB + hstep, voffB); PG8_STAGE(PG8_SA(0, 1), cA + hstep, voffA);
    if (wr == 1) PG8_BAR;
    PG8_WAIT_V(4); PG8_BAR;
    PG8_STAGE(PG8_SB(1, 0), cB + kstep, voffB); PG8_STAGE(PG8_SA(1, 0), cA + kstep, voffA); PG8_STAGE(PG8_SB(1, 1), cB + hstep + kstep, voffB);
    PG8_WAIT_V(6); PG8_BAR;
    PG8_STAMP();
    for (;;) {
        const bool has_next = S.next(ui + 1, nxt);
        const char* nA = has_next ? (const char*)g.A + (size_t)nxt.pm * tstep : cA; const char* nB = has_next ? (const char*)g.Bt + (size_t)nxt.pn * tstep : cB;
        for (int t = 0; t < nt; t += 2) {
            const bool last = (t == nt - 2);
            const char* a1 = cA + (size_t)(t + 1) * kstep;
            const char* a2 = last ? nA : cA + (size_t)(t + 2) * kstep; const char* b2 = last ? nB : cB + (size_t)(t + 2) * kstep;
            const char* a3 = a2 + kstep; const char* b3 = b2 + kstep;
            if (last && has_next) S.a_ready(nxt);
            PG8_LDB(B0, 0, 0); PG8_SCHED; PG8_LDA(At, 0, 0); PG8_STAGE(PG8_SA(1, 1), a1 + hstep, voffA);
            PG8_WAIT_L(8); PG8_BAR; PG8_WAIT_L(0); PG8_MMA(0, 0, At, B0); PG8_BAR; PG8_SCHED;
            PG8_LDB(B1, 0, 1); PG8_STAGE(PG8_SB(0, 0), b2, voffB);
            PG8_BAR; PG8_WAIT_L(0); PG8_MMA(0, 1, At, B1); PG8_BAR;
            PG8_LDA(At, 0, 1); PG8_STAGE(PG8_SA(0, 0), a2, voffA);
            PG8_BAR; PG8_WAIT_L(0); PG8_MMA(1, 0, At, B0); PG8_BAR; PG8_SCHED;
            PG8_STAGE(PG8_SB(0, 1), b2 + hstep, voffB);
            PG8_WAIT_V(6); PG8_BAR; PG8_MMA(1, 1, At, B1); PG8_BAR;
            PG8_LDB(B0, 1, 0); PG8_SCHED; PG8_LDA(At, 1, 0); PG8_STAGE(PG8_SA(0, 1), a2 + hstep, voffA);
            PG8_WAIT_L(8); PG8_BAR; PG8_WAIT_L(0); PG8_MMA(0, 0, At, B0); PG8_BAR; PG8_SCHED;
            PG8_LDB(B1, 1, 1); PG8_STAGE(PG8_SB(1, 0), b3, voffB);
            PG8_BAR; PG8_WAIT_L(0); PG8_MMA(0, 1, At, B1); PG8_BAR;
            PG8_LDA(At, 1, 1); PG8_STAGE(PG8_SA(1, 0), a3, voffA);
            PG8_BAR; PG8_WAIT_L(0); PG8_MMA(1, 0, At, B0); PG8_BAR; PG8_SCHED;
            PG8_STAGE(PG8_SB(1, 1), b3 + hstep, voffB);
            PG8_WAIT_V(6); PG8_BAR; PG8_MMA(1, 1, At, B1); PG8_BAR;
        }
        PG8_STAMP();
        if constexpr (!Epi::AFTER_DRAIN) { E(acc, cur, wr, wc, fr, fq); S.done(cur); }
        PG8_STAMP();
        if (!has_next) break;
#pragma unroll
        for (int a = 0; a < 2; ++a)
#pragma unroll
            for (int b = 0; b < 2; ++b)
#pragma unroll
                for (int m = 0; m < 4; ++m)
#pragma unroll
                    for (int n = 0; n < 2; ++n) acc[a][b][m][n] = (f32x4){0.f, 0.f, 0.f, 0.f};
        cur = nxt; cA = nA; cB = nB; ++ui;
    }
    PG8_WAIT_V(0);
    if (wr == 0) PG8_BAR;
    PG8_BAR;
    if constexpr (Epi::AFTER_DRAIN) { E.fused(acc, cur, wr, wc, fr, fq, lds, wid, lane); S.done(cur); }
    PG8_STAMP();
    if (STAMP && wid == 0) { stamps[lane] = lane < nts ? (((unsigned long long)(unsigned)ts_hi << 32) | (unsigned)ts_lo) : 0ull;
        if (lane == 62) stamps[62] = rt_entry; if (lane == 63) stamps[63] = (unsigned long long)wall_clock64(); }
#undef PG8_STAMP
#undef PG8_SA
#undef PG8_SB
#undef PG8_STAGE
#undef PG8_LDA
#undef PG8_LDB
#undef PG8_MMA
#undef PG8_WAIT_V
#undef PG8_WAIT_L
#undef PG8_BAR
#undef PG8_SCHED
}
}


namespace pg8 {
struct EpiProj {
    static constexpr bool PERM = true, AFTER_DRAIN = false;
    bf16_t* O; float* dtraw;
    __device__ __forceinline__ void operator()(const f32x4 (&acc)[2][2][4][2], const Unit& u, int wr, int wc, int fr, int fq) const {
        const int row0 = u.pm * BM + wr * 64 + fr;
        if (u.pn < 22) {
            const int col0 = u.pn * BM + wc * 32 + 8 * fq;
#pragma unroll
            for (int ai = 0; ai < 2; ++ai)
#pragma unroll
                for (int m = 0; m < 4; ++m) { bf16_t* rowp = O + (size_t)(row0 + ai * HALF + m * 16) * 5632 + col0;
#pragma unroll
                    for (int bj = 0; bj < 2; ++bj) { const f32x4 v0 = acc[ai][bj][m][0], v1 = acc[ai][bj][m][1];
                        u32x4 w; w.x = cvt_pk_bf16(v0[0], v0[1]); w.y = cvt_pk_bf16(v0[2], v0[3]); w.z = cvt_pk_bf16(v1[0], v1[1]); w.w = cvt_pk_bf16(v1[2], v1[3]);
                        *(u32x4*)(rowp + bj * HALF) = w; } }
        } else if (wc == 0) {
#pragma unroll
            for (int ai = 0; ai < 2; ++ai)
#pragma unroll
                for (int m = 0; m < 4; ++m) { float* rp = dtraw + (size_t)(row0 + ai * HALF + m * 16) * 32 + 8 * fq;
                    *(f32x4*)rp = acc[ai][0][m][0]; *(f32x4*)(rp + 4) = acc[ai][0][m][1]; }
        }
    }
};
}


namespace pg8 {
struct EpiBf16Plain {
    static constexpr bool PERM = true, AFTER_DRAIN = false;
    bf16_t* O; int ldc;
    __device__ __forceinline__ void operator()(const f32x4 (&acc)[2][2][4][2], const Unit& u, int wr, int wc, int fr, int fq) const {
        const int row0 = u.pm * BM + wr * 64 + fr, col0 = u.pn * BM + wc * 32 + 8 * fq;
#pragma unroll
        for (int ai = 0; ai < 2; ++ai)
#pragma unroll
            for (int m = 0; m < 4; ++m) { bf16_t* rowp = O + (size_t)(row0 + ai * HALF + m * 16) * ldc + col0;
#pragma unroll
                for (int bj = 0; bj < 2; ++bj) { const f32x4 v0 = acc[ai][bj][m][0], v1 = acc[ai][bj][m][1];
                    u32x4 w; w.x = cvt_pk_bf16(v0[0], v0[1]); w.y = cvt_pk_bf16(v0[2], v0[3]); w.z = cvt_pk_bf16(v1[0], v1[1]); w.w = cvt_pk_bf16(v1[2], v1[3]);
                    *(u32x4*)(rowp + bj * HALF) = w; } }
    }
};
}

#define NTHR 512
#define NWAVE 8

__device__ __forceinline__ void ph_gemm_f32(float* lds, const float* __restrict__ A, const float* __restrict__ B, float* __restrict__ C,
                                            int M, int N, int K, int lda, int ldb, int ldc) {
    const int tid = threadIdx.x & 255, half = threadIdx.x >> 8, tx = tid & 15, ty = tid >> 4;
    float (*As)[68] = (float (*)[68])(lds + half * 2 * 16 * 68);
    float (*Bs)[68] = (float (*)[68])(lds + half * 2 * 16 * 68 + 16 * 68);
    const int ntx = (N + 63) / 64, nty = M / 64, ntiles = ntx * nty;
    for (int it = blockIdx.x; 2 * it < ntiles; it += gridDim.x) {
        const int tile = 2 * it + half;
        const int m0 = (tile / ntx) * 64, n0 = (tile % ntx) * 64;
        float acc[4][4];
#pragma unroll
        for (int i = 0; i < 4; ++i)
#pragma unroll
            for (int j = 0; j < 4; ++j) acc[i][j] = 0.f;
        for (int k0 = 0; k0 < K; k0 += 16) {
#pragma unroll
            for (int i = 0; i < 4; ++i) {
                int idx = tid + i * 256;
                int r = idx >> 4, c = idx & 15;
                As[c][r] = (m0 + r < M) ? A[(size_t)(m0 + r) * lda + k0 + c] : 0.f;
                int rb = idx >> 6, cb = idx & 63;
                Bs[rb][cb] = (n0 + cb < N) ? B[(size_t)(k0 + rb) * ldb + n0 + cb] : 0.f;
            }
            __syncthreads();
#pragma unroll
            for (int k = 0; k < 16; ++k) {
                float a[4], b[4];
#pragma unroll
                for (int i = 0; i < 4; ++i) { a[i] = As[k][ty * 4 + i]; b[i] = Bs[k][tx * 4 + i]; }
#pragma unroll
                for (int i = 0; i < 4; ++i)
#pragma unroll
                    for (int j = 0; j < 4; ++j) acc[i][j] += a[i] * b[j];
            }
            __syncthreads();
        }
#pragma unroll
        for (int i = 0; i < 4; ++i)
#pragma unroll
            for (int j = 0; j < 4; ++j) {
                int r = m0 + ty * 4 + i, c = n0 + tx * 4 + j;
                if (r < M && c < N) C[(size_t)r * ldc + c] = acc[i][j];
            }
    }
}


template <int MODE>
__device__ __forceinline__ void transpose_item(const float* __restrict__ W, int K, int N, int Npad, bf16* __restrict__ WT, LAS float* scr, int item, int lane) {
    const int nblk = Npad / 32, kb = item / nblk, nb = item % nblk, k0 = 64 * kb, n0 = 32 * nb;
    const int n = n0 + (lane & 31);
    int sc = n;
    if (MODE == 1) sc = (n < 4096) ? n : (n < 5632 ? n + 24 : (n < 5656 ? n - 5632 + 4096 : -1));
    else sc = (n < N) ? n : -1;
#pragma unroll 8
    for (int i = 0; i < 32; ++i) { const int kk = 2 * i + (lane >> 5); scr[kk * 33 + (lane & 31)] = (sc >= 0) ? W[(size_t)(k0 + kk) * N + sc] : 0.f; }
    LDS_WAIT(); asm volatile("" ::: "memory");
    const int c = lane & 7;
#pragma unroll
    for (int j = 0; j < 4; ++j) { const int nn = (lane >> 3) + 8 * j; const LAS float* s = scr + (8 * c) * 33 + nn;
        v4u o; o.x = pk2(s[0 * 33], s[1 * 33]); o.y = pk2(s[2 * 33], s[3 * 33]); o.z = pk2(s[4 * 33], s[5 * 33]); o.w = pk2(s[6 * 33], s[7 * 33]);
        *(v4u*)(WT + (size_t)(n0 + nn) * K + k0 + 8 * c) = o; }
    LDS_WAIT(); asm volatile("" ::: "memory");
}
__device__ __forceinline__ void ph_prologue(LAS unsigned char* ldsb, const float* __restrict__ xp, const float* __restrict__ xs, bf16* __restrict__ A0,
                                            const float* __restrict__ w_in, bf16* __restrict__ wt_in, float* __restrict__ rope_tab) {
    const int lane = threadIdx.x & 63, wave = threadIdx.x >> 6;
    LAS float* scr = (LAS float*)(ldsb + wave * 16384);
    const int gw = blockIdx.x * NWAVE + wave, NGW = gridDim.x * NWAVE;
    constexpr int I_IN = (D_MODEL / 64) * (PROJ_LD / 32);
    for (int it = gw; it < I_IN; it += NGW) transpose_item<1>(w_in, D_MODEL, IN_WIDTH, PROJ_LD, wt_in, scr, it, lane);
    for (int idx = blockIdx.x * NTHR + threadIdx.x; idx < SEQ * 32; idx += gridDim.x * NTHR) {
        const int pos = idx >> 5, j = idx & 31;
        const double rev = (double)pos * ROPE_INV_REV[j];
        const float fr = (float)(rev - floor(rev));
        rope_tab[(size_t)pos * 64 + j] = __builtin_amdgcn_cosf(fr); rope_tab[(size_t)pos * 64 + 32 + j] = __builtin_amdgcn_sinf(fr);
    }
    const size_t n8 = (size_t)T_ALL * D_MODEL / 8, np8 = (size_t)T_PROMPT * D_MODEL / 8;
#pragma unroll 4
    for (size_t i = (size_t)blockIdx.x * NTHR + threadIdx.x; i < n8; i += (size_t)gridDim.x * NTHR) {
        const float4* s = (i < np8) ? (const float4*)xp + 2 * i : (const float4*)xs + 2 * (i - np8);
        float4 a = s[0], b = s[1];
        v4u o; o.x = pk2(a.x, a.y); o.y = pk2(a.z, a.w); o.z = pk2(b.x, b.y); o.w = pk2(b.z, b.w);
        ((v4u*)A0)[i] = o;
    }
}
__device__ __forceinline__ void ph_prologue2(LAS unsigned char* ldsb, const float* __restrict__ w_out, bf16* __restrict__ wt_out, const float* __restrict__ w_q, bf16* __restrict__ wt_q,
                                             int rank, int nranks) {
    const int lane = threadIdx.x & 63, wave = threadIdx.x >> 6;
    LAS float* scr = (LAS float*)(ldsb + wave * 16384);
    constexpr int I_OUT = (MIX_WIDTH / 64) * (D_MODEL / 32), I_Q = (D_MODEL / 64) * (2048 / 32);
    for (int it = rank * NWAVE + wave; it < I_OUT + I_Q; it += nranks * NWAVE) {
        if (it < I_OUT) transpose_item<0>(w_out, MIX_WIDTH, D_MODEL, D_MODEL, wt_out, scr, it, lane);
        else transpose_item<0>(w_q, D_MODEL, 2048, 2048, wt_q, scr, it - I_OUT, lane);
    }
}

__device__ __forceinline__ void ph_concat_x(const float* __restrict__ xp, const float* __restrict__ xs, float* __restrict__ xall) {
    const size_t n4 = (size_t)T_ALL * D_MODEL / 4, np4 = (size_t)T_PROMPT * D_MODEL / 4;
    for (size_t i = (size_t)blockIdx.x * NTHR + threadIdx.x; i < n4; i += (size_t)gridDim.x * NTHR) {
        float4 v = (i < np4) ? ((const float4*)xp)[i] : ((const float4*)xs)[i - np4];
        ((float4*)xall)[i] = v;
    }
}

typedef float f32x4n __attribute__((ext_vector_type(4)));
__device__ __forceinline__ void ph_cache_copy(const float* __restrict__ ck, const float* __restrict__ cv, float* __restrict__ out) {
    constexpr unsigned PER_B = (WBUF - DEC_SEQ) * ATT_WIDTH / 4;
    constexpr unsigned TOTAL = 2u * DEC_BATCH * PER_B;
    for (unsigned c = blockIdx.x; c < TOTAL / 4096u; c += gridDim.x) {
        f32x4n v[8]; size_t dsti[8]; bool isv[8];
#pragma unroll
        for (int j = 0; j < 8; ++j) {
            const unsigned idx = c * 4096u + j * 512u + threadIdx.x;
            const unsigned tb = idx / PER_B, r = idx - tb * PER_B, bb = tb & (DEC_BATCH - 1);
            isv[j] = tb >= DEC_BATCH;
            const size_t srci = (size_t)bb * (WBUF * ATT_WIDTH / 4) + (DEC_SEQ * ATT_WIDTH / 4) + r;
            dsti[j] = (size_t)bb * (WBUF * ATT_WIDTH / 4) + r;
            v[j] = __builtin_nontemporal_load((isv[j] ? (const f32x4n*)cv : (const f32x4n*)ck) + srci);
        }
#pragma unroll
        for (int j = 0; j < 8; ++j) __builtin_nontemporal_store(v[j], (f32x4n*)(out + (isv[j] ? OUT_SV : OUT_SK)) + dsti[j]);
    }
}

__device__ __forceinline__ void ph_post_proj(const float* __restrict__ proj, const float* __restrict__ state_conv,
                                             const float* __restrict__ conv_w, const float* __restrict__ conv_b, const float* __restrict__ dt_bias,
                                             float* __restrict__ xbc_act, float* __restrict__ dtv, float* __restrict__ qrot, float* __restrict__ krot,
                                             float* __restrict__ out) {
    const int tid = threadIdx.x & 255, half = threadIdx.x >> 8;
    for (int t = 2 * blockIdx.x + half; t < T_ALL; t += 2 * gridDim.x) {
        const bool is_p = t < T_PROMPT;
        int b, i, pos;
        if (is_p) { b = t / SEQ; i = t % SEQ; pos = i; } else { int ts = t - T_PROMPT; b = ts / DEC_SEQ; i = ts % DEC_SEQ; pos = PAST_LEN + i; }
        const float* row = proj + (size_t)t * PROJ_LD;
        for (int c = tid; c < CONV_DIM; c += 256) {
            float acc = conv_b[c];
#pragma unroll
            for (int tap = 0; tap < 4; ++tap) {
                int r = i - 3 + tap;
                float val;
                if (r >= 0) val = proj[(size_t)(t - i + r) * PROJ_LD + O_XBC + c];
                else val = is_p ? 0.f : state_conv[((size_t)b * 3 + (3 + r)) * CONV_DIM + c];
                acc += val * conv_w[tap * CONV_DIM + c];
            }
            xbc_act[(size_t)t * CONV_DIM + c] = silu_f(acc);
        }
        if (tid < SSD_HEADS) dtv[(size_t)t * SSD_HEADS + tid] = softplus_f(row[O_DT + tid] + dt_bias[tid]);
        for (int idx = tid; idx < 512; idx += 256) {
            int which = idx >> 8, h = (idx >> 5) & 7, j = idx & 31;
            double rev = (double)pos * ROPE_INV_REV[j];
            float fr = (float)(rev - floor(rev));
            float sn = __builtin_amdgcn_sinf(fr), cs = __builtin_amdgcn_cosf(fr);
            const float* src = row + (which ? O_K : O_Q) + h * 64;
            float t1 = src[j], t2 = src[j + 32];
            float o1 = t1 * cs - t2 * sn, o2 = t2 * cs + t1 * sn;
            float* dst = (which ? krot : qrot) + (size_t)t * ATT_WIDTH + h * 64;
            dst[j] = o1; dst[j + 32] = o2;
            if (which) {
                if (is_p) { if (i >= SEQ - WBUF) { float* o = out + OUT_PK + ((size_t)b * WBUF + (i - (SEQ - WBUF))) * ATT_WIDTH + h * 64; o[j] = o1; o[j + 32] = o2; } }
                else { float* o = out + OUT_SK + ((size_t)b * WBUF + (WBUF - DEC_SEQ + i)) * ATT_WIDTH + h * 64; o[j] = o1; o[j + 32] = o2; }
            }
        }
        for (int c = tid; c < ATT_WIDTH; c += 256) {
            float v = row[O_V + c];
            if (is_p) { if (i >= SEQ - WBUF) out[OUT_PV + ((size_t)b * WBUF + (i - (SEQ - WBUF))) * ATT_WIDTH + c] = v; }
            else out[OUT_SV + ((size_t)b * WBUF + (WBUF - DEC_SEQ + i)) * ATT_WIDTH + c] = v;
        }
        if (is_p) {
            if (i >= SEQ - 3) { int r = i - (SEQ - 3); for (int c = tid; c < CONV_DIM; c += 256) out[OUT_PC + ((size_t)b * 3 + r) * CONV_DIM + c] = row[O_XBC + c]; }
        } else {
            if (i >= 1) { int r = i - 1; for (int c = tid; c < CONV_DIM; c += 256) out[OUT_SC + ((size_t)b * 3 + r) * CONV_DIM + c] = row[O_XBC + c]; }
        }
    }
}


#define NB_LD 5632
#define NB_XBC 1536
#define NB_Q 4096
#define NB_K 4608
#define NB_V 5120
__device__ __forceinline__ void unpack8(const v4u w, float (&f)[8]) {
    f[0] = __builtin_bit_cast(float, w.x << 16); f[1] = __builtin_bit_cast(float, w.x & 0xffff0000u);
    f[2] = __builtin_bit_cast(float, w.y << 16); f[3] = __builtin_bit_cast(float, w.y & 0xffff0000u);
    f[4] = __builtin_bit_cast(float, w.z << 16); f[5] = __builtin_bit_cast(float, w.z & 0xffff0000u);
    f[6] = __builtin_bit_cast(float, w.w << 16); f[7] = __builtin_bit_cast(float, w.w & 0xffff0000u);
}
__device__ __forceinline__ void store8f(float* d, const float (&f)[8]) { *(float4*)d = make_float4(f[0], f[1], f[2], f[3]); *(float4*)(d + 4) = make_float4(f[4], f[5], f[6], f[7]); }
__device__ __forceinline__ void ph_post_proj2(const bf16* __restrict__ projb, const float* __restrict__ dtraw, const float* __restrict__ state_conv,
                                              const float* __restrict__ conv_w, const float* __restrict__ conv_b, const float* __restrict__ dt_bias,
                                              bf16* __restrict__ xbc_b, float* __restrict__ dtv, bf16* __restrict__ qrot_b, bf16* __restrict__ krot_b,
                                              float* __restrict__ out) {
    const int tid = threadIdx.x & 255, half = threadIdx.x >> 8;
    for (int t = T_PROMPT + 2 * blockIdx.x + half; t < T_ALL; t += 2 * gridDim.x) {
        const bool is_p = t < T_PROMPT;
        int b, i, pos;
        if (is_p) { b = t / SEQ; i = t % SEQ; pos = i; } else { int ts = t - T_PROMPT; b = ts / DEC_SEQ; i = ts % DEC_SEQ; pos = PAST_LEN + i; }
        const bf16* row = projb + (size_t)t * NB_LD;
        if (tid < 64) {
            float f[8]; unpack8(*(const v4u*)(row + NB_V + tid * 8), f);
            if (is_p) { if (i >= SEQ - WBUF) store8f(out + OUT_PV + ((size_t)b * WBUF + (i - (SEQ - WBUF))) * ATT_WIDTH + tid * 8, f); }
            else store8f(out + OUT_SV + ((size_t)b * WBUF + (WBUF - DEC_SEQ + i)) * ATT_WIDTH + tid * 8, f);
        }
        for (int c8 = tid; c8 < 320; c8 += 256) {
            const int c = c8 * 8;
            float acc[8], cur[8];
            { const float4 b0 = *(const float4*)(conv_b + c), b1 = *(const float4*)(conv_b + c + 4);
              acc[0] = b0.x; acc[1] = b0.y; acc[2] = b0.z; acc[3] = b0.w; acc[4] = b1.x; acc[5] = b1.y; acc[6] = b1.z; acc[7] = b1.w; }
#pragma unroll
            for (int tap = 0; tap < 4; ++tap) {
                const int r = i - 3 + tap;
                float val[8];
                if (r >= 0) unpack8(*(const v4u*)(projb + (size_t)(t - i + r) * NB_LD + NB_XBC + c), val);
                else if (!is_p) { const float* sp = state_conv + ((size_t)b * 3 + (3 + r)) * CONV_DIM + c; const float4 s0 = *(const float4*)sp, s1 = *(const float4*)(sp + 4);
                    val[0] = s0.x; val[1] = s0.y; val[2] = s0.z; val[3] = s0.w; val[4] = s1.x; val[5] = s1.y; val[6] = s1.z; val[7] = s1.w; }
                else {
#pragma unroll
                    for (int j = 0; j < 8; ++j) val[j] = 0.f; }
                const float4 w0 = *(const float4*)(conv_w + tap * CONV_DIM + c), w1 = *(const float4*)(conv_w + tap * CONV_DIM + c + 4);
                acc[0] += val[0] * w0.x; acc[1] += val[1] * w0.y; acc[2] += val[2] * w0.z; acc[3] += val[3] * w0.w;
                acc[4] += val[4] * w1.x; acc[5] += val[5] * w1.y; acc[6] += val[6] * w1.z; acc[7] += val[7] * w1.w;
                if (tap == 3) {
#pragma unroll
                    for (int j = 0; j < 8; ++j) cur[j] = val[j]; }
            }
#pragma unroll
            for (int j = 0; j < 8; ++j) acc[j] = silu_f(acc[j]);
            v4u o; o.x = pk2(acc[0], acc[1]); o.y = pk2(acc[2], acc[3]); o.z = pk2(acc[4], acc[5]); o.w = pk2(acc[6], acc[7]);
            *(v4u*)(xbc_b + (size_t)t * CONV_DIM + c) = o;
            if (is_p) { if (i >= SEQ - 3) store8f(out + OUT_PC + ((size_t)b * 3 + (i - (SEQ - 3))) * CONV_DIM + c, cur); }
            else { if (i >= 1) store8f(out + OUT_SC + ((size_t)b * 3 + (i - 1)) * CONV_DIM + c, cur); }
        }
        if (tid < SSD_HEADS) dtv[(size_t)t * SSD_HEADS + tid] = softplus_f(dtraw[(size_t)t * 32 + tid] + dt_bias[tid]);
        if (tid < 128) {
            const int which = tid >> 6, h = (tid >> 3) & 7, jc = tid & 7;
            const bf16* src = row + (which ? NB_K : NB_Q) + h * 64 + jc * 4;
            const uint2 lo = *(const uint2*)src, hi = *(const uint2*)(src + 32);
            float t1[4], t2[4], o1[4], o2[4];
            t1[0] = __builtin_bit_cast(float, lo.x << 16); t1[1] = __builtin_bit_cast(float, lo.x & 0xffff0000u); t1[2] = __builtin_bit_cast(float, lo.y << 16); t1[3] = __builtin_bit_cast(float, lo.y & 0xffff0000u);
            t2[0] = __builtin_bit_cast(float, hi.x << 16); t2[1] = __builtin_bit_cast(float, hi.x & 0xffff0000u); t2[2] = __builtin_bit_cast(float, hi.y << 16); t2[3] = __builtin_bit_cast(float, hi.y & 0xffff0000u);
#pragma unroll
            for (int e = 0; e < 4; ++e) {
                const double rev = (double)pos * ROPE_INV_REV[jc * 4 + e];
                const float fr = (float)(rev - floor(rev));
                const float sn = __builtin_amdgcn_sinf(fr), cs = __builtin_amdgcn_cosf(fr);
                o1[e] = t1[e] * cs - t2[e] * sn; o2[e] = t2[e] * cs + t1[e] * sn;
            }
            const size_t doff = (size_t)t * ATT_WIDTH + h * 64 + jc * 4;
            bf16* db = which ? krot_b : qrot_b;
            *(uint2*)(db + doff) = make_uint2(pk2(o1[0], o1[1]), pk2(o1[2], o1[3])); *(uint2*)(db + doff + 32) = make_uint2(pk2(o2[0], o2[1]), pk2(o2[2], o2[3]));
            if (which) {
                float* o = nullptr;
                if (is_p) { if (i >= SEQ - WBUF) o = out + OUT_PK + ((size_t)b * WBUF + (i - (SEQ - WBUF))) * ATT_WIDTH + h * 64 + jc * 4; }
                else o = out + OUT_SK + ((size_t)b * WBUF + (WBUF - DEC_SEQ + i)) * ATT_WIDTH + h * 64 + jc * 4;
                if (o) { *(float4*)o = make_float4(o1[0], o1[1], o1[2], o1[3]); *(float4*)(o + 32) = make_float4(o2[0], o2[1], o2[2], o2[3]); }
            }
        }
    }
}


__device__ __forceinline__ void ph_post_proj_prompt(const bf16* __restrict__ projb, const float* __restrict__ dtraw, const float* __restrict__ conv_w, const float* __restrict__ conv_b,
                                                    const float* __restrict__ dt_bias, const float* __restrict__ rope_tab, bf16* __restrict__ xbc_b, float* __restrict__ dtv,
                                                    bf16* __restrict__ qrot_b, bf16* __restrict__ krot_b, float* __restrict__ out) {
    const int gtid = blockIdx.x * NTHR + threadIdx.x, gsz = gridDim.x * NTHR;
    for (int item = gtid; item < (T_PROMPT / 16) * 320; item += gsz) {
        const int run = item / 320, c = (item - run * 320) * 8, t0 = run * 16, i0 = t0 & (SEQ - 1), b = t0 >> 13;
        float w[4][8], bias[8];
#pragma unroll
        for (int tap = 0; tap < 4; ++tap) { const float4 w0 = *(const float4*)(conv_w + tap * CONV_DIM + c), w1 = *(const float4*)(conv_w + tap * CONV_DIM + c + 4);
            w[tap][0] = w0.x; w[tap][1] = w0.y; w[tap][2] = w0.z; w[tap][3] = w0.w; w[tap][4] = w1.x; w[tap][5] = w1.y; w[tap][6] = w1.z; w[tap][7] = w1.w; }
        { const float4 b0 = *(const float4*)(conv_b + c), b1 = *(const float4*)(conv_b + c + 4);
          bias[0] = b0.x; bias[1] = b0.y; bias[2] = b0.z; bias[3] = b0.w; bias[4] = b1.x; bias[5] = b1.y; bias[6] = b1.z; bias[7] = b1.w; }
        const bf16* src = projb + (size_t)t0 * NB_LD + NB_XBC + c;
        v4u raw[19];
#pragma unroll
        for (int s = 0; s < 19; ++s) { v4u z; z.x = 0u; z.y = 0u; z.z = 0u; z.w = 0u; raw[s] = (s >= 3 || i0 != 0) ? *(const v4u*)(src + (ptrdiff_t)(s - 3) * NB_LD) : z; }
        float p0[8], p1[8], p2[8];
        unpack8(raw[0], p0); unpack8(raw[1], p1); unpack8(raw[2], p2);
#pragma unroll
        for (int s = 0; s < 16; ++s) {
            float cur[8], acc[8]; unpack8(raw[s + 3], cur);
#pragma unroll
            for (int j = 0; j < 8; ++j) acc[j] = silu_f(bias[j] + p0[j] * w[0][j] + p1[j] * w[1][j] + p2[j] * w[2][j] + cur[j] * w[3][j]);
            v4u o; o.x = pk2(acc[0], acc[1]); o.y = pk2(acc[2], acc[3]); o.z = pk2(acc[4], acc[5]); o.w = pk2(acc[6], acc[7]);
            *(v4u*)(xbc_b + (size_t)(t0 + s) * CONV_DIM + c) = o;
            if (i0 + s >= SEQ - 3) store8f(out + OUT_PC + ((size_t)b * 3 + (i0 + s - (SEQ - 3))) * CONV_DIM + c, cur);
#pragma unroll
            for (int j = 0; j < 8; ++j) { p0[j] = p1[j]; p1[j] = p2[j]; p2[j] = cur[j]; }
        }
    }
#pragma unroll 4
    for (int item = gtid; item < T_PROMPT * 128; item += gsz) {
        const int t = item >> 7, sub = item & 127, which = sub >> 6, h = (sub >> 3) & 7, jc = sub & 7, i = t & (SEQ - 1), b = t >> 13;
        const bf16* src = projb + (size_t)t * NB_LD + (which ? NB_K : NB_Q) + h * 64 + jc * 4;
        const uint2 lo = *(const uint2*)src, hi = *(const uint2*)(src + 32);
        const float4 cs = *(const float4*)(rope_tab + (size_t)i * 64 + jc * 4), sn = *(const float4*)(rope_tab + (size_t)i * 64 + 32 + jc * 4);
        float t1[4], t2[4], o1[4], o2[4];
        t1[0] = __builtin_bit_cast(float, lo.x << 16); t1[1] = __builtin_bit_cast(float, lo.x & 0xffff0000u); t1[2] = __builtin_bit_cast(float, lo.y << 16); t1[3] = __builtin_bit_cast(float, lo.y & 0xffff0000u);
        t2[0] = __builtin_bit_cast(float, hi.x << 16); t2[1] = __builtin_bit_cast(float, hi.x & 0xffff0000u); t2[2] = __builtin_bit_cast(float, hi.y << 16); t2[3] = __builtin_bit_cast(float, hi.y & 0xffff0000u);
        const float cv[4] = {cs.x, cs.y, cs.z, cs.w}, sv[4] = {sn.x, sn.y, sn.z, sn.w};
#pragma unroll
        for (int e = 0; e < 4; ++e) { o1[e] = t1[e] * cv[e] - t2[e] * sv[e]; o2[e] = t2[e] * cv[e] + t1[e] * sv[e]; }
        const size_t doff = (size_t)t * ATT_WIDTH + h * 64 + jc * 4;
        bf16* db = which ? krot_b : qrot_b;
        *(uint2*)(db + doff) = make_uint2(pk2(o1[0], o1[1]), pk2(o1[2], o1[3])); *(uint2*)(db + doff + 32) = make_uint2(pk2(o2[0], o2[1]), pk2(o2[2], o2[3]));
        if (which && i >= SEQ - WBUF) {
            float* o = out + OUT_PK + ((size_t)b * WBUF + (i - (SEQ - WBUF))) * ATT_WIDTH + h * 64 + jc * 4;
            *(float4*)o = make_float4(o1[0], o1[1], o1[2], o1[3]); *(float4*)(o + 32) = make_float4(o2[0], o2[1], o2[2], o2[3]);
        }
    }
#pragma unroll 4
    for (int item = gtid; item < T_PROMPT * SSD_HEADS; item += gsz) { const int t = item / SSD_HEADS, hd = item - t * SSD_HEADS; dtv[item] = softplus_f(dtraw[(size_t)t * 32 + hd] + dt_bias[hd]); }
#pragma unroll 2
    for (int item = gtid; item < BATCH * WBUF * 64; item += gsz) {
        const int ch = item & 63, j = (item >> 6) & (WBUF - 1), b = item >> 17;
        float f[8]; unpack8(*(const v4u*)(projb + (size_t)(b * SEQ + (SEQ - WBUF) + j) * NB_LD + NB_V + ch * 8), f);
        store8f(out + OUT_PV + ((size_t)b * WBUF + j) * ATT_WIDTH + ch * 8, f);
    }
}

#define SSD_CH 32
__device__ __forceinline__ void ph_ssd_naive(float* lds, const bf16* __restrict__ xbc_act, const float* __restrict__ dtv, const float* __restrict__ a_log,
                                             const float* __restrict__ d_skip, const float* __restrict__ state_ssm, float* __restrict__ ybuf, float* __restrict__ out) {
    float (*sx)[64] = (float (*)[64])lds;
    float (*sB)[128] = (float (*)[128])(lds + SSD_CH * 64);
    float (*sC)[128] = (float (*)[128])(lds + SSD_CH * 64 + SSD_CH * 128);
    float* sdt = lds + SSD_CH * 64 + 2 * SSD_CH * 128;
    const int tid = threadIdx.x, p = tid >> 3, ng = tid & 7;
    for (int vb = BATCH * SSD_HEADS + blockIdx.x; vb < (BATCH + DEC_BATCH) * SSD_HEADS; vb += gridDim.x) {
        const int seq = vb / SSD_HEADS, h = vb % SSD_HEADS, g = h / 6;
        const bool is_p = seq < BATCH;
        const int L = is_p ? SEQ : DEC_SEQ;
        const int t0 = is_p ? seq * SEQ : T_PROMPT + (seq - BATCH) * DEC_SEQ;
        const float A = -__expf(a_log[h]);
        const float D = d_skip[h];
        float hs[16];
        if (is_p) {
#pragma unroll
            for (int j = 0; j < 16; ++j) hs[j] = 0.f;
        } else {
            const float* s0 = state_ssm + (((size_t)(seq - BATCH) * SSD_HEADS + h) * 64 + p) * 128 + ng * 16;
#pragma unroll
            for (int j = 0; j < 16; ++j) hs[j] = s0[j];
        }
        for (int c0 = 0; c0 < L; c0 += SSD_CH) {
            const int nst = (L - c0) < SSD_CH ? (L - c0) : SSD_CH;
            __syncthreads();
            for (int idx = tid; idx < nst * 64; idx += NTHR) { int s = idx >> 6, c = idx & 63; sx[s][c] = bf2f(xbc_act[(size_t)(t0 + c0 + s) * CONV_DIM + h * 64 + c]); }
            for (int idx = tid; idx < nst * 128; idx += NTHR) { int s = idx >> 7, c = idx & 127;
                sB[s][c] = bf2f(xbc_act[(size_t)(t0 + c0 + s) * CONV_DIM + 1536 + g * 128 + c]);
                sC[s][c] = bf2f(xbc_act[(size_t)(t0 + c0 + s) * CONV_DIM + 2048 + g * 128 + c]); }
            if (tid < nst) sdt[tid] = dtv[(size_t)(t0 + c0 + tid) * SSD_HEADS + h];
            __syncthreads();
            for (int s = 0; s < nst; ++s) {
                const float dt = sdt[s], x = sx[s][p];
                const float a = __expf(dt * A), xdt = x * dt;
                float y = 0.f;
#pragma unroll
                for (int j = 0; j < 16; ++j) { hs[j] = a * hs[j] + xdt * sB[s][ng * 16 + j]; y += sC[s][ng * 16 + j] * hs[j]; }
                y += __shfl_xor(y, 1); y += __shfl_xor(y, 2); y += __shfl_xor(y, 4);
                if (ng == 0) ybuf[(size_t)(t0 + c0 + s) * MIX_WIDTH + h * 64 + p] = y + D * x;
            }
        }
        float* so = is_p ? out + OUT_PS + (((size_t)seq * SSD_HEADS + h) * 64 + p) * 128 + ng * 16
                         : out + OUT_SS + (((size_t)(seq - BATCH) * SSD_HEADS + h) * 64 + p) * 128 + ng * 16;
#pragma unroll
        for (int j = 0; j < 16; ++j) so[j] = hs[j];
    }
}

__device__ __forceinline__ void ph_gate_norm(const bf16* __restrict__ projb, const float* __restrict__ norm_g, const float* __restrict__ ybuf, bf16* __restrict__ A1) {
    const int w = threadIdx.x >> 6, lane = threadIdx.x & 63, g = w & 3;
    for (int t = T_PROMPT + 2 * blockIdx.x + (w >> 2); t < T_ALL; t += 2 * gridDim.x) {
        float v[6]; float ss = 0.f;
#pragma unroll
        for (int j = 0; j < 6; ++j) {
            int c = g * 384 + j * 64 + lane;
            float y = ybuf[(size_t)t * MIX_WIDTH + c], z = bf2f(projb[(size_t)t * NB_LD + c]);
            v[j] = y * silu_f(z); ss += v[j] * v[j];
        }
        ss = wave_sum(ss);
        const float r = rsqrtf(ss * (1.0f / 384.0f) + LN_EPS);
#pragma unroll
        for (int j = 0; j < 6; ++j) { int c = g * 384 + j * 64 + lane; A1[(size_t)t * MIX_WIDTH + c] = (bf16)f2bf(v[j] * r * norm_g[c]); }
    }
}

__device__ __forceinline__ void ph_attn_naive(float* lds, const float* __restrict__ proj, const float* __restrict__ qrot, const float* __restrict__ krot,
                                              const float* __restrict__ ck, const float* __restrict__ cv, float* __restrict__ ybuf) {
    float (*sq)[64] = (float (*)[64])lds;
    const int w = threadIdx.x >> 6, lane = threadIdx.x & 63;
    for (int vb = blockIdx.x; vb < T_SAMPLE * 8 / NWAVE; vb += gridDim.x) {
        const int item = T_PROMPT * 8 + vb * NWAVE + w;
        const int t = item >> 3, h = item & 7;
        const bool is_p = t < T_PROMPT;
        int b, i;
        if (is_p) { b = t / SEQ; i = t % SEQ; } else { int ts = t - T_PROMPT; b = ts / DEC_SEQ; i = ts % DEC_SEQ; }
        __syncthreads();
        sq[w][lane] = qrot[(size_t)t * ATT_WIDTH + h * 64 + lane];
        __syncthreads();
        const int qi = is_p ? i : WBUF + i;
        float sc[3][3];
        float mx = -INFINITY;
#pragma unroll
        for (int pt = 0; pt < 3; ++pt) {
            const int d = pt == 0 ? 1 : (pt == 1 ? 4 : 16);
#pragma unroll
            for (int sl = 0; sl < 3; ++sl) {
                const int m = lane + sl * 64;
                float s = -INFINITY;
                const int kj = qi - d * m;
                if (m <= 128 && kj >= 0) {
                    const float* kr;
                    if (is_p) kr = krot + (size_t)(b * SEQ + kj) * ATT_WIDTH + h * 64;
                    else kr = (kj >= WBUF) ? krot + (size_t)(T_PROMPT + b * DEC_SEQ + (kj - WBUF)) * ATT_WIDTH + h * 64
                                           : ck + ((size_t)b * WBUF + kj) * ATT_WIDTH + h * 64;
                    float a = 0.f;
#pragma unroll
                    for (int c = 0; c < 64; c += 4) { float4 kv = *(const float4*)(kr + c); a += kv.x * sq[w][c] + kv.y * sq[w][c + 1] + kv.z * sq[w][c + 2] + kv.w * sq[w][c + 3]; }
                    s = a * 0.125f;
                }
                sc[pt][sl] = s; mx = fmaxf(mx, s);
            }
        }
        mx = wave_max(mx);
        float lsum = 0.f;
#pragma unroll
        for (int pt = 0; pt < 3; ++pt)
#pragma unroll
            for (int sl = 0; sl < 3; ++sl) { float pv = (sc[pt][sl] == -INFINITY) ? 0.f : __expf(sc[pt][sl] - mx); sc[pt][sl] = pv; lsum += pv; }
        lsum = wave_sum(lsum);
        float o = 0.f;
#pragma unroll
        for (int pt = 0; pt < 3; ++pt) {
            const int d = pt == 0 ? 1 : (pt == 1 ? 4 : 16);
#pragma unroll
            for (int sl = 0; sl < 3; ++sl) {
                const int mend = sl < 2 ? 64 : 1;
                for (int ml = 0; ml < mend; ++ml) {
                    const int m = ml + sl * 64;
                    const int kj = qi - d * m;
                    const float pv = __shfl(sc[pt][sl], ml);
                    if (kj < 0) continue;
                    const float* vr;
                    if (is_p) vr = proj + (size_t)(b * SEQ + kj) * PROJ_LD + O_V + h * 64;
                    else vr = (kj >= WBUF) ? proj + (size_t)(T_PROMPT + b * DEC_SEQ + (kj - WBUF)) * PROJ_LD + O_V + h * 64
                                           : cv + ((size_t)b * WBUF + kj) * ATT_WIDTH + h * 64;
                    o += pv * vr[lane];
                }
            }
        }
        ybuf[(size_t)t * MIX_WIDTH + SSD_WIDTH + h * 64 + lane] = o / lsum;
    }
}

__device__ __forceinline__ void ph_ln_res(const float* __restrict__ xp, const float* __restrict__ xs, const bf16* __restrict__ add, const float* __restrict__ gam,
                                          const float* __restrict__ bet, bf16* __restrict__ dstb) {
    const int lane = threadIdx.x & 63;
#pragma unroll 2
    for (int t = blockIdx.x * NWAVE + (threadIdx.x >> 6); t < T_ALL; t += gridDim.x * NWAVE) {
        const float* res = (t < T_PROMPT) ? xp + (size_t)t * D_MODEL : xs + (size_t)(t - T_PROMPT) * D_MODEL;
        float v[16]; float s = 0.f;
#pragma unroll
        for (int j = 0; j < 2; ++j) { const int c = j * 512 + lane * 8; const float4 r0 = *(const float4*)(res + c), r1 = *(const float4*)(res + c + 4);
            float a8[8]; unpack8(*(const v4u*)(add + (size_t)t * D_MODEL + c), a8);
            v[8 * j] = ALPHA_F * r0.x + a8[0]; v[8 * j + 1] = ALPHA_F * r0.y + a8[1]; v[8 * j + 2] = ALPHA_F * r0.z + a8[2]; v[8 * j + 3] = ALPHA_F * r0.w + a8[3];
            v[8 * j + 4] = ALPHA_F * r1.x + a8[4]; v[8 * j + 5] = ALPHA_F * r1.y + a8[5]; v[8 * j + 6] = ALPHA_F * r1.z + a8[6]; v[8 * j + 7] = ALPHA_F * r1.w + a8[7]; }
#pragma unroll
        for (int j = 0; j < 16; ++j) s += v[j];
        s = wave_sum(s);
        const float mu = s * (1.0f / 1024.0f);
        float q = 0.f;
#pragma unroll
        for (int j = 0; j < 16; ++j) { v[j] -= mu; q += v[j] * v[j]; }
        q = wave_sum(q);
        const float r = rsqrtf(q * (1.0f / 1024.0f) + LN_EPS);
#pragma unroll
        for (int j = 0; j < 2; ++j) { const int c = j * 512 + lane * 8; const float4 g0 = *(const float4*)(gam + c), g1 = *(const float4*)(gam + c + 4), b0 = *(const float4*)(bet + c), b1 = *(const float4*)(bet + c + 4);
            v4u o; o.x = pk2(v[8 * j] * r * g0.x + b0.x, v[8 * j + 1] * r * g0.y + b0.y); o.y = pk2(v[8 * j + 2] * r * g0.z + b0.z, v[8 * j + 3] * r * g0.w + b0.w);
            o.z = pk2(v[8 * j + 4] * r * g1.x + b1.x, v[8 * j + 5] * r * g1.y + b1.y); o.w = pk2(v[8 * j + 6] * r * g1.z + b1.z, v[8 * j + 7] * r * g1.w + b1.w);
            *(v4u*)(dstb + (size_t)t * D_MODEL + c) = o; }
    }
}

__device__ __forceinline__ void ph_peer_route(float* lds, const float* __restrict__ qh, const float* __restrict__ keys1, const float* __restrict__ keys2,
                                              int* __restrict__ eidx, float* __restrict__ gate) {
    float (*sq)[256] = (float (*)[256])lds;
    float (*sv)[2][16] = (float (*)[2][16])(lds + NWAVE * 256);
    int (*si)[2][16] = (int (*)[2][16])(lds + NWAVE * 256 + NWAVE * 32);
    const int w = threadIdx.x >> 6, lane = threadIdx.x & 63;
    for (int vb = blockIdx.x; vb < T_ALL * 8 / NWAVE; vb += gridDim.x) {
        const int item = vb * NWAVE + w;
        const int t = item >> 3, h = item & 7;
        __syncthreads();
        for (int c = lane; c < 256; c += 64) sq[w][c] = qh[(size_t)t * 2048 + h * 256 + c];
        __syncthreads();
#pragma unroll
        for (int half = 0; half < 2; ++half) {
            const float* keys = half ? keys2 : keys1;
            float s[2];
#pragma unroll
            for (int sl = 0; sl < 2; ++sl) {
                const float* kr = keys + (size_t)(lane + sl * 64) * 128;
                float a = 0.f;
#pragma unroll 8
                for (int c = 0; c < 128; c += 4) { float4 kv = *(const float4*)(kr + c); const float* qq = &sq[w][half * 128 + c]; a += kv.x * qq[0] + kv.y * qq[1] + kv.z * qq[2] + kv.w * qq[3]; }
                s[sl] = a;
            }
            for (int r = 0; r < 16; ++r) {
                float bv; int bi;
                if (s[0] >= s[1]) { bv = s[0]; bi = lane; } else { bv = s[1]; bi = lane + 64; }
#pragma unroll
                for (int o = 32; o > 0; o >>= 1) {
                    float ov = __shfl_xor(bv, o); int oi = __shfl_xor(bi, o);
                    if (ov > bv || (ov == bv && oi < bi)) { bv = ov; bi = oi; }
                }
                if (lane == 0) { sv[w][half][r] = bv; si[w][half][r] = bi; }
                if (bi == lane) s[0] = -INFINITY;
                if (bi == lane + 64) s[1] = -INFINITY;
            }
        }
        __syncthreads();
        float c[4];
#pragma unroll
        for (int j = 0; j < 4; ++j) { int ci = lane * 4 + j; c[j] = sv[w][0][ci >> 4] + sv[w][1][ci & 15]; }
        float myv = 0.f; int myc = 0;
        for (int r = 0; r < 16; ++r) {
            float bv = c[0]; int bi = lane * 4;
#pragma unroll
            for (int j = 1; j < 4; ++j) if (c[j] > bv) { bv = c[j]; bi = lane * 4 + j; }
#pragma unroll
            for (int o = 32; o > 0; o >>= 1) {
                float ov = __shfl_xor(bv, o); int oi = __shfl_xor(bi, o);
                if (ov > bv || (ov == bv && oi < bi)) { bv = ov; bi = oi; }
            }
            if (lane == r) { myv = bv; myc = bi; }
#pragma unroll
            for (int j = 0; j < 4; ++j) if (bi == lane * 4 + j) c[j] = -INFINITY;
        }
        float v = lane < 16 ? myv : -INFINITY;
        float mx = wave_max(v);
        float e = lane < 16 ? __expf(v - mx) : 0.f;
        float sum = wave_sum(e);
        if (lane < 16) {
            int ex = si[w][0][myc >> 4] * PEER_NKEYS + si[w][1][myc & 15];
            eidx[(size_t)t * 128 + h * 16 + lane] = ex;
            gate[(size_t)t * 128 + h * 16 + lane] = e / sum;
        }
    }
}

__device__ __forceinline__ void ph_peer_ffn(const float* __restrict__ hbuf, const int* __restrict__ eidx, const float* __restrict__ gate,
                                            const bf16* __restrict__ ub, const bf16* __restrict__ vb, const float* __restrict__ gam,
                                            const float* __restrict__ bet, float* __restrict__ out) {
    const int lane = threadIdx.x & 63;
    for (int t = blockIdx.x * NWAVE + (threadIdx.x >> 6); t < T_ALL; t += gridDim.x * NWAVE) {
        float x[16], acc[16];
        { const float* xr = hbuf + (size_t)t * D_MODEL + lane * 8;
          const float4 a = *(const float4*)xr, b = *(const float4*)(xr + 4), c = *(const float4*)(xr + 512), d = *(const float4*)(xr + 516);
          x[0] = a.x; x[1] = a.y; x[2] = a.z; x[3] = a.w; x[4] = b.x; x[5] = b.y; x[6] = b.z; x[7] = b.w;
          x[8] = c.x; x[9] = c.y; x[10] = c.z; x[11] = c.w; x[12] = d.x; x[13] = d.y; x[14] = d.z; x[15] = d.w; }
#pragma unroll
        for (int j = 0; j < 16; ++j) acc[j] = 0.f;
        for (int k = 0; k < 128; ++k) {
            const int e = eidx[(size_t)t * 128 + k];
            const float g = gate[(size_t)t * 128 + k];
            const bf16* ur = ub + (size_t)e * D_MODEL + lane * 8;
            float u0[8], u1[8];
            unpack8(*(const v4u*)ur, u0); unpack8(*(const v4u*)(ur + 512), u1);
            float d = 0.f;
#pragma unroll
            for (int j = 0; j < 8; ++j) d += u0[j] * x[j] + u1[j] * x[8 + j];
            d = wave_sum(d);
            const float wgt = g * gelu_f(d);
            const bf16* vr = vb + (size_t)e * D_MODEL + lane * 8;
            unpack8(*(const v4u*)vr, u0); unpack8(*(const v4u*)(vr + 512), u1);
#pragma unroll
            for (int j = 0; j < 8; ++j) { acc[j] += wgt * u0[j]; acc[8 + j] += wgt * u1[j]; }
        }
        float s = 0.f;
#pragma unroll
        for (int j = 0; j < 16; ++j) { acc[j] += ALPHA_F * x[j]; s += acc[j]; }
        s = wave_sum(s);
        const float mu = s * (1.0f / 1024.0f);
        float q = 0.f;
#pragma unroll
        for (int j = 0; j < 16; ++j) { acc[j] -= mu; q += acc[j] * acc[j]; }
        q = wave_sum(q);
        const float r = rsqrtf(q * (1.0f / 1024.0f) + LN_EPS);
        float* dst = ((t < T_PROMPT) ? out + OUT_YP + (size_t)t * D_MODEL : out + OUT_YS + (size_t)(t - T_PROMPT) * D_MODEL) + lane * 8;
#pragma unroll
        for (int q4 = 0; q4 < 4; ++q4) {
            const int eo = (q4 >> 1) * 512 + (q4 & 1) * 4;
            const float4 g4 = *(const float4*)(gam + lane * 8 + eo), b4 = *(const float4*)(bet + lane * 8 + eo);
            float4 o; o.x = acc[q4 * 4 + 0] * r * g4.x + b4.x; o.y = acc[q4 * 4 + 1] * r * g4.y + b4.y; o.z = acc[q4 * 4 + 2] * r * g4.z + b4.z; o.w = acc[q4 * 4 + 3] * r * g4.w + b4.w;
            *(float4*)(dst + eo) = o;
        }
    }
}

__device__ __forceinline__ float peer_dot16(const v4u a, const v4u b, const float (&x)[16]) {
    float u0[8], u1[8]; unpack8(a, u0); unpack8(b, u1);
    float d = 0.f;
#pragma unroll
    for (int j = 0; j < 8; ++j) d += u0[j] * x[j] + u1[j] * x[8 + j];
    return d;
}
#define PEER_TR_STEP(N, M) _Pragma("unroll") for (int i = 0; i < N; ++i) { const bool up = (lane & M) != 0; const float keep = up ? part[i + N] : part[i]; const float send = up ? part[i] : part[i + N]; part[i] = keep + __shfl_xor(send, M); }
__device__ __forceinline__ void ph_peer_ffn2(const float* __restrict__ hbuf, const int* __restrict__ eidx, const float* __restrict__ gate,
                                             const bf16* __restrict__ ub, const bf16* __restrict__ vb, const float* __restrict__ gam,
                                             const float* __restrict__ bet, float* __restrict__ out) {
    const int lane0 = threadIdx.x & 63;
    for (int t = blockIdx.x * NWAVE + (threadIdx.x >> 6); t < T_ALL; t += gridDim.x * NWAVE) {
        int lane = lane0; asm volatile("" : "+v"(lane));
        float x[16];
        { const float* xr = hbuf + (size_t)t * D_MODEL + lane * 8;
          const float4 a = *(const float4*)xr, b = *(const float4*)(xr + 4), c = *(const float4*)(xr + 512), d = *(const float4*)(xr + 516);
          x[0] = a.x; x[1] = a.y; x[2] = a.z; x[3] = a.w; x[4] = b.x; x[5] = b.y; x[6] = b.z; x[7] = b.w;
          x[8] = c.x; x[9] = c.y; x[10] = c.z; x[11] = c.w; x[12] = d.x; x[13] = d.y; x[14] = d.z; x[15] = d.w; }
        int ev[2]; float wv[4];
        ev[0] = eidx[(size_t)t * 128 + lane]; ev[1] = eidx[(size_t)t * 128 + 64 + lane];
#pragma unroll
        for (int rd = 0; rd < 4; ++rd) wv[rd] = gate[(size_t)t * 128 + rd * 32 + (lane >> 1)];
#pragma unroll
        for (int rd = 0; rd < 4; ++rd) {
            float part[32];
#pragma unroll
            for (int kb = 0; kb < 8; ++kb) {
                v4u ra[4], rb[4];
#pragma unroll
                for (int k8 = 0; k8 < 4; ++k8) {
                    const int e = __builtin_amdgcn_readlane(ev[rd >> 1], (rd & 1) * 32 + kb * 4 + k8);
                    const bf16* ur = ub + (size_t)e * D_MODEL + lane * 8;
                    ra[k8] = *(const v4u*)ur; rb[k8] = *(const v4u*)(ur + 512);
                }
#pragma unroll
                for (int k8 = 0; k8 < 4; ++k8) part[kb * 4 + k8] = peer_dot16(ra[k8], rb[k8], x);
            }
            PEER_TR_STEP(16, 32) PEER_TR_STEP(8, 16) PEER_TR_STEP(4, 8) PEER_TR_STEP(2, 4) PEER_TR_STEP(1, 2)
            const float hid = part[0] + __shfl_xor(part[0], 1);
            wv[rd] *= gelu_f(hid);
        }
        float acc[16];
#pragma unroll
        for (int j = 0; j < 16; ++j) acc[j] = 0.f;
#pragma unroll
        for (int rd = 0; rd < 4; ++rd) {
#pragma unroll
            for (int kb = 0; kb < 4; ++kb) {
                v4u ra[8], rb[8];
#pragma unroll
                for (int k8 = 0; k8 < 8; ++k8) {
                    const int e = __builtin_amdgcn_readlane(ev[rd >> 1], (rd & 1) * 32 + kb * 8 + k8);
                    const bf16* vr = vb + (size_t)e * D_MODEL + lane * 8;
                    ra[k8] = *(const v4u*)vr; rb[k8] = *(const v4u*)(vr + 512);
                }
#pragma unroll
                for (int k8 = 0; k8 < 8; ++k8) {
                    const float wk = __builtin_bit_cast(float, __builtin_amdgcn_readlane(__builtin_bit_cast(int, wv[rd]), 2 * (kb * 8 + k8)));
                    float u0[8], u1[8]; unpack8(ra[k8], u0); unpack8(rb[k8], u1);
#pragma unroll
                    for (int j = 0; j < 8; ++j) { acc[j] += wk * u0[j]; acc[8 + j] += wk * u1[j]; }
                }
            }
        }
        float s = 0.f;
#pragma unroll
        for (int j = 0; j < 16; ++j) { acc[j] += ALPHA_F * x[j]; s += acc[j]; }
        s = wave_sum(s);
        const float mu = s * (1.0f / 1024.0f);
        float q = 0.f;
#pragma unroll
        for (int j = 0; j < 16; ++j) { acc[j] -= mu; q += acc[j] * acc[j]; }
        q = wave_sum(q);
        const float r = rsqrtf(q * (1.0f / 1024.0f) + LN_EPS);
        float* dst = ((t < T_PROMPT) ? out + OUT_YP + (size_t)t * D_MODEL : out + OUT_YS + (size_t)(t - T_PROMPT) * D_MODEL) + lane * 8;
#pragma unroll
        for (int q4 = 0; q4 < 4; ++q4) {
            const int eo = (q4 >> 1) * 512 + (q4 & 1) * 4;
            const float4 g4 = *(const float4*)(gam + lane * 8 + eo), b4 = *(const float4*)(bet + lane * 8 + eo);
            float4 o; o.x = acc[q4 * 4 + 0] * r * g4.x + b4.x; o.y = acc[q4 * 4 + 1] * r * g4.y + b4.y; o.z = acc[q4 * 4 + 2] * r * g4.z + b4.z; o.w = acc[q4 * 4 + 3] * r * g4.w + b4.w;
            *(float4*)(dst + eo) = o;
        }
    }
}

__device__ __forceinline__ void ph_attn_sample(float* lds, const bf16* __restrict__ qrot_b, const bf16* __restrict__ krot_b, const bf16* __restrict__ projb,
                                               const float* __restrict__ ck, const float* __restrict__ cv, bf16* __restrict__ A1) {
    float (*sq)[64] = (float (*)[64])lds;
    const int w = threadIdx.x >> 6, lane0 = threadIdx.x & 63;
    for (int vb = blockIdx.x; vb < T_SAMPLE * 8 / NWAVE; vb += gridDim.x) {
        int lane = lane0; asm volatile("" : "+v"(lane));
        const int item = vb * NWAVE + w, ts = item >> 3, hd = item & 7, b = ts >> 2, i = ts & 3, t = T_PROMPT + ts;
        __syncthreads();
        sq[w][lane] = bf2f(qrot_b[(size_t)t * ATT_WIDTH + hd * 64 + lane]);
        __syncthreads();
        const int qi = WBUF + i;
        float sc[8];
        float mx = -INFINITY;
#pragma unroll
        for (int slot = 0; slot < 7; ++slot) {
            const int pt = slot < 6 ? (slot >> 1) : (lane < 3 ? lane : 0);
            const int m = slot < 6 ? lane + 64 * (slot & 1) : 128;
            const int kj = qi - (m << (2 * pt));
            const bool valid = (slot < 6 || lane < 3) && kj < WBUF;
            const int kc = kj < WBUF ? kj : WBUF - 1;
            const float* kr = ck + ((size_t)b * WBUF + kc) * ATT_WIDTH + hd * 64;
            float a = 0.f;
#pragma unroll
            for (int c = 0; c < 64; c += 4) { const float4 kv = *(const float4*)(kr + c); a += kv.x * sq[w][c] + kv.y * sq[w][c + 1] + kv.z * sq[w][c + 2] + kv.w * sq[w][c + 3]; }
            const float s = valid ? a * 0.125f : -INFINITY;
            sc[slot] = s; mx = fmaxf(mx, s);
        }
        const int nt7 = lane <= i ? i - lane : i;
        const bool valid7 = lane < i + 3;
        {
            const bf16* kr = krot_b + (size_t)(T_PROMPT + b * DEC_SEQ + nt7) * ATT_WIDTH + hd * 64;
            float a = 0.f;
#pragma unroll
            for (int c = 0; c < 64; c += 8) { float f[8]; unpack8(*(const v4u*)(kr + c), f);
#pragma unroll
                for (int j = 0; j < 8; ++j) a += f[j] * sq[w][c + j]; }
            const float s = valid7 ? a * 0.125f : -INFINITY;
            sc[7] = s; mx = fmaxf(mx, s);
        }
        mx = wave_max(mx);
        float lsum = 0.f;
#pragma unroll
        for (int slot = 0; slot < 8; ++slot) { const float pv = __expf(sc[slot] - mx); sc[slot] = pv; lsum += pv; }
        lsum = wave_sum(lsum);
        float part[64];
#pragma unroll
        for (int c = 0; c < 64; ++c) part[c] = 0.f;
#pragma unroll
        for (int slot = 0; slot < 7; ++slot) {
            const int pt = slot < 6 ? (slot >> 1) : (lane < 3 ? lane : 0);
            const int m = slot < 6 ? lane + 64 * (slot & 1) : 128;
            const int kj = qi - (m << (2 * pt));
            const int kc = kj < WBUF ? kj : WBUF - 1;
            const float pv = sc[slot];
            const float* vr = cv + ((size_t)b * WBUF + kc) * ATT_WIDTH + hd * 64;
#pragma unroll
            for (int c = 0; c < 64; c += 4) { const float4 vv = *(const float4*)(vr + c); part[c] += pv * vv.x; part[c + 1] += pv * vv.y; part[c + 2] += pv * vv.z; part[c + 3] += pv * vv.w; }
        }
        {
            const float pv = sc[7];
            const bf16* vr = projb + (size_t)(T_PROMPT + b * DEC_SEQ + nt7) * NB_LD + NB_V + hd * 64;
#pragma unroll
            for (int c = 0; c < 64; c += 8) { float f[8]; unpack8(*(const v4u*)(vr + c), f);
#pragma unroll
                for (int j = 0; j < 8; ++j) part[c + j] += pv * f[j]; }
        }
        PEER_TR_STEP(32, 32) PEER_TR_STEP(16, 16) PEER_TR_STEP(8, 8) PEER_TR_STEP(4, 4) PEER_TR_STEP(2, 2) PEER_TR_STEP(1, 1)
        A1[(size_t)t * MIX_WIDTH + SSD_WIDTH + hd * 64 + lane] = (bf16)f2bf(part[0] / lsum);
    }
}


__device__ __forceinline__ void cache_copy_slice(const float* __restrict__ ck, const float* __restrict__ cv, float* __restrict__ out, unsigned slice, unsigned lane) {
    constexpr unsigned PER_B = (WBUF - DEC_SEQ) * ATT_WIDTH / 4;
    constexpr unsigned TOTAL = 2u * DEC_BATCH * PER_B;
#pragma unroll 1
    for (unsigned bt = 0; bt < 8; ++bt) {
        f32x4n v[8]; size_t dsti[8]; bool isv[8]; bool ok[8];
#pragma unroll
        for (int j = 0; j < 8; ++j) {
            const unsigned idx = slice * 4096u + bt * 512u + j * 64u + lane;
            ok[j] = idx < TOTAL;
            const unsigned idc = ok[j] ? idx : 0u;
            const unsigned tb = idc / PER_B, r = idc - tb * PER_B, bb = tb & (DEC_BATCH - 1);
            isv[j] = tb >= DEC_BATCH;
            const size_t srci = (size_t)bb * (WBUF * ATT_WIDTH / 4) + (DEC_SEQ * ATT_WIDTH / 4) + r;
            dsti[j] = (size_t)bb * (WBUF * ATT_WIDTH / 4) + r;
            v[j] = __builtin_nontemporal_load((isv[j] ? (const f32x4n*)cv : (const f32x4n*)ck) + srci);
        }
#pragma unroll
        for (int j = 0; j < 8; ++j) if (ok[j]) __builtin_nontemporal_store(v[j], (f32x4n*)(out + (isv[j] ? OUT_SV : OUT_SK)) + dsti[j]);
    }
}

__device__ __forceinline__ void copy_q_load(const float* __restrict__ ck, const float* __restrict__ cv, unsigned q, unsigned lane, f32x4n (&v)[16]) {
    constexpr unsigned PER_B = (WBUF - DEC_SEQ) * ATT_WIDTH / 4, TOTAL = 2u * DEC_BATCH * PER_B;
#pragma unroll
    for (int j = 0; j < 16; ++j) {
        const unsigned idx = q * 1024u + j * 64u + lane, idc = idx < TOTAL ? idx : 0u;
        const unsigned tb = idc / PER_B, r = idc - tb * PER_B, bb = tb & (DEC_BATCH - 1);
        const size_t srci = (size_t)bb * (WBUF * ATT_WIDTH / 4) + (DEC_SEQ * ATT_WIDTH / 4) + r;
        v[j] = __builtin_nontemporal_load((tb >= DEC_BATCH ? (const f32x4n*)cv : (const f32x4n*)ck) + srci);
    }
}
__device__ __forceinline__ void copy_q_store(float* __restrict__ out, unsigned q, unsigned lane, const f32x4n (&v)[16]) {
    constexpr unsigned PER_B = (WBUF - DEC_SEQ) * ATT_WIDTH / 4, TOTAL = 2u * DEC_BATCH * PER_B;
#pragma unroll
    for (int j = 0; j < 16; ++j) {
        const unsigned idx = q * 1024u + j * 64u + lane;
        if (idx < TOTAL) {
            const unsigned tb = idx / PER_B, r = idx - tb * PER_B, bb = tb & (DEC_BATCH - 1);
            const size_t dsti = (size_t)bb * (WBUF * ATT_WIDTH / 4) + r;
            __builtin_nontemporal_store(v[j], (f32x4n*)(out + (tb >= DEC_BATCH ? OUT_SV : OUT_SK)) + dsti);
        }
    }
}
typedef float f32x2v __attribute__((ext_vector_type(2)));
__device__ __forceinline__ void ph_quant_tables(const float* __restrict__ pu, const float* __restrict__ pv, unsigned char* __restrict__ ub8, unsigned char* __restrict__ vb8,
                                                float* __restrict__ usc, float* __restrict__ vsc, int rank, int nranks) {
    const int lane = threadIdx.x & 63;
#pragma unroll 2
    for (int row = rank * NWAVE + (threadIdx.x >> 6); row < 2 * 16384; row += nranks * NWAVE) {
        const int rr = row & 16383; const bool isv = row >= 16384;
        const float* src = (isv ? pv : pu) + (size_t)rr * D_MODEL + lane * 8;
        const float4 a = *(const float4*)src, b = *(const float4*)(src + 4), c = *(const float4*)(src + 512), d = *(const float4*)(src + 516);
        float am = fmaxf(fmaxf(fmaxf(fabsf(a.x), fabsf(a.y)), fmaxf(fabsf(a.z), fabsf(a.w))), fmaxf(fmaxf(fabsf(b.x), fabsf(b.y)), fmaxf(fabsf(b.z), fabsf(b.w))));
        am = fmaxf(am, fmaxf(fmaxf(fmaxf(fabsf(c.x), fabsf(c.y)), fmaxf(fabsf(c.z), fabsf(c.w))), fmaxf(fmaxf(fabsf(d.x), fabsf(d.y)), fmaxf(fabsf(d.z), fabsf(d.w)))));
        am = wave_max(am);
        const float sc = am > 0.f ? 224.0f / am : 1.0f;
        v4u o;
        o.x = (unsigned)__builtin_amdgcn_cvt_pk_fp8_f32(a.z * sc, a.w * sc, __builtin_amdgcn_cvt_pk_fp8_f32(a.x * sc, a.y * sc, 0, false), true);
        o.y = (unsigned)__builtin_amdgcn_cvt_pk_fp8_f32(b.z * sc, b.w * sc, __builtin_amdgcn_cvt_pk_fp8_f32(b.x * sc, b.y * sc, 0, false), true);
        o.z = (unsigned)__builtin_amdgcn_cvt_pk_fp8_f32(c.z * sc, c.w * sc, __builtin_amdgcn_cvt_pk_fp8_f32(c.x * sc, c.y * sc, 0, false), true);
        o.w = (unsigned)__builtin_amdgcn_cvt_pk_fp8_f32(d.z * sc, d.w * sc, __builtin_amdgcn_cvt_pk_fp8_f32(d.x * sc, d.y * sc, 0, false), true);
        *(v4u*)((isv ? vb8 : ub8) + (size_t)rr * 1024 + lane * 16) = o;
        if (lane == 0) (isv ? vsc : usc)[rr] = am > 0.f ? am * (1.0f / 224.0f) : 1.0f;
    }
}
__device__ __forceinline__ void unpack16_fp8(const v4u w, float (&f)[16]) {
#pragma unroll
    for (int i = 0; i < 4; ++i) {
        const f32x2v lo = __builtin_amdgcn_cvt_pk_f32_fp8((int)w[i], false), hi = __builtin_amdgcn_cvt_pk_f32_fp8((int)w[i], true);
        f[4 * i] = lo[0]; f[4 * i + 1] = lo[1]; f[4 * i + 2] = hi[0]; f[4 * i + 3] = hi[1];
    }
}
__device__ __forceinline__ void ph_peer_ffn3(const bf16* __restrict__ hb, const int* __restrict__ eidx, const float* __restrict__ gate,
                                             const unsigned char* __restrict__ ub8, const unsigned char* __restrict__ vb8, const float* __restrict__ usc, const float* __restrict__ vsc,
                                             const float* __restrict__ gam, const float* __restrict__ bet, float* __restrict__ out,
                                             const float* __restrict__ ck, const float* __restrict__ cv, unsigned n9) {
    const int lane0 = threadIdx.x & 63;
    unsigned it = 0;
    for (int t = blockIdx.x * NWAVE + (threadIdx.x >> 6); t < T_ALL; t += gridDim.x * NWAVE, ++it) {
        int lane = lane0; asm volatile("" : "+v"(lane));
        { const unsigned sl = n9 + (blockIdx.x * NWAVE + (threadIdx.x >> 6)) + it * (gridDim.x * NWAVE); if (sl < 16384u) cache_copy_slice(ck, cv, out, sl, (unsigned)lane); }
        const unsigned lo16 = (unsigned)lane * 16u, lo8 = (unsigned)lane * 8u;
        float x[16];
        { float f0[8], f1[8]; const bf16* xr = hb + (size_t)t * D_MODEL + lo8; unpack8(*(const v4u*)xr, f0); unpack8(*(const v4u*)(xr + 512), f1);
#pragma unroll
          for (int j = 0; j < 8; ++j) { x[j] = f0[j]; x[8 + j] = f1[j]; } }
        int ev[2]; float wv[4], su[4];
        ev[0] = eidx[(size_t)t * 128 + lane]; ev[1] = eidx[(size_t)t * 128 + 64 + lane];
#pragma unroll
        for (int rd = 0; rd < 4; ++rd) {
            const int er = eidx[(size_t)t * 128 + rd * 32 + (lane >> 1)];
            wv[rd] = gate[(size_t)t * 128 + rd * 32 + (lane >> 1)] * vsc[er];
            su[rd] = usc[er];
        }
#pragma unroll
        for (int rd = 0; rd < 4; ++rd) {
            float part[32];
#pragma unroll
            for (int kb = 0; kb < 8; ++kb) {
                v4u ra[4];
#pragma unroll
                for (int k8 = 0; k8 < 4; ++k8) {
                    const int e = __builtin_amdgcn_readlane(ev[rd >> 1], (rd & 1) * 32 + kb * 4 + k8);
                    ra[k8] = *(const v4u*)(ub8 + (size_t)e * 1024 + lo16);
                }
#pragma unroll
                for (int k8 = 0; k8 < 4; ++k8) {
                    f32x2v dv = {0.f, 0.f};
#pragma unroll
                    for (int i = 0; i < 4; ++i) {
                        const f32x2v lo = __builtin_amdgcn_cvt_pk_f32_fp8((int)ra[k8][i], false), hi = __builtin_amdgcn_cvt_pk_f32_fp8((int)ra[k8][i], true);
                        dv += lo * (f32x2v){x[4 * i], x[4 * i + 1]}; dv += hi * (f32x2v){x[4 * i + 2], x[4 * i + 3]};
                    }
                    part[kb * 4 + k8] = dv[0] + dv[1];
                    if (k8 & 1) __builtin_amdgcn_sched_barrier(0);
                }
            }
            PEER_TR_STEP(16, 32) PEER_TR_STEP(8, 16) PEER_TR_STEP(4, 8) PEER_TR_STEP(2, 4) PEER_TR_STEP(1, 2)
            const float hid = (part[0] + __shfl_xor(part[0], 1)) * su[rd];
            wv[rd] *= gelu_f(hid);
        }
        float acc[16];
#pragma unroll
        for (int j = 0; j < 16; ++j) acc[j] = 0.f;
#pragma unroll
        for (int rd = 0; rd < 4; ++rd) {
#pragma unroll
            for (int kb = 0; kb < 4; ++kb) {
                v4u ra[8];
#pragma unroll
                for (int k8 = 0; k8 < 8; ++k8) {
                    const int e = __builtin_amdgcn_readlane(ev[rd >> 1], (rd & 1) * 32 + kb * 8 + k8);
                    ra[k8] = *(const v4u*)(vb8 + (size_t)e * 1024 + lo16);
                }
#pragma unroll
                for (int k8 = 0; k8 < 8; ++k8) {
                    const float wk = __builtin_bit_cast(float, __builtin_amdgcn_readlane(__builtin_bit_cast(int, wv[rd]), 2 * (kb * 8 + k8)));
                    float f[16]; unpack16_fp8(ra[k8], f);
#pragma unroll
                    for (int j = 0; j < 16; ++j) acc[j] += wk * f[j];
                    if (k8 & 1) __builtin_amdgcn_sched_barrier(0);
                }
            }
        }
        float s = 0.f;
#pragma unroll
        for (int j = 0; j < 16; ++j) { acc[j] += ALPHA_F * x[j]; s += acc[j]; }
        s = wave_sum(s);
        const float mu = s * (1.0f / 1024.0f);
        float q = 0.f;
#pragma unroll
        for (int j = 0; j < 16; ++j) { acc[j] -= mu; q += acc[j] * acc[j]; }
        q = wave_sum(q);
        const float r = rsqrtf(q * (1.0f / 1024.0f) + LN_EPS);
        float* dst = ((t < T_PROMPT) ? out + OUT_YP + (size_t)t * D_MODEL : out + OUT_YS + (size_t)(t - T_PROMPT) * D_MODEL) + lo8;
#pragma unroll
        for (int q4 = 0; q4 < 4; ++q4) {
            const int eo = (q4 >> 1) * 512 + (q4 & 1) * 4;
            const float4 g4 = *(const float4*)(gam + lo8 + eo), b4 = *(const float4*)(bet + lo8 + eo);
            float4 o; o.x = acc[q4 * 4 + 0] * r * g4.x + b4.x; o.y = acc[q4 * 4 + 1] * r * g4.y + b4.y; o.z = acc[q4 * 4 + 2] * r * g4.z + b4.z; o.w = acc[q4 * 4 + 3] * r * g4.w + b4.w;
            *(float4*)(dst + eo) = o;
        }
    }
    for (;; ++it) {
        const unsigned sl = n9 + (blockIdx.x * NWAVE + (threadIdx.x >> 6)) + it * (gridDim.x * NWAVE);
        if (sl >= 16384u) break;
        cache_copy_slice(ck, cv, out, sl, (unsigned)lane0);
    }
}


__device__ __forceinline__ void ssd_decode_load(const bf16* __restrict__ xbc_b, const float* __restrict__ dtv, const float* __restrict__ state_ssm, int item, int p, int ng,
                                                float (&hs)[16], v4u (&bq)[4][2], v4u (&cq)[4][2], float (&xv)[4], float (&dv)[4]) {
    const int sb = item / SSD_HEADS, h = item - sb * SSD_HEADS, g = h / 6, t0 = T_PROMPT + sb * DEC_SEQ;
    const float* s0 = state_ssm + (((size_t)sb * SSD_HEADS + h) * 64 + p) * 128 + ng * 16;
#pragma unroll
    for (int j = 0; j < 4; ++j) { const float4 v = *(const float4*)(s0 + 4 * j); hs[4 * j] = v.x; hs[4 * j + 1] = v.y; hs[4 * j + 2] = v.z; hs[4 * j + 3] = v.w; }
#pragma unroll
    for (int s = 0; s < 4; ++s) {
        const bf16* row = xbc_b + (size_t)(t0 + s) * CONV_DIM;
        bq[s][0] = *(const v4u*)(row + 1536 + g * 128 + ng * 16); bq[s][1] = *(const v4u*)(row + 1536 + g * 128 + ng * 16 + 8);
        cq[s][0] = *(const v4u*)(row + 2048 + g * 128 + ng * 16); cq[s][1] = *(const v4u*)(row + 2048 + g * 128 + ng * 16 + 8);
        xv[s] = bf2f(row[h * 64 + p]); dv[s] = dtv[(size_t)(t0 + s) * SSD_HEADS + h];
    }
}
__device__ __forceinline__ void ssd_decode_compute(const float* __restrict__ a_log, const float* __restrict__ d_skip, int item, int p, int ng,
                                                   float (&hs)[16], const v4u (&bq)[4][2], const v4u (&cq)[4][2], const float (&xv)[4], const float (&dv)[4],
                                                   float* __restrict__ ybuf, float* __restrict__ out) {
    const int sb = item / SSD_HEADS, h = item - sb * SSD_HEADS, t0 = T_PROMPT + sb * DEC_SEQ;
    const float A = -__expf(a_log[h]), D = d_skip[h];
#pragma unroll
    for (int s = 0; s < 4; ++s) {
        float Bf[16], Cf[16];
        { float t8[8]; unpack8(bq[s][0], t8);
#pragma unroll
          for (int j = 0; j < 8; ++j) Bf[j] = t8[j];
          unpack8(bq[s][1], t8);
#pragma unroll
          for (int j = 0; j < 8; ++j) Bf[8 + j] = t8[j];
          unpack8(cq[s][0], t8);
#pragma unroll
          for (int j = 0; j < 8; ++j) Cf[j] = t8[j];
          unpack8(cq[s][1], t8);
#pragma unroll
          for (int j = 0; j < 8; ++j) Cf[8 + j] = t8[j]; }
        const float a = __expf(dv[s] * A), xdt = xv[s] * dv[s];
        float y = 0.f;
#pragma unroll
        for (int j = 0; j < 16; ++j) { hs[j] = a * hs[j] + xdt * Bf[j]; y += Cf[j] * hs[j]; }
        y += __shfl_xor(y, 1); y += __shfl_xor(y, 2); y += __shfl_xor(y, 4);
        if (ng == 0) ybuf[(size_t)(t0 + s) * MIX_WIDTH + h * 64 + p] = y + D * xv[s];
    }
    float* so = out + OUT_SS + (((size_t)sb * SSD_HEADS + h) * 64 + p) * 128 + ng * 16;
#pragma unroll
    for (int j = 0; j < 4; ++j) *(float4*)(so + 4 * j) = make_float4(hs[4 * j], hs[4 * j + 1], hs[4 * j + 2], hs[4 * j + 3]);
}
__device__ __forceinline__ void ph_ssd_decode(const bf16* __restrict__ xbc_b, const float* __restrict__ dtv, const float* __restrict__ a_log, const float* __restrict__ d_skip,
                                              const float* __restrict__ state_ssm, float* __restrict__ ybuf, float* __restrict__ out) {
    const int tid = threadIdx.x, p = tid >> 3, ng = tid & 7;
    constexpr int NITEM = DEC_BATCH * SSD_HEADS;
    for (int it = blockIdx.x; it < NITEM; it += 2 * gridDim.x) {
        const int it2 = it + gridDim.x; const bool has2 = it2 < NITEM; const int it2c = has2 ? it2 : it;
        float hsA[16], hsB[16], xA[4], xB[4], dA[4], dB[4]; v4u bA[4][2], cA[4][2], bB[4][2], cB[4][2];
        ssd_decode_load(xbc_b, dtv, state_ssm, it, p, ng, hsA, bA, cA, xA, dA);
        ssd_decode_load(xbc_b, dtv, state_ssm, it2c, p, ng, hsB, bB, cB, xB, dB);
        ssd_decode_compute(a_log, d_skip, it, p, ng, hsA, bA, cA, xA, dA, ybuf, out);
        if (has2) ssd_decode_compute(a_log, d_skip, it2, p, ng, hsB, bB, cB, xB, dB, ybuf, out);
    }
}

__device__ __forceinline__ float samp_cw(int d) { return (float)((int)(d >= 0 && d <= 128) + (int)(d >= 0 && (d & 3) == 0 && d <= 512) + (int)(d >= 0 && (d & 15) == 0 && d <= 2048)); }
__device__ __forceinline__ void samp_update(float sv, float cw, const float (&vrow)[64], float& m, float& l, float (&part)[64]) {
    const float mn = fmaxf(m, sv), alpha = __expf(m - mn), p = cw * __expf(sv - mn);
    m = mn; l = l * alpha + p;
#pragma unroll
    for (int c = 0; c < 64; ++c) part[c] = part[c] * alpha + p * vrow[c];
}
__device__ __forceinline__ void ph_attn_sample3(float* lds, const bf16* __restrict__ qrot_b, const bf16* __restrict__ krot_b, const bf16* __restrict__ projb,
                                                const float* __restrict__ ck, const float* __restrict__ cv, bf16* __restrict__ A1) {
    const int lane0 = threadIdx.x & 63, w = __builtin_amdgcn_readfirstlane(threadIdx.x >> 6);
    float* sq = lds + w * 256;
    for (int item = blockIdx.x + gridDim.x * w; item < DEC_BATCH * ATT_HEADS; item += gridDim.x * NWAVE) {
        int lane = lane0; asm volatile("" : "+v"(lane));
        const int b = item >> 3, hd = item & 7, qi = lane & 3, g = lane >> 2;
        const int tq0 = T_PROMPT + b * DEC_SEQ;
#pragma unroll
        for (int i = 0; i < 4; ++i) sq[i * 64 + lane] = bf2f(qrot_b[(size_t)(tq0 + i) * ATT_WIDTH + hd * 64 + lane]);
        asm volatile("s_waitcnt lgkmcnt(0)" ::: "memory");
        const float* qv = sq + qi * 64;
        const float* ckb = ck + (size_t)b * WBUF * ATT_WIDTH + hd * 64; const float* cvb = cv + (size_t)b * WBUF * ATT_WIDTH + hd * 64;
        float m = -1e30f, l = 0.f, part[64];
#pragma unroll
        for (int c = 0; c < 64; ++c) part[c] = 0.f;
        {
            const int P = 2051 - g;
            const float cw = samp_cw(WBUF + qi - P);
            const bool isn = P >= WBUF;
            const int nt = isn ? P - WBUF : 0, Pc = isn ? WBUF - 1 : P;
            const bf16* kn = krot_b + (size_t)(tq0 + nt) * ATT_WIDTH + hd * 64; const float* kr = ckb + (size_t)Pc * ATT_WIDTH;
            float a = 0.f;
#pragma unroll
            for (int c = 0; c < 64; c += 8) { float f[8]; unpack8(*(const v4u*)(kn + c), f); const float4 k0 = *(const float4*)(kr + c), k1 = *(const float4*)(kr + c + 4);
                a += (isn ? f[0] : k0.x) * qv[c] + (isn ? f[1] : k0.y) * qv[c + 1] + (isn ? f[2] : k0.z) * qv[c + 2] + (isn ? f[3] : k0.w) * qv[c + 3]
                   + (isn ? f[4] : k1.x) * qv[c + 4] + (isn ? f[5] : k1.y) * qv[c + 5] + (isn ? f[6] : k1.z) * qv[c + 6] + (isn ? f[7] : k1.w) * qv[c + 7]; }
            const float sv = cw > 0.f ? a * 0.125f : -1e30f;
            const bf16* vn = projb + (size_t)(tq0 + nt) * NB_LD + NB_V + hd * 64; const float* vr = cvb + (size_t)Pc * ATT_WIDTH;
            float vrow[64];
#pragma unroll
            for (int c = 0; c < 64; c += 8) { float f[8]; unpack8(*(const v4u*)(vn + c), f); const float4 v0 = *(const float4*)(vr + c), v1 = *(const float4*)(vr + c + 4);
                vrow[c] = isn ? f[0] : v0.x; vrow[c + 1] = isn ? f[1] : v0.y; vrow[c + 2] = isn ? f[2] : v0.z; vrow[c + 3] = isn ? f[3] : v0.w;
                vrow[c + 4] = isn ? f[4] : v1.x; vrow[c + 5] = isn ? f[5] : v1.y; vrow[c + 6] = isn ? f[6] : v1.z; vrow[c + 7] = isn ? f[7] : v1.w; }
            samp_update(sv, cw, vrow, m, l, part);
        }
#pragma unroll 1
        for (int s = 1; s < 21; ++s) {
            const int P = s < 9 ? 2051 - (16 * s + g) : (s < 15 ? 1536 + 64 * (s - 9) + lane : qi + 16 * (16 * (s - 15) + g));
            const float cw = (s < 9 && P < 1920) ? 0.f : samp_cw(WBUF + qi - P);
            const float* kr = ckb + (size_t)P * ATT_WIDTH;
            float a = 0.f;
#pragma unroll
            for (int c = 0; c < 64; c += 4) { const float4 kv = *(const float4*)(kr + c); a += kv.x * qv[c] + kv.y * qv[c + 1] + kv.z * qv[c + 2] + kv.w * qv[c + 3]; }
            const float sv = cw > 0.f ? a * 0.125f : -1e30f;
            __builtin_amdgcn_sched_barrier(0);
            const float* vr = cvb + (size_t)P * ATT_WIDTH;
            float vrow[64];
#pragma unroll
            for (int c = 0; c < 64; c += 4) { const float4 vv = *(const float4*)(vr + c); vrow[c] = vv.x; vrow[c + 1] = vv.y; vrow[c + 2] = vv.z; vrow[c + 3] = vv.w; }
            samp_update(sv, cw, vrow, m, l, part);
        }
        float M = m;
        M = fmaxf(M, __shfl_xor(M, 4)); M = fmaxf(M, __shfl_xor(M, 8)); M = fmaxf(M, __shfl_xor(M, 16)); M = fmaxf(M, __shfl_xor(M, 32));
        const float sc = __expf(m - M);
        float lsum = l * sc;
        lsum += __shfl_xor(lsum, 4); lsum += __shfl_xor(lsum, 8); lsum += __shfl_xor(lsum, 16); lsum += __shfl_xor(lsum, 32);
#pragma unroll
        for (int c = 0; c < 64; ++c) part[c] *= sc;
        PEER_TR_STEP(32, 32) PEER_TR_STEP(16, 16) PEER_TR_STEP(8, 8) PEER_TR_STEP(4, 4)
        const float inv = 1.0f / lsum;
        *(uint2*)(A1 + (size_t)(tq0 + qi) * MIX_WIDTH + SSD_WIDTH + hd * 64 + 4 * g) = make_uint2(pk2(part[0] * inv, part[1] * inv), pk2(part[2] * inv, part[3] * inv));
    }
}

typedef float f32x16 __attribute__((ext_vector_type(16)));
typedef short s16x8 __attribute__((ext_vector_type(8)));
typedef short s16x4 __attribute__((ext_vector_type(4)));
typedef float f32x4v __attribute__((ext_vector_type(4)));
#define SSD_L_ACS 0
#define SSD_L_DTS 3072
#define SSD_L_BM 6144
#define SSD_RS_B 272
#define SSD_L_X (6144 + 128 * 272)
#define SSD_RS_X 144
#define SSD_XIMG (128 * 144)
#define SSD_RS_Y 784
template <int OFF0, int OFF1>
__device__ __forceinline__ s16x8 tr_frag(unsigned base) {
    s16x4 a, b;
    asm volatile("ds_read_b64_tr_b16 %0, %2 offset:%3\n\tds_read_b64_tr_b16 %1, %2 offset:%4\n\ts_waitcnt lgkmcnt(0)"
                 : "=&v"(a), "=&v"(b) : "v"(base), "n"(OFF0), "n"(OFF1) : "memory");
    return __builtin_shufflevector(a, b, 0, 1, 2, 3, 4, 5, 6, 7);
}
__device__ __forceinline__ unsigned lds_addr(LAS unsigned char* p) { return (unsigned)(size_t)p; }
template <int O0, int O1, int O2, int O3, int O4, int O5, int O6, int O7>
__device__ __forceinline__ void tr_read8(unsigned base, s16x4 (&v)[8]) {
    asm volatile("ds_read_b64_tr_b16 %0, %8 offset:%9\n\tds_read_b64_tr_b16 %1, %8 offset:%10\n\tds_read_b64_tr_b16 %2, %8 offset:%11\n\tds_read_b64_tr_b16 %3, %8 offset:%12\n\t"
                 "ds_read_b64_tr_b16 %4, %8 offset:%13\n\tds_read_b64_tr_b16 %5, %8 offset:%14\n\tds_read_b64_tr_b16 %6, %8 offset:%15\n\tds_read_b64_tr_b16 %7, %8 offset:%16\n\ts_waitcnt lgkmcnt(0)"
                 : "=&v"(v[0]), "=&v"(v[1]), "=&v"(v[2]), "=&v"(v[3]), "=&v"(v[4]), "=&v"(v[5]), "=&v"(v[6]), "=&v"(v[7])
                 : "v"(base), "n"(O0), "n"(O1), "n"(O2), "n"(O3), "n"(O4), "n"(O5), "n"(O6), "n"(O7) : "memory");
}
#define TRCAT(a, b) __builtin_shufflevector(a, b, 0, 1, 2, 3, 4, 5, 6, 7)


__device__ __forceinline__ void ssd_chunk_acs(LAS unsigned char* ldsb, const float* __restrict__ dtv, const float* __restrict__ a_log, int t0, int g, float* cdec_out) {
    const int w = __builtin_amdgcn_readfirstlane(threadIdx.x >> 6), lane = threadIdx.x & 63;
    if (w < 6) {
        const int head = 6 * g + w;
        const float A = -__expf(a_log[head]);
        const float v0 = dtv[(size_t)(t0 + 2 * lane) * SSD_HEADS + head], v1 = dtv[(size_t)(t0 + 2 * lane + 1) * SSD_HEADS + head];
        const float a1 = v1 * A;
        float s = v0 * A + a1;
#pragma unroll
        for (int o = 1; o < 64; o <<= 1) { const float tmp = __shfl_up(s, o); if (lane >= o) s += tmp; }
        LAS float* acs = (LAS float*)(ldsb + SSD_L_ACS) + w * 128;
        LAS float* dts = (LAS float*)(ldsb + SSD_L_DTS) + w * 128;
        acs[2 * lane] = s - a1; acs[2 * lane + 1] = s;
        dts[2 * lane] = v0; dts[2 * lane + 1] = v1;
        if (cdec_out && lane == 63) cdec_out[head] = __expf(s);
    }
}

__device__ __forceinline__ void ph_ssd_states(LAS unsigned char* ldsb, const bf16* __restrict__ xbc_b, const float* __restrict__ dtv, const float* __restrict__ a_log,
                                              bf16* __restrict__ Sbuf, float* __restrict__ cdec, const float* __restrict__ ck, const float* __restrict__ cv, float* __restrict__ out) {
    const int tid = threadIdx.x, w = __builtin_amdgcn_readfirstlane(tid >> 6), lane = tid & 63;
    const int r = lane & 31, h = lane >> 5, blk = (lane >> 4) & 1, q = (lane & 15) >> 2, pp = lane & 3;
    const int nt = w & 3, pt = w >> 2;
    for (int unit = blockIdx.x; unit < BATCH * 64 * SSD_GROUPS; unit += gridDim.x) {
        const int g = unit & 3, bc = unit >> 2;
        const int t0 = bc * 128;
        __syncthreads();
        ssd_chunk_acs(ldsb, dtv, a_log, t0, g, cdec + (size_t)bc * SSD_HEADS);
#pragma unroll
        for (int it_ = 0; it_ < 4; ++it_) { const int idx = tid + it_ * NTHR; const int row = idx >> 4, ch = idx & 15;
            const v4u v = *(const v4u*)(xbc_b + (size_t)(t0 + row) * CONV_DIM + 1536 + 128 * g + ch * 8);
            *(LAS v4u*)(ldsb + SSD_L_BM + row * SSD_RS_B + ch * 16) = v; }
        __syncthreads();
#pragma unroll
        for (int it_ = 0; it_ < 12; ++it_) { const int idx = tid + it_ * NTHR; const int hh = idx >> 10, rem = idx & 1023, row = rem >> 3, ch = rem & 7;
            const LAS float* acs = (const LAS float*)(ldsb + SSD_L_ACS) + hh * 128; const LAS float* dts = (const LAS float*)(ldsb + SSD_L_DTS) + hh * 128;
            const float wgt = dts[row] * __expf(acs[127] - acs[row]);
            float f[8]; unpack8(*(const v4u*)(xbc_b + (size_t)(t0 + row) * CONV_DIM + (6 * g + hh) * 64 + ch * 8), f);
            v4u o; o.x = pk2(f[0] * wgt, f[1] * wgt); o.y = pk2(f[2] * wgt, f[3] * wgt); o.z = pk2(f[4] * wgt, f[5] * wgt); o.w = pk2(f[6] * wgt, f[7] * wgt);
            *(LAS v4u*)(ldsb + SSD_L_X + hh * SSD_XIMG + row * SSD_RS_X + ch * 16) = o; }
        __syncthreads();
        f32x4n rider[16];
        copy_q_load(ck, cv, 12288u + (unsigned)(unit * NWAVE + w), (unsigned)lane, rider);
        const unsigned abase = lds_addr(ldsb + SSD_L_BM) + (8 * h + q) * SSD_RS_B + (32 * nt + 16 * blk + 4 * pp) * 2;
        s16x8 afr[8];
        { s16x4 av[8];
          tr_read8<0 * SSD_RS_B, 4 * SSD_RS_B, 16 * SSD_RS_B, 20 * SSD_RS_B, 32 * SSD_RS_B, 36 * SSD_RS_B, 48 * SSD_RS_B, 52 * SSD_RS_B>(abase, av);
          afr[0] = TRCAT(av[0], av[1]); afr[1] = TRCAT(av[2], av[3]); afr[2] = TRCAT(av[4], av[5]); afr[3] = TRCAT(av[6], av[7]);
          tr_read8<64 * SSD_RS_B, 68 * SSD_RS_B, 80 * SSD_RS_B, 84 * SSD_RS_B, 96 * SSD_RS_B, 100 * SSD_RS_B, 112 * SSD_RS_B, 116 * SSD_RS_B>(abase, av);
          afr[4] = TRCAT(av[0], av[1]); afr[5] = TRCAT(av[2], av[3]); afr[6] = TRCAT(av[4], av[5]); afr[7] = TRCAT(av[6], av[7]); }
#pragma unroll
        for (int hh = 0; hh < 6; ++hh) {
            const unsigned xb = lds_addr(ldsb + SSD_L_X + hh * SSD_XIMG) + (8 * h + q) * SSD_RS_X + (32 * pt + 16 * blk + 4 * pp) * 2;
            f32x16 acc;
#pragma unroll
            for (int i = 0; i < 16; ++i) acc[i] = 0.f;
            { s16x4 xv[8];
              tr_read8<0 * SSD_RS_X, 4 * SSD_RS_X, 16 * SSD_RS_X, 20 * SSD_RS_X, 32 * SSD_RS_X, 36 * SSD_RS_X, 48 * SSD_RS_X, 52 * SSD_RS_X>(xb, xv);
              acc = __builtin_amdgcn_mfma_f32_32x32x16_bf16(afr[0], TRCAT(xv[0], xv[1]), acc, 0, 0, 0);
              acc = __builtin_amdgcn_mfma_f32_32x32x16_bf16(afr[1], TRCAT(xv[2], xv[3]), acc, 0, 0, 0);
              acc = __builtin_amdgcn_mfma_f32_32x32x16_bf16(afr[2], TRCAT(xv[4], xv[5]), acc, 0, 0, 0);
              acc = __builtin_amdgcn_mfma_f32_32x32x16_bf16(afr[3], TRCAT(xv[6], xv[7]), acc, 0, 0, 0);
              tr_read8<64 * SSD_RS_X, 68 * SSD_RS_X, 80 * SSD_RS_X, 84 * SSD_RS_X, 96 * SSD_RS_X, 100 * SSD_RS_X, 112 * SSD_RS_X, 116 * SSD_RS_X>(xb, xv);
              acc = __builtin_amdgcn_mfma_f32_32x32x16_bf16(afr[4], TRCAT(xv[0], xv[1]), acc, 0, 0, 0);
              acc = __builtin_amdgcn_mfma_f32_32x32x16_bf16(afr[5], TRCAT(xv[2], xv[3]), acc, 0, 0, 0);
              acc = __builtin_amdgcn_mfma_f32_32x32x16_bf16(afr[6], TRCAT(xv[4], xv[5]), acc, 0, 0, 0);
              acc = __builtin_amdgcn_mfma_f32_32x32x16_bf16(afr[7], TRCAT(xv[6], xv[7]), acc, 0, 0, 0); }
            bf16* dst = Sbuf + ((size_t)bc * SSD_HEADS + 6 * g + hh) * 8192 + (size_t)(pt * 8 + 2 * nt) * 512 + r * 8 + 4 * h;
#pragma unroll
            for (int q4 = 0; q4 < 4; ++q4) *(uint2*)(dst + (q4 >> 1) * 512 + (q4 & 1) * 256) = make_uint2(pk2(acc[4 * q4], acc[4 * q4 + 1]), pk2(acc[4 * q4 + 2], acc[4 * q4 + 3]));
        }
        copy_q_store(out, 12288u + (unsigned)(unit * NWAVE + w), (unsigned)lane, rider);
    }
}

__device__ __forceinline__ void ph_ssd_scan(const bf16* __restrict__ Sbuf, const float* __restrict__ cdec, bf16* __restrict__ Hin, float* __restrict__ out, int rank, int nranks) {
    for (int idx = rank * NTHR + threadIdx.x; idx < BATCH * SSD_HEADS * 1024; idx += nranks * NTHR) {
        const int i = idx & 1023, hb = idx >> 10, hd = hb % SSD_HEADS, b = hb / SSD_HEADS;
        float st[8];
#pragma unroll
        for (int j = 0; j < 8; ++j) st[j] = 0.f;
#pragma unroll 8
        for (int c = 0; c < 64; ++c) {
            const size_t base = (((size_t)(b * 64 + c)) * SSD_HEADS + hd) * 8192 + (size_t)i * 8;
            v4u o; o.x = pk2(st[0], st[1]); o.y = pk2(st[2], st[3]); o.z = pk2(st[4], st[5]); o.w = pk2(st[6], st[7]);
            *(v4u*)(Hin + base) = o;
            float s[8]; unpack8(*(const v4u*)(Sbuf + base), s);
            const float a = cdec[(size_t)(b * 64 + c) * SSD_HEADS + hd];
#pragma unroll
            for (int j = 0; j < 8; ++j) st[j] = a * st[j] + s[j];
        }
        const int ln = i & 63, ks = (i >> 6) & 7, pt = i >> 9, p = 32 * pt + (ln & 31), n0 = 16 * ks + 8 * (ln >> 5);
        store8f(out + OUT_PS + (((size_t)b * SSD_HEADS + hd) * 64 + p) * 128 + n0, st);
    }
}

__device__ __forceinline__ void ph_ssd_out(LAS unsigned char* ldsb, const bf16* __restrict__ xbc_b, const bf16* __restrict__ projb, const float* __restrict__ dtv,
                                           const float* __restrict__ a_log, const float* __restrict__ d_skip, const float* __restrict__ norm_g,
                                           const bf16* __restrict__ Hin, bf16* __restrict__ A1) {
    const int tid = threadIdx.x, w = __builtin_amdgcn_readfirstlane(tid >> 6), lane = tid & 63;
    const int r = lane & 31, h = lane >> 5, blk = (lane >> 4) & 1, q = (lane & 15) >> 2, pp = lane & 3;
    const int hs = w >> 2, lt = hs ? 3 - (w & 3) : (w & 3);
    for (int unit = blockIdx.x; unit < BATCH * 64 * SSD_GROUPS; unit += gridDim.x) {
        const int g = unit & 3, bc = unit >> 2;
        const int t0 = bc * 128;
        __syncthreads();
        ssd_chunk_acs(ldsb, dtv, a_log, t0, g, nullptr);
#pragma unroll
        for (int it_ = 0; it_ < 4; ++it_) { const int idx = tid + it_ * NTHR; const int row = idx >> 4, ch = idx & 15;
            const v4u v = *(const v4u*)(xbc_b + (size_t)(t0 + row) * CONV_DIM + 1536 + 128 * g + ch * 8);
            *(LAS v4u*)(ldsb + SSD_L_BM + row * SSD_RS_B + ch * 16) = v; }
#pragma unroll
        for (int it_ = 0; it_ < 12; ++it_) { const int idx = tid + it_ * NTHR; const int hh = idx >> 10, rem = idx & 1023, row = rem >> 3, ch = rem & 7;
            const v4u v = *(const v4u*)(xbc_b + (size_t)(t0 + row) * CONV_DIM + (6 * g + hh) * 64 + ch * 8);
            *(LAS v4u*)(ldsb + SSD_L_X + hh * SSD_XIMG + row * SSD_RS_X + ch * 16) = v; }
        __syncthreads();
        const bf16* cp = xbc_b + (size_t)(t0 + 32 * lt + r) * CONV_DIM + 2048 + 128 * g + 8 * h;
        s16x8 cfr[8];
#pragma unroll
        for (int ks = 0; ks < 8; ++ks) cfr[ks] = *(const s16x8*)(cp + 16 * ks);
        const int lcol = 32 * lt + r;
        const LAS float* acsb = (const LAS float*)(ldsb + SSD_L_ACS) + 3 * hs * 128; const LAS float* dtsb = (const LAS float*)(ldsb + SSD_L_DTS) + 3 * hs * 128;
        const unsigned xb0 = lds_addr(ldsb + SSD_L_X + 3 * hs * SSD_XIMG) + (4 * h + q) * SSD_RS_X + (16 * blk + 4 * pp) * 2;
        unsigned ypk[3][16];
#pragma unroll
        for (int h3 = 0; h3 < 3; ++h3) {
            const LAS float* acs = acsb + h3 * 128; const LAS float* dts = dtsb + h3 * 128;
            const float myacs = acs[lcol];
            const float Dh = d_skip[6 * g + 3 * hs + h3];
            f32x16 y0, y1;
#pragma unroll
            for (int i = 0; i < 16; ++i) { y0[i] = 0.f; y1[i] = 0.f; }
            { const bf16* hp = Hin + ((size_t)bc * SSD_HEADS + 6 * g + 3 * hs + h3) * 8192 + lane * 8;
#pragma unroll
              for (int kh = 0; kh < 2; ++kh) {
                  s16x8 hf0[4], hf1[4];
#pragma unroll
                  for (int ks = 0; ks < 4; ++ks) { hf0[ks] = *(const s16x8*)(hp + (4 * kh + ks) * 512); hf1[ks] = *(const s16x8*)(hp + (8 + 4 * kh + ks) * 512); }
#pragma unroll
                  for (int ks = 0; ks < 4; ++ks) { y0 = __builtin_amdgcn_mfma_f32_32x32x16_bf16(cfr[4 * kh + ks], hf0[ks], y0, 0, 0, 0); y1 = __builtin_amdgcn_mfma_f32_32x32x16_bf16(cfr[4 * kh + ks], hf1[ks], y1, 0, 0, 0); }
                  __builtin_amdgcn_sched_barrier(0);
              } }
#pragma unroll
            for (int q4 = 0; q4 < 4; ++q4) {
                const f32x4v a4 = *(const LAS f32x4v*)(acs + 32 * lt + 8 * q4 + 4 * h);
                const float e0 = __expf(a4[0]), e1 = __expf(a4[1]), e2 = __expf(a4[2]), e3 = __expf(a4[3]);
                y0[4 * q4] *= e0; y0[4 * q4 + 1] *= e1; y0[4 * q4 + 2] *= e2; y0[4 * q4 + 3] *= e3;
                y1[4 * q4] *= e0; y1[4 * q4 + 1] *= e1; y1[4 * q4 + 2] *= e2; y1[4 * q4 + 3] *= e3;
            }
            __builtin_amdgcn_sched_barrier(0);
            for (int st = 0; st <= lt; ++st) {
                f32x16 cb;
#pragma unroll
                for (int i = 0; i < 16; ++i) cb[i] = 0.f;
#pragma unroll
                for (int ks = 0; ks < 8; ++ks) {
                    const s16x8 bfrag = *(const LAS s16x8*)(ldsb + SSD_L_BM + (32 * st + r) * SSD_RS_B + (16 * ks + 8 * h) * 2);
                    cb = __builtin_amdgcn_mfma_f32_32x32x16_bf16(bfrag, cfr[ks], cb, 0, 0, 0);
                }
                __builtin_amdgcn_sched_barrier(0);
                const unsigned xb = xb0 + h3 * SSD_XIMG + st * 32 * SSD_RS_X;
                s16x4 xv[8];
                tr_read8<0, 8 * SSD_RS_X, 64, 8 * SSD_RS_X + 64, 16 * SSD_RS_X, 24 * SSD_RS_X, 16 * SSD_RS_X + 64, 24 * SSD_RS_X + 64>(xb, xv);
#pragma unroll
                for (int kk = 0; kk < 2; ++kk) {
                    const int s0 = 32 * st + 16 * kk + 4 * h;
                    const f32x4v as0 = *(const LAS f32x4v*)(acs + s0), as1 = *(const LAS f32x4v*)(acs + s0 + 8);
                    const f32x4v ds0 = *(const LAS f32x4v*)(dts + s0), ds1 = *(const LAS f32x4v*)(dts + s0 + 8);
                    float wv[8];
#pragma unroll
                    for (int j = 0; j < 8; ++j) {
                        const int s = s0 + 8 * (j >> 2) + (j & 3);
                        const float asj = (j < 4) ? as0[j & 3] : as1[j & 3], dsj = (j < 4) ? ds0[j & 3] : ds1[j & 3];
                        float v = cb[8 * kk + j] * __expf(myacs - asj) * dsj;
                        v = (s <= lcol) ? v : 0.f;
                        v = (s == lcol) ? v + Dh : v;
                        wv[j] = v;
                    }
                    s16x8 afr;
                    { v4u o; o.x = pk2(wv[0], wv[1]); o.y = pk2(wv[2], wv[3]); o.z = pk2(wv[4], wv[5]); o.w = pk2(wv[6], wv[7]); afr = __builtin_bit_cast(s16x8, o); }
                    const s16x8 b0 = kk == 0 ? TRCAT(xv[0], xv[1]) : TRCAT(xv[4], xv[5]);
                    const s16x8 b1 = kk == 0 ? TRCAT(xv[2], xv[3]) : TRCAT(xv[6], xv[7]);
                    y0 = __builtin_amdgcn_mfma_f32_32x32x16_bf16(afr, b0, y0, 0, 0, 0);
                    y1 = __builtin_amdgcn_mfma_f32_32x32x16_bf16(afr, b1, y1, 0, 0, 0);
                    __builtin_amdgcn_sched_barrier(0);
                }
            }
#pragma unroll
            for (int i = 0; i < 8; ++i) { ypk[h3][i] = pk2(y0[2 * i], y0[2 * i + 1]); ypk[h3][8 + i] = pk2(y1[2 * i], y1[2 * i + 1]); }
            __builtin_amdgcn_sched_barrier(0);
        }
        __syncthreads();
        {
            LAS unsigned short* yst = (LAS unsigned short*)(ldsb + SSD_L_X);
#pragma unroll
            for (int h3 = 0; h3 < 3; ++h3)
#pragma unroll
                for (int ptile = 0; ptile < 2; ++ptile)
#pragma unroll
                    for (int i = 0; i < 8; ++i) {
                        const int reg = 2 * i;
                        const int l0 = 32 * lt + (reg & 3) + 8 * (reg >> 2) + 4 * h;
                        const int col = (3 * hs + h3) * 64 + 32 * ptile + r;
                        const unsigned v = ypk[h3][8 * ptile + i];
                        yst[l0 * (SSD_RS_Y / 2) + col] = (unsigned short)(v & 0xffffu);
                        yst[(l0 + 1) * (SSD_RS_Y / 2) + col] = (unsigned short)(v >> 16);
                    }
        }
        __syncthreads();
#pragma unroll
        for (int pass = 0; pass < 4; ++pass) {
            const int l = 4 * (pass * 8 + w) + (lane >> 4), i16 = lane & 15;
            float gv[3][8]; float ss = 0.f;
#pragma unroll
            for (int k = 0; k < 3; ++k) {
                const int col0 = 24 * i16 + 8 * k;
                float yv[8], zv[8];
                unpack8(*(const LAS v4u*)(ldsb + SSD_L_X + l * SSD_RS_Y + col0 * 2), yv);
                unpack8(*(const v4u*)(projb + (size_t)(t0 + l) * NB_LD + g * 384 + col0), zv);
#pragma unroll
                for (int j = 0; j < 8; ++j) { const float gg = yv[j] * silu_f(zv[j]); gv[k][j] = gg; ss += gg * gg; }
            }
            ss += __shfl_xor(ss, 1); ss += __shfl_xor(ss, 2); ss += __shfl_xor(ss, 4); ss += __shfl_xor(ss, 8);
            const float rstd = rsqrtf(ss * (1.0f / 384.0f) + LN_EPS);
#pragma unroll
            for (int k = 0; k < 3; ++k) {
                const int col0 = g * 384 + 24 * i16 + 8 * k;
                const float4 g0 = *(const float4*)(norm_g + col0), g1 = *(const float4*)(norm_g + col0 + 4);
                v4u o; o.x = pk2(gv[k][0] * rstd * g0.x, gv[k][1] * rstd * g0.y); o.y = pk2(gv[k][2] * rstd * g0.z, gv[k][3] * rstd * g0.w);
                o.z = pk2(gv[k][4] * rstd * g1.x, gv[k][5] * rstd * g1.y); o.w = pk2(gv[k][6] * rstd * g1.z, gv[k][7] * rstd * g1.w);
                *(v4u*)(A1 + (size_t)(t0 + l) * MIX_WIDTH + col0) = o;
            }
        }
    }
}

#define ATT_RS_V 144
#define ATT_VIMG (256 * ATT_RS_V)
#define ATT_HIMG (2 * ATT_VIMG)
#define ATT_PVT(KT) { \
        s16x4 vv_[8]; \
        tr_read8<(32 * KT) * ATT_RS_V, (32 * KT + 8) * ATT_RS_V, (32 * KT) * ATT_RS_V + 64, (32 * KT + 8) * ATT_RS_V + 64, \
                 (32 * KT + 16) * ATT_RS_V, (32 * KT + 24) * ATT_RS_V, (32 * KT + 16) * ATT_RS_V + 64, (32 * KT + 24) * ATT_RS_V + 64>(vbase, vv_); \
        _Pragma("unroll") for (int s2_ = 0; s2_ < 2; ++s2_) { \
            v4u o_; o_.x = pk2(s[KT][8 * s2_ + 0], s[KT][8 * s2_ + 1]); o_.y = pk2(s[KT][8 * s2_ + 2], s[KT][8 * s2_ + 3]); \
            o_.z = pk2(s[KT][8 * s2_ + 4], s[KT][8 * s2_ + 5]); o_.w = pk2(s[KT][8 * s2_ + 6], s[KT][8 * s2_ + 7]); \
            const s16x8 pf_ = __builtin_bit_cast(s16x8, o_); \
            const s16x8 a0_ = s2_ == 0 ? TRCAT(vv_[0], vv_[1]) : TRCAT(vv_[4], vv_[5]); \
            const s16x8 a1_ = s2_ == 0 ? TRCAT(vv_[2], vv_[3]) : TRCAT(vv_[6], vv_[7]); \
            o0 = __builtin_amdgcn_mfma_f32_32x32x16_bf16(a0_, pf_, o0, 0, 0, 0); \
            o1 = __builtin_amdgcn_mfma_f32_32x32x16_bf16(a1_, pf_, o1, 0, 0, 0); } }
__device__ __forceinline__ void ph_attn_prompt(LAS unsigned char* ldsb, const bf16* __restrict__ qrot_b, const bf16* __restrict__ krot_b, const bf16* __restrict__ projb,
                                               bf16* __restrict__ obuf, float* __restrict__ lsebuf, const float* __restrict__ ck, const float* __restrict__ cv, float* __restrict__ out) {
    const int tid = threadIdx.x, w = __builtin_amdgcn_readfirstlane(tid >> 6), lane = tid & 63;
    const int r = lane & 31, h = lane >> 5, blk = (lane >> 4) & 1, q = (lane & 15) >> 2, pp = lane & 3;
    const int qt = w & 3, hsel = w >> 2;
    f32x4n rider[16]; bool pend = false; unsigned pq = 0u;
    for (int unit = blockIdx.x; unit < 3 * 512; unit += gridDim.x) {
        const int pat = unit >> 9, rem = unit & 511, hp = rem & 3, rem2 = rem >> 2, b = rem2 >> 6, bk = rem2 & 63;
        const int dsh = 2 * pat, nper = 64 >> dsh, res = bk >> (6 - dsh), nb = bk & (nper - 1);
        const int head = 2 * hp + hsel;
        __syncthreads();
        { v4u vst[8], kst[8];
#pragma unroll
          for (int it_ = 0; it_ < 8; ++it_) { const int idx = (tid & 255) + it_ * 256;
              const int row = idx >> 3, ch = idx & 7, js = 128 * nb - 128 + row, jc = js < 0 ? 0 : js;
              const size_t tk = (size_t)(b * SEQ + (jc << dsh) + res);
              vst[it_] = *(const v4u*)(projb + tk * NB_LD + NB_V + head * 64 + ch * 8);
              kst[it_] = *(const v4u*)(krot_b + tk * ATT_WIDTH + head * 64 + ch * 8); }
#pragma unroll
          for (int it_ = 0; it_ < 8; ++it_) { const int idx = (tid & 255) + it_ * 256;
              const int row = idx >> 3, ch = idx & 7, js = 128 * nb - 128 + row;
              v4u v = vst[it_], k = kst[it_]; if (js < 0) { v.x = 0u; v.y = 0u; v.z = 0u; v.w = 0u; k = v; }
              *(LAS v4u*)(ldsb + hsel * ATT_HIMG + row * ATT_RS_V + ch * 16) = v;
              *(LAS v4u*)(ldsb + hsel * ATT_HIMG + ATT_VIMG + row * ATT_RS_V + ch * 16) = k; } }
        const int tq = b * SEQ + ((128 * nb + 32 * qt + r) << dsh) + res;
        s16x8 qf[4];
#pragma unroll
        for (int ks = 0; ks < 4; ++ks) qf[ks] = *(const s16x8*)(qrot_b + (size_t)tq * ATT_WIDTH + head * 64 + 16 * ks + 8 * h);
        __syncthreads();
        f32x16 s[5];
#pragma unroll
        for (int kt = 0; kt < 5; ++kt) {
            const LAS unsigned char* kp = ldsb + hsel * ATT_HIMG + ATT_VIMG + (32 * qt + 32 * kt + r) * ATT_RS_V + 16 * h;
#pragma unroll
            for (int i = 0; i < 16; ++i) s[kt][i] = 0.f;
#pragma unroll
            for (int ks = 0; ks < 4; ++ks) s[kt] = __builtin_amdgcn_mfma_f32_32x32x16_bf16(*(const LAS s16x8*)(kp + 32 * ks), qf[ks], s[kt], 0, 0, 0);
        }
        if (pend) copy_q_store(out, pq, (unsigned)lane, rider);
        float m = -INFINITY;
#pragma unroll
        for (int kt = 0; kt < 5; ++kt) {
            const bool tile_ok = (nb > 0) || (qt + kt >= 4);
#pragma unroll
            for (int reg = 0; reg < 16; ++reg) {
                const int c = (reg & 3) + 8 * (reg >> 2) + 4 * h;
                const bool ok = tile_ok && (kt == 0 ? (c >= r) : (kt == 4 ? (c <= r) : true));
                const float v = ok ? s[kt][reg] * 0.125f : -INFINITY;
                s[kt][reg] = v; m = fmaxf(m, v);
            }
        }
        m = fmaxf(m, __shfl_xor(m, 32));
        float l = 0.f;
#pragma unroll
        for (int kt = 0; kt < 5; ++kt)
#pragma unroll
            for (int reg = 0; reg < 16; ++reg) { const float p = __expf(s[kt][reg] - m); s[kt][reg] = p; l += p; }
        l += __shfl_xor(l, 32);
        pq = (unsigned)(unit * NWAVE + w); copy_q_load(ck, cv, pq, (unsigned)lane, rider); pend = true;
        f32x16 o0, o1;
#pragma unroll
        for (int i = 0; i < 16; ++i) { o0[i] = 0.f; o1[i] = 0.f; }
        const unsigned vbase = lds_addr(ldsb + hsel * ATT_HIMG) + (32 * qt + 4 * h + q) * ATT_RS_V + (16 * blk + 4 * pp) * 2;
        ATT_PVT(0) ATT_PVT(1) ATT_PVT(2) ATT_PVT(3) ATT_PVT(4)
        const float inv = 1.0f / l;
        bf16* op = obuf + ((size_t)pat * T_PROMPT + tq) * ATT_WIDTH + head * 64 + 8 * h;
#pragma unroll
        for (int k2 = 0; k2 < 4; ++k2) {
            unsigned ax, ay, bx, by;
            if (k2 < 2) { ax = pk2(o0[8 * k2] * inv, o0[8 * k2 + 1] * inv); ay = pk2(o0[8 * k2 + 2] * inv, o0[8 * k2 + 3] * inv);
                          bx = pk2(o0[8 * k2 + 4] * inv, o0[8 * k2 + 5] * inv); by = pk2(o0[8 * k2 + 6] * inv, o0[8 * k2 + 7] * inv); }
            else { const int k3 = k2 - 2;
                   ax = pk2(o1[8 * k3] * inv, o1[8 * k3 + 1] * inv); ay = pk2(o1[8 * k3 + 2] * inv, o1[8 * k3 + 3] * inv);
                   bx = pk2(o1[8 * k3 + 4] * inv, o1[8 * k3 + 5] * inv); by = pk2(o1[8 * k3 + 6] * inv, o1[8 * k3 + 7] * inv); }
            const auto rx = __builtin_amdgcn_permlane32_swap(ax, bx, false, false);
            const auto ry = __builtin_amdgcn_permlane32_swap(ay, by, false, false);
            v4u o; o.x = rx[0]; o.y = ry[0]; o.z = rx[1]; o.w = ry[1];
            *(v4u*)(op + 16 * k2) = o;
        }
        if (h == 0) lsebuf[((size_t)pat * T_PROMPT + tq) * 8 + head] = m + __logf(l);
    }
    if (pend) copy_q_store(out, pq, (unsigned)lane, rider);
}
__device__ __forceinline__ void ph_attn_combine(const bf16* __restrict__ obuf, const float* __restrict__ lsebuf, bf16* __restrict__ A1) {
    const int lane = threadIdx.x & 63;
#pragma unroll 4
    for (int t = blockIdx.x * NWAVE + (threadIdx.x >> 6); t < T_PROMPT; t += gridDim.x * NWAVE) {
        const int hd = lane >> 3;
        const float l0 = lsebuf[((size_t)0 * T_PROMPT + t) * 8 + hd], l1 = lsebuf[((size_t)1 * T_PROMPT + t) * 8 + hd], l2 = lsebuf[((size_t)2 * T_PROMPT + t) * 8 + hd];
        const float mx = fmaxf(l0, fmaxf(l1, l2));
        const float e0 = __expf(l0 - mx), e1 = __expf(l1 - mx), e2 = __expf(l2 - mx);
        const float inv = 1.0f / (e0 + e1 + e2);
        float a[8], b[8], c[8];
        unpack8(*(const v4u*)(obuf + ((size_t)0 * T_PROMPT + t) * ATT_WIDTH + lane * 8), a);
        unpack8(*(const v4u*)(obuf + ((size_t)1 * T_PROMPT + t) * ATT_WIDTH + lane * 8), b);
        unpack8(*(const v4u*)(obuf + ((size_t)2 * T_PROMPT + t) * ATT_WIDTH + lane * 8), c);
        float o[8];
#pragma unroll
        for (int j = 0; j < 8; ++j) o[j] = (e0 * a[j] + e1 * b[j] + e2 * c[j]) * inv;
        v4u w; w.x = pk2(o[0], o[1]); w.y = pk2(o[2], o[3]); w.z = pk2(o[4], o[5]); w.w = pk2(o[6], o[7]);
        *(v4u*)(A1 + (size_t)t * MIX_WIDTH + SSD_WIDTH + lane * 8) = w;
    }
}

#define RT_RS 272
#define RT_KIMG (128 * RT_RS)
#define RT_LUT (2 * RT_KIMG)
constexpr unsigned char RT_CANDS[64] = {0, 1, 2, 3, 4, 5, 6, 7, 8, 9, 10, 11, 12, 13, 14, 15, 16, 17, 18, 19, 20, 21, 22, 23, 32, 33, 34, 35, 36, 48, 49, 50, 51, 64, 65, 66, 80, 81, 96, 97,
                                        112, 113, 128, 144, 160, 176, 192, 208, 224, 240, 0, 0, 0, 0, 0, 0, 0, 0, 0, 0, 0, 0, 0, 0};
__device__ __forceinline__ unsigned rt_mono(float f) { const unsigned u = __builtin_bit_cast(unsigned, f); return u ^ ((unsigned)((int)u >> 31) | 0x80000000u); }
__device__ __forceinline__ float rt_unmono(unsigned m) { const unsigned u = (m & 0x80000000u) ? (m ^ 0x80000000u) : ~m; return __builtin_bit_cast(float, u); }
#define RT_CE_DESC(a, b) { const unsigned x_ = (a), y_ = (b); (a) = x_ > y_ ? x_ : y_; (b) = x_ > y_ ? y_ : x_; }
#define RT_CE_ASC(a, b) { const unsigned x_ = (a), y_ = (b); (a) = x_ > y_ ? y_ : x_; (b) = x_ > y_ ? x_ : y_; }
__device__ __forceinline__ void rt_sort16(unsigned (&v)[16]) {
#pragma unroll
    for (int k = 2; k <= 16; k <<= 1)
#pragma unroll
        for (int j = k >> 1; j > 0; j >>= 1)
#pragma unroll
            for (int i = 0; i < 16; ++i) { const int l = i ^ j; if (l > i) { if ((i & k) == 0) RT_CE_DESC(v[i], v[l]) else RT_CE_ASC(v[i], v[l]) } }
}
__device__ __forceinline__ void rt_merge16(unsigned (&v)[16]) {
#pragma unroll
    for (int j = 8; j > 0; j >>= 1)
#pragma unroll
        for (int i = 0; i < 16; ++i) { const int l = i ^ j; if (l > i) RT_CE_DESC(v[i], v[l]) }
}
__device__ __forceinline__ void rt_top16(unsigned (&a)[16], const unsigned (&b)[16]) {
#pragma unroll
    for (int i = 0; i < 16; ++i) a[i] = a[i] > b[15 - i] ? a[i] : b[15 - i];
    rt_merge16(a);
}
__device__ __forceinline__ void rt_top16_partner(unsigned (&a)[16]) {
    unsigned b[16];
#pragma unroll
    for (int i = 0; i < 16; ++i) b[i] = (unsigned)__shfl_xor((int)a[i], 32);
    rt_top16(a, b);
}
__device__ __forceinline__ void rt_scores_top16(LAS unsigned char* kimg, const bf16* __restrict__ qp, int r, int h, unsigned (&k0)[16]) {
    f32x16 acc[4];
#pragma unroll
    for (int kt = 0; kt < 4; ++kt)
#pragma unroll
        for (int i = 0; i < 16; ++i) acc[kt][i] = 0.f;
#pragma unroll
    for (int ks = 0; ks < 8; ++ks) {
        const s16x8 qf = *(const s16x8*)(qp + 16 * ks);
#pragma unroll
        for (int kt = 0; kt < 4; ++kt) {
            const s16x8 kf = *(const LAS s16x8*)(kimg + (32 * kt + r) * RT_RS + (16 * ks + 8 * h) * 2);
            acc[kt] = __builtin_amdgcn_mfma_f32_32x32x16_bf16(kf, qf, acc[kt], 0, 0, 0);
        }
    }
    unsigned k1[16], k2[16], k3[16];
#pragma unroll
    for (int reg = 0; reg < 16; ++reg) {
        const unsigned ki = (unsigned)((reg & 3) + 8 * (reg >> 2) + 4 * h);
        k0[reg] = (rt_mono(acc[0][reg]) & 0xFFFFFF80u) | ki;
        k1[reg] = (rt_mono(acc[1][reg]) & 0xFFFFFF80u) | (ki + 32u);
        k2[reg] = (rt_mono(acc[2][reg]) & 0xFFFFFF80u) | (ki + 64u);
        k3[reg] = (rt_mono(acc[3][reg]) & 0xFFFFFF80u) | (ki + 96u);
    }
    rt_sort16(k0); rt_sort16(k1); rt_sort16(k2); rt_sort16(k3);
    rt_top16(k0, k1); rt_top16(k2, k3); rt_top16(k0, k2);
    rt_top16_partner(k0);
}
__device__ __forceinline__ void ph_peer_route2(LAS unsigned char* ldsb, const bf16* __restrict__ qhb, const float* __restrict__ keys1, const float* __restrict__ keys2,
                                               int* __restrict__ eidx, float* __restrict__ gate, const float* __restrict__ ck, const float* __restrict__ cv, float* __restrict__ out) {
    const int tid = threadIdx.x, w = __builtin_amdgcn_readfirstlane(tid >> 6), lane = tid & 63, r = lane & 31, h = lane >> 5;
    __syncthreads();
    for (int idx = tid; idx < 2 * 128 * 16; idx += NTHR) {
        const int tb = idx >> 11, rem = idx & 2047, row = rem >> 4, ch = rem & 15;
        const float* sp = (tb ? keys2 : keys1) + row * 128 + ch * 8;
        const float4 a = *(const float4*)sp, b = *(const float4*)(sp + 4);
        v4u o; o.x = pk2(a.x, a.y); o.y = pk2(a.z, a.w); o.z = pk2(b.x, b.y); o.w = pk2(b.z, b.w);
        *(LAS v4u*)(ldsb + tb * RT_KIMG + row * RT_RS + ch * 16) = o;
    }
    __syncthreads();
    LAS unsigned* lut = (LAS unsigned*)(ldsb + RT_LUT) + w * 512;
    for (int unit = blockIdx.x * NWAVE + w; unit < (T_ALL / 32) * 8; unit += gridDim.x * NWAVE) {
        const int tt = unit >> 3, hd = unit & 7;
        const int tok = 32 * tt + r;
        const bf16* qp = qhb + (size_t)tok * 2048 + hd * 256 + 8 * h;
        unsigned ka[16], kb[16];
        rt_scores_top16(ldsb, qp, r, h, ka);
        rt_scores_top16(ldsb + RT_KIMG, qp + 128, r, h, kb);
        float v1[16], v2[16];
#pragma unroll
        for (int i = 0; i < 16; ++i) { v1[i] = rt_unmono(ka[i] & 0xFFFFFF80u); v2[i] = rt_unmono(kb[i] & 0xFFFFFF80u); }
#pragma unroll
        for (int wd = 0; wd < 4; ++wd) {
            lut[wd * 64 + lane] = (ka[4 * wd] & 0x7Fu) | ((ka[4 * wd + 1] & 0x7Fu) << 8) | ((ka[4 * wd + 2] & 0x7Fu) << 16) | ((ka[4 * wd + 3] & 0x7Fu) << 24);
            lut[(4 + wd) * 64 + lane] = (kb[4 * wd] & 0x7Fu) | ((kb[4 * wd + 1] & 0x7Fu) << 8) | ((kb[4 * wd + 2] & 0x7Fu) << 16) | ((kb[4 * wd + 3] & 0x7Fu) << 24);
        }
        unsigned c0[16], c1[16];
        c0[0] = (rt_mono(h ? (v1[0] + v2[1]) : (v1[0] + v2[0])) & 0xFFFFFF00u) | (h ? 1u : 0u);
        c0[1] = (rt_mono(h ? (v1[0] + v2[3]) : (v1[0] + v2[2])) & 0xFFFFFF00u) | (h ? 3u : 2u);
        c0[2] = (rt_mono(h ? (v1[0] + v2[5]) : (v1[0] + v2[4])) & 0xFFFFFF00u) | (h ? 5u : 4u);
        c0[3] = (rt_mono(h ? (v1[0] + v2[7]) : (v1[0] + v2[6])) & 0xFFFFFF00u) | (h ? 7u : 6u);
        c0[4] = (rt_mono(h ? (v1[0] + v2[9]) : (v1[0] + v2[8])) & 0xFFFFFF00u) | (h ? 9u : 8u);
        c0[5] = (rt_mono(h ? (v1[0] + v2[11]) : (v1[0] + v2[10])) & 0xFFFFFF00u) | (h ? 11u : 10u);
        c0[6] = (rt_mono(h ? (v1[0] + v2[13]) : (v1[0] + v2[12])) & 0xFFFFFF00u) | (h ? 13u : 12u);
        c0[7] = (rt_mono(h ? (v1[0] + v2[15]) : (v1[0] + v2[14])) & 0xFFFFFF00u) | (h ? 15u : 14u);
        c0[8] = (rt_mono(h ? (v1[1] + v2[1]) : (v1[1] + v2[0])) & 0xFFFFFF00u) | (h ? 17u : 16u);
        c0[9] = (rt_mono(h ? (v1[1] + v2[3]) : (v1[1] + v2[2])) & 0xFFFFFF00u) | (h ? 19u : 18u);
        c0[10] = (rt_mono(h ? (v1[1] + v2[5]) : (v1[1] + v2[4])) & 0xFFFFFF00u) | (h ? 21u : 20u);
        c0[11] = (rt_mono(h ? (v1[1] + v2[7]) : (v1[1] + v2[6])) & 0xFFFFFF00u) | (h ? 23u : 22u);
        c0[12] = (rt_mono(h ? (v1[2] + v2[1]) : (v1[2] + v2[0])) & 0xFFFFFF00u) | (h ? 33u : 32u);
        c0[13] = (rt_mono(h ? (v1[2] + v2[3]) : (v1[2] + v2[2])) & 0xFFFFFF00u) | (h ? 35u : 34u);
        c0[14] = (rt_mono(h ? (v1[3] + v2[0]) : (v1[2] + v2[4])) & 0xFFFFFF00u) | (h ? 48u : 36u);
        c0[15] = (rt_mono(h ? (v1[3] + v2[2]) : (v1[3] + v2[1])) & 0xFFFFFF00u) | (h ? 50u : 49u);
        c1[0] = (rt_mono(h ? (v1[4] + v2[0]) : (v1[3] + v2[3])) & 0xFFFFFF00u) | (h ? 64u : 51u);
        c1[1] = (rt_mono(h ? (v1[4] + v2[2]) : (v1[4] + v2[1])) & 0xFFFFFF00u) | (h ? 66u : 65u);
        c1[2] = (rt_mono(h ? (v1[5] + v2[1]) : (v1[5] + v2[0])) & 0xFFFFFF00u) | (h ? 81u : 80u);
        c1[3] = (rt_mono(h ? (v1[6] + v2[1]) : (v1[6] + v2[0])) & 0xFFFFFF00u) | (h ? 97u : 96u);
        c1[4] = (rt_mono(h ? (v1[7] + v2[1]) : (v1[7] + v2[0])) & 0xFFFFFF00u) | (h ? 113u : 112u);
        c1[5] = (rt_mono(h ? (v1[9] + v2[0]) : (v1[8] + v2[0])) & 0xFFFFFF00u) | (h ? 144u : 128u);
        c1[6] = (rt_mono(h ? (v1[11] + v2[0]) : (v1[10] + v2[0])) & 0xFFFFFF00u) | (h ? 176u : 160u);
        c1[7] = (rt_mono(h ? (v1[13] + v2[0]) : (v1[12] + v2[0])) & 0xFFFFFF00u) | (h ? 208u : 192u);
        c1[8] = (rt_mono(h ? (v1[15] + v2[0]) : (v1[14] + v2[0])) & 0xFFFFFF00u) | (h ? 240u : 224u);
        c1[9] = 0u;
        c1[10] = 0u;
        c1[11] = 0u;
        c1[12] = 0u;
        c1[13] = 0u;
        c1[14] = 0u;
        c1[15] = 0u;
        rt_sort16(c0); rt_sort16(c1); rt_top16(c0, c1); rt_top16_partner(c0);
        float e[16]; float sum = 0.f;
        const float mx = rt_unmono(c0[0] & 0xFFFFFF00u);
#pragma unroll
        for (int k = 0; k < 16; ++k) { e[k] = __expf(rt_unmono(c0[k] & 0xFFFFFF00u) - mx); sum += e[k]; }
        const float inv = 1.0f / sum;
        asm volatile("s_waitcnt lgkmcnt(0)" ::: "memory");
        int ex[8]; float gv[8];
#pragma unroll
        for (int k = 0; k < 8; ++k) {
            const unsigned hm = (unsigned)(-h);
            const unsigned ck = (c0[k] & ~hm) | (c0[8 + k] & hm);
            const float ek = __builtin_bit_cast(float, (__builtin_bit_cast(unsigned, e[k]) & ~hm) | (__builtin_bit_cast(unsigned, e[8 + k]) & hm));
            const unsigned ci = (ck >> 4) & 15u, cj = ck & 15u;
            const unsigned w1 = lut[(ci >> 2) * 64 + lane], w2 = lut[(4 + (cj >> 2)) * 64 + lane];
            const unsigned i1 = (w1 >> (8 * (ci & 3))) & 0x7Fu, i2 = (w2 >> (8 * (cj & 3))) & 0x7Fu;
            ex[k] = (int)(i1 * PEER_NKEYS + i2); gv[k] = ek * inv;
        }
        int* ep = eidx + (size_t)tok * 128 + hd * 16 + 8 * h; float* gp = gate + (size_t)tok * 128 + hd * 16 + 8 * h;
        *(int4*)ep = make_int4(ex[0], ex[1], ex[2], ex[3]); *(int4*)(ep + 4) = make_int4(ex[4], ex[5], ex[6], ex[7]);
        *(float4*)gp = make_float4(gv[0], gv[1], gv[2], gv[3]); *(float4*)(gp + 4) = make_float4(gv[4], gv[5], gv[6], gv[7]);
    }
    { const unsigned gwv = blockIdx.x * NWAVE + w; if (gridDim.x == 256 && gwv >= 128u) cache_copy_slice(ck, cv, out, 7040u + (gwv - 128u), (unsigned)lane); }
}

struct Params {
    const float* in[23];
    float* out;
    unsigned char* ws;
    unsigned* bar;
};

#define WS_BAR      0ull
#define WS_XALL     (1ull << 20)
#define WS_PROJ     (WS_XALL + (size_t)T_ALL * D_MODEL * 4)
#define WS_XBC      (WS_PROJ + (size_t)T_ALL * PROJ_LD * 4)
#define WS_DT       (WS_XBC + (size_t)T_ALL * CONV_DIM * 4)
#define WS_QROT     (WS_DT + (size_t)T_ALL * SSD_HEADS * 4)
#define WS_KROT     (WS_QROT + (size_t)T_ALL * ATT_WIDTH * 4)
#define WS_YBUF     (WS_KROT + (size_t)T_ALL * ATT_WIDTH * 4)
#define WS_MIX      (WS_YBUF + (size_t)T_ALL * MIX_WIDTH * 4)
#define WS_HBUF     (WS_MIX + (size_t)T_ALL * D_MODEL * 4)
#define WS_QH       (WS_HBUF + (size_t)T_ALL * D_MODEL * 4)
#define WS_EIDX     (WS_QH + (size_t)T_ALL * 2048 * 4)
#define WS_GATE     (WS_EIDX + (size_t)T_ALL * 128 * 4)
#define WS_A0       (WS_GATE + (size_t)T_ALL * 128 * 4)
#define WS_A1       (WS_A0 + (size_t)T_ALL * D_MODEL * 2)
#define WS_A2       (WS_A1 + (size_t)T_ALL * MIX_WIDTH * 2)
#define WS_WTIN     (WS_A2 + (size_t)T_ALL * D_MODEL * 2)
#define WS_WTOUT    (WS_WTIN + (size_t)PROJ_LD * D_MODEL * 2)
#define WS_WTQ      (WS_WTOUT + (size_t)D_MODEL * MIX_WIDTH * 2)
#define WS_PROJB    (WS_WTQ + (size_t)2048 * D_MODEL * 2)
#define WS_DTRAW    (WS_PROJB + (size_t)T_ALL * NB_LD * 2)
#define WS_XBCB     (WS_DTRAW + (size_t)T_ALL * 32 * 4)
#define WS_QROTB    (WS_XBCB + (size_t)T_ALL * CONV_DIM * 2)
#define WS_KROTB    (WS_QROTB + (size_t)T_ALL * ATT_WIDTH * 2)
#define WS_UB       (WS_KROTB + (size_t)T_ALL * ATT_WIDTH * 2)
#define WS_VB       (WS_UB + (size_t)16384 * D_MODEL * 2)
#define WS_USC      (WS_VB + (size_t)16384 * D_MODEL * 2)
#define WS_VSC      (WS_USC + 16384 * 4)
#define WS_SBUF     (WS_VSC + 16384 * 4)
#define WS_HIN      (WS_SBUF + (size_t)BATCH * 64 * SSD_HEADS * 64 * 128 * 2)
#define WS_CDEC     (WS_HIN + (size_t)BATCH * 64 * SSD_HEADS * 64 * 128 * 2)
#define WS_OBUF     (WS_CDEC + (size_t)BATCH * 64 * SSD_HEADS * 4)
#define WS_LSE      (WS_OBUF + (size_t)3 * T_PROMPT * ATT_WIDTH * 2)
#define WS_ROPE     (WS_LSE + (size_t)3 * T_PROMPT * 8 * 4)
#define WS_END      (WS_ROPE + (size_t)SEQ * 64 * 4)

#define LDS_BYTES (160 * 1024)

#define KP const __attribute__((address_space(4))) Params* kp = (const __attribute__((address_space(4))) Params*)__builtin_amdgcn_kernarg_segment_ptr(); asm volatile("" : "+s"(kp)); unsigned char* ws = kp->ws; (void)ws;
#define IN(i) (kp->in[i])
#define WSP(T, off) ((T*)(ws + (off)))
__global__ void __launch_bounds__(512, 2) mega_fwd(Params p) {
    extern __shared__ __attribute__((aligned(16))) unsigned char smem[];
    if (threadIdx.x == 0) *(uint4*)smem = make_uint4(0u, 0u, 0u, 0u);
    __syncthreads();
    XcdBarrier bar = xcd_barrier_post(p.bar, (volatile LAS unsigned*)smem);
    float* lds = (float*)(smem + 256);
    LAS unsigned char* ldsb = (LAS unsigned char*)smem + 256;

    { KP ph_prologue(ldsb, IN(0), IN(1), WSP(bf16, WS_A0), IN(6), WSP(bf16, WS_WTIN), WSP(float, WS_ROPE)); }
    xcd_barrier(bar);
    { KP pg8::Gemm g{WSP(bf16, WS_A0), WSP(bf16, WS_WTIN), T_ALL, PROJ_LD, D_MODEL}; pg8::StaticOrder S; S.init(g.M, g.N, (int)gridDim.x, (int)blockIdx.x);
      pg8::EpiProj E{WSP(bf16, WS_PROJB), WSP(float, WS_DTRAW)}; pg8::gemm_phase<pg8::EpiProj, pg8::StaticOrder, false>(ldsb, g, S, E, nullptr); }
    xcd_barrier(bar);
    { KP ph_post_proj_prompt(WSP(bf16, WS_PROJB), WSP(float, WS_DTRAW), IN(7), IN(8), IN(9), WSP(float, WS_ROPE), WSP(bf16, WS_XBCB), WSP(float, WS_DT), WSP(bf16, WS_QROTB), WSP(bf16, WS_KROTB), kp->out); }
    { KP ph_post_proj2(WSP(bf16, WS_PROJB), WSP(float, WS_DTRAW), IN(4), IN(7), IN(8), IN(9), WSP(bf16, WS_XBCB), WSP(float, WS_DT), WSP(bf16, WS_QROTB), WSP(bf16, WS_KROTB), kp->out); }
    xcd_barrier(bar);
    { KP ph_ssd_states(ldsb, WSP(bf16, WS_XBCB), WSP(float, WS_DT), IN(10), WSP(bf16, WS_SBUF), WSP(float, WS_CDEC), IN(2), IN(3), kp->out); }
    __syncthreads();
    { KP ph_attn_prompt(ldsb, WSP(bf16, WS_QROTB), WSP(bf16, WS_KROTB), WSP(bf16, WS_PROJB), WSP(bf16, WS_OBUF), WSP(float, WS_LSE), IN(2), IN(3), kp->out); }
    __syncthreads();
    { KP ph_ssd_decode(WSP(bf16, WS_XBCB), WSP(float, WS_DT), IN(10), IN(11), IN(5), WSP(float, WS_YBUF), kp->out); }
    { KP ph_attn_sample3(lds, WSP(bf16, WS_QROTB), WSP(bf16, WS_KROTB), WSP(bf16, WS_PROJB), IN(2), IN(3), WSP(bf16, WS_A1)); }
    xcd_barrier(bar);
    if ((int)gridDim.x > 128) {
        if ((int)blockIdx.x < 96) { KP ph_ssd_scan(WSP(bf16, WS_SBUF), WSP(float, WS_CDEC), WSP(bf16, WS_HIN), kp->out, (int)blockIdx.x, 96); }
        else {
            { KP ph_prologue2(ldsb, IN(13), WSP(bf16, WS_WTOUT), IN(16), WSP(bf16, WS_WTQ), (int)blockIdx.x - 96, (int)gridDim.x - 96); }
            { KP ph_quant_tables(IN(19), IN(20), WSP(unsigned char, WS_UB), WSP(unsigned char, WS_VB), WSP(float, WS_USC), WSP(float, WS_VSC), (int)blockIdx.x - 96, (int)gridDim.x - 96); }
        }
    } else {
        { KP ph_ssd_scan(WSP(bf16, WS_SBUF), WSP(float, WS_CDEC), WSP(bf16, WS_HIN), kp->out, (int)blockIdx.x, (int)gridDim.x); }
        { KP ph_prologue2(ldsb, IN(13), WSP(bf16, WS_WTOUT), IN(16), WSP(bf16, WS_WTQ), (int)blockIdx.x, (int)gridDim.x); }
        { KP ph_quant_tables(IN(19), IN(20), WSP(unsigned char, WS_UB), WSP(unsigned char, WS_VB), WSP(float, WS_USC), WSP(float, WS_VSC), (int)blockIdx.x, (int)gridDim.x); }
    }
    xcd_barrier(bar);
    { KP ph_ssd_out(ldsb, WSP(bf16, WS_XBCB), WSP(bf16, WS_PROJB), WSP(float, WS_DT), IN(10), IN(11), IN(12), WSP(bf16, WS_HIN), WSP(bf16, WS_A1)); }
    { KP ph_attn_combine(WSP(bf16, WS_OBUF), WSP(float, WS_LSE), WSP(bf16, WS_A1)); }
    { KP ph_gate_norm(WSP(bf16, WS_PROJB), IN(12), WSP(float, WS_YBUF), WSP(bf16, WS_A1)); }
    xcd_barrier(bar);
    { KP pg8::Gemm g{WSP(bf16, WS_A1), WSP(bf16, WS_WTOUT), T_ALL, D_MODEL, MIX_WIDTH}; pg8::StaticOrder S; S.init(g.M, g.N, (int)gridDim.x, (int)blockIdx.x);
      pg8::EpiBf16Plain E{WSP(bf16, WS_MIX), D_MODEL}; pg8::gemm_phase<pg8::EpiBf16Plain, pg8::StaticOrder, false>(ldsb, g, S, E, nullptr); }
    if (blockIdx.x >= 8 && gridDim.x == 256) { KP cache_copy_slice(IN(2), IN(3), kp->out, 4096u + (blockIdx.x - 8) * 8u + (threadIdx.x >> 6), threadIdx.x & 63u); }
    xcd_barrier(bar);
    { KP ph_ln_res(IN(0), IN(1), WSP(bf16, WS_MIX), IN(14), IN(15), WSP(bf16, WS_A2)); }
    xcd_barrier(bar);
    { KP pg8::Gemm g{WSP(bf16, WS_A2), WSP(bf16, WS_WTQ), T_ALL, 2048, D_MODEL}; pg8::StaticOrder S; S.init(g.M, g.N, (int)gridDim.x, (int)blockIdx.x);
      pg8::EpiBf16Plain E{WSP(bf16, WS_QH), 2048}; pg8::gemm_phase<pg8::EpiBf16Plain, pg8::StaticOrder, false>(ldsb, g, S, E, nullptr); }
    if (blockIdx.x >= 16 && gridDim.x == 256 && threadIdx.x < 256) { KP cache_copy_slice(IN(2), IN(3), kp->out, 4096u + 1984u + (blockIdx.x - 16) * 4u + (threadIdx.x >> 6), threadIdx.x & 63u); }
    xcd_barrier(bar);
    { KP ph_peer_route2(ldsb, WSP(bf16, WS_QH), IN(17), IN(18), WSP(int, WS_EIDX), WSP(float, WS_GATE), IN(2), IN(3), kp->out); }
    xcd_barrier(bar);
    { KP ph_peer_ffn3(WSP(bf16, WS_A2), WSP(int, WS_EIDX), WSP(float, WS_GATE), WSP(unsigned char, WS_UB), WSP(unsigned char, WS_VB), WSP(float, WS_USC), WSP(float, WS_VSC), IN(21), IN(22), kp->out, IN(2), IN(3), gridDim.x == 256 ? 8960u : 4096u); }
}

extern "C" void kernel_launch(void* const* d_in, const int* in_sizes, int n_in, void* d_out, int out_size, void* d_ws, size_t ws_size, hipStream_t stream) {
    static int grid = 0;
    if (grid == 0) {
        int dev = 0, cus = 0, per_cu = 0;
        if (hipGetDevice(&dev) != hipSuccess || hipDeviceGetAttribute(&cus, hipDeviceAttributeMultiprocessorCount, dev) != hipSuccess) { fprintf(stderr, "kernel_launch: device query failed\n"); grid = -1; return; }
        if (hipFuncSetAttribute((const void*)mega_fwd, hipFuncAttributeMaxDynamicSharedMemorySize, LDS_BYTES) != hipSuccess) { fprintf(stderr, "kernel_launch: hipFuncSetAttribute failed\n"); grid = -1; return; }
        if (hipOccupancyMaxActiveBlocksPerMultiprocessor(&per_cu, (const void*)mega_fwd, NTHR, LDS_BYTES) != hipSuccess || per_cu < 1) { fprintf(stderr, "kernel_launch: occupancy query says %d\n", per_cu); }
        (void)hipGetLastError();
        grid = cus;
        if (ws_size < WS_END) { fprintf(stderr, "kernel_launch: workspace too small\n"); grid = -1; return; }
    }
    if (grid < 0) return;
    (void)hipMemsetAsync((char*)d_ws + WS_BAR, 0, XCD_BAR_WORDS * sizeof(unsigned), stream);
    Params p{};
    for (int i = 0; i < 23; ++i) p.in[i] = (const float*)d_in[i];
    p.out = (float*)d_out; p.ws = (unsigned char*)d_ws; p.bar = (unsigned*)((char*)d_ws + WS_BAR);
    hipLaunchKernelGGL(mega_fwd, dim3(grid), dim3(NTHR), LDS_BYTES, stream, p);
}
```

```cpp
#include <hip/hip_runtime.h>
#include <stdint.h>

#define D_MODEL 1024
#define BATCH 2
#define SEQ 8192
#define DEC_BATCH 128
#define DEC_SEQ 4
#define PAST_LEN 8192
#define HEAD_DIM 64
#define ATT_WIDTH 512
#define ATT_HEADS 8
#define SSD_WIDTH 1536
#define SSD_HEADS 24
#define SSD_GROUPS 4
#define SSD_STATE 128
#define CONV_DIM 2560
#define IN_WIDTH 5656
#define PROJ_LD 5888
#define MIX_WIDTH 2048
#define WBUF 2048
#define PEER_NKEYS 128
#define PEER_HEADS 8
#define PEER_TOPK 16
#define PEER_DKEY 256
#define T_PROMPT (BATCH * SEQ)
#define T_SAMPLE (DEC_BATCH * DEC_SEQ)
#define T_ALL (T_PROMPT + T_SAMPLE)
#define O_Z 0
#define O_XBC 1536
#define O_DT 4096
#define O_Q 4120
#define O_K 4632
#define O_V 5144
#define ALPHA_F 1.189207115002721f
#define LN_EPS 1e-5f

#define OUT_YP 0ull
#define OUT_YS (OUT_YP + 16777216ull)
#define OUT_PK (OUT_YS + 524288ull)
#define OUT_PV (OUT_PK + 2097152ull)
#define OUT_PC (OUT_PV + 2097152ull)
#define OUT_PS (OUT_PC + 15360ull)
#define OUT_SK (OUT_PS + 393216ull)
#define OUT_SV (OUT_SK + 134217728ull)
#define OUT_SC (OUT_SV + 134217728ull)
#define OUT_SS (OUT_SC + 983040ull)

__constant__ double ROPE_INV_REV[32] = {
    1.59154943091895346e-01, 1.19349370211248862e-01, 8.94994016088910133e-02, 6.71150830052272551e-02,
    5.03292121044870353e-02, 3.77415847174197711e-02, 2.83021958306233987e-02, 2.12236527647776604e-02,
    1.59154943091895339e-02, 1.19349370211248862e-02, 8.94994016088910237e-03, 6.71150830052272534e-03,
    5.03292121044870370e-03, 3.77415847174197719e-03, 2.83021958306233987e-03, 2.12236527647776622e-03,
    1.59154943091895356e-03, 1.19349370211248849e-03, 8.94994016088910237e-04, 6.71150830052272599e-04,
    5.03292121044870326e-04, 3.77415847174197741e-04, 2.83021958306233954e-04, 2.12236527647776605e-04,
    1.59154943091895351e-04, 1.19349370211248862e-04, 8.94994016088910182e-05, 6.71150830052272545e-05,
    5.03292121044870354e-05, 3.77415847174197768e-05, 2.83021958306233961e-05, 2.12236527647776592e-05
};

__device__ __forceinline__ float silu_f(float x) { return x * __builtin_amdgcn_rcpf(1.0f + __expf(-x)); }
__device__ __forceinline__ float softplus_f(float x) { return fmaxf(x, 0.f) + log1pf(__expf(-fabsf(x))); }
__device__ __forceinline__ float gelu_f(float x) { return 0.5f * x * (1.0f + erff(x * 0.70710678118654752f)); }
__device__ __forceinline__ float wave_sum(float v) {
#pragma unroll
    for (int o = 32; o > 0; o >>= 1) v += __shfl_xor(v, o);
    return v;
}
__device__ __forceinline__ float wave_max(float v) {
#pragma unroll
    for (int o = 32; o > 0; o >>= 1) v = fmaxf(v, __shfl_xor(v, o));
    return v;
}

#include <cstdio>
#define XB_TMO      128
#define XB_XCNT(j)  (256  + 64 * (j))
#define XB_XSUB(j)  (1280 + 64 * (j))
#define XB_XGEN(j)  (2304 + 64 * (j))
#define XB_TOP      3328
#define XB_TOPGEN   3392
#define XCD_BAR_WORDS 3456
#define XB_SPIN_CAP (1u << 18)
#define LAS __attribute__((address_space(3)))

__device__ __forceinline__ unsigned xb_ld(unsigned* p)              { return __hip_atomic_load(p, __ATOMIC_RELAXED, __HIP_MEMORY_SCOPE_AGENT); }
__device__ __forceinline__ unsigned xb_add(unsigned* p, unsigned v) { return __hip_atomic_fetch_add(p, v, __ATOMIC_RELAXED, __HIP_MEMORY_SCOPE_AGENT); }
__device__ __forceinline__ unsigned xb_xcc_id() { return (unsigned)__builtin_amdgcn_s_getreg((3 << 11) | 20) & 0xFu; }
#define XB_SPIN(cond, bar) do { unsigned _sp = 0; while (cond) { __builtin_amdgcn_s_sleep(1); \
    if ((++_sp & 255u) == 0u) { if (xb_ld(&(bar)[XB_TMO])) break; if (_sp > XB_SPIN_CAP) { atomicAdd(&(bar)[XB_TMO], 1u); break; } } } } while (0)

struct XcdBarrier {
    unsigned* bar; unsigned x;
    volatile LAS unsigned* st;
};

__device__ __forceinline__ XcdBarrier xcd_barrier_post(unsigned* bar, volatile LAS unsigned* st) {
    XcdBarrier b; b.bar = bar; b.x = xb_xcc_id(); b.st = st;
    if (threadIdx.x == 0) (void)xb_add(&bar[XB_XCNT(b.x)], 1u);
    return b;
}
__device__ __forceinline__ void xcd_barrier_complete(unsigned* bar, unsigned x, unsigned& nloc, unsigned& nx) {
    const unsigned G = gridDim.x * gridDim.y * gridDim.z;
    unsigned sum, cnt, mine, sp = 0u;
    for (;;) {
        sum = 0u; cnt = 0u; mine = 0u;
#pragma unroll
        for (unsigned j = 0; j < 16; ++j) { const unsigned c = xb_ld(&bar[XB_XCNT(j)]); sum += c; cnt += (c > 0u) ? 1u : 0u; mine = (j == x) ? c : mine; }
        if (sum == G) break;
        __builtin_amdgcn_s_sleep(1);
        if ((++sp & 255u) == 0u) { if (xb_ld(&bar[XB_TMO])) break; if (sp > XB_SPIN_CAP) { atomicAdd(&bar[XB_TMO], 1u); break; } }
    }
    nloc = mine > 0u ? mine : 1u; nx = cnt > 0u ? cnt : 1u;
}

__device__ __forceinline__ void xcd_barrier(const XcdBarrier& b) {
    asm volatile("s_waitcnt vmcnt(0)" ::: "memory");
    __syncthreads();
    if (threadIdx.x == 0) {
        unsigned* bar = b.bar;
        __builtin_amdgcn_s_waitcnt(0);
        unsigned nloc = b.st[0], nx = b.st[1];
        if (nloc == 0u) { xcd_barrier_complete(bar, b.x, nloc, nx); b.st[0] = nloc; b.st[1] = nx; }
        const unsigned old = xb_add(&bar[XB_XSUB(b.x)], 1u);
        const unsigned gen = old / nloc;
        if (old + 1u == (gen + 1u) * nloc) {
            __builtin_amdgcn_fence(__ATOMIC_RELEASE, "agent");
            asm volatile("s_waitcnt vmcnt(0)" ::: "memory");
            const unsigned og = xb_add(&bar[XB_TOP], 1u);
            const unsigned tg = og / nx;
            if (og + 1u == (tg + 1u) * nx) xb_add(&bar[XB_TOPGEN], 1u);
            else XB_SPIN(xb_ld(&bar[XB_TOPGEN]) == tg, bar);
            __builtin_amdgcn_fence(__ATOMIC_ACQUIRE, "agent");
            xb_add(&bar[XB_XGEN(b.x)], 1u);
            asm volatile("s_waitcnt vmcnt(0)" ::: "memory");
        } else {
            XB_SPIN(xb_ld(&bar[XB_XGEN(b.x)]) == gen, bar);
            __builtin_amdgcn_fence(__ATOMIC_ACQUIRE, "agent");
            asm volatile("s_waitcnt vmcnt(0)" ::: "memory");
        }
    }
    __syncthreads();
}


#define GAS __attribute__((address_space(1)))
typedef unsigned short bf16;
typedef unsigned v4u __attribute__((ext_vector_type(4)));
#define LDS_WAIT() asm volatile("s_waitcnt lgkmcnt(0)" ::: "memory")
__device__ __forceinline__ unsigned f2bf(float f) { unsigned u = __builtin_bit_cast(unsigned, f); return (u + 0x7fffu + ((u >> 16) & 1u)) >> 16; }
__device__ __forceinline__ unsigned pk2(float lo, float hi) { return f2bf(lo) | (f2bf(hi) << 16); }
__device__ __forceinline__ float bf2f(unsigned short b) { return __builtin_bit_cast(float, (unsigned)b << 16); }
#include <hip/hip_runtime.h>
namespace pg8 {
#define PG8_LAS __attribute__((address_space(3)))
typedef unsigned short bf16_t;
typedef short bf16x8 __attribute__((ext_vector_type(8)));
typedef float f32x4 __attribute__((ext_vector_type(4)));
typedef unsigned u32x4 __attribute__((ext_vector_type(4)));
constexpr int BM = 256, BK = 64, HALF = 128, HTB = HALF * BK * 2  , STAGE_BYTES = 8 * HTB, NXCD = 8, WGM = 8;

__host__ __device__ __forceinline__ int lds_byte(int r, int c) { const int st = (r >> 4) * 2 + (c >> 5), rr = r & 15, cc = c & 31, ob = rr * 64 + cc * 2; return st * 1024 + (ob ^ (((ob >> 9) & 1) << 5)); }
__host__ __device__ __forceinline__ void stage_rc(int b, int& R, int& C) { const int st = b / 1024, sb = b % 1024, swz = sb ^ (((sb >> 9) & 1) << 5); R = (st >> 1) * 16 + swz / 64; C = (st & 1) * 32 + (swz % 64) / 2; }
__host__ __device__ __forceinline__ int perm32(int rho) { const int n = rho >> 4, i = rho & 15; return 8 * (i >> 2) + 4 * n + (i & 3); }

struct Unit { int pm, pn; };
struct Gemm { const bf16_t* A; const bf16_t* Bt; int M, N, K; };

struct StaticOrder {
    int nM, nN, nwg, G, c;
    __host__ __device__ void init(int M, int N, int G_, int c_) { nM = M / BM; nN = N / BM; nwg = nM * nN; G = G_; c = c_; }
    __host__ __device__ bool next(int i, Unit& u) const {
        const long L = (long)i * G + c; if (L >= nwg) return false;
        int wgid = (int)L; { const int q = nwg / NXCD, r = nwg % NXCD, xcd = wgid % NXCD, off = wgid / NXCD; wgid = (xcd < r ? xcd * (q + 1) : r * (q + 1) + (xcd - r) * q) + off; }
        const int nig = WGM * nN, gid = wgid / nig, fm = gid * WGM, gsz = (nM - fm) < WGM ? (nM - fm) : WGM;
        u.pm = fm + ((wgid % nig) % gsz); u.pn = (wgid % nig) / gsz; return true;
    }
    __device__ __forceinline__ void a_ready(const Unit&) const {}
    __device__ __forceinline__ void done(const Unit&) const {}
};
__device__ __forceinline__ unsigned cvt_pk_bf16(float lo, float hi) { unsigned r; asm volatile("v_cvt_pk_bf16_f32 %0, %1, %2" : "=v"(r) : "v"(lo), "v"(hi)); return r; }
typedef float f32x2 __attribute__((ext_vector_type(2)));
__device__ __forceinline__ f32x2 gelu_pk(f32x2 v) {
    const f32x2 av = __builtin_elementwise_abs(v), d = av * 0.2316418882f + 1.0f;
    f32x2 t; t.x = __builtin_amdgcn_rcpf(d.x); t.y = __builtin_amdgcn_rcpf(d.y);
    f32x2 q = t * 0.5307027145f + (-0.7265760135f); q = q * t + 0.7107068705f; q = q * t + (-0.142248368f); q = q * t + 0.127414796f; q = q * t;
    const f32x2 s = (v * v) * (-0.72134752044f);
    f32x2 e; e.x = __builtin_amdgcn_exp2f(s.x); e.y = __builtin_amdgcn_exp2f(s.y);
    const f32x2 m = v * (q * e), r = v - m;
    f32x2 o; o.x = v.x < 0.f ? m.x : r.x; o.y = v.y < 0.f ? m.y : r.y; return o;
}

struct EpiF32 {
    static constexpr bool PERM = false, AFTER_DRAIN = false;
    float* C; int ldc; const float* bias;
    __device__ __forceinline__ void operator()(const f32x4 (&acc)[2][2][4][2], const Unit& u, int wr, int wc, int fr, int fq) const {
        const int row0 = u.pm * BM + wr * 64 + fr, col0 = u.pn * BM + wc * 32 + 4 * fq;
        f32x4 bv[2][2];
#pragma unroll
        for (int bj = 0; bj < 2; ++bj)
#pragma unroll
            for (int n = 0; n < 2; ++n) bv[bj][n] = bias ? *(const f32x4*)(bias + col0 + bj * HALF + n * 16) : (f32x4){0.f, 0.f, 0.f, 0.f};
#pragma unroll
        for (int ai = 0; ai < 2; ++ai)
#pragma unroll
            for (int m = 0; m < 4; ++m) { float* rowp = C + (size_t)(row0 + ai * HALF + m * 16) * ldc + col0;
#pragma unroll
                for (int bj = 0; bj < 2; ++bj)
#pragma unroll
                    for (int n = 0; n < 2; ++n) *(f32x4*)(rowp + bj * HALF + n * 16) = acc[ai][bj][m][n] + bv[bj][n]; }
    }
};

template <class Epi, class Sched, bool STAMP = false>
__device__ __forceinline__ void gemm_phase(PG8_LAS unsigned char* lds, const Gemm g, const Sched& S, const Epi& E, unsigned long long* stamps) {
    int tid = threadIdx.x; asm volatile("" : "+v"(tid));
    const int wid = __builtin_amdgcn_readfirstlane(tid >> 6), lane = tid & 63, wr = wid >> 2, wc = wid & 3, fr = lane & 15, fq = lane >> 4;
    const int K = g.K, nt = K / BK;
    int ts_lo = 0, ts_hi = 0, nts = 0; const unsigned long long rt_entry = STAMP ? (unsigned long long)wall_clock64() : 0ull;
#define PG8_STAMP() do { if (STAMP && wid == 0 && nts < 64) { const unsigned long long _c = (unsigned long long)clock64(); \
        ts_lo = (lane == nts) ? (int)(unsigned)_c : ts_lo; ts_hi = (lane == nts) ? (int)(unsigned)(_c >> 32) : ts_hi; ++nts; } } while (0)
    PG8_STAMP();
    unsigned voffA[2], voffB[2];
#pragma unroll
    for (int i = 0; i < 2; ++i) { int R, C; stage_rc(tid * 16 + i * 8192, R, C); const int Rb = Epi::PERM ? ((R & ~31) + perm32(R & 31)) : R;
        voffA[i] = (unsigned)(R * K + C) * 2u; voffB[i] = (unsigned)(Rb * K + C) * 2u; }
    const size_t kstep = (size_t)(BK * 2);
    const size_t hstep = (size_t)HALF * K * 2;
    const size_t tstep = 2 * hstep;
    const unsigned ldsw = (unsigned)wid * 1024u;
    const int aoff = lds_byte(wr * 64 + fr, fq * 8), boff = lds_byte(wc * 32 + fr, fq * 8);
#define PG8_SA(b, h) (((b) * 2 + (h)) * HTB)
#define PG8_SB(b, h) ((4 + (b) * 2 + (h)) * HTB)
#define PG8_STAGE(bufoff, gbase, voff) do { _Pragma("unroll") for (int _i = 0; _i < 2; ++_i) \
        __builtin_amdgcn_global_load_lds((const unsigned*)((const char*)(gbase) + (voff)[_i]), (PG8_LAS unsigned*)(lds + (bufoff) + ldsw + _i * 8192), 16, 0, 0); } while (0)
#define PG8_LDA(dst, b, h) do { _Pragma("unroll") for (int m = 0; m < 4; ++m) _Pragma("unroll") for (int k = 0; k < 2; ++k) dst[m][k] = *(const PG8_LAS bf16x8*)(lds + PG8_SA(b, h) + aoff + m * 2048 + k * 1024); } while (0)
#define PG8_LDB(dst, b, h) do { _Pragma("unroll") for (int n = 0; n < 2; ++n) _Pragma("unroll") for (int k = 0; k < 2; ++k) dst[n][k] = *(const PG8_LAS bf16x8*)(lds + PG8_SB(b, h) + boff + n * 2048 + k * 1024); } while (0)
#define PG8_MMA(ai, bj, At, Bt) do { __builtin_amdgcn_s_setprio(1); _Pragma("unroll") for (int m = 0; m < 4; ++m) _Pragma("unroll") for (int n = 0; n < 2; ++n) _Pragma("unroll") for (int k = 0; k < 2; ++k) \
        acc[ai][bj][m][n] = __builtin_amdgcn_mfma_f32_16x16x32_bf16(Bt[n][k], At[m][k], acc[ai][bj][m][n], 0, 0, 0); __builtin_amdgcn_s_setprio(0); } while (0)
#define PG8_WAIT_V(n) asm volatile("s_waitcnt vmcnt(" #n ")" ::: "memory")
#define PG8_WAIT_L(n) asm volatile("s_waitcnt lgkmcnt(" #n ")" ::: "memory")
#define PG8_BAR __builtin_amdgcn_s_barrier()
#define PG8_SCHED __builtin_amdgcn_sched_barrier(0)
    Unit cur, nxt; int ui = 0;
    if (!S.next(0, cur)) return;
    f32x4 acc[2][2][4][2];
#pragma unroll
    for (int a = 0; a < 2; ++a)
#pragma unroll
        for (int b = 0; b < 2; ++b)
#pragma unroll
            for (int m = 0; m < 4; ++m)
#pragma unroll
                for (int n = 0; n < 2; ++n) acc[a][b][m][n] = (f32x4){0.f, 0.f, 0.f, 0.f};
    bf16x8 At[4][2], B0[2][2], B1[2][2];
    const char* cA = (const char*)g.A + (size_t)cur.pm * tstep; const char* cB = (const char*)g.Bt + (size_t)cur.pn * tstep;
    S.a_ready(cur);
    PG8_STAGE(PG8_SB(0, 0), cB, voffB); PG8_STAGE(PG8_SA(0, 0), cA, voffA); PG8_STAGE(PG8_SB(0, 1), cB + hstep, voffB); PG8_STAGE(PG8_SA(0, 1), cA + hstep, voffA);
    if (wr == 1) PG8_BAR;
    PG8_WAIT_V(4); PG8_BAR;
    PG8_STAGE(PG8_SB(1, 0), cB + kstep, voffB); PG8_STAGE(PG8_SA(1, 0), cA + kstep, voffA); PG8_STAGE(PG8_SB(1, 1), cB + hstep + kstep, voffB);
    PG8_WAIT_V(6); PG8_BAR;
    PG8_STAMP();
    for (;;) {
        const bool has_next = S.next(ui + 1, nxt);
        const char* nA = has_next ? (const char*)g.A + (size_t)nxt.pm * tstep : cA; const char* nB = has_next ? (const char*)g.Bt + (size_t)nxt.pn * tstep : cB;
        for (int t = 0; t < nt; t += 2) {
            const bool last = (t == nt - 2);
            const char* a1 = cA + (size_t)(t + 1) * kstep;
            const char* a2 = last ? nA : cA + (size_t)(t + 2) * kstep; const char* b2 = last ? nB : cB + (size_t)(t + 2) * kstep;
            const char* a3 = a2 + kstep; const char* b3 = b2 + kstep;
            if (last && has_next) S.a_ready(nxt);
            PG8_LDB(B0, 0, 0); PG8_SCHED; PG8_LDA(At, 0, 0); PG8_STAGE(PG8_SA(1, 1), a1 + hstep, voffA);
            PG8_WAIT_L(8); PG8_BAR; PG8_WAIT_L(0); PG8_MMA(0, 0, At, B0); PG8_BAR; PG8_SCHED;
            PG8_LDB(B1, 0, 1); PG8_STAGE(PG8_SB(0, 0), b2, voffB);
            PG8_BAR; PG8_WAIT_L(0); PG8_MMA(0, 1, At, B1); PG8_BAR;
            PG8_LDA(At, 0, 1); PG8_STAGE(PG8_SA(0, 0), a2, voffA);
            PG8_BAR; PG8_WAIT_L(0); PG8_MMA(1, 0, At, B0); PG8_BAR; PG8_SCHED;
            PG8_STAGE(PG8_SB(0, 1), b2 + hstep, voffB);
            PG8_WAIT_V(6); PG8_BAR; PG8_MMA(1, 1, At, B1); PG8_BAR;
            PG8_LDB(B0, 1, 0); PG8_SCHED; PG8_LDA(At, 1, 0); PG8_STAGE(PG8_SA(0, 1), a2 + hstep, voffA);
            PG8_WAIT_L(8); PG8_BAR; PG8_WAIT_L(0); PG8_MMA(0, 0, At, B0); PG8_BAR; PG8_SCHED;
            PG8_LDB(B1, 1, 1); PG8_STAGE(PG8_SB(1, 0), b3, voffB);
            PG8_BAR; PG8_WAIT_L(0); PG8_MMA(0, 1, At, B1); PG8_BAR;
            PG8_LDA(At, 1, 1); PG8_STAGE(PG8_SA(1, 0), a3, voffA);
            PG8_BAR; PG8_WAIT_L(0); PG8_MMA(1, 0, At, B0); PG8_BAR; PG8_SCHED;
            PG8_STAGE(PG8_SB(1, 1), b3 + hstep, voffB);
            PG8_WAIT_V(6); PG8_BAR; PG8_MMA(1, 1, At, B1); PG8_BAR;
        }
        PG8_STAMP();
        if constexpr (!Epi::AFTER_DRAIN) { E(acc, cur, wr, wc, fr, fq); S.done(cur); }
        PG8_STAMP();
        if (!has_next) break;
#pragma unroll
        for (int a = 0; a < 2; ++a)
#pragma unroll
            for (int b = 0; b < 2; ++b)
#pragma unroll
                for (int m = 0; m < 4; ++m)
#pragma unroll
                    for (int n = 0; n < 2; ++n) acc[a][b][m][n] = (f32x4){0.f, 0.f, 0.f, 0.f};
        cur = nxt; cA = nA; cB = nB; ++ui;
    }
    PG8_WAIT_V(0);
    if (wr == 0) PG8_BAR;
    PG8_BAR;
    if constexpr (Epi::AFTER_DRAIN) { E.fused(acc, cur, wr, wc, fr, fq, lds, wid, lane); S.done(cur); }
    PG8_STAMP();
    if (STAMP && wid == 0) { stamps[lane] = lane < nts ? (((unsigned long long)(unsigned)ts_hi << 32) | (unsigned)ts_lo) : 0ull;
        if (lane == 62) stamps[62] = rt_entry; if (lane == 63) stamps[63] = (unsigned long long)wall_clock64(); }
#undef PG8_STAMP
#undef PG8_SA
#undef PG8_SB
#undef PG8_STAGE
#undef PG8_LDA
#undef PG8_LDB
#undef PG8_MMA
#undef PG8_WAIT_V
#undef PG8_WAIT_L
#undef PG8_BAR
#undef PG8_SCHED
}
}


namespace pg8 {
struct EpiProj {
    static constexpr bool PERM = true, AFTER_DRAIN = false;
    bf16_t* O; float* dtraw;
    __device__ __forceinline__ void operator()(const f32x4 (&acc)[2][2][4][2], const Unit& u, int wr, int wc, int fr, int fq) const {
        const int row0 = u.pm * BM + wr * 64 + fr;
        if (u.pn < 22) {
            const int col0 = u.pn * BM + wc * 32 + 8 * fq;
#pragma unroll
            for (int ai = 0; ai < 2; ++ai)
#pragma unroll
                for (int m = 0; m < 4; ++m) { bf16_t* rowp = O + (size_t)(row0 + ai * HALF + m * 16) * 5632 + col0;
#pragma unroll
                    for (int bj = 0; bj < 2; ++bj) { const f32x4 v0 = acc[ai][bj][m][0], v1 = acc[ai][bj][m][1];
                        u32x4 w; w.x = cvt_pk_bf16(v0[0], v0[1]); w.y = cvt_pk_bf16(v0[2], v0[3]); w.z = cvt_pk_bf16(v1[0], v1[1]); w.w = cvt_pk_bf16(v1[2], v1[3]);
                        *(u32x4*)(rowp + bj * HALF) = w; } }
        } else if (wc == 0) {
#pragma unroll
            for (int ai = 0; ai < 2; ++ai)
#pragma unroll
                for (int m = 0; m < 4; ++m) { float* rp = dtraw + (size_t)(row0 + ai * HALF + m * 16) * 32 + 8 * fq;
                    *(f32x4*)rp = acc[ai][0][m][0]; *(f32x4*)(rp + 4) = acc[ai][0][m][1]; }
        }
    }
};
}


namespace pg8 {
struct EpiBf16Plain {
    static constexpr bool PERM = true, AFTER_DRAIN = false;
    bf16_t* O; int ldc;
    __device__ __forceinline__ void operator()(const f32x4 (&acc)[2][2][4][2], const Unit& u, int wr, int wc, int fr, int fq) const {
        const int row0 = u.pm * BM + wr * 64 + fr, col0 = u.pn * BM + wc * 32 + 8 * fq;
#pragma unroll
        for (int ai = 0; ai < 2; ++ai)
#pragma unroll
            for (int m = 0; m < 4; ++m) { bf16_t* rowp = O + (size_t)(row0 + ai * HALF + m * 16) * ldc + col0;
#pragma unroll
                for (int bj = 0; bj < 2; ++bj) { const f32x4 v0 = acc[ai][bj][m][0], v1 = acc[ai][bj][m][1];
                    u32x4 w; w.x = cvt_pk_bf16(v0[0], v0[1]); w.y = cvt_pk_bf16(v0[2], v0[3]); w.z = cvt_pk_bf16(v1[0], v1[1]); w.w = cvt_pk_bf16(v1[2], v1[3]);
                    *(u32x4*)(rowp + bj * HALF) = w; } }
    }
};
}

#define NTHR 512
#define NWAVE 8

__device__ __forceinline__ void ph_gemm_f32(float* lds, const float* __restrict__ A, const float* __restrict__ B, float* __restrict__ C,
                                            int M, int N, int K, int lda, int ldb, int ldc) {
    const int tid = threadIdx.x & 255, half = threadIdx.x >> 8, tx = tid & 15, ty = tid >> 4;
    float (*As)[68] = (float (*)[68])(lds + half * 2 * 16 * 68);
    float (*Bs)[68] = (float (*)[68])(lds + half * 2 * 16 * 68 + 16 * 68);
    const int ntx = (N + 63) / 64, nty = M / 64, ntiles = ntx * nty;
    for (int it = blockIdx.x; 2 * it < ntiles; it += gridDim.x) {
        const int tile = 2 * it + half;
        const int m0 = (tile / ntx) * 64, n0 = (tile % ntx) * 64;
        float acc[4][4];
#pragma unroll
        for (int i = 0; i < 4; ++i)
#pragma unroll
            for (int j = 0; j < 4; ++j) acc[i][j] = 0.f;
        for (int k0 = 0; k0 < K; k0 += 16) {
#pragma unroll
            for (int i = 0; i < 4; ++i) {
                int idx = tid + i * 256;
                int r = idx >> 4, c = idx & 15;
                As[c][r] = (m0 + r < M) ? A[(size_t)(m0 + r) * lda + k0 + c] : 0.f;
                int rb = idx >> 6, cb = idx & 63;
                Bs[rb][cb] = (n0 + cb < N) ? B[(size_t)(k0 + rb) * ldb + n0 + cb] : 0.f;
            }
            __syncthreads();
#pragma unroll
            for (int k = 0; k < 16; ++k) {
                float a[4], b[4];
#pragma unroll
                for (int i = 0; i < 4; ++i) { a[i] = As[k][ty * 4 + i]; b[i] = Bs[k][tx * 4 + i]; }
#pragma unroll
                for (int i = 0; i < 4; ++i)
#pragma unroll
                    for (int j = 0; j < 4; ++j) acc[i][j] += a[i] * b[j];
            }
            __syncthreads();
        }
#pragma unroll
        for (int i = 0; i < 4; ++i)
#pragma unroll
            for (int j = 0; j < 4; ++j) {
                int r = m0 + ty * 4 + i, c = n0 + tx * 4 + j;
                if (r < M && c < N) C[(size_t)r * ldc + c] = acc[i][j];
            }
    }
}


template <int MODE>
__device__ __forceinline__ void transpose_item(const float* __restrict__ W, int K, int N, int Npad, bf16* __restrict__ WT, LAS float* scr, int item, int lane) {
    const int nblk = Npad / 32, kb = item / nblk, nb = item % nblk, k0 = 64 * kb, n0 = 32 * nb;
    const int n = n0 + (lane & 31);
    int sc = n;
    if (MODE == 1) sc = (n < 4096) ? n : (n < 5632 ? n + 24 : (n < 5656 ? n - 5632 + 4096 : -1));
    else sc = (n < N) ? n : -1;
#pragma unroll 8
    for (int i = 0; i < 32; ++i) { const int kk = 2 * i + (lane >> 5); scr[kk * 33 + (lane & 31)] = (sc >= 0) ? W[(size_t)(k0 + kk) * N + sc] : 0.f; }
    LDS_WAIT(); asm volatile("" ::: "memory");
    const int c = lane & 7;
#pragma unroll
    for (int j = 0; j < 4; ++j) { const int nn = (lane >> 3) + 8 * j; const LAS float* s = scr + (8 * c) * 33 + nn;
        v4u o; o.x = pk2(s[0 * 33], s[1 * 33]); o.y = pk2(s[2 * 33], s[3 * 33]); o.z = pk2(s[4 * 33], s[5 * 33]); o.w = pk2(s[6 * 33], s[7 * 33]);
        *(v4u*)(WT + (size_t)(n0 + nn) * K + k0 + 8 * c) = o; }
    LDS_WAIT(); asm volatile("" ::: "memory");
}
__device__ __forceinline__ void ph_prologue(LAS unsigned char* ldsb, const float* __restrict__ xp, const float* __restrict__ xs, bf16* __restrict__ A0,
                                            const float* __restrict__ w_in, bf16* __restrict__ wt_in, float* __restrict__ rope_tab) {
    const int lane = threadIdx.x & 63, wave = threadIdx.x >> 6;
    LAS float* scr = (LAS float*)(ldsb + wave * 16384);
    const int gw = blockIdx.x * NWAVE + wave, NGW = gridDim.x * NWAVE;
    constexpr int I_IN = (D_MODEL / 64) * (PROJ_LD / 32);
    for (int it = gw; it < I_IN; it += NGW) transpose_item<1>(w_in, D_MODEL, IN_WIDTH, PROJ_LD, wt_in, scr, it, lane);
    for (int idx = blockIdx.x * NTHR + threadIdx.x; idx < SEQ * 32; idx += gridDim.x * NTHR) {
        const int pos = idx >> 5, j = idx & 31;
        const double rev = (double)pos * ROPE_INV_REV[j];
        const float fr = (float)(rev - floor(rev));
        rope_tab[(size_t)pos * 64 + j] = __builtin_amdgcn_cosf(fr); rope_tab[(size_t)pos * 64 + 32 + j] = __builtin_amdgcn_sinf(fr);
    }
    const size_t n8 = (size_t)T_ALL * D_MODEL / 8, np8 = (size_t)T_PROMPT * D_MODEL / 8;
#pragma unroll 4
    for (size_t i = (size_t)blockIdx.x * NTHR + threadIdx.x; i < n8; i += (size_t)gridDim.x * NTHR) {
        const float4* s = (i < np8) ? (const float4*)xp + 2 * i : (const float4*)xs + 2 * (i - np8);
        float4 a = s[0], b = s[1];
        v4u o; o.x = pk2(a.x, a.y); o.y = pk2(a.z, a.w); o.z = pk2(b.x, b.y); o.w = pk2(b.z, b.w);
        ((v4u*)A0)[i] = o;
    }
}
__device__ __forceinline__ void ph_prologue2(LAS unsigned char* ldsb, const float* __restrict__ w_out, bf16* __restrict__ wt_out, const float* __restrict__ w_q, bf16* __restrict__ wt_q,
                                             int rank, int nranks) {
    const int lane = threadIdx.x & 63, wave = threadIdx.x >> 6;
    LAS float* scr = (LAS float*)(ldsb + wave * 16384);
    constexpr int I_OUT = (MIX_WIDTH / 64) * (D_MODEL / 32), I_Q = (D_MODEL / 64) * (2048 / 32);
    for (int it = rank * NWAVE + wave; it < I_OUT + I_Q; it += nranks * NWAVE) {
        if (it < I_OUT) transpose_item<0>(w_out, MIX_WIDTH, D_MODEL, D_MODEL, wt_out, scr, it, lane);
        else transpose_item<0>(w_q, D_MODEL, 2048, 2048, wt_q, scr, it - I_OUT, lane);
    }
}

__device__ __forceinline__ void ph_concat_x(const float* __restrict__ xp, const float* __restrict__ xs, float* __restrict__ xall) {
    const size_t n4 = (size_t)T_ALL * D_MODEL / 4, np4 = (size_t)T_PROMPT * D_MODEL / 4;
    for (size_t i = (size_t)blockIdx.x * NTHR + threadIdx.x; i < n4; i += (size_t)gridDim.x * NTHR) {
        float4 v = (i < np4) ? ((const float4*)xp)[i] : ((const float4*)xs)[i - np4];
        ((float4*)xall)[i] = v;
    }
}

typedef float f32x4n __attribute__((ext_vector_type(4)));
__device__ __forceinline__ void ph_cache_copy(const float* __restrict__ ck, const float* __restrict__ cv, float* __restrict__ out) {
    constexpr unsigned PER_B = (WBUF - DEC_SEQ) * ATT_WIDTH / 4;
    constexpr unsigned TOTAL = 2u * DEC_BATCH * PER_B;
    for (unsigned c = blockIdx.x; c < TOTAL / 4096u; c += gridDim.x) {
        f32x4n v[8]; size_t dsti[8]; bool isv[8];
#pragma unroll
        for (int j = 0; j < 8; ++j) {
            const unsigned idx = c * 4096u + j * 512u + threadIdx.x;
            const unsigned tb = idx / PER_B, r = idx - tb * PER_B, bb = tb & (DEC_BATCH - 1);
            isv[j] = tb >= DEC_BATCH;
            const size_t srci = (size_t)bb * (WBUF * ATT_WIDTH / 4) + (DEC_SEQ * ATT_WIDTH / 4) + r;
            dsti[j] = (size_t)bb * (WBUF * ATT_WIDTH / 4) + r;
            v[j] = __builtin_nontemporal_load((isv[j] ? (const f32x4n*)cv : (const f32x4n*)ck) + srci);
        }
#pragma unroll
        for (int j = 0; j < 8; ++j) __builtin_nontemporal_store(v[j], (f32x4n*)(out + (isv[j] ? OUT_SV : OUT_SK)) + dsti[j]);
    }
}

__device__ __forceinline__ void ph_post_proj(const float* __restrict__ proj, const float* __restrict__ state_conv,
                                             const float* __restrict__ conv_w, const float* __restrict__ conv_b, const float* __restrict__ dt_bias,
                                             float* __restrict__ xbc_act, float* __restrict__ dtv, float* __restrict__ qrot, float* __restrict__ krot,
                                             float* __restrict__ out) {
    const int tid = threadIdx.x & 255, half = threadIdx.x >> 8;
    for (int t = 2 * blockIdx.x + half; t < T_ALL; t += 2 * gridDim.x) {
        const bool is_p = t < T_PROMPT;
        int b, i, pos;
        if (is_p) { b = t / SEQ; i = t % SEQ; pos = i; } else { int ts = t - T_PROMPT; b = ts / DEC_SEQ; i = ts % DEC_SEQ; pos = PAST_LEN + i; }
        const float* row = proj + (size_t)t * PROJ_LD;
        for (int c = tid; c < CONV_DIM; c += 256) {
            float acc = conv_b[c];
#pragma unroll
            for (int tap = 0; tap < 4; ++tap) {
                int r = i - 3 + tap;
                float val;
                if (r >= 0) val = proj[(size_t)(t - i + r) * PROJ_LD + O_XBC + c];
                else val = is_p ? 0.f : state_conv[((size_t)b * 3 + (3 + r)) * CONV_DIM + c];
                acc += val * conv_w[tap * CONV_DIM + c];
            }
            xbc_act[(size_t)t * CONV_DIM + c] = silu_f(acc);
        }
        if (tid < SSD_HEADS) dtv[(size_t)t * SSD_HEADS + tid] = softplus_f(row[O_DT + tid] + dt_bias[tid]);
        for (int idx = tid; idx < 512; idx += 256) {
            int which = idx >> 8, h = (idx >> 5) & 7, j = idx & 31;
            double rev = (double)pos * ROPE_INV_REV[j];
            float fr = (float)(rev - floor(rev));
            float sn = __builtin_amdgcn_sinf(fr), cs = __builtin_amdgcn_cosf(fr);
            const float* src = row + (which ? O_K : O_Q) + h * 64;
            float t1 = src[j], t2 = src[j + 32];
            float o1 = t1 * cs - t2 * sn, o2 = t2 * cs + t1 * sn;
            float* dst = (which ? krot : qrot) + (size_t)t * ATT_WIDTH + h * 64;
            dst[j] = o1; dst[j + 32] = o2;
            if (which) {
                if (is_p) { if (i >= SEQ - WBUF) { float* o = out + OUT_PK + ((size_t)b * WBUF + (i - (SEQ - WBUF))) * ATT_WIDTH + h * 64; o[j] = o1; o[j + 32] = o2; } }
                else { float* o = out + OUT_SK + ((size_t)b * WBUF + (WBUF - DEC_SEQ + i)) * ATT_WIDTH + h * 64; o[j] = o1; o[j + 32] = o2; }
            }
        }
        for (int c = tid; c < ATT_WIDTH; c += 256) {
            float v = row[O_V + c];
            if (is_p) { if (i >= SEQ - WBUF) out[OUT_PV + ((size_t)b * WBUF + (i - (SEQ - WBUF))) * ATT_WIDTH + c] = v; }
            else out[OUT_SV + ((size_t)b * WBUF + (WBUF - DEC_SEQ + i)) * ATT_WIDTH + c] = v;
        }
        if (is_p) {
            if (i >= SEQ - 3) { int r = i - (SEQ - 3); for (int c = tid; c < CONV_DIM; c += 256) out[OUT_PC + ((size_t)b * 3 + r) * CONV_DIM + c] = row[O_XBC + c]; }
        } else {
            if (i >= 1) { int r = i - 1; for (int c = tid; c < CONV_DIM; c += 256) out[OUT_SC + ((size_t)b * 3 + r) * CONV_DIM + c] = row[O_XBC + c]; }
        }
    }
}


#define NB_LD 5632
#define NB_XBC 1536
#define NB_Q 4096
#define NB_K 4608
#define NB_V 5120
__device__ __forceinline__ void unpack8(const v4u w, float (&f)[8]) {
    f[0] = __builtin_bit_cast(float, w.x << 16); f[1] = __builtin_bit_cast(float, w.x & 0xffff0000u);
    f[2] = __builtin_bit_cast(float, w.y << 16); f[3] = __builtin_bit_cast(float, w.y & 0xffff0000u);
    f[4] = __builtin_bit_cast(float, w.z << 16); f[5] = __builtin_bit_cast(float, w.z & 0xffff0000u);
    f[6] = __builtin_bit_cast(float, w.w << 16); f[7] = __builtin_bit_cast(float, w.w & 0xffff0000u);
}
__device__ __forceinline__ void store8f(float* d, const float (&f)[8]) { *(float4*)d = make_float4(f[0], f[1], f[2], f[3]); *(float4*)(d + 4) = make_float4(f[4], f[5], f[6], f[7]); }
__device__ __forceinline__ void ph_post_proj2(const bf16* __restrict__ projb, const float* __restrict__ dtraw, const float* __restrict__ state_conv,
                                              const float* __restrict__ conv_w, const float* __restrict__ conv_b, const float* __restrict__ dt_bias,
                                              bf16* __restrict__ xbc_b, float* __restrict__ dtv, bf16* __restrict__ qrot_b, bf16* __restrict__ krot_b,
                                              float* __restrict__ out) {
    const int tid = threadIdx.x & 255, half = threadIdx.x >> 8;
    for (int t = T_PROMPT + 2 * blockIdx.x + half; t < T_ALL; t += 2 * gridDim.x) {
        const bool is_p = t < T_PROMPT;
        int b, i, pos;
        if (is_p) { b = t / SEQ; i = t % SEQ; pos = i; } else { int ts = t - T_PROMPT; b = ts / DEC_SEQ; i = ts % DEC_SEQ; pos = PAST_LEN + i; }
        const bf16* row = projb + (size_t)t * NB_LD;
        if (tid < 64) {
            float f[8]; unpack8(*(const v4u*)(row + NB_V + tid * 8), f);
            if (is_p) { if (i >= SEQ - WBUF) store8f(out + OUT_PV + ((size_t)b * WBUF + (i - (SEQ - WBUF))) * ATT_WIDTH + tid * 8, f); }
            else store8f(out + OUT_SV + ((size_t)b * WBUF + (WBUF - DEC_SEQ + i)) * ATT_WIDTH + tid * 8, f);
        }
        for (int c8 = tid; c8 < 320; c8 += 256) {
            const int c = c8 * 8;
            float acc[8], cur[8];
            { const float4 b0 = *(const float4*)(conv_b + c), b1 = *(const float4*)(conv_b + c + 4);
              acc[0] = b0.x; acc[1] = b0.y; acc[2] = b0.z; acc[3] = b0.w; acc[4] = b1.x; acc[5] = b1.y; acc[6] = b1.z; acc[7] = b1.w; }
#pragma unroll
            for (int tap = 0; tap < 4; ++tap) {
                const int r = i - 3 + tap;
                float val[8];
                if (r >= 0) unpack8(*(const v4u*)(projb + (size_t)(t - i + r) * NB_LD + NB_XBC + c), val);
                else if (!is_p) { const float* sp = state_conv + ((size_t)b * 3 + (3 + r)) * CONV_DIM + c; const float4 s0 = *(const float4*)sp, s1 = *(const float4*)(sp + 4);
                    val[0] = s0.x; val[1] = s0.y; val[2] = s0.z; val[3] = s0.w; val[4] = s1.x; val[5] = s1.y; val[6] = s1.z; val[7] = s1.w; }
                else {
#pragma unroll
                    for (int j = 0; j < 8; ++j) val[j] = 0.f; }
                const float4 w0 = *(const float4*)(conv_w + tap * CONV_DIM + c), w1 = *(const float4*)(conv_w + tap * CONV_DIM + c + 4);
                acc[0] += val[0] * w0.x; acc[1] += val[1] * w0.y; acc[2] += val[2] * w0.z; acc[3] += val[3] * w0.w;
                acc[4] += val[4] * w1.x; acc[5] += val[5] * w1.y; acc[6] += val[6] * w1.z; acc[7] += val[7] * w1.w;
                if (tap == 3) {
#pragma unroll
                    for (int j = 0; j < 8; ++j) cur[j] = val[j]; }
            }
#pragma unroll
            for (int j = 0; j < 8; ++j) acc[j] = silu_f(acc[j]);
            v4u o; o.x = pk2(acc[0], acc[1]); o.y = pk2(acc[2], acc[3]); o.z = pk2(acc[4], acc[5]); o.w = pk2(acc[6], acc[7]);
            *(v4u*)(xbc_b + (size_t)t * CONV_DIM + c) = o;
            if (is_p) { if (i >= SEQ - 3) store8f(out + OUT_PC + ((size_t)b * 3 + (i - (SEQ - 3))) * CONV_DIM + c, cur); }
            else { if (i >= 1) store8f(out + OUT_SC + ((size_t)b * 3 + (i - 1)) * CONV_DIM + c, cur); }
        }
        if (tid < SSD_HEADS) dtv[(size_t)t * SSD_HEADS + tid] = softplus_f(dtraw[(size_t)t * 32 + tid] + dt_bias[tid]);
        if (tid < 128) {
            const int which = tid >> 6, h = (tid >> 3) & 7, jc = tid & 7;
            const bf16* src = row + (which ? NB_K : NB_Q) + h * 64 + jc * 4;
            const uint2 lo = *(const uint2*)src, hi = *(const uint2*)(src + 32);
            float t1[4], t2[4], o1[4], o2[4];
            t1[0] = __builtin_bit_cast(float, lo.x << 16); t1[1] = __builtin_bit_cast(float, lo.x & 0xffff0000u); t1[2] = __builtin_bit_cast(float, lo.y << 16); t1[3] = __builtin_bit_cast(float, lo.y & 0xffff0000u);
            t2[0] = __builtin_bit_cast(float, hi.x << 16); t2[1] = __builtin_bit_cast(float, hi.x & 0xffff0000u); t2[2] = __builtin_bit_cast(float, hi.y << 16); t2[3] = __builtin_bit_cast(float, hi.y & 0xffff0000u);
#pragma unroll
            for (int e = 0; e < 4; ++e) {
                const double rev = (double)pos * ROPE_INV_REV[jc * 4 + e];
                const float fr = (float)(rev - floor(rev));
                const float sn = __builtin_amdgcn_sinf(fr), cs = __builtin_amdgcn_cosf(fr);
                o1[e] = t1[e] * cs - t2[e] * sn; o2[e] = t2[e] * cs + t1[e] * sn;
            }
            const size_t doff = (size_t)t * ATT_WIDTH + h * 64 + jc * 4;
            bf16* db = which ? krot_b : qrot_b;
            *(uint2*)(db + doff) = make_uint2(pk2(o1[0], o1[1]), pk2(o1[2], o1[3])); *(uint2*)(db + doff + 32) = make_uint2(pk2(o2[0], o2[1]), pk2(o2[2], o2[3]));
            if (which) {
                float* o = nullptr;
                if (is_p) { if (i >= SEQ - WBUF) o = out + OUT_PK + ((size_t)b * WBUF + (i - (SEQ - WBUF))) * ATT_WIDTH + h * 64 + jc * 4; }
                else o = out + OUT_SK + ((size_t)b * WBUF + (WBUF - DEC_SEQ + i)) * ATT_WIDTH + h * 64 + jc * 4;
                if (o) { *(float4*)o = make_float4(o1[0], o1[1], o1[2], o1[3]); *(float4*)(o + 32) = make_float4(o2[0], o2[1], o2[2], o2[3]); }
            }
        }
    }
}


__device__ __forceinline__ void ph_post_proj_prompt(const bf16* __restrict__ projb, const float* __restrict__ dtraw, const float* __restrict__ conv_w, const float* __restrict__ conv_b,
                                                    const float* __restrict__ dt_bias, const float* __restrict__ rope_tab, bf16* __restrict__ xbc_b, float* __restrict__ dtv,
                                                    bf16* __restrict__ qrot_b, bf16* __restrict__ krot_b, float* __restrict__ out) {
    const int gtid = blockIdx.x * NTHR + threadIdx.x, gsz = gridDim.x * NTHR;
    for (int item = gtid; item < (T_PROMPT / 16) * 320; item += gsz) {
        const int run = item / 320, c = (item - run * 320) * 8, t0 = run * 16, i0 = t0 & (SEQ - 1), b = t0 >> 13;
        float w[4][8], bias[8];
#pragma unroll
        for (int tap = 0; tap < 4; ++tap) { const float4 w0 = *(const float4*)(conv_w + tap * CONV_DIM + c), w1 = *(const float4*)(conv_w + tap * CONV_DIM + c + 4);
            w[tap][0] = w0.x; w[tap][1] = w0.y; w[tap][2] = w0.z; w[tap][3] = w0.w; w[tap][4] = w1.x; w[tap][5] = w1.y; w[tap][6] = w1.z; w[tap][7] = w1.w; }
        { const float4 b0 = *(const float4*)(conv_b + c), b1 = *(const float4*)(conv_b + c + 4);
          bias[0] = b0.x; bias[1] = b0.y; bias[2] = b0.z; bias[3] = b0.w; bias[4] = b1.x; bias[5] = b1.y; bias[6] = b1.z; bias[7] = b1.w; }
        const bf16* src = projb + (size_t)t0 * NB_LD + NB_XBC + c;
        v4u raw[19];
#pragma unroll
        for (int s = 0; s < 19; ++s) { v4u z; z.x = 0u; z.y = 0u; z.z = 0u; z.w = 0u; raw[s] = (s >= 3 || i0 != 0) ? *(const v4u*)(src + (ptrdiff_t)(s - 3) * NB_LD) : z; }
        float p0[8], p1[8], p2[8];
        unpack8(raw[0], p0); unpack8(raw[1], p1); unpack8(raw[2], p2);
#pragma unroll
        for (int s = 0; s < 16; ++s) {
            float cur[8], acc[8]; unpack8(raw[s + 3], cur);
#pragma unroll
            for (int j = 0; j < 8; ++j) acc[j] = silu_f(bias[j] + p0[j] * w[0][j] + p1[j] * w[1][j] + p2[j] * w[2][j] + cur[j] * w[3][j]);
            v4u o; o.x = pk2(acc[0], acc[1]); o.y = pk2(acc[2], acc[3]); o.z = pk2(acc[4], acc[5]); o.w = pk2(acc[6], acc[7]);
            *(v4u*)(xbc_b + (size_t)(t0 + s) * CONV_DIM + c) = o;
            if (i0 + s >= SEQ - 3) store8f(out + OUT_PC + ((size_t)b * 3 + (i0 + s - (SEQ - 3))) * CONV_DIM + c, cur);
#pragma unroll
            for (int j = 0; j < 8; ++j) { p0[j] = p1[j]; p1[j] = p2[j]; p2[j] = cur[j]; }
        }
    }
#pragma unroll 4
    for (int item = gtid; item < T_PROMPT * 128; item += gsz) {
        const int t = item >> 7, sub = item & 127, which = sub >> 6, h = (sub >> 3) & 7, jc = sub & 7, i = t & (SEQ - 1), b = t >> 13;
        const bf16* src = projb + (size_t)t * NB_LD + (which ? NB_K : NB_Q) + h * 64 + jc * 4;
        const uint2 lo = *(const uint2*)src, hi = *(const uint2*)(src + 32);
        const float4 cs = *(const float4*)(rope_tab + (size_t)i * 64 + jc * 4), sn = *(const float4*)(rope_tab + (size_t)i * 64 + 32 + jc * 4);
        float t1[4], t2[4], o1[4], o2[4];
        t1[0] = __builtin_bit_cast(float, lo.x << 16); t1[1] = __builtin_bit_cast(float, lo.x & 0xffff0000u); t1[2] = __builtin_bit_cast(float, lo.y << 16); t1[3] = __builtin_bit_cast(float, lo.y & 0xffff0000u);
        t2[0] = __builtin_bit_cast(float, hi.x << 16); t2[1] = __builtin_bit_cast(float, hi.x & 0xffff0000u); t2[2] = __builtin_bit_cast(float, hi.y << 16); t2[3] = __builtin_bit_cast(float, hi.y & 0xffff0000u);
        const float cv[4] = {cs.x, cs.y, cs.z, cs.w}, sv[4] = {sn.x, sn.y, sn.z, sn.w};
#pragma unroll
        for (int e = 0; e < 4; ++e) { o1[e] = t1[e] * cv[e] - t2[e] * sv[e]; o2[e] = t2[e] * cv[e] + t1[e] * sv[e]; }
        const size_t doff = (size_t)t * ATT_WIDTH + h * 64 + jc * 4;
        bf16* db = which ? krot_b : qrot_b;
        *(uint2*)(db + doff) = make_uint2(pk2(o1[0], o1[1]), pk2(o1[2], o1[3])); *(uint2*)(db + doff + 32) = make_uint2(pk2(o2[0], o2[1]), pk2(o2[2], o2[3]));
        if (which && i >= SEQ - WBUF) {
            float* o = out + OUT_PK + ((size_t)b * WBUF + (i - (SEQ - WBUF))) * ATT_WIDTH + h * 64 + jc * 4;
            *(float4*)o = make_float4(o1[0], o1[1], o1[2], o1[3]); *(float4*)(o + 32) = make_float4(o2[0], o2[1], o2[2], o2[3]);
        }
    }
#pragma unroll 4
    for (int item = gtid; item < T_PROMPT * SSD_HEADS; item += gsz) { const int t = item / SSD_HEADS, hd = item - t * SSD_HEADS; dtv[item] = softplus_f(dtraw[(size_t)t * 32 + hd] + dt_bias[hd]); }
#pragma unroll 2
    for (int item = gtid; item < BATCH * WBUF * 64; item += gsz) {
        const int ch = item & 63, j = (item >> 6) & (WBUF - 1), b = item >> 17;
        float f[8]; unpack8(*(const v4u*)(projb + (size_t)(b * SEQ + (SEQ - WBUF) + j) * NB_LD + NB_V + ch * 8), f);
        store8f(out + OUT_PV + ((size_t)b * WBUF + j) * ATT_WIDTH + ch * 8, f);
    }
}

#define SSD_CH 32
__device__ __forceinline__ void ph_ssd_naive(float* lds, const bf16* __restrict__ xbc_act, const float* __restrict__ dtv, const float* __restrict__ a_log,
                                             const float* __restrict__ d_skip, const float* __restrict__ state_ssm, float* __restrict__ ybuf, float* __restrict__ out) {
    float (*sx)[64] = (float (*)[64])lds;
    float (*sB)[128] = (float (*)[128])(lds + SSD_CH * 64);
    float (*sC)[128] = (float (*)[128])(lds + SSD_CH * 64 + SSD_CH * 128);
    float* sdt = lds + SSD_CH * 64 + 2 * SSD_CH * 128;
    const int tid = threadIdx.x, p = tid >> 3, ng = tid & 7;
    for (int vb = BATCH * SSD_HEADS + blockIdx.x; vb < (BATCH + DEC_BATCH) * SSD_HEADS; vb += gridDim.x) {
        const int seq = vb / SSD_HEADS, h = vb % SSD_HEADS, g = h / 6;
        const bool is_p = seq < BATCH;
        const int L = is_p ? SEQ : DEC_SEQ;
        const int t0 = is_p ? seq * SEQ : T_PROMPT + (seq - BATCH) * DEC_SEQ;
        const float A = -__expf(a_log[h]);
        const float D = d_skip[h];
        float hs[16];
        if (is_p) {
#pragma unroll
            for (int j = 0; j < 16; ++j) hs[j] = 0.f;
        } else {
            const float* s0 = state_ssm + (((size_t)(seq - BATCH) * SSD_HEADS + h) * 64 + p) * 128 + ng * 16;
#pragma unroll
            for (int j = 0; j < 16; ++j) hs[j] = s0[j];
        }
        for (int c0 = 0; c0 < L; c0 += SSD_CH) {
            const int nst = (L - c0) < SSD_CH ? (L - c0) : SSD_CH;
            __syncthreads();
            for (int idx = tid; idx < nst * 64; idx += NTHR) { int s = idx >> 6, c = idx & 63; sx[s][c] = bf2f(xbc_act[(size_t)(t0 + c0 + s) * CONV_DIM + h * 64 + c]); }
            for (int idx = tid; idx < nst * 128; idx += NTHR) { int s = idx >> 7, c = idx & 127;
                sB[s][c] = bf2f(xbc_act[(size_t)(t0 + c0 + s) * CONV_DIM + 1536 + g * 128 + c]);
                sC[s][c] = bf2f(xbc_act[(size_t)(t0 + c0 + s) * CONV_DIM + 2048 + g * 128 + c]); }
            if (tid < nst) sdt[tid] = dtv[(size_t)(t0 + c0 + tid) * SSD_HEADS + h];
            __syncthreads();
            for (int s = 0; s < nst; ++s) {
                const float dt = sdt[s], x = sx[s][p];
                const float a = __expf(dt * A), xdt = x * dt;
                float y = 0.f;
#pragma unroll
                for (int j = 0; j < 16; ++j) { hs[j] = a * hs[j] + xdt * sB[s][ng * 16 + j]; y += sC[s][ng * 16 + j] * hs[j]; }
                y += __shfl_xor(y, 1); y += __shfl_xor(y, 2); y += __shfl_xor(y, 4);
                if (ng == 0) ybuf[(size_t)(t0 + c0 + s) * MIX_WIDTH + h * 64 + p] = y + D * x;
            }
        }
        float* so = is_p ? out + OUT_PS + (((size_t)seq * SSD_HEADS + h) * 64 + p) * 128 + ng * 16
                         : out + OUT_SS + (((size_t)(seq - BATCH) * SSD_HEADS + h) * 64 + p) * 128 + ng * 16;
#pragma unroll
        for (int j = 0; j < 16; ++j) so[j] = hs[j];
    }
}

__device__ __forceinline__ void ph_gate_norm(const bf16* __restrict__ projb, const float* __restrict__ norm_g, const float* __restrict__ ybuf, bf16* __restrict__ A1) {
    const int w = threadIdx.x >> 6, lane = threadIdx.x & 63, g = w & 3;
    for (int t = T_PROMPT + 2 * blockIdx.x + (w >> 2); t < T_ALL; t += 2 * gridDim.x) {
        float v[6]; float ss = 0.f;
#pragma unroll
        for (int j = 0; j < 6; ++j) {
            int c = g * 384 + j * 64 + lane;
            float y = ybuf[(size_t)t * MIX_WIDTH + c], z = bf2f(projb[(size_t)t * NB_LD + c]);
            v[j] = y * silu_f(z); ss += v[j] * v[j];
        }
        ss = wave_sum(ss);
        const float r = rsqrtf(ss * (1.0f / 384.0f) + LN_EPS);
#pragma unroll
        for (int j = 0; j < 6; ++j) { int c = g * 384 + j * 64 + lane; A1[(size_t)t * MIX_WIDTH + c] = (bf16)f2bf(v[j] * r * norm_g[c]); }
    }
}

__device__ __forceinline__ void ph_attn_naive(float* lds, const float* __restrict__ proj, const float* __restrict__ qrot, const float* __restrict__ krot,
                                              const float* __restrict__ ck, const float* __restrict__ cv, float* __restrict__ ybuf) {
    float (*sq)[64] = (float (*)[64])lds;
    const int w = threadIdx.x >> 6, lane = threadIdx.x & 63;
    for (int vb = blockIdx.x; vb < T_SAMPLE * 8 / NWAVE; vb += gridDim.x) {
        const int item = T_PROMPT * 8 + vb * NWAVE + w;
        const int t = item >> 3, h = item & 7;
        const bool is_p = t < T_PROMPT;
        int b, i;
        if (is_p) { b = t / SEQ; i = t % SEQ; } else { int ts = t - T_PROMPT; b = ts / DEC_SEQ; i = ts % DEC_SEQ; }
        __syncthreads();
        sq[w][lane] = qrot[(size_t)t * ATT_WIDTH + h * 64 + lane];
        __syncthreads();
        const int qi = is_p ? i : WBUF + i;
        float sc[3][3];
        float mx = -INFINITY;
#pragma unroll
        for (int pt = 0; pt < 3; ++pt) {
            const int d = pt == 0 ? 1 : (pt == 1 ? 4 : 16);
#pragma unroll
            for (int sl = 0; sl < 3; ++sl) {
                const int m = lane + sl * 64;
                float s = -INFINITY;
                const int kj = qi - d * m;
                if (m <= 128 && kj >= 0) {
                    const float* kr;
                    if (is_p) kr = krot + (size_t)(b * SEQ + kj) * ATT_WIDTH + h * 64;
                    else kr = (kj >= WBUF) ? krot + (size_t)(T_PROMPT + b * DEC_SEQ + (kj - WBUF)) * ATT_WIDTH + h * 64
                                           : ck + ((size_t)b * WBUF + kj) * ATT_WIDTH + h * 64;
                    float a = 0.f;
#pragma unroll
                    for (int c = 0; c < 64; c += 4) { float4 kv = *(const float4*)(kr + c); a += kv.x * sq[w][c] + kv.y * sq[w][c + 1] + kv.z * sq[w][c + 2] + kv.w * sq[w][c + 3]; }
                    s = a * 0.125f;
                }
                sc[pt][sl] = s; mx = fmaxf(mx, s);
            }
        }
        mx = wave_max(mx);
        float lsum = 0.f;
#pragma unroll
        for (int pt = 0; pt < 3; ++pt)
#pragma unroll
            for (int sl = 0; sl < 3; ++sl) { float pv = (sc[pt][sl] == -INFINITY) ? 0.f : __expf(sc[pt][sl] - mx); sc[pt][sl] = pv; lsum += pv; }
        lsum = wave_sum(lsum);
        float o = 0.f;
#pragma unroll
        for (int pt = 0; pt < 3; ++pt) {
            const int d = pt == 0 ? 1 : (pt == 1 ? 4 : 16);
#pragma unroll
            for (int sl = 0; sl < 3; ++sl) {
                const int mend = sl < 2 ? 64 : 1;
                for (int ml = 0; ml < mend; ++ml) {
                    const int m = ml + sl * 64;
                    const int kj = qi - d * m;
                    const float pv = __shfl(sc[pt][sl], ml);
                    if (kj < 0) continue;
                    const float* vr;
                    if (is_p) vr = proj + (size_t)(b * SEQ + kj) * PROJ_LD + O_V + h * 64;
                    else vr = (kj >= WBUF) ? proj + (size_t)(T_PROMPT + b * DEC_SEQ + (kj - WBUF)) * PROJ_LD + O_V + h * 64
                                           : cv + ((size_t)b * WBUF + kj) * ATT_WIDTH + h * 64;
                    o += pv * vr[lane];
                }
            }
        }
        ybuf[(size_t)t * MIX_WIDTH + SSD_WIDTH + h * 64 + lane] = o / lsum;
    }
}

__device__ __forceinline__ void ph_ln_res(const float* __restrict__ xp, const float* __restrict__ xs, const bf16* __restrict__ add, const float* __restrict__ gam,
                                          const float* __restrict__ bet, bf16* __restrict__ dstb) {
    const int lane = threadIdx.x & 63;
#pragma unroll 2
    for (int t = blockIdx.x * NWAVE + (threadIdx.x >> 6); t < T_ALL; t += gridDim.x * NWAVE) {
        const float* res = (t < T_PROMPT) ? xp + (size_t)t * D_MODEL : xs + (size_t)(t - T_PROMPT) * D_MODEL;
        float v[16]; float s = 0.f;
#pragma unroll
        for (int j = 0; j < 2; ++j) { const int c = j * 512 + lane * 8; const float4 r0 = *(const float4*)(res + c), r1 = *(const float4*)(res + c + 4);
            float a8[8]; unpack8(*(const v4u*)(add + (size_t)t * D_MODEL + c), a8);
            v[8 * j] = ALPHA_F * r0.x + a8[0]; v[8 * j + 1] = ALPHA_F * r0.y + a8[1]; v[8 * j + 2] = ALPHA_F * r0.z + a8[2]; v[8 * j + 3] = ALPHA_F * r0.w + a8[3];
            v[8 * j + 4] = ALPHA_F * r1.x + a8[4]; v[8 * j + 5] = ALPHA_F * r1.y + a8[5]; v[8 * j + 6] = ALPHA_F * r1.z + a8[6]; v[8 * j + 7] = ALPHA_F * r1.w + a8[7]; }
#pragma unroll
        for (int j = 0; j < 16; ++j) s += v[j];
        s = wave_sum(s);
        const float mu = s * (1.0f / 1024.0f);
        float q = 0.f;
#pragma unroll
        for (int j = 0; j < 16; ++j) { v[j] -= mu; q += v[j] * v[j]; }
        q = wave_sum(q);
        const float r = rsqrtf(q * (1.0f / 1024.0f) + LN_EPS);
#pragma unroll
        for (int j = 0; j < 2; ++j) { const int c = j * 512 + lane * 8; const float4 g0 = *(const float4*)(gam + c), g1 = *(const float4*)(gam + c + 4), b0 = *(const float4*)(bet + c), b1 = *(const float4*)(bet + c + 4);
            v4u o; o.x = pk2(v[8 * j] * r * g0.x + b0.x, v[8 * j + 1] * r * g0.y + b0.y); o.y = pk2(v[8 * j + 2] * r * g0.z + b0.z, v[8 * j + 3] * r * g0.w + b0.w);
            o.z = pk2(v[8 * j + 4] * r * g1.x + b1.x, v[8 * j + 5] * r * g1.y + b1.y); o.w = pk2(v[8 * j + 6] * r * g1.z + b1.z, v[8 * j + 7] * r * g1.w + b1.w);
            *(v4u*)(dstb + (size_t)t * D_MODEL + c) = o; }
    }
}

__device__ __forceinline__ void ph_peer_route(float* lds, const float* __restrict__ qh, const float* __restrict__ keys1, const float* __restrict__ keys2,
                                              int* __restrict__ eidx, float* __restrict__ gate) {
    float (*sq)[256] = (float (*)[256])lds;
    float (*sv)[2][16] = (float (*)[2][16])(lds + NWAVE * 256);
    int (*si)[2][16] = (int (*)[2][16])(lds + NWAVE * 256 + NWAVE * 32);
    const int w = threadIdx.x >> 6, lane = threadIdx.x & 63;
    for (int vb = blockIdx.x; vb < T_ALL * 8 / NWAVE; vb += gridDim.x) {
        const int item = vb * NWAVE + w;
        const int t = item >> 3, h = item & 7;
        __syncthreads();
        for (int c = lane; c < 256; c += 64) sq[w][c] = qh[(size_t)t * 2048 + h * 256 + c];
        __syncthreads();
#pragma unroll
        for (int half = 0; half < 2; ++half) {
            const float* keys = half ? keys2 : keys1;
            float s[2];
#pragma unroll
            for (int sl = 0; sl < 2; ++sl) {
                const float* kr = keys + (size_t)(lane + sl * 64) * 128;
                float a = 0.f;
#pragma unroll 8
                for (int c = 0; c < 128; c += 4) { float4 kv = *(const float4*)(kr + c); const float* qq = &sq[w][half * 128 + c]; a += kv.x * qq[0] + kv.y * qq[1] + kv.z * qq[2] + kv.w * qq[3]; }
                s[sl] = a;
            }
            for (int r = 0; r < 16; ++r) {
                float bv; int bi;
                if (s[0] >= s[1]) { bv = s[0]; bi = lane; } else { bv = s[1]; bi = lane + 64; }
#pragma unroll
                for (int o = 32; o > 0; o >>= 1) {
                    float ov = __shfl_xor(bv, o); int oi = __shfl_xor(bi, o);
                    if (ov > bv || (ov == bv && oi < bi)) { bv = ov; bi = oi; }
                }
                if (lane == 0) { sv[w][half][r] = bv; si[w][half][r] = bi; }
                if (bi == lane) s[0] = -INFINITY;
                if (bi == lane + 64) s[1] = -INFINITY;
            }
        }
        __syncthreads();
        float c[4];
#pragma unroll
        for (int j = 0; j < 4; ++j) { int ci = lane * 4 + j; c[j] = sv[w][0][ci >> 4] + sv[w][1][ci & 15]; }
        float myv = 0.f; int myc = 0;
        for (int r = 0; r < 16; ++r) {
            float bv = c[0]; int bi = lane * 4;
#pragma unroll
            for (int j = 1; j < 4; ++j) if (c[j] > bv) { bv = c[j]; bi = lane * 4 + j; }
#pragma unroll
            for (int o = 32; o > 0; o >>= 1) {
                float ov = __shfl_xor(bv, o); int oi = __shfl_xor(bi, o);
                if (ov > bv || (ov == bv && oi < bi)) { bv = ov; bi = oi; }
            }
            if (lane == r) { myv = bv; myc = bi; }
#pragma unroll
            for (int j = 0; j < 4; ++j) if (bi == lane * 4 + j) c[j] = -INFINITY;
        }
        float v = lane < 16 ? myv : -INFINITY;
        float mx = wave_max(v);
        float e = lane < 16 ? __expf(v - mx) : 0.f;
        float sum = wave_sum(e);
        if (lane < 16) {
            int ex = si[w][0][myc >> 4] * PEER_NKEYS + si[w][1][myc & 15];
            eidx[(size_t)t * 128 + h * 16 + lane] = ex;
            gate[(size_t)t * 128 + h * 16 + lane] = e / sum;
        }
    }
}

__device__ __forceinline__ void ph_peer_ffn(const float* __restrict__ hbuf, const int* __restrict__ eidx, const float* __restrict__ gate,
                                            const bf16* __restrict__ ub, const bf16* __restrict__ vb, const float* __restrict__ gam,
                                            const float* __restrict__ bet, float* __restrict__ out) {
    const int lane = threadIdx.x & 63;
    for (int t = blockIdx.x * NWAVE + (threadIdx.x >> 6); t < T_ALL; t += gridDim.x * NWAVE) {
        float x[16], acc[16];
        { const float* xr = hbuf + (size_t)t * D_MODEL + lane * 8;
          const float4 a = *(const float4*)xr, b = *(const float4*)(xr + 4), c = *(const float4*)(xr + 512), d = *(const float4*)(xr + 516);
          x[0] = a.x; x[1] = a.y; x[2] = a.z; x[3] = a.w; x[4] = b.x; x[5] = b.y; x[6] = b.z; x[7] = b.w;
          x[8] = c.x; x[9] = c.y; x[10] = c.z; x[11] = c.w; x[12] = d.x; x[13] = d.y; x[14] = d.z; x[15] = d.w; }
#pragma unroll
        for (int j = 0; j < 16; ++j) acc[j] = 0.f;
        for (int k = 0; k < 128; ++k) {
            const int e = eidx[(size_t)t * 128 + k];
            const float g = gate[(size_t)t * 128 + k];
            const bf16* ur = ub + (size_t)e * D_MODEL + lane * 8;
            float u0[8], u1[8];
            unpack8(*(const v4u*)ur, u0); unpack8(*(const v4u*)(ur + 512), u1);
            float d = 0.f;
#pragma unroll
            for (int j = 0; j < 8; ++j) d += u0[j] * x[j] + u1[j] * x[8 + j];
            d = wave_sum(d);
            const float wgt = g * gelu_f(d);
            const bf16* vr = vb + (size_t)e * D_MODEL + lane * 8;
            unpack8(*(const v4u*)vr, u0); unpack8(*(const v4u*)(vr + 512), u1);
#pragma unroll
            for (int j = 0; j < 8; ++j) { acc[j] += wgt * u0[j]; acc[8 + j] += wgt * u1[j]; }
        }
        float s = 0.f;
#pragma unroll
        for (int j = 0; j < 16; ++j) { acc[j] += ALPHA_F * x[j]; s += acc[j]; }
        s = wave_sum(s);
        const float mu = s * (1.0f / 1024.0f);
        float q = 0.f;
#pragma unroll
        for (int j = 0; j < 16; ++j) { acc[j] -= mu; q += acc[j] * acc[j]; }
        q = wave_sum(q);
        const float r = rsqrtf(q * (1.0f / 1024.0f) + LN_EPS);
        float* dst = ((t < T_PROMPT) ? out + OUT_YP + (size_t)t * D_MODEL : out + OUT_YS + (size_t)(t - T_PROMPT) * D_MODEL) + lane * 8;
#pragma unroll
        for (int q4 = 0; q4 < 4; ++q4) {
            const int eo = (q4 >> 1) * 512 + (q4 & 1) * 4;
            const float4 g4 = *(const float4*)(gam + lane * 8 + eo), b4 = *(const float4*)(bet + lane * 8 + eo);
            float4 o; o.x = acc[q4 * 4 + 0] * r * g4.x + b4.x; o.y = acc[q4 * 4 + 1] * r * g4.y + b4.y; o.z = acc[q4 * 4 + 2] * r * g4.z + b4.z; o.w = acc[q4 * 4 + 3] * r * g4.w + b4.w;
            *(float4*)(dst + eo) = o;
        }
    }
}

__device__ __forceinline__ float peer_dot16(const v4u a, const v4u b, const float (&x)[16]) {
    float u0[8], u1[8]; unpack8(a, u0); unpack8(b, u1);
    float d = 0.f;
#pragma unroll
    for (int j = 0; j < 8; ++j) d += u0[j] * x[j] + u1[j] * x[8 + j];
    return d;
}
#define PEER_TR_STEP(N, M) _Pragma("unroll") for (int i = 0; i < N; ++i) { const bool up = (lane & M) != 0; const float keep = up ? part[i + N] : part[i]; const float send = up ? part[i] : part[i + N]; part[i] = keep + __shfl_xor(send, M); }
__device__ __forceinline__ void ph_peer_ffn2(const float* __restrict__ hbuf, const int* __restrict__ eidx, const float* __restrict__ gate,
                                             const bf16* __restrict__ ub, const bf16* __restrict__ vb, const float* __restrict__ gam,
                                             const float* __restrict__ bet, float* __restrict__ out) {
    const int lane0 = threadIdx.x & 63;
    for (int t = blockIdx.x * NWAVE + (threadIdx.x >> 6); t < T_ALL; t += gridDim.x * NWAVE) {
        int lane = lane0; asm volatile("" : "+v"(lane));
        float x[16];
        { const float* xr = hbuf + (size_t)t * D_MODEL + lane * 8;
          const float4 a = *(const float4*)xr, b = *(const float4*)(xr + 4), c = *(const float4*)(xr + 512), d = *(const float4*)(xr + 516);
          x[0] = a.x; x[1] = a.y; x[2] = a.z; x[3] = a.w; x[4] = b.x; x[5] = b.y; x[6] = b.z; x[7] = b.w;
          x[8] = c.x; x[9] = c.y; x[10] = c.z; x[11] = c.w; x[12] = d.x; x[13] = d.y; x[14] = d.z; x[15] = d.w; }
        int ev[2]; float wv[4];
        ev[0] = eidx[(size_t)t * 128 + lane]; ev[1] = eidx[(size_t)t * 128 + 64 + lane];
#pragma unroll
        for (int rd = 0; rd < 4; ++rd) wv[rd] = gate[(size_t)t * 128 + rd * 32 + (lane >> 1)];
#pragma unroll
        for (int rd = 0; rd < 4; ++rd) {
            float part[32];
#pragma unroll
            for (int kb = 0; kb < 8; ++kb) {
                v4u ra[4], rb[4];
#pragma unroll
                for (int k8 = 0; k8 < 4; ++k8) {
                    const int e = __builtin_amdgcn_readlane(ev[rd >> 1], (rd & 1) * 32 + kb * 4 + k8);
                    const bf16* ur = ub + (size_t)e * D_MODEL + lane * 8;
                    ra[k8] = *(const v4u*)ur; rb[k8] = *(const v4u*)(ur + 512);
                }
#pragma unroll
                for (int k8 = 0; k8 < 4; ++k8) part[kb * 4 + k8] = peer_dot16(ra[k8], rb[k8], x);
            }
            PEER_TR_STEP(16, 32) PEER_TR_STEP(8, 16) PEER_TR_STEP(4, 8) PEER_TR_STEP(2, 4) PEER_TR_STEP(1, 2)
            const float hid = part[0] + __shfl_xor(part[0], 1);
            wv[rd] *= gelu_f(hid);
        }
        float acc[16];
#pragma unroll
        for (int j = 0; j < 16; ++j) acc[j] = 0.f;
#pragma unroll
        for (int rd = 0; rd < 4; ++rd) {
#pragma unroll
            for (int kb = 0; kb < 4; ++kb) {
                v4u ra[8], rb[8];
#pragma unroll
                for (int k8 = 0; k8 < 8; ++k8) {
                    const int e = __builtin_amdgcn_readlane(ev[rd >> 1], (rd & 1) * 32 + kb * 8 + k8);
                    const bf16* vr = vb + (size_t)e * D_MODEL + lane * 8;
                    ra[k8] = *(const v4u*)vr; rb[k8] = *(const v4u*)(vr + 512);
                }
#pragma unroll
                for (int k8 = 0; k8 < 8; ++k8) {
                    const float wk = __builtin_bit_cast(float, __builtin_amdgcn_readlane(__builtin_bit_cast(int, wv[rd]), 2 * (kb * 8 + k8)));
                    float u0[8], u1[8]; unpack8(ra[k8], u0); unpack8(rb[k8], u1);
#pragma unroll
                    for (int j = 0; j < 8; ++j) { acc[j] += wk * u0[j]; acc[8 + j] += wk * u1[j]; }
                }
            }
        }
        float s = 0.f;
#pragma unroll
        for (int j = 0; j < 16; ++j) { acc[j] += ALPHA_F * x[j]; s += acc[j]; }
        s = wave_sum(s);
        const float mu = s * (1.0f / 1024.0f);
        float q = 0.f;
#pragma unroll
        for (int j = 0; j < 16; ++j) { acc[j] -= mu; q += acc[j] * acc[j]; }
        q = wave_sum(q);
        const float r = rsqrtf(q * (1.0f / 1024.0f) + LN_EPS);
        float* dst = ((t < T_PROMPT) ? out + OUT_YP + (size_t)t * D_MODEL : out + OUT_YS + (size_t)(t - T_PROMPT) * D_MODEL) + lane * 8;
#pragma unroll
        for (int q4 = 0; q4 < 4; ++q4) {
            const int eo = (q4 >> 1) * 512 + (q4 & 1) * 4;
            const float4 g4 = *(const float4*)(gam + lane * 8 + eo), b4 = *(const float4*)(bet + lane * 8 + eo);
            float4 o; o.x = acc[q4 * 4 + 0] * r * g4.x + b4.x; o.y = acc[q4 * 4 + 1] * r * g4.y + b4.y; o.z = acc[q4 * 4 + 2] * r * g4.z + b4.z; o.w = acc[q4 * 4 + 3] * r * g4.w + b4.w;
            *(float4*)(dst + eo) = o;
        }
    }
}

__device__ __forceinline__ void ph_attn_sample(float* lds, const bf16* __restrict__ qrot_b, const bf16* __restrict__ krot_b, const bf16* __restrict__ projb,
                                               const float* __restrict__ ck, const float* __restrict__ cv, bf16* __restrict__ A1) {
    float (*sq)[64] = (float (*)[64])lds;
    const int w = threadIdx.x >> 6, lane0 = threadIdx.x & 63;
    for (int vb = blockIdx.x; vb < T_SAMPLE * 8 / NWAVE; vb += gridDim.x) {
        int lane = lane0; asm volatile("" : "+v"(lane));
        const int item = vb * NWAVE + w, ts = item >> 3, hd = item & 7, b = ts >> 2, i = ts & 3, t = T_PROMPT + ts;
        __syncthreads();
        sq[w][lane] = bf2f(qrot_b[(size_t)t * ATT_WIDTH + hd * 64 + lane]);
        __syncthreads();
        const int qi = WBUF + i;
        float sc[8];
        float mx = -INFINITY;
#pragma unroll
        for (int slot = 0; slot < 7; ++slot) {
            const int pt = slot < 6 ? (slot >> 1) : (lane < 3 ? lane : 0);
            const int m = slot < 6 ? lane + 64 * (slot & 1) : 128;
            const int kj = qi - (m << (2 * pt));
            const bool valid = (slot < 6 || lane < 3) && kj < WBUF;
            const int kc = kj < WBUF ? kj : WBUF - 1;
            const float* kr = ck + ((size_t)b * WBUF + kc) * ATT_WIDTH + hd * 64;
            float a = 0.f;
#pragma unroll
            for (int c = 0; c < 64; c += 4) { const float4 kv = *(const float4*)(kr + c); a += kv.x * sq[w][c] + kv.y * sq[w][c + 1] + kv.z * sq[w][c + 2] + kv.w * sq[w][c + 3]; }
            const float s = valid ? a * 0.125f : -INFINITY;
            sc[slot] = s; mx = fmaxf(mx, s);
        }
        const int nt7 = lane <= i ? i - lane : i;
        const bool valid7 = lane < i + 3;
        {
            const bf16* kr = krot_b + (size_t)(T_PROMPT + b * DEC_SEQ + nt7) * ATT_WIDTH + hd * 64;
            float a = 0.f;
#pragma unroll
            for (int c = 0; c < 64; c += 8) { float f[8]; unpack8(*(const v4u*)(kr + c), f);
#pragma unroll
                for (int j = 0; j < 8; ++j) a += f[j] * sq[w][c + j]; }
            const float s = valid7 ? a * 0.125f : -INFINITY;
            sc[7] = s; mx = fmaxf(mx, s);
        }
        mx = wave_max(mx);
        float lsum = 0.f;
#pragma unroll
        for (int slot = 0; slot < 8; ++slot) { const float pv = __expf(sc[slot] - mx); sc[slot] = pv; lsum += pv; }
        lsum = wave_sum(lsum);
        float part[64];
#pragma unroll
        for (int c = 0; c < 64; ++c) part[c] = 0.f;
#pragma unroll
        for (int slot = 0; slot < 7; ++slot) {
            const int pt = slot < 6 ? (slot >> 1) : (lane < 3 ? lane : 0);
            const int m = slot < 6 ? lane + 64 * (slot & 1) : 128;
            const int kj = qi - (m << (2 * pt));
            const int kc = kj < WBUF ? kj : WBUF - 1;
            const float pv = sc[slot];
            const float* vr = cv + ((size_t)b * WBUF + kc) * ATT_WIDTH + hd * 64;
#pragma unroll
            for (int c = 0; c < 64; c += 4) { const float4 vv = *(const float4*)(vr + c); part[c] += pv * vv.x; part[c + 1] += pv * vv.y; part[c + 2] += pv * vv.z; part[c + 3] += pv * vv.w; }
        }
        {
            const float pv = sc[7];
            const bf16* vr = projb + (size_t)(T_PROMPT + b * DEC_SEQ + nt7) * NB_LD + NB_V + hd * 64;
#pragma unroll
            for (int c = 0; c < 64; c += 8) { float f[8]; unpack8(*(const v4u*)(vr + c), f);
#pragma unroll
                for (int j = 0; j < 8; ++j) part[c + j] += pv * f[j]; }
        }
        PEER_TR_STEP(32, 32) PEER_TR_STEP(16, 16) PEER_TR_STEP(8, 8) PEER_TR_STEP(4, 4) PEER_TR_STEP(2, 2) PEER_TR_STEP(1, 1)
        A1[(size_t)t * MIX_WIDTH + SSD_WIDTH + hd * 64 + lane] = (bf16)f2bf(part[0] / lsum);
    }
}


__device__ __forceinline__ void cache_copy_slice(const float* __restrict__ ck, const float* __restrict__ cv, float* __restrict__ out, unsigned slice, unsigned lane) {
    constexpr unsigned PER_B = (WBUF - DEC_SEQ) * ATT_WIDTH / 4;
    constexpr unsigned TOTAL = 2u * DEC_BATCH * PER_B;
#pragma unroll 1
    for (unsigned bt = 0; bt < 8; ++bt) {
        f32x4n v[8]; size_t dsti[8]; bool isv[8]; bool ok[8];
#pragma unroll
        for (int j = 0; j < 8; ++j) {
            const unsigned idx = slice * 4096u + bt * 512u + j * 64u + lane;
            ok[j] = idx < TOTAL;
            const unsigned idc = ok[j] ? idx : 0u;
            const unsigned tb = idc / PER_B, r = idc - tb * PER_B, bb = tb & (DEC_BATCH - 1);
            isv[j] = tb >= DEC_BATCH;
            const size_t srci = (size_t)bb * (WBUF * ATT_WIDTH / 4) + (DEC_SEQ * ATT_WIDTH / 4) + r;
            dsti[j] = (size_t)bb * (WBUF * ATT_WIDTH / 4) + r;
            v[j] = __builtin_nontemporal_load((isv[j] ? (const f32x4n*)cv : (const f32x4n*)ck) + srci);
        }
#pragma unroll
        for (int j = 0; j < 8; ++j) if (ok[j]) __builtin_nontemporal_store(v[j], (f32x4n*)(out + (isv[j] ? OUT_SV : OUT_SK)) + dsti[j]);
    }
}

__device__ __forceinline__ void copy_q_load(const float* __restrict__ ck, const float* __restrict__ cv, unsigned q, unsigned lane, f32x4n (&v)[16]) {
    constexpr unsigned PER_B = (WBUF - DEC_SEQ) * ATT_WIDTH / 4, TOTAL = 2u * DEC_BATCH * PER_B;
#pragma unroll
    for (int j = 0; j < 16; ++j) {
        const unsigned idx = q * 1024u + j * 64u + lane, idc = idx < TOTAL ? idx : 0u;
        const unsigned tb = idc / PER_B, r = idc - tb * PER_B, bb = tb & (DEC_BATCH - 1);
        const size_t srci = (size_t)bb * (WBUF * ATT_WIDTH / 4) + (DEC_SEQ * ATT_WIDTH / 4) + r;
        v[j] = __builtin_nontemporal_load((tb >= DEC_BATCH ? (const f32x4n*)cv : (const f32x4n*)ck) + srci);
    }
}
__device__ __forceinline__ void copy_q_store(float* __restrict__ out, unsigned q, unsigned lane, const f32x4n (&v)[16]) {
    constexpr unsigned PER_B = (WBUF - DEC_SEQ) * ATT_WIDTH / 4, TOTAL = 2u * DEC_BATCH * PER_B;
#pragma unroll
    for (int j = 0; j < 16; ++j) {
        const unsigned idx = q * 1024u + j * 64u + lane;
        if (idx < TOTAL) {
            const unsigned tb = idx / PER_B, r = idx - tb * PER_B, bb = tb & (DEC_BATCH - 1);
            const size_t dsti = (size_t)bb * (WBUF * ATT_WIDTH / 4) + r;
            __builtin_nontemporal_store(v[j], (f32x4n*)(out + (tb >= DEC_BATCH ? OUT_SV : OUT_SK)) + dsti);
        }
    }
}
typedef float f32x2v __attribute__((ext_vector_type(2)));
__device__ __forceinline__ void ph_quant_tables(const float* __restrict__ pu, const float* __restrict__ pv, unsigned char* __restrict__ ub8, unsigned char* __restrict__ vb8,
                                                float* __restrict__ usc, float* __restrict__ vsc, int rank, int nranks) {
    const int lane = threadIdx.x & 63;
#pragma unroll 2
    for (int row = rank * NWAVE + (threadIdx.x >> 6); row < 2 * 16384; row += nranks * NWAVE) {
        const int rr = row & 16383; const bool isv = row >= 16384;
        const float* src = (isv ? pv : pu) + (size_t)rr * D_MODEL + lane * 8;
        const float4 a = *(const float4*)src, b = *(const float4*)(src + 4), c = *(const float4*)(src + 512), d = *(const float4*)(src + 516);
        float am = fmaxf(fmaxf(fmaxf(fabsf(a.x), fabsf(a.y)), fmaxf(fabsf(a.z), fabsf(a.w))), fmaxf(fmaxf(fabsf(b.x), fabsf(b.y)), fmaxf(fabsf(b.z), fabsf(b.w))));
        am = fmaxf(am, fmaxf(fmaxf(fmaxf(fabsf(c.x), fabsf(c.y)), fmaxf(fabsf(c.z), fabsf(c.w))), fmaxf(fmaxf(fabsf(d.x), fabsf(d.y)), fmaxf(fabsf(d.z), fabsf(d.w)))));
        am = wave_max(am);
        const float sc = am > 0.f ? 224.0f / am : 1.0f;
        v4u o;
        o.x = (unsigned)__builtin_amdgcn_cvt_pk_fp8_f32(a.z * sc, a.w * sc, __builtin_amdgcn_cvt_pk_fp8_f32(a.x * sc, a.y * sc, 0, false), true);
        o.y = (unsigned)__builtin_amdgcn_cvt_pk_fp8_f32(b.z * sc, b.w * sc, __builtin_amdgcn_cvt_pk_fp8_f32(b.x * sc, b.y * sc, 0, false), true);
        o.z = (unsigned)__builtin_amdgcn_cvt_pk_fp8_f32(c.z * sc, c.w * sc, __builtin_amdgcn_cvt_pk_fp8_f32(c.x * sc, c.y * sc, 0, false), true);
        o.w = (unsigned)__builtin_amdgcn_cvt_pk_fp8_f32(d.z * sc, d.w * sc, __builtin_amdgcn_cvt_pk_fp8_f32(d.x * sc, d.y * sc, 0, false), true);
        *(v4u*)((isv ? vb8 : ub8) + (size_t)rr * 1024 + lane * 16) = o;
        if (lane == 0) (isv ? vsc : usc)[rr] = am > 0.f ? am * (1.0f / 224.0f) : 1.0f;
    }
}
__device__ __forceinline__ void unpack16_fp8(const v4u w, float (&f)[16]) {
#pragma unroll
    for (int i = 0; i < 4; ++i) {
        const f32x2v lo = __builtin_amdgcn_cvt_pk_f32_fp8((int)w[i], false), hi = __builtin_amdgcn_cvt_pk_f32_fp8((int)w[i], true);
        f[4 * i] = lo[0]; f[4 * i + 1] = lo[1]; f[4 * i + 2] = hi[0]; f[4 * i + 3] = hi[1];
    }
}
__device__ __forceinline__ unsigned ffn_slice(unsigned n9, unsigned it) {
    const unsigned wgl = blockIdx.x * NWAVE + (threadIdx.x >> 6);
    if (gridDim.x != 256) return n9 + wgl + it * (gridDim.x * NWAVE);
    if (it < 2u) return n9 + it * 2048u + wgl;
    if (wgl < 512u) return 0xffffffffu;
    const unsigned lw = wgl - 512u;
    if (it < 4u) return n9 + 4096u + (it - 2u) * 1536u + lw;
    if (it == 4u && lw < 256u) return n9 + 7168u + lw;
    return 0xffffffffu;
}
__device__ __forceinline__ void ph_peer_ffn3(const bf16* __restrict__ hb, const int* __restrict__ eidx, const float* __restrict__ gate,
                                             const unsigned char* __restrict__ ub8, const unsigned char* __restrict__ vb8, const float* __restrict__ usc, const float* __restrict__ vsc,
                                             const float* __restrict__ gam, const float* __restrict__ bet, float* __restrict__ out,
                                             const float* __restrict__ ck, const float* __restrict__ cv, unsigned n9) {
    const int lane0 = threadIdx.x & 63;
    unsigned it = 0;
    for (int t = blockIdx.x * NWAVE + (threadIdx.x >> 6); t < T_ALL; t += gridDim.x * NWAVE, ++it) {
        int lane = lane0; asm volatile("" : "+v"(lane));
        { const unsigned sl = ffn_slice(n9, it); if (sl < 16384u) cache_copy_slice(ck, cv, out, sl, (unsigned)lane); }
        const unsigned lo16 = (unsigned)lane * 16u, lo8 = (unsigned)lane * 8u;
        float x[16];
        { float f0[8], f1[8]; const bf16* xr = hb + (size_t)t * D_MODEL + lo8; unpack8(*(const v4u*)xr, f0); unpack8(*(const v4u*)(xr + 512), f1);
#pragma unroll
          for (int j = 0; j < 8; ++j) { x[j] = f0[j]; x[8 + j] = f1[j]; } }
        int ev[2]; float wv[4], su[4];
        ev[0] = eidx[(size_t)t * 128 + lane]; ev[1] = eidx[(size_t)t * 128 + 64 + lane];
#pragma unroll
        for (int rd = 0; rd < 4; ++rd) {
            const int er = eidx[(size_t)t * 128 + rd * 32 + (lane >> 1)];
            wv[rd] = gate[(size_t)t * 128 + rd * 32 + (lane >> 1)] * vsc[er];
            su[rd] = usc[er];
        }
#pragma unroll
        for (int rd = 0; rd < 4; ++rd) {
            float part[32];
#pragma unroll
            for (int kb = 0; kb < 8; ++kb) {
                v4u ra[4];
#pragma unroll
                for (int k8 = 0; k8 < 4; ++k8) {
                    const int e = __builtin_amdgcn_readlane(ev[rd >> 1], (rd & 1) * 32 + kb * 4 + k8);
                    ra[k8] = *(const v4u*)(ub8 + (size_t)e * 1024 + lo16);
                }
#pragma unroll
                for (int k8 = 0; k8 < 4; ++k8) {
                    f32x2v dv = {0.f, 0.f};
#pragma unroll
                    for (int i = 0; i < 4; ++i) {
                        const f32x2v lo = __builtin_amdgcn_cvt_pk_f32_fp8((int)ra[k8][i], false), hi = __builtin_amdgcn_cvt_pk_f32_fp8((int)ra[k8][i], true);
                        dv += lo * (f32x2v){x[4 * i], x[4 * i + 1]}; dv += hi * (f32x2v){x[4 * i + 2], x[4 * i + 3]};
                    }
                    part[kb * 4 + k8] = dv[0] + dv[1];
                    if (k8 & 1) __builtin_amdgcn_sched_barrier(0);
                }
            }
            PEER_TR_STEP(16, 32) PEER_TR_STEP(8, 16) PEER_TR_STEP(4, 8) PEER_TR_STEP(2, 4) PEER_TR_STEP(1, 2)
            const float hid = (part[0] + __shfl_xor(part[0], 1)) * su[rd];
            wv[rd] *= gelu_f(hid);
        }
        float acc[16];
#pragma unroll
        for (int j = 0; j < 16; ++j) acc[j] = 0.f;
#pragma unroll
        for (int rd = 0; rd < 4; ++rd) {
#pragma unroll
            for (int kb = 0; kb < 4; ++kb) {
                v4u ra[8];
#pragma unroll
                for (int k8 = 0; k8 < 8; ++k8) {
                    const int e = __builtin_amdgcn_readlane(ev[rd >> 1], (rd & 1) * 32 + kb * 8 + k8);
                    ra[k8] = *(const v4u*)(vb8 + (size_t)e * 1024 + lo16);
                }
#pragma unroll
                for (int k8 = 0; k8 < 8; ++k8) {
                    const float wk = __builtin_bit_cast(float, __builtin_amdgcn_readlane(__builtin_bit_cast(int, wv[rd]), 2 * (kb * 8 + k8)));
                    float f[16]; unpack16_fp8(ra[k8], f);
#pragma unroll
                    for (int j = 0; j < 16; ++j) acc[j] += wk * f[j];
                    if (k8 & 1) __builtin_amdgcn_sched_barrier(0);
                }
            }
        }
        float s = 0.f;
#pragma unroll
        for (int j = 0; j < 16; ++j) { acc[j] += ALPHA_F * x[j]; s += acc[j]; }
        s = wave_sum(s);
        const float mu = s * (1.0f / 1024.0f);
        float q = 0.f;
#pragma unroll
        for (int j = 0; j < 16; ++j) { acc[j] -= mu; q += acc[j] * acc[j]; }
        q = wave_sum(q);
        const float r = rsqrtf(q * (1.0f / 1024.0f) + LN_EPS);
        float* dst = ((t < T_PROMPT) ? out + OUT_YP + (size_t)t * D_MODEL : out + OUT_YS + (size_t)(t - T_PROMPT) * D_MODEL) + lo8;
#pragma unroll
        for (int q4 = 0; q4 < 4; ++q4) {
            const int eo = (q4 >> 1) * 512 + (q4 & 1) * 4;
            const float4 g4 = *(const float4*)(gam + lo8 + eo), b4 = *(const float4*)(bet + lo8 + eo);
            float4 o; o.x = acc[q4 * 4 + 0] * r * g4.x + b4.x; o.y = acc[q4 * 4 + 1] * r * g4.y + b4.y; o.z = acc[q4 * 4 + 2] * r * g4.z + b4.z; o.w = acc[q4 * 4 + 3] * r * g4.w + b4.w;
            *(float4*)(dst + eo) = o;
        }
    }
    for (;; ++it) {
        if (gridDim.x == 256 && it >= 5u) break;
        const unsigned sl = ffn_slice(n9, it);
        if (gridDim.x != 256 && sl >= 16384u) break;
        if (sl < 16384u) cache_copy_slice(ck, cv, out, sl, (unsigned)lane0);
    }
}


__device__ __forceinline__ void ssd_decode_load(const bf16* __restrict__ xbc_b, const float* __restrict__ dtv, const float* __restrict__ state_ssm, int item, int p, int ng,
                                                float (&hs)[16], v4u (&bq)[4][2], v4u (&cq)[4][2], float (&xv)[4], float (&dv)[4]) {
    const int sb = item / SSD_HEADS, h = item - sb * SSD_HEADS, g = h / 6, t0 = T_PROMPT + sb * DEC_SEQ;
    const float* s0 = state_ssm + (((size_t)sb * SSD_HEADS + h) * 64 + p) * 128 + ng * 16;
#pragma unroll
    for (int j = 0; j < 4; ++j) { const float4 v = *(const float4*)(s0 + 4 * j); hs[4 * j] = v.x; hs[4 * j + 1] = v.y; hs[4 * j + 2] = v.z; hs[4 * j + 3] = v.w; }
#pragma unroll
    for (int s = 0; s < 4; ++s) {
        const bf16* row = xbc_b + (size_t)(t0 + s) * CONV_DIM;
        bq[s][0] = *(const v4u*)(row + 1536 + g * 128 + ng * 16); bq[s][1] = *(const v4u*)(row + 1536 + g * 128 + ng * 16 + 8);
        cq[s][0] = *(const v4u*)(row + 2048 + g * 128 + ng * 16); cq[s][1] = *(const v4u*)(row + 2048 + g * 128 + ng * 16 + 8);
        xv[s] = bf2f(row[h * 64 + p]); dv[s] = dtv[(size_t)(t0 + s) * SSD_HEADS + h];
    }
}
__device__ __forceinline__ void ssd_decode_compute(const float* __restrict__ a_log, const float* __restrict__ d_skip, int item, int p, int ng,
                                                   float (&hs)[16], const v4u (&bq)[4][2], const v4u (&cq)[4][2], const float (&xv)[4], const float (&dv)[4],
                                                   float* __restrict__ ybuf, float* __restrict__ out) {
    const int sb = item / SSD_HEADS, h = item - sb * SSD_HEADS, t0 = T_PROMPT + sb * DEC_SEQ;
    const float A = -__expf(a_log[h]), D = d_skip[h];
#pragma unroll
    for (int s = 0; s < 4; ++s) {
        float Bf[16], Cf[16];
        { float t8[8]; unpack8(bq[s][0], t8);
#pragma unroll
          for (int j = 0; j < 8; ++j) Bf[j] = t8[j];
          unpack8(bq[s][1], t8);
#pragma unroll
          for (int j = 0; j < 8; ++j) Bf[8 + j] = t8[j];
          unpack8(cq[s][0], t8);
#pragma unroll
          for (int j = 0; j < 8; ++j) Cf[j] = t8[j];
          unpack8(cq[s][1], t8);
#pragma unroll
          for (int j = 0; j < 8; ++j) Cf[8 + j] = t8[j]; }
        const float a = __expf(dv[s] * A), xdt = xv[s] * dv[s];
        float y = 0.f;
#pragma unroll
        for (int j = 0; j < 16; ++j) { hs[j] = a * hs[j] + xdt * Bf[j]; y += Cf[j] * hs[j]; }
        y += __shfl_xor(y, 1); y += __shfl_xor(y, 2); y += __shfl_xor(y, 4);
        if (ng == 0) ybuf[(size_t)(t0 + s) * MIX_WIDTH + h * 64 + p] = y + D * xv[s];
    }
    float* so = out + OUT_SS + (((size_t)sb * SSD_HEADS + h) * 64 + p) * 128 + ng * 16;
#pragma unroll
    for (int j = 0; j < 4; ++j) *(float4*)(so + 4 * j) = make_float4(hs[4 * j], hs[4 * j + 1], hs[4 * j + 2], hs[4 * j + 3]);
}
__device__ __forceinline__ void ph_ssd_decode(const bf16* __restrict__ xbc_b, const float* __restrict__ dtv, const float* __restrict__ a_log, const float* __restrict__ d_skip,
                                              const float* __restrict__ state_ssm, float* __restrict__ ybuf, float* __restrict__ out) {
    const int tid = threadIdx.x, p = tid >> 3, ng = tid & 7;
    constexpr int NITEM = DEC_BATCH * SSD_HEADS;
    for (int it = blockIdx.x; it < NITEM; it += 2 * gridDim.x) {
        const int it2 = it + gridDim.x; const bool has2 = it2 < NITEM; const int it2c = has2 ? it2 : it;
        float hsA[16], hsB[16], xA[4], xB[4], dA[4], dB[4]; v4u bA[4][2], cA[4][2], bB[4][2], cB[4][2];
        ssd_decode_load(xbc_b, dtv, state_ssm, it, p, ng, hsA, bA, cA, xA, dA);
        ssd_decode_load(xbc_b, dtv, state_ssm, it2c, p, ng, hsB, bB, cB, xB, dB);
        ssd_decode_compute(a_log, d_skip, it, p, ng, hsA, bA, cA, xA, dA, ybuf, out);
        if (has2) ssd_decode_compute(a_log, d_skip, it2, p, ng, hsB, bB, cB, xB, dB, ybuf, out);
    }
}

__device__ __forceinline__ float samp_cw(int d) { return (float)((int)(d >= 0 && d <= 128) + (int)(d >= 0 && (d & 3) == 0 && d <= 512) + (int)(d >= 0 && (d & 15) == 0 && d <= 2048)); }
__device__ __forceinline__ void samp_update(float sv, float cw, const float (&vrow)[64], float& m, float& l, float (&part)[64]) {
    const float mn = fmaxf(m, sv), alpha = __expf(m - mn), p = cw * __expf(sv - mn);
    m = mn; l = l * alpha + p;
#pragma unroll
    for (int c = 0; c < 64; ++c) part[c] = part[c] * alpha + p * vrow[c];
}
__device__ __forceinline__ void ph_attn_sample3(float* lds, const bf16* __restrict__ qrot_b, const bf16* __restrict__ krot_b, const bf16* __restrict__ projb,
                                                const float* __restrict__ ck, const float* __restrict__ cv, bf16* __restrict__ A1) {
    const int lane0 = threadIdx.x & 63, w = __builtin_amdgcn_readfirstlane(threadIdx.x >> 6);
    float* sq = lds + w * 256;
    for (int item = blockIdx.x + gridDim.x * w; item < DEC_BATCH * ATT_HEADS; item += gridDim.x * NWAVE) {
        int lane = lane0; asm volatile("" : "+v"(lane));
        const int b = item >> 3, hd = item & 7, qi = lane & 3, g = lane >> 2;
        const int tq0 = T_PROMPT + b * DEC_SEQ;
#pragma unroll
        for (int i = 0; i < 4; ++i) sq[i * 64 + lane] = bf2f(qrot_b[(size_t)(tq0 + i) * ATT_WIDTH + hd * 64 + lane]);
        asm volatile("s_waitcnt lgkmcnt(0)" ::: "memory");
        const float* qv = sq + qi * 64;
        const float* ckb = ck + (size_t)b * WBUF * ATT_WIDTH + hd * 64; const float* cvb = cv + (size_t)b * WBUF * ATT_WIDTH + hd * 64;
        float m = -1e30f, l = 0.f, part[64];
#pragma unroll
        for (int c = 0; c < 64; ++c) part[c] = 0.f;
        {
            const int P = 2051 - g;
            const float cw = samp_cw(WBUF + qi - P);
            const bool isn = P >= WBUF;
            const int nt = isn ? P - WBUF : 0, Pc = isn ? WBUF - 1 : P;
            const bf16* kn = krot_b + (size_t)(tq0 + nt) * ATT_WIDTH + hd * 64; const float* kr = ckb + (size_t)Pc * ATT_WIDTH;
            float a = 0.f;
#pragma unroll
            for (int c = 0; c < 64; c += 8) { float f[8]; unpack8(*(const v4u*)(kn + c), f); const float4 k0 = *(const float4*)(kr + c), k1 = *(const float4*)(kr + c + 4);
                a += (isn ? f[0] : k0.x) * qv[c] + (isn ? f[1] : k0.y) * qv[c + 1] + (isn ? f[2] : k0.z) * qv[c + 2] + (isn ? f[3] : k0.w) * qv[c + 3]
                   + (isn ? f[4] : k1.x) * qv[c + 4] + (isn ? f[5] : k1.y) * qv[c + 5] + (isn ? f[6] : k1.z) * qv[c + 6] + (isn ? f[7] : k1.w) * qv[c + 7]; }
            const float sv = cw > 0.f ? a * 0.125f : -1e30f;
            const bf16* vn = projb + (size_t)(tq0 + nt) * NB_LD + NB_V + hd * 64; const float* vr = cvb + (size_t)Pc * ATT_WIDTH;
            float vrow[64];
#pragma unroll
            for (int c = 0; c < 64; c += 8) { float f[8]; unpack8(*(const v4u*)(vn + c), f); const float4 v0 = *(const float4*)(vr + c), v1 = *(const float4*)(vr + c + 4);
                vrow[c] = isn ? f[0] : v0.x; vrow[c + 1] = isn ? f[1] : v0.y; vrow[c + 2] = isn ? f[2] : v0.z; vrow[c + 3] = isn ? f[3] : v0.w;
                vrow[c + 4] = isn ? f[4] : v1.x; vrow[c + 5] = isn ? f[5] : v1.y; vrow[c + 6] = isn ? f[6] : v1.z; vrow[c + 7] = isn ? f[7] : v1.w; }
            samp_update(sv, cw, vrow, m, l, part);
        }
#pragma unroll 1
        for (int s = 1; s < 21; ++s) {
            const int P = s < 9 ? 2051 - (16 * s + g) : (s < 15 ? 1536 + 64 * (s - 9) + lane : qi + 16 * (16 * (s - 15) + g));
            const float cw = (s < 9 && P < 1920) ? 0.f : samp_cw(WBUF + qi - P);
            const float* kr = ckb + (size_t)P * ATT_WIDTH;
            float a = 0.f;
#pragma unroll
            for (int c = 0; c < 64; c += 4) { const float4 kv = *(const float4*)(kr + c); a += kv.x * qv[c] + kv.y * qv[c + 1] + kv.z * qv[c + 2] + kv.w * qv[c + 3]; }
            const float sv = cw > 0.f ? a * 0.125f : -1e30f;
            __builtin_amdgcn_sched_barrier(0);
            const float* vr = cvb + (size_t)P * ATT_WIDTH;
            float vrow[64];
#pragma unroll
            for (int c = 0; c < 64; c += 4) { const float4 vv = *(const float4*)(vr + c); vrow[c] = vv.x; vrow[c + 1] = vv.y; vrow[c + 2] = vv.z; vrow[c + 3] = vv.w; }
            samp_update(sv, cw, vrow, m, l, part);
        }
        float M = m;
        M = fmaxf(M, __shfl_xor(M, 4)); M = fmaxf(M, __shfl_xor(M, 8)); M = fmaxf(M, __shfl_xor(M, 16)); M = fmaxf(M, __shfl_xor(M, 32));
        const float sc = __expf(m - M);
        float lsum = l * sc;
        lsum += __shfl_xor(lsum, 4); lsum += __shfl_xor(lsum, 8); lsum += __shfl_xor(lsum, 16); lsum += __shfl_xor(lsum, 32);
#pragma unroll
        for (int c = 0; c < 64; ++c) part[c] *= sc;
        PEER_TR_STEP(32, 32) PEER_TR_STEP(16, 16) PEER_TR_STEP(8, 8) PEER_TR_STEP(4, 4)
        const float inv = 1.0f / lsum;
        *(uint2*)(A1 + (size_t)(tq0 + qi) * MIX_WIDTH + SSD_WIDTH + hd * 64 + 4 * g) = make_uint2(pk2(part[0] * inv, part[1] * inv), pk2(part[2] * inv, part[3] * inv));
    }
}

typedef float f32x16 __attribute__((ext_vector_type(16)));
typedef short s16x8 __attribute__((ext_vector_type(8)));
typedef short s16x4 __attribute__((ext_vector_type(4)));
typedef float f32x4v __attribute__((ext_vector_type(4)));
#define SSD_L_ACS 0
#define SSD_L_DTS 3072
#define SSD_L_BM 6144
#define SSD_RS_B 272
#define SSD_L_X (6144 + 128 * 272)
#define SSD_RS_X 144
#define SSD_XIMG (128 * 144)
#define SSD_RS_Y 784
template <int OFF0, int OFF1>
__device__ __forceinline__ s16x8 tr_frag(unsigned base) {
    s16x4 a, b;
    asm volatile("ds_read_b64_tr_b16 %0, %2 offset:%3\n\tds_read_b64_tr_b16 %1, %2 offset:%4\n\ts_waitcnt lgkmcnt(0)"
                 : "=&v"(a), "=&v"(b) : "v"(base), "n"(OFF0), "n"(OFF1) : "memory");
    return __builtin_shufflevector(a, b, 0, 1, 2, 3, 4, 5, 6, 7);
}
__device__ __forceinline__ unsigned lds_addr(LAS unsigned char* p) { return (unsigned)(size_t)p; }
template <int O0, int O1, int O2, int O3, int O4, int O5, int O6, int O7>
__device__ __forceinline__ void tr_read8(unsigned base, s16x4 (&v)[8]) {
    asm volatile("ds_read_b64_tr_b16 %0, %8 offset:%9\n\tds_read_b64_tr_b16 %1, %8 offset:%10\n\tds_read_b64_tr_b16 %2, %8 offset:%11\n\tds_read_b64_tr_b16 %3, %8 offset:%12\n\t"
                 "ds_read_b64_tr_b16 %4, %8 offset:%13\n\tds_read_b64_tr_b16 %5, %8 offset:%14\n\tds_read_b64_tr_b16 %6, %8 offset:%15\n\tds_read_b64_tr_b16 %7, %8 offset:%16\n\ts_waitcnt lgkmcnt(0)"
                 : "=&v"(v[0]), "=&v"(v[1]), "=&v"(v[2]), "=&v"(v[3]), "=&v"(v[4]), "=&v"(v[5]), "=&v"(v[6]), "=&v"(v[7])
                 : "v"(base), "n"(O0), "n"(O1), "n"(O2), "n"(O3), "n"(O4), "n"(O5), "n"(O6), "n"(O7) : "memory");
}
#define TRCAT(a, b) __builtin_shufflevector(a, b, 0, 1, 2, 3, 4, 5, 6, 7)


__device__ __forceinline__ void ssd_chunk_acs(LAS unsigned char* ldsb, const float* __restrict__ dtv, const float* __restrict__ a_log, int t0, int g, float* cdec_out) {
    const int w = __builtin_amdgcn_readfirstlane(threadIdx.x >> 6), lane = threadIdx.x & 63;
    if (w < 6) {
        const int head = 6 * g + w;
        const float A = -__expf(a_log[head]);
        const float v0 = dtv[(size_t)(t0 + 2 * lane) * SSD_HEADS + head], v1 = dtv[(size_t)(t0 + 2 * lane + 1) * SSD_HEADS + head];
        const float a1 = v1 * A;
        float s = v0 * A + a1;
#pragma unroll
        for (int o = 1; o < 64; o <<= 1) { const float tmp = __shfl_up(s, o); if (lane >= o) s += tmp; }
        LAS float* acs = (LAS float*)(ldsb + SSD_L_ACS) + w * 128;
        LAS float* dts = (LAS float*)(ldsb + SSD_L_DTS) + w * 128;
        acs[2 * lane] = s - a1; acs[2 * lane + 1] = s;
        dts[2 * lane] = v0; dts[2 * lane + 1] = v1;
        if (cdec_out && lane == 63) cdec_out[head] = __expf(s);
    }
}

__device__ __forceinline__ void ph_ssd_states(LAS unsigned char* ldsb, const bf16* __restrict__ xbc_b, const float* __restrict__ dtv, const float* __restrict__ a_log,
                                              bf16* __restrict__ Sbuf, float* __restrict__ cdec, const float* __restrict__ ck, const float* __restrict__ cv, float* __restrict__ out) {
    const int tid = threadIdx.x, w = __builtin_amdgcn_readfirstlane(tid >> 6), lane = tid & 63;
    const int r = lane & 31, h = lane >> 5, blk = (lane >> 4) & 1, q = (lane & 15) >> 2, pp = lane & 3;
    const int nt = w & 3, pt = w >> 2;
    for (int unit = blockIdx.x; unit < BATCH * 64 * SSD_GROUPS; unit += gridDim.x) {
        const int g = unit & 3, bc = unit >> 2;
        const int t0 = bc * 128;
        __syncthreads();
        ssd_chunk_acs(ldsb, dtv, a_log, t0, g, cdec + (size_t)bc * SSD_HEADS);
#pragma unroll
        for (int it_ = 0; it_ < 4; ++it_) { const int idx = tid + it_ * NTHR; const int row = idx >> 4, ch = idx & 15;
            const v4u v = *(const v4u*)(xbc_b + (size_t)(t0 + row) * CONV_DIM + 1536 + 128 * g + ch * 8);
            *(LAS v4u*)(ldsb + SSD_L_BM + row * SSD_RS_B + ch * 16) = v; }
        __syncthreads();
#pragma unroll
        for (int it_ = 0; it_ < 12; ++it_) { const int idx = tid + it_ * NTHR; const int hh = idx >> 10, rem = idx & 1023, row = rem >> 3, ch = rem & 7;
            const LAS float* acs = (const LAS float*)(ldsb + SSD_L_ACS) + hh * 128; const LAS float* dts = (const LAS float*)(ldsb + SSD_L_DTS) + hh * 128;
            const float wgt = dts[row] * __expf(acs[127] - acs[row]);
            float f[8]; unpack8(*(const v4u*)(xbc_b + (size_t)(t0 + row) * CONV_DIM + (6 * g + hh) * 64 + ch * 8), f);
            v4u o; o.x = pk2(f[0] * wgt, f[1] * wgt); o.y = pk2(f[2] * wgt, f[3] * wgt); o.z = pk2(f[4] * wgt, f[5] * wgt); o.w = pk2(f[6] * wgt, f[7] * wgt);
            *(LAS v4u*)(ldsb + SSD_L_X + hh * SSD_XIMG + row * SSD_RS_X + ch * 16) = o; }
        __syncthreads();
        f32x4n rider[16];
        copy_q_load(ck, cv, 12288u + (unsigned)(unit * NWAVE + w), (unsigned)lane, rider);
        const unsigned abase = lds_addr(ldsb + SSD_L_BM) + (8 * h + q) * SSD_RS_B + (32 * nt + 16 * blk + 4 * pp) * 2;
        s16x8 afr[8];
        { s16x4 av[8];
          tr_read8<0 * SSD_RS_B, 4 * SSD_RS_B, 16 * SSD_RS_B, 20 * SSD_RS_B, 32 * SSD_RS_B, 36 * SSD_RS_B, 48 * SSD_RS_B, 52 * SSD_RS_B>(abase, av);
          afr[0] = TRCAT(av[0], av[1]); afr[1] = TRCAT(av[2], av[3]); afr[2] = TRCAT(av[4], av[5]); afr[3] = TRCAT(av[6], av[7]);
          tr_read8<64 * SSD_RS_B, 68 * SSD_RS_B, 80 * SSD_RS_B, 84 * SSD_RS_B, 96 * SSD_RS_B, 100 * SSD_RS_B, 112 * SSD_RS_B, 116 * SSD_RS_B>(abase, av);
          afr[4] = TRCAT(av[0], av[1]); afr[5] = TRCAT(av[2], av[3]); afr[6] = TRCAT(av[4], av[5]); afr[7] = TRCAT(av[6], av[7]); }
#pragma unroll
        for (int hh = 0; hh < 6; ++hh) {
            const unsigned xb = lds_addr(ldsb + SSD_L_X + hh * SSD_XIMG) + (8 * h + q) * SSD_RS_X + (32 * pt + 16 * blk + 4 * pp) * 2;
            f32x16 acc;
#pragma unroll
            for (int i = 0; i < 16; ++i) acc[i] = 0.f;
            { s16x4 xv[8];
              tr_read8<0 * SSD_RS_X, 4 * SSD_RS_X, 16 * SSD_RS_X, 20 * SSD_RS_X, 32 * SSD_RS_X, 36 * SSD_RS_X, 48 * SSD_RS_X, 52 * SSD_RS_X>(xb, xv);
              acc = __builtin_amdgcn_mfma_f32_32x32x16_bf16(afr[0], TRCAT(xv[0], xv[1]), acc, 0, 0, 0);
              acc = __builtin_amdgcn_mfma_f32_32x32x16_bf16(afr[1], TRCAT(xv[2], xv[3]), acc, 0, 0, 0);
              acc = __builtin_amdgcn_mfma_f32_32x32x16_bf16(afr[2], TRCAT(xv[4], xv[5]), acc, 0, 0, 0);
              acc = __builtin_amdgcn_mfma_f32_32x32x16_bf16(afr[3], TRCAT(xv[6], xv[7]), acc, 0, 0, 0);
              tr_read8<64 * SSD_RS_X, 68 * SSD_RS_X, 80 * SSD_RS_X, 84 * SSD_RS_X, 96 * SSD_RS_X, 100 * SSD_RS_X, 112 * SSD_RS_X, 116 * SSD_RS_X>(xb, xv);
              acc = __builtin_amdgcn_mfma_f32_32x32x16_bf16(afr[4], TRCAT(xv[0], xv[1]), acc, 0, 0, 0);
              acc = __builtin_amdgcn_mfma_f32_32x32x16_bf16(afr[5], TRCAT(xv[2], xv[3]), acc, 0, 0, 0);
              acc = __builtin_amdgcn_mfma_f32_32x32x16_bf16(afr[6], TRCAT(xv[4], xv[5]), acc, 0, 0, 0);
              acc = __builtin_amdgcn_mfma_f32_32x32x16_bf16(afr[7], TRCAT(xv[6], xv[7]), acc, 0, 0, 0); }
            bf16* dst = Sbuf + ((size_t)bc * SSD_HEADS + 6 * g + hh) * 8192 + (size_t)(pt * 8 + 2 * nt) * 512 + r * 8 + 4 * h;
#pragma unroll
            for (int q4 = 0; q4 < 4; ++q4) *(uint2*)(dst + (q4 >> 1) * 512 + (q4 & 1) * 256) = make_uint2(pk2(acc[4 * q4], acc[4 * q4 + 1]), pk2(acc[4 * q4 + 2], acc[4 * q4 + 3]));
        }
        copy_q_store(out, 12288u + (unsigned)(unit * NWAVE + w), (unsigned)lane, rider);
    }
}

__device__ __forceinline__ void ph_ssd_scan(const bf16* __restrict__ Sbuf, const float* __restrict__ cdec, bf16* __restrict__ Hin, float* __restrict__ out, int rank, int nranks) {
    for (int idx = rank * NTHR + threadIdx.x; idx < BATCH * SSD_HEADS * 1024; idx += nranks * NTHR) {
        const int i = idx & 1023, hb = idx >> 10, hd = hb % SSD_HEADS, b = hb / SSD_HEADS;
        float st[8];
#pragma unroll
        for (int j = 0; j < 8; ++j) st[j] = 0.f;
#pragma unroll 8
        for (int c = 0; c < 64; ++c) {
            const size_t base = (((size_t)(b * 64 + c)) * SSD_HEADS + hd) * 8192 + (size_t)i * 8;
            v4u o; o.x = pk2(st[0], st[1]); o.y = pk2(st[2], st[3]); o.z = pk2(st[4], st[5]); o.w = pk2(st[6], st[7]);
            *(v4u*)(Hin + base) = o;
            float s[8]; unpack8(*(const v4u*)(Sbuf + base), s);
            const float a = cdec[(size_t)(b * 64 + c) * SSD_HEADS + hd];
#pragma unroll
            for (int j = 0; j < 8; ++j) st[j] = a * st[j] + s[j];
        }
        const int ln = i & 63, ks = (i >> 6) & 7, pt = i >> 9, p = 32 * pt + (ln & 31), n0 = 16 * ks + 8 * (ln >> 5);
        store8f(out + OUT_PS + (((size_t)b * SSD_HEADS + hd) * 64 + p) * 128 + n0, st);
    }
}

__device__ __forceinline__ void ph_ssd_out(LAS unsigned char* ldsb, const bf16* __restrict__ xbc_b, const bf16* __restrict__ projb, const float* __restrict__ dtv,
                                           const float* __restrict__ a_log, const float* __restrict__ d_skip, const float* __restrict__ norm_g,
                                           const bf16* __restrict__ Hin, bf16* __restrict__ A1) {
    const int tid = threadIdx.x, w = __builtin_amdgcn_readfirstlane(tid >> 6), lane = tid & 63;
    const int r = lane & 31, h = lane >> 5, blk = (lane >> 4) & 1, q = (lane & 15) >> 2, pp = lane & 3;
    const int hs = w >> 2, lt = hs ? 3 - (w & 3) : (w & 3);
    for (int unit = blockIdx.x; unit < BATCH * 64 * SSD_GROUPS; unit += gridDim.x) {
        const int g = unit & 3, bc = unit >> 2;
        const int t0 = bc * 128;
        __syncthreads();
        ssd_chunk_acs(ldsb, dtv, a_log, t0, g, nullptr);
#pragma unroll
        for (int it_ = 0; it_ < 4; ++it_) { const int idx = tid + it_ * NTHR; const int row = idx >> 4, ch = idx & 15;
            const v4u v = *(const v4u*)(xbc_b + (size_t)(t0 + row) * CONV_DIM + 1536 + 128 * g + ch * 8);
            *(LAS v4u*)(ldsb + SSD_L_BM + row * SSD_RS_B + ch * 16) = v; }
#pragma unroll
        for (int it_ = 0; it_ < 12; ++it_) { const int idx = tid + it_ * NTHR; const int hh = idx >> 10, rem = idx & 1023, row = rem >> 3, ch = rem & 7;
            const v4u v = *(const v4u*)(xbc_b + (size_t)(t0 + row) * CONV_DIM + (6 * g + hh) * 64 + ch * 8);
            *(LAS v4u*)(ldsb + SSD_L_X + hh * SSD_XIMG + row * SSD_RS_X + ch * 16) = v; }
        __syncthreads();
        const bf16* cp = xbc_b + (size_t)(t0 + 32 * lt + r) * CONV_DIM + 2048 + 128 * g + 8 * h;
        s16x8 cfr[8];
#pragma unroll
        for (int ks = 0; ks < 8; ++ks) cfr[ks] = *(const s16x8*)(cp + 16 * ks);
        const int lcol = 32 * lt + r;
        const LAS float* acsb = (const LAS float*)(ldsb + SSD_L_ACS) + 3 * hs * 128; const LAS float* dtsb = (const LAS float*)(ldsb + SSD_L_DTS) + 3 * hs * 128;
        const unsigned xb0 = lds_addr(ldsb + SSD_L_X + 3 * hs * SSD_XIMG) + (4 * h + q) * SSD_RS_X + (16 * blk + 4 * pp) * 2;
        unsigned ypk[3][16];
#pragma unroll
        for (int h3 = 0; h3 < 3; ++h3) {
            const LAS float* acs = acsb + h3 * 128; const LAS float* dts = dtsb + h3 * 128;
            const float myacs = acs[lcol];
            const float Dh = d_skip[6 * g + 3 * hs + h3];
            f32x16 y0, y1;
#pragma unroll
            for (int i = 0; i < 16; ++i) { y0[i] = 0.f; y1[i] = 0.f; }
            { const bf16* hp = Hin + ((size_t)bc * SSD_HEADS + 6 * g + 3 * hs + h3) * 8192 + lane * 8;
#pragma unroll
              for (int kh = 0; kh < 2; ++kh) {
                  s16x8 hf0[4], hf1[4];
#pragma unroll
                  for (int ks = 0; ks < 4; ++ks) { hf0[ks] = *(const s16x8*)(hp + (4 * kh + ks) * 512); hf1[ks] = *(const s16x8*)(hp + (8 + 4 * kh + ks) * 512); }
#pragma unroll
                  for (int ks = 0; ks < 4; ++ks) { y0 = __builtin_amdgcn_mfma_f32_32x32x16_bf16(cfr[4 * kh + ks], hf0[ks], y0, 0, 0, 0); y1 = __builtin_amdgcn_mfma_f32_32x32x16_bf16(cfr[4 * kh + ks], hf1[ks], y1, 0, 0, 0); }
                  __builtin_amdgcn_sched_barrier(0);
              } }
#pragma unroll
            for (int q4 = 0; q4 < 4; ++q4) {
                const f32x4v a4 = *(const LAS f32x4v*)(acs + 32 * lt + 8 * q4 + 4 * h);
                const float e0 = __expf(a4[0]), e1 = __expf(a4[1]), e2 = __expf(a4[2]), e3 = __expf(a4[3]);
                y0[4 * q4] *= e0; y0[4 * q4 + 1] *= e1; y0[4 * q4 + 2] *= e2; y0[4 * q4 + 3] *= e3;
                y1[4 * q4] *= e0; y1[4 * q4 + 1] *= e1; y1[4 * q4 + 2] *= e2; y1[4 * q4 + 3] *= e3;
            }
            __builtin_amdgcn_sched_barrier(0);
            for (int st = 0; st <= lt; ++st) {
                f32x16 cb;
#pragma unroll
                for (int i = 0; i < 16; ++i) cb[i] = 0.f;
#pragma unroll
                for (int ks = 0; ks < 8; ++ks) {
                    const s16x8 bfrag = *(const LAS s16x8*)(ldsb + SSD_L_BM + (32 * st + r) * SSD_RS_B + (16 * ks + 8 * h) * 2);
                    cb = __builtin_amdgcn_mfma_f32_32x32x16_bf16(bfrag, cfr[ks], cb, 0, 0, 0);
                }
                __builtin_amdgcn_sched_barrier(0);
                const unsigned xb = xb0 + h3 * SSD_XIMG + st * 32 * SSD_RS_X;
                s16x4 xv[8];
                tr_read8<0, 8 * SSD_RS_X, 64, 8 * SSD_RS_X + 64, 16 * SSD_RS_X, 24 * SSD_RS_X, 16 * SSD_RS_X + 64, 24 * SSD_RS_X + 64>(xb, xv);
#pragma unroll
                for (int kk = 0; kk < 2; ++kk) {
                    const int s0 = 32 * st + 16 * kk + 4 * h;
                    const f32x4v as0 = *(const LAS f32x4v*)(acs + s0), as1 = *(const LAS f32x4v*)(acs + s0 + 8);
                    const f32x4v ds0 = *(const LAS f32x4v*)(dts + s0), ds1 = *(const LAS f32x4v*)(dts + s0 + 8);
                    float wv[8];
#pragma unroll
                    for (int j = 0; j < 8; ++j) {
                        const int s = s0 + 8 * (j >> 2) + (j & 3);
                        const float asj = (j < 4) ? as0[j & 3] : as1[j & 3], dsj = (j < 4) ? ds0[j & 3] : ds1[j & 3];
                        float v = cb[8 * kk + j] * __expf(myacs - asj) * dsj;
                        v = (s <= lcol) ? v : 0.f;
                        v = (s == lcol) ? v + Dh : v;
                        wv[j] = v;
                    }
                    s16x8 afr;
                    { v4u o; o.x = pk2(wv[0], wv[1]); o.y = pk2(wv[2], wv[3]); o.z = pk2(wv[4], wv[5]); o.w = pk2(wv[6], wv[7]); afr = __builtin_bit_cast(s16x8, o); }
                    const s16x8 b0 = kk == 0 ? TRCAT(xv[0], xv[1]) : TRCAT(xv[4], xv[5]);
                    const s16x8 b1 = kk == 0 ? TRCAT(xv[2], xv[3]) : TRCAT(xv[6], xv[7]);
                    y0 = __builtin_amdgcn_mfma_f32_32x32x16_bf16(afr, b0, y0, 0, 0, 0);
                    y1 = __builtin_amdgcn_mfma_f32_32x32x16_bf16(afr, b1, y1, 0, 0, 0);
                    __builtin_amdgcn_sched_barrier(0);
                }
            }
#pragma unroll
            for (int i = 0; i < 8; ++i) { ypk[h3][i] = pk2(y0[2 * i], y0[2 * i + 1]); ypk[h3][8 + i] = pk2(y1[2 * i], y1[2 * i + 1]); }
            __builtin_amdgcn_sched_barrier(0);
        }
        __syncthreads();
        {
            LAS unsigned short* yst = (LAS unsigned short*)(ldsb + SSD_L_X);
#pragma unroll
            for (int h3 = 0; h3 < 3; ++h3)
#pragma unroll
                for (int ptile = 0; ptile < 2; ++ptile)
#pragma unroll
                    for (int i = 0; i < 8; ++i) {
                        const int reg = 2 * i;
                        const int l0 = 32 * lt + (reg & 3) + 8 * (reg >> 2) + 4 * h;
                        const int col = (3 * hs + h3) * 64 + 32 * ptile + r;
                        const unsigned v = ypk[h3][8 * ptile + i];
                        yst[l0 * (SSD_RS_Y / 2) + col] = (unsigned short)(v & 0xffffu);
                        yst[(l0 + 1) * (SSD_RS_Y / 2) + col] = (unsigned short)(v >> 16);
                    }
        }
        __syncthreads();
#pragma unroll
        for (int pass = 0; pass < 4; ++pass) {
            const int l = 4 * (pass * 8 + w) + (lane >> 4), i16 = lane & 15;
            float gv[3][8]; float ss = 0.f;
#pragma unroll
            for (int k = 0; k < 3; ++k) {
                const int col0 = 24 * i16 + 8 * k;
                float yv[8], zv[8];
                unpack8(*(const LAS v4u*)(ldsb + SSD_L_X + l * SSD_RS_Y + col0 * 2), yv);
                unpack8(*(const v4u*)(projb + (size_t)(t0 + l) * NB_LD + g * 384 + col0), zv);
#pragma unroll
                for (int j = 0; j < 8; ++j) { const float gg = yv[j] * silu_f(zv[j]); gv[k][j] = gg; ss += gg * gg; }
            }
            ss += __shfl_xor(ss, 1); ss += __shfl_xor(ss, 2); ss += __shfl_xor(ss, 4); ss += __shfl_xor(ss, 8);
            const float rstd = rsqrtf(ss * (1.0f / 384.0f) + LN_EPS);
#pragma unroll
            for (int k = 0; k < 3; ++k) {
                const int col0 = g * 384 + 24 * i16 + 8 * k;
                const float4 g0 = *(const float4*)(norm_g + col0), g1 = *(const float4*)(norm_g + col0 + 4);
                v4u o; o.x = pk2(gv[k][0] * rstd * g0.x, gv[k][1] * rstd * g0.y); o.y = pk2(gv[k][2] * rstd * g0.z, gv[k][3] * rstd * g0.w);
                o.z = pk2(gv[k][4] * rstd * g1.x, gv[k][5] * rstd * g1.y); o.w = pk2(gv[k][6] * rstd * g1.z, gv[k][7] * rstd * g1.w);
                *(v4u*)(A1 + (size_t)(t0 + l) * MIX_WIDTH + col0) = o;
            }
        }
    }
}

#define ATT_RS_V 144
#define ATT_VIMG (256 * ATT_RS_V)
#define ATT_HIMG (2 * ATT_VIMG)
#define ATT_PVT(KT) { \
        s16x4 vv_[8]; \
        tr_read8<(32 * KT) * ATT_RS_V, (32 * KT + 8) * ATT_RS_V, (32 * KT) * ATT_RS_V + 64, (32 * KT + 8) * ATT_RS_V + 64, \
                 (32 * KT + 16) * ATT_RS_V, (32 * KT + 24) * ATT_RS_V, (32 * KT + 16) * ATT_RS_V + 64, (32 * KT + 24) * ATT_RS_V + 64>(vbase, vv_); \
        _Pragma("unroll") for (int s2_ = 0; s2_ < 2; ++s2_) { \
            v4u o_; o_.x = pk2(s[KT][8 * s2_ + 0], s[KT][8 * s2_ + 1]); o_.y = pk2(s[KT][8 * s2_ + 2], s[KT][8 * s2_ + 3]); \
            o_.z = pk2(s[KT][8 * s2_ + 4], s[KT][8 * s2_ + 5]); o_.w = pk2(s[KT][8 * s2_ + 6], s[KT][8 * s2_ + 7]); \
            const s16x8 pf_ = __builtin_bit_cast(s16x8, o_); \
            const s16x8 a0_ = s2_ == 0 ? TRCAT(vv_[0], vv_[1]) : TRCAT(vv_[4], vv_[5]); \
            const s16x8 a1_ = s2_ == 0 ? TRCAT(vv_[2], vv_[3]) : TRCAT(vv_[6], vv_[7]); \
            o0 = __builtin_amdgcn_mfma_f32_32x32x16_bf16(a0_, pf_, o0, 0, 0, 0); \
            o1 = __builtin_amdgcn_mfma_f32_32x32x16_bf16(a1_, pf_, o1, 0, 0, 0); } }
__device__ __forceinline__ void ph_attn_prompt(LAS unsigned char* ldsb, const bf16* __restrict__ qrot_b, const bf16* __restrict__ krot_b, const bf16* __restrict__ projb,
                                               bf16* __restrict__ obuf, float* __restrict__ lsebuf, const float* __restrict__ ck, const float* __restrict__ cv, float* __restrict__ out) {
    const int tid = threadIdx.x, w = __builtin_amdgcn_readfirstlane(tid >> 6), lane = tid & 63;
    const int r = lane & 31, h = lane >> 5, blk = (lane >> 4) & 1, q = (lane & 15) >> 2, pp = lane & 3;
    const int qt = w & 3, hsel = w >> 2;
    f32x4n rider[16]; bool pend = false; unsigned pq = 0u;
    for (int unit = blockIdx.x; unit < 3 * 512; unit += gridDim.x) {
        const int pat = unit >> 9, rem = unit & 511, hp = rem & 3, rem2 = rem >> 2, b = rem2 >> 6, bk = rem2 & 63;
        const int dsh = 2 * pat, nper = 64 >> dsh, res = bk >> (6 - dsh), nb = bk & (nper - 1);
        const int head = 2 * hp + hsel;
        __syncthreads();
        { v4u vst[8], kst[8];
#pragma unroll
          for (int it_ = 0; it_ < 8; ++it_) { const int idx = (tid & 255) + it_ * 256;
              const int row = idx >> 3, ch = idx & 7, js = 128 * nb - 128 + row, jc = js < 0 ? 0 : js;
              const size_t tk = (size_t)(b * SEQ + (jc << dsh) + res);
              vst[it_] = *(const v4u*)(projb + tk * NB_LD + NB_V + head * 64 + ch * 8);
              kst[it_] = *(const v4u*)(krot_b + tk * ATT_WIDTH + head * 64 + ch * 8); }
#pragma unroll
          for (int it_ = 0; it_ < 8; ++it_) { const int idx = (tid & 255) + it_ * 256;
              const int row = idx >> 3, ch = idx & 7, js = 128 * nb - 128 + row;
              v4u v = vst[it_], k = kst[it_]; if (js < 0) { v.x = 0u; v.y = 0u; v.z = 0u; v.w = 0u; k = v; }
              *(LAS v4u*)(ldsb + hsel * ATT_HIMG + row * ATT_RS_V + ch * 16) = v;
              *(LAS v4u*)(ldsb + hsel * ATT_HIMG + ATT_VIMG + row * ATT_RS_V + ch * 16) = k; } }
        const int tq = b * SEQ + ((128 * nb + 32 * qt + r) << dsh) + res;
        s16x8 qf[4];
#pragma unroll
        for (int ks = 0; ks < 4; ++ks) qf[ks] = *(const s16x8*)(qrot_b + (size_t)tq * ATT_WIDTH + head * 64 + 16 * ks + 8 * h);
        __syncthreads();
        f32x16 s[5];
#pragma unroll
        for (int kt = 0; kt < 5; ++kt) {
            const LAS unsigned char* kp = ldsb + hsel * ATT_HIMG + ATT_VIMG + (32 * qt + 32 * kt + r) * ATT_RS_V + 16 * h;
#pragma unroll
            for (int i = 0; i < 16; ++i) s[kt][i] = 0.f;
#pragma unroll
            for (int ks = 0; ks < 4; ++ks) s[kt] = __builtin_amdgcn_mfma_f32_32x32x16_bf16(*(const LAS s16x8*)(kp + 32 * ks), qf[ks], s[kt], 0, 0, 0);
        }
        if (pend) copy_q_store(out, pq, (unsigned)lane, rider);
        float m = -INFINITY;
#pragma unroll
        for (int kt = 0; kt < 5; ++kt) {
            const bool tile_ok = (nb > 0) || (qt + kt >= 4);
#pragma unroll
            for (int reg = 0; reg < 16; ++reg) {
                const int c = (reg & 3) + 8 * (reg >> 2) + 4 * h;
                const bool ok = tile_ok && (kt == 0 ? (c >= r) : (kt == 4 ? (c <= r) : true));
                const float v = ok ? s[kt][reg] * 0.125f : -INFINITY;
                s[kt][reg] = v; m = fmaxf(m, v);
            }
        }
        m = fmaxf(m, __shfl_xor(m, 32));
        float l = 0.f;
#pragma unroll
        for (int kt = 0; kt < 5; ++kt)
#pragma unroll
            for (int reg = 0; reg < 16; ++reg) { const float p = __expf(s[kt][reg] - m); s[kt][reg] = p; l += p; }
        l += __shfl_xor(l, 32);
        pq = (unsigned)(unit * NWAVE + w); copy_q_load(ck, cv, pq, (unsigned)lane, rider); pend = true;
        f32x16 o0, o1;
#pragma unroll
        for (int i = 0; i < 16; ++i) { o0[i] = 0.f; o1[i] = 0.f; }
        const unsigned vbase = lds_addr(ldsb + hsel * ATT_HIMG) + (32 * qt + 4 * h + q) * ATT_RS_V + (16 * blk + 4 * pp) * 2;
        ATT_PVT(0) ATT_PVT(1) ATT_PVT(2) ATT_PVT(3) ATT_PVT(4)
        const float inv = 1.0f / l;
        bf16* op = obuf + ((size_t)pat * T_PROMPT + tq) * ATT_WIDTH + head * 64 + 8 * h;
#pragma unroll
        for (int k2 = 0; k2 < 4; ++k2) {
            unsigned ax, ay, bx, by;
            if (k2 < 2) { ax = pk2(o0[8 * k2] * inv, o0[8 * k2 + 1] * inv); ay = pk2(o0[8 * k2 + 2] * inv, o0[8 * k2 + 3] * inv);
                          bx = pk2(o0[8 * k2 + 4] * inv, o0[8 * k2 + 5] * inv); by = pk2(o0[8 * k2 + 6] * inv, o0[8 * k2 + 7] * inv); }
            else { const int k3 = k2 - 2;
                   ax = pk2(o1[8 * k3] * inv, o1[8 * k3 + 1] * inv); ay = pk2(o1[8 * k3 + 2] * inv, o1[8 * k3 + 3] * inv);
                   bx = pk2(o1[8 * k3 + 4] * inv, o1[8 * k3 + 5] * inv); by = pk2(o1[8 * k3 + 6] * inv, o1[8 * k3 + 7] * inv); }
            const auto rx = __builtin_amdgcn_permlane32_swap(ax, bx, false, false);
            const auto ry = __builtin_amdgcn_permlane32_swap(ay, by, false, false);
            v4u o; o.x = rx[0]; o.y = ry[0]; o.z = rx[1]; o.w = ry[1];
            *(v4u*)(op + 16 * k2) = o;
        }
        if (h == 0) lsebuf[((size_t)pat * T_PROMPT + tq) * 8 + head] = m + __logf(l);
    }
    if (pend) copy_q_store(out, pq, (unsigned)lane, rider);
}
__device__ __forceinline__ void ph_attn_combine(const bf16* __restrict__ obuf, const float* __restrict__ lsebuf, bf16* __restrict__ A1) {
    const int lane = threadIdx.x & 63;
#pragma unroll 4
    for (int t = blockIdx.x * NWAVE + (threadIdx.x >> 6); t < T_PROMPT; t += gridDim.x * NWAVE) {
        const int hd = lane >> 3;
        const float l0 = lsebuf[((size_t)0 * T_PROMPT + t) * 8 + hd], l1 = lsebuf[((size_t)1 * T_PROMPT + t) * 8 + hd], l2 = lsebuf[((size_t)2 * T_PROMPT + t) * 8 + hd];
        const float mx = fmaxf(l0, fmaxf(l1, l2));
        const float e0 = __expf(l0 - mx), e1 = __expf(l1 - mx), e2 = __expf(l2 - mx);
        const float inv = 1.0f / (e0 + e1 + e2);
        float a[8], b[8], c[8];
        unpack8(*(const v4u*)(obuf + ((size_t)0 * T_PROMPT + t) * ATT_WIDTH + lane * 8), a);
        unpack8(*(const v4u*)(obuf + ((size_t)1 * T_PROMPT + t) * ATT_WIDTH + lane * 8), b);
        unpack8(*(const v4u*)(obuf + ((size_t)2 * T_PROMPT + t) * ATT_WIDTH + lane * 8), c);
        float o[8];
#pragma unroll
        for (int j = 0; j < 8; ++j) o[j] = (e0 * a[j] + e1 * b[j] + e2 * c[j]) * inv;
        v4u w; w.x = pk2(o[0], o[1]); w.y = pk2(o[2], o[3]); w.z = pk2(o[4], o[5]); w.w = pk2(o[6], o[7]);
        *(v4u*)(A1 + (size_t)t * MIX_WIDTH + SSD_WIDTH + lane * 8) = w;
    }
}

#define RT_RS 272
#define RT_KIMG (128 * RT_RS)
#define RT_LUT (2 * RT_KIMG)
constexpr unsigned char RT_CANDS[64] = {0, 1, 2, 3, 4, 5, 6, 7, 8, 9, 10, 11, 12, 13, 14, 15, 16, 17, 18, 19, 20, 21, 22, 23, 32, 33, 34, 35, 36, 48, 49, 50, 51, 64, 65, 66, 80, 81, 96, 97,
                                        112, 113, 128, 144, 160, 176, 192, 208, 224, 240, 0, 0, 0, 0, 0, 0, 0, 0, 0, 0, 0, 0, 0, 0};
__device__ __forceinline__ unsigned rt_mono(float f) { const unsigned u = __builtin_bit_cast(unsigned, f); return u ^ ((unsigned)((int)u >> 31) | 0x80000000u); }
__device__ __forceinline__ float rt_unmono(unsigned m) { const unsigned u = (m & 0x80000000u) ? (m ^ 0x80000000u) : ~m; return __builtin_bit_cast(float, u); }
#define RT_CE_DESC(a, b) { const unsigned x_ = (a), y_ = (b); (a) = x_ > y_ ? x_ : y_; (b) = x_ > y_ ? y_ : x_; }
#define RT_CE_ASC(a, b) { const unsigned x_ = (a), y_ = (b); (a) = x_ > y_ ? y_ : x_; (b) = x_ > y_ ? x_ : y_; }
__device__ __forceinline__ void rt_sort16(unsigned (&v)[16]) {
#pragma unroll
    for (int k = 2; k <= 16; k <<= 1)
#pragma unroll
        for (int j = k >> 1; j > 0; j >>= 1)
#pragma unroll
            for (int i = 0; i < 16; ++i) { const int l = i ^ j; if (l > i) { if ((i & k) == 0) RT_CE_DESC(v[i], v[l]) else RT_CE_ASC(v[i], v[l]) } }
}
__device__ __forceinline__ void rt_merge16(unsigned (&v)[16]) {
#pragma unroll
    for (int j = 8; j > 0; j >>= 1)
#pragma unroll
        for (int i = 0; i < 16; ++i) { const int l = i ^ j; if (l > i) RT_CE_DESC(v[i], v[l]) }
}
__device__ __forceinline__ void rt_top16(unsigned (&a)[16], const unsigned (&b)[16]) {
#pragma unroll
    for (int i = 0; i < 16; ++i) a[i] = a[i] > b[15 - i] ? a[i] : b[15 - i];
    rt_merge16(a);
}
__device__ __forceinline__ void rt_top16_partner(unsigned (&a)[16]) {
    unsigned b[16];
#pragma unroll
    for (int i = 0; i < 16; ++i) b[i] = (unsigned)__shfl_xor((int)a[i], 32);
    rt_top16(a, b);
}
__device__ __forceinline__ void rt_scores_top16(LAS unsigned char* kimg, const bf16* __restrict__ qp, int r, int h, unsigned (&k0)[16]) {
    f32x16 acc[4];
#pragma unroll
    for (int kt = 0; kt < 4; ++kt)
#pragma unroll
        for (int i = 0; i < 16; ++i) acc[kt][i] = 0.f;
#pragma unroll
    for (int ks = 0; ks < 8; ++ks) {
        const s16x8 qf = *(const s16x8*)(qp + 16 * ks);
#pragma unroll
        for (int kt = 0; kt < 4; ++kt) {
            const s16x8 kf = *(const LAS s16x8*)(kimg + (32 * kt + r) * RT_RS + (16 * ks + 8 * h) * 2);
            acc[kt] = __builtin_amdgcn_mfma_f32_32x32x16_bf16(kf, qf, acc[kt], 0, 0, 0);
        }
    }
    unsigned k1[16], k2[16], k3[16];
#pragma unroll
    for (int reg = 0; reg < 16; ++reg) {
        const unsigned ki = (unsigned)((reg & 3) + 8 * (reg >> 2) + 4 * h);
        k0[reg] = (rt_mono(acc[0][reg]) & 0xFFFFFF80u) | ki;
        k1[reg] = (rt_mono(acc[1][reg]) & 0xFFFFFF80u) | (ki + 32u);
        k2[reg] = (rt_mono(acc[2][reg]) & 0xFFFFFF80u) | (ki + 64u);
        k3[reg] = (rt_mono(acc[3][reg]) & 0xFFFFFF80u) | (ki + 96u);
    }
    rt_sort16(k0); rt_sort16(k1); rt_sort16(k2); rt_sort16(k3);
    rt_top16(k0, k1); rt_top16(k2, k3); rt_top16(k0, k2);
    rt_top16_partner(k0);
}
__device__ __forceinline__ void ph_peer_route2(LAS unsigned char* ldsb, const bf16* __restrict__ qhb, const float* __restrict__ keys1, const float* __restrict__ keys2,
                                               int* __restrict__ eidx, float* __restrict__ gate, const float* __restrict__ ck, const float* __restrict__ cv, float* __restrict__ out) {
    const int tid = threadIdx.x, w = __builtin_amdgcn_readfirstlane(tid >> 6), lane = tid & 63, r = lane & 31, h = lane >> 5;
    __syncthreads();
    for (int idx = tid; idx < 2 * 128 * 16; idx += NTHR) {
        const int tb = idx >> 11, rem = idx & 2047, row = rem >> 4, ch = rem & 15;
        const float* sp = (tb ? keys2 : keys1) + row * 128 + ch * 8;
        const float4 a = *(const float4*)sp, b = *(const float4*)(sp + 4);
        v4u o; o.x = pk2(a.x, a.y); o.y = pk2(a.z, a.w); o.z = pk2(b.x, b.y); o.w = pk2(b.z, b.w);
        *(LAS v4u*)(ldsb + tb * RT_KIMG + row * RT_RS + ch * 16) = o;
    }
    __syncthreads();
    LAS unsigned* lut = (LAS unsigned*)(ldsb + RT_LUT) + w * 512;
    for (int unit = blockIdx.x * NWAVE + w; unit < (T_ALL / 32) * 8; unit += gridDim.x * NWAVE) {
        const int tt = unit >> 3, hd = unit & 7;
        const int tok = 32 * tt + r;
        const bf16* qp = qhb + (size_t)tok * 2048 + hd * 256 + 8 * h;
        unsigned ka[16], kb[16];
        rt_scores_top16(ldsb, qp, r, h, ka);
        rt_scores_top16(ldsb + RT_KIMG, qp + 128, r, h, kb);
        float v1[16], v2[16];
#pragma unroll
        for (int i = 0; i < 16; ++i) { v1[i] = rt_unmono(ka[i] & 0xFFFFFF80u); v2[i] = rt_unmono(kb[i] & 0xFFFFFF80u); }
#pragma unroll
        for (int wd = 0; wd < 4; ++wd) {
            lut[wd * 64 + lane] = (ka[4 * wd] & 0x7Fu) | ((ka[4 * wd + 1] & 0x7Fu) << 8) | ((ka[4 * wd + 2] & 0x7Fu) << 16) | ((ka[4 * wd + 3] & 0x7Fu) << 24);
            lut[(4 + wd) * 64 + lane] = (kb[4 * wd] & 0x7Fu) | ((kb[4 * wd + 1] & 0x7Fu) << 8) | ((kb[4 * wd + 2] & 0x7Fu) << 16) | ((kb[4 * wd + 3] & 0x7Fu) << 24);
        }
        unsigned c0[16], c1[16];
        c0[0] = (rt_mono(h ? (v1[0] + v2[1]) : (v1[0] + v2[0])) & 0xFFFFFF00u) | (h ? 1u : 0u);
        c0[1] = (rt_mono(h ? (v1[0] + v2[3]) : (v1[0] + v2[2])) & 0xFFFFFF00u) | (h ? 3u : 2u);
        c0[2] = (rt_mono(h ? (v1[0] + v2[5]) : (v1[0] + v2[4])) & 0xFFFFFF00u) | (h ? 5u : 4u);
        c0[3] = (rt_mono(h ? (v1[0] + v2[7]) : (v1[0] + v2[6])) & 0xFFFFFF00u) | (h ? 7u : 6u);
        c0[4] = (rt_mono(h ? (v1[0] + v2[9]) : (v1[0] + v2[8])) & 0xFFFFFF00u) | (h ? 9u : 8u);
        c0[5] = (rt_mono(h ? (v1[0] + v2[11]) : (v1[0] + v2[10])) & 0xFFFFFF00u) | (h ? 11u : 10u);
        c0[6] = (rt_mono(h ? (v1[0] + v2[13]) : (v1[0] + v2[12])) & 0xFFFFFF00u) | (h ? 13u : 12u);
        c0[7] = (rt_mono(h ? (v1[0] + v2[15]) : (v1[0] + v2[14])) & 0xFFFFFF00u) | (h ? 15u : 14u);
        c0[8] = (rt_mono(h ? (v1[1] + v2[1]) : (v1[1] + v2[0])) & 0xFFFFFF00u) | (h ? 17u : 16u);
        c0[9] = (rt_mono(h ? (v1[1] + v2[3]) : (v1[1] + v2[2])) & 0xFFFFFF00u) | (h ? 19u : 18u);
        c0[10] = (rt_mono(h ? (v1[1] + v2[5]) : (v1[1] + v2[4])) & 0xFFFFFF00u) | (h ? 21u : 20u);
        c0[11] = (rt_mono(h ? (v1[1] + v2[7]) : (v1[1] + v2[6])) & 0xFFFFFF00u) | (h ? 23u : 22u);
        c0[12] = (rt_mono(h ? (v1[2] + v2[1]) : (v1[2] + v2[0])) & 0xFFFFFF00u) | (h ? 33u : 32u);
        c0[13] = (rt_mono(h ? (v1[2] + v2[3]) : (v1[2] + v2[2])) & 0xFFFFFF00u) | (h ? 35u : 34u);
        c0[14] = (rt_mono(h ? (v1[3] + v2[0]) : (v1[2] + v2[4])) & 0xFFFFFF00u) | (h ? 48u : 36u);
        c0[15] = (rt_mono(h ? (v1[3] + v2[2]) : (v1[3] + v2[1])) & 0xFFFFFF00u) | (h ? 50u : 49u);
        c1[0] = (rt_mono(h ? (v1[4] + v2[0]) : (v1[3] + v2[3])) & 0xFFFFFF00u) | (h ? 64u : 51u);
        c1[1] = (rt_mono(h ? (v1[4] + v2[2]) : (v1[4] + v2[1])) & 0xFFFFFF00u) | (h ? 66u : 65u);
        c1[2] = (rt_mono(h ? (v1[5] + v2[1]) : (v1[5] + v2[0])) & 0xFFFFFF00u) | (h ? 81u : 80u);
        c1[3] = (rt_mono(h ? (v1[6] + v2[1]) : (v1[6] + v2[0])) & 0xFFFFFF00u) | (h ? 97u : 96u);
        c1[4] = (rt_mono(h ? (v1[7] + v2[1]) : (v1[7] + v2[0])) & 0xFFFFFF00u) | (h ? 113u : 112u);
        c1[5] = (rt_mono(h ? (v1[9] + v2[0]) : (v1[8] + v2[0])) & 0xFFFFFF00u) | (h ? 144u : 128u);
        c1[6] = (rt_mono(h ? (v1[11] + v2[0]) : (v1[10] + v2[0])) & 0xFFFFFF00u) | (h ? 176u : 160u);
        c1[7] = (rt_mono(h ? (v1[13] + v2[0]) : (v1[12] + v2[0])) & 0xFFFFFF00u) | (h ? 208u : 192u);
        c1[8] = (rt_mono(h ? (v1[15] + v2[0]) : (v1[14] + v2[0])) & 0xFFFFFF00u) | (h ? 240u : 224u);
        c1[9] = 0u;
        c1[10] = 0u;
        c1[11] = 0u;
        c1[12] = 0u;
        c1[13] = 0u;
        c1[14] = 0u;
        c1[15] = 0u;
        rt_sort16(c0); rt_sort16(c1); rt_top16(c0, c1); rt_top16_partner(c0);
        float e[16]; float sum = 0.f;
        const float mx = rt_unmono(c0[0] & 0xFFFFFF00u);
#pragma unroll
        for (int k = 0; k < 16; ++k) { e[k] = __expf(rt_unmono(c0[k] & 0xFFFFFF00u) - mx); sum += e[k]; }
        const float inv = 1.0f / sum;
        asm volatile("s_waitcnt lgkmcnt(0)" ::: "memory");
        int ex[8]; float gv[8];
#pragma unroll
        for (int k = 0; k < 8; ++k) {
            const unsigned hm = (unsigned)(-h);
            const unsigned ck = (c0[k] & ~hm) | (c0[8 + k] & hm);
            const float ek = __builtin_bit_cast(float, (__builtin_bit_cast(unsigned, e[k]) & ~hm) | (__builtin_bit_cast(unsigned, e[8 + k]) & hm));
            const unsigned ci = (ck >> 4) & 15u, cj = ck & 15u;
            const unsigned w1 = lut[(ci >> 2) * 64 + lane], w2 = lut[(4 + (cj >> 2)) * 64 + lane];
            const unsigned i1 = (w1 >> (8 * (ci & 3))) & 0x7Fu, i2 = (w2 >> (8 * (cj & 3))) & 0x7Fu;
            ex[k] = (int)(i1 * PEER_NKEYS + i2); gv[k] = ek * inv;
        }
        int* ep = eidx + (size_t)tok * 128 + hd * 16 + 8 * h; float* gp = gate + (size_t)tok * 128 + hd * 16 + 8 * h;
        *(int4*)ep = make_int4(ex[0], ex[1], ex[2], ex[3]); *(int4*)(ep + 4) = make_int4(ex[4], ex[5], ex[6], ex[7]);
        *(float4*)gp = make_float4(gv[0], gv[1], gv[2], gv[3]); *(float4*)(gp + 4) = make_float4(gv[4], gv[5], gv[6], gv[7]);
    }
    { const unsigned gwv = blockIdx.x * NWAVE + w; if (gridDim.x == 256 && gwv >= 128u) cache_copy_slice(ck, cv, out, 7040u + (gwv - 128u), (unsigned)lane); }
}

struct Params {
    const float* in[23];
    float* out;
    unsigned char* ws;
    unsigned* bar;
};

#define WS_BAR      0ull
#define WS_XALL     (1ull << 20)
#define WS_PROJ     (WS_XALL + (size_t)T_ALL * D_MODEL * 4)
#define WS_XBC      (WS_PROJ + (size_t)T_ALL * PROJ_LD * 4)
#define WS_DT       (WS_XBC + (size_t)T_ALL * CONV_DIM * 4)
#define WS_QROT     (WS_DT + (size_t)T_ALL * SSD_HEADS * 4)
#define WS_KROT     (WS_QROT + (size_t)T_ALL * ATT_WIDTH * 4)
#define WS_YBUF     (WS_KROT + (size_t)T_ALL * ATT_WIDTH * 4)
#define WS_MIX      (WS_YBUF + (size_t)T_ALL * MIX_WIDTH * 4)
#define WS_HBUF     (WS_MIX + (size_t)T_ALL * D_MODEL * 4)
#define WS_QH       (WS_HBUF + (size_t)T_ALL * D_MODEL * 4)
#define WS_EIDX     (WS_QH + (size_t)T_ALL * 2048 * 4)
#define WS_GATE     (WS_EIDX + (size_t)T_ALL * 128 * 4)
#define WS_A0       (WS_GATE + (size_t)T_ALL * 128 * 4)
#define WS_A1       (WS_A0 + (size_t)T_ALL * D_MODEL * 2)
#define WS_A2       (WS_A1 + (size_t)T_ALL * MIX_WIDTH * 2)
#define WS_WTIN     (WS_A2 + (size_t)T_ALL * D_MODEL * 2)
#define WS_WTOUT    (WS_WTIN + (size_t)PROJ_LD * D_MODEL * 2)
#define WS_WTQ      (WS_WTOUT + (size_t)D_MODEL * MIX_WIDTH * 2)
#define WS_PROJB    (WS_WTQ + (size_t)2048 * D_MODEL * 2)
#define WS_DTRAW    (WS_PROJB + (size_t)T_ALL * NB_LD * 2)
#define WS_XBCB     (WS_DTRAW + (size_t)T_ALL * 32 * 4)
#define WS_QROTB    (WS_XBCB + (size_t)T_ALL * CONV_DIM * 2)
#define WS_KROTB    (WS_QROTB + (size_t)T_ALL * ATT_WIDTH * 2)
#define WS_UB       (WS_KROTB + (size_t)T_ALL * ATT_WIDTH * 2)
#define WS_VB       (WS_UB + (size_t)16384 * D_MODEL * 2)
#define WS_USC      (WS_VB + (size_t)16384 * D_MODEL * 2)
#define WS_VSC      (WS_USC + 16384 * 4)
#define WS_SBUF     (WS_VSC + 16384 * 4)
#define WS_HIN      (WS_SBUF + (size_t)BATCH * 64 * SSD_HEADS * 64 * 128 * 2)
#define WS_CDEC     (WS_HIN + (size_t)BATCH * 64 * SSD_HEADS * 64 * 128 * 2)
#define WS_OBUF     (WS_CDEC + (size_t)BATCH * 64 * SSD_HEADS * 4)
#define WS_LSE      (WS_OBUF + (size_t)3 * T_PROMPT * ATT_WIDTH * 2)
#define WS_ROPE     (WS_LSE + (size_t)3 * T_PROMPT * 8 * 4)
#define WS_END      (WS_ROPE + (size_t)SEQ * 64 * 4)

#define LDS_BYTES (160 * 1024)

#define KP const __attribute__((address_space(4))) Params* kp = (const __attribute__((address_space(4))) Params*)__builtin_amdgcn_kernarg_segment_ptr(); asm volatile("" : "+s"(kp)); unsigned char* ws = kp->ws; (void)ws;
#define IN(i) (kp->in[i])
#define WSP(T, off) ((T*)(ws + (off)))
__global__ void __launch_bounds__(512, 2) mega_fwd(Params p) {
    extern __shared__ __attribute__((aligned(16))) unsigned char smem[];
    if (threadIdx.x == 0) *(uint4*)smem = make_uint4(0u, 0u, 0u, 0u);
    __syncthreads();
    XcdBarrier bar = xcd_barrier_post(p.bar, (volatile LAS unsigned*)smem);
    float* lds = (float*)(smem + 256);
    LAS unsigned char* ldsb = (LAS unsigned char*)smem + 256;

    { KP ph_prologue(ldsb, IN(0), IN(1), WSP(bf16, WS_A0), IN(6), WSP(bf16, WS_WTIN), WSP(float, WS_ROPE)); }
    xcd_barrier(bar);
    { KP pg8::Gemm g{WSP(bf16, WS_A0), WSP(bf16, WS_WTIN), T_ALL, PROJ_LD, D_MODEL}; pg8::StaticOrder S; S.init(g.M, g.N, (int)gridDim.x, (int)blockIdx.x);
      pg8::EpiProj E{WSP(bf16, WS_PROJB), WSP(float, WS_DTRAW)}; pg8::gemm_phase<pg8::EpiProj, pg8::StaticOrder, false>(ldsb, g, S, E, nullptr); }
    xcd_barrier(bar);
    { KP ph_post_proj_prompt(WSP(bf16, WS_PROJB), WSP(float, WS_DTRAW), IN(7), IN(8), IN(9), WSP(float, WS_ROPE), WSP(bf16, WS_XBCB), WSP(float, WS_DT), WSP(bf16, WS_QROTB), WSP(bf16, WS_KROTB), kp->out); }
    { KP ph_post_proj2(WSP(bf16, WS_PROJB), WSP(float, WS_DTRAW), IN(4), IN(7), IN(8), IN(9), WSP(bf16, WS_XBCB), WSP(float, WS_DT), WSP(bf16, WS_QROTB), WSP(bf16, WS_KROTB), kp->out); }
    xcd_barrier(bar);
    { KP ph_ssd_states(ldsb, WSP(bf16, WS_XBCB), WSP(float, WS_DT), IN(10), WSP(bf16, WS_SBUF), WSP(float, WS_CDEC), IN(2), IN(3), kp->out); }
    __syncthreads();
    { KP ph_attn_prompt(ldsb, WSP(bf16, WS_QROTB), WSP(bf16, WS_KROTB), WSP(bf16, WS_PROJB), WSP(bf16, WS_OBUF), WSP(float, WS_LSE), IN(2), IN(3), kp->out); }
    __syncthreads();
    { KP ph_ssd_decode(WSP(bf16, WS_XBCB), WSP(float, WS_DT), IN(10), IN(11), IN(5), WSP(float, WS_YBUF), kp->out); }
    { KP ph_attn_sample3(lds, WSP(bf16, WS_QROTB), WSP(bf16, WS_KROTB), WSP(bf16, WS_PROJB), IN(2), IN(3), WSP(bf16, WS_A1)); }
    xcd_barrier(bar);
    if ((int)gridDim.x > 128) {
        if ((int)blockIdx.x < 96) { KP ph_ssd_scan(WSP(bf16, WS_SBUF), WSP(float, WS_CDEC), WSP(bf16, WS_HIN), kp->out, (int)blockIdx.x, 96); }
        else {
            { KP ph_prologue2(ldsb, IN(13), WSP(bf16, WS_WTOUT), IN(16), WSP(bf16, WS_WTQ), (int)blockIdx.x - 96, (int)gridDim.x - 96); }
            { KP ph_quant_tables(IN(19), IN(20), WSP(unsigned char, WS_UB), WSP(unsigned char, WS_VB), WSP(float, WS_USC), WSP(float, WS_VSC), (int)blockIdx.x - 96, (int)gridDim.x - 96); }
        }
    } else {
        { KP ph_ssd_scan(WSP(bf16, WS_SBUF), WSP(float, WS_CDEC), WSP(bf16, WS_HIN), kp->out, (int)blockIdx.x, (int)gridDim.x); }
        { KP ph_prologue2(ldsb, IN(13), WSP(bf16, WS_WTOUT), IN(16), WSP(bf16, WS_WTQ), (int)blockIdx.x, (int)gridDim.x); }
        { KP ph_quant_tables(IN(19), IN(20), WSP(unsigned char, WS_UB), WSP(unsigned char, WS_VB), WSP(float, WS_USC), WSP(float, WS_VSC), (int)blockIdx.x, (int)gridDim.x); }
    }
    xcd_barrier(bar);
    { KP ph_ssd_out(ldsb, WSP(bf16, WS_XBCB), WSP(bf16, WS_PROJB), WSP(float, WS_DT), IN(10), IN(11), IN(12), WSP(bf16, WS_HIN), WSP(bf16, WS_A1)); }
    { KP ph_attn_combine(WSP(bf16, WS_OBUF), WSP(float, WS_LSE), WSP(bf16, WS_A1)); }
    { KP ph_gate_norm(WSP(bf16, WS_PROJB), IN(12), WSP(float, WS_YBUF), WSP(bf16, WS_A1)); }
    xcd_barrier(bar);
    { KP pg8::Gemm g{WSP(bf16, WS_A1), WSP(bf16, WS_WTOUT), T_ALL, D_MODEL, MIX_WIDTH}; pg8::StaticOrder S; S.init(g.M, g.N, (int)gridDim.x, (int)blockIdx.x);
      pg8::EpiBf16Plain E{WSP(bf16, WS_MIX), D_MODEL}; pg8::gemm_phase<pg8::EpiBf16Plain, pg8::StaticOrder, false>(ldsb, g, S, E, nullptr); }
    if (blockIdx.x >= 8 && gridDim.x == 256) { KP cache_copy_slice(IN(2), IN(3), kp->out, 4096u + (blockIdx.x - 8) * 8u + (threadIdx.x >> 6), threadIdx.x & 63u); }
    xcd_barrier(bar);
    { KP ph_ln_res(IN(0), IN(1), WSP(bf16, WS_MIX), IN(14), IN(15), WSP(bf16, WS_A2)); }
    xcd_barrier(bar);
    { KP pg8::Gemm g{WSP(bf16, WS_A2), WSP(bf16, WS_WTQ), T_ALL, 2048, D_MODEL}; pg8::StaticOrder S; S.init(g.M, g.N, (int)gridDim.x, (int)blockIdx.x);
      pg8::EpiBf16Plain E{WSP(bf16, WS_QH), 2048}; pg8::gemm_phase<pg8::EpiBf16Plain, pg8::StaticOrder, false>(ldsb, g, S, E, nullptr); }
    if (blockIdx.x >= 16 && gridDim.x == 256 && threadIdx.x < 256) { KP cache_copy_slice(IN(2), IN(3), kp->out, 4096u + 1984u + (blockIdx.x - 16) * 4u + (threadIdx.x >> 6), threadIdx.x & 63u); }
    xcd_barrier(bar);
    { KP ph_peer_route2(ldsb, WSP(bf16, WS_QH), IN(17), IN(18), WSP(int, WS_EIDX), WSP(float, WS_GATE), IN(2), IN(3), kp->out); }
    xcd_barrier(bar);
    { KP ph_peer_ffn3(WSP(bf16, WS_A2), WSP(int, WS_EIDX), WSP(float, WS_GATE), WSP(unsigned char, WS_UB), WSP(unsigned char, WS_VB), WSP(float, WS_USC), WSP(float, WS_VSC), IN(21), IN(22), kp->out, IN(2), IN(3), gridDim.x == 256 ? 8960u : 4096u); }
}

extern "C" void kernel_launch(void* const* d_in, const int* in_sizes, int n_in, void* d_out, int out_size, void* d_ws, size_t ws_size, hipStream_t stream) {
    static int grid = 0;
    if (grid == 0) {
        int dev = 0, cus = 0, per_cu = 0;
        if (hipGetDevice(&dev) != hipSuccess || hipDeviceGetAttribute(&cus, hipDeviceAttributeMultiprocessorCount, dev) != hipSuccess) { fprintf(stderr, "kernel_launch: device query failed\n"); grid = -1; return; }
        if (hipFuncSetAttribute((const void*)mega_fwd, hipFuncAttributeMaxDynamicSharedMemorySize, LDS_BYTES) != hipSuccess) { fprintf(stderr, "kernel_launch: hipFuncSetAttribute failed\n"); grid = -1; return; }
        if (hipOccupancyMaxActiveBlocksPerMultiprocessor(&per_cu, (const void*)mega_fwd, NTHR, LDS_BYTES) != hipSuccess || per_cu < 1) { fprintf(stderr, "kernel_launch: occupancy query says %d\n", per_cu); }
        (void)hipGetLastError();
        grid = cus;
        if (ws_size < WS_END) { fprintf(stderr, "kernel_launch: workspace too small\n"); grid = -1; return; }
    }
    if (grid < 0) return;
    (void)hipMemsetAsync((char*)d_ws + WS_BAR, 0, XCD_BAR_WORDS * sizeof(unsigned), stream);
    Params p{};
    for (int i = 0; i < 23; ++i) p.in[i] = (const float*)d_in[i];
    p.out = (float*)d_out; p.ws = (unsigned char*)d_ws; p.bar = (unsigned*)((char*)d_ws + WS_BAR);
    hipLaunchKernelGGL(mega_fwd, dim3(grid), dim3(NTHR), LDS_BYTES, stream, p);
}
```

```cpp
#include <hip/hip_runtime.h>
#include <stdint.h>

#define D_MODEL 1024
#define BATCH 2
#define SEQ 8192
#define DEC_BATCH 128
#define DEC_SEQ 4
#define PAST_LEN 8192
#define HEAD_DIM 64
#define ATT_WIDTH 512
#define ATT_HEADS 8
#define SSD_WIDTH 1536
#define SSD_HEADS 24
#define SSD_GROUPS 4
#define SSD_STATE 128
#define CONV_DIM 2560
#define IN_WIDTH 5656
#define PROJ_LD 5888
#define MIX_WIDTH 2048
#define WBUF 2048
#define PEER_NKEYS 128
#define PEER_HEADS 8
#define PEER_TOPK 16
#define PEER_DKEY 256
#define T_PROMPT (BATCH * SEQ)
#define T_SAMPLE (DEC_BATCH * DEC_SEQ)
#define T_ALL (T_PROMPT + T_SAMPLE)
#define O_Z 0
#define O_XBC 1536
#define O_DT 4096
#define O_Q 4120
#define O_K 4632
#define O_V 5144
#define ALPHA_F 1.189207115002721f
#define LN_EPS 1e-5f

#define OUT_YP 0ull
#define OUT_YS (OUT_YP + 16777216ull)
#define OUT_PK (OUT_YS + 524288ull)
#define OUT_PV (OUT_PK + 2097152ull)
#define OUT_PC (OUT_PV + 2097152ull)
#define OUT_PS (OUT_PC + 15360ull)
#define OUT_SK (OUT_PS + 393216ull)
#define OUT_SV (OUT_SK + 134217728ull)
#define OUT_SC (OUT_SV + 134217728ull)
#define OUT_SS (OUT_SC + 983040ull)

__constant__ double ROPE_INV_REV[32] = {
    1.59154943091895346e-01, 1.19349370211248862e-01, 8.94994016088910133e-02, 6.71150830052272551e-02,
    5.03292121044870353e-02, 3.77415847174197711e-02, 2.83021958306233987e-02, 2.12236527647776604e-02,
    1.59154943091895339e-02, 1.19349370211248862e-02, 8.94994016088910237e-03, 6.71150830052272534e-03,
    5.03292121044870370e-03, 3.77415847174197719e-03, 2.83021958306233987e-03, 2.12236527647776622e-03,
    1.59154943091895356e-03, 1.19349370211248849e-03, 8.94994016088910237e-04, 6.71150830052272599e-04,
    5.03292121044870326e-04, 3.77415847174197741e-04, 2.83021958306233954e-04, 2.12236527647776605e-04,
    1.59154943091895351e-04, 1.19349370211248862e-04, 8.94994016088910182e-05, 6.71150830052272545e-05,
    5.03292121044870354e-05, 3.77415847174197768e-05, 2.83021958306233961e-05, 2.12236527647776592e-05
};

__device__ __forceinline__ float silu_f(float x) { return x * __builtin_amdgcn_rcpf(1.0f + __expf(-x)); }
__device__ __forceinline__ float softplus_f(float x) { return fmaxf(x, 0.f) + log1pf(__expf(-fabsf(x))); }
__device__ __forceinline__ float gelu_f(float x) { return 0.5f * x * (1.0f + erff(x * 0.70710678118654752f)); }
__device__ __forceinline__ float wave_sum(float v) {
#pragma unroll
    for (int o = 32; o > 0; o >>= 1) v += __shfl_xor(v, o);
    return v;
}
__device__ __forceinline__ float wave_max(float v) {
#pragma unroll
    for (int o = 32; o > 0; o >>= 1) v = fmaxf(v, __shfl_xor(v, o));
    return v;
}

#include <cstdio>
#define XB_TMO      128
#define XB_XCNT(j)  (256  + 64 * (j))
#define XB_XSUB(j)  (1280 + 64 * (j))
#define XB_XGEN(j)  (2304 + 64 * (j))
#define XB_TOP      3328
#define XB_TOPGEN   3392
#define XCD_BAR_WORDS 3456
#define XB_SPIN_CAP (1u << 18)
#define LAS __attribute__((address_space(3)))

__device__ __forceinline__ unsigned xb_ld(unsigned* p)              { return __hip_atomic_load(p, __ATOMIC_RELAXED, __HIP_MEMORY_SCOPE_AGENT); }
__device__ __forceinline__ unsigned xb_add(unsigned* p, unsigned v) { return __hip_atomic_fetch_add(p, v, __ATOMIC_RELAXED, __HIP_MEMORY_SCOPE_AGENT); }
__device__ __forceinline__ unsigned xb_xcc_id() { return (unsigned)__builtin_amdgcn_s_getreg((3 << 11) | 20) & 0xFu; }
#define XB_SPIN(cond, bar) do { unsigned _sp = 0; while (cond) { __builtin_amdgcn_s_sleep(1); \
    if ((++_sp & 255u) == 0u) { if (xb_ld(&(bar)[XB_TMO])) break; if (_sp > XB_SPIN_CAP) { atomicAdd(&(bar)[XB_TMO], 1u); break; } } } } while (0)

struct XcdBarrier {
    unsigned* bar; unsigned x;
    volatile LAS unsigned* st;
};

__device__ __forceinline__ XcdBarrier xcd_barrier_post(unsigned* bar, volatile LAS unsigned* st) {
    XcdBarrier b; b.bar = bar; b.x = xb_xcc_id(); b.st = st;
    if (threadIdx.x == 0) (void)xb_add(&bar[XB_XCNT(b.x)], 1u);
    return b;
}
__device__ __forceinline__ void xcd_barrier_complete(unsigned* bar, unsigned x, unsigned& nloc, unsigned& nx) {
    const unsigned G = gridDim.x * gridDim.y * gridDim.z;
    unsigned sum, cnt, mine, sp = 0u;
    for (;;) {
        sum = 0u; cnt = 0u; mine = 0u;
#pragma unroll
        for (unsigned j = 0; j < 16; ++j) { const unsigned c = xb_ld(&bar[XB_XCNT(j)]); sum += c; cnt += (c > 0u) ? 1u : 0u; mine = (j == x) ? c : mine; }
        if (sum == G) break;
        __builtin_amdgcn_s_sleep(1);
        if ((++sp & 255u) == 0u) { if (xb_ld(&bar[XB_TMO])) break; if (sp > XB_SPIN_CAP) { atomicAdd(&bar[XB_TMO], 1u); break; } }
    }
    nloc = mine > 0u ? mine : 1u; nx = cnt > 0u ? cnt : 1u;
}

__device__ __forceinline__ void xcd_barrier(const XcdBarrier& b) {
    asm volatile("s_waitcnt vmcnt(0)" ::: "memory");
    __syncthreads();
    if (threadIdx.x == 0) {
        unsigned* bar = b.bar;
        __builtin_amdgcn_s_waitcnt(0);
        unsigned nloc = b.st[0], nx = b.st[1];
        if (nloc == 0u) { xcd_barrier_complete(bar, b.x, nloc, nx); b.st[0] = nloc; b.st[1] = nx; }
        const unsigned old = xb_add(&bar[XB_XSUB(b.x)], 1u);
        const unsigned gen = old / nloc;
        if (old + 1u == (gen + 1u) * nloc) {
            __builtin_amdgcn_fence(__ATOMIC_RELEASE, "agent");
            asm volatile("s_waitcnt vmcnt(0)" ::: "memory");
            const unsigned og = xb_add(&bar[XB_TOP], 1u);
            const unsigned tg = og / nx;
            if (og + 1u == (tg + 1u) * nx) xb_add(&bar[XB_TOPGEN], 1u);
            else XB_SPIN(xb_ld(&bar[XB_TOPGEN]) == tg, bar);
            __builtin_amdgcn_fence(__ATOMIC_ACQUIRE, "agent");
            xb_add(&bar[XB_XGEN(b.x)], 1u);
            asm volatile("s_waitcnt vmcnt(0)" ::: "memory");
        } else {
            XB_SPIN(xb_ld(&bar[XB_XGEN(b.x)]) == gen, bar);
            __builtin_amdgcn_fence(__ATOMIC_ACQUIRE, "agent");
            asm volatile("s_waitcnt vmcnt(0)" ::: "memory");
        }
    }
    __syncthreads();
}


#define GAS __attribute__((address_space(1)))
typedef unsigned short bf16;
typedef unsigned v4u __attribute__((ext_vector_type(4)));
#define LDS_WAIT() asm volatile("s_waitcnt lgkmcnt(0)" ::: "memory")
__device__ __forceinline__ unsigned f2bf(float f) { unsigned u = __builtin_bit_cast(unsigned, f); return (u + 0x7fffu + ((u >> 16) & 1u)) >> 16; }
__device__ __forceinline__ unsigned pk2(float lo, float hi) { return f2bf(lo) | (f2bf(hi) << 16); }
__device__ __forceinline__ float bf2f(unsigned short b) { return __builtin_bit_cast(float, (unsigned)b << 16); }
#include <hip/hip_runtime.h>
namespace pg8 {
#define PG8_LAS __attribute__((address_space(3)))
typedef unsigned short bf16_t;
typedef short bf16x8 __attribute__((ext_vector_type(8)));
typedef float f32x4 __attribute__((ext_vector_type(4)));
typedef unsigned u32x4 __attribute__((ext_vector_type(4)));
constexpr int BM = 256, BK = 64, HALF = 128, HTB = HALF * BK * 2  , STAGE_BYTES = 8 * HTB, NXCD = 8, WGM = 8;

__host__ __device__ __forceinline__ int lds_byte(int r, int c) { const int st = (r >> 4) * 2 + (c >> 5), rr = r & 15, cc = c & 31, ob = rr * 64 + cc * 2; return st * 1024 + (ob ^ (((ob >> 9) & 1) << 5)); }
__host__ __device__ __forceinline__ void stage_rc(int b, int& R, int& C) { const int st = b / 1024, sb = b % 1024, swz = sb ^ (((sb >> 9) & 1) << 5); R = (st >> 1) * 16 + swz / 64; C = (st & 1) * 32 + (swz % 64) / 2; }
__host__ __device__ __forceinline__ int perm32(int rho) { const int n = rho >> 4, i = rho & 15; return 8 * (i >> 2) + 4 * n + (i & 3); }

struct Unit { int pm, pn; };
struct Gemm { const bf16_t* A; const bf16_t* Bt; int M, N, K; };

struct StaticOrder {
    int nM, nN, nwg, G, c;
    __host__ __device__ void init(int M, int N, int G_, int c_) { nM = M / BM; nN = N / BM; nwg = nM * nN; G = G_; c = c_; }
    __host__ __device__ bool next(int i, Unit& u) const {
        const long L = (long)i * G + c; if (L >= nwg) return false;
        int wgid = (int)L; { const int q = nwg / NXCD, r = nwg % NXCD, xcd = wgid % NXCD, off = wgid / NXCD; wgid = (xcd < r ? xcd * (q + 1) : r * (q + 1) + (xcd - r) * q) + off; }
        const int nig = WGM * nN, gid = wgid / nig, fm = gid * WGM, gsz = (nM - fm) < WGM ? (nM - fm) : WGM;
        u.pm = fm + ((wgid % nig) % gsz); u.pn = (wgid % nig) / gsz; return true;
    }
    __device__ __forceinline__ void a_ready(const Unit&) const {}
    __device__ __forceinline__ void done(const Unit&) const {}
};
__device__ __forceinline__ unsigned cvt_pk_bf16(float lo, float hi) { unsigned r; asm volatile("v_cvt_pk_bf16_f32 %0, %1, %2" : "=v"(r) : "v"(lo), "v"(hi)); return r; }
typedef float f32x2 __attribute__((ext_vector_type(2)));
__device__ __forceinline__ f32x2 gelu_pk(f32x2 v) {
    const f32x2 av = __builtin_elementwise_abs(v), d = av * 0.2316418882f + 1.0f;
    f32x2 t; t.x = __builtin_amdgcn_rcpf(d.x); t.y = __builtin_amdgcn_rcpf(d.y);
    f32x2 q = t * 0.5307027145f + (-0.7265760135f); q = q * t + 0.7107068705f; q = q * t + (-0.142248368f); q = q * t + 0.127414796f; q = q * t;
    const f32x2 s = (v * v) * (-0.72134752044f);
    f32x2 e; e.x = __builtin_amdgcn_exp2f(s.x); e.y = __builtin_amdgcn_exp2f(s.y);
    const f32x2 m = v * (q * e), r = v - m;
    f32x2 o; o.x = v.x < 0.f ? m.x : r.x; o.y = v.y < 0.f ? m.y : r.y; return o;
}

struct EpiF32 {
    static constexpr bool PERM = false, AFTER_DRAIN = false;
    float* C; int ldc; const float* bias;
    __device__ __forceinline__ void operator()(const f32x4 (&acc)[2][2][4][2], const Unit& u, int wr, int wc, int fr, int fq) const {
        const int row0 = u.pm * BM + wr * 64 + fr, col0 = u.pn * BM + wc * 32 + 4 * fq;
        f32x4 bv[2][2];
#pragma unroll
        for (int bj = 0; bj < 2; ++bj)
#pragma unroll
            for (int n = 0; n < 2; ++n) bv[bj][n] = bias ? *(const f32x4*)(bias + col0 + bj * HALF + n * 16) : (f32x4){0.f, 0.f, 0.f, 0.f};
#pragma unroll
        for (int ai = 0; ai < 2; ++ai)
#pragma unroll
            for (int m = 0; m < 4; ++m) { float* rowp = C + (size_t)(row0 + ai * HALF + m * 16) * ldc + col0;
#pragma unroll
                for (int bj = 0; bj < 2; ++bj)
#pragma unroll
                    for (int n = 0; n < 2; ++n) *(f32x4*)(rowp + bj * HALF + n * 16) = acc[ai][bj][m][n] + bv[bj][n]; }
    }
};

template <class Epi, class Sched, bool STAMP = false>
__device__ __forceinline__ void gemm_phase(PG8_LAS unsigned char* lds, const Gemm g, const Sched& S, const Epi& E, unsigned long long* stamps) {
    int tid = threadIdx.x; asm volatile("" : "+v"(tid));
    const int wid = __builtin_amdgcn_readfirstlane(tid >> 6), lane = tid & 63, wr = wid >> 2, wc = wid & 3, fr = lane & 15, fq = lane >> 4;
    const int K = g.K, nt = K / BK;
    int ts_lo = 0, ts_hi = 0, nts = 0; const unsigned long long rt_entry = STAMP ? (unsigned long long)wall_clock64() : 0ull;
#define PG8_STAMP() do { if (STAMP && wid == 0 && nts < 64) { const unsigned long long _c = (unsigned long long)clock64(); \
        ts_lo = (lane == nts) ? (int)(unsigned)_c : ts_lo; ts_hi = (lane == nts) ? (int)(unsigned)(_c >> 32) : ts_hi; ++nts; } } while (0)
    PG8_STAMP();
    unsigned voffA[2], voffB[2];
#pragma unroll
    for (int i = 0; i < 2; ++i) { int R, C; stage_rc(tid * 16 + i * 8192, R, C); const int Rb = Epi::PERM ? ((R & ~31) + perm32(R & 31)) : R;
        voffA[i] = (unsigned)(R * K + C) * 2u; voffB[i] = (unsigned)(Rb * K + C) * 2u; }
    const size_t kstep = (size_t)(BK * 2);
    const size_t hstep = (size_t)HALF * K * 2;
    const size_t tstep = 2 * hstep;
    const unsigned ldsw = (unsigned)wid * 1024u;
    const int aoff = lds_byte(wr * 64 + fr, fq * 8), boff = lds_byte(wc * 32 + fr, fq * 8);
#define PG8_SA(b, h) (((b) * 2 + (h)) * HTB)
#define PG8_SB(b, h) ((4 + (b) * 2 + (h)) * HTB)
#define PG8_STAGE(bufoff, gbase, voff) do { _Pragma("unroll") for (int _i = 0; _i < 2; ++_i) \
        __builtin_amdgcn_global_load_lds((const unsigned*)((const char*)(gbase) + (voff)[_i]), (PG8_LAS unsigned*)(lds + (bufoff) + ldsw + _i * 8192), 16, 0, 0); } while (0)
#define PG8_LDA(dst, b, h) do { _Pragma("unroll") for (int m = 0; m < 4; ++m) _Pragma("unroll") for (int k = 0; k < 2; ++k) dst[m][k] = *(const PG8_LAS bf16x8*)(lds + PG8_SA(b, h) + aoff + m * 2048 + k * 1024); } while (0)
#define PG8_LDB(dst, b, h) do { _Pragma("unroll") for (int n = 0; n < 2; ++n) _Pragma("unroll") for (int k = 0; k < 2; ++k) dst[n][k] = *(const PG8_LAS bf16x8*)(lds + PG8_SB(b, h) + boff + n * 2048 + k * 1024); } while (0)
#define PG8_MMA(ai, bj, At, Bt) do { __builtin_amdgcn_s_setprio(1); _Pragma("unroll") for (int m = 0; m < 4; ++m) _Pragma("unroll") for (int n = 0; n < 2; ++n) _Pragma("unroll") for (int k = 0; k < 2; ++k) \
        acc[ai][bj][m][n] = __builtin_amdgcn_mfma_f32_16x16x32_bf16(Bt[n][k], At[m][k], acc[ai][bj][m][n], 0, 0, 0); __builtin_amdgcn_s_setprio(0); } while (0)
#define PG8_WAIT_V(n) asm volatile("s_waitcnt vmcnt(" #n ")" ::: "memory")
#define PG8_WAIT_L(n) asm volatile("s_waitcnt lgkmcnt(" #n ")" ::: "memory")
#define PG8_BAR __builtin_amdgcn_s_barrier()
#define PG8_SCHED __builtin_amdgcn_sched_barrier(0)
    Unit cur, nxt; int ui = 0;
    if (!S.next(0, cur)) return;
    f32x4 acc[2][2][4][2];
#pragma unroll
    for (int a = 0; a < 2; ++a)
#pragma unroll
        for (int b = 0; b < 2; ++b)
#pragma unroll
            for (int m = 0; m < 4; ++m)
#pragma unroll
                for (int n = 0; n < 2; ++n) acc[a][b][m][n] = (f32x4){0.f, 0.f, 0.f, 0.f};
    bf16x8 At[4][2], B0[2][2], B1[2][2];
    const char* cA = (const char*)g.A + (size_t)cur.pm * tstep; const char* cB = (const char*)g.Bt + (size_t)cur.pn * tstep;
    S.a_ready(cur);
    PG8_STAGE(PG8_SB(0, 0), cB, voffB); PG8_STAGE(PG8_SA(0, 0), cA, voffA); PG8_STAGE(PG8_SB(0, 1), cB + hstep, voffB); PG8_STAGE(PG8_SA(0, 1), cA + hstep, voffA);
    if (wr == 1) PG8_BAR;
    PG8_WAIT_V(4); PG8_BAR;
    PG8_STAGE(PG8_SB(1, 0), cB + kstep, voffB); PG8_STAGE(PG8_SA(1, 0), cA + kstep, voffA); PG8_STAGE(PG8_SB(1, 1), cB + hstep + kstep, voffB);
    PG8_WAIT_V(6); PG8_BAR;
    PG8_STAMP();
    for (;;) {
        const bool has_next = S.next(ui + 1, nxt);
        const char* nA = has_next ? (const char*)g.A + (size_t)nxt.pm * tstep : cA; const char* nB = has_next ? (const char*)g.Bt + (size_t)nxt.pn * tstep : cB;
        for (int t = 0; t < nt; t += 2) {
            const bool last = (t == nt - 2);
            const char* a1 = cA + (size_t)(t + 1) * kstep;
            const char* a2 = last ? nA : cA + (size_t)(t + 2) * kstep; const char* b2 = last ? nB : cB + (size_t)(t + 2) * kstep;
            const char* a3 = a2 + kstep; const char* b3 = b2 + kstep;
            if (last && has_next) S.a_ready(nxt);
            PG8_LDB(B0, 0, 0); PG8_SCHED; PG8_LDA(At, 0, 0); PG8_STAGE(PG8_SA(1, 1), a1 + hstep, voffA);
            PG8_WAIT_L(8); PG8_BAR; PG8_WAIT_L(0); PG8_MMA(0, 0, At, B0); PG8_BAR; PG8_SCHED;
            PG8_LDB(B1, 0, 1); PG8_STAGE(PG8_SB(0, 0), b2, voffB);
            PG8_BAR; PG8_WAIT_L(0); PG8_MMA(0, 1, At, B1); PG8_BAR;
            PG8_LDA(At, 0, 1); PG8_STAGE(PG8_SA(0, 0), a2, voffA);
            PG8_BAR; PG8_WAIT_L(0); PG8_MMA(1, 0, At, B0); PG8_BAR; PG8_SCHED;
            PG8_STAGE(PG8_SB(0, 1), b2 + hstep, voffB);
            PG8_WAIT_V(6); PG8_BAR; PG8_MMA(1, 1, At, B1); PG8_BAR;
            PG8_LDB(B0, 1, 0); PG8_SCHED; PG8_LDA(At, 1, 0); PG8_STAGE(PG8_SA(0, 1), a2 + hstep, voffA);
            PG8_WAIT_L(8); PG8_BAR; PG8_WAIT_L(0); PG8_MMA(0, 0, At, B0); PG8_BAR; PG8_SCHED;
            PG8_LDB(B1, 1, 1); PG8_STAGE(PG8_SB(1, 0), b3, voffB);
            PG8_BAR; PG8_WAIT_L(0); PG8_MMA(0, 1, At, B1); PG8_BAR;
            PG8_LDA(At, 1, 1); PG8_STAGE(PG8_SA(1, 0), a3, voffA);
            PG8_BAR; PG8_WAIT_L(0); PG8_MMA(1, 0, At, B0); PG8_BAR; PG8_SCHED;
            PG8_STAGE(PG8_SB(1, 1), b3 + hstep, voffB);
            PG8_WAIT_V(6); PG8_BAR; PG8_MMA(1, 1, At, B1); PG8_BAR;
        }
        PG8_STAMP();
        if constexpr (!Epi::AFTER_DRAIN) { E(acc, cur, wr, wc, fr, fq); S.done(cur); }
        PG8_STAMP();
        if (!has_next) break;
#pragma unroll
        for (int a = 0; a < 2; ++a)
#pragma unroll
            for (int b = 0; b < 2; ++b)
#pragma unroll
                for (int m = 0; m < 4; ++m)
#pragma unroll
                    for (int n = 0; n < 2; ++n) acc[a][b][m][n] = (f32x4){0.f, 0.f, 0.f, 0.f};
        cur = nxt; cA = nA; cB = nB; ++ui;
    }
    PG8_WAIT_V(0);
    if (wr == 0) PG8_BAR;
    PG8_BAR;
    if constexpr (Epi::AFTER_DRAIN) { E.fused(acc, cur, wr, wc, fr, fq, lds, wid, lane); S.done(cur); }
    PG8_STAMP();
    if (STAMP && wid == 0) { stamps[lane] = lane < nts ? (((unsigned long long)(unsigned)ts_hi << 32) | (unsigned)ts_lo) : 0ull;
        if (lane == 62) stamps[62] = rt_entry; if (lane == 63) stamps[63] = (unsigned long long)wall_clock64(); }
#undef PG8_STAMP
#undef PG8_SA
#undef PG8_SB
#undef PG8_STAGE
#undef PG8_LDA
#undef PG8_LDB
#undef PG8_MMA
#undef PG8_WAIT_V
#undef PG8_WAIT_L
#undef PG8_BAR
#undef PG8_SCHED
}
}


namespace pg8 {
struct EpiProj {
    static constexpr bool PERM = true, AFTER_DRAIN = false;
    bf16_t* O; float* dtraw;
    __device__ __forceinline__ void operator()(const f32x4 (&acc)[2][2][4][2], const Unit& u, int wr, int wc, int fr, int fq) const {
        const int row0 = u.pm * BM + wr * 64 + fr;
        if (u.pn < 22) {
            const int col0 = u.pn * BM + wc * 32 + 8 * fq;
#pragma unroll
            for (int ai = 0; ai < 2; ++ai)
#pragma unroll
                for (int m = 0; m < 4; ++m) { bf16_t* rowp = O + (size_t)(row0 + ai * HALF + m * 16) * 5632 + col0;
#pragma unroll
                    for (int bj = 0; bj < 2; ++bj) { const f32x4 v0 = acc[ai][bj][m][0], v1 = acc[ai][bj][m][1];
                        u32x4 w; w.x = cvt_pk_bf16(v0[0], v0[1]); w.y = cvt_pk_bf16(v0[2], v0[3]); w.z = cvt_pk_bf16(v1[0], v1[1]); w.w = cvt_pk_bf16(v1[2], v1[3]);
                        *(u32x4*)(rowp + bj * HALF) = w; } }
        } else if (wc == 0) {
#pragma unroll
            for (int ai = 0; ai < 2; ++ai)
#pragma unroll
                for (int m = 0; m < 4; ++m) { float* rp = dtraw + (size_t)(row0 + ai * HALF + m * 16) * 32 + 8 * fq;
                    *(f32x4*)rp = acc[ai][0][m][0]; *(f32x4*)(rp + 4) = acc[ai][0][m][1]; }
        }
    }
};
}


namespace pg8 {
struct EpiBf16Plain {
    static constexpr bool PERM = true, AFTER_DRAIN = false;
    bf16_t* O; int ldc;
    __device__ __forceinline__ void operator()(const f32x4 (&acc)[2][2][4][2], const Unit& u, int wr, int wc, int fr, int fq) const {
        const int row0 = u.pm * BM + wr * 64 + fr, col0 = u.pn * BM + wc * 32 + 8 * fq;
#pragma unroll
        for (int ai = 0; ai < 2; ++ai)
#pragma unroll
            for (int m = 0; m < 4; ++m) { bf16_t* rowp = O + (size_t)(row0 + ai * HALF + m * 16) * ldc + col0;
#pragma unroll
                for (int bj = 0; bj < 2; ++bj) { const f32x4 v0 = acc[ai][bj][m][0], v1 = acc[ai][bj][m][1];
                    u32x4 w; w.x = cvt_pk_bf16(v0[0], v0[1]); w.y = cvt_pk_bf16(v0[2], v0[3]); w.z = cvt_pk_bf16(v1[0], v1[1]); w.w = cvt_pk_bf16(v1[2], v1[3]);
                    *(u32x4*)(rowp + bj * HALF) = w; } }
    }
};
}

#define NTHR 512
#define NWAVE 8

__device__ __forceinline__ void ph_gemm_f32(float* lds, const float* __restrict__ A, const float* __restrict__ B, float* __restrict__ C,
                                            int M, int N, int K, int lda, int ldb, int ldc) {
    const int tid = threadIdx.x & 255, half = threadIdx.x >> 8, tx = tid & 15, ty = tid >> 4;
    float (*As)[68] = (float (*)[68])(lds + half * 2 * 16 * 68);
    float (*Bs)[68] = (float (*)[68])(lds + half * 2 * 16 * 68 + 16 * 68);
    const int ntx = (N + 63) / 64, nty = M / 64, ntiles = ntx * nty;
    for (int it = blockIdx.x; 2 * it < ntiles; it += gridDim.x) {
        const int tile = 2 * it + half;
        const int m0 = (tile / ntx) * 64, n0 = (tile % ntx) * 64;
        float acc[4][4];
#pragma unroll
        for (int i = 0; i < 4; ++i)
#pragma unroll
            for (int j = 0; j < 4; ++j) acc[i][j] = 0.f;
        for (int k0 = 0; k0 < K; k0 += 16) {
#pragma unroll
            for (int i = 0; i < 4; ++i) {
                int idx = tid + i * 256;
                int r = idx >> 4, c = idx & 15;
                As[c][r] = (m0 + r < M) ? A[(size_t)(m0 + r) * lda + k0 + c] : 0.f;
                int rb = idx >> 6, cb = idx & 63;
                Bs[rb][cb] = (n0 + cb < N) ? B[(size_t)(k0 + rb) * ldb + n0 + cb] : 0.f;
            }
            __syncthreads();
#pragma unroll
            for (int k = 0; k < 16; ++k) {
                float a[4], b[4];
#pragma unroll
                for (int i = 0; i < 4; ++i) { a[i] = As[k][ty * 4 + i]; b[i] = Bs[k][tx * 4 + i]; }
#pragma unroll
                for (int i = 0; i < 4; ++i)
#pragma unroll
                    for (int j = 0; j < 4; ++j) acc[i][j] += a[i] * b[j];
            }
            __syncthreads();
        }
#pragma unroll
        for (int i = 0; i < 4; ++i)
#pragma unroll
            for (int j = 0; j < 4; ++j) {
                int r = m0 + ty * 4 + i, c = n0 + tx * 4 + j;
                if (r < M && c < N) C[(size_t)r * ldc + c] = acc[i][j];
            }
    }
}


template <int MODE>
__device__ __forceinline__ void transpose_item(const float* __restrict__ W, int K, int N, int Npad, bf16* __restrict__ WT, LAS float* scr, int item, int lane) {
    const int nblk = Npad / 32, kb = item / nblk, nb = item % nblk, k0 = 64 * kb, n0 = 32 * nb;
    const int n = n0 + (lane & 31);
    int sc = n;
    if (MODE == 1) sc = (n < 4096) ? n : (n < 5632 ? n + 24 : (n < 5656 ? n - 5632 + 4096 : -1));
    else sc = (n < N) ? n : -1;
#pragma unroll 8
    for (int i = 0; i < 32; ++i) { const int kk = 2 * i + (lane >> 5); scr[kk * 33 + (lane & 31)] = (sc >= 0) ? W[(size_t)(k0 + kk) * N + sc] : 0.f; }
    LDS_WAIT(); asm volatile("" ::: "memory");
    const int c = lane & 7;
#pragma unroll
    for (int j = 0; j < 4; ++j) { const int nn = (lane >> 3) + 8 * j; const LAS float* s = scr + (8 * c) * 33 + nn;
        v4u o; o.x = pk2(s[0 * 33], s[1 * 33]); o.y = pk2(s[2 * 33], s[3 * 33]); o.z = pk2(s[4 * 33], s[5 * 33]); o.w = pk2(s[6 * 33], s[7 * 33]);
        *(v4u*)(WT + (size_t)(n0 + nn) * K + k0 + 8 * c) = o; }
    LDS_WAIT(); asm volatile("" ::: "memory");
}
__device__ __forceinline__ void ph_prologue(LAS unsigned char* ldsb, const float* __restrict__ xp, const float* __restrict__ xs, bf16* __restrict__ A0,
                                            const float* __restrict__ w_in, bf16* __restrict__ wt_in, float* __restrict__ rope_tab) {
    const int lane = threadIdx.x & 63, wave = threadIdx.x >> 6;
    LAS float* scr = (LAS float*)(ldsb + wave * 16384);
    const int gw = blockIdx.x * NWAVE + wave, NGW = gridDim.x * NWAVE;
    constexpr int I_IN = (D_MODEL / 64) * (PROJ_LD / 32);
    for (int it = gw; it < I_IN; it += NGW) transpose_item<1>(w_in, D_MODEL, IN_WIDTH, PROJ_LD, wt_in, scr, it, lane);
    for (int idx = blockIdx.x * NTHR + threadIdx.x; idx < SEQ * 32; idx += gridDim.x * NTHR) {
        const int pos = idx >> 5, j = idx & 31;
        const double rev = (double)pos * ROPE_INV_REV[j];
        const float fr = (float)(rev - floor(rev));
        rope_tab[(size_t)pos * 64 + j] = __builtin_amdgcn_cosf(fr); rope_tab[(size_t)pos * 64 + 32 + j] = __builtin_amdgcn_sinf(fr);
    }
    const size_t n8 = (size_t)T_ALL * D_MODEL / 8, np8 = (size_t)T_PROMPT * D_MODEL / 8;
#pragma unroll 4
    for (size_t i = (size_t)blockIdx.x * NTHR + threadIdx.x; i < n8; i += (size_t)gridDim.x * NTHR) {
        const float4* s = (i < np8) ? (const float4*)xp + 2 * i : (const float4*)xs + 2 * (i - np8);
        float4 a = s[0], b = s[1];
        v4u o; o.x = pk2(a.x, a.y); o.y = pk2(a.z, a.w); o.z = pk2(b.x, b.y); o.w = pk2(b.z, b.w);
        ((v4u*)A0)[i] = o;
    }
}
__device__ __forceinline__ void ph_prologue2(LAS unsigned char* ldsb, const float* __restrict__ w_out, bf16* __restrict__ wt_out, const float* __restrict__ w_q, bf16* __restrict__ wt_q,
                                             int rank, int nranks) {
    const int lane = threadIdx.x & 63, wave = threadIdx.x >> 6;
    LAS float* scr = (LAS float*)(ldsb + wave * 16384);
    constexpr int I_OUT = (MIX_WIDTH / 64) * (D_MODEL / 32), I_Q = (D_MODEL / 64) * (2048 / 32);
    for (int it = rank * NWAVE + wave; it < I_OUT + I_Q; it += nranks * NWAVE) {
        if (it < I_OUT) transpose_item<0>(w_out, MIX_WIDTH, D_MODEL, D_MODEL, wt_out, scr, it, lane);
        else transpose_item<0>(w_q, D_MODEL, 2048, 2048, wt_q, scr, it - I_OUT, lane);
    }
}

__device__ __forceinline__ void ph_concat_x(const float* __restrict__ xp, const float* __restrict__ xs, float* __restrict__ xall) {
    const size_t n4 = (size_t)T_ALL * D_MODEL / 4, np4 = (size_t)T_PROMPT * D_MODEL / 4;
    for (size_t i = (size_t)blockIdx.x * NTHR + threadIdx.x; i < n4; i += (size_t)gridDim.x * NTHR) {
        float4 v = (i < np4) ? ((const float4*)xp)[i] : ((const float4*)xs)[i - np4];
        ((float4*)xall)[i] = v;
    }
}

typedef float f32x4n __attribute__((ext_vector_type(4)));
__device__ __forceinline__ void ph_cache_copy(const float* __restrict__ ck, const float* __restrict__ cv, float* __restrict__ out) {
    constexpr unsigned PER_B = (WBUF - DEC_SEQ) * ATT_WIDTH / 4;
    constexpr unsigned TOTAL = 2u * DEC_BATCH * PER_B;
    for (unsigned c = blockIdx.x; c < TOTAL / 4096u; c += gridDim.x) {
        f32x4n v[8]; size_t dsti[8]; bool isv[8];
#pragma unroll
        for (int j = 0; j < 8; ++j) {
            const unsigned idx = c * 4096u + j * 512u + threadIdx.x;
            const unsigned tb = idx / PER_B, r = idx - tb * PER_B, bb = tb & (DEC_BATCH - 1);
            isv[j] = tb >= DEC_BATCH;
            const size_t srci = (size_t)bb * (WBUF * ATT_WIDTH / 4) + (DEC_SEQ * ATT_WIDTH / 4) + r;
            dsti[j] = (size_t)bb * (WBUF * ATT_WIDTH / 4) + r;
            v[j] = __builtin_nontemporal_load((isv[j] ? (const f32x4n*)cv : (const f32x4n*)ck) + srci);
        }
#pragma unroll
        for (int j = 0; j < 8; ++j) __builtin_nontemporal_store(v[j], (f32x4n*)(out + (isv[j] ? OUT_SV : OUT_SK)) + dsti[j]);
    }
}

__device__ __forceinline__ void ph_post_proj(const float* __restrict__ proj, const float* __restrict__ state_conv,
                                             const float* __restrict__ conv_w, const float* __restrict__ conv_b, const float* __restrict__ dt_bias,
                                             float* __restrict__ xbc_act, float* __restrict__ dtv, float* __restrict__ qrot, float* __restrict__ krot,
                                             float* __restrict__ out) {
    const int tid = threadIdx.x & 255, half = threadIdx.x >> 8;
    for (int t = 2 * blockIdx.x + half; t < T_ALL; t += 2 * gridDim.x) {
        const bool is_p = t < T_PROMPT;
        int b, i, pos;
        if (is_p) { b = t / SEQ; i = t % SEQ; pos = i; } else { int ts = t - T_PROMPT; b = ts / DEC_SEQ; i = ts % DEC_SEQ; pos = PAST_LEN + i; }
        const float* row = proj + (size_t)t * PROJ_LD;
        for (int c = tid; c < CONV_DIM; c += 256) {
            float acc = conv_b[c];
#pragma unroll
            for (int tap = 0; tap < 4; ++tap) {
                int r = i - 3 + tap;
                float val;
                if (r >= 0) val = proj[(size_t)(t - i + r) * PROJ_LD + O_XBC + c];
                else val = is_p ? 0.f : state_conv[((size_t)b * 3 + (3 + r)) * CONV_DIM + c];
                acc += val * conv_w[tap * CONV_DIM + c];
            }
            xbc_act[(size_t)t * CONV_DIM + c] = silu_f(acc);
        }
        if (tid < SSD_HEADS) dtv[(size_t)t * SSD_HEADS + tid] = softplus_f(row[O_DT + tid] + dt_bias[tid]);
        for (int idx = tid; idx < 512; idx += 256) {
            int which = idx >> 8, h = (idx >> 5) & 7, j = idx & 31;
            double rev = (double)pos * ROPE_INV_REV[j];
            float fr = (float)(rev - floor(rev));
            float sn = __builtin_amdgcn_sinf(fr), cs = __builtin_amdgcn_cosf(fr);
            const float* src = row + (which ? O_K : O_Q) + h * 64;
            float t1 = src[j], t2 = src[j + 32];
            float o1 = t1 * cs - t2 * sn, o2 = t2 * cs + t1 * sn;
            float* dst = (which ? krot : qrot) + (size_t)t * ATT_WIDTH + h * 64;
            dst[j] = o1; dst[j + 32] = o2;
            if (which) {
                if (is_p) { if (i >= SEQ - WBUF) { float* o = out + OUT_PK + ((size_t)b * WBUF + (i - (SEQ - WBUF))) * ATT_WIDTH + h * 64; o[j] = o1; o[j + 32] = o2; } }
                else { float* o = out + OUT_SK + ((size_t)b * WBUF + (WBUF - DEC_SEQ + i)) * ATT_WIDTH + h * 64; o[j] = o1; o[j + 32] = o2; }
            }
        }
        for (int c = tid; c < ATT_WIDTH; c += 256) {
            float v = row[O_V + c];
            if (is_p) { if (i >= SEQ - WBUF) out[OUT_PV + ((size_t)b * WBUF + (i - (SEQ - WBUF))) * ATT_WIDTH + c] = v; }
            else out[OUT_SV + ((size_t)b * WBUF + (WBUF - DEC_SEQ + i)) * ATT_WIDTH + c] = v;
        }
        if (is_p) {
            if (i >= SEQ - 3) { int r = i - (SEQ - 3); for (int c = tid; c < CONV_DIM; c += 256) out[OUT_PC + ((size_t)b * 3 + r) * CONV_DIM + c] = row[O_XBC + c]; }
        } else {
            if (i >= 1) { int r = i - 1; for (int c = tid; c < CONV_DIM; c += 256) out[OUT_SC + ((size_t)b * 3 + r) * CONV_DIM + c] = row[O_XBC + c]; }
        }
    }
}


#define NB_LD 5632
#define NB_XBC 1536
#define NB_Q 4096
#define NB_K 4608
#define NB_V 5120
__device__ __forceinline__ void unpack8(const v4u w, float (&f)[8]) {
    f[0] = __builtin_bit_cast(float, w.x << 16); f[1] = __builtin_bit_cast(float, w.x & 0xffff0000u);
    f[2] = __builtin_bit_cast(float, w.y << 16); f[3] = __builtin_bit_cast(float, w.y & 0xffff0000u);
    f[4] = __builtin_bit_cast(float, w.z << 16); f[5] = __builtin_bit_cast(float, w.z & 0xffff0000u);
    f[6] = __builtin_bit_cast(float, w.w << 16); f[7] = __builtin_bit_cast(float, w.w & 0xffff0000u);
}
__device__ __forceinline__ void store8f(float* d, const float (&f)[8]) { *(float4*)d = make_float4(f[0], f[1], f[2], f[3]); *(float4*)(d + 4) = make_float4(f[4], f[5], f[6], f[7]); }
__device__ __forceinline__ void ph_post_proj2(const bf16* __restrict__ projb, const float* __restrict__ dtraw, const float* __restrict__ state_conv,
                                              const float* __restrict__ conv_w, const float* __restrict__ conv_b, const float* __restrict__ dt_bias,
                                              bf16* __restrict__ xbc_b, float* __restrict__ dtv, bf16* __restrict__ qrot_b, bf16* __restrict__ krot_b,
                                              float* __restrict__ out) {
    const int tid = threadIdx.x & 255, half = threadIdx.x >> 8;
    for (int t = T_PROMPT + 2 * blockIdx.x + half; t < T_ALL; t += 2 * gridDim.x) {
        const bool is_p = t < T_PROMPT;
        int b, i, pos;
        if (is_p) { b = t / SEQ; i = t % SEQ; pos = i; } else { int ts = t - T_PROMPT; b = ts / DEC_SEQ; i = ts % DEC_SEQ; pos = PAST_LEN + i; }
        const bf16* row = projb + (size_t)t * NB_LD;
        if (tid < 64) {
            float f[8]; unpack8(*(const v4u*)(row + NB_V + tid * 8), f);
            if (is_p) { if (i >= SEQ - WBUF) store8f(out + OUT_PV + ((size_t)b * WBUF + (i - (SEQ - WBUF))) * ATT_WIDTH + tid * 8, f); }
            else store8f(out + OUT_SV + ((size_t)b * WBUF + (WBUF - DEC_SEQ + i)) * ATT_WIDTH + tid * 8, f);
        }
        for (int c8 = tid; c8 < 320; c8 += 256) {
            const int c = c8 * 8;
            float acc[8], cur[8];
            { const float4 b0 = *(const float4*)(conv_b + c), b1 = *(const float4*)(conv_b + c + 4);
              acc[0] = b0.x; acc[1] = b0.y; acc[2] = b0.z; acc[3] = b0.w; acc[4] = b1.x; acc[5] = b1.y; acc[6] = b1.z; acc[7] = b1.w; }
#pragma unroll
            for (int tap = 0; tap < 4; ++tap) {
                const int r = i - 3 + tap;
                float val[8];
                if (r >= 0) unpack8(*(const v4u*)(projb + (size_t)(t - i + r) * NB_LD + NB_XBC + c), val);
                else if (!is_p) { const float* sp = state_conv + ((size_t)b * 3 + (3 + r)) * CONV_DIM + c; const float4 s0 = *(const float4*)sp, s1 = *(const float4*)(sp + 4);
                    val[0] = s0.x; val[1] = s0.y; val[2] = s0.z; val[3] = s0.w; val[4] = s1.x; val[5] = s1.y; val[6] = s1.z; val[7] = s1.w; }
                else {
#pragma unroll
                    for (int j = 0; j < 8; ++j) val[j] = 0.f; }
                const float4 w0 = *(const float4*)(conv_w + tap * CONV_DIM + c), w1 = *(const float4*)(conv_w + tap * CONV_DIM + c + 4);
                acc[0] += val[0] * w0.x; acc[1] += val[1] * w0.y; acc[2] += val[2] * w0.z; acc[3] += val[3] * w0.w;
                acc[4] += val[4] * w1.x; acc[5] += val[5] * w1.y; acc[6] += val[6] * w1.z; acc[7] += val[7] * w1.w;
                if (tap == 3) {
#pragma unroll
                    for (int j = 0; j < 8; ++j) cur[j] = val[j]; }
            }
#pragma unroll
            for (int j = 0; j < 8; ++j) acc[j] = silu_f(acc[j]);
            v4u o; o.x = pk2(acc[0], acc[1]); o.y = pk2(acc[2], acc[3]); o.z = pk2(acc[4], acc[5]); o.w = pk2(acc[6], acc[7]);
            *(v4u*)(xbc_b + (size_t)t * CONV_DIM + c) = o;
            if (is_p) { if (i >= SEQ - 3) store8f(out + OUT_PC + ((size_t)b * 3 + (i - (SEQ - 3))) * CONV_DIM + c, cur); }
            else { if (i >= 1) store8f(out + OUT_SC + ((size_t)b * 3 + (i - 1)) * CONV_DIM + c, cur); }
        }
        if (tid < SSD_HEADS) dtv[(size_t)t * SSD_HEADS + tid] = softplus_f(dtraw[(size_t)t * 32 + tid] + dt_bias[tid]);
        if (tid < 128) {
            const int which = tid >> 6, h = (tid >> 3) & 7, jc = tid & 7;
            const bf16* src = row + (which ? NB_K : NB_Q) + h * 64 + jc * 4;
            const uint2 lo = *(const uint2*)src, hi = *(const uint2*)(src + 32);
            float t1[4], t2[4], o1[4], o2[4];
            t1[0] = __builtin_bit_cast(float, lo.x << 16); t1[1] = __builtin_bit_cast(float, lo.x & 0xffff0000u); t1[2] = __builtin_bit_cast(float, lo.y << 16); t1[3] = __builtin_bit_cast(float, lo.y & 0xffff0000u);
            t2[0] = __builtin_bit_cast(float, hi.x << 16); t2[1] = __builtin_bit_cast(float, hi.x & 0xffff0000u); t2[2] = __builtin_bit_cast(float, hi.y << 16); t2[3] = __builtin_bit_cast(float, hi.y & 0xffff0000u);
#pragma unroll
            for (int e = 0; e < 4; ++e) {
                const double rev = (double)pos * ROPE_INV_REV[jc * 4 + e];
                const float fr = (float)(rev - floor(rev));
                const float sn = __builtin_amdgcn_sinf(fr), cs = __builtin_amdgcn_cosf(fr);
                o1[e] = t1[e] * cs - t2[e] * sn; o2[e] = t2[e] * cs + t1[e] * sn;
            }
            const size_t doff = (size_t)t * ATT_WIDTH + h * 64 + jc * 4;
            bf16* db = which ? krot_b : qrot_b;
            *(uint2*)(db + doff) = make_uint2(pk2(o1[0], o1[1]), pk2(o1[2], o1[3])); *(uint2*)(db + doff + 32) = make_uint2(pk2(o2[0], o2[1]), pk2(o2[2], o2[3]));
            if (which) {
                float* o = nullptr;
                if (is_p) { if (i >= SEQ - WBUF) o = out + OUT_PK + ((size_t)b * WBUF + (i - (SEQ - WBUF))) * ATT_WIDTH + h * 64 + jc * 4; }
                else o = out + OUT_SK + ((size_t)b * WBUF + (WBUF - DEC_SEQ + i)) * ATT_WIDTH + h * 64 + jc * 4;
                if (o) { *(float4*)o = make_float4(o1[0], o1[1], o1[2], o1[3]); *(float4*)(o + 32) = make_float4(o2[0], o2[1], o2[2], o2[3]); }
            }
        }
    }
}


__device__ __forceinline__ void ph_post_proj_prompt(const bf16* __restrict__ projb, const float* __restrict__ dtraw, const float* __restrict__ conv_w, const float* __restrict__ conv_b,
                                                    const float* __restrict__ dt_bias, const float* __restrict__ rope_tab, bf16* __restrict__ xbc_b, float* __restrict__ dtv,
                                                    bf16* __restrict__ qrot_b, bf16* __restrict__ krot_b, float* __restrict__ out) {
    const int gtid = blockIdx.x * NTHR + threadIdx.x, gsz = gridDim.x * NTHR;
    for (int item = gtid; item < (T_PROMPT / 16) * 320; item += gsz) {
        const int run = item / 320, c = (item - run * 320) * 8, t0 = run * 16, i0 = t0 & (SEQ - 1), b = t0 >> 13;
        float w[4][8], bias[8];
#pragma unroll
        for (int tap = 0; tap < 4; ++tap) { const float4 w0 = *(const float4*)(conv_w + tap * CONV_DIM + c), w1 = *(const float4*)(conv_w + tap * CONV_DIM + c + 4);
            w[tap][0] = w0.x; w[tap][1] = w0.y; w[tap][2] = w0.z; w[tap][3] = w0.w; w[tap][4] = w1.x; w[tap][5] = w1.y; w[tap][6] = w1.z; w[tap][7] = w1.w; }
        { const float4 b0 = *(const float4*)(conv_b + c), b1 = *(const float4*)(conv_b + c + 4);
          bias[0] = b0.x; bias[1] = b0.y; bias[2] = b0.z; bias[3] = b0.w; bias[4] = b1.x; bias[5] = b1.y; bias[6] = b1.z; bias[7] = b1.w; }
        const bf16* src = projb + (size_t)t0 * NB_LD + NB_XBC + c;
        v4u raw[19];
#pragma unroll
        for (int s = 0; s < 19; ++s) { v4u z; z.x = 0u; z.y = 0u; z.z = 0u; z.w = 0u; raw[s] = (s >= 3 || i0 != 0) ? *(const v4u*)(src + (ptrdiff_t)(s - 3) * NB_LD) : z; }
        float p0[8], p1[8], p2[8];
        unpack8(raw[0], p0); unpack8(raw[1], p1); unpack8(raw[2], p2);
#pragma unroll
        for (int s = 0; s < 16; ++s) {
            float cur[8], acc[8]; unpack8(raw[s + 3], cur);
#pragma unroll
            for (int j = 0; j < 8; ++j) acc[j] = silu_f(bias[j] + p0[j] * w[0][j] + p1[j] * w[1][j] + p2[j] * w[2][j] + cur[j] * w[3][j]);
            v4u o; o.x = pk2(acc[0], acc[1]); o.y = pk2(acc[2], acc[3]); o.z = pk2(acc[4], acc[5]); o.w = pk2(acc[6], acc[7]);
            *(v4u*)(xbc_b + (size_t)(t0 + s) * CONV_DIM + c) = o;
            if (i0 + s >= SEQ - 3) store8f(out + OUT_PC + ((size_t)b * 3 + (i0 + s - (SEQ - 3))) * CONV_DIM + c, cur);
#pragma unroll
            for (int j = 0; j < 8; ++j) { p0[j] = p1[j]; p1[j] = p2[j]; p2[j] = cur[j]; }
        }
    }
#pragma unroll 4
    for (int item = gtid; item < T_PROMPT * 128; item += gsz) {
        const int t = item >> 7, sub = item & 127, which = sub >> 6, h = (sub >> 3) & 7, jc = sub & 7, i = t & (SEQ - 1), b = t >> 13;
        const bf16* src = projb + (size_t)t * NB_LD + (which ? NB_K : NB_Q) + h * 64 + jc * 4;
        const uint2 lo = *(const uint2*)src, hi = *(const uint2*)(src + 32);
        const float4 cs = *(const float4*)(rope_tab + (size_t)i * 64 + jc * 4), sn = *(const float4*)(rope_tab + (size_t)i * 64 + 32 + jc * 4);
        float t1[4], t2[4], o1[4], o2[4];
        t1[0] = __builtin_bit_cast(float, lo.x << 16); t1[1] = __builtin_bit_cast(float, lo.x & 0xffff0000u); t1[2] = __builtin_bit_cast(float, lo.y << 16); t1[3] = __builtin_bit_cast(float, lo.y & 0xffff0000u);
        t2[0] = __builtin_bit_cast(float, hi.x << 16); t2[1] = __builtin_bit_cast(float, hi.x & 0xffff0000u); t2[2] = __builtin_bit_cast(float, hi.y << 16); t2[3] = __builtin_bit_cast(float, hi.y & 0xffff0000u);
        const float cv[4] = {cs.x, cs.y, cs.z, cs.w}, sv[4] = {sn.x, sn.y, sn.z, sn.w};
#pragma unroll
        for (int e = 0; e < 4; ++e) { o1[e] = t1[e] * cv[e] - t2[e] * sv[e]; o2[e] = t2[e] * cv[e] + t1[e] * sv[e]; }
        const size_t doff = (size_t)t * ATT_WIDTH + h * 64 + jc * 4;
        bf16* db = which ? krot_b : qrot_b;
        *(uint2*)(db + doff) = make_uint2(pk2(o1[0], o1[1]), pk2(o1[2], o1[3])); *(uint2*)(db + doff + 32) = make_uint2(pk2(o2[0], o2[1]), pk2(o2[2], o2[3]));
        if (which && i >= SEQ - WBUF) {
            float* o = out + OUT_PK + ((size_t)b * WBUF + (i - (SEQ - WBUF))) * ATT_WIDTH + h * 64 + jc * 4;
            *(float4*)o = make_float4(o1[0], o1[1], o1[2], o1[3]); *(float4*)(o + 32) = make_float4(o2[0], o2[1], o2[2], o2[3]);
        }
    }
#pragma unroll 4
    for (int item = gtid; item < T_PROMPT * SSD_HEADS; item += gsz) { const int t = item / SSD_HEADS, hd = item - t * SSD_HEADS; dtv[item] = softplus_f(dtraw[(size_t)t * 32 + hd] + dt_bias[hd]); }
#pragma unroll 2
    for (int item = gtid; item < BATCH * WBUF * 64; item += gsz) {
        const int ch = item & 63, j = (item >> 6) & (WBUF - 1), b = item >> 17;
        float f[8]; unpack8(*(const v4u*)(projb + (size_t)(b * SEQ + (SEQ - WBUF) + j) * NB_LD + NB_V + ch * 8), f);
        store8f(out + OUT_PV + ((size_t)b * WBUF + j) * ATT_WIDTH + ch * 8, f);
    }
}

#define SSD_CH 32
__device__ __forceinline__ void ph_ssd_naive(float* lds, const bf16* __restrict__ xbc_act, const float* __restrict__ dtv, const float* __restrict__ a_log,
                                             const float* __restrict__ d_skip, const float* __restrict__ state_ssm, float* __restrict__ ybuf, float* __restrict__ out) {
    float (*sx)[64] = (float (*)[64])lds;
    float (*sB)[128] = (float (*)[128])(lds + SSD_CH * 64);
    float (*sC)[128] = (float (*)[128])(lds + SSD_CH * 64 + SSD_CH * 128);
    float* sdt = lds + SSD_CH * 64 + 2 * SSD_CH * 128;
    const int tid = threadIdx.x, p = tid >> 3, ng = tid & 7;
    for (int vb = BATCH * SSD_HEADS + blockIdx.x; vb < (BATCH + DEC_BATCH) * SSD_HEADS; vb += gridDim.x) {
        const int seq = vb / SSD_HEADS, h = vb % SSD_HEADS, g = h / 6;
        const bool is_p = seq < BATCH;
        const int L = is_p ? SEQ : DEC_SEQ;
        const int t0 = is_p ? seq * SEQ : T_PROMPT + (seq - BATCH) * DEC_SEQ;
        const float A = -__expf(a_log[h]);
        const float D = d_skip[h];
        float hs[16];
        if (is_p) {
#pragma unroll
            for (int j = 0; j < 16; ++j) hs[j] = 0.f;
        } else {
            const float* s0 = state_ssm + (((size_t)(seq - BATCH) * SSD_HEADS + h) * 64 + p) * 128 + ng * 16;
#pragma unroll
            for (int j = 0; j < 16; ++j) hs[j] = s0[j];
        }
        for (int c0 = 0; c0 < L; c0 += SSD_CH) {
            const int nst = (L - c0) < SSD_CH ? (L - c0) : SSD_CH;
            __syncthreads();
            for (int idx = tid; idx < nst * 64; idx += NTHR) { int s = idx >> 6, c = idx & 63; sx[s][c] = bf2f(xbc_act[(size_t)(t0 + c0 + s) * CONV_DIM + h * 64 + c]); }
            for (int idx = tid; idx < nst * 128; idx += NTHR) { int s = idx >> 7, c = idx & 127;
                sB[s][c] = bf2f(xbc_act[(size_t)(t0 + c0 + s) * CONV_DIM + 1536 + g * 128 + c]);
                sC[s][c] = bf2f(xbc_act[(size_t)(t0 + c0 + s) * CONV_DIM + 2048 + g * 128 + c]); }
            if (tid < nst) sdt[tid] = dtv[(size_t)(t0 + c0 + tid) * SSD_HEADS + h];
            __syncthreads();
            for (int s = 0; s < nst; ++s) {
                const float dt = sdt[s], x = sx[s][p];
                const float a = __expf(dt * A), xdt = x * dt;
                float y = 0.f;
#pragma unroll
                for (int j = 0; j < 16; ++j) { hs[j] = a * hs[j] + xdt * sB[s][ng * 16 + j]; y += sC[s][ng * 16 + j] * hs[j]; }
                y += __shfl_xor(y, 1); y += __shfl_xor(y, 2); y += __shfl_xor(y, 4);
                if (ng == 0) ybuf[(size_t)(t0 + c0 + s) * MIX_WIDTH + h * 64 + p] = y + D * x;
            }
        }
        float* so = is_p ? out + OUT_PS + (((size_t)seq * SSD_HEADS + h) * 64 + p) * 128 + ng * 16
                         : out + OUT_SS + (((size_t)(seq - BATCH) * SSD_HEADS + h) * 64 + p) * 128 + ng * 16;
#pragma unroll
        for (int j = 0; j < 16; ++j) so[j] = hs[j];
    }
}

__device__ __forceinline__ void ph_gate_norm(const bf16* __restrict__ projb, const float* __restrict__ norm_g, const float* __restrict__ ybuf, bf16* __restrict__ A1) {
    const int w = threadIdx.x >> 6, lane = threadIdx.x & 63, g = w & 3;
    for (int t = T_PROMPT + 2 * blockIdx.x + (w >> 2); t < T_ALL; t += 2 * gridDim.x) {
        float v[6]; float ss = 0.f;
#pragma unroll
        for (int j = 0; j < 6; ++j) {
            int c = g * 384 + j * 64 + lane;
            float y = ybuf[(size_t)t * MIX_WIDTH + c], z = bf2f(projb[(size_t)t * NB_LD + c]);
            v[j] = y * silu_f(z); ss += v[j] * v[j];
        }
        ss = wave_sum(ss);
        const float r = rsqrtf(ss * (1.0f / 384.0f) + LN_EPS);
#pragma unroll
        for (int j = 0; j < 6; ++j) { int c = g * 384 + j * 64 + lane; A1[(size_t)t * MIX_WIDTH + c] = (bf16)f2bf(v[j] * r * norm_g[c]); }
    }
}

__device__ __forceinline__ void ph_attn_naive(float* lds, const float* __restrict__ proj, const float* __restrict__ qrot, const float* __restrict__ krot,
                                              const float* __restrict__ ck, const float* __restrict__ cv, float* __restrict__ ybuf) {
    float (*sq)[64] = (float (*)[64])lds;
    const int w = threadIdx.x >> 6, lane = threadIdx.x & 63;
    for (int vb = blockIdx.x; vb < T_SAMPLE * 8 / NWAVE; vb += gridDim.x) {
        const int item = T_PROMPT * 8 + vb * NWAVE + w;
        const int t = item >> 3, h = item & 7;
        const bool is_p = t < T_PROMPT;
        int b, i;
        if (is_p) { b = t / SEQ; i = t % SEQ; } else { int ts = t - T_PROMPT; b = ts / DEC_SEQ; i = ts % DEC_SEQ; }
        __syncthreads();
        sq[w][lane] = qrot[(size_t)t * ATT_WIDTH + h * 64 + lane];
        __syncthreads();
        const int qi = is_p ? i : WBUF + i;
        float sc[3][3];
        float mx = -INFINITY;
#pragma unroll
        for (int pt = 0; pt < 3; ++pt) {
            const int d = pt == 0 ? 1 : (pt == 1 ? 4 : 16);
#pragma unroll
            for (int sl = 0; sl < 3; ++sl) {
                const int m = lane + sl * 64;
                float s = -INFINITY;
                const int kj = qi - d * m;
                if (m <= 128 && kj >= 0) {
                    const float* kr;
                    if (is_p) kr = krot + (size_t)(b * SEQ + kj) * ATT_WIDTH + h * 64;
                    else kr = (kj >= WBUF) ? krot + (size_t)(T_PROMPT + b * DEC_SEQ + (kj - WBUF)) * ATT_WIDTH + h * 64
                                           : ck + ((size_t)b * WBUF + kj) * ATT_WIDTH + h * 64;
                    float a = 0.f;
#pragma unroll
                    for (int c = 0; c < 64; c += 4) { float4 kv = *(const float4*)(kr + c); a += kv.x * sq[w][c] + kv.y * sq[w][c + 1] + kv.z * sq[w][c + 2] + kv.w * sq[w][c + 3]; }
                    s = a * 0.125f;
                }
                sc[pt][sl] = s; mx = fmaxf(mx, s);
            }
        }
        mx = wave_max(mx);
        float lsum = 0.f;
#pragma unroll
        for (int pt = 0; pt < 3; ++pt)
#pragma unroll
            for (int sl = 0; sl < 3; ++sl) { float pv = (sc[pt][sl] == -INFINITY) ? 0.f : __expf(sc[pt][sl] - mx); sc[pt][sl] = pv; lsum += pv; }
        lsum = wave_sum(lsum);
        float o = 0.f;
#pragma unroll
        for (int pt = 0; pt < 3; ++pt) {
            const int d = pt == 0 ? 1 : (pt == 1 ? 4 : 16);
#pragma unroll
            for (int sl = 0; sl < 3; ++sl) {
                const int mend = sl < 2 ? 64 : 1;
                for (int ml = 0; ml < mend; ++ml) {
                    const int m = ml + sl * 64;
                    const int kj = qi - d * m;
                    const float pv = __shfl(sc[pt][sl], ml);
                    if (kj < 0) continue;
                    const float* vr;
                    if (is_p) vr = proj + (size_t)(b * SEQ + kj) * PROJ_LD + O_V + h * 64;
                    else vr = (kj >= WBUF) ? proj + (size_t)(T_PROMPT + b * DEC_SEQ + (kj - WBUF)) * PROJ_LD + O_V + h * 64
                                           : cv + ((size_t)b * WBUF + kj) * ATT_WIDTH + h * 64;
                    o += pv * vr[lane];
                }
            }
        }
        ybuf[(size_t)t * MIX_WIDTH + SSD_WIDTH + h * 64 + lane] = o / lsum;
    }
}

__device__ __forceinline__ int token_of_iter(int k) {
    const int w = __builtin_amdgcn_readfirstlane(threadIdx.x >> 6), wgl = blockIdx.x * NWAVE + w;
    if (gridDim.x != 256) { const int t = wgl + k * (int)(gridDim.x * NWAVE); return t < T_ALL ? t : -1; }
    if (k < 8) return k * 2048 + wgl;
    if (k == 8 && w < 2) return 16384 + w * 256 + (int)blockIdx.x;
    return -1;
}
__device__ __forceinline__ void ph_ln_res(const float* __restrict__ xp, const float* __restrict__ xs, const bf16* __restrict__ add, const float* __restrict__ gam,
                                          const float* __restrict__ bet, bf16* __restrict__ dstb) {
    const int lane = threadIdx.x & 63;
#pragma unroll 2
    for (int k = 0;; ++k) {
        const int t = token_of_iter(k);
        if (t < 0) break;
        const float* res = (t < T_PROMPT) ? xp + (size_t)t * D_MODEL : xs + (size_t)(t - T_PROMPT) * D_MODEL;
        float v[16]; float s = 0.f;
#pragma unroll
        for (int j = 0; j < 2; ++j) { const int c = j * 512 + lane * 8; const float4 r0 = *(const float4*)(res + c), r1 = *(const float4*)(res + c + 4);
            float a8[8]; unpack8(*(const v4u*)(add + (size_t)t * D_MODEL + c), a8);
            v[8 * j] = ALPHA_F * r0.x + a8[0]; v[8 * j + 1] = ALPHA_F * r0.y + a8[1]; v[8 * j + 2] = ALPHA_F * r0.z + a8[2]; v[8 * j + 3] = ALPHA_F * r0.w + a8[3];
            v[8 * j + 4] = ALPHA_F * r1.x + a8[4]; v[8 * j + 5] = ALPHA_F * r1.y + a8[5]; v[8 * j + 6] = ALPHA_F * r1.z + a8[6]; v[8 * j + 7] = ALPHA_F * r1.w + a8[7]; }
#pragma unroll
        for (int j = 0; j < 16; ++j) s += v[j];
        s = wave_sum(s);
        const float mu = s * (1.0f / 1024.0f);
        float q = 0.f;
#pragma unroll
        for (int j = 0; j < 16; ++j) { v[j] -= mu; q += v[j] * v[j]; }
        q = wave_sum(q);
        const float r = rsqrtf(q * (1.0f / 1024.0f) + LN_EPS);
#pragma unroll
        for (int j = 0; j < 2; ++j) { const int c = j * 512 + lane * 8; const float4 g0 = *(const float4*)(gam + c), g1 = *(const float4*)(gam + c + 4), b0 = *(const float4*)(bet + c), b1 = *(const float4*)(bet + c + 4);
            v4u o; o.x = pk2(v[8 * j] * r * g0.x + b0.x, v[8 * j + 1] * r * g0.y + b0.y); o.y = pk2(v[8 * j + 2] * r * g0.z + b0.z, v[8 * j + 3] * r * g0.w + b0.w);
            o.z = pk2(v[8 * j + 4] * r * g1.x + b1.x, v[8 * j + 5] * r * g1.y + b1.y); o.w = pk2(v[8 * j + 6] * r * g1.z + b1.z, v[8 * j + 7] * r * g1.w + b1.w);
            *(v4u*)(dstb + (size_t)t * D_MODEL + c) = o; }
    }
}

__device__ __forceinline__ void ph_peer_route(float* lds, const float* __restrict__ qh, const float* __restrict__ keys1, const float* __restrict__ keys2,
                                              int* __restrict__ eidx, float* __restrict__ gate) {
    float (*sq)[256] = (float (*)[256])lds;
    float (*sv)[2][16] = (float (*)[2][16])(lds + NWAVE * 256);
    int (*si)[2][16] = (int (*)[2][16])(lds + NWAVE * 256 + NWAVE * 32);
    const int w = threadIdx.x >> 6, lane = threadIdx.x & 63;
    for (int vb = blockIdx.x; vb < T_ALL * 8 / NWAVE; vb += gridDim.x) {
        const int item = vb * NWAVE + w;
        const int t = item >> 3, h = item & 7;
        __syncthreads();
        for (int c = lane; c < 256; c += 64) sq[w][c] = qh[(size_t)t * 2048 + h * 256 + c];
        __syncthreads();
#pragma unroll
        for (int half = 0; half < 2; ++half) {
            const float* keys = half ? keys2 : keys1;
            float s[2];
#pragma unroll
            for (int sl = 0; sl < 2; ++sl) {
                const float* kr = keys + (size_t)(lane + sl * 64) * 128;
                float a = 0.f;
#pragma unroll 8
                for (int c = 0; c < 128; c += 4) { float4 kv = *(const float4*)(kr + c); const float* qq = &sq[w][half * 128 + c]; a += kv.x * qq[0] + kv.y * qq[1] + kv.z * qq[2] + kv.w * qq[3]; }
                s[sl] = a;
            }
            for (int r = 0; r < 16; ++r) {
                float bv; int bi;
                if (s[0] >= s[1]) { bv = s[0]; bi = lane; } else { bv = s[1]; bi = lane + 64; }
#pragma unroll
                for (int o = 32; o > 0; o >>= 1) {
                    float ov = __shfl_xor(bv, o); int oi = __shfl_xor(bi, o);
                    if (ov > bv || (ov == bv && oi < bi)) { bv = ov; bi = oi; }
                }
                if (lane == 0) { sv[w][half][r] = bv; si[w][half][r] = bi; }
                if (bi == lane) s[0] = -INFINITY;
                if (bi == lane + 64) s[1] = -INFINITY;
            }
        }
        __syncthreads();
        float c[4];
#pragma unroll
        for (int j = 0; j < 4; ++j) { int ci = lane * 4 + j; c[j] = sv[w][0][ci >> 4] + sv[w][1][ci & 15]; }
        float myv = 0.f; int myc = 0;
        for (int r = 0; r < 16; ++r) {
            float bv = c[0]; int bi = lane * 4;
#pragma unroll
            for (int j = 1; j < 4; ++j) if (c[j] > bv) { bv = c[j]; bi = lane * 4 + j; }
#pragma unroll
            for (int o = 32; o > 0; o >>= 1) {
                float ov = __shfl_xor(bv, o); int oi = __shfl_xor(bi, o);
                if (ov > bv || (ov == bv && oi < bi)) { bv = ov; bi = oi; }
            }
            if (lane == r) { myv = bv; myc = bi; }
#pragma unroll
            for (int j = 0; j < 4; ++j) if (bi == lane * 4 + j) c[j] = -INFINITY;
        }
        float v = lane < 16 ? myv : -INFINITY;
        float mx = wave_max(v);
        float e = lane < 16 ? __expf(v - mx) : 0.f;
        float sum = wave_sum(e);
        if (lane < 16) {
            int ex = si[w][0][myc >> 4] * PEER_NKEYS + si[w][1][myc & 15];
            eidx[(size_t)t * 128 + h * 16 + lane] = ex;
            gate[(size_t)t * 128 + h * 16 + lane] = e / sum;
        }
    }
}

__device__ __forceinline__ void ph_peer_ffn(const float* __restrict__ hbuf, const int* __restrict__ eidx, const float* __restrict__ gate,
                                            const bf16* __restrict__ ub, const bf16* __restrict__ vb, const float* __restrict__ gam,
                                            const float* __restrict__ bet, float* __restrict__ out) {
    const int lane = threadIdx.x & 63;
    for (int t = blockIdx.x * NWAVE + (threadIdx.x >> 6); t < T_ALL; t += gridDim.x * NWAVE) {
        float x[16], acc[16];
        { const float* xr = hbuf + (size_t)t * D_MODEL + lane * 8;
          const float4 a = *(const float4*)xr, b = *(const float4*)(xr + 4), c = *(const float4*)(xr + 512), d = *(const float4*)(xr + 516);
          x[0] = a.x; x[1] = a.y; x[2] = a.z; x[3] = a.w; x[4] = b.x; x[5] = b.y; x[6] = b.z; x[7] = b.w;
          x[8] = c.x; x[9] = c.y; x[10] = c.z; x[11] = c.w; x[12] = d.x; x[13] = d.y; x[14] = d.z; x[15] = d.w; }
#pragma unroll
        for (int j = 0; j < 16; ++j) acc[j] = 0.f;
        for (int k = 0; k < 128; ++k) {
            const int e = eidx[(size_t)t * 128 + k];
            const float g = gate[(size_t)t * 128 + k];
            const bf16* ur = ub + (size_t)e * D_MODEL + lane * 8;
            float u0[8], u1[8];
            unpack8(*(const v4u*)ur, u0); unpack8(*(const v4u*)(ur + 512), u1);
            float d = 0.f;
#pragma unroll
            for (int j = 0; j < 8; ++j) d += u0[j] * x[j] + u1[j] * x[8 + j];
            d = wave_sum(d);
            const float wgt = g * gelu_f(d);
            const bf16* vr = vb + (size_t)e * D_MODEL + lane * 8;
            unpack8(*(const v4u*)vr, u0); unpack8(*(const v4u*)(vr + 512), u1);
#pragma unroll
            for (int j = 0; j < 8; ++j) { acc[j] += wgt * u0[j]; acc[8 + j] += wgt * u1[j]; }
        }
        float s = 0.f;
#pragma unroll
        for (int j = 0; j < 16; ++j) { acc[j] += ALPHA_F * x[j]; s += acc[j]; }
        s = wave_sum(s);
        const float mu = s * (1.0f / 1024.0f);
        float q = 0.f;
#pragma unroll
        for (int j = 0; j < 16; ++j) { acc[j] -= mu; q += acc[j] * acc[j]; }
        q = wave_sum(q);
        const float r = rsqrtf(q * (1.0f / 1024.0f) + LN_EPS);
        float* dst = ((t < T_PROMPT) ? out + OUT_YP + (size_t)t * D_MODEL : out + OUT_YS + (size_t)(t - T_PROMPT) * D_MODEL) + lane * 8;
#pragma unroll
        for (int q4 = 0; q4 < 4; ++q4) {
            const int eo = (q4 >> 1) * 512 + (q4 & 1) * 4;
            const float4 g4 = *(const float4*)(gam + lane * 8 + eo), b4 = *(const float4*)(bet + lane * 8 + eo);
            float4 o; o.x = acc[q4 * 4 + 0] * r * g4.x + b4.x; o.y = acc[q4 * 4 + 1] * r * g4.y + b4.y; o.z = acc[q4 * 4 + 2] * r * g4.z + b4.z; o.w = acc[q4 * 4 + 3] * r * g4.w + b4.w;
            *(float4*)(dst + eo) = o;
        }
    }
}

__device__ __forceinline__ float peer_dot16(const v4u a, const v4u b, const float (&x)[16]) {
    float u0[8], u1[8]; unpack8(a, u0); unpack8(b, u1);
    float d = 0.f;
#pragma unroll
    for (int j = 0; j < 8; ++j) d += u0[j] * x[j] + u1[j] * x[8 + j];
    return d;
}
#define PEER_TR_STEP(N, M) _Pragma("unroll") for (int i = 0; i < N; ++i) { const bool up = (lane & M) != 0; const float keep = up ? part[i + N] : part[i]; const float send = up ? part[i] : part[i + N]; part[i] = keep + __shfl_xor(send, M); }
__device__ __forceinline__ void ph_peer_ffn2(const float* __restrict__ hbuf, const int* __restrict__ eidx, const float* __restrict__ gate,
                                             const bf16* __restrict__ ub, const bf16* __restrict__ vb, const float* __restrict__ gam,
                                             const float* __restrict__ bet, float* __restrict__ out) {
    const int lane0 = threadIdx.x & 63;
    for (int t = blockIdx.x * NWAVE + (threadIdx.x >> 6); t < T_ALL; t += gridDim.x * NWAVE) {
        int lane = lane0; asm volatile("" : "+v"(lane));
        float x[16];
        { const float* xr = hbuf + (size_t)t * D_MODEL + lane * 8;
          const float4 a = *(const float4*)xr, b = *(const float4*)(xr + 4), c = *(const float4*)(xr + 512), d = *(const float4*)(xr + 516);
          x[0] = a.x; x[1] = a.y; x[2] = a.z; x[3] = a.w; x[4] = b.x; x[5] = b.y; x[6] = b.z; x[7] = b.w;
          x[8] = c.x; x[9] = c.y; x[10] = c.z; x[11] = c.w; x[12] = d.x; x[13] = d.y; x[14] = d.z; x[15] = d.w; }
        int ev[2]; float wv[4];
        ev[0] = eidx[(size_t)t * 128 + lane]; ev[1] = eidx[(size_t)t * 128 + 64 + lane];
#pragma unroll
        for (int rd = 0; rd < 4; ++rd) wv[rd] = gate[(size_t)t * 128 + rd * 32 + (lane >> 1)];
#pragma unroll
        for (int rd = 0; rd < 4; ++rd) {
            float part[32];
#pragma unroll
            for (int kb = 0; kb < 8; ++kb) {
                v4u ra[4], rb[4];
#pragma unroll
                for (int k8 = 0; k8 < 4; ++k8) {
                    const int e = __builtin_amdgcn_readlane(ev[rd >> 1], (rd & 1) * 32 + kb * 4 + k8);
                    const bf16* ur = ub + (size_t)e * D_MODEL + lane * 8;
                    ra[k8] = *(const v4u*)ur; rb[k8] = *(const v4u*)(ur + 512);
                }
#pragma unroll
                for (int k8 = 0; k8 < 4; ++k8) part[kb * 4 + k8] = peer_dot16(ra[k8], rb[k8], x);
            }
            PEER_TR_STEP(16, 32) PEER_TR_STEP(8, 16) PEER_TR_STEP(4, 8) PEER_TR_STEP(2, 4) PEER_TR_STEP(1, 2)
            const float hid = part[0] + __shfl_xor(part[0], 1);
            wv[rd] *= gelu_f(hid);
        }
        float acc[16];
#pragma unroll
        for (int j = 0; j < 16; ++j) acc[j] = 0.f;
#pragma unroll
        for (int rd = 0; rd < 4; ++rd) {
#pragma unroll
            for (int kb = 0; kb < 4; ++kb) {
                v4u ra[8], rb[8];
#pragma unroll
                for (int k8 = 0; k8 < 8; ++k8) {
                    const int e = __builtin_amdgcn_readlane(ev[rd >> 1], (rd & 1) * 32 + kb * 8 + k8);
                    const bf16* vr = vb + (size_t)e * D_MODEL + lane * 8;
                    ra[k8] = *(const v4u*)vr; rb[k8] = *(const v4u*)(vr + 512);
                }
#pragma unroll
                for (int k8 = 0; k8 < 8; ++k8) {
                    const float wk = __builtin_bit_cast(float, __builtin_amdgcn_readlane(__builtin_bit_cast(int, wv[rd]), 2 * (kb * 8 + k8)));
                    float u0[8], u1[8]; unpack8(ra[k8], u0); unpack8(rb[k8], u1);
#pragma unroll
                    for (int j = 0; j < 8; ++j) { acc[j] += wk * u0[j]; acc[8 + j] += wk * u1[j]; }
                }
            }
        }
        float s = 0.f;
#pragma unroll
        for (int j = 0; j < 16; ++j) { acc[j] += ALPHA_F * x[j]; s += acc[j]; }
        s = wave_sum(s);
        const float mu = s * (1.0f / 1024.0f);
        float q = 0.f;
#pragma unroll
        for (int j = 0; j < 16; ++j) { acc[j] -= mu; q += acc[j] * acc[j]; }
        q = wave_sum(q);
        const float r = rsqrtf(q * (1.0f / 1024.0f) + LN_EPS);
        float* dst = ((t < T_PROMPT) ? out + OUT_YP + (size_t)t * D_MODEL : out + OUT_YS + (size_t)(t - T_PROMPT) * D_MODEL) + lane * 8;
#pragma unroll
        for (int q4 = 0; q4 < 4; ++q4) {
            const int eo = (q4 >> 1) * 512 + (q4 & 1) * 4;
            const float4 g4 = *(const float4*)(gam + lane * 8 + eo), b4 = *(const float4*)(bet + lane * 8 + eo);
            float4 o; o.x = acc[q4 * 4 + 0] * r * g4.x + b4.x; o.y = acc[q4 * 4 + 1] * r * g4.y + b4.y; o.z = acc[q4 * 4 + 2] * r * g4.z + b4.z; o.w = acc[q4 * 4 + 3] * r * g4.w + b4.w;
            *(float4*)(dst + eo) = o;
        }
    }
}

__device__ __forceinline__ void ph_attn_sample(float* lds, const bf16* __restrict__ qrot_b, const bf16* __restrict__ krot_b, const bf16* __restrict__ projb,
                                               const float* __restrict__ ck, const float* __restrict__ cv, bf16* __restrict__ A1) {
    float (*sq)[64] = (float (*)[64])lds;
    const int w = threadIdx.x >> 6, lane0 = threadIdx.x & 63;
    for (int vb = blockIdx.x; vb < T_SAMPLE * 8 / NWAVE; vb += gridDim.x) {
        int lane = lane0; asm volatile("" : "+v"(lane));
        const int item = vb * NWAVE + w, ts = item >> 3, hd = item & 7, b = ts >> 2, i = ts & 3, t = T_PROMPT + ts;
        __syncthreads();
        sq[w][lane] = bf2f(qrot_b[(size_t)t * ATT_WIDTH + hd * 64 + lane]);
        __syncthreads();
        const int qi = WBUF + i;
        float sc[8];
        float mx = -INFINITY;
#pragma unroll
        for (int slot = 0; slot < 7; ++slot) {
            const int pt = slot < 6 ? (slot >> 1) : (lane < 3 ? lane : 0);
            const int m = slot < 6 ? lane + 64 * (slot & 1) : 128;
            const int kj = qi - (m << (2 * pt));
            const bool valid = (slot < 6 || lane < 3) && kj < WBUF;
            const int kc = kj < WBUF ? kj : WBUF - 1;
            const float* kr = ck + ((size_t)b * WBUF + kc) * ATT_WIDTH + hd * 64;
            float a = 0.f;
#pragma unroll
            for (int c = 0; c < 64; c += 4) { const float4 kv = *(const float4*)(kr + c); a += kv.x * sq[w][c] + kv.y * sq[w][c + 1] + kv.z * sq[w][c + 2] + kv.w * sq[w][c + 3]; }
            const float s = valid ? a * 0.125f : -INFINITY;
            sc[slot] = s; mx = fmaxf(mx, s);
        }
        const int nt7 = lane <= i ? i - lane : i;
        const bool valid7 = lane < i + 3;
        {
            const bf16* kr = krot_b + (size_t)(T_PROMPT + b * DEC_SEQ + nt7) * ATT_WIDTH + hd * 64;
            float a = 0.f;
#pragma unroll
            for (int c = 0; c < 64; c += 8) { float f[8]; unpack8(*(const v4u*)(kr + c), f);
#pragma unroll
                for (int j = 0; j < 8; ++j) a += f[j] * sq[w][c + j]; }
            const float s = valid7 ? a * 0.125f : -INFINITY;
            sc[7] = s; mx = fmaxf(mx, s);
        }
        mx = wave_max(mx);
        float lsum = 0.f;
#pragma unroll
        for (int slot = 0; slot < 8; ++slot) { const float pv = __expf(sc[slot] - mx); sc[slot] = pv; lsum += pv; }
        lsum = wave_sum(lsum);
        float part[64];
#pragma unroll
        for (int c = 0; c < 64; ++c) part[c] = 0.f;
#pragma unroll
        for (int slot = 0; slot < 7; ++slot) {
            const int pt = slot < 6 ? (slot >> 1) : (lane < 3 ? lane : 0);
            const int m = slot < 6 ? lane + 64 * (slot & 1) : 128;
            const int kj = qi - (m << (2 * pt));
            const int kc = kj < WBUF ? kj : WBUF - 1;
            const float pv = sc[slot];
            const float* vr = cv + ((size_t)b * WBUF + kc) * ATT_WIDTH + hd * 64;
#pragma unroll
            for (int c = 0; c < 64; c += 4) { const float4 vv = *(const float4*)(vr + c); part[c] += pv * vv.x; part[c + 1] += pv * vv.y; part[c + 2] += pv * vv.z; part[c + 3] += pv * vv.w; }
        }
        {
            const float pv = sc[7];
            const bf16* vr = projb + (size_t)(T_PROMPT + b * DEC_SEQ + nt7) * NB_LD + NB_V + hd * 64;
#pragma unroll
            for (int c = 0; c < 64; c += 8) { float f[8]; unpack8(*(const v4u*)(vr + c), f);
#pragma unroll
                for (int j = 0; j < 8; ++j) part[c + j] += pv * f[j]; }
        }
        PEER_TR_STEP(32, 32) PEER_TR_STEP(16, 16) PEER_TR_STEP(8, 8) PEER_TR_STEP(4, 4) PEER_TR_STEP(2, 2) PEER_TR_STEP(1, 1)
        A1[(size_t)t * MIX_WIDTH + SSD_WIDTH + hd * 64 + lane] = (bf16)f2bf(part[0] / lsum);
    }
}


__device__ __forceinline__ void cache_copy_slice(const float* __restrict__ ck, const float* __restrict__ cv, float* __restrict__ out, unsigned slice, unsigned lane) {
    constexpr unsigned PER_B = (WBUF - DEC_SEQ) * ATT_WIDTH / 4;
    constexpr unsigned TOTAL = 2u * DEC_BATCH * PER_B;
#pragma unroll 1
    for (unsigned bt = 0; bt < 8; ++bt) {
        f32x4n v[8]; size_t dsti[8]; bool isv[8]; bool ok[8];
#pragma unroll
        for (int j = 0; j < 8; ++j) {
            const unsigned idx = slice * 4096u + bt * 512u + j * 64u + lane;
            ok[j] = idx < TOTAL;
            const unsigned idc = ok[j] ? idx : 0u;
            const unsigned tb = idc / PER_B, r = idc - tb * PER_B, bb = tb & (DEC_BATCH - 1);
            isv[j] = tb >= DEC_BATCH;
            const size_t srci = (size_t)bb * (WBUF * ATT_WIDTH / 4) + (DEC_SEQ * ATT_WIDTH / 4) + r;
            dsti[j] = (size_t)bb * (WBUF * ATT_WIDTH / 4) + r;
            v[j] = __builtin_nontemporal_load((isv[j] ? (const f32x4n*)cv : (const f32x4n*)ck) + srci);
        }
#pragma unroll
        for (int j = 0; j < 8; ++j) if (ok[j]) __builtin_nontemporal_store(v[j], (f32x4n*)(out + (isv[j] ? OUT_SV : OUT_SK)) + dsti[j]);
    }
}

__device__ __forceinline__ void copy_q_load(const float* __restrict__ ck, const float* __restrict__ cv, unsigned q, unsigned lane, f32x4n (&v)[16]) {
    constexpr unsigned PER_B = (WBUF - DEC_SEQ) * ATT_WIDTH / 4, TOTAL = 2u * DEC_BATCH * PER_B;
#pragma unroll
    for (int j = 0; j < 16; ++j) {
        const unsigned idx = q * 1024u + j * 64u + lane, idc = idx < TOTAL ? idx : 0u;
        const unsigned tb = idc / PER_B, r = idc - tb * PER_B, bb = tb & (DEC_BATCH - 1);
        const size_t srci = (size_t)bb * (WBUF * ATT_WIDTH / 4) + (DEC_SEQ * ATT_WIDTH / 4) + r;
        v[j] = __builtin_nontemporal_load((tb >= DEC_BATCH ? (const f32x4n*)cv : (const f32x4n*)ck) + srci);
    }
}
__device__ __forceinline__ void copy_q_store(float* __restrict__ out, unsigned q, unsigned lane, const f32x4n (&v)[16]) {
    constexpr unsigned PER_B = (WBUF - DEC_SEQ) * ATT_WIDTH / 4, TOTAL = 2u * DEC_BATCH * PER_B;
#pragma unroll
    for (int j = 0; j < 16; ++j) {
        const unsigned idx = q * 1024u + j * 64u + lane;
        if (idx < TOTAL) {
            const unsigned tb = idx / PER_B, r = idx - tb * PER_B, bb = tb & (DEC_BATCH - 1);
            const size_t dsti = (size_t)bb * (WBUF * ATT_WIDTH / 4) + r;
            __builtin_nontemporal_store(v[j], (f32x4n*)(out + (tb >= DEC_BATCH ? OUT_SV : OUT_SK)) + dsti);
        }
    }
}
typedef float f32x2v __attribute__((ext_vector_type(2)));
typedef unsigned u32x6 __attribute__((ext_vector_type(6)));
typedef float f32x32 __attribute__((ext_vector_type(32)));
typedef float f32x16q __attribute__((ext_vector_type(16)));
struct __attribute__((aligned(4))) u3w { unsigned x, y, z; };
#define PEER_ROWB 768
__device__ __forceinline__ void ph_quant_tables(const float* __restrict__ pu, const float* __restrict__ pv, unsigned char* __restrict__ ub8, unsigned char* __restrict__ vb8,
                                                float* __restrict__ usc, float* __restrict__ vsc, int rank, int nranks) {
    const int lane = threadIdx.x & 63;
#pragma unroll 2
    for (int row = rank * NWAVE + (threadIdx.x >> 6); row < 2 * 16384; row += nranks * NWAVE) {
        const int rr = row & 16383; const bool isv = row >= 16384;
        const float* src = (isv ? pv : pu) + (size_t)rr * D_MODEL + lane * 8;
        const float4 a = *(const float4*)src, b = *(const float4*)(src + 4), c = *(const float4*)(src + 512), d = *(const float4*)(src + 516);
        float am = fmaxf(fmaxf(fmaxf(fabsf(a.x), fabsf(a.y)), fmaxf(fabsf(a.z), fabsf(a.w))), fmaxf(fmaxf(fabsf(b.x), fabsf(b.y)), fmaxf(fabsf(b.z), fabsf(b.w))));
        am = fmaxf(am, fmaxf(fmaxf(fmaxf(fabsf(c.x), fabsf(c.y)), fmaxf(fabsf(c.z), fabsf(c.w))), fmaxf(fmaxf(fabsf(d.x), fabsf(d.y)), fmaxf(fabsf(d.z), fabsf(d.w)))));
        am = wave_max(am);
        const float sc = am > 0.f ? 7.5f / am : 1.0f;
        f32x16q e0, e1;
#pragma unroll
        for (int i = 0; i < 16; ++i) { e0[i] = 0.f; e1[i] = 0.f; }
        e0[0] = a.x * sc; e1[0] = a.y * sc; e0[1] = a.z * sc; e1[1] = a.w * sc; e0[2] = b.x * sc; e1[2] = b.y * sc; e0[3] = b.z * sc; e1[3] = b.w * sc;
        e0[4] = c.x * sc; e1[4] = c.y * sc; e0[5] = c.z * sc; e1[5] = c.w * sc; e0[6] = d.x * sc; e1[6] = d.y * sc; e0[7] = d.z * sc; e1[7] = d.w * sc;
        const u32x6 qv = __builtin_amdgcn_cvt_scalef32_2xpk16_fp6_f32(e0, e1, 1.0f);
        u3w o; o.x = qv[0]; o.y = qv[1]; o.z = qv[2];
        *(u3w*)((isv ? vb8 : ub8) + (size_t)rr * PEER_ROWB + lane * 12) = o;
        if (lane == 0) (isv ? vsc : usc)[rr] = am > 0.f ? am * (1.0f / 7.5f) : 1.0f;
    }
}
__device__ __forceinline__ void unpack16_fp8(const v4u w, float (&f)[16]) {
#pragma unroll
    for (int i = 0; i < 4; ++i) {
        const f32x2v lo = __builtin_amdgcn_cvt_pk_f32_fp8((int)w[i], false), hi = __builtin_amdgcn_cvt_pk_f32_fp8((int)w[i], true);
        f[4 * i] = lo[0]; f[4 * i + 1] = lo[1]; f[4 * i + 2] = hi[0]; f[4 * i + 3] = hi[1];
    }
}
__device__ __forceinline__ unsigned ffn_slice(unsigned n9, unsigned it) {
    const unsigned w = (unsigned)__builtin_amdgcn_readfirstlane(threadIdx.x >> 6), wgl = blockIdx.x * NWAVE + w;
    if (gridDim.x != 256) return n9 + wgl + it * (gridDim.x * NWAVE);
    if (it < 2u) return n9 + it * 2048u + wgl;
    if (w < 2u) return 0xffffffffu;
    const unsigned lw = blockIdx.x * 6u + (w - 2u);
    if (it < 4u) return n9 + 4096u + (it - 2u) * 1536u + lw;
    if (it == 4u && lw < 256u) return n9 + 7168u + lw;
    return 0xffffffffu;
}
__device__ __forceinline__ void ph_peer_ffn3(const bf16* __restrict__ hb, const int* __restrict__ eidx, const float* __restrict__ gate,
                                             const unsigned char* __restrict__ ub8, const unsigned char* __restrict__ vb8, const float* __restrict__ usc, const float* __restrict__ vsc,
                                             const float* __restrict__ gam, const float* __restrict__ bet, float* __restrict__ out,
                                             const float* __restrict__ ck, const float* __restrict__ cv, unsigned n9) {
    const int lane0 = threadIdx.x & 63;
    unsigned it = 0;
    for (;; ++it) {
        const int t = token_of_iter((int)it);
        if (t < 0) break;
        int lane = lane0; asm volatile("" : "+v"(lane));
        { const unsigned sl = ffn_slice(n9, it); if (sl < 16384u) cache_copy_slice(ck, cv, out, sl, (unsigned)lane); }
        const unsigned lo12 = (unsigned)lane * 12u, lo8 = (unsigned)lane * 8u;
        float x[16];
        { float f0[8], f1[8]; const bf16* xr = hb + (size_t)t * D_MODEL + lo8; unpack8(*(const v4u*)xr, f0); unpack8(*(const v4u*)(xr + 512), f1);
#pragma unroll
          for (int j = 0; j < 8; ++j) { x[j] = f0[j]; x[8 + j] = f1[j]; } }
        int ev[2]; float wv[4], su[4];
        ev[0] = eidx[(size_t)t * 128 + lane]; ev[1] = eidx[(size_t)t * 128 + 64 + lane];
#pragma unroll
        for (int rd = 0; rd < 4; ++rd) {
            const int er = eidx[(size_t)t * 128 + rd * 32 + (lane >> 1)];
            wv[rd] = gate[(size_t)t * 128 + rd * 32 + (lane >> 1)] * vsc[er];
            su[rd] = usc[er];
        }
#pragma unroll
        for (int rd = 0; rd < 4; ++rd) {
            float part[32];
#pragma unroll
            for (int kb = 0; kb < 8; ++kb) {
                u3w ra[4];
#pragma unroll
                for (int k8 = 0; k8 < 4; ++k8) {
                    const int e = __builtin_amdgcn_readlane(ev[rd >> 1], (rd & 1) * 32 + kb * 4 + k8);
                    ra[k8] = *(const u3w*)(ub8 + (size_t)e * PEER_ROWB + lo12);
                }
#pragma unroll
                for (int k8 = 0; k8 < 4; k8 += 2) {
                    u32x6 sv; sv[0] = ra[k8].x; sv[1] = ra[k8].y; sv[2] = ra[k8].z; sv[3] = ra[k8 + 1].x; sv[4] = ra[k8 + 1].y; sv[5] = ra[k8 + 1].z;
                    const f32x32 f = __builtin_amdgcn_cvt_scalef32_pk32_f32_fp6(sv, 1.0f);
                    f32x2v d0 = {0.f, 0.f}, d1 = {0.f, 0.f};
#pragma unroll
                    for (int i = 0; i < 8; ++i) {
                        d0 += (f32x2v){f[2 * i], f[2 * i + 1]} * (f32x2v){x[2 * i], x[2 * i + 1]};
                        d1 += (f32x2v){f[16 + 2 * i], f[17 + 2 * i]} * (f32x2v){x[2 * i], x[2 * i + 1]};
                    }
                    part[kb * 4 + k8] = d0[0] + d0[1]; part[kb * 4 + k8 + 1] = d1[0] + d1[1];
                    __builtin_amdgcn_sched_barrier(0);
                }
            }
            PEER_TR_STEP(16, 32) PEER_TR_STEP(8, 16) PEER_TR_STEP(4, 8) PEER_TR_STEP(2, 4) PEER_TR_STEP(1, 2)
            const float hid = (part[0] + __shfl_xor(part[0], 1)) * su[rd];
            wv[rd] *= gelu_f(hid);
        }
        f32x2v accp[8];
#pragma unroll
        for (int i = 0; i < 8; ++i) accp[i] = (f32x2v){0.f, 0.f};
#pragma unroll
        for (int rd = 0; rd < 4; ++rd) {
#pragma unroll
            for (int kb = 0; kb < 4; ++kb) {
                u3w ra[8];
#pragma unroll
                for (int k8 = 0; k8 < 8; ++k8) {
                    const int e = __builtin_amdgcn_readlane(ev[rd >> 1], (rd & 1) * 32 + kb * 8 + k8);
                    ra[k8] = *(const u3w*)(vb8 + (size_t)e * PEER_ROWB + lo12);
                }
#pragma unroll
                for (int k8 = 0; k8 < 8; k8 += 2) {
                    const float wk0 = __builtin_bit_cast(float, __builtin_amdgcn_readlane(__builtin_bit_cast(int, wv[rd]), 2 * (kb * 8 + k8)));
                    const float wk1 = __builtin_bit_cast(float, __builtin_amdgcn_readlane(__builtin_bit_cast(int, wv[rd]), 2 * (kb * 8 + k8 + 1)));
                    u32x6 sv; sv[0] = ra[k8].x; sv[1] = ra[k8].y; sv[2] = ra[k8].z; sv[3] = ra[k8 + 1].x; sv[4] = ra[k8 + 1].y; sv[5] = ra[k8 + 1].z;
                    const f32x32 f = __builtin_amdgcn_cvt_scalef32_pk32_f32_fp6(sv, 1.0f);
#pragma unroll
                    for (int i = 0; i < 8; ++i) {
                        accp[i] += (f32x2v){wk0, wk0} * (f32x2v){f[2 * i], f[2 * i + 1]};
                        accp[i] += (f32x2v){wk1, wk1} * (f32x2v){f[16 + 2 * i], f[17 + 2 * i]};
                    }
                    __builtin_amdgcn_sched_barrier(0);
                }
            }
        }
        float acc[16];
#pragma unroll
        for (int i = 0; i < 8; ++i) { acc[2 * i] = accp[i][0]; acc[2 * i + 1] = accp[i][1]; }
        float s = 0.f;
#pragma unroll
        for (int j = 0; j < 16; ++j) { acc[j] += ALPHA_F * x[j]; s += acc[j]; }
        s = wave_sum(s);
        const float mu = s * (1.0f / 1024.0f);
        float q = 0.f;
#pragma unroll
        for (int j = 0; j < 16; ++j) { acc[j] -= mu; q += acc[j] * acc[j]; }
        q = wave_sum(q);
        const float r = rsqrtf(q * (1.0f / 1024.0f) + LN_EPS);
        float* dst = ((t < T_PROMPT) ? out + OUT_YP + (size_t)t * D_MODEL : out + OUT_YS + (size_t)(t - T_PROMPT) * D_MODEL) + lo8;
#pragma unroll
        for (int q4 = 0; q4 < 4; ++q4) {
            const int eo = (q4 >> 1) * 512 + (q4 & 1) * 4;
            const float4 g4 = *(const float4*)(gam + lo8 + eo), b4 = *(const float4*)(bet + lo8 + eo);
            float4 o; o.x = acc[q4 * 4 + 0] * r * g4.x + b4.x; o.y = acc[q4 * 4 + 1] * r * g4.y + b4.y; o.z = acc[q4 * 4 + 2] * r * g4.z + b4.z; o.w = acc[q4 * 4 + 3] * r * g4.w + b4.w;
            *(float4*)(dst + eo) = o;
        }
    }
    for (;; ++it) {
        if (gridDim.x == 256 && it >= 5u) break;
        const unsigned sl = ffn_slice(n9, it);
        if (gridDim.x != 256 && sl >= 16384u) break;
        if (sl < 16384u) cache_copy_slice(ck, cv, out, sl, (unsigned)lane0);
    }
}


__device__ __forceinline__ void ssd_decode_load(const bf16* __restrict__ xbc_b, const float* __restrict__ dtv, const float* __restrict__ state_ssm, int item, int p, int ng,
                                                float (&hs)[16], v4u (&bq)[4][2], v4u (&cq)[4][2], float (&xv)[4], float (&dv)[4]) {
    const int sb = item / SSD_HEADS, h = item - sb * SSD_HEADS, g = h / 6, t0 = T_PROMPT + sb * DEC_SEQ;
    const float* s0 = state_ssm + (((size_t)sb * SSD_HEADS + h) * 64 + p) * 128 + ng * 16;
#pragma unroll
    for (int j = 0; j < 4; ++j) { const float4 v = *(const float4*)(s0 + 4 * j); hs[4 * j] = v.x; hs[4 * j + 1] = v.y; hs[4 * j + 2] = v.z; hs[4 * j + 3] = v.w; }
#pragma unroll
    for (int s = 0; s < 4; ++s) {
        const bf16* row = xbc_b + (size_t)(t0 + s) * CONV_DIM;
        bq[s][0] = *(const v4u*)(row + 1536 + g * 128 + ng * 16); bq[s][1] = *(const v4u*)(row + 1536 + g * 128 + ng * 16 + 8);
        cq[s][0] = *(const v4u*)(row + 2048 + g * 128 + ng * 16); cq[s][1] = *(const v4u*)(row + 2048 + g * 128 + ng * 16 + 8);
        xv[s] = bf2f(row[h * 64 + p]); dv[s] = dtv[(size_t)(t0 + s) * SSD_HEADS + h];
    }
}
__device__ __forceinline__ void ssd_decode_compute(const float* __restrict__ a_log, const float* __restrict__ d_skip, int item, int p, int ng,
                                                   float (&hs)[16], const v4u (&bq)[4][2], const v4u (&cq)[4][2], const float (&xv)[4], const float (&dv)[4],
                                                   float* __restrict__ ybuf, float* __restrict__ out) {
    const int sb = item / SSD_HEADS, h = item - sb * SSD_HEADS, t0 = T_PROMPT + sb * DEC_SEQ;
    const float A = -__expf(a_log[h]), D = d_skip[h];
#pragma unroll
    for (int s = 0; s < 4; ++s) {
        float Bf[16], Cf[16];
        { float t8[8]; unpack8(bq[s][0], t8);
#pragma unroll
          for (int j = 0; j < 8; ++j) Bf[j] = t8[j];
          unpack8(bq[s][1], t8);
#pragma unroll
          for (int j = 0; j < 8; ++j) Bf[8 + j] = t8[j];
          unpack8(cq[s][0], t8);
#pragma unroll
          for (int j = 0; j < 8; ++j) Cf[j] = t8[j];
          unpack8(cq[s][1], t8);
#pragma unroll
          for (int j = 0; j < 8; ++j) Cf[8 + j] = t8[j]; }
        const float a = __expf(dv[s] * A), xdt = xv[s] * dv[s];
        float y = 0.f;
#pragma unroll
        for (int j = 0; j < 16; ++j) { hs[j] = a * hs[j] + xdt * Bf[j]; y += Cf[j] * hs[j]; }
        y += __shfl_xor(y, 1); y += __shfl_xor(y, 2); y += __shfl_xor(y, 4);
        if (ng == 0) ybuf[(size_t)(t0 + s) * MIX_WIDTH + h * 64 + p] = y + D * xv[s];
    }
    float* so = out + OUT_SS + (((size_t)sb * SSD_HEADS + h) * 64 + p) * 128 + ng * 16;
#pragma unroll
    for (int j = 0; j < 4; ++j) *(float4*)(so + 4 * j) = make_float4(hs[4 * j], hs[4 * j + 1], hs[4 * j + 2], hs[4 * j + 3]);
}
__device__ __forceinline__ void ph_ssd_decode(const bf16* __restrict__ xbc_b, const float* __restrict__ dtv, const float* __restrict__ a_log, const float* __restrict__ d_skip,
                                              const float* __restrict__ state_ssm, float* __restrict__ ybuf, float* __restrict__ out) {
    const int tid = threadIdx.x, p = tid >> 3, ng = tid & 7;
    constexpr int NITEM = DEC_BATCH * SSD_HEADS;
    for (int it = blockIdx.x; it < NITEM; it += 2 * gridDim.x) {
        const int it2 = it + gridDim.x; const bool has2 = it2 < NITEM; const int it2c = has2 ? it2 : it;
        float hsA[16], hsB[16], xA[4], xB[4], dA[4], dB[4]; v4u bA[4][2], cA[4][2], bB[4][2], cB[4][2];
        ssd_decode_load(xbc_b, dtv, state_ssm, it, p, ng, hsA, bA, cA, xA, dA);
        ssd_decode_load(xbc_b, dtv, state_ssm, it2c, p, ng, hsB, bB, cB, xB, dB);
        ssd_decode_compute(a_log, d_skip, it, p, ng, hsA, bA, cA, xA, dA, ybuf, out);
        if (has2) ssd_decode_compute(a_log, d_skip, it2, p, ng, hsB, bB, cB, xB, dB, ybuf, out);
    }
}

__device__ __forceinline__ float samp_cw(int d) { return (float)((int)(d >= 0 && d <= 128) + (int)(d >= 0 && (d & 3) == 0 && d <= 512) + (int)(d >= 0 && (d & 15) == 0 && d <= 2048)); }
__device__ __forceinline__ void samp_update(float sv, float cw, const float (&vrow)[64], float& m, float& l, float (&part)[64]) {
    const float mn = fmaxf(m, sv), alpha = __expf(m - mn), p = cw * __expf(sv - mn);
    m = mn; l = l * alpha + p;
#pragma unroll
    for (int c = 0; c < 64; ++c) part[c] = part[c] * alpha + p * vrow[c];
}
__device__ __forceinline__ void ph_attn_sample3(float* lds, const bf16* __restrict__ qrot_b, const bf16* __restrict__ krot_b, const bf16* __restrict__ projb,
                                                const float* __restrict__ ck, const float* __restrict__ cv, bf16* __restrict__ A1) {
    const int lane0 = threadIdx.x & 63, w = __builtin_amdgcn_readfirstlane(threadIdx.x >> 6);
    float* sq = lds + w * 256;
    for (int item = blockIdx.x + gridDim.x * w; item < DEC_BATCH * ATT_HEADS; item += gridDim.x * NWAVE) {
        int lane = lane0; asm volatile("" : "+v"(lane));
        const int b = item >> 3, hd = item & 7, qi = lane & 3, g = lane >> 2;
        const int tq0 = T_PROMPT + b * DEC_SEQ;
#pragma unroll
        for (int i = 0; i < 4; ++i) sq[i * 64 + lane] = bf2f(qrot_b[(size_t)(tq0 + i) * ATT_WIDTH + hd * 64 + lane]);
        asm volatile("s_waitcnt lgkmcnt(0)" ::: "memory");
        const float* qv = sq + qi * 64;
        const float* ckb = ck + (size_t)b * WBUF * ATT_WIDTH + hd * 64; const float* cvb = cv + (size_t)b * WBUF * ATT_WIDTH + hd * 64;
        float m = -1e30f, l = 0.f, part[64];
#pragma unroll
        for (int c = 0; c < 64; ++c) part[c] = 0.f;
        {
            const int P = 2051 - g;
            const float cw = samp_cw(WBUF + qi - P);
            const bool isn = P >= WBUF;
            const int nt = isn ? P - WBUF : 0, Pc = isn ? WBUF - 1 : P;
            const bf16* kn = krot_b + (size_t)(tq0 + nt) * ATT_WIDTH + hd * 64; const float* kr = ckb + (size_t)Pc * ATT_WIDTH;
            float a = 0.f;
#pragma unroll
            for (int c = 0; c < 64; c += 8) { float f[8]; unpack8(*(const v4u*)(kn + c), f); const float4 k0 = *(const float4*)(kr + c), k1 = *(const float4*)(kr + c + 4);
                a += (isn ? f[0] : k0.x) * qv[c] + (isn ? f[1] : k0.y) * qv[c + 1] + (isn ? f[2] : k0.z) * qv[c + 2] + (isn ? f[3] : k0.w) * qv[c + 3]
                   + (isn ? f[4] : k1.x) * qv[c + 4] + (isn ? f[5] : k1.y) * qv[c + 5] + (isn ? f[6] : k1.z) * qv[c + 6] + (isn ? f[7] : k1.w) * qv[c + 7]; }
            const float sv = cw > 0.f ? a * 0.125f : -1e30f;
            const bf16* vn = projb + (size_t)(tq0 + nt) * NB_LD + NB_V + hd * 64; const float* vr = cvb + (size_t)Pc * ATT_WIDTH;
            float vrow[64];
#pragma unroll
            for (int c = 0; c < 64; c += 8) { float f[8]; unpack8(*(const v4u*)(vn + c), f); const float4 v0 = *(const float4*)(vr + c), v1 = *(const float4*)(vr + c + 4);
                vrow[c] = isn ? f[0] : v0.x; vrow[c + 1] = isn ? f[1] : v0.y; vrow[c + 2] = isn ? f[2] : v0.z; vrow[c + 3] = isn ? f[3] : v0.w;
                vrow[c + 4] = isn ? f[4] : v1.x; vrow[c + 5] = isn ? f[5] : v1.y; vrow[c + 6] = isn ? f[6] : v1.z; vrow[c + 7] = isn ? f[7] : v1.w; }
            samp_update(sv, cw, vrow, m, l, part);
        }
#pragma unroll 1
        for (int s = 1; s < 21; ++s) {
            const int P = s < 9 ? 2051 - (16 * s + g) : (s < 15 ? 1536 + 64 * (s - 9) + lane : qi + 16 * (16 * (s - 15) + g));
            const float cw = (s < 9 && P < 1920) ? 0.f : samp_cw(WBUF + qi - P);
            const float* kr = ckb + (size_t)P * ATT_WIDTH;
            float a = 0.f;
#pragma unroll
            for (int c = 0; c < 64; c += 4) { const float4 kv = *(const float4*)(kr + c); a += kv.x * qv[c] + kv.y * qv[c + 1] + kv.z * qv[c + 2] + kv.w * qv[c + 3]; }
            const float sv = cw > 0.f ? a * 0.125f : -1e30f;
            __builtin_amdgcn_sched_barrier(0);
            const float* vr = cvb + (size_t)P * ATT_WIDTH;
            float vrow[64];
#pragma unroll
            for (int c = 0; c < 64; c += 4) { const float4 vv = *(const float4*)(vr + c); vrow[c] = vv.x; vrow[c + 1] = vv.y; vrow[c + 2] = vv.z; vrow[c + 3] = vv.w; }
            samp_update(sv, cw, vrow, m, l, part);
        }
        float M = m;
        M = fmaxf(M, __shfl_xor(M, 4)); M = fmaxf(M, __shfl_xor(M, 8)); M = fmaxf(M, __shfl_xor(M, 16)); M = fmaxf(M, __shfl_xor(M, 32));
        const float sc = __expf(m - M);
        float lsum = l * sc;
        lsum += __shfl_xor(lsum, 4); lsum += __shfl_xor(lsum, 8); lsum += __shfl_xor(lsum, 16); lsum += __shfl_xor(lsum, 32);
#pragma unroll
        for (int c = 0; c < 64; ++c) part[c] *= sc;
        PEER_TR_STEP(32, 32) PEER_TR_STEP(16, 16) PEER_TR_STEP(8, 8) PEER_TR_STEP(4, 4)
        const float inv = 1.0f / lsum;
        *(uint2*)(A1 + (size_t)(tq0 + qi) * MIX_WIDTH + SSD_WIDTH + hd * 64 + 4 * g) = make_uint2(pk2(part[0] * inv, part[1] * inv), pk2(part[2] * inv, part[3] * inv));
    }
}

typedef float f32x16 __attribute__((ext_vector_type(16)));
typedef short s16x8 __attribute__((ext_vector_type(8)));
typedef short s16x4 __attribute__((ext_vector_type(4)));
typedef float f32x4v __attribute__((ext_vector_type(4)));
#define SSD_L_ACS 0
#define SSD_L_DTS 3072
#define SSD_L_BM 6144
#define SSD_RS_B 272
#define SSD_L_X (6144 + 128 * 272)
#define SSD_RS_X 144
#define SSD_XIMG (128 * 144)
#define SSD_RS_Y 784
template <int OFF0, int OFF1>
__device__ __forceinline__ s16x8 tr_frag(unsigned base) {
    s16x4 a, b;
    asm volatile("ds_read_b64_tr_b16 %0, %2 offset:%3\n\tds_read_b64_tr_b16 %1, %2 offset:%4\n\ts_waitcnt lgkmcnt(0)"
                 : "=&v"(a), "=&v"(b) : "v"(base), "n"(OFF0), "n"(OFF1) : "memory");
    return __builtin_shufflevector(a, b, 0, 1, 2, 3, 4, 5, 6, 7);
}
__device__ __forceinline__ unsigned lds_addr(LAS unsigned char* p) { return (unsigned)(size_t)p; }
template <int O0, int O1, int O2, int O3, int O4, int O5, int O6, int O7>
__device__ __forceinline__ void tr_read8(unsigned base, s16x4 (&v)[8]) {
    asm volatile("ds_read_b64_tr_b16 %0, %8 offset:%9\n\tds_read_b64_tr_b16 %1, %8 offset:%10\n\tds_read_b64_tr_b16 %2, %8 offset:%11\n\tds_read_b64_tr_b16 %3, %8 offset:%12\n\t"
                 "ds_read_b64_tr_b16 %4, %8 offset:%13\n\tds_read_b64_tr_b16 %5, %8 offset:%14\n\tds_read_b64_tr_b16 %6, %8 offset:%15\n\tds_read_b64_tr_b16 %7, %8 offset:%16\n\ts_waitcnt lgkmcnt(0)"
                 : "=&v"(v[0]), "=&v"(v[1]), "=&v"(v[2]), "=&v"(v[3]), "=&v"(v[4]), "=&v"(v[5]), "=&v"(v[6]), "=&v"(v[7])
                 : "v"(base), "n"(O0), "n"(O1), "n"(O2), "n"(O3), "n"(O4), "n"(O5), "n"(O6), "n"(O7) : "memory");
}
#define TRCAT(a, b) __builtin_shufflevector(a, b, 0, 1, 2, 3, 4, 5, 6, 7)


__device__ __forceinline__ void ssd_chunk_acs(LAS unsigned char* ldsb, const float* __restrict__ dtv, const float* __restrict__ a_log, int t0, int g, float* cdec_out) {
    const int w = __builtin_amdgcn_readfirstlane(threadIdx.x >> 6), lane = threadIdx.x & 63;
    if (w < 6) {
        const int head = 6 * g + w;
        const float A = -__expf(a_log[head]);
        const float v0 = dtv[(size_t)(t0 + 2 * lane) * SSD_HEADS + head], v1 = dtv[(size_t)(t0 + 2 * lane + 1) * SSD_HEADS + head];
        const float a1 = v1 * A;
        float s = v0 * A + a1;
#pragma unroll
        for (int o = 1; o < 64; o <<= 1) { const float tmp = __shfl_up(s, o); if (lane >= o) s += tmp; }
        LAS float* acs = (LAS float*)(ldsb + SSD_L_ACS) + w * 128;
        LAS float* dts = (LAS float*)(ldsb + SSD_L_DTS) + w * 128;
        acs[2 * lane] = s - a1; acs[2 * lane + 1] = s;
        dts[2 * lane] = v0; dts[2 * lane + 1] = v1;
        if (cdec_out && lane == 63) cdec_out[head] = __expf(s);
    }
}

__device__ __forceinline__ void ph_ssd_states(LAS unsigned char* ldsb, const bf16* __restrict__ xbc_b, const float* __restrict__ dtv, const float* __restrict__ a_log,
                                              bf16* __restrict__ Sbuf, float* __restrict__ cdec, const float* __restrict__ ck, const float* __restrict__ cv, float* __restrict__ out) {
    const int tid = threadIdx.x, w = __builtin_amdgcn_readfirstlane(tid >> 6), lane = tid & 63;
    const int r = lane & 31, h = lane >> 5, blk = (lane >> 4) & 1, q = (lane & 15) >> 2, pp = lane & 3;
    const int nt = w & 3, pt = w >> 2;
    for (int unit = blockIdx.x; unit < BATCH * 64 * SSD_GROUPS; unit += gridDim.x) {
        const int g = unit & 3, bc = unit >> 2;
        const int t0 = bc * 128;
        __syncthreads();
        ssd_chunk_acs(ldsb, dtv, a_log, t0, g, cdec + (size_t)bc * SSD_HEADS);
#pragma unroll
        for (int it_ = 0; it_ < 4; ++it_) { const int idx = tid + it_ * NTHR; const int row = idx >> 4, ch = idx & 15;
            const v4u v = *(const v4u*)(xbc_b + (size_t)(t0 + row) * CONV_DIM + 1536 + 128 * g + ch * 8);
            *(LAS v4u*)(ldsb + SSD_L_BM + row * SSD_RS_B + ch * 16) = v; }
        __syncthreads();
#pragma unroll
        for (int it_ = 0; it_ < 12; ++it_) { const int idx = tid + it_ * NTHR; const int hh = idx >> 10, rem = idx & 1023, row = rem >> 3, ch = rem & 7;
            const LAS float* acs = (const LAS float*)(ldsb + SSD_L_ACS) + hh * 128; const LAS float* dts = (const LAS float*)(ldsb + SSD_L_DTS) + hh * 128;
            const float wgt = dts[row] * __expf(acs[127] - acs[row]);
            float f[8]; unpack8(*(const v4u*)(xbc_b + (size_t)(t0 + row) * CONV_DIM + (6 * g + hh) * 64 + ch * 8), f);
            v4u o; o.x = pk2(f[0] * wgt, f[1] * wgt); o.y = pk2(f[2] * wgt, f[3] * wgt); o.z = pk2(f[4] * wgt, f[5] * wgt); o.w = pk2(f[6] * wgt, f[7] * wgt);
            *(LAS v4u*)(ldsb + SSD_L_X + hh * SSD_XIMG + row * SSD_RS_X + ch * 16) = o; }
        __syncthreads();
        f32x4n rider[16];
        copy_q_load(ck, cv, 12288u + (unsigned)(unit * NWAVE + w), (unsigned)lane, rider);
        const unsigned abase = lds_addr(ldsb + SSD_L_BM) + (8 * h + q) * SSD_RS_B + (32 * nt + 16 * blk + 4 * pp) * 2;
        s16x8 afr[8];
        { s16x4 av[8];
          tr_read8<0 * SSD_RS_B, 4 * SSD_RS_B, 16 * SSD_RS_B, 20 * SSD_RS_B, 32 * SSD_RS_B, 36 * SSD_RS_B, 48 * SSD_RS_B, 52 * SSD_RS_B>(abase, av);
          afr[0] = TRCAT(av[0], av[1]); afr[1] = TRCAT(av[2], av[3]); afr[2] = TRCAT(av[4], av[5]); afr[3] = TRCAT(av[6], av[7]);
          tr_read8<64 * SSD_RS_B, 68 * SSD_RS_B, 80 * SSD_RS_B, 84 * SSD_RS_B, 96 * SSD_RS_B, 100 * SSD_RS_B, 112 * SSD_RS_B, 116 * SSD_RS_B>(abase, av);
          afr[4] = TRCAT(av[0], av[1]); afr[5] = TRCAT(av[2], av[3]); afr[6] = TRCAT(av[4], av[5]); afr[7] = TRCAT(av[6], av[7]); }
#pragma unroll
        for (int hh = 0; hh < 6; ++hh) {
            const unsigned xb = lds_addr(ldsb + SSD_L_X + hh * SSD_XIMG) + (8 * h + q) * SSD_RS_X + (32 * pt + 16 * blk + 4 * pp) * 2;
            f32x16 acc;
#pragma unroll
            for (int i = 0; i < 16; ++i) acc[i] = 0.f;
            { s16x4 xv[8];
              tr_read8<0 * SSD_RS_X, 4 * SSD_RS_X, 16 * SSD_RS_X, 20 * SSD_RS_X, 32 * SSD_RS_X, 36 * SSD_RS_X, 48 * SSD_RS_X, 52 * SSD_RS_X>(xb, xv);
              acc = __builtin_amdgcn_mfma_f32_32x32x16_bf16(afr[0], TRCAT(xv[0], xv[1]), acc, 0, 0, 0);
              acc = __builtin_amdgcn_mfma_f32_32x32x16_bf16(afr[1], TRCAT(xv[2], xv[3]), acc, 0, 0, 0);
              acc = __builtin_amdgcn_mfma_f32_32x32x16_bf16(afr[2], TRCAT(xv[4], xv[5]), acc, 0, 0, 0);
              acc = __builtin_amdgcn_mfma_f32_32x32x16_bf16(afr[3], TRCAT(xv[6], xv[7]), acc, 0, 0, 0);
              tr_read8<64 * SSD_RS_X, 68 * SSD_RS_X, 80 * SSD_RS_X, 84 * SSD_RS_X, 96 * SSD_RS_X, 100 * SSD_RS_X, 112 * SSD_RS_X, 116 * SSD_RS_X>(xb, xv);
              acc = __builtin_amdgcn_mfma_f32_32x32x16_bf16(afr[4], TRCAT(xv[0], xv[1]), acc, 0, 0, 0);
              acc = __builtin_amdgcn_mfma_f32_32x32x16_bf16(afr[5], TRCAT(xv[2], xv[3]), acc, 0, 0, 0);
              acc = __builtin_amdgcn_mfma_f32_32x32x16_bf16(afr[6], TRCAT(xv[4], xv[5]), acc, 0, 0, 0);
              acc = __builtin_amdgcn_mfma_f32_32x32x16_bf16(afr[7], TRCAT(xv[6], xv[7]), acc, 0, 0, 0); }
            bf16* dst = Sbuf + ((size_t)bc * SSD_HEADS + 6 * g + hh) * 8192 + (size_t)(pt * 8 + 2 * nt) * 512 + r * 8 + 4 * h;
#pragma unroll
            for (int q4 = 0; q4 < 4; ++q4) *(uint2*)(dst + (q4 >> 1) * 512 + (q4 & 1) * 256) = make_uint2(pk2(acc[4 * q4], acc[4 * q4 + 1]), pk2(acc[4 * q4 + 2], acc[4 * q4 + 3]));
        }
        copy_q_store(out, 12288u + (unsigned)(unit * NWAVE + w), (unsigned)lane, rider);
    }
}

__device__ __forceinline__ void ph_ssd_scan(const bf16* __restrict__ Sbuf, const float* __restrict__ cdec, bf16* __restrict__ Hin, float* __restrict__ out, int rank, int nranks) {
    for (int idx = rank * NTHR + threadIdx.x; idx < BATCH * SSD_HEADS * 1024; idx += nranks * NTHR) {
        const int i = idx & 1023, hb = idx >> 10, hd = hb % SSD_HEADS, b = hb / SSD_HEADS;
        float st[8];
#pragma unroll
        for (int j = 0; j < 8; ++j) st[j] = 0.f;
#pragma unroll 8
        for (int c = 0; c < 64; ++c) {
            const size_t base = (((size_t)(b * 64 + c)) * SSD_HEADS + hd) * 8192 + (size_t)i * 8;
            v4u o; o.x = pk2(st[0], st[1]); o.y = pk2(st[2], st[3]); o.z = pk2(st[4], st[5]); o.w = pk2(st[6], st[7]);
            *(v4u*)(Hin + base) = o;
            float s[8]; unpack8(*(const v4u*)(Sbuf + base), s);
            const float a = cdec[(size_t)(b * 64 + c) * SSD_HEADS + hd];
#pragma unroll
            for (int j = 0; j < 8; ++j) st[j] = a * st[j] + s[j];
        }
        const int ln = i & 63, ks = (i >> 6) & 7, pt = i >> 9, p = 32 * pt + (ln & 31), n0 = 16 * ks + 8 * (ln >> 5);
        store8f(out + OUT_PS + (((size_t)b * SSD_HEADS + hd) * 64 + p) * 128 + n0, st);
    }
}

__device__ __forceinline__ void ph_ssd_out(LAS unsigned char* ldsb, const bf16* __restrict__ xbc_b, const bf16* __restrict__ projb, const float* __restrict__ dtv,
                                           const float* __restrict__ a_log, const float* __restrict__ d_skip, const float* __restrict__ norm_g,
                                           const bf16* __restrict__ Hin, bf16* __restrict__ A1) {
    const int tid = threadIdx.x, w = __builtin_amdgcn_readfirstlane(tid >> 6), lane = tid & 63;
    const int r = lane & 31, h = lane >> 5, blk = (lane >> 4) & 1, q = (lane & 15) >> 2, pp = lane & 3;
    const int hs = w >> 2, lt = hs ? 3 - (w & 3) : (w & 3);
    for (int unit = blockIdx.x; unit < BATCH * 64 * SSD_GROUPS; unit += gridDim.x) {
        const int g = unit & 3, bc = unit >> 2;
        const int t0 = bc * 128;
        __syncthreads();
        ssd_chunk_acs(ldsb, dtv, a_log, t0, g, nullptr);
#pragma unroll
        for (int it_ = 0; it_ < 4; ++it_) { const int idx = tid + it_ * NTHR; const int row = idx >> 4, ch = idx & 15;
            const v4u v = *(const v4u*)(xbc_b + (size_t)(t0 + row) * CONV_DIM + 1536 + 128 * g + ch * 8);
            *(LAS v4u*)(ldsb + SSD_L_BM + row * SSD_RS_B + ch * 16) = v; }
#pragma unroll
        for (int it_ = 0; it_ < 12; ++it_) { const int idx = tid + it_ * NTHR; const int hh = idx >> 10, rem = idx & 1023, row = rem >> 3, ch = rem & 7;
            const v4u v = *(const v4u*)(xbc_b + (size_t)(t0 + row) * CONV_DIM + (6 * g + hh) * 64 + ch * 8);
            *(LAS v4u*)(ldsb + SSD_L_X + hh * SSD_XIMG + row * SSD_RS_X + ch * 16) = v; }
        __syncthreads();
        const bf16* cp = xbc_b + (size_t)(t0 + 32 * lt + r) * CONV_DIM + 2048 + 128 * g + 8 * h;
        s16x8 cfr[8];
#pragma unroll
        for (int ks = 0; ks < 8; ++ks) cfr[ks] = *(const s16x8*)(cp + 16 * ks);
        const int lcol = 32 * lt + r;
        const LAS float* acsb = (const LAS float*)(ldsb + SSD_L_ACS) + 3 * hs * 128; const LAS float* dtsb = (const LAS float*)(ldsb + SSD_L_DTS) + 3 * hs * 128;
        const unsigned xb0 = lds_addr(ldsb + SSD_L_X + 3 * hs * SSD_XIMG) + (4 * h + q) * SSD_RS_X + (16 * blk + 4 * pp) * 2;
        unsigned ypk[3][16];
#pragma unroll
        for (int h3 = 0; h3 < 3; ++h3) {
            const LAS float* acs = acsb + h3 * 128; const LAS float* dts = dtsb + h3 * 128;
            const float myacs = acs[lcol];
            const float Dh = d_skip[6 * g + 3 * hs + h3];
            f32x16 y0, y1;
#pragma unroll
            for (int i = 0; i < 16; ++i) { y0[i] = 0.f; y1[i] = 0.f; }
            { const bf16* hp = Hin + ((size_t)bc * SSD_HEADS + 6 * g + 3 * hs + h3) * 8192 + lane * 8;
#pragma unroll
              for (int kh = 0; kh < 2; ++kh) {
                  s16x8 hf0[4], hf1[4];
#pragma unroll
                  for (int ks = 0; ks < 4; ++ks) { hf0[ks] = *(const s16x8*)(hp + (4 * kh + ks) * 512); hf1[ks] = *(const s16x8*)(hp + (8 + 4 * kh + ks) * 512); }
#pragma unroll
                  for (int ks = 0; ks < 4; ++ks) { y0 = __builtin_amdgcn_mfma_f32_32x32x16_bf16(cfr[4 * kh + ks], hf0[ks], y0, 0, 0, 0); y1 = __builtin_amdgcn_mfma_f32_32x32x16_bf16(cfr[4 * kh + ks], hf1[ks], y1, 0, 0, 0); }
                  __builtin_amdgcn_sched_barrier(0);
              } }
#pragma unroll
            for (int q4 = 0; q4 < 4; ++q4) {
                const f32x4v a4 = *(const LAS f32x4v*)(acs + 32 * lt + 8 * q4 + 4 * h);
                const float e0 = __expf(a4[0]), e1 = __expf(a4[1]), e2 = __expf(a4[2]), e3 = __expf(a4[3]);
                y0[4 * q4] *= e0; y0[4 * q4 + 1] *= e1; y0[4 * q4 + 2] *= e2; y0[4 * q4 + 3] *= e3;
                y1[4 * q4] *= e0; y1[4 * q4 + 1] *= e1; y1[4 * q4 + 2] *= e2; y1[4 * q4 + 3] *= e3;
            }
            __builtin_amdgcn_sched_barrier(0);
            for (int st = 0; st <= lt; ++st) {
                f32x16 cb;
#pragma unroll
                for (int i = 0; i < 16; ++i) cb[i] = 0.f;
#pragma unroll
                for (int ks = 0; ks < 8; ++ks) {
                    const s16x8 bfrag = *(const LAS s16x8*)(ldsb + SSD_L_BM + (32 * st + r) * SSD_RS_B + (16 * ks + 8 * h) * 2);
                    cb = __builtin_amdgcn_mfma_f32_32x32x16_bf16(bfrag, cfr[ks], cb, 0, 0, 0);
                }
                __builtin_amdgcn_sched_barrier(0);
                const unsigned xb = xb0 + h3 * SSD_XIMG + st * 32 * SSD_RS_X;
                s16x4 xv[8];
                tr_read8<0, 8 * SSD_RS_X, 64, 8 * SSD_RS_X + 64, 16 * SSD_RS_X, 24 * SSD_RS_X, 16 * SSD_RS_X + 64, 24 * SSD_RS_X + 64>(xb, xv);
#pragma unroll
                for (int kk = 0; kk < 2; ++kk) {
                    const int s0 = 32 * st + 16 * kk + 4 * h;
                    const f32x4v as0 = *(const LAS f32x4v*)(acs + s0), as1 = *(const LAS f32x4v*)(acs + s0 + 8);
                    const f32x4v ds0 = *(const LAS f32x4v*)(dts + s0), ds1 = *(const LAS f32x4v*)(dts + s0 + 8);
                    float wv[8];
#pragma unroll
                    for (int j = 0; j < 8; ++j) {
                        const int s = s0 + 8 * (j >> 2) + (j & 3);
                        const float asj = (j < 4) ? as0[j & 3] : as1[j & 3], dsj = (j < 4) ? ds0[j & 3] : ds1[j & 3];
                        float v = cb[8 * kk + j] * __expf(myacs - asj) * dsj;
                        v = (s <= lcol) ? v : 0.f;
                        v = (s == lcol) ? v + Dh : v;
                        wv[j] = v;
                    }
                    s16x8 afr;
                    { v4u o; o.x = pk2(wv[0], wv[1]); o.y = pk2(wv[2], wv[3]); o.z = pk2(wv[4], wv[5]); o.w = pk2(wv[6], wv[7]); afr = __builtin_bit_cast(s16x8, o); }
                    const s16x8 b0 = kk == 0 ? TRCAT(xv[0], xv[1]) : TRCAT(xv[4], xv[5]);
                    const s16x8 b1 = kk == 0 ? TRCAT(xv[2], xv[3]) : TRCAT(xv[6], xv[7]);
                    y0 = __builtin_amdgcn_mfma_f32_32x32x16_bf16(afr, b0, y0, 0, 0, 0);
                    y1 = __builtin_amdgcn_mfma_f32_32x32x16_bf16(afr, b1, y1, 0, 0, 0);
                    __builtin_amdgcn_sched_barrier(0);
                }
            }
#pragma unroll
            for (int i = 0; i < 8; ++i) { ypk[h3][i] = pk2(y0[2 * i], y0[2 * i + 1]); ypk[h3][8 + i] = pk2(y1[2 * i], y1[2 * i + 1]); }
            __builtin_amdgcn_sched_barrier(0);
        }
        __syncthreads();
        {
            LAS unsigned short* yst = (LAS unsigned short*)(ldsb + SSD_L_X);
#pragma unroll
            for (int h3 = 0; h3 < 3; ++h3)
#pragma unroll
                for (int ptile = 0; ptile < 2; ++ptile)
#pragma unroll
                    for (int i = 0; i < 8; ++i) {
                        const int reg = 2 * i;
                        const int l0 = 32 * lt + (reg & 3) + 8 * (reg >> 2) + 4 * h;
                        const int col = (3 * hs + h3) * 64 + 32 * ptile + r;
                        const unsigned v = ypk[h3][8 * ptile + i];
                        yst[l0 * (SSD_RS_Y / 2) + col] = (unsigned short)(v & 0xffffu);
                        yst[(l0 + 1) * (SSD_RS_Y / 2) + col] = (unsigned short)(v >> 16);
                    }
        }
        __syncthreads();
#pragma unroll
        for (int pass = 0; pass < 4; ++pass) {
            const int l = 4 * (pass * 8 + w) + (lane >> 4), i16 = lane & 15;
            float gv[3][8]; float ss = 0.f;
#pragma unroll
            for (int k = 0; k < 3; ++k) {
                const int col0 = 24 * i16 + 8 * k;
                float yv[8], zv[8];
                unpack8(*(const LAS v4u*)(ldsb + SSD_L_X + l * SSD_RS_Y + col0 * 2), yv);
                unpack8(*(const v4u*)(projb + (size_t)(t0 + l) * NB_LD + g * 384 + col0), zv);
#pragma unroll
                for (int j = 0; j < 8; ++j) { const float gg = yv[j] * silu_f(zv[j]); gv[k][j] = gg; ss += gg * gg; }
            }
            ss += __shfl_xor(ss, 1); ss += __shfl_xor(ss, 2); ss += __shfl_xor(ss, 4); ss += __shfl_xor(ss, 8);
            const float rstd = rsqrtf(ss * (1.0f / 384.0f) + LN_EPS);
#pragma unroll
            for (int k = 0; k < 3; ++k) {
                const int col0 = g * 384 + 24 * i16 + 8 * k;
                const float4 g0 = *(const float4*)(norm_g + col0), g1 = *(const float4*)(norm_g + col0 + 4);
                v4u o; o.x = pk2(gv[k][0] * rstd * g0.x, gv[k][1] * rstd * g0.y); o.y = pk2(gv[k][2] * rstd * g0.z, gv[k][3] * rstd * g0.w);
                o.z = pk2(gv[k][4] * rstd * g1.x, gv[k][5] * rstd * g1.y); o.w = pk2(gv[k][6] * rstd * g1.z, gv[k][7] * rstd * g1.w);
                *(v4u*)(A1 + (size_t)(t0 + l) * MIX_WIDTH + col0) = o;
            }
        }
    }
}

#define ATT_RS_V 144
#define ATT_VIMG (256 * ATT_RS_V)
#define ATT_HIMG (2 * ATT_VIMG)
#define ATT_PVT(KT) { \
        s16x4 vv_[8]; \
        tr_read8<(32 * KT) * ATT_RS_V, (32 * KT + 8) * ATT_RS_V, (32 * KT) * ATT_RS_V + 64, (32 * KT + 8) * ATT_RS_V + 64, \
                 (32 * KT + 16) * ATT_RS_V, (32 * KT + 24) * ATT_RS_V, (32 * KT + 16) * ATT_RS_V + 64, (32 * KT + 24) * ATT_RS_V + 64>(vbase, vv_); \
        _Pragma("unroll") for (int s2_ = 0; s2_ < 2; ++s2_) { \
            v4u o_; o_.x = pk2(s[KT][8 * s2_ + 0], s[KT][8 * s2_ + 1]); o_.y = pk2(s[KT][8 * s2_ + 2], s[KT][8 * s2_ + 3]); \
            o_.z = pk2(s[KT][8 * s2_ + 4], s[KT][8 * s2_ + 5]); o_.w = pk2(s[KT][8 * s2_ + 6], s[KT][8 * s2_ + 7]); \
            const s16x8 pf_ = __builtin_bit_cast(s16x8, o_); \
            const s16x8 a0_ = s2_ == 0 ? TRCAT(vv_[0], vv_[1]) : TRCAT(vv_[4], vv_[5]); \
            const s16x8 a1_ = s2_ == 0 ? TRCAT(vv_[2], vv_[3]) : TRCAT(vv_[6], vv_[7]); \
            o0 = __builtin_amdgcn_mfma_f32_32x32x16_bf16(a0_, pf_, o0, 0, 0, 0); \
            o1 = __builtin_amdgcn_mfma_f32_32x32x16_bf16(a1_, pf_, o1, 0, 0, 0); } }
__device__ __forceinline__ void ph_attn_prompt(LAS unsigned char* ldsb, const bf16* __restrict__ qrot_b, const bf16* __restrict__ krot_b, const bf16* __restrict__ projb,
                                               bf16* __restrict__ obuf, float* __restrict__ lsebuf, const float* __restrict__ ck, const float* __restrict__ cv, float* __restrict__ out) {
    const int tid = threadIdx.x, w = __builtin_amdgcn_readfirstlane(tid >> 6), lane = tid & 63;
    const int r = lane & 31, h = lane >> 5, blk = (lane >> 4) & 1, q = (lane & 15) >> 2, pp = lane & 3;
    const int qt = w & 3, hsel = w >> 2;
    f32x4n rider[16]; bool pend = false; unsigned pq = 0u;
    for (int unit = blockIdx.x; unit < 3 * 512; unit += gridDim.x) {
        const int pat = unit >> 9, rem = unit & 511, hp = rem & 3, rem2 = rem >> 2, b = rem2 >> 6, bk = rem2 & 63;
        const int dsh = 2 * pat, nper = 64 >> dsh, res = bk >> (6 - dsh), nb = bk & (nper - 1);
        const int head = 2 * hp + hsel;
        __syncthreads();
        { v4u vst[8], kst[8];
#pragma unroll
          for (int it_ = 0; it_ < 8; ++it_) { const int idx = (tid & 255) + it_ * 256;
              const int row = idx >> 3, ch = idx & 7, js = 128 * nb - 128 + row, jc = js < 0 ? 0 : js;
              const size_t tk = (size_t)(b * SEQ + (jc << dsh) + res);
              vst[it_] = *(const v4u*)(projb + tk * NB_LD + NB_V + head * 64 + ch * 8);
              kst[it_] = *(const v4u*)(krot_b + tk * ATT_WIDTH + head * 64 + ch * 8); }
#pragma unroll
          for (int it_ = 0; it_ < 8; ++it_) { const int idx = (tid & 255) + it_ * 256;
              const int row = idx >> 3, ch = idx & 7, js = 128 * nb - 128 + row;
              v4u v = vst[it_], k = kst[it_]; if (js < 0) { v.x = 0u; v.y = 0u; v.z = 0u; v.w = 0u; k = v; }
              *(LAS v4u*)(ldsb + hsel * ATT_HIMG + row * ATT_RS_V + ch * 16) = v;
              *(LAS v4u*)(ldsb + hsel * ATT_HIMG + ATT_VIMG + row * ATT_RS_V + ch * 16) = k; } }
        const int tq = b * SEQ + ((128 * nb + 32 * qt + r) << dsh) + res;
        s16x8 qf[4];
#pragma unroll
        for (int ks = 0; ks < 4; ++ks) qf[ks] = *(const s16x8*)(qrot_b + (size_t)tq * ATT_WIDTH + head * 64 + 16 * ks + 8 * h);
        __syncthreads();
        f32x16 s[5];
#pragma unroll
        for (int kt = 0; kt < 5; ++kt) {
            const LAS unsigned char* kp = ldsb + hsel * ATT_HIMG + ATT_VIMG + (32 * qt + 32 * kt + r) * ATT_RS_V + 16 * h;
#pragma unroll
            for (int i = 0; i < 16; ++i) s[kt][i] = 0.f;
#pragma unroll
            for (int ks = 0; ks < 4; ++ks) s[kt] = __builtin_amdgcn_mfma_f32_32x32x16_bf16(*(const LAS s16x8*)(kp + 32 * ks), qf[ks], s[kt], 0, 0, 0);
        }
        if (pend) copy_q_store(out, pq, (unsigned)lane, rider);
        float m = -INFINITY;
#pragma unroll
        for (int kt = 0; kt < 5; ++kt) {
            const bool tile_ok = (nb > 0) || (qt + kt >= 4);
#pragma unroll
            for (int reg = 0; reg < 16; ++reg) {
                const int c = (reg & 3) + 8 * (reg >> 2) + 4 * h;
                const bool ok = tile_ok && (kt == 0 ? (c >= r) : (kt == 4 ? (c <= r) : true));
                const float v = ok ? s[kt][reg] * 0.125f : -INFINITY;
                s[kt][reg] = v; m = fmaxf(m, v);
            }
        }
        m = fmaxf(m, __shfl_xor(m, 32));
        float l = 0.f;
#pragma unroll
        for (int kt = 0; kt < 5; ++kt)
#pragma unroll
            for (int reg = 0; reg < 16; ++reg) { const float p = __expf(s[kt][reg] - m); s[kt][reg] = p; l += p; }
        l += __shfl_xor(l, 32);
        pq = (unsigned)(unit * NWAVE + w); copy_q_load(ck, cv, pq, (unsigned)lane, rider); pend = true;
        f32x16 o0, o1;
#pragma unroll
        for (int i = 0; i < 16; ++i) { o0[i] = 0.f; o1[i] = 0.f; }
        const unsigned vbase = lds_addr(ldsb + hsel * ATT_HIMG) + (32 * qt + 4 * h + q) * ATT_RS_V + (16 * blk + 4 * pp) * 2;
        ATT_PVT(0) ATT_PVT(1) ATT_PVT(2) ATT_PVT(3) ATT_PVT(4)
        const float inv = 1.0f / l;
        bf16* op = obuf + ((size_t)pat * T_PROMPT + tq) * ATT_WIDTH + head * 64 + 8 * h;
#pragma unroll
        for (int k2 = 0; k2 < 4; ++k2) {
            unsigned ax, ay, bx, by;
            if (k2 < 2) { ax = pk2(o0[8 * k2] * inv, o0[8 * k2 + 1] * inv); ay = pk2(o0[8 * k2 + 2] * inv, o0[8 * k2 + 3] * inv);
                          bx = pk2(o0[8 * k2 + 4] * inv, o0[8 * k2 + 5] * inv); by = pk2(o0[8 * k2 + 6] * inv, o0[8 * k2 + 7] * inv); }
            else { const int k3 = k2 - 2;
                   ax = pk2(o1[8 * k3] * inv, o1[8 * k3 + 1] * inv); ay = pk2(o1[8 * k3 + 2] * inv, o1[8 * k3 + 3] * inv);
                   bx = pk2(o1[8 * k3 + 4] * inv, o1[8 * k3 + 5] * inv); by = pk2(o1[8 * k3 + 6] * inv, o1[8 * k3 + 7] * inv); }
            const auto rx = __builtin_amdgcn_permlane32_swap(ax, bx, false, false);
            const auto ry = __builtin_amdgcn_permlane32_swap(ay, by, false, false);
            v4u o; o.x = rx[0]; o.y = ry[0]; o.z = rx[1]; o.w = ry[1];
            *(v4u*)(op + 16 * k2) = o;
        }
        if (h == 0) lsebuf[((size_t)pat * T_PROMPT + tq) * 8 + head] = m + __logf(l);
    }
    if (pend) copy_q_store(out, pq, (unsigned)lane, rider);
}
__device__ __forceinline__ void ph_attn_combine(const bf16* __restrict__ obuf, const float* __restrict__ lsebuf, bf16* __restrict__ A1) {
    const int lane = threadIdx.x & 63;
#pragma unroll 4
    for (int t = blockIdx.x * NWAVE + (threadIdx.x >> 6); t < T_PROMPT; t += gridDim.x * NWAVE) {
        const int hd = lane >> 3;
        const float l0 = lsebuf[((size_t)0 * T_PROMPT + t) * 8 + hd], l1 = lsebuf[((size_t)1 * T_PROMPT + t) * 8 + hd], l2 = lsebuf[((size_t)2 * T_PROMPT + t) * 8 + hd];
        const float mx = fmaxf(l0, fmaxf(l1, l2));
        const float e0 = __expf(l0 - mx), e1 = __expf(l1 - mx), e2 = __expf(l2 - mx);
        const float inv = 1.0f / (e0 + e1 + e2);
        float a[8], b[8], c[8];
        unpack8(*(const v4u*)(obuf + ((size_t)0 * T_PROMPT + t) * ATT_WIDTH + lane * 8), a);
        unpack8(*(const v4u*)(obuf + ((size_t)1 * T_PROMPT + t) * ATT_WIDTH + lane * 8), b);
        unpack8(*(const v4u*)(obuf + ((size_t)2 * T_PROMPT + t) * ATT_WIDTH + lane * 8), c);
        float o[8];
#pragma unroll
        for (int j = 0; j < 8; ++j) o[j] = (e0 * a[j] + e1 * b[j] + e2 * c[j]) * inv;
        v4u w; w.x = pk2(o[0], o[1]); w.y = pk2(o[2], o[3]); w.z = pk2(o[4], o[5]); w.w = pk2(o[6], o[7]);
        *(v4u*)(A1 + (size_t)t * MIX_WIDTH + SSD_WIDTH + lane * 8) = w;
    }
}

#define RT_RS 272
#define RT_KIMG (128 * RT_RS)
#define RT_LUT (2 * RT_KIMG)
constexpr unsigned char RT_CANDS[64] = {0, 1, 2, 3, 4, 5, 6, 7, 8, 9, 10, 11, 12, 13, 14, 15, 16, 17, 18, 19, 20, 21, 22, 23, 32, 33, 34, 35, 36, 48, 49, 50, 51, 64, 65, 66, 80, 81, 96, 97,
                                        112, 113, 128, 144, 160, 176, 192, 208, 224, 240, 0, 0, 0, 0, 0, 0, 0, 0, 0, 0, 0, 0, 0, 0};
__device__ __forceinline__ unsigned rt_mono(float f) { const unsigned u = __builtin_bit_cast(unsigned, f); return u ^ ((unsigned)((int)u >> 31) | 0x80000000u); }
__device__ __forceinline__ float rt_unmono(unsigned m) { const unsigned u = (m & 0x80000000u) ? (m ^ 0x80000000u) : ~m; return __builtin_bit_cast(float, u); }
#define RT_CE_DESC(a, b) { const unsigned x_ = (a), y_ = (b); (a) = x_ > y_ ? x_ : y_; (b) = x_ > y_ ? y_ : x_; }
#define RT_CE_ASC(a, b) { const unsigned x_ = (a), y_ = (b); (a) = x_ > y_ ? y_ : x_; (b) = x_ > y_ ? x_ : y_; }
__device__ __forceinline__ void rt_sort16(unsigned (&v)[16]) {
#pragma unroll
    for (int k = 2; k <= 16; k <<= 1)
#pragma unroll
        for (int j = k >> 1; j > 0; j >>= 1)
#pragma unroll
            for (int i = 0; i < 16; ++i) { const int l = i ^ j; if (l > i) { if ((i & k) == 0) RT_CE_DESC(v[i], v[l]) else RT_CE_ASC(v[i], v[l]) } }
}
__device__ __forceinline__ void rt_merge16(unsigned (&v)[16]) {
#pragma unroll
    for (int j = 8; j > 0; j >>= 1)
#pragma unroll
        for (int i = 0; i < 16; ++i) { const int l = i ^ j; if (l > i) RT_CE_DESC(v[i], v[l]) }
}
__device__ __forceinline__ void rt_top16(unsigned (&a)[16], const unsigned (&b)[16]) {
#pragma unroll
    for (int i = 0; i < 16; ++i) a[i] = a[i] > b[15 - i] ? a[i] : b[15 - i];
    rt_merge16(a);
}
__device__ __forceinline__ void rt_top16_partner(unsigned (&a)[16]) {
    unsigned b[16];
#pragma unroll
    for (int i = 0; i < 16; ++i) b[i] = (unsigned)__shfl_xor((int)a[i], 32);
    rt_top16(a, b);
}
__device__ __forceinline__ void rt_scores_top16(LAS unsigned char* kimg, const bf16* __restrict__ qp, int r, int h, unsigned (&k0)[16]) {
    f32x16 acc[4];
#pragma unroll
    for (int kt = 0; kt < 4; ++kt)
#pragma unroll
        for (int i = 0; i < 16; ++i) acc[kt][i] = 0.f;
#pragma unroll
    for (int ks = 0; ks < 8; ++ks) {
        const s16x8 qf = *(const s16x8*)(qp + 16 * ks);
#pragma unroll
        for (int kt = 0; kt < 4; ++kt) {
            const s16x8 kf = *(const LAS s16x8*)(kimg + (32 * kt + r) * RT_RS + (16 * ks + 8 * h) * 2);
            acc[kt] = __builtin_amdgcn_mfma_f32_32x32x16_bf16(kf, qf, acc[kt], 0, 0, 0);
        }
    }
    unsigned k1[16], k2[16], k3[16];
#pragma unroll
    for (int reg = 0; reg < 16; ++reg) {
        const unsigned ki = (unsigned)((reg & 3) + 8 * (reg >> 2) + 4 * h);
        k0[reg] = (rt_mono(acc[0][reg]) & 0xFFFFFF80u) | ki;
        k1[reg] = (rt_mono(acc[1][reg]) & 0xFFFFFF80u) | (ki + 32u);
        k2[reg] = (rt_mono(acc[2][reg]) & 0xFFFFFF80u) | (ki + 64u);
        k3[reg] = (rt_mono(acc[3][reg]) & 0xFFFFFF80u) | (ki + 96u);
    }
    rt_sort16(k0); rt_sort16(k1); rt_sort16(k2); rt_sort16(k3);
    rt_top16(k0, k1); rt_top16(k2, k3); rt_top16(k0, k2);
    rt_top16_partner(k0);
}
__device__ __forceinline__ void ph_peer_route2(LAS unsigned char* ldsb, const bf16* __restrict__ qhb, const float* __restrict__ keys1, const float* __restrict__ keys2,
                                               int* __restrict__ eidx, float* __restrict__ gate, const float* __restrict__ ck, const float* __restrict__ cv, float* __restrict__ out) {
    const int tid = threadIdx.x, w = __builtin_amdgcn_readfirstlane(tid >> 6), lane = tid & 63, r = lane & 31, h = lane >> 5;
    __syncthreads();
    for (int idx = tid; idx < 2 * 128 * 16; idx += NTHR) {
        const int tb = idx >> 11, rem = idx & 2047, row = rem >> 4, ch = rem & 15;
        const float* sp = (tb ? keys2 : keys1) + row * 128 + ch * 8;
        const float4 a = *(const float4*)sp, b = *(const float4*)(sp + 4);
        v4u o; o.x = pk2(a.x, a.y); o.y = pk2(a.z, a.w); o.z = pk2(b.x, b.y); o.w = pk2(b.z, b.w);
        *(LAS v4u*)(ldsb + tb * RT_KIMG + row * RT_RS + ch * 16) = o;
    }
    __syncthreads();
    LAS unsigned* lut = (LAS unsigned*)(ldsb + RT_LUT) + w * 512;
    for (int k = 0;; ++k) {
        int unit;
        if (gridDim.x != 256) { unit = blockIdx.x * NWAVE + w + k * (int)(gridDim.x * NWAVE); if (unit >= (T_ALL / 32) * 8) break; }
        else if (k < 2) unit = k * 2048 + blockIdx.x * NWAVE + w;
        else if (k == 2 && w == 0 && blockIdx.x < 128) unit = 4096 + (int)blockIdx.x;
        else break;
        const int tt = unit >> 3, hd = unit & 7;
        const int tok = 32 * tt + r;
        const bf16* qp = qhb + (size_t)tok * 2048 + hd * 256 + 8 * h;
        unsigned ka[16], kb[16];
        rt_scores_top16(ldsb, qp, r, h, ka);
        rt_scores_top16(ldsb + RT_KIMG, qp + 128, r, h, kb);
        float v1[16], v2[16];
#pragma unroll
        for (int i = 0; i < 16; ++i) { v1[i] = rt_unmono(ka[i] & 0xFFFFFF80u); v2[i] = rt_unmono(kb[i] & 0xFFFFFF80u); }
#pragma unroll
        for (int wd = 0; wd < 4; ++wd) {
            lut[wd * 64 + lane] = (ka[4 * wd] & 0x7Fu) | ((ka[4 * wd + 1] & 0x7Fu) << 8) | ((ka[4 * wd + 2] & 0x7Fu) << 16) | ((ka[4 * wd + 3] & 0x7Fu) << 24);
            lut[(4 + wd) * 64 + lane] = (kb[4 * wd] & 0x7Fu) | ((kb[4 * wd + 1] & 0x7Fu) << 8) | ((kb[4 * wd + 2] & 0x7Fu) << 16) | ((kb[4 * wd + 3] & 0x7Fu) << 24);
        }
        unsigned c0[16], c1[16];
        c0[0] = (rt_mono(h ? (v1[0] + v2[1]) : (v1[0] + v2[0])) & 0xFFFFFF00u) | (h ? 1u : 0u);
        c0[1] = (rt_mono(h ? (v1[0] + v2[3]) : (v1[0] + v2[2])) & 0xFFFFFF00u) | (h ? 3u : 2u);
        c0[2] = (rt_mono(h ? (v1[0] + v2[5]) : (v1[0] + v2[4])) & 0xFFFFFF00u) | (h ? 5u : 4u);
        c0[3] = (rt_mono(h ? (v1[0] + v2[7]) : (v1[0] + v2[6])) & 0xFFFFFF00u) | (h ? 7u : 6u);
        c0[4] = (rt_mono(h ? (v1[0] + v2[9]) : (v1[0] + v2[8])) & 0xFFFFFF00u) | (h ? 9u : 8u);
        c0[5] = (rt_mono(h ? (v1[0] + v2[11]) : (v1[0] + v2[10])) & 0xFFFFFF00u) | (h ? 11u : 10u);
        c0[6] = (rt_mono(h ? (v1[0] + v2[13]) : (v1[0] + v2[12])) & 0xFFFFFF00u) | (h ? 13u : 12u);
        c0[7] = (rt_mono(h ? (v1[0] + v2[15]) : (v1[0] + v2[14])) & 0xFFFFFF00u) | (h ? 15u : 14u);
        c0[8] = (rt_mono(h ? (v1[1] + v2[1]) : (v1[1] + v2[0])) & 0xFFFFFF00u) | (h ? 17u : 16u);
        c0[9] = (rt_mono(h ? (v1[1] + v2[3]) : (v1[1] + v2[2])) & 0xFFFFFF00u) | (h ? 19u : 18u);
        c0[10] = (rt_mono(h ? (v1[1] + v2[5]) : (v1[1] + v2[4])) & 0xFFFFFF00u) | (h ? 21u : 20u);
        c0[11] = (rt_mono(h ? (v1[1] + v2[7]) : (v1[1] + v2[6])) & 0xFFFFFF00u) | (h ? 23u : 22u);
        c0[12] = (rt_mono(h ? (v1[2] + v2[1]) : (v1[2] + v2[0])) & 0xFFFFFF00u) | (h ? 33u : 32u);
        c0[13] = (rt_mono(h ? (v1[2] + v2[3]) : (v1[2] + v2[2])) & 0xFFFFFF00u) | (h ? 35u : 34u);
        c0[14] = (rt_mono(h ? (v1[3] + v2[0]) : (v1[2] + v2[4])) & 0xFFFFFF00u) | (h ? 48u : 36u);
        c0[15] = (rt_mono(h ? (v1[3] + v2[2]) : (v1[3] + v2[1])) & 0xFFFFFF00u) | (h ? 50u : 49u);
        c1[0] = (rt_mono(h ? (v1[4] + v2[0]) : (v1[3] + v2[3])) & 0xFFFFFF00u) | (h ? 64u : 51u);
        c1[1] = (rt_mono(h ? (v1[4] + v2[2]) : (v1[4] + v2[1])) & 0xFFFFFF00u) | (h ? 66u : 65u);
        c1[2] = (rt_mono(h ? (v1[5] + v2[1]) : (v1[5] + v2[0])) & 0xFFFFFF00u) | (h ? 81u : 80u);
        c1[3] = (rt_mono(h ? (v1[6] + v2[1]) : (v1[6] + v2[0])) & 0xFFFFFF00u) | (h ? 97u : 96u);
        c1[4] = (rt_mono(h ? (v1[7] + v2[1]) : (v1[7] + v2[0])) & 0xFFFFFF00u) | (h ? 113u : 112u);
        c1[5] = (rt_mono(h ? (v1[9] + v2[0]) : (v1[8] + v2[0])) & 0xFFFFFF00u) | (h ? 144u : 128u);
        c1[6] = (rt_mono(h ? (v1[11] + v2[0]) : (v1[10] + v2[0])) & 0xFFFFFF00u) | (h ? 176u : 160u);
        c1[7] = (rt_mono(h ? (v1[13] + v2[0]) : (v1[12] + v2[0])) & 0xFFFFFF00u) | (h ? 208u : 192u);
        c1[8] = (rt_mono(h ? (v1[15] + v2[0]) : (v1[14] + v2[0])) & 0xFFFFFF00u) | (h ? 240u : 224u);
        c1[9] = 0u;
        c1[10] = 0u;
        c1[11] = 0u;
        c1[12] = 0u;
        c1[13] = 0u;
        c1[14] = 0u;
        c1[15] = 0u;
        rt_sort16(c0); rt_sort16(c1); rt_top16(c0, c1); rt_top16_partner(c0);
        float e[16]; float sum = 0.f;
        const float mx = rt_unmono(c0[0] & 0xFFFFFF00u);
#pragma unroll
        for (int k = 0; k < 16; ++k) { e[k] = __expf(rt_unmono(c0[k] & 0xFFFFFF00u) - mx); sum += e[k]; }
        const float inv = 1.0f / sum;
        asm volatile("s_waitcnt lgkmcnt(0)" ::: "memory");
        int ex[8]; float gv[8];
#pragma unroll
        for (int k = 0; k < 8; ++k) {
            const unsigned hm = (unsigned)(-h);
            const unsigned ck = (c0[k] & ~hm) | (c0[8 + k] & hm);
            const float ek = __builtin_bit_cast(float, (__builtin_bit_cast(unsigned, e[k]) & ~hm) | (__builtin_bit_cast(unsigned, e[8 + k]) & hm));
            const unsigned ci = (ck >> 4) & 15u, cj = ck & 15u;
            const unsigned w1 = lut[(ci >> 2) * 64 + lane], w2 = lut[(4 + (cj >> 2)) * 64 + lane];
            const unsigned i1 = (w1 >> (8 * (ci & 3))) & 0x7Fu, i2 = (w2 >> (8 * (cj & 3))) & 0x7Fu;
            ex[k] = (int)(i1 * PEER_NKEYS + i2); gv[k] = ek * inv;
        }
        int* ep = eidx + (size_t)tok * 128 + hd * 16 + 8 * h; float* gp = gate + (size_t)tok * 128 + hd * 16 + 8 * h;
        *(int4*)ep = make_int4(ex[0], ex[1], ex[2], ex[3]); *(int4*)(ep + 4) = make_int4(ex[4], ex[5], ex[6], ex[7]);
        *(float4*)gp = make_float4(gv[0], gv[1], gv[2], gv[3]); *(float4*)(gp + 4) = make_float4(gv[4], gv[5], gv[6], gv[7]);
    }
    if (gridDim.x == 256 && (w != 0 || blockIdx.x >= 128)) {
        const unsigned si = blockIdx.x < 128 ? blockIdx.x * 7u + (unsigned)(w - 1) : 896u + (blockIdx.x - 128u) * 8u + (unsigned)w;
        cache_copy_slice(ck, cv, out, 7040u + si, (unsigned)lane);
    }
}

struct Params {
    const float* in[23];
    float* out;
    unsigned char* ws;
    unsigned* bar;
};

#define WS_BAR      0ull
#define WS_XALL     (1ull << 20)
#define WS_PROJ     (WS_XALL + (size_t)T_ALL * D_MODEL * 4)
#define WS_XBC      (WS_PROJ + (size_t)T_ALL * PROJ_LD * 4)
#define WS_DT       (WS_XBC + (size_t)T_ALL * CONV_DIM * 4)
#define WS_QROT     (WS_DT + (size_t)T_ALL * SSD_HEADS * 4)
#define WS_KROT     (WS_QROT + (size_t)T_ALL * ATT_WIDTH * 4)
#define WS_YBUF     (WS_KROT + (size_t)T_ALL * ATT_WIDTH * 4)
#define WS_MIX      (WS_YBUF + (size_t)T_ALL * MIX_WIDTH * 4)
#define WS_HBUF     (WS_MIX + (size_t)T_ALL * D_MODEL * 4)
#define WS_QH       (WS_HBUF + (size_t)T_ALL * D_MODEL * 4)
#define WS_EIDX     (WS_QH + (size_t)T_ALL * 2048 * 4)
#define WS_GATE     (WS_EIDX + (size_t)T_ALL * 128 * 4)
#define WS_A0       (WS_GATE + (size_t)T_ALL * 128 * 4)
#define WS_A1       (WS_A0 + (size_t)T_ALL * D_MODEL * 2)
#define WS_A2       (WS_A1 + (size_t)T_ALL * MIX_WIDTH * 2)
#define WS_WTIN     (WS_A2 + (size_t)T_ALL * D_MODEL * 2)
#define WS_WTOUT    (WS_WTIN + (size_t)PROJ_LD * D_MODEL * 2)
#define WS_WTQ      (WS_WTOUT + (size_t)D_MODEL * MIX_WIDTH * 2)
#define WS_PROJB    (WS_WTQ + (size_t)2048 * D_MODEL * 2)
#define WS_DTRAW    (WS_PROJB + (size_t)T_ALL * NB_LD * 2)
#define WS_XBCB     (WS_DTRAW + (size_t)T_ALL * 32 * 4)
#define WS_QROTB    (WS_XBCB + (size_t)T_ALL * CONV_DIM * 2)
#define WS_KROTB    (WS_QROTB + (size_t)T_ALL * ATT_WIDTH * 2)
#define WS_UB       (WS_KROTB + (size_t)T_ALL * ATT_WIDTH * 2)
#define WS_VB       (WS_UB + (size_t)16384 * D_MODEL * 2)
#define WS_USC      (WS_VB + (size_t)16384 * D_MODEL * 2)
#define WS_VSC      (WS_USC + 16384 * 4)
#define WS_SBUF     (WS_VSC + 16384 * 4)
#define WS_HIN      (WS_SBUF + (size_t)BATCH * 64 * SSD_HEADS * 64 * 128 * 2)
#define WS_CDEC     (WS_HIN + (size_t)BATCH * 64 * SSD_HEADS * 64 * 128 * 2)
#define WS_OBUF     (WS_CDEC + (size_t)BATCH * 64 * SSD_HEADS * 4)
#define WS_LSE      (WS_OBUF + (size_t)3 * T_PROMPT * ATT_WIDTH * 2)
#define WS_ROPE     (WS_LSE + (size_t)3 * T_PROMPT * 8 * 4)
#define WS_END      (WS_ROPE + (size_t)SEQ * 64 * 4)

#define LDS_BYTES (160 * 1024)

#define KP const __attribute__((address_space(4))) Params* kp = (const __attribute__((address_space(4))) Params*)__builtin_amdgcn_kernarg_segment_ptr(); asm volatile("" : "+s"(kp)); unsigned char* ws = kp->ws; (void)ws;
#define IN(i) (kp->in[i])
#define WSP(T, off) ((T*)(ws + (off)))
__global__ void __launch_bounds__(512, 2) mega_fwd(Params p) {
    extern __shared__ __attribute__((aligned(16))) unsigned char smem[];
    if (threadIdx.x == 0) *(uint4*)smem = make_uint4(0u, 0u, 0u, 0u);
    __syncthreads();
    XcdBarrier bar = xcd_barrier_post(p.bar, (volatile LAS unsigned*)smem);
    float* lds = (float*)(smem + 256);
    LAS unsigned char* ldsb = (LAS unsigned char*)smem + 256;

    { KP ph_prologue(ldsb, IN(0), IN(1), WSP(bf16, WS_A0), IN(6), WSP(bf16, WS_WTIN), WSP(float, WS_ROPE)); }
    xcd_barrier(bar);
    { KP pg8::Gemm g{WSP(bf16, WS_A0), WSP(bf16, WS_WTIN), T_ALL, PROJ_LD, D_MODEL}; pg8::StaticOrder S; S.init(g.M, g.N, (int)gridDim.x, (int)blockIdx.x);
      pg8::EpiProj E{WSP(bf16, WS_PROJB), WSP(float, WS_DTRAW)}; pg8::gemm_phase<pg8::EpiProj, pg8::StaticOrder, false>(ldsb, g, S, E, nullptr); }
    xcd_barrier(bar);
    { KP ph_post_proj_prompt(WSP(bf16, WS_PROJB), WSP(float, WS_DTRAW), IN(7), IN(8), IN(9), WSP(float, WS_ROPE), WSP(bf16, WS_XBCB), WSP(float, WS_DT), WSP(bf16, WS_QROTB), WSP(bf16, WS_KROTB), kp->out); }
    { KP ph_post_proj2(WSP(bf16, WS_PROJB), WSP(float, WS_DTRAW), IN(4), IN(7), IN(8), IN(9), WSP(bf16, WS_XBCB), WSP(float, WS_DT), WSP(bf16, WS_QROTB), WSP(bf16, WS_KROTB), kp->out); }
    xcd_barrier(bar);
    { KP ph_ssd_states(ldsb, WSP(bf16, WS_XBCB), WSP(float, WS_DT), IN(10), WSP(bf16, WS_SBUF), WSP(float, WS_CDEC), IN(2), IN(3), kp->out); }
    __syncthreads();
    { KP ph_attn_prompt(ldsb, WSP(bf16, WS_QROTB), WSP(bf16, WS_KROTB), WSP(bf16, WS_PROJB), WSP(bf16, WS_OBUF), WSP(float, WS_LSE), IN(2), IN(3), kp->out); }
    __syncthreads();
    { KP ph_ssd_decode(WSP(bf16, WS_XBCB), WSP(float, WS_DT), IN(10), IN(11), IN(5), WSP(float, WS_YBUF), kp->out); }
    { KP ph_attn_sample3(lds, WSP(bf16, WS_QROTB), WSP(bf16, WS_KROTB), WSP(bf16, WS_PROJB), IN(2), IN(3), WSP(bf16, WS_A1)); }
    xcd_barrier(bar);
    if ((int)gridDim.x > 128) {
        if ((int)blockIdx.x < 96) { KP ph_ssd_scan(WSP(bf16, WS_SBUF), WSP(float, WS_CDEC), WSP(bf16, WS_HIN), kp->out, (int)blockIdx.x, 96); }
        else {
            { KP ph_prologue2(ldsb, IN(13), WSP(bf16, WS_WTOUT), IN(16), WSP(bf16, WS_WTQ), (int)blockIdx.x - 96, (int)gridDim.x - 96); }
            { KP ph_quant_tables(IN(19), IN(20), WSP(unsigned char, WS_UB), WSP(unsigned char, WS_VB), WSP(float, WS_USC), WSP(float, WS_VSC), (int)blockIdx.x - 96, (int)gridDim.x - 96); }
        }
    } else {
        { KP ph_ssd_scan(WSP(bf16, WS_SBUF), WSP(float, WS_CDEC), WSP(bf16, WS_HIN), kp->out, (int)blockIdx.x, (int)gridDim.x); }
        { KP ph_prologue2(ldsb, IN(13), WSP(bf16, WS_WTOUT), IN(16), WSP(bf16, WS_WTQ), (int)blockIdx.x, (int)gridDim.x); }
        { KP ph_quant_tables(IN(19), IN(20), WSP(unsigned char, WS_UB), WSP(unsigned char, WS_VB), WSP(float, WS_USC), WSP(float, WS_VSC), (int)blockIdx.x, (int)gridDim.x); }
    }
    xcd_barrier(bar);
    { KP ph_ssd_out(ldsb, WSP(bf16, WS_XBCB), WSP(bf16, WS_PROJB), WSP(float, WS_DT), IN(10), IN(11), IN(12), WSP(bf16, WS_HIN), WSP(bf16, WS_A1)); }
    { KP ph_attn_combine(WSP(bf16, WS_OBUF), WSP(float, WS_LSE), WSP(bf16, WS_A1)); }
    { KP ph_gate_norm(WSP(bf16, WS_PROJB), IN(12), WSP(float, WS_YBUF), WSP(bf16, WS_A1)); }
    xcd_barrier(bar);
    { KP pg8::Gemm g{WSP(bf16, WS_A1), WSP(bf16, WS_WTOUT), T_ALL, D_MODEL, MIX_WIDTH}; pg8::StaticOrder S; S.init(g.M, g.N, (int)gridDim.x, (int)blockIdx.x);
      pg8::EpiBf16Plain E{WSP(bf16, WS_MIX), D_MODEL}; pg8::gemm_phase<pg8::EpiBf16Plain, pg8::StaticOrder, false>(ldsb, g, S, E, nullptr); }
    if (blockIdx.x >= 8 && gridDim.x == 256) { KP cache_copy_slice(IN(2), IN(3), kp->out, 4096u + (blockIdx.x - 8) * 8u + (threadIdx.x >> 6), threadIdx.x & 63u); }
    xcd_barrier(bar);
    { KP ph_ln_res(IN(0), IN(1), WSP(bf16, WS_MIX), IN(14), IN(15), WSP(bf16, WS_A2)); }
    xcd_barrier(bar);
    { KP pg8::Gemm g{WSP(bf16, WS_A2), WSP(bf16, WS_WTQ), T_ALL, 2048, D_MODEL}; pg8::StaticOrder S; S.init(g.M, g.N, (int)gridDim.x, (int)blockIdx.x);
      pg8::EpiBf16Plain E{WSP(bf16, WS_QH), 2048}; pg8::gemm_phase<pg8::EpiBf16Plain, pg8::StaticOrder, false>(ldsb, g, S, E, nullptr); }
    if (blockIdx.x >= 16 && gridDim.x == 256 && threadIdx.x < 256) { KP cache_copy_slice(IN(2), IN(3), kp->out, 4096u + 1984u + (blockIdx.x - 16) * 4u + (threadIdx.x >> 6), threadIdx.x & 63u); }
    xcd_barrier(bar);
    { KP ph_peer_route2(ldsb, WSP(bf16, WS_QH), IN(17), IN(18), WSP(int, WS_EIDX), WSP(float, WS_GATE), IN(2), IN(3), kp->out); }
    xcd_barrier(bar);
    { KP ph_peer_ffn3(WSP(bf16, WS_A2), WSP(int, WS_EIDX), WSP(float, WS_GATE), WSP(unsigned char, WS_UB), WSP(unsigned char, WS_VB), WSP(float, WS_USC), WSP(float, WS_VSC), IN(21), IN(22), kp->out, IN(2), IN(3), gridDim.x == 256 ? 8960u : 4096u); }
}

extern "C" void kernel_launch(void* const* d_in, const int* in_sizes, int n_in, void* d_out, int out_size, void* d_ws, size_t ws_size, hipStream_t stream) {
    static int grid = 0;
    if (grid == 0) {
        int dev = 0, cus = 0, per_cu = 0;
        if (hipGetDevice(&dev) != hipSuccess || hipDeviceGetAttribute(&cus, hipDeviceAttributeMultiprocessorCount, dev) != hipSuccess) { fprintf(stderr, "kernel_launch: device query failed\n"); grid = -1; return; }
        if (hipFuncSetAttribute((const void*)mega_fwd, hipFuncAttributeMaxDynamicSharedMemorySize, LDS_BYTES) != hipSuccess) { fprintf(stderr, "kernel_launch: hipFuncSetAttribute failed\n"); grid = -1; return; }
        if (hipOccupancyMaxActiveBlocksPerMultiprocessor(&per_cu, (const void*)mega_fwd, NTHR, LDS_BYTES) != hipSuccess || per_cu < 1) { fprintf(stderr, "kernel_launch: occupancy query says %d\n", per_cu); }
        (void)hipGetLastError();
        grid = cus;
        if (ws_size < WS_END) { fprintf(stderr, "kernel_launch: workspace too small\n"); grid = -1; return; }
    }
    if (grid < 0) return;
    (void)hipMemsetAsync((char*)d_ws + WS_BAR, 0, XCD_BAR_WORDS * sizeof(unsigned), stream);
    Params p{};
    for (int i = 0; i < 23; ++i) p.in[i] = (const float*)d_in[i];
    p.out = (float*)d_out; p.ws = (unsigned char*)d_ws; p.bar = (unsigned*)((char*)d_ws + WS_BAR);
    hipLaunchKernelGGL(mega_fwd, dim3(grid), dim3(NTHR), LDS_BYTES, stream, p);
}
```

```cpp
#include <hip/hip_runtime.h>
#include <stdint.h>

#define D_MODEL 1024
#define BATCH 2
#define SEQ 8192
#define DEC_BATCH 128
#define DEC_SEQ 4
#define PAST_LEN 8192
#define HEAD_DIM 64
#define ATT_WIDTH 512
#define ATT_HEADS 8
#define SSD_WIDTH 1536
#define SSD_HEADS 24
#define SSD_GROUPS 4
#define SSD_STATE 128
#define CONV_DIM 2560
#define IN_WIDTH 5656
#define PROJ_LD 5888
#define MIX_WIDTH 2048
#define WBUF 2048
#define PEER_NKEYS 128
#define PEER_HEADS 8
#define PEER_TOPK 16
#define PEER_DKEY 256
#define T_PROMPT (BATCH * SEQ)
#define T_SAMPLE (DEC_BATCH * DEC_SEQ)
#define T_ALL (T_PROMPT + T_SAMPLE)
#define O_Z 0
#define O_XBC 1536
#define O_DT 4096
#define O_Q 4120
#define O_K 4632
#define O_V 5144
#define ALPHA_F 1.189207115002721f
#define LN_EPS 1e-5f

#define OUT_YP 0ull
#define OUT_YS (OUT_YP + 16777216ull)
#define OUT_PK (OUT_YS + 524288ull)
#define OUT_PV (OUT_PK + 2097152ull)
#define OUT_PC (OUT_PV + 2097152ull)
#define OUT_PS (OUT_PC + 15360ull)
#define OUT_SK (OUT_PS + 393216ull)
#define OUT_SV (OUT_SK + 134217728ull)
#define OUT_SC (OUT_SV + 134217728ull)
#define OUT_SS (OUT_SC + 983040ull)

__constant__ double ROPE_INV_REV[32] = {
    1.59154943091895346e-01, 1.19349370211248862e-01, 8.94994016088910133e-02, 6.71150830052272551e-02,
    5.03292121044870353e-02, 3.77415847174197711e-02, 2.83021958306233987e-02, 2.12236527647776604e-02,
    1.59154943091895339e-02, 1.19349370211248862e-02, 8.94994016088910237e-03, 6.71150830052272534e-03,
    5.03292121044870370e-03, 3.77415847174197719e-03, 2.83021958306233987e-03, 2.12236527647776622e-03,
    1.59154943091895356e-03, 1.19349370211248849e-03, 8.94994016088910237e-04, 6.71150830052272599e-04,
    5.03292121044870326e-04, 3.77415847174197741e-04, 2.83021958306233954e-04, 2.12236527647776605e-04,
    1.59154943091895351e-04, 1.19349370211248862e-04, 8.94994016088910182e-05, 6.71150830052272545e-05,
    5.03292121044870354e-05, 3.77415847174197768e-05, 2.83021958306233961e-05, 2.12236527647776592e-05
};

__device__ __forceinline__ float silu_f(float x) { return x * __builtin_amdgcn_rcpf(1.0f + __expf(-x)); }
__device__ __forceinline__ float softplus_f(float x) { return fmaxf(x, 0.f) + log1pf(__expf(-fabsf(x))); }
__device__ __forceinline__ float gelu_f(float x) { return 0.5f * x * (1.0f + erff(x * 0.70710678118654752f)); }
__device__ __forceinline__ float wave_sum(float v) {
#pragma unroll
    for (int o = 32; o > 0; o >>= 1) v += __shfl_xor(v, o);
    return v;
}
__device__ __forceinline__ float wave_max(float v) {
#pragma unroll
    for (int o = 32; o > 0; o >>= 1) v = fmaxf(v, __shfl_xor(v, o));
    return v;
}

#include <cstdio>
#define XB_TMO      128
#define XB_XCNT(j)  (256  + 64 * (j))
#define XB_XSUB(j)  (1280 + 64 * (j))
#define XB_XGEN(j)  (2304 + 64 * (j))
#define XB_TOP      3328
#define XB_TOPGEN   3392
#define XCD_BAR_WORDS 3456
#define XB_SPIN_CAP (1u << 18)
#define LAS __attribute__((address_space(3)))

__device__ __forceinline__ unsigned xb_ld(unsigned* p)              { return __hip_atomic_load(p, __ATOMIC_RELAXED, __HIP_MEMORY_SCOPE_AGENT); }
__device__ __forceinline__ unsigned xb_add(unsigned* p, unsigned v) { return __hip_atomic_fetch_add(p, v, __ATOMIC_RELAXED, __HIP_MEMORY_SCOPE_AGENT); }
__device__ __forceinline__ unsigned xb_xcc_id() { return (unsigned)__builtin_amdgcn_s_getreg((3 << 11) | 20) & 0xFu; }
#define XB_SPIN(cond, bar) do { unsigned _sp = 0; while (cond) { __builtin_amdgcn_s_sleep(1); \
    if ((++_sp & 255u) == 0u) { if (xb_ld(&(bar)[XB_TMO])) break; if (_sp > XB_SPIN_CAP) { atomicAdd(&(bar)[XB_TMO], 1u); break; } } } } while (0)

struct XcdBarrier {
    unsigned* bar; unsigned x;
    volatile LAS unsigned* st;
};

__device__ __forceinline__ XcdBarrier xcd_barrier_post(unsigned* bar, volatile LAS unsigned* st) {
    XcdBarrier b; b.bar = bar; b.x = xb_xcc_id(); b.st = st;
    if (threadIdx.x == 0) (void)xb_add(&bar[XB_XCNT(b.x)], 1u);
    return b;
}
__device__ __forceinline__ void xcd_barrier_complete(unsigned* bar, unsigned x, unsigned& nloc, unsigned& nx) {
    const unsigned G = gridDim.x * gridDim.y * gridDim.z;
    unsigned sum, cnt, mine, sp = 0u;
    for (;;) {
        sum = 0u; cnt = 0u; mine = 0u;
#pragma unroll
        for (unsigned j = 0; j < 16; ++j) { const unsigned c = xb_ld(&bar[XB_XCNT(j)]); sum += c; cnt += (c > 0u) ? 1u : 0u; mine = (j == x) ? c : mine; }
        if (sum == G) break;
        __builtin_amdgcn_s_sleep(1);
        if ((++sp & 255u) == 0u) { if (xb_ld(&bar[XB_TMO])) break; if (sp > XB_SPIN_CAP) { atomicAdd(&bar[XB_TMO], 1u); break; } }
    }
    nloc = mine > 0u ? mine : 1u; nx = cnt > 0u ? cnt : 1u;
}

__device__ __forceinline__ void xcd_barrier(const XcdBarrier& b) {
    asm volatile("s_waitcnt vmcnt(0)" ::: "memory");
    __syncthreads();
    if (threadIdx.x == 0) {
        unsigned* bar = b.bar;
        __builtin_amdgcn_s_waitcnt(0);
        unsigned nloc = b.st[0], nx = b.st[1];
        if (nloc == 0u) { xcd_barrier_complete(bar, b.x, nloc, nx); b.st[0] = nloc; b.st[1] = nx; }
        const unsigned old = xb_add(&bar[XB_XSUB(b.x)], 1u);
        const unsigned gen = old / nloc;
        if (old + 1u == (gen + 1u) * nloc) {
            __builtin_amdgcn_fence(__ATOMIC_RELEASE, "agent");
            asm volatile("s_waitcnt vmcnt(0)" ::: "memory");
            const unsigned og = xb_add(&bar[XB_TOP], 1u);
            const unsigned tg = og / nx;
            if (og + 1u == (tg + 1u) * nx) xb_add(&bar[XB_TOPGEN], 1u);
            else XB_SPIN(xb_ld(&bar[XB_TOPGEN]) == tg, bar);
            __builtin_amdgcn_fence(__ATOMIC_ACQUIRE, "agent");
            xb_add(&bar[XB_XGEN(b.x)], 1u);
            asm volatile("s_waitcnt vmcnt(0)" ::: "memory");
        } else {
            XB_SPIN(xb_ld(&bar[XB_XGEN(b.x)]) == gen, bar);
            __builtin_amdgcn_fence(__ATOMIC_ACQUIRE, "agent");
            asm volatile("s_waitcnt vmcnt(0)" ::: "memory");
        }
    }
    __syncthreads();
}


#define GAS __attribute__((address_space(1)))
typedef unsigned short bf16;
typedef unsigned v4u __attribute__((ext_vector_type(4)));
#define LDS_WAIT() asm volatile("s_waitcnt lgkmcnt(0)" ::: "memory")
__device__ __forceinline__ unsigned f2bf(float f) { unsigned u = __builtin_bit_cast(unsigned, f); return (u + 0x7fffu + ((u >> 16) & 1u)) >> 16; }
__device__ __forceinline__ unsigned pk2(float lo, float hi) { return f2bf(lo) | (f2bf(hi) << 16); }
__device__ __forceinline__ float bf2f(unsigned short b) { return __builtin_bit_cast(float, (unsigned)b << 16); }
#include <hip/hip_runtime.h>
namespace pg8 {
#define PG8_LAS __attribute__((address_space(3)))
typedef unsigned short bf16_t;
typedef short bf16x8 __attribute__((ext_vector_type(8)));
typedef float f32x4 __attribute__((ext_vector_type(4)));
typedef unsigned u32x4 __attribute__((ext_vector_type(4)));
constexpr int BM = 256, BK = 64, HALF = 128, HTB = HALF * BK * 2  , STAGE_BYTES = 8 * HTB, NXCD = 8, WGM = 8;

__host__ __device__ __forceinline__ int lds_byte(int r, int c) { const int st = (r >> 4) * 2 + (c >> 5), rr = r & 15, cc = c & 31, ob = rr * 64 + cc * 2; return st * 1024 + (ob ^ (((ob >> 9) & 1) << 5)); }
__host__ __device__ __forceinline__ void stage_rc(int b, int& R, int& C) { const int st = b / 1024, sb = b % 1024, swz = sb ^ (((sb >> 9) & 1) << 5); R = (st >> 1) * 16 + swz / 64; C = (st & 1) * 32 + (swz % 64) / 2; }
__host__ __device__ __forceinline__ int perm32(int rho) { const int n = rho >> 4, i = rho & 15; return 8 * (i >> 2) + 4 * n + (i & 3); }

struct Unit { int pm, pn; };
struct Gemm { const bf16_t* A; const bf16_t* Bt; int M, N, K; };

struct StaticOrder {
    int nM, nN, nwg, G, c;
    __host__ __device__ void init(int M, int N, int G_, int c_) { nM = M / BM; nN = N / BM; nwg = nM * nN; G = G_; c = c_; }
    __host__ __device__ bool next(int i, Unit& u) const {
        const long L = (long)i * G + c; if (L >= nwg) return false;
        int wgid = (int)L; { const int q = nwg / NXCD, r = nwg % NXCD, xcd = wgid % NXCD, off = wgid / NXCD; wgid = (xcd < r ? xcd * (q + 1) : r * (q + 1) + (xcd - r) * q) + off; }
        const int nig = WGM * nN, gid = wgid / nig, fm = gid * WGM, gsz = (nM - fm) < WGM ? (nM - fm) : WGM;
        u.pm = fm + ((wgid % nig) % gsz); u.pn = (wgid % nig) / gsz; return true;
    }
    __device__ __forceinline__ void a_ready(const Unit&) const {}
    __device__ __forceinline__ void done(const Unit&) const {}
};
__device__ __forceinline__ unsigned cvt_pk_bf16(float lo, float hi) { unsigned r; asm volatile("v_cvt_pk_bf16_f32 %0, %1, %2" : "=v"(r) : "v"(lo), "v"(hi)); return r; }
typedef float f32x2 __attribute__((ext_vector_type(2)));
__device__ __forceinline__ f32x2 gelu_pk(f32x2 v) {
    const f32x2 av = __builtin_elementwise_abs(v), d = av * 0.2316418882f + 1.0f;
    f32x2 t; t.x = __builtin_amdgcn_rcpf(d.x); t.y = __builtin_amdgcn_rcpf(d.y);
    f32x2 q = t * 0.5307027145f + (-0.7265760135f); q = q * t + 0.7107068705f; q = q * t + (-0.142248368f); q = q * t + 0.127414796f; q = q * t;
    const f32x2 s = (v * v) * (-0.72134752044f);
    f32x2 e; e.x = __builtin_amdgcn_exp2f(s.x); e.y = __builtin_amdgcn_exp2f(s.y);
    const f32x2 m = v * (q * e), r = v - m;
    f32x2 o; o.x = v.x < 0.f ? m.x : r.x; o.y = v.y < 0.f ? m.y : r.y; return o;
}

struct EpiF32 {
    static constexpr bool PERM = false, AFTER_DRAIN = false;
    float* C; int ldc; const float* bias;
    __device__ __forceinline__ void operator()(const f32x4 (&acc)[2][2][4][2], const Unit& u, int wr, int wc, int fr, int fq) const {
        const int row0 = u.pm * BM + wr * 64 + fr, col0 = u.pn * BM + wc * 32 + 4 * fq;
        f32x4 bv[2][2];
#pragma unroll
        for (int bj = 0; bj < 2; ++bj)
#pragma unroll
            for (int n = 0; n < 2; ++n) bv[bj][n] = bias ? *(const f32x4*)(bias + col0 + bj * HALF + n * 16) : (f32x4){0.f, 0.f, 0.f, 0.f};
#pragma unroll
        for (int ai = 0; ai < 2; ++ai)
#pragma unroll
            for (int m = 0; m < 4; ++m) { float* rowp = C + (size_t)(row0 + ai * HALF + m * 16) * ldc + col0;
#pragma unroll
                for (int bj = 0; bj < 2; ++bj)
#pragma unroll
                    for (int n = 0; n < 2; ++n) *(f32x4*)(rowp + bj * HALF + n * 16) = acc[ai][bj][m][n] + bv[bj][n]; }
    }
};

template <class Epi, class Sched, bool STAMP = false>
__device__ __forceinline__ void gemm_phase(PG8_LAS unsigned char* lds, const Gemm g, const Sched& S, const Epi& E, unsigned long long* stamps) {
    int tid = threadIdx.x; asm volatile("" : "+v"(tid));
    const int wid = __builtin_amdgcn_readfirstlane(tid >> 6), lane = tid & 63, wr = wid >> 2, wc = wid & 3, fr = lane & 15, fq = lane >> 4;
    const int K = g.K, nt = K / BK;
    int ts_lo = 0, ts_hi = 0, nts = 0; const unsigned long long rt_entry = STAMP ? (unsigned long long)wall_clock64() : 0ull;
#define PG8_STAMP() do { if (STAMP && wid == 0 && nts < 64) { const unsigned long long _c = (unsigned long long)clock64(); \
        ts_lo = (lane == nts) ? (int)(unsigned)_c : ts_lo; ts_hi = (lane == nts) ? (int)(unsigned)(_c >> 32) : ts_hi; ++nts; } } while (0)
    PG8_STAMP();
    unsigned voffA[2], voffB[2];
#pragma unroll
    for (int i = 0; i < 2; ++i) { int R, C; stage_rc(tid * 16 + i * 8192, R, C); const int Rb = Epi::PERM ? ((R & ~31) + perm32(R & 31)) : R;
        voffA[i] = (unsigned)(R * K + C) * 2u; voffB[i] = (unsigned)(Rb * K + C) * 2u; }
    const size_t kstep = (size_t)(BK * 2);
    const size_t hstep = (size_t)HALF * K * 2;
    const size_t tstep = 2 * hstep;
    const unsigned ldsw = (unsigned)wid * 1024u;
    const int aoff = lds_byte(wr * 64 + fr, fq * 8), boff = lds_byte(wc * 32 + fr, fq * 8);
#define PG8_SA(b, h) (((b) * 2 + (h)) * HTB)
#define PG8_SB(b, h) ((4 + (b) * 2 + (h)) * HTB)
#define PG8_STAGE(bufoff, gbase, voff) do { _Pragma("unroll") for (int _i = 0; _i < 2; ++_i) \
        __builtin_amdgcn_global_load_lds((const unsigned*)((const char*)(gbase) + (voff)[_i]), (PG8_LAS unsigned*)(lds + (bufoff) + ldsw + _i * 8192), 16, 0, 0); } while (0)
#define PG8_LDA(dst, b, h) do { _Pragma("unroll") for (int m = 0; m < 4; ++m) _Pragma("unroll") for (int k = 0; k < 2; ++k) dst[m][k] = *(const PG8_LAS bf16x8*)(lds + PG8_SA(b, h) + aoff + m * 2048 + k * 1024); } while (0)
#define PG8_LDB(dst, b, h) do { _Pragma("unroll") for (int n = 0; n < 2; ++n) _Pragma("unroll") for (int k = 0; k < 2; ++k) dst[n][k] = *(const PG8_LAS bf16x8*)(lds + PG8_SB(b, h) + boff + n * 2048 + k * 1024); } while (0)
#define PG8_MMA(ai, bj, At, Bt) do { __builtin_amdgcn_s_setprio(1); _Pragma("unroll") for (int m = 0; m < 4; ++m) _Pragma("unroll") for (int n = 0; n < 2; ++n) _Pragma("unroll") for (int k = 0; k < 2; ++k) \
        acc[ai][bj][m][n] = __builtin_amdgcn_mfma_f32_16x16x32_bf16(Bt[n][k], At[m][k], acc[ai][bj][m][n], 0, 0, 0); __builtin_amdgcn_s_setprio(0); } while (0)
#define PG8_WAIT_V(n) asm volatile("s_waitcnt vmcnt(" #n ")" ::: "memory")
#define PG8_WAIT_L(n) asm volatile("s_waitcnt lgkmcnt(" #n ")" ::: "memory")
#define PG8_BAR __builtin_amdgcn_s_barrier()
#define PG8_SCHED __builtin_amdgcn_sched_barrier(0)
    Unit cur, nxt; int ui = 0;
    if (!S.next(0, cur)) return;
    f32x4 acc[2][2][4][2];
#pragma unroll
    for (int a = 0; a < 2; ++a)
#pragma unroll
        for (int b = 0; b < 2; ++b)
#pragma unroll
            for (int m = 0; m < 4; ++m)
#pragma unroll
                for (int n = 0; n < 2; ++n) acc[a][b][m][n] = (f32x4){0.f, 0.f, 0.f, 0.f};
    bf16x8 At[4][2], B0[2][2], B1[2][2];
    const char* cA = (const char*)g.A + (size_t)cur.pm * tstep; const char* cB = (const char*)g.Bt + (size_t)cur.pn * tstep;
    S.a_ready(cur);
    PG8_STAGE(PG8_SB(0, 0), cB, voffB); PG8_STAGE(PG8_SA(0, 0), cA, voffA); PG8_STAGE(PG8_SB(0, 1), cB + hstep, voffB); PG8_STAGE(PG8_SA(0, 1), cA + hstep, voffA);
    if (wr == 1) PG8_BAR;
    PG8_WAIT_V(4); PG8_BAR;
    PG8_STAGE(PG8_SB(1, 0), cB + kstep, voffB); PG8_STAGE(PG8_SA(1, 0), cA + kstep, voffA); PG8_STAGE(PG8_SB(1, 1), cB + hstep + kstep, voffB);
    PG8_WAIT_V(6); PG8_BAR;
    PG8_STAMP();
    for (;;) {
        const bool has_next = S.next(ui + 1, nxt);
        const char* nA = has_next ? (const char*)g.A + (size_t)nxt.pm * tstep : cA; const char* nB = has_next ? (const char*)g.Bt + (size_t)nxt.pn * tstep : cB;
        for (int t = 0; t < nt; t += 2) {
            const bool last = (t == nt - 2);
            const char* a1 = cA + (size_t)(t + 1) * kstep;
            const char* a2 = last ? nA : cA + (size_t)(t + 2) * kstep; const char* b2 = last ? nB : cB + (size_t)(t + 2) * kstep;
            const char* a3 = a2 + kstep; const char* b3 = b2 + kstep;
            if (last && has_next) S.a_ready(nxt);
            PG8_LDB(B0, 0, 0); PG8_SCHED; PG8_LDA(At, 0, 0); PG8_STAGE(PG8_SA(1, 1), a1 + hstep, voffA);
            PG8_WAIT_L(8); PG8_BAR; PG8_WAIT_L(0); PG8_MMA(0, 0, At, B0); PG8_BAR; PG8_SCHED;
            PG8_LDB(B1, 0, 1); PG8_STAGE(PG8_SB(0, 0), b2, voffB);
            PG8_BAR; PG8_WAIT_L(0); PG8_MMA(0, 1, At, B1); PG8_BAR;
            PG8_LDA(At, 0, 1); PG8_STAGE(PG8_SA(0, 0), a2, voffA);
            PG8_BAR; PG8_WAIT_L(0); PG8_MMA(1, 0, At, B0); PG8_BAR; PG8_SCHED;
            PG8_STAGE(PG8_SB(0, 1), b2 + hstep, voffB);
            PG8_WAIT_V(6); PG8_BAR; PG8_MMA(1, 1, At, B1); PG8_BAR;
            PG8_LDB(B0, 1, 0); PG8_SCHED; PG8_LDA(At, 1, 0); PG8_STAGE(PG8_SA(0, 1), a2 + hstep, voffA);
            PG8_WAIT_L(8); PG8_BAR; PG8_WAIT_L(0); PG8_MMA(0, 0, At, B0); PG8_BAR; PG8_SCHED;
            PG8_LDB(B1, 1, 1); PG8_STAGE(PG8_SB(1, 0), b3, voffB);
            PG8_BAR; PG8_WAIT_L(0); PG8_MMA(0, 1, At, B1); PG8_BAR;
            PG8_LDA(At, 1, 1); PG8_STAGE(PG8_SA(1, 0), a3, voffA);
            PG8_BAR; PG8_WAIT_L(0); PG8_MMA(1, 0, At, B0); PG8_BAR; PG8_SCHED;
            PG8_STAGE(PG8_SB(1, 1), b3 + hstep, voffB);
            PG8_WAIT_V(6); PG8_BAR; PG8_MMA(1, 1, At, B1); PG8_BAR;
        }
        PG8_STAMP();
        if constexpr (!Epi::AFTER_DRAIN) { E(acc, cur, wr, wc, fr, fq); S.done(cur); }
        PG8_STAMP();
        if (!has_next) break;
#pragma unroll
        for (int a = 0; a < 2; ++a)
#pragma unroll
            for (int b = 0; b < 2; ++b)
#pragma unroll
                for (int m = 0; m < 4; ++m)
#pragma unroll
                    for (int n = 0; n < 2; ++n) acc[a][b][m][n] = (f32x4){0.f, 0.f, 0.f, 0.f};
        cur = nxt; cA = nA; cB = nB; ++ui;
    }
    PG8_WAIT_V(0);
    if (wr == 0) PG8_BAR;
    PG8_BAR;
    if constexpr (Epi::AFTER_DRAIN) { E.fused(acc, cur, wr, wc, fr, fq, lds, wid, lane); S.done(cur); }
    PG8_STAMP();
    if (STAMP && wid == 0) { stamps[lane] = lane < nts ? (((unsigned long long)(unsigned)ts_hi << 32) | (unsigned)ts_lo) : 0ull;
        if (lane == 62) stamps[62] = rt_entry; if (lane == 63) stamps[63] = (unsigned long long)wall_clock64(); }
#undef PG8_STAMP
#undef PG8_SA
#undef PG8_SB
#undef PG8_STAGE
#undef PG8_LDA
#undef PG8_LDB
#undef PG8_MMA
#undef PG8_WAIT_V
#undef PG8_WAIT_L
#undef PG8_BAR
#undef PG8_SCHED
}
}


namespace pg8 {
struct EpiProj {
    static constexpr bool PERM = true, AFTER_DRAIN = false;
    bf16_t* O; float* dtraw;
    __device__ __forceinline__ void operator()(const f32x4 (&acc)[2][2][4][2], const Unit& u, int wr, int wc, int fr, int fq) const {
        const int row0 = u.pm * BM + wr * 64 + fr;
        if (u.pn < 22) {
            const int col0 = u.pn * BM + wc * 32 + 8 * fq;
#pragma unroll
            for (int ai = 0; ai < 2; ++ai)
#pragma unroll
                for (int m = 0; m < 4; ++m) { bf16_t* rowp = O + (size_t)(row0 + ai * HALF + m * 16) * 5632 + col0;
#pragma unroll
                    for (int bj = 0; bj < 2; ++bj) { const f32x4 v0 = acc[ai][bj][m][0], v1 = acc[ai][bj][m][1];
                        u32x4 w; w.x = cvt_pk_bf16(v0[0], v0[1]); w.y = cvt_pk_bf16(v0[2], v0[3]); w.z = cvt_pk_bf16(v1[0], v1[1]); w.w = cvt_pk_bf16(v1[2], v1[3]);
                        *(u32x4*)(rowp + bj * HALF) = w; } }
        } else if (wc == 0) {
#pragma unroll
            for (int ai = 0; ai < 2; ++ai)
#pragma unroll
                for (int m = 0; m < 4; ++m) { float* rp = dtraw + (size_t)(row0 + ai * HALF + m * 16) * 32 + 8 * fq;
                    *(f32x4*)rp = acc[ai][0][m][0]; *(f32x4*)(rp + 4) = acc[ai][0][m][1]; }
        }
    }
};
}


namespace pg8 {
struct EpiBf16Plain {
    static constexpr bool PERM = true, AFTER_DRAIN = false;
    bf16_t* O; int ldc;
    __device__ __forceinline__ void operator()(const f32x4 (&acc)[2][2][4][2], const Unit& u, int wr, int wc, int fr, int fq) const {
        const int row0 = u.pm * BM + wr * 64 + fr, col0 = u.pn * BM + wc * 32 + 8 * fq;
#pragma unroll
        for (int ai = 0; ai < 2; ++ai)
#pragma unroll
            for (int m = 0; m < 4; ++m) { bf16_t* rowp = O + (size_t)(row0 + ai * HALF + m * 16) * ldc + col0;
#pragma unroll
                for (int bj = 0; bj < 2; ++bj) { const f32x4 v0 = acc[ai][bj][m][0], v1 = acc[ai][bj][m][1];
                    u32x4 w; w.x = cvt_pk_bf16(v0[0], v0[1]); w.y = cvt_pk_bf16(v0[2], v0[3]); w.z = cvt_pk_bf16(v1[0], v1[1]); w.w = cvt_pk_bf16(v1[2], v1[3]);
                    *(u32x4*)(rowp + bj * HALF) = w; } }
    }
};
}

#define NTHR 512
#define NWAVE 8

__device__ __forceinline__ void ph_gemm_f32(float* lds, const float* __restrict__ A, const float* __restrict__ B, float* __restrict__ C,
                                            int M, int N, int K, int lda, int ldb, int ldc) {
    const int tid = threadIdx.x & 255, half = threadIdx.x >> 8, tx = tid & 15, ty = tid >> 4;
    float (*As)[68] = (float (*)[68])(lds + half * 2 * 16 * 68);
    float (*Bs)[68] = (float (*)[68])(lds + half * 2 * 16 * 68 + 16 * 68);
    const int ntx = (N + 63) / 64, nty = M / 64, ntiles = ntx * nty;
    for (int it = blockIdx.x; 2 * it < ntiles; it += gridDim.x) {
        const int tile = 2 * it + half;
        const int m0 = (tile / ntx) * 64, n0 = (tile % ntx) * 64;
        float acc[4][4];
#pragma unroll
        for (int i = 0; i < 4; ++i)
#pragma unroll
            for (int j = 0; j < 4; ++j) acc[i][j] = 0.f;
        for (int k0 = 0; k0 < K; k0 += 16) {
#pragma unroll
            for (int i = 0; i < 4; ++i) {
                int idx = tid + i * 256;
                int r = idx >> 4, c = idx & 15;
                As[c][r] = (m0 + r < M) ? A[(size_t)(m0 + r) * lda + k0 + c] : 0.f;
                int rb = idx >> 6, cb = idx & 63;
                Bs[rb][cb] = (n0 + cb < N) ? B[(size_t)(k0 + rb) * ldb + n0 + cb] : 0.f;
            }
            __syncthreads();
#pragma unroll
            for (int k = 0; k < 16; ++k) {
                float a[4], b[4];
#pragma unroll
                for (int i = 0; i < 4; ++i) { a[i] = As[k][ty * 4 + i]; b[i] = Bs[k][tx * 4 + i]; }
#pragma unroll
                for (int i = 0; i < 4; ++i)
#pragma unroll
                    for (int j = 0; j < 4; ++j) acc[i][j] += a[i] * b[j];
            }
            __syncthreads();
        }
#pragma unroll
        for (int i = 0; i < 4; ++i)
#pragma unroll
            for (int j = 0; j < 4; ++j) {
                int r = m0 + ty * 4 + i, c = n0 + tx * 4 + j;
                if (r < M && c < N) C[(size_t)r * ldc + c] = acc[i][j];
            }
    }
}


template <int MODE>
__device__ __forceinline__ void transpose_item(const float* __restrict__ W, int K, int N, int Npad, bf16* __restrict__ WT, LAS float* scr, int item, int lane) {
    const int nblk = Npad / 32, kb = item / nblk, nb = item % nblk, k0 = 64 * kb, n0 = 32 * nb;
    const int n = n0 + (lane & 31);
    int sc = n;
    if (MODE == 1) sc = (n < 4096) ? n : (n < 5632 ? n + 24 : (n < 5656 ? n - 5632 + 4096 : -1));
    else sc = (n < N) ? n : -1;
#pragma unroll 8
    for (int i = 0; i < 32; ++i) { const int kk = 2 * i + (lane >> 5); scr[kk * 33 + (lane & 31)] = (sc >= 0) ? W[(size_t)(k0 + kk) * N + sc] : 0.f; }
    LDS_WAIT(); asm volatile("" ::: "memory");
    const int c = lane & 7;
#pragma unroll
    for (int j = 0; j < 4; ++j) { const int nn = (lane >> 3) + 8 * j; const LAS float* s = scr + (8 * c) * 33 + nn;
        v4u o; o.x = pk2(s[0 * 33], s[1 * 33]); o.y = pk2(s[2 * 33], s[3 * 33]); o.z = pk2(s[4 * 33], s[5 * 33]); o.w = pk2(s[6 * 33], s[7 * 33]);
        *(v4u*)(WT + (size_t)(n0 + nn) * K + k0 + 8 * c) = o; }
    LDS_WAIT(); asm volatile("" ::: "memory");
}
__device__ __forceinline__ void ph_prologue(LAS unsigned char* ldsb, const float* __restrict__ xp, const float* __restrict__ xs, bf16* __restrict__ A0,
                                            const float* __restrict__ w_in, bf16* __restrict__ wt_in, float* __restrict__ rope_tab) {
    const int lane = threadIdx.x & 63, wave = threadIdx.x >> 6;
    LAS float* scr = (LAS float*)(ldsb + wave * 16384);
    const int gw = blockIdx.x * NWAVE + wave, NGW = gridDim.x * NWAVE;
    constexpr int I_IN = (D_MODEL / 64) * (PROJ_LD / 32);
    for (int it = gw; it < I_IN; it += NGW) transpose_item<1>(w_in, D_MODEL, IN_WIDTH, PROJ_LD, wt_in, scr, it, lane);
    for (int idx = blockIdx.x * NTHR + threadIdx.x; idx < SEQ * 32; idx += gridDim.x * NTHR) {
        const int pos = idx >> 5, j = idx & 31;
        const double rev = (double)pos * ROPE_INV_REV[j];
        const float fr = (float)(rev - floor(rev));
        rope_tab[(size_t)pos * 64 + j] = __builtin_amdgcn_cosf(fr); rope_tab[(size_t)pos * 64 + 32 + j] = __builtin_amdgcn_sinf(fr);
    }
    const size_t n8 = (size_t)T_ALL * D_MODEL / 8, np8 = (size_t)T_PROMPT * D_MODEL / 8;
#pragma unroll 4
    for (size_t i = (size_t)blockIdx.x * NTHR + threadIdx.x; i < n8; i += (size_t)gridDim.x * NTHR) {
        const float4* s = (i < np8) ? (const float4*)xp + 2 * i : (const float4*)xs + 2 * (i - np8);
        float4 a = s[0], b = s[1];
        v4u o; o.x = pk2(a.x, a.y); o.y = pk2(a.z, a.w); o.z = pk2(b.x, b.y); o.w = pk2(b.z, b.w);
        ((v4u*)A0)[i] = o;
    }
}
__device__ __forceinline__ void ph_prologue2(LAS unsigned char* ldsb, const float* __restrict__ w_out, bf16* __restrict__ wt_out, const float* __restrict__ w_q, bf16* __restrict__ wt_q,
                                             int rank, int nranks) {
    const int lane = threadIdx.x & 63, wave = threadIdx.x >> 6;
    LAS float* scr = (LAS float*)(ldsb + wave * 16384);
    constexpr int I_OUT = (MIX_WIDTH / 64) * (D_MODEL / 32), I_Q = (D_MODEL / 64) * (2048 / 32);
    for (int it = rank * NWAVE + wave; it < I_OUT + I_Q; it += nranks * NWAVE) {
        if (it < I_OUT) transpose_item<0>(w_out, MIX_WIDTH, D_MODEL, D_MODEL, wt_out, scr, it, lane);
        else transpose_item<0>(w_q, D_MODEL, 2048, 2048, wt_q, scr, it - I_OUT, lane);
    }
}

__device__ __forceinline__ void ph_concat_x(const float* __restrict__ xp, const float* __restrict__ xs, float* __restrict__ xall) {
    const size_t n4 = (size_t)T_ALL * D_MODEL / 4, np4 = (size_t)T_PROMPT * D_MODEL / 4;
    for (size_t i = (size_t)blockIdx.x * NTHR + threadIdx.x; i < n4; i += (size_t)gridDim.x * NTHR) {
        float4 v = (i < np4) ? ((const float4*)xp)[i] : ((const float4*)xs)[i - np4];
        ((float4*)xall)[i] = v;
    }
}

typedef float f32x4n __attribute__((ext_vector_type(4)));
__device__ __forceinline__ void ph_cache_copy(const float* __restrict__ ck, const float* __restrict__ cv, float* __restrict__ out) {
    constexpr unsigned PER_B = (WBUF - DEC_SEQ) * ATT_WIDTH / 4;
    constexpr unsigned TOTAL = 2u * DEC_BATCH * PER_B;
    for (unsigned c = blockIdx.x; c < TOTAL / 4096u; c += gridDim.x) {
        f32x4n v[8]; size_t dsti[8]; bool isv[8];
#pragma unroll
        for (int j = 0; j < 8; ++j) {
            const unsigned idx = c * 4096u + j * 512u + threadIdx.x;
            const unsigned tb = idx / PER_B, r = idx - tb * PER_B, bb = tb & (DEC_BATCH - 1);
            isv[j] = tb >= DEC_BATCH;
            const size_t srci = (size_t)bb * (WBUF * ATT_WIDTH / 4) + (DEC_SEQ * ATT_WIDTH / 4) + r;
            dsti[j] = (size_t)bb * (WBUF * ATT_WIDTH / 4) + r;
            v[j] = __builtin_nontemporal_load((isv[j] ? (const f32x4n*)cv : (const f32x4n*)ck) + srci);
        }
#pragma unroll
        for (int j = 0; j < 8; ++j) __builtin_nontemporal_store(v[j], (f32x4n*)(out + (isv[j] ? OUT_SV : OUT_SK)) + dsti[j]);
    }
}

__device__ __forceinline__ void ph_post_proj(const float* __restrict__ proj, const float* __restrict__ state_conv,
                                             const float* __restrict__ conv_w, const float* __restrict__ conv_b, const float* __restrict__ dt_bias,
                                             float* __restrict__ xbc_act, float* __restrict__ dtv, float* __restrict__ qrot, float* __restrict__ krot,
                                             float* __restrict__ out) {
    const int tid = threadIdx.x & 255, half = threadIdx.x >> 8;
    for (int t = 2 * blockIdx.x + half; t < T_ALL; t += 2 * gridDim.x) {
        const bool is_p = t < T_PROMPT;
        int b, i, pos;
        if (is_p) { b = t / SEQ; i = t % SEQ; pos = i; } else { int ts = t - T_PROMPT; b = ts / DEC_SEQ; i = ts % DEC_SEQ; pos = PAST_LEN + i; }
        const float* row = proj + (size_t)t * PROJ_LD;
        for (int c = tid; c < CONV_DIM; c += 256) {
            float acc = conv_b[c];
#pragma unroll
            for (int tap = 0; tap < 4; ++tap) {
                int r = i - 3 + tap;
                float val;
                if (r >= 0) val = proj[(size_t)(t - i + r) * PROJ_LD + O_XBC + c];
                else val = is_p ? 0.f : state_conv[((size_t)b * 3 + (3 + r)) * CONV_DIM + c];
                acc += val * conv_w[tap * CONV_DIM + c];
            }
            xbc_act[(size_t)t * CONV_DIM + c] = silu_f(acc);
        }
        if (tid < SSD_HEADS) dtv[(size_t)t * SSD_HEADS + tid] = softplus_f(row[O_DT + tid] + dt_bias[tid]);
        for (int idx = tid; idx < 512; idx += 256) {
            int which = idx >> 8, h = (idx >> 5) & 7, j = idx & 31;
            double rev = (double)pos * ROPE_INV_REV[j];
            float fr = (float)(rev - floor(rev));
            float sn = __builtin_amdgcn_sinf(fr), cs = __builtin_amdgcn_cosf(fr);
            const float* src = row + (which ? O_K : O_Q) + h * 64;
            float t1 = src[j], t2 = src[j + 32];
            float o1 = t1 * cs - t2 * sn, o2 = t2 * cs + t1 * sn;
            float* dst = (which ? krot : qrot) + (size_t)t * ATT_WIDTH + h * 64;
            dst[j] = o1; dst[j + 32] = o2;
            if (which) {
                if (is_p) { if (i >= SEQ - WBUF) { float* o = out + OUT_PK + ((size_t)b * WBUF + (i - (SEQ - WBUF))) * ATT_WIDTH + h * 64; o[j] = o1; o[j + 32] = o2; } }
                else { float* o = out + OUT_SK + ((size_t)b * WBUF + (WBUF - DEC_SEQ + i)) * ATT_WIDTH + h * 64; o[j] = o1; o[j + 32] = o2; }
            }
        }
        for (int c = tid; c < ATT_WIDTH; c += 256) {
            float v = row[O_V + c];
            if (is_p) { if (i >= SEQ - WBUF) out[OUT_PV + ((size_t)b * WBUF + (i - (SEQ - WBUF))) * ATT_WIDTH + c] = v; }
            else out[OUT_SV + ((size_t)b * WBUF + (WBUF - DEC_SEQ + i)) * ATT_WIDTH + c] = v;
        }
        if (is_p) {
            if (i >= SEQ - 3) { int r = i - (SEQ - 3); for (int c = tid; c < CONV_DIM; c += 256) out[OUT_PC + ((size_t)b * 3 + r) * CONV_DIM + c] = row[O_XBC + c]; }
        } else {
            if (i >= 1) { int r = i - 1; for (int c = tid; c < CONV_DIM; c += 256) out[OUT_SC + ((size_t)b * 3 + r) * CONV_DIM + c] = row[O_XBC + c]; }
        }
    }
}


#define NB_LD 5632
#define NB_XBC 1536
#define NB_Q 4096
#define NB_K 4608
#define NB_V 5120
__device__ __forceinline__ void unpack8(const v4u w, float (&f)[8]) {
    f[0] = __builtin_bit_cast(float, w.x << 16); f[1] = __builtin_bit_cast(float, w.x & 0xffff0000u);
    f[2] = __builtin_bit_cast(float, w.y << 16); f[3] = __builtin_bit_cast(float, w.y & 0xffff0000u);
    f[4] = __builtin_bit_cast(float, w.z << 16); f[5] = __builtin_bit_cast(float, w.z & 0xffff0000u);
    f[6] = __builtin_bit_cast(float, w.w << 16); f[7] = __builtin_bit_cast(float, w.w & 0xffff0000u);
}
__device__ __forceinline__ void store8f(float* d, const float (&f)[8]) { *(float4*)d = make_float4(f[0], f[1], f[2], f[3]); *(float4*)(d + 4) = make_float4(f[4], f[5], f[6], f[7]); }
__device__ __forceinline__ void ph_post_proj2(const bf16* __restrict__ projb, const float* __restrict__ dtraw, const float* __restrict__ state_conv,
                                              const float* __restrict__ conv_w, const float* __restrict__ conv_b, const float* __restrict__ dt_bias,
                                              bf16* __restrict__ xbc_b, float* __restrict__ dtv, bf16* __restrict__ qrot_b, bf16* __restrict__ krot_b,
                                              float* __restrict__ out) {
    const int tid = threadIdx.x & 255, half = threadIdx.x >> 8;
    for (int t = T_PROMPT + 2 * blockIdx.x + half; t < T_ALL; t += 2 * gridDim.x) {
        const bool is_p = t < T_PROMPT;
        int b, i, pos;
        if (is_p) { b = t / SEQ; i = t % SEQ; pos = i; } else { int ts = t - T_PROMPT; b = ts / DEC_SEQ; i = ts % DEC_SEQ; pos = PAST_LEN + i; }
        const bf16* row = projb + (size_t)t * NB_LD;
        if (tid < 64) {
            float f[8]; unpack8(*(const v4u*)(row + NB_V + tid * 8), f);
            if (is_p) { if (i >= SEQ - WBUF) store8f(out + OUT_PV + ((size_t)b * WBUF + (i - (SEQ - WBUF))) * ATT_WIDTH + tid * 8, f); }
            else store8f(out + OUT_SV + ((size_t)b * WBUF + (WBUF - DEC_SEQ + i)) * ATT_WIDTH + tid * 8, f);
        }
        for (int c8 = tid; c8 < 320; c8 += 256) {
            const int c = c8 * 8;
            float acc[8], cur[8];
            { const float4 b0 = *(const float4*)(conv_b + c), b1 = *(const float4*)(conv_b + c + 4);
              acc[0] = b0.x; acc[1] = b0.y; acc[2] = b0.z; acc[3] = b0.w; acc[4] = b1.x; acc[5] = b1.y; acc[6] = b1.z; acc[7] = b1.w; }
#pragma unroll
            for (int tap = 0; tap < 4; ++tap) {
                const int r = i - 3 + tap;
                float val[8];
                if (r >= 0) unpack8(*(const v4u*)(projb + (size_t)(t - i + r) * NB_LD + NB_XBC + c), val);
                else if (!is_p) { const float* sp = state_conv + ((size_t)b * 3 + (3 + r)) * CONV_DIM + c; const float4 s0 = *(const float4*)sp, s1 = *(const float4*)(sp + 4);
                    val[0] = s0.x; val[1] = s0.y; val[2] = s0.z; val[3] = s0.w; val[4] = s1.x; val[5] = s1.y; val[6] = s1.z; val[7] = s1.w; }
                else {
#pragma unroll
                    for (int j = 0; j < 8; ++j) val[j] = 0.f; }
                const float4 w0 = *(const float4*)(conv_w + tap * CONV_DIM + c), w1 = *(const float4*)(conv_w + tap * CONV_DIM + c + 4);
                acc[0] += val[0] * w0.x; acc[1] += val[1] * w0.y; acc[2] += val[2] * w0.z; acc[3] += val[3] * w0.w;
                acc[4] += val[4] * w1.x; acc[5] += val[5] * w1.y; acc[6] += val[6] * w1.z; acc[7] += val[7] * w1.w;
                if (tap == 3) {
#pragma unroll
                    for (int j = 0; j < 8; ++j) cur[j] = val[j]; }
            }
#pragma unroll
            for (int j = 0; j < 8; ++j) acc[j] = silu_f(acc[j]);
            v4u o; o.x = pk2(acc[0], acc[1]); o.y = pk2(acc[2], acc[3]); o.z = pk2(acc[4], acc[5]); o.w = pk2(acc[6], acc[7]);
            *(v4u*)(xbc_b + (size_t)t * CONV_DIM + c) = o;
            if (is_p) { if (i >= SEQ - 3) store8f(out + OUT_PC + ((size_t)b * 3 + (i - (SEQ - 3))) * CONV_DIM + c, cur); }
            else { if (i >= 1) store8f(out + OUT_SC + ((size_t)b * 3 + (i - 1)) * CONV_DIM + c, cur); }
        }
        if (tid < SSD_HEADS) dtv[(size_t)t * SSD_HEADS + tid] = softplus_f(dtraw[(size_t)t * 32 + tid] + dt_bias[tid]);
        if (tid < 128) {
            const int which = tid >> 6, h = (tid >> 3) & 7, jc = tid & 7;
            const bf16* src = row + (which ? NB_K : NB_Q) + h * 64 + jc * 4;
            const uint2 lo = *(const uint2*)src, hi = *(const uint2*)(src + 32);
            float t1[4], t2[4], o1[4], o2[4];
            t1[0] = __builtin_bit_cast(float, lo.x << 16); t1[1] = __builtin_bit_cast(float, lo.x & 0xffff0000u); t1[2] = __builtin_bit_cast(float, lo.y << 16); t1[3] = __builtin_bit_cast(float, lo.y & 0xffff0000u);
            t2[0] = __builtin_bit_cast(float, hi.x << 16); t2[1] = __builtin_bit_cast(float, hi.x & 0xffff0000u); t2[2] = __builtin_bit_cast(float, hi.y << 16); t2[3] = __builtin_bit_cast(float, hi.y & 0xffff0000u);
#pragma unroll
            for (int e = 0; e < 4; ++e) {
                const double rev = (double)pos * ROPE_INV_REV[jc * 4 + e];
                const float fr = (float)(rev - floor(rev));
                const float sn = __builtin_amdgcn_sinf(fr), cs = __builtin_amdgcn_cosf(fr);
                o1[e] = t1[e] * cs - t2[e] * sn; o2[e] = t2[e] * cs + t1[e] * sn;
            }
            const size_t doff = (size_t)t * ATT_WIDTH + h * 64 + jc * 4;
            bf16* db = which ? krot_b : qrot_b;
            *(uint2*)(db + doff) = make_uint2(pk2(o1[0], o1[1]), pk2(o1[2], o1[3])); *(uint2*)(db + doff + 32) = make_uint2(pk2(o2[0], o2[1]), pk2(o2[2], o2[3]));
            if (which) {
                float* o = nullptr;
                if (is_p) { if (i >= SEQ - WBUF) o = out + OUT_PK + ((size_t)b * WBUF + (i - (SEQ - WBUF))) * ATT_WIDTH + h * 64 + jc * 4; }
                else o = out + OUT_SK + ((size_t)b * WBUF + (WBUF - DEC_SEQ + i)) * ATT_WIDTH + h * 64 + jc * 4;
                if (o) { *(float4*)o = make_float4(o1[0], o1[1], o1[2], o1[3]); *(float4*)(o + 32) = make_float4(o2[0], o2[1], o2[2], o2[3]); }
            }
        }
    }
}


__device__ __forceinline__ void ph_post_proj_prompt(const bf16* __restrict__ projb, const float* __restrict__ dtraw, const float* __restrict__ conv_w, const float* __restrict__ conv_b,
                                                    const float* __restrict__ dt_bias, const float* __restrict__ rope_tab, bf16* __restrict__ xbc_b, float* __restrict__ dtv,
                                                    bf16* __restrict__ qrot_b, bf16* __restrict__ krot_b, float* __restrict__ out) {
    const int gtid = blockIdx.x * NTHR + threadIdx.x, gsz = gridDim.x * NTHR;
    for (int item = gtid; item < (T_PROMPT / 16) * 320; item += gsz) {
        const int run = item / 320, c = (item - run * 320) * 8, t0 = run * 16, i0 = t0 & (SEQ - 1), b = t0 >> 13;
        float w[4][8], bias[8];
#pragma unroll
        for (int tap = 0; tap < 4; ++tap) { const float4 w0 = *(const float4*)(conv_w + tap * CONV_DIM + c), w1 = *(const float4*)(conv_w + tap * CONV_DIM + c + 4);
            w[tap][0] = w0.x; w[tap][1] = w0.y; w[tap][2] = w0.z; w[tap][3] = w0.w; w[tap][4] = w1.x; w[tap][5] = w1.y; w[tap][6] = w1.z; w[tap][7] = w1.w; }
        { const float4 b0 = *(const float4*)(conv_b + c), b1 = *(const float4*)(conv_b + c + 4);
          bias[0] = b0.x; bias[1] = b0.y; bias[2] = b0.z; bias[3] = b0.w; bias[4] = b1.x; bias[5] = b1.y; bias[6] = b1.z; bias[7] = b1.w; }
        const bf16* src = projb + (size_t)t0 * NB_LD + NB_XBC + c;
        v4u raw[19];
#pragma unroll
        for (int s = 0; s < 19; ++s) { v4u z; z.x = 0u; z.y = 0u; z.z = 0u; z.w = 0u; raw[s] = (s >= 3 || i0 != 0) ? *(const v4u*)(src + (ptrdiff_t)(s - 3) * NB_LD) : z; }
        float p0[8], p1[8], p2[8];
        unpack8(raw[0], p0); unpack8(raw[1], p1); unpack8(raw[2], p2);
#pragma unroll
        for (int s = 0; s < 16; ++s) {
            float cur[8], acc[8]; unpack8(raw[s + 3], cur);
#pragma unroll
            for (int j = 0; j < 8; ++j) acc[j] = silu_f(bias[j] + p0[j] * w[0][j] + p1[j] * w[1][j] + p2[j] * w[2][j] + cur[j] * w[3][j]);
            v4u o; o.x = pk2(acc[0], acc[1]); o.y = pk2(acc[2], acc[3]); o.z = pk2(acc[4], acc[5]); o.w = pk2(acc[6], acc[7]);
            *(v4u*)(xbc_b + (size_t)(t0 + s) * CONV_DIM + c) = o;
            if (i0 + s >= SEQ - 3) store8f(out + OUT_PC + ((size_t)b * 3 + (i0 + s - (SEQ - 3))) * CONV_DIM + c, cur);
#pragma unroll
            for (int j = 0; j < 8; ++j) { p0[j] = p1[j]; p1[j] = p2[j]; p2[j] = cur[j]; }
        }
    }
#pragma unroll 4
    for (int item = gtid; item < T_PROMPT * 128; item += gsz) {
        const int t = item >> 7, sub = item & 127, which = sub >> 6, h = (sub >> 3) & 7, jc = sub & 7, i = t & (SEQ - 1), b = t >> 13;
        const bf16* src = projb + (size_t)t * NB_LD + (which ? NB_K : NB_Q) + h * 64 + jc * 4;
        const uint2 lo = *(const uint2*)src, hi = *(const uint2*)(src + 32);
        const float4 cs = *(const float4*)(rope_tab + (size_t)i * 64 + jc * 4), sn = *(const float4*)(rope_tab + (size_t)i * 64 + 32 + jc * 4);
        float t1[4], t2[4], o1[4], o2[4];
        t1[0] = __builtin_bit_cast(float, lo.x << 16); t1[1] = __builtin_bit_cast(float, lo.x & 0xffff0000u); t1[2] = __builtin_bit_cast(float, lo.y << 16); t1[3] = __builtin_bit_cast(float, lo.y & 0xffff0000u);
        t2[0] = __builtin_bit_cast(float, hi.x << 16); t2[1] = __builtin_bit_cast(float, hi.x & 0xffff0000u); t2[2] = __builtin_bit_cast(float, hi.y << 16); t2[3] = __builtin_bit_cast(float, hi.y & 0xffff0000u);
        const float cv[4] = {cs.x, cs.y, cs.z, cs.w}, sv[4] = {sn.x, sn.y, sn.z, sn.w};
#pragma unroll
        for (int e = 0; e < 4; ++e) { o1[e] = t1[e] * cv[e] - t2[e] * sv[e]; o2[e] = t2[e] * cv[e] + t1[e] * sv[e]; }
        const size_t doff = (size_t)t * ATT_WIDTH + h * 64 + jc * 4;
        bf16* db = which ? krot_b : qrot_b;
        *(uint2*)(db + doff) = make_uint2(pk2(o1[0], o1[1]), pk2(o1[2], o1[3])); *(uint2*)(db + doff + 32) = make_uint2(pk2(o2[0], o2[1]), pk2(o2[2], o2[3]));
        if (which && i >= SEQ - WBUF) {
            float* o = out + OUT_PK + ((size_t)b * WBUF + (i - (SEQ - WBUF))) * ATT_WIDTH + h * 64 + jc * 4;
            *(float4*)o = make_float4(o1[0], o1[1], o1[2], o1[3]); *(float4*)(o + 32) = make_float4(o2[0], o2[1], o2[2], o2[3]);
        }
    }
#pragma unroll 4
    for (int item = gtid; item < T_PROMPT * SSD_HEADS; item += gsz) { const int t = item / SSD_HEADS, hd = item - t * SSD_HEADS; dtv[item] = softplus_f(dtraw[(size_t)t * 32 + hd] + dt_bias[hd]); }
#pragma unroll 2
    for (int item = gtid; item < BATCH * WBUF * 64; item += gsz) {
        const int ch = item & 63, j = (item >> 6) & (WBUF - 1), b = item >> 17;
        float f[8]; unpack8(*(const v4u*)(projb + (size_t)(b * SEQ + (SEQ - WBUF) + j) * NB_LD + NB_V + ch * 8), f);
        store8f(out + OUT_PV + ((size_t)b * WBUF + j) * ATT_WIDTH + ch * 8, f);
    }
}

#define SSD_CH 32
__device__ __forceinline__ void ph_ssd_naive(float* lds, const bf16* __restrict__ xbc_act, const float* __restrict__ dtv, const float* __restrict__ a_log,
                                             const float* __restrict__ d_skip, const float* __restrict__ state_ssm, float* __restrict__ ybuf, float* __restrict__ out) {
    float (*sx)[64] = (float (*)[64])lds;
    float (*sB)[128] = (float (*)[128])(lds + SSD_CH * 64);
    float (*sC)[128] = (float (*)[128])(lds + SSD_CH * 64 + SSD_CH * 128);
    float* sdt = lds + SSD_CH * 64 + 2 * SSD_CH * 128;
    const int tid = threadIdx.x, p = tid >> 3, ng = tid & 7;
    for (int vb = BATCH * SSD_HEADS + blockIdx.x; vb < (BATCH + DEC_BATCH) * SSD_HEADS; vb += gridDim.x) {
        const int seq = vb / SSD_HEADS, h = vb % SSD_HEADS, g = h / 6;
        const bool is_p = seq < BATCH;
        const int L = is_p ? SEQ : DEC_SEQ;
        const int t0 = is_p ? seq * SEQ : T_PROMPT + (seq - BATCH) * DEC_SEQ;
        const float A = -__expf(a_log[h]);
        const float D = d_skip[h];
        float hs[16];
        if (is_p) {
#pragma unroll
            for (int j = 0; j < 16; ++j) hs[j] = 0.f;
        } else {
            const float* s0 = state_ssm + (((size_t)(seq - BATCH) * SSD_HEADS + h) * 64 + p) * 128 + ng * 16;
#pragma unroll
            for (int j = 0; j < 16; ++j) hs[j] = s0[j];
        }
        for (int c0 = 0; c0 < L; c0 += SSD_CH) {
            const int nst = (L - c0) < SSD_CH ? (L - c0) : SSD_CH;
            __syncthreads();
            for (int idx = tid; idx < nst * 64; idx += NTHR) { int s = idx >> 6, c = idx & 63; sx[s][c] = bf2f(xbc_act[(size_t)(t0 + c0 + s) * CONV_DIM + h * 64 + c]); }
            for (int idx = tid; idx < nst * 128; idx += NTHR) { int s = idx >> 7, c = idx & 127;
                sB[s][c] = bf2f(xbc_act[(size_t)(t0 + c0 + s) * CONV_DIM + 1536 + g * 128 + c]);
                sC[s][c] = bf2f(xbc_act[(size_t)(t0 + c0 + s) * CONV_DIM + 2048 + g * 128 + c]); }
            if (tid < nst) sdt[tid] = dtv[(size_t)(t0 + c0 + tid) * SSD_HEADS + h];
            __syncthreads();
            for (int s = 0; s < nst; ++s) {
                const float dt = sdt[s], x = sx[s][p];
                const float a = __expf(dt * A), xdt = x * dt;
                float y = 0.f;
#pragma unroll
                for (int j = 0; j < 16; ++j) { hs[j] = a * hs[j] + xdt * sB[s][ng * 16 + j]; y += sC[s][ng * 16 + j] * hs[j]; }
                y += __shfl_xor(y, 1); y += __shfl_xor(y, 2); y += __shfl_xor(y, 4);
                if (ng == 0) ybuf[(size_t)(t0 + c0 + s) * MIX_WIDTH + h * 64 + p] = y + D * x;
            }
        }
        float* so = is_p ? out + OUT_PS + (((size_t)seq * SSD_HEADS + h) * 64 + p) * 128 + ng * 16
                         : out + OUT_SS + (((size_t)(seq - BATCH) * SSD_HEADS + h) * 64 + p) * 128 + ng * 16;
#pragma unroll
        for (int j = 0; j < 16; ++j) so[j] = hs[j];
    }
}

__device__ __forceinline__ void ph_gate_norm(const bf16* __restrict__ projb, const float* __restrict__ norm_g, const float* __restrict__ ybuf, bf16* __restrict__ A1) {
    const int w = threadIdx.x >> 6, lane = threadIdx.x & 63, g = w & 3;
    for (int t = T_PROMPT + 2 * blockIdx.x + (w >> 2); t < T_ALL; t += 2 * gridDim.x) {
        float v[6]; float ss = 0.f;
#pragma unroll
        for (int j = 0; j < 6; ++j) {
            int c = g * 384 + j * 64 + lane;
            float y = ybuf[(size_t)t * MIX_WIDTH + c], z = bf2f(projb[(size_t)t * NB_LD + c]);
            v[j] = y * silu_f(z); ss += v[j] * v[j];
        }
        ss = wave_sum(ss);
        const float r = rsqrtf(ss * (1.0f / 384.0f) + LN_EPS);
#pragma unroll
        for (int j = 0; j < 6; ++j) { int c = g * 384 + j * 64 + lane; A1[(size_t)t * MIX_WIDTH + c] = (bf16)f2bf(v[j] * r * norm_g[c]); }
    }
}

__device__ __forceinline__ void ph_attn_naive(float* lds, const float* __restrict__ proj, const float* __restrict__ qrot, const float* __restrict__ krot,
                                              const float* __restrict__ ck, const float* __restrict__ cv, float* __restrict__ ybuf) {
    float (*sq)[64] = (float (*)[64])lds;
    const int w = threadIdx.x >> 6, lane = threadIdx.x & 63;
    for (int vb = blockIdx.x; vb < T_SAMPLE * 8 / NWAVE; vb += gridDim.x) {
        const int item = T_PROMPT * 8 + vb * NWAVE + w;
        const int t = item >> 3, h = item & 7;
        const bool is_p = t < T_PROMPT;
        int b, i;
        if (is_p) { b = t / SEQ; i = t % SEQ; } else { int ts = t - T_PROMPT; b = ts / DEC_SEQ; i = ts % DEC_SEQ; }
        __syncthreads();
        sq[w][lane] = qrot[(size_t)t * ATT_WIDTH + h * 64 + lane];
        __syncthreads();
        const int qi = is_p ? i : WBUF + i;
        float sc[3][3];
        float mx = -INFINITY;
#pragma unroll
        for (int pt = 0; pt < 3; ++pt) {
            const int d = pt == 0 ? 1 : (pt == 1 ? 4 : 16);
#pragma unroll
            for (int sl = 0; sl < 3; ++sl) {
                const int m = lane + sl * 64;
                float s = -INFINITY;
                const int kj = qi - d * m;
                if (m <= 128 && kj >= 0) {
                    const float* kr;
                    if (is_p) kr = krot + (size_t)(b * SEQ + kj) * ATT_WIDTH + h * 64;
                    else kr = (kj >= WBUF) ? krot + (size_t)(T_PROMPT + b * DEC_SEQ + (kj - WBUF)) * ATT_WIDTH + h * 64
                                           : ck + ((size_t)b * WBUF + kj) * ATT_WIDTH + h * 64;
                    float a = 0.f;
#pragma unroll
                    for (int c = 0; c < 64; c += 4) { float4 kv = *(const float4*)(kr + c); a += kv.x * sq[w][c] + kv.y * sq[w][c + 1] + kv.z * sq[w][c + 2] + kv.w * sq[w][c + 3]; }
                    s = a * 0.125f;
                }
                sc[pt][sl] = s; mx = fmaxf(mx, s);
            }
        }
        mx = wave_max(mx);
        float lsum = 0.f;
#pragma unroll
        for (int pt = 0; pt < 3; ++pt)
#pragma unroll
            for (int sl = 0; sl < 3; ++sl) { float pv = (sc[pt][sl] == -INFINITY) ? 0.f : __expf(sc[pt][sl] - mx); sc[pt][sl] = pv; lsum += pv; }
        lsum = wave_sum(lsum);
        float o = 0.f;
#pragma unroll
        for (int pt = 0; pt < 3; ++pt) {
            const int d = pt == 0 ? 1 : (pt == 1 ? 4 : 16);
#pragma unroll
            for (int sl = 0; sl < 3; ++sl) {
                const int mend = sl < 2 ? 64 : 1;
                for (int ml = 0; ml < mend; ++ml) {
                    const int m = ml + sl * 64;
                    const int kj = qi - d * m;
                    const float pv = __shfl(sc[pt][sl], ml);
                    if (kj < 0) continue;
                    const float* vr;
                    if (is_p) vr = proj + (size_t)(b * SEQ + kj) * PROJ_LD + O_V + h * 64;
                    else vr = (kj >= WBUF) ? proj + (size_t)(T_PROMPT + b * DEC_SEQ + (kj - WBUF)) * PROJ_LD + O_V + h * 64
                                           : cv + ((size_t)b * WBUF + kj) * ATT_WIDTH + h * 64;
                    o += pv * vr[lane];
                }
            }
        }
        ybuf[(size_t)t * MIX_WIDTH + SSD_WIDTH + h * 64 + lane] = o / lsum;
    }
}

__device__ __forceinline__ int token_of_iter(int k) {
    const int w = __builtin_amdgcn_readfirstlane(threadIdx.x >> 6), wgl = blockIdx.x * NWAVE + w;
    if (gridDim.x != 256) { const int t = wgl + k * (int)(gridDim.x * NWAVE); return t < T_ALL ? t : -1; }
    if (k < 8) return k * 2048 + wgl;
    if (k == 8 && w < 2) return 16384 + w * 256 + (int)blockIdx.x;
    return -1;
}
__device__ __forceinline__ void ph_ln_res(const float* __restrict__ xp, const float* __restrict__ xs, const bf16* __restrict__ add, const float* __restrict__ gam,
                                          const float* __restrict__ bet, bf16* __restrict__ dstb) {
    const int lane = threadIdx.x & 63;
#pragma unroll 2
    for (int k = 0;; ++k) {
        const int t = token_of_iter(k);
        if (t < 0) break;
        const float* res = (t < T_PROMPT) ? xp + (size_t)t * D_MODEL : xs + (size_t)(t - T_PROMPT) * D_MODEL;
        float v[16]; float s = 0.f;
#pragma unroll
        for (int j = 0; j < 2; ++j) { const int c = j * 512 + lane * 8; const float4 r0 = *(const float4*)(res + c), r1 = *(const float4*)(res + c + 4);
            float a8[8]; unpack8(*(const v4u*)(add + (size_t)t * D_MODEL + c), a8);
            v[8 * j] = ALPHA_F * r0.x + a8[0]; v[8 * j + 1] = ALPHA_F * r0.y + a8[1]; v[8 * j + 2] = ALPHA_F * r0.z + a8[2]; v[8 * j + 3] = ALPHA_F * r0.w + a8[3];
            v[8 * j + 4] = ALPHA_F * r1.x + a8[4]; v[8 * j + 5] = ALPHA_F * r1.y + a8[5]; v[8 * j + 6] = ALPHA_F * r1.z + a8[6]; v[8 * j + 7] = ALPHA_F * r1.w + a8[7]; }
#pragma unroll
        for (int j = 0; j < 16; ++j) s += v[j];
        s = wave_sum(s);
        const float mu = s * (1.0f / 1024.0f);
        float q = 0.f;
#pragma unroll
        for (int j = 0; j < 16; ++j) { v[j] -= mu; q += v[j] * v[j]; }
        q = wave_sum(q);
        const float r = rsqrtf(q * (1.0f / 1024.0f) + LN_EPS);
#pragma unroll
        for (int j = 0; j < 2; ++j) { const int c = j * 512 + lane * 8; const float4 g0 = *(const float4*)(gam + c), g1 = *(const float4*)(gam + c + 4), b0 = *(const float4*)(bet + c), b1 = *(const float4*)(bet + c + 4);
            v4u o; o.x = pk2(v[8 * j] * r * g0.x + b0.x, v[8 * j + 1] * r * g0.y + b0.y); o.y = pk2(v[8 * j + 2] * r * g0.z + b0.z, v[8 * j + 3] * r * g0.w + b0.w);
            o.z = pk2(v[8 * j + 4] * r * g1.x + b1.x, v[8 * j + 5] * r * g1.y + b1.y); o.w = pk2(v[8 * j + 6] * r * g1.z + b1.z, v[8 * j + 7] * r * g1.w + b1.w);
            *(v4u*)(dstb + (size_t)t * D_MODEL + c) = o; }
    }
}

__device__ __forceinline__ void ph_peer_route(float* lds, const float* __restrict__ qh, const float* __restrict__ keys1, const float* __restrict__ keys2,
                                              int* __restrict__ eidx, float* __restrict__ gate) {
    float (*sq)[256] = (float (*)[256])lds;
    float (*sv)[2][16] = (float (*)[2][16])(lds + NWAVE * 256);
    int (*si)[2][16] = (int (*)[2][16])(lds + NWAVE * 256 + NWAVE * 32);
    const int w = threadIdx.x >> 6, lane = threadIdx.x & 63;
    for (int vb = blockIdx.x; vb < T_ALL * 8 / NWAVE; vb += gridDim.x) {
        const int item = vb * NWAVE + w;
        const int t = item >> 3, h = item & 7;
        __syncthreads();
        for (int c = lane; c < 256; c += 64) sq[w][c] = qh[(size_t)t * 2048 + h * 256 + c];
        __syncthreads();
#pragma unroll
        for (int half = 0; half < 2; ++half) {
            const float* keys = half ? keys2 : keys1;
            float s[2];
#pragma unroll
            for (int sl = 0; sl < 2; ++sl) {
                const float* kr = keys + (size_t)(lane + sl * 64) * 128;
                float a = 0.f;
#pragma unroll 8
                for (int c = 0; c < 128; c += 4) { float4 kv = *(const float4*)(kr + c); const float* qq = &sq[w][half * 128 + c]; a += kv.x * qq[0] + kv.y * qq[1] + kv.z * qq[2] + kv.w * qq[3]; }
                s[sl] = a;
            }
            for (int r = 0; r < 16; ++r) {
                float bv; int bi;
                if (s[0] >= s[1]) { bv = s[0]; bi = lane; } else { bv = s[1]; bi = lane + 64; }
#pragma unroll
                for (int o = 32; o > 0; o >>= 1) {
                    float ov = __shfl_xor(bv, o); int oi = __shfl_xor(bi, o);
                    if (ov > bv || (ov == bv && oi < bi)) { bv = ov; bi = oi; }
                }
                if (lane == 0) { sv[w][half][r] = bv; si[w][half][r] = bi; }
                if (bi == lane) s[0] = -INFINITY;
                if (bi == lane + 64) s[1] = -INFINITY;
            }
        }
        __syncthreads();
        float c[4];
#pragma unroll
        for (int j = 0; j < 4; ++j) { int ci = lane * 4 + j; c[j] = sv[w][0][ci >> 4] + sv[w][1][ci & 15]; }
        float myv = 0.f; int myc = 0;
        for (int r = 0; r < 16; ++r) {
            float bv = c[0]; int bi = lane * 4;
#pragma unroll
            for (int j = 1; j < 4; ++j) if (c[j] > bv) { bv = c[j]; bi = lane * 4 + j; }
#pragma unroll
            for (int o = 32; o > 0; o >>= 1) {
                float ov = __shfl_xor(bv, o); int oi = __shfl_xor(bi, o);
                if (ov > bv || (ov == bv && oi < bi)) { bv = ov; bi = oi; }
            }
            if (lane == r) { myv = bv; myc = bi; }
#pragma unroll
            for (int j = 0; j < 4; ++j) if (bi == lane * 4 + j) c[j] = -INFINITY;
        }
        float v = lane < 16 ? myv : -INFINITY;
        float mx = wave_max(v);
        float e = lane < 16 ? __expf(v - mx) : 0.f;
        float sum = wave_sum(e);
        if (lane < 16) {
            int ex = si[w][0][myc >> 4] * PEER_NKEYS + si[w][1][myc & 15];
            eidx[(size_t)t * 128 + h * 16 + lane] = ex;
            gate[(size_t)t * 128 + h * 16 + lane] = e / sum;
        }
    }
}

__device__ __forceinline__ void ph_peer_ffn(const float* __restrict__ hbuf, const int* __restrict__ eidx, const float* __restrict__ gate,
                                            const bf16* __restrict__ ub, const bf16* __restrict__ vb, const float* __restrict__ gam,
                                            const float* __restrict__ bet, float* __restrict__ out) {
    const int lane = threadIdx.x & 63;
    for (int t = blockIdx.x * NWAVE + (threadIdx.x >> 6); t < T_ALL; t += gridDim.x * NWAVE) {
        float x[16], acc[16];
        { const float* xr = hbuf + (size_t)t * D_MODEL + lane * 8;
          const float4 a = *(const float4*)xr, b = *(const float4*)(xr + 4), c = *(const float4*)(xr + 512), d = *(const float4*)(xr + 516);
          x[0] = a.x; x[1] = a.y; x[2] = a.z; x[3] = a.w; x[4] = b.x; x[5] = b.y; x[6] = b.z; x[7] = b.w;
          x[8] = c.x; x[9] = c.y; x[10] = c.z; x[11] = c.w; x[12] = d.x; x[13] = d.y; x[14] = d.z; x[15] = d.w; }
#pragma unroll
        for (int j = 0; j < 16; ++j) acc[j] = 0.f;
        for (int k = 0; k < 128; ++k) {
            const int e = eidx[(size_t)t * 128 + k];
            const float g = gate[(size_t)t * 128 + k];
            const bf16* ur = ub + (size_t)e * D_MODEL + lane * 8;
            float u0[8], u1[8];
            unpack8(*(const v4u*)ur, u0); unpack8(*(const v4u*)(ur + 512), u1);
            float d = 0.f;
#pragma unroll
            for (int j = 0; j < 8; ++j) d += u0[j] * x[j] + u1[j] * x[8 + j];
            d = wave_sum(d);
            const float wgt = g * gelu_f(d);
            const bf16* vr = vb + (size_t)e * D_MODEL + lane * 8;
            unpack8(*(const v4u*)vr, u0); unpack8(*(const v4u*)(vr + 512), u1);
#pragma unroll
            for (int j = 0; j < 8; ++j) { acc[j] += wgt * u0[j]; acc[8 + j] += wgt * u1[j]; }
        }
        float s = 0.f;
#pragma unroll
        for (int j = 0; j < 16; ++j) { acc[j] += ALPHA_F * x[j]; s += acc[j]; }
        s = wave_sum(s);
        const float mu = s * (1.0f / 1024.0f);
        float q = 0.f;
#pragma unroll
        for (int j = 0; j < 16; ++j) { acc[j] -= mu; q += acc[j] * acc[j]; }
        q = wave_sum(q);
        const float r = rsqrtf(q * (1.0f / 1024.0f) + LN_EPS);
        float* dst = ((t < T_PROMPT) ? out + OUT_YP + (size_t)t * D_MODEL : out + OUT_YS + (size_t)(t - T_PROMPT) * D_MODEL) + lane * 8;
#pragma unroll
        for (int q4 = 0; q4 < 4; ++q4) {
            const int eo = (q4 >> 1) * 512 + (q4 & 1) * 4;
            const float4 g4 = *(const float4*)(gam + lane * 8 + eo), b4 = *(const float4*)(bet + lane * 8 + eo);
            float4 o; o.x = acc[q4 * 4 + 0] * r * g4.x + b4.x; o.y = acc[q4 * 4 + 1] * r * g4.y + b4.y; o.z = acc[q4 * 4 + 2] * r * g4.z + b4.z; o.w = acc[q4 * 4 + 3] * r * g4.w + b4.w;
            *(float4*)(dst + eo) = o;
        }
    }
}

__device__ __forceinline__ float peer_dot16(const v4u a, const v4u b, const float (&x)[16]) {
    float u0[8], u1[8]; unpack8(a, u0); unpack8(b, u1);
    float d = 0.f;
#pragma unroll
    for (int j = 0; j < 8; ++j) d += u0[j] * x[j] + u1[j] * x[8 + j];
    return d;
}
#define PEER_TR_STEP(N, M) _Pragma("unroll") for (int i = 0; i < N; ++i) { const bool up = (lane & M) != 0; const float keep = up ? part[i + N] : part[i]; const float send = up ? part[i] : part[i + N]; part[i] = keep + __shfl_xor(send, M); }
__device__ __forceinline__ void ph_peer_ffn2(const float* __restrict__ hbuf, const int* __restrict__ eidx, const float* __restrict__ gate,
                                             const bf16* __restrict__ ub, const bf16* __restrict__ vb, const float* __restrict__ gam,
                                             const float* __restrict__ bet, float* __restrict__ out) {
    const int lane0 = threadIdx.x & 63;
    for (int t = blockIdx.x * NWAVE + (threadIdx.x >> 6); t < T_ALL; t += gridDim.x * NWAVE) {
        int lane = lane0; asm volatile("" : "+v"(lane));
        float x[16];
        { const float* xr = hbuf + (size_t)t * D_MODEL + lane * 8;
          const float4 a = *(const float4*)xr, b = *(const float4*)(xr + 4), c = *(const float4*)(xr + 512), d = *(const float4*)(xr + 516);
          x[0] = a.x; x[1] = a.y; x[2] = a.z; x[3] = a.w; x[4] = b.x; x[5] = b.y; x[6] = b.z; x[7] = b.w;
          x[8] = c.x; x[9] = c.y; x[10] = c.z; x[11] = c.w; x[12] = d.x; x[13] = d.y; x[14] = d.z; x[15] = d.w; }
        int ev[2]; float wv[4];
        ev[0] = eidx[(size_t)t * 128 + lane]; ev[1] = eidx[(size_t)t * 128 + 64 + lane];
#pragma unroll
        for (int rd = 0; rd < 4; ++rd) wv[rd] = gate[(size_t)t * 128 + rd * 32 + (lane >> 1)];
#pragma unroll
        for (int rd = 0; rd < 4; ++rd) {
            float part[32];
#pragma unroll
            for (int kb = 0; kb < 8; ++kb) {
                v4u ra[4], rb[4];
#pragma unroll
                for (int k8 = 0; k8 < 4; ++k8) {
                    const int e = __builtin_amdgcn_readlane(ev[rd >> 1], (rd & 1) * 32 + kb * 4 + k8);
                    const bf16* ur = ub + (size_t)e * D_MODEL + lane * 8;
                    ra[k8] = *(const v4u*)ur; rb[k8] = *(const v4u*)(ur + 512);
                }
#pragma unroll
                for (int k8 = 0; k8 < 4; ++k8) part[kb * 4 + k8] = peer_dot16(ra[k8], rb[k8], x);
            }
            PEER_TR_STEP(16, 32) PEER_TR_STEP(8, 16) PEER_TR_STEP(4, 8) PEER_TR_STEP(2, 4) PEER_TR_STEP(1, 2)
            const float hid = part[0] + __shfl_xor(part[0], 1);
            wv[rd] *= gelu_f(hid);
        }
        float acc[16];
#pragma unroll
        for (int j = 0; j < 16; ++j) acc[j] = 0.f;
#pragma unroll
        for (int rd = 0; rd < 4; ++rd) {
#pragma unroll
            for (int kb = 0; kb < 4; ++kb) {
                v4u ra[8], rb[8];
#pragma unroll
                for (int k8 = 0; k8 < 8; ++k8) {
                    const int e = __builtin_amdgcn_readlane(ev[rd >> 1], (rd & 1) * 32 + kb * 8 + k8);
                    const bf16* vr = vb + (size_t)e * D_MODEL + lane * 8;
                    ra[k8] = *(const v4u*)vr; rb[k8] = *(const v4u*)(vr + 512);
                }
#pragma unroll
                for (int k8 = 0; k8 < 8; ++k8) {
                    const float wk = __builtin_bit_cast(float, __builtin_amdgcn_readlane(__builtin_bit_cast(int, wv[rd]), 2 * (kb * 8 + k8)));
                    float u0[8], u1[8]; unpack8(ra[k8], u0); unpack8(rb[k8], u1);
#pragma unroll
                    for (int j = 0; j < 8; ++j) { acc[j] += wk * u0[j]; acc[8 + j] += wk * u1[j]; }
                }
            }
        }
        float s = 0.f;
#pragma unroll
        for (int j = 0; j < 16; ++j) { acc[j] += ALPHA_F * x[j]; s += acc[j]; }
        s = wave_sum(s);
        const float mu = s * (1.0f / 1024.0f);
        float q = 0.f;
#pragma unroll
        for (int j = 0; j < 16; ++j) { acc[j] -= mu; q += acc[j] * acc[j]; }
        q = wave_sum(q);
        const float r = rsqrtf(q * (1.0f / 1024.0f) + LN_EPS);
        float* dst = ((t < T_PROMPT) ? out + OUT_YP + (size_t)t * D_MODEL : out + OUT_YS + (size_t)(t - T_PROMPT) * D_MODEL) + lane * 8;
#pragma unroll
        for (int q4 = 0; q4 < 4; ++q4) {
            const int eo = (q4 >> 1) * 512 + (q4 & 1) * 4;
            const float4 g4 = *(const float4*)(gam + lane * 8 + eo), b4 = *(const float4*)(bet + lane * 8 + eo);
            float4 o; o.x = acc[q4 * 4 + 0] * r * g4.x + b4.x; o.y = acc[q4 * 4 + 1] * r * g4.y + b4.y; o.z = acc[q4 * 4 + 2] * r * g4.z + b4.z; o.w = acc[q4 * 4 + 3] * r * g4.w + b4.w;
            *(float4*)(dst + eo) = o;
        }
    }
}

__device__ __forceinline__ void ph_attn_sample(float* lds, const bf16* __restrict__ qrot_b, const bf16* __restrict__ krot_b, const bf16* __restrict__ projb,
                                               const float* __restrict__ ck, const float* __restrict__ cv, bf16* __restrict__ A1) {
    float (*sq)[64] = (float (*)[64])lds;
    const int w = threadIdx.x >> 6, lane0 = threadIdx.x & 63;
    for (int vb = blockIdx.x; vb < T_SAMPLE * 8 / NWAVE; vb += gridDim.x) {
        int lane = lane0; asm volatile("" : "+v"(lane));
        const int item = vb * NWAVE + w, ts = item >> 3, hd = item & 7, b = ts >> 2, i = ts & 3, t = T_PROMPT + ts;
        __syncthreads();
        sq[w][lane] = bf2f(qrot_b[(size_t)t * ATT_WIDTH + hd * 64 + lane]);
        __syncthreads();
        const int qi = WBUF + i;
        float sc[8];
        float mx = -INFINITY;
#pragma unroll
        for (int slot = 0; slot < 7; ++slot) {
            const int pt = slot < 6 ? (slot >> 1) : (lane < 3 ? lane : 0);
            const int m = slot < 6 ? lane + 64 * (slot & 1) : 128;
            const int kj = qi - (m << (2 * pt));
            const bool valid = (slot < 6 || lane < 3) && kj < WBUF;
            const int kc = kj < WBUF ? kj : WBUF - 1;
            const float* kr = ck + ((size_t)b * WBUF + kc) * ATT_WIDTH + hd * 64;
            float a = 0.f;
#pragma unroll
            for (int c = 0; c < 64; c += 4) { const float4 kv = *(const float4*)(kr + c); a += kv.x * sq[w][c] + kv.y * sq[w][c + 1] + kv.z * sq[w][c + 2] + kv.w * sq[w][c + 3]; }
            const float s = valid ? a * 0.125f : -INFINITY;
            sc[slot] = s; mx = fmaxf(mx, s);
        }
        const int nt7 = lane <= i ? i - lane : i;
        const bool valid7 = lane < i + 3;
        {
            const bf16* kr = krot_b + (size_t)(T_PROMPT + b * DEC_SEQ + nt7) * ATT_WIDTH + hd * 64;
            float a = 0.f;
#pragma unroll
            for (int c = 0; c < 64; c += 8) { float f[8]; unpack8(*(const v4u*)(kr + c), f);
#pragma unroll
                for (int j = 0; j < 8; ++j) a += f[j] * sq[w][c + j]; }
            const float s = valid7 ? a * 0.125f : -INFINITY;
            sc[7] = s; mx = fmaxf(mx, s);
        }
        mx = wave_max(mx);
        float lsum = 0.f;
#pragma unroll
        for (int slot = 0; slot < 8; ++slot) { const float pv = __expf(sc[slot] - mx); sc[slot] = pv; lsum += pv; }
        lsum = wave_sum(lsum);
        float part[64];
#pragma unroll
        for (int c = 0; c < 64; ++c) part[c] = 0.f;
#pragma unroll
        for (int slot = 0; slot < 7; ++slot) {
            const int pt = slot < 6 ? (slot >> 1) : (lane < 3 ? lane : 0);
            const int m = slot < 6 ? lane + 64 * (slot & 1) : 128;
            const int kj = qi - (m << (2 * pt));
            const int kc = kj < WBUF ? kj : WBUF - 1;
            const float pv = sc[slot];
            const float* vr = cv + ((size_t)b * WBUF + kc) * ATT_WIDTH + hd * 64;
#pragma unroll
            for (int c = 0; c < 64; c += 4) { const float4 vv = *(const float4*)(vr + c); part[c] += pv * vv.x; part[c + 1] += pv * vv.y; part[c + 2] += pv * vv.z; part[c + 3] += pv * vv.w; }
        }
        {
            const float pv = sc[7];
            const bf16* vr = projb + (size_t)(T_PROMPT + b * DEC_SEQ + nt7) * NB_LD + NB_V + hd * 64;
#pragma unroll
            for (int c = 0; c < 64; c += 8) { float f[8]; unpack8(*(const v4u*)(vr + c), f);
#pragma unroll
                for (int j = 0; j < 8; ++j) part[c + j] += pv * f[j]; }
        }
        PEER_TR_STEP(32, 32) PEER_TR_STEP(16, 16) PEER_TR_STEP(8, 8) PEER_TR_STEP(4, 4) PEER_TR_STEP(2, 2) PEER_TR_STEP(1, 1)
        A1[(size_t)t * MIX_WIDTH + SSD_WIDTH + hd * 64 + lane] = (bf16)f2bf(part[0] / lsum);
    }
}


__device__ __forceinline__ void cache_copy_slice(const float* __restrict__ ck, const float* __restrict__ cv, float* __restrict__ out, unsigned slice, unsigned lane) {
    constexpr unsigned PER_B = (WBUF - DEC_SEQ) * ATT_WIDTH / 4;
    constexpr unsigned TOTAL = 2u * DEC_BATCH * PER_B;
#pragma unroll 1
    for (unsigned bt = 0; bt < 8; ++bt) {
        f32x4n v[8]; size_t dsti[8]; bool isv[8]; bool ok[8];
#pragma unroll
        for (int j = 0; j < 8; ++j) {
            const unsigned idx = slice * 4096u + bt * 512u + j * 64u + lane;
            ok[j] = idx < TOTAL;
            const unsigned idc = ok[j] ? idx : 0u;
            const unsigned tb = idc / PER_B, r = idc - tb * PER_B, bb = tb & (DEC_BATCH - 1);
            isv[j] = tb >= DEC_BATCH;
            const size_t srci = (size_t)bb * (WBUF * ATT_WIDTH / 4) + (DEC_SEQ * ATT_WIDTH / 4) + r;
            dsti[j] = (size_t)bb * (WBUF * ATT_WIDTH / 4) + r;
            v[j] = __builtin_nontemporal_load((isv[j] ? (const f32x4n*)cv : (const f32x4n*)ck) + srci);
        }
#pragma unroll
        for (int j = 0; j < 8; ++j) if (ok[j]) __builtin_nontemporal_store(v[j], (f32x4n*)(out + (isv[j] ? OUT_SV : OUT_SK)) + dsti[j]);
    }
}

__device__ __forceinline__ void copy_q_load(const float* __restrict__ ck, const float* __restrict__ cv, unsigned q, unsigned lane, f32x4n (&v)[16]) {
    constexpr unsigned PER_B = (WBUF - DEC_SEQ) * ATT_WIDTH / 4, TOTAL = 2u * DEC_BATCH * PER_B;
#pragma unroll
    for (int j = 0; j < 16; ++j) {
        const unsigned idx = q * 1024u + j * 64u + lane, idc = idx < TOTAL ? idx : 0u;
        const unsigned tb = idc / PER_B, r = idc - tb * PER_B, bb = tb & (DEC_BATCH - 1);
        const size_t srci = (size_t)bb * (WBUF * ATT_WIDTH / 4) + (DEC_SEQ * ATT_WIDTH / 4) + r;
        v[j] = __builtin_nontemporal_load((tb >= DEC_BATCH ? (const f32x4n*)cv : (const f32x4n*)ck) + srci);
    }
}
__device__ __forceinline__ void copy_q_store(float* __restrict__ out, unsigned q, unsigned lane, const f32x4n (&v)[16]) {
    constexpr unsigned PER_B = (WBUF - DEC_SEQ) * ATT_WIDTH / 4, TOTAL = 2u * DEC_BATCH * PER_B;
#pragma unroll
    for (int j = 0; j < 16; ++j) {
        const unsigned idx = q * 1024u + j * 64u + lane;
        if (idx < TOTAL) {
            const unsigned tb = idx / PER_B, r = idx - tb * PER_B, bb = tb & (DEC_BATCH - 1);
            const size_t dsti = (size_t)bb * (WBUF * ATT_WIDTH / 4) + r;
            __builtin_nontemporal_store(v[j], (f32x4n*)(out + (tb >= DEC_BATCH ? OUT_SV : OUT_SK)) + dsti);
        }
    }
}
typedef float f32x2v __attribute__((ext_vector_type(2)));
typedef unsigned u32x6 __attribute__((ext_vector_type(6)));
typedef float f32x32 __attribute__((ext_vector_type(32)));
typedef float f32x16q __attribute__((ext_vector_type(16)));
struct __attribute__((aligned(4))) u3w { unsigned x, y, z; };
#define PEER_ROWB 768
__device__ __forceinline__ void ph_quant_tables(const float* __restrict__ pu, const float* __restrict__ pv, unsigned char* __restrict__ ub8, unsigned char* __restrict__ vb8,
                                                float* __restrict__ usc, float* __restrict__ vsc, int rank, int nranks) {
    const int lane = threadIdx.x & 63;
#pragma unroll 2
    for (int row = rank * NWAVE + (threadIdx.x >> 6); row < 2 * 16384; row += nranks * NWAVE) {
        const int rr = row & 16383; const bool isv = row >= 16384;
        const float* src = (isv ? pv : pu) + (size_t)rr * D_MODEL + lane * 8;
        const float4 a = *(const float4*)src, b = *(const float4*)(src + 4), c = *(const float4*)(src + 512), d = *(const float4*)(src + 516);
        float am = fmaxf(fmaxf(fmaxf(fabsf(a.x), fabsf(a.y)), fmaxf(fabsf(a.z), fabsf(a.w))), fmaxf(fmaxf(fabsf(b.x), fabsf(b.y)), fmaxf(fabsf(b.z), fabsf(b.w))));
        am = fmaxf(am, fmaxf(fmaxf(fmaxf(fabsf(c.x), fabsf(c.y)), fmaxf(fabsf(c.z), fabsf(c.w))), fmaxf(fmaxf(fabsf(d.x), fabsf(d.y)), fmaxf(fabsf(d.z), fabsf(d.w)))));
        am = wave_max(am);
        const float sc = am > 0.f ? 7.5f / am : 1.0f;
        f32x16q e0, e1;
#pragma unroll
        for (int i = 0; i < 16; ++i) { e0[i] = 0.f; e1[i] = 0.f; }
        e0[0] = a.x * sc; e1[0] = a.y * sc; e0[1] = a.z * sc; e1[1] = a.w * sc; e0[2] = b.x * sc; e1[2] = b.y * sc; e0[3] = b.z * sc; e1[3] = b.w * sc;
        e0[4] = c.x * sc; e1[4] = c.y * sc; e0[5] = c.z * sc; e1[5] = c.w * sc; e0[6] = d.x * sc; e1[6] = d.y * sc; e0[7] = d.z * sc; e1[7] = d.w * sc;
        const u32x6 qv = __builtin_amdgcn_cvt_scalef32_2xpk16_fp6_f32(e0, e1, 1.0f);
        u3w o; o.x = qv[0]; o.y = qv[1]; o.z = qv[2];
        *(u3w*)((isv ? vb8 : ub8) + (size_t)rr * PEER_ROWB + lane * 12) = o;
        if (lane == 0) (isv ? vsc : usc)[rr] = am > 0.f ? am * (1.0f / 7.5f) : 1.0f;
    }
}
__device__ __forceinline__ void unpack16_fp8(const v4u w, float (&f)[16]) {
#pragma unroll
    for (int i = 0; i < 4; ++i) {
        const f32x2v lo = __builtin_amdgcn_cvt_pk_f32_fp8((int)w[i], false), hi = __builtin_amdgcn_cvt_pk_f32_fp8((int)w[i], true);
        f[4 * i] = lo[0]; f[4 * i + 1] = lo[1]; f[4 * i + 2] = hi[0]; f[4 * i + 3] = hi[1];
    }
}
__device__ __forceinline__ unsigned ffn_slice(unsigned n9, unsigned it) {
    const unsigned w = (unsigned)__builtin_amdgcn_readfirstlane(threadIdx.x >> 6), wgl = blockIdx.x * NWAVE + w;
    if (gridDim.x != 256) return n9 + wgl + it * (gridDim.x * NWAVE);
    if (it < 2u) return n9 + it * 2048u + wgl;
    if (w < 2u) return 0xffffffffu;
    const unsigned lw = blockIdx.x * 6u + (w - 2u);
    if (it < 4u) return n9 + 4096u + (it - 2u) * 1536u + lw;
    if (it == 4u && lw < 256u) return n9 + 7168u + lw;
    return 0xffffffffu;
}
__device__ __forceinline__ void ph_peer_ffn3(const bf16* __restrict__ hb, const int* __restrict__ eidx, const float* __restrict__ gate,
                                             const unsigned char* __restrict__ ub8, const unsigned char* __restrict__ vb8, const float* __restrict__ usc, const float* __restrict__ vsc,
                                             const float* __restrict__ gam, const float* __restrict__ bet, float* __restrict__ out,
                                             const float* __restrict__ ck, const float* __restrict__ cv, unsigned n9) {
    const int lane0 = threadIdx.x & 63;
    unsigned it = 0;
    for (;; ++it) {
        const int t = token_of_iter((int)it);
        if (t < 0) break;
        int lane = lane0; asm volatile("" : "+v"(lane));
        { const unsigned sl = ffn_slice(n9, it); if (sl < 16384u) cache_copy_slice(ck, cv, out, sl, (unsigned)lane); }
        const unsigned lo12 = (unsigned)lane * 12u, lo8 = (unsigned)lane * 8u;
        float x[16];
        { float f0[8], f1[8]; const bf16* xr = hb + (size_t)t * D_MODEL + lo8; unpack8(*(const v4u*)xr, f0); unpack8(*(const v4u*)(xr + 512), f1);
#pragma unroll
          for (int j = 0; j < 8; ++j) { x[j] = f0[j]; x[8 + j] = f1[j]; } }
        int ev[2]; float wv[4], su[4];
        ev[0] = eidx[(size_t)t * 128 + lane]; ev[1] = eidx[(size_t)t * 128 + 64 + lane];
#pragma unroll
        for (int rd = 0; rd < 4; ++rd) {
            const int er = eidx[(size_t)t * 128 + rd * 32 + (lane >> 1)];
            wv[rd] = gate[(size_t)t * 128 + rd * 32 + (lane >> 1)] * vsc[er];
            su[rd] = usc[er];
        }
#pragma unroll
        for (int rd = 0; rd < 4; ++rd) {
            float part[32];
#pragma unroll
            for (int kb = 0; kb < 2; ++kb) {
                u3w ra[16];
#pragma unroll
                for (int k8 = 0; k8 < 16; ++k8) {
                    const int e = __builtin_amdgcn_readlane(ev[rd >> 1], (rd & 1) * 32 + kb * 16 + k8);
                    ra[k8] = *(const u3w*)(ub8 + (size_t)e * PEER_ROWB + lo12);
                }
#pragma unroll
                for (int k8 = 0; k8 < 16; k8 += 2) {
                    u32x6 sv; sv[0] = ra[k8].x; sv[1] = ra[k8].y; sv[2] = ra[k8].z; sv[3] = ra[k8 + 1].x; sv[4] = ra[k8 + 1].y; sv[5] = ra[k8 + 1].z;
                    const f32x32 f = __builtin_amdgcn_cvt_scalef32_pk32_f32_fp6(sv, 1.0f);
                    f32x2v d0 = {0.f, 0.f}, d1 = {0.f, 0.f};
#pragma unroll
                    for (int i = 0; i < 8; ++i) {
                        d0 += (f32x2v){f[2 * i], f[2 * i + 1]} * (f32x2v){x[2 * i], x[2 * i + 1]};
                        d1 += (f32x2v){f[16 + 2 * i], f[17 + 2 * i]} * (f32x2v){x[2 * i], x[2 * i + 1]};
                    }
                    part[kb * 16 + k8] = d0[0] + d0[1]; part[kb * 16 + k8 + 1] = d1[0] + d1[1];
                    __builtin_amdgcn_sched_barrier(0);
                }
            }
            PEER_TR_STEP(16, 32) PEER_TR_STEP(8, 16) PEER_TR_STEP(4, 8) PEER_TR_STEP(2, 4) PEER_TR_STEP(1, 2)
            const float hid = (part[0] + __shfl_xor(part[0], 1)) * su[rd];
            wv[rd] *= gelu_f(hid);
        }
        f32x2v accp[8];
#pragma unroll
        for (int i = 0; i < 8; ++i) accp[i] = (f32x2v){0.f, 0.f};
#pragma unroll
        for (int rd = 0; rd < 4; ++rd) {
#pragma unroll
            for (int kb = 0; kb < 2; ++kb) {
                u3w ra[16];
#pragma unroll
                for (int k8 = 0; k8 < 16; ++k8) {
                    const int e = __builtin_amdgcn_readlane(ev[rd >> 1], (rd & 1) * 32 + kb * 16 + k8);
                    ra[k8] = *(const u3w*)(vb8 + (size_t)e * PEER_ROWB + lo12);
                }
#pragma unroll
                for (int k8 = 0; k8 < 16; k8 += 2) {
                    const float wk0 = __builtin_bit_cast(float, __builtin_amdgcn_readlane(__builtin_bit_cast(int, wv[rd]), 2 * (kb * 16 + k8)));
                    const float wk1 = __builtin_bit_cast(float, __builtin_amdgcn_readlane(__builtin_bit_cast(int, wv[rd]), 2 * (kb * 16 + k8 + 1)));
                    u32x6 sv; sv[0] = ra[k8].x; sv[1] = ra[k8].y; sv[2] = ra[k8].z; sv[3] = ra[k8 + 1].x; sv[4] = ra[k8 + 1].y; sv[5] = ra[k8 + 1].z;
                    const f32x32 f = __builtin_amdgcn_cvt_scalef32_pk32_f32_fp6(sv, 1.0f);
#pragma unroll
                    for (int i = 0; i < 8; ++i) {
                        accp[i] += (f32x2v){wk0, wk0} * (f32x2v){f[2 * i], f[2 * i + 1]};
                        accp[i] += (f32x2v){wk1, wk1} * (f32x2v){f[16 + 2 * i], f[17 + 2 * i]};
                    }
                    __builtin_amdgcn_sched_barrier(0);
                }
            }
        }
        float acc[16];
#pragma unroll
        for (int i = 0; i < 8; ++i) { acc[2 * i] = accp[i][0]; acc[2 * i + 1] = accp[i][1]; }
        float s = 0.f;
#pragma unroll
        for (int j = 0; j < 16; ++j) { acc[j] += ALPHA_F * x[j]; s += acc[j]; }
        s = wave_sum(s);
        const float mu = s * (1.0f / 1024.0f);
        float q = 0.f;
#pragma unroll
        for (int j = 0; j < 16; ++j) { acc[j] -= mu; q += acc[j] * acc[j]; }
        q = wave_sum(q);
        const float r = rsqrtf(q * (1.0f / 1024.0f) + LN_EPS);
        float* dst = ((t < T_PROMPT) ? out + OUT_YP + (size_t)t * D_MODEL : out + OUT_YS + (size_t)(t - T_PROMPT) * D_MODEL) + lo8;
#pragma unroll
        for (int q4 = 0; q4 < 4; ++q4) {
            const int eo = (q4 >> 1) * 512 + (q4 & 1) * 4;
            const float4 g4 = *(const float4*)(gam + lo8 + eo), b4 = *(const float4*)(bet + lo8 + eo);
            float4 o; o.x = acc[q4 * 4 + 0] * r * g4.x + b4.x; o.y = acc[q4 * 4 + 1] * r * g4.y + b4.y; o.z = acc[q4 * 4 + 2] * r * g4.z + b4.z; o.w = acc[q4 * 4 + 3] * r * g4.w + b4.w;
            *(float4*)(dst + eo) = o;
        }
    }
    for (;; ++it) {
        if (gridDim.x == 256 && it >= 5u) break;
        const unsigned sl = ffn_slice(n9, it);
        if (gridDim.x != 256 && sl >= 16384u) break;
        if (sl < 16384u) cache_copy_slice(ck, cv, out, sl, (unsigned)lane0);
    }
}


__device__ __forceinline__ void ssd_decode_load(const bf16* __restrict__ xbc_b, const float* __restrict__ dtv, const float* __restrict__ state_ssm, int item, int p, int ng,
                                                float (&hs)[16], v4u (&bq)[4][2], v4u (&cq)[4][2], float (&xv)[4], float (&dv)[4]) {
    const int sb = item / SSD_HEADS, h = item - sb * SSD_HEADS, g = h / 6, t0 = T_PROMPT + sb * DEC_SEQ;
    const float* s0 = state_ssm + (((size_t)sb * SSD_HEADS + h) * 64 + p) * 128 + ng * 16;
#pragma unroll
    for (int j = 0; j < 4; ++j) { const float4 v = *(const float4*)(s0 + 4 * j); hs[4 * j] = v.x; hs[4 * j + 1] = v.y; hs[4 * j + 2] = v.z; hs[4 * j + 3] = v.w; }
#pragma unroll
    for (int s = 0; s < 4; ++s) {
        const bf16* row = xbc_b + (size_t)(t0 + s) * CONV_DIM;
        bq[s][0] = *(const v4u*)(row + 1536 + g * 128 + ng * 16); bq[s][1] = *(const v4u*)(row + 1536 + g * 128 + ng * 16 + 8);
        cq[s][0] = *(const v4u*)(row + 2048 + g * 128 + ng * 16); cq[s][1] = *(const v4u*)(row + 2048 + g * 128 + ng * 16 + 8);
        xv[s] = bf2f(row[h * 64 + p]); dv[s] = dtv[(size_t)(t0 + s) * SSD_HEADS + h];
    }
}
__device__ __forceinline__ void ssd_decode_compute(const float* __restrict__ a_log, const float* __restrict__ d_skip, int item, int p, int ng,
                                                   float (&hs)[16], const v4u (&bq)[4][2], const v4u (&cq)[4][2], const float (&xv)[4], const float (&dv)[4],
                                                   float* __restrict__ ybuf, float* __restrict__ out) {
    const int sb = item / SSD_HEADS, h = item - sb * SSD_HEADS, t0 = T_PROMPT + sb * DEC_SEQ;
    const float A = -__expf(a_log[h]), D = d_skip[h];
#pragma unroll
    for (int s = 0; s < 4; ++s) {
        float Bf[16], Cf[16];
        { float t8[8]; unpack8(bq[s][0], t8);
#pragma unroll
          for (int j = 0; j < 8; ++j) Bf[j] = t8[j];
          unpack8(bq[s][1], t8);
#pragma unroll
          for (int j = 0; j < 8; ++j) Bf[8 + j] = t8[j];
          unpack8(cq[s][0], t8);
#pragma unroll
          for (int j = 0; j < 8; ++j) Cf[j] = t8[j];
          unpack8(cq[s][1], t8);
#pragma unroll
          for (int j = 0; j < 8; ++j) Cf[8 + j] = t8[j]; }
        const float a = __expf(dv[s] * A), xdt = xv[s] * dv[s];
        float y = 0.f;
#pragma unroll
        for (int j = 0; j < 16; ++j) { hs[j] = a * hs[j] + xdt * Bf[j]; y += Cf[j] * hs[j]; }
        y += __shfl_xor(y, 1); y += __shfl_xor(y, 2); y += __shfl_xor(y, 4);
        if (ng == 0) ybuf[(size_t)(t0 + s) * MIX_WIDTH + h * 64 + p] = y + D * xv[s];
    }
    float* so = out + OUT_SS + (((size_t)sb * SSD_HEADS + h) * 64 + p) * 128 + ng * 16;
#pragma unroll
    for (int j = 0; j < 4; ++j) *(float4*)(so + 4 * j) = make_float4(hs[4 * j], hs[4 * j + 1], hs[4 * j + 2], hs[4 * j + 3]);
}
__device__ __forceinline__ void ph_ssd_decode(const bf16* __restrict__ xbc_b, const float* __restrict__ dtv, const float* __restrict__ a_log, const float* __restrict__ d_skip,
                                              const float* __restrict__ state_ssm, float* __restrict__ ybuf, float* __restrict__ out) {
    const int tid = threadIdx.x, p = tid >> 3, ng = tid & 7;
    constexpr int NITEM = DEC_BATCH * SSD_HEADS;
    for (int it = blockIdx.x; it < NITEM; it += 2 * gridDim.x) {
        const int it2 = it + gridDim.x; const bool has2 = it2 < NITEM; const int it2c = has2 ? it2 : it;
        float hsA[16], hsB[16], xA[4], xB[4], dA[4], dB[4]; v4u bA[4][2], cA[4][2], bB[4][2], cB[4][2];
        ssd_decode_load(xbc_b, dtv, state_ssm, it, p, ng, hsA, bA, cA, xA, dA);
        ssd_decode_load(xbc_b, dtv, state_ssm, it2c, p, ng, hsB, bB, cB, xB, dB);
        ssd_decode_compute(a_log, d_skip, it, p, ng, hsA, bA, cA, xA, dA, ybuf, out);
        if (has2) ssd_decode_compute(a_log, d_skip, it2, p, ng, hsB, bB, cB, xB, dB, ybuf, out);
    }
}

__device__ __forceinline__ float samp_cw(int d) { return (float)((int)(d >= 0 && d <= 128) + (int)(d >= 0 && (d & 3) == 0 && d <= 512) + (int)(d >= 0 && (d & 15) == 0 && d <= 2048)); }
__device__ __forceinline__ void samp_update(float sv, float cw, const float (&vrow)[64], float& m, float& l, float (&part)[64]) {
    const float mn = fmaxf(m, sv), alpha = __expf(m - mn), p = cw * __expf(sv - mn);
    m = mn; l = l * alpha + p;
#pragma unroll
    for (int c = 0; c < 64; ++c) part[c] = part[c] * alpha + p * vrow[c];
}
__device__ __forceinline__ void ph_attn_sample3(float* lds, const bf16* __restrict__ qrot_b, const bf16* __restrict__ krot_b, const bf16* __restrict__ projb,
                                                const float* __restrict__ ck, const float* __restrict__ cv, bf16* __restrict__ A1) {
    const int lane0 = threadIdx.x & 63, w = __builtin_amdgcn_readfirstlane(threadIdx.x >> 6);
    float* sq = lds + w * 256;
    for (int item = blockIdx.x + gridDim.x * w; item < DEC_BATCH * ATT_HEADS; item += gridDim.x * NWAVE) {
        int lane = lane0; asm volatile("" : "+v"(lane));
        const int b = item >> 3, hd = item & 7, qi = lane & 3, g = lane >> 2;
        const int tq0 = T_PROMPT + b * DEC_SEQ;
#pragma unroll
        for (int i = 0; i < 4; ++i) sq[i * 64 + lane] = bf2f(qrot_b[(size_t)(tq0 + i) * ATT_WIDTH + hd * 64 + lane]);
        asm volatile("s_waitcnt lgkmcnt(0)" ::: "memory");
        const float* qv = sq + qi * 64;
        const float* ckb = ck + (size_t)b * WBUF * ATT_WIDTH + hd * 64; const float* cvb = cv + (size_t)b * WBUF * ATT_WIDTH + hd * 64;
        float m = -1e30f, l = 0.f, part[64];
#pragma unroll
        for (int c = 0; c < 64; ++c) part[c] = 0.f;
        {
            const int P = 2051 - g;
            const float cw = samp_cw(WBUF + qi - P);
            const bool isn = P >= WBUF;
            const int nt = isn ? P - WBUF : 0, Pc = isn ? WBUF - 1 : P;
            const bf16* kn = krot_b + (size_t)(tq0 + nt) * ATT_WIDTH + hd * 64; const float* kr = ckb + (size_t)Pc * ATT_WIDTH;
            float a = 0.f;
#pragma unroll
            for (int c = 0; c < 64; c += 8) { float f[8]; unpack8(*(const v4u*)(kn + c), f); const float4 k0 = *(const float4*)(kr + c), k1 = *(const float4*)(kr + c + 4);
                a += (isn ? f[0] : k0.x) * qv[c] + (isn ? f[1] : k0.y) * qv[c + 1] + (isn ? f[2] : k0.z) * qv[c + 2] + (isn ? f[3] : k0.w) * qv[c + 3]
                   + (isn ? f[4] : k1.x) * qv[c + 4] + (isn ? f[5] : k1.y) * qv[c + 5] + (isn ? f[6] : k1.z) * qv[c + 6] + (isn ? f[7] : k1.w) * qv[c + 7]; }
            const float sv = cw > 0.f ? a * 0.125f : -1e30f;
            const bf16* vn = projb + (size_t)(tq0 + nt) * NB_LD + NB_V + hd * 64; const float* vr = cvb + (size_t)Pc * ATT_WIDTH;
            float vrow[64];
#pragma unroll
            for (int c = 0; c < 64; c += 8) { float f[8]; unpack8(*(const v4u*)(vn + c), f); const float4 v0 = *(const float4*)(vr + c), v1 = *(const float4*)(vr + c + 4);
                vrow[c] = isn ? f[0] : v0.x; vrow[c + 1] = isn ? f[1] : v0.y; vrow[c + 2] = isn ? f[2] : v0.z; vrow[c + 3] = isn ? f[3] : v0.w;
                vrow[c + 4] = isn ? f[4] : v1.x; vrow[c + 5] = isn ? f[5] : v1.y; vrow[c + 6] = isn ? f[6] : v1.z; vrow[c + 7] = isn ? f[7] : v1.w; }
            samp_update(sv, cw, vrow, m, l, part);
        }
#pragma unroll 1
        for (int s = 1; s < 21; ++s) {
            const int P = s < 9 ? 2051 - (16 * s + g) : (s < 15 ? 1536 + 64 * (s - 9) + lane : qi + 16 * (16 * (s - 15) + g));
            const float cw = (s < 9 && P < 1920) ? 0.f : samp_cw(WBUF + qi - P);
            const float* kr = ckb + (size_t)P * ATT_WIDTH;
            float a = 0.f;
#pragma unroll
            for (int c = 0; c < 64; c += 4) { const float4 kv = *(const float4*)(kr + c); a += kv.x * qv[c] + kv.y * qv[c + 1] + kv.z * qv[c + 2] + kv.w * qv[c + 3]; }
            const float sv = cw > 0.f ? a * 0.125f : -1e30f;
            __builtin_amdgcn_sched_barrier(0);
            const float* vr = cvb + (size_t)P * ATT_WIDTH;
            float vrow[64];
#pragma unroll
            for (int c = 0; c < 64; c += 4) { const float4 vv = *(const float4*)(vr + c); vrow[c] = vv.x; vrow[c + 1] = vv.y; vrow[c + 2] = vv.z; vrow[c + 3] = vv.w; }
            samp_update(sv, cw, vrow, m, l, part);
        }
        float M = m;
        M = fmaxf(M, __shfl_xor(M, 4)); M = fmaxf(M, __shfl_xor(M, 8)); M = fmaxf(M, __shfl_xor(M, 16)); M = fmaxf(M, __shfl_xor(M, 32));
        const float sc = __expf(m - M);
        float lsum = l * sc;
        lsum += __shfl_xor(lsum, 4); lsum += __shfl_xor(lsum, 8); lsum += __shfl_xor(lsum, 16); lsum += __shfl_xor(lsum, 32);
#pragma unroll
        for (int c = 0; c < 64; ++c) part[c] *= sc;
        PEER_TR_STEP(32, 32) PEER_TR_STEP(16, 16) PEER_TR_STEP(8, 8) PEER_TR_STEP(4, 4)
        const float inv = 1.0f / lsum;
        *(uint2*)(A1 + (size_t)(tq0 + qi) * MIX_WIDTH + SSD_WIDTH + hd * 64 + 4 * g) = make_uint2(pk2(part[0] * inv, part[1] * inv), pk2(part[2] * inv, part[3] * inv));
    }
}

typedef float f32x16 __attribute__((ext_vector_type(16)));
typedef short s16x8 __attribute__((ext_vector_type(8)));
typedef short s16x4 __attribute__((ext_vector_type(4)));
typedef float f32x4v __attribute__((ext_vector_type(4)));
#define SSD_L_ACS 0
#define SSD_L_DTS 3072
#define SSD_L_BM 6144
#define SSD_RS_B 272
#define SSD_L_X (6144 + 128 * 272)
#define SSD_RS_X 144
#define SSD_XIMG (128 * 144)
#define SSD_RS_Y 784
template <int OFF0, int OFF1>
__device__ __forceinline__ s16x8 tr_frag(unsigned base) {
    s16x4 a, b;
    asm volatile("ds_read_b64_tr_b16 %0, %2 offset:%3\n\tds_read_b64_tr_b16 %1, %2 offset:%4\n\ts_waitcnt lgkmcnt(0)"
                 : "=&v"(a), "=&v"(b) : "v"(base), "n"(OFF0), "n"(OFF1) : "memory");
    return __builtin_shufflevector(a, b, 0, 1, 2, 3, 4, 5, 6, 7);
}
__device__ __forceinline__ unsigned lds_addr(LAS unsigned char* p) { return (unsigned)(size_t)p; }
template <int O0, int O1, int O2, int O3, int O4, int O5, int O6, int O7>
__device__ __forceinline__ void tr_read8(unsigned base, s16x4 (&v)[8]) {
    asm volatile("ds_read_b64_tr_b16 %0, %8 offset:%9\n\tds_read_b64_tr_b16 %1, %8 offset:%10\n\tds_read_b64_tr_b16 %2, %8 offset:%11\n\tds_read_b64_tr_b16 %3, %8 offset:%12\n\t"
                 "ds_read_b64_tr_b16 %4, %8 offset:%13\n\tds_read_b64_tr_b16 %5, %8 offset:%14\n\tds_read_b64_tr_b16 %6, %8 offset:%15\n\tds_read_b64_tr_b16 %7, %8 offset:%16\n\ts_waitcnt lgkmcnt(0)"
                 : "=&v"(v[0]), "=&v"(v[1]), "=&v"(v[2]), "=&v"(v[3]), "=&v"(v[4]), "=&v"(v[5]), "=&v"(v[6]), "=&v"(v[7])
                 : "v"(base), "n"(O0), "n"(O1), "n"(O2), "n"(O3), "n"(O4), "n"(O5), "n"(O6), "n"(O7) : "memory");
}
#define TRCAT(a, b) __builtin_shufflevector(a, b, 0, 1, 2, 3, 4, 5, 6, 7)


__device__ __forceinline__ void ssd_chunk_acs(LAS unsigned char* ldsb, const float* __restrict__ dtv, const float* __restrict__ a_log, int t0, int g, float* cdec_out) {
    const int w = __builtin_amdgcn_readfirstlane(threadIdx.x >> 6), lane = threadIdx.x & 63;
    if (w < 6) {
        const int head = 6 * g + w;
        const float A = -__expf(a_log[head]);
        const float v0 = dtv[(size_t)(t0 + 2 * lane) * SSD_HEADS + head], v1 = dtv[(size_t)(t0 + 2 * lane + 1) * SSD_HEADS + head];
        const float a1 = v1 * A;
        float s = v0 * A + a1;
#pragma unroll
        for (int o = 1; o < 64; o <<= 1) { const float tmp = __shfl_up(s, o); if (lane >= o) s += tmp; }
        LAS float* acs = (LAS float*)(ldsb + SSD_L_ACS) + w * 128;
        LAS float* dts = (LAS float*)(ldsb + SSD_L_DTS) + w * 128;
        acs[2 * lane] = s - a1; acs[2 * lane + 1] = s;
        dts[2 * lane] = v0; dts[2 * lane + 1] = v1;
        if (cdec_out && lane == 63) cdec_out[head] = __expf(s);
    }
}

__device__ __forceinline__ void ph_ssd_states(LAS unsigned char* ldsb, const bf16* __restrict__ xbc_b, const float* __restrict__ dtv, const float* __restrict__ a_log,
                                              bf16* __restrict__ Sbuf, float* __restrict__ cdec, const float* __restrict__ ck, const float* __restrict__ cv, float* __restrict__ out) {
    const int tid = threadIdx.x, w = __builtin_amdgcn_readfirstlane(tid >> 6), lane = tid & 63;
    const int r = lane & 31, h = lane >> 5, blk = (lane >> 4) & 1, q = (lane & 15) >> 2, pp = lane & 3;
    const int nt = w & 3, pt = w >> 2;
    for (int unit = blockIdx.x; unit < BATCH * 64 * SSD_GROUPS; unit += gridDim.x) {
        const int g = unit & 3, bc = unit >> 2;
        const int t0 = bc * 128;
        __syncthreads();
        ssd_chunk_acs(ldsb, dtv, a_log, t0, g, cdec + (size_t)bc * SSD_HEADS);
#pragma unroll
        for (int it_ = 0; it_ < 4; ++it_) { const int idx = tid + it_ * NTHR; const int row = idx >> 4, ch = idx & 15;
            const v4u v = *(const v4u*)(xbc_b + (size_t)(t0 + row) * CONV_DIM + 1536 + 128 * g + ch * 8);
            *(LAS v4u*)(ldsb + SSD_L_BM + row * SSD_RS_B + ch * 16) = v; }
        __syncthreads();
#pragma unroll
        for (int it_ = 0; it_ < 12; ++it_) { const int idx = tid + it_ * NTHR; const int hh = idx >> 10, rem = idx & 1023, row = rem >> 3, ch = rem & 7;
            const LAS float* acs = (const LAS float*)(ldsb + SSD_L_ACS) + hh * 128; const LAS float* dts = (const LAS float*)(ldsb + SSD_L_DTS) + hh * 128;
            const float wgt = dts[row] * __expf(acs[127] - acs[row]);
            float f[8]; unpack8(*(const v4u*)(xbc_b + (size_t)(t0 + row) * CONV_DIM + (6 * g + hh) * 64 + ch * 8), f);
            v4u o; o.x = pk2(f[0] * wgt, f[1] * wgt); o.y = pk2(f[2] * wgt, f[3] * wgt); o.z = pk2(f[4] * wgt, f[5] * wgt); o.w = pk2(f[6] * wgt, f[7] * wgt);
            *(LAS v4u*)(ldsb + SSD_L_X + hh * SSD_XIMG + row * SSD_RS_X + ch * 16) = o; }
        __syncthreads();
        f32x4n rider[16];
        copy_q_load(ck, cv, 12288u + (unsigned)(unit * NWAVE + w), (unsigned)lane, rider);
        const unsigned abase = lds_addr(ldsb + SSD_L_BM) + (8 * h + q) * SSD_RS_B + (32 * nt + 16 * blk + 4 * pp) * 2;
        s16x8 afr[8];
        { s16x4 av[8];
          tr_read8<0 * SSD_RS_B, 4 * SSD_RS_B, 16 * SSD_RS_B, 20 * SSD_RS_B, 32 * SSD_RS_B, 36 * SSD_RS_B, 48 * SSD_RS_B, 52 * SSD_RS_B>(abase, av);
          afr[0] = TRCAT(av[0], av[1]); afr[1] = TRCAT(av[2], av[3]); afr[2] = TRCAT(av[4], av[5]); afr[3] = TRCAT(av[6], av[7]);
          tr_read8<64 * SSD_RS_B, 68 * SSD_RS_B, 80 * SSD_RS_B, 84 * SSD_RS_B, 96 * SSD_RS_B, 100 * SSD_RS_B, 112 * SSD_RS_B, 116 * SSD_RS_B>(abase, av);
          afr[4] = TRCAT(av[0], av[1]); afr[5] = TRCAT(av[2], av[3]); afr[6] = TRCAT(av[4], av[5]); afr[7] = TRCAT(av[6], av[7]); }
#pragma unroll
        for (int hh = 0; hh < 6; ++hh) {
            const unsigned xb = lds_addr(ldsb + SSD_L_X + hh * SSD_XIMG) + (8 * h + q) * SSD_RS_X + (32 * pt + 16 * blk + 4 * pp) * 2;
            f32x16 acc;
#pragma unroll
            for (int i = 0; i < 16; ++i) acc[i] = 0.f;
            { s16x4 xv[8];
              tr_read8<0 * SSD_RS_X, 4 * SSD_RS_X, 16 * SSD_RS_X, 20 * SSD_RS_X, 32 * SSD_RS_X, 36 * SSD_RS_X, 48 * SSD_RS_X, 52 * SSD_RS_X>(xb, xv);
              acc = __builtin_amdgcn_mfma_f32_32x32x16_bf16(afr[0], TRCAT(xv[0], xv[1]), acc, 0, 0, 0);
              acc = __builtin_amdgcn_mfma_f32_32x32x16_bf16(afr[1], TRCAT(xv[2], xv[3]), acc, 0, 0, 0);
              acc = __builtin_amdgcn_mfma_f32_32x32x16_bf16(afr[2], TRCAT(xv[4], xv[5]), acc, 0, 0, 0);
              acc = __builtin_amdgcn_mfma_f32_32x32x16_bf16(afr[3], TRCAT(xv[6], xv[7]), acc, 0, 0, 0);
              tr_read8<64 * SSD_RS_X, 68 * SSD_RS_X, 80 * SSD_RS_X, 84 * SSD_RS_X, 96 * SSD_RS_X, 100 * SSD_RS_X, 112 * SSD_RS_X, 116 * SSD_RS_X>(xb, xv);
              acc = __builtin_amdgcn_mfma_f32_32x32x16_bf16(afr[4], TRCAT(xv[0], xv[1]), acc, 0, 0, 0);
              acc = __builtin_amdgcn_mfma_f32_32x32x16_bf16(afr[5], TRCAT(xv[2], xv[3]), acc, 0, 0, 0);
              acc = __builtin_amdgcn_mfma_f32_32x32x16_bf16(afr[6], TRCAT(xv[4], xv[5]), acc, 0, 0, 0);
              acc = __builtin_amdgcn_mfma_f32_32x32x16_bf16(afr[7], TRCAT(xv[6], xv[7]), acc, 0, 0, 0); }
            bf16* dst = Sbuf + ((size_t)bc * SSD_HEADS + 6 * g + hh) * 8192 + (size_t)(pt * 8 + 2 * nt) * 512 + r * 8 + 4 * h;
#pragma unroll
            for (int q4 = 0; q4 < 4; ++q4) *(uint2*)(dst + (q4 >> 1) * 512 + (q4 & 1) * 256) = make_uint2(pk2(acc[4 * q4], acc[4 * q4 + 1]), pk2(acc[4 * q4 + 2], acc[4 * q4 + 3]));
        }
        copy_q_store(out, 12288u + (unsigned)(unit * NWAVE + w), (unsigned)lane, rider);
    }
}

__device__ __forceinline__ void ph_ssd_scan(const bf16* __restrict__ Sbuf, const float* __restrict__ cdec, bf16* __restrict__ Hin, float* __restrict__ out, int rank, int nranks) {
    for (int idx = rank * NTHR + threadIdx.x; idx < BATCH * SSD_HEADS * 1024; idx += nranks * NTHR) {
        const int i = idx & 1023, hb = idx >> 10, hd = hb % SSD_HEADS, b = hb / SSD_HEADS;
        float st[8];
#pragma unroll
        for (int j = 0; j < 8; ++j) st[j] = 0.f;
#pragma unroll 8
        for (int c = 0; c < 64; ++c) {
            const size_t base = (((size_t)(b * 64 + c)) * SSD_HEADS + hd) * 8192 + (size_t)i * 8;
            v4u o; o.x = pk2(st[0], st[1]); o.y = pk2(st[2], st[3]); o.z = pk2(st[4], st[5]); o.w = pk2(st[6], st[7]);
            *(v4u*)(Hin + base) = o;
            float s[8]; unpack8(*(const v4u*)(Sbuf + base), s);
            const float a = cdec[(size_t)(b * 64 + c) * SSD_HEADS + hd];
#pragma unroll
            for (int j = 0; j < 8; ++j) st[j] = a * st[j] + s[j];
        }
        const int ln = i & 63, ks = (i >> 6) & 7, pt = i >> 9, p = 32 * pt + (ln & 31), n0 = 16 * ks + 8 * (ln >> 5);
        store8f(out + OUT_PS + (((size_t)b * SSD_HEADS + hd) * 64 + p) * 128 + n0, st);
    }
}

__device__ __forceinline__ void ph_ssd_out(LAS unsigned char* ldsb, const bf16* __restrict__ xbc_b, const bf16* __restrict__ projb, const float* __restrict__ dtv,
                                           const float* __restrict__ a_log, const float* __restrict__ d_skip, const float* __restrict__ norm_g,
                                           const bf16* __restrict__ Hin, bf16* __restrict__ A1) {
    const int tid = threadIdx.x, w = __builtin_amdgcn_readfirstlane(tid >> 6), lane = tid & 63;
    const int r = lane & 31, h = lane >> 5, blk = (lane >> 4) & 1, q = (lane & 15) >> 2, pp = lane & 3;
    const int hs = w >> 2, lt = hs ? 3 - (w & 3) : (w & 3);
    for (int unit = blockIdx.x; unit < BATCH * 64 * SSD_GROUPS; unit += gridDim.x) {
        const int g = unit & 3, bc = unit >> 2;
        const int t0 = bc * 128;
        __syncthreads();
        ssd_chunk_acs(ldsb, dtv, a_log, t0, g, nullptr);
#pragma unroll
        for (int it_ = 0; it_ < 4; ++it_) { const int idx = tid + it_ * NTHR; const int row = idx >> 4, ch = idx & 15;
            const v4u v = *(const v4u*)(xbc_b + (size_t)(t0 + row) * CONV_DIM + 1536 + 128 * g + ch * 8);
            *(LAS v4u*)(ldsb + SSD_L_BM + row * SSD_RS_B + ch * 16) = v; }
#pragma unroll
        for (int it_ = 0; it_ < 12; ++it_) { const int idx = tid + it_ * NTHR; const int hh = idx >> 10, rem = idx & 1023, row = rem >> 3, ch = rem & 7;
            const v4u v = *(const v4u*)(xbc_b + (size_t)(t0 + row) * CONV_DIM + (6 * g + hh) * 64 + ch * 8);
            *(LAS v4u*)(ldsb + SSD_L_X + hh * SSD_XIMG + row * SSD_RS_X + ch * 16) = v; }
        __syncthreads();
        const bf16* cp = xbc_b + (size_t)(t0 + 32 * lt + r) * CONV_DIM + 2048 + 128 * g + 8 * h;
        s16x8 cfr[8];
#pragma unroll
        for (int ks = 0; ks < 8; ++ks) cfr[ks] = *(const s16x8*)(cp + 16 * ks);
        const int lcol = 32 * lt + r;
        const LAS float* acsb = (const LAS float*)(ldsb + SSD_L_ACS) + 3 * hs * 128; const LAS float* dtsb = (const LAS float*)(ldsb + SSD_L_DTS) + 3 * hs * 128;
        const unsigned xb0 = lds_addr(ldsb + SSD_L_X + 3 * hs * SSD_XIMG) + (4 * h + q) * SSD_RS_X + (16 * blk + 4 * pp) * 2;
        unsigned ypk[3][16];
#pragma unroll
        for (int h3 = 0; h3 < 3; ++h3) {
            const LAS float* acs = acsb + h3 * 128; const LAS float* dts = dtsb + h3 * 128;
            const float myacs = acs[lcol];
            const float Dh = d_skip[6 * g + 3 * hs + h3];
            f32x16 y0, y1;
#pragma unroll
            for (int i = 0; i < 16; ++i) { y0[i] = 0.f; y1[i] = 0.f; }
            { const bf16* hp = Hin + ((size_t)bc * SSD_HEADS + 6 * g + 3 * hs + h3) * 8192 + lane * 8;
#pragma unroll
              for (int kh = 0; kh < 2; ++kh) {
                  s16x8 hf0[4], hf1[4];
#pragma unroll
                  for (int ks = 0; ks < 4; ++ks) { hf0[ks] = *(const s16x8*)(hp + (4 * kh + ks) * 512); hf1[ks] = *(const s16x8*)(hp + (8 + 4 * kh + ks) * 512); }
#pragma unroll
                  for (int ks = 0; ks < 4; ++ks) { y0 = __builtin_amdgcn_mfma_f32_32x32x16_bf16(cfr[4 * kh + ks], hf0[ks], y0, 0, 0, 0); y1 = __builtin_amdgcn_mfma_f32_32x32x16_bf16(cfr[4 * kh + ks], hf1[ks], y1, 0, 0, 0); }
                  __builtin_amdgcn_sched_barrier(0);
              } }
#pragma unroll
            for (int q4 = 0; q4 < 4; ++q4) {
                const f32x4v a4 = *(const LAS f32x4v*)(acs + 32 * lt + 8 * q4 + 4 * h);
                const float e0 = __expf(a4[0]), e1 = __expf(a4[1]), e2 = __expf(a4[2]), e3 = __expf(a4[3]);
                y0[4 * q4] *= e0; y0[4 * q4 + 1] *= e1; y0[4 * q4 + 2] *= e2; y0[4 * q4 + 3] *= e3;
                y1[4 * q4] *= e0; y1[4 * q4 + 1] *= e1; y1[4 * q4 + 2] *= e2; y1[4 * q4 + 3] *= e3;
            }
            __builtin_amdgcn_sched_barrier(0);
            for (int st = 0; st <= lt; ++st) {
                f32x16 cb;
#pragma unroll
                for (int i = 0; i < 16; ++i) cb[i] = 0.f;
#pragma unroll
                for (int ks = 0; ks < 8; ++ks) {
                    const s16x8 bfrag = *(const LAS s16x8*)(ldsb + SSD_L_BM + (32 * st + r) * SSD_RS_B + (16 * ks + 8 * h) * 2);
                    cb = __builtin_amdgcn_mfma_f32_32x32x16_bf16(bfrag, cfr[ks], cb, 0, 0, 0);
                }
                __builtin_amdgcn_sched_barrier(0);
                const unsigned xb = xb0 + h3 * SSD_XIMG + st * 32 * SSD_RS_X;
                s16x4 xv[8];
                tr_read8<0, 8 * SSD_RS_X, 64, 8 * SSD_RS_X + 64, 16 * SSD_RS_X, 24 * SSD_RS_X, 16 * SSD_RS_X + 64, 24 * SSD_RS_X + 64>(xb, xv);
#pragma unroll
                for (int kk = 0; kk < 2; ++kk) {
                    const int s0 = 32 * st + 16 * kk + 4 * h;
                    const f32x4v as0 = *(const LAS f32x4v*)(acs + s0), as1 = *(const LAS f32x4v*)(acs + s0 + 8);
                    const f32x4v ds0 = *(const LAS f32x4v*)(dts + s0), ds1 = *(const LAS f32x4v*)(dts + s0 + 8);
                    float wv[8];
#pragma unroll
                    for (int j = 0; j < 8; ++j) {
                        const int s = s0 + 8 * (j >> 2) + (j & 3);
                        const float asj = (j < 4) ? as0[j & 3] : as1[j & 3], dsj = (j < 4) ? ds0[j & 3] : ds1[j & 3];
                        float v = cb[8 * kk + j] * __expf(myacs - asj) * dsj;
                        v = (s <= lcol) ? v : 0.f;
                        v = (s == lcol) ? v + Dh : v;
                        wv[j] = v;
                    }
                    s16x8 afr;
                    { v4u o; o.x = pk2(wv[0], wv[1]); o.y = pk2(wv[2], wv[3]); o.z = pk2(wv[4], wv[5]); o.w = pk2(wv[6], wv[7]); afr = __builtin_bit_cast(s16x8, o); }
                    const s16x8 b0 = kk == 0 ? TRCAT(xv[0], xv[1]) : TRCAT(xv[4], xv[5]);
                    const s16x8 b1 = kk == 0 ? TRCAT(xv[2], xv[3]) : TRCAT(xv[6], xv[7]);
                    y0 = __builtin_amdgcn_mfma_f32_32x32x16_bf16(afr, b0, y0, 0, 0, 0);
                    y1 = __builtin_amdgcn_mfma_f32_32x32x16_bf16(afr, b1, y1, 0, 0, 0);
                    __builtin_amdgcn_sched_barrier(0);
                }
            }
#pragma unroll
            for (int i = 0; i < 8; ++i) { ypk[h3][i] = pk2(y0[2 * i], y0[2 * i + 1]); ypk[h3][8 + i] = pk2(y1[2 * i], y1[2 * i + 1]); }
            __builtin_amdgcn_sched_barrier(0);
        }
        __syncthreads();
        {
            LAS unsigned short* yst = (LAS unsigned short*)(ldsb + SSD_L_X);
#pragma unroll
            for (int h3 = 0; h3 < 3; ++h3)
#pragma unroll
                for (int ptile = 0; ptile < 2; ++ptile)
#pragma unroll
                    for (int i = 0; i < 8; ++i) {
                        const int reg = 2 * i;
                        const int l0 = 32 * lt + (reg & 3) + 8 * (reg >> 2) + 4 * h;
                        const int col = (3 * hs + h3) * 64 + 32 * ptile + r;
                        const unsigned v = ypk[h3][8 * ptile + i];
                        yst[l0 * (SSD_RS_Y / 2) + col] = (unsigned short)(v & 0xffffu);
                        yst[(l0 + 1) * (SSD_RS_Y / 2) + col] = (unsigned short)(v >> 16);
                    }
        }
        __syncthreads();
#pragma unroll
        for (int pass = 0; pass < 4; ++pass) {
            const int l = 4 * (pass * 8 + w) + (lane >> 4), i16 = lane & 15;
            float gv[3][8]; float ss = 0.f;
#pragma unroll
            for (int k = 0; k < 3; ++k) {
                const int col0 = 24 * i16 + 8 * k;
                float yv[8], zv[8];
                unpack8(*(const LAS v4u*)(ldsb + SSD_L_X + l * SSD_RS_Y + col0 * 2), yv);
                unpack8(*(const v4u*)(projb + (size_t)(t0 + l) * NB_LD + g * 384 + col0), zv);
#pragma unroll
                for (int j = 0; j < 8; ++j) { const float gg = yv[j] * silu_f(zv[j]); gv[k][j] = gg; ss += gg * gg; }
            }
            ss += __shfl_xor(ss, 1); ss += __shfl_xor(ss, 2); ss += __shfl_xor(ss, 4); ss += __shfl_xor(ss, 8);
            const float rstd = rsqrtf(ss * (1.0f / 384.0f) + LN_EPS);
#pragma unroll
            for (int k = 0; k < 3; ++k) {
                const int col0 = g * 384 + 24 * i16 + 8 * k;
                const float4 g0 = *(const float4*)(norm_g + col0), g1 = *(const float4*)(norm_g + col0 + 4);
                v4u o; o.x = pk2(gv[k][0] * rstd * g0.x, gv[k][1] * rstd * g0.y); o.y = pk2(gv[k][2] * rstd * g0.z, gv[k][3] * rstd * g0.w);
                o.z = pk2(gv[k][4] * rstd * g1.x, gv[k][5] * rstd * g1.y); o.w = pk2(gv[k][6] * rstd * g1.z, gv[k][7] * rstd * g1.w);
                *(v4u*)(A1 + (size_t)(t0 + l) * MIX_WIDTH + col0) = o;
            }
        }
    }
}

#define ATT_RS_V 144
#define ATT_VIMG (256 * ATT_RS_V)
#define ATT_HIMG (2 * ATT_VIMG)
#define ATT_PVT(KT) { \
        s16x4 vv_[8]; \
        tr_read8<(32 * KT) * ATT_RS_V, (32 * KT + 8) * ATT_RS_V, (32 * KT) * ATT_RS_V + 64, (32 * KT + 8) * ATT_RS_V + 64, \
                 (32 * KT + 16) * ATT_RS_V, (32 * KT + 24) * ATT_RS_V, (32 * KT + 16) * ATT_RS_V + 64, (32 * KT + 24) * ATT_RS_V + 64>(vbase, vv_); \
        _Pragma("unroll") for (int s2_ = 0; s2_ < 2; ++s2_) { \
            v4u o_; o_.x = pk2(s[KT][8 * s2_ + 0], s[KT][8 * s2_ + 1]); o_.y = pk2(s[KT][8 * s2_ + 2], s[KT][8 * s2_ + 3]); \
            o_.z = pk2(s[KT][8 * s2_ + 4], s[KT][8 * s2_ + 5]); o_.w = pk2(s[KT][8 * s2_ + 6], s[KT][8 * s2_ + 7]); \
            const s16x8 pf_ = __builtin_bit_cast(s16x8, o_); \
            const s16x8 a0_ = s2_ == 0 ? TRCAT(vv_[0], vv_[1]) : TRCAT(vv_[4], vv_[5]); \
            const s16x8 a1_ = s2_ == 0 ? TRCAT(vv_[2], vv_[3]) : TRCAT(vv_[6], vv_[7]); \
            o0 = __builtin_amdgcn_mfma_f32_32x32x16_bf16(a0_, pf_, o0, 0, 0, 0); \
            o1 = __builtin_amdgcn_mfma_f32_32x32x16_bf16(a1_, pf_, o1, 0, 0, 0); } }
__device__ __forceinline__ void ph_attn_prompt(LAS unsigned char* ldsb, const bf16* __restrict__ qrot_b, const bf16* __restrict__ krot_b, const bf16* __restrict__ projb,
                                               bf16* __restrict__ obuf, float* __restrict__ lsebuf, const float* __restrict__ ck, const float* __restrict__ cv, float* __restrict__ out) {
    const int tid = threadIdx.x, w = __builtin_amdgcn_readfirstlane(tid >> 6), lane = tid & 63;
    const int r = lane & 31, h = lane >> 5, blk = (lane >> 4) & 1, q = (lane & 15) >> 2, pp = lane & 3;
    const int qt = w & 3, hsel = w >> 2;
    f32x4n rider[16]; bool pend = false; unsigned pq = 0u;
    for (int unit = blockIdx.x; unit < 3 * 512; unit += gridDim.x) {
        const int pat = unit >> 9, rem = unit & 511, hp = rem & 3, rem2 = rem >> 2, b = rem2 >> 6, bk = rem2 & 63;
        const int dsh = 2 * pat, nper = 64 >> dsh, res = bk >> (6 - dsh), nb = bk & (nper - 1);
        const int head = 2 * hp + hsel;
        __syncthreads();
        { v4u vst[8], kst[8];
#pragma unroll
          for (int it_ = 0; it_ < 8; ++it_) { const int idx = (tid & 255) + it_ * 256;
              const int row = idx >> 3, ch = idx & 7, js = 128 * nb - 128 + row, jc = js < 0 ? 0 : js;
              const size_t tk = (size_t)(b * SEQ + (jc << dsh) + res);
              vst[it_] = *(const v4u*)(projb + tk * NB_LD + NB_V + head * 64 + ch * 8);
              kst[it_] = *(const v4u*)(krot_b + tk * ATT_WIDTH + head * 64 + ch * 8); }
#pragma unroll
          for (int it_ = 0; it_ < 8; ++it_) { const int idx = (tid & 255) + it_ * 256;
              const int row = idx >> 3, ch = idx & 7, js = 128 * nb - 128 + row;
              v4u v = vst[it_], k = kst[it_]; if (js < 0) { v.x = 0u; v.y = 0u; v.z = 0u; v.w = 0u; k = v; }
              *(LAS v4u*)(ldsb + hsel * ATT_HIMG + row * ATT_RS_V + ch * 16) = v;
              *(LAS v4u*)(ldsb + hsel * ATT_HIMG + ATT_VIMG + row * ATT_RS_V + ch * 16) = k; } }
        const int tq = b * SEQ + ((128 * nb + 32 * qt + r) << dsh) + res;
        s16x8 qf[4];
#pragma unroll
        for (int ks = 0; ks < 4; ++ks) qf[ks] = *(const s16x8*)(qrot_b + (size_t)tq * ATT_WIDTH + head * 64 + 16 * ks + 8 * h);
        __syncthreads();
        f32x16 s[5];
#pragma unroll
        for (int kt = 0; kt < 5; ++kt) {
            const LAS unsigned char* kp = ldsb + hsel * ATT_HIMG + ATT_VIMG + (32 * qt + 32 * kt + r) * ATT_RS_V + 16 * h;
#pragma unroll
            for (int i = 0; i < 16; ++i) s[kt][i] = 0.f;
#pragma unroll
            for (int ks = 0; ks < 4; ++ks) s[kt] = __builtin_amdgcn_mfma_f32_32x32x16_bf16(*(const LAS s16x8*)(kp + 32 * ks), qf[ks], s[kt], 0, 0, 0);
        }
        if (pend) copy_q_store(out, pq, (unsigned)lane, rider);
        float m = -INFINITY;
#pragma unroll
        for (int kt = 0; kt < 5; ++kt) {
            const bool tile_ok = (nb > 0) || (qt + kt >= 4);
#pragma unroll
            for (int reg = 0; reg < 16; ++reg) {
                const int c = (reg & 3) + 8 * (reg >> 2) + 4 * h;
                const bool ok = tile_ok && (kt == 0 ? (c >= r) : (kt == 4 ? (c <= r) : true));
                const float v = ok ? s[kt][reg] * 0.125f : -INFINITY;
                s[kt][reg] = v; m = fmaxf(m, v);
            }
        }
        m = fmaxf(m, __shfl_xor(m, 32));
        float l = 0.f;
#pragma unroll
        for (int kt = 0; kt < 5; ++kt)
#pragma unroll
            for (int reg = 0; reg < 16; ++reg) { const float p = __expf(s[kt][reg] - m); s[kt][reg] = p; l += p; }
        l += __shfl_xor(l, 32);
        pq = (unsigned)(unit * NWAVE + w); copy_q_load(ck, cv, pq, (unsigned)lane, rider); pend = true;
        f32x16 o0, o1;
#pragma unroll
        for (int i = 0; i < 16; ++i) { o0[i] = 0.f; o1[i] = 0.f; }
        const unsigned vbase = lds_addr(ldsb + hsel * ATT_HIMG) + (32 * qt + 4 * h + q) * ATT_RS_V + (16 * blk + 4 * pp) * 2;
        ATT_PVT(0) ATT_PVT(1) ATT_PVT(2) ATT_PVT(3) ATT_PVT(4)
        const float inv = 1.0f / l;
        bf16* op = obuf + ((size_t)pat * T_PROMPT + tq) * ATT_WIDTH + head * 64 + 8 * h;
#pragma unroll
        for (int k2 = 0; k2 < 4; ++k2) {
            unsigned ax, ay, bx, by;
            if (k2 < 2) { ax = pk2(o0[8 * k2] * inv, o0[8 * k2 + 1] * inv); ay = pk2(o0[8 * k2 + 2] * inv, o0[8 * k2 + 3] * inv);
                          bx = pk2(o0[8 * k2 + 4] * inv, o0[8 * k2 + 5] * inv); by = pk2(o0[8 * k2 + 6] * inv, o0[8 * k2 + 7] * inv); }
            else { const int k3 = k2 - 2;
                   ax = pk2(o1[8 * k3] * inv, o1[8 * k3 + 1] * inv); ay = pk2(o1[8 * k3 + 2] * inv, o1[8 * k3 + 3] * inv);
                   bx = pk2(o1[8 * k3 + 4] * inv, o1[8 * k3 + 5] * inv); by = pk2(o1[8 * k3 + 6] * inv, o1[8 * k3 + 7] * inv); }
            const auto rx = __builtin_amdgcn_permlane32_swap(ax, bx, false, false);
            const auto ry = __builtin_amdgcn_permlane32_swap(ay, by, false, false);
            v4u o; o.x = rx[0]; o.y = ry[0]; o.z = rx[1]; o.w = ry[1];
            *(v4u*)(op + 16 * k2) = o;
        }
        if (h == 0) lsebuf[((size_t)pat * T_PROMPT + tq) * 8 + head] = m + __logf(l);
    }
    if (pend) copy_q_store(out, pq, (unsigned)lane, rider);
}
__device__ __forceinline__ void ph_attn_combine(const bf16* __restrict__ obuf, const float* __restrict__ lsebuf, bf16* __restrict__ A1) {
    const int lane = threadIdx.x & 63;
#pragma unroll 4
    for (int t = blockIdx.x * NWAVE + (threadIdx.x >> 6); t < T_PROMPT; t += gridDim.x * NWAVE) {
        const int hd = lane >> 3;
        const float l0 = lsebuf[((size_t)0 * T_PROMPT + t) * 8 + hd], l1 = lsebuf[((size_t)1 * T_PROMPT + t) * 8 + hd], l2 = lsebuf[((size_t)2 * T_PROMPT + t) * 8 + hd];
        const float mx = fmaxf(l0, fmaxf(l1, l2));
        const float e0 = __expf(l0 - mx), e1 = __expf(l1 - mx), e2 = __expf(l2 - mx);
        const float inv = 1.0f / (e0 + e1 + e2);
        float a[8], b[8], c[8];
        unpack8(*(const v4u*)(obuf + ((size_t)0 * T_PROMPT + t) * ATT_WIDTH + lane * 8), a);
        unpack8(*(const v4u*)(obuf + ((size_t)1 * T_PROMPT + t) * ATT_WIDTH + lane * 8), b);
        unpack8(*(const v4u*)(obuf + ((size_t)2 * T_PROMPT + t) * ATT_WIDTH + lane * 8), c);
        float o[8];
#pragma unroll
        for (int j = 0; j < 8; ++j) o[j] = (e0 * a[j] + e1 * b[j] + e2 * c[j]) * inv;
        v4u w; w.x = pk2(o[0], o[1]); w.y = pk2(o[2], o[3]); w.z = pk2(o[4], o[5]); w.w = pk2(o[6], o[7]);
        *(v4u*)(A1 + (size_t)t * MIX_WIDTH + SSD_WIDTH + lane * 8) = w;
    }
}

#define RT_RS 272
#define RT_KIMG (128 * RT_RS)
#define RT_LUT (2 * RT_KIMG)
constexpr unsigned char RT_CANDS[64] = {0, 1, 2, 3, 4, 5, 6, 7, 8, 9, 10, 11, 12, 13, 14, 15, 16, 17, 18, 19, 20, 21, 22, 23, 32, 33, 34, 35, 36, 48, 49, 50, 51, 64, 65, 66, 80, 81, 96, 97,
                                        112, 113, 128, 144, 160, 176, 192, 208, 224, 240, 0, 0, 0, 0, 0, 0, 0, 0, 0, 0, 0, 0, 0, 0};
__device__ __forceinline__ unsigned rt_mono(float f) { const unsigned u = __builtin_bit_cast(unsigned, f); return u ^ ((unsigned)((int)u >> 31) | 0x80000000u); }
__device__ __forceinline__ float rt_unmono(unsigned m) { const unsigned u = (m & 0x80000000u) ? (m ^ 0x80000000u) : ~m; return __builtin_bit_cast(float, u); }
#define RT_CE_DESC(a, b) { const unsigned x_ = (a), y_ = (b); (a) = x_ > y_ ? x_ : y_; (b) = x_ > y_ ? y_ : x_; }
#define RT_CE_ASC(a, b) { const unsigned x_ = (a), y_ = (b); (a) = x_ > y_ ? y_ : x_; (b) = x_ > y_ ? x_ : y_; }
__device__ __forceinline__ void rt_sort16(unsigned (&v)[16]) {
#pragma unroll
    for (int k = 2; k <= 16; k <<= 1)
#pragma unroll
        for (int j = k >> 1; j > 0; j >>= 1)
#pragma unroll
            for (int i = 0; i < 16; ++i) { const int l = i ^ j; if (l > i) { if ((i & k) == 0) RT_CE_DESC(v[i], v[l]) else RT_CE_ASC(v[i], v[l]) } }
}
__device__ __forceinline__ void rt_merge16(unsigned (&v)[16]) {
#pragma unroll
    for (int j = 8; j > 0; j >>= 1)
#pragma unroll
        for (int i = 0; i < 16; ++i) { const int l = i ^ j; if (l > i) RT_CE_DESC(v[i], v[l]) }
}
__device__ __forceinline__ void rt_top16(unsigned (&a)[16], const unsigned (&b)[16]) {
#pragma unroll
    for (int i = 0; i < 16; ++i) a[i] = a[i] > b[15 - i] ? a[i] : b[15 - i];
    rt_merge16(a);
}
__device__ __forceinline__ void rt_top16_partner(unsigned (&a)[16]) {
    unsigned b[16];
#pragma unroll
    for (int i = 0; i < 16; ++i) b[i] = (unsigned)__shfl_xor((int)a[i], 32);
    rt_top16(a, b);
}
__device__ __forceinline__ void rt_scores_top16(LAS unsigned char* kimg, const bf16* __restrict__ qp, int r, int h, unsigned (&k0)[16]) {
    f32x16 acc[4];
#pragma unroll
    for (int kt = 0; kt < 4; ++kt)
#pragma unroll
        for (int i = 0; i < 16; ++i) acc[kt][i] = 0.f;
#pragma unroll
    for (int ks = 0; ks < 8; ++ks) {
        const s16x8 qf = *(const s16x8*)(qp + 16 * ks);
#pragma unroll
        for (int kt = 0; kt < 4; ++kt) {
            const s16x8 kf = *(const LAS s16x8*)(kimg + (32 * kt + r) * RT_RS + (16 * ks + 8 * h) * 2);
            acc[kt] = __builtin_amdgcn_mfma_f32_32x32x16_bf16(kf, qf, acc[kt], 0, 0, 0);
        }
    }
    unsigned k1[16], k2[16], k3[16];
#pragma unroll
    for (int reg = 0; reg < 16; ++reg) {
        const unsigned ki = (unsigned)((reg & 3) + 8 * (reg >> 2) + 4 * h);
        k0[reg] = (rt_mono(acc[0][reg]) & 0xFFFFFF80u) | ki;
        k1[reg] = (rt_mono(acc[1][reg]) & 0xFFFFFF80u) | (ki + 32u);
        k2[reg] = (rt_mono(acc[2][reg]) & 0xFFFFFF80u) | (ki + 64u);
        k3[reg] = (rt_mono(acc[3][reg]) & 0xFFFFFF80u) | (ki + 96u);
    }
    rt_sort16(k0); rt_sort16(k1); rt_sort16(k2); rt_sort16(k3);
    rt_top16(k0, k1); rt_top16(k2, k3); rt_top16(k0, k2);
    rt_top16_partner(k0);
}
__device__ __forceinline__ void ph_peer_route2(LAS unsigned char* ldsb, const bf16* __restrict__ qhb, const float* __restrict__ keys1, const float* __restrict__ keys2,
                                               int* __restrict__ eidx, float* __restrict__ gate, const float* __restrict__ ck, const float* __restrict__ cv, float* __restrict__ out) {
    const int tid = threadIdx.x, w = __builtin_amdgcn_readfirstlane(tid >> 6), lane = tid & 63, r = lane & 31, h = lane >> 5;
    __syncthreads();
    for (int idx = tid; idx < 2 * 128 * 16; idx += NTHR) {
        const int tb = idx >> 11, rem = idx & 2047, row = rem >> 4, ch = rem & 15;
        const float* sp = (tb ? keys2 : keys1) + row * 128 + ch * 8;
        const float4 a = *(const float4*)sp, b = *(const float4*)(sp + 4);
        v4u o; o.x = pk2(a.x, a.y); o.y = pk2(a.z, a.w); o.z = pk2(b.x, b.y); o.w = pk2(b.z, b.w);
        *(LAS v4u*)(ldsb + tb * RT_KIMG + row * RT_RS + ch * 16) = o;
    }
    __syncthreads();
    LAS unsigned* lut = (LAS unsigned*)(ldsb + RT_LUT) + w * 512;
    for (int k = 0;; ++k) {
        int unit;
        if (gridDim.x != 256) { unit = blockIdx.x * NWAVE + w + k * (int)(gridDim.x * NWAVE); if (unit >= (T_ALL / 32) * 8) break; }
        else if (k < 2) unit = k * 2048 + blockIdx.x * NWAVE + w;
        else if (k == 2 && w == 0 && blockIdx.x < 128) unit = 4096 + (int)blockIdx.x;
        else break;
        const int tt = unit >> 3, hd = unit & 7;
        const int tok = 32 * tt + r;
        const bf16* qp = qhb + (size_t)tok * 2048 + hd * 256 + 8 * h;
        unsigned ka[16], kb[16];
        rt_scores_top16(ldsb, qp, r, h, ka);
        rt_scores_top16(ldsb + RT_KIMG, qp + 128, r, h, kb);
        float v1[16], v2[16];
#pragma unroll
        for (int i = 0; i < 16; ++i) { v1[i] = rt_unmono(ka[i] & 0xFFFFFF80u); v2[i] = rt_unmono(kb[i] & 0xFFFFFF80u); }
#pragma unroll
        for (int wd = 0; wd < 4; ++wd) {
            lut[wd * 64 + lane] = (ka[4 * wd] & 0x7Fu) | ((ka[4 * wd + 1] & 0x7Fu) << 8) | ((ka[4 * wd + 2] & 0x7Fu) << 16) | ((ka[4 * wd + 3] & 0x7Fu) << 24);
            lut[(4 + wd) * 64 + lane] = (kb[4 * wd] & 0x7Fu) | ((kb[4 * wd + 1] & 0x7Fu) << 8) | ((kb[4 * wd + 2] & 0x7Fu) << 16) | ((kb[4 * wd + 3] & 0x7Fu) << 24);
        }
        unsigned c0[16], c1[16];
        c0[0] = (rt_mono(h ? (v1[0] + v2[1]) : (v1[0] + v2[0])) & 0xFFFFFF00u) | (h ? 1u : 0u);
        c0[1] = (rt_mono(h ? (v1[0] + v2[3]) : (v1[0] + v2[2])) & 0xFFFFFF00u) | (h ? 3u : 2u);
        c0[2] = (rt_mono(h ? (v1[0] + v2[5]) : (v1[0] + v2[4])) & 0xFFFFFF00u) | (h ? 5u : 4u);
        c0[3] = (rt_mono(h ? (v1[0] + v2[7]) : (v1[0] + v2[6])) & 0xFFFFFF00u) | (h ? 7u : 6u);
        c0[4] = (rt_mono(h ? (v1[0] + v2[9]) : (v1[0] + v2[8])) & 0xFFFFFF00u) | (h ? 9u : 8u);
        c0[5] = (rt_mono(h ? (v1[0] + v2[11]) : (v1[0] + v2[10])) & 0xFFFFFF00u) | (h ? 11u : 10u);
        c0[6] = (rt_mono(h ? (v1[0] + v2[13]) : (v1[0] + v2[12])) & 0xFFFFFF00u) | (h ? 13u : 12u);
        c0[7] = (rt_mono(h ? (v1[0] + v2[15]) : (v1[0] + v2[14])) & 0xFFFFFF00u) | (h ? 15u : 14u);
        c0[8] = (rt_mono(h ? (v1[1] + v2[1]) : (v1[1] + v2[0])) & 0xFFFFFF00u) | (h ? 17u : 16u);
        c0[9] = (rt_mono(h ? (v1[1] + v2[3]) : (v1[1] + v2[2])) & 0xFFFFFF00u) | (h ? 19u : 18u);
        c0[10] = (rt_mono(h ? (v1[1] + v2[5]) : (v1[1] + v2[4])) & 0xFFFFFF00u) | (h ? 21u : 20u);
        c0[11] = (rt_mono(h ? (v1[1] + v2[7]) : (v1[1] + v2[6])) & 0xFFFFFF00u) | (h ? 23u : 22u);
        c0[12] = (rt_mono(h ? (v1[2] + v2[1]) : (v1[2] + v2[0])) & 0xFFFFFF00u) | (h ? 33u : 32u);
        c0[13] = (rt_mono(h ? (v1[2] + v2[3]) : (v1[2] + v2[2])) & 0xFFFFFF00u) | (h ? 35u : 34u);
        c0[14] = (rt_mono(h ? (v1[3] + v2[0]) : (v1[2] + v2[4])) & 0xFFFFFF00u) | (h ? 48u : 36u);
        c0[15] = (rt_mono(h ? (v1[3] + v2[2]) : (v1[3] + v2[1])) & 0xFFFFFF00u) | (h ? 50u : 49u);
        c1[0] = (rt_mono(h ? (v1[4] + v2[0]) : (v1[3] + v2[3])) & 0xFFFFFF00u) | (h ? 64u : 51u);
        c1[1] = (rt_mono(h ? (v1[4] + v2[2]) : (v1[4] + v2[1])) & 0xFFFFFF00u) | (h ? 66u : 65u);
        c1[2] = (rt_mono(h ? (v1[5] + v2[1]) : (v1[5] + v2[0])) & 0xFFFFFF00u) | (h ? 81u : 80u);
        c1[3] = (rt_mono(h ? (v1[6] + v2[1]) : (v1[6] + v2[0])) & 0xFFFFFF00u) | (h ? 97u : 96u);
        c1[4] = (rt_mono(h ? (v1[7] + v2[1]) : (v1[7] + v2[0])) & 0xFFFFFF00u) | (h ? 113u : 112u);
        c1[5] = (rt_mono(h ? (v1[9] + v2[0]) : (v1[8] + v2[0])) & 0xFFFFFF00u) | (h ? 144u : 128u);
        c1[6] = (rt_mono(h ? (v1[11] + v2[0]) : (v1[10] + v2[0])) & 0xFFFFFF00u) | (h ? 176u : 160u);
        c1[7] = (rt_mono(h ? (v1[13] + v2[0]) : (v1[12] + v2[0])) & 0xFFFFFF00u) | (h ? 208u : 192u);
        c1[8] = (rt_mono(h ? (v1[15] + v2[0]) : (v1[14] + v2[0])) & 0xFFFFFF00u) | (h ? 240u : 224u);
        c1[9] = 0u;
        c1[10] = 0u;
        c1[11] = 0u;
        c1[12] = 0u;
        c1[13] = 0u;
        c1[14] = 0u;
        c1[15] = 0u;
        rt_sort16(c0); rt_sort16(c1); rt_top16(c0, c1); rt_top16_partner(c0);
        float e[16]; float sum = 0.f;
        const float mx = rt_unmono(c0[0] & 0xFFFFFF00u);
#pragma unroll
        for (int k = 0; k < 16; ++k) { e[k] = __expf(rt_unmono(c0[k] & 0xFFFFFF00u) - mx); sum += e[k]; }
        const float inv = 1.0f / sum;
        asm volatile("s_waitcnt lgkmcnt(0)" ::: "memory");
        int ex[8]; float gv[8];
#pragma unroll
        for (int k = 0; k < 8; ++k) {
            const unsigned hm = (unsigned)(-h);
            const unsigned ck = (c0[k] & ~hm) | (c0[8 + k] & hm);
            const float ek = __builtin_bit_cast(float, (__builtin_bit_cast(unsigned, e[k]) & ~hm) | (__builtin_bit_cast(unsigned, e[8 + k]) & hm));
            const unsigned ci = (ck >> 4) & 15u, cj = ck & 15u;
            const unsigned w1 = lut[(ci >> 2) * 64 + lane], w2 = lut[(4 + (cj >> 2)) * 64 + lane];
            const unsigned i1 = (w1 >> (8 * (ci & 3))) & 0x7Fu, i2 = (w2 >> (8 * (cj & 3))) & 0x7Fu;
            ex[k] = (int)(i1 * PEER_NKEYS + i2); gv[k] = ek * inv;
        }
        int* ep = eidx + (size_t)tok * 128 + hd * 16 + 8 * h; float* gp = gate + (size_t)tok * 128 + hd * 16 + 8 * h;
        *(int4*)ep = make_int4(ex[0], ex[1], ex[2], ex[3]); *(int4*)(ep + 4) = make_int4(ex[4], ex[5], ex[6], ex[7]);
        *(float4*)gp = make_float4(gv[0], gv[1], gv[2], gv[3]); *(float4*)(gp + 4) = make_float4(gv[4], gv[5], gv[6], gv[7]);
    }
    if (gridDim.x == 256 && (w != 0 || blockIdx.x >= 128)) {
        const unsigned si = blockIdx.x < 128 ? blockIdx.x * 7u + (unsigned)(w - 1) : 896u + (blockIdx.x - 128u) * 8u + (unsigned)w;
        cache_copy_slice(ck, cv, out, 7040u + si, (unsigned)lane);
    }
}

struct Params {
    const float* in[23];
    float* out;
    unsigned char* ws;
    unsigned* bar;
};

#define WS_BAR      0ull
#define WS_XALL     (1ull << 20)
#define WS_PROJ     (WS_XALL + (size_t)T_ALL * D_MODEL * 4)
#define WS_XBC      (WS_PROJ + (size_t)T_ALL * PROJ_LD * 4)
#define WS_DT       (WS_XBC + (size_t)T_ALL * CONV_DIM * 4)
#define WS_QROT     (WS_DT + (size_t)T_ALL * SSD_HEADS * 4)
#define WS_KROT     (WS_QROT + (size_t)T_ALL * ATT_WIDTH * 4)
#define WS_YBUF     (WS_KROT + (size_t)T_ALL * ATT_WIDTH * 4)
#define WS_MIX      (WS_YBUF + (size_t)T_ALL * MIX_WIDTH * 4)
#define WS_HBUF     (WS_MIX + (size_t)T_ALL * D_MODEL * 4)
#define WS_QH       (WS_HBUF + (size_t)T_ALL * D_MODEL * 4)
#define WS_EIDX     (WS_QH + (size_t)T_ALL * 2048 * 4)
#define WS_GATE     (WS_EIDX + (size_t)T_ALL * 128 * 4)
#define WS_A0       (WS_GATE + (size_t)T_ALL * 128 * 4)
#define WS_A1       (WS_A0 + (size_t)T_ALL * D_MODEL * 2)
#define WS_A2       (WS_A1 + (size_t)T_ALL * MIX_WIDTH * 2)
#define WS_WTIN     (WS_A2 + (size_t)T_ALL * D_MODEL * 2)
#define WS_WTOUT    (WS_WTIN + (size_t)PROJ_LD * D_MODEL * 2)
#define WS_WTQ      (WS_WTOUT + (size_t)D_MODEL * MIX_WIDTH * 2)
#define WS_PROJB    (WS_WTQ + (size_t)2048 * D_MODEL * 2)
#define WS_DTRAW    (WS_PROJB + (size_t)T_ALL * NB_LD * 2)
#define WS_XBCB     (WS_DTRAW + (size_t)T_ALL * 32 * 4)
#define WS_QROTB    (WS_XBCB + (size_t)T_ALL * CONV_DIM * 2)
#define WS_KROTB    (WS_QROTB + (size_t)T_ALL * ATT_WIDTH * 2)
#define WS_UB       (WS_KROTB + (size_t)T_ALL * ATT_WIDTH * 2)
#define WS_VB       (WS_UB + (size_t)16384 * D_MODEL * 2)
#define WS_USC      (WS_VB + (size_t)16384 * D_MODEL * 2)
#define WS_VSC      (WS_USC + 16384 * 4)
#define WS_SBUF     (WS_VSC + 16384 * 4)
#define WS_HIN      (WS_SBUF + (size_t)BATCH * 64 * SSD_HEADS * 64 * 128 * 2)
#define WS_CDEC     (WS_HIN + (size_t)BATCH * 64 * SSD_HEADS * 64 * 128 * 2)
#define WS_OBUF     (WS_CDEC + (size_t)BATCH * 64 * SSD_HEADS * 4)
#define WS_LSE      (WS_OBUF + (size_t)3 * T_PROMPT * ATT_WIDTH * 2)
#define WS_ROPE     (WS_LSE + (size_t)3 * T_PROMPT * 8 * 4)
#define WS_END      (WS_ROPE + (size_t)SEQ * 64 * 4)

#define LDS_BYTES (160 * 1024)

#define KP const __attribute__((address_space(4))) Params* kp = (const __attribute__((address_space(4))) Params*)__builtin_amdgcn_kernarg_segment_ptr(); asm volatile("" : "+s"(kp)); unsigned char* ws = kp->ws; (void)ws;
#define IN(i) (kp->in[i])
#define WSP(T, off) ((T*)(ws + (off)))
__global__ void __launch_bounds__(512, 2) mega_fwd(Params p) {
    extern __shared__ __attribute__((aligned(16))) unsigned char smem[];
    if (threadIdx.x == 0) *(uint4*)smem = make_uint4(0u, 0u, 0u, 0u);
    __syncthreads();
    XcdBarrier bar = xcd_barrier_post(p.bar, (volatile LAS unsigned*)smem);
    float* lds = (float*)(smem + 256);
    LAS unsigned char* ldsb = (LAS unsigned char*)smem + 256;

    { KP ph_prologue(ldsb, IN(0), IN(1), WSP(bf16, WS_A0), IN(6), WSP(bf16, WS_WTIN), WSP(float, WS_ROPE)); }
    xcd_barrier(bar);
    { KP pg8::Gemm g{WSP(bf16, WS_A0), WSP(bf16, WS_WTIN), T_ALL, PROJ_LD, D_MODEL}; pg8::StaticOrder S; S.init(g.M, g.N, (int)gridDim.x, (int)blockIdx.x);
      pg8::EpiProj E{WSP(bf16, WS_PROJB), WSP(float, WS_DTRAW)}; pg8::gemm_phase<pg8::EpiProj, pg8::StaticOrder, false>(ldsb, g, S, E, nullptr); }
    xcd_barrier(bar);
    { KP ph_post_proj_prompt(WSP(bf16, WS_PROJB), WSP(float, WS_DTRAW), IN(7), IN(8), IN(9), WSP(float, WS_ROPE), WSP(bf16, WS_XBCB), WSP(float, WS_DT), WSP(bf16, WS_QROTB), WSP(bf16, WS_KROTB), kp->out); }
    { KP ph_post_proj2(WSP(bf16, WS_PROJB), WSP(float, WS_DTRAW), IN(4), IN(7), IN(8), IN(9), WSP(bf16, WS_XBCB), WSP(float, WS_DT), WSP(bf16, WS_QROTB), WSP(bf16, WS_KROTB), kp->out); }
    xcd_barrier(bar);
    { KP ph_ssd_states(ldsb, WSP(bf16, WS_XBCB), WSP(float, WS_DT), IN(10), WSP(bf16, WS_SBUF), WSP(float, WS_CDEC), IN(2), IN(3), kp->out); }
    __syncthreads();
    { KP ph_attn_prompt(ldsb, WSP(bf16, WS_QROTB), WSP(bf16, WS_KROTB), WSP(bf16, WS_PROJB), WSP(bf16, WS_OBUF), WSP(float, WS_LSE), IN(2), IN(3), kp->out); }
    __syncthreads();
    { KP ph_ssd_decode(WSP(bf16, WS_XBCB), WSP(float, WS_DT), IN(10), IN(11), IN(5), WSP(float, WS_YBUF), kp->out); }
    { KP ph_attn_sample3(lds, WSP(bf16, WS_QROTB), WSP(bf16, WS_KROTB), WSP(bf16, WS_PROJB), IN(2), IN(3), WSP(bf16, WS_A1)); }
    xcd_barrier(bar);
    if ((int)gridDim.x > 128) {
        if ((int)blockIdx.x < 96) { KP ph_ssd_scan(WSP(bf16, WS_SBUF), WSP(float, WS_CDEC), WSP(bf16, WS_HIN), kp->out, (int)blockIdx.x, 96); }
        else {
            { KP ph_prologue2(ldsb, IN(13), WSP(bf16, WS_WTOUT), IN(16), WSP(bf16, WS_WTQ), (int)blockIdx.x - 96, (int)gridDim.x - 96); }
            { KP ph_quant_tables(IN(19), IN(20), WSP(unsigned char, WS_UB), WSP(unsigned char, WS_VB), WSP(float, WS_USC), WSP(float, WS_VSC), (int)blockIdx.x - 96, (int)gridDim.x - 96); }
        }
    } else {
        { KP ph_ssd_scan(WSP(bf16, WS_SBUF), WSP(float, WS_CDEC), WSP(bf16, WS_HIN), kp->out, (int)blockIdx.x, (int)gridDim.x); }
        { KP ph_prologue2(ldsb, IN(13), WSP(bf16, WS_WTOUT), IN(16), WSP(bf16, WS_WTQ), (int)blockIdx.x, (int)gridDim.x); }
        { KP ph_quant_tables(IN(19), IN(20), WSP(unsigned char, WS_UB), WSP(unsigned char, WS_VB), WSP(float, WS_USC), WSP(float, WS_VSC), (int)blockIdx.x, (int)gridDim.x); }
    }
    xcd_barrier(bar);
    { KP ph_ssd_out(ldsb, WSP(bf16, WS_XBCB), WSP(bf16, WS_PROJB), WSP(float, WS_DT), IN(10), IN(11), IN(12), WSP(bf16, WS_HIN), WSP(bf16, WS_A1)); }
    { KP ph_attn_combine(WSP(bf16, WS_OBUF), WSP(float, WS_LSE), WSP(bf16, WS_A1)); }
    { KP ph_gate_norm(WSP(bf16, WS_PROJB), IN(12), WSP(float, WS_YBUF), WSP(bf16, WS_A1)); }
    xcd_barrier(bar);
    { KP pg8::Gemm g{WSP(bf16, WS_A1), WSP(bf16, WS_WTOUT), T_ALL, D_MODEL, MIX_WIDTH}; pg8::StaticOrder S; S.init(g.M, g.N, (int)gridDim.x, (int)blockIdx.x);
      pg8::EpiBf16Plain E{WSP(bf16, WS_MIX), D_MODEL}; pg8::gemm_phase<pg8::EpiBf16Plain, pg8::StaticOrder, false>(ldsb, g, S, E, nullptr); }
    if (blockIdx.x >= 8 && gridDim.x == 256) { KP cache_copy_slice(IN(2), IN(3), kp->out, 4096u + (blockIdx.x - 8) * 8u + (threadIdx.x >> 6), threadIdx.x & 63u); }
    xcd_barrier(bar);
    { KP ph_ln_res(IN(0), IN(1), WSP(bf16, WS_MIX), IN(14), IN(15), WSP(bf16, WS_A2)); }
    xcd_barrier(bar);
    { KP pg8::Gemm g{WSP(bf16, WS_A2), WSP(bf16, WS_WTQ), T_ALL, 2048, D_MODEL}; pg8::StaticOrder S; S.init(g.M, g.N, (int)gridDim.x, (int)blockIdx.x);
      pg8::EpiBf16Plain E{WSP(bf16, WS_QH), 2048}; pg8::gemm_phase<pg8::EpiBf16Plain, pg8::StaticOrder, false>(ldsb, g, S, E, nullptr); }
    if (blockIdx.x >= 16 && gridDim.x == 256 && threadIdx.x < 256) { KP cache_copy_slice(IN(2), IN(3), kp->out, 4096u + 1984u + (blockIdx.x - 16) * 4u + (threadIdx.x >> 6), threadIdx.x & 63u); }
    xcd_barrier(bar);
    { KP ph_peer_route2(ldsb, WSP(bf16, WS_QH), IN(17), IN(18), WSP(int, WS_EIDX), WSP(float, WS_GATE), IN(2), IN(3), kp->out); }
    xcd_barrier(bar);
    { KP ph_peer_ffn3(WSP(bf16, WS_A2), WSP(int, WS_EIDX), WSP(float, WS_GATE), WSP(unsigned char, WS_UB), WSP(unsigned char, WS_VB), WSP(float, WS_USC), WSP(float, WS_VSC), IN(21), IN(22), kp->out, IN(2), IN(3), gridDim.x == 256 ? 8960u : 4096u); }
}

extern "C" void kernel_launch(void* const* d_in, const int* in_sizes, int n_in, void* d_out, int out_size, void* d_ws, size_t ws_size, hipStream_t stream) {
    static int grid = 0;
    if (grid == 0) {
        int dev = 0, cus = 0, per_cu = 0;
        if (hipGetDevice(&dev) != hipSuccess || hipDeviceGetAttribute(&cus, hipDeviceAttributeMultiprocessorCount, dev) != hipSuccess) { fprintf(stderr, "kernel_launch: device query failed\n"); grid = -1; return; }
        if (hipFuncSetAttribute((const void*)mega_fwd, hipFuncAttributeMaxDynamicSharedMemorySize, LDS_BYTES) != hipSuccess) { fprintf(stderr, "kernel_launch: hipFuncSetAttribute failed\n"); grid = -1; return; }
        if (hipOccupancyMaxActiveBlocksPerMultiprocessor(&per_cu, (const void*)mega_fwd, NTHR, LDS_BYTES) != hipSuccess || per_cu < 1) { fprintf(stderr, "kernel_launch: occupancy query says %d\n", per_cu); }
        (void)hipGetLastError();
        grid = cus;
        if (ws_size < WS_END) { fprintf(stderr, "kernel_launch: workspace too small\n"); grid = -1; return; }
    }
    if (grid < 0) return;
    (void)hipMemsetAsync((char*)d_ws + WS_BAR, 0, XCD_BAR_WORDS * sizeof(unsigned), stream);
    Params p{};
    for (int i = 0; i < 23; ++i) p.in[i] = (const float*)d_in[i];
    p.out = (float*)d_out; p.ws = (unsigned char*)d_ws; p.bar = (unsigned*)((char*)d_ws + WS_BAR);
    hipLaunchKernelGGL(mega_fwd, dim3(grid), dim3(NTHR), LDS_BYTES, stream, p);
}
```

```cpp
#include <hip/hip_runtime.h>
#include <stdint.h>

#define D_MODEL 1024
#define BATCH 2
#define SEQ 8192
#define DEC_BATCH 128
#define DEC_SEQ 4
#define PAST_LEN 8192
#define HEAD_DIM 64
#define ATT_WIDTH 512
#define ATT_HEADS 8
#define SSD_WIDTH 1536
#define SSD_HEADS 24
#define SSD_GROUPS 4
#define SSD_STATE 128
#define CONV_DIM 2560
#define IN_WIDTH 5656
#define PROJ_LD 5888
#define MIX_WIDTH 2048
#define WBUF 2048
#define PEER_NKEYS 128
#define PEER_HEADS 8
#define PEER_TOPK 16
#define PEER_DKEY 256
#define T_PROMPT (BATCH * SEQ)
#define T_SAMPLE (DEC_BATCH * DEC_SEQ)
#define T_ALL (T_PROMPT + T_SAMPLE)
#define O_Z 0
#define O_XBC 1536
#define O_DT 4096
#define O_Q 4120
#define O_K 4632
#define O_V 5144
#define ALPHA_F 1.189207115002721f
#define LN_EPS 1e-5f

#define OUT_YP 0ull
#define OUT_YS (OUT_YP + 16777216ull)
#define OUT_PK (OUT_YS + 524288ull)
#define OUT_PV (OUT_PK + 2097152ull)
#define OUT_PC (OUT_PV + 2097152ull)
#define OUT_PS (OUT_PC + 15360ull)
#define OUT_SK (OUT_PS + 393216ull)
#define OUT_SV (OUT_SK + 134217728ull)
#define OUT_SC (OUT_SV + 134217728ull)
#define OUT_SS (OUT_SC + 983040ull)

__constant__ double ROPE_INV_REV[32] = {
    1.59154943091895346e-01, 1.19349370211248862e-01, 8.94994016088910133e-02, 6.71150830052272551e-02,
    5.03292121044870353e-02, 3.77415847174197711e-02, 2.83021958306233987e-02, 2.12236527647776604e-02,
    1.59154943091895339e-02, 1.19349370211248862e-02, 8.94994016088910237e-03, 6.71150830052272534e-03,
    5.03292121044870370e-03, 3.77415847174197719e-03, 2.83021958306233987e-03, 2.12236527647776622e-03,
    1.59154943091895356e-03, 1.19349370211248849e-03, 8.94994016088910237e-04, 6.71150830052272599e-04,
    5.03292121044870326e-04, 3.77415847174197741e-04, 2.83021958306233954e-04, 2.12236527647776605e-04,
    1.59154943091895351e-04, 1.19349370211248862e-04, 8.94994016088910182e-05, 6.71150830052272545e-05,
    5.03292121044870354e-05, 3.77415847174197768e-05, 2.83021958306233961e-05, 2.12236527647776592e-05
};

__device__ __forceinline__ float silu_f(float x) { return x * __builtin_amdgcn_rcpf(1.0f + __expf(-x)); }
__device__ __forceinline__ float softplus_f(float x) { return fmaxf(x, 0.f) + log1pf(__expf(-fabsf(x))); }
__device__ __forceinline__ float gelu_f(float x) { return 0.5f * x * (1.0f + erff(x * 0.70710678118654752f)); }
__device__ __forceinline__ float wave_sum(float v) {
#pragma unroll
    for (int o = 32; o > 0; o >>= 1) v += __shfl_xor(v, o);
    return v;
}
__device__ __forceinline__ float wave_max(float v) {
#pragma unroll
    for (int o = 32; o > 0; o >>= 1) v = fmaxf(v, __shfl_xor(v, o));
    return v;
}

#include <cstdio>
#define XB_TMO      128
#define XB_XCNT(j)  (256  + 64 * (j))
#define XB_XSUB(j)  (1280 + 64 * (j))
#define XB_XGEN(j)  (2304 + 64 * (j))
#define XB_TOP      3328
#define XB_TOPGEN   3392
#define XCD_BAR_WORDS 3456
#define XB_SPIN_CAP (1u << 18)
#define LAS __attribute__((address_space(3)))

__device__ __forceinline__ unsigned xb_ld(unsigned* p)              { return __hip_atomic_load(p, __ATOMIC_RELAXED, __HIP_MEMORY_SCOPE_AGENT); }
__device__ __forceinline__ unsigned xb_add(unsigned* p, unsigned v) { return __hip_atomic_fetch_add(p, v, __ATOMIC_RELAXED, __HIP_MEMORY_SCOPE_AGENT); }
__device__ __forceinline__ unsigned xb_xcc_id() { return (unsigned)__builtin_amdgcn_s_getreg((3 << 11) | 20) & 0xFu; }
#define XB_SPIN(cond, bar) do { unsigned _sp = 0; while (cond) { __builtin_amdgcn_s_sleep(1); \
    if ((++_sp & 255u) == 0u) { if (xb_ld(&(bar)[XB_TMO])) break; if (_sp > XB_SPIN_CAP) { atomicAdd(&(bar)[XB_TMO], 1u); break; } } } } while (0)

struct XcdBarrier {
    unsigned* bar; unsigned x;
    volatile LAS unsigned* st;
};

__device__ __forceinline__ XcdBarrier xcd_barrier_post(unsigned* bar, volatile LAS unsigned* st) {
    XcdBarrier b; b.bar = bar; b.x = xb_xcc_id(); b.st = st;
    if (threadIdx.x == 0) (void)xb_add(&bar[XB_XCNT(b.x)], 1u);
    return b;
}
__device__ __forceinline__ void xcd_barrier_complete(unsigned* bar, unsigned x, unsigned& nloc, unsigned& nx) {
    const unsigned G = gridDim.x * gridDim.y * gridDim.z;
    unsigned sum, cnt, mine, sp = 0u;
    for (;;) {
        sum = 0u; cnt = 0u; mine = 0u;
#pragma unroll
        for (unsigned j = 0; j < 16; ++j) { const unsigned c = xb_ld(&bar[XB_XCNT(j)]); sum += c; cnt += (c > 0u) ? 1u : 0u; mine = (j == x) ? c : mine; }
        if (sum == G) break;
        __builtin_amdgcn_s_sleep(1);
        if ((++sp & 255u) == 0u) { if (xb_ld(&bar[XB_TMO])) break; if (sp > XB_SPIN_CAP) { atomicAdd(&bar[XB_TMO], 1u); break; } }
    }
    nloc = mine > 0u ? mine : 1u; nx = cnt > 0u ? cnt : 1u;
}

__device__ __forceinline__ void xcd_barrier(const XcdBarrier& b) {
    asm volatile("s_waitcnt vmcnt(0)" ::: "memory");
    __syncthreads();
    if (threadIdx.x == 0) {
        unsigned* bar = b.bar;
        __builtin_amdgcn_s_waitcnt(0);
        unsigned nloc = b.st[0], nx = b.st[1];
        if (nloc == 0u) { xcd_barrier_complete(bar, b.x, nloc, nx); b.st[0] = nloc; b.st[1] = nx; }
        const unsigned old = xb_add(&bar[XB_XSUB(b.x)], 1u);
        const unsigned gen = old / nloc;
        if (old + 1u == (gen + 1u) * nloc) {
            __builtin_amdgcn_fence(__ATOMIC_RELEASE, "agent");
            asm volatile("s_waitcnt vmcnt(0)" ::: "memory");
            const unsigned og = xb_add(&bar[XB_TOP], 1u);
            const unsigned tg = og / nx;
            if (og + 1u == (tg + 1u) * nx) xb_add(&bar[XB_TOPGEN], 1u);
            else XB_SPIN(xb_ld(&bar[XB_TOPGEN]) == tg, bar);
            __builtin_amdgcn_fence(__ATOMIC_ACQUIRE, "agent");
            xb_add(&bar[XB_XGEN(b.x)], 1u);
            asm volatile("s_waitcnt vmcnt(0)" ::: "memory");
        } else {
            XB_SPIN(xb_ld(&bar[XB_XGEN(b.x)]) == gen, bar);
            __builtin_amdgcn_fence(__ATOMIC_ACQUIRE, "agent");
            asm volatile("s_waitcnt vmcnt(0)" ::: "memory");
        }
    }
    __syncthreads();
}


#define GAS __attribute__((address_space(1)))
typedef unsigned short bf16;
typedef unsigned v4u __attribute__((ext_vector_type(4)));
#define LDS_WAIT() asm volatile("s_waitcnt lgkmcnt(0)" ::: "memory")
__device__ __forceinline__ unsigned f2bf(float f) { unsigned u = __builtin_bit_cast(unsigned, f); return (u + 0x7fffu + ((u >> 16) & 1u)) >> 16; }
__device__ __forceinline__ unsigned pk2(float lo, float hi) { return f2bf(lo) | (f2bf(hi) << 16); }
__device__ __forceinline__ float bf2f(unsigned short b) { return __builtin_bit_cast(float, (unsigned)b << 16); }
#include <hip/hip_runtime.h>
namespace pg8 {
#define PG8_LAS __attribute__((address_space(3)))
typedef unsigned short bf16_t;
typedef short bf16x8 __attribute__((ext_vector_type(8)));
typedef float f32x4 __attribute__((ext_vector_type(4)));
typedef unsigned u32x4 __attribute__((ext_vector_type(4)));
constexpr int BM = 256, BK = 64, HALF = 128, HTB = HALF * BK * 2  , STAGE_BYTES = 8 * HTB, NXCD = 8, WGM = 8;

__host__ __device__ __forceinline__ int lds_byte(int r, int c) { const int st = (r >> 4) * 2 + (c >> 5), rr = r & 15, cc = c & 31, ob = rr * 64 + cc * 2; return st * 1024 + (ob ^ (((ob >> 9) & 1) << 5)); }
__host__ __device__ __forceinline__ void stage_rc(int b, int& R, int& C) { const int st = b / 1024, sb = b % 1024, swz = sb ^ (((sb >> 9) & 1) << 5); R = (st >> 1) * 16 + swz / 64; C = (st & 1) * 32 + (swz % 64) / 2; }
__host__ __device__ __forceinline__ int perm32(int rho) { const int n = rho >> 4, i = rho & 15; return 8 * (i >> 2) + 4 * n + (i & 3); }

struct Unit { int pm, pn; };
struct Gemm { const bf16_t* A; const bf16_t* Bt; int M, N, K; };

struct StaticOrder {
    int nM, nN, nwg, G, c;
    __host__ __device__ void init(int M, int N, int G_, int c_) { nM = M / BM; nN = N / BM; nwg = nM * nN; G = G_; c = c_; }
    __host__ __device__ bool next(int i, Unit& u) const {
        const long L = (long)i * G + c; if (L >= nwg) return false;
        int wgid = (int)L; { const int q = nwg / NXCD, r = nwg % NXCD, xcd = wgid % NXCD, off = wgid / NXCD; wgid = (xcd < r ? xcd * (q + 1) : r * (q + 1) + (xcd - r) * q) + off; }
        const int nig = WGM * nN, gid = wgid / nig, fm = gid * WGM, gsz = (nM - fm) < WGM ? (nM - fm) : WGM;
        u.pm = fm + ((wgid % nig) % gsz); u.pn = (wgid % nig) / gsz; return true;
    }
    __device__ __forceinline__ void a_ready(const Unit&) const {}
    __device__ __forceinline__ void done(const Unit&) const {}
};
__device__ __forceinline__ unsigned cvt_pk_bf16(float lo, float hi) { unsigned r; asm volatile("v_cvt_pk_bf16_f32 %0, %1, %2" : "=v"(r) : "v"(lo), "v"(hi)); return r; }
typedef float f32x2 __attribute__((ext_vector_type(2)));
__device__ __forceinline__ f32x2 gelu_pk(f32x2 v) {
    const f32x2 av = __builtin_elementwise_abs(v), d = av * 0.2316418882f + 1.0f;
    f32x2 t; t.x = __builtin_amdgcn_rcpf(d.x); t.y = __builtin_amdgcn_rcpf(d.y);
    f32x2 q = t * 0.5307027145f + (-0.7265760135f); q = q * t + 0.7107068705f; q = q * t + (-0.142248368f); q = q * t + 0.127414796f; q = q * t;
    const f32x2 s = (v * v) * (-0.72134752044f);
    f32x2 e; e.x = __builtin_amdgcn_exp2f(s.x); e.y = __builtin_amdgcn_exp2f(s.y);
    const f32x2 m = v * (q * e), r = v - m;
    f32x2 o; o.x = v.x < 0.f ? m.x : r.x; o.y = v.y < 0.f ? m.y : r.y; return o;
}

struct EpiF32 {
    static constexpr bool PERM = false, AFTER_DRAIN = false;
    float* C; int ldc; const float* bias;
    __device__ __forceinline__ void operator()(const f32x4 (&acc)[2][2][4][2], const Unit& u, int wr, int wc, int fr, int fq) const {
        const int row0 = u.pm * BM + wr * 64 + fr, col0 = u.pn * BM + wc * 32 + 4 * fq;
        f32x4 bv[2][2];
#pragma unroll
        for (int bj = 0; bj < 2; ++bj)
#pragma unroll
            for (int n = 0; n < 2; ++n) bv[bj][n] = bias ? *(const f32x4*)(bias + col0 + bj * HALF + n * 16) : (f32x4){0.f, 0.f, 0.f, 0.f};
#pragma unroll
        for (int ai = 0; ai < 2; ++ai)
#pragma unroll
            for (int m = 0; m < 4; ++m) { float* rowp = C + (size_t)(row0 + ai * HALF + m * 16) * ldc + col0;
#pragma unroll
                for (int bj = 0; bj < 2; ++bj)
#pragma unroll
                    for (int n = 0; n < 2; ++n) *(f32x4*)(rowp + bj * HALF + n * 16) = acc[ai][bj][m][n] + bv[bj][n]; }
    }
};

template <class Epi, class Sched, bool STAMP = false>
__device__ __forceinline__ void gemm_phase(PG8_LAS unsigned char* lds, const Gemm g, const Sched& S, const Epi& E, unsigned long long* stamps) {
    int tid = threadIdx.x; asm volatile("" : "+v"(tid));
    const int wid = __builtin_amdgcn_readfirstlane(tid >> 6), lane = tid & 63, wr = wid >> 2, wc = wid & 3, fr = lane & 15, fq = lane >> 4;
    const int K = g.K, nt = K / BK;
    int ts_lo = 0, ts_hi = 0, nts = 0; const unsigned long long rt_entry = STAMP ? (unsigned long long)wall_clock64() : 0ull;
#define PG8_STAMP() do { if (STAMP && wid == 0 && nts < 64) { const unsigned long long _c = (unsigned long long)clock64(); \
        ts_lo = (lane == nts) ? (int)(unsigned)_c : ts_lo; ts_hi = (lane == nts) ? (int)(unsigned)(_c >> 32) : ts_hi; ++nts; } } while (0)
    PG8_STAMP();
    unsigned voffA[2], voffB[2];
#pragma unroll
    for (int i = 0; i < 2; ++i) { int R, C; stage_rc(tid * 16 + i * 8192, R, C); const int Rb = Epi::PERM ? ((R & ~31) + perm32(R & 31)) : R;
        voffA[i] = (unsigned)(R * K + C) * 2u; voffB[i] = (unsigned)(Rb * K + C) * 2u; }
    const size_t kstep = (size_t)(BK * 2);
    const size_t hstep = (size_t)HALF * K * 2;
    const size_t tstep = 2 * hstep;
    const unsigned ldsw = (unsigned)wid * 1024u;
    const int aoff = lds_byte(wr * 64 + fr, fq * 8), boff = lds_byte(wc * 32 + fr, fq * 8);
#define PG8_SA(b, h) (((b) * 2 + (h)) * HTB)
#define PG8_SB(b, h) ((4 + (b) * 2 + (h)) * HTB)
#define PG8_STAGE(bufoff, gbase, voff) do { _Pragma("unroll") for (int _i = 0; _i < 2; ++_i) \
        __builtin_amdgcn_global_load_lds((const unsigned*)((const char*)(gbase) + (voff)[_i]), (PG8_LAS unsigned*)(lds + (bufoff) + ldsw + _i * 8192), 16, 0, 0); } while (0)
#define PG8_LDA(dst, b, h) do { _Pragma("unroll") for (int m = 0; m < 4; ++m) _Pragma("unroll") for (int k = 0; k < 2; ++k) dst[m][k] = *(const PG8_LAS bf16x8*)(lds + PG8_SA(b, h) + aoff + m * 2048 + k * 1024); } while (0)
#define PG8_LDB(dst, b, h) do { _Pragma("unroll") for (int n = 0; n < 2; ++n) _Pragma("unroll") for (int k = 0; k < 2; ++k) dst[n][k] = *(const PG8_LAS bf16x8*)(lds + PG8_SB(b, h) + boff + n * 2048 + k * 1024); } while (0)
#define PG8_MMA(ai, bj, At, Bt) do { __builtin_amdgcn_s_setprio(1); _Pragma("unroll") for (int m = 0; m < 4; ++m) _Pragma("unroll") for (int n = 0; n < 2; ++n) _Pragma("unroll") for (int k = 0; k < 2; ++k) \
        acc[ai][bj][m][n] = __builtin_amdgcn_mfma_f32_16x16x32_bf16(Bt[n][k], At[m][k], acc[ai][bj][m][n], 0, 0, 0); __builtin_amdgcn_s_setprio(0); } while (0)
#define PG8_WAIT_V(n) asm volatile("s_waitcnt vmcnt(" #n ")" ::: "memory")
#define PG8_WAIT_L(n) asm volatile("s_waitcnt lgkmcnt(" #n ")" ::: "memory")
#define PG8_BAR __builtin_amdgcn_s_barrier()
#define PG8_SCHED __builtin_amdgcn_sched_barrier(0)
    Unit cur, nxt; int ui = 0;
    if (!S.next(0, cur)) return;
    f32x4 acc[2][2][4][2];
#pragma unroll
    for (int a = 0; a < 2; ++a)
#pragma unroll
        for (int b = 0; b < 2; ++b)
#pragma unroll
            for (int m = 0; m < 4; ++m)
#pragma unroll
                for (int n = 0; n < 2; ++n) acc[a][b][m][n] = (f32x4){0.f, 0.f, 0.f, 0.f};
    bf16x8 At[4][2], B0[2][2], B1[2][2];
    const char* cA = (const char*)g.A + (size_t)cur.pm * tstep; const char* cB = (const char*)g.Bt + (size_t)cur.pn * tstep;
    S.a_ready(cur);
    PG8_STAGE(PG8_SB(0, 0), cB, voffB); PG8_STAGE(PG8_SA(0, 0), cA, voffA); PG8_STAGE(PG8_SB(0, 1), cB + hstep, voffB); PG8_STAGE(PG8_SA(0, 1), cA + hstep, voffA);
    if (wr == 1) PG8_BAR;
    PG8_WAIT_V(4); PG8_BAR;
    PG8_STAGE(PG8_SB(1, 0), cB + kstep, voffB); PG8_STAGE(PG8_SA(1, 0), cA + kstep, voffA); PG8_STAGE(PG8_SB(1, 1), cB + hstep + kstep, voffB);
    PG8_WAIT_V(6); PG8_BAR;
    PG8_STAMP();
    for (;;) {
        const bool has_next = S.next(ui + 1, nxt);
        const char* nA = has_next ? (const char*)g.A + (size_t)nxt.pm * tstep : cA; const char* nB = has_next ? (const char*)g.Bt + (size_t)nxt.pn * tstep : cB;
        for (int t = 0; t < nt; t += 2) {
            const bool last = (t == nt - 2);
            const char* a1 = cA + (size_t)(t + 1) * kstep;
            const char* a2 = last ? nA : cA + (size_t)(t + 2) * kstep; const char* b2 = last ? nB : cB + (size_t)(t + 2) * kstep;
            const char* a3 = a2 + kstep; const char* b3 = b2 + kstep;
            if (last && has_next) S.a_ready(nxt);
            PG8_LDB(B0, 0, 0); PG8_SCHED; PG8_LDA(At, 0, 0); PG8_STAGE(PG8_SA(1, 1), a1 + hstep, voffA);
            PG8_WAIT_L(8); PG8_BAR; PG8_WAIT_L(0); PG8_MMA(0, 0, At, B0); PG8_BAR; PG8_SCHED;
            PG8_LDB(B1, 0, 1); PG8_STAGE(PG8_SB(0, 0), b2, voffB);
            PG8_BAR; PG8_WAIT_L(0); PG8_MMA(0, 1, At, B1); PG8_BAR;
            PG8_LDA(At, 0, 1); PG8_STAGE(PG8_SA(0, 0), a2, voffA);
            PG8_BAR; PG8_WAIT_L(0); PG8_MMA(1, 0, At, B0); PG8_BAR; PG8_SCHED;
            PG8_STAGE(PG8_SB(0, 1), b2 + hstep, voffB);
            PG8_WAIT_V(6); PG8_BAR; PG8_MMA(1, 1, At, B1); PG8_BAR;
            PG8_LDB(B0, 1, 0); PG8_SCHED; PG8_LDA(At, 1, 0); PG8_STAGE(PG8_SA(0, 1), a2 + hstep, voffA);
            PG8_WAIT_L(8); PG8_BAR; PG8_WAIT_L(0); PG8_MMA(0, 0, At, B0); PG8_BAR; PG8_SCHED;
            PG8_LDB(B1, 1, 1); PG8_STAGE(PG8_SB(1, 0), b3, voffB);
            PG8_BAR; PG8_WAIT_L(0); PG8_MMA(0, 1, At, B1); PG8_BAR;
            PG8_LDA(At, 1, 1); PG8_STAGE(PG8_SA(1, 0), a3, voffA);
            PG8_BAR; PG8_WAIT_L(0); PG8_MMA(1, 0, At, B0); PG8_BAR; PG8_SCHED;
            PG8_STAGE(PG8_SB(1, 1), b3 + hstep, voffB);
            PG8_WAIT_V(6); PG8_BAR; PG8_MMA(1, 1, At, B1); PG8_BAR;
        }
        PG8_STAMP();
        if constexpr (!Epi::AFTER_DRAIN) { E(acc, cur, wr, wc, fr, fq); S.done(cur); }
        PG8_STAMP();
        if (!has_next) break;
#pragma unroll
        for (int a = 0; a < 2; ++a)
#pragma unroll
            for (int b = 0; b < 2; ++b)
#pragma unroll
                for (int m = 0; m < 4; ++m)
#pragma unroll
                    for (int n = 0; n < 2; ++n) acc[a][b][m][n] = (f32x4){0.f, 0.f, 0.f, 0.f};
        cur = nxt; cA = nA; cB = nB; ++ui;
    }
    PG8_WAIT_V(0);
    if (wr == 0) PG8_BAR;
    PG8_BAR;
    if constexpr (Epi::AFTER_DRAIN) { E.fused(acc, cur, wr, wc, fr, fq, lds, wid, lane); S.done(cur); }
    PG8_STAMP();
    if (STAMP && wid == 0) { stamps[lane] = lane < nts ? (((unsigned long long)(unsigned)ts_hi << 32) | (unsigned)ts_lo) : 0ull;
        if (lane == 62) stamps[62] = rt_entry; if (lane == 63) stamps[63] = (unsigned long long)wall_clock64(); }
#undef PG8_STAMP
#undef PG8_SA
#undef PG8_SB
#undef PG8_STAGE
#undef PG8_LDA
#undef PG8_LDB
#undef PG8_MMA
#undef PG8_WAIT_V
#undef PG8_WAIT_L
#undef PG8_BAR
#undef PG8_SCHED
}
}


namespace pg8 {
struct EpiProj {
    static constexpr bool PERM = true, AFTER_DRAIN = false;
    bf16_t* O; float* dtraw;
    __device__ __forceinline__ void operator()(const f32x4 (&acc)[2][2][4][2], const Unit& u, int wr, int wc, int fr, int fq) const {
        const int row0 = u.pm * BM + wr * 64 + fr;
        if (u.pn < 22) {
            const int col0 = u.pn * BM + wc * 32 + 8 * fq;
#pragma unroll
            for (int ai = 0; ai < 2; ++ai)
#pragma unroll
                for (int m = 0; m < 4; ++m) { bf16_t* rowp = O + (size_t)(row0 + ai * HALF + m * 16) * 5632 + col0;
#pragma unroll
                    for (int bj = 0; bj < 2; ++bj) { const f32x4 v0 = acc[ai][bj][m][0], v1 = acc[ai][bj][m][1];
                        u32x4 w; w.x = cvt_pk_bf16(v0[0], v0[1]); w.y = cvt_pk_bf16(v0[2], v0[3]); w.z = cvt_pk_bf16(v1[0], v1[1]); w.w = cvt_pk_bf16(v1[2], v1[3]);
                        *(u32x4*)(rowp + bj * HALF) = w; } }
        } else if (wc == 0) {
#pragma unroll
            for (int ai = 0; ai < 2; ++ai)
#pragma unroll
                for (int m = 0; m < 4; ++m) { float* rp = dtraw + (size_t)(row0 + ai * HALF + m * 16) * 32 + 8 * fq;
                    *(f32x4*)rp = acc[ai][0][m][0]; *(f32x4*)(rp + 4) = acc[ai][0][m][1]; }
        }
    }
};
}


namespace pg8 {
struct EpiBf16Plain {
    static constexpr bool PERM = true, AFTER_DRAIN = false;
    bf16_t* O; int ldc;
    __device__ __forceinline__ void operator()(const f32x4 (&acc)[2][2][4][2], const Unit& u, int wr, int wc, int fr, int fq) const {
        const int row0 = u.pm * BM + wr * 64 + fr, col0 = u.pn * BM + wc * 32 + 8 * fq;
#pragma unroll
        for (int ai = 0; ai < 2; ++ai)
#pragma unroll
            for (int m = 0; m < 4; ++m) { bf16_t* rowp = O + (size_t)(row0 + ai * HALF + m * 16) * ldc + col0;
#pragma unroll
                for (int bj = 0; bj < 2; ++bj) { const f32x4 v0 = acc[ai][bj][m][0], v1 = acc[ai][bj][m][1];
                    u32x4 w; w.x = cvt_pk_bf16(v0[0], v0[1]); w.y = cvt_pk_bf16(v0[2], v0[3]); w.z = cvt_pk_bf16(v1[0], v1[1]); w.w = cvt_pk_bf16(v1[2], v1[3]);
                    *(u32x4*)(rowp + bj * HALF) = w; } }
    }
};
}

#define NTHR 512
#define NWAVE 8

__device__ __forceinline__ void ph_gemm_f32(float* lds, const float* __restrict__ A, const float* __restrict__ B, float* __restrict__ C,
                                            int M, int N, int K, int lda, int ldb, int ldc) {
    const int tid = threadIdx.x & 255, half = threadIdx.x >> 8, tx = tid & 15, ty = tid >> 4;
    float (*As)[68] = (float (*)[68])(lds + half * 2 * 16 * 68);
    float (*Bs)[68] = (float (*)[68])(lds + half * 2 * 16 * 68 + 16 * 68);
    const int ntx = (N + 63) / 64, nty = M / 64, ntiles = ntx * nty;
    for (int it = blockIdx.x; 2 * it < ntiles; it += gridDim.x) {
        const int tile = 2 * it + half;
        const int m0 = (tile / ntx) * 64, n0 = (tile % ntx) * 64;
        float acc[4][4];
#pragma unroll
        for (int i = 0; i < 4; ++i)
#pragma unroll
            for (int j = 0; j < 4; ++j) acc[i][j] = 0.f;
        for (int k0 = 0; k0 < K; k0 += 16) {
#pragma unroll
            for (int i = 0; i < 4; ++i) {
                int idx = tid + i * 256;
                int r = idx >> 4, c = idx & 15;
                As[c][r] = (m0 + r < M) ? A[(size_t)(m0 + r) * lda + k0 + c] : 0.f;
                int rb = idx >> 6, cb = idx & 63;
                Bs[rb][cb] = (n0 + cb < N) ? B[(size_t)(k0 + rb) * ldb + n0 + cb] : 0.f;
            }
            __syncthreads();
#pragma unroll
            for (int k = 0; k < 16; ++k) {
                float a[4], b[4];
#pragma unroll
                for (int i = 0; i < 4; ++i) { a[i] = As[k][ty * 4 + i]; b[i] = Bs[k][tx * 4 + i]; }
#pragma unroll
                for (int i = 0; i < 4; ++i)
#pragma unroll
                    for (int j = 0; j < 4; ++j) acc[i][j] += a[i] * b[j];
            }
            __syncthreads();
        }
#pragma unroll
        for (int i = 0; i < 4; ++i)
#pragma unroll
            for (int j = 0; j < 4; ++j) {
                int r = m0 + ty * 4 + i, c = n0 + tx * 4 + j;
                if (r < M && c < N) C[(size_t)r * ldc + c] = acc[i][j];
            }
    }
}


template <int MODE>
__device__ __forceinline__ void transpose_item(const float* __restrict__ W, int K, int N, int Npad, bf16* __restrict__ WT, LAS float* scr, int item, int lane) {
    const int nblk = Npad / 32, kb = item / nblk, nb = item % nblk, k0 = 64 * kb, n0 = 32 * nb;
    const int n = n0 + (lane & 31);
    int sc = n;
    if (MODE == 1) sc = (n < 4096) ? n : (n < 5632 ? n + 24 : (n < 5656 ? n - 5632 + 4096 : -1));
    else sc = (n < N) ? n : -1;
#pragma unroll 8
    for (int i = 0; i < 32; ++i) { const int kk = 2 * i + (lane >> 5); scr[kk * 33 + (lane & 31)] = (sc >= 0) ? W[(size_t)(k0 + kk) * N + sc] : 0.f; }
    LDS_WAIT(); asm volatile("" ::: "memory");
    const int c = lane & 7;
#pragma unroll
    for (int j = 0; j < 4; ++j) { const int nn = (lane >> 3) + 8 * j; const LAS float* s = scr + (8 * c) * 33 + nn;
        v4u o; o.x = pk2(s[0 * 33], s[1 * 33]); o.y = pk2(s[2 * 33], s[3 * 33]); o.z = pk2(s[4 * 33], s[5 * 33]); o.w = pk2(s[6 * 33], s[7 * 33]);
        *(v4u*)(WT + (size_t)(n0 + nn) * K + k0 + 8 * c) = o; }
    LDS_WAIT(); asm volatile("" ::: "memory");
}
__device__ __forceinline__ void ph_prologue(LAS unsigned char* ldsb, const float* __restrict__ xp, const float* __restrict__ xs, bf16* __restrict__ A0,
                                            const float* __restrict__ w_in, bf16* __restrict__ wt_in, float* __restrict__ rope_tab) {
    const int lane = threadIdx.x & 63, wave = threadIdx.x >> 6;
    LAS float* scr = (LAS float*)(ldsb + wave * 16384);
    const int gw = blockIdx.x * NWAVE + wave, NGW = gridDim.x * NWAVE;
    constexpr int I_IN = (D_MODEL / 64) * (PROJ_LD / 32);
    for (int it = gw; it < I_IN; it += NGW) transpose_item<1>(w_in, D_MODEL, IN_WIDTH, PROJ_LD, wt_in, scr, it, lane);
    for (int idx = blockIdx.x * NTHR + threadIdx.x; idx < SEQ * 32; idx += gridDim.x * NTHR) {
        const int pos = idx >> 5, j = idx & 31;
        const double rev = (double)pos * ROPE_INV_REV[j];
        const float fr = (float)(rev - floor(rev));
        rope_tab[(size_t)pos * 64 + j] = __builtin_amdgcn_cosf(fr); rope_tab[(size_t)pos * 64 + 32 + j] = __builtin_amdgcn_sinf(fr);
    }
    const size_t n8 = (size_t)T_ALL * D_MODEL / 8, np8 = (size_t)T_PROMPT * D_MODEL / 8;
#pragma unroll 4
    for (size_t i = (size_t)blockIdx.x * NTHR + threadIdx.x; i < n8; i += (size_t)gridDim.x * NTHR) {
        const float4* s = (i < np8) ? (const float4*)xp + 2 * i : (const float4*)xs + 2 * (i - np8);
        float4 a = s[0], b = s[1];
        v4u o; o.x = pk2(a.x, a.y); o.y = pk2(a.z, a.w); o.z = pk2(b.x, b.y); o.w = pk2(b.z, b.w);
        ((v4u*)A0)[i] = o;
    }
}
__device__ __forceinline__ void ph_prologue2(LAS unsigned char* ldsb, const float* __restrict__ w_out, bf16* __restrict__ wt_out, const float* __restrict__ w_q, bf16* __restrict__ wt_q,
                                             int rank, int nranks) {
    const int lane = threadIdx.x & 63, wave = threadIdx.x >> 6;
    LAS float* scr = (LAS float*)(ldsb + wave * 16384);
    constexpr int I_OUT = (MIX_WIDTH / 64) * (D_MODEL / 32), I_Q = (D_MODEL / 64) * (2048 / 32);
    for (int it = rank * NWAVE + wave; it < I_OUT + I_Q; it += nranks * NWAVE) {
        if (it < I_OUT) transpose_item<0>(w_out, MIX_WIDTH, D_MODEL, D_MODEL, wt_out, scr, it, lane);
        else transpose_item<0>(w_q, D_MODEL, 2048, 2048, wt_q, scr, it - I_OUT, lane);
    }
}

__device__ __forceinline__ void ph_concat_x(const float* __restrict__ xp, const float* __restrict__ xs, float* __restrict__ xall) {
    const size_t n4 = (size_t)T_ALL * D_MODEL / 4, np4 = (size_t)T_PROMPT * D_MODEL / 4;
    for (size_t i = (size_t)blockIdx.x * NTHR + threadIdx.x; i < n4; i += (size_t)gridDim.x * NTHR) {
        float4 v = (i < np4) ? ((const float4*)xp)[i] : ((const float4*)xs)[i - np4];
        ((float4*)xall)[i] = v;
    }
}

typedef float f32x4n __attribute__((ext_vector_type(4)));
__device__ __forceinline__ void ph_cache_copy(const float* __restrict__ ck, const float* __restrict__ cv, float* __restrict__ out) {
    constexpr unsigned PER_B = (WBUF - DEC_SEQ) * ATT_WIDTH / 4;
    constexpr unsigned TOTAL = 2u * DEC_BATCH * PER_B;
    for (unsigned c = blockIdx.x; c < TOTAL / 4096u; c += gridDim.x) {
        f32x4n v[8]; size_t dsti[8]; bool isv[8];
#pragma unroll
        for (int j = 0; j < 8; ++j) {
            const unsigned idx = c * 4096u + j * 512u + threadIdx.x;
            const unsigned tb = idx / PER_B, r = idx - tb * PER_B, bb = tb & (DEC_BATCH - 1);
            isv[j] = tb >= DEC_BATCH;
            const size_t srci = (size_t)bb * (WBUF * ATT_WIDTH / 4) + (DEC_SEQ * ATT_WIDTH / 4) + r;
            dsti[j] = (size_t)bb * (WBUF * ATT_WIDTH / 4) + r;
            v[j] = __builtin_nontemporal_load((isv[j] ? (const f32x4n*)cv : (const f32x4n*)ck) + srci);
        }
#pragma unroll
        for (int j = 0; j < 8; ++j) __builtin_nontemporal_store(v[j], (f32x4n*)(out + (isv[j] ? OUT_SV : OUT_SK)) + dsti[j]);
    }
}

__device__ __forceinline__ void ph_post_proj(const float* __restrict__ proj, const float* __restrict__ state_conv,
                                             const float* __restrict__ conv_w, const float* __restrict__ conv_b, const float* __restrict__ dt_bias,
                                             float* __restrict__ xbc_act, float* __restrict__ dtv, float* __restrict__ qrot, float* __restrict__ krot,
                                             float* __restrict__ out) {
    const int tid = threadIdx.x & 255, half = threadIdx.x >> 8;
    for (int t = 2 * blockIdx.x + half; t < T_ALL; t += 2 * gridDim.x) {
        const bool is_p = t < T_PROMPT;
        int b, i, pos;
        if (is_p) { b = t / SEQ; i = t % SEQ; pos = i; } else { int ts = t - T_PROMPT; b = ts / DEC_SEQ; i = ts % DEC_SEQ; pos = PAST_LEN + i; }
        const float* row = proj + (size_t)t * PROJ_LD;
        for (int c = tid; c < CONV_DIM; c += 256) {
            float acc = conv_b[c];
#pragma unroll
            for (int tap = 0; tap < 4; ++tap) {
                int r = i - 3 + tap;
                float val;
                if (r >= 0) val = proj[(size_t)(t - i + r) * PROJ_LD + O_XBC + c];
                else val = is_p ? 0.f : state_conv[((size_t)b * 3 + (3 + r)) * CONV_DIM + c];
                acc += val * conv_w[tap * CONV_DIM + c];
            }
            xbc_act[(size_t)t * CONV_DIM + c] = silu_f(acc);
        }
        if (tid < SSD_HEADS) dtv[(size_t)t * SSD_HEADS + tid] = softplus_f(row[O_DT + tid] + dt_bias[tid]);
        for (int idx = tid; idx < 512; idx += 256) {
            int which = idx >> 8, h = (idx >> 5) & 7, j = idx & 31;
            double rev = (double)pos * ROPE_INV_REV[j];
            float fr = (float)(rev - floor(rev));
            float sn = __builtin_amdgcn_sinf(fr), cs = __builtin_amdgcn_cosf(fr);
            const float* src = row + (which ? O_K : O_Q) + h * 64;
            float t1 = src[j], t2 = src[j + 32];
            float o1 = t1 * cs - t2 * sn, o2 = t2 * cs + t1 * sn;
            float* dst = (which ? krot : qrot) + (size_t)t * ATT_WIDTH + h * 64;
            dst[j] = o1; dst[j + 32] = o2;
            if (which) {
                if (is_p) { if (i >= SEQ - WBUF) { float* o = out + OUT_PK + ((size_t)b * WBUF + (i - (SEQ - WBUF))) * ATT_WIDTH + h * 64; o[j] = o1; o[j + 32] = o2; } }
                else { float* o = out + OUT_SK + ((size_t)b * WBUF + (WBUF - DEC_SEQ + i)) * ATT_WIDTH + h * 64; o[j] = o1; o[j + 32] = o2; }
            }
        }
        for (int c = tid; c < ATT_WIDTH; c += 256) {
            float v = row[O_V + c];
            if (is_p) { if (i >= SEQ - WBUF) out[OUT_PV + ((size_t)b * WBUF + (i - (SEQ - WBUF))) * ATT_WIDTH + c] = v; }
            else out[OUT_SV + ((size_t)b * WBUF + (WBUF - DEC_SEQ + i)) * ATT_WIDTH + c] = v;
        }
        if (is_p) {
            if (i >= SEQ - 3) { int r = i - (SEQ - 3); for (int c = tid; c < CONV_DIM; c += 256) out[OUT_PC + ((size_t)b * 3 + r) * CONV_DIM + c] = row[O_XBC + c]; }
        } else {
            if (i >= 1) { int r = i - 1; for (int c = tid; c < CONV_DIM; c += 256) out[OUT_SC + ((size_t)b * 3 + r) * CONV_DIM + c] = row[O_XBC + c]; }
        }
    }
}


#define NB_LD 5632
#define NB_XBC 1536
#define NB_Q 4096
#define NB_K 4608
#define NB_V 5120
__device__ __forceinline__ void unpack8(const v4u w, float (&f)[8]) {
    f[0] = __builtin_bit_cast(float, w.x << 16); f[1] = __builtin_bit_cast(float, w.x & 0xffff0000u);
    f[2] = __builtin_bit_cast(float, w.y << 16); f[3] = __builtin_bit_cast(float, w.y & 0xffff0000u);
    f[4] = __builtin_bit_cast(float, w.z << 16); f[5] = __builtin_bit_cast(float, w.z & 0xffff0000u);
    f[6] = __builtin_bit_cast(float, w.w << 16); f[7] = __builtin_bit_cast(float, w.w & 0xffff0000u);
}
__device__ __forceinline__ void store8f(float* d, const float (&f)[8]) { *(float4*)d = make_float4(f[0], f[1], f[2], f[3]); *(float4*)(d + 4) = make_float4(f[4], f[5], f[6], f[7]); }
__device__ __forceinline__ void ph_post_proj2(const bf16* __restrict__ projb, const float* __restrict__ dtraw, const float* __restrict__ state_conv,
                                              const float* __restrict__ conv_w, const float* __restrict__ conv_b, const float* __restrict__ dt_bias,
                                              bf16* __restrict__ xbc_b, float* __restrict__ dtv, bf16* __restrict__ qrot_b, bf16* __restrict__ krot_b,
                                              float* __restrict__ out) {
    const int tid = threadIdx.x & 255, half = threadIdx.x >> 8;
    for (int t = T_PROMPT + 2 * blockIdx.x + half; t < T_ALL; t += 2 * gridDim.x) {
        const bool is_p = t < T_PROMPT;
        int b, i, pos;
        if (is_p) { b = t / SEQ; i = t % SEQ; pos = i; } else { int ts = t - T_PROMPT; b = ts / DEC_SEQ; i = ts % DEC_SEQ; pos = PAST_LEN + i; }
        const bf16* row = projb + (size_t)t * NB_LD;
        if (tid < 64) {
            float f[8]; unpack8(*(const v4u*)(row + NB_V + tid * 8), f);
            if (is_p) { if (i >= SEQ - WBUF) store8f(out + OUT_PV + ((size_t)b * WBUF + (i - (SEQ - WBUF))) * ATT_WIDTH + tid * 8, f); }
            else store8f(out + OUT_SV + ((size_t)b * WBUF + (WBUF - DEC_SEQ + i)) * ATT_WIDTH + tid * 8, f);
        }
        for (int c8 = tid; c8 < 320; c8 += 256) {
            const int c = c8 * 8;
            float acc[8], cur[8];
            { const float4 b0 = *(const float4*)(conv_b + c), b1 = *(const float4*)(conv_b + c + 4);
              acc[0] = b0.x; acc[1] = b0.y; acc[2] = b0.z; acc[3] = b0.w; acc[4] = b1.x; acc[5] = b1.y; acc[6] = b1.z; acc[7] = b1.w; }
#pragma unroll
            for (int tap = 0; tap < 4; ++tap) {
                const int r = i - 3 + tap;
                float val[8];
                if (r >= 0) unpack8(*(const v4u*)(projb + (size_t)(t - i + r) * NB_LD + NB_XBC + c), val);
                else if (!is_p) { const float* sp = state_conv + ((size_t)b * 3 + (3 + r)) * CONV_DIM + c; const float4 s0 = *(const float4*)sp, s1 = *(const float4*)(sp + 4);
                    val[0] = s0.x; val[1] = s0.y; val[2] = s0.z; val[3] = s0.w; val[4] = s1.x; val[5] = s1.y; val[6] = s1.z; val[7] = s1.w; }
                else {
#pragma unroll
                    for (int j = 0; j < 8; ++j) val[j] = 0.f; }
                const float4 w0 = *(const float4*)(conv_w + tap * CONV_DIM + c), w1 = *(const float4*)(conv_w + tap * CONV_DIM + c + 4);
                acc[0] += val[0] * w0.x; acc[1] += val[1] * w0.y; acc[2] += val[2] * w0.z; acc[3] += val[3] * w0.w;
                acc[4] += val[4] * w1.x; acc[5] += val[5] * w1.y; acc[6] += val[6] * w1.z; acc[7] += val[7] * w1.w;
                if (tap == 3) {
#pragma unroll
                    for (int j = 0; j < 8; ++j) cur[j] = val[j]; }
            }
#pragma unroll
            for (int j = 0; j < 8; ++j) acc[j] = silu_f(acc[j]);
            v4u o; o.x = pk2(acc[0], acc[1]); o.y = pk2(acc[2], acc[3]); o.z = pk2(acc[4], acc[5]); o.w = pk2(acc[6], acc[7]);
            *(v4u*)(xbc_b + (size_t)t * CONV_DIM + c) = o;
            if (is_p) { if (i >= SEQ - 3) store8f(out + OUT_PC + ((size_t)b * 3 + (i - (SEQ - 3))) * CONV_DIM + c, cur); }
            else { if (i >= 1) store8f(out + OUT_SC + ((size_t)b * 3 + (i - 1)) * CONV_DIM + c, cur); }
        }
        if (tid < SSD_HEADS) dtv[(size_t)t * SSD_HEADS + tid] = softplus_f(dtraw[(size_t)t * 32 + tid] + dt_bias[tid]);
        if (tid < 128) {
            const int which = tid >> 6, h = (tid >> 3) & 7, jc = tid & 7;
            const bf16* src = row + (which ? NB_K : NB_Q) + h * 64 + jc * 4;
            const uint2 lo = *(const uint2*)src, hi = *(const uint2*)(src + 32);
            float t1[4], t2[4], o1[4], o2[4];
            t1[0] = __builtin_bit_cast(float, lo.x << 16); t1[1] = __builtin_bit_cast(float, lo.x & 0xffff0000u); t1[2] = __builtin_bit_cast(float, lo.y << 16); t1[3] = __builtin_bit_cast(float, lo.y & 0xffff0000u);
            t2[0] = __builtin_bit_cast(float, hi.x << 16); t2[1] = __builtin_bit_cast(float, hi.x & 0xffff0000u); t2[2] = __builtin_bit_cast(float, hi.y << 16); t2[3] = __builtin_bit_cast(float, hi.y & 0xffff0000u);
#pragma unroll
            for (int e = 0; e < 4; ++e) {
                const double rev = (double)pos * ROPE_INV_REV[jc * 4 + e];
                const float fr = (float)(rev - floor(rev));
                const float sn = __builtin_amdgcn_sinf(fr), cs = __builtin_amdgcn_cosf(fr);
                o1[e] = t1[e] * cs - t2[e] * sn; o2[e] = t2[e] * cs + t1[e] * sn;
            }
            const size_t doff = (size_t)t * ATT_WIDTH + h * 64 + jc * 4;
            bf16* db = which ? krot_b : qrot_b;
            *(uint2*)(db + doff) = make_uint2(pk2(o1[0], o1[1]), pk2(o1[2], o1[3])); *(uint2*)(db + doff + 32) = make_uint2(pk2(o2[0], o2[1]), pk2(o2[2], o2[3]));
            if (which) {
                float* o = nullptr;
                if (is_p) { if (i >= SEQ - WBUF) o = out + OUT_PK + ((size_t)b * WBUF + (i - (SEQ - WBUF))) * ATT_WIDTH + h * 64 + jc * 4; }
                else o = out + OUT_SK + ((size_t)b * WBUF + (WBUF - DEC_SEQ + i)) * ATT_WIDTH + h * 64 + jc * 4;
                if (o) { *(float4*)o = make_float4(o1[0], o1[1], o1[2], o1[3]); *(float4*)(o + 32) = make_float4(o2[0], o2[1], o2[2], o2[3]); }
            }
        }
    }
}


__device__ __forceinline__ void ph_post_proj_prompt(const bf16* __restrict__ projb, const float* __restrict__ dtraw, const float* __restrict__ conv_w, const float* __restrict__ conv_b,
                                                    const float* __restrict__ dt_bias, const float* __restrict__ rope_tab, bf16* __restrict__ xbc_b, float* __restrict__ dtv,
                                                    bf16* __restrict__ qrot_b, bf16* __restrict__ krot_b, float* __restrict__ out) {
    const int gtid = blockIdx.x * NTHR + threadIdx.x, gsz = gridDim.x * NTHR;
    for (int item = gtid; item < (T_PROMPT / 16) * 320; item += gsz) {
        const int run = item / 320, c = (item - run * 320) * 8, t0 = run * 16, i0 = t0 & (SEQ - 1), b = t0 >> 13;
        float w[4][8], bias[8];
#pragma unroll
        for (int tap = 0; tap < 4; ++tap) { const float4 w0 = *(const float4*)(conv_w + tap * CONV_DIM + c), w1 = *(const float4*)(conv_w + tap * CONV_DIM + c + 4);
            w[tap][0] = w0.x; w[tap][1] = w0.y; w[tap][2] = w0.z; w[tap][3] = w0.w; w[tap][4] = w1.x; w[tap][5] = w1.y; w[tap][6] = w1.z; w[tap][7] = w1.w; }
        { const float4 b0 = *(const float4*)(conv_b + c), b1 = *(const float4*)(conv_b + c + 4);
          bias[0] = b0.x; bias[1] = b0.y; bias[2] = b0.z; bias[3] = b0.w; bias[4] = b1.x; bias[5] = b1.y; bias[6] = b1.z; bias[7] = b1.w; }
        const bf16* src = projb + (size_t)t0 * NB_LD + NB_XBC + c;
        v4u raw[19];
#pragma unroll
        for (int s = 0; s < 19; ++s) { v4u z; z.x = 0u; z.y = 0u; z.z = 0u; z.w = 0u; raw[s] = (s >= 3 || i0 != 0) ? *(const v4u*)(src + (ptrdiff_t)(s - 3) * NB_LD) : z; }
        float p0[8], p1[8], p2[8];
        unpack8(raw[0], p0); unpack8(raw[1], p1); unpack8(raw[2], p2);
#pragma unroll
        for (int s = 0; s < 16; ++s) {
            float cur[8], acc[8]; unpack8(raw[s + 3], cur);
#pragma unroll
            for (int j = 0; j < 8; ++j) acc[j] = silu_f(bias[j] + p0[j] * w[0][j] + p1[j] * w[1][j] + p2[j] * w[2][j] + cur[j] * w[3][j]);
            v4u o; o.x = pk2(acc[0], acc[1]); o.y = pk2(acc[2], acc[3]); o.z = pk2(acc[4], acc[5]); o.w = pk2(acc[6], acc[7]);
            *(v4u*)(xbc_b + (size_t)(t0 + s) * CONV_DIM + c) = o;
            if (i0 + s >= SEQ - 3) store8f(out + OUT_PC + ((size_t)b * 3 + (i0 + s - (SEQ - 3))) * CONV_DIM + c, cur);
#pragma unroll
            for (int j = 0; j < 8; ++j) { p0[j] = p1[j]; p1[j] = p2[j]; p2[j] = cur[j]; }
        }
    }
#pragma unroll 4
    for (int item = gtid; item < T_PROMPT * 128; item += gsz) {
        const int t = item >> 7, sub = item & 127, which = sub >> 6, h = (sub >> 3) & 7, jc = sub & 7, i = t & (SEQ - 1), b = t >> 13;
        const bf16* src = projb + (size_t)t * NB_LD + (which ? NB_K : NB_Q) + h * 64 + jc * 4;
        const uint2 lo = *(const uint2*)src, hi = *(const uint2*)(src + 32);
        const float4 cs = *(const float4*)(rope_tab + (size_t)i * 64 + jc * 4), sn = *(const float4*)(rope_tab + (size_t)i * 64 + 32 + jc * 4);
        float t1[4], t2[4], o1[4], o2[4];
        t1[0] = __builtin_bit_cast(float, lo.x << 16); t1[1] = __builtin_bit_cast(float, lo.x & 0xffff0000u); t1[2] = __builtin_bit_cast(float, lo.y << 16); t1[3] = __builtin_bit_cast(float, lo.y & 0xffff0000u);
        t2[0] = __builtin_bit_cast(float, hi.x << 16); t2[1] = __builtin_bit_cast(float, hi.x & 0xffff0000u); t2[2] = __builtin_bit_cast(float, hi.y << 16); t2[3] = __builtin_bit_cast(float, hi.y & 0xffff0000u);
        const float cv[4] = {cs.x, cs.y, cs.z, cs.w}, sv[4] = {sn.x, sn.y, sn.z, sn.w};
#pragma unroll
        for (int e = 0; e < 4; ++e) { o1[e] = t1[e] * cv[e] - t2[e] * sv[e]; o2[e] = t2[e] * cv[e] + t1[e] * sv[e]; }
        const size_t doff = (size_t)t * ATT_WIDTH + h * 64 + jc * 4;
        bf16* db = which ? krot_b : qrot_b;
        *(uint2*)(db + doff) = make_uint2(pk2(o1[0], o1[1]), pk2(o1[2], o1[3])); *(uint2*)(db + doff + 32) = make_uint2(pk2(o2[0], o2[1]), pk2(o2[2], o2[3]));
        if (which && i >= SEQ - WBUF) {
            float* o = out + OUT_PK + ((size_t)b * WBUF + (i - (SEQ - WBUF))) * ATT_WIDTH + h * 64 + jc * 4;
            *(float4*)o = make_float4(o1[0], o1[1], o1[2], o1[3]); *(float4*)(o + 32) = make_float4(o2[0], o2[1], o2[2], o2[3]);
        }
    }
#pragma unroll 4
    for (int item = gtid; item < T_PROMPT * SSD_HEADS; item += gsz) { const int t = item / SSD_HEADS, hd = item - t * SSD_HEADS; dtv[item] = softplus_f(dtraw[(size_t)t * 32 + hd] + dt_bias[hd]); }
#pragma unroll 2
    for (int item = gtid; item < BATCH * WBUF * 64; item += gsz) {
        const int ch = item & 63, j = (item >> 6) & (WBUF - 1), b = item >> 17;
        float f[8]; unpack8(*(const v4u*)(projb + (size_t)(b * SEQ + (SEQ - WBUF) + j) * NB_LD + NB_V + ch * 8), f);
        store8f(out + OUT_PV + ((size_t)b * WBUF + j) * ATT_WIDTH + ch * 8, f);
    }
}

#define SSD_CH 32
__device__ __forceinline__ void ph_ssd_naive(float* lds, const bf16* __restrict__ xbc_act, const float* __restrict__ dtv, const float* __restrict__ a_log,
                                             const float* __restrict__ d_skip, const float* __restrict__ state_ssm, float* __restrict__ ybuf, float* __restrict__ out) {
    float (*sx)[64] = (float (*)[64])lds;
    float (*sB)[128] = (float (*)[128])(lds + SSD_CH * 64);
    float (*sC)[128] = (float (*)[128])(lds + SSD_CH * 64 + SSD_CH * 128);
    float* sdt = lds + SSD_CH * 64 + 2 * SSD_CH * 128;
    const int tid = threadIdx.x, p = tid >> 3, ng = tid & 7;
    for (int vb = BATCH * SSD_HEADS + blockIdx.x; vb < (BATCH + DEC_BATCH) * SSD_HEADS; vb += gridDim.x) {
        const int seq = vb / SSD_HEADS, h = vb % SSD_HEADS, g = h / 6;
        const bool is_p = seq < BATCH;
        const int L = is_p ? SEQ : DEC_SEQ;
        const int t0 = is_p ? seq * SEQ : T_PROMPT + (seq - BATCH) * DEC_SEQ;
        const float A = -__expf(a_log[h]);
        const float D = d_skip[h];
        float hs[16];
        if (is_p) {
#pragma unroll
            for (int j = 0; j < 16; ++j) hs[j] = 0.f;
        } else {
            const float* s0 = state_ssm + (((size_t)(seq - BATCH) * SSD_HEADS + h) * 64 + p) * 128 + ng * 16;
#pragma unroll
            for (int j = 0; j < 16; ++j) hs[j] = s0[j];
        }
        for (int c0 = 0; c0 < L; c0 += SSD_CH) {
            const int nst = (L - c0) < SSD_CH ? (L - c0) : SSD_CH;
            __syncthreads();
            for (int idx = tid; idx < nst * 64; idx += NTHR) { int s = idx >> 6, c = idx & 63; sx[s][c] = bf2f(xbc_act[(size_t)(t0 + c0 + s) * CONV_DIM + h * 64 + c]); }
            for (int idx = tid; idx < nst * 128; idx += NTHR) { int s = idx >> 7, c = idx & 127;
                sB[s][c] = bf2f(xbc_act[(size_t)(t0 + c0 + s) * CONV_DIM + 1536 + g * 128 + c]);
                sC[s][c] = bf2f(xbc_act[(size_t)(t0 + c0 + s) * CONV_DIM + 2048 + g * 128 + c]); }
            if (tid < nst) sdt[tid] = dtv[(size_t)(t0 + c0 + tid) * SSD_HEADS + h];
            __syncthreads();
            for (int s = 0; s < nst; ++s) {
                const float dt = sdt[s], x = sx[s][p];
                const float a = __expf(dt * A), xdt = x * dt;
                float y = 0.f;
#pragma unroll
                for (int j = 0; j < 16; ++j) { hs[j] = a * hs[j] + xdt * sB[s][ng * 16 + j]; y += sC[s][ng * 16 + j] * hs[j]; }
                y += __shfl_xor(y, 1); y += __shfl_xor(y, 2); y += __shfl_xor(y, 4);
                if (ng == 0) ybuf[(size_t)(t0 + c0 + s) * MIX_WIDTH + h * 64 + p] = y + D * x;
            }
        }
        float* so = is_p ? out + OUT_PS + (((size_t)seq * SSD_HEADS + h) * 64 + p) * 128 + ng * 16
                         : out + OUT_SS + (((size_t)(seq - BATCH) * SSD_HEADS + h) * 64 + p) * 128 + ng * 16;
#pragma unroll
        for (int j = 0; j < 16; ++j) so[j] = hs[j];
    }
}

__device__ __forceinline__ void ph_gate_norm(const bf16* __restrict__ projb, const float* __restrict__ norm_g, const float* __restrict__ ybuf, bf16* __restrict__ A1) {
    const int w = threadIdx.x >> 6, lane = threadIdx.x & 63, g = w & 3;
    for (int t = T_PROMPT + 2 * blockIdx.x + (w >> 2); t < T_ALL; t += 2 * gridDim.x) {
        float v[6]; float ss = 0.f;
#pragma unroll
        for (int j = 0; j < 6; ++j) {
            int c = g * 384 + j * 64 + lane;
            float y = ybuf[(size_t)t * MIX_WIDTH + c], z = bf2f(projb[(size_t)t * NB_LD + c]);
            v[j] = y * silu_f(z); ss += v[j] * v[j];
        }
        ss = wave_sum(ss);
        const float r = rsqrtf(ss * (1.0f / 384.0f) + LN_EPS);
#pragma unroll
        for (int j = 0; j < 6; ++j) { int c = g * 384 + j * 64 + lane; A1[(size_t)t * MIX_WIDTH + c] = (bf16)f2bf(v[j] * r * norm_g[c]); }
    }
}

__device__ __forceinline__ void ph_attn_naive(float* lds, const float* __restrict__ proj, const float* __restrict__ qrot, const float* __restrict__ krot,
                                              const float* __restrict__ ck, const float* __restrict__ cv, float* __restrict__ ybuf) {
    float (*sq)[64] = (float (*)[64])lds;
    const int w = threadIdx.x >> 6, lane = threadIdx.x & 63;
    for (int vb = blockIdx.x; vb < T_SAMPLE * 8 / NWAVE; vb += gridDim.x) {
        const int item = T_PROMPT * 8 + vb * NWAVE + w;
        const int t = item >> 3, h = item & 7;
        const bool is_p = t < T_PROMPT;
        int b, i;
        if (is_p) { b = t / SEQ; i = t % SEQ; } else { int ts = t - T_PROMPT; b = ts / DEC_SEQ; i = ts % DEC_SEQ; }
        __syncthreads();
        sq[w][lane] = qrot[(size_t)t * ATT_WIDTH + h * 64 + lane];
        __syncthreads();
        const int qi = is_p ? i : WBUF + i;
        float sc[3][3];
        float mx = -INFINITY;
#pragma unroll
        for (int pt = 0; pt < 3; ++pt) {
            const int d = pt == 0 ? 1 : (pt == 1 ? 4 : 16);
#pragma unroll
            for (int sl = 0; sl < 3; ++sl) {
                const int m = lane + sl * 64;
                float s = -INFINITY;
                const int kj = qi - d * m;
                if (m <= 128 && kj >= 0) {
                    const float* kr;
                    if (is_p) kr = krot + (size_t)(b * SEQ + kj) * ATT_WIDTH + h * 64;
                    else kr = (kj >= WBUF) ? krot + (size_t)(T_PROMPT + b * DEC_SEQ + (kj - WBUF)) * ATT_WIDTH + h * 64
                                           : ck + ((size_t)b * WBUF + kj) * ATT_WIDTH + h * 64;
                    float a = 0.f;
#pragma unroll
                    for (int c = 0; c < 64; c += 4) { float4 kv = *(const float4*)(kr + c); a += kv.x * sq[w][c] + kv.y * sq[w][c + 1] + kv.z * sq[w][c + 2] + kv.w * sq[w][c + 3]; }
                    s = a * 0.125f;
                }
                sc[pt][sl] = s; mx = fmaxf(mx, s);
            }
        }
        mx = wave_max(mx);
        float lsum = 0.f;
#pragma unroll
        for (int pt = 0; pt < 3; ++pt)
#pragma unroll
            for (int sl = 0; sl < 3; ++sl) { float pv = (sc[pt][sl] == -INFINITY) ? 0.f : __expf(sc[pt][sl] - mx); sc[pt][sl] = pv; lsum += pv; }
        lsum = wave_sum(lsum);
        float o = 0.f;
#pragma unroll
        for (int pt = 0; pt < 3; ++pt) {
            const int d = pt == 0 ? 1 : (pt == 1 ? 4 : 16);
#pragma unroll
            for (int sl = 0; sl < 3; ++sl) {
                const int mend = sl < 2 ? 64 : 1;
                for (int ml = 0; ml < mend; ++ml) {
                    const int m = ml + sl * 64;
                    const int kj = qi - d * m;
                    const float pv = __shfl(sc[pt][sl], ml);
                    if (kj < 0) continue;
                    const float* vr;
                    if (is_p) vr = proj + (size_t)(b * SEQ + kj) * PROJ_LD + O_V + h * 64;
                    else vr = (kj >= WBUF) ? proj + (size_t)(T_PROMPT + b * DEC_SEQ + (kj - WBUF)) * PROJ_LD + O_V + h * 64
                                           : cv + ((size_t)b * WBUF + kj) * ATT_WIDTH + h * 64;
                    o += pv * vr[lane];
                }
            }
        }
        ybuf[(size_t)t * MIX_WIDTH + SSD_WIDTH + h * 64 + lane] = o / lsum;
    }
}

__device__ __forceinline__ int token_of_iter(int k) {
    const int w = __builtin_amdgcn_readfirstlane(threadIdx.x >> 6), wgl = blockIdx.x * NWAVE + w;
    if (gridDim.x != 256) { const int t = wgl + k * (int)(gridDim.x * NWAVE); return t < T_ALL ? t : -1; }
    if (k < 8) return k * 2048 + wgl;
    if (k == 8 && w < 2) return 16384 + w * 256 + (int)blockIdx.x;
    return -1;
}
__device__ __forceinline__ void ph_ln_res(const float* __restrict__ xp, const float* __restrict__ xs, const bf16* __restrict__ add, const float* __restrict__ gam,
                                          const float* __restrict__ bet, bf16* __restrict__ dstb) {
    const int lane = threadIdx.x & 63;
#pragma unroll 2
    for (int k = 0;; ++k) {
        const int t = token_of_iter(k);
        if (t < 0) break;
        const float* res = (t < T_PROMPT) ? xp + (size_t)t * D_MODEL : xs + (size_t)(t - T_PROMPT) * D_MODEL;
        float v[16]; float s = 0.f;
#pragma unroll
        for (int j = 0; j < 2; ++j) { const int c = j * 512 + lane * 8; const float4 r0 = *(const float4*)(res + c), r1 = *(const float4*)(res + c + 4);
            float a8[8]; unpack8(*(const v4u*)(add + (size_t)t * D_MODEL + c), a8);
            v[8 * j] = ALPHA_F * r0.x + a8[0]; v[8 * j + 1] = ALPHA_F * r0.y + a8[1]; v[8 * j + 2] = ALPHA_F * r0.z + a8[2]; v[8 * j + 3] = ALPHA_F * r0.w + a8[3];
            v[8 * j + 4] = ALPHA_F * r1.x + a8[4]; v[8 * j + 5] = ALPHA_F * r1.y + a8[5]; v[8 * j + 6] = ALPHA_F * r1.z + a8[6]; v[8 * j + 7] = ALPHA_F * r1.w + a8[7]; }
#pragma unroll
        for (int j = 0; j < 16; ++j) s += v[j];
        s = wave_sum(s);
        const float mu = s * (1.0f / 1024.0f);
        float q = 0.f;
#pragma unroll
        for (int j = 0; j < 16; ++j) { v[j] -= mu; q += v[j] * v[j]; }
        q = wave_sum(q);
        const float r = rsqrtf(q * (1.0f / 1024.0f) + LN_EPS);
#pragma unroll
        for (int j = 0; j < 2; ++j) { const int c = j * 512 + lane * 8; const float4 g0 = *(const float4*)(gam + c), g1 = *(const float4*)(gam + c + 4), b0 = *(const float4*)(bet + c), b1 = *(const float4*)(bet + c + 4);
            v4u o; o.x = pk2(v[8 * j] * r * g0.x + b0.x, v[8 * j + 1] * r * g0.y + b0.y); o.y = pk2(v[8 * j + 2] * r * g0.z + b0.z, v[8 * j + 3] * r * g0.w + b0.w);
            o.z = pk2(v[8 * j + 4] * r * g1.x + b1.x, v[8 * j + 5] * r * g1.y + b1.y); o.w = pk2(v[8 * j + 6] * r * g1.z + b1.z, v[8 * j + 7] * r * g1.w + b1.w);
            *(v4u*)(dstb + (size_t)t * D_MODEL + c) = o; }
    }
}

__device__ __forceinline__ void ph_peer_route(float* lds, const float* __restrict__ qh, const float* __restrict__ keys1, const float* __restrict__ keys2,
                                              int* __restrict__ eidx, float* __restrict__ gate) {
    float (*sq)[256] = (float (*)[256])lds;
    float (*sv)[2][16] = (float (*)[2][16])(lds + NWAVE * 256);
    int (*si)[2][16] = (int (*)[2][16])(lds + NWAVE * 256 + NWAVE * 32);
    const int w = threadIdx.x >> 6, lane = threadIdx.x & 63;
    for (int vb = blockIdx.x; vb < T_ALL * 8 / NWAVE; vb += gridDim.x) {
        const int item = vb * NWAVE + w;
        const int t = item >> 3, h = item & 7;
        __syncthreads();
        for (int c = lane; c < 256; c += 64) sq[w][c] = qh[(size_t)t * 2048 + h * 256 + c];
        __syncthreads();
#pragma unroll
        for (int half = 0; half < 2; ++half) {
            const float* keys = half ? keys2 : keys1;
            float s[2];
#pragma unroll
            for (int sl = 0; sl < 2; ++sl) {
                const float* kr = keys + (size_t)(lane + sl * 64) * 128;
                float a = 0.f;
#pragma unroll 8
                for (int c = 0; c < 128; c += 4) { float4 kv = *(const float4*)(kr + c); const float* qq = &sq[w][half * 128 + c]; a += kv.x * qq[0] + kv.y * qq[1] + kv.z * qq[2] + kv.w * qq[3]; }
                s[sl] = a;
            }
            for (int r = 0; r < 16; ++r) {
                float bv; int bi;
                if (s[0] >= s[1]) { bv = s[0]; bi = lane; } else { bv = s[1]; bi = lane + 64; }
#pragma unroll
                for (int o = 32; o > 0; o >>= 1) {
                    float ov = __shfl_xor(bv, o); int oi = __shfl_xor(bi, o);
                    if (ov > bv || (ov == bv && oi < bi)) { bv = ov; bi = oi; }
                }
                if (lane == 0) { sv[w][half][r] = bv; si[w][half][r] = bi; }
                if (bi == lane) s[0] = -INFINITY;
                if (bi == lane + 64) s[1] = -INFINITY;
            }
        }
        __syncthreads();
        float c[4];
#pragma unroll
        for (int j = 0; j < 4; ++j) { int ci = lane * 4 + j; c[j] = sv[w][0][ci >> 4] + sv[w][1][ci & 15]; }
        float myv = 0.f; int myc = 0;
        for (int r = 0; r < 16; ++r) {
            float bv = c[0]; int bi = lane * 4;
#pragma unroll
            for (int j = 1; j < 4; ++j) if (c[j] > bv) { bv = c[j]; bi = lane * 4 + j; }
#pragma unroll
            for (int o = 32; o > 0; o >>= 1) {
                float ov = __shfl_xor(bv, o); int oi = __shfl_xor(bi, o);
                if (ov > bv || (ov == bv && oi < bi)) { bv = ov; bi = oi; }
            }
            if (lane == r) { myv = bv; myc = bi; }
#pragma unroll
            for (int j = 0; j < 4; ++j) if (bi == lane * 4 + j) c[j] = -INFINITY;
        }
        float v = lane < 16 ? myv : -INFINITY;
        float mx = wave_max(v);
        float e = lane < 16 ? __expf(v - mx) : 0.f;
        float sum = wave_sum(e);
        if (lane < 16) {
            int ex = si[w][0][myc >> 4] * PEER_NKEYS + si[w][1][myc & 15];
            eidx[(size_t)t * 128 + h * 16 + lane] = ex;
            gate[(size_t)t * 128 + h * 16 + lane] = e / sum;
        }
    }
}

__device__ __forceinline__ void ph_peer_ffn(const float* __restrict__ hbuf, const int* __restrict__ eidx, const float* __restrict__ gate,
                                            const bf16* __restrict__ ub, const bf16* __restrict__ vb, const float* __restrict__ gam,
                                            const float* __restrict__ bet, float* __restrict__ out) {
    const int lane = threadIdx.x & 63;
    for (int t = blockIdx.x * NWAVE + (threadIdx.x >> 6); t < T_ALL; t += gridDim.x * NWAVE) {
        float x[16], acc[16];
        { const float* xr = hbuf + (size_t)t * D_MODEL + lane * 8;
          const float4 a = *(const float4*)xr, b = *(const float4*)(xr + 4), c = *(const float4*)(xr + 512), d = *(const float4*)(xr + 516);
          x[0] = a.x; x[1] = a.y; x[2] = a.z; x[3] = a.w; x[4] = b.x; x[5] = b.y; x[6] = b.z; x[7] = b.w;
          x[8] = c.x; x[9] = c.y; x[10] = c.z; x[11] = c.w; x[12] = d.x; x[13] = d.y; x[14] = d.z; x[15] = d.w; }
#pragma unroll
        for (int j = 0; j < 16; ++j) acc[j] = 0.f;
        for (int k = 0; k < 128; ++k) {
            const int e = eidx[(size_t)t * 128 + k];
            const float g = gate[(size_t)t * 128 + k];
            const bf16* ur = ub + (size_t)e * D_MODEL + lane * 8;
            float u0[8], u1[8];
            unpack8(*(const v4u*)ur, u0); unpack8(*(const v4u*)(ur + 512), u1);
            float d = 0.f;
#pragma unroll
            for (int j = 0; j < 8; ++j) d += u0[j] * x[j] + u1[j] * x[8 + j];
            d = wave_sum(d);
            const float wgt = g * gelu_f(d);
            const bf16* vr = vb + (size_t)e * D_MODEL + lane * 8;
            unpack8(*(const v4u*)vr, u0); unpack8(*(const v4u*)(vr + 512), u1);
#pragma unroll
            for (int j = 0; j < 8; ++j) { acc[j] += wgt * u0[j]; acc[8 + j] += wgt * u1[j]; }
        }
        float s = 0.f;
#pragma unroll
        for (int j = 0; j < 16; ++j) { acc[j] += ALPHA_F * x[j]; s += acc[j]; }
        s = wave_sum(s);
        const float mu = s * (1.0f / 1024.0f);
        float q = 0.f;
#pragma unroll
        for (int j = 0; j < 16; ++j) { acc[j] -= mu; q += acc[j] * acc[j]; }
        q = wave_sum(q);
        const float r = rsqrtf(q * (1.0f / 1024.0f) + LN_EPS);
        float* dst = ((t < T_PROMPT) ? out + OUT_YP + (size_t)t * D_MODEL : out + OUT_YS + (size_t)(t - T_PROMPT) * D_MODEL) + lane * 8;
#pragma unroll
        for (int q4 = 0; q4 < 4; ++q4) {
            const int eo = (q4 >> 1) * 512 + (q4 & 1) * 4;
            const float4 g4 = *(const float4*)(gam + lane * 8 + eo), b4 = *(const float4*)(bet + lane * 8 + eo);
            float4 o; o.x = acc[q4 * 4 + 0] * r * g4.x + b4.x; o.y = acc[q4 * 4 + 1] * r * g4.y + b4.y; o.z = acc[q4 * 4 + 2] * r * g4.z + b4.z; o.w = acc[q4 * 4 + 3] * r * g4.w + b4.w;
            *(float4*)(dst + eo) = o;
        }
    }
}

__device__ __forceinline__ float peer_dot16(const v4u a, const v4u b, const float (&x)[16]) {
    float u0[8], u1[8]; unpack8(a, u0); unpack8(b, u1);
    float d = 0.f;
#pragma unroll
    for (int j = 0; j < 8; ++j) d += u0[j] * x[j] + u1[j] * x[8 + j];
    return d;
}
#define PEER_TR_STEP(N, M) _Pragma("unroll") for (int i = 0; i < N; ++i) { const bool up = (lane & M) != 0; const float keep = up ? part[i + N] : part[i]; const float send = up ? part[i] : part[i + N]; part[i] = keep + __shfl_xor(send, M); }
__device__ __forceinline__ void ph_peer_ffn2(const float* __restrict__ hbuf, const int* __restrict__ eidx, const float* __restrict__ gate,
                                             const bf16* __restrict__ ub, const bf16* __restrict__ vb, const float* __restrict__ gam,
                                             const float* __restrict__ bet, float* __restrict__ out) {
    const int lane0 = threadIdx.x & 63;
    for (int t = blockIdx.x * NWAVE + (threadIdx.x >> 6); t < T_ALL; t += gridDim.x * NWAVE) {
        int lane = lane0; asm volatile("" : "+v"(lane));
        float x[16];
        { const float* xr = hbuf + (size_t)t * D_MODEL + lane * 8;
          const float4 a = *(const float4*)xr, b = *(const float4*)(xr + 4), c = *(const float4*)(xr + 512), d = *(const float4*)(xr + 516);
          x[0] = a.x; x[1] = a.y; x[2] = a.z; x[3] = a.w; x[4] = b.x; x[5] = b.y; x[6] = b.z; x[7] = b.w;
          x[8] = c.x; x[9] = c.y; x[10] = c.z; x[11] = c.w; x[12] = d.x; x[13] = d.y; x[14] = d.z; x[15] = d.w; }
        int ev[2]; float wv[4];
        ev[0] = eidx[(size_t)t * 128 + lane]; ev[1] = eidx[(size_t)t * 128 + 64 + lane];
#pragma unroll
        for (int rd = 0; rd < 4; ++rd) wv[rd] = gate[(size_t)t * 128 + rd * 32 + (lane >> 1)];
#pragma unroll
        for (int rd = 0; rd < 4; ++rd) {
            float part[32];
#pragma unroll
            for (int kb = 0; kb < 8; ++kb) {
                v4u ra[4], rb[4];
#pragma unroll
                for (int k8 = 0; k8 < 4; ++k8) {
                    const int e = __builtin_amdgcn_readlane(ev[rd >> 1], (rd & 1) * 32 + kb * 4 + k8);
                    const bf16* ur = ub + (size_t)e * D_MODEL + lane * 8;
                    ra[k8] = *(const v4u*)ur; rb[k8] = *(const v4u*)(ur + 512);
                }
#pragma unroll
                for (int k8 = 0; k8 < 4; ++k8) part[kb * 4 + k8] = peer_dot16(ra[k8], rb[k8], x);
            }
            PEER_TR_STEP(16, 32) PEER_TR_STEP(8, 16) PEER_TR_STEP(4, 8) PEER_TR_STEP(2, 4) PEER_TR_STEP(1, 2)
            const float hid = part[0] + __shfl_xor(part[0], 1);
            wv[rd] *= gelu_f(hid);
        }
        float acc[16];
#pragma unroll
        for (int j = 0; j < 16; ++j) acc[j] = 0.f;
#pragma unroll
        for (int rd = 0; rd < 4; ++rd) {
#pragma unroll
            for (int kb = 0; kb < 4; ++kb) {
                v4u ra[8], rb[8];
#pragma unroll
                for (int k8 = 0; k8 < 8; ++k8) {
                    const int e = __builtin_amdgcn_readlane(ev[rd >> 1], (rd & 1) * 32 + kb * 8 + k8);
                    const bf16* vr = vb + (size_t)e * D_MODEL + lane * 8;
                    ra[k8] = *(const v4u*)vr; rb[k8] = *(const v4u*)(vr + 512);
                }
#pragma unroll
                for (int k8 = 0; k8 < 8; ++k8) {
                    const float wk = __builtin_bit_cast(float, __builtin_amdgcn_readlane(__builtin_bit_cast(int, wv[rd]), 2 * (kb * 8 + k8)));
                    float u0[8], u1[8]; unpack8(ra[k8], u0); unpack8(rb[k8], u1);
#pragma unroll
                    for (int j = 0; j < 8; ++j) { acc[j] += wk * u0[j]; acc[8 + j] += wk * u1[j]; }
                }
            }
        }
        float s = 0.f;
#pragma unroll
        for (int j = 0; j < 16; ++j) { acc[j] += ALPHA_F * x[j]; s += acc[j]; }
        s = wave_sum(s);
        const float mu = s * (1.0f / 1024.0f);
        float q = 0.f;
#pragma unroll
        for (int j = 0; j < 16; ++j) { acc[j] -= mu; q += acc[j] * acc[j]; }
        q = wave_sum(q);
        const float r = rsqrtf(q * (1.0f / 1024.0f) + LN_EPS);
        float* dst = ((t < T_PROMPT) ? out + OUT_YP + (size_t)t * D_MODEL : out + OUT_YS + (size_t)(t - T_PROMPT) * D_MODEL) + lane * 8;
#pragma unroll
        for (int q4 = 0; q4 < 4; ++q4) {
            const int eo = (q4 >> 1) * 512 + (q4 & 1) * 4;
            const float4 g4 = *(const float4*)(gam + lane * 8 + eo), b4 = *(const float4*)(bet + lane * 8 + eo);
            float4 o; o.x = acc[q4 * 4 + 0] * r * g4.x + b4.x; o.y = acc[q4 * 4 + 1] * r * g4.y + b4.y; o.z = acc[q4 * 4 + 2] * r * g4.z + b4.z; o.w = acc[q4 * 4 + 3] * r * g4.w + b4.w;
            *(float4*)(dst + eo) = o;
        }
    }
}

__device__ __forceinline__ void ph_attn_sample(float* lds, const bf16* __restrict__ qrot_b, const bf16* __restrict__ krot_b, const bf16* __restrict__ projb,
                                               const float* __restrict__ ck, const float* __restrict__ cv, bf16* __restrict__ A1) {
    float (*sq)[64] = (float (*)[64])lds;
    const int w = threadIdx.x >> 6, lane0 = threadIdx.x & 63;
    for (int vb = blockIdx.x; vb < T_SAMPLE * 8 / NWAVE; vb += gridDim.x) {
        int lane = lane0; asm volatile("" : "+v"(lane));
        const int item = vb * NWAVE + w, ts = item >> 3, hd = item & 7, b = ts >> 2, i = ts & 3, t = T_PROMPT + ts;
        __syncthreads();
        sq[w][lane] = bf2f(qrot_b[(size_t)t * ATT_WIDTH + hd * 64 + lane]);
        __syncthreads();
        const int qi = WBUF + i;
        float sc[8];
        float mx = -INFINITY;
#pragma unroll
        for (int slot = 0; slot < 7; ++slot) {
            const int pt = slot < 6 ? (slot >> 1) : (lane < 3 ? lane : 0);
            const int m = slot < 6 ? lane + 64 * (slot & 1) : 128;
            const int kj = qi - (m << (2 * pt));
            const bool valid = (slot < 6 || lane < 3) && kj < WBUF;
            const int kc = kj < WBUF ? kj : WBUF - 1;
            const float* kr = ck + ((size_t)b * WBUF + kc) * ATT_WIDTH + hd * 64;
            float a = 0.f;
#pragma unroll
            for (int c = 0; c < 64; c += 4) { const float4 kv = *(const float4*)(kr + c); a += kv.x * sq[w][c] + kv.y * sq[w][c + 1] + kv.z * sq[w][c + 2] + kv.w * sq[w][c + 3]; }
            const float s = valid ? a * 0.125f : -INFINITY;
            sc[slot] = s; mx = fmaxf(mx, s);
        }
        const int nt7 = lane <= i ? i - lane : i;
        const bool valid7 = lane < i + 3;
        {
            const bf16* kr = krot_b + (size_t)(T_PROMPT + b * DEC_SEQ + nt7) * ATT_WIDTH + hd * 64;
            float a = 0.f;
#pragma unroll
            for (int c = 0; c < 64; c += 8) { float f[8]; unpack8(*(const v4u*)(kr + c), f);
#pragma unroll
                for (int j = 0; j < 8; ++j) a += f[j] * sq[w][c + j]; }
            const float s = valid7 ? a * 0.125f : -INFINITY;
            sc[7] = s; mx = fmaxf(mx, s);
        }
        mx = wave_max(mx);
        float lsum = 0.f;
#pragma unroll
        for (int slot = 0; slot < 8; ++slot) { const float pv = __expf(sc[slot] - mx); sc[slot] = pv; lsum += pv; }
        lsum = wave_sum(lsum);
        float part[64];
#pragma unroll
        for (int c = 0; c < 64; ++c) part[c] = 0.f;
#pragma unroll
        for (int slot = 0; slot < 7; ++slot) {
            const int pt = slot < 6 ? (slot >> 1) : (lane < 3 ? lane : 0);
            const int m = slot < 6 ? lane + 64 * (slot & 1) : 128;
            const int kj = qi - (m << (2 * pt));
            const int kc = kj < WBUF ? kj : WBUF - 1;
            const float pv = sc[slot];
            const float* vr = cv + ((size_t)b * WBUF + kc) * ATT_WIDTH + hd * 64;
#pragma unroll
            for (int c = 0; c < 64; c += 4) { const float4 vv = *(const float4*)(vr + c); part[c] += pv * vv.x; part[c + 1] += pv * vv.y; part[c + 2] += pv * vv.z; part[c + 3] += pv * vv.w; }
        }
        {
            const float pv = sc[7];
            const bf16* vr = projb + (size_t)(T_PROMPT + b * DEC_SEQ + nt7) * NB_LD + NB_V + hd * 64;
#pragma unroll
            for (int c = 0; c < 64; c += 8) { float f[8]; unpack8(*(const v4u*)(vr + c), f);
#pragma unroll
                for (int j = 0; j < 8; ++j) part[c + j] += pv * f[j]; }
        }
        PEER_TR_STEP(32, 32) PEER_TR_STEP(16, 16) PEER_TR_STEP(8, 8) PEER_TR_STEP(4, 4) PEER_TR_STEP(2, 2) PEER_TR_STEP(1, 1)
        A1[(size_t)t * MIX_WIDTH + SSD_WIDTH + hd * 64 + lane] = (bf16)f2bf(part[0] / lsum);
    }
}


__device__ __forceinline__ void cache_copy_slice(const float* __restrict__ ck, const float* __restrict__ cv, float* __restrict__ out, unsigned slice, unsigned lane) {
    constexpr unsigned PER_B = (WBUF - DEC_SEQ) * ATT_WIDTH / 4;
    constexpr unsigned TOTAL = 2u * DEC_BATCH * PER_B;
#pragma unroll 1
    for (unsigned bt = 0; bt < 8; ++bt) {
        f32x4n v[8]; size_t dsti[8]; bool isv[8]; bool ok[8];
#pragma unroll
        for (int j = 0; j < 8; ++j) {
            const unsigned idx = slice * 4096u + bt * 512u + j * 64u + lane;
            ok[j] = idx < TOTAL;
            const unsigned idc = ok[j] ? idx : 0u;
            const unsigned tb = idc / PER_B, r = idc - tb * PER_B, bb = tb & (DEC_BATCH - 1);
            isv[j] = tb >= DEC_BATCH;
            const size_t srci = (size_t)bb * (WBUF * ATT_WIDTH / 4) + (DEC_SEQ * ATT_WIDTH / 4) + r;
            dsti[j] = (size_t)bb * (WBUF * ATT_WIDTH / 4) + r;
            v[j] = __builtin_nontemporal_load((isv[j] ? (const f32x4n*)cv : (const f32x4n*)ck) + srci);
        }
#pragma unroll
        for (int j = 0; j < 8; ++j) if (ok[j]) __builtin_nontemporal_store(v[j], (f32x4n*)(out + (isv[j] ? OUT_SV : OUT_SK)) + dsti[j]);
    }
}

__device__ __forceinline__ void copy_q_load(const float* __restrict__ ck, const float* __restrict__ cv, unsigned q, unsigned lane, f32x4n (&v)[16]) {
    constexpr unsigned PER_B = (WBUF - DEC_SEQ) * ATT_WIDTH / 4, TOTAL = 2u * DEC_BATCH * PER_B;
#pragma unroll
    for (int j = 0; j < 16; ++j) {
        const unsigned idx = q * 1024u + j * 64u + lane, idc = idx < TOTAL ? idx : 0u;
        const unsigned tb = idc / PER_B, r = idc - tb * PER_B, bb = tb & (DEC_BATCH - 1);
        const size_t srci = (size_t)bb * (WBUF * ATT_WIDTH / 4) + (DEC_SEQ * ATT_WIDTH / 4) + r;
        v[j] = __builtin_nontemporal_load((tb >= DEC_BATCH ? (const f32x4n*)cv : (const f32x4n*)ck) + srci);
    }
}
__device__ __forceinline__ void copy_q_store(float* __restrict__ out, unsigned q, unsigned lane, const f32x4n (&v)[16]) {
    constexpr unsigned PER_B = (WBUF - DEC_SEQ) * ATT_WIDTH / 4, TOTAL = 2u * DEC_BATCH * PER_B;
#pragma unroll
    for (int j = 0; j < 16; ++j) {
        const unsigned idx = q * 1024u + j * 64u + lane;
        if (idx < TOTAL) {
            const unsigned tb = idx / PER_B, r = idx - tb * PER_B, bb = tb & (DEC_BATCH - 1);
            const size_t dsti = (size_t)bb * (WBUF * ATT_WIDTH / 4) + r;
            __builtin_nontemporal_store(v[j], (f32x4n*)(out + (tb >= DEC_BATCH ? OUT_SV : OUT_SK)) + dsti);
        }
    }
}
typedef float f32x2v __attribute__((ext_vector_type(2)));
typedef unsigned u32x6 __attribute__((ext_vector_type(6)));
typedef float f32x32 __attribute__((ext_vector_type(32)));
typedef float f32x16q __attribute__((ext_vector_type(16)));
struct __attribute__((aligned(4))) u3w { unsigned x, y, z; };
#define PEER_ROWB 768
__device__ __forceinline__ void ph_quant_tables(const float* __restrict__ pu, const float* __restrict__ pv, unsigned char* __restrict__ ub8, unsigned char* __restrict__ vb8,
                                                float* __restrict__ usc, float* __restrict__ vsc, int rank, int nranks) {
    const int lane = threadIdx.x & 63;
#pragma unroll 2
    for (int row = rank * NWAVE + (threadIdx.x >> 6); row < 2 * 16384; row += nranks * NWAVE) {
        const int rr = row & 16383; const bool isv = row >= 16384;
        const float* src = (isv ? pv : pu) + (size_t)rr * D_MODEL + lane * 8;
        const float4 a = *(const float4*)src, b = *(const float4*)(src + 4), c = *(const float4*)(src + 512), d = *(const float4*)(src + 516);
        float am = fmaxf(fmaxf(fmaxf(fabsf(a.x), fabsf(a.y)), fmaxf(fabsf(a.z), fabsf(a.w))), fmaxf(fmaxf(fabsf(b.x), fabsf(b.y)), fmaxf(fabsf(b.z), fabsf(b.w))));
        am = fmaxf(am, fmaxf(fmaxf(fmaxf(fabsf(c.x), fabsf(c.y)), fmaxf(fabsf(c.z), fabsf(c.w))), fmaxf(fmaxf(fabsf(d.x), fabsf(d.y)), fmaxf(fabsf(d.z), fabsf(d.w)))));
        am = wave_max(am);
        const float sc = am > 0.f ? 7.5f / am : 1.0f;
        f32x16q e0, e1;
#pragma unroll
        for (int i = 0; i < 16; ++i) { e0[i] = 0.f; e1[i] = 0.f; }
        e0[0] = a.x * sc; e1[0] = a.y * sc; e0[1] = a.z * sc; e1[1] = a.w * sc; e0[2] = b.x * sc; e1[2] = b.y * sc; e0[3] = b.z * sc; e1[3] = b.w * sc;
        e0[4] = c.x * sc; e1[4] = c.y * sc; e0[5] = c.z * sc; e1[5] = c.w * sc; e0[6] = d.x * sc; e1[6] = d.y * sc; e0[7] = d.z * sc; e1[7] = d.w * sc;
        const u32x6 qv = __builtin_amdgcn_cvt_scalef32_2xpk16_fp6_f32(e0, e1, 1.0f);
        u3w o; o.x = qv[0]; o.y = qv[1]; o.z = qv[2];
        *(u3w*)((isv ? vb8 : ub8) + (size_t)rr * PEER_ROWB + lane * 12) = o;
        if (lane == 0) (isv ? vsc : usc)[rr] = am > 0.f ? am * (1.0f / 7.5f) : 1.0f;
    }
}
__device__ __forceinline__ void unpack16_fp8(const v4u w, float (&f)[16]) {
#pragma unroll
    for (int i = 0; i < 4; ++i) {
        const f32x2v lo = __builtin_amdgcn_cvt_pk_f32_fp8((int)w[i], false), hi = __builtin_amdgcn_cvt_pk_f32_fp8((int)w[i], true);
        f[4 * i] = lo[0]; f[4 * i + 1] = lo[1]; f[4 * i + 2] = hi[0]; f[4 * i + 3] = hi[1];
    }
}
__device__ __forceinline__ unsigned ffn_slice(unsigned n9, unsigned it) {
    const unsigned w = (unsigned)__builtin_amdgcn_readfirstlane(threadIdx.x >> 6), wgl = blockIdx.x * NWAVE + w;
    if (gridDim.x != 256) return n9 + wgl + it * (gridDim.x * NWAVE);
    if (it < 2u) return n9 + it * 2048u + wgl;
    if (w < 2u) return 0xffffffffu;
    const unsigned lw = blockIdx.x * 6u + (w - 2u);
    if (it < 4u) return n9 + 4096u + (it - 2u) * 1536u + lw;
    if (it == 4u && lw < 256u) return n9 + 7168u + lw;
    return 0xffffffffu;
}
__device__ __forceinline__ void ph_peer_ffn3(const bf16* __restrict__ hb, const int* __restrict__ eidx, const float* __restrict__ gate,
                                             const unsigned char* __restrict__ ub8, const unsigned char* __restrict__ vb8, const float* __restrict__ usc, const float* __restrict__ vsc,
                                             const float* __restrict__ gam, const float* __restrict__ bet, float* __restrict__ out,
                                             const float* __restrict__ ck, const float* __restrict__ cv, unsigned n9) {
    const int lane0 = threadIdx.x & 63;
    unsigned it = 0;
    for (;; ++it) {
        const int t = token_of_iter((int)it);
        if (t < 0) break;
        int lane = lane0; asm volatile("" : "+v"(lane));
        { const unsigned sl = ffn_slice(n9, it); if (sl < 16384u) cache_copy_slice(ck, cv, out, sl, (unsigned)lane); }
        const unsigned lo12 = (unsigned)lane * 12u, lo8 = (unsigned)lane * 8u;
        float x[16];
        { float f0[8], f1[8]; const bf16* xr = hb + (size_t)t * D_MODEL + lo8; unpack8(*(const v4u*)xr, f0); unpack8(*(const v4u*)(xr + 512), f1);
#pragma unroll
          for (int j = 0; j < 8; ++j) { x[j] = f0[j]; x[8 + j] = f1[j]; } }
        int ev[2]; float wv[4], su[4];
        ev[0] = eidx[(size_t)t * 128 + lane]; ev[1] = eidx[(size_t)t * 128 + 64 + lane];
#pragma unroll
        for (int rd = 0; rd < 4; ++rd) {
            const int er = eidx[(size_t)t * 128 + rd * 32 + (lane >> 1)];
            wv[rd] = gate[(size_t)t * 128 + rd * 32 + (lane >> 1)] * vsc[er];
            su[rd] = usc[er];
        }
#pragma unroll
        for (int rd = 0; rd < 4; ++rd) {
            float part[32];
#pragma unroll
            for (int kb = 0; kb < 2; ++kb) {
                u3w ra[16];
#pragma unroll
                for (int k8 = 0; k8 < 16; ++k8) {
                    const int e = __builtin_amdgcn_readlane(ev[rd >> 1], (rd & 1) * 32 + kb * 16 + k8);
                    ra[k8] = *(const u3w*)(ub8 + (size_t)e * PEER_ROWB + lo12);
                }
#pragma unroll
                for (int k8 = 0; k8 < 16; k8 += 2) {
                    u32x6 sv; sv[0] = ra[k8].x; sv[1] = ra[k8].y; sv[2] = ra[k8].z; sv[3] = ra[k8 + 1].x; sv[4] = ra[k8 + 1].y; sv[5] = ra[k8 + 1].z;
                    const f32x32 f = __builtin_amdgcn_cvt_scalef32_pk32_f32_fp6(sv, 1.0f);
                    f32x2v d0 = {0.f, 0.f}, d1 = {0.f, 0.f};
#pragma unroll
                    for (int i = 0; i < 8; ++i) {
                        d0 += (f32x2v){f[2 * i], f[2 * i + 1]} * (f32x2v){x[2 * i], x[2 * i + 1]};
                        d1 += (f32x2v){f[16 + 2 * i], f[17 + 2 * i]} * (f32x2v){x[2 * i], x[2 * i + 1]};
                    }
                    part[kb * 16 + k8] = d0[0] + d0[1]; part[kb * 16 + k8 + 1] = d1[0] + d1[1];
                    __builtin_amdgcn_sched_barrier(0);
                }
            }
            PEER_TR_STEP(16, 32) PEER_TR_STEP(8, 16) PEER_TR_STEP(4, 8) PEER_TR_STEP(2, 4) PEER_TR_STEP(1, 2)
            const float hid = (part[0] + __shfl_xor(part[0], 1)) * su[rd];
            wv[rd] *= gelu_f(hid);
        }
        f32x2v accp[8];
#pragma unroll
        for (int i = 0; i < 8; ++i) accp[i] = (f32x2v){0.f, 0.f};
#pragma unroll
        for (int rd = 0; rd < 4; ++rd) {
#pragma unroll
            for (int kb = 0; kb < 2; ++kb) {
                u3w ra[16];
#pragma unroll
                for (int k8 = 0; k8 < 16; ++k8) {
                    const int e = __builtin_amdgcn_readlane(ev[rd >> 1], (rd & 1) * 32 + kb * 16 + k8);
                    ra[k8] = *(const u3w*)(vb8 + (size_t)e * PEER_ROWB + lo12);
                }
#pragma unroll
                for (int k8 = 0; k8 < 16; k8 += 2) {
                    const float wk0 = __builtin_bit_cast(float, __builtin_amdgcn_readlane(__builtin_bit_cast(int, wv[rd]), 2 * (kb * 16 + k8)));
                    const float wk1 = __builtin_bit_cast(float, __builtin_amdgcn_readlane(__builtin_bit_cast(int, wv[rd]), 2 * (kb * 16 + k8 + 1)));
                    u32x6 sv; sv[0] = ra[k8].x; sv[1] = ra[k8].y; sv[2] = ra[k8].z; sv[3] = ra[k8 + 1].x; sv[4] = ra[k8 + 1].y; sv[5] = ra[k8 + 1].z;
                    const f32x32 f = __builtin_amdgcn_cvt_scalef32_pk32_f32_fp6(sv, 1.0f);
#pragma unroll
                    for (int i = 0; i < 8; ++i) {
                        accp[i] += (f32x2v){wk0, wk0} * (f32x2v){f[2 * i], f[2 * i + 1]};
                        accp[i] += (f32x2v){wk1, wk1} * (f32x2v){f[16 + 2 * i], f[17 + 2 * i]};
                    }
                    __builtin_amdgcn_sched_barrier(0);
                }
            }
        }
        float acc[16];
#pragma unroll
        for (int i = 0; i < 8; ++i) { acc[2 * i] = accp[i][0]; acc[2 * i + 1] = accp[i][1]; }
        float s = 0.f;
#pragma unroll
        for (int j = 0; j < 16; ++j) { acc[j] += ALPHA_F * x[j]; s += acc[j]; }
        s = wave_sum(s);
        const float mu = s * (1.0f / 1024.0f);
        float q = 0.f;
#pragma unroll
        for (int j = 0; j < 16; ++j) { acc[j] -= mu; q += acc[j] * acc[j]; }
        q = wave_sum(q);
        const float r = rsqrtf(q * (1.0f / 1024.0f) + LN_EPS);
        float* dst = ((t < T_PROMPT) ? out + OUT_YP + (size_t)t * D_MODEL : out + OUT_YS + (size_t)(t - T_PROMPT) * D_MODEL) + lo8;
#pragma unroll
        for (int q4 = 0; q4 < 4; ++q4) {
            const int eo = (q4 >> 1) * 512 + (q4 & 1) * 4;
            const float4 g4 = *(const float4*)(gam + lo8 + eo), b4 = *(const float4*)(bet + lo8 + eo);
            float4 o; o.x = acc[q4 * 4 + 0] * r * g4.x + b4.x; o.y = acc[q4 * 4 + 1] * r * g4.y + b4.y; o.z = acc[q4 * 4 + 2] * r * g4.z + b4.z; o.w = acc[q4 * 4 + 3] * r * g4.w + b4.w;
            *(float4*)(dst + eo) = o;
        }
    }
    for (;; ++it) {
        if (gridDim.x == 256 && it >= 5u) break;
        const unsigned sl = ffn_slice(n9, it);
        if (gridDim.x != 256 && sl >= 16384u) break;
        if (sl < 16384u) cache_copy_slice(ck, cv, out, sl, (unsigned)lane0);
    }
}


__device__ __forceinline__ void ssd_decode_load(const bf16* __restrict__ xbc_b, const float* __restrict__ dtv, const float* __restrict__ state_ssm, int item, int p, int ng,
                                                float (&hs)[16], v4u (&bq)[4][2], v4u (&cq)[4][2], float (&xv)[4], float (&dv)[4]) {
    const int sb = item / SSD_HEADS, h = item - sb * SSD_HEADS, g = h / 6, t0 = T_PROMPT + sb * DEC_SEQ;
    const float* s0 = state_ssm + (((size_t)sb * SSD_HEADS + h) * 64 + p) * 128 + ng * 16;
#pragma unroll
    for (int j = 0; j < 4; ++j) { const float4 v = *(const float4*)(s0 + 4 * j); hs[4 * j] = v.x; hs[4 * j + 1] = v.y; hs[4 * j + 2] = v.z; hs[4 * j + 3] = v.w; }
#pragma unroll
    for (int s = 0; s < 4; ++s) {
        const bf16* row = xbc_b + (size_t)(t0 + s) * CONV_DIM;
        bq[s][0] = *(const v4u*)(row + 1536 + g * 128 + ng * 16); bq[s][1] = *(const v4u*)(row + 1536 + g * 128 + ng * 16 + 8);
        cq[s][0] = *(const v4u*)(row + 2048 + g * 128 + ng * 16); cq[s][1] = *(const v4u*)(row + 2048 + g * 128 + ng * 16 + 8);
        xv[s] = bf2f(row[h * 64 + p]); dv[s] = dtv[(size_t)(t0 + s) * SSD_HEADS + h];
    }
}
__device__ __forceinline__ void ssd_decode_compute(const float* __restrict__ a_log, const float* __restrict__ d_skip, int item, int p, int ng,
                                                   float (&hs)[16], const v4u (&bq)[4][2], const v4u (&cq)[4][2], const float (&xv)[4], const float (&dv)[4],
                                                   float* __restrict__ ybuf, float* __restrict__ out) {
    const int sb = item / SSD_HEADS, h = item - sb * SSD_HEADS, t0 = T_PROMPT + sb * DEC_SEQ;
    const float A = -__expf(a_log[h]), D = d_skip[h];
#pragma unroll
    for (int s = 0; s < 4; ++s) {
        float Bf[16], Cf[16];
        { float t8[8]; unpack8(bq[s][0], t8);
#pragma unroll
          for (int j = 0; j < 8; ++j) Bf[j] = t8[j];
          unpack8(bq[s][1], t8);
#pragma unroll
          for (int j = 0; j < 8; ++j) Bf[8 + j] = t8[j];
          unpack8(cq[s][0], t8);
#pragma unroll
          for (int j = 0; j < 8; ++j) Cf[j] = t8[j];
          unpack8(cq[s][1], t8);
#pragma unroll
          for (int j = 0; j < 8; ++j) Cf[8 + j] = t8[j]; }
        const float a = __expf(dv[s] * A), xdt = xv[s] * dv[s];
        float y = 0.f;
#pragma unroll
        for (int j = 0; j < 16; ++j) { hs[j] = a * hs[j] + xdt * Bf[j]; y += Cf[j] * hs[j]; }
        y += __shfl_xor(y, 1); y += __shfl_xor(y, 2); y += __shfl_xor(y, 4);
        if (ng == 0) ybuf[(size_t)(t0 + s) * MIX_WIDTH + h * 64 + p] = y + D * xv[s];
    }
    float* so = out + OUT_SS + (((size_t)sb * SSD_HEADS + h) * 64 + p) * 128 + ng * 16;
#pragma unroll
    for (int j = 0; j < 4; ++j) *(float4*)(so + 4 * j) = make_float4(hs[4 * j], hs[4 * j + 1], hs[4 * j + 2], hs[4 * j + 3]);
}
__device__ __forceinline__ void ph_ssd_decode(const bf16* __restrict__ xbc_b, const float* __restrict__ dtv, const float* __restrict__ a_log, const float* __restrict__ d_skip,
                                              const float* __restrict__ state_ssm, float* __restrict__ ybuf, float* __restrict__ out) {
    const int tid = threadIdx.x, p = tid >> 3, ng = tid & 7;
    constexpr int NITEM = DEC_BATCH * SSD_HEADS;
    for (int it = blockIdx.x; it < NITEM; it += 2 * gridDim.x) {
        const int it2 = it + gridDim.x; const bool has2 = it2 < NITEM; const int it2c = has2 ? it2 : it;
        float hsA[16], hsB[16], xA[4], xB[4], dA[4], dB[4]; v4u bA[4][2], cA[4][2], bB[4][2], cB[4][2];
        ssd_decode_load(xbc_b, dtv, state_ssm, it, p, ng, hsA, bA, cA, xA, dA);
        ssd_decode_load(xbc_b, dtv, state_ssm, it2c, p, ng, hsB, bB, cB, xB, dB);
        ssd_decode_compute(a_log, d_skip, it, p, ng, hsA, bA, cA, xA, dA, ybuf, out);
        if (has2) ssd_decode_compute(a_log, d_skip, it2, p, ng, hsB, bB, cB, xB, dB, ybuf, out);
    }
}

__device__ __forceinline__ float samp_cw(int d) { return (float)((int)(d >= 0 && d <= 128) + (int)(d >= 0 && (d & 3) == 0 && d <= 512) + (int)(d >= 0 && (d & 15) == 0 && d <= 2048)); }
__device__ __forceinline__ void samp_update(float sv, float cw, const float (&vrow)[64], float& m, float& l, float (&part)[64]) {
    const float mn = fmaxf(m, sv), alpha = __expf(m - mn), p = cw * __expf(sv - mn);
    m = mn; l = l * alpha + p;
#pragma unroll
    for (int c = 0; c < 64; ++c) part[c] = part[c] * alpha + p * vrow[c];
}
__device__ __forceinline__ void ph_attn_sample3(float* lds, const bf16* __restrict__ qrot_b, const bf16* __restrict__ krot_b, const bf16* __restrict__ projb,
                                                const float* __restrict__ ck, const float* __restrict__ cv, bf16* __restrict__ A1) {
    const int lane0 = threadIdx.x & 63, w = __builtin_amdgcn_readfirstlane(threadIdx.x >> 6), hf = w >> 2, wi = w & 3;
    float* sq = lds + w * 256;
    float* mg = lds + 8 * 256 + wi * 6 * 64;
    const int nitem = DEC_BATCH * ATT_HEADS, niter = (nitem + gridDim.x * 4 - 1) / (gridDim.x * 4);
    for (int itn = 0; itn < niter; ++itn) {
        const int item = blockIdx.x + gridDim.x * (wi + 4 * itn);
        const bool live = item < nitem;
        int lane = lane0; asm volatile("" : "+v"(lane));
        const int itc = live ? item : 0;
        const int b = itc >> 3, hd = itc & 7, qi = lane & 3, g = lane >> 2;
        const int tq0 = T_PROMPT + b * DEC_SEQ;
        __syncthreads();
#pragma unroll
        for (int i = 0; i < 4; ++i) sq[i * 64 + lane] = bf2f(qrot_b[(size_t)(tq0 + i) * ATT_WIDTH + hd * 64 + lane]);
        asm volatile("s_waitcnt lgkmcnt(0)" ::: "memory");
        const float* qv = sq + qi * 64;
        const float* ckb = ck + (size_t)b * WBUF * ATT_WIDTH + hd * 64; const float* cvb = cv + (size_t)b * WBUF * ATT_WIDTH + hd * 64;
        float m = -1e30f, l = 0.f, part[64];
#pragma unroll
        for (int c = 0; c < 64; ++c) part[c] = 0.f;
        if (hf == 0) {
            const int P = 2051 - g;
            const float cw = samp_cw(WBUF + qi - P);
            const bool isn = P >= WBUF;
            const int nt = isn ? P - WBUF : 0, Pc = isn ? WBUF - 1 : P;
            const bf16* kn = krot_b + (size_t)(tq0 + nt) * ATT_WIDTH + hd * 64; const float* kr = ckb + (size_t)Pc * ATT_WIDTH;
            float a = 0.f;
#pragma unroll
            for (int c = 0; c < 64; c += 8) { float f[8]; unpack8(*(const v4u*)(kn + c), f); const float4 k0 = *(const float4*)(kr + c), k1 = *(const float4*)(kr + c + 4);
                a += (isn ? f[0] : k0.x) * qv[c] + (isn ? f[1] : k0.y) * qv[c + 1] + (isn ? f[2] : k0.z) * qv[c + 2] + (isn ? f[3] : k0.w) * qv[c + 3]
                   + (isn ? f[4] : k1.x) * qv[c + 4] + (isn ? f[5] : k1.y) * qv[c + 5] + (isn ? f[6] : k1.z) * qv[c + 6] + (isn ? f[7] : k1.w) * qv[c + 7]; }
            const float sv = cw > 0.f ? a * 0.125f : -1e30f;
            const bf16* vn = projb + (size_t)(tq0 + nt) * NB_LD + NB_V + hd * 64; const float* vr = cvb + (size_t)Pc * ATT_WIDTH;
            float vrow[64];
#pragma unroll
            for (int c = 0; c < 64; c += 8) { float f[8]; unpack8(*(const v4u*)(vn + c), f); const float4 v0 = *(const float4*)(vr + c), v1 = *(const float4*)(vr + c + 4);
                vrow[c] = isn ? f[0] : v0.x; vrow[c + 1] = isn ? f[1] : v0.y; vrow[c + 2] = isn ? f[2] : v0.z; vrow[c + 3] = isn ? f[3] : v0.w;
                vrow[c + 4] = isn ? f[4] : v1.x; vrow[c + 5] = isn ? f[5] : v1.y; vrow[c + 6] = isn ? f[6] : v1.z; vrow[c + 7] = isn ? f[7] : v1.w; }
            samp_update(sv, cw, vrow, m, l, part);
        }
        const int s_lo = hf == 0 ? 1 : 11, s_hi = hf == 0 ? 11 : 21;
#pragma unroll 1
        for (int s = s_lo; s < s_hi; ++s) {
            const int P = s < 9 ? 2051 - (16 * s + g) : (s < 15 ? 1536 + 64 * (s - 9) + lane : qi + 16 * (16 * (s - 15) + g));
            const float cw = (s < 9 && P < 1920) ? 0.f : samp_cw(WBUF + qi - P);
            const float* kr = ckb + (size_t)P * ATT_WIDTH;
            float a = 0.f;
#pragma unroll
            for (int c = 0; c < 64; c += 4) { const float4 kv = *(const float4*)(kr + c); a += kv.x * qv[c] + kv.y * qv[c + 1] + kv.z * qv[c + 2] + kv.w * qv[c + 3]; }
            const float sv = cw > 0.f ? a * 0.125f : -1e30f;
            const float* vr = cvb + (size_t)P * ATT_WIDTH;
            float vrow[64];
#pragma unroll
            for (int c = 0; c < 64; c += 4) { const float4 vv = *(const float4*)(vr + c); vrow[c] = vv.x; vrow[c + 1] = vv.y; vrow[c + 2] = vv.z; vrow[c + 3] = vv.w; }
            samp_update(sv, cw, vrow, m, l, part);
        }
        float M = m;
        M = fmaxf(M, __shfl_xor(M, 4)); M = fmaxf(M, __shfl_xor(M, 8)); M = fmaxf(M, __shfl_xor(M, 16)); M = fmaxf(M, __shfl_xor(M, 32));
        const float sc = __expf(m - M);
        float lsum = l * sc;
        lsum += __shfl_xor(lsum, 4); lsum += __shfl_xor(lsum, 8); lsum += __shfl_xor(lsum, 16); lsum += __shfl_xor(lsum, 32);
#pragma unroll
        for (int c = 0; c < 64; ++c) part[c] *= sc;
        PEER_TR_STEP(32, 32) PEER_TR_STEP(16, 16) PEER_TR_STEP(8, 8) PEER_TR_STEP(4, 4)
        if (hf == 1) { mg[lane] = M; mg[64 + lane] = lsum; mg[128 + lane] = part[0]; mg[192 + lane] = part[1]; mg[256 + lane] = part[2]; mg[320 + lane] = part[3]; }
        __syncthreads();
        if (hf == 0 && live) {
            const float M1 = mg[lane], l1 = mg[64 + lane];
            const float Mc = fmaxf(M, M1), e0 = __expf(M - Mc), e1 = __expf(M1 - Mc);
            const float inv = 1.0f / (lsum * e0 + l1 * e1);
            const float o0 = (part[0] * e0 + mg[128 + lane] * e1) * inv, o1 = (part[1] * e0 + mg[192 + lane] * e1) * inv;
            const float o2 = (part[2] * e0 + mg[256 + lane] * e1) * inv, o3 = (part[3] * e0 + mg[320 + lane] * e1) * inv;
            *(uint2*)(A1 + (size_t)(tq0 + qi) * MIX_WIDTH + SSD_WIDTH + hd * 64 + 4 * g) = make_uint2(pk2(o0, o1), pk2(o2, o3));
        }
    }
}

typedef float f32x16 __attribute__((ext_vector_type(16)));
typedef short s16x8 __attribute__((ext_vector_type(8)));
typedef short s16x4 __attribute__((ext_vector_type(4)));
typedef float f32x4v __attribute__((ext_vector_type(4)));
#define SSD_L_ACS 0
#define SSD_L_DTS 3072
#define SSD_L_BM 6144
#define SSD_RS_B 272
#define SSD_L_X (6144 + 128 * 272)
#define SSD_RS_X 144
#define SSD_XIMG (128 * 144)
#define SSD_RS_Y 784
template <int OFF0, int OFF1>
__device__ __forceinline__ s16x8 tr_frag(unsigned base) {
    s16x4 a, b;
    asm volatile("ds_read_b64_tr_b16 %0, %2 offset:%3\n\tds_read_b64_tr_b16 %1, %2 offset:%4\n\ts_waitcnt lgkmcnt(0)"
                 : "=&v"(a), "=&v"(b) : "v"(base), "n"(OFF0), "n"(OFF1) : "memory");
    return __builtin_shufflevector(a, b, 0, 1, 2, 3, 4, 5, 6, 7);
}
__device__ __forceinline__ unsigned lds_addr(LAS unsigned char* p) { return (unsigned)(size_t)p; }
template <int O0, int O1, int O2, int O3, int O4, int O5, int O6, int O7>
__device__ __forceinline__ void tr_read8(unsigned base, s16x4 (&v)[8]) {
    asm volatile("ds_read_b64_tr_b16 %0, %8 offset:%9\n\tds_read_b64_tr_b16 %1, %8 offset:%10\n\tds_read_b64_tr_b16 %2, %8 offset:%11\n\tds_read_b64_tr_b16 %3, %8 offset:%12\n\t"
                 "ds_read_b64_tr_b16 %4, %8 offset:%13\n\tds_read_b64_tr_b16 %5, %8 offset:%14\n\tds_read_b64_tr_b16 %6, %8 offset:%15\n\tds_read_b64_tr_b16 %7, %8 offset:%16\n\ts_waitcnt lgkmcnt(0)"
                 : "=&v"(v[0]), "=&v"(v[1]), "=&v"(v[2]), "=&v"(v[3]), "=&v"(v[4]), "=&v"(v[5]), "=&v"(v[6]), "=&v"(v[7])
                 : "v"(base), "n"(O0), "n"(O1), "n"(O2), "n"(O3), "n"(O4), "n"(O5), "n"(O6), "n"(O7) : "memory");
}
#define TRCAT(a, b) __builtin_shufflevector(a, b, 0, 1, 2, 3, 4, 5, 6, 7)


__device__ __forceinline__ void ssd_chunk_acs(LAS unsigned char* ldsb, const float* __restrict__ dtv, const float* __restrict__ a_log, int t0, int g, float* cdec_out) {
    const int w = __builtin_amdgcn_readfirstlane(threadIdx.x >> 6), lane = threadIdx.x & 63;
    if (w < 6) {
        const int head = 6 * g + w;
        const float A = -__expf(a_log[head]);
        const float v0 = dtv[(size_t)(t0 + 2 * lane) * SSD_HEADS + head], v1 = dtv[(size_t)(t0 + 2 * lane + 1) * SSD_HEADS + head];
        const float a1 = v1 * A;
        float s = v0 * A + a1;
#pragma unroll
        for (int o = 1; o < 64; o <<= 1) { const float tmp = __shfl_up(s, o); if (lane >= o) s += tmp; }
        LAS float* acs = (LAS float*)(ldsb + SSD_L_ACS) + w * 128;
        LAS float* dts = (LAS float*)(ldsb + SSD_L_DTS) + w * 128;
        acs[2 * lane] = s - a1; acs[2 * lane + 1] = s;
        dts[2 * lane] = v0; dts[2 * lane + 1] = v1;
        if (cdec_out && lane == 63) cdec_out[head] = __expf(s);
    }
}

__device__ __forceinline__ void ph_ssd_states(LAS unsigned char* ldsb, const bf16* __restrict__ xbc_b, const float* __restrict__ dtv, const float* __restrict__ a_log,
                                              bf16* __restrict__ Sbuf, float* __restrict__ cdec, const float* __restrict__ ck, const float* __restrict__ cv, float* __restrict__ out) {
    const int tid = threadIdx.x, w = __builtin_amdgcn_readfirstlane(tid >> 6), lane = tid & 63;
    const int r = lane & 31, h = lane >> 5, blk = (lane >> 4) & 1, q = (lane & 15) >> 2, pp = lane & 3;
    const int nt = w & 3, pt = w >> 2;
    for (int unit = blockIdx.x; unit < BATCH * 64 * SSD_GROUPS; unit += gridDim.x) {
        const int g = unit & 3, bc = unit >> 2;
        const int t0 = bc * 128;
        __syncthreads();
        ssd_chunk_acs(ldsb, dtv, a_log, t0, g, cdec + (size_t)bc * SSD_HEADS);
#pragma unroll
        for (int it_ = 0; it_ < 4; ++it_) { const int idx = tid + it_ * NTHR; const int row = idx >> 4, ch = idx & 15;
            const v4u v = *(const v4u*)(xbc_b + (size_t)(t0 + row) * CONV_DIM + 1536 + 128 * g + ch * 8);
            *(LAS v4u*)(ldsb + SSD_L_BM + row * SSD_RS_B + ch * 16) = v; }
        __syncthreads();
#pragma unroll
        for (int it_ = 0; it_ < 12; ++it_) { const int idx = tid + it_ * NTHR; const int hh = idx >> 10, rem = idx & 1023, row = rem >> 3, ch = rem & 7;
            const LAS float* acs = (const LAS float*)(ldsb + SSD_L_ACS) + hh * 128; const LAS float* dts = (const LAS float*)(ldsb + SSD_L_DTS) + hh * 128;
            const float wgt = dts[row] * __expf(acs[127] - acs[row]);
            float f[8]; unpack8(*(const v4u*)(xbc_b + (size_t)(t0 + row) * CONV_DIM + (6 * g + hh) * 64 + ch * 8), f);
            v4u o; o.x = pk2(f[0] * wgt, f[1] * wgt); o.y = pk2(f[2] * wgt, f[3] * wgt); o.z = pk2(f[4] * wgt, f[5] * wgt); o.w = pk2(f[6] * wgt, f[7] * wgt);
            *(LAS v4u*)(ldsb + SSD_L_X + hh * SSD_XIMG + row * SSD_RS_X + ch * 16) = o; }
        __syncthreads();
        f32x4n rider[16];
        copy_q_load(ck, cv, 12288u + (unsigned)(unit * NWAVE + w), (unsigned)lane, rider);
        const unsigned abase = lds_addr(ldsb + SSD_L_BM) + (8 * h + q) * SSD_RS_B + (32 * nt + 16 * blk + 4 * pp) * 2;
        s16x8 afr[8];
        { s16x4 av[8];
          tr_read8<0 * SSD_RS_B, 4 * SSD_RS_B, 16 * SSD_RS_B, 20 * SSD_RS_B, 32 * SSD_RS_B, 36 * SSD_RS_B, 48 * SSD_RS_B, 52 * SSD_RS_B>(abase, av);
          afr[0] = TRCAT(av[0], av[1]); afr[1] = TRCAT(av[2], av[3]); afr[2] = TRCAT(av[4], av[5]); afr[3] = TRCAT(av[6], av[7]);
          tr_read8<64 * SSD_RS_B, 68 * SSD_RS_B, 80 * SSD_RS_B, 84 * SSD_RS_B, 96 * SSD_RS_B, 100 * SSD_RS_B, 112 * SSD_RS_B, 116 * SSD_RS_B>(abase, av);
          afr[4] = TRCAT(av[0], av[1]); afr[5] = TRCAT(av[2], av[3]); afr[6] = TRCAT(av[4], av[5]); afr[7] = TRCAT(av[6], av[7]); }
#pragma unroll
        for (int hh = 0; hh < 6; ++hh) {
            const unsigned xb = lds_addr(ldsb + SSD_L_X + hh * SSD_XIMG) + (8 * h + q) * SSD_RS_X + (32 * pt + 16 * blk + 4 * pp) * 2;
            f32x16 acc;
#pragma unroll
            for (int i = 0; i < 16; ++i) acc[i] = 0.f;
            { s16x4 xv[8];
              tr_read8<0 * SSD_RS_X, 4 * SSD_RS_X, 16 * SSD_RS_X, 20 * SSD_RS_X, 32 * SSD_RS_X, 36 * SSD_RS_X, 48 * SSD_RS_X, 52 * SSD_RS_X>(xb, xv);
              acc = __builtin_amdgcn_mfma_f32_32x32x16_bf16(afr[0], TRCAT(xv[0], xv[1]), acc, 0, 0, 0);
              acc = __builtin_amdgcn_mfma_f32_32x32x16_bf16(afr[1], TRCAT(xv[2], xv[3]), acc, 0, 0, 0);
              acc = __builtin_amdgcn_mfma_f32_32x32x16_bf16(afr[2], TRCAT(xv[4], xv[5]), acc, 0, 0, 0);
              acc = __builtin_amdgcn_mfma_f32_32x32x16_bf16(afr[3], TRCAT(xv[6], xv[7]), acc, 0, 0, 0);
              tr_read8<64 * SSD_RS_X, 68 * SSD_RS_X, 80 * SSD_RS_X, 84 * SSD_RS_X, 96 * SSD_RS_X, 100 * SSD_RS_X, 112 * SSD_RS_X, 116 * SSD_RS_X>(xb, xv);
              acc = __builtin_amdgcn_mfma_f32_32x32x16_bf16(afr[4], TRCAT(xv[0], xv[1]), acc, 0, 0, 0);
              acc = __builtin_amdgcn_mfma_f32_32x32x16_bf16(afr[5], TRCAT(xv[2], xv[3]), acc, 0, 0, 0);
              acc = __builtin_amdgcn_mfma_f32_32x32x16_bf16(afr[6], TRCAT(xv[4], xv[5]), acc, 0, 0, 0);
              acc = __builtin_amdgcn_mfma_f32_32x32x16_bf16(afr[7], TRCAT(xv[6], xv[7]), acc, 0, 0, 0); }
            bf16* dst = Sbuf + ((size_t)bc * SSD_HEADS + 6 * g + hh) * 8192 + (size_t)(pt * 8 + 2 * nt) * 512 + r * 8 + 4 * h;
#pragma unroll
            for (int q4 = 0; q4 < 4; ++q4) *(uint2*)(dst + (q4 >> 1) * 512 + (q4 & 1) * 256) = make_uint2(pk2(acc[4 * q4], acc[4 * q4 + 1]), pk2(acc[4 * q4 + 2], acc[4 * q4 + 3]));
        }
        copy_q_store(out, 12288u + (unsigned)(unit * NWAVE + w), (unsigned)lane, rider);
    }
}

__device__ __forceinline__ void ph_ssd_scan(const bf16* __restrict__ Sbuf, const float* __restrict__ cdec, bf16* __restrict__ Hin, float* __restrict__ out, int rank, int nranks) {
    for (int idx = rank * NTHR + threadIdx.x; idx < BATCH * SSD_HEADS * 1024; idx += nranks * NTHR) {
        const int i = idx & 1023, hb = idx >> 10, hd = hb % SSD_HEADS, b = hb / SSD_HEADS;
        float st[8];
#pragma unroll
        for (int j = 0; j < 8; ++j) st[j] = 0.f;
#pragma unroll 8
        for (int c = 0; c < 64; ++c) {
            const size_t base = (((size_t)(b * 64 + c)) * SSD_HEADS + hd) * 8192 + (size_t)i * 8;
            v4u o; o.x = pk2(st[0], st[1]); o.y = pk2(st[2], st[3]); o.z = pk2(st[4], st[5]); o.w = pk2(st[6], st[7]);
            *(v4u*)(Hin + base) = o;
            float s[8]; unpack8(*(const v4u*)(Sbuf + base), s);
            const float a = cdec[(size_t)(b * 64 + c) * SSD_HEADS + hd];
#pragma unroll
            for (int j = 0; j < 8; ++j) st[j] = a * st[j] + s[j];
        }
        const int ln = i & 63, ks = (i >> 6) & 7, pt = i >> 9, p = 32 * pt + (ln & 31), n0 = 16 * ks + 8 * (ln >> 5);
        store8f(out + OUT_PS + (((size_t)b * SSD_HEADS + hd) * 64 + p) * 128 + n0, st);
    }
}

__device__ __forceinline__ void ph_ssd_out(LAS unsigned char* ldsb, const bf16* __restrict__ xbc_b, const bf16* __restrict__ projb, const float* __restrict__ dtv,
                                           const float* __restrict__ a_log, const float* __restrict__ d_skip, const float* __restrict__ norm_g,
                                           const bf16* __restrict__ Hin, bf16* __restrict__ A1) {
    const int tid = threadIdx.x, w = __builtin_amdgcn_readfirstlane(tid >> 6), lane = tid & 63;
    const int r = lane & 31, h = lane >> 5, blk = (lane >> 4) & 1, q = (lane & 15) >> 2, pp = lane & 3;
    const int hs = w >> 2, lt = hs ? 3 - (w & 3) : (w & 3);
    for (int unit = blockIdx.x; unit < BATCH * 64 * SSD_GROUPS; unit += gridDim.x) {
        const int g = unit & 3, bc = unit >> 2;
        const int t0 = bc * 128;
        __syncthreads();
        ssd_chunk_acs(ldsb, dtv, a_log, t0, g, nullptr);
#pragma unroll
        for (int it_ = 0; it_ < 4; ++it_) { const int idx = tid + it_ * NTHR; const int row = idx >> 4, ch = idx & 15;
            const v4u v = *(const v4u*)(xbc_b + (size_t)(t0 + row) * CONV_DIM + 1536 + 128 * g + ch * 8);
            *(LAS v4u*)(ldsb + SSD_L_BM + row * SSD_RS_B + ch * 16) = v; }
#pragma unroll
        for (int it_ = 0; it_ < 12; ++it_) { const int idx = tid + it_ * NTHR; const int hh = idx >> 10, rem = idx & 1023, row = rem >> 3, ch = rem & 7;
            const v4u v = *(const v4u*)(xbc_b + (size_t)(t0 + row) * CONV_DIM + (6 * g + hh) * 64 + ch * 8);
            *(LAS v4u*)(ldsb + SSD_L_X + hh * SSD_XIMG + row * SSD_RS_X + ch * 16) = v; }
        __syncthreads();
        const bf16* cp = xbc_b + (size_t)(t0 + 32 * lt + r) * CONV_DIM + 2048 + 128 * g + 8 * h;
        s16x8 cfr[8];
#pragma unroll
        for (int ks = 0; ks < 8; ++ks) cfr[ks] = *(const s16x8*)(cp + 16 * ks);
        const int lcol = 32 * lt + r;
        const LAS float* acsb = (const LAS float*)(ldsb + SSD_L_ACS) + 3 * hs * 128; const LAS float* dtsb = (const LAS float*)(ldsb + SSD_L_DTS) + 3 * hs * 128;
        const unsigned xb0 = lds_addr(ldsb + SSD_L_X + 3 * hs * SSD_XIMG) + (4 * h + q) * SSD_RS_X + (16 * blk + 4 * pp) * 2;
        unsigned ypk[3][16];
#pragma unroll
        for (int h3 = 0; h3 < 3; ++h3) {
            const LAS float* acs = acsb + h3 * 128; const LAS float* dts = dtsb + h3 * 128;
            const float myacs = acs[lcol];
            const float Dh = d_skip[6 * g + 3 * hs + h3];
            f32x16 y0, y1;
#pragma unroll
            for (int i = 0; i < 16; ++i) { y0[i] = 0.f; y1[i] = 0.f; }
            { const bf16* hp = Hin + ((size_t)bc * SSD_HEADS + 6 * g + 3 * hs + h3) * 8192 + lane * 8;
#pragma unroll
              for (int kh = 0; kh < 2; ++kh) {
                  s16x8 hf0[4], hf1[4];
#pragma unroll
                  for (int ks = 0; ks < 4; ++ks) { hf0[ks] = *(const s16x8*)(hp + (4 * kh + ks) * 512); hf1[ks] = *(const s16x8*)(hp + (8 + 4 * kh + ks) * 512); }
#pragma unroll
                  for (int ks = 0; ks < 4; ++ks) { y0 = __builtin_amdgcn_mfma_f32_32x32x16_bf16(cfr[4 * kh + ks], hf0[ks], y0, 0, 0, 0); y1 = __builtin_amdgcn_mfma_f32_32x32x16_bf16(cfr[4 * kh + ks], hf1[ks], y1, 0, 0, 0); }
                  __builtin_amdgcn_sched_barrier(0);
              } }
#pragma unroll
            for (int q4 = 0; q4 < 4; ++q4) {
                const f32x4v a4 = *(const LAS f32x4v*)(acs + 32 * lt + 8 * q4 + 4 * h);
                const float e0 = __expf(a4[0]), e1 = __expf(a4[1]), e2 = __expf(a4[2]), e3 = __expf(a4[3]);
                y0[4 * q4] *= e0; y0[4 * q4 + 1] *= e1; y0[4 * q4 + 2] *= e2; y0[4 * q4 + 3] *= e3;
                y1[4 * q4] *= e0; y1[4 * q4 + 1] *= e1; y1[4 * q4 + 2] *= e2; y1[4 * q4 + 3] *= e3;
            }
            __builtin_amdgcn_sched_barrier(0);
            for (int st = 0; st <= lt; ++st) {
                f32x16 cb;
#pragma unroll
                for (int i = 0; i < 16; ++i) cb[i] = 0.f;
#pragma unroll
                for (int ks = 0; ks < 8; ++ks) {
                    const s16x8 bfrag = *(const LAS s16x8*)(ldsb + SSD_L_BM + (32 * st + r) * SSD_RS_B + (16 * ks + 8 * h) * 2);
                    cb = __builtin_amdgcn_mfma_f32_32x32x16_bf16(bfrag, cfr[ks], cb, 0, 0, 0);
                }
                __builtin_amdgcn_sched_barrier(0);
                const unsigned xb = xb0 + h3 * SSD_XIMG + st * 32 * SSD_RS_X;
                s16x4 xv[8];
                tr_read8<0, 8 * SSD_RS_X, 64, 8 * SSD_RS_X + 64, 16 * SSD_RS_X, 24 * SSD_RS_X, 16 * SSD_RS_X + 64, 24 * SSD_RS_X + 64>(xb, xv);
#pragma unroll
                for (int kk = 0; kk < 2; ++kk) {
                    const int s0 = 32 * st + 16 * kk + 4 * h;
                    const f32x4v as0 = *(const LAS f32x4v*)(acs + s0), as1 = *(const LAS f32x4v*)(acs + s0 + 8);
                    const f32x4v ds0 = *(const LAS f32x4v*)(dts + s0), ds1 = *(const LAS f32x4v*)(dts + s0 + 8);
                    float wv[8];
#pragma unroll
                    for (int j = 0; j < 8; ++j) {
                        const int s = s0 + 8 * (j >> 2) + (j & 3);
                        const float asj = (j < 4) ? as0[j & 3] : as1[j & 3], dsj = (j < 4) ? ds0[j & 3] : ds1[j & 3];
                        float v = cb[8 * kk + j] * __expf(myacs - asj) * dsj;
                        v = (s <= lcol) ? v : 0.f;
                        v = (s == lcol) ? v + Dh : v;
                        wv[j] = v;
                    }
                    s16x8 afr;
                    { v4u o; o.x = pk2(wv[0], wv[1]); o.y = pk2(wv[2], wv[3]); o.z = pk2(wv[4], wv[5]); o.w = pk2(wv[6], wv[7]); afr = __builtin_bit_cast(s16x8, o); }
                    const s16x8 b0 = kk == 0 ? TRCAT(xv[0], xv[1]) : TRCAT(xv[4], xv[5]);
                    const s16x8 b1 = kk == 0 ? TRCAT(xv[2], xv[3]) : TRCAT(xv[6], xv[7]);
                    y0 = __builtin_amdgcn_mfma_f32_32x32x16_bf16(afr, b0, y0, 0, 0, 0);
                    y1 = __builtin_amdgcn_mfma_f32_32x32x16_bf16(afr, b1, y1, 0, 0, 0);
                    __builtin_amdgcn_sched_barrier(0);
                }
            }
#pragma unroll
            for (int i = 0; i < 8; ++i) { ypk[h3][i] = pk2(y0[2 * i], y0[2 * i + 1]); ypk[h3][8 + i] = pk2(y1[2 * i], y1[2 * i + 1]); }
            __builtin_amdgcn_sched_barrier(0);
        }
        __syncthreads();
        {
            LAS unsigned short* yst = (LAS unsigned short*)(ldsb + SSD_L_X);
#pragma unroll
            for (int h3 = 0; h3 < 3; ++h3)
#pragma unroll
                for (int ptile = 0; ptile < 2; ++ptile)
#pragma unroll
                    for (int i = 0; i < 8; ++i) {
                        const int reg = 2 * i;
                        const int l0 = 32 * lt + (reg & 3) + 8 * (reg >> 2) + 4 * h;
                        const int col = (3 * hs + h3) * 64 + 32 * ptile + r;
                        const unsigned v = ypk[h3][8 * ptile + i];
                        yst[l0 * (SSD_RS_Y / 2) + col] = (unsigned short)(v & 0xffffu);
                        yst[(l0 + 1) * (SSD_RS_Y / 2) + col] = (unsigned short)(v >> 16);
                    }
        }
        __syncthreads();
#pragma unroll
        for (int pass = 0; pass < 4; ++pass) {
            const int l = 4 * (pass * 8 + w) + (lane >> 4), i16 = lane & 15;
            float gv[3][8]; float ss = 0.f;
#pragma unroll
            for (int k = 0; k < 3; ++k) {
                const int col0 = 24 * i16 + 8 * k;
                float yv[8], zv[8];
                unpack8(*(const LAS v4u*)(ldsb + SSD_L_X + l * SSD_RS_Y + col0 * 2), yv);
                unpack8(*(const v4u*)(projb + (size_t)(t0 + l) * NB_LD + g * 384 + col0), zv);
#pragma unroll
                for (int j = 0; j < 8; ++j) { const float gg = yv[j] * silu_f(zv[j]); gv[k][j] = gg; ss += gg * gg; }
            }
            ss += __shfl_xor(ss, 1); ss += __shfl_xor(ss, 2); ss += __shfl_xor(ss, 4); ss += __shfl_xor(ss, 8);
            const float rstd = rsqrtf(ss * (1.0f / 384.0f) + LN_EPS);
#pragma unroll
            for (int k = 0; k < 3; ++k) {
                const int col0 = g * 384 + 24 * i16 + 8 * k;
                const float4 g0 = *(const float4*)(norm_g + col0), g1 = *(const float4*)(norm_g + col0 + 4);
                v4u o; o.x = pk2(gv[k][0] * rstd * g0.x, gv[k][1] * rstd * g0.y); o.y = pk2(gv[k][2] * rstd * g0.z, gv[k][3] * rstd * g0.w);
                o.z = pk2(gv[k][4] * rstd * g1.x, gv[k][5] * rstd * g1.y); o.w = pk2(gv[k][6] * rstd * g1.z, gv[k][7] * rstd * g1.w);
                *(v4u*)(A1 + (size_t)(t0 + l) * MIX_WIDTH + col0) = o;
            }
        }
    }
}

#define ATT_RS_V 144
#define ATT_VIMG (256 * ATT_RS_V)
#define ATT_HIMG (2 * ATT_VIMG)
#define ATT_PVT(KT) { \
        s16x4 vv_[8]; \
        tr_read8<(32 * KT) * ATT_RS_V, (32 * KT + 8) * ATT_RS_V, (32 * KT) * ATT_RS_V + 64, (32 * KT + 8) * ATT_RS_V + 64, \
                 (32 * KT + 16) * ATT_RS_V, (32 * KT + 24) * ATT_RS_V, (32 * KT + 16) * ATT_RS_V + 64, (32 * KT + 24) * ATT_RS_V + 64>(vbase, vv_); \
        _Pragma("unroll") for (int s2_ = 0; s2_ < 2; ++s2_) { \
            v4u o_; o_.x = pk2(s[KT][8 * s2_ + 0], s[KT][8 * s2_ + 1]); o_.y = pk2(s[KT][8 * s2_ + 2], s[KT][8 * s2_ + 3]); \
            o_.z = pk2(s[KT][8 * s2_ + 4], s[KT][8 * s2_ + 5]); o_.w = pk2(s[KT][8 * s2_ + 6], s[KT][8 * s2_ + 7]); \
            const s16x8 pf_ = __builtin_bit_cast(s16x8, o_); \
            const s16x8 a0_ = s2_ == 0 ? TRCAT(vv_[0], vv_[1]) : TRCAT(vv_[4], vv_[5]); \
            const s16x8 a1_ = s2_ == 0 ? TRCAT(vv_[2], vv_[3]) : TRCAT(vv_[6], vv_[7]); \
            o0 = __builtin_amdgcn_mfma_f32_32x32x16_bf16(a0_, pf_, o0, 0, 0, 0); \
            o1 = __builtin_amdgcn_mfma_f32_32x32x16_bf16(a1_, pf_, o1, 0, 0, 0); } }
__device__ __forceinline__ void ph_attn_prompt(LAS unsigned char* ldsb, const bf16* __restrict__ qrot_b, const bf16* __restrict__ krot_b, const bf16* __restrict__ projb,
                                               bf16* __restrict__ obuf, float* __restrict__ lsebuf, const float* __restrict__ ck, const float* __restrict__ cv, float* __restrict__ out) {
    const int tid = threadIdx.x, w = __builtin_amdgcn_readfirstlane(tid >> 6), lane = tid & 63;
    const int r = lane & 31, h = lane >> 5, blk = (lane >> 4) & 1, q = (lane & 15) >> 2, pp = lane & 3;
    const int qt = w & 3, hsel = w >> 2;
    f32x4n rider[16]; bool pend = false; unsigned pq = 0u;
    for (int unit = blockIdx.x; unit < 3 * 512; unit += gridDim.x) {
        const int pat = unit >> 9, rem = unit & 511, hp = rem & 3, rem2 = rem >> 2, b = rem2 >> 6, bk = rem2 & 63;
        const int dsh = 2 * pat, nper = 64 >> dsh, res = bk >> (6 - dsh), nb = bk & (nper - 1);
        const int head = 2 * hp + hsel;
        __syncthreads();
        { v4u vst[8], kst[8];
#pragma unroll
          for (int it_ = 0; it_ < 8; ++it_) { const int idx = (tid & 255) + it_ * 256;
              const int row = idx >> 3, ch = idx & 7, js = 128 * nb - 128 + row, jc = js < 0 ? 0 : js;
              const size_t tk = (size_t)(b * SEQ + (jc << dsh) + res);
              vst[it_] = *(const v4u*)(projb + tk * NB_LD + NB_V + head * 64 + ch * 8);
              kst[it_] = *(const v4u*)(krot_b + tk * ATT_WIDTH + head * 64 + ch * 8); }
#pragma unroll
          for (int it_ = 0; it_ < 8; ++it_) { const int idx = (tid & 255) + it_ * 256;
              const int row = idx >> 3, ch = idx & 7, js = 128 * nb - 128 + row;
              v4u v = vst[it_], k = kst[it_]; if (js < 0) { v.x = 0u; v.y = 0u; v.z = 0u; v.w = 0u; k = v; }
              *(LAS v4u*)(ldsb + hsel * ATT_HIMG + row * ATT_RS_V + ch * 16) = v;
              *(LAS v4u*)(ldsb + hsel * ATT_HIMG + ATT_VIMG + row * ATT_RS_V + ch * 16) = k; } }
        const int tq = b * SEQ + ((128 * nb + 32 * qt + r) << dsh) + res;
        s16x8 qf[4];
#pragma unroll
        for (int ks = 0; ks < 4; ++ks) qf[ks] = *(const s16x8*)(qrot_b + (size_t)tq * ATT_WIDTH + head * 64 + 16 * ks + 8 * h);
        __syncthreads();
        f32x16 s[5];
#pragma unroll
        for (int kt = 0; kt < 5; ++kt) {
            const LAS unsigned char* kp = ldsb + hsel * ATT_HIMG + ATT_VIMG + (32 * qt + 32 * kt + r) * ATT_RS_V + 16 * h;
#pragma unroll
            for (int i = 0; i < 16; ++i) s[kt][i] = 0.f;
#pragma unroll
            for (int ks = 0; ks < 4; ++ks) s[kt] = __builtin_amdgcn_mfma_f32_32x32x16_bf16(*(const LAS s16x8*)(kp + 32 * ks), qf[ks], s[kt], 0, 0, 0);
        }
        if (pend) copy_q_store(out, pq, (unsigned)lane, rider);
        float m = -INFINITY;
#pragma unroll
        for (int kt = 0; kt < 5; ++kt) {
            const bool tile_ok = (nb > 0) || (qt + kt >= 4);
#pragma unroll
            for (int reg = 0; reg < 16; ++reg) {
                const int c = (reg & 3) + 8 * (reg >> 2) + 4 * h;
                const bool ok = tile_ok && (kt == 0 ? (c >= r) : (kt == 4 ? (c <= r) : true));
                const float v = ok ? s[kt][reg] * 0.125f : -INFINITY;
                s[kt][reg] = v; m = fmaxf(m, v);
            }
        }
        m = fmaxf(m, __shfl_xor(m, 32));
        float l = 0.f;
#pragma unroll
        for (int kt = 0; kt < 5; ++kt)
#pragma unroll
            for (int reg = 0; reg < 16; ++reg) { const float p = __expf(s[kt][reg] - m); s[kt][reg] = p; l += p; }
        l += __shfl_xor(l, 32);
        pq = (unsigned)(unit * NWAVE + w); copy_q_load(ck, cv, pq, (unsigned)lane, rider); pend = true;
        f32x16 o0, o1;
#pragma unroll
        for (int i = 0; i < 16; ++i) { o0[i] = 0.f; o1[i] = 0.f; }
        const unsigned vbase = lds_addr(ldsb + hsel * ATT_HIMG) + (32 * qt + 4 * h + q) * ATT_RS_V + (16 * blk + 4 * pp) * 2;
        ATT_PVT(0) ATT_PVT(1) ATT_PVT(2) ATT_PVT(3) ATT_PVT(4)
        const float inv = 1.0f / l;
        bf16* op = obuf + ((size_t)pat * T_PROMPT + tq) * ATT_WIDTH + head * 64 + 8 * h;
#pragma unroll
        for (int k2 = 0; k2 < 4; ++k2) {
            unsigned ax, ay, bx, by;
            if (k2 < 2) { ax = pk2(o0[8 * k2] * inv, o0[8 * k2 + 1] * inv); ay = pk2(o0[8 * k2 + 2] * inv, o0[8 * k2 + 3] * inv);
                          bx = pk2(o0[8 * k2 + 4] * inv, o0[8 * k2 + 5] * inv); by = pk2(o0[8 * k2 + 6] * inv, o0[8 * k2 + 7] * inv); }
            else { const int k3 = k2 - 2;
                   ax = pk2(o1[8 * k3] * inv, o1[8 * k3 + 1] * inv); ay = pk2(o1[8 * k3 + 2] * inv, o1[8 * k3 + 3] * inv);
                   bx = pk2(o1[8 * k3 + 4] * inv, o1[8 * k3 + 5] * inv); by = pk2(o1[8 * k3 + 6] * inv, o1[8 * k3 + 7] * inv); }
            const auto rx = __builtin_amdgcn_permlane32_swap(ax, bx, false, false);
            const auto ry = __builtin_amdgcn_permlane32_swap(ay, by, false, false);
            v4u o; o.x = rx[0]; o.y = ry[0]; o.z = rx[1]; o.w = ry[1];
            *(v4u*)(op + 16 * k2) = o;
        }
        if (h == 0) lsebuf[((size_t)pat * T_PROMPT + tq) * 8 + head] = m + __logf(l);
    }
    if (pend) copy_q_store(out, pq, (unsigned)lane, rider);
}
__device__ __forceinline__ void ph_attn_combine(const bf16* __restrict__ obuf, const float* __restrict__ lsebuf, bf16* __restrict__ A1) {
    const int lane = threadIdx.x & 63;
#pragma unroll 4
    for (int t = blockIdx.x * NWAVE + (threadIdx.x >> 6); t < T_PROMPT; t += gridDim.x * NWAVE) {
        const int hd = lane >> 3;
        const float l0 = lsebuf[((size_t)0 * T_PROMPT + t) * 8 + hd], l1 = lsebuf[((size_t)1 * T_PROMPT + t) * 8 + hd], l2 = lsebuf[((size_t)2 * T_PROMPT + t) * 8 + hd];
        const float mx = fmaxf(l0, fmaxf(l1, l2));
        const float e0 = __expf(l0 - mx), e1 = __expf(l1 - mx), e2 = __expf(l2 - mx);
        const float inv = 1.0f / (e0 + e1 + e2);
        float a[8], b[8], c[8];
        unpack8(*(const v4u*)(obuf + ((size_t)0 * T_PROMPT + t) * ATT_WIDTH + lane * 8), a);
        unpack8(*(const v4u*)(obuf + ((size_t)1 * T_PROMPT + t) * ATT_WIDTH + lane * 8), b);
        unpack8(*(const v4u*)(obuf + ((size_t)2 * T_PROMPT + t) * ATT_WIDTH + lane * 8), c);
        float o[8];
#pragma unroll
        for (int j = 0; j < 8; ++j) o[j] = (e0 * a[j] + e1 * b[j] + e2 * c[j]) * inv;
        v4u w; w.x = pk2(o[0], o[1]); w.y = pk2(o[2], o[3]); w.z = pk2(o[4], o[5]); w.w = pk2(o[6], o[7]);
        *(v4u*)(A1 + (size_t)t * MIX_WIDTH + SSD_WIDTH + lane * 8) = w;
    }
}

#define RT_RS 272
#define RT_KIMG (128 * RT_RS)
#define RT_LUT (2 * RT_KIMG)
constexpr unsigned char RT_CANDS[64] = {0, 1, 2, 3, 4, 5, 6, 7, 8, 9, 10, 11, 12, 13, 14, 15, 16, 17, 18, 19, 20, 21, 22, 23, 32, 33, 34, 35, 36, 48, 49, 50, 51, 64, 65, 66, 80, 81, 96, 97,
                                        112, 113, 128, 144, 160, 176, 192, 208, 224, 240, 0, 0, 0, 0, 0, 0, 0, 0, 0, 0, 0, 0, 0, 0};
__device__ __forceinline__ unsigned rt_mono(float f) { const unsigned u = __builtin_bit_cast(unsigned, f); return u ^ ((unsigned)((int)u >> 31) | 0x80000000u); }
__device__ __forceinline__ float rt_unmono(unsigned m) { const unsigned u = (m & 0x80000000u) ? (m ^ 0x80000000u) : ~m; return __builtin_bit_cast(float, u); }
#define RT_CE_DESC(a, b) { const unsigned x_ = (a), y_ = (b); (a) = x_ > y_ ? x_ : y_; (b) = x_ > y_ ? y_ : x_; }
#define RT_CE_ASC(a, b) { const unsigned x_ = (a), y_ = (b); (a) = x_ > y_ ? y_ : x_; (b) = x_ > y_ ? x_ : y_; }
__device__ __forceinline__ void rt_sort16(unsigned (&v)[16]) {
#pragma unroll
    for (int k = 2; k <= 16; k <<= 1)
#pragma unroll
        for (int j = k >> 1; j > 0; j >>= 1)
#pragma unroll
            for (int i = 0; i < 16; ++i) { const int l = i ^ j; if (l > i) { if ((i & k) == 0) RT_CE_DESC(v[i], v[l]) else RT_CE_ASC(v[i], v[l]) } }
}
__device__ __forceinline__ void rt_merge16(unsigned (&v)[16]) {
#pragma unroll
    for (int j = 8; j > 0; j >>= 1)
#pragma unroll
        for (int i = 0; i < 16; ++i) { const int l = i ^ j; if (l > i) RT_CE_DESC(v[i], v[l]) }
}
__device__ __forceinline__ void rt_top16(unsigned (&a)[16], const unsigned (&b)[16]) {
#pragma unroll
    for (int i = 0; i < 16; ++i) a[i] = a[i] > b[15 - i] ? a[i] : b[15 - i];
    rt_merge16(a);
}
__device__ __forceinline__ void rt_top16_partner(unsigned (&a)[16]) {
    unsigned b[16];
#pragma unroll
    for (int i = 0; i < 16; ++i) b[i] = (unsigned)__shfl_xor((int)a[i], 32);
    rt_top16(a, b);
}
__device__ __forceinline__ void rt_scores_top16(LAS unsigned char* kimg, const bf16* __restrict__ qp, int r, int h, unsigned (&k0)[16]) {
    f32x16 acc[4];
#pragma unroll
    for (int kt = 0; kt < 4; ++kt)
#pragma unroll
        for (int i = 0; i < 16; ++i) acc[kt][i] = 0.f;
#pragma unroll
    for (int ks = 0; ks < 8; ++ks) {
        const s16x8 qf = *(const s16x8*)(qp + 16 * ks);
#pragma unroll
        for (int kt = 0; kt < 4; ++kt) {
            const s16x8 kf = *(const LAS s16x8*)(kimg + (32 * kt + r) * RT_RS + (16 * ks + 8 * h) * 2);
            acc[kt] = __builtin_amdgcn_mfma_f32_32x32x16_bf16(kf, qf, acc[kt], 0, 0, 0);
        }
    }
    unsigned k1[16], k2[16], k3[16];
#pragma unroll
    for (int reg = 0; reg < 16; ++reg) {
        const unsigned ki = (unsigned)((reg & 3) + 8 * (reg >> 2) + 4 * h);
        k0[reg] = (rt_mono(acc[0][reg]) & 0xFFFFFF80u) | ki;
        k1[reg] = (rt_mono(acc[1][reg]) & 0xFFFFFF80u) | (ki + 32u);
        k2[reg] = (rt_mono(acc[2][reg]) & 0xFFFFFF80u) | (ki + 64u);
        k3[reg] = (rt_mono(acc[3][reg]) & 0xFFFFFF80u) | (ki + 96u);
    }
    rt_sort16(k0); rt_sort16(k1); rt_sort16(k2); rt_sort16(k3);
    rt_top16(k0, k1); rt_top16(k2, k3); rt_top16(k0, k2);
    rt_top16_partner(k0);
}
__device__ __forceinline__ void ph_peer_route2(LAS unsigned char* ldsb, const bf16* __restrict__ qhb, const float* __restrict__ keys1, const float* __restrict__ keys2,
                                               int* __restrict__ eidx, float* __restrict__ gate, const float* __restrict__ ck, const float* __restrict__ cv, float* __restrict__ out) {
    const int tid = threadIdx.x, w = __builtin_amdgcn_readfirstlane(tid >> 6), lane = tid & 63, r = lane & 31, h = lane >> 5;
    __syncthreads();
    for (int idx = tid; idx < 2 * 128 * 16; idx += NTHR) {
        const int tb = idx >> 11, rem = idx & 2047, row = rem >> 4, ch = rem & 15;
        const float* sp = (tb ? keys2 : keys1) + row * 128 + ch * 8;
        const float4 a = *(const float4*)sp, b = *(const float4*)(sp + 4);
        v4u o; o.x = pk2(a.x, a.y); o.y = pk2(a.z, a.w); o.z = pk2(b.x, b.y); o.w = pk2(b.z, b.w);
        *(LAS v4u*)(ldsb + tb * RT_KIMG + row * RT_RS + ch * 16) = o;
    }
    __syncthreads();
    LAS unsigned* lut = (LAS unsigned*)(ldsb + RT_LUT) + w * 512;
    for (int k = 0;; ++k) {
        int unit;
        if (gridDim.x != 256) { unit = blockIdx.x * NWAVE + w + k * (int)(gridDim.x * NWAVE); if (unit >= (T_ALL / 32) * 8) break; }
        else if (k < 2) unit = k * 2048 + blockIdx.x * NWAVE + w;
        else if (k == 2 && w == 0 && blockIdx.x < 128) unit = 4096 + (int)blockIdx.x;
        else break;
        const int tt = unit >> 3, hd = unit & 7;
        const int tok = 32 * tt + r;
        const bf16* qp = qhb + (size_t)tok * 2048 + hd * 256 + 8 * h;
        unsigned ka[16], kb[16];
        rt_scores_top16(ldsb, qp, r, h, ka);
        rt_scores_top16(ldsb + RT_KIMG, qp + 128, r, h, kb);
        float v1[16], v2[16];
#pragma unroll
        for (int i = 0; i < 16; ++i) { v1[i] = rt_unmono(ka[i] & 0xFFFFFF80u); v2[i] = rt_unmono(kb[i] & 0xFFFFFF80u); }
#pragma unroll
        for (int wd = 0; wd < 4; ++wd) {
            lut[wd * 64 + lane] = (ka[4 * wd] & 0x7Fu) | ((ka[4 * wd + 1] & 0x7Fu) << 8) | ((ka[4 * wd + 2] & 0x7Fu) << 16) | ((ka[4 * wd + 3] & 0x7Fu) << 24);
            lut[(4 + wd) * 64 + lane] = (kb[4 * wd] & 0x7Fu) | ((kb[4 * wd + 1] & 0x7Fu) << 8) | ((kb[4 * wd + 2] & 0x7Fu) << 16) | ((kb[4 * wd + 3] & 0x7Fu) << 24);
        }
        unsigned c0[16], c1[16];
        c0[0] = (rt_mono(h ? (v1[0] + v2[1]) : (v1[0] + v2[0])) & 0xFFFFFF00u) | (h ? 1u : 0u);
        c0[1] = (rt_mono(h ? (v1[0] + v2[3]) : (v1[0] + v2[2])) & 0xFFFFFF00u) | (h ? 3u : 2u);
        c0[2] = (rt_mono(h ? (v1[0] + v2[5]) : (v1[0] + v2[4])) & 0xFFFFFF00u) | (h ? 5u : 4u);
        c0[3] = (rt_mono(h ? (v1[0] + v2[7]) : (v1[0] + v2[6])) & 0xFFFFFF00u) | (h ? 7u : 6u);
        c0[4] = (rt_mono(h ? (v1[0] + v2[9]) : (v1[0] + v2[8])) & 0xFFFFFF00u) | (h ? 9u : 8u);
        c0[5] = (rt_mono(h ? (v1[0] + v2[11]) : (v1[0] + v2[10])) & 0xFFFFFF00u) | (h ? 11u : 10u);
        c0[6] = (rt_mono(h ? (v1[0] + v2[13]) : (v1[0] + v2[12])) & 0xFFFFFF00u) | (h ? 13u : 12u);
        c0[7] = (rt_mono(h ? (v1[0] + v2[15]) : (v1[0] + v2[14])) & 0xFFFFFF00u) | (h ? 15u : 14u);
        c0[8] = (rt_mono(h ? (v1[1] + v2[1]) : (v1[1] + v2[0])) & 0xFFFFFF00u) | (h ? 17u : 16u);
        c0[9] = (rt_mono(h ? (v1[1] + v2[3]) : (v1[1] + v2[2])) & 0xFFFFFF00u) | (h ? 19u : 18u);
        c0[10] = (rt_mono(h ? (v1[1] + v2[5]) : (v1[1] + v2[4])) & 0xFFFFFF00u) | (h ? 21u : 20u);
        c0[11] = (rt_mono(h ? (v1[1] + v2[7]) : (v1[1] + v2[6])) & 0xFFFFFF00u) | (h ? 23u : 22u);
        c0[12] = (rt_mono(h ? (v1[2] + v2[1]) : (v1[2] + v2[0])) & 0xFFFFFF00u) | (h ? 33u : 32u);
        c0[13] = (rt_mono(h ? (v1[2] + v2[3]) : (v1[2] + v2[2])) & 0xFFFFFF00u) | (h ? 35u : 34u);
        c0[14] = (rt_mono(h ? (v1[3] + v2[0]) : (v1[2] + v2[4])) & 0xFFFFFF00u) | (h ? 48u : 36u);
        c0[15] = (rt_mono(h ? (v1[3] + v2[2]) : (v1[3] + v2[1])) & 0xFFFFFF00u) | (h ? 50u : 49u);
        c1[0] = (rt_mono(h ? (v1[4] + v2[0]) : (v1[3] + v2[3])) & 0xFFFFFF00u) | (h ? 64u : 51u);
        c1[1] = (rt_mono(h ? (v1[4] + v2[2]) : (v1[4] + v2[1])) & 0xFFFFFF00u) | (h ? 66u : 65u);
        c1[2] = (rt_mono(h ? (v1[5] + v2[1]) : (v1[5] + v2[0])) & 0xFFFFFF00u) | (h ? 81u : 80u);
        c1[3] = (rt_mono(h ? (v1[6] + v2[1]) : (v1[6] + v2[0])) & 0xFFFFFF00u) | (h ? 97u : 96u);
        c1[4] = (rt_mono(h ? (v1[7] + v2[1]) : (v1[7] + v2[0])) & 0xFFFFFF00u) | (h ? 113u : 112u);
        c1[5] = (rt_mono(h ? (v1[9] + v2[0]) : (v1[8] + v2[0])) & 0xFFFFFF00u) | (h ? 144u : 128u);
        c1[6] = (rt_mono(h ? (v1[11] + v2[0]) : (v1[10] + v2[0])) & 0xFFFFFF00u) | (h ? 176u : 160u);
        c1[7] = (rt_mono(h ? (v1[13] + v2[0]) : (v1[12] + v2[0])) & 0xFFFFFF00u) | (h ? 208u : 192u);
        c1[8] = (rt_mono(h ? (v1[15] + v2[0]) : (v1[14] + v2[0])) & 0xFFFFFF00u) | (h ? 240u : 224u);
        c1[9] = 0u;
        c1[10] = 0u;
        c1[11] = 0u;
        c1[12] = 0u;
        c1[13] = 0u;
        c1[14] = 0u;
        c1[15] = 0u;
        rt_sort16(c0); rt_sort16(c1); rt_top16(c0, c1); rt_top16_partner(c0);
        float e[16]; float sum = 0.f;
        const float mx = rt_unmono(c0[0] & 0xFFFFFF00u);
#pragma unroll
        for (int k = 0; k < 16; ++k) { e[k] = __expf(rt_unmono(c0[k] & 0xFFFFFF00u) - mx); sum += e[k]; }
        const float inv = 1.0f / sum;
        asm volatile("s_waitcnt lgkmcnt(0)" ::: "memory");
        int ex[8]; float gv[8];
#pragma unroll
        for (int k = 0; k < 8; ++k) {
            const unsigned hm = (unsigned)(-h);
            const unsigned ck = (c0[k] & ~hm) | (c0[8 + k] & hm);
            const float ek = __builtin_bit_cast(float, (__builtin_bit_cast(unsigned, e[k]) & ~hm) | (__builtin_bit_cast(unsigned, e[8 + k]) & hm));
            const unsigned ci = (ck >> 4) & 15u, cj = ck & 15u;
            const unsigned w1 = lut[(ci >> 2) * 64 + lane], w2 = lut[(4 + (cj >> 2)) * 64 + lane];
            const unsigned i1 = (w1 >> (8 * (ci & 3))) & 0x7Fu, i2 = (w2 >> (8 * (cj & 3))) & 0x7Fu;
            ex[k] = (int)(i1 * PEER_NKEYS + i2); gv[k] = ek * inv;
        }
        int* ep = eidx + (size_t)tok * 128 + hd * 16 + 8 * h; float* gp = gate + (size_t)tok * 128 + hd * 16 + 8 * h;
        *(int4*)ep = make_int4(ex[0], ex[1], ex[2], ex[3]); *(int4*)(ep + 4) = make_int4(ex[4], ex[5], ex[6], ex[7]);
        *(float4*)gp = make_float4(gv[0], gv[1], gv[2], gv[3]); *(float4*)(gp + 4) = make_float4(gv[4], gv[5], gv[6], gv[7]);
    }
    if (gridDim.x == 256 && (w != 0 || blockIdx.x >= 128)) {
        const unsigned si = blockIdx.x < 128 ? blockIdx.x * 7u + (unsigned)(w - 1) : 896u + (blockIdx.x - 128u) * 8u + (unsigned)w;
        cache_copy_slice(ck, cv, out, 7040u + si, (unsigned)lane);
    }
}

struct Params {
    const float* in[23];
    float* out;
    unsigned char* ws;
    unsigned* bar;
};

#define WS_BAR      0ull
#define WS_XALL     (1ull << 20)
#define WS_PROJ     (WS_XALL + (size_t)T_ALL * D_MODEL * 4)
#define WS_XBC      (WS_PROJ + (size_t)T_ALL * PROJ_LD * 4)
#define WS_DT       (WS_XBC + (size_t)T_ALL * CONV_DIM * 4)
#define WS_QROT     (WS_DT + (size_t)T_ALL * SSD_HEADS * 4)
#define WS_KROT     (WS_QROT + (size_t)T_ALL * ATT_WIDTH * 4)
#define WS_YBUF     (WS_KROT + (size_t)T_ALL * ATT_WIDTH * 4)
#define WS_MIX      (WS_YBUF + (size_t)T_ALL * MIX_WIDTH * 4)
#define WS_HBUF     (WS_MIX + (size_t)T_ALL * D_MODEL * 4)
#define WS_QH       (WS_HBUF + (size_t)T_ALL * D_MODEL * 4)
#define WS_EIDX     (WS_QH + (size_t)T_ALL * 2048 * 4)
#define WS_GATE     (WS_EIDX + (size_t)T_ALL * 128 * 4)
#define WS_A0       (WS_GATE + (size_t)T_ALL * 128 * 4)
#define WS_A1       (WS_A0 + (size_t)T_ALL * D_MODEL * 2)
#define WS_A2       (WS_A1 + (size_t)T_ALL * MIX_WIDTH * 2)
#define WS_WTIN     (WS_A2 + (size_t)T_ALL * D_MODEL * 2)
#define WS_WTOUT    (WS_WTIN + (size_t)PROJ_LD * D_MODEL * 2)
#define WS_WTQ      (WS_WTOUT + (size_t)D_MODEL * MIX_WIDTH * 2)
#define WS_PROJB    (WS_WTQ + (size_t)2048 * D_MODEL * 2)
#define WS_DTRAW    (WS_PROJB + (size_t)T_ALL * NB_LD * 2)
#define WS_XBCB     (WS_DTRAW + (size_t)T_ALL * 32 * 4)
#define WS_QROTB    (WS_XBCB + (size_t)T_ALL * CONV_DIM * 2)
#define WS_KROTB    (WS_QROTB + (size_t)T_ALL * ATT_WIDTH * 2)
#define WS_UB       (WS_KROTB + (size_t)T_ALL * ATT_WIDTH * 2)
#define WS_VB       (WS_UB + (size_t)16384 * D_MODEL * 2)
#define WS_USC      (WS_VB + (size_t)16384 * D_MODEL * 2)
#define WS_VSC      (WS_USC + 16384 * 4)
#define WS_SBUF     (WS_VSC + 16384 * 4)
#define WS_HIN      (WS_SBUF + (size_t)BATCH * 64 * SSD_HEADS * 64 * 128 * 2)
#define WS_CDEC     (WS_HIN + (size_t)BATCH * 64 * SSD_HEADS * 64 * 128 * 2)
#define WS_OBUF     (WS_CDEC + (size_t)BATCH * 64 * SSD_HEADS * 4)
#define WS_LSE      (WS_OBUF + (size_t)3 * T_PROMPT * ATT_WIDTH * 2)
#define WS_ROPE     (WS_LSE + (size_t)3 * T_PROMPT * 8 * 4)
#define WS_END      (WS_ROPE + (size_t)SEQ * 64 * 4)

#define LDS_BYTES (160 * 1024)

#define KP const __attribute__((address_space(4))) Params* kp = (const __attribute__((address_space(4))) Params*)__builtin_amdgcn_kernarg_segment_ptr(); asm volatile("" : "+s"(kp)); unsigned char* ws = kp->ws; (void)ws;
#define IN(i) (kp->in[i])
#define WSP(T, off) ((T*)(ws + (off)))
__global__ void __launch_bounds__(512, 2) mega_fwd(Params p) {
    extern __shared__ __attribute__((aligned(16))) unsigned char smem[];
    if (threadIdx.x == 0) *(uint4*)smem = make_uint4(0u, 0u, 0u, 0u);
    __syncthreads();
    XcdBarrier bar = xcd_barrier_post(p.bar, (volatile LAS unsigned*)smem);
    float* lds = (float*)(smem + 256);
    LAS unsigned char* ldsb = (LAS unsigned char*)smem + 256;

    { KP ph_prologue(ldsb, IN(0), IN(1), WSP(bf16, WS_A0), IN(6), WSP(bf16, WS_WTIN), WSP(float, WS_ROPE)); }
    xcd_barrier(bar);
    { KP pg8::Gemm g{WSP(bf16, WS_A0), WSP(bf16, WS_WTIN), T_ALL, PROJ_LD, D_MODEL}; pg8::StaticOrder S; S.init(g.M, g.N, (int)gridDim.x, (int)blockIdx.x);
      pg8::EpiProj E{WSP(bf16, WS_PROJB), WSP(float, WS_DTRAW)}; pg8::gemm_phase<pg8::EpiProj, pg8::StaticOrder, false>(ldsb, g, S, E, nullptr); }
    xcd_barrier(bar);
    { KP ph_post_proj_prompt(WSP(bf16, WS_PROJB), WSP(float, WS_DTRAW), IN(7), IN(8), IN(9), WSP(float, WS_ROPE), WSP(bf16, WS_XBCB), WSP(float, WS_DT), WSP(bf16, WS_QROTB), WSP(bf16, WS_KROTB), kp->out); }
    { KP ph_post_proj2(WSP(bf16, WS_PROJB), WSP(float, WS_DTRAW), IN(4), IN(7), IN(8), IN(9), WSP(bf16, WS_XBCB), WSP(float, WS_DT), WSP(bf16, WS_QROTB), WSP(bf16, WS_KROTB), kp->out); }
    xcd_barrier(bar);
    if (((blockIdx.x >> 3) & 1) != 0) {
        { KP ph_ssd_decode(WSP(bf16, WS_XBCB), WSP(float, WS_DT), IN(10), IN(11), IN(5), WSP(float, WS_YBUF), kp->out); }
        { KP ph_attn_sample3(lds, WSP(bf16, WS_QROTB), WSP(bf16, WS_KROTB), WSP(bf16, WS_PROJB), IN(2), IN(3), WSP(bf16, WS_A1)); }
        __syncthreads();
        { KP ph_ssd_states(ldsb, WSP(bf16, WS_XBCB), WSP(float, WS_DT), IN(10), WSP(bf16, WS_SBUF), WSP(float, WS_CDEC), IN(2), IN(3), kp->out); }
        __syncthreads();
        { KP ph_attn_prompt(ldsb, WSP(bf16, WS_QROTB), WSP(bf16, WS_KROTB), WSP(bf16, WS_PROJB), WSP(bf16, WS_OBUF), WSP(float, WS_LSE), IN(2), IN(3), kp->out); }
    } else {
        { KP ph_ssd_states(ldsb, WSP(bf16, WS_XBCB), WSP(float, WS_DT), IN(10), WSP(bf16, WS_SBUF), WSP(float, WS_CDEC), IN(2), IN(3), kp->out); }
        __syncthreads();
        { KP ph_attn_prompt(ldsb, WSP(bf16, WS_QROTB), WSP(bf16, WS_KROTB), WSP(bf16, WS_PROJB), WSP(bf16, WS_OBUF), WSP(float, WS_LSE), IN(2), IN(3), kp->out); }
        __syncthreads();
        { KP ph_ssd_decode(WSP(bf16, WS_XBCB), WSP(float, WS_DT), IN(10), IN(11), IN(5), WSP(float, WS_YBUF), kp->out); }
        { KP ph_attn_sample3(lds, WSP(bf16, WS_QROTB), WSP(bf16, WS_KROTB), WSP(bf16, WS_PROJB), IN(2), IN(3), WSP(bf16, WS_A1)); }
    }
    xcd_barrier(bar);
    if ((int)gridDim.x > 128) {
        if ((int)blockIdx.x < 96) { KP ph_ssd_scan(WSP(bf16, WS_SBUF), WSP(float, WS_CDEC), WSP(bf16, WS_HIN), kp->out, (int)blockIdx.x, 96); }
        else {
            { KP ph_prologue2(ldsb, IN(13), WSP(bf16, WS_WTOUT), IN(16), WSP(bf16, WS_WTQ), (int)blockIdx.x - 96, (int)gridDim.x - 96); }
            { KP ph_quant_tables(IN(19), IN(20), WSP(unsigned char, WS_UB), WSP(unsigned char, WS_VB), WSP(float, WS_USC), WSP(float, WS_VSC), (int)blockIdx.x - 96, (int)gridDim.x - 96); }
        }
    } else {
        { KP ph_ssd_scan(WSP(bf16, WS_SBUF), WSP(float, WS_CDEC), WSP(bf16, WS_HIN), kp->out, (int)blockIdx.x, (int)gridDim.x); }
        { KP ph_prologue2(ldsb, IN(13), WSP(bf16, WS_WTOUT), IN(16), WSP(bf16, WS_WTQ), (int)blockIdx.x, (int)gridDim.x); }
        { KP ph_quant_tables(IN(19), IN(20), WSP(unsigned char, WS_UB), WSP(unsigned char, WS_VB), WSP(float, WS_USC), WSP(float, WS_VSC), (int)blockIdx.x, (int)gridDim.x); }
    }
    xcd_barrier(bar);
    { KP ph_ssd_out(ldsb, WSP(bf16, WS_XBCB), WSP(bf16, WS_PROJB), WSP(float, WS_DT), IN(10), IN(11), IN(12), WSP(bf16, WS_HIN), WSP(bf16, WS_A1)); }
    { KP ph_attn_combine(WSP(bf16, WS_OBUF), WSP(float, WS_LSE), WSP(bf16, WS_A1)); }
    { KP ph_gate_norm(WSP(bf16, WS_PROJB), IN(12), WSP(float, WS_YBUF), WSP(bf16, WS_A1)); }
    xcd_barrier(bar);
    { KP pg8::Gemm g{WSP(bf16, WS_A1), WSP(bf16, WS_WTOUT), T_ALL, D_MODEL, MIX_WIDTH}; pg8::StaticOrder S; S.init(g.M, g.N, (int)gridDim.x, (int)blockIdx.x);
      pg8::EpiBf16Plain E{WSP(bf16, WS_MIX), D_MODEL}; pg8::gemm_phase<pg8::EpiBf16Plain, pg8::StaticOrder, false>(ldsb, g, S, E, nullptr); }
    if (blockIdx.x >= 8 && gridDim.x == 256) { KP cache_copy_slice(IN(2), IN(3), kp->out, 4096u + (blockIdx.x - 8) * 8u + (threadIdx.x >> 6), threadIdx.x & 63u); }
    xcd_barrier(bar);
    { KP ph_ln_res(IN(0), IN(1), WSP(bf16, WS_MIX), IN(14), IN(15), WSP(bf16, WS_A2)); }
    xcd_barrier(bar);
    { KP pg8::Gemm g{WSP(bf16, WS_A2), WSP(bf16, WS_WTQ), T_ALL, 2048, D_MODEL}; pg8::StaticOrder S; S.init(g.M, g.N, (int)gridDim.x, (int)blockIdx.x);
      pg8::EpiBf16Plain E{WSP(bf16, WS_QH), 2048}; pg8::gemm_phase<pg8::EpiBf16Plain, pg8::StaticOrder, false>(ldsb, g, S, E, nullptr); }
    if (blockIdx.x >= 16 && gridDim.x == 256 && threadIdx.x < 256) { KP cache_copy_slice(IN(2), IN(3), kp->out, 4096u + 1984u + (blockIdx.x - 16) * 4u + (threadIdx.x >> 6), threadIdx.x & 63u); }
    xcd_barrier(bar);
    { KP ph_peer_route2(ldsb, WSP(bf16, WS_QH), IN(17), IN(18), WSP(int, WS_EIDX), WSP(float, WS_GATE), IN(2), IN(3), kp->out); }
    xcd_barrier(bar);
    { KP ph_peer_ffn3(WSP(bf16, WS_A2), WSP(int, WS_EIDX), WSP(float, WS_GATE), WSP(unsigned char, WS_UB), WSP(unsigned char, WS_VB), WSP(float, WS_USC), WSP(float, WS_VSC), IN(21), IN(22), kp->out, IN(2), IN(3), gridDim.x == 256 ? 8960u : 4096u); }
}

extern "C" void kernel_launch(void* const* d_in, const int* in_sizes, int n_in, void* d_out, int out_size, void* d_ws, size_t ws_size, hipStream_t stream) {
    static int grid = 0;
    if (grid == 0) {
        int dev = 0, cus = 0, per_cu = 0;
        if (hipGetDevice(&dev) != hipSuccess || hipDeviceGetAttribute(&cus, hipDeviceAttributeMultiprocessorCount, dev) != hipSuccess) { fprintf(stderr, "kernel_launch: device query failed\n"); grid = -1; return; }
        if (hipFuncSetAttribute((const void*)mega_fwd, hipFuncAttributeMaxDynamicSharedMemorySize, LDS_BYTES) != hipSuccess) { fprintf(stderr, "kernel_launch: hipFuncSetAttribute failed\n"); grid = -1; return; }
        if (hipOccupancyMaxActiveBlocksPerMultiprocessor(&per_cu, (const void*)mega_fwd, NTHR, LDS_BYTES) != hipSuccess || per_cu < 1) { fprintf(stderr, "kernel_launch: occupancy query says %d\n", per_cu); }
        (void)hipGetLastError();
        grid = cus;
        if (ws_size < WS_END) { fprintf(stderr, "kernel_launch: workspace too small\n"); grid = -1; return; }
    }
    if (grid < 0) return;
    (void)hipMemsetAsync((char*)d_ws + WS_BAR, 0, XCD_BAR_WORDS * sizeof(unsigned), stream);
    Params p{};
    for (int i = 0; i < 23; ++i) p.in[i] = (const float*)d_in[i];
    p.out = (float*)d_out; p.ws = (unsigned char*)d_ws; p.bar = (unsigned*)((char*)d_ws + WS_BAR);
    hipLaunchKernelGGL(mega_fwd, dim3(grid), dim3(NTHR), LDS_BYTES, stream, p);
}
```

```cpp
#include <hip/hip_runtime.h>
#include <stdint.h>

#define D_MODEL 1024
#define BATCH 2
#define SEQ 8192
#define DEC_BATCH 128
#define DEC_SEQ 4
#define PAST_LEN 8192
#define HEAD_DIM 64
#define ATT_WIDTH 512
#define ATT_HEADS 8
#define SSD_WIDTH 1536
#define SSD_HEADS 24
#define SSD_GROUPS 4
#define SSD_STATE 128
#define CONV_DIM 2560
#define IN_WIDTH 5656
#define PROJ_LD 5888
#define MIX_WIDTH 2048
#define WBUF 2048
#define PEER_NKEYS 128
#define PEER_HEADS 8
#define PEER_TOPK 16
#define PEER_DKEY 256
#define T_PROMPT (BATCH * SEQ)
#define T_SAMPLE (DEC_BATCH * DEC_SEQ)
#define T_ALL (T_PROMPT + T_SAMPLE)
#define O_Z 0
#define O_XBC 1536
#define O_DT 4096
#define O_Q 4120
#define O_K 4632
#define O_V 5144
#define ALPHA_F 1.189207115002721f
#define LN_EPS 1e-5f

#define OUT_YP 0ull
#define OUT_YS (OUT_YP + 16777216ull)
#define OUT_PK (OUT_YS + 524288ull)
#define OUT_PV (OUT_PK + 2097152ull)
#define OUT_PC (OUT_PV + 2097152ull)
#define OUT_PS (OUT_PC + 15360ull)
#define OUT_SK (OUT_PS + 393216ull)
#define OUT_SV (OUT_SK + 134217728ull)
#define OUT_SC (OUT_SV + 134217728ull)
#define OUT_SS (OUT_SC + 983040ull)

__constant__ double ROPE_INV_REV[32] = {
    1.59154943091895346e-01, 1.19349370211248862e-01, 8.94994016088910133e-02, 6.71150830052272551e-02,
    5.03292121044870353e-02, 3.77415847174197711e-02, 2.83021958306233987e-02, 2.12236527647776604e-02,
    1.59154943091895339e-02, 1.19349370211248862e-02, 8.94994016088910237e-03, 6.71150830052272534e-03,
    5.03292121044870370e-03, 3.77415847174197719e-03, 2.83021958306233987e-03, 2.12236527647776622e-03,
    1.59154943091895356e-03, 1.19349370211248849e-03, 8.94994016088910237e-04, 6.71150830052272599e-04,
    5.03292121044870326e-04, 3.77415847174197741e-04, 2.83021958306233954e-04, 2.12236527647776605e-04,
    1.59154943091895351e-04, 1.19349370211248862e-04, 8.94994016088910182e-05, 6.71150830052272545e-05,
    5.03292121044870354e-05, 3.77415847174197768e-05, 2.83021958306233961e-05, 2.12236527647776592e-05
};

__device__ __forceinline__ float silu_f(float x) { return x * __builtin_amdgcn_rcpf(1.0f + __expf(-x)); }
__device__ __forceinline__ float softplus_f(float x) { return fmaxf(x, 0.f) + log1pf(__expf(-fabsf(x))); }
__device__ __forceinline__ float gelu_f(float x) { return 0.5f * x * (1.0f + erff(x * 0.70710678118654752f)); }
__device__ __forceinline__ float wave_sum(float v) {
#pragma unroll
    for (int o = 32; o > 0; o >>= 1) v += __shfl_xor(v, o);
    return v;
}
__device__ __forceinline__ float wave_max(float v) {
#pragma unroll
    for (int o = 32; o > 0; o >>= 1) v = fmaxf(v, __shfl_xor(v, o));
    return v;
}

#include <cstdio>
#define XB_TMO      128
#define XB_XCNT(j)  (256  + 64 * (j))
#define XB_XSUB(j)  (1280 + 64 * (j))
#define XB_XGEN(j)  (2304 + 64 * (j))
#define XB_TOP      3328
#define XB_TOPGEN   3392
#define XCD_BAR_WORDS 3456
#define XB_SPIN_CAP (1u << 18)
#define LAS __attribute__((address_space(3)))

__device__ __forceinline__ unsigned xb_ld(unsigned* p)              { return __hip_atomic_load(p, __ATOMIC_RELAXED, __HIP_MEMORY_SCOPE_AGENT); }
__device__ __forceinline__ unsigned xb_add(unsigned* p, unsigned v) { return __hip_atomic_fetch_add(p, v, __ATOMIC_RELAXED, __HIP_MEMORY_SCOPE_AGENT); }
__device__ __forceinline__ unsigned xb_xcc_id() { return (unsigned)__builtin_amdgcn_s_getreg((3 << 11) | 20) & 0xFu; }
#define XB_SPIN(cond, bar) do { unsigned _sp = 0; while (cond) { __builtin_amdgcn_s_sleep(1); \
    if ((++_sp & 255u) == 0u) { if (xb_ld(&(bar)[XB_TMO])) break; if (_sp > XB_SPIN_CAP) { atomicAdd(&(bar)[XB_TMO], 1u); break; } } } } while (0)

struct XcdBarrier {
    unsigned* bar; unsigned x;
    volatile LAS unsigned* st;
};

__device__ __forceinline__ XcdBarrier xcd_barrier_post(unsigned* bar, volatile LAS unsigned* st) {
    XcdBarrier b; b.bar = bar; b.x = xb_xcc_id(); b.st = st;
    if (threadIdx.x == 0) (void)xb_add(&bar[XB_XCNT(b.x)], 1u);
    return b;
}
__device__ __forceinline__ void xcd_barrier_complete(unsigned* bar, unsigned x, unsigned& nloc, unsigned& nx) {
    const unsigned G = gridDim.x * gridDim.y * gridDim.z;
    unsigned sum, cnt, mine, sp = 0u;
    for (;;) {
        sum = 0u; cnt = 0u; mine = 0u;
#pragma unroll
        for (unsigned j = 0; j < 16; ++j) { const unsigned c = xb_ld(&bar[XB_XCNT(j)]); sum += c; cnt += (c > 0u) ? 1u : 0u; mine = (j == x) ? c : mine; }
        if (sum == G) break;
        __builtin_amdgcn_s_sleep(1);
        if ((++sp & 255u) == 0u) { if (xb_ld(&bar[XB_TMO])) break; if (sp > XB_SPIN_CAP) { atomicAdd(&bar[XB_TMO], 1u); break; } }
    }
    nloc = mine > 0u ? mine : 1u; nx = cnt > 0u ? cnt : 1u;
}

__device__ __forceinline__ void xcd_barrier(const XcdBarrier& b) {
    asm volatile("s_waitcnt vmcnt(0)" ::: "memory");
    __syncthreads();
    if (threadIdx.x == 0) {
        unsigned* bar = b.bar;
        __builtin_amdgcn_s_waitcnt(0);
        unsigned nloc = b.st[0], nx = b.st[1];
        if (nloc == 0u) { xcd_barrier_complete(bar, b.x, nloc, nx); b.st[0] = nloc; b.st[1] = nx; }
        const unsigned old = xb_add(&bar[XB_XSUB(b.x)], 1u);
        const unsigned gen = old / nloc;
        if (old + 1u == (gen + 1u) * nloc) {
            __builtin_amdgcn_fence(__ATOMIC_RELEASE, "agent");
            asm volatile("s_waitcnt vmcnt(0)" ::: "memory");
            const unsigned og = xb_add(&bar[XB_TOP], 1u);
            const unsigned tg = og / nx;
            if (og + 1u == (tg + 1u) * nx) xb_add(&bar[XB_TOPGEN], 1u);
            else XB_SPIN(xb_ld(&bar[XB_TOPGEN]) == tg, bar);
            __builtin_amdgcn_fence(__ATOMIC_ACQUIRE, "agent");
            xb_add(&bar[XB_XGEN(b.x)], 1u);
            asm volatile("s_waitcnt vmcnt(0)" ::: "memory");
        } else {
            XB_SPIN(xb_ld(&bar[XB_XGEN(b.x)]) == gen, bar);
            __builtin_amdgcn_fence(__ATOMIC_ACQUIRE, "agent");
            asm volatile("s_waitcnt vmcnt(0)" ::: "memory");
        }
    }
    __syncthreads();
}


#define GAS __attribute__((address_space(1)))
typedef unsigned short bf16;
typedef unsigned v4u __attribute__((ext_vector_type(4)));
#define LDS_WAIT() asm volatile("s_waitcnt lgkmcnt(0)" ::: "memory")
__device__ __forceinline__ unsigned f2bf(float f) { unsigned u = __builtin_bit_cast(unsigned, f); return (u + 0x7fffu + ((u >> 16) & 1u)) >> 16; }
__device__ __forceinline__ unsigned pk2(float lo, float hi) { return f2bf(lo) | (f2bf(hi) << 16); }
__device__ __forceinline__ float bf2f(unsigned short b) { return __builtin_bit_cast(float, (unsigned)b << 16); }
#include <hip/hip_runtime.h>
namespace pg8 {
#define PG8_LAS __attribute__((address_space(3)))
typedef unsigned short bf16_t;
typedef short bf16x8 __attribute__((ext_vector_type(8)));
typedef float f32x4 __attribute__((ext_vector_type(4)));
typedef unsigned u32x4 __attribute__((ext_vector_type(4)));
constexpr int BM = 256, BK = 64, HALF = 128, HTB = HALF * BK * 2  , STAGE_BYTES = 8 * HTB, NXCD = 8, WGM = 8;

__host__ __device__ __forceinline__ int lds_byte(int r, int c) { const int st = (r >> 4) * 2 + (c >> 5), rr = r & 15, cc = c & 31, ob = rr * 64 + cc * 2; return st * 1024 + (ob ^ (((ob >> 9) & 1) << 5)); }
__host__ __device__ __forceinline__ void stage_rc(int b, int& R, int& C) { const int st = b / 1024, sb = b % 1024, swz = sb ^ (((sb >> 9) & 1) << 5); R = (st >> 1) * 16 + swz / 64; C = (st & 1) * 32 + (swz % 64) / 2; }
__host__ __device__ __forceinline__ int perm32(int rho) { const int n = rho >> 4, i = rho & 15; return 8 * (i >> 2) + 4 * n + (i & 3); }

struct Unit { int pm, pn; };
struct Gemm { const bf16_t* A; const bf16_t* Bt; int M, N, K; };

struct StaticOrder {
    int nM, nN, nwg, G, c;
    __host__ __device__ void init(int M, int N, int G_, int c_) { nM = M / BM; nN = N / BM; nwg = nM * nN; G = G_; c = c_; }
    __host__ __device__ bool next(int i, Unit& u) const {
        const long L = (long)i * G + c; if (L >= nwg) return false;
        int wgid = (int)L; { const int q = nwg / NXCD, r = nwg % NXCD, xcd = wgid % NXCD, off = wgid / NXCD; wgid = (xcd < r ? xcd * (q + 1) : r * (q + 1) + (xcd - r) * q) + off; }
        const int nig = WGM * nN, gid = wgid / nig, fm = gid * WGM, gsz = (nM - fm) < WGM ? (nM - fm) : WGM;
        u.pm = fm + ((wgid % nig) % gsz); u.pn = (wgid % nig) / gsz; return true;
    }
    __device__ __forceinline__ void a_ready(const Unit&) const {}
    __device__ __forceinline__ void done(const Unit&) const {}
};
__device__ __forceinline__ unsigned cvt_pk_bf16(float lo, float hi) { unsigned r; asm volatile("v_cvt_pk_bf16_f32 %0, %1, %2" : "=v"(r) : "v"(lo), "v"(hi)); return r; }
typedef float f32x2 __attribute__((ext_vector_type(2)));
__device__ __forceinline__ f32x2 gelu_pk(f32x2 v) {
    const f32x2 av = __builtin_elementwise_abs(v), d = av * 0.2316418882f + 1.0f;
    f32x2 t; t.x = __builtin_amdgcn_rcpf(d.x); t.y = __builtin_amdgcn_rcpf(d.y);
    f32x2 q = t * 0.5307027145f + (-0.7265760135f); q = q * t + 0.7107068705f; q = q * t + (-0.142248368f); q = q * t + 0.127414796f; q = q * t;
    const f32x2 s = (v * v) * (-0.72134752044f);
    f32x2 e; e.x = __builtin_amdgcn_exp2f(s.x); e.y = __builtin_amdgcn_exp2f(s.y);
    const f32x2 m = v * (q * e), r = v - m;
    f32x2 o; o.x = v.x < 0.f ? m.x : r.x; o.y = v.y < 0.f ? m.y : r.y; return o;
}

struct EpiF32 {
    static constexpr bool PERM = false, AFTER_DRAIN = false;
    float* C; int ldc; const float* bias;
    __device__ __forceinline__ void operator()(const f32x4 (&acc)[2][2][4][2], const Unit& u, int wr, int wc, int fr, int fq) const {
        const int row0 = u.pm * BM + wr * 64 + fr, col0 = u.pn * BM + wc * 32 + 4 * fq;
        f32x4 bv[2][2];
#pragma unroll
        for (int bj = 0; bj < 2; ++bj)
#pragma unroll
            for (int n = 0; n < 2; ++n) bv[bj][n] = bias ? *(const f32x4*)(bias + col0 + bj * HALF + n * 16) : (f32x4){0.f, 0.f, 0.f, 0.f};
#pragma unroll
        for (int ai = 0; ai < 2; ++ai)
#pragma unroll
            for (int m = 0; m < 4; ++m) { float* rowp = C + (size_t)(row0 + ai * HALF + m * 16) * ldc + col0;
#pragma unroll
                for (int bj = 0; bj < 2; ++bj)
#pragma unroll
                    for (int n = 0; n < 2; ++n) *(f32x4*)(rowp + bj * HALF + n * 16) = acc[ai][bj][m][n] + bv[bj][n]; }
    }
};

template <class Epi, class Sched, bool STAMP = false>
__device__ __forceinline__ void gemm_phase(PG8_LAS unsigned char* lds, const Gemm g, const Sched& S, const Epi& E, unsigned long long* stamps) {
    int tid = threadIdx.x; asm volatile("" : "+v"(tid));
    const int wid = __builtin_amdgcn_readfirstlane(tid >> 6), lane = tid & 63, wr = wid >> 2, wc = wid & 3, fr = lane & 15, fq = lane >> 4;
    const int K = g.K, nt = K / BK;
    int ts_lo = 0, ts_hi = 0, nts = 0; const unsigned long long rt_entry = STAMP ? (unsigned long long)wall_clock64() : 0ull;
#define PG8_STAMP() do { if (STAMP && wid == 0 && nts < 64) { const unsigned long long _c = (unsigned long long)clock64(); \
        ts_lo = (lane == nts) ? (int)(unsigned)_c : ts_lo; ts_hi = (lane == nts) ? (int)(unsigned)(_c >> 32) : ts_hi; ++nts; } } while (0)
    PG8_STAMP();
    unsigned voffA[2], voffB[2];
#pragma unroll
    for (int i = 0; i < 2; ++i) { int R, C; stage_rc(tid * 16 + i * 8192, R, C); const int Rb = Epi::PERM ? ((R & ~31) + perm32(R & 31)) : R;
        voffA[i] = (unsigned)(R * K + C) * 2u; voffB[i] = (unsigned)(Rb * K + C) * 2u; }
    const size_t kstep = (size_t)(BK * 2);
    const size_t hstep = (size_t)HALF * K * 2;
    const size_t tstep = 2 * hstep;
    const unsigned ldsw = (unsigned)wid * 1024u;
    const int aoff = lds_byte(wr * 64 + fr, fq * 8), boff = lds_byte(wc * 32 + fr, fq * 8);
#define PG8_SA(b, h) (((b) * 2 + (h)) * HTB)
#define PG8_SB(b, h) ((4 + (b) * 2 + (h)) * HTB)
#define PG8_STAGE(bufoff, gbase, voff) do { _Pragma("unroll") for (int _i = 0; _i < 2; ++_i) \
        __builtin_amdgcn_global_load_lds((const unsigned*)((const char*)(gbase) + (voff)[_i]), (PG8_LAS unsigned*)(lds + (bufoff) + ldsw + _i * 8192), 16, 0, 0); } while (0)
#define PG8_LDA(dst, b, h) do { _Pragma("unroll") for (int m = 0; m < 4; ++m) _Pragma("unroll") for (int k = 0; k < 2; ++k) dst[m][k] = *(const PG8_LAS bf16x8*)(lds + PG8_SA(b, h) + aoff + m * 2048 + k * 1024); } while (0)
#define PG8_LDB(dst, b, h) do { _Pragma("unroll") for (int n = 0; n < 2; ++n) _Pragma("unroll") for (int k = 0; k < 2; ++k) dst[n][k] = *(const PG8_LAS bf16x8*)(lds + PG8_SB(b, h) + boff + n * 2048 + k * 1024); } while (0)
#define PG8_MMA(ai, bj, At, Bt) do { __builtin_amdgcn_s_setprio(1); _Pragma("unroll") for (int m = 0; m < 4; ++m) _Pragma("unroll") for (int n = 0; n < 2; ++n) _Pragma("unroll") for (int k = 0; k < 2; ++k) \
        acc[ai][bj][m][n] = __builtin_amdgcn_mfma_f32_16x16x32_bf16(Bt[n][k], At[m][k], acc[ai][bj][m][n], 0, 0, 0); __builtin_amdgcn_s_setprio(0); } while (0)
#define PG8_WAIT_V(n) asm volatile("s_waitcnt vmcnt(" #n ")" ::: "memory")
#define PG8_WAIT_L(n) asm volatile("s_waitcnt lgkmcnt(" #n ")" ::: "memory")
#define PG8_BAR __builtin_amdgcn_s_barrier()
#define PG8_SCHED __builtin_amdgcn_sched_barrier(0)
    Unit cur, nxt; int ui = 0;
    if (!S.next(0, cur)) return;
    f32x4 acc[2][2][4][2];
#pragma unroll
    for (int a = 0; a < 2; ++a)
#pragma unroll
        for (int b = 0; b < 2; ++b)
#pragma unroll
            for (int m = 0; m < 4; ++m)
#pragma unroll
                for (int n = 0; n < 2; ++n) acc[a][b][m][n] = (f32x4){0.f, 0.f, 0.f, 0.f};
    bf16x8 At[4][2], B0[2][2], B1[2][2];
    const char* cA = (const char*)g.A + (size_t)cur.pm * tstep; const char* cB = (const char*)g.Bt + (size_t)cur.pn * tstep;
    S.a_ready(cur);
    PG8_STAGE(PG8_SB(0, 0), cB, voffB); PG8_STAGE(PG8_SA(0, 0), cA, voffA); PG8_STAGE(PG8_SB(0, 1), cB + hstep, voffB); PG8_STAGE(PG8_SA(0, 1), cA + hstep, voffA);
    if (wr == 1) PG8_BAR;
    PG8_WAIT_V(4); PG8_BAR;
    PG8_STAGE(PG8_SB(1, 0), cB + kstep, voffB); PG8_STAGE(PG8_SA(1, 0), cA + kstep, voffA); PG8_STAGE(PG8_SB(1, 1), cB + hstep + kstep, voffB);
    PG8_WAIT_V(6); PG8_BAR;
    PG8_STAMP();
    for (;;) {
        const bool has_next = S.next(ui + 1, nxt);
        const char* nA = has_next ? (const char*)g.A + (size_t)nxt.pm * tstep : cA; const char* nB = has_next ? (const char*)g.Bt + (size_t)nxt.pn * tstep : cB;
        for (int t = 0; t < nt; t += 2) {
            const bool last = (t == nt - 2);
            const char* a1 = cA + (size_t)(t + 1) * kstep;
            const char* a2 = last ? nA : cA + (size_t)(t + 2) * kstep; const char* b2 = last ? nB : cB + (size_t)(t + 2) * kstep;
            const char* a3 = a2 + kstep; const char* b3 = b2 + kstep;
            if (last && has_next) S.a_ready(nxt);
            PG8_LDB(B0, 0, 0); PG8_SCHED; PG8_LDA(At, 0, 0); PG8_STAGE(PG8_SA(1, 1), a1 + hstep, voffA);
            PG8_WAIT_L(8); PG8_BAR; PG8_WAIT_L(0); PG8_MMA(0, 0, At, B0); PG8_BAR; PG8_SCHED;
            PG8_LDB(B1, 0, 1); PG8_STAGE(PG8_SB(0, 0), b2, voffB);
            PG8_BAR; PG8_WAIT_L(0); PG8_MMA(0, 1, At, B1); PG8_BAR;
            PG8_LDA(At, 0, 1); PG8_STAGE(PG8_SA(0, 0), a2, voffA);
            PG8_BAR; PG8_WAIT_L(0); PG8_MMA(1, 0, At, B0); PG8_BAR; PG8_SCHED;
            PG8_STAGE(PG8_SB(0, 1), b2 + hstep, voffB);
            PG8_WAIT_V(6); PG8_BAR; PG8_MMA(1, 1, At, B1); PG8_BAR;
            PG8_LDB(B0, 1, 0); PG8_SCHED; PG8_LDA(At, 1, 0); PG8_STAGE(PG8_SA(0, 1), a2 + hstep, voffA);
            PG8_WAIT_L(8); PG8_BAR; PG8_WAIT_L(0); PG8_MMA(0, 0, At, B0); PG8_BAR; PG8_SCHED;
            PG8_LDB(B1, 1, 1); PG8_STAGE(PG8_SB(1, 0), b3, voffB);
            PG8_BAR; PG8_WAIT_L(0); PG8_MMA(0, 1, At, B1); PG8_BAR;
            PG8_LDA(At, 1, 1); PG8_STAGE(PG8_SA(1, 0), a3, voffA);
            PG8_BAR; PG8_WAIT_L(0); PG8_MMA(1, 0, At, B0); PG8_BAR; PG8_SCHED;
            PG8_STAGE(PG8_SB(1, 1), b3 + hstep, voffB);
            PG8_WAIT_V(6); PG8_BAR; PG8_MMA(1, 1, At, B1); PG8_BAR;
        }
        PG8_STAMP();
        if constexpr (!Epi::AFTER_DRAIN) { E(acc, cur, wr, wc, fr, fq); S.done(cur); }
        PG8_STAMP();
        if (!has_next) break;
#pragma unroll
        for (int a = 0; a < 2; ++a)
#pragma unroll
            for (int b = 0; b < 2; ++b)
#pragma unroll
                for (int m = 0; m < 4; ++m)
#pragma unroll
                    for (int n = 0; n < 2; ++n) acc[a][b][m][n] = (f32x4){0.f, 0.f, 0.f, 0.f};
        cur = nxt; cA = nA; cB = nB; ++ui;
    }
    PG8_WAIT_V(0);
    if (wr == 0) PG8_BAR;
    PG8_BAR;
    if constexpr (Epi::AFTER_DRAIN) { E.fused(acc, cur, wr, wc, fr, fq, lds, wid, lane); S.done(cur); }
    PG8_STAMP();
    if (STAMP && wid == 0) { stamps[lane] = lane < nts ? (((unsigned long long)(unsigned)ts_hi << 32) | (unsigned)ts_lo) : 0ull;
        if (lane == 62) stamps[62] = rt_entry; if (lane == 63) stamps[63] = (unsigned long long)wall_clock64(); }
#undef PG8_STAMP
#undef PG8_SA
#undef PG8_SB
#undef PG8_STAGE
#undef PG8_LDA
#undef PG8_LDB
#undef PG8_MMA
#undef PG8_WAIT_V
#undef PG8_WAIT_L
#undef PG8_BAR
#undef PG8_SCHED
}
}


namespace pg8 {
struct EpiProj {
    static constexpr bool PERM = true, AFTER_DRAIN = false;
    bf16_t* O; float* dtraw;
    __device__ __forceinline__ void operator()(const f32x4 (&acc)[2][2][4][2], const Unit& u, int wr, int wc, int fr, int fq) const {
        const int row0 = u.pm * BM + wr * 64 + fr;
        if (u.pn < 22) {
            const int col0 = u.pn * BM + wc * 32 + 8 * fq;
#pragma unroll
            for (int ai = 0; ai < 2; ++ai)
#pragma unroll
                for (int m = 0; m < 4; ++m) { bf16_t* rowp = O + (size_t)(row0 + ai * HALF + m * 16) * 5632 + col0;
#pragma unroll
                    for (int bj = 0; bj < 2; ++bj) { const f32x4 v0 = acc[ai][bj][m][0], v1 = acc[ai][bj][m][1];
                        u32x4 w; w.x = cvt_pk_bf16(v0[0], v0[1]); w.y = cvt_pk_bf16(v0[2], v0[3]); w.z = cvt_pk_bf16(v1[0], v1[1]); w.w = cvt_pk_bf16(v1[2], v1[3]);
                        *(u32x4*)(rowp + bj * HALF) = w; } }
        } else if (wc == 0) {
#pragma unroll
            for (int ai = 0; ai < 2; ++ai)
#pragma unroll
                for (int m = 0; m < 4; ++m) { float* rp = dtraw + (size_t)(row0 + ai * HALF + m * 16) * 32 + 8 * fq;
                    *(f32x4*)rp = acc[ai][0][m][0]; *(f32x4*)(rp + 4) = acc[ai][0][m][1]; }
        }
    }
};
}


namespace pg8 {
struct EpiBf16Plain {
    static constexpr bool PERM = true, AFTER_DRAIN = false;
    bf16_t* O; int ldc;
    __device__ __forceinline__ void operator()(const f32x4 (&acc)[2][2][4][2], const Unit& u, int wr, int wc, int fr, int fq) const {
        const int row0 = u.pm * BM + wr * 64 + fr, col0 = u.pn * BM + wc * 32 + 8 * fq;
#pragma unroll
        for (int ai = 0; ai < 2; ++ai)
#pragma unroll
            for (int m = 0; m < 4; ++m) { bf16_t* rowp = O + (size_t)(row0 + ai * HALF + m * 16) * ldc + col0;
#pragma unroll
                for (int bj = 0; bj < 2; ++bj) { const f32x4 v0 = acc[ai][bj][m][0], v1 = acc[ai][bj][m][1];
                    u32x4 w; w.x = cvt_pk_bf16(v0[0], v0[1]); w.y = cvt_pk_bf16(v0[2], v0[3]); w.z = cvt_pk_bf16(v1[0], v1[1]); w.w = cvt_pk_bf16(v1[2], v1[3]);
                    *(u32x4*)(rowp + bj * HALF) = w; } }
    }
};
}

#define NTHR 512
#define NWAVE 8

__device__ __forceinline__ void ph_gemm_f32(float* lds, const float* __restrict__ A, const float* __restrict__ B, float* __restrict__ C,
                                            int M, int N, int K, int lda, int ldb, int ldc) {
    const int tid = threadIdx.x & 255, half = threadIdx.x >> 8, tx = tid & 15, ty = tid >> 4;
    float (*As)[68] = (float (*)[68])(lds + half * 2 * 16 * 68);
    float (*Bs)[68] = (float (*)[68])(lds + half * 2 * 16 * 68 + 16 * 68);
    const int ntx = (N + 63) / 64, nty = M / 64, ntiles = ntx * nty;
    for (int it = blockIdx.x; 2 * it < ntiles; it += gridDim.x) {
        const int tile = 2 * it + half;
        const int m0 = (tile / ntx) * 64, n0 = (tile % ntx) * 64;
        float acc[4][4];
#pragma unroll
        for (int i = 0; i < 4; ++i)
#pragma unroll
            for (int j = 0; j < 4; ++j) acc[i][j] = 0.f;
        for (int k0 = 0; k0 < K; k0 += 16) {
#pragma unroll
            for (int i = 0; i < 4; ++i) {
                int idx = tid + i * 256;
                int r = idx >> 4, c = idx & 15;
                As[c][r] = (m0 + r < M) ? A[(size_t)(m0 + r) * lda + k0 + c] : 0.f;
                int rb = idx >> 6, cb = idx & 63;
                Bs[rb][cb] = (n0 + cb < N) ? B[(size_t)(k0 + rb) * ldb + n0 + cb] : 0.f;
            }
            __syncthreads();
#pragma unroll
            for (int k = 0; k < 16; ++k) {
                float a[4], b[4];
#pragma unroll
                for (int i = 0; i < 4; ++i) { a[i] = As[k][ty * 4 + i]; b[i] = Bs[k][tx * 4 + i]; }
#pragma unroll
                for (int i = 0; i < 4; ++i)
#pragma unroll
                    for (int j = 0; j < 4; ++j) acc[i][j] += a[i] * b[j];
            }
            __syncthreads();
        }
#pragma unroll
        for (int i = 0; i < 4; ++i)
#pragma unroll
            for (int j = 0; j < 4; ++j) {
                int r = m0 + ty * 4 + i, c = n0 + tx * 4 + j;
                if (r < M && c < N) C[(size_t)r * ldc + c] = acc[i][j];
            }
    }
}


template <int MODE>
__device__ __forceinline__ void transpose_item(const float* __restrict__ W, int K, int N, int Npad, bf16* __restrict__ WT, LAS float* scr, int item, int lane) {
    const int nblk = Npad / 32, kb = item / nblk, nb = item % nblk, k0 = 64 * kb, n0 = 32 * nb;
    const int n = n0 + (lane & 31);
    int sc = n;
    if (MODE == 1) sc = (n < 4096) ? n : (n < 5632 ? n + 24 : (n < 5656 ? n - 5632 + 4096 : -1));
    else sc = (n < N) ? n : -1;
#pragma unroll 8
    for (int i = 0; i < 32; ++i) { const int kk = 2 * i + (lane >> 5); scr[kk * 33 + (lane & 31)] = (sc >= 0) ? W[(size_t)(k0 + kk) * N + sc] : 0.f; }
    LDS_WAIT(); asm volatile("" ::: "memory");
    const int c = lane & 7;
#pragma unroll
    for (int j = 0; j < 4; ++j) { const int nn = (lane >> 3) + 8 * j; const LAS float* s = scr + (8 * c) * 33 + nn;
        v4u o; o.x = pk2(s[0 * 33], s[1 * 33]); o.y = pk2(s[2 * 33], s[3 * 33]); o.z = pk2(s[4 * 33], s[5 * 33]); o.w = pk2(s[6 * 33], s[7 * 33]);
        *(v4u*)(WT + (size_t)(n0 + nn) * K + k0 + 8 * c) = o; }
    LDS_WAIT(); asm volatile("" ::: "memory");
}
__device__ __forceinline__ void ph_prologue(LAS unsigned char* ldsb, const float* __restrict__ xp, const float* __restrict__ xs, bf16* __restrict__ A0,
                                            const float* __restrict__ w_in, bf16* __restrict__ wt_in, float* __restrict__ rope_tab) {
    const int lane = threadIdx.x & 63, wave = threadIdx.x >> 6;
    LAS float* scr = (LAS float*)(ldsb + wave * 16384);
    const int gw = blockIdx.x * NWAVE + wave, NGW = gridDim.x * NWAVE;
    constexpr int I_IN = (D_MODEL / 64) * (PROJ_LD / 32);
    for (int it = gw; it < I_IN; it += NGW) transpose_item<1>(w_in, D_MODEL, IN_WIDTH, PROJ_LD, wt_in, scr, it, lane);
    for (int idx = blockIdx.x * NTHR + threadIdx.x; idx < SEQ * 32; idx += gridDim.x * NTHR) {
        const int pos = idx >> 5, j = idx & 31;
        const double rev = (double)pos * ROPE_INV_REV[j];
        const float fr = (float)(rev - floor(rev));
        rope_tab[(size_t)pos * 64 + j] = __builtin_amdgcn_cosf(fr); rope_tab[(size_t)pos * 64 + 32 + j] = __builtin_amdgcn_sinf(fr);
    }
    const size_t n8 = (size_t)T_ALL * D_MODEL / 8, np8 = (size_t)T_PROMPT * D_MODEL / 8;
#pragma unroll 4
    for (size_t i = (size_t)blockIdx.x * NTHR + threadIdx.x; i < n8; i += (size_t)gridDim.x * NTHR) {
        const float4* s = (i < np8) ? (const float4*)xp + 2 * i : (const float4*)xs + 2 * (i - np8);
        float4 a = s[0], b = s[1];
        v4u o; o.x = pk2(a.x, a.y); o.y = pk2(a.z, a.w); o.z = pk2(b.x, b.y); o.w = pk2(b.z, b.w);
        ((v4u*)A0)[i] = o;
    }
}
__device__ __forceinline__ void ph_prologue2(LAS unsigned char* ldsb, const float* __restrict__ w_out, bf16* __restrict__ wt_out, const float* __restrict__ w_q, bf16* __restrict__ wt_q,
                                             int rank, int nranks) {
    const int lane = threadIdx.x & 63, wave = threadIdx.x >> 6;
    LAS float* scr = (LAS float*)(ldsb + wave * 16384);
    constexpr int I_OUT = (MIX_WIDTH / 64) * (D_MODEL / 32), I_Q = (D_MODEL / 64) * (2048 / 32);
    for (int it = rank * NWAVE + wave; it < I_OUT + I_Q; it += nranks * NWAVE) {
        if (it < I_OUT) transpose_item<0>(w_out, MIX_WIDTH, D_MODEL, D_MODEL, wt_out, scr, it, lane);
        else transpose_item<0>(w_q, D_MODEL, 2048, 2048, wt_q, scr, it - I_OUT, lane);
    }
}

__device__ __forceinline__ void ph_concat_x(const float* __restrict__ xp, const float* __restrict__ xs, float* __restrict__ xall) {
    const size_t n4 = (size_t)T_ALL * D_MODEL / 4, np4 = (size_t)T_PROMPT * D_MODEL / 4;
    for (size_t i = (size_t)blockIdx.x * NTHR + threadIdx.x; i < n4; i += (size_t)gridDim.x * NTHR) {
        float4 v = (i < np4) ? ((const float4*)xp)[i] : ((const float4*)xs)[i - np4];
        ((float4*)xall)[i] = v;
    }
}

typedef float f32x4n __attribute__((ext_vector_type(4)));
__device__ __forceinline__ void ph_cache_copy(const float* __restrict__ ck, const float* __restrict__ cv, float* __restrict__ out) {
    constexpr unsigned PER_B = (WBUF - DEC_SEQ) * ATT_WIDTH / 4;
    constexpr unsigned TOTAL = 2u * DEC_BATCH * PER_B;
    for (unsigned c = blockIdx.x; c < TOTAL / 4096u; c += gridDim.x) {
        f32x4n v[8]; size_t dsti[8]; bool isv[8];
#pragma unroll
        for (int j = 0; j < 8; ++j) {
            const unsigned idx = c * 4096u + j * 512u + threadIdx.x;
            const unsigned tb = idx / PER_B, r = idx - tb * PER_B, bb = tb & (DEC_BATCH - 1);
            isv[j] = tb >= DEC_BATCH;
            const size_t srci = (size_t)bb * (WBUF * ATT_WIDTH / 4) + (DEC_SEQ * ATT_WIDTH / 4) + r;
            dsti[j] = (size_t)bb * (WBUF * ATT_WIDTH / 4) + r;
            v[j] = __builtin_nontemporal_load((isv[j] ? (const f32x4n*)cv : (const f32x4n*)ck) + srci);
        }
#pragma unroll
        for (int j = 0; j < 8; ++j) __builtin_nontemporal_store(v[j], (f32x4n*)(out + (isv[j] ? OUT_SV : OUT_SK)) + dsti[j]);
    }
}

__device__ __forceinline__ void ph_post_proj(const float* __restrict__ proj, const float* __restrict__ state_conv,
                                             const float* __restrict__ conv_w, const float* __restrict__ conv_b, const float* __restrict__ dt_bias,
                                             float* __restrict__ xbc_act, float* __restrict__ dtv, float* __restrict__ qrot, float* __restrict__ krot,
                                             float* __restrict__ out) {
    const int tid = threadIdx.x & 255, half = threadIdx.x >> 8;
    for (int t = 2 * blockIdx.x + half; t < T_ALL; t += 2 * gridDim.x) {
        const bool is_p = t < T_PROMPT;
        int b, i, pos;
        if (is_p) { b = t / SEQ; i = t % SEQ; pos = i; } else { int ts = t - T_PROMPT; b = ts / DEC_SEQ; i = ts % DEC_SEQ; pos = PAST_LEN + i; }
        const float* row = proj + (size_t)t * PROJ_LD;
        for (int c = tid; c < CONV_DIM; c += 256) {
            float acc = conv_b[c];
#pragma unroll
            for (int tap = 0; tap < 4; ++tap) {
                int r = i - 3 + tap;
                float val;
                if (r >= 0) val = proj[(size_t)(t - i + r) * PROJ_LD + O_XBC + c];
                else val = is_p ? 0.f : state_conv[((size_t)b * 3 + (3 + r)) * CONV_DIM + c];
                acc += val * conv_w[tap * CONV_DIM + c];
            }
            xbc_act[(size_t)t * CONV_DIM + c] = silu_f(acc);
        }
        if (tid < SSD_HEADS) dtv[(size_t)t * SSD_HEADS + tid] = softplus_f(row[O_DT + tid] + dt_bias[tid]);
        for (int idx = tid; idx < 512; idx += 256) {
            int which = idx >> 8, h = (idx >> 5) & 7, j = idx & 31;
            double rev = (double)pos * ROPE_INV_REV[j];
            float fr = (float)(rev - floor(rev));
            float sn = __builtin_amdgcn_sinf(fr), cs = __builtin_amdgcn_cosf(fr);
            const float* src = row + (which ? O_K : O_Q) + h * 64;
            float t1 = src[j], t2 = src[j + 32];
            float o1 = t1 * cs - t2 * sn, o2 = t2 * cs + t1 * sn;
            float* dst = (which ? krot : qrot) + (size_t)t * ATT_WIDTH + h * 64;
            dst[j] = o1; dst[j + 32] = o2;
            if (which) {
                if (is_p) { if (i >= SEQ - WBUF) { float* o = out + OUT_PK + ((size_t)b * WBUF + (i - (SEQ - WBUF))) * ATT_WIDTH + h * 64; o[j] = o1; o[j + 32] = o2; } }
                else { float* o = out + OUT_SK + ((size_t)b * WBUF + (WBUF - DEC_SEQ + i)) * ATT_WIDTH + h * 64; o[j] = o1; o[j + 32] = o2; }
            }
        }
        for (int c = tid; c < ATT_WIDTH; c += 256) {
            float v = row[O_V + c];
            if (is_p) { if (i >= SEQ - WBUF) out[OUT_PV + ((size_t)b * WBUF + (i - (SEQ - WBUF))) * ATT_WIDTH + c] = v; }
            else out[OUT_SV + ((size_t)b * WBUF + (WBUF - DEC_SEQ + i)) * ATT_WIDTH + c] = v;
        }
        if (is_p) {
            if (i >= SEQ - 3) { int r = i - (SEQ - 3); for (int c = tid; c < CONV_DIM; c += 256) out[OUT_PC + ((size_t)b * 3 + r) * CONV_DIM + c] = row[O_XBC + c]; }
        } else {
            if (i >= 1) { int r = i - 1; for (int c = tid; c < CONV_DIM; c += 256) out[OUT_SC + ((size_t)b * 3 + r) * CONV_DIM + c] = row[O_XBC + c]; }
        }
    }
}


#define NB_LD 5632
#define NB_XBC 1536
#define NB_Q 4096
#define NB_K 4608
#define NB_V 5120
__device__ __forceinline__ void unpack8(const v4u w, float (&f)[8]) {
    f[0] = __builtin_bit_cast(float, w.x << 16); f[1] = __builtin_bit_cast(float, w.x & 0xffff0000u);
    f[2] = __builtin_bit_cast(float, w.y << 16); f[3] = __builtin_bit_cast(float, w.y & 0xffff0000u);
    f[4] = __builtin_bit_cast(float, w.z << 16); f[5] = __builtin_bit_cast(float, w.z & 0xffff0000u);
    f[6] = __builtin_bit_cast(float, w.w << 16); f[7] = __builtin_bit_cast(float, w.w & 0xffff0000u);
}
__device__ __forceinline__ void store8f(float* d, const float (&f)[8]) { *(float4*)d = make_float4(f[0], f[1], f[2], f[3]); *(float4*)(d + 4) = make_float4(f[4], f[5], f[6], f[7]); }
__device__ __forceinline__ void ph_post_proj2(const bf16* __restrict__ projb, const float* __restrict__ dtraw, const float* __restrict__ state_conv,
                                              const float* __restrict__ conv_w, const float* __restrict__ conv_b, const float* __restrict__ dt_bias,
                                              bf16* __restrict__ xbc_b, float* __restrict__ dtv, bf16* __restrict__ qrot_b, bf16* __restrict__ krot_b,
                                              float* __restrict__ out) {
    const int tid = threadIdx.x & 255, half = threadIdx.x >> 8;
    for (int t = T_PROMPT + 2 * blockIdx.x + half; t < T_ALL; t += 2 * gridDim.x) {
        const bool is_p = t < T_PROMPT;
        int b, i, pos;
        if (is_p) { b = t / SEQ; i = t % SEQ; pos = i; } else { int ts = t - T_PROMPT; b = ts / DEC_SEQ; i = ts % DEC_SEQ; pos = PAST_LEN + i; }
        const bf16* row = projb + (size_t)t * NB_LD;
        if (tid < 64) {
            float f[8]; unpack8(*(const v4u*)(row + NB_V + tid * 8), f);
            if (is_p) { if (i >= SEQ - WBUF) store8f(out + OUT_PV + ((size_t)b * WBUF + (i - (SEQ - WBUF))) * ATT_WIDTH + tid * 8, f); }
            else store8f(out + OUT_SV + ((size_t)b * WBUF + (WBUF - DEC_SEQ + i)) * ATT_WIDTH + tid * 8, f);
        }
        for (int c8 = tid; c8 < 320; c8 += 256) {
            const int c = c8 * 8;
            float acc[8], cur[8];
            { const float4 b0 = *(const float4*)(conv_b + c), b1 = *(const float4*)(conv_b + c + 4);
              acc[0] = b0.x; acc[1] = b0.y; acc[2] = b0.z; acc[3] = b0.w; acc[4] = b1.x; acc[5] = b1.y; acc[6] = b1.z; acc[7] = b1.w; }
#pragma unroll
            for (int tap = 0; tap < 4; ++tap) {
                const int r = i - 3 + tap;
                float val[8];
                if (r >= 0) unpack8(*(const v4u*)(projb + (size_t)(t - i + r) * NB_LD + NB_XBC + c), val);
                else if (!is_p) { const float* sp = state_conv + ((size_t)b * 3 + (3 + r)) * CONV_DIM + c; const float4 s0 = *(const float4*)sp, s1 = *(const float4*)(sp + 4);
                    val[0] = s0.x; val[1] = s0.y; val[2] = s0.z; val[3] = s0.w; val[4] = s1.x; val[5] = s1.y; val[6] = s1.z; val[7] = s1.w; }
                else {
#pragma unroll
                    for (int j = 0; j < 8; ++j) val[j] = 0.f; }
                const float4 w0 = *(const float4*)(conv_w + tap * CONV_DIM + c), w1 = *(const float4*)(conv_w + tap * CONV_DIM + c + 4);
                acc[0] += val[0] * w0.x; acc[1] += val[1] * w0.y; acc[2] += val[2] * w0.z; acc[3] += val[3] * w0.w;
                acc[4] += val[4] * w1.x; acc[5] += val[5] * w1.y; acc[6] += val[6] * w1.z; acc[7] += val[7] * w1.w;
                if (tap == 3) {
#pragma unroll
                    for (int j = 0; j < 8; ++j) cur[j] = val[j]; }
            }
#pragma unroll
            for (int j = 0; j < 8; ++j) acc[j] = silu_f(acc[j]);
            v4u o; o.x = pk2(acc[0], acc[1]); o.y = pk2(acc[2], acc[3]); o.z = pk2(acc[4], acc[5]); o.w = pk2(acc[6], acc[7]);
            *(v4u*)(xbc_b + (size_t)t * CONV_DIM + c) = o;
            if (is_p) { if (i >= SEQ - 3) store8f(out + OUT_PC + ((size_t)b * 3 + (i - (SEQ - 3))) * CONV_DIM + c, cur); }
            else { if (i >= 1) store8f(out + OUT_SC + ((size_t)b * 3 + (i - 1)) * CONV_DIM + c, cur); }
        }
        if (tid < SSD_HEADS) dtv[(size_t)t * SSD_HEADS + tid] = softplus_f(dtraw[(size_t)t * 32 + tid] + dt_bias[tid]);
        if (tid < 128) {
            const int which = tid >> 6, h = (tid >> 3) & 7, jc = tid & 7;
            const bf16* src = row + (which ? NB_K : NB_Q) + h * 64 + jc * 4;
            const uint2 lo = *(const uint2*)src, hi = *(const uint2*)(src + 32);
            float t1[4], t2[4], o1[4], o2[4];
            t1[0] = __builtin_bit_cast(float, lo.x << 16); t1[1] = __builtin_bit_cast(float, lo.x & 0xffff0000u); t1[2] = __builtin_bit_cast(float, lo.y << 16); t1[3] = __builtin_bit_cast(float, lo.y & 0xffff0000u);
            t2[0] = __builtin_bit_cast(float, hi.x << 16); t2[1] = __builtin_bit_cast(float, hi.x & 0xffff0000u); t2[2] = __builtin_bit_cast(float, hi.y << 16); t2[3] = __builtin_bit_cast(float, hi.y & 0xffff0000u);
#pragma unroll
            for (int e = 0; e < 4; ++e) {
                const double rev = (double)pos * ROPE_INV_REV[jc * 4 + e];
                const float fr = (float)(rev - floor(rev));
                const float sn = __builtin_amdgcn_sinf(fr), cs = __builtin_amdgcn_cosf(fr);
                o1[e] = t1[e] * cs - t2[e] * sn; o2[e] = t2[e] * cs + t1[e] * sn;
            }
            const size_t doff = (size_t)t * ATT_WIDTH + h * 64 + jc * 4;
            bf16* db = which ? krot_b : qrot_b;
            *(uint2*)(db + doff) = make_uint2(pk2(o1[0], o1[1]), pk2(o1[2], o1[3])); *(uint2*)(db + doff + 32) = make_uint2(pk2(o2[0], o2[1]), pk2(o2[2], o2[3]));
            if (which) {
                float* o = nullptr;
                if (is_p) { if (i >= SEQ - WBUF) o = out + OUT_PK + ((size_t)b * WBUF + (i - (SEQ - WBUF))) * ATT_WIDTH + h * 64 + jc * 4; }
                else o = out + OUT_SK + ((size_t)b * WBUF + (WBUF - DEC_SEQ + i)) * ATT_WIDTH + h * 64 + jc * 4;
                if (o) { *(float4*)o = make_float4(o1[0], o1[1], o1[2], o1[3]); *(float4*)(o + 32) = make_float4(o2[0], o2[1], o2[2], o2[3]); }
            }
        }
    }
}


__device__ __forceinline__ void ph_post_proj_prompt(const bf16* __restrict__ projb, const float* __restrict__ dtraw, const float* __restrict__ conv_w, const float* __restrict__ conv_b,
                                                    const float* __restrict__ dt_bias, const float* __restrict__ rope_tab, bf16* __restrict__ xbc_b, float* __restrict__ dtv,
                                                    bf16* __restrict__ qrot_b, bf16* __restrict__ krot_b, float* __restrict__ out) {
    const int gtid = blockIdx.x * NTHR + threadIdx.x, gsz = gridDim.x * NTHR;
    for (int item = gtid; item < (T_PROMPT / 16) * 320; item += gsz) {
        const int run = item / 320, c = (item - run * 320) * 8, t0 = run * 16, i0 = t0 & (SEQ - 1), b = t0 >> 13;
        float w[4][8], bias[8];
#pragma unroll
        for (int tap = 0; tap < 4; ++tap) { const float4 w0 = *(const float4*)(conv_w + tap * CONV_DIM + c), w1 = *(const float4*)(conv_w + tap * CONV_DIM + c + 4);
            w[tap][0] = w0.x; w[tap][1] = w0.y; w[tap][2] = w0.z; w[tap][3] = w0.w; w[tap][4] = w1.x; w[tap][5] = w1.y; w[tap][6] = w1.z; w[tap][7] = w1.w; }
        { const float4 b0 = *(const float4*)(conv_b + c), b1 = *(const float4*)(conv_b + c + 4);
          bias[0] = b0.x; bias[1] = b0.y; bias[2] = b0.z; bias[3] = b0.w; bias[4] = b1.x; bias[5] = b1.y; bias[6] = b1.z; bias[7] = b1.w; }
        const bf16* src = projb + (size_t)t0 * NB_LD + NB_XBC + c;
        v4u raw[19];
#pragma unroll
        for (int s = 0; s < 19; ++s) { v4u z; z.x = 0u; z.y = 0u; z.z = 0u; z.w = 0u; raw[s] = (s >= 3 || i0 != 0) ? *(const v4u*)(src + (ptrdiff_t)(s - 3) * NB_LD) : z; }
        float p0[8], p1[8], p2[8];
        unpack8(raw[0], p0); unpack8(raw[1], p1); unpack8(raw[2], p2);
#pragma unroll
        for (int s = 0; s < 16; ++s) {
            float cur[8], acc[8]; unpack8(raw[s + 3], cur);
#pragma unroll
            for (int j = 0; j < 8; ++j) acc[j] = silu_f(bias[j] + p0[j] * w[0][j] + p1[j] * w[1][j] + p2[j] * w[2][j] + cur[j] * w[3][j]);
            v4u o; o.x = pk2(acc[0], acc[1]); o.y = pk2(acc[2], acc[3]); o.z = pk2(acc[4], acc[5]); o.w = pk2(acc[6], acc[7]);
            *(v4u*)(xbc_b + (size_t)(t0 + s) * CONV_DIM + c) = o;
            if (i0 + s >= SEQ - 3) store8f(out + OUT_PC + ((size_t)b * 3 + (i0 + s - (SEQ - 3))) * CONV_DIM + c, cur);
#pragma unroll
            for (int j = 0; j < 8; ++j) { p0[j] = p1[j]; p1[j] = p2[j]; p2[j] = cur[j]; }
        }
    }
#pragma unroll 4
    for (int item = gtid; item < T_PROMPT * 128; item += gsz) {
        const int t = item >> 7, sub = item & 127, which = sub >> 6, h = (sub >> 3) & 7, jc = sub & 7, i = t & (SEQ - 1), b = t >> 13;
        const bf16* src = projb + (size_t)t * NB_LD + (which ? NB_K : NB_Q) + h * 64 + jc * 4;
        const uint2 lo = *(const uint2*)src, hi = *(const uint2*)(src + 32);
        const float4 cs = *(const float4*)(rope_tab + (size_t)i * 64 + jc * 4), sn = *(const float4*)(rope_tab + (size_t)i * 64 + 32 + jc * 4);
        float t1[4], t2[4], o1[4], o2[4];
        t1[0] = __builtin_bit_cast(float, lo.x << 16); t1[1] = __builtin_bit_cast(float, lo.x & 0xffff0000u); t1[2] = __builtin_bit_cast(float, lo.y << 16); t1[3] = __builtin_bit_cast(float, lo.y & 0xffff0000u);
        t2[0] = __builtin_bit_cast(float, hi.x << 16); t2[1] = __builtin_bit_cast(float, hi.x & 0xffff0000u); t2[2] = __builtin_bit_cast(float, hi.y << 16); t2[3] = __builtin_bit_cast(float, hi.y & 0xffff0000u);
        const float cv[4] = {cs.x, cs.y, cs.z, cs.w}, sv[4] = {sn.x, sn.y, sn.z, sn.w};
#pragma unroll
        for (int e = 0; e < 4; ++e) { o1[e] = t1[e] * cv[e] - t2[e] * sv[e]; o2[e] = t2[e] * cv[e] + t1[e] * sv[e]; }
        const size_t doff = (size_t)t * ATT_WIDTH + h * 64 + jc * 4;
        bf16* db = which ? krot_b : qrot_b;
        *(uint2*)(db + doff) = make_uint2(pk2(o1[0], o1[1]), pk2(o1[2], o1[3])); *(uint2*)(db + doff + 32) = make_uint2(pk2(o2[0], o2[1]), pk2(o2[2], o2[3]));
        if (which && i >= SEQ - WBUF) {
            float* o = out + OUT_PK + ((size_t)b * WBUF + (i - (SEQ - WBUF))) * ATT_WIDTH + h * 64 + jc * 4;
            *(float4*)o = make_float4(o1[0], o1[1], o1[2], o1[3]); *(float4*)(o + 32) = make_float4(o2[0], o2[1], o2[2], o2[3]);
        }
    }
#pragma unroll 4
    for (int item = gtid; item < T_PROMPT * SSD_HEADS; item += gsz) { const int t = item / SSD_HEADS, hd = item - t * SSD_HEADS; dtv[item] = softplus_f(dtraw[(size_t)t * 32 + hd] + dt_bias[hd]); }
#pragma unroll 2
    for (int item = gtid; item < BATCH * WBUF * 64; item += gsz) {
        const int ch = item & 63, j = (item >> 6) & (WBUF - 1), b = item >> 17;
        float f[8]; unpack8(*(const v4u*)(projb + (size_t)(b * SEQ + (SEQ - WBUF) + j) * NB_LD + NB_V + ch * 8), f);
        store8f(out + OUT_PV + ((size_t)b * WBUF + j) * ATT_WIDTH + ch * 8, f);
    }
}

#define SSD_CH 32
__device__ __forceinline__ void ph_ssd_naive(float* lds, const bf16* __restrict__ xbc_act, const float* __restrict__ dtv, const float* __restrict__ a_log,
                                             const float* __restrict__ d_skip, const float* __restrict__ state_ssm, float* __restrict__ ybuf, float* __restrict__ out) {
    float (*sx)[64] = (float (*)[64])lds;
    float (*sB)[128] = (float (*)[128])(lds + SSD_CH * 64);
    float (*sC)[128] = (float (*)[128])(lds + SSD_CH * 64 + SSD_CH * 128);
    float* sdt = lds + SSD_CH * 64 + 2 * SSD_CH * 128;
    const int tid = threadIdx.x, p = tid >> 3, ng = tid & 7;
    for (int vb = BATCH * SSD_HEADS + blockIdx.x; vb < (BATCH + DEC_BATCH) * SSD_HEADS; vb += gridDim.x) {
        const int seq = vb / SSD_HEADS, h = vb % SSD_HEADS, g = h / 6;
        const bool is_p = seq < BATCH;
        const int L = is_p ? SEQ : DEC_SEQ;
        const int t0 = is_p ? seq * SEQ : T_PROMPT + (seq - BATCH) * DEC_SEQ;
        const float A = -__expf(a_log[h]);
        const float D = d_skip[h];
        float hs[16];
        if (is_p) {
#pragma unroll
            for (int j = 0; j < 16; ++j) hs[j] = 0.f;
        } else {
            const float* s0 = state_ssm + (((size_t)(seq - BATCH) * SSD_HEADS + h) * 64 + p) * 128 + ng * 16;
#pragma unroll
            for (int j = 0; j < 16; ++j) hs[j] = s0[j];
        }
        for (int c0 = 0; c0 < L; c0 += SSD_CH) {
            const int nst = (L - c0) < SSD_CH ? (L - c0) : SSD_CH;
            __syncthreads();
            for (int idx = tid; idx < nst * 64; idx += NTHR) { int s = idx >> 6, c = idx & 63; sx[s][c] = bf2f(xbc_act[(size_t)(t0 + c0 + s) * CONV_DIM + h * 64 + c]); }
            for (int idx = tid; idx < nst * 128; idx += NTHR) { int s = idx >> 7, c = idx & 127;
                sB[s][c] = bf2f(xbc_act[(size_t)(t0 + c0 + s) * CONV_DIM + 1536 + g * 128 + c]);
                sC[s][c] = bf2f(xbc_act[(size_t)(t0 + c0 + s) * CONV_DIM + 2048 + g * 128 + c]); }
            if (tid < nst) sdt[tid] = dtv[(size_t)(t0 + c0 + tid) * SSD_HEADS + h];
            __syncthreads();
            for (int s = 0; s < nst; ++s) {
                const float dt = sdt[s], x = sx[s][p];
                const float a = __expf(dt * A), xdt = x * dt;
                float y = 0.f;
#pragma unroll
                for (int j = 0; j < 16; ++j) { hs[j] = a * hs[j] + xdt * sB[s][ng * 16 + j]; y += sC[s][ng * 16 + j] * hs[j]; }
                y += __shfl_xor(y, 1); y += __shfl_xor(y, 2); y += __shfl_xor(y, 4);
                if (ng == 0) ybuf[(size_t)(t0 + c0 + s) * MIX_WIDTH + h * 64 + p] = y + D * x;
            }
        }
        float* so = is_p ? out + OUT_PS + (((size_t)seq * SSD_HEADS + h) * 64 + p) * 128 + ng * 16
                         : out + OUT_SS + (((size_t)(seq - BATCH) * SSD_HEADS + h) * 64 + p) * 128 + ng * 16;
#pragma unroll
        for (int j = 0; j < 16; ++j) so[j] = hs[j];
    }
}

__device__ __forceinline__ void ph_gate_norm(const bf16* __restrict__ projb, const float* __restrict__ norm_g, const float* __restrict__ ybuf, bf16* __restrict__ A1) {
    const int w = threadIdx.x >> 6, lane = threadIdx.x & 63, g = w & 3;
    for (int t = T_PROMPT + 2 * blockIdx.x + (w >> 2); t < T_ALL; t += 2 * gridDim.x) {
        float v[6]; float ss = 0.f;
#pragma unroll
        for (int j = 0; j < 6; ++j) {
            int c = g * 384 + j * 64 + lane;
            float y = ybuf[(size_t)t * MIX_WIDTH + c], z = bf2f(projb[(size_t)t * NB_LD + c]);
            v[j] = y * silu_f(z); ss += v[j] * v[j];
        }
        ss = wave_sum(ss);
        const float r = rsqrtf(ss * (1.0f / 384.0f) + LN_EPS);
#pragma unroll
        for (int j = 0; j < 6; ++j) { int c = g * 384 + j * 64 + lane; A1[(size_t)t * MIX_WIDTH + c] = (bf16)f2bf(v[j] * r * norm_g[c]); }
    }
}

__device__ __forceinline__ void ph_attn_naive(float* lds, const float* __restrict__ proj, const float* __restrict__ qrot, const float* __restrict__ krot,
                                              const float* __restrict__ ck, const float* __restrict__ cv, float* __restrict__ ybuf) {
    float (*sq)[64] = (float (*)[64])lds;
    const int w = threadIdx.x >> 6, lane = threadIdx.x & 63;
    for (int vb = blockIdx.x; vb < T_SAMPLE * 8 / NWAVE; vb += gridDim.x) {
        const int item = T_PROMPT * 8 + vb * NWAVE + w;
        const int t = item >> 3, h = item & 7;
        const bool is_p = t < T_PROMPT;
        int b, i;
        if (is_p) { b = t / SEQ; i = t % SEQ; } else { int ts = t - T_PROMPT; b = ts / DEC_SEQ; i = ts % DEC_SEQ; }
        __syncthreads();
        sq[w][lane] = qrot[(size_t)t * ATT_WIDTH + h * 64 + lane];
        __syncthreads();
        const int qi = is_p ? i : WBUF + i;
        float sc[3][3];
        float mx = -INFINITY;
#pragma unroll
        for (int pt = 0; pt < 3; ++pt) {
            const int d = pt == 0 ? 1 : (pt == 1 ? 4 : 16);
#pragma unroll
            for (int sl = 0; sl < 3; ++sl) {
                const int m = lane + sl * 64;
                float s = -INFINITY;
                const int kj = qi - d * m;
                if (m <= 128 && kj >= 0) {
                    const float* kr;
                    if (is_p) kr = krot + (size_t)(b * SEQ + kj) * ATT_WIDTH + h * 64;
                    else kr = (kj >= WBUF) ? krot + (size_t)(T_PROMPT + b * DEC_SEQ + (kj - WBUF)) * ATT_WIDTH + h * 64
                                           : ck + ((size_t)b * WBUF + kj) * ATT_WIDTH + h * 64;
                    float a = 0.f;
#pragma unroll
                    for (int c = 0; c < 64; c += 4) { float4 kv = *(const float4*)(kr + c); a += kv.x * sq[w][c] + kv.y * sq[w][c + 1] + kv.z * sq[w][c + 2] + kv.w * sq[w][c + 3]; }
                    s = a * 0.125f;
                }
                sc[pt][sl] = s; mx = fmaxf(mx, s);
            }
        }
        mx = wave_max(mx);
        float lsum = 0.f;
#pragma unroll
        for (int pt = 0; pt < 3; ++pt)
#pragma unroll
            for (int sl = 0; sl < 3; ++sl) { float pv = (sc[pt][sl] == -INFINITY) ? 0.f : __expf(sc[pt][sl] - mx); sc[pt][sl] = pv; lsum += pv; }
        lsum = wave_sum(lsum);
        float o = 0.f;
#pragma unroll
        for (int pt = 0; pt < 3; ++pt) {
            const int d = pt == 0 ? 1 : (pt == 1 ? 4 : 16);
#pragma unroll
            for (int sl = 0; sl < 3; ++sl) {
                const int mend = sl < 2 ? 64 : 1;
                for (int ml = 0; ml < mend; ++ml) {
                    const int m = ml + sl * 64;
                    const int kj = qi - d * m;
                    const float pv = __shfl(sc[pt][sl], ml);
                    if (kj < 0) continue;
                    const float* vr;
                    if (is_p) vr = proj + (size_t)(b * SEQ + kj) * PROJ_LD + O_V + h * 64;
                    else vr = (kj >= WBUF) ? proj + (size_t)(T_PROMPT + b * DEC_SEQ + (kj - WBUF)) * PROJ_LD + O_V + h * 64
                                           : cv + ((size_t)b * WBUF + kj) * ATT_WIDTH + h * 64;
                    o += pv * vr[lane];
                }
            }
        }
        ybuf[(size_t)t * MIX_WIDTH + SSD_WIDTH + h * 64 + lane] = o / lsum;
    }
}

__device__ __forceinline__ int token_of_iter(int k) {
    const int w = __builtin_amdgcn_readfirstlane(threadIdx.x >> 6), wgl = blockIdx.x * NWAVE + w;
    if (gridDim.x != 256) { const int t = wgl + k * (int)(gridDim.x * NWAVE); return t < T_ALL ? t : -1; }
    if (k < 8) return k * 2048 + wgl;
    if (k == 8 && w < 2) return 16384 + w * 256 + (int)blockIdx.x;
    return -1;
}
__device__ __forceinline__ void ph_ln_res(const float* __restrict__ xp, const float* __restrict__ xs, const bf16* __restrict__ add, const float* __restrict__ gam,
                                          const float* __restrict__ bet, bf16* __restrict__ dstb) {
    const int lane = threadIdx.x & 63;
#pragma unroll 2
    for (int k = 0;; ++k) {
        const int t = token_of_iter(k);
        if (t < 0) break;
        const float* res = (t < T_PROMPT) ? xp + (size_t)t * D_MODEL : xs + (size_t)(t - T_PROMPT) * D_MODEL;
        float v[16]; float s = 0.f;
#pragma unroll
        for (int j = 0; j < 2; ++j) { const int c = j * 512 + lane * 8; const float4 r0 = *(const float4*)(res + c), r1 = *(const float4*)(res + c + 4);
            float a8[8]; unpack8(*(const v4u*)(add + (size_t)t * D_MODEL + c), a8);
            v[8 * j] = ALPHA_F * r0.x + a8[0]; v[8 * j + 1] = ALPHA_F * r0.y + a8[1]; v[8 * j + 2] = ALPHA_F * r0.z + a8[2]; v[8 * j + 3] = ALPHA_F * r0.w + a8[3];
            v[8 * j + 4] = ALPHA_F * r1.x + a8[4]; v[8 * j + 5] = ALPHA_F * r1.y + a8[5]; v[8 * j + 6] = ALPHA_F * r1.z + a8[6]; v[8 * j + 7] = ALPHA_F * r1.w + a8[7]; }
#pragma unroll
        for (int j = 0; j < 16; ++j) s += v[j];
        s = wave_sum(s);
        const float mu = s * (1.0f / 1024.0f);
        float q = 0.f;
#pragma unroll
        for (int j = 0; j < 16; ++j) { v[j] -= mu; q += v[j] * v[j]; }
        q = wave_sum(q);
        const float r = rsqrtf(q * (1.0f / 1024.0f) + LN_EPS);
#pragma unroll
        for (int j = 0; j < 2; ++j) { const int c = j * 512 + lane * 8; const float4 g0 = *(const float4*)(gam + c), g1 = *(const float4*)(gam + c + 4), b0 = *(const float4*)(bet + c), b1 = *(const float4*)(bet + c + 4);
            v4u o; o.x = pk2(v[8 * j] * r * g0.x + b0.x, v[8 * j + 1] * r * g0.y + b0.y); o.y = pk2(v[8 * j + 2] * r * g0.z + b0.z, v[8 * j + 3] * r * g0.w + b0.w);
            o.z = pk2(v[8 * j + 4] * r * g1.x + b1.x, v[8 * j + 5] * r * g1.y + b1.y); o.w = pk2(v[8 * j + 6] * r * g1.z + b1.z, v[8 * j + 7] * r * g1.w + b1.w);
            *(v4u*)(dstb + (size_t)t * D_MODEL + c) = o; }
    }
}

__device__ __forceinline__ void ph_peer_route(float* lds, const float* __restrict__ qh, const float* __restrict__ keys1, const float* __restrict__ keys2,
                                              int* __restrict__ eidx, float* __restrict__ gate) {
    float (*sq)[256] = (float (*)[256])lds;
    float (*sv)[2][16] = (float (*)[2][16])(lds + NWAVE * 256);
    int (*si)[2][16] = (int (*)[2][16])(lds + NWAVE * 256 + NWAVE * 32);
    const int w = threadIdx.x >> 6, lane = threadIdx.x & 63;
    for (int vb = blockIdx.x; vb < T_ALL * 8 / NWAVE; vb += gridDim.x) {
        const int item = vb * NWAVE + w;
        const int t = item >> 3, h = item & 7;
        __syncthreads();
        for (int c = lane; c < 256; c += 64) sq[w][c] = qh[(size_t)t * 2048 + h * 256 + c];
        __syncthreads();
#pragma unroll
        for (int half = 0; half < 2; ++half) {
            const float* keys = half ? keys2 : keys1;
            float s[2];
#pragma unroll
            for (int sl = 0; sl < 2; ++sl) {
                const float* kr = keys + (size_t)(lane + sl * 64) * 128;
                float a = 0.f;
#pragma unroll 8
                for (int c = 0; c < 128; c += 4) { float4 kv = *(const float4*)(kr + c); const float* qq = &sq[w][half * 128 + c]; a += kv.x * qq[0] + kv.y * qq[1] + kv.z * qq[2] + kv.w * qq[3]; }
                s[sl] = a;
            }
            for (int r = 0; r < 16; ++r) {
                float bv; int bi;
                if (s[0] >= s[1]) { bv = s[0]; bi = lane; } else { bv = s[1]; bi = lane + 64; }
#pragma unroll
                for (int o = 32; o > 0; o >>= 1) {
                    float ov = __shfl_xor(bv, o); int oi = __shfl_xor(bi, o);
                    if (ov > bv || (ov == bv && oi < bi)) { bv = ov; bi = oi; }
                }
                if (lane == 0) { sv[w][half][r] = bv; si[w][half][r] = bi; }
                if (bi == lane) s[0] = -INFINITY;
                if (bi == lane + 64) s[1] = -INFINITY;
            }
        }
        __syncthreads();
        float c[4];
#pragma unroll
        for (int j = 0; j < 4; ++j) { int ci = lane * 4 + j; c[j] = sv[w][0][ci >> 4] + sv[w][1][ci & 15]; }
        float myv = 0.f; int myc = 0;
        for (int r = 0; r < 16; ++r) {
            float bv = c[0]; int bi = lane * 4;
#pragma unroll
            for (int j = 1; j < 4; ++j) if (c[j] > bv) { bv = c[j]; bi = lane * 4 + j; }
#pragma unroll
            for (int o = 32; o > 0; o >>= 1) {
                float ov = __shfl_xor(bv, o); int oi = __shfl_xor(bi, o);
                if (ov > bv || (ov == bv && oi < bi)) { bv = ov; bi = oi; }
            }
            if (lane == r) { myv = bv; myc = bi; }
#pragma unroll
            for (int j = 0; j < 4; ++j) if (bi == lane * 4 + j) c[j] = -INFINITY;
        }
        float v = lane < 16 ? myv : -INFINITY;
        float mx = wave_max(v);
        float e = lane < 16 ? __expf(v - mx) : 0.f;
        float sum = wave_sum(e);
        if (lane < 16) {
            int ex = si[w][0][myc >> 4] * PEER_NKEYS + si[w][1][myc & 15];
            eidx[(size_t)t * 128 + h * 16 + lane] = ex;
            gate[(size_t)t * 128 + h * 16 + lane] = e / sum;
        }
    }
}

__device__ __forceinline__ void ph_peer_ffn(const float* __restrict__ hbuf, const int* __restrict__ eidx, const float* __restrict__ gate,
                                            const bf16* __restrict__ ub, const bf16* __restrict__ vb, const float* __restrict__ gam,
                                            const float* __restrict__ bet, float* __restrict__ out) {
    const int lane = threadIdx.x & 63;
    for (int t = blockIdx.x * NWAVE + (threadIdx.x >> 6); t < T_ALL; t += gridDim.x * NWAVE) {
        float x[16], acc[16];
        { const float* xr = hbuf + (size_t)t * D_MODEL + lane * 8;
          const float4 a = *(const float4*)xr, b = *(const float4*)(xr + 4), c = *(const float4*)(xr + 512), d = *(const float4*)(xr + 516);
          x[0] = a.x; x[1] = a.y; x[2] = a.z; x[3] = a.w; x[4] = b.x; x[5] = b.y; x[6] = b.z; x[7] = b.w;
          x[8] = c.x; x[9] = c.y; x[10] = c.z; x[11] = c.w; x[12] = d.x; x[13] = d.y; x[14] = d.z; x[15] = d.w; }
#pragma unroll
        for (int j = 0; j < 16; ++j) acc[j] = 0.f;
        for (int k = 0; k < 128; ++k) {
            const int e = eidx[(size_t)t * 128 + k];
            const float g = gate[(size_t)t * 128 + k];
            const bf16* ur = ub + (size_t)e * D_MODEL + lane * 8;
            float u0[8], u1[8];
            unpack8(*(const v4u*)ur, u0); unpack8(*(const v4u*)(ur + 512), u1);
            float d = 0.f;
#pragma unroll
            for (int j = 0; j < 8; ++j) d += u0[j] * x[j] + u1[j] * x[8 + j];
            d = wave_sum(d);
            const float wgt = g * gelu_f(d);
            const bf16* vr = vb + (size_t)e * D_MODEL + lane * 8;
            unpack8(*(const v4u*)vr, u0); unpack8(*(const v4u*)(vr + 512), u1);
#pragma unroll
            for (int j = 0; j < 8; ++j) { acc[j] += wgt * u0[j]; acc[8 + j] += wgt * u1[j]; }
        }
        float s = 0.f;
#pragma unroll
        for (int j = 0; j < 16; ++j) { acc[j] += ALPHA_F * x[j]; s += acc[j]; }
        s = wave_sum(s);
        const float mu = s * (1.0f / 1024.0f);
        float q = 0.f;
#pragma unroll
        for (int j = 0; j < 16; ++j) { acc[j] -= mu; q += acc[j] * acc[j]; }
        q = wave_sum(q);
        const float r = rsqrtf(q * (1.0f / 1024.0f) + LN_EPS);
        float* dst = ((t < T_PROMPT) ? out + OUT_YP + (size_t)t * D_MODEL : out + OUT_YS + (size_t)(t - T_PROMPT) * D_MODEL) + lane * 8;
#pragma unroll
        for (int q4 = 0; q4 < 4; ++q4) {
            const int eo = (q4 >> 1) * 512 + (q4 & 1) * 4;
            const float4 g4 = *(const float4*)(gam + lane * 8 + eo), b4 = *(const float4*)(bet + lane * 8 + eo);
            float4 o; o.x = acc[q4 * 4 + 0] * r * g4.x + b4.x; o.y = acc[q4 * 4 + 1] * r * g4.y + b4.y; o.z = acc[q4 * 4 + 2] * r * g4.z + b4.z; o.w = acc[q4 * 4 + 3] * r * g4.w + b4.w;
            *(float4*)(dst + eo) = o;
        }
    }
}

__device__ __forceinline__ float peer_dot16(const v4u a, const v4u b, const float (&x)[16]) {
    float u0[8], u1[8]; unpack8(a, u0); unpack8(b, u1);
    float d = 0.f;
#pragma unroll
    for (int j = 0; j < 8; ++j) d += u0[j] * x[j] + u1[j] * x[8 + j];
    return d;
}
#define PEER_TR_STEP(N, M) _Pragma("unroll") for (int i = 0; i < N; ++i) { const bool up = (lane & M) != 0; const float keep = up ? part[i + N] : part[i]; const float send = up ? part[i] : part[i + N]; part[i] = keep + __shfl_xor(send, M); }
__device__ __forceinline__ void ph_peer_ffn2(const float* __restrict__ hbuf, const int* __restrict__ eidx, const float* __restrict__ gate,
                                             const bf16* __restrict__ ub, const bf16* __restrict__ vb, const float* __restrict__ gam,
                                             const float* __restrict__ bet, float* __restrict__ out) {
    const int lane0 = threadIdx.x & 63;
    for (int t = blockIdx.x * NWAVE + (threadIdx.x >> 6); t < T_ALL; t += gridDim.x * NWAVE) {
        int lane = lane0; asm volatile("" : "+v"(lane));
        float x[16];
        { const float* xr = hbuf + (size_t)t * D_MODEL + lane * 8;
          const float4 a = *(const float4*)xr, b = *(const float4*)(xr + 4), c = *(const float4*)(xr + 512), d = *(const float4*)(xr + 516);
          x[0] = a.x; x[1] = a.y; x[2] = a.z; x[3] = a.w; x[4] = b.x; x[5] = b.y; x[6] = b.z; x[7] = b.w;
          x[8] = c.x; x[9] = c.y; x[10] = c.z; x[11] = c.w; x[12] = d.x; x[13] = d.y; x[14] = d.z; x[15] = d.w; }
        int ev[2]; float wv[4];
        ev[0] = eidx[(size_t)t * 128 + lane]; ev[1] = eidx[(size_t)t * 128 + 64 + lane];
#pragma unroll
        for (int rd = 0; rd < 4; ++rd) wv[rd] = gate[(size_t)t * 128 + rd * 32 + (lane >> 1)];
#pragma unroll
        for (int rd = 0; rd < 4; ++rd) {
            float part[32];
#pragma unroll
            for (int kb = 0; kb < 8; ++kb) {
                v4u ra[4], rb[4];
#pragma unroll
                for (int k8 = 0; k8 < 4; ++k8) {
                    const int e = __builtin_amdgcn_readlane(ev[rd >> 1], (rd & 1) * 32 + kb * 4 + k8);
                    const bf16* ur = ub + (size_t)e * D_MODEL + lane * 8;
                    ra[k8] = *(const v4u*)ur; rb[k8] = *(const v4u*)(ur + 512);
                }
#pragma unroll
                for (int k8 = 0; k8 < 4; ++k8) part[kb * 4 + k8] = peer_dot16(ra[k8], rb[k8], x);
            }
            PEER_TR_STEP(16, 32) PEER_TR_STEP(8, 16) PEER_TR_STEP(4, 8) PEER_TR_STEP(2, 4) PEER_TR_STEP(1, 2)
            const float hid = part[0] + __shfl_xor(part[0], 1);
            wv[rd] *= gelu_f(hid);
        }
        float acc[16];
#pragma unroll
        for (int j = 0; j < 16; ++j) acc[j] = 0.f;
#pragma unroll
        for (int rd = 0; rd < 4; ++rd) {
#pragma unroll
            for (int kb = 0; kb < 4; ++kb) {
                v4u ra[8], rb[8];
#pragma unroll
                for (int k8 = 0; k8 < 8; ++k8) {
                    const int e = __builtin_amdgcn_readlane(ev[rd >> 1], (rd & 1) * 32 + kb * 8 + k8);
                    const bf16* vr = vb + (size_t)e * D_MODEL + lane * 8;
                    ra[k8] = *(const v4u*)vr; rb[k8] = *(const v4u*)(vr + 512);
                }
#pragma unroll
                for (int k8 = 0; k8 < 8; ++k8) {
                    const float wk = __builtin_bit_cast(float, __builtin_amdgcn_readlane(__builtin_bit_cast(int, wv[rd]), 2 * (kb * 8 + k8)));
                    float u0[8], u1[8]; unpack8(ra[k8], u0); unpack8(rb[k8], u1);
#pragma unroll
                    for (int j = 0; j < 8; ++j) { acc[j] += wk * u0[j]; acc[8 + j] += wk * u1[j]; }
                }
            }
        }
        float s = 0.f;
#pragma unroll
        for (int j = 0; j < 16; ++j) { acc[j] += ALPHA_F * x[j]; s += acc[j]; }
        s = wave_sum(s);
        const float mu = s * (1.0f / 1024.0f);
        float q = 0.f;
#pragma unroll
        for (int j = 0; j < 16; ++j) { acc[j] -= mu; q += acc[j] * acc[j]; }
        q = wave_sum(q);
        const float r = rsqrtf(q * (1.0f / 1024.0f) + LN_EPS);
        float* dst = ((t < T_PROMPT) ? out + OUT_YP + (size_t)t * D_MODEL : out + OUT_YS + (size_t)(t - T_PROMPT) * D_MODEL) + lane * 8;
#pragma unroll
        for (int q4 = 0; q4 < 4; ++q4) {
            const int eo = (q4 >> 1) * 512 + (q4 & 1) * 4;
            const float4 g4 = *(const float4*)(gam + lane * 8 + eo), b4 = *(const float4*)(bet + lane * 8 + eo);
            float4 o; o.x = acc[q4 * 4 + 0] * r * g4.x + b4.x; o.y = acc[q4 * 4 + 1] * r * g4.y + b4.y; o.z = acc[q4 * 4 + 2] * r * g4.z + b4.z; o.w = acc[q4 * 4 + 3] * r * g4.w + b4.w;
            *(float4*)(dst + eo) = o;
        }
    }
}

__device__ __forceinline__ void ph_attn_sample(float* lds, const bf16* __restrict__ qrot_b, const bf16* __restrict__ krot_b, const bf16* __restrict__ projb,
                                               const float* __restrict__ ck, const float* __restrict__ cv, bf16* __restrict__ A1) {
    float (*sq)[64] = (float (*)[64])lds;
    const int w = threadIdx.x >> 6, lane0 = threadIdx.x & 63;
    for (int vb = blockIdx.x; vb < T_SAMPLE * 8 / NWAVE; vb += gridDim.x) {
        int lane = lane0; asm volatile("" : "+v"(lane));
        const int item = vb * NWAVE + w, ts = item >> 3, hd = item & 7, b = ts >> 2, i = ts & 3, t = T_PROMPT + ts;
        __syncthreads();
        sq[w][lane] = bf2f(qrot_b[(size_t)t * ATT_WIDTH + hd * 64 + lane]);
        __syncthreads();
        const int qi = WBUF + i;
        float sc[8];
        float mx = -INFINITY;
#pragma unroll
        for (int slot = 0; slot < 7; ++slot) {
            const int pt = slot < 6 ? (slot >> 1) : (lane < 3 ? lane : 0);
            const int m = slot < 6 ? lane + 64 * (slot & 1) : 128;
            const int kj = qi - (m << (2 * pt));
            const bool valid = (slot < 6 || lane < 3) && kj < WBUF;
            const int kc = kj < WBUF ? kj : WBUF - 1;
            const float* kr = ck + ((size_t)b * WBUF + kc) * ATT_WIDTH + hd * 64;
            float a = 0.f;
#pragma unroll
            for (int c = 0; c < 64; c += 4) { const float4 kv = *(const float4*)(kr + c); a += kv.x * sq[w][c] + kv.y * sq[w][c + 1] + kv.z * sq[w][c + 2] + kv.w * sq[w][c + 3]; }
            const float s = valid ? a * 0.125f : -INFINITY;
            sc[slot] = s; mx = fmaxf(mx, s);
        }
        const int nt7 = lane <= i ? i - lane : i;
        const bool valid7 = lane < i + 3;
        {
            const bf16* kr = krot_b + (size_t)(T_PROMPT + b * DEC_SEQ + nt7) * ATT_WIDTH + hd * 64;
            float a = 0.f;
#pragma unroll
            for (int c = 0; c < 64; c += 8) { float f[8]; unpack8(*(const v4u*)(kr + c), f);
#pragma unroll
                for (int j = 0; j < 8; ++j) a += f[j] * sq[w][c + j]; }
            const float s = valid7 ? a * 0.125f : -INFINITY;
            sc[7] = s; mx = fmaxf(mx, s);
        }
        mx = wave_max(mx);
        float lsum = 0.f;
#pragma unroll
        for (int slot = 0; slot < 8; ++slot) { const float pv = __expf(sc[slot] - mx); sc[slot] = pv; lsum += pv; }
        lsum = wave_sum(lsum);
        float part[64];
#pragma unroll
        for (int c = 0; c < 64; ++c) part[c] = 0.f;
#pragma unroll
        for (int slot = 0; slot < 7; ++slot) {
            const int pt = slot < 6 ? (slot >> 1) : (lane < 3 ? lane : 0);
            const int m = slot < 6 ? lane + 64 * (slot & 1) : 128;
            const int kj = qi - (m << (2 * pt));
            const int kc = kj < WBUF ? kj : WBUF - 1;
            const float pv = sc[slot];
            const float* vr = cv + ((size_t)b * WBUF + kc) * ATT_WIDTH + hd * 64;
#pragma unroll
            for (int c = 0; c < 64; c += 4) { const float4 vv = *(const float4*)(vr + c); part[c] += pv * vv.x; part[c + 1] += pv * vv.y; part[c + 2] += pv * vv.z; part[c + 3] += pv * vv.w; }
        }
        {
            const float pv = sc[7];
            const bf16* vr = projb + (size_t)(T_PROMPT + b * DEC_SEQ + nt7) * NB_LD + NB_V + hd * 64;
#pragma unroll
            for (int c = 0; c < 64; c += 8) { float f[8]; unpack8(*(const v4u*)(vr + c), f);
#pragma unroll
                for (int j = 0; j < 8; ++j) part[c + j] += pv * f[j]; }
        }
        PEER_TR_STEP(32, 32) PEER_TR_STEP(16, 16) PEER_TR_STEP(8, 8) PEER_TR_STEP(4, 4) PEER_TR_STEP(2, 2) PEER_TR_STEP(1, 1)
        A1[(size_t)t * MIX_WIDTH + SSD_WIDTH + hd * 64 + lane] = (bf16)f2bf(part[0] / lsum);
    }
}


__device__ __forceinline__ void cache_copy_slice(const float* __restrict__ ck, const float* __restrict__ cv, float* __restrict__ out, unsigned slice, unsigned lane) {
    constexpr unsigned PER_B = (WBUF - DEC_SEQ) * ATT_WIDTH / 4;
    constexpr unsigned TOTAL = 2u * DEC_BATCH * PER_B;
#pragma unroll 1
    for (unsigned bt = 0; bt < 8; ++bt) {
        f32x4n v[8]; size_t dsti[8]; bool isv[8]; bool ok[8];
#pragma unroll
        for (int j = 0; j < 8; ++j) {
            const unsigned idx = slice * 4096u + bt * 512u + j * 64u + lane;
            ok[j] = idx < TOTAL;
            const unsigned idc = ok[j] ? idx : 0u;
            const unsigned tb = idc / PER_B, r = idc - tb * PER_B, bb = tb & (DEC_BATCH - 1);
            isv[j] = tb >= DEC_BATCH;
            const size_t srci = (size_t)bb * (WBUF * ATT_WIDTH / 4) + (DEC_SEQ * ATT_WIDTH / 4) + r;
            dsti[j] = (size_t)bb * (WBUF * ATT_WIDTH / 4) + r;
            v[j] = __builtin_nontemporal_load((isv[j] ? (const f32x4n*)cv : (const f32x4n*)ck) + srci);
        }
#pragma unroll
        for (int j = 0; j < 8; ++j) if (ok[j]) __builtin_nontemporal_store(v[j], (f32x4n*)(out + (isv[j] ? OUT_SV : OUT_SK)) + dsti[j]);
    }
}

__device__ __forceinline__ void copy_q_load(const float* __restrict__ ck, const float* __restrict__ cv, unsigned q, unsigned lane, f32x4n (&v)[16]) {
    constexpr unsigned PER_B = (WBUF - DEC_SEQ) * ATT_WIDTH / 4, TOTAL = 2u * DEC_BATCH * PER_B;
#pragma unroll
    for (int j = 0; j < 16; ++j) {
        const unsigned idx = q * 1024u + j * 64u + lane, idc = idx < TOTAL ? idx : 0u;
        const unsigned tb = idc / PER_B, r = idc - tb * PER_B, bb = tb & (DEC_BATCH - 1);
        const size_t srci = (size_t)bb * (WBUF * ATT_WIDTH / 4) + (DEC_SEQ * ATT_WIDTH / 4) + r;
        v[j] = __builtin_nontemporal_load((tb >= DEC_BATCH ? (const f32x4n*)cv : (const f32x4n*)ck) + srci);
    }
}
__device__ __forceinline__ void copy_q_store(float* __restrict__ out, unsigned q, unsigned lane, const f32x4n (&v)[16]) {
    constexpr unsigned PER_B = (WBUF - DEC_SEQ) * ATT_WIDTH / 4, TOTAL = 2u * DEC_BATCH * PER_B;
#pragma unroll
    for (int j = 0; j < 16; ++j) {
        const unsigned idx = q * 1024u + j * 64u + lane;
        if (idx < TOTAL) {
            const unsigned tb = idx / PER_B, r = idx - tb * PER_B, bb = tb & (DEC_BATCH - 1);
            const size_t dsti = (size_t)bb * (WBUF * ATT_WIDTH / 4) + r;
            __builtin_nontemporal_store(v[j], (f32x4n*)(out + (tb >= DEC_BATCH ? OUT_SV : OUT_SK)) + dsti);
        }
    }
}
typedef float f32x2v __attribute__((ext_vector_type(2)));
typedef unsigned u32x6 __attribute__((ext_vector_type(6)));
typedef float f32x32 __attribute__((ext_vector_type(32)));
typedef float f32x16q __attribute__((ext_vector_type(16)));
struct __attribute__((aligned(4))) u3w { unsigned x, y, z; };
#define PEER_ROWB 768
__device__ __forceinline__ void ph_quant_tables(const float* __restrict__ pu, const float* __restrict__ pv, unsigned char* __restrict__ ub8, unsigned char* __restrict__ vb8,
                                                float* __restrict__ usc, float* __restrict__ vsc, int rank, int nranks) {
    const int lane = threadIdx.x & 63;
#pragma unroll 2
    for (int row = rank * NWAVE + (threadIdx.x >> 6); row < 2 * 16384; row += nranks * NWAVE) {
        const int rr = row & 16383; const bool isv = row >= 16384;
        const float* src = (isv ? pv : pu) + (size_t)rr * D_MODEL + lane * 8;
        const float4 a = *(const float4*)src, b = *(const float4*)(src + 4), c = *(const float4*)(src + 512), d = *(const float4*)(src + 516);
        float am = fmaxf(fmaxf(fmaxf(fabsf(a.x), fabsf(a.y)), fmaxf(fabsf(a.z), fabsf(a.w))), fmaxf(fmaxf(fabsf(b.x), fabsf(b.y)), fmaxf(fabsf(b.z), fabsf(b.w))));
        am = fmaxf(am, fmaxf(fmaxf(fmaxf(fabsf(c.x), fabsf(c.y)), fmaxf(fabsf(c.z), fabsf(c.w))), fmaxf(fmaxf(fabsf(d.x), fabsf(d.y)), fmaxf(fabsf(d.z), fabsf(d.w)))));
        am = wave_max(am);
        const float sc = am > 0.f ? 7.5f / am : 1.0f;
        f32x16q e0, e1;
#pragma unroll
        for (int i = 0; i < 16; ++i) { e0[i] = 0.f; e1[i] = 0.f; }
        e0[0] = a.x * sc; e1[0] = a.y * sc; e0[1] = a.z * sc; e1[1] = a.w * sc; e0[2] = b.x * sc; e1[2] = b.y * sc; e0[3] = b.z * sc; e1[3] = b.w * sc;
        e0[4] = c.x * sc; e1[4] = c.y * sc; e0[5] = c.z * sc; e1[5] = c.w * sc; e0[6] = d.x * sc; e1[6] = d.y * sc; e0[7] = d.z * sc; e1[7] = d.w * sc;
        const u32x6 qv = __builtin_amdgcn_cvt_scalef32_2xpk16_fp6_f32(e0, e1, 1.0f);
        u3w o; o.x = qv[0]; o.y = qv[1]; o.z = qv[2];
        *(u3w*)((isv ? vb8 : ub8) + (size_t)rr * PEER_ROWB + lane * 12) = o;
        if (lane == 0) (isv ? vsc : usc)[rr] = am > 0.f ? am * (1.0f / 7.5f) : 1.0f;
    }
}
__device__ __forceinline__ void unpack16_fp8(const v4u w, float (&f)[16]) {
#pragma unroll
    for (int i = 0; i < 4; ++i) {
        const f32x2v lo = __builtin_amdgcn_cvt_pk_f32_fp8((int)w[i], false), hi = __builtin_amdgcn_cvt_pk_f32_fp8((int)w[i], true);
        f[4 * i] = lo[0]; f[4 * i + 1] = lo[1]; f[4 * i + 2] = hi[0]; f[4 * i + 3] = hi[1];
    }
}
__device__ __forceinline__ unsigned ffn_slice(unsigned n9, unsigned it) {
    const unsigned w = (unsigned)__builtin_amdgcn_readfirstlane(threadIdx.x >> 6), wgl = blockIdx.x * NWAVE + w;
    if (gridDim.x != 256) return n9 + wgl + it * (gridDim.x * NWAVE);
    unsigned v;
    if (w < 2u) { if (it == 0u) v = 0u; else if (it == 4u) v = 1u; else return 0xffffffffu; }
    else { if (it == 7u) v = 4u; else if ((it & 1u) == 0u) v = it >> 1; else return 0xffffffffu; }
    if (v < 2u) return n9 + v * 2048u + wgl;
    const unsigned lw = blockIdx.x * 6u + (w - 2u);
    if (v < 4u) return n9 + 4096u + (v - 2u) * 1536u + lw;
    if (lw < 256u) return n9 + 7168u + lw;
    return 0xffffffffu;
}
__device__ __forceinline__ void ph_peer_ffn3(const bf16* __restrict__ hb, const int* __restrict__ eidx, const float* __restrict__ gate,
                                             const unsigned char* __restrict__ ub8, const unsigned char* __restrict__ vb8, const float* __restrict__ usc, const float* __restrict__ vsc,
                                             const float* __restrict__ gam, const float* __restrict__ bet, float* __restrict__ out,
                                             const float* __restrict__ ck, const float* __restrict__ cv, unsigned n9) {
    const int lane0 = threadIdx.x & 63;
    unsigned it = 0;
    for (;; ++it) {
        const int t = token_of_iter((int)it);
        if (t < 0) break;
        int lane = lane0; asm volatile("" : "+v"(lane));
        { const unsigned sl = ffn_slice(n9, it); if (sl < 16384u) cache_copy_slice(ck, cv, out, sl, (unsigned)lane); }
        const unsigned lo12 = (unsigned)lane * 12u, lo8 = (unsigned)lane * 8u;
        float x[16];
        { float f0[8], f1[8]; const bf16* xr = hb + (size_t)t * D_MODEL + lo8; unpack8(*(const v4u*)xr, f0); unpack8(*(const v4u*)(xr + 512), f1);
#pragma unroll
          for (int j = 0; j < 8; ++j) { x[j] = f0[j]; x[8 + j] = f1[j]; } }
        int ev[2]; float wv[4], su[4];
        ev[0] = eidx[(size_t)t * 128 + lane]; ev[1] = eidx[(size_t)t * 128 + 64 + lane];
#pragma unroll
        for (int rd = 0; rd < 4; ++rd) {
            const int er = eidx[(size_t)t * 128 + rd * 32 + (lane >> 1)];
            wv[rd] = gate[(size_t)t * 128 + rd * 32 + (lane >> 1)] * vsc[er];
            su[rd] = usc[er];
        }
#pragma unroll
        for (int rd = 0; rd < 4; ++rd) {
            float part[32];
#pragma unroll
            for (int kb = 0; kb < 2; ++kb) {
                u3w ra[16];
#pragma unroll
                for (int k8 = 0; k8 < 16; ++k8) {
                    const int e = __builtin_amdgcn_readlane(ev[rd >> 1], (rd & 1) * 32 + kb * 16 + k8);
                    ra[k8] = *(const u3w*)(ub8 + (size_t)e * PEER_ROWB + lo12);
                }
#pragma unroll
                for (int k8 = 0; k8 < 16; k8 += 2) {
                    u32x6 sv; sv[0] = ra[k8].x; sv[1] = ra[k8].y; sv[2] = ra[k8].z; sv[3] = ra[k8 + 1].x; sv[4] = ra[k8 + 1].y; sv[5] = ra[k8 + 1].z;
                    const f32x32 f = __builtin_amdgcn_cvt_scalef32_pk32_f32_fp6(sv, 1.0f);
                    f32x2v d0 = {0.f, 0.f}, d1 = {0.f, 0.f};
#pragma unroll
                    for (int i = 0; i < 8; ++i) {
                        d0 += (f32x2v){f[2 * i], f[2 * i + 1]} * (f32x2v){x[2 * i], x[2 * i + 1]};
                        d1 += (f32x2v){f[16 + 2 * i], f[17 + 2 * i]} * (f32x2v){x[2 * i], x[2 * i + 1]};
                    }
                    part[kb * 16 + k8] = d0[0] + d0[1]; part[kb * 16 + k8 + 1] = d1[0] + d1[1];
                    __builtin_amdgcn_sched_barrier(0);
                }
            }
            PEER_TR_STEP(16, 32) PEER_TR_STEP(8, 16) PEER_TR_STEP(4, 8) PEER_TR_STEP(2, 4) PEER_TR_STEP(1, 2)
            const float hid = (part[0] + __shfl_xor(part[0], 1)) * su[rd];
            wv[rd] *= gelu_f(hid);
        }
        f32x2v accp[8];
#pragma unroll
        for (int i = 0; i < 8; ++i) accp[i] = (f32x2v){0.f, 0.f};
#pragma unroll
        for (int rd = 0; rd < 4; ++rd) {
#pragma unroll
            for (int kb = 0; kb < 2; ++kb) {
                u3w ra[16];
#pragma unroll
                for (int k8 = 0; k8 < 16; ++k8) {
                    const int e = __builtin_amdgcn_readlane(ev[rd >> 1], (rd & 1) * 32 + kb * 16 + k8);
                    ra[k8] = *(const u3w*)(vb8 + (size_t)e * PEER_ROWB + lo12);
                }
#pragma unroll
                for (int k8 = 0; k8 < 16; k8 += 2) {
                    const float wk0 = __builtin_bit_cast(float, __builtin_amdgcn_readlane(__builtin_bit_cast(int, wv[rd]), 2 * (kb * 16 + k8)));
                    const float wk1 = __builtin_bit_cast(float, __builtin_amdgcn_readlane(__builtin_bit_cast(int, wv[rd]), 2 * (kb * 16 + k8 + 1)));
                    u32x6 sv; sv[0] = ra[k8].x; sv[1] = ra[k8].y; sv[2] = ra[k8].z; sv[3] = ra[k8 + 1].x; sv[4] = ra[k8 + 1].y; sv[5] = ra[k8 + 1].z;
                    const f32x32 f = __builtin_amdgcn_cvt_scalef32_pk32_f32_fp6(sv, 1.0f);
#pragma unroll
                    for (int i = 0; i < 8; ++i) {
                        accp[i] += (f32x2v){wk0, wk0} * (f32x2v){f[2 * i], f[2 * i + 1]};
                        accp[i] += (f32x2v){wk1, wk1} * (f32x2v){f[16 + 2 * i], f[17 + 2 * i]};
                    }
                    __builtin_amdgcn_sched_barrier(0);
                }
            }
        }
        float acc[16];
#pragma unroll
        for (int i = 0; i < 8; ++i) { acc[2 * i] = accp[i][0]; acc[2 * i + 1] = accp[i][1]; }
        float s = 0.f;
#pragma unroll
        for (int j = 0; j < 16; ++j) { acc[j] += ALPHA_F * x[j]; s += acc[j]; }
        s = wave_sum(s);
        const float mu = s * (1.0f / 1024.0f);
        float q = 0.f;
#pragma unroll
        for (int j = 0; j < 16; ++j) { acc[j] -= mu; q += acc[j] * acc[j]; }
        q = wave_sum(q);
        const float r = rsqrtf(q * (1.0f / 1024.0f) + LN_EPS);
        float* dst = ((t < T_PROMPT) ? out + OUT_YP + (size_t)t * D_MODEL : out + OUT_YS + (size_t)(t - T_PROMPT) * D_MODEL) + lo8;
#pragma unroll
        for (int q4 = 0; q4 < 4; ++q4) {
            const int eo = (q4 >> 1) * 512 + (q4 & 1) * 4;
            const float4 g4 = *(const float4*)(gam + lo8 + eo), b4 = *(const float4*)(bet + lo8 + eo);
            float4 o; o.x = acc[q4 * 4 + 0] * r * g4.x + b4.x; o.y = acc[q4 * 4 + 1] * r * g4.y + b4.y; o.z = acc[q4 * 4 + 2] * r * g4.z + b4.z; o.w = acc[q4 * 4 + 3] * r * g4.w + b4.w;
            *(float4*)(dst + eo) = o;
        }
    }
    for (;; ++it) {
        if (gridDim.x == 256 && it >= 5u) break;
        const unsigned sl = ffn_slice(n9, it);
        if (gridDim.x != 256 && sl >= 16384u) break;
        if (sl < 16384u) cache_copy_slice(ck, cv, out, sl, (unsigned)lane0);
    }
}


__device__ __forceinline__ void ssd_decode_load(const bf16* __restrict__ xbc_b, const float* __restrict__ dtv, const float* __restrict__ state_ssm, int item, int p, int ng,
                                                float (&hs)[16], v4u (&bq)[4][2], v4u (&cq)[4][2], float (&xv)[4], float (&dv)[4]) {
    const int sb = item / SSD_HEADS, h = item - sb * SSD_HEADS, g = h / 6, t0 = T_PROMPT + sb * DEC_SEQ;
    const float* s0 = state_ssm + (((size_t)sb * SSD_HEADS + h) * 64 + p) * 128 + ng * 16;
#pragma unroll
    for (int j = 0; j < 4; ++j) { const float4 v = *(const float4*)(s0 + 4 * j); hs[4 * j] = v.x; hs[4 * j + 1] = v.y; hs[4 * j + 2] = v.z; hs[4 * j + 3] = v.w; }
#pragma unroll
    for (int s = 0; s < 4; ++s) {
        const bf16* row = xbc_b + (size_t)(t0 + s) * CONV_DIM;
        bq[s][0] = *(const v4u*)(row + 1536 + g * 128 + ng * 16); bq[s][1] = *(const v4u*)(row + 1536 + g * 128 + ng * 16 + 8);
        cq[s][0] = *(const v4u*)(row + 2048 + g * 128 + ng * 16); cq[s][1] = *(const v4u*)(row + 2048 + g * 128 + ng * 16 + 8);
        xv[s] = bf2f(row[h * 64 + p]); dv[s] = dtv[(size_t)(t0 + s) * SSD_HEADS + h];
    }
}
__device__ __forceinline__ void ssd_decode_compute(const float* __restrict__ a_log, const float* __restrict__ d_skip, int item, int p, int ng,
                                                   float (&hs)[16], const v4u (&bq)[4][2], const v4u (&cq)[4][2], const float (&xv)[4], const float (&dv)[4],
                                                   float* __restrict__ ybuf, float* __restrict__ out) {
    const int sb = item / SSD_HEADS, h = item - sb * SSD_HEADS, t0 = T_PROMPT + sb * DEC_SEQ;
    const float A = -__expf(a_log[h]), D = d_skip[h];
#pragma unroll
    for (int s = 0; s < 4; ++s) {
        float Bf[16], Cf[16];
        { float t8[8]; unpack8(bq[s][0], t8);
#pragma unroll
          for (int j = 0; j < 8; ++j) Bf[j] = t8[j];
          unpack8(bq[s][1], t8);
#pragma unroll
          for (int j = 0; j < 8; ++j) Bf[8 + j] = t8[j];
          unpack8(cq[s][0], t8);
#pragma unroll
          for (int j = 0; j < 8; ++j) Cf[j] = t8[j];
          unpack8(cq[s][1], t8);
#pragma unroll
          for (int j = 0; j < 8; ++j) Cf[8 + j] = t8[j]; }
        const float a = __expf(dv[s] * A), xdt = xv[s] * dv[s];
        float y = 0.f;
#pragma unroll
        for (int j = 0; j < 16; ++j) { hs[j] = a * hs[j] + xdt * Bf[j]; y += Cf[j] * hs[j]; }
        y += __shfl_xor(y, 1); y += __shfl_xor(y, 2); y += __shfl_xor(y, 4);
        if (ng == 0) ybuf[(size_t)(t0 + s) * MIX_WIDTH + h * 64 + p] = y + D * xv[s];
    }
    float* so = out + OUT_SS + (((size_t)sb * SSD_HEADS + h) * 64 + p) * 128 + ng * 16;
#pragma unroll
    for (int j = 0; j < 4; ++j) *(float4*)(so + 4 * j) = make_float4(hs[4 * j], hs[4 * j + 1], hs[4 * j + 2], hs[4 * j + 3]);
}
__device__ __forceinline__ void ph_ssd_decode(const bf16* __restrict__ xbc_b, const float* __restrict__ dtv, const float* __restrict__ a_log, const float* __restrict__ d_skip,
                                              const float* __restrict__ state_ssm, float* __restrict__ ybuf, float* __restrict__ out) {
    const int tid = threadIdx.x, p = tid >> 3, ng = tid & 7;
    constexpr int NITEM = DEC_BATCH * SSD_HEADS;
    for (int it = blockIdx.x; it < NITEM; it += 2 * gridDim.x) {
        const int it2 = it + gridDim.x; const bool has2 = it2 < NITEM; const int it2c = has2 ? it2 : it;
        float hsA[16], hsB[16], xA[4], xB[4], dA[4], dB[4]; v4u bA[4][2], cA[4][2], bB[4][2], cB[4][2];
        ssd_decode_load(xbc_b, dtv, state_ssm, it, p, ng, hsA, bA, cA, xA, dA);
        ssd_decode_load(xbc_b, dtv, state_ssm, it2c, p, ng, hsB, bB, cB, xB, dB);
        ssd_decode_compute(a_log, d_skip, it, p, ng, hsA, bA, cA, xA, dA, ybuf, out);
        if (has2) ssd_decode_compute(a_log, d_skip, it2, p, ng, hsB, bB, cB, xB, dB, ybuf, out);
    }
}

__device__ __forceinline__ float samp_cw(int d) { return (float)((int)(d >= 0 && d <= 128) + (int)(d >= 0 && (d & 3) == 0 && d <= 512) + (int)(d >= 0 && (d & 15) == 0 && d <= 2048)); }
__device__ __forceinline__ void samp_update(float sv, float cw, const float (&vrow)[64], float& m, float& l, float (&part)[64]) {
    const float mn = fmaxf(m, sv), alpha = __expf(m - mn), p = cw * __expf(sv - mn);
    m = mn; l = l * alpha + p;
#pragma unroll
    for (int c = 0; c < 64; ++c) part[c] = part[c] * alpha + p * vrow[c];
}
__device__ __forceinline__ void ph_attn_sample3(float* lds, const bf16* __restrict__ qrot_b, const bf16* __restrict__ krot_b, const bf16* __restrict__ projb,
                                                const float* __restrict__ ck, const float* __restrict__ cv, bf16* __restrict__ A1) {
    const int lane0 = threadIdx.x & 63, w = __builtin_amdgcn_readfirstlane(threadIdx.x >> 6);
    float* sq = lds + w * 256;
    for (int item = blockIdx.x + gridDim.x * w; item < DEC_BATCH * ATT_HEADS; item += gridDim.x * NWAVE) {
        int lane = lane0; asm volatile("" : "+v"(lane));
        const int b = item >> 3, hd = item & 7, qi = lane & 3, g = lane >> 2;
        const int tq0 = T_PROMPT + b * DEC_SEQ;
#pragma unroll
        for (int i = 0; i < 4; ++i) sq[i * 64 + lane] = bf2f(qrot_b[(size_t)(tq0 + i) * ATT_WIDTH + hd * 64 + lane]);
        asm volatile("s_waitcnt lgkmcnt(0)" ::: "memory");
        const float* qv = sq + qi * 64;
        const float* ckb = ck + (size_t)b * WBUF * ATT_WIDTH + hd * 64; const float* cvb = cv + (size_t)b * WBUF * ATT_WIDTH + hd * 64;
        float m = -1e30f, l = 0.f, part[64];
#pragma unroll
        for (int c = 0; c < 64; ++c) part[c] = 0.f;
        {
            const int P = 2051 - g;
            const float cw = samp_cw(WBUF + qi - P);
            const bool isn = P >= WBUF;
            const int nt = isn ? P - WBUF : 0, Pc = isn ? WBUF - 1 : P;
            const bf16* kn = krot_b + (size_t)(tq0 + nt) * ATT_WIDTH + hd * 64; const float* kr = ckb + (size_t)Pc * ATT_WIDTH;
            float a = 0.f;
#pragma unroll
            for (int c = 0; c < 64; c += 8) { float f[8]; unpack8(*(const v4u*)(kn + c), f); const float4 k0 = *(const float4*)(kr + c), k1 = *(const float4*)(kr + c + 4);
                a += (isn ? f[0] : k0.x) * qv[c] + (isn ? f[1] : k0.y) * qv[c + 1] + (isn ? f[2] : k0.z) * qv[c + 2] + (isn ? f[3] : k0.w) * qv[c + 3]
                   + (isn ? f[4] : k1.x) * qv[c + 4] + (isn ? f[5] : k1.y) * qv[c + 5] + (isn ? f[6] : k1.z) * qv[c + 6] + (isn ? f[7] : k1.w) * qv[c + 7]; }
            const float sv = cw > 0.f ? a * 0.125f : -1e30f;
            const bf16* vn = projb + (size_t)(tq0 + nt) * NB_LD + NB_V + hd * 64; const float* vr = cvb + (size_t)Pc * ATT_WIDTH;
            float vrow[64];
#pragma unroll
            for (int c = 0; c < 64; c += 8) { float f[8]; unpack8(*(const v4u*)(vn + c), f); const float4 v0 = *(const float4*)(vr + c), v1 = *(const float4*)(vr + c + 4);
                vrow[c] = isn ? f[0] : v0.x; vrow[c + 1] = isn ? f[1] : v0.y; vrow[c + 2] = isn ? f[2] : v0.z; vrow[c + 3] = isn ? f[3] : v0.w;
                vrow[c + 4] = isn ? f[4] : v1.x; vrow[c + 5] = isn ? f[5] : v1.y; vrow[c + 6] = isn ? f[6] : v1.z; vrow[c + 7] = isn ? f[7] : v1.w; }
            samp_update(sv, cw, vrow, m, l, part);
        }
#pragma unroll 1
        for (int s = 1; s < 21; ++s) {
            const int P = s < 9 ? 2051 - (16 * s + g) : (s < 15 ? 1536 + 64 * (s - 9) + lane : qi + 16 * (16 * (s - 15) + g));
            const float cw = (s < 9 && P < 1920) ? 0.f : samp_cw(WBUF + qi - P);
            const float* kr = ckb + (size_t)P * ATT_WIDTH;
            float a = 0.f;
#pragma unroll
            for (int c = 0; c < 64; c += 4) { const float4 kv = *(const float4*)(kr + c); a += kv.x * qv[c] + kv.y * qv[c + 1] + kv.z * qv[c + 2] + kv.w * qv[c + 3]; }
            const float sv = cw > 0.f ? a * 0.125f : -1e30f;
            __builtin_amdgcn_sched_barrier(0);
            const float* vr = cvb + (size_t)P * ATT_WIDTH;
            float vrow[64];
#pragma unroll
            for (int c = 0; c < 64; c += 4) { const float4 vv = *(const float4*)(vr + c); vrow[c] = vv.x; vrow[c + 1] = vv.y; vrow[c + 2] = vv.z; vrow[c + 3] = vv.w; }
            samp_update(sv, cw, vrow, m, l, part);
        }
        float M = m;
        M = fmaxf(M, __shfl_xor(M, 4)); M = fmaxf(M, __shfl_xor(M, 8)); M = fmaxf(M, __shfl_xor(M, 16)); M = fmaxf(M, __shfl_xor(M, 32));
        const float sc = __expf(m - M);
        float lsum = l * sc;
        lsum += __shfl_xor(lsum, 4); lsum += __shfl_xor(lsum, 8); lsum += __shfl_xor(lsum, 16); lsum += __shfl_xor(lsum, 32);
#pragma unroll
        for (int c = 0; c < 64; ++c) part[c] *= sc;
        PEER_TR_STEP(32, 32) PEER_TR_STEP(16, 16) PEER_TR_STEP(8, 8) PEER_TR_STEP(4, 4)
        const float inv = 1.0f / lsum;
        *(uint2*)(A1 + (size_t)(tq0 + qi) * MIX_WIDTH + SSD_WIDTH + hd * 64 + 4 * g) = make_uint2(pk2(part[0] * inv, part[1] * inv), pk2(part[2] * inv, part[3] * inv));
    }
}

typedef float f32x16 __attribute__((ext_vector_type(16)));
typedef short s16x8 __attribute__((ext_vector_type(8)));
typedef short s16x4 __attribute__((ext_vector_type(4)));
typedef float f32x4v __attribute__((ext_vector_type(4)));
#define SSD_L_ACS 0
#define SSD_L_DTS 3072
#define SSD_L_BM 6144
#define SSD_RS_B 272
#define SSD_L_X (6144 + 128 * 272)
#define SSD_RS_X 144
#define SSD_XIMG (128 * 144)
#define SSD_RS_Y 784
template <int OFF0, int OFF1>
__device__ __forceinline__ s16x8 tr_frag(unsigned base) {
    s16x4 a, b;
    asm volatile("ds_read_b64_tr_b16 %0, %2 offset:%3\n\tds_read_b64_tr_b16 %1, %2 offset:%4\n\ts_waitcnt lgkmcnt(0)"
                 : "=&v"(a), "=&v"(b) : "v"(base), "n"(OFF0), "n"(OFF1) : "memory");
    return __builtin_shufflevector(a, b, 0, 1, 2, 3, 4, 5, 6, 7);
}
__device__ __forceinline__ unsigned lds_addr(LAS unsigned char* p) { return (unsigned)(size_t)p; }
template <int O0, int O1, int O2, int O3, int O4, int O5, int O6, int O7>
__device__ __forceinline__ void tr_read8(unsigned base, s16x4 (&v)[8]) {
    asm volatile("ds_read_b64_tr_b16 %0, %8 offset:%9\n\tds_read_b64_tr_b16 %1, %8 offset:%10\n\tds_read_b64_tr_b16 %2, %8 offset:%11\n\tds_read_b64_tr_b16 %3, %8 offset:%12\n\t"
                 "ds_read_b64_tr_b16 %4, %8 offset:%13\n\tds_read_b64_tr_b16 %5, %8 offset:%14\n\tds_read_b64_tr_b16 %6, %8 offset:%15\n\tds_read_b64_tr_b16 %7, %8 offset:%16\n\ts_waitcnt lgkmcnt(0)"
                 : "=&v"(v[0]), "=&v"(v[1]), "=&v"(v[2]), "=&v"(v[3]), "=&v"(v[4]), "=&v"(v[5]), "=&v"(v[6]), "=&v"(v[7])
                 : "v"(base), "n"(O0), "n"(O1), "n"(O2), "n"(O3), "n"(O4), "n"(O5), "n"(O6), "n"(O7) : "memory");
}
#define TRCAT(a, b) __builtin_shufflevector(a, b, 0, 1, 2, 3, 4, 5, 6, 7)


__device__ __forceinline__ void ssd_chunk_acs(LAS unsigned char* ldsb, const float* __restrict__ dtv, const float* __restrict__ a_log, int t0, int g, float* cdec_out) {
    const int w = __builtin_amdgcn_readfirstlane(threadIdx.x >> 6), lane = threadIdx.x & 63;
    if (w < 6) {
        const int head = 6 * g + w;
        const float A = -__expf(a_log[head]);
        const float v0 = dtv[(size_t)(t0 + 2 * lane) * SSD_HEADS + head], v1 = dtv[(size_t)(t0 + 2 * lane + 1) * SSD_HEADS + head];
        const float a1 = v1 * A;
        float s = v0 * A + a1;
#pragma unroll
        for (int o = 1; o < 64; o <<= 1) { const float tmp = __shfl_up(s, o); if (lane >= o) s += tmp; }
        LAS float* acs = (LAS float*)(ldsb + SSD_L_ACS) + w * 128;
        LAS float* dts = (LAS float*)(ldsb + SSD_L_DTS) + w * 128;
        acs[2 * lane] = s - a1; acs[2 * lane + 1] = s;
        dts[2 * lane] = v0; dts[2 * lane + 1] = v1;
        if (cdec_out && lane == 63) cdec_out[head] = __expf(s);
    }
}

__device__ __forceinline__ void ph_ssd_states(LAS unsigned char* ldsb, const bf16* __restrict__ xbc_b, const float* __restrict__ dtv, const float* __restrict__ a_log,
                                              bf16* __restrict__ Sbuf, float* __restrict__ cdec, const float* __restrict__ ck, const float* __restrict__ cv, float* __restrict__ out) {
    const int tid = threadIdx.x, w = __builtin_amdgcn_readfirstlane(tid >> 6), lane = tid & 63;
    const int r = lane & 31, h = lane >> 5, blk = (lane >> 4) & 1, q = (lane & 15) >> 2, pp = lane & 3;
    const int nt = w & 3, pt = w >> 2;
    for (int unit = blockIdx.x; unit < BATCH * 64 * SSD_GROUPS; unit += gridDim.x) {
        const int g = unit & 3, bc = unit >> 2;
        const int t0 = bc * 128;
        __syncthreads();
        ssd_chunk_acs(ldsb, dtv, a_log, t0, g, cdec + (size_t)bc * SSD_HEADS);
#pragma unroll
        for (int it_ = 0; it_ < 4; ++it_) { const int idx = tid + it_ * NTHR; const int row = idx >> 4, ch = idx & 15;
            const v4u v = *(const v4u*)(xbc_b + (size_t)(t0 + row) * CONV_DIM + 1536 + 128 * g + ch * 8);
            *(LAS v4u*)(ldsb + SSD_L_BM + row * SSD_RS_B + ch * 16) = v; }
        __syncthreads();
#pragma unroll
        for (int it_ = 0; it_ < 12; ++it_) { const int idx = tid + it_ * NTHR; const int hh = idx >> 10, rem = idx & 1023, row = rem >> 3, ch = rem & 7;
            const LAS float* acs = (const LAS float*)(ldsb + SSD_L_ACS) + hh * 128; const LAS float* dts = (const LAS float*)(ldsb + SSD_L_DTS) + hh * 128;
            const float wgt = dts[row] * __expf(acs[127] - acs[row]);
            float f[8]; unpack8(*(const v4u*)(xbc_b + (size_t)(t0 + row) * CONV_DIM + (6 * g + hh) * 64 + ch * 8), f);
            v4u o; o.x = pk2(f[0] * wgt, f[1] * wgt); o.y = pk2(f[2] * wgt, f[3] * wgt); o.z = pk2(f[4] * wgt, f[5] * wgt); o.w = pk2(f[6] * wgt, f[7] * wgt);
            *(LAS v4u*)(ldsb + SSD_L_X + hh * SSD_XIMG + row * SSD_RS_X + ch * 16) = o; }
        __syncthreads();
        f32x4n rider[16];
        copy_q_load(ck, cv, 12288u + (unsigned)(unit * NWAVE + w), (unsigned)lane, rider);
        const unsigned abase = lds_addr(ldsb + SSD_L_BM) + (8 * h + q) * SSD_RS_B + (32 * nt + 16 * blk + 4 * pp) * 2;
        s16x8 afr[8];
        { s16x4 av[8];
          tr_read8<0 * SSD_RS_B, 4 * SSD_RS_B, 16 * SSD_RS_B, 20 * SSD_RS_B, 32 * SSD_RS_B, 36 * SSD_RS_B, 48 * SSD_RS_B, 52 * SSD_RS_B>(abase, av);
          afr[0] = TRCAT(av[0], av[1]); afr[1] = TRCAT(av[2], av[3]); afr[2] = TRCAT(av[4], av[5]); afr[3] = TRCAT(av[6], av[7]);
          tr_read8<64 * SSD_RS_B, 68 * SSD_RS_B, 80 * SSD_RS_B, 84 * SSD_RS_B, 96 * SSD_RS_B, 100 * SSD_RS_B, 112 * SSD_RS_B, 116 * SSD_RS_B>(abase, av);
          afr[4] = TRCAT(av[0], av[1]); afr[5] = TRCAT(av[2], av[3]); afr[6] = TRCAT(av[4], av[5]); afr[7] = TRCAT(av[6], av[7]); }
#pragma unroll
        for (int hh = 0; hh < 6; ++hh) {
            const unsigned xb = lds_addr(ldsb + SSD_L_X + hh * SSD_XIMG) + (8 * h + q) * SSD_RS_X + (32 * pt + 16 * blk + 4 * pp) * 2;
            f32x16 acc;
#pragma unroll
            for (int i = 0; i < 16; ++i) acc[i] = 0.f;
            { s16x4 xv[8];
              tr_read8<0 * SSD_RS_X, 4 * SSD_RS_X, 16 * SSD_RS_X, 20 * SSD_RS_X, 32 * SSD_RS_X, 36 * SSD_RS_X, 48 * SSD_RS_X, 52 * SSD_RS_X>(xb, xv);
              acc = __builtin_amdgcn_mfma_f32_32x32x16_bf16(afr[0], TRCAT(xv[0], xv[1]), acc, 0, 0, 0);
              acc = __builtin_amdgcn_mfma_f32_32x32x16_bf16(afr[1], TRCAT(xv[2], xv[3]), acc, 0, 0, 0);
              acc = __builtin_amdgcn_mfma_f32_32x32x16_bf16(afr[2], TRCAT(xv[4], xv[5]), acc, 0, 0, 0);
              acc = __builtin_amdgcn_mfma_f32_32x32x16_bf16(afr[3], TRCAT(xv[6], xv[7]), acc, 0, 0, 0);
              tr_read8<64 * SSD_RS_X, 68 * SSD_RS_X, 80 * SSD_RS_X, 84 * SSD_RS_X, 96 * SSD_RS_X, 100 * SSD_RS_X, 112 * SSD_RS_X, 116 * SSD_RS_X>(xb, xv);
              acc = __builtin_amdgcn_mfma_f32_32x32x16_bf16(afr[4], TRCAT(xv[0], xv[1]), acc, 0, 0, 0);
              acc = __builtin_amdgcn_mfma_f32_32x32x16_bf16(afr[5], TRCAT(xv[2], xv[3]), acc, 0, 0, 0);
              acc = __builtin_amdgcn_mfma_f32_32x32x16_bf16(afr[6], TRCAT(xv[4], xv[5]), acc, 0, 0, 0);
              acc = __builtin_amdgcn_mfma_f32_32x32x16_bf16(afr[7], TRCAT(xv[6], xv[7]), acc, 0, 0, 0); }
            bf16* dst = Sbuf + ((size_t)bc * SSD_HEADS + 6 * g + hh) * 8192 + (size_t)(pt * 8 + 2 * nt) * 512 + r * 8 + 4 * h;
#pragma unroll
            for (int q4 = 0; q4 < 4; ++q4) *(uint2*)(dst + (q4 >> 1) * 512 + (q4 & 1) * 256) = make_uint2(pk2(acc[4 * q4], acc[4 * q4 + 1]), pk2(acc[4 * q4 + 2], acc[4 * q4 + 3]));
        }
        copy_q_store(out, 12288u + (unsigned)(unit * NWAVE + w), (unsigned)lane, rider);
    }
}

__device__ __forceinline__ void ph_ssd_scan(const bf16* __restrict__ Sbuf, const float* __restrict__ cdec, bf16* __restrict__ Hin, float* __restrict__ out, int rank, int nranks) {
    for (int idx = rank * NTHR + threadIdx.x; idx < BATCH * SSD_HEADS * 1024; idx += nranks * NTHR) {
        const int i = idx & 1023, hb = idx >> 10, hd = hb % SSD_HEADS, b = hb / SSD_HEADS;
        float st[8];
#pragma unroll
        for (int j = 0; j < 8; ++j) st[j] = 0.f;
#pragma unroll 8
        for (int c = 0; c < 64; ++c) {
            const size_t base = (((size_t)(b * 64 + c)) * SSD_HEADS + hd) * 8192 + (size_t)i * 8;
            v4u o; o.x = pk2(st[0], st[1]); o.y = pk2(st[2], st[3]); o.z = pk2(st[4], st[5]); o.w = pk2(st[6], st[7]);
            *(v4u*)(Hin + base) = o;
            float s[8]; unpack8(*(const v4u*)(Sbuf + base), s);
            const float a = cdec[(size_t)(b * 64 + c) * SSD_HEADS + hd];
#pragma unroll
            for (int j = 0; j < 8; ++j) st[j] = a * st[j] + s[j];
        }
        const int ln = i & 63, ks = (i >> 6) & 7, pt = i >> 9, p = 32 * pt + (ln & 31), n0 = 16 * ks + 8 * (ln >> 5);
        store8f(out + OUT_PS + (((size_t)b * SSD_HEADS + hd) * 64 + p) * 128 + n0, st);
    }
}

__device__ __forceinline__ void ph_ssd_out(LAS unsigned char* ldsb, const bf16* __restrict__ xbc_b, const bf16* __restrict__ projb, const float* __restrict__ dtv,
                                           const float* __restrict__ a_log, const float* __restrict__ d_skip, const float* __restrict__ norm_g,
                                           const bf16* __restrict__ Hin, bf16* __restrict__ A1) {
    const int tid = threadIdx.x, w = __builtin_amdgcn_readfirstlane(tid >> 6), lane = tid & 63;
    const int r = lane & 31, h = lane >> 5, blk = (lane >> 4) & 1, q = (lane & 15) >> 2, pp = lane & 3;
    const int hs = w >> 2, lt = hs ? 3 - (w & 3) : (w & 3);
    for (int unit = blockIdx.x; unit < BATCH * 64 * SSD_GROUPS; unit += gridDim.x) {
        const int g = unit & 3, bc = unit >> 2;
        const int t0 = bc * 128;
        __syncthreads();
        ssd_chunk_acs(ldsb, dtv, a_log, t0, g, nullptr);
#pragma unroll
        for (int it_ = 0; it_ < 4; ++it_) { const int idx = tid + it_ * NTHR; const int row = idx >> 4, ch = idx & 15;
            const v4u v = *(const v4u*)(xbc_b + (size_t)(t0 + row) * CONV_DIM + 1536 + 128 * g + ch * 8);
            *(LAS v4u*)(ldsb + SSD_L_BM + row * SSD_RS_B + ch * 16) = v; }
#pragma unroll
        for (int it_ = 0; it_ < 12; ++it_) { const int idx = tid + it_ * NTHR; const int hh = idx >> 10, rem = idx & 1023, row = rem >> 3, ch = rem & 7;
            const v4u v = *(const v4u*)(xbc_b + (size_t)(t0 + row) * CONV_DIM + (6 * g + hh) * 64 + ch * 8);
            *(LAS v4u*)(ldsb + SSD_L_X + hh * SSD_XIMG + row * SSD_RS_X + ch * 16) = v; }
        __syncthreads();
        const bf16* cp = xbc_b + (size_t)(t0 + 32 * lt + r) * CONV_DIM + 2048 + 128 * g + 8 * h;
        s16x8 cfr[8];
#pragma unroll
        for (int ks = 0; ks < 8; ++ks) cfr[ks] = *(const s16x8*)(cp + 16 * ks);
        const int lcol = 32 * lt + r;
        const LAS float* acsb = (const LAS float*)(ldsb + SSD_L_ACS) + 3 * hs * 128; const LAS float* dtsb = (const LAS float*)(ldsb + SSD_L_DTS) + 3 * hs * 128;
        const unsigned xb0 = lds_addr(ldsb + SSD_L_X + 3 * hs * SSD_XIMG) + (4 * h + q) * SSD_RS_X + (16 * blk + 4 * pp) * 2;
        unsigned ypk[3][16];
#pragma unroll
        for (int h3 = 0; h3 < 3; ++h3) {
            const LAS float* acs = acsb + h3 * 128; const LAS float* dts = dtsb + h3 * 128;
            const float myacs = acs[lcol];
            const float Dh = d_skip[6 * g + 3 * hs + h3];
            f32x16 y0, y1;
#pragma unroll
            for (int i = 0; i < 16; ++i) { y0[i] = 0.f; y1[i] = 0.f; }
            { const bf16* hp = Hin + ((size_t)bc * SSD_HEADS + 6 * g + 3 * hs + h3) * 8192 + lane * 8;
#pragma unroll
              for (int kh = 0; kh < 2; ++kh) {
                  s16x8 hf0[4], hf1[4];
#pragma unroll
                  for (int ks = 0; ks < 4; ++ks) { hf0[ks] = *(const s16x8*)(hp + (4 * kh + ks) * 512); hf1[ks] = *(const s16x8*)(hp + (8 + 4 * kh + ks) * 512); }
#pragma unroll
                  for (int ks = 0; ks < 4; ++ks) { y0 = __builtin_amdgcn_mfma_f32_32x32x16_bf16(cfr[4 * kh + ks], hf0[ks], y0, 0, 0, 0); y1 = __builtin_amdgcn_mfma_f32_32x32x16_bf16(cfr[4 * kh + ks], hf1[ks], y1, 0, 0, 0); }
                  __builtin_amdgcn_sched_barrier(0);
              } }
#pragma unroll
            for (int q4 = 0; q4 < 4; ++q4) {
                const f32x4v a4 = *(const LAS f32x4v*)(acs + 32 * lt + 8 * q4 + 4 * h);
                const float e0 = __expf(a4[0]), e1 = __expf(a4[1]), e2 = __expf(a4[2]), e3 = __expf(a4[3]);
                y0[4 * q4] *= e0; y0[4 * q4 + 1] *= e1; y0[4 * q4 + 2] *= e2; y0[4 * q4 + 3] *= e3;
                y1[4 * q4] *= e0; y1[4 * q4 + 1] *= e1; y1[4 * q4 + 2] *= e2; y1[4 * q4 + 3] *= e3;
            }
            __builtin_amdgcn_sched_barrier(0);
            for (int st = 0; st <= lt; ++st) {
                f32x16 cb;
#pragma unroll
                for (int i = 0; i < 16; ++i) cb[i] = 0.f;
#pragma unroll
                for (int ks = 0; ks < 8; ++ks) {
                    const s16x8 bfrag = *(const LAS s16x8*)(ldsb + SSD_L_BM + (32 * st + r) * SSD_RS_B + (16 * ks + 8 * h) * 2);
                    cb = __builtin_amdgcn_mfma_f32_32x32x16_bf16(bfrag, cfr[ks], cb, 0, 0, 0);
                }
                __builtin_amdgcn_sched_barrier(0);
                const unsigned xb = xb0 + h3 * SSD_XIMG + st * 32 * SSD_RS_X;
                s16x4 xv[8];
                tr_read8<0, 8 * SSD_RS_X, 64, 8 * SSD_RS_X + 64, 16 * SSD_RS_X, 24 * SSD_RS_X, 16 * SSD_RS_X + 64, 24 * SSD_RS_X + 64>(xb, xv);
#pragma unroll
                for (int kk = 0; kk < 2; ++kk) {
                    const int s0 = 32 * st + 16 * kk + 4 * h;
                    const f32x4v as0 = *(const LAS f32x4v*)(acs + s0), as1 = *(const LAS f32x4v*)(acs + s0 + 8);
                    const f32x4v ds0 = *(const LAS f32x4v*)(dts + s0), ds1 = *(const LAS f32x4v*)(dts + s0 + 8);
                    float wv[8];
#pragma unroll
                    for (int j = 0; j < 8; ++j) {
                        const int s = s0 + 8 * (j >> 2) + (j & 3);
                        const float asj = (j < 4) ? as0[j & 3] : as1[j & 3], dsj = (j < 4) ? ds0[j & 3] : ds1[j & 3];
                        float v = cb[8 * kk + j] * __expf(myacs - asj) * dsj;
                        v = (s <= lcol) ? v : 0.f;
                        v = (s == lcol) ? v + Dh : v;
                        wv[j] = v;
                    }
                    s16x8 afr;
                    { v4u o; o.x = pk2(wv[0], wv[1]); o.y = pk2(wv[2], wv[3]); o.z = pk2(wv[4], wv[5]); o.w = pk2(wv[6], wv[7]); afr = __builtin_bit_cast(s16x8, o); }
                    const s16x8 b0 = kk == 0 ? TRCAT(xv[0], xv[1]) : TRCAT(xv[4], xv[5]);
                    const s16x8 b1 = kk == 0 ? TRCAT(xv[2], xv[3]) : TRCAT(xv[6], xv[7]);
                    y0 = __builtin_amdgcn_mfma_f32_32x32x16_bf16(afr, b0, y0, 0, 0, 0);
                    y1 = __builtin_amdgcn_mfma_f32_32x32x16_bf16(afr, b1, y1, 0, 0, 0);
                    __builtin_amdgcn_sched_barrier(0);
                }
            }
#pragma unroll
            for (int i = 0; i < 8; ++i) { ypk[h3][i] = pk2(y0[2 * i], y0[2 * i + 1]); ypk[h3][8 + i] = pk2(y1[2 * i], y1[2 * i + 1]); }
            __builtin_amdgcn_sched_barrier(0);
        }
        __syncthreads();
        {
            LAS unsigned short* yst = (LAS unsigned short*)(ldsb + SSD_L_X);
#pragma unroll
            for (int h3 = 0; h3 < 3; ++h3)
#pragma unroll
                for (int ptile = 0; ptile < 2; ++ptile)
#pragma unroll
                    for (int i = 0; i < 8; ++i) {
                        const int reg = 2 * i;
                        const int l0 = 32 * lt + (reg & 3) + 8 * (reg >> 2) + 4 * h;
                        const int col = (3 * hs + h3) * 64 + 32 * ptile + r;
                        const unsigned v = ypk[h3][8 * ptile + i];
                        yst[l0 * (SSD_RS_Y / 2) + col] = (unsigned short)(v & 0xffffu);
                        yst[(l0 + 1) * (SSD_RS_Y / 2) + col] = (unsigned short)(v >> 16);
                    }
        }
        __syncthreads();
#pragma unroll
        for (int pass = 0; pass < 4; ++pass) {
            const int l = 4 * (pass * 8 + w) + (lane >> 4), i16 = lane & 15;
            float gv[3][8]; float ss = 0.f;
#pragma unroll
            for (int k = 0; k < 3; ++k) {
                const int col0 = 24 * i16 + 8 * k;
                float yv[8], zv[8];
                unpack8(*(const LAS v4u*)(ldsb + SSD_L_X + l * SSD_RS_Y + col0 * 2), yv);
                unpack8(*(const v4u*)(projb + (size_t)(t0 + l) * NB_LD + g * 384 + col0), zv);
#pragma unroll
                for (int j = 0; j < 8; ++j) { const float gg = yv[j] * silu_f(zv[j]); gv[k][j] = gg; ss += gg * gg; }
            }
            ss += __shfl_xor(ss, 1); ss += __shfl_xor(ss, 2); ss += __shfl_xor(ss, 4); ss += __shfl_xor(ss, 8);
            const float rstd = rsqrtf(ss * (1.0f / 384.0f) + LN_EPS);
#pragma unroll
            for (int k = 0; k < 3; ++k) {
                const int col0 = g * 384 + 24 * i16 + 8 * k;
                const float4 g0 = *(const float4*)(norm_g + col0), g1 = *(const float4*)(norm_g + col0 + 4);
                v4u o; o.x = pk2(gv[k][0] * rstd * g0.x, gv[k][1] * rstd * g0.y); o.y = pk2(gv[k][2] * rstd * g0.z, gv[k][3] * rstd * g0.w);
                o.z = pk2(gv[k][4] * rstd * g1.x, gv[k][5] * rstd * g1.y); o.w = pk2(gv[k][6] * rstd * g1.z, gv[k][7] * rstd * g1.w);
                *(v4u*)(A1 + (size_t)(t0 + l) * MIX_WIDTH + col0) = o;
            }
        }
    }
}

#define ATT_RS_V 144
#define ATT_VIMG (256 * ATT_RS_V)
#define ATT_HIMG (2 * ATT_VIMG)
#define ATT_PVT(KT) { \
        s16x4 vv_[8]; \
        tr_read8<(32 * KT) * ATT_RS_V, (32 * KT + 8) * ATT_RS_V, (32 * KT) * ATT_RS_V + 64, (32 * KT + 8) * ATT_RS_V + 64, \
                 (32 * KT + 16) * ATT_RS_V, (32 * KT + 24) * ATT_RS_V, (32 * KT + 16) * ATT_RS_V + 64, (32 * KT + 24) * ATT_RS_V + 64>(vbase, vv_); \
        _Pragma("unroll") for (int s2_ = 0; s2_ < 2; ++s2_) { \
            v4u o_; o_.x = pk2(s[KT][8 * s2_ + 0], s[KT][8 * s2_ + 1]); o_.y = pk2(s[KT][8 * s2_ + 2], s[KT][8 * s2_ + 3]); \
            o_.z = pk2(s[KT][8 * s2_ + 4], s[KT][8 * s2_ + 5]); o_.w = pk2(s[KT][8 * s2_ + 6], s[KT][8 * s2_ + 7]); \
            const s16x8 pf_ = __builtin_bit_cast(s16x8, o_); \
            const s16x8 a0_ = s2_ == 0 ? TRCAT(vv_[0], vv_[1]) : TRCAT(vv_[4], vv_[5]); \
            const s16x8 a1_ = s2_ == 0 ? TRCAT(vv_[2], vv_[3]) : TRCAT(vv_[6], vv_[7]); \
            o0 = __builtin_amdgcn_mfma_f32_32x32x16_bf16(a0_, pf_, o0, 0, 0, 0); \
            o1 = __builtin_amdgcn_mfma_f32_32x32x16_bf16(a1_, pf_, o1, 0, 0, 0); } }
__device__ __forceinline__ void ph_attn_prompt(LAS unsigned char* ldsb, const bf16* __restrict__ qrot_b, const bf16* __restrict__ krot_b, const bf16* __restrict__ projb,
                                               bf16* __restrict__ obuf, float* __restrict__ lsebuf, const float* __restrict__ ck, const float* __restrict__ cv, float* __restrict__ out) {
    const int tid = threadIdx.x, w = __builtin_amdgcn_readfirstlane(tid >> 6), lane = tid & 63;
    const int r = lane & 31, h = lane >> 5, blk = (lane >> 4) & 1, q = (lane & 15) >> 2, pp = lane & 3;
    const int qt = w & 3, hsel = w >> 2;
    f32x4n rider[16]; bool pend = false; unsigned pq = 0u;
    for (int unit = blockIdx.x; unit < 3 * 512; unit += gridDim.x) {
        const int pat = unit >> 9, rem = unit & 511, hp = rem & 3, rem2 = rem >> 2, b = rem2 >> 6, bk = rem2 & 63;
        const int dsh = 2 * pat, nper = 64 >> dsh, res = bk >> (6 - dsh), nb = bk & (nper - 1);
        const int head = 2 * hp + hsel;
        __syncthreads();
        { v4u vst[8], kst[8];
#pragma unroll
          for (int it_ = 0; it_ < 8; ++it_) { const int idx = (tid & 255) + it_ * 256;
              const int row = idx >> 3, ch = idx & 7, js = 128 * nb - 128 + row, jc = js < 0 ? 0 : js;
              const size_t tk = (size_t)(b * SEQ + (jc << dsh) + res);
              vst[it_] = *(const v4u*)(projb + tk * NB_LD + NB_V + head * 64 + ch * 8);
              kst[it_] = *(const v4u*)(krot_b + tk * ATT_WIDTH + head * 64 + ch * 8); }
#pragma unroll
          for (int it_ = 0; it_ < 8; ++it_) { const int idx = (tid & 255) + it_ * 256;
              const int row = idx >> 3, ch = idx & 7, js = 128 * nb - 128 + row;
              v4u v = vst[it_], k = kst[it_]; if (js < 0) { v.x = 0u; v.y = 0u; v.z = 0u; v.w = 0u; k = v; }
              *(LAS v4u*)(ldsb + hsel * ATT_HIMG + row * ATT_RS_V + ch * 16) = v;
              *(LAS v4u*)(ldsb + hsel * ATT_HIMG + ATT_VIMG + row * ATT_RS_V + ch * 16) = k; } }
        const int tq = b * SEQ + ((128 * nb + 32 * qt + r) << dsh) + res;
        s16x8 qf[4];
#pragma unroll
        for (int ks = 0; ks < 4; ++ks) qf[ks] = *(const s16x8*)(qrot_b + (size_t)tq * ATT_WIDTH + head * 64 + 16 * ks + 8 * h);
        __syncthreads();
        f32x16 s[5];
#pragma unroll
        for (int kt = 0; kt < 5; ++kt) {
            const LAS unsigned char* kp = ldsb + hsel * ATT_HIMG + ATT_VIMG + (32 * qt + 32 * kt + r) * ATT_RS_V + 16 * h;
#pragma unroll
            for (int i = 0; i < 16; ++i) s[kt][i] = 0.f;
#pragma unroll
            for (int ks = 0; ks < 4; ++ks) s[kt] = __builtin_amdgcn_mfma_f32_32x32x16_bf16(*(const LAS s16x8*)(kp + 32 * ks), qf[ks], s[kt], 0, 0, 0);
        }
        if (pend) copy_q_store(out, pq, (unsigned)lane, rider);
        float m = -INFINITY;
#pragma unroll
        for (int kt = 0; kt < 5; ++kt) {
            const bool tile_ok = (nb > 0) || (qt + kt >= 4);
#pragma unroll
            for (int reg = 0; reg < 16; ++reg) {
                const int c = (reg & 3) + 8 * (reg >> 2) + 4 * h;
                const bool ok = tile_ok && (kt == 0 ? (c >= r) : (kt == 4 ? (c <= r) : true));
                const float v = ok ? s[kt][reg] * 0.125f : -INFINITY;
                s[kt][reg] = v; m = fmaxf(m, v);
            }
        }
        m = fmaxf(m, __shfl_xor(m, 32));
        float l = 0.f;
#pragma unroll
        for (int kt = 0; kt < 5; ++kt)
#pragma unroll
            for (int reg = 0; reg < 16; ++reg) { const float p = __expf(s[kt][reg] - m); s[kt][reg] = p; l += p; }
        l += __shfl_xor(l, 32);
        pq = (unsigned)(unit * NWAVE + w); copy_q_load(ck, cv, pq, (unsigned)lane, rider); pend = true;
        f32x16 o0, o1;
#pragma unroll
        for (int i = 0; i < 16; ++i) { o0[i] = 0.f; o1[i] = 0.f; }
        const unsigned vbase = lds_addr(ldsb + hsel * ATT_HIMG) + (32 * qt + 4 * h + q) * ATT_RS_V + (16 * blk + 4 * pp) * 2;
        ATT_PVT(0) ATT_PVT(1) ATT_PVT(2) ATT_PVT(3) ATT_PVT(4)
        const float inv = 1.0f / l;
        bf16* op = obuf + ((size_t)pat * T_PROMPT + tq) * ATT_WIDTH + head * 64 + 8 * h;
#pragma unroll
        for (int k2 = 0; k2 < 4; ++k2) {
            unsigned ax, ay, bx, by;
            if (k2 < 2) { ax = pk2(o0[8 * k2] * inv, o0[8 * k2 + 1] * inv); ay = pk2(o0[8 * k2 + 2] * inv, o0[8 * k2 + 3] * inv);
                          bx = pk2(o0[8 * k2 + 4] * inv, o0[8 * k2 + 5] * inv); by = pk2(o0[8 * k2 + 6] * inv, o0[8 * k2 + 7] * inv); }
            else { const int k3 = k2 - 2;
                   ax = pk2(o1[8 * k3] * inv, o1[8 * k3 + 1] * inv); ay = pk2(o1[8 * k3 + 2] * inv, o1[8 * k3 + 3] * inv);
                   bx = pk2(o1[8 * k3 + 4] * inv, o1[8 * k3 + 5] * inv); by = pk2(o1[8 * k3 + 6] * inv, o1[8 * k3 + 7] * inv); }
            const auto rx = __builtin_amdgcn_permlane32_swap(ax, bx, false, false);
            const auto ry = __builtin_amdgcn_permlane32_swap(ay, by, false, false);
            v4u o; o.x = rx[0]; o.y = ry[0]; o.z = rx[1]; o.w = ry[1];
            *(v4u*)(op + 16 * k2) = o;
        }
        if (h == 0) lsebuf[((size_t)pat * T_PROMPT + tq) * 8 + head] = m + __logf(l);
    }
    if (pend) copy_q_store(out, pq, (unsigned)lane, rider);
}
__device__ __forceinline__ void ph_attn_combine(const bf16* __restrict__ obuf, const float* __restrict__ lsebuf, bf16* __restrict__ A1) {
    const int lane = threadIdx.x & 63;
#pragma unroll 4
    for (int t = blockIdx.x * NWAVE + (threadIdx.x >> 6); t < T_PROMPT; t += gridDim.x * NWAVE) {
        const int hd = lane >> 3;
        const float l0 = lsebuf[((size_t)0 * T_PROMPT + t) * 8 + hd], l1 = lsebuf[((size_t)1 * T_PROMPT + t) * 8 + hd], l2 = lsebuf[((size_t)2 * T_PROMPT + t) * 8 + hd];
        const float mx = fmaxf(l0, fmaxf(l1, l2));
        const float e0 = __expf(l0 - mx), e1 = __expf(l1 - mx), e2 = __expf(l2 - mx);
        const float inv = 1.0f / (e0 + e1 + e2);
        float a[8], b[8], c[8];
        unpack8(*(const v4u*)(obuf + ((size_t)0 * T_PROMPT + t) * ATT_WIDTH + lane * 8), a);
        unpack8(*(const v4u*)(obuf + ((size_t)1 * T_PROMPT + t) * ATT_WIDTH + lane * 8), b);
        unpack8(*(const v4u*)(obuf + ((size_t)2 * T_PROMPT + t) * ATT_WIDTH + lane * 8), c);
        float o[8];
#pragma unroll
        for (int j = 0; j < 8; ++j) o[j] = (e0 * a[j] + e1 * b[j] + e2 * c[j]) * inv;
        v4u w; w.x = pk2(o[0], o[1]); w.y = pk2(o[2], o[3]); w.z = pk2(o[4], o[5]); w.w = pk2(o[6], o[7]);
        *(v4u*)(A1 + (size_t)t * MIX_WIDTH + SSD_WIDTH + lane * 8) = w;
    }
}

#define RT_RS 272
#define RT_KIMG (128 * RT_RS)
#define RT_LUT (2 * RT_KIMG)
constexpr unsigned char RT_CANDS[64] = {0, 1, 2, 3, 4, 5, 6, 7, 8, 9, 10, 11, 12, 13, 14, 15, 16, 17, 18, 19, 20, 21, 22, 23, 32, 33, 34, 35, 36, 48, 49, 50, 51, 64, 65, 66, 80, 81, 96, 97,
                                        112, 113, 128, 144, 160, 176, 192, 208, 224, 240, 0, 0, 0, 0, 0, 0, 0, 0, 0, 0, 0, 0, 0, 0};
__device__ __forceinline__ unsigned rt_mono(float f) { const unsigned u = __builtin_bit_cast(unsigned, f); return u ^ ((unsigned)((int)u >> 31) | 0x80000000u); }
__device__ __forceinline__ float rt_unmono(unsigned m) { const unsigned u = (m & 0x80000000u) ? (m ^ 0x80000000u) : ~m; return __builtin_bit_cast(float, u); }
#define RT_CE_DESC(a, b) { const unsigned x_ = (a), y_ = (b); (a) = x_ > y_ ? x_ : y_; (b) = x_ > y_ ? y_ : x_; }
#define RT_CE_ASC(a, b) { const unsigned x_ = (a), y_ = (b); (a) = x_ > y_ ? y_ : x_; (b) = x_ > y_ ? x_ : y_; }
__device__ __forceinline__ void rt_sort16(unsigned (&v)[16]) {
#pragma unroll
    for (int k = 2; k <= 16; k <<= 1)
#pragma unroll
        for (int j = k >> 1; j > 0; j >>= 1)
#pragma unroll
            for (int i = 0; i < 16; ++i) { const int l = i ^ j; if (l > i) { if ((i & k) == 0) RT_CE_DESC(v[i], v[l]) else RT_CE_ASC(v[i], v[l]) } }
}
__device__ __forceinline__ void rt_merge16(unsigned (&v)[16]) {
#pragma unroll
    for (int j = 8; j > 0; j >>= 1)
#pragma unroll
        for (int i = 0; i < 16; ++i) { const int l = i ^ j; if (l > i) RT_CE_DESC(v[i], v[l]) }
}
__device__ __forceinline__ void rt_top16(unsigned (&a)[16], const unsigned (&b)[16]) {
#pragma unroll
    for (int i = 0; i < 16; ++i) a[i] = a[i] > b[15 - i] ? a[i] : b[15 - i];
    rt_merge16(a);
}
__device__ __forceinline__ void rt_top16_partner(unsigned (&a)[16]) {
    unsigned b[16];
#pragma unroll
    for (int i = 0; i < 16; ++i) b[i] = (unsigned)__shfl_xor((int)a[i], 32);
    rt_top16(a, b);
}
__device__ __forceinline__ void rt_scores_top16(LAS unsigned char* kimg, const bf16* __restrict__ qp, int r, int h, unsigned (&k0)[16]) {
    f32x16 acc[4];
#pragma unroll
    for (int kt = 0; kt < 4; ++kt)
#pragma unroll
        for (int i = 0; i < 16; ++i) acc[kt][i] = 0.f;
#pragma unroll
    for (int ks = 0; ks < 8; ++ks) {
        const s16x8 qf = *(const s16x8*)(qp + 16 * ks);
#pragma unroll
        for (int kt = 0; kt < 4; ++kt) {
            const s16x8 kf = *(const LAS s16x8*)(kimg + (32 * kt + r) * RT_RS + (16 * ks + 8 * h) * 2);
            acc[kt] = __builtin_amdgcn_mfma_f32_32x32x16_bf16(kf, qf, acc[kt], 0, 0, 0);
        }
    }
    unsigned k1[16], k2[16], k3[16];
#pragma unroll
    for (int reg = 0; reg < 16; ++reg) {
        const unsigned ki = (unsigned)((reg & 3) + 8 * (reg >> 2) + 4 * h);
        k0[reg] = (rt_mono(acc[0][reg]) & 0xFFFFFF80u) | ki;
        k1[reg] = (rt_mono(acc[1][reg]) & 0xFFFFFF80u) | (ki + 32u);
        k2[reg] = (rt_mono(acc[2][reg]) & 0xFFFFFF80u) | (ki + 64u);
        k3[reg] = (rt_mono(acc[3][reg]) & 0xFFFFFF80u) | (ki + 96u);
    }
    rt_sort16(k0); rt_sort16(k1); rt_sort16(k2); rt_sort16(k3);
    rt_top16(k0, k1); rt_top16(k2, k3); rt_top16(k0, k2);
    rt_top16_partner(k0);
}
__device__ __forceinline__ void ph_peer_route2(LAS unsigned char* ldsb, const bf16* __restrict__ qhb, const float* __restrict__ keys1, const float* __restrict__ keys2,
                                               int* __restrict__ eidx, float* __restrict__ gate, const float* __restrict__ ck, const float* __restrict__ cv, float* __restrict__ out) {
    const int tid = threadIdx.x, w = __builtin_amdgcn_readfirstlane(tid >> 6), lane = tid & 63, r = lane & 31, h = lane >> 5;
    __syncthreads();
    for (int idx = tid; idx < 2 * 128 * 16; idx += NTHR) {
        const int tb = idx >> 11, rem = idx & 2047, row = rem >> 4, ch = rem & 15;
        const float* sp = (tb ? keys2 : keys1) + row * 128 + ch * 8;
        const float4 a = *(const float4*)sp, b = *(const float4*)(sp + 4);
        v4u o; o.x = pk2(a.x, a.y); o.y = pk2(a.z, a.w); o.z = pk2(b.x, b.y); o.w = pk2(b.z, b.w);
        *(LAS v4u*)(ldsb + tb * RT_KIMG + row * RT_RS + ch * 16) = o;
    }
    __syncthreads();
    LAS unsigned* lut = (LAS unsigned*)(ldsb + RT_LUT) + w * 512;
    for (int k = 0;; ++k) {
        int unit;
        if (gridDim.x != 256) { unit = blockIdx.x * NWAVE + w + k * (int)(gridDim.x * NWAVE); if (unit >= (T_ALL / 32) * 8) break; }
        else if (k < 2) unit = k * 2048 + blockIdx.x * NWAVE + w;
        else if (k == 2 && w == 0 && blockIdx.x < 128) unit = 4096 + (int)blockIdx.x;
        else break;
        const int tt = unit >> 3, hd = unit & 7;
        const int tok = 32 * tt + r;
        const bf16* qp = qhb + (size_t)tok * 2048 + hd * 256 + 8 * h;
        unsigned ka[16], kb[16];
        rt_scores_top16(ldsb, qp, r, h, ka);
        rt_scores_top16(ldsb + RT_KIMG, qp + 128, r, h, kb);
        float v1[16], v2[16];
#pragma unroll
        for (int i = 0; i < 16; ++i) { v1[i] = rt_unmono(ka[i] & 0xFFFFFF80u); v2[i] = rt_unmono(kb[i] & 0xFFFFFF80u); }
#pragma unroll
        for (int wd = 0; wd < 4; ++wd) {
            lut[wd * 64 + lane] = (ka[4 * wd] & 0x7Fu) | ((ka[4 * wd + 1] & 0x7Fu) << 8) | ((ka[4 * wd + 2] & 0x7Fu) << 16) | ((ka[4 * wd + 3] & 0x7Fu) << 24);
            lut[(4 + wd) * 64 + lane] = (kb[4 * wd] & 0x7Fu) | ((kb[4 * wd + 1] & 0x7Fu) << 8) | ((kb[4 * wd + 2] & 0x7Fu) << 16) | ((kb[4 * wd + 3] & 0x7Fu) << 24);
        }
        unsigned c0[16], c1[16];
        c0[0] = (rt_mono(h ? (v1[0] + v2[1]) : (v1[0] + v2[0])) & 0xFFFFFF00u) | (h ? 1u : 0u);
        c0[1] = (rt_mono(h ? (v1[0] + v2[3]) : (v1[0] + v2[2])) & 0xFFFFFF00u) | (h ? 3u : 2u);
        c0[2] = (rt_mono(h ? (v1[0] + v2[5]) : (v1[0] + v2[4])) & 0xFFFFFF00u) | (h ? 5u : 4u);
        c0[3] = (rt_mono(h ? (v1[0] + v2[7]) : (v1[0] + v2[6])) & 0xFFFFFF00u) | (h ? 7u : 6u);
        c0[4] = (rt_mono(h ? (v1[0] + v2[9]) : (v1[0] + v2[8])) & 0xFFFFFF00u) | (h ? 9u : 8u);
        c0[5] = (rt_mono(h ? (v1[0] + v2[11]) : (v1[0] + v2[10])) & 0xFFFFFF00u) | (h ? 11u : 10u);
        c0[6] = (rt_mono(h ? (v1[0] + v2[13]) : (v1[0] + v2[12])) & 0xFFFFFF00u) | (h ? 13u : 12u);
        c0[7] = (rt_mono(h ? (v1[0] + v2[15]) : (v1[0] + v2[14])) & 0xFFFFFF00u) | (h ? 15u : 14u);
        c0[8] = (rt_mono(h ? (v1[1] + v2[1]) : (v1[1] + v2[0])) & 0xFFFFFF00u) | (h ? 17u : 16u);
        c0[9] = (rt_mono(h ? (v1[1] + v2[3]) : (v1[1] + v2[2])) & 0xFFFFFF00u) | (h ? 19u : 18u);
        c0[10] = (rt_mono(h ? (v1[1] + v2[5]) : (v1[1] + v2[4])) & 0xFFFFFF00u) | (h ? 21u : 20u);
        c0[11] = (rt_mono(h ? (v1[1] + v2[7]) : (v1[1] + v2[6])) & 0xFFFFFF00u) | (h ? 23u : 22u);
        c0[12] = (rt_mono(h ? (v1[2] + v2[1]) : (v1[2] + v2[0])) & 0xFFFFFF00u) | (h ? 33u : 32u);
        c0[13] = (rt_mono(h ? (v1[2] + v2[3]) : (v1[2] + v2[2])) & 0xFFFFFF00u) | (h ? 35u : 34u);
        c0[14] = (rt_mono(h ? (v1[3] + v2[0]) : (v1[2] + v2[4])) & 0xFFFFFF00u) | (h ? 48u : 36u);
        c0[15] = (rt_mono(h ? (v1[3] + v2[2]) : (v1[3] + v2[1])) & 0xFFFFFF00u) | (h ? 50u : 49u);
        c1[0] = (rt_mono(h ? (v1[4] + v2[0]) : (v1[3] + v2[3])) & 0xFFFFFF00u) | (h ? 64u : 51u);
        c1[1] = (rt_mono(h ? (v1[4] + v2[2]) : (v1[4] + v2[1])) & 0xFFFFFF00u) | (h ? 66u : 65u);
        c1[2] = (rt_mono(h ? (v1[5] + v2[1]) : (v1[5] + v2[0])) & 0xFFFFFF00u) | (h ? 81u : 80u);
        c1[3] = (rt_mono(h ? (v1[6] + v2[1]) : (v1[6] + v2[0])) & 0xFFFFFF00u) | (h ? 97u : 96u);
        c1[4] = (rt_mono(h ? (v1[7] + v2[1]) : (v1[7] + v2[0])) & 0xFFFFFF00u) | (h ? 113u : 112u);
        c1[5] = (rt_mono(h ? (v1[9] + v2[0]) : (v1[8] + v2[0])) & 0xFFFFFF00u) | (h ? 144u : 128u);
        c1[6] = (rt_mono(h ? (v1[11] + v2[0]) : (v1[10] + v2[0])) & 0xFFFFFF00u) | (h ? 176u : 160u);
        c1[7] = (rt_mono(h ? (v1[13] + v2[0]) : (v1[12] + v2[0])) & 0xFFFFFF00u) | (h ? 208u : 192u);
        c1[8] = (rt_mono(h ? (v1[15] + v2[0]) : (v1[14] + v2[0])) & 0xFFFFFF00u) | (h ? 240u : 224u);
        c1[9] = 0u;
        c1[10] = 0u;
        c1[11] = 0u;
        c1[12] = 0u;
        c1[13] = 0u;
        c1[14] = 0u;
        c1[15] = 0u;
        rt_sort16(c0); rt_sort16(c1); rt_top16(c0, c1); rt_top16_partner(c0);
        float e[16]; float sum = 0.f;
        const float mx = rt_unmono(c0[0] & 0xFFFFFF00u);
#pragma unroll
        for (int k = 0; k < 16; ++k) { e[k] = __expf(rt_unmono(c0[k] & 0xFFFFFF00u) - mx); sum += e[k]; }
        const float inv = 1.0f / sum;
        asm volatile("s_waitcnt lgkmcnt(0)" ::: "memory");
        int ex[8]; float gv[8];
#pragma unroll
        for (int k = 0; k < 8; ++k) {
            const unsigned hm = (unsigned)(-h);
            const unsigned ck = (c0[k] & ~hm) | (c0[8 + k] & hm);
            const float ek = __builtin_bit_cast(float, (__builtin_bit_cast(unsigned, e[k]) & ~hm) | (__builtin_bit_cast(unsigned, e[8 + k]) & hm));
            const unsigned ci = (ck >> 4) & 15u, cj = ck & 15u;
            const unsigned w1 = lut[(ci >> 2) * 64 + lane], w2 = lut[(4 + (cj >> 2)) * 64 + lane];
            const unsigned i1 = (w1 >> (8 * (ci & 3))) & 0x7Fu, i2 = (w2 >> (8 * (cj & 3))) & 0x7Fu;
            ex[k] = (int)(i1 * PEER_NKEYS + i2); gv[k] = ek * inv;
        }
        int* ep = eidx + (size_t)tok * 128 + hd * 16 + 8 * h; float* gp = gate + (size_t)tok * 128 + hd * 16 + 8 * h;
        *(int4*)ep = make_int4(ex[0], ex[1], ex[2], ex[3]); *(int4*)(ep + 4) = make_int4(ex[4], ex[5], ex[6], ex[7]);
        *(float4*)gp = make_float4(gv[0], gv[1], gv[2], gv[3]); *(float4*)(gp + 4) = make_float4(gv[4], gv[5], gv[6], gv[7]);
    }
    if (gridDim.x == 256 && (w != 0 || blockIdx.x >= 128)) {
        const unsigned si = blockIdx.x < 128 ? blockIdx.x * 7u + (unsigned)(w - 1) : 896u + (blockIdx.x - 128u) * 8u + (unsigned)w;
        cache_copy_slice(ck, cv, out, 7040u + si, (unsigned)lane);
    }
}

struct Params {
    const float* in[23];
    float* out;
    unsigned char* ws;
    unsigned* bar;
};

#define WS_BAR      0ull
#define WS_XALL     (1ull << 20)
#define WS_PROJ     (WS_XALL + (size_t)T_ALL * D_MODEL * 4)
#define WS_XBC      (WS_PROJ + (size_t)T_ALL * PROJ_LD * 4)
#define WS_DT       (WS_XBC + (size_t)T_ALL * CONV_DIM * 4)
#define WS_QROT     (WS_DT + (size_t)T_ALL * SSD_HEADS * 4)
#define WS_KROT     (WS_QROT + (size_t)T_ALL * ATT_WIDTH * 4)
#define WS_YBUF     (WS_KROT + (size_t)T_ALL * ATT_WIDTH * 4)
#define WS_MIX      (WS_YBUF + (size_t)T_ALL * MIX_WIDTH * 4)
#define WS_HBUF     (WS_MIX + (size_t)T_ALL * D_MODEL * 4)
#define WS_QH       (WS_HBUF + (size_t)T_ALL * D_MODEL * 4)
#define WS_EIDX     (WS_QH + (size_t)T_ALL * 2048 * 4)
#define WS_GATE     (WS_EIDX + (size_t)T_ALL * 128 * 4)
#define WS_A0       (WS_GATE + (size_t)T_ALL * 128 * 4)
#define WS_A1       (WS_A0 + (size_t)T_ALL * D_MODEL * 2)
#define WS_A2       (WS_A1 + (size_t)T_ALL * MIX_WIDTH * 2)
#define WS_WTIN     (WS_A2 + (size_t)T_ALL * D_MODEL * 2)
#define WS_WTOUT    (WS_WTIN + (size_t)PROJ_LD * D_MODEL * 2)
#define WS_WTQ      (WS_WTOUT + (size_t)D_MODEL * MIX_WIDTH * 2)
#define WS_PROJB    (WS_WTQ + (size_t)2048 * D_MODEL * 2)
#define WS_DTRAW    (WS_PROJB + (size_t)T_ALL * NB_LD * 2)
#define WS_XBCB     (WS_DTRAW + (size_t)T_ALL * 32 * 4)
#define WS_QROTB    (WS_XBCB + (size_t)T_ALL * CONV_DIM * 2)
#define WS_KROTB    (WS_QROTB + (size_t)T_ALL * ATT_WIDTH * 2)
#define WS_UB       (WS_KROTB + (size_t)T_ALL * ATT_WIDTH * 2)
#define WS_VB       (WS_UB + (size_t)16384 * D_MODEL * 2)
#define WS_USC      (WS_VB + (size_t)16384 * D_MODEL * 2)
#define WS_VSC      (WS_USC + 16384 * 4)
#define WS_SBUF     (WS_VSC + 16384 * 4)
#define WS_HIN      (WS_SBUF + (size_t)BATCH * 64 * SSD_HEADS * 64 * 128 * 2)
#define WS_CDEC     (WS_HIN + (size_t)BATCH * 64 * SSD_HEADS * 64 * 128 * 2)
#define WS_OBUF     (WS_CDEC + (size_t)BATCH * 64 * SSD_HEADS * 4)
#define WS_LSE      (WS_OBUF + (size_t)3 * T_PROMPT * ATT_WIDTH * 2)
#define WS_ROPE     (WS_LSE + (size_t)3 * T_PROMPT * 8 * 4)
#define WS_END      (WS_ROPE + (size_t)SEQ * 64 * 4)

#define LDS_BYTES (160 * 1024)

#define KP const __attribute__((address_space(4))) Params* kp = (const __attribute__((address_space(4))) Params*)__builtin_amdgcn_kernarg_segment_ptr(); asm volatile("" : "+s"(kp)); unsigned char* ws = kp->ws; (void)ws;
#define IN(i) (kp->in[i])
#define WSP(T, off) ((T*)(ws + (off)))
__global__ void __launch_bounds__(512, 2) mega_fwd(Params p) {
    extern __shared__ __attribute__((aligned(16))) unsigned char smem[];
    if (threadIdx.x == 0) *(uint4*)smem = make_uint4(0u, 0u, 0u, 0u);
    __syncthreads();
    XcdBarrier bar = xcd_barrier_post(p.bar, (volatile LAS unsigned*)smem);
    float* lds = (float*)(smem + 256);
    LAS unsigned char* ldsb = (LAS unsigned char*)smem + 256;

    { KP ph_prologue(ldsb, IN(0), IN(1), WSP(bf16, WS_A0), IN(6), WSP(bf16, WS_WTIN), WSP(float, WS_ROPE)); }
    xcd_barrier(bar);
    { KP pg8::Gemm g{WSP(bf16, WS_A0), WSP(bf16, WS_WTIN), T_ALL, PROJ_LD, D_MODEL}; pg8::StaticOrder S; S.init(g.M, g.N, (int)gridDim.x, (int)blockIdx.x);
      pg8::EpiProj E{WSP(bf16, WS_PROJB), WSP(float, WS_DTRAW)}; pg8::gemm_phase<pg8::EpiProj, pg8::StaticOrder, false>(ldsb, g, S, E, nullptr); }
    xcd_barrier(bar);
    { KP ph_post_proj_prompt(WSP(bf16, WS_PROJB), WSP(float, WS_DTRAW), IN(7), IN(8), IN(9), WSP(float, WS_ROPE), WSP(bf16, WS_XBCB), WSP(float, WS_DT), WSP(bf16, WS_QROTB), WSP(bf16, WS_KROTB), kp->out); }
    { KP ph_post_proj2(WSP(bf16, WS_PROJB), WSP(float, WS_DTRAW), IN(4), IN(7), IN(8), IN(9), WSP(bf16, WS_XBCB), WSP(float, WS_DT), WSP(bf16, WS_QROTB), WSP(bf16, WS_KROTB), kp->out); }
    xcd_barrier(bar);
    { KP ph_ssd_states(ldsb, WSP(bf16, WS_XBCB), WSP(float, WS_DT), IN(10), WSP(bf16, WS_SBUF), WSP(float, WS_CDEC), IN(2), IN(3), kp->out); }
    __syncthreads();
    { KP ph_attn_prompt(ldsb, WSP(bf16, WS_QROTB), WSP(bf16, WS_KROTB), WSP(bf16, WS_PROJB), WSP(bf16, WS_OBUF), WSP(float, WS_LSE), IN(2), IN(3), kp->out); }
    __syncthreads();
    { KP ph_ssd_decode(WSP(bf16, WS_XBCB), WSP(float, WS_DT), IN(10), IN(11), IN(5), WSP(float, WS_YBUF), kp->out); }
    { KP ph_attn_sample3(lds, WSP(bf16, WS_QROTB), WSP(bf16, WS_KROTB), WSP(bf16, WS_PROJB), IN(2), IN(3), WSP(bf16, WS_A1)); }
    xcd_barrier(bar);
    if ((int)gridDim.x > 128) {
        if ((int)blockIdx.x < 96) { KP ph_ssd_scan(WSP(bf16, WS_SBUF), WSP(float, WS_CDEC), WSP(bf16, WS_HIN), kp->out, (int)blockIdx.x, 96); }
        else {
            { KP ph_prologue2(ldsb, IN(13), WSP(bf16, WS_WTOUT), IN(16), WSP(bf16, WS_WTQ), (int)blockIdx.x - 96, (int)gridDim.x - 96); }
            { KP ph_quant_tables(IN(19), IN(20), WSP(unsigned char, WS_UB), WSP(unsigned char, WS_VB), WSP(float, WS_USC), WSP(float, WS_VSC), (int)blockIdx.x - 96, (int)gridDim.x - 96); }
        }
    } else {
        { KP ph_ssd_scan(WSP(bf16, WS_SBUF), WSP(float, WS_CDEC), WSP(bf16, WS_HIN), kp->out, (int)blockIdx.x, (int)gridDim.x); }
        { KP ph_prologue2(ldsb, IN(13), WSP(bf16, WS_WTOUT), IN(16), WSP(bf16, WS_WTQ), (int)blockIdx.x, (int)gridDim.x); }
        { KP ph_quant_tables(IN(19), IN(20), WSP(unsigned char, WS_UB), WSP(unsigned char, WS_VB), WSP(float, WS_USC), WSP(float, WS_VSC), (int)blockIdx.x, (int)gridDim.x); }
    }
    xcd_barrier(bar);
    { KP ph_ssd_out(ldsb, WSP(bf16, WS_XBCB), WSP(bf16, WS_PROJB), WSP(float, WS_DT), IN(10), IN(11), IN(12), WSP(bf16, WS_HIN), WSP(bf16, WS_A1)); }
    { KP ph_attn_combine(WSP(bf16, WS_OBUF), WSP(float, WS_LSE), WSP(bf16, WS_A1)); }
    { KP ph_gate_norm(WSP(bf16, WS_PROJB), IN(12), WSP(float, WS_YBUF), WSP(bf16, WS_A1)); }
    xcd_barrier(bar);
    { KP pg8::Gemm g{WSP(bf16, WS_A1), WSP(bf16, WS_WTOUT), T_ALL, D_MODEL, MIX_WIDTH}; pg8::StaticOrder S; S.init(g.M, g.N, (int)gridDim.x, (int)blockIdx.x);
      pg8::EpiBf16Plain E{WSP(bf16, WS_MIX), D_MODEL}; pg8::gemm_phase<pg8::EpiBf16Plain, pg8::StaticOrder, false>(ldsb, g, S, E, nullptr); }
    if (blockIdx.x >= 8 && gridDim.x == 256) { KP cache_copy_slice(IN(2), IN(3), kp->out, 4096u + (blockIdx.x - 8) * 8u + (threadIdx.x >> 6), threadIdx.x & 63u); }
    xcd_barrier(bar);
    { KP ph_ln_res(IN(0), IN(1), WSP(bf16, WS_MIX), IN(14), IN(15), WSP(bf16, WS_A2)); }
    xcd_barrier(bar);
    { KP pg8::Gemm g{WSP(bf16, WS_A2), WSP(bf16, WS_WTQ), T_ALL, 2048, D_MODEL}; pg8::StaticOrder S; S.init(g.M, g.N, (int)gridDim.x, (int)blockIdx.x);
      pg8::EpiBf16Plain E{WSP(bf16, WS_QH), 2048}; pg8::gemm_phase<pg8::EpiBf16Plain, pg8::StaticOrder, false>(ldsb, g, S, E, nullptr); }
    if (blockIdx.x >= 16 && gridDim.x == 256 && threadIdx.x < 256) { KP cache_copy_slice(IN(2), IN(3), kp->out, 4096u + 1984u + (blockIdx.x - 16) * 4u + (threadIdx.x >> 6), threadIdx.x & 63u); }
    xcd_barrier(bar);
    { KP ph_peer_route2(ldsb, WSP(bf16, WS_QH), IN(17), IN(18), WSP(int, WS_EIDX), WSP(float, WS_GATE), IN(2), IN(3), kp->out); }
    xcd_barrier(bar);
    { KP ph_peer_ffn3(WSP(bf16, WS_A2), WSP(int, WS_EIDX), WSP(float, WS_GATE), WSP(unsigned char, WS_UB), WSP(unsigned char, WS_VB), WSP(float, WS_USC), WSP(float, WS_VSC), IN(21), IN(22), kp->out, IN(2), IN(3), gridDim.x == 256 ? 8960u : 4096u); }
}

extern "C" void kernel_launch(void* const* d_in, const int* in_sizes, int n_in, void* d_out, int out_size, void* d_ws, size_t ws_size, hipStream_t stream) {
    static int grid = 0;
    if (grid == 0) {
        int dev = 0, cus = 0, per_cu = 0;
        if (hipGetDevice(&dev) != hipSuccess || hipDeviceGetAttribute(&cus, hipDeviceAttributeMultiprocessorCount, dev) != hipSuccess) { fprintf(stderr, "kernel_launch: device query failed\n"); grid = -1; return; }
        if (hipFuncSetAttribute((const void*)mega_fwd, hipFuncAttributeMaxDynamicSharedMemorySize, LDS_BYTES) != hipSuccess) { fprintf(stderr, "kernel_launch: hipFuncSetAttribute failed\n"); grid = -1; return; }
        if (hipOccupancyMaxActiveBlocksPerMultiprocessor(&per_cu, (const void*)mega_fwd, NTHR, LDS_BYTES) != hipSuccess || per_cu < 1) { fprintf(stderr, "kernel_launch: occupancy query says %d\n", per_cu); }
        (void)hipGetLastError();
        grid = cus;
        if (ws_size < WS_END) { fprintf(stderr, "kernel_launch: workspace too small\n"); grid = -1; return; }
    }
    if (grid < 0) return;
    (void)hipMemsetAsync((char*)d_ws + WS_BAR, 0, XCD_BAR_WORDS * sizeof(unsigned), stream);
    Params p{};
    for (int i = 0; i < 23; ++i) p.in[i] = (const float*)d_in[i];
    p.out = (float*)d_out; p.ws = (unsigned char*)d_ws; p.bar = (unsigned*)((char*)d_ws + WS_BAR);
    hipLaunchKernelGGL(mega_fwd, dim3(grid), dim3(NTHR), LDS_BYTES, stream, p);
}
```

```cpp
#include <hip/hip_runtime.h>
#include <stdint.h>

#define D_MODEL 1024
#define BATCH 2
#define SEQ 8192
#define DEC_BATCH 128
#define DEC_SEQ 4
#define PAST_LEN 8192
#define HEAD_DIM 64
#define ATT_WIDTH 512
#define ATT_HEADS 8
#define SSD_WIDTH 1536
#define SSD_HEADS 24
#define SSD_GROUPS 4
#define SSD_STATE 128
#define CONV_DIM 2560
#define IN_WIDTH 5656
#define PROJ_LD 5888
#define MIX_WIDTH 2048
#define WBUF 2048
#define PEER_NKEYS 128
#define PEER_HEADS 8
#define PEER_TOPK 16
#define PEER_DKEY 256
#define T_PROMPT (BATCH * SEQ)
#define T_SAMPLE (DEC_BATCH * DEC_SEQ)
#define T_ALL (T_PROMPT + T_SAMPLE)
#define O_Z 0
#define O_XBC 1536
#define O_DT 4096
#define O_Q 4120
#define O_K 4632
#define O_V 5144
#define ALPHA_F 1.189207115002721f
#define LN_EPS 1e-5f

#define OUT_YP 0ull
#define OUT_YS (OUT_YP + 16777216ull)
#define OUT_PK (OUT_YS + 524288ull)
#define OUT_PV (OUT_PK + 2097152ull)
#define OUT_PC (OUT_PV + 2097152ull)
#define OUT_PS (OUT_PC + 15360ull)
#define OUT_SK (OUT_PS + 393216ull)
#define OUT_SV (OUT_SK + 134217728ull)
#define OUT_SC (OUT_SV + 134217728ull)
#define OUT_SS (OUT_SC + 983040ull)

__constant__ double ROPE_INV_REV[32] = {
    1.59154943091895346e-01, 1.19349370211248862e-01, 8.94994016088910133e-02, 6.71150830052272551e-02,
    5.03292121044870353e-02, 3.77415847174197711e-02, 2.83021958306233987e-02, 2.12236527647776604e-02,
    1.59154943091895339e-02, 1.19349370211248862e-02, 8.94994016088910237e-03, 6.71150830052272534e-03,
    5.03292121044870370e-03, 3.77415847174197719e-03, 2.83021958306233987e-03, 2.12236527647776622e-03,
    1.59154943091895356e-03, 1.19349370211248849e-03, 8.94994016088910237e-04, 6.71150830052272599e-04,
    5.03292121044870326e-04, 3.77415847174197741e-04, 2.83021958306233954e-04, 2.12236527647776605e-04,
    1.59154943091895351e-04, 1.19349370211248862e-04, 8.94994016088910182e-05, 6.71150830052272545e-05,
    5.03292121044870354e-05, 3.77415847174197768e-05, 2.83021958306233961e-05, 2.12236527647776592e-05
};

__device__ __forceinline__ float silu_f(float x) { return x * __builtin_amdgcn_rcpf(1.0f + __expf(-x)); }
__device__ __forceinline__ float softplus_f(float x) { return fmaxf(x, 0.f) + log1pf(__expf(-fabsf(x))); }
__device__ __forceinline__ float gelu_f(float x) { return 0.5f * x * (1.0f + erff(x * 0.70710678118654752f)); }
__device__ __forceinline__ float wave_sum(float v) {
#pragma unroll
    for (int o = 32; o > 0; o >>= 1) v += __shfl_xor(v, o);
    return v;
}
__device__ __forceinline__ float wave_max(float v) {
#pragma unroll
    for (int o = 32; o > 0; o >>= 1) v = fmaxf(v, __shfl_xor(v, o));
    return v;
}

#include <cstdio>
#define XB_TMO      128
#define XB_XCNT(j)  (256  + 64 * (j))
#define XB_XSUB(j)  (1280 + 64 * (j))
#define XB_XGEN(j)  (2304 + 64 * (j))
#define XB_TOP      3328
#define XB_TOPGEN   3392
#define XCD_BAR_WORDS 3456
#define XB_SPIN_CAP (1u << 18)
#define LAS __attribute__((address_space(3)))

__device__ __forceinline__ unsigned xb_ld(unsigned* p)              { return __hip_atomic_load(p, __ATOMIC_RELAXED, __HIP_MEMORY_SCOPE_AGENT); }
__device__ __forceinline__ unsigned xb_add(unsigned* p, unsigned v) { return __hip_atomic_fetch_add(p, v, __ATOMIC_RELAXED, __HIP_MEMORY_SCOPE_AGENT); }
__device__ __forceinline__ unsigned xb_xcc_id() { return (unsigned)__builtin_amdgcn_s_getreg((3 << 11) | 20) & 0xFu; }
#define XB_SPIN(cond, bar) do { unsigned _sp = 0; while (cond) { __builtin_amdgcn_s_sleep(1); \
    if ((++_sp & 255u) == 0u) { if (xb_ld(&(bar)[XB_TMO])) break; if (_sp > XB_SPIN_CAP) { atomicAdd(&(bar)[XB_TMO], 1u); break; } } } } while (0)

struct XcdBarrier {
    unsigned* bar; unsigned x;
    volatile LAS unsigned* st;
};

__device__ __forceinline__ XcdBarrier xcd_barrier_post(unsigned* bar, volatile LAS unsigned* st) {
    XcdBarrier b; b.bar = bar; b.x = xb_xcc_id(); b.st = st;
    if (threadIdx.x == 0) (void)xb_add(&bar[XB_XCNT(b.x)], 1u);
    return b;
}
__device__ __forceinline__ void xcd_barrier_complete(unsigned* bar, unsigned x, unsigned& nloc, unsigned& nx) {
    const unsigned G = gridDim.x * gridDim.y * gridDim.z;
    unsigned sum, cnt, mine, sp = 0u;
    for (;;) {
        sum = 0u; cnt = 0u; mine = 0u;
#pragma unroll
        for (unsigned j = 0; j < 16; ++j) { const unsigned c = xb_ld(&bar[XB_XCNT(j)]); sum += c; cnt += (c > 0u) ? 1u : 0u; mine = (j == x) ? c : mine; }
        if (sum == G) break;
        __builtin_amdgcn_s_sleep(1);
        if ((++sp & 255u) == 0u) { if (xb_ld(&bar[XB_TMO])) break; if (sp > XB_SPIN_CAP) { atomicAdd(&bar[XB_TMO], 1u); break; } }
    }
    nloc = mine > 0u ? mine : 1u; nx = cnt > 0u ? cnt : 1u;
}

__device__ __forceinline__ void xcd_barrier(const XcdBarrier& b) {
    asm volatile("s_waitcnt vmcnt(0)" ::: "memory");
    __syncthreads();
    if (threadIdx.x == 0) {
        unsigned* bar = b.bar;
        __builtin_amdgcn_s_waitcnt(0);
        unsigned nloc = b.st[0], nx = b.st[1];
        if (nloc == 0u) { xcd_barrier_complete(bar, b.x, nloc, nx); b.st[0] = nloc; b.st[1] = nx; }
        const unsigned old = xb_add(&bar[XB_XSUB(b.x)], 1u);
        const unsigned gen = old / nloc;
        if (old + 1u == (gen + 1u) * nloc) {
            __builtin_amdgcn_fence(__ATOMIC_RELEASE, "agent");
            asm volatile("s_waitcnt vmcnt(0)" ::: "memory");
            const unsigned og = xb_add(&bar[XB_TOP], 1u);
            const unsigned tg = og / nx;
            if (og + 1u == (tg + 1u) * nx) xb_add(&bar[XB_TOPGEN], 1u);
            else XB_SPIN(xb_ld(&bar[XB_TOPGEN]) == tg, bar);
            __builtin_amdgcn_fence(__ATOMIC_ACQUIRE, "agent");
            xb_add(&bar[XB_XGEN(b.x)], 1u);
            asm volatile("s_waitcnt vmcnt(0)" ::: "memory");
        } else {
            XB_SPIN(xb_ld(&bar[XB_XGEN(b.x)]) == gen, bar);
            __builtin_amdgcn_fence(__ATOMIC_ACQUIRE, "agent");
            asm volatile("s_waitcnt vmcnt(0)" ::: "memory");
        }
    }
    __syncthreads();
}


#define GAS __attribute__((address_space(1)))
typedef unsigned short bf16;
typedef unsigned v4u __attribute__((ext_vector_type(4)));
#define LDS_WAIT() asm volatile("s_waitcnt lgkmcnt(0)" ::: "memory")
__device__ __forceinline__ unsigned f2bf(float f) { unsigned u = __builtin_bit_cast(unsigned, f); return (u + 0x7fffu + ((u >> 16) & 1u)) >> 16; }
__device__ __forceinline__ unsigned pk2(float lo, float hi) { return f2bf(lo) | (f2bf(hi) << 16); }
__device__ __forceinline__ float bf2f(unsigned short b) { return __builtin_bit_cast(float, (unsigned)b << 16); }
#include <hip/hip_runtime.h>
namespace pg8 {
#define PG8_LAS __attribute__((address_space(3)))
typedef unsigned short bf16_t;
typedef short bf16x8 __attribute__((ext_vector_type(8)));
typedef float f32x4 __attribute__((ext_vector_type(4)));
typedef unsigned u32x4 __attribute__((ext_vector_type(4)));
constexpr int BM = 256, BK = 64, HALF = 128, HTB = HALF * BK * 2  , STAGE_BYTES = 8 * HTB, NXCD = 8, WGM = 8;

__host__ __device__ __forceinline__ int lds_byte(int r, int c) { const int st = (r >> 4) * 2 + (c >> 5), rr = r & 15, cc = c & 31, ob = rr * 64 + cc * 2; return st * 1024 + (ob ^ (((ob >> 9) & 1) << 5)); }
__host__ __device__ __forceinline__ void stage_rc(int b, int& R, int& C) { const int st = b / 1024, sb = b % 1024, swz = sb ^ (((sb >> 9) & 1) << 5); R = (st >> 1) * 16 + swz / 64; C = (st & 1) * 32 + (swz % 64) / 2; }
__host__ __device__ __forceinline__ int perm32(int rho) { const int n = rho >> 4, i = rho & 15; return 8 * (i >> 2) + 4 * n + (i & 3); }

struct Unit { int pm, pn; };
struct Gemm { const bf16_t* A; const bf16_t* Bt; int M, N, K; };

struct StaticOrder {
    int nM, nN, nwg, G, c;
    __host__ __device__ void init(int M, int N, int G_, int c_) { nM = M / BM; nN = N / BM; nwg = nM * nN; G = G_; c = c_; }
    __host__ __device__ bool next(int i, Unit& u) const {
        const long L = (long)i * G + c; if (L >= nwg) return false;
        int wgid = (int)L; { const int q = nwg / NXCD, r = nwg % NXCD, xcd = wgid % NXCD, off = wgid / NXCD; wgid = (xcd < r ? xcd * (q + 1) : r * (q + 1) + (xcd - r) * q) + off; }
        const int nig = WGM * nN, gid = wgid / nig, fm = gid * WGM, gsz = (nM - fm) < WGM ? (nM - fm) : WGM;
        u.pm = fm + ((wgid % nig) % gsz); u.pn = (wgid % nig) / gsz; return true;
    }
    __device__ __forceinline__ void a_ready(const Unit&) const {}
    __device__ __forceinline__ void done(const Unit&) const {}
};
__device__ __forceinline__ unsigned cvt_pk_bf16(float lo, float hi) { unsigned r; asm volatile("v_cvt_pk_bf16_f32 %0, %1, %2" : "=v"(r) : "v"(lo), "v"(hi)); return r; }
typedef float f32x2 __attribute__((ext_vector_type(2)));
__device__ __forceinline__ f32x2 gelu_pk(f32x2 v) {
    const f32x2 av = __builtin_elementwise_abs(v), d = av * 0.2316418882f + 1.0f;
    f32x2 t; t.x = __builtin_amdgcn_rcpf(d.x); t.y = __builtin_amdgcn_rcpf(d.y);
    f32x2 q = t * 0.5307027145f + (-0.7265760135f); q = q * t + 0.7107068705f; q = q * t + (-0.142248368f); q = q * t + 0.127414796f; q = q * t;
    const f32x2 s = (v * v) * (-0.72134752044f);
    f32x2 e; e.x = __builtin_amdgcn_exp2f(s.x); e.y = __builtin_amdgcn_exp2f(s.y);
    const f32x2 m = v * (q * e), r = v - m;
    f32x2 o; o.x = v.x < 0.f ? m.x : r.x; o.y = v.y < 0.f ? m.y : r.y; return o;
}

struct EpiF32 {
    static constexpr bool PERM = false, AFTER_DRAIN = false;
    float* C; int ldc; const float* bias;
    __device__ __forceinline__ void operator()(const f32x4 (&acc)[2][2][4][2], const Unit& u, int wr, int wc, int fr, int fq) const {
        const int row0 = u.pm * BM + wr * 64 + fr, col0 = u.pn * BM + wc * 32 + 4 * fq;
        f32x4 bv[2][2];
#pragma unroll
        for (int bj = 0; bj < 2; ++bj)
#pragma unroll
            for (int n = 0; n < 2; ++n) bv[bj][n] = bias ? *(const f32x4*)(bias + col0 + bj * HALF + n * 16) : (f32x4){0.f, 0.f, 0.f, 0.f};
#pragma unroll
        for (int ai = 0; ai < 2; ++ai)
#pragma unroll
            for (int m = 0; m < 4; ++m) { float* rowp = C + (size_t)(row0 + ai * HALF + m * 16) * ldc + col0;
#pragma unroll
                for (int bj = 0; bj < 2; ++bj)
#pragma unroll
                    for (int n = 0; n < 2; ++n) *(f32x4*)(rowp + bj * HALF + n * 16) = acc[ai][bj][m][n] + bv[bj][n]; }
    }
};

template <class Epi, class Sched, bool STAMP = false>
__device__ __forceinline__ void gemm_phase(PG8_LAS unsigned char* lds, const Gemm g, const Sched& S, const Epi& E, unsigned long long* stamps) {
    int tid = threadIdx.x; asm volatile("" : "+v"(tid));
    const int wid = __builtin_amdgcn_readfirstlane(tid >> 6), lane = tid & 63, wr = wid >> 2, wc = wid & 3, fr = lane & 15, fq = lane >> 4;
    const int K = g.K, nt = K / BK;
    int ts_lo = 0, ts_hi = 0, nts = 0; const unsigned long long rt_entry = STAMP ? (unsigned long long)wall_clock64() : 0ull;
#define PG8_STAMP() do { if (STAMP && wid == 0 && nts < 64) { const unsigned long long _c = (unsigned long long)clock64(); \
        ts_lo = (lane == nts) ? (int)(unsigned)_c : ts_lo; ts_hi = (lane == nts) ? (int)(unsigned)(_c >> 32) : ts_hi; ++nts; } } while (0)
    PG8_STAMP();
    unsigned voffA[2], voffB[2];
#pragma unroll
    for (int i = 0; i < 2; ++i) { int R, C; stage_rc(tid * 16 + i * 8192, R, C); const int Rb = Epi::PERM ? ((R & ~31) + perm32(R & 31)) : R;
        voffA[i] = (unsigned)(R * K + C) * 2u; voffB[i] = (unsigned)(Rb * K + C) * 2u; }
    const size_t kstep = (size_t)(BK * 2);
    const size_t hstep = (size_t)HALF * K * 2;
    const size_t tstep = 2 * hstep;
    const unsigned ldsw = (unsigned)wid * 1024u;
    const int aoff = lds_byte(wr * 64 + fr, fq * 8), boff = lds_byte(wc * 32 + fr, fq * 8);
#define PG8_SA(b, h) (((b) * 2 + (h)) * HTB)
#define PG8_SB(b, h) ((4 + (b) * 2 + (h)) * HTB)
#define PG8_STAGE(bufoff, gbase, voff) do { _Pragma("unroll") for (int _i = 0; _i < 2; ++_i) \
        __builtin_amdgcn_global_load_lds((const unsigned*)((const char*)(gbase) + (voff)[_i]), (PG8_LAS unsigned*)(lds + (bufoff) + ldsw + _i * 8192), 16, 0, 0); } while (0)
#define PG8_LDA(dst, b, h) do { _Pragma("unroll") for (int m = 0; m < 4; ++m) _Pragma("unroll") for (int k = 0; k < 2; ++k) dst[m][k] = *(const PG8_LAS bf16x8*)(lds + PG8_SA(b, h) + aoff + m * 2048 + k * 1024); } while (0)
#define PG8_LDB(dst, b, h) do { _Pragma("unroll") for (int n = 0; n < 2; ++n) _Pragma("unroll") for (int k = 0; k < 2; ++k) dst[n][k] = *(const PG8_LAS bf16x8*)(lds + PG8_SB(b, h) + boff + n * 2048 + k * 1024); } while (0)
#define PG8_MMA(ai, bj, At, Bt) do { __builtin_amdgcn_s_setprio(1); _Pragma("unroll") for (int m = 0; m < 4; ++m) _Pragma("unroll") for (int n = 0; n < 2; ++n) _Pragma("unroll") for (int k = 0; k < 2; ++k) \
        acc[ai][bj][m][n] = __builtin_amdgcn_mfma_f32_16x16x32_bf16(Bt[n][k], At[m][k], acc[ai][bj][m][n], 0, 0, 0); __builtin_amdgcn_s_setprio(0); } while (0)
#define PG8_WAIT_V(n) asm volatile("s_waitcnt vmcnt(" #n ")" ::: "memory")
#define PG8_WAIT_L(n) asm volatile("s_waitcnt lgkmcnt(" #n ")" ::: "memory")
#define PG8_BAR __builtin_amdgcn_s_barrier()
#define PG8_SCHED __builtin_amdgcn_sched_barrier(0)
    Unit cur, nxt; int ui = 0;
    if (!S.next(0, cur)) return;
    f32x4 acc[2][2][4][2];
#pragma unroll
    for (int a = 0; a < 2; ++a)
#pragma unroll
        for (int b = 0; b < 2; ++b)
#pragma unroll
            for (int m = 0; m < 4; ++m)
#pragma unroll
                for (int n = 0; n < 2; ++n) acc[a][b][m][n] = (f32x4){0.f, 0.f, 0.f, 0.f};
    bf16x8 At[4][2], B0[2][2], B1[2][2];
    const char* cA = (const char*)g.A + (size_t)cur.pm * tstep; const char* cB = (const char*)g.Bt + (size_t)cur.pn * tstep;
    S.a_ready(cur);
    PG8_STAGE(PG8_SB(0, 0), cB, voffB); PG8_STAGE(PG8_SA(0, 0), cA, voffA); PG8_STAGE(PG8_SB(0, 1), cB + hstep, voffB); PG8_STAGE(PG8_SA(0, 1), cA + hstep, voffA);
    if (wr == 1) PG8_BAR;
    PG8_WAIT_V(4); PG8_BAR;
    PG8_STAGE(PG8_SB(1, 0), cB + kstep, voffB); PG8_STAGE(PG8_SA(1, 0), cA + kstep, voffA); PG8_STAGE(PG8_SB(1, 1), cB + hstep + kstep, voffB);
    PG8_WAIT_V(6); PG8_BAR;
    PG8_STAMP();
    for (;;) {
        const bool has_next = S.next(ui + 1, nxt);
        const char* nA = has_next ? (const char*)g.A + (size_t)nxt.pm * tstep : cA; const char* nB = has_next ? (const char*)g.Bt + (size_t)nxt.pn * tstep : cB;
        for (int t = 0; t < nt; t += 2) {
            const bool last = (t == nt - 2);
            const char* a1 = cA + (size_t)(t + 1) * kstep;
            const char* a2 = last ? nA : cA + (size_t)(t + 2) * kstep; const char* b2 = last ? nB : cB + (size_t)(t + 2) * kstep;
            const char* a3 = a2 + kstep; const char* b3 = b2 + kstep;
            if (last && has_next) S.a_ready(nxt);
            PG8_LDB(B0, 0, 0); PG8_SCHED; PG8_LDA(At, 0, 0); PG8_STAGE(PG8_SA(1, 1), a1 + hstep, voffA);
            PG8_WAIT_L(8); PG8_BAR; PG8_WAIT_L(0); PG8_MMA(0, 0, At, B0); PG8_BAR; PG8_SCHED;
            PG8_LDB(B1, 0, 1); PG8_STAGE(PG8_SB(0, 0), b2, voffB);
            PG8_BAR; PG8_WAIT_L(0); PG8_MMA(0, 1, At, B1); PG8_BAR;
            PG8_LDA(At, 0, 1); PG8_STAGE(PG8_SA(0, 0), a2, voffA);
            PG8_BAR; PG8_WAIT_L(0); PG8_MMA(1, 0, At, B0); PG8_BAR; PG8_SCHED;
            PG8_STAGE(PG8_SB(0, 1), b2 + hstep, voffB);
            PG8_WAIT_V(6); PG8_BAR; PG8_MMA(1, 1, At, B1); PG8_BAR;
            PG8_LDB(B0, 1, 0); PG8_SCHED; PG8_LDA(At, 1, 0); PG8_STAGE(PG8_SA(0, 1), a2 + hstep, voffA);
            PG8_WAIT_L(8); PG8_BAR; PG8_WAIT_L(0); PG8_MMA(0, 0, At, B0); PG8_BAR; PG8_SCHED;
            PG8_LDB(B1, 1, 1); PG8_STAGE(PG8_SB(1, 0), b3, voffB);
            PG8_BAR; PG8_WAIT_L(0); PG8_MMA(0, 1, At, B1); PG8_BAR;
            PG8_LDA(At, 1, 1); PG8_STAGE(PG8_SA(1, 0), a3, voffA);
            PG8_BAR; PG8_WAIT_L(0); PG8_MMA(1, 0, At, B0); PG8_BAR; PG8_SCHED;
            PG8_STAGE(PG8_SB(1, 1), b3 + hstep, voffB);
            PG8_WAIT_V(6); PG8_BAR; PG8_MMA(1, 1, At, B1); PG8_BAR;
        }
        PG8_STAMP();
        if constexpr (!Epi::AFTER_DRAIN) { E(acc, cur, wr, wc, fr, fq); S.done(cur); }
        PG8_STAMP();
        if (!has_next) break;
#pragma unroll
        for (int a = 0; a < 2; ++a)
#pragma unroll
            for (int b = 0; b < 2; ++b)
#pragma unroll
                for (int m = 0; m < 4; ++m)
#pragma unroll
                    for (int n = 0; n < 2; ++n) acc[a][b][m][n] = (f32x4){0.f, 0.f, 0.f, 0.f};
        cur = nxt; cA = nA; cB = nB; ++ui;
    }
    PG8_WAIT_V(0);
    if (wr == 0) PG8_BAR;
    PG8_BAR;
    if constexpr (Epi::AFTER_DRAIN) { E.fused(acc, cur, wr, wc, fr, fq, lds, wid, lane); S.done(cur); }
    PG8_STAMP();
    if (STAMP && wid == 0) { stamps[lane] = lane < nts ? (((unsigned long long)(unsigned)ts_hi << 32) | (unsigned)ts_lo) : 0ull;
        if (lane == 62) stamps[62] = rt_entry; if (lane == 63) stamps[63] = (unsigned long long)wall_clock64(); }
#undef PG8_STAMP
#undef PG8_SA
#undef PG8_SB
#undef PG8_STAGE
#undef PG8_LDA
#undef PG8_LDB
#undef PG8_MMA
#undef PG8_WAIT_V
#undef PG8_WAIT_L
#undef PG8_BAR
#undef PG8_SCHED
}
}


namespace pg8 {
struct EpiProj {
    static constexpr bool PERM = true, AFTER_DRAIN = false;
    bf16_t* O; float* dtraw;
    __device__ __forceinline__ void operator()(const f32x4 (&acc)[2][2][4][2], const Unit& u, int wr, int wc, int fr, int fq) const {
        const int row0 = u.pm * BM + wr * 64 + fr;
        if (u.pn < 22) {
            const int col0 = u.pn * BM + wc * 32 + 8 * fq;
#pragma unroll
            for (int ai = 0; ai < 2; ++ai)
#pragma unroll
                for (int m = 0; m < 4; ++m) { bf16_t* rowp = O + (size_t)(row0 + ai * HALF + m * 16) * 5632 + col0;
#pragma unroll
                    for (int bj = 0; bj < 2; ++bj) { const f32x4 v0 = acc[ai][bj][m][0], v1 = acc[ai][bj][m][1];
                        u32x4 w; w.x = cvt_pk_bf16(v0[0], v0[1]); w.y = cvt_pk_bf16(v0[2], v0[3]); w.z = cvt_pk_bf16(v1[0], v1[1]); w.w = cvt_pk_bf16(v1[2], v1[3]);
                        *(u32x4*)(rowp + bj * HALF) = w; } }
        } else if (wc == 0) {
#pragma unroll
            for (int ai = 0; ai < 2; ++ai)
#pragma unroll
                for (int m = 0; m < 4; ++m) { float* rp = dtraw + (size_t)(row0 + ai * HALF + m * 16) * 32 + 8 * fq;
                    *(f32x4*)rp = acc[ai][0][m][0]; *(f32x4*)(rp + 4) = acc[ai][0][m][1]; }
        }
    }
};
}


namespace pg8 {
struct EpiBf16Plain {
    static constexpr bool PERM = true, AFTER_DRAIN = false;
    bf16_t* O; int ldc;
    __device__ __forceinline__ void operator()(const f32x4 (&acc)[2][2][4][2], const Unit& u, int wr, int wc, int fr, int fq) const {
        const int row0 = u.pm * BM + wr * 64 + fr, col0 = u.pn * BM + wc * 32 + 8 * fq;
#pragma unroll
        for (int ai = 0; ai < 2; ++ai)
#pragma unroll
            for (int m = 0; m < 4; ++m) { bf16_t* rowp = O + (size_t)(row0 + ai * HALF + m * 16) * ldc + col0;
#pragma unroll
                for (int bj = 0; bj < 2; ++bj) { const f32x4 v0 = acc[ai][bj][m][0], v1 = acc[ai][bj][m][1];
                    u32x4 w; w.x = cvt_pk_bf16(v0[0], v0[1]); w.y = cvt_pk_bf16(v0[2], v0[3]); w.z = cvt_pk_bf16(v1[0], v1[1]); w.w = cvt_pk_bf16(v1[2], v1[3]);
                    *(u32x4*)(rowp + bj * HALF) = w; } }
    }
};
}

#define NTHR 512
#define NWAVE 8

__device__ __forceinline__ void ph_gemm_f32(float* lds, const float* __restrict__ A, const float* __restrict__ B, float* __restrict__ C,
                                            int M, int N, int K, int lda, int ldb, int ldc) {
    const int tid = threadIdx.x & 255, half = threadIdx.x >> 8, tx = tid & 15, ty = tid >> 4;
    float (*As)[68] = (float (*)[68])(lds + half * 2 * 16 * 68);
    float (*Bs)[68] = (float (*)[68])(lds + half * 2 * 16 * 68 + 16 * 68);
    const int ntx = (N + 63) / 64, nty = M / 64, ntiles = ntx * nty;
    for (int it = blockIdx.x; 2 * it < ntiles; it += gridDim.x) {
        const int tile = 2 * it + half;
        const int m0 = (tile / ntx) * 64, n0 = (tile % ntx) * 64;
        float acc[4][4];
#pragma unroll
        for (int i = 0; i < 4; ++i)
#pragma unroll
            for (int j = 0; j < 4; ++j) acc[i][j] = 0.f;
        for (int k0 = 0; k0 < K; k0 += 16) {
#pragma unroll
            for (int i = 0; i < 4; ++i) {
                int idx = tid + i * 256;
                int r = idx >> 4, c = idx & 15;
                As[c][r] = (m0 + r < M) ? A[(size_t)(m0 + r) * lda + k0 + c] : 0.f;
                int rb = idx >> 6, cb = idx & 63;
                Bs[rb][cb] = (n0 + cb < N) ? B[(size_t)(k0 + rb) * ldb + n0 + cb] : 0.f;
            }
            __syncthreads();
#pragma unroll
            for (int k = 0; k < 16; ++k) {
                float a[4], b[4];
#pragma unroll
                for (int i = 0; i < 4; ++i) { a[i] = As[k][ty * 4 + i]; b[i] = Bs[k][tx * 4 + i]; }
#pragma unroll
                for (int i = 0; i < 4; ++i)
#pragma unroll
                    for (int j = 0; j < 4; ++j) acc[i][j] += a[i] * b[j];
            }
            __syncthreads();
        }
#pragma unroll
        for (int i = 0; i < 4; ++i)
#pragma unroll
            for (int j = 0; j < 4; ++j) {
                int r = m0 + ty * 4 + i, c = n0 + tx * 4 + j;
                if (r < M && c < N) C[(size_t)r * ldc + c] = acc[i][j];
            }
    }
}


template <int MODE>
__device__ __forceinline__ void transpose_item(const float* __restrict__ W, int K, int N, int Npad, bf16* __restrict__ WT, LAS float* scr, int item, int lane) {
    const int nblk = Npad / 32, kb = item / nblk, nb = item % nblk, k0 = 64 * kb, n0 = 32 * nb;
    const int n = n0 + (lane & 31);
    int sc = n;
    if (MODE == 1) sc = (n < 4096) ? n : (n < 5632 ? n + 24 : (n < 5656 ? n - 5632 + 4096 : -1));
    else sc = (n < N) ? n : -1;
#pragma unroll 8
    for (int i = 0; i < 32; ++i) { const int kk = 2 * i + (lane >> 5); scr[kk * 33 + (lane & 31)] = (sc >= 0) ? W[(size_t)(k0 + kk) * N + sc] : 0.f; }
    LDS_WAIT(); asm volatile("" ::: "memory");
    const int c = lane & 7;
#pragma unroll
    for (int j = 0; j < 4; ++j) { const int nn = (lane >> 3) + 8 * j; const LAS float* s = scr + (8 * c) * 33 + nn;
        v4u o; o.x = pk2(s[0 * 33], s[1 * 33]); o.y = pk2(s[2 * 33], s[3 * 33]); o.z = pk2(s[4 * 33], s[5 * 33]); o.w = pk2(s[6 * 33], s[7 * 33]);
        *(v4u*)(WT + (size_t)(n0 + nn) * K + k0 + 8 * c) = o; }
    LDS_WAIT(); asm volatile("" ::: "memory");
}
__device__ __forceinline__ void ph_prologue(LAS unsigned char* ldsb, const float* __restrict__ xp, const float* __restrict__ xs, bf16* __restrict__ A0,
                                            const float* __restrict__ w_in, bf16* __restrict__ wt_in, float* __restrict__ rope_tab) {
    const int lane = threadIdx.x & 63, wave = threadIdx.x >> 6;
    LAS float* scr = (LAS float*)(ldsb + wave * 16384);
    const int gw = blockIdx.x * NWAVE + wave, NGW = gridDim.x * NWAVE;
    constexpr int I_IN = (D_MODEL / 64) * (PROJ_LD / 32);
    for (int it = gw; it < I_IN; it += NGW) transpose_item<1>(w_in, D_MODEL, IN_WIDTH, PROJ_LD, wt_in, scr, it, lane);
    for (int idx = blockIdx.x * NTHR + threadIdx.x; idx < SEQ * 32; idx += gridDim.x * NTHR) {
        const int pos = idx >> 5, j = idx & 31;
        const double rev = (double)pos * ROPE_INV_REV[j];
        const float fr = (float)(rev - floor(rev));
        rope_tab[(size_t)pos * 64 + j] = __builtin_amdgcn_cosf(fr); rope_tab[(size_t)pos * 64 + 32 + j] = __builtin_amdgcn_sinf(fr);
    }
    const size_t n8 = (size_t)T_ALL * D_MODEL / 8, np8 = (size_t)T_PROMPT * D_MODEL / 8;
#pragma unroll 4
    for (size_t i = (size_t)blockIdx.x * NTHR + threadIdx.x; i < n8; i += (size_t)gridDim.x * NTHR) {
        const float4* s = (i < np8) ? (const float4*)xp + 2 * i : (const float4*)xs + 2 * (i - np8);
        float4 a = s[0], b = s[1];
        v4u o; o.x = pk2(a.x, a.y); o.y = pk2(a.z, a.w); o.z = pk2(b.x, b.y); o.w = pk2(b.z, b.w);
        ((v4u*)A0)[i] = o;
    }
}
__device__ __forceinline__ void ph_prologue2(LAS unsigned char* ldsb, const float* __restrict__ w_out, bf16* __restrict__ wt_out, const float* __restrict__ w_q, bf16* __restrict__ wt_q,
                                             int rank, int nranks) {
    const int lane = threadIdx.x & 63, wave = threadIdx.x >> 6;
    LAS float* scr = (LAS float*)(ldsb + wave * 16384);
    constexpr int I_OUT = (MIX_WIDTH / 64) * (D_MODEL / 32), I_Q = (D_MODEL / 64) * (2048 / 32);
    for (int it = rank * NWAVE + wave; it < I_OUT + I_Q; it += nranks * NWAVE) {
        if (it < I_OUT) transpose_item<0>(w_out, MIX_WIDTH, D_MODEL, D_MODEL, wt_out, scr, it, lane);
        else transpose_item<0>(w_q, D_MODEL, 2048, 2048, wt_q, scr, it - I_OUT, lane);
    }
}

__device__ __forceinline__ void ph_concat_x(const float* __restrict__ xp, const float* __restrict__ xs, float* __restrict__ xall) {
    const size_t n4 = (size_t)T_ALL * D_MODEL / 4, np4 = (size_t)T_PROMPT * D_MODEL / 4;
    for (size_t i = (size_t)blockIdx.x * NTHR + threadIdx.x; i < n4; i += (size_t)gridDim.x * NTHR) {
        float4 v = (i < np4) ? ((const float4*)xp)[i] : ((const float4*)xs)[i - np4];
        ((float4*)xall)[i] = v;
    }
}

typedef float f32x4n __attribute__((ext_vector_type(4)));
__device__ __forceinline__ void ph_cache_copy(const float* __restrict__ ck, const float* __restrict__ cv, float* __restrict__ out) {
    constexpr unsigned PER_B = (WBUF - DEC_SEQ) * ATT_WIDTH / 4;
    constexpr unsigned TOTAL = 2u * DEC_BATCH * PER_B;
    for (unsigned c = blockIdx.x; c < TOTAL / 4096u; c += gridDim.x) {
        f32x4n v[8]; size_t dsti[8]; bool isv[8];
#pragma unroll
        for (int j = 0; j < 8; ++j) {
            const unsigned idx = c * 4096u + j * 512u + threadIdx.x;
            const unsigned tb = idx / PER_B, r = idx - tb * PER_B, bb = tb & (DEC_BATCH - 1);
            isv[j] = tb >= DEC_BATCH;
            const size_t srci = (size_t)bb * (WBUF * ATT_WIDTH / 4) + (DEC_SEQ * ATT_WIDTH / 4) + r;
            dsti[j] = (size_t)bb * (WBUF * ATT_WIDTH / 4) + r;
            v[j] = __builtin_nontemporal_load((isv[j] ? (const f32x4n*)cv : (const f32x4n*)ck) + srci);
        }
#pragma unroll
        for (int j = 0; j < 8; ++j) __builtin_nontemporal_store(v[j], (f32x4n*)(out + (isv[j] ? OUT_SV : OUT_SK)) + dsti[j]);
    }
}

__device__ __forceinline__ void ph_post_proj(const float* __restrict__ proj, const float* __restrict__ state_conv,
                                             const float* __restrict__ conv_w, const float* __restrict__ conv_b, const float* __restrict__ dt_bias,
                                             float* __restrict__ xbc_act, float* __restrict__ dtv, float* __restrict__ qrot, float* __restrict__ krot,
                                             float* __restrict__ out) {
    const int tid = threadIdx.x & 255, half = threadIdx.x >> 8;
    for (int t = 2 * blockIdx.x + half; t < T_ALL; t += 2 * gridDim.x) {
        const bool is_p = t < T_PROMPT;
        int b, i, pos;
        if (is_p) { b = t / SEQ; i = t % SEQ; pos = i; } else { int ts = t - T_PROMPT; b = ts / DEC_SEQ; i = ts % DEC_SEQ; pos = PAST_LEN + i; }
        const float* row = proj + (size_t)t * PROJ_LD;
        for (int c = tid; c < CONV_DIM; c += 256) {
            float acc = conv_b[c];
#pragma unroll
            for (int tap = 0; tap < 4; ++tap) {
                int r = i - 3 + tap;
                float val;
                if (r >= 0) val = proj[(size_t)(t - i + r) * PROJ_LD + O_XBC + c];
                else val = is_p ? 0.f : state_conv[((size_t)b * 3 + (3 + r)) * CONV_DIM + c];
                acc += val * conv_w[tap * CONV_DIM + c];
            }
            xbc_act[(size_t)t * CONV_DIM + c] = silu_f(acc);
        }
        if (tid < SSD_HEADS) dtv[(size_t)t * SSD_HEADS + tid] = softplus_f(row[O_DT + tid] + dt_bias[tid]);
        for (int idx = tid; idx < 512; idx += 256) {
            int which = idx >> 8, h = (idx >> 5) & 7, j = idx & 31;
            double rev = (double)pos * ROPE_INV_REV[j];
            float fr = (float)(rev - floor(rev));
            float sn = __builtin_amdgcn_sinf(fr), cs = __builtin_amdgcn_cosf(fr);
            const float* src = row + (which ? O_K : O_Q) + h * 64;
            float t1 = src[j], t2 = src[j + 32];
            float o1 = t1 * cs - t2 * sn, o2 = t2 * cs + t1 * sn;
            float* dst = (which ? krot : qrot) + (size_t)t * ATT_WIDTH + h * 64;
            dst[j] = o1; dst[j + 32] = o2;
            if (which) {
                if (is_p) { if (i >= SEQ - WBUF) { float* o = out + OUT_PK + ((size_t)b * WBUF + (i - (SEQ - WBUF))) * ATT_WIDTH + h * 64; o[j] = o1; o[j + 32] = o2; } }
                else { float* o = out + OUT_SK + ((size_t)b * WBUF + (WBUF - DEC_SEQ + i)) * ATT_WIDTH + h * 64; o[j] = o1; o[j + 32] = o2; }
            }
        }
        for (int c = tid; c < ATT_WIDTH; c += 256) {
            float v = row[O_V + c];
            if (is_p) { if (i >= SEQ - WBUF) out[OUT_PV + ((size_t)b * WBUF + (i - (SEQ - WBUF))) * ATT_WIDTH + c] = v; }
            else out[OUT_SV + ((size_t)b * WBUF + (WBUF - DEC_SEQ + i)) * ATT_WIDTH + c] = v;
        }
        if (is_p) {
            if (i >= SEQ - 3) { int r = i - (SEQ - 3); for (int c = tid; c < CONV_DIM; c += 256) out[OUT_PC + ((size_t)b * 3 + r) * CONV_DIM + c] = row[O_XBC + c]; }
        } else {
            if (i >= 1) { int r = i - 1; for (int c = tid; c < CONV_DIM; c += 256) out[OUT_SC + ((size_t)b * 3 + r) * CONV_DIM + c] = row[O_XBC + c]; }
        }
    }
}


#define NB_LD 5632
#define NB_XBC 1536
#define NB_Q 4096
#define NB_K 4608
#define NB_V 5120
__device__ __forceinline__ void unpack8(const v4u w, float (&f)[8]) {
    f[0] = __builtin_bit_cast(float, w.x << 16); f[1] = __builtin_bit_cast(float, w.x & 0xffff0000u);
    f[2] = __builtin_bit_cast(float, w.y << 16); f[3] = __builtin_bit_cast(float, w.y & 0xffff0000u);
    f[4] = __builtin_bit_cast(float, w.z << 16); f[5] = __builtin_bit_cast(float, w.z & 0xffff0000u);
    f[6] = __builtin_bit_cast(float, w.w << 16); f[7] = __builtin_bit_cast(float, w.w & 0xffff0000u);
}
__device__ __forceinline__ void store8f(float* d, const float (&f)[8]) { *(float4*)d = make_float4(f[0], f[1], f[2], f[3]); *(float4*)(d + 4) = make_float4(f[4], f[5], f[6], f[7]); }
__device__ __forceinline__ void ph_post_proj2(const bf16* __restrict__ projb, const float* __restrict__ dtraw, const float* __restrict__ state_conv,
                                              const float* __restrict__ conv_w, const float* __restrict__ conv_b, const float* __restrict__ dt_bias,
                                              bf16* __restrict__ xbc_b, float* __restrict__ dtv, bf16* __restrict__ qrot_b, bf16* __restrict__ krot_b,
                                              float* __restrict__ out) {
    const int tid = threadIdx.x & 255, half = threadIdx.x >> 8;
    for (int t = T_PROMPT + 2 * blockIdx.x + half; t < T_ALL; t += 2 * gridDim.x) {
        const bool is_p = t < T_PROMPT;
        int b, i, pos;
        if (is_p) { b = t / SEQ; i = t % SEQ; pos = i; } else { int ts = t - T_PROMPT; b = ts / DEC_SEQ; i = ts % DEC_SEQ; pos = PAST_LEN + i; }
        const bf16* row = projb + (size_t)t * NB_LD;
        if (tid < 64) {
            float f[8]; unpack8(*(const v4u*)(row + NB_V + tid * 8), f);
            if (is_p) { if (i >= SEQ - WBUF) store8f(out + OUT_PV + ((size_t)b * WBUF + (i - (SEQ - WBUF))) * ATT_WIDTH + tid * 8, f); }
            else store8f(out + OUT_SV + ((size_t)b * WBUF + (WBUF - DEC_SEQ + i)) * ATT_WIDTH + tid * 8, f);
        }
        for (int c8 = tid; c8 < 320; c8 += 256) {
            const int c = c8 * 8;
            float acc[8], cur[8];
            { const float4 b0 = *(const float4*)(conv_b + c), b1 = *(const float4*)(conv_b + c + 4);
              acc[0] = b0.x; acc[1] = b0.y; acc[2] = b0.z; acc[3] = b0.w; acc[4] = b1.x; acc[5] = b1.y; acc[6] = b1.z; acc[7] = b1.w; }
#pragma unroll
            for (int tap = 0; tap < 4; ++tap) {
                const int r = i - 3 + tap;
                float val[8];
                if (r >= 0) unpack8(*(const v4u*)(projb + (size_t)(t - i + r) * NB_LD + NB_XBC + c), val);
                else if (!is_p) { const float* sp = state_conv + ((size_t)b * 3 + (3 + r)) * CONV_DIM + c; const float4 s0 = *(const float4*)sp, s1 = *(const float4*)(sp + 4);
                    val[0] = s0.x; val[1] = s0.y; val[2] = s0.z; val[3] = s0.w; val[4] = s1.x; val[5] = s1.y; val[6] = s1.z; val[7] = s1.w; }
                else {
#pragma unroll
                    for (int j = 0; j < 8; ++j) val[j] = 0.f; }
                const float4 w0 = *(const float4*)(conv_w + tap * CONV_DIM + c), w1 = *(const float4*)(conv_w + tap * CONV_DIM + c + 4);
                acc[0] += val[0] * w0.x; acc[1] += val[1] * w0.y; acc[2] += val[2] * w0.z; acc[3] += val[3] * w0.w;
                acc[4] += val[4] * w1.x; acc[5] += val[5] * w1.y; acc[6] += val[6] * w1.z; acc[7] += val[7] * w1.w;
                if (tap == 3) {
#pragma unroll
                    for (int j = 0; j < 8; ++j) cur[j] = val[j]; }
            }
#pragma unroll
            for (int j = 0; j < 8; ++j) acc[j] = silu_f(acc[j]);
            v4u o; o.x = pk2(acc[0], acc[1]); o.y = pk2(acc[2], acc[3]); o.z = pk2(acc[4], acc[5]); o.w = pk2(acc[6], acc[7]);
            *(v4u*)(xbc_b + (size_t)t * CONV_DIM + c) = o;
            if (is_p) { if (i >= SEQ - 3) store8f(out + OUT_PC + ((size_t)b * 3 + (i - (SEQ - 3))) * CONV_DIM + c, cur); }
            else { if (i >= 1) store8f(out + OUT_SC + ((size_t)b * 3 + (i - 1)) * CONV_DIM + c, cur); }
        }
        if (tid < SSD_HEADS) dtv[(size_t)t * SSD_HEADS + tid] = softplus_f(dtraw[(size_t)t * 32 + tid] + dt_bias[tid]);
        if (tid < 128) {
            const int which = tid >> 6, h = (tid >> 3) & 7, jc = tid & 7;
            const bf16* src = row + (which ? NB_K : NB_Q) + h * 64 + jc * 4;
            const uint2 lo = *(const uint2*)src, hi = *(const uint2*)(src + 32);
            float t1[4], t2[4], o1[4], o2[4];
            t1[0] = __builtin_bit_cast(float, lo.x << 16); t1[1] = __builtin_bit_cast(float, lo.x & 0xffff0000u); t1[2] = __builtin_bit_cast(float, lo.y << 16); t1[3] = __builtin_bit_cast(float, lo.y & 0xffff0000u);
            t2[0] = __builtin_bit_cast(float, hi.x << 16); t2[1] = __builtin_bit_cast(float, hi.x & 0xffff0000u); t2[2] = __builtin_bit_cast(float, hi.y << 16); t2[3] = __builtin_bit_cast(float, hi.y & 0xffff0000u);
#pragma unroll
            for (int e = 0; e < 4; ++e) {
                const double rev = (double)pos * ROPE_INV_REV[jc * 4 + e];
                const float fr = (float)(rev - floor(rev));
                const float sn = __builtin_amdgcn_sinf(fr), cs = __builtin_amdgcn_cosf(fr);
                o1[e] = t1[e] * cs - t2[e] * sn; o2[e] = t2[e] * cs + t1[e] * sn;
            }
            const size_t doff = (size_t)t * ATT_WIDTH + h * 64 + jc * 4;
            bf16* db = which ? krot_b : qrot_b;
            *(uint2*)(db + doff) = make_uint2(pk2(o1[0], o1[1]), pk2(o1[2], o1[3])); *(uint2*)(db + doff + 32) = make_uint2(pk2(o2[0], o2[1]), pk2(o2[2], o2[3]));
            if (which) {
                float* o = nullptr;
                if (is_p) { if (i >= SEQ - WBUF) o = out + OUT_PK + ((size_t)b * WBUF + (i - (SEQ - WBUF))) * ATT_WIDTH + h * 64 + jc * 4; }
                else o = out + OUT_SK + ((size_t)b * WBUF + (WBUF - DEC_SEQ + i)) * ATT_WIDTH + h * 64 + jc * 4;
                if (o) { *(float4*)o = make_float4(o1[0], o1[1], o1[2], o1[3]); *(float4*)(o + 32) = make_float4(o2[0], o2[1], o2[2], o2[3]); }
            }
        }
    }
}


__device__ __forceinline__ void ph_post_proj_prompt(const bf16* __restrict__ projb, const float* __restrict__ dtraw, const float* __restrict__ conv_w, const float* __restrict__ conv_b,
                                                    const float* __restrict__ dt_bias, const float* __restrict__ rope_tab, bf16* __restrict__ xbc_b, float* __restrict__ dtv,
                                                    bf16* __restrict__ qrot_b, bf16* __restrict__ krot_b, float* __restrict__ out) {
    const int gtid = blockIdx.x * NTHR + threadIdx.x, gsz = gridDim.x * NTHR;
    for (int item = gtid; item < (T_PROMPT / 16) * 320; item += gsz) {
        const int run = item / 320, c = (item - run * 320) * 8, t0 = run * 16, i0 = t0 & (SEQ - 1), b = t0 >> 13;
        float w[4][8], bias[8];
#pragma unroll
        for (int tap = 0; tap < 4; ++tap) { const float4 w0 = *(const float4*)(conv_w + tap * CONV_DIM + c), w1 = *(const float4*)(conv_w + tap * CONV_DIM + c + 4);
            w[tap][0] = w0.x; w[tap][1] = w0.y; w[tap][2] = w0.z; w[tap][3] = w0.w; w[tap][4] = w1.x; w[tap][5] = w1.y; w[tap][6] = w1.z; w[tap][7] = w1.w; }
        { const float4 b0 = *(const float4*)(conv_b + c), b1 = *(const float4*)(conv_b + c + 4);
          bias[0] = b0.x; bias[1] = b0.y; bias[2] = b0.z; bias[3] = b0.w; bias[4] = b1.x; bias[5] = b1.y; bias[6] = b1.z; bias[7] = b1.w; }
        const bf16* src = projb + (size_t)t0 * NB_LD + NB_XBC + c;
        v4u raw[19];
#pragma unroll
        for (int s = 0; s < 19; ++s) { v4u z; z.x = 0u; z.y = 0u; z.z = 0u; z.w = 0u; raw[s] = (s >= 3 || i0 != 0) ? *(const v4u*)(src + (ptrdiff_t)(s - 3) * NB_LD) : z; }
        float p0[8], p1[8], p2[8];
        unpack8(raw[0], p0); unpack8(raw[1], p1); unpack8(raw[2], p2);
#pragma unroll
        for (int s = 0; s < 16; ++s) {
            float cur[8], acc[8]; unpack8(raw[s + 3], cur);
#pragma unroll
            for (int j = 0; j < 8; ++j) acc[j] = silu_f(bias[j] + p0[j] * w[0][j] + p1[j] * w[1][j] + p2[j] * w[2][j] + cur[j] * w[3][j]);
            v4u o; o.x = pk2(acc[0], acc[1]); o.y = pk2(acc[2], acc[3]); o.z = pk2(acc[4], acc[5]); o.w = pk2(acc[6], acc[7]);
            *(v4u*)(xbc_b + (size_t)(t0 + s) * CONV_DIM + c) = o;
            if (i0 + s >= SEQ - 3) store8f(out + OUT_PC + ((size_t)b * 3 + (i0 + s - (SEQ - 3))) * CONV_DIM + c, cur);
#pragma unroll
            for (int j = 0; j < 8; ++j) { p0[j] = p1[j]; p1[j] = p2[j]; p2[j] = cur[j]; }
        }
    }
#pragma unroll 4
    for (int item = gtid; item < T_PROMPT * 128; item += gsz) {
        const int t = item >> 7, sub = item & 127, which = sub >> 6, h = (sub >> 3) & 7, jc = sub & 7, i = t & (SEQ - 1), b = t >> 13;
        const bf16* src = projb + (size_t)t * NB_LD + (which ? NB_K : NB_Q) + h * 64 + jc * 4;
        const uint2 lo = *(const uint2*)src, hi = *(const uint2*)(src + 32);
        const float4 cs = *(const float4*)(rope_tab + (size_t)i * 64 + jc * 4), sn = *(const float4*)(rope_tab + (size_t)i * 64 + 32 + jc * 4);
        float t1[4], t2[4], o1[4], o2[4];
        t1[0] = __builtin_bit_cast(float, lo.x << 16); t1[1] = __builtin_bit_cast(float, lo.x & 0xffff0000u); t1[2] = __builtin_bit_cast(float, lo.y << 16); t1[3] = __builtin_bit_cast(float, lo.y & 0xffff0000u);
        t2[0] = __builtin_bit_cast(float, hi.x << 16); t2[1] = __builtin_bit_cast(float, hi.x & 0xffff0000u); t2[2] = __builtin_bit_cast(float, hi.y << 16); t2[3] = __builtin_bit_cast(float, hi.y & 0xffff0000u);
        const float cv[4] = {cs.x, cs.y, cs.z, cs.w}, sv[4] = {sn.x, sn.y, sn.z, sn.w};
#pragma unroll
        for (int e = 0; e < 4; ++e) { o1[e] = t1[e] * cv[e] - t2[e] * sv[e]; o2[e] = t2[e] * cv[e] + t1[e] * sv[e]; }
        const size_t doff = (size_t)t * ATT_WIDTH + h * 64 + jc * 4;
        bf16* db = which ? krot_b : qrot_b;
        *(uint2*)(db + doff) = make_uint2(pk2(o1[0], o1[1]), pk2(o1[2], o1[3])); *(uint2*)(db + doff + 32) = make_uint2(pk2(o2[0], o2[1]), pk2(o2[2], o2[3]));
        if (which && i >= SEQ - WBUF) {
            float* o = out + OUT_PK + ((size_t)b * WBUF + (i - (SEQ - WBUF))) * ATT_WIDTH + h * 64 + jc * 4;
            *(float4*)o = make_float4(o1[0], o1[1], o1[2], o1[3]); *(float4*)(o + 32) = make_float4(o2[0], o2[1], o2[2], o2[3]);
        }
    }
#pragma unroll 4
    for (int item = gtid; item < T_PROMPT * SSD_HEADS; item += gsz) { const int t = item / SSD_HEADS, hd = item - t * SSD_HEADS; dtv[item] = softplus_f(dtraw[(size_t)t * 32 + hd] + dt_bias[hd]); }
#pragma unroll 2
    for (int item = gtid; item < BATCH * WBUF * 64; item += gsz) {
        const int ch = item & 63, j = (item >> 6) & (WBUF - 1), b = item >> 17;
        float f[8]; unpack8(*(const v4u*)(projb + (size_t)(b * SEQ + (SEQ - WBUF) + j) * NB_LD + NB_V + ch * 8), f);
        store8f(out + OUT_PV + ((size_t)b * WBUF + j) * ATT_WIDTH + ch * 8, f);
    }
}

#define SSD_CH 32
__device__ __forceinline__ void ph_ssd_naive(float* lds, const bf16* __restrict__ xbc_act, const float* __restrict__ dtv, const float* __restrict__ a_log,
                                             const float* __restrict__ d_skip, const float* __restrict__ state_ssm, float* __restrict__ ybuf, float* __restrict__ out) {
    float (*sx)[64] = (float (*)[64])lds;
    float (*sB)[128] = (float (*)[128])(lds + SSD_CH * 64);
    float (*sC)[128] = (float (*)[128])(lds + SSD_CH * 64 + SSD_CH * 128);
    float* sdt = lds + SSD_CH * 64 + 2 * SSD_CH * 128;
    const int tid = threadIdx.x, p = tid >> 3, ng = tid & 7;
    for (int vb = BATCH * SSD_HEADS + blockIdx.x; vb < (BATCH + DEC_BATCH) * SSD_HEADS; vb += gridDim.x) {
        const int seq = vb / SSD_HEADS, h = vb % SSD_HEADS, g = h / 6;
        const bool is_p = seq < BATCH;
        const int L = is_p ? SEQ : DEC_SEQ;
        const int t0 = is_p ? seq * SEQ : T_PROMPT + (seq - BATCH) * DEC_SEQ;
        const float A = -__expf(a_log[h]);
        const float D = d_skip[h];
        float hs[16];
        if (is_p) {
#pragma unroll
            for (int j = 0; j < 16; ++j) hs[j] = 0.f;
        } else {
            const float* s0 = state_ssm + (((size_t)(seq - BATCH) * SSD_HEADS + h) * 64 + p) * 128 + ng * 16;
#pragma unroll
            for (int j = 0; j < 16; ++j) hs[j] = s0[j];
        }
        for (int c0 = 0; c0 < L; c0 += SSD_CH) {
            const int nst = (L - c0) < SSD_CH ? (L - c0) : SSD_CH;
            __syncthreads();
            for (int idx = tid; idx < nst * 64; idx += NTHR) { int s = idx >> 6, c = idx & 63; sx[s][c] = bf2f(xbc_act[(size_t)(t0 + c0 + s) * CONV_DIM + h * 64 + c]); }
            for (int idx = tid; idx < nst * 128; idx += NTHR) { int s = idx >> 7, c = idx & 127;
                sB[s][c] = bf2f(xbc_act[(size_t)(t0 + c0 + s) * CONV_DIM + 1536 + g * 128 + c]);
                sC[s][c] = bf2f(xbc_act[(size_t)(t0 + c0 + s) * CONV_DIM + 2048 + g * 128 + c]); }
            if (tid < nst) sdt[tid] = dtv[(size_t)(t0 + c0 + tid) * SSD_HEADS + h];
            __syncthreads();
            for (int s = 0; s < nst; ++s) {
                const float dt = sdt[s], x = sx[s][p];
                const float a = __expf(dt * A), xdt = x * dt;
                float y = 0.f;
#pragma unroll
                for (int j = 0; j < 16; ++j) { hs[j] = a * hs[j] + xdt * sB[s][ng * 16 + j]; y += sC[s][ng * 16 + j] * hs[j]; }
                y += __shfl_xor(y, 1); y += __shfl_xor(y, 2); y += __shfl_xor(y, 4);
                if (ng == 0) ybuf[(size_t)(t0 + c0 + s) * MIX_WIDTH + h * 64 + p] = y + D * x;
            }
        }
        float* so = is_p ? out + OUT_PS + (((size_t)seq * SSD_HEADS + h) * 64 + p) * 128 + ng * 16
                         : out + OUT_SS + (((size_t)(seq - BATCH) * SSD_HEADS + h) * 64 + p) * 128 + ng * 16;
#pragma unroll
        for (int j = 0; j < 16; ++j) so[j] = hs[j];
    }
}

__device__ __forceinline__ void ph_gate_norm(const bf16* __restrict__ projb, const float* __restrict__ norm_g, const float* __restrict__ ybuf, bf16* __restrict__ A1) {
    const int w = threadIdx.x >> 6, lane = threadIdx.x & 63, g = w & 3;
    for (int t = T_PROMPT + 2 * blockIdx.x + (w >> 2); t < T_ALL; t += 2 * gridDim.x) {
        float v[6]; float ss = 0.f;
#pragma unroll
        for (int j = 0; j < 6; ++j) {
            int c = g * 384 + j * 64 + lane;
            float y = ybuf[(size_t)t * MIX_WIDTH + c], z = bf2f(projb[(size_t)t * NB_LD + c]);
            v[j] = y * silu_f(z); ss += v[j] * v[j];
        }
        ss = wave_sum(ss);
        const float r = rsqrtf(ss * (1.0f / 384.0f) + LN_EPS);
#pragma unroll
        for (int j = 0; j < 6; ++j) { int c = g * 384 + j * 64 + lane; A1[(size_t)t * MIX_WIDTH + c] = (bf16)f2bf(v[j] * r * norm_g[c]); }
    }
}

__device__ __forceinline__ void ph_attn_naive(float* lds, const float* __restrict__ proj, const float* __restrict__ qrot, const float* __restrict__ krot,
                                              const float* __restrict__ ck, const float* __restrict__ cv, float* __restrict__ ybuf) {
    float (*sq)[64] = (float (*)[64])lds;
    const int w = threadIdx.x >> 6, lane = threadIdx.x & 63;
    for (int vb = blockIdx.x; vb < T_SAMPLE * 8 / NWAVE; vb += gridDim.x) {
        const int item = T_PROMPT * 8 + vb * NWAVE + w;
        const int t = item >> 3, h = item & 7;
        const bool is_p = t < T_PROMPT;
        int b, i;
        if (is_p) { b = t / SEQ; i = t % SEQ; } else { int ts = t - T_PROMPT; b = ts / DEC_SEQ; i = ts % DEC_SEQ; }
        __syncthreads();
        sq[w][lane] = qrot[(size_t)t * ATT_WIDTH + h * 64 + lane];
        __syncthreads();
        const int qi = is_p ? i : WBUF + i;
        float sc[3][3];
        float mx = -INFINITY;
#pragma unroll
        for (int pt = 0; pt < 3; ++pt) {
            const int d = pt == 0 ? 1 : (pt == 1 ? 4 : 16);
#pragma unroll
            for (int sl = 0; sl < 3; ++sl) {
                const int m = lane + sl * 64;
                float s = -INFINITY;
                const int kj = qi - d * m;
                if (m <= 128 && kj >= 0) {
                    const float* kr;
                    if (is_p) kr = krot + (size_t)(b * SEQ + kj) * ATT_WIDTH + h * 64;
                    else kr = (kj >= WBUF) ? krot + (size_t)(T_PROMPT + b * DEC_SEQ + (kj - WBUF)) * ATT_WIDTH + h * 64
                                           : ck + ((size_t)b * WBUF + kj) * ATT_WIDTH + h * 64;
                    float a = 0.f;
#pragma unroll
                    for (int c = 0; c < 64; c += 4) { float4 kv = *(const float4*)(kr + c); a += kv.x * sq[w][c] + kv.y * sq[w][c + 1] + kv.z * sq[w][c + 2] + kv.w * sq[w][c + 3]; }
                    s = a * 0.125f;
                }
                sc[pt][sl] = s; mx = fmaxf(mx, s);
            }
        }
        mx = wave_max(mx);
        float lsum = 0.f;
#pragma unroll
        for (int pt = 0; pt < 3; ++pt)
#pragma unroll
            for (int sl = 0; sl < 3; ++sl) { float pv = (sc[pt][sl] == -INFINITY) ? 0.f : __expf(sc[pt][sl] - mx); sc[pt][sl] = pv; lsum += pv; }
        lsum = wave_sum(lsum);
        float o = 0.f;
#pragma unroll
        for (int pt = 0; pt < 3; ++pt) {
            const int d = pt == 0 ? 1 : (pt == 1 ? 4 : 16);
#pragma unroll
            for (int sl = 0; sl < 3; ++sl) {
                const int mend = sl < 2 ? 64 : 1;
                for (int ml = 0; ml < mend; ++ml) {
                    const int m = ml + sl * 64;
                    const int kj = qi - d * m;
                    const float pv = __shfl(sc[pt][sl], ml);
                    if (kj < 0) continue;
                    const float* vr;
                    if (is_p) vr = proj + (size_t)(b * SEQ + kj) * PROJ_LD + O_V + h * 64;
                    else vr = (kj >= WBUF) ? proj + (size_t)(T_PROMPT + b * DEC_SEQ + (kj - WBUF)) * PROJ_LD + O_V + h * 64
                                           : cv + ((size_t)b * WBUF + kj) * ATT_WIDTH + h * 64;
                    o += pv * vr[lane];
                }
            }
        }
        ybuf[(size_t)t * MIX_WIDTH + SSD_WIDTH + h * 64 + lane] = o / lsum;
    }
}

__device__ __forceinline__ int token_of_iter(int k) {
    const int w = __builtin_amdgcn_readfirstlane(threadIdx.x >> 6), wgl = blockIdx.x * NWAVE + w;
    if (gridDim.x != 256) { const int t = wgl + k * (int)(gridDim.x * NWAVE); return t < T_ALL ? t : -1; }
    if (k < 8) return k * 2048 + wgl;
    if (k == 8 && w < 2) return 16384 + w * 256 + (int)blockIdx.x;
    return -1;
}
__device__ __forceinline__ void ph_ln_res(const float* __restrict__ xp, const float* __restrict__ xs, const bf16* __restrict__ add, const float* __restrict__ gam,
                                          const float* __restrict__ bet, bf16* __restrict__ dstb) {
    const int lane = threadIdx.x & 63;
#pragma unroll 2
    for (int k = 0;; ++k) {
        const int t = token_of_iter(k);
        if (t < 0) break;
        const float* res = (t < T_PROMPT) ? xp + (size_t)t * D_MODEL : xs + (size_t)(t - T_PROMPT) * D_MODEL;
        float v[16]; float s = 0.f;
#pragma unroll
        for (int j = 0; j < 2; ++j) { const int c = j * 512 + lane * 8; const float4 r0 = *(const float4*)(res + c), r1 = *(const float4*)(res + c + 4);
            float a8[8]; unpack8(*(const v4u*)(add + (size_t)t * D_MODEL + c), a8);
            v[8 * j] = ALPHA_F * r0.x + a8[0]; v[8 * j + 1] = ALPHA_F * r0.y + a8[1]; v[8 * j + 2] = ALPHA_F * r0.z + a8[2]; v[8 * j + 3] = ALPHA_F * r0.w + a8[3];
            v[8 * j + 4] = ALPHA_F * r1.x + a8[4]; v[8 * j + 5] = ALPHA_F * r1.y + a8[5]; v[8 * j + 6] = ALPHA_F * r1.z + a8[6]; v[8 * j + 7] = ALPHA_F * r1.w + a8[7]; }
#pragma unroll
        for (int j = 0; j < 16; ++j) s += v[j];
        s = wave_sum(s);
        const float mu = s * (1.0f / 1024.0f);
        float q = 0.f;
#pragma unroll
        for (int j = 0; j < 16; ++j) { v[j] -= mu; q += v[j] * v[j]; }
        q = wave_sum(q);
        const float r = rsqrtf(q * (1.0f / 1024.0f) + LN_EPS);
#pragma unroll
        for (int j = 0; j < 2; ++j) { const int c = j * 512 + lane * 8; const float4 g0 = *(const float4*)(gam + c), g1 = *(const float4*)(gam + c + 4), b0 = *(const float4*)(bet + c), b1 = *(const float4*)(bet + c + 4);
            v4u o; o.x = pk2(v[8 * j] * r * g0.x + b0.x, v[8 * j + 1] * r * g0.y + b0.y); o.y = pk2(v[8 * j + 2] * r * g0.z + b0.z, v[8 * j + 3] * r * g0.w + b0.w);
            o.z = pk2(v[8 * j + 4] * r * g1.x + b1.x, v[8 * j + 5] * r * g1.y + b1.y); o.w = pk2(v[8 * j + 6] * r * g1.z + b1.z, v[8 * j + 7] * r * g1.w + b1.w);
            *(v4u*)(dstb + (size_t)t * D_MODEL + c) = o; }
    }
}

__device__ __forceinline__ void ph_peer_route(float* lds, const float* __restrict__ qh, const float* __restrict__ keys1, const float* __restrict__ keys2,
                                              int* __restrict__ eidx, float* __restrict__ gate) {
    float (*sq)[256] = (float (*)[256])lds;
    float (*sv)[2][16] = (float (*)[2][16])(lds + NWAVE * 256);
    int (*si)[2][16] = (int (*)[2][16])(lds + NWAVE * 256 + NWAVE * 32);
    const int w = threadIdx.x >> 6, lane = threadIdx.x & 63;
    for (int vb = blockIdx.x; vb < T_ALL * 8 / NWAVE; vb += gridDim.x) {
        const int item = vb * NWAVE + w;
        const int t = item >> 3, h = item & 7;
        __syncthreads();
        for (int c = lane; c < 256; c += 64) sq[w][c] = qh[(size_t)t * 2048 + h * 256 + c];
        __syncthreads();
#pragma unroll
        for (int half = 0; half < 2; ++half) {
            const float* keys = half ? keys2 : keys1;
            float s[2];
#pragma unroll
            for (int sl = 0; sl < 2; ++sl) {
                const float* kr = keys + (size_t)(lane + sl * 64) * 128;
                float a = 0.f;
#pragma unroll 8
                for (int c = 0; c < 128; c += 4) { float4 kv = *(const float4*)(kr + c); const float* qq = &sq[w][half * 128 + c]; a += kv.x * qq[0] + kv.y * qq[1] + kv.z * qq[2] + kv.w * qq[3]; }
                s[sl] = a;
            }
            for (int r = 0; r < 16; ++r) {
                float bv; int bi;
                if (s[0] >= s[1]) { bv = s[0]; bi = lane; } else { bv = s[1]; bi = lane + 64; }
#pragma unroll
                for (int o = 32; o > 0; o >>= 1) {
                    float ov = __shfl_xor(bv, o); int oi = __shfl_xor(bi, o);
                    if (ov > bv || (ov == bv && oi < bi)) { bv = ov; bi = oi; }
                }
                if (lane == 0) { sv[w][half][r] = bv; si[w][half][r] = bi; }
                if (bi == lane) s[0] = -INFINITY;
                if (bi == lane + 64) s[1] = -INFINITY;
            }
        }
        __syncthreads();
        float c[4];
#pragma unroll
        for (int j = 0; j < 4; ++j) { int ci = lane * 4 + j; c[j] = sv[w][0][ci >> 4] + sv[w][1][ci & 15]; }
        float myv = 0.f; int myc = 0;
        for (int r = 0; r < 16; ++r) {
            float bv = c[0]; int bi = lane * 4;
#pragma unroll
            for (int j = 1; j < 4; ++j) if (c[j] > bv) { bv = c[j]; bi = lane * 4 + j; }
#pragma unroll
            for (int o = 32; o > 0; o >>= 1) {
                float ov = __shfl_xor(bv, o); int oi = __shfl_xor(bi, o);
                if (ov > bv || (ov == bv && oi < bi)) { bv = ov; bi = oi; }
            }
            if (lane == r) { myv = bv; myc = bi; }
#pragma unroll
            for (int j = 0; j < 4; ++j) if (bi == lane * 4 + j) c[j] = -INFINITY;
        }
        float v = lane < 16 ? myv : -INFINITY;
        float mx = wave_max(v);
        float e = lane < 16 ? __expf(v - mx) : 0.f;
        float sum = wave_sum(e);
        if (lane < 16) {
            int ex = si[w][0][myc >> 4] * PEER_NKEYS + si[w][1][myc & 15];
            eidx[(size_t)t * 128 + h * 16 + lane] = ex;
            gate[(size_t)t * 128 + h * 16 + lane] = e / sum;
        }
    }
}

__device__ __forceinline__ void ph_peer_ffn(const float* __restrict__ hbuf, const int* __restrict__ eidx, const float* __restrict__ gate,
                                            const bf16* __restrict__ ub, const bf16* __restrict__ vb, const float* __restrict__ gam,
                                            const float* __restrict__ bet, float* __restrict__ out) {
    const int lane = threadIdx.x & 63;
    for (int t = blockIdx.x * NWAVE + (threadIdx.x >> 6); t < T_ALL; t += gridDim.x * NWAVE) {
        float x[16], acc[16];
        { const float* xr = hbuf + (size_t)t * D_MODEL + lane * 8;
          const float4 a = *(const float4*)xr, b = *(const float4*)(xr + 4), c = *(const float4*)(xr + 512), d = *(const float4*)(xr + 516);
          x[0] = a.x; x[1] = a.y; x[2] = a.z; x[3] = a.w; x[4] = b.x; x[5] = b.y; x[6] = b.z; x[7] = b.w;
          x[8] = c.x; x[9] = c.y; x[10] = c.z; x[11] = c.w; x[12] = d.x; x[13] = d.y; x[14] = d.z; x[15] = d.w; }
#pragma unroll
        for (int j = 0; j < 16; ++j) acc[j] = 0.f;
        for (int k = 0; k < 128; ++k) {
            const int e = eidx[(size_t)t * 128 + k];
            const float g = gate[(size_t)t * 128 + k];
            const bf16* ur = ub + (size_t)e * D_MODEL + lane * 8;
            float u0[8], u1[8];
            unpack8(*(const v4u*)ur, u0); unpack8(*(const v4u*)(ur + 512), u1);
            float d = 0.f;
#pragma unroll
            for (int j = 0; j < 8; ++j) d += u0[j] * x[j] + u1[j] * x[8 + j];
            d = wave_sum(d);
            const float wgt = g * gelu_f(d);
            const bf16* vr = vb + (size_t)e * D_MODEL + lane * 8;
            unpack8(*(const v4u*)vr, u0); unpack8(*(const v4u*)(vr + 512), u1);
#pragma unroll
            for (int j = 0; j < 8; ++j) { acc[j] += wgt * u0[j]; acc[8 + j] += wgt * u1[j]; }
        }
        float s = 0.f;
#pragma unroll
        for (int j = 0; j < 16; ++j) { acc[j] += ALPHA_F * x[j]; s += acc[j]; }
        s = wave_sum(s);
        const float mu = s * (1.0f / 1024.0f);
        float q = 0.f;
#pragma unroll
        for (int j = 0; j < 16; ++j) { acc[j] -= mu; q += acc[j] * acc[j]; }
        q = wave_sum(q);
        const float r = rsqrtf(q * (1.0f / 1024.0f) + LN_EPS);
        float* dst = ((t < T_PROMPT) ? out + OUT_YP + (size_t)t * D_MODEL : out + OUT_YS + (size_t)(t - T_PROMPT) * D_MODEL) + lane * 8;
#pragma unroll
        for (int q4 = 0; q4 < 4; ++q4) {
            const int eo = (q4 >> 1) * 512 + (q4 & 1) * 4;
            const float4 g4 = *(const float4*)(gam + lane * 8 + eo), b4 = *(const float4*)(bet + lane * 8 + eo);
            float4 o; o.x = acc[q4 * 4 + 0] * r * g4.x + b4.x; o.y = acc[q4 * 4 + 1] * r * g4.y + b4.y; o.z = acc[q4 * 4 + 2] * r * g4.z + b4.z; o.w = acc[q4 * 4 + 3] * r * g4.w + b4.w;
            *(float4*)(dst + eo) = o;
        }
    }
}

__device__ __forceinline__ float peer_dot16(const v4u a, const v4u b, const float (&x)[16]) {
    float u0[8], u1[8]; unpack8(a, u0); unpack8(b, u1);
    float d = 0.f;
#pragma unroll
    for (int j = 0; j < 8; ++j) d += u0[j] * x[j] + u1[j] * x[8 + j];
    return d;
}
#define PEER_TR_STEP(N, M) _Pragma("unroll") for (int i = 0; i < N; ++i) { const bool up = (lane & M) != 0; const float keep = up ? part[i + N] : part[i]; const float send = up ? part[i] : part[i + N]; part[i] = keep + __shfl_xor(send, M); }
__device__ __forceinline__ void ph_peer_ffn2(const float* __restrict__ hbuf, const int* __restrict__ eidx, const float* __restrict__ gate,
                                             const bf16* __restrict__ ub, const bf16* __restrict__ vb, const float* __restrict__ gam,
                                             const float* __restrict__ bet, float* __restrict__ out) {
    const int lane0 = threadIdx.x & 63;
    for (int t = blockIdx.x * NWAVE + (threadIdx.x >> 6); t < T_ALL; t += gridDim.x * NWAVE) {
        int lane = lane0; asm volatile("" : "+v"(lane));
        float x[16];
        { const float* xr = hbuf + (size_t)t * D_MODEL + lane * 8;
          const float4 a = *(const float4*)xr, b = *(const float4*)(xr + 4), c = *(const float4*)(xr + 512), d = *(const float4*)(xr + 516);
          x[0] = a.x; x[1] = a.y; x[2] = a.z; x[3] = a.w; x[4] = b.x; x[5] = b.y; x[6] = b.z; x[7] = b.w;
          x[8] = c.x; x[9] = c.y; x[10] = c.z; x[11] = c.w; x[12] = d.x; x[13] = d.y; x[14] = d.z; x[15] = d.w; }
        int ev[2]; float wv[4];
        ev[0] = eidx[(size_t)t * 128 + lane]; ev[1] = eidx[(size_t)t * 128 + 64 + lane];
#pragma unroll
        for (int rd = 0; rd < 4; ++rd) wv[rd] = gate[(size_t)t * 128 + rd * 32 + (lane >> 1)];
#pragma unroll
        for (int rd = 0; rd < 4; ++rd) {
            float part[32];
#pragma unroll
            for (int kb = 0; kb < 8; ++kb) {
                v4u ra[4], rb[4];
#pragma unroll
                for (int k8 = 0; k8 < 4; ++k8) {
                    const int e = __builtin_amdgcn_readlane(ev[rd >> 1], (rd & 1) * 32 + kb * 4 + k8);
                    const bf16* ur = ub + (size_t)e * D_MODEL + lane * 8;
                    ra[k8] = *(const v4u*)ur; rb[k8] = *(const v4u*)(ur + 512);
                }
#pragma unroll
                for (int k8 = 0; k8 < 4; ++k8) part[kb * 4 + k8] = peer_dot16(ra[k8], rb[k8], x);
            }
            PEER_TR_STEP(16, 32) PEER_TR_STEP(8, 16) PEER_TR_STEP(4, 8) PEER_TR_STEP(2, 4) PEER_TR_STEP(1, 2)
            const float hid = part[0] + __shfl_xor(part[0], 1);
            wv[rd] *= gelu_f(hid);
        }
        float acc[16];
#pragma unroll
        for (int j = 0; j < 16; ++j) acc[j] = 0.f;
#pragma unroll
        for (int rd = 0; rd < 4; ++rd) {
#pragma unroll
            for (int kb = 0; kb < 4; ++kb) {
                v4u ra[8], rb[8];
#pragma unroll
                for (int k8 = 0; k8 < 8; ++k8) {
                    const int e = __builtin_amdgcn_readlane(ev[rd >> 1], (rd & 1) * 32 + kb * 8 + k8);
                    const bf16* vr = vb + (size_t)e * D_MODEL + lane * 8;
                    ra[k8] = *(const v4u*)vr; rb[k8] = *(const v4u*)(vr + 512);
                }
#pragma unroll
                for (int k8 = 0; k8 < 8; ++k8) {
                    const float wk = __builtin_bit_cast(float, __builtin_amdgcn_readlane(__builtin_bit_cast(int, wv[rd]), 2 * (kb * 8 + k8)));
                    float u0[8], u1[8]; unpack8(ra[k8], u0); unpack8(rb[k8], u1);
#pragma unroll
                    for (int j = 0; j < 8; ++j) { acc[j] += wk * u0[j]; acc[8 + j] += wk * u1[j]; }
                }
            }
        }
        float s = 0.f;
#pragma unroll
        for (int j = 0; j < 16; ++j) { acc[j] += ALPHA_F * x[j]; s += acc[j]; }
        s = wave_sum(s);
        const float mu = s * (1.0f / 1024.0f);
        float q = 0.f;
#pragma unroll
        for (int j = 0; j < 16; ++j) { acc[j] -= mu; q += acc[j] * acc[j]; }
        q = wave_sum(q);
        const float r = rsqrtf(q * (1.0f / 1024.0f) + LN_EPS);
        float* dst = ((t < T_PROMPT) ? out + OUT_YP + (size_t)t * D_MODEL : out + OUT_YS + (size_t)(t - T_PROMPT) * D_MODEL) + lane * 8;
#pragma unroll
        for (int q4 = 0; q4 < 4; ++q4) {
            const int eo = (q4 >> 1) * 512 + (q4 & 1) * 4;
            const float4 g4 = *(const float4*)(gam + lane * 8 + eo), b4 = *(const float4*)(bet + lane * 8 + eo);
            float4 o; o.x = acc[q4 * 4 + 0] * r * g4.x + b4.x; o.y = acc[q4 * 4 + 1] * r * g4.y + b4.y; o.z = acc[q4 * 4 + 2] * r * g4.z + b4.z; o.w = acc[q4 * 4 + 3] * r * g4.w + b4.w;
            *(float4*)(dst + eo) = o;
        }
    }
}

__device__ __forceinline__ void ph_attn_sample(float* lds, const bf16* __restrict__ qrot_b, const bf16* __restrict__ krot_b, const bf16* __restrict__ projb,
                                               const float* __restrict__ ck, const float* __restrict__ cv, bf16* __restrict__ A1) {
    float (*sq)[64] = (float (*)[64])lds;
    const int w = threadIdx.x >> 6, lane0 = threadIdx.x & 63;
    for (int vb = blockIdx.x; vb < T_SAMPLE * 8 / NWAVE; vb += gridDim.x) {
        int lane = lane0; asm volatile("" : "+v"(lane));
        const int item = vb * NWAVE + w, ts = item >> 3, hd = item & 7, b = ts >> 2, i = ts & 3, t = T_PROMPT + ts;
        __syncthreads();
        sq[w][lane] = bf2f(qrot_b[(size_t)t * ATT_WIDTH + hd * 64 + lane]);
        __syncthreads();
        const int qi = WBUF + i;
        float sc[8];
        float mx = -INFINITY;
#pragma unroll
        for (int slot = 0; slot < 7; ++slot) {
            const int pt = slot < 6 ? (slot >> 1) : (lane < 3 ? lane : 0);
            const int m = slot < 6 ? lane + 64 * (slot & 1) : 128;
            const int kj = qi - (m << (2 * pt));
            const bool valid = (slot < 6 || lane < 3) && kj < WBUF;
            const int kc = kj < WBUF ? kj : WBUF - 1;
            const float* kr = ck + ((size_t)b * WBUF + kc) * ATT_WIDTH + hd * 64;
            float a = 0.f;
#pragma unroll
            for (int c = 0; c < 64; c += 4) { const float4 kv = *(const float4*)(kr + c); a += kv.x * sq[w][c] + kv.y * sq[w][c + 1] + kv.z * sq[w][c + 2] + kv.w * sq[w][c + 3]; }
            const float s = valid ? a * 0.125f : -INFINITY;
            sc[slot] = s; mx = fmaxf(mx, s);
        }
        const int nt7 = lane <= i ? i - lane : i;
        const bool valid7 = lane < i + 3;
        {
            const bf16* kr = krot_b + (size_t)(T_PROMPT + b * DEC_SEQ + nt7) * ATT_WIDTH + hd * 64;
            float a = 0.f;
#pragma unroll
            for (int c = 0; c < 64; c += 8) { float f[8]; unpack8(*(const v4u*)(kr + c), f);
#pragma unroll
                for (int j = 0; j < 8; ++j) a += f[j] * sq[w][c + j]; }
            const float s = valid7 ? a * 0.125f : -INFINITY;
            sc[7] = s; mx = fmaxf(mx, s);
        }
        mx = wave_max(mx);
        float lsum = 0.f;
#pragma unroll
        for (int slot = 0; slot < 8; ++slot) { const float pv = __expf(sc[slot] - mx); sc[slot] = pv; lsum += pv; }
        lsum = wave_sum(lsum);
        float part[64];
#pragma unroll
        for (int c = 0; c < 64; ++c) part[c] = 0.f;
#pragma unroll
        for (int slot = 0; slot < 7; ++slot) {
            const int pt = slot < 6 ? (slot >> 1) : (lane < 3 ? lane : 0);
            const int m = slot < 6 ? lane + 64 * (slot & 1) : 128;
            const int kj = qi - (m << (2 * pt));
            const int kc = kj < WBUF ? kj : WBUF - 1;
            const float pv = sc[slot];
            const float* vr = cv + ((size_t)b * WBUF + kc) * ATT_WIDTH + hd * 64;
#pragma unroll
            for (int c = 0; c < 64; c += 4) { const float4 vv = *(const float4*)(vr + c); part[c] += pv * vv.x; part[c + 1] += pv * vv.y; part[c + 2] += pv * vv.z; part[c + 3] += pv * vv.w; }
        }
        {
            const float pv = sc[7];
            const bf16* vr = projb + (size_t)(T_PROMPT + b * DEC_SEQ + nt7) * NB_LD + NB_V + hd * 64;
#pragma unroll
            for (int c = 0; c < 64; c += 8) { float f[8]; unpack8(*(const v4u*)(vr + c), f);
#pragma unroll
                for (int j = 0; j < 8; ++j) part[c + j] += pv * f[j]; }
        }
        PEER_TR_STEP(32, 32) PEER_TR_STEP(16, 16) PEER_TR_STEP(8, 8) PEER_TR_STEP(4, 4) PEER_TR_STEP(2, 2) PEER_TR_STEP(1, 1)
        A1[(size_t)t * MIX_WIDTH + SSD_WIDTH + hd * 64 + lane] = (bf16)f2bf(part[0] / lsum);
    }
}


__device__ __forceinline__ void cache_copy_slice(const float* __restrict__ ck, const float* __restrict__ cv, float* __restrict__ out, unsigned slice, unsigned lane, unsigned bt0 = 0u, unsigned bt1 = 8u) {
    constexpr unsigned PER_B = (WBUF - DEC_SEQ) * ATT_WIDTH / 4;
    constexpr unsigned TOTAL = 2u * DEC_BATCH * PER_B;
#pragma unroll 1
    for (unsigned bt = bt0; bt < bt1; ++bt) {
        f32x4n v[8]; size_t dsti[8]; bool isv[8]; bool ok[8];
#pragma unroll
        for (int j = 0; j < 8; ++j) {
            const unsigned idx = slice * 4096u + bt * 512u + j * 64u + lane;
            ok[j] = idx < TOTAL;
            const unsigned idc = ok[j] ? idx : 0u;
            const unsigned tb = idc / PER_B, r = idc - tb * PER_B, bb = tb & (DEC_BATCH - 1);
            isv[j] = tb >= DEC_BATCH;
            const size_t srci = (size_t)bb * (WBUF * ATT_WIDTH / 4) + (DEC_SEQ * ATT_WIDTH / 4) + r;
            dsti[j] = (size_t)bb * (WBUF * ATT_WIDTH / 4) + r;
            v[j] = __builtin_nontemporal_load((isv[j] ? (const f32x4n*)cv : (const f32x4n*)ck) + srci);
        }
#pragma unroll
        for (int j = 0; j < 8; ++j) if (ok[j]) __builtin_nontemporal_store(v[j], (f32x4n*)(out + (isv[j] ? OUT_SV : OUT_SK)) + dsti[j]);
    }
}

__device__ __forceinline__ void copy_q_load(const float* __restrict__ ck, const float* __restrict__ cv, unsigned q, unsigned lane, f32x4n (&v)[16]) {
    constexpr unsigned PER_B = (WBUF - DEC_SEQ) * ATT_WIDTH / 4, TOTAL = 2u * DEC_BATCH * PER_B;
#pragma unroll
    for (int j = 0; j < 16; ++j) {
        const unsigned idx = q * 1024u + j * 64u + lane, idc = idx < TOTAL ? idx : 0u;
        const unsigned tb = idc / PER_B, r = idc - tb * PER_B, bb = tb & (DEC_BATCH - 1);
        const size_t srci = (size_t)bb * (WBUF * ATT_WIDTH / 4) + (DEC_SEQ * ATT_WIDTH / 4) + r;
        v[j] = __builtin_nontemporal_load((tb >= DEC_BATCH ? (const f32x4n*)cv : (const f32x4n*)ck) + srci);
    }
}
__device__ __forceinline__ void copy_q_store(float* __restrict__ out, unsigned q, unsigned lane, const f32x4n (&v)[16]) {
    constexpr unsigned PER_B = (WBUF - DEC_SEQ) * ATT_WIDTH / 4, TOTAL = 2u * DEC_BATCH * PER_B;
#pragma unroll
    for (int j = 0; j < 16; ++j) {
        const unsigned idx = q * 1024u + j * 64u + lane;
        if (idx < TOTAL) {
            const unsigned tb = idx / PER_B, r = idx - tb * PER_B, bb = tb & (DEC_BATCH - 1);
            const size_t dsti = (size_t)bb * (WBUF * ATT_WIDTH / 4) + r;
            __builtin_nontemporal_store(v[j], (f32x4n*)(out + (tb >= DEC_BATCH ? OUT_SV : OUT_SK)) + dsti);
        }
    }
}
typedef float f32x2v __attribute__((ext_vector_type(2)));
typedef unsigned u32x6 __attribute__((ext_vector_type(6)));
typedef float f32x32 __attribute__((ext_vector_type(32)));
typedef float f32x16q __attribute__((ext_vector_type(16)));
struct __attribute__((aligned(4))) u3w { unsigned x, y, z; };
#define PEER_ROWB 768
__device__ __forceinline__ void ph_quant_tables(const float* __restrict__ pu, const float* __restrict__ pv, unsigned char* __restrict__ ub8, unsigned char* __restrict__ vb8,
                                                float* __restrict__ usc, float* __restrict__ vsc, int rank, int nranks) {
    const int lane = threadIdx.x & 63;
#pragma unroll 2
    for (int row = rank * NWAVE + (threadIdx.x >> 6); row < 2 * 16384; row += nranks * NWAVE) {
        const int rr = row & 16383; const bool isv = row >= 16384;
        const float* src = (isv ? pv : pu) + (size_t)rr * D_MODEL + lane * 8;
        const float4 a = *(const float4*)src, b = *(const float4*)(src + 4), c = *(const float4*)(src + 512), d = *(const float4*)(src + 516);
        float am = fmaxf(fmaxf(fmaxf(fabsf(a.x), fabsf(a.y)), fmaxf(fabsf(a.z), fabsf(a.w))), fmaxf(fmaxf(fabsf(b.x), fabsf(b.y)), fmaxf(fabsf(b.z), fabsf(b.w))));
        am = fmaxf(am, fmaxf(fmaxf(fmaxf(fabsf(c.x), fabsf(c.y)), fmaxf(fabsf(c.z), fabsf(c.w))), fmaxf(fmaxf(fabsf(d.x), fabsf(d.y)), fmaxf(fabsf(d.z), fabsf(d.w)))));
        am = wave_max(am);
        const float sc = am > 0.f ? 7.5f / am : 1.0f;
        f32x16q e0, e1;
#pragma unroll
        for (int i = 0; i < 16; ++i) { e0[i] = 0.f; e1[i] = 0.f; }
        e0[0] = a.x * sc; e1[0] = a.y * sc; e0[1] = a.z * sc; e1[1] = a.w * sc; e0[2] = b.x * sc; e1[2] = b.y * sc; e0[3] = b.z * sc; e1[3] = b.w * sc;
        e0[4] = c.x * sc; e1[4] = c.y * sc; e0[5] = c.z * sc; e1[5] = c.w * sc; e0[6] = d.x * sc; e1[6] = d.y * sc; e0[7] = d.z * sc; e1[7] = d.w * sc;
        const u32x6 qv = __builtin_amdgcn_cvt_scalef32_2xpk16_fp6_f32(e0, e1, 1.0f);
        u3w o; o.x = qv[0]; o.y = qv[1]; o.z = qv[2];
        *(u3w*)((isv ? vb8 : ub8) + (size_t)rr * PEER_ROWB + lane * 12) = o;
        if (lane == 0) (isv ? vsc : usc)[rr] = am > 0.f ? am * (1.0f / 7.5f) : 1.0f;
    }
}
__device__ __forceinline__ void unpack16_fp8(const v4u w, float (&f)[16]) {
#pragma unroll
    for (int i = 0; i < 4; ++i) {
        const f32x2v lo = __builtin_amdgcn_cvt_pk_f32_fp8((int)w[i], false), hi = __builtin_amdgcn_cvt_pk_f32_fp8((int)w[i], true);
        f[4 * i] = lo[0]; f[4 * i + 1] = lo[1]; f[4 * i + 2] = hi[0]; f[4 * i + 3] = hi[1];
    }
}
__device__ __forceinline__ unsigned ffn_slice(unsigned n9, unsigned it) {
    const unsigned w = (unsigned)__builtin_amdgcn_readfirstlane(threadIdx.x >> 6), wgl = blockIdx.x * NWAVE + w;
    if (gridDim.x != 256) return n9 + wgl + it * (gridDim.x * NWAVE);
    unsigned v;
    if (w < 2u) { if (it == 0u) v = 0u; else if (it == 4u) v = 1u; else return 0xffffffffu; }
    else { if ((it & 1u) == 0u && it < 8u) v = it >> 1; else return 0xffffffffu; }
    if (v < 2u) return n9 + v * 2048u + wgl;
    const unsigned lw = blockIdx.x * 6u + (w - 2u);
    return n9 + 4096u + (v - 2u) * 1536u + lw;
}
__device__ __forceinline__ unsigned ffn_half(unsigned n9, unsigned it) {
    const unsigned w = (unsigned)__builtin_amdgcn_readfirstlane(threadIdx.x >> 6);
    if (gridDim.x != 256 || w >= 2u || it != 7u) return 0xffffffffu;
    const unsigned hw = blockIdx.x * 2u + w;
    return ((n9 + 7168u + (hw >> 1)) << 1) | (hw & 1u);
}
__device__ __forceinline__ void ph_peer_ffn3(const bf16* __restrict__ hb, const int* __restrict__ eidx, const float* __restrict__ gate,
                                             const unsigned char* __restrict__ ub8, const unsigned char* __restrict__ vb8, const float* __restrict__ usc, const float* __restrict__ vsc,
                                             const float* __restrict__ gam, const float* __restrict__ bet, float* __restrict__ out,
                                             const float* __restrict__ ck, const float* __restrict__ cv, unsigned n9) {
    const int lane0 = threadIdx.x & 63;
    unsigned it = 0;
    for (;; ++it) {
        const int t = token_of_iter((int)it);
        if (t < 0) break;
        int lane = lane0; asm volatile("" : "+v"(lane));
        { const unsigned sl = ffn_slice(n9, it); if (sl < 16384u) cache_copy_slice(ck, cv, out, sl, (unsigned)lane);
          const unsigned hc = ffn_half(n9, it); if (hc != 0xffffffffu) cache_copy_slice(ck, cv, out, hc >> 1, (unsigned)lane, 4u * (hc & 1u), 4u * (hc & 1u) + 4u); }
        const unsigned lo12 = (unsigned)lane * 12u, lo8 = (unsigned)lane * 8u;
        float x[16];
        { float f0[8], f1[8]; const bf16* xr = hb + (size_t)t * D_MODEL + lo8; unpack8(*(const v4u*)xr, f0); unpack8(*(const v4u*)(xr + 512), f1);
#pragma unroll
          for (int j = 0; j < 8; ++j) { x[j] = f0[j]; x[8 + j] = f1[j]; } }
        int ev[2]; float wv[4], su[4];
        ev[0] = eidx[(size_t)t * 128 + lane]; ev[1] = eidx[(size_t)t * 128 + 64 + lane];
#pragma unroll
        for (int rd = 0; rd < 4; ++rd) {
            const int er = eidx[(size_t)t * 128 + rd * 32 + (lane >> 1)];
            wv[rd] = gate[(size_t)t * 128 + rd * 32 + (lane >> 1)] * vsc[er];
            su[rd] = usc[er];
        }
#pragma unroll
        for (int rd = 0; rd < 4; ++rd) {
            float part[32];
#pragma unroll
            for (int kb = 0; kb < 2; ++kb) {
                u3w ra[16];
#pragma unroll
                for (int k8 = 0; k8 < 16; ++k8) {
                    const int e = __builtin_amdgcn_readlane(ev[rd >> 1], (rd & 1) * 32 + kb * 16 + k8);
                    ra[k8] = *(const u3w*)(ub8 + (size_t)e * PEER_ROWB + lo12);
                }
#pragma unroll
                for (int k8 = 0; k8 < 16; k8 += 2) {
                    u32x6 sv; sv[0] = ra[k8].x; sv[1] = ra[k8].y; sv[2] = ra[k8].z; sv[3] = ra[k8 + 1].x; sv[4] = ra[k8 + 1].y; sv[5] = ra[k8 + 1].z;
                    const f32x32 f = __builtin_amdgcn_cvt_scalef32_pk32_f32_fp6(sv, 1.0f);
                    f32x2v d0 = {0.f, 0.f}, d1 = {0.f, 0.f};
#pragma unroll
                    for (int i = 0; i < 8; ++i) {
                        d0 += (f32x2v){f[2 * i], f[2 * i + 1]} * (f32x2v){x[2 * i], x[2 * i + 1]};
                        d1 += (f32x2v){f[16 + 2 * i], f[17 + 2 * i]} * (f32x2v){x[2 * i], x[2 * i + 1]};
                    }
                    part[kb * 16 + k8] = d0[0] + d0[1]; part[kb * 16 + k8 + 1] = d1[0] + d1[1];
                    __builtin_amdgcn_sched_barrier(0);
                }
            }
            PEER_TR_STEP(16, 32) PEER_TR_STEP(8, 16) PEER_TR_STEP(4, 8) PEER_TR_STEP(2, 4) PEER_TR_STEP(1, 2)
            const float hid = (part[0] + __shfl_xor(part[0], 1)) * su[rd];
            wv[rd] *= gelu_f(hid);
        }
        f32x2v accp[8];
#pragma unroll
        for (int i = 0; i < 8; ++i) accp[i] = (f32x2v){0.f, 0.f};
#pragma unroll
        for (int rd = 0; rd < 4; ++rd) {
#pragma unroll
            for (int kb = 0; kb < 2; ++kb) {
                u3w ra[16];
#pragma unroll
                for (int k8 = 0; k8 < 16; ++k8) {
                    const int e = __builtin_amdgcn_readlane(ev[rd >> 1], (rd & 1) * 32 + kb * 16 + k8);
                    ra[k8] = *(const u3w*)(vb8 + (size_t)e * PEER_ROWB + lo12);
                }
#pragma unroll
                for (int k8 = 0; k8 < 16; k8 += 2) {
                    const float wk0 = __builtin_bit_cast(float, __builtin_amdgcn_readlane(__builtin_bit_cast(int, wv[rd]), 2 * (kb * 16 + k8)));
                    const float wk1 = __builtin_bit_cast(float, __builtin_amdgcn_readlane(__builtin_bit_cast(int, wv[rd]), 2 * (kb * 16 + k8 + 1)));
                    u32x6 sv; sv[0] = ra[k8].x; sv[1] = ra[k8].y; sv[2] = ra[k8].z; sv[3] = ra[k8 + 1].x; sv[4] = ra[k8 + 1].y; sv[5] = ra[k8 + 1].z;
                    const f32x32 f = __builtin_amdgcn_cvt_scalef32_pk32_f32_fp6(sv, 1.0f);
#pragma unroll
                    for (int i = 0; i < 8; ++i) {
                        accp[i] += (f32x2v){wk0, wk0} * (f32x2v){f[2 * i], f[2 * i + 1]};
                        accp[i] += (f32x2v){wk1, wk1} * (f32x2v){f[16 + 2 * i], f[17 + 2 * i]};
                    }
                    __builtin_amdgcn_sched_barrier(0);
                }
            }
        }
        float acc[16];
#pragma unroll
        for (int i = 0; i < 8; ++i) { acc[2 * i] = accp[i][0]; acc[2 * i + 1] = accp[i][1]; }
        float s = 0.f;
#pragma unroll
        for (int j = 0; j < 16; ++j) { acc[j] += ALPHA_F * x[j]; s += acc[j]; }
        s = wave_sum(s);
        const float mu = s * (1.0f / 1024.0f);
        float q = 0.f;
#pragma unroll
        for (int j = 0; j < 16; ++j) { acc[j] -= mu; q += acc[j] * acc[j]; }
        q = wave_sum(q);
        const float r = rsqrtf(q * (1.0f / 1024.0f) + LN_EPS);
        float* dst = ((t < T_PROMPT) ? out + OUT_YP + (size_t)t * D_MODEL : out + OUT_YS + (size_t)(t - T_PROMPT) * D_MODEL) + lo8;
#pragma unroll
        for (int q4 = 0; q4 < 4; ++q4) {
            const int eo = (q4 >> 1) * 512 + (q4 & 1) * 4;
            const float4 g4 = *(const float4*)(gam + lo8 + eo), b4 = *(const float4*)(bet + lo8 + eo);
            float4 o; o.x = acc[q4 * 4 + 0] * r * g4.x + b4.x; o.y = acc[q4 * 4 + 1] * r * g4.y + b4.y; o.z = acc[q4 * 4 + 2] * r * g4.z + b4.z; o.w = acc[q4 * 4 + 3] * r * g4.w + b4.w;
            *(float4*)(dst + eo) = o;
        }
    }
    for (;; ++it) {
        if (gridDim.x == 256 && it >= 5u) break;
        const unsigned sl = ffn_slice(n9, it);
        if (gridDim.x != 256 && sl >= 16384u) break;
        if (sl < 16384u) cache_copy_slice(ck, cv, out, sl, (unsigned)lane0);
    }
}


__device__ __forceinline__ void ssd_decode_load(const bf16* __restrict__ xbc_b, const float* __restrict__ dtv, const float* __restrict__ state_ssm, int item, int p, int ng,
                                                float (&hs)[16], v4u (&bq)[4][2], v4u (&cq)[4][2], float (&xv)[4], float (&dv)[4]) {
    const int sb = item / SSD_HEADS, h = item - sb * SSD_HEADS, g = h / 6, t0 = T_PROMPT + sb * DEC_SEQ;
    const float* s0 = state_ssm + (((size_t)sb * SSD_HEADS + h) * 64 + p) * 128 + ng * 16;
#pragma unroll
    for (int j = 0; j < 4; ++j) { const float4 v = *(const float4*)(s0 + 4 * j); hs[4 * j] = v.x; hs[4 * j + 1] = v.y; hs[4 * j + 2] = v.z; hs[4 * j + 3] = v.w; }
#pragma unroll
    for (int s = 0; s < 4; ++s) {
        const bf16* row = xbc_b + (size_t)(t0 + s) * CONV_DIM;
        bq[s][0] = *(const v4u*)(row + 1536 + g * 128 + ng * 16); bq[s][1] = *(const v4u*)(row + 1536 + g * 128 + ng * 16 + 8);
        cq[s][0] = *(const v4u*)(row + 2048 + g * 128 + ng * 16); cq[s][1] = *(const v4u*)(row + 2048 + g * 128 + ng * 16 + 8);
        xv[s] = bf2f(row[h * 64 + p]); dv[s] = dtv[(size_t)(t0 + s) * SSD_HEADS + h];
    }
}
__device__ __forceinline__ void ssd_decode_compute(const float* __restrict__ a_log, const float* __restrict__ d_skip, int item, int p, int ng,
                                                   float (&hs)[16], const v4u (&bq)[4][2], const v4u (&cq)[4][2], const float (&xv)[4], const float (&dv)[4],
                                                   float* __restrict__ ybuf, float* __restrict__ out) {
    const int sb = item / SSD_HEADS, h = item - sb * SSD_HEADS, t0 = T_PROMPT + sb * DEC_SEQ;
    const float A = -__expf(a_log[h]), D = d_skip[h];
#pragma unroll
    for (int s = 0; s < 4; ++s) {
        float Bf[16], Cf[16];
        { float t8[8]; unpack8(bq[s][0], t8);
#pragma unroll
          for (int j = 0; j < 8; ++j) Bf[j] = t8[j];
          unpack8(bq[s][1], t8);
#pragma unroll
          for (int j = 0; j < 8; ++j) Bf[8 + j] = t8[j];
          unpack8(cq[s][0], t8);
#pragma unroll
          for (int j = 0; j < 8; ++j) Cf[j] = t8[j];
          unpack8(cq[s][1], t8);
#pragma unroll
          for (int j = 0; j < 8; ++j) Cf[8 + j] = t8[j]; }
        const float a = __expf(dv[s] * A), xdt = xv[s] * dv[s];
        float y = 0.f;
#pragma unroll
        for (int j = 0; j < 16; ++j) { hs[j] = a * hs[j] + xdt * Bf[j]; y += Cf[j] * hs[j]; }
        y += __shfl_xor(y, 1); y += __shfl_xor(y, 2); y += __shfl_xor(y, 4);
        if (ng == 0) ybuf[(size_t)(t0 + s) * MIX_WIDTH + h * 64 + p] = y + D * xv[s];
    }
    float* so = out + OUT_SS + (((size_t)sb * SSD_HEADS + h) * 64 + p) * 128 + ng * 16;
#pragma unroll
    for (int j = 0; j < 4; ++j) *(float4*)(so + 4 * j) = make_float4(hs[4 * j], hs[4 * j + 1], hs[4 * j + 2], hs[4 * j + 3]);
}
__device__ __forceinline__ void ph_ssd_decode(const bf16* __restrict__ xbc_b, const float* __restrict__ dtv, const float* __restrict__ a_log, const float* __restrict__ d_skip,
                                              const float* __restrict__ state_ssm, float* __restrict__ ybuf, float* __restrict__ out) {
    const int tid = threadIdx.x, p = tid >> 3, ng = tid & 7;
    constexpr int NITEM = DEC_BATCH * SSD_HEADS;
    for (int it = blockIdx.x; it < NITEM; it += 2 * gridDim.x) {
        const int it2 = it + gridDim.x; const bool has2 = it2 < NITEM; const int it2c = has2 ? it2 : it;
        float hsA[16], hsB[16], xA[4], xB[4], dA[4], dB[4]; v4u bA[4][2], cA[4][2], bB[4][2], cB[4][2];
        ssd_decode_load(xbc_b, dtv, state_ssm, it, p, ng, hsA, bA, cA, xA, dA);
        ssd_decode_load(xbc_b, dtv, state_ssm, it2c, p, ng, hsB, bB, cB, xB, dB);
        ssd_decode_compute(a_log, d_skip, it, p, ng, hsA, bA, cA, xA, dA, ybuf, out);
        if (has2) ssd_decode_compute(a_log, d_skip, it2, p, ng, hsB, bB, cB, xB, dB, ybuf, out);
    }
}

__device__ __forceinline__ float samp_cw(int d) { return (float)((int)(d >= 0 && d <= 128) + (int)(d >= 0 && (d & 3) == 0 && d <= 512) + (int)(d >= 0 && (d & 15) == 0 && d <= 2048)); }
__device__ __forceinline__ void samp_update(float sv, float cw, const float (&vrow)[64], float& m, float& l, float (&part)[64]) {
    const float mn = fmaxf(m, sv), alpha = __expf(m - mn), p = cw * __expf(sv - mn);
    m = mn; l = l * alpha + p;
#pragma unroll
    for (int c = 0; c < 64; ++c) part[c] = part[c] * alpha + p * vrow[c];
}
__device__ __forceinline__ void ph_attn_sample3(float* lds, const bf16* __restrict__ qrot_b, const bf16* __restrict__ krot_b, const bf16* __restrict__ projb,
                                                const float* __restrict__ ck, const float* __restrict__ cv, bf16* __restrict__ A1) {
    const int lane0 = threadIdx.x & 63, w = __builtin_amdgcn_readfirstlane(threadIdx.x >> 6);
    float* sq = lds + w * 256;
    for (int item = blockIdx.x + gridDim.x * w; item < DEC_BATCH * ATT_HEADS; item += gridDim.x * NWAVE) {
        int lane = lane0; asm volatile("" : "+v"(lane));
        const int b = item >> 3, hd = item & 7, qi = lane & 3, g = lane >> 2;
        const int tq0 = T_PROMPT + b * DEC_SEQ;
#pragma unroll
        for (int i = 0; i < 4; ++i) sq[i * 64 + lane] = bf2f(qrot_b[(size_t)(tq0 + i) * ATT_WIDTH + hd * 64 + lane]);
        asm volatile("s_waitcnt lgkmcnt(0)" ::: "memory");
        const float* qv = sq + qi * 64;
        const float* ckb = ck + (size_t)b * WBUF * ATT_WIDTH + hd * 64; const float* cvb = cv + (size_t)b * WBUF * ATT_WIDTH + hd * 64;
        float m = -1e30f, l = 0.f, part[64];
#pragma unroll
        for (int c = 0; c < 64; ++c) part[c] = 0.f;
        {
            const int P = 2051 - g;
            const float cw = samp_cw(WBUF + qi - P);
            const bool isn = P >= WBUF;
            const int nt = isn ? P - WBUF : 0, Pc = isn ? WBUF - 1 : P;
            const bf16* kn = krot_b + (size_t)(tq0 + nt) * ATT_WIDTH + hd * 64; const float* kr = ckb + (size_t)Pc * ATT_WIDTH;
            float a = 0.f;
#pragma unroll
            for (int c = 0; c < 64; c += 8) { float f[8]; unpack8(*(const v4u*)(kn + c), f); const float4 k0 = *(const float4*)(kr + c), k1 = *(const float4*)(kr + c + 4);
                a += (isn ? f[0] : k0.x) * qv[c] + (isn ? f[1] : k0.y) * qv[c + 1] + (isn ? f[2] : k0.z) * qv[c + 2] + (isn ? f[3] : k0.w) * qv[c + 3]
                   + (isn ? f[4] : k1.x) * qv[c + 4] + (isn ? f[5] : k1.y) * qv[c + 5] + (isn ? f[6] : k1.z) * qv[c + 6] + (isn ? f[7] : k1.w) * qv[c + 7]; }
            const float sv = cw > 0.f ? a * 0.125f : -1e30f;
            const bf16* vn = projb + (size_t)(tq0 + nt) * NB_LD + NB_V + hd * 64; const float* vr = cvb + (size_t)Pc * ATT_WIDTH;
            float vrow[64];
#pragma unroll
            for (int c = 0; c < 64; c += 8) { float f[8]; unpack8(*(const v4u*)(vn + c), f); const float4 v0 = *(const float4*)(vr + c), v1 = *(const float4*)(vr + c + 4);
                vrow[c] = isn ? f[0] : v0.x; vrow[c + 1] = isn ? f[1] : v0.y; vrow[c + 2] = isn ? f[2] : v0.z; vrow[c + 3] = isn ? f[3] : v0.w;
                vrow[c + 4] = isn ? f[4] : v1.x; vrow[c + 5] = isn ? f[5] : v1.y; vrow[c + 6] = isn ? f[6] : v1.z; vrow[c + 7] = isn ? f[7] : v1.w; }
            samp_update(sv, cw, vrow, m, l, part);
        }
#pragma unroll 1
        for (int s = 1; s < 21; ++s) {
            const int P = s < 9 ? 2051 - (16 * s + g) : (s < 15 ? 1536 + 64 * (s - 9) + lane : qi + 16 * (16 * (s - 15) + g));
            const float cw = (s < 9 && P < 1920) ? 0.f : samp_cw(WBUF + qi - P);
            const float* kr = ckb + (size_t)P * ATT_WIDTH;
            float a = 0.f;
#pragma unroll
            for (int c = 0; c < 64; c += 4) { const float4 kv = *(const float4*)(kr + c); a += kv.x * qv[c] + kv.y * qv[c + 1] + kv.z * qv[c + 2] + kv.w * qv[c + 3]; }
            const float sv = cw > 0.f ? a * 0.125f : -1e30f;
            __builtin_amdgcn_sched_barrier(0);
            const float* vr = cvb + (size_t)P * ATT_WIDTH;
            float vrow[64];
#pragma unroll
            for (int c = 0; c < 64; c += 4) { const float4 vv = *(const float4*)(vr + c); vrow[c] = vv.x; vrow[c + 1] = vv.y; vrow[c + 2] = vv.z; vrow[c + 3] = vv.w; }
            samp_update(sv, cw, vrow, m, l, part);
        }
        float M = m;
        M = fmaxf(M, __shfl_xor(M, 4)); M = fmaxf(M, __shfl_xor(M, 8)); M = fmaxf(M, __shfl_xor(M, 16)); M = fmaxf(M, __shfl_xor(M, 32));
        const float sc = __expf(m - M);
        float lsum = l * sc;
        lsum += __shfl_xor(lsum, 4); lsum += __shfl_xor(lsum, 8); lsum += __shfl_xor(lsum, 16); lsum += __shfl_xor(lsum, 32);
#pragma unroll
        for (int c = 0; c < 64; ++c) part[c] *= sc;
        PEER_TR_STEP(32, 32) PEER_TR_STEP(16, 16) PEER_TR_STEP(8, 8) PEER_TR_STEP(4, 4)
        const float inv = 1.0f / lsum;
        *(uint2*)(A1 + (size_t)(tq0 + qi) * MIX_WIDTH + SSD_WIDTH + hd * 64 + 4 * g) = make_uint2(pk2(part[0] * inv, part[1] * inv), pk2(part[2] * inv, part[3] * inv));
    }
}

typedef float f32x16 __attribute__((ext_vector_type(16)));
typedef short s16x8 __attribute__((ext_vector_type(8)));
typedef short s16x4 __attribute__((ext_vector_type(4)));
typedef float f32x4v __attribute__((ext_vector_type(4)));
#define SSD_L_ACS 0
#define SSD_L_DTS 3072
#define SSD_L_BM 6144
#define SSD_RS_B 272
#define SSD_L_X (6144 + 128 * 272)
#define SSD_RS_X 144
#define SSD_XIMG (128 * 144)
#define SSD_RS_Y 784
template <int OFF0, int OFF1>
__device__ __forceinline__ s16x8 tr_frag(unsigned base) {
    s16x4 a, b;
    asm volatile("ds_read_b64_tr_b16 %0, %2 offset:%3\n\tds_read_b64_tr_b16 %1, %2 offset:%4\n\ts_waitcnt lgkmcnt(0)"
                 : "=&v"(a), "=&v"(b) : "v"(base), "n"(OFF0), "n"(OFF1) : "memory");
    return __builtin_shufflevector(a, b, 0, 1, 2, 3, 4, 5, 6, 7);
}
__device__ __forceinline__ unsigned lds_addr(LAS unsigned char* p) { return (unsigned)(size_t)p; }
template <int O0, int O1, int O2, int O3, int O4, int O5, int O6, int O7>
__device__ __forceinline__ void tr_read8(unsigned base, s16x4 (&v)[8]) {
    asm volatile("ds_read_b64_tr_b16 %0, %8 offset:%9\n\tds_read_b64_tr_b16 %1, %8 offset:%10\n\tds_read_b64_tr_b16 %2, %8 offset:%11\n\tds_read_b64_tr_b16 %3, %8 offset:%12\n\t"
                 "ds_read_b64_tr_b16 %4, %8 offset:%13\n\tds_read_b64_tr_b16 %5, %8 offset:%14\n\tds_read_b64_tr_b16 %6, %8 offset:%15\n\tds_read_b64_tr_b16 %7, %8 offset:%16\n\ts_waitcnt lgkmcnt(0)"
                 : "=&v"(v[0]), "=&v"(v[1]), "=&v"(v[2]), "=&v"(v[3]), "=&v"(v[4]), "=&v"(v[5]), "=&v"(v[6]), "=&v"(v[7])
                 : "v"(base), "n"(O0), "n"(O1), "n"(O2), "n"(O3), "n"(O4), "n"(O5), "n"(O6), "n"(O7) : "memory");
}
#define TRCAT(a, b) __builtin_shufflevector(a, b, 0, 1, 2, 3, 4, 5, 6, 7)


__device__ __forceinline__ void ssd_chunk_acs(LAS unsigned char* ldsb, const float* __restrict__ dtv, const float* __restrict__ a_log, int t0, int g, float* cdec_out) {
    const int w = __builtin_amdgcn_readfirstlane(threadIdx.x >> 6), lane = threadIdx.x & 63;
    if (w < 6) {
        const int head = 6 * g + w;
        const float A = -__expf(a_log[head]);
        const float v0 = dtv[(size_t)(t0 + 2 * lane) * SSD_HEADS + head], v1 = dtv[(size_t)(t0 + 2 * lane + 1) * SSD_HEADS + head];
        const float a1 = v1 * A;
        float s = v0 * A + a1;
#pragma unroll
        for (int o = 1; o < 64; o <<= 1) { const float tmp = __shfl_up(s, o); if (lane >= o) s += tmp; }
        LAS float* acs = (LAS float*)(ldsb + SSD_L_ACS) + w * 128;
        LAS float* dts = (LAS float*)(ldsb + SSD_L_DTS) + w * 128;
        acs[2 * lane] = s - a1; acs[2 * lane + 1] = s;
        dts[2 * lane] = v0; dts[2 * lane + 1] = v1;
        if (cdec_out && lane == 63) cdec_out[head] = __expf(s);
    }
}

__device__ __forceinline__ void ph_ssd_states(LAS unsigned char* ldsb, const bf16* __restrict__ xbc_b, const float* __restrict__ dtv, const float* __restrict__ a_log,
                                              bf16* __restrict__ Sbuf, float* __restrict__ cdec, const float* __restrict__ ck, const float* __restrict__ cv, float* __restrict__ out) {
    const int tid = threadIdx.x, w = __builtin_amdgcn_readfirstlane(tid >> 6), lane = tid & 63;
    const int r = lane & 31, h = lane >> 5, blk = (lane >> 4) & 1, q = (lane & 15) >> 2, pp = lane & 3;
    const int nt = w & 3, pt = w >> 2;
    for (int unit = blockIdx.x; unit < BATCH * 64 * SSD_GROUPS; unit += gridDim.x) {
        const int g = unit & 3, bc = unit >> 2;
        const int t0 = bc * 128;
        __syncthreads();
        ssd_chunk_acs(ldsb, dtv, a_log, t0, g, cdec + (size_t)bc * SSD_HEADS);
#pragma unroll
        for (int it_ = 0; it_ < 4; ++it_) { const int idx = tid + it_ * NTHR; const int row = idx >> 4, ch = idx & 15;
            const v4u v = *(const v4u*)(xbc_b + (size_t)(t0 + row) * CONV_DIM + 1536 + 128 * g + ch * 8);
            *(LAS v4u*)(ldsb + SSD_L_BM + row * SSD_RS_B + ch * 16) = v; }
        __syncthreads();
#pragma unroll
        for (int it_ = 0; it_ < 12; ++it_) { const int idx = tid + it_ * NTHR; const int hh = idx >> 10, rem = idx & 1023, row = rem >> 3, ch = rem & 7;
            const LAS float* acs = (const LAS float*)(ldsb + SSD_L_ACS) + hh * 128; const LAS float* dts = (const LAS float*)(ldsb + SSD_L_DTS) + hh * 128;
            const float wgt = dts[row] * __expf(acs[127] - acs[row]);
            float f[8]; unpack8(*(const v4u*)(xbc_b + (size_t)(t0 + row) * CONV_DIM + (6 * g + hh) * 64 + ch * 8), f);
            v4u o; o.x = pk2(f[0] * wgt, f[1] * wgt); o.y = pk2(f[2] * wgt, f[3] * wgt); o.z = pk2(f[4] * wgt, f[5] * wgt); o.w = pk2(f[6] * wgt, f[7] * wgt);
            *(LAS v4u*)(ldsb + SSD_L_X + hh * SSD_XIMG + row * SSD_RS_X + ch * 16) = o; }
        __syncthreads();
        f32x4n rider[16];
        copy_q_load(ck, cv, 12288u + (unsigned)(unit * NWAVE + w), (unsigned)lane, rider);
        const unsigned abase = lds_addr(ldsb + SSD_L_BM) + (8 * h + q) * SSD_RS_B + (32 * nt + 16 * blk + 4 * pp) * 2;
        s16x8 afr[8];
        { s16x4 av[8];
          tr_read8<0 * SSD_RS_B, 4 * SSD_RS_B, 16 * SSD_RS_B, 20 * SSD_RS_B, 32 * SSD_RS_B, 36 * SSD_RS_B, 48 * SSD_RS_B, 52 * SSD_RS_B>(abase, av);
          afr[0] = TRCAT(av[0], av[1]); afr[1] = TRCAT(av[2], av[3]); afr[2] = TRCAT(av[4], av[5]); afr[3] = TRCAT(av[6], av[7]);
          tr_read8<64 * SSD_RS_B, 68 * SSD_RS_B, 80 * SSD_RS_B, 84 * SSD_RS_B, 96 * SSD_RS_B, 100 * SSD_RS_B, 112 * SSD_RS_B, 116 * SSD_RS_B>(abase, av);
          afr[4] = TRCAT(av[0], av[1]); afr[5] = TRCAT(av[2], av[3]); afr[6] = TRCAT(av[4], av[5]); afr[7] = TRCAT(av[6], av[7]); }
#pragma unroll
        for (int hh = 0; hh < 6; ++hh) {
            const unsigned xb = lds_addr(ldsb + SSD_L_X + hh * SSD_XIMG) + (8 * h + q) * SSD_RS_X + (32 * pt + 16 * blk + 4 * pp) * 2;
            f32x16 acc;
#pragma unroll
            for (int i = 0; i < 16; ++i) acc[i] = 0.f;
            { s16x4 xv[8];
              tr_read8<0 * SSD_RS_X, 4 * SSD_RS_X, 16 * SSD_RS_X, 20 * SSD_RS_X, 32 * SSD_RS_X, 36 * SSD_RS_X, 48 * SSD_RS_X, 52 * SSD_RS_X>(xb, xv);
              acc = __builtin_amdgcn_mfma_f32_32x32x16_bf16(afr[0], TRCAT(xv[0], xv[1]), acc, 0, 0, 0);
              acc = __builtin_amdgcn_mfma_f32_32x32x16_bf16(afr[1], TRCAT(xv[2], xv[3]), acc, 0, 0, 0);
              acc = __builtin_amdgcn_mfma_f32_32x32x16_bf16(afr[2], TRCAT(xv[4], xv[5]), acc, 0, 0, 0);
              acc = __builtin_amdgcn_mfma_f32_32x32x16_bf16(afr[3], TRCAT(xv[6], xv[7]), acc, 0, 0, 0);
              tr_read8<64 * SSD_RS_X, 68 * SSD_RS_X, 80 * SSD_RS_X, 84 * SSD_RS_X, 96 * SSD_RS_X, 100 * SSD_RS_X, 112 * SSD_RS_X, 116 * SSD_RS_X>(xb, xv);
              acc = __builtin_amdgcn_mfma_f32_32x32x16_bf16(afr[4], TRCAT(xv[0], xv[1]), acc, 0, 0, 0);
              acc = __builtin_amdgcn_mfma_f32_32x32x16_bf16(afr[5], TRCAT(xv[2], xv[3]), acc, 0, 0, 0);
              acc = __builtin_amdgcn_mfma_f32_32x32x16_bf16(afr[6], TRCAT(xv[4], xv[5]), acc, 0, 0, 0);
              acc = __builtin_amdgcn_mfma_f32_32x32x16_bf16(afr[7], TRCAT(xv[6], xv[7]), acc, 0, 0, 0); }
            bf16* dst = Sbuf + ((size_t)bc * SSD_HEADS + 6 * g + hh) * 8192 + (size_t)(pt * 8 + 2 * nt) * 512 + r * 8 + 4 * h;
#pragma unroll
            for (int q4 = 0; q4 < 4; ++q4) *(uint2*)(dst + (q4 >> 1) * 512 + (q4 & 1) * 256) = make_uint2(pk2(acc[4 * q4], acc[4 * q4 + 1]), pk2(acc[4 * q4 + 2], acc[4 * q4 + 3]));
        }
        copy_q_store(out, 12288u + (unsigned)(unit * NWAVE + w), (unsigned)lane, rider);
    }
}

__device__ __forceinline__ void ph_ssd_scan(const bf16* __restrict__ Sbuf, const float* __restrict__ cdec, bf16* __restrict__ Hin, float* __restrict__ out, int rank, int nranks) {
    for (int idx = rank * NTHR + threadIdx.x; idx < BATCH * SSD_HEADS * 1024; idx += nranks * NTHR) {
        const int i = idx & 1023, hb = idx >> 10, hd = hb % SSD_HEADS, b = hb / SSD_HEADS;
        float st[8];
#pragma unroll
        for (int j = 0; j < 8; ++j) st[j] = 0.f;
#pragma unroll 8
        for (int c = 0; c < 64; ++c) {
            const size_t base = (((size_t)(b * 64 + c)) * SSD_HEADS + hd) * 8192 + (size_t)i * 8;
            v4u o; o.x = pk2(st[0], st[1]); o.y = pk2(st[2], st[3]); o.z = pk2(st[4], st[5]); o.w = pk2(st[6], st[7]);
            *(v4u*)(Hin + base) = o;
            float s[8]; unpack8(*(const v4u*)(Sbuf + base), s);
            const float a = cdec[(size_t)(b * 64 + c) * SSD_HEADS + hd];
#pragma unroll
            for (int j = 0; j < 8; ++j) st[j] = a * st[j] + s[j];
        }
        const int ln = i & 63, ks = (i >> 6) & 7, pt = i >> 9, p = 32 * pt + (ln & 31), n0 = 16 * ks + 8 * (ln >> 5);
        store8f(out + OUT_PS + (((size_t)b * SSD_HEADS + hd) * 64 + p) * 128 + n0, st);
    }
}

__device__ __forceinline__ void ph_ssd_out(LAS unsigned char* ldsb, const bf16* __restrict__ xbc_b, const bf16* __restrict__ projb, const float* __restrict__ dtv,
                                           const float* __restrict__ a_log, const float* __restrict__ d_skip, const float* __restrict__ norm_g,
                                           const bf16* __restrict__ Hin, bf16* __restrict__ A1) {
    const int tid = threadIdx.x, w = __builtin_amdgcn_readfirstlane(tid >> 6), lane = tid & 63;
    const int r = lane & 31, h = lane >> 5, blk = (lane >> 4) & 1, q = (lane & 15) >> 2, pp = lane & 3;
    const int hs = w >> 2, lt = hs ? 3 - (w & 3) : (w & 3);
    for (int unit = blockIdx.x; unit < BATCH * 64 * SSD_GROUPS; unit += gridDim.x) {
        const int g = unit & 3, bc = unit >> 2;
        const int t0 = bc * 128;
        __syncthreads();
        ssd_chunk_acs(ldsb, dtv, a_log, t0, g, nullptr);
#pragma unroll
        for (int it_ = 0; it_ < 4; ++it_) { const int idx = tid + it_ * NTHR; const int row = idx >> 4, ch = idx & 15;
            const v4u v = *(const v4u*)(xbc_b + (size_t)(t0 + row) * CONV_DIM + 1536 + 128 * g + ch * 8);
            *(LAS v4u*)(ldsb + SSD_L_BM + row * SSD_RS_B + ch * 16) = v; }
#pragma unroll
        for (int it_ = 0; it_ < 12; ++it_) { const int idx = tid + it_ * NTHR; const int hh = idx >> 10, rem = idx & 1023, row = rem >> 3, ch = rem & 7;
            const v4u v = *(const v4u*)(xbc_b + (size_t)(t0 + row) * CONV_DIM + (6 * g + hh) * 64 + ch * 8);
            *(LAS v4u*)(ldsb + SSD_L_X + hh * SSD_XIMG + row * SSD_RS_X + ch * 16) = v; }
        __syncthreads();
        const bf16* cp = xbc_b + (size_t)(t0 + 32 * lt + r) * CONV_DIM + 2048 + 128 * g + 8 * h;
        s16x8 cfr[8];
#pragma unroll
        for (int ks = 0; ks < 8; ++ks) cfr[ks] = *(const s16x8*)(cp + 16 * ks);
        const int lcol = 32 * lt + r;
        const LAS float* acsb = (const LAS float*)(ldsb + SSD_L_ACS) + 3 * hs * 128; const LAS float* dtsb = (const LAS float*)(ldsb + SSD_L_DTS) + 3 * hs * 128;
        const unsigned xb0 = lds_addr(ldsb + SSD_L_X + 3 * hs * SSD_XIMG) + (4 * h + q) * SSD_RS_X + (16 * blk + 4 * pp) * 2;
        unsigned ypk[3][16];
#pragma unroll
        for (int h3 = 0; h3 < 3; ++h3) {
            const LAS float* acs = acsb + h3 * 128; const LAS float* dts = dtsb + h3 * 128;
            const float myacs = acs[lcol];
            const float Dh = d_skip[6 * g + 3 * hs + h3];
            f32x16 y0, y1;
#pragma unroll
            for (int i = 0; i < 16; ++i) { y0[i] = 0.f; y1[i] = 0.f; }
            { const bf16* hp = Hin + ((size_t)bc * SSD_HEADS + 6 * g + 3 * hs + h3) * 8192 + lane * 8;
#pragma unroll
              for (int kh = 0; kh < 2; ++kh) {
                  s16x8 hf0[4], hf1[4];
#pragma unroll
                  for (int ks = 0; ks < 4; ++ks) { hf0[ks] = *(const s16x8*)(hp + (4 * kh + ks) * 512); hf1[ks] = *(const s16x8*)(hp + (8 + 4 * kh + ks) * 512); }
#pragma unroll
                  for (int ks = 0; ks < 4; ++ks) { y0 = __builtin_amdgcn_mfma_f32_32x32x16_bf16(cfr[4 * kh + ks], hf0[ks], y0, 0, 0, 0); y1 = __builtin_amdgcn_mfma_f32_32x32x16_bf16(cfr[4 * kh + ks], hf1[ks], y1, 0, 0, 0); }
                  __builtin_amdgcn_sched_barrier(0);
              } }
#pragma unroll
            for (int q4 = 0; q4 < 4; ++q4) {
                const f32x4v a4 = *(const LAS f32x4v*)(acs + 32 * lt + 8 * q4 + 4 * h);
                const float e0 = __expf(a4[0]), e1 = __expf(a4[1]), e2 = __expf(a4[2]), e3 = __expf(a4[3]);
                y0[4 * q4] *= e0; y0[4 * q4 + 1] *= e1; y0[4 * q4 + 2] *= e2; y0[4 * q4 + 3] *= e3;
                y1[4 * q4] *= e0; y1[4 * q4 + 1] *= e1; y1[4 * q4 + 2] *= e2; y1[4 * q4 + 3] *= e3;
            }
            __builtin_amdgcn_sched_barrier(0);
            for (int st = 0; st <= lt; ++st) {
                f32x16 cb;
#pragma unroll
                for (int i = 0; i < 16; ++i) cb[i] = 0.f;
#pragma unroll
                for (int ks = 0; ks < 8; ++ks) {
                    const s16x8 bfrag = *(const LAS s16x8*)(ldsb + SSD_L_BM + (32 * st + r) * SSD_RS_B + (16 * ks + 8 * h) * 2);
                    cb = __builtin_amdgcn_mfma_f32_32x32x16_bf16(bfrag, cfr[ks], cb, 0, 0, 0);
                }
                __builtin_amdgcn_sched_barrier(0);
                const unsigned xb = xb0 + h3 * SSD_XIMG + st * 32 * SSD_RS_X;
                s16x4 xv[8];
                tr_read8<0, 8 * SSD_RS_X, 64, 8 * SSD_RS_X + 64, 16 * SSD_RS_X, 24 * SSD_RS_X, 16 * SSD_RS_X + 64, 24 * SSD_RS_X + 64>(xb, xv);
#pragma unroll
                for (int kk = 0; kk < 2; ++kk) {
                    const int s0 = 32 * st + 16 * kk + 4 * h;
                    const f32x4v as0 = *(const LAS f32x4v*)(acs + s0), as1 = *(const LAS f32x4v*)(acs + s0 + 8);
                    const f32x4v ds0 = *(const LAS f32x4v*)(dts + s0), ds1 = *(const LAS f32x4v*)(dts + s0 + 8);
                    float wv[8];
#pragma unroll
                    for (int j = 0; j < 8; ++j) {
                        const int s = s0 + 8 * (j >> 2) + (j & 3);
                        const float asj = (j < 4) ? as0[j & 3] : as1[j & 3], dsj = (j < 4) ? ds0[j & 3] : ds1[j & 3];
                        float v = cb[8 * kk + j] * __expf(myacs - asj) * dsj;
                        v = (s <= lcol) ? v : 0.f;
                        v = (s == lcol) ? v + Dh : v;
                        wv[j] = v;
                    }
                    s16x8 afr;
                    { v4u o; o.x = pk2(wv[0], wv[1]); o.y = pk2(wv[2], wv[3]); o.z = pk2(wv[4], wv[5]); o.w = pk2(wv[6], wv[7]); afr = __builtin_bit_cast(s16x8, o); }
                    const s16x8 b0 = kk == 0 ? TRCAT(xv[0], xv[1]) : TRCAT(xv[4], xv[5]);
                    const s16x8 b1 = kk == 0 ? TRCAT(xv[2], xv[3]) : TRCAT(xv[6], xv[7]);
                    y0 = __builtin_amdgcn_mfma_f32_32x32x16_bf16(afr, b0, y0, 0, 0, 0);
                    y1 = __builtin_amdgcn_mfma_f32_32x32x16_bf16(afr, b1, y1, 0, 0, 0);
                    __builtin_amdgcn_sched_barrier(0);
                }
            }
#pragma unroll
            for (int i = 0; i < 8; ++i) { ypk[h3][i] = pk2(y0[2 * i], y0[2 * i + 1]); ypk[h3][8 + i] = pk2(y1[2 * i], y1[2 * i + 1]); }
            __builtin_amdgcn_sched_barrier(0);
        }
        __syncthreads();
        {
            LAS unsigned short* yst = (LAS unsigned short*)(ldsb + SSD_L_X);
#pragma unroll
            for (int h3 = 0; h3 < 3; ++h3)
#pragma unroll
                for (int ptile = 0; ptile < 2; ++ptile)
#pragma unroll
                    for (int i = 0; i < 8; ++i) {
                        const int reg = 2 * i;
                        const int l0 = 32 * lt + (reg & 3) + 8 * (reg >> 2) + 4 * h;
                        const int col = (3 * hs + h3) * 64 + 32 * ptile + r;
                        const unsigned v = ypk[h3][8 * ptile + i];
                        yst[l0 * (SSD_RS_Y / 2) + col] = (unsigned short)(v & 0xffffu);
                        yst[(l0 + 1) * (SSD_RS_Y / 2) + col] = (unsigned short)(v >> 16);
                    }
        }
        __syncthreads();
#pragma unroll
        for (int pass = 0; pass < 4; ++pass) {
            const int l = 4 * (pass * 8 + w) + (lane >> 4), i16 = lane & 15;
            float gv[3][8]; float ss = 0.f;
#pragma unroll
            for (int k = 0; k < 3; ++k) {
                const int col0 = 24 * i16 + 8 * k;
                float yv[8], zv[8];
                unpack8(*(const LAS v4u*)(ldsb + SSD_L_X + l * SSD_RS_Y + col0 * 2), yv);
                unpack8(*(const v4u*)(projb + (size_t)(t0 + l) * NB_LD + g * 384 + col0), zv);
#pragma unroll
                for (int j = 0; j < 8; ++j) { const float gg = yv[j] * silu_f(zv[j]); gv[k][j] = gg; ss += gg * gg; }
            }
            ss += __shfl_xor(ss, 1); ss += __shfl_xor(ss, 2); ss += __shfl_xor(ss, 4); ss += __shfl_xor(ss, 8);
            const float rstd = rsqrtf(ss * (1.0f / 384.0f) + LN_EPS);
#pragma unroll
            for (int k = 0; k < 3; ++k) {
                const int col0 = g * 384 + 24 * i16 + 8 * k;
                const float4 g0 = *(const float4*)(norm_g + col0), g1 = *(const float4*)(norm_g + col0 + 4);
                v4u o; o.x = pk2(gv[k][0] * rstd * g0.x, gv[k][1] * rstd * g0.y); o.y = pk2(gv[k][2] * rstd * g0.z, gv[k][3] * rstd * g0.w);
                o.z = pk2(gv[k][4] * rstd * g1.x, gv[k][5] * rstd * g1.y); o.w = pk2(gv[k][6] * rstd * g1.z, gv[k][7] * rstd * g1.w);
                *(v4u*)(A1 + (size_t)(t0 + l) * MIX_WIDTH + col0) = o;
            }
        }
    }
}

#define ATT_RS_V 144
#define ATT_VIMG (256 * ATT_RS_V)
#define ATT_HIMG (2 * ATT_VIMG)
#define ATT_PVT(KT) { \
        s16x4 vv_[8]; \
        tr_read8<(32 * KT) * ATT_RS_V, (32 * KT + 8) * ATT_RS_V, (32 * KT) * ATT_RS_V + 64, (32 * KT + 8) * ATT_RS_V + 64, \
                 (32 * KT + 16) * ATT_RS_V, (32 * KT + 24) * ATT_RS_V, (32 * KT + 16) * ATT_RS_V + 64, (32 * KT + 24) * ATT_RS_V + 64>(vbase, vv_); \
        _Pragma("unroll") for (int s2_ = 0; s2_ < 2; ++s2_) { \
            v4u o_; o_.x = pk2(s[KT][8 * s2_ + 0], s[KT][8 * s2_ + 1]); o_.y = pk2(s[KT][8 * s2_ + 2], s[KT][8 * s2_ + 3]); \
            o_.z = pk2(s[KT][8 * s2_ + 4], s[KT][8 * s2_ + 5]); o_.w = pk2(s[KT][8 * s2_ + 6], s[KT][8 * s2_ + 7]); \
            const s16x8 pf_ = __builtin_bit_cast(s16x8, o_); \
            const s16x8 a0_ = s2_ == 0 ? TRCAT(vv_[0], vv_[1]) : TRCAT(vv_[4], vv_[5]); \
            const s16x8 a1_ = s2_ == 0 ? TRCAT(vv_[2], vv_[3]) : TRCAT(vv_[6], vv_[7]); \
            o0 = __builtin_amdgcn_mfma_f32_32x32x16_bf16(a0_, pf_, o0, 0, 0, 0); \
            o1 = __builtin_amdgcn_mfma_f32_32x32x16_bf16(a1_, pf_, o1, 0, 0, 0); } }
__device__ __forceinline__ void ph_attn_prompt(LAS unsigned char* ldsb, const bf16* __restrict__ qrot_b, const bf16* __restrict__ krot_b, const bf16* __restrict__ projb,
                                               bf16* __restrict__ obuf, float* __restrict__ lsebuf, const float* __restrict__ ck, const float* __restrict__ cv, float* __restrict__ out) {
    const int tid = threadIdx.x, w = __builtin_amdgcn_readfirstlane(tid >> 6), lane = tid & 63;
    const int r = lane & 31, h = lane >> 5, blk = (lane >> 4) & 1, q = (lane & 15) >> 2, pp = lane & 3;
    const int qt = w & 3, hsel = w >> 2;
    f32x4n rider[16]; bool pend = false; unsigned pq = 0u;
    for (int unit = blockIdx.x; unit < 3 * 512; unit += gridDim.x) {
        const int pat = unit >> 9, rem = unit & 511, hp = rem & 3, rem2 = rem >> 2, b = rem2 >> 6, bk = rem2 & 63;
        const int dsh = 2 * pat, nper = 64 >> dsh, res = bk >> (6 - dsh), nb = bk & (nper - 1);
        const int head = 2 * hp + hsel;
        __syncthreads();
        { v4u vst[8], kst[8];
#pragma unroll
          for (int it_ = 0; it_ < 8; ++it_) { const int idx = (tid & 255) + it_ * 256;
              const int row = idx >> 3, ch = idx & 7, js = 128 * nb - 128 + row, jc = js < 0 ? 0 : js;
              const size_t tk = (size_t)(b * SEQ + (jc << dsh) + res);
              vst[it_] = *(const v4u*)(projb + tk * NB_LD + NB_V + head * 64 + ch * 8);
              kst[it_] = *(const v4u*)(krot_b + tk * ATT_WIDTH + head * 64 + ch * 8); }
#pragma unroll
          for (int it_ = 0; it_ < 8; ++it_) { const int idx = (tid & 255) + it_ * 256;
              const int row = idx >> 3, ch = idx & 7, js = 128 * nb - 128 + row;
              v4u v = vst[it_], k = kst[it_]; if (js < 0) { v.x = 0u; v.y = 0u; v.z = 0u; v.w = 0u; k = v; }
              *(LAS v4u*)(ldsb + hsel * ATT_HIMG + row * ATT_RS_V + ch * 16) = v;
              *(LAS v4u*)(ldsb + hsel * ATT_HIMG + ATT_VIMG + row * ATT_RS_V + ch * 16) = k; } }
        const int tq = b * SEQ + ((128 * nb + 32 * qt + r) << dsh) + res;
        s16x8 qf[4];
#pragma unroll
        for (int ks = 0; ks < 4; ++ks) qf[ks] = *(const s16x8*)(qrot_b + (size_t)tq * ATT_WIDTH + head * 64 + 16 * ks + 8 * h);
        __syncthreads();
        f32x16 s[5];
#pragma unroll
        for (int kt = 0; kt < 5; ++kt) {
            const LAS unsigned char* kp = ldsb + hsel * ATT_HIMG + ATT_VIMG + (32 * qt + 32 * kt + r) * ATT_RS_V + 16 * h;
#pragma unroll
            for (int i = 0; i < 16; ++i) s[kt][i] = 0.f;
#pragma unroll
            for (int ks = 0; ks < 4; ++ks) s[kt] = __builtin_amdgcn_mfma_f32_32x32x16_bf16(*(const LAS s16x8*)(kp + 32 * ks), qf[ks], s[kt], 0, 0, 0);
        }
        if (pend) copy_q_store(out, pq, (unsigned)lane, rider);
        float m = -INFINITY;
#pragma unroll
        for (int kt = 0; kt < 5; ++kt) {
            const bool tile_ok = (nb > 0) || (qt + kt >= 4);
#pragma unroll
            for (int reg = 0; reg < 16; ++reg) {
                const int c = (reg & 3) + 8 * (reg >> 2) + 4 * h;
                const bool ok = tile_ok && (kt == 0 ? (c >= r) : (kt == 4 ? (c <= r) : true));
                const float v = ok ? s[kt][reg] * 0.125f : -INFINITY;
                s[kt][reg] = v; m = fmaxf(m, v);
            }
        }
        m = fmaxf(m, __shfl_xor(m, 32));
        float l = 0.f;
#pragma unroll
        for (int kt = 0; kt < 5; ++kt)
#pragma unroll
            for (int reg = 0; reg < 16; ++reg) { const float p = __expf(s[kt][reg] - m); s[kt][reg] = p; l += p; }
        l += __shfl_xor(l, 32);
        pq = (unsigned)(unit * NWAVE + w); copy_q_load(ck, cv, pq, (unsigned)lane, rider); pend = true;
        f32x16 o0, o1;
#pragma unroll
        for (int i = 0; i < 16; ++i) { o0[i] = 0.f; o1[i] = 0.f; }
        const unsigned vbase = lds_addr(ldsb + hsel * ATT_HIMG) + (32 * qt + 4 * h + q) * ATT_RS_V + (16 * blk + 4 * pp) * 2;
        ATT_PVT(0) ATT_PVT(1) ATT_PVT(2) ATT_PVT(3) ATT_PVT(4)
        const float inv = 1.0f / l;
        bf16* op = obuf + ((size_t)pat * T_PROMPT + tq) * ATT_WIDTH + head * 64 + 8 * h;
#pragma unroll
        for (int k2 = 0; k2 < 4; ++k2) {
            unsigned ax, ay, bx, by;
            if (k2 < 2) { ax = pk2(o0[8 * k2] * inv, o0[8 * k2 + 1] * inv); ay = pk2(o0[8 * k2 + 2] * inv, o0[8 * k2 + 3] * inv);
                          bx = pk2(o0[8 * k2 + 4] * inv, o0[8 * k2 + 5] * inv); by = pk2(o0[8 * k2 + 6] * inv, o0[8 * k2 + 7] * inv); }
            else { const int k3 = k2 - 2;
                   ax = pk2(o1[8 * k3] * inv, o1[8 * k3 + 1] * inv); ay = pk2(o1[8 * k3 + 2] * inv, o1[8 * k3 + 3] * inv);
                   bx = pk2(o1[8 * k3 + 4] * inv, o1[8 * k3 + 5] * inv); by = pk2(o1[8 * k3 + 6] * inv, o1[8 * k3 + 7] * inv); }
            const auto rx = __builtin_amdgcn_permlane32_swap(ax, bx, false, false);
            const auto ry = __builtin_amdgcn_permlane32_swap(ay, by, false, false);
            v4u o; o.x = rx[0]; o.y = ry[0]; o.z = rx[1]; o.w = ry[1];
            *(v4u*)(op + 16 * k2) = o;
        }
        if (h == 0) lsebuf[((size_t)pat * T_PROMPT + tq) * 8 + head] = m + __logf(l);
    }
    if (pend) copy_q_store(out, pq, (unsigned)lane, rider);
}
__device__ __forceinline__ void ph_attn_combine(const bf16* __restrict__ obuf, const float* __restrict__ lsebuf, bf16* __restrict__ A1) {
    const int lane = threadIdx.x & 63;
#pragma unroll 4
    for (int t = blockIdx.x * NWAVE + (threadIdx.x >> 6); t < T_PROMPT; t += gridDim.x * NWAVE) {
        const int hd = lane >> 3;
        const float l0 = lsebuf[((size_t)0 * T_PROMPT + t) * 8 + hd], l1 = lsebuf[((size_t)1 * T_PROMPT + t) * 8 + hd], l2 = lsebuf[((size_t)2 * T_PROMPT + t) * 8 + hd];
        const float mx = fmaxf(l0, fmaxf(l1, l2));
        const float e0 = __expf(l0 - mx), e1 = __expf(l1 - mx), e2 = __expf(l2 - mx);
        const float inv = 1.0f / (e0 + e1 + e2);
        float a[8], b[8], c[8];
        unpack8(*(const v4u*)(obuf + ((size_t)0 * T_PROMPT + t) * ATT_WIDTH + lane * 8), a);
        unpack8(*(const v4u*)(obuf + ((size_t)1 * T_PROMPT + t) * ATT_WIDTH + lane * 8), b);
        unpack8(*(const v4u*)(obuf + ((size_t)2 * T_PROMPT + t) * ATT_WIDTH + lane * 8), c);
        float o[8];
#pragma unroll
        for (int j = 0; j < 8; ++j) o[j] = (e0 * a[j] + e1 * b[j] + e2 * c[j]) * inv;
        v4u w; w.x = pk2(o[0], o[1]); w.y = pk2(o[2], o[3]); w.z = pk2(o[4], o[5]); w.w = pk2(o[6], o[7]);
        *(v4u*)(A1 + (size_t)t * MIX_WIDTH + SSD_WIDTH + lane * 8) = w;
    }
}

#define RT_RS 272
#define RT_KIMG (128 * RT_RS)
#define RT_LUT (2 * RT_KIMG)
constexpr unsigned char RT_CANDS[64] = {0, 1, 2, 3, 4, 5, 6, 7, 8, 9, 10, 11, 12, 13, 14, 15, 16, 17, 18, 19, 20, 21, 22, 23, 32, 33, 34, 35, 36, 48, 49, 50, 51, 64, 65, 66, 80, 81, 96, 97,
                                        112, 113, 128, 144, 160, 176, 192, 208, 224, 240, 0, 0, 0, 0, 0, 0, 0, 0, 0, 0, 0, 0, 0, 0};
__device__ __forceinline__ unsigned rt_mono(float f) { const unsigned u = __builtin_bit_cast(unsigned, f); return u ^ ((unsigned)((int)u >> 31) | 0x80000000u); }
__device__ __forceinline__ float rt_unmono(unsigned m) { const unsigned u = (m & 0x80000000u) ? (m ^ 0x80000000u) : ~m; return __builtin_bit_cast(float, u); }
#define RT_CE_DESC(a, b) { const unsigned x_ = (a), y_ = (b); (a) = x_ > y_ ? x_ : y_; (b) = x_ > y_ ? y_ : x_; }
#define RT_CE_ASC(a, b) { const unsigned x_ = (a), y_ = (b); (a) = x_ > y_ ? y_ : x_; (b) = x_ > y_ ? x_ : y_; }
__device__ __forceinline__ void rt_sort16(unsigned (&v)[16]) {
#pragma unroll
    for (int k = 2; k <= 16; k <<= 1)
#pragma unroll
        for (int j = k >> 1; j > 0; j >>= 1)
#pragma unroll
            for (int i = 0; i < 16; ++i) { const int l = i ^ j; if (l > i) { if ((i & k) == 0) RT_CE_DESC(v[i], v[l]) else RT_CE_ASC(v[i], v[l]) } }
}
__device__ __forceinline__ void rt_merge16(unsigned (&v)[16]) {
#pragma unroll
    for (int j = 8; j > 0; j >>= 1)
#pragma unroll
        for (int i = 0; i < 16; ++i) { const int l = i ^ j; if (l > i) RT_CE_DESC(v[i], v[l]) }
}
__device__ __forceinline__ void rt_top16(unsigned (&a)[16], const unsigned (&b)[16]) {
#pragma unroll
    for (int i = 0; i < 16; ++i) a[i] = a[i] > b[15 - i] ? a[i] : b[15 - i];
    rt_merge16(a);
}
__device__ __forceinline__ void rt_top16_partner(unsigned (&a)[16]) {
    unsigned b[16];
#pragma unroll
    for (int i = 0; i < 16; ++i) b[i] = (unsigned)__shfl_xor((int)a[i], 32);
    rt_top16(a, b);
}
__device__ __forceinline__ void rt_scores_top16(LAS unsigned char* kimg, const bf16* __restrict__ qp, int r, int h, unsigned (&k0)[16]) {
    f32x16 acc[4];
#pragma unroll
    for (int kt = 0; kt < 4; ++kt)
#pragma unroll
        for (int i = 0; i < 16; ++i) acc[kt][i] = 0.f;
#pragma unroll
    for (int ks = 0; ks < 8; ++ks) {
        const s16x8 qf = *(const s16x8*)(qp + 16 * ks);
#pragma unroll
        for (int kt = 0; kt < 4; ++kt) {
            const s16x8 kf = *(const LAS s16x8*)(kimg + (32 * kt + r) * RT_RS + (16 * ks + 8 * h) * 2);
            acc[kt] = __builtin_amdgcn_mfma_f32_32x32x16_bf16(kf, qf, acc[kt], 0, 0, 0);
        }
    }
    unsigned k1[16], k2[16], k3[16];
#pragma unroll
    for (int reg = 0; reg < 16; ++reg) {
        const unsigned ki = (unsigned)((reg & 3) + 8 * (reg >> 2) + 4 * h);
        k0[reg] = (rt_mono(acc[0][reg]) & 0xFFFFFF80u) | ki;
        k1[reg] = (rt_mono(acc[1][reg]) & 0xFFFFFF80u) | (ki + 32u);
        k2[reg] = (rt_mono(acc[2][reg]) & 0xFFFFFF80u) | (ki + 64u);
        k3[reg] = (rt_mono(acc[3][reg]) & 0xFFFFFF80u) | (ki + 96u);
    }
    rt_sort16(k0); rt_sort16(k1); rt_sort16(k2); rt_sort16(k3);
    rt_top16(k0, k1); rt_top16(k2, k3); rt_top16(k0, k2);
    rt_top16_partner(k0);
}
__device__ __forceinline__ void ph_peer_route2(LAS unsigned char* ldsb, const bf16* __restrict__ qhb, const float* __restrict__ keys1, const float* __restrict__ keys2,
                                               int* __restrict__ eidx, float* __restrict__ gate, const float* __restrict__ ck, const float* __restrict__ cv, float* __restrict__ out) {
    const int tid = threadIdx.x, w = __builtin_amdgcn_readfirstlane(tid >> 6), lane = tid & 63, r = lane & 31, h = lane >> 5;
    __syncthreads();
    for (int idx = tid; idx < 2 * 128 * 16; idx += NTHR) {
        const int tb = idx >> 11, rem = idx & 2047, row = rem >> 4, ch = rem & 15;
        const float* sp = (tb ? keys2 : keys1) + row * 128 + ch * 8;
        const float4 a = *(const float4*)sp, b = *(const float4*)(sp + 4);
        v4u o; o.x = pk2(a.x, a.y); o.y = pk2(a.z, a.w); o.z = pk2(b.x, b.y); o.w = pk2(b.z, b.w);
        *(LAS v4u*)(ldsb + tb * RT_KIMG + row * RT_RS + ch * 16) = o;
    }
    __syncthreads();
    LAS unsigned* lut = (LAS unsigned*)(ldsb + RT_LUT) + w * 512;
    for (int k = 0;; ++k) {
        int unit;
        if (gridDim.x != 256) { unit = blockIdx.x * NWAVE + w + k * (int)(gridDim.x * NWAVE); if (unit >= (T_ALL / 32) * 8) break; }
        else if (k < 2) unit = k * 2048 + blockIdx.x * NWAVE + w;
        else if (k == 2 && w == 0 && blockIdx.x < 128) unit = 4096 + (int)blockIdx.x;
        else break;
        const int tt = unit >> 3, hd = unit & 7;
        const int tok = 32 * tt + r;
        const bf16* qp = qhb + (size_t)tok * 2048 + hd * 256 + 8 * h;
        unsigned ka[16], kb[16];
        rt_scores_top16(ldsb, qp, r, h, ka);
        rt_scores_top16(ldsb + RT_KIMG, qp + 128, r, h, kb);
        float v1[16], v2[16];
#pragma unroll
        for (int i = 0; i < 16; ++i) { v1[i] = rt_unmono(ka[i] & 0xFFFFFF80u); v2[i] = rt_unmono(kb[i] & 0xFFFFFF80u); }
#pragma unroll
        for (int wd = 0; wd < 4; ++wd) {
            lut[wd * 64 + lane] = (ka[4 * wd] & 0x7Fu) | ((ka[4 * wd + 1] & 0x7Fu) << 8) | ((ka[4 * wd + 2] & 0x7Fu) << 16) | ((ka[4 * wd + 3] & 0x7Fu) << 24);
            lut[(4 + wd) * 64 + lane] = (kb[4 * wd] & 0x7Fu) | ((kb[4 * wd + 1] & 0x7Fu) << 8) | ((kb[4 * wd + 2] & 0x7Fu) << 16) | ((kb[4 * wd + 3] & 0x7Fu) << 24);
        }
        unsigned c0[16], c1[16];
        c0[0] = (rt_mono(h ? (v1[0] + v2[1]) : (v1[0] + v2[0])) & 0xFFFFFF00u) | (h ? 1u : 0u);
        c0[1] = (rt_mono(h ? (v1[0] + v2[3]) : (v1[0] + v2[2])) & 0xFFFFFF00u) | (h ? 3u : 2u);
        c0[2] = (rt_mono(h ? (v1[0] + v2[5]) : (v1[0] + v2[4])) & 0xFFFFFF00u) | (h ? 5u : 4u);
        c0[3] = (rt_mono(h ? (v1[0] + v2[7]) : (v1[0] + v2[6])) & 0xFFFFFF00u) | (h ? 7u : 6u);
        c0[4] = (rt_mono(h ? (v1[0] + v2[9]) : (v1[0] + v2[8])) & 0xFFFFFF00u) | (h ? 9u : 8u);
        c0[5] = (rt_mono(h ? (v1[0] + v2[11]) : (v1[0] + v2[10])) & 0xFFFFFF00u) | (h ? 11u : 10u);
        c0[6] = (rt_mono(h ? (v1[0] + v2[13]) : (v1[0] + v2[12])) & 0xFFFFFF00u) | (h ? 13u : 12u);
        c0[7] = (rt_mono(h ? (v1[0] + v2[15]) : (v1[0] + v2[14])) & 0xFFFFFF00u) | (h ? 15u : 14u);
        c0[8] = (rt_mono(h ? (v1[1] + v2[1]) : (v1[1] + v2[0])) & 0xFFFFFF00u) | (h ? 17u : 16u);
        c0[9] = (rt_mono(h ? (v1[1] + v2[3]) : (v1[1] + v2[2])) & 0xFFFFFF00u) | (h ? 19u : 18u);
        c0[10] = (rt_mono(h ? (v1[1] + v2[5]) : (v1[1] + v2[4])) & 0xFFFFFF00u) | (h ? 21u : 20u);
        c0[11] = (rt_mono(h ? (v1[1] + v2[7]) : (v1[1] + v2[6])) & 0xFFFFFF00u) | (h ? 23u : 22u);
        c0[12] = (rt_mono(h ? (v1[2] + v2[1]) : (v1[2] + v2[0])) & 0xFFFFFF00u) | (h ? 33u : 32u);
        c0[13] = (rt_mono(h ? (v1[2] + v2[3]) : (v1[2] + v2[2])) & 0xFFFFFF00u) | (h ? 35u : 34u);
        c0[14] = (rt_mono(h ? (v1[3] + v2[0]) : (v1[2] + v2[4])) & 0xFFFFFF00u) | (h ? 48u : 36u);
        c0[15] = (rt_mono(h ? (v1[3] + v2[2]) : (v1[3] + v2[1])) & 0xFFFFFF00u) | (h ? 50u : 49u);
        c1[0] = (rt_mono(h ? (v1[4] + v2[0]) : (v1[3] + v2[3])) & 0xFFFFFF00u) | (h ? 64u : 51u);
        c1[1] = (rt_mono(h ? (v1[4] + v2[2]) : (v1[4] + v2[1])) & 0xFFFFFF00u) | (h ? 66u : 65u);
        c1[2] = (rt_mono(h ? (v1[5] + v2[1]) : (v1[5] + v2[0])) & 0xFFFFFF00u) | (h ? 81u : 80u);
        c1[3] = (rt_mono(h ? (v1[6] + v2[1]) : (v1[6] + v2[0])) & 0xFFFFFF00u) | (h ? 97u : 96u);
        c1[4] = (rt_mono(h ? (v1[7] + v2[1]) : (v1[7] + v2[0])) & 0xFFFFFF00u) | (h ? 113u : 112u);
        c1[5] = (rt_mono(h ? (v1[9] + v2[0]) : (v1[8] + v2[0])) & 0xFFFFFF00u) | (h ? 144u : 128u);
        c1[6] = (rt_mono(h ? (v1[11] + v2[0]) : (v1[10] + v2[0])) & 0xFFFFFF00u) | (h ? 176u : 160u);
        c1[7] = (rt_mono(h ? (v1[13] + v2[0]) : (v1[12] + v2[0])) & 0xFFFFFF00u) | (h ? 208u : 192u);
        c1[8] = (rt_mono(h ? (v1[15] + v2[0]) : (v1[14] + v2[0])) & 0xFFFFFF00u) | (h ? 240u : 224u);
        c1[9] = 0u;
        c1[10] = 0u;
        c1[11] = 0u;
        c1[12] = 0u;
        c1[13] = 0u;
        c1[14] = 0u;
        c1[15] = 0u;
        rt_sort16(c0); rt_sort16(c1); rt_top16(c0, c1); rt_top16_partner(c0);
        float e[16]; float sum = 0.f;
        const float mx = rt_unmono(c0[0] & 0xFFFFFF00u);
#pragma unroll
        for (int k = 0; k < 16; ++k) { e[k] = __expf(rt_unmono(c0[k] & 0xFFFFFF00u) - mx); sum += e[k]; }
        const float inv = 1.0f / sum;
        asm volatile("s_waitcnt lgkmcnt(0)" ::: "memory");
        int ex[8]; float gv[8];
#pragma unroll
        for (int k = 0; k < 8; ++k) {
            const unsigned hm = (unsigned)(-h);
            const unsigned ck = (c0[k] & ~hm) | (c0[8 + k] & hm);
            const float ek = __builtin_bit_cast(float, (__builtin_bit_cast(unsigned, e[k]) & ~hm) | (__builtin_bit_cast(unsigned, e[8 + k]) & hm));
            const unsigned ci = (ck >> 4) & 15u, cj = ck & 15u;
            const unsigned w1 = lut[(ci >> 2) * 64 + lane], w2 = lut[(4 + (cj >> 2)) * 64 + lane];
            const unsigned i1 = (w1 >> (8 * (ci & 3))) & 0x7Fu, i2 = (w2 >> (8 * (cj & 3))) & 0x7Fu;
            ex[k] = (int)(i1 * PEER_NKEYS + i2); gv[k] = ek * inv;
        }
        int* ep = eidx + (size_t)tok * 128 + hd * 16 + 8 * h; float* gp = gate + (size_t)tok * 128 + hd * 16 + 8 * h;
        *(int4*)ep = make_int4(ex[0], ex[1], ex[2], ex[3]); *(int4*)(ep + 4) = make_int4(ex[4], ex[5], ex[6], ex[7]);
        *(float4*)gp = make_float4(gv[0], gv[1], gv[2], gv[3]); *(float4*)(gp + 4) = make_float4(gv[4], gv[5], gv[6], gv[7]);
    }
    if (gridDim.x == 256 && (w != 0 || blockIdx.x >= 128)) {
        const unsigned si = blockIdx.x < 128 ? blockIdx.x * 7u + (unsigned)(w - 1) : 896u + (blockIdx.x - 128u) * 8u + (unsigned)w;
        cache_copy_slice(ck, cv, out, 7040u + si, (unsigned)lane);
    }
}

struct Params {
    const float* in[23];
    float* out;
    unsigned char* ws;
    unsigned* bar;
};

#define WS_BAR      0ull
#define WS_XALL     (1ull << 20)
#define WS_PROJ     (WS_XALL + (size_t)T_ALL * D_MODEL * 4)
#define WS_XBC      (WS_PROJ + (size_t)T_ALL * PROJ_LD * 4)
#define WS_DT       (WS_XBC + (size_t)T_ALL * CONV_DIM * 4)
#define WS_QROT     (WS_DT + (size_t)T_ALL * SSD_HEADS * 4)
#define WS_KROT     (WS_QROT + (size_t)T_ALL * ATT_WIDTH * 4)
#define WS_YBUF     (WS_KROT + (size_t)T_ALL * ATT_WIDTH * 4)
#define WS_MIX      (WS_YBUF + (size_t)T_ALL * MIX_WIDTH * 4)
#define WS_HBUF     (WS_MIX + (size_t)T_ALL * D_MODEL * 4)
#define WS_QH       (WS_HBUF + (size_t)T_ALL * D_MODEL * 4)
#define WS_EIDX     (WS_QH + (size_t)T_ALL * 2048 * 4)
#define WS_GATE     (WS_EIDX + (size_t)T_ALL * 128 * 4)
#define WS_A0       (WS_GATE + (size_t)T_ALL * 128 * 4)
#define WS_A1       (WS_A0 + (size_t)T_ALL * D_MODEL * 2)
#define WS_A2       (WS_A1 + (size_t)T_ALL * MIX_WIDTH * 2)
#define WS_WTIN     (WS_A2 + (size_t)T_ALL * D_MODEL * 2)
#define WS_WTOUT    (WS_WTIN + (size_t)PROJ_LD * D_MODEL * 2)
#define WS_WTQ      (WS_WTOUT + (size_t)D_MODEL * MIX_WIDTH * 2)
#define WS_PROJB    (WS_WTQ + (size_t)2048 * D_MODEL * 2)
#define WS_DTRAW    (WS_PROJB + (size_t)T_ALL * NB_LD * 2)
#define WS_XBCB     (WS_DTRAW + (size_t)T_ALL * 32 * 4)
#define WS_QROTB    (WS_XBCB + (size_t)T_ALL * CONV_DIM * 2)
#define WS_KROTB    (WS_QROTB + (size_t)T_ALL * ATT_WIDTH * 2)
#define WS_UB       (WS_KROTB + (size_t)T_ALL * ATT_WIDTH * 2)
#define WS_VB       (WS_UB + (size_t)16384 * D_MODEL * 2)
#define WS_USC      (WS_VB + (size_t)16384 * D_MODEL * 2)
#define WS_VSC      (WS_USC + 16384 * 4)
#define WS_SBUF     (WS_VSC + 16384 * 4)
#define WS_HIN      (WS_SBUF + (size_t)BATCH * 64 * SSD_HEADS * 64 * 128 * 2)
#define WS_CDEC     (WS_HIN + (size_t)BATCH * 64 * SSD_HEADS * 64 * 128 * 2)
#define WS_OBUF     (WS_CDEC + (size_t)BATCH * 64 * SSD_HEADS * 4)
#define WS_LSE      (WS_OBUF + (size_t)3 * T_PROMPT * ATT_WIDTH * 2)
#define WS_ROPE     (WS_LSE + (size_t)3 * T_PROMPT * 8 * 4)
#define WS_END      (WS_ROPE + (size_t)SEQ * 64 * 4)

#define LDS_BYTES (160 * 1024)

#define KP const __attribute__((address_space(4))) Params* kp = (const __attribute__((address_space(4))) Params*)__builtin_amdgcn_kernarg_segment_ptr(); asm volatile("" : "+s"(kp)); unsigned char* ws = kp->ws; (void)ws;
#define IN(i) (kp->in[i])
#define WSP(T, off) ((T*)(ws + (off)))
__global__ void __launch_bounds__(512, 2) mega_fwd(Params p) {
    extern __shared__ __attribute__((aligned(16))) unsigned char smem[];
    if (threadIdx.x == 0) *(uint4*)smem = make_uint4(0u, 0u, 0u, 0u);
    __syncthreads();
    XcdBarrier bar = xcd_barrier_post(p.bar, (volatile LAS unsigned*)smem);
    float* lds = (float*)(smem + 256);
    LAS unsigned char* ldsb = (LAS unsigned char*)smem + 256;

    { KP ph_prologue(ldsb, IN(0), IN(1), WSP(bf16, WS_A0), IN(6), WSP(bf16, WS_WTIN), WSP(float, WS_ROPE)); }
    xcd_barrier(bar);
    { KP pg8::Gemm g{WSP(bf16, WS_A0), WSP(bf16, WS_WTIN), T_ALL, PROJ_LD, D_MODEL}; pg8::StaticOrder S; S.init(g.M, g.N, (int)gridDim.x, (int)blockIdx.x);
      pg8::EpiProj E{WSP(bf16, WS_PROJB), WSP(float, WS_DTRAW)}; pg8::gemm_phase<pg8::EpiProj, pg8::StaticOrder, false>(ldsb, g, S, E, nullptr); }
    xcd_barrier(bar);
    { KP ph_post_proj_prompt(WSP(bf16, WS_PROJB), WSP(float, WS_DTRAW), IN(7), IN(8), IN(9), WSP(float, WS_ROPE), WSP(bf16, WS_XBCB), WSP(float, WS_DT), WSP(bf16, WS_QROTB), WSP(bf16, WS_KROTB), kp->out); }
    { KP ph_post_proj2(WSP(bf16, WS_PROJB), WSP(float, WS_DTRAW), IN(4), IN(7), IN(8), IN(9), WSP(bf16, WS_XBCB), WSP(float, WS_DT), WSP(bf16, WS_QROTB), WSP(bf16, WS_KROTB), kp->out); }
    xcd_barrier(bar);
    { KP ph_ssd_states(ldsb, WSP(bf16, WS_XBCB), WSP(float, WS_DT), IN(10), WSP(bf16, WS_SBUF), WSP(float, WS_CDEC), IN(2), IN(3), kp->out); }
    __syncthreads();
    { KP ph_attn_prompt(ldsb, WSP(bf16, WS_QROTB), WSP(bf16, WS_KROTB), WSP(bf16, WS_PROJB), WSP(bf16, WS_OBUF), WSP(float, WS_LSE), IN(2), IN(3), kp->out); }
    __syncthreads();
    { KP ph_ssd_decode(WSP(bf16, WS_XBCB), WSP(float, WS_DT), IN(10), IN(11), IN(5), WSP(float, WS_YBUF), kp->out); }
    { KP ph_attn_sample3(lds, WSP(bf16, WS_QROTB), WSP(bf16, WS_KROTB), WSP(bf16, WS_PROJB), IN(2), IN(3), WSP(bf16, WS_A1)); }
    xcd_barrier(bar);
    if ((int)gridDim.x > 128) {
        if ((int)blockIdx.x < 96) { KP ph_ssd_scan(WSP(bf16, WS_SBUF), WSP(float, WS_CDEC), WSP(bf16, WS_HIN), kp->out, (int)blockIdx.x, 96); }
        else {
            { KP ph_prologue2(ldsb, IN(13), WSP(bf16, WS_WTOUT), IN(16), WSP(bf16, WS_WTQ), (int)blockIdx.x - 96, (int)gridDim.x - 96); }
            { KP ph_quant_tables(IN(19), IN(20), WSP(unsigned char, WS_UB), WSP(unsigned char, WS_VB), WSP(float, WS_USC), WSP(float, WS_VSC), (int)blockIdx.x - 96, (int)gridDim.x - 96); }
        }
    } else {
        { KP ph_ssd_scan(WSP(bf16, WS_SBUF), WSP(float, WS_CDEC), WSP(bf16, WS_HIN), kp->out, (int)blockIdx.x, (int)gridDim.x); }
        { KP ph_prologue2(ldsb, IN(13), WSP(bf16, WS_WTOUT), IN(16), WSP(bf16, WS_WTQ), (int)blockIdx.x, (int)gridDim.x); }
        { KP ph_quant_tables(IN(19), IN(20), WSP(unsigned char, WS_UB), WSP(unsigned char, WS_VB), WSP(float, WS_USC), WSP(float, WS_VSC), (int)blockIdx.x, (int)gridDim.x); }
    }
    xcd_barrier(bar);
    { KP ph_ssd_out(ldsb, WSP(bf16, WS_XBCB), WSP(bf16, WS_PROJB), WSP(float, WS_DT), IN(10), IN(11), IN(12), WSP(bf16, WS_HIN), WSP(bf16, WS_A1)); }
    { KP ph_attn_combine(WSP(bf16, WS_OBUF), WSP(float, WS_LSE), WSP(bf16, WS_A1)); }
    { KP ph_gate_norm(WSP(bf16, WS_PROJB), IN(12), WSP(float, WS_YBUF), WSP(bf16, WS_A1)); }
    xcd_barrier(bar);
    { KP pg8::Gemm g{WSP(bf16, WS_A1), WSP(bf16, WS_WTOUT), T_ALL, D_MODEL, MIX_WIDTH}; pg8::StaticOrder S; S.init(g.M, g.N, (int)gridDim.x, (int)blockIdx.x);
      pg8::EpiBf16Plain E{WSP(bf16, WS_MIX), D_MODEL}; pg8::gemm_phase<pg8::EpiBf16Plain, pg8::StaticOrder, false>(ldsb, g, S, E, nullptr); }
    if (blockIdx.x >= 8 && gridDim.x == 256) { KP cache_copy_slice(IN(2), IN(3), kp->out, 4096u + (blockIdx.x - 8) * 8u + (threadIdx.x >> 6), threadIdx.x & 63u); }
    xcd_barrier(bar);
    { KP ph_ln_res(IN(0), IN(1), WSP(bf16, WS_MIX), IN(14), IN(15), WSP(bf16, WS_A2)); }
    xcd_barrier(bar);
    { KP pg8::Gemm g{WSP(bf16, WS_A2), WSP(bf16, WS_WTQ), T_ALL, 2048, D_MODEL}; pg8::StaticOrder S; S.init(g.M, g.N, (int)gridDim.x, (int)blockIdx.x);
      pg8::EpiBf16Plain E{WSP(bf16, WS_QH), 2048}; pg8::gemm_phase<pg8::EpiBf16Plain, pg8::StaticOrder, false>(ldsb, g, S, E, nullptr); }
    if (blockIdx.x >= 16 && gridDim.x == 256 && threadIdx.x < 256) { KP cache_copy_slice(IN(2), IN(3), kp->out, 4096u + 1984u + (blockIdx.x - 16) * 4u + (threadIdx.x >> 6), threadIdx.x & 63u); }
    xcd_barrier(bar);
    { KP ph_peer_route2(ldsb, WSP(bf16, WS_QH), IN(17), IN(18), WSP(int, WS_EIDX), WSP(float, WS_GATE), IN(2), IN(3), kp->out); }
    xcd_barrier(bar);
    { KP ph_peer_ffn3(WSP(bf16, WS_A2), WSP(int, WS_EIDX), WSP(float, WS_GATE), WSP(unsigned char, WS_UB), WSP(unsigned char, WS_VB), WSP(float, WS_USC), WSP(float, WS_VSC), IN(21), IN(22), kp->out, IN(2), IN(3), gridDim.x == 256 ? 8960u : 4096u); }
}

extern "C" void kernel_launch(void* const* d_in, const int* in_sizes, int n_in, void* d_out, int out_size, void* d_ws, size_t ws_size, hipStream_t stream) {
    static int grid = 0;
    if (grid == 0) {
        int dev = 0, cus = 0, per_cu = 0;
        if (hipGetDevice(&dev) != hipSuccess || hipDeviceGetAttribute(&cus, hipDeviceAttributeMultiprocessorCount, dev) != hipSuccess) { fprintf(stderr, "kernel_launch: device query failed\n"); grid = -1; return; }
        if (hipFuncSetAttribute((const void*)mega_fwd, hipFuncAttributeMaxDynamicSharedMemorySize, LDS_BYTES) != hipSuccess) { fprintf(stderr, "kernel_launch: hipFuncSetAttribute failed\n"); grid = -1; return; }
        if (hipOccupancyMaxActiveBlocksPerMultiprocessor(&per_cu, (const void*)mega_fwd, NTHR, LDS_BYTES) != hipSuccess || per_cu < 1) { fprintf(stderr, "kernel_launch: occupancy query says %d\n", per_cu); }
        (void)hipGetLastError();
        grid = cus;
        if (ws_size < WS_END) { fprintf(stderr, "kernel_launch: workspace too small\n"); grid = -1; return; }
    }
    if (grid < 0) return;
    (void)hipMemsetAsync((char*)d_ws + WS_BAR, 0, XCD_BAR_WORDS * sizeof(unsigned), stream);
    Params p{};
    for (int i = 0; i < 23; ++i) p.in[i] = (const float*)d_in[i];
    p.out = (float*)d_out; p.ws = (unsigned char*)d_ws; p.bar = (unsigned*)((char*)d_ws + WS_BAR);
    hipLaunchKernelGGL(mega_fwd, dim3(grid), dim3(NTHR), LDS_BYTES, stream, p);
}
```

```cpp
#include <hip/hip_runtime.h>
#include <stdint.h>

#define D_MODEL 1024
#define BATCH 2
#define SEQ 8192
#define DEC_BATCH 128
#define DEC_SEQ 4
#define PAST_LEN 8192
#define HEAD_DIM 64
#define ATT_WIDTH 512
#define ATT_HEADS 8
#define SSD_WIDTH 1536
#define SSD_HEADS 24
#define SSD_GROUPS 4
#define SSD_STATE 128
#define CONV_DIM 2560
#define IN_WIDTH 5656
#define PROJ_LD 5888
#define MIX_WIDTH 2048
#define WBUF 2048
#define PEER_NKEYS 128
#define PEER_HEADS 8
#define PEER_TOPK 16
#define PEER_DKEY 256
#define T_PROMPT (BATCH * SEQ)
#define T_SAMPLE (DEC_BATCH * DEC_SEQ)
#define T_ALL (T_PROMPT + T_SAMPLE)
#define O_Z 0
#define O_XBC 1536
#define O_DT 4096
#define O_Q 4120
#define O_K 4632
#define O_V 5144
#define ALPHA_F 1.189207115002721f
#define LN_EPS 1e-5f

#define OUT_YP 0ull
#define OUT_YS (OUT_YP + 16777216ull)
#define OUT_PK (OUT_YS + 524288ull)
#define OUT_PV (OUT_PK + 2097152ull)
#define OUT_PC (OUT_PV + 2097152ull)
#define OUT_PS (OUT_PC + 15360ull)
#define OUT_SK (OUT_PS + 393216ull)
#define OUT_SV (OUT_SK + 134217728ull)
#define OUT_SC (OUT_SV + 134217728ull)
#define OUT_SS (OUT_SC + 983040ull)

__constant__ double ROPE_INV_REV[32] = {
    1.59154943091895346e-01, 1.19349370211248862e-01, 8.94994016088910133e-02, 6.71150830052272551e-02,
    5.03292121044870353e-02, 3.77415847174197711e-02, 2.83021958306233987e-02, 2.12236527647776604e-02,
    1.59154943091895339e-02, 1.19349370211248862e-02, 8.94994016088910237e-03, 6.71150830052272534e-03,
    5.03292121044870370e-03, 3.77415847174197719e-03, 2.83021958306233987e-03, 2.12236527647776622e-03,
    1.59154943091895356e-03, 1.19349370211248849e-03, 8.94994016088910237e-04, 6.71150830052272599e-04,
    5.03292121044870326e-04, 3.77415847174197741e-04, 2.83021958306233954e-04, 2.12236527647776605e-04,
    1.59154943091895351e-04, 1.19349370211248862e-04, 8.94994016088910182e-05, 6.71150830052272545e-05,
    5.03292121044870354e-05, 3.77415847174197768e-05, 2.83021958306233961e-05, 2.12236527647776592e-05
};

__device__ __forceinline__ float silu_f(float x) { return x * __builtin_amdgcn_rcpf(1.0f + __expf(-x)); }
__device__ __forceinline__ float softplus_f(float x) { return fmaxf(x, 0.f) + log1pf(__expf(-fabsf(x))); }
__device__ __forceinline__ float gelu_f(float x) { return 0.5f * x * (1.0f + erff(x * 0.70710678118654752f)); }
__device__ __forceinline__ float wave_sum(float v) {
#pragma unroll
    for (int o = 32; o > 0; o >>= 1) v += __shfl_xor(v, o);
    return v;
}
__device__ __forceinline__ float wave_max(float v) {
#pragma unroll
    for (int o = 32; o > 0; o >>= 1) v = fmaxf(v, __shfl_xor(v, o));
    return v;
}

#include <cstdio>
#define XB_TMO      128
#define XB_XCNT(j)  (256  + 64 * (j))
#define XB_XSUB(j)  (1280 + 64 * (j))
#define XB_XGEN(j)  (2304 + 64 * (j))
#define XB_TOP      3328
#define XB_TOPGEN   3392
#define XCD_BAR_WORDS 3456
#define XB_SPIN_CAP (1u << 18)
#define LAS __attribute__((address_space(3)))

__device__ __forceinline__ unsigned xb_ld(unsigned* p)              { return __hip_atomic_load(p, __ATOMIC_RELAXED, __HIP_MEMORY_SCOPE_AGENT); }
__device__ __forceinline__ unsigned xb_add(unsigned* p, unsigned v) { return __hip_atomic_fetch_add(p, v, __ATOMIC_RELAXED, __HIP_MEMORY_SCOPE_AGENT); }
__device__ __forceinline__ unsigned xb_xcc_id() { return (unsigned)__builtin_amdgcn_s_getreg((3 << 11) | 20) & 0xFu; }
#define XB_SPIN(cond, bar) do { unsigned _sp = 0; while (cond) { __builtin_amdgcn_s_sleep(1); \
    if ((++_sp & 255u) == 0u) { if (xb_ld(&(bar)[XB_TMO])) break; if (_sp > XB_SPIN_CAP) { atomicAdd(&(bar)[XB_TMO], 1u); break; } } } } while (0)

struct XcdBarrier {
    unsigned* bar; unsigned x;
    volatile LAS unsigned* st;
};

__device__ __forceinline__ XcdBarrier xcd_barrier_post(unsigned* bar, volatile LAS unsigned* st) {
    XcdBarrier b; b.bar = bar; b.x = xb_xcc_id(); b.st = st;
    if (threadIdx.x == 0) (void)xb_add(&bar[XB_XCNT(b.x)], 1u);
    return b;
}
__device__ __forceinline__ void xcd_barrier_complete(unsigned* bar, unsigned x, unsigned& nloc, unsigned& nx) {
    const unsigned G = gridDim.x * gridDim.y * gridDim.z;
    unsigned sum, cnt, mine, sp = 0u;
    for (;;) {
        sum = 0u; cnt = 0u; mine = 0u;
#pragma unroll
        for (unsigned j = 0; j < 16; ++j) { const unsigned c = xb_ld(&bar[XB_XCNT(j)]); sum += c; cnt += (c > 0u) ? 1u : 0u; mine = (j == x) ? c : mine; }
        if (sum == G) break;
        __builtin_amdgcn_s_sleep(1);
        if ((++sp & 255u) == 0u) { if (xb_ld(&bar[XB_TMO])) break; if (sp > XB_SPIN_CAP) { atomicAdd(&bar[XB_TMO], 1u); break; } }
    }
    nloc = mine > 0u ? mine : 1u; nx = cnt > 0u ? cnt : 1u;
}

__device__ __forceinline__ void xcd_barrier(const XcdBarrier& b) {
    asm volatile("s_waitcnt vmcnt(0)" ::: "memory");
    __syncthreads();
    if (threadIdx.x == 0) {
        unsigned* bar = b.bar;
        __builtin_amdgcn_s_waitcnt(0);
        unsigned nloc = b.st[0], nx = b.st[1];
        if (nloc == 0u) { xcd_barrier_complete(bar, b.x, nloc, nx); b.st[0] = nloc; b.st[1] = nx; }
        const unsigned old = xb_add(&bar[XB_XSUB(b.x)], 1u);
        const unsigned gen = old / nloc;
        if (old + 1u == (gen + 1u) * nloc) {
            __builtin_amdgcn_fence(__ATOMIC_RELEASE, "agent");
            asm volatile("s_waitcnt vmcnt(0)" ::: "memory");
            const unsigned og = xb_add(&bar[XB_TOP], 1u);
            const unsigned tg = og / nx;
            if (og + 1u == (tg + 1u) * nx) xb_add(&bar[XB_TOPGEN], 1u);
            else XB_SPIN(xb_ld(&bar[XB_TOPGEN]) == tg, bar);
            __builtin_amdgcn_fence(__ATOMIC_ACQUIRE, "agent");
            xb_add(&bar[XB_XGEN(b.x)], 1u);
            asm volatile("s_waitcnt vmcnt(0)" ::: "memory");
        } else {
            XB_SPIN(xb_ld(&bar[XB_XGEN(b.x)]) == gen, bar);
            __builtin_amdgcn_fence(__ATOMIC_ACQUIRE, "agent");
            asm volatile("s_waitcnt vmcnt(0)" ::: "memory");
        }
    }
    __syncthreads();
}


#define GAS __attribute__((address_space(1)))
typedef unsigned short bf16;
typedef unsigned v4u __attribute__((ext_vector_type(4)));
#define LDS_WAIT() asm volatile("s_waitcnt lgkmcnt(0)" ::: "memory")
__device__ __forceinline__ unsigned f2bf(float f) { unsigned u = __builtin_bit_cast(unsigned, f); return (u + 0x7fffu + ((u >> 16) & 1u)) >> 16; }
__device__ __forceinline__ unsigned pk2(float lo, float hi) { return f2bf(lo) | (f2bf(hi) << 16); }
__device__ __forceinline__ float bf2f(unsigned short b) { return __builtin_bit_cast(float, (unsigned)b << 16); }
#include <hip/hip_runtime.h>
namespace pg8 {
#define PG8_LAS __attribute__((address_space(3)))
typedef unsigned short bf16_t;
typedef short bf16x8 __attribute__((ext_vector_type(8)));
typedef float f32x4 __attribute__((ext_vector_type(4)));
typedef unsigned u32x4 __attribute__((ext_vector_type(4)));
constexpr int BM = 256, BK = 64, HALF = 128, HTB = HALF * BK * 2  , STAGE_BYTES = 8 * HTB, NXCD = 8, WGM = 8;

__host__ __device__ __forceinline__ int lds_byte(int r, int c) { const int st = (r >> 4) * 2 + (c >> 5), rr = r & 15, cc = c & 31, ob = rr * 64 + cc * 2; return st * 1024 + (ob ^ (((ob >> 9) & 1) << 5)); }
__host__ __device__ __forceinline__ void stage_rc(int b, int& R, int& C) { const int st = b / 1024, sb = b % 1024, swz = sb ^ (((sb >> 9) & 1) << 5); R = (st >> 1) * 16 + swz / 64; C = (st & 1) * 32 + (swz % 64) / 2; }
__host__ __device__ __forceinline__ int perm32(int rho) { const int n = rho >> 4, i = rho & 15; return 8 * (i >> 2) + 4 * n + (i & 3); }

struct Unit { int pm, pn; };
struct Gemm { const bf16_t* A; const bf16_t* Bt; int M, N, K; };

struct StaticOrder {
    int nM, nN, nwg, G, c;
    __host__ __device__ void init(int M, int N, int G_, int c_) { nM = M / BM; nN = N / BM; nwg = nM * nN; G = G_; c = c_; }
    __host__ __device__ bool next(int i, Unit& u) const {
        const long L = (long)i * G + c; if (L >= nwg) return false;
        int wgid = (int)L; { const int q = nwg / NXCD, r = nwg % NXCD, xcd = wgid % NXCD, off = wgid / NXCD; wgid = (xcd < r ? xcd * (q + 1) : r * (q + 1) + (xcd - r) * q) + off; }
        const int nig = WGM * nN, gid = wgid / nig, fm = gid * WGM, gsz = (nM - fm) < WGM ? (nM - fm) : WGM;
        u.pm = fm + ((wgid % nig) % gsz); u.pn = (wgid % nig) / gsz; return true;
    }
    __device__ __forceinline__ void a_ready(const Unit&) const {}
    __device__ __forceinline__ void done(const Unit&) const {}
};
__device__ __forceinline__ unsigned cvt_pk_bf16(float lo, float hi) { unsigned r; asm volatile("v_cvt_pk_bf16_f32 %0, %1, %2" : "=v"(r) : "v"(lo), "v"(hi)); return r; }
typedef float f32x2 __attribute__((ext_vector_type(2)));
__device__ __forceinline__ f32x2 gelu_pk(f32x2 v) {
    const f32x2 av = __builtin_elementwise_abs(v), d = av * 0.2316418882f + 1.0f;
    f32x2 t; t.x = __builtin_amdgcn_rcpf(d.x); t.y = __builtin_amdgcn_rcpf(d.y);
    f32x2 q = t * 0.5307027145f + (-0.7265760135f); q = q * t + 0.7107068705f; q = q * t + (-0.142248368f); q = q * t + 0.127414796f; q = q * t;
    const f32x2 s = (v * v) * (-0.72134752044f);
    f32x2 e; e.x = __builtin_amdgcn_exp2f(s.x); e.y = __builtin_amdgcn_exp2f(s.y);
    const f32x2 m = v * (q * e), r = v - m;
    f32x2 o; o.x = v.x < 0.f ? m.x : r.x; o.y = v.y < 0.f ? m.y : r.y; return o;
}

struct EpiF32 {
    static constexpr bool PERM = false, AFTER_DRAIN = false;
    float* C; int ldc; const float* bias;
    __device__ __forceinline__ void operator()(const f32x4 (&acc)[2][2][4][2], const Unit& u, int wr, int wc, int fr, int fq) const {
        const int row0 = u.pm * BM + wr * 64 + fr, col0 = u.pn * BM + wc * 32 + 4 * fq;
        f32x4 bv[2][2];
#pragma unroll
        for (int bj = 0; bj < 2; ++bj)
#pragma unroll
            for (int n = 0; n < 2; ++n) bv[bj][n] = bias ? *(const f32x4*)(bias + col0 + bj * HALF + n * 16) : (f32x4){0.f, 0.f, 0.f, 0.f};
#pragma unroll
        for (int ai = 0; ai < 2; ++ai)
#pragma unroll
            for (int m = 0; m < 4; ++m) { float* rowp = C + (size_t)(row0 + ai * HALF + m * 16) * ldc + col0;
#pragma unroll
                for (int bj = 0; bj < 2; ++bj)
#pragma unroll
                    for (int n = 0; n < 2; ++n) *(f32x4*)(rowp + bj * HALF + n * 16) = acc[ai][bj][m][n] + bv[bj][n]; }
    }
};

template <class Epi, class Sched, bool STAMP = false>
__device__ __forceinline__ void gemm_phase(PG8_LAS unsigned char* lds, const Gemm g, const Sched& S, const Epi& E, unsigned long long* stamps) {
    int tid = threadIdx.x; asm volatile("" : "+v"(tid));
    const int wid = __builtin_amdgcn_readfirstlane(tid >> 6), lane = tid & 63, wr = wid >> 2, wc = wid & 3, fr = lane & 15, fq = lane >> 4;
    const int K = g.K, nt = K / BK;
    int ts_lo = 0, ts_hi = 0, nts = 0; const unsigned long long rt_entry = STAMP ? (unsigned long long)wall_clock64() : 0ull;
#define PG8_STAMP() do { if (STAMP && wid == 0 && nts < 64) { const unsigned long long _c = (unsigned long long)clock64(); \
        ts_lo = (lane == nts) ? (int)(unsigned)_c : ts_lo; ts_hi = (lane == nts) ? (int)(unsigned)(_c >> 32) : ts_hi; ++nts; } } while (0)
    PG8_STAMP();
    unsigned voffA[2], voffB[2];
#pragma unroll
    for (int i = 0; i < 2; ++i) { int R, C; stage_rc(tid * 16 + i * 8192, R, C); const int Rb = Epi::PERM ? ((R & ~31) + perm32(R & 31)) : R;
        voffA[i] = (unsigned)(R * K + C) * 2u; voffB[i] = (unsigned)(Rb * K + C) * 2u; }
    const size_t kstep = (size_t)(BK * 2);
    const size_t hstep = (size_t)HALF * K * 2;
    const size_t tstep = 2 * hstep;
    const unsigned ldsw = (unsigned)wid * 1024u;
    const int aoff = lds_byte(wr * 64 + fr, fq * 8), boff = lds_byte(wc * 32 + fr, fq * 8);
#define PG8_SA(b, h) (((b) * 2 + (h)) * HTB)
#define PG8_SB(b, h) ((4 + (b) * 2 + (h)) * HTB)
#define PG8_STAGE(bufoff, gbase, voff) do { _Pragma("unroll") for (int _i = 0; _i < 2; ++_i) \
        __builtin_amdgcn_global_load_lds((const unsigned*)((const char*)(gbase) + (voff)[_i]), (PG8_LAS unsigned*)(lds + (bufoff) + ldsw + _i * 8192), 16, 0, 0); } while (0)
#define PG8_LDA(dst, b, h) do { _Pragma("unroll") for (int m = 0; m < 4; ++m) _Pragma("unroll") for (int k = 0; k < 2; ++k) dst[m][k] = *(const PG8_LAS bf16x8*)(lds + PG8_SA(b, h) + aoff + m * 2048 + k * 1024); } while (0)
#define PG8_LDB(dst, b, h) do { _Pragma("unroll") for (int n = 0; n < 2; ++n) _Pragma("unroll") for (int k = 0; k < 2; ++k) dst[n][k] = *(const PG8_LAS bf16x8*)(lds + PG8_SB(b, h) + boff + n * 2048 + k * 1024); } while (0)
#define PG8_MMA(ai, bj, At, Bt) do { __builtin_amdgcn_s_setprio(1); _Pragma("unroll") for (int m = 0; m < 4; ++m) _Pragma("unroll") for (int n = 0; n < 2; ++n) _Pragma("unroll") for (int k = 0; k < 2; ++k) \
        acc[ai][bj][m][n] = __builtin_amdgcn_mfma_f32_16x16x32_bf16(Bt[n][k], At[m][k], acc[ai][bj][m][n], 0, 0, 0); __builtin_amdgcn_s_setprio(0); } while (0)
#define PG8_WAIT_V(n) asm volatile("s_waitcnt vmcnt(" #n ")" ::: "memory")
#define PG8_WAIT_L(n) asm volatile("s_waitcnt lgkmcnt(" #n ")" ::: "memory")
#define PG8_BAR __builtin_amdgcn_s_barrier()
#define PG8_SCHED __builtin_amdgcn_sched_barrier(0)
    Unit cur, nxt; int ui = 0;
    if (!S.next(0, cur)) return;
    f32x4 acc[2][2][4][2];
#pragma unroll
    for (int a = 0; a < 2; ++a)
#pragma unroll
        for (int b = 0; b < 2; ++b)
#pragma unroll
            for (int m = 0; m < 4; ++m)
#pragma unroll
                for (int n = 0; n < 2; ++n) acc[a][b][m][n] = (f32x4){0.f, 0.f, 0.f, 0.f};
    bf16x8 At[4][2], B0[2][2], B1[2][2];
    const char* cA = (const char*)g.A + (size_t)cur.pm * tstep; const char* cB = (const char*)g.Bt + (size_t)cur.pn * tstep;
    S.a_ready(cur);
    PG8_STAGE(PG8_SB(0, 0), cB, voffB); PG8_STAGE(PG8_SA(0, 0), cA, voffA); PG8_STAGE(PG8_SB(0, 1), cB + hstep, voffB); PG8_STAGE(PG8_SA(0, 1), cA + hstep, voffA);
    if (wr == 1) PG8_BAR;
    PG8_WAIT_V(4); PG8_BAR;
    PG8_STAGE(PG8_SB(1, 0), cB + kstep, voffB); PG8_STAGE(PG8_SA(1, 0), cA + kstep, voffA); PG8_STAGE(PG8_SB(1, 1), cB + hstep + kstep, voffB);
    PG8_WAIT_V(6); PG8_BAR;
    PG8_STAMP();
    for (;;) {
        const bool has_next = S.next(ui + 1, nxt);
        const char* nA = has_next ? (const char*)g.A + (size_t)nxt.pm * tstep : cA; const char* nB = has_next ? (const char*)g.Bt + (size_t)nxt.pn * tstep : cB;
        for (int t = 0; t < nt; t += 2) {
            const bool last = (t == nt - 2);
            const char* a1 = cA + (size_t)(t + 1) * kstep;
            const char* a2 = last ? nA : cA + (size_t)(t + 2) * kstep; const char* b2 = last ? nB : cB + (size_t)(t + 2) * kstep;
            const char* a3 = a2 + kstep; const char* b3 = b2 + kstep;
            if (last && has_next) S.a_ready(nxt);
            PG8_LDB(B0, 0, 0); PG8_SCHED; PG8_LDA(At, 0, 0); PG8_STAGE(PG8_SA(1, 1), a1 + hstep, voffA);
            PG8_WAIT_L(8); PG8_BAR; PG8_WAIT_L(0); PG8_MMA(0, 0, At, B0); PG8_BAR; PG8_SCHED;
            PG8_LDB(B1, 0, 1); PG8_STAGE(PG8_SB(0, 0), b2, voffB);
            PG8_BAR; PG8_WAIT_L(0); PG8_MMA(0, 1, At, B1); PG8_BAR;
            PG8_LDA(At, 0, 1); PG8_STAGE(PG8_SA(0, 0), a2, voffA);
            PG8_BAR; PG8_WAIT_L(0); PG8_MMA(1, 0, At, B0); PG8_BAR; PG8_SCHED;
            PG8_STAGE(PG8_SB(0, 1), b2 + hstep, voffB);
            PG8_WAIT_V(6); PG8_BAR; PG8_MMA(1, 1, At, B1); PG8_BAR;
            PG8_LDB(B0, 1, 0); PG8_SCHED; PG8_LDA(At, 1, 0); PG8_STAGE(PG8_SA(0, 1), a2 + hstep, voffA);
            PG8_WAIT_L(8); PG8_BAR; PG8_WAIT_L(0); PG8_MMA(0, 0, At, B0); PG8_BAR; PG8_SCHED;
            PG8_LDB(B1, 1, 1); PG8_STAGE(PG8_SB(1, 0), b3, voffB);
            PG8_BAR; PG8_WAIT_L(0); PG8_MMA(0, 1, At, B1); PG8_BAR;
            PG8_LDA(At, 1, 1); PG8_STAGE(PG8_SA(1, 0), a3, voffA);
            PG8_BAR; PG8_WAIT_L(0); PG8_MMA(1, 0, At, B0); PG8_BAR; PG8_SCHED;
            PG8_STAGE(PG8_SB(1, 1), b3 + hstep, voffB);
            PG8_WAIT_V(6); PG8_BAR; PG8_MMA(1, 1, At, B1); PG8_BAR;
        }
        PG8_STAMP();
        if constexpr (!Epi::AFTER_DRAIN) { E(acc, cur, wr, wc, fr, fq); S.done(cur); }
        PG8_STAMP();
        if (!has_next) break;
#pragma unroll
        for (int a = 0; a < 2; ++a)
#pragma unroll
            for (int b = 0; b < 2; ++b)
#pragma unroll
                for (int m = 0; m < 4; ++m)
#pragma unroll
                    for (int n = 0; n < 2; ++n) acc[a][b][m][n] = (f32x4){0.f, 0.f, 0.f, 0.f};
        cur = nxt; cA = nA; cB = nB; ++ui;
    }
    PG8_WAIT_V(0);
    if (wr == 0) PG8_BAR;
    PG8_BAR;
    if constexpr (Epi::AFTER_DRAIN) { E.fused(acc, cur, wr, wc, fr, fq, lds, wid, lane); S.done(cur); }
    PG8_STAMP();
    if (STAMP && wid == 0) { stamps[lane] = lane < nts ? (((unsigned long long)(unsigned)ts_hi << 32) | (unsigned)ts_lo) : 0ull;
        if (lane == 62) stamps[62] = rt_entry; if (lane == 63) stamps[63] = (unsigned long long)wall_clock64(); }
#undef PG8_STAMP
#undef PG8_SA
#undef PG8_SB
#undef PG8_STAGE
#undef PG8_LDA
#undef PG8_LDB
#undef PG8_MMA
#undef PG8_WAIT_V
#undef PG8_WAIT_L
#undef PG8_BAR
#undef PG8_SCHED
}
}


namespace pg8 {
struct EpiProj {
    static constexpr bool PERM = true, AFTER_DRAIN = false;
    bf16_t* O; float* dtraw;
    __device__ __forceinline__ void operator()(const f32x4 (&acc)[2][2][4][2], const Unit& u, int wr, int wc, int fr, int fq) const {
        const int row0 = u.pm * BM + wr * 64 + fr;
        if (u.pn < 22) {
            const int col0 = u.pn * BM + wc * 32 + 8 * fq;
#pragma unroll
            for (int ai = 0; ai < 2; ++ai)
#pragma unroll
                for (int m = 0; m < 4; ++m) { bf16_t* rowp = O + (size_t)(row0 + ai * HALF + m * 16) * 5632 + col0;
#pragma unroll
                    for (int bj = 0; bj < 2; ++bj) { const f32x4 v0 = acc[ai][bj][m][0], v1 = acc[ai][bj][m][1];
                        u32x4 w; w.x = cvt_pk_bf16(v0[0], v0[1]); w.y = cvt_pk_bf16(v0[2], v0[3]); w.z = cvt_pk_bf16(v1[0], v1[1]); w.w = cvt_pk_bf16(v1[2], v1[3]);
                        *(u32x4*)(rowp + bj * HALF) = w; } }
        } else if (wc == 0) {
#pragma unroll
            for (int ai = 0; ai < 2; ++ai)
#pragma unroll
                for (int m = 0; m < 4; ++m) { float* rp = dtraw + (size_t)(row0 + ai * HALF + m * 16) * 32 + 8 * fq;
                    *(f32x4*)rp = acc[ai][0][m][0]; *(f32x4*)(rp + 4) = acc[ai][0][m][1]; }
        }
    }
};
}


namespace pg8 {
struct EpiBf16Plain {
    static constexpr bool PERM = true, AFTER_DRAIN = false;
    bf16_t* O; int ldc;
    __device__ __forceinline__ void operator()(const f32x4 (&acc)[2][2][4][2], const Unit& u, int wr, int wc, int fr, int fq) const {
        const int row0 = u.pm * BM + wr * 64 + fr, col0 = u.pn * BM + wc * 32 + 8 * fq;
#pragma unroll
        for (int ai = 0; ai < 2; ++ai)
#pragma unroll
            for (int m = 0; m < 4; ++m) { bf16_t* rowp = O + (size_t)(row0 + ai * HALF + m * 16) * ldc + col0;
#pragma unroll
                for (int bj = 0; bj < 2; ++bj) { const f32x4 v0 = acc[ai][bj][m][0], v1 = acc[ai][bj][m][1];
                    u32x4 w; w.x = cvt_pk_bf16(v0[0], v0[1]); w.y = cvt_pk_bf16(v0[2], v0[3]); w.z = cvt_pk_bf16(v1[0], v1[1]); w.w = cvt_pk_bf16(v1[2], v1[3]);
                    *(u32x4*)(rowp + bj * HALF) = w; } }
    }
};
}

#define NTHR 512
#define NWAVE 8

__device__ __forceinline__ void ph_gemm_f32(float* lds, const float* __restrict__ A, const float* __restrict__ B, float* __restrict__ C,
                                            int M, int N, int K, int lda, int ldb, int ldc) {
    const int tid = threadIdx.x & 255, half = threadIdx.x >> 8, tx = tid & 15, ty = tid >> 4;
    float (*As)[68] = (float (*)[68])(lds + half * 2 * 16 * 68);
    float (*Bs)[68] = (float (*)[68])(lds + half * 2 * 16 * 68 + 16 * 68);
    const int ntx = (N + 63) / 64, nty = M / 64, ntiles = ntx * nty;
    for (int it = blockIdx.x; 2 * it < ntiles; it += gridDim.x) {
        const int tile = 2 * it + half;
        const int m0 = (tile / ntx) * 64, n0 = (tile % ntx) * 64;
        float acc[4][4];
#pragma unroll
        for (int i = 0; i < 4; ++i)
#pragma unroll
            for (int j = 0; j < 4; ++j) acc[i][j] = 0.f;
        for (int k0 = 0; k0 < K; k0 += 16) {
#pragma unroll
            for (int i = 0; i < 4; ++i) {
                int idx = tid + i * 256;
                int r = idx >> 4, c = idx & 15;
                As[c][r] = (m0 + r < M) ? A[(size_t)(m0 + r) * lda + k0 + c] : 0.f;
                int rb = idx >> 6, cb = idx & 63;
                Bs[rb][cb] = (n0 + cb < N) ? B[(size_t)(k0 + rb) * ldb + n0 + cb] : 0.f;
            }
            __syncthreads();
#pragma unroll
            for (int k = 0; k < 16; ++k) {
                float a[4], b[4];
#pragma unroll
                for (int i = 0; i < 4; ++i) { a[i] = As[k][ty * 4 + i]; b[i] = Bs[k][tx * 4 + i]; }
#pragma unroll
                for (int i = 0; i < 4; ++i)
#pragma unroll
                    for (int j = 0; j < 4; ++j) acc[i][j] += a[i] * b[j];
            }
            __syncthreads();
        }
#pragma unroll
        for (int i = 0; i < 4; ++i)
#pragma unroll
            for (int j = 0; j < 4; ++j) {
                int r = m0 + ty * 4 + i, c = n0 + tx * 4 + j;
                if (r < M && c < N) C[(size_t)r * ldc + c] = acc[i][j];
            }
    }
}


template <int MODE>
__device__ __forceinline__ void transpose_item(const float* __restrict__ W, int K, int N, int Npad, bf16* __restrict__ WT, LAS float* scr, int item, int lane) {
    const int nblk = Npad / 32, kb = item / nblk, nb = item % nblk, k0 = 64 * kb, n0 = 32 * nb;
    const int n = n0 + (lane & 31);
    int sc = n;
    if (MODE == 1) sc = (n < 4096) ? n : (n < 5632 ? n + 24 : (n < 5656 ? n - 5632 + 4096 : -1));
    else sc = (n < N) ? n : -1;
#pragma unroll 8
    for (int i = 0; i < 32; ++i) { const int kk = 2 * i + (lane >> 5); scr[kk * 33 + (lane & 31)] = (sc >= 0) ? W[(size_t)(k0 + kk) * N + sc] : 0.f; }
    LDS_WAIT(); asm volatile("" ::: "memory");
    const int c = lane & 7;
#pragma unroll
    for (int j = 0; j < 4; ++j) { const int nn = (lane >> 3) + 8 * j; const LAS float* s = scr + (8 * c) * 33 + nn;
        v4u o; o.x = pk2(s[0 * 33], s[1 * 33]); o.y = pk2(s[2 * 33], s[3 * 33]); o.z = pk2(s[4 * 33], s[5 * 33]); o.w = pk2(s[6 * 33], s[7 * 33]);
        *(v4u*)(WT + (size_t)(n0 + nn) * K + k0 + 8 * c) = o; }
    LDS_WAIT(); asm volatile("" ::: "memory");
}
__device__ __forceinline__ void ph_prologue(LAS unsigned char* ldsb, const float* __restrict__ xp, const float* __restrict__ xs, bf16* __restrict__ A0,
                                            const float* __restrict__ w_in, bf16* __restrict__ wt_in, float* __restrict__ rope_tab) {
    const int lane = threadIdx.x & 63, wave = threadIdx.x >> 6;
    LAS float* scr = (LAS float*)(ldsb + wave * 16384);
    const int gw = blockIdx.x * NWAVE + wave, NGW = gridDim.x * NWAVE;
    constexpr int I_IN = (D_MODEL / 64) * (PROJ_LD / 32);
    for (int it = gw; it < I_IN; it += NGW) transpose_item<1>(w_in, D_MODEL, IN_WIDTH, PROJ_LD, wt_in, scr, it, lane);
    for (int idx = blockIdx.x * NTHR + threadIdx.x; idx < SEQ * 32; idx += gridDim.x * NTHR) {
        const int pos = idx >> 5, j = idx & 31;
        const double rev = (double)pos * ROPE_INV_REV[j];
        const float fr = (float)(rev - floor(rev));
        rope_tab[(size_t)pos * 64 + j] = __builtin_amdgcn_cosf(fr); rope_tab[(size_t)pos * 64 + 32 + j] = __builtin_amdgcn_sinf(fr);
    }
    const size_t n8 = (size_t)T_ALL * D_MODEL / 8, np8 = (size_t)T_PROMPT * D_MODEL / 8;
#pragma unroll 4
    for (size_t i = (size_t)blockIdx.x * NTHR + threadIdx.x; i < n8; i += (size_t)gridDim.x * NTHR) {
        const float4* s = (i < np8) ? (const float4*)xp + 2 * i : (const float4*)xs + 2 * (i - np8);
        float4 a = s[0], b = s[1];
        v4u o; o.x = pk2(a.x, a.y); o.y = pk2(a.z, a.w); o.z = pk2(b.x, b.y); o.w = pk2(b.z, b.w);
        ((v4u*)A0)[i] = o;
    }
}
__device__ __forceinline__ void ph_prologue2(LAS unsigned char* ldsb, const float* __restrict__ w_out, bf16* __restrict__ wt_out, const float* __restrict__ w_q, bf16* __restrict__ wt_q,
                                             int rank, int nranks) {
    const int lane = threadIdx.x & 63, wave = threadIdx.x >> 6;
    LAS float* scr = (LAS float*)(ldsb + wave * 16384);
    constexpr int I_OUT = (MIX_WIDTH / 64) * (D_MODEL / 32), I_Q = (D_MODEL / 64) * (2048 / 32);
    for (int it = rank * NWAVE + wave; it < I_OUT + I_Q; it += nranks * NWAVE) {
        if (it < I_OUT) transpose_item<0>(w_out, MIX_WIDTH, D_MODEL, D_MODEL, wt_out, scr, it, lane);
        else transpose_item<0>(w_q, D_MODEL, 2048, 2048, wt_q, scr, it - I_OUT, lane);
    }
}

__device__ __forceinline__ void ph_concat_x(const float* __restrict__ xp, const float* __restrict__ xs, float* __restrict__ xall) {
    const size_t n4 = (size_t)T_ALL * D_MODEL / 4, np4 = (size_t)T_PROMPT * D_MODEL / 4;
    for (size_t i = (size_t)blockIdx.x * NTHR + threadIdx.x; i < n4; i += (size_t)gridDim.x * NTHR) {
        float4 v = (i < np4) ? ((const float4*)xp)[i] : ((const float4*)xs)[i - np4];
        ((float4*)xall)[i] = v;
    }
}

typedef float f32x4n __attribute__((ext_vector_type(4)));
__device__ __forceinline__ void ph_cache_copy(const float* __restrict__ ck, const float* __restrict__ cv, float* __restrict__ out) {
    constexpr unsigned PER_B = (WBUF - DEC_SEQ) * ATT_WIDTH / 4;
    constexpr unsigned TOTAL = 2u * DEC_BATCH * PER_B;
    for (unsigned c = blockIdx.x; c < TOTAL / 4096u; c += gridDim.x) {
        f32x4n v[8]; size_t dsti[8]; bool isv[8];
#pragma unroll
        for (int j = 0; j < 8; ++j) {
            const unsigned idx = c * 4096u + j * 512u + threadIdx.x;
            const unsigned tb = idx / PER_B, r = idx - tb * PER_B, bb = tb & (DEC_BATCH - 1);
            isv[j] = tb >= DEC_BATCH;
            const size_t srci = (size_t)bb * (WBUF * ATT_WIDTH / 4) + (DEC_SEQ * ATT_WIDTH / 4) + r;
            dsti[j] = (size_t)bb * (WBUF * ATT_WIDTH / 4) + r;
            v[j] = __builtin_nontemporal_load((isv[j] ? (const f32x4n*)cv : (const f32x4n*)ck) + srci);
        }
#pragma unroll
        for (int j = 0; j < 8; ++j) __builtin_nontemporal_store(v[j], (f32x4n*)(out + (isv[j] ? OUT_SV : OUT_SK)) + dsti[j]);
    }
}

__device__ __forceinline__ void ph_post_proj(const float* __restrict__ proj, const float* __restrict__ state_conv,
                                             const float* __restrict__ conv_w, const float* __restrict__ conv_b, const float* __restrict__ dt_bias,
                                             float* __restrict__ xbc_act, float* __restrict__ dtv, float* __restrict__ qrot, float* __restrict__ krot,
                                             float* __restrict__ out) {
    const int tid = threadIdx.x & 255, half = threadIdx.x >> 8;
    for (int t = 2 * blockIdx.x + half; t < T_ALL; t += 2 * gridDim.x) {
        const bool is_p = t < T_PROMPT;
        int b, i, pos;
        if (is_p) { b = t / SEQ; i = t % SEQ; pos = i; } else { int ts = t - T_PROMPT; b = ts / DEC_SEQ; i = ts % DEC_SEQ; pos = PAST_LEN + i; }
        const float* row = proj + (size_t)t * PROJ_LD;
        for (int c = tid; c < CONV_DIM; c += 256) {
            float acc = conv_b[c];
#pragma unroll
            for (int tap = 0; tap < 4; ++tap) {
                int r = i - 3 + tap;
                float val;
                if (r >= 0) val = proj[(size_t)(t - i + r) * PROJ_LD + O_XBC + c];
                else val = is_p ? 0.f : state_conv[((size_t)b * 3 + (3 + r)) * CONV_DIM + c];
                acc += val * conv_w[tap * CONV_DIM + c];
            }
            xbc_act[(size_t)t * CONV_DIM + c] = silu_f(acc);
        }
        if (tid < SSD_HEADS) dtv[(size_t)t * SSD_HEADS + tid] = softplus_f(row[O_DT + tid] + dt_bias[tid]);
        for (int idx = tid; idx < 512; idx += 256) {
            int which = idx >> 8, h = (idx >> 5) & 7, j = idx & 31;
            double rev = (double)pos * ROPE_INV_REV[j];
            float fr = (float)(rev - floor(rev));
            float sn = __builtin_amdgcn_sinf(fr), cs = __builtin_amdgcn_cosf(fr);
            const float* src = row + (which ? O_K : O_Q) + h * 64;
            float t1 = src[j], t2 = src[j + 32];
            float o1 = t1 * cs - t2 * sn, o2 = t2 * cs + t1 * sn;
            float* dst = (which ? krot : qrot) + (size_t)t * ATT_WIDTH + h * 64;
            dst[j] = o1; dst[j + 32] = o2;
            if (which) {
                if (is_p) { if (i >= SEQ - WBUF) { float* o = out + OUT_PK + ((size_t)b * WBUF + (i - (SEQ - WBUF))) * ATT_WIDTH + h * 64; o[j] = o1; o[j + 32] = o2; } }
                else { float* o = out + OUT_SK + ((size_t)b * WBUF + (WBUF - DEC_SEQ + i)) * ATT_WIDTH + h * 64; o[j] = o1; o[j + 32] = o2; }
            }
        }
        for (int c = tid; c < ATT_WIDTH; c += 256) {
            float v = row[O_V + c];
            if (is_p) { if (i >= SEQ - WBUF) out[OUT_PV + ((size_t)b * WBUF + (i - (SEQ - WBUF))) * ATT_WIDTH + c] = v; }
            else out[OUT_SV + ((size_t)b * WBUF + (WBUF - DEC_SEQ + i)) * ATT_WIDTH + c] = v;
        }
        if (is_p) {
            if (i >= SEQ - 3) { int r = i - (SEQ - 3); for (int c = tid; c < CONV_DIM; c += 256) out[OUT_PC + ((size_t)b * 3 + r) * CONV_DIM + c] = row[O_XBC + c]; }
        } else {
            if (i >= 1) { int r = i - 1; for (int c = tid; c < CONV_DIM; c += 256) out[OUT_SC + ((size_t)b * 3 + r) * CONV_DIM + c] = row[O_XBC + c]; }
        }
    }
}


#define NB_LD 5632
#define NB_XBC 1536
#define NB_Q 4096
#define NB_K 4608
#define NB_V 5120
__device__ __forceinline__ void unpack8(const v4u w, float (&f)[8]) {
    f[0] = __builtin_bit_cast(float, w.x << 16); f[1] = __builtin_bit_cast(float, w.x & 0xffff0000u);
    f[2] = __builtin_bit_cast(float, w.y << 16); f[3] = __builtin_bit_cast(float, w.y & 0xffff0000u);
    f[4] = __builtin_bit_cast(float, w.z << 16); f[5] = __builtin_bit_cast(float, w.z & 0xffff0000u);
    f[6] = __builtin_bit_cast(float, w.w << 16); f[7] = __builtin_bit_cast(float, w.w & 0xffff0000u);
}
__device__ __forceinline__ void store8f(float* d, const float (&f)[8]) { *(float4*)d = make_float4(f[0], f[1], f[2], f[3]); *(float4*)(d + 4) = make_float4(f[4], f[5], f[6], f[7]); }
__device__ __forceinline__ void ph_post_proj2(const bf16* __restrict__ projb, const float* __restrict__ dtraw, const float* __restrict__ state_conv,
                                              const float* __restrict__ conv_w, const float* __restrict__ conv_b, const float* __restrict__ dt_bias,
                                              bf16* __restrict__ xbc_b, float* __restrict__ dtv, bf16* __restrict__ qrot_b, bf16* __restrict__ krot_b,
                                              float* __restrict__ out) {
    const int tid = threadIdx.x & 255, half = threadIdx.x >> 8;
    for (int t = T_PROMPT + 2 * blockIdx.x + half; t < T_ALL; t += 2 * gridDim.x) {
        const bool is_p = t < T_PROMPT;
        int b, i, pos;
        if (is_p) { b = t / SEQ; i = t % SEQ; pos = i; } else { int ts = t - T_PROMPT; b = ts / DEC_SEQ; i = ts % DEC_SEQ; pos = PAST_LEN + i; }
        const bf16* row = projb + (size_t)t * NB_LD;
        if (tid < 64) {
            float f[8]; unpack8(*(const v4u*)(row + NB_V + tid * 8), f);
            if (is_p) { if (i >= SEQ - WBUF) store8f(out + OUT_PV + ((size_t)b * WBUF + (i - (SEQ - WBUF))) * ATT_WIDTH + tid * 8, f); }
            else store8f(out + OUT_SV + ((size_t)b * WBUF + (WBUF - DEC_SEQ + i)) * ATT_WIDTH + tid * 8, f);
        }
        for (int c8 = tid; c8 < 320; c8 += 256) {
            const int c = c8 * 8;
            float acc[8], cur[8];
            { const float4 b0 = *(const float4*)(conv_b + c), b1 = *(const float4*)(conv_b + c + 4);
              acc[0] = b0.x; acc[1] = b0.y; acc[2] = b0.z; acc[3] = b0.w; acc[4] = b1.x; acc[5] = b1.y; acc[6] = b1.z; acc[7] = b1.w; }
#pragma unroll
            for (int tap = 0; tap < 4; ++tap) {
                const int r = i - 3 + tap;
                float val[8];
                if (r >= 0) unpack8(*(const v4u*)(projb + (size_t)(t - i + r) * NB_LD + NB_XBC + c), val);
                else if (!is_p) { const float* sp = state_conv + ((size_t)b * 3 + (3 + r)) * CONV_DIM + c; const float4 s0 = *(const float4*)sp, s1 = *(const float4*)(sp + 4);
                    val[0] = s0.x; val[1] = s0.y; val[2] = s0.z; val[3] = s0.w; val[4] = s1.x; val[5] = s1.y; val[6] = s1.z; val[7] = s1.w; }
                else {
#pragma unroll
                    for (int j = 0; j < 8; ++j) val[j] = 0.f; }
                const float4 w0 = *(const float4*)(conv_w + tap * CONV_DIM + c), w1 = *(const float4*)(conv_w + tap * CONV_DIM + c + 4);
                acc[0] += val[0] * w0.x; acc[1] += val[1] * w0.y; acc[2] += val[2] * w0.z; acc[3] += val[3] * w0.w;
                acc[4] += val[4] * w1.x; acc[5] += val[5] * w1.y; acc[6] += val[6] * w1.z; acc[7] += val[7] * w1.w;
                if (tap == 3) {
#pragma unroll
                    for (int j = 0; j < 8; ++j) cur[j] = val[j]; }
            }
#pragma unroll
            for (int j = 0; j < 8; ++j) acc[j] = silu_f(acc[j]);
            v4u o; o.x = pk2(acc[0], acc[1]); o.y = pk2(acc[2], acc[3]); o.z = pk2(acc[4], acc[5]); o.w = pk2(acc[6], acc[7]);
            *(v4u*)(xbc_b + (size_t)t * CONV_DIM + c) = o;
            if (is_p) { if (i >= SEQ - 3) store8f(out + OUT_PC + ((size_t)b * 3 + (i - (SEQ - 3))) * CONV_DIM + c, cur); }
            else { if (i >= 1) store8f(out + OUT_SC + ((size_t)b * 3 + (i - 1)) * CONV_DIM + c, cur); }
        }
        if (tid < SSD_HEADS) dtv[(size_t)t * SSD_HEADS + tid] = softplus_f(dtraw[(size_t)t * 32 + tid] + dt_bias[tid]);
        if (tid < 128) {
            const int which = tid >> 6, h = (tid >> 3) & 7, jc = tid & 7;
            const bf16* src = row + (which ? NB_K : NB_Q) + h * 64 + jc * 4;
            const uint2 lo = *(const uint2*)src, hi = *(const uint2*)(src + 32);
            float t1[4], t2[4], o1[4], o2[4];
            t1[0] = __builtin_bit_cast(float, lo.x << 16); t1[1] = __builtin_bit_cast(float, lo.x & 0xffff0000u); t1[2] = __builtin_bit_cast(float, lo.y << 16); t1[3] = __builtin_bit_cast(float, lo.y & 0xffff0000u);
            t2[0] = __builtin_bit_cast(float, hi.x << 16); t2[1] = __builtin_bit_cast(float, hi.x & 0xffff0000u); t2[2] = __builtin_bit_cast(float, hi.y << 16); t2[3] = __builtin_bit_cast(float, hi.y & 0xffff0000u);
#pragma unroll
            for (int e = 0; e < 4; ++e) {
                const double rev = (double)pos * ROPE_INV_REV[jc * 4 + e];
                const float fr = (float)(rev - floor(rev));
                const float sn = __builtin_amdgcn_sinf(fr), cs = __builtin_amdgcn_cosf(fr);
                o1[e] = t1[e] * cs - t2[e] * sn; o2[e] = t2[e] * cs + t1[e] * sn;
            }
            const size_t doff = (size_t)t * ATT_WIDTH + h * 64 + jc * 4;
            bf16* db = which ? krot_b : qrot_b;
            *(uint2*)(db + doff) = make_uint2(pk2(o1[0], o1[1]), pk2(o1[2], o1[3])); *(uint2*)(db + doff + 32) = make_uint2(pk2(o2[0], o2[1]), pk2(o2[2], o2[3]));
            if (which) {
                float* o = nullptr;
                if (is_p) { if (i >= SEQ - WBUF) o = out + OUT_PK + ((size_t)b * WBUF + (i - (SEQ - WBUF))) * ATT_WIDTH + h * 64 + jc * 4; }
                else o = out + OUT_SK + ((size_t)b * WBUF + (WBUF - DEC_SEQ + i)) * ATT_WIDTH + h * 64 + jc * 4;
                if (o) { *(float4*)o = make_float4(o1[0], o1[1], o1[2], o1[3]); *(float4*)(o + 32) = make_float4(o2[0], o2[1], o2[2], o2[3]); }
            }
        }
    }
}


__device__ __forceinline__ void ph_post_proj_prompt(const bf16* __restrict__ projb, const float* __restrict__ dtraw, const float* __restrict__ conv_w, const float* __restrict__ conv_b,
                                                    const float* __restrict__ dt_bias, const float* __restrict__ rope_tab, bf16* __restrict__ xbc_b, float* __restrict__ dtv,
                                                    bf16* __restrict__ qrot_b, bf16* __restrict__ krot_b, float* __restrict__ out) {
    const int gtid = blockIdx.x * NTHR + threadIdx.x, gsz = gridDim.x * NTHR;
    for (int item = gtid; item < (T_PROMPT / 16) * 320; item += gsz) {
        const int run = item / 320, c = (item - run * 320) * 8, t0 = run * 16, i0 = t0 & (SEQ - 1), b = t0 >> 13;
        float w[4][8], bias[8];
#pragma unroll
        for (int tap = 0; tap < 4; ++tap) { const float4 w0 = *(const float4*)(conv_w + tap * CONV_DIM + c), w1 = *(const float4*)(conv_w + tap * CONV_DIM + c + 4);
            w[tap][0] = w0.x; w[tap][1] = w0.y; w[tap][2] = w0.z; w[tap][3] = w0.w; w[tap][4] = w1.x; w[tap][5] = w1.y; w[tap][6] = w1.z; w[tap][7] = w1.w; }
        { const float4 b0 = *(const float4*)(conv_b + c), b1 = *(const float4*)(conv_b + c + 4);
          bias[0] = b0.x; bias[1] = b0.y; bias[2] = b0.z; bias[3] = b0.w; bias[4] = b1.x; bias[5] = b1.y; bias[6] = b1.z; bias[7] = b1.w; }
        const bf16* src = projb + (size_t)t0 * NB_LD + NB_XBC + c;
        v4u raw[19];
#pragma unroll
        for (int s = 0; s < 19; ++s) { v4u z; z.x = 0u; z.y = 0u; z.z = 0u; z.w = 0u; raw[s] = (s >= 3 || i0 != 0) ? *(const v4u*)(src + (ptrdiff_t)(s - 3) * NB_LD) : z; }
        float p0[8], p1[8], p2[8];
        unpack8(raw[0], p0); unpack8(raw[1], p1); unpack8(raw[2], p2);
#pragma unroll
        for (int s = 0; s < 16; ++s) {
            float cur[8], acc[8]; unpack8(raw[s + 3], cur);
#pragma unroll
            for (int j = 0; j < 8; ++j) acc[j] = silu_f(bias[j] + p0[j] * w[0][j] + p1[j] * w[1][j] + p2[j] * w[2][j] + cur[j] * w[3][j]);
            v4u o; o.x = pk2(acc[0], acc[1]); o.y = pk2(acc[2], acc[3]); o.z = pk2(acc[4], acc[5]); o.w = pk2(acc[6], acc[7]);
            *(v4u*)(xbc_b + (size_t)(t0 + s) * CONV_DIM + c) = o;
            if (i0 + s >= SEQ - 3) store8f(out + OUT_PC + ((size_t)b * 3 + (i0 + s - (SEQ - 3))) * CONV_DIM + c, cur);
#pragma unroll
            for (int j = 0; j < 8; ++j) { p0[j] = p1[j]; p1[j] = p2[j]; p2[j] = cur[j]; }
        }
    }
#pragma unroll 4
    for (int item = gtid; item < T_PROMPT * 128; item += gsz) {
        const int t = item >> 7, sub = item & 127, which = sub >> 6, h = (sub >> 3) & 7, jc = sub & 7, i = t & (SEQ - 1), b = t >> 13;
        const bf16* src = projb + (size_t)t * NB_LD + (which ? NB_K : NB_Q) + h * 64 + jc * 4;
        const uint2 lo = *(const uint2*)src, hi = *(const uint2*)(src + 32);
        const float4 cs = *(const float4*)(rope_tab + (size_t)i * 64 + jc * 4), sn = *(const float4*)(rope_tab + (size_t)i * 64 + 32 + jc * 4);
        float t1[4], t2[4], o1[4], o2[4];
        t1[0] = __builtin_bit_cast(float, lo.x << 16); t1[1] = __builtin_bit_cast(float, lo.x & 0xffff0000u); t1[2] = __builtin_bit_cast(float, lo.y << 16); t1[3] = __builtin_bit_cast(float, lo.y & 0xffff0000u);
        t2[0] = __builtin_bit_cast(float, hi.x << 16); t2[1] = __builtin_bit_cast(float, hi.x & 0xffff0000u); t2[2] = __builtin_bit_cast(float, hi.y << 16); t2[3] = __builtin_bit_cast(float, hi.y & 0xffff0000u);
        const float cv[4] = {cs.x, cs.y, cs.z, cs.w}, sv[4] = {sn.x, sn.y, sn.z, sn.w};
#pragma unroll
        for (int e = 0; e < 4; ++e) { o1[e] = t1[e] * cv[e] - t2[e] * sv[e]; o2[e] = t2[e] * cv[e] + t1[e] * sv[e]; }
        const size_t doff = (size_t)t * ATT_WIDTH + h * 64 + jc * 4;
        bf16* db = which ? krot_b : qrot_b;
        *(uint2*)(db + doff) = make_uint2(pk2(o1[0], o1[1]), pk2(o1[2], o1[3])); *(uint2*)(db + doff + 32) = make_uint2(pk2(o2[0], o2[1]), pk2(o2[2], o2[3]));
        if (which && i >= SEQ - WBUF) {
            float* o = out + OUT_PK + ((size_t)b * WBUF + (i - (SEQ - WBUF))) * ATT_WIDTH + h * 64 + jc * 4;
            *(float4*)o = make_float4(o1[0], o1[1], o1[2], o1[3]); *(float4*)(o + 32) = make_float4(o2[0], o2[1], o2[2], o2[3]);
        }
    }
#pragma unroll 4
    for (int item = gtid; item < T_PROMPT * SSD_HEADS; item += gsz) { const int t = item / SSD_HEADS, hd = item - t * SSD_HEADS; dtv[item] = softplus_f(dtraw[(size_t)t * 32 + hd] + dt_bias[hd]); }
#pragma unroll 2
    for (int item = gtid; item < BATCH * WBUF * 64; item += gsz) {
        const int ch = item & 63, j = (item >> 6) & (WBUF - 1), b = item >> 17;
        float f[8]; unpack8(*(const v4u*)(projb + (size_t)(b * SEQ + (SEQ - WBUF) + j) * NB_LD + NB_V + ch * 8), f);
        store8f(out + OUT_PV + ((size_t)b * WBUF + j) * ATT_WIDTH + ch * 8, f);
    }
}

#define SSD_CH 32
__device__ __forceinline__ void ph_ssd_naive(float* lds, const bf16* __restrict__ xbc_act, const float* __restrict__ dtv, const float* __restrict__ a_log,
                                             const float* __restrict__ d_skip, const float* __restrict__ state_ssm, float* __restrict__ ybuf, float* __restrict__ out) {
    float (*sx)[64] = (float (*)[64])lds;
    float (*sB)[128] = (float (*)[128])(lds + SSD_CH * 64);
    float (*sC)[128] = (float (*)[128])(lds + SSD_CH * 64 + SSD_CH * 128);
    float* sdt = lds + SSD_CH * 64 + 2 * SSD_CH * 128;
    const int tid = threadIdx.x, p = tid >> 3, ng = tid & 7;
    for (int vb = BATCH * SSD_HEADS + blockIdx.x; vb < (BATCH + DEC_BATCH) * SSD_HEADS; vb += gridDim.x) {
        const int seq = vb / SSD_HEADS, h = vb % SSD_HEADS, g = h / 6;
        const bool is_p = seq < BATCH;
        const int L = is_p ? SEQ : DEC_SEQ;
        const int t0 = is_p ? seq * SEQ : T_PROMPT + (seq - BATCH) * DEC_SEQ;
        const float A = -__expf(a_log[h]);
        const float D = d_skip[h];
        float hs[16];
        if (is_p) {
#pragma unroll
            for (int j = 0; j < 16; ++j) hs[j] = 0.f;
        } else {
            const float* s0 = state_ssm + (((size_t)(seq - BATCH) * SSD_HEADS + h) * 64 + p) * 128 + ng * 16;
#pragma unroll
            for (int j = 0; j < 16; ++j) hs[j] = s0[j];
        }
        for (int c0 = 0; c0 < L; c0 += SSD_CH) {
            const int nst = (L - c0) < SSD_CH ? (L - c0) : SSD_CH;
            __syncthreads();
            for (int idx = tid; idx < nst * 64; idx += NTHR) { int s = idx >> 6, c = idx & 63; sx[s][c] = bf2f(xbc_act[(size_t)(t0 + c0 + s) * CONV_DIM + h * 64 + c]); }
            for (int idx = tid; idx < nst * 128; idx += NTHR) { int s = idx >> 7, c = idx & 127;
                sB[s][c] = bf2f(xbc_act[(size_t)(t0 + c0 + s) * CONV_DIM + 1536 + g * 128 + c]);
                sC[s][c] = bf2f(xbc_act[(size_t)(t0 + c0 + s) * CONV_DIM + 2048 + g * 128 + c]); }
            if (tid < nst) sdt[tid] = dtv[(size_t)(t0 + c0 + tid) * SSD_HEADS + h];
            __syncthreads();
            for (int s = 0; s < nst; ++s) {
                const float dt = sdt[s], x = sx[s][p];
                const float a = __expf(dt * A), xdt = x * dt;
                float y = 0.f;
#pragma unroll
                for (int j = 0; j < 16; ++j) { hs[j] = a * hs[j] + xdt * sB[s][ng * 16 + j]; y += sC[s][ng * 16 + j] * hs[j]; }
                y += __shfl_xor(y, 1); y += __shfl_xor(y, 2); y += __shfl_xor(y, 4);
                if (ng == 0) ybuf[(size_t)(t0 + c0 + s) * MIX_WIDTH + h * 64 + p] = y + D * x;
            }
        }
        float* so = is_p ? out + OUT_PS + (((size_t)seq * SSD_HEADS + h) * 64 + p) * 128 + ng * 16
                         : out + OUT_SS + (((size_t)(seq - BATCH) * SSD_HEADS + h) * 64 + p) * 128 + ng * 16;
#pragma unroll
        for (int j = 0; j < 16; ++j) so[j] = hs[j];
    }
}

__device__ __forceinline__ void ph_gate_norm(const bf16* __restrict__ projb, const float* __restrict__ norm_g, const float* __restrict__ ybuf, bf16* __restrict__ A1) {
    const int w = threadIdx.x >> 6, lane = threadIdx.x & 63, g = w & 3;
    for (int t = T_PROMPT + 2 * blockIdx.x + (w >> 2); t < T_ALL; t += 2 * gridDim.x) {
        float v[6]; float ss = 0.f;
#pragma unroll
        for (int j = 0; j < 6; ++j) {
            int c = g * 384 + j * 64 + lane;
            float y = ybuf[(size_t)t * MIX_WIDTH + c], z = bf2f(projb[(size_t)t * NB_LD + c]);
            v[j] = y * silu_f(z); ss += v[j] * v[j];
        }
        ss = wave_sum(ss);
        const float r = rsqrtf(ss * (1.0f / 384.0f) + LN_EPS);
#pragma unroll
        for (int j = 0; j < 6; ++j) { int c = g * 384 + j * 64 + lane; A1[(size_t)t * MIX_WIDTH + c] = (bf16)f2bf(v[j] * r * norm_g[c]); }
    }
}

__device__ __forceinline__ void ph_attn_naive(float* lds, const float* __restrict__ proj, const float* __restrict__ qrot, const float* __restrict__ krot,
                                              const float* __restrict__ ck, const float* __restrict__ cv, float* __restrict__ ybuf) {
    float (*sq)[64] = (float (*)[64])lds;
    const int w = threadIdx.x >> 6, lane = threadIdx.x & 63;
    for (int vb = blockIdx.x; vb < T_SAMPLE * 8 / NWAVE; vb += gridDim.x) {
        const int item = T_PROMPT * 8 + vb * NWAVE + w;
        const int t = item >> 3, h = item & 7;
        const bool is_p = t < T_PROMPT;
        int b, i;
        if (is_p) { b = t / SEQ; i = t % SEQ; } else { int ts = t - T_PROMPT; b = ts / DEC_SEQ; i = ts % DEC_SEQ; }
        __syncthreads();
        sq[w][lane] = qrot[(size_t)t * ATT_WIDTH + h * 64 + lane];
        __syncthreads();
        const int qi = is_p ? i : WBUF + i;
        float sc[3][3];
        float mx = -INFINITY;
#pragma unroll
        for (int pt = 0; pt < 3; ++pt) {
            const int d = pt == 0 ? 1 : (pt == 1 ? 4 : 16);
#pragma unroll
            for (int sl = 0; sl < 3; ++sl) {
                const int m = lane + sl * 64;
                float s = -INFINITY;
                const int kj = qi - d * m;
                if (m <= 128 && kj >= 0) {
                    const float* kr;
                    if (is_p) kr = krot + (size_t)(b * SEQ + kj) * ATT_WIDTH + h * 64;
                    else kr = (kj >= WBUF) ? krot + (size_t)(T_PROMPT + b * DEC_SEQ + (kj - WBUF)) * ATT_WIDTH + h * 64
                                           : ck + ((size_t)b * WBUF + kj) * ATT_WIDTH + h * 64;
                    float a = 0.f;
#pragma unroll
                    for (int c = 0; c < 64; c += 4) { float4 kv = *(const float4*)(kr + c); a += kv.x * sq[w][c] + kv.y * sq[w][c + 1] + kv.z * sq[w][c + 2] + kv.w * sq[w][c + 3]; }
                    s = a * 0.125f;
                }
                sc[pt][sl] = s; mx = fmaxf(mx, s);
            }
        }
        mx = wave_max(mx);
        float lsum = 0.f;
#pragma unroll
        for (int pt = 0; pt < 3; ++pt)
#pragma unroll
            for (int sl = 0; sl < 3; ++sl) { float pv = (sc[pt][sl] == -INFINITY) ? 0.f : __expf(sc[pt][sl] - mx); sc[pt][sl] = pv; lsum += pv; }
        lsum = wave_sum(lsum);
        float o = 0.f;
#pragma unroll
        for (int pt = 0; pt < 3; ++pt) {
            const int d = pt == 0 ? 1 : (pt == 1 ? 4 : 16);
#pragma unroll
            for (int sl = 0; sl < 3; ++sl) {
                const int mend = sl < 2 ? 64 : 1;
                for (int ml = 0; ml < mend; ++ml) {
                    const int m = ml + sl * 64;
                    const int kj = qi - d * m;
                    const float pv = __shfl(sc[pt][sl], ml);
                    if (kj < 0) continue;
                    const float* vr;
                    if (is_p) vr = proj + (size_t)(b * SEQ + kj) * PROJ_LD + O_V + h * 64;
                    else vr = (kj >= WBUF) ? proj + (size_t)(T_PROMPT + b * DEC_SEQ + (kj - WBUF)) * PROJ_LD + O_V + h * 64
                                           : cv + ((size_t)b * WBUF + kj) * ATT_WIDTH + h * 64;
                    o += pv * vr[lane];
                }
            }
        }
        ybuf[(size_t)t * MIX_WIDTH + SSD_WIDTH + h * 64 + lane] = o / lsum;
    }
}

__device__ __forceinline__ int token_of_iter(int k) {
    const int w = __builtin_amdgcn_readfirstlane(threadIdx.x >> 6), wgl = blockIdx.x * NWAVE + w;
    if (gridDim.x != 256) { const int t = wgl + k * (int)(gridDim.x * NWAVE); return t < T_ALL ? t : -1; }
    if (k < 8) return k * 2048 + wgl;
    if (k == 8 && w < 2) return 16384 + w * 256 + (int)blockIdx.x;
    return -1;
}
__device__ __forceinline__ void ph_ln_res(const float* __restrict__ xp, const float* __restrict__ xs, const bf16* __restrict__ add, const float* __restrict__ gam,
                                          const float* __restrict__ bet, bf16* __restrict__ dstb) {
    const int lane = threadIdx.x & 63;
#pragma unroll 2
    for (int k = 0;; ++k) {
        const int t = token_of_iter(k);
        if (t < 0) break;
        const float* res = (t < T_PROMPT) ? xp + (size_t)t * D_MODEL : xs + (size_t)(t - T_PROMPT) * D_MODEL;
        float v[16]; float s = 0.f;
#pragma unroll
        for (int j = 0; j < 2; ++j) { const int c = j * 512 + lane * 8; const float4 r0 = *(const float4*)(res + c), r1 = *(const float4*)(res + c + 4);
            float a8[8]; unpack8(*(const v4u*)(add + (size_t)t * D_MODEL + c), a8);
            v[8 * j] = ALPHA_F * r0.x + a8[0]; v[8 * j + 1] = ALPHA_F * r0.y + a8[1]; v[8 * j + 2] = ALPHA_F * r0.z + a8[2]; v[8 * j + 3] = ALPHA_F * r0.w + a8[3];
            v[8 * j + 4] = ALPHA_F * r1.x + a8[4]; v[8 * j + 5] = ALPHA_F * r1.y + a8[5]; v[8 * j + 6] = ALPHA_F * r1.z + a8[6]; v[8 * j + 7] = ALPHA_F * r1.w + a8[7]; }
#pragma unroll
        for (int j = 0; j < 16; ++j) s += v[j];
        s = wave_sum(s);
        const float mu = s * (1.0f / 1024.0f);
        float q = 0.f;
#pragma unroll
        for (int j = 0; j < 16; ++j) { v[j] -= mu; q += v[j] * v[j]; }
        q = wave_sum(q);
        const float r = rsqrtf(q * (1.0f / 1024.0f) + LN_EPS);
#pragma unroll
        for (int j = 0; j < 2; ++j) { const int c = j * 512 + lane * 8; const float4 g0 = *(const float4*)(gam + c), g1 = *(const float4*)(gam + c + 4), b0 = *(const float4*)(bet + c), b1 = *(const float4*)(bet + c + 4);
            v4u o; o.x = pk2(v[8 * j] * r * g0.x + b0.x, v[8 * j + 1] * r * g0.y + b0.y); o.y = pk2(v[8 * j + 2] * r * g0.z + b0.z, v[8 * j + 3] * r * g0.w + b0.w);
            o.z = pk2(v[8 * j + 4] * r * g1.x + b1.x, v[8 * j + 5] * r * g1.y + b1.y); o.w = pk2(v[8 * j + 6] * r * g1.z + b1.z, v[8 * j + 7] * r * g1.w + b1.w);
            *(v4u*)(dstb + (size_t)t * D_MODEL + c) = o; }
    }
}

__device__ __forceinline__ void ph_peer_route(float* lds, const float* __restrict__ qh, const float* __restrict__ keys1, const float* __restrict__ keys2,
                                              int* __restrict__ eidx, float* __restrict__ gate) {
    float (*sq)[256] = (float (*)[256])lds;
    float (*sv)[2][16] = (float (*)[2][16])(lds + NWAVE * 256);
    int (*si)[2][16] = (int (*)[2][16])(lds + NWAVE * 256 + NWAVE * 32);
    const int w = threadIdx.x >> 6, lane = threadIdx.x & 63;
    for (int vb = blockIdx.x; vb < T_ALL * 8 / NWAVE; vb += gridDim.x) {
        const int item = vb * NWAVE + w;
        const int t = item >> 3, h = item & 7;
        __syncthreads();
        for (int c = lane; c < 256; c += 64) sq[w][c] = qh[(size_t)t * 2048 + h * 256 + c];
        __syncthreads();
#pragma unroll
        for (int half = 0; half < 2; ++half) {
            const float* keys = half ? keys2 : keys1;
            float s[2];
#pragma unroll
            for (int sl = 0; sl < 2; ++sl) {
                const float* kr = keys + (size_t)(lane + sl * 64) * 128;
                float a = 0.f;
#pragma unroll 8
                for (int c = 0; c < 128; c += 4) { float4 kv = *(const float4*)(kr + c); const float* qq = &sq[w][half * 128 + c]; a += kv.x * qq[0] + kv.y * qq[1] + kv.z * qq[2] + kv.w * qq[3]; }
                s[sl] = a;
            }
            for (int r = 0; r < 16; ++r) {
                float bv; int bi;
                if (s[0] >= s[1]) { bv = s[0]; bi = lane; } else { bv = s[1]; bi = lane + 64; }
#pragma unroll
                for (int o = 32; o > 0; o >>= 1) {
                    float ov = __shfl_xor(bv, o); int oi = __shfl_xor(bi, o);
                    if (ov > bv || (ov == bv && oi < bi)) { bv = ov; bi = oi; }
                }
                if (lane == 0) { sv[w][half][r] = bv; si[w][half][r] = bi; }
                if (bi == lane) s[0] = -INFINITY;
                if (bi == lane + 64) s[1] = -INFINITY;
            }
        }
        __syncthreads();
        float c[4];
#pragma unroll
        for (int j = 0; j < 4; ++j) { int ci = lane * 4 + j; c[j] = sv[w][0][ci >> 4] + sv[w][1][ci & 15]; }
        float myv = 0.f; int myc = 0;
        for (int r = 0; r < 16; ++r) {
            float bv = c[0]; int bi = lane * 4;
#pragma unroll
            for (int j = 1; j < 4; ++j) if (c[j] > bv) { bv = c[j]; bi = lane * 4 + j; }
#pragma unroll
            for (int o = 32; o > 0; o >>= 1) {
                float ov = __shfl_xor(bv, o); int oi = __shfl_xor(bi, o);
                if (ov > bv || (ov == bv && oi < bi)) { bv = ov; bi = oi; }
            }
            if (lane == r) { myv = bv; myc = bi; }
#pragma unroll
            for (int j = 0; j < 4; ++j) if (bi == lane * 4 + j) c[j] = -INFINITY;
        }
        float v = lane < 16 ? myv : -INFINITY;
        float mx = wave_max(v);
        float e = lane < 16 ? __expf(v - mx) : 0.f;
        float sum = wave_sum(e);
        if (lane < 16) {
            int ex = si[w][0][myc >> 4] * PEER_NKEYS + si[w][1][myc & 15];
            eidx[(size_t)t * 128 + h * 16 + lane] = ex;
            gate[(size_t)t * 128 + h * 16 + lane] = e / sum;
        }
    }
}

__device__ __forceinline__ void ph_peer_ffn(const float* __restrict__ hbuf, const int* __restrict__ eidx, const float* __restrict__ gate,
                                            const bf16* __restrict__ ub, const bf16* __restrict__ vb, const float* __restrict__ gam,
                                            const float* __restrict__ bet, float* __restrict__ out) {
    const int lane = threadIdx.x & 63;
    for (int t = blockIdx.x * NWAVE + (threadIdx.x >> 6); t < T_ALL; t += gridDim.x * NWAVE) {
        float x[16], acc[16];
        { const float* xr = hbuf + (size_t)t * D_MODEL + lane * 8;
          const float4 a = *(const float4*)xr, b = *(const float4*)(xr + 4), c = *(const float4*)(xr + 512), d = *(const float4*)(xr + 516);
          x[0] = a.x; x[1] = a.y; x[2] = a.z; x[3] = a.w; x[4] = b.x; x[5] = b.y; x[6] = b.z; x[7] = b.w;
          x[8] = c.x; x[9] = c.y; x[10] = c.z; x[11] = c.w; x[12] = d.x; x[13] = d.y; x[14] = d.z; x[15] = d.w; }
#pragma unroll
        for (int j = 0; j < 16; ++j) acc[j] = 0.f;
        for (int k = 0; k < 128; ++k) {
            const int e = eidx[(size_t)t * 128 + k];
            const float g = gate[(size_t)t * 128 + k];
            const bf16* ur = ub + (size_t)e * D_MODEL + lane * 8;
            float u0[8], u1[8];
            unpack8(*(const v4u*)ur, u0); unpack8(*(const v4u*)(ur + 512), u1);
            float d = 0.f;
#pragma unroll
            for (int j = 0; j < 8; ++j) d += u0[j] * x[j] + u1[j] * x[8 + j];
            d = wave_sum(d);
            const float wgt = g * gelu_f(d);
            const bf16* vr = vb + (size_t)e * D_MODEL + lane * 8;
            unpack8(*(const v4u*)vr, u0); unpack8(*(const v4u*)(vr + 512), u1);
#pragma unroll
            for (int j = 0; j < 8; ++j) { acc[j] += wgt * u0[j]; acc[8 + j] += wgt * u1[j]; }
        }
        float s = 0.f;
#pragma unroll
        for (int j = 0; j < 16; ++j) { acc[j] += ALPHA_F * x[j]; s += acc[j]; }
        s = wave_sum(s);
        const float mu = s * (1.0f / 1024.0f);
        float q = 0.f;
#pragma unroll
        for (int j = 0; j < 16; ++j) { acc[j] -= mu; q += acc[j] * acc[j]; }
        q = wave_sum(q);
        const float r = rsqrtf(q * (1.0f / 1024.0f) + LN_EPS);
        float* dst = ((t < T_PROMPT) ? out + OUT_YP + (size_t)t * D_MODEL : out + OUT_YS + (size_t)(t - T_PROMPT) * D_MODEL) + lane * 8;
#pragma unroll
        for (int q4 = 0; q4 < 4; ++q4) {
            const int eo = (q4 >> 1) * 512 + (q4 & 1) * 4;
            const float4 g4 = *(const float4*)(gam + lane * 8 + eo), b4 = *(const float4*)(bet + lane * 8 + eo);
            float4 o; o.x = acc[q4 * 4 + 0] * r * g4.x + b4.x; o.y = acc[q4 * 4 + 1] * r * g4.y + b4.y; o.z = acc[q4 * 4 + 2] * r * g4.z + b4.z; o.w = acc[q4 * 4 + 3] * r * g4.w + b4.w;
            *(float4*)(dst + eo) = o;
        }
    }
}

__device__ __forceinline__ float peer_dot16(const v4u a, const v4u b, const float (&x)[16]) {
    float u0[8], u1[8]; unpack8(a, u0); unpack8(b, u1);
    float d = 0.f;
#pragma unroll
    for (int j = 0; j < 8; ++j) d += u0[j] * x[j] + u1[j] * x[8 + j];
    return d;
}
#define PEER_TR_STEP(N, M) _Pragma("unroll") for (int i = 0; i < N; ++i) { const bool up = (lane & M) != 0; const float keep = up ? part[i + N] : part[i]; const float send = up ? part[i] : part[i + N]; part[i] = keep + __shfl_xor(send, M); }
__device__ __forceinline__ void ph_peer_ffn2(const float* __restrict__ hbuf, const int* __restrict__ eidx, const float* __restrict__ gate,
                                             const bf16* __restrict__ ub, const bf16* __restrict__ vb, const float* __restrict__ gam,
                                             const float* __restrict__ bet, float* __restrict__ out) {
    const int lane0 = threadIdx.x & 63;
    for (int t = blockIdx.x * NWAVE + (threadIdx.x >> 6); t < T_ALL; t += gridDim.x * NWAVE) {
        int lane = lane0; asm volatile("" : "+v"(lane));
        float x[16];
        { const float* xr = hbuf + (size_t)t * D_MODEL + lane * 8;
          const float4 a = *(const float4*)xr, b = *(const float4*)(xr + 4), c = *(const float4*)(xr + 512), d = *(const float4*)(xr + 516);
          x[0] = a.x; x[1] = a.y; x[2] = a.z; x[3] = a.w; x[4] = b.x; x[5] = b.y; x[6] = b.z; x[7] = b.w;
          x[8] = c.x; x[9] = c.y; x[10] = c.z; x[11] = c.w; x[12] = d.x; x[13] = d.y; x[14] = d.z; x[15] = d.w; }
        int ev[2]; float wv[4];
        ev[0] = eidx[(size_t)t * 128 + lane]; ev[1] = eidx[(size_t)t * 128 + 64 + lane];
#pragma unroll
        for (int rd = 0; rd < 4; ++rd) wv[rd] = gate[(size_t)t * 128 + rd * 32 + (lane >> 1)];
#pragma unroll
        for (int rd = 0; rd < 4; ++rd) {
            float part[32];
#pragma unroll
            for (int kb = 0; kb < 8; ++kb) {
                v4u ra[4], rb[4];
#pragma unroll
                for (int k8 = 0; k8 < 4; ++k8) {
                    const int e = __builtin_amdgcn_readlane(ev[rd >> 1], (rd & 1) * 32 + kb * 4 + k8);
                    const bf16* ur = ub + (size_t)e * D_MODEL + lane * 8;
                    ra[k8] = *(const v4u*)ur; rb[k8] = *(const v4u*)(ur + 512);
                }
#pragma unroll
                for (int k8 = 0; k8 < 4; ++k8) part[kb * 4 + k8] = peer_dot16(ra[k8], rb[k8], x);
            }
            PEER_TR_STEP(16, 32) PEER_TR_STEP(8, 16) PEER_TR_STEP(4, 8) PEER_TR_STEP(2, 4) PEER_TR_STEP(1, 2)
            const float hid = part[0] + __shfl_xor(part[0], 1);
            wv[rd] *= gelu_f(hid);
        }
        float acc[16];
#pragma unroll
        for (int j = 0; j < 16; ++j) acc[j] = 0.f;
#pragma unroll
        for (int rd = 0; rd < 4; ++rd) {
#pragma unroll
            for (int kb = 0; kb < 4; ++kb) {
                v4u ra[8], rb[8];
#pragma unroll
                for (int k8 = 0; k8 < 8; ++k8) {
                    const int e = __builtin_amdgcn_readlane(ev[rd >> 1], (rd & 1) * 32 + kb * 8 + k8);
                    const bf16* vr = vb + (size_t)e * D_MODEL + lane * 8;
                    ra[k8] = *(const v4u*)vr; rb[k8] = *(const v4u*)(vr + 512);
                }
#pragma unroll
                for (int k8 = 0; k8 < 8; ++k8) {
                    const float wk = __builtin_bit_cast(float, __builtin_amdgcn_readlane(__builtin_bit_cast(int, wv[rd]), 2 * (kb * 8 + k8)));
                    float u0[8], u1[8]; unpack8(ra[k8], u0); unpack8(rb[k8], u1);
#pragma unroll
                    for (int j = 0; j < 8; ++j) { acc[j] += wk * u0[j]; acc[8 + j] += wk * u1[j]; }
                }
            }
        }
        float s = 0.f;
#pragma unroll
        for (int j = 0; j < 16; ++j) { acc[j] += ALPHA_F * x[j]; s += acc[j]; }
        s = wave_sum(s);
        const float mu = s * (1.0f / 1024.0f);
        float q = 0.f;
#pragma unroll
        for (int j = 0; j < 16; ++j) { acc[j] -= mu; q += acc[j] * acc[j]; }
        q = wave_sum(q);
        const float r = rsqrtf(q * (1.0f / 1024.0f) + LN_EPS);
        float* dst = ((t < T_PROMPT) ? out + OUT_YP + (size_t)t * D_MODEL : out + OUT_YS + (size_t)(t - T_PROMPT) * D_MODEL) + lane * 8;
#pragma unroll
        for (int q4 = 0; q4 < 4; ++q4) {
            const int eo = (q4 >> 1) * 512 + (q4 & 1) * 4;
            const float4 g4 = *(const float4*)(gam + lane * 8 + eo), b4 = *(const float4*)(bet + lane * 8 + eo);
            float4 o; o.x = acc[q4 * 4 + 0] * r * g4.x + b4.x; o.y = acc[q4 * 4 + 1] * r * g4.y + b4.y; o.z = acc[q4 * 4 + 2] * r * g4.z + b4.z; o.w = acc[q4 * 4 + 3] * r * g4.w + b4.w;
            *(float4*)(dst + eo) = o;
        }
    }
}

__device__ __forceinline__ void ph_attn_sample(float* lds, const bf16* __restrict__ qrot_b, const bf16* __restrict__ krot_b, const bf16* __restrict__ projb,
                                               const float* __restrict__ ck, const float* __restrict__ cv, bf16* __restrict__ A1) {
    float (*sq)[64] = (float (*)[64])lds;
    const int w = threadIdx.x >> 6, lane0 = threadIdx.x & 63;
    for (int vb = blockIdx.x; vb < T_SAMPLE * 8 / NWAVE; vb += gridDim.x) {
        int lane = lane0; asm volatile("" : "+v"(lane));
        const int item = vb * NWAVE + w, ts = item >> 3, hd = item & 7, b = ts >> 2, i = ts & 3, t = T_PROMPT + ts;
        __syncthreads();
        sq[w][lane] = bf2f(qrot_b[(size_t)t * ATT_WIDTH + hd * 64 + lane]);
        __syncthreads();
        const int qi = WBUF + i;
        float sc[8];
        float mx = -INFINITY;
#pragma unroll
        for (int slot = 0; slot < 7; ++slot) {
            const int pt = slot < 6 ? (slot >> 1) : (lane < 3 ? lane : 0);
            const int m = slot < 6 ? lane + 64 * (slot & 1) : 128;
            const int kj = qi - (m << (2 * pt));
            const bool valid = (slot < 6 || lane < 3) && kj < WBUF;
            const int kc = kj < WBUF ? kj : WBUF - 1;
            const float* kr = ck + ((size_t)b * WBUF + kc) * ATT_WIDTH + hd * 64;
            float a = 0.f;
#pragma unroll
            for (int c = 0; c < 64; c += 4) { const float4 kv = *(const float4*)(kr + c); a += kv.x * sq[w][c] + kv.y * sq[w][c + 1] + kv.z * sq[w][c + 2] + kv.w * sq[w][c + 3]; }
            const float s = valid ? a * 0.125f : -INFINITY;
            sc[slot] = s; mx = fmaxf(mx, s);
        }
        const int nt7 = lane <= i ? i - lane : i;
        const bool valid7 = lane < i + 3;
        {
            const bf16* kr = krot_b + (size_t)(T_PROMPT + b * DEC_SEQ + nt7) * ATT_WIDTH + hd * 64;
            float a = 0.f;
#pragma unroll
            for (int c = 0; c < 64; c += 8) { float f[8]; unpack8(*(const v4u*)(kr + c), f);
#pragma unroll
                for (int j = 0; j < 8; ++j) a += f[j] * sq[w][c + j]; }
            const float s = valid7 ? a * 0.125f : -INFINITY;
            sc[7] = s; mx = fmaxf(mx, s);
        }
        mx = wave_max(mx);
        float lsum = 0.f;
#pragma unroll
        for (int slot = 0; slot < 8; ++slot) { const float pv = __expf(sc[slot] - mx); sc[slot] = pv; lsum += pv; }
        lsum = wave_sum(lsum);
        float part[64];
#pragma unroll
        for (int c = 0; c < 64; ++c) part[c] = 0.f;
#pragma unroll
        for (int slot = 0; slot < 7; ++slot) {
            const int pt = slot < 6 ? (slot >> 1) : (lane < 3 ? lane : 0);
            const int m = slot < 6 ? lane + 64 * (slot & 1) : 128;
            const int kj = qi - (m << (2 * pt));
            const int kc = kj < WBUF ? kj : WBUF - 1;
            const float pv = sc[slot];
            const float* vr = cv + ((size_t)b * WBUF + kc) * ATT_WIDTH + hd * 64;
#pragma unroll
            for (int c = 0; c < 64; c += 4) { const float4 vv = *(const float4*)(vr + c); part[c] += pv * vv.x; part[c + 1] += pv * vv.y; part[c + 2] += pv * vv.z; part[c + 3] += pv * vv.w; }
        }
        {
            const float pv = sc[7];
            const bf16* vr = projb + (size_t)(T_PROMPT + b * DEC_SEQ + nt7) * NB_LD + NB_V + hd * 64;
#pragma unroll
            for (int c = 0; c < 64; c += 8) { float f[8]; unpack8(*(const v4u*)(vr + c), f);
#pragma unroll
                for (int j = 0; j < 8; ++j) part[c + j] += pv * f[j]; }
        }
        PEER_TR_STEP(32, 32) PEER_TR_STEP(16, 16) PEER_TR_STEP(8, 8) PEER_TR_STEP(4, 4) PEER_TR_STEP(2, 2) PEER_TR_STEP(1, 1)
        A1[(size_t)t * MIX_WIDTH + SSD_WIDTH + hd * 64 + lane] = (bf16)f2bf(part[0] / lsum);
    }
}


__device__ __forceinline__ void cache_copy_slice(const float* __restrict__ ck, const float* __restrict__ cv, float* __restrict__ out, unsigned slice, unsigned lane, unsigned bt0 = 0u, unsigned bt1 = 8u) {
    constexpr unsigned PER_B = (WBUF - DEC_SEQ) * ATT_WIDTH / 4;
    constexpr unsigned TOTAL = 2u * DEC_BATCH * PER_B;
#pragma unroll 1
    for (unsigned bt = bt0; bt < bt1; ++bt) {
        f32x4n v[8]; size_t dsti[8]; bool isv[8]; bool ok[8];
#pragma unroll
        for (int j = 0; j < 8; ++j) {
            const unsigned idx = slice * 4096u + bt * 512u + j * 64u + lane;
            ok[j] = idx < TOTAL;
            const unsigned idc = ok[j] ? idx : 0u;
            const unsigned tb = idc / PER_B, r = idc - tb * PER_B, bb = tb & (DEC_BATCH - 1);
            isv[j] = tb >= DEC_BATCH;
            const size_t srci = (size_t)bb * (WBUF * ATT_WIDTH / 4) + (DEC_SEQ * ATT_WIDTH / 4) + r;
            dsti[j] = (size_t)bb * (WBUF * ATT_WIDTH / 4) + r;
            v[j] = __builtin_nontemporal_load((isv[j] ? (const f32x4n*)cv : (const f32x4n*)ck) + srci);
        }
#pragma unroll
        for (int j = 0; j < 8; ++j) if (ok[j]) __builtin_nontemporal_store(v[j], (f32x4n*)(out + (isv[j] ? OUT_SV : OUT_SK)) + dsti[j]);
    }
}

__device__ __forceinline__ void copy_q_load(const float* __restrict__ ck, const float* __restrict__ cv, unsigned q, unsigned lane, f32x4n (&v)[16]) {
    constexpr unsigned PER_B = (WBUF - DEC_SEQ) * ATT_WIDTH / 4, TOTAL = 2u * DEC_BATCH * PER_B;
#pragma unroll
    for (int j = 0; j < 16; ++j) {
        const unsigned idx = q * 1024u + j * 64u + lane, idc = idx < TOTAL ? idx : 0u;
        const unsigned tb = idc / PER_B, r = idc - tb * PER_B, bb = tb & (DEC_BATCH - 1);
        const size_t srci = (size_t)bb * (WBUF * ATT_WIDTH / 4) + (DEC_SEQ * ATT_WIDTH / 4) + r;
        v[j] = __builtin_nontemporal_load((tb >= DEC_BATCH ? (const f32x4n*)cv : (const f32x4n*)ck) + srci);
    }
}
__device__ __forceinline__ void copy_q_store(float* __restrict__ out, unsigned q, unsigned lane, const f32x4n (&v)[16]) {
    constexpr unsigned PER_B = (WBUF - DEC_SEQ) * ATT_WIDTH / 4, TOTAL = 2u * DEC_BATCH * PER_B;
#pragma unroll
    for (int j = 0; j < 16; ++j) {
        const unsigned idx = q * 1024u + j * 64u + lane;
        if (idx < TOTAL) {
            const unsigned tb = idx / PER_B, r = idx - tb * PER_B, bb = tb & (DEC_BATCH - 1);
            const size_t dsti = (size_t)bb * (WBUF * ATT_WIDTH / 4) + r;
            __builtin_nontemporal_store(v[j], (f32x4n*)(out + (tb >= DEC_BATCH ? OUT_SV : OUT_SK)) + dsti);
        }
    }
}
typedef float f32x2v __attribute__((ext_vector_type(2)));
typedef unsigned u32x6 __attribute__((ext_vector_type(6)));
typedef float f32x32 __attribute__((ext_vector_type(32)));
typedef float f32x16q __attribute__((ext_vector_type(16)));
struct __attribute__((aligned(4))) u3w { unsigned x, y, z; };
#define PEER_ROWB 768
#define QSPLIT 8192
__device__ __forceinline__ void ph_quant_tables(const float* __restrict__ pu, const float* __restrict__ pv, unsigned char* __restrict__ ub8, unsigned char* __restrict__ vb8,
                                                float* __restrict__ usc, float* __restrict__ vsc, int rank, int nranks, int row0 = 0, int row1 = 2 * 16384) {
    const int lane = threadIdx.x & 63;
#pragma unroll 2
    for (int row = row0 + rank * NWAVE + (threadIdx.x >> 6); row < row1; row += nranks * NWAVE) {
        const int rr = row & 16383; const bool isv = row >= 16384;
        const float* src = (isv ? pv : pu) + (size_t)rr * D_MODEL + lane * 8;
        const float4 a = *(const float4*)src, b = *(const float4*)(src + 4), c = *(const float4*)(src + 512), d = *(const float4*)(src + 516);
        float am = fmaxf(fmaxf(fmaxf(fabsf(a.x), fabsf(a.y)), fmaxf(fabsf(a.z), fabsf(a.w))), fmaxf(fmaxf(fabsf(b.x), fabsf(b.y)), fmaxf(fabsf(b.z), fabsf(b.w))));
        am = fmaxf(am, fmaxf(fmaxf(fmaxf(fabsf(c.x), fabsf(c.y)), fmaxf(fabsf(c.z), fabsf(c.w))), fmaxf(fmaxf(fabsf(d.x), fabsf(d.y)), fmaxf(fabsf(d.z), fabsf(d.w)))));
        am = wave_max(am);
        const float sc = am > 0.f ? 7.5f / am : 1.0f;
        f32x16q e0, e1;
#pragma unroll
        for (int i = 0; i < 16; ++i) { e0[i] = 0.f; e1[i] = 0.f; }
        e0[0] = a.x * sc; e1[0] = a.y * sc; e0[1] = a.z * sc; e1[1] = a.w * sc; e0[2] = b.x * sc; e1[2] = b.y * sc; e0[3] = b.z * sc; e1[3] = b.w * sc;
        e0[4] = c.x * sc; e1[4] = c.y * sc; e0[5] = c.z * sc; e1[5] = c.w * sc; e0[6] = d.x * sc; e1[6] = d.y * sc; e0[7] = d.z * sc; e1[7] = d.w * sc;
        const u32x6 qv = __builtin_amdgcn_cvt_scalef32_2xpk16_fp6_f32(e0, e1, 1.0f);
        u3w o; o.x = qv[0]; o.y = qv[1]; o.z = qv[2];
        *(u3w*)((isv ? vb8 : ub8) + (size_t)rr * PEER_ROWB + lane * 12) = o;
        if (lane == 0) (isv ? vsc : usc)[rr] = am > 0.f ? am * (1.0f / 7.5f) : 1.0f;
    }
}
__device__ __forceinline__ void unpack16_fp8(const v4u w, float (&f)[16]) {
#pragma unroll
    for (int i = 0; i < 4; ++i) {
        const f32x2v lo = __builtin_amdgcn_cvt_pk_f32_fp8((int)w[i], false), hi = __builtin_amdgcn_cvt_pk_f32_fp8((int)w[i], true);
        f[4 * i] = lo[0]; f[4 * i + 1] = lo[1]; f[4 * i + 2] = hi[0]; f[4 * i + 3] = hi[1];
    }
}
__device__ __forceinline__ unsigned ffn_slice(unsigned n9, unsigned it) {
    const unsigned w = (unsigned)__builtin_amdgcn_readfirstlane(threadIdx.x >> 6), wgl = blockIdx.x * NWAVE + w;
    if (gridDim.x != 256) return n9 + wgl + it * (gridDim.x * NWAVE);
    unsigned v;
    if (w < 2u) { if (it == 0u) v = 0u; else if (it == 4u) v = 1u; else return 0xffffffffu; }
    else { if ((it & 1u) == 0u && it < 8u) v = it >> 1; else return 0xffffffffu; }
    if (v < 2u) return n9 + v * 2048u + wgl;
    const unsigned lw = blockIdx.x * 6u + (w - 2u);
    return n9 + 4096u + (v - 2u) * 1536u + lw;
}
__device__ __forceinline__ unsigned ffn_half(unsigned n9, unsigned it) {
    const unsigned w = (unsigned)__builtin_amdgcn_readfirstlane(threadIdx.x >> 6);
    if (gridDim.x != 256 || w >= 2u || it != 7u) return 0xffffffffu;
    const unsigned hw = blockIdx.x * 2u + w;
    return ((n9 + 7168u + (hw >> 1)) << 1) | (hw & 1u);
}
__device__ __forceinline__ void ph_peer_ffn3(const bf16* __restrict__ hb, const int* __restrict__ eidx, const float* __restrict__ gate,
                                             const unsigned char* __restrict__ ub8, const unsigned char* __restrict__ vb8, const float* __restrict__ usc, const float* __restrict__ vsc,
                                             const float* __restrict__ gam, const float* __restrict__ bet, float* __restrict__ out,
                                             const float* __restrict__ ck, const float* __restrict__ cv, unsigned n9) {
    const int lane0 = threadIdx.x & 63;
    unsigned it = 0;
    for (;; ++it) {
        const int t = token_of_iter((int)it);
        if (t < 0) break;
        int lane = lane0; asm volatile("" : "+v"(lane));
        { const unsigned sl = ffn_slice(n9, it); if (sl < 16384u) cache_copy_slice(ck, cv, out, sl, (unsigned)lane);
          const unsigned hc = ffn_half(n9, it); if (hc != 0xffffffffu) cache_copy_slice(ck, cv, out, hc >> 1, (unsigned)lane, 4u * (hc & 1u), 4u * (hc & 1u) + 4u); }
        const unsigned lo12 = (unsigned)lane * 12u, lo8 = (unsigned)lane * 8u;
        float x[16];
        { float f0[8], f1[8]; const bf16* xr = hb + (size_t)t * D_MODEL + lo8; unpack8(*(const v4u*)xr, f0); unpack8(*(const v4u*)(xr + 512), f1);
#pragma unroll
          for (int j = 0; j < 8; ++j) { x[j] = f0[j]; x[8 + j] = f1[j]; } }
        int ev[2]; float wv[4], su[4];
        ev[0] = eidx[(size_t)t * 128 + lane]; ev[1] = eidx[(size_t)t * 128 + 64 + lane];
#pragma unroll
        for (int rd = 0; rd < 4; ++rd) {
            const int er = eidx[(size_t)t * 128 + rd * 32 + (lane >> 1)];
            wv[rd] = gate[(size_t)t * 128 + rd * 32 + (lane >> 1)] * vsc[er];
            su[rd] = usc[er];
        }
#pragma unroll
        for (int rd = 0; rd < 4; ++rd) {
            float part[32];
#pragma unroll
            for (int kb = 0; kb < 2; ++kb) {
                u3w ra[16];
#pragma unroll
                for (int k8 = 0; k8 < 16; ++k8) {
                    const int e = __builtin_amdgcn_readlane(ev[rd >> 1], (rd & 1) * 32 + kb * 16 + k8);
                    ra[k8] = *(const u3w*)(ub8 + (size_t)e * PEER_ROWB + lo12);
                }
#pragma unroll
                for (int k8 = 0; k8 < 16; k8 += 2) {
                    u32x6 sv; sv[0] = ra[k8].x; sv[1] = ra[k8].y; sv[2] = ra[k8].z; sv[3] = ra[k8 + 1].x; sv[4] = ra[k8 + 1].y; sv[5] = ra[k8 + 1].z;
                    const f32x32 f = __builtin_amdgcn_cvt_scalef32_pk32_f32_fp6(sv, 1.0f);
                    f32x2v d0 = {0.f, 0.f}, d1 = {0.f, 0.f};
#pragma unroll
                    for (int i = 0; i < 8; ++i) {
                        d0 += (f32x2v){f[2 * i], f[2 * i + 1]} * (f32x2v){x[2 * i], x[2 * i + 1]};
                        d1 += (f32x2v){f[16 + 2 * i], f[17 + 2 * i]} * (f32x2v){x[2 * i], x[2 * i + 1]};
                    }
                    part[kb * 16 + k8] = d0[0] + d0[1]; part[kb * 16 + k8 + 1] = d1[0] + d1[1];
                    __builtin_amdgcn_sched_barrier(0);
                }
            }
            PEER_TR_STEP(16, 32) PEER_TR_STEP(8, 16) PEER_TR_STEP(4, 8) PEER_TR_STEP(2, 4) PEER_TR_STEP(1, 2)
            const float hid = (part[0] + __shfl_xor(part[0], 1)) * su[rd];
            wv[rd] *= gelu_f(hid);
        }
        f32x2v accp[8];
#pragma unroll
        for (int i = 0; i < 8; ++i) accp[i] = (f32x2v){0.f, 0.f};
#pragma unroll
        for (int rd = 0; rd < 4; ++rd) {
#pragma unroll
            for (int kb = 0; kb < 2; ++kb) {
                u3w ra[16];
#pragma unroll
                for (int k8 = 0; k8 < 16; ++k8) {
                    const int e = __builtin_amdgcn_readlane(ev[rd >> 1], (rd & 1) * 32 + kb * 16 + k8);
                    ra[k8] = *(const u3w*)(vb8 + (size_t)e * PEER_ROWB + lo12);
                }
#pragma unroll
                for (int k8 = 0; k8 < 16; k8 += 2) {
                    const float wk0 = __builtin_bit_cast(float, __builtin_amdgcn_readlane(__builtin_bit_cast(int, wv[rd]), 2 * (kb * 16 + k8)));
                    const float wk1 = __builtin_bit_cast(float, __builtin_amdgcn_readlane(__builtin_bit_cast(int, wv[rd]), 2 * (kb * 16 + k8 + 1)));
                    u32x6 sv; sv[0] = ra[k8].x; sv[1] = ra[k8].y; sv[2] = ra[k8].z; sv[3] = ra[k8 + 1].x; sv[4] = ra[k8 + 1].y; sv[5] = ra[k8 + 1].z;
                    const f32x32 f = __builtin_amdgcn_cvt_scalef32_pk32_f32_fp6(sv, 1.0f);
#pragma unroll
                    for (int i = 0; i < 8; ++i) {
                        accp[i] += (f32x2v){wk0, wk0} * (f32x2v){f[2 * i], f[2 * i + 1]};
                        accp[i] += (f32x2v){wk1, wk1} * (f32x2v){f[16 + 2 * i], f[17 + 2 * i]};
                    }
                    __builtin_amdgcn_sched_barrier(0);
                }
            }
        }
        float acc[16];
#pragma unroll
        for (int i = 0; i < 8; ++i) { acc[2 * i] = accp[i][0]; acc[2 * i + 1] = accp[i][1]; }
        float s = 0.f;
#pragma unroll
        for (int j = 0; j < 16; ++j) { acc[j] += ALPHA_F * x[j]; s += acc[j]; }
        s = wave_sum(s);
        const float mu = s * (1.0f / 1024.0f);
        float q = 0.f;
#pragma unroll
        for (int j = 0; j < 16; ++j) { acc[j] -= mu; q += acc[j] * acc[j]; }
        q = wave_sum(q);
        const float r = rsqrtf(q * (1.0f / 1024.0f) + LN_EPS);
        float* dst = ((t < T_PROMPT) ? out + OUT_YP + (size_t)t * D_MODEL : out + OUT_YS + (size_t)(t - T_PROMPT) * D_MODEL) + lo8;
#pragma unroll
        for (int q4 = 0; q4 < 4; ++q4) {
            const int eo = (q4 >> 1) * 512 + (q4 & 1) * 4;
            const float4 g4 = *(const float4*)(gam + lo8 + eo), b4 = *(const float4*)(bet + lo8 + eo);
            float4 o; o.x = acc[q4 * 4 + 0] * r * g4.x + b4.x; o.y = acc[q4 * 4 + 1] * r * g4.y + b4.y; o.z = acc[q4 * 4 + 2] * r * g4.z + b4.z; o.w = acc[q4 * 4 + 3] * r * g4.w + b4.w;
            *(float4*)(dst + eo) = o;
        }
    }
    for (;; ++it) {
        if (gridDim.x == 256 && it >= 5u) break;
        const unsigned sl = ffn_slice(n9, it);
        if (gridDim.x != 256 && sl >= 16384u) break;
        if (sl < 16384u) cache_copy_slice(ck, cv, out, sl, (unsigned)lane0);
    }
}


__device__ __forceinline__ void ssd_decode_load(const bf16* __restrict__ xbc_b, const float* __restrict__ dtv, const float* __restrict__ state_ssm, int item, int p, int ng,
                                                float (&hs)[16], v4u (&bq)[4][2], v4u (&cq)[4][2], float (&xv)[4], float (&dv)[4]) {
    const int sb = item / SSD_HEADS, h = item - sb * SSD_HEADS, g = h / 6, t0 = T_PROMPT + sb * DEC_SEQ;
    const float* s0 = state_ssm + (((size_t)sb * SSD_HEADS + h) * 64 + p) * 128 + ng * 16;
#pragma unroll
    for (int j = 0; j < 4; ++j) { const float4 v = *(const float4*)(s0 + 4 * j); hs[4 * j] = v.x; hs[4 * j + 1] = v.y; hs[4 * j + 2] = v.z; hs[4 * j + 3] = v.w; }
#pragma unroll
    for (int s = 0; s < 4; ++s) {
        const bf16* row = xbc_b + (size_t)(t0 + s) * CONV_DIM;
        bq[s][0] = *(const v4u*)(row + 1536 + g * 128 + ng * 16); bq[s][1] = *(const v4u*)(row + 1536 + g * 128 + ng * 16 + 8);
        cq[s][0] = *(const v4u*)(row + 2048 + g * 128 + ng * 16); cq[s][1] = *(const v4u*)(row + 2048 + g * 128 + ng * 16 + 8);
        xv[s] = bf2f(row[h * 64 + p]); dv[s] = dtv[(size_t)(t0 + s) * SSD_HEADS + h];
    }
}
__device__ __forceinline__ void ssd_decode_compute(const float* __restrict__ a_log, const float* __restrict__ d_skip, int item, int p, int ng,
                                                   float (&hs)[16], const v4u (&bq)[4][2], const v4u (&cq)[4][2], const float (&xv)[4], const float (&dv)[4],
                                                   float* __restrict__ ybuf, float* __restrict__ out) {
    const int sb = item / SSD_HEADS, h = item - sb * SSD_HEADS, t0 = T_PROMPT + sb * DEC_SEQ;
    const float A = -__expf(a_log[h]), D = d_skip[h];
#pragma unroll
    for (int s = 0; s < 4; ++s) {
        float Bf[16], Cf[16];
        { float t8[8]; unpack8(bq[s][0], t8);
#pragma unroll
          for (int j = 0; j < 8; ++j) Bf[j] = t8[j];
          unpack8(bq[s][1], t8);
#pragma unroll
          for (int j = 0; j < 8; ++j) Bf[8 + j] = t8[j];
          unpack8(cq[s][0], t8);
#pragma unroll
          for (int j = 0; j < 8; ++j) Cf[j] = t8[j];
          unpack8(cq[s][1], t8);
#pragma unroll
          for (int j = 0; j < 8; ++j) Cf[8 + j] = t8[j]; }
        const float a = __expf(dv[s] * A), xdt = xv[s] * dv[s];
        float y = 0.f;
#pragma unroll
        for (int j = 0; j < 16; ++j) { hs[j] = a * hs[j] + xdt * Bf[j]; y += Cf[j] * hs[j]; }
        y += __shfl_xor(y, 1); y += __shfl_xor(y, 2); y += __shfl_xor(y, 4);
        if (ng == 0) ybuf[(size_t)(t0 + s) * MIX_WIDTH + h * 64 + p] = y + D * xv[s];
    }
    float* so = out + OUT_SS + (((size_t)sb * SSD_HEADS + h) * 64 + p) * 128 + ng * 16;
#pragma unroll
    for (int j = 0; j < 4; ++j) *(float4*)(so + 4 * j) = make_float4(hs[4 * j], hs[4 * j + 1], hs[4 * j + 2], hs[4 * j + 3]);
}
__device__ __forceinline__ void ph_ssd_decode(const bf16* __restrict__ xbc_b, const float* __restrict__ dtv, const float* __restrict__ a_log, const float* __restrict__ d_skip,
                                              const float* __restrict__ state_ssm, float* __restrict__ ybuf, float* __restrict__ out) {
    const int tid = threadIdx.x, p = tid >> 3, ng = tid & 7;
    constexpr int NITEM = DEC_BATCH * SSD_HEADS;
    for (int it = blockIdx.x; it < NITEM; it += 2 * gridDim.x) {
        const int it2 = it + gridDim.x; const bool has2 = it2 < NITEM; const int it2c = has2 ? it2 : it;
        float hsA[16], hsB[16], xA[4], xB[4], dA[4], dB[4]; v4u bA[4][2], cA[4][2], bB[4][2], cB[4][2];
        ssd_decode_load(xbc_b, dtv, state_ssm, it, p, ng, hsA, bA, cA, xA, dA);
        ssd_decode_load(xbc_b, dtv, state_ssm, it2c, p, ng, hsB, bB, cB, xB, dB);
        ssd_decode_compute(a_log, d_skip, it, p, ng, hsA, bA, cA, xA, dA, ybuf, out);
        if (has2) ssd_decode_compute(a_log, d_skip, it2, p, ng, hsB, bB, cB, xB, dB, ybuf, out);
    }
}

__device__ __forceinline__ float samp_cw(int d) { return (float)((int)(d >= 0 && d <= 128) + (int)(d >= 0 && (d & 3) == 0 && d <= 512) + (int)(d >= 0 && (d & 15) == 0 && d <= 2048)); }
__device__ __forceinline__ void samp_update(float sv, float cw, const float (&vrow)[64], float& m, float& l, float (&part)[64]) {
    const float mn = fmaxf(m, sv), alpha = __expf(m - mn), p = cw * __expf(sv - mn);
    m = mn; l = l * alpha + p;
#pragma unroll
    for (int c = 0; c < 64; ++c) part[c] = part[c] * alpha + p * vrow[c];
}
__device__ __forceinline__ void ph_attn_sample3(float* lds, const bf16* __restrict__ qrot_b, const bf16* __restrict__ krot_b, const bf16* __restrict__ projb,
                                                const float* __restrict__ ck, const float* __restrict__ cv, bf16* __restrict__ A1) {
    const int lane0 = threadIdx.x & 63, w = __builtin_amdgcn_readfirstlane(threadIdx.x >> 6);
    float* sq = lds + w * 256;
    for (int item = blockIdx.x + gridDim.x * w; item < DEC_BATCH * ATT_HEADS; item += gridDim.x * NWAVE) {
        int lane = lane0; asm volatile("" : "+v"(lane));
        const int b = item >> 3, hd = item & 7, qi = lane & 3, g = lane >> 2;
        const int tq0 = T_PROMPT + b * DEC_SEQ;
#pragma unroll
        for (int i = 0; i < 4; ++i) sq[i * 64 + lane] = bf2f(qrot_b[(size_t)(tq0 + i) * ATT_WIDTH + hd * 64 + lane]);
        asm volatile("s_waitcnt lgkmcnt(0)" ::: "memory");
        const float* qv = sq + qi * 64;
        const float* ckb = ck + (size_t)b * WBUF * ATT_WIDTH + hd * 64; const float* cvb = cv + (size_t)b * WBUF * ATT_WIDTH + hd * 64;
        float m = -1e30f, l = 0.f, part[64];
#pragma unroll
        for (int c = 0; c < 64; ++c) part[c] = 0.f;
        {
            const int P = 2051 - g;
            const float cw = samp_cw(WBUF + qi - P);
            const bool isn = P >= WBUF;
            const int nt = isn ? P - WBUF : 0, Pc = isn ? WBUF - 1 : P;
            const bf16* kn = krot_b + (size_t)(tq0 + nt) * ATT_WIDTH + hd * 64; const float* kr = ckb + (size_t)Pc * ATT_WIDTH;
            float a = 0.f;
#pragma unroll
            for (int c = 0; c < 64; c += 8) { float f[8]; unpack8(*(const v4u*)(kn + c), f); const float4 k0 = *(const float4*)(kr + c), k1 = *(const float4*)(kr + c + 4);
                a += (isn ? f[0] : k0.x) * qv[c] + (isn ? f[1] : k0.y) * qv[c + 1] + (isn ? f[2] : k0.z) * qv[c + 2] + (isn ? f[3] : k0.w) * qv[c + 3]
                   + (isn ? f[4] : k1.x) * qv[c + 4] + (isn ? f[5] : k1.y) * qv[c + 5] + (isn ? f[6] : k1.z) * qv[c + 6] + (isn ? f[7] : k1.w) * qv[c + 7]; }
            const float sv = cw > 0.f ? a * 0.125f : -1e30f;
            const bf16* vn = projb + (size_t)(tq0 + nt) * NB_LD + NB_V + hd * 64; const float* vr = cvb + (size_t)Pc * ATT_WIDTH;
            float vrow[64];
#pragma unroll
            for (int c = 0; c < 64; c += 8) { float f[8]; unpack8(*(const v4u*)(vn + c), f); const float4 v0 = *(const float4*)(vr + c), v1 = *(const float4*)(vr + c + 4);
                vrow[c] = isn ? f[0] : v0.x; vrow[c + 1] = isn ? f[1] : v0.y; vrow[c + 2] = isn ? f[2] : v0.z; vrow[c + 3] = isn ? f[3] : v0.w;
                vrow[c + 4] = isn ? f[4] : v1.x; vrow[c + 5] = isn ? f[5] : v1.y; vrow[c + 6] = isn ? f[6] : v1.z; vrow[c + 7] = isn ? f[7] : v1.w; }
            samp_update(sv, cw, vrow, m, l, part);
        }
#pragma unroll 1
        for (int s = 1; s < 21; ++s) {
            const int P = s < 9 ? 2051 - (16 * s + g) : (s < 15 ? 1536 + 64 * (s - 9) + lane : qi + 16 * (16 * (s - 15) + g));
            const float cw = (s < 9 && P < 1920) ? 0.f : samp_cw(WBUF + qi - P);
            const float* kr = ckb + (size_t)P * ATT_WIDTH;
            float a = 0.f;
#pragma unroll
            for (int c = 0; c < 64; c += 4) { const float4 kv = *(const float4*)(kr + c); a += kv.x * qv[c] + kv.y * qv[c + 1] + kv.z * qv[c + 2] + kv.w * qv[c + 3]; }
            const float sv = cw > 0.f ? a * 0.125f : -1e30f;
            __builtin_amdgcn_sched_barrier(0);
            const float* vr = cvb + (size_t)P * ATT_WIDTH;
            float vrow[64];
#pragma unroll
            for (int c = 0; c < 64; c += 4) { const float4 vv = *(const float4*)(vr + c); vrow[c] = vv.x; vrow[c + 1] = vv.y; vrow[c + 2] = vv.z; vrow[c + 3] = vv.w; }
            samp_update(sv, cw, vrow, m, l, part);
        }
        float M = m;
        M = fmaxf(M, __shfl_xor(M, 4)); M = fmaxf(M, __shfl_xor(M, 8)); M = fmaxf(M, __shfl_xor(M, 16)); M = fmaxf(M, __shfl_xor(M, 32));
        const float sc = __expf(m - M);
        float lsum = l * sc;
        lsum += __shfl_xor(lsum, 4); lsum += __shfl_xor(lsum, 8); lsum += __shfl_xor(lsum, 16); lsum += __shfl_xor(lsum, 32);
#pragma unroll
        for (int c = 0; c < 64; ++c) part[c] *= sc;
        PEER_TR_STEP(32, 32) PEER_TR_STEP(16, 16) PEER_TR_STEP(8, 8) PEER_TR_STEP(4, 4)
        const float inv = 1.0f / lsum;
        *(uint2*)(A1 + (size_t)(tq0 + qi) * MIX_WIDTH + SSD_WIDTH + hd * 64 + 4 * g) = make_uint2(pk2(part[0] * inv, part[1] * inv), pk2(part[2] * inv, part[3] * inv));
    }
}

typedef float f32x16 __attribute__((ext_vector_type(16)));
typedef short s16x8 __attribute__((ext_vector_type(8)));
typedef short s16x4 __attribute__((ext_vector_type(4)));
typedef float f32x4v __attribute__((ext_vector_type(4)));
#define SSD_L_ACS 0
#define SSD_L_DTS 3072
#define SSD_L_BM 6144
#define SSD_RS_B 272
#define SSD_L_X (6144 + 128 * 272)
#define SSD_RS_X 144
#define SSD_XIMG (128 * 144)
#define SSD_RS_Y 784
template <int OFF0, int OFF1>
__device__ __forceinline__ s16x8 tr_frag(unsigned base) {
    s16x4 a, b;
    asm volatile("ds_read_b64_tr_b16 %0, %2 offset:%3\n\tds_read_b64_tr_b16 %1, %2 offset:%4\n\ts_waitcnt lgkmcnt(0)"
                 : "=&v"(a), "=&v"(b) : "v"(base), "n"(OFF0), "n"(OFF1) : "memory");
    return __builtin_shufflevector(a, b, 0, 1, 2, 3, 4, 5, 6, 7);
}
__device__ __forceinline__ unsigned lds_addr(LAS unsigned char* p) { return (unsigned)(size_t)p; }
template <int O0, int O1, int O2, int O3, int O4, int O5, int O6, int O7>
__device__ __forceinline__ void tr_read8(unsigned base, s16x4 (&v)[8]) {
    asm volatile("ds_read_b64_tr_b16 %0, %8 offset:%9\n\tds_read_b64_tr_b16 %1, %8 offset:%10\n\tds_read_b64_tr_b16 %2, %8 offset:%11\n\tds_read_b64_tr_b16 %3, %8 offset:%12\n\t"
                 "ds_read_b64_tr_b16 %4, %8 offset:%13\n\tds_read_b64_tr_b16 %5, %8 offset:%14\n\tds_read_b64_tr_b16 %6, %8 offset:%15\n\tds_read_b64_tr_b16 %7, %8 offset:%16\n\ts_waitcnt lgkmcnt(0)"
                 : "=&v"(v[0]), "=&v"(v[1]), "=&v"(v[2]), "=&v"(v[3]), "=&v"(v[4]), "=&v"(v[5]), "=&v"(v[6]), "=&v"(v[7])
                 : "v"(base), "n"(O0), "n"(O1), "n"(O2), "n"(O3), "n"(O4), "n"(O5), "n"(O6), "n"(O7) : "memory");
}
#define TRCAT(a, b) __builtin_shufflevector(a, b, 0, 1, 2, 3, 4, 5, 6, 7)


__device__ __forceinline__ void ssd_chunk_acs(LAS unsigned char* ldsb, const float* __restrict__ dtv, const float* __restrict__ a_log, int t0, int g, float* cdec_out) {
    const int w = __builtin_amdgcn_readfirstlane(threadIdx.x >> 6), lane = threadIdx.x & 63;
    if (w < 6) {
        const int head = 6 * g + w;
        const float A = -__expf(a_log[head]);
        const float v0 = dtv[(size_t)(t0 + 2 * lane) * SSD_HEADS + head], v1 = dtv[(size_t)(t0 + 2 * lane + 1) * SSD_HEADS + head];
        const float a1 = v1 * A;
        float s = v0 * A + a1;
#pragma unroll
        for (int o = 1; o < 64; o <<= 1) { const float tmp = __shfl_up(s, o); if (lane >= o) s += tmp; }
        LAS float* acs = (LAS float*)(ldsb + SSD_L_ACS) + w * 128;
        LAS float* dts = (LAS float*)(ldsb + SSD_L_DTS) + w * 128;
        acs[2 * lane] = s - a1; acs[2 * lane + 1] = s;
        dts[2 * lane] = v0; dts[2 * lane + 1] = v1;
        if (cdec_out && lane == 63) cdec_out[head] = __expf(s);
    }
}

__device__ __forceinline__ void ph_ssd_states(LAS unsigned char* ldsb, const bf16* __restrict__ xbc_b, const float* __restrict__ dtv, const float* __restrict__ a_log,
                                              bf16* __restrict__ Sbuf, float* __restrict__ cdec, const float* __restrict__ ck, const float* __restrict__ cv, float* __restrict__ out) {
    const int tid = threadIdx.x, w = __builtin_amdgcn_readfirstlane(tid >> 6), lane = tid & 63;
    const int r = lane & 31, h = lane >> 5, blk = (lane >> 4) & 1, q = (lane & 15) >> 2, pp = lane & 3;
    const int nt = w & 3, pt = w >> 2;
    for (int unit = blockIdx.x; unit < BATCH * 64 * SSD_GROUPS; unit += gridDim.x) {
        const int g = unit & 3, bc = unit >> 2;
        const int t0 = bc * 128;
        __syncthreads();
        ssd_chunk_acs(ldsb, dtv, a_log, t0, g, cdec + (size_t)bc * SSD_HEADS);
#pragma unroll
        for (int it_ = 0; it_ < 4; ++it_) { const int idx = tid + it_ * NTHR; const int row = idx >> 4, ch = idx & 15;
            const v4u v = *(const v4u*)(xbc_b + (size_t)(t0 + row) * CONV_DIM + 1536 + 128 * g + ch * 8);
            *(LAS v4u*)(ldsb + SSD_L_BM + row * SSD_RS_B + ch * 16) = v; }
        __syncthreads();
#pragma unroll
        for (int it_ = 0; it_ < 12; ++it_) { const int idx = tid + it_ * NTHR; const int hh = idx >> 10, rem = idx & 1023, row = rem >> 3, ch = rem & 7;
            const LAS float* acs = (const LAS float*)(ldsb + SSD_L_ACS) + hh * 128; const LAS float* dts = (const LAS float*)(ldsb + SSD_L_DTS) + hh * 128;
            const float wgt = dts[row] * __expf(acs[127] - acs[row]);
            float f[8]; unpack8(*(const v4u*)(xbc_b + (size_t)(t0 + row) * CONV_DIM + (6 * g + hh) * 64 + ch * 8), f);
            v4u o; o.x = pk2(f[0] * wgt, f[1] * wgt); o.y = pk2(f[2] * wgt, f[3] * wgt); o.z = pk2(f[4] * wgt, f[5] * wgt); o.w = pk2(f[6] * wgt, f[7] * wgt);
            *(LAS v4u*)(ldsb + SSD_L_X + hh * SSD_XIMG + row * SSD_RS_X + ch * 16) = o; }
        __syncthreads();
        f32x4n rider[16];
        copy_q_load(ck, cv, 12288u + (unsigned)(unit * NWAVE + w), (unsigned)lane, rider);
        const unsigned abase = lds_addr(ldsb + SSD_L_BM) + (8 * h + q) * SSD_RS_B + (32 * nt + 16 * blk + 4 * pp) * 2;
        s16x8 afr[8];
        { s16x4 av[8];
          tr_read8<0 * SSD_RS_B, 4 * SSD_RS_B, 16 * SSD_RS_B, 20 * SSD_RS_B, 32 * SSD_RS_B, 36 * SSD_RS_B, 48 * SSD_RS_B, 52 * SSD_RS_B>(abase, av);
          afr[0] = TRCAT(av[0], av[1]); afr[1] = TRCAT(av[2], av[3]); afr[2] = TRCAT(av[4], av[5]); afr[3] = TRCAT(av[6], av[7]);
          tr_read8<64 * SSD_RS_B, 68 * SSD_RS_B, 80 * SSD_RS_B, 84 * SSD_RS_B, 96 * SSD_RS_B, 100 * SSD_RS_B, 112 * SSD_RS_B, 116 * SSD_RS_B>(abase, av);
          afr[4] = TRCAT(av[0], av[1]); afr[5] = TRCAT(av[2], av[3]); afr[6] = TRCAT(av[4], av[5]); afr[7] = TRCAT(av[6], av[7]); }
#pragma unroll
        for (int hh = 0; hh < 6; ++hh) {
            const unsigned xb = lds_addr(ldsb + SSD_L_X + hh * SSD_XIMG) + (8 * h + q) * SSD_RS_X + (32 * pt + 16 * blk + 4 * pp) * 2;
            f32x16 acc;
#pragma unroll
            for (int i = 0; i < 16; ++i) acc[i] = 0.f;
            { s16x4 xv[8];
              tr_read8<0 * SSD_RS_X, 4 * SSD_RS_X, 16 * SSD_RS_X, 20 * SSD_RS_X, 32 * SSD_RS_X, 36 * SSD_RS_X, 48 * SSD_RS_X, 52 * SSD_RS_X>(xb, xv);
              acc = __builtin_amdgcn_mfma_f32_32x32x16_bf16(afr[0], TRCAT(xv[0], xv[1]), acc, 0, 0, 0);
              acc = __builtin_amdgcn_mfma_f32_32x32x16_bf16(afr[1], TRCAT(xv[2], xv[3]), acc, 0, 0, 0);
              acc = __builtin_amdgcn_mfma_f32_32x32x16_bf16(afr[2], TRCAT(xv[4], xv[5]), acc, 0, 0, 0);
              acc = __builtin_amdgcn_mfma_f32_32x32x16_bf16(afr[3], TRCAT(xv[6], xv[7]), acc, 0, 0, 0);
              tr_read8<64 * SSD_RS_X, 68 * SSD_RS_X, 80 * SSD_RS_X, 84 * SSD_RS_X, 96 * SSD_RS_X, 100 * SSD_RS_X, 112 * SSD_RS_X, 116 * SSD_RS_X>(xb, xv);
              acc = __builtin_amdgcn_mfma_f32_32x32x16_bf16(afr[4], TRCAT(xv[0], xv[1]), acc, 0, 0, 0);
              acc = __builtin_amdgcn_mfma_f32_32x32x16_bf16(afr[5], TRCAT(xv[2], xv[3]), acc, 0, 0, 0);
              acc = __builtin_amdgcn_mfma_f32_32x32x16_bf16(afr[6], TRCAT(xv[4], xv[5]), acc, 0, 0, 0);
              acc = __builtin_amdgcn_mfma_f32_32x32x16_bf16(afr[7], TRCAT(xv[6], xv[7]), acc, 0, 0, 0); }
            bf16* dst = Sbuf + ((size_t)bc * SSD_HEADS + 6 * g + hh) * 8192 + (size_t)(pt * 8 + 2 * nt) * 512 + r * 8 + 4 * h;
#pragma unroll
            for (int q4 = 0; q4 < 4; ++q4) *(uint2*)(dst + (q4 >> 1) * 512 + (q4 & 1) * 256) = make_uint2(pk2(acc[4 * q4], acc[4 * q4 + 1]), pk2(acc[4 * q4 + 2], acc[4 * q4 + 3]));
        }
        copy_q_store(out, 12288u + (unsigned)(unit * NWAVE + w), (unsigned)lane, rider);
    }
}

__device__ __forceinline__ void ph_ssd_scan(const bf16* __restrict__ Sbuf, const float* __restrict__ cdec, bf16* __restrict__ Hin, float* __restrict__ out, int rank, int nranks) {
    for (int idx = rank * NTHR + threadIdx.x; idx < BATCH * SSD_HEADS * 1024; idx += nranks * NTHR) {
        const int i = idx & 1023, hb = idx >> 10, hd = hb % SSD_HEADS, b = hb / SSD_HEADS;
        float st[8];
#pragma unroll
        for (int j = 0; j < 8; ++j) st[j] = 0.f;
#pragma unroll 8
        for (int c = 0; c < 64; ++c) {
            const size_t base = (((size_t)(b * 64 + c)) * SSD_HEADS + hd) * 8192 + (size_t)i * 8;
            v4u o; o.x = pk2(st[0], st[1]); o.y = pk2(st[2], st[3]); o.z = pk2(st[4], st[5]); o.w = pk2(st[6], st[7]);
            *(v4u*)(Hin + base) = o;
            float s[8]; unpack8(*(const v4u*)(Sbuf + base), s);
            const float a = cdec[(size_t)(b * 64 + c) * SSD_HEADS + hd];
#pragma unroll
            for (int j = 0; j < 8; ++j) st[j] = a * st[j] + s[j];
        }
        const int ln = i & 63, ks = (i >> 6) & 7, pt = i >> 9, p = 32 * pt + (ln & 31), n0 = 16 * ks + 8 * (ln >> 5);
        store8f(out + OUT_PS + (((size_t)b * SSD_HEADS + hd) * 64 + p) * 128 + n0, st);
    }
}

__device__ __forceinline__ void ph_ssd_out(LAS unsigned char* ldsb, const bf16* __restrict__ xbc_b, const bf16* __restrict__ projb, const float* __restrict__ dtv,
                                           const float* __restrict__ a_log, const float* __restrict__ d_skip, const float* __restrict__ norm_g,
                                           const bf16* __restrict__ Hin, bf16* __restrict__ A1) {
    const int tid = threadIdx.x, w = __builtin_amdgcn_readfirstlane(tid >> 6), lane = tid & 63;
    const int r = lane & 31, h = lane >> 5, blk = (lane >> 4) & 1, q = (lane & 15) >> 2, pp = lane & 3;
    const int hs = w >> 2, lt = hs ? 3 - (w & 3) : (w & 3);
    for (int unit = blockIdx.x; unit < BATCH * 64 * SSD_GROUPS; unit += gridDim.x) {
        const int g = unit & 3, bc = unit >> 2;
        const int t0 = bc * 128;
        __syncthreads();
        ssd_chunk_acs(ldsb, dtv, a_log, t0, g, nullptr);
#pragma unroll
        for (int it_ = 0; it_ < 4; ++it_) { const int idx = tid + it_ * NTHR; const int row = idx >> 4, ch = idx & 15;
            const v4u v = *(const v4u*)(xbc_b + (size_t)(t0 + row) * CONV_DIM + 1536 + 128 * g + ch * 8);
            *(LAS v4u*)(ldsb + SSD_L_BM + row * SSD_RS_B + ch * 16) = v; }
#pragma unroll
        for (int it_ = 0; it_ < 12; ++it_) { const int idx = tid + it_ * NTHR; const int hh = idx >> 10, rem = idx & 1023, row = rem >> 3, ch = rem & 7;
            const v4u v = *(const v4u*)(xbc_b + (size_t)(t0 + row) * CONV_DIM + (6 * g + hh) * 64 + ch * 8);
            *(LAS v4u*)(ldsb + SSD_L_X + hh * SSD_XIMG + row * SSD_RS_X + ch * 16) = v; }
        __syncthreads();
        const bf16* cp = xbc_b + (size_t)(t0 + 32 * lt + r) * CONV_DIM + 2048 + 128 * g + 8 * h;
        s16x8 cfr[8];
#pragma unroll
        for (int ks = 0; ks < 8; ++ks) cfr[ks] = *(const s16x8*)(cp + 16 * ks);
        const int lcol = 32 * lt + r;
        const LAS float* acsb = (const LAS float*)(ldsb + SSD_L_ACS) + 3 * hs * 128; const LAS float* dtsb = (const LAS float*)(ldsb + SSD_L_DTS) + 3 * hs * 128;
        const unsigned xb0 = lds_addr(ldsb + SSD_L_X + 3 * hs * SSD_XIMG) + (4 * h + q) * SSD_RS_X + (16 * blk + 4 * pp) * 2;
        unsigned ypk[3][16];
#pragma unroll
        for (int h3 = 0; h3 < 3; ++h3) {
            const LAS float* acs = acsb + h3 * 128; const LAS float* dts = dtsb + h3 * 128;
            const float myacs = acs[lcol];
            const float Dh = d_skip[6 * g + 3 * hs + h3];
            f32x16 y0, y1;
#pragma unroll
            for (int i = 0; i < 16; ++i) { y0[i] = 0.f; y1[i] = 0.f; }
            { const bf16* hp = Hin + ((size_t)bc * SSD_HEADS + 6 * g + 3 * hs + h3) * 8192 + lane * 8;
#pragma unroll
              for (int kh = 0; kh < 2; ++kh) {
                  s16x8 hf0[4], hf1[4];
#pragma unroll
                  for (int ks = 0; ks < 4; ++ks) { hf0[ks] = *(const s16x8*)(hp + (4 * kh + ks) * 512); hf1[ks] = *(const s16x8*)(hp + (8 + 4 * kh + ks) * 512); }
#pragma unroll
                  for (int ks = 0; ks < 4; ++ks) { y0 = __builtin_amdgcn_mfma_f32_32x32x16_bf16(cfr[4 * kh + ks], hf0[ks], y0, 0, 0, 0); y1 = __builtin_amdgcn_mfma_f32_32x32x16_bf16(cfr[4 * kh + ks], hf1[ks], y1, 0, 0, 0); }
                  __builtin_amdgcn_sched_barrier(0);
              } }
#pragma unroll
            for (int q4 = 0; q4 < 4; ++q4) {
                const f32x4v a4 = *(const LAS f32x4v*)(acs + 32 * lt + 8 * q4 + 4 * h);
                const float e0 = __expf(a4[0]), e1 = __expf(a4[1]), e2 = __expf(a4[2]), e3 = __expf(a4[3]);
                y0[4 * q4] *= e0; y0[4 * q4 + 1] *= e1; y0[4 * q4 + 2] *= e2; y0[4 * q4 + 3] *= e3;
                y1[4 * q4] *= e0; y1[4 * q4 + 1] *= e1; y1[4 * q4 + 2] *= e2; y1[4 * q4 + 3] *= e3;
            }
            __builtin_amdgcn_sched_barrier(0);
            for (int st = 0; st <= lt; ++st) {
                f32x16 cb;
#pragma unroll
                for (int i = 0; i < 16; ++i) cb[i] = 0.f;
#pragma unroll
                for (int ks = 0; ks < 8; ++ks) {
                    const s16x8 bfrag = *(const LAS s16x8*)(ldsb + SSD_L_BM + (32 * st + r) * SSD_RS_B + (16 * ks + 8 * h) * 2);
                    cb = __builtin_amdgcn_mfma_f32_32x32x16_bf16(bfrag, cfr[ks], cb, 0, 0, 0);
                }
                __builtin_amdgcn_sched_barrier(0);
                const unsigned xb = xb0 + h3 * SSD_XIMG + st * 32 * SSD_RS_X;
                s16x4 xv[8];
                tr_read8<0, 8 * SSD_RS_X, 64, 8 * SSD_RS_X + 64, 16 * SSD_RS_X, 24 * SSD_RS_X, 16 * SSD_RS_X + 64, 24 * SSD_RS_X + 64>(xb, xv);
#pragma unroll
                for (int kk = 0; kk < 2; ++kk) {
                    const int s0 = 32 * st + 16 * kk + 4 * h;
                    const f32x4v as0 = *(const LAS f32x4v*)(acs + s0), as1 = *(const LAS f32x4v*)(acs + s0 + 8);
                    const f32x4v ds0 = *(const LAS f32x4v*)(dts + s0), ds1 = *(const LAS f32x4v*)(dts + s0 + 8);
                    float wv[8];
#pragma unroll
                    for (int j = 0; j < 8; ++j) {
                        const int s = s0 + 8 * (j >> 2) + (j & 3);
                        const float asj = (j < 4) ? as0[j & 3] : as1[j & 3], dsj = (j < 4) ? ds0[j & 3] : ds1[j & 3];
                        float v = cb[8 * kk + j] * __expf(myacs - asj) * dsj;
                        v = (s <= lcol) ? v : 0.f;
                        v = (s == lcol) ? v + Dh : v;
                        wv[j] = v;
                    }
                    s16x8 afr;
                    { v4u o; o.x = pk2(wv[0], wv[1]); o.y = pk2(wv[2], wv[3]); o.z = pk2(wv[4], wv[5]); o.w = pk2(wv[6], wv[7]); afr = __builtin_bit_cast(s16x8, o); }
                    const s16x8 b0 = kk == 0 ? TRCAT(xv[0], xv[1]) : TRCAT(xv[4], xv[5]);
                    const s16x8 b1 = kk == 0 ? TRCAT(xv[2], xv[3]) : TRCAT(xv[6], xv[7]);
                    y0 = __builtin_amdgcn_mfma_f32_32x32x16_bf16(afr, b0, y0, 0, 0, 0);
                    y1 = __builtin_amdgcn_mfma_f32_32x32x16_bf16(afr, b1, y1, 0, 0, 0);
                    __builtin_amdgcn_sched_barrier(0);
                }
            }
#pragma unroll
            for (int i = 0; i < 8; ++i) { ypk[h3][i] = pk2(y0[2 * i], y0[2 * i + 1]); ypk[h3][8 + i] = pk2(y1[2 * i], y1[2 * i + 1]); }
            __builtin_amdgcn_sched_barrier(0);
        }
        __syncthreads();
        {
            LAS unsigned short* yst = (LAS unsigned short*)(ldsb + SSD_L_X);
#pragma unroll
            for (int h3 = 0; h3 < 3; ++h3)
#pragma unroll
                for (int ptile = 0; ptile < 2; ++ptile)
#pragma unroll
                    for (int i = 0; i < 8; ++i) {
                        const int reg = 2 * i;
                        const int l0 = 32 * lt + (reg & 3) + 8 * (reg >> 2) + 4 * h;
                        const int col = (3 * hs + h3) * 64 + 32 * ptile + r;
                        const unsigned v = ypk[h3][8 * ptile + i];
                        yst[l0 * (SSD_RS_Y / 2) + col] = (unsigned short)(v & 0xffffu);
                        yst[(l0 + 1) * (SSD_RS_Y / 2) + col] = (unsigned short)(v >> 16);
                    }
        }
        __syncthreads();
#pragma unroll
        for (int pass = 0; pass < 4; ++pass) {
            const int l = 4 * (pass * 8 + w) + (lane >> 4), i16 = lane & 15;
            float gv[3][8]; float ss = 0.f;
#pragma unroll
            for (int k = 0; k < 3; ++k) {
                const int col0 = 24 * i16 + 8 * k;
                float yv[8], zv[8];
                unpack8(*(const LAS v4u*)(ldsb + SSD_L_X + l * SSD_RS_Y + col0 * 2), yv);
                unpack8(*(const v4u*)(projb + (size_t)(t0 + l) * NB_LD + g * 384 + col0), zv);
#pragma unroll
                for (int j = 0; j < 8; ++j) { const float gg = yv[j] * silu_f(zv[j]); gv[k][j] = gg; ss += gg * gg; }
            }
            ss += __shfl_xor(ss, 1); ss += __shfl_xor(ss, 2); ss += __shfl_xor(ss, 4); ss += __shfl_xor(ss, 8);
            const float rstd = rsqrtf(ss * (1.0f / 384.0f) + LN_EPS);
#pragma unroll
            for (int k = 0; k < 3; ++k) {
                const int col0 = g * 384 + 24 * i16 + 8 * k;
                const float4 g0 = *(const float4*)(norm_g + col0), g1 = *(const float4*)(norm_g + col0 + 4);
                v4u o; o.x = pk2(gv[k][0] * rstd * g0.x, gv[k][1] * rstd * g0.y); o.y = pk2(gv[k][2] * rstd * g0.z, gv[k][3] * rstd * g0.w);
                o.z = pk2(gv[k][4] * rstd * g1.x, gv[k][5] * rstd * g1.y); o.w = pk2(gv[k][6] * rstd * g1.z, gv[k][7] * rstd * g1.w);
                *(v4u*)(A1 + (size_t)(t0 + l) * MIX_WIDTH + col0) = o;
            }
        }
    }
}

#define ATT_RS_V 144
#define ATT_VIMG (256 * ATT_RS_V)
#define ATT_HIMG (2 * ATT_VIMG)
#define ATT_PVT(KT) { \
        s16x4 vv_[8]; \
        tr_read8<(32 * KT) * ATT_RS_V, (32 * KT + 8) * ATT_RS_V, (32 * KT) * ATT_RS_V + 64, (32 * KT + 8) * ATT_RS_V + 64, \
                 (32 * KT + 16) * ATT_RS_V, (32 * KT + 24) * ATT_RS_V, (32 * KT + 16) * ATT_RS_V + 64, (32 * KT + 24) * ATT_RS_V + 64>(vbase, vv_); \
        _Pragma("unroll") for (int s2_ = 0; s2_ < 2; ++s2_) { \
            v4u o_; o_.x = pk2(s[KT][8 * s2_ + 0], s[KT][8 * s2_ + 1]); o_.y = pk2(s[KT][8 * s2_ + 2], s[KT][8 * s2_ + 3]); \
            o_.z = pk2(s[KT][8 * s2_ + 4], s[KT][8 * s2_ + 5]); o_.w = pk2(s[KT][8 * s2_ + 6], s[KT][8 * s2_ + 7]); \
            const s16x8 pf_ = __builtin_bit_cast(s16x8, o_); \
            const s16x8 a0_ = s2_ == 0 ? TRCAT(vv_[0], vv_[1]) : TRCAT(vv_[4], vv_[5]); \
            const s16x8 a1_ = s2_ == 0 ? TRCAT(vv_[2], vv_[3]) : TRCAT(vv_[6], vv_[7]); \
            o0 = __builtin_amdgcn_mfma_f32_32x32x16_bf16(a0_, pf_, o0, 0, 0, 0); \
            o1 = __builtin_amdgcn_mfma_f32_32x32x16_bf16(a1_, pf_, o1, 0, 0, 0); } }
__device__ __forceinline__ void ph_attn_prompt(LAS unsigned char* ldsb, const bf16* __restrict__ qrot_b, const bf16* __restrict__ krot_b, const bf16* __restrict__ projb,
                                               bf16* __restrict__ obuf, float* __restrict__ lsebuf, const float* __restrict__ ck, const float* __restrict__ cv, float* __restrict__ out) {
    const int tid = threadIdx.x, w = __builtin_amdgcn_readfirstlane(tid >> 6), lane = tid & 63;
    const int r = lane & 31, h = lane >> 5, blk = (lane >> 4) & 1, q = (lane & 15) >> 2, pp = lane & 3;
    const int qt = w & 3, hsel = w >> 2;
    f32x4n rider[16]; bool pend = false; unsigned pq = 0u;
    for (int unit = blockIdx.x; unit < 3 * 512; unit += gridDim.x) {
        const int pat = unit >> 9, rem = unit & 511, hp = rem & 3, rem2 = rem >> 2, b = rem2 >> 6, bk = rem2 & 63;
        const int dsh = 2 * pat, nper = 64 >> dsh, res = bk >> (6 - dsh), nb = bk & (nper - 1);
        const int head = 2 * hp + hsel;
        __syncthreads();
        { v4u vst[8], kst[8];
#pragma unroll
          for (int it_ = 0; it_ < 8; ++it_) { const int idx = (tid & 255) + it_ * 256;
              const int row = idx >> 3, ch = idx & 7, js = 128 * nb - 128 + row, jc = js < 0 ? 0 : js;
              const size_t tk = (size_t)(b * SEQ + (jc << dsh) + res);
              vst[it_] = *(const v4u*)(projb + tk * NB_LD + NB_V + head * 64 + ch * 8);
              kst[it_] = *(const v4u*)(krot_b + tk * ATT_WIDTH + head * 64 + ch * 8); }
#pragma unroll
          for (int it_ = 0; it_ < 8; ++it_) { const int idx = (tid & 255) + it_ * 256;
              const int row = idx >> 3, ch = idx & 7, js = 128 * nb - 128 + row;
              v4u v = vst[it_], k = kst[it_]; if (js < 0) { v.x = 0u; v.y = 0u; v.z = 0u; v.w = 0u; k = v; }
              *(LAS v4u*)(ldsb + hsel * ATT_HIMG + row * ATT_RS_V + ch * 16) = v;
              *(LAS v4u*)(ldsb + hsel * ATT_HIMG + ATT_VIMG + row * ATT_RS_V + ch * 16) = k; } }
        const int tq = b * SEQ + ((128 * nb + 32 * qt + r) << dsh) + res;
        s16x8 qf[4];
#pragma unroll
        for (int ks = 0; ks < 4; ++ks) qf[ks] = *(const s16x8*)(qrot_b + (size_t)tq * ATT_WIDTH + head * 64 + 16 * ks + 8 * h);
        __syncthreads();
        f32x16 s[5];
#pragma unroll
        for (int kt = 0; kt < 5; ++kt) {
            const LAS unsigned char* kp = ldsb + hsel * ATT_HIMG + ATT_VIMG + (32 * qt + 32 * kt + r) * ATT_RS_V + 16 * h;
#pragma unroll
            for (int i = 0; i < 16; ++i) s[kt][i] = 0.f;
#pragma unroll
            for (int ks = 0; ks < 4; ++ks) s[kt] = __builtin_amdgcn_mfma_f32_32x32x16_bf16(*(const LAS s16x8*)(kp + 32 * ks), qf[ks], s[kt], 0, 0, 0);
        }
        if (pend) copy_q_store(out, pq, (unsigned)lane, rider);
        float m = -INFINITY;
#pragma unroll
        for (int kt = 0; kt < 5; ++kt) {
            const bool tile_ok = (nb > 0) || (qt + kt >= 4);
#pragma unroll
            for (int reg = 0; reg < 16; ++reg) {
                const int c = (reg & 3) + 8 * (reg >> 2) + 4 * h;
                const bool ok = tile_ok && (kt == 0 ? (c >= r) : (kt == 4 ? (c <= r) : true));
                const float v = ok ? s[kt][reg] * 0.125f : -INFINITY;
                s[kt][reg] = v; m = fmaxf(m, v);
            }
        }
        m = fmaxf(m, __shfl_xor(m, 32));
        float l = 0.f;
#pragma unroll
        for (int kt = 0; kt < 5; ++kt)
#pragma unroll
            for (int reg = 0; reg < 16; ++reg) { const float p = __expf(s[kt][reg] - m); s[kt][reg] = p; l += p; }
        l += __shfl_xor(l, 32);
        pq = (unsigned)(unit * NWAVE + w); copy_q_load(ck, cv, pq, (unsigned)lane, rider); pend = true;
        f32x16 o0, o1;
#pragma unroll
        for (int i = 0; i < 16; ++i) { o0[i] = 0.f; o1[i] = 0.f; }
        const unsigned vbase = lds_addr(ldsb + hsel * ATT_HIMG) + (32 * qt + 4 * h + q) * ATT_RS_V + (16 * blk + 4 * pp) * 2;
        ATT_PVT(0) ATT_PVT(1) ATT_PVT(2) ATT_PVT(3) ATT_PVT(4)
        const float inv = 1.0f / l;
        bf16* op = obuf + ((size_t)pat * T_PROMPT + tq) * ATT_WIDTH + head * 64 + 8 * h;
#pragma unroll
        for (int k2 = 0; k2 < 4; ++k2) {
            unsigned ax, ay, bx, by;
            if (k2 < 2) { ax = pk2(o0[8 * k2] * inv, o0[8 * k2 + 1] * inv); ay = pk2(o0[8 * k2 + 2] * inv, o0[8 * k2 + 3] * inv);
                          bx = pk2(o0[8 * k2 + 4] * inv, o0[8 * k2 + 5] * inv); by = pk2(o0[8 * k2 + 6] * inv, o0[8 * k2 + 7] * inv); }
            else { const int k3 = k2 - 2;
                   ax = pk2(o1[8 * k3] * inv, o1[8 * k3 + 1] * inv); ay = pk2(o1[8 * k3 + 2] * inv, o1[8 * k3 + 3] * inv);
                   bx = pk2(o1[8 * k3 + 4] * inv, o1[8 * k3 + 5] * inv); by = pk2(o1[8 * k3 + 6] * inv, o1[8 * k3 + 7] * inv); }
            const auto rx = __builtin_amdgcn_permlane32_swap(ax, bx, false, false);
            const auto ry = __builtin_amdgcn_permlane32_swap(ay, by, false, false);
            v4u o; o.x = rx[0]; o.y = ry[0]; o.z = rx[1]; o.w = ry[1];
            *(v4u*)(op + 16 * k2) = o;
        }
        if (h == 0) lsebuf[((size_t)pat * T_PROMPT + tq) * 8 + head] = m + __logf(l);
    }
    if (pend) copy_q_store(out, pq, (unsigned)lane, rider);
}
__device__ __forceinline__ void ph_attn_combine(const bf16* __restrict__ obuf, const float* __restrict__ lsebuf, bf16* __restrict__ A1) {
    const int lane = threadIdx.x & 63;
#pragma unroll 4
    for (int t = blockIdx.x * NWAVE + (threadIdx.x >> 6); t < T_PROMPT; t += gridDim.x * NWAVE) {
        const int hd = lane >> 3;
        const float l0 = lsebuf[((size_t)0 * T_PROMPT + t) * 8 + hd], l1 = lsebuf[((size_t)1 * T_PROMPT + t) * 8 + hd], l2 = lsebuf[((size_t)2 * T_PROMPT + t) * 8 + hd];
        const float mx = fmaxf(l0, fmaxf(l1, l2));
        const float e0 = __expf(l0 - mx), e1 = __expf(l1 - mx), e2 = __expf(l2 - mx);
        const float inv = 1.0f / (e0 + e1 + e2);
        float a[8], b[8], c[8];
        unpack8(*(const v4u*)(obuf + ((size_t)0 * T_PROMPT + t) * ATT_WIDTH + lane * 8), a);
        unpack8(*(const v4u*)(obuf + ((size_t)1 * T_PROMPT + t) * ATT_WIDTH + lane * 8), b);
        unpack8(*(const v4u*)(obuf + ((size_t)2 * T_PROMPT + t) * ATT_WIDTH + lane * 8), c);
        float o[8];
#pragma unroll
        for (int j = 0; j < 8; ++j) o[j] = (e0 * a[j] + e1 * b[j] + e2 * c[j]) * inv;
        v4u w; w.x = pk2(o[0], o[1]); w.y = pk2(o[2], o[3]); w.z = pk2(o[4], o[5]); w.w = pk2(o[6], o[7]);
        *(v4u*)(A1 + (size_t)t * MIX_WIDTH + SSD_WIDTH + lane * 8) = w;
    }
}

#define RT_RS 272
#define RT_KIMG (128 * RT_RS)
#define RT_LUT (2 * RT_KIMG)
constexpr unsigned char RT_CANDS[64] = {0, 1, 2, 3, 4, 5, 6, 7, 8, 9, 10, 11, 12, 13, 14, 15, 16, 17, 18, 19, 20, 21, 22, 23, 32, 33, 34, 35, 36, 48, 49, 50, 51, 64, 65, 66, 80, 81, 96, 97,
                                        112, 113, 128, 144, 160, 176, 192, 208, 224, 240, 0, 0, 0, 0, 0, 0, 0, 0, 0, 0, 0, 0, 0, 0};
__device__ __forceinline__ unsigned rt_mono(float f) { const unsigned u = __builtin_bit_cast(unsigned, f); return u ^ ((unsigned)((int)u >> 31) | 0x80000000u); }
__device__ __forceinline__ float rt_unmono(unsigned m) { const unsigned u = (m & 0x80000000u) ? (m ^ 0x80000000u) : ~m; return __builtin_bit_cast(float, u); }
#define RT_CE_DESC(a, b) { const unsigned x_ = (a), y_ = (b); (a) = x_ > y_ ? x_ : y_; (b) = x_ > y_ ? y_ : x_; }
#define RT_CE_ASC(a, b) { const unsigned x_ = (a), y_ = (b); (a) = x_ > y_ ? y_ : x_; (b) = x_ > y_ ? x_ : y_; }
__device__ __forceinline__ void rt_sort16(unsigned (&v)[16]) {
#pragma unroll
    for (int k = 2; k <= 16; k <<= 1)
#pragma unroll
        for (int j = k >> 1; j > 0; j >>= 1)
#pragma unroll
            for (int i = 0; i < 16; ++i) { const int l = i ^ j; if (l > i) { if ((i & k) == 0) RT_CE_DESC(v[i], v[l]) else RT_CE_ASC(v[i], v[l]) } }
}
__device__ __forceinline__ void rt_merge16(unsigned (&v)[16]) {
#pragma unroll
    for (int j = 8; j > 0; j >>= 1)
#pragma unroll
        for (int i = 0; i < 16; ++i) { const int l = i ^ j; if (l > i) RT_CE_DESC(v[i], v[l]) }
}
__device__ __forceinline__ void rt_top16(unsigned (&a)[16], const unsigned (&b)[16]) {
#pragma unroll
    for (int i = 0; i < 16; ++i) a[i] = a[i] > b[15 - i] ? a[i] : b[15 - i];
    rt_merge16(a);
}
__device__ __forceinline__ void rt_top16_partner(unsigned (&a)[16]) {
    unsigned b[16];
#pragma unroll
    for (int i = 0; i < 16; ++i) b[i] = (unsigned)__shfl_xor((int)a[i], 32);
    rt_top16(a, b);
}
__device__ __forceinline__ void rt_scores_top16(LAS unsigned char* kimg, const bf16* __restrict__ qp, int r, int h, unsigned (&k0)[16]) {
    f32x16 acc[4];
#pragma unroll
    for (int kt = 0; kt < 4; ++kt)
#pragma unroll
        for (int i = 0; i < 16; ++i) acc[kt][i] = 0.f;
#pragma unroll
    for (int ks = 0; ks < 8; ++ks) {
        const s16x8 qf = *(const s16x8*)(qp + 16 * ks);
#pragma unroll
        for (int kt = 0; kt < 4; ++kt) {
            const s16x8 kf = *(const LAS s16x8*)(kimg + (32 * kt + r) * RT_RS + (16 * ks + 8 * h) * 2);
            acc[kt] = __builtin_amdgcn_mfma_f32_32x32x16_bf16(kf, qf, acc[kt], 0, 0, 0);
        }
    }
    unsigned k1[16], k2[16], k3[16];
#pragma unroll
    for (int reg = 0; reg < 16; ++reg) {
        const unsigned ki = (unsigned)((reg & 3) + 8 * (reg >> 2) + 4 * h);
        k0[reg] = (rt_mono(acc[0][reg]) & 0xFFFFFF80u) | ki;
        k1[reg] = (rt_mono(acc[1][reg]) & 0xFFFFFF80u) | (ki + 32u);
        k2[reg] = (rt_mono(acc[2][reg]) & 0xFFFFFF80u) | (ki + 64u);
        k3[reg] = (rt_mono(acc[3][reg]) & 0xFFFFFF80u) | (ki + 96u);
    }
    rt_sort16(k0); rt_sort16(k1); rt_sort16(k2); rt_sort16(k3);
    rt_top16(k0, k1); rt_top16(k2, k3); rt_top16(k0, k2);
    rt_top16_partner(k0);
}
__device__ __forceinline__ void ph_peer_route2(LAS unsigned char* ldsb, const bf16* __restrict__ qhb, const float* __restrict__ keys1, const float* __restrict__ keys2,
                                               int* __restrict__ eidx, float* __restrict__ gate, const float* __restrict__ ck, const float* __restrict__ cv, float* __restrict__ out) {
    const int tid = threadIdx.x, w = __builtin_amdgcn_readfirstlane(tid >> 6), lane = tid & 63, r = lane & 31, h = lane >> 5;
    __syncthreads();
    for (int idx = tid; idx < 2 * 128 * 16; idx += NTHR) {
        const int tb = idx >> 11, rem = idx & 2047, row = rem >> 4, ch = rem & 15;
        const float* sp = (tb ? keys2 : keys1) + row * 128 + ch * 8;
        const float4 a = *(const float4*)sp, b = *(const float4*)(sp + 4);
        v4u o; o.x = pk2(a.x, a.y); o.y = pk2(a.z, a.w); o.z = pk2(b.x, b.y); o.w = pk2(b.z, b.w);
        *(LAS v4u*)(ldsb + tb * RT_KIMG + row * RT_RS + ch * 16) = o;
    }
    __syncthreads();
    LAS unsigned* lut = (LAS unsigned*)(ldsb + RT_LUT) + w * 512;
    for (int k = 0;; ++k) {
        int unit;
        if (gridDim.x != 256) { unit = blockIdx.x * NWAVE + w + k * (int)(gridDim.x * NWAVE); if (unit >= (T_ALL / 32) * 8) break; }
        else if (k < 2) unit = k * 2048 + blockIdx.x * NWAVE + w;
        else if (k == 2 && w == 0 && blockIdx.x < 128) unit = 4096 + (int)blockIdx.x;
        else break;
        const int tt = unit >> 3, hd = unit & 7;
        const int tok = 32 * tt + r;
        const bf16* qp = qhb + (size_t)tok * 2048 + hd * 256 + 8 * h;
        unsigned ka[16], kb[16];
        rt_scores_top16(ldsb, qp, r, h, ka);
        rt_scores_top16(ldsb + RT_KIMG, qp + 128, r, h, kb);
        float v1[16], v2[16];
#pragma unroll
        for (int i = 0; i < 16; ++i) { v1[i] = rt_unmono(ka[i] & 0xFFFFFF80u); v2[i] = rt_unmono(kb[i] & 0xFFFFFF80u); }
#pragma unroll
        for (int wd = 0; wd < 4; ++wd) {
            lut[wd * 64 + lane] = (ka[4 * wd] & 0x7Fu) | ((ka[4 * wd + 1] & 0x7Fu) << 8) | ((ka[4 * wd + 2] & 0x7Fu) << 16) | ((ka[4 * wd + 3] & 0x7Fu) << 24);
            lut[(4 + wd) * 64 + lane] = (kb[4 * wd] & 0x7Fu) | ((kb[4 * wd + 1] & 0x7Fu) << 8) | ((kb[4 * wd + 2] & 0x7Fu) << 16) | ((kb[4 * wd + 3] & 0x7Fu) << 24);
        }
        unsigned c0[16], c1[16];
        c0[0] = (rt_mono(h ? (v1[0] + v2[1]) : (v1[0] + v2[0])) & 0xFFFFFF00u) | (h ? 1u : 0u);
        c0[1] = (rt_mono(h ? (v1[0] + v2[3]) : (v1[0] + v2[2])) & 0xFFFFFF00u) | (h ? 3u : 2u);
        c0[2] = (rt_mono(h ? (v1[0] + v2[5]) : (v1[0] + v2[4])) & 0xFFFFFF00u) | (h ? 5u : 4u);
        c0[3] = (rt_mono(h ? (v1[0] + v2[7]) : (v1[0] + v2[6])) & 0xFFFFFF00u) | (h ? 7u : 6u);
        c0[4] = (rt_mono(h ? (v1[0] + v2[9]) : (v1[0] + v2[8])) & 0xFFFFFF00u) | (h ? 9u : 8u);
        c0[5] = (rt_mono(h ? (v1[0] + v2[11]) : (v1[0] + v2[10])) & 0xFFFFFF00u) | (h ? 11u : 10u);
        c0[6] = (rt_mono(h ? (v1[0] + v2[13]) : (v1[0] + v2[12])) & 0xFFFFFF00u) | (h ? 13u : 12u);
        c0[7] = (rt_mono(h ? (v1[0] + v2[15]) : (v1[0] + v2[14])) & 0xFFFFFF00u) | (h ? 15u : 14u);
        c0[8] = (rt_mono(h ? (v1[1] + v2[1]) : (v1[1] + v2[0])) & 0xFFFFFF00u) | (h ? 17u : 16u);
        c0[9] = (rt_mono(h ? (v1[1] + v2[3]) : (v1[1] + v2[2])) & 0xFFFFFF00u) | (h ? 19u : 18u);
        c0[10] = (rt_mono(h ? (v1[1] + v2[5]) : (v1[1] + v2[4])) & 0xFFFFFF00u) | (h ? 21u : 20u);
        c0[11] = (rt_mono(h ? (v1[1] + v2[7]) : (v1[1] + v2[6])) & 0xFFFFFF00u) | (h ? 23u : 22u);
        c0[12] = (rt_mono(h ? (v1[2] + v2[1]) : (v1[2] + v2[0])) & 0xFFFFFF00u) | (h ? 33u : 32u);
        c0[13] = (rt_mono(h ? (v1[2] + v2[3]) : (v1[2] + v2[2])) & 0xFFFFFF00u) | (h ? 35u : 34u);
        c0[14] = (rt_mono(h ? (v1[3] + v2[0]) : (v1[2] + v2[4])) & 0xFFFFFF00u) | (h ? 48u : 36u);
        c0[15] = (rt_mono(h ? (v1[3] + v2[2]) : (v1[3] + v2[1])) & 0xFFFFFF00u) | (h ? 50u : 49u);
        c1[0] = (rt_mono(h ? (v1[4] + v2[0]) : (v1[3] + v2[3])) & 0xFFFFFF00u) | (h ? 64u : 51u);
        c1[1] = (rt_mono(h ? (v1[4] + v2[2]) : (v1[4] + v2[1])) & 0xFFFFFF00u) | (h ? 66u : 65u);
        c1[2] = (rt_mono(h ? (v1[5] + v2[1]) : (v1[5] + v2[0])) & 0xFFFFFF00u) | (h ? 81u : 80u);
        c1[3] = (rt_mono(h ? (v1[6] + v2[1]) : (v1[6] + v2[0])) & 0xFFFFFF00u) | (h ? 97u : 96u);
        c1[4] = (rt_mono(h ? (v1[7] + v2[1]) : (v1[7] + v2[0])) & 0xFFFFFF00u) | (h ? 113u : 112u);
        c1[5] = (rt_mono(h ? (v1[9] + v2[0]) : (v1[8] + v2[0])) & 0xFFFFFF00u) | (h ? 144u : 128u);
        c1[6] = (rt_mono(h ? (v1[11] + v2[0]) : (v1[10] + v2[0])) & 0xFFFFFF00u) | (h ? 176u : 160u);
        c1[7] = (rt_mono(h ? (v1[13] + v2[0]) : (v1[12] + v2[0])) & 0xFFFFFF00u) | (h ? 208u : 192u);
        c1[8] = (rt_mono(h ? (v1[15] + v2[0]) : (v1[14] + v2[0])) & 0xFFFFFF00u) | (h ? 240u : 224u);
        c1[9] = 0u;
        c1[10] = 0u;
        c1[11] = 0u;
        c1[12] = 0u;
        c1[13] = 0u;
        c1[14] = 0u;
        c1[15] = 0u;
        rt_sort16(c0); rt_sort16(c1); rt_top16(c0, c1); rt_top16_partner(c0);
        float e[16]; float sum = 0.f;
        const float mx = rt_unmono(c0[0] & 0xFFFFFF00u);
#pragma unroll
        for (int k = 0; k < 16; ++k) { e[k] = __expf(rt_unmono(c0[k] & 0xFFFFFF00u) - mx); sum += e[k]; }
        const float inv = 1.0f / sum;
        asm volatile("s_waitcnt lgkmcnt(0)" ::: "memory");
        int ex[8]; float gv[8];
#pragma unroll
        for (int k = 0; k < 8; ++k) {
            const unsigned hm = (unsigned)(-h);
            const unsigned ck = (c0[k] & ~hm) | (c0[8 + k] & hm);
            const float ek = __builtin_bit_cast(float, (__builtin_bit_cast(unsigned, e[k]) & ~hm) | (__builtin_bit_cast(unsigned, e[8 + k]) & hm));
            const unsigned ci = (ck >> 4) & 15u, cj = ck & 15u;
            const unsigned w1 = lut[(ci >> 2) * 64 + lane], w2 = lut[(4 + (cj >> 2)) * 64 + lane];
            const unsigned i1 = (w1 >> (8 * (ci & 3))) & 0x7Fu, i2 = (w2 >> (8 * (cj & 3))) & 0x7Fu;
            ex[k] = (int)(i1 * PEER_NKEYS + i2); gv[k] = ek * inv;
        }
        int* ep = eidx + (size_t)tok * 128 + hd * 16 + 8 * h; float* gp = gate + (size_t)tok * 128 + hd * 16 + 8 * h;
        *(int4*)ep = make_int4(ex[0], ex[1], ex[2], ex[3]); *(int4*)(ep + 4) = make_int4(ex[4], ex[5], ex[6], ex[7]);
        *(float4*)gp = make_float4(gv[0], gv[1], gv[2], gv[3]); *(float4*)(gp + 4) = make_float4(gv[4], gv[5], gv[6], gv[7]);
    }
    if (gridDim.x == 256 && (w != 0 || blockIdx.x >= 128)) {
        const unsigned si = blockIdx.x < 128 ? blockIdx.x * 7u + (unsigned)(w - 1) : 896u + (blockIdx.x - 128u) * 8u + (unsigned)w;
        cache_copy_slice(ck, cv, out, 7040u + si, (unsigned)lane);
    }
}

struct Params {
    const float* in[23];
    float* out;
    unsigned char* ws;
    unsigned* bar;
};

#define WS_BAR      0ull
#define WS_XALL     (1ull << 20)
#define WS_PROJ     (WS_XALL + (size_t)T_ALL * D_MODEL * 4)
#define WS_XBC      (WS_PROJ + (size_t)T_ALL * PROJ_LD * 4)
#define WS_DT       (WS_XBC + (size_t)T_ALL * CONV_DIM * 4)
#define WS_QROT     (WS_DT + (size_t)T_ALL * SSD_HEADS * 4)
#define WS_KROT     (WS_QROT + (size_t)T_ALL * ATT_WIDTH * 4)
#define WS_YBUF     (WS_KROT + (size_t)T_ALL * ATT_WIDTH * 4)
#define WS_MIX      (WS_YBUF + (size_t)T_ALL * MIX_WIDTH * 4)
#define WS_HBUF     (WS_MIX + (size_t)T_ALL * D_MODEL * 4)
#define WS_QH       (WS_HBUF + (size_t)T_ALL * D_MODEL * 4)
#define WS_EIDX     (WS_QH + (size_t)T_ALL * 2048 * 4)
#define WS_GATE     (WS_EIDX + (size_t)T_ALL * 128 * 4)
#define WS_A0       (WS_GATE + (size_t)T_ALL * 128 * 4)
#define WS_A1       (WS_A0 + (size_t)T_ALL * D_MODEL * 2)
#define WS_A2       (WS_A1 + (size_t)T_ALL * MIX_WIDTH * 2)
#define WS_WTIN     (WS_A2 + (size_t)T_ALL * D_MODEL * 2)
#define WS_WTOUT    (WS_WTIN + (size_t)PROJ_LD * D_MODEL * 2)
#define WS_WTQ      (WS_WTOUT + (size_t)D_MODEL * MIX_WIDTH * 2)
#define WS_PROJB    (WS_WTQ + (size_t)2048 * D_MODEL * 2)
#define WS_DTRAW    (WS_PROJB + (size_t)T_ALL * NB_LD * 2)
#define WS_XBCB     (WS_DTRAW + (size_t)T_ALL * 32 * 4)
#define WS_QROTB    (WS_XBCB + (size_t)T_ALL * CONV_DIM * 2)
#define WS_KROTB    (WS_QROTB + (size_t)T_ALL * ATT_WIDTH * 2)
#define WS_UB       (WS_KROTB + (size_t)T_ALL * ATT_WIDTH * 2)
#define WS_VB       (WS_UB + (size_t)16384 * D_MODEL * 2)
#define WS_USC      (WS_VB + (size_t)16384 * D_MODEL * 2)
#define WS_VSC      (WS_USC + 16384 * 4)
#define WS_SBUF     (WS_VSC + 16384 * 4)
#define WS_HIN      (WS_SBUF + (size_t)BATCH * 64 * SSD_HEADS * 64 * 128 * 2)
#define WS_CDEC     (WS_HIN + (size_t)BATCH * 64 * SSD_HEADS * 64 * 128 * 2)
#define WS_OBUF     (WS_CDEC + (size_t)BATCH * 64 * SSD_HEADS * 4)
#define WS_LSE      (WS_OBUF + (size_t)3 * T_PROMPT * ATT_WIDTH * 2)
#define WS_ROPE     (WS_LSE + (size_t)3 * T_PROMPT * 8 * 4)
#define WS_END      (WS_ROPE + (size_t)SEQ * 64 * 4)

#define LDS_BYTES (160 * 1024)

#define KP const __attribute__((address_space(4))) Params* kp = (const __attribute__((address_space(4))) Params*)__builtin_amdgcn_kernarg_segment_ptr(); asm volatile("" : "+s"(kp)); unsigned char* ws = kp->ws; (void)ws;
#define IN(i) (kp->in[i])
#define WSP(T, off) ((T*)(ws + (off)))
__global__ void __launch_bounds__(512, 2) mega_fwd(Params p) {
    extern __shared__ __attribute__((aligned(16))) unsigned char smem[];
    if (threadIdx.x == 0) *(uint4*)smem = make_uint4(0u, 0u, 0u, 0u);
    __syncthreads();
    XcdBarrier bar = xcd_barrier_post(p.bar, (volatile LAS unsigned*)smem);
    float* lds = (float*)(smem + 256);
    LAS unsigned char* ldsb = (LAS unsigned char*)smem + 256;

    { KP ph_prologue(ldsb, IN(0), IN(1), WSP(bf16, WS_A0), IN(6), WSP(bf16, WS_WTIN), WSP(float, WS_ROPE)); }
    xcd_barrier(bar);
    { KP pg8::Gemm g{WSP(bf16, WS_A0), WSP(bf16, WS_WTIN), T_ALL, PROJ_LD, D_MODEL}; pg8::StaticOrder S; S.init(g.M, g.N, (int)gridDim.x, (int)blockIdx.x);
      pg8::EpiProj E{WSP(bf16, WS_PROJB), WSP(float, WS_DTRAW)}; pg8::gemm_phase<pg8::EpiProj, pg8::StaticOrder, false>(ldsb, g, S, E, nullptr); }
    xcd_barrier(bar);
    { KP ph_post_proj_prompt(WSP(bf16, WS_PROJB), WSP(float, WS_DTRAW), IN(7), IN(8), IN(9), WSP(float, WS_ROPE), WSP(bf16, WS_XBCB), WSP(float, WS_DT), WSP(bf16, WS_QROTB), WSP(bf16, WS_KROTB), kp->out); }
    { KP ph_post_proj2(WSP(bf16, WS_PROJB), WSP(float, WS_DTRAW), IN(4), IN(7), IN(8), IN(9), WSP(bf16, WS_XBCB), WSP(float, WS_DT), WSP(bf16, WS_QROTB), WSP(bf16, WS_KROTB), kp->out); }
    xcd_barrier(bar);
    { KP ph_ssd_states(ldsb, WSP(bf16, WS_XBCB), WSP(float, WS_DT), IN(10), WSP(bf16, WS_SBUF), WSP(float, WS_CDEC), IN(2), IN(3), kp->out); }
    __syncthreads();
    { KP ph_attn_prompt(ldsb, WSP(bf16, WS_QROTB), WSP(bf16, WS_KROTB), WSP(bf16, WS_PROJB), WSP(bf16, WS_OBUF), WSP(float, WS_LSE), IN(2), IN(3), kp->out); }
    __syncthreads();
    { KP ph_ssd_decode(WSP(bf16, WS_XBCB), WSP(float, WS_DT), IN(10), IN(11), IN(5), WSP(float, WS_YBUF), kp->out); }
    { KP ph_attn_sample3(lds, WSP(bf16, WS_QROTB), WSP(bf16, WS_KROTB), WSP(bf16, WS_PROJB), IN(2), IN(3), WSP(bf16, WS_A1)); }
    xcd_barrier(bar);
    if ((int)gridDim.x > 128) {
        if ((int)blockIdx.x < 96) {
            { KP ph_ssd_scan(WSP(bf16, WS_SBUF), WSP(float, WS_CDEC), WSP(bf16, WS_HIN), kp->out, (int)blockIdx.x, 96); }
            { KP ph_quant_tables(IN(19), IN(20), WSP(unsigned char, WS_UB), WSP(unsigned char, WS_VB), WSP(float, WS_USC), WSP(float, WS_VSC), (int)blockIdx.x, 96, 0, QSPLIT); }
        } else {
            { KP ph_prologue2(ldsb, IN(13), WSP(bf16, WS_WTOUT), IN(16), WSP(bf16, WS_WTQ), (int)blockIdx.x - 96, (int)gridDim.x - 96); }
            { KP ph_quant_tables(IN(19), IN(20), WSP(unsigned char, WS_UB), WSP(unsigned char, WS_VB), WSP(float, WS_USC), WSP(float, WS_VSC), (int)blockIdx.x - 96, (int)gridDim.x - 96, QSPLIT, 2 * 16384); }
        }
    } else {
        { KP ph_ssd_scan(WSP(bf16, WS_SBUF), WSP(float, WS_CDEC), WSP(bf16, WS_HIN), kp->out, (int)blockIdx.x, (int)gridDim.x); }
        { KP ph_prologue2(ldsb, IN(13), WSP(bf16, WS_WTOUT), IN(16), WSP(bf16, WS_WTQ), (int)blockIdx.x, (int)gridDim.x); }
        { KP ph_quant_tables(IN(19), IN(20), WSP(unsigned char, WS_UB), WSP(unsigned char, WS_VB), WSP(float, WS_USC), WSP(float, WS_VSC), (int)blockIdx.x, (int)gridDim.x); }
    }
    xcd_barrier(bar);
    { KP ph_ssd_out(ldsb, WSP(bf16, WS_XBCB), WSP(bf16, WS_PROJB), WSP(float, WS_DT), IN(10), IN(11), IN(12), WSP(bf16, WS_HIN), WSP(bf16, WS_A1)); }
    { KP ph_attn_combine(WSP(bf16, WS_OBUF), WSP(float, WS_LSE), WSP(bf16, WS_A1)); }
    { KP ph_gate_norm(WSP(bf16, WS_PROJB), IN(12), WSP(float, WS_YBUF), WSP(bf16, WS_A1)); }
    xcd_barrier(bar);
    { KP pg8::Gemm g{WSP(bf16, WS_A1), WSP(bf16, WS_WTOUT), T_ALL, D_MODEL, MIX_WIDTH}; pg8::StaticOrder S; S.init(g.M, g.N, (int)gridDim.x, (int)blockIdx.x);
      pg8::EpiBf16Plain E{WSP(bf16, WS_MIX), D_MODEL}; pg8::gemm_phase<pg8::EpiBf16Plain, pg8::StaticOrder, false>(ldsb, g, S, E, nullptr); }
    if (blockIdx.x >= 8 && gridDim.x == 256) { KP cache_copy_slice(IN(2), IN(3), kp->out, 4096u + (blockIdx.x - 8) * 8u + (threadIdx.x >> 6), threadIdx.x & 63u); }
    xcd_barrier(bar);
    { KP ph_ln_res(IN(0), IN(1), WSP(bf16, WS_MIX), IN(14), IN(15), WSP(bf16, WS_A2)); }
    xcd_barrier(bar);
    { KP pg8::Gemm g{WSP(bf16, WS_A2), WSP(bf16, WS_WTQ), T_ALL, 2048, D_MODEL}; pg8::StaticOrder S; S.init(g.M, g.N, (int)gridDim.x, (int)blockIdx.x);
      pg8::EpiBf16Plain E{WSP(bf16, WS_QH), 2048}; pg8::gemm_phase<pg8::EpiBf16Plain, pg8::StaticOrder, false>(ldsb, g, S, E, nullptr); }
    if (blockIdx.x >= 16 && gridDim.x == 256 && threadIdx.x < 256) { KP cache_copy_slice(IN(2), IN(3), kp->out, 4096u + 1984u + (blockIdx.x - 16) * 4u + (threadIdx.x >> 6), threadIdx.x & 63u); }
    xcd_barrier(bar);
    { KP ph_peer_route2(ldsb, WSP(bf16, WS_QH), IN(17), IN(18), WSP(int, WS_EIDX), WSP(float, WS_GATE), IN(2), IN(3), kp->out); }
    xcd_barrier(bar);
    { KP ph_peer_ffn3(WSP(bf16, WS_A2), WSP(int, WS_EIDX), WSP(float, WS_GATE), WSP(unsigned char, WS_UB), WSP(unsigned char, WS_VB), WSP(float, WS_USC), WSP(float, WS_VSC), IN(21), IN(22), kp->out, IN(2), IN(3), gridDim.x == 256 ? 8960u : 4096u); }
}

extern "C" void kernel_launch(void* const* d_in, const int* in_sizes, int n_in, void* d_out, int out_size, void* d_ws, size_t ws_size, hipStream_t stream) {
    static int grid = 0;
    if (grid == 0) {
        int dev = 0, cus = 0, per_cu = 0;
        if (hipGetDevice(&dev) != hipSuccess || hipDeviceGetAttribute(&cus, hipDeviceAttributeMultiprocessorCount, dev) != hipSuccess) { fprintf(stderr, "kernel_launch: device query failed\n"); grid = -1; return; }
        if (hipFuncSetAttribute((const void*)mega_fwd, hipFuncAttributeMaxDynamicSharedMemorySize, LDS_BYTES) != hipSuccess) { fprintf(stderr, "kernel_launch: hipFuncSetAttribute failed\n"); grid = -1; return; }
        if (hipOccupancyMaxActiveBlocksPerMultiprocessor(&per_cu, (const void*)mega_fwd, NTHR, LDS_BYTES) != hipSuccess || per_cu < 1) { fprintf(stderr, "kernel_launch: occupancy query says %d\n", per_cu); }
        (void)hipGetLastError();
        grid = cus;
        if (ws_size < WS_END) { fprintf(stderr, "kernel_launch: workspace too small\n"); grid = -1; return; }
    }
    if (grid < 0) return;
    (void)hipMemsetAsync((char*)d_ws + WS_BAR, 0, XCD_BAR_WORDS * sizeof(unsigned), stream);
    Params p{};
    for (int i = 0; i < 23; ++i) p.in[i] = (const float*)d_in[i];
    p.out = (float*)d_out; p.ws = (unsigned char*)d_ws; p.bar = (unsigned*)((char*)d_ws + WS_BAR);
    hipLaunchKernelGGL(mega_fwd, dim3(grid), dim3(NTHR), LDS_BYTES, stream, p);
}
```

```cpp
#include <hip/hip_runtime.h>
#include <stdint.h>

#define D_MODEL 1024
#define BATCH 2
#define SEQ 8192
#define DEC_BATCH 128
#define DEC_SEQ 4
#define PAST_LEN 8192
#define HEAD_DIM 64
#define ATT_WIDTH 512
#define ATT_HEADS 8
#define SSD_WIDTH 1536
#define SSD_HEADS 24
#define SSD_GROUPS 4
#define SSD_STATE 128
#define CONV_DIM 2560
#define IN_WIDTH 5656
#define PROJ_LD 5888
#define MIX_WIDTH 2048
#define WBUF 2048
#define PEER_NKEYS 128
#define PEER_HEADS 8
#define PEER_TOPK 16
#define PEER_DKEY 256
#define T_PROMPT (BATCH * SEQ)
#define T_SAMPLE (DEC_BATCH * DEC_SEQ)
#define T_ALL (T_PROMPT + T_SAMPLE)
#define O_Z 0
#define O_XBC 1536
#define O_DT 4096
#define O_Q 4120
#define O_K 4632
#define O_V 5144
#define ALPHA_F 1.189207115002721f
#define LN_EPS 1e-5f

#define OUT_YP 0ull
#define OUT_YS (OUT_YP + 16777216ull)
#define OUT_PK (OUT_YS + 524288ull)
#define OUT_PV (OUT_PK + 2097152ull)
#define OUT_PC (OUT_PV + 2097152ull)
#define OUT_PS (OUT_PC + 15360ull)
#define OUT_SK (OUT_PS + 393216ull)
#define OUT_SV (OUT_SK + 134217728ull)
#define OUT_SC (OUT_SV + 134217728ull)
#define OUT_SS (OUT_SC + 983040ull)

__constant__ double ROPE_INV_REV[32] = {
    1.59154943091895346e-01, 1.19349370211248862e-01, 8.94994016088910133e-02, 6.71150830052272551e-02,
    5.03292121044870353e-02, 3.77415847174197711e-02, 2.83021958306233987e-02, 2.12236527647776604e-02,
    1.59154943091895339e-02, 1.19349370211248862e-02, 8.94994016088910237e-03, 6.71150830052272534e-03,
    5.03292121044870370e-03, 3.77415847174197719e-03, 2.83021958306233987e-03, 2.12236527647776622e-03,
    1.59154943091895356e-03, 1.19349370211248849e-03, 8.94994016088910237e-04, 6.71150830052272599e-04,
    5.03292121044870326e-04, 3.77415847174197741e-04, 2.83021958306233954e-04, 2.12236527647776605e-04,
    1.59154943091895351e-04, 1.19349370211248862e-04, 8.94994016088910182e-05, 6.71150830052272545e-05,
    5.03292121044870354e-05, 3.77415847174197768e-05, 2.83021958306233961e-05, 2.12236527647776592e-05
};

__device__ __forceinline__ float silu_f(float x) { return x * __builtin_amdgcn_rcpf(1.0f + __expf(-x)); }
__device__ __forceinline__ float softplus_f(float x) { return fmaxf(x, 0.f) + log1pf(__expf(-fabsf(x))); }
__device__ __forceinline__ float gelu_f(float x) { return 0.5f * x * (1.0f + erff(x * 0.70710678118654752f)); }
__device__ __forceinline__ float wave_sum(float v) {
#pragma unroll
    for (int o = 32; o > 0; o >>= 1) v += __shfl_xor(v, o);
    return v;
}
__device__ __forceinline__ float wave_max(float v) {
#pragma unroll
    for (int o = 32; o > 0; o >>= 1) v = fmaxf(v, __shfl_xor(v, o));
    return v;
}

#include <cstdio>
#define XB_TMO      128
#define XB_XCNT(j)  (256  + 64 * (j))
#define XB_XSUB(j)  (1280 + 64 * (j))
#define XB_XGEN(j)  (2304 + 64 * (j))
#define XB_TOP      3328
#define XB_TOPGEN   3392
#define XCD_BAR_WORDS 3456
#define XB_SPIN_CAP (1u << 18)
#define LAS __attribute__((address_space(3)))

__device__ __forceinline__ unsigned xb_ld(unsigned* p)              { return __hip_atomic_load(p, __ATOMIC_RELAXED, __HIP_MEMORY_SCOPE_AGENT); }
__device__ __forceinline__ unsigned xb_add(unsigned* p, unsigned v) { return __hip_atomic_fetch_add(p, v, __ATOMIC_RELAXED, __HIP_MEMORY_SCOPE_AGENT); }
__device__ __forceinline__ unsigned xb_xcc_id() { return (unsigned)__builtin_amdgcn_s_getreg((3 << 11) | 20) & 0xFu; }
#define XB_SPIN(cond, bar) do { unsigned _sp = 0; while (cond) { __builtin_amdgcn_s_sleep(1); \
    if ((++_sp & 255u) == 0u) { if (xb_ld(&(bar)[XB_TMO])) break; if (_sp > XB_SPIN_CAP) { atomicAdd(&(bar)[XB_TMO], 1u); break; } } } } while (0)

struct XcdBarrier {
    unsigned* bar; unsigned x;
    volatile LAS unsigned* st;
};

__device__ __forceinline__ XcdBarrier xcd_barrier_post(unsigned* bar, volatile LAS unsigned* st) {
    XcdBarrier b; b.bar = bar; b.x = xb_xcc_id(); b.st = st;
    if (threadIdx.x == 0) (void)xb_add(&bar[XB_XCNT(b.x)], 1u);
    return b;
}
__device__ __forceinline__ void xcd_barrier_complete(unsigned* bar, unsigned x, unsigned& nloc, unsigned& nx) {
    const unsigned G = gridDim.x * gridDim.y * gridDim.z;
    unsigned sum, cnt, mine, sp = 0u;
    for (;;) {
        sum = 0u; cnt = 0u; mine = 0u;
#pragma unroll
        for (unsigned j = 0; j < 16; ++j) { const unsigned c = xb_ld(&bar[XB_XCNT(j)]); sum += c; cnt += (c > 0u) ? 1u : 0u; mine = (j == x) ? c : mine; }
        if (sum == G) break;
        __builtin_amdgcn_s_sleep(1);
        if ((++sp & 255u) == 0u) { if (xb_ld(&bar[XB_TMO])) break; if (sp > XB_SPIN_CAP) { atomicAdd(&bar[XB_TMO], 1u); break; } }
    }
    nloc = mine > 0u ? mine : 1u; nx = cnt > 0u ? cnt : 1u;
}

__device__ __forceinline__ void xcd_barrier(const XcdBarrier& b) {
    asm volatile("s_waitcnt vmcnt(0)" ::: "memory");
    __syncthreads();
    if (threadIdx.x == 0) {
        unsigned* bar = b.bar;
        __builtin_amdgcn_s_waitcnt(0);
        unsigned nloc = b.st[0], nx = b.st[1];
        if (nloc == 0u) { xcd_barrier_complete(bar, b.x, nloc, nx); b.st[0] = nloc; b.st[1] = nx; }
        const unsigned old = xb_add(&bar[XB_XSUB(b.x)], 1u);
        const unsigned gen = old / nloc;
        if (old + 1u == (gen + 1u) * nloc) {
            __builtin_amdgcn_fence(__ATOMIC_RELEASE, "agent");
            asm volatile("s_waitcnt vmcnt(0)" ::: "memory");
            const unsigned og = xb_add(&bar[XB_TOP], 1u);
            const unsigned tg = og / nx;
            if (og + 1u == (tg + 1u) * nx) xb_add(&bar[XB_TOPGEN], 1u);
            else XB_SPIN(xb_ld(&bar[XB_TOPGEN]) == tg, bar);
            __builtin_amdgcn_fence(__ATOMIC_ACQUIRE, "agent");
            xb_add(&bar[XB_XGEN(b.x)], 1u);
            asm volatile("s_waitcnt vmcnt(0)" ::: "memory");
        } else {
            XB_SPIN(xb_ld(&bar[XB_XGEN(b.x)]) == gen, bar);
            __builtin_amdgcn_fence(__ATOMIC_ACQUIRE, "agent");
            asm volatile("s_waitcnt vmcnt(0)" ::: "memory");
        }
    }
    __syncthreads();
}


#define GAS __attribute__((address_space(1)))
typedef unsigned short bf16;
typedef unsigned v4u __attribute__((ext_vector_type(4)));
#define LDS_WAIT() asm volatile("s_waitcnt lgkmcnt(0)" ::: "memory")
__device__ __forceinline__ unsigned f2bf(float f) { unsigned u = __builtin_bit_cast(unsigned, f); return (u + 0x7fffu + ((u >> 16) & 1u)) >> 16; }
__device__ __forceinline__ unsigned pk2(float lo, float hi) { return f2bf(lo) | (f2bf(hi) << 16); }
__device__ __forceinline__ float bf2f(unsigned short b) { return __builtin_bit_cast(float, (unsigned)b << 16); }
#include <hip/hip_runtime.h>
namespace pg8 {
#define PG8_LAS __attribute__((address_space(3)))
typedef unsigned short bf16_t;
typedef short bf16x8 __attribute__((ext_vector_type(8)));
typedef float f32x4 __attribute__((ext_vector_type(4)));
typedef unsigned u32x4 __attribute__((ext_vector_type(4)));
constexpr int BM = 256, BK = 64, HALF = 128, HTB = HALF * BK * 2  , STAGE_BYTES = 8 * HTB, NXCD = 8, WGM = 8;

__host__ __device__ __forceinline__ int lds_byte(int r, int c) { const int st = (r >> 4) * 2 + (c >> 5), rr = r & 15, cc = c & 31, ob = rr * 64 + cc * 2; return st * 1024 + (ob ^ (((ob >> 9) & 1) << 5)); }
__host__ __device__ __forceinline__ void stage_rc(int b, int& R, int& C) { const int st = b / 1024, sb = b % 1024, swz = sb ^ (((sb >> 9) & 1) << 5); R = (st >> 1) * 16 + swz / 64; C = (st & 1) * 32 + (swz % 64) / 2; }
__host__ __device__ __forceinline__ int perm32(int rho) { const int n = rho >> 4, i = rho & 15; return 8 * (i >> 2) + 4 * n + (i & 3); }

struct Unit { int pm, pn; };
struct Gemm { const bf16_t* A; const bf16_t* Bt; int M, N, K; };

struct StaticOrder {
    int nM, nN, nwg, G, c;
    __host__ __device__ void init(int M, int N, int G_, int c_) { nM = M / BM; nN = N / BM; nwg = nM * nN; G = G_; c = c_; }
    __host__ __device__ bool next(int i, Unit& u) const {
        const long L = (long)i * G + c; if (L >= nwg) return false;
        int wgid = (int)L; { const int q = nwg / NXCD, r = nwg % NXCD, xcd = wgid % NXCD, off = wgid / NXCD; wgid = (xcd < r ? xcd * (q + 1) : r * (q + 1) + (xcd - r) * q) + off; }
        const int nig = WGM * nN, gid = wgid / nig, fm = gid * WGM, gsz = (nM - fm) < WGM ? (nM - fm) : WGM;
        u.pm = fm + ((wgid % nig) % gsz); u.pn = (wgid % nig) / gsz; return true;
    }
    __device__ __forceinline__ void a_ready(const Unit&) const {}
    __device__ __forceinline__ void done(const Unit&) const {}
};
__device__ __forceinline__ unsigned cvt_pk_bf16(float lo, float hi) { unsigned r; asm volatile("v_cvt_pk_bf16_f32 %0, %1, %2" : "=v"(r) : "v"(lo), "v"(hi)); return r; }
typedef float f32x2 __attribute__((ext_vector_type(2)));
__device__ __forceinline__ f32x2 gelu_pk(f32x2 v) {
    const f32x2 av = __builtin_elementwise_abs(v), d = av * 0.2316418882f + 1.0f;
    f32x2 t; t.x = __builtin_amdgcn_rcpf(d.x); t.y = __builtin_amdgcn_rcpf(d.y);
    f32x2 q = t * 0.5307027145f + (-0.7265760135f); q = q * t + 0.7107068705f; q = q * t + (-0.142248368f); q = q * t + 0.127414796f; q = q * t;
    const f32x2 s = (v * v) * (-0.72134752044f);
    f32x2 e; e.x = __builtin_amdgcn_exp2f(s.x); e.y = __builtin_amdgcn_exp2f(s.y);
    const f32x2 m = v * (q * e), r = v - m;
    f32x2 o; o.x = v.x < 0.f ? m.x : r.x; o.y = v.y < 0.f ? m.y : r.y; return o;
}

struct EpiF32 {
    static constexpr bool PERM = false, AFTER_DRAIN = false;
    float* C; int ldc; const float* bias;
    __device__ __forceinline__ void operator()(const f32x4 (&acc)[2][2][4][2], const Unit& u, int wr, int wc, int fr, int fq) const {
        const int row0 = u.pm * BM + wr * 64 + fr, col0 = u.pn * BM + wc * 32 + 4 * fq;
        f32x4 bv[2][2];
#pragma unroll
        for (int bj = 0; bj < 2; ++bj)
#pragma unroll
            for (int n = 0; n < 2; ++n) bv[bj][n] = bias ? *(const f32x4*)(bias + col0 + bj * HALF + n * 16) : (f32x4){0.f, 0.f, 0.f, 0.f};
#pragma unroll
        for (int ai = 0; ai < 2; ++ai)
#pragma unroll
            for (int m = 0; m < 4; ++m) { float* rowp = C + (size_t)(row0 + ai * HALF + m * 16) * ldc + col0;
#pragma unroll
                for (int bj = 0; bj < 2; ++bj)
#pragma unroll
                    for (int n = 0; n < 2; ++n) *(f32x4*)(rowp + bj * HALF + n * 16) = acc[ai][bj][m][n] + bv[bj][n]; }
    }
};

template <class Epi, class Sched, bool STAMP = false>
__device__ __forceinline__ void gemm_phase(PG8_LAS unsigned char* lds, const Gemm g, const Sched& S, const Epi& E, unsigned long long* stamps) {
    int tid = threadIdx.x; asm volatile("" : "+v"(tid));
    const int wid = __builtin_amdgcn_readfirstlane(tid >> 6), lane = tid & 63, wr = wid >> 2, wc = wid & 3, fr = lane & 15, fq = lane >> 4;
    const int K = g.K, nt = K / BK;
    int ts_lo = 0, ts_hi = 0, nts = 0; const unsigned long long rt_entry = STAMP ? (unsigned long long)wall_clock64() : 0ull;
#define PG8_STAMP() do { if (STAMP && wid == 0 && nts < 64) { const unsigned long long _c = (unsigned long long)clock64(); \
        ts_lo = (lane == nts) ? (int)(unsigned)_c : ts_lo; ts_hi = (lane == nts) ? (int)(unsigned)(_c >> 32) : ts_hi; ++nts; } } while (0)
    PG8_STAMP();
    unsigned voffA[2], voffB[2];
#pragma unroll
    for (int i = 0; i < 2; ++i) { int R, C; stage_rc(tid * 16 + i * 8192, R, C); const int Rb = Epi::PERM ? ((R & ~31) + perm32(R & 31)) : R;
        voffA[i] = (unsigned)(R * K + C) * 2u; voffB[i] = (unsigned)(Rb * K + C) * 2u; }
    const size_t kstep = (size_t)(BK * 2);
    const size_t hstep = (size_t)HALF * K * 2;
    const size_t tstep = 2 * hstep;
    const unsigned ldsw = (unsigned)wid * 1024u;
    const int aoff = lds_byte(wr * 64 + fr, fq * 8), boff = lds_byte(wc * 32 + fr, fq * 8);
#define PG8_SA(b, h) (((b) * 2 + (h)) * HTB)
#define PG8_SB(b, h) ((4 + (b) * 2 + (h)) * HTB)
#define PG8_STAGE(bufoff, gbase, voff) do { _Pragma("unroll") for (int _i = 0; _i < 2; ++_i) \
        __builtin_amdgcn_global_load_lds((const unsigned*)((const char*)(gbase) + (voff)[_i]), (PG8_LAS unsigned*)(lds + (bufoff) + ldsw + _i * 8192), 16, 0, 0); } while (0)
#define PG8_LDA(dst, b, h) do { _Pragma("unroll") for (int m = 0; m < 4; ++m) _Pragma("unroll") for (int k = 0; k < 2; ++k) dst[m][k] = *(const PG8_LAS bf16x8*)(lds + PG8_SA(b, h) + aoff + m * 2048 + k * 1024); } while (0)
#define PG8_LDB(dst, b, h) do { _Pragma("unroll") for (int n = 0; n < 2; ++n) _Pragma("unroll") for (int k = 0; k < 2; ++k) dst[n][k] = *(const PG8_LAS bf16x8*)(lds + PG8_SB(b, h) + boff + n * 2048 + k * 1024); } while (0)
#define PG8_MMA(ai, bj, At, Bt) do { __builtin_amdgcn_s_setprio(1); _Pragma("unroll") for (int m = 0; m < 4; ++m) _Pragma("unroll") for (int n = 0; n < 2; ++n) _Pragma("unroll") for (int k = 0; k < 2; ++k) \
        acc[ai][bj][m][n] = __builtin_amdgcn_mfma_f32_16x16x32_bf16(Bt[n][k], At[m][k], acc[ai][bj][m][n], 0, 0, 0); __builtin_amdgcn_s_setprio(0); } while (0)
#define PG8_WAIT_V(n) asm volatile("s_waitcnt vmcnt(" #n ")" ::: "memory")
#define PG8_WAIT_L(n) asm volatile("s_waitcnt lgkmcnt(" #n ")" ::: "memory")
#define PG8_BAR __builtin_amdgcn_s_barrier()
#define PG8_SCHED __builtin_amdgcn_sched_barrier(0)
    Unit cur, nxt; int ui = 0;
    if (!S.next(0, cur)) return;
    f32x4 acc[2][2][4][2];
#pragma unroll
    for (int a = 0; a < 2; ++a)
#pragma unroll
        for (int b = 0; b < 2; ++b)
#pragma unroll
            for (int m = 0; m < 4; ++m)
#pragma unroll
                for (int n = 0; n < 2; ++n) acc[a][b][m][n] = (f32x4){0.f, 0.f, 0.f, 0.f};
    bf16x8 At[4][2], B0[2][2], B1[2][2];
    const char* cA = (const char*)g.A + (size_t)cur.pm * tstep; const char* cB = (const char*)g.Bt + (size_t)cur.pn * tstep;
    S.a_ready(cur);
    PG8_STAGE(PG8_SB(0, 0), cB, voffB); PG8_STAGE(PG8_SA(0, 0), cA, voffA); PG8_STAGE(PG8_SB(0, 1), cB + hstep, voffB); PG8_STAGE(PG8_SA(0, 1), cA + hstep, voffA);
    if (wr == 1) PG8_BAR;
    PG8_WAIT_V(4); PG8_BAR;
    PG8_STAGE(PG8_SB(1, 0), cB + kstep, voffB); PG8_STAGE(PG8_SA(1, 0), cA + kstep, voffA); PG8_STAGE(PG8_SB(1, 1), cB + hstep + kstep, voffB);
    PG8_WAIT_V(6); PG8_BAR;
    PG8_STAMP();
    for (;;) {
        const bool has_next = S.next(ui + 1, nxt);
        const char* nA = has_next ? (const char*)g.A + (size_t)nxt.pm * tstep : cA; const char* nB = has_next ? (const char*)g.Bt + (size_t)nxt.pn * tstep : cB;
        for (int t = 0; t < nt; t += 2) {
            const bool last = (t == nt - 2);
            const char* a1 = cA + (size_t)(t + 1) * kstep;
            const char* a2 = last ? nA : cA + (size_t)(t + 2) * kstep; const char* b2 = last ? nB : cB + (size_t)(t + 2) * kstep;
            const char* a3 = a2 + kstep; const char* b3 = b2 + kstep;
            if (last && has_next) S.a_ready(nxt);
            PG8_LDB(B0, 0, 0); PG8_SCHED; PG8_LDA(At, 0, 0); PG8_STAGE(PG8_SA(1, 1), a1 + hstep, voffA);
            PG8_WAIT_L(8); PG8_BAR; PG8_WAIT_L(0); PG8_MMA(0, 0, At, B0); PG8_BAR; PG8_SCHED;
            PG8_LDB(B1, 0, 1); PG8_STAGE(PG8_SB(0, 0), b2, voffB);
            PG8_BAR; PG8_WAIT_L(0); PG8_MMA(0, 1, At, B1); PG8_BAR;
            PG8_LDA(At, 0, 1); PG8_STAGE(PG8_SA(0, 0), a2, voffA);
            PG8_BAR; PG8_WAIT_L(0); PG8_MMA(1, 0, At, B0); PG8_BAR; PG8_SCHED;
            PG8_STAGE(PG8_SB(0, 1), b2 + hstep, voffB);
            PG8_WAIT_V(6); PG8_BAR; PG8_MMA(1, 1, At, B1); PG8_BAR;
            PG8_LDB(B0, 1, 0); PG8_SCHED; PG8_LDA(At, 1, 0); PG8_STAGE(PG8_SA(0, 1), a2 + hstep, voffA);
            PG8_WAIT_L(8); PG8_BAR; PG8_WAIT_L(0); PG8_MMA(0, 0, At, B0); PG8_BAR; PG8_SCHED;
            PG8_LDB(B1, 1, 1); PG8_STAGE(PG8_SB(1, 0), b3, voffB);
            PG8_BAR; PG8_WAIT_L(0); PG8_MMA(0, 1, At, B1); PG8_BAR;
            PG8_LDA(At, 1, 1); PG8_STAGE(PG8_SA(1, 0), a3, voffA);
            PG8_BAR; PG8_WAIT_L(0); PG8_MMA(1, 0, At, B0); PG8_BAR; PG8_SCHED;
            PG8_STAGE(PG8_SB(1, 1), b3 + hstep, voffB);
            PG8_WAIT_V(6); PG8_BAR; PG8_MMA(1, 1, At, B1); PG8_BAR;
        }
        PG8_STAMP();
        if constexpr (!Epi::AFTER_DRAIN) { E(acc, cur, wr, wc, fr, fq); S.done(cur); }
        PG8_STAMP();
        if (!has_next) break;
#pragma unroll
        for (int a = 0; a < 2; ++a)
#pragma unroll
            for (int b = 0; b < 2; ++b)
#pragma unroll
                for (int m = 0; m < 4; ++m)
#pragma unroll
                    for (int n = 0; n < 2; ++n) acc[a][b][m][n] = (f32x4){0.f, 0.f, 0.f, 0.f};
        cur = nxt; cA = nA; cB = nB; ++ui;
    }
    PG8_WAIT_V(0);
    if (wr == 0) PG8_BAR;
    PG8_BAR;
    if constexpr (Epi::AFTER_DRAIN) { E.fused(acc, cur, wr, wc, fr, fq, lds, wid, lane); S.done(cur); }
    PG8_STAMP();
    if (STAMP && wid == 0) { stamps[lane] = lane < nts ? (((unsigned long long)(unsigned)ts_hi << 32) | (unsigned)ts_lo) : 0ull;
        if (lane == 62) stamps[62] = rt_entry; if (lane == 63) stamps[63] = (unsigned long long)wall_clock64(); }
#undef PG8_STAMP
#undef PG8_SA
#undef PG8_SB
#undef PG8_STAGE
#undef PG8_LDA
#undef PG8_LDB
#undef PG8_MMA
#undef PG8_WAIT_V
#undef PG8_WAIT_L
#undef PG8_BAR
#undef PG8_SCHED
}
}


namespace pg8 {
struct EpiProj {
    static constexpr bool PERM = true, AFTER_DRAIN = false;
    bf16_t* O; float* dtraw;
    __device__ __forceinline__ void operator()(const f32x4 (&acc)[2][2][4][2], const Unit& u, int wr, int wc, int fr, int fq) const {
        const int row0 = u.pm * BM + wr * 64 + fr;
        if (u.pn < 22) {
            const int col0 = u.pn * BM + wc * 32 + 8 * fq;
#pragma unroll
            for (int ai = 0; ai < 2; ++ai)
#pragma unroll
                for (int m = 0; m < 4; ++m) { bf16_t* rowp = O + (size_t)(row0 + ai * HALF + m * 16) * 5632 + col0;
#pragma unroll
                    for (int bj = 0; bj < 2; ++bj) { const f32x4 v0 = acc[ai][bj][m][0], v1 = acc[ai][bj][m][1];
                        u32x4 w; w.x = cvt_pk_bf16(v0[0], v0[1]); w.y = cvt_pk_bf16(v0[2], v0[3]); w.z = cvt_pk_bf16(v1[0], v1[1]); w.w = cvt_pk_bf16(v1[2], v1[3]);
                        *(u32x4*)(rowp + bj * HALF) = w; } }
        } else if (wc == 0) {
#pragma unroll
            for (int ai = 0; ai < 2; ++ai)
#pragma unroll
                for (int m = 0; m < 4; ++m) { float* rp = dtraw + (size_t)(row0 + ai * HALF + m * 16) * 32 + 8 * fq;
                    *(f32x4*)rp = acc[ai][0][m][0]; *(f32x4*)(rp + 4) = acc[ai][0][m][1]; }
        }
    }
};
}


namespace pg8 {
struct EpiBf16Plain {
    static constexpr bool PERM = true, AFTER_DRAIN = false;
    bf16_t* O; int ldc;
    __device__ __forceinline__ void operator()(const f32x4 (&acc)[2][2][4][2], const Unit& u, int wr, int wc, int fr, int fq) const {
        const int row0 = u.pm * BM + wr * 64 + fr, col0 = u.pn * BM + wc * 32 + 8 * fq;
#pragma unroll
        for (int ai = 0; ai < 2; ++ai)
#pragma unroll
            for (int m = 0; m < 4; ++m) { bf16_t* rowp = O + (size_t)(row0 + ai * HALF + m * 16) * ldc + col0;
#pragma unroll
                for (int bj = 0; bj < 2; ++bj) { const f32x4 v0 = acc[ai][bj][m][0], v1 = acc[ai][bj][m][1];
                    u32x4 w; w.x = cvt_pk_bf16(v0[0], v0[1]); w.y = cvt_pk_bf16(v0[2], v0[3]); w.z = cvt_pk_bf16(v1[0], v1[1]); w.w = cvt_pk_bf16(v1[2], v1[3]);
                    *(u32x4*)(rowp + bj * HALF) = w; } }
    }
};
}

#define NTHR 512
#define NWAVE 8

__device__ __forceinline__ void ph_gemm_f32(float* lds, const float* __restrict__ A, const float* __restrict__ B, float* __restrict__ C,
                                            int M, int N, int K, int lda, int ldb, int ldc) {
    const int tid = threadIdx.x & 255, half = threadIdx.x >> 8, tx = tid & 15, ty = tid >> 4;
    float (*As)[68] = (float (*)[68])(lds + half * 2 * 16 * 68);
    float (*Bs)[68] = (float (*)[68])(lds + half * 2 * 16 * 68 + 16 * 68);
    const int ntx = (N + 63) / 64, nty = M / 64, ntiles = ntx * nty;
    for (int it = blockIdx.x; 2 * it < ntiles; it += gridDim.x) {
        const int tile = 2 * it + half;
        const int m0 = (tile / ntx) * 64, n0 = (tile % ntx) * 64;
        float acc[4][4];
#pragma unroll
        for (int i = 0; i < 4; ++i)
#pragma unroll
            for (int j = 0; j < 4; ++j) acc[i][j] = 0.f;
        for (int k0 = 0; k0 < K; k0 += 16) {
#pragma unroll
            for (int i = 0; i < 4; ++i) {
                int idx = tid + i * 256;
                int r = idx >> 4, c = idx & 15;
                As[c][r] = (m0 + r < M) ? A[(size_t)(m0 + r) * lda + k0 + c] : 0.f;
                int rb = idx >> 6, cb = idx & 63;
                Bs[rb][cb] = (n0 + cb < N) ? B[(size_t)(k0 + rb) * ldb + n0 + cb] : 0.f;
            }
            __syncthreads();
#pragma unroll
            for (int k = 0; k < 16; ++k) {
                float a[4], b[4];
#pragma unroll
                for (int i = 0; i < 4; ++i) { a[i] = As[k][ty * 4 + i]; b[i] = Bs[k][tx * 4 + i]; }
#pragma unroll
                for (int i = 0; i < 4; ++i)
#pragma unroll
                    for (int j = 0; j < 4; ++j) acc[i][j] += a[i] * b[j];
            }
            __syncthreads();
        }
#pragma unroll
        for (int i = 0; i < 4; ++i)
#pragma unroll
            for (int j = 0; j < 4; ++j) {
                int r = m0 + ty * 4 + i, c = n0 + tx * 4 + j;
                if (r < M && c < N) C[(size_t)r * ldc + c] = acc[i][j];
            }
    }
}


template <int MODE>
__device__ __forceinline__ void transpose_item(const float* __restrict__ W, int K, int N, int Npad, bf16* __restrict__ WT, LAS float* scr, int item, int lane) {
    const int nblk = Npad / 32, kb = item / nblk, nb = item % nblk, k0 = 64 * kb, n0 = 32 * nb;
    const int n = n0 + (lane & 31);
    int sc = n;
    if (MODE == 1) sc = (n < 4096) ? n : (n < 5632 ? n + 24 : (n < 5656 ? n - 5632 + 4096 : -1));
    else sc = (n < N) ? n : -1;
#pragma unroll 8
    for (int i = 0; i < 32; ++i) { const int kk = 2 * i + (lane >> 5); scr[kk * 33 + (lane & 31)] = (sc >= 0) ? W[(size_t)(k0 + kk) * N + sc] : 0.f; }
    LDS_WAIT(); asm volatile("" ::: "memory");
    const int c = lane & 7;
#pragma unroll
    for (int j = 0; j < 4; ++j) { const int nn = (lane >> 3) + 8 * j; const LAS float* s = scr + (8 * c) * 33 + nn;
        v4u o; o.x = pk2(s[0 * 33], s[1 * 33]); o.y = pk2(s[2 * 33], s[3 * 33]); o.z = pk2(s[4 * 33], s[5 * 33]); o.w = pk2(s[6 * 33], s[7 * 33]);
        *(v4u*)(WT + (size_t)(n0 + nn) * K + k0 + 8 * c) = o; }
    LDS_WAIT(); asm volatile("" ::: "memory");
}
__device__ __forceinline__ void ph_prologue(LAS unsigned char* ldsb, const float* __restrict__ xp, const float* __restrict__ xs, bf16* __restrict__ A0,
                                            const float* __restrict__ w_in, bf16* __restrict__ wt_in, float* __restrict__ rope_tab) {
    const int lane = threadIdx.x & 63, wave = threadIdx.x >> 6;
    LAS float* scr = (LAS float*)(ldsb + wave * 16384);
    const int gw = blockIdx.x * NWAVE + wave, NGW = gridDim.x * NWAVE;
    constexpr int I_IN = (D_MODEL / 64) * (PROJ_LD / 32);
    for (int it = gw; it < I_IN; it += NGW) transpose_item<1>(w_in, D_MODEL, IN_WIDTH, PROJ_LD, wt_in, scr, it, lane);
    for (int idx = blockIdx.x * NTHR + threadIdx.x; idx < SEQ * 32; idx += gridDim.x * NTHR) {
        const int pos = idx >> 5, j = idx & 31;
        const double rev = (double)pos * ROPE_INV_REV[j];
        const float fr = (float)(rev - floor(rev));
        rope_tab[(size_t)pos * 64 + j] = __builtin_amdgcn_cosf(fr); rope_tab[(size_t)pos * 64 + 32 + j] = __builtin_amdgcn_sinf(fr);
    }
    const size_t n8 = (size_t)T_ALL * D_MODEL / 8, np8 = (size_t)T_PROMPT * D_MODEL / 8;
#pragma unroll 4
    for (size_t i = (size_t)blockIdx.x * NTHR + threadIdx.x; i < n8; i += (size_t)gridDim.x * NTHR) {
        const float4* s = (i < np8) ? (const float4*)xp + 2 * i : (const float4*)xs + 2 * (i - np8);
        float4 a = s[0], b = s[1];
        v4u o; o.x = pk2(a.x, a.y); o.y = pk2(a.z, a.w); o.z = pk2(b.x, b.y); o.w = pk2(b.z, b.w);
        ((v4u*)A0)[i] = o;
    }
}
__device__ __forceinline__ void ph_prologue2(LAS unsigned char* ldsb, const float* __restrict__ w_out, bf16* __restrict__ wt_out, const float* __restrict__ w_q, bf16* __restrict__ wt_q,
                                             int rank, int nranks) {
    const int lane = threadIdx.x & 63, wave = threadIdx.x >> 6;
    LAS float* scr = (LAS float*)(ldsb + wave * 16384);
    constexpr int I_OUT = (MIX_WIDTH / 64) * (D_MODEL / 32), I_Q = (D_MODEL / 64) * (2048 / 32);
    for (int it = rank * NWAVE + wave; it < I_OUT + I_Q; it += nranks * NWAVE) {
        if (it < I_OUT) transpose_item<0>(w_out, MIX_WIDTH, D_MODEL, D_MODEL, wt_out, scr, it, lane);
        else transpose_item<0>(w_q, D_MODEL, 2048, 2048, wt_q, scr, it - I_OUT, lane);
    }
}

__device__ __forceinline__ void ph_concat_x(const float* __restrict__ xp, const float* __restrict__ xs, float* __restrict__ xall) {
    const size_t n4 = (size_t)T_ALL * D_MODEL / 4, np4 = (size_t)T_PROMPT * D_MODEL / 4;
    for (size_t i = (size_t)blockIdx.x * NTHR + threadIdx.x; i < n4; i += (size_t)gridDim.x * NTHR) {
        float4 v = (i < np4) ? ((const float4*)xp)[i] : ((const float4*)xs)[i - np4];
        ((float4*)xall)[i] = v;
    }
}

typedef float f32x4n __attribute__((ext_vector_type(4)));
__device__ __forceinline__ void ph_cache_copy(const float* __restrict__ ck, const float* __restrict__ cv, float* __restrict__ out) {
    constexpr unsigned PER_B = (WBUF - DEC_SEQ) * ATT_WIDTH / 4;
    constexpr unsigned TOTAL = 2u * DEC_BATCH * PER_B;
    for (unsigned c = blockIdx.x; c < TOTAL / 4096u; c += gridDim.x) {
        f32x4n v[8]; size_t dsti[8]; bool isv[8];
#pragma unroll
        for (int j = 0; j < 8; ++j) {
            const unsigned idx = c * 4096u + j * 512u + threadIdx.x;
            const unsigned tb = idx / PER_B, r = idx - tb * PER_B, bb = tb & (DEC_BATCH - 1);
            isv[j] = tb >= DEC_BATCH;
            const size_t srci = (size_t)bb * (WBUF * ATT_WIDTH / 4) + (DEC_SEQ * ATT_WIDTH / 4) + r;
            dsti[j] = (size_t)bb * (WBUF * ATT_WIDTH / 4) + r;
            v[j] = __builtin_nontemporal_load((isv[j] ? (const f32x4n*)cv : (const f32x4n*)ck) + srci);
        }
#pragma unroll
        for (int j = 0; j < 8; ++j) __builtin_nontemporal_store(v[j], (f32x4n*)(out + (isv[j] ? OUT_SV : OUT_SK)) + dsti[j]);
    }
}

__device__ __forceinline__ void ph_post_proj(const float* __restrict__ proj, const float* __restrict__ state_conv,
                                             const float* __restrict__ conv_w, const float* __restrict__ conv_b, const float* __restrict__ dt_bias,
                                             float* __restrict__ xbc_act, float* __restrict__ dtv, float* __restrict__ qrot, float* __restrict__ krot,
                                             float* __restrict__ out) {
    const int tid = threadIdx.x & 255, half = threadIdx.x >> 8;
    for (int t = 2 * blockIdx.x + half; t < T_ALL; t += 2 * gridDim.x) {
        const bool is_p = t < T_PROMPT;
        int b, i, pos;
        if (is_p) { b = t / SEQ; i = t % SEQ; pos = i; } else { int ts = t - T_PROMPT; b = ts / DEC_SEQ; i = ts % DEC_SEQ; pos = PAST_LEN + i; }
        const float* row = proj + (size_t)t * PROJ_LD;
        for (int c = tid; c < CONV_DIM; c += 256) {
            float acc = conv_b[c];
#pragma unroll
            for (int tap = 0; tap < 4; ++tap) {
                int r = i - 3 + tap;
                float val;
                if (r >= 0) val = proj[(size_t)(t - i + r) * PROJ_LD + O_XBC + c];
                else val = is_p ? 0.f : state_conv[((size_t)b * 3 + (3 + r)) * CONV_DIM + c];
                acc += val * conv_w[tap * CONV_DIM + c];
            }
            xbc_act[(size_t)t * CONV_DIM + c] = silu_f(acc);
        }
        if (tid < SSD_HEADS) dtv[(size_t)t * SSD_HEADS + tid] = softplus_f(row[O_DT + tid] + dt_bias[tid]);
        for (int idx = tid; idx < 512; idx += 256) {
            int which = idx >> 8, h = (idx >> 5) & 7, j = idx & 31;
            double rev = (double)pos * ROPE_INV_REV[j];
            float fr = (float)(rev - floor(rev));
            float sn = __builtin_amdgcn_sinf(fr), cs = __builtin_amdgcn_cosf(fr);
            const float* src = row + (which ? O_K : O_Q) + h * 64;
            float t1 = src[j], t2 = src[j + 32];
            float o1 = t1 * cs - t2 * sn, o2 = t2 * cs + t1 * sn;
            float* dst = (which ? krot : qrot) + (size_t)t * ATT_WIDTH + h * 64;
            dst[j] = o1; dst[j + 32] = o2;
            if (which) {
                if (is_p) { if (i >= SEQ - WBUF) { float* o = out + OUT_PK + ((size_t)b * WBUF + (i - (SEQ - WBUF))) * ATT_WIDTH + h * 64; o[j] = o1; o[j + 32] = o2; } }
                else { float* o = out + OUT_SK + ((size_t)b * WBUF + (WBUF - DEC_SEQ + i)) * ATT_WIDTH + h * 64; o[j] = o1; o[j + 32] = o2; }
            }
        }
        for (int c = tid; c < ATT_WIDTH; c += 256) {
            float v = row[O_V + c];
            if (is_p) { if (i >= SEQ - WBUF) out[OUT_PV + ((size_t)b * WBUF + (i - (SEQ - WBUF))) * ATT_WIDTH + c] = v; }
            else out[OUT_SV + ((size_t)b * WBUF + (WBUF - DEC_SEQ + i)) * ATT_WIDTH + c] = v;
        }
        if (is_p) {
            if (i >= SEQ - 3) { int r = i - (SEQ - 3); for (int c = tid; c < CONV_DIM; c += 256) out[OUT_PC + ((size_t)b * 3 + r) * CONV_DIM + c] = row[O_XBC + c]; }
        } else {
            if (i >= 1) { int r = i - 1; for (int c = tid; c < CONV_DIM; c += 256) out[OUT_SC + ((size_t)b * 3 + r) * CONV_DIM + c] = row[O_XBC + c]; }
        }
    }
}


#define NB_LD 5632
#define NB_XBC 1536
#define NB_Q 4096
#define NB_K 4608
#define NB_V 5120
__device__ __forceinline__ void unpack8(const v4u w, float (&f)[8]) {
    f[0] = __builtin_bit_cast(float, w.x << 16); f[1] = __builtin_bit_cast(float, w.x & 0xffff0000u);
    f[2] = __builtin_bit_cast(float, w.y << 16); f[3] = __builtin_bit_cast(float, w.y & 0xffff0000u);
    f[4] = __builtin_bit_cast(float, w.z << 16); f[5] = __builtin_bit_cast(float, w.z & 0xffff0000u);
    f[6] = __builtin_bit_cast(float, w.w << 16); f[7] = __builtin_bit_cast(float, w.w & 0xffff0000u);
}
__device__ __forceinline__ void store8f(float* d, const float (&f)[8]) { *(float4*)d = make_float4(f[0], f[1], f[2], f[3]); *(float4*)(d + 4) = make_float4(f[4], f[5], f[6], f[7]); }
__device__ __forceinline__ void ph_post_proj2(const bf16* __restrict__ projb, const float* __restrict__ dtraw, const float* __restrict__ state_conv,
                                              const float* __restrict__ conv_w, const float* __restrict__ conv_b, const float* __restrict__ dt_bias,
                                              bf16* __restrict__ xbc_b, float* __restrict__ dtv, bf16* __restrict__ qrot_b, bf16* __restrict__ krot_b,
                                              float* __restrict__ out) {
    const int tid = threadIdx.x & 255, half = threadIdx.x >> 8;
    for (int t = T_PROMPT + 2 * blockIdx.x + half; t < T_ALL; t += 2 * gridDim.x) {
        const bool is_p = t < T_PROMPT;
        int b, i, pos;
        if (is_p) { b = t / SEQ; i = t % SEQ; pos = i; } else { int ts = t - T_PROMPT; b = ts / DEC_SEQ; i = ts % DEC_SEQ; pos = PAST_LEN + i; }
        const bf16* row = projb + (size_t)t * NB_LD;
        if (tid < 64) {
            float f[8]; unpack8(*(const v4u*)(row + NB_V + tid * 8), f);
            if (is_p) { if (i >= SEQ - WBUF) store8f(out + OUT_PV + ((size_t)b * WBUF + (i - (SEQ - WBUF))) * ATT_WIDTH + tid * 8, f); }
            else store8f(out + OUT_SV + ((size_t)b * WBUF + (WBUF - DEC_SEQ + i)) * ATT_WIDTH + tid * 8, f);
        }
        for (int c8 = tid; c8 < 320; c8 += 256) {
            const int c = c8 * 8;
            float acc[8], cur[8];
            { const float4 b0 = *(const float4*)(conv_b + c), b1 = *(const float4*)(conv_b + c + 4);
              acc[0] = b0.x; acc[1] = b0.y; acc[2] = b0.z; acc[3] = b0.w; acc[4] = b1.x; acc[5] = b1.y; acc[6] = b1.z; acc[7] = b1.w; }
#pragma unroll
            for (int tap = 0; tap < 4; ++tap) {
                const int r = i - 3 + tap;
                float val[8];
                if (r >= 0) unpack8(*(const v4u*)(projb + (size_t)(t - i + r) * NB_LD + NB_XBC + c), val);
                else if (!is_p) { const float* sp = state_conv + ((size_t)b * 3 + (3 + r)) * CONV_DIM + c; const float4 s0 = *(const float4*)sp, s1 = *(const float4*)(sp + 4);
                    val[0] = s0.x; val[1] = s0.y; val[2] = s0.z; val[3] = s0.w; val[4] = s1.x; val[5] = s1.y; val[6] = s1.z; val[7] = s1.w; }
                else {
#pragma unroll
                    for (int j = 0; j < 8; ++j) val[j] = 0.f; }
                const float4 w0 = *(const float4*)(conv_w + tap * CONV_DIM + c), w1 = *(const float4*)(conv_w + tap * CONV_DIM + c + 4);
                acc[0] += val[0] * w0.x; acc[1] += val[1] * w0.y; acc[2] += val[2] * w0.z; acc[3] += val[3] * w0.w;
                acc[4] += val[4] * w1.x; acc[5] += val[5] * w1.y; acc[6] += val[6] * w1.z; acc[7] += val[7] * w1.w;
                if (tap == 3) {
#pragma unroll
                    for (int j = 0; j < 8; ++j) cur[j] = val[j]; }
            }
#pragma unroll
            for (int j = 0; j < 8; ++j) acc[j] = silu_f(acc[j]);
            v4u o; o.x = pk2(acc[0], acc[1]); o.y = pk2(acc[2], acc[3]); o.z = pk2(acc[4], acc[5]); o.w = pk2(acc[6], acc[7]);
            *(v4u*)(xbc_b + (size_t)t * CONV_DIM + c) = o;
            if (is_p) { if (i >= SEQ - 3) store8f(out + OUT_PC + ((size_t)b * 3 + (i - (SEQ - 3))) * CONV_DIM + c, cur); }
            else { if (i >= 1) store8f(out + OUT_SC + ((size_t)b * 3 + (i - 1)) * CONV_DIM + c, cur); }
        }
        if (tid < SSD_HEADS) dtv[(size_t)t * SSD_HEADS + tid] = softplus_f(dtraw[(size_t)t * 32 + tid] + dt_bias[tid]);
        if (tid < 128) {
            const int which = tid >> 6, h = (tid >> 3) & 7, jc = tid & 7;
            const bf16* src = row + (which ? NB_K : NB_Q) + h * 64 + jc * 4;
            const uint2 lo = *(const uint2*)src, hi = *(const uint2*)(src + 32);
            float t1[4], t2[4], o1[4], o2[4];
            t1[0] = __builtin_bit_cast(float, lo.x << 16); t1[1] = __builtin_bit_cast(float, lo.x & 0xffff0000u); t1[2] = __builtin_bit_cast(float, lo.y << 16); t1[3] = __builtin_bit_cast(float, lo.y & 0xffff0000u);
            t2[0] = __builtin_bit_cast(float, hi.x << 16); t2[1] = __builtin_bit_cast(float, hi.x & 0xffff0000u); t2[2] = __builtin_bit_cast(float, hi.y << 16); t2[3] = __builtin_bit_cast(float, hi.y & 0xffff0000u);
#pragma unroll
            for (int e = 0; e < 4; ++e) {
                const double rev = (double)pos * ROPE_INV_REV[jc * 4 + e];
                const float fr = (float)(rev - floor(rev));
                const float sn = __builtin_amdgcn_sinf(fr), cs = __builtin_amdgcn_cosf(fr);
                o1[e] = t1[e] * cs - t2[e] * sn; o2[e] = t2[e] * cs + t1[e] * sn;
            }
            const size_t doff = (size_t)t * ATT_WIDTH + h * 64 + jc * 4;
            bf16* db = which ? krot_b : qrot_b;
            *(uint2*)(db + doff) = make_uint2(pk2(o1[0], o1[1]), pk2(o1[2], o1[3])); *(uint2*)(db + doff + 32) = make_uint2(pk2(o2[0], o2[1]), pk2(o2[2], o2[3]));
            if (which) {
                float* o = nullptr;
                if (is_p) { if (i >= SEQ - WBUF) o = out + OUT_PK + ((size_t)b * WBUF + (i - (SEQ - WBUF))) * ATT_WIDTH + h * 64 + jc * 4; }
                else o = out + OUT_SK + ((size_t)b * WBUF + (WBUF - DEC_SEQ + i)) * ATT_WIDTH + h * 64 + jc * 4;
                if (o) { *(float4*)o = make_float4(o1[0], o1[1], o1[2], o1[3]); *(float4*)(o + 32) = make_float4(o2[0], o2[1], o2[2], o2[3]); }
            }
        }
    }
}


__device__ __forceinline__ void ph_post_proj_prompt(const bf16* __restrict__ projb, const float* __restrict__ dtraw, const float* __restrict__ conv_w, const float* __restrict__ conv_b,
                                                    const float* __restrict__ dt_bias, const float* __restrict__ rope_tab, bf16* __restrict__ xbc_b, float* __restrict__ dtv,
                                                    bf16* __restrict__ qrot_b, bf16* __restrict__ krot_b, float* __restrict__ out) {
    const int gtid = blockIdx.x * NTHR + threadIdx.x, gsz = gridDim.x * NTHR;
    for (int item = gtid; item < (T_PROMPT / 16) * 320; item += gsz) {
        const int run = item / 320, c = (item - run * 320) * 8, t0 = run * 16, i0 = t0 & (SEQ - 1), b = t0 >> 13;
        float w[4][8], bias[8];
#pragma unroll
        for (int tap = 0; tap < 4; ++tap) { const float4 w0 = *(const float4*)(conv_w + tap * CONV_DIM + c), w1 = *(const float4*)(conv_w + tap * CONV_DIM + c + 4);
            w[tap][0] = w0.x; w[tap][1] = w0.y; w[tap][2] = w0.z; w[tap][3] = w0.w; w[tap][4] = w1.x; w[tap][5] = w1.y; w[tap][6] = w1.z; w[tap][7] = w1.w; }
        { const float4 b0 = *(const float4*)(conv_b + c), b1 = *(const float4*)(conv_b + c + 4);
          bias[0] = b0.x; bias[1] = b0.y; bias[2] = b0.z; bias[3] = b0.w; bias[4] = b1.x; bias[5] = b1.y; bias[6] = b1.z; bias[7] = b1.w; }
        const bf16* src = projb + (size_t)t0 * NB_LD + NB_XBC + c;
        v4u raw[19];
#pragma unroll
        for (int s = 0; s < 19; ++s) { v4u z; z.x = 0u; z.y = 0u; z.z = 0u; z.w = 0u; raw[s] = (s >= 3 || i0 != 0) ? *(const v4u*)(src + (ptrdiff_t)(s - 3) * NB_LD) : z; }
        float p0[8], p1[8], p2[8];
        unpack8(raw[0], p0); unpack8(raw[1], p1); unpack8(raw[2], p2);
#pragma unroll
        for (int s = 0; s < 16; ++s) {
            float cur[8], acc[8]; unpack8(raw[s + 3], cur);
#pragma unroll
            for (int j = 0; j < 8; ++j) acc[j] = silu_f(bias[j] + p0[j] * w[0][j] + p1[j] * w[1][j] + p2[j] * w[2][j] + cur[j] * w[3][j]);
            v4u o; o.x = pk2(acc[0], acc[1]); o.y = pk2(acc[2], acc[3]); o.z = pk2(acc[4], acc[5]); o.w = pk2(acc[6], acc[7]);
            *(v4u*)(xbc_b + (size_t)(t0 + s) * CONV_DIM + c) = o;
            if (i0 + s >= SEQ - 3) store8f(out + OUT_PC + ((size_t)b * 3 + (i0 + s - (SEQ - 3))) * CONV_DIM + c, cur);
#pragma unroll
            for (int j = 0; j < 8; ++j) { p0[j] = p1[j]; p1[j] = p2[j]; p2[j] = cur[j]; }
        }
    }
#pragma unroll 4
    for (int item = gtid; item < T_PROMPT * 128; item += gsz) {
        const int t = item >> 7, sub = item & 127, which = sub >> 6, h = (sub >> 3) & 7, jc = sub & 7, i = t & (SEQ - 1), b = t >> 13;
        const bf16* src = projb + (size_t)t * NB_LD + (which ? NB_K : NB_Q) + h * 64 + jc * 4;
        const uint2 lo = *(const uint2*)src, hi = *(const uint2*)(src + 32);
        const float4 cs = *(const float4*)(rope_tab + (size_t)i * 64 + jc * 4), sn = *(const float4*)(rope_tab + (size_t)i * 64 + 32 + jc * 4);
        float t1[4], t2[4], o1[4], o2[4];
        t1[0] = __builtin_bit_cast(float, lo.x << 16); t1[1] = __builtin_bit_cast(float, lo.x & 0xffff0000u); t1[2] = __builtin_bit_cast(float, lo.y << 16); t1[3] = __builtin_bit_cast(float, lo.y & 0xffff0000u);
        t2[0] = __builtin_bit_cast(float, hi.x << 16); t2[1] = __builtin_bit_cast(float, hi.x & 0xffff0000u); t2[2] = __builtin_bit_cast(float, hi.y << 16); t2[3] = __builtin_bit_cast(float, hi.y & 0xffff0000u);
        const float cv[4] = {cs.x, cs.y, cs.z, cs.w}, sv[4] = {sn.x, sn.y, sn.z, sn.w};
#pragma unroll
        for (int e = 0; e < 4; ++e) { o1[e] = t1[e] * cv[e] - t2[e] * sv[e]; o2[e] = t2[e] * cv[e] + t1[e] * sv[e]; }
        const size_t doff = (size_t)t * ATT_WIDTH + h * 64 + jc * 4;
        bf16* db = which ? krot_b : qrot_b;
        *(uint2*)(db + doff) = make_uint2(pk2(o1[0], o1[1]), pk2(o1[2], o1[3])); *(uint2*)(db + doff + 32) = make_uint2(pk2(o2[0], o2[1]), pk2(o2[2], o2[3]));
        if (which && i >= SEQ - WBUF) {
            float* o = out + OUT_PK + ((size_t)b * WBUF + (i - (SEQ - WBUF))) * ATT_WIDTH + h * 64 + jc * 4;
            *(float4*)o = make_float4(o1[0], o1[1], o1[2], o1[3]); *(float4*)(o + 32) = make_float4(o2[0], o2[1], o2[2], o2[3]);
        }
    }
#pragma unroll 4
    for (int item = gtid; item < T_PROMPT * SSD_HEADS; item += gsz) { const int t = item / SSD_HEADS, hd = item - t * SSD_HEADS; dtv[item] = softplus_f(dtraw[(size_t)t * 32 + hd] + dt_bias[hd]); }
#pragma unroll 2
    for (int item = gtid; item < BATCH * WBUF * 64; item += gsz) {
        const int ch = item & 63, j = (item >> 6) & (WBUF - 1), b = item >> 17;
        float f[8]; unpack8(*(const v4u*)(projb + (size_t)(b * SEQ + (SEQ - WBUF) + j) * NB_LD + NB_V + ch * 8), f);
        store8f(out + OUT_PV + ((size_t)b * WBUF + j) * ATT_WIDTH + ch * 8, f);
    }
}

#define SSD_CH 32
__device__ __forceinline__ void ph_ssd_naive(float* lds, const bf16* __restrict__ xbc_act, const float* __restrict__ dtv, const float* __restrict__ a_log,
                                             const float* __restrict__ d_skip, const float* __restrict__ state_ssm, float* __restrict__ ybuf, float* __restrict__ out) {
    float (*sx)[64] = (float (*)[64])lds;
    float (*sB)[128] = (float (*)[128])(lds + SSD_CH * 64);
    float (*sC)[128] = (float (*)[128])(lds + SSD_CH * 64 + SSD_CH * 128);
    float* sdt = lds + SSD_CH * 64 + 2 * SSD_CH * 128;
    const int tid = threadIdx.x, p = tid >> 3, ng = tid & 7;
    for (int vb = BATCH * SSD_HEADS + blockIdx.x; vb < (BATCH + DEC_BATCH) * SSD_HEADS; vb += gridDim.x) {
        const int seq = vb / SSD_HEADS, h = vb % SSD_HEADS, g = h / 6;
        const bool is_p = seq < BATCH;
        const int L = is_p ? SEQ : DEC_SEQ;
        const int t0 = is_p ? seq * SEQ : T_PROMPT + (seq - BATCH) * DEC_SEQ;
        const float A = -__expf(a_log[h]);
        const float D = d_skip[h];
        float hs[16];
        if (is_p) {
#pragma unroll
            for (int j = 0; j < 16; ++j) hs[j] = 0.f;
        } else {
            const float* s0 = state_ssm + (((size_t)(seq - BATCH) * SSD_HEADS + h) * 64 + p) * 128 + ng * 16;
#pragma unroll
            for (int j = 0; j < 16; ++j) hs[j] = s0[j];
        }
        for (int c0 = 0; c0 < L; c0 += SSD_CH) {
            const int nst = (L - c0) < SSD_CH ? (L - c0) : SSD_CH;
            __syncthreads();
            for (int idx = tid; idx < nst * 64; idx += NTHR) { int s = idx >> 6, c = idx & 63; sx[s][c] = bf2f(xbc_act[(size_t)(t0 + c0 + s) * CONV_DIM + h * 64 + c]); }
            for (int idx = tid; idx < nst * 128; idx += NTHR) { int s = idx >> 7, c = idx & 127;
                sB[s][c] = bf2f(xbc_act[(size_t)(t0 + c0 + s) * CONV_DIM + 1536 + g * 128 + c]);
                sC[s][c] = bf2f(xbc_act[(size_t)(t0 + c0 + s) * CONV_DIM + 2048 + g * 128 + c]); }
            if (tid < nst) sdt[tid] = dtv[(size_t)(t0 + c0 + tid) * SSD_HEADS + h];
            __syncthreads();
            for (int s = 0; s < nst; ++s) {
                const float dt = sdt[s], x = sx[s][p];
                const float a = __expf(dt * A), xdt = x * dt;
                float y = 0.f;
#pragma unroll
                for (int j = 0; j < 16; ++j) { hs[j] = a * hs[j] + xdt * sB[s][ng * 16 + j]; y += sC[s][ng * 16 + j] * hs[j]; }
                y += __shfl_xor(y, 1); y += __shfl_xor(y, 2); y += __shfl_xor(y, 4);
                if (ng == 0) ybuf[(size_t)(t0 + c0 + s) * MIX_WIDTH + h * 64 + p] = y + D * x;
            }
        }
        float* so = is_p ? out + OUT_PS + (((size_t)seq * SSD_HEADS + h) * 64 + p) * 128 + ng * 16
                         : out + OUT_SS + (((size_t)(seq - BATCH) * SSD_HEADS + h) * 64 + p) * 128 + ng * 16;
#pragma unroll
        for (int j = 0; j < 16; ++j) so[j] = hs[j];
    }
}

__device__ __forceinline__ void ph_gate_norm(const bf16* __restrict__ projb, const float* __restrict__ norm_g, const float* __restrict__ ybuf, bf16* __restrict__ A1) {
    const int w = threadIdx.x >> 6, lane = threadIdx.x & 63, g = w & 3;
    for (int t = T_PROMPT + 2 * blockIdx.x + (w >> 2); t < T_ALL; t += 2 * gridDim.x) {
        float v[6]; float ss = 0.f;
#pragma unroll
        for (int j = 0; j < 6; ++j) {
            int c = g * 384 + j * 64 + lane;
            float y = ybuf[(size_t)t * MIX_WIDTH + c], z = bf2f(projb[(size_t)t * NB_LD + c]);
            v[j] = y * silu_f(z); ss += v[j] * v[j];
        }
        ss = wave_sum(ss);
        const float r = rsqrtf(ss * (1.0f / 384.0f) + LN_EPS);
#pragma unroll
        for (int j = 0; j < 6; ++j) { int c = g * 384 + j * 64 + lane; A1[(size_t)t * MIX_WIDTH + c] = (bf16)f2bf(v[j] * r * norm_g[c]); }
    }
}

__device__ __forceinline__ void ph_attn_naive(float* lds, const float* __restrict__ proj, const float* __restrict__ qrot, const float* __restrict__ krot,
                                              const float* __restrict__ ck, const float* __restrict__ cv, float* __restrict__ ybuf) {
    float (*sq)[64] = (float (*)[64])lds;
    const int w = threadIdx.x >> 6, lane = threadIdx.x & 63;
    for (int vb = blockIdx.x; vb < T_SAMPLE * 8 / NWAVE; vb += gridDim.x) {
        const int item = T_PROMPT * 8 + vb * NWAVE + w;
        const int t = item >> 3, h = item & 7;
        const bool is_p = t < T_PROMPT;
        int b, i;
        if (is_p) { b = t / SEQ; i = t % SEQ; } else { int ts = t - T_PROMPT; b = ts / DEC_SEQ; i = ts % DEC_SEQ; }
        __syncthreads();
        sq[w][lane] = qrot[(size_t)t * ATT_WIDTH + h * 64 + lane];
        __syncthreads();
        const int qi = is_p ? i : WBUF + i;
        float sc[3][3];
        float mx = -INFINITY;
#pragma unroll
        for (int pt = 0; pt < 3; ++pt) {
            const int d = pt == 0 ? 1 : (pt == 1 ? 4 : 16);
#pragma unroll
            for (int sl = 0; sl < 3; ++sl) {
                const int m = lane + sl * 64;
                float s = -INFINITY;
                const int kj = qi - d * m;
                if (m <= 128 && kj >= 0) {
                    const float* kr;
                    if (is_p) kr = krot + (size_t)(b * SEQ + kj) * ATT_WIDTH + h * 64;
                    else kr = (kj >= WBUF) ? krot + (size_t)(T_PROMPT + b * DEC_SEQ + (kj - WBUF)) * ATT_WIDTH + h * 64
                                           : ck + ((size_t)b * WBUF + kj) * ATT_WIDTH + h * 64;
                    float a = 0.f;
#pragma unroll
                    for (int c = 0; c < 64; c += 4) { float4 kv = *(const float4*)(kr + c); a += kv.x * sq[w][c] + kv.y * sq[w][c + 1] + kv.z * sq[w][c + 2] + kv.w * sq[w][c + 3]; }
                    s = a * 0.125f;
                }
                sc[pt][sl] = s; mx = fmaxf(mx, s);
            }
        }
        mx = wave_max(mx);
        float lsum = 0.f;
#pragma unroll
        for (int pt = 0; pt < 3; ++pt)
#pragma unroll
            for (int sl = 0; sl < 3; ++sl) { float pv = (sc[pt][sl] == -INFINITY) ? 0.f : __expf(sc[pt][sl] - mx); sc[pt][sl] = pv; lsum += pv; }
        lsum = wave_sum(lsum);
        float o = 0.f;
#pragma unroll
        for (int pt = 0; pt < 3; ++pt) {
            const int d = pt == 0 ? 1 : (pt == 1 ? 4 : 16);
#pragma unroll
            for (int sl = 0; sl < 3; ++sl) {
                const int mend = sl < 2 ? 64 : 1;
                for (int ml = 0; ml < mend; ++ml) {
                    const int m = ml + sl * 64;
                    const int kj = qi - d * m;
                    const float pv = __shfl(sc[pt][sl], ml);
                    if (kj < 0) continue;
                    const float* vr;
                    if (is_p) vr = proj + (size_t)(b * SEQ + kj) * PROJ_LD + O_V + h * 64;
                    else vr = (kj >= WBUF) ? proj + (size_t)(T_PROMPT + b * DEC_SEQ + (kj - WBUF)) * PROJ_LD + O_V + h * 64
                                           : cv + ((size_t)b * WBUF + kj) * ATT_WIDTH + h * 64;
                    o += pv * vr[lane];
                }
            }
        }
        ybuf[(size_t)t * MIX_WIDTH + SSD_WIDTH + h * 64 + lane] = o / lsum;
    }
}

__device__ __forceinline__ int token_of_iter(int k) {
    const int w = __builtin_amdgcn_readfirstlane(threadIdx.x >> 6), wgl = blockIdx.x * NWAVE + w;
    if (gridDim.x != 256) { const int t = wgl + k * (int)(gridDim.x * NWAVE); return t < T_ALL ? t : -1; }
    if (k < 8) return k * 2048 + wgl;
    if (k == 8 && w < 2) return 16384 + w * 256 + (int)blockIdx.x;
    return -1;
}
__device__ __forceinline__ void ph_ln_res(const bf16* __restrict__ xb, const bf16* __restrict__ add, const float* __restrict__ gam,
                                          const float* __restrict__ bet, bf16* __restrict__ dstb) {
    const int lane = threadIdx.x & 63;
#pragma unroll 2
    for (int k = 0;; ++k) {
        const int t = token_of_iter(k);
        if (t < 0) break;
        const bf16* res = xb + (size_t)t * D_MODEL;
        float v[16]; float s = 0.f;
#pragma unroll
        for (int j = 0; j < 2; ++j) { const int c = j * 512 + lane * 8; float r8[8]; unpack8(*(const v4u*)(res + c), r8);
            const float4 r0 = make_float4(r8[0], r8[1], r8[2], r8[3]), r1 = make_float4(r8[4], r8[5], r8[6], r8[7]);
            float a8[8]; unpack8(*(const v4u*)(add + (size_t)t * D_MODEL + c), a8);
            v[8 * j] = ALPHA_F * r0.x + a8[0]; v[8 * j + 1] = ALPHA_F * r0.y + a8[1]; v[8 * j + 2] = ALPHA_F * r0.z + a8[2]; v[8 * j + 3] = ALPHA_F * r0.w + a8[3];
            v[8 * j + 4] = ALPHA_F * r1.x + a8[4]; v[8 * j + 5] = ALPHA_F * r1.y + a8[5]; v[8 * j + 6] = ALPHA_F * r1.z + a8[6]; v[8 * j + 7] = ALPHA_F * r1.w + a8[7]; }
#pragma unroll
        for (int j = 0; j < 16; ++j) s += v[j];
        s = wave_sum(s);
        const float mu = s * (1.0f / 1024.0f);
        float q = 0.f;
#pragma unroll
        for (int j = 0; j < 16; ++j) { v[j] -= mu; q += v[j] * v[j]; }
        q = wave_sum(q);
        const float r = rsqrtf(q * (1.0f / 1024.0f) + LN_EPS);
#pragma unroll
        for (int j = 0; j < 2; ++j) { const int c = j * 512 + lane * 8; const float4 g0 = *(const float4*)(gam + c), g1 = *(const float4*)(gam + c + 4), b0 = *(const float4*)(bet + c), b1 = *(const float4*)(bet + c + 4);
            v4u o; o.x = pk2(v[8 * j] * r * g0.x + b0.x, v[8 * j + 1] * r * g0.y + b0.y); o.y = pk2(v[8 * j + 2] * r * g0.z + b0.z, v[8 * j + 3] * r * g0.w + b0.w);
            o.z = pk2(v[8 * j + 4] * r * g1.x + b1.x, v[8 * j + 5] * r * g1.y + b1.y); o.w = pk2(v[8 * j + 6] * r * g1.z + b1.z, v[8 * j + 7] * r * g1.w + b1.w);
            *(v4u*)(dstb + (size_t)t * D_MODEL + c) = o; }
    }
}

__device__ __forceinline__ void ph_peer_route(float* lds, const float* __restrict__ qh, const float* __restrict__ keys1, const float* __restrict__ keys2,
                                              int* __restrict__ eidx, float* __restrict__ gate) {
    float (*sq)[256] = (float (*)[256])lds;
    float (*sv)[2][16] = (float (*)[2][16])(lds + NWAVE * 256);
    int (*si)[2][16] = (int (*)[2][16])(lds + NWAVE * 256 + NWAVE * 32);
    const int w = threadIdx.x >> 6, lane = threadIdx.x & 63;
    for (int vb = blockIdx.x; vb < T_ALL * 8 / NWAVE; vb += gridDim.x) {
        const int item = vb * NWAVE + w;
        const int t = item >> 3, h = item & 7;
        __syncthreads();
        for (int c = lane; c < 256; c += 64) sq[w][c] = qh[(size_t)t * 2048 + h * 256 + c];
        __syncthreads();
#pragma unroll
        for (int half = 0; half < 2; ++half) {
            const float* keys = half ? keys2 : keys1;
            float s[2];
#pragma unroll
            for (int sl = 0; sl < 2; ++sl) {
                const float* kr = keys + (size_t)(lane + sl * 64) * 128;
                float a = 0.f;
#pragma unroll 8
                for (int c = 0; c < 128; c += 4) { float4 kv = *(const float4*)(kr + c); const float* qq = &sq[w][half * 128 + c]; a += kv.x * qq[0] + kv.y * qq[1] + kv.z * qq[2] + kv.w * qq[3]; }
                s[sl] = a;
            }
            for (int r = 0; r < 16; ++r) {
                float bv; int bi;
                if (s[0] >= s[1]) { bv = s[0]; bi = lane; } else { bv = s[1]; bi = lane + 64; }
#pragma unroll
                for (int o = 32; o > 0; o >>= 1) {
                    float ov = __shfl_xor(bv, o); int oi = __shfl_xor(bi, o);
                    if (ov > bv || (ov == bv && oi < bi)) { bv = ov; bi = oi; }
                }
                if (lane == 0) { sv[w][half][r] = bv; si[w][half][r] = bi; }
                if (bi == lane) s[0] = -INFINITY;
                if (bi == lane + 64) s[1] = -INFINITY;
            }
        }
        __syncthreads();
        float c[4];
#pragma unroll
        for (int j = 0; j < 4; ++j) { int ci = lane * 4 + j; c[j] = sv[w][0][ci >> 4] + sv[w][1][ci & 15]; }
        float myv = 0.f; int myc = 0;
        for (int r = 0; r < 16; ++r) {
            float bv = c[0]; int bi = lane * 4;
#pragma unroll
            for (int j = 1; j < 4; ++j) if (c[j] > bv) { bv = c[j]; bi = lane * 4 + j; }
#pragma unroll
            for (int o = 32; o > 0; o >>= 1) {
                float ov = __shfl_xor(bv, o); int oi = __shfl_xor(bi, o);
                if (ov > bv || (ov == bv && oi < bi)) { bv = ov; bi = oi; }
            }
            if (lane == r) { myv = bv; myc = bi; }
#pragma unroll
            for (int j = 0; j < 4; ++j) if (bi == lane * 4 + j) c[j] = -INFINITY;
        }
        float v = lane < 16 ? myv : -INFINITY;
        float mx = wave_max(v);
        float e = lane < 16 ? __expf(v - mx) : 0.f;
        float sum = wave_sum(e);
        if (lane < 16) {
            int ex = si[w][0][myc >> 4] * PEER_NKEYS + si[w][1][myc & 15];
            eidx[(size_t)t * 128 + h * 16 + lane] = ex;
            gate[(size_t)t * 128 + h * 16 + lane] = e / sum;
        }
    }
}

__device__ __forceinline__ void ph_peer_ffn(const float* __restrict__ hbuf, const int* __restrict__ eidx, const float* __restrict__ gate,
                                            const bf16* __restrict__ ub, const bf16* __restrict__ vb, const float* __restrict__ gam,
                                            const float* __restrict__ bet, float* __restrict__ out) {
    const int lane = threadIdx.x & 63;
    for (int t = blockIdx.x * NWAVE + (threadIdx.x >> 6); t < T_ALL; t += gridDim.x * NWAVE) {
        float x[16], acc[16];
        { const float* xr = hbuf + (size_t)t * D_MODEL + lane * 8;
          const float4 a = *(const float4*)xr, b = *(const float4*)(xr + 4), c = *(const float4*)(xr + 512), d = *(const float4*)(xr + 516);
          x[0] = a.x; x[1] = a.y; x[2] = a.z; x[3] = a.w; x[4] = b.x; x[5] = b.y; x[6] = b.z; x[7] = b.w;
          x[8] = c.x; x[9] = c.y; x[10] = c.z; x[11] = c.w; x[12] = d.x; x[13] = d.y; x[14] = d.z; x[15] = d.w; }
#pragma unroll
        for (int j = 0; j < 16; ++j) acc[j] = 0.f;
        for (int k = 0; k < 128; ++k) {
            const int e = eidx[(size_t)t * 128 + k];
            const float g = gate[(size_t)t * 128 + k];
            const bf16* ur = ub + (size_t)e * D_MODEL + lane * 8;
            float u0[8], u1[8];
            unpack8(*(const v4u*)ur, u0); unpack8(*(const v4u*)(ur + 512), u1);
            float d = 0.f;
#pragma unroll
            for (int j = 0; j < 8; ++j) d += u0[j] * x[j] + u1[j] * x[8 + j];
            d = wave_sum(d);
            const float wgt = g * gelu_f(d);
            const bf16* vr = vb + (size_t)e * D_MODEL + lane * 8;
            unpack8(*(const v4u*)vr, u0); unpack8(*(const v4u*)(vr + 512), u1);
#pragma unroll
            for (int j = 0; j < 8; ++j) { acc[j] += wgt * u0[j]; acc[8 + j] += wgt * u1[j]; }
        }
        float s = 0.f;
#pragma unroll
        for (int j = 0; j < 16; ++j) { acc[j] += ALPHA_F * x[j]; s += acc[j]; }
        s = wave_sum(s);
        const float mu = s * (1.0f / 1024.0f);
        float q = 0.f;
#pragma unroll
        for (int j = 0; j < 16; ++j) { acc[j] -= mu; q += acc[j] * acc[j]; }
        q = wave_sum(q);
        const float r = rsqrtf(q * (1.0f / 1024.0f) + LN_EPS);
        float* dst = ((t < T_PROMPT) ? out + OUT_YP + (size_t)t * D_MODEL : out + OUT_YS + (size_t)(t - T_PROMPT) * D_MODEL) + lane * 8;
#pragma unroll
        for (int q4 = 0; q4 < 4; ++q4) {
            const int eo = (q4 >> 1) * 512 + (q4 & 1) * 4;
            const float4 g4 = *(const float4*)(gam + lane * 8 + eo), b4 = *(const float4*)(bet + lane * 8 + eo);
            float4 o; o.x = acc[q4 * 4 + 0] * r * g4.x + b4.x; o.y = acc[q4 * 4 + 1] * r * g4.y + b4.y; o.z = acc[q4 * 4 + 2] * r * g4.z + b4.z; o.w = acc[q4 * 4 + 3] * r * g4.w + b4.w;
            *(float4*)(dst + eo) = o;
        }
    }
}

__device__ __forceinline__ float peer_dot16(const v4u a, const v4u b, const float (&x)[16]) {
    float u0[8], u1[8]; unpack8(a, u0); unpack8(b, u1);
    float d = 0.f;
#pragma unroll
    for (int j = 0; j < 8; ++j) d += u0[j] * x[j] + u1[j] * x[8 + j];
    return d;
}
#define PEER_TR_STEP(N, M) _Pragma("unroll") for (int i = 0; i < N; ++i) { const bool up = (lane & M) != 0; const float keep = up ? part[i + N] : part[i]; const float send = up ? part[i] : part[i + N]; part[i] = keep + __shfl_xor(send, M); }
__device__ __forceinline__ void ph_peer_ffn2(const float* __restrict__ hbuf, const int* __restrict__ eidx, const float* __restrict__ gate,
                                             const bf16* __restrict__ ub, const bf16* __restrict__ vb, const float* __restrict__ gam,
                                             const float* __restrict__ bet, float* __restrict__ out) {
    const int lane0 = threadIdx.x & 63;
    for (int t = blockIdx.x * NWAVE + (threadIdx.x >> 6); t < T_ALL; t += gridDim.x * NWAVE) {
        int lane = lane0; asm volatile("" : "+v"(lane));
        float x[16];
        { const float* xr = hbuf + (size_t)t * D_MODEL + lane * 8;
          const float4 a = *(const float4*)xr, b = *(const float4*)(xr + 4), c = *(const float4*)(xr + 512), d = *(const float4*)(xr + 516);
          x[0] = a.x; x[1] = a.y; x[2] = a.z; x[3] = a.w; x[4] = b.x; x[5] = b.y; x[6] = b.z; x[7] = b.w;
          x[8] = c.x; x[9] = c.y; x[10] = c.z; x[11] = c.w; x[12] = d.x; x[13] = d.y; x[14] = d.z; x[15] = d.w; }
        int ev[2]; float wv[4];
        ev[0] = eidx[(size_t)t * 128 + lane]; ev[1] = eidx[(size_t)t * 128 + 64 + lane];
#pragma unroll
        for (int rd = 0; rd < 4; ++rd) wv[rd] = gate[(size_t)t * 128 + rd * 32 + (lane >> 1)];
#pragma unroll
        for (int rd = 0; rd < 4; ++rd) {
            float part[32];
#pragma unroll
            for (int kb = 0; kb < 8; ++kb) {
                v4u ra[4], rb[4];
#pragma unroll
                for (int k8 = 0; k8 < 4; ++k8) {
                    const int e = __builtin_amdgcn_readlane(ev[rd >> 1], (rd & 1) * 32 + kb * 4 + k8);
                    const bf16* ur = ub + (size_t)e * D_MODEL + lane * 8;
                    ra[k8] = *(const v4u*)ur; rb[k8] = *(const v4u*)(ur + 512);
                }
#pragma unroll
                for (int k8 = 0; k8 < 4; ++k8) part[kb * 4 + k8] = peer_dot16(ra[k8], rb[k8], x);
            }
            PEER_TR_STEP(16, 32) PEER_TR_STEP(8, 16) PEER_TR_STEP(4, 8) PEER_TR_STEP(2, 4) PEER_TR_STEP(1, 2)
            const float hid = part[0] + __shfl_xor(part[0], 1);
            wv[rd] *= gelu_f(hid);
        }
        float acc[16];
#pragma unroll
        for (int j = 0; j < 16; ++j) acc[j] = 0.f;
#pragma unroll
        for (int rd = 0; rd < 4; ++rd) {
#pragma unroll
            for (int kb = 0; kb < 4; ++kb) {
                v4u ra[8], rb[8];
#pragma unroll
                for (int k8 = 0; k8 < 8; ++k8) {
                    const int e = __builtin_amdgcn_readlane(ev[rd >> 1], (rd & 1) * 32 + kb * 8 + k8);
                    const bf16* vr = vb + (size_t)e * D_MODEL + lane * 8;
                    ra[k8] = *(const v4u*)vr; rb[k8] = *(const v4u*)(vr + 512);
                }
#pragma unroll
                for (int k8 = 0; k8 < 8; ++k8) {
                    const float wk = __builtin_bit_cast(float, __builtin_amdgcn_readlane(__builtin_bit_cast(int, wv[rd]), 2 * (kb * 8 + k8)));
                    float u0[8], u1[8]; unpack8(ra[k8], u0); unpack8(rb[k8], u1);
#pragma unroll
                    for (int j = 0; j < 8; ++j) { acc[j] += wk * u0[j]; acc[8 + j] += wk * u1[j]; }
                }
            }
        }
        float s = 0.f;
#pragma unroll
        for (int j = 0; j < 16; ++j) { acc[j] += ALPHA_F * x[j]; s += acc[j]; }
        s = wave_sum(s);
        const float mu = s * (1.0f / 1024.0f);
        float q = 0.f;
#pragma unroll
        for (int j = 0; j < 16; ++j) { acc[j] -= mu; q += acc[j] * acc[j]; }
        q = wave_sum(q);
        const float r = rsqrtf(q * (1.0f / 1024.0f) + LN_EPS);
        float* dst = ((t < T_PROMPT) ? out + OUT_YP + (size_t)t * D_MODEL : out + OUT_YS + (size_t)(t - T_PROMPT) * D_MODEL) + lane * 8;
#pragma unroll
        for (int q4 = 0; q4 < 4; ++q4) {
            const int eo = (q4 >> 1) * 512 + (q4 & 1) * 4;
            const float4 g4 = *(const float4*)(gam + lane * 8 + eo), b4 = *(const float4*)(bet + lane * 8 + eo);
            float4 o; o.x = acc[q4 * 4 + 0] * r * g4.x + b4.x; o.y = acc[q4 * 4 + 1] * r * g4.y + b4.y; o.z = acc[q4 * 4 + 2] * r * g4.z + b4.z; o.w = acc[q4 * 4 + 3] * r * g4.w + b4.w;
            *(float4*)(dst + eo) = o;
        }
    }
}

__device__ __forceinline__ void ph_attn_sample(float* lds, const bf16* __restrict__ qrot_b, const bf16* __restrict__ krot_b, const bf16* __restrict__ projb,
                                               const float* __restrict__ ck, const float* __restrict__ cv, bf16* __restrict__ A1) {
    float (*sq)[64] = (float (*)[64])lds;
    const int w = threadIdx.x >> 6, lane0 = threadIdx.x & 63;
    for (int vb = blockIdx.x; vb < T_SAMPLE * 8 / NWAVE; vb += gridDim.x) {
        int lane = lane0; asm volatile("" : "+v"(lane));
        const int item = vb * NWAVE + w, ts = item >> 3, hd = item & 7, b = ts >> 2, i = ts & 3, t = T_PROMPT + ts;
        __syncthreads();
        sq[w][lane] = bf2f(qrot_b[(size_t)t * ATT_WIDTH + hd * 64 + lane]);
        __syncthreads();
        const int qi = WBUF + i;
        float sc[8];
        float mx = -INFINITY;
#pragma unroll
        for (int slot = 0; slot < 7; ++slot) {
            const int pt = slot < 6 ? (slot >> 1) : (lane < 3 ? lane : 0);
            const int m = slot < 6 ? lane + 64 * (slot & 1) : 128;
            const int kj = qi - (m << (2 * pt));
            const bool valid = (slot < 6 || lane < 3) && kj < WBUF;
            const int kc = kj < WBUF ? kj : WBUF - 1;
            const float* kr = ck + ((size_t)b * WBUF + kc) * ATT_WIDTH + hd * 64;
            float a = 0.f;
#pragma unroll
            for (int c = 0; c < 64; c += 4) { const float4 kv = *(const float4*)(kr + c); a += kv.x * sq[w][c] + kv.y * sq[w][c + 1] + kv.z * sq[w][c + 2] + kv.w * sq[w][c + 3]; }
            const float s = valid ? a * 0.125f : -INFINITY;
            sc[slot] = s; mx = fmaxf(mx, s);
        }
        const int nt7 = lane <= i ? i - lane : i;
        const bool valid7 = lane < i + 3;
        {
            const bf16* kr = krot_b + (size_t)(T_PROMPT + b * DEC_SEQ + nt7) * ATT_WIDTH + hd * 64;
            float a = 0.f;
#pragma unroll
            for (int c = 0; c < 64; c += 8) { float f[8]; unpack8(*(const v4u*)(kr + c), f);
#pragma unroll
                for (int j = 0; j < 8; ++j) a += f[j] * sq[w][c + j]; }
            const float s = valid7 ? a * 0.125f : -INFINITY;
            sc[7] = s; mx = fmaxf(mx, s);
        }
        mx = wave_max(mx);
        float lsum = 0.f;
#pragma unroll
        for (int slot = 0; slot < 8; ++slot) { const float pv = __expf(sc[slot] - mx); sc[slot] = pv; lsum += pv; }
        lsum = wave_sum(lsum);
        float part[64];
#pragma unroll
        for (int c = 0; c < 64; ++c) part[c] = 0.f;
#pragma unroll
        for (int slot = 0; slot < 7; ++slot) {
            const int pt = slot < 6 ? (slot >> 1) : (lane < 3 ? lane : 0);
            const int m = slot < 6 ? lane + 64 * (slot & 1) : 128;
            const int kj = qi - (m << (2 * pt));
            const int kc = kj < WBUF ? kj : WBUF - 1;
            const float pv = sc[slot];
            const float* vr = cv + ((size_t)b * WBUF + kc) * ATT_WIDTH + hd * 64;
#pragma unroll
            for (int c = 0; c < 64; c += 4) { const float4 vv = *(const float4*)(vr + c); part[c] += pv * vv.x; part[c + 1] += pv * vv.y; part[c + 2] += pv * vv.z; part[c + 3] += pv * vv.w; }
        }
        {
            const float pv = sc[7];
            const bf16* vr = projb + (size_t)(T_PROMPT + b * DEC_SEQ + nt7) * NB_LD + NB_V + hd * 64;
#pragma unroll
            for (int c = 0; c < 64; c += 8) { float f[8]; unpack8(*(const v4u*)(vr + c), f);
#pragma unroll
                for (int j = 0; j < 8; ++j) part[c + j] += pv * f[j]; }
        }
        PEER_TR_STEP(32, 32) PEER_TR_STEP(16, 16) PEER_TR_STEP(8, 8) PEER_TR_STEP(4, 4) PEER_TR_STEP(2, 2) PEER_TR_STEP(1, 1)
        A1[(size_t)t * MIX_WIDTH + SSD_WIDTH + hd * 64 + lane] = (bf16)f2bf(part[0] / lsum);
    }
}


__device__ __forceinline__ void cache_copy_slice(const float* __restrict__ ck, const float* __restrict__ cv, float* __restrict__ out, unsigned slice, unsigned lane, unsigned bt0 = 0u, unsigned bt1 = 8u) {
    constexpr unsigned PER_B = (WBUF - DEC_SEQ) * ATT_WIDTH / 4;
    constexpr unsigned TOTAL = 2u * DEC_BATCH * PER_B;
#pragma unroll 1
    for (unsigned bt = bt0; bt < bt1; ++bt) {
        f32x4n v[8]; size_t dsti[8]; bool isv[8]; bool ok[8];
#pragma unroll
        for (int j = 0; j < 8; ++j) {
            const unsigned idx = slice * 4096u + bt * 512u + j * 64u + lane;
            ok[j] = idx < TOTAL;
            const unsigned idc = ok[j] ? idx : 0u;
            const unsigned tb = idc / PER_B, r = idc - tb * PER_B, bb = tb & (DEC_BATCH - 1);
            isv[j] = tb >= DEC_BATCH;
            const size_t srci = (size_t)bb * (WBUF * ATT_WIDTH / 4) + (DEC_SEQ * ATT_WIDTH / 4) + r;
            dsti[j] = (size_t)bb * (WBUF * ATT_WIDTH / 4) + r;
            v[j] = __builtin_nontemporal_load((isv[j] ? (const f32x4n*)cv : (const f32x4n*)ck) + srci);
        }
#pragma unroll
        for (int j = 0; j < 8; ++j) if (ok[j]) __builtin_nontemporal_store(v[j], (f32x4n*)(out + (isv[j] ? OUT_SV : OUT_SK)) + dsti[j]);
    }
}

__device__ __forceinline__ void copy_q_load(const float* __restrict__ ck, const float* __restrict__ cv, unsigned q, unsigned lane, f32x4n (&v)[16]) {
    constexpr unsigned PER_B = (WBUF - DEC_SEQ) * ATT_WIDTH / 4, TOTAL = 2u * DEC_BATCH * PER_B;
#pragma unroll
    for (int j = 0; j < 16; ++j) {
        const unsigned idx = q * 1024u + j * 64u + lane, idc = idx < TOTAL ? idx : 0u;
        const unsigned tb = idc / PER_B, r = idc - tb * PER_B, bb = tb & (DEC_BATCH - 1);
        const size_t srci = (size_t)bb * (WBUF * ATT_WIDTH / 4) + (DEC_SEQ * ATT_WIDTH / 4) + r;
        v[j] = __builtin_nontemporal_load((tb >= DEC_BATCH ? (const f32x4n*)cv : (const f32x4n*)ck) + srci);
    }
}
__device__ __forceinline__ void copy_q_store(float* __restrict__ out, unsigned q, unsigned lane, const f32x4n (&v)[16]) {
    constexpr unsigned PER_B = (WBUF - DEC_SEQ) * ATT_WIDTH / 4, TOTAL = 2u * DEC_BATCH * PER_B;
#pragma unroll
    for (int j = 0; j < 16; ++j) {
        const unsigned idx = q * 1024u + j * 64u + lane;
        if (idx < TOTAL) {
            const unsigned tb = idx / PER_B, r = idx - tb * PER_B, bb = tb & (DEC_BATCH - 1);
            const size_t dsti = (size_t)bb * (WBUF * ATT_WIDTH / 4) + r;
            __builtin_nontemporal_store(v[j], (f32x4n*)(out + (tb >= DEC_BATCH ? OUT_SV : OUT_SK)) + dsti);
        }
    }
}
typedef float f32x2v __attribute__((ext_vector_type(2)));
typedef unsigned u32x6 __attribute__((ext_vector_type(6)));
typedef float f32x32 __attribute__((ext_vector_type(32)));
typedef float f32x16q __attribute__((ext_vector_type(16)));
struct __attribute__((aligned(4))) u3w { unsigned x, y, z; };
#define PEER_ROWB 768
#define QSPLIT 8192
__device__ __forceinline__ void ph_quant_tables(const float* __restrict__ pu, const float* __restrict__ pv, unsigned char* __restrict__ ub8, unsigned char* __restrict__ vb8,
                                                float* __restrict__ usc, float* __restrict__ vsc, int rank, int nranks, int row0 = 0, int row1 = 2 * 16384) {
    const int lane = threadIdx.x & 63;
#pragma unroll 2
    for (int row = row0 + rank * NWAVE + (threadIdx.x >> 6); row < row1; row += nranks * NWAVE) {
        const int rr = row & 16383; const bool isv = row >= 16384;
        const float* src = (isv ? pv : pu) + (size_t)rr * D_MODEL + lane * 8;
        const float4 a = *(const float4*)src, b = *(const float4*)(src + 4), c = *(const float4*)(src + 512), d = *(const float4*)(src + 516);
        float am = fmaxf(fmaxf(fmaxf(fabsf(a.x), fabsf(a.y)), fmaxf(fabsf(a.z), fabsf(a.w))), fmaxf(fmaxf(fabsf(b.x), fabsf(b.y)), fmaxf(fabsf(b.z), fabsf(b.w))));
        am = fmaxf(am, fmaxf(fmaxf(fmaxf(fabsf(c.x), fabsf(c.y)), fmaxf(fabsf(c.z), fabsf(c.w))), fmaxf(fmaxf(fabsf(d.x), fabsf(d.y)), fmaxf(fabsf(d.z), fabsf(d.w)))));
        am = wave_max(am);
        const float sc = am > 0.f ? 7.5f / am : 1.0f;
        f32x16q e0, e1;
#pragma unroll
        for (int i = 0; i < 16; ++i) { e0[i] = 0.f; e1[i] = 0.f; }
        e0[0] = a.x * sc; e1[0] = a.y * sc; e0[1] = a.z * sc; e1[1] = a.w * sc; e0[2] = b.x * sc; e1[2] = b.y * sc; e0[3] = b.z * sc; e1[3] = b.w * sc;
        e0[4] = c.x * sc; e1[4] = c.y * sc; e0[5] = c.z * sc; e1[5] = c.w * sc; e0[6] = d.x * sc; e1[6] = d.y * sc; e0[7] = d.z * sc; e1[7] = d.w * sc;
        const u32x6 qv = __builtin_amdgcn_cvt_scalef32_2xpk16_fp6_f32(e0, e1, 1.0f);
        u3w o; o.x = qv[0]; o.y = qv[1]; o.z = qv[2];
        *(u3w*)((isv ? vb8 : ub8) + (size_t)rr * PEER_ROWB + lane * 12) = o;
        if (lane == 0) (isv ? vsc : usc)[rr] = am > 0.f ? am * (1.0f / 7.5f) : 1.0f;
    }
}
__device__ __forceinline__ void unpack16_fp8(const v4u w, float (&f)[16]) {
#pragma unroll
    for (int i = 0; i < 4; ++i) {
        const f32x2v lo = __builtin_amdgcn_cvt_pk_f32_fp8((int)w[i], false), hi = __builtin_amdgcn_cvt_pk_f32_fp8((int)w[i], true);
        f[4 * i] = lo[0]; f[4 * i + 1] = lo[1]; f[4 * i + 2] = hi[0]; f[4 * i + 3] = hi[1];
    }
}
__device__ __forceinline__ unsigned ffn_slice(unsigned n9, unsigned it) {
    const unsigned w = (unsigned)__builtin_amdgcn_readfirstlane(threadIdx.x >> 6), wgl = blockIdx.x * NWAVE + w;
    if (gridDim.x != 256) return n9 + wgl + it * (gridDim.x * NWAVE);
    unsigned v;
    if (w < 2u) { if (it == 0u) v = 0u; else if (it == 4u) v = 1u; else return 0xffffffffu; }
    else { if ((it & 1u) == 0u && it < 8u) v = it >> 1; else return 0xffffffffu; }
    if (v < 2u) return n9 + v * 2048u + wgl;
    const unsigned lw = blockIdx.x * 6u + (w - 2u);
    return n9 + 4096u + (v - 2u) * 1536u + lw;
}
__device__ __forceinline__ unsigned ffn_half(unsigned n9, unsigned it) {
    const unsigned w = (unsigned)__builtin_amdgcn_readfirstlane(threadIdx.x >> 6);
    if (gridDim.x != 256 || w >= 2u || it != 7u) return 0xffffffffu;
    const unsigned hw = blockIdx.x * 2u + w;
    return ((n9 + 7168u + (hw >> 1)) << 1) | (hw & 1u);
}
__device__ __forceinline__ void ph_peer_ffn3(const bf16* __restrict__ hb, const int* __restrict__ eidx, const float* __restrict__ gate,
                                             const unsigned char* __restrict__ ub8, const unsigned char* __restrict__ vb8, const float* __restrict__ usc, const float* __restrict__ vsc,
                                             const float* __restrict__ gam, const float* __restrict__ bet, float* __restrict__ out,
                                             const float* __restrict__ ck, const float* __restrict__ cv, unsigned n9) {
    const int lane0 = threadIdx.x & 63;
    unsigned it = 0;
    for (;; ++it) {
        const int t = token_of_iter((int)it);
        if (t < 0) break;
        int lane = lane0; asm volatile("" : "+v"(lane));
        { const unsigned sl = ffn_slice(n9, it); if (sl < 16384u) cache_copy_slice(ck, cv, out, sl, (unsigned)lane);
          const unsigned hc = ffn_half(n9, it); if (hc != 0xffffffffu) cache_copy_slice(ck, cv, out, hc >> 1, (unsigned)lane, 4u * (hc & 1u), 4u * (hc & 1u) + 4u); }
        const unsigned lo12 = (unsigned)lane * 12u, lo8 = (unsigned)lane * 8u;
        float x[16];
        { float f0[8], f1[8]; const bf16* xr = hb + (size_t)t * D_MODEL + lo8; unpack8(*(const v4u*)xr, f0); unpack8(*(const v4u*)(xr + 512), f1);
#pragma unroll
          for (int j = 0; j < 8; ++j) { x[j] = f0[j]; x[8 + j] = f1[j]; } }
        int ev[2]; float wv[4], su[4];
        ev[0] = eidx[(size_t)t * 128 + lane]; ev[1] = eidx[(size_t)t * 128 + 64 + lane];
#pragma unroll
        for (int rd = 0; rd < 4; ++rd) {
            const int er = eidx[(size_t)t * 128 + rd * 32 + (lane >> 1)];
            wv[rd] = gate[(size_t)t * 128 + rd * 32 + (lane >> 1)] * vsc[er];
            su[rd] = usc[er];
        }
#pragma unroll
        for (int rd = 0; rd < 4; ++rd) {
            float part[32];
#pragma unroll
            for (int kb = 0; kb < 2; ++kb) {
                u3w ra[16];
#pragma unroll
                for (int k8 = 0; k8 < 16; ++k8) {
                    const int e = __builtin_amdgcn_readlane(ev[rd >> 1], (rd & 1) * 32 + kb * 16 + k8);
                    ra[k8] = *(const u3w*)(ub8 + (size_t)e * PEER_ROWB + lo12);
                }
#pragma unroll
                for (int k8 = 0; k8 < 16; k8 += 2) {
                    u32x6 sv; sv[0] = ra[k8].x; sv[1] = ra[k8].y; sv[2] = ra[k8].z; sv[3] = ra[k8 + 1].x; sv[4] = ra[k8 + 1].y; sv[5] = ra[k8 + 1].z;
                    const f32x32 f = __builtin_amdgcn_cvt_scalef32_pk32_f32_fp6(sv, 1.0f);
                    f32x2v d0 = {0.f, 0.f}, d1 = {0.f, 0.f};
#pragma unroll
                    for (int i = 0; i < 8; ++i) {
                        d0 += (f32x2v){f[2 * i], f[2 * i + 1]} * (f32x2v){x[2 * i], x[2 * i + 1]};
                        d1 += (f32x2v){f[16 + 2 * i], f[17 + 2 * i]} * (f32x2v){x[2 * i], x[2 * i + 1]};
                    }
                    part[kb * 16 + k8] = d0[0] + d0[1]; part[kb * 16 + k8 + 1] = d1[0] + d1[1];
                    __builtin_amdgcn_sched_barrier(0);
                }
            }
            PEER_TR_STEP(16, 32) PEER_TR_STEP(8, 16) PEER_TR_STEP(4, 8) PEER_TR_STEP(2, 4) PEER_TR_STEP(1, 2)
            const float hid = (part[0] + __shfl_xor(part[0], 1)) * su[rd];
            wv[rd] *= gelu_f(hid);
        }
        f32x2v accp[8];
#pragma unroll
        for (int i = 0; i < 8; ++i) accp[i] = (f32x2v){0.f, 0.f};
#pragma unroll
        for (int rd = 0; rd < 4; ++rd) {
#pragma unroll
            for (int kb = 0; kb < 2; ++kb) {
                u3w ra[16];
#pragma unroll
                for (int k8 = 0; k8 < 16; ++k8) {
                    const int e = __builtin_amdgcn_readlane(ev[rd >> 1], (rd & 1) * 32 + kb * 16 + k8);
                    ra[k8] = *(const u3w*)(vb8 + (size_t)e * PEER_ROWB + lo12);
                }
#pragma unroll
                for (int k8 = 0; k8 < 16; k8 += 2) {
                    const float wk0 = __builtin_bit_cast(float, __builtin_amdgcn_readlane(__builtin_bit_cast(int, wv[rd]), 2 * (kb * 16 + k8)));
                    const float wk1 = __builtin_bit_cast(float, __builtin_amdgcn_readlane(__builtin_bit_cast(int, wv[rd]), 2 * (kb * 16 + k8 + 1)));
                    u32x6 sv; sv[0] = ra[k8].x; sv[1] = ra[k8].y; sv[2] = ra[k8].z; sv[3] = ra[k8 + 1].x; sv[4] = ra[k8 + 1].y; sv[5] = ra[k8 + 1].z;
                    const f32x32 f = __builtin_amdgcn_cvt_scalef32_pk32_f32_fp6(sv, 1.0f);
#pragma unroll
                    for (int i = 0; i < 8; ++i) {
                        accp[i] += (f32x2v){wk0, wk0} * (f32x2v){f[2 * i], f[2 * i + 1]};
                        accp[i] += (f32x2v){wk1, wk1} * (f32x2v){f[16 + 2 * i], f[17 + 2 * i]};
                    }
                    __builtin_amdgcn_sched_barrier(0);
                }
            }
        }
        float acc[16];
#pragma unroll
        for (int i = 0; i < 8; ++i) { acc[2 * i] = accp[i][0]; acc[2 * i + 1] = accp[i][1]; }
        float s = 0.f;
#pragma unroll
        for (int j = 0; j < 16; ++j) { acc[j] += ALPHA_F * x[j]; s += acc[j]; }
        s = wave_sum(s);
        const float mu = s * (1.0f / 1024.0f);
        float q = 0.f;
#pragma unroll
        for (int j = 0; j < 16; ++j) { acc[j] -= mu; q += acc[j] * acc[j]; }
        q = wave_sum(q);
        const float r = rsqrtf(q * (1.0f / 1024.0f) + LN_EPS);
        float* dst = ((t < T_PROMPT) ? out + OUT_YP + (size_t)t * D_MODEL : out + OUT_YS + (size_t)(t - T_PROMPT) * D_MODEL) + lo8;
#pragma unroll
        for (int q4 = 0; q4 < 4; ++q4) {
            const int eo = (q4 >> 1) * 512 + (q4 & 1) * 4;
            const float4 g4 = *(const float4*)(gam + lo8 + eo), b4 = *(const float4*)(bet + lo8 + eo);
            float4 o; o.x = acc[q4 * 4 + 0] * r * g4.x + b4.x; o.y = acc[q4 * 4 + 1] * r * g4.y + b4.y; o.z = acc[q4 * 4 + 2] * r * g4.z + b4.z; o.w = acc[q4 * 4 + 3] * r * g4.w + b4.w;
            *(float4*)(dst + eo) = o;
        }
    }
    for (;; ++it) {
        if (gridDim.x == 256 && it >= 5u) break;
        const unsigned sl = ffn_slice(n9, it);
        if (gridDim.x != 256 && sl >= 16384u) break;
        if (sl < 16384u) cache_copy_slice(ck, cv, out, sl, (unsigned)lane0);
    }
}


__device__ __forceinline__ void ssd_decode_load(const bf16* __restrict__ xbc_b, const float* __restrict__ dtv, const float* __restrict__ state_ssm, int item, int p, int ng,
                                                float (&hs)[16], v4u (&bq)[4][2], v4u (&cq)[4][2], float (&xv)[4], float (&dv)[4]) {
    const int sb = item / SSD_HEADS, h = item - sb * SSD_HEADS, g = h / 6, t0 = T_PROMPT + sb * DEC_SEQ;
    const float* s0 = state_ssm + (((size_t)sb * SSD_HEADS + h) * 64 + p) * 128 + ng * 16;
#pragma unroll
    for (int j = 0; j < 4; ++j) { const float4 v = *(const float4*)(s0 + 4 * j); hs[4 * j] = v.x; hs[4 * j + 1] = v.y; hs[4 * j + 2] = v.z; hs[4 * j + 3] = v.w; }
#pragma unroll
    for (int s = 0; s < 4; ++s) {
        const bf16* row = xbc_b + (size_t)(t0 + s) * CONV_DIM;
        bq[s][0] = *(const v4u*)(row + 1536 + g * 128 + ng * 16); bq[s][1] = *(const v4u*)(row + 1536 + g * 128 + ng * 16 + 8);
        cq[s][0] = *(const v4u*)(row + 2048 + g * 128 + ng * 16); cq[s][1] = *(const v4u*)(row + 2048 + g * 128 + ng * 16 + 8);
        xv[s] = bf2f(row[h * 64 + p]); dv[s] = dtv[(size_t)(t0 + s) * SSD_HEADS + h];
    }
}
__device__ __forceinline__ void ssd_decode_compute(const float* __restrict__ a_log, const float* __restrict__ d_skip, int item, int p, int ng,
                                                   float (&hs)[16], const v4u (&bq)[4][2], const v4u (&cq)[4][2], const float (&xv)[4], const float (&dv)[4],
                                                   float* __restrict__ ybuf, float* __restrict__ out) {
    const int sb = item / SSD_HEADS, h = item - sb * SSD_HEADS, t0 = T_PROMPT + sb * DEC_SEQ;
    const float A = -__expf(a_log[h]), D = d_skip[h];
#pragma unroll
    for (int s = 0; s < 4; ++s) {
        float Bf[16], Cf[16];
        { float t8[8]; unpack8(bq[s][0], t8);
#pragma unroll
          for (int j = 0; j < 8; ++j) Bf[j] = t8[j];
          unpack8(bq[s][1], t8);
#pragma unroll
          for (int j = 0; j < 8; ++j) Bf[8 + j] = t8[j];
          unpack8(cq[s][0], t8);
#pragma unroll
          for (int j = 0; j < 8; ++j) Cf[j] = t8[j];
          unpack8(cq[s][1], t8);
#pragma unroll
          for (int j = 0; j < 8; ++j) Cf[8 + j] = t8[j]; }
        const float a = __expf(dv[s] * A), xdt = xv[s] * dv[s];
        float y = 0.f;
#pragma unroll
        for (int j = 0; j < 16; ++j) { hs[j] = a * hs[j] + xdt * Bf[j]; y += Cf[j] * hs[j]; }
        y += __shfl_xor(y, 1); y += __shfl_xor(y, 2); y += __shfl_xor(y, 4);
        if (ng == 0) ybuf[(size_t)(t0 + s) * MIX_WIDTH + h * 64 + p] = y + D * xv[s];
    }
    float* so = out + OUT_SS + (((size_t)sb * SSD_HEADS + h) * 64 + p) * 128 + ng * 16;
#pragma unroll
    for (int j = 0; j < 4; ++j) *(float4*)(so + 4 * j) = make_float4(hs[4 * j], hs[4 * j + 1], hs[4 * j + 2], hs[4 * j + 3]);
}
__device__ __forceinline__ void ph_ssd_decode(const bf16* __restrict__ xbc_b, const float* __restrict__ dtv, const float* __restrict__ a_log, const float* __restrict__ d_skip,
                                              const float* __restrict__ state_ssm, float* __restrict__ ybuf, float* __restrict__ out) {
    const int tid = threadIdx.x, p = tid >> 3, ng = tid & 7;
    constexpr int NITEM = DEC_BATCH * SSD_HEADS;
    for (int it = blockIdx.x; it < NITEM; it += 2 * gridDim.x) {
        const int it2 = it + gridDim.x; const bool has2 = it2 < NITEM; const int it2c = has2 ? it2 : it;
        float hsA[16], hsB[16], xA[4], xB[4], dA[4], dB[4]; v4u bA[4][2], cA[4][2], bB[4][2], cB[4][2];
        ssd_decode_load(xbc_b, dtv, state_ssm, it, p, ng, hsA, bA, cA, xA, dA);
        ssd_decode_load(xbc_b, dtv, state_ssm, it2c, p, ng, hsB, bB, cB, xB, dB);
        ssd_decode_compute(a_log, d_skip, it, p, ng, hsA, bA, cA, xA, dA, ybuf, out);
        if (has2) ssd_decode_compute(a_log, d_skip, it2, p, ng, hsB, bB, cB, xB, dB, ybuf, out);
    }
}

__device__ __forceinline__ float samp_cw(int d) { return (float)((int)(d >= 0 && d <= 128) + (int)(d >= 0 && (d & 3) == 0 && d <= 512) + (int)(d >= 0 && (d & 15) == 0 && d <= 2048)); }
__device__ __forceinline__ void samp_update(float sv, float cw, const float (&vrow)[64], float& m, float& l, float (&part)[64]) {
    const float mn = fmaxf(m, sv), alpha = __expf(m - mn), p = cw * __expf(sv - mn);
    m = mn; l = l * alpha + p;
#pragma unroll
    for (int c = 0; c < 64; ++c) part[c] = part[c] * alpha + p * vrow[c];
}
__device__ __forceinline__ void ph_attn_sample3(float* lds, const bf16* __restrict__ qrot_b, const bf16* __restrict__ krot_b, const bf16* __restrict__ projb,
                                                const float* __restrict__ ck, const float* __restrict__ cv, bf16* __restrict__ A1) {
    const int lane0 = threadIdx.x & 63, w = __builtin_amdgcn_readfirstlane(threadIdx.x >> 6);
    float* sq = lds + w * 256;
    for (int item = blockIdx.x + gridDim.x * w; item < DEC_BATCH * ATT_HEADS; item += gridDim.x * NWAVE) {
        int lane = lane0; asm volatile("" : "+v"(lane));
        const int b = item >> 3, hd = item & 7, qi = lane & 3, g = lane >> 2;
        const int tq0 = T_PROMPT + b * DEC_SEQ;
#pragma unroll
        for (int i = 0; i < 4; ++i) sq[i * 64 + lane] = bf2f(qrot_b[(size_t)(tq0 + i) * ATT_WIDTH + hd * 64 + lane]);
        asm volatile("s_waitcnt lgkmcnt(0)" ::: "memory");
        const float* qv = sq + qi * 64;
        const float* ckb = ck + (size_t)b * WBUF * ATT_WIDTH + hd * 64; const float* cvb = cv + (size_t)b * WBUF * ATT_WIDTH + hd * 64;
        float m = -1e30f, l = 0.f, part[64];
#pragma unroll
        for (int c = 0; c < 64; ++c) part[c] = 0.f;
        {
            const int P = 2051 - g;
            const float cw = samp_cw(WBUF + qi - P);
            const bool isn = P >= WBUF;
            const int nt = isn ? P - WBUF : 0, Pc = isn ? WBUF - 1 : P;
            const bf16* kn = krot_b + (size_t)(tq0 + nt) * ATT_WIDTH + hd * 64; const float* kr = ckb + (size_t)Pc * ATT_WIDTH;
            float a = 0.f;
#pragma unroll
            for (int c = 0; c < 64; c += 8) { float f[8]; unpack8(*(const v4u*)(kn + c), f); const float4 k0 = *(const float4*)(kr + c), k1 = *(const float4*)(kr + c + 4);
                a += (isn ? f[0] : k0.x) * qv[c] + (isn ? f[1] : k0.y) * qv[c + 1] + (isn ? f[2] : k0.z) * qv[c + 2] + (isn ? f[3] : k0.w) * qv[c + 3]
                   + (isn ? f[4] : k1.x) * qv[c + 4] + (isn ? f[5] : k1.y) * qv[c + 5] + (isn ? f[6] : k1.z) * qv[c + 6] + (isn ? f[7] : k1.w) * qv[c + 7]; }
            const float sv = cw > 0.f ? a * 0.125f : -1e30f;
            const bf16* vn = projb + (size_t)(tq0 + nt) * NB_LD + NB_V + hd * 64; const float* vr = cvb + (size_t)Pc * ATT_WIDTH;
            float vrow[64];
#pragma unroll
            for (int c = 0; c < 64; c += 8) { float f[8]; unpack8(*(const v4u*)(vn + c), f); const float4 v0 = *(const float4*)(vr + c), v1 = *(const float4*)(vr + c + 4);
                vrow[c] = isn ? f[0] : v0.x; vrow[c + 1] = isn ? f[1] : v0.y; vrow[c + 2] = isn ? f[2] : v0.z; vrow[c + 3] = isn ? f[3] : v0.w;
                vrow[c + 4] = isn ? f[4] : v1.x; vrow[c + 5] = isn ? f[5] : v1.y; vrow[c + 6] = isn ? f[6] : v1.z; vrow[c + 7] = isn ? f[7] : v1.w; }
            samp_update(sv, cw, vrow, m, l, part);
        }
#pragma unroll 1
        for (int s = 1; s < 21; ++s) {
            const int P = s < 9 ? 2051 - (16 * s + g) : (s < 15 ? 1536 + 64 * (s - 9) + lane : qi + 16 * (16 * (s - 15) + g));
            const float cw = (s < 9 && P < 1920) ? 0.f : samp_cw(WBUF + qi - P);
            const float* kr = ckb + (size_t)P * ATT_WIDTH;
            float a = 0.f;
#pragma unroll
            for (int c = 0; c < 64; c += 4) { const float4 kv = *(const float4*)(kr + c); a += kv.x * qv[c] + kv.y * qv[c + 1] + kv.z * qv[c + 2] + kv.w * qv[c + 3]; }
            const float sv = cw > 0.f ? a * 0.125f : -1e30f;
            __builtin_amdgcn_sched_barrier(0);
            const float* vr = cvb + (size_t)P * ATT_WIDTH;
            float vrow[64];
#pragma unroll
            for (int c = 0; c < 64; c += 4) { const float4 vv = *(const float4*)(vr + c); vrow[c] = vv.x; vrow[c + 1] = vv.y; vrow[c + 2] = vv.z; vrow[c + 3] = vv.w; }
            samp_update(sv, cw, vrow, m, l, part);
        }
        float M = m;
        M = fmaxf(M, __shfl_xor(M, 4)); M = fmaxf(M, __shfl_xor(M, 8)); M = fmaxf(M, __shfl_xor(M, 16)); M = fmaxf(M, __shfl_xor(M, 32));
        const float sc = __expf(m - M);
        float lsum = l * sc;
        lsum += __shfl_xor(lsum, 4); lsum += __shfl_xor(lsum, 8); lsum += __shfl_xor(lsum, 16); lsum += __shfl_xor(lsum, 32);
#pragma unroll
        for (int c = 0; c < 64; ++c) part[c] *= sc;
        PEER_TR_STEP(32, 32) PEER_TR_STEP(16, 16) PEER_TR_STEP(8, 8) PEER_TR_STEP(4, 4)
        const float inv = 1.0f / lsum;
        *(uint2*)(A1 + (size_t)(tq0 + qi) * MIX_WIDTH + SSD_WIDTH + hd * 64 + 4 * g) = make_uint2(pk2(part[0] * inv, part[1] * inv), pk2(part[2] * inv, part[3] * inv));
    }
}

typedef float f32x16 __attribute__((ext_vector_type(16)));
typedef short s16x8 __attribute__((ext_vector_type(8)));
typedef short s16x4 __attribute__((ext_vector_type(4)));
typedef float f32x4v __attribute__((ext_vector_type(4)));
#define SSD_L_ACS 0
#define SSD_L_DTS 3072
#define SSD_L_BM 6144
#define SSD_RS_B 272
#define SSD_L_X (6144 + 128 * 272)
#define SSD_RS_X 144
#define SSD_XIMG (128 * 144)
#define SSD_RS_Y 784
template <int OFF0, int OFF1>
__device__ __forceinline__ s16x8 tr_frag(unsigned base) {
    s16x4 a, b;
    asm volatile("ds_read_b64_tr_b16 %0, %2 offset:%3\n\tds_read_b64_tr_b16 %1, %2 offset:%4\n\ts_waitcnt lgkmcnt(0)"
                 : "=&v"(a), "=&v"(b) : "v"(base), "n"(OFF0), "n"(OFF1) : "memory");
    return __builtin_shufflevector(a, b, 0, 1, 2, 3, 4, 5, 6, 7);
}
__device__ __forceinline__ unsigned lds_addr(LAS unsigned char* p) { return (unsigned)(size_t)p; }
template <int O0, int O1, int O2, int O3, int O4, int O5, int O6, int O7>
__device__ __forceinline__ void tr_read8(unsigned base, s16x4 (&v)[8]) {
    asm volatile("ds_read_b64_tr_b16 %0, %8 offset:%9\n\tds_read_b64_tr_b16 %1, %8 offset:%10\n\tds_read_b64_tr_b16 %2, %8 offset:%11\n\tds_read_b64_tr_b16 %3, %8 offset:%12\n\t"
                 "ds_read_b64_tr_b16 %4, %8 offset:%13\n\tds_read_b64_tr_b16 %5, %8 offset:%14\n\tds_read_b64_tr_b16 %6, %8 offset:%15\n\tds_read_b64_tr_b16 %7, %8 offset:%16\n\ts_waitcnt lgkmcnt(0)"
                 : "=&v"(v[0]), "=&v"(v[1]), "=&v"(v[2]), "=&v"(v[3]), "=&v"(v[4]), "=&v"(v[5]), "=&v"(v[6]), "=&v"(v[7])
                 : "v"(base), "n"(O0), "n"(O1), "n"(O2), "n"(O3), "n"(O4), "n"(O5), "n"(O6), "n"(O7) : "memory");
}
#define TRCAT(a, b) __builtin_shufflevector(a, b, 0, 1, 2, 3, 4, 5, 6, 7)


__device__ __forceinline__ void ssd_chunk_acs(LAS unsigned char* ldsb, const float* __restrict__ dtv, const float* __restrict__ a_log, int t0, int g, float* cdec_out) {
    const int w = __builtin_amdgcn_readfirstlane(threadIdx.x >> 6), lane = threadIdx.x & 63;
    if (w < 6) {
        const int head = 6 * g + w;
        const float A = -__expf(a_log[head]);
        const float v0 = dtv[(size_t)(t0 + 2 * lane) * SSD_HEADS + head], v1 = dtv[(size_t)(t0 + 2 * lane + 1) * SSD_HEADS + head];
        const float a1 = v1 * A;
        float s = v0 * A + a1;
#pragma unroll
        for (int o = 1; o < 64; o <<= 1) { const float tmp = __shfl_up(s, o); if (lane >= o) s += tmp; }
        LAS float* acs = (LAS float*)(ldsb + SSD_L_ACS) + w * 128;
        LAS float* dts = (LAS float*)(ldsb + SSD_L_DTS) + w * 128;
        acs[2 * lane] = s - a1; acs[2 * lane + 1] = s;
        dts[2 * lane] = v0; dts[2 * lane + 1] = v1;
        if (cdec_out && lane == 63) cdec_out[head] = __expf(s);
    }
}

__device__ __forceinline__ void ph_ssd_states(LAS unsigned char* ldsb, const bf16* __restrict__ xbc_b, const float* __restrict__ dtv, const float* __restrict__ a_log,
                                              bf16* __restrict__ Sbuf, float* __restrict__ cdec, const float* __restrict__ ck, const float* __restrict__ cv, float* __restrict__ out) {
    const int tid = threadIdx.x, w = __builtin_amdgcn_readfirstlane(tid >> 6), lane = tid & 63;
    const int r = lane & 31, h = lane >> 5, blk = (lane >> 4) & 1, q = (lane & 15) >> 2, pp = lane & 3;
    const int nt = w & 3, pt = w >> 2;
    for (int unit = blockIdx.x; unit < BATCH * 64 * SSD_GROUPS; unit += gridDim.x) {
        const int g = unit & 3, bc = unit >> 2;
        const int t0 = bc * 128;
        __syncthreads();
        ssd_chunk_acs(ldsb, dtv, a_log, t0, g, cdec + (size_t)bc * SSD_HEADS);
#pragma unroll
        for (int it_ = 0; it_ < 4; ++it_) { const int idx = tid + it_ * NTHR; const int row = idx >> 4, ch = idx & 15;
            const v4u v = *(const v4u*)(xbc_b + (size_t)(t0 + row) * CONV_DIM + 1536 + 128 * g + ch * 8);
            *(LAS v4u*)(ldsb + SSD_L_BM + row * SSD_RS_B + ch * 16) = v; }
        __syncthreads();
#pragma unroll
        for (int it_ = 0; it_ < 12; ++it_) { const int idx = tid + it_ * NTHR; const int hh = idx >> 10, rem = idx & 1023, row = rem >> 3, ch = rem & 7;
            const LAS float* acs = (const LAS float*)(ldsb + SSD_L_ACS) + hh * 128; const LAS float* dts = (const LAS float*)(ldsb + SSD_L_DTS) + hh * 128;
            const float wgt = dts[row] * __expf(acs[127] - acs[row]);
            float f[8]; unpack8(*(const v4u*)(xbc_b + (size_t)(t0 + row) * CONV_DIM + (6 * g + hh) * 64 + ch * 8), f);
            v4u o; o.x = pk2(f[0] * wgt, f[1] * wgt); o.y = pk2(f[2] * wgt, f[3] * wgt); o.z = pk2(f[4] * wgt, f[5] * wgt); o.w = pk2(f[6] * wgt, f[7] * wgt);
            *(LAS v4u*)(ldsb + SSD_L_X + hh * SSD_XIMG + row * SSD_RS_X + ch * 16) = o; }
        __syncthreads();
        f32x4n rider[16];
        copy_q_load(ck, cv, 12288u + (unsigned)(unit * NWAVE + w), (unsigned)lane, rider);
        const unsigned abase = lds_addr(ldsb + SSD_L_BM) + (8 * h + q) * SSD_RS_B + (32 * nt + 16 * blk + 4 * pp) * 2;
        s16x8 afr[8];
        { s16x4 av[8];
          tr_read8<0 * SSD_RS_B, 4 * SSD_RS_B, 16 * SSD_RS_B, 20 * SSD_RS_B, 32 * SSD_RS_B, 36 * SSD_RS_B, 48 * SSD_RS_B, 52 * SSD_RS_B>(abase, av);
          afr[0] = TRCAT(av[0], av[1]); afr[1] = TRCAT(av[2], av[3]); afr[2] = TRCAT(av[4], av[5]); afr[3] = TRCAT(av[6], av[7]);
          tr_read8<64 * SSD_RS_B, 68 * SSD_RS_B, 80 * SSD_RS_B, 84 * SSD_RS_B, 96 * SSD_RS_B, 100 * SSD_RS_B, 112 * SSD_RS_B, 116 * SSD_RS_B>(abase, av);
          afr[4] = TRCAT(av[0], av[1]); afr[5] = TRCAT(av[2], av[3]); afr[6] = TRCAT(av[4], av[5]); afr[7] = TRCAT(av[6], av[7]); }
#pragma unroll
        for (int hh = 0; hh < 6; ++hh) {
            const unsigned xb = lds_addr(ldsb + SSD_L_X + hh * SSD_XIMG) + (8 * h + q) * SSD_RS_X + (32 * pt + 16 * blk + 4 * pp) * 2;
            f32x16 acc;
#pragma unroll
            for (int i = 0; i < 16; ++i) acc[i] = 0.f;
            { s16x4 xv[8];
              tr_read8<0 * SSD_RS_X, 4 * SSD_RS_X, 16 * SSD_RS_X, 20 * SSD_RS_X, 32 * SSD_RS_X, 36 * SSD_RS_X, 48 * SSD_RS_X, 52 * SSD_RS_X>(xb, xv);
              acc = __builtin_amdgcn_mfma_f32_32x32x16_bf16(afr[0], TRCAT(xv[0], xv[1]), acc, 0, 0, 0);
              acc = __builtin_amdgcn_mfma_f32_32x32x16_bf16(afr[1], TRCAT(xv[2], xv[3]), acc, 0, 0, 0);
              acc = __builtin_amdgcn_mfma_f32_32x32x16_bf16(afr[2], TRCAT(xv[4], xv[5]), acc, 0, 0, 0);
              acc = __builtin_amdgcn_mfma_f32_32x32x16_bf16(afr[3], TRCAT(xv[6], xv[7]), acc, 0, 0, 0);
              tr_read8<64 * SSD_RS_X, 68 * SSD_RS_X, 80 * SSD_RS_X, 84 * SSD_RS_X, 96 * SSD_RS_X, 100 * SSD_RS_X, 112 * SSD_RS_X, 116 * SSD_RS_X>(xb, xv);
              acc = __builtin_amdgcn_mfma_f32_32x32x16_bf16(afr[4], TRCAT(xv[0], xv[1]), acc, 0, 0, 0);
              acc = __builtin_amdgcn_mfma_f32_32x32x16_bf16(afr[5], TRCAT(xv[2], xv[3]), acc, 0, 0, 0);
              acc = __builtin_amdgcn_mfma_f32_32x32x16_bf16(afr[6], TRCAT(xv[4], xv[5]), acc, 0, 0, 0);
              acc = __builtin_amdgcn_mfma_f32_32x32x16_bf16(afr[7], TRCAT(xv[6], xv[7]), acc, 0, 0, 0); }
            bf16* dst = Sbuf + ((size_t)bc * SSD_HEADS + 6 * g + hh) * 8192 + (size_t)(pt * 8 + 2 * nt) * 512 + r * 8 + 4 * h;
#pragma unroll
            for (int q4 = 0; q4 < 4; ++q4) *(uint2*)(dst + (q4 >> 1) * 512 + (q4 & 1) * 256) = make_uint2(pk2(acc[4 * q4], acc[4 * q4 + 1]), pk2(acc[4 * q4 + 2], acc[4 * q4 + 3]));
        }
        copy_q_store(out, 12288u + (unsigned)(unit * NWAVE + w), (unsigned)lane, rider);
    }
}

__device__ __forceinline__ void ph_ssd_scan(const bf16* __restrict__ Sbuf, const float* __restrict__ cdec, bf16* __restrict__ Hin, float* __restrict__ out, int rank, int nranks) {
    for (int idx = rank * NTHR + threadIdx.x; idx < BATCH * SSD_HEADS * 1024; idx += nranks * NTHR) {
        const int i = idx & 1023, hb = idx >> 10, hd = hb % SSD_HEADS, b = hb / SSD_HEADS;
        float st[8];
#pragma unroll
        for (int j = 0; j < 8; ++j) st[j] = 0.f;
#pragma unroll 8
        for (int c = 0; c < 64; ++c) {
            const size_t base = (((size_t)(b * 64 + c)) * SSD_HEADS + hd) * 8192 + (size_t)i * 8;
            v4u o; o.x = pk2(st[0], st[1]); o.y = pk2(st[2], st[3]); o.z = pk2(st[4], st[5]); o.w = pk2(st[6], st[7]);
            *(v4u*)(Hin + base) = o;
            float s[8]; unpack8(*(const v4u*)(Sbuf + base), s);
            const float a = cdec[(size_t)(b * 64 + c) * SSD_HEADS + hd];
#pragma unroll
            for (int j = 0; j < 8; ++j) st[j] = a * st[j] + s[j];
        }
        const int ln = i & 63, ks = (i >> 6) & 7, pt = i >> 9, p = 32 * pt + (ln & 31), n0 = 16 * ks + 8 * (ln >> 5);
        store8f(out + OUT_PS + (((size_t)b * SSD_HEADS + hd) * 64 + p) * 128 + n0, st);
    }
}

__device__ __forceinline__ void ph_ssd_out(LAS unsigned char* ldsb, const bf16* __restrict__ xbc_b, const bf16* __restrict__ projb, const float* __restrict__ dtv,
                                           const float* __restrict__ a_log, const float* __restrict__ d_skip, const float* __restrict__ norm_g,
                                           const bf16* __restrict__ Hin, bf16* __restrict__ A1) {
    const int tid = threadIdx.x, w = __builtin_amdgcn_readfirstlane(tid >> 6), lane = tid & 63;
    const int r = lane & 31, h = lane >> 5, blk = (lane >> 4) & 1, q = (lane & 15) >> 2, pp = lane & 3;
    const int hs = w >> 2, lt = hs ? 3 - (w & 3) : (w & 3);
    for (int unit = blockIdx.x; unit < BATCH * 64 * SSD_GROUPS; unit += gridDim.x) {
        const int g = unit & 3, bc = unit >> 2;
        const int t0 = bc * 128;
        __syncthreads();
        ssd_chunk_acs(ldsb, dtv, a_log, t0, g, nullptr);
#pragma unroll
        for (int it_ = 0; it_ < 4; ++it_) { const int idx = tid + it_ * NTHR; const int row = idx >> 4, ch = idx & 15;
            const v4u v = *(const v4u*)(xbc_b + (size_t)(t0 + row) * CONV_DIM + 1536 + 128 * g + ch * 8);
            *(LAS v4u*)(ldsb + SSD_L_BM + row * SSD_RS_B + ch * 16) = v; }
#pragma unroll
        for (int it_ = 0; it_ < 12; ++it_) { const int idx = tid + it_ * NTHR; const int hh = idx >> 10, rem = idx & 1023, row = rem >> 3, ch = rem & 7;
            const v4u v = *(const v4u*)(xbc_b + (size_t)(t0 + row) * CONV_DIM + (6 * g + hh) * 64 + ch * 8);
            *(LAS v4u*)(ldsb + SSD_L_X + hh * SSD_XIMG + row * SSD_RS_X + ch * 16) = v; }
        __syncthreads();
        const bf16* cp = xbc_b + (size_t)(t0 + 32 * lt + r) * CONV_DIM + 2048 + 128 * g + 8 * h;
        s16x8 cfr[8];
#pragma unroll
        for (int ks = 0; ks < 8; ++ks) cfr[ks] = *(const s16x8*)(cp + 16 * ks);
        const int lcol = 32 * lt + r;
        const LAS float* acsb = (const LAS float*)(ldsb + SSD_L_ACS) + 3 * hs * 128; const LAS float* dtsb = (const LAS float*)(ldsb + SSD_L_DTS) + 3 * hs * 128;
        const unsigned xb0 = lds_addr(ldsb + SSD_L_X + 3 * hs * SSD_XIMG) + (4 * h + q) * SSD_RS_X + (16 * blk + 4 * pp) * 2;
        unsigned ypk[3][16];
#pragma unroll
        for (int h3 = 0; h3 < 3; ++h3) {
            const LAS float* acs = acsb + h3 * 128; const LAS float* dts = dtsb + h3 * 128;
            const float myacs = acs[lcol];
            const float Dh = d_skip[6 * g + 3 * hs + h3];
            f32x16 y0, y1;
#pragma unroll
            for (int i = 0; i < 16; ++i) { y0[i] = 0.f; y1[i] = 0.f; }
            { const bf16* hp = Hin + ((size_t)bc * SSD_HEADS + 6 * g + 3 * hs + h3) * 8192 + lane * 8;
#pragma unroll
              for (int kh = 0; kh < 2; ++kh) {
                  s16x8 hf0[4], hf1[4];
#pragma unroll
                  for (int ks = 0; ks < 4; ++ks) { hf0[ks] = *(const s16x8*)(hp + (4 * kh + ks) * 512); hf1[ks] = *(const s16x8*)(hp + (8 + 4 * kh + ks) * 512); }
#pragma unroll
                  for (int ks = 0; ks < 4; ++ks) { y0 = __builtin_amdgcn_mfma_f32_32x32x16_bf16(cfr[4 * kh + ks], hf0[ks], y0, 0, 0, 0); y1 = __builtin_amdgcn_mfma_f32_32x32x16_bf16(cfr[4 * kh + ks], hf1[ks], y1, 0, 0, 0); }
                  __builtin_amdgcn_sched_barrier(0);
              } }
#pragma unroll
            for (int q4 = 0; q4 < 4; ++q4) {
                const f32x4v a4 = *(const LAS f32x4v*)(acs + 32 * lt + 8 * q4 + 4 * h);
                const float e0 = __expf(a4[0]), e1 = __expf(a4[1]), e2 = __expf(a4[2]), e3 = __expf(a4[3]);
                y0[4 * q4] *= e0; y0[4 * q4 + 1] *= e1; y0[4 * q4 + 2] *= e2; y0[4 * q4 + 3] *= e3;
                y1[4 * q4] *= e0; y1[4 * q4 + 1] *= e1; y1[4 * q4 + 2] *= e2; y1[4 * q4 + 3] *= e3;
            }
            __builtin_amdgcn_sched_barrier(0);
            for (int st = 0; st <= lt; ++st) {
                f32x16 cb;
#pragma unroll
                for (int i = 0; i < 16; ++i) cb[i] = 0.f;
#pragma unroll
                for (int ks = 0; ks < 8; ++ks) {
                    const s16x8 bfrag = *(const LAS s16x8*)(ldsb + SSD_L_BM + (32 * st + r) * SSD_RS_B + (16 * ks + 8 * h) * 2);
                    cb = __builtin_amdgcn_mfma_f32_32x32x16_bf16(bfrag, cfr[ks], cb, 0, 0, 0);
                }
                __builtin_amdgcn_sched_barrier(0);
                const unsigned xb = xb0 + h3 * SSD_XIMG + st * 32 * SSD_RS_X;
                s16x4 xv[8];
                tr_read8<0, 8 * SSD_RS_X, 64, 8 * SSD_RS_X + 64, 16 * SSD_RS_X, 24 * SSD_RS_X, 16 * SSD_RS_X + 64, 24 * SSD_RS_X + 64>(xb, xv);
#pragma unroll
                for (int kk = 0; kk < 2; ++kk) {
                    const int s0 = 32 * st + 16 * kk + 4 * h;
                    const f32x4v as0 = *(const LAS f32x4v*)(acs + s0), as1 = *(const LAS f32x4v*)(acs + s0 + 8);
                    const f32x4v ds0 = *(const LAS f32x4v*)(dts + s0), ds1 = *(const LAS f32x4v*)(dts + s0 + 8);
                    float wv[8];
#pragma unroll
                    for (int j = 0; j < 8; ++j) {
                        const int s = s0 + 8 * (j >> 2) + (j & 3);
                        const float asj = (j < 4) ? as0[j & 3] : as1[j & 3], dsj = (j < 4) ? ds0[j & 3] : ds1[j & 3];
                        float v = cb[8 * kk + j] * __expf(myacs - asj) * dsj;
                        v = (s <= lcol) ? v : 0.f;
                        v = (s == lcol) ? v + Dh : v;
                        wv[j] = v;
                    }
                    s16x8 afr;
                    { v4u o; o.x = pk2(wv[0], wv[1]); o.y = pk2(wv[2], wv[3]); o.z = pk2(wv[4], wv[5]); o.w = pk2(wv[6], wv[7]); afr = __builtin_bit_cast(s16x8, o); }
                    const s16x8 b0 = kk == 0 ? TRCAT(xv[0], xv[1]) : TRCAT(xv[4], xv[5]);
                    const s16x8 b1 = kk == 0 ? TRCAT(xv[2], xv[3]) : TRCAT(xv[6], xv[7]);
                    y0 = __builtin_amdgcn_mfma_f32_32x32x16_bf16(afr, b0, y0, 0, 0, 0);
                    y1 = __builtin_amdgcn_mfma_f32_32x32x16_bf16(afr, b1, y1, 0, 0, 0);
                    __builtin_amdgcn_sched_barrier(0);
                }
            }
#pragma unroll
            for (int i = 0; i < 8; ++i) { ypk[h3][i] = pk2(y0[2 * i], y0[2 * i + 1]); ypk[h3][8 + i] = pk2(y1[2 * i], y1[2 * i + 1]); }
            __builtin_amdgcn_sched_barrier(0);
        }
        __syncthreads();
        {
            LAS unsigned short* yst = (LAS unsigned short*)(ldsb + SSD_L_X);
#pragma unroll
            for (int h3 = 0; h3 < 3; ++h3)
#pragma unroll
                for (int ptile = 0; ptile < 2; ++ptile)
#pragma unroll
                    for (int i = 0; i < 8; ++i) {
                        const int reg = 2 * i;
                        const int l0 = 32 * lt + (reg & 3) + 8 * (reg >> 2) + 4 * h;
                        const int col = (3 * hs + h3) * 64 + 32 * ptile + r;
                        const unsigned v = ypk[h3][8 * ptile + i];
                        yst[l0 * (SSD_RS_Y / 2) + col] = (unsigned short)(v & 0xffffu);
                        yst[(l0 + 1) * (SSD_RS_Y / 2) + col] = (unsigned short)(v >> 16);
                    }
        }
        __syncthreads();
#pragma unroll
        for (int pass = 0; pass < 4; ++pass) {
            const int l = 4 * (pass * 8 + w) + (lane >> 4), i16 = lane & 15;
            float gv[3][8]; float ss = 0.f;
#pragma unroll
            for (int k = 0; k < 3; ++k) {
                const int col0 = 24 * i16 + 8 * k;
                float yv[8], zv[8];
                unpack8(*(const LAS v4u*)(ldsb + SSD_L_X + l * SSD_RS_Y + col0 * 2), yv);
                unpack8(*(const v4u*)(projb + (size_t)(t0 + l) * NB_LD + g * 384 + col0), zv);
#pragma unroll
                for (int j = 0; j < 8; ++j) { const float gg = yv[j] * silu_f(zv[j]); gv[k][j] = gg; ss += gg * gg; }
            }
            ss += __shfl_xor(ss, 1); ss += __shfl_xor(ss, 2); ss += __shfl_xor(ss, 4); ss += __shfl_xor(ss, 8);
            const float rstd = rsqrtf(ss * (1.0f / 384.0f) + LN_EPS);
#pragma unroll
            for (int k = 0; k < 3; ++k) {
                const int col0 = g * 384 + 24 * i16 + 8 * k;
                const float4 g0 = *(const float4*)(norm_g + col0), g1 = *(const float4*)(norm_g + col0 + 4);
                v4u o; o.x = pk2(gv[k][0] * rstd * g0.x, gv[k][1] * rstd * g0.y); o.y = pk2(gv[k][2] * rstd * g0.z, gv[k][3] * rstd * g0.w);
                o.z = pk2(gv[k][4] * rstd * g1.x, gv[k][5] * rstd * g1.y); o.w = pk2(gv[k][6] * rstd * g1.z, gv[k][7] * rstd * g1.w);
                *(v4u*)(A1 + (size_t)(t0 + l) * MIX_WIDTH + col0) = o;
            }
        }
    }
}

#define ATT_RS_V 144
#define ATT_VIMG (256 * ATT_RS_V)
#define ATT_HIMG (2 * ATT_VIMG)
#define ATT_PVT(KT) { \
        s16x4 vv_[8]; \
        tr_read8<(32 * KT) * ATT_RS_V, (32 * KT + 8) * ATT_RS_V, (32 * KT) * ATT_RS_V + 64, (32 * KT + 8) * ATT_RS_V + 64, \
                 (32 * KT + 16) * ATT_RS_V, (32 * KT + 24) * ATT_RS_V, (32 * KT + 16) * ATT_RS_V + 64, (32 * KT + 24) * ATT_RS_V + 64>(vbase, vv_); \
        _Pragma("unroll") for (int s2_ = 0; s2_ < 2; ++s2_) { \
            v4u o_; o_.x = pk2(s[KT][8 * s2_ + 0], s[KT][8 * s2_ + 1]); o_.y = pk2(s[KT][8 * s2_ + 2], s[KT][8 * s2_ + 3]); \
            o_.z = pk2(s[KT][8 * s2_ + 4], s[KT][8 * s2_ + 5]); o_.w = pk2(s[KT][8 * s2_ + 6], s[KT][8 * s2_ + 7]); \
            const s16x8 pf_ = __builtin_bit_cast(s16x8, o_); \
            const s16x8 a0_ = s2_ == 0 ? TRCAT(vv_[0], vv_[1]) : TRCAT(vv_[4], vv_[5]); \
            const s16x8 a1_ = s2_ == 0 ? TRCAT(vv_[2], vv_[3]) : TRCAT(vv_[6], vv_[7]); \
            o0 = __builtin_amdgcn_mfma_f32_32x32x16_bf16(a0_, pf_, o0, 0, 0, 0); \
            o1 = __builtin_amdgcn_mfma_f32_32x32x16_bf16(a1_, pf_, o1, 0, 0, 0); } }
__device__ __forceinline__ void ph_attn_prompt(LAS unsigned char* ldsb, const bf16* __restrict__ qrot_b, const bf16* __restrict__ krot_b, const bf16* __restrict__ projb,
                                               bf16* __restrict__ obuf, float* __restrict__ lsebuf, const float* __restrict__ ck, const float* __restrict__ cv, float* __restrict__ out) {
    const int tid = threadIdx.x, w = __builtin_amdgcn_readfirstlane(tid >> 6), lane = tid & 63;
    const int r = lane & 31, h = lane >> 5, blk = (lane >> 4) & 1, q = (lane & 15) >> 2, pp = lane & 3;
    const int qt = w & 3, hsel = w >> 2;
    f32x4n rider[16]; bool pend = false; unsigned pq = 0u;
    for (int unit = blockIdx.x; unit < 3 * 512; unit += gridDim.x) {
        const int pat = unit >> 9, rem = unit & 511, hp = rem & 3, rem2 = rem >> 2, b = rem2 >> 6, bk = rem2 & 63;
        const int dsh = 2 * pat, nper = 64 >> dsh, res = bk >> (6 - dsh), nb = bk & (nper - 1);
        const int head = 2 * hp + hsel;
        __syncthreads();
        { v4u vst[8], kst[8];
#pragma unroll
          for (int it_ = 0; it_ < 8; ++it_) { const int idx = (tid & 255) + it_ * 256;
              const int row = idx >> 3, ch = idx & 7, js = 128 * nb - 128 + row, jc = js < 0 ? 0 : js;
              const size_t tk = (size_t)(b * SEQ + (jc << dsh) + res);
              vst[it_] = *(const v4u*)(projb + tk * NB_LD + NB_V + head * 64 + ch * 8);
              kst[it_] = *(const v4u*)(krot_b + tk * ATT_WIDTH + head * 64 + ch * 8); }
#pragma unroll
          for (int it_ = 0; it_ < 8; ++it_) { const int idx = (tid & 255) + it_ * 256;
              const int row = idx >> 3, ch = idx & 7, js = 128 * nb - 128 + row;
              v4u v = vst[it_], k = kst[it_]; if (js < 0) { v.x = 0u; v.y = 0u; v.z = 0u; v.w = 0u; k = v; }
              *(LAS v4u*)(ldsb + hsel * ATT_HIMG + row * ATT_RS_V + ch * 16) = v;
              *(LAS v4u*)(ldsb + hsel * ATT_HIMG + ATT_VIMG + row * ATT_RS_V + ch * 16) = k; } }
        const int tq = b * SEQ + ((128 * nb + 32 * qt + r) << dsh) + res;
        s16x8 qf[4];
#pragma unroll
        for (int ks = 0; ks < 4; ++ks) qf[ks] = *(const s16x8*)(qrot_b + (size_t)tq * ATT_WIDTH + head * 64 + 16 * ks + 8 * h);
        __syncthreads();
        f32x16 s[5];
#pragma unroll
        for (int kt = 0; kt < 5; ++kt) {
            const LAS unsigned char* kp = ldsb + hsel * ATT_HIMG + ATT_VIMG + (32 * qt + 32 * kt + r) * ATT_RS_V + 16 * h;
#pragma unroll
            for (int i = 0; i < 16; ++i) s[kt][i] = 0.f;
#pragma unroll
            for (int ks = 0; ks < 4; ++ks) s[kt] = __builtin_amdgcn_mfma_f32_32x32x16_bf16(*(const LAS s16x8*)(kp + 32 * ks), qf[ks], s[kt], 0, 0, 0);
        }
        if (pend) copy_q_store(out, pq, (unsigned)lane, rider);
        float m = -INFINITY;
#pragma unroll
        for (int kt = 0; kt < 5; ++kt) {
            const bool tile_ok = (nb > 0) || (qt + kt >= 4);
#pragma unroll
            for (int reg = 0; reg < 16; ++reg) {
                const int c = (reg & 3) + 8 * (reg >> 2) + 4 * h;
                const bool ok = tile_ok && (kt == 0 ? (c >= r) : (kt == 4 ? (c <= r) : true));
                const float v = ok ? s[kt][reg] * 0.125f : -INFINITY;
                s[kt][reg] = v; m = fmaxf(m, v);
            }
        }
        m = fmaxf(m, __shfl_xor(m, 32));
        float l = 0.f;
#pragma unroll
        for (int kt = 0; kt < 5; ++kt)
#pragma unroll
            for (int reg = 0; reg < 16; ++reg) { const float p = __expf(s[kt][reg] - m); s[kt][reg] = p; l += p; }
        l += __shfl_xor(l, 32);
        pq = (unsigned)(unit * NWAVE + w); copy_q_load(ck, cv, pq, (unsigned)lane, rider); pend = true;
        f32x16 o0, o1;
#pragma unroll
        for (int i = 0; i < 16; ++i) { o0[i] = 0.f; o1[i] = 0.f; }
        const unsigned vbase = lds_addr(ldsb + hsel * ATT_HIMG) + (32 * qt + 4 * h + q) * ATT_RS_V + (16 * blk + 4 * pp) * 2;
        ATT_PVT(0) ATT_PVT(1) ATT_PVT(2) ATT_PVT(3) ATT_PVT(4)
        const float inv = 1.0f / l;
        bf16* op = obuf + ((size_t)pat * T_PROMPT + tq) * ATT_WIDTH + head * 64 + 8 * h;
#pragma unroll
        for (int k2 = 0; k2 < 4; ++k2) {
            unsigned ax, ay, bx, by;
            if (k2 < 2) { ax = pk2(o0[8 * k2] * inv, o0[8 * k2 + 1] * inv); ay = pk2(o0[8 * k2 + 2] * inv, o0[8 * k2 + 3] * inv);
                          bx = pk2(o0[8 * k2 + 4] * inv, o0[8 * k2 + 5] * inv); by = pk2(o0[8 * k2 + 6] * inv, o0[8 * k2 + 7] * inv); }
            else { const int k3 = k2 - 2;
                   ax = pk2(o1[8 * k3] * inv, o1[8 * k3 + 1] * inv); ay = pk2(o1[8 * k3 + 2] * inv, o1[8 * k3 + 3] * inv);
                   bx = pk2(o1[8 * k3 + 4] * inv, o1[8 * k3 + 5] * inv); by = pk2(o1[8 * k3 + 6] * inv, o1[8 * k3 + 7] * inv); }
            const auto rx = __builtin_amdgcn_permlane32_swap(ax, bx, false, false);
            const auto ry = __builtin_amdgcn_permlane32_swap(ay, by, false, false);
            v4u o; o.x = rx[0]; o.y = ry[0]; o.z = rx[1]; o.w = ry[1];
            *(v4u*)(op + 16 * k2) = o;
        }
        if (h == 0) lsebuf[((size_t)pat * T_PROMPT + tq) * 8 + head] = m + __logf(l);
    }
    if (pend) copy_q_store(out, pq, (unsigned)lane, rider);
}
__device__ __forceinline__ void ph_attn_combine(const bf16* __restrict__ obuf, const float* __restrict__ lsebuf, bf16* __restrict__ A1) {
    const int lane = threadIdx.x & 63;
#pragma unroll 4
    for (int t = blockIdx.x * NWAVE + (threadIdx.x >> 6); t < T_PROMPT; t += gridDim.x * NWAVE) {
        const int hd = lane >> 3;
        const float l0 = lsebuf[((size_t)0 * T_PROMPT + t) * 8 + hd], l1 = lsebuf[((size_t)1 * T_PROMPT + t) * 8 + hd], l2 = lsebuf[((size_t)2 * T_PROMPT + t) * 8 + hd];
        const float mx = fmaxf(l0, fmaxf(l1, l2));
        const float e0 = __expf(l0 - mx), e1 = __expf(l1 - mx), e2 = __expf(l2 - mx);
        const float inv = 1.0f / (e0 + e1 + e2);
        float a[8], b[8], c[8];
        unpack8(*(const v4u*)(obuf + ((size_t)0 * T_PROMPT + t) * ATT_WIDTH + lane * 8), a);
        unpack8(*(const v4u*)(obuf + ((size_t)1 * T_PROMPT + t) * ATT_WIDTH + lane * 8), b);
        unpack8(*(const v4u*)(obuf + ((size_t)2 * T_PROMPT + t) * ATT_WIDTH + lane * 8), c);
        float o[8];
#pragma unroll
        for (int j = 0; j < 8; ++j) o[j] = (e0 * a[j] + e1 * b[j] + e2 * c[j]) * inv;
        v4u w; w.x = pk2(o[0], o[1]); w.y = pk2(o[2], o[3]); w.z = pk2(o[4], o[5]); w.w = pk2(o[6], o[7]);
        *(v4u*)(A1 + (size_t)t * MIX_WIDTH + SSD_WIDTH + lane * 8) = w;
    }
}

#define RT_RS 272
#define RT_KIMG (128 * RT_RS)
#define RT_LUT (2 * RT_KIMG)
constexpr unsigned char RT_CANDS[64] = {0, 1, 2, 3, 4, 5, 6, 7, 8, 9, 10, 11, 12, 13, 14, 15, 16, 17, 18, 19, 20, 21, 22, 23, 32, 33, 34, 35, 36, 48, 49, 50, 51, 64, 65, 66, 80, 81, 96, 97,
                                        112, 113, 128, 144, 160, 176, 192, 208, 224, 240, 0, 0, 0, 0, 0, 0, 0, 0, 0, 0, 0, 0, 0, 0};
__device__ __forceinline__ unsigned rt_mono(float f) { const unsigned u = __builtin_bit_cast(unsigned, f); return u ^ ((unsigned)((int)u >> 31) | 0x80000000u); }
__device__ __forceinline__ float rt_unmono(unsigned m) { const unsigned u = (m & 0x80000000u) ? (m ^ 0x80000000u) : ~m; return __builtin_bit_cast(float, u); }
#define RT_CE_DESC(a, b) { const unsigned x_ = (a), y_ = (b); (a) = x_ > y_ ? x_ : y_; (b) = x_ > y_ ? y_ : x_; }
#define RT_CE_ASC(a, b) { const unsigned x_ = (a), y_ = (b); (a) = x_ > y_ ? y_ : x_; (b) = x_ > y_ ? x_ : y_; }
__device__ __forceinline__ void rt_sort16(unsigned (&v)[16]) {
#pragma unroll
    for (int k = 2; k <= 16; k <<= 1)
#pragma unroll
        for (int j = k >> 1; j > 0; j >>= 1)
#pragma unroll
            for (int i = 0; i < 16; ++i) { const int l = i ^ j; if (l > i) { if ((i & k) == 0) RT_CE_DESC(v[i], v[l]) else RT_CE_ASC(v[i], v[l]) } }
}
__device__ __forceinline__ void rt_merge16(unsigned (&v)[16]) {
#pragma unroll
    for (int j = 8; j > 0; j >>= 1)
#pragma unroll
        for (int i = 0; i < 16; ++i) { const int l = i ^ j; if (l > i) RT_CE_DESC(v[i], v[l]) }
}
__device__ __forceinline__ void rt_top16(unsigned (&a)[16], const unsigned (&b)[16]) {
#pragma unroll
    for (int i = 0; i < 16; ++i) a[i] = a[i] > b[15 - i] ? a[i] : b[15 - i];
    rt_merge16(a);
}
__device__ __forceinline__ void rt_top16_partner(unsigned (&a)[16]) {
    unsigned b[16];
#pragma unroll
    for (int i = 0; i < 16; ++i) b[i] = (unsigned)__shfl_xor((int)a[i], 32);
    rt_top16(a, b);
}
__device__ __forceinline__ void rt_scores_top16(LAS unsigned char* kimg, const bf16* __restrict__ qp, int r, int h, unsigned (&k0)[16]) {
    f32x16 acc[4];
#pragma unroll
    for (int kt = 0; kt < 4; ++kt)
#pragma unroll
        for (int i = 0; i < 16; ++i) acc[kt][i] = 0.f;
#pragma unroll
    for (int ks = 0; ks < 8; ++ks) {
        const s16x8 qf = *(const s16x8*)(qp + 16 * ks);
#pragma unroll
        for (int kt = 0; kt < 4; ++kt) {
            const s16x8 kf = *(const LAS s16x8*)(kimg + (32 * kt + r) * RT_RS + (16 * ks + 8 * h) * 2);
            acc[kt] = __builtin_amdgcn_mfma_f32_32x32x16_bf16(kf, qf, acc[kt], 0, 0, 0);
        }
    }
    unsigned k1[16], k2[16], k3[16];
#pragma unroll
    for (int reg = 0; reg < 16; ++reg) {
        const unsigned ki = (unsigned)((reg & 3) + 8 * (reg >> 2) + 4 * h);
        k0[reg] = (rt_mono(acc[0][reg]) & 0xFFFFFF80u) | ki;
        k1[reg] = (rt_mono(acc[1][reg]) & 0xFFFFFF80u) | (ki + 32u);
        k2[reg] = (rt_mono(acc[2][reg]) & 0xFFFFFF80u) | (ki + 64u);
        k3[reg] = (rt_mono(acc[3][reg]) & 0xFFFFFF80u) | (ki + 96u);
    }
    rt_sort16(k0); rt_sort16(k1); rt_sort16(k2); rt_sort16(k3);
    rt_top16(k0, k1); rt_top16(k2, k3); rt_top16(k0, k2);
    rt_top16_partner(k0);
}
__device__ __forceinline__ void ph_peer_route2(LAS unsigned char* ldsb, const bf16* __restrict__ qhb, const float* __restrict__ keys1, const float* __restrict__ keys2,
                                               int* __restrict__ eidx, float* __restrict__ gate, const float* __restrict__ ck, const float* __restrict__ cv, float* __restrict__ out) {
    const int tid = threadIdx.x, w = __builtin_amdgcn_readfirstlane(tid >> 6), lane = tid & 63, r = lane & 31, h = lane >> 5;
    __syncthreads();
    for (int idx = tid; idx < 2 * 128 * 16; idx += NTHR) {
        const int tb = idx >> 11, rem = idx & 2047, row = rem >> 4, ch = rem & 15;
        const float* sp = (tb ? keys2 : keys1) + row * 128 + ch * 8;
        const float4 a = *(const float4*)sp, b = *(const float4*)(sp + 4);
        v4u o; o.x = pk2(a.x, a.y); o.y = pk2(a.z, a.w); o.z = pk2(b.x, b.y); o.w = pk2(b.z, b.w);
        *(LAS v4u*)(ldsb + tb * RT_KIMG + row * RT_RS + ch * 16) = o;
    }
    __syncthreads();
    LAS unsigned* lut = (LAS unsigned*)(ldsb + RT_LUT) + w * 512;
    for (int k = 0;; ++k) {
        int unit;
        if (gridDim.x != 256) { unit = blockIdx.x * NWAVE + w + k * (int)(gridDim.x * NWAVE); if (unit >= (T_ALL / 32) * 8) break; }
        else if (k < 2) unit = k * 2048 + blockIdx.x * NWAVE + w;
        else if (k == 2 && w == 0 && blockIdx.x < 128) unit = 4096 + (int)blockIdx.x;
        else break;
        const int tt = unit >> 3, hd = unit & 7;
        const int tok = 32 * tt + r;
        const bf16* qp = qhb + (size_t)tok * 2048 + hd * 256 + 8 * h;
        unsigned ka[16], kb[16];
        rt_scores_top16(ldsb, qp, r, h, ka);
        rt_scores_top16(ldsb + RT_KIMG, qp + 128, r, h, kb);
        float v1[16], v2[16];
#pragma unroll
        for (int i = 0; i < 16; ++i) { v1[i] = rt_unmono(ka[i] & 0xFFFFFF80u); v2[i] = rt_unmono(kb[i] & 0xFFFFFF80u); }
#pragma unroll
        for (int wd = 0; wd < 4; ++wd) {
            lut[wd * 64 + lane] = (ka[4 * wd] & 0x7Fu) | ((ka[4 * wd + 1] & 0x7Fu) << 8) | ((ka[4 * wd + 2] & 0x7Fu) << 16) | ((ka[4 * wd + 3] & 0x7Fu) << 24);
            lut[(4 + wd) * 64 + lane] = (kb[4 * wd] & 0x7Fu) | ((kb[4 * wd + 1] & 0x7Fu) << 8) | ((kb[4 * wd + 2] & 0x7Fu) << 16) | ((kb[4 * wd + 3] & 0x7Fu) << 24);
        }
        unsigned c0[16], c1[16];
        c0[0] = (rt_mono(h ? (v1[0] + v2[1]) : (v1[0] + v2[0])) & 0xFFFFFF00u) | (h ? 1u : 0u);
        c0[1] = (rt_mono(h ? (v1[0] + v2[3]) : (v1[0] + v2[2])) & 0xFFFFFF00u) | (h ? 3u : 2u);
        c0[2] = (rt_mono(h ? (v1[0] + v2[5]) : (v1[0] + v2[4])) & 0xFFFFFF00u) | (h ? 5u : 4u);
        c0[3] = (rt_mono(h ? (v1[0] + v2[7]) : (v1[0] + v2[6])) & 0xFFFFFF00u) | (h ? 7u : 6u);
        c0[4] = (rt_mono(h ? (v1[0] + v2[9]) : (v1[0] + v2[8])) & 0xFFFFFF00u) | (h ? 9u : 8u);
        c0[5] = (rt_mono(h ? (v1[0] + v2[11]) : (v1[0] + v2[10])) & 0xFFFFFF00u) | (h ? 11u : 10u);
        c0[6] = (rt_mono(h ? (v1[0] + v2[13]) : (v1[0] + v2[12])) & 0xFFFFFF00u) | (h ? 13u : 12u);
        c0[7] = (rt_mono(h ? (v1[0] + v2[15]) : (v1[0] + v2[14])) & 0xFFFFFF00u) | (h ? 15u : 14u);
        c0[8] = (rt_mono(h ? (v1[1] + v2[1]) : (v1[1] + v2[0])) & 0xFFFFFF00u) | (h ? 17u : 16u);
        c0[9] = (rt_mono(h ? (v1[1] + v2[3]) : (v1[1] + v2[2])) & 0xFFFFFF00u) | (h ? 19u : 18u);
        c0[10] = (rt_mono(h ? (v1[1] + v2[5]) : (v1[1] + v2[4])) & 0xFFFFFF00u) | (h ? 21u : 20u);
        c0[11] = (rt_mono(h ? (v1[1] + v2[7]) : (v1[1] + v2[6])) & 0xFFFFFF00u) | (h ? 23u : 22u);
        c0[12] = (rt_mono(h ? (v1[2] + v2[1]) : (v1[2] + v2[0])) & 0xFFFFFF00u) | (h ? 33u : 32u);
        c0[13] = (rt_mono(h ? (v1[2] + v2[3]) : (v1[2] + v2[2])) & 0xFFFFFF00u) | (h ? 35u : 34u);
        c0[14] = (rt_mono(h ? (v1[3] + v2[0]) : (v1[2] + v2[4])) & 0xFFFFFF00u) | (h ? 48u : 36u);
        c0[15] = (rt_mono(h ? (v1[3] + v2[2]) : (v1[3] + v2[1])) & 0xFFFFFF00u) | (h ? 50u : 49u);
        c1[0] = (rt_mono(h ? (v1[4] + v2[0]) : (v1[3] + v2[3])) & 0xFFFFFF00u) | (h ? 64u : 51u);
        c1[1] = (rt_mono(h ? (v1[4] + v2[2]) : (v1[4] + v2[1])) & 0xFFFFFF00u) | (h ? 66u : 65u);
        c1[2] = (rt_mono(h ? (v1[5] + v2[1]) : (v1[5] + v2[0])) & 0xFFFFFF00u) | (h ? 81u : 80u);
        c1[3] = (rt_mono(h ? (v1[6] + v2[1]) : (v1[6] + v2[0])) & 0xFFFFFF00u) | (h ? 97u : 96u);
        c1[4] = (rt_mono(h ? (v1[7] + v2[1]) : (v1[7] + v2[0])) & 0xFFFFFF00u) | (h ? 113u : 112u);
        c1[5] = (rt_mono(h ? (v1[9] + v2[0]) : (v1[8] + v2[0])) & 0xFFFFFF00u) | (h ? 144u : 128u);
        c1[6] = (rt_mono(h ? (v1[11] + v2[0]) : (v1[10] + v2[0])) & 0xFFFFFF00u) | (h ? 176u : 160u);
        c1[7] = (rt_mono(h ? (v1[13] + v2[0]) : (v1[12] + v2[0])) & 0xFFFFFF00u) | (h ? 208u : 192u);
        c1[8] = (rt_mono(h ? (v1[15] + v2[0]) : (v1[14] + v2[0])) & 0xFFFFFF00u) | (h ? 240u : 224u);
        c1[9] = 0u;
        c1[10] = 0u;
        c1[11] = 0u;
        c1[12] = 0u;
        c1[13] = 0u;
        c1[14] = 0u;
        c1[15] = 0u;
        rt_sort16(c0); rt_sort16(c1); rt_top16(c0, c1); rt_top16_partner(c0);
        float e[16]; float sum = 0.f;
        const float mx = rt_unmono(c0[0] & 0xFFFFFF00u);
#pragma unroll
        for (int k = 0; k < 16; ++k) { e[k] = __expf(rt_unmono(c0[k] & 0xFFFFFF00u) - mx); sum += e[k]; }
        const float inv = 1.0f / sum;
        asm volatile("s_waitcnt lgkmcnt(0)" ::: "memory");
        int ex[8]; float gv[8];
#pragma unroll
        for (int k = 0; k < 8; ++k) {
            const unsigned hm = (unsigned)(-h);
            const unsigned ck = (c0[k] & ~hm) | (c0[8 + k] & hm);
            const float ek = __builtin_bit_cast(float, (__builtin_bit_cast(unsigned, e[k]) & ~hm) | (__builtin_bit_cast(unsigned, e[8 + k]) & hm));
            const unsigned ci = (ck >> 4) & 15u, cj = ck & 15u;
            const unsigned w1 = lut[(ci >> 2) * 64 + lane], w2 = lut[(4 + (cj >> 2)) * 64 + lane];
            const unsigned i1 = (w1 >> (8 * (ci & 3))) & 0x7Fu, i2 = (w2 >> (8 * (cj & 3))) & 0x7Fu;
            ex[k] = (int)(i1 * PEER_NKEYS + i2); gv[k] = ek * inv;
        }
        int* ep = eidx + (size_t)tok * 128 + hd * 16 + 8 * h; float* gp = gate + (size_t)tok * 128 + hd * 16 + 8 * h;
        *(int4*)ep = make_int4(ex[0], ex[1], ex[2], ex[3]); *(int4*)(ep + 4) = make_int4(ex[4], ex[5], ex[6], ex[7]);
        *(float4*)gp = make_float4(gv[0], gv[1], gv[2], gv[3]); *(float4*)(gp + 4) = make_float4(gv[4], gv[5], gv[6], gv[7]);
    }
    if (gridDim.x == 256 && (w != 0 || blockIdx.x >= 128)) {
        const unsigned si = blockIdx.x < 128 ? blockIdx.x * 7u + (unsigned)(w - 1) : 896u + (blockIdx.x - 128u) * 8u + (unsigned)w;
        cache_copy_slice(ck, cv, out, 7040u + si, (unsigned)lane);
    }
}

struct Params {
    const float* in[23];
    float* out;
    unsigned char* ws;
    unsigned* bar;
};

#define WS_BAR      0ull
#define WS_XALL     (1ull << 20)
#define WS_PROJ     (WS_XALL + (size_t)T_ALL * D_MODEL * 4)
#define WS_XBC      (WS_PROJ + (size_t)T_ALL * PROJ_LD * 4)
#define WS_DT       (WS_XBC + (size_t)T_ALL * CONV_DIM * 4)
#define WS_QROT     (WS_DT + (size_t)T_ALL * SSD_HEADS * 4)
#define WS_KROT     (WS_QROT + (size_t)T_ALL * ATT_WIDTH * 4)
#define WS_YBUF     (WS_KROT + (size_t)T_ALL * ATT_WIDTH * 4)
#define WS_MIX      (WS_YBUF + (size_t)T_ALL * MIX_WIDTH * 4)
#define WS_HBUF     (WS_MIX + (size_t)T_ALL * D_MODEL * 4)
#define WS_QH       (WS_HBUF + (size_t)T_ALL * D_MODEL * 4)
#define WS_EIDX     (WS_QH + (size_t)T_ALL * 2048 * 4)
#define WS_GATE     (WS_EIDX + (size_t)T_ALL * 128 * 4)
#define WS_A0       (WS_GATE + (size_t)T_ALL * 128 * 4)
#define WS_A1       (WS_A0 + (size_t)T_ALL * D_MODEL * 2)
#define WS_A2       (WS_A1 + (size_t)T_ALL * MIX_WIDTH * 2)
#define WS_WTIN     (WS_A2 + (size_t)T_ALL * D_MODEL * 2)
#define WS_WTOUT    (WS_WTIN + (size_t)PROJ_LD * D_MODEL * 2)
#define WS_WTQ      (WS_WTOUT + (size_t)D_MODEL * MIX_WIDTH * 2)
#define WS_PROJB    (WS_WTQ + (size_t)2048 * D_MODEL * 2)
#define WS_DTRAW    (WS_PROJB + (size_t)T_ALL * NB_LD * 2)
#define WS_XBCB     (WS_DTRAW + (size_t)T_ALL * 32 * 4)
#define WS_QROTB    (WS_XBCB + (size_t)T_ALL * CONV_DIM * 2)
#define WS_KROTB    (WS_QROTB + (size_t)T_ALL * ATT_WIDTH * 2)
#define WS_UB       (WS_KROTB + (size_t)T_ALL * ATT_WIDTH * 2)
#define WS_VB       (WS_UB + (size_t)16384 * D_MODEL * 2)
#define WS_USC      (WS_VB + (size_t)16384 * D_MODEL * 2)
#define WS_VSC      (WS_USC + 16384 * 4)
#define WS_SBUF     (WS_VSC + 16384 * 4)
#define WS_HIN      (WS_SBUF + (size_t)BATCH * 64 * SSD_HEADS * 64 * 128 * 2)
#define WS_CDEC     (WS_HIN + (size_t)BATCH * 64 * SSD_HEADS * 64 * 128 * 2)
#define WS_OBUF     (WS_CDEC + (size_t)BATCH * 64 * SSD_HEADS * 4)
#define WS_LSE      (WS_OBUF + (size_t)3 * T_PROMPT * ATT_WIDTH * 2)
#define WS_ROPE     (WS_LSE + (size_t)3 * T_PROMPT * 8 * 4)
#define WS_END      (WS_ROPE + (size_t)SEQ * 64 * 4)

#define LDS_BYTES (160 * 1024)

#define KP const __attribute__((address_space(4))) Params* kp = (const __attribute__((address_space(4))) Params*)__builtin_amdgcn_kernarg_segment_ptr(); asm volatile("" : "+s"(kp)); unsigned char* ws = kp->ws; (void)ws;
#define IN(i) (kp->in[i])
#define WSP(T, off) ((T*)(ws + (off)))
__global__ void __launch_bounds__(512, 2) mega_fwd(Params p) {
    extern __shared__ __attribute__((aligned(16))) unsigned char smem[];
    if (threadIdx.x == 0) *(uint4*)smem = make_uint4(0u, 0u, 0u, 0u);
    __syncthreads();
    XcdBarrier bar = xcd_barrier_post(p.bar, (volatile LAS unsigned*)smem);
    float* lds = (float*)(smem + 256);
    LAS unsigned char* ldsb = (LAS unsigned char*)smem + 256;

    { KP ph_prologue(ldsb, IN(0), IN(1), WSP(bf16, WS_A0), IN(6), WSP(bf16, WS_WTIN), WSP(float, WS_ROPE)); }
    xcd_barrier(bar);
    { KP pg8::Gemm g{WSP(bf16, WS_A0), WSP(bf16, WS_WTIN), T_ALL, PROJ_LD, D_MODEL}; pg8::StaticOrder S; S.init(g.M, g.N, (int)gridDim.x, (int)blockIdx.x);
      pg8::EpiProj E{WSP(bf16, WS_PROJB), WSP(float, WS_DTRAW)}; pg8::gemm_phase<pg8::EpiProj, pg8::StaticOrder, false>(ldsb, g, S, E, nullptr); }
    xcd_barrier(bar);
    { KP ph_post_proj_prompt(WSP(bf16, WS_PROJB), WSP(float, WS_DTRAW), IN(7), IN(8), IN(9), WSP(float, WS_ROPE), WSP(bf16, WS_XBCB), WSP(float, WS_DT), WSP(bf16, WS_QROTB), WSP(bf16, WS_KROTB), kp->out); }
    { KP ph_post_proj2(WSP(bf16, WS_PROJB), WSP(float, WS_DTRAW), IN(4), IN(7), IN(8), IN(9), WSP(bf16, WS_XBCB), WSP(float, WS_DT), WSP(bf16, WS_QROTB), WSP(bf16, WS_KROTB), kp->out); }
    xcd_barrier(bar);
    { KP ph_ssd_states(ldsb, WSP(bf16, WS_XBCB), WSP(float, WS_DT), IN(10), WSP(bf16, WS_SBUF), WSP(float, WS_CDEC), IN(2), IN(3), kp->out); }
    __syncthreads();
    { KP ph_attn_prompt(ldsb, WSP(bf16, WS_QROTB), WSP(bf16, WS_KROTB), WSP(bf16, WS_PROJB), WSP(bf16, WS_OBUF), WSP(float, WS_LSE), IN(2), IN(3), kp->out); }
    __syncthreads();
    { KP ph_ssd_decode(WSP(bf16, WS_XBCB), WSP(float, WS_DT), IN(10), IN(11), IN(5), WSP(float, WS_YBUF), kp->out); }
    { KP ph_attn_sample3(lds, WSP(bf16, WS_QROTB), WSP(bf16, WS_KROTB), WSP(bf16, WS_PROJB), IN(2), IN(3), WSP(bf16, WS_A1)); }
    xcd_barrier(bar);
    if ((int)gridDim.x > 128) {
        if ((int)blockIdx.x < 96) {
            { KP ph_ssd_scan(WSP(bf16, WS_SBUF), WSP(float, WS_CDEC), WSP(bf16, WS_HIN), kp->out, (int)blockIdx.x, 96); }
            { KP ph_quant_tables(IN(19), IN(20), WSP(unsigned char, WS_UB), WSP(unsigned char, WS_VB), WSP(float, WS_USC), WSP(float, WS_VSC), (int)blockIdx.x, 96, 0, QSPLIT); }
        } else {
            { KP ph_prologue2(ldsb, IN(13), WSP(bf16, WS_WTOUT), IN(16), WSP(bf16, WS_WTQ), (int)blockIdx.x - 96, (int)gridDim.x - 96); }
            { KP ph_quant_tables(IN(19), IN(20), WSP(unsigned char, WS_UB), WSP(unsigned char, WS_VB), WSP(float, WS_USC), WSP(float, WS_VSC), (int)blockIdx.x - 96, (int)gridDim.x - 96, QSPLIT, 2 * 16384); }
        }
    } else {
        { KP ph_ssd_scan(WSP(bf16, WS_SBUF), WSP(float, WS_CDEC), WSP(bf16, WS_HIN), kp->out, (int)blockIdx.x, (int)gridDim.x); }
        { KP ph_prologue2(ldsb, IN(13), WSP(bf16, WS_WTOUT), IN(16), WSP(bf16, WS_WTQ), (int)blockIdx.x, (int)gridDim.x); }
        { KP ph_quant_tables(IN(19), IN(20), WSP(unsigned char, WS_UB), WSP(unsigned char, WS_VB), WSP(float, WS_USC), WSP(float, WS_VSC), (int)blockIdx.x, (int)gridDim.x); }
    }
    xcd_barrier(bar);
    { KP ph_ssd_out(ldsb, WSP(bf16, WS_XBCB), WSP(bf16, WS_PROJB), WSP(float, WS_DT), IN(10), IN(11), IN(12), WSP(bf16, WS_HIN), WSP(bf16, WS_A1)); }
    { KP ph_attn_combine(WSP(bf16, WS_OBUF), WSP(float, WS_LSE), WSP(bf16, WS_A1)); }
    { KP ph_gate_norm(WSP(bf16, WS_PROJB), IN(12), WSP(float, WS_YBUF), WSP(bf16, WS_A1)); }
    xcd_barrier(bar);
    { KP pg8::Gemm g{WSP(bf16, WS_A1), WSP(bf16, WS_WTOUT), T_ALL, D_MODEL, MIX_WIDTH}; pg8::StaticOrder S; S.init(g.M, g.N, (int)gridDim.x, (int)blockIdx.x);
      pg8::EpiBf16Plain E{WSP(bf16, WS_MIX), D_MODEL}; pg8::gemm_phase<pg8::EpiBf16Plain, pg8::StaticOrder, false>(ldsb, g, S, E, nullptr); }
    if (blockIdx.x >= 8 && gridDim.x == 256) { KP cache_copy_slice(IN(2), IN(3), kp->out, 4096u + (blockIdx.x - 8) * 8u + (threadIdx.x >> 6), threadIdx.x & 63u); }
    xcd_barrier(bar);
    { KP ph_ln_res(WSP(bf16, WS_A0), WSP(bf16, WS_MIX), IN(14), IN(15), WSP(bf16, WS_A2)); }
    xcd_barrier(bar);
    { KP pg8::Gemm g{WSP(bf16, WS_A2), WSP(bf16, WS_WTQ), T_ALL, 2048, D_MODEL}; pg8::StaticOrder S; S.init(g.M, g.N, (int)gridDim.x, (int)blockIdx.x);
      pg8::EpiBf16Plain E{WSP(bf16, WS_QH), 2048}; pg8::gemm_phase<pg8::EpiBf16Plain, pg8::StaticOrder, false>(ldsb, g, S, E, nullptr); }
    if (blockIdx.x >= 16 && gridDim.x == 256 && threadIdx.x < 256) { KP cache_copy_slice(IN(2), IN(3), kp->out, 4096u + 1984u + (blockIdx.x - 16) * 4u + (threadIdx.x >> 6), threadIdx.x & 63u); }
    xcd_barrier(bar);
    { KP ph_peer_route2(ldsb, WSP(bf16, WS_QH), IN(17), IN(18), WSP(int, WS_EIDX), WSP(float, WS_GATE), IN(2), IN(3), kp->out); }
    xcd_barrier(bar);
    { KP ph_peer_ffn3(WSP(bf16, WS_A2), WSP(int, WS_EIDX), WSP(float, WS_GATE), WSP(unsigned char, WS_UB), WSP(unsigned char, WS_VB), WSP(float, WS_USC), WSP(float, WS_VSC), IN(21), IN(22), kp->out, IN(2), IN(3), gridDim.x == 256 ? 8960u : 4096u); }
}

extern "C" void kernel_launch(void* const* d_in, const int* in_sizes, int n_in, void* d_out, int out_size, void* d_ws, size_t ws_size, hipStream_t stream) {
    static int grid = 0;
    if (grid == 0) {
        int dev = 0, cus = 0, per_cu = 0;
        if (hipGetDevice(&dev) != hipSuccess || hipDeviceGetAttribute(&cus, hipDeviceAttributeMultiprocessorCount, dev) != hipSuccess) { fprintf(stderr, "kernel_launch: device query failed\n"); grid = -1; return; }
        if (hipFuncSetAttribute((const void*)mega_fwd, hipFuncAttributeMaxDynamicSharedMemorySize, LDS_BYTES) != hipSuccess) { fprintf(stderr, "kernel_launch: hipFuncSetAttribute failed\n"); grid = -1; return; }
        if (hipOccupancyMaxActiveBlocksPerMultiprocessor(&per_cu, (const void*)mega_fwd, NTHR, LDS_BYTES) != hipSuccess || per_cu < 1) { fprintf(stderr, "kernel_launch: occupancy query says %d\n", per_cu); }
        (void)hipGetLastError();
        grid = cus;
        if (ws_size < WS_END) { fprintf(stderr, "kernel_launch: workspace too small\n"); grid = -1; return; }
    }
    if (grid < 0) return;
    (void)hipMemsetAsync((char*)d_ws + WS_BAR, 0, XCD_BAR_WORDS * sizeof(unsigned), stream);
    Params p{};
    for (int i = 0; i < 23; ++i) p.in[i] = (const float*)d_in[i];
    p.out = (float*)d_out; p.ws = (unsigned char*)d_ws; p.bar = (unsigned*)((char*)d_ws + WS_BAR);
    hipLaunchKernelGGL(mega_fwd, dim3(grid), dim3(NTHR), LDS_BYTES, stream, p);
}
```

```cpp
#include <hip/hip_runtime.h>
#include <stdint.h>

#define D_MODEL 1024
#define BATCH 2
#define SEQ 8192
#define DEC_BATCH 128
#define DEC_SEQ 4
#define PAST_LEN 8192
#define HEAD_DIM 64
#define ATT_WIDTH 512
#define ATT_HEADS 8
#define SSD_WIDTH 1536
#define SSD_HEADS 24
#define SSD_GROUPS 4
#define SSD_STATE 128
#define CONV_DIM 2560
#define IN_WIDTH 5656
#define PROJ_LD 5888
#define MIX_WIDTH 2048
#define WBUF 2048
#define PEER_NKEYS 128
#define PEER_HEADS 8
#define PEER_TOPK 16
#define PEER_DKEY 256
#define T_PROMPT (BATCH * SEQ)
#define T_SAMPLE (DEC_BATCH * DEC_SEQ)
#define T_ALL (T_PROMPT + T_SAMPLE)
#define O_Z 0
#define O_XBC 1536
#define O_DT 4096
#define O_Q 4120
#define O_K 4632
#define O_V 5144
#define ALPHA_F 1.189207115002721f
#define LN_EPS 1e-5f

#define OUT_YP 0ull
#define OUT_YS (OUT_YP + 16777216ull)
#define OUT_PK (OUT_YS + 524288ull)
#define OUT_PV (OUT_PK + 2097152ull)
#define OUT_PC (OUT_PV + 2097152ull)
#define OUT_PS (OUT_PC + 15360ull)
#define OUT_SK (OUT_PS + 393216ull)
#define OUT_SV (OUT_SK + 134217728ull)
#define OUT_SC (OUT_SV + 134217728ull)
#define OUT_SS (OUT_SC + 983040ull)

__constant__ double ROPE_INV_REV[32] = {
    1.59154943091895346e-01, 1.19349370211248862e-01, 8.94994016088910133e-02, 6.71150830052272551e-02,
    5.03292121044870353e-02, 3.77415847174197711e-02, 2.83021958306233987e-02, 2.12236527647776604e-02,
    1.59154943091895339e-02, 1.19349370211248862e-02, 8.94994016088910237e-03, 6.71150830052272534e-03,
    5.03292121044870370e-03, 3.77415847174197719e-03, 2.83021958306233987e-03, 2.12236527647776622e-03,
    1.59154943091895356e-03, 1.19349370211248849e-03, 8.94994016088910237e-04, 6.71150830052272599e-04,
    5.03292121044870326e-04, 3.77415847174197741e-04, 2.83021958306233954e-04, 2.12236527647776605e-04,
    1.59154943091895351e-04, 1.19349370211248862e-04, 8.94994016088910182e-05, 6.71150830052272545e-05,
    5.03292121044870354e-05, 3.77415847174197768e-05, 2.83021958306233961e-05, 2.12236527647776592e-05
};

__device__ __forceinline__ float silu_f(float x) { return x * __builtin_amdgcn_rcpf(1.0f + __expf(-x)); }
__device__ __forceinline__ float softplus_f(float x) { return fmaxf(x, 0.f) + log1pf(__expf(-fabsf(x))); }
__device__ __forceinline__ float gelu_f(float x) { return 0.5f * x * (1.0f + erff(x * 0.70710678118654752f)); }
__device__ __forceinline__ float wave_sum(float v) {
#pragma unroll
    for (int o = 32; o > 0; o >>= 1) v += __shfl_xor(v, o);
    return v;
}
__device__ __forceinline__ float wave_max(float v) {
#pragma unroll
    for (int o = 32; o > 0; o >>= 1) v = fmaxf(v, __shfl_xor(v, o));
    return v;
}

#include <cstdio>
#define XB_TMO      128
#define XB_XCNT(j)  (256  + 64 * (j))
#define XB_XSUB(j)  (1280 + 64 * (j))
#define XB_XGEN(j)  (2304 + 64 * (j))
#define XB_TOP      3328
#define XB_TOPGEN   3392
#define XCD_BAR_WORDS 3456
#define XB_SPIN_CAP (1u << 18)
#define LAS __attribute__((address_space(3)))

__device__ __forceinline__ unsigned xb_ld(unsigned* p)              { return __hip_atomic_load(p, __ATOMIC_RELAXED, __HIP_MEMORY_SCOPE_AGENT); }
__device__ __forceinline__ unsigned xb_add(unsigned* p, unsigned v) { return __hip_atomic_fetch_add(p, v, __ATOMIC_RELAXED, __HIP_MEMORY_SCOPE_AGENT); }
__device__ __forceinline__ unsigned xb_xcc_id() { return (unsigned)__builtin_amdgcn_s_getreg((3 << 11) | 20) & 0xFu; }
#define XB_SPIN(cond, bar) do { unsigned _sp = 0; while (cond) { __builtin_amdgcn_s_sleep(1); \
    if ((++_sp & 255u) == 0u) { if (xb_ld(&(bar)[XB_TMO])) break; if (_sp > XB_SPIN_CAP) { atomicAdd(&(bar)[XB_TMO], 1u); break; } } } } while (0)

struct XcdBarrier {
    unsigned* bar; unsigned x;
    volatile LAS unsigned* st;
};

__device__ __forceinline__ XcdBarrier xcd_barrier_post(unsigned* bar, volatile LAS unsigned* st) {
    XcdBarrier b; b.bar = bar; b.x = xb_xcc_id(); b.st = st;
    if (threadIdx.x == 0) (void)xb_add(&bar[XB_XCNT(b.x)], 1u);
    return b;
}
__device__ __forceinline__ void xcd_barrier_complete(unsigned* bar, unsigned x, unsigned& nloc, unsigned& nx) {
    const unsigned G = gridDim.x * gridDim.y * gridDim.z;
    unsigned sum, cnt, mine, sp = 0u;
    for (;;) {
        sum = 0u; cnt = 0u; mine = 0u;
#pragma unroll
        for (unsigned j = 0; j < 16; ++j) { const unsigned c = xb_ld(&bar[XB_XCNT(j)]); sum += c; cnt += (c > 0u) ? 1u : 0u; mine = (j == x) ? c : mine; }
        if (sum == G) break;
        __builtin_amdgcn_s_sleep(1);
        if ((++sp & 255u) == 0u) { if (xb_ld(&bar[XB_TMO])) break; if (sp > XB_SPIN_CAP) { atomicAdd(&bar[XB_TMO], 1u); break; } }
    }
    nloc = mine > 0u ? mine : 1u; nx = cnt > 0u ? cnt : 1u;
}

__device__ __forceinline__ void xcd_barrier(const XcdBarrier& b) {
    asm volatile("s_waitcnt vmcnt(0)" ::: "memory");
    __syncthreads();
    if (threadIdx.x == 0) {
        unsigned* bar = b.bar;
        __builtin_amdgcn_s_waitcnt(0);
        unsigned nloc = b.st[0], nx = b.st[1];
        if (nloc == 0u) { xcd_barrier_complete(bar, b.x, nloc, nx); b.st[0] = nloc; b.st[1] = nx; }
        const unsigned old = xb_add(&bar[XB_XSUB(b.x)], 1u);
        const unsigned gen = old / nloc;
        if (old + 1u == (gen + 1u) * nloc) {
            __builtin_amdgcn_fence(__ATOMIC_RELEASE, "agent");
            asm volatile("s_waitcnt vmcnt(0)" ::: "memory");
            const unsigned og = xb_add(&bar[XB_TOP], 1u);
            const unsigned tg = og / nx;
            if (og + 1u == (tg + 1u) * nx) xb_add(&bar[XB_TOPGEN], 1u);
            else XB_SPIN(xb_ld(&bar[XB_TOPGEN]) == tg, bar);
            __builtin_amdgcn_fence(__ATOMIC_ACQUIRE, "agent");
            xb_add(&bar[XB_XGEN(b.x)], 1u);
            asm volatile("s_waitcnt vmcnt(0)" ::: "memory");
        } else {
            XB_SPIN(xb_ld(&bar[XB_XGEN(b.x)]) == gen, bar);
            __builtin_amdgcn_fence(__ATOMIC_ACQUIRE, "agent");
            asm volatile("s_waitcnt vmcnt(0)" ::: "memory");
        }
    }
    __syncthreads();
}


#define GAS __attribute__((address_space(1)))
typedef unsigned short bf16;
typedef unsigned v4u __attribute__((ext_vector_type(4)));
#define LDS_WAIT() asm volatile("s_waitcnt lgkmcnt(0)" ::: "memory")
__device__ __forceinline__ unsigned f2bf(float f) { unsigned u = __builtin_bit_cast(unsigned, f); return (u + 0x7fffu + ((u >> 16) & 1u)) >> 16; }
__device__ __forceinline__ unsigned pk2(float lo, float hi) { return f2bf(lo) | (f2bf(hi) << 16); }
__device__ __forceinline__ float bf2f(unsigned short b) { return __builtin_bit_cast(float, (unsigned)b << 16); }
#include <hip/hip_runtime.h>
namespace pg8 {
#define PG8_LAS __attribute__((address_space(3)))
typedef unsigned short bf16_t;
typedef short bf16x8 __attribute__((ext_vector_type(8)));
typedef float f32x4 __attribute__((ext_vector_type(4)));
typedef unsigned u32x4 __attribute__((ext_vector_type(4)));
constexpr int BM = 256, BK = 64, HALF = 128, HTB = HALF * BK * 2  , STAGE_BYTES = 8 * HTB, NXCD = 8, WGM = 8;

__host__ __device__ __forceinline__ int lds_byte(int r, int c) { const int st = (r >> 4) * 2 + (c >> 5), rr = r & 15, cc = c & 31, ob = rr * 64 + cc * 2; return st * 1024 + (ob ^ (((ob >> 9) & 1) << 5)); }
__host__ __device__ __forceinline__ void stage_rc(int b, int& R, int& C) { const int st = b / 1024, sb = b % 1024, swz = sb ^ (((sb >> 9) & 1) << 5); R = (st >> 1) * 16 + swz / 64; C = (st & 1) * 32 + (swz % 64) / 2; }
__host__ __device__ __forceinline__ int perm32(int rho) { const int n = rho >> 4, i = rho & 15; return 8 * (i >> 2) + 4 * n + (i & 3); }

struct Unit { int pm, pn; };
struct Gemm { const bf16_t* A; const bf16_t* Bt; int M, N, K; };

struct StaticOrder {
    int nM, nN, nwg, G, c;
    __host__ __device__ void init(int M, int N, int G_, int c_) { nM = M / BM; nN = N / BM; nwg = nM * nN; G = G_; c = c_; }
    __host__ __device__ bool next(int i, Unit& u) const {
        const long L = (long)i * G + c; if (L >= nwg) return false;
        int wgid = (int)L; { const int q = nwg / NXCD, r = nwg % NXCD, xcd = wgid % NXCD, off = wgid / NXCD; wgid = (xcd < r ? xcd * (q + 1) : r * (q + 1) + (xcd - r) * q) + off; }
        const int nig = WGM * nN, gid = wgid / nig, fm = gid * WGM, gsz = (nM - fm) < WGM ? (nM - fm) : WGM;
        u.pm = fm + ((wgid % nig) % gsz); u.pn = (wgid % nig) / gsz; return true;
    }
    __device__ __forceinline__ void a_ready(const Unit&) const {}
    __device__ __forceinline__ void done(const Unit&) const {}
};
__device__ __forceinline__ unsigned cvt_pk_bf16(float lo, float hi) { unsigned r; asm volatile("v_cvt_pk_bf16_f32 %0, %1, %2" : "=v"(r) : "v"(lo), "v"(hi)); return r; }
typedef float f32x2 __attribute__((ext_vector_type(2)));
__device__ __forceinline__ f32x2 gelu_pk(f32x2 v) {
    const f32x2 av = __builtin_elementwise_abs(v), d = av * 0.2316418882f + 1.0f;
    f32x2 t; t.x = __builtin_amdgcn_rcpf(d.x); t.y = __builtin_amdgcn_rcpf(d.y);
    f32x2 q = t * 0.5307027145f + (-0.7265760135f); q = q * t + 0.7107068705f; q = q * t + (-0.142248368f); q = q * t + 0.127414796f; q = q * t;
    const f32x2 s = (v * v) * (-0.72134752044f);
    f32x2 e; e.x = __builtin_amdgcn_exp2f(s.x); e.y = __builtin_amdgcn_exp2f(s.y);
    const f32x2 m = v * (q * e), r = v - m;
    f32x2 o; o.x = v.x < 0.f ? m.x : r.x; o.y = v.y < 0.f ? m.y : r.y; return o;
}

struct EpiF32 {
    static constexpr bool PERM = false, AFTER_DRAIN = false;
    float* C; int ldc; const float* bias;
    __device__ __forceinline__ void operator()(const f32x4 (&acc)[2][2][4][2], const Unit& u, int wr, int wc, int fr, int fq) const {
        const int row0 = u.pm * BM + wr * 64 + fr, col0 = u.pn * BM + wc * 32 + 4 * fq;
        f32x4 bv[2][2];
#pragma unroll
        for (int bj = 0; bj < 2; ++bj)
#pragma unroll
            for (int n = 0; n < 2; ++n) bv[bj][n] = bias ? *(const f32x4*)(bias + col0 + bj * HALF + n * 16) : (f32x4){0.f, 0.f, 0.f, 0.f};
#pragma unroll
        for (int ai = 0; ai < 2; ++ai)
#pragma unroll
            for (int m = 0; m < 4; ++m) { float* rowp = C + (size_t)(row0 + ai * HALF + m * 16) * ldc + col0;
#pragma unroll
                for (int bj = 0; bj < 2; ++bj)
#pragma unroll
                    for (int n = 0; n < 2; ++n) *(f32x4*)(rowp + bj * HALF + n * 16) = acc[ai][bj][m][n] + bv[bj][n]; }
    }
};

template <class Epi, class Sched, bool STAMP = false>
__device__ __forceinline__ void gemm_phase(PG8_LAS unsigned char* lds, const Gemm g, const Sched& S, const Epi& E, unsigned long long* stamps) {
    int tid = threadIdx.x; asm volatile("" : "+v"(tid));
    const int wid = __builtin_amdgcn_readfirstlane(tid >> 6), lane = tid & 63, wr = wid >> 2, wc = wid & 3, fr = lane & 15, fq = lane >> 4;
    const int K = g.K, nt = K / BK;
    int ts_lo = 0, ts_hi = 0, nts = 0; const unsigned long long rt_entry = STAMP ? (unsigned long long)wall_clock64() : 0ull;
#define PG8_STAMP() do { if (STAMP && wid == 0 && nts < 64) { const unsigned long long _c = (unsigned long long)clock64(); \
        ts_lo = (lane == nts) ? (int)(unsigned)_c : ts_lo; ts_hi = (lane == nts) ? (int)(unsigned)(_c >> 32) : ts_hi; ++nts; } } while (0)
    PG8_STAMP();
    unsigned voffA[2], voffB[2];
#pragma unroll
    for (int i = 0; i < 2; ++i) { int R, C; stage_rc(tid * 16 + i * 8192, R, C); const int Rb = Epi::PERM ? ((R & ~31) + perm32(R & 31)) : R;
        voffA[i] = (unsigned)(R * K + C) * 2u; voffB[i] = (unsigned)(Rb * K + C) * 2u; }
    const size_t kstep = (size_t)(BK * 2);
    const size_t hstep = (size_t)HALF * K * 2;
    const size_t tstep = 2 * hstep;
    const unsigned ldsw = (unsigned)wid * 1024u;
    const int aoff = lds_byte(wr * 64 + fr, fq * 8), boff = lds_byte(wc * 32 + fr, fq * 8);
#define PG8_SA(b, h) (((b) * 2 + (h)) * HTB)
#define PG8_SB(b, h) ((4 + (b) * 2 + (h)) * HTB)
#define PG8_STAGE(bufoff, gbase, voff) do { _Pragma("unroll") for (int _i = 0; _i < 2; ++_i) \
        __builtin_amdgcn_global_load_lds((const unsigned*)((const char*)(gbase) + (voff)[_i]), (PG8_LAS unsigned*)(lds + (bufoff) + ldsw + _i * 8192), 16, 0, 0); } while (0)
#define PG8_LDA(dst, b, h) do { _Pragma("unroll") for (int m = 0; m < 4; ++m) _Pragma("unroll") for (int k = 0; k < 2; ++k) dst[m][k] = *(const PG8_LAS bf16x8*)(lds + PG8_SA(b, h) + aoff + m * 2048 + k * 1024); } while (0)
#define PG8_LDB(dst, b, h) do { _Pragma("unroll") for (int n = 0; n < 2; ++n) _Pragma("unroll") for (int k = 0; k < 2; ++k) dst[n][k] = *(const PG8_LAS bf16x8*)(lds + PG8_SB(b, h) + boff + n * 2048 + k * 1024); } while (0)
#define PG8_MMA(ai, bj, At, Bt) do { __builtin_amdgcn_s_setprio(1); _Pragma("unroll") for (int m = 0; m < 4; ++m) _Pragma("unroll") for (int n = 0; n < 2; ++n) _Pragma("unroll") for (int k = 0; k < 2; ++k) \
        acc[ai][bj][m][n] = __builtin_amdgcn_mfma_f32_16x16x32_bf16(Bt[n][k], At[m][k], acc[ai][bj][m][n], 0, 0, 0); __builtin_amdgcn_s_setprio(0); } while (0)
#define PG8_WAIT_V(n) asm volatile("s_waitcnt vmcnt(" #n ")" ::: "memory")
#define PG8_WAIT_L(n) asm volatile("s_waitcnt lgkmcnt(" #n ")" ::: "memory")
#define PG8_BAR __builtin_amdgcn_s_barrier()
#define PG8_SCHED __builtin_amdgcn_sched_barrier(0)
    Unit cur, nxt; int ui = 0;
    if (!S.next(0, cur)) return;
    f32x4 acc[2][2][4][2];
#pragma unroll
    for (int a = 0; a < 2; ++a)
#pragma unroll
        for (int b = 0; b < 2; ++b)
#pragma unroll
            for (int m = 0; m < 4; ++m)
#pragma unroll
                for (int n = 0; n < 2; ++n) acc[a][b][m][n] = (f32x4){0.f, 0.f, 0.f, 0.f};
    bf16x8 At[4][2], B0[2][2], B1[2][2];
    const char* cA = (const char*)g.A + (size_t)cur.pm * tstep; const char* cB = (const char*)g.Bt + (size_t)cur.pn * tstep;
    S.a_ready(cur);
    PG8_STAGE(PG8_SB(0, 0), cB, voffB); PG8_STAGE(PG8_SA(0, 0), cA, voffA); PG8_STAGE(PG8_SB(0, 1), cB + hstep, voffB); PG8_STAGE(PG8_SA(0, 1), cA + hstep, voffA);
    if (wr == 1) PG8_BAR;
    PG8_WAIT_V(4); PG8_BAR;
    PG8_STAGE(PG8_SB(1, 0), cB + kstep, voffB); PG8_STAGE(PG8_SA(1, 0), cA + kstep, voffA); PG8_STAGE(PG8_SB(1, 1), cB + hstep + kstep, voffB);
    PG8_WAIT_V(6); PG8_BAR;
    PG8_STAMP();
    for (;;) {
        const bool has_next = S.next(ui + 1, nxt);
        const char* nA = has_next ? (const char*)g.A + (size_t)nxt.pm * tstep : cA; const char* nB = has_next ? (const char*)g.Bt + (size_t)nxt.pn * tstep : cB;
        for (int t = 0; t < nt; t += 2) {
            const bool last = (t == nt - 2);
            const char* a1 = cA + (size_t)(t + 1) * kstep;
            const char* a2 = last ? nA : cA + (size_t)(t + 2) * kstep; const char* b2 = last ? nB : cB + (size_t)(t + 2) * kstep;
            const char* a3 = a2 + kstep; const char* b3 = b2 + kstep;
            if (last && has_next) S.a_ready(nxt);
            PG8_LDB(B0, 0, 0); PG8_SCHED; PG8_LDA(At, 0, 0); PG8_STAGE(PG8_SA(1, 1), a1 + hstep, voffA);
            PG8_WAIT_L(8); PG8_BAR; PG8_WAIT_L(0); PG8_MMA(0, 0, At, B0); PG8_BAR; PG8_SCHED;
            PG8_LDB(B1, 0, 1); PG8_STAGE(PG8_SB(0, 0), b2, voffB);
            PG8_BAR; PG8_WAIT_L(0); PG8_MMA(0, 1, At, B1); PG8_BAR;
            PG8_LDA(At, 0, 1); PG8_STAGE(PG8_SA(0, 0), a2, voffA);
            PG8_BAR; PG8_WAIT_L(0); PG8_MMA(1, 0, At, B0); PG8_BAR; PG8_SCHED;
            PG8_STAGE(PG8_SB(0, 1), b2 + hstep, voffB);
            PG8_WAIT_V(6); PG8_BAR; PG8_MMA(1, 1, At, B1); PG8_BAR;
            PG8_LDB(B0, 1, 0); PG8_SCHED; PG8_LDA(At, 1, 0); PG8_STAGE(PG8_SA(0, 1), a2 + hstep, voffA);
            PG8_WAIT_L(8); PG8_BAR; PG8_WAIT_L(0); PG8_MMA(0, 0, At, B0); PG8_BAR; PG8_SCHED;
            PG8_LDB(B1, 1, 1); PG8_STAGE(PG8_SB(1, 0), b3, voffB);
            PG8_BAR; PG8_WAIT_L(0); PG8_MMA(0, 1, At, B1); PG8_BAR;
            PG8_LDA(At, 1, 1); PG8_STAGE(PG8_SA(1, 0), a3, voffA);
            PG8_BAR; PG8_WAIT_L(0); PG8_MMA(1, 0, At, B0); PG8_BAR; PG8_SCHED;
            PG8_STAGE(PG8_SB(1, 1), b3 + hstep, voffB);
            PG8_WAIT_V(6); PG8_BAR; PG8_MMA(1, 1, At, B1); PG8_BAR;
        }
        PG8_STAMP();
        if constexpr (!Epi::AFTER_DRAIN) { E(acc, cur, wr, wc, fr, fq); S.done(cur); }
        PG8_STAMP();
        if (!has_next) break;
#pragma unroll
        for (int a = 0; a < 2; ++a)
#pragma unroll
            for (int b = 0; b < 2; ++b)
#pragma unroll
                for (int m = 0; m < 4; ++m)
#pragma unroll
                    for (int n = 0; n < 2; ++n) acc[a][b][m][n] = (f32x4){0.f, 0.f, 0.f, 0.f};
        cur = nxt; cA = nA; cB = nB; ++ui;
    }
    PG8_WAIT_V(0);
    if (wr == 0) PG8_BAR;
    PG8_BAR;
    if constexpr (Epi::AFTER_DRAIN) { E.fused(acc, cur, wr, wc, fr, fq, lds, wid, lane); S.done(cur); }
    PG8_STAMP();
    if (STAMP && wid == 0) { stamps[lane] = lane < nts ? (((unsigned long long)(unsigned)ts_hi << 32) | (unsigned)ts_lo) : 0ull;
        if (lane == 62) stamps[62] = rt_entry; if (lane == 63) stamps[63] = (unsigned long long)wall_clock64(); }
#undef PG8_STAMP
#undef PG8_SA
#undef PG8_SB
#undef PG8_STAGE
#undef PG8_LDA
#undef PG8_LDB
#undef PG8_MMA
#undef PG8_WAIT_V
#undef PG8_WAIT_L
#undef PG8_BAR
#undef PG8_SCHED
}
}


namespace pg8 {
struct EpiProj {
    static constexpr bool PERM = true, AFTER_DRAIN = false;
    bf16_t* O; float* dtraw;
    __device__ __forceinline__ void operator()(const f32x4 (&acc)[2][2][4][2], const Unit& u, int wr, int wc, int fr, int fq) const {
        const int row0 = u.pm * BM + wr * 64 + fr;
        if (u.pn < 22) {
            const int col0 = u.pn * BM + wc * 32 + 8 * fq;
#pragma unroll
            for (int ai = 0; ai < 2; ++ai)
#pragma unroll
                for (int m = 0; m < 4; ++m) { bf16_t* rowp = O + (size_t)(row0 + ai * HALF + m * 16) * 5632 + col0;
#pragma unroll
                    for (int bj = 0; bj < 2; ++bj) { const f32x4 v0 = acc[ai][bj][m][0], v1 = acc[ai][bj][m][1];
                        u32x4 w; w.x = cvt_pk_bf16(v0[0], v0[1]); w.y = cvt_pk_bf16(v0[2], v0[3]); w.z = cvt_pk_bf16(v1[0], v1[1]); w.w = cvt_pk_bf16(v1[2], v1[3]);
                        *(u32x4*)(rowp + bj * HALF) = w; } }
        } else if (wc == 0) {
#pragma unroll
            for (int ai = 0; ai < 2; ++ai)
#pragma unroll
                for (int m = 0; m < 4; ++m) { float* rp = dtraw + (size_t)(row0 + ai * HALF + m * 16) * 32 + 8 * fq;
                    *(f32x4*)rp = acc[ai][0][m][0]; *(f32x4*)(rp + 4) = acc[ai][0][m][1]; }
        }
    }
};
}


namespace pg8 {
struct EpiBf16Plain {
    static constexpr bool PERM = true, AFTER_DRAIN = false;
    bf16_t* O; int ldc;
    __device__ __forceinline__ void operator()(const f32x4 (&acc)[2][2][4][2], const Unit& u, int wr, int wc, int fr, int fq) const {
        const int row0 = u.pm * BM + wr * 64 + fr, col0 = u.pn * BM + wc * 32 + 8 * fq;
#pragma unroll
        for (int ai = 0; ai < 2; ++ai)
#pragma unroll
            for (int m = 0; m < 4; ++m) { bf16_t* rowp = O + (size_t)(row0 + ai * HALF + m * 16) * ldc + col0;
#pragma unroll
                for (int bj = 0; bj < 2; ++bj) { const f32x4 v0 = acc[ai][bj][m][0], v1 = acc[ai][bj][m][1];
                    u32x4 w; w.x = cvt_pk_bf16(v0[0], v0[1]); w.y = cvt_pk_bf16(v0[2], v0[3]); w.z = cvt_pk_bf16(v1[0], v1[1]); w.w = cvt_pk_bf16(v1[2], v1[3]);
                    *(u32x4*)(rowp + bj * HALF) = w; } }
    }
};
}

#define NTHR 512
#define NWAVE 8

__device__ __forceinline__ void ph_gemm_f32(float* lds, const float* __restrict__ A, const float* __restrict__ B, float* __restrict__ C,
                                            int M, int N, int K, int lda, int ldb, int ldc) {
    const int tid = threadIdx.x & 255, half = threadIdx.x >> 8, tx = tid & 15, ty = tid >> 4;
    float (*As)[68] = (float (*)[68])(lds + half * 2 * 16 * 68);
    float (*Bs)[68] = (float (*)[68])(lds + half * 2 * 16 * 68 + 16 * 68);
    const int ntx = (N + 63) / 64, nty = M / 64, ntiles = ntx * nty;
    for (int it = blockIdx.x; 2 * it < ntiles; it += gridDim.x) {
        const int tile = 2 * it + half;
        const int m0 = (tile / ntx) * 64, n0 = (tile % ntx) * 64;
        float acc[4][4];
#pragma unroll
        for (int i = 0; i < 4; ++i)
#pragma unroll
            for (int j = 0; j < 4; ++j) acc[i][j] = 0.f;
        for (int k0 = 0; k0 < K; k0 += 16) {
#pragma unroll
            for (int i = 0; i < 4; ++i) {
                int idx = tid + i * 256;
                int r = idx >> 4, c = idx & 15;
                As[c][r] = (m0 + r < M) ? A[(size_t)(m0 + r) * lda + k0 + c] : 0.f;
                int rb = idx >> 6, cb = idx & 63;
                Bs[rb][cb] = (n0 + cb < N) ? B[(size_t)(k0 + rb) * ldb + n0 + cb] : 0.f;
            }
            __syncthreads();
#pragma unroll
            for (int k = 0; k < 16; ++k) {
                float a[4], b[4];
#pragma unroll
                for (int i = 0; i < 4; ++i) { a[i] = As[k][ty * 4 + i]; b[i] = Bs[k][tx * 4 + i]; }
#pragma unroll
                for (int i = 0; i < 4; ++i)
#pragma unroll
                    for (int j = 0; j < 4; ++j) acc[i][j] += a[i] * b[j];
            }
            __syncthreads();
        }
#pragma unroll
        for (int i = 0; i < 4; ++i)
#pragma unroll
            for (int j = 0; j < 4; ++j) {
                int r = m0 + ty * 4 + i, c = n0 + tx * 4 + j;
                if (r < M && c < N) C[(size_t)r * ldc + c] = acc[i][j];
            }
    }
}


template <int MODE>
__device__ __forceinline__ void transpose_item(const float* __restrict__ W, int K, int N, int Npad, bf16* __restrict__ WT, LAS float* scr, int item, int lane) {
    const int nblk = Npad / 32, kb = item / nblk, nb = item % nblk, k0 = 64 * kb, n0 = 32 * nb;
    const int n = n0 + (lane & 31);
    int sc = n;
    if (MODE == 1) sc = (n < 4096) ? n : (n < 5632 ? n + 24 : (n < 5656 ? n - 5632 + 4096 : -1));
    else sc = (n < N) ? n : -1;
#pragma unroll 8
    for (int i = 0; i < 32; ++i) { const int kk = 2 * i + (lane >> 5); scr[kk * 33 + (lane & 31)] = (sc >= 0) ? W[(size_t)(k0 + kk) * N + sc] : 0.f; }
    LDS_WAIT(); asm volatile("" ::: "memory");
    const int c = lane & 7;
#pragma unroll
    for (int j = 0; j < 4; ++j) { const int nn = (lane >> 3) + 8 * j; const LAS float* s = scr + (8 * c) * 33 + nn;
        v4u o; o.x = pk2(s[0 * 33], s[1 * 33]); o.y = pk2(s[2 * 33], s[3 * 33]); o.z = pk2(s[4 * 33], s[5 * 33]); o.w = pk2(s[6 * 33], s[7 * 33]);
        *(v4u*)(WT + (size_t)(n0 + nn) * K + k0 + 8 * c) = o; }
    LDS_WAIT(); asm volatile("" ::: "memory");
}
__device__ __forceinline__ void ph_prologue(LAS unsigned char* ldsb, const float* __restrict__ xp, const float* __restrict__ xs, bf16* __restrict__ A0,
                                            const float* __restrict__ w_in, bf16* __restrict__ wt_in, float* __restrict__ rope_tab) {
    const int lane = threadIdx.x & 63, wave = threadIdx.x >> 6;
    LAS float* scr = (LAS float*)(ldsb + wave * 16384);
    const int gw = blockIdx.x * NWAVE + wave, NGW = gridDim.x * NWAVE;
    constexpr int I_IN = (D_MODEL / 64) * (PROJ_LD / 32);
    for (int it = gw; it < I_IN; it += NGW) transpose_item<1>(w_in, D_MODEL, IN_WIDTH, PROJ_LD, wt_in, scr, it, lane);
    for (int idx = blockIdx.x * NTHR + threadIdx.x; idx < SEQ * 32; idx += gridDim.x * NTHR) {
        const int pos = idx >> 5, j = idx & 31;
        const double rev = (double)pos * ROPE_INV_REV[j];
        const float fr = (float)(rev - floor(rev));
        rope_tab[(size_t)pos * 64 + j] = __builtin_amdgcn_cosf(fr); rope_tab[(size_t)pos * 64 + 32 + j] = __builtin_amdgcn_sinf(fr);
    }
    const size_t n8 = (size_t)T_ALL * D_MODEL / 8, np8 = (size_t)T_PROMPT * D_MODEL / 8;
#pragma unroll 4
    for (size_t i = (size_t)blockIdx.x * NTHR + threadIdx.x; i < n8; i += (size_t)gridDim.x * NTHR) {
        const float4* s = (i < np8) ? (const float4*)xp + 2 * i : (const float4*)xs + 2 * (i - np8);
        float4 a = s[0], b = s[1];
        v4u o; o.x = pk2(a.x, a.y); o.y = pk2(a.z, a.w); o.z = pk2(b.x, b.y); o.w = pk2(b.z, b.w);
        ((v4u*)A0)[i] = o;
    }
}
__device__ __forceinline__ void ph_prologue2(LAS unsigned char* ldsb, const float* __restrict__ w_out, bf16* __restrict__ wt_out, const float* __restrict__ w_q, bf16* __restrict__ wt_q,
                                             int rank, int nranks) {
    const int lane = threadIdx.x & 63, wave = threadIdx.x >> 6;
    LAS float* scr = (LAS float*)(ldsb + wave * 16384);
    constexpr int I_OUT = (MIX_WIDTH / 64) * (D_MODEL / 32), I_Q = (D_MODEL / 64) * (2048 / 32);
    for (int it = rank * NWAVE + wave; it < I_OUT + I_Q; it += nranks * NWAVE) {
        if (it < I_OUT) transpose_item<0>(w_out, MIX_WIDTH, D_MODEL, D_MODEL, wt_out, scr, it, lane);
        else transpose_item<0>(w_q, D_MODEL, 2048, 2048, wt_q, scr, it - I_OUT, lane);
    }
}

__device__ __forceinline__ void ph_concat_x(const float* __restrict__ xp, const float* __restrict__ xs, float* __restrict__ xall) {
    const size_t n4 = (size_t)T_ALL * D_MODEL / 4, np4 = (size_t)T_PROMPT * D_MODEL / 4;
    for (size_t i = (size_t)blockIdx.x * NTHR + threadIdx.x; i < n4; i += (size_t)gridDim.x * NTHR) {
        float4 v = (i < np4) ? ((const float4*)xp)[i] : ((const float4*)xs)[i - np4];
        ((float4*)xall)[i] = v;
    }
}

typedef float f32x4n __attribute__((ext_vector_type(4)));
__device__ __forceinline__ void ph_cache_copy(const float* __restrict__ ck, const float* __restrict__ cv, float* __restrict__ out) {
    constexpr unsigned PER_B = (WBUF - DEC_SEQ) * ATT_WIDTH / 4;
    constexpr unsigned TOTAL = 2u * DEC_BATCH * PER_B;
    for (unsigned c = blockIdx.x; c < TOTAL / 4096u; c += gridDim.x) {
        f32x4n v[8]; size_t dsti[8]; bool isv[8];
#pragma unroll
        for (int j = 0; j < 8; ++j) {
            const unsigned idx = c * 4096u + j * 512u + threadIdx.x;
            const unsigned tb = idx / PER_B, r = idx - tb * PER_B, bb = tb & (DEC_BATCH - 1);
            isv[j] = tb >= DEC_BATCH;
            const size_t srci = (size_t)bb * (WBUF * ATT_WIDTH / 4) + (DEC_SEQ * ATT_WIDTH / 4) + r;
            dsti[j] = (size_t)bb * (WBUF * ATT_WIDTH / 4) + r;
            v[j] = __builtin_nontemporal_load((isv[j] ? (const f32x4n*)cv : (const f32x4n*)ck) + srci);
        }
#pragma unroll
        for (int j = 0; j < 8; ++j) __builtin_nontemporal_store(v[j], (f32x4n*)(out + (isv[j] ? OUT_SV : OUT_SK)) + dsti[j]);
    }
}

__device__ __forceinline__ void ph_post_proj(const float* __restrict__ proj, const float* __restrict__ state_conv,
                                             const float* __restrict__ conv_w, const float* __restrict__ conv_b, const float* __restrict__ dt_bias,
                                             float* __restrict__ xbc_act, float* __restrict__ dtv, float* __restrict__ qrot, float* __restrict__ krot,
                                             float* __restrict__ out) {
    const int tid = threadIdx.x & 255, half = threadIdx.x >> 8;
    for (int t = 2 * blockIdx.x + half; t < T_ALL; t += 2 * gridDim.x) {
        const bool is_p = t < T_PROMPT;
        int b, i, pos;
        if (is_p) { b = t / SEQ; i = t % SEQ; pos = i; } else { int ts = t - T_PROMPT; b = ts / DEC_SEQ; i = ts % DEC_SEQ; pos = PAST_LEN + i; }
        const float* row = proj + (size_t)t * PROJ_LD;
        for (int c = tid; c < CONV_DIM; c += 256) {
            float acc = conv_b[c];
#pragma unroll
            for (int tap = 0; tap < 4; ++tap) {
                int r = i - 3 + tap;
                float val;
                if (r >= 0) val = proj[(size_t)(t - i + r) * PROJ_LD + O_XBC + c];
                else val = is_p ? 0.f : state_conv[((size_t)b * 3 + (3 + r)) * CONV_DIM + c];
                acc += val * conv_w[tap * CONV_DIM + c];
            }
            xbc_act[(size_t)t * CONV_DIM + c] = silu_f(acc);
        }
        if (tid < SSD_HEADS) dtv[(size_t)t * SSD_HEADS + tid] = softplus_f(row[O_DT + tid] + dt_bias[tid]);
        for (int idx = tid; idx < 512; idx += 256) {
            int which = idx >> 8, h = (idx >> 5) & 7, j = idx & 31;
            double rev = (double)pos * ROPE_INV_REV[j];
            float fr = (float)(rev - floor(rev));
            float sn = __builtin_amdgcn_sinf(fr), cs = __builtin_amdgcn_cosf(fr);
            const float* src = row + (which ? O_K : O_Q) + h * 64;
            float t1 = src[j], t2 = src[j + 32];
            float o1 = t1 * cs - t2 * sn, o2 = t2 * cs + t1 * sn;
            float* dst = (which ? krot : qrot) + (size_t)t * ATT_WIDTH + h * 64;
            dst[j] = o1; dst[j + 32] = o2;
            if (which) {
                if (is_p) { if (i >= SEQ - WBUF) { float* o = out + OUT_PK + ((size_t)b * WBUF + (i - (SEQ - WBUF))) * ATT_WIDTH + h * 64; o[j] = o1; o[j + 32] = o2; } }
                else { float* o = out + OUT_SK + ((size_t)b * WBUF + (WBUF - DEC_SEQ + i)) * ATT_WIDTH + h * 64; o[j] = o1; o[j + 32] = o2; }
            }
        }
        for (int c = tid; c < ATT_WIDTH; c += 256) {
            float v = row[O_V + c];
            if (is_p) { if (i >= SEQ - WBUF) out[OUT_PV + ((size_t)b * WBUF + (i - (SEQ - WBUF))) * ATT_WIDTH + c] = v; }
            else out[OUT_SV + ((size_t)b * WBUF + (WBUF - DEC_SEQ + i)) * ATT_WIDTH + c] = v;
        }
        if (is_p) {
            if (i >= SEQ - 3) { int r = i - (SEQ - 3); for (int c = tid; c < CONV_DIM; c += 256) out[OUT_PC + ((size_t)b * 3 + r) * CONV_DIM + c] = row[O_XBC + c]; }
        } else {
            if (i >= 1) { int r = i - 1; for (int c = tid; c < CONV_DIM; c += 256) out[OUT_SC + ((size_t)b * 3 + r) * CONV_DIM + c] = row[O_XBC + c]; }
        }
    }
}


#define NB_LD 5632
#define NB_XBC 1536
#define NB_Q 4096
#define NB_K 4608
#define NB_V 5120
__device__ __forceinline__ void unpack8(const v4u w, float (&f)[8]) {
    f[0] = __builtin_bit_cast(float, w.x << 16); f[1] = __builtin_bit_cast(float, w.x & 0xffff0000u);
    f[2] = __builtin_bit_cast(float, w.y << 16); f[3] = __builtin_bit_cast(float, w.y & 0xffff0000u);
    f[4] = __builtin_bit_cast(float, w.z << 16); f[5] = __builtin_bit_cast(float, w.z & 0xffff0000u);
    f[6] = __builtin_bit_cast(float, w.w << 16); f[7] = __builtin_bit_cast(float, w.w & 0xffff0000u);
}
__device__ __forceinline__ void store8f(float* d, const float (&f)[8]) { *(float4*)d = make_float4(f[0], f[1], f[2], f[3]); *(float4*)(d + 4) = make_float4(f[4], f[5], f[6], f[7]); }
__device__ __forceinline__ void ph_post_proj2(const bf16* __restrict__ projb, const float* __restrict__ dtraw, const float* __restrict__ state_conv,
                                              const float* __restrict__ conv_w, const float* __restrict__ conv_b, const float* __restrict__ dt_bias,
                                              bf16* __restrict__ xbc_b, float* __restrict__ dtv, bf16* __restrict__ qrot_b, bf16* __restrict__ krot_b,
                                              float* __restrict__ out) {
    const int tid = threadIdx.x & 255, half = threadIdx.x >> 8;
    for (int t = T_PROMPT + 2 * blockIdx.x + half; t < T_ALL; t += 2 * gridDim.x) {
        const bool is_p = t < T_PROMPT;
        int b, i, pos;
        if (is_p) { b = t / SEQ; i = t % SEQ; pos = i; } else { int ts = t - T_PROMPT; b = ts / DEC_SEQ; i = ts % DEC_SEQ; pos = PAST_LEN + i; }
        const bf16* row = projb + (size_t)t * NB_LD;
        if (tid < 64) {
            float f[8]; unpack8(*(const v4u*)(row + NB_V + tid * 8), f);
            if (is_p) { if (i >= SEQ - WBUF) store8f(out + OUT_PV + ((size_t)b * WBUF + (i - (SEQ - WBUF))) * ATT_WIDTH + tid * 8, f); }
            else store8f(out + OUT_SV + ((size_t)b * WBUF + (WBUF - DEC_SEQ + i)) * ATT_WIDTH + tid * 8, f);
        }
        for (int c8 = tid; c8 < 320; c8 += 256) {
            const int c = c8 * 8;
            float acc[8], cur[8];
            { const float4 b0 = *(const float4*)(conv_b + c), b1 = *(const float4*)(conv_b + c + 4);
              acc[0] = b0.x; acc[1] = b0.y; acc[2] = b0.z; acc[3] = b0.w; acc[4] = b1.x; acc[5] = b1.y; acc[6] = b1.z; acc[7] = b1.w; }
#pragma unroll
            for (int tap = 0; tap < 4; ++tap) {
                const int r = i - 3 + tap;
                float val[8];
                if (r >= 0) unpack8(*(const v4u*)(projb + (size_t)(t - i + r) * NB_LD + NB_XBC + c), val);
                else if (!is_p) { const float* sp = state_conv + ((size_t)b * 3 + (3 + r)) * CONV_DIM + c; const float4 s0 = *(const float4*)sp, s1 = *(const float4*)(sp + 4);
                    val[0] = s0.x; val[1] = s0.y; val[2] = s0.z; val[3] = s0.w; val[4] = s1.x; val[5] = s1.y; val[6] = s1.z; val[7] = s1.w; }
                else {
#pragma unroll
                    for (int j = 0; j < 8; ++j) val[j] = 0.f; }
                const float4 w0 = *(const float4*)(conv_w + tap * CONV_DIM + c), w1 = *(const float4*)(conv_w + tap * CONV_DIM + c + 4);
                acc[0] += val[0] * w0.x; acc[1] += val[1] * w0.y; acc[2] += val[2] * w0.z; acc[3] += val[3] * w0.w;
                acc[4] += val[4] * w1.x; acc[5] += val[5] * w1.y; acc[6] += val[6] * w1.z; acc[7] += val[7] * w1.w;
                if (tap == 3) {
#pragma unroll
                    for (int j = 0; j < 8; ++j) cur[j] = val[j]; }
            }
#pragma unroll
            for (int j = 0; j < 8; ++j) acc[j] = silu_f(acc[j]);
            v4u o; o.x = pk2(acc[0], acc[1]); o.y = pk2(acc[2], acc[3]); o.z = pk2(acc[4], acc[5]); o.w = pk2(acc[6], acc[7]);
            *(v4u*)(xbc_b + (size_t)t * CONV_DIM + c) = o;
            if (is_p) { if (i >= SEQ - 3) store8f(out + OUT_PC + ((size_t)b * 3 + (i - (SEQ - 3))) * CONV_DIM + c, cur); }
            else { if (i >= 1) store8f(out + OUT_SC + ((size_t)b * 3 + (i - 1)) * CONV_DIM + c, cur); }
        }
        if (tid < SSD_HEADS) dtv[(size_t)t * SSD_HEADS + tid] = softplus_f(dtraw[(size_t)t * 32 + tid] + dt_bias[tid]);
        if (tid < 128) {
            const int which = tid >> 6, h = (tid >> 3) & 7, jc = tid & 7;
            const bf16* src = row + (which ? NB_K : NB_Q) + h * 64 + jc * 4;
            const uint2 lo = *(const uint2*)src, hi = *(const uint2*)(src + 32);
            float t1[4], t2[4], o1[4], o2[4];
            t1[0] = __builtin_bit_cast(float, lo.x << 16); t1[1] = __builtin_bit_cast(float, lo.x & 0xffff0000u); t1[2] = __builtin_bit_cast(float, lo.y << 16); t1[3] = __builtin_bit_cast(float, lo.y & 0xffff0000u);
            t2[0] = __builtin_bit_cast(float, hi.x << 16); t2[1] = __builtin_bit_cast(float, hi.x & 0xffff0000u); t2[2] = __builtin_bit_cast(float, hi.y << 16); t2[3] = __builtin_bit_cast(float, hi.y & 0xffff0000u);
#pragma unroll
            for (int e = 0; e < 4; ++e) {
                const double rev = (double)pos * ROPE_INV_REV[jc * 4 + e];
                const float fr = (float)(rev - floor(rev));
                const float sn = __builtin_amdgcn_sinf(fr), cs = __builtin_amdgcn_cosf(fr);
                o1[e] = t1[e] * cs - t2[e] * sn; o2[e] = t2[e] * cs + t1[e] * sn;
            }
            const size_t doff = (size_t)t * ATT_WIDTH + h * 64 + jc * 4;
            bf16* db = which ? krot_b : qrot_b;
            *(uint2*)(db + doff) = make_uint2(pk2(o1[0], o1[1]), pk2(o1[2], o1[3])); *(uint2*)(db + doff + 32) = make_uint2(pk2(o2[0], o2[1]), pk2(o2[2], o2[3]));
            if (which) {
                float* o = nullptr;
                if (is_p) { if (i >= SEQ - WBUF) o = out + OUT_PK + ((size_t)b * WBUF + (i - (SEQ - WBUF))) * ATT_WIDTH + h * 64 + jc * 4; }
                else o = out + OUT_SK + ((size_t)b * WBUF + (WBUF - DEC_SEQ + i)) * ATT_WIDTH + h * 64 + jc * 4;
                if (o) { *(float4*)o = make_float4(o1[0], o1[1], o1[2], o1[3]); *(float4*)(o + 32) = make_float4(o2[0], o2[1], o2[2], o2[3]); }
            }
        }
    }
}


__device__ __forceinline__ void ph_post_proj_prompt(const bf16* __restrict__ projb, const float* __restrict__ dtraw, const float* __restrict__ conv_w, const float* __restrict__ conv_b,
                                                    const float* __restrict__ dt_bias, const float* __restrict__ rope_tab, bf16* __restrict__ xbc_b, float* __restrict__ dtv,
                                                    bf16* __restrict__ qrot_b, bf16* __restrict__ krot_b, float* __restrict__ out) {
    const int gtid = blockIdx.x * NTHR + threadIdx.x, gsz = gridDim.x * NTHR;
    for (int item = gtid; item < (T_PROMPT / 16) * 320; item += gsz) {
        const int run = item / 320, c = (item - run * 320) * 8, t0 = run * 16, i0 = t0 & (SEQ - 1), b = t0 >> 13;
        float w[4][8], bias[8];
#pragma unroll
        for (int tap = 0; tap < 4; ++tap) { const float4 w0 = *(const float4*)(conv_w + tap * CONV_DIM + c), w1 = *(const float4*)(conv_w + tap * CONV_DIM + c + 4);
            w[tap][0] = w0.x; w[tap][1] = w0.y; w[tap][2] = w0.z; w[tap][3] = w0.w; w[tap][4] = w1.x; w[tap][5] = w1.y; w[tap][6] = w1.z; w[tap][7] = w1.w; }
        { const float4 b0 = *(const float4*)(conv_b + c), b1 = *(const float4*)(conv_b + c + 4);
          bias[0] = b0.x; bias[1] = b0.y; bias[2] = b0.z; bias[3] = b0.w; bias[4] = b1.x; bias[5] = b1.y; bias[6] = b1.z; bias[7] = b1.w; }
        const bf16* src = projb + (size_t)t0 * NB_LD + NB_XBC + c;
        v4u raw[19];
#pragma unroll
        for (int s = 0; s < 19; ++s) { v4u z; z.x = 0u; z.y = 0u; z.z = 0u; z.w = 0u; raw[s] = (s >= 3 || i0 != 0) ? *(const v4u*)(src + (ptrdiff_t)(s - 3) * NB_LD) : z; }
        float p0[8], p1[8], p2[8];
        unpack8(raw[0], p0); unpack8(raw[1], p1); unpack8(raw[2], p2);
#pragma unroll
        for (int s = 0; s < 16; ++s) {
            float cur[8], acc[8]; unpack8(raw[s + 3], cur);
#pragma unroll
            for (int j = 0; j < 8; ++j) acc[j] = silu_f(bias[j] + p0[j] * w[0][j] + p1[j] * w[1][j] + p2[j] * w[2][j] + cur[j] * w[3][j]);
            v4u o; o.x = pk2(acc[0], acc[1]); o.y = pk2(acc[2], acc[3]); o.z = pk2(acc[4], acc[5]); o.w = pk2(acc[6], acc[7]);
            *(v4u*)(xbc_b + (size_t)(t0 + s) * CONV_DIM + c) = o;
            if (i0 + s >= SEQ - 3) store8f(out + OUT_PC + ((size_t)b * 3 + (i0 + s - (SEQ - 3))) * CONV_DIM + c, cur);
#pragma unroll
            for (int j = 0; j < 8; ++j) { p0[j] = p1[j]; p1[j] = p2[j]; p2[j] = cur[j]; }
        }
    }
#pragma unroll 4
    for (int item = gtid; item < T_PROMPT * 128; item += gsz) {
        const int t = item >> 7, sub = item & 127, which = sub >> 6, h = (sub >> 3) & 7, jc = sub & 7, i = t & (SEQ - 1), b = t >> 13;
        const bf16* src = projb + (size_t)t * NB_LD + (which ? NB_K : NB_Q) + h * 64 + jc * 4;
        const uint2 lo = *(const uint2*)src, hi = *(const uint2*)(src + 32);
        const float4 cs = *(const float4*)(rope_tab + (size_t)i * 64 + jc * 4), sn = *(const float4*)(rope_tab + (size_t)i * 64 + 32 + jc * 4);
        float t1[4], t2[4], o1[4], o2[4];
        t1[0] = __builtin_bit_cast(float, lo.x << 16); t1[1] = __builtin_bit_cast(float, lo.x & 0xffff0000u); t1[2] = __builtin_bit_cast(float, lo.y << 16); t1[3] = __builtin_bit_cast(float, lo.y & 0xffff0000u);
        t2[0] = __builtin_bit_cast(float, hi.x << 16); t2[1] = __builtin_bit_cast(float, hi.x & 0xffff0000u); t2[2] = __builtin_bit_cast(float, hi.y << 16); t2[3] = __builtin_bit_cast(float, hi.y & 0xffff0000u);
        const float cv[4] = {cs.x, cs.y, cs.z, cs.w}, sv[4] = {sn.x, sn.y, sn.z, sn.w};
#pragma unroll
        for (int e = 0; e < 4; ++e) { o1[e] = t1[e] * cv[e] - t2[e] * sv[e]; o2[e] = t2[e] * cv[e] + t1[e] * sv[e]; }
        const size_t doff = (size_t)t * ATT_WIDTH + h * 64 + jc * 4;
        bf16* db = which ? krot_b : qrot_b;
        *(uint2*)(db + doff) = make_uint2(pk2(o1[0], o1[1]), pk2(o1[2], o1[3])); *(uint2*)(db + doff + 32) = make_uint2(pk2(o2[0], o2[1]), pk2(o2[2], o2[3]));
        if (which && i >= SEQ - WBUF) {
            float* o = out + OUT_PK + ((size_t)b * WBUF + (i - (SEQ - WBUF))) * ATT_WIDTH + h * 64 + jc * 4;
            *(float4*)o = make_float4(o1[0], o1[1], o1[2], o1[3]); *(float4*)(o + 32) = make_float4(o2[0], o2[1], o2[2], o2[3]);
        }
    }
#pragma unroll 4
    for (int item = gtid; item < T_PROMPT * SSD_HEADS; item += gsz) { const int t = item / SSD_HEADS, hd = item - t * SSD_HEADS; dtv[item] = softplus_f(dtraw[(size_t)t * 32 + hd] + dt_bias[hd]); }
#pragma unroll 2
    for (int item = gtid; item < BATCH * WBUF * 64; item += gsz) {
        const int ch = item & 63, j = (item >> 6) & (WBUF - 1), b = item >> 17;
        float f[8]; unpack8(*(const v4u*)(projb + (size_t)(b * SEQ + (SEQ - WBUF) + j) * NB_LD + NB_V + ch * 8), f);
        store8f(out + OUT_PV + ((size_t)b * WBUF + j) * ATT_WIDTH + ch * 8, f);
    }
}

#define SSD_CH 32
__device__ __forceinline__ void ph_ssd_naive(float* lds, const bf16* __restrict__ xbc_act, const float* __restrict__ dtv, const float* __restrict__ a_log,
                                             const float* __restrict__ d_skip, const float* __restrict__ state_ssm, float* __restrict__ ybuf, float* __restrict__ out) {
    float (*sx)[64] = (float (*)[64])lds;
    float (*sB)[128] = (float (*)[128])(lds + SSD_CH * 64);
    float (*sC)[128] = (float (*)[128])(lds + SSD_CH * 64 + SSD_CH * 128);
    float* sdt = lds + SSD_CH * 64 + 2 * SSD_CH * 128;
    const int tid = threadIdx.x, p = tid >> 3, ng = tid & 7;
    for (int vb = BATCH * SSD_HEADS + blockIdx.x; vb < (BATCH + DEC_BATCH) * SSD_HEADS; vb += gridDim.x) {
        const int seq = vb / SSD_HEADS, h = vb % SSD_HEADS, g = h / 6;
        const bool is_p = seq < BATCH;
        const int L = is_p ? SEQ : DEC_SEQ;
        const int t0 = is_p ? seq * SEQ : T_PROMPT + (seq - BATCH) * DEC_SEQ;
        const float A = -__expf(a_log[h]);
        const float D = d_skip[h];
        float hs[16];
        if (is_p) {
#pragma unroll
            for (int j = 0; j < 16; ++j) hs[j] = 0.f;
        } else {
            const float* s0 = state_ssm + (((size_t)(seq - BATCH) * SSD_HEADS + h) * 64 + p) * 128 + ng * 16;
#pragma unroll
            for (int j = 0; j < 16; ++j) hs[j] = s0[j];
        }
        for (int c0 = 0; c0 < L; c0 += SSD_CH) {
            const int nst = (L - c0) < SSD_CH ? (L - c0) : SSD_CH;
            __syncthreads();
            for (int idx = tid; idx < nst * 64; idx += NTHR) { int s = idx >> 6, c = idx & 63; sx[s][c] = bf2f(xbc_act[(size_t)(t0 + c0 + s) * CONV_DIM + h * 64 + c]); }
            for (int idx = tid; idx < nst * 128; idx += NTHR) { int s = idx >> 7, c = idx & 127;
                sB[s][c] = bf2f(xbc_act[(size_t)(t0 + c0 + s) * CONV_DIM + 1536 + g * 128 + c]);
                sC[s][c] = bf2f(xbc_act[(size_t)(t0 + c0 + s) * CONV_DIM + 2048 + g * 128 + c]); }
            if (tid < nst) sdt[tid] = dtv[(size_t)(t0 + c0 + tid) * SSD_HEADS + h];
            __syncthreads();
            for (int s = 0; s < nst; ++s) {
                const float dt = sdt[s], x = sx[s][p];
                const float a = __expf(dt * A), xdt = x * dt;
                float y = 0.f;
#pragma unroll
                for (int j = 0; j < 16; ++j) { hs[j] = a * hs[j] + xdt * sB[s][ng * 16 + j]; y += sC[s][ng * 16 + j] * hs[j]; }
                y += __shfl_xor(y, 1); y += __shfl_xor(y, 2); y += __shfl_xor(y, 4);
                if (ng == 0) ybuf[(size_t)(t0 + c0 + s) * MIX_WIDTH + h * 64 + p] = y + D * x;
            }
        }
        float* so = is_p ? out + OUT_PS + (((size_t)seq * SSD_HEADS + h) * 64 + p) * 128 + ng * 16
                         : out + OUT_SS + (((size_t)(seq - BATCH) * SSD_HEADS + h) * 64 + p) * 128 + ng * 16;
#pragma unroll
        for (int j = 0; j < 16; ++j) so[j] = hs[j];
    }
}

__device__ __forceinline__ void ph_gate_norm(const bf16* __restrict__ projb, const float* __restrict__ norm_g, const float* __restrict__ ybuf, bf16* __restrict__ A1) {
    const int w = threadIdx.x >> 6, lane = threadIdx.x & 63, g = w & 3;
    for (int t = T_PROMPT + 2 * blockIdx.x + (w >> 2); t < T_ALL; t += 2 * gridDim.x) {
        float v[6]; float ss = 0.f;
#pragma unroll
        for (int j = 0; j < 6; ++j) {
            int c = g * 384 + j * 64 + lane;
            float y = ybuf[(size_t)t * MIX_WIDTH + c], z = bf2f(projb[(size_t)t * NB_LD + c]);
            v[j] = y * silu_f(z); ss += v[j] * v[j];
        }
        ss = wave_sum(ss);
        const float r = rsqrtf(ss * (1.0f / 384.0f) + LN_EPS);
#pragma unroll
        for (int j = 0; j < 6; ++j) { int c = g * 384 + j * 64 + lane; A1[(size_t)t * MIX_WIDTH + c] = (bf16)f2bf(v[j] * r * norm_g[c]); }
    }
}

__device__ __forceinline__ void ph_attn_naive(float* lds, const float* __restrict__ proj, const float* __restrict__ qrot, const float* __restrict__ krot,
                                              const float* __restrict__ ck, const float* __restrict__ cv, float* __restrict__ ybuf) {
    float (*sq)[64] = (float (*)[64])lds;
    const int w = threadIdx.x >> 6, lane = threadIdx.x & 63;
    for (int vb = blockIdx.x; vb < T_SAMPLE * 8 / NWAVE; vb += gridDim.x) {
        const int item = T_PROMPT * 8 + vb * NWAVE + w;
        const int t = item >> 3, h = item & 7;
        const bool is_p = t < T_PROMPT;
        int b, i;
        if (is_p) { b = t / SEQ; i = t % SEQ; } else { int ts = t - T_PROMPT; b = ts / DEC_SEQ; i = ts % DEC_SEQ; }
        __syncthreads();
        sq[w][lane] = qrot[(size_t)t * ATT_WIDTH + h * 64 + lane];
        __syncthreads();
        const int qi = is_p ? i : WBUF + i;
        float sc[3][3];
        float mx = -INFINITY;
#pragma unroll
        for (int pt = 0; pt < 3; ++pt) {
            const int d = pt == 0 ? 1 : (pt == 1 ? 4 : 16);
#pragma unroll
            for (int sl = 0; sl < 3; ++sl) {
                const int m = lane + sl * 64;
                float s = -INFINITY;
                const int kj = qi - d * m;
                if (m <= 128 && kj >= 0) {
                    const float* kr;
                    if (is_p) kr = krot + (size_t)(b * SEQ + kj) * ATT_WIDTH + h * 64;
                    else kr = (kj >= WBUF) ? krot + (size_t)(T_PROMPT + b * DEC_SEQ + (kj - WBUF)) * ATT_WIDTH + h * 64
                                           : ck + ((size_t)b * WBUF + kj) * ATT_WIDTH + h * 64;
                    float a = 0.f;
#pragma unroll
                    for (int c = 0; c < 64; c += 4) { float4 kv = *(const float4*)(kr + c); a += kv.x * sq[w][c] + kv.y * sq[w][c + 1] + kv.z * sq[w][c + 2] + kv.w * sq[w][c + 3]; }
                    s = a * 0.125f;
                }
                sc[pt][sl] = s; mx = fmaxf(mx, s);
            }
        }
        mx = wave_max(mx);
        float lsum = 0.f;
#pragma unroll
        for (int pt = 0; pt < 3; ++pt)
#pragma unroll
            for (int sl = 0; sl < 3; ++sl) { float pv = (sc[pt][sl] == -INFINITY) ? 0.f : __expf(sc[pt][sl] - mx); sc[pt][sl] = pv; lsum += pv; }
        lsum = wave_sum(lsum);
        float o = 0.f;
#pragma unroll
        for (int pt = 0; pt < 3; ++pt) {
            const int d = pt == 0 ? 1 : (pt == 1 ? 4 : 16);
#pragma unroll
            for (int sl = 0; sl < 3; ++sl) {
                const int mend = sl < 2 ? 64 : 1;
                for (int ml = 0; ml < mend; ++ml) {
                    const int m = ml + sl * 64;
                    const int kj = qi - d * m;
                    const float pv = __shfl(sc[pt][sl], ml);
                    if (kj < 0) continue;
                    const float* vr;
                    if (is_p) vr = proj + (size_t)(b * SEQ + kj) * PROJ_LD + O_V + h * 64;
                    else vr = (kj >= WBUF) ? proj + (size_t)(T_PROMPT + b * DEC_SEQ + (kj - WBUF)) * PROJ_LD + O_V + h * 64
                                           : cv + ((size_t)b * WBUF + kj) * ATT_WIDTH + h * 64;
                    o += pv * vr[lane];
                }
            }
        }
        ybuf[(size_t)t * MIX_WIDTH + SSD_WIDTH + h * 64 + lane] = o / lsum;
    }
}

__device__ __forceinline__ int token_of_iter(int k) {
    const int w = __builtin_amdgcn_readfirstlane(threadIdx.x >> 6), wgl = blockIdx.x * NWAVE + w;
    if (gridDim.x != 256) { const int t = wgl + k * (int)(gridDim.x * NWAVE); return t < T_ALL ? t : -1; }
    if (k < 8) return k * 2048 + wgl;
    if (k == 8 && w < 2) return 16384 + w * 256 + (int)blockIdx.x;
    return -1;
}
__device__ __forceinline__ void ph_ln_res(const bf16* __restrict__ xb, const bf16* __restrict__ add, const float* __restrict__ gam,
                                          const float* __restrict__ bet, bf16* __restrict__ dstb) {
    const int lane = threadIdx.x & 63;
#pragma unroll 2
    for (int k = 0;; ++k) {
        const int t = token_of_iter(k);
        if (t < 0) break;
        const bf16* res = xb + (size_t)t * D_MODEL;
        float v[16]; float s = 0.f;
#pragma unroll
        for (int j = 0; j < 2; ++j) { const int c = j * 512 + lane * 8; float r8[8]; unpack8(*(const v4u*)(res + c), r8);
            const float4 r0 = make_float4(r8[0], r8[1], r8[2], r8[3]), r1 = make_float4(r8[4], r8[5], r8[6], r8[7]);
            float a8[8]; unpack8(*(const v4u*)(add + (size_t)t * D_MODEL + c), a8);
            v[8 * j] = ALPHA_F * r0.x + a8[0]; v[8 * j + 1] = ALPHA_F * r0.y + a8[1]; v[8 * j + 2] = ALPHA_F * r0.z + a8[2]; v[8 * j + 3] = ALPHA_F * r0.w + a8[3];
            v[8 * j + 4] = ALPHA_F * r1.x + a8[4]; v[8 * j + 5] = ALPHA_F * r1.y + a8[5]; v[8 * j + 6] = ALPHA_F * r1.z + a8[6]; v[8 * j + 7] = ALPHA_F * r1.w + a8[7]; }
#pragma unroll
        for (int j = 0; j < 16; ++j) s += v[j];
        s = wave_sum(s);
        const float mu = s * (1.0f / 1024.0f);
        float q = 0.f;
#pragma unroll
        for (int j = 0; j < 16; ++j) { v[j] -= mu; q += v[j] * v[j]; }
        q = wave_sum(q);
        const float r = rsqrtf(q * (1.0f / 1024.0f) + LN_EPS);
#pragma unroll
        for (int j = 0; j < 2; ++j) { const int c = j * 512 + lane * 8; const float4 g0 = *(const float4*)(gam + c), g1 = *(const float4*)(gam + c + 4), b0 = *(const float4*)(bet + c), b1 = *(const float4*)(bet + c + 4);
            v4u o; o.x = pk2(v[8 * j] * r * g0.x + b0.x, v[8 * j + 1] * r * g0.y + b0.y); o.y = pk2(v[8 * j + 2] * r * g0.z + b0.z, v[8 * j + 3] * r * g0.w + b0.w);
            o.z = pk2(v[8 * j + 4] * r * g1.x + b1.x, v[8 * j + 5] * r * g1.y + b1.y); o.w = pk2(v[8 * j + 6] * r * g1.z + b1.z, v[8 * j + 7] * r * g1.w + b1.w);
            *(v4u*)(dstb + (size_t)t * D_MODEL + c) = o; }
    }
}

__device__ __forceinline__ void ph_peer_route(float* lds, const float* __restrict__ qh, const float* __restrict__ keys1, const float* __restrict__ keys2,
                                              int* __restrict__ eidx, float* __restrict__ gate) {
    float (*sq)[256] = (float (*)[256])lds;
    float (*sv)[2][16] = (float (*)[2][16])(lds + NWAVE * 256);
    int (*si)[2][16] = (int (*)[2][16])(lds + NWAVE * 256 + NWAVE * 32);
    const int w = threadIdx.x >> 6, lane = threadIdx.x & 63;
    for (int vb = blockIdx.x; vb < T_ALL * 8 / NWAVE; vb += gridDim.x) {
        const int item = vb * NWAVE + w;
        const int t = item >> 3, h = item & 7;
        __syncthreads();
        for (int c = lane; c < 256; c += 64) sq[w][c] = qh[(size_t)t * 2048 + h * 256 + c];
        __syncthreads();
#pragma unroll
        for (int half = 0; half < 2; ++half) {
            const float* keys = half ? keys2 : keys1;
            float s[2];
#pragma unroll
            for (int sl = 0; sl < 2; ++sl) {
                const float* kr = keys + (size_t)(lane + sl * 64) * 128;
                float a = 0.f;
#pragma unroll 8
                for (int c = 0; c < 128; c += 4) { float4 kv = *(const float4*)(kr + c); const float* qq = &sq[w][half * 128 + c]; a += kv.x * qq[0] + kv.y * qq[1] + kv.z * qq[2] + kv.w * qq[3]; }
                s[sl] = a;
            }
            for (int r = 0; r < 16; ++r) {
                float bv; int bi;
                if (s[0] >= s[1]) { bv = s[0]; bi = lane; } else { bv = s[1]; bi = lane + 64; }
#pragma unroll
                for (int o = 32; o > 0; o >>= 1) {
                    float ov = __shfl_xor(bv, o); int oi = __shfl_xor(bi, o);
                    if (ov > bv || (ov == bv && oi < bi)) { bv = ov; bi = oi; }
                }
                if (lane == 0) { sv[w][half][r] = bv; si[w][half][r] = bi; }
                if (bi == lane) s[0] = -INFINITY;
                if (bi == lane + 64) s[1] = -INFINITY;
            }
        }
        __syncthreads();
        float c[4];
#pragma unroll
        for (int j = 0; j < 4; ++j) { int ci = lane * 4 + j; c[j] = sv[w][0][ci >> 4] + sv[w][1][ci & 15]; }
        float myv = 0.f; int myc = 0;
        for (int r = 0; r < 16; ++r) {
            float bv = c[0]; int bi = lane * 4;
#pragma unroll
            for (int j = 1; j < 4; ++j) if (c[j] > bv) { bv = c[j]; bi = lane * 4 + j; }
#pragma unroll
            for (int o = 32; o > 0; o >>= 1) {
                float ov = __shfl_xor(bv, o); int oi = __shfl_xor(bi, o);
                if (ov > bv || (ov == bv && oi < bi)) { bv = ov; bi = oi; }
            }
            if (lane == r) { myv = bv; myc = bi; }
#pragma unroll
            for (int j = 0; j < 4; ++j) if (bi == lane * 4 + j) c[j] = -INFINITY;
        }
        float v = lane < 16 ? myv : -INFINITY;
        float mx = wave_max(v);
        float e = lane < 16 ? __expf(v - mx) : 0.f;
        float sum = wave_sum(e);
        if (lane < 16) {
            int ex = si[w][0][myc >> 4] * PEER_NKEYS + si[w][1][myc & 15];
            eidx[(size_t)t * 128 + h * 16 + lane] = ex;
            gate[(size_t)t * 128 + h * 16 + lane] = e / sum;
        }
    }
}

__device__ __forceinline__ void ph_peer_ffn(const float* __restrict__ hbuf, const int* __restrict__ eidx, const float* __restrict__ gate,
                                            const bf16* __restrict__ ub, const bf16* __restrict__ vb, const float* __restrict__ gam,
                                            const float* __restrict__ bet, float* __restrict__ out) {
    const int lane = threadIdx.x & 63;
    for (int t = blockIdx.x * NWAVE + (threadIdx.x >> 6); t < T_ALL; t += gridDim.x * NWAVE) {
        float x[16], acc[16];
        { const float* xr = hbuf + (size_t)t * D_MODEL + lane * 8;
          const float4 a = *(const float4*)xr, b = *(const float4*)(xr + 4), c = *(const float4*)(xr + 512), d = *(const float4*)(xr + 516);
          x[0] = a.x; x[1] = a.y; x[2] = a.z; x[3] = a.w; x[4] = b.x; x[5] = b.y; x[6] = b.z; x[7] = b.w;
          x[8] = c.x; x[9] = c.y; x[10] = c.z; x[11] = c.w; x[12] = d.x; x[13] = d.y; x[14] = d.z; x[15] = d.w; }
#pragma unroll
        for (int j = 0; j < 16; ++j) acc[j] = 0.f;
        for (int k = 0; k < 128; ++k) {
            const int e = eidx[(size_t)t * 128 + k];
            const float g = gate[(size_t)t * 128 + k];
            const bf16* ur = ub + (size_t)e * D_MODEL + lane * 8;
            float u0[8], u1[8];
            unpack8(*(const v4u*)ur, u0); unpack8(*(const v4u*)(ur + 512), u1);
            float d = 0.f;
#pragma unroll
            for (int j = 0; j < 8; ++j) d += u0[j] * x[j] + u1[j] * x[8 + j];
            d = wave_sum(d);
            const float wgt = g * gelu_f(d);
            const bf16* vr = vb + (size_t)e * D_MODEL + lane * 8;
            unpack8(*(const v4u*)vr, u0); unpack8(*(const v4u*)(vr + 512), u1);
#pragma unroll
            for (int j = 0; j < 8; ++j) { acc[j] += wgt * u0[j]; acc[8 + j] += wgt * u1[j]; }
        }
        float s = 0.f;
#pragma unroll
        for (int j = 0; j < 16; ++j) { acc[j] += ALPHA_F * x[j]; s += acc[j]; }
        s = wave_sum(s);
        const float mu = s * (1.0f / 1024.0f);
        float q = 0.f;
#pragma unroll
        for (int j = 0; j < 16; ++j) { acc[j] -= mu; q += acc[j] * acc[j]; }
        q = wave_sum(q);
        const float r = rsqrtf(q * (1.0f / 1024.0f) + LN_EPS);
        float* dst = ((t < T_PROMPT) ? out + OUT_YP + (size_t)t * D_MODEL : out + OUT_YS + (size_t)(t - T_PROMPT) * D_MODEL) + lane * 8;
#pragma unroll
        for (int q4 = 0; q4 < 4; ++q4) {
            const int eo = (q4 >> 1) * 512 + (q4 & 1) * 4;
            const float4 g4 = *(const float4*)(gam + lane * 8 + eo), b4 = *(const float4*)(bet + lane * 8 + eo);
            float4 o; o.x = acc[q4 * 4 + 0] * r * g4.x + b4.x; o.y = acc[q4 * 4 + 1] * r * g4.y + b4.y; o.z = acc[q4 * 4 + 2] * r * g4.z + b4.z; o.w = acc[q4 * 4 + 3] * r * g4.w + b4.w;
            *(float4*)(dst + eo) = o;
        }
    }
}

__device__ __forceinline__ float peer_dot16(const v4u a, const v4u b, const float (&x)[16]) {
    float u0[8], u1[8]; unpack8(a, u0); unpack8(b, u1);
    float d = 0.f;
#pragma unroll
    for (int j = 0; j < 8; ++j) d += u0[j] * x[j] + u1[j] * x[8 + j];
    return d;
}
#define PEER_TR_STEP(N, M) _Pragma("unroll") for (int i = 0; i < N; ++i) { const bool up = (lane & M) != 0; const float keep = up ? part[i + N] : part[i]; const float send = up ? part[i] : part[i + N]; part[i] = keep + __shfl_xor(send, M); }
__device__ __forceinline__ void ph_peer_ffn2(const float* __restrict__ hbuf, const int* __restrict__ eidx, const float* __restrict__ gate,
                                             const bf16* __restrict__ ub, const bf16* __restrict__ vb, const float* __restrict__ gam,
                                             const float* __restrict__ bet, float* __restrict__ out) {
    const int lane0 = threadIdx.x & 63;
    for (int t = blockIdx.x * NWAVE + (threadIdx.x >> 6); t < T_ALL; t += gridDim.x * NWAVE) {
        int lane = lane0; asm volatile("" : "+v"(lane));
        float x[16];
        { const float* xr = hbuf + (size_t)t * D_MODEL + lane * 8;
          const float4 a = *(const float4*)xr, b = *(const float4*)(xr + 4), c = *(const float4*)(xr + 512), d = *(const float4*)(xr + 516);
          x[0] = a.x; x[1] = a.y; x[2] = a.z; x[3] = a.w; x[4] = b.x; x[5] = b.y; x[6] = b.z; x[7] = b.w;
          x[8] = c.x; x[9] = c.y; x[10] = c.z; x[11] = c.w; x[12] = d.x; x[13] = d.y; x[14] = d.z; x[15] = d.w; }
        int ev[2]; float wv[4];
        ev[0] = eidx[(size_t)t * 128 + lane]; ev[1] = eidx[(size_t)t * 128 + 64 + lane];
#pragma unroll
        for (int rd = 0; rd < 4; ++rd) wv[rd] = gate[(size_t)t * 128 + rd * 32 + (lane >> 1)];
#pragma unroll
        for (int rd = 0; rd < 4; ++rd) {
            float part[32];
#pragma unroll
            for (int kb = 0; kb < 8; ++kb) {
                v4u ra[4], rb[4];
#pragma unroll
                for (int k8 = 0; k8 < 4; ++k8) {
                    const int e = __builtin_amdgcn_readlane(ev[rd >> 1], (rd & 1) * 32 + kb * 4 + k8);
                    const bf16* ur = ub + (size_t)e * D_MODEL + lane * 8;
                    ra[k8] = *(const v4u*)ur; rb[k8] = *(const v4u*)(ur + 512);
                }
#pragma unroll
                for (int k8 = 0; k8 < 4; ++k8) part[kb * 4 + k8] = peer_dot16(ra[k8], rb[k8], x);
            }
            PEER_TR_STEP(16, 32) PEER_TR_STEP(8, 16) PEER_TR_STEP(4, 8) PEER_TR_STEP(2, 4) PEER_TR_STEP(1, 2)
            const float hid = part[0] + __shfl_xor(part[0], 1);
            wv[rd] *= gelu_f(hid);
        }
        float acc[16];
#pragma unroll
        for (int j = 0; j < 16; ++j) acc[j] = 0.f;
#pragma unroll
        for (int rd = 0; rd < 4; ++rd) {
#pragma unroll
            for (int kb = 0; kb < 4; ++kb) {
                v4u ra[8], rb[8];
#pragma unroll
                for (int k8 = 0; k8 < 8; ++k8) {
                    const int e = __builtin_amdgcn_readlane(ev[rd >> 1], (rd & 1) * 32 + kb * 8 + k8);
                    const bf16* vr = vb + (size_t)e * D_MODEL + lane * 8;
                    ra[k8] = *(const v4u*)vr; rb[k8] = *(const v4u*)(vr + 512);
                }
#pragma unroll
                for (int k8 = 0; k8 < 8; ++k8) {
                    const float wk = __builtin_bit_cast(float, __builtin_amdgcn_readlane(__builtin_bit_cast(int, wv[rd]), 2 * (kb * 8 + k8)));
                    float u0[8], u1[8]; unpack8(ra[k8], u0); unpack8(rb[k8], u1);
#pragma unroll
                    for (int j = 0; j < 8; ++j) { acc[j] += wk * u0[j]; acc[8 + j] += wk * u1[j]; }
                }
            }
        }
        float s = 0.f;
#pragma unroll
        for (int j = 0; j < 16; ++j) { acc[j] += ALPHA_F * x[j]; s += acc[j]; }
        s = wave_sum(s);
        const float mu = s * (1.0f / 1024.0f);
        float q = 0.f;
#pragma unroll
        for (int j = 0; j < 16; ++j) { acc[j] -= mu; q += acc[j] * acc[j]; }
        q = wave_sum(q);
        const float r = rsqrtf(q * (1.0f / 1024.0f) + LN_EPS);
        float* dst = ((t < T_PROMPT) ? out + OUT_YP + (size_t)t * D_MODEL : out + OUT_YS + (size_t)(t - T_PROMPT) * D_MODEL) + lane * 8;
#pragma unroll
        for (int q4 = 0; q4 < 4; ++q4) {
            const int eo = (q4 >> 1) * 512 + (q4 & 1) * 4;
            const float4 g4 = *(const float4*)(gam + lane * 8 + eo), b4 = *(const float4*)(bet + lane * 8 + eo);
            float4 o; o.x = acc[q4 * 4 + 0] * r * g4.x + b4.x; o.y = acc[q4 * 4 + 1] * r * g4.y + b4.y; o.z = acc[q4 * 4 + 2] * r * g4.z + b4.z; o.w = acc[q4 * 4 + 3] * r * g4.w + b4.w;
            *(float4*)(dst + eo) = o;
        }
    }
}

__device__ __forceinline__ void ph_attn_sample(float* lds, const bf16* __restrict__ qrot_b, const bf16* __restrict__ krot_b, const bf16* __restrict__ projb,
                                               const float* __restrict__ ck, const float* __restrict__ cv, bf16* __restrict__ A1) {
    float (*sq)[64] = (float (*)[64])lds;
    const int w = threadIdx.x >> 6, lane0 = threadIdx.x & 63;
    for (int vb = blockIdx.x; vb < T_SAMPLE * 8 / NWAVE; vb += gridDim.x) {
        int lane = lane0; asm volatile("" : "+v"(lane));
        const int item = vb * NWAVE + w, ts = item >> 3, hd = item & 7, b = ts >> 2, i = ts & 3, t = T_PROMPT + ts;
        __syncthreads();
        sq[w][lane] = bf2f(qrot_b[(size_t)t * ATT_WIDTH + hd * 64 + lane]);
        __syncthreads();
        const int qi = WBUF + i;
        float sc[8];
        float mx = -INFINITY;
#pragma unroll
        for (int slot = 0; slot < 7; ++slot) {
            const int pt = slot < 6 ? (slot >> 1) : (lane < 3 ? lane : 0);
            const int m = slot < 6 ? lane + 64 * (slot & 1) : 128;
            const int kj = qi - (m << (2 * pt));
            const bool valid = (slot < 6 || lane < 3) && kj < WBUF;
            const int kc = kj < WBUF ? kj : WBUF - 1;
            const float* kr = ck + ((size_t)b * WBUF + kc) * ATT_WIDTH + hd * 64;
            float a = 0.f;
#pragma unroll
            for (int c = 0; c < 64; c += 4) { const float4 kv = *(const float4*)(kr + c); a += kv.x * sq[w][c] + kv.y * sq[w][c + 1] + kv.z * sq[w][c + 2] + kv.w * sq[w][c + 3]; }
            const float s = valid ? a * 0.125f : -INFINITY;
            sc[slot] = s; mx = fmaxf(mx, s);
        }
        const int nt7 = lane <= i ? i - lane : i;
        const bool valid7 = lane < i + 3;
        {
            const bf16* kr = krot_b + (size_t)(T_PROMPT + b * DEC_SEQ + nt7) * ATT_WIDTH + hd * 64;
            float a = 0.f;
#pragma unroll
            for (int c = 0; c < 64; c += 8) { float f[8]; unpack8(*(const v4u*)(kr + c), f);
#pragma unroll
                for (int j = 0; j < 8; ++j) a += f[j] * sq[w][c + j]; }
            const float s = valid7 ? a * 0.125f : -INFINITY;
            sc[7] = s; mx = fmaxf(mx, s);
        }
        mx = wave_max(mx);
        float lsum = 0.f;
#pragma unroll
        for (int slot = 0; slot < 8; ++slot) { const float pv = __expf(sc[slot] - mx); sc[slot] = pv; lsum += pv; }
        lsum = wave_sum(lsum);
        float part[64];
#pragma unroll
        for (int c = 0; c < 64; ++c) part[c] = 0.f;
#pragma unroll
        for (int slot = 0; slot < 7; ++slot) {
            const int pt = slot < 6 ? (slot >> 1) : (lane < 3 ? lane : 0);
            const int m = slot < 6 ? lane + 64 * (slot & 1) : 128;
            const int kj = qi - (m << (2 * pt));
            const int kc = kj < WBUF ? kj : WBUF - 1;
            const float pv = sc[slot];
            const float* vr = cv + ((size_t)b * WBUF + kc) * ATT_WIDTH + hd * 64;
#pragma unroll
            for (int c = 0; c < 64; c += 4) { const float4 vv = *(const float4*)(vr + c); part[c] += pv * vv.x; part[c + 1] += pv * vv.y; part[c + 2] += pv * vv.z; part[c + 3] += pv * vv.w; }
        }
        {
            const float pv = sc[7];
            const bf16* vr = projb + (size_t)(T_PROMPT + b * DEC_SEQ + nt7) * NB_LD + NB_V + hd * 64;
#pragma unroll
            for (int c = 0; c < 64; c += 8) { float f[8]; unpack8(*(const v4u*)(vr + c), f);
#pragma unroll
                for (int j = 0; j < 8; ++j) part[c + j] += pv * f[j]; }
        }
        PEER_TR_STEP(32, 32) PEER_TR_STEP(16, 16) PEER_TR_STEP(8, 8) PEER_TR_STEP(4, 4) PEER_TR_STEP(2, 2) PEER_TR_STEP(1, 1)
        A1[(size_t)t * MIX_WIDTH + SSD_WIDTH + hd * 64 + lane] = (bf16)f2bf(part[0] / lsum);
    }
}


__device__ __forceinline__ void cache_copy_slice(const float* __restrict__ ck, const float* __restrict__ cv, float* __restrict__ out, unsigned slice, unsigned lane, unsigned bt0 = 0u, unsigned bt1 = 8u) {
    constexpr unsigned PER_B = (WBUF - DEC_SEQ) * ATT_WIDTH / 4;
    constexpr unsigned TOTAL = 2u * DEC_BATCH * PER_B;
#pragma unroll 1
    for (unsigned bt = bt0; bt < bt1; ++bt) {
        f32x4n v[8]; size_t dsti[8]; bool isv[8]; bool ok[8];
#pragma unroll
        for (int j = 0; j < 8; ++j) {
            const unsigned idx = slice * 4096u + bt * 512u + j * 64u + lane;
            ok[j] = idx < TOTAL;
            const unsigned idc = ok[j] ? idx : 0u;
            const unsigned tb = idc / PER_B, r = idc - tb * PER_B, bb = tb & (DEC_BATCH - 1);
            isv[j] = tb >= DEC_BATCH;
            const size_t srci = (size_t)bb * (WBUF * ATT_WIDTH / 4) + (DEC_SEQ * ATT_WIDTH / 4) + r;
            dsti[j] = (size_t)bb * (WBUF * ATT_WIDTH / 4) + r;
            v[j] = __builtin_nontemporal_load((isv[j] ? (const f32x4n*)cv : (const f32x4n*)ck) + srci);
        }
#pragma unroll
        for (int j = 0; j < 8; ++j) if (ok[j]) __builtin_nontemporal_store(v[j], (f32x4n*)(out + (isv[j] ? OUT_SV : OUT_SK)) + dsti[j]);
    }
}

__device__ __forceinline__ void copy_q_load(const float* __restrict__ ck, const float* __restrict__ cv, unsigned q, unsigned lane, f32x4n (&v)[16]) {
    constexpr unsigned PER_B = (WBUF - DEC_SEQ) * ATT_WIDTH / 4, TOTAL = 2u * DEC_BATCH * PER_B;
#pragma unroll
    for (int j = 0; j < 16; ++j) {
        const unsigned idx = q * 1024u + j * 64u + lane, idc = idx < TOTAL ? idx : 0u;
        const unsigned tb = idc / PER_B, r = idc - tb * PER_B, bb = tb & (DEC_BATCH - 1);
        const size_t srci = (size_t)bb * (WBUF * ATT_WIDTH / 4) + (DEC_SEQ * ATT_WIDTH / 4) + r;
        v[j] = __builtin_nontemporal_load((tb >= DEC_BATCH ? (const f32x4n*)cv : (const f32x4n*)ck) + srci);
    }
}
__device__ __forceinline__ void copy_q_store(float* __restrict__ out, unsigned q, unsigned lane, const f32x4n (&v)[16]) {
    constexpr unsigned PER_B = (WBUF - DEC_SEQ) * ATT_WIDTH / 4, TOTAL = 2u * DEC_BATCH * PER_B;
#pragma unroll
    for (int j = 0; j < 16; ++j) {
        const unsigned idx = q * 1024u + j * 64u + lane;
        if (idx < TOTAL) {
            const unsigned tb = idx / PER_B, r = idx - tb * PER_B, bb = tb & (DEC_BATCH - 1);
            const size_t dsti = (size_t)bb * (WBUF * ATT_WIDTH / 4) + r;
            __builtin_nontemporal_store(v[j], (f32x4n*)(out + (tb >= DEC_BATCH ? OUT_SV : OUT_SK)) + dsti);
        }
    }
}
typedef float f32x2v __attribute__((ext_vector_type(2)));
typedef unsigned u32x6 __attribute__((ext_vector_type(6)));
typedef float f32x32 __attribute__((ext_vector_type(32)));
typedef float f32x16q __attribute__((ext_vector_type(16)));
struct __attribute__((aligned(4))) u3w { unsigned x, y, z; };
#define PEER_ROWB 768
#define QSPLIT 8192
__device__ __forceinline__ void ph_quant_tables(const float* __restrict__ pu, const float* __restrict__ pv, unsigned char* __restrict__ ub8, unsigned char* __restrict__ vb8,
                                                float* __restrict__ usc, float* __restrict__ vsc, int rank, int nranks, int row0 = 0, int row1 = 2 * 16384) {
    const int lane = threadIdx.x & 63;
#pragma unroll 2
    for (int row = row0 + rank * NWAVE + (threadIdx.x >> 6); row < row1; row += nranks * NWAVE) {
        const int rr = row & 16383; const bool isv = row >= 16384;
        const float* src = (isv ? pv : pu) + (size_t)rr * D_MODEL + lane * 8;
        const float4 a = *(const float4*)src, b = *(const float4*)(src + 4), c = *(const float4*)(src + 512), d = *(const float4*)(src + 516);
        float am = fmaxf(fmaxf(fmaxf(fabsf(a.x), fabsf(a.y)), fmaxf(fabsf(a.z), fabsf(a.w))), fmaxf(fmaxf(fabsf(b.x), fabsf(b.y)), fmaxf(fabsf(b.z), fabsf(b.w))));
        am = fmaxf(am, fmaxf(fmaxf(fmaxf(fabsf(c.x), fabsf(c.y)), fmaxf(fabsf(c.z), fabsf(c.w))), fmaxf(fmaxf(fabsf(d.x), fabsf(d.y)), fmaxf(fabsf(d.z), fabsf(d.w)))));
        am = wave_max(am);
        const float sc = am > 0.f ? 7.5f / am : 1.0f;
        f32x16q e0, e1;
#pragma unroll
        for (int i = 0; i < 16; ++i) { e0[i] = 0.f; e1[i] = 0.f; }
        e0[0] = a.x * sc; e1[0] = a.y * sc; e0[1] = a.z * sc; e1[1] = a.w * sc; e0[2] = b.x * sc; e1[2] = b.y * sc; e0[3] = b.z * sc; e1[3] = b.w * sc;
        e0[4] = c.x * sc; e1[4] = c.y * sc; e0[5] = c.z * sc; e1[5] = c.w * sc; e0[6] = d.x * sc; e1[6] = d.y * sc; e0[7] = d.z * sc; e1[7] = d.w * sc;
        const u32x6 qv = __builtin_amdgcn_cvt_scalef32_2xpk16_fp6_f32(e0, e1, 1.0f);
        u3w o; o.x = qv[0]; o.y = qv[1]; o.z = qv[2];
        *(u3w*)((isv ? vb8 : ub8) + (size_t)rr * PEER_ROWB + lane * 12) = o;
        if (lane == 0) (isv ? vsc : usc)[rr] = am > 0.f ? am * (1.0f / 7.5f) : 1.0f;
    }
}
__device__ __forceinline__ void unpack16_fp8(const v4u w, float (&f)[16]) {
#pragma unroll
    for (int i = 0; i < 4; ++i) {
        const f32x2v lo = __builtin_amdgcn_cvt_pk_f32_fp8((int)w[i], false), hi = __builtin_amdgcn_cvt_pk_f32_fp8((int)w[i], true);
        f[4 * i] = lo[0]; f[4 * i + 1] = lo[1]; f[4 * i + 2] = hi[0]; f[4 * i + 3] = hi[1];
    }
}
__device__ __forceinline__ unsigned ffn_slice(unsigned n9, unsigned it) {
    const unsigned w = (unsigned)__builtin_amdgcn_readfirstlane(threadIdx.x >> 6), wgl = blockIdx.x * NWAVE + w;
    if (gridDim.x != 256) return n9 + wgl + it * (gridDim.x * NWAVE);
    unsigned v;
    if (w < 2u) { if (it == 0u) v = 0u; else if (it == 4u) v = 1u; else return 0xffffffffu; }
    else { if ((it & 1u) == 0u && it < 8u) v = it >> 1; else return 0xffffffffu; }
    if (v < 2u) return n9 + v * 2048u + wgl;
    const unsigned lw = blockIdx.x * 6u + (w - 2u);
    return n9 + 4096u + (v - 2u) * 1536u + lw;
}
__device__ __forceinline__ unsigned ffn_half(unsigned n9, unsigned it) {
    const unsigned w = (unsigned)__builtin_amdgcn_readfirstlane(threadIdx.x >> 6);
    if (gridDim.x != 256 || w >= 2u || it != 7u) return 0xffffffffu;
    const unsigned hw = blockIdx.x * 2u + w;
    return ((n9 + 7168u + (hw >> 1)) << 1) | (hw & 1u);
}
__device__ __forceinline__ void ph_peer_ffn3(const bf16* __restrict__ hb, const int* __restrict__ eidx, const float* __restrict__ gate,
                                             const unsigned char* __restrict__ ub8, const unsigned char* __restrict__ vb8, const float* __restrict__ usc, const float* __restrict__ vsc,
                                             const float* __restrict__ gam, const float* __restrict__ bet, float* __restrict__ out,
                                             const float* __restrict__ ck, const float* __restrict__ cv, unsigned n9) {
    const int lane0 = threadIdx.x & 63;
    unsigned it = 0;
    for (;; ++it) {
        const int t = token_of_iter((int)it);
        if (t < 0) break;
        int lane = lane0; asm volatile("" : "+v"(lane));
        { const unsigned sl = ffn_slice(n9, it); if (sl < 16384u) cache_copy_slice(ck, cv, out, sl, (unsigned)lane);
          const unsigned hc = ffn_half(n9, it); if (hc != 0xffffffffu) cache_copy_slice(ck, cv, out, hc >> 1, (unsigned)lane, 4u * (hc & 1u), 4u * (hc & 1u) + 4u); }
        const unsigned lo12 = (unsigned)lane * 12u, lo8 = (unsigned)lane * 8u;
        float x[16];
        { float f0[8], f1[8]; const bf16* xr = hb + (size_t)t * D_MODEL + lo8; unpack8(*(const v4u*)xr, f0); unpack8(*(const v4u*)(xr + 512), f1);
#pragma unroll
          for (int j = 0; j < 8; ++j) { x[j] = f0[j]; x[8 + j] = f1[j]; } }
        int ev[2]; float wv[4], su[4];
        ev[0] = eidx[(size_t)t * 128 + lane] & 0x3FFF; ev[1] = eidx[(size_t)t * 128 + 64 + lane] & 0x3FFF;
#pragma unroll
        for (int rd = 0; rd < 4; ++rd) {
            const unsigned pk = (unsigned)eidx[(size_t)t * 128 + rd * 32 + (lane >> 1)];
            const int er = (int)(pk & 0x3FFFu);
            wv[rd] = __builtin_bit_cast(float, pk & 0xFFFFC000u) * vsc[er];
            su[rd] = usc[er];
        }
#pragma unroll
        for (int rd = 0; rd < 4; ++rd) {
            float part[32];
#pragma unroll
            for (int kb = 0; kb < 2; ++kb) {
                u3w ra[16];
#pragma unroll
                for (int k8 = 0; k8 < 16; ++k8) {
                    const int e = __builtin_amdgcn_readlane(ev[rd >> 1], (rd & 1) * 32 + kb * 16 + k8);
                    ra[k8] = *(const u3w*)(ub8 + (size_t)e * PEER_ROWB + lo12);
                }
#pragma unroll
                for (int k8 = 0; k8 < 16; k8 += 2) {
                    u32x6 sv; sv[0] = ra[k8].x; sv[1] = ra[k8].y; sv[2] = ra[k8].z; sv[3] = ra[k8 + 1].x; sv[4] = ra[k8 + 1].y; sv[5] = ra[k8 + 1].z;
                    const f32x32 f = __builtin_amdgcn_cvt_scalef32_pk32_f32_fp6(sv, 1.0f);
                    f32x2v d0 = {0.f, 0.f}, d1 = {0.f, 0.f};
#pragma unroll
                    for (int i = 0; i < 8; ++i) {
                        d0 += (f32x2v){f[2 * i], f[2 * i + 1]} * (f32x2v){x[2 * i], x[2 * i + 1]};
                        d1 += (f32x2v){f[16 + 2 * i], f[17 + 2 * i]} * (f32x2v){x[2 * i], x[2 * i + 1]};
                    }
                    part[kb * 16 + k8] = d0[0] + d0[1]; part[kb * 16 + k8 + 1] = d1[0] + d1[1];
                    __builtin_amdgcn_sched_barrier(0);
                }
            }
            PEER_TR_STEP(16, 32) PEER_TR_STEP(8, 16) PEER_TR_STEP(4, 8) PEER_TR_STEP(2, 4) PEER_TR_STEP(1, 2)
            const float hid = (part[0] + __shfl_xor(part[0], 1)) * su[rd];
            wv[rd] *= gelu_f(hid);
        }
        f32x2v accp[8];
#pragma unroll
        for (int i = 0; i < 8; ++i) accp[i] = (f32x2v){0.f, 0.f};
#pragma unroll
        for (int rd = 0; rd < 4; ++rd) {
#pragma unroll
            for (int kb = 0; kb < 2; ++kb) {
                u3w ra[16];
#pragma unroll
                for (int k8 = 0; k8 < 16; ++k8) {
                    const int e = __builtin_amdgcn_readlane(ev[rd >> 1], (rd & 1) * 32 + kb * 16 + k8);
                    ra[k8] = *(const u3w*)(vb8 + (size_t)e * PEER_ROWB + lo12);
                }
#pragma unroll
                for (int k8 = 0; k8 < 16; k8 += 2) {
                    const float wk0 = __builtin_bit_cast(float, __builtin_amdgcn_readlane(__builtin_bit_cast(int, wv[rd]), 2 * (kb * 16 + k8)));
                    const float wk1 = __builtin_bit_cast(float, __builtin_amdgcn_readlane(__builtin_bit_cast(int, wv[rd]), 2 * (kb * 16 + k8 + 1)));
                    u32x6 sv; sv[0] = ra[k8].x; sv[1] = ra[k8].y; sv[2] = ra[k8].z; sv[3] = ra[k8 + 1].x; sv[4] = ra[k8 + 1].y; sv[5] = ra[k8 + 1].z;
                    const f32x32 f = __builtin_amdgcn_cvt_scalef32_pk32_f32_fp6(sv, 1.0f);
#pragma unroll
                    for (int i = 0; i < 8; ++i) {
                        accp[i] += (f32x2v){wk0, wk0} * (f32x2v){f[2 * i], f[2 * i + 1]};
                        accp[i] += (f32x2v){wk1, wk1} * (f32x2v){f[16 + 2 * i], f[17 + 2 * i]};
                    }
                    __builtin_amdgcn_sched_barrier(0);
                }
            }
        }
        float acc[16];
#pragma unroll
        for (int i = 0; i < 8; ++i) { acc[2 * i] = accp[i][0]; acc[2 * i + 1] = accp[i][1]; }
        float s = 0.f;
#pragma unroll
        for (int j = 0; j < 16; ++j) { acc[j] += ALPHA_F * x[j]; s += acc[j]; }
        s = wave_sum(s);
        const float mu = s * (1.0f / 1024.0f);
        float q = 0.f;
#pragma unroll
        for (int j = 0; j < 16; ++j) { acc[j] -= mu; q += acc[j] * acc[j]; }
        q = wave_sum(q);
        const float r = rsqrtf(q * (1.0f / 1024.0f) + LN_EPS);
        float* dst = ((t < T_PROMPT) ? out + OUT_YP + (size_t)t * D_MODEL : out + OUT_YS + (size_t)(t - T_PROMPT) * D_MODEL) + lo8;
#pragma unroll
        for (int q4 = 0; q4 < 4; ++q4) {
            const int eo = (q4 >> 1) * 512 + (q4 & 1) * 4;
            const float4 g4 = *(const float4*)(gam + lo8 + eo), b4 = *(const float4*)(bet + lo8 + eo);
            float4 o; o.x = acc[q4 * 4 + 0] * r * g4.x + b4.x; o.y = acc[q4 * 4 + 1] * r * g4.y + b4.y; o.z = acc[q4 * 4 + 2] * r * g4.z + b4.z; o.w = acc[q4 * 4 + 3] * r * g4.w + b4.w;
            *(float4*)(dst + eo) = o;
        }
    }
    for (;; ++it) {
        if (gridDim.x == 256 && it >= 5u) break;
        const unsigned sl = ffn_slice(n9, it);
        if (gridDim.x != 256 && sl >= 16384u) break;
        if (sl < 16384u) cache_copy_slice(ck, cv, out, sl, (unsigned)lane0);
    }
}


__device__ __forceinline__ void ssd_decode_load(const bf16* __restrict__ xbc_b, const float* __restrict__ dtv, const float* __restrict__ state_ssm, int item, int p, int ng,
                                                float (&hs)[16], v4u (&bq)[4][2], v4u (&cq)[4][2], float (&xv)[4], float (&dv)[4]) {
    const int sb = item / SSD_HEADS, h = item - sb * SSD_HEADS, g = h / 6, t0 = T_PROMPT + sb * DEC_SEQ;
    const float* s0 = state_ssm + (((size_t)sb * SSD_HEADS + h) * 64 + p) * 128 + ng * 16;
#pragma unroll
    for (int j = 0; j < 4; ++j) { const float4 v = *(const float4*)(s0 + 4 * j); hs[4 * j] = v.x; hs[4 * j + 1] = v.y; hs[4 * j + 2] = v.z; hs[4 * j + 3] = v.w; }
#pragma unroll
    for (int s = 0; s < 4; ++s) {
        const bf16* row = xbc_b + (size_t)(t0 + s) * CONV_DIM;
        bq[s][0] = *(const v4u*)(row + 1536 + g * 128 + ng * 16); bq[s][1] = *(const v4u*)(row + 1536 + g * 128 + ng * 16 + 8);
        cq[s][0] = *(const v4u*)(row + 2048 + g * 128 + ng * 16); cq[s][1] = *(const v4u*)(row + 2048 + g * 128 + ng * 16 + 8);
        xv[s] = bf2f(row[h * 64 + p]); dv[s] = dtv[(size_t)(t0 + s) * SSD_HEADS + h];
    }
}
__device__ __forceinline__ void ssd_decode_compute(const float* __restrict__ a_log, const float* __restrict__ d_skip, int item, int p, int ng,
                                                   float (&hs)[16], const v4u (&bq)[4][2], const v4u (&cq)[4][2], const float (&xv)[4], const float (&dv)[4],
                                                   float* __restrict__ ybuf, float* __restrict__ out) {
    const int sb = item / SSD_HEADS, h = item - sb * SSD_HEADS, t0 = T_PROMPT + sb * DEC_SEQ;
    const float A = -__expf(a_log[h]), D = d_skip[h];
#pragma unroll
    for (int s = 0; s < 4; ++s) {
        float Bf[16], Cf[16];
        { float t8[8]; unpack8(bq[s][0], t8);
#pragma unroll
          for (int j = 0; j < 8; ++j) Bf[j] = t8[j];
          unpack8(bq[s][1], t8);
#pragma unroll
          for (int j = 0; j < 8; ++j) Bf[8 + j] = t8[j];
          unpack8(cq[s][0], t8);
#pragma unroll
          for (int j = 0; j < 8; ++j) Cf[j] = t8[j];
          unpack8(cq[s][1], t8);
#pragma unroll
          for (int j = 0; j < 8; ++j) Cf[8 + j] = t8[j]; }
        const float a = __expf(dv[s] * A), xdt = xv[s] * dv[s];
        float y = 0.f;
#pragma unroll
        for (int j = 0; j < 16; ++j) { hs[j] = a * hs[j] + xdt * Bf[j]; y += Cf[j] * hs[j]; }
        y += __shfl_xor(y, 1); y += __shfl_xor(y, 2); y += __shfl_xor(y, 4);
        if (ng == 0) ybuf[(size_t)(t0 + s) * MIX_WIDTH + h * 64 + p] = y + D * xv[s];
    }
    float* so = out + OUT_SS + (((size_t)sb * SSD_HEADS + h) * 64 + p) * 128 + ng * 16;
#pragma unroll
    for (int j = 0; j < 4; ++j) *(float4*)(so + 4 * j) = make_float4(hs[4 * j], hs[4 * j + 1], hs[4 * j + 2], hs[4 * j + 3]);
}
__device__ __forceinline__ void ph_ssd_decode(const bf16* __restrict__ xbc_b, const float* __restrict__ dtv, const float* __restrict__ a_log, const float* __restrict__ d_skip,
                                              const float* __restrict__ state_ssm, float* __restrict__ ybuf, float* __restrict__ out) {
    const int tid = threadIdx.x, p = tid >> 3, ng = tid & 7;
    constexpr int NITEM = DEC_BATCH * SSD_HEADS;
    for (int it = blockIdx.x; it < NITEM; it += 2 * gridDim.x) {
        const int it2 = it + gridDim.x; const bool has2 = it2 < NITEM; const int it2c = has2 ? it2 : it;
        float hsA[16], hsB[16], xA[4], xB[4], dA[4], dB[4]; v4u bA[4][2], cA[4][2], bB[4][2], cB[4][2];
        ssd_decode_load(xbc_b, dtv, state_ssm, it, p, ng, hsA, bA, cA, xA, dA);
        ssd_decode_load(xbc_b, dtv, state_ssm, it2c, p, ng, hsB, bB, cB, xB, dB);
        ssd_decode_compute(a_log, d_skip, it, p, ng, hsA, bA, cA, xA, dA, ybuf, out);
        if (has2) ssd_decode_compute(a_log, d_skip, it2, p, ng, hsB, bB, cB, xB, dB, ybuf, out);
    }
}

__device__ __forceinline__ float samp_cw(int d) { return (float)((int)(d >= 0 && d <= 128) + (int)(d >= 0 && (d & 3) == 0 && d <= 512) + (int)(d >= 0 && (d & 15) == 0 && d <= 2048)); }
__device__ __forceinline__ void samp_update(float sv, float cw, const float (&vrow)[64], float& m, float& l, float (&part)[64]) {
    const float mn = fmaxf(m, sv), alpha = __expf(m - mn), p = cw * __expf(sv - mn);
    m = mn; l = l * alpha + p;
#pragma unroll
    for (int c = 0; c < 64; ++c) part[c] = part[c] * alpha + p * vrow[c];
}
__device__ __forceinline__ void ph_attn_sample3(float* lds, const bf16* __restrict__ qrot_b, const bf16* __restrict__ krot_b, const bf16* __restrict__ projb,
                                                const float* __restrict__ ck, const float* __restrict__ cv, bf16* __restrict__ A1) {
    const int lane0 = threadIdx.x & 63, w = __builtin_amdgcn_readfirstlane(threadIdx.x >> 6);
    float* sq = lds + w * 256;
    for (int item = blockIdx.x + gridDim.x * w; item < DEC_BATCH * ATT_HEADS; item += gridDim.x * NWAVE) {
        int lane = lane0; asm volatile("" : "+v"(lane));
        const int b = item >> 3, hd = item & 7, qi = lane & 3, g = lane >> 2;
        const int tq0 = T_PROMPT + b * DEC_SEQ;
#pragma unroll
        for (int i = 0; i < 4; ++i) sq[i * 64 + lane] = bf2f(qrot_b[(size_t)(tq0 + i) * ATT_WIDTH + hd * 64 + lane]);
        asm volatile("s_waitcnt lgkmcnt(0)" ::: "memory");
        const float* qv = sq + qi * 64;
        const float* ckb = ck + (size_t)b * WBUF * ATT_WIDTH + hd * 64; const float* cvb = cv + (size_t)b * WBUF * ATT_WIDTH + hd * 64;
        float m = -1e30f, l = 0.f, part[64];
#pragma unroll
        for (int c = 0; c < 64; ++c) part[c] = 0.f;
        {
            const int P = 2051 - g;
            const float cw = samp_cw(WBUF + qi - P);
            const bool isn = P >= WBUF;
            const int nt = isn ? P - WBUF : 0, Pc = isn ? WBUF - 1 : P;
            const bf16* kn = krot_b + (size_t)(tq0 + nt) * ATT_WIDTH + hd * 64; const float* kr = ckb + (size_t)Pc * ATT_WIDTH;
            float a = 0.f;
#pragma unroll
            for (int c = 0; c < 64; c += 8) { float f[8]; unpack8(*(const v4u*)(kn + c), f); const float4 k0 = *(const float4*)(kr + c), k1 = *(const float4*)(kr + c + 4);
                a += (isn ? f[0] : k0.x) * qv[c] + (isn ? f[1] : k0.y) * qv[c + 1] + (isn ? f[2] : k0.z) * qv[c + 2] + (isn ? f[3] : k0.w) * qv[c + 3]
                   + (isn ? f[4] : k1.x) * qv[c + 4] + (isn ? f[5] : k1.y) * qv[c + 5] + (isn ? f[6] : k1.z) * qv[c + 6] + (isn ? f[7] : k1.w) * qv[c + 7]; }
            const float sv = cw > 0.f ? a * 0.125f : -1e30f;
            const bf16* vn = projb + (size_t)(tq0 + nt) * NB_LD + NB_V + hd * 64; const float* vr = cvb + (size_t)Pc * ATT_WIDTH;
            float vrow[64];
#pragma unroll
            for (int c = 0; c < 64; c += 8) { float f[8]; unpack8(*(const v4u*)(vn + c), f); const float4 v0 = *(const float4*)(vr + c), v1 = *(const float4*)(vr + c + 4);
                vrow[c] = isn ? f[0] : v0.x; vrow[c + 1] = isn ? f[1] : v0.y; vrow[c + 2] = isn ? f[2] : v0.z; vrow[c + 3] = isn ? f[3] : v0.w;
                vrow[c + 4] = isn ? f[4] : v1.x; vrow[c + 5] = isn ? f[5] : v1.y; vrow[c + 6] = isn ? f[6] : v1.z; vrow[c + 7] = isn ? f[7] : v1.w; }
            samp_update(sv, cw, vrow, m, l, part);
        }
#pragma unroll 1
        for (int s = 1; s < 21; ++s) {
            const int P = s < 9 ? 2051 - (16 * s + g) : (s < 15 ? 1536 + 64 * (s - 9) + lane : qi + 16 * (16 * (s - 15) + g));
            const float cw = (s < 9 && P < 1920) ? 0.f : samp_cw(WBUF + qi - P);
            const float* kr = ckb + (size_t)P * ATT_WIDTH;
            float a = 0.f;
#pragma unroll
            for (int c = 0; c < 64; c += 4) { const float4 kv = *(const float4*)(kr + c); a += kv.x * qv[c] + kv.y * qv[c + 1] + kv.z * qv[c + 2] + kv.w * qv[c + 3]; }
            const float sv = cw > 0.f ? a * 0.125f : -1e30f;
            __builtin_amdgcn_sched_barrier(0);
            const float* vr = cvb + (size_t)P * ATT_WIDTH;
            float vrow[64];
#pragma unroll
            for (int c = 0; c < 64; c += 4) { const float4 vv = *(const float4*)(vr + c); vrow[c] = vv.x; vrow[c + 1] = vv.y; vrow[c + 2] = vv.z; vrow[c + 3] = vv.w; }
            samp_update(sv, cw, vrow, m, l, part);
        }
        float M = m;
        M = fmaxf(M, __shfl_xor(M, 4)); M = fmaxf(M, __shfl_xor(M, 8)); M = fmaxf(M, __shfl_xor(M, 16)); M = fmaxf(M, __shfl_xor(M, 32));
        const float sc = __expf(m - M);
        float lsum = l * sc;
        lsum += __shfl_xor(lsum, 4); lsum += __shfl_xor(lsum, 8); lsum += __shfl_xor(lsum, 16); lsum += __shfl_xor(lsum, 32);
#pragma unroll
        for (int c = 0; c < 64; ++c) part[c] *= sc;
        PEER_TR_STEP(32, 32) PEER_TR_STEP(16, 16) PEER_TR_STEP(8, 8) PEER_TR_STEP(4, 4)
        const float inv = 1.0f / lsum;
        *(uint2*)(A1 + (size_t)(tq0 + qi) * MIX_WIDTH + SSD_WIDTH + hd * 64 + 4 * g) = make_uint2(pk2(part[0] * inv, part[1] * inv), pk2(part[2] * inv, part[3] * inv));
    }
}

typedef float f32x16 __attribute__((ext_vector_type(16)));
typedef short s16x8 __attribute__((ext_vector_type(8)));
typedef short s16x4 __attribute__((ext_vector_type(4)));
typedef float f32x4v __attribute__((ext_vector_type(4)));
#define SSD_L_ACS 0
#define SSD_L_DTS 3072
#define SSD_L_BM 6144
#define SSD_RS_B 272
#define SSD_L_X (6144 + 128 * 272)
#define SSD_RS_X 144
#define SSD_XIMG (128 * 144)
#define SSD_RS_Y 784
template <int OFF0, int OFF1>
__device__ __forceinline__ s16x8 tr_frag(unsigned base) {
    s16x4 a, b;
    asm volatile("ds_read_b64_tr_b16 %0, %2 offset:%3\n\tds_read_b64_tr_b16 %1, %2 offset:%4\n\ts_waitcnt lgkmcnt(0)"
                 : "=&v"(a), "=&v"(b) : "v"(base), "n"(OFF0), "n"(OFF1) : "memory");
    return __builtin_shufflevector(a, b, 0, 1, 2, 3, 4, 5, 6, 7);
}
__device__ __forceinline__ unsigned lds_addr(LAS unsigned char* p) { return (unsigned)(size_t)p; }
template <int O0, int O1, int O2, int O3, int O4, int O5, int O6, int O7>
__device__ __forceinline__ void tr_read8(unsigned base, s16x4 (&v)[8]) {
    asm volatile("ds_read_b64_tr_b16 %0, %8 offset:%9\n\tds_read_b64_tr_b16 %1, %8 offset:%10\n\tds_read_b64_tr_b16 %2, %8 offset:%11\n\tds_read_b64_tr_b16 %3, %8 offset:%12\n\t"
                 "ds_read_b64_tr_b16 %4, %8 offset:%13\n\tds_read_b64_tr_b16 %5, %8 offset:%14\n\tds_read_b64_tr_b16 %6, %8 offset:%15\n\tds_read_b64_tr_b16 %7, %8 offset:%16\n\ts_waitcnt lgkmcnt(0)"
                 : "=&v"(v[0]), "=&v"(v[1]), "=&v"(v[2]), "=&v"(v[3]), "=&v"(v[4]), "=&v"(v[5]), "=&v"(v[6]), "=&v"(v[7])
                 : "v"(base), "n"(O0), "n"(O1), "n"(O2), "n"(O3), "n"(O4), "n"(O5), "n"(O6), "n"(O7) : "memory");
}
#define TRCAT(a, b) __builtin_shufflevector(a, b, 0, 1, 2, 3, 4, 5, 6, 7)


__device__ __forceinline__ void ssd_chunk_acs(LAS unsigned char* ldsb, const float* __restrict__ dtv, const float* __restrict__ a_log, int t0, int g, float* cdec_out) {
    const int w = __builtin_amdgcn_readfirstlane(threadIdx.x >> 6), lane = threadIdx.x & 63;
    if (w < 6) {
        const int head = 6 * g + w;
        const float A = -__expf(a_log[head]);
        const float v0 = dtv[(size_t)(t0 + 2 * lane) * SSD_HEADS + head], v1 = dtv[(size_t)(t0 + 2 * lane + 1) * SSD_HEADS + head];
        const float a1 = v1 * A;
        float s = v0 * A + a1;
#pragma unroll
        for (int o = 1; o < 64; o <<= 1) { const float tmp = __shfl_up(s, o); if (lane >= o) s += tmp; }
        LAS float* acs = (LAS float*)(ldsb + SSD_L_ACS) + w * 128;
        LAS float* dts = (LAS float*)(ldsb + SSD_L_DTS) + w * 128;
        acs[2 * lane] = s - a1; acs[2 * lane + 1] = s;
        dts[2 * lane] = v0; dts[2 * lane + 1] = v1;
        if (cdec_out && lane == 63) cdec_out[head] = __expf(s);
    }
}

__device__ __forceinline__ void ph_ssd_states(LAS unsigned char* ldsb, const bf16* __restrict__ xbc_b, const float* __restrict__ dtv, const float* __restrict__ a_log,
                                              bf16* __restrict__ Sbuf, float* __restrict__ cdec, const float* __restrict__ ck, const float* __restrict__ cv, float* __restrict__ out) {
    const int tid = threadIdx.x, w = __builtin_amdgcn_readfirstlane(tid >> 6), lane = tid & 63;
    const int r = lane & 31, h = lane >> 5, blk = (lane >> 4) & 1, q = (lane & 15) >> 2, pp = lane & 3;
    const int nt = w & 3, pt = w >> 2;
    for (int unit = blockIdx.x; unit < BATCH * 64 * SSD_GROUPS; unit += gridDim.x) {
        const int g = unit & 3, bc = unit >> 2;
        const int t0 = bc * 128;
        __syncthreads();
        ssd_chunk_acs(ldsb, dtv, a_log, t0, g, cdec + (size_t)bc * SSD_HEADS);
#pragma unroll
        for (int it_ = 0; it_ < 4; ++it_) { const int idx = tid + it_ * NTHR; const int row = idx >> 4, ch = idx & 15;
            const v4u v = *(const v4u*)(xbc_b + (size_t)(t0 + row) * CONV_DIM + 1536 + 128 * g + ch * 8);
            *(LAS v4u*)(ldsb + SSD_L_BM + row * SSD_RS_B + ch * 16) = v; }
        __syncthreads();
#pragma unroll
        for (int it_ = 0; it_ < 12; ++it_) { const int idx = tid + it_ * NTHR; const int hh = idx >> 10, rem = idx & 1023, row = rem >> 3, ch = rem & 7;
            const LAS float* acs = (const LAS float*)(ldsb + SSD_L_ACS) + hh * 128; const LAS float* dts = (const LAS float*)(ldsb + SSD_L_DTS) + hh * 128;
            const float wgt = dts[row] * __expf(acs[127] - acs[row]);
            float f[8]; unpack8(*(const v4u*)(xbc_b + (size_t)(t0 + row) * CONV_DIM + (6 * g + hh) * 64 + ch * 8), f);
            v4u o; o.x = pk2(f[0] * wgt, f[1] * wgt); o.y = pk2(f[2] * wgt, f[3] * wgt); o.z = pk2(f[4] * wgt, f[5] * wgt); o.w = pk2(f[6] * wgt, f[7] * wgt);
            *(LAS v4u*)(ldsb + SSD_L_X + hh * SSD_XIMG + row * SSD_RS_X + ch * 16) = o; }
        __syncthreads();
        f32x4n rider[16];
        copy_q_load(ck, cv, 12288u + (unsigned)(unit * NWAVE + w), (unsigned)lane, rider);
        const unsigned abase = lds_addr(ldsb + SSD_L_BM) + (8 * h + q) * SSD_RS_B + (32 * nt + 16 * blk + 4 * pp) * 2;
        s16x8 afr[8];
        { s16x4 av[8];
          tr_read8<0 * SSD_RS_B, 4 * SSD_RS_B, 16 * SSD_RS_B, 20 * SSD_RS_B, 32 * SSD_RS_B, 36 * SSD_RS_B, 48 * SSD_RS_B, 52 * SSD_RS_B>(abase, av);
          afr[0] = TRCAT(av[0], av[1]); afr[1] = TRCAT(av[2], av[3]); afr[2] = TRCAT(av[4], av[5]); afr[3] = TRCAT(av[6], av[7]);
          tr_read8<64 * SSD_RS_B, 68 * SSD_RS_B, 80 * SSD_RS_B, 84 * SSD_RS_B, 96 * SSD_RS_B, 100 * SSD_RS_B, 112 * SSD_RS_B, 116 * SSD_RS_B>(abase, av);
          afr[4] = TRCAT(av[0], av[1]); afr[5] = TRCAT(av[2], av[3]); afr[6] = TRCAT(av[4], av[5]); afr[7] = TRCAT(av[6], av[7]); }
#pragma unroll
        for (int hh = 0; hh < 6; ++hh) {
            const unsigned xb = lds_addr(ldsb + SSD_L_X + hh * SSD_XIMG) + (8 * h + q) * SSD_RS_X + (32 * pt + 16 * blk + 4 * pp) * 2;
            f32x16 acc;
#pragma unroll
            for (int i = 0; i < 16; ++i) acc[i] = 0.f;
            { s16x4 xv[8];
              tr_read8<0 * SSD_RS_X, 4 * SSD_RS_X, 16 * SSD_RS_X, 20 * SSD_RS_X, 32 * SSD_RS_X, 36 * SSD_RS_X, 48 * SSD_RS_X, 52 * SSD_RS_X>(xb, xv);
              acc = __builtin_amdgcn_mfma_f32_32x32x16_bf16(afr[0], TRCAT(xv[0], xv[1]), acc, 0, 0, 0);
              acc = __builtin_amdgcn_mfma_f32_32x32x16_bf16(afr[1], TRCAT(xv[2], xv[3]), acc, 0, 0, 0);
              acc = __builtin_amdgcn_mfma_f32_32x32x16_bf16(afr[2], TRCAT(xv[4], xv[5]), acc, 0, 0, 0);
              acc = __builtin_amdgcn_mfma_f32_32x32x16_bf16(afr[3], TRCAT(xv[6], xv[7]), acc, 0, 0, 0);
              tr_read8<64 * SSD_RS_X, 68 * SSD_RS_X, 80 * SSD_RS_X, 84 * SSD_RS_X, 96 * SSD_RS_X, 100 * SSD_RS_X, 112 * SSD_RS_X, 116 * SSD_RS_X>(xb, xv);
              acc = __builtin_amdgcn_mfma_f32_32x32x16_bf16(afr[4], TRCAT(xv[0], xv[1]), acc, 0, 0, 0);
              acc = __builtin_amdgcn_mfma_f32_32x32x16_bf16(afr[5], TRCAT(xv[2], xv[3]), acc, 0, 0, 0);
              acc = __builtin_amdgcn_mfma_f32_32x32x16_bf16(afr[6], TRCAT(xv[4], xv[5]), acc, 0, 0, 0);
              acc = __builtin_amdgcn_mfma_f32_32x32x16_bf16(afr[7], TRCAT(xv[6], xv[7]), acc, 0, 0, 0); }
            bf16* dst = Sbuf + ((size_t)bc * SSD_HEADS + 6 * g + hh) * 8192 + (size_t)(pt * 8 + 2 * nt) * 512 + r * 8 + 4 * h;
#pragma unroll
            for (int q4 = 0; q4 < 4; ++q4) *(uint2*)(dst + (q4 >> 1) * 512 + (q4 & 1) * 256) = make_uint2(pk2(acc[4 * q4], acc[4 * q4 + 1]), pk2(acc[4 * q4 + 2], acc[4 * q4 + 3]));
        }
        copy_q_store(out, 12288u + (unsigned)(unit * NWAVE + w), (unsigned)lane, rider);
    }
}

__device__ __forceinline__ void ph_ssd_scan(const bf16* __restrict__ Sbuf, const float* __restrict__ cdec, bf16* __restrict__ Hin, float* __restrict__ out, int rank, int nranks) {
    for (int idx = rank * NTHR + threadIdx.x; idx < BATCH * SSD_HEADS * 1024; idx += nranks * NTHR) {
        const int i = idx & 1023, hb = idx >> 10, hd = hb % SSD_HEADS, b = hb / SSD_HEADS;
        float st[8];
#pragma unroll
        for (int j = 0; j < 8; ++j) st[j] = 0.f;
#pragma unroll 8
        for (int c = 0; c < 64; ++c) {
            const size_t base = (((size_t)(b * 64 + c)) * SSD_HEADS + hd) * 8192 + (size_t)i * 8;
            v4u o; o.x = pk2(st[0], st[1]); o.y = pk2(st[2], st[3]); o.z = pk2(st[4], st[5]); o.w = pk2(st[6], st[7]);
            *(v4u*)(Hin + base) = o;
            float s[8]; unpack8(*(const v4u*)(Sbuf + base), s);
            const float a = cdec[(size_t)(b * 64 + c) * SSD_HEADS + hd];
#pragma unroll
            for (int j = 0; j < 8; ++j) st[j] = a * st[j] + s[j];
        }
        const int ln = i & 63, ks = (i >> 6) & 7, pt = i >> 9, p = 32 * pt + (ln & 31), n0 = 16 * ks + 8 * (ln >> 5);
        store8f(out + OUT_PS + (((size_t)b * SSD_HEADS + hd) * 64 + p) * 128 + n0, st);
    }
}

__device__ __forceinline__ void ph_ssd_out(LAS unsigned char* ldsb, const bf16* __restrict__ xbc_b, const bf16* __restrict__ projb, const float* __restrict__ dtv,
                                           const float* __restrict__ a_log, const float* __restrict__ d_skip, const float* __restrict__ norm_g,
                                           const bf16* __restrict__ Hin, bf16* __restrict__ A1) {
    const int tid = threadIdx.x, w = __builtin_amdgcn_readfirstlane(tid >> 6), lane = tid & 63;
    const int r = lane & 31, h = lane >> 5, blk = (lane >> 4) & 1, q = (lane & 15) >> 2, pp = lane & 3;
    const int hs = w >> 2, lt = hs ? 3 - (w & 3) : (w & 3);
    for (int unit = blockIdx.x; unit < BATCH * 64 * SSD_GROUPS; unit += gridDim.x) {
        const int g = unit & 3, bc = unit >> 2;
        const int t0 = bc * 128;
        __syncthreads();
        ssd_chunk_acs(ldsb, dtv, a_log, t0, g, nullptr);
#pragma unroll
        for (int it_ = 0; it_ < 4; ++it_) { const int idx = tid + it_ * NTHR; const int row = idx >> 4, ch = idx & 15;
            const v4u v = *(const v4u*)(xbc_b + (size_t)(t0 + row) * CONV_DIM + 1536 + 128 * g + ch * 8);
            *(LAS v4u*)(ldsb + SSD_L_BM + row * SSD_RS_B + ch * 16) = v; }
#pragma unroll
        for (int it_ = 0; it_ < 12; ++it_) { const int idx = tid + it_ * NTHR; const int hh = idx >> 10, rem = idx & 1023, row = rem >> 3, ch = rem & 7;
            const v4u v = *(const v4u*)(xbc_b + (size_t)(t0 + row) * CONV_DIM + (6 * g + hh) * 64 + ch * 8);
            *(LAS v4u*)(ldsb + SSD_L_X + hh * SSD_XIMG + row * SSD_RS_X + ch * 16) = v; }
        __syncthreads();
        const bf16* cp = xbc_b + (size_t)(t0 + 32 * lt + r) * CONV_DIM + 2048 + 128 * g + 8 * h;
        s16x8 cfr[8];
#pragma unroll
        for (int ks = 0; ks < 8; ++ks) cfr[ks] = *(const s16x8*)(cp + 16 * ks);
        const int lcol = 32 * lt + r;
        const LAS float* acsb = (const LAS float*)(ldsb + SSD_L_ACS) + 3 * hs * 128; const LAS float* dtsb = (const LAS float*)(ldsb + SSD_L_DTS) + 3 * hs * 128;
        const unsigned xb0 = lds_addr(ldsb + SSD_L_X + 3 * hs * SSD_XIMG) + (4 * h + q) * SSD_RS_X + (16 * blk + 4 * pp) * 2;
        unsigned ypk[3][16];
#pragma unroll
        for (int h3 = 0; h3 < 3; ++h3) {
            const LAS float* acs = acsb + h3 * 128; const LAS float* dts = dtsb + h3 * 128;
            const float myacs = acs[lcol];
            const float Dh = d_skip[6 * g + 3 * hs + h3];
            f32x16 y0, y1;
#pragma unroll
            for (int i = 0; i < 16; ++i) { y0[i] = 0.f; y1[i] = 0.f; }
            { const bf16* hp = Hin + ((size_t)bc * SSD_HEADS + 6 * g + 3 * hs + h3) * 8192 + lane * 8;
#pragma unroll
              for (int kh = 0; kh < 2; ++kh) {
                  s16x8 hf0[4], hf1[4];
#pragma unroll
                  for (int ks = 0; ks < 4; ++ks) { hf0[ks] = *(const s16x8*)(hp + (4 * kh + ks) * 512); hf1[ks] = *(const s16x8*)(hp + (8 + 4 * kh + ks) * 512); }
#pragma unroll
                  for (int ks = 0; ks < 4; ++ks) { y0 = __builtin_amdgcn_mfma_f32_32x32x16_bf16(cfr[4 * kh + ks], hf0[ks], y0, 0, 0, 0); y1 = __builtin_amdgcn_mfma_f32_32x32x16_bf16(cfr[4 * kh + ks], hf1[ks], y1, 0, 0, 0); }
                  __builtin_amdgcn_sched_barrier(0);
              } }
#pragma unroll
            for (int q4 = 0; q4 < 4; ++q4) {
                const f32x4v a4 = *(const LAS f32x4v*)(acs + 32 * lt + 8 * q4 + 4 * h);
                const float e0 = __expf(a4[0]), e1 = __expf(a4[1]), e2 = __expf(a4[2]), e3 = __expf(a4[3]);
                y0[4 * q4] *= e0; y0[4 * q4 + 1] *= e1; y0[4 * q4 + 2] *= e2; y0[4 * q4 + 3] *= e3;
                y1[4 * q4] *= e0; y1[4 * q4 + 1] *= e1; y1[4 * q4 + 2] *= e2; y1[4 * q4 + 3] *= e3;
            }
            __builtin_amdgcn_sched_barrier(0);
            for (int st = 0; st <= lt; ++st) {
                f32x16 cb;
#pragma unroll
                for (int i = 0; i < 16; ++i) cb[i] = 0.f;
#pragma unroll
                for (int ks = 0; ks < 8; ++ks) {
                    const s16x8 bfrag = *(const LAS s16x8*)(ldsb + SSD_L_BM + (32 * st + r) * SSD_RS_B + (16 * ks + 8 * h) * 2);
                    cb = __builtin_amdgcn_mfma_f32_32x32x16_bf16(bfrag, cfr[ks], cb, 0, 0, 0);
                }
                __builtin_amdgcn_sched_barrier(0);
                const unsigned xb = xb0 + h3 * SSD_XIMG + st * 32 * SSD_RS_X;
                s16x4 xv[8];
                tr_read8<0, 8 * SSD_RS_X, 64, 8 * SSD_RS_X + 64, 16 * SSD_RS_X, 24 * SSD_RS_X, 16 * SSD_RS_X + 64, 24 * SSD_RS_X + 64>(xb, xv);
#pragma unroll
                for (int kk = 0; kk < 2; ++kk) {
                    const int s0 = 32 * st + 16 * kk + 4 * h;
                    const f32x4v as0 = *(const LAS f32x4v*)(acs + s0), as1 = *(const LAS f32x4v*)(acs + s0 + 8);
                    const f32x4v ds0 = *(const LAS f32x4v*)(dts + s0), ds1 = *(const LAS f32x4v*)(dts + s0 + 8);
                    float wv[8];
#pragma unroll
                    for (int j = 0; j < 8; ++j) {
                        const int s = s0 + 8 * (j >> 2) + (j & 3);
                        const float asj = (j < 4) ? as0[j & 3] : as1[j & 3], dsj = (j < 4) ? ds0[j & 3] : ds1[j & 3];
                        float v = cb[8 * kk + j] * __expf(myacs - asj) * dsj;
                        v = (s <= lcol) ? v : 0.f;
                        v = (s == lcol) ? v + Dh : v;
                        wv[j] = v;
                    }
                    s16x8 afr;
                    { v4u o; o.x = pk2(wv[0], wv[1]); o.y = pk2(wv[2], wv[3]); o.z = pk2(wv[4], wv[5]); o.w = pk2(wv[6], wv[7]); afr = __builtin_bit_cast(s16x8, o); }
                    const s16x8 b0 = kk == 0 ? TRCAT(xv[0], xv[1]) : TRCAT(xv[4], xv[5]);
                    const s16x8 b1 = kk == 0 ? TRCAT(xv[2], xv[3]) : TRCAT(xv[6], xv[7]);
                    y0 = __builtin_amdgcn_mfma_f32_32x32x16_bf16(afr, b0, y0, 0, 0, 0);
                    y1 = __builtin_amdgcn_mfma_f32_32x32x16_bf16(afr, b1, y1, 0, 0, 0);
                    __builtin_amdgcn_sched_barrier(0);
                }
            }
#pragma unroll
            for (int i = 0; i < 8; ++i) { ypk[h3][i] = pk2(y0[2 * i], y0[2 * i + 1]); ypk[h3][8 + i] = pk2(y1[2 * i], y1[2 * i + 1]); }
            __builtin_amdgcn_sched_barrier(0);
        }
        __syncthreads();
        {
            LAS unsigned short* yst = (LAS unsigned short*)(ldsb + SSD_L_X);
#pragma unroll
            for (int h3 = 0; h3 < 3; ++h3)
#pragma unroll
                for (int ptile = 0; ptile < 2; ++ptile)
#pragma unroll
                    for (int i = 0; i < 8; ++i) {
                        const int reg = 2 * i;
                        const int l0 = 32 * lt + (reg & 3) + 8 * (reg >> 2) + 4 * h;
                        const int col = (3 * hs + h3) * 64 + 32 * ptile + r;
                        const unsigned v = ypk[h3][8 * ptile + i];
                        yst[l0 * (SSD_RS_Y / 2) + col] = (unsigned short)(v & 0xffffu);
                        yst[(l0 + 1) * (SSD_RS_Y / 2) + col] = (unsigned short)(v >> 16);
                    }
        }
        __syncthreads();
#pragma unroll
        for (int pass = 0; pass < 4; ++pass) {
            const int l = 4 * (pass * 8 + w) + (lane >> 4), i16 = lane & 15;
            float gv[3][8]; float ss = 0.f;
#pragma unroll
            for (int k = 0; k < 3; ++k) {
                const int col0 = 24 * i16 + 8 * k;
                float yv[8], zv[8];
                unpack8(*(const LAS v4u*)(ldsb + SSD_L_X + l * SSD_RS_Y + col0 * 2), yv);
                unpack8(*(const v4u*)(projb + (size_t)(t0 + l) * NB_LD + g * 384 + col0), zv);
#pragma unroll
                for (int j = 0; j < 8; ++j) { const float gg = yv[j] * silu_f(zv[j]); gv[k][j] = gg; ss += gg * gg; }
            }
            ss += __shfl_xor(ss, 1); ss += __shfl_xor(ss, 2); ss += __shfl_xor(ss, 4); ss += __shfl_xor(ss, 8);
            const float rstd = rsqrtf(ss * (1.0f / 384.0f) + LN_EPS);
#pragma unroll
            for (int k = 0; k < 3; ++k) {
                const int col0 = g * 384 + 24 * i16 + 8 * k;
                const float4 g0 = *(const float4*)(norm_g + col0), g1 = *(const float4*)(norm_g + col0 + 4);
                v4u o; o.x = pk2(gv[k][0] * rstd * g0.x, gv[k][1] * rstd * g0.y); o.y = pk2(gv[k][2] * rstd * g0.z, gv[k][3] * rstd * g0.w);
                o.z = pk2(gv[k][4] * rstd * g1.x, gv[k][5] * rstd * g1.y); o.w = pk2(gv[k][6] * rstd * g1.z, gv[k][7] * rstd * g1.w);
                *(v4u*)(A1 + (size_t)(t0 + l) * MIX_WIDTH + col0) = o;
            }
        }
    }
}

#define ATT_RS_V 144
#define ATT_VIMG (256 * ATT_RS_V)
#define ATT_HIMG (2 * ATT_VIMG)
#define ATT_PVT(KT) { \
        s16x4 vv_[8]; \
        tr_read8<(32 * KT) * ATT_RS_V, (32 * KT + 8) * ATT_RS_V, (32 * KT) * ATT_RS_V + 64, (32 * KT + 8) * ATT_RS_V + 64, \
                 (32 * KT + 16) * ATT_RS_V, (32 * KT + 24) * ATT_RS_V, (32 * KT + 16) * ATT_RS_V + 64, (32 * KT + 24) * ATT_RS_V + 64>(vbase, vv_); \
        _Pragma("unroll") for (int s2_ = 0; s2_ < 2; ++s2_) { \
            v4u o_; o_.x = pk2(s[KT][8 * s2_ + 0], s[KT][8 * s2_ + 1]); o_.y = pk2(s[KT][8 * s2_ + 2], s[KT][8 * s2_ + 3]); \
            o_.z = pk2(s[KT][8 * s2_ + 4], s[KT][8 * s2_ + 5]); o_.w = pk2(s[KT][8 * s2_ + 6], s[KT][8 * s2_ + 7]); \
            const s16x8 pf_ = __builtin_bit_cast(s16x8, o_); \
            const s16x8 a0_ = s2_ == 0 ? TRCAT(vv_[0], vv_[1]) : TRCAT(vv_[4], vv_[5]); \
            const s16x8 a1_ = s2_ == 0 ? TRCAT(vv_[2], vv_[3]) : TRCAT(vv_[6], vv_[7]); \
            o0 = __builtin_amdgcn_mfma_f32_32x32x16_bf16(a0_, pf_, o0, 0, 0, 0); \
            o1 = __builtin_amdgcn_mfma_f32_32x32x16_bf16(a1_, pf_, o1, 0, 0, 0); } }
__device__ __forceinline__ void ph_attn_prompt(LAS unsigned char* ldsb, const bf16* __restrict__ qrot_b, const bf16* __restrict__ krot_b, const bf16* __restrict__ projb,
                                               bf16* __restrict__ obuf, float* __restrict__ lsebuf, const float* __restrict__ ck, const float* __restrict__ cv, float* __restrict__ out) {
    const int tid = threadIdx.x, w = __builtin_amdgcn_readfirstlane(tid >> 6), lane = tid & 63;
    const int r = lane & 31, h = lane >> 5, blk = (lane >> 4) & 1, q = (lane & 15) >> 2, pp = lane & 3;
    const int qt = w & 3, hsel = w >> 2;
    f32x4n rider[16]; bool pend = false; unsigned pq = 0u;
    for (int unit = blockIdx.x; unit < 3 * 512; unit += gridDim.x) {
        const int pat = unit >> 9, rem = unit & 511, hp = rem & 3, rem2 = rem >> 2, b = rem2 >> 6, bk = rem2 & 63;
        const int dsh = 2 * pat, nper = 64 >> dsh, res = bk >> (6 - dsh), nb = bk & (nper - 1);
        const int head = 2 * hp + hsel;
        __syncthreads();
        { v4u vst[8], kst[8];
#pragma unroll
          for (int it_ = 0; it_ < 8; ++it_) { const int idx = (tid & 255) + it_ * 256;
              const int row = idx >> 3, ch = idx & 7, js = 128 * nb - 128 + row, jc = js < 0 ? 0 : js;
              const size_t tk = (size_t)(b * SEQ + (jc << dsh) + res);
              vst[it_] = *(const v4u*)(projb + tk * NB_LD + NB_V + head * 64 + ch * 8);
              kst[it_] = *(const v4u*)(krot_b + tk * ATT_WIDTH + head * 64 + ch * 8); }
#pragma unroll
          for (int it_ = 0; it_ < 8; ++it_) { const int idx = (tid & 255) + it_ * 256;
              const int row = idx >> 3, ch = idx & 7, js = 128 * nb - 128 + row;
              v4u v = vst[it_], k = kst[it_]; if (js < 0) { v.x = 0u; v.y = 0u; v.z = 0u; v.w = 0u; k = v; }
              *(LAS v4u*)(ldsb + hsel * ATT_HIMG + row * ATT_RS_V + ch * 16) = v;
              *(LAS v4u*)(ldsb + hsel * ATT_HIMG + ATT_VIMG + row * ATT_RS_V + ch * 16) = k; } }
        const int tq = b * SEQ + ((128 * nb + 32 * qt + r) << dsh) + res;
        s16x8 qf[4];
#pragma unroll
        for (int ks = 0; ks < 4; ++ks) qf[ks] = *(const s16x8*)(qrot_b + (size_t)tq * ATT_WIDTH + head * 64 + 16 * ks + 8 * h);
        __syncthreads();
        f32x16 s[5];
#pragma unroll
        for (int kt = 0; kt < 5; ++kt) {
            const LAS unsigned char* kp = ldsb + hsel * ATT_HIMG + ATT_VIMG + (32 * qt + 32 * kt + r) * ATT_RS_V + 16 * h;
#pragma unroll
            for (int i = 0; i < 16; ++i) s[kt][i] = 0.f;
#pragma unroll
            for (int ks = 0; ks < 4; ++ks) s[kt] = __builtin_amdgcn_mfma_f32_32x32x16_bf16(*(const LAS s16x8*)(kp + 32 * ks), qf[ks], s[kt], 0, 0, 0);
        }
        if (pend) copy_q_store(out, pq, (unsigned)lane, rider);
        float m = -INFINITY;
#pragma unroll
        for (int kt = 0; kt < 5; ++kt) {
            const bool tile_ok = (nb > 0) || (qt + kt >= 4);
#pragma unroll
            for (int reg = 0; reg < 16; ++reg) {
                const int c = (reg & 3) + 8 * (reg >> 2) + 4 * h;
                const bool ok = tile_ok && (kt == 0 ? (c >= r) : (kt == 4 ? (c <= r) : true));
                const float v = ok ? s[kt][reg] * 0.125f : -INFINITY;
                s[kt][reg] = v; m = fmaxf(m, v);
            }
        }
        m = fmaxf(m, __shfl_xor(m, 32));
        float l = 0.f;
#pragma unroll
        for (int kt = 0; kt < 5; ++kt)
#pragma unroll
            for (int reg = 0; reg < 16; ++reg) { const float p = __expf(s[kt][reg] - m); s[kt][reg] = p; l += p; }
        l += __shfl_xor(l, 32);
        pq = (unsigned)(unit * NWAVE + w); copy_q_load(ck, cv, pq, (unsigned)lane, rider); pend = true;
        f32x16 o0, o1;
#pragma unroll
        for (int i = 0; i < 16; ++i) { o0[i] = 0.f; o1[i] = 0.f; }
        const unsigned vbase = lds_addr(ldsb + hsel * ATT_HIMG) + (32 * qt + 4 * h + q) * ATT_RS_V + (16 * blk + 4 * pp) * 2;
        ATT_PVT(0) ATT_PVT(1) ATT_PVT(2) ATT_PVT(3) ATT_PVT(4)
        const float inv = 1.0f / l;
        bf16* op = obuf + ((size_t)pat * T_PROMPT + tq) * ATT_WIDTH + head * 64 + 8 * h;
#pragma unroll
        for (int k2 = 0; k2 < 4; ++k2) {
            unsigned ax, ay, bx, by;
            if (k2 < 2) { ax = pk2(o0[8 * k2] * inv, o0[8 * k2 + 1] * inv); ay = pk2(o0[8 * k2 + 2] * inv, o0[8 * k2 + 3] * inv);
                          bx = pk2(o0[8 * k2 + 4] * inv, o0[8 * k2 + 5] * inv); by = pk2(o0[8 * k2 + 6] * inv, o0[8 * k2 + 7] * inv); }
            else { const int k3 = k2 - 2;
                   ax = pk2(o1[8 * k3] * inv, o1[8 * k3 + 1] * inv); ay = pk2(o1[8 * k3 + 2] * inv, o1[8 * k3 + 3] * inv);
                   bx = pk2(o1[8 * k3 + 4] * inv, o1[8 * k3 + 5] * inv); by = pk2(o1[8 * k3 + 6] * inv, o1[8 * k3 + 7] * inv); }
            const auto rx = __builtin_amdgcn_permlane32_swap(ax, bx, false, false);
            const auto ry = __builtin_amdgcn_permlane32_swap(ay, by, false, false);
            v4u o; o.x = rx[0]; o.y = ry[0]; o.z = rx[1]; o.w = ry[1];
            *(v4u*)(op + 16 * k2) = o;
        }
        if (h == 0) lsebuf[((size_t)pat * T_PROMPT + tq) * 8 + head] = m + __logf(l);
    }
    if (pend) copy_q_store(out, pq, (unsigned)lane, rider);
}
__device__ __forceinline__ void ph_attn_combine(const bf16* __restrict__ obuf, const float* __restrict__ lsebuf, bf16* __restrict__ A1) {
    const int lane = threadIdx.x & 63;
#pragma unroll 4
    for (int t = blockIdx.x * NWAVE + (threadIdx.x >> 6); t < T_PROMPT; t += gridDim.x * NWAVE) {
        const int hd = lane >> 3;
        const float l0 = lsebuf[((size_t)0 * T_PROMPT + t) * 8 + hd], l1 = lsebuf[((size_t)1 * T_PROMPT + t) * 8 + hd], l2 = lsebuf[((size_t)2 * T_PROMPT + t) * 8 + hd];
        const float mx = fmaxf(l0, fmaxf(l1, l2));
        const float e0 = __expf(l0 - mx), e1 = __expf(l1 - mx), e2 = __expf(l2 - mx);
        const float inv = 1.0f / (e0 + e1 + e2);
        float a[8], b[8], c[8];
        unpack8(*(const v4u*)(obuf + ((size_t)0 * T_PROMPT + t) * ATT_WIDTH + lane * 8), a);
        unpack8(*(const v4u*)(obuf + ((size_t)1 * T_PROMPT + t) * ATT_WIDTH + lane * 8), b);
        unpack8(*(const v4u*)(obuf + ((size_t)2 * T_PROMPT + t) * ATT_WIDTH + lane * 8), c);
        float o[8];
#pragma unroll
        for (int j = 0; j < 8; ++j) o[j] = (e0 * a[j] + e1 * b[j] + e2 * c[j]) * inv;
        v4u w; w.x = pk2(o[0], o[1]); w.y = pk2(o[2], o[3]); w.z = pk2(o[4], o[5]); w.w = pk2(o[6], o[7]);
        *(v4u*)(A1 + (size_t)t * MIX_WIDTH + SSD_WIDTH + lane * 8) = w;
    }
}

#define RT_RS 272
#define RT_KIMG (128 * RT_RS)
#define RT_LUT (2 * RT_KIMG)
constexpr unsigned char RT_CANDS[64] = {0, 1, 2, 3, 4, 5, 6, 7, 8, 9, 10, 11, 12, 13, 14, 15, 16, 17, 18, 19, 20, 21, 22, 23, 32, 33, 34, 35, 36, 48, 49, 50, 51, 64, 65, 66, 80, 81, 96, 97,
                                        112, 113, 128, 144, 160, 176, 192, 208, 224, 240, 0, 0, 0, 0, 0, 0, 0, 0, 0, 0, 0, 0, 0, 0};
__device__ __forceinline__ unsigned rt_mono(float f) { const unsigned u = __builtin_bit_cast(unsigned, f); return u ^ ((unsigned)((int)u >> 31) | 0x80000000u); }
__device__ __forceinline__ float rt_unmono(unsigned m) { const unsigned u = (m & 0x80000000u) ? (m ^ 0x80000000u) : ~m; return __builtin_bit_cast(float, u); }
#define RT_CE_DESC(a, b) { const unsigned x_ = (a), y_ = (b); (a) = x_ > y_ ? x_ : y_; (b) = x_ > y_ ? y_ : x_; }
#define RT_CE_ASC(a, b) { const unsigned x_ = (a), y_ = (b); (a) = x_ > y_ ? y_ : x_; (b) = x_ > y_ ? x_ : y_; }
__device__ __forceinline__ void rt_sort16(unsigned (&v)[16]) {
#pragma unroll
    for (int k = 2; k <= 16; k <<= 1)
#pragma unroll
        for (int j = k >> 1; j > 0; j >>= 1)
#pragma unroll
            for (int i = 0; i < 16; ++i) { const int l = i ^ j; if (l > i) { if ((i & k) == 0) RT_CE_DESC(v[i], v[l]) else RT_CE_ASC(v[i], v[l]) } }
}
__device__ __forceinline__ void rt_merge16(unsigned (&v)[16]) {
#pragma unroll
    for (int j = 8; j > 0; j >>= 1)
#pragma unroll
        for (int i = 0; i < 16; ++i) { const int l = i ^ j; if (l > i) RT_CE_DESC(v[i], v[l]) }
}
__device__ __forceinline__ void rt_top16(unsigned (&a)[16], const unsigned (&b)[16]) {
#pragma unroll
    for (int i = 0; i < 16; ++i) a[i] = a[i] > b[15 - i] ? a[i] : b[15 - i];
    rt_merge16(a);
}
__device__ __forceinline__ void rt_top16_partner(unsigned (&a)[16]) {
    unsigned b[16];
#pragma unroll
    for (int i = 0; i < 16; ++i) b[i] = (unsigned)__shfl_xor((int)a[i], 32);
    rt_top16(a, b);
}
__device__ __forceinline__ void rt_scores_top16(LAS unsigned char* kimg, const bf16* __restrict__ qp, int r, int h, unsigned (&k0)[16]) {
    f32x16 acc[4];
#pragma unroll
    for (int kt = 0; kt < 4; ++kt)
#pragma unroll
        for (int i = 0; i < 16; ++i) acc[kt][i] = 0.f;
#pragma unroll
    for (int ks = 0; ks < 8; ++ks) {
        const s16x8 qf = *(const s16x8*)(qp + 16 * ks);
#pragma unroll
        for (int kt = 0; kt < 4; ++kt) {
            const s16x8 kf = *(const LAS s16x8*)(kimg + (32 * kt + r) * RT_RS + (16 * ks + 8 * h) * 2);
            acc[kt] = __builtin_amdgcn_mfma_f32_32x32x16_bf16(kf, qf, acc[kt], 0, 0, 0);
        }
    }
    unsigned k1[16], k2[16], k3[16];
#pragma unroll
    for (int reg = 0; reg < 16; ++reg) {
        const unsigned ki = (unsigned)((reg & 3) + 8 * (reg >> 2) + 4 * h);
        k0[reg] = (rt_mono(acc[0][reg]) & 0xFFFFFF80u) | ki;
        k1[reg] = (rt_mono(acc[1][reg]) & 0xFFFFFF80u) | (ki + 32u);
        k2[reg] = (rt_mono(acc[2][reg]) & 0xFFFFFF80u) | (ki + 64u);
        k3[reg] = (rt_mono(acc[3][reg]) & 0xFFFFFF80u) | (ki + 96u);
    }
    rt_sort16(k0); rt_sort16(k1); rt_sort16(k2); rt_sort16(k3);
    rt_top16(k0, k1); rt_top16(k2, k3); rt_top16(k0, k2);
    rt_top16_partner(k0);
}
__device__ __forceinline__ void ph_peer_route2(LAS unsigned char* ldsb, const bf16* __restrict__ qhb, const float* __restrict__ keys1, const float* __restrict__ keys2,
                                               int* __restrict__ eidx, float* __restrict__ gate, const float* __restrict__ ck, const float* __restrict__ cv, float* __restrict__ out) {
    const int tid = threadIdx.x, w = __builtin_amdgcn_readfirstlane(tid >> 6), lane = tid & 63, r = lane & 31, h = lane >> 5;
    __syncthreads();
    for (int idx = tid; idx < 2 * 128 * 16; idx += NTHR) {
        const int tb = idx >> 11, rem = idx & 2047, row = rem >> 4, ch = rem & 15;
        const float* sp = (tb ? keys2 : keys1) + row * 128 + ch * 8;
        const float4 a = *(const float4*)sp, b = *(const float4*)(sp + 4);
        v4u o; o.x = pk2(a.x, a.y); o.y = pk2(a.z, a.w); o.z = pk2(b.x, b.y); o.w = pk2(b.z, b.w);
        *(LAS v4u*)(ldsb + tb * RT_KIMG + row * RT_RS + ch * 16) = o;
    }
    __syncthreads();
    LAS unsigned* lut = (LAS unsigned*)(ldsb + RT_LUT) + w * 512;
    for (int k = 0;; ++k) {
        int unit;
        if (gridDim.x != 256) { unit = blockIdx.x * NWAVE + w + k * (int)(gridDim.x * NWAVE); if (unit >= (T_ALL / 32) * 8) break; }
        else if (k < 2) unit = k * 2048 + blockIdx.x * NWAVE + w;
        else if (k == 2 && w == 0 && blockIdx.x < 128) unit = 4096 + (int)blockIdx.x;
        else break;
        const int tt = unit >> 3, hd = unit & 7;
        const int tok = 32 * tt + r;
        const bf16* qp = qhb + (size_t)tok * 2048 + hd * 256 + 8 * h;
        unsigned ka[16], kb[16];
        rt_scores_top16(ldsb, qp, r, h, ka);
        rt_scores_top16(ldsb + RT_KIMG, qp + 128, r, h, kb);
        float v1[16], v2[16];
#pragma unroll
        for (int i = 0; i < 16; ++i) { v1[i] = rt_unmono(ka[i] & 0xFFFFFF80u); v2[i] = rt_unmono(kb[i] & 0xFFFFFF80u); }
#pragma unroll
        for (int wd = 0; wd < 4; ++wd) {
            lut[wd * 64 + lane] = (ka[4 * wd] & 0x7Fu) | ((ka[4 * wd + 1] & 0x7Fu) << 8) | ((ka[4 * wd + 2] & 0x7Fu) << 16) | ((ka[4 * wd + 3] & 0x7Fu) << 24);
            lut[(4 + wd) * 64 + lane] = (kb[4 * wd] & 0x7Fu) | ((kb[4 * wd + 1] & 0x7Fu) << 8) | ((kb[4 * wd + 2] & 0x7Fu) << 16) | ((kb[4 * wd + 3] & 0x7Fu) << 24);
        }
        unsigned c0[16], c1[16];
        c0[0] = (rt_mono(h ? (v1[0] + v2[1]) : (v1[0] + v2[0])) & 0xFFFFFF00u) | (h ? 1u : 0u);
        c0[1] = (rt_mono(h ? (v1[0] + v2[3]) : (v1[0] + v2[2])) & 0xFFFFFF00u) | (h ? 3u : 2u);
        c0[2] = (rt_mono(h ? (v1[0] + v2[5]) : (v1[0] + v2[4])) & 0xFFFFFF00u) | (h ? 5u : 4u);
        c0[3] = (rt_mono(h ? (v1[0] + v2[7]) : (v1[0] + v2[6])) & 0xFFFFFF00u) | (h ? 7u : 6u);
        c0[4] = (rt_mono(h ? (v1[0] + v2[9]) : (v1[0] + v2[8])) & 0xFFFFFF00u) | (h ? 9u : 8u);
        c0[5] = (rt_mono(h ? (v1[0] + v2[11]) : (v1[0] + v2[10])) & 0xFFFFFF00u) | (h ? 11u : 10u);
        c0[6] = (rt_mono(h ? (v1[0] + v2[13]) : (v1[0] + v2[12])) & 0xFFFFFF00u) | (h ? 13u : 12u);
        c0[7] = (rt_mono(h ? (v1[0] + v2[15]) : (v1[0] + v2[14])) & 0xFFFFFF00u) | (h ? 15u : 14u);
        c0[8] = (rt_mono(h ? (v1[1] + v2[1]) : (v1[1] + v2[0])) & 0xFFFFFF00u) | (h ? 17u : 16u);
        c0[9] = (rt_mono(h ? (v1[1] + v2[3]) : (v1[1] + v2[2])) & 0xFFFFFF00u) | (h ? 19u : 18u);
        c0[10] = (rt_mono(h ? (v1[1] + v2[5]) : (v1[1] + v2[4])) & 0xFFFFFF00u) | (h ? 21u : 20u);
        c0[11] = (rt_mono(h ? (v1[1] + v2[7]) : (v1[1] + v2[6])) & 0xFFFFFF00u) | (h ? 23u : 22u);
        c0[12] = (rt_mono(h ? (v1[2] + v2[1]) : (v1[2] + v2[0])) & 0xFFFFFF00u) | (h ? 33u : 32u);
        c0[13] = (rt_mono(h ? (v1[2] + v2[3]) : (v1[2] + v2[2])) & 0xFFFFFF00u) | (h ? 35u : 34u);
        c0[14] = (rt_mono(h ? (v1[3] + v2[0]) : (v1[2] + v2[4])) & 0xFFFFFF00u) | (h ? 48u : 36u);
        c0[15] = (rt_mono(h ? (v1[3] + v2[2]) : (v1[3] + v2[1])) & 0xFFFFFF00u) | (h ? 50u : 49u);
        c1[0] = (rt_mono(h ? (v1[4] + v2[0]) : (v1[3] + v2[3])) & 0xFFFFFF00u) | (h ? 64u : 51u);
        c1[1] = (rt_mono(h ? (v1[4] + v2[2]) : (v1[4] + v2[1])) & 0xFFFFFF00u) | (h ? 66u : 65u);
        c1[2] = (rt_mono(h ? (v1[5] + v2[1]) : (v1[5] + v2[0])) & 0xFFFFFF00u) | (h ? 81u : 80u);
        c1[3] = (rt_mono(h ? (v1[6] + v2[1]) : (v1[6] + v2[0])) & 0xFFFFFF00u) | (h ? 97u : 96u);
        c1[4] = (rt_mono(h ? (v1[7] + v2[1]) : (v1[7] + v2[0])) & 0xFFFFFF00u) | (h ? 113u : 112u);
        c1[5] = (rt_mono(h ? (v1[9] + v2[0]) : (v1[8] + v2[0])) & 0xFFFFFF00u) | (h ? 144u : 128u);
        c1[6] = (rt_mono(h ? (v1[11] + v2[0]) : (v1[10] + v2[0])) & 0xFFFFFF00u) | (h ? 176u : 160u);
        c1[7] = (rt_mono(h ? (v1[13] + v2[0]) : (v1[12] + v2[0])) & 0xFFFFFF00u) | (h ? 208u : 192u);
        c1[8] = (rt_mono(h ? (v1[15] + v2[0]) : (v1[14] + v2[0])) & 0xFFFFFF00u) | (h ? 240u : 224u);
        c1[9] = 0u;
        c1[10] = 0u;
        c1[11] = 0u;
        c1[12] = 0u;
        c1[13] = 0u;
        c1[14] = 0u;
        c1[15] = 0u;
        rt_sort16(c0); rt_sort16(c1); rt_top16(c0, c1); rt_top16_partner(c0);
        float e[16]; float sum = 0.f;
        const float mx = rt_unmono(c0[0] & 0xFFFFFF00u);
#pragma unroll
        for (int k = 0; k < 16; ++k) { e[k] = __expf(rt_unmono(c0[k] & 0xFFFFFF00u) - mx); sum += e[k]; }
        const float inv = 1.0f / sum;
        asm volatile("s_waitcnt lgkmcnt(0)" ::: "memory");
        int ex[8]; float gv[8];
#pragma unroll
        for (int k = 0; k < 8; ++k) {
            const unsigned hm = (unsigned)(-h);
            const unsigned ck = (c0[k] & ~hm) | (c0[8 + k] & hm);
            const float ek = __builtin_bit_cast(float, (__builtin_bit_cast(unsigned, e[k]) & ~hm) | (__builtin_bit_cast(unsigned, e[8 + k]) & hm));
            const unsigned ci = (ck >> 4) & 15u, cj = ck & 15u;
            const unsigned w1 = lut[(ci >> 2) * 64 + lane], w2 = lut[(4 + (cj >> 2)) * 64 + lane];
            const unsigned i1 = (w1 >> (8 * (ci & 3))) & 0x7Fu, i2 = (w2 >> (8 * (cj & 3))) & 0x7Fu;
            ex[k] = (int)(i1 * PEER_NKEYS + i2); gv[k] = ek * inv;
        }
        int* ep = eidx + (size_t)tok * 128 + hd * 16 + 8 * h; float* gp = gate + (size_t)tok * 128 + hd * 16 + 8 * h;
#pragma unroll
        for (int k = 0; k < 8; ++k) ex[k] = (int)(((__builtin_bit_cast(unsigned, gv[k]) + 0x2000u) & 0xFFFFC000u) | (unsigned)ex[k]);
        *(int4*)ep = make_int4(ex[0], ex[1], ex[2], ex[3]); *(int4*)(ep + 4) = make_int4(ex[4], ex[5], ex[6], ex[7]);
        (void)gp;
    }
    if (gridDim.x == 256 && (w != 0 || blockIdx.x >= 128)) {
        const unsigned si = blockIdx.x < 128 ? blockIdx.x * 7u + (unsigned)(w - 1) : 896u + (blockIdx.x - 128u) * 8u + (unsigned)w;
        cache_copy_slice(ck, cv, out, 7040u + si, (unsigned)lane);
    }
}

struct Params {
    const float* in[23];
    float* out;
    unsigned char* ws;
    unsigned* bar;
};

#define WS_BAR      0ull
#define WS_XALL     (1ull << 20)
#define WS_PROJ     (WS_XALL + (size_t)T_ALL * D_MODEL * 4)
#define WS_XBC      (WS_PROJ + (size_t)T_ALL * PROJ_LD * 4)
#define WS_DT       (WS_XBC + (size_t)T_ALL * CONV_DIM * 4)
#define WS_QROT     (WS_DT + (size_t)T_ALL * SSD_HEADS * 4)
#define WS_KROT     (WS_QROT + (size_t)T_ALL * ATT_WIDTH * 4)
#define WS_YBUF     (WS_KROT + (size_t)T_ALL * ATT_WIDTH * 4)
#define WS_MIX      (WS_YBUF + (size_t)T_ALL * MIX_WIDTH * 4)
#define WS_HBUF     (WS_MIX + (size_t)T_ALL * D_MODEL * 4)
#define WS_QH       (WS_HBUF + (size_t)T_ALL * D_MODEL * 4)
#define WS_EIDX     (WS_QH + (size_t)T_ALL * 2048 * 4)
#define WS_GATE     (WS_EIDX + (size_t)T_ALL * 128 * 4)
#define WS_A0       (WS_GATE + (size_t)T_ALL * 128 * 4)
#define WS_A1       (WS_A0 + (size_t)T_ALL * D_MODEL * 2)
#define WS_A2       (WS_A1 + (size_t)T_ALL * MIX_WIDTH * 2)
#define WS_WTIN     (WS_A2 + (size_t)T_ALL * D_MODEL * 2)
#define WS_WTOUT    (WS_WTIN + (size_t)PROJ_LD * D_MODEL * 2)
#define WS_WTQ      (WS_WTOUT + (size_t)D_MODEL * MIX_WIDTH * 2)
#define WS_PROJB    (WS_WTQ + (size_t)2048 * D_MODEL * 2)
#define WS_DTRAW    (WS_PROJB + (size_t)T_ALL * NB_LD * 2)
#define WS_XBCB     (WS_DTRAW + (size_t)T_ALL * 32 * 4)
#define WS_QROTB    (WS_XBCB + (size_t)T_ALL * CONV_DIM * 2)
#define WS_KROTB    (WS_QROTB + (size_t)T_ALL * ATT_WIDTH * 2)
#define WS_UB       (WS_KROTB + (size_t)T_ALL * ATT_WIDTH * 2)
#define WS_VB       (WS_UB + (size_t)16384 * D_MODEL * 2)
#define WS_USC      (WS_VB + (size_t)16384 * D_MODEL * 2)
#define WS_VSC      (WS_USC + 16384 * 4)
#define WS_SBUF     (WS_VSC + 16384 * 4)
#define WS_HIN      (WS_SBUF + (size_t)BATCH * 64 * SSD_HEADS * 64 * 128 * 2)
#define WS_CDEC     (WS_HIN + (size_t)BATCH * 64 * SSD_HEADS * 64 * 128 * 2)
#define WS_OBUF     (WS_CDEC + (size_t)BATCH * 64 * SSD_HEADS * 4)
#define WS_LSE      (WS_OBUF + (size_t)3 * T_PROMPT * ATT_WIDTH * 2)
#define WS_ROPE     (WS_LSE + (size_t)3 * T_PROMPT * 8 * 4)
#define WS_END      (WS_ROPE + (size_t)SEQ * 64 * 4)

#define LDS_BYTES (160 * 1024)

#define KP const __attribute__((address_space(4))) Params* kp = (const __attribute__((address_space(4))) Params*)__builtin_amdgcn_kernarg_segment_ptr(); asm volatile("" : "+s"(kp)); unsigned char* ws = kp->ws; (void)ws;
#define IN(i) (kp->in[i])
#define WSP(T, off) ((T*)(ws + (off)))
__global__ void __launch_bounds__(512, 2) mega_fwd(Params p) {
    extern __shared__ __attribute__((aligned(16))) unsigned char smem[];
    if (threadIdx.x == 0) *(uint4*)smem = make_uint4(0u, 0u, 0u, 0u);
    __syncthreads();
    XcdBarrier bar = xcd_barrier_post(p.bar, (volatile LAS unsigned*)smem);
    float* lds = (float*)(smem + 256);
    LAS unsigned char* ldsb = (LAS unsigned char*)smem + 256;

    { KP ph_prologue(ldsb, IN(0), IN(1), WSP(bf16, WS_A0), IN(6), WSP(bf16, WS_WTIN), WSP(float, WS_ROPE)); }
    xcd_barrier(bar);
    { KP pg8::Gemm g{WSP(bf16, WS_A0), WSP(bf16, WS_WTIN), T_ALL, PROJ_LD, D_MODEL}; pg8::StaticOrder S; S.init(g.M, g.N, (int)gridDim.x, (int)blockIdx.x);
      pg8::EpiProj E{WSP(bf16, WS_PROJB), WSP(float, WS_DTRAW)}; pg8::gemm_phase<pg8::EpiProj, pg8::StaticOrder, false>(ldsb, g, S, E, nullptr); }
    xcd_barrier(bar);
    { KP ph_post_proj_prompt(WSP(bf16, WS_PROJB), WSP(float, WS_DTRAW), IN(7), IN(8), IN(9), WSP(float, WS_ROPE), WSP(bf16, WS_XBCB), WSP(float, WS_DT), WSP(bf16, WS_QROTB), WSP(bf16, WS_KROTB), kp->out); }
    { KP ph_post_proj2(WSP(bf16, WS_PROJB), WSP(float, WS_DTRAW), IN(4), IN(7), IN(8), IN(9), WSP(bf16, WS_XBCB), WSP(float, WS_DT), WSP(bf16, WS_QROTB), WSP(bf16, WS_KROTB), kp->out); }
    xcd_barrier(bar);
    { KP ph_ssd_states(ldsb, WSP(bf16, WS_XBCB), WSP(float, WS_DT), IN(10), WSP(bf16, WS_SBUF), WSP(float, WS_CDEC), IN(2), IN(3), kp->out); }
    __syncthreads();
    { KP ph_attn_prompt(ldsb, WSP(bf16, WS_QROTB), WSP(bf16, WS_KROTB), WSP(bf16, WS_PROJB), WSP(bf16, WS_OBUF), WSP(float, WS_LSE), IN(2), IN(3), kp->out); }
    __syncthreads();
    { KP ph_ssd_decode(WSP(bf16, WS_XBCB), WSP(float, WS_DT), IN(10), IN(11), IN(5), WSP(float, WS_YBUF), kp->out); }
    { KP ph_attn_sample3(lds, WSP(bf16, WS_QROTB), WSP(bf16, WS_KROTB), WSP(bf16, WS_PROJB), IN(2), IN(3), WSP(bf16, WS_A1)); }
    xcd_barrier(bar);
    if ((int)gridDim.x > 128) {
        if ((int)blockIdx.x < 96) {
            { KP ph_ssd_scan(WSP(bf16, WS_SBUF), WSP(float, WS_CDEC), WSP(bf16, WS_HIN), kp->out, (int)blockIdx.x, 96); }
            { KP ph_quant_tables(IN(19), IN(20), WSP(unsigned char, WS_UB), WSP(unsigned char, WS_VB), WSP(float, WS_USC), WSP(float, WS_VSC), (int)blockIdx.x, 96, 0, QSPLIT); }
        } else {
            { KP ph_prologue2(ldsb, IN(13), WSP(bf16, WS_WTOUT), IN(16), WSP(bf16, WS_WTQ), (int)blockIdx.x - 96, (int)gridDim.x - 96); }
            { KP ph_quant_tables(IN(19), IN(20), WSP(unsigned char, WS_UB), WSP(unsigned char, WS_VB), WSP(float, WS_USC), WSP(float, WS_VSC), (int)blockIdx.x - 96, (int)gridDim.x - 96, QSPLIT, 2 * 16384); }
        }
    } else {
        { KP ph_ssd_scan(WSP(bf16, WS_SBUF), WSP(float, WS_CDEC), WSP(bf16, WS_HIN), kp->out, (int)blockIdx.x, (int)gridDim.x); }
        { KP ph_prologue2(ldsb, IN(13), WSP(bf16, WS_WTOUT), IN(16), WSP(bf16, WS_WTQ), (int)blockIdx.x, (int)gridDim.x); }
        { KP ph_quant_tables(IN(19), IN(20), WSP(unsigned char, WS_UB), WSP(unsigned char, WS_VB), WSP(float, WS_USC), WSP(float, WS_VSC), (int)blockIdx.x, (int)gridDim.x); }
    }
    xcd_barrier(bar);
    { KP ph_ssd_out(ldsb, WSP(bf16, WS_XBCB), WSP(bf16, WS_PROJB), WSP(float, WS_DT), IN(10), IN(11), IN(12), WSP(bf16, WS_HIN), WSP(bf16, WS_A1)); }
    { KP ph_attn_combine(WSP(bf16, WS_OBUF), WSP(float, WS_LSE), WSP(bf16, WS_A1)); }
    { KP ph_gate_norm(WSP(bf16, WS_PROJB), IN(12), WSP(float, WS_YBUF), WSP(bf16, WS_A1)); }
    xcd_barrier(bar);
    { KP pg8::Gemm g{WSP(bf16, WS_A1), WSP(bf16, WS_WTOUT), T_ALL, D_MODEL, MIX_WIDTH}; pg8::StaticOrder S; S.init(g.M, g.N, (int)gridDim.x, (int)blockIdx.x);
      pg8::EpiBf16Plain E{WSP(bf16, WS_MIX), D_MODEL}; pg8::gemm_phase<pg8::EpiBf16Plain, pg8::StaticOrder, false>(ldsb, g, S, E, nullptr); }
    if (blockIdx.x >= 8 && gridDim.x == 256) { KP cache_copy_slice(IN(2), IN(3), kp->out, 4096u + (blockIdx.x - 8) * 8u + (threadIdx.x >> 6), threadIdx.x & 63u); }
    xcd_barrier(bar);
    { KP ph_ln_res(WSP(bf16, WS_A0), WSP(bf16, WS_MIX), IN(14), IN(15), WSP(bf16, WS_A2)); }
    xcd_barrier(bar);
    { KP pg8::Gemm g{WSP(bf16, WS_A2), WSP(bf16, WS_WTQ), T_ALL, 2048, D_MODEL}; pg8::StaticOrder S; S.init(g.M, g.N, (int)gridDim.x, (int)blockIdx.x);
      pg8::EpiBf16Plain E{WSP(bf16, WS_QH), 2048}; pg8::gemm_phase<pg8::EpiBf16Plain, pg8::StaticOrder, false>(ldsb, g, S, E, nullptr); }
    if (blockIdx.x >= 16 && gridDim.x == 256 && threadIdx.x < 256) { KP cache_copy_slice(IN(2), IN(3), kp->out, 4096u + 1984u + (blockIdx.x - 16) * 4u + (threadIdx.x >> 6), threadIdx.x & 63u); }
    xcd_barrier(bar);
    { KP ph_peer_route2(ldsb, WSP(bf16, WS_QH), IN(17), IN(18), WSP(int, WS_EIDX), WSP(float, WS_GATE), IN(2), IN(3), kp->out); }
    xcd_barrier(bar);
    { KP ph_peer_ffn3(WSP(bf16, WS_A2), WSP(int, WS_EIDX), WSP(float, WS_GATE), WSP(unsigned char, WS_UB), WSP(unsigned char, WS_VB), WSP(float, WS_USC), WSP(float, WS_VSC), IN(21), IN(22), kp->out, IN(2), IN(3), gridDim.x == 256 ? 8960u : 4096u); }
}

extern "C" void kernel_launch(void* const* d_in, const int* in_sizes, int n_in, void* d_out, int out_size, void* d_ws, size_t ws_size, hipStream_t stream) {
    static int grid = 0;
    if (grid == 0) {
        int dev = 0, cus = 0, per_cu = 0;
        if (hipGetDevice(&dev) != hipSuccess || hipDeviceGetAttribute(&cus, hipDeviceAttributeMultiprocessorCount, dev) != hipSuccess) { fprintf(stderr, "kernel_launch: device query failed\n"); grid = -1; return; }
        if (hipFuncSetAttribute((const void*)mega_fwd, hipFuncAttributeMaxDynamicSharedMemorySize, LDS_BYTES) != hipSuccess) { fprintf(stderr, "kernel_launch: hipFuncSetAttribute failed\n"); grid = -1; return; }
        if (hipOccupancyMaxActiveBlocksPerMultiprocessor(&per_cu, (const void*)mega_fwd, NTHR, LDS_BYTES) != hipSuccess || per_cu < 1) { fprintf(stderr, "kernel_launch: occupancy query says %d\n", per_cu); }
        (void)hipGetLastError();
        grid = cus;
        if (ws_size < WS_END) { fprintf(stderr, "kernel_launch: workspace too small\n"); grid = -1; return; }
    }
    if (grid < 0) return;
    (void)hipMemsetAsync((char*)d_ws + WS_BAR, 0, XCD_BAR_WORDS * sizeof(unsigned), stream);
    Params p{};
    for (int i = 0; i < 23; ++i) p.in[i] = (const float*)d_in[i];
    p.out = (float*)d_out; p.ws = (unsigned char*)d_ws; p.bar = (unsigned*)((char*)d_ws + WS_BAR);
    hipLaunchKernelGGL(mega_fwd, dim3(grid), dim3(NTHR), LDS_BYTES, stream, p);
}
```

```cpp
#include <hip/hip_runtime.h>
#include <stdint.h>

#define D_MODEL 1024
#define BATCH 2
#define SEQ 8192
#define DEC_BATCH 128
#define DEC_SEQ 4
#define PAST_LEN 8192
#define HEAD_DIM 64
#define ATT_WIDTH 512
#define ATT_HEADS 8
#define SSD_WIDTH 1536
#define SSD_HEADS 24
#define SSD_GROUPS 4
#define SSD_STATE 128
#define CONV_DIM 2560
#define IN_WIDTH 5656
#define PROJ_LD 5888
#define MIX_WIDTH 2048
#define WBUF 2048
#define PEER_NKEYS 128
#define PEER_HEADS 8
#define PEER_TOPK 16
#define PEER_DKEY 256
#define T_PROMPT (BATCH * SEQ)
#define T_SAMPLE (DEC_BATCH * DEC_SEQ)
#define T_ALL (T_PROMPT + T_SAMPLE)
#define O_Z 0
#define O_XBC 1536
#define O_DT 4096
#define O_Q 4120
#define O_K 4632
#define O_V 5144
#define ALPHA_F 1.189207115002721f
#define LN_EPS 1e-5f

#define OUT_YP 0ull
#define OUT_YS (OUT_YP + 16777216ull)
#define OUT_PK (OUT_YS + 524288ull)
#define OUT_PV (OUT_PK + 2097152ull)
#define OUT_PC (OUT_PV + 2097152ull)
#define OUT_PS (OUT_PC + 15360ull)
#define OUT_SK (OUT_PS + 393216ull)
#define OUT_SV (OUT_SK + 134217728ull)
#define OUT_SC (OUT_SV + 134217728ull)
#define OUT_SS (OUT_SC + 983040ull)

__constant__ double ROPE_INV_REV[32] = {
    1.59154943091895346e-01, 1.19349370211248862e-01, 8.94994016088910133e-02, 6.71150830052272551e-02,
    5.03292121044870353e-02, 3.77415847174197711e-02, 2.83021958306233987e-02, 2.12236527647776604e-02,
    1.59154943091895339e-02, 1.19349370211248862e-02, 8.94994016088910237e-03, 6.71150830052272534e-03,
    5.03292121044870370e-03, 3.77415847174197719e-03, 2.83021958306233987e-03, 2.12236527647776622e-03,
    1.59154943091895356e-03, 1.19349370211248849e-03, 8.94994016088910237e-04, 6.71150830052272599e-04,
    5.03292121044870326e-04, 3.77415847174197741e-04, 2.83021958306233954e-04, 2.12236527647776605e-04,
    1.59154943091895351e-04, 1.19349370211248862e-04, 8.94994016088910182e-05, 6.71150830052272545e-05,
    5.03292121044870354e-05, 3.77415847174197768e-05, 2.83021958306233961e-05, 2.12236527647776592e-05
};

__device__ __forceinline__ float silu_f(float x) { return x * __builtin_amdgcn_rcpf(1.0f + __expf(-x)); }
__device__ __forceinline__ float softplus_f(float x) { return fmaxf(x, 0.f) + log1pf(__expf(-fabsf(x))); }
__device__ __forceinline__ float gelu_f(float x) { return 0.5f * x * (1.0f + erff(x * 0.70710678118654752f)); }
__device__ __forceinline__ float wave_sum(float v) {
#pragma unroll
    for (int o = 32; o > 0; o >>= 1) v += __shfl_xor(v, o);
    return v;
}
__device__ __forceinline__ float wave_max(float v) {
#pragma unroll
    for (int o = 32; o > 0; o >>= 1) v = fmaxf(v, __shfl_xor(v, o));
    return v;
}

#include <cstdio>
#define XB_TMO      128
#define XB_XCNT(j)  (256  + 64 * (j))
#define XB_XSUB(j)  (1280 + 64 * (j))
#define XB_XGEN(j)  (2304 + 64 * (j))
#define XB_TOP      3328
#define XB_TOPGEN   3392
#define XCD_BAR_WORDS 3456
#define XB_SPIN_CAP (1u << 18)
#define LAS __attribute__((address_space(3)))

__device__ __forceinline__ unsigned xb_ld(unsigned* p)              { return __hip_atomic_load(p, __ATOMIC_RELAXED, __HIP_MEMORY_SCOPE_AGENT); }
__device__ __forceinline__ unsigned xb_add(unsigned* p, unsigned v) { return __hip_atomic_fetch_add(p, v, __ATOMIC_RELAXED, __HIP_MEMORY_SCOPE_AGENT); }
__device__ __forceinline__ unsigned xb_xcc_id() { return (unsigned)__builtin_amdgcn_s_getreg((3 << 11) | 20) & 0xFu; }
#define XB_SPIN(cond, bar) do { unsigned _sp = 0; while (cond) { __builtin_amdgcn_s_sleep(1); \
    if ((++_sp & 255u) == 0u) { if (xb_ld(&(bar)[XB_TMO])) break; if (_sp > XB_SPIN_CAP) { atomicAdd(&(bar)[XB_TMO], 1u); break; } } } } while (0)

struct XcdBarrier {
    unsigned* bar; unsigned x;
    volatile LAS unsigned* st;
};

__device__ __forceinline__ XcdBarrier xcd_barrier_post(unsigned* bar, volatile LAS unsigned* st) {
    XcdBarrier b; b.bar = bar; b.x = xb_xcc_id(); b.st = st;
    if (threadIdx.x == 0) (void)xb_add(&bar[XB_XCNT(b.x)], 1u);
    return b;
}
__device__ __forceinline__ void xcd_barrier_complete(unsigned* bar, unsigned x, unsigned& nloc, unsigned& nx) {
    const unsigned G = gridDim.x * gridDim.y * gridDim.z;
    unsigned sum, cnt, mine, sp = 0u;
    for (;;) {
        sum = 0u; cnt = 0u; mine = 0u;
#pragma unroll
        for (unsigned j = 0; j < 16; ++j) { const unsigned c = xb_ld(&bar[XB_XCNT(j)]); sum += c; cnt += (c > 0u) ? 1u : 0u; mine = (j == x) ? c : mine; }
        if (sum == G) break;
        __builtin_amdgcn_s_sleep(1);
        if ((++sp & 255u) == 0u) { if (xb_ld(&bar[XB_TMO])) break; if (sp > XB_SPIN_CAP) { atomicAdd(&bar[XB_TMO], 1u); break; } }
    }
    nloc = mine > 0u ? mine : 1u; nx = cnt > 0u ? cnt : 1u;
}

__device__ __forceinline__ void xcd_barrier(const XcdBarrier& b) {
    asm volatile("s_waitcnt vmcnt(0)" ::: "memory");
    __syncthreads();
    if (threadIdx.x == 0) {
        unsigned* bar = b.bar;
        __builtin_amdgcn_s_waitcnt(0);
        unsigned nloc = b.st[0], nx = b.st[1];
        if (nloc == 0u) { xcd_barrier_complete(bar, b.x, nloc, nx); b.st[0] = nloc; b.st[1] = nx; }
        const unsigned old = xb_add(&bar[XB_XSUB(b.x)], 1u);
        const unsigned gen = old / nloc;
        if (old + 1u == (gen + 1u) * nloc) {
            __builtin_amdgcn_fence(__ATOMIC_RELEASE, "agent");
            asm volatile("s_waitcnt vmcnt(0)" ::: "memory");
            const unsigned og = xb_add(&bar[XB_TOP], 1u);
            const unsigned tg = og / nx;
            if (og + 1u == (tg + 1u) * nx) xb_add(&bar[XB_TOPGEN], 1u);
            else XB_SPIN(xb_ld(&bar[XB_TOPGEN]) == tg, bar);
            __builtin_amdgcn_fence(__ATOMIC_ACQUIRE, "agent");
            xb_add(&bar[XB_XGEN(b.x)], 1u);
            asm volatile("s_waitcnt vmcnt(0)" ::: "memory");
        } else {
            XB_SPIN(xb_ld(&bar[XB_XGEN(b.x)]) == gen, bar);
            __builtin_amdgcn_fence(__ATOMIC_ACQUIRE, "agent");
            asm volatile("s_waitcnt vmcnt(0)" ::: "memory");
        }
    }
    __syncthreads();
}


#define GAS __attribute__((address_space(1)))
typedef unsigned short bf16;
typedef unsigned v4u __attribute__((ext_vector_type(4)));
#define LDS_WAIT() asm volatile("s_waitcnt lgkmcnt(0)" ::: "memory")
__device__ __forceinline__ unsigned f2bf(float f) { unsigned u = __builtin_bit_cast(unsigned, f); return (u + 0x7fffu + ((u >> 16) & 1u)) >> 16; }
__device__ __forceinline__ unsigned pk2(float lo, float hi) { return f2bf(lo) | (f2bf(hi) << 16); }
__device__ __forceinline__ float bf2f(unsigned short b) { return __builtin_bit_cast(float, (unsigned)b << 16); }
#include <hip/hip_runtime.h>
namespace pg8 {
#define PG8_LAS __attribute__((address_space(3)))
typedef unsigned short bf16_t;
typedef short bf16x8 __attribute__((ext_vector_type(8)));
typedef float f32x4 __attribute__((ext_vector_type(4)));
typedef unsigned u32x4 __attribute__((ext_vector_type(4)));
constexpr int BM = 256, BK = 64, HALF = 128, HTB = HALF * BK * 2  , STAGE_BYTES = 8 * HTB, NXCD = 8, WGM = 8;

__host__ __device__ __forceinline__ int lds_byte(int r, int c) { const int st = (r >> 4) * 2 + (c >> 5), rr = r & 15, cc = c & 31, ob = rr * 64 + cc * 2; return st * 1024 + (ob ^ (((ob >> 9) & 1) << 5)); }
__host__ __device__ __forceinline__ void stage_rc(int b, int& R, int& C) { const int st = b / 1024, sb = b % 1024, swz = sb ^ (((sb >> 9) & 1) << 5); R = (st >> 1) * 16 + swz / 64; C = (st & 1) * 32 + (swz % 64) / 2; }
__host__ __device__ __forceinline__ int perm32(int rho) { const int n = rho >> 4, i = rho & 15; return 8 * (i >> 2) + 4 * n + (i & 3); }

struct Unit { int pm, pn; };
struct Gemm { const bf16_t* A; const bf16_t* Bt; int M, N, K; };

struct StaticOrder {
    int nM, nN, nwg, G, c;
    __host__ __device__ void init(int M, int N, int G_, int c_) { nM = M / BM; nN = N / BM; nwg = nM * nN; G = G_; c = c_; }
    __host__ __device__ bool next(int i, Unit& u) const {
        const long L = (long)i * G + c; if (L >= nwg) return false;
        int wgid = (int)L; { const int q = nwg / NXCD, r = nwg % NXCD, xcd = wgid % NXCD, off = wgid / NXCD; wgid = (xcd < r ? xcd * (q + 1) : r * (q + 1) + (xcd - r) * q) + off; }
        const int nig = WGM * nN, gid = wgid / nig, fm = gid * WGM, gsz = (nM - fm) < WGM ? (nM - fm) : WGM;
        u.pm = fm + ((wgid % nig) % gsz); u.pn = (wgid % nig) / gsz; return true;
    }
    __device__ __forceinline__ void a_ready(const Unit&) const {}
    __device__ __forceinline__ void done(const Unit&) const {}
};
__device__ __forceinline__ unsigned cvt_pk_bf16(float lo, float hi) { unsigned r; asm volatile("v_cvt_pk_bf16_f32 %0, %1, %2" : "=v"(r) : "v"(lo), "v"(hi)); return r; }
typedef float f32x2 __attribute__((ext_vector_type(2)));
__device__ __forceinline__ f32x2 gelu_pk(f32x2 v) {
    const f32x2 av = __builtin_elementwise_abs(v), d = av * 0.2316418882f + 1.0f;
    f32x2 t; t.x = __builtin_amdgcn_rcpf(d.x); t.y = __builtin_amdgcn_rcpf(d.y);
    f32x2 q = t * 0.5307027145f + (-0.7265760135f); q = q * t + 0.7107068705f; q = q * t + (-0.142248368f); q = q * t + 0.127414796f; q = q * t;
    const f32x2 s = (v * v) * (-0.72134752044f);
    f32x2 e; e.x = __builtin_amdgcn_exp2f(s.x); e.y = __builtin_amdgcn_exp2f(s.y);
    const f32x2 m = v * (q * e), r = v - m;
    f32x2 o; o.x = v.x < 0.f ? m.x : r.x; o.y = v.y < 0.f ? m.y : r.y; return o;
}

struct EpiF32 {
    static constexpr bool PERM = false, AFTER_DRAIN = false;
    float* C; int ldc; const float* bias;
    __device__ __forceinline__ void operator()(const f32x4 (&acc)[2][2][4][2], const Unit& u, int wr, int wc, int fr, int fq) const {
        const int row0 = u.pm * BM + wr * 64 + fr, col0 = u.pn * BM + wc * 32 + 4 * fq;
        f32x4 bv[2][2];
#pragma unroll
        for (int bj = 0; bj < 2; ++bj)
#pragma unroll
            for (int n = 0; n < 2; ++n) bv[bj][n] = bias ? *(const f32x4*)(bias + col0 + bj * HALF + n * 16) : (f32x4){0.f, 0.f, 0.f, 0.f};
#pragma unroll
        for (int ai = 0; ai < 2; ++ai)
#pragma unroll
            for (int m = 0; m < 4; ++m) { float* rowp = C + (size_t)(row0 + ai * HALF + m * 16) * ldc + col0;
#pragma unroll
                for (int bj = 0; bj < 2; ++bj)
#pragma unroll
                    for (int n = 0; n < 2; ++n) *(f32x4*)(rowp + bj * HALF + n * 16) = acc[ai][bj][m][n] + bv[bj][n]; }
    }
};

template <class Epi, class Sched, bool STAMP = false>
__device__ __forceinline__ void gemm_phase(PG8_LAS unsigned char* lds, const Gemm g, const Sched& S, const Epi& E, unsigned long long* stamps) {
    int tid = threadIdx.x; asm volatile("" : "+v"(tid));
    const int wid = __builtin_amdgcn_readfirstlane(tid >> 6), lane = tid & 63, wr = wid >> 2, wc = wid & 3, fr = lane & 15, fq = lane >> 4;
    const int K = g.K, nt = K / BK;
    int ts_lo = 0, ts_hi = 0, nts = 0; const unsigned long long rt_entry = STAMP ? (unsigned long long)wall_clock64() : 0ull;
#define PG8_STAMP() do { if (STAMP && wid == 0 && nts < 64) { const unsigned long long _c = (unsigned long long)clock64(); \
        ts_lo = (lane == nts) ? (int)(unsigned)_c : ts_lo; ts_hi = (lane == nts) ? (int)(unsigned)(_c >> 32) : ts_hi; ++nts; } } while (0)
    PG8_STAMP();
    unsigned voffA[2], voffB[2];
#pragma unroll
    for (int i = 0; i < 2; ++i) { int R, C; stage_rc(tid * 16 + i * 8192, R, C); const int Rb = Epi::PERM ? ((R & ~31) + perm32(R & 31)) : R;
        voffA[i] = (unsigned)(R * K + C) * 2u; voffB[i] = (unsigned)(Rb * K + C) * 2u; }
    const size_t kstep = (size_t)(BK * 2);
    const size_t hstep = (size_t)HALF * K * 2;
    const size_t tstep = 2 * hstep;
    const unsigned ldsw = (unsigned)wid * 1024u;
    const int aoff = lds_byte(wr * 64 + fr, fq * 8), boff = lds_byte(wc * 32 + fr, fq * 8);
#define PG8_SA(b, h) (((b) * 2 + (h)) * HTB)
#define PG8_SB(b, h) ((4 + (b) * 2 + (h)) * HTB)
#define PG8_STAGE(bufoff, gbase, voff) do { _Pragma("unroll") for (int _i = 0; _i < 2; ++_i) \
        __builtin_amdgcn_global_load_lds((const unsigned*)((const char*)(gbase) + (voff)[_i]), (PG8_LAS unsigned*)(lds + (bufoff) + ldsw + _i * 8192), 16, 0, 0); } while (0)
#define PG8_LDA(dst, b, h) do { _Pragma("unroll") for (int m = 0; m < 4; ++m) _Pragma("unroll") for (int k = 0; k < 2; ++k) dst[m][k] = *(const PG8_LAS bf16x8*)(lds + PG8_SA(b, h) + aoff + m * 2048 + k * 1024); } while (0)
#define PG8_LDB(dst, b, h) do { _Pragma("unroll") for (int n = 0; n < 2; ++n) _Pragma("unroll") for (int k = 0; k < 2; ++k) dst[n][k] = *(const PG8_LAS bf16x8*)(lds + PG8_SB(b, h) + boff + n * 2048 + k * 1024); } while (0)
#define PG8_MMA(ai, bj, At, Bt) do { __builtin_amdgcn_s_setprio(1); _Pragma("unroll") for (int m = 0; m < 4; ++m) _Pragma("unroll") for (int n = 0; n < 2; ++n) _Pragma("unroll") for (int k = 0; k < 2; ++k) \
        acc[ai][bj][m][n] = __builtin_amdgcn_mfma_f32_16x16x32_bf16(Bt[n][k], At[m][k], acc[ai][bj][m][n], 0, 0, 0); __builtin_amdgcn_s_setprio(0); } while (0)
#define PG8_WAIT_V(n) asm volatile("s_waitcnt vmcnt(" #n ")" ::: "memory")
#define PG8_WAIT_L(n) asm volatile("s_waitcnt lgkmcnt(" #n ")" ::: "memory")
#define PG8_BAR __builtin_amdgcn_s_barrier()
#define PG8_SCHED __builtin_amdgcn_sched_barrier(0)
    Unit cur, nxt; int ui = 0;
    if (!S.next(0, cur)) return;
    f32x4 acc[2][2][4][2];
#pragma unroll
    for (int a = 0; a < 2; ++a)
#pragma unroll
        for (int b = 0; b < 2; ++b)
#pragma unroll
            for (int m = 0; m < 4; ++m)
#pragma unroll
                for (int n = 0; n < 2; ++n) acc[a][b][m][n] = (f32x4){0.f, 0.f, 0.f, 0.f};
    bf16x8 At[4][2], B0[2][2], B1[2][2];
    const char* cA = (const char*)g.A + (size_t)cur.pm * tstep; const char* cB = (const char*)g.Bt + (size_t)cur.pn * tstep;
    S.a_ready(cur);
    PG8_STAGE(PG8_SB(0, 0), cB, voffB); PG8_STAGE(PG8_SA(0, 0), cA, voffA); PG8_STAGE(PG8_SB(0, 1), cB + hstep, voffB); PG8_STAGE(PG8_SA(0, 1), cA + hstep, voffA);
    if (wr == 1) PG8_BAR;
    PG8_WAIT_V(4); PG8_BAR;
    PG8_STAGE(PG8_SB(1, 0), cB + kstep, voffB); PG8_STAGE(PG8_SA(1, 0), cA + kstep, voffA); PG8_STAGE(PG8_SB(1, 1), cB + hstep + kstep, voffB);
    PG8_WAIT_V(6); PG8_BAR;
    PG8_STAMP();
    for (;;) {
        const bool has_next = S.next(ui + 1, nxt);
        const char* nA = has_next ? (const char*)g.A + (size_t)nxt.pm * tstep : cA; const char* nB = has_next ? (const char*)g.Bt + (size_t)nxt.pn * tstep : cB;
        for (int t = 0; t < nt; t += 2) {
            const bool last = (t == nt - 2);
            const char* a1 = cA + (size_t)(t + 1) * kstep;
            const char* a2 = last ? nA : cA + (size_t)(t + 2) * kstep; const char* b2 = last ? nB : cB + (size_t)(t + 2) * kstep;
            const char* a3 = a2 + kstep; const char* b3 = b2 + kstep;
            if (last && has_next) S.a_ready(nxt);
            PG8_LDB(B0, 0, 0); PG8_SCHED; PG8_LDA(At, 0, 0); PG8_STAGE(PG8_SA(1, 1), a1 + hstep, voffA);
            PG8_WAIT_L(8); PG8_BAR; PG8_WAIT_L(0); PG8_MMA(0, 0, At, B0); PG8_BAR; PG8_SCHED;
            PG8_LDB(B1, 0, 1); PG8_STAGE(PG8_SB(0, 0), b2, voffB);
            PG8_BAR; PG8_WAIT_L(0); PG8_MMA(0, 1, At, B1); PG8_BAR;
            PG8_LDA(At, 0, 1); PG8_STAGE(PG8_SA(0, 0), a2, voffA);
            PG8_BAR; PG8_WAIT_L(0); PG8_MMA(1, 0, At, B0); PG8_BAR; PG8_SCHED;
            PG8_STAGE(PG8_SB(0, 1), b2 + hstep, voffB);
            PG8_WAIT_V(6); PG8_BAR; PG8_MMA(1, 1, At, B1); PG8_BAR;
            PG8_LDB(B0, 1, 0); PG8_SCHED; PG8_LDA(At, 1, 0); PG8_STAGE(PG8_SA(0, 1), a2 + hstep, voffA);
            PG8_WAIT_L(8); PG8_BAR; PG8_WAIT_L(0); PG8_MMA(0, 0, At, B0); PG8_BAR; PG8_SCHED;
            PG8_LDB(B1, 1, 1); PG8_STAGE(PG8_SB(1, 0), b3, voffB);
            PG8_BAR; PG8_WAIT_L(0); PG8_MMA(0, 1, At, B1); PG8_BAR;
            PG8_LDA(At, 1, 1); PG8_STAGE(PG8_SA(1, 0), a3, voffA);
            PG8_BAR; PG8_WAIT_L(0); PG8_MMA(1, 0, At, B0); PG8_BAR; PG8_SCHED;
            PG8_STAGE(PG8_SB(1, 1), b3 + hstep, voffB);
            PG8_WAIT_V(6); PG8_BAR; PG8_MMA(1, 1, At, B1); PG8_BAR;
        }
        PG8_STAMP();
        if constexpr (!Epi::AFTER_DRAIN) { E(acc, cur, wr, wc, fr, fq); S.done(cur); }
        PG8_STAMP();
        if (!has_next) break;
#pragma unroll
        for (int a = 0; a < 2; ++a)
#pragma unroll
            for (int b = 0; b < 2; ++b)
#pragma unroll
                for (int m = 0; m < 4; ++m)
#pragma unroll
                    for (int n = 0; n < 2; ++n) acc[a][b][m][n] = (f32x4){0.f, 0.f, 0.f, 0.f};
        cur = nxt; cA = nA; cB = nB; ++ui;
    }
    PG8_WAIT_V(0);
    if (wr == 0) PG8_BAR;
    PG8_BAR;
    if constexpr (Epi::AFTER_DRAIN) { E.fused(acc, cur, wr, wc, fr, fq, lds, wid, lane); S.done(cur); }
    PG8_STAMP();
    if (STAMP && wid == 0) { stamps[lane] = lane < nts ? (((unsigned long long)(unsigned)ts_hi << 32) | (unsigned)ts_lo) : 0ull;
        if (lane == 62) stamps[62] = rt_entry; if (lane == 63) stamps[63] = (unsigned long long)wall_clock64(); }
#undef PG8_STAMP
#undef PG8_SA
#undef PG8_SB
#undef PG8_STAGE
#undef PG8_LDA
#undef PG8_LDB
#undef PG8_MMA
#undef PG8_WAIT_V
#undef PG8_WAIT_L
#undef PG8_BAR
#undef PG8_SCHED
}
}


namespace pg8 {
struct EpiProj {
    static constexpr bool PERM = true, AFTER_DRAIN = false;
    bf16_t* O; float* dtraw;
    __device__ __forceinline__ void operator()(const f32x4 (&acc)[2][2][4][2], const Unit& u, int wr, int wc, int fr, int fq) const {
        const int row0 = u.pm * BM + wr * 64 + fr;
        if (u.pn < 22) {
            const int col0 = u.pn * BM + wc * 32 + 8 * fq;
#pragma unroll
            for (int ai = 0; ai < 2; ++ai)
#pragma unroll
                for (int m = 0; m < 4; ++m) { bf16_t* rowp = O + (size_t)(row0 + ai * HALF + m * 16) * 5632 + col0;
#pragma unroll
                    for (int bj = 0; bj < 2; ++bj) { const f32x4 v0 = acc[ai][bj][m][0], v1 = acc[ai][bj][m][1];
                        u32x4 w; w.x = cvt_pk_bf16(v0[0], v0[1]); w.y = cvt_pk_bf16(v0[2], v0[3]); w.z = cvt_pk_bf16(v1[0], v1[1]); w.w = cvt_pk_bf16(v1[2], v1[3]);
                        *(u32x4*)(rowp + bj * HALF) = w; } }
        } else if (wc == 0) {
#pragma unroll
            for (int ai = 0; ai < 2; ++ai)
#pragma unroll
                for (int m = 0; m < 4; ++m) { float* rp = dtraw + (size_t)(row0 + ai * HALF + m * 16) * 32 + 8 * fq;
                    *(f32x4*)rp = acc[ai][0][m][0]; *(f32x4*)(rp + 4) = acc[ai][0][m][1]; }
        }
    }
};
}


namespace pg8 {
struct EpiBf16Plain {
    static constexpr bool PERM = true, AFTER_DRAIN = false;
    bf16_t* O; int ldc;
    __device__ __forceinline__ void operator()(const f32x4 (&acc)[2][2][4][2], const Unit& u, int wr, int wc, int fr, int fq) const {
        const int row0 = u.pm * BM + wr * 64 + fr, col0 = u.pn * BM + wc * 32 + 8 * fq;
#pragma unroll
        for (int ai = 0; ai < 2; ++ai)
#pragma unroll
            for (int m = 0; m < 4; ++m) { bf16_t* rowp = O + (size_t)(row0 + ai * HALF + m * 16) * ldc + col0;
#pragma unroll
                for (int bj = 0; bj < 2; ++bj) { const f32x4 v0 = acc[ai][bj][m][0], v1 = acc[ai][bj][m][1];
                    u32x4 w; w.x = cvt_pk_bf16(v0[0], v0[1]); w.y = cvt_pk_bf16(v0[2], v0[3]); w.z = cvt_pk_bf16(v1[0], v1[1]); w.w = cvt_pk_bf16(v1[2], v1[3]);
                    *(u32x4*)(rowp + bj * HALF) = w; } }
    }
};
}

#define NTHR 512
#define NWAVE 8

__device__ __forceinline__ void ph_gemm_f32(float* lds, const float* __restrict__ A, const float* __restrict__ B, float* __restrict__ C,
                                            int M, int N, int K, int lda, int ldb, int ldc) {
    const int tid = threadIdx.x & 255, half = threadIdx.x >> 8, tx = tid & 15, ty = tid >> 4;
    float (*As)[68] = (float (*)[68])(lds + half * 2 * 16 * 68);
    float (*Bs)[68] = (float (*)[68])(lds + half * 2 * 16 * 68 + 16 * 68);
    const int ntx = (N + 63) / 64, nty = M / 64, ntiles = ntx * nty;
    for (int it = blockIdx.x; 2 * it < ntiles; it += gridDim.x) {
        const int tile = 2 * it + half;
        const int m0 = (tile / ntx) * 64, n0 = (tile % ntx) * 64;
        float acc[4][4];
#pragma unroll
        for (int i = 0; i < 4; ++i)
#pragma unroll
            for (int j = 0; j < 4; ++j) acc[i][j] = 0.f;
        for (int k0 = 0; k0 < K; k0 += 16) {
#pragma unroll
            for (int i = 0; i < 4; ++i) {
                int idx = tid + i * 256;
                int r = idx >> 4, c = idx & 15;
                As[c][r] = (m0 + r < M) ? A[(size_t)(m0 + r) * lda + k0 + c] : 0.f;
                int rb = idx >> 6, cb = idx & 63;
                Bs[rb][cb] = (n0 + cb < N) ? B[(size_t)(k0 + rb) * ldb + n0 + cb] : 0.f;
            }
            __syncthreads();
#pragma unroll
            for (int k = 0; k < 16; ++k) {
                float a[4], b[4];
#pragma unroll
                for (int i = 0; i < 4; ++i) { a[i] = As[k][ty * 4 + i]; b[i] = Bs[k][tx * 4 + i]; }
#pragma unroll
                for (int i = 0; i < 4; ++i)
#pragma unroll
                    for (int j = 0; j < 4; ++j) acc[i][j] += a[i] * b[j];
            }
            __syncthreads();
        }
#pragma unroll
        for (int i = 0; i < 4; ++i)
#pragma unroll
            for (int j = 0; j < 4; ++j) {
                int r = m0 + ty * 4 + i, c = n0 + tx * 4 + j;
                if (r < M && c < N) C[(size_t)r * ldc + c] = acc[i][j];
            }
    }
}


template <int MODE>
__device__ __forceinline__ void transpose_item(const float* __restrict__ W, int K, int N, int Npad, bf16* __restrict__ WT, LAS float* scr, int item, int lane) {
    const int nblk = Npad / 32, kb = item / nblk, nb = item % nblk, k0 = 64 * kb, n0 = 32 * nb;
    const int n = n0 + (lane & 31);
    int sc = n;
    if (MODE == 1) sc = (n < 4096) ? n : (n < 5632 ? n + 24 : (n < 5656 ? n - 5632 + 4096 : -1));
    else sc = (n < N) ? n : -1;
#pragma unroll 8
    for (int i = 0; i < 32; ++i) { const int kk = 2 * i + (lane >> 5); scr[kk * 33 + (lane & 31)] = (sc >= 0) ? W[(size_t)(k0 + kk) * N + sc] : 0.f; }
    LDS_WAIT(); asm volatile("" ::: "memory");
    const int c = lane & 7;
#pragma unroll
    for (int j = 0; j < 4; ++j) { const int nn = (lane >> 3) + 8 * j; const LAS float* s = scr + (8 * c) * 33 + nn;
        v4u o; o.x = pk2(s[0 * 33], s[1 * 33]); o.y = pk2(s[2 * 33], s[3 * 33]); o.z = pk2(s[4 * 33], s[5 * 33]); o.w = pk2(s[6 * 33], s[7 * 33]);
        *(v4u*)(WT + (size_t)(n0 + nn) * K + k0 + 8 * c) = o; }
    LDS_WAIT(); asm volatile("" ::: "memory");
}
__device__ __forceinline__ void ph_prologue(LAS unsigned char* ldsb, const float* __restrict__ xp, const float* __restrict__ xs, bf16* __restrict__ A0,
                                            const float* __restrict__ w_in, bf16* __restrict__ wt_in, float* __restrict__ rope_tab) {
    const int lane = threadIdx.x & 63, wave = threadIdx.x >> 6;
    LAS float* scr = (LAS float*)(ldsb + wave * 16384);
    const int gw = blockIdx.x * NWAVE + wave, NGW = gridDim.x * NWAVE;
    constexpr int I_IN = (D_MODEL / 64) * (PROJ_LD / 32);
    for (int it = gw; it < I_IN; it += NGW) transpose_item<1>(w_in, D_MODEL, IN_WIDTH, PROJ_LD, wt_in, scr, it, lane);
    for (int idx = blockIdx.x * NTHR + threadIdx.x; idx < SEQ * 32; idx += gridDim.x * NTHR) {
        const int pos = idx >> 5, j = idx & 31;
        const double rev = (double)pos * ROPE_INV_REV[j];
        const float fr = (float)(rev - floor(rev));
        rope_tab[(size_t)pos * 64 + j] = __builtin_amdgcn_cosf(fr); rope_tab[(size_t)pos * 64 + 32 + j] = __builtin_amdgcn_sinf(fr);
    }
    const size_t n8 = (size_t)T_ALL * D_MODEL / 8, np8 = (size_t)T_PROMPT * D_MODEL / 8;
#pragma unroll 4
    for (size_t i = (size_t)blockIdx.x * NTHR + threadIdx.x; i < n8; i += (size_t)gridDim.x * NTHR) {
        const float4* s = (i < np8) ? (const float4*)xp + 2 * i : (const float4*)xs + 2 * (i - np8);
        float4 a = s[0], b = s[1];
        v4u o; o.x = pk2(a.x, a.y); o.y = pk2(a.z, a.w); o.z = pk2(b.x, b.y); o.w = pk2(b.z, b.w);
        ((v4u*)A0)[i] = o;
    }
}
__device__ __forceinline__ void ph_prologue2(LAS unsigned char* ldsb, const float* __restrict__ w_out, bf16* __restrict__ wt_out, const float* __restrict__ w_q, bf16* __restrict__ wt_q,
                                             int rank, int nranks) {
    const int lane = threadIdx.x & 63, wave = threadIdx.x >> 6;
    LAS float* scr = (LAS float*)(ldsb + wave * 16384);
    constexpr int I_OUT = (MIX_WIDTH / 64) * (D_MODEL / 32), I_Q = (D_MODEL / 64) * (2048 / 32);
    for (int it = rank * NWAVE + wave; it < I_OUT + I_Q; it += nranks * NWAVE) {
        if (it < I_OUT) transpose_item<0>(w_out, MIX_WIDTH, D_MODEL, D_MODEL, wt_out, scr, it, lane);
        else transpose_item<0>(w_q, D_MODEL, 2048, 2048, wt_q, scr, it - I_OUT, lane);
    }
}

__device__ __forceinline__ void ph_concat_x(const float* __restrict__ xp, const float* __restrict__ xs, float* __restrict__ xall) {
    const size_t n4 = (size_t)T_ALL * D_MODEL / 4, np4 = (size_t)T_PROMPT * D_MODEL / 4;
    for (size_t i = (size_t)blockIdx.x * NTHR + threadIdx.x; i < n4; i += (size_t)gridDim.x * NTHR) {
        float4 v = (i < np4) ? ((const float4*)xp)[i] : ((const float4*)xs)[i - np4];
        ((float4*)xall)[i] = v;
    }
}

typedef float f32x4n __attribute__((ext_vector_type(4)));
__device__ __forceinline__ void ph_cache_copy(const float* __restrict__ ck, const float* __restrict__ cv, float* __restrict__ out) {
    constexpr unsigned PER_B = (WBUF - DEC_SEQ) * ATT_WIDTH / 4;
    constexpr unsigned TOTAL = 2u * DEC_BATCH * PER_B;
    for (unsigned c = blockIdx.x; c < TOTAL / 4096u; c += gridDim.x) {
        f32x4n v[8]; size_t dsti[8]; bool isv[8];
#pragma unroll
        for (int j = 0; j < 8; ++j) {
            const unsigned idx = c * 4096u + j * 512u + threadIdx.x;
            const unsigned tb = idx / PER_B, r = idx - tb * PER_B, bb = tb & (DEC_BATCH - 1);
            isv[j] = tb >= DEC_BATCH;
            const size_t srci = (size_t)bb * (WBUF * ATT_WIDTH / 4) + (DEC_SEQ * ATT_WIDTH / 4) + r;
            dsti[j] = (size_t)bb * (WBUF * ATT_WIDTH / 4) + r;
            v[j] = __builtin_nontemporal_load((isv[j] ? (const f32x4n*)cv : (const f32x4n*)ck) + srci);
        }
#pragma unroll
        for (int j = 0; j < 8; ++j) __builtin_nontemporal_store(v[j], (f32x4n*)(out + (isv[j] ? OUT_SV : OUT_SK)) + dsti[j]);
    }
}

__device__ __forceinline__ void ph_post_proj(const float* __restrict__ proj, const float* __restrict__ state_conv,
                                             const float* __restrict__ conv_w, const float* __restrict__ conv_b, const float* __restrict__ dt_bias,
                                             float* __restrict__ xbc_act, float* __restrict__ dtv, float* __restrict__ qrot, float* __restrict__ krot,
                                             float* __restrict__ out) {
    const int tid = threadIdx.x & 255, half = threadIdx.x >> 8;
    for (int t = 2 * blockIdx.x + half; t < T_ALL; t += 2 * gridDim.x) {
        const bool is_p = t < T_PROMPT;
        int b, i, pos;
        if (is_p) { b = t / SEQ; i = t % SEQ; pos = i; } else { int ts = t - T_PROMPT; b = ts / DEC_SEQ; i = ts % DEC_SEQ; pos = PAST_LEN + i; }
        const float* row = proj + (size_t)t * PROJ_LD;
        for (int c = tid; c < CONV_DIM; c += 256) {
            float acc = conv_b[c];
#pragma unroll
            for (int tap = 0; tap < 4; ++tap) {
                int r = i - 3 + tap;
                float val;
                if (r >= 0) val = proj[(size_t)(t - i + r) * PROJ_LD + O_XBC + c];
                else val = is_p ? 0.f : state_conv[((size_t)b * 3 + (3 + r)) * CONV_DIM + c];
                acc += val * conv_w[tap * CONV_DIM + c];
            }
            xbc_act[(size_t)t * CONV_DIM + c] = silu_f(acc);
        }
        if (tid < SSD_HEADS) dtv[(size_t)t * SSD_HEADS + tid] = softplus_f(row[O_DT + tid] + dt_bias[tid]);
        for (int idx = tid; idx < 512; idx += 256) {
            int which = idx >> 8, h = (idx >> 5) & 7, j = idx & 31;
            double rev = (double)pos * ROPE_INV_REV[j];
            float fr = (float)(rev - floor(rev));
            float sn = __builtin_amdgcn_sinf(fr), cs = __builtin_amdgcn_cosf(fr);
            const float* src = row + (which ? O_K : O_Q) + h * 64;
            float t1 = src[j], t2 = src[j + 32];
            float o1 = t1 * cs - t2 * sn, o2 = t2 * cs + t1 * sn;
            float* dst = (which ? krot : qrot) + (size_t)t * ATT_WIDTH + h * 64;
            dst[j] = o1; dst[j + 32] = o2;
            if (which) {
                if (is_p) { if (i >= SEQ - WBUF) { float* o = out + OUT_PK + ((size_t)b * WBUF + (i - (SEQ - WBUF))) * ATT_WIDTH + h * 64; o[j] = o1; o[j + 32] = o2; } }
                else { float* o = out + OUT_SK + ((size_t)b * WBUF + (WBUF - DEC_SEQ + i)) * ATT_WIDTH + h * 64; o[j] = o1; o[j + 32] = o2; }
            }
        }
        for (int c = tid; c < ATT_WIDTH; c += 256) {
            float v = row[O_V + c];
            if (is_p) { if (i >= SEQ - WBUF) out[OUT_PV + ((size_t)b * WBUF + (i - (SEQ - WBUF))) * ATT_WIDTH + c] = v; }
            else out[OUT_SV + ((size_t)b * WBUF + (WBUF - DEC_SEQ + i)) * ATT_WIDTH + c] = v;
        }
        if (is_p) {
            if (i >= SEQ - 3) { int r = i - (SEQ - 3); for (int c = tid; c < CONV_DIM; c += 256) out[OUT_PC + ((size_t)b * 3 + r) * CONV_DIM + c] = row[O_XBC + c]; }
        } else {
            if (i >= 1) { int r = i - 1; for (int c = tid; c < CONV_DIM; c += 256) out[OUT_SC + ((size_t)b * 3 + r) * CONV_DIM + c] = row[O_XBC + c]; }
        }
    }
}


#define NB_LD 5632
#define NB_XBC 1536
#define NB_Q 4096
#define NB_K 4608
#define NB_V 5120
__device__ __forceinline__ void unpack8(const v4u w, float (&f)[8]) {
    f[0] = __builtin_bit_cast(float, w.x << 16); f[1] = __builtin_bit_cast(float, w.x & 0xffff0000u);
    f[2] = __builtin_bit_cast(float, w.y << 16); f[3] = __builtin_bit_cast(float, w.y & 0xffff0000u);
    f[4] = __builtin_bit_cast(float, w.z << 16); f[5] = __builtin_bit_cast(float, w.z & 0xffff0000u);
    f[6] = __builtin_bit_cast(float, w.w << 16); f[7] = __builtin_bit_cast(float, w.w & 0xffff0000u);
}
__device__ __forceinline__ void store8f(float* d, const float (&f)[8]) { *(float4*)d = make_float4(f[0], f[1], f[2], f[3]); *(float4*)(d + 4) = make_float4(f[4], f[5], f[6], f[7]); }
__device__ __forceinline__ void ph_post_proj2(const bf16* __restrict__ projb, const float* __restrict__ dtraw, const float* __restrict__ state_conv,
                                              const float* __restrict__ conv_w, const float* __restrict__ conv_b, const float* __restrict__ dt_bias,
                                              bf16* __restrict__ xbc_b, float* __restrict__ dtv, bf16* __restrict__ qrot_b, bf16* __restrict__ krot_b,
                                              float* __restrict__ out) {
    const int tid = threadIdx.x & 255, half = threadIdx.x >> 8;
    for (int t = T_PROMPT + 2 * blockIdx.x + half; t < T_ALL; t += 2 * gridDim.x) {
        const bool is_p = t < T_PROMPT;
        int b, i, pos;
        if (is_p) { b = t / SEQ; i = t % SEQ; pos = i; } else { int ts = t - T_PROMPT; b = ts / DEC_SEQ; i = ts % DEC_SEQ; pos = PAST_LEN + i; }
        const bf16* row = projb + (size_t)t * NB_LD;
        if (tid < 64) {
            float f[8]; unpack8(*(const v4u*)(row + NB_V + tid * 8), f);
            if (is_p) { if (i >= SEQ - WBUF) store8f(out + OUT_PV + ((size_t)b * WBUF + (i - (SEQ - WBUF))) * ATT_WIDTH + tid * 8, f); }
            else store8f(out + OUT_SV + ((size_t)b * WBUF + (WBUF - DEC_SEQ + i)) * ATT_WIDTH + tid * 8, f);
        }
        for (int c8 = tid; c8 < 320; c8 += 256) {
            const int c = c8 * 8;
            float acc[8], cur[8];
            { const float4 b0 = *(const float4*)(conv_b + c), b1 = *(const float4*)(conv_b + c + 4);
              acc[0] = b0.x; acc[1] = b0.y; acc[2] = b0.z; acc[3] = b0.w; acc[4] = b1.x; acc[5] = b1.y; acc[6] = b1.z; acc[7] = b1.w; }
#pragma unroll
            for (int tap = 0; tap < 4; ++tap) {
                const int r = i - 3 + tap;
                float val[8];
                if (r >= 0) unpack8(*(const v4u*)(projb + (size_t)(t - i + r) * NB_LD + NB_XBC + c), val);
                else if (!is_p) { const float* sp = state_conv + ((size_t)b * 3 + (3 + r)) * CONV_DIM + c; const float4 s0 = *(const float4*)sp, s1 = *(const float4*)(sp + 4);
                    val[0] = s0.x; val[1] = s0.y; val[2] = s0.z; val[3] = s0.w; val[4] = s1.x; val[5] = s1.y; val[6] = s1.z; val[7] = s1.w; }
                else {
#pragma unroll
                    for (int j = 0; j < 8; ++j) val[j] = 0.f; }
                const float4 w0 = *(const float4*)(conv_w + tap * CONV_DIM + c), w1 = *(const float4*)(conv_w + tap * CONV_DIM + c + 4);
                acc[0] += val[0] * w0.x; acc[1] += val[1] * w0.y; acc[2] += val[2] * w0.z; acc[3] += val[3] * w0.w;
                acc[4] += val[4] * w1.x; acc[5] += val[5] * w1.y; acc[6] += val[6] * w1.z; acc[7] += val[7] * w1.w;
                if (tap == 3) {
#pragma unroll
                    for (int j = 0; j < 8; ++j) cur[j] = val[j]; }
            }
#pragma unroll
            for (int j = 0; j < 8; ++j) acc[j] = silu_f(acc[j]);
            v4u o; o.x = pk2(acc[0], acc[1]); o.y = pk2(acc[2], acc[3]); o.z = pk2(acc[4], acc[5]); o.w = pk2(acc[6], acc[7]);
            *(v4u*)(xbc_b + (size_t)t * CONV_DIM + c) = o;
            if (is_p) { if (i >= SEQ - 3) store8f(out + OUT_PC + ((size_t)b * 3 + (i - (SEQ - 3))) * CONV_DIM + c, cur); }
            else { if (i >= 1) store8f(out + OUT_SC + ((size_t)b * 3 + (i - 1)) * CONV_DIM + c, cur); }
        }
        if (tid < SSD_HEADS) dtv[(size_t)t * SSD_HEADS + tid] = softplus_f(dtraw[(size_t)t * 32 + tid] + dt_bias[tid]);
        if (tid < 128) {
            const int which = tid >> 6, h = (tid >> 3) & 7, jc = tid & 7;
            const bf16* src = row + (which ? NB_K : NB_Q) + h * 64 + jc * 4;
            const uint2 lo = *(const uint2*)src, hi = *(const uint2*)(src + 32);
            float t1[4], t2[4], o1[4], o2[4];
            t1[0] = __builtin_bit_cast(float, lo.x << 16); t1[1] = __builtin_bit_cast(float, lo.x & 0xffff0000u); t1[2] = __builtin_bit_cast(float, lo.y << 16); t1[3] = __builtin_bit_cast(float, lo.y & 0xffff0000u);
            t2[0] = __builtin_bit_cast(float, hi.x << 16); t2[1] = __builtin_bit_cast(float, hi.x & 0xffff0000u); t2[2] = __builtin_bit_cast(float, hi.y << 16); t2[3] = __builtin_bit_cast(float, hi.y & 0xffff0000u);
#pragma unroll
            for (int e = 0; e < 4; ++e) {
                const double rev = (double)pos * ROPE_INV_REV[jc * 4 + e];
                const float fr = (float)(rev - floor(rev));
                const float sn = __builtin_amdgcn_sinf(fr), cs = __builtin_amdgcn_cosf(fr);
                o1[e] = t1[e] * cs - t2[e] * sn; o2[e] = t2[e] * cs + t1[e] * sn;
            }
            const size_t doff = (size_t)t * ATT_WIDTH + h * 64 + jc * 4;
            bf16* db = which ? krot_b : qrot_b;
            *(uint2*)(db + doff) = make_uint2(pk2(o1[0], o1[1]), pk2(o1[2], o1[3])); *(uint2*)(db + doff + 32) = make_uint2(pk2(o2[0], o2[1]), pk2(o2[2], o2[3]));
            if (which) {
                float* o = nullptr;
                if (is_p) { if (i >= SEQ - WBUF) o = out + OUT_PK + ((size_t)b * WBUF + (i - (SEQ - WBUF))) * ATT_WIDTH + h * 64 + jc * 4; }
                else o = out + OUT_SK + ((size_t)b * WBUF + (WBUF - DEC_SEQ + i)) * ATT_WIDTH + h * 64 + jc * 4;
                if (o) { *(float4*)o = make_float4(o1[0], o1[1], o1[2], o1[3]); *(float4*)(o + 32) = make_float4(o2[0], o2[1], o2[2], o2[3]); }
            }
        }
    }
}


__device__ __forceinline__ void ph_post_proj_prompt(const bf16* __restrict__ projb, const float* __restrict__ dtraw, const float* __restrict__ conv_w, const float* __restrict__ conv_b,
                                                    const float* __restrict__ dt_bias, const float* __restrict__ rope_tab, bf16* __restrict__ xbc_b, float* __restrict__ dtv,
                                                    bf16* __restrict__ qrot_b, bf16* __restrict__ krot_b, float* __restrict__ out) {
    const int gtid = blockIdx.x * NTHR + threadIdx.x, gsz = gridDim.x * NTHR;
    for (int item = gtid; item < (T_PROMPT / 16) * 320; item += gsz) {
        const int run = item / 320, c = (item - run * 320) * 8, t0 = run * 16, i0 = t0 & (SEQ - 1), b = t0 >> 13;
        float w[4][8], bias[8];
#pragma unroll
        for (int tap = 0; tap < 4; ++tap) { const float4 w0 = *(const float4*)(conv_w + tap * CONV_DIM + c), w1 = *(const float4*)(conv_w + tap * CONV_DIM + c + 4);
            w[tap][0] = w0.x; w[tap][1] = w0.y; w[tap][2] = w0.z; w[tap][3] = w0.w; w[tap][4] = w1.x; w[tap][5] = w1.y; w[tap][6] = w1.z; w[tap][7] = w1.w; }
        { const float4 b0 = *(const float4*)(conv_b + c), b1 = *(const float4*)(conv_b + c + 4);
          bias[0] = b0.x; bias[1] = b0.y; bias[2] = b0.z; bias[3] = b0.w; bias[4] = b1.x; bias[5] = b1.y; bias[6] = b1.z; bias[7] = b1.w; }
        const bf16* src = projb + (size_t)t0 * NB_LD + NB_XBC + c;
        v4u raw[19];
#pragma unroll
        for (int s = 0; s < 19; ++s) { v4u z; z.x = 0u; z.y = 0u; z.z = 0u; z.w = 0u; raw[s] = (s >= 3 || i0 != 0) ? *(const v4u*)(src + (ptrdiff_t)(s - 3) * NB_LD) : z; }
        float p0[8], p1[8], p2[8];
        unpack8(raw[0], p0); unpack8(raw[1], p1); unpack8(raw[2], p2);
#pragma unroll
        for (int s = 0; s < 16; ++s) {
            float cur[8], acc[8]; unpack8(raw[s + 3], cur);
#pragma unroll
            for (int j = 0; j < 8; ++j) acc[j] = silu_f(bias[j] + p0[j] * w[0][j] + p1[j] * w[1][j] + p2[j] * w[2][j] + cur[j] * w[3][j]);
            v4u o; o.x = pk2(acc[0], acc[1]); o.y = pk2(acc[2], acc[3]); o.z = pk2(acc[4], acc[5]); o.w = pk2(acc[6], acc[7]);
            *(v4u*)(xbc_b + (size_t)(t0 + s) * CONV_DIM + c) = o;
            if (i0 + s >= SEQ - 3) store8f(out + OUT_PC + ((size_t)b * 3 + (i0 + s - (SEQ - 3))) * CONV_DIM + c, cur);
#pragma unroll
            for (int j = 0; j < 8; ++j) { p0[j] = p1[j]; p1[j] = p2[j]; p2[j] = cur[j]; }
        }
    }
#pragma unroll 4
    for (int item = gtid; item < T_PROMPT * 128; item += gsz) {
        const int t = item >> 7, sub = item & 127, which = sub >> 6, h = (sub >> 3) & 7, jc = sub & 7, i = t & (SEQ - 1), b = t >> 13;
        const bf16* src = projb + (size_t)t * NB_LD + (which ? NB_K : NB_Q) + h * 64 + jc * 4;
        const uint2 lo = *(const uint2*)src, hi = *(const uint2*)(src + 32);
        const float4 cs = *(const float4*)(rope_tab + (size_t)i * 64 + jc * 4), sn = *(const float4*)(rope_tab + (size_t)i * 64 + 32 + jc * 4);
        float t1[4], t2[4], o1[4], o2[4];
        t1[0] = __builtin_bit_cast(float, lo.x << 16); t1[1] = __builtin_bit_cast(float, lo.x & 0xffff0000u); t1[2] = __builtin_bit_cast(float, lo.y << 16); t1[3] = __builtin_bit_cast(float, lo.y & 0xffff0000u);
        t2[0] = __builtin_bit_cast(float, hi.x << 16); t2[1] = __builtin_bit_cast(float, hi.x & 0xffff0000u); t2[2] = __builtin_bit_cast(float, hi.y << 16); t2[3] = __builtin_bit_cast(float, hi.y & 0xffff0000u);
        const float cv[4] = {cs.x, cs.y, cs.z, cs.w}, sv[4] = {sn.x, sn.y, sn.z, sn.w};
#pragma unroll
        for (int e = 0; e < 4; ++e) { o1[e] = t1[e] * cv[e] - t2[e] * sv[e]; o2[e] = t2[e] * cv[e] + t1[e] * sv[e]; }
        const size_t doff = (size_t)t * ATT_WIDTH + h * 64 + jc * 4;
        bf16* db = which ? krot_b : qrot_b;
        *(uint2*)(db + doff) = make_uint2(pk2(o1[0], o1[1]), pk2(o1[2], o1[3])); *(uint2*)(db + doff + 32) = make_uint2(pk2(o2[0], o2[1]), pk2(o2[2], o2[3]));
        if (which && i >= SEQ - WBUF) {
            float* o = out + OUT_PK + ((size_t)b * WBUF + (i - (SEQ - WBUF))) * ATT_WIDTH + h * 64 + jc * 4;
            *(float4*)o = make_float4(o1[0], o1[1], o1[2], o1[3]); *(float4*)(o + 32) = make_float4(o2[0], o2[1], o2[2], o2[3]);
        }
    }
#pragma unroll 4
    for (int item = gtid; item < T_PROMPT * SSD_HEADS; item += gsz) { const int t = item / SSD_HEADS, hd = item - t * SSD_HEADS; dtv[item] = softplus_f(dtraw[(size_t)t * 32 + hd] + dt_bias[hd]); }
#pragma unroll 2
    for (int item = gtid; item < BATCH * WBUF * 64; item += gsz) {
        const int ch = item & 63, j = (item >> 6) & (WBUF - 1), b = item >> 17;
        float f[8]; unpack8(*(const v4u*)(projb + (size_t)(b * SEQ + (SEQ - WBUF) + j) * NB_LD + NB_V + ch * 8), f);
        store8f(out + OUT_PV + ((size_t)b * WBUF + j) * ATT_WIDTH + ch * 8, f);
    }
}

#define SSD_CH 32
__device__ __forceinline__ void ph_ssd_naive(float* lds, const bf16* __restrict__ xbc_act, const float* __restrict__ dtv, const float* __restrict__ a_log,
                                             const float* __restrict__ d_skip, const float* __restrict__ state_ssm, float* __restrict__ ybuf, float* __restrict__ out) {
    float (*sx)[64] = (float (*)[64])lds;
    float (*sB)[128] = (float (*)[128])(lds + SSD_CH * 64);
    float (*sC)[128] = (float (*)[128])(lds + SSD_CH * 64 + SSD_CH * 128);
    float* sdt = lds + SSD_CH * 64 + 2 * SSD_CH * 128;
    const int tid = threadIdx.x, p = tid >> 3, ng = tid & 7;
    for (int vb = BATCH * SSD_HEADS + blockIdx.x; vb < (BATCH + DEC_BATCH) * SSD_HEADS; vb += gridDim.x) {
        const int seq = vb / SSD_HEADS, h = vb % SSD_HEADS, g = h / 6;
        const bool is_p = seq < BATCH;
        const int L = is_p ? SEQ : DEC_SEQ;
        const int t0 = is_p ? seq * SEQ : T_PROMPT + (seq - BATCH) * DEC_SEQ;
        const float A = -__expf(a_log[h]);
        const float D = d_skip[h];
        float hs[16];
        if (is_p) {
#pragma unroll
            for (int j = 0; j < 16; ++j) hs[j] = 0.f;
        } else {
            const float* s0 = state_ssm + (((size_t)(seq - BATCH) * SSD_HEADS + h) * 64 + p) * 128 + ng * 16;
#pragma unroll
            for (int j = 0; j < 16; ++j) hs[j] = s0[j];
        }
        for (int c0 = 0; c0 < L; c0 += SSD_CH) {
            const int nst = (L - c0) < SSD_CH ? (L - c0) : SSD_CH;
            __syncthreads();
            for (int idx = tid; idx < nst * 64; idx += NTHR) { int s = idx >> 6, c = idx & 63; sx[s][c] = bf2f(xbc_act[(size_t)(t0 + c0 + s) * CONV_DIM + h * 64 + c]); }
            for (int idx = tid; idx < nst * 128; idx += NTHR) { int s = idx >> 7, c = idx & 127;
                sB[s][c] = bf2f(xbc_act[(size_t)(t0 + c0 + s) * CONV_DIM + 1536 + g * 128 + c]);
                sC[s][c] = bf2f(xbc_act[(size_t)(t0 + c0 + s) * CONV_DIM + 2048 + g * 128 + c]); }
            if (tid < nst) sdt[tid] = dtv[(size_t)(t0 + c0 + tid) * SSD_HEADS + h];
            __syncthreads();
            for (int s = 0; s < nst; ++s) {
                const float dt = sdt[s], x = sx[s][p];
                const float a = __expf(dt * A), xdt = x * dt;
                float y = 0.f;
#pragma unroll
                for (int j = 0; j < 16; ++j) { hs[j] = a * hs[j] + xdt * sB[s][ng * 16 + j]; y += sC[s][ng * 16 + j] * hs[j]; }
                y += __shfl_xor(y, 1); y += __shfl_xor(y, 2); y += __shfl_xor(y, 4);
                if (ng == 0) ybuf[(size_t)(t0 + c0 + s) * MIX_WIDTH + h * 64 + p] = y + D * x;
            }
        }
        float* so = is_p ? out + OUT_PS + (((size_t)seq * SSD_HEADS + h) * 64 + p) * 128 + ng * 16
                         : out + OUT_SS + (((size_t)(seq - BATCH) * SSD_HEADS + h) * 64 + p) * 128 + ng * 16;
#pragma unroll
        for (int j = 0; j < 16; ++j) so[j] = hs[j];
    }
}

__device__ __forceinline__ void ph_gate_norm(const bf16* __restrict__ projb, const float* __restrict__ norm_g, const float* __restrict__ ybuf, bf16* __restrict__ A1) {
    const int w = threadIdx.x >> 6, lane = threadIdx.x & 63, g = w & 3;
    for (int t = T_PROMPT + 2 * blockIdx.x + (w >> 2); t < T_ALL; t += 2 * gridDim.x) {
        float v[6]; float ss = 0.f;
#pragma unroll
        for (int j = 0; j < 6; ++j) {
            int c = g * 384 + j * 64 + lane;
            float y = ybuf[(size_t)t * MIX_WIDTH + c], z = bf2f(projb[(size_t)t * NB_LD + c]);
            v[j] = y * silu_f(z); ss += v[j] * v[j];
        }
        ss = wave_sum(ss);
        const float r = rsqrtf(ss * (1.0f / 384.0f) + LN_EPS);
#pragma unroll
        for (int j = 0; j < 6; ++j) { int c = g * 384 + j * 64 + lane; A1[(size_t)t * MIX_WIDTH + c] = (bf16)f2bf(v[j] * r * norm_g[c]); }
    }
}

__device__ __forceinline__ void ph_attn_naive(float* lds, const float* __restrict__ proj, const float* __restrict__ qrot, const float* __restrict__ krot,
                                              const float* __restrict__ ck, const float* __restrict__ cv, float* __restrict__ ybuf) {
    float (*sq)[64] = (float (*)[64])lds;
    const int w = threadIdx.x >> 6, lane = threadIdx.x & 63;
    for (int vb = blockIdx.x; vb < T_SAMPLE * 8 / NWAVE; vb += gridDim.x) {
        const int item = T_PROMPT * 8 + vb * NWAVE + w;
        const int t = item >> 3, h = item & 7;
        const bool is_p = t < T_PROMPT;
        int b, i;
        if (is_p) { b = t / SEQ; i = t % SEQ; } else { int ts = t - T_PROMPT; b = ts / DEC_SEQ; i = ts % DEC_SEQ; }
        __syncthreads();
        sq[w][lane] = qrot[(size_t)t * ATT_WIDTH + h * 64 + lane];
        __syncthreads();
        const int qi = is_p ? i : WBUF + i;
        float sc[3][3];
        float mx = -INFINITY;
#pragma unroll
        for (int pt = 0; pt < 3; ++pt) {
            const int d = pt == 0 ? 1 : (pt == 1 ? 4 : 16);
#pragma unroll
            for (int sl = 0; sl < 3; ++sl) {
                const int m = lane + sl * 64;
                float s = -INFINITY;
                const int kj = qi - d * m;
                if (m <= 128 && kj >= 0) {
                    const float* kr;
                    if (is_p) kr = krot + (size_t)(b * SEQ + kj) * ATT_WIDTH + h * 64;
                    else kr = (kj >= WBUF) ? krot + (size_t)(T_PROMPT + b * DEC_SEQ + (kj - WBUF)) * ATT_WIDTH + h * 64
                                           : ck + ((size_t)b * WBUF + kj) * ATT_WIDTH + h * 64;
                    float a = 0.f;
#pragma unroll
                    for (int c = 0; c < 64; c += 4) { float4 kv = *(const float4*)(kr + c); a += kv.x * sq[w][c] + kv.y * sq[w][c + 1] + kv.z * sq[w][c + 2] + kv.w * sq[w][c + 3]; }
                    s = a * 0.125f;
                }
                sc[pt][sl] = s; mx = fmaxf(mx, s);
            }
        }
        mx = wave_max(mx);
        float lsum = 0.f;
#pragma unroll
        for (int pt = 0; pt < 3; ++pt)
#pragma unroll
            for (int sl = 0; sl < 3; ++sl) { float pv = (sc[pt][sl] == -INFINITY) ? 0.f : __expf(sc[pt][sl] - mx); sc[pt][sl] = pv; lsum += pv; }
        lsum = wave_sum(lsum);
        float o = 0.f;
#pragma unroll
        for (int pt = 0; pt < 3; ++pt) {
            const int d = pt == 0 ? 1 : (pt == 1 ? 4 : 16);
#pragma unroll
            for (int sl = 0; sl < 3; ++sl) {
                const int mend = sl < 2 ? 64 : 1;
                for (int ml = 0; ml < mend; ++ml) {
                    const int m = ml + sl * 64;
                    const int kj = qi - d * m;
                    const float pv = __shfl(sc[pt][sl], ml);
                    if (kj < 0) continue;
                    const float* vr;
                    if (is_p) vr = proj + (size_t)(b * SEQ + kj) * PROJ_LD + O_V + h * 64;
                    else vr = (kj >= WBUF) ? proj + (size_t)(T_PROMPT + b * DEC_SEQ + (kj - WBUF)) * PROJ_LD + O_V + h * 64
                                           : cv + ((size_t)b * WBUF + kj) * ATT_WIDTH + h * 64;
                    o += pv * vr[lane];
                }
            }
        }
        ybuf[(size_t)t * MIX_WIDTH + SSD_WIDTH + h * 64 + lane] = o / lsum;
    }
}

__device__ __forceinline__ int token_of_iter(int k) {
    const int w = __builtin_amdgcn_readfirstlane(threadIdx.x >> 6), wgl = blockIdx.x * NWAVE + w;
    if (gridDim.x != 256) { const int t = wgl + k * (int)(gridDim.x * NWAVE); return t < T_ALL ? t : -1; }
    if (k < 8) return k * 2048 + wgl;
    if (k == 8 && w < 2) return 16384 + w * 256 + (int)blockIdx.x;
    return -1;
}
__device__ __forceinline__ void ph_ln_res(const bf16* __restrict__ xb, const bf16* __restrict__ add, const float* __restrict__ gam,
                                          const float* __restrict__ bet, bf16* __restrict__ dstb) {
    const int lane = threadIdx.x & 63;
    float4 G0[2], G1[2], B0[2], B1[2];
#pragma unroll
    for (int j = 0; j < 2; ++j) { const int c = j * 512 + lane * 8; G0[j] = *(const float4*)(gam + c); G1[j] = *(const float4*)(gam + c + 4); B0[j] = *(const float4*)(bet + c); B1[j] = *(const float4*)(bet + c + 4); }
#pragma unroll 2
    for (int k = 0;; ++k) {
        const int t = token_of_iter(k);
        if (t < 0) break;
        const bf16* res = xb + (size_t)t * D_MODEL;
        float v[16]; float s = 0.f;
#pragma unroll
        for (int j = 0; j < 2; ++j) { const int c = j * 512 + lane * 8; float r8[8]; unpack8(*(const v4u*)(res + c), r8);
            const float4 r0 = make_float4(r8[0], r8[1], r8[2], r8[3]), r1 = make_float4(r8[4], r8[5], r8[6], r8[7]);
            float a8[8]; unpack8(*(const v4u*)(add + (size_t)t * D_MODEL + c), a8);
            v[8 * j] = ALPHA_F * r0.x + a8[0]; v[8 * j + 1] = ALPHA_F * r0.y + a8[1]; v[8 * j + 2] = ALPHA_F * r0.z + a8[2]; v[8 * j + 3] = ALPHA_F * r0.w + a8[3];
            v[8 * j + 4] = ALPHA_F * r1.x + a8[4]; v[8 * j + 5] = ALPHA_F * r1.y + a8[5]; v[8 * j + 6] = ALPHA_F * r1.z + a8[6]; v[8 * j + 7] = ALPHA_F * r1.w + a8[7]; }
#pragma unroll
        for (int j = 0; j < 16; ++j) s += v[j];
        s = wave_sum(s);
        const float mu = s * (1.0f / 1024.0f);
        float q = 0.f;
#pragma unroll
        for (int j = 0; j < 16; ++j) { v[j] -= mu; q += v[j] * v[j]; }
        q = wave_sum(q);
        const float r = rsqrtf(q * (1.0f / 1024.0f) + LN_EPS);
#pragma unroll
        for (int j = 0; j < 2; ++j) { const int c = j * 512 + lane * 8; const float4 g0 = G0[j], g1 = G1[j], b0 = B0[j], b1 = B1[j];
            v4u o; o.x = pk2(v[8 * j] * r * g0.x + b0.x, v[8 * j + 1] * r * g0.y + b0.y); o.y = pk2(v[8 * j + 2] * r * g0.z + b0.z, v[8 * j + 3] * r * g0.w + b0.w);
            o.z = pk2(v[8 * j + 4] * r * g1.x + b1.x, v[8 * j + 5] * r * g1.y + b1.y); o.w = pk2(v[8 * j + 6] * r * g1.z + b1.z, v[8 * j + 7] * r * g1.w + b1.w);
            *(v4u*)(dstb + (size_t)t * D_MODEL + c) = o; }
    }
}

__device__ __forceinline__ void ph_peer_route(float* lds, const float* __restrict__ qh, const float* __restrict__ keys1, const float* __restrict__ keys2,
                                              int* __restrict__ eidx, float* __restrict__ gate) {
    float (*sq)[256] = (float (*)[256])lds;
    float (*sv)[2][16] = (float (*)[2][16])(lds + NWAVE * 256);
    int (*si)[2][16] = (int (*)[2][16])(lds + NWAVE * 256 + NWAVE * 32);
    const int w = threadIdx.x >> 6, lane = threadIdx.x & 63;
    for (int vb = blockIdx.x; vb < T_ALL * 8 / NWAVE; vb += gridDim.x) {
        const int item = vb * NWAVE + w;
        const int t = item >> 3, h = item & 7;
        __syncthreads();
        for (int c = lane; c < 256; c += 64) sq[w][c] = qh[(size_t)t * 2048 + h * 256 + c];
        __syncthreads();
#pragma unroll
        for (int half = 0; half < 2; ++half) {
            const float* keys = half ? keys2 : keys1;
            float s[2];
#pragma unroll
            for (int sl = 0; sl < 2; ++sl) {
                const float* kr = keys + (size_t)(lane + sl * 64) * 128;
                float a = 0.f;
#pragma unroll 8
                for (int c = 0; c < 128; c += 4) { float4 kv = *(const float4*)(kr + c); const float* qq = &sq[w][half * 128 + c]; a += kv.x * qq[0] + kv.y * qq[1] + kv.z * qq[2] + kv.w * qq[3]; }
                s[sl] = a;
            }
            for (int r = 0; r < 16; ++r) {
                float bv; int bi;
                if (s[0] >= s[1]) { bv = s[0]; bi = lane; } else { bv = s[1]; bi = lane + 64; }
#pragma unroll
                for (int o = 32; o > 0; o >>= 1) {
                    float ov = __shfl_xor(bv, o); int oi = __shfl_xor(bi, o);
                    if (ov > bv || (ov == bv && oi < bi)) { bv = ov; bi = oi; }
                }
                if (lane == 0) { sv[w][half][r] = bv; si[w][half][r] = bi; }
                if (bi == lane) s[0] = -INFINITY;
                if (bi == lane + 64) s[1] = -INFINITY;
            }
        }
        __syncthreads();
        float c[4];
#pragma unroll
        for (int j = 0; j < 4; ++j) { int ci = lane * 4 + j; c[j] = sv[w][0][ci >> 4] + sv[w][1][ci & 15]; }
        float myv = 0.f; int myc = 0;
        for (int r = 0; r < 16; ++r) {
            float bv = c[0]; int bi = lane * 4;
#pragma unroll
            for (int j = 1; j < 4; ++j) if (c[j] > bv) { bv = c[j]; bi = lane * 4 + j; }
#pragma unroll
            for (int o = 32; o > 0; o >>= 1) {
                float ov = __shfl_xor(bv, o); int oi = __shfl_xor(bi, o);
                if (ov > bv || (ov == bv && oi < bi)) { bv = ov; bi = oi; }
            }
            if (lane == r) { myv = bv; myc = bi; }
#pragma unroll
            for (int j = 0; j < 4; ++j) if (bi == lane * 4 + j) c[j] = -INFINITY;
        }
        float v = lane < 16 ? myv : -INFINITY;
        float mx = wave_max(v);
        float e = lane < 16 ? __expf(v - mx) : 0.f;
        float sum = wave_sum(e);
        if (lane < 16) {
            int ex = si[w][0][myc >> 4] * PEER_NKEYS + si[w][1][myc & 15];
            eidx[(size_t)t * 128 + h * 16 + lane] = ex;
            gate[(size_t)t * 128 + h * 16 + lane] = e / sum;
        }
    }
}

__device__ __forceinline__ void ph_peer_ffn(const float* __restrict__ hbuf, const int* __restrict__ eidx, const float* __restrict__ gate,
                                            const bf16* __restrict__ ub, const bf16* __restrict__ vb, const float* __restrict__ gam,
                                            const float* __restrict__ bet, float* __restrict__ out) {
    const int lane = threadIdx.x & 63;
    for (int t = blockIdx.x * NWAVE + (threadIdx.x >> 6); t < T_ALL; t += gridDim.x * NWAVE) {
        float x[16], acc[16];
        { const float* xr = hbuf + (size_t)t * D_MODEL + lane * 8;
          const float4 a = *(const float4*)xr, b = *(const float4*)(xr + 4), c = *(const float4*)(xr + 512), d = *(const float4*)(xr + 516);
          x[0] = a.x; x[1] = a.y; x[2] = a.z; x[3] = a.w; x[4] = b.x; x[5] = b.y; x[6] = b.z; x[7] = b.w;
          x[8] = c.x; x[9] = c.y; x[10] = c.z; x[11] = c.w; x[12] = d.x; x[13] = d.y; x[14] = d.z; x[15] = d.w; }
#pragma unroll
        for (int j = 0; j < 16; ++j) acc[j] = 0.f;
        for (int k = 0; k < 128; ++k) {
            const int e = eidx[(size_t)t * 128 + k];
            const float g = gate[(size_t)t * 128 + k];
            const bf16* ur = ub + (size_t)e * D_MODEL + lane * 8;
            float u0[8], u1[8];
            unpack8(*(const v4u*)ur, u0); unpack8(*(const v4u*)(ur + 512), u1);
            float d = 0.f;
#pragma unroll
            for (int j = 0; j < 8; ++j) d += u0[j] * x[j] + u1[j] * x[8 + j];
            d = wave_sum(d);
            const float wgt = g * gelu_f(d);
            const bf16* vr = vb + (size_t)e * D_MODEL + lane * 8;
            unpack8(*(const v4u*)vr, u0); unpack8(*(const v4u*)(vr + 512), u1);
#pragma unroll
            for (int j = 0; j < 8; ++j) { acc[j] += wgt * u0[j]; acc[8 + j] += wgt * u1[j]; }
        }
        float s = 0.f;
#pragma unroll
        for (int j = 0; j < 16; ++j) { acc[j] += ALPHA_F * x[j]; s += acc[j]; }
        s = wave_sum(s);
        const float mu = s * (1.0f / 1024.0f);
        float q = 0.f;
#pragma unroll
        for (int j = 0; j < 16; ++j) { acc[j] -= mu; q += acc[j] * acc[j]; }
        q = wave_sum(q);
        const float r = rsqrtf(q * (1.0f / 1024.0f) + LN_EPS);
        float* dst = ((t < T_PROMPT) ? out + OUT_YP + (size_t)t * D_MODEL : out + OUT_YS + (size_t)(t - T_PROMPT) * D_MODEL) + lane * 8;
#pragma unroll
        for (int q4 = 0; q4 < 4; ++q4) {
            const int eo = (q4 >> 1) * 512 + (q4 & 1) * 4;
            const float4 g4 = *(const float4*)(gam + lane * 8 + eo), b4 = *(const float4*)(bet + lane * 8 + eo);
            float4 o; o.x = acc[q4 * 4 + 0] * r * g4.x + b4.x; o.y = acc[q4 * 4 + 1] * r * g4.y + b4.y; o.z = acc[q4 * 4 + 2] * r * g4.z + b4.z; o.w = acc[q4 * 4 + 3] * r * g4.w + b4.w;
            *(float4*)(dst + eo) = o;
        }
    }
}

__device__ __forceinline__ float peer_dot16(const v4u a, const v4u b, const float (&x)[16]) {
    float u0[8], u1[8]; unpack8(a, u0); unpack8(b, u1);
    float d = 0.f;
#pragma unroll
    for (int j = 0; j < 8; ++j) d += u0[j] * x[j] + u1[j] * x[8 + j];
    return d;
}
#define PEER_TR_STEP(N, M) _Pragma("unroll") for (int i = 0; i < N; ++i) { const bool up = (lane & M) != 0; const float keep = up ? part[i + N] : part[i]; const float send = up ? part[i] : part[i + N]; part[i] = keep + __shfl_xor(send, M); }
__device__ __forceinline__ void ph_peer_ffn2(const float* __restrict__ hbuf, const int* __restrict__ eidx, const float* __restrict__ gate,
                                             const bf16* __restrict__ ub, const bf16* __restrict__ vb, const float* __restrict__ gam,
                                             const float* __restrict__ bet, float* __restrict__ out) {
    const int lane0 = threadIdx.x & 63;
    for (int t = blockIdx.x * NWAVE + (threadIdx.x >> 6); t < T_ALL; t += gridDim.x * NWAVE) {
        int lane = lane0; asm volatile("" : "+v"(lane));
        float x[16];
        { const float* xr = hbuf + (size_t)t * D_MODEL + lane * 8;
          const float4 a = *(const float4*)xr, b = *(const float4*)(xr + 4), c = *(const float4*)(xr + 512), d = *(const float4*)(xr + 516);
          x[0] = a.x; x[1] = a.y; x[2] = a.z; x[3] = a.w; x[4] = b.x; x[5] = b.y; x[6] = b.z; x[7] = b.w;
          x[8] = c.x; x[9] = c.y; x[10] = c.z; x[11] = c.w; x[12] = d.x; x[13] = d.y; x[14] = d.z; x[15] = d.w; }
        int ev[2]; float wv[4];
        ev[0] = eidx[(size_t)t * 128 + lane]; ev[1] = eidx[(size_t)t * 128 + 64 + lane];
#pragma unroll
        for (int rd = 0; rd < 4; ++rd) wv[rd] = gate[(size_t)t * 128 + rd * 32 + (lane >> 1)];
#pragma unroll
        for (int rd = 0; rd < 4; ++rd) {
            float part[32];
#pragma unroll
            for (int kb = 0; kb < 8; ++kb) {
                v4u ra[4], rb[4];
#pragma unroll
                for (int k8 = 0; k8 < 4; ++k8) {
                    const int e = __builtin_amdgcn_readlane(ev[rd >> 1], (rd & 1) * 32 + kb * 4 + k8);
                    const bf16* ur = ub + (size_t)e * D_MODEL + lane * 8;
                    ra[k8] = *(const v4u*)ur; rb[k8] = *(const v4u*)(ur + 512);
                }
#pragma unroll
                for (int k8 = 0; k8 < 4; ++k8) part[kb * 4 + k8] = peer_dot16(ra[k8], rb[k8], x);
            }
            PEER_TR_STEP(16, 32) PEER_TR_STEP(8, 16) PEER_TR_STEP(4, 8) PEER_TR_STEP(2, 4) PEER_TR_STEP(1, 2)
            const float hid = part[0] + __shfl_xor(part[0], 1);
            wv[rd] *= gelu_f(hid);
        }
        float acc[16];
#pragma unroll
        for (int j = 0; j < 16; ++j) acc[j] = 0.f;
#pragma unroll
        for (int rd = 0; rd < 4; ++rd) {
#pragma unroll
            for (int kb = 0; kb < 4; ++kb) {
                v4u ra[8], rb[8];
#pragma unroll
                for (int k8 = 0; k8 < 8; ++k8) {
                    const int e = __builtin_amdgcn_readlane(ev[rd >> 1], (rd & 1) * 32 + kb * 8 + k8);
                    const bf16* vr = vb + (size_t)e * D_MODEL + lane * 8;
                    ra[k8] = *(const v4u*)vr; rb[k8] = *(const v4u*)(vr + 512);
                }
#pragma unroll
                for (int k8 = 0; k8 < 8; ++k8) {
                    const float wk = __builtin_bit_cast(float, __builtin_amdgcn_readlane(__builtin_bit_cast(int, wv[rd]), 2 * (kb * 8 + k8)));
                    float u0[8], u1[8]; unpack8(ra[k8], u0); unpack8(rb[k8], u1);
#pragma unroll
                    for (int j = 0; j < 8; ++j) { acc[j] += wk * u0[j]; acc[8 + j] += wk * u1[j]; }
                }
            }
        }
        float s = 0.f;
#pragma unroll
        for (int j = 0; j < 16; ++j) { acc[j] += ALPHA_F * x[j]; s += acc[j]; }
        s = wave_sum(s);
        const float mu = s * (1.0f / 1024.0f);
        float q = 0.f;
#pragma unroll
        for (int j = 0; j < 16; ++j) { acc[j] -= mu; q += acc[j] * acc[j]; }
        q = wave_sum(q);
        const float r = rsqrtf(q * (1.0f / 1024.0f) + LN_EPS);
        float* dst = ((t < T_PROMPT) ? out + OUT_YP + (size_t)t * D_MODEL : out + OUT_YS + (size_t)(t - T_PROMPT) * D_MODEL) + lane * 8;
#pragma unroll
        for (int q4 = 0; q4 < 4; ++q4) {
            const int eo = (q4 >> 1) * 512 + (q4 & 1) * 4;
            const float4 g4 = *(const float4*)(gam + lane * 8 + eo), b4 = *(const float4*)(bet + lane * 8 + eo);
            float4 o; o.x = acc[q4 * 4 + 0] * r * g4.x + b4.x; o.y = acc[q4 * 4 + 1] * r * g4.y + b4.y; o.z = acc[q4 * 4 + 2] * r * g4.z + b4.z; o.w = acc[q4 * 4 + 3] * r * g4.w + b4.w;
            *(float4*)(dst + eo) = o;
        }
    }
}

__device__ __forceinline__ void ph_attn_sample(float* lds, const bf16* __restrict__ qrot_b, const bf16* __restrict__ krot_b, const bf16* __restrict__ projb,
                                               const float* __restrict__ ck, const float* __restrict__ cv, bf16* __restrict__ A1) {
    float (*sq)[64] = (float (*)[64])lds;
    const int w = threadIdx.x >> 6, lane0 = threadIdx.x & 63;
    for (int vb = blockIdx.x; vb < T_SAMPLE * 8 / NWAVE; vb += gridDim.x) {
        int lane = lane0; asm volatile("" : "+v"(lane));
        const int item = vb * NWAVE + w, ts = item >> 3, hd = item & 7, b = ts >> 2, i = ts & 3, t = T_PROMPT + ts;
        __syncthreads();
        sq[w][lane] = bf2f(qrot_b[(size_t)t * ATT_WIDTH + hd * 64 + lane]);
        __syncthreads();
        const int qi = WBUF + i;
        float sc[8];
        float mx = -INFINITY;
#pragma unroll
        for (int slot = 0; slot < 7; ++slot) {
            const int pt = slot < 6 ? (slot >> 1) : (lane < 3 ? lane : 0);
            const int m = slot < 6 ? lane + 64 * (slot & 1) : 128;
            const int kj = qi - (m << (2 * pt));
            const bool valid = (slot < 6 || lane < 3) && kj < WBUF;
            const int kc = kj < WBUF ? kj : WBUF - 1;
            const float* kr = ck + ((size_t)b * WBUF + kc) * ATT_WIDTH + hd * 64;
            float a = 0.f;
#pragma unroll
            for (int c = 0; c < 64; c += 4) { const float4 kv = *(const float4*)(kr + c); a += kv.x * sq[w][c] + kv.y * sq[w][c + 1] + kv.z * sq[w][c + 2] + kv.w * sq[w][c + 3]; }
            const float s = valid ? a * 0.125f : -INFINITY;
            sc[slot] = s; mx = fmaxf(mx, s);
        }
        const int nt7 = lane <= i ? i - lane : i;
        const bool valid7 = lane < i + 3;
        {
            const bf16* kr = krot_b + (size_t)(T_PROMPT + b * DEC_SEQ + nt7) * ATT_WIDTH + hd * 64;
            float a = 0.f;
#pragma unroll
            for (int c = 0; c < 64; c += 8) { float f[8]; unpack8(*(const v4u*)(kr + c), f);
#pragma unroll
                for (int j = 0; j < 8; ++j) a += f[j] * sq[w][c + j]; }
            const float s = valid7 ? a * 0.125f : -INFINITY;
            sc[7] = s; mx = fmaxf(mx, s);
        }
        mx = wave_max(mx);
        float lsum = 0.f;
#pragma unroll
        for (int slot = 0; slot < 8; ++slot) { const float pv = __expf(sc[slot] - mx); sc[slot] = pv; lsum += pv; }
        lsum = wave_sum(lsum);
        float part[64];
#pragma unroll
        for (int c = 0; c < 64; ++c) part[c] = 0.f;
#pragma unroll
        for (int slot = 0; slot < 7; ++slot) {
            const int pt = slot < 6 ? (slot >> 1) : (lane < 3 ? lane : 0);
            const int m = slot < 6 ? lane + 64 * (slot & 1) : 128;
            const int kj = qi - (m << (2 * pt));
            const int kc = kj < WBUF ? kj : WBUF - 1;
            const float pv = sc[slot];
            const float* vr = cv + ((size_t)b * WBUF + kc) * ATT_WIDTH + hd * 64;
#pragma unroll
            for (int c = 0; c < 64; c += 4) { const float4 vv = *(const float4*)(vr + c); part[c] += pv * vv.x; part[c + 1] += pv * vv.y; part[c + 2] += pv * vv.z; part[c + 3] += pv * vv.w; }
        }
        {
            const float pv = sc[7];
            const bf16* vr = projb + (size_t)(T_PROMPT + b * DEC_SEQ + nt7) * NB_LD + NB_V + hd * 64;
#pragma unroll
            for (int c = 0; c < 64; c += 8) { float f[8]; unpack8(*(const v4u*)(vr + c), f);
#pragma unroll
                for (int j = 0; j < 8; ++j) part[c + j] += pv * f[j]; }
        }
        PEER_TR_STEP(32, 32) PEER_TR_STEP(16, 16) PEER_TR_STEP(8, 8) PEER_TR_STEP(4, 4) PEER_TR_STEP(2, 2) PEER_TR_STEP(1, 1)
        A1[(size_t)t * MIX_WIDTH + SSD_WIDTH + hd * 64 + lane] = (bf16)f2bf(part[0] / lsum);
    }
}


__device__ __forceinline__ void cache_copy_slice(const float* __restrict__ ck, const float* __restrict__ cv, float* __restrict__ out, unsigned slice, unsigned lane, unsigned bt0 = 0u, unsigned bt1 = 8u) {
    constexpr unsigned PER_B = (WBUF - DEC_SEQ) * ATT_WIDTH / 4;
    constexpr unsigned TOTAL = 2u * DEC_BATCH * PER_B;
#pragma unroll 1
    for (unsigned bt = bt0; bt < bt1; ++bt) {
        f32x4n v[8]; size_t dsti[8]; bool isv[8]; bool ok[8];
#pragma unroll
        for (int j = 0; j < 8; ++j) {
            const unsigned idx = slice * 4096u + bt * 512u + j * 64u + lane;
            ok[j] = idx < TOTAL;
            const unsigned idc = ok[j] ? idx : 0u;
            const unsigned tb = idc / PER_B, r = idc - tb * PER_B, bb = tb & (DEC_BATCH - 1);
            isv[j] = tb >= DEC_BATCH;
            const size_t srci = (size_t)bb * (WBUF * ATT_WIDTH / 4) + (DEC_SEQ * ATT_WIDTH / 4) + r;
            dsti[j] = (size_t)bb * (WBUF * ATT_WIDTH / 4) + r;
            v[j] = __builtin_nontemporal_load((isv[j] ? (const f32x4n*)cv : (const f32x4n*)ck) + srci);
        }
#pragma unroll
        for (int j = 0; j < 8; ++j) if (ok[j]) __builtin_nontemporal_store(v[j], (f32x4n*)(out + (isv[j] ? OUT_SV : OUT_SK)) + dsti[j]);
    }
}

__device__ __forceinline__ void copy_q_load(const float* __restrict__ ck, const float* __restrict__ cv, unsigned q, unsigned lane, f32x4n (&v)[16]) {
    constexpr unsigned PER_B = (WBUF - DEC_SEQ) * ATT_WIDTH / 4, TOTAL = 2u * DEC_BATCH * PER_B;
#pragma unroll
    for (int j = 0; j < 16; ++j) {
        const unsigned idx = q * 1024u + j * 64u + lane, idc = idx < TOTAL ? idx : 0u;
        const unsigned tb = idc / PER_B, r = idc - tb * PER_B, bb = tb & (DEC_BATCH - 1);
        const size_t srci = (size_t)bb * (WBUF * ATT_WIDTH / 4) + (DEC_SEQ * ATT_WIDTH / 4) + r;
        v[j] = __builtin_nontemporal_load((tb >= DEC_BATCH ? (const f32x4n*)cv : (const f32x4n*)ck) + srci);
    }
}
__device__ __forceinline__ void copy_q_store(float* __restrict__ out, unsigned q, unsigned lane, const f32x4n (&v)[16]) {
    constexpr unsigned PER_B = (WBUF - DEC_SEQ) * ATT_WIDTH / 4, TOTAL = 2u * DEC_BATCH * PER_B;
#pragma unroll
    for (int j = 0; j < 16; ++j) {
        const unsigned idx = q * 1024u + j * 64u + lane;
        if (idx < TOTAL) {
            const unsigned tb = idx / PER_B, r = idx - tb * PER_B, bb = tb & (DEC_BATCH - 1);
            const size_t dsti = (size_t)bb * (WBUF * ATT_WIDTH / 4) + r;
            __builtin_nontemporal_store(v[j], (f32x4n*)(out + (tb >= DEC_BATCH ? OUT_SV : OUT_SK)) + dsti);
        }
    }
}
typedef float f32x2v __attribute__((ext_vector_type(2)));
typedef unsigned u32x6 __attribute__((ext_vector_type(6)));
typedef float f32x32 __attribute__((ext_vector_type(32)));
typedef float f32x16q __attribute__((ext_vector_type(16)));
struct __attribute__((aligned(4))) u3w { unsigned x, y, z; };
#define PEER_ROWB 768
#define QSPLIT 8192
__device__ __forceinline__ void ph_quant_tables(const float* __restrict__ pu, const float* __restrict__ pv, unsigned char* __restrict__ ub8, unsigned char* __restrict__ vb8,
                                                float* __restrict__ usc, float* __restrict__ vsc, int rank, int nranks, int row0 = 0, int row1 = 2 * 16384) {
    const int lane = threadIdx.x & 63;
#pragma unroll 2
    for (int row = row0 + rank * NWAVE + (threadIdx.x >> 6); row < row1; row += nranks * NWAVE) {
        const int rr = row & 16383; const bool isv = row >= 16384;
        const float* src = (isv ? pv : pu) + (size_t)rr * D_MODEL + lane * 8;
        const float4 a = *(const float4*)src, b = *(const float4*)(src + 4), c = *(const float4*)(src + 512), d = *(const float4*)(src + 516);
        float am = fmaxf(fmaxf(fmaxf(fabsf(a.x), fabsf(a.y)), fmaxf(fabsf(a.z), fabsf(a.w))), fmaxf(fmaxf(fabsf(b.x), fabsf(b.y)), fmaxf(fabsf(b.z), fabsf(b.w))));
        am = fmaxf(am, fmaxf(fmaxf(fmaxf(fabsf(c.x), fabsf(c.y)), fmaxf(fabsf(c.z), fabsf(c.w))), fmaxf(fmaxf(fabsf(d.x), fabsf(d.y)), fmaxf(fabsf(d.z), fabsf(d.w)))));
        am = wave_max(am);
        const float sc = am > 0.f ? 7.5f / am : 1.0f;
        f32x16q e0, e1;
#pragma unroll
        for (int i = 0; i < 16; ++i) { e0[i] = 0.f; e1[i] = 0.f; }
        e0[0] = a.x * sc; e1[0] = a.y * sc; e0[1] = a.z * sc; e1[1] = a.w * sc; e0[2] = b.x * sc; e1[2] = b.y * sc; e0[3] = b.z * sc; e1[3] = b.w * sc;
        e0[4] = c.x * sc; e1[4] = c.y * sc; e0[5] = c.z * sc; e1[5] = c.w * sc; e0[6] = d.x * sc; e1[6] = d.y * sc; e0[7] = d.z * sc; e1[7] = d.w * sc;
        const u32x6 qv = __builtin_amdgcn_cvt_scalef32_2xpk16_fp6_f32(e0, e1, 1.0f);
        u3w o; o.x = qv[0]; o.y = qv[1]; o.z = qv[2];
        *(u3w*)((isv ? vb8 : ub8) + (size_t)rr * PEER_ROWB + lane * 12) = o;
        if (lane == 0) (isv ? vsc : usc)[rr] = am > 0.f ? am * (1.0f / 7.5f) : 1.0f;
    }
}
__device__ __forceinline__ void unpack16_fp8(const v4u w, float (&f)[16]) {
#pragma unroll
    for (int i = 0; i < 4; ++i) {
        const f32x2v lo = __builtin_amdgcn_cvt_pk_f32_fp8((int)w[i], false), hi = __builtin_amdgcn_cvt_pk_f32_fp8((int)w[i], true);
        f[4 * i] = lo[0]; f[4 * i + 1] = lo[1]; f[4 * i + 2] = hi[0]; f[4 * i + 3] = hi[1];
    }
}
__device__ __forceinline__ unsigned ffn_slice(unsigned n9, unsigned it) {
    const unsigned w = (unsigned)__builtin_amdgcn_readfirstlane(threadIdx.x >> 6), wgl = blockIdx.x * NWAVE + w;
    if (gridDim.x != 256) return n9 + wgl + it * (gridDim.x * NWAVE);
    unsigned v;
    if (w < 2u) { if (it == 0u) v = 0u; else if (it == 4u) v = 1u; else return 0xffffffffu; }
    else { if ((it & 1u) == 0u && it < 8u) v = it >> 1; else return 0xffffffffu; }
    if (v < 2u) return n9 + v * 2048u + wgl;
    const unsigned lw = blockIdx.x * 6u + (w - 2u);
    return n9 + 4096u + (v - 2u) * 1536u + lw;
}
__device__ __forceinline__ unsigned ffn_half(unsigned n9, unsigned it) {
    const unsigned w = (unsigned)__builtin_amdgcn_readfirstlane(threadIdx.x >> 6);
    if (gridDim.x != 256 || w >= 2u || it != 7u) return 0xffffffffu;
    const unsigned hw = blockIdx.x * 2u + w;
    return ((n9 + 7168u + (hw >> 1)) << 1) | (hw & 1u);
}
__device__ __forceinline__ void ph_peer_ffn3(const bf16* __restrict__ hb, const int* __restrict__ eidx, const float* __restrict__ gate,
                                             const unsigned char* __restrict__ ub8, const unsigned char* __restrict__ vb8, const float* __restrict__ usc, const float* __restrict__ vsc,
                                             const float* __restrict__ gam, const float* __restrict__ bet, float* __restrict__ out,
                                             const float* __restrict__ ck, const float* __restrict__ cv, unsigned n9) {
    const int lane0 = threadIdx.x & 63;
    unsigned it = 0;
    for (;; ++it) {
        const int t = token_of_iter((int)it);
        if (t < 0) break;
        int lane = lane0; asm volatile("" : "+v"(lane));
        { const unsigned sl = ffn_slice(n9, it); if (sl < 16384u) cache_copy_slice(ck, cv, out, sl, (unsigned)lane);
          const unsigned hc = ffn_half(n9, it); if (hc != 0xffffffffu) cache_copy_slice(ck, cv, out, hc >> 1, (unsigned)lane, 4u * (hc & 1u), 4u * (hc & 1u) + 4u); }
        const unsigned lo12 = (unsigned)lane * 12u, lo8 = (unsigned)lane * 8u;
        float x[16];
        { float f0[8], f1[8]; const bf16* xr = hb + (size_t)t * D_MODEL + lo8; unpack8(*(const v4u*)xr, f0); unpack8(*(const v4u*)(xr + 512), f1);
#pragma unroll
          for (int j = 0; j < 8; ++j) { x[j] = f0[j]; x[8 + j] = f1[j]; } }
        int ev[2]; float wv[4], su[4];
        ev[0] = eidx[(size_t)t * 128 + lane] & 0x3FFF; ev[1] = eidx[(size_t)t * 128 + 64 + lane] & 0x3FFF;
#pragma unroll
        for (int rd = 0; rd < 4; ++rd) {
            const unsigned pk = (unsigned)eidx[(size_t)t * 128 + rd * 32 + (lane >> 1)];
            const int er = (int)(pk & 0x3FFFu);
            wv[rd] = __builtin_bit_cast(float, pk & 0xFFFFC000u) * vsc[er];
            su[rd] = usc[er];
        }
#pragma unroll
        for (int rd = 0; rd < 4; ++rd) {
            float part[32];
#pragma unroll
            for (int kb = 0; kb < 2; ++kb) {
                u3w ra[16];
#pragma unroll
                for (int k8 = 0; k8 < 16; ++k8) {
                    const int e = __builtin_amdgcn_readlane(ev[rd >> 1], (rd & 1) * 32 + kb * 16 + k8);
                    ra[k8] = *(const u3w*)(ub8 + (size_t)e * PEER_ROWB + lo12);
                }
#pragma unroll
                for (int k8 = 0; k8 < 16; k8 += 2) {
                    u32x6 sv; sv[0] = ra[k8].x; sv[1] = ra[k8].y; sv[2] = ra[k8].z; sv[3] = ra[k8 + 1].x; sv[4] = ra[k8 + 1].y; sv[5] = ra[k8 + 1].z;
                    const f32x32 f = __builtin_amdgcn_cvt_scalef32_pk32_f32_fp6(sv, 1.0f);
                    f32x2v d0 = {0.f, 0.f}, d1 = {0.f, 0.f};
#pragma unroll
                    for (int i = 0; i < 8; ++i) {
                        d0 += (f32x2v){f[2 * i], f[2 * i + 1]} * (f32x2v){x[2 * i], x[2 * i + 1]};
                        d1 += (f32x2v){f[16 + 2 * i], f[17 + 2 * i]} * (f32x2v){x[2 * i], x[2 * i + 1]};
                    }
                    part[kb * 16 + k8] = d0[0] + d0[1]; part[kb * 16 + k8 + 1] = d1[0] + d1[1];
                    __builtin_amdgcn_sched_barrier(0);
                }
            }
            PEER_TR_STEP(16, 32) PEER_TR_STEP(8, 16) PEER_TR_STEP(4, 8) PEER_TR_STEP(2, 4) PEER_TR_STEP(1, 2)
            const float hid = (part[0] + __shfl_xor(part[0], 1)) * su[rd];
            wv[rd] *= gelu_f(hid);
        }
        f32x2v accp[8];
#pragma unroll
        for (int i = 0; i < 8; ++i) accp[i] = (f32x2v){0.f, 0.f};
#pragma unroll
        for (int rd = 0; rd < 4; ++rd) {
#pragma unroll
            for (int kb = 0; kb < 2; ++kb) {
                u3w ra[16];
#pragma unroll
                for (int k8 = 0; k8 < 16; ++k8) {
                    const int e = __builtin_amdgcn_readlane(ev[rd >> 1], (rd & 1) * 32 + kb * 16 + k8);
                    ra[k8] = *(const u3w*)(vb8 + (size_t)e * PEER_ROWB + lo12);
                }
#pragma unroll
                for (int k8 = 0; k8 < 16; k8 += 2) {
                    const float wk0 = __builtin_bit_cast(float, __builtin_amdgcn_readlane(__builtin_bit_cast(int, wv[rd]), 2 * (kb * 16 + k8)));
                    const float wk1 = __builtin_bit_cast(float, __builtin_amdgcn_readlane(__builtin_bit_cast(int, wv[rd]), 2 * (kb * 16 + k8 + 1)));
                    u32x6 sv; sv[0] = ra[k8].x; sv[1] = ra[k8].y; sv[2] = ra[k8].z; sv[3] = ra[k8 + 1].x; sv[4] = ra[k8 + 1].y; sv[5] = ra[k8 + 1].z;
                    const f32x32 f = __builtin_amdgcn_cvt_scalef32_pk32_f32_fp6(sv, 1.0f);
#pragma unroll
                    for (int i = 0; i < 8; ++i) {
                        accp[i] += (f32x2v){wk0, wk0} * (f32x2v){f[2 * i], f[2 * i + 1]};
                        accp[i] += (f32x2v){wk1, wk1} * (f32x2v){f[16 + 2 * i], f[17 + 2 * i]};
                    }
                    __builtin_amdgcn_sched_barrier(0);
                }
            }
        }
        float acc[16];
#pragma unroll
        for (int i = 0; i < 8; ++i) { acc[2 * i] = accp[i][0]; acc[2 * i + 1] = accp[i][1]; }
        float s = 0.f;
#pragma unroll
        for (int j = 0; j < 16; ++j) { acc[j] += ALPHA_F * x[j]; s += acc[j]; }
        s = wave_sum(s);
        const float mu = s * (1.0f / 1024.0f);
        float q = 0.f;
#pragma unroll
        for (int j = 0; j < 16; ++j) { acc[j] -= mu; q += acc[j] * acc[j]; }
        q = wave_sum(q);
        const float r = rsqrtf(q * (1.0f / 1024.0f) + LN_EPS);
        float* dst = ((t < T_PROMPT) ? out + OUT_YP + (size_t)t * D_MODEL : out + OUT_YS + (size_t)(t - T_PROMPT) * D_MODEL) + lo8;
#pragma unroll
        for (int q4 = 0; q4 < 4; ++q4) {
            const int eo = (q4 >> 1) * 512 + (q4 & 1) * 4;
            const float4 g4 = *(const float4*)(gam + lo8 + eo), b4 = *(const float4*)(bet + lo8 + eo);
            float4 o; o.x = acc[q4 * 4 + 0] * r * g4.x + b4.x; o.y = acc[q4 * 4 + 1] * r * g4.y + b4.y; o.z = acc[q4 * 4 + 2] * r * g4.z + b4.z; o.w = acc[q4 * 4 + 3] * r * g4.w + b4.w;
            *(float4*)(dst + eo) = o;
        }
    }
    for (;; ++it) {
        if (gridDim.x == 256 && it >= 5u) break;
        const unsigned sl = ffn_slice(n9, it);
        if (gridDim.x != 256 && sl >= 16384u) break;
        if (sl < 16384u) cache_copy_slice(ck, cv, out, sl, (unsigned)lane0);
    }
}


__device__ __forceinline__ void ssd_decode_load(const bf16* __restrict__ xbc_b, const float* __restrict__ dtv, const float* __restrict__ state_ssm, int item, int p, int ng,
                                                float (&hs)[16], v4u (&bq)[4][2], v4u (&cq)[4][2], float (&xv)[4], float (&dv)[4]) {
    const int sb = item / SSD_HEADS, h = item - sb * SSD_HEADS, g = h / 6, t0 = T_PROMPT + sb * DEC_SEQ;
    const float* s0 = state_ssm + (((size_t)sb * SSD_HEADS + h) * 64 + p) * 128 + ng * 16;
#pragma unroll
    for (int j = 0; j < 4; ++j) { const float4 v = *(const float4*)(s0 + 4 * j); hs[4 * j] = v.x; hs[4 * j + 1] = v.y; hs[4 * j + 2] = v.z; hs[4 * j + 3] = v.w; }
#pragma unroll
    for (int s = 0; s < 4; ++s) {
        const bf16* row = xbc_b + (size_t)(t0 + s) * CONV_DIM;
        bq[s][0] = *(const v4u*)(row + 1536 + g * 128 + ng * 16); bq[s][1] = *(const v4u*)(row + 1536 + g * 128 + ng * 16 + 8);
        cq[s][0] = *(const v4u*)(row + 2048 + g * 128 + ng * 16); cq[s][1] = *(const v4u*)(row + 2048 + g * 128 + ng * 16 + 8);
        xv[s] = bf2f(row[h * 64 + p]); dv[s] = dtv[(size_t)(t0 + s) * SSD_HEADS + h];
    }
}
__device__ __forceinline__ void ssd_decode_compute(const float* __restrict__ a_log, const float* __restrict__ d_skip, int item, int p, int ng,
                                                   float (&hs)[16], const v4u (&bq)[4][2], const v4u (&cq)[4][2], const float (&xv)[4], const float (&dv)[4],
                                                   float* __restrict__ ybuf, float* __restrict__ out) {
    const int sb = item / SSD_HEADS, h = item - sb * SSD_HEADS, t0 = T_PROMPT + sb * DEC_SEQ;
    const float A = -__expf(a_log[h]), D = d_skip[h];
#pragma unroll
    for (int s = 0; s < 4; ++s) {
        float Bf[16], Cf[16];
        { float t8[8]; unpack8(bq[s][0], t8);
#pragma unroll
          for (int j = 0; j < 8; ++j) Bf[j] = t8[j];
          unpack8(bq[s][1], t8);
#pragma unroll
          for (int j = 0; j < 8; ++j) Bf[8 + j] = t8[j];
          unpack8(cq[s][0], t8);
#pragma unroll
          for (int j = 0; j < 8; ++j) Cf[j] = t8[j];
          unpack8(cq[s][1], t8);
#pragma unroll
          for (int j = 0; j < 8; ++j) Cf[8 + j] = t8[j]; }
        const float a = __expf(dv[s] * A), xdt = xv[s] * dv[s];
        float y = 0.f;
#pragma unroll
        for (int j = 0; j < 16; ++j) { hs[j] = a * hs[j] + xdt * Bf[j]; y += Cf[j] * hs[j]; }
        y += __shfl_xor(y, 1); y += __shfl_xor(y, 2); y += __shfl_xor(y, 4);
        if (ng == 0) ybuf[(size_t)(t0 + s) * MIX_WIDTH + h * 64 + p] = y + D * xv[s];
    }
    float* so = out + OUT_SS + (((size_t)sb * SSD_HEADS + h) * 64 + p) * 128 + ng * 16;
#pragma unroll
    for (int j = 0; j < 4; ++j) *(float4*)(so + 4 * j) = make_float4(hs[4 * j], hs[4 * j + 1], hs[4 * j + 2], hs[4 * j + 3]);
}
__device__ __forceinline__ void ph_ssd_decode(const bf16* __restrict__ xbc_b, const float* __restrict__ dtv, const float* __restrict__ a_log, const float* __restrict__ d_skip,
                                              const float* __restrict__ state_ssm, float* __restrict__ ybuf, float* __restrict__ out) {
    const int tid = threadIdx.x, p = tid >> 3, ng = tid & 7;
    constexpr int NITEM = DEC_BATCH * SSD_HEADS;
    for (int it = blockIdx.x; it < NITEM; it += 2 * gridDim.x) {
        const int it2 = it + gridDim.x; const bool has2 = it2 < NITEM; const int it2c = has2 ? it2 : it;
        float hsA[16], hsB[16], xA[4], xB[4], dA[4], dB[4]; v4u bA[4][2], cA[4][2], bB[4][2], cB[4][2];
        ssd_decode_load(xbc_b, dtv, state_ssm, it, p, ng, hsA, bA, cA, xA, dA);
        ssd_decode_load(xbc_b, dtv, state_ssm, it2c, p, ng, hsB, bB, cB, xB, dB);
        ssd_decode_compute(a_log, d_skip, it, p, ng, hsA, bA, cA, xA, dA, ybuf, out);
        if (has2) ssd_decode_compute(a_log, d_skip, it2, p, ng, hsB, bB, cB, xB, dB, ybuf, out);
    }
}

__device__ __forceinline__ float samp_cw(int d) { return (float)((int)(d >= 0 && d <= 128) + (int)(d >= 0 && (d & 3) == 0 && d <= 512) + (int)(d >= 0 && (d & 15) == 0 && d <= 2048)); }
__device__ __forceinline__ void samp_update(float sv, float cw, const float (&vrow)[64], float& m, float& l, float (&part)[64]) {
    const float mn = fmaxf(m, sv), alpha = __expf(m - mn), p = cw * __expf(sv - mn);
    m = mn; l = l * alpha + p;
#pragma unroll
    for (int c = 0; c < 64; ++c) part[c] = part[c] * alpha + p * vrow[c];
}
__device__ __forceinline__ void ph_attn_sample3(float* lds, const bf16* __restrict__ qrot_b, const bf16* __restrict__ krot_b, const bf16* __restrict__ projb,
                                                const float* __restrict__ ck, const float* __restrict__ cv, bf16* __restrict__ A1) {
    const int lane0 = threadIdx.x & 63, w = __builtin_amdgcn_readfirstlane(threadIdx.x >> 6);
    float* sq = lds + w * 256;
    for (int item = blockIdx.x + gridDim.x * w; item < DEC_BATCH * ATT_HEADS; item += gridDim.x * NWAVE) {
        int lane = lane0; asm volatile("" : "+v"(lane));
        const int b = item >> 3, hd = item & 7, qi = lane & 3, g = lane >> 2;
        const int tq0 = T_PROMPT + b * DEC_SEQ;
#pragma unroll
        for (int i = 0; i < 4; ++i) sq[i * 64 + lane] = bf2f(qrot_b[(size_t)(tq0 + i) * ATT_WIDTH + hd * 64 + lane]);
        asm volatile("s_waitcnt lgkmcnt(0)" ::: "memory");
        const float* qv = sq + qi * 64;
        const float* ckb = ck + (size_t)b * WBUF * ATT_WIDTH + hd * 64; const float* cvb = cv + (size_t)b * WBUF * ATT_WIDTH + hd * 64;
        float m = -1e30f, l = 0.f, part[64];
#pragma unroll
        for (int c = 0; c < 64; ++c) part[c] = 0.f;
        {
            const int P = 2051 - g;
            const float cw = samp_cw(WBUF + qi - P);
            const bool isn = P >= WBUF;
            const int nt = isn ? P - WBUF : 0, Pc = isn ? WBUF - 1 : P;
            const bf16* kn = krot_b + (size_t)(tq0 + nt) * ATT_WIDTH + hd * 64; const float* kr = ckb + (size_t)Pc * ATT_WIDTH;
            float a = 0.f;
#pragma unroll
            for (int c = 0; c < 64; c += 8) { float f[8]; unpack8(*(const v4u*)(kn + c), f); const float4 k0 = *(const float4*)(kr + c), k1 = *(const float4*)(kr + c + 4);
                a += (isn ? f[0] : k0.x) * qv[c] + (isn ? f[1] : k0.y) * qv[c + 1] + (isn ? f[2] : k0.z) * qv[c + 2] + (isn ? f[3] : k0.w) * qv[c + 3]
                   + (isn ? f[4] : k1.x) * qv[c + 4] + (isn ? f[5] : k1.y) * qv[c + 5] + (isn ? f[6] : k1.z) * qv[c + 6] + (isn ? f[7] : k1.w) * qv[c + 7]; }
            const float sv = cw > 0.f ? a * 0.125f : -1e30f;
            const bf16* vn = projb + (size_t)(tq0 + nt) * NB_LD + NB_V + hd * 64; const float* vr = cvb + (size_t)Pc * ATT_WIDTH;
            float vrow[64];
#pragma unroll
            for (int c = 0; c < 64; c += 8) { float f[8]; unpack8(*(const v4u*)(vn + c), f); const float4 v0 = *(const float4*)(vr + c), v1 = *(const float4*)(vr + c + 4);
                vrow[c] = isn ? f[0] : v0.x; vrow[c + 1] = isn ? f[1] : v0.y; vrow[c + 2] = isn ? f[2] : v0.z; vrow[c + 3] = isn ? f[3] : v0.w;
                vrow[c + 4] = isn ? f[4] : v1.x; vrow[c + 5] = isn ? f[5] : v1.y; vrow[c + 6] = isn ? f[6] : v1.z; vrow[c + 7] = isn ? f[7] : v1.w; }
            samp_update(sv, cw, vrow, m, l, part);
        }
#pragma unroll 1
        for (int s = 1; s < 21; ++s) {
            const int P = s < 9 ? 2051 - (16 * s + g) : (s < 15 ? 1536 + 64 * (s - 9) + lane : qi + 16 * (16 * (s - 15) + g));
            const float cw = (s < 9 && P < 1920) ? 0.f : samp_cw(WBUF + qi - P);
            const float* kr = ckb + (size_t)P * ATT_WIDTH;
            float a = 0.f;
#pragma unroll
            for (int c = 0; c < 64; c += 4) { const float4 kv = *(const float4*)(kr + c); a += kv.x * qv[c] + kv.y * qv[c + 1] + kv.z * qv[c + 2] + kv.w * qv[c + 3]; }
            const float sv = cw > 0.f ? a * 0.125f : -1e30f;
            __builtin_amdgcn_sched_barrier(0);
            const float* vr = cvb + (size_t)P * ATT_WIDTH;
            float vrow[64];
#pragma unroll
            for (int c = 0; c < 64; c += 4) { const float4 vv = *(const float4*)(vr + c); vrow[c] = vv.x; vrow[c + 1] = vv.y; vrow[c + 2] = vv.z; vrow[c + 3] = vv.w; }
            samp_update(sv, cw, vrow, m, l, part);
        }
        float M = m;
        M = fmaxf(M, __shfl_xor(M, 4)); M = fmaxf(M, __shfl_xor(M, 8)); M = fmaxf(M, __shfl_xor(M, 16)); M = fmaxf(M, __shfl_xor(M, 32));
        const float sc = __expf(m - M);
        float lsum = l * sc;
        lsum += __shfl_xor(lsum, 4); lsum += __shfl_xor(lsum, 8); lsum += __shfl_xor(lsum, 16); lsum += __shfl_xor(lsum, 32);
#pragma unroll
        for (int c = 0; c < 64; ++c) part[c] *= sc;
        PEER_TR_STEP(32, 32) PEER_TR_STEP(16, 16) PEER_TR_STEP(8, 8) PEER_TR_STEP(4, 4)
        const float inv = 1.0f / lsum;
        *(uint2*)(A1 + (size_t)(tq0 + qi) * MIX_WIDTH + SSD_WIDTH + hd * 64 + 4 * g) = make_uint2(pk2(part[0] * inv, part[1] * inv), pk2(part[2] * inv, part[3] * inv));
    }
}

typedef float f32x16 __attribute__((ext_vector_type(16)));
typedef short s16x8 __attribute__((ext_vector_type(8)));
typedef short s16x4 __attribute__((ext_vector_type(4)));
typedef float f32x4v __attribute__((ext_vector_type(4)));
#define SSD_L_ACS 0
#define SSD_L_DTS 3072
#define SSD_L_BM 6144
#define SSD_RS_B 272
#define SSD_L_X (6144 + 128 * 272)
#define SSD_RS_X 144
#define SSD_XIMG (128 * 144)
#define SSD_RS_Y 784
template <int OFF0, int OFF1>
__device__ __forceinline__ s16x8 tr_frag(unsigned base) {
    s16x4 a, b;
    asm volatile("ds_read_b64_tr_b16 %0, %2 offset:%3\n\tds_read_b64_tr_b16 %1, %2 offset:%4\n\ts_waitcnt lgkmcnt(0)"
                 : "=&v"(a), "=&v"(b) : "v"(base), "n"(OFF0), "n"(OFF1) : "memory");
    return __builtin_shufflevector(a, b, 0, 1, 2, 3, 4, 5, 6, 7);
}
__device__ __forceinline__ unsigned lds_addr(LAS unsigned char* p) { return (unsigned)(size_t)p; }
template <int O0, int O1, int O2, int O3, int O4, int O5, int O6, int O7>
__device__ __forceinline__ void tr_read8(unsigned base, s16x4 (&v)[8]) {
    asm volatile("ds_read_b64_tr_b16 %0, %8 offset:%9\n\tds_read_b64_tr_b16 %1, %8 offset:%10\n\tds_read_b64_tr_b16 %2, %8 offset:%11\n\tds_read_b64_tr_b16 %3, %8 offset:%12\n\t"
                 "ds_read_b64_tr_b16 %4, %8 offset:%13\n\tds_read_b64_tr_b16 %5, %8 offset:%14\n\tds_read_b64_tr_b16 %6, %8 offset:%15\n\tds_read_b64_tr_b16 %7, %8 offset:%16\n\ts_waitcnt lgkmcnt(0)"
                 : "=&v"(v[0]), "=&v"(v[1]), "=&v"(v[2]), "=&v"(v[3]), "=&v"(v[4]), "=&v"(v[5]), "=&v"(v[6]), "=&v"(v[7])
                 : "v"(base), "n"(O0), "n"(O1), "n"(O2), "n"(O3), "n"(O4), "n"(O5), "n"(O6), "n"(O7) : "memory");
}
#define TRCAT(a, b) __builtin_shufflevector(a, b, 0, 1, 2, 3, 4, 5, 6, 7)


__device__ __forceinline__ void ssd_chunk_acs(LAS unsigned char* ldsb, const float* __restrict__ dtv, const float* __restrict__ a_log, int t0, int g, float* cdec_out) {
    const int w = __builtin_amdgcn_readfirstlane(threadIdx.x >> 6), lane = threadIdx.x & 63;
    if (w < 6) {
        const int head = 6 * g + w;
        const float A = -__expf(a_log[head]);
        const float v0 = dtv[(size_t)(t0 + 2 * lane) * SSD_HEADS + head], v1 = dtv[(size_t)(t0 + 2 * lane + 1) * SSD_HEADS + head];
        const float a1 = v1 * A;
        float s = v0 * A + a1;
#pragma unroll
        for (int o = 1; o < 64; o <<= 1) { const float tmp = __shfl_up(s, o); if (lane >= o) s += tmp; }
        LAS float* acs = (LAS float*)(ldsb + SSD_L_ACS) + w * 128;
        LAS float* dts = (LAS float*)(ldsb + SSD_L_DTS) + w * 128;
        acs[2 * lane] = s - a1; acs[2 * lane + 1] = s;
        dts[2 * lane] = v0; dts[2 * lane + 1] = v1;
        if (cdec_out && lane == 63) cdec_out[head] = __expf(s);
    }
}

__device__ __forceinline__ void ph_ssd_states(LAS unsigned char* ldsb, const bf16* __restrict__ xbc_b, const float* __restrict__ dtv, const float* __restrict__ a_log,
                                              bf16* __restrict__ Sbuf, float* __restrict__ cdec, const float* __restrict__ ck, const float* __restrict__ cv, float* __restrict__ out) {
    const int tid = threadIdx.x, w = __builtin_amdgcn_readfirstlane(tid >> 6), lane = tid & 63;
    const int r = lane & 31, h = lane >> 5, blk = (lane >> 4) & 1, q = (lane & 15) >> 2, pp = lane & 3;
    const int nt = w & 3, pt = w >> 2;
    for (int unit = blockIdx.x; unit < BATCH * 64 * SSD_GROUPS; unit += gridDim.x) {
        const int g = unit & 3, bc = unit >> 2;
        const int t0 = bc * 128;
        __syncthreads();
        ssd_chunk_acs(ldsb, dtv, a_log, t0, g, cdec + (size_t)bc * SSD_HEADS);
#pragma unroll
        for (int it_ = 0; it_ < 4; ++it_) { const int idx = tid + it_ * NTHR; const int row = idx >> 4, ch = idx & 15;
            const v4u v = *(const v4u*)(xbc_b + (size_t)(t0 + row) * CONV_DIM + 1536 + 128 * g + ch * 8);
            *(LAS v4u*)(ldsb + SSD_L_BM + row * SSD_RS_B + ch * 16) = v; }
        __syncthreads();
#pragma unroll
        for (int it_ = 0; it_ < 12; ++it_) { const int idx = tid + it_ * NTHR; const int hh = idx >> 10, rem = idx & 1023, row = rem >> 3, ch = rem & 7;
            const LAS float* acs = (const LAS float*)(ldsb + SSD_L_ACS) + hh * 128; const LAS float* dts = (const LAS float*)(ldsb + SSD_L_DTS) + hh * 128;
            const float wgt = dts[row] * __expf(acs[127] - acs[row]);
            float f[8]; unpack8(*(const v4u*)(xbc_b + (size_t)(t0 + row) * CONV_DIM + (6 * g + hh) * 64 + ch * 8), f);
            v4u o; o.x = pk2(f[0] * wgt, f[1] * wgt); o.y = pk2(f[2] * wgt, f[3] * wgt); o.z = pk2(f[4] * wgt, f[5] * wgt); o.w = pk2(f[6] * wgt, f[7] * wgt);
            *(LAS v4u*)(ldsb + SSD_L_X + hh * SSD_XIMG + row * SSD_RS_X + ch * 16) = o; }
        __syncthreads();
        f32x4n rider[16];
        copy_q_load(ck, cv, 12288u + (unsigned)(unit * NWAVE + w), (unsigned)lane, rider);
        const unsigned abase = lds_addr(ldsb + SSD_L_BM) + (8 * h + q) * SSD_RS_B + (32 * nt + 16 * blk + 4 * pp) * 2;
        s16x8 afr[8];
        { s16x4 av[8];
          tr_read8<0 * SSD_RS_B, 4 * SSD_RS_B, 16 * SSD_RS_B, 20 * SSD_RS_B, 32 * SSD_RS_B, 36 * SSD_RS_B, 48 * SSD_RS_B, 52 * SSD_RS_B>(abase, av);
          afr[0] = TRCAT(av[0], av[1]); afr[1] = TRCAT(av[2], av[3]); afr[2] = TRCAT(av[4], av[5]); afr[3] = TRCAT(av[6], av[7]);
          tr_read8<64 * SSD_RS_B, 68 * SSD_RS_B, 80 * SSD_RS_B, 84 * SSD_RS_B, 96 * SSD_RS_B, 100 * SSD_RS_B, 112 * SSD_RS_B, 116 * SSD_RS_B>(abase, av);
          afr[4] = TRCAT(av[0], av[1]); afr[5] = TRCAT(av[2], av[3]); afr[6] = TRCAT(av[4], av[5]); afr[7] = TRCAT(av[6], av[7]); }
#pragma unroll
        for (int hh = 0; hh < 6; ++hh) {
            const unsigned xb = lds_addr(ldsb + SSD_L_X + hh * SSD_XIMG) + (8 * h + q) * SSD_RS_X + (32 * pt + 16 * blk + 4 * pp) * 2;
            f32x16 acc;
#pragma unroll
            for (int i = 0; i < 16; ++i) acc[i] = 0.f;
            { s16x4 xv[8];
              tr_read8<0 * SSD_RS_X, 4 * SSD_RS_X, 16 * SSD_RS_X, 20 * SSD_RS_X, 32 * SSD_RS_X, 36 * SSD_RS_X, 48 * SSD_RS_X, 52 * SSD_RS_X>(xb, xv);
              acc = __builtin_amdgcn_mfma_f32_32x32x16_bf16(afr[0], TRCAT(xv[0], xv[1]), acc, 0, 0, 0);
              acc = __builtin_amdgcn_mfma_f32_32x32x16_bf16(afr[1], TRCAT(xv[2], xv[3]), acc, 0, 0, 0);
              acc = __builtin_amdgcn_mfma_f32_32x32x16_bf16(afr[2], TRCAT(xv[4], xv[5]), acc, 0, 0, 0);
              acc = __builtin_amdgcn_mfma_f32_32x32x16_bf16(afr[3], TRCAT(xv[6], xv[7]), acc, 0, 0, 0);
              tr_read8<64 * SSD_RS_X, 68 * SSD_RS_X, 80 * SSD_RS_X, 84 * SSD_RS_X, 96 * SSD_RS_X, 100 * SSD_RS_X, 112 * SSD_RS_X, 116 * SSD_RS_X>(xb, xv);
              acc = __builtin_amdgcn_mfma_f32_32x32x16_bf16(afr[4], TRCAT(xv[0], xv[1]), acc, 0, 0, 0);
              acc = __builtin_amdgcn_mfma_f32_32x32x16_bf16(afr[5], TRCAT(xv[2], xv[3]), acc, 0, 0, 0);
              acc = __builtin_amdgcn_mfma_f32_32x32x16_bf16(afr[6], TRCAT(xv[4], xv[5]), acc, 0, 0, 0);
              acc = __builtin_amdgcn_mfma_f32_32x32x16_bf16(afr[7], TRCAT(xv[6], xv[7]), acc, 0, 0, 0); }
            bf16* dst = Sbuf + ((size_t)bc * SSD_HEADS + 6 * g + hh) * 8192 + (size_t)(pt * 8 + 2 * nt) * 512 + r * 8 + 4 * h;
#pragma unroll
            for (int q4 = 0; q4 < 4; ++q4) *(uint2*)(dst + (q4 >> 1) * 512 + (q4 & 1) * 256) = make_uint2(pk2(acc[4 * q4], acc[4 * q4 + 1]), pk2(acc[4 * q4 + 2], acc[4 * q4 + 3]));
        }
        copy_q_store(out, 12288u + (unsigned)(unit * NWAVE + w), (unsigned)lane, rider);
    }
}

__device__ __forceinline__ void ph_ssd_scan(const bf16* __restrict__ Sbuf, const float* __restrict__ cdec, bf16* __restrict__ Hin, float* __restrict__ out, int rank, int nranks) {
    for (int idx = rank * NTHR + threadIdx.x; idx < BATCH * SSD_HEADS * 1024; idx += nranks * NTHR) {
        const int i = idx & 1023, hb = idx >> 10, hd = hb % SSD_HEADS, b = hb / SSD_HEADS;
        float st[8];
#pragma unroll
        for (int j = 0; j < 8; ++j) st[j] = 0.f;
#pragma unroll 8
        for (int c = 0; c < 64; ++c) {
            const size_t base = (((size_t)(b * 64 + c)) * SSD_HEADS + hd) * 8192 + (size_t)i * 8;
            v4u o; o.x = pk2(st[0], st[1]); o.y = pk2(st[2], st[3]); o.z = pk2(st[4], st[5]); o.w = pk2(st[6], st[7]);
            *(v4u*)(Hin + base) = o;
            float s[8]; unpack8(*(const v4u*)(Sbuf + base), s);
            const float a = cdec[(size_t)(b * 64 + c) * SSD_HEADS + hd];
#pragma unroll
            for (int j = 0; j < 8; ++j) st[j] = a * st[j] + s[j];
        }
        const int ln = i & 63, ks = (i >> 6) & 7, pt = i >> 9, p = 32 * pt + (ln & 31), n0 = 16 * ks + 8 * (ln >> 5);
        store8f(out + OUT_PS + (((size_t)b * SSD_HEADS + hd) * 64 + p) * 128 + n0, st);
    }
}

__device__ __forceinline__ void ph_ssd_out(LAS unsigned char* ldsb, const bf16* __restrict__ xbc_b, const bf16* __restrict__ projb, const float* __restrict__ dtv,
                                           const float* __restrict__ a_log, const float* __restrict__ d_skip, const float* __restrict__ norm_g,
                                           const bf16* __restrict__ Hin, bf16* __restrict__ A1) {
    const int tid = threadIdx.x, w = __builtin_amdgcn_readfirstlane(tid >> 6), lane = tid & 63;
    const int r = lane & 31, h = lane >> 5, blk = (lane >> 4) & 1, q = (lane & 15) >> 2, pp = lane & 3;
    const int hs = w >> 2, lt = hs ? 3 - (w & 3) : (w & 3);
    for (int unit = blockIdx.x; unit < BATCH * 64 * SSD_GROUPS; unit += gridDim.x) {
        const int g = unit & 3, bc = unit >> 2;
        const int t0 = bc * 128;
        __syncthreads();
        ssd_chunk_acs(ldsb, dtv, a_log, t0, g, nullptr);
#pragma unroll
        for (int it_ = 0; it_ < 4; ++it_) { const int idx = tid + it_ * NTHR; const int row = idx >> 4, ch = idx & 15;
            const v4u v = *(const v4u*)(xbc_b + (size_t)(t0 + row) * CONV_DIM + 1536 + 128 * g + ch * 8);
            *(LAS v4u*)(ldsb + SSD_L_BM + row * SSD_RS_B + ch * 16) = v; }
#pragma unroll
        for (int it_ = 0; it_ < 12; ++it_) { const int idx = tid + it_ * NTHR; const int hh = idx >> 10, rem = idx & 1023, row = rem >> 3, ch = rem & 7;
            const v4u v = *(const v4u*)(xbc_b + (size_t)(t0 + row) * CONV_DIM + (6 * g + hh) * 64 + ch * 8);
            *(LAS v4u*)(ldsb + SSD_L_X + hh * SSD_XIMG + row * SSD_RS_X + ch * 16) = v; }
        __syncthreads();
        const bf16* cp = xbc_b + (size_t)(t0 + 32 * lt + r) * CONV_DIM + 2048 + 128 * g + 8 * h;
        s16x8 cfr[8];
#pragma unroll
        for (int ks = 0; ks < 8; ++ks) cfr[ks] = *(const s16x8*)(cp + 16 * ks);
        const int lcol = 32 * lt + r;
        const LAS float* acsb = (const LAS float*)(ldsb + SSD_L_ACS) + 3 * hs * 128; const LAS float* dtsb = (const LAS float*)(ldsb + SSD_L_DTS) + 3 * hs * 128;
        const unsigned xb0 = lds_addr(ldsb + SSD_L_X + 3 * hs * SSD_XIMG) + (4 * h + q) * SSD_RS_X + (16 * blk + 4 * pp) * 2;
        unsigned ypk[3][16];
#pragma unroll
        for (int h3 = 0; h3 < 3; ++h3) {
            const LAS float* acs = acsb + h3 * 128; const LAS float* dts = dtsb + h3 * 128;
            const float myacs = acs[lcol];
            const float Dh = d_skip[6 * g + 3 * hs + h3];
            f32x16 y0, y1;
#pragma unroll
            for (int i = 0; i < 16; ++i) { y0[i] = 0.f; y1[i] = 0.f; }
            { const bf16* hp = Hin + ((size_t)bc * SSD_HEADS + 6 * g + 3 * hs + h3) * 8192 + lane * 8;
#pragma unroll
              for (int kh = 0; kh < 2; ++kh) {
                  s16x8 hf0[4], hf1[4];
#pragma unroll
                  for (int ks = 0; ks < 4; ++ks) { hf0[ks] = *(const s16x8*)(hp + (4 * kh + ks) * 512); hf1[ks] = *(const s16x8*)(hp + (8 + 4 * kh + ks) * 512); }
#pragma unroll
                  for (int ks = 0; ks < 4; ++ks) { y0 = __builtin_amdgcn_mfma_f32_32x32x16_bf16(cfr[4 * kh + ks], hf0[ks], y0, 0, 0, 0); y1 = __builtin_amdgcn_mfma_f32_32x32x16_bf16(cfr[4 * kh + ks], hf1[ks], y1, 0, 0, 0); }
                  __builtin_amdgcn_sched_barrier(0);
              } }
#pragma unroll
            for (int q4 = 0; q4 < 4; ++q4) {
                const f32x4v a4 = *(const LAS f32x4v*)(acs + 32 * lt + 8 * q4 + 4 * h);
                const float e0 = __expf(a4[0]), e1 = __expf(a4[1]), e2 = __expf(a4[2]), e3 = __expf(a4[3]);
                y0[4 * q4] *= e0; y0[4 * q4 + 1] *= e1; y0[4 * q4 + 2] *= e2; y0[4 * q4 + 3] *= e3;
                y1[4 * q4] *= e0; y1[4 * q4 + 1] *= e1; y1[4 * q4 + 2] *= e2; y1[4 * q4 + 3] *= e3;
            }
            __builtin_amdgcn_sched_barrier(0);
            for (int st = 0; st <= lt; ++st) {
                f32x16 cb;
#pragma unroll
                for (int i = 0; i < 16; ++i) cb[i] = 0.f;
#pragma unroll
                for (int ks = 0; ks < 8; ++ks) {
                    const s16x8 bfrag = *(const LAS s16x8*)(ldsb + SSD_L_BM + (32 * st + r) * SSD_RS_B + (16 * ks + 8 * h) * 2);
                    cb = __builtin_amdgcn_mfma_f32_32x32x16_bf16(bfrag, cfr[ks], cb, 0, 0, 0);
                }
                __builtin_amdgcn_sched_barrier(0);
                const unsigned xb = xb0 + h3 * SSD_XIMG + st * 32 * SSD_RS_X;
                s16x4 xv[8];
                tr_read8<0, 8 * SSD_RS_X, 64, 8 * SSD_RS_X + 64, 16 * SSD_RS_X, 24 * SSD_RS_X, 16 * SSD_RS_X + 64, 24 * SSD_RS_X + 64>(xb, xv);
#pragma unroll
                for (int kk = 0; kk < 2; ++kk) {
                    const int s0 = 32 * st + 16 * kk + 4 * h;
                    const f32x4v as0 = *(const LAS f32x4v*)(acs + s0), as1 = *(const LAS f32x4v*)(acs + s0 + 8);
                    const f32x4v ds0 = *(const LAS f32x4v*)(dts + s0), ds1 = *(const LAS f32x4v*)(dts + s0 + 8);
                    float wv[8];
#pragma unroll
                    for (int j = 0; j < 8; ++j) {
                        const int s = s0 + 8 * (j >> 2) + (j & 3);
                        const float asj = (j < 4) ? as0[j & 3] : as1[j & 3], dsj = (j < 4) ? ds0[j & 3] : ds1[j & 3];
                        float v = cb[8 * kk + j] * __expf(myacs - asj) * dsj;
                        v = (s <= lcol) ? v : 0.f;
                        v = (s == lcol) ? v + Dh : v;
                        wv[j] = v;
                    }
                    s16x8 afr;
                    { v4u o; o.x = pk2(wv[0], wv[1]); o.y = pk2(wv[2], wv[3]); o.z = pk2(wv[4], wv[5]); o.w = pk2(wv[6], wv[7]); afr = __builtin_bit_cast(s16x8, o); }
                    const s16x8 b0 = kk == 0 ? TRCAT(xv[0], xv[1]) : TRCAT(xv[4], xv[5]);
                    const s16x8 b1 = kk == 0 ? TRCAT(xv[2], xv[3]) : TRCAT(xv[6], xv[7]);
                    y0 = __builtin_amdgcn_mfma_f32_32x32x16_bf16(afr, b0, y0, 0, 0, 0);
                    y1 = __builtin_amdgcn_mfma_f32_32x32x16_bf16(afr, b1, y1, 0, 0, 0);
                    __builtin_amdgcn_sched_barrier(0);
                }
            }
#pragma unroll
            for (int i = 0; i < 8; ++i) { ypk[h3][i] = pk2(y0[2 * i], y0[2 * i + 1]); ypk[h3][8 + i] = pk2(y1[2 * i], y1[2 * i + 1]); }
            __builtin_amdgcn_sched_barrier(0);
        }
        __syncthreads();
        {
            LAS unsigned short* yst = (LAS unsigned short*)(ldsb + SSD_L_X);
#pragma unroll
            for (int h3 = 0; h3 < 3; ++h3)
#pragma unroll
                for (int ptile = 0; ptile < 2; ++ptile)
#pragma unroll
                    for (int i = 0; i < 8; ++i) {
                        const int reg = 2 * i;
                        const int l0 = 32 * lt + (reg & 3) + 8 * (reg >> 2) + 4 * h;
                        const int col = (3 * hs + h3) * 64 + 32 * ptile + r;
                        const unsigned v = ypk[h3][8 * ptile + i];
                        yst[l0 * (SSD_RS_Y / 2) + col] = (unsigned short)(v & 0xffffu);
                        yst[(l0 + 1) * (SSD_RS_Y / 2) + col] = (unsigned short)(v >> 16);
                    }
        }
        __syncthreads();
#pragma unroll
        for (int pass = 0; pass < 4; ++pass) {
            const int l = 4 * (pass * 8 + w) + (lane >> 4), i16 = lane & 15;
            float gv[3][8]; float ss = 0.f;
#pragma unroll
            for (int k = 0; k < 3; ++k) {
                const int col0 = 24 * i16 + 8 * k;
                float yv[8], zv[8];
                unpack8(*(const LAS v4u*)(ldsb + SSD_L_X + l * SSD_RS_Y + col0 * 2), yv);
                unpack8(*(const v4u*)(projb + (size_t)(t0 + l) * NB_LD + g * 384 + col0), zv);
#pragma unroll
                for (int j = 0; j < 8; ++j) { const float gg = yv[j] * silu_f(zv[j]); gv[k][j] = gg; ss += gg * gg; }
            }
            ss += __shfl_xor(ss, 1); ss += __shfl_xor(ss, 2); ss += __shfl_xor(ss, 4); ss += __shfl_xor(ss, 8);
            const float rstd = rsqrtf(ss * (1.0f / 384.0f) + LN_EPS);
#pragma unroll
            for (int k = 0; k < 3; ++k) {
                const int col0 = g * 384 + 24 * i16 + 8 * k;
                const float4 g0 = *(const float4*)(norm_g + col0), g1 = *(const float4*)(norm_g + col0 + 4);
                v4u o; o.x = pk2(gv[k][0] * rstd * g0.x, gv[k][1] * rstd * g0.y); o.y = pk2(gv[k][2] * rstd * g0.z, gv[k][3] * rstd * g0.w);
                o.z = pk2(gv[k][4] * rstd * g1.x, gv[k][5] * rstd * g1.y); o.w = pk2(gv[k][6] * rstd * g1.z, gv[k][7] * rstd * g1.w);
                *(v4u*)(A1 + (size_t)(t0 + l) * MIX_WIDTH + col0) = o;
            }
        }
    }
}

#define ATT_RS_V 144
#define ATT_VIMG (256 * ATT_RS_V)
#define ATT_HIMG (2 * ATT_VIMG)
#define ATT_PVT(KT) { \
        s16x4 vv_[8]; \
        tr_read8<(32 * KT) * ATT_RS_V, (32 * KT + 8) * ATT_RS_V, (32 * KT) * ATT_RS_V + 64, (32 * KT + 8) * ATT_RS_V + 64, \
                 (32 * KT + 16) * ATT_RS_V, (32 * KT + 24) * ATT_RS_V, (32 * KT + 16) * ATT_RS_V + 64, (32 * KT + 24) * ATT_RS_V + 64>(vbase, vv_); \
        _Pragma("unroll") for (int s2_ = 0; s2_ < 2; ++s2_) { \
            v4u o_; o_.x = pk2(s[KT][8 * s2_ + 0], s[KT][8 * s2_ + 1]); o_.y = pk2(s[KT][8 * s2_ + 2], s[KT][8 * s2_ + 3]); \
            o_.z = pk2(s[KT][8 * s2_ + 4], s[KT][8 * s2_ + 5]); o_.w = pk2(s[KT][8 * s2_ + 6], s[KT][8 * s2_ + 7]); \
            const s16x8 pf_ = __builtin_bit_cast(s16x8, o_); \
            const s16x8 a0_ = s2_ == 0 ? TRCAT(vv_[0], vv_[1]) : TRCAT(vv_[4], vv_[5]); \
            const s16x8 a1_ = s2_ == 0 ? TRCAT(vv_[2], vv_[3]) : TRCAT(vv_[6], vv_[7]); \
            o0 = __builtin_amdgcn_mfma_f32_32x32x16_bf16(a0_, pf_, o0, 0, 0, 0); \
            o1 = __builtin_amdgcn_mfma_f32_32x32x16_bf16(a1_, pf_, o1, 0, 0, 0); } }
__device__ __forceinline__ void ph_attn_prompt(LAS unsigned char* ldsb, const bf16* __restrict__ qrot_b, const bf16* __restrict__ krot_b, const bf16* __restrict__ projb,
                                               bf16* __restrict__ obuf, float* __restrict__ lsebuf, const float* __restrict__ ck, const float* __restrict__ cv, float* __restrict__ out) {
    const int tid = threadIdx.x, w = __builtin_amdgcn_readfirstlane(tid >> 6), lane = tid & 63;
    const int r = lane & 31, h = lane >> 5, blk = (lane >> 4) & 1, q = (lane & 15) >> 2, pp = lane & 3;
    const int qt = w & 3, hsel = w >> 2;
    f32x4n rider[16]; bool pend = false; unsigned pq = 0u;
    for (int unit = blockIdx.x; unit < 3 * 512; unit += gridDim.x) {
        const int pat = unit >> 9, rem = unit & 511, hp = rem & 3, rem2 = rem >> 2, b = rem2 >> 6, bk = rem2 & 63;
        const int dsh = 2 * pat, nper = 64 >> dsh, res = bk >> (6 - dsh), nb = bk & (nper - 1);
        const int head = 2 * hp + hsel;
        __syncthreads();
        { v4u vst[8], kst[8];
#pragma unroll
          for (int it_ = 0; it_ < 8; ++it_) { const int idx = (tid & 255) + it_ * 256;
              const int row = idx >> 3, ch = idx & 7, js = 128 * nb - 128 + row, jc = js < 0 ? 0 : js;
              const size_t tk = (size_t)(b * SEQ + (jc << dsh) + res);
              vst[it_] = *(const v4u*)(projb + tk * NB_LD + NB_V + head * 64 + ch * 8);
              kst[it_] = *(const v4u*)(krot_b + tk * ATT_WIDTH + head * 64 + ch * 8); }
#pragma unroll
          for (int it_ = 0; it_ < 8; ++it_) { const int idx = (tid & 255) + it_ * 256;
              const int row = idx >> 3, ch = idx & 7, js = 128 * nb - 128 + row;
              v4u v = vst[it_], k = kst[it_]; if (js < 0) { v.x = 0u; v.y = 0u; v.z = 0u; v.w = 0u; k = v; }
              *(LAS v4u*)(ldsb + hsel * ATT_HIMG + row * ATT_RS_V + ch * 16) = v;
              *(LAS v4u*)(ldsb + hsel * ATT_HIMG + ATT_VIMG + row * ATT_RS_V + ch * 16) = k; } }
        const int tq = b * SEQ + ((128 * nb + 32 * qt + r) << dsh) + res;
        s16x8 qf[4];
#pragma unroll
        for (int ks = 0; ks < 4; ++ks) qf[ks] = *(const s16x8*)(qrot_b + (size_t)tq * ATT_WIDTH + head * 64 + 16 * ks + 8 * h);
        __syncthreads();
        f32x16 s[5];
#pragma unroll
        for (int kt = 0; kt < 5; ++kt) {
            const LAS unsigned char* kp = ldsb + hsel * ATT_HIMG + ATT_VIMG + (32 * qt + 32 * kt + r) * ATT_RS_V + 16 * h;
#pragma unroll
            for (int i = 0; i < 16; ++i) s[kt][i] = 0.f;
#pragma unroll
            for (int ks = 0; ks < 4; ++ks) s[kt] = __builtin_amdgcn_mfma_f32_32x32x16_bf16(*(const LAS s16x8*)(kp + 32 * ks), qf[ks], s[kt], 0, 0, 0);
        }
        if (pend) copy_q_store(out, pq, (unsigned)lane, rider);
        float m = -INFINITY;
#pragma unroll
        for (int kt = 0; kt < 5; ++kt) {
            const bool tile_ok = (nb > 0) || (qt + kt >= 4);
#pragma unroll
            for (int reg = 0; reg < 16; ++reg) {
                const int c = (reg & 3) + 8 * (reg >> 2) + 4 * h;
                const bool ok = tile_ok && (kt == 0 ? (c >= r) : (kt == 4 ? (c <= r) : true));
                const float v = ok ? s[kt][reg] * 0.125f : -INFINITY;
                s[kt][reg] = v; m = fmaxf(m, v);
            }
        }
        m = fmaxf(m, __shfl_xor(m, 32));
        float l = 0.f;
#pragma unroll
        for (int kt = 0; kt < 5; ++kt)
#pragma unroll
            for (int reg = 0; reg < 16; ++reg) { const float p = __expf(s[kt][reg] - m); s[kt][reg] = p; l += p; }
        l += __shfl_xor(l, 32);
        pq = (unsigned)(unit * NWAVE + w); copy_q_load(ck, cv, pq, (unsigned)lane, rider); pend = true;
        f32x16 o0, o1;
#pragma unroll
        for (int i = 0; i < 16; ++i) { o0[i] = 0.f; o1[i] = 0.f; }
        const unsigned vbase = lds_addr(ldsb + hsel * ATT_HIMG) + (32 * qt + 4 * h + q) * ATT_RS_V + (16 * blk + 4 * pp) * 2;
        ATT_PVT(0) ATT_PVT(1) ATT_PVT(2) ATT_PVT(3) ATT_PVT(4)
        const float inv = 1.0f / l;
        bf16* op = obuf + ((size_t)pat * T_PROMPT + tq) * ATT_WIDTH + head * 64 + 8 * h;
#pragma unroll
        for (int k2 = 0; k2 < 4; ++k2) {
            unsigned ax, ay, bx, by;
            if (k2 < 2) { ax = pk2(o0[8 * k2] * inv, o0[8 * k2 + 1] * inv); ay = pk2(o0[8 * k2 + 2] * inv, o0[8 * k2 + 3] * inv);
                          bx = pk2(o0[8 * k2 + 4] * inv, o0[8 * k2 + 5] * inv); by = pk2(o0[8 * k2 + 6] * inv, o0[8 * k2 + 7] * inv); }
            else { const int k3 = k2 - 2;
                   ax = pk2(o1[8 * k3] * inv, o1[8 * k3 + 1] * inv); ay = pk2(o1[8 * k3 + 2] * inv, o1[8 * k3 + 3] * inv);
                   bx = pk2(o1[8 * k3 + 4] * inv, o1[8 * k3 + 5] * inv); by = pk2(o1[8 * k3 + 6] * inv, o1[8 * k3 + 7] * inv); }
            const auto rx = __builtin_amdgcn_permlane32_swap(ax, bx, false, false);
            const auto ry = __builtin_amdgcn_permlane32_swap(ay, by, false, false);
            v4u o; o.x = rx[0]; o.y = ry[0]; o.z = rx[1]; o.w = ry[1];
            *(v4u*)(op + 16 * k2) = o;
        }
        if (h == 0) lsebuf[((size_t)pat * T_PROMPT + tq) * 8 + head] = m + __logf(l);
    }
    if (pend) copy_q_store(out, pq, (unsigned)lane, rider);
}
__device__ __forceinline__ void ph_attn_combine(const bf16* __restrict__ obuf, const float* __restrict__ lsebuf, bf16* __restrict__ A1) {
    const int lane = threadIdx.x & 63;
#pragma unroll 4
    for (int t = blockIdx.x * NWAVE + (threadIdx.x >> 6); t < T_PROMPT; t += gridDim.x * NWAVE) {
        const int hd = lane >> 3;
        const float l0 = lsebuf[((size_t)0 * T_PROMPT + t) * 8 + hd], l1 = lsebuf[((size_t)1 * T_PROMPT + t) * 8 + hd], l2 = lsebuf[((size_t)2 * T_PROMPT + t) * 8 + hd];
        const float mx = fmaxf(l0, fmaxf(l1, l2));
        const float e0 = __expf(l0 - mx), e1 = __expf(l1 - mx), e2 = __expf(l2 - mx);
        const float inv = 1.0f / (e0 + e1 + e2);
        float a[8], b[8], c[8];
        unpack8(*(const v4u*)(obuf + ((size_t)0 * T_PROMPT + t) * ATT_WIDTH + lane * 8), a);
        unpack8(*(const v4u*)(obuf + ((size_t)1 * T_PROMPT + t) * ATT_WIDTH + lane * 8), b);
        unpack8(*(const v4u*)(obuf + ((size_t)2 * T_PROMPT + t) * ATT_WIDTH + lane * 8), c);
        float o[8];
#pragma unroll
        for (int j = 0; j < 8; ++j) o[j] = (e0 * a[j] + e1 * b[j] + e2 * c[j]) * inv;
        v4u w; w.x = pk2(o[0], o[1]); w.y = pk2(o[2], o[3]); w.z = pk2(o[4], o[5]); w.w = pk2(o[6], o[7]);
        *(v4u*)(A1 + (size_t)t * MIX_WIDTH + SSD_WIDTH + lane * 8) = w;
    }
}

#define RT_RS 272
#define RT_KIMG (128 * RT_RS)
#define RT_LUT (2 * RT_KIMG)
constexpr unsigned char RT_CANDS[64] = {0, 1, 2, 3, 4, 5, 6, 7, 8, 9, 10, 11, 12, 13, 14, 15, 16, 17, 18, 19, 20, 21, 22, 23, 32, 33, 34, 35, 36, 48, 49, 50, 51, 64, 65, 66, 80, 81, 96, 97,
                                        112, 113, 128, 144, 160, 176, 192, 208, 224, 240, 0, 0, 0, 0, 0, 0, 0, 0, 0, 0, 0, 0, 0, 0};
__device__ __forceinline__ unsigned rt_mono(float f) { const unsigned u = __builtin_bit_cast(unsigned, f); return u ^ ((unsigned)((int)u >> 31) | 0x80000000u); }
__device__ __forceinline__ float rt_unmono(unsigned m) { const unsigned u = (m & 0x80000000u) ? (m ^ 0x80000000u) : ~m; return __builtin_bit_cast(float, u); }
#define RT_CE_DESC(a, b) { const unsigned x_ = (a), y_ = (b); (a) = x_ > y_ ? x_ : y_; (b) = x_ > y_ ? y_ : x_; }
#define RT_CE_ASC(a, b) { const unsigned x_ = (a), y_ = (b); (a) = x_ > y_ ? y_ : x_; (b) = x_ > y_ ? x_ : y_; }
__device__ __forceinline__ void rt_sort16(unsigned (&v)[16]) {
#pragma unroll
    for (int k = 2; k <= 16; k <<= 1)
#pragma unroll
        for (int j = k >> 1; j > 0; j >>= 1)
#pragma unroll
            for (int i = 0; i < 16; ++i) { const int l = i ^ j; if (l > i) { if ((i & k) == 0) RT_CE_DESC(v[i], v[l]) else RT_CE_ASC(v[i], v[l]) } }
}
__device__ __forceinline__ void rt_merge16(unsigned (&v)[16]) {
#pragma unroll
    for (int j = 8; j > 0; j >>= 1)
#pragma unroll
        for (int i = 0; i < 16; ++i) { const int l = i ^ j; if (l > i) RT_CE_DESC(v[i], v[l]) }
}
__device__ __forceinline__ void rt_top16(unsigned (&a)[16], const unsigned (&b)[16]) {
#pragma unroll
    for (int i = 0; i < 16; ++i) a[i] = a[i] > b[15 - i] ? a[i] : b[15 - i];
    rt_merge16(a);
}
__device__ __forceinline__ void rt_top16_partner(unsigned (&a)[16]) {
    unsigned b[16];
#pragma unroll
    for (int i = 0; i < 16; ++i) b[i] = (unsigned)__shfl_xor((int)a[i], 32);
    rt_top16(a, b);
}
__device__ __forceinline__ void rt_scores_top16(LAS unsigned char* kimg, const bf16* __restrict__ qp, int r, int h, unsigned (&k0)[16]) {
    f32x16 acc[4];
#pragma unroll
    for (int kt = 0; kt < 4; ++kt)
#pragma unroll
        for (int i = 0; i < 16; ++i) acc[kt][i] = 0.f;
#pragma unroll
    for (int ks = 0; ks < 8; ++ks) {
        const s16x8 qf = *(const s16x8*)(qp + 16 * ks);
#pragma unroll
        for (int kt = 0; kt < 4; ++kt) {
            const s16x8 kf = *(const LAS s16x8*)(kimg + (32 * kt + r) * RT_RS + (16 * ks + 8 * h) * 2);
            acc[kt] = __builtin_amdgcn_mfma_f32_32x32x16_bf16(kf, qf, acc[kt], 0, 0, 0);
        }
    }
    unsigned k1[16], k2[16], k3[16];
#pragma unroll
    for (int reg = 0; reg < 16; ++reg) {
        const unsigned ki = (unsigned)((reg & 3) + 8 * (reg >> 2) + 4 * h);
        k0[reg] = (rt_mono(acc[0][reg]) & 0xFFFFFF80u) | ki;
        k1[reg] = (rt_mono(acc[1][reg]) & 0xFFFFFF80u) | (ki + 32u);
        k2[reg] = (rt_mono(acc[2][reg]) & 0xFFFFFF80u) | (ki + 64u);
        k3[reg] = (rt_mono(acc[3][reg]) & 0xFFFFFF80u) | (ki + 96u);
    }
    rt_sort16(k0); rt_sort16(k1); rt_sort16(k2); rt_sort16(k3);
    rt_top16(k0, k1); rt_top16(k2, k3); rt_top16(k0, k2);
    rt_top16_partner(k0);
}
__device__ __forceinline__ void ph_peer_route2(LAS unsigned char* ldsb, const bf16* __restrict__ qhb, const float* __restrict__ keys1, const float* __restrict__ keys2,
                                               int* __restrict__ eidx, float* __restrict__ gate, const float* __restrict__ ck, const float* __restrict__ cv, float* __restrict__ out) {
    const int tid = threadIdx.x, w = __builtin_amdgcn_readfirstlane(tid >> 6), lane = tid & 63, r = lane & 31, h = lane >> 5;
    __syncthreads();
    for (int idx = tid; idx < 2 * 128 * 16; idx += NTHR) {
        const int tb = idx >> 11, rem = idx & 2047, row = rem >> 4, ch = rem & 15;
        const float* sp = (tb ? keys2 : keys1) + row * 128 + ch * 8;
        const float4 a = *(const float4*)sp, b = *(const float4*)(sp + 4);
        v4u o; o.x = pk2(a.x, a.y); o.y = pk2(a.z, a.w); o.z = pk2(b.x, b.y); o.w = pk2(b.z, b.w);
        *(LAS v4u*)(ldsb + tb * RT_KIMG + row * RT_RS + ch * 16) = o;
    }
    __syncthreads();
    LAS unsigned* lut = (LAS unsigned*)(ldsb + RT_LUT) + w * 512;
    for (int k = 0;; ++k) {
        int unit;
        if (gridDim.x != 256) { unit = blockIdx.x * NWAVE + w + k * (int)(gridDim.x * NWAVE); if (unit >= (T_ALL / 32) * 8) break; }
        else if (k < 2) unit = k * 2048 + blockIdx.x * NWAVE + w;
        else if (k == 2 && w == 0 && blockIdx.x < 128) unit = 4096 + (int)blockIdx.x;
        else break;
        const int tt = unit >> 3, hd = unit & 7;
        const int tok = 32 * tt + r;
        const bf16* qp = qhb + (size_t)tok * 2048 + hd * 256 + 8 * h;
        unsigned ka[16], kb[16];
        rt_scores_top16(ldsb, qp, r, h, ka);
        rt_scores_top16(ldsb + RT_KIMG, qp + 128, r, h, kb);
        float v1[16], v2[16];
#pragma unroll
        for (int i = 0; i < 16; ++i) { v1[i] = rt_unmono(ka[i] & 0xFFFFFF80u); v2[i] = rt_unmono(kb[i] & 0xFFFFFF80u); }
#pragma unroll
        for (int wd = 0; wd < 4; ++wd) {
            lut[wd * 64 + lane] = (ka[4 * wd] & 0x7Fu) | ((ka[4 * wd + 1] & 0x7Fu) << 8) | ((ka[4 * wd + 2] & 0x7Fu) << 16) | ((ka[4 * wd + 3] & 0x7Fu) << 24);
            lut[(4 + wd) * 64 + lane] = (kb[4 * wd] & 0x7Fu) | ((kb[4 * wd + 1] & 0x7Fu) << 8) | ((kb[4 * wd + 2] & 0x7Fu) << 16) | ((kb[4 * wd + 3] & 0x7Fu) << 24);
        }
        unsigned c0[16], c1[16];
        c0[0] = (rt_mono(h ? (v1[0] + v2[1]) : (v1[0] + v2[0])) & 0xFFFFFF00u) | (h ? 1u : 0u);
        c0[1] = (rt_mono(h ? (v1[0] + v2[3]) : (v1[0] + v2[2])) & 0xFFFFFF00u) | (h ? 3u : 2u);
        c0[2] = (rt_mono(h ? (v1[0] + v2[5]) : (v1[0] + v2[4])) & 0xFFFFFF00u) | (h ? 5u : 4u);
        c0[3] = (rt_mono(h ? (v1[0] + v2[7]) : (v1[0] + v2[6])) & 0xFFFFFF00u) | (h ? 7u : 6u);
        c0[4] = (rt_mono(h ? (v1[0] + v2[9]) : (v1[0] + v2[8])) & 0xFFFFFF00u) | (h ? 9u : 8u);
        c0[5] = (rt_mono(h ? (v1[0] + v2[11]) : (v1[0] + v2[10])) & 0xFFFFFF00u) | (h ? 11u : 10u);
        c0[6] = (rt_mono(h ? (v1[0] + v2[13]) : (v1[0] + v2[12])) & 0xFFFFFF00u) | (h ? 13u : 12u);
        c0[7] = (rt_mono(h ? (v1[0] + v2[15]) : (v1[0] + v2[14])) & 0xFFFFFF00u) | (h ? 15u : 14u);
        c0[8] = (rt_mono(h ? (v1[1] + v2[1]) : (v1[1] + v2[0])) & 0xFFFFFF00u) | (h ? 17u : 16u);
        c0[9] = (rt_mono(h ? (v1[1] + v2[3]) : (v1[1] + v2[2])) & 0xFFFFFF00u) | (h ? 19u : 18u);
        c0[10] = (rt_mono(h ? (v1[1] + v2[5]) : (v1[1] + v2[4])) & 0xFFFFFF00u) | (h ? 21u : 20u);
        c0[11] = (rt_mono(h ? (v1[1] + v2[7]) : (v1[1] + v2[6])) & 0xFFFFFF00u) | (h ? 23u : 22u);
        c0[12] = (rt_mono(h ? (v1[2] + v2[1]) : (v1[2] + v2[0])) & 0xFFFFFF00u) | (h ? 33u : 32u);
        c0[13] = (rt_mono(h ? (v1[2] + v2[3]) : (v1[2] + v2[2])) & 0xFFFFFF00u) | (h ? 35u : 34u);
        c0[14] = (rt_mono(h ? (v1[3] + v2[0]) : (v1[2] + v2[4])) & 0xFFFFFF00u) | (h ? 48u : 36u);
        c0[15] = (rt_mono(h ? (v1[3] + v2[2]) : (v1[3] + v2[1])) & 0xFFFFFF00u) | (h ? 50u : 49u);
        c1[0] = (rt_mono(h ? (v1[4] + v2[0]) : (v1[3] + v2[3])) & 0xFFFFFF00u) | (h ? 64u : 51u);
        c1[1] = (rt_mono(h ? (v1[4] + v2[2]) : (v1[4] + v2[1])) & 0xFFFFFF00u) | (h ? 66u : 65u);
        c1[2] = (rt_mono(h ? (v1[5] + v2[1]) : (v1[5] + v2[0])) & 0xFFFFFF00u) | (h ? 81u : 80u);
        c1[3] = (rt_mono(h ? (v1[6] + v2[1]) : (v1[6] + v2[0])) & 0xFFFFFF00u) | (h ? 97u : 96u);
        c1[4] = (rt_mono(h ? (v1[7] + v2[1]) : (v1[7] + v2[0])) & 0xFFFFFF00u) | (h ? 113u : 112u);
        c1[5] = (rt_mono(h ? (v1[9] + v2[0]) : (v1[8] + v2[0])) & 0xFFFFFF00u) | (h ? 144u : 128u);
        c1[6] = (rt_mono(h ? (v1[11] + v2[0]) : (v1[10] + v2[0])) & 0xFFFFFF00u) | (h ? 176u : 160u);
        c1[7] = (rt_mono(h ? (v1[13] + v2[0]) : (v1[12] + v2[0])) & 0xFFFFFF00u) | (h ? 208u : 192u);
        c1[8] = (rt_mono(h ? (v1[15] + v2[0]) : (v1[14] + v2[0])) & 0xFFFFFF00u) | (h ? 240u : 224u);
        c1[9] = 0u;
        c1[10] = 0u;
        c1[11] = 0u;
        c1[12] = 0u;
        c1[13] = 0u;
        c1[14] = 0u;
        c1[15] = 0u;
        rt_sort16(c0); rt_sort16(c1); rt_top16(c0, c1); rt_top16_partner(c0);
        float e[16]; float sum = 0.f;
        const float mx = rt_unmono(c0[0] & 0xFFFFFF00u);
#pragma unroll
        for (int k = 0; k < 16; ++k) { e[k] = __expf(rt_unmono(c0[k] & 0xFFFFFF00u) - mx); sum += e[k]; }
        const float inv = 1.0f / sum;
        asm volatile("s_waitcnt lgkmcnt(0)" ::: "memory");
        int ex[8]; float gv[8];
#pragma unroll
        for (int k = 0; k < 8; ++k) {
            const unsigned hm = (unsigned)(-h);
            const unsigned ck = (c0[k] & ~hm) | (c0[8 + k] & hm);
            const float ek = __builtin_bit_cast(float, (__builtin_bit_cast(unsigned, e[k]) & ~hm) | (__builtin_bit_cast(unsigned, e[8 + k]) & hm));
            const unsigned ci = (ck >> 4) & 15u, cj = ck & 15u;
            const unsigned w1 = lut[(ci >> 2) * 64 + lane], w2 = lut[(4 + (cj >> 2)) * 64 + lane];
            const unsigned i1 = (w1 >> (8 * (ci & 3))) & 0x7Fu, i2 = (w2 >> (8 * (cj & 3))) & 0x7Fu;
            ex[k] = (int)(i1 * PEER_NKEYS + i2); gv[k] = ek * inv;
        }
        int* ep = eidx + (size_t)tok * 128 + hd * 16 + 8 * h; float* gp = gate + (size_t)tok * 128 + hd * 16 + 8 * h;
#pragma unroll
        for (int k = 0; k < 8; ++k) ex[k] = (int)(((__builtin_bit_cast(unsigned, gv[k]) + 0x2000u) & 0xFFFFC000u) | (unsigned)ex[k]);
        *(int4*)ep = make_int4(ex[0], ex[1], ex[2], ex[3]); *(int4*)(ep + 4) = make_int4(ex[4], ex[5], ex[6], ex[7]);
        (void)gp;
    }
    if (gridDim.x == 256 && (w != 0 || blockIdx.x >= 128)) {
        const unsigned si = blockIdx.x < 128 ? blockIdx.x * 7u + (unsigned)(w - 1) : 896u + (blockIdx.x - 128u) * 8u + (unsigned)w;
        cache_copy_slice(ck, cv, out, 7040u + si, (unsigned)lane);
    }
}

struct Params {
    const float* in[23];
    float* out;
    unsigned char* ws;
    unsigned* bar;
};

#define WS_BAR      0ull
#define WS_XALL     (1ull << 20)
#define WS_PROJ     (WS_XALL + (size_t)T_ALL * D_MODEL * 4)
#define WS_XBC      (WS_PROJ + (size_t)T_ALL * PROJ_LD * 4)
#define WS_DT       (WS_XBC + (size_t)T_ALL * CONV_DIM * 4)
#define WS_QROT     (WS_DT + (size_t)T_ALL * SSD_HEADS * 4)
#define WS_KROT     (WS_QROT + (size_t)T_ALL * ATT_WIDTH * 4)
#define WS_YBUF     (WS_KROT + (size_t)T_ALL * ATT_WIDTH * 4)
#define WS_MIX      (WS_YBUF + (size_t)T_ALL * MIX_WIDTH * 4)
#define WS_HBUF     (WS_MIX + (size_t)T_ALL * D_MODEL * 4)
#define WS_QH       (WS_HBUF + (size_t)T_ALL * D_MODEL * 4)
#define WS_EIDX     (WS_QH + (size_t)T_ALL * 2048 * 4)
#define WS_GATE     (WS_EIDX + (size_t)T_ALL * 128 * 4)
#define WS_A0       (WS_GATE + (size_t)T_ALL * 128 * 4)
#define WS_A1       (WS_A0 + (size_t)T_ALL * D_MODEL * 2)
#define WS_A2       (WS_A1 + (size_t)T_ALL * MIX_WIDTH * 2)
#define WS_WTIN     (WS_A2 + (size_t)T_ALL * D_MODEL * 2)
#define WS_WTOUT    (WS_WTIN + (size_t)PROJ_LD * D_MODEL * 2)
#define WS_WTQ      (WS_WTOUT + (size_t)D_MODEL * MIX_WIDTH * 2)
#define WS_PROJB    (WS_WTQ + (size_t)2048 * D_MODEL * 2)
#define WS_DTRAW    (WS_PROJB + (size_t)T_ALL * NB_LD * 2)
#define WS_XBCB     (WS_DTRAW + (size_t)T_ALL * 32 * 4)
#define WS_QROTB    (WS_XBCB + (size_t)T_ALL * CONV_DIM * 2)
#define WS_KROTB    (WS_QROTB + (size_t)T_ALL * ATT_WIDTH * 2)
#define WS_UB       (WS_KROTB + (size_t)T_ALL * ATT_WIDTH * 2)
#define WS_VB       (WS_UB + (size_t)16384 * D_MODEL * 2)
#define WS_USC      (WS_VB + (size_t)16384 * D_MODEL * 2)
#define WS_VSC      (WS_USC + 16384 * 4)
#define WS_SBUF     (WS_VSC + 16384 * 4)
#define WS_HIN      (WS_SBUF + (size_t)BATCH * 64 * SSD_HEADS * 64 * 128 * 2)
#define WS_CDEC     (WS_HIN + (size_t)BATCH * 64 * SSD_HEADS * 64 * 128 * 2)
#define WS_OBUF     (WS_CDEC + (size_t)BATCH * 64 * SSD_HEADS * 4)
#define WS_LSE      (WS_OBUF + (size_t)3 * T_PROMPT * ATT_WIDTH * 2)
#define WS_ROPE     (WS_LSE + (size_t)3 * T_PROMPT * 8 * 4)
#define WS_END      (WS_ROPE + (size_t)SEQ * 64 * 4)

#define LDS_BYTES (160 * 1024)

#define KP const __attribute__((address_space(4))) Params* kp = (const __attribute__((address_space(4))) Params*)__builtin_amdgcn_kernarg_segment_ptr(); asm volatile("" : "+s"(kp)); unsigned char* ws = kp->ws; (void)ws;
#define IN(i) (kp->in[i])
#define WSP(T, off) ((T*)(ws + (off)))
__global__ void __launch_bounds__(512, 2) mega_fwd(Params p) {
    extern __shared__ __attribute__((aligned(16))) unsigned char smem[];
    if (threadIdx.x == 0) *(uint4*)smem = make_uint4(0u, 0u, 0u, 0u);
    __syncthreads();
    XcdBarrier bar = xcd_barrier_post(p.bar, (volatile LAS unsigned*)smem);
    float* lds = (float*)(smem + 256);
    LAS unsigned char* ldsb = (LAS unsigned char*)smem + 256;

    { KP ph_prologue(ldsb, IN(0), IN(1), WSP(bf16, WS_A0), IN(6), WSP(bf16, WS_WTIN), WSP(float, WS_ROPE)); }
    xcd_barrier(bar);
    { KP pg8::Gemm g{WSP(bf16, WS_A0), WSP(bf16, WS_WTIN), T_ALL, PROJ_LD, D_MODEL}; pg8::StaticOrder S; S.init(g.M, g.N, (int)gridDim.x, (int)blockIdx.x);
      pg8::EpiProj E{WSP(bf16, WS_PROJB), WSP(float, WS_DTRAW)}; pg8::gemm_phase<pg8::EpiProj, pg8::StaticOrder, false>(ldsb, g, S, E, nullptr); }
    xcd_barrier(bar);
    { KP ph_post_proj_prompt(WSP(bf16, WS_PROJB), WSP(float, WS_DTRAW), IN(7), IN(8), IN(9), WSP(float, WS_ROPE), WSP(bf16, WS_XBCB), WSP(float, WS_DT), WSP(bf16, WS_QROTB), WSP(bf16, WS_KROTB), kp->out); }
    { KP ph_post_proj2(WSP(bf16, WS_PROJB), WSP(float, WS_DTRAW), IN(4), IN(7), IN(8), IN(9), WSP(bf16, WS_XBCB), WSP(float, WS_DT), WSP(bf16, WS_QROTB), WSP(bf16, WS_KROTB), kp->out); }
    xcd_barrier(bar);
    { KP ph_ssd_states(ldsb, WSP(bf16, WS_XBCB), WSP(float, WS_DT), IN(10), WSP(bf16, WS_SBUF), WSP(float, WS_CDEC), IN(2), IN(3), kp->out); }
    __syncthreads();
    { KP ph_attn_prompt(ldsb, WSP(bf16, WS_QROTB), WSP(bf16, WS_KROTB), WSP(bf16, WS_PROJB), WSP(bf16, WS_OBUF), WSP(float, WS_LSE), IN(2), IN(3), kp->out); }
    __syncthreads();
    { KP ph_ssd_decode(WSP(bf16, WS_XBCB), WSP(float, WS_DT), IN(10), IN(11), IN(5), WSP(float, WS_YBUF), kp->out); }
    { KP ph_attn_sample3(lds, WSP(bf16, WS_QROTB), WSP(bf16, WS_KROTB), WSP(bf16, WS_PROJB), IN(2), IN(3), WSP(bf16, WS_A1)); }
    xcd_barrier(bar);
    if ((int)gridDim.x > 128) {
        if ((int)blockIdx.x < 96) {
            { KP ph_ssd_scan(WSP(bf16, WS_SBUF), WSP(float, WS_CDEC), WSP(bf16, WS_HIN), kp->out, (int)blockIdx.x, 96); }
            { KP ph_quant_tables(IN(19), IN(20), WSP(unsigned char, WS_UB), WSP(unsigned char, WS_VB), WSP(float, WS_USC), WSP(float, WS_VSC), (int)blockIdx.x, 96, 0, QSPLIT); }
        } else {
            { KP ph_prologue2(ldsb, IN(13), WSP(bf16, WS_WTOUT), IN(16), WSP(bf16, WS_WTQ), (int)blockIdx.x - 96, (int)gridDim.x - 96); }
            { KP ph_quant_tables(IN(19), IN(20), WSP(unsigned char, WS_UB), WSP(unsigned char, WS_VB), WSP(float, WS_USC), WSP(float, WS_VSC), (int)blockIdx.x - 96, (int)gridDim.x - 96, QSPLIT, 2 * 16384); }
        }
    } else {
        { KP ph_ssd_scan(WSP(bf16, WS_SBUF), WSP(float, WS_CDEC), WSP(bf16, WS_HIN), kp->out, (int)blockIdx.x, (int)gridDim.x); }
        { KP ph_prologue2(ldsb, IN(13), WSP(bf16, WS_WTOUT), IN(16), WSP(bf16, WS_WTQ), (int)blockIdx.x, (int)gridDim.x); }
        { KP ph_quant_tables(IN(19), IN(20), WSP(unsigned char, WS_UB), WSP(unsigned char, WS_VB), WSP(float, WS_USC), WSP(float, WS_VSC), (int)blockIdx.x, (int)gridDim.x); }
    }
    xcd_barrier(bar);
    { KP ph_ssd_out(ldsb, WSP(bf16, WS_XBCB), WSP(bf16, WS_PROJB), WSP(float, WS_DT), IN(10), IN(11), IN(12), WSP(bf16, WS_HIN), WSP(bf16, WS_A1)); }
    { KP ph_attn_combine(WSP(bf16, WS_OBUF), WSP(float, WS_LSE), WSP(bf16, WS_A1)); }
    { KP ph_gate_norm(WSP(bf16, WS_PROJB), IN(12), WSP(float, WS_YBUF), WSP(bf16, WS_A1)); }
    xcd_barrier(bar);
    { KP pg8::Gemm g{WSP(bf16, WS_A1), WSP(bf16, WS_WTOUT), T_ALL, D_MODEL, MIX_WIDTH}; pg8::StaticOrder S; S.init(g.M, g.N, (int)gridDim.x, (int)blockIdx.x);
      pg8::EpiBf16Plain E{WSP(bf16, WS_MIX), D_MODEL}; pg8::gemm_phase<pg8::EpiBf16Plain, pg8::StaticOrder, false>(ldsb, g, S, E, nullptr); }
    if (blockIdx.x >= 8 && gridDim.x == 256) { KP cache_copy_slice(IN(2), IN(3), kp->out, 4096u + (blockIdx.x - 8) * 8u + (threadIdx.x >> 6), threadIdx.x & 63u); }
    xcd_barrier(bar);
    { KP ph_ln_res(WSP(bf16, WS_A0), WSP(bf16, WS_MIX), IN(14), IN(15), WSP(bf16, WS_A2)); }
    xcd_barrier(bar);
    { KP pg8::Gemm g{WSP(bf16, WS_A2), WSP(bf16, WS_WTQ), T_ALL, 2048, D_MODEL}; pg8::StaticOrder S; S.init(g.M, g.N, (int)gridDim.x, (int)blockIdx.x);
      pg8::EpiBf16Plain E{WSP(bf16, WS_QH), 2048}; pg8::gemm_phase<pg8::EpiBf16Plain, pg8::StaticOrder, false>(ldsb, g, S, E, nullptr); }
    if (blockIdx.x >= 16 && gridDim.x == 256 && threadIdx.x < 256) { KP cache_copy_slice(IN(2), IN(3), kp->out, 4096u + 1984u + (blockIdx.x - 16) * 4u + (threadIdx.x >> 6), threadIdx.x & 63u); }
    xcd_barrier(bar);
    { KP ph_peer_route2(ldsb, WSP(bf16, WS_QH), IN(17), IN(18), WSP(int, WS_EIDX), WSP(float, WS_GATE), IN(2), IN(3), kp->out); }
    xcd_barrier(bar);
    { KP ph_peer_ffn3(WSP(bf16, WS_A2), WSP(int, WS_EIDX), WSP(float, WS_GATE), WSP(unsigned char, WS_UB), WSP(unsigned char, WS_VB), WSP(float, WS_USC), WSP(float, WS_VSC), IN(21), IN(22), kp->out, IN(2), IN(3), gridDim.x == 256 ? 8960u : 4096u); }
}

extern "C" void kernel_launch(void* const* d_in, const int* in_sizes, int n_in, void* d_out, int out_size, void* d_ws, size_t ws_size, hipStream_t stream) {
    static int grid = 0;
    if (grid == 0) {
        int dev = 0, cus = 0, per_cu = 0;
        if (hipGetDevice(&dev) != hipSuccess || hipDeviceGetAttribute(&cus, hipDeviceAttributeMultiprocessorCount, dev) != hipSuccess) { fprintf(stderr, "kernel_launch: device query failed\n"); grid = -1; return; }
        if (hipFuncSetAttribute((const void*)mega_fwd, hipFuncAttributeMaxDynamicSharedMemorySize, LDS_BYTES) != hipSuccess) { fprintf(stderr, "kernel_launch: hipFuncSetAttribute failed\n"); grid = -1; return; }
        if (hipOccupancyMaxActiveBlocksPerMultiprocessor(&per_cu, (const void*)mega_fwd, NTHR, LDS_BYTES) != hipSuccess || per_cu < 1) { fprintf(stderr, "kernel_launch: occupancy query says %d\n", per_cu); }
        (void)hipGetLastError();
        grid = cus;
        if (ws_size < WS_END) { fprintf(stderr, "kernel_launch: workspace too small\n"); grid = -1; return; }
    }
    if (grid < 0) return;
    (void)hipMemsetAsync((char*)d_ws + WS_BAR, 0, XCD_BAR_WORDS * sizeof(unsigned), stream);
    Params p{};
    for (int i = 0; i < 23; ++i) p.in[i] = (const float*)d_in[i];
    p.out = (float*)d_out; p.ws = (unsigned char*)d_ws; p.bar = (unsigned*)((char*)d_ws + WS_BAR);
    hipLaunchKernelGGL(mega_fwd, dim3(grid), dim3(NTHR), LDS_BYTES, stream, p);
}
```
